# Optimizing an MI355X kernel written in HIP

```python
import jax, jax.numpy as jnp
from jax import lax
import numpy as np

D_MODEL = 2048
BATCH = 2
SEQ = 8192
DEPTH = 2

GRID_W = 64
CTX_LEN = 256
ROPE_THETA = 10000.0
NORM_EPS = 1e-6
Q_BLOCK = 128

GQA_HEADS = 8
GQA_KV_HEADS = 2
HEAD_DIM = 128
GLA_HEADS = 4
GLA_DK = 128
GLA_DV = 256
GLA_GATE_RANK = 16
GLA_TAU = 16.0
GLA_CHUNK = 64
MLA_HEADS = 8
MLA_Q_RANK = 512
MLA_KV_RANK = 512
MLA_NOPE = 128
MLA_ROPE = 64
MLA_V = 128
GQA_W = GQA_HEADS * HEAD_DIM
GLA_W = GLA_HEADS * GLA_DV
MLA_W = MLA_HEADS * MLA_V
PEER_HEADS = 8
PEER_NKEYS = 128
PEER_EXPERTS = PEER_NKEYS * PEER_NKEYS
PEER_QDIM = 256
PEER_HALF = PEER_QDIM // 2
PEER_TOPK = 16
PEER_BLOCK = 128

IN_SPLITS = (GQA_HEADS * HEAD_DIM, GQA_KV_HEADS * HEAD_DIM, GQA_KV_HEADS * HEAD_DIM,
             GLA_HEADS * GLA_DK, GLA_HEADS * GLA_DK, GLA_HEADS * GLA_DV, GLA_HEADS * GLA_DV,
             GLA_GATE_RANK, GLA_GATE_RANK,
             MLA_Q_RANK, MLA_KV_RANK, MLA_ROPE,
             D_MODEL, D_MODEL, D_MODEL)
IN_COLS = sum(IN_SPLITS)

kernel_name = 'hybrid_gqa_gla_mla_peer_dit'


def rms_norm(x, g):
    xf = x.astype(jnp.float32)
    y = xf * lax.rsqrt(jnp.mean(xf * xf, axis=-1, keepdims=True) + NORM_EPS)
    return (y * g.astype(jnp.float32)).astype(x.dtype)


def split_cols(p, sizes):
    out, off = [], 0
    for n in sizes:
        out.append(p[..., off:off + n])
        off += n
    return out


def axial_rope(row_idx, col_idx, dim):
    quarter = dim // 4
    inv_freq = ROPE_THETA ** (-jnp.arange(quarter, dtype=jnp.float32) / quarter)
    ang = jnp.concatenate([row_idx[:, None].astype(jnp.float32) * inv_freq,
                           col_idx[:, None].astype(jnp.float32) * inv_freq], axis=-1)
    return jnp.cos(ang), jnp.sin(ang)


def apply_rope(x, cos, sin):
    half = x.shape[-1] // 2
    xf = x.astype(jnp.float32)
    x1, x2 = xf[..., :half], xf[..., half:]
    cs, sn = cos[None, :, None, :], sin[None, :, None, :]
    return jnp.concatenate([x1 * cs - x2 * sn, x2 * cs + x1 * sn], axis=-1).astype(x.dtype)


def block_attention(q, k, v):
    B, Sq, Hkv, G, dq = q.shape
    dv = v.shape[-1]
    nblk = Sq // Q_BLOCK
    scale = dq ** -0.5
    qb = q.reshape(B, nblk, Q_BLOCK, Hkv, G, dq).transpose(1, 0, 2, 3, 4, 5)

    def one_block(qblk):
        s = jnp.einsum('bqhgd,bkhd->bhgqk', qblk, k, preferred_element_type=jnp.float32) * scale
        p = jax.nn.softmax(s, axis=-1)
        return jnp.einsum('bhgqk,bkhe->bqhge', p.astype(v.dtype), v)

    o = lax.map(one_block, qb)
    return o.transpose(1, 0, 2, 3, 4, 5).reshape(B, Sq, Hkv, G, dv)


def gla_scan(q, k, v, log_a, state0):
    B, S, H, dk = q.shape
    dv = v.shape[-1]
    n = S // GLA_CHUNK

    def chunks(t):
        return t.reshape(B, n, GLA_CHUNK, H, t.shape[-1]).transpose(1, 0, 3, 2, 4).astype(jnp.float32)

    tri = jnp.tril(jnp.ones((GLA_CHUNK, GLA_CHUNK), dtype=bool))[:, :, None]

    def step(state, inp):
        qc, kc, vc, ac = inp
        b = jnp.cumsum(ac, axis=2)
        b_end = b[:, :, -1:, :]
        o_inter = jnp.einsum('bhtd,bhde->bhte', qc * jnp.exp(b), state)
        decay = jnp.exp(jnp.where(tri, b[:, :, :, None, :] - b[:, :, None, :, :], -jnp.inf))
        scores = jnp.einsum('bhtd,bhsd,bhtsd->bhts', qc, kc, decay)
        o_intra = jnp.einsum('bhts,bhse->bhte', scores, vc)
        new_state = (jnp.exp(b_end[:, :, 0, :, None]) * state
                     + jnp.einsum('bhsd,bhse->bhde', kc * jnp.exp(b_end - b), vc))
        return new_state, o_inter + o_intra

    state, o = lax.scan(step, state0, (chunks(q), chunks(k), chunks(v), chunks(log_a)))
    o = o.transpose(1, 0, 3, 2, 4).reshape(B, S, H, dv).astype(v.dtype)
    return o, state


def gla_scan_reverse(q, k, v, log_a, state0):
    o, state = gla_scan(jnp.flip(q, 1), jnp.flip(k, 1), jnp.flip(v, 1), jnp.flip(log_a, 1), state0)
    return jnp.flip(o, 1), state


def stream_inputs(p, lp, rope_a, rope_m):
    B, S = p.shape[:2]
    aq, ak, av, lq, lk, lv, lg, lrf, lrb, mcq, mckv, mkr, ga, gl, gm = split_cols(p, IN_SPLITS)
    aq = rms_norm(aq.reshape(B, S, GQA_HEADS, HEAD_DIM), lp['gqa_qn_g'])
    ak = rms_norm(ak.reshape(B, S, GQA_KV_HEADS, HEAD_DIM), lp['gqa_kn_g'])
    mq = (rms_norm(mcq, lp['mla_qn_g']) @ lp['mla_wuq']).reshape(B, S, MLA_HEADS, MLA_NOPE + MLA_ROPE)
    mkv = (rms_norm(mckv, lp['mla_kvn_g']) @ lp['mla_wukv']).reshape(B, S, MLA_HEADS, MLA_NOPE + MLA_V)
    mq_nope, mq_rope = mq[..., :MLA_NOPE], mq[..., MLA_NOPE:]
    mk_nope, mv = mkv[..., :MLA_NOPE], mkv[..., MLA_NOPE:]
    mk_rope = mkr.reshape(B, S, 1, MLA_ROPE)
    if rope_a is not None:
        aq = apply_rope(aq, *rope_a)
        ak = apply_rope(ak, *rope_a)
        mq_rope = apply_rope(mq_rope, *rope_m)
        mk_rope = apply_rope(mk_rope, *rope_m)

    def log_decay(lr, w, bias):
        pre = (lr @ w + bias).astype(jnp.float32)
        return (jax.nn.log_sigmoid(pre) / GLA_TAU).reshape(B, S, GLA_HEADS, GLA_DK)

    return dict(
        a_q=aq.reshape(B, S, GQA_KV_HEADS, GQA_HEADS // GQA_KV_HEADS, HEAD_DIM),
        a_k=ak,
        a_v=av.reshape(B, S, GQA_KV_HEADS, HEAD_DIM),
        l_q=lq.reshape(B, S, GLA_HEADS, GLA_DK) * GLA_DK ** -0.5,
        l_k=lk.reshape(B, S, GLA_HEADS, GLA_DK),
        l_v=lv.reshape(B, S, GLA_HEADS, GLA_DV),
        l_g=lg,
        l_af=log_decay(lrf, lp['gla_wa2_f'], lp['gla_ba_f']),
        l_ab=log_decay(lrb, lp['gla_wa2_b'], lp['gla_ba_b']),
        m_q=jnp.concatenate([mq_nope, mq_rope], axis=-1)[:, :, :, None, :],
        m_k=jnp.concatenate([mk_nope, jnp.broadcast_to(mk_rope, (B, S, MLA_HEADS, MLA_ROPE))], axis=-1),
        m_v=mv,
        gates=(ga, gl, gm),
    )


def gla_readout(o, gate, g):
    B, S = o.shape[:2]
    y = rms_norm(o, g) * jax.nn.silu(gate.reshape(B, S, GLA_HEADS, GLA_DV))
    return y.reshape(B, S, GLA_W)


def merge_branches(o_a, o_l, o_m, gates, lp):
    ga, gl, gm = gates
    y = (jax.nn.sigmoid(ga) * (o_a @ lp['w_br_gqa'])
         + jax.nn.sigmoid(gl) * (o_l @ lp['w_br_gla'])
         + jax.nn.sigmoid(gm) * (o_m @ lp['w_br_mla']))
    return y @ lp['w_out']


def token_mixer(h_l, h_c, lp, rope_a, rope_m, need_ctx):
    B, S = h_l.shape[:2]
    Sc = h_c.shape[1]
    L = stream_inputs(h_l @ lp['w_in'], lp, rope_a, rope_m)
    C = stream_inputs(h_c @ lp['w_in'], lp, None, None)
    o_a = block_attention(L['a_q'], jnp.concatenate([C['a_k'], L['a_k']], axis=1),
                          jnp.concatenate([C['a_v'], L['a_v']], axis=1)).reshape(B, S, GQA_W)
    o_m = block_attention(L['m_q'], jnp.concatenate([C['m_k'], L['m_k']], axis=1),
                          jnp.concatenate([C['m_v'], L['m_v']], axis=1)).reshape(B, S, MLA_W)
    zero = jnp.zeros((B, GLA_HEADS, GLA_DK, GLA_DV), jnp.float32)
    oc_f, st_f = gla_scan(C['l_q'], C['l_k'], C['l_v'], C['l_af'], zero)
    oc_b, st_b = gla_scan_reverse(C['l_q'], C['l_k'], C['l_v'], C['l_ab'], zero)
    ol_f, _ = gla_scan(L['l_q'], L['l_k'], L['l_v'], L['l_af'], st_f)
    ol_b, _ = gla_scan_reverse(L['l_q'], L['l_k'], L['l_v'], L['l_ab'], st_b)
    o_l = gla_readout(ol_f + ol_b, L['l_g'], lp['gla_on_g'])
    y_l = merge_branches(o_a, o_l, o_m, L['gates'], lp)
    if not need_ctx:
        return y_l, None
    oc_a = block_attention(C['a_q'], C['a_k'], C['a_v']).reshape(B, Sc, GQA_W)
    oc_m = block_attention(C['m_q'], C['m_k'], C['m_v']).reshape(B, Sc, MLA_W)
    oc_l = gla_readout(oc_f + oc_b, C['l_g'], lp['gla_on_g'])
    y_c = merge_branches(oc_a, oc_l, oc_m, C['gates'], lp)
    return y_l, y_c


def peer_ffn(h, wq, k1, k2, u_tab, v_tab):
    T, D = h.shape
    n = T // PEER_BLOCK

    def one_block(hb):
        q = (hb @ wq).reshape(PEER_BLOCK, PEER_HEADS, 2, PEER_HALF)
        s1 = jnp.einsum('thd,hnd->thn', q[:, :, 0], k1, preferred_element_type=jnp.float32)
        s2 = jnp.einsum('thd,hnd->thn', q[:, :, 1], k2, preferred_element_type=jnp.float32)
        v1, i1 = lax.top_k(s1, PEER_TOPK)
        v2, i2 = lax.top_k(s2, PEER_TOPK)
        ncand = PEER_TOPK * PEER_TOPK
        cand = (v1[..., :, None] + v2[..., None, :]).reshape(PEER_BLOCK, PEER_HEADS, ncand)
        cand_idx = (i1[..., :, None] * PEER_NKEYS + i2[..., None, :]).reshape(PEER_BLOCK, PEER_HEADS, ncand)
        best, pos = lax.top_k(cand, PEER_TOPK)
        idx = jnp.take_along_axis(cand_idx, pos, axis=-1)
        g = jax.nn.softmax(best, axis=-1)
        act = jax.nn.gelu(jnp.einsum('td,thkd->thk', hb, u_tab[idx]), approximate=False)
        return jnp.einsum('thk,thkd->td', (g * act).astype(hb.dtype), v_tab[idx])

    return lax.map(one_block, h.reshape(n, PEER_BLOCK, D)).reshape(T, D)


def ada_params(cvec, w, b):
    return jnp.split(jax.nn.silu(cvec) @ w + b, 6, axis=-1)


def setup_inputs(seed: int = 0) -> dict:
    key = jax.random.key(seed)
    ks = jax.random.split(key, 40)
    counter = iter(range(40))
    L, D = DEPTH, D_MODEL

    def normal(shape, scale):
        return jax.random.normal(ks[next(counter)], shape, jnp.float32) * scale

    def gain(shape):
        return 1.0 + normal(shape, 0.02)

    return {
        'x': normal((BATCH, SEQ, D), 1.0),
        'c': normal((BATCH, D), 1.0),
        'ctx': normal((BATCH, CTX_LEN, D), 1.0),
        'c_ctx': normal((D,), 1.0),
        'w_mod': normal((L, D, 6 * D), 0.5 * D ** -0.5),
        'b_mod': normal((L, 6 * D), 0.01),
        'norm1_g': gain((L, D)),
        'w_in': normal((L, D, IN_COLS), D ** -0.5),
        'gqa_qn_g': gain((L, HEAD_DIM)),
        'gqa_kn_g': gain((L, HEAD_DIM)),
        'gla_wa2_f': normal((L, GLA_GATE_RANK, GLA_HEADS * GLA_DK), GLA_GATE_RANK ** -0.5),
        'gla_ba_f': normal((L, GLA_HEADS * GLA_DK), 0.1),
        'gla_wa2_b': normal((L, GLA_GATE_RANK, GLA_HEADS * GLA_DK), GLA_GATE_RANK ** -0.5),
        'gla_ba_b': normal((L, GLA_HEADS * GLA_DK), 0.1),
        'gla_on_g': gain((L, GLA_DV)),
        'mla_qn_g': gain((L, MLA_Q_RANK)),
        'mla_wuq': normal((L, MLA_Q_RANK, MLA_HEADS * (MLA_NOPE + MLA_ROPE)), MLA_Q_RANK ** -0.5),
        'mla_kvn_g': gain((L, MLA_KV_RANK)),
        'mla_wukv': normal((L, MLA_KV_RANK, MLA_HEADS * (MLA_NOPE + MLA_V)), MLA_KV_RANK ** -0.5),
        'w_br_gqa': normal((L, GQA_W, D), GQA_W ** -0.5),
        'w_br_gla': normal((L, GLA_W, D), GLA_W ** -0.5),
        'w_br_mla': normal((L, MLA_W, D), MLA_W ** -0.5),
        'w_out': normal((L, D, D), D ** -0.5),
        'norm2_g': gain((L, D)),
        'peer_wq': normal((L, D, PEER_HEADS * PEER_QDIM), D ** -0.5),
        'peer_k1': normal((L, PEER_HEADS, PEER_NKEYS, PEER_HALF), PEER_HALF ** -0.5),
        'peer_k2': normal((L, PEER_HEADS, PEER_NKEYS, PEER_HALF), PEER_HALF ** -0.5),
        'peer_u': normal((L, PEER_EXPERTS, D), D ** -0.5),
        'peer_v': normal((L, PEER_EXPERTS, D), 0.5),
        'final_g': gain((D,)),
    }


def reference(x, c, ctx, c_ctx, w_mod, b_mod, norm1_g, w_in, gqa_qn_g, gqa_kn_g,
              gla_wa2_f, gla_ba_f, gla_wa2_b, gla_ba_b, gla_on_g,
              mla_qn_g, mla_wuq, mla_kvn_g, mla_wukv,
              w_br_gqa, w_br_gla, w_br_mla, w_out, norm2_g,
              peer_wq, peer_k1, peer_k2, peer_u, peer_v, final_g):
    B, S, D = x.shape
    rows = S // GRID_W
    row_idx = jnp.repeat(jnp.arange(rows, dtype=jnp.int32), GRID_W)
    col_idx = jnp.tile(jnp.arange(GRID_W, dtype=jnp.int32), rows)
    rope_a = axial_rope(row_idx, col_idx, HEAD_DIM)
    rope_m = axial_rope(row_idx, col_idx, MLA_ROPE)
    for i in range(DEPTH):
        need_ctx = i < DEPTH - 1
        lp = dict(w_in=w_in[i], gqa_qn_g=gqa_qn_g[i], gqa_kn_g=gqa_kn_g[i],
                  gla_wa2_f=gla_wa2_f[i], gla_ba_f=gla_ba_f[i], gla_wa2_b=gla_wa2_b[i], gla_ba_b=gla_ba_b[i],
                  gla_on_g=gla_on_g[i], mla_qn_g=mla_qn_g[i], mla_wuq=mla_wuq[i],
                  mla_kvn_g=mla_kvn_g[i], mla_wukv=mla_wukv[i],
                  w_br_gqa=w_br_gqa[i], w_br_gla=w_br_gla[i], w_br_mla=w_br_mla[i], w_out=w_out[i])
        sh1, sc1, g1, sh2, sc2, g2 = [m[:, None, :] for m in ada_params(c, w_mod[i], b_mod[i])]
        mc = ada_params(c_ctx, w_mod[i], b_mod[i])
        h_l = rms_norm(x, norm1_g[i]) * (1.0 + sc1) + sh1
        h_c = rms_norm(ctx, norm1_g[i]) * (1.0 + mc[1]) + mc[0]
        y_l, y_c = token_mixer(h_l, h_c, lp, rope_a, rope_m, need_ctx)
        x = x + g1 * y_l
        h2 = rms_norm(x, norm2_g[i]) * (1.0 + sc2) + sh2
        x = x + g2 * peer_ffn(h2.reshape(B * S, D), peer_wq[i], peer_k1[i], peer_k2[i],
                              peer_u[i], peer_v[i]).reshape(B, S, D)
        if need_ctx:
            ctx = ctx + mc[2] * y_c
            h2c = rms_norm(ctx, norm2_g[i]) * (1.0 + mc[4]) + mc[3]
            ctx = ctx + mc[5] * peer_ffn(h2c.reshape(-1, D), peer_wq[i], peer_k1[i], peer_k2[i],
                                         peer_u[i], peer_v[i]).reshape(ctx.shape)
    return rms_norm(x, final_g)
```

```cpp
#include <hip/hip_runtime.h>
#include <cstdio>
#include <cstdint>

#ifndef MK_N_LAUNCHES
#define MK_N_LAUNCHES 1
#endif

#ifndef DBG_MIX0
#define DBG_MIX0 1.0f
#define DBG_MIX1 1.0f
#define DBG_PEER0 1.0f
#define DBG_PEER1 1.0f
#endif
#define LAS __attribute__((address_space(3)))
typedef unsigned short bf16_t;
typedef short bf16x8 __attribute__((ext_vector_type(8)));
typedef short s16x4 __attribute__((ext_vector_type(4)));
typedef float f32x4 __attribute__((ext_vector_type(4)));
typedef float f32x2 __attribute__((ext_vector_type(2)));
typedef float f32x16 __attribute__((ext_vector_type(16)));
typedef unsigned u32x4 __attribute__((ext_vector_type(4)));
typedef unsigned u32x2 __attribute__((ext_vector_type(2)));
typedef __bf16 bf2_t __attribute__((ext_vector_type(2)));

constexpr int DM = 2048, NBATCH = 2, SEQ = 8192, CTXL = 256, DEPTH = 2;
constexpr int RPB = SEQ + CTXL;
constexpr int TT = NBATCH * RPB;
constexpr int IN_COLS = 11872, NP = 12032;
constexpr int C_AQ = 0, C_AK = 1024, C_AV = 1280, C_LQ = 1536, C_LK = 2048, C_LV = 2560, C_LG = 3584, C_LRF = 4608, C_LRB = 4624,
              C_MCQ = 4640, C_MCKV = 5152, C_MKR = 5664, C_GA = 5728, C_GL = 7776, C_GM = 9824;
constexpr int NCH = RPB / 64;
constexpr int NEXP = 16384;
constexpr float NORM_EPS = 1e-6f;
constexpr int NTHREADS = 512;

constexpr size_t al256(size_t x) { return (x + 255) / 256 * 256; }
constexpr size_t WS_CTL   = 0;
constexpr size_t CTL_BYTES = 65536;
constexpr size_t WS_MODV  = WS_CTL + CTL_BYTES;
constexpr size_t WS_TABA  = al256(WS_MODV + (size_t)2 * 3 * 12288 * 4);
constexpr size_t WS_TABM  = WS_TABA + 2 * 128 * 32 * 4;
constexpr size_t WS_XS    = al256(WS_TABM + 2 * 128 * 16 * 4);
constexpr size_t WS_HB    = WS_XS + (size_t)TT * DM * 4;
constexpr size_t WS_P     = WS_HB + (size_t)TT * DM * 2;
constexpr size_t WS_MQ    = WS_P + (size_t)TT * NP * 2;
constexpr size_t WS_MKV   = WS_MQ + (size_t)TT * 1536 * 2;
constexpr size_t WS_OA    = WS_MKV + (size_t)TT * 2048 * 2;
constexpr size_t WS_OL    = WS_OA + (size_t)TT * 1024 * 2;
constexpr size_t WS_OM    = WS_OL + (size_t)TT * 1024 * 2;
constexpr size_t WS_WIN   = WS_OM + (size_t)TT * 1024 * 2;
constexpr size_t WS_WUQ   = WS_WIN + (size_t)NP * 2048 * 2;
constexpr size_t WS_WUKV  = WS_WUQ + (size_t)1536 * 512 * 2;
constexpr size_t WS_WBR   = WS_WUKV + (size_t)2048 * 512 * 2;
constexpr size_t WS_WOUT  = WS_WBR + (size_t)3 * 2048 * 1024 * 2;
constexpr size_t WS_WQ    = WS_WOUT + (size_t)2048 * 2048 * 2;
constexpr size_t WS_K1    = WS_WQ + (size_t)2048 * 2048 * 2;
constexpr size_t WS_K2    = WS_K1 + (size_t)8 * 128 * 128 * 2;
constexpr size_t WS_GST   = WS_K2 + (size_t)8 * 128 * 128 * 2;
constexpr size_t WS_GDEC  = WS_GST + (size_t)NBATCH * 2 * 4 * NCH * 32768 * 2;
constexpr size_t WS_END   = WS_GDEC + (size_t)NBATCH * 2 * 4 * NCH * 128 * 4;
constexpr size_t WS_Y     = WS_MKV;
constexpr size_t WS_PQ    = WS_OA;
constexpr size_t WS_UB    = WS_P;
constexpr size_t WS_VB    = WS_UB + (size_t)NEXP * DM * 2;
constexpr size_t WS_PIDX  = WS_VB + (size_t)NEXP * DM * 2;
constexpr size_t WS_PG    = WS_PIDX + (size_t)TT * 128 * 4;
static_assert(WS_PG + (size_t)TT * 128 * 4 <= WS_MQ, "PEER alias region overflows P");

__device__ __forceinline__ unsigned cvt_pk_bf16(float lo, float hi) { bf2_t v; v.x = (__bf16)lo; v.y = (__bf16)hi; return __builtin_bit_cast(unsigned, v); }
__device__ __forceinline__ bf16_t f2bf(float f) { return (bf16_t)(cvt_pk_bf16(f, 0.f) & 0xffffu); }
__device__ __forceinline__ float bf2f(bf16_t b) { return __uint_as_float(((unsigned)b) << 16); }
__device__ __forceinline__ float bflo(unsigned w) { return __uint_as_float(w << 16); }
__device__ __forceinline__ float bfhi(unsigned w) { return __uint_as_float(w & 0xffff0000u); }
__device__ __forceinline__ float wave_sum(float v) {
#pragma unroll
    for (int o = 32; o >= 1; o >>= 1) v += __shfl_xor(v, o);
    return v;
}
__device__ __forceinline__ float sigmoidf_(float x) { return 1.0f / (1.0f + __expf(-x)); }
__device__ __forceinline__ float siluf_(float x) { return x / (1.0f + __expf(-x)); }

#define XB_TMO      128
#define XB_XCNT(j)  (256  + 64 * (j))
#define XB_XSUB(j)  (1280 + 64 * (j))
#define XB_XGEN(j)  (2304 + 64 * (j))
#define XB_TOP      3328
#define XB_TOPGEN   3392
#define XCD_BAR_WORDS 3456
#define XB_SPIN_CAP (1u << 20)
__device__ __forceinline__ unsigned xb_ld(unsigned* p)              { return __hip_atomic_load(p, __ATOMIC_RELAXED, __HIP_MEMORY_SCOPE_AGENT); }
__device__ __forceinline__ unsigned xb_add(unsigned* p, unsigned v) { return __hip_atomic_fetch_add(p, v, __ATOMIC_RELAXED, __HIP_MEMORY_SCOPE_AGENT); }
__device__ __forceinline__ unsigned xb_xcc_id() { return (unsigned)__builtin_amdgcn_s_getreg((3 << 11) | 20) & 0xFu; }
#define XB_SPIN(cond, bar) do { unsigned _sp = 0; while (cond) { __builtin_amdgcn_s_sleep(1); \
    if ((++_sp & 255u) == 0u) { if (xb_ld(&(bar)[XB_TMO])) break; if (_sp > XB_SPIN_CAP) { atomicAdd(&(bar)[XB_TMO], 1u); break; } } } } while (0)
struct XcdBarrier { unsigned* bar; unsigned x; volatile LAS unsigned* st; };
__device__ __forceinline__ XcdBarrier xcd_barrier_post(unsigned* bar, volatile LAS unsigned* st) {
    XcdBarrier b; b.bar = bar; b.x = xb_xcc_id(); b.st = st;
    if (threadIdx.x == 0) (void)xb_add(&bar[XB_XCNT(b.x)], 1u);
    return b;
}
__device__ __forceinline__ void xcd_barrier_complete(unsigned* bar, unsigned x, unsigned& nloc, unsigned& nx) {
    const unsigned G = gridDim.x * gridDim.y * gridDim.z;
    unsigned sum, cnt, mine, sp = 0u;
    for (;;) {
        sum = 0u; cnt = 0u; mine = 0u;
#pragma unroll
        for (unsigned j = 0; j < 16; ++j) { const unsigned c = xb_ld(&bar[XB_XCNT(j)]); sum += c; cnt += (c > 0u) ? 1u : 0u; mine = (j == x) ? c : mine; }
        if (sum == G) break;
        __builtin_amdgcn_s_sleep(1);
        if ((++sp & 255u) == 0u) { if (xb_ld(&bar[XB_TMO])) break; if (sp > XB_SPIN_CAP) { atomicAdd(&bar[XB_TMO], 1u); break; } }
    }
    nloc = mine > 0u ? mine : 1u; nx = cnt > 0u ? cnt : 1u;
}
__device__ __forceinline__ void xcd_barrier(const XcdBarrier& b) {
    asm volatile("s_waitcnt vmcnt(0)" ::: "memory");
    __syncthreads();
    if (threadIdx.x == 0) {
        unsigned* bar = b.bar;
        __builtin_amdgcn_s_waitcnt(0);
        unsigned nloc = b.st[0], nx = b.st[1];
        if (nloc == 0u) { xcd_barrier_complete(bar, b.x, nloc, nx); b.st[0] = nloc; b.st[1] = nx; }
        const unsigned old = xb_add(&bar[XB_XSUB(b.x)], 1u);
        const unsigned gen = old / nloc;
        if (old + 1u == (gen + 1u) * nloc) {
            __builtin_amdgcn_fence(__ATOMIC_RELEASE, "agent");
            asm volatile("s_waitcnt vmcnt(0)" ::: "memory");
            const unsigned og = xb_add(&bar[XB_TOP], 1u);
            const unsigned tg = og / nx;
            if (og + 1u == (tg + 1u) * nx) xb_add(&bar[XB_TOPGEN], 1u);
            else XB_SPIN(xb_ld(&bar[XB_TOPGEN]) == tg, bar);
            __builtin_amdgcn_fence(__ATOMIC_ACQUIRE, "agent");
            xb_add(&bar[XB_XGEN(b.x)], 1u);
            asm volatile("s_waitcnt vmcnt(0)" ::: "memory");
        } else {
            XB_SPIN(xb_ld(&bar[XB_XGEN(b.x)]) == gen, bar);
            __builtin_amdgcn_fence(__ATOMIC_ACQUIRE, "agent");
            asm volatile("s_waitcnt vmcnt(0)" ::: "memory");
        }
    }
    __syncthreads();
}

namespace pg8 {
constexpr int BM = 256, BK = 64, HALF = 128, HTB = HALF * BK * 2, STAGE_BYTES = 8 * HTB, NXCD = 8, WGM = 8;
__host__ __device__ __forceinline__ int lds_byte(int r, int c) { const int st = (r >> 4) * 2 + (c >> 5), rr = r & 15, cc = c & 31, ob = rr * 64 + cc * 2; return st * 1024 + (ob ^ (((ob >> 9) & 1) << 5)); }
__host__ __device__ __forceinline__ void stage_rc(int b, int& R, int& C) { const int st = b / 1024, sb = b % 1024, swz = sb ^ (((sb >> 9) & 1) << 5); R = (st >> 1) * 16 + swz / 64; C = (st & 1) * 32 + (swz % 64) / 2; }
__host__ __device__ __forceinline__ int perm32(int rho) { const int n = rho >> 4, i = rho & 15; return 8 * (i >> 2) + 4 * n + (i & 3); }
struct Unit { int pm, pn; };
struct Gemm { const bf16_t* A; const bf16_t* Bt; int M, N, K, lda, ldb; };
struct StaticOrder {
    int nM, nN, nwg, G, c;
    __host__ __device__ void init(int M, int N, int G_, int c_) { nM = M / BM; nN = N / BM; nwg = nM * nN; G = G_; c = c_; }
    __host__ __device__ bool next(int i, Unit& u) const {
        const long L = (long)i * G + c; if (L >= nwg) return false;
        int wgid = (int)L; { const int q = nwg / NXCD, r = nwg % NXCD, xcd = wgid % NXCD, off = wgid / NXCD; wgid = (xcd < r ? xcd * (q + 1) : r * (q + 1) + (xcd - r) * q) + off; }
        const int nig = WGM * nN, gid = wgid / nig, fm = gid * WGM, gsz = (nM - fm) < WGM ? (nM - fm) : WGM;
        u.pm = fm + ((wgid % nig) % gsz); u.pn = (wgid % nig) / gsz; return true;
    }
};
struct EpiStoreBf16 {
    static constexpr bool PERM = true;
    bf16_t* O; int ldc;
    __device__ __forceinline__ void operator()(const f32x4 (&acc)[2][2][4][2], const Unit& u, int wr, int wc, int fr, int fq) const {
        const int row0 = u.pm * BM + wr * 64 + fr, col0 = u.pn * BM + wc * 32 + 8 * fq;
#pragma unroll
        for (int ai = 0; ai < 2; ++ai)
#pragma unroll
            for (int m = 0; m < 4; ++m) { bf16_t* rowp = O + (size_t)(row0 + ai * HALF + m * 16) * ldc + col0;
#pragma unroll
                for (int bj = 0; bj < 2; ++bj) { const f32x4 v0 = acc[ai][bj][m][0], v1 = acc[ai][bj][m][1];
                    u32x4 w; w.x = cvt_pk_bf16(v0[0], v0[1]); w.y = cvt_pk_bf16(v0[2], v0[3]); w.z = cvt_pk_bf16(v1[0], v1[1]); w.w = cvt_pk_bf16(v1[2], v1[3]);
                    *(u32x4*)(rowp + bj * HALF) = w; } }
    }
};
template <bool FIRST> struct EpiGate {
    static constexpr bool PERM = true;
    bf16_t* Y; int ldy; const bf16_t* Gt; int ldg;
    __device__ __forceinline__ void operator()(const f32x4 (&acc)[2][2][4][2], const Unit& u, int wr, int wc, int fr, int fq) const {
        const int row0 = u.pm * BM + wr * 64 + fr, col0 = u.pn * BM + wc * 32 + 8 * fq;
#pragma unroll
        for (int ai = 0; ai < 2; ++ai)
#pragma unroll
            for (int m = 0; m < 4; ++m) { const size_t r = (size_t)(row0 + ai * HALF + m * 16);
#pragma unroll
                for (int bj = 0; bj < 2; ++bj) { const f32x4 v0 = acc[ai][bj][m][0], v1 = acc[ai][bj][m][1];
                    const u32x4 g = *(const u32x4*)(Gt + r * ldg + col0 + bj * HALF);
                    float o[8];
                    o[0] = sigmoidf_(bflo(g.x)) * v0[0]; o[1] = sigmoidf_(bfhi(g.x)) * v0[1]; o[2] = sigmoidf_(bflo(g.y)) * v0[2]; o[3] = sigmoidf_(bfhi(g.y)) * v0[3];
                    o[4] = sigmoidf_(bflo(g.z)) * v1[0]; o[5] = sigmoidf_(bfhi(g.z)) * v1[1]; o[6] = sigmoidf_(bflo(g.w)) * v1[2]; o[7] = sigmoidf_(bfhi(g.w)) * v1[3];
                    bf16_t* yp = Y + r * ldy + col0 + bj * HALF;
                    if (!FIRST) { const u32x4 y = *(const u32x4*)yp;
                        o[0] += bflo(y.x); o[1] += bfhi(y.x); o[2] += bflo(y.y); o[3] += bfhi(y.y); o[4] += bflo(y.z); o[5] += bfhi(y.z); o[6] += bflo(y.w); o[7] += bfhi(y.w); }
                    u32x4 w; w.x = cvt_pk_bf16(o[0], o[1]); w.y = cvt_pk_bf16(o[2], o[3]); w.z = cvt_pk_bf16(o[4], o[5]); w.w = cvt_pk_bf16(o[6], o[7]);
                    *(u32x4*)yp = w; } }
    }
};
struct EpiResid {
    static constexpr bool PERM = false;
    float* X; int ldx; const float* gate; float gscale;
    __device__ __forceinline__ void operator()(const f32x4 (&acc)[2][2][4][2], const Unit& u, int wr, int wc, int fr, int fq) const {
        const int row0 = u.pm * BM + wr * 64 + fr, col0 = u.pn * BM + wc * 32 + 4 * fq;
        const int sel = (u.pm % 33 == 0) ? 2 : (u.pm / 33);
        const float* gp = gate + (size_t)sel * 12288 + col0;
        f32x4 gv[2][2];
#pragma unroll
        for (int bj = 0; bj < 2; ++bj)
#pragma unroll
            for (int n = 0; n < 2; ++n) gv[bj][n] = *(const f32x4*)(gp + bj * HALF + n * 16) * gscale;
#pragma unroll
        for (int ai = 0; ai < 2; ++ai)
#pragma unroll
            for (int m = 0; m < 4; ++m) { float* rowp = X + (size_t)(row0 + ai * HALF + m * 16) * ldx + col0;
#pragma unroll
                for (int bj = 0; bj < 2; ++bj)
#pragma unroll
                    for (int n = 0; n < 2; ++n) { f32x4* p = (f32x4*)(rowp + bj * HALF + n * 16); *p = *p + gv[bj][n] * acc[ai][bj][m][n]; } }
    }
};

template <class Epi, class Sched>
__device__ __forceinline__ void gemm_phase(LAS unsigned char* lds, const int tid, const Gemm g, const Sched& S, const Epi& E) {
    const int wid = __builtin_amdgcn_readfirstlane(tid >> 6), lane = tid & 63, wr = wid >> 2, wc = wid & 3, fr = lane & 15, fq = lane >> 4;
    const int K = g.K, nt = K / BK, lda = g.lda, ldb = g.ldb;
    unsigned voffA[2], voffB[2];
#pragma unroll
    for (int i = 0; i < 2; ++i) { int R, C; stage_rc(tid * 16 + i * 8192, R, C); const int Rb = Epi::PERM ? ((R & ~31) + perm32(R & 31)) : R;
        voffA[i] = (unsigned)(R * lda + C) * 2u; voffB[i] = (unsigned)(Rb * ldb + C) * 2u; }
    const size_t kstep = (size_t)(BK * 2);
    const size_t hstepA = (size_t)HALF * lda * 2, hstepB = (size_t)HALF * ldb * 2;
    const size_t tstepA = 2 * hstepA, tstepB = 2 * hstepB;
    const unsigned ldsw = (unsigned)wid * 1024u;
    const int aoff = lds_byte(wr * 64 + fr, fq * 8), boff = lds_byte(wc * 32 + fr, fq * 8);
#define PG8_SA(b, h) (((b) * 2 + (h)) * HTB)
#define PG8_SB(b, h) ((4 + (b) * 2 + (h)) * HTB)
#define PG8_STAGE(bufoff, gbase, voff) do { _Pragma("unroll") for (int _i = 0; _i < 2; ++_i) \
        __builtin_amdgcn_global_load_lds((const unsigned*)((const char*)(gbase) + (voff)[_i]), (LAS unsigned*)(lds + (bufoff) + ldsw + _i * 8192), 16, 0, 0); } while (0)
#define PG8_LDA(dst, b, h) do { _Pragma("unroll") for (int m = 0; m < 4; ++m) _Pragma("unroll") for (int k = 0; k < 2; ++k) dst[m][k] = *(const LAS bf16x8*)(lds + PG8_SA(b, h) + aoff + m * 2048 + k * 1024); } while (0)
#define PG8_LDB(dst, b, h) do { _Pragma("unroll") for (int n = 0; n < 2; ++n) _Pragma("unroll") for (int k = 0; k < 2; ++k) dst[n][k] = *(const LAS bf16x8*)(lds + PG8_SB(b, h) + boff + n * 2048 + k * 1024); } while (0)
#define PG8_MMA(ai, bj, At, Bt) do { __builtin_amdgcn_s_setprio(1); _Pragma("unroll") for (int m = 0; m < 4; ++m) _Pragma("unroll") for (int n = 0; n < 2; ++n) _Pragma("unroll") for (int k = 0; k < 2; ++k) \
        acc[ai][bj][m][n] = __builtin_amdgcn_mfma_f32_16x16x32_bf16(Bt[n][k], At[m][k], acc[ai][bj][m][n], 0, 0, 0); __builtin_amdgcn_s_setprio(0); } while (0)
#define PG8_WAIT_V(n) asm volatile("s_waitcnt vmcnt(" #n ")" ::: "memory")
#define PG8_WAIT_L(n) asm volatile("s_waitcnt lgkmcnt(" #n ")" ::: "memory")
#define PG8_BAR __builtin_amdgcn_s_barrier()
#define PG8_SCHED __builtin_amdgcn_sched_barrier(0)
    Unit cur, nxt; int ui = 0;
    if (!S.next(0, cur)) return;
    f32x4 acc[2][2][4][2];
#pragma unroll
    for (int a = 0; a < 2; ++a)
#pragma unroll
        for (int b = 0; b < 2; ++b)
#pragma unroll
            for (int m = 0; m < 4; ++m)
#pragma unroll
                for (int n = 0; n < 2; ++n) acc[a][b][m][n] = (f32x4){0.f, 0.f, 0.f, 0.f};
    bf16x8 At[4][2], B0[2][2], B1[2][2];
    const char* cA = (const char*)g.A + (size_t)cur.pm * tstepA; const char* cB = (const char*)g.Bt + (size_t)cur.pn * tstepB;
    PG8_STAGE(PG8_SB(0, 0), cB, voffB); PG8_STAGE(PG8_SA(0, 0), cA, voffA); PG8_STAGE(PG8_SB(0, 1), cB + hstepB, voffB); PG8_STAGE(PG8_SA(0, 1), cA + hstepA, voffA);
    if (wr == 1) PG8_BAR;
    PG8_WAIT_V(4); PG8_BAR;
    PG8_STAGE(PG8_SB(1, 0), cB + kstep, voffB); PG8_STAGE(PG8_SA(1, 0), cA + kstep, voffA); PG8_STAGE(PG8_SB(1, 1), cB + hstepB + kstep, voffB);
    PG8_WAIT_V(6); PG8_BAR;
    for (;;) {
        const bool has_next = S.next(ui + 1, nxt);
        const char* nA = has_next ? (const char*)g.A + (size_t)nxt.pm * tstepA : cA; const char* nB = has_next ? (const char*)g.Bt + (size_t)nxt.pn * tstepB : cB;
        for (int t = 0; t < nt; t += 2) {
            const bool last = (t == nt - 2);
            const char* a1 = cA + (size_t)(t + 1) * kstep;
            const char* a2 = last ? nA : cA + (size_t)(t + 2) * kstep; const char* b2 = last ? nB : cB + (size_t)(t + 2) * kstep;
            const char* a3 = a2 + kstep; const char* b3 = b2 + kstep;
            PG8_LDB(B0, 0, 0); PG8_SCHED; PG8_LDA(At, 0, 0); PG8_STAGE(PG8_SA(1, 1), a1 + hstepA, voffA);
            PG8_WAIT_L(8); PG8_BAR; PG8_WAIT_L(0); PG8_MMA(0, 0, At, B0); PG8_BAR; PG8_SCHED;
            PG8_LDB(B1, 0, 1); PG8_STAGE(PG8_SB(0, 0), b2, voffB);
            PG8_BAR; PG8_WAIT_L(0); PG8_MMA(0, 1, At, B1); PG8_BAR;
            PG8_LDA(At, 0, 1); PG8_STAGE(PG8_SA(0, 0), a2, voffA);
            PG8_BAR; PG8_WAIT_L(0); PG8_MMA(1, 0, At, B0); PG8_BAR; PG8_SCHED;
            PG8_STAGE(PG8_SB(0, 1), b2 + hstepB, voffB);
            PG8_WAIT_V(6); PG8_BAR; PG8_MMA(1, 1, At, B1); PG8_BAR;
            PG8_LDB(B0, 1, 0); PG8_SCHED; PG8_LDA(At, 1, 0); PG8_STAGE(PG8_SA(0, 1), a2 + hstepA, voffA);
            PG8_WAIT_L(8); PG8_BAR; PG8_WAIT_L(0); PG8_MMA(0, 0, At, B0); PG8_BAR; PG8_SCHED;
            PG8_LDB(B1, 1, 1); PG8_STAGE(PG8_SB(1, 0), b3, voffB);
            PG8_BAR; PG8_WAIT_L(0); PG8_MMA(0, 1, At, B1); PG8_BAR;
            PG8_LDA(At, 1, 1); PG8_STAGE(PG8_SA(1, 0), a3, voffA);
            PG8_BAR; PG8_WAIT_L(0); PG8_MMA(1, 0, At, B0); PG8_BAR; PG8_SCHED;
            PG8_STAGE(PG8_SB(1, 1), b3 + hstepB, voffB);
            PG8_WAIT_V(6); PG8_BAR; PG8_MMA(1, 1, At, B1); PG8_BAR;
        }
        E(acc, cur, wr, wc, fr, fq);
        if (!has_next) break;
#pragma unroll
        for (int a = 0; a < 2; ++a)
#pragma unroll
            for (int b = 0; b < 2; ++b)
#pragma unroll
                for (int m = 0; m < 4; ++m)
#pragma unroll
                    for (int n = 0; n < 2; ++n) acc[a][b][m][n] = (f32x4){0.f, 0.f, 0.f, 0.f};
        cur = nxt; cA = nA; cB = nB; ++ui;
    }
    PG8_WAIT_V(0);
    if (wr == 0) PG8_BAR;
    PG8_BAR;
#undef PG8_SA
#undef PG8_SB
#undef PG8_STAGE
#undef PG8_LDA
#undef PG8_LDB
#undef PG8_MMA
#undef PG8_WAIT_V
#undef PG8_WAIT_L
#undef PG8_BAR
#undef PG8_SCHED
}
}

struct Args { const float* in[30]; float* out; unsigned char* ws; int ph_lo, ph_hi; };
enum { I_X = 0, I_C, I_CTX, I_CCTX, I_WMOD, I_BMOD, I_N1G, I_WIN, I_QNG, I_KNG, I_WA2F, I_BAF, I_WA2B, I_BAB, I_ONG, I_MQNG, I_WUQ, I_MKVNG, I_WUKV,
       I_WBRA, I_WBRL, I_WBRM, I_WOUT, I_N2G, I_PWQ, I_PK1, I_PK2, I_PU, I_PV, I_FG };
typedef const float* cfp_t;
struct Ctx {
    const __attribute__((address_space(4))) cfp_t* in; float* out; unsigned char* ws; LAS unsigned char* lds;
    int tid, lane, wid, G, bid;
};
#define WSP(T, off) ((T*)(C.ws + (off)))
#define INP(i) (C.in[(i)])
__device__ __forceinline__ unsigned long long launder_u64(unsigned long long w) {
    unsigned lo = (unsigned)w, hi = (unsigned)(w >> 32); asm volatile("" : "+v"(lo), "+v"(hi));
    lo = __builtin_amdgcn_readfirstlane(lo); hi = __builtin_amdgcn_readfirstlane(hi); return ((unsigned long long)hi << 32) | lo;
}
__device__ __forceinline__ Ctx launder(const Ctx& C0) {
    Ctx R = C0; int t = C0.tid; asm volatile("" : "+v"(t)); R.tid = t; R.lane = t & 63; R.wid = __builtin_amdgcn_readfirstlane(t >> 6);
    R.ws = (unsigned char*)launder_u64((unsigned long long)C0.ws);
    R.in = (const __attribute__((address_space(4))) cfp_t*)launder_u64((unsigned long long)C0.in);
    unsigned l = (unsigned)(uintptr_t)C0.lds; asm volatile("" : "+v"(l)); l = __builtin_amdgcn_readfirstlane(l); R.lds = (LAS unsigned char*)(uintptr_t)l;
    return R;
}

__device__ __forceinline__ const float* src_row(const Ctx& C, int r) {
    const int b = r / RPB, j = r % RPB;
    return j < CTXL ? INP(I_CTX) + ((size_t)b * CTXL + j) * DM : INP(I_X) + ((size_t)b * SEQ + (j - CTXL)) * DM;
}
__device__ __forceinline__ int mod_sel(int r) { const int b = r / RPB, j = r % RPB; return j < CTXL ? 2 : b; }

__device__ __forceinline__ void phase_modv(const Ctx& C) {
    LAS float* sc = (LAS float*)C.lds;
    LAS float* red = (LAS float*)(C.lds + 3 * 2048 * 4);
    for (int i = C.tid; i < 3 * DM; i += NTHREADS) { const int r = i / DM, k = i % DM; const float v = r < 2 ? INP(I_C)[r * DM + k] : INP(I_CCTX)[k]; sc[i] = siluf_(v); }
    __syncthreads();
    float* modv = WSP(float, WS_MODV);
    const int kq = C.tid / 12, c4 = C.tid % 12;
    for (int item = C.bid; item < 2 * 256; item += C.G) {
        const int l = item / 256, cg = item % 256;
        float acc[3][4];
#pragma unroll
        for (int r = 0; r < 3; ++r)
#pragma unroll
            for (int j = 0; j < 4; ++j) acc[r][j] = 0.f;
        if (kq < 42) {
            const float* wp = INP(I_WMOD) + (size_t)l * DM * 12288 + 48 * cg + 4 * c4;
            for (int k = kq; k < DM; k += 42) {
                const f32x4 w = *(const f32x4*)(wp + (size_t)k * 12288);
#pragma unroll
                for (int r = 0; r < 3; ++r) { const float s = sc[r * DM + k];
#pragma unroll
                    for (int j = 0; j < 4; ++j) acc[r][j] += s * w[j]; }
            }
#pragma unroll
            for (int r = 0; r < 3; ++r)
#pragma unroll
                for (int j = 0; j < 4; ++j) red[kq * 144 + r * 48 + c4 * 4 + j] = acc[r][j];
        }
        __syncthreads();
        if (C.tid < 144) { float s = 0.f; for (int q = 0; q < 42; ++q) s += red[q * 144 + C.tid];
            const int r = C.tid / 48, cc = C.tid % 48;
            modv[((size_t)l * 3 + r) * 12288 + 48 * cg + cc] = s + INP(I_BMOD)[(size_t)l * 12288 + 48 * cg + cc]; }
        __syncthreads();
    }
}
__device__ __forceinline__ void phase_tables(const Ctx& C) {
    float* ta = WSP(float, WS_TABA); float* tm = WSP(float, WS_TABM);
    for (int i = C.bid * NTHREADS + C.tid; i < 128 * 32 + 128 * 16; i += C.G * NTHREADS) {
        if (i < 128 * 32) { const int pos = i / 32, f = i % 32; const float inv = exp2f(-(float)f * (13.287712379549449f / 32.0f)); const float a = (float)pos * inv;
            ta[i] = cosf(a); ta[128 * 32 + i] = sinf(a); }
        else { const int k = i - 128 * 32, pos = k / 16, f = k % 16; const float inv = exp2f(-(float)f * (13.287712379549449f / 16.0f)); const float a = (float)pos * inv;
            tm[k] = cosf(a); tm[128 * 16 + k] = sinf(a); }
    }
}
__device__ __forceinline__ void transpose_cvt(const Ctx& C, const float* src, int K, int N, bf16_t* dst, int Npad, int& item) {
    LAS float* tile = (LAS float*)C.lds;
    const int tk = K / 64, tn = Npad / 64, ntile = tk * tn;
    for (int t = 0; t < ntile; ++t, ++item) {
        if (item % C.G != C.bid) continue;
        const int k0 = (t / tn) * 64, n0 = (t % tn) * 64;
#pragma unroll
        for (int p = 0; p < 2; ++p) { const int kk = (C.tid >> 4) + p * 32, nn = (C.tid & 15) * 4;
            f32x4 v = (f32x4){0.f, 0.f, 0.f, 0.f};
            if (n0 + nn < N) v = *(const f32x4*)(src + (size_t)(k0 + kk) * N + n0 + nn);
#pragma unroll
            for (int j = 0; j < 4; ++j) tile[kk * 65 + nn + j] = v[j]; }
        __syncthreads();
        { const int n = C.tid >> 3, k8 = (C.tid & 7) * 8; float v[8];
#pragma unroll
          for (int j = 0; j < 8; ++j) v[j] = tile[(k8 + j) * 65 + n];
          u32x4 w; w.x = cvt_pk_bf16(v[0], v[1]); w.y = cvt_pk_bf16(v[2], v[3]); w.z = cvt_pk_bf16(v[4], v[5]); w.w = cvt_pk_bf16(v[6], v[7]);
          *(u32x4*)(dst + (size_t)(n0 + n) * K + k0 + k8) = w; }
        __syncthreads();
    }
}
__device__ __forceinline__ void cvt_plain(const Ctx& C, const float* src, bf16_t* dst, size_t n8) {
    for (size_t i = (size_t)C.bid * NTHREADS + C.tid; i < n8; i += (size_t)C.G * NTHREADS) {
        const f32x4 a = *(const f32x4*)(src + i * 8), b = *(const f32x4*)(src + i * 8 + 4);
        u32x4 w; w.x = cvt_pk_bf16(a[0], a[1]); w.y = cvt_pk_bf16(a[2], a[3]); w.z = cvt_pk_bf16(b[0], b[1]); w.w = cvt_pk_bf16(b[2], b[3]);
        *(u32x4*)(dst + i * 8) = w;
    }
}
__device__ __forceinline__ void phase_cvt_mixer_weights(const Ctx& C, int l) {
    int item = 0;
    transpose_cvt(C, INP(I_WIN) + (size_t)l * DM * IN_COLS, DM, IN_COLS, WSP(bf16_t, WS_WIN), NP, item);
    transpose_cvt(C, INP(I_WUQ) + (size_t)l * 512 * 1536, 512, 1536, WSP(bf16_t, WS_WUQ), 1536, item);
    transpose_cvt(C, INP(I_WUKV) + (size_t)l * 512 * 2048, 512, 2048, WSP(bf16_t, WS_WUKV), 2048, item);
    transpose_cvt(C, INP(I_WBRA) + (size_t)l * 1024 * 2048, 1024, 2048, WSP(bf16_t, WS_WBR), 2048, item);
    transpose_cvt(C, INP(I_WBRL) + (size_t)l * 1024 * 2048, 1024, 2048, WSP(bf16_t, WS_WBR) + (size_t)2048 * 1024, 2048, item);
    transpose_cvt(C, INP(I_WBRM) + (size_t)l * 1024 * 2048, 1024, 2048, WSP(bf16_t, WS_WBR) + (size_t)2 * 2048 * 1024, 2048, item);
    transpose_cvt(C, INP(I_WOUT) + (size_t)l * 2048 * 2048, 2048, 2048, WSP(bf16_t, WS_WOUT), 2048, item);
    transpose_cvt(C, INP(I_PWQ) + (size_t)l * 2048 * 2048, 2048, 2048, WSP(bf16_t, WS_WQ), 2048, item);
    cvt_plain(C, INP(I_PK1) + (size_t)l * 8 * 128 * 128, WSP(bf16_t, WS_K1), 8 * 128 * 128 / 8);
    cvt_plain(C, INP(I_PK2) + (size_t)l * 8 * 128 * 128, WSP(bf16_t, WS_K2), 8 * 128 * 128 / 8);
}
__device__ __forceinline__ void phase_cvt_peer_tables(const Ctx& C, int l) {
    cvt_plain(C, INP(I_PU) + (size_t)l * NEXP * DM, WSP(bf16_t, WS_UB), (size_t)NEXP * DM / 8);
    cvt_plain(C, INP(I_PV) + (size_t)l * NEXP * DM, WSP(bf16_t, WS_VB), (size_t)NEXP * DM / 8);
}

template <bool FIRST> __device__ __forceinline__ void phase_norm_mod(const Ctx& C, const float* gvec, const float* modl  , int shift_off, int scale_off) {
    float* xs = WSP(float, WS_XS); bf16_t* hb = WSP(bf16_t, WS_HB);
    for (int r = C.bid * 8 + C.wid; r < TT; r += C.G * 8) {
        const float* xr = FIRST ? src_row(C, r) : xs + (size_t)r * DM;
        const float* mv = modl + (size_t)mod_sel(r) * 12288;
        f32x4 v[8]; float ss = 0.f;
#pragma unroll
        for (int c = 0; c < 4; ++c) { v[2 * c] = *(const f32x4*)(xr + c * 512 + C.lane * 8); v[2 * c + 1] = *(const f32x4*)(xr + c * 512 + C.lane * 8 + 4); }
#pragma unroll
        for (int c = 0; c < 8; ++c) ss += v[c][0] * v[c][0] + v[c][1] * v[c][1] + v[c][2] * v[c][2] + v[c][3] * v[c][3];
        ss = wave_sum(ss);
        const float rs = rsqrtf(ss * (1.0f / DM) + NORM_EPS);
#pragma unroll
        for (int c = 0; c < 4; ++c) { const int col = c * 512 + C.lane * 8;
            if (FIRST) { *(f32x4*)(xs + (size_t)r * DM + col) = v[2 * c]; *(f32x4*)(xs + (size_t)r * DM + col + 4) = v[2 * c + 1]; }
            float o[8];
#pragma unroll
            for (int h = 0; h < 2; ++h) { const f32x4 g = *(const f32x4*)(gvec + col + 4 * h), s = *(const f32x4*)(mv + scale_off + col + 4 * h), t = *(const f32x4*)(mv + shift_off + col + 4 * h);
#pragma unroll
                for (int j = 0; j < 4; ++j) o[4 * h + j] = v[2 * c + h][j] * rs * g[j] * (1.0f + s[j]) + t[j]; }
            u32x4 w; w.x = cvt_pk_bf16(o[0], o[1]); w.y = cvt_pk_bf16(o[2], o[3]); w.z = cvt_pk_bf16(o[4], o[5]); w.w = cvt_pk_bf16(o[6], o[7]);
            *(u32x4*)(hb + (size_t)r * DM + col) = w; }
    }
}

__device__ __forceinline__ void phase_post_p(const Ctx& C, int l) {
    bf16_t* P = WSP(bf16_t, WS_P); const float* ta = WSP(float, WS_TABA); const float* tm = WSP(float, WS_TABM);
    const float* qg = INP(I_QNG) + l * 128; const float* kg = INP(I_KNG) + l * 128;
    const float* mqg = INP(I_MQNG) + l * 512; const float* mkvg = INP(I_MKVNG) + l * 512;
    const int lane = C.lane;
    const float qg1 = qg[lane], qg2 = qg[lane + 64], kg1 = kg[lane], kg2 = kg[lane + 64];
    for (int r = C.bid * 8 + C.wid; r < TT; r += C.G * 8) {
        bf16_t* pr = P + (size_t)r * NP;
        const int j = r % RPB; const bool lat = j >= CTXL; const int pos = lat ? j - CTXL : 0, ri = pos >> 6, ci = pos & 63;
        float cs = 1.f, sn = 0.f;
        if (lat) { const int p = lane < 32 ? ri : ci, f = lane & 31; cs = ta[p * 32 + f]; sn = ta[128 * 32 + p * 32 + f]; }
#pragma unroll
        for (int h = 0; h < 10; ++h) {
            bf16_t* hp = pr + (h < 8 ? C_AQ + h * 128 : C_AK + (h - 8) * 128);
            const float x1 = bf2f(hp[lane]), x2 = bf2f(hp[lane + 64]);
            const float ss = wave_sum(x1 * x1 + x2 * x2);
            const float rs = rsqrtf(ss * (1.0f / 128.0f) + NORM_EPS);
            const float y1 = x1 * rs * (h < 8 ? qg1 : kg1), y2 = x2 * rs * (h < 8 ? qg2 : kg2);
            hp[lane] = f2bf(y1 * cs - y2 * sn); hp[lane + 64] = f2bf(y2 * cs + y1 * sn);
        }
#pragma unroll
        for (int s = 0; s < 2; ++s) {
            bf16_t* sp = pr + (s == 0 ? C_MCQ : C_MCKV) + lane * 8; const float* gg = (s == 0 ? mqg : mkvg) + lane * 8;
            const u32x4 w = *(const u32x4*)sp; float x[8] = {bflo(w.x), bfhi(w.x), bflo(w.y), bfhi(w.y), bflo(w.z), bfhi(w.z), bflo(w.w), bfhi(w.w)};
            float ss = 0.f;
#pragma unroll
            for (int i = 0; i < 8; ++i) ss += x[i] * x[i];
            ss = wave_sum(ss);
            const float rs = rsqrtf(ss * (1.0f / 512.0f) + NORM_EPS);
#pragma unroll
            for (int i = 0; i < 8; ++i) x[i] = x[i] * rs * gg[i];
            u32x4 o; o.x = cvt_pk_bf16(x[0], x[1]); o.y = cvt_pk_bf16(x[2], x[3]); o.z = cvt_pk_bf16(x[4], x[5]); o.w = cvt_pk_bf16(x[6], x[7]);
            *(u32x4*)sp = o;
        }
        if (lat) { bf16_t* kp = pr + C_MKR; const int i = lane & 31; const float x1 = bf2f(kp[i]), x2 = bf2f(kp[i + 32]);
            const int p = i < 16 ? ri : ci, f = i & 15; const float c2 = tm[p * 16 + f], s2 = tm[128 * 16 + p * 16 + f];
            if (lane < 32) { kp[i] = f2bf(x1 * c2 - x2 * s2); kp[i + 32] = f2bf(x2 * c2 + x1 * s2); } }
    }
}

namespace att {
constexpr int NW = 8, QBLK = 32, KVBLK = 64, DV = 128;
constexpr float THR = 8.f;
#define SBAR() __builtin_amdgcn_sched_barrier(0)
__device__ __forceinline__ int crow(int r, int hi) { return (r & 3) + 8 * (r >> 2) + 4 * hi; }
template <int DQ> struct Cf {
    static constexpr int ND0 = DQ / 16, KROWB = DQ * 2, SHM_K = KVBLK * DQ * 2, SHM_V = KVBLK * DV * 2, SHM = 2 * SHM_V + 2 * SHM_K + NW * 64 * 4;
    static constexpr float SCALE = DQ == 128 ? 0.088388347648318440f : 0.072168783648703220f;
    __device__ static __forceinline__ int kswz(int row, int colB) { return row * KROWB + (colB ^ ((row & 7) << 4)); }
};
template <int DQ> __device__ __forceinline__ void partialSM(f32x16& p0, f32x16& p1, float& m_reg, float& mn, float& alpha) {
    constexpr float SC = Cf<DQ>::SCALE, Cc = SC * 1.4426950408889634f;
    float pmax = p0[0];
#pragma unroll
    for (int r = 1; r < 16; ++r) pmax = fmaxf(pmax, p0[r]);
#pragma unroll
    for (int r = 0; r < 16; ++r) pmax = fmaxf(pmax, p1[r]);
    { auto rr = __builtin_amdgcn_permlane32_swap(__float_as_uint(pmax), __float_as_uint(pmax), false, false);
      pmax = fmaxf(__uint_as_float(rr[0]), __uint_as_float(rr[1])); }
    if (__builtin_expect(__all(pmax - m_reg <= THR / SC), 1)) { mn = m_reg; alpha = 1.f; }
    else { mn = fmaxf(m_reg, pmax); alpha = __builtin_amdgcn_exp2f((m_reg - mn) * Cc); m_reg = mn; }
    const float mnC = -mn * Cc;
#pragma unroll
    for (int r = 0; r < 16; ++r) p0[r] = fmaf(p0[r], Cc, mnC);
#pragma unroll
    for (int r = 0; r < 16; ++r) p1[r] = fmaf(p1[r], Cc, mnC);
#pragma unroll
    for (int r = 0; r < 16; ++r) p0[r] = __builtin_amdgcn_exp2f(p0[r]);
}
__device__ __forceinline__ void finishSM(f32x16& p0, f32x16& p1, float alpha, float& l_reg, bf16x8& pa0, bf16x8& pa1, bf16x8& pa2, bf16x8& pa3) {
#pragma unroll
    for (int r = 0; r < 16; ++r) p1[r] = __builtin_amdgcn_exp2f(p1[r]);
    float ps = 0;
#pragma unroll
    for (int r = 0; r < 16; ++r) ps += p0[r];
#pragma unroll
    for (int r = 0; r < 16; ++r) ps += p1[r];
    { auto rr = __builtin_amdgcn_permlane32_swap(__float_as_uint(ps), __float_as_uint(ps), false, false);
      ps = __uint_as_float(rr[0]) + __uint_as_float(rr[1]); }
    l_reg = l_reg * alpha + ps;
#define PK4(P, BASE, OUT) do { unsigned a0 = cvt_pk_bf16(P[BASE + 0], P[BASE + 1]), a1 = cvt_pk_bf16(P[BASE + 2], P[BASE + 3]);   \
    unsigned b0 = cvt_pk_bf16(P[BASE + 4], P[BASE + 5]), b1 = cvt_pk_bf16(P[BASE + 6], P[BASE + 7]);                              \
    auto r0 = __builtin_amdgcn_permlane32_swap(a0, b0, false, false); auto r1 = __builtin_amdgcn_permlane32_swap(a1, b1, false, false); \
    u32x4 w = {r0[0], r1[0], r0[1], r1[1]}; OUT = *reinterpret_cast<bf16x8*>(&w); } while (0)
    PK4(p0, 0, pa0); PK4(p0, 8, pa1); PK4(p1, 0, pa2); PK4(p1, 8, pa3);
#undef PK4
}
template <int DQ> __device__ __forceinline__ void qkt(f32x16& p0, f32x16& p1, const char* Ks, const bf16x8* qr, const char* qx, int r32, int hi) {
    p0 = f32x16{}; p1 = f32x16{};
#pragma unroll
    for (int d0 = 0; d0 < Cf<DQ>::ND0; ++d0) { const int cb = (d0 * 16 + hi * 8) * 2;
        const bf16x8 b0 = *reinterpret_cast<const bf16x8*>(Ks + Cf<DQ>::kswz(r32, cb));
        const bf16x8 b1 = *reinterpret_cast<const bf16x8*>(Ks + Cf<DQ>::kswz(32 + r32, cb));
        constexpr int NQR = DQ == 192 ? 4 : 8;
        bf16x8 q; if (d0 < NQR) q = qr[d0]; else q = *reinterpret_cast<const bf16x8*>(qx + (d0 - NQR) * 1024);
        p0 = __builtin_amdgcn_mfma_f32_32x32x16_bf16(b0, q, p0, 0, 0, 0);
        p1 = __builtin_amdgcn_mfma_f32_32x32x16_bf16(b1, q, p1, 0, 0, 0); }
}
__device__ __forceinline__ int v_st(int k, int c) { const int kk = (k & ~0xC) | ((k & 4) << 1) | ((k & 8) >> 1); return ((kk >> 3) * 4 + (c >> 5)) * 512 + ((kk & 7) * 32 + (c & 31)) * 2; }
__device__ __forceinline__ int v_rd_base(int lane) { return ((lane & 3) << 3) | (((lane >> 2) & 3) << 6) | (((lane >> 4) & 1) << 5) | (((lane >> 5) & 1) << 8); }
constexpr int v_rd_off(int d0, int ks, int half) { return d0 * 512 + ks * 4096 + half * 2048; }
template <int OFF> __device__ __forceinline__ s16x4 tr_read(int vb) {
    s16x4 r; asm volatile("ds_read_b64_tr_b16 %0, %1 offset:%2" : "=&v"(r) : "v"(vb), "i"(OFF) : "memory"); return r;
}
template <int D0> __device__ __forceinline__ void pv_one(f32x16& od, int vb, bf16x8 pa0, bf16x8 pa1, bf16x8 pa2, bf16x8 pa3) {
    const s16x4 l0 = tr_read<v_rd_off(D0, 0, 0)>(vb), h0 = tr_read<v_rd_off(D0, 0, 1)>(vb), l1 = tr_read<v_rd_off(D0, 1, 0)>(vb), h1 = tr_read<v_rd_off(D0, 1, 1)>(vb);
    const s16x4 l2 = tr_read<v_rd_off(D0, 2, 0)>(vb), h2 = tr_read<v_rd_off(D0, 2, 1)>(vb), l3 = tr_read<v_rd_off(D0, 3, 0)>(vb), h3 = tr_read<v_rd_off(D0, 3, 1)>(vb);
    asm volatile("s_waitcnt lgkmcnt(0)" ::: "memory"); SBAR();
#define PK(L, H) (bf16x8){L[0], L[1], L[2], L[3], H[0], H[1], H[2], H[3]}
    od = __builtin_amdgcn_mfma_f32_32x32x16_bf16(pa0, PK(l0, h0), od, 0, 0, 0);
    od = __builtin_amdgcn_mfma_f32_32x32x16_bf16(pa1, PK(l1, h1), od, 0, 0, 0);
    od = __builtin_amdgcn_mfma_f32_32x32x16_bf16(pa2, PK(l2, h2), od, 0, 0, 0);
    od = __builtin_amdgcn_mfma_f32_32x32x16_bf16(pa3, PK(l3, h3), od, 0, 0, 0);
#undef PK
}
__device__ __forceinline__ void pv_d0(f32x16* o, int vb, bf16x8 pa0, bf16x8 pa1, bf16x8 pa2, bf16x8 pa3) {
    pv_one<0>(o[0], vb, pa0, pa1, pa2, pa3); pv_one<1>(o[1], vb, pa0, pa1, pa2, pa3); pv_one<2>(o[2], vb, pa0, pa1, pa2, pa3); pv_one<3>(o[3], vb, pa0, pa1, pa2, pa3);
}
__device__ __forceinline__ bf16x8 ld8(const bf16_t* p) { return *reinterpret_cast<const bf16x8*>(p); }

template <int DQ, int SD>
__device__ __forceinline__ void attn_body(const bf16_t* __restrict__ Qb, int ldq, const bf16_t* __restrict__ Kn, int ldkn, const bf16_t* __restrict__ Kr, int ldkr,
                                          const bf16_t* __restrict__ Vh, int ldv, bf16_t* __restrict__ Ob, int ldo, int seq, bool rope_q, int pos0, const float* __restrict__ tabM, char* lds, const int tid) {
    using CF = Cf<DQ>; constexpr int ND0 = CF::ND0, SHM_V = CF::SHM_V, SHM_K = CF::SHM_K;
    const int wid = tid >> 6, lane = tid & 63, r32 = lane & 31, hi = lane >> 5;
    char* V_lds = lds; char* K_lds = lds + 2 * SHM_V;
    float* ws = (float*)(lds + 2 * SHM_V + 2 * SHM_K) + wid * 64; float* li_l = ws; float* al_l = ws + 32;
    constexpr int NQR = DQ == 192 ? 4 : 8;
    float m_reg = -1e30f, l_reg = 0; f32x16 o[4] = {}; bf16x8 qr[NQR];
    const bf16_t* Qw = Qb + (long)(wid * QBLK + r32) * ldq + hi * 8;
#pragma unroll
    for (int d0 = 0; d0 < NQR; ++d0) qr[d0] = ld8(Qw + d0 * 16);
    char* qx = lds + CF::SHM + wid * 8192 + lane * 16;
    if constexpr (DQ == 192) {
#pragma unroll
        for (int d0 = 4; d0 < 8; ++d0) *(bf16x8*)(qx + (d0 - 4) * 1024) = ld8(Qw + d0 * 16);
        bf16x8 qe[4];
#pragma unroll
        for (int d0 = 0; d0 < 4; ++d0) qe[d0] = ld8(Qw + (8 + d0) * 16);
        if (rope_q) {
            const int pos = pos0 + wid * QBLK + r32, ri = pos >> 6, ci = pos & 63;
#pragma unroll
            for (int t = 0; t < 2; ++t) { const int p = t == 0 ? ri : ci; const float* tc = tabM + p * 16 + hi * 8; const float* tsn = tabM + 128 * 16 + p * 16 + hi * 8;
                bf16x8 a = qe[t], b = qe[2 + t];
#pragma unroll
                for (int jj = 0; jj < 8; ++jj) { const float x1 = bf2f((bf16_t)a[jj]), x2 = bf2f((bf16_t)b[jj]), c = tc[jj], s = tsn[jj];
                    a[jj] = (short)f2bf(x1 * c - x2 * s); b[jj] = (short)f2bf(x2 * c + x1 * s); }
                qe[t] = a; qe[2 + t] = b; }
        }
#pragma unroll
        for (int d0 = 0; d0 < 4; ++d0) *(bf16x8*)(qx + (4 + d0) * 1024) = qe[d0];
    }
    const int sr = tid >> 4, sc = (tid & 15) * 8, vst0 = v_st(sr, sc), vst1 = v_st(32 + sr, sc);
    const int sr2 = tid >> 3, sc2 = (tid & 7) * 8;
    const int vb0 = (int)(uintptr_t)V_lds + v_rd_base(lane);
    struct { bf16x8 vs0, vs1, ks0, ks1, ks2; } sr_[SD];
    const unsigned offV = (unsigned)(sr * ldv + sc) * 2u, offK = (unsigned)(sr * ldkn + sc) * 2u, offR = (unsigned)(sr2 * ldkr + sc2) * 2u;
#define SLOAD(i, k0) do { const char* vt_ = (const char*)Vh + (size_t)(k0) * ldv * 2; const char* kt_ = (const char*)Kn + (size_t)(k0) * ldkn * 2; \
    sr_[i].vs0 = *(const bf16x8*)(vt_ + offV); sr_[i].vs1 = *(const bf16x8*)(vt_ + (size_t)32 * ldv * 2 + offV); \
    sr_[i].ks0 = *(const bf16x8*)(kt_ + offK); sr_[i].ks1 = *(const bf16x8*)(kt_ + (size_t)32 * ldkn * 2 + offK); \
    if constexpr (DQ == 192) sr_[i].ks2 = *(const bf16x8*)((const char*)Kr + (size_t)(k0) * ldkr * 2 + offR); } while (0)
#define SWRITE(b, i) do { *(bf16x8*)(V_lds + (b) * SHM_V + vst0) = sr_[i].vs0; *(bf16x8*)(V_lds + (b) * SHM_V + vst1) = sr_[i].vs1; const int kc = sc * 2; \
    *(bf16x8*)(K_lds + (b) * SHM_K + CF::kswz(sr, kc)) = sr_[i].ks0; *(bf16x8*)(K_lds + (b) * SHM_K + CF::kswz(32 + sr, kc)) = sr_[i].ks1; \
    if constexpr (DQ == 192) *(bf16x8*)(K_lds + (b) * SHM_K + CF::kswz(sr2, 256 + sc2 * 2)) = sr_[i].ks2; } while (0)
#define SWAIT() do { if constexpr (SD == 1) asm volatile("s_waitcnt vmcnt(0)" ::: "memory"); else if constexpr (DQ == 192) asm volatile("s_waitcnt vmcnt(5)" ::: "memory"); else asm volatile("s_waitcnt vmcnt(4)" ::: "memory"); } while (0)
#define RESC(a) do { if (__any((a) < 1.f)) { if (hi == 0) al_l[r32] = (a); asm volatile("s_waitcnt lgkmcnt(0)" ::: "memory"); \
    _Pragma("unroll") for (int d = 0; d < 4; ++d) _Pragma("unroll") for (int r = 0; r < 16; ++r) o[d][r] *= al_l[crow(r, hi)]; } } while (0)
    f32x16 pA0, pA1, pB0, pB1; float mnA, mnB, alA, alB; bf16x8 pa0, pa1, pa2, pa3; const int NT = seq / KVBLK;
    constexpr int SE = 0, SO = SD - 1;
    SLOAD(SE, 0); asm volatile("s_waitcnt vmcnt(0)" ::: "memory"); SWRITE(0, SE); __syncthreads();
    qkt<DQ>(pA0, pA1, K_lds, qr, qx, r32, hi); partialSM<DQ>(pA0, pA1, m_reg, mnA, alA);
    SLOAD(SO, KVBLK); if constexpr (SD == 2) { if (2 < NT) SLOAD(SE, 2 * KVBLK); }
    SWAIT(); SWRITE(1, SO); __syncthreads();
    for (int j = 1; j + 1 < NT; j += 2) {
        SBAR(); qkt<DQ>(pB0, pB1, K_lds + SHM_K, qr, qx, r32, hi);
        finishSM(pA0, pA1, alA, l_reg, pa0, pa1, pa2, pa3); SBAR();
        SLOAD(SO, (j + SD) * KVBLK); SBAR();
        pv_d0(o, vb0, pa0, pa1, pa2, pa3); partialSM<DQ>(pB0, pB1, m_reg, mnB, alB);
        __syncthreads(); SWAIT(); SWRITE(0, SE);
        RESC(alB); __syncthreads();
        SBAR(); qkt<DQ>(pA0, pA1, K_lds, qr, qx, r32, hi);
        finishSM(pB0, pB1, alB, l_reg, pa0, pa1, pa2, pa3); SBAR();
        if (SD == 1 || j + 3 < NT) SLOAD(SE, (j + 1 + SD) * KVBLK); SBAR();
        pv_d0(o, vb0 + SHM_V, pa0, pa1, pa2, pa3); partialSM<DQ>(pA0, pA1, m_reg, mnA, alA);
        __syncthreads(); SWAIT(); SWRITE(1, SO);
        RESC(alA); __syncthreads();
    }
    SBAR(); qkt<DQ>(pB0, pB1, K_lds + SHM_K, qr, qx, r32, hi);
    finishSM(pA0, pA1, alA, l_reg, pa0, pa1, pa2, pa3); SBAR();
    pv_d0(o, vb0, pa0, pa1, pa2, pa3); partialSM<DQ>(pB0, pB1, m_reg, mnB, alB);
    __syncthreads(); RESC(alB);
    finishSM(pB0, pB1, alB, l_reg, pa0, pa1, pa2, pa3); SBAR();
    pv_d0(o, vb0 + SHM_V, pa0, pa1, pa2, pa3);
    if (hi == 0) li_l[r32] = l_reg; asm volatile("s_waitcnt lgkmcnt(0)" ::: "memory");
    float rli[16];
#pragma unroll
    for (int r = 0; r < 16; ++r) rli[r] = __builtin_amdgcn_rcpf(li_l[crow(r, hi)]);
    bf16_t* Ow = Ob + (long)(wid * QBLK) * ldo;
#pragma unroll
    for (int r = 0; r < 16; ++r) { const int orow = crow(r, hi);
#pragma unroll
        for (int d0 = 0; d0 < 4; ++d0) Ow[(long)orow * ldo + d0 * 32 + r32] = f2bf(o[d0][r] * rli[r]); }
#undef SLOAD
#undef SWRITE
#undef SWAIT
#undef RESC
}
}

template <int KS> __device__ __forceinline__ void mma_xy(f32x16& acc, const LAS bf16_t* X, const LAS bf16_t* Y, int hi) {
#pragma unroll
    for (int ks = 0; ks < KS; ++ks) { const bf16x8 a = *(const LAS bf16x8*)(X + ks * 16 + hi * 8), b = *(const LAS bf16x8*)(Y + ks * 16 + hi * 8);
        acc = __builtin_amdgcn_mfma_f32_32x32x16_bf16(a, b, acc, 0, 0, 0); }
}
__device__ __forceinline__ float logsig16(float x) { const float e = __expf(-fabsf(x)); return (fminf(x, 0.f) - __logf(1.f + e)) * 0.0625f; }
__device__ __forceinline__ int gla_sidx(int b, int dir, int h) { return (b * 2 + dir) * 4 + h; }

__device__ __forceinline__ void gla_cumsum(const Ctx& C, int l, int h, int dir, const LAS float* lr, LAS float* segtot, float (&cum)[16]) {
    const int seg = C.tid >> 7, d = C.tid & 127;
    const float* wa = INP(dir ? I_WA2B : I_WA2F) + (size_t)l * 16 * 512 + h * 128 + d;
    const float bias = INP(dir ? I_BAB : I_BAF)[l * 512 + h * 128 + d];
    float w[16];
#pragma unroll
    for (int j = 0; j < 16; ++j) w[j] = wa[j * 512];
    float run = 0.f;
#pragma unroll
    for (int i = 0; i < 16; ++i) { const int s = seg * 16 + i, tk = dir ? 63 - s : s; float pre = bias;
#pragma unroll
        for (int j = 0; j < 16; ++j) pre += lr[tk * 32 + dir * 16 + j] * w[j];
        run += logsig16(pre); cum[i] = run; }
    segtot[seg * 128 + d] = run;
    __syncthreads();
    float off = 0.f;
#pragma unroll
    for (int q = 0; q < 3; ++q) if (q < seg) off += segtot[q * 128 + d];
#pragma unroll
    for (int i = 0; i < 16; ++i) cum[i] += off;
    __syncthreads();
}

__device__ __forceinline__ void phase_gla_local(const Ctx& C, int l) {
    const bf16_t* P = WSP(bf16_t, WS_P); bf16_t* GST = WSP(bf16_t, WS_GST); float* GDEC = WSP(float, WS_GDEC);
    LAS float* lr = (LAS float*)C.lds;
    LAS float* segtot = (LAS float*)(C.lds + 8192);
    LAS bf16_t* KT = (LAS bf16_t*)(C.lds + 8192 + 2048);
    LAS bf16_t* VT = (LAS bf16_t*)(C.lds + 8192 + 2048 + 18432);
    const int r32 = C.lane & 31, hi = C.lane >> 5, seg = C.tid >> 7, d = C.tid & 127;
    for (int unit = C.bid; unit < NBATCH * 4 * NCH; unit += C.G) {
        const int b = unit / (4 * NCH), h = (unit / NCH) % 4, ck = unit % NCH; const size_t r0 = (size_t)b * RPB + ck * 64;
        for (int i = C.tid; i < 64 * 32; i += NTHREADS) lr[i] = bf2f(P[(r0 + (i >> 5)) * NP + C_LRF + (i & 31)]);
        for (int i = C.tid; i < 64 * 256; i += NTHREADS) { const int s = i >> 8, e = i & 255; VT[e * 72 + s] = P[(r0 + s) * NP + C_LV + h * 256 + e]; }
        __syncthreads();
#pragma unroll 1
        for (int dir = 0; dir < 2; ++dir) {
            float cum[16];
            gla_cumsum(C, l, h, dir, lr, segtot, cum);
            if (seg == 3) segtot[d] = cum[15];
            __syncthreads();
            const float bend = segtot[d];
            const size_t sx = (size_t)gla_sidx(b, dir, h) * NCH + ck;
            if (seg == 0) GDEC[sx * 128 + d] = __expf(bend);
#pragma unroll
            for (int i = 0; i < 16; ++i) { const int s = seg * 16 + i, tk = dir ? 63 - s : s;
                const float kv = bf2f(P[(r0 + tk) * NP + C_LK + h * 128 + d]);
                KT[d * 72 + tk] = f2bf(kv * __expf(bend - cum[i])); }
            __syncthreads();
            { const int dt = C.wid & 3, eb = (C.wid >> 2) * 4;
              f32x16 acc[4] = {};
#pragma unroll
              for (int q = 0; q < 4; ++q) mma_xy<4>(acc[q], KT + (dt * 32 + r32) * 72, VT + ((eb + q) * 32 + r32) * 72, hi);
              bf16_t* st = GST + sx * 32768;
#pragma unroll
              for (int q = 0; q < 4; ++q)
#pragma unroll
                  for (int g = 0; g < 4; ++g) { u32x2 w; w.x = cvt_pk_bf16(acc[q][4 * g], acc[q][4 * g + 1]); w.y = cvt_pk_bf16(acc[q][4 * g + 2], acc[q][4 * g + 3]);
                      *(u32x2*)(st + (size_t)((eb + q) * 32 + r32) * 128 + dt * 32 + 8 * g + 4 * hi) = w; } }
            __syncthreads();
        }
    }
}

__device__ __forceinline__ void phase_gla_scan(const Ctx& C) {
    bf16_t* GST = WSP(bf16_t, WS_GST); const float* GDEC = WSP(float, WS_GDEC);
    for (int gid = C.bid * NTHREADS + C.tid; gid < 16 * 8192; gid += C.G * NTHREADS) {
        const int sidx = gid >> 13, g = gid & 8191, dir = (sidx >> 2) & 1, d4 = (g & 31) * 4;
        bf16_t* base = GST + (size_t)sidx * NCH * 32768 + (size_t)g * 4;
        const float* dbase = GDEC + (size_t)sidx * NCH * 128 + d4;
        float S[4] = {0.f, 0.f, 0.f, 0.f};
        for (int st = 0; st < NCH; st += 4) {
            int ck[4]; u32x2 L[4]; f32x4 dc[4];
#pragma unroll
            for (int q = 0; q < 4; ++q) { const int s = st + q; ck[q] = dir ? (s < 4 ? 3 - s : NCH + 3 - s) : s;
                L[q] = *(const u32x2*)(base + (size_t)ck[q] * 32768); dc[q] = *(const f32x4*)(dbase + (size_t)ck[q] * 128); }
#pragma unroll
            for (int q = 0; q < 4; ++q) { u32x2 w; w.x = cvt_pk_bf16(S[0], S[1]); w.y = cvt_pk_bf16(S[2], S[3]);
                *(u32x2*)(base + (size_t)ck[q] * 32768) = w;
                S[0] = dc[q][0] * S[0] + bflo(L[q].x); S[1] = dc[q][1] * S[1] + bfhi(L[q].x); S[2] = dc[q][2] * S[2] + bflo(L[q].y); S[3] = dc[q][3] * S[3] + bfhi(L[q].y); }
        }
    }
}

__device__ __forceinline__ void phase_gla_out(const Ctx& C, int l) {
    const bf16_t* P = WSP(bf16_t, WS_P); const bf16_t* GST = WSP(bf16_t, WS_GST); bf16_t* OL = WSP(bf16_t, WS_OL);
    LAS float* lr = (LAS float*)C.lds;
    LAS float* segtot = (LAS float*)(C.lds + 8192);
    LAS bf16_t* QT = (LAS bf16_t*)(C.lds + 10240);
    LAS bf16_t* KT = (LAS bf16_t*)(C.lds + 27648);
    LAS bf16_t* VT = (LAS bf16_t*)(C.lds + 45056);
    LAS bf16_t* SCm = (LAS bf16_t*)(C.lds + 81920);
    LAS float* OB = (LAS float*)(C.lds + 91136);
    const float* gon = INP(I_ONG) + l * 256;
    const int r32 = C.lane & 31, hi = C.lane >> 5, seg = C.tid >> 7, d = C.tid & 127;
    for (int unit = C.bid; unit < NBATCH * 4 * NCH; unit += C.G) {
        const int b = unit / (4 * NCH), h = (unit / NCH) % 4, ck = unit % NCH; const size_t r0 = (size_t)b * RPB + ck * 64;
        for (int i = C.tid; i < 64 * 32; i += NTHREADS) lr[i] = bf2f(P[(r0 + (i >> 5)) * NP + C_LRF + (i & 31)]);
        for (int i = C.tid; i < 64 * 256; i += NTHREADS) { const int s = i >> 8, e = i & 255; VT[e * 72 + s] = P[(r0 + s) * NP + C_LV + h * 256 + e]; }
        __syncthreads();
        f32x16 oacc[2] = {};
#pragma unroll 1
        for (int dir = 0; dir < 2; ++dir) {
            float cum[16];
            gla_cumsum(C, l, h, dir, lr, segtot, cum);
#pragma unroll
            for (int i = 0; i < 16; ++i) { const int s = seg * 16 + i, tk = dir ? 63 - s : s;
                const float qv = bf2f(P[(r0 + tk) * NP + C_LQ + h * 128 + d]), kv = bf2f(P[(r0 + tk) * NP + C_LK + h * 128 + d]);
                QT[tk * 136 + d] = f2bf(qv * __expf(cum[i]) * 0.088388347648318440f); KT[tk * 136 + d] = f2bf(kv * __expf(-cum[i])); }
            __syncthreads();
            if (C.wid < 4) { const int mt = C.wid >> 1, nt = C.wid & 1; f32x16 sc = {};
                mma_xy<8>(sc, QT + (mt * 32 + r32) * 136, KT + (nt * 32 + r32) * 136, hi);
#pragma unroll
                for (int i = 0; i < 16; ++i) { const int t = mt * 32 + att::crow(i, hi), s = nt * 32 + r32; const bool keep = dir ? (s >= t) : (s <= t);
                    SCm[t * 72 + s] = f2bf(keep ? sc[i] : 0.f); } }
            __syncthreads();
            { const bf16_t* st = GST + ((size_t)gla_sidx(b, dir, h) * NCH + ck) * 32768 + (size_t)(C.wid * 32 + r32) * 128 + hi * 8;
              bf16x8 sb[8];
#pragma unroll
              for (int ks = 0; ks < 8; ++ks) sb[ks] = *(const bf16x8*)(st + ks * 16);
#pragma unroll
              for (int mt = 0; mt < 2; ++mt) {
                  mma_xy<4>(oacc[mt], SCm + (mt * 32 + r32) * 72, VT + (C.wid * 32 + r32) * 72, hi);
#pragma unroll
                  for (int ks = 0; ks < 8; ++ks) { const bf16x8 a = *(const LAS bf16x8*)(QT + (mt * 32 + r32) * 136 + ks * 16 + hi * 8);
                      oacc[mt] = __builtin_amdgcn_mfma_f32_32x32x16_bf16(a, sb[ks], oacc[mt], 0, 0, 0); } } }
            __syncthreads();
        }
#pragma unroll
        for (int mt = 0; mt < 2; ++mt)
#pragma unroll
            for (int i = 0; i < 16; ++i) OB[(mt * 32 + att::crow(i, hi)) * 260 + C.wid * 32 + r32] = oacc[mt][i];
        __syncthreads();
        { const int t = C.tid >> 3, part = C.tid & 7; f32x4 v[8]; float ss = 0.f;
#pragma unroll
          for (int jj = 0; jj < 8; ++jj) { v[jj] = *(const LAS f32x4*)(OB + t * 260 + jj * 32 + part * 4); ss += v[jj][0] * v[jj][0] + v[jj][1] * v[jj][1] + v[jj][2] * v[jj][2] + v[jj][3] * v[jj][3]; }
          ss += __shfl_xor(ss, 1); ss += __shfl_xor(ss, 2); ss += __shfl_xor(ss, 4);
          const float rs = rsqrtf(ss * (1.0f / 256.0f) + NORM_EPS);
#pragma unroll
          for (int jj = 0; jj < 8; ++jj) { const int e = jj * 32 + part * 4; const f32x4 g = *(const f32x4*)(gon + e);
              const u32x2 gt = *(const u32x2*)(P + (r0 + t) * NP + C_LG + h * 256 + e);
              const float o0 = v[jj][0] * rs * g[0] * siluf_(bflo(gt.x)), o1 = v[jj][1] * rs * g[1] * siluf_(bfhi(gt.x)), o2 = v[jj][2] * rs * g[2] * siluf_(bflo(gt.y)), o3 = v[jj][3] * rs * g[3] * siluf_(bfhi(gt.y));
              u32x2 w; w.x = cvt_pk_bf16(o0, o1); w.y = cvt_pk_bf16(o2, o3);
              *(u32x2*)(OL + (r0 + t) * 1024 + h * 256 + e) = w; } }
        __syncthreads();
    }
}

__device__ __forceinline__ unsigned f_ord(float f) { const unsigned u = __float_as_uint(f); return u ^ ((unsigned)((int)u >> 31) | 0x80000000u); }
__device__ __forceinline__ float f_unord(unsigned k) { return __uint_as_float((k & 0x80000000u) ? (k ^ 0x80000000u) : ~k); }
__device__ __forceinline__ void ins_u(unsigned (&L)[16], unsigned x) {
#pragma unroll
    for (int j = 0; j < 16; ++j) { const unsigned h = L[j] > x ? L[j] : x; x = L[j] > x ? x : L[j]; L[j] = h; }
}
__device__ __forceinline__ void ins_f(float (&M)[16], float x) {
#pragma unroll
    for (int j = 0; j < 16; ++j) { const float h = M[j] > x ? M[j] : x; x = M[j] > x ? x : M[j]; M[j] = h; }
}
__device__ __forceinline__ void peer_top16(const bf16_t* __restrict__ qrow, const bf16_t* __restrict__ keys, int r32, int hi, unsigned (&L)[16]) {
    bf16x8 qf[8];
#pragma unroll
    for (int kk = 0; kk < 8; ++kk) qf[kk] = *(const bf16x8*)(qrow + kk * 16 + hi * 8);
#pragma unroll
    for (int j = 0; j < 16; ++j) L[j] = 0u;
#pragma unroll 1
    for (int mt = 0; mt < 4; ++mt) {
        f32x16 acc = {};
#pragma unroll
        for (int kk = 0; kk < 8; ++kk) { const bf16x8 a = *(const bf16x8*)(keys + (size_t)(mt * 32 + r32) * 128 + kk * 16 + hi * 8);
            acc = __builtin_amdgcn_mfma_f32_32x32x16_bf16(a, qf[kk], acc, 0, 0, 0); }
#pragma unroll
        for (int i = 0; i < 16; ++i) { const unsigned kidx = (unsigned)(mt * 32 + att::crow(i, hi)); ins_u(L, (f_ord(acc[i]) & ~127u) | (127u - kidx)); }
    }
    unsigned Pn[16];
#pragma unroll
    for (int j = 0; j < 16; ++j) Pn[j] = (unsigned)__shfl_xor((int)L[j], 32);
#pragma unroll
    for (int j = 0; j < 16; ++j) ins_u(L, Pn[j]);
}
__device__ __forceinline__ void phase_peer_select(const Ctx& C) {
    const bf16_t* PQ = WSP(bf16_t, WS_PQ); const bf16_t* K1 = WSP(bf16_t, WS_K1); const bf16_t* K2 = WSP(bf16_t, WS_K2);
    int* PIDX = WSP(int, WS_PIDX); float* PG = WSP(float, WS_PG);
    const int r32 = C.lane & 31, hi = C.lane >> 5, head = C.wid;
    for (int grp = C.bid; grp < TT / 32; grp += C.G) {
        const size_t tok = (size_t)grp * 32 + r32;
        unsigned L1[16], L2[16];
        peer_top16(PQ + tok * DM + head * 256, K1 + (size_t)head * 128 * 128, r32, hi, L1);
        peer_top16(PQ + tok * DM + head * 256 + 128, K2 + (size_t)head * 128 * 128, r32, hi, L2);
        float v1[16], v2[16];
#pragma unroll
        for (int j = 0; j < 16; ++j) { v1[j] = f_unord(L1[j] & ~127u); v2[j] = f_unord(L2[j] & ~127u); }
        float M[16];
#pragma unroll
        for (int j = 0; j < 16; ++j) M[j] = -3.0e38f;
#pragma unroll
        for (int a = 0; a < 16; ++a)
#pragma unroll
            for (int b = 0; b < 16; ++b) if ((a + 1) * (b + 1) <= 16) ins_f(M, v1[a] + v2[b]);
        const float thr = M[15], mx = M[0]; float den = 0.f;
#pragma unroll
        for (int j = 0; j < 16; ++j) den += __expf(M[j] - mx);
        const float rden = 1.0f / den;
        int pos = 0; int* ip = PIDX + tok * 128 + head * 16; float* gp = PG + tok * 128 + head * 16;
#pragma unroll
        for (int a = 0; a < 16; ++a)
#pragma unroll
            for (int b = 0; b < 16; ++b) if ((a + 1) * (b + 1) <= 16) {
                const float val = v1[a] + v2[b];
                if (val >= thr && pos < 16) { if (hi == 0) { ip[pos] = (int)((127u - (L1[a] & 127u)) * 128u + (127u - (L2[b] & 127u))); gp[pos] = __expf(val - mx) * rden; } ++pos; } }
    }
}
__device__ __forceinline__ float dot8(const u32x4 a, const u32x4 b, float acc) {
    acc += bflo(a.x) * bflo(b.x); acc += bfhi(a.x) * bfhi(b.x); acc += bflo(a.y) * bflo(b.y); acc += bfhi(a.y) * bfhi(b.y);
    acc += bflo(a.z) * bflo(b.z); acc += bfhi(a.z) * bfhi(b.z); acc += bflo(a.w) * bflo(b.w); acc += bfhi(a.w) * bfhi(b.w);
    return acc;
}
template <bool LAST> __device__ __forceinline__ void phase_peer_gather(const Ctx& C, const float* modl, const float pscale) {
    const bf16_t* HB = WSP(bf16_t, WS_HB); const bf16_t* UB = WSP(bf16_t, WS_UB); const bf16_t* VB = WSP(bf16_t, WS_VB);
    const int* PIDX = WSP(int, WS_PIDX); const float* PG = WSP(float, WS_PG); float* XS = WSP(float, WS_XS);
    const int lane = C.lane;
    for (int r = C.bid * 8 + C.wid; r < TT; r += C.G * 8) {
        if (LAST && (r % RPB) < CTXL) continue;
        u32x4 hq[4];
#pragma unroll
        for (int c = 0; c < 4; ++c) hq[c] = *(const u32x4*)(HB + (size_t)r * DM + c * 512 + lane * 8);
        const int id0 = PIDX[(size_t)r * 128 + lane] & (NEXP - 1), id1 = PIDX[(size_t)r * 128 + 64 + lane] & (NEXP - 1);
        const float g0 = PG[(size_t)r * 128 + lane], g1 = PG[(size_t)r * 128 + 64 + lane];
        float a0 = 0.f, a1 = 0.f;
#pragma unroll 1
        for (int e4 = 0; e4 < 32; ++e4) {
            u32x4 uq[4][4];
#pragma unroll
            for (int q = 0; q < 4; ++q) { const int le = (e4 & 15) * 4 + q; const int id = __builtin_amdgcn_readlane(e4 < 16 ? id0 : id1, le);
                const bf16_t* up = UB + (size_t)id * DM + lane * 8;
#pragma unroll
                for (int c = 0; c < 4; ++c) uq[q][c] = *(const u32x4*)(up + c * 512); }
#pragma unroll
            for (int q = 0; q < 4; ++q) { const int le = (e4 & 15) * 4 + q; float s = 0.f;
#pragma unroll
                for (int c = 0; c < 4; ++c) s = dot8(hq[c], uq[q][c], s);
                s = wave_sum(s);
                if (e4 < 16) a0 = (lane == le) ? s : a0; else a1 = (lane == le) ? s : a1; }
        }
        const float w0 = g0 * 0.5f * a0 * (1.0f + erff(a0 * 0.70710678118654752f)), w1 = g1 * 0.5f * a1 * (1.0f + erff(a1 * 0.70710678118654752f));
        float o[32];
#pragma unroll
        for (int i = 0; i < 32; ++i) o[i] = 0.f;
#pragma unroll 1
        for (int e4 = 0; e4 < 32; ++e4) {
            u32x4 vq[4][4]; float wq[4];
#pragma unroll
            for (int q = 0; q < 4; ++q) { const int le = (e4 & 15) * 4 + q; const int id = __builtin_amdgcn_readlane(e4 < 16 ? id0 : id1, le);
                wq[q] = __uint_as_float(__builtin_amdgcn_readlane(__float_as_uint(e4 < 16 ? w0 : w1), le));
                const bf16_t* vp = VB + (size_t)id * DM + lane * 8;
#pragma unroll
                for (int c = 0; c < 4; ++c) vq[q][c] = *(const u32x4*)(vp + c * 512); }
#pragma unroll
            for (int q = 0; q < 4; ++q)
#pragma unroll
                for (int c = 0; c < 4; ++c) { const u32x4 v = vq[q][c]; const float w = wq[q];
                    o[c * 8 + 0] += w * bflo(v.x); o[c * 8 + 1] += w * bfhi(v.x); o[c * 8 + 2] += w * bflo(v.y); o[c * 8 + 3] += w * bfhi(v.y);
                    o[c * 8 + 4] += w * bflo(v.z); o[c * 8 + 5] += w * bfhi(v.z); o[c * 8 + 6] += w * bflo(v.w); o[c * 8 + 7] += w * bfhi(v.w); }
        }
#ifdef DBG_CHECK
        { float* dbgo = WSP(float, WS_MQ);
#pragma unroll
          for (int c = 0; c < 4; ++c)
#pragma unroll
              for (int k = 0; k < 8; ++k) if (((r - 300) & 63) == 0 && r >= 300 && r < 300 + 64 * 128) dbgo[(size_t)r * DM + c * 512 + lane * 8 + k] = o[c * 8 + k]; }
#endif
        const float* g2 = modl + (size_t)mod_sel(r) * 12288 + 5 * DM;
        float ss = 0.f;
#pragma unroll
        for (int c = 0; c < 4; ++c)
#pragma unroll
            for (int h = 0; h < 2; ++h) { const int col = c * 512 + lane * 8 + 4 * h; float* xp = XS + (size_t)r * DM + col;
                const f32x4 x = *(const f32x4*)xp, g = *(const f32x4*)(g2 + col); f32x4 y;
#pragma unroll
                for (int j = 0; j < 4; ++j) { y[j] = x[j] + pscale * g[j] * o[c * 8 + 4 * h + j]; ss += y[j] * y[j]; o[c * 8 + 4 * h + j] = y[j]; }
                if (!LAST) *(f32x4*)xp = y; }
        if (LAST) {
            ss = wave_sum(ss); const float rs = rsqrtf(ss * (1.0f / DM) + NORM_EPS);
            const int b = r / RPB, j = r % RPB; float* op = C.out + ((size_t)b * SEQ + (j - CTXL)) * DM; const float* fg = INP(I_FG);
#pragma unroll
            for (int c = 0; c < 4; ++c)
#pragma unroll
                for (int h = 0; h < 2; ++h) { const int col = c * 512 + lane * 8 + 4 * h; const f32x4 g = *(const f32x4*)(fg + col); f32x4 y;
#pragma unroll
                    for (int jj = 0; jj < 4; ++jj) y[jj] = o[c * 8 + 4 * h + jj] * rs * g[jj];
                    *(f32x4*)(op + col) = y; }
        }
    }
}

template <int TYPE  > __device__ __forceinline__ void attn_units(const Ctx& C, bool need_ctx) {
    const bf16_t* P = WSP(bf16_t, WS_P);
    const int nu = need_ctx ? 528 : 512;
#pragma unroll 1
    for (int u = C.bid; u < nu; u += C.G) {
        int bh, qb; if (u < 512) { bh = (u >> 8) * 8 + (u & 7); qb = ((u & 255) >> 3) + 1; } else { bh = u - 512; qb = 0; }
        const int b = bh >> 3, h = bh & 7; const size_t rq = (size_t)b * RPB + (size_t)qb * 256, rk = (size_t)b * RPB; const int seq = qb == 0 ? CTXL : RPB;
        __syncthreads();
        if constexpr (TYPE == 1) {
            att::attn_body<128, 1>(P + rq * NP + C_AQ + h * 128, NP, P + rk * NP + C_AK + (h >> 2) * 128, NP, nullptr, 0, P + rk * NP + C_AV + (h >> 2) * 128, NP,
                                   WSP(bf16_t, WS_OA) + rq * 1024 + h * 128, 1024, seq, false, 0, nullptr, (char*)C.lds, C.tid);
        } else {
            const bf16_t* MQ = WSP(bf16_t, WS_MQ); const bf16_t* MKV = WSP(bf16_t, WS_MKV);
            att::attn_body<192, 1>(MQ + rq * 1536 + h * 192, 1536, MKV + rk * 2048 + h * 256, 2048, P + rk * NP + C_MKR, NP, MKV + rk * 2048 + h * 256 + 128, 2048,
                                   WSP(bf16_t, WS_OM) + rq * 1024 + h * 128, 1024, seq, qb > 0, (qb - 1) * 256, WSP(float, WS_TABM), (char*)C.lds, C.tid);
        }
    }
    __syncthreads();
}

constexpr int LDS_BYTES = 163840, LDS_BAR_OFF = LDS_BYTES - 16;
constexpr int N_PHASES = 25;
template <int K> __device__ __forceinline__ void run_phase(const Ctx& C0, int l) {
    const Ctx C = launder(C0);
    const float* modl = WSP(float, WS_MODV) + (size_t)l * 3 * 12288;
    if constexpr (K == 0) { phase_modv(C); phase_tables(C); __syncthreads(); phase_cvt_mixer_weights(C, 0); }
    if constexpr (K == 1) {
        if (l == 0) phase_norm_mod<true>(C, INP(I_N1G), modl, 0, DM);
        else { phase_norm_mod<false>(C, INP(I_N1G) + l * DM, modl, 0, DM); __syncthreads(); phase_cvt_mixer_weights(C, l); }
    }
    if constexpr (K == 2) {
        pg8::Gemm g{WSP(bf16_t, WS_HB), WSP(bf16_t, WS_WIN), TT, NP, DM, DM, DM}; pg8::StaticOrder S; S.init(TT, NP, C.G, C.bid);
        pg8::EpiStoreBf16 E{WSP(bf16_t, WS_P), NP};
        pg8::gemm_phase(C.lds, C.tid, g, S, E);
    }
    if constexpr (K == 3) phase_post_p(C, l);
    if constexpr (K == 4) {
        { pg8::Gemm g{WSP(bf16_t, WS_P) + C_MCQ, WSP(bf16_t, WS_WUQ), TT, 1536, 512, NP, 512}; pg8::StaticOrder S; S.init(TT, 1536, C.G, C.bid);
          pg8::EpiStoreBf16 E{WSP(bf16_t, WS_MQ), 1536}; pg8::gemm_phase(C.lds, C.tid, g, S, E); }
        { pg8::Gemm g{WSP(bf16_t, WS_P) + C_MCKV, WSP(bf16_t, WS_WUKV), TT, 2048, 512, NP, 512}; pg8::StaticOrder S; S.init(TT, 2048, C.G, C.bid);
          pg8::EpiStoreBf16 E{WSP(bf16_t, WS_MKV), 2048}; pg8::gemm_phase(C.lds, C.tid, g, S, E); }
        { const Ctx C2 = launder(C0); phase_gla_local(C2, l); }
    }
    if constexpr (K == 5) phase_gla_scan(C);
    if constexpr (K == 6) { attn_units<0>(C, l + 1 < DEPTH); { const Ctx C2 = launder(C0); attn_units<1>(C2, l + 1 < DEPTH); } { const Ctx C3 = launder(C0); phase_gla_out(C3, l); } }
    if constexpr (K == 7) {
        const bf16_t* P = WSP(bf16_t, WS_P); bf16_t* Y = WSP(bf16_t, WS_Y); pg8::StaticOrder S; S.init(TT, DM, C.G, C.bid);
        { pg8::Gemm g{WSP(bf16_t, WS_OA), WSP(bf16_t, WS_WBR), TT, DM, 1024, 1024, 1024}; pg8::EpiGate<true> E{Y, DM, P + C_GA, NP}; pg8::gemm_phase(C.lds, C.tid, g, S, E); }
        { pg8::Gemm g{WSP(bf16_t, WS_OL), WSP(bf16_t, WS_WBR) + (size_t)2048 * 1024, TT, DM, 1024, 1024, 1024}; pg8::EpiGate<false> E{Y, DM, P + C_GL, NP}; pg8::gemm_phase(C.lds, C.tid, g, S, E); }
        { pg8::Gemm g{WSP(bf16_t, WS_OM), WSP(bf16_t, WS_WBR) + (size_t)2 * 2048 * 1024, TT, DM, 1024, 1024, 1024}; pg8::EpiGate<false> E{Y, DM, P + C_GM, NP}; pg8::gemm_phase(C.lds, C.tid, g, S, E); }
    }
    if constexpr (K == 8) {
        pg8::Gemm g{WSP(bf16_t, WS_Y), WSP(bf16_t, WS_WOUT), TT, DM, DM, DM, DM}; pg8::StaticOrder S; S.init(TT, DM, C.G, C.bid);
        pg8::EpiResid E{WSP(float, WS_XS), DM, modl + 2 * DM, l == 0 ? DBG_MIX0 : DBG_MIX1};
        pg8::gemm_phase(C.lds, C.tid, g, S, E);
        phase_cvt_peer_tables(C, l);
    }
    if constexpr (K == 9) phase_norm_mod<false>(C, INP(I_N2G) + l * DM, modl, 3 * DM, 4 * DM);
    if constexpr (K == 10) {
        pg8::Gemm g{WSP(bf16_t, WS_HB), WSP(bf16_t, WS_WQ), TT, DM, DM, DM, DM}; pg8::StaticOrder S; S.init(TT, DM, C.G, C.bid);
        pg8::EpiStoreBf16 E{WSP(bf16_t, WS_PQ), DM};
        pg8::gemm_phase(C.lds, C.tid, g, S, E);
    }
    if constexpr (K == 11) phase_peer_select(C);
    if constexpr (K == 12) { if (l + 1 < DEPTH) phase_peer_gather<false>(C, modl, DBG_PEER0); else phase_peer_gather<true>(C, modl, DBG_PEER1); }
}
__device__ __forceinline__ Ctx make_ctx(const Args& args, unsigned char* lds_raw) {
    Ctx C0; C0.in = (const __attribute__((address_space(4))) cfp_t*)__builtin_amdgcn_kernarg_segment_ptr(); C0.out = args.out; C0.ws = args.ws; C0.lds = (LAS unsigned char*)lds_raw;
    C0.tid = threadIdx.x; C0.lane = C0.tid & 63; C0.wid = __builtin_amdgcn_readfirstlane(C0.tid >> 6); C0.G = gridDim.x; C0.bid = blockIdx.x;
    return C0;
}
template <int K> __global__ void __launch_bounds__(NTHREADS, 2) k_one(Args args) {
    extern __shared__ __attribute__((aligned(16))) unsigned char lds_raw[];
    const Ctx C0 = make_ctx(args, lds_raw);
    run_phase<K>(C0, args.ph_lo);
}
#if MK_N_LAUNCHES == 1
__global__ void __launch_bounds__(NTHREADS, 2) mk_fwd(Args args) {
    extern __shared__ __attribute__((aligned(16))) unsigned char lds_raw[];
    const Ctx C0 = make_ctx(args, lds_raw);
    if (C0.tid < 4) ((LAS unsigned*)(C0.lds + LDS_BAR_OFF))[C0.tid] = 0u;
    __syncthreads();
    const int lo = args.ph_lo, hi = args.ph_hi;
    XcdBarrier bar; bar.bar = (unsigned*)(args.ws + WS_CTL); bar.x = 0; bar.st = nullptr;
    if (hi - lo > 1) bar = xcd_barrier_post((unsigned*)(args.ws + WS_CTL), (volatile LAS unsigned*)(C0.lds + LDS_BAR_OFF));
#define IN(k) (lo <= (k) && (k) < hi)
#define SEAM(k) do { if (IN(k) && IN((k) + 1)) xcd_barrier(bar); } while (0)
#define PH(K, k) do { if (IN(k)) run_phase<K>(C0, l); SEAM(k); } while (0)
    { const int l = 0; PH(0, 0); }
#pragma unroll 1
    for (int l = 0; l < DEPTH; ++l) {
        const int pb = 1 + 12 * l;
        PH(1, pb + 0); PH(2, pb + 1); PH(3, pb + 2); PH(4, pb + 3); PH(5, pb + 4); PH(6, pb + 5);
        PH(7, pb + 6); PH(8, pb + 7); PH(9, pb + 8); PH(10, pb + 9); PH(11, pb + 10); PH(12, pb + 11);
    }
#undef PH
#undef IN
#undef SEAM
}
#define MAIN_KERNEL mk_fwd
#else
#define MAIN_KERNEL k_one<6>
#endif


#ifdef DBG_CHECK
__device__ __forceinline__ void dbg_report(unsigned* slot, float err) { if (!(err <= 3e38f)) err = 1e30f; atomicMax(slot, __float_as_uint(err)); }
__global__ void k_check_gemm(const bf16_t* A, int lda, const float* W, int K, int N, const bf16_t* Cm, int ldc, int M, unsigned* slot) {
    const unsigned id = blockIdx.x * blockDim.x + threadIdx.x; if (id >= 8192) return;
    const unsigned h = id * 2654435761u; const int row = (int)((h >> 8) % (unsigned)M), col = (int)((h * 40503u >> 7) % (unsigned)N);
    float ref = 0.f; for (int k = 0; k < K; ++k) ref += bf2f(A[(size_t)row * lda + k]) * W[(size_t)k * N + col];
    const float got = bf2f(Cm[(size_t)row * ldc + col]);
    dbg_report(slot, fabsf(got - ref) / (fabsf(ref) + 0.1f));
}
__global__ void k_check_select(const bf16_t* PQ, const float* k1, const float* k2, const int* PIDX, const float* PG, unsigned* slot) {
    __shared__ float s1[128], s2[128]; __shared__ int cnt; __shared__ float selv[16];
    const int tok = (blockIdx.x >> 3) * 61 + 5, head = blockIdx.x & 7, t = threadIdx.x;
    if (t == 0) cnt = 0;
    for (int n = t; n < 128; n += 64) { float a = 0.f, b = 0.f; for (int d = 0; d < 128; ++d) { a += bf2f(PQ[(size_t)tok * DM + head * 256 + d]) * k1[((size_t)head * 128 + n) * 128 + d]; b += bf2f(PQ[(size_t)tok * DM + head * 256 + 128 + d]) * k2[((size_t)head * 128 + n) * 128 + d]; } s1[n] = a; s2[n] = b; }
    __syncthreads();
    if (t < 16) { const int id = PIDX[(size_t)tok * 128 + head * 16 + t]; selv[t] = (id >= 0 && id < 16384) ? s1[id >> 7] + s2[id & 127] : -1e30f; }
    __syncthreads();
    float thr = selv[0], mx = selv[0]; for (int k = 1; k < 16; ++k) { thr = fminf(thr, selv[k]); mx = fmaxf(mx, selv[k]); }
    int c = 0; for (int p = t; p < 16384; p += 64) if (s1[p >> 7] + s2[p & 127] > thr + 0.02f) ++c;
    atomicAdd(&cnt, c); __syncthreads();
    if (t == 0) { float den = 0.f; for (int k = 0; k < 16; ++k) den += __expf(selv[k] - mx); float e = fabsf((float)cnt - 15.f) / 15.f > 0.34f ? fabsf((float)cnt - 15.f) / 15.f : 0.f;
        for (int k = 0; k < 16; ++k) e = fmaxf(e, fabsf(PG[(size_t)tok * 128 + head * 16 + k] - __expf(selv[k] - mx) / den) * 4.f);
        for (int k = 0; k < 16; ++k) for (int k2_ = 0; k2_ < k; ++k2_) if (PIDX[(size_t)tok * 128 + head * 16 + k] == PIDX[(size_t)tok * 128 + head * 16 + k2_]) e = fmaxf(e, 10.f);
        dbg_report(slot, e); }
}
__global__ void k_check_gather(const bf16_t* HB, const float* u, const float* v, const int* PIDX, const float* PG, const float* dbgo, unsigned* slot) {
    __shared__ float w[128];
    const int tok = blockIdx.x * 64 + 300, t = threadIdx.x;
    for (int k = t; k < 128; k += 64) { const int id = PIDX[(size_t)tok * 128 + k] & 16383; float a = 0.f; for (int d = 0; d < DM; ++d) a += bf2f(HB[(size_t)tok * DM + d]) * u[(size_t)id * DM + d];
        w[k] = PG[(size_t)tok * 128 + k] * 0.5f * a * (1.0f + erff(a * 0.70710678f)); }
    __syncthreads();
    float e = 0.f, sc = 0.f;
    for (int d = t; d < DM; d += 64) { float o = 0.f; for (int k = 0; k < 128; ++k) o += w[k] * v[(size_t)(PIDX[(size_t)tok * 128 + k] & 16383) * DM + d];
        e = fmaxf(e, fabsf(o - dbgo[(size_t)tok * DM + d])); sc = fmaxf(sc, fabsf(o)); }
    for (int o_ = 32; o_ >= 1; o_ >>= 1) { e = fmaxf(e, __shfl_xor(e, o_)); sc = fmaxf(sc, __shfl_xor(sc, o_)); }
    if (t == 0) dbg_report(slot, e / (sc + 1e-6f));
}
__global__ void k_dbg_out2(const float* x, const float* fg, float* out, const unsigned* slot) {
    const float mx = __uint_as_float(*slot); float v = 0.25f * (log10f(fmaxf(mx, 1e-30f)) + 4.0f); v = fminf(fmaxf(v, 0.f), 9.f);
    const float f = 1.0f + v;
    const int lane = threadIdx.x & 63; const size_t r = (size_t)blockIdx.x * 4 + (threadIdx.x >> 6);
    const float* xr = x + r * DM; float ss = 0.f;
    for (int c = lane; c < DM; c += 64) ss += xr[c] * xr[c];
    ss = wave_sum(ss); const float rs = rsqrtf(ss / DM + NORM_EPS);
    for (int c = lane; c < DM; c += 64) out[r * DM + c] = xr[c] * rs * fg[c] * f;
}
#endif
#ifdef DBG_SCAN
__global__ void k_scan16(const bf16_t* p, size_t n, unsigned* flags, int stage) {
    unsigned bad = 0; for (size_t i = (size_t)blockIdx.x * blockDim.x + threadIdx.x; i < n; i += (size_t)gridDim.x * blockDim.x) bad |= ((p[i] & 0x7f80u) == 0x7f80u);
    if (bad) atomicOr(&flags[stage], 1u);
}
__global__ void k_scan32(const float* p, size_t n, unsigned* flags, int stage) {
    unsigned bad = 0; for (size_t i = (size_t)blockIdx.x * blockDim.x + threadIdx.x; i < n; i += (size_t)gridDim.x * blockDim.x) bad |= ((__float_as_uint(p[i]) & 0x7f800000u) == 0x7f800000u);
    if (bad) atomicOr(&flags[stage], 1u);
}
__global__ void k_dbg_out(const float* x, const float* fg, float* out, const unsigned* flags, int nstage) {
    int code = 0; for (int s = nstage; s >= 1; --s) if (flags[s]) code = s;
    const float f = 1.0f + 0.25f * (float)code;
    const int lane = threadIdx.x & 63; const size_t r = (size_t)blockIdx.x * 4 + (threadIdx.x >> 6);
    const float* xr = x + r * DM; float ss = 0.f;
    for (int c = lane; c < DM; c += 64) ss += xr[c] * xr[c];
    ss = wave_sum(ss); const float rs = rsqrtf(ss / DM + NORM_EPS);
    for (int c = lane; c < DM; c += 64) out[r * DM + c] = xr[c] * rs * fg[c] * f;
}
#endif
extern "C" void kernel_launch(void* const* d_in, const int* in_sizes, int n_in, void* d_out, int out_size, void* d_ws, size_t ws_size, hipStream_t stream) {
    static int grid = 0;
    if (grid == 0) {
        if (n_in != 30 || out_size != NBATCH * SEQ * DM || ws_size < WS_END) { fprintf(stderr, "kernel_launch: shape/workspace mismatch: n_in %d out %d ws %zu (need %zu)\n", n_in, out_size, ws_size, (size_t)WS_END); grid = -1; return; }
        int dev = 0, cus = 0, per_cu = 0;
        if (hipGetDevice(&dev) != hipSuccess || hipDeviceGetAttribute(&cus, hipDeviceAttributeMultiprocessorCount, dev) != hipSuccess) { grid = -1; return; }
        bool okattr = hipFuncSetAttribute((const void*)MAIN_KERNEL, hipFuncAttributeMaxDynamicSharedMemorySize, LDS_BYTES) == hipSuccess;
#if MK_N_LAUNCHES != 1
#define SETA(K) okattr = okattr && hipFuncSetAttribute((const void*)k_one<K>, hipFuncAttributeMaxDynamicSharedMemorySize, LDS_BYTES) == hipSuccess
        SETA(0); SETA(1); SETA(2); SETA(3); SETA(4); SETA(5); SETA(6); SETA(7); SETA(8); SETA(9); SETA(10); SETA(11); SETA(12);
#undef SETA
#endif
        if (!okattr) { fprintf(stderr, "kernel_launch: hipFuncSetAttribute failed\n"); grid = -1; return; }
        if (hipOccupancyMaxActiveBlocksPerMultiprocessor(&per_cu, (const void*)MAIN_KERNEL, NTHREADS, LDS_BYTES) != hipSuccess || per_cu < 1) { fprintf(stderr, "kernel_launch: occupancy query says %d blocks per CU\n", per_cu); grid = -1; (void)hipGetLastError(); return; }
        grid = cus;
    }
    if (grid < 0) return;
    if (hipMemsetAsync((char*)d_ws + WS_CTL, 0, CTL_BYTES, stream) != hipSuccess) return;
    Args a{};
    for (int i = 0; i < 30; ++i) a.in[i] = (const float*)d_in[i];
    a.out = (float*)d_out; a.ws = (unsigned char*)d_ws;
#if MK_N_LAUNCHES == 1
    a.ph_lo = 0; a.ph_hi = N_PHASES;
    hipLaunchKernelGGL(mk_fwd, dim3(grid), dim3(NTHREADS), LDS_BYTES, stream, a);
#else
    a.ph_hi = 0;
#ifndef DBG_NLAUNCH
#define DBG_NLAUNCH 100
#endif
    int nl_ = 0;
#define LAUNCH1(K, L) do { a.ph_lo = (L); if (nl_++ < DBG_NLAUNCH) hipLaunchKernelGGL(k_one<K>, dim3(grid), dim3(NTHREADS), LDS_BYTES, stream, a); } while (0)
#ifdef DBG_SCAN
    unsigned* flags = (unsigned*)((char*)d_ws + WS_CTL + 32768);
    char* W = (char*)d_ws;
#define S16(off, n, st) hipLaunchKernelGGL(k_scan16, dim3(1024), dim3(256), 0, stream, (const bf16_t*)(W + (off)), (size_t)(n), flags, st)
#define S32(off, n, st) hipLaunchKernelGGL(k_scan32, dim3(1024), dim3(256), 0, stream, (const float*)(W + (off)), (size_t)(n), flags, st)
    LAUNCH1(0, 0); S32(WS_MODV, 2 * 3 * 12288, 1);
    { const int l = 0;
      LAUNCH1(1, l); S16(WS_HB, (size_t)TT * DM, 2);
      LAUNCH1(2, l); S16(WS_P, (size_t)TT * NP, 3);
      LAUNCH1(3, l); S16(WS_P, (size_t)TT * NP, 4);
      LAUNCH1(4, l); S16(WS_MQ, (size_t)TT * 1536, 5); S16(WS_MKV, (size_t)TT * 2048, 5); S16(WS_GST, (size_t)2112 * 32768, 6); S32(WS_GDEC, (size_t)2112 * 128, 6);
      LAUNCH1(5, l); S16(WS_GST, (size_t)2112 * 32768, 7);
      LAUNCH1(6, l); S16(WS_OA, (size_t)TT * 1024, 8); S16(WS_OM, (size_t)TT * 1024, 9); S16(WS_OL, (size_t)TT * 1024, 10);
      LAUNCH1(7, l); S16(WS_Y, (size_t)TT * DM, 11);
      LAUNCH1(8, l); S32(WS_XS, (size_t)TT * DM, 12);
      LAUNCH1(9, l); S16(WS_HB, (size_t)TT * DM, 13);
      LAUNCH1(10, l); S16(WS_PQ, (size_t)TT * DM, 14);
      LAUNCH1(11, l); S32(WS_PG, (size_t)TT * 128, 15);
      LAUNCH1(12, l); S32(WS_XS, (size_t)TT * DM, 16);
    }
    hipLaunchKernelGGL(k_dbg_out, dim3(NBATCH * SEQ / 4), dim3(256), 0, stream, (const float*)d_in[0], (const float*)d_in[29], (float*)d_out, flags, 16);
#elif defined(DBG_CHECK)
    unsigned* flags = (unsigned*)((char*)d_ws + WS_CTL + 32768);
    char* W = (char*)d_ws;
    LAUNCH1(0, 0);
    { const int l = 0; LAUNCH1(1, l); LAUNCH1(2, l); LAUNCH1(3, l); LAUNCH1(4, l); LAUNCH1(5, l); LAUNCH1(6, l); LAUNCH1(7, l); LAUNCH1(8, l); LAUNCH1(9, l); LAUNCH1(10, l);
#if DBG_CHECK == 1
      hipLaunchKernelGGL(k_check_gemm, dim3(32), dim3(256), 0, stream, (const bf16_t*)(W + WS_HB), DM, (const float*)d_in[I_PWQ], DM, DM, (const bf16_t*)(W + WS_PQ), DM, TT, flags + 100);
#endif
      LAUNCH1(11, l);
#if DBG_CHECK == 2
      hipLaunchKernelGGL(k_check_select, dim3(256 * 8), dim3(64), 0, stream, (const bf16_t*)(W + WS_PQ), (const float*)d_in[I_PK1], (const float*)d_in[I_PK2], (const int*)(W + WS_PIDX), (const float*)(W + WS_PG), flags + 100);
#endif
      LAUNCH1(12, l);
#if DBG_CHECK == 3
      hipLaunchKernelGGL(k_check_gather, dim3(128), dim3(64), 0, stream, (const bf16_t*)(W + WS_HB), (const float*)d_in[I_PU], (const float*)d_in[I_PV], (const int*)(W + WS_PIDX), (const float*)(W + WS_PG), (const float*)(W + WS_MQ), flags + 100);
#endif
    }
    hipLaunchKernelGGL(k_dbg_out2, dim3(NBATCH * SEQ / 4), dim3(256), 0, stream, (const float*)d_in[0], (const float*)d_in[29], (float*)d_out, flags + 100);
#else
    LAUNCH1(0, 0);
    for (int l = 0; l < DEPTH; ++l) { LAUNCH1(1, l); LAUNCH1(2, l); LAUNCH1(3, l); LAUNCH1(4, l); LAUNCH1(5, l); LAUNCH1(6, l); LAUNCH1(7, l); LAUNCH1(8, l); LAUNCH1(9, l); LAUNCH1(10, l); LAUNCH1(11, l); LAUNCH1(12, l); }
#endif
#undef LAUNCH1
#endif
    const hipError_t le = hipPeekAtLastError();
    if (le != hipSuccess) fprintf(stderr, "kernel_launch: launch failed: %s\n", hipGetErrorName(le));
}
```

```cpp
#include <hip/hip_runtime.h>
#include <cstdio>
#include <cstdint>

#ifndef MK_N_LAUNCHES
#ifndef DBG_DUP
#define DBG_DUP -1
#endif
#define MK_N_LAUNCHES 1
#endif

#ifndef DBG_MIX0
#define DBG_MIX0 1.0f
#define DBG_MIX1 1.0f
#define DBG_PEER0 1.0f
#define DBG_PEER1 1.0f
#endif
#define LAS __attribute__((address_space(3)))
typedef unsigned short bf16_t;
typedef short bf16x8 __attribute__((ext_vector_type(8)));
typedef short s16x4 __attribute__((ext_vector_type(4)));
typedef float f32x4 __attribute__((ext_vector_type(4)));
typedef float f32x2 __attribute__((ext_vector_type(2)));
typedef float f32x16 __attribute__((ext_vector_type(16)));
typedef unsigned u32x4 __attribute__((ext_vector_type(4)));
typedef unsigned u32x2 __attribute__((ext_vector_type(2)));
typedef __bf16 bf2_t __attribute__((ext_vector_type(2)));

constexpr int DM = 2048, NBATCH = 2, SEQ = 8192, CTXL = 256, DEPTH = 2;
constexpr int RPB = SEQ + CTXL;
constexpr int TT = NBATCH * RPB;
constexpr int IN_COLS = 11872, NP = 12032;
constexpr int C_AQ = 0, C_AK = 1024, C_AV = 1280, C_LQ = 1536, C_LK = 2048, C_LV = 2560, C_LG = 3584, C_LRF = 4608, C_LRB = 4624,
              C_MCQ = 4640, C_MCKV = 5152, C_MKR = 5664, C_GA = 5728, C_GL = 7776, C_GM = 9824;
constexpr int NCH = RPB / 64;
constexpr int NEXP = 16384;
constexpr float NORM_EPS = 1e-6f;
constexpr int NTHREADS = 512;

constexpr size_t al256(size_t x) { return (x + 255) / 256 * 256; }
constexpr size_t WS_CTL   = 0;
constexpr size_t CTL_BYTES = 65536;
constexpr size_t WS_MODV  = WS_CTL + CTL_BYTES;
constexpr size_t WS_TABA  = al256(WS_MODV + (size_t)2 * 3 * 12288 * 4);
constexpr size_t WS_TABM  = WS_TABA + 2 * 128 * 32 * 4;
constexpr size_t WS_XS    = al256(WS_TABM + 2 * 128 * 16 * 4);
constexpr size_t WS_HB    = WS_XS + (size_t)TT * DM * 4;
constexpr size_t WS_P     = WS_HB + (size_t)TT * DM * 2;
constexpr size_t WS_MQ    = WS_P + (size_t)TT * NP * 2;
constexpr size_t WS_MKV   = WS_MQ + (size_t)TT * 1536 * 2;
constexpr size_t WS_OA    = WS_MKV + (size_t)TT * 2048 * 2;
constexpr size_t WS_OL    = WS_OA + (size_t)TT * 1024 * 2;
constexpr size_t WS_OM    = WS_OL + (size_t)TT * 1024 * 2;
constexpr size_t WS_WIN   = WS_OM + (size_t)TT * 1024 * 2;
constexpr size_t WS_WUQ   = WS_WIN + (size_t)NP * 2048 * 2;
constexpr size_t WS_WUKV  = WS_WUQ + (size_t)1536 * 512 * 2;
constexpr size_t WS_WBR   = WS_WUKV + (size_t)2048 * 512 * 2;
constexpr size_t WS_WOUT  = WS_WBR + (size_t)3 * 2048 * 1024 * 2;
constexpr size_t WS_WQ    = WS_WOUT + (size_t)2048 * 2048 * 2;
constexpr size_t WS_K1    = WS_WQ + (size_t)2048 * 2048 * 2;
constexpr size_t WS_K2    = WS_K1 + (size_t)8 * 128 * 128 * 2;
constexpr size_t WS_GST   = WS_K2 + (size_t)8 * 128 * 128 * 2;
constexpr size_t WS_GDEC  = WS_GST + (size_t)NBATCH * 2 * 4 * NCH * 32768 * 2;
constexpr size_t WS_END   = WS_GDEC + (size_t)NBATCH * 2 * 4 * NCH * 128 * 4;
constexpr size_t WS_Y     = WS_MKV;
constexpr size_t WS_PQ    = WS_OA;
constexpr size_t WS_U8    = WS_P;
constexpr size_t WS_V8    = WS_U8 + (size_t)NEXP * DM;
constexpr size_t WS_SCU   = WS_V8 + (size_t)NEXP * DM;
constexpr size_t WS_SCV   = WS_SCU + (size_t)NEXP * 4;
constexpr size_t WS_PIDX  = WS_SCV + (size_t)NEXP * 4;
constexpr size_t WS_PG    = WS_PIDX + (size_t)TT * 128 * 4;
static_assert(WS_PG + (size_t)TT * 128 * 4 <= WS_MQ, "PEER alias region overflows P");

__device__ __forceinline__ unsigned cvt_pk_bf16(float lo, float hi) { bf2_t v; v.x = (__bf16)lo; v.y = (__bf16)hi; return __builtin_bit_cast(unsigned, v); }
__device__ __forceinline__ bf16_t f2bf(float f) { return (bf16_t)(cvt_pk_bf16(f, 0.f) & 0xffffu); }
__device__ __forceinline__ float bf2f(bf16_t b) { return __uint_as_float(((unsigned)b) << 16); }
__device__ __forceinline__ float bflo(unsigned w) { return __uint_as_float(w << 16); }
__device__ __forceinline__ float bfhi(unsigned w) { return __uint_as_float(w & 0xffff0000u); }
__device__ __forceinline__ float wave_sum(float v) {
#pragma unroll
    for (int o = 32; o >= 1; o >>= 1) v += __shfl_xor(v, o);
    return v;
}
__device__ __forceinline__ float sigmoidf_(float x) { return 1.0f / (1.0f + __expf(-x)); }
__device__ __forceinline__ float siluf_(float x) { return x / (1.0f + __expf(-x)); }

#define XB_TMO      128
#define XB_XCNT(j)  (256  + 64 * (j))
#define XB_XSUB(j)  (1280 + 64 * (j))
#define XB_XGEN(j)  (2304 + 64 * (j))
#define XB_TOP      3328
#define XB_TOPGEN   3392
#define XCD_BAR_WORDS 3456
#define XB_SPIN_CAP (1u << 20)
__device__ __forceinline__ unsigned xb_ld(unsigned* p)              { return __hip_atomic_load(p, __ATOMIC_RELAXED, __HIP_MEMORY_SCOPE_AGENT); }
__device__ __forceinline__ unsigned xb_add(unsigned* p, unsigned v) { return __hip_atomic_fetch_add(p, v, __ATOMIC_RELAXED, __HIP_MEMORY_SCOPE_AGENT); }
__device__ __forceinline__ unsigned xb_xcc_id() { return (unsigned)__builtin_amdgcn_s_getreg((3 << 11) | 20) & 0xFu; }
#define XB_SPIN(cond, bar) do { unsigned _sp = 0; while (cond) { __builtin_amdgcn_s_sleep(1); \
    if ((++_sp & 255u) == 0u) { if (xb_ld(&(bar)[XB_TMO])) break; if (_sp > XB_SPIN_CAP) { atomicAdd(&(bar)[XB_TMO], 1u); break; } } } } while (0)
struct XcdBarrier { unsigned* bar; unsigned x; volatile LAS unsigned* st; };
__device__ __forceinline__ XcdBarrier xcd_barrier_post(unsigned* bar, volatile LAS unsigned* st) {
    XcdBarrier b; b.bar = bar; b.x = xb_xcc_id(); b.st = st;
    if (threadIdx.x == 0) (void)xb_add(&bar[XB_XCNT(b.x)], 1u);
    return b;
}
__device__ __forceinline__ void xcd_barrier_complete(unsigned* bar, unsigned x, unsigned& nloc, unsigned& nx) {
    const unsigned G = gridDim.x * gridDim.y * gridDim.z;
    unsigned sum, cnt, mine, sp = 0u;
    for (;;) {
        sum = 0u; cnt = 0u; mine = 0u;
#pragma unroll
        for (unsigned j = 0; j < 16; ++j) { const unsigned c = xb_ld(&bar[XB_XCNT(j)]); sum += c; cnt += (c > 0u) ? 1u : 0u; mine = (j == x) ? c : mine; }
        if (sum == G) break;
        __builtin_amdgcn_s_sleep(1);
        if ((++sp & 255u) == 0u) { if (xb_ld(&bar[XB_TMO])) break; if (sp > XB_SPIN_CAP) { atomicAdd(&bar[XB_TMO], 1u); break; } }
    }
    nloc = mine > 0u ? mine : 1u; nx = cnt > 0u ? cnt : 1u;
}
__device__ __forceinline__ void xcd_barrier(const XcdBarrier& b) {
    asm volatile("s_waitcnt vmcnt(0)" ::: "memory");
    __syncthreads();
    if (threadIdx.x == 0) {
        unsigned* bar = b.bar;
        __builtin_amdgcn_s_waitcnt(0);
        unsigned nloc = b.st[0], nx = b.st[1];
        if (nloc == 0u) { xcd_barrier_complete(bar, b.x, nloc, nx); b.st[0] = nloc; b.st[1] = nx; }
        const unsigned old = xb_add(&bar[XB_XSUB(b.x)], 1u);
        const unsigned gen = old / nloc;
        if (old + 1u == (gen + 1u) * nloc) {
            __builtin_amdgcn_fence(__ATOMIC_RELEASE, "agent");
            asm volatile("s_waitcnt vmcnt(0)" ::: "memory");
            const unsigned og = xb_add(&bar[XB_TOP], 1u);
            const unsigned tg = og / nx;
            if (og + 1u == (tg + 1u) * nx) xb_add(&bar[XB_TOPGEN], 1u);
            else XB_SPIN(xb_ld(&bar[XB_TOPGEN]) == tg, bar);
            __builtin_amdgcn_fence(__ATOMIC_ACQUIRE, "agent");
            xb_add(&bar[XB_XGEN(b.x)], 1u);
            asm volatile("s_waitcnt vmcnt(0)" ::: "memory");
        } else {
            XB_SPIN(xb_ld(&bar[XB_XGEN(b.x)]) == gen, bar);
            __builtin_amdgcn_fence(__ATOMIC_ACQUIRE, "agent");
            asm volatile("s_waitcnt vmcnt(0)" ::: "memory");
        }
    }
    __syncthreads();
}

namespace pg8 {
constexpr int BM = 256, BK = 64, HALF = 128, HTB = HALF * BK * 2, STAGE_BYTES = 8 * HTB, NXCD = 8, WGM = 8;
__host__ __device__ __forceinline__ int lds_byte(int r, int c) { const int st = (r >> 4) * 2 + (c >> 5), rr = r & 15, cc = c & 31, ob = rr * 64 + cc * 2; return st * 1024 + (ob ^ (((ob >> 9) & 1) << 5)); }
__host__ __device__ __forceinline__ void stage_rc(int b, int& R, int& C) { const int st = b / 1024, sb = b % 1024, swz = sb ^ (((sb >> 9) & 1) << 5); R = (st >> 1) * 16 + swz / 64; C = (st & 1) * 32 + (swz % 64) / 2; }
__host__ __device__ __forceinline__ int perm32(int rho) { const int n = rho >> 4, i = rho & 15; return 8 * (i >> 2) + 4 * n + (i & 3); }
struct Unit { int pm, pn; };
struct Gemm { const bf16_t* A; const bf16_t* Bt; int M, N, K, lda, ldb; };
struct StaticOrder {
    int nM, nN, nwg, G, c;
    __host__ __device__ void init(int M, int N, int G_, int c_) { nM = M / BM; nN = N / BM; nwg = nM * nN; G = G_; c = c_; }
    __host__ __device__ bool next(int i, Unit& u) const {
        const long L = (long)i * G + c; if (L >= nwg) return false;
        int wgid = (int)L; { const int q = nwg / NXCD, r = nwg % NXCD, xcd = wgid % NXCD, off = wgid / NXCD; wgid = (xcd < r ? xcd * (q + 1) : r * (q + 1) + (xcd - r) * q) + off; }
        const int nig = WGM * nN, gid = wgid / nig, fm = gid * WGM, gsz = (nM - fm) < WGM ? (nM - fm) : WGM;
        u.pm = fm + ((wgid % nig) % gsz); u.pn = (wgid % nig) / gsz; return true;
    }
};
struct EpiStoreBf16 {
    static constexpr bool PERM = true;
    bf16_t* O; int ldc;
    __device__ __forceinline__ void operator()(const f32x4 (&acc)[2][2][4][2], const Unit& u, int wr, int wc, int fr, int fq) const {
        const int row0 = u.pm * BM + wr * 64 + fr, col0 = u.pn * BM + wc * 32 + 8 * fq;
#pragma unroll
        for (int ai = 0; ai < 2; ++ai)
#pragma unroll
            for (int m = 0; m < 4; ++m) { bf16_t* rowp = O + (size_t)(row0 + ai * HALF + m * 16) * ldc + col0;
#pragma unroll
                for (int bj = 0; bj < 2; ++bj) { const f32x4 v0 = acc[ai][bj][m][0], v1 = acc[ai][bj][m][1];
                    u32x4 w; w.x = cvt_pk_bf16(v0[0], v0[1]); w.y = cvt_pk_bf16(v0[2], v0[3]); w.z = cvt_pk_bf16(v1[0], v1[1]); w.w = cvt_pk_bf16(v1[2], v1[3]);
                    *(u32x4*)(rowp + bj * HALF) = w; } }
    }
};
template <bool FIRST> struct EpiGate {
    static constexpr bool PERM = true;
    bf16_t* Y; int ldy; const bf16_t* Gt; int ldg;
    __device__ __forceinline__ void operator()(const f32x4 (&acc)[2][2][4][2], const Unit& u, int wr, int wc, int fr, int fq) const {
        const int row0 = u.pm * BM + wr * 64 + fr, col0 = u.pn * BM + wc * 32 + 8 * fq;
#pragma unroll
        for (int ai = 0; ai < 2; ++ai)
#pragma unroll
            for (int m = 0; m < 4; ++m) { const size_t r = (size_t)(row0 + ai * HALF + m * 16);
#pragma unroll
                for (int bj = 0; bj < 2; ++bj) { const f32x4 v0 = acc[ai][bj][m][0], v1 = acc[ai][bj][m][1];
                    const u32x4 g = *(const u32x4*)(Gt + r * ldg + col0 + bj * HALF);
                    float o[8];
                    o[0] = sigmoidf_(bflo(g.x)) * v0[0]; o[1] = sigmoidf_(bfhi(g.x)) * v0[1]; o[2] = sigmoidf_(bflo(g.y)) * v0[2]; o[3] = sigmoidf_(bfhi(g.y)) * v0[3];
                    o[4] = sigmoidf_(bflo(g.z)) * v1[0]; o[5] = sigmoidf_(bfhi(g.z)) * v1[1]; o[6] = sigmoidf_(bflo(g.w)) * v1[2]; o[7] = sigmoidf_(bfhi(g.w)) * v1[3];
                    bf16_t* yp = Y + r * ldy + col0 + bj * HALF;
                    if (!FIRST) { const u32x4 y = *(const u32x4*)yp;
                        o[0] += bflo(y.x); o[1] += bfhi(y.x); o[2] += bflo(y.y); o[3] += bfhi(y.y); o[4] += bflo(y.z); o[5] += bfhi(y.z); o[6] += bflo(y.w); o[7] += bfhi(y.w); }
                    u32x4 w; w.x = cvt_pk_bf16(o[0], o[1]); w.y = cvt_pk_bf16(o[2], o[3]); w.z = cvt_pk_bf16(o[4], o[5]); w.w = cvt_pk_bf16(o[6], o[7]);
                    *(u32x4*)yp = w; } }
    }
};
struct EpiResid {
    static constexpr bool PERM = false;
    float* X; int ldx; const float* gate; float gscale;
    __device__ __forceinline__ void operator()(const f32x4 (&acc)[2][2][4][2], const Unit& u, int wr, int wc, int fr, int fq) const {
        const int row0 = u.pm * BM + wr * 64 + fr, col0 = u.pn * BM + wc * 32 + 4 * fq;
        const int sel = (u.pm % 33 == 0) ? 2 : (u.pm / 33);
        const float* gp = gate + (size_t)sel * 12288 + col0;
        f32x4 gv[2][2];
#pragma unroll
        for (int bj = 0; bj < 2; ++bj)
#pragma unroll
            for (int n = 0; n < 2; ++n) gv[bj][n] = *(const f32x4*)(gp + bj * HALF + n * 16) * gscale;
#pragma unroll
        for (int ai = 0; ai < 2; ++ai)
#pragma unroll
            for (int m = 0; m < 4; ++m) { float* rowp = X + (size_t)(row0 + ai * HALF + m * 16) * ldx + col0;
#pragma unroll
                for (int bj = 0; bj < 2; ++bj)
#pragma unroll
                    for (int n = 0; n < 2; ++n) { f32x4* p = (f32x4*)(rowp + bj * HALF + n * 16); *p = *p + gv[bj][n] * acc[ai][bj][m][n]; } }
    }
};

template <class Epi, class Sched>
__device__ __forceinline__ void gemm_phase(LAS unsigned char* lds, const int tid, const Gemm g, const Sched& S, const Epi& E) {
    const int wid = __builtin_amdgcn_readfirstlane(tid >> 6), lane = tid & 63, wr = wid >> 2, wc = wid & 3, fr = lane & 15, fq = lane >> 4;
    const int K = g.K, nt = K / BK, lda = g.lda, ldb = g.ldb;
    unsigned voffA[2], voffB[2];
#pragma unroll
    for (int i = 0; i < 2; ++i) { int R, C; stage_rc(tid * 16 + i * 8192, R, C); const int Rb = Epi::PERM ? ((R & ~31) + perm32(R & 31)) : R;
        voffA[i] = (unsigned)(R * lda + C) * 2u; voffB[i] = (unsigned)(Rb * ldb + C) * 2u; }
    const size_t kstep = (size_t)(BK * 2);
    const size_t hstepA = (size_t)HALF * lda * 2, hstepB = (size_t)HALF * ldb * 2;
    const size_t tstepA = 2 * hstepA, tstepB = 2 * hstepB;
    const unsigned ldsw = (unsigned)wid * 1024u;
    const int aoff = lds_byte(wr * 64 + fr, fq * 8), boff = lds_byte(wc * 32 + fr, fq * 8);
#define PG8_SA(b, h) (((b) * 2 + (h)) * HTB)
#define PG8_SB(b, h) ((4 + (b) * 2 + (h)) * HTB)
#define PG8_STAGE(bufoff, gbase, voff) do { _Pragma("unroll") for (int _i = 0; _i < 2; ++_i) \
        __builtin_amdgcn_global_load_lds((const unsigned*)((const char*)(gbase) + (voff)[_i]), (LAS unsigned*)(lds + (bufoff) + ldsw + _i * 8192), 16, 0, 0); } while (0)
#define PG8_LDA(dst, b, h) do { _Pragma("unroll") for (int m = 0; m < 4; ++m) _Pragma("unroll") for (int k = 0; k < 2; ++k) dst[m][k] = *(const LAS bf16x8*)(lds + PG8_SA(b, h) + aoff + m * 2048 + k * 1024); } while (0)
#define PG8_LDB(dst, b, h) do { _Pragma("unroll") for (int n = 0; n < 2; ++n) _Pragma("unroll") for (int k = 0; k < 2; ++k) dst[n][k] = *(const LAS bf16x8*)(lds + PG8_SB(b, h) + boff + n * 2048 + k * 1024); } while (0)
#define PG8_MMA(ai, bj, At, Bt) do { __builtin_amdgcn_s_setprio(1); _Pragma("unroll") for (int m = 0; m < 4; ++m) _Pragma("unroll") for (int n = 0; n < 2; ++n) _Pragma("unroll") for (int k = 0; k < 2; ++k) \
        acc[ai][bj][m][n] = __builtin_amdgcn_mfma_f32_16x16x32_bf16(Bt[n][k], At[m][k], acc[ai][bj][m][n], 0, 0, 0); __builtin_amdgcn_s_setprio(0); } while (0)
#define PG8_WAIT_V(n) asm volatile("s_waitcnt vmcnt(" #n ")" ::: "memory")
#define PG8_WAIT_L(n) asm volatile("s_waitcnt lgkmcnt(" #n ")" ::: "memory")
#define PG8_BAR __builtin_amdgcn_s_barrier()
#define PG8_SCHED __builtin_amdgcn_sched_barrier(0)
    Unit cur, nxt; int ui = 0;
    if (!S.next(0, cur)) return;
    f32x4 acc[2][2][4][2];
#pragma unroll
    for (int a = 0; a < 2; ++a)
#pragma unroll
        for (int b = 0; b < 2; ++b)
#pragma unroll
            for (int m = 0; m < 4; ++m)
#pragma unroll
                for (int n = 0; n < 2; ++n) acc[a][b][m][n] = (f32x4){0.f, 0.f, 0.f, 0.f};
    bf16x8 At[4][2], B0[2][2], B1[2][2];
    const char* cA = (const char*)g.A + (size_t)cur.pm * tstepA; const char* cB = (const char*)g.Bt + (size_t)cur.pn * tstepB;
    PG8_STAGE(PG8_SB(0, 0), cB, voffB); PG8_STAGE(PG8_SA(0, 0), cA, voffA); PG8_STAGE(PG8_SB(0, 1), cB + hstepB, voffB); PG8_STAGE(PG8_SA(0, 1), cA + hstepA, voffA);
    if (wr == 1) PG8_BAR;
    PG8_WAIT_V(4); PG8_BAR;
    PG8_STAGE(PG8_SB(1, 0), cB + kstep, voffB); PG8_STAGE(PG8_SA(1, 0), cA + kstep, voffA); PG8_STAGE(PG8_SB(1, 1), cB + hstepB + kstep, voffB);
    PG8_WAIT_V(6); PG8_BAR;
    for (;;) {
        const bool has_next = S.next(ui + 1, nxt);
        const char* nA = has_next ? (const char*)g.A + (size_t)nxt.pm * tstepA : cA; const char* nB = has_next ? (const char*)g.Bt + (size_t)nxt.pn * tstepB : cB;
        for (int t = 0; t < nt; t += 2) {
            const bool last = (t == nt - 2);
            const char* a1 = cA + (size_t)(t + 1) * kstep;
            const char* a2 = last ? nA : cA + (size_t)(t + 2) * kstep; const char* b2 = last ? nB : cB + (size_t)(t + 2) * kstep;
            const char* a3 = a2 + kstep; const char* b3 = b2 + kstep;
            PG8_LDB(B0, 0, 0); PG8_SCHED; PG8_LDA(At, 0, 0); PG8_STAGE(PG8_SA(1, 1), a1 + hstepA, voffA);
            PG8_WAIT_L(8); PG8_BAR; PG8_WAIT_L(0); PG8_MMA(0, 0, At, B0); PG8_BAR; PG8_SCHED;
            PG8_LDB(B1, 0, 1); PG8_STAGE(PG8_SB(0, 0), b2, voffB);
            PG8_BAR; PG8_WAIT_L(0); PG8_MMA(0, 1, At, B1); PG8_BAR;
            PG8_LDA(At, 0, 1); PG8_STAGE(PG8_SA(0, 0), a2, voffA);
            PG8_BAR; PG8_WAIT_L(0); PG8_MMA(1, 0, At, B0); PG8_BAR; PG8_SCHED;
            PG8_STAGE(PG8_SB(0, 1), b2 + hstepB, voffB);
            PG8_WAIT_V(6); PG8_BAR; PG8_MMA(1, 1, At, B1); PG8_BAR;
            PG8_LDB(B0, 1, 0); PG8_SCHED; PG8_LDA(At, 1, 0); PG8_STAGE(PG8_SA(0, 1), a2 + hstepA, voffA);
            PG8_WAIT_L(8); PG8_BAR; PG8_WAIT_L(0); PG8_MMA(0, 0, At, B0); PG8_BAR; PG8_SCHED;
            PG8_LDB(B1, 1, 1); PG8_STAGE(PG8_SB(1, 0), b3, voffB);
            PG8_BAR; PG8_WAIT_L(0); PG8_MMA(0, 1, At, B1); PG8_BAR;
            PG8_LDA(At, 1, 1); PG8_STAGE(PG8_SA(1, 0), a3, voffA);
            PG8_BAR; PG8_WAIT_L(0); PG8_MMA(1, 0, At, B0); PG8_BAR; PG8_SCHED;
            PG8_STAGE(PG8_SB(1, 1), b3 + hstepB, voffB);
            PG8_WAIT_V(6); PG8_BAR; PG8_MMA(1, 1, At, B1); PG8_BAR;
        }
        E(acc, cur, wr, wc, fr, fq);
        if (!has_next) break;
#pragma unroll
        for (int a = 0; a < 2; ++a)
#pragma unroll
            for (int b = 0; b < 2; ++b)
#pragma unroll
                for (int m = 0; m < 4; ++m)
#pragma unroll
                    for (int n = 0; n < 2; ++n) acc[a][b][m][n] = (f32x4){0.f, 0.f, 0.f, 0.f};
        cur = nxt; cA = nA; cB = nB; ++ui;
    }
    PG8_WAIT_V(0);
    if (wr == 0) PG8_BAR;
    PG8_BAR;
#undef PG8_SA
#undef PG8_SB
#undef PG8_STAGE
#undef PG8_LDA
#undef PG8_LDB
#undef PG8_MMA
#undef PG8_WAIT_V
#undef PG8_WAIT_L
#undef PG8_BAR
#undef PG8_SCHED
}
}

struct Args { const float* in[30]; float* out; unsigned char* ws; int ph_lo, ph_hi; };
enum { I_X = 0, I_C, I_CTX, I_CCTX, I_WMOD, I_BMOD, I_N1G, I_WIN, I_QNG, I_KNG, I_WA2F, I_BAF, I_WA2B, I_BAB, I_ONG, I_MQNG, I_WUQ, I_MKVNG, I_WUKV,
       I_WBRA, I_WBRL, I_WBRM, I_WOUT, I_N2G, I_PWQ, I_PK1, I_PK2, I_PU, I_PV, I_FG };
typedef const float* cfp_t;
struct Ctx {
    const __attribute__((address_space(4))) cfp_t* in; float* out; unsigned char* ws; LAS unsigned char* lds;
    int tid, lane, wid, G, bid;
};
#define WSP(T, off) ((T*)(C.ws + (off)))
#define INP(i) (C.in[(i)])
__device__ __forceinline__ unsigned long long launder_u64(unsigned long long w) {
    unsigned lo = (unsigned)w, hi = (unsigned)(w >> 32); asm volatile("" : "+v"(lo), "+v"(hi));
    lo = __builtin_amdgcn_readfirstlane(lo); hi = __builtin_amdgcn_readfirstlane(hi); return ((unsigned long long)hi << 32) | lo;
}
__device__ __forceinline__ Ctx launder(const Ctx& C0) {
    Ctx R = C0; int t = C0.tid; asm volatile("" : "+v"(t)); R.tid = t; R.lane = t & 63; R.wid = __builtin_amdgcn_readfirstlane(t >> 6);
    R.ws = (unsigned char*)launder_u64((unsigned long long)C0.ws);
    R.in = (const __attribute__((address_space(4))) cfp_t*)launder_u64((unsigned long long)C0.in);
    unsigned l = (unsigned)(uintptr_t)C0.lds; asm volatile("" : "+v"(l)); l = __builtin_amdgcn_readfirstlane(l); R.lds = (LAS unsigned char*)(uintptr_t)l;
    return R;
}

__device__ __forceinline__ const float* src_row(const Ctx& C, int r) {
    const int b = r / RPB, j = r % RPB;
    return j < CTXL ? INP(I_CTX) + ((size_t)b * CTXL + j) * DM : INP(I_X) + ((size_t)b * SEQ + (j - CTXL)) * DM;
}
__device__ __forceinline__ int mod_sel(int r) { const int b = r / RPB, j = r % RPB; return j < CTXL ? 2 : b; }

__device__ __forceinline__ void phase_modv(const Ctx& C) {
    LAS float* sc = (LAS float*)C.lds;
    LAS float* red = (LAS float*)(C.lds + 3 * 2048 * 4);
    for (int i = C.tid; i < 3 * DM; i += NTHREADS) { const int r = i / DM, k = i % DM; const float v = r < 2 ? INP(I_C)[r * DM + k] : INP(I_CCTX)[k]; sc[i] = siluf_(v); }
    __syncthreads();
    float* modv = WSP(float, WS_MODV);
    const int kq = C.tid / 12, c4 = C.tid % 12;
    for (int item = C.bid; item < 2 * 256; item += C.G) {
        const int l = item / 256, cg = item % 256;
        float acc[3][4];
#pragma unroll
        for (int r = 0; r < 3; ++r)
#pragma unroll
            for (int j = 0; j < 4; ++j) acc[r][j] = 0.f;
        if (kq < 42) {
            const float* wp = INP(I_WMOD) + (size_t)l * DM * 12288 + 48 * cg + 4 * c4;
            for (int k = kq; k < DM; k += 42) {
                const f32x4 w = *(const f32x4*)(wp + (size_t)k * 12288);
#pragma unroll
                for (int r = 0; r < 3; ++r) { const float s = sc[r * DM + k];
#pragma unroll
                    for (int j = 0; j < 4; ++j) acc[r][j] += s * w[j]; }
            }
#pragma unroll
            for (int r = 0; r < 3; ++r)
#pragma unroll
                for (int j = 0; j < 4; ++j) red[kq * 144 + r * 48 + c4 * 4 + j] = acc[r][j];
        }
        __syncthreads();
        if (C.tid < 144) { float s = 0.f; for (int q = 0; q < 42; ++q) s += red[q * 144 + C.tid];
            const int r = C.tid / 48, cc = C.tid % 48;
            modv[((size_t)l * 3 + r) * 12288 + 48 * cg + cc] = s + INP(I_BMOD)[(size_t)l * 12288 + 48 * cg + cc]; }
        __syncthreads();
    }
}
__device__ __forceinline__ void phase_tables(const Ctx& C) {
    float* ta = WSP(float, WS_TABA); float* tm = WSP(float, WS_TABM);
    for (int i = C.bid * NTHREADS + C.tid; i < 128 * 32 + 128 * 16; i += C.G * NTHREADS) {
        if (i < 128 * 32) { const int pos = i / 32, f = i % 32; const float inv = exp2f(-(float)f * (13.287712379549449f / 32.0f)); const float a = (float)pos * inv;
            ta[i] = cosf(a); ta[128 * 32 + i] = sinf(a); }
        else { const int k = i - 128 * 32, pos = k / 16, f = k % 16; const float inv = exp2f(-(float)f * (13.287712379549449f / 16.0f)); const float a = (float)pos * inv;
            tm[k] = cosf(a); tm[128 * 16 + k] = sinf(a); }
    }
}
__device__ __forceinline__ void transpose_cvt(const Ctx& C, const float* src, int K, int N, bf16_t* dst, int Npad, int& item) {
    LAS float* tile = (LAS float*)C.lds;
    const int tk = K / 64, tn = Npad / 64, ntile = tk * tn;
    const int t0 = ((C.bid - item % C.G) + C.G) % C.G; item += ntile;
    for (int t = t0; t < ntile; t += C.G) {
        const int k0 = (t / tn) * 64, n0 = (t % tn) * 64;
#pragma unroll
        for (int p = 0; p < 2; ++p) { const int kk = (C.tid >> 4) + p * 32, nn = (C.tid & 15) * 4;
            f32x4 v = (f32x4){0.f, 0.f, 0.f, 0.f};
            if (n0 + nn < N) v = *(const f32x4*)(src + (size_t)(k0 + kk) * N + n0 + nn);
#pragma unroll
            for (int j = 0; j < 4; ++j) tile[kk * 65 + nn + j] = v[j]; }
        __syncthreads();
        { const int n = C.tid >> 3, k8 = (C.tid & 7) * 8; float v[8];
#pragma unroll
          for (int j = 0; j < 8; ++j) v[j] = tile[(k8 + j) * 65 + n];
          u32x4 w; w.x = cvt_pk_bf16(v[0], v[1]); w.y = cvt_pk_bf16(v[2], v[3]); w.z = cvt_pk_bf16(v[4], v[5]); w.w = cvt_pk_bf16(v[6], v[7]);
          *(u32x4*)(dst + (size_t)(n0 + n) * K + k0 + k8) = w; }
        __syncthreads();
    }
}
__device__ __forceinline__ void cvt_plain(const Ctx& C, const float* src, bf16_t* dst, size_t n8) {
    for (size_t i = (size_t)C.bid * NTHREADS + C.tid; i < n8; i += (size_t)C.G * NTHREADS) {
        const f32x4 a = *(const f32x4*)(src + i * 8), b = *(const f32x4*)(src + i * 8 + 4);
        u32x4 w; w.x = cvt_pk_bf16(a[0], a[1]); w.y = cvt_pk_bf16(a[2], a[3]); w.z = cvt_pk_bf16(b[0], b[1]); w.w = cvt_pk_bf16(b[2], b[3]);
        *(u32x4*)(dst + i * 8) = w;
    }
}
__device__ __forceinline__ void phase_cvt_mixer_weights(const Ctx& C, int l) {
    int item = 0;
    transpose_cvt(C, INP(I_WIN) + (size_t)l * DM * IN_COLS, DM, IN_COLS, WSP(bf16_t, WS_WIN), NP, item);
    transpose_cvt(C, INP(I_WUQ) + (size_t)l * 512 * 1536, 512, 1536, WSP(bf16_t, WS_WUQ), 1536, item);
    transpose_cvt(C, INP(I_WUKV) + (size_t)l * 512 * 2048, 512, 2048, WSP(bf16_t, WS_WUKV), 2048, item);
    transpose_cvt(C, INP(I_WBRA) + (size_t)l * 1024 * 2048, 1024, 2048, WSP(bf16_t, WS_WBR), 2048, item);
    transpose_cvt(C, INP(I_WBRL) + (size_t)l * 1024 * 2048, 1024, 2048, WSP(bf16_t, WS_WBR) + (size_t)2048 * 1024, 2048, item);
    transpose_cvt(C, INP(I_WBRM) + (size_t)l * 1024 * 2048, 1024, 2048, WSP(bf16_t, WS_WBR) + (size_t)2 * 2048 * 1024, 2048, item);
    transpose_cvt(C, INP(I_WOUT) + (size_t)l * 2048 * 2048, 2048, 2048, WSP(bf16_t, WS_WOUT), 2048, item);
    transpose_cvt(C, INP(I_PWQ) + (size_t)l * 2048 * 2048, 2048, 2048, WSP(bf16_t, WS_WQ), 2048, item);
    cvt_plain(C, INP(I_PK1) + (size_t)l * 8 * 128 * 128, WSP(bf16_t, WS_K1), 8 * 128 * 128 / 8);
    cvt_plain(C, INP(I_PK2) + (size_t)l * 8 * 128 * 128, WSP(bf16_t, WS_K2), 8 * 128 * 128 / 8);
}
__device__ __forceinline__ void phase_cvt_peer_tables(const Ctx& C, int l) {
    const int lane = C.lane;
    for (int row = C.bid * 8 + C.wid; row < NEXP; row += C.G * 8) {
#pragma unroll 1
        for (int tb = 0; tb < 2; ++tb) {
            const float* src = (tb ? INP(I_PV) : INP(I_PU)) + ((size_t)l * NEXP + row) * DM + lane * 16;
            f32x4 x[8]; float amax = 0.f;
#pragma unroll
            for (int c = 0; c < 2; ++c)
#pragma unroll
                for (int q = 0; q < 4; ++q) { x[c * 4 + q] = *(const f32x4*)(src + c * 1024 + q * 4);
                    amax = fmaxf(amax, fmaxf(fmaxf(fabsf(x[c * 4 + q][0]), fabsf(x[c * 4 + q][1])), fmaxf(fabsf(x[c * 4 + q][2]), fabsf(x[c * 4 + q][3])))); }
#pragma unroll
            for (int o = 32; o >= 1; o >>= 1) amax = fmaxf(amax, __shfl_xor(amax, o));
            const float sc = amax > 0.f ? 224.0f / amax : 1.0f, inv = amax > 0.f ? amax * (1.0f / 224.0f) : 1.0f;
            unsigned char* dst = C.ws + (tb ? WS_V8 : WS_U8) + (size_t)row * DM + lane * 16;
#pragma unroll
            for (int c = 0; c < 2; ++c) { u32x4 w;
#pragma unroll
                for (int q = 0; q < 4; ++q) { const f32x4 v = x[c * 4 + q] * sc; int p = __builtin_amdgcn_cvt_pk_fp8_f32(v[0], v[1], 0, false); p = __builtin_amdgcn_cvt_pk_fp8_f32(v[2], v[3], p, true); w[q] = (unsigned)p; }
                *(u32x4*)(dst + c * 1024) = w; }
            if (lane == 0) WSP(float, tb ? WS_SCV : WS_SCU)[row] = inv;
        }
    }
}

template <bool FIRST> __device__ __forceinline__ void phase_norm_mod(const Ctx& C, const float* gvec, const float* modl  , int shift_off, int scale_off) {
    float* xs = WSP(float, WS_XS); bf16_t* hb = WSP(bf16_t, WS_HB);
    for (int r = C.bid * 8 + C.wid; r < TT; r += C.G * 8) {
        const float* xr = FIRST ? src_row(C, r) : xs + (size_t)r * DM;
        const float* mv = modl + (size_t)mod_sel(r) * 12288;
        f32x4 v[8]; float ss = 0.f;
#pragma unroll
        for (int c = 0; c < 4; ++c) { v[2 * c] = *(const f32x4*)(xr + c * 512 + C.lane * 8); v[2 * c + 1] = *(const f32x4*)(xr + c * 512 + C.lane * 8 + 4); }
#pragma unroll
        for (int c = 0; c < 8; ++c) ss += v[c][0] * v[c][0] + v[c][1] * v[c][1] + v[c][2] * v[c][2] + v[c][3] * v[c][3];
        ss = wave_sum(ss);
        const float rs = rsqrtf(ss * (1.0f / DM) + NORM_EPS);
#pragma unroll
        for (int c = 0; c < 4; ++c) { const int col = c * 512 + C.lane * 8;
            if (FIRST) { *(f32x4*)(xs + (size_t)r * DM + col) = v[2 * c]; *(f32x4*)(xs + (size_t)r * DM + col + 4) = v[2 * c + 1]; }
            float o[8];
#pragma unroll
            for (int h = 0; h < 2; ++h) { const f32x4 g = *(const f32x4*)(gvec + col + 4 * h), s = *(const f32x4*)(mv + scale_off + col + 4 * h), t = *(const f32x4*)(mv + shift_off + col + 4 * h);
#pragma unroll
                for (int j = 0; j < 4; ++j) o[4 * h + j] = v[2 * c + h][j] * rs * g[j] * (1.0f + s[j]) + t[j]; }
            u32x4 w; w.x = cvt_pk_bf16(o[0], o[1]); w.y = cvt_pk_bf16(o[2], o[3]); w.z = cvt_pk_bf16(o[4], o[5]); w.w = cvt_pk_bf16(o[6], o[7]);
            *(u32x4*)(hb + (size_t)r * DM + col) = w; }
    }
}

__device__ __forceinline__ void phase_post_p(const Ctx& C, int l) {
    bf16_t* P = WSP(bf16_t, WS_P); const float* ta = WSP(float, WS_TABA); const float* tm = WSP(float, WS_TABM);
    const float* qg = INP(I_QNG) + l * 128; const float* kg = INP(I_KNG) + l * 128;
    const float* mqg = INP(I_MQNG) + l * 512; const float* mkvg = INP(I_MKVNG) + l * 512;
    const int lane = C.lane;
    const float qg1 = qg[lane], qg2 = qg[lane + 64], kg1 = kg[lane], kg2 = kg[lane + 64];
    for (int r = C.bid * 8 + C.wid; r < TT; r += C.G * 8) {
        bf16_t* pr = P + (size_t)r * NP;
        const int j = r % RPB; const bool lat = j >= CTXL; const int pos = lat ? j - CTXL : 0, ri = pos >> 6, ci = pos & 63;
        float cs = 1.f, sn = 0.f;
        if (lat) { const int p = lane < 32 ? ri : ci, f = lane & 31; cs = ta[p * 32 + f]; sn = ta[128 * 32 + p * 32 + f]; }
#pragma unroll
        for (int h = 0; h < 10; ++h) {
            bf16_t* hp = pr + (h < 8 ? C_AQ + h * 128 : C_AK + (h - 8) * 128);
            const float x1 = bf2f(hp[lane]), x2 = bf2f(hp[lane + 64]);
            const float ss = wave_sum(x1 * x1 + x2 * x2);
            const float rs = rsqrtf(ss * (1.0f / 128.0f) + NORM_EPS);
            const float y1 = x1 * rs * (h < 8 ? qg1 : kg1), y2 = x2 * rs * (h < 8 ? qg2 : kg2);
            hp[lane] = f2bf(y1 * cs - y2 * sn); hp[lane + 64] = f2bf(y2 * cs + y1 * sn);
        }
#pragma unroll
        for (int s = 0; s < 2; ++s) {
            bf16_t* sp = pr + (s == 0 ? C_MCQ : C_MCKV) + lane * 8; const float* gg = (s == 0 ? mqg : mkvg) + lane * 8;
            const u32x4 w = *(const u32x4*)sp; float x[8] = {bflo(w.x), bfhi(w.x), bflo(w.y), bfhi(w.y), bflo(w.z), bfhi(w.z), bflo(w.w), bfhi(w.w)};
            float ss = 0.f;
#pragma unroll
            for (int i = 0; i < 8; ++i) ss += x[i] * x[i];
            ss = wave_sum(ss);
            const float rs = rsqrtf(ss * (1.0f / 512.0f) + NORM_EPS);
#pragma unroll
            for (int i = 0; i < 8; ++i) x[i] = x[i] * rs * gg[i];
            u32x4 o; o.x = cvt_pk_bf16(x[0], x[1]); o.y = cvt_pk_bf16(x[2], x[3]); o.z = cvt_pk_bf16(x[4], x[5]); o.w = cvt_pk_bf16(x[6], x[7]);
            *(u32x4*)sp = o;
        }
        if (lat) { bf16_t* kp = pr + C_MKR; const int i = lane & 31; const float x1 = bf2f(kp[i]), x2 = bf2f(kp[i + 32]);
            const int p = i < 16 ? ri : ci, f = i & 15; const float c2 = tm[p * 16 + f], s2 = tm[128 * 16 + p * 16 + f];
            if (lane < 32) { kp[i] = f2bf(x1 * c2 - x2 * s2); kp[i + 32] = f2bf(x2 * c2 + x1 * s2); } }
    }
}

namespace att {
constexpr int NW = 8, QBLK = 32, KVBLK = 64, DV = 128;
constexpr float THR = 8.f;
#define SBAR() __builtin_amdgcn_sched_barrier(0)
__device__ __forceinline__ int crow(int r, int hi) { return (r & 3) + 8 * (r >> 2) + 4 * hi; }
template <int DQ> struct Cf {
    static constexpr int ND0 = DQ / 16, KROWB = DQ * 2, SHM_K = KVBLK * DQ * 2, SHM_V = KVBLK * DV * 2, SHM = 2 * SHM_V + 2 * SHM_K + NW * 64 * 4;
    static constexpr float SCALE = DQ == 128 ? 0.088388347648318440f : 0.072168783648703220f;
    __device__ static __forceinline__ int kswz(int row, int colB) { return row * KROWB + (colB ^ ((row & 7) << 4)); }
};
template <int DQ> __device__ __forceinline__ void partialSM(f32x16& p0, f32x16& p1, float& m_reg, float& mn, float& alpha) {
    constexpr float SC = Cf<DQ>::SCALE, Cc = SC * 1.4426950408889634f;
    float pmax = p0[0];
#pragma unroll
    for (int r = 1; r < 16; ++r) pmax = fmaxf(pmax, p0[r]);
#pragma unroll
    for (int r = 0; r < 16; ++r) pmax = fmaxf(pmax, p1[r]);
    { auto rr = __builtin_amdgcn_permlane32_swap(__float_as_uint(pmax), __float_as_uint(pmax), false, false);
      pmax = fmaxf(__uint_as_float(rr[0]), __uint_as_float(rr[1])); }
    if (__builtin_expect(__all(pmax - m_reg <= THR / SC), 1)) { mn = m_reg; alpha = 1.f; }
    else { mn = fmaxf(m_reg, pmax); alpha = __builtin_amdgcn_exp2f((m_reg - mn) * Cc); m_reg = mn; }
    const float mnC = -mn * Cc;
#pragma unroll
    for (int r = 0; r < 16; ++r) p0[r] = fmaf(p0[r], Cc, mnC);
#pragma unroll
    for (int r = 0; r < 16; ++r) p1[r] = fmaf(p1[r], Cc, mnC);
#pragma unroll
    for (int r = 0; r < 16; ++r) p0[r] = __builtin_amdgcn_exp2f(p0[r]);
}
__device__ __forceinline__ void finishSM(f32x16& p0, f32x16& p1, float alpha, float& l_reg, bf16x8& pa0, bf16x8& pa1, bf16x8& pa2, bf16x8& pa3) {
#pragma unroll
    for (int r = 0; r < 16; ++r) p1[r] = __builtin_amdgcn_exp2f(p1[r]);
    float ps = 0;
#pragma unroll
    for (int r = 0; r < 16; ++r) ps += p0[r];
#pragma unroll
    for (int r = 0; r < 16; ++r) ps += p1[r];
    { auto rr = __builtin_amdgcn_permlane32_swap(__float_as_uint(ps), __float_as_uint(ps), false, false);
      ps = __uint_as_float(rr[0]) + __uint_as_float(rr[1]); }
    l_reg = l_reg * alpha + ps;
#define PK4(P, BASE, OUT) do { unsigned a0 = cvt_pk_bf16(P[BASE + 0], P[BASE + 1]), a1 = cvt_pk_bf16(P[BASE + 2], P[BASE + 3]);   \
    unsigned b0 = cvt_pk_bf16(P[BASE + 4], P[BASE + 5]), b1 = cvt_pk_bf16(P[BASE + 6], P[BASE + 7]);                              \
    auto r0 = __builtin_amdgcn_permlane32_swap(a0, b0, false, false); auto r1 = __builtin_amdgcn_permlane32_swap(a1, b1, false, false); \
    u32x4 w = {r0[0], r1[0], r0[1], r1[1]}; OUT = *reinterpret_cast<bf16x8*>(&w); } while (0)
    PK4(p0, 0, pa0); PK4(p0, 8, pa1); PK4(p1, 0, pa2); PK4(p1, 8, pa3);
#undef PK4
}
template <int DQ> __device__ __forceinline__ void qkt(f32x16& p0, f32x16& p1, const char* Ks, const bf16x8* qr, const char* qx, int r32, int hi) {
    p0 = f32x16{}; p1 = f32x16{};
#pragma unroll
    for (int d0 = 0; d0 < Cf<DQ>::ND0; ++d0) { const int cb = (d0 * 16 + hi * 8) * 2;
        const bf16x8 b0 = *reinterpret_cast<const bf16x8*>(Ks + Cf<DQ>::kswz(r32, cb));
        const bf16x8 b1 = *reinterpret_cast<const bf16x8*>(Ks + Cf<DQ>::kswz(32 + r32, cb));
        constexpr int NQR = DQ == 192 ? 4 : 8;
        bf16x8 q; if (d0 < NQR) q = qr[d0]; else q = *reinterpret_cast<const bf16x8*>(qx + (d0 - NQR) * 1024);
        p0 = __builtin_amdgcn_mfma_f32_32x32x16_bf16(b0, q, p0, 0, 0, 0);
        p1 = __builtin_amdgcn_mfma_f32_32x32x16_bf16(b1, q, p1, 0, 0, 0); }
}
__device__ __forceinline__ int v_st(int k, int c) { const int kk = (k & ~0xC) | ((k & 4) << 1) | ((k & 8) >> 1); return ((kk >> 3) * 4 + (c >> 5)) * 512 + ((kk & 7) * 32 + (c & 31)) * 2; }
__device__ __forceinline__ int v_rd_base(int lane) { return ((lane & 3) << 3) | (((lane >> 2) & 3) << 6) | (((lane >> 4) & 1) << 5) | (((lane >> 5) & 1) << 8); }
constexpr int v_rd_off(int d0, int ks, int half) { return d0 * 512 + ks * 4096 + half * 2048; }
template <int OFF> __device__ __forceinline__ s16x4 tr_read(int vb) {
    s16x4 r; asm volatile("ds_read_b64_tr_b16 %0, %1 offset:%2" : "=&v"(r) : "v"(vb), "i"(OFF) : "memory"); return r;
}
template <int D0> __device__ __forceinline__ void pv_one(f32x16& od, int vb, bf16x8 pa0, bf16x8 pa1, bf16x8 pa2, bf16x8 pa3) {
    const s16x4 l0 = tr_read<v_rd_off(D0, 0, 0)>(vb), h0 = tr_read<v_rd_off(D0, 0, 1)>(vb), l1 = tr_read<v_rd_off(D0, 1, 0)>(vb), h1 = tr_read<v_rd_off(D0, 1, 1)>(vb);
    const s16x4 l2 = tr_read<v_rd_off(D0, 2, 0)>(vb), h2 = tr_read<v_rd_off(D0, 2, 1)>(vb), l3 = tr_read<v_rd_off(D0, 3, 0)>(vb), h3 = tr_read<v_rd_off(D0, 3, 1)>(vb);
    asm volatile("s_waitcnt lgkmcnt(0)" ::: "memory"); SBAR();
#define PK(L, H) (bf16x8){L[0], L[1], L[2], L[3], H[0], H[1], H[2], H[3]}
    od = __builtin_amdgcn_mfma_f32_32x32x16_bf16(pa0, PK(l0, h0), od, 0, 0, 0);
    od = __builtin_amdgcn_mfma_f32_32x32x16_bf16(pa1, PK(l1, h1), od, 0, 0, 0);
    od = __builtin_amdgcn_mfma_f32_32x32x16_bf16(pa2, PK(l2, h2), od, 0, 0, 0);
    od = __builtin_amdgcn_mfma_f32_32x32x16_bf16(pa3, PK(l3, h3), od, 0, 0, 0);
#undef PK
}
__device__ __forceinline__ void pv_d0(f32x16* o, int vb, bf16x8 pa0, bf16x8 pa1, bf16x8 pa2, bf16x8 pa3) {
    pv_one<0>(o[0], vb, pa0, pa1, pa2, pa3); pv_one<1>(o[1], vb, pa0, pa1, pa2, pa3); pv_one<2>(o[2], vb, pa0, pa1, pa2, pa3); pv_one<3>(o[3], vb, pa0, pa1, pa2, pa3);
}
__device__ __forceinline__ bf16x8 ld8(const bf16_t* p) { return *reinterpret_cast<const bf16x8*>(p); }

template <int DQ, int SD>
__device__ __forceinline__ void attn_body(const bf16_t* __restrict__ Qb, int ldq, const bf16_t* __restrict__ Kn, int ldkn, const bf16_t* __restrict__ Kr, int ldkr,
                                          const bf16_t* __restrict__ Vh, int ldv, bf16_t* __restrict__ Ob, int ldo, int seq, bool rope_q, int pos0, const float* __restrict__ tabM, char* lds, const int tid) {
    using CF = Cf<DQ>; constexpr int ND0 = CF::ND0, SHM_V = CF::SHM_V, SHM_K = CF::SHM_K;
    const int wid = tid >> 6, lane = tid & 63, r32 = lane & 31, hi = lane >> 5;
    char* V_lds = lds; char* K_lds = lds + 2 * SHM_V;
    float* ws = (float*)(lds + 2 * SHM_V + 2 * SHM_K) + wid * 64; float* li_l = ws; float* al_l = ws + 32;
    constexpr int NQR = DQ == 192 ? 4 : 8;
    float m_reg = -1e30f, l_reg = 0; f32x16 o[4] = {}; bf16x8 qr[NQR];
    const bf16_t* Qw = Qb + (long)(wid * QBLK + r32) * ldq + hi * 8;
#pragma unroll
    for (int d0 = 0; d0 < NQR; ++d0) qr[d0] = ld8(Qw + d0 * 16);
    char* qx = lds + CF::SHM + wid * 8192 + lane * 16;
    if constexpr (DQ == 192) {
#pragma unroll
        for (int d0 = 4; d0 < 8; ++d0) *(bf16x8*)(qx + (d0 - 4) * 1024) = ld8(Qw + d0 * 16);
        bf16x8 qe[4];
#pragma unroll
        for (int d0 = 0; d0 < 4; ++d0) qe[d0] = ld8(Qw + (8 + d0) * 16);
        if (rope_q) {
            const int pos = pos0 + wid * QBLK + r32, ri = pos >> 6, ci = pos & 63;
#pragma unroll
            for (int t = 0; t < 2; ++t) { const int p = t == 0 ? ri : ci; const float* tc = tabM + p * 16 + hi * 8; const float* tsn = tabM + 128 * 16 + p * 16 + hi * 8;
                bf16x8 a = qe[t], b = qe[2 + t];
#pragma unroll
                for (int jj = 0; jj < 8; ++jj) { const float x1 = bf2f((bf16_t)a[jj]), x2 = bf2f((bf16_t)b[jj]), c = tc[jj], s = tsn[jj];
                    a[jj] = (short)f2bf(x1 * c - x2 * s); b[jj] = (short)f2bf(x2 * c + x1 * s); }
                qe[t] = a; qe[2 + t] = b; }
        }
#pragma unroll
        for (int d0 = 0; d0 < 4; ++d0) *(bf16x8*)(qx + (4 + d0) * 1024) = qe[d0];
    }
    const int sr = tid >> 4, sc = (tid & 15) * 8, vst0 = v_st(sr, sc), vst1 = v_st(32 + sr, sc);
    const int sr2 = tid >> 3, sc2 = (tid & 7) * 8;
    const int vb0 = (int)(uintptr_t)V_lds + v_rd_base(lane);
    struct { bf16x8 vs0, vs1, ks0, ks1, ks2; } sr_[SD];
    const unsigned offV = (unsigned)(sr * ldv + sc) * 2u, offK = (unsigned)(sr * ldkn + sc) * 2u, offR = (unsigned)(sr2 * ldkr + sc2) * 2u;
#define SLOAD(i, k0) do { const char* vt_ = (const char*)Vh + (size_t)(k0) * ldv * 2; const char* kt_ = (const char*)Kn + (size_t)(k0) * ldkn * 2; \
    sr_[i].vs0 = *(const bf16x8*)(vt_ + offV); sr_[i].vs1 = *(const bf16x8*)(vt_ + (size_t)32 * ldv * 2 + offV); \
    sr_[i].ks0 = *(const bf16x8*)(kt_ + offK); sr_[i].ks1 = *(const bf16x8*)(kt_ + (size_t)32 * ldkn * 2 + offK); \
    if constexpr (DQ == 192) sr_[i].ks2 = *(const bf16x8*)((const char*)Kr + (size_t)(k0) * ldkr * 2 + offR); } while (0)
#define SWRITE(b, i) do { *(bf16x8*)(V_lds + (b) * SHM_V + vst0) = sr_[i].vs0; *(bf16x8*)(V_lds + (b) * SHM_V + vst1) = sr_[i].vs1; const int kc = sc * 2; \
    *(bf16x8*)(K_lds + (b) * SHM_K + CF::kswz(sr, kc)) = sr_[i].ks0; *(bf16x8*)(K_lds + (b) * SHM_K + CF::kswz(32 + sr, kc)) = sr_[i].ks1; \
    if constexpr (DQ == 192) *(bf16x8*)(K_lds + (b) * SHM_K + CF::kswz(sr2, 256 + sc2 * 2)) = sr_[i].ks2; } while (0)
#define SWAIT() do { if constexpr (SD == 1) asm volatile("s_waitcnt vmcnt(0)" ::: "memory"); else if constexpr (DQ == 192) asm volatile("s_waitcnt vmcnt(5)" ::: "memory"); else asm volatile("s_waitcnt vmcnt(4)" ::: "memory"); } while (0)
#define RESC(a) do { if (__any((a) < 1.f)) { if (hi == 0) al_l[r32] = (a); asm volatile("s_waitcnt lgkmcnt(0)" ::: "memory"); \
    _Pragma("unroll") for (int d = 0; d < 4; ++d) _Pragma("unroll") for (int r = 0; r < 16; ++r) o[d][r] *= al_l[crow(r, hi)]; } } while (0)
    f32x16 pA0, pA1, pB0, pB1; float mnA, mnB, alA, alB; bf16x8 pa0, pa1, pa2, pa3; const int NT = seq / KVBLK;
    constexpr int SE = 0, SO = SD - 1;
    SLOAD(SE, 0); asm volatile("s_waitcnt vmcnt(0)" ::: "memory"); SWRITE(0, SE); __syncthreads();
    qkt<DQ>(pA0, pA1, K_lds, qr, qx, r32, hi); partialSM<DQ>(pA0, pA1, m_reg, mnA, alA);
    SLOAD(SO, KVBLK); if constexpr (SD == 2) { if (2 < NT) SLOAD(SE, 2 * KVBLK); }
    SWAIT(); SWRITE(1, SO); __syncthreads();
    for (int j = 1; j + 1 < NT; j += 2) {
        SBAR(); qkt<DQ>(pB0, pB1, K_lds + SHM_K, qr, qx, r32, hi);
        finishSM(pA0, pA1, alA, l_reg, pa0, pa1, pa2, pa3); SBAR();
        SLOAD(SO, (j + SD) * KVBLK); SBAR();
        pv_d0(o, vb0, pa0, pa1, pa2, pa3); partialSM<DQ>(pB0, pB1, m_reg, mnB, alB);
        __syncthreads(); SWAIT(); SWRITE(0, SE);
        RESC(alB); __syncthreads();
        SBAR(); qkt<DQ>(pA0, pA1, K_lds, qr, qx, r32, hi);
        finishSM(pB0, pB1, alB, l_reg, pa0, pa1, pa2, pa3); SBAR();
        if (SD == 1 || j + 3 < NT) SLOAD(SE, (j + 1 + SD) * KVBLK); SBAR();
        pv_d0(o, vb0 + SHM_V, pa0, pa1, pa2, pa3); partialSM<DQ>(pA0, pA1, m_reg, mnA, alA);
        __syncthreads(); SWAIT(); SWRITE(1, SO);
        RESC(alA); __syncthreads();
    }
    SBAR(); qkt<DQ>(pB0, pB1, K_lds + SHM_K, qr, qx, r32, hi);
    finishSM(pA0, pA1, alA, l_reg, pa0, pa1, pa2, pa3); SBAR();
    pv_d0(o, vb0, pa0, pa1, pa2, pa3); partialSM<DQ>(pB0, pB1, m_reg, mnB, alB);
    __syncthreads(); RESC(alB);
    finishSM(pB0, pB1, alB, l_reg, pa0, pa1, pa2, pa3); SBAR();
    pv_d0(o, vb0 + SHM_V, pa0, pa1, pa2, pa3);
    if (hi == 0) li_l[r32] = l_reg; asm volatile("s_waitcnt lgkmcnt(0)" ::: "memory");
    float rli[16];
#pragma unroll
    for (int r = 0; r < 16; ++r) rli[r] = __builtin_amdgcn_rcpf(li_l[crow(r, hi)]);
    bf16_t* Ow = Ob + (long)(wid * QBLK) * ldo;
#pragma unroll
    for (int r = 0; r < 16; ++r) { const int orow = crow(r, hi);
#pragma unroll
        for (int d0 = 0; d0 < 4; ++d0) Ow[(long)orow * ldo + d0 * 32 + r32] = f2bf(o[d0][r] * rli[r]); }
#undef SLOAD
#undef SWRITE
#undef SWAIT
#undef RESC
}
}

template <int KS> __device__ __forceinline__ void mma_xy(f32x16& acc, const LAS bf16_t* X, const LAS bf16_t* Y, int hi) {
#pragma unroll
    for (int ks = 0; ks < KS; ++ks) { const bf16x8 a = *(const LAS bf16x8*)(X + ks * 16 + hi * 8), b = *(const LAS bf16x8*)(Y + ks * 16 + hi * 8);
        acc = __builtin_amdgcn_mfma_f32_32x32x16_bf16(a, b, acc, 0, 0, 0); }
}
__device__ __forceinline__ float logsig16(float x) { const float e = __expf(-fabsf(x)); return (fminf(x, 0.f) - __logf(1.f + e)) * 0.0625f; }
__device__ __forceinline__ int gla_sidx(int b, int dir, int h) { return (b * 2 + dir) * 4 + h; }

__device__ __forceinline__ void gla_cumsum(const Ctx& C, int l, int h, int dir, const LAS float* lr, LAS float* segtot, float (&cum)[16]) {
    const int seg = C.tid >> 7, d = C.tid & 127;
    const float* wa = INP(dir ? I_WA2B : I_WA2F) + (size_t)l * 16 * 512 + h * 128 + d;
    const float bias = INP(dir ? I_BAB : I_BAF)[l * 512 + h * 128 + d];
    float w[16];
#pragma unroll
    for (int j = 0; j < 16; ++j) w[j] = wa[j * 512];
    float run = 0.f;
#pragma unroll
    for (int i = 0; i < 16; ++i) { const int s = seg * 16 + i, tk = dir ? 63 - s : s; float pre = bias;
#pragma unroll
        for (int j = 0; j < 16; ++j) pre += lr[tk * 32 + dir * 16 + j] * w[j];
        run += logsig16(pre); cum[i] = run; }
    segtot[seg * 128 + d] = run;
    __syncthreads();
    float off = 0.f;
#pragma unroll
    for (int q = 0; q < 3; ++q) if (q < seg) off += segtot[q * 128 + d];
#pragma unroll
    for (int i = 0; i < 16; ++i) cum[i] += off;
    __syncthreads();
}

__device__ __forceinline__ void phase_gla_local(const Ctx& C, int l) {
    const bf16_t* P = WSP(bf16_t, WS_P); bf16_t* GST = WSP(bf16_t, WS_GST); float* GDEC = WSP(float, WS_GDEC);
    LAS float* lr = (LAS float*)C.lds;
    LAS float* segtot = (LAS float*)(C.lds + 8192);
    LAS bf16_t* KT = (LAS bf16_t*)(C.lds + 8192 + 2048);
    LAS bf16_t* VT = (LAS bf16_t*)(C.lds + 8192 + 2048 + 18432);
    const int r32 = C.lane & 31, hi = C.lane >> 5, seg = C.tid >> 7, d = C.tid & 127;
    for (int unit = C.bid; unit < NBATCH * 4 * NCH; unit += C.G) {
        const int b = unit / (4 * NCH), h = (unit / NCH) % 4, ck = unit % NCH; const size_t r0 = (size_t)b * RPB + ck * 64;
        for (int i = C.tid; i < 64 * 32; i += NTHREADS) lr[i] = bf2f(P[(r0 + (i >> 5)) * NP + C_LRF + (i & 31)]);
        for (int i = C.tid; i < 64 * 256; i += NTHREADS) { const int s = i >> 8, e = i & 255; VT[e * 72 + s] = P[(r0 + s) * NP + C_LV + h * 256 + e]; }
        __syncthreads();
#pragma unroll 1
        for (int dir = 0; dir < 2; ++dir) {
            float cum[16];
            gla_cumsum(C, l, h, dir, lr, segtot, cum);
            if (seg == 3) segtot[d] = cum[15];
            __syncthreads();
            const float bend = segtot[d];
            const size_t sx = (size_t)gla_sidx(b, dir, h) * NCH + ck;
            if (seg == 0) GDEC[sx * 128 + d] = __expf(bend);
#pragma unroll
            for (int i = 0; i < 16; ++i) { const int s = seg * 16 + i, tk = dir ? 63 - s : s;
                const float kv = bf2f(P[(r0 + tk) * NP + C_LK + h * 128 + d]);
                KT[d * 72 + tk] = f2bf(kv * __expf(bend - cum[i])); }
            __syncthreads();
            { const int dt = C.wid & 3, eb = (C.wid >> 2) * 4;
              f32x16 acc[4] = {};
#pragma unroll
              for (int q = 0; q < 4; ++q) mma_xy<4>(acc[q], KT + (dt * 32 + r32) * 72, VT + ((eb + q) * 32 + r32) * 72, hi);
              bf16_t* st = GST + sx * 32768;
#pragma unroll
              for (int q = 0; q < 4; ++q)
#pragma unroll
                  for (int g = 0; g < 4; ++g) { u32x2 w; w.x = cvt_pk_bf16(acc[q][4 * g], acc[q][4 * g + 1]); w.y = cvt_pk_bf16(acc[q][4 * g + 2], acc[q][4 * g + 3]);
                      *(u32x2*)(st + (size_t)((eb + q) * 32 + r32) * 128 + dt * 32 + 8 * g + 4 * hi) = w; } }
            __syncthreads();
        }
    }
}

__device__ __forceinline__ void phase_gla_scan(const Ctx& C) {
    bf16_t* GST = WSP(bf16_t, WS_GST); const float* GDEC = WSP(float, WS_GDEC);
    for (int gid = C.bid * NTHREADS + C.tid; gid < 16 * 8192; gid += C.G * NTHREADS) {
        const int sidx = gid >> 13, g = gid & 8191, dir = (sidx >> 2) & 1, d4 = (g & 31) * 4;
        bf16_t* base = GST + (size_t)sidx * NCH * 32768 + (size_t)g * 4;
        const float* dbase = GDEC + (size_t)sidx * NCH * 128 + d4;
        float S[4] = {0.f, 0.f, 0.f, 0.f};
        for (int st = 0; st < NCH; st += 4) {
            int ck[4]; u32x2 L[4]; f32x4 dc[4];
#pragma unroll
            for (int q = 0; q < 4; ++q) { const int s = st + q; ck[q] = dir ? (s < 4 ? 3 - s : NCH + 3 - s) : s;
                L[q] = *(const u32x2*)(base + (size_t)ck[q] * 32768); dc[q] = *(const f32x4*)(dbase + (size_t)ck[q] * 128); }
#pragma unroll
            for (int q = 0; q < 4; ++q) { u32x2 w; w.x = cvt_pk_bf16(S[0], S[1]); w.y = cvt_pk_bf16(S[2], S[3]);
                *(u32x2*)(base + (size_t)ck[q] * 32768) = w;
                S[0] = dc[q][0] * S[0] + bflo(L[q].x); S[1] = dc[q][1] * S[1] + bfhi(L[q].x); S[2] = dc[q][2] * S[2] + bflo(L[q].y); S[3] = dc[q][3] * S[3] + bfhi(L[q].y); }
        }
    }
}

__device__ __forceinline__ void phase_gla_out(const Ctx& C, int l) {
    const bf16_t* P = WSP(bf16_t, WS_P); const bf16_t* GST = WSP(bf16_t, WS_GST); bf16_t* OL = WSP(bf16_t, WS_OL);
    LAS float* lr = (LAS float*)C.lds;
    LAS float* segtot = (LAS float*)(C.lds + 8192);
    LAS bf16_t* QT = (LAS bf16_t*)(C.lds + 10240);
    LAS bf16_t* KT = (LAS bf16_t*)(C.lds + 27648);
    LAS bf16_t* VT = (LAS bf16_t*)(C.lds + 45056);
    LAS bf16_t* SCm = (LAS bf16_t*)(C.lds + 81920);
    LAS float* OB = (LAS float*)(C.lds + 91136);
    const float* gon = INP(I_ONG) + l * 256;
    const int r32 = C.lane & 31, hi = C.lane >> 5, seg = C.tid >> 7, d = C.tid & 127;
    for (int unit = C.bid; unit < NBATCH * 4 * NCH; unit += C.G) {
        const int b = unit / (4 * NCH), h = (unit / NCH) % 4, ck = unit % NCH; const size_t r0 = (size_t)b * RPB + ck * 64;
        for (int i = C.tid; i < 64 * 32; i += NTHREADS) lr[i] = bf2f(P[(r0 + (i >> 5)) * NP + C_LRF + (i & 31)]);
        for (int i = C.tid; i < 64 * 256; i += NTHREADS) { const int s = i >> 8, e = i & 255; VT[e * 72 + s] = P[(r0 + s) * NP + C_LV + h * 256 + e]; }
        __syncthreads();
        f32x16 oacc[2] = {};
#pragma unroll 1
        for (int dir = 0; dir < 2; ++dir) {
            float cum[16];
            gla_cumsum(C, l, h, dir, lr, segtot, cum);
#pragma unroll
            for (int i = 0; i < 16; ++i) { const int s = seg * 16 + i, tk = dir ? 63 - s : s;
                const float qv = bf2f(P[(r0 + tk) * NP + C_LQ + h * 128 + d]), kv = bf2f(P[(r0 + tk) * NP + C_LK + h * 128 + d]);
                QT[tk * 136 + d] = f2bf(qv * __expf(cum[i]) * 0.088388347648318440f); KT[tk * 136 + d] = f2bf(kv * __expf(-cum[i])); }
            __syncthreads();
            if (C.wid < 4) { const int mt = C.wid >> 1, nt = C.wid & 1; f32x16 sc = {};
                mma_xy<8>(sc, QT + (mt * 32 + r32) * 136, KT + (nt * 32 + r32) * 136, hi);
#pragma unroll
                for (int i = 0; i < 16; ++i) { const int t = mt * 32 + att::crow(i, hi), s = nt * 32 + r32; const bool keep = dir ? (s >= t) : (s <= t);
                    SCm[t * 72 + s] = f2bf(keep ? sc[i] : 0.f); } }
            __syncthreads();
            { const bf16_t* st = GST + ((size_t)gla_sidx(b, dir, h) * NCH + ck) * 32768 + (size_t)(C.wid * 32 + r32) * 128 + hi * 8;
              bf16x8 sb[8];
#pragma unroll
              for (int ks = 0; ks < 8; ++ks) sb[ks] = *(const bf16x8*)(st + ks * 16);
#pragma unroll
              for (int mt = 0; mt < 2; ++mt) {
                  mma_xy<4>(oacc[mt], SCm + (mt * 32 + r32) * 72, VT + (C.wid * 32 + r32) * 72, hi);
#pragma unroll
                  for (int ks = 0; ks < 8; ++ks) { const bf16x8 a = *(const LAS bf16x8*)(QT + (mt * 32 + r32) * 136 + ks * 16 + hi * 8);
                      oacc[mt] = __builtin_amdgcn_mfma_f32_32x32x16_bf16(a, sb[ks], oacc[mt], 0, 0, 0); } } }
            __syncthreads();
        }
#pragma unroll
        for (int mt = 0; mt < 2; ++mt)
#pragma unroll
            for (int i = 0; i < 16; ++i) OB[(mt * 32 + att::crow(i, hi)) * 260 + C.wid * 32 + r32] = oacc[mt][i];
        __syncthreads();
        { const int t = C.tid >> 3, part = C.tid & 7; f32x4 v[8]; float ss = 0.f;
#pragma unroll
          for (int jj = 0; jj < 8; ++jj) { v[jj] = *(const LAS f32x4*)(OB + t * 260 + jj * 32 + part * 4); ss += v[jj][0] * v[jj][0] + v[jj][1] * v[jj][1] + v[jj][2] * v[jj][2] + v[jj][3] * v[jj][3]; }
          ss += __shfl_xor(ss, 1); ss += __shfl_xor(ss, 2); ss += __shfl_xor(ss, 4);
          const float rs = rsqrtf(ss * (1.0f / 256.0f) + NORM_EPS);
#pragma unroll
          for (int jj = 0; jj < 8; ++jj) { const int e = jj * 32 + part * 4; const f32x4 g = *(const f32x4*)(gon + e);
              const u32x2 gt = *(const u32x2*)(P + (r0 + t) * NP + C_LG + h * 256 + e);
              const float o0 = v[jj][0] * rs * g[0] * siluf_(bflo(gt.x)), o1 = v[jj][1] * rs * g[1] * siluf_(bfhi(gt.x)), o2 = v[jj][2] * rs * g[2] * siluf_(bflo(gt.y)), o3 = v[jj][3] * rs * g[3] * siluf_(bfhi(gt.y));
              u32x2 w; w.x = cvt_pk_bf16(o0, o1); w.y = cvt_pk_bf16(o2, o3);
              *(u32x2*)(OL + (r0 + t) * 1024 + h * 256 + e) = w; } }
        __syncthreads();
    }
}

__device__ __forceinline__ unsigned f_ord(float f) { const unsigned u = __float_as_uint(f); return u ^ ((unsigned)((int)u >> 31) | 0x80000000u); }
__device__ __forceinline__ float f_unord(unsigned k) { return __uint_as_float((k & 0x80000000u) ? (k ^ 0x80000000u) : ~k); }
__device__ __forceinline__ void ins_u(unsigned (&L)[16], unsigned x) {
#pragma unroll
    for (int j = 0; j < 16; ++j) { const unsigned h = L[j] > x ? L[j] : x; x = L[j] > x ? x : L[j]; L[j] = h; }
}
__device__ __forceinline__ void ins_f(float (&M)[16], float x) {
#pragma unroll
    for (int j = 0; j < 16; ++j) { const float h = M[j] > x ? M[j] : x; x = M[j] > x ? x : M[j]; M[j] = h; }
}
__device__ __forceinline__ void peer_top16(const bf16_t* __restrict__ qrow, const bf16_t* __restrict__ keys, int r32, int hi, unsigned (&L)[16]) {
    bf16x8 qf[8];
#pragma unroll
    for (int kk = 0; kk < 8; ++kk) qf[kk] = *(const bf16x8*)(qrow + kk * 16 + hi * 8);
#pragma unroll
    for (int j = 0; j < 16; ++j) L[j] = 0u;
#pragma unroll 1
    for (int mt = 0; mt < 4; ++mt) {
        f32x16 acc = {};
#pragma unroll
        for (int kk = 0; kk < 8; ++kk) { const bf16x8 a = *(const bf16x8*)(keys + (size_t)(mt * 32 + r32) * 128 + kk * 16 + hi * 8);
            acc = __builtin_amdgcn_mfma_f32_32x32x16_bf16(a, qf[kk], acc, 0, 0, 0); }
#pragma unroll
        for (int i = 0; i < 16; ++i) { const unsigned kidx = (unsigned)(mt * 32 + att::crow(i, hi)); ins_u(L, (f_ord(acc[i]) & ~127u) | (127u - kidx)); }
    }
    unsigned Pn[16];
#pragma unroll
    for (int j = 0; j < 16; ++j) Pn[j] = (unsigned)__shfl_xor((int)L[j], 32);
#pragma unroll
    for (int j = 0; j < 16; ++j) ins_u(L, Pn[j]);
}
__device__ __forceinline__ void phase_peer_select(const Ctx& C) {
    const bf16_t* PQ = WSP(bf16_t, WS_PQ); const bf16_t* K1 = WSP(bf16_t, WS_K1); const bf16_t* K2 = WSP(bf16_t, WS_K2);
    int* PIDX = WSP(int, WS_PIDX); float* PG = WSP(float, WS_PG);
    const int r32 = C.lane & 31, hi = C.lane >> 5, head = C.wid;
    for (int grp = C.bid; grp < TT / 32; grp += C.G) {
        const size_t tok = (size_t)grp * 32 + r32;
        unsigned L1[16], L2[16];
        peer_top16(PQ + tok * DM + head * 256, K1 + (size_t)head * 128 * 128, r32, hi, L1);
        peer_top16(PQ + tok * DM + head * 256 + 128, K2 + (size_t)head * 128 * 128, r32, hi, L2);
        float v1[16], v2[16];
#pragma unroll
        for (int j = 0; j < 16; ++j) { v1[j] = f_unord(L1[j] & ~127u); v2[j] = f_unord(L2[j] & ~127u); }
        float M[16];
#pragma unroll
        for (int j = 0; j < 16; ++j) M[j] = -3.0e38f;
#pragma unroll
        for (int a = 0; a < 16; ++a)
#pragma unroll
            for (int b = 0; b < 16; ++b) if ((a + 1) * (b + 1) <= 16) ins_f(M, v1[a] + v2[b]);
        const float thr = M[15], mx = M[0]; float den = 0.f;
#pragma unroll
        for (int j = 0; j < 16; ++j) den += __expf(M[j] - mx);
        const float rden = 1.0f / den;
        int pos = 0; int* ip = PIDX + tok * 128 + head * 16; float* gp = PG + tok * 128 + head * 16;
#pragma unroll
        for (int a = 0; a < 16; ++a)
#pragma unroll
            for (int b = 0; b < 16; ++b) if ((a + 1) * (b + 1) <= 16) {
                const float val = v1[a] + v2[b];
                if (val >= thr && pos < 16) { if (hi == 0) { ip[pos] = (int)((127u - (L1[a] & 127u)) * 128u + (127u - (L2[b] & 127u))); gp[pos] = __expf(val - mx) * rden; } ++pos; } }
    }
}
template <int OFF> __device__ __forceinline__ float dotf8(const float (&h)[32], const u32x4 w, float acc) {
#pragma unroll
    for (int j = 0; j < 4; ++j) { const f32x2 lo = __builtin_amdgcn_cvt_pk_f32_fp8((int)w[j], false), hi = __builtin_amdgcn_cvt_pk_f32_fp8((int)w[j], true);
        acc += h[OFF + 4 * j] * lo.x; acc += h[OFF + 4 * j + 1] * lo.y; acc += h[OFF + 4 * j + 2] * hi.x; acc += h[OFF + 4 * j + 3] * hi.y; }
    return acc;
}
template <bool LAST> __device__ __forceinline__ void phase_peer_gather(const Ctx& C, const float* modl, const float pscale) {
    const bf16_t* HB = WSP(bf16_t, WS_HB); const unsigned char* U8 = C.ws + WS_U8; const unsigned char* V8 = C.ws + WS_V8;
    const float* SCU = WSP(float, WS_SCU); const float* SCV = WSP(float, WS_SCV);
    const int* PIDX = WSP(int, WS_PIDX); const float* PG = WSP(float, WS_PG); float* XS = WSP(float, WS_XS);
    const int lane = C.lane;
    for (int r = C.bid * 8 + C.wid; r < TT; r += C.G * 8) {
        if (LAST && (r % RPB) < CTXL) continue;
        float hf[32];
#pragma unroll
        for (int c = 0; c < 2; ++c)
#pragma unroll
            for (int hh = 0; hh < 2; ++hh) { const u32x4 w = *(const u32x4*)(HB + (size_t)r * DM + c * 1024 + lane * 16 + hh * 8);
                hf[c * 16 + hh * 8 + 0] = bflo(w.x); hf[c * 16 + hh * 8 + 1] = bfhi(w.x); hf[c * 16 + hh * 8 + 2] = bflo(w.y); hf[c * 16 + hh * 8 + 3] = bfhi(w.y);
                hf[c * 16 + hh * 8 + 4] = bflo(w.z); hf[c * 16 + hh * 8 + 5] = bfhi(w.z); hf[c * 16 + hh * 8 + 6] = bflo(w.w); hf[c * 16 + hh * 8 + 7] = bfhi(w.w); }
        const int id0 = PIDX[(size_t)r * 128 + lane] & (NEXP - 1), id1 = PIDX[(size_t)r * 128 + 64 + lane] & (NEXP - 1);
        const float g0 = PG[(size_t)r * 128 + lane], g1 = PG[(size_t)r * 128 + 64 + lane];
        const float su0 = SCU[id0], su1 = SCU[id1], sv0 = SCV[id0], sv1 = SCV[id1];
        float a0 = 0.f, a1 = 0.f;
#ifdef DBG_GDUP
#pragma unroll 1
        for (int rep_ = 0; rep_ < 2; ++rep_)
#endif
#pragma unroll 1
        for (int e4 = 0; e4 < 32; ++e4) {
            u32x4 uq[4][2];
#pragma unroll
            for (int q = 0; q < 4; ++q) { const int le = (e4 & 15) * 4 + q; const int id = __builtin_amdgcn_readlane(e4 < 16 ? id0 : id1, le);
                const unsigned char* up = U8 + (size_t)id * DM + lane * 16;
                uq[q][0] = *(const u32x4*)up; uq[q][1] = *(const u32x4*)(up + 1024); }
#pragma unroll
            for (int q = 0; q < 4; ++q) { const int le = (e4 & 15) * 4 + q; float sdot = dotf8<0>(hf, uq[q][0], 0.f); sdot = dotf8<16>(hf, uq[q][1], sdot);
                sdot = wave_sum(sdot);
                if (e4 < 16) a0 = (lane == le) ? sdot : a0; else a1 = (lane == le) ? sdot : a1; }
        }
        a0 *= su0; a1 *= su1;
        const float w0 = g0 * 0.5f * a0 * (1.0f + erff(a0 * 0.70710678118654752f)) * sv0, w1 = g1 * 0.5f * a1 * (1.0f + erff(a1 * 0.70710678118654752f)) * sv1;
#ifdef DBG_CHECK
        const bool dump_ = __builtin_amdgcn_readfirstlane((int)(((r - 300) & 63) == 0 && r >= 300 && r < 300 + 64 * 128)) != 0;
        if (dump_) { float* dbgw = WSP(float, WS_OM) + (size_t)r * 128 + lane; dbgw[0] = w0 / sv0; dbgw[64] = w1 / sv1; }
#endif
        float o[32];
#ifdef DBG_GDUP
#pragma unroll 1
        for (int rep_ = 0; rep_ < 2; ++rep_) {
#endif
#pragma unroll
        for (int i = 0; i < 32; ++i) o[i] = 0.f;
#pragma unroll 1
        for (int e4 = 0; e4 < 32; ++e4) {
            u32x4 vq[4][2]; float wq[4];
#pragma unroll
            for (int q = 0; q < 4; ++q) { const int le = (e4 & 15) * 4 + q; const int id = __builtin_amdgcn_readlane(e4 < 16 ? id0 : id1, le);
                wq[q] = __uint_as_float(__builtin_amdgcn_readlane(__float_as_uint(e4 < 16 ? w0 : w1), le));
                const unsigned char* vp = V8 + (size_t)id * DM + lane * 16;
                vq[q][0] = *(const u32x4*)vp; vq[q][1] = *(const u32x4*)(vp + 1024); }
#pragma unroll
            for (int q = 0; q < 4; ++q)
#pragma unroll
                for (int c = 0; c < 2; ++c)
#pragma unroll
                    for (int j = 0; j < 4; ++j) { const f32x2 lo = __builtin_amdgcn_cvt_pk_f32_fp8((int)vq[q][c][j], false), hi = __builtin_amdgcn_cvt_pk_f32_fp8((int)vq[q][c][j], true); const float w = wq[q];
                        o[c * 16 + 4 * j] += w * lo.x; o[c * 16 + 4 * j + 1] += w * lo.y; o[c * 16 + 4 * j + 2] += w * hi.x; o[c * 16 + 4 * j + 3] += w * hi.y; }
        }
#ifdef DBG_GDUP
        }
#endif
#ifdef DBG_CHECK
        if (dump_) { float* dbgo = WSP(float, WS_MQ) + (size_t)r * DM + lane * 16;
#pragma unroll
          for (int c = 0; c < 2; ++c)
#pragma unroll
              for (int k4 = 0; k4 < 4; ++k4) *(f32x4*)(dbgo + c * 1024 + k4 * 4) = (f32x4){o[c * 16 + k4 * 4], o[c * 16 + k4 * 4 + 1], o[c * 16 + k4 * 4 + 2], o[c * 16 + k4 * 4 + 3]}; }
#endif
        const float* g2 = modl + (size_t)mod_sel(r) * 12288 + 5 * DM;
        float ss = 0.f;
#pragma unroll
        for (int c = 0; c < 2; ++c)
#pragma unroll
            for (int h = 0; h < 4; ++h) { const int col = c * 1024 + lane * 16 + 4 * h; float* xp = XS + (size_t)r * DM + col;
                const f32x4 x = *(const f32x4*)xp, g = *(const f32x4*)(g2 + col); f32x4 y;
#pragma unroll
                for (int j = 0; j < 4; ++j) { y[j] = x[j] + pscale * g[j] * o[c * 16 + 4 * h + j]; ss += y[j] * y[j]; o[c * 16 + 4 * h + j] = y[j]; }
                if (!LAST) *(f32x4*)xp = y; }
        if (LAST) {
            ss = wave_sum(ss); const float rs = rsqrtf(ss * (1.0f / DM) + NORM_EPS);
            const int b = r / RPB, j = r % RPB; float* op = C.out + ((size_t)b * SEQ + (j - CTXL)) * DM; const float* fg = INP(I_FG);
#pragma unroll
            for (int c = 0; c < 2; ++c)
#pragma unroll
                for (int h = 0; h < 4; ++h) { const int col = c * 1024 + lane * 16 + 4 * h; const f32x4 g = *(const f32x4*)(fg + col); f32x4 y;
#pragma unroll
                    for (int jj = 0; jj < 4; ++jj) y[jj] = o[c * 16 + 4 * h + jj] * rs * g[jj];
                    *(f32x4*)(op + col) = y; }
        }
    }
}

template <int TYPE  > __device__ __forceinline__ void attn_units(const Ctx& C, bool need_ctx) {
    const bf16_t* P = WSP(bf16_t, WS_P);
    const int nu = need_ctx ? 528 : 512;
#pragma unroll 1
    for (int u = C.bid; u < nu; u += C.G) {
        int bh, qb; if (u < 512) { bh = (u >> 8) * 8 + (u & 7); qb = ((u & 255) >> 3) + 1; } else { bh = u - 512; qb = 0; }
        const int b = bh >> 3, h = bh & 7; const size_t rq = (size_t)b * RPB + (size_t)qb * 256, rk = (size_t)b * RPB; const int seq = qb == 0 ? CTXL : RPB;
        __syncthreads();
        if constexpr (TYPE == 1) {
            att::attn_body<128, 1>(P + rq * NP + C_AQ + h * 128, NP, P + rk * NP + C_AK + (h >> 2) * 128, NP, nullptr, 0, P + rk * NP + C_AV + (h >> 2) * 128, NP,
                                   WSP(bf16_t, WS_OA) + rq * 1024 + h * 128, 1024, seq, false, 0, nullptr, (char*)C.lds, C.tid);
        } else {
            const bf16_t* MQ = WSP(bf16_t, WS_MQ); const bf16_t* MKV = WSP(bf16_t, WS_MKV);
            att::attn_body<192, 1>(MQ + rq * 1536 + h * 192, 1536, MKV + rk * 2048 + h * 256, 2048, P + rk * NP + C_MKR, NP, MKV + rk * 2048 + h * 256 + 128, 2048,
                                   WSP(bf16_t, WS_OM) + rq * 1024 + h * 128, 1024, seq, qb > 0, (qb - 1) * 256, WSP(float, WS_TABM), (char*)C.lds, C.tid);
        }
    }
    __syncthreads();
}

constexpr int LDS_BYTES = 163840, LDS_BAR_OFF = LDS_BYTES - 16;
constexpr int N_PHASES = 25;
template <int K> __device__ __forceinline__ void run_phase(const Ctx& C0, int l) {
    const Ctx C = launder(C0);
    const float* modl = WSP(float, WS_MODV) + (size_t)l * 3 * 12288;
    if constexpr (K == 0) { phase_modv(C); phase_tables(C); __syncthreads(); phase_cvt_mixer_weights(C, 0); }
    if constexpr (K == 1) {
        if (l == 0) phase_norm_mod<true>(C, INP(I_N1G), modl, 0, DM);
        else { phase_norm_mod<false>(C, INP(I_N1G) + l * DM, modl, 0, DM); __syncthreads(); phase_cvt_mixer_weights(C, l); }
    }
    if constexpr (K == 2) {
        pg8::Gemm g{WSP(bf16_t, WS_HB), WSP(bf16_t, WS_WIN), TT, NP, DM, DM, DM}; pg8::StaticOrder S; S.init(TT, NP, C.G, C.bid);
        pg8::EpiStoreBf16 E{WSP(bf16_t, WS_P), NP};
        pg8::gemm_phase(C.lds, C.tid, g, S, E);
    }
    if constexpr (K == 3) phase_post_p(C, l);
    if constexpr (K == 4) {
        { pg8::Gemm g{WSP(bf16_t, WS_P) + C_MCQ, WSP(bf16_t, WS_WUQ), TT, 1536, 512, NP, 512}; pg8::StaticOrder S; S.init(TT, 1536, C.G, C.bid);
          pg8::EpiStoreBf16 E{WSP(bf16_t, WS_MQ), 1536}; pg8::gemm_phase(C.lds, C.tid, g, S, E); }
        { pg8::Gemm g{WSP(bf16_t, WS_P) + C_MCKV, WSP(bf16_t, WS_WUKV), TT, 2048, 512, NP, 512}; pg8::StaticOrder S; S.init(TT, 2048, C.G, C.bid);
          pg8::EpiStoreBf16 E{WSP(bf16_t, WS_MKV), 2048}; pg8::gemm_phase(C.lds, C.tid, g, S, E); }
        { const Ctx C2 = launder(C0); phase_gla_local(C2, l); }
    }
    if constexpr (K == 5) phase_gla_scan(C);
    if constexpr (K == 6) { attn_units<0>(C, l + 1 < DEPTH); { const Ctx C2 = launder(C0); attn_units<1>(C2, l + 1 < DEPTH); } { const Ctx C3 = launder(C0); phase_gla_out(C3, l); } }
    if constexpr (K == 7) {
        const bf16_t* P = WSP(bf16_t, WS_P); bf16_t* Y = WSP(bf16_t, WS_Y); pg8::StaticOrder S; S.init(TT, DM, C.G, C.bid);
        { pg8::Gemm g{WSP(bf16_t, WS_OA), WSP(bf16_t, WS_WBR), TT, DM, 1024, 1024, 1024}; pg8::EpiGate<true> E{Y, DM, P + C_GA, NP}; pg8::gemm_phase(C.lds, C.tid, g, S, E); }
        { pg8::Gemm g{WSP(bf16_t, WS_OL), WSP(bf16_t, WS_WBR) + (size_t)2048 * 1024, TT, DM, 1024, 1024, 1024}; pg8::EpiGate<false> E{Y, DM, P + C_GL, NP}; pg8::gemm_phase(C.lds, C.tid, g, S, E); }
        { pg8::Gemm g{WSP(bf16_t, WS_OM), WSP(bf16_t, WS_WBR) + (size_t)2 * 2048 * 1024, TT, DM, 1024, 1024, 1024}; pg8::EpiGate<false> E{Y, DM, P + C_GM, NP}; pg8::gemm_phase(C.lds, C.tid, g, S, E); }
    }
    if constexpr (K == 8) {
        pg8::Gemm g{WSP(bf16_t, WS_Y), WSP(bf16_t, WS_WOUT), TT, DM, DM, DM, DM}; pg8::StaticOrder S; S.init(TT, DM, C.G, C.bid);
        pg8::EpiResid E{WSP(float, WS_XS), DM, modl + 2 * DM, l == 0 ? DBG_MIX0 : DBG_MIX1};
        pg8::gemm_phase(C.lds, C.tid, g, S, E);
        phase_cvt_peer_tables(C, l);
#ifdef DBG_CDUP
        phase_cvt_peer_tables(C, l);
#endif
    }
    if constexpr (K == 9) phase_norm_mod<false>(C, INP(I_N2G) + l * DM, modl, 3 * DM, 4 * DM);
    if constexpr (K == 10) {
        pg8::Gemm g{WSP(bf16_t, WS_HB), WSP(bf16_t, WS_WQ), TT, DM, DM, DM, DM}; pg8::StaticOrder S; S.init(TT, DM, C.G, C.bid);
        pg8::EpiStoreBf16 E{WSP(bf16_t, WS_PQ), DM};
        pg8::gemm_phase(C.lds, C.tid, g, S, E);
    }
    if constexpr (K == 11) phase_peer_select(C);
    if constexpr (K == 12) { if (l + 1 < DEPTH) phase_peer_gather<false>(C, modl, DBG_PEER0); else phase_peer_gather<true>(C, modl, DBG_PEER1); }
}
__device__ __forceinline__ Ctx make_ctx(const Args& args, unsigned char* lds_raw) {
    Ctx C0; C0.in = (const __attribute__((address_space(4))) cfp_t*)__builtin_amdgcn_kernarg_segment_ptr(); C0.out = args.out; C0.ws = args.ws; C0.lds = (LAS unsigned char*)lds_raw;
    C0.tid = threadIdx.x; C0.lane = C0.tid & 63; C0.wid = __builtin_amdgcn_readfirstlane(C0.tid >> 6); C0.G = gridDim.x; C0.bid = blockIdx.x;
    return C0;
}
template <int K> __global__ void __launch_bounds__(NTHREADS, 2) k_one(Args args) {
    extern __shared__ __attribute__((aligned(16))) unsigned char lds_raw[];
    const Ctx C0 = make_ctx(args, lds_raw);
    run_phase<K>(C0, args.ph_lo);
}
#if MK_N_LAUNCHES == 1
__global__ void __launch_bounds__(NTHREADS, 2) mk_fwd(Args args) {
    extern __shared__ __attribute__((aligned(16))) unsigned char lds_raw[];
    const Ctx C0 = make_ctx(args, lds_raw);
    if (C0.tid < 4) ((LAS unsigned*)(C0.lds + LDS_BAR_OFF))[C0.tid] = 0u;
    __syncthreads();
    const int lo = args.ph_lo, hi = args.ph_hi;
    XcdBarrier bar; bar.bar = (unsigned*)(args.ws + WS_CTL); bar.x = 0; bar.st = nullptr;
    if (hi - lo > 1) bar = xcd_barrier_post((unsigned*)(args.ws + WS_CTL), (volatile LAS unsigned*)(C0.lds + LDS_BAR_OFF));
#define IN(k) (lo <= (k) && (k) < hi)
#define SEAM(k) do { if (IN(k) && IN((k) + 1)) xcd_barrier(bar); } while (0)
#ifndef DBG_DUP
#define DBG_DUP -1
#endif
#define PH(K, k) do { if (IN(k)) { run_phase<K>(C0, l); if (K == DBG_DUP) { xcd_barrier(bar); run_phase<K>(C0, l); } } SEAM(k); } while (0)
    { const int l = 0; PH(0, 0); }
#pragma unroll 1
    for (int l = 0; l < DEPTH; ++l) {
        const int pb = 1 + 12 * l;
        PH(1, pb + 0); PH(2, pb + 1); PH(3, pb + 2); PH(4, pb + 3); PH(5, pb + 4); PH(6, pb + 5);
        PH(7, pb + 6); PH(8, pb + 7); PH(9, pb + 8); PH(10, pb + 9); PH(11, pb + 10); PH(12, pb + 11);
    }
#undef PH
#undef IN
#undef SEAM
}
#define MAIN_KERNEL mk_fwd
#else
#define MAIN_KERNEL k_one<6>
#endif


#ifdef DBG_CHECK
__device__ __forceinline__ void dbg_report(unsigned* slot, float err) { if (!(err <= 3e38f)) err = 1e30f; atomicMax(slot, __float_as_uint(err)); }
__global__ void k_check_gemm(const bf16_t* A, int lda, const float* W, int K, int N, const bf16_t* Cm, int ldc, int M, unsigned* slot) {
    const unsigned id = blockIdx.x * blockDim.x + threadIdx.x; if (id >= 8192) return;
    const unsigned h = id * 2654435761u; const int row = (int)((h >> 8) % (unsigned)M), col = (int)((h * 40503u >> 7) % (unsigned)N);
    float ref = 0.f; for (int k = 0; k < K; ++k) ref += bf2f(A[(size_t)row * lda + k]) * W[(size_t)k * N + col];
    const float got = bf2f(Cm[(size_t)row * ldc + col]);
    dbg_report(slot, fabsf(got - ref) / (fabsf(ref) + 0.1f));
}

__global__ void k_check_attn(const unsigned char* ws, int type, unsigned* slot) {
    __shared__ float sc[RPB]; __shared__ float red[256]; __shared__ float qv[192];
    const int t = threadIdx.x, bh = blockIdx.x & 15, b = bh >> 3, h = bh & 7; const int qpos = (int)(((blockIdx.x >> 4) * 977u + 13u) % SEQ); const size_t rq = (size_t)b * RPB + CTXL + qpos, rk = (size_t)b * RPB;
    const bf16_t* P = (const bf16_t*)(ws + WS_P); const bf16_t* MQ = (const bf16_t*)(ws + WS_MQ); const bf16_t* MKV = (const bf16_t*)(ws + WS_MKV);
    const int dq = type ? 128 : 192;
    if (t < dq) { float v = type ? bf2f(P[rq * NP + C_AQ + h * 128 + t]) : bf2f(MQ[rq * 1536 + h * 192 + t]); qv[t] = v; }
    __syncthreads();
    if (!type && t < 32) {
        const int ri = qpos >> 6, ci = qpos & 63; const int i = t; const float pos = (float)(i < 16 ? ri : ci); const float inv = powf(10000.f, -(float)(i & 15) / 16.f); const float a = pos * inv;
        const float x1 = qv[128 + i], x2 = qv[160 + i]; qv[128 + i] = x1 * cosf(a) - x2 * sinf(a); qv[160 + i] = x2 * cosf(a) + x1 * sinf(a); }
    __syncthreads();
    const float scale = type ? 0.088388347648f : 0.0721687836487f;
    float mx = -1e30f;
    for (int k = t; k < RPB; k += 256) { float s = 0.f;
        if (type) { const bf16_t* kp = P + (rk + k) * NP + C_AK + (h >> 2) * 128; for (int d = 0; d < 128; ++d) s += qv[d] * bf2f(kp[d]); }
        else { const bf16_t* kp = MKV + (rk + k) * 2048 + h * 256; for (int d = 0; d < 128; ++d) s += qv[d] * bf2f(kp[d]); const bf16_t* kr = P + (rk + k) * NP + C_MKR; for (int d = 0; d < 64; ++d) s += qv[128 + d] * bf2f(kr[d]); }
        s *= scale; sc[k] = s; mx = fmaxf(mx, s); }
    red[t] = mx; __syncthreads(); for (int o = 128; o >= 1; o >>= 1) { if (t < o) red[t] = fmaxf(red[t], red[t + o]); __syncthreads(); } mx = red[0]; __syncthreads();
    float sum = 0.f; for (int k = t; k < RPB; k += 256) { const float p = __expf(sc[k] - mx); sc[k] = p; sum += p; }
    red[t] = sum; __syncthreads(); for (int o = 128; o >= 1; o >>= 1) { if (t < o) red[t] += red[t + o]; __syncthreads(); } sum = red[0]; __syncthreads();
    float e = 0.f, mag = 0.f;
    if (t < 128) { float o = 0.f; for (int k = 0; k < RPB; ++k) { const float vv = type ? bf2f(P[(rk + k) * NP + C_AV + (h >> 2) * 128 + t]) : bf2f(MKV[(rk + k) * 2048 + h * 256 + 128 + t]); o += sc[k] * vv; }
        o /= sum; const float got = bf2f(((const bf16_t*)(ws + (type ? WS_OA : WS_OM)))[rq * 1024 + h * 128 + t]); e = fabsf(got - o); mag = fabsf(o); }
    red[t] = e; __syncthreads(); for (int o = 128; o >= 1; o >>= 1) { if (t < o) red[t] = fmaxf(red[t], red[t + o]); __syncthreads(); } e = red[0]; __syncthreads();
    red[t] = mag; __syncthreads(); for (int o = 128; o >= 1; o >>= 1) { if (t < o) red[t] = fmaxf(red[t], red[t + o]); __syncthreads(); } mag = red[0];
    if (t == 0) dbg_report(slot, e / (mag + 1e-4f));
}
__global__ void __launch_bounds__(256) k_check_gla_rec(const unsigned char* ws, const float* wa_f, const float* ba_f, const float* wa_b, const float* ba_b, float* obuf, int b) {
    __shared__ float ad[128], kd[128], qd[128], lrs[16];
    const int e = threadIdx.x, h = blockIdx.x & 3, dir = blockIdx.x >> 2; const bf16_t* P = (const bf16_t*)(ws + WS_P);
    const float* wa = dir ? wa_b : wa_f; const float* ba = dir ? ba_b : ba_f;
    float S[128];
#pragma unroll
    for (int d = 0; d < 128; ++d) S[d] = 0.f;
    float* ob = obuf + ((size_t)(dir * 2 + b) * 4 + h) * RPB * 256;
    for (int st = 0; st < RPB; ++st) {
        int j; if (!dir) j = st; else j = st < CTXL ? CTXL - 1 - st : RPB - 1 - (st - CTXL);
        const size_t r = (size_t)b * RPB + j; const bf16_t* pr = P + r * NP;
        if (e < 16) lrs[e] = bf2f(pr[(dir ? C_LRB : C_LRF) + e]);
        __syncthreads();
        if (e < 128) { float pre = ba[h * 128 + e]; for (int q = 0; q < 16; ++q) pre += lrs[q] * wa[q * 512 + h * 128 + e];
            const float ls = (fminf(pre, 0.f) - log1pf(expf(-fabsf(pre)))) / 16.f; ad[e] = expf(ls); kd[e] = bf2f(pr[C_LK + h * 128 + e]); qd[e] = bf2f(pr[C_LQ + h * 128 + e]) * 0.088388347648f; }
        __syncthreads();
        const float v = bf2f(pr[C_LV + h * 256 + e]); float o = 0.f;
#pragma unroll
        for (int d = 0; d < 128; ++d) { S[d] = ad[d] * S[d] + kd[d] * v; o += qd[d] * S[d]; }
        ob[(size_t)j * 256 + e] = o;
        __syncthreads();
    }
}
__global__ void k_check_gla_cmp(const unsigned char* ws, const float* obuf, const float* gon, int b, unsigned* slot) {
    __shared__ float red[256];
    const int e = threadIdx.x, h = blockIdx.x & 3, j = blockIdx.x >> 2; const size_t r = (size_t)b * RPB + j; const bf16_t* P = (const bf16_t*)(ws + WS_P);
    const float o = obuf[((size_t)(0 * 2 + b) * 4 + h) * RPB * 256 + (size_t)j * 256 + e] + obuf[((size_t)(1 * 2 + b) * 4 + h) * RPB * 256 + (size_t)j * 256 + e];
    red[e] = o * o; __syncthreads(); for (int s_ = 128; s_ >= 1; s_ >>= 1) { if (e < s_) red[e] += red[e + s_]; __syncthreads(); }
    const float rs = rsqrtf(red[0] / 256.f + NORM_EPS); __syncthreads();
    const float gt = bf2f(P[r * NP + C_LG + h * 256 + e]); const float ref = o * rs * gon[e] * (gt / (1.f + expf(-gt)));
    const float got = bf2f(((const bf16_t*)(ws + WS_OL))[r * 1024 + h * 256 + e]);
    red[e] = fabsf(got - ref); __syncthreads(); for (int s_ = 128; s_ >= 1; s_ >>= 1) { if (e < s_) red[e] = fmaxf(red[e], red[e + s_]); __syncthreads(); }
    if (e == 0) dbg_report(slot, red[0] / 1.0f);
}
__global__ void k_check_select(const bf16_t* PQ, const float* k1, const float* k2, const int* PIDX, const float* PG, unsigned* slot) {
    __shared__ float s1[128], s2[128]; __shared__ int cnt; __shared__ float selv[16];
    const int tok = (blockIdx.x >> 3) * 61 + 5, head = blockIdx.x & 7, t = threadIdx.x;
    if (t == 0) cnt = 0;
    for (int n = t; n < 128; n += 64) { float a = 0.f, b = 0.f; for (int d = 0; d < 128; ++d) { a += bf2f(PQ[(size_t)tok * DM + head * 256 + d]) * k1[((size_t)head * 128 + n) * 128 + d]; b += bf2f(PQ[(size_t)tok * DM + head * 256 + 128 + d]) * k2[((size_t)head * 128 + n) * 128 + d]; } s1[n] = a; s2[n] = b; }
    __syncthreads();
    if (t < 16) { const int id = PIDX[(size_t)tok * 128 + head * 16 + t]; selv[t] = (id >= 0 && id < 16384) ? s1[id >> 7] + s2[id & 127] : -1e30f; }
    __syncthreads();
    float thr = selv[0], mx = selv[0]; for (int k = 1; k < 16; ++k) { thr = fminf(thr, selv[k]); mx = fmaxf(mx, selv[k]); }
    int c = 0; for (int p = t; p < 16384; p += 64) if (s1[p >> 7] + s2[p & 127] > thr + 0.02f) ++c;
    atomicAdd(&cnt, c); __syncthreads();
    if (t == 0) { float den = 0.f; for (int k = 0; k < 16; ++k) den += __expf(selv[k] - mx); float e = fabsf((float)cnt - 15.f) / 15.f > 0.34f ? fabsf((float)cnt - 15.f) / 15.f : 0.f;
        for (int k = 0; k < 16; ++k) e = fmaxf(e, fabsf(PG[(size_t)tok * 128 + head * 16 + k] - __expf(selv[k] - mx) / den) * 4.f);
        for (int k = 0; k < 16; ++k) for (int k2_ = 0; k2_ < k; ++k2_) if (PIDX[(size_t)tok * 128 + head * 16 + k] == PIDX[(size_t)tok * 128 + head * 16 + k2_]) e = fmaxf(e, 10.f);
        dbg_report(slot, e); }
}
__global__ void k_check_gather(const bf16_t* HB, const float* u, const float* v, const int* PIDX, const float* PG, const float* dbgo, unsigned* slot) {
    __shared__ float w[128];
    const int tok = blockIdx.x * 64 + 300, t = threadIdx.x;
    for (int k = t; k < 128; k += 64) { const int id = PIDX[(size_t)tok * 128 + k] & 16383; float a = 0.f; for (int d = 0; d < DM; ++d) a += bf2f(HB[(size_t)tok * DM + d]) * u[(size_t)id * DM + d];
        w[k] = PG[(size_t)tok * 128 + k] * 0.5f * a * (1.0f + erff(a * 0.70710678f)); }
    __syncthreads();
    float e = 0.f, sc = 0.f;
    for (int d = t; d < DM; d += 64) { float o = 0.f; for (int k = 0; k < 128; ++k) o += w[k] * v[(size_t)(PIDX[(size_t)tok * 128 + k] & 16383) * DM + d];
        e = fmaxf(e, fabsf(o - dbgo[(size_t)tok * DM + d])); sc = fmaxf(sc, fabsf(o)); }
    for (int o_ = 32; o_ >= 1; o_ >>= 1) { e = fmaxf(e, __shfl_xor(e, o_)); sc = fmaxf(sc, __shfl_xor(sc, o_)); }
    if (t == 0) dbg_report(slot, e / (sc + 1e-6f));
}
__global__ void k_dbg_out2(const float* x, const float* fg, float* out, const unsigned* slot) {
    const float mx = __uint_as_float(*slot); float v = 0.25f * (log10f(fmaxf(mx, 1e-30f)) + 4.0f); v = fminf(fmaxf(v, 0.f), 9.f);
    const float f = 1.0f + v;
    const int lane = threadIdx.x & 63; const size_t r = (size_t)blockIdx.x * 4 + (threadIdx.x >> 6);
    const float* xr = x + r * DM; float ss = 0.f;
    for (int c = lane; c < DM; c += 64) ss += xr[c] * xr[c];
    ss = wave_sum(ss); const float rs = rsqrtf(ss / DM + NORM_EPS);
    for (int c = lane; c < DM; c += 64) out[r * DM + c] = xr[c] * rs * fg[c] * f;
}
#endif
#ifdef DBG_SCAN
__global__ void k_scan16(const bf16_t* p, size_t n, unsigned* flags, int stage) {
    unsigned bad = 0; for (size_t i = (size_t)blockIdx.x * blockDim.x + threadIdx.x; i < n; i += (size_t)gridDim.x * blockDim.x) bad |= ((p[i] & 0x7f80u) == 0x7f80u);
    if (bad) atomicOr(&flags[stage], 1u);
}
__global__ void k_scan32(const float* p, size_t n, unsigned* flags, int stage) {
    unsigned bad = 0; for (size_t i = (size_t)blockIdx.x * blockDim.x + threadIdx.x; i < n; i += (size_t)gridDim.x * blockDim.x) bad |= ((__float_as_uint(p[i]) & 0x7f800000u) == 0x7f800000u);
    if (bad) atomicOr(&flags[stage], 1u);
}
__global__ void k_dbg_out(const float* x, const float* fg, float* out, const unsigned* flags, int nstage) {
    int code = 0; for (int s = nstage; s >= 1; --s) if (flags[s]) code = s;
    const float f = 1.0f + 0.25f * (float)code;
    const int lane = threadIdx.x & 63; const size_t r = (size_t)blockIdx.x * 4 + (threadIdx.x >> 6);
    const float* xr = x + r * DM; float ss = 0.f;
    for (int c = lane; c < DM; c += 64) ss += xr[c] * xr[c];
    ss = wave_sum(ss); const float rs = rsqrtf(ss / DM + NORM_EPS);
    for (int c = lane; c < DM; c += 64) out[r * DM + c] = xr[c] * rs * fg[c] * f;
}
#endif
extern "C" void kernel_launch(void* const* d_in, const int* in_sizes, int n_in, void* d_out, int out_size, void* d_ws, size_t ws_size, hipStream_t stream) {
    static int grid = 0;
    if (grid == 0) {
        if (n_in != 30 || out_size != NBATCH * SEQ * DM || ws_size < WS_END) { fprintf(stderr, "kernel_launch: shape/workspace mismatch: n_in %d out %d ws %zu (need %zu)\n", n_in, out_size, ws_size, (size_t)WS_END); grid = -1; return; }
        int dev = 0, cus = 0, per_cu = 0;
        if (hipGetDevice(&dev) != hipSuccess || hipDeviceGetAttribute(&cus, hipDeviceAttributeMultiprocessorCount, dev) != hipSuccess) { grid = -1; return; }
        bool okattr = hipFuncSetAttribute((const void*)MAIN_KERNEL, hipFuncAttributeMaxDynamicSharedMemorySize, LDS_BYTES) == hipSuccess;
#if MK_N_LAUNCHES != 1
#define SETA(K) okattr = okattr && hipFuncSetAttribute((const void*)k_one<K>, hipFuncAttributeMaxDynamicSharedMemorySize, LDS_BYTES) == hipSuccess
        SETA(0); SETA(1); SETA(2); SETA(3); SETA(4); SETA(5); SETA(6); SETA(7); SETA(8); SETA(9); SETA(10); SETA(11); SETA(12);
#undef SETA
#endif
        if (!okattr) { fprintf(stderr, "kernel_launch: hipFuncSetAttribute failed\n"); grid = -1; return; }
        if (hipOccupancyMaxActiveBlocksPerMultiprocessor(&per_cu, (const void*)MAIN_KERNEL, NTHREADS, LDS_BYTES) != hipSuccess || per_cu < 1) { fprintf(stderr, "kernel_launch: occupancy query says %d blocks per CU\n", per_cu); grid = -1; (void)hipGetLastError(); return; }
        grid = cus;
    }
    if (grid < 0) return;
    if (hipMemsetAsync((char*)d_ws + WS_CTL, 0, CTL_BYTES, stream) != hipSuccess) return;
    Args a{};
    for (int i = 0; i < 30; ++i) a.in[i] = (const float*)d_in[i];
    a.out = (float*)d_out; a.ws = (unsigned char*)d_ws;
#if MK_N_LAUNCHES == 1
    a.ph_lo = 0; a.ph_hi = N_PHASES;
    hipLaunchKernelGGL(mk_fwd, dim3(grid), dim3(NTHREADS), LDS_BYTES, stream, a);
#else
    a.ph_hi = 0;
#ifndef DBG_NLAUNCH
#define DBG_NLAUNCH 100
#endif
    int nl_ = 0;
#define LAUNCH1(K, L) do { a.ph_lo = (L); if (nl_++ < DBG_NLAUNCH) { hipLaunchKernelGGL(k_one<K>, dim3(grid), dim3(NTHREADS), LDS_BYTES, stream, a); if (K == DBG_DUP) hipLaunchKernelGGL(k_one<K>, dim3(grid), dim3(NTHREADS), LDS_BYTES, stream, a); } } while (0)
#ifdef DBG_SCAN
    unsigned* flags = (unsigned*)((char*)d_ws + WS_CTL + 32768);
    char* W = (char*)d_ws;
#define S16(off, n, st) hipLaunchKernelGGL(k_scan16, dim3(1024), dim3(256), 0, stream, (const bf16_t*)(W + (off)), (size_t)(n), flags, st)
#define S32(off, n, st) hipLaunchKernelGGL(k_scan32, dim3(1024), dim3(256), 0, stream, (const float*)(W + (off)), (size_t)(n), flags, st)
    LAUNCH1(0, 0); S32(WS_MODV, 2 * 3 * 12288, 1);
    { const int l = 0;
      LAUNCH1(1, l); S16(WS_HB, (size_t)TT * DM, 2);
      LAUNCH1(2, l); S16(WS_P, (size_t)TT * NP, 3);
      LAUNCH1(3, l); S16(WS_P, (size_t)TT * NP, 4);
      LAUNCH1(4, l); S16(WS_MQ, (size_t)TT * 1536, 5); S16(WS_MKV, (size_t)TT * 2048, 5); S16(WS_GST, (size_t)2112 * 32768, 6); S32(WS_GDEC, (size_t)2112 * 128, 6);
      LAUNCH1(5, l); S16(WS_GST, (size_t)2112 * 32768, 7);
      LAUNCH1(6, l); S16(WS_OA, (size_t)TT * 1024, 8); S16(WS_OM, (size_t)TT * 1024, 9); S16(WS_OL, (size_t)TT * 1024, 10);
      LAUNCH1(7, l); S16(WS_Y, (size_t)TT * DM, 11);
      LAUNCH1(8, l); S32(WS_XS, (size_t)TT * DM, 12);
      LAUNCH1(9, l); S16(WS_HB, (size_t)TT * DM, 13);
      LAUNCH1(10, l); S16(WS_PQ, (size_t)TT * DM, 14);
      LAUNCH1(11, l); S32(WS_PG, (size_t)TT * 128, 15);
      LAUNCH1(12, l); S32(WS_XS, (size_t)TT * DM, 16);
    }
    hipLaunchKernelGGL(k_dbg_out, dim3(NBATCH * SEQ / 4), dim3(256), 0, stream, (const float*)d_in[0], (const float*)d_in[29], (float*)d_out, flags, 16);
#elif defined(DBG_CHECK)
    unsigned* flags = (unsigned*)((char*)d_ws + WS_CTL + 32768);
    char* W = (char*)d_ws;
    LAUNCH1(0, 0);
    { const int l = 0; LAUNCH1(1, l); LAUNCH1(2, l); LAUNCH1(3, l); LAUNCH1(4, l); LAUNCH1(5, l); LAUNCH1(6, l);
#if DBG_CHECK == 5 || DBG_CHECK == 6
      hipLaunchKernelGGL(k_check_attn, dim3(16 * 24), dim3(256), 0, stream, (const unsigned char*)d_ws, DBG_CHECK == 5 ? 1 : 0, flags + 100);
#endif
#if DBG_CHECK == 7
      { float* obuf = (float*)(W + WS_MQ);
        hipLaunchKernelGGL(k_check_gla_rec, dim3(8), dim3(256), 0, stream, (const unsigned char*)d_ws, (const float*)d_in[I_WA2F], (const float*)d_in[I_BAF], (const float*)d_in[I_WA2B], (const float*)d_in[I_BAB], obuf, 0);
        hipLaunchKernelGGL(k_check_gla_cmp, dim3(RPB * 4), dim3(256), 0, stream, (const unsigned char*)d_ws, (const float*)obuf, (const float*)d_in[I_ONG], 0, flags + 100); }
#endif
      LAUNCH1(7, l); LAUNCH1(8, l); LAUNCH1(9, l); LAUNCH1(10, l);
#if DBG_CHECK == 1
      hipLaunchKernelGGL(k_check_gemm, dim3(32), dim3(256), 0, stream, (const bf16_t*)(W + WS_HB), DM, (const float*)d_in[I_PWQ], DM, DM, (const bf16_t*)(W + WS_PQ), DM, TT, flags + 100);
#endif
      LAUNCH1(11, l);
#if DBG_CHECK == 2
      hipLaunchKernelGGL(k_check_select, dim3(256 * 8), dim3(64), 0, stream, (const bf16_t*)(W + WS_PQ), (const float*)d_in[I_PK1], (const float*)d_in[I_PK2], (const int*)(W + WS_PIDX), (const float*)(W + WS_PG), flags + 100);
#endif
      LAUNCH1(12, l);
#if DBG_CHECK == 3
      hipLaunchKernelGGL(k_check_gather, dim3(128), dim3(64), 0, stream, (const bf16_t*)(W + WS_HB), (const float*)d_in[I_PU], (const float*)d_in[I_PV], (const int*)(W + WS_PIDX), (const float*)(W + WS_PG), (const float*)(W + WS_MQ), flags + 100);
#endif
    }
    hipLaunchKernelGGL(k_dbg_out2, dim3(NBATCH * SEQ / 4), dim3(256), 0, stream, (const float*)d_in[0], (const float*)d_in[29], (float*)d_out, flags + 100);
#else
    LAUNCH1(0, 0);
    for (int l = 0; l < DEPTH; ++l) { LAUNCH1(1, l); LAUNCH1(2, l); LAUNCH1(3, l); LAUNCH1(4, l); LAUNCH1(5, l); LAUNCH1(6, l); LAUNCH1(7, l); LAUNCH1(8, l); LAUNCH1(9, l); LAUNCH1(10, l); LAUNCH1(11, l); LAUNCH1(12, l); }
#endif
#undef LAUNCH1
#endif
    const hipError_t le = hipPeekAtLastError();
    if (le != hipSuccess) fprintf(stderr, "kernel_launch: launch failed: %s\n", hipGetErrorName(le));
}
```

```cpp
#include <hip/hip_runtime.h>
#include <cstdio>
#include <cstdint>

#ifndef MK_N_LAUNCHES
#ifndef DBG_DUP
#define DBG_DUP -1
#endif
#define MK_N_LAUNCHES 1
#endif

#ifndef DBG_MIX0
#define DBG_MIX0 1.0f
#define DBG_MIX1 1.0f
#define DBG_PEER0 1.0f
#define DBG_PEER1 1.0f
#endif
#define LAS __attribute__((address_space(3)))
typedef unsigned short bf16_t;
typedef short bf16x8 __attribute__((ext_vector_type(8)));
typedef short s16x4 __attribute__((ext_vector_type(4)));
typedef float f32x4 __attribute__((ext_vector_type(4)));
typedef float f32x2 __attribute__((ext_vector_type(2)));
typedef float f32x16 __attribute__((ext_vector_type(16)));
typedef unsigned u32x4 __attribute__((ext_vector_type(4)));
typedef unsigned u32x2 __attribute__((ext_vector_type(2)));
typedef __bf16 bf2_t __attribute__((ext_vector_type(2)));

constexpr int DM = 2048, NBATCH = 2, SEQ = 8192, CTXL = 256, DEPTH = 2;
constexpr int RPB = SEQ + CTXL;
constexpr int TT = NBATCH * RPB;
constexpr int IN_COLS = 11872, NP = 12032;
constexpr int C_AQ = 0, C_AK = 1024, C_AV = 1280, C_LQ = 1536, C_LK = 2048, C_LV = 2560, C_LG = 3584, C_LRF = 4608, C_LRB = 4624,
              C_MCQ = 4640, C_MCKV = 5152, C_MKR = 5664, C_GA = 5728, C_GL = 7776, C_GM = 9824;
constexpr int NCH = RPB / 64;
constexpr int NEXP = 16384;
constexpr float NORM_EPS = 1e-6f;
constexpr int NTHREADS = 512;

constexpr size_t al256(size_t x) { return (x + 255) / 256 * 256; }
constexpr size_t WS_CTL   = 0;
constexpr size_t CTL_BYTES = 65536;
constexpr size_t WS_MODV  = WS_CTL + CTL_BYTES;
constexpr size_t WS_TABA  = al256(WS_MODV + (size_t)2 * 3 * 12288 * 4);
constexpr size_t WS_TABM  = WS_TABA + 2 * 128 * 32 * 4;
constexpr size_t WS_XS    = al256(WS_TABM + 2 * 128 * 16 * 4);
constexpr size_t WS_HB    = WS_XS + (size_t)TT * DM * 4;
constexpr size_t WS_P     = WS_HB + (size_t)TT * DM * 2;
constexpr size_t WS_MQ    = WS_P + (size_t)TT * NP * 2;
constexpr size_t WS_MKV   = WS_MQ + (size_t)TT * 1536 * 2;
constexpr size_t WS_OA    = WS_MKV + (size_t)TT * 2048 * 2;
constexpr size_t WS_OL    = WS_OA + (size_t)TT * 1024 * 2;
constexpr size_t WS_OM    = WS_OL + (size_t)TT * 1024 * 2;
constexpr size_t WS_WIN   = WS_OM + (size_t)TT * 1024 * 2;
constexpr size_t WS_WUQ   = WS_WIN + (size_t)NP * 2048 * 2;
constexpr size_t WS_WUKV  = WS_WUQ + (size_t)1536 * 512 * 2;
constexpr size_t WS_WBR   = WS_WUKV + (size_t)2048 * 512 * 2;
constexpr size_t WS_WOUT  = WS_WBR + (size_t)3 * 2048 * 1024 * 2;
constexpr size_t WS_WQ    = WS_WOUT + (size_t)2048 * 2048 * 2;
constexpr size_t WS_K1    = WS_WQ + (size_t)2048 * 2048 * 2;
constexpr size_t WS_K2    = WS_K1 + (size_t)8 * 128 * 128 * 2;
constexpr size_t WS_GST   = WS_K2 + (size_t)8 * 128 * 128 * 2;
constexpr size_t WS_GDEC  = WS_GST + (size_t)NBATCH * 2 * 4 * NCH * 32768 * 2;
constexpr size_t WS_END   = WS_GDEC + (size_t)NBATCH * 2 * 4 * NCH * 128 * 4;
constexpr size_t WS_Y     = WS_MKV;
constexpr size_t WS_PQ    = WS_OA;
constexpr size_t WS_U8    = WS_P;
constexpr size_t WS_V8    = WS_U8 + (size_t)NEXP * DM;
constexpr size_t WS_SCU   = WS_V8 + (size_t)NEXP * DM;
constexpr size_t WS_SCV   = WS_SCU + (size_t)NEXP * 4;
constexpr size_t WS_PIDX  = WS_SCV + (size_t)NEXP * 4;
constexpr size_t WS_PG    = WS_PIDX + (size_t)TT * 128 * 4;
static_assert(WS_PG + (size_t)TT * 128 * 4 <= WS_MQ, "PEER alias region overflows P");

__device__ __forceinline__ unsigned cvt_pk_bf16(float lo, float hi) { bf2_t v; v.x = (__bf16)lo; v.y = (__bf16)hi; return __builtin_bit_cast(unsigned, v); }
__device__ __forceinline__ bf16_t f2bf(float f) { return (bf16_t)(cvt_pk_bf16(f, 0.f) & 0xffffu); }
__device__ __forceinline__ float bf2f(bf16_t b) { return __uint_as_float(((unsigned)b) << 16); }
__device__ __forceinline__ float bflo(unsigned w) { return __uint_as_float(w << 16); }
__device__ __forceinline__ float bfhi(unsigned w) { return __uint_as_float(w & 0xffff0000u); }
__device__ __forceinline__ float wave_sum(float v) {
#pragma unroll
    for (int o = 32; o >= 1; o >>= 1) v += __shfl_xor(v, o);
    return v;
}
__device__ __forceinline__ float sigmoidf_(float x) { return 1.0f / (1.0f + __expf(-x)); }
__device__ __forceinline__ float siluf_(float x) { return x / (1.0f + __expf(-x)); }

#define XB_TMO      128
#define XB_XCNT(j)  (256  + 64 * (j))
#define XB_XSUB(j)  (1280 + 64 * (j))
#define XB_XGEN(j)  (2304 + 64 * (j))
#define XB_TOP      3328
#define XB_TOPGEN   3392
#define XCD_BAR_WORDS 3456
#define XB_SPIN_CAP (1u << 20)
__device__ __forceinline__ unsigned xb_ld(unsigned* p)              { return __hip_atomic_load(p, __ATOMIC_RELAXED, __HIP_MEMORY_SCOPE_AGENT); }
__device__ __forceinline__ unsigned xb_add(unsigned* p, unsigned v) { return __hip_atomic_fetch_add(p, v, __ATOMIC_RELAXED, __HIP_MEMORY_SCOPE_AGENT); }
__device__ __forceinline__ unsigned xb_xcc_id() { return (unsigned)__builtin_amdgcn_s_getreg((3 << 11) | 20) & 0xFu; }
#define XB_SPIN(cond, bar) do { unsigned _sp = 0; while (cond) { __builtin_amdgcn_s_sleep(1); \
    if ((++_sp & 255u) == 0u) { if (xb_ld(&(bar)[XB_TMO])) break; if (_sp > XB_SPIN_CAP) { atomicAdd(&(bar)[XB_TMO], 1u); break; } } } } while (0)
struct XcdBarrier { unsigned* bar; unsigned x; volatile LAS unsigned* st; };
__device__ __forceinline__ XcdBarrier xcd_barrier_post(unsigned* bar, volatile LAS unsigned* st) {
    XcdBarrier b; b.bar = bar; b.x = xb_xcc_id(); b.st = st;
    if (threadIdx.x == 0) (void)xb_add(&bar[XB_XCNT(b.x)], 1u);
    return b;
}
__device__ __forceinline__ void xcd_barrier_complete(unsigned* bar, unsigned x, unsigned& nloc, unsigned& nx) {
    const unsigned G = gridDim.x * gridDim.y * gridDim.z;
    unsigned sum, cnt, mine, sp = 0u;
    for (;;) {
        sum = 0u; cnt = 0u; mine = 0u;
#pragma unroll
        for (unsigned j = 0; j < 16; ++j) { const unsigned c = xb_ld(&bar[XB_XCNT(j)]); sum += c; cnt += (c > 0u) ? 1u : 0u; mine = (j == x) ? c : mine; }
        if (sum == G) break;
        __builtin_amdgcn_s_sleep(1);
        if ((++sp & 255u) == 0u) { if (xb_ld(&bar[XB_TMO])) break; if (sp > XB_SPIN_CAP) { atomicAdd(&bar[XB_TMO], 1u); break; } }
    }
    nloc = mine > 0u ? mine : 1u; nx = cnt > 0u ? cnt : 1u;
}
__device__ __forceinline__ void xcd_barrier(const XcdBarrier& b) {
    asm volatile("s_waitcnt vmcnt(0)" ::: "memory");
    __syncthreads();
    if (threadIdx.x == 0) {
        unsigned* bar = b.bar;
        __builtin_amdgcn_s_waitcnt(0);
        unsigned nloc = b.st[0], nx = b.st[1];
        if (nloc == 0u) { xcd_barrier_complete(bar, b.x, nloc, nx); b.st[0] = nloc; b.st[1] = nx; }
        const unsigned old = xb_add(&bar[XB_XSUB(b.x)], 1u);
        const unsigned gen = old / nloc;
        if (old + 1u == (gen + 1u) * nloc) {
            __builtin_amdgcn_fence(__ATOMIC_RELEASE, "agent");
            asm volatile("s_waitcnt vmcnt(0)" ::: "memory");
            const unsigned og = xb_add(&bar[XB_TOP], 1u);
            const unsigned tg = og / nx;
            if (og + 1u == (tg + 1u) * nx) xb_add(&bar[XB_TOPGEN], 1u);
            else XB_SPIN(xb_ld(&bar[XB_TOPGEN]) == tg, bar);
            __builtin_amdgcn_fence(__ATOMIC_ACQUIRE, "agent");
            xb_add(&bar[XB_XGEN(b.x)], 1u);
            asm volatile("s_waitcnt vmcnt(0)" ::: "memory");
        } else {
            XB_SPIN(xb_ld(&bar[XB_XGEN(b.x)]) == gen, bar);
            __builtin_amdgcn_fence(__ATOMIC_ACQUIRE, "agent");
            asm volatile("s_waitcnt vmcnt(0)" ::: "memory");
        }
    }
    __syncthreads();
}

namespace pg8 {
constexpr int BM = 256, BK = 64, HALF = 128, HTB = HALF * BK * 2, STAGE_BYTES = 8 * HTB, NXCD = 8, WGM = 8;
__host__ __device__ __forceinline__ int lds_byte(int r, int c) { const int st = (r >> 4) * 2 + (c >> 5), rr = r & 15, cc = c & 31, ob = rr * 64 + cc * 2; return st * 1024 + (ob ^ (((ob >> 9) & 1) << 5)); }
__host__ __device__ __forceinline__ void stage_rc(int b, int& R, int& C) { const int st = b / 1024, sb = b % 1024, swz = sb ^ (((sb >> 9) & 1) << 5); R = (st >> 1) * 16 + swz / 64; C = (st & 1) * 32 + (swz % 64) / 2; }
__host__ __device__ __forceinline__ int perm32(int rho) { const int n = rho >> 4, i = rho & 15; return 8 * (i >> 2) + 4 * n + (i & 3); }
struct Unit { int pm, pn; };
struct Gemm { const bf16_t* A; const bf16_t* Bt; int M, N, K, lda, ldb; };
struct StaticOrder {
    int nM, nN, nwg, G, c;
    __host__ __device__ void init(int M, int N, int G_, int c_) { nM = M / BM; nN = N / BM; nwg = nM * nN; G = G_; c = c_; }
    __host__ __device__ bool next(int i, Unit& u) const {
        const long L = (long)i * G + c; if (L >= nwg) return false;
        int wgid = (int)L; { const int q = nwg / NXCD, r = nwg % NXCD, xcd = wgid % NXCD, off = wgid / NXCD; wgid = (xcd < r ? xcd * (q + 1) : r * (q + 1) + (xcd - r) * q) + off; }
        const int nig = WGM * nN, gid = wgid / nig, fm = gid * WGM, gsz = (nM - fm) < WGM ? (nM - fm) : WGM;
        u.pm = fm + ((wgid % nig) % gsz); u.pn = (wgid % nig) / gsz; return true;
    }
};
struct EpiStoreBf16 {
    static constexpr bool PERM = true;
    bf16_t* O; int ldc;
    __device__ __forceinline__ void operator()(const f32x4 (&acc)[2][2][4][2], const Unit& u, int wr, int wc, int fr, int fq) const {
        const int row0 = u.pm * BM + wr * 64 + fr, col0 = u.pn * BM + wc * 32 + 8 * fq;
#pragma unroll
        for (int ai = 0; ai < 2; ++ai)
#pragma unroll
            for (int m = 0; m < 4; ++m) { bf16_t* rowp = O + (size_t)(row0 + ai * HALF + m * 16) * ldc + col0;
#pragma unroll
                for (int bj = 0; bj < 2; ++bj) { const f32x4 v0 = acc[ai][bj][m][0], v1 = acc[ai][bj][m][1];
                    u32x4 w; w.x = cvt_pk_bf16(v0[0], v0[1]); w.y = cvt_pk_bf16(v0[2], v0[3]); w.z = cvt_pk_bf16(v1[0], v1[1]); w.w = cvt_pk_bf16(v1[2], v1[3]);
                    *(u32x4*)(rowp + bj * HALF) = w; } }
    }
};
template <bool FIRST> struct EpiGate {
    static constexpr bool PERM = true;
    bf16_t* Y; int ldy; const bf16_t* Gt; int ldg;
    __device__ __forceinline__ void operator()(const f32x4 (&acc)[2][2][4][2], const Unit& u, int wr, int wc, int fr, int fq) const {
        const int row0 = u.pm * BM + wr * 64 + fr, col0 = u.pn * BM + wc * 32 + 8 * fq;
#pragma unroll
        for (int ai = 0; ai < 2; ++ai)
#pragma unroll
            for (int m = 0; m < 4; ++m) { const size_t r = (size_t)(row0 + ai * HALF + m * 16);
#pragma unroll
                for (int bj = 0; bj < 2; ++bj) { const f32x4 v0 = acc[ai][bj][m][0], v1 = acc[ai][bj][m][1];
                    const u32x4 g = *(const u32x4*)(Gt + r * ldg + col0 + bj * HALF);
                    float o[8];
                    o[0] = sigmoidf_(bflo(g.x)) * v0[0]; o[1] = sigmoidf_(bfhi(g.x)) * v0[1]; o[2] = sigmoidf_(bflo(g.y)) * v0[2]; o[3] = sigmoidf_(bfhi(g.y)) * v0[3];
                    o[4] = sigmoidf_(bflo(g.z)) * v1[0]; o[5] = sigmoidf_(bfhi(g.z)) * v1[1]; o[6] = sigmoidf_(bflo(g.w)) * v1[2]; o[7] = sigmoidf_(bfhi(g.w)) * v1[3];
                    bf16_t* yp = Y + r * ldy + col0 + bj * HALF;
                    if (!FIRST) { const u32x4 y = *(const u32x4*)yp;
                        o[0] += bflo(y.x); o[1] += bfhi(y.x); o[2] += bflo(y.y); o[3] += bfhi(y.y); o[4] += bflo(y.z); o[5] += bfhi(y.z); o[6] += bflo(y.w); o[7] += bfhi(y.w); }
                    u32x4 w; w.x = cvt_pk_bf16(o[0], o[1]); w.y = cvt_pk_bf16(o[2], o[3]); w.z = cvt_pk_bf16(o[4], o[5]); w.w = cvt_pk_bf16(o[6], o[7]);
                    *(u32x4*)yp = w; } }
    }
};
struct EpiResid {
    static constexpr bool PERM = false;
    float* X; int ldx; const float* gate; float gscale;
    __device__ __forceinline__ void operator()(const f32x4 (&acc)[2][2][4][2], const Unit& u, int wr, int wc, int fr, int fq) const {
        const int row0 = u.pm * BM + wr * 64 + fr, col0 = u.pn * BM + wc * 32 + 4 * fq;
        const int sel = (u.pm % 33 == 0) ? 2 : (u.pm / 33);
        const float* gp = gate + (size_t)sel * 12288 + col0;
        f32x4 gv[2][2];
#pragma unroll
        for (int bj = 0; bj < 2; ++bj)
#pragma unroll
            for (int n = 0; n < 2; ++n) gv[bj][n] = *(const f32x4*)(gp + bj * HALF + n * 16) * gscale;
#pragma unroll
        for (int ai = 0; ai < 2; ++ai)
#pragma unroll
            for (int m = 0; m < 4; ++m) { float* rowp = X + (size_t)(row0 + ai * HALF + m * 16) * ldx + col0;
#pragma unroll
                for (int bj = 0; bj < 2; ++bj)
#pragma unroll
                    for (int n = 0; n < 2; ++n) { f32x4* p = (f32x4*)(rowp + bj * HALF + n * 16); *p = *p + gv[bj][n] * acc[ai][bj][m][n]; } }
    }
};

template <class Epi, class Sched>
__device__ __forceinline__ void gemm_phase(LAS unsigned char* lds, const int tid, const Gemm g, const Sched& S, const Epi& E) {
    const int wid = __builtin_amdgcn_readfirstlane(tid >> 6), lane = tid & 63, wr = wid >> 2, wc = wid & 3, fr = lane & 15, fq = lane >> 4;
    const int K = g.K, nt = K / BK, lda = g.lda, ldb = g.ldb;
    unsigned voffA[2], voffB[2];
#pragma unroll
    for (int i = 0; i < 2; ++i) { int R, C; stage_rc(tid * 16 + i * 8192, R, C); const int Rb = Epi::PERM ? ((R & ~31) + perm32(R & 31)) : R;
        voffA[i] = (unsigned)(R * lda + C) * 2u; voffB[i] = (unsigned)(Rb * ldb + C) * 2u; }
    const size_t kstep = (size_t)(BK * 2);
    const size_t hstepA = (size_t)HALF * lda * 2, hstepB = (size_t)HALF * ldb * 2;
    const size_t tstepA = 2 * hstepA, tstepB = 2 * hstepB;
    const unsigned ldsw = (unsigned)wid * 1024u;
    const int aoff = lds_byte(wr * 64 + fr, fq * 8), boff = lds_byte(wc * 32 + fr, fq * 8);
#define PG8_SA(b, h) (((b) * 2 + (h)) * HTB)
#define PG8_SB(b, h) ((4 + (b) * 2 + (h)) * HTB)
#define PG8_STAGE(bufoff, gbase, voff) do { _Pragma("unroll") for (int _i = 0; _i < 2; ++_i) \
        __builtin_amdgcn_global_load_lds((const unsigned*)((const char*)(gbase) + (voff)[_i]), (LAS unsigned*)(lds + (bufoff) + ldsw + _i * 8192), 16, 0, 0); } while (0)
#define PG8_LDA(dst, b, h) do { _Pragma("unroll") for (int m = 0; m < 4; ++m) _Pragma("unroll") for (int k = 0; k < 2; ++k) dst[m][k] = *(const LAS bf16x8*)(lds + PG8_SA(b, h) + aoff + m * 2048 + k * 1024); } while (0)
#define PG8_LDB(dst, b, h) do { _Pragma("unroll") for (int n = 0; n < 2; ++n) _Pragma("unroll") for (int k = 0; k < 2; ++k) dst[n][k] = *(const LAS bf16x8*)(lds + PG8_SB(b, h) + boff + n * 2048 + k * 1024); } while (0)
#define PG8_MMA(ai, bj, At, Bt) do { __builtin_amdgcn_s_setprio(1); _Pragma("unroll") for (int m = 0; m < 4; ++m) _Pragma("unroll") for (int n = 0; n < 2; ++n) _Pragma("unroll") for (int k = 0; k < 2; ++k) \
        acc[ai][bj][m][n] = __builtin_amdgcn_mfma_f32_16x16x32_bf16(Bt[n][k], At[m][k], acc[ai][bj][m][n], 0, 0, 0); __builtin_amdgcn_s_setprio(0); } while (0)
#define PG8_WAIT_V(n) asm volatile("s_waitcnt vmcnt(" #n ")" ::: "memory")
#define PG8_WAIT_L(n) asm volatile("s_waitcnt lgkmcnt(" #n ")" ::: "memory")
#define PG8_BAR __builtin_amdgcn_s_barrier()
#define PG8_SCHED __builtin_amdgcn_sched_barrier(0)
    Unit cur, nxt; int ui = 0;
    if (!S.next(0, cur)) return;
    f32x4 acc[2][2][4][2];
#pragma unroll
    for (int a = 0; a < 2; ++a)
#pragma unroll
        for (int b = 0; b < 2; ++b)
#pragma unroll
            for (int m = 0; m < 4; ++m)
#pragma unroll
                for (int n = 0; n < 2; ++n) acc[a][b][m][n] = (f32x4){0.f, 0.f, 0.f, 0.f};
    bf16x8 At[4][2], B0[2][2], B1[2][2];
    const char* cA = (const char*)g.A + (size_t)cur.pm * tstepA; const char* cB = (const char*)g.Bt + (size_t)cur.pn * tstepB;
    PG8_STAGE(PG8_SB(0, 0), cB, voffB); PG8_STAGE(PG8_SA(0, 0), cA, voffA); PG8_STAGE(PG8_SB(0, 1), cB + hstepB, voffB); PG8_STAGE(PG8_SA(0, 1), cA + hstepA, voffA);
    if (wr == 1) PG8_BAR;
    PG8_WAIT_V(4); PG8_BAR;
    PG8_STAGE(PG8_SB(1, 0), cB + kstep, voffB); PG8_STAGE(PG8_SA(1, 0), cA + kstep, voffA); PG8_STAGE(PG8_SB(1, 1), cB + hstepB + kstep, voffB);
    PG8_WAIT_V(6); PG8_BAR;
    for (;;) {
        const bool has_next = S.next(ui + 1, nxt);
        const char* nA = has_next ? (const char*)g.A + (size_t)nxt.pm * tstepA : cA; const char* nB = has_next ? (const char*)g.Bt + (size_t)nxt.pn * tstepB : cB;
        for (int t = 0; t < nt; t += 2) {
            const bool last = (t == nt - 2);
            const char* a1 = cA + (size_t)(t + 1) * kstep;
            const char* a2 = last ? nA : cA + (size_t)(t + 2) * kstep; const char* b2 = last ? nB : cB + (size_t)(t + 2) * kstep;
            const char* a3 = a2 + kstep; const char* b3 = b2 + kstep;
            PG8_LDB(B0, 0, 0); PG8_SCHED; PG8_LDA(At, 0, 0); PG8_STAGE(PG8_SA(1, 1), a1 + hstepA, voffA);
            PG8_WAIT_L(8); PG8_BAR; PG8_WAIT_L(0); PG8_MMA(0, 0, At, B0); PG8_BAR; PG8_SCHED;
            PG8_LDB(B1, 0, 1); PG8_STAGE(PG8_SB(0, 0), b2, voffB);
            PG8_BAR; PG8_WAIT_L(0); PG8_MMA(0, 1, At, B1); PG8_BAR;
            PG8_LDA(At, 0, 1); PG8_STAGE(PG8_SA(0, 0), a2, voffA);
            PG8_BAR; PG8_WAIT_L(0); PG8_MMA(1, 0, At, B0); PG8_BAR; PG8_SCHED;
            PG8_STAGE(PG8_SB(0, 1), b2 + hstepB, voffB);
            PG8_WAIT_V(6); PG8_BAR; PG8_MMA(1, 1, At, B1); PG8_BAR;
            PG8_LDB(B0, 1, 0); PG8_SCHED; PG8_LDA(At, 1, 0); PG8_STAGE(PG8_SA(0, 1), a2 + hstepA, voffA);
            PG8_WAIT_L(8); PG8_BAR; PG8_WAIT_L(0); PG8_MMA(0, 0, At, B0); PG8_BAR; PG8_SCHED;
            PG8_LDB(B1, 1, 1); PG8_STAGE(PG8_SB(1, 0), b3, voffB);
            PG8_BAR; PG8_WAIT_L(0); PG8_MMA(0, 1, At, B1); PG8_BAR;
            PG8_LDA(At, 1, 1); PG8_STAGE(PG8_SA(1, 0), a3, voffA);
            PG8_BAR; PG8_WAIT_L(0); PG8_MMA(1, 0, At, B0); PG8_BAR; PG8_SCHED;
            PG8_STAGE(PG8_SB(1, 1), b3 + hstepB, voffB);
            PG8_WAIT_V(6); PG8_BAR; PG8_MMA(1, 1, At, B1); PG8_BAR;
        }
        E(acc, cur, wr, wc, fr, fq);
        if (!has_next) break;
#pragma unroll
        for (int a = 0; a < 2; ++a)
#pragma unroll
            for (int b = 0; b < 2; ++b)
#pragma unroll
                for (int m = 0; m < 4; ++m)
#pragma unroll
                    for (int n = 0; n < 2; ++n) acc[a][b][m][n] = (f32x4){0.f, 0.f, 0.f, 0.f};
        cur = nxt; cA = nA; cB = nB; ++ui;
    }
    PG8_WAIT_V(0);
    if (wr == 0) PG8_BAR;
    PG8_BAR;
#undef PG8_SA
#undef PG8_SB
#undef PG8_STAGE
#undef PG8_LDA
#undef PG8_LDB
#undef PG8_MMA
#undef PG8_WAIT_V
#undef PG8_WAIT_L
#undef PG8_BAR
#undef PG8_SCHED
}
}

struct Args { const float* in[30]; float* out; unsigned char* ws; int ph_lo, ph_hi; };
enum { I_X = 0, I_C, I_CTX, I_CCTX, I_WMOD, I_BMOD, I_N1G, I_WIN, I_QNG, I_KNG, I_WA2F, I_BAF, I_WA2B, I_BAB, I_ONG, I_MQNG, I_WUQ, I_MKVNG, I_WUKV,
       I_WBRA, I_WBRL, I_WBRM, I_WOUT, I_N2G, I_PWQ, I_PK1, I_PK2, I_PU, I_PV, I_FG };
typedef const float* cfp_t;
struct Ctx {
    const __attribute__((address_space(4))) cfp_t* in; float* out; unsigned char* ws; LAS unsigned char* lds;
    int tid, lane, wid, G, bid;
};
#define WSP(T, off) ((T*)(C.ws + (off)))
#define INP(i) (C.in[(i)])
__device__ __forceinline__ unsigned long long launder_u64(unsigned long long w) {
    unsigned lo = (unsigned)w, hi = (unsigned)(w >> 32); asm volatile("" : "+v"(lo), "+v"(hi));
    lo = __builtin_amdgcn_readfirstlane(lo); hi = __builtin_amdgcn_readfirstlane(hi); return ((unsigned long long)hi << 32) | lo;
}
__device__ __forceinline__ Ctx launder(const Ctx& C0) {
    Ctx R = C0; int t = C0.tid; asm volatile("" : "+v"(t)); R.tid = t; R.lane = t & 63; R.wid = __builtin_amdgcn_readfirstlane(t >> 6);
    R.ws = (unsigned char*)launder_u64((unsigned long long)C0.ws);
    R.in = (const __attribute__((address_space(4))) cfp_t*)launder_u64((unsigned long long)C0.in);
    unsigned l = (unsigned)(uintptr_t)C0.lds; asm volatile("" : "+v"(l)); l = __builtin_amdgcn_readfirstlane(l); R.lds = (LAS unsigned char*)(uintptr_t)l;
    return R;
}

__device__ __forceinline__ const float* src_row(const Ctx& C, int r) {
    const int b = r / RPB, j = r % RPB;
    return j < CTXL ? INP(I_CTX) + ((size_t)b * CTXL + j) * DM : INP(I_X) + ((size_t)b * SEQ + (j - CTXL)) * DM;
}
__device__ __forceinline__ int mod_sel(int r) { const int b = r / RPB, j = r % RPB; return j < CTXL ? 2 : b; }

__device__ __forceinline__ void phase_modv(const Ctx& C) {
    LAS float* sc = (LAS float*)C.lds;
    LAS float* red = (LAS float*)(C.lds + 3 * 2048 * 4);
    for (int i = C.tid; i < 3 * DM; i += NTHREADS) { const int r = i / DM, k = i % DM; const float v = r < 2 ? INP(I_C)[r * DM + k] : INP(I_CCTX)[k]; sc[i] = siluf_(v); }
    __syncthreads();
    float* modv = WSP(float, WS_MODV);
    const int kq = C.tid / 12, c4 = C.tid % 12;
    for (int item = C.bid; item < 2 * 256; item += C.G) {
        const int l = item / 256, cg = item % 256;
        float acc[3][4];
#pragma unroll
        for (int r = 0; r < 3; ++r)
#pragma unroll
            for (int j = 0; j < 4; ++j) acc[r][j] = 0.f;
        if (kq < 42) {
            const float* wp = INP(I_WMOD) + (size_t)l * DM * 12288 + 48 * cg + 4 * c4;
            for (int k = kq; k < DM; k += 42) {
                const f32x4 w = *(const f32x4*)(wp + (size_t)k * 12288);
#pragma unroll
                for (int r = 0; r < 3; ++r) { const float s = sc[r * DM + k];
#pragma unroll
                    for (int j = 0; j < 4; ++j) acc[r][j] += s * w[j]; }
            }
#pragma unroll
            for (int r = 0; r < 3; ++r)
#pragma unroll
                for (int j = 0; j < 4; ++j) red[kq * 144 + r * 48 + c4 * 4 + j] = acc[r][j];
        }
        __syncthreads();
        if (C.tid < 144) { float s = 0.f; for (int q = 0; q < 42; ++q) s += red[q * 144 + C.tid];
            const int r = C.tid / 48, cc = C.tid % 48;
            modv[((size_t)l * 3 + r) * 12288 + 48 * cg + cc] = s + INP(I_BMOD)[(size_t)l * 12288 + 48 * cg + cc]; }
        __syncthreads();
    }
}
__device__ __forceinline__ void phase_tables(const Ctx& C) {
    float* ta = WSP(float, WS_TABA); float* tm = WSP(float, WS_TABM);
    for (int i = C.bid * NTHREADS + C.tid; i < 128 * 32 + 128 * 16; i += C.G * NTHREADS) {
        if (i < 128 * 32) { const int pos = i / 32, f = i % 32; const float inv = exp2f(-(float)f * (13.287712379549449f / 32.0f)); const float a = (float)pos * inv;
            ta[i] = cosf(a); ta[128 * 32 + i] = sinf(a); }
        else { const int k = i - 128 * 32, pos = k / 16, f = k % 16; const float inv = exp2f(-(float)f * (13.287712379549449f / 16.0f)); const float a = (float)pos * inv;
            tm[k] = cosf(a); tm[128 * 16 + k] = sinf(a); }
    }
}
__device__ __forceinline__ void transpose_cvt(const Ctx& C, const float* src, int K, int N, bf16_t* dst, int Npad, int& item) {
    LAS float* tile = (LAS float*)C.lds;
    const int tk = K / 64, tn = Npad / 64, ntile = tk * tn;
    const int t0 = ((C.bid - item % C.G) + C.G) % C.G; item += ntile;
    for (int t = t0; t < ntile; t += C.G) {
        const int k0 = (t / tn) * 64, n0 = (t % tn) * 64;
#pragma unroll
        for (int p = 0; p < 2; ++p) { const int kk = (C.tid >> 4) + p * 32, nn = (C.tid & 15) * 4;
            f32x4 v = (f32x4){0.f, 0.f, 0.f, 0.f};
            if (n0 + nn < N) v = *(const f32x4*)(src + (size_t)(k0 + kk) * N + n0 + nn);
#pragma unroll
            for (int j = 0; j < 4; ++j) tile[kk * 65 + nn + j] = v[j]; }
        __syncthreads();
        { const int n = C.tid >> 3, k8 = (C.tid & 7) * 8; float v[8];
#pragma unroll
          for (int j = 0; j < 8; ++j) v[j] = tile[(k8 + j) * 65 + n];
          u32x4 w; w.x = cvt_pk_bf16(v[0], v[1]); w.y = cvt_pk_bf16(v[2], v[3]); w.z = cvt_pk_bf16(v[4], v[5]); w.w = cvt_pk_bf16(v[6], v[7]);
          *(u32x4*)(dst + (size_t)(n0 + n) * K + k0 + k8) = w; }
        __syncthreads();
    }
}
__device__ __forceinline__ void cvt_plain(const Ctx& C, const float* src, bf16_t* dst, size_t n8) {
    for (size_t i = (size_t)C.bid * NTHREADS + C.tid; i < n8; i += (size_t)C.G * NTHREADS) {
        const f32x4 a = *(const f32x4*)(src + i * 8), b = *(const f32x4*)(src + i * 8 + 4);
        u32x4 w; w.x = cvt_pk_bf16(a[0], a[1]); w.y = cvt_pk_bf16(a[2], a[3]); w.z = cvt_pk_bf16(b[0], b[1]); w.w = cvt_pk_bf16(b[2], b[3]);
        *(u32x4*)(dst + i * 8) = w;
    }
}
__device__ __forceinline__ void phase_cvt_mixer_weights(const Ctx& C, int l) {
    int item = 0;
    transpose_cvt(C, INP(I_WIN) + (size_t)l * DM * IN_COLS, DM, IN_COLS, WSP(bf16_t, WS_WIN), NP, item);
    transpose_cvt(C, INP(I_WUQ) + (size_t)l * 512 * 1536, 512, 1536, WSP(bf16_t, WS_WUQ), 1536, item);
    transpose_cvt(C, INP(I_WUKV) + (size_t)l * 512 * 2048, 512, 2048, WSP(bf16_t, WS_WUKV), 2048, item);
    transpose_cvt(C, INP(I_WBRA) + (size_t)l * 1024 * 2048, 1024, 2048, WSP(bf16_t, WS_WBR), 2048, item);
    transpose_cvt(C, INP(I_WBRL) + (size_t)l * 1024 * 2048, 1024, 2048, WSP(bf16_t, WS_WBR) + (size_t)2048 * 1024, 2048, item);
    transpose_cvt(C, INP(I_WBRM) + (size_t)l * 1024 * 2048, 1024, 2048, WSP(bf16_t, WS_WBR) + (size_t)2 * 2048 * 1024, 2048, item);
    transpose_cvt(C, INP(I_WOUT) + (size_t)l * 2048 * 2048, 2048, 2048, WSP(bf16_t, WS_WOUT), 2048, item);
    transpose_cvt(C, INP(I_PWQ) + (size_t)l * 2048 * 2048, 2048, 2048, WSP(bf16_t, WS_WQ), 2048, item);
    cvt_plain(C, INP(I_PK1) + (size_t)l * 8 * 128 * 128, WSP(bf16_t, WS_K1), 8 * 128 * 128 / 8);
    cvt_plain(C, INP(I_PK2) + (size_t)l * 8 * 128 * 128, WSP(bf16_t, WS_K2), 8 * 128 * 128 / 8);
}
__device__ __forceinline__ void phase_cvt_peer_tables(const Ctx& C, int l) {
    const int lane = C.lane;
    for (int row = C.bid * 8 + C.wid; row < NEXP; row += C.G * 8) {
#pragma unroll 1
        for (int tb = 0; tb < 2; ++tb) {
            const float* src = (tb ? INP(I_PV) : INP(I_PU)) + ((size_t)l * NEXP + row) * DM + lane * 16;
            f32x4 x[8]; float amax = 0.f;
#pragma unroll
            for (int c = 0; c < 2; ++c)
#pragma unroll
                for (int q = 0; q < 4; ++q) { x[c * 4 + q] = *(const f32x4*)(src + c * 1024 + q * 4);
                    amax = fmaxf(amax, fmaxf(fmaxf(fabsf(x[c * 4 + q][0]), fabsf(x[c * 4 + q][1])), fmaxf(fabsf(x[c * 4 + q][2]), fabsf(x[c * 4 + q][3])))); }
#pragma unroll
            for (int o = 32; o >= 1; o >>= 1) amax = fmaxf(amax, __shfl_xor(amax, o));
            const float sc = amax > 0.f ? 224.0f / amax : 1.0f, inv = amax > 0.f ? amax * (1.0f / 224.0f) : 1.0f;
            unsigned char* dst = C.ws + (tb ? WS_V8 : WS_U8) + (size_t)(lane >> 3) * ((size_t)NEXP * 128) + (size_t)row * 128 + (lane & 7) * 16;
#pragma unroll
            for (int c = 0; c < 2; ++c) { u32x4 w;
#pragma unroll
                for (int q = 0; q < 4; ++q) { const f32x4 v = x[c * 4 + q] * sc; int p = __builtin_amdgcn_cvt_pk_fp8_f32(v[0], v[1], 0, false); p = __builtin_amdgcn_cvt_pk_fp8_f32(v[2], v[3], p, true); w[q] = (unsigned)p; }
                *(u32x4*)(dst + (size_t)c * 8 * ((size_t)NEXP * 128)) = w; }
            if (lane == 0) WSP(float, tb ? WS_SCV : WS_SCU)[row] = inv;
        }
    }
}

template <bool FIRST> __device__ __forceinline__ void phase_norm_mod(const Ctx& C, const float* gvec, const float* modl  , int shift_off, int scale_off) {
    float* xs = WSP(float, WS_XS); bf16_t* hb = WSP(bf16_t, WS_HB);
    for (int r = C.bid * 8 + C.wid; r < TT; r += C.G * 8) {
        const float* xr = FIRST ? src_row(C, r) : xs + (size_t)r * DM;
        const float* mv = modl + (size_t)mod_sel(r) * 12288;
        f32x4 v[8]; float ss = 0.f;
#pragma unroll
        for (int c = 0; c < 4; ++c) { v[2 * c] = *(const f32x4*)(xr + c * 512 + C.lane * 8); v[2 * c + 1] = *(const f32x4*)(xr + c * 512 + C.lane * 8 + 4); }
#pragma unroll
        for (int c = 0; c < 8; ++c) ss += v[c][0] * v[c][0] + v[c][1] * v[c][1] + v[c][2] * v[c][2] + v[c][3] * v[c][3];
        ss = wave_sum(ss);
        const float rs = rsqrtf(ss * (1.0f / DM) + NORM_EPS);
#pragma unroll
        for (int c = 0; c < 4; ++c) { const int col = c * 512 + C.lane * 8;
            if (FIRST) { *(f32x4*)(xs + (size_t)r * DM + col) = v[2 * c]; *(f32x4*)(xs + (size_t)r * DM + col + 4) = v[2 * c + 1]; }
            float o[8];
#pragma unroll
            for (int h = 0; h < 2; ++h) { const f32x4 g = *(const f32x4*)(gvec + col + 4 * h), s = *(const f32x4*)(mv + scale_off + col + 4 * h), t = *(const f32x4*)(mv + shift_off + col + 4 * h);
#pragma unroll
                for (int j = 0; j < 4; ++j) o[4 * h + j] = v[2 * c + h][j] * rs * g[j] * (1.0f + s[j]) + t[j]; }
            u32x4 w; w.x = cvt_pk_bf16(o[0], o[1]); w.y = cvt_pk_bf16(o[2], o[3]); w.z = cvt_pk_bf16(o[4], o[5]); w.w = cvt_pk_bf16(o[6], o[7]);
            *(u32x4*)(hb + (size_t)r * DM + col) = w; }
    }
}

__device__ __forceinline__ void phase_post_p(const Ctx& C, int l) {
    bf16_t* P = WSP(bf16_t, WS_P); const float* ta = WSP(float, WS_TABA); const float* tm = WSP(float, WS_TABM);
    const float* qg = INP(I_QNG) + l * 128; const float* kg = INP(I_KNG) + l * 128;
    const float* mqg = INP(I_MQNG) + l * 512; const float* mkvg = INP(I_MKVNG) + l * 512;
    const int lane = C.lane;
    const float qg1 = qg[lane], qg2 = qg[lane + 64], kg1 = kg[lane], kg2 = kg[lane + 64];
    for (int r = C.bid * 8 + C.wid; r < TT; r += C.G * 8) {
        bf16_t* pr = P + (size_t)r * NP;
        const int j = r % RPB; const bool lat = j >= CTXL; const int pos = lat ? j - CTXL : 0, ri = pos >> 6, ci = pos & 63;
        float cs = 1.f, sn = 0.f;
        if (lat) { const int p = lane < 32 ? ri : ci, f = lane & 31; cs = ta[p * 32 + f]; sn = ta[128 * 32 + p * 32 + f]; }
#pragma unroll
        for (int h = 0; h < 10; ++h) {
            bf16_t* hp = pr + (h < 8 ? C_AQ + h * 128 : C_AK + (h - 8) * 128);
            const float x1 = bf2f(hp[lane]), x2 = bf2f(hp[lane + 64]);
            const float ss = wave_sum(x1 * x1 + x2 * x2);
            const float rs = rsqrtf(ss * (1.0f / 128.0f) + NORM_EPS);
            const float y1 = x1 * rs * (h < 8 ? qg1 : kg1), y2 = x2 * rs * (h < 8 ? qg2 : kg2);
            hp[lane] = f2bf(y1 * cs - y2 * sn); hp[lane + 64] = f2bf(y2 * cs + y1 * sn);
        }
#pragma unroll
        for (int s = 0; s < 2; ++s) {
            bf16_t* sp = pr + (s == 0 ? C_MCQ : C_MCKV) + lane * 8; const float* gg = (s == 0 ? mqg : mkvg) + lane * 8;
            const u32x4 w = *(const u32x4*)sp; float x[8] = {bflo(w.x), bfhi(w.x), bflo(w.y), bfhi(w.y), bflo(w.z), bfhi(w.z), bflo(w.w), bfhi(w.w)};
            float ss = 0.f;
#pragma unroll
            for (int i = 0; i < 8; ++i) ss += x[i] * x[i];
            ss = wave_sum(ss);
            const float rs = rsqrtf(ss * (1.0f / 512.0f) + NORM_EPS);
#pragma unroll
            for (int i = 0; i < 8; ++i) x[i] = x[i] * rs * gg[i];
            u32x4 o; o.x = cvt_pk_bf16(x[0], x[1]); o.y = cvt_pk_bf16(x[2], x[3]); o.z = cvt_pk_bf16(x[4], x[5]); o.w = cvt_pk_bf16(x[6], x[7]);
            *(u32x4*)sp = o;
        }
        if (lat) { bf16_t* kp = pr + C_MKR; const int i = lane & 31; const float x1 = bf2f(kp[i]), x2 = bf2f(kp[i + 32]);
            const int p = i < 16 ? ri : ci, f = i & 15; const float c2 = tm[p * 16 + f], s2 = tm[128 * 16 + p * 16 + f];
            if (lane < 32) { kp[i] = f2bf(x1 * c2 - x2 * s2); kp[i + 32] = f2bf(x2 * c2 + x1 * s2); } }
    }
}

namespace att {
constexpr int NW = 8, QBLK = 32, KVBLK = 64, DV = 128;
constexpr float THR = 8.f;
#define SBAR() __builtin_amdgcn_sched_barrier(0)
__device__ __forceinline__ int crow(int r, int hi) { return (r & 3) + 8 * (r >> 2) + 4 * hi; }
template <int DQ> struct Cf {
    static constexpr int ND0 = DQ / 16, KROWB = DQ * 2, SHM_K = KVBLK * DQ * 2, SHM_V = KVBLK * DV * 2, SHM = 2 * SHM_V + 2 * SHM_K + NW * 64 * 4;
    static constexpr float SCALE = DQ == 128 ? 0.088388347648318440f : 0.072168783648703220f;
    __device__ static __forceinline__ int kswz(int row, int colB) { return row * KROWB + (colB ^ ((row & 7) << 4)); }
};
template <int DQ> __device__ __forceinline__ void partialSM(f32x16& p0, f32x16& p1, float& m_reg, float& mn, float& alpha) {
    constexpr float SC = Cf<DQ>::SCALE, Cc = SC * 1.4426950408889634f;
    float pmax = p0[0];
#pragma unroll
    for (int r = 1; r < 16; ++r) pmax = fmaxf(pmax, p0[r]);
#pragma unroll
    for (int r = 0; r < 16; ++r) pmax = fmaxf(pmax, p1[r]);
    { auto rr = __builtin_amdgcn_permlane32_swap(__float_as_uint(pmax), __float_as_uint(pmax), false, false);
      pmax = fmaxf(__uint_as_float(rr[0]), __uint_as_float(rr[1])); }
    if (__builtin_expect(__all(pmax - m_reg <= THR / SC), 1)) { mn = m_reg; alpha = 1.f; }
    else { mn = fmaxf(m_reg, pmax); alpha = __builtin_amdgcn_exp2f((m_reg - mn) * Cc); m_reg = mn; }
    const float mnC = -mn * Cc;
#pragma unroll
    for (int r = 0; r < 16; ++r) p0[r] = fmaf(p0[r], Cc, mnC);
#pragma unroll
    for (int r = 0; r < 16; ++r) p1[r] = fmaf(p1[r], Cc, mnC);
#pragma unroll
    for (int r = 0; r < 16; ++r) p0[r] = __builtin_amdgcn_exp2f(p0[r]);
}
__device__ __forceinline__ void finishSM(f32x16& p0, f32x16& p1, float alpha, float& l_reg, bf16x8& pa0, bf16x8& pa1, bf16x8& pa2, bf16x8& pa3) {
#pragma unroll
    for (int r = 0; r < 16; ++r) p1[r] = __builtin_amdgcn_exp2f(p1[r]);
    float ps = 0;
#pragma unroll
    for (int r = 0; r < 16; ++r) ps += p0[r];
#pragma unroll
    for (int r = 0; r < 16; ++r) ps += p1[r];
    { auto rr = __builtin_amdgcn_permlane32_swap(__float_as_uint(ps), __float_as_uint(ps), false, false);
      ps = __uint_as_float(rr[0]) + __uint_as_float(rr[1]); }
    l_reg = l_reg * alpha + ps;
#define PK4(P, BASE, OUT) do { unsigned a0 = cvt_pk_bf16(P[BASE + 0], P[BASE + 1]), a1 = cvt_pk_bf16(P[BASE + 2], P[BASE + 3]);   \
    unsigned b0 = cvt_pk_bf16(P[BASE + 4], P[BASE + 5]), b1 = cvt_pk_bf16(P[BASE + 6], P[BASE + 7]);                              \
    auto r0 = __builtin_amdgcn_permlane32_swap(a0, b0, false, false); auto r1 = __builtin_amdgcn_permlane32_swap(a1, b1, false, false); \
    u32x4 w = {r0[0], r1[0], r0[1], r1[1]}; OUT = *reinterpret_cast<bf16x8*>(&w); } while (0)
    PK4(p0, 0, pa0); PK4(p0, 8, pa1); PK4(p1, 0, pa2); PK4(p1, 8, pa3);
#undef PK4
}
template <int DQ> __device__ __forceinline__ void qkt(f32x16& p0, f32x16& p1, const char* Ks, const bf16x8* qr, const char* qx, int r32, int hi) {
    p0 = f32x16{}; p1 = f32x16{};
#pragma unroll
    for (int d0 = 0; d0 < Cf<DQ>::ND0; ++d0) { const int cb = (d0 * 16 + hi * 8) * 2;
        const bf16x8 b0 = *reinterpret_cast<const bf16x8*>(Ks + Cf<DQ>::kswz(r32, cb));
        const bf16x8 b1 = *reinterpret_cast<const bf16x8*>(Ks + Cf<DQ>::kswz(32 + r32, cb));
        constexpr int NQR = DQ == 192 ? 4 : 8;
        bf16x8 q; if (d0 < NQR) q = qr[d0]; else q = *reinterpret_cast<const bf16x8*>(qx + (d0 - NQR) * 1024);
        p0 = __builtin_amdgcn_mfma_f32_32x32x16_bf16(b0, q, p0, 0, 0, 0);
        p1 = __builtin_amdgcn_mfma_f32_32x32x16_bf16(b1, q, p1, 0, 0, 0); }
}
__device__ __forceinline__ int v_st(int k, int c) { const int kk = (k & ~0xC) | ((k & 4) << 1) | ((k & 8) >> 1); return ((kk >> 3) * 4 + (c >> 5)) * 512 + ((kk & 7) * 32 + (c & 31)) * 2; }
__device__ __forceinline__ int v_rd_base(int lane) { return ((lane & 3) << 3) | (((lane >> 2) & 3) << 6) | (((lane >> 4) & 1) << 5) | (((lane >> 5) & 1) << 8); }
constexpr int v_rd_off(int d0, int ks, int half) { return d0 * 512 + ks * 4096 + half * 2048; }
template <int OFF> __device__ __forceinline__ s16x4 tr_read(int vb) {
    s16x4 r; asm volatile("ds_read_b64_tr_b16 %0, %1 offset:%2" : "=&v"(r) : "v"(vb), "i"(OFF) : "memory"); return r;
}
template <int D0> __device__ __forceinline__ void pv_one(f32x16& od, int vb, bf16x8 pa0, bf16x8 pa1, bf16x8 pa2, bf16x8 pa3) {
    const s16x4 l0 = tr_read<v_rd_off(D0, 0, 0)>(vb), h0 = tr_read<v_rd_off(D0, 0, 1)>(vb), l1 = tr_read<v_rd_off(D0, 1, 0)>(vb), h1 = tr_read<v_rd_off(D0, 1, 1)>(vb);
    const s16x4 l2 = tr_read<v_rd_off(D0, 2, 0)>(vb), h2 = tr_read<v_rd_off(D0, 2, 1)>(vb), l3 = tr_read<v_rd_off(D0, 3, 0)>(vb), h3 = tr_read<v_rd_off(D0, 3, 1)>(vb);
    asm volatile("s_waitcnt lgkmcnt(0)" ::: "memory"); SBAR();
#define PK(L, H) (bf16x8){L[0], L[1], L[2], L[3], H[0], H[1], H[2], H[3]}
    od = __builtin_amdgcn_mfma_f32_32x32x16_bf16(pa0, PK(l0, h0), od, 0, 0, 0);
    od = __builtin_amdgcn_mfma_f32_32x32x16_bf16(pa1, PK(l1, h1), od, 0, 0, 0);
    od = __builtin_amdgcn_mfma_f32_32x32x16_bf16(pa2, PK(l2, h2), od, 0, 0, 0);
    od = __builtin_amdgcn_mfma_f32_32x32x16_bf16(pa3, PK(l3, h3), od, 0, 0, 0);
#undef PK
}
__device__ __forceinline__ void pv_d0(f32x16* o, int vb, bf16x8 pa0, bf16x8 pa1, bf16x8 pa2, bf16x8 pa3) {
    pv_one<0>(o[0], vb, pa0, pa1, pa2, pa3); pv_one<1>(o[1], vb, pa0, pa1, pa2, pa3); pv_one<2>(o[2], vb, pa0, pa1, pa2, pa3); pv_one<3>(o[3], vb, pa0, pa1, pa2, pa3);
}
__device__ __forceinline__ bf16x8 ld8(const bf16_t* p) { return *reinterpret_cast<const bf16x8*>(p); }

template <int DQ, int SD>
__device__ __forceinline__ void attn_body(const bf16_t* __restrict__ Qb, int ldq, const bf16_t* __restrict__ Kn, int ldkn, const bf16_t* __restrict__ Kr, int ldkr,
                                          const bf16_t* __restrict__ Vh, int ldv, bf16_t* __restrict__ Ob, int ldo, int seq, bool rope_q, int pos0, const float* __restrict__ tabM, char* lds, const int tid) {
    using CF = Cf<DQ>; constexpr int ND0 = CF::ND0, SHM_V = CF::SHM_V, SHM_K = CF::SHM_K;
    const int wid = tid >> 6, lane = tid & 63, r32 = lane & 31, hi = lane >> 5;
    char* V_lds = lds; char* K_lds = lds + 2 * SHM_V;
    float* ws = (float*)(lds + 2 * SHM_V + 2 * SHM_K) + wid * 64; float* li_l = ws; float* al_l = ws + 32;
    constexpr int NQR = DQ == 192 ? 4 : 8;
    float m_reg = -1e30f, l_reg = 0; f32x16 o[4] = {}; bf16x8 qr[NQR];
    const bf16_t* Qw = Qb + (long)(wid * QBLK + r32) * ldq + hi * 8;
#pragma unroll
    for (int d0 = 0; d0 < NQR; ++d0) qr[d0] = ld8(Qw + d0 * 16);
    char* qx = lds + CF::SHM + wid * 8192 + lane * 16;
    if constexpr (DQ == 192) {
#pragma unroll
        for (int d0 = 4; d0 < 8; ++d0) *(bf16x8*)(qx + (d0 - 4) * 1024) = ld8(Qw + d0 * 16);
        bf16x8 qe[4];
#pragma unroll
        for (int d0 = 0; d0 < 4; ++d0) qe[d0] = ld8(Qw + (8 + d0) * 16);
        if (rope_q) {
            const int pos = pos0 + wid * QBLK + r32, ri = pos >> 6, ci = pos & 63;
#pragma unroll
            for (int t = 0; t < 2; ++t) { const int p = t == 0 ? ri : ci; const float* tc = tabM + p * 16 + hi * 8; const float* tsn = tabM + 128 * 16 + p * 16 + hi * 8;
                bf16x8 a = qe[t], b = qe[2 + t];
#pragma unroll
                for (int jj = 0; jj < 8; ++jj) { const float x1 = bf2f((bf16_t)a[jj]), x2 = bf2f((bf16_t)b[jj]), c = tc[jj], s = tsn[jj];
                    a[jj] = (short)f2bf(x1 * c - x2 * s); b[jj] = (short)f2bf(x2 * c + x1 * s); }
                qe[t] = a; qe[2 + t] = b; }
        }
#pragma unroll
        for (int d0 = 0; d0 < 4; ++d0) *(bf16x8*)(qx + (4 + d0) * 1024) = qe[d0];
    }
    const int sr = tid >> 4, sc = (tid & 15) * 8, vst0 = v_st(sr, sc), vst1 = v_st(32 + sr, sc);
    const int sr2 = tid >> 3, sc2 = (tid & 7) * 8;
    const int vb0 = (int)(uintptr_t)V_lds + v_rd_base(lane);
    struct { bf16x8 vs0, vs1, ks0, ks1, ks2; } sr_[SD];
    const unsigned offV = (unsigned)(sr * ldv + sc) * 2u, offK = (unsigned)(sr * ldkn + sc) * 2u, offR = (unsigned)(sr2 * ldkr + sc2) * 2u;
#define SLOAD(i, k0) do { const char* vt_ = (const char*)Vh + (size_t)(k0) * ldv * 2; const char* kt_ = (const char*)Kn + (size_t)(k0) * ldkn * 2; \
    sr_[i].vs0 = *(const bf16x8*)(vt_ + offV); sr_[i].vs1 = *(const bf16x8*)(vt_ + (size_t)32 * ldv * 2 + offV); \
    sr_[i].ks0 = *(const bf16x8*)(kt_ + offK); sr_[i].ks1 = *(const bf16x8*)(kt_ + (size_t)32 * ldkn * 2 + offK); \
    if constexpr (DQ == 192) sr_[i].ks2 = *(const bf16x8*)((const char*)Kr + (size_t)(k0) * ldkr * 2 + offR); } while (0)
#define SWRITE(b, i) do { *(bf16x8*)(V_lds + (b) * SHM_V + vst0) = sr_[i].vs0; *(bf16x8*)(V_lds + (b) * SHM_V + vst1) = sr_[i].vs1; const int kc = sc * 2; \
    *(bf16x8*)(K_lds + (b) * SHM_K + CF::kswz(sr, kc)) = sr_[i].ks0; *(bf16x8*)(K_lds + (b) * SHM_K + CF::kswz(32 + sr, kc)) = sr_[i].ks1; \
    if constexpr (DQ == 192) *(bf16x8*)(K_lds + (b) * SHM_K + CF::kswz(sr2, 256 + sc2 * 2)) = sr_[i].ks2; } while (0)
#define SWAIT() do { if constexpr (SD == 1) asm volatile("s_waitcnt vmcnt(0)" ::: "memory"); else if constexpr (DQ == 192) asm volatile("s_waitcnt vmcnt(5)" ::: "memory"); else asm volatile("s_waitcnt vmcnt(4)" ::: "memory"); } while (0)
#define RESC(a) do { if (__any((a) < 1.f)) { if (hi == 0) al_l[r32] = (a); asm volatile("s_waitcnt lgkmcnt(0)" ::: "memory"); \
    _Pragma("unroll") for (int d = 0; d < 4; ++d) _Pragma("unroll") for (int r = 0; r < 16; ++r) o[d][r] *= al_l[crow(r, hi)]; } } while (0)
    f32x16 pA0, pA1, pB0, pB1; float mnA, mnB, alA, alB; bf16x8 pa0, pa1, pa2, pa3; const int NT = seq / KVBLK;
    constexpr int SE = 0, SO = SD - 1;
    SLOAD(SE, 0); asm volatile("s_waitcnt vmcnt(0)" ::: "memory"); SWRITE(0, SE); __syncthreads();
    qkt<DQ>(pA0, pA1, K_lds, qr, qx, r32, hi); partialSM<DQ>(pA0, pA1, m_reg, mnA, alA);
    SLOAD(SO, KVBLK); if constexpr (SD == 2) { if (2 < NT) SLOAD(SE, 2 * KVBLK); }
    SWAIT(); SWRITE(1, SO); __syncthreads();
    for (int j = 1; j + 1 < NT; j += 2) {
        SBAR(); qkt<DQ>(pB0, pB1, K_lds + SHM_K, qr, qx, r32, hi);
        finishSM(pA0, pA1, alA, l_reg, pa0, pa1, pa2, pa3); SBAR();
        SLOAD(SO, (j + SD) * KVBLK); SBAR();
        pv_d0(o, vb0, pa0, pa1, pa2, pa3); partialSM<DQ>(pB0, pB1, m_reg, mnB, alB);
        __syncthreads(); SWAIT(); SWRITE(0, SE);
        RESC(alB); __syncthreads();
        SBAR(); qkt<DQ>(pA0, pA1, K_lds, qr, qx, r32, hi);
        finishSM(pB0, pB1, alB, l_reg, pa0, pa1, pa2, pa3); SBAR();
        if (SD == 1 || j + 3 < NT) SLOAD(SE, (j + 1 + SD) * KVBLK); SBAR();
        pv_d0(o, vb0 + SHM_V, pa0, pa1, pa2, pa3); partialSM<DQ>(pA0, pA1, m_reg, mnA, alA);
        __syncthreads(); SWAIT(); SWRITE(1, SO);
        RESC(alA); __syncthreads();
    }
    SBAR(); qkt<DQ>(pB0, pB1, K_lds + SHM_K, qr, qx, r32, hi);
    finishSM(pA0, pA1, alA, l_reg, pa0, pa1, pa2, pa3); SBAR();
    pv_d0(o, vb0, pa0, pa1, pa2, pa3); partialSM<DQ>(pB0, pB1, m_reg, mnB, alB);
    __syncthreads(); RESC(alB);
    finishSM(pB0, pB1, alB, l_reg, pa0, pa1, pa2, pa3); SBAR();
    pv_d0(o, vb0 + SHM_V, pa0, pa1, pa2, pa3);
    if (hi == 0) li_l[r32] = l_reg; asm volatile("s_waitcnt lgkmcnt(0)" ::: "memory");
    float rli[16];
#pragma unroll
    for (int r = 0; r < 16; ++r) rli[r] = __builtin_amdgcn_rcpf(li_l[crow(r, hi)]);
    bf16_t* Ow = Ob + (long)(wid * QBLK) * ldo;
#pragma unroll
    for (int r = 0; r < 16; ++r) { const int orow = crow(r, hi);
#pragma unroll
        for (int d0 = 0; d0 < 4; ++d0) Ow[(long)orow * ldo + d0 * 32 + r32] = f2bf(o[d0][r] * rli[r]); }
#undef SLOAD
#undef SWRITE
#undef SWAIT
#undef RESC
}
}

template <int KS> __device__ __forceinline__ void mma_xy(f32x16& acc, const LAS bf16_t* X, const LAS bf16_t* Y, int hi) {
#pragma unroll
    for (int ks = 0; ks < KS; ++ks) { const bf16x8 a = *(const LAS bf16x8*)(X + ks * 16 + hi * 8), b = *(const LAS bf16x8*)(Y + ks * 16 + hi * 8);
        acc = __builtin_amdgcn_mfma_f32_32x32x16_bf16(a, b, acc, 0, 0, 0); }
}
__device__ __forceinline__ float logsig16(float x) { const float e = __expf(-fabsf(x)); return (fminf(x, 0.f) - __logf(1.f + e)) * 0.0625f; }
__device__ __forceinline__ int gla_sidx(int b, int dir, int h) { return (b * 2 + dir) * 4 + h; }

__device__ __forceinline__ void gla_cumsum(const Ctx& C, int l, int h, int dir, const LAS float* lr, LAS float* segtot, float (&cum)[16]) {
    const int seg = C.tid >> 7, d = C.tid & 127;
    const float* wa = INP(dir ? I_WA2B : I_WA2F) + (size_t)l * 16 * 512 + h * 128 + d;
    const float bias = INP(dir ? I_BAB : I_BAF)[l * 512 + h * 128 + d];
    float w[16];
#pragma unroll
    for (int j = 0; j < 16; ++j) w[j] = wa[j * 512];
    float run = 0.f;
#pragma unroll
    for (int i = 0; i < 16; ++i) { const int s = seg * 16 + i, tk = dir ? 63 - s : s; float pre = bias;
#pragma unroll
        for (int j = 0; j < 16; ++j) pre += lr[tk * 32 + dir * 16 + j] * w[j];
        run += logsig16(pre); cum[i] = run; }
    segtot[seg * 128 + d] = run;
    __syncthreads();
    float off = 0.f;
#pragma unroll
    for (int q = 0; q < 3; ++q) if (q < seg) off += segtot[q * 128 + d];
#pragma unroll
    for (int i = 0; i < 16; ++i) cum[i] += off;
    __syncthreads();
}

__device__ __forceinline__ void phase_gla_local(const Ctx& C, int l) {
    const bf16_t* P = WSP(bf16_t, WS_P); bf16_t* GST = WSP(bf16_t, WS_GST); float* GDEC = WSP(float, WS_GDEC);
    LAS float* lr = (LAS float*)C.lds;
    LAS float* segtot = (LAS float*)(C.lds + 8192);
    LAS bf16_t* KT = (LAS bf16_t*)(C.lds + 8192 + 2048);
    LAS bf16_t* VT = (LAS bf16_t*)(C.lds + 8192 + 2048 + 18432);
    const int r32 = C.lane & 31, hi = C.lane >> 5, seg = C.tid >> 7, d = C.tid & 127;
    for (int unit = C.bid; unit < NBATCH * 4 * NCH; unit += C.G) {
        const int b = unit / (4 * NCH), h = (unit / NCH) % 4, ck = unit % NCH; const size_t r0 = (size_t)b * RPB + ck * 64;
        for (int i = C.tid; i < 64 * 32; i += NTHREADS) lr[i] = bf2f(P[(r0 + (i >> 5)) * NP + C_LRF + (i & 31)]);
        for (int i = C.tid; i < 64 * 256; i += NTHREADS) { const int s = i >> 8, e = i & 255; VT[e * 72 + s] = P[(r0 + s) * NP + C_LV + h * 256 + e]; }
        __syncthreads();
#pragma unroll 1
        for (int dir = 0; dir < 2; ++dir) {
            float cum[16];
            gla_cumsum(C, l, h, dir, lr, segtot, cum);
            if (seg == 3) segtot[d] = cum[15];
            __syncthreads();
            const float bend = segtot[d];
            const size_t sx = (size_t)gla_sidx(b, dir, h) * NCH + ck;
            if (seg == 0) GDEC[sx * 128 + d] = __expf(bend);
#pragma unroll
            for (int i = 0; i < 16; ++i) { const int s = seg * 16 + i, tk = dir ? 63 - s : s;
                const float kv = bf2f(P[(r0 + tk) * NP + C_LK + h * 128 + d]);
                KT[d * 72 + tk] = f2bf(kv * __expf(bend - cum[i])); }
            __syncthreads();
            { const int dt = C.wid & 3, eb = (C.wid >> 2) * 4;
              f32x16 acc[4] = {};
#pragma unroll
              for (int q = 0; q < 4; ++q) mma_xy<4>(acc[q], KT + (dt * 32 + r32) * 72, VT + ((eb + q) * 32 + r32) * 72, hi);
              bf16_t* st = GST + sx * 32768;
#pragma unroll
              for (int q = 0; q < 4; ++q)
#pragma unroll
                  for (int g = 0; g < 4; ++g) { u32x2 w; w.x = cvt_pk_bf16(acc[q][4 * g], acc[q][4 * g + 1]); w.y = cvt_pk_bf16(acc[q][4 * g + 2], acc[q][4 * g + 3]);
                      *(u32x2*)(st + (size_t)((eb + q) * 32 + r32) * 128 + dt * 32 + 8 * g + 4 * hi) = w; } }
            __syncthreads();
        }
    }
}

__device__ __forceinline__ void phase_gla_scan(const Ctx& C) {
    bf16_t* GST = WSP(bf16_t, WS_GST); const float* GDEC = WSP(float, WS_GDEC);
    for (int gid = C.bid * NTHREADS + C.tid; gid < 16 * 8192; gid += C.G * NTHREADS) {
        const int sidx = gid >> 13, g = gid & 8191, dir = (sidx >> 2) & 1, d4 = (g & 31) * 4;
        bf16_t* base = GST + (size_t)sidx * NCH * 32768 + (size_t)g * 4;
        const float* dbase = GDEC + (size_t)sidx * NCH * 128 + d4;
        float S[4] = {0.f, 0.f, 0.f, 0.f};
        for (int st = 0; st < NCH; st += 4) {
            int ck[4]; u32x2 L[4]; f32x4 dc[4];
#pragma unroll
            for (int q = 0; q < 4; ++q) { const int s = st + q; ck[q] = dir ? (s < 4 ? 3 - s : NCH + 3 - s) : s;
                L[q] = *(const u32x2*)(base + (size_t)ck[q] * 32768); dc[q] = *(const f32x4*)(dbase + (size_t)ck[q] * 128); }
#pragma unroll
            for (int q = 0; q < 4; ++q) { u32x2 w; w.x = cvt_pk_bf16(S[0], S[1]); w.y = cvt_pk_bf16(S[2], S[3]);
                *(u32x2*)(base + (size_t)ck[q] * 32768) = w;
                S[0] = dc[q][0] * S[0] + bflo(L[q].x); S[1] = dc[q][1] * S[1] + bfhi(L[q].x); S[2] = dc[q][2] * S[2] + bflo(L[q].y); S[3] = dc[q][3] * S[3] + bfhi(L[q].y); }
        }
    }
}

__device__ __forceinline__ void phase_gla_out(const Ctx& C, int l) {
    const bf16_t* P = WSP(bf16_t, WS_P); const bf16_t* GST = WSP(bf16_t, WS_GST); bf16_t* OL = WSP(bf16_t, WS_OL);
    LAS float* lr = (LAS float*)C.lds;
    LAS float* segtot = (LAS float*)(C.lds + 8192);
    LAS bf16_t* QT = (LAS bf16_t*)(C.lds + 10240);
    LAS bf16_t* KT = (LAS bf16_t*)(C.lds + 27648);
    LAS bf16_t* VT = (LAS bf16_t*)(C.lds + 45056);
    LAS bf16_t* SCm = (LAS bf16_t*)(C.lds + 81920);
    LAS float* OB = (LAS float*)(C.lds + 91136);
    const float* gon = INP(I_ONG) + l * 256;
    const int r32 = C.lane & 31, hi = C.lane >> 5, seg = C.tid >> 7, d = C.tid & 127;
    for (int unit = C.bid; unit < NBATCH * 4 * NCH; unit += C.G) {
        const int b = unit / (4 * NCH), h = (unit / NCH) % 4, ck = unit % NCH; const size_t r0 = (size_t)b * RPB + ck * 64;
        for (int i = C.tid; i < 64 * 32; i += NTHREADS) lr[i] = bf2f(P[(r0 + (i >> 5)) * NP + C_LRF + (i & 31)]);
        for (int i = C.tid; i < 64 * 256; i += NTHREADS) { const int s = i >> 8, e = i & 255; VT[e * 72 + s] = P[(r0 + s) * NP + C_LV + h * 256 + e]; }
        __syncthreads();
        f32x16 oacc[2] = {};
#pragma unroll 1
        for (int dir = 0; dir < 2; ++dir) {
            float cum[16];
            gla_cumsum(C, l, h, dir, lr, segtot, cum);
#pragma unroll
            for (int i = 0; i < 16; ++i) { const int s = seg * 16 + i, tk = dir ? 63 - s : s;
                const float qv = bf2f(P[(r0 + tk) * NP + C_LQ + h * 128 + d]), kv = bf2f(P[(r0 + tk) * NP + C_LK + h * 128 + d]);
                QT[tk * 136 + d] = f2bf(qv * __expf(cum[i]) * 0.088388347648318440f); KT[tk * 136 + d] = f2bf(kv * __expf(-cum[i])); }
            __syncthreads();
            if (C.wid < 4) { const int mt = C.wid >> 1, nt = C.wid & 1; f32x16 sc = {};
                mma_xy<8>(sc, QT + (mt * 32 + r32) * 136, KT + (nt * 32 + r32) * 136, hi);
#pragma unroll
                for (int i = 0; i < 16; ++i) { const int t = mt * 32 + att::crow(i, hi), s = nt * 32 + r32; const bool keep = dir ? (s >= t) : (s <= t);
                    SCm[t * 72 + s] = f2bf(keep ? sc[i] : 0.f); } }
            __syncthreads();
            { const bf16_t* st = GST + ((size_t)gla_sidx(b, dir, h) * NCH + ck) * 32768 + (size_t)(C.wid * 32 + r32) * 128 + hi * 8;
              bf16x8 sb[8];
#pragma unroll
              for (int ks = 0; ks < 8; ++ks) sb[ks] = *(const bf16x8*)(st + ks * 16);
#pragma unroll
              for (int mt = 0; mt < 2; ++mt) {
                  mma_xy<4>(oacc[mt], SCm + (mt * 32 + r32) * 72, VT + (C.wid * 32 + r32) * 72, hi);
#pragma unroll
                  for (int ks = 0; ks < 8; ++ks) { const bf16x8 a = *(const LAS bf16x8*)(QT + (mt * 32 + r32) * 136 + ks * 16 + hi * 8);
                      oacc[mt] = __builtin_amdgcn_mfma_f32_32x32x16_bf16(a, sb[ks], oacc[mt], 0, 0, 0); } } }
            __syncthreads();
        }
#pragma unroll
        for (int mt = 0; mt < 2; ++mt)
#pragma unroll
            for (int i = 0; i < 16; ++i) OB[(mt * 32 + att::crow(i, hi)) * 260 + C.wid * 32 + r32] = oacc[mt][i];
        __syncthreads();
        { const int t = C.tid >> 3, part = C.tid & 7; f32x4 v[8]; float ss = 0.f;
#pragma unroll
          for (int jj = 0; jj < 8; ++jj) { v[jj] = *(const LAS f32x4*)(OB + t * 260 + jj * 32 + part * 4); ss += v[jj][0] * v[jj][0] + v[jj][1] * v[jj][1] + v[jj][2] * v[jj][2] + v[jj][3] * v[jj][3]; }
          ss += __shfl_xor(ss, 1); ss += __shfl_xor(ss, 2); ss += __shfl_xor(ss, 4);
          const float rs = rsqrtf(ss * (1.0f / 256.0f) + NORM_EPS);
#pragma unroll
          for (int jj = 0; jj < 8; ++jj) { const int e = jj * 32 + part * 4; const f32x4 g = *(const f32x4*)(gon + e);
              const u32x2 gt = *(const u32x2*)(P + (r0 + t) * NP + C_LG + h * 256 + e);
              const float o0 = v[jj][0] * rs * g[0] * siluf_(bflo(gt.x)), o1 = v[jj][1] * rs * g[1] * siluf_(bfhi(gt.x)), o2 = v[jj][2] * rs * g[2] * siluf_(bflo(gt.y)), o3 = v[jj][3] * rs * g[3] * siluf_(bfhi(gt.y));
              u32x2 w; w.x = cvt_pk_bf16(o0, o1); w.y = cvt_pk_bf16(o2, o3);
              *(u32x2*)(OL + (r0 + t) * 1024 + h * 256 + e) = w; } }
        __syncthreads();
    }
}

__device__ __forceinline__ unsigned f_ord(float f) { const unsigned u = __float_as_uint(f); return u ^ ((unsigned)((int)u >> 31) | 0x80000000u); }
__device__ __forceinline__ float f_unord(unsigned k) { return __uint_as_float((k & 0x80000000u) ? (k ^ 0x80000000u) : ~k); }
__device__ __forceinline__ void ins_u(unsigned (&L)[16], unsigned x) {
#pragma unroll
    for (int j = 0; j < 16; ++j) { const unsigned h = L[j] > x ? L[j] : x; x = L[j] > x ? x : L[j]; L[j] = h; }
}
__device__ __forceinline__ void ins_f(float (&M)[16], float x) {
#pragma unroll
    for (int j = 0; j < 16; ++j) { const float h = M[j] > x ? M[j] : x; x = M[j] > x ? x : M[j]; M[j] = h; }
}
__device__ __forceinline__ void peer_top16(const bf16_t* __restrict__ qrow, const bf16_t* __restrict__ keys, int r32, int hi, unsigned (&L)[16]) {
    bf16x8 qf[8];
#pragma unroll
    for (int kk = 0; kk < 8; ++kk) qf[kk] = *(const bf16x8*)(qrow + kk * 16 + hi * 8);
#pragma unroll
    for (int j = 0; j < 16; ++j) L[j] = 0u;
#pragma unroll 1
    for (int mt = 0; mt < 4; ++mt) {
        f32x16 acc = {};
#pragma unroll
        for (int kk = 0; kk < 8; ++kk) { const bf16x8 a = *(const bf16x8*)(keys + (size_t)(mt * 32 + r32) * 128 + kk * 16 + hi * 8);
            acc = __builtin_amdgcn_mfma_f32_32x32x16_bf16(a, qf[kk], acc, 0, 0, 0); }
#pragma unroll
        for (int i = 0; i < 16; ++i) { const unsigned kidx = (unsigned)(mt * 32 + att::crow(i, hi)); ins_u(L, (f_ord(acc[i]) & ~127u) | (127u - kidx)); }
    }
    unsigned Pn[16];
#pragma unroll
    for (int j = 0; j < 16; ++j) Pn[j] = (unsigned)__shfl_xor((int)L[j], 32);
#pragma unroll
    for (int j = 0; j < 16; ++j) ins_u(L, Pn[j]);
}
__device__ __forceinline__ void phase_peer_select(const Ctx& C) {
    const bf16_t* PQ = WSP(bf16_t, WS_PQ); const bf16_t* K1 = WSP(bf16_t, WS_K1); const bf16_t* K2 = WSP(bf16_t, WS_K2);
    int* PIDX = WSP(int, WS_PIDX); float* PG = WSP(float, WS_PG);
    const int r32 = C.lane & 31, hi = C.lane >> 5, head = C.wid;
    for (int grp = C.bid; grp < TT / 32; grp += C.G) {
        const size_t tok = (size_t)grp * 32 + r32;
        unsigned L1[16], L2[16];
        peer_top16(PQ + tok * DM + head * 256, K1 + (size_t)head * 128 * 128, r32, hi, L1);
        peer_top16(PQ + tok * DM + head * 256 + 128, K2 + (size_t)head * 128 * 128, r32, hi, L2);
        float v1[16], v2[16];
#pragma unroll
        for (int j = 0; j < 16; ++j) { v1[j] = f_unord(L1[j] & ~127u); v2[j] = f_unord(L2[j] & ~127u); }
        float M[16];
#pragma unroll
        for (int j = 0; j < 16; ++j) M[j] = -3.0e38f;
#pragma unroll
        for (int a = 0; a < 16; ++a)
#pragma unroll
            for (int b = 0; b < 16; ++b) if ((a + 1) * (b + 1) <= 16) ins_f(M, v1[a] + v2[b]);
        const float thr = M[15], mx = M[0]; float den = 0.f;
#pragma unroll
        for (int j = 0; j < 16; ++j) den += __expf(M[j] - mx);
        const float rden = 1.0f / den;
        int pos = 0; int* ip = PIDX + tok * 128 + head * 16; float* gp = PG + tok * 128 + head * 16;
#pragma unroll
        for (int a = 0; a < 16; ++a)
#pragma unroll
            for (int b = 0; b < 16; ++b) if ((a + 1) * (b + 1) <= 16) {
                const float val = v1[a] + v2[b];
                if (val >= thr && pos < 16) { if (hi == 0) { ip[pos] = (int)((127u - (L1[a] & 127u)) * 128u + (127u - (L2[b] & 127u))); gp[pos] = __expf(val - mx) * rden; } ++pos; } }
    }
}
template <int OFF> __device__ __forceinline__ float dotf8(const float (&h)[32], const u32x4 w, float acc) {
#pragma unroll
    for (int j = 0; j < 4; ++j) { const f32x2 lo = __builtin_amdgcn_cvt_pk_f32_fp8((int)w[j], false), hi = __builtin_amdgcn_cvt_pk_f32_fp8((int)w[j], true);
        acc += h[OFF + 4 * j] * lo.x; acc += h[OFF + 4 * j + 1] * lo.y; acc += h[OFF + 4 * j + 2] * hi.x; acc += h[OFF + 4 * j + 3] * hi.y; }
    return acc;
}
constexpr int GT_MAXTOK = 9;
template <bool LAST> __device__ __forceinline__ void phase_peer_gather(const Ctx& C, const float* modl, const float pscale) {
    const bf16_t* HB = WSP(bf16_t, WS_HB); const unsigned char* U8 = C.ws + WS_U8; const unsigned char* V8 = C.ws + WS_V8;
    const float* SCU = WSP(float, WS_SCU); const float* SCV = WSP(float, WS_SCV);
    const int* PIDX = WSP(int, WS_PIDX); const float* PG = WSP(float, WS_PG); float* XS = WSP(float, WS_XS);
    const int lane = C.lane, s = lane >> 3, j = lane & 7;
    LAS int* IDS = (LAS int*)(C.lds + C.wid * (GT_MAXTOK * 512));
    LAS float* ACT = (LAS float*)(C.lds + 8 * GT_MAXTOK * 512 + C.wid * (GT_MAXTOK * 512));
    LAS int* ROWS = (LAS int*)(C.lds + 16 * GT_MAXTOK * 512 + C.wid * 64);
    int nk = 0;
    {
      const int per = (TT + C.G - 1) / C.G, base = C.bid * per;
#pragma unroll 1
      for (int k = 0; k < GT_MAXTOK; ++k) { const int o = C.wid + 8 * k; const int r = base + o; if (o < per && r < TT && !(LAST && (r % RPB) < CTXL)) { if (lane == 0) ROWS[nk] = r; ++nk; } } }
#define GT_ROW(k) __builtin_amdgcn_readfirstlane(ROWS[k])
#pragma unroll 1
    for (int k = 0; k < nk; ++k) { const int r = GT_ROW(k);
        IDS[k * 128 + lane] = PIDX[(size_t)r * 128 + lane] & (NEXP - 1); IDS[k * 128 + 64 + lane] = PIDX[(size_t)r * 128 + 64 + lane] & (NEXP - 1);
        ACT[k * 128 + lane] = 0.f; ACT[k * 128 + 64 + lane] = 0.f; }
    const int nit = 32 * nk;
#define GT_ITEM(it_) const int cb_ = (it_) / (2 * nk), rem_ = (it_) - cb_ * (2 * nk), k_ = rem_ >> 1, hf_ = rem_ & 1
#define GT_LOADU(UQ, HQ, it_) do { GT_ITEM(it_); const int r_ = GT_ROW(k_); \
        const bf16_t* hp_ = HB + (size_t)r_ * DM + cb_ * 128 + j * 16; HQ[0] = *(const u32x4*)hp_; HQ[1] = *(const u32x4*)(hp_ + 8); \
        const unsigned char* ub_ = U8 + (size_t)cb_ * ((size_t)NEXP * 128) + j * 16; \
        _Pragma("unroll") for (int eg = 0; eg < 8; ++eg) { const int id_ = IDS[k_ * 128 + (hf_ * 8 + eg) * 8 + s] & idmask; UQ[eg] = *(const u32x4*)(ub_ + (size_t)id_ * 128); } } while (0)
#define GT_COMPU(UQ, HQ, it_) do { GT_ITEM(it_); (void)cb_; f32x2 hf2[8]; \
        _Pragma("unroll") for (int hh = 0; hh < 2; ++hh) { const u32x4 w_ = HQ[hh]; \
            hf2[hh * 4 + 0] = (f32x2){bflo(w_.x), bfhi(w_.x)}; hf2[hh * 4 + 1] = (f32x2){bflo(w_.y), bfhi(w_.y)}; hf2[hh * 4 + 2] = (f32x2){bflo(w_.z), bfhi(w_.z)}; hf2[hh * 4 + 3] = (f32x2){bflo(w_.w), bfhi(w_.w)}; } \
        float d[8]; \
        _Pragma("unroll") for (int eg = 0; eg < 8; ++eg) { f32x2 d2 = (f32x2){0.f, 0.f}; \
            _Pragma("unroll") for (int q = 0; q < 4; ++q) { const f32x2 lo = __builtin_amdgcn_cvt_pk_f32_fp8((int)UQ[eg][q], false), hi = __builtin_amdgcn_cvt_pk_f32_fp8((int)UQ[eg][q], true); \
                d2 += hf2[2 * q] * lo; d2 += hf2[2 * q + 1] * hi; } \
            d[eg] = d2.x + d2.y; } \
          \
        float t4[4], t2[2], t1; \
        _Pragma("unroll") for (int i = 0; i < 4; ++i) { const float snd = (j & 4) ? d[i] : d[i + 4], kp = (j & 4) ? d[i + 4] : d[i]; t4[i] = kp + __shfl_xor(snd, 4); } \
        _Pragma("unroll") for (int i = 0; i < 2; ++i) { const float snd = (j & 2) ? t4[i] : t4[i + 2], kp = (j & 2) ? t4[i + 2] : t4[i]; t2[i] = kp + __shfl_xor(snd, 2); } \
        { const float snd = (j & 1) ? t2[0] : t2[1], kp = (j & 1) ? t2[1] : t2[0]; t1 = kp + __shfl_xor(snd, 1); } \
        ACT[k_ * 128 + (hf_ * 8 + j) * 8 + s] += t1; } while (0)
#ifdef DBG_GDUP
#pragma unroll 1
    for (int rep_ = 0; rep_ < 2; ++rep_) {
    const int idmask = rep_ == 0 ? DBG_GMASK : (NEXP - 1);
    if (rep_ == 1) { for (int k = 0; k < nk; ++k) { ACT[k * 128 + lane] = 0.f; ACT[k * 128 + 64 + lane] = 0.f; } }
#else
    { const int idmask = NEXP - 1;
#endif
    if (nit > 0) {
        u32x4 uA[8], uB[8], hA[2], hB[2];
        GT_LOADU(uA, hA, 0);
#pragma unroll 1
        for (int it = 0; it < nit; it += 2) {
            GT_LOADU(uB, hB, it + 1);
            GT_COMPU(uA, hA, it);
            if (it + 2 < nit) GT_LOADU(uA, hA, it + 2);
            GT_COMPU(uB, hB, it + 1);
        }
    }
    }
#undef GT_LOADU
#undef GT_COMPU
#pragma unroll 1
    for (int k = 0; k < nk; ++k) { const int r = GT_ROW(k);
#pragma unroll
        for (int hh = 0; hh < 2; ++hh) { const int e = hh * 64 + lane; const int id = IDS[k * 128 + e]; const float a = ACT[k * 128 + e] * SCU[id];
            const float w = PG[(size_t)r * 128 + e] * 0.5f * a * (1.0f + erff(a * 0.70710678118654752f));
#ifdef DBG_CHECK
            if (((r - 300) & 63) == 0 && r >= 300 && r < 300 + 64 * 128) WSP(float, WS_OM)[(size_t)r * 128 + e] = w;
#endif
            ACT[k * 128 + e] = w * SCV[id]; } }
#define GT_LOADV(VQ, WV, it_) do { GT_ITEM(it_); const unsigned char* vb_ = V8 + (size_t)cb_ * ((size_t)NEXP * 128) + j * 16; \
        _Pragma("unroll") for (int eg = 0; eg < 8; ++eg) { const int e_ = k_ * 128 + (hf_ * 8 + eg) * 8 + s; const int id_ = IDS[e_]; VQ[eg] = *(const u32x4*)(vb_ + (size_t)id_ * 128); WV[eg] = ACT[e_]; } } while (0)
#define GT_COMPV(VQ, WV) do { \
        _Pragma("unroll") for (int eg = 0; eg < 8; ++eg) { const f32x2 w2_ = (f32x2){WV[eg], WV[eg]}; \
            _Pragma("unroll") for (int q = 0; q < 4; ++q) { \
                const f32x2 lo = __builtin_amdgcn_cvt_pk_f32_fp8((int)VQ[eg][q], false), hi = __builtin_amdgcn_cvt_pk_f32_fp8((int)VQ[eg][q], true); \
                acc2[2 * q] += w2_ * lo; acc2[2 * q + 1] += w2_ * hi; } } } while (0)
    if (nit > 0) {
        u32x4 vA[8], vB[8]; float wA[8], wB[8];
        GT_LOADV(vA, wA, 0);
#pragma unroll 1
        for (int it = 0; it < nit; it += 2) {
            f32x2 acc2[8];
#pragma unroll
            for (int i = 0; i < 8; ++i) acc2[i] = (f32x2){0.f, 0.f};
            GT_LOADV(vB, wB, it + 1);
            GT_COMPV(vA, wA);
            if (it + 2 < nit) GT_LOADV(vA, wA, it + 2);
            GT_COMPV(vB, wB);
            f32x2 t4[4], t2[2], t1;
#pragma unroll
            for (int i = 0; i < 4; ++i) { const f32x2 snd = (s & 4) ? acc2[i] : acc2[i + 4], kp = (s & 4) ? acc2[i + 4] : acc2[i];
                t4[i] = kp + (f32x2){__shfl_xor(snd.x, 32), __shfl_xor(snd.y, 32)}; }
#pragma unroll
            for (int i = 0; i < 2; ++i) { const f32x2 snd = (s & 2) ? t4[i] : t4[i + 2], kp = (s & 2) ? t4[i + 2] : t4[i];
                t2[i] = kp + (f32x2){__shfl_xor(snd.x, 16), __shfl_xor(snd.y, 16)}; }
            { const f32x2 snd = (s & 1) ? t2[0] : t2[1], kp = (s & 1) ? t2[1] : t2[0]; t1 = kp + (f32x2){__shfl_xor(snd.x, 8), __shfl_xor(snd.y, 8)}; }
            { GT_ITEM(it); (void)hf_; const int r_ = GT_ROW(k_);
              const int col = cb_ * 128 + j * 16 + 2 * s; float* xp = XS + (size_t)r_ * DM + col; const float* g2 = modl + (size_t)mod_sel(r_) * 12288 + 5 * DM + col;
#ifdef DBG_CHECK
              if (((r_ - 300) & 63) == 0 && r_ >= 300 && r_ < 300 + 64 * 128) { float* dbgo = WSP(float, WS_MQ) + (size_t)r_ * DM + col; dbgo[0] = t1.x; dbgo[1] = t1.y; }
#endif
              const f32x2 x = *(const f32x2*)xp, g = *(const f32x2*)g2;
              *(f32x2*)xp = x + pscale * g * t1; }
        }
    }
#undef GT_LOADV
#undef GT_COMPV
#undef GT_ITEM
#undef GT_ROW
}
__device__ __forceinline__ void phase_final_norm(const Ctx& C) {
    const float* XS = WSP(float, WS_XS); const float* fg = INP(I_FG);
    for (int q = C.bid * 8 + C.wid; q < NBATCH * SEQ; q += C.G * 8) {
        const int b = q / SEQ, t = q % SEQ; const float* xr = XS + ((size_t)b * RPB + CTXL + t) * DM; float* op = C.out + (size_t)q * DM;
        f32x4 v[8]; float ss = 0.f;
#pragma unroll
        for (int c = 0; c < 8; ++c) { v[c] = *(const f32x4*)(xr + c * 256 + C.lane * 4); ss += v[c][0] * v[c][0] + v[c][1] * v[c][1] + v[c][2] * v[c][2] + v[c][3] * v[c][3]; }
        ss = wave_sum(ss); const float rs = rsqrtf(ss * (1.0f / DM) + NORM_EPS);
#pragma unroll
        for (int c = 0; c < 8; ++c) { const f32x4 g = *(const f32x4*)(fg + c * 256 + C.lane * 4); *(f32x4*)(op + c * 256 + C.lane * 4) = v[c] * rs * g; }
    }
}

template <int TYPE  > __device__ __forceinline__ void attn_units(const Ctx& C, bool need_ctx) {
    const bf16_t* P = WSP(bf16_t, WS_P);
    const int nu = need_ctx ? 528 : 512;
#pragma unroll 1
    for (int u = C.bid; u < nu; u += C.G) {
        int bh, qb; if (u < 512) { bh = (u >> 8) * 8 + (u & 7); qb = ((u & 255) >> 3) + 1; } else { bh = u - 512; qb = 0; }
        const int b = bh >> 3, h = bh & 7; const size_t rq = (size_t)b * RPB + (size_t)qb * 256, rk = (size_t)b * RPB; const int seq = qb == 0 ? CTXL : RPB;
        __syncthreads();
        if constexpr (TYPE == 1) {
            att::attn_body<128, 1>(P + rq * NP + C_AQ + h * 128, NP, P + rk * NP + C_AK + (h >> 2) * 128, NP, nullptr, 0, P + rk * NP + C_AV + (h >> 2) * 128, NP,
                                   WSP(bf16_t, WS_OA) + rq * 1024 + h * 128, 1024, seq, false, 0, nullptr, (char*)C.lds, C.tid);
        } else {
            const bf16_t* MQ = WSP(bf16_t, WS_MQ); const bf16_t* MKV = WSP(bf16_t, WS_MKV);
            att::attn_body<192, 1>(MQ + rq * 1536 + h * 192, 1536, MKV + rk * 2048 + h * 256, 2048, P + rk * NP + C_MKR, NP, MKV + rk * 2048 + h * 256 + 128, 2048,
                                   WSP(bf16_t, WS_OM) + rq * 1024 + h * 128, 1024, seq, qb > 0, (qb - 1) * 256, WSP(float, WS_TABM), (char*)C.lds, C.tid);
        }
    }
    __syncthreads();
}

constexpr int LDS_BYTES = 163840, LDS_BAR_OFF = LDS_BYTES - 16;
constexpr int N_PHASES = 26;
template <int K> __device__ __forceinline__ void run_phase(const Ctx& C0, int l) {
    const Ctx C = launder(C0);
    const float* modl = WSP(float, WS_MODV) + (size_t)l * 3 * 12288;
    if constexpr (K == 0) { phase_modv(C); phase_tables(C); __syncthreads(); phase_cvt_mixer_weights(C, 0); }
    if constexpr (K == 1) {
        if (l == 0) phase_norm_mod<true>(C, INP(I_N1G), modl, 0, DM);
        else { phase_norm_mod<false>(C, INP(I_N1G) + l * DM, modl, 0, DM); __syncthreads(); phase_cvt_mixer_weights(C, l); }
    }
    if constexpr (K == 2) {
        pg8::Gemm g{WSP(bf16_t, WS_HB), WSP(bf16_t, WS_WIN), TT, NP, DM, DM, DM}; pg8::StaticOrder S; S.init(TT, NP, C.G, C.bid);
        pg8::EpiStoreBf16 E{WSP(bf16_t, WS_P), NP};
        pg8::gemm_phase(C.lds, C.tid, g, S, E);
    }
    if constexpr (K == 3) phase_post_p(C, l);
    if constexpr (K == 4) {
        { pg8::Gemm g{WSP(bf16_t, WS_P) + C_MCQ, WSP(bf16_t, WS_WUQ), TT, 1536, 512, NP, 512}; pg8::StaticOrder S; S.init(TT, 1536, C.G, C.bid);
          pg8::EpiStoreBf16 E{WSP(bf16_t, WS_MQ), 1536}; pg8::gemm_phase(C.lds, C.tid, g, S, E); }
        { pg8::Gemm g{WSP(bf16_t, WS_P) + C_MCKV, WSP(bf16_t, WS_WUKV), TT, 2048, 512, NP, 512}; pg8::StaticOrder S; S.init(TT, 2048, C.G, C.bid);
          pg8::EpiStoreBf16 E{WSP(bf16_t, WS_MKV), 2048}; pg8::gemm_phase(C.lds, C.tid, g, S, E); }
        { const Ctx C2 = launder(C0); phase_gla_local(C2, l); }
#ifdef DBG_DUP_GLALOCAL
        { const Ctx C2 = launder(C0); __syncthreads(); phase_gla_local(C2, l); }
#endif
    }
    if constexpr (K == 5) phase_gla_scan(C);
    if constexpr (K == 6) { attn_units<0>(C, l + 1 < DEPTH); { const Ctx C2 = launder(C0); attn_units<1>(C2, l + 1 < DEPTH); } { const Ctx C3 = launder(C0); phase_gla_out(C3, l); }
#ifdef DBG_DUP_GLAOUT
        { const Ctx C3 = launder(C0); __syncthreads(); phase_gla_out(C3, l); }
#endif
    }
    if constexpr (K == 7) {
        const bf16_t* P = WSP(bf16_t, WS_P); bf16_t* Y = WSP(bf16_t, WS_Y); pg8::StaticOrder S; S.init(TT, DM, C.G, C.bid);
        { pg8::Gemm g{WSP(bf16_t, WS_OA), WSP(bf16_t, WS_WBR), TT, DM, 1024, 1024, 1024}; pg8::EpiGate<true> E{Y, DM, P + C_GA, NP}; pg8::gemm_phase(C.lds, C.tid, g, S, E); }
        { pg8::Gemm g{WSP(bf16_t, WS_OL), WSP(bf16_t, WS_WBR) + (size_t)2048 * 1024, TT, DM, 1024, 1024, 1024}; pg8::EpiGate<false> E{Y, DM, P + C_GL, NP}; pg8::gemm_phase(C.lds, C.tid, g, S, E); }
        { pg8::Gemm g{WSP(bf16_t, WS_OM), WSP(bf16_t, WS_WBR) + (size_t)2 * 2048 * 1024, TT, DM, 1024, 1024, 1024}; pg8::EpiGate<false> E{Y, DM, P + C_GM, NP}; pg8::gemm_phase(C.lds, C.tid, g, S, E); }
    }
    if constexpr (K == 8) {
        pg8::Gemm g{WSP(bf16_t, WS_Y), WSP(bf16_t, WS_WOUT), TT, DM, DM, DM, DM}; pg8::StaticOrder S; S.init(TT, DM, C.G, C.bid);
        pg8::EpiResid E{WSP(float, WS_XS), DM, modl + 2 * DM, l == 0 ? DBG_MIX0 : DBG_MIX1};
        pg8::gemm_phase(C.lds, C.tid, g, S, E);
        phase_cvt_peer_tables(C, l);
#ifdef DBG_CDUP
        phase_cvt_peer_tables(C, l);
#endif
    }
    if constexpr (K == 9) phase_norm_mod<false>(C, INP(I_N2G) + l * DM, modl, 3 * DM, 4 * DM);
    if constexpr (K == 10) {
        pg8::Gemm g{WSP(bf16_t, WS_HB), WSP(bf16_t, WS_WQ), TT, DM, DM, DM, DM}; pg8::StaticOrder S; S.init(TT, DM, C.G, C.bid);
        pg8::EpiStoreBf16 E{WSP(bf16_t, WS_PQ), DM};
        pg8::gemm_phase(C.lds, C.tid, g, S, E);
    }
    if constexpr (K == 11) phase_peer_select(C);
    if constexpr (K == 13) phase_final_norm(C);
    if constexpr (K == 12) { if (l + 1 < DEPTH) phase_peer_gather<false>(C, modl, DBG_PEER0); else phase_peer_gather<true>(C, modl, DBG_PEER1); }
}
__device__ __forceinline__ Ctx make_ctx(const Args& args, unsigned char* lds_raw) {
    Ctx C0; C0.in = (const __attribute__((address_space(4))) cfp_t*)__builtin_amdgcn_kernarg_segment_ptr(); C0.out = args.out; C0.ws = args.ws; C0.lds = (LAS unsigned char*)lds_raw;
    C0.tid = threadIdx.x; C0.lane = C0.tid & 63; C0.wid = __builtin_amdgcn_readfirstlane(C0.tid >> 6); C0.G = gridDim.x; C0.bid = blockIdx.x;
    return C0;
}
template <int K> __global__ void __launch_bounds__(NTHREADS, 2) k_one(Args args) {
    extern __shared__ __attribute__((aligned(16))) unsigned char lds_raw[];
    const Ctx C0 = make_ctx(args, lds_raw);
    run_phase<K>(C0, args.ph_lo);
}
#if MK_N_LAUNCHES == 1
__global__ void __launch_bounds__(NTHREADS, 2) mk_fwd(Args args) {
    extern __shared__ __attribute__((aligned(16))) unsigned char lds_raw[];
    const Ctx C0 = make_ctx(args, lds_raw);
    if (C0.tid < 4) ((LAS unsigned*)(C0.lds + LDS_BAR_OFF))[C0.tid] = 0u;
    __syncthreads();
    const int lo = args.ph_lo, hi = args.ph_hi;
    XcdBarrier bar; bar.bar = (unsigned*)(args.ws + WS_CTL); bar.x = 0; bar.st = nullptr;
    if (hi - lo > 1) bar = xcd_barrier_post((unsigned*)(args.ws + WS_CTL), (volatile LAS unsigned*)(C0.lds + LDS_BAR_OFF));
#define IN(k) (lo <= (k) && (k) < hi)
#define SEAM(k) do { if (IN(k) && IN((k) + 1)) xcd_barrier(bar); } while (0)
#ifndef DBG_DUP
#define DBG_DUP -1
#endif
#define PH(K, k) do { if (IN(k)) { run_phase<K>(C0, l); if (K == DBG_DUP) { xcd_barrier(bar); run_phase<K>(C0, l); } } SEAM(k); } while (0)
    { const int l = 0; PH(0, 0); }
#pragma unroll 1
    for (int l = 0; l < DEPTH; ++l) {
        const int pb = 1 + 12 * l;
        PH(1, pb + 0); PH(2, pb + 1); PH(3, pb + 2); PH(4, pb + 3); PH(5, pb + 4); PH(6, pb + 5);
        PH(7, pb + 6); PH(8, pb + 7); PH(9, pb + 8); PH(10, pb + 9); PH(11, pb + 10); PH(12, pb + 11);
    }
    { const int l = DEPTH - 1; PH(13, 1 + 12 * DEPTH); }
#undef PH
#undef IN
#undef SEAM
}
#define MAIN_KERNEL mk_fwd
#else
#define MAIN_KERNEL k_one<6>
#endif


#ifdef DBG_CHECK
__device__ __forceinline__ void dbg_report(unsigned* slot, float err) { if (!(err <= 3e38f)) err = 1e30f; atomicMax(slot, __float_as_uint(err)); }
__global__ void k_check_gemm(const bf16_t* A, int lda, const float* W, int K, int N, const bf16_t* Cm, int ldc, int M, unsigned* slot) {
    const unsigned id = blockIdx.x * blockDim.x + threadIdx.x; if (id >= 8192) return;
    const unsigned h = id * 2654435761u; const int row = (int)((h >> 8) % (unsigned)M), col = (int)((h * 40503u >> 7) % (unsigned)N);
    float ref = 0.f; for (int k = 0; k < K; ++k) ref += bf2f(A[(size_t)row * lda + k]) * W[(size_t)k * N + col];
    const float got = bf2f(Cm[(size_t)row * ldc + col]);
    dbg_report(slot, fabsf(got - ref) / (fabsf(ref) + 0.1f));
}

__global__ void k_check_attn(const unsigned char* ws, int type, unsigned* slot) {
    __shared__ float sc[RPB]; __shared__ float red[256]; __shared__ float qv[192];
    const int t = threadIdx.x, bh = blockIdx.x & 15, b = bh >> 3, h = bh & 7; const int qpos = (int)(((blockIdx.x >> 4) * 977u + 13u) % SEQ); const size_t rq = (size_t)b * RPB + CTXL + qpos, rk = (size_t)b * RPB;
    const bf16_t* P = (const bf16_t*)(ws + WS_P); const bf16_t* MQ = (const bf16_t*)(ws + WS_MQ); const bf16_t* MKV = (const bf16_t*)(ws + WS_MKV);
    const int dq = type ? 128 : 192;
    if (t < dq) { float v = type ? bf2f(P[rq * NP + C_AQ + h * 128 + t]) : bf2f(MQ[rq * 1536 + h * 192 + t]); qv[t] = v; }
    __syncthreads();
    if (!type && t < 32) {
        const int ri = qpos >> 6, ci = qpos & 63; const int i = t; const float pos = (float)(i < 16 ? ri : ci); const float inv = powf(10000.f, -(float)(i & 15) / 16.f); const float a = pos * inv;
        const float x1 = qv[128 + i], x2 = qv[160 + i]; qv[128 + i] = x1 * cosf(a) - x2 * sinf(a); qv[160 + i] = x2 * cosf(a) + x1 * sinf(a); }
    __syncthreads();
    const float scale = type ? 0.088388347648f : 0.0721687836487f;
    float mx = -1e30f;
    for (int k = t; k < RPB; k += 256) { float s = 0.f;
        if (type) { const bf16_t* kp = P + (rk + k) * NP + C_AK + (h >> 2) * 128; for (int d = 0; d < 128; ++d) s += qv[d] * bf2f(kp[d]); }
        else { const bf16_t* kp = MKV + (rk + k) * 2048 + h * 256; for (int d = 0; d < 128; ++d) s += qv[d] * bf2f(kp[d]); const bf16_t* kr = P + (rk + k) * NP + C_MKR; for (int d = 0; d < 64; ++d) s += qv[128 + d] * bf2f(kr[d]); }
        s *= scale; sc[k] = s; mx = fmaxf(mx, s); }
    red[t] = mx; __syncthreads(); for (int o = 128; o >= 1; o >>= 1) { if (t < o) red[t] = fmaxf(red[t], red[t + o]); __syncthreads(); } mx = red[0]; __syncthreads();
    float sum = 0.f; for (int k = t; k < RPB; k += 256) { const float p = __expf(sc[k] - mx); sc[k] = p; sum += p; }
    red[t] = sum; __syncthreads(); for (int o = 128; o >= 1; o >>= 1) { if (t < o) red[t] += red[t + o]; __syncthreads(); } sum = red[0]; __syncthreads();
    float e = 0.f, mag = 0.f;
    if (t < 128) { float o = 0.f; for (int k = 0; k < RPB; ++k) { const float vv = type ? bf2f(P[(rk + k) * NP + C_AV + (h >> 2) * 128 + t]) : bf2f(MKV[(rk + k) * 2048 + h * 256 + 128 + t]); o += sc[k] * vv; }
        o /= sum; const float got = bf2f(((const bf16_t*)(ws + (type ? WS_OA : WS_OM)))[rq * 1024 + h * 128 + t]); e = fabsf(got - o); mag = fabsf(o); }
    red[t] = e; __syncthreads(); for (int o = 128; o >= 1; o >>= 1) { if (t < o) red[t] = fmaxf(red[t], red[t + o]); __syncthreads(); } e = red[0]; __syncthreads();
    red[t] = mag; __syncthreads(); for (int o = 128; o >= 1; o >>= 1) { if (t < o) red[t] = fmaxf(red[t], red[t + o]); __syncthreads(); } mag = red[0];
    if (t == 0) dbg_report(slot, e / (mag + 1e-4f));
}
__global__ void __launch_bounds__(256) k_check_gla_rec(const unsigned char* ws, const float* wa_f, const float* ba_f, const float* wa_b, const float* ba_b, float* obuf, int b) {
    __shared__ float ad[128], kd[128], qd[128], lrs[16];
    const int e = threadIdx.x, h = blockIdx.x & 3, dir = blockIdx.x >> 2; const bf16_t* P = (const bf16_t*)(ws + WS_P);
    const float* wa = dir ? wa_b : wa_f; const float* ba = dir ? ba_b : ba_f;
    float S[128];
#pragma unroll
    for (int d = 0; d < 128; ++d) S[d] = 0.f;
    float* ob = obuf + ((size_t)(dir * 2 + b) * 4 + h) * RPB * 256;
    for (int st = 0; st < RPB; ++st) {
        int j; if (!dir) j = st; else j = st < CTXL ? CTXL - 1 - st : RPB - 1 - (st - CTXL);
        const size_t r = (size_t)b * RPB + j; const bf16_t* pr = P + r * NP;
        if (e < 16) lrs[e] = bf2f(pr[(dir ? C_LRB : C_LRF) + e]);
        __syncthreads();
        if (e < 128) { float pre = ba[h * 128 + e]; for (int q = 0; q < 16; ++q) pre += lrs[q] * wa[q * 512 + h * 128 + e];
            const float ls = (fminf(pre, 0.f) - log1pf(expf(-fabsf(pre)))) / 16.f; ad[e] = expf(ls); kd[e] = bf2f(pr[C_LK + h * 128 + e]); qd[e] = bf2f(pr[C_LQ + h * 128 + e]) * 0.088388347648f; }
        __syncthreads();
        const float v = bf2f(pr[C_LV + h * 256 + e]); float o = 0.f;
#pragma unroll
        for (int d = 0; d < 128; ++d) { S[d] = ad[d] * S[d] + kd[d] * v; o += qd[d] * S[d]; }
        ob[(size_t)j * 256 + e] = o;
        __syncthreads();
    }
}
__global__ void k_check_gla_cmp(const unsigned char* ws, const float* obuf, const float* gon, int b, unsigned* slot) {
    __shared__ float red[256];
    const int e = threadIdx.x, h = blockIdx.x & 3, j = blockIdx.x >> 2; const size_t r = (size_t)b * RPB + j; const bf16_t* P = (const bf16_t*)(ws + WS_P);
    const float o = obuf[((size_t)(0 * 2 + b) * 4 + h) * RPB * 256 + (size_t)j * 256 + e] + obuf[((size_t)(1 * 2 + b) * 4 + h) * RPB * 256 + (size_t)j * 256 + e];
    red[e] = o * o; __syncthreads(); for (int s_ = 128; s_ >= 1; s_ >>= 1) { if (e < s_) red[e] += red[e + s_]; __syncthreads(); }
    const float rs = rsqrtf(red[0] / 256.f + NORM_EPS); __syncthreads();
    const float gt = bf2f(P[r * NP + C_LG + h * 256 + e]); const float ref = o * rs * gon[e] * (gt / (1.f + expf(-gt)));
    const float got = bf2f(((const bf16_t*)(ws + WS_OL))[r * 1024 + h * 256 + e]);
    red[e] = fabsf(got - ref); __syncthreads(); for (int s_ = 128; s_ >= 1; s_ >>= 1) { if (e < s_) red[e] = fmaxf(red[e], red[e + s_]); __syncthreads(); }
    if (e == 0) dbg_report(slot, red[0] / 1.0f);
}
__global__ void k_check_select(const bf16_t* PQ, const float* k1, const float* k2, const int* PIDX, const float* PG, unsigned* slot) {
    __shared__ float s1[128], s2[128]; __shared__ int cnt; __shared__ float selv[16];
    const int tok = (blockIdx.x >> 3) * 61 + 5, head = blockIdx.x & 7, t = threadIdx.x;
    if (t == 0) cnt = 0;
    for (int n = t; n < 128; n += 64) { float a = 0.f, b = 0.f; for (int d = 0; d < 128; ++d) { a += bf2f(PQ[(size_t)tok * DM + head * 256 + d]) * k1[((size_t)head * 128 + n) * 128 + d]; b += bf2f(PQ[(size_t)tok * DM + head * 256 + 128 + d]) * k2[((size_t)head * 128 + n) * 128 + d]; } s1[n] = a; s2[n] = b; }
    __syncthreads();
    if (t < 16) { const int id = PIDX[(size_t)tok * 128 + head * 16 + t]; selv[t] = (id >= 0 && id < 16384) ? s1[id >> 7] + s2[id & 127] : -1e30f; }
    __syncthreads();
    float thr = selv[0], mx = selv[0]; for (int k = 1; k < 16; ++k) { thr = fminf(thr, selv[k]); mx = fmaxf(mx, selv[k]); }
    int c = 0; for (int p = t; p < 16384; p += 64) if (s1[p >> 7] + s2[p & 127] > thr + 0.02f) ++c;
    atomicAdd(&cnt, c); __syncthreads();
    if (t == 0) { float den = 0.f; for (int k = 0; k < 16; ++k) den += __expf(selv[k] - mx); float e = fabsf((float)cnt - 15.f) / 15.f > 0.34f ? fabsf((float)cnt - 15.f) / 15.f : 0.f;
        for (int k = 0; k < 16; ++k) e = fmaxf(e, fabsf(PG[(size_t)tok * 128 + head * 16 + k] - __expf(selv[k] - mx) / den) * 4.f);
        for (int k = 0; k < 16; ++k) for (int k2_ = 0; k2_ < k; ++k2_) if (PIDX[(size_t)tok * 128 + head * 16 + k] == PIDX[(size_t)tok * 128 + head * 16 + k2_]) e = fmaxf(e, 10.f);
        dbg_report(slot, e); }
}
__global__ void k_check_gather(const bf16_t* HB, const float* u, const float* v, const int* PIDX, const float* PG, const float* dbgo, unsigned* slot) {
    __shared__ float w[128];
    const int tok = blockIdx.x * 64 + 300, t = threadIdx.x;
    for (int k = t; k < 128; k += 64) { const int id = PIDX[(size_t)tok * 128 + k] & 16383; float a = 0.f; for (int d = 0; d < DM; ++d) a += bf2f(HB[(size_t)tok * DM + d]) * u[(size_t)id * DM + d];
        w[k] = PG[(size_t)tok * 128 + k] * 0.5f * a * (1.0f + erff(a * 0.70710678f)); }
    __syncthreads();
    float e = 0.f, sc = 0.f;
    for (int d = t; d < DM; d += 64) { float o = 0.f; for (int k = 0; k < 128; ++k) o += w[k] * v[(size_t)(PIDX[(size_t)tok * 128 + k] & 16383) * DM + d];
        e = fmaxf(e, fabsf(o - dbgo[(size_t)tok * DM + d])); sc = fmaxf(sc, fabsf(o)); }
    for (int o_ = 32; o_ >= 1; o_ >>= 1) { e = fmaxf(e, __shfl_xor(e, o_)); sc = fmaxf(sc, __shfl_xor(sc, o_)); }
    if (t == 0) dbg_report(slot, e / (sc + 1e-6f));
}
__global__ void k_dbg_out2(const float* x, const float* fg, float* out, const unsigned* slot) {
    const float mx = __uint_as_float(*slot); float v = 0.25f * (log10f(fmaxf(mx, 1e-30f)) + 4.0f); v = fminf(fmaxf(v, 0.f), 9.f);
    const float f = 1.0f + v;
    const int lane = threadIdx.x & 63; const size_t r = (size_t)blockIdx.x * 4 + (threadIdx.x >> 6);
    const float* xr = x + r * DM; float ss = 0.f;
    for (int c = lane; c < DM; c += 64) ss += xr[c] * xr[c];
    ss = wave_sum(ss); const float rs = rsqrtf(ss / DM + NORM_EPS);
    for (int c = lane; c < DM; c += 64) out[r * DM + c] = xr[c] * rs * fg[c] * f;
}
#endif
#ifdef DBG_SCAN
__global__ void k_scan16(const bf16_t* p, size_t n, unsigned* flags, int stage) {
    unsigned bad = 0; for (size_t i = (size_t)blockIdx.x * blockDim.x + threadIdx.x; i < n; i += (size_t)gridDim.x * blockDim.x) bad |= ((p[i] & 0x7f80u) == 0x7f80u);
    if (bad) atomicOr(&flags[stage], 1u);
}
__global__ void k_scan32(const float* p, size_t n, unsigned* flags, int stage) {
    unsigned bad = 0; for (size_t i = (size_t)blockIdx.x * blockDim.x + threadIdx.x; i < n; i += (size_t)gridDim.x * blockDim.x) bad |= ((__float_as_uint(p[i]) & 0x7f800000u) == 0x7f800000u);
    if (bad) atomicOr(&flags[stage], 1u);
}
__global__ void k_dbg_out(const float* x, const float* fg, float* out, const unsigned* flags, int nstage) {
    int code = 0; for (int s = nstage; s >= 1; --s) if (flags[s]) code = s;
    const float f = 1.0f + 0.25f * (float)code;
    const int lane = threadIdx.x & 63; const size_t r = (size_t)blockIdx.x * 4 + (threadIdx.x >> 6);
    const float* xr = x + r * DM; float ss = 0.f;
    for (int c = lane; c < DM; c += 64) ss += xr[c] * xr[c];
    ss = wave_sum(ss); const float rs = rsqrtf(ss / DM + NORM_EPS);
    for (int c = lane; c < DM; c += 64) out[r * DM + c] = xr[c] * rs * fg[c] * f;
}
#endif
extern "C" void kernel_launch(void* const* d_in, const int* in_sizes, int n_in, void* d_out, int out_size, void* d_ws, size_t ws_size, hipStream_t stream) {
    static int grid = 0;
    if (grid == 0) {
        if (n_in != 30 || out_size != NBATCH * SEQ * DM || ws_size < WS_END) { fprintf(stderr, "kernel_launch: shape/workspace mismatch: n_in %d out %d ws %zu (need %zu)\n", n_in, out_size, ws_size, (size_t)WS_END); grid = -1; return; }
        int dev = 0, cus = 0, per_cu = 0;
        if (hipGetDevice(&dev) != hipSuccess || hipDeviceGetAttribute(&cus, hipDeviceAttributeMultiprocessorCount, dev) != hipSuccess) { grid = -1; return; }
        bool okattr = hipFuncSetAttribute((const void*)MAIN_KERNEL, hipFuncAttributeMaxDynamicSharedMemorySize, LDS_BYTES) == hipSuccess;
#if MK_N_LAUNCHES != 1
#define SETA(K) okattr = okattr && hipFuncSetAttribute((const void*)k_one<K>, hipFuncAttributeMaxDynamicSharedMemorySize, LDS_BYTES) == hipSuccess
        SETA(0); SETA(1); SETA(2); SETA(3); SETA(4); SETA(5); SETA(6); SETA(7); SETA(8); SETA(9); SETA(10); SETA(11); SETA(12); SETA(13);
#undef SETA
#endif
        if (!okattr) { fprintf(stderr, "kernel_launch: hipFuncSetAttribute failed\n"); grid = -1; return; }
        if (hipOccupancyMaxActiveBlocksPerMultiprocessor(&per_cu, (const void*)MAIN_KERNEL, NTHREADS, LDS_BYTES) != hipSuccess || per_cu < 1) { fprintf(stderr, "kernel_launch: occupancy query says %d blocks per CU\n", per_cu); grid = -1; (void)hipGetLastError(); return; }
        grid = cus;
    }
    if (grid < 0) return;
    if (hipMemsetAsync((char*)d_ws + WS_CTL, 0, CTL_BYTES, stream) != hipSuccess) return;
    Args a{};
    for (int i = 0; i < 30; ++i) a.in[i] = (const float*)d_in[i];
    a.out = (float*)d_out; a.ws = (unsigned char*)d_ws;
#if MK_N_LAUNCHES == 1
    a.ph_lo = 0; a.ph_hi = N_PHASES;
    hipLaunchKernelGGL(mk_fwd, dim3(grid), dim3(NTHREADS), LDS_BYTES, stream, a);
#else
    a.ph_hi = 0;
#ifndef DBG_NLAUNCH
#define DBG_NLAUNCH 100
#endif
    int nl_ = 0;
#define LAUNCH1(K, L) do { a.ph_lo = (L); if (nl_++ < DBG_NLAUNCH) { hipLaunchKernelGGL(k_one<K>, dim3(grid), dim3(NTHREADS), LDS_BYTES, stream, a); if (K == DBG_DUP) hipLaunchKernelGGL(k_one<K>, dim3(grid), dim3(NTHREADS), LDS_BYTES, stream, a); } } while (0)
#ifdef DBG_SCAN
    unsigned* flags = (unsigned*)((char*)d_ws + WS_CTL + 32768);
    char* W = (char*)d_ws;
#define S16(off, n, st) hipLaunchKernelGGL(k_scan16, dim3(1024), dim3(256), 0, stream, (const bf16_t*)(W + (off)), (size_t)(n), flags, st)
#define S32(off, n, st) hipLaunchKernelGGL(k_scan32, dim3(1024), dim3(256), 0, stream, (const float*)(W + (off)), (size_t)(n), flags, st)
    LAUNCH1(0, 0); S32(WS_MODV, 2 * 3 * 12288, 1);
    { const int l = 0;
      LAUNCH1(1, l); S16(WS_HB, (size_t)TT * DM, 2);
      LAUNCH1(2, l); S16(WS_P, (size_t)TT * NP, 3);
      LAUNCH1(3, l); S16(WS_P, (size_t)TT * NP, 4);
      LAUNCH1(4, l); S16(WS_MQ, (size_t)TT * 1536, 5); S16(WS_MKV, (size_t)TT * 2048, 5); S16(WS_GST, (size_t)2112 * 32768, 6); S32(WS_GDEC, (size_t)2112 * 128, 6);
      LAUNCH1(5, l); S16(WS_GST, (size_t)2112 * 32768, 7);
      LAUNCH1(6, l); S16(WS_OA, (size_t)TT * 1024, 8); S16(WS_OM, (size_t)TT * 1024, 9); S16(WS_OL, (size_t)TT * 1024, 10);
      LAUNCH1(7, l); S16(WS_Y, (size_t)TT * DM, 11);
      LAUNCH1(8, l); S32(WS_XS, (size_t)TT * DM, 12);
      LAUNCH1(9, l); S16(WS_HB, (size_t)TT * DM, 13);
      LAUNCH1(10, l); S16(WS_PQ, (size_t)TT * DM, 14);
      LAUNCH1(11, l); S32(WS_PG, (size_t)TT * 128, 15);
      LAUNCH1(12, l); S32(WS_XS, (size_t)TT * DM, 16);
    }
    hipLaunchKernelGGL(k_dbg_out, dim3(NBATCH * SEQ / 4), dim3(256), 0, stream, (const float*)d_in[0], (const float*)d_in[29], (float*)d_out, flags, 16);
#elif defined(DBG_CHECK)
    unsigned* flags = (unsigned*)((char*)d_ws + WS_CTL + 32768);
    char* W = (char*)d_ws;
    LAUNCH1(0, 0);
    { const int l = 0; LAUNCH1(1, l); LAUNCH1(2, l); LAUNCH1(3, l); LAUNCH1(4, l); LAUNCH1(5, l); LAUNCH1(6, l);
#if DBG_CHECK == 5 || DBG_CHECK == 6
      hipLaunchKernelGGL(k_check_attn, dim3(16 * 24), dim3(256), 0, stream, (const unsigned char*)d_ws, DBG_CHECK == 5 ? 1 : 0, flags + 100);
#endif
#if DBG_CHECK == 7
      { float* obuf = (float*)(W + WS_MQ);
        hipLaunchKernelGGL(k_check_gla_rec, dim3(8), dim3(256), 0, stream, (const unsigned char*)d_ws, (const float*)d_in[I_WA2F], (const float*)d_in[I_BAF], (const float*)d_in[I_WA2B], (const float*)d_in[I_BAB], obuf, 0);
        hipLaunchKernelGGL(k_check_gla_cmp, dim3(RPB * 4), dim3(256), 0, stream, (const unsigned char*)d_ws, (const float*)obuf, (const float*)d_in[I_ONG], 0, flags + 100); }
#endif
      LAUNCH1(7, l); LAUNCH1(8, l); LAUNCH1(9, l); LAUNCH1(10, l);
#if DBG_CHECK == 1
      hipLaunchKernelGGL(k_check_gemm, dim3(32), dim3(256), 0, stream, (const bf16_t*)(W + WS_HB), DM, (const float*)d_in[I_PWQ], DM, DM, (const bf16_t*)(W + WS_PQ), DM, TT, flags + 100);
#endif
      LAUNCH1(11, l);
#if DBG_CHECK == 2
      hipLaunchKernelGGL(k_check_select, dim3(256 * 8), dim3(64), 0, stream, (const bf16_t*)(W + WS_PQ), (const float*)d_in[I_PK1], (const float*)d_in[I_PK2], (const int*)(W + WS_PIDX), (const float*)(W + WS_PG), flags + 100);
#endif
      LAUNCH1(12, l);
#if DBG_CHECK == 3
      hipLaunchKernelGGL(k_check_gather, dim3(128), dim3(64), 0, stream, (const bf16_t*)(W + WS_HB), (const float*)d_in[I_PU], (const float*)d_in[I_PV], (const int*)(W + WS_PIDX), (const float*)(W + WS_PG), (const float*)(W + WS_MQ), flags + 100);
#endif
    }
    hipLaunchKernelGGL(k_dbg_out2, dim3(NBATCH * SEQ / 4), dim3(256), 0, stream, (const float*)d_in[0], (const float*)d_in[29], (float*)d_out, flags + 100);
#else
    LAUNCH1(0, 0);
    for (int l = 0; l < DEPTH; ++l) { LAUNCH1(1, l); LAUNCH1(2, l); LAUNCH1(3, l); LAUNCH1(4, l); LAUNCH1(5, l); LAUNCH1(6, l); LAUNCH1(7, l); LAUNCH1(8, l); LAUNCH1(9, l); LAUNCH1(10, l); LAUNCH1(11, l); LAUNCH1(12, l); }
    LAUNCH1(13, DEPTH - 1);
#endif
#undef LAUNCH1
#endif
    const hipError_t le = hipPeekAtLastError();
    if (le != hipSuccess) fprintf(stderr, "kernel_launch: launch failed: %s\n", hipGetErrorName(le));
}
```

```cpp
#include <hip/hip_runtime.h>
#include <cstdio>
#include <cstdint>

#ifndef MK_N_LAUNCHES
#ifndef DBG_DUP
#define DBG_DUP -1
#endif
#define MK_N_LAUNCHES 1
#endif

#ifndef DBG_MIX0
#define DBG_MIX0 1.0f
#define DBG_MIX1 1.0f
#define DBG_PEER0 1.0f
#define DBG_PEER1 1.0f
#endif
#define LAS __attribute__((address_space(3)))
typedef unsigned short bf16_t;
typedef short bf16x8 __attribute__((ext_vector_type(8)));
typedef short s16x4 __attribute__((ext_vector_type(4)));
typedef float f32x4 __attribute__((ext_vector_type(4)));
typedef float f32x2 __attribute__((ext_vector_type(2)));
typedef float f32x16 __attribute__((ext_vector_type(16)));
typedef unsigned u32x4 __attribute__((ext_vector_type(4)));
typedef unsigned u32x2 __attribute__((ext_vector_type(2)));
typedef __bf16 bf2_t __attribute__((ext_vector_type(2)));

constexpr int DM = 2048, NBATCH = 2, SEQ = 8192, CTXL = 256, DEPTH = 2;
constexpr int RPB = SEQ + CTXL;
constexpr int TT = NBATCH * RPB;
constexpr int IN_COLS = 11872, NP = 12032;
constexpr int C_AQ = 0, C_AK = 1024, C_AV = 1280, C_LQ = 1536, C_LK = 2048, C_LV = 2560, C_LG = 3584, C_LRF = 4608, C_LRB = 4624,
              C_MCQ = 4640, C_MCKV = 5152, C_MKR = 5664, C_GA = 5728, C_GL = 7776, C_GM = 9824;
constexpr int NCH = RPB / 64;
constexpr int NEXP = 16384;
constexpr float NORM_EPS = 1e-6f;
constexpr int NTHREADS = 512;

constexpr size_t al256(size_t x) { return (x + 255) / 256 * 256; }
constexpr size_t WS_CTL   = 0;
constexpr size_t CTL_BYTES = 65536;
constexpr size_t WS_MODV  = WS_CTL + CTL_BYTES;
constexpr size_t WS_TABA  = al256(WS_MODV + (size_t)2 * 3 * 12288 * 4);
constexpr size_t WS_TABM  = WS_TABA + 2 * 128 * 32 * 4;
constexpr size_t WS_XS    = al256(WS_TABM + 2 * 128 * 16 * 4);
constexpr size_t WS_HB    = WS_XS + (size_t)TT * DM * 4;
constexpr size_t WS_P     = WS_HB + (size_t)TT * DM * 2;
constexpr size_t WS_MQ    = WS_P + (size_t)TT * NP * 2;
constexpr size_t WS_MKV   = WS_MQ + (size_t)TT * 1536 * 2;
constexpr size_t WS_OA    = WS_MKV + (size_t)TT * 2048 * 2;
constexpr size_t WS_OL    = WS_OA + (size_t)TT * 1024 * 2;
constexpr size_t WS_OM    = WS_OL + (size_t)TT * 1024 * 2;
constexpr size_t WS_WIN   = WS_OM + (size_t)TT * 1024 * 2;
constexpr size_t WS_WUQ   = WS_WIN + (size_t)NP * 2048 * 2;
constexpr size_t WS_WUKV  = WS_WUQ + (size_t)1536 * 512 * 2;
constexpr size_t WS_WBR   = WS_WUKV + (size_t)2048 * 512 * 2;
constexpr size_t WS_WOUT  = WS_WBR + (size_t)3 * 2048 * 1024 * 2;
constexpr size_t WS_WQ    = WS_WOUT + (size_t)2048 * 2048 * 2;
constexpr size_t WS_K1    = WS_WQ + (size_t)2048 * 2048 * 2;
constexpr size_t WS_K2    = WS_K1 + (size_t)8 * 128 * 128 * 2;
constexpr size_t WS_GST   = WS_K2 + (size_t)8 * 128 * 128 * 2;
constexpr size_t WS_GDEC  = WS_GST + (size_t)NBATCH * 2 * 4 * NCH * 32768 * 2;
constexpr size_t WS_END   = WS_GDEC + (size_t)NBATCH * 2 * 4 * NCH * 128 * 4;
constexpr size_t WS_Y     = WS_MKV;
constexpr size_t WS_PQ    = WS_OA;
constexpr size_t WS_U8    = WS_P;
constexpr size_t WS_V8    = WS_U8 + (size_t)NEXP * DM;
constexpr size_t WS_SCU   = WS_V8 + (size_t)NEXP * DM;
constexpr size_t WS_SCV   = WS_SCU + (size_t)NEXP * 4;
constexpr size_t WS_PIDX  = WS_SCV + (size_t)NEXP * 4;
constexpr size_t WS_PG    = WS_PIDX + (size_t)TT * 128 * 4;
static_assert(WS_PG + (size_t)TT * 128 * 4 <= WS_MQ, "PEER alias region overflows P");

__device__ __forceinline__ unsigned cvt_pk_bf16(float lo, float hi) { bf2_t v; v.x = (__bf16)lo; v.y = (__bf16)hi; return __builtin_bit_cast(unsigned, v); }
__device__ __forceinline__ bf16_t f2bf(float f) { return (bf16_t)(cvt_pk_bf16(f, 0.f) & 0xffffu); }
__device__ __forceinline__ float bf2f(bf16_t b) { return __uint_as_float(((unsigned)b) << 16); }
__device__ __forceinline__ float bflo(unsigned w) { return __uint_as_float(w << 16); }
__device__ __forceinline__ float bfhi(unsigned w) { return __uint_as_float(w & 0xffff0000u); }
__device__ __forceinline__ float wave_sum(float v) {
#pragma unroll
    for (int o = 32; o >= 1; o >>= 1) v += __shfl_xor(v, o);
    return v;
}
__device__ __forceinline__ float sigmoidf_(float x) { return 1.0f / (1.0f + __expf(-x)); }
__device__ __forceinline__ float siluf_(float x) { return x / (1.0f + __expf(-x)); }

#define XB_TMO      128
#define XB_XCNT(j)  (256  + 64 * (j))
#define XB_XSUB(j)  (1280 + 64 * (j))
#define XB_XGEN(j)  (2304 + 64 * (j))
#define XB_TOP      3328
#define XB_TOPGEN   3392
#define XCD_BAR_WORDS 3456
#define XB_SPIN_CAP (1u << 20)
__device__ __forceinline__ unsigned xb_ld(unsigned* p)              { return __hip_atomic_load(p, __ATOMIC_RELAXED, __HIP_MEMORY_SCOPE_AGENT); }
__device__ __forceinline__ unsigned xb_add(unsigned* p, unsigned v) { return __hip_atomic_fetch_add(p, v, __ATOMIC_RELAXED, __HIP_MEMORY_SCOPE_AGENT); }
__device__ __forceinline__ unsigned xb_xcc_id() { return (unsigned)__builtin_amdgcn_s_getreg((3 << 11) | 20) & 0xFu; }
#define XB_SPIN(cond, bar) do { unsigned _sp = 0; while (cond) { __builtin_amdgcn_s_sleep(1); \
    if ((++_sp & 255u) == 0u) { if (xb_ld(&(bar)[XB_TMO])) break; if (_sp > XB_SPIN_CAP) { atomicAdd(&(bar)[XB_TMO], 1u); break; } } } } while (0)
struct XcdBarrier { unsigned* bar; unsigned x; volatile LAS unsigned* st; };
__device__ __forceinline__ XcdBarrier xcd_barrier_post(unsigned* bar, volatile LAS unsigned* st) {
    XcdBarrier b; b.bar = bar; b.x = xb_xcc_id(); b.st = st;
    if (threadIdx.x == 0) (void)xb_add(&bar[XB_XCNT(b.x)], 1u);
    return b;
}
__device__ __forceinline__ void xcd_barrier_complete(unsigned* bar, unsigned x, unsigned& nloc, unsigned& nx) {
    const unsigned G = gridDim.x * gridDim.y * gridDim.z;
    unsigned sum, cnt, mine, sp = 0u;
    for (;;) {
        sum = 0u; cnt = 0u; mine = 0u;
#pragma unroll
        for (unsigned j = 0; j < 16; ++j) { const unsigned c = xb_ld(&bar[XB_XCNT(j)]); sum += c; cnt += (c > 0u) ? 1u : 0u; mine = (j == x) ? c : mine; }
        if (sum == G) break;
        __builtin_amdgcn_s_sleep(1);
        if ((++sp & 255u) == 0u) { if (xb_ld(&bar[XB_TMO])) break; if (sp > XB_SPIN_CAP) { atomicAdd(&bar[XB_TMO], 1u); break; } }
    }
    nloc = mine > 0u ? mine : 1u; nx = cnt > 0u ? cnt : 1u;
}
__device__ __forceinline__ void xcd_barrier(const XcdBarrier& b) {
    asm volatile("s_waitcnt vmcnt(0)" ::: "memory");
    __syncthreads();
    if (threadIdx.x == 0) {
        unsigned* bar = b.bar;
        __builtin_amdgcn_s_waitcnt(0);
        unsigned nloc = b.st[0], nx = b.st[1];
        if (nloc == 0u) { xcd_barrier_complete(bar, b.x, nloc, nx); b.st[0] = nloc; b.st[1] = nx; }
        const unsigned old = xb_add(&bar[XB_XSUB(b.x)], 1u);
        const unsigned gen = old / nloc;
        if (old + 1u == (gen + 1u) * nloc) {
            __builtin_amdgcn_fence(__ATOMIC_RELEASE, "agent");
            asm volatile("s_waitcnt vmcnt(0)" ::: "memory");
            const unsigned og = xb_add(&bar[XB_TOP], 1u);
            const unsigned tg = og / nx;
            if (og + 1u == (tg + 1u) * nx) xb_add(&bar[XB_TOPGEN], 1u);
            else XB_SPIN(xb_ld(&bar[XB_TOPGEN]) == tg, bar);
            __builtin_amdgcn_fence(__ATOMIC_ACQUIRE, "agent");
            xb_add(&bar[XB_XGEN(b.x)], 1u);
            asm volatile("s_waitcnt vmcnt(0)" ::: "memory");
        } else {
            XB_SPIN(xb_ld(&bar[XB_XGEN(b.x)]) == gen, bar);
            __builtin_amdgcn_fence(__ATOMIC_ACQUIRE, "agent");
            asm volatile("s_waitcnt vmcnt(0)" ::: "memory");
        }
    }
    __syncthreads();
}

namespace pg8 {
constexpr int BM = 256, BK = 64, HALF = 128, HTB = HALF * BK * 2, STAGE_BYTES = 8 * HTB, NXCD = 8, WGM = 8;
__host__ __device__ __forceinline__ int lds_byte(int r, int c) { const int st = (r >> 4) * 2 + (c >> 5), rr = r & 15, cc = c & 31, ob = rr * 64 + cc * 2; return st * 1024 + (ob ^ (((ob >> 9) & 1) << 5)); }
__host__ __device__ __forceinline__ void stage_rc(int b, int& R, int& C) { const int st = b / 1024, sb = b % 1024, swz = sb ^ (((sb >> 9) & 1) << 5); R = (st >> 1) * 16 + swz / 64; C = (st & 1) * 32 + (swz % 64) / 2; }
__host__ __device__ __forceinline__ int perm32(int rho) { const int n = rho >> 4, i = rho & 15; return 8 * (i >> 2) + 4 * n + (i & 3); }
struct Unit { int pm, pn; };
struct Gemm { const bf16_t* A; const bf16_t* Bt; int M, N, K, lda, ldb; };
struct StaticOrder {
    int nM, nN, nwg, G, c, latent;
    __host__ __device__ void init(int M, int N, int G_, int c_, int latent_ = 0) { latent = latent_; nM = latent_ ? 64 : M / BM; nN = N / BM; nwg = nM * nN; G = G_; c = c_; }
    __host__ __device__ bool next(int i, Unit& u) const {
        const long L = (long)i * G + c; if (L >= nwg) return false;
        int wgid = (int)L; { const int q = nwg / NXCD, r = nwg % NXCD, xcd = wgid % NXCD, off = wgid / NXCD; wgid = (xcd < r ? xcd * (q + 1) : r * (q + 1) + (xcd - r) * q) + off; }
        const int nig = WGM * nN, gid = wgid / nig, fm = gid * WGM, gsz = (nM - fm) < WGM ? (nM - fm) : WGM;
        u.pm = fm + ((wgid % nig) % gsz); u.pn = (wgid % nig) / gsz; if (latent) u.pm += 1 + (u.pm >= 32 ? 1 : 0); return true;
    }
};
struct EpiStoreBf16 {
    static constexpr bool PERM = true;
    bf16_t* O; int ldc;
    __device__ __forceinline__ void operator()(const f32x4 (&acc)[2][2][4][2], const Unit& u, int wr, int wc, int fr, int fq) const {
        const int row0 = u.pm * BM + wr * 64 + fr, col0 = u.pn * BM + wc * 32 + 8 * fq;
#pragma unroll
        for (int ai = 0; ai < 2; ++ai)
#pragma unroll
            for (int m = 0; m < 4; ++m) { bf16_t* rowp = O + (size_t)(row0 + ai * HALF + m * 16) * ldc + col0;
#pragma unroll
                for (int bj = 0; bj < 2; ++bj) { const f32x4 v0 = acc[ai][bj][m][0], v1 = acc[ai][bj][m][1];
                    u32x4 w; w.x = cvt_pk_bf16(v0[0], v0[1]); w.y = cvt_pk_bf16(v0[2], v0[3]); w.z = cvt_pk_bf16(v1[0], v1[1]); w.w = cvt_pk_bf16(v1[2], v1[3]);
                    *(u32x4*)(rowp + bj * HALF) = w; } }
    }
};
template <bool FIRST> struct EpiGate {
    static constexpr bool PERM = true;
    bf16_t* Y; int ldy; const bf16_t* Gt; int ldg;
    __device__ __forceinline__ void operator()(const f32x4 (&acc)[2][2][4][2], const Unit& u, int wr, int wc, int fr, int fq) const {
        const int row0 = u.pm * BM + wr * 64 + fr, col0 = u.pn * BM + wc * 32 + 8 * fq;
#pragma unroll
        for (int ai = 0; ai < 2; ++ai)
#pragma unroll
            for (int m = 0; m < 4; ++m) { const size_t r = (size_t)(row0 + ai * HALF + m * 16);
#pragma unroll
                for (int bj = 0; bj < 2; ++bj) { const f32x4 v0 = acc[ai][bj][m][0], v1 = acc[ai][bj][m][1];
                    const u32x4 g = *(const u32x4*)(Gt + r * ldg + col0 + bj * HALF);
                    float o[8];
                    o[0] = sigmoidf_(bflo(g.x)) * v0[0]; o[1] = sigmoidf_(bfhi(g.x)) * v0[1]; o[2] = sigmoidf_(bflo(g.y)) * v0[2]; o[3] = sigmoidf_(bfhi(g.y)) * v0[3];
                    o[4] = sigmoidf_(bflo(g.z)) * v1[0]; o[5] = sigmoidf_(bfhi(g.z)) * v1[1]; o[6] = sigmoidf_(bflo(g.w)) * v1[2]; o[7] = sigmoidf_(bfhi(g.w)) * v1[3];
                    bf16_t* yp = Y + r * ldy + col0 + bj * HALF;
                    if (!FIRST) { const u32x4 y = *(const u32x4*)yp;
                        o[0] += bflo(y.x); o[1] += bfhi(y.x); o[2] += bflo(y.y); o[3] += bfhi(y.y); o[4] += bflo(y.z); o[5] += bfhi(y.z); o[6] += bflo(y.w); o[7] += bfhi(y.w); }
                    u32x4 w; w.x = cvt_pk_bf16(o[0], o[1]); w.y = cvt_pk_bf16(o[2], o[3]); w.z = cvt_pk_bf16(o[4], o[5]); w.w = cvt_pk_bf16(o[6], o[7]);
                    *(u32x4*)yp = w; } }
    }
};
struct EpiResid {
    static constexpr bool PERM = false;
    float* X; int ldx; const float* gate; float gscale;
    __device__ __forceinline__ void operator()(const f32x4 (&acc)[2][2][4][2], const Unit& u, int wr, int wc, int fr, int fq) const {
        const int row0 = u.pm * BM + wr * 64 + fr, col0 = u.pn * BM + wc * 32 + 4 * fq;
        const int sel = (u.pm % 33 == 0) ? 2 : (u.pm / 33);
        const float* gp = gate + (size_t)sel * 12288 + col0;
        f32x4 gv[2][2];
#pragma unroll
        for (int bj = 0; bj < 2; ++bj)
#pragma unroll
            for (int n = 0; n < 2; ++n) gv[bj][n] = *(const f32x4*)(gp + bj * HALF + n * 16) * gscale;
#pragma unroll
        for (int ai = 0; ai < 2; ++ai)
#pragma unroll
            for (int m = 0; m < 4; ++m) { float* rowp = X + (size_t)(row0 + ai * HALF + m * 16) * ldx + col0;
#pragma unroll
                for (int bj = 0; bj < 2; ++bj)
#pragma unroll
                    for (int n = 0; n < 2; ++n) { f32x4* p = (f32x4*)(rowp + bj * HALF + n * 16); *p = *p + gv[bj][n] * acc[ai][bj][m][n]; } }
    }
};

template <class Epi, class Sched>
__device__ __forceinline__ void gemm_phase(LAS unsigned char* lds, const int tid, const Gemm g, const Sched& S, const Epi& E) {
    const int wid = __builtin_amdgcn_readfirstlane(tid >> 6), lane = tid & 63, wr = wid >> 2, wc = wid & 3, fr = lane & 15, fq = lane >> 4;
    const int K = g.K, nt = K / BK, lda = g.lda, ldb = g.ldb;
    unsigned voffA[2], voffB[2];
#pragma unroll
    for (int i = 0; i < 2; ++i) { int R, C; stage_rc(tid * 16 + i * 8192, R, C); const int Rb = Epi::PERM ? ((R & ~31) + perm32(R & 31)) : R;
        voffA[i] = (unsigned)(R * lda + C) * 2u; voffB[i] = (unsigned)(Rb * ldb + C) * 2u; }
    const size_t kstep = (size_t)(BK * 2);
    const size_t hstepA = (size_t)HALF * lda * 2, hstepB = (size_t)HALF * ldb * 2;
    const size_t tstepA = 2 * hstepA, tstepB = 2 * hstepB;
    const unsigned ldsw = (unsigned)wid * 1024u;
    const int aoff = lds_byte(wr * 64 + fr, fq * 8), boff = lds_byte(wc * 32 + fr, fq * 8);
#define PG8_SA(b, h) (((b) * 2 + (h)) * HTB)
#define PG8_SB(b, h) ((4 + (b) * 2 + (h)) * HTB)
#define PG8_STAGE(bufoff, gbase, voff) do { _Pragma("unroll") for (int _i = 0; _i < 2; ++_i) \
        __builtin_amdgcn_global_load_lds((const unsigned*)((const char*)(gbase) + (voff)[_i]), (LAS unsigned*)(lds + (bufoff) + ldsw + _i * 8192), 16, 0, 0); } while (0)
#define PG8_LDA(dst, b, h) do { _Pragma("unroll") for (int m = 0; m < 4; ++m) _Pragma("unroll") for (int k = 0; k < 2; ++k) dst[m][k] = *(const LAS bf16x8*)(lds + PG8_SA(b, h) + aoff + m * 2048 + k * 1024); } while (0)
#define PG8_LDB(dst, b, h) do { _Pragma("unroll") for (int n = 0; n < 2; ++n) _Pragma("unroll") for (int k = 0; k < 2; ++k) dst[n][k] = *(const LAS bf16x8*)(lds + PG8_SB(b, h) + boff + n * 2048 + k * 1024); } while (0)
#define PG8_MMA(ai, bj, At, Bt) do { __builtin_amdgcn_s_setprio(1); _Pragma("unroll") for (int m = 0; m < 4; ++m) _Pragma("unroll") for (int n = 0; n < 2; ++n) _Pragma("unroll") for (int k = 0; k < 2; ++k) \
        acc[ai][bj][m][n] = __builtin_amdgcn_mfma_f32_16x16x32_bf16(Bt[n][k], At[m][k], acc[ai][bj][m][n], 0, 0, 0); __builtin_amdgcn_s_setprio(0); } while (0)
#define PG8_WAIT_V(n) asm volatile("s_waitcnt vmcnt(" #n ")" ::: "memory")
#define PG8_WAIT_L(n) asm volatile("s_waitcnt lgkmcnt(" #n ")" ::: "memory")
#define PG8_BAR __builtin_amdgcn_s_barrier()
#define PG8_SCHED __builtin_amdgcn_sched_barrier(0)
    Unit cur, nxt; int ui = 0;
    if (!S.next(0, cur)) return;
    f32x4 acc[2][2][4][2];
#pragma unroll
    for (int a = 0; a < 2; ++a)
#pragma unroll
        for (int b = 0; b < 2; ++b)
#pragma unroll
            for (int m = 0; m < 4; ++m)
#pragma unroll
                for (int n = 0; n < 2; ++n) acc[a][b][m][n] = (f32x4){0.f, 0.f, 0.f, 0.f};
    bf16x8 At[4][2], B0[2][2], B1[2][2];
    const char* cA = (const char*)g.A + (size_t)cur.pm * tstepA; const char* cB = (const char*)g.Bt + (size_t)cur.pn * tstepB;
    PG8_STAGE(PG8_SB(0, 0), cB, voffB); PG8_STAGE(PG8_SA(0, 0), cA, voffA); PG8_STAGE(PG8_SB(0, 1), cB + hstepB, voffB); PG8_STAGE(PG8_SA(0, 1), cA + hstepA, voffA);
    if (wr == 1) PG8_BAR;
    PG8_WAIT_V(4); PG8_BAR;
    PG8_STAGE(PG8_SB(1, 0), cB + kstep, voffB); PG8_STAGE(PG8_SA(1, 0), cA + kstep, voffA); PG8_STAGE(PG8_SB(1, 1), cB + hstepB + kstep, voffB);
    PG8_WAIT_V(6); PG8_BAR;
    for (;;) {
        const bool has_next = S.next(ui + 1, nxt);
        const char* nA = has_next ? (const char*)g.A + (size_t)nxt.pm * tstepA : cA; const char* nB = has_next ? (const char*)g.Bt + (size_t)nxt.pn * tstepB : cB;
        for (int t = 0; t < nt; t += 2) {
            const bool last = (t == nt - 2);
            const char* a1 = cA + (size_t)(t + 1) * kstep;
            const char* a2 = last ? nA : cA + (size_t)(t + 2) * kstep; const char* b2 = last ? nB : cB + (size_t)(t + 2) * kstep;
            const char* a3 = a2 + kstep; const char* b3 = b2 + kstep;
            PG8_LDB(B0, 0, 0); PG8_SCHED; PG8_LDA(At, 0, 0); PG8_STAGE(PG8_SA(1, 1), a1 + hstepA, voffA);
            PG8_WAIT_L(8); PG8_BAR; PG8_WAIT_L(0); PG8_MMA(0, 0, At, B0); PG8_BAR; PG8_SCHED;
            PG8_LDB(B1, 0, 1); PG8_STAGE(PG8_SB(0, 0), b2, voffB);
            PG8_BAR; PG8_WAIT_L(0); PG8_MMA(0, 1, At, B1); PG8_BAR;
            PG8_LDA(At, 0, 1); PG8_STAGE(PG8_SA(0, 0), a2, voffA);
            PG8_BAR; PG8_WAIT_L(0); PG8_MMA(1, 0, At, B0); PG8_BAR; PG8_SCHED;
            PG8_STAGE(PG8_SB(0, 1), b2 + hstepB, voffB);
            PG8_WAIT_V(6); PG8_BAR; PG8_MMA(1, 1, At, B1); PG8_BAR;
            PG8_LDB(B0, 1, 0); PG8_SCHED; PG8_LDA(At, 1, 0); PG8_STAGE(PG8_SA(0, 1), a2 + hstepA, voffA);
            PG8_WAIT_L(8); PG8_BAR; PG8_WAIT_L(0); PG8_MMA(0, 0, At, B0); PG8_BAR; PG8_SCHED;
            PG8_LDB(B1, 1, 1); PG8_STAGE(PG8_SB(1, 0), b3, voffB);
            PG8_BAR; PG8_WAIT_L(0); PG8_MMA(0, 1, At, B1); PG8_BAR;
            PG8_LDA(At, 1, 1); PG8_STAGE(PG8_SA(1, 0), a3, voffA);
            PG8_BAR; PG8_WAIT_L(0); PG8_MMA(1, 0, At, B0); PG8_BAR; PG8_SCHED;
            PG8_STAGE(PG8_SB(1, 1), b3 + hstepB, voffB);
            PG8_WAIT_V(6); PG8_BAR; PG8_MMA(1, 1, At, B1); PG8_BAR;
        }
        E(acc, cur, wr, wc, fr, fq);
        if (!has_next) break;
#pragma unroll
        for (int a = 0; a < 2; ++a)
#pragma unroll
            for (int b = 0; b < 2; ++b)
#pragma unroll
                for (int m = 0; m < 4; ++m)
#pragma unroll
                    for (int n = 0; n < 2; ++n) acc[a][b][m][n] = (f32x4){0.f, 0.f, 0.f, 0.f};
        cur = nxt; cA = nA; cB = nB; ++ui;
    }
    PG8_WAIT_V(0);
    if (wr == 0) PG8_BAR;
    PG8_BAR;
#undef PG8_SA
#undef PG8_SB
#undef PG8_STAGE
#undef PG8_LDA
#undef PG8_LDB
#undef PG8_MMA
#undef PG8_WAIT_V
#undef PG8_WAIT_L
#undef PG8_BAR
#undef PG8_SCHED
}
}

struct Args { const float* in[30]; float* out; unsigned char* ws; int ph_lo, ph_hi; };
enum { I_X = 0, I_C, I_CTX, I_CCTX, I_WMOD, I_BMOD, I_N1G, I_WIN, I_QNG, I_KNG, I_WA2F, I_BAF, I_WA2B, I_BAB, I_ONG, I_MQNG, I_WUQ, I_MKVNG, I_WUKV,
       I_WBRA, I_WBRL, I_WBRM, I_WOUT, I_N2G, I_PWQ, I_PK1, I_PK2, I_PU, I_PV, I_FG };
typedef const float* cfp_t;
struct Ctx {
    const __attribute__((address_space(4))) cfp_t* in; float* out; unsigned char* ws; LAS unsigned char* lds;
    int tid, lane, wid, G, bid;
};
#define WSP(T, off) ((T*)(C.ws + (off)))
#define INP(i) (C.in[(i)])
__device__ __forceinline__ unsigned long long launder_u64(unsigned long long w) {
    unsigned lo = (unsigned)w, hi = (unsigned)(w >> 32); asm volatile("" : "+v"(lo), "+v"(hi));
    lo = __builtin_amdgcn_readfirstlane(lo); hi = __builtin_amdgcn_readfirstlane(hi); return ((unsigned long long)hi << 32) | lo;
}
__device__ __forceinline__ Ctx launder(const Ctx& C0) {
    Ctx R = C0; int t = C0.tid; asm volatile("" : "+v"(t)); R.tid = t; R.lane = t & 63; R.wid = __builtin_amdgcn_readfirstlane(t >> 6);
    R.ws = (unsigned char*)launder_u64((unsigned long long)C0.ws);
    R.in = (const __attribute__((address_space(4))) cfp_t*)launder_u64((unsigned long long)C0.in);
    unsigned l = (unsigned)(uintptr_t)C0.lds; asm volatile("" : "+v"(l)); l = __builtin_amdgcn_readfirstlane(l); R.lds = (LAS unsigned char*)(uintptr_t)l;
    return R;
}

__device__ __forceinline__ const float* src_row(const Ctx& C, int r) {
    const int b = r / RPB, j = r % RPB;
    return j < CTXL ? INP(I_CTX) + ((size_t)b * CTXL + j) * DM : INP(I_X) + ((size_t)b * SEQ + (j - CTXL)) * DM;
}
__device__ __forceinline__ int mod_sel(int r) { const int b = r / RPB, j = r % RPB; return j < CTXL ? 2 : b; }

__device__ __forceinline__ void phase_modv(const Ctx& C) {
    LAS float* sc = (LAS float*)C.lds;
    LAS float* red = (LAS float*)(C.lds + 3 * 2048 * 4);
    for (int i = C.tid; i < 3 * DM; i += NTHREADS) { const int r = i / DM, k = i % DM; const float v = r < 2 ? INP(I_C)[r * DM + k] : INP(I_CCTX)[k]; sc[i] = siluf_(v); }
    __syncthreads();
    float* modv = WSP(float, WS_MODV);
    const int kq = C.tid / 12, c4 = C.tid % 12;
    for (int item = C.bid; item < 2 * 256; item += C.G) {
        const int l = item / 256, cg = item % 256;
        float acc[3][4];
#pragma unroll
        for (int r = 0; r < 3; ++r)
#pragma unroll
            for (int j = 0; j < 4; ++j) acc[r][j] = 0.f;
        if (kq < 42) {
            const float* wp = INP(I_WMOD) + (size_t)l * DM * 12288 + 48 * cg + 4 * c4;
            for (int k = kq; k < DM; k += 42) {
                const f32x4 w = *(const f32x4*)(wp + (size_t)k * 12288);
#pragma unroll
                for (int r = 0; r < 3; ++r) { const float s = sc[r * DM + k];
#pragma unroll
                    for (int j = 0; j < 4; ++j) acc[r][j] += s * w[j]; }
            }
#pragma unroll
            for (int r = 0; r < 3; ++r)
#pragma unroll
                for (int j = 0; j < 4; ++j) red[kq * 144 + r * 48 + c4 * 4 + j] = acc[r][j];
        }
        __syncthreads();
        if (C.tid < 144) { float s = 0.f; for (int q = 0; q < 42; ++q) s += red[q * 144 + C.tid];
            const int r = C.tid / 48, cc = C.tid % 48;
            modv[((size_t)l * 3 + r) * 12288 + 48 * cg + cc] = s + INP(I_BMOD)[(size_t)l * 12288 + 48 * cg + cc]; }
        __syncthreads();
    }
}
__device__ __forceinline__ void phase_tables(const Ctx& C) {
    float* ta = WSP(float, WS_TABA); float* tm = WSP(float, WS_TABM);
    for (int i = C.bid * NTHREADS + C.tid; i < 128 * 32 + 128 * 16; i += C.G * NTHREADS) {
        if (i < 128 * 32) { const int pos = i / 32, f = i % 32; const float inv = exp2f(-(float)f * (13.287712379549449f / 32.0f)); const float a = (float)pos * inv;
            ta[i] = cosf(a); ta[128 * 32 + i] = sinf(a); }
        else { const int k = i - 128 * 32, pos = k / 16, f = k % 16; const float inv = exp2f(-(float)f * (13.287712379549449f / 16.0f)); const float a = (float)pos * inv;
            tm[k] = cosf(a); tm[128 * 16 + k] = sinf(a); }
    }
}
__device__ __forceinline__ void transpose_cvt(const Ctx& C, const float* src, int K, int N, bf16_t* dst, int Npad, int& item) {
    LAS float* tile = (LAS float*)C.lds;
    const int tk = K / 64, tn = Npad / 64, ntile = tk * tn;
    const int t0 = ((C.bid - item % C.G) + C.G) % C.G; item += ntile;
    for (int t = t0; t < ntile; t += C.G) {
        const int k0 = (t / tn) * 64, n0 = (t % tn) * 64;
#pragma unroll
        for (int p = 0; p < 2; ++p) { const int kk = (C.tid >> 4) + p * 32, nn = (C.tid & 15) * 4;
            f32x4 v = (f32x4){0.f, 0.f, 0.f, 0.f};
            if (n0 + nn < N) v = *(const f32x4*)(src + (size_t)(k0 + kk) * N + n0 + nn);
#pragma unroll
            for (int j = 0; j < 4; ++j) tile[kk * 65 + nn + j] = v[j]; }
        __syncthreads();
        { const int n = C.tid >> 3, k8 = (C.tid & 7) * 8; float v[8];
#pragma unroll
          for (int j = 0; j < 8; ++j) v[j] = tile[(k8 + j) * 65 + n];
          u32x4 w; w.x = cvt_pk_bf16(v[0], v[1]); w.y = cvt_pk_bf16(v[2], v[3]); w.z = cvt_pk_bf16(v[4], v[5]); w.w = cvt_pk_bf16(v[6], v[7]);
          *(u32x4*)(dst + (size_t)(n0 + n) * K + k0 + k8) = w; }
        __syncthreads();
    }
}
__device__ __forceinline__ void cvt_plain(const Ctx& C, const float* src, bf16_t* dst, size_t n8) {
    for (size_t i = (size_t)C.bid * NTHREADS + C.tid; i < n8; i += (size_t)C.G * NTHREADS) {
        const f32x4 a = *(const f32x4*)(src + i * 8), b = *(const f32x4*)(src + i * 8 + 4);
        u32x4 w; w.x = cvt_pk_bf16(a[0], a[1]); w.y = cvt_pk_bf16(a[2], a[3]); w.z = cvt_pk_bf16(b[0], b[1]); w.w = cvt_pk_bf16(b[2], b[3]);
        *(u32x4*)(dst + i * 8) = w;
    }
}
__device__ __forceinline__ void phase_cvt_mixer_weights(const Ctx& C, int l) {
    int item = 0;
    transpose_cvt(C, INP(I_WIN) + (size_t)l * DM * IN_COLS, DM, IN_COLS, WSP(bf16_t, WS_WIN), NP, item);
    transpose_cvt(C, INP(I_WUQ) + (size_t)l * 512 * 1536, 512, 1536, WSP(bf16_t, WS_WUQ), 1536, item);
    transpose_cvt(C, INP(I_WUKV) + (size_t)l * 512 * 2048, 512, 2048, WSP(bf16_t, WS_WUKV), 2048, item);
    transpose_cvt(C, INP(I_WBRA) + (size_t)l * 1024 * 2048, 1024, 2048, WSP(bf16_t, WS_WBR), 2048, item);
    transpose_cvt(C, INP(I_WBRL) + (size_t)l * 1024 * 2048, 1024, 2048, WSP(bf16_t, WS_WBR) + (size_t)2048 * 1024, 2048, item);
    transpose_cvt(C, INP(I_WBRM) + (size_t)l * 1024 * 2048, 1024, 2048, WSP(bf16_t, WS_WBR) + (size_t)2 * 2048 * 1024, 2048, item);
    transpose_cvt(C, INP(I_WOUT) + (size_t)l * 2048 * 2048, 2048, 2048, WSP(bf16_t, WS_WOUT), 2048, item);
    transpose_cvt(C, INP(I_PWQ) + (size_t)l * 2048 * 2048, 2048, 2048, WSP(bf16_t, WS_WQ), 2048, item);
    cvt_plain(C, INP(I_PK1) + (size_t)l * 8 * 128 * 128, WSP(bf16_t, WS_K1), 8 * 128 * 128 / 8);
    cvt_plain(C, INP(I_PK2) + (size_t)l * 8 * 128 * 128, WSP(bf16_t, WS_K2), 8 * 128 * 128 / 8);
}
__device__ __forceinline__ void phase_cvt_peer_tables(const Ctx& C, int l) {
    const int lane = C.lane;
    for (int row = C.bid * 8 + C.wid; row < NEXP; row += C.G * 8) {
#pragma unroll 1
        for (int tb = 0; tb < 2; ++tb) {
            const float* src = (tb ? INP(I_PV) : INP(I_PU)) + ((size_t)l * NEXP + row) * DM + lane * 16;
            f32x4 x[8]; float amax = 0.f;
#pragma unroll
            for (int c = 0; c < 2; ++c)
#pragma unroll
                for (int q = 0; q < 4; ++q) { x[c * 4 + q] = *(const f32x4*)(src + c * 1024 + q * 4);
                    amax = fmaxf(amax, fmaxf(fmaxf(fabsf(x[c * 4 + q][0]), fabsf(x[c * 4 + q][1])), fmaxf(fabsf(x[c * 4 + q][2]), fabsf(x[c * 4 + q][3])))); }
#pragma unroll
            for (int o = 32; o >= 1; o >>= 1) amax = fmaxf(amax, __shfl_xor(amax, o));
            const float sc = amax > 0.f ? 224.0f / amax : 1.0f, inv = amax > 0.f ? amax * (1.0f / 224.0f) : 1.0f;
            unsigned char* dst = C.ws + (tb ? WS_V8 : WS_U8) + (size_t)(lane >> 3) * ((size_t)NEXP * 128) + (size_t)row * 128 + (lane & 7) * 16;
#pragma unroll
            for (int c = 0; c < 2; ++c) { u32x4 w;
#pragma unroll
                for (int q = 0; q < 4; ++q) { const f32x4 v = x[c * 4 + q] * sc; int p = __builtin_amdgcn_cvt_pk_fp8_f32(v[0], v[1], 0, false); p = __builtin_amdgcn_cvt_pk_fp8_f32(v[2], v[3], p, true); w[q] = (unsigned)p; }
                *(u32x4*)(dst + (size_t)c * 8 * ((size_t)NEXP * 128)) = w; }
            if (lane == 0) WSP(float, tb ? WS_SCV : WS_SCU)[row] = inv;
        }
    }
}

template <bool FIRST> __device__ __forceinline__ void phase_norm_mod(const Ctx& C, const float* gvec, const float* modl  , int shift_off, int scale_off) {
    float* xs = WSP(float, WS_XS); bf16_t* hb = WSP(bf16_t, WS_HB);
    for (int r = C.bid * 8 + C.wid; r < TT; r += C.G * 8) {
        const float* xr = FIRST ? src_row(C, r) : xs + (size_t)r * DM;
        const float* mv = modl + (size_t)mod_sel(r) * 12288;
        f32x4 v[8]; float ss = 0.f;
#pragma unroll
        for (int c = 0; c < 4; ++c) { v[2 * c] = *(const f32x4*)(xr + c * 512 + C.lane * 8); v[2 * c + 1] = *(const f32x4*)(xr + c * 512 + C.lane * 8 + 4); }
#pragma unroll
        for (int c = 0; c < 8; ++c) ss += v[c][0] * v[c][0] + v[c][1] * v[c][1] + v[c][2] * v[c][2] + v[c][3] * v[c][3];
        ss = wave_sum(ss);
        const float rs = rsqrtf(ss * (1.0f / DM) + NORM_EPS);
#pragma unroll
        for (int c = 0; c < 4; ++c) { const int col = c * 512 + C.lane * 8;
            if (FIRST) { *(f32x4*)(xs + (size_t)r * DM + col) = v[2 * c]; *(f32x4*)(xs + (size_t)r * DM + col + 4) = v[2 * c + 1]; }
            float o[8];
#pragma unroll
            for (int h = 0; h < 2; ++h) { const f32x4 g = *(const f32x4*)(gvec + col + 4 * h), s = *(const f32x4*)(mv + scale_off + col + 4 * h), t = *(const f32x4*)(mv + shift_off + col + 4 * h);
#pragma unroll
                for (int j = 0; j < 4; ++j) o[4 * h + j] = v[2 * c + h][j] * rs * g[j] * (1.0f + s[j]) + t[j]; }
            u32x4 w; w.x = cvt_pk_bf16(o[0], o[1]); w.y = cvt_pk_bf16(o[2], o[3]); w.z = cvt_pk_bf16(o[4], o[5]); w.w = cvt_pk_bf16(o[6], o[7]);
            *(u32x4*)(hb + (size_t)r * DM + col) = w; }
    }
}

__device__ __forceinline__ void phase_post_p(const Ctx& C, int l) {
    bf16_t* P = WSP(bf16_t, WS_P); const float* ta = WSP(float, WS_TABA); const float* tm = WSP(float, WS_TABM);
    const float* qg = INP(I_QNG) + l * 128; const float* kg = INP(I_KNG) + l * 128;
    const float* mqg = INP(I_MQNG) + l * 512; const float* mkvg = INP(I_MKVNG) + l * 512;
    const int lane = C.lane;
    const float qg1 = qg[lane], qg2 = qg[lane + 64], kg1 = kg[lane], kg2 = kg[lane + 64];
    for (int r = C.bid * 8 + C.wid; r < TT; r += C.G * 8) {
        bf16_t* pr = P + (size_t)r * NP;
        const int j = r % RPB; const bool lat = j >= CTXL; const int pos = lat ? j - CTXL : 0, ri = pos >> 6, ci = pos & 63;
        float cs = 1.f, sn = 0.f;
        if (lat) { const int p = lane < 32 ? ri : ci, f = lane & 31; cs = ta[p * 32 + f]; sn = ta[128 * 32 + p * 32 + f]; }
#pragma unroll
        for (int h = 0; h < 10; ++h) {
            bf16_t* hp = pr + (h < 8 ? C_AQ + h * 128 : C_AK + (h - 8) * 128);
            const float x1 = bf2f(hp[lane]), x2 = bf2f(hp[lane + 64]);
            const float ss = wave_sum(x1 * x1 + x2 * x2);
            const float rs = rsqrtf(ss * (1.0f / 128.0f) + NORM_EPS);
            const float y1 = x1 * rs * (h < 8 ? qg1 : kg1), y2 = x2 * rs * (h < 8 ? qg2 : kg2);
            hp[lane] = f2bf(y1 * cs - y2 * sn); hp[lane + 64] = f2bf(y2 * cs + y1 * sn);
        }
#pragma unroll
        for (int s = 0; s < 2; ++s) {
            bf16_t* sp = pr + (s == 0 ? C_MCQ : C_MCKV) + lane * 8; const float* gg = (s == 0 ? mqg : mkvg) + lane * 8;
            const u32x4 w = *(const u32x4*)sp; float x[8] = {bflo(w.x), bfhi(w.x), bflo(w.y), bfhi(w.y), bflo(w.z), bfhi(w.z), bflo(w.w), bfhi(w.w)};
            float ss = 0.f;
#pragma unroll
            for (int i = 0; i < 8; ++i) ss += x[i] * x[i];
            ss = wave_sum(ss);
            const float rs = rsqrtf(ss * (1.0f / 512.0f) + NORM_EPS);
#pragma unroll
            for (int i = 0; i < 8; ++i) x[i] = x[i] * rs * gg[i];
            u32x4 o; o.x = cvt_pk_bf16(x[0], x[1]); o.y = cvt_pk_bf16(x[2], x[3]); o.z = cvt_pk_bf16(x[4], x[5]); o.w = cvt_pk_bf16(x[6], x[7]);
            *(u32x4*)sp = o;
        }
        if (lat) { bf16_t* kp = pr + C_MKR; const int i = lane & 31; const float x1 = bf2f(kp[i]), x2 = bf2f(kp[i + 32]);
            const int p = i < 16 ? ri : ci, f = i & 15; const float c2 = tm[p * 16 + f], s2 = tm[128 * 16 + p * 16 + f];
            if (lane < 32) { kp[i] = f2bf(x1 * c2 - x2 * s2); kp[i + 32] = f2bf(x2 * c2 + x1 * s2); } }
    }
}

namespace att {
constexpr int NW = 8, QBLK = 32, KVBLK = 64, DV = 128;
constexpr float THR = 8.f;
#define SBAR() __builtin_amdgcn_sched_barrier(0)
__device__ __forceinline__ int crow(int r, int hi) { return (r & 3) + 8 * (r >> 2) + 4 * hi; }
template <int DQ> struct Cf {
    static constexpr int ND0 = DQ / 16, KROWB = DQ * 2, SHM_K = KVBLK * DQ * 2, SHM_V = KVBLK * DV * 2, SHM = 2 * SHM_V + 2 * SHM_K + NW * 64 * 4;
    static constexpr float SCALE = DQ == 128 ? 0.088388347648318440f : 0.072168783648703220f;
    __device__ static __forceinline__ int kswz(int row, int colB) { return row * KROWB + (colB ^ ((row & 7) << 4)); }
};
template <int DQ> __device__ __forceinline__ void partialSM(f32x16& p0, f32x16& p1, float& m_reg, float& mn, float& alpha) {
    constexpr float SC = Cf<DQ>::SCALE, Cc = SC * 1.4426950408889634f;
    float pmax = p0[0];
#pragma unroll
    for (int r = 1; r < 16; ++r) pmax = fmaxf(pmax, p0[r]);
#pragma unroll
    for (int r = 0; r < 16; ++r) pmax = fmaxf(pmax, p1[r]);
    { auto rr = __builtin_amdgcn_permlane32_swap(__float_as_uint(pmax), __float_as_uint(pmax), false, false);
      pmax = fmaxf(__uint_as_float(rr[0]), __uint_as_float(rr[1])); }
    if (__builtin_expect(__all(pmax - m_reg <= THR / SC), 1)) { mn = m_reg; alpha = 1.f; }
    else { mn = fmaxf(m_reg, pmax); alpha = __builtin_amdgcn_exp2f((m_reg - mn) * Cc); m_reg = mn; }
    const float mnC = -mn * Cc;
#pragma unroll
    for (int r = 0; r < 16; ++r) p0[r] = fmaf(p0[r], Cc, mnC);
#pragma unroll
    for (int r = 0; r < 16; ++r) p1[r] = fmaf(p1[r], Cc, mnC);
#pragma unroll
    for (int r = 0; r < 16; ++r) p0[r] = __builtin_amdgcn_exp2f(p0[r]);
}
__device__ __forceinline__ void finishSM(f32x16& p0, f32x16& p1, float alpha, float& l_reg, bf16x8& pa0, bf16x8& pa1, bf16x8& pa2, bf16x8& pa3) {
#pragma unroll
    for (int r = 0; r < 16; ++r) p1[r] = __builtin_amdgcn_exp2f(p1[r]);
    float ps = 0;
#pragma unroll
    for (int r = 0; r < 16; ++r) ps += p0[r];
#pragma unroll
    for (int r = 0; r < 16; ++r) ps += p1[r];
    { auto rr = __builtin_amdgcn_permlane32_swap(__float_as_uint(ps), __float_as_uint(ps), false, false);
      ps = __uint_as_float(rr[0]) + __uint_as_float(rr[1]); }
    l_reg = l_reg * alpha + ps;
#define PK4(P, BASE, OUT) do { unsigned a0 = cvt_pk_bf16(P[BASE + 0], P[BASE + 1]), a1 = cvt_pk_bf16(P[BASE + 2], P[BASE + 3]);   \
    unsigned b0 = cvt_pk_bf16(P[BASE + 4], P[BASE + 5]), b1 = cvt_pk_bf16(P[BASE + 6], P[BASE + 7]);                              \
    auto r0 = __builtin_amdgcn_permlane32_swap(a0, b0, false, false); auto r1 = __builtin_amdgcn_permlane32_swap(a1, b1, false, false); \
    u32x4 w = {r0[0], r1[0], r0[1], r1[1]}; OUT = *reinterpret_cast<bf16x8*>(&w); } while (0)
    PK4(p0, 0, pa0); PK4(p0, 8, pa1); PK4(p1, 0, pa2); PK4(p1, 8, pa3);
#undef PK4
}
template <int DQ> __device__ __forceinline__ void qkt(f32x16& p0, f32x16& p1, const char* Ks, const bf16x8* qr, const char* qx, int r32, int hi) {
    p0 = f32x16{}; p1 = f32x16{};
#pragma unroll
    for (int d0 = 0; d0 < Cf<DQ>::ND0; ++d0) { const int cb = (d0 * 16 + hi * 8) * 2;
        const bf16x8 b0 = *reinterpret_cast<const bf16x8*>(Ks + Cf<DQ>::kswz(r32, cb));
        const bf16x8 b1 = *reinterpret_cast<const bf16x8*>(Ks + Cf<DQ>::kswz(32 + r32, cb));
        constexpr int NQR = DQ == 192 ? 4 : 8;
        bf16x8 q; if (d0 < NQR) q = qr[d0]; else q = *reinterpret_cast<const bf16x8*>(qx + (d0 - NQR) * 1024);
        p0 = __builtin_amdgcn_mfma_f32_32x32x16_bf16(b0, q, p0, 0, 0, 0);
        p1 = __builtin_amdgcn_mfma_f32_32x32x16_bf16(b1, q, p1, 0, 0, 0); }
}
__device__ __forceinline__ int v_st(int k, int c) { const int kk = (k & ~0xC) | ((k & 4) << 1) | ((k & 8) >> 1); return ((kk >> 3) * 4 + (c >> 5)) * 512 + ((kk & 7) * 32 + (c & 31)) * 2; }
__device__ __forceinline__ int v_rd_base(int lane) { return ((lane & 3) << 3) | (((lane >> 2) & 3) << 6) | (((lane >> 4) & 1) << 5) | (((lane >> 5) & 1) << 8); }
constexpr int v_rd_off(int d0, int ks, int half) { return d0 * 512 + ks * 4096 + half * 2048; }
template <int OFF> __device__ __forceinline__ s16x4 tr_read(int vb) {
    s16x4 r; asm volatile("ds_read_b64_tr_b16 %0, %1 offset:%2" : "=&v"(r) : "v"(vb), "i"(OFF) : "memory"); return r;
}
template <int D0> __device__ __forceinline__ void pv_one(f32x16& od, int vb, bf16x8 pa0, bf16x8 pa1, bf16x8 pa2, bf16x8 pa3) {
    const s16x4 l0 = tr_read<v_rd_off(D0, 0, 0)>(vb), h0 = tr_read<v_rd_off(D0, 0, 1)>(vb), l1 = tr_read<v_rd_off(D0, 1, 0)>(vb), h1 = tr_read<v_rd_off(D0, 1, 1)>(vb);
    const s16x4 l2 = tr_read<v_rd_off(D0, 2, 0)>(vb), h2 = tr_read<v_rd_off(D0, 2, 1)>(vb), l3 = tr_read<v_rd_off(D0, 3, 0)>(vb), h3 = tr_read<v_rd_off(D0, 3, 1)>(vb);
    asm volatile("s_waitcnt lgkmcnt(0)" ::: "memory"); SBAR();
#define PK(L, H) (bf16x8){L[0], L[1], L[2], L[3], H[0], H[1], H[2], H[3]}
    od = __builtin_amdgcn_mfma_f32_32x32x16_bf16(pa0, PK(l0, h0), od, 0, 0, 0);
    od = __builtin_amdgcn_mfma_f32_32x32x16_bf16(pa1, PK(l1, h1), od, 0, 0, 0);
    od = __builtin_amdgcn_mfma_f32_32x32x16_bf16(pa2, PK(l2, h2), od, 0, 0, 0);
    od = __builtin_amdgcn_mfma_f32_32x32x16_bf16(pa3, PK(l3, h3), od, 0, 0, 0);
#undef PK
}
__device__ __forceinline__ void pv_d0(f32x16* o, int vb, bf16x8 pa0, bf16x8 pa1, bf16x8 pa2, bf16x8 pa3) {
    pv_one<0>(o[0], vb, pa0, pa1, pa2, pa3); pv_one<1>(o[1], vb, pa0, pa1, pa2, pa3); pv_one<2>(o[2], vb, pa0, pa1, pa2, pa3); pv_one<3>(o[3], vb, pa0, pa1, pa2, pa3);
}
__device__ __forceinline__ bf16x8 ld8(const bf16_t* p) { return *reinterpret_cast<const bf16x8*>(p); }

template <int DQ, int SD>
__device__ __forceinline__ void attn_body(const bf16_t* __restrict__ Qb, int ldq, const bf16_t* __restrict__ Kn, int ldkn, const bf16_t* __restrict__ Kr, int ldkr,
                                          const bf16_t* __restrict__ Vh, int ldv, bf16_t* __restrict__ Ob, int ldo, int seq, bool rope_q, int pos0, const float* __restrict__ tabM, char* lds, const int tid) {
    using CF = Cf<DQ>; constexpr int ND0 = CF::ND0, SHM_V = CF::SHM_V, SHM_K = CF::SHM_K;
    const int wid = tid >> 6, lane = tid & 63, r32 = lane & 31, hi = lane >> 5;
    char* V_lds = lds; char* K_lds = lds + 2 * SHM_V;
    float* ws = (float*)(lds + 2 * SHM_V + 2 * SHM_K) + wid * 64; float* li_l = ws; float* al_l = ws + 32;
    constexpr int NQR = DQ == 192 ? 4 : 8;
    float m_reg = -1e30f, l_reg = 0; f32x16 o[4] = {}; bf16x8 qr[NQR];
    const bf16_t* Qw = Qb + (long)(wid * QBLK + r32) * ldq + hi * 8;
#pragma unroll
    for (int d0 = 0; d0 < NQR; ++d0) qr[d0] = ld8(Qw + d0 * 16);
    char* qx = lds + CF::SHM + wid * 8192 + lane * 16;
    if constexpr (DQ == 192) {
#pragma unroll
        for (int d0 = 4; d0 < 8; ++d0) *(bf16x8*)(qx + (d0 - 4) * 1024) = ld8(Qw + d0 * 16);
        bf16x8 qe[4];
#pragma unroll
        for (int d0 = 0; d0 < 4; ++d0) qe[d0] = ld8(Qw + (8 + d0) * 16);
        if (rope_q) {
            const int pos = pos0 + wid * QBLK + r32, ri = pos >> 6, ci = pos & 63;
#pragma unroll
            for (int t = 0; t < 2; ++t) { const int p = t == 0 ? ri : ci; const float* tc = tabM + p * 16 + hi * 8; const float* tsn = tabM + 128 * 16 + p * 16 + hi * 8;
                bf16x8 a = qe[t], b = qe[2 + t];
#pragma unroll
                for (int jj = 0; jj < 8; ++jj) { const float x1 = bf2f((bf16_t)a[jj]), x2 = bf2f((bf16_t)b[jj]), c = tc[jj], s = tsn[jj];
                    a[jj] = (short)f2bf(x1 * c - x2 * s); b[jj] = (short)f2bf(x2 * c + x1 * s); }
                qe[t] = a; qe[2 + t] = b; }
        }
#pragma unroll
        for (int d0 = 0; d0 < 4; ++d0) *(bf16x8*)(qx + (4 + d0) * 1024) = qe[d0];
    }
    const int sr = tid >> 4, sc = (tid & 15) * 8, vst0 = v_st(sr, sc), vst1 = v_st(32 + sr, sc);
    const int sr2 = tid >> 3, sc2 = (tid & 7) * 8;
    const int vb0 = (int)(uintptr_t)V_lds + v_rd_base(lane);
    struct { bf16x8 vs0, vs1, ks0, ks1, ks2; } sr_[SD];
    const unsigned offV = (unsigned)(sr * ldv + sc) * 2u, offK = (unsigned)(sr * ldkn + sc) * 2u, offR = (unsigned)(sr2 * ldkr + sc2) * 2u;
#define SLOAD(i, k0) do { const char* vt_ = (const char*)Vh + (size_t)(k0) * ldv * 2; const char* kt_ = (const char*)Kn + (size_t)(k0) * ldkn * 2; \
    sr_[i].vs0 = *(const bf16x8*)(vt_ + offV); sr_[i].vs1 = *(const bf16x8*)(vt_ + (size_t)32 * ldv * 2 + offV); \
    sr_[i].ks0 = *(const bf16x8*)(kt_ + offK); sr_[i].ks1 = *(const bf16x8*)(kt_ + (size_t)32 * ldkn * 2 + offK); \
    if constexpr (DQ == 192) sr_[i].ks2 = *(const bf16x8*)((const char*)Kr + (size_t)(k0) * ldkr * 2 + offR); } while (0)
#define SWRITE(b, i) do { *(bf16x8*)(V_lds + (b) * SHM_V + vst0) = sr_[i].vs0; *(bf16x8*)(V_lds + (b) * SHM_V + vst1) = sr_[i].vs1; const int kc = sc * 2; \
    *(bf16x8*)(K_lds + (b) * SHM_K + CF::kswz(sr, kc)) = sr_[i].ks0; *(bf16x8*)(K_lds + (b) * SHM_K + CF::kswz(32 + sr, kc)) = sr_[i].ks1; \
    if constexpr (DQ == 192) *(bf16x8*)(K_lds + (b) * SHM_K + CF::kswz(sr2, 256 + sc2 * 2)) = sr_[i].ks2; } while (0)
#define SWAIT() do { if constexpr (SD == 1) asm volatile("s_waitcnt vmcnt(0)" ::: "memory"); else if constexpr (DQ == 192) asm volatile("s_waitcnt vmcnt(5)" ::: "memory"); else asm volatile("s_waitcnt vmcnt(4)" ::: "memory"); } while (0)
#define RESC(a) do { if (__any((a) < 1.f)) { if (hi == 0) al_l[r32] = (a); asm volatile("s_waitcnt lgkmcnt(0)" ::: "memory"); \
    _Pragma("unroll") for (int d = 0; d < 4; ++d) _Pragma("unroll") for (int r = 0; r < 16; ++r) o[d][r] *= al_l[crow(r, hi)]; } } while (0)
    f32x16 pA0, pA1, pB0, pB1; float mnA, mnB, alA, alB; bf16x8 pa0, pa1, pa2, pa3; const int NT = seq / KVBLK;
    constexpr int SE = 0, SO = SD - 1;
    SLOAD(SE, 0); asm volatile("s_waitcnt vmcnt(0)" ::: "memory"); SWRITE(0, SE); __syncthreads();
    qkt<DQ>(pA0, pA1, K_lds, qr, qx, r32, hi); partialSM<DQ>(pA0, pA1, m_reg, mnA, alA);
    SLOAD(SO, KVBLK); if constexpr (SD == 2) { if (2 < NT) SLOAD(SE, 2 * KVBLK); }
    SWAIT(); SWRITE(1, SO); __syncthreads();
    for (int j = 1; j + 1 < NT; j += 2) {
        SBAR(); qkt<DQ>(pB0, pB1, K_lds + SHM_K, qr, qx, r32, hi);
        finishSM(pA0, pA1, alA, l_reg, pa0, pa1, pa2, pa3); SBAR();
        SLOAD(SO, (j + SD) * KVBLK); SBAR();
        pv_d0(o, vb0, pa0, pa1, pa2, pa3); partialSM<DQ>(pB0, pB1, m_reg, mnB, alB);
        __syncthreads(); SWAIT(); SWRITE(0, SE);
        RESC(alB); __syncthreads();
        SBAR(); qkt<DQ>(pA0, pA1, K_lds, qr, qx, r32, hi);
        finishSM(pB0, pB1, alB, l_reg, pa0, pa1, pa2, pa3); SBAR();
        if (SD == 1 || j + 3 < NT) SLOAD(SE, (j + 1 + SD) * KVBLK); SBAR();
        pv_d0(o, vb0 + SHM_V, pa0, pa1, pa2, pa3); partialSM<DQ>(pA0, pA1, m_reg, mnA, alA);
        __syncthreads(); SWAIT(); SWRITE(1, SO);
        RESC(alA); __syncthreads();
    }
    SBAR(); qkt<DQ>(pB0, pB1, K_lds + SHM_K, qr, qx, r32, hi);
    finishSM(pA0, pA1, alA, l_reg, pa0, pa1, pa2, pa3); SBAR();
    pv_d0(o, vb0, pa0, pa1, pa2, pa3); partialSM<DQ>(pB0, pB1, m_reg, mnB, alB);
    __syncthreads(); RESC(alB);
    finishSM(pB0, pB1, alB, l_reg, pa0, pa1, pa2, pa3); SBAR();
    pv_d0(o, vb0 + SHM_V, pa0, pa1, pa2, pa3);
    if (hi == 0) li_l[r32] = l_reg; asm volatile("s_waitcnt lgkmcnt(0)" ::: "memory");
    float rli[16];
#pragma unroll
    for (int r = 0; r < 16; ++r) rli[r] = __builtin_amdgcn_rcpf(li_l[crow(r, hi)]);
    bf16_t* Ow = Ob + (long)(wid * QBLK) * ldo;
#pragma unroll
    for (int r = 0; r < 16; ++r) { const int orow = crow(r, hi);
#pragma unroll
        for (int d0 = 0; d0 < 4; ++d0) Ow[(long)orow * ldo + d0 * 32 + r32] = f2bf(o[d0][r] * rli[r]); }
#undef SLOAD
#undef SWRITE
#undef SWAIT
#undef RESC
}
}

template <int KS> __device__ __forceinline__ void mma_xy(f32x16& acc, const LAS bf16_t* X, const LAS bf16_t* Y, int hi) {
#pragma unroll
    for (int ks = 0; ks < KS; ++ks) { const bf16x8 a = *(const LAS bf16x8*)(X + ks * 16 + hi * 8), b = *(const LAS bf16x8*)(Y + ks * 16 + hi * 8);
        acc = __builtin_amdgcn_mfma_f32_32x32x16_bf16(a, b, acc, 0, 0, 0); }
}
__device__ __forceinline__ float logsig16(float x) { const float e = __expf(-fabsf(x)); return (fminf(x, 0.f) - __logf(1.f + e)) * 0.0625f; }
__device__ __forceinline__ int gla_sidx(int b, int dir, int h) { return (b * 2 + dir) * 4 + h; }

__device__ __forceinline__ void gla_cumsum(const Ctx& C, int l, int h, int dir, const LAS float* lr, LAS float* segtot, float (&cum)[16]) {
    const int seg = C.tid >> 7, d = C.tid & 127;
    const float* wa = INP(dir ? I_WA2B : I_WA2F) + (size_t)l * 16 * 512 + h * 128 + d;
    const float bias = INP(dir ? I_BAB : I_BAF)[l * 512 + h * 128 + d];
    float w[16];
#pragma unroll
    for (int j = 0; j < 16; ++j) w[j] = wa[j * 512];
    float run = 0.f;
#pragma unroll
    for (int i = 0; i < 16; ++i) { const int s = seg * 16 + i, tk = dir ? 63 - s : s; float pre = bias;
#pragma unroll
        for (int j = 0; j < 16; ++j) pre += lr[tk * 32 + dir * 16 + j] * w[j];
        run += logsig16(pre); cum[i] = run; }
    segtot[seg * 128 + d] = run;
    __syncthreads();
    float off = 0.f;
#pragma unroll
    for (int q = 0; q < 3; ++q) if (q < seg) off += segtot[q * 128 + d];
#pragma unroll
    for (int i = 0; i < 16; ++i) cum[i] += off;
    __syncthreads();
}

__device__ __forceinline__ void phase_gla_local(const Ctx& C, int l) {
    const bf16_t* P = WSP(bf16_t, WS_P); bf16_t* GST = WSP(bf16_t, WS_GST); float* GDEC = WSP(float, WS_GDEC);
    LAS float* lr = (LAS float*)C.lds;
    LAS float* segtot = (LAS float*)(C.lds + 8192);
    LAS bf16_t* KT = (LAS bf16_t*)(C.lds + 8192 + 2048);
    LAS bf16_t* VT = (LAS bf16_t*)(C.lds + 8192 + 2048 + 18432);
    const int r32 = C.lane & 31, hi = C.lane >> 5, seg = C.tid >> 7, d = C.tid & 127;
    for (int unit = C.bid; unit < NBATCH * 4 * NCH; unit += C.G) {
        const int b = unit / (4 * NCH), h = (unit / NCH) % 4, ck = unit % NCH; const size_t r0 = (size_t)b * RPB + ck * 64;
        for (int i = C.tid; i < 64 * 32; i += NTHREADS) lr[i] = bf2f(P[(r0 + (i >> 5)) * NP + C_LRF + (i & 31)]);
        for (int i = C.tid; i < 64 * 256; i += NTHREADS) { const int s = i >> 8, e = i & 255; VT[e * 72 + s] = P[(r0 + s) * NP + C_LV + h * 256 + e]; }
        __syncthreads();
#pragma unroll 1
        for (int dir = 0; dir < 2; ++dir) {
            float cum[16];
            gla_cumsum(C, l, h, dir, lr, segtot, cum);
            if (seg == 3) segtot[d] = cum[15];
            __syncthreads();
            const float bend = segtot[d];
            const size_t sx = (size_t)gla_sidx(b, dir, h) * NCH + ck;
            if (seg == 0) GDEC[sx * 128 + d] = __expf(bend);
#pragma unroll
            for (int i = 0; i < 16; ++i) { const int s = seg * 16 + i, tk = dir ? 63 - s : s;
                const float kv = bf2f(P[(r0 + tk) * NP + C_LK + h * 128 + d]);
                KT[d * 72 + tk] = f2bf(kv * __expf(bend - cum[i])); }
            __syncthreads();
            { const int dt = C.wid & 3, eb = (C.wid >> 2) * 4;
              f32x16 acc[4] = {};
#pragma unroll
              for (int q = 0; q < 4; ++q) mma_xy<4>(acc[q], KT + (dt * 32 + r32) * 72, VT + ((eb + q) * 32 + r32) * 72, hi);
              bf16_t* st = GST + sx * 32768;
#pragma unroll
              for (int q = 0; q < 4; ++q)
#pragma unroll
                  for (int g = 0; g < 4; ++g) { u32x2 w; w.x = cvt_pk_bf16(acc[q][4 * g], acc[q][4 * g + 1]); w.y = cvt_pk_bf16(acc[q][4 * g + 2], acc[q][4 * g + 3]);
                      *(u32x2*)(st + (size_t)((eb + q) * 32 + r32) * 128 + dt * 32 + 8 * g + 4 * hi) = w; } }
            __syncthreads();
        }
    }
}

__device__ __forceinline__ void phase_gla_scan(const Ctx& C) {
    bf16_t* GST = WSP(bf16_t, WS_GST); const float* GDEC = WSP(float, WS_GDEC);
    for (int gid = C.bid * NTHREADS + C.tid; gid < 16 * 8192; gid += C.G * NTHREADS) {
        const int sidx = gid >> 13, g = gid & 8191, dir = (sidx >> 2) & 1, d4 = (g & 31) * 4;
        bf16_t* base = GST + (size_t)sidx * NCH * 32768 + (size_t)g * 4;
        const float* dbase = GDEC + (size_t)sidx * NCH * 128 + d4;
        float S[4] = {0.f, 0.f, 0.f, 0.f};
        for (int st = 0; st < NCH; st += 4) {
            int ck[4]; u32x2 L[4]; f32x4 dc[4];
#pragma unroll
            for (int q = 0; q < 4; ++q) { const int s = st + q; ck[q] = dir ? (s < 4 ? 3 - s : NCH + 3 - s) : s;
                L[q] = *(const u32x2*)(base + (size_t)ck[q] * 32768); dc[q] = *(const f32x4*)(dbase + (size_t)ck[q] * 128); }
#pragma unroll
            for (int q = 0; q < 4; ++q) { u32x2 w; w.x = cvt_pk_bf16(S[0], S[1]); w.y = cvt_pk_bf16(S[2], S[3]);
                *(u32x2*)(base + (size_t)ck[q] * 32768) = w;
                S[0] = dc[q][0] * S[0] + bflo(L[q].x); S[1] = dc[q][1] * S[1] + bfhi(L[q].x); S[2] = dc[q][2] * S[2] + bflo(L[q].y); S[3] = dc[q][3] * S[3] + bfhi(L[q].y); }
        }
    }
}

__device__ __forceinline__ void phase_gla_out(const Ctx& C, int l) {
    const bf16_t* P = WSP(bf16_t, WS_P); const bf16_t* GST = WSP(bf16_t, WS_GST); bf16_t* OL = WSP(bf16_t, WS_OL);
    LAS float* lr = (LAS float*)C.lds;
    LAS float* segtot = (LAS float*)(C.lds + 8192);
    LAS bf16_t* QT = (LAS bf16_t*)(C.lds + 10240);
    LAS bf16_t* KT = (LAS bf16_t*)(C.lds + 27648);
    LAS bf16_t* VT = (LAS bf16_t*)(C.lds + 45056);
    LAS bf16_t* SCm = (LAS bf16_t*)(C.lds + 81920);
    LAS float* OB = (LAS float*)(C.lds + 91136);
    const float* gon = INP(I_ONG) + l * 256;
    const int r32 = C.lane & 31, hi = C.lane >> 5, seg = C.tid >> 7, d = C.tid & 127;
    for (int unit = C.bid; unit < NBATCH * 4 * NCH; unit += C.G) {
        const int b = unit / (4 * NCH), h = (unit / NCH) % 4, ck = unit % NCH; const size_t r0 = (size_t)b * RPB + ck * 64;
        for (int i = C.tid; i < 64 * 32; i += NTHREADS) lr[i] = bf2f(P[(r0 + (i >> 5)) * NP + C_LRF + (i & 31)]);
        for (int i = C.tid; i < 64 * 256; i += NTHREADS) { const int s = i >> 8, e = i & 255; VT[e * 72 + s] = P[(r0 + s) * NP + C_LV + h * 256 + e]; }
        __syncthreads();
        f32x16 oacc[2] = {};
#pragma unroll 1
        for (int dir = 0; dir < 2; ++dir) {
            float cum[16];
            gla_cumsum(C, l, h, dir, lr, segtot, cum);
#pragma unroll
            for (int i = 0; i < 16; ++i) { const int s = seg * 16 + i, tk = dir ? 63 - s : s;
                const float qv = bf2f(P[(r0 + tk) * NP + C_LQ + h * 128 + d]), kv = bf2f(P[(r0 + tk) * NP + C_LK + h * 128 + d]);
                QT[tk * 136 + d] = f2bf(qv * __expf(cum[i]) * 0.088388347648318440f); KT[tk * 136 + d] = f2bf(kv * __expf(-cum[i])); }
            __syncthreads();
            if (C.wid < 4) { const int mt = C.wid >> 1, nt = C.wid & 1; f32x16 sc = {};
                mma_xy<8>(sc, QT + (mt * 32 + r32) * 136, KT + (nt * 32 + r32) * 136, hi);
#pragma unroll
                for (int i = 0; i < 16; ++i) { const int t = mt * 32 + att::crow(i, hi), s = nt * 32 + r32; const bool keep = dir ? (s >= t) : (s <= t);
                    SCm[t * 72 + s] = f2bf(keep ? sc[i] : 0.f); } }
            __syncthreads();
            { const bf16_t* st = GST + ((size_t)gla_sidx(b, dir, h) * NCH + ck) * 32768 + (size_t)(C.wid * 32 + r32) * 128 + hi * 8;
              bf16x8 sb[8];
#pragma unroll
              for (int ks = 0; ks < 8; ++ks) sb[ks] = *(const bf16x8*)(st + ks * 16);
#pragma unroll
              for (int mt = 0; mt < 2; ++mt) {
                  mma_xy<4>(oacc[mt], SCm + (mt * 32 + r32) * 72, VT + (C.wid * 32 + r32) * 72, hi);
#pragma unroll
                  for (int ks = 0; ks < 8; ++ks) { const bf16x8 a = *(const LAS bf16x8*)(QT + (mt * 32 + r32) * 136 + ks * 16 + hi * 8);
                      oacc[mt] = __builtin_amdgcn_mfma_f32_32x32x16_bf16(a, sb[ks], oacc[mt], 0, 0, 0); } } }
            __syncthreads();
        }
#pragma unroll
        for (int mt = 0; mt < 2; ++mt)
#pragma unroll
            for (int i = 0; i < 16; ++i) OB[(mt * 32 + att::crow(i, hi)) * 260 + C.wid * 32 + r32] = oacc[mt][i];
        __syncthreads();
        { const int t = C.tid >> 3, part = C.tid & 7; f32x4 v[8]; float ss = 0.f;
#pragma unroll
          for (int jj = 0; jj < 8; ++jj) { v[jj] = *(const LAS f32x4*)(OB + t * 260 + jj * 32 + part * 4); ss += v[jj][0] * v[jj][0] + v[jj][1] * v[jj][1] + v[jj][2] * v[jj][2] + v[jj][3] * v[jj][3]; }
          ss += __shfl_xor(ss, 1); ss += __shfl_xor(ss, 2); ss += __shfl_xor(ss, 4);
          const float rs = rsqrtf(ss * (1.0f / 256.0f) + NORM_EPS);
#pragma unroll
          for (int jj = 0; jj < 8; ++jj) { const int e = jj * 32 + part * 4; const f32x4 g = *(const f32x4*)(gon + e);
              const u32x2 gt = *(const u32x2*)(P + (r0 + t) * NP + C_LG + h * 256 + e);
              const float o0 = v[jj][0] * rs * g[0] * siluf_(bflo(gt.x)), o1 = v[jj][1] * rs * g[1] * siluf_(bfhi(gt.x)), o2 = v[jj][2] * rs * g[2] * siluf_(bflo(gt.y)), o3 = v[jj][3] * rs * g[3] * siluf_(bfhi(gt.y));
              u32x2 w; w.x = cvt_pk_bf16(o0, o1); w.y = cvt_pk_bf16(o2, o3);
              *(u32x2*)(OL + (r0 + t) * 1024 + h * 256 + e) = w; } }
        __syncthreads();
    }
}

__device__ __forceinline__ unsigned f_ord(float f) { const unsigned u = __float_as_uint(f); return u ^ ((unsigned)((int)u >> 31) | 0x80000000u); }
__device__ __forceinline__ float f_unord(unsigned k) { return __uint_as_float((k & 0x80000000u) ? (k ^ 0x80000000u) : ~k); }
__device__ __forceinline__ void ins_u(unsigned (&L)[16], unsigned x) {
#pragma unroll
    for (int j = 0; j < 16; ++j) { const unsigned h = L[j] > x ? L[j] : x; x = L[j] > x ? x : L[j]; L[j] = h; }
}
__device__ __forceinline__ void ins_f(float (&M)[16], float x) {
#pragma unroll
    for (int j = 0; j < 16; ++j) { const float h = M[j] > x ? M[j] : x; x = M[j] > x ? x : M[j]; M[j] = h; }
}
__device__ __forceinline__ void peer_top16(const bf16_t* __restrict__ qrow, const bf16_t* __restrict__ keys, int r32, int hi, unsigned (&L)[16]) {
    bf16x8 qf[8];
#pragma unroll
    for (int kk = 0; kk < 8; ++kk) qf[kk] = *(const bf16x8*)(qrow + kk * 16 + hi * 8);
#pragma unroll
    for (int j = 0; j < 16; ++j) L[j] = 0u;
#pragma unroll 1
    for (int mt = 0; mt < 4; ++mt) {
        f32x16 acc = {};
#pragma unroll
        for (int kk = 0; kk < 8; ++kk) { const bf16x8 a = *(const bf16x8*)(keys + (size_t)(mt * 32 + r32) * 128 + kk * 16 + hi * 8);
            acc = __builtin_amdgcn_mfma_f32_32x32x16_bf16(a, qf[kk], acc, 0, 0, 0); }
#pragma unroll
        for (int i = 0; i < 16; ++i) { const unsigned kidx = (unsigned)(mt * 32 + att::crow(i, hi)); ins_u(L, (f_ord(acc[i]) & ~127u) | (127u - kidx)); }
    }
    unsigned Pn[16];
#pragma unroll
    for (int j = 0; j < 16; ++j) Pn[j] = (unsigned)__shfl_xor((int)L[j], 32);
#pragma unroll
    for (int j = 0; j < 16; ++j) ins_u(L, Pn[j]);
}
__device__ __forceinline__ void phase_peer_select(const Ctx& C, const bool latent_only) {
    const bf16_t* PQ = WSP(bf16_t, WS_PQ); const bf16_t* K1 = WSP(bf16_t, WS_K1); const bf16_t* K2 = WSP(bf16_t, WS_K2);
    int* PIDX = WSP(int, WS_PIDX); float* PG = WSP(float, WS_PG);
    const int r32 = C.lane & 31, hi = C.lane >> 5, head = C.wid;
    const int ngrp = latent_only ? NBATCH * SEQ / 32 : TT / 32;
    for (int gi = C.bid; gi < ngrp; gi += C.G) {
        const int grp = latent_only ? gi + (CTXL / 32) * (1 + gi / (SEQ / 32)) : gi;
        const size_t tok = (size_t)grp * 32 + r32;
        unsigned L1[16], L2[16];
        peer_top16(PQ + tok * DM + head * 256, K1 + (size_t)head * 128 * 128, r32, hi, L1);
        peer_top16(PQ + tok * DM + head * 256 + 128, K2 + (size_t)head * 128 * 128, r32, hi, L2);
        float v1[16], v2[16];
#pragma unroll
        for (int j = 0; j < 16; ++j) { v1[j] = f_unord(L1[j] & ~127u); v2[j] = f_unord(L2[j] & ~127u); }
        float M[16];
#pragma unroll
        for (int j = 0; j < 16; ++j) M[j] = -3.0e38f;
#pragma unroll
        for (int a = 0; a < 16; ++a)
#pragma unroll
            for (int b = 0; b < 16; ++b) if ((a + 1) * (b + 1) <= 16) ins_f(M, v1[a] + v2[b]);
        const float thr = M[15], mx = M[0]; float den = 0.f;
#pragma unroll
        for (int j = 0; j < 16; ++j) den += __expf(M[j] - mx);
        const float rden = 1.0f / den;
        int pos = 0; int* ip = PIDX + tok * 128 + head * 16; float* gp = PG + tok * 128 + head * 16;
#pragma unroll
        for (int a = 0; a < 16; ++a)
#pragma unroll
            for (int b = 0; b < 16; ++b) if ((a + 1) * (b + 1) <= 16) {
                const float val = v1[a] + v2[b];
                if (val >= thr && pos < 16) { if (hi == 0) { ip[pos] = (int)((127u - (L1[a] & 127u)) * 128u + (127u - (L2[b] & 127u))); gp[pos] = __expf(val - mx) * rden; } ++pos; } }
    }
}
template <int OFF> __device__ __forceinline__ float dotf8(const float (&h)[32], const u32x4 w, float acc) {
#pragma unroll
    for (int j = 0; j < 4; ++j) { const f32x2 lo = __builtin_amdgcn_cvt_pk_f32_fp8((int)w[j], false), hi = __builtin_amdgcn_cvt_pk_f32_fp8((int)w[j], true);
        acc += h[OFF + 4 * j] * lo.x; acc += h[OFF + 4 * j + 1] * lo.y; acc += h[OFF + 4 * j + 2] * hi.x; acc += h[OFF + 4 * j + 3] * hi.y; }
    return acc;
}
constexpr int GT_MAXTOK = 9;
template <bool LAST> __device__ __forceinline__ void phase_peer_gather(const Ctx& C, const float* modl, const float pscale) {
    const bf16_t* HB = WSP(bf16_t, WS_HB); const unsigned char* U8 = C.ws + WS_U8; const unsigned char* V8 = C.ws + WS_V8;
    const float* SCU = WSP(float, WS_SCU); const float* SCV = WSP(float, WS_SCV);
    const int* PIDX = WSP(int, WS_PIDX); const float* PG = WSP(float, WS_PG); float* XS = WSP(float, WS_XS);
    const int lane = C.lane, s = lane >> 3, j = lane & 7;
    LAS int* IDS = (LAS int*)(C.lds + C.wid * (GT_MAXTOK * 512));
    LAS float* ACT = (LAS float*)(C.lds + 8 * GT_MAXTOK * 512 + C.wid * (GT_MAXTOK * 512));
    LAS int* ROWS = (LAS int*)(C.lds + 16 * GT_MAXTOK * 512 + C.wid * 64);
    int nk = 0;
    {
      const int per = (TT + C.G - 1) / C.G, base = C.bid * per;
#pragma unroll 1
      for (int k = 0; k < GT_MAXTOK; ++k) { const int o = C.wid + 8 * k; const int r = base + o; if (o < per && r < TT && !(LAST && (r % RPB) < CTXL)) { if (lane == 0) ROWS[nk] = r; ++nk; } } }
#define GT_ROW(k) __builtin_amdgcn_readfirstlane(ROWS[k])
#pragma unroll 1
    for (int k = 0; k < nk; ++k) { const int r = GT_ROW(k);
        IDS[k * 128 + lane] = PIDX[(size_t)r * 128 + lane] & (NEXP - 1); IDS[k * 128 + 64 + lane] = PIDX[(size_t)r * 128 + 64 + lane] & (NEXP - 1);
        ACT[k * 128 + lane] = 0.f; ACT[k * 128 + 64 + lane] = 0.f; }
    const int nit = 32 * nk;
#define GT_ITEM(it_) const int cb_ = (it_) / (2 * nk), rem_ = (it_) - cb_ * (2 * nk), k_ = rem_ >> 1, hf_ = rem_ & 1
#define GT_LOADU(UQ, HQ, it_) do { GT_ITEM(it_); const int r_ = GT_ROW(k_); \
        const bf16_t* hp_ = HB + (size_t)r_ * DM + cb_ * 128 + j * 16; HQ[0] = *(const u32x4*)hp_; HQ[1] = *(const u32x4*)(hp_ + 8); \
        const unsigned char* ub_ = U8 + (size_t)cb_ * ((size_t)NEXP * 128) + j * 16; \
        _Pragma("unroll") for (int eg = 0; eg < 8; ++eg) { const int id_ = IDS[k_ * 128 + (hf_ * 8 + eg) * 8 + s] & idmask; UQ[eg] = *(const u32x4*)(ub_ + (size_t)id_ * 128); } } while (0)
#define GT_COMPU(UQ, HQ, it_) do { GT_ITEM(it_); (void)cb_; f32x2 hf2[8]; \
        _Pragma("unroll") for (int hh = 0; hh < 2; ++hh) { const u32x4 w_ = HQ[hh]; \
            hf2[hh * 4 + 0] = (f32x2){bflo(w_.x), bfhi(w_.x)}; hf2[hh * 4 + 1] = (f32x2){bflo(w_.y), bfhi(w_.y)}; hf2[hh * 4 + 2] = (f32x2){bflo(w_.z), bfhi(w_.z)}; hf2[hh * 4 + 3] = (f32x2){bflo(w_.w), bfhi(w_.w)}; } \
        float d[8]; \
        _Pragma("unroll") for (int eg = 0; eg < 8; ++eg) { f32x2 d2 = (f32x2){0.f, 0.f}; \
            _Pragma("unroll") for (int q = 0; q < 4; ++q) { const f32x2 lo = __builtin_amdgcn_cvt_pk_f32_fp8((int)UQ[eg][q], false), hi = __builtin_amdgcn_cvt_pk_f32_fp8((int)UQ[eg][q], true); \
                d2 += hf2[2 * q] * lo; d2 += hf2[2 * q + 1] * hi; } \
            d[eg] = d2.x + d2.y; } \
          \
        float t4[4], t2[2], t1; \
        _Pragma("unroll") for (int i = 0; i < 4; ++i) { const float snd = (j & 4) ? d[i] : d[i + 4], kp = (j & 4) ? d[i + 4] : d[i]; t4[i] = kp + __shfl_xor(snd, 4); } \
        _Pragma("unroll") for (int i = 0; i < 2; ++i) { const float snd = (j & 2) ? t4[i] : t4[i + 2], kp = (j & 2) ? t4[i + 2] : t4[i]; t2[i] = kp + __shfl_xor(snd, 2); } \
        { const float snd = (j & 1) ? t2[0] : t2[1], kp = (j & 1) ? t2[1] : t2[0]; t1 = kp + __shfl_xor(snd, 1); } \
        ACT[k_ * 128 + (hf_ * 8 + j) * 8 + s] += t1; } while (0)
#ifdef DBG_GDUP
#pragma unroll 1
    for (int rep_ = 0; rep_ < 2; ++rep_) {
    const int idmask = rep_ == 0 ? DBG_GMASK : (NEXP - 1);
    if (rep_ == 1) { for (int k = 0; k < nk; ++k) { ACT[k * 128 + lane] = 0.f; ACT[k * 128 + 64 + lane] = 0.f; } }
#else
    { const int idmask = NEXP - 1;
#endif
    if (nit > 0) {
        u32x4 uA[8], uB[8], hA[2], hB[2];
        GT_LOADU(uA, hA, 0);
#pragma unroll 1
        for (int it = 0; it < nit; it += 2) {
            GT_LOADU(uB, hB, it + 1);
            GT_COMPU(uA, hA, it);
            if (it + 2 < nit) GT_LOADU(uA, hA, it + 2);
            GT_COMPU(uB, hB, it + 1);
        }
    }
    }
#undef GT_LOADU
#undef GT_COMPU
#pragma unroll 1
    for (int k = 0; k < nk; ++k) { const int r = GT_ROW(k);
#pragma unroll
        for (int hh = 0; hh < 2; ++hh) { const int e = hh * 64 + lane; const int id = IDS[k * 128 + e]; const float a = ACT[k * 128 + e] * SCU[id];
            const float w = PG[(size_t)r * 128 + e] * 0.5f * a * (1.0f + erff(a * 0.70710678118654752f));
#ifdef DBG_CHECK
            if (((r - 300) & 63) == 0 && r >= 300 && r < 300 + 64 * 128) WSP(float, WS_OM)[(size_t)r * 128 + e] = w;
#endif
            ACT[k * 128 + e] = w * SCV[id]; } }
#define GT_LOADV(VQ, WV, it_) do { GT_ITEM(it_); const unsigned char* vb_ = V8 + (size_t)cb_ * ((size_t)NEXP * 128) + j * 16; \
        _Pragma("unroll") for (int eg = 0; eg < 8; ++eg) { const int e_ = k_ * 128 + (hf_ * 8 + eg) * 8 + s; const int id_ = IDS[e_]; VQ[eg] = *(const u32x4*)(vb_ + (size_t)id_ * 128); WV[eg] = ACT[e_]; } } while (0)
#define GT_COMPV(VQ, WV) do { \
        _Pragma("unroll") for (int eg = 0; eg < 8; ++eg) { const f32x2 w2_ = (f32x2){WV[eg], WV[eg]}; \
            _Pragma("unroll") for (int q = 0; q < 4; ++q) { \
                const f32x2 lo = __builtin_amdgcn_cvt_pk_f32_fp8((int)VQ[eg][q], false), hi = __builtin_amdgcn_cvt_pk_f32_fp8((int)VQ[eg][q], true); \
                acc2[2 * q] += w2_ * lo; acc2[2 * q + 1] += w2_ * hi; } } } while (0)
    if (nit > 0) {
        u32x4 vA[8], vB[8]; float wA[8], wB[8];
        GT_LOADV(vA, wA, 0);
#pragma unroll 1
        for (int it = 0; it < nit; it += 2) {
            f32x2 acc2[8];
#pragma unroll
            for (int i = 0; i < 8; ++i) acc2[i] = (f32x2){0.f, 0.f};
            GT_LOADV(vB, wB, it + 1);
            GT_COMPV(vA, wA);
            if (it + 2 < nit) GT_LOADV(vA, wA, it + 2);
            GT_COMPV(vB, wB);
            f32x2 t4[4], t2[2], t1;
#pragma unroll
            for (int i = 0; i < 4; ++i) { const f32x2 snd = (s & 4) ? acc2[i] : acc2[i + 4], kp = (s & 4) ? acc2[i + 4] : acc2[i];
                t4[i] = kp + (f32x2){__shfl_xor(snd.x, 32), __shfl_xor(snd.y, 32)}; }
#pragma unroll
            for (int i = 0; i < 2; ++i) { const f32x2 snd = (s & 2) ? t4[i] : t4[i + 2], kp = (s & 2) ? t4[i + 2] : t4[i];
                t2[i] = kp + (f32x2){__shfl_xor(snd.x, 16), __shfl_xor(snd.y, 16)}; }
            { const f32x2 snd = (s & 1) ? t2[0] : t2[1], kp = (s & 1) ? t2[1] : t2[0]; t1 = kp + (f32x2){__shfl_xor(snd.x, 8), __shfl_xor(snd.y, 8)}; }
            { GT_ITEM(it); (void)hf_; const int r_ = GT_ROW(k_);
              const int col = cb_ * 128 + j * 16 + 2 * s; float* xp = XS + (size_t)r_ * DM + col; const float* g2 = modl + (size_t)mod_sel(r_) * 12288 + 5 * DM + col;
#ifdef DBG_CHECK
              if (((r_ - 300) & 63) == 0 && r_ >= 300 && r_ < 300 + 64 * 128) { float* dbgo = WSP(float, WS_MQ) + (size_t)r_ * DM + col; dbgo[0] = t1.x; dbgo[1] = t1.y; }
#endif
              const f32x2 x = *(const f32x2*)xp, g = *(const f32x2*)g2;
              *(f32x2*)xp = x + pscale * g * t1; }
        }
    }
#undef GT_LOADV
#undef GT_COMPV
#undef GT_ITEM
#undef GT_ROW
}
__device__ __forceinline__ void phase_final_norm(const Ctx& C) {
    const float* XS = WSP(float, WS_XS); const float* fg = INP(I_FG);
    for (int q = C.bid * 8 + C.wid; q < NBATCH * SEQ; q += C.G * 8) {
        const int b = q / SEQ, t = q % SEQ; const float* xr = XS + ((size_t)b * RPB + CTXL + t) * DM; float* op = C.out + (size_t)q * DM;
        f32x4 v[8]; float ss = 0.f;
#pragma unroll
        for (int c = 0; c < 8; ++c) { v[c] = *(const f32x4*)(xr + c * 256 + C.lane * 4); ss += v[c][0] * v[c][0] + v[c][1] * v[c][1] + v[c][2] * v[c][2] + v[c][3] * v[c][3]; }
        ss = wave_sum(ss); const float rs = rsqrtf(ss * (1.0f / DM) + NORM_EPS);
#pragma unroll
        for (int c = 0; c < 8; ++c) { const f32x4 g = *(const f32x4*)(fg + c * 256 + C.lane * 4); *(f32x4*)(op + c * 256 + C.lane * 4) = v[c] * rs * g; }
    }
}

template <int TYPE  > __device__ __forceinline__ void attn_units(const Ctx& C, bool need_ctx) {
    const bf16_t* P = WSP(bf16_t, WS_P);
    const int nu = need_ctx ? 528 : 512;
#pragma unroll 1
    for (int u = C.bid; u < nu; u += C.G) {
        int bh, qb; if (u < 512) { bh = (u >> 8) * 8 + (u & 7); qb = ((u & 255) >> 3) + 1; } else { bh = u - 512; qb = 0; }
        const int b = bh >> 3, h = bh & 7; const size_t rq = (size_t)b * RPB + (size_t)qb * 256, rk = (size_t)b * RPB; const int seq = qb == 0 ? CTXL : RPB;
        __syncthreads();
        if constexpr (TYPE == 1) {
            att::attn_body<128, 1>(P + rq * NP + C_AQ + h * 128, NP, P + rk * NP + C_AK + (h >> 2) * 128, NP, nullptr, 0, P + rk * NP + C_AV + (h >> 2) * 128, NP,
                                   WSP(bf16_t, WS_OA) + rq * 1024 + h * 128, 1024, seq, false, 0, nullptr, (char*)C.lds, C.tid);
        } else {
            const bf16_t* MQ = WSP(bf16_t, WS_MQ); const bf16_t* MKV = WSP(bf16_t, WS_MKV);
            att::attn_body<192, 1>(MQ + rq * 1536 + h * 192, 1536, MKV + rk * 2048 + h * 256, 2048, P + rk * NP + C_MKR, NP, MKV + rk * 2048 + h * 256 + 128, 2048,
                                   WSP(bf16_t, WS_OM) + rq * 1024 + h * 128, 1024, seq, qb > 0, (qb - 1) * 256, WSP(float, WS_TABM), (char*)C.lds, C.tid);
        }
    }
    __syncthreads();
}

constexpr int LDS_BYTES = 163840, LDS_BAR_OFF = LDS_BYTES - 16;
constexpr int N_PHASES = 26;
template <int K> __device__ __forceinline__ void run_phase(const Ctx& C0, int l) {
    const Ctx C = launder(C0);
    const float* modl = WSP(float, WS_MODV) + (size_t)l * 3 * 12288;
    if constexpr (K == 0) { phase_modv(C); phase_tables(C); __syncthreads(); phase_cvt_mixer_weights(C, 0); }
    if constexpr (K == 1) {
        if (l == 0) phase_norm_mod<true>(C, INP(I_N1G), modl, 0, DM);
        else { phase_norm_mod<false>(C, INP(I_N1G) + l * DM, modl, 0, DM); __syncthreads(); phase_cvt_mixer_weights(C, l); }
    }
    if constexpr (K == 2) {
        pg8::Gemm g{WSP(bf16_t, WS_HB), WSP(bf16_t, WS_WIN), TT, NP, DM, DM, DM}; pg8::StaticOrder S; S.init(TT, NP, C.G, C.bid);
        pg8::EpiStoreBf16 E{WSP(bf16_t, WS_P), NP};
        pg8::gemm_phase(C.lds, C.tid, g, S, E);
    }
    if constexpr (K == 3) phase_post_p(C, l);
    if constexpr (K == 4) {
        { pg8::Gemm g{WSP(bf16_t, WS_P) + C_MCQ, WSP(bf16_t, WS_WUQ), TT, 1536, 512, NP, 512}; pg8::StaticOrder S; S.init(TT, 1536, C.G, C.bid);
          pg8::EpiStoreBf16 E{WSP(bf16_t, WS_MQ), 1536}; pg8::gemm_phase(C.lds, C.tid, g, S, E); }
        { pg8::Gemm g{WSP(bf16_t, WS_P) + C_MCKV, WSP(bf16_t, WS_WUKV), TT, 2048, 512, NP, 512}; pg8::StaticOrder S; S.init(TT, 2048, C.G, C.bid);
          pg8::EpiStoreBf16 E{WSP(bf16_t, WS_MKV), 2048}; pg8::gemm_phase(C.lds, C.tid, g, S, E); }
        { const Ctx C2 = launder(C0); phase_gla_local(C2, l); }
#ifdef DBG_DUP_GLALOCAL
        { const Ctx C2 = launder(C0); __syncthreads(); phase_gla_local(C2, l); }
#endif
    }
    if constexpr (K == 5) phase_gla_scan(C);
    if constexpr (K == 6) { attn_units<0>(C, l + 1 < DEPTH); { const Ctx C2 = launder(C0); attn_units<1>(C2, l + 1 < DEPTH); } { const Ctx C3 = launder(C0); phase_gla_out(C3, l); }
#ifdef DBG_DUP_GLAOUT
        { const Ctx C3 = launder(C0); __syncthreads(); phase_gla_out(C3, l); }
#endif
    }
    if constexpr (K == 7) {
        const bf16_t* P = WSP(bf16_t, WS_P); bf16_t* Y = WSP(bf16_t, WS_Y);
        const pg8::Gemm ga{WSP(bf16_t, WS_OA), WSP(bf16_t, WS_WBR), TT, DM, 1024, 1024, 1024}, gl{WSP(bf16_t, WS_OL), WSP(bf16_t, WS_WBR) + (size_t)2048 * 1024, TT, DM, 1024, 1024, 1024},
                        gm{WSP(bf16_t, WS_OM), WSP(bf16_t, WS_WBR) + (size_t)2 * 2048 * 1024, TT, DM, 1024, 1024, 1024};
        const pg8::EpiGate<true> Ea{Y, DM, P + C_GA, NP}; const pg8::EpiGate<false> El{Y, DM, P + C_GL, NP}, Em{Y, DM, P + C_GM, NP};
        pg8::StaticOrder S; S.init(TT, DM, C.G, C.bid, l + 1 >= DEPTH);
        pg8::gemm_phase(C.lds, C.tid, ga, S, Ea); pg8::gemm_phase(C.lds, C.tid, gl, S, El); pg8::gemm_phase(C.lds, C.tid, gm, S, Em);
    }
    if constexpr (K == 8) {
        pg8::Gemm g{WSP(bf16_t, WS_Y), WSP(bf16_t, WS_WOUT), TT, DM, DM, DM, DM};
        pg8::EpiResid E{WSP(float, WS_XS), DM, modl + 2 * DM, l == 0 ? DBG_MIX0 : DBG_MIX1};
        pg8::StaticOrder S; S.init(TT, DM, C.G, C.bid, l + 1 >= DEPTH); pg8::gemm_phase(C.lds, C.tid, g, S, E);
        phase_cvt_peer_tables(C, l);
#ifdef DBG_CDUP
        phase_cvt_peer_tables(C, l);
#endif
    }
    if constexpr (K == 9) phase_norm_mod<false>(C, INP(I_N2G) + l * DM, modl, 3 * DM, 4 * DM);
    if constexpr (K == 10) {
        pg8::Gemm g{WSP(bf16_t, WS_HB), WSP(bf16_t, WS_WQ), TT, DM, DM, DM, DM};
        pg8::EpiStoreBf16 E{WSP(bf16_t, WS_PQ), DM};
        pg8::StaticOrder S; S.init(TT, DM, C.G, C.bid, l + 1 >= DEPTH); pg8::gemm_phase(C.lds, C.tid, g, S, E);
    }
    if constexpr (K == 11) phase_peer_select(C, l + 1 >= DEPTH);
    if constexpr (K == 13) phase_final_norm(C);
    if constexpr (K == 12) { if (l + 1 < DEPTH) phase_peer_gather<false>(C, modl, DBG_PEER0); else phase_peer_gather<true>(C, modl, DBG_PEER1); }
}
__device__ __forceinline__ Ctx make_ctx(const Args& args, unsigned char* lds_raw) {
    Ctx C0; C0.in = (const __attribute__((address_space(4))) cfp_t*)__builtin_amdgcn_kernarg_segment_ptr(); C0.out = args.out; C0.ws = args.ws; C0.lds = (LAS unsigned char*)lds_raw;
    C0.tid = threadIdx.x; C0.lane = C0.tid & 63; C0.wid = __builtin_amdgcn_readfirstlane(C0.tid >> 6); C0.G = gridDim.x; C0.bid = blockIdx.x;
    return C0;
}
template <int K> __global__ void __launch_bounds__(NTHREADS, 2) k_one(Args args) {
    extern __shared__ __attribute__((aligned(16))) unsigned char lds_raw[];
    const Ctx C0 = make_ctx(args, lds_raw);
    run_phase<K>(C0, args.ph_lo);
}
#if MK_N_LAUNCHES == 1
__global__ void __launch_bounds__(NTHREADS, 2) mk_fwd(Args args) {
    extern __shared__ __attribute__((aligned(16))) unsigned char lds_raw[];
    const Ctx C0 = make_ctx(args, lds_raw);
    if (C0.tid < 4) ((LAS unsigned*)(C0.lds + LDS_BAR_OFF))[C0.tid] = 0u;
    __syncthreads();
    const int lo = args.ph_lo, hi = args.ph_hi;
    XcdBarrier bar; bar.bar = (unsigned*)(args.ws + WS_CTL); bar.x = 0; bar.st = nullptr;
    if (hi - lo > 1) bar = xcd_barrier_post((unsigned*)(args.ws + WS_CTL), (volatile LAS unsigned*)(C0.lds + LDS_BAR_OFF));
#define IN(k) (lo <= (k) && (k) < hi)
#define SEAM(k) do { if (IN(k) && IN((k) + 1)) xcd_barrier(bar); } while (0)
#ifndef DBG_DUP
#define DBG_DUP -1
#endif
#define PH(K, k) do { if (IN(k)) { run_phase<K>(C0, l); if (K == DBG_DUP) { xcd_barrier(bar); run_phase<K>(C0, l); } } SEAM(k); } while (0)
    { const int l = 0; PH(0, 0); }
#pragma unroll 1
    for (int l = 0; l < DEPTH; ++l) {
        const int pb = 1 + 12 * l;
        PH(1, pb + 0); PH(2, pb + 1); PH(3, pb + 2); PH(4, pb + 3); PH(5, pb + 4); PH(6, pb + 5);
        PH(7, pb + 6); PH(8, pb + 7); PH(9, pb + 8); PH(10, pb + 9); PH(11, pb + 10); PH(12, pb + 11);
    }
    { const int l = DEPTH - 1; PH(13, 1 + 12 * DEPTH); }
#undef PH
#undef IN
#undef SEAM
}
#define MAIN_KERNEL mk_fwd
#else
#define MAIN_KERNEL k_one<6>
#endif


#ifdef DBG_CHECK
__device__ __forceinline__ void dbg_report(unsigned* slot, float err) { if (!(err <= 3e38f)) err = 1e30f; atomicMax(slot, __float_as_uint(err)); }
__global__ void k_check_gemm(const bf16_t* A, int lda, const float* W, int K, int N, const bf16_t* Cm, int ldc, int M, unsigned* slot) {
    const unsigned id = blockIdx.x * blockDim.x + threadIdx.x; if (id >= 8192) return;
    const unsigned h = id * 2654435761u; const int row = (int)((h >> 8) % (unsigned)M), col = (int)((h * 40503u >> 7) % (unsigned)N);
    float ref = 0.f; for (int k = 0; k < K; ++k) ref += bf2f(A[(size_t)row * lda + k]) * W[(size_t)k * N + col];
    const float got = bf2f(Cm[(size_t)row * ldc + col]);
    dbg_report(slot, fabsf(got - ref) / (fabsf(ref) + 0.1f));
}

__global__ void k_check_attn(const unsigned char* ws, int type, unsigned* slot) {
    __shared__ float sc[RPB]; __shared__ float red[256]; __shared__ float qv[192];
    const int t = threadIdx.x, bh = blockIdx.x & 15, b = bh >> 3, h = bh & 7; const int qpos = (int)(((blockIdx.x >> 4) * 977u + 13u) % SEQ); const size_t rq = (size_t)b * RPB + CTXL + qpos, rk = (size_t)b * RPB;
    const bf16_t* P = (const bf16_t*)(ws + WS_P); const bf16_t* MQ = (const bf16_t*)(ws + WS_MQ); const bf16_t* MKV = (const bf16_t*)(ws + WS_MKV);
    const int dq = type ? 128 : 192;
    if (t < dq) { float v = type ? bf2f(P[rq * NP + C_AQ + h * 128 + t]) : bf2f(MQ[rq * 1536 + h * 192 + t]); qv[t] = v; }
    __syncthreads();
    if (!type && t < 32) {
        const int ri = qpos >> 6, ci = qpos & 63; const int i = t; const float pos = (float)(i < 16 ? ri : ci); const float inv = powf(10000.f, -(float)(i & 15) / 16.f); const float a = pos * inv;
        const float x1 = qv[128 + i], x2 = qv[160 + i]; qv[128 + i] = x1 * cosf(a) - x2 * sinf(a); qv[160 + i] = x2 * cosf(a) + x1 * sinf(a); }
    __syncthreads();
    const float scale = type ? 0.088388347648f : 0.0721687836487f;
    float mx = -1e30f;
    for (int k = t; k < RPB; k += 256) { float s = 0.f;
        if (type) { const bf16_t* kp = P + (rk + k) * NP + C_AK + (h >> 2) * 128; for (int d = 0; d < 128; ++d) s += qv[d] * bf2f(kp[d]); }
        else { const bf16_t* kp = MKV + (rk + k) * 2048 + h * 256; for (int d = 0; d < 128; ++d) s += qv[d] * bf2f(kp[d]); const bf16_t* kr = P + (rk + k) * NP + C_MKR; for (int d = 0; d < 64; ++d) s += qv[128 + d] * bf2f(kr[d]); }
        s *= scale; sc[k] = s; mx = fmaxf(mx, s); }
    red[t] = mx; __syncthreads(); for (int o = 128; o >= 1; o >>= 1) { if (t < o) red[t] = fmaxf(red[t], red[t + o]); __syncthreads(); } mx = red[0]; __syncthreads();
    float sum = 0.f; for (int k = t; k < RPB; k += 256) { const float p = __expf(sc[k] - mx); sc[k] = p; sum += p; }
    red[t] = sum; __syncthreads(); for (int o = 128; o >= 1; o >>= 1) { if (t < o) red[t] += red[t + o]; __syncthreads(); } sum = red[0]; __syncthreads();
    float e = 0.f, mag = 0.f;
    if (t < 128) { float o = 0.f; for (int k = 0; k < RPB; ++k) { const float vv = type ? bf2f(P[(rk + k) * NP + C_AV + (h >> 2) * 128 + t]) : bf2f(MKV[(rk + k) * 2048 + h * 256 + 128 + t]); o += sc[k] * vv; }
        o /= sum; const float got = bf2f(((const bf16_t*)(ws + (type ? WS_OA : WS_OM)))[rq * 1024 + h * 128 + t]); e = fabsf(got - o); mag = fabsf(o); }
    red[t] = e; __syncthreads(); for (int o = 128; o >= 1; o >>= 1) { if (t < o) red[t] = fmaxf(red[t], red[t + o]); __syncthreads(); } e = red[0]; __syncthreads();
    red[t] = mag; __syncthreads(); for (int o = 128; o >= 1; o >>= 1) { if (t < o) red[t] = fmaxf(red[t], red[t + o]); __syncthreads(); } mag = red[0];
    if (t == 0) dbg_report(slot, e / (mag + 1e-4f));
}
__global__ void __launch_bounds__(256) k_check_gla_rec(const unsigned char* ws, const float* wa_f, const float* ba_f, const float* wa_b, const float* ba_b, float* obuf, int b) {
    __shared__ float ad[128], kd[128], qd[128], lrs[16];
    const int e = threadIdx.x, h = blockIdx.x & 3, dir = blockIdx.x >> 2; const bf16_t* P = (const bf16_t*)(ws + WS_P);
    const float* wa = dir ? wa_b : wa_f; const float* ba = dir ? ba_b : ba_f;
    float S[128];
#pragma unroll
    for (int d = 0; d < 128; ++d) S[d] = 0.f;
    float* ob = obuf + ((size_t)(dir * 2 + b) * 4 + h) * RPB * 256;
    for (int st = 0; st < RPB; ++st) {
        int j; if (!dir) j = st; else j = st < CTXL ? CTXL - 1 - st : RPB - 1 - (st - CTXL);
        const size_t r = (size_t)b * RPB + j; const bf16_t* pr = P + r * NP;
        if (e < 16) lrs[e] = bf2f(pr[(dir ? C_LRB : C_LRF) + e]);
        __syncthreads();
        if (e < 128) { float pre = ba[h * 128 + e]; for (int q = 0; q < 16; ++q) pre += lrs[q] * wa[q * 512 + h * 128 + e];
            const float ls = (fminf(pre, 0.f) - log1pf(expf(-fabsf(pre)))) / 16.f; ad[e] = expf(ls); kd[e] = bf2f(pr[C_LK + h * 128 + e]); qd[e] = bf2f(pr[C_LQ + h * 128 + e]) * 0.088388347648f; }
        __syncthreads();
        const float v = bf2f(pr[C_LV + h * 256 + e]); float o = 0.f;
#pragma unroll
        for (int d = 0; d < 128; ++d) { S[d] = ad[d] * S[d] + kd[d] * v; o += qd[d] * S[d]; }
        ob[(size_t)j * 256 + e] = o;
        __syncthreads();
    }
}
__global__ void k_check_gla_cmp(const unsigned char* ws, const float* obuf, const float* gon, int b, unsigned* slot) {
    __shared__ float red[256];
    const int e = threadIdx.x, h = blockIdx.x & 3, j = blockIdx.x >> 2; const size_t r = (size_t)b * RPB + j; const bf16_t* P = (const bf16_t*)(ws + WS_P);
    const float o = obuf[((size_t)(0 * 2 + b) * 4 + h) * RPB * 256 + (size_t)j * 256 + e] + obuf[((size_t)(1 * 2 + b) * 4 + h) * RPB * 256 + (size_t)j * 256 + e];
    red[e] = o * o; __syncthreads(); for (int s_ = 128; s_ >= 1; s_ >>= 1) { if (e < s_) red[e] += red[e + s_]; __syncthreads(); }
    const float rs = rsqrtf(red[0] / 256.f + NORM_EPS); __syncthreads();
    const float gt = bf2f(P[r * NP + C_LG + h * 256 + e]); const float ref = o * rs * gon[e] * (gt / (1.f + expf(-gt)));
    const float got = bf2f(((const bf16_t*)(ws + WS_OL))[r * 1024 + h * 256 + e]);
    red[e] = fabsf(got - ref); __syncthreads(); for (int s_ = 128; s_ >= 1; s_ >>= 1) { if (e < s_) red[e] = fmaxf(red[e], red[e + s_]); __syncthreads(); }
    if (e == 0) dbg_report(slot, red[0] / 1.0f);
}
__global__ void k_check_select(const bf16_t* PQ, const float* k1, const float* k2, const int* PIDX, const float* PG, unsigned* slot) {
    __shared__ float s1[128], s2[128]; __shared__ int cnt; __shared__ float selv[16];
    const int tok = (blockIdx.x >> 3) * 61 + 5, head = blockIdx.x & 7, t = threadIdx.x;
    if (t == 0) cnt = 0;
    for (int n = t; n < 128; n += 64) { float a = 0.f, b = 0.f; for (int d = 0; d < 128; ++d) { a += bf2f(PQ[(size_t)tok * DM + head * 256 + d]) * k1[((size_t)head * 128 + n) * 128 + d]; b += bf2f(PQ[(size_t)tok * DM + head * 256 + 128 + d]) * k2[((size_t)head * 128 + n) * 128 + d]; } s1[n] = a; s2[n] = b; }
    __syncthreads();
    if (t < 16) { const int id = PIDX[(size_t)tok * 128 + head * 16 + t]; selv[t] = (id >= 0 && id < 16384) ? s1[id >> 7] + s2[id & 127] : -1e30f; }
    __syncthreads();
    float thr = selv[0], mx = selv[0]; for (int k = 1; k < 16; ++k) { thr = fminf(thr, selv[k]); mx = fmaxf(mx, selv[k]); }
    int c = 0; for (int p = t; p < 16384; p += 64) if (s1[p >> 7] + s2[p & 127] > thr + 0.02f) ++c;
    atomicAdd(&cnt, c); __syncthreads();
    if (t == 0) { float den = 0.f; for (int k = 0; k < 16; ++k) den += __expf(selv[k] - mx); float e = fabsf((float)cnt - 15.f) / 15.f > 0.34f ? fabsf((float)cnt - 15.f) / 15.f : 0.f;
        for (int k = 0; k < 16; ++k) e = fmaxf(e, fabsf(PG[(size_t)tok * 128 + head * 16 + k] - __expf(selv[k] - mx) / den) * 4.f);
        for (int k = 0; k < 16; ++k) for (int k2_ = 0; k2_ < k; ++k2_) if (PIDX[(size_t)tok * 128 + head * 16 + k] == PIDX[(size_t)tok * 128 + head * 16 + k2_]) e = fmaxf(e, 10.f);
        dbg_report(slot, e); }
}
__global__ void k_check_gather(const bf16_t* HB, const float* u, const float* v, const int* PIDX, const float* PG, const float* dbgo, unsigned* slot) {
    __shared__ float w[128];
    const int tok = blockIdx.x * 64 + 300, t = threadIdx.x;
    for (int k = t; k < 128; k += 64) { const int id = PIDX[(size_t)tok * 128 + k] & 16383; float a = 0.f; for (int d = 0; d < DM; ++d) a += bf2f(HB[(size_t)tok * DM + d]) * u[(size_t)id * DM + d];
        w[k] = PG[(size_t)tok * 128 + k] * 0.5f * a * (1.0f + erff(a * 0.70710678f)); }
    __syncthreads();
    float e = 0.f, sc = 0.f;
    for (int d = t; d < DM; d += 64) { float o = 0.f; for (int k = 0; k < 128; ++k) o += w[k] * v[(size_t)(PIDX[(size_t)tok * 128 + k] & 16383) * DM + d];
        e = fmaxf(e, fabsf(o - dbgo[(size_t)tok * DM + d])); sc = fmaxf(sc, fabsf(o)); }
    for (int o_ = 32; o_ >= 1; o_ >>= 1) { e = fmaxf(e, __shfl_xor(e, o_)); sc = fmaxf(sc, __shfl_xor(sc, o_)); }
    if (t == 0) dbg_report(slot, e / (sc + 1e-6f));
}
__global__ void k_dbg_out2(const float* x, const float* fg, float* out, const unsigned* slot) {
    const float mx = __uint_as_float(*slot); float v = 0.25f * (log10f(fmaxf(mx, 1e-30f)) + 4.0f); v = fminf(fmaxf(v, 0.f), 9.f);
    const float f = 1.0f + v;
    const int lane = threadIdx.x & 63; const size_t r = (size_t)blockIdx.x * 4 + (threadIdx.x >> 6);
    const float* xr = x + r * DM; float ss = 0.f;
    for (int c = lane; c < DM; c += 64) ss += xr[c] * xr[c];
    ss = wave_sum(ss); const float rs = rsqrtf(ss / DM + NORM_EPS);
    for (int c = lane; c < DM; c += 64) out[r * DM + c] = xr[c] * rs * fg[c] * f;
}
#endif
#ifdef DBG_SCAN
__global__ void k_scan16(const bf16_t* p, size_t n, unsigned* flags, int stage) {
    unsigned bad = 0; for (size_t i = (size_t)blockIdx.x * blockDim.x + threadIdx.x; i < n; i += (size_t)gridDim.x * blockDim.x) bad |= ((p[i] & 0x7f80u) == 0x7f80u);
    if (bad) atomicOr(&flags[stage], 1u);
}
__global__ void k_scan32(const float* p, size_t n, unsigned* flags, int stage) {
    unsigned bad = 0; for (size_t i = (size_t)blockIdx.x * blockDim.x + threadIdx.x; i < n; i += (size_t)gridDim.x * blockDim.x) bad |= ((__float_as_uint(p[i]) & 0x7f800000u) == 0x7f800000u);
    if (bad) atomicOr(&flags[stage], 1u);
}
__global__ void k_dbg_out(const float* x, const float* fg, float* out, const unsigned* flags, int nstage) {
    int code = 0; for (int s = nstage; s >= 1; --s) if (flags[s]) code = s;
    const float f = 1.0f + 0.25f * (float)code;
    const int lane = threadIdx.x & 63; const size_t r = (size_t)blockIdx.x * 4 + (threadIdx.x >> 6);
    const float* xr = x + r * DM; float ss = 0.f;
    for (int c = lane; c < DM; c += 64) ss += xr[c] * xr[c];
    ss = wave_sum(ss); const float rs = rsqrtf(ss / DM + NORM_EPS);
    for (int c = lane; c < DM; c += 64) out[r * DM + c] = xr[c] * rs * fg[c] * f;
}
#endif
extern "C" void kernel_launch(void* const* d_in, const int* in_sizes, int n_in, void* d_out, int out_size, void* d_ws, size_t ws_size, hipStream_t stream) {
    static int grid = 0;
    if (grid == 0) {
        if (n_in != 30 || out_size != NBATCH * SEQ * DM || ws_size < WS_END) { fprintf(stderr, "kernel_launch: shape/workspace mismatch: n_in %d out %d ws %zu (need %zu)\n", n_in, out_size, ws_size, (size_t)WS_END); grid = -1; return; }
        int dev = 0, cus = 0, per_cu = 0;
        if (hipGetDevice(&dev) != hipSuccess || hipDeviceGetAttribute(&cus, hipDeviceAttributeMultiprocessorCount, dev) != hipSuccess) { grid = -1; return; }
        bool okattr = hipFuncSetAttribute((const void*)MAIN_KERNEL, hipFuncAttributeMaxDynamicSharedMemorySize, LDS_BYTES) == hipSuccess;
#if MK_N_LAUNCHES != 1
#define SETA(K) okattr = okattr && hipFuncSetAttribute((const void*)k_one<K>, hipFuncAttributeMaxDynamicSharedMemorySize, LDS_BYTES) == hipSuccess
        SETA(0); SETA(1); SETA(2); SETA(3); SETA(4); SETA(5); SETA(6); SETA(7); SETA(8); SETA(9); SETA(10); SETA(11); SETA(12); SETA(13);
#undef SETA
#endif
        if (!okattr) { fprintf(stderr, "kernel_launch: hipFuncSetAttribute failed\n"); grid = -1; return; }
        if (hipOccupancyMaxActiveBlocksPerMultiprocessor(&per_cu, (const void*)MAIN_KERNEL, NTHREADS, LDS_BYTES) != hipSuccess || per_cu < 1) { fprintf(stderr, "kernel_launch: occupancy query says %d blocks per CU\n", per_cu); grid = -1; (void)hipGetLastError(); return; }
        grid = cus;
    }
    if (grid < 0) return;
    if (hipMemsetAsync((char*)d_ws + WS_CTL, 0, CTL_BYTES, stream) != hipSuccess) return;
    Args a{};
    for (int i = 0; i < 30; ++i) a.in[i] = (const float*)d_in[i];
    a.out = (float*)d_out; a.ws = (unsigned char*)d_ws;
#if MK_N_LAUNCHES == 1
    a.ph_lo = 0; a.ph_hi = N_PHASES;
    hipLaunchKernelGGL(mk_fwd, dim3(grid), dim3(NTHREADS), LDS_BYTES, stream, a);
#else
    a.ph_hi = 0;
#ifndef DBG_NLAUNCH
#define DBG_NLAUNCH 100
#endif
    int nl_ = 0;
#define LAUNCH1(K, L) do { a.ph_lo = (L); if (nl_++ < DBG_NLAUNCH) { hipLaunchKernelGGL(k_one<K>, dim3(grid), dim3(NTHREADS), LDS_BYTES, stream, a); if (K == DBG_DUP) hipLaunchKernelGGL(k_one<K>, dim3(grid), dim3(NTHREADS), LDS_BYTES, stream, a); } } while (0)
#ifdef DBG_SCAN
    unsigned* flags = (unsigned*)((char*)d_ws + WS_CTL + 32768);
    char* W = (char*)d_ws;
#define S16(off, n, st) hipLaunchKernelGGL(k_scan16, dim3(1024), dim3(256), 0, stream, (const bf16_t*)(W + (off)), (size_t)(n), flags, st)
#define S32(off, n, st) hipLaunchKernelGGL(k_scan32, dim3(1024), dim3(256), 0, stream, (const float*)(W + (off)), (size_t)(n), flags, st)
    LAUNCH1(0, 0); S32(WS_MODV, 2 * 3 * 12288, 1);
    { const int l = 0;
      LAUNCH1(1, l); S16(WS_HB, (size_t)TT * DM, 2);
      LAUNCH1(2, l); S16(WS_P, (size_t)TT * NP, 3);
      LAUNCH1(3, l); S16(WS_P, (size_t)TT * NP, 4);
      LAUNCH1(4, l); S16(WS_MQ, (size_t)TT * 1536, 5); S16(WS_MKV, (size_t)TT * 2048, 5); S16(WS_GST, (size_t)2112 * 32768, 6); S32(WS_GDEC, (size_t)2112 * 128, 6);
      LAUNCH1(5, l); S16(WS_GST, (size_t)2112 * 32768, 7);
      LAUNCH1(6, l); S16(WS_OA, (size_t)TT * 1024, 8); S16(WS_OM, (size_t)TT * 1024, 9); S16(WS_OL, (size_t)TT * 1024, 10);
      LAUNCH1(7, l); S16(WS_Y, (size_t)TT * DM, 11);
      LAUNCH1(8, l); S32(WS_XS, (size_t)TT * DM, 12);
      LAUNCH1(9, l); S16(WS_HB, (size_t)TT * DM, 13);
      LAUNCH1(10, l); S16(WS_PQ, (size_t)TT * DM, 14);
      LAUNCH1(11, l); S32(WS_PG, (size_t)TT * 128, 15);
      LAUNCH1(12, l); S32(WS_XS, (size_t)TT * DM, 16);
    }
    hipLaunchKernelGGL(k_dbg_out, dim3(NBATCH * SEQ / 4), dim3(256), 0, stream, (const float*)d_in[0], (const float*)d_in[29], (float*)d_out, flags, 16);
#elif defined(DBG_CHECK)
    unsigned* flags = (unsigned*)((char*)d_ws + WS_CTL + 32768);
    char* W = (char*)d_ws;
    LAUNCH1(0, 0);
    { const int l = 0; LAUNCH1(1, l); LAUNCH1(2, l); LAUNCH1(3, l); LAUNCH1(4, l); LAUNCH1(5, l); LAUNCH1(6, l);
#if DBG_CHECK == 5 || DBG_CHECK == 6
      hipLaunchKernelGGL(k_check_attn, dim3(16 * 24), dim3(256), 0, stream, (const unsigned char*)d_ws, DBG_CHECK == 5 ? 1 : 0, flags + 100);
#endif
#if DBG_CHECK == 7
      { float* obuf = (float*)(W + WS_MQ);
        hipLaunchKernelGGL(k_check_gla_rec, dim3(8), dim3(256), 0, stream, (const unsigned char*)d_ws, (const float*)d_in[I_WA2F], (const float*)d_in[I_BAF], (const float*)d_in[I_WA2B], (const float*)d_in[I_BAB], obuf, 0);
        hipLaunchKernelGGL(k_check_gla_cmp, dim3(RPB * 4), dim3(256), 0, stream, (const unsigned char*)d_ws, (const float*)obuf, (const float*)d_in[I_ONG], 0, flags + 100); }
#endif
      LAUNCH1(7, l); LAUNCH1(8, l); LAUNCH1(9, l); LAUNCH1(10, l);
#if DBG_CHECK == 1
      hipLaunchKernelGGL(k_check_gemm, dim3(32), dim3(256), 0, stream, (const bf16_t*)(W + WS_HB), DM, (const float*)d_in[I_PWQ], DM, DM, (const bf16_t*)(W + WS_PQ), DM, TT, flags + 100);
#endif
      LAUNCH1(11, l);
#if DBG_CHECK == 2
      hipLaunchKernelGGL(k_check_select, dim3(256 * 8), dim3(64), 0, stream, (const bf16_t*)(W + WS_PQ), (const float*)d_in[I_PK1], (const float*)d_in[I_PK2], (const int*)(W + WS_PIDX), (const float*)(W + WS_PG), flags + 100);
#endif
      LAUNCH1(12, l);
#if DBG_CHECK == 3
      hipLaunchKernelGGL(k_check_gather, dim3(128), dim3(64), 0, stream, (const bf16_t*)(W + WS_HB), (const float*)d_in[I_PU], (const float*)d_in[I_PV], (const int*)(W + WS_PIDX), (const float*)(W + WS_PG), (const float*)(W + WS_MQ), flags + 100);
#endif
    }
    hipLaunchKernelGGL(k_dbg_out2, dim3(NBATCH * SEQ / 4), dim3(256), 0, stream, (const float*)d_in[0], (const float*)d_in[29], (float*)d_out, flags + 100);
#else
    LAUNCH1(0, 0);
    for (int l = 0; l < DEPTH; ++l) { LAUNCH1(1, l); LAUNCH1(2, l); LAUNCH1(3, l); LAUNCH1(4, l); LAUNCH1(5, l); LAUNCH1(6, l); LAUNCH1(7, l); LAUNCH1(8, l); LAUNCH1(9, l); LAUNCH1(10, l); LAUNCH1(11, l); LAUNCH1(12, l); }
    LAUNCH1(13, DEPTH - 1);
#endif
#undef LAUNCH1
#endif
    const hipError_t le = hipPeekAtLastError();
    if (le != hipSuccess) fprintf(stderr, "kernel_launch: launch failed: %s\n", hipGetErrorName(le));
}
```

```cpp
#include <hip/hip_runtime.h>
#include <cstdio>
#include <cstdint>

#ifndef MK_N_LAUNCHES
#ifndef DBG_DUP
#define DBG_DUP -1
#endif
#define MK_N_LAUNCHES 1
#endif

#ifndef DBG_MIX0
#define DBG_MIX0 1.0f
#define DBG_MIX1 1.0f
#define DBG_PEER0 1.0f
#define DBG_PEER1 1.0f
#endif
#define LAS __attribute__((address_space(3)))
typedef unsigned short bf16_t;
typedef short bf16x8 __attribute__((ext_vector_type(8)));
typedef short s16x4 __attribute__((ext_vector_type(4)));
typedef float f32x4 __attribute__((ext_vector_type(4)));
typedef float f32x2 __attribute__((ext_vector_type(2)));
typedef float f32x16 __attribute__((ext_vector_type(16)));
typedef unsigned u32x4 __attribute__((ext_vector_type(4)));
typedef unsigned u32x2 __attribute__((ext_vector_type(2)));
typedef __bf16 bf2_t __attribute__((ext_vector_type(2)));

constexpr int DM = 2048, NBATCH = 2, SEQ = 8192, CTXL = 256, DEPTH = 2;
constexpr int RPB = SEQ + CTXL;
constexpr int TT = NBATCH * RPB;
constexpr int IN_COLS = 11872, NP = 12032;
constexpr int C_AQ = 0, C_AK = 1024, C_AV = 1280, C_LQ = 1536, C_LK = 2048, C_LV = 2560, C_LG = 3584, C_LRF = 4608, C_LRB = 4624,
              C_MCQ = 4640, C_MCKV = 5152, C_MKR = 5664, C_GA = 5728, C_GL = 7776, C_GM = 9824;
constexpr int NCH = RPB / 64;
constexpr int NEXP = 16384;
constexpr float NORM_EPS = 1e-6f;
constexpr int NTHREADS = 512;

constexpr size_t al256(size_t x) { return (x + 255) / 256 * 256; }
constexpr size_t WS_CTL   = 0;
constexpr size_t CTL_BYTES = 65536;
constexpr size_t WS_MODV  = WS_CTL + CTL_BYTES;
constexpr size_t WS_TABA  = al256(WS_MODV + (size_t)2 * 3 * 12288 * 4);
constexpr size_t WS_TABM  = WS_TABA + 2 * 128 * 32 * 4;
constexpr size_t WS_XS    = al256(WS_TABM + 2 * 128 * 16 * 4);
constexpr size_t WS_HB    = WS_XS + (size_t)TT * DM * 4;
constexpr size_t WS_P     = WS_HB + (size_t)TT * DM * 2;
constexpr size_t WS_MQ    = WS_P + (size_t)TT * NP * 2;
constexpr size_t WS_MKV   = WS_MQ + (size_t)TT * 1536 * 2;
constexpr size_t WS_OA    = WS_MKV + (size_t)TT * 2048 * 2;
constexpr size_t WS_OL    = WS_OA + (size_t)TT * 1024 * 2;
constexpr size_t WS_OM    = WS_OL + (size_t)TT * 1024 * 2;
constexpr size_t WS_WIN   = WS_OM + (size_t)TT * 1024 * 2;
constexpr size_t WS_WUQ   = WS_WIN + (size_t)NP * 2048 * 2;
constexpr size_t WS_WUKV  = WS_WUQ + (size_t)1536 * 512 * 2;
constexpr size_t WS_WBR   = WS_WUKV + (size_t)2048 * 512 * 2;
constexpr size_t WS_WOUT  = WS_WBR + (size_t)3 * 2048 * 1024 * 2;
constexpr size_t WS_WQ    = WS_WOUT + (size_t)2048 * 2048 * 2;
constexpr size_t WS_K1    = WS_WQ + (size_t)2048 * 2048 * 2;
constexpr size_t WS_K2    = WS_K1 + (size_t)8 * 128 * 128 * 2;
constexpr size_t WS_GST   = WS_K2 + (size_t)8 * 128 * 128 * 2;
constexpr size_t WS_GDEC  = WS_GST + (size_t)NBATCH * 2 * 4 * NCH * 32768 * 2;
constexpr size_t WS_END   = WS_GDEC + (size_t)NBATCH * 2 * 4 * NCH * 128 * 4;
constexpr size_t WS_Y     = WS_MKV;
constexpr size_t WS_PQ    = WS_OA;
constexpr size_t WS_U8    = WS_P;
constexpr size_t WS_V8    = WS_U8 + (size_t)NEXP * DM;
constexpr size_t WS_SCU   = WS_V8 + (size_t)NEXP * DM;
constexpr size_t WS_SCV   = WS_SCU + (size_t)NEXP * 4;
constexpr size_t WS_PIDX  = WS_SCV + (size_t)NEXP * 4;
constexpr size_t WS_PG    = WS_PIDX + (size_t)TT * 128 * 4;
static_assert(WS_PG + (size_t)TT * 128 * 4 <= WS_MQ, "PEER alias region overflows P");

__device__ __forceinline__ unsigned cvt_pk_bf16(float lo, float hi) { bf2_t v; v.x = (__bf16)lo; v.y = (__bf16)hi; return __builtin_bit_cast(unsigned, v); }
__device__ __forceinline__ bf16_t f2bf(float f) { return (bf16_t)(cvt_pk_bf16(f, 0.f) & 0xffffu); }
__device__ __forceinline__ float bf2f(bf16_t b) { return __uint_as_float(((unsigned)b) << 16); }
__device__ __forceinline__ float bflo(unsigned w) { return __uint_as_float(w << 16); }
__device__ __forceinline__ float bfhi(unsigned w) { return __uint_as_float(w & 0xffff0000u); }
__device__ __forceinline__ float wave_sum(float v) {
#pragma unroll
    for (int o = 32; o >= 1; o >>= 1) v += __shfl_xor(v, o);
    return v;
}
__device__ __forceinline__ float sigmoidf_(float x) { return __builtin_amdgcn_rcpf(1.0f + __expf(-x)); }
__device__ __forceinline__ float siluf_(float x) { return x * __builtin_amdgcn_rcpf(1.0f + __expf(-x)); }

#define XB_TMO      128
#define XB_XCNT(j)  (256  + 64 * (j))
#define XB_XSUB(j)  (1280 + 64 * (j))
#define XB_XGEN(j)  (2304 + 64 * (j))
#define XB_TOP      3328
#define XB_TOPGEN   3392
#define XCD_BAR_WORDS 3456
#define XB_SPIN_CAP (1u << 20)
__device__ __forceinline__ unsigned xb_ld(unsigned* p)              { return __hip_atomic_load(p, __ATOMIC_RELAXED, __HIP_MEMORY_SCOPE_AGENT); }
__device__ __forceinline__ unsigned xb_add(unsigned* p, unsigned v) { return __hip_atomic_fetch_add(p, v, __ATOMIC_RELAXED, __HIP_MEMORY_SCOPE_AGENT); }
__device__ __forceinline__ unsigned xb_xcc_id() { return (unsigned)__builtin_amdgcn_s_getreg((3 << 11) | 20) & 0xFu; }
#define XB_SPIN(cond, bar) do { unsigned _sp = 0; while (cond) { __builtin_amdgcn_s_sleep(1); \
    if ((++_sp & 255u) == 0u) { if (xb_ld(&(bar)[XB_TMO])) break; if (_sp > XB_SPIN_CAP) { atomicAdd(&(bar)[XB_TMO], 1u); break; } } } } while (0)
struct XcdBarrier { unsigned* bar; unsigned x; volatile LAS unsigned* st; };
__device__ __forceinline__ XcdBarrier xcd_barrier_post(unsigned* bar, volatile LAS unsigned* st) {
    XcdBarrier b; b.bar = bar; b.x = xb_xcc_id(); b.st = st;
    if (threadIdx.x == 0) (void)xb_add(&bar[XB_XCNT(b.x)], 1u);
    return b;
}
__device__ __forceinline__ void xcd_barrier_complete(unsigned* bar, unsigned x, unsigned& nloc, unsigned& nx) {
    const unsigned G = gridDim.x * gridDim.y * gridDim.z;
    unsigned sum, cnt, mine, sp = 0u;
    for (;;) {
        sum = 0u; cnt = 0u; mine = 0u;
#pragma unroll
        for (unsigned j = 0; j < 16; ++j) { const unsigned c = xb_ld(&bar[XB_XCNT(j)]); sum += c; cnt += (c > 0u) ? 1u : 0u; mine = (j == x) ? c : mine; }
        if (sum == G) break;
        __builtin_amdgcn_s_sleep(1);
        if ((++sp & 255u) == 0u) { if (xb_ld(&bar[XB_TMO])) break; if (sp > XB_SPIN_CAP) { atomicAdd(&bar[XB_TMO], 1u); break; } }
    }
    nloc = mine > 0u ? mine : 1u; nx = cnt > 0u ? cnt : 1u;
}
__device__ __forceinline__ void xcd_barrier(const XcdBarrier& b) {
    asm volatile("s_waitcnt vmcnt(0)" ::: "memory");
    __syncthreads();
    if (threadIdx.x == 0) {
        unsigned* bar = b.bar;
        __builtin_amdgcn_s_waitcnt(0);
        unsigned nloc = b.st[0], nx = b.st[1];
        if (nloc == 0u) { xcd_barrier_complete(bar, b.x, nloc, nx); b.st[0] = nloc; b.st[1] = nx; }
        const unsigned old = xb_add(&bar[XB_XSUB(b.x)], 1u);
        const unsigned gen = old / nloc;
        if (old + 1u == (gen + 1u) * nloc) {
            __builtin_amdgcn_fence(__ATOMIC_RELEASE, "agent");
            asm volatile("s_waitcnt vmcnt(0)" ::: "memory");
            const unsigned og = xb_add(&bar[XB_TOP], 1u);
            const unsigned tg = og / nx;
            if (og + 1u == (tg + 1u) * nx) xb_add(&bar[XB_TOPGEN], 1u);
            else XB_SPIN(xb_ld(&bar[XB_TOPGEN]) == tg, bar);
            __builtin_amdgcn_fence(__ATOMIC_ACQUIRE, "agent");
            xb_add(&bar[XB_XGEN(b.x)], 1u);
            asm volatile("s_waitcnt vmcnt(0)" ::: "memory");
        } else {
            XB_SPIN(xb_ld(&bar[XB_XGEN(b.x)]) == gen, bar);
            __builtin_amdgcn_fence(__ATOMIC_ACQUIRE, "agent");
            asm volatile("s_waitcnt vmcnt(0)" ::: "memory");
        }
    }
    __syncthreads();
}

namespace pg8 {
constexpr int BM = 256, BK = 64, HALF = 128, HTB = HALF * BK * 2, STAGE_BYTES = 8 * HTB, NXCD = 8, WGM = 8;
__host__ __device__ __forceinline__ int lds_byte(int r, int c) { const int st = (r >> 4) * 2 + (c >> 5), rr = r & 15, cc = c & 31, ob = rr * 64 + cc * 2; return st * 1024 + (ob ^ (((ob >> 9) & 1) << 5)); }
__host__ __device__ __forceinline__ void stage_rc(int b, int& R, int& C) { const int st = b / 1024, sb = b % 1024, swz = sb ^ (((sb >> 9) & 1) << 5); R = (st >> 1) * 16 + swz / 64; C = (st & 1) * 32 + (swz % 64) / 2; }
__host__ __device__ __forceinline__ int perm32(int rho) { const int n = rho >> 4, i = rho & 15; return 8 * (i >> 2) + 4 * n + (i & 3); }
struct Unit { int pm, pn; };
struct Gemm { const bf16_t* A; const bf16_t* Bt; int M, N, K, lda, ldb; };
struct StaticOrder {
    int nM, nN, nwg, G, c, latent;
    __host__ __device__ void init(int M, int N, int G_, int c_, int latent_ = 0) { latent = latent_; nM = latent_ ? 64 : M / BM; nN = N / BM; nwg = nM * nN; G = G_; c = c_; }
    __host__ __device__ bool next(int i, Unit& u) const {
        const long L = (long)i * G + c; if (L >= nwg) return false;
        int wgid = (int)L; { const int q = nwg / NXCD, r = nwg % NXCD, xcd = wgid % NXCD, off = wgid / NXCD; wgid = (xcd < r ? xcd * (q + 1) : r * (q + 1) + (xcd - r) * q) + off; }
        const int nig = WGM * nN, gid = wgid / nig, fm = gid * WGM, gsz = (nM - fm) < WGM ? (nM - fm) : WGM;
        u.pm = fm + ((wgid % nig) % gsz); u.pn = (wgid % nig) / gsz; if (latent) u.pm += 1 + (u.pm >= 32 ? 1 : 0); return true;
    }
};
struct EpiStoreBf16 {
    static constexpr bool PERM = true;
    bf16_t* O; int ldc;
    __device__ __forceinline__ void operator()(const f32x4 (&acc)[2][2][4][2], const Unit& u, int wr, int wc, int fr, int fq) const {
        const int row0 = u.pm * BM + wr * 64 + fr, col0 = u.pn * BM + wc * 32 + 8 * fq;
#pragma unroll
        for (int ai = 0; ai < 2; ++ai)
#pragma unroll
            for (int m = 0; m < 4; ++m) { bf16_t* rowp = O + (size_t)(row0 + ai * HALF + m * 16) * ldc + col0;
#pragma unroll
                for (int bj = 0; bj < 2; ++bj) { const f32x4 v0 = acc[ai][bj][m][0], v1 = acc[ai][bj][m][1];
                    u32x4 w; w.x = cvt_pk_bf16(v0[0], v0[1]); w.y = cvt_pk_bf16(v0[2], v0[3]); w.z = cvt_pk_bf16(v1[0], v1[1]); w.w = cvt_pk_bf16(v1[2], v1[3]);
                    *(u32x4*)(rowp + bj * HALF) = w; } }
    }
};
template <bool FIRST> struct EpiGate {
    static constexpr bool PERM = true;
    bf16_t* Y; int ldy; const bf16_t* Gt; int ldg;
    __device__ __forceinline__ void operator()(const f32x4 (&acc)[2][2][4][2], const Unit& u, int wr, int wc, int fr, int fq) const {
        const int row0 = u.pm * BM + wr * 64 + fr, col0 = u.pn * BM + wc * 32 + 8 * fq;
#pragma unroll
        for (int ai = 0; ai < 2; ++ai)
#pragma unroll
            for (int m = 0; m < 4; ++m) { const size_t r = (size_t)(row0 + ai * HALF + m * 16);
#pragma unroll
                for (int bj = 0; bj < 2; ++bj) { const f32x4 v0 = acc[ai][bj][m][0], v1 = acc[ai][bj][m][1];
                    const u32x4 g = *(const u32x4*)(Gt + r * ldg + col0 + bj * HALF);
                    float o[8];
                    o[0] = sigmoidf_(bflo(g.x)) * v0[0]; o[1] = sigmoidf_(bfhi(g.x)) * v0[1]; o[2] = sigmoidf_(bflo(g.y)) * v0[2]; o[3] = sigmoidf_(bfhi(g.y)) * v0[3];
                    o[4] = sigmoidf_(bflo(g.z)) * v1[0]; o[5] = sigmoidf_(bfhi(g.z)) * v1[1]; o[6] = sigmoidf_(bflo(g.w)) * v1[2]; o[7] = sigmoidf_(bfhi(g.w)) * v1[3];
                    bf16_t* yp = Y + r * ldy + col0 + bj * HALF;
                    if (!FIRST) { const u32x4 y = *(const u32x4*)yp;
                        o[0] += bflo(y.x); o[1] += bfhi(y.x); o[2] += bflo(y.y); o[3] += bfhi(y.y); o[4] += bflo(y.z); o[5] += bfhi(y.z); o[6] += bflo(y.w); o[7] += bfhi(y.w); }
                    u32x4 w; w.x = cvt_pk_bf16(o[0], o[1]); w.y = cvt_pk_bf16(o[2], o[3]); w.z = cvt_pk_bf16(o[4], o[5]); w.w = cvt_pk_bf16(o[6], o[7]);
                    *(u32x4*)yp = w; } }
    }
};
struct EpiResid {
    static constexpr bool PERM = false;
    float* X; int ldx; const float* gate; float gscale;
    __device__ __forceinline__ void operator()(const f32x4 (&acc)[2][2][4][2], const Unit& u, int wr, int wc, int fr, int fq) const {
        const int row0 = u.pm * BM + wr * 64 + fr, col0 = u.pn * BM + wc * 32 + 4 * fq;
        const int sel = (u.pm % 33 == 0) ? 2 : (u.pm / 33);
        const float* gp = gate + (size_t)sel * 12288 + col0;
        f32x4 gv[2][2];
#pragma unroll
        for (int bj = 0; bj < 2; ++bj)
#pragma unroll
            for (int n = 0; n < 2; ++n) gv[bj][n] = *(const f32x4*)(gp + bj * HALF + n * 16) * gscale;
#pragma unroll
        for (int ai = 0; ai < 2; ++ai)
#pragma unroll
            for (int m = 0; m < 4; ++m) { float* rowp = X + (size_t)(row0 + ai * HALF + m * 16) * ldx + col0;
#pragma unroll
                for (int bj = 0; bj < 2; ++bj)
#pragma unroll
                    for (int n = 0; n < 2; ++n) { f32x4* p = (f32x4*)(rowp + bj * HALF + n * 16); *p = *p + gv[bj][n] * acc[ai][bj][m][n]; } }
    }
};

template <class Epi, class Sched>
__device__ __forceinline__ void gemm_phase(LAS unsigned char* lds, const int tid, const Gemm g, const Sched& S, const Epi& E) {
    const int wid = __builtin_amdgcn_readfirstlane(tid >> 6), lane = tid & 63, wr = wid >> 2, wc = wid & 3, fr = lane & 15, fq = lane >> 4;
    const int K = g.K, nt = K / BK, lda = g.lda, ldb = g.ldb;
    unsigned voffA[2], voffB[2];
#pragma unroll
    for (int i = 0; i < 2; ++i) { int R, C; stage_rc(tid * 16 + i * 8192, R, C); const int Rb = Epi::PERM ? ((R & ~31) + perm32(R & 31)) : R;
        voffA[i] = (unsigned)(R * lda + C) * 2u; voffB[i] = (unsigned)(Rb * ldb + C) * 2u; }
    const size_t kstep = (size_t)(BK * 2);
    const size_t hstepA = (size_t)HALF * lda * 2, hstepB = (size_t)HALF * ldb * 2;
    const size_t tstepA = 2 * hstepA, tstepB = 2 * hstepB;
    const unsigned ldsw = (unsigned)wid * 1024u;
    const int aoff = lds_byte(wr * 64 + fr, fq * 8), boff = lds_byte(wc * 32 + fr, fq * 8);
#define PG8_SA(b, h) (((b) * 2 + (h)) * HTB)
#define PG8_SB(b, h) ((4 + (b) * 2 + (h)) * HTB)
#define PG8_STAGE(bufoff, gbase, voff) do { _Pragma("unroll") for (int _i = 0; _i < 2; ++_i) \
        __builtin_amdgcn_global_load_lds((const unsigned*)((const char*)(gbase) + (voff)[_i]), (LAS unsigned*)(lds + (bufoff) + ldsw + _i * 8192), 16, 0, 0); } while (0)
#define PG8_LDA(dst, b, h) do { _Pragma("unroll") for (int m = 0; m < 4; ++m) _Pragma("unroll") for (int k = 0; k < 2; ++k) dst[m][k] = *(const LAS bf16x8*)(lds + PG8_SA(b, h) + aoff + m * 2048 + k * 1024); } while (0)
#define PG8_LDB(dst, b, h) do { _Pragma("unroll") for (int n = 0; n < 2; ++n) _Pragma("unroll") for (int k = 0; k < 2; ++k) dst[n][k] = *(const LAS bf16x8*)(lds + PG8_SB(b, h) + boff + n * 2048 + k * 1024); } while (0)
#define PG8_MMA(ai, bj, At, Bt) do { __builtin_amdgcn_s_setprio(1); _Pragma("unroll") for (int m = 0; m < 4; ++m) _Pragma("unroll") for (int n = 0; n < 2; ++n) _Pragma("unroll") for (int k = 0; k < 2; ++k) \
        acc[ai][bj][m][n] = __builtin_amdgcn_mfma_f32_16x16x32_bf16(Bt[n][k], At[m][k], acc[ai][bj][m][n], 0, 0, 0); __builtin_amdgcn_s_setprio(0); } while (0)
#define PG8_WAIT_V(n) asm volatile("s_waitcnt vmcnt(" #n ")" ::: "memory")
#define PG8_WAIT_L(n) asm volatile("s_waitcnt lgkmcnt(" #n ")" ::: "memory")
#define PG8_BAR __builtin_amdgcn_s_barrier()
#define PG8_SCHED __builtin_amdgcn_sched_barrier(0)
    Unit cur, nxt; int ui = 0;
    if (!S.next(0, cur)) return;
    f32x4 acc[2][2][4][2];
#pragma unroll
    for (int a = 0; a < 2; ++a)
#pragma unroll
        for (int b = 0; b < 2; ++b)
#pragma unroll
            for (int m = 0; m < 4; ++m)
#pragma unroll
                for (int n = 0; n < 2; ++n) acc[a][b][m][n] = (f32x4){0.f, 0.f, 0.f, 0.f};
    bf16x8 At[4][2], B0[2][2], B1[2][2];
    const char* cA = (const char*)g.A + (size_t)cur.pm * tstepA; const char* cB = (const char*)g.Bt + (size_t)cur.pn * tstepB;
    PG8_STAGE(PG8_SB(0, 0), cB, voffB); PG8_STAGE(PG8_SA(0, 0), cA, voffA); PG8_STAGE(PG8_SB(0, 1), cB + hstepB, voffB); PG8_STAGE(PG8_SA(0, 1), cA + hstepA, voffA);
    if (wr == 1) PG8_BAR;
    PG8_WAIT_V(4); PG8_BAR;
    PG8_STAGE(PG8_SB(1, 0), cB + kstep, voffB); PG8_STAGE(PG8_SA(1, 0), cA + kstep, voffA); PG8_STAGE(PG8_SB(1, 1), cB + hstepB + kstep, voffB);
    PG8_WAIT_V(6); PG8_BAR;
    for (;;) {
        const bool has_next = S.next(ui + 1, nxt);
        const char* nA = has_next ? (const char*)g.A + (size_t)nxt.pm * tstepA : cA; const char* nB = has_next ? (const char*)g.Bt + (size_t)nxt.pn * tstepB : cB;
        for (int t = 0; t < nt; t += 2) {
            const bool last = (t == nt - 2);
            const char* a1 = cA + (size_t)(t + 1) * kstep;
            const char* a2 = last ? nA : cA + (size_t)(t + 2) * kstep; const char* b2 = last ? nB : cB + (size_t)(t + 2) * kstep;
            const char* a3 = a2 + kstep; const char* b3 = b2 + kstep;
            PG8_LDB(B0, 0, 0); PG8_SCHED; PG8_LDA(At, 0, 0); PG8_STAGE(PG8_SA(1, 1), a1 + hstepA, voffA);
            PG8_WAIT_L(8); PG8_BAR; PG8_WAIT_L(0); PG8_MMA(0, 0, At, B0); PG8_BAR; PG8_SCHED;
            PG8_LDB(B1, 0, 1); PG8_STAGE(PG8_SB(0, 0), b2, voffB);
            PG8_BAR; PG8_WAIT_L(0); PG8_MMA(0, 1, At, B1); PG8_BAR;
            PG8_LDA(At, 0, 1); PG8_STAGE(PG8_SA(0, 0), a2, voffA);
            PG8_BAR; PG8_WAIT_L(0); PG8_MMA(1, 0, At, B0); PG8_BAR; PG8_SCHED;
            PG8_STAGE(PG8_SB(0, 1), b2 + hstepB, voffB);
            PG8_WAIT_V(6); PG8_BAR; PG8_MMA(1, 1, At, B1); PG8_BAR;
            PG8_LDB(B0, 1, 0); PG8_SCHED; PG8_LDA(At, 1, 0); PG8_STAGE(PG8_SA(0, 1), a2 + hstepA, voffA);
            PG8_WAIT_L(8); PG8_BAR; PG8_WAIT_L(0); PG8_MMA(0, 0, At, B0); PG8_BAR; PG8_SCHED;
            PG8_LDB(B1, 1, 1); PG8_STAGE(PG8_SB(1, 0), b3, voffB);
            PG8_BAR; PG8_WAIT_L(0); PG8_MMA(0, 1, At, B1); PG8_BAR;
            PG8_LDA(At, 1, 1); PG8_STAGE(PG8_SA(1, 0), a3, voffA);
            PG8_BAR; PG8_WAIT_L(0); PG8_MMA(1, 0, At, B0); PG8_BAR; PG8_SCHED;
            PG8_STAGE(PG8_SB(1, 1), b3 + hstepB, voffB);
            PG8_WAIT_V(6); PG8_BAR; PG8_MMA(1, 1, At, B1); PG8_BAR;
        }
        E(acc, cur, wr, wc, fr, fq);
        if (!has_next) break;
#pragma unroll
        for (int a = 0; a < 2; ++a)
#pragma unroll
            for (int b = 0; b < 2; ++b)
#pragma unroll
                for (int m = 0; m < 4; ++m)
#pragma unroll
                    for (int n = 0; n < 2; ++n) acc[a][b][m][n] = (f32x4){0.f, 0.f, 0.f, 0.f};
        cur = nxt; cA = nA; cB = nB; ++ui;
    }
    PG8_WAIT_V(0);
    if (wr == 0) PG8_BAR;
    PG8_BAR;
#undef PG8_SA
#undef PG8_SB
#undef PG8_STAGE
#undef PG8_LDA
#undef PG8_LDB
#undef PG8_MMA
#undef PG8_WAIT_V
#undef PG8_WAIT_L
#undef PG8_BAR
#undef PG8_SCHED
}
}

struct Args { const float* in[30]; float* out; unsigned char* ws; int ph_lo, ph_hi; };
enum { I_X = 0, I_C, I_CTX, I_CCTX, I_WMOD, I_BMOD, I_N1G, I_WIN, I_QNG, I_KNG, I_WA2F, I_BAF, I_WA2B, I_BAB, I_ONG, I_MQNG, I_WUQ, I_MKVNG, I_WUKV,
       I_WBRA, I_WBRL, I_WBRM, I_WOUT, I_N2G, I_PWQ, I_PK1, I_PK2, I_PU, I_PV, I_FG };
typedef const float* cfp_t;
struct Ctx {
    const __attribute__((address_space(4))) cfp_t* in; float* out; unsigned char* ws; LAS unsigned char* lds;
    int tid, lane, wid, G, bid;
};
#define WSP(T, off) ((T*)(C.ws + (off)))
#define INP(i) (C.in[(i)])
__device__ __forceinline__ unsigned long long launder_u64(unsigned long long w) {
    unsigned lo = (unsigned)w, hi = (unsigned)(w >> 32); asm volatile("" : "+v"(lo), "+v"(hi));
    lo = __builtin_amdgcn_readfirstlane(lo); hi = __builtin_amdgcn_readfirstlane(hi); return ((unsigned long long)hi << 32) | lo;
}
__device__ __forceinline__ Ctx launder(const Ctx& C0) {
    Ctx R = C0; int t = C0.tid; asm volatile("" : "+v"(t)); R.tid = t; R.lane = t & 63; R.wid = __builtin_amdgcn_readfirstlane(t >> 6);
    R.ws = (unsigned char*)launder_u64((unsigned long long)C0.ws);
    R.in = (const __attribute__((address_space(4))) cfp_t*)launder_u64((unsigned long long)C0.in);
    unsigned l = (unsigned)(uintptr_t)C0.lds; asm volatile("" : "+v"(l)); l = __builtin_amdgcn_readfirstlane(l); R.lds = (LAS unsigned char*)(uintptr_t)l;
    return R;
}

__device__ __forceinline__ const float* src_row(const Ctx& C, int r) {
    const int b = r / RPB, j = r % RPB;
    return j < CTXL ? INP(I_CTX) + ((size_t)b * CTXL + j) * DM : INP(I_X) + ((size_t)b * SEQ + (j - CTXL)) * DM;
}
__device__ __forceinline__ int mod_sel(int r) { const int b = r / RPB, j = r % RPB; return j < CTXL ? 2 : b; }

__device__ __forceinline__ void phase_modv(const Ctx& C) {
    LAS float* sc = (LAS float*)C.lds;
    LAS float* red = (LAS float*)(C.lds + 3 * 2048 * 4);
    for (int i = C.tid; i < 3 * DM; i += NTHREADS) { const int r = i / DM, k = i % DM; const float v = r < 2 ? INP(I_C)[r * DM + k] : INP(I_CCTX)[k]; sc[i] = siluf_(v); }
    __syncthreads();
    float* modv = WSP(float, WS_MODV);
    const int kq = C.tid / 12, c4 = C.tid % 12;
    for (int item = C.bid; item < 2 * 256; item += C.G) {
        const int l = item / 256, cg = item % 256;
        float acc[3][4];
#pragma unroll
        for (int r = 0; r < 3; ++r)
#pragma unroll
            for (int j = 0; j < 4; ++j) acc[r][j] = 0.f;
        if (kq < 42) {
            const float* wp = INP(I_WMOD) + (size_t)l * DM * 12288 + 48 * cg + 4 * c4;
            for (int k = kq; k < DM; k += 42) {
                const f32x4 w = *(const f32x4*)(wp + (size_t)k * 12288);
#pragma unroll
                for (int r = 0; r < 3; ++r) { const float s = sc[r * DM + k];
#pragma unroll
                    for (int j = 0; j < 4; ++j) acc[r][j] += s * w[j]; }
            }
#pragma unroll
            for (int r = 0; r < 3; ++r)
#pragma unroll
                for (int j = 0; j < 4; ++j) red[kq * 144 + r * 48 + c4 * 4 + j] = acc[r][j];
        }
        __syncthreads();
        if (C.tid < 144) { float s = 0.f; for (int q = 0; q < 42; ++q) s += red[q * 144 + C.tid];
            const int r = C.tid / 48, cc = C.tid % 48;
            modv[((size_t)l * 3 + r) * 12288 + 48 * cg + cc] = s + INP(I_BMOD)[(size_t)l * 12288 + 48 * cg + cc]; }
        __syncthreads();
    }
}
__device__ __forceinline__ void phase_tables(const Ctx& C) {
    float* ta = WSP(float, WS_TABA); float* tm = WSP(float, WS_TABM);
    for (int i = C.bid * NTHREADS + C.tid; i < 128 * 32 + 128 * 16; i += C.G * NTHREADS) {
        if (i < 128 * 32) { const int pos = i / 32, f = i % 32; const float inv = exp2f(-(float)f * (13.287712379549449f / 32.0f)); const float a = (float)pos * inv;
            ta[i] = cosf(a); ta[128 * 32 + i] = sinf(a); }
        else { const int k = i - 128 * 32, pos = k / 16, f = k % 16; const float inv = exp2f(-(float)f * (13.287712379549449f / 16.0f)); const float a = (float)pos * inv;
            tm[k] = cosf(a); tm[128 * 16 + k] = sinf(a); }
    }
}
__device__ __forceinline__ void transpose_cvt(const Ctx& C, const float* src, int K, int N, bf16_t* dst, int Npad, int& item) {
    LAS float* tile = (LAS float*)C.lds;
    const int tk = K / 64, tn = Npad / 64, ntile = tk * tn;
    const int t0 = ((C.bid - item % C.G) + C.G) % C.G; item += ntile;
    for (int t = t0; t < ntile; t += C.G) {
        const int k0 = (t / tn) * 64, n0 = (t % tn) * 64;
#pragma unroll
        for (int p = 0; p < 2; ++p) { const int kk = (C.tid >> 4) + p * 32, nn = (C.tid & 15) * 4;
            f32x4 v = (f32x4){0.f, 0.f, 0.f, 0.f};
            if (n0 + nn < N) v = *(const f32x4*)(src + (size_t)(k0 + kk) * N + n0 + nn);
#pragma unroll
            for (int j = 0; j < 4; ++j) tile[kk * 65 + nn + j] = v[j]; }
        __syncthreads();
        { const int n = C.tid >> 3, k8 = (C.tid & 7) * 8; float v[8];
#pragma unroll
          for (int j = 0; j < 8; ++j) v[j] = tile[(k8 + j) * 65 + n];
          u32x4 w; w.x = cvt_pk_bf16(v[0], v[1]); w.y = cvt_pk_bf16(v[2], v[3]); w.z = cvt_pk_bf16(v[4], v[5]); w.w = cvt_pk_bf16(v[6], v[7]);
          *(u32x4*)(dst + (size_t)(n0 + n) * K + k0 + k8) = w; }
        __syncthreads();
    }
}
__device__ __forceinline__ void cvt_plain(const Ctx& C, const float* src, bf16_t* dst, size_t n8) {
    for (size_t i = (size_t)C.bid * NTHREADS + C.tid; i < n8; i += (size_t)C.G * NTHREADS) {
        const f32x4 a = *(const f32x4*)(src + i * 8), b = *(const f32x4*)(src + i * 8 + 4);
        u32x4 w; w.x = cvt_pk_bf16(a[0], a[1]); w.y = cvt_pk_bf16(a[2], a[3]); w.z = cvt_pk_bf16(b[0], b[1]); w.w = cvt_pk_bf16(b[2], b[3]);
        *(u32x4*)(dst + i * 8) = w;
    }
}
__device__ __forceinline__ void phase_cvt_mixer_weights(const Ctx& C, int l) {
    int item = 0;
    transpose_cvt(C, INP(I_WIN) + (size_t)l * DM * IN_COLS, DM, IN_COLS, WSP(bf16_t, WS_WIN), NP, item);
    transpose_cvt(C, INP(I_WUQ) + (size_t)l * 512 * 1536, 512, 1536, WSP(bf16_t, WS_WUQ), 1536, item);
    transpose_cvt(C, INP(I_WUKV) + (size_t)l * 512 * 2048, 512, 2048, WSP(bf16_t, WS_WUKV), 2048, item);
    transpose_cvt(C, INP(I_WBRA) + (size_t)l * 1024 * 2048, 1024, 2048, WSP(bf16_t, WS_WBR), 2048, item);
    transpose_cvt(C, INP(I_WBRL) + (size_t)l * 1024 * 2048, 1024, 2048, WSP(bf16_t, WS_WBR) + (size_t)2048 * 1024, 2048, item);
    transpose_cvt(C, INP(I_WBRM) + (size_t)l * 1024 * 2048, 1024, 2048, WSP(bf16_t, WS_WBR) + (size_t)2 * 2048 * 1024, 2048, item);
    transpose_cvt(C, INP(I_WOUT) + (size_t)l * 2048 * 2048, 2048, 2048, WSP(bf16_t, WS_WOUT), 2048, item);
    transpose_cvt(C, INP(I_PWQ) + (size_t)l * 2048 * 2048, 2048, 2048, WSP(bf16_t, WS_WQ), 2048, item);
    cvt_plain(C, INP(I_PK1) + (size_t)l * 8 * 128 * 128, WSP(bf16_t, WS_K1), 8 * 128 * 128 / 8);
    cvt_plain(C, INP(I_PK2) + (size_t)l * 8 * 128 * 128, WSP(bf16_t, WS_K2), 8 * 128 * 128 / 8);
}
__device__ __forceinline__ void phase_cvt_peer_tables(const Ctx& C, int l) {
    const int lane = C.lane;
    for (int row = C.bid * 8 + C.wid; row < NEXP; row += C.G * 8) {
#pragma unroll 1
        for (int tb = 0; tb < 2; ++tb) {
            const float* src = (tb ? INP(I_PV) : INP(I_PU)) + ((size_t)l * NEXP + row) * DM + lane * 16;
            f32x4 x[8]; float amax = 0.f;
#pragma unroll
            for (int c = 0; c < 2; ++c)
#pragma unroll
                for (int q = 0; q < 4; ++q) { x[c * 4 + q] = *(const f32x4*)(src + c * 1024 + q * 4);
                    amax = fmaxf(amax, fmaxf(fmaxf(fabsf(x[c * 4 + q][0]), fabsf(x[c * 4 + q][1])), fmaxf(fabsf(x[c * 4 + q][2]), fabsf(x[c * 4 + q][3])))); }
#pragma unroll
            for (int o = 32; o >= 1; o >>= 1) amax = fmaxf(amax, __shfl_xor(amax, o));
            const float sc = amax > 0.f ? 224.0f / amax : 1.0f, inv = amax > 0.f ? amax * (1.0f / 224.0f) : 1.0f;
            unsigned char* dst = C.ws + (tb ? WS_V8 : WS_U8) + (size_t)(lane >> 3) * ((size_t)NEXP * 128) + (size_t)row * 128 + (lane & 7) * 16;
#pragma unroll
            for (int c = 0; c < 2; ++c) { u32x4 w;
#pragma unroll
                for (int q = 0; q < 4; ++q) { const f32x4 v = x[c * 4 + q] * sc; int p = __builtin_amdgcn_cvt_pk_fp8_f32(v[0], v[1], 0, false); p = __builtin_amdgcn_cvt_pk_fp8_f32(v[2], v[3], p, true); w[q] = (unsigned)p; }
                *(u32x4*)(dst + (size_t)c * 8 * ((size_t)NEXP * 128)) = w; }
            if (lane == 0) WSP(float, tb ? WS_SCV : WS_SCU)[row] = inv;
        }
    }
}

template <bool FIRST> __device__ __forceinline__ void phase_norm_mod(const Ctx& C, const float* gvec, const float* modl  , int shift_off, int scale_off) {
    float* xs = WSP(float, WS_XS); bf16_t* hb = WSP(bf16_t, WS_HB);
    for (int r = C.bid * 8 + C.wid; r < TT; r += C.G * 8) {
        const float* xr = FIRST ? src_row(C, r) : xs + (size_t)r * DM;
        const float* mv = modl + (size_t)mod_sel(r) * 12288;
        f32x4 v[8]; float ss = 0.f;
#pragma unroll
        for (int c = 0; c < 4; ++c) { v[2 * c] = *(const f32x4*)(xr + c * 512 + C.lane * 8); v[2 * c + 1] = *(const f32x4*)(xr + c * 512 + C.lane * 8 + 4); }
#pragma unroll
        for (int c = 0; c < 8; ++c) ss += v[c][0] * v[c][0] + v[c][1] * v[c][1] + v[c][2] * v[c][2] + v[c][3] * v[c][3];
        ss = wave_sum(ss);
        const float rs = rsqrtf(ss * (1.0f / DM) + NORM_EPS);
#pragma unroll
        for (int c = 0; c < 4; ++c) { const int col = c * 512 + C.lane * 8;
            if (FIRST) { *(f32x4*)(xs + (size_t)r * DM + col) = v[2 * c]; *(f32x4*)(xs + (size_t)r * DM + col + 4) = v[2 * c + 1]; }
            float o[8];
#pragma unroll
            for (int h = 0; h < 2; ++h) { const f32x4 g = *(const f32x4*)(gvec + col + 4 * h), s = *(const f32x4*)(mv + scale_off + col + 4 * h), t = *(const f32x4*)(mv + shift_off + col + 4 * h);
#pragma unroll
                for (int j = 0; j < 4; ++j) o[4 * h + j] = v[2 * c + h][j] * rs * g[j] * (1.0f + s[j]) + t[j]; }
            u32x4 w; w.x = cvt_pk_bf16(o[0], o[1]); w.y = cvt_pk_bf16(o[2], o[3]); w.z = cvt_pk_bf16(o[4], o[5]); w.w = cvt_pk_bf16(o[6], o[7]);
            *(u32x4*)(hb + (size_t)r * DM + col) = w; }
    }
}

__device__ __forceinline__ void phase_post_p(const Ctx& C, int l) {
    bf16_t* P = WSP(bf16_t, WS_P); const float* ta = WSP(float, WS_TABA); const float* tm = WSP(float, WS_TABM);
    const float* qg = INP(I_QNG) + l * 128; const float* kg = INP(I_KNG) + l * 128;
    const float* mqg = INP(I_MQNG) + l * 512; const float* mkvg = INP(I_MKVNG) + l * 512;
    const int lane = C.lane;
    const float qg1 = qg[lane], qg2 = qg[lane + 64], kg1 = kg[lane], kg2 = kg[lane + 64];
    for (int r = C.bid * 8 + C.wid; r < TT; r += C.G * 8) {
        bf16_t* pr = P + (size_t)r * NP;
        const int j = r % RPB; const bool lat = j >= CTXL; const int pos = lat ? j - CTXL : 0, ri = pos >> 6, ci = pos & 63;
        float cs = 1.f, sn = 0.f;
        if (lat) { const int p = lane < 32 ? ri : ci, f = lane & 31; cs = ta[p * 32 + f]; sn = ta[128 * 32 + p * 32 + f]; }
#pragma unroll
        for (int h = 0; h < 10; ++h) {
            bf16_t* hp = pr + (h < 8 ? C_AQ + h * 128 : C_AK + (h - 8) * 128);
            const float x1 = bf2f(hp[lane]), x2 = bf2f(hp[lane + 64]);
            const float ss = wave_sum(x1 * x1 + x2 * x2);
            const float rs = rsqrtf(ss * (1.0f / 128.0f) + NORM_EPS);
            const float y1 = x1 * rs * (h < 8 ? qg1 : kg1), y2 = x2 * rs * (h < 8 ? qg2 : kg2);
            hp[lane] = f2bf(y1 * cs - y2 * sn); hp[lane + 64] = f2bf(y2 * cs + y1 * sn);
        }
#pragma unroll
        for (int s = 0; s < 2; ++s) {
            bf16_t* sp = pr + (s == 0 ? C_MCQ : C_MCKV) + lane * 8; const float* gg = (s == 0 ? mqg : mkvg) + lane * 8;
            const u32x4 w = *(const u32x4*)sp; float x[8] = {bflo(w.x), bfhi(w.x), bflo(w.y), bfhi(w.y), bflo(w.z), bfhi(w.z), bflo(w.w), bfhi(w.w)};
            float ss = 0.f;
#pragma unroll
            for (int i = 0; i < 8; ++i) ss += x[i] * x[i];
            ss = wave_sum(ss);
            const float rs = rsqrtf(ss * (1.0f / 512.0f) + NORM_EPS);
#pragma unroll
            for (int i = 0; i < 8; ++i) x[i] = x[i] * rs * gg[i];
            u32x4 o; o.x = cvt_pk_bf16(x[0], x[1]); o.y = cvt_pk_bf16(x[2], x[3]); o.z = cvt_pk_bf16(x[4], x[5]); o.w = cvt_pk_bf16(x[6], x[7]);
            *(u32x4*)sp = o;
        }
        if (lat) { bf16_t* kp = pr + C_MKR; const int i = lane & 31; const float x1 = bf2f(kp[i]), x2 = bf2f(kp[i + 32]);
            const int p = i < 16 ? ri : ci, f = i & 15; const float c2 = tm[p * 16 + f], s2 = tm[128 * 16 + p * 16 + f];
            if (lane < 32) { kp[i] = f2bf(x1 * c2 - x2 * s2); kp[i + 32] = f2bf(x2 * c2 + x1 * s2); } }
    }
}

namespace att {
constexpr int NW = 8, QBLK = 32, KVBLK = 64, DV = 128;
constexpr float THR = 8.f;
#define SBAR() __builtin_amdgcn_sched_barrier(0)
__device__ __forceinline__ int crow(int r, int hi) { return (r & 3) + 8 * (r >> 2) + 4 * hi; }
template <int DQ> struct Cf {
    static constexpr int ND0 = DQ / 16, KROWB = DQ * 2, SHM_K = KVBLK * DQ * 2, SHM_V = KVBLK * DV * 2, SHM = 2 * SHM_V + 2 * SHM_K + NW * 64 * 4;
    static constexpr float SCALE = DQ == 128 ? 0.088388347648318440f : 0.072168783648703220f;
    __device__ static __forceinline__ int kswz(int row, int colB) { return row * KROWB + (colB ^ ((row & 7) << 4)); }
};
template <int DQ> __device__ __forceinline__ void partialSM(f32x16& p0, f32x16& p1, float& m_reg, float& mn, float& alpha) {
    constexpr float SC = Cf<DQ>::SCALE, Cc = SC * 1.4426950408889634f;
    float pmax = p0[0];
#pragma unroll
    for (int r = 1; r < 16; ++r) pmax = fmaxf(pmax, p0[r]);
#pragma unroll
    for (int r = 0; r < 16; ++r) pmax = fmaxf(pmax, p1[r]);
    { auto rr = __builtin_amdgcn_permlane32_swap(__float_as_uint(pmax), __float_as_uint(pmax), false, false);
      pmax = fmaxf(__uint_as_float(rr[0]), __uint_as_float(rr[1])); }
    if (__builtin_expect(__all(pmax - m_reg <= THR / SC), 1)) { mn = m_reg; alpha = 1.f; }
    else { mn = fmaxf(m_reg, pmax); alpha = __builtin_amdgcn_exp2f((m_reg - mn) * Cc); m_reg = mn; }
    const float mnC = -mn * Cc;
#pragma unroll
    for (int r = 0; r < 16; ++r) p0[r] = fmaf(p0[r], Cc, mnC);
#pragma unroll
    for (int r = 0; r < 16; ++r) p1[r] = fmaf(p1[r], Cc, mnC);
#pragma unroll
    for (int r = 0; r < 16; ++r) p0[r] = __builtin_amdgcn_exp2f(p0[r]);
}
__device__ __forceinline__ void finishSM(f32x16& p0, f32x16& p1, float alpha, float& l_reg, bf16x8& pa0, bf16x8& pa1, bf16x8& pa2, bf16x8& pa3) {
#pragma unroll
    for (int r = 0; r < 16; ++r) p1[r] = __builtin_amdgcn_exp2f(p1[r]);
    float ps = 0;
#pragma unroll
    for (int r = 0; r < 16; ++r) ps += p0[r];
#pragma unroll
    for (int r = 0; r < 16; ++r) ps += p1[r];
    { auto rr = __builtin_amdgcn_permlane32_swap(__float_as_uint(ps), __float_as_uint(ps), false, false);
      ps = __uint_as_float(rr[0]) + __uint_as_float(rr[1]); }
    l_reg = l_reg * alpha + ps;
#define PK4(P, BASE, OUT) do { unsigned a0 = cvt_pk_bf16(P[BASE + 0], P[BASE + 1]), a1 = cvt_pk_bf16(P[BASE + 2], P[BASE + 3]);   \
    unsigned b0 = cvt_pk_bf16(P[BASE + 4], P[BASE + 5]), b1 = cvt_pk_bf16(P[BASE + 6], P[BASE + 7]);                              \
    auto r0 = __builtin_amdgcn_permlane32_swap(a0, b0, false, false); auto r1 = __builtin_amdgcn_permlane32_swap(a1, b1, false, false); \
    u32x4 w = {r0[0], r1[0], r0[1], r1[1]}; OUT = *reinterpret_cast<bf16x8*>(&w); } while (0)
    PK4(p0, 0, pa0); PK4(p0, 8, pa1); PK4(p1, 0, pa2); PK4(p1, 8, pa3);
#undef PK4
}
template <int DQ> __device__ __forceinline__ void qkt(f32x16& p0, f32x16& p1, const char* Ks, const bf16x8* qr, const char* qx, int r32, int hi) {
    p0 = f32x16{}; p1 = f32x16{};
#pragma unroll
    for (int d0 = 0; d0 < Cf<DQ>::ND0; ++d0) { const int cb = (d0 * 16 + hi * 8) * 2;
        const bf16x8 b0 = *reinterpret_cast<const bf16x8*>(Ks + Cf<DQ>::kswz(r32, cb));
        const bf16x8 b1 = *reinterpret_cast<const bf16x8*>(Ks + Cf<DQ>::kswz(32 + r32, cb));
        constexpr int NQR = DQ == 192 ? 4 : 8;
        bf16x8 q; if (d0 < NQR) q = qr[d0]; else q = *reinterpret_cast<const bf16x8*>(qx + (d0 - NQR) * 1024);
        p0 = __builtin_amdgcn_mfma_f32_32x32x16_bf16(b0, q, p0, 0, 0, 0);
        p1 = __builtin_amdgcn_mfma_f32_32x32x16_bf16(b1, q, p1, 0, 0, 0); }
}
__device__ __forceinline__ int v_st(int k, int c) { const int kk = (k & ~0xC) | ((k & 4) << 1) | ((k & 8) >> 1); return ((kk >> 3) * 4 + (c >> 5)) * 512 + ((kk & 7) * 32 + (c & 31)) * 2; }
__device__ __forceinline__ int v_rd_base(int lane) { return ((lane & 3) << 3) | (((lane >> 2) & 3) << 6) | (((lane >> 4) & 1) << 5) | (((lane >> 5) & 1) << 8); }
constexpr int v_rd_off(int d0, int ks, int half) { return d0 * 512 + ks * 4096 + half * 2048; }
template <int OFF> __device__ __forceinline__ s16x4 tr_read(int vb) {
    s16x4 r; asm volatile("ds_read_b64_tr_b16 %0, %1 offset:%2" : "=&v"(r) : "v"(vb), "i"(OFF) : "memory"); return r;
}
template <int D0> __device__ __forceinline__ void pv_one(f32x16& od, int vb, bf16x8 pa0, bf16x8 pa1, bf16x8 pa2, bf16x8 pa3) {
    const s16x4 l0 = tr_read<v_rd_off(D0, 0, 0)>(vb), h0 = tr_read<v_rd_off(D0, 0, 1)>(vb), l1 = tr_read<v_rd_off(D0, 1, 0)>(vb), h1 = tr_read<v_rd_off(D0, 1, 1)>(vb);
    const s16x4 l2 = tr_read<v_rd_off(D0, 2, 0)>(vb), h2 = tr_read<v_rd_off(D0, 2, 1)>(vb), l3 = tr_read<v_rd_off(D0, 3, 0)>(vb), h3 = tr_read<v_rd_off(D0, 3, 1)>(vb);
    asm volatile("s_waitcnt lgkmcnt(0)" ::: "memory"); SBAR();
#define PK(L, H) (bf16x8){L[0], L[1], L[2], L[3], H[0], H[1], H[2], H[3]}
    od = __builtin_amdgcn_mfma_f32_32x32x16_bf16(pa0, PK(l0, h0), od, 0, 0, 0);
    od = __builtin_amdgcn_mfma_f32_32x32x16_bf16(pa1, PK(l1, h1), od, 0, 0, 0);
    od = __builtin_amdgcn_mfma_f32_32x32x16_bf16(pa2, PK(l2, h2), od, 0, 0, 0);
    od = __builtin_amdgcn_mfma_f32_32x32x16_bf16(pa3, PK(l3, h3), od, 0, 0, 0);
#undef PK
}
__device__ __forceinline__ void pv_d0(f32x16* o, int vb, bf16x8 pa0, bf16x8 pa1, bf16x8 pa2, bf16x8 pa3) {
    pv_one<0>(o[0], vb, pa0, pa1, pa2, pa3); pv_one<1>(o[1], vb, pa0, pa1, pa2, pa3); pv_one<2>(o[2], vb, pa0, pa1, pa2, pa3); pv_one<3>(o[3], vb, pa0, pa1, pa2, pa3);
}
__device__ __forceinline__ bf16x8 ld8(const bf16_t* p) { return *reinterpret_cast<const bf16x8*>(p); }

template <int DQ, int SD>
__device__ __forceinline__ void attn_body(const bf16_t* __restrict__ Qb, int ldq, const bf16_t* __restrict__ Kn, int ldkn, const bf16_t* __restrict__ Kr, int ldkr,
                                          const bf16_t* __restrict__ Vh, int ldv, bf16_t* __restrict__ Ob, int ldo, int seq, bool rope_q, int pos0, const float* __restrict__ tabM, char* lds, const int tid) {
    using CF = Cf<DQ>; constexpr int ND0 = CF::ND0, SHM_V = CF::SHM_V, SHM_K = CF::SHM_K;
    const int wid = tid >> 6, lane = tid & 63, r32 = lane & 31, hi = lane >> 5;
    char* V_lds = lds; char* K_lds = lds + 2 * SHM_V;
    float* ws = (float*)(lds + 2 * SHM_V + 2 * SHM_K) + wid * 64; float* li_l = ws; float* al_l = ws + 32;
    constexpr int NQR = DQ == 192 ? 4 : 8;
    float m_reg = -1e30f, l_reg = 0; f32x16 o[4] = {}; bf16x8 qr[NQR];
    const bf16_t* Qw = Qb + (long)(wid * QBLK + r32) * ldq + hi * 8;
#pragma unroll
    for (int d0 = 0; d0 < NQR; ++d0) qr[d0] = ld8(Qw + d0 * 16);
    char* qx = lds + CF::SHM + wid * 8192 + lane * 16;
    if constexpr (DQ == 192) {
#pragma unroll
        for (int d0 = 4; d0 < 8; ++d0) *(bf16x8*)(qx + (d0 - 4) * 1024) = ld8(Qw + d0 * 16);
        bf16x8 qe[4];
#pragma unroll
        for (int d0 = 0; d0 < 4; ++d0) qe[d0] = ld8(Qw + (8 + d0) * 16);
        if (rope_q) {
            const int pos = pos0 + wid * QBLK + r32, ri = pos >> 6, ci = pos & 63;
#pragma unroll
            for (int t = 0; t < 2; ++t) { const int p = t == 0 ? ri : ci; const float* tc = tabM + p * 16 + hi * 8; const float* tsn = tabM + 128 * 16 + p * 16 + hi * 8;
                bf16x8 a = qe[t], b = qe[2 + t];
#pragma unroll
                for (int jj = 0; jj < 8; ++jj) { const float x1 = bf2f((bf16_t)a[jj]), x2 = bf2f((bf16_t)b[jj]), c = tc[jj], s = tsn[jj];
                    a[jj] = (short)f2bf(x1 * c - x2 * s); b[jj] = (short)f2bf(x2 * c + x1 * s); }
                qe[t] = a; qe[2 + t] = b; }
        }
#pragma unroll
        for (int d0 = 0; d0 < 4; ++d0) *(bf16x8*)(qx + (4 + d0) * 1024) = qe[d0];
    }
    const int sr = tid >> 4, sc = (tid & 15) * 8, vst0 = v_st(sr, sc), vst1 = v_st(32 + sr, sc);
    const int sr2 = tid >> 3, sc2 = (tid & 7) * 8;
    const int vb0 = (int)(uintptr_t)V_lds + v_rd_base(lane);
    struct { bf16x8 vs0, vs1, ks0, ks1, ks2; } sr_[SD];
    const unsigned offV = (unsigned)(sr * ldv + sc) * 2u, offK = (unsigned)(sr * ldkn + sc) * 2u, offR = (unsigned)(sr2 * ldkr + sc2) * 2u;
#define SLOAD(i, k0) do { const char* vt_ = (const char*)Vh + (size_t)(k0) * ldv * 2; const char* kt_ = (const char*)Kn + (size_t)(k0) * ldkn * 2; \
    sr_[i].vs0 = *(const bf16x8*)(vt_ + offV); sr_[i].vs1 = *(const bf16x8*)(vt_ + (size_t)32 * ldv * 2 + offV); \
    sr_[i].ks0 = *(const bf16x8*)(kt_ + offK); sr_[i].ks1 = *(const bf16x8*)(kt_ + (size_t)32 * ldkn * 2 + offK); \
    if constexpr (DQ == 192) sr_[i].ks2 = *(const bf16x8*)((const char*)Kr + (size_t)(k0) * ldkr * 2 + offR); } while (0)
#define SWRITE(b, i) do { *(bf16x8*)(V_lds + (b) * SHM_V + vst0) = sr_[i].vs0; *(bf16x8*)(V_lds + (b) * SHM_V + vst1) = sr_[i].vs1; const int kc = sc * 2; \
    *(bf16x8*)(K_lds + (b) * SHM_K + CF::kswz(sr, kc)) = sr_[i].ks0; *(bf16x8*)(K_lds + (b) * SHM_K + CF::kswz(32 + sr, kc)) = sr_[i].ks1; \
    if constexpr (DQ == 192) *(bf16x8*)(K_lds + (b) * SHM_K + CF::kswz(sr2, 256 + sc2 * 2)) = sr_[i].ks2; } while (0)
#define SWAIT() do { if constexpr (SD == 1) asm volatile("s_waitcnt vmcnt(0)" ::: "memory"); else if constexpr (DQ == 192) asm volatile("s_waitcnt vmcnt(5)" ::: "memory"); else asm volatile("s_waitcnt vmcnt(4)" ::: "memory"); } while (0)
#define RESC(a) do { if (__any((a) < 1.f)) { if (hi == 0) al_l[r32] = (a); asm volatile("s_waitcnt lgkmcnt(0)" ::: "memory"); \
    _Pragma("unroll") for (int d = 0; d < 4; ++d) _Pragma("unroll") for (int r = 0; r < 16; ++r) o[d][r] *= al_l[crow(r, hi)]; } } while (0)
    f32x16 pA0, pA1, pB0, pB1; float mnA, mnB, alA, alB; bf16x8 pa0, pa1, pa2, pa3; const int NT = seq / KVBLK;
    constexpr int SE = 0, SO = SD - 1;
    SLOAD(SE, 0); asm volatile("s_waitcnt vmcnt(0)" ::: "memory"); SWRITE(0, SE); __syncthreads();
    qkt<DQ>(pA0, pA1, K_lds, qr, qx, r32, hi); partialSM<DQ>(pA0, pA1, m_reg, mnA, alA);
    SLOAD(SO, KVBLK); if constexpr (SD == 2) { if (2 < NT) SLOAD(SE, 2 * KVBLK); }
    SWAIT(); SWRITE(1, SO); __syncthreads();
    for (int j = 1; j + 1 < NT; j += 2) {
        SBAR(); qkt<DQ>(pB0, pB1, K_lds + SHM_K, qr, qx, r32, hi);
        finishSM(pA0, pA1, alA, l_reg, pa0, pa1, pa2, pa3); SBAR();
        SLOAD(SO, (j + SD) * KVBLK); SBAR();
        pv_d0(o, vb0, pa0, pa1, pa2, pa3); partialSM<DQ>(pB0, pB1, m_reg, mnB, alB);
        __syncthreads(); SWAIT(); SWRITE(0, SE);
        RESC(alB); __syncthreads();
        SBAR(); qkt<DQ>(pA0, pA1, K_lds, qr, qx, r32, hi);
        finishSM(pB0, pB1, alB, l_reg, pa0, pa1, pa2, pa3); SBAR();
        if (SD == 1 || j + 3 < NT) SLOAD(SE, (j + 1 + SD) * KVBLK); SBAR();
        pv_d0(o, vb0 + SHM_V, pa0, pa1, pa2, pa3); partialSM<DQ>(pA0, pA1, m_reg, mnA, alA);
        __syncthreads(); SWAIT(); SWRITE(1, SO);
        RESC(alA); __syncthreads();
    }
    SBAR(); qkt<DQ>(pB0, pB1, K_lds + SHM_K, qr, qx, r32, hi);
    finishSM(pA0, pA1, alA, l_reg, pa0, pa1, pa2, pa3); SBAR();
    pv_d0(o, vb0, pa0, pa1, pa2, pa3); partialSM<DQ>(pB0, pB1, m_reg, mnB, alB);
    __syncthreads(); RESC(alB);
    finishSM(pB0, pB1, alB, l_reg, pa0, pa1, pa2, pa3); SBAR();
    pv_d0(o, vb0 + SHM_V, pa0, pa1, pa2, pa3);
    if (hi == 0) li_l[r32] = l_reg; asm volatile("s_waitcnt lgkmcnt(0)" ::: "memory");
    float rli[16];
#pragma unroll
    for (int r = 0; r < 16; ++r) rli[r] = __builtin_amdgcn_rcpf(li_l[crow(r, hi)]);
    bf16_t* Ow = Ob + (long)(wid * QBLK) * ldo;
#pragma unroll
    for (int r = 0; r < 16; ++r) { const int orow = crow(r, hi);
#pragma unroll
        for (int d0 = 0; d0 < 4; ++d0) Ow[(long)orow * ldo + d0 * 32 + r32] = f2bf(o[d0][r] * rli[r]); }
#undef SLOAD
#undef SWRITE
#undef SWAIT
#undef RESC
}
}

template <int KS> __device__ __forceinline__ void mma_xy(f32x16& acc, const LAS bf16_t* X, const LAS bf16_t* Y, int hi) {
#pragma unroll
    for (int ks = 0; ks < KS; ++ks) { const bf16x8 a = *(const LAS bf16x8*)(X + ks * 16 + hi * 8), b = *(const LAS bf16x8*)(Y + ks * 16 + hi * 8);
        acc = __builtin_amdgcn_mfma_f32_32x32x16_bf16(a, b, acc, 0, 0, 0); }
}
__device__ __forceinline__ float logsig16(float x) { const float e = __expf(-fabsf(x)); return (fminf(x, 0.f) - __logf(1.f + e)) * 0.0625f; }
__device__ __forceinline__ int gla_sidx(int b, int dir, int h) { return (b * 2 + dir) * 4 + h; }

__device__ __forceinline__ void gla_cumsum_lds(const Ctx& C, int l, int h, int dir, const LAS float* lr, LAS float* segtot, LAS float* CUM) {
    const int seg = C.tid >> 7, d = C.tid & 127;
    const float* wa = INP(dir ? I_WA2B : I_WA2F) + (size_t)l * 16 * 512 + h * 128 + d;
    const float bias = INP(dir ? I_BAB : I_BAF)[l * 512 + h * 128 + d];
    float w[16], cum[16];
#pragma unroll
    for (int j = 0; j < 16; ++j) w[j] = wa[j * 512];
    float run = 0.f;
#pragma unroll
    for (int i = 0; i < 16; ++i) { const int s = seg * 16 + i, tk = dir ? 63 - s : s; float pre = bias;
#pragma unroll
        for (int j = 0; j < 16; ++j) pre += lr[tk * 32 + dir * 16 + j] * w[j];
        run += logsig16(pre); cum[i] = run; }
    segtot[seg * 128 + d] = run;
    __syncthreads();
    float off = 0.f;
#pragma unroll
    for (int q = 0; q < 3; ++q) if (q < seg) off += segtot[q * 128 + d];
#pragma unroll
    for (int i = 0; i < 16; ++i) { const int s = seg * 16 + i, tk = dir ? 63 - s : s; CUM[tk * 132 + d] = cum[i] + off; }
    __syncthreads();
}
__device__ __forceinline__ void unpack8(const u32x4 w, float (&x)[8]) { x[0] = bflo(w.x); x[1] = bfhi(w.x); x[2] = bflo(w.y); x[3] = bfhi(w.y); x[4] = bflo(w.z); x[5] = bfhi(w.z); x[6] = bflo(w.w); x[7] = bfhi(w.w); }
__device__ __forceinline__ void gla_build_vt(const Ctx& C, const bf16_t* P, size_t r0, int h, LAS bf16_t* VT) {
    u32x4 v[4];
#pragma unroll
    for (int it = 0; it < 4; ++it) { const int idx = C.tid + it * NTHREADS, sv = idx >> 5, e0 = (idx & 31) * 8; v[it] = *(const u32x4*)(P + (r0 + sv) * NP + C_LV + h * 256 + e0); }
#pragma unroll
    for (int it = 0; it < 4; ++it) { const int idx = C.tid + it * NTHREADS, sv = idx >> 5, e0 = (idx & 31) * 8;
        const unsigned wd[4] = {v[it].x, v[it].y, v[it].z, v[it].w};
#pragma unroll
        for (int q = 0; q < 4; ++q) { VT[(e0 + 2 * q) * 72 + sv] = (bf16_t)(wd[q] & 0xffffu); VT[(e0 + 2 * q + 1) * 72 + sv] = (bf16_t)(wd[q] >> 16); } }
}

__device__ __forceinline__ void phase_gla_local(const Ctx& C, int l) {
    const bf16_t* P = WSP(bf16_t, WS_P); bf16_t* GST = WSP(bf16_t, WS_GST); float* GDEC = WSP(float, WS_GDEC);
    LAS float* lr = (LAS float*)C.lds;
    LAS float* segtot = (LAS float*)(C.lds + 8192);
    LAS bf16_t* KT = (LAS bf16_t*)(C.lds + 10240);
    LAS bf16_t* VT = (LAS bf16_t*)(C.lds + 28672);
    LAS float* CUM = (LAS float*)(C.lds + 65536);
    const int r32 = C.lane & 31, hi = C.lane >> 5, d = C.tid & 127;
    const int btk = C.tid >> 3, bdg = (C.tid & 7) * 16;
    for (int unit = C.bid; unit < NBATCH * 4 * NCH; unit += C.G) {
        const int b = unit / (4 * NCH), h = (unit / NCH) % 4, ck = unit % NCH; const size_t r0 = (size_t)b * RPB + ck * 64;
        for (int i = C.tid; i < 64 * 32; i += NTHREADS) lr[i] = bf2f(P[(r0 + (i >> 5)) * NP + C_LRF + (i & 31)]);
        const u32x4 kw0 = *(const u32x4*)(P + (r0 + btk) * NP + C_LK + h * 128 + bdg), kw1 = *(const u32x4*)(P + (r0 + btk) * NP + C_LK + h * 128 + bdg + 8);
        gla_build_vt(C, P, r0, h, VT);
        __syncthreads();
#pragma unroll 1
        for (int dir = 0; dir < 2; ++dir) {
            gla_cumsum_lds(C, l, h, dir, lr, segtot, CUM);
            const int tend = dir ? 0 : 63;
            const size_t sx = (size_t)gla_sidx(b, dir, h) * NCH + ck;
            if (C.tid < 128) GDEC[sx * 128 + d] = __expf(CUM[tend * 132 + d]);
            { float kf[16]; { float t8[8]; unpack8(kw0, t8);
#pragma unroll
                for (int i = 0; i < 8; ++i) kf[i] = t8[i]; unpack8(kw1, t8);
#pragma unroll
                for (int i = 0; i < 8; ++i) kf[8 + i] = t8[i]; }
#pragma unroll
              for (int q = 0; q < 4; ++q) { const f32x4 cm = *(const LAS f32x4*)(CUM + btk * 132 + bdg + 4 * q), be = *(const LAS f32x4*)(CUM + tend * 132 + bdg + 4 * q);
#pragma unroll
                  for (int i = 0; i < 4; ++i) KT[(bdg + 4 * q + i) * 72 + btk] = f2bf(kf[4 * q + i] * __expf(be[i] - cm[i])); } }
            __syncthreads();
            { const int dt = C.wid & 3, eb = (C.wid >> 2) * 4;
              f32x16 acc[4] = {};
#pragma unroll
              for (int q = 0; q < 4; ++q) mma_xy<4>(acc[q], KT + (dt * 32 + r32) * 72, VT + ((eb + q) * 32 + r32) * 72, hi);
              bf16_t* st = GST + sx * 32768;
#pragma unroll
              for (int q = 0; q < 4; ++q)
#pragma unroll
                  for (int g = 0; g < 4; ++g) { u32x2 w; w.x = cvt_pk_bf16(acc[q][4 * g], acc[q][4 * g + 1]); w.y = cvt_pk_bf16(acc[q][4 * g + 2], acc[q][4 * g + 3]);
                      *(u32x2*)(st + (size_t)((eb + q) * 32 + r32) * 128 + dt * 32 + 8 * g + 4 * hi) = w; } }
            __syncthreads();
        }
    }
}

__device__ __forceinline__ void phase_gla_scan(const Ctx& C) {
    bf16_t* GST = WSP(bf16_t, WS_GST); const float* GDEC = WSP(float, WS_GDEC);
    for (int gid = C.bid * NTHREADS + C.tid; gid < 16 * 8192; gid += C.G * NTHREADS) {
        const int sidx = gid >> 13, g = gid & 8191, dir = (sidx >> 2) & 1, d4 = (g & 31) * 4;
        bf16_t* base = GST + (size_t)sidx * NCH * 32768 + (size_t)g * 4;
        const float* dbase = GDEC + (size_t)sidx * NCH * 128 + d4;
        float S[4] = {0.f, 0.f, 0.f, 0.f};
        for (int st = 0; st < NCH; st += 4) {
            int ck[4]; u32x2 L[4]; f32x4 dc[4];
#pragma unroll
            for (int q = 0; q < 4; ++q) { const int s = st + q; ck[q] = dir ? (s < 4 ? 3 - s : NCH + 3 - s) : s;
                L[q] = *(const u32x2*)(base + (size_t)ck[q] * 32768); dc[q] = *(const f32x4*)(dbase + (size_t)ck[q] * 128); }
#pragma unroll
            for (int q = 0; q < 4; ++q) { u32x2 w; w.x = cvt_pk_bf16(S[0], S[1]); w.y = cvt_pk_bf16(S[2], S[3]);
                *(u32x2*)(base + (size_t)ck[q] * 32768) = w;
                S[0] = dc[q][0] * S[0] + bflo(L[q].x); S[1] = dc[q][1] * S[1] + bfhi(L[q].x); S[2] = dc[q][2] * S[2] + bflo(L[q].y); S[3] = dc[q][3] * S[3] + bfhi(L[q].y); }
        }
    }
}

__device__ __forceinline__ void phase_gla_out(const Ctx& C, int l) {
    const bf16_t* P = WSP(bf16_t, WS_P); const bf16_t* GST = WSP(bf16_t, WS_GST); bf16_t* OL = WSP(bf16_t, WS_OL);
    LAS float* lr = (LAS float*)C.lds;
    LAS float* segtot = (LAS float*)(C.lds + 8192);
    LAS bf16_t* QT = (LAS bf16_t*)(C.lds + 10240);
    LAS bf16_t* KT = (LAS bf16_t*)(C.lds + 27648);
    LAS bf16_t* VT = (LAS bf16_t*)(C.lds + 45056);
    LAS bf16_t* SCm = (LAS bf16_t*)(C.lds + 81920);
    LAS float* OB = (LAS float*)(C.lds + 91136);
    LAS float* CUM = OB;
    const float* gon = INP(I_ONG) + l * 256;
    const int r32 = C.lane & 31, hi = C.lane >> 5;
    const int btk = C.tid >> 3, bdg = (C.tid & 7) * 16;
    for (int unit = C.bid; unit < NBATCH * 4 * NCH; unit += C.G) {
        const int b = unit / (4 * NCH), h = (unit / NCH) % 4, ck = unit % NCH; const size_t r0 = (size_t)b * RPB + ck * 64;
        for (int i = C.tid; i < 64 * 32; i += NTHREADS) lr[i] = bf2f(P[(r0 + (i >> 5)) * NP + C_LRF + (i & 31)]);
        const bf16_t* qp = P + (r0 + btk) * NP + C_LQ + h * 128 + bdg; const bf16_t* kp = P + (r0 + btk) * NP + C_LK + h * 128 + bdg;
        const u32x4 qw0 = *(const u32x4*)qp, qw1 = *(const u32x4*)(qp + 8), kw0 = *(const u32x4*)kp, kw1 = *(const u32x4*)(kp + 8);
        gla_build_vt(C, P, r0, h, VT);
        __syncthreads();
        f32x16 oacc[2] = {};
#pragma unroll 1
        for (int dir = 0; dir < 2; ++dir) {
            gla_cumsum_lds(C, l, h, dir, lr, segtot, CUM);
            { float qf[8], kf[8];
#pragma unroll
              for (int hh = 0; hh < 2; ++hh) { unpack8(hh ? qw1 : qw0, qf); unpack8(hh ? kw1 : kw0, kf);
                  const f32x4 c0 = *(const LAS f32x4*)(CUM + btk * 132 + bdg + 8 * hh), c1 = *(const LAS f32x4*)(CUM + btk * 132 + bdg + 8 * hh + 4);
                  float qo[8], ko[8];
#pragma unroll
                  for (int i = 0; i < 8; ++i) { const float cm = i < 4 ? c0[i & 3] : c1[i & 3]; qo[i] = qf[i] * __expf(cm) * 0.088388347648318440f; ko[i] = kf[i] * __expf(-cm); }
                  u32x4 wq, wk; wq.x = cvt_pk_bf16(qo[0], qo[1]); wq.y = cvt_pk_bf16(qo[2], qo[3]); wq.z = cvt_pk_bf16(qo[4], qo[5]); wq.w = cvt_pk_bf16(qo[6], qo[7]);
                  wk.x = cvt_pk_bf16(ko[0], ko[1]); wk.y = cvt_pk_bf16(ko[2], ko[3]); wk.z = cvt_pk_bf16(ko[4], ko[5]); wk.w = cvt_pk_bf16(ko[6], ko[7]);
                  *(LAS u32x4*)(QT + btk * 136 + bdg + 8 * hh) = wq; *(LAS u32x4*)(KT + btk * 136 + bdg + 8 * hh) = wk; } }
            __syncthreads();
            if (C.wid < 4) { const int mt = C.wid >> 1, nt = C.wid & 1; f32x16 sc = {};
                mma_xy<8>(sc, QT + (mt * 32 + r32) * 136, KT + (nt * 32 + r32) * 136, hi);
#pragma unroll
                for (int i = 0; i < 16; ++i) { const int t = mt * 32 + att::crow(i, hi), sx_ = nt * 32 + r32; const bool keep = dir ? (sx_ >= t) : (sx_ <= t);
                    SCm[t * 72 + sx_] = f2bf(keep ? sc[i] : 0.f); } }
            __syncthreads();
            { const bf16_t* st = GST + ((size_t)gla_sidx(b, dir, h) * NCH + ck) * 32768 + (size_t)(C.wid * 32 + r32) * 128 + hi * 8;
              bf16x8 sb[8];
#pragma unroll
              for (int ks = 0; ks < 8; ++ks) sb[ks] = *(const bf16x8*)(st + ks * 16);
#pragma unroll
              for (int mt = 0; mt < 2; ++mt) {
                  mma_xy<4>(oacc[mt], SCm + (mt * 32 + r32) * 72, VT + (C.wid * 32 + r32) * 72, hi);
#pragma unroll
                  for (int ks = 0; ks < 8; ++ks) { const bf16x8 a = *(const LAS bf16x8*)(QT + (mt * 32 + r32) * 136 + ks * 16 + hi * 8);
                      oacc[mt] = __builtin_amdgcn_mfma_f32_32x32x16_bf16(a, sb[ks], oacc[mt], 0, 0, 0); } } }
            __syncthreads();
        }
#pragma unroll
        for (int mt = 0; mt < 2; ++mt)
#pragma unroll
            for (int i = 0; i < 16; ++i) OB[(mt * 32 + att::crow(i, hi)) * 260 + C.wid * 32 + r32] = oacc[mt][i];
        __syncthreads();
        { const int t = C.tid >> 3, part = C.tid & 7; f32x4 v[8]; float ss = 0.f;
#pragma unroll
          for (int jj = 0; jj < 8; ++jj) { v[jj] = *(const LAS f32x4*)(OB + t * 260 + jj * 32 + part * 4); ss += v[jj][0] * v[jj][0] + v[jj][1] * v[jj][1] + v[jj][2] * v[jj][2] + v[jj][3] * v[jj][3]; }
          ss += __shfl_xor(ss, 1); ss += __shfl_xor(ss, 2); ss += __shfl_xor(ss, 4);
          const float rs = rsqrtf(ss * (1.0f / 256.0f) + NORM_EPS);
#pragma unroll
          for (int jj = 0; jj < 8; ++jj) { const int e = jj * 32 + part * 4; const f32x4 g = *(const f32x4*)(gon + e);
              const u32x2 gt = *(const u32x2*)(P + (r0 + t) * NP + C_LG + h * 256 + e);
              const float o0 = v[jj][0] * rs * g[0] * siluf_(bflo(gt.x)), o1 = v[jj][1] * rs * g[1] * siluf_(bfhi(gt.x)), o2 = v[jj][2] * rs * g[2] * siluf_(bflo(gt.y)), o3 = v[jj][3] * rs * g[3] * siluf_(bfhi(gt.y));
              u32x2 w; w.x = cvt_pk_bf16(o0, o1); w.y = cvt_pk_bf16(o2, o3);
              *(u32x2*)(OL + (r0 + t) * 1024 + h * 256 + e) = w; } }
        __syncthreads();
    }
}

__device__ __forceinline__ unsigned f_ord(float f) { const unsigned u = __float_as_uint(f); return u ^ ((unsigned)((int)u >> 31) | 0x80000000u); }
__device__ __forceinline__ float f_unord(unsigned k) { return __uint_as_float((k & 0x80000000u) ? (k ^ 0x80000000u) : ~k); }
__device__ __forceinline__ void ins_u(unsigned (&L)[16], unsigned x) {
#pragma unroll
    for (int j = 0; j < 16; ++j) { const unsigned h = L[j] > x ? L[j] : x; x = L[j] > x ? x : L[j]; L[j] = h; }
}
__device__ __forceinline__ void ins_f(float (&M)[16], float x) {
#pragma unroll
    for (int j = 0; j < 16; ++j) { const float h = M[j] > x ? M[j] : x; x = M[j] > x ? x : M[j]; M[j] = h; }
}
__device__ __forceinline__ void peer_top16(const bf16_t* __restrict__ qrow, const bf16_t* __restrict__ keys, int r32, int hi, unsigned (&L)[16]) {
    bf16x8 qf[8];
#pragma unroll
    for (int kk = 0; kk < 8; ++kk) qf[kk] = *(const bf16x8*)(qrow + kk * 16 + hi * 8);
#pragma unroll
    for (int j = 0; j < 16; ++j) L[j] = 0u;
#pragma unroll 1
    for (int mt = 0; mt < 4; ++mt) {
        f32x16 acc = {};
#pragma unroll
        for (int kk = 0; kk < 8; ++kk) { const bf16x8 a = *(const bf16x8*)(keys + (size_t)(mt * 32 + r32) * 128 + kk * 16 + hi * 8);
            acc = __builtin_amdgcn_mfma_f32_32x32x16_bf16(a, qf[kk], acc, 0, 0, 0); }
#pragma unroll
        for (int i = 0; i < 16; ++i) { const unsigned kidx = (unsigned)(mt * 32 + att::crow(i, hi)); ins_u(L, (f_ord(acc[i]) & ~127u) | (127u - kidx)); }
    }
    unsigned Pn[16];
#pragma unroll
    for (int j = 0; j < 16; ++j) Pn[j] = (unsigned)__shfl_xor((int)L[j], 32);
#pragma unroll
    for (int j = 0; j < 16; ++j) ins_u(L, Pn[j]);
}
__device__ __forceinline__ void phase_peer_select(const Ctx& C, const bool latent_only) {
    const bf16_t* PQ = WSP(bf16_t, WS_PQ); const bf16_t* K1 = WSP(bf16_t, WS_K1); const bf16_t* K2 = WSP(bf16_t, WS_K2);
    int* PIDX = WSP(int, WS_PIDX); float* PG = WSP(float, WS_PG);
    const int r32 = C.lane & 31, hi = C.lane >> 5, head = C.wid;
    const int ngrp = latent_only ? NBATCH * SEQ / 32 : TT / 32;
    for (int gi = C.bid; gi < ngrp; gi += C.G) {
        const int grp = latent_only ? gi + (CTXL / 32) * (1 + gi / (SEQ / 32)) : gi;
        const size_t tok = (size_t)grp * 32 + r32;
        unsigned L1[16], L2[16];
        peer_top16(PQ + tok * DM + head * 256, K1 + (size_t)head * 128 * 128, r32, hi, L1);
        peer_top16(PQ + tok * DM + head * 256 + 128, K2 + (size_t)head * 128 * 128, r32, hi, L2);
        float v1[16], v2[16];
#pragma unroll
        for (int j = 0; j < 16; ++j) { v1[j] = f_unord(L1[j] & ~127u); v2[j] = f_unord(L2[j] & ~127u); }
        float M[16];
#pragma unroll
        for (int j = 0; j < 16; ++j) M[j] = -3.0e38f;
#pragma unroll
        for (int a = 0; a < 16; ++a)
#pragma unroll
            for (int b = 0; b < 16; ++b) if ((a + 1) * (b + 1) <= 16) ins_f(M, v1[a] + v2[b]);
        const float thr = M[15], mx = M[0]; float den = 0.f;
#pragma unroll
        for (int j = 0; j < 16; ++j) den += __expf(M[j] - mx);
        const float rden = 1.0f / den;
        int pos = 0; int* ip = PIDX + tok * 128 + head * 16; float* gp = PG + tok * 128 + head * 16;
#pragma unroll
        for (int a = 0; a < 16; ++a)
#pragma unroll
            for (int b = 0; b < 16; ++b) if ((a + 1) * (b + 1) <= 16) {
                const float val = v1[a] + v2[b];
                if (val >= thr && pos < 16) { if (hi == 0) { ip[pos] = (int)((127u - (L1[a] & 127u)) * 128u + (127u - (L2[b] & 127u))); gp[pos] = __expf(val - mx) * rden; } ++pos; } }
    }
}
template <int OFF> __device__ __forceinline__ float dotf8(const float (&h)[32], const u32x4 w, float acc) {
#pragma unroll
    for (int j = 0; j < 4; ++j) { const f32x2 lo = __builtin_amdgcn_cvt_pk_f32_fp8((int)w[j], false), hi = __builtin_amdgcn_cvt_pk_f32_fp8((int)w[j], true);
        acc += h[OFF + 4 * j] * lo.x; acc += h[OFF + 4 * j + 1] * lo.y; acc += h[OFF + 4 * j + 2] * hi.x; acc += h[OFF + 4 * j + 3] * hi.y; }
    return acc;
}
constexpr int GT_MAXTOK = 9;
template <bool LAST> __device__ __forceinline__ void phase_peer_gather(const Ctx& C, const float* modl, const float pscale) {
    const bf16_t* HB = WSP(bf16_t, WS_HB); const unsigned char* U8 = C.ws + WS_U8; const unsigned char* V8 = C.ws + WS_V8;
    const float* SCU = WSP(float, WS_SCU); const float* SCV = WSP(float, WS_SCV);
    const int* PIDX = WSP(int, WS_PIDX); const float* PG = WSP(float, WS_PG); float* XS = WSP(float, WS_XS);
    const int lane = C.lane, s = lane >> 3, j = lane & 7;
    LAS int* IDS = (LAS int*)(C.lds + C.wid * (GT_MAXTOK * 512));
    LAS float* ACT = (LAS float*)(C.lds + 8 * GT_MAXTOK * 512 + C.wid * (GT_MAXTOK * 512));
    LAS int* ROWS = (LAS int*)(C.lds + 16 * GT_MAXTOK * 512 + C.wid * 64);
    int nk = 0;
    {
      const int per = (TT + C.G - 1) / C.G, base = C.bid * per;
#pragma unroll 1
      for (int k = 0; k < GT_MAXTOK; ++k) { const int o = C.wid + 8 * k; const int r = base + o; if (o < per && r < TT && !(LAST && (r % RPB) < CTXL)) { if (lane == 0) ROWS[nk] = r; ++nk; } } }
#define GT_ROW(k) __builtin_amdgcn_readfirstlane(ROWS[k])
#pragma unroll 1
    for (int k = 0; k < nk; ++k) { const int r = GT_ROW(k);
        IDS[k * 128 + lane] = PIDX[(size_t)r * 128 + lane] & (NEXP - 1); IDS[k * 128 + 64 + lane] = PIDX[(size_t)r * 128 + 64 + lane] & (NEXP - 1);
        ACT[k * 128 + lane] = 0.f; ACT[k * 128 + 64 + lane] = 0.f; }
    const int nit = 32 * nk;
#define GT_ITEM(it_) const int cb_ = (it_) / (2 * nk), rem_ = (it_) - cb_ * (2 * nk), k_ = rem_ >> 1, hf_ = rem_ & 1
#define GT_LOADU(UQ, HQ, it_) do { GT_ITEM(it_); const int r_ = GT_ROW(k_); \
        const bf16_t* hp_ = HB + (size_t)r_ * DM + cb_ * 128 + j * 16; HQ[0] = *(const u32x4*)hp_; HQ[1] = *(const u32x4*)(hp_ + 8); \
        const unsigned char* ub_ = U8 + (size_t)cb_ * ((size_t)NEXP * 128) + j * 16; \
        _Pragma("unroll") for (int eg = 0; eg < 8; ++eg) { const int id_ = IDS[k_ * 128 + (hf_ * 8 + eg) * 8 + s] & idmask; UQ[eg] = *(const u32x4*)(ub_ + (size_t)id_ * 128); } } while (0)
#define GT_COMPU(UQ, HQ, it_) do { GT_ITEM(it_); (void)cb_; f32x2 hf2[8]; \
        _Pragma("unroll") for (int hh = 0; hh < 2; ++hh) { const u32x4 w_ = HQ[hh]; \
            hf2[hh * 4 + 0] = (f32x2){bflo(w_.x), bfhi(w_.x)}; hf2[hh * 4 + 1] = (f32x2){bflo(w_.y), bfhi(w_.y)}; hf2[hh * 4 + 2] = (f32x2){bflo(w_.z), bfhi(w_.z)}; hf2[hh * 4 + 3] = (f32x2){bflo(w_.w), bfhi(w_.w)}; } \
        float d[8]; \
        _Pragma("unroll") for (int eg = 0; eg < 8; ++eg) { f32x2 d2 = (f32x2){0.f, 0.f}; \
            _Pragma("unroll") for (int q = 0; q < 4; ++q) { const f32x2 lo = __builtin_amdgcn_cvt_pk_f32_fp8((int)UQ[eg][q], false), hi = __builtin_amdgcn_cvt_pk_f32_fp8((int)UQ[eg][q], true); \
                d2 += hf2[2 * q] * lo; d2 += hf2[2 * q + 1] * hi; } \
            d[eg] = d2.x + d2.y; } \
          \
        float t4[4], t2[2], t1; \
        _Pragma("unroll") for (int i = 0; i < 4; ++i) { const float snd = (j & 4) ? d[i] : d[i + 4], kp = (j & 4) ? d[i + 4] : d[i]; t4[i] = kp + __shfl_xor(snd, 4); } \
        _Pragma("unroll") for (int i = 0; i < 2; ++i) { const float snd = (j & 2) ? t4[i] : t4[i + 2], kp = (j & 2) ? t4[i + 2] : t4[i]; t2[i] = kp + __shfl_xor(snd, 2); } \
        { const float snd = (j & 1) ? t2[0] : t2[1], kp = (j & 1) ? t2[1] : t2[0]; t1 = kp + __shfl_xor(snd, 1); } \
        ACT[k_ * 128 + (hf_ * 8 + j) * 8 + s] += t1; } while (0)
#ifdef DBG_GDUP
#pragma unroll 1
    for (int rep_ = 0; rep_ < 2; ++rep_) {
    const int idmask = rep_ == 0 ? DBG_GMASK : (NEXP - 1);
    if (rep_ == 1) { for (int k = 0; k < nk; ++k) { ACT[k * 128 + lane] = 0.f; ACT[k * 128 + 64 + lane] = 0.f; } }
#else
    { const int idmask = NEXP - 1;
#endif
    if (nit > 0) {
        u32x4 uA[8], uB[8], hA[2], hB[2];
        GT_LOADU(uA, hA, 0);
#pragma unroll 1
        for (int it = 0; it < nit; it += 2) {
            GT_LOADU(uB, hB, it + 1);
            GT_COMPU(uA, hA, it);
            if (it + 2 < nit) GT_LOADU(uA, hA, it + 2);
            GT_COMPU(uB, hB, it + 1);
        }
    }
    }
#undef GT_LOADU
#undef GT_COMPU
#pragma unroll 1
    for (int k = 0; k < nk; ++k) { const int r = GT_ROW(k);
#pragma unroll
        for (int hh = 0; hh < 2; ++hh) { const int e = hh * 64 + lane; const int id = IDS[k * 128 + e]; const float a = ACT[k * 128 + e] * SCU[id];
            const float w = PG[(size_t)r * 128 + e] * 0.5f * a * (1.0f + erff(a * 0.70710678118654752f));
#ifdef DBG_CHECK
            if (((r - 300) & 63) == 0 && r >= 300 && r < 300 + 64 * 128) WSP(float, WS_OM)[(size_t)r * 128 + e] = w;
#endif
            ACT[k * 128 + e] = w * SCV[id]; } }
#define GT_LOADV(VQ, WV, it_) do { GT_ITEM(it_); const unsigned char* vb_ = V8 + (size_t)cb_ * ((size_t)NEXP * 128) + j * 16; \
        _Pragma("unroll") for (int eg = 0; eg < 8; ++eg) { const int e_ = k_ * 128 + (hf_ * 8 + eg) * 8 + s; const int id_ = IDS[e_]; VQ[eg] = *(const u32x4*)(vb_ + (size_t)id_ * 128); WV[eg] = ACT[e_]; } } while (0)
#define GT_COMPV(VQ, WV) do { \
        _Pragma("unroll") for (int eg = 0; eg < 8; ++eg) { const f32x2 w2_ = (f32x2){WV[eg], WV[eg]}; \
            _Pragma("unroll") for (int q = 0; q < 4; ++q) { \
                const f32x2 lo = __builtin_amdgcn_cvt_pk_f32_fp8((int)VQ[eg][q], false), hi = __builtin_amdgcn_cvt_pk_f32_fp8((int)VQ[eg][q], true); \
                acc2[2 * q] += w2_ * lo; acc2[2 * q + 1] += w2_ * hi; } } } while (0)
    if (nit > 0) {
        u32x4 vA[8], vB[8]; float wA[8], wB[8];
        GT_LOADV(vA, wA, 0);
#pragma unroll 1
        for (int it = 0; it < nit; it += 2) {
            f32x2 acc2[8];
#pragma unroll
            for (int i = 0; i < 8; ++i) acc2[i] = (f32x2){0.f, 0.f};
            GT_LOADV(vB, wB, it + 1);
            GT_COMPV(vA, wA);
            if (it + 2 < nit) GT_LOADV(vA, wA, it + 2);
            GT_COMPV(vB, wB);
            f32x2 t4[4], t2[2], t1;
#pragma unroll
            for (int i = 0; i < 4; ++i) { const f32x2 snd = (s & 4) ? acc2[i] : acc2[i + 4], kp = (s & 4) ? acc2[i + 4] : acc2[i];
                t4[i] = kp + (f32x2){__shfl_xor(snd.x, 32), __shfl_xor(snd.y, 32)}; }
#pragma unroll
            for (int i = 0; i < 2; ++i) { const f32x2 snd = (s & 2) ? t4[i] : t4[i + 2], kp = (s & 2) ? t4[i + 2] : t4[i];
                t2[i] = kp + (f32x2){__shfl_xor(snd.x, 16), __shfl_xor(snd.y, 16)}; }
            { const f32x2 snd = (s & 1) ? t2[0] : t2[1], kp = (s & 1) ? t2[1] : t2[0]; t1 = kp + (f32x2){__shfl_xor(snd.x, 8), __shfl_xor(snd.y, 8)}; }
            { GT_ITEM(it); (void)hf_; const int r_ = GT_ROW(k_);
              const int col = cb_ * 128 + j * 16 + 2 * s; float* xp = XS + (size_t)r_ * DM + col; const float* g2 = modl + (size_t)mod_sel(r_) * 12288 + 5 * DM + col;
#ifdef DBG_CHECK
              if (((r_ - 300) & 63) == 0 && r_ >= 300 && r_ < 300 + 64 * 128) { float* dbgo = WSP(float, WS_MQ) + (size_t)r_ * DM + col; dbgo[0] = t1.x; dbgo[1] = t1.y; }
#endif
              const f32x2 x = *(const f32x2*)xp, g = *(const f32x2*)g2;
              *(f32x2*)xp = x + pscale * g * t1; }
        }
    }
#undef GT_LOADV
#undef GT_COMPV
#undef GT_ITEM
#undef GT_ROW
}
__device__ __forceinline__ void phase_final_norm(const Ctx& C) {
    const float* XS = WSP(float, WS_XS); const float* fg = INP(I_FG);
    for (int q = C.bid * 8 + C.wid; q < NBATCH * SEQ; q += C.G * 8) {
        const int b = q / SEQ, t = q % SEQ; const float* xr = XS + ((size_t)b * RPB + CTXL + t) * DM; float* op = C.out + (size_t)q * DM;
        f32x4 v[8]; float ss = 0.f;
#pragma unroll
        for (int c = 0; c < 8; ++c) { v[c] = *(const f32x4*)(xr + c * 256 + C.lane * 4); ss += v[c][0] * v[c][0] + v[c][1] * v[c][1] + v[c][2] * v[c][2] + v[c][3] * v[c][3]; }
        ss = wave_sum(ss); const float rs = rsqrtf(ss * (1.0f / DM) + NORM_EPS);
#pragma unroll
        for (int c = 0; c < 8; ++c) { const f32x4 g = *(const f32x4*)(fg + c * 256 + C.lane * 4); *(f32x4*)(op + c * 256 + C.lane * 4) = v[c] * rs * g; }
    }
}

template <int TYPE  > __device__ __forceinline__ void attn_units(const Ctx& C, bool need_ctx) {
    const bf16_t* P = WSP(bf16_t, WS_P);
    const int nu = need_ctx ? 528 : 512;
#pragma unroll 1
    for (int u = C.bid; u < nu; u += C.G) {
        int bh, qb; if (u < 512) { bh = (u >> 8) * 8 + (u & 7); qb = ((u & 255) >> 3) + 1; } else { bh = u - 512; qb = 0; }
        const int b = bh >> 3, h = bh & 7; const size_t rq = (size_t)b * RPB + (size_t)qb * 256, rk = (size_t)b * RPB; const int seq = qb == 0 ? CTXL : RPB;
        __syncthreads();
        if constexpr (TYPE == 1) {
            att::attn_body<128, 1>(P + rq * NP + C_AQ + h * 128, NP, P + rk * NP + C_AK + (h >> 2) * 128, NP, nullptr, 0, P + rk * NP + C_AV + (h >> 2) * 128, NP,
                                   WSP(bf16_t, WS_OA) + rq * 1024 + h * 128, 1024, seq, false, 0, nullptr, (char*)C.lds, C.tid);
        } else {
            const bf16_t* MQ = WSP(bf16_t, WS_MQ); const bf16_t* MKV = WSP(bf16_t, WS_MKV);
            att::attn_body<192, 1>(MQ + rq * 1536 + h * 192, 1536, MKV + rk * 2048 + h * 256, 2048, P + rk * NP + C_MKR, NP, MKV + rk * 2048 + h * 256 + 128, 2048,
                                   WSP(bf16_t, WS_OM) + rq * 1024 + h * 128, 1024, seq, qb > 0, (qb - 1) * 256, WSP(float, WS_TABM), (char*)C.lds, C.tid);
        }
    }
    __syncthreads();
}

constexpr int LDS_BYTES = 163840, LDS_BAR_OFF = LDS_BYTES - 16;
constexpr int N_PHASES = 26;
template <int K> __device__ __forceinline__ void run_phase(const Ctx& C0, int l) {
    const Ctx C = launder(C0);
    const float* modl = WSP(float, WS_MODV) + (size_t)l * 3 * 12288;
    if constexpr (K == 0) { phase_modv(C); phase_tables(C); __syncthreads(); phase_cvt_mixer_weights(C, 0); }
    if constexpr (K == 1) {
        if (l == 0) phase_norm_mod<true>(C, INP(I_N1G), modl, 0, DM);
        else { phase_norm_mod<false>(C, INP(I_N1G) + l * DM, modl, 0, DM); __syncthreads(); phase_cvt_mixer_weights(C, l); }
    }
    if constexpr (K == 2) {
        pg8::Gemm g{WSP(bf16_t, WS_HB), WSP(bf16_t, WS_WIN), TT, NP, DM, DM, DM}; pg8::StaticOrder S; S.init(TT, NP, C.G, C.bid);
        pg8::EpiStoreBf16 E{WSP(bf16_t, WS_P), NP};
        pg8::gemm_phase(C.lds, C.tid, g, S, E);
    }
    if constexpr (K == 3) phase_post_p(C, l);
    if constexpr (K == 4) {
        { pg8::Gemm g{WSP(bf16_t, WS_P) + C_MCQ, WSP(bf16_t, WS_WUQ), TT, 1536, 512, NP, 512}; pg8::StaticOrder S; S.init(TT, 1536, C.G, C.bid);
          pg8::EpiStoreBf16 E{WSP(bf16_t, WS_MQ), 1536}; pg8::gemm_phase(C.lds, C.tid, g, S, E); }
        { pg8::Gemm g{WSP(bf16_t, WS_P) + C_MCKV, WSP(bf16_t, WS_WUKV), TT, 2048, 512, NP, 512}; pg8::StaticOrder S; S.init(TT, 2048, C.G, C.bid);
          pg8::EpiStoreBf16 E{WSP(bf16_t, WS_MKV), 2048}; pg8::gemm_phase(C.lds, C.tid, g, S, E); }
        { const Ctx C2 = launder(C0); phase_gla_local(C2, l); }
#ifdef DBG_DUP_GLALOCAL
        { const Ctx C2 = launder(C0); __syncthreads(); phase_gla_local(C2, l); }
#endif
    }
    if constexpr (K == 5) phase_gla_scan(C);
    if constexpr (K == 6) { attn_units<0>(C, l + 1 < DEPTH); { const Ctx C2 = launder(C0); attn_units<1>(C2, l + 1 < DEPTH); } { const Ctx C3 = launder(C0); phase_gla_out(C3, l); }
#ifdef DBG_DUP_GLAOUT
        { const Ctx C3 = launder(C0); __syncthreads(); phase_gla_out(C3, l); }
#endif
    }
    if constexpr (K == 7) {
        const bf16_t* P = WSP(bf16_t, WS_P); bf16_t* Y = WSP(bf16_t, WS_Y);
        const pg8::Gemm ga{WSP(bf16_t, WS_OA), WSP(bf16_t, WS_WBR), TT, DM, 1024, 1024, 1024}, gl{WSP(bf16_t, WS_OL), WSP(bf16_t, WS_WBR) + (size_t)2048 * 1024, TT, DM, 1024, 1024, 1024},
                        gm{WSP(bf16_t, WS_OM), WSP(bf16_t, WS_WBR) + (size_t)2 * 2048 * 1024, TT, DM, 1024, 1024, 1024};
        const pg8::EpiGate<true> Ea{Y, DM, P + C_GA, NP}; const pg8::EpiGate<false> El{Y, DM, P + C_GL, NP}, Em{Y, DM, P + C_GM, NP};
        pg8::StaticOrder S; S.init(TT, DM, C.G, C.bid, l + 1 >= DEPTH);
        pg8::gemm_phase(C.lds, C.tid, ga, S, Ea); pg8::gemm_phase(C.lds, C.tid, gl, S, El); pg8::gemm_phase(C.lds, C.tid, gm, S, Em);
    }
    if constexpr (K == 8) {
        pg8::Gemm g{WSP(bf16_t, WS_Y), WSP(bf16_t, WS_WOUT), TT, DM, DM, DM, DM};
        pg8::EpiResid E{WSP(float, WS_XS), DM, modl + 2 * DM, l == 0 ? DBG_MIX0 : DBG_MIX1};
        pg8::StaticOrder S; S.init(TT, DM, C.G, C.bid, l + 1 >= DEPTH); pg8::gemm_phase(C.lds, C.tid, g, S, E);
        phase_cvt_peer_tables(C, l);
#ifdef DBG_CDUP
        phase_cvt_peer_tables(C, l);
#endif
    }
    if constexpr (K == 9) phase_norm_mod<false>(C, INP(I_N2G) + l * DM, modl, 3 * DM, 4 * DM);
    if constexpr (K == 10) {
        pg8::Gemm g{WSP(bf16_t, WS_HB), WSP(bf16_t, WS_WQ), TT, DM, DM, DM, DM};
        pg8::EpiStoreBf16 E{WSP(bf16_t, WS_PQ), DM};
        pg8::StaticOrder S; S.init(TT, DM, C.G, C.bid, l + 1 >= DEPTH); pg8::gemm_phase(C.lds, C.tid, g, S, E);
    }
    if constexpr (K == 11) phase_peer_select(C, l + 1 >= DEPTH);
    if constexpr (K == 13) phase_final_norm(C);
    if constexpr (K == 12) { if (l + 1 < DEPTH) phase_peer_gather<false>(C, modl, DBG_PEER0); else phase_peer_gather<true>(C, modl, DBG_PEER1); }
}
__device__ __forceinline__ Ctx make_ctx(const Args& args, unsigned char* lds_raw) {
    Ctx C0; C0.in = (const __attribute__((address_space(4))) cfp_t*)__builtin_amdgcn_kernarg_segment_ptr(); C0.out = args.out; C0.ws = args.ws; C0.lds = (LAS unsigned char*)lds_raw;
    C0.tid = threadIdx.x; C0.lane = C0.tid & 63; C0.wid = __builtin_amdgcn_readfirstlane(C0.tid >> 6); C0.G = gridDim.x; C0.bid = blockIdx.x;
    return C0;
}
template <int K> __global__ void __launch_bounds__(NTHREADS, 2) k_one(Args args) {
    extern __shared__ __attribute__((aligned(16))) unsigned char lds_raw[];
    const Ctx C0 = make_ctx(args, lds_raw);
    run_phase<K>(C0, args.ph_lo);
}
#if MK_N_LAUNCHES == 1
__global__ void __launch_bounds__(NTHREADS, 2) mk_fwd(Args args) {
    extern __shared__ __attribute__((aligned(16))) unsigned char lds_raw[];
    const Ctx C0 = make_ctx(args, lds_raw);
    if (C0.tid < 4) ((LAS unsigned*)(C0.lds + LDS_BAR_OFF))[C0.tid] = 0u;
    __syncthreads();
    const int lo = args.ph_lo, hi = args.ph_hi;
    XcdBarrier bar; bar.bar = (unsigned*)(args.ws + WS_CTL); bar.x = 0; bar.st = nullptr;
    if (hi - lo > 1) bar = xcd_barrier_post((unsigned*)(args.ws + WS_CTL), (volatile LAS unsigned*)(C0.lds + LDS_BAR_OFF));
#define IN(k) (lo <= (k) && (k) < hi)
#define SEAM(k) do { if (IN(k) && IN((k) + 1)) xcd_barrier(bar); } while (0)
#ifndef DBG_DUP
#define DBG_DUP -1
#endif
#define PH(K, k) do { if (IN(k)) { run_phase<K>(C0, l); if (K == DBG_DUP) { xcd_barrier(bar); run_phase<K>(C0, l); } } SEAM(k); } while (0)
    { const int l = 0; PH(0, 0); }
#pragma unroll 1
    for (int l = 0; l < DEPTH; ++l) {
        const int pb = 1 + 12 * l;
        PH(1, pb + 0); PH(2, pb + 1); PH(3, pb + 2); PH(4, pb + 3); PH(5, pb + 4); PH(6, pb + 5);
        PH(7, pb + 6); PH(8, pb + 7); PH(9, pb + 8); PH(10, pb + 9); PH(11, pb + 10); PH(12, pb + 11);
    }
    { const int l = DEPTH - 1; PH(13, 1 + 12 * DEPTH); }
#undef PH
#undef IN
#undef SEAM
}
#define MAIN_KERNEL mk_fwd
#else
#define MAIN_KERNEL k_one<6>
#endif


#ifdef DBG_CHECK
__device__ __forceinline__ void dbg_report(unsigned* slot, float err) { if (!(err <= 3e38f)) err = 1e30f; atomicMax(slot, __float_as_uint(err)); }
__global__ void k_check_gemm(const bf16_t* A, int lda, const float* W, int K, int N, const bf16_t* Cm, int ldc, int M, unsigned* slot) {
    const unsigned id = blockIdx.x * blockDim.x + threadIdx.x; if (id >= 8192) return;
    const unsigned h = id * 2654435761u; const int row = (int)((h >> 8) % (unsigned)M), col = (int)((h * 40503u >> 7) % (unsigned)N);
    float ref = 0.f; for (int k = 0; k < K; ++k) ref += bf2f(A[(size_t)row * lda + k]) * W[(size_t)k * N + col];
    const float got = bf2f(Cm[(size_t)row * ldc + col]);
    dbg_report(slot, fabsf(got - ref) / (fabsf(ref) + 0.1f));
}

__global__ void k_check_attn(const unsigned char* ws, int type, unsigned* slot) {
    __shared__ float sc[RPB]; __shared__ float red[256]; __shared__ float qv[192];
    const int t = threadIdx.x, bh = blockIdx.x & 15, b = bh >> 3, h = bh & 7; const int qpos = (int)(((blockIdx.x >> 4) * 977u + 13u) % SEQ); const size_t rq = (size_t)b * RPB + CTXL + qpos, rk = (size_t)b * RPB;
    const bf16_t* P = (const bf16_t*)(ws + WS_P); const bf16_t* MQ = (const bf16_t*)(ws + WS_MQ); const bf16_t* MKV = (const bf16_t*)(ws + WS_MKV);
    const int dq = type ? 128 : 192;
    if (t < dq) { float v = type ? bf2f(P[rq * NP + C_AQ + h * 128 + t]) : bf2f(MQ[rq * 1536 + h * 192 + t]); qv[t] = v; }
    __syncthreads();
    if (!type && t < 32) {
        const int ri = qpos >> 6, ci = qpos & 63; const int i = t; const float pos = (float)(i < 16 ? ri : ci); const float inv = powf(10000.f, -(float)(i & 15) / 16.f); const float a = pos * inv;
        const float x1 = qv[128 + i], x2 = qv[160 + i]; qv[128 + i] = x1 * cosf(a) - x2 * sinf(a); qv[160 + i] = x2 * cosf(a) + x1 * sinf(a); }
    __syncthreads();
    const float scale = type ? 0.088388347648f : 0.0721687836487f;
    float mx = -1e30f;
    for (int k = t; k < RPB; k += 256) { float s = 0.f;
        if (type) { const bf16_t* kp = P + (rk + k) * NP + C_AK + (h >> 2) * 128; for (int d = 0; d < 128; ++d) s += qv[d] * bf2f(kp[d]); }
        else { const bf16_t* kp = MKV + (rk + k) * 2048 + h * 256; for (int d = 0; d < 128; ++d) s += qv[d] * bf2f(kp[d]); const bf16_t* kr = P + (rk + k) * NP + C_MKR; for (int d = 0; d < 64; ++d) s += qv[128 + d] * bf2f(kr[d]); }
        s *= scale; sc[k] = s; mx = fmaxf(mx, s); }
    red[t] = mx; __syncthreads(); for (int o = 128; o >= 1; o >>= 1) { if (t < o) red[t] = fmaxf(red[t], red[t + o]); __syncthreads(); } mx = red[0]; __syncthreads();
    float sum = 0.f; for (int k = t; k < RPB; k += 256) { const float p = __expf(sc[k] - mx); sc[k] = p; sum += p; }
    red[t] = sum; __syncthreads(); for (int o = 128; o >= 1; o >>= 1) { if (t < o) red[t] += red[t + o]; __syncthreads(); } sum = red[0]; __syncthreads();
    float e = 0.f, mag = 0.f;
    if (t < 128) { float o = 0.f; for (int k = 0; k < RPB; ++k) { const float vv = type ? bf2f(P[(rk + k) * NP + C_AV + (h >> 2) * 128 + t]) : bf2f(MKV[(rk + k) * 2048 + h * 256 + 128 + t]); o += sc[k] * vv; }
        o /= sum; const float got = bf2f(((const bf16_t*)(ws + (type ? WS_OA : WS_OM)))[rq * 1024 + h * 128 + t]); e = fabsf(got - o); mag = fabsf(o); }
    red[t] = e; __syncthreads(); for (int o = 128; o >= 1; o >>= 1) { if (t < o) red[t] = fmaxf(red[t], red[t + o]); __syncthreads(); } e = red[0]; __syncthreads();
    red[t] = mag; __syncthreads(); for (int o = 128; o >= 1; o >>= 1) { if (t < o) red[t] = fmaxf(red[t], red[t + o]); __syncthreads(); } mag = red[0];
    if (t == 0) dbg_report(slot, e / (mag + 1e-4f));
}
__global__ void __launch_bounds__(256) k_check_gla_rec(const unsigned char* ws, const float* wa_f, const float* ba_f, const float* wa_b, const float* ba_b, float* obuf, int b) {
    __shared__ float ad[128], kd[128], qd[128], lrs[16];
    const int e = threadIdx.x, h = blockIdx.x & 3, dir = blockIdx.x >> 2; const bf16_t* P = (const bf16_t*)(ws + WS_P);
    const float* wa = dir ? wa_b : wa_f; const float* ba = dir ? ba_b : ba_f;
    float S[128];
#pragma unroll
    for (int d = 0; d < 128; ++d) S[d] = 0.f;
    float* ob = obuf + ((size_t)(dir * 2 + b) * 4 + h) * RPB * 256;
    for (int st = 0; st < RPB; ++st) {
        int j; if (!dir) j = st; else j = st < CTXL ? CTXL - 1 - st : RPB - 1 - (st - CTXL);
        const size_t r = (size_t)b * RPB + j; const bf16_t* pr = P + r * NP;
        if (e < 16) lrs[e] = bf2f(pr[(dir ? C_LRB : C_LRF) + e]);
        __syncthreads();
        if (e < 128) { float pre = ba[h * 128 + e]; for (int q = 0; q < 16; ++q) pre += lrs[q] * wa[q * 512 + h * 128 + e];
            const float ls = (fminf(pre, 0.f) - log1pf(expf(-fabsf(pre)))) / 16.f; ad[e] = expf(ls); kd[e] = bf2f(pr[C_LK + h * 128 + e]); qd[e] = bf2f(pr[C_LQ + h * 128 + e]) * 0.088388347648f; }
        __syncthreads();
        const float v = bf2f(pr[C_LV + h * 256 + e]); float o = 0.f;
#pragma unroll
        for (int d = 0; d < 128; ++d) { S[d] = ad[d] * S[d] + kd[d] * v; o += qd[d] * S[d]; }
        ob[(size_t)j * 256 + e] = o;
        __syncthreads();
    }
}
__global__ void k_check_gla_cmp(const unsigned char* ws, const float* obuf, const float* gon, int b, unsigned* slot) {
    __shared__ float red[256];
    const int e = threadIdx.x, h = blockIdx.x & 3, j = blockIdx.x >> 2; const size_t r = (size_t)b * RPB + j; const bf16_t* P = (const bf16_t*)(ws + WS_P);
    const float o = obuf[((size_t)(0 * 2 + b) * 4 + h) * RPB * 256 + (size_t)j * 256 + e] + obuf[((size_t)(1 * 2 + b) * 4 + h) * RPB * 256 + (size_t)j * 256 + e];
    red[e] = o * o; __syncthreads(); for (int s_ = 128; s_ >= 1; s_ >>= 1) { if (e < s_) red[e] += red[e + s_]; __syncthreads(); }
    const float rs = rsqrtf(red[0] / 256.f + NORM_EPS); __syncthreads();
    const float gt = bf2f(P[r * NP + C_LG + h * 256 + e]); const float ref = o * rs * gon[e] * (gt / (1.f + expf(-gt)));
    const float got = bf2f(((const bf16_t*)(ws + WS_OL))[r * 1024 + h * 256 + e]);
    red[e] = fabsf(got - ref); __syncthreads(); for (int s_ = 128; s_ >= 1; s_ >>= 1) { if (e < s_) red[e] = fmaxf(red[e], red[e + s_]); __syncthreads(); }
    if (e == 0) dbg_report(slot, red[0] / 1.0f);
}
__global__ void k_check_select(const bf16_t* PQ, const float* k1, const float* k2, const int* PIDX, const float* PG, unsigned* slot) {
    __shared__ float s1[128], s2[128]; __shared__ int cnt; __shared__ float selv[16];
    const int tok = (blockIdx.x >> 3) * 61 + 5, head = blockIdx.x & 7, t = threadIdx.x;
    if (t == 0) cnt = 0;
    for (int n = t; n < 128; n += 64) { float a = 0.f, b = 0.f; for (int d = 0; d < 128; ++d) { a += bf2f(PQ[(size_t)tok * DM + head * 256 + d]) * k1[((size_t)head * 128 + n) * 128 + d]; b += bf2f(PQ[(size_t)tok * DM + head * 256 + 128 + d]) * k2[((size_t)head * 128 + n) * 128 + d]; } s1[n] = a; s2[n] = b; }
    __syncthreads();
    if (t < 16) { const int id = PIDX[(size_t)tok * 128 + head * 16 + t]; selv[t] = (id >= 0 && id < 16384) ? s1[id >> 7] + s2[id & 127] : -1e30f; }
    __syncthreads();
    float thr = selv[0], mx = selv[0]; for (int k = 1; k < 16; ++k) { thr = fminf(thr, selv[k]); mx = fmaxf(mx, selv[k]); }
    int c = 0; for (int p = t; p < 16384; p += 64) if (s1[p >> 7] + s2[p & 127] > thr + 0.02f) ++c;
    atomicAdd(&cnt, c); __syncthreads();
    if (t == 0) { float den = 0.f; for (int k = 0; k < 16; ++k) den += __expf(selv[k] - mx); float e = fabsf((float)cnt - 15.f) / 15.f > 0.34f ? fabsf((float)cnt - 15.f) / 15.f : 0.f;
        for (int k = 0; k < 16; ++k) e = fmaxf(e, fabsf(PG[(size_t)tok * 128 + head * 16 + k] - __expf(selv[k] - mx) / den) * 4.f);
        for (int k = 0; k < 16; ++k) for (int k2_ = 0; k2_ < k; ++k2_) if (PIDX[(size_t)tok * 128 + head * 16 + k] == PIDX[(size_t)tok * 128 + head * 16 + k2_]) e = fmaxf(e, 10.f);
        dbg_report(slot, e); }
}
__global__ void k_check_gather(const bf16_t* HB, const float* u, const float* v, const int* PIDX, const float* PG, const float* dbgo, unsigned* slot) {
    __shared__ float w[128];
    const int tok = blockIdx.x * 64 + 300, t = threadIdx.x;
    for (int k = t; k < 128; k += 64) { const int id = PIDX[(size_t)tok * 128 + k] & 16383; float a = 0.f; for (int d = 0; d < DM; ++d) a += bf2f(HB[(size_t)tok * DM + d]) * u[(size_t)id * DM + d];
        w[k] = PG[(size_t)tok * 128 + k] * 0.5f * a * (1.0f + erff(a * 0.70710678f)); }
    __syncthreads();
    float e = 0.f, sc = 0.f;
    for (int d = t; d < DM; d += 64) { float o = 0.f; for (int k = 0; k < 128; ++k) o += w[k] * v[(size_t)(PIDX[(size_t)tok * 128 + k] & 16383) * DM + d];
        e = fmaxf(e, fabsf(o - dbgo[(size_t)tok * DM + d])); sc = fmaxf(sc, fabsf(o)); }
    for (int o_ = 32; o_ >= 1; o_ >>= 1) { e = fmaxf(e, __shfl_xor(e, o_)); sc = fmaxf(sc, __shfl_xor(sc, o_)); }
    if (t == 0) dbg_report(slot, e / (sc + 1e-6f));
}
__global__ void k_dbg_out2(const float* x, const float* fg, float* out, const unsigned* slot) {
    const float mx = __uint_as_float(*slot); float v = 0.25f * (log10f(fmaxf(mx, 1e-30f)) + 4.0f); v = fminf(fmaxf(v, 0.f), 9.f);
    const float f = 1.0f + v;
    const int lane = threadIdx.x & 63; const size_t r = (size_t)blockIdx.x * 4 + (threadIdx.x >> 6);
    const float* xr = x + r * DM; float ss = 0.f;
    for (int c = lane; c < DM; c += 64) ss += xr[c] * xr[c];
    ss = wave_sum(ss); const float rs = rsqrtf(ss / DM + NORM_EPS);
    for (int c = lane; c < DM; c += 64) out[r * DM + c] = xr[c] * rs * fg[c] * f;
}
#endif
#ifdef DBG_SCAN
__global__ void k_scan16(const bf16_t* p, size_t n, unsigned* flags, int stage) {
    unsigned bad = 0; for (size_t i = (size_t)blockIdx.x * blockDim.x + threadIdx.x; i < n; i += (size_t)gridDim.x * blockDim.x) bad |= ((p[i] & 0x7f80u) == 0x7f80u);
    if (bad) atomicOr(&flags[stage], 1u);
}
__global__ void k_scan32(const float* p, size_t n, unsigned* flags, int stage) {
    unsigned bad = 0; for (size_t i = (size_t)blockIdx.x * blockDim.x + threadIdx.x; i < n; i += (size_t)gridDim.x * blockDim.x) bad |= ((__float_as_uint(p[i]) & 0x7f800000u) == 0x7f800000u);
    if (bad) atomicOr(&flags[stage], 1u);
}
__global__ void k_dbg_out(const float* x, const float* fg, float* out, const unsigned* flags, int nstage) {
    int code = 0; for (int s = nstage; s >= 1; --s) if (flags[s]) code = s;
    const float f = 1.0f + 0.25f * (float)code;
    const int lane = threadIdx.x & 63; const size_t r = (size_t)blockIdx.x * 4 + (threadIdx.x >> 6);
    const float* xr = x + r * DM; float ss = 0.f;
    for (int c = lane; c < DM; c += 64) ss += xr[c] * xr[c];
    ss = wave_sum(ss); const float rs = rsqrtf(ss / DM + NORM_EPS);
    for (int c = lane; c < DM; c += 64) out[r * DM + c] = xr[c] * rs * fg[c] * f;
}
#endif
extern "C" void kernel_launch(void* const* d_in, const int* in_sizes, int n_in, void* d_out, int out_size, void* d_ws, size_t ws_size, hipStream_t stream) {
    static int grid = 0;
    if (grid == 0) {
        if (n_in != 30 || out_size != NBATCH * SEQ * DM || ws_size < WS_END) { fprintf(stderr, "kernel_launch: shape/workspace mismatch: n_in %d out %d ws %zu (need %zu)\n", n_in, out_size, ws_size, (size_t)WS_END); grid = -1; return; }
        int dev = 0, cus = 0, per_cu = 0;
        if (hipGetDevice(&dev) != hipSuccess || hipDeviceGetAttribute(&cus, hipDeviceAttributeMultiprocessorCount, dev) != hipSuccess) { grid = -1; return; }
        bool okattr = hipFuncSetAttribute((const void*)MAIN_KERNEL, hipFuncAttributeMaxDynamicSharedMemorySize, LDS_BYTES) == hipSuccess;
#if MK_N_LAUNCHES != 1
#define SETA(K) okattr = okattr && hipFuncSetAttribute((const void*)k_one<K>, hipFuncAttributeMaxDynamicSharedMemorySize, LDS_BYTES) == hipSuccess
        SETA(0); SETA(1); SETA(2); SETA(3); SETA(4); SETA(5); SETA(6); SETA(7); SETA(8); SETA(9); SETA(10); SETA(11); SETA(12); SETA(13);
#undef SETA
#endif
        if (!okattr) { fprintf(stderr, "kernel_launch: hipFuncSetAttribute failed\n"); grid = -1; return; }
        if (hipOccupancyMaxActiveBlocksPerMultiprocessor(&per_cu, (const void*)MAIN_KERNEL, NTHREADS, LDS_BYTES) != hipSuccess || per_cu < 1) { fprintf(stderr, "kernel_launch: occupancy query says %d blocks per CU\n", per_cu); grid = -1; (void)hipGetLastError(); return; }
        grid = cus;
    }
    if (grid < 0) return;
    if (hipMemsetAsync((char*)d_ws + WS_CTL, 0, CTL_BYTES, stream) != hipSuccess) return;
    Args a{};
    for (int i = 0; i < 30; ++i) a.in[i] = (const float*)d_in[i];
    a.out = (float*)d_out; a.ws = (unsigned char*)d_ws;
#if MK_N_LAUNCHES == 1
    a.ph_lo = 0; a.ph_hi = N_PHASES;
    hipLaunchKernelGGL(mk_fwd, dim3(grid), dim3(NTHREADS), LDS_BYTES, stream, a);
#else
    a.ph_hi = 0;
#ifndef DBG_NLAUNCH
#define DBG_NLAUNCH 100
#endif
    int nl_ = 0;
#define LAUNCH1(K, L) do { a.ph_lo = (L); if (nl_++ < DBG_NLAUNCH) { hipLaunchKernelGGL(k_one<K>, dim3(grid), dim3(NTHREADS), LDS_BYTES, stream, a); if (K == DBG_DUP) hipLaunchKernelGGL(k_one<K>, dim3(grid), dim3(NTHREADS), LDS_BYTES, stream, a); } } while (0)
#ifdef DBG_SCAN
    unsigned* flags = (unsigned*)((char*)d_ws + WS_CTL + 32768);
    char* W = (char*)d_ws;
#define S16(off, n, st) hipLaunchKernelGGL(k_scan16, dim3(1024), dim3(256), 0, stream, (const bf16_t*)(W + (off)), (size_t)(n), flags, st)
#define S32(off, n, st) hipLaunchKernelGGL(k_scan32, dim3(1024), dim3(256), 0, stream, (const float*)(W + (off)), (size_t)(n), flags, st)
    LAUNCH1(0, 0); S32(WS_MODV, 2 * 3 * 12288, 1);
    { const int l = 0;
      LAUNCH1(1, l); S16(WS_HB, (size_t)TT * DM, 2);
      LAUNCH1(2, l); S16(WS_P, (size_t)TT * NP, 3);
      LAUNCH1(3, l); S16(WS_P, (size_t)TT * NP, 4);
      LAUNCH1(4, l); S16(WS_MQ, (size_t)TT * 1536, 5); S16(WS_MKV, (size_t)TT * 2048, 5); S16(WS_GST, (size_t)2112 * 32768, 6); S32(WS_GDEC, (size_t)2112 * 128, 6);
      LAUNCH1(5, l); S16(WS_GST, (size_t)2112 * 32768, 7);
      LAUNCH1(6, l); S16(WS_OA, (size_t)TT * 1024, 8); S16(WS_OM, (size_t)TT * 1024, 9); S16(WS_OL, (size_t)TT * 1024, 10);
      LAUNCH1(7, l); S16(WS_Y, (size_t)TT * DM, 11);
      LAUNCH1(8, l); S32(WS_XS, (size_t)TT * DM, 12);
      LAUNCH1(9, l); S16(WS_HB, (size_t)TT * DM, 13);
      LAUNCH1(10, l); S16(WS_PQ, (size_t)TT * DM, 14);
      LAUNCH1(11, l); S32(WS_PG, (size_t)TT * 128, 15);
      LAUNCH1(12, l); S32(WS_XS, (size_t)TT * DM, 16);
    }
    hipLaunchKernelGGL(k_dbg_out, dim3(NBATCH * SEQ / 4), dim3(256), 0, stream, (const float*)d_in[0], (const float*)d_in[29], (float*)d_out, flags, 16);
#elif defined(DBG_CHECK)
    unsigned* flags = (unsigned*)((char*)d_ws + WS_CTL + 32768);
    char* W = (char*)d_ws;
    LAUNCH1(0, 0);
    { const int l = 0; LAUNCH1(1, l); LAUNCH1(2, l); LAUNCH1(3, l); LAUNCH1(4, l); LAUNCH1(5, l); LAUNCH1(6, l);
#if DBG_CHECK == 5 || DBG_CHECK == 6
      hipLaunchKernelGGL(k_check_attn, dim3(16 * 24), dim3(256), 0, stream, (const unsigned char*)d_ws, DBG_CHECK == 5 ? 1 : 0, flags + 100);
#endif
#if DBG_CHECK == 7
      { float* obuf = (float*)(W + WS_MQ);
        hipLaunchKernelGGL(k_check_gla_rec, dim3(8), dim3(256), 0, stream, (const unsigned char*)d_ws, (const float*)d_in[I_WA2F], (const float*)d_in[I_BAF], (const float*)d_in[I_WA2B], (const float*)d_in[I_BAB], obuf, 0);
        hipLaunchKernelGGL(k_check_gla_cmp, dim3(RPB * 4), dim3(256), 0, stream, (const unsigned char*)d_ws, (const float*)obuf, (const float*)d_in[I_ONG], 0, flags + 100); }
#endif
      LAUNCH1(7, l); LAUNCH1(8, l); LAUNCH1(9, l); LAUNCH1(10, l);
#if DBG_CHECK == 1
      hipLaunchKernelGGL(k_check_gemm, dim3(32), dim3(256), 0, stream, (const bf16_t*)(W + WS_HB), DM, (const float*)d_in[I_PWQ], DM, DM, (const bf16_t*)(W + WS_PQ), DM, TT, flags + 100);
#endif
      LAUNCH1(11, l);
#if DBG_CHECK == 2
      hipLaunchKernelGGL(k_check_select, dim3(256 * 8), dim3(64), 0, stream, (const bf16_t*)(W + WS_PQ), (const float*)d_in[I_PK1], (const float*)d_in[I_PK2], (const int*)(W + WS_PIDX), (const float*)(W + WS_PG), flags + 100);
#endif
      LAUNCH1(12, l);
#if DBG_CHECK == 3
      hipLaunchKernelGGL(k_check_gather, dim3(128), dim3(64), 0, stream, (const bf16_t*)(W + WS_HB), (const float*)d_in[I_PU], (const float*)d_in[I_PV], (const int*)(W + WS_PIDX), (const float*)(W + WS_PG), (const float*)(W + WS_MQ), flags + 100);
#endif
    }
    hipLaunchKernelGGL(k_dbg_out2, dim3(NBATCH * SEQ / 4), dim3(256), 0, stream, (const float*)d_in[0], (const float*)d_in[29], (float*)d_out, flags + 100);
#else
    LAUNCH1(0, 0);
    for (int l = 0; l < DEPTH; ++l) { LAUNCH1(1, l); LAUNCH1(2, l); LAUNCH1(3, l); LAUNCH1(4, l); LAUNCH1(5, l); LAUNCH1(6, l); LAUNCH1(7, l); LAUNCH1(8, l); LAUNCH1(9, l); LAUNCH1(10, l); LAUNCH1(11, l); LAUNCH1(12, l); }
    LAUNCH1(13, DEPTH - 1);
#endif
#undef LAUNCH1
#endif
    const hipError_t le = hipPeekAtLastError();
    if (le != hipSuccess) fprintf(stderr, "kernel_launch: launch failed: %s\n", hipGetErrorName(le));
}
```

```cpp
#include <hip/hip_runtime.h>
#include <cstdio>
#include <cstdint>

#ifndef MK_N_LAUNCHES
#ifndef DBG_DUP
#define DBG_DUP -1
#endif
#define MK_N_LAUNCHES 1
#endif

#ifndef DBG_MIX0
#define DBG_MIX0 1.0f
#define DBG_MIX1 1.0f
#define DBG_PEER0 1.0f
#define DBG_PEER1 1.0f
#endif
#define LAS __attribute__((address_space(3)))
typedef unsigned short bf16_t;
typedef short bf16x8 __attribute__((ext_vector_type(8)));
typedef short s16x4 __attribute__((ext_vector_type(4)));
typedef float f32x4 __attribute__((ext_vector_type(4)));
typedef float f32x2 __attribute__((ext_vector_type(2)));
typedef float f32x16 __attribute__((ext_vector_type(16)));
typedef unsigned u32x4 __attribute__((ext_vector_type(4)));
typedef unsigned u32x2 __attribute__((ext_vector_type(2)));
typedef __bf16 bf2_t __attribute__((ext_vector_type(2)));

constexpr int DM = 2048, NBATCH = 2, SEQ = 8192, CTXL = 256, DEPTH = 2;
constexpr int RPB = SEQ + CTXL;
constexpr int TT = NBATCH * RPB;
constexpr int IN_COLS = 11872, NP = 12032;
constexpr int C_AQ = 0, C_AK = 1024, C_AV = 1280, C_LQ = 1536, C_LK = 2048, C_LV = 2560, C_LG = 3584, C_LRF = 4608, C_LRB = 4624,
              C_MCQ = 4640, C_MCKV = 5152, C_MKR = 5664, C_GA = 5728, C_GL = 7776, C_GM = 9824;
constexpr int NCH = RPB / 64;
constexpr int NEXP = 16384;
constexpr float NORM_EPS = 1e-6f;
constexpr int NTHREADS = 512;

constexpr size_t al256(size_t x) { return (x + 255) / 256 * 256; }
constexpr size_t WS_CTL   = 0;
constexpr size_t CTL_BYTES = 65536;
constexpr size_t WS_MODV  = WS_CTL + CTL_BYTES;
constexpr size_t WS_TABA  = al256(WS_MODV + (size_t)2 * 3 * 12288 * 4);
constexpr size_t WS_TABM  = WS_TABA + 2 * 128 * 32 * 4;
constexpr size_t WS_XS    = al256(WS_TABM + 2 * 128 * 16 * 4);
constexpr size_t WS_HB    = WS_XS + (size_t)TT * DM * 4;
constexpr size_t WS_P     = WS_HB + (size_t)TT * DM * 2;
constexpr size_t WS_MQ    = WS_P + (size_t)TT * NP * 2;
constexpr size_t WS_MKV   = WS_MQ + (size_t)TT * 1536 * 2;
constexpr size_t WS_OA    = WS_MKV + (size_t)TT * 2048 * 2;
constexpr size_t WS_OL    = WS_OA + (size_t)TT * 1024 * 2;
constexpr size_t WS_OM    = WS_OL + (size_t)TT * 1024 * 2;
constexpr size_t WS_WIN   = WS_OM + (size_t)TT * 1024 * 2;
constexpr size_t WS_WUQ   = WS_WIN + (size_t)NP * 2048 * 2;
constexpr size_t WS_WUKV  = WS_WUQ + (size_t)1536 * 512 * 2;
constexpr size_t WS_WBR   = WS_WUKV + (size_t)2048 * 512 * 2;
constexpr size_t WS_WOUT  = WS_WBR + (size_t)3 * 2048 * 1024 * 2;
constexpr size_t WS_WQ    = WS_WOUT + (size_t)2048 * 2048 * 2;
constexpr size_t WS_K1    = WS_WQ + (size_t)2048 * 2048 * 2;
constexpr size_t WS_K2    = WS_K1 + (size_t)8 * 128 * 128 * 2;
constexpr size_t WS_GST   = WS_K2 + (size_t)8 * 128 * 128 * 2;
constexpr size_t WS_GDEC  = WS_GST + (size_t)NBATCH * 2 * 4 * NCH * 32768 * 2;
constexpr size_t WS_END   = WS_GDEC + (size_t)NBATCH * 2 * 4 * NCH * 128 * 4;
constexpr size_t WS_Y     = WS_MKV;
constexpr size_t WS_PQ    = WS_OA;
constexpr size_t WS_U8    = WS_P;
constexpr size_t WS_V8    = WS_U8 + (size_t)NEXP * DM;
constexpr size_t WS_SCU   = WS_V8 + (size_t)NEXP * DM;
constexpr size_t WS_SCV   = WS_SCU + (size_t)NEXP * 4;
constexpr size_t WS_PIDX  = WS_SCV + (size_t)NEXP * 4;
constexpr size_t WS_PG    = WS_PIDX + (size_t)TT * 128 * 4;
static_assert(WS_PG + (size_t)TT * 128 * 4 <= WS_MQ, "PEER alias region overflows P");

__device__ __forceinline__ unsigned cvt_pk_bf16(float lo, float hi) { bf2_t v; v.x = (__bf16)lo; v.y = (__bf16)hi; return __builtin_bit_cast(unsigned, v); }
__device__ __forceinline__ bf16_t f2bf(float f) { return (bf16_t)(cvt_pk_bf16(f, 0.f) & 0xffffu); }
__device__ __forceinline__ float bf2f(bf16_t b) { return __uint_as_float(((unsigned)b) << 16); }
__device__ __forceinline__ float bflo(unsigned w) { return __uint_as_float(w << 16); }
__device__ __forceinline__ float bfhi(unsigned w) { return __uint_as_float(w & 0xffff0000u); }
__device__ __forceinline__ float wave_sum(float v) {
#pragma unroll
    for (int o = 32; o >= 1; o >>= 1) v += __shfl_xor(v, o);
    return v;
}
__device__ __forceinline__ float sigmoidf_(float x) { return __builtin_amdgcn_rcpf(1.0f + __expf(-x)); }
__device__ __forceinline__ float siluf_(float x) { return x * __builtin_amdgcn_rcpf(1.0f + __expf(-x)); }

#define XB_TMO      128
#define XB_XCNT(j)  (256  + 64 * (j))
#define XB_XSUB(j)  (1280 + 64 * (j))
#define XB_XGEN(j)  (2304 + 64 * (j))
#define XB_TOP      3328
#define XB_TOPGEN   3392
#define XCD_BAR_WORDS 3456
#define XB_SPIN_CAP (1u << 20)
__device__ __forceinline__ unsigned xb_ld(unsigned* p)              { return __hip_atomic_load(p, __ATOMIC_RELAXED, __HIP_MEMORY_SCOPE_AGENT); }
__device__ __forceinline__ unsigned xb_add(unsigned* p, unsigned v) { return __hip_atomic_fetch_add(p, v, __ATOMIC_RELAXED, __HIP_MEMORY_SCOPE_AGENT); }
__device__ __forceinline__ unsigned xb_xcc_id() { return (unsigned)__builtin_amdgcn_s_getreg((3 << 11) | 20) & 0xFu; }
#define XB_SPIN(cond, bar) do { unsigned _sp = 0; while (cond) { __builtin_amdgcn_s_sleep(1); \
    if ((++_sp & 255u) == 0u) { if (xb_ld(&(bar)[XB_TMO])) break; if (_sp > XB_SPIN_CAP) { atomicAdd(&(bar)[XB_TMO], 1u); break; } } } } while (0)
struct XcdBarrier { unsigned* bar; unsigned x; volatile LAS unsigned* st; };
__device__ __forceinline__ XcdBarrier xcd_barrier_post(unsigned* bar, volatile LAS unsigned* st) {
    XcdBarrier b; b.bar = bar; b.x = xb_xcc_id(); b.st = st;
    if (threadIdx.x == 0) (void)xb_add(&bar[XB_XCNT(b.x)], 1u);
    return b;
}
__device__ __forceinline__ void xcd_barrier_complete(unsigned* bar, unsigned x, unsigned& nloc, unsigned& nx) {
    const unsigned G = gridDim.x * gridDim.y * gridDim.z;
    unsigned sum, cnt, mine, sp = 0u;
    for (;;) {
        sum = 0u; cnt = 0u; mine = 0u;
#pragma unroll
        for (unsigned j = 0; j < 16; ++j) { const unsigned c = xb_ld(&bar[XB_XCNT(j)]); sum += c; cnt += (c > 0u) ? 1u : 0u; mine = (j == x) ? c : mine; }
        if (sum == G) break;
        __builtin_amdgcn_s_sleep(1);
        if ((++sp & 255u) == 0u) { if (xb_ld(&bar[XB_TMO])) break; if (sp > XB_SPIN_CAP) { atomicAdd(&bar[XB_TMO], 1u); break; } }
    }
    nloc = mine > 0u ? mine : 1u; nx = cnt > 0u ? cnt : 1u;
}
__device__ __forceinline__ void xcd_barrier(const XcdBarrier& b) {
    asm volatile("s_waitcnt vmcnt(0)" ::: "memory");
    __syncthreads();
    if (threadIdx.x == 0) {
        unsigned* bar = b.bar;
        __builtin_amdgcn_s_waitcnt(0);
        unsigned nloc = b.st[0], nx = b.st[1];
        if (nloc == 0u) { xcd_barrier_complete(bar, b.x, nloc, nx); b.st[0] = nloc; b.st[1] = nx; }
        const unsigned old = xb_add(&bar[XB_XSUB(b.x)], 1u);
        const unsigned gen = old / nloc;
        if (old + 1u == (gen + 1u) * nloc) {
            __builtin_amdgcn_fence(__ATOMIC_RELEASE, "agent");
            asm volatile("s_waitcnt vmcnt(0)" ::: "memory");
            const unsigned og = xb_add(&bar[XB_TOP], 1u);
            const unsigned tg = og / nx;
            if (og + 1u == (tg + 1u) * nx) xb_add(&bar[XB_TOPGEN], 1u);
            else XB_SPIN(xb_ld(&bar[XB_TOPGEN]) == tg, bar);
            __builtin_amdgcn_fence(__ATOMIC_ACQUIRE, "agent");
            xb_add(&bar[XB_XGEN(b.x)], 1u);
            asm volatile("s_waitcnt vmcnt(0)" ::: "memory");
        } else {
            XB_SPIN(xb_ld(&bar[XB_XGEN(b.x)]) == gen, bar);
            __builtin_amdgcn_fence(__ATOMIC_ACQUIRE, "agent");
            asm volatile("s_waitcnt vmcnt(0)" ::: "memory");
        }
    }
    __syncthreads();
}

namespace pg8 {
constexpr int BM = 256, BK = 64, HALF = 128, HTB = HALF * BK * 2, STAGE_BYTES = 8 * HTB, NXCD = 8, WGM = 8;
__host__ __device__ __forceinline__ int lds_byte(int r, int c) { const int st = (r >> 4) * 2 + (c >> 5), rr = r & 15, cc = c & 31, ob = rr * 64 + cc * 2; return st * 1024 + (ob ^ (((ob >> 9) & 1) << 5)); }
__host__ __device__ __forceinline__ void stage_rc(int b, int& R, int& C) { const int st = b / 1024, sb = b % 1024, swz = sb ^ (((sb >> 9) & 1) << 5); R = (st >> 1) * 16 + swz / 64; C = (st & 1) * 32 + (swz % 64) / 2; }
__host__ __device__ __forceinline__ int perm32(int rho) { const int n = rho >> 4, i = rho & 15; return 8 * (i >> 2) + 4 * n + (i & 3); }
struct Unit { int pm, pn; };
struct Gemm { const bf16_t* A; const bf16_t* Bt; int M, N, K, lda, ldb; };
struct StaticOrder {
    int nM, nN, nwg, G, c, latent;
    __host__ __device__ void init(int M, int N, int G_, int c_, int latent_ = 0) { latent = latent_; nM = latent_ ? 64 : M / BM; nN = N / BM; nwg = nM * nN; G = G_; c = c_; }
    __host__ __device__ bool next(int i, Unit& u) const {
        const long L = (long)i * G + c; if (L >= nwg) return false;
        int wgid = (int)L; { const int q = nwg / NXCD, r = nwg % NXCD, xcd = wgid % NXCD, off = wgid / NXCD; wgid = (xcd < r ? xcd * (q + 1) : r * (q + 1) + (xcd - r) * q) + off; }
        const int nig = WGM * nN, gid = wgid / nig, fm = gid * WGM, gsz = (nM - fm) < WGM ? (nM - fm) : WGM;
        u.pm = fm + ((wgid % nig) % gsz); u.pn = (wgid % nig) / gsz; if (latent) u.pm += 1 + (u.pm >= 32 ? 1 : 0); return true;
    }
};
struct EpiStoreBf16 {
    static constexpr bool PERM = true;
    bf16_t* O; int ldc;
    __device__ __forceinline__ void operator()(const f32x4 (&acc)[2][2][4][2], const Unit& u, int wr, int wc, int fr, int fq) const {
        const int row0 = u.pm * BM + wr * 64 + fr, col0 = u.pn * BM + wc * 32 + 8 * fq;
#pragma unroll
        for (int ai = 0; ai < 2; ++ai)
#pragma unroll
            for (int m = 0; m < 4; ++m) { bf16_t* rowp = O + (size_t)(row0 + ai * HALF + m * 16) * ldc + col0;
#pragma unroll
                for (int bj = 0; bj < 2; ++bj) { const f32x4 v0 = acc[ai][bj][m][0], v1 = acc[ai][bj][m][1];
                    u32x4 w; w.x = cvt_pk_bf16(v0[0], v0[1]); w.y = cvt_pk_bf16(v0[2], v0[3]); w.z = cvt_pk_bf16(v1[0], v1[1]); w.w = cvt_pk_bf16(v1[2], v1[3]);
                    *(u32x4*)(rowp + bj * HALF) = w; } }
    }
};
template <bool FIRST> struct EpiGate {
    static constexpr bool PERM = true;
    bf16_t* Y; int ldy; const bf16_t* Gt; int ldg;
    __device__ __forceinline__ void operator()(const f32x4 (&acc)[2][2][4][2], const Unit& u, int wr, int wc, int fr, int fq) const {
        const int row0 = u.pm * BM + wr * 64 + fr, col0 = u.pn * BM + wc * 32 + 8 * fq;
#pragma unroll
        for (int ai = 0; ai < 2; ++ai)
#pragma unroll
        for (int mh = 0; mh < 2; ++mh) {
            u32x4 g[2][2], y[2][2];
#pragma unroll
            for (int mm = 0; mm < 2; ++mm)
#pragma unroll
                for (int bj = 0; bj < 2; ++bj) { const size_t r = (size_t)(row0 + ai * HALF + (mh * 2 + mm) * 16);
                    g[mm][bj] = *(const u32x4*)(Gt + r * ldg + col0 + bj * HALF);
                    if (!FIRST) y[mm][bj] = *(const u32x4*)(Y + r * ldy + col0 + bj * HALF); }
#pragma unroll
            for (int mm = 0; mm < 2; ++mm)
#pragma unroll
                for (int bj = 0; bj < 2; ++bj) { const int m = mh * 2 + mm; const size_t r = (size_t)(row0 + ai * HALF + m * 16); const f32x4 v0 = acc[ai][bj][m][0], v1 = acc[ai][bj][m][1]; const u32x4 gg = g[mm][bj];
                    float o[8];
                    o[0] = sigmoidf_(bflo(gg.x)) * v0[0]; o[1] = sigmoidf_(bfhi(gg.x)) * v0[1]; o[2] = sigmoidf_(bflo(gg.y)) * v0[2]; o[3] = sigmoidf_(bfhi(gg.y)) * v0[3];
                    o[4] = sigmoidf_(bflo(gg.z)) * v1[0]; o[5] = sigmoidf_(bfhi(gg.z)) * v1[1]; o[6] = sigmoidf_(bflo(gg.w)) * v1[2]; o[7] = sigmoidf_(bfhi(gg.w)) * v1[3];
                    if (!FIRST) { const u32x4 yy = y[mm][bj];
                        o[0] += bflo(yy.x); o[1] += bfhi(yy.x); o[2] += bflo(yy.y); o[3] += bfhi(yy.y); o[4] += bflo(yy.z); o[5] += bfhi(yy.z); o[6] += bflo(yy.w); o[7] += bfhi(yy.w); }
                    u32x4 w; w.x = cvt_pk_bf16(o[0], o[1]); w.y = cvt_pk_bf16(o[2], o[3]); w.z = cvt_pk_bf16(o[4], o[5]); w.w = cvt_pk_bf16(o[6], o[7]);
                    *(u32x4*)(Y + r * ldy + col0 + bj * HALF) = w; }
        }
    }
};
struct EpiResid {
    static constexpr bool PERM = false;
    float* X; int ldx; const float* gate; float gscale;
    __device__ __forceinline__ void operator()(const f32x4 (&acc)[2][2][4][2], const Unit& u, int wr, int wc, int fr, int fq) const {
        const int row0 = u.pm * BM + wr * 64 + fr, col0 = u.pn * BM + wc * 32 + 4 * fq;
        const int sel = (u.pm % 33 == 0) ? 2 : (u.pm / 33);
        const float* gp = gate + (size_t)sel * 12288 + col0;
        f32x4 gv[2][2];
#pragma unroll
        for (int bj = 0; bj < 2; ++bj)
#pragma unroll
            for (int n = 0; n < 2; ++n) gv[bj][n] = *(const f32x4*)(gp + bj * HALF + n * 16) * gscale;
#pragma unroll
        for (int ai = 0; ai < 2; ++ai)
#pragma unroll
            for (int mh = 0; mh < 2; ++mh) {
                f32x4 x[2][2][2];
#pragma unroll
                for (int mm = 0; mm < 2; ++mm)
#pragma unroll
                    for (int bj = 0; bj < 2; ++bj)
#pragma unroll
                        for (int n = 0; n < 2; ++n) x[mm][bj][n] = *(const f32x4*)(X + (size_t)(row0 + ai * HALF + (mh * 2 + mm) * 16) * ldx + col0 + bj * HALF + n * 16);
#pragma unroll
                for (int mm = 0; mm < 2; ++mm)
#pragma unroll
                    for (int bj = 0; bj < 2; ++bj)
#pragma unroll
                        for (int n = 0; n < 2; ++n) *(f32x4*)(X + (size_t)(row0 + ai * HALF + (mh * 2 + mm) * 16) * ldx + col0 + bj * HALF + n * 16) = x[mm][bj][n] + gv[bj][n] * acc[ai][bj][mh * 2 + mm][n];
            }
    }
};

template <class Epi, class Sched>
__device__ __forceinline__ void gemm_phase(LAS unsigned char* lds, const int tid, const Gemm g, const Sched& S, const Epi& E) {
    const int wid = __builtin_amdgcn_readfirstlane(tid >> 6), lane = tid & 63, wr = wid >> 2, wc = wid & 3, fr = lane & 15, fq = lane >> 4;
    const int K = g.K, nt = K / BK, lda = g.lda, ldb = g.ldb;
    unsigned voffA[2], voffB[2];
#pragma unroll
    for (int i = 0; i < 2; ++i) { int R, C; stage_rc(tid * 16 + i * 8192, R, C); const int Rb = Epi::PERM ? ((R & ~31) + perm32(R & 31)) : R;
        voffA[i] = (unsigned)(R * lda + C) * 2u; voffB[i] = (unsigned)(Rb * ldb + C) * 2u; }
    const size_t kstep = (size_t)(BK * 2);
    const size_t hstepA = (size_t)HALF * lda * 2, hstepB = (size_t)HALF * ldb * 2;
    const size_t tstepA = 2 * hstepA, tstepB = 2 * hstepB;
    const unsigned ldsw = (unsigned)wid * 1024u;
    const int aoff = lds_byte(wr * 64 + fr, fq * 8), boff = lds_byte(wc * 32 + fr, fq * 8);
#define PG8_SA(b, h) (((b) * 2 + (h)) * HTB)
#define PG8_SB(b, h) ((4 + (b) * 2 + (h)) * HTB)
#define PG8_STAGE(bufoff, gbase, voff) do { _Pragma("unroll") for (int _i = 0; _i < 2; ++_i) \
        __builtin_amdgcn_global_load_lds((const unsigned*)((const char*)(gbase) + (voff)[_i]), (LAS unsigned*)(lds + (bufoff) + ldsw + _i * 8192), 16, 0, 0); } while (0)
#define PG8_LDA(dst, b, h) do { _Pragma("unroll") for (int m = 0; m < 4; ++m) _Pragma("unroll") for (int k = 0; k < 2; ++k) dst[m][k] = *(const LAS bf16x8*)(lds + PG8_SA(b, h) + aoff + m * 2048 + k * 1024); } while (0)
#define PG8_LDB(dst, b, h) do { _Pragma("unroll") for (int n = 0; n < 2; ++n) _Pragma("unroll") for (int k = 0; k < 2; ++k) dst[n][k] = *(const LAS bf16x8*)(lds + PG8_SB(b, h) + boff + n * 2048 + k * 1024); } while (0)
#define PG8_MMA(ai, bj, At, Bt) do { __builtin_amdgcn_s_setprio(1); _Pragma("unroll") for (int m = 0; m < 4; ++m) _Pragma("unroll") for (int n = 0; n < 2; ++n) _Pragma("unroll") for (int k = 0; k < 2; ++k) \
        acc[ai][bj][m][n] = __builtin_amdgcn_mfma_f32_16x16x32_bf16(Bt[n][k], At[m][k], acc[ai][bj][m][n], 0, 0, 0); __builtin_amdgcn_s_setprio(0); } while (0)
#define PG8_WAIT_V(n) asm volatile("s_waitcnt vmcnt(" #n ")" ::: "memory")
#define PG8_WAIT_L(n) asm volatile("s_waitcnt lgkmcnt(" #n ")" ::: "memory")
#define PG8_BAR __builtin_amdgcn_s_barrier()
#define PG8_SCHED __builtin_amdgcn_sched_barrier(0)
    Unit cur, nxt; int ui = 0;
    if (!S.next(0, cur)) return;
    f32x4 acc[2][2][4][2];
#pragma unroll
    for (int a = 0; a < 2; ++a)
#pragma unroll
        for (int b = 0; b < 2; ++b)
#pragma unroll
            for (int m = 0; m < 4; ++m)
#pragma unroll
                for (int n = 0; n < 2; ++n) acc[a][b][m][n] = (f32x4){0.f, 0.f, 0.f, 0.f};
    bf16x8 At[4][2], B0[2][2], B1[2][2];
    const char* cA = (const char*)g.A + (size_t)cur.pm * tstepA; const char* cB = (const char*)g.Bt + (size_t)cur.pn * tstepB;
    PG8_STAGE(PG8_SB(0, 0), cB, voffB); PG8_STAGE(PG8_SA(0, 0), cA, voffA); PG8_STAGE(PG8_SB(0, 1), cB + hstepB, voffB); PG8_STAGE(PG8_SA(0, 1), cA + hstepA, voffA);
    if (wr == 1) PG8_BAR;
    PG8_WAIT_V(4); PG8_BAR;
    PG8_STAGE(PG8_SB(1, 0), cB + kstep, voffB); PG8_STAGE(PG8_SA(1, 0), cA + kstep, voffA); PG8_STAGE(PG8_SB(1, 1), cB + hstepB + kstep, voffB);
    PG8_WAIT_V(6); PG8_BAR;
    for (;;) {
        const bool has_next = S.next(ui + 1, nxt);
        const char* nA = has_next ? (const char*)g.A + (size_t)nxt.pm * tstepA : cA; const char* nB = has_next ? (const char*)g.Bt + (size_t)nxt.pn * tstepB : cB;
        for (int t = 0; t < nt; t += 2) {
            const bool last = (t == nt - 2);
            const char* a1 = cA + (size_t)(t + 1) * kstep;
            const char* a2 = last ? nA : cA + (size_t)(t + 2) * kstep; const char* b2 = last ? nB : cB + (size_t)(t + 2) * kstep;
            const char* a3 = a2 + kstep; const char* b3 = b2 + kstep;
            PG8_LDB(B0, 0, 0); PG8_SCHED; PG8_LDA(At, 0, 0); PG8_STAGE(PG8_SA(1, 1), a1 + hstepA, voffA);
            PG8_WAIT_L(8); PG8_BAR; PG8_WAIT_L(0); PG8_MMA(0, 0, At, B0); PG8_BAR; PG8_SCHED;
            PG8_LDB(B1, 0, 1); PG8_STAGE(PG8_SB(0, 0), b2, voffB);
            PG8_BAR; PG8_WAIT_L(0); PG8_MMA(0, 1, At, B1); PG8_BAR;
            PG8_LDA(At, 0, 1); PG8_STAGE(PG8_SA(0, 0), a2, voffA);
            PG8_BAR; PG8_WAIT_L(0); PG8_MMA(1, 0, At, B0); PG8_BAR; PG8_SCHED;
            PG8_STAGE(PG8_SB(0, 1), b2 + hstepB, voffB);
            PG8_WAIT_V(6); PG8_BAR; PG8_MMA(1, 1, At, B1); PG8_BAR;
            PG8_LDB(B0, 1, 0); PG8_SCHED; PG8_LDA(At, 1, 0); PG8_STAGE(PG8_SA(0, 1), a2 + hstepA, voffA);
            PG8_WAIT_L(8); PG8_BAR; PG8_WAIT_L(0); PG8_MMA(0, 0, At, B0); PG8_BAR; PG8_SCHED;
            PG8_LDB(B1, 1, 1); PG8_STAGE(PG8_SB(1, 0), b3, voffB);
            PG8_BAR; PG8_WAIT_L(0); PG8_MMA(0, 1, At, B1); PG8_BAR;
            PG8_LDA(At, 1, 1); PG8_STAGE(PG8_SA(1, 0), a3, voffA);
            PG8_BAR; PG8_WAIT_L(0); PG8_MMA(1, 0, At, B0); PG8_BAR; PG8_SCHED;
            PG8_STAGE(PG8_SB(1, 1), b3 + hstepB, voffB);
            PG8_WAIT_V(6); PG8_BAR; PG8_MMA(1, 1, At, B1); PG8_BAR;
        }
        E(acc, cur, wr, wc, fr, fq);
        if (!has_next) break;
#pragma unroll
        for (int a = 0; a < 2; ++a)
#pragma unroll
            for (int b = 0; b < 2; ++b)
#pragma unroll
                for (int m = 0; m < 4; ++m)
#pragma unroll
                    for (int n = 0; n < 2; ++n) acc[a][b][m][n] = (f32x4){0.f, 0.f, 0.f, 0.f};
        cur = nxt; cA = nA; cB = nB; ++ui;
    }
    PG8_WAIT_V(0);
    if (wr == 0) PG8_BAR;
    PG8_BAR;
#undef PG8_SA
#undef PG8_SB
#undef PG8_STAGE
#undef PG8_LDA
#undef PG8_LDB
#undef PG8_MMA
#undef PG8_WAIT_V
#undef PG8_WAIT_L
#undef PG8_BAR
#undef PG8_SCHED
}
}

struct Args { const float* in[30]; float* out; unsigned char* ws; int ph_lo, ph_hi; };
enum { I_X = 0, I_C, I_CTX, I_CCTX, I_WMOD, I_BMOD, I_N1G, I_WIN, I_QNG, I_KNG, I_WA2F, I_BAF, I_WA2B, I_BAB, I_ONG, I_MQNG, I_WUQ, I_MKVNG, I_WUKV,
       I_WBRA, I_WBRL, I_WBRM, I_WOUT, I_N2G, I_PWQ, I_PK1, I_PK2, I_PU, I_PV, I_FG };
typedef const float* cfp_t;
struct Ctx {
    const __attribute__((address_space(4))) cfp_t* in; float* out; unsigned char* ws; LAS unsigned char* lds;
    int tid, lane, wid, G, bid;
};
#define WSP(T, off) ((T*)(C.ws + (off)))
#define INP(i) (C.in[(i)])
__device__ __forceinline__ unsigned long long launder_u64(unsigned long long w) {
    unsigned lo = (unsigned)w, hi = (unsigned)(w >> 32); asm volatile("" : "+v"(lo), "+v"(hi));
    lo = __builtin_amdgcn_readfirstlane(lo); hi = __builtin_amdgcn_readfirstlane(hi); return ((unsigned long long)hi << 32) | lo;
}
__device__ __forceinline__ Ctx launder(const Ctx& C0) {
    Ctx R = C0; int t = C0.tid; asm volatile("" : "+v"(t)); R.tid = t; R.lane = t & 63; R.wid = __builtin_amdgcn_readfirstlane(t >> 6);
    R.ws = (unsigned char*)launder_u64((unsigned long long)C0.ws);
    R.in = (const __attribute__((address_space(4))) cfp_t*)launder_u64((unsigned long long)C0.in);
    unsigned l = (unsigned)(uintptr_t)C0.lds; asm volatile("" : "+v"(l)); l = __builtin_amdgcn_readfirstlane(l); R.lds = (LAS unsigned char*)(uintptr_t)l;
    return R;
}

__device__ __forceinline__ const float* src_row(const Ctx& C, int r) {
    const int b = r / RPB, j = r % RPB;
    return j < CTXL ? INP(I_CTX) + ((size_t)b * CTXL + j) * DM : INP(I_X) + ((size_t)b * SEQ + (j - CTXL)) * DM;
}
__device__ __forceinline__ int mod_sel(int r) { const int b = r / RPB, j = r % RPB; return j < CTXL ? 2 : b; }

__device__ __forceinline__ void phase_modv(const Ctx& C) {
    LAS float* sc = (LAS float*)C.lds;
    LAS float* red = (LAS float*)(C.lds + 3 * 2048 * 4);
    for (int i = C.tid; i < 3 * DM; i += NTHREADS) { const int r = i / DM, k = i % DM; const float v = r < 2 ? INP(I_C)[r * DM + k] : INP(I_CCTX)[k]; sc[i] = siluf_(v); }
    __syncthreads();
    float* modv = WSP(float, WS_MODV);
    const int kq = C.tid / 12, c4 = C.tid % 12;
    for (int item = C.bid; item < 2 * 256; item += C.G) {
        const int l = item / 256, cg = item % 256;
        float acc[3][4];
#pragma unroll
        for (int r = 0; r < 3; ++r)
#pragma unroll
            for (int j = 0; j < 4; ++j) acc[r][j] = 0.f;
        if (kq < 42) {
            const float* wp = INP(I_WMOD) + (size_t)l * DM * 12288 + 48 * cg + 4 * c4;
            for (int k = kq; k < DM; k += 42) {
                const f32x4 w = *(const f32x4*)(wp + (size_t)k * 12288);
#pragma unroll
                for (int r = 0; r < 3; ++r) { const float s = sc[r * DM + k];
#pragma unroll
                    for (int j = 0; j < 4; ++j) acc[r][j] += s * w[j]; }
            }
#pragma unroll
            for (int r = 0; r < 3; ++r)
#pragma unroll
                for (int j = 0; j < 4; ++j) red[kq * 144 + r * 48 + c4 * 4 + j] = acc[r][j];
        }
        __syncthreads();
        if (C.tid < 144) { float s = 0.f; for (int q = 0; q < 42; ++q) s += red[q * 144 + C.tid];
            const int r = C.tid / 48, cc = C.tid % 48;
            modv[((size_t)l * 3 + r) * 12288 + 48 * cg + cc] = s + INP(I_BMOD)[(size_t)l * 12288 + 48 * cg + cc]; }
        __syncthreads();
    }
}
__device__ __forceinline__ void phase_tables(const Ctx& C) {
    float* ta = WSP(float, WS_TABA); float* tm = WSP(float, WS_TABM);
    for (int i = C.bid * NTHREADS + C.tid; i < 128 * 32 + 128 * 16; i += C.G * NTHREADS) {
        if (i < 128 * 32) { const int pos = i / 32, f = i % 32; const float inv = exp2f(-(float)f * (13.287712379549449f / 32.0f)); const float a = (float)pos * inv;
            ta[i] = cosf(a); ta[128 * 32 + i] = sinf(a); }
        else { const int k = i - 128 * 32, pos = k / 16, f = k % 16; const float inv = exp2f(-(float)f * (13.287712379549449f / 16.0f)); const float a = (float)pos * inv;
            tm[k] = cosf(a); tm[128 * 16 + k] = sinf(a); }
    }
}
__device__ __forceinline__ void transpose_cvt(const Ctx& C, const float* src, int K, int N, bf16_t* dst, int Npad, int& item) {
    LAS float* tile = (LAS float*)C.lds;
    const int tk = K / 64, tn = Npad / 64, ntile = tk * tn;
    const int t0 = ((C.bid - item % C.G) + C.G) % C.G; item += ntile;
    for (int t = t0; t < ntile; t += C.G) {
        const int k0 = (t / tn) * 64, n0 = (t % tn) * 64;
#pragma unroll
        for (int p = 0; p < 2; ++p) { const int kk = (C.tid >> 4) + p * 32, nn = (C.tid & 15) * 4;
            f32x4 v = (f32x4){0.f, 0.f, 0.f, 0.f};
            if (n0 + nn < N) v = *(const f32x4*)(src + (size_t)(k0 + kk) * N + n0 + nn);
#pragma unroll
            for (int j = 0; j < 4; ++j) tile[kk * 65 + nn + j] = v[j]; }
        __syncthreads();
        { const int n = C.tid >> 3, k8 = (C.tid & 7) * 8; float v[8];
#pragma unroll
          for (int j = 0; j < 8; ++j) v[j] = tile[(k8 + j) * 65 + n];
          u32x4 w; w.x = cvt_pk_bf16(v[0], v[1]); w.y = cvt_pk_bf16(v[2], v[3]); w.z = cvt_pk_bf16(v[4], v[5]); w.w = cvt_pk_bf16(v[6], v[7]);
          *(u32x4*)(dst + (size_t)(n0 + n) * K + k0 + k8) = w; }
        __syncthreads();
    }
}
__device__ __forceinline__ void cvt_plain(const Ctx& C, const float* src, bf16_t* dst, size_t n8) {
    for (size_t i = (size_t)C.bid * NTHREADS + C.tid; i < n8; i += (size_t)C.G * NTHREADS) {
        const f32x4 a = *(const f32x4*)(src + i * 8), b = *(const f32x4*)(src + i * 8 + 4);
        u32x4 w; w.x = cvt_pk_bf16(a[0], a[1]); w.y = cvt_pk_bf16(a[2], a[3]); w.z = cvt_pk_bf16(b[0], b[1]); w.w = cvt_pk_bf16(b[2], b[3]);
        *(u32x4*)(dst + i * 8) = w;
    }
}
__device__ __forceinline__ void phase_cvt_mixer_weights(const Ctx& C, int l) {
    int item = 0;
    transpose_cvt(C, INP(I_WIN) + (size_t)l * DM * IN_COLS, DM, IN_COLS, WSP(bf16_t, WS_WIN), NP, item);
    transpose_cvt(C, INP(I_WUQ) + (size_t)l * 512 * 1536, 512, 1536, WSP(bf16_t, WS_WUQ), 1536, item);
    transpose_cvt(C, INP(I_WUKV) + (size_t)l * 512 * 2048, 512, 2048, WSP(bf16_t, WS_WUKV), 2048, item);
    transpose_cvt(C, INP(I_WBRA) + (size_t)l * 1024 * 2048, 1024, 2048, WSP(bf16_t, WS_WBR), 2048, item);
    transpose_cvt(C, INP(I_WBRL) + (size_t)l * 1024 * 2048, 1024, 2048, WSP(bf16_t, WS_WBR) + (size_t)2048 * 1024, 2048, item);
    transpose_cvt(C, INP(I_WBRM) + (size_t)l * 1024 * 2048, 1024, 2048, WSP(bf16_t, WS_WBR) + (size_t)2 * 2048 * 1024, 2048, item);
    transpose_cvt(C, INP(I_WOUT) + (size_t)l * 2048 * 2048, 2048, 2048, WSP(bf16_t, WS_WOUT), 2048, item);
    transpose_cvt(C, INP(I_PWQ) + (size_t)l * 2048 * 2048, 2048, 2048, WSP(bf16_t, WS_WQ), 2048, item);
    cvt_plain(C, INP(I_PK1) + (size_t)l * 8 * 128 * 128, WSP(bf16_t, WS_K1), 8 * 128 * 128 / 8);
    cvt_plain(C, INP(I_PK2) + (size_t)l * 8 * 128 * 128, WSP(bf16_t, WS_K2), 8 * 128 * 128 / 8);
}
__device__ __forceinline__ void phase_cvt_peer_tables(const Ctx& C, int l) {
    const int lane = C.lane;
    for (int row = C.bid * 8 + C.wid; row < NEXP; row += C.G * 8) {
#pragma unroll 1
        for (int tb = 0; tb < 2; ++tb) {
            const float* src = (tb ? INP(I_PV) : INP(I_PU)) + ((size_t)l * NEXP + row) * DM + lane * 16;
            f32x4 x[8]; float amax = 0.f;
#pragma unroll
            for (int c = 0; c < 2; ++c)
#pragma unroll
                for (int q = 0; q < 4; ++q) { x[c * 4 + q] = *(const f32x4*)(src + c * 1024 + q * 4);
                    amax = fmaxf(amax, fmaxf(fmaxf(fabsf(x[c * 4 + q][0]), fabsf(x[c * 4 + q][1])), fmaxf(fabsf(x[c * 4 + q][2]), fabsf(x[c * 4 + q][3])))); }
#pragma unroll
            for (int o = 32; o >= 1; o >>= 1) amax = fmaxf(amax, __shfl_xor(amax, o));
            const float sc = amax > 0.f ? 224.0f / amax : 1.0f, inv = amax > 0.f ? amax * (1.0f / 224.0f) : 1.0f;
            unsigned char* dst = C.ws + (tb ? WS_V8 : WS_U8) + (size_t)(lane >> 3) * ((size_t)NEXP * 128) + (size_t)row * 128 + (lane & 7) * 16;
#pragma unroll
            for (int c = 0; c < 2; ++c) { u32x4 w;
#pragma unroll
                for (int q = 0; q < 4; ++q) { const f32x4 v = x[c * 4 + q] * sc; int p = __builtin_amdgcn_cvt_pk_fp8_f32(v[0], v[1], 0, false); p = __builtin_amdgcn_cvt_pk_fp8_f32(v[2], v[3], p, true); w[q] = (unsigned)p; }
                *(u32x4*)(dst + (size_t)c * 8 * ((size_t)NEXP * 128)) = w; }
            if (lane == 0) WSP(float, tb ? WS_SCV : WS_SCU)[row] = inv;
        }
    }
}

template <bool FIRST> __device__ __forceinline__ void phase_norm_mod(const Ctx& C, const float* gvec, const float* modl  , int shift_off, int scale_off) {
    float* xs = WSP(float, WS_XS); bf16_t* hb = WSP(bf16_t, WS_HB);
    for (int r = C.bid * 8 + C.wid; r < TT; r += C.G * 8) {
        const float* xr = FIRST ? src_row(C, r) : xs + (size_t)r * DM;
        const float* mv = modl + (size_t)mod_sel(r) * 12288;
        f32x4 v[8]; float ss = 0.f;
#pragma unroll
        for (int c = 0; c < 4; ++c) { v[2 * c] = *(const f32x4*)(xr + c * 512 + C.lane * 8); v[2 * c + 1] = *(const f32x4*)(xr + c * 512 + C.lane * 8 + 4); }
#pragma unroll
        for (int c = 0; c < 8; ++c) ss += v[c][0] * v[c][0] + v[c][1] * v[c][1] + v[c][2] * v[c][2] + v[c][3] * v[c][3];
        ss = wave_sum(ss);
        const float rs = rsqrtf(ss * (1.0f / DM) + NORM_EPS);
#pragma unroll
        for (int c = 0; c < 4; ++c) { const int col = c * 512 + C.lane * 8;
            if (FIRST) { *(f32x4*)(xs + (size_t)r * DM + col) = v[2 * c]; *(f32x4*)(xs + (size_t)r * DM + col + 4) = v[2 * c + 1]; }
            float o[8];
#pragma unroll
            for (int h = 0; h < 2; ++h) { const f32x4 g = *(const f32x4*)(gvec + col + 4 * h), s = *(const f32x4*)(mv + scale_off + col + 4 * h), t = *(const f32x4*)(mv + shift_off + col + 4 * h);
#pragma unroll
                for (int j = 0; j < 4; ++j) o[4 * h + j] = v[2 * c + h][j] * rs * g[j] * (1.0f + s[j]) + t[j]; }
            u32x4 w; w.x = cvt_pk_bf16(o[0], o[1]); w.y = cvt_pk_bf16(o[2], o[3]); w.z = cvt_pk_bf16(o[4], o[5]); w.w = cvt_pk_bf16(o[6], o[7]);
            *(u32x4*)(hb + (size_t)r * DM + col) = w; }
    }
}

__device__ __forceinline__ void phase_post_p(const Ctx& C, int l) {
    bf16_t* P = WSP(bf16_t, WS_P); const float* ta = WSP(float, WS_TABA); const float* tm = WSP(float, WS_TABM);
    const float* qg = INP(I_QNG) + l * 128; const float* kg = INP(I_KNG) + l * 128;
    const float* mqg = INP(I_MQNG) + l * 512; const float* mkvg = INP(I_MKVNG) + l * 512;
    const int lane = C.lane;
    const float qg1 = qg[lane], qg2 = qg[lane + 64], kg1 = kg[lane], kg2 = kg[lane + 64];
    for (int r = C.bid * 8 + C.wid; r < TT; r += C.G * 8) {
        bf16_t* pr = P + (size_t)r * NP;
        const int j = r % RPB; const bool lat = j >= CTXL; const int pos = lat ? j - CTXL : 0, ri = pos >> 6, ci = pos & 63;
        float cs = 1.f, sn = 0.f;
        if (lat) { const int p = lane < 32 ? ri : ci, f = lane & 31; cs = ta[p * 32 + f]; sn = ta[128 * 32 + p * 32 + f]; }
#pragma unroll
        for (int h = 0; h < 10; ++h) {
            bf16_t* hp = pr + (h < 8 ? C_AQ + h * 128 : C_AK + (h - 8) * 128);
            const float x1 = bf2f(hp[lane]), x2 = bf2f(hp[lane + 64]);
            const float ss = wave_sum(x1 * x1 + x2 * x2);
            const float rs = rsqrtf(ss * (1.0f / 128.0f) + NORM_EPS);
            const float y1 = x1 * rs * (h < 8 ? qg1 : kg1), y2 = x2 * rs * (h < 8 ? qg2 : kg2);
            hp[lane] = f2bf(y1 * cs - y2 * sn); hp[lane + 64] = f2bf(y2 * cs + y1 * sn);
        }
#pragma unroll
        for (int s = 0; s < 2; ++s) {
            bf16_t* sp = pr + (s == 0 ? C_MCQ : C_MCKV) + lane * 8; const float* gg = (s == 0 ? mqg : mkvg) + lane * 8;
            const u32x4 w = *(const u32x4*)sp; float x[8] = {bflo(w.x), bfhi(w.x), bflo(w.y), bfhi(w.y), bflo(w.z), bfhi(w.z), bflo(w.w), bfhi(w.w)};
            float ss = 0.f;
#pragma unroll
            for (int i = 0; i < 8; ++i) ss += x[i] * x[i];
            ss = wave_sum(ss);
            const float rs = rsqrtf(ss * (1.0f / 512.0f) + NORM_EPS);
#pragma unroll
            for (int i = 0; i < 8; ++i) x[i] = x[i] * rs * gg[i];
            u32x4 o; o.x = cvt_pk_bf16(x[0], x[1]); o.y = cvt_pk_bf16(x[2], x[3]); o.z = cvt_pk_bf16(x[4], x[5]); o.w = cvt_pk_bf16(x[6], x[7]);
            *(u32x4*)sp = o;
        }
        if (lat) { bf16_t* kp = pr + C_MKR; const int i = lane & 31; const float x1 = bf2f(kp[i]), x2 = bf2f(kp[i + 32]);
            const int p = i < 16 ? ri : ci, f = i & 15; const float c2 = tm[p * 16 + f], s2 = tm[128 * 16 + p * 16 + f];
            if (lane < 32) { kp[i] = f2bf(x1 * c2 - x2 * s2); kp[i + 32] = f2bf(x2 * c2 + x1 * s2); } }
    }
}

namespace att {
constexpr int NW = 8, QBLK = 32, KVBLK = 64, DV = 128;
constexpr float THR = 8.f;
#define SBAR() __builtin_amdgcn_sched_barrier(0)
__device__ __forceinline__ int crow(int r, int hi) { return (r & 3) + 8 * (r >> 2) + 4 * hi; }
template <int DQ> struct Cf {
    static constexpr int ND0 = DQ / 16, KROWB = DQ * 2, SHM_K = KVBLK * DQ * 2, SHM_V = KVBLK * DV * 2, SHM = 2 * SHM_V + 2 * SHM_K + NW * 64 * 4;
    static constexpr float SCALE = DQ == 128 ? 0.088388347648318440f : 0.072168783648703220f;
    __device__ static __forceinline__ int kswz(int row, int colB) { return row * KROWB + (colB ^ ((row & 7) << 4)); }
};
template <int DQ> __device__ __forceinline__ void partialSM(f32x16& p0, f32x16& p1, float& m_reg, float& mn, float& alpha) {
    constexpr float SC = Cf<DQ>::SCALE, Cc = SC * 1.4426950408889634f;
    float pmax = p0[0];
#pragma unroll
    for (int r = 1; r < 16; ++r) pmax = fmaxf(pmax, p0[r]);
#pragma unroll
    for (int r = 0; r < 16; ++r) pmax = fmaxf(pmax, p1[r]);
    { auto rr = __builtin_amdgcn_permlane32_swap(__float_as_uint(pmax), __float_as_uint(pmax), false, false);
      pmax = fmaxf(__uint_as_float(rr[0]), __uint_as_float(rr[1])); }
    if (__builtin_expect(__all(pmax - m_reg <= THR / SC), 1)) { mn = m_reg; alpha = 1.f; }
    else { mn = fmaxf(m_reg, pmax); alpha = __builtin_amdgcn_exp2f((m_reg - mn) * Cc); m_reg = mn; }
    const float mnC = -mn * Cc;
#pragma unroll
    for (int r = 0; r < 16; ++r) p0[r] = fmaf(p0[r], Cc, mnC);
#pragma unroll
    for (int r = 0; r < 16; ++r) p1[r] = fmaf(p1[r], Cc, mnC);
#pragma unroll
    for (int r = 0; r < 16; ++r) p0[r] = __builtin_amdgcn_exp2f(p0[r]);
}
__device__ __forceinline__ void finishSM(f32x16& p0, f32x16& p1, float alpha, float& l_reg, bf16x8& pa0, bf16x8& pa1, bf16x8& pa2, bf16x8& pa3) {
#pragma unroll
    for (int r = 0; r < 16; ++r) p1[r] = __builtin_amdgcn_exp2f(p1[r]);
    float ps = 0;
#pragma unroll
    for (int r = 0; r < 16; ++r) ps += p0[r];
#pragma unroll
    for (int r = 0; r < 16; ++r) ps += p1[r];
    { auto rr = __builtin_amdgcn_permlane32_swap(__float_as_uint(ps), __float_as_uint(ps), false, false);
      ps = __uint_as_float(rr[0]) + __uint_as_float(rr[1]); }
    l_reg = l_reg * alpha + ps;
#define PK4(P, BASE, OUT) do { unsigned a0 = cvt_pk_bf16(P[BASE + 0], P[BASE + 1]), a1 = cvt_pk_bf16(P[BASE + 2], P[BASE + 3]);   \
    unsigned b0 = cvt_pk_bf16(P[BASE + 4], P[BASE + 5]), b1 = cvt_pk_bf16(P[BASE + 6], P[BASE + 7]);                              \
    auto r0 = __builtin_amdgcn_permlane32_swap(a0, b0, false, false); auto r1 = __builtin_amdgcn_permlane32_swap(a1, b1, false, false); \
    u32x4 w = {r0[0], r1[0], r0[1], r1[1]}; OUT = *reinterpret_cast<bf16x8*>(&w); } while (0)
    PK4(p0, 0, pa0); PK4(p0, 8, pa1); PK4(p1, 0, pa2); PK4(p1, 8, pa3);
#undef PK4
}
template <int DQ> __device__ __forceinline__ void qkt(f32x16& p0, f32x16& p1, const char* Ks, const bf16x8* qr, const char* qx, int r32, int hi) {
    p0 = f32x16{}; p1 = f32x16{};
#pragma unroll
    for (int d0 = 0; d0 < Cf<DQ>::ND0; ++d0) { const int cb = (d0 * 16 + hi * 8) * 2;
        const bf16x8 b0 = *reinterpret_cast<const bf16x8*>(Ks + Cf<DQ>::kswz(r32, cb));
        const bf16x8 b1 = *reinterpret_cast<const bf16x8*>(Ks + Cf<DQ>::kswz(32 + r32, cb));
        constexpr int NQR = DQ == 192 ? 4 : 8;
        bf16x8 q; if (d0 < NQR) q = qr[d0]; else q = *reinterpret_cast<const bf16x8*>(qx + (d0 - NQR) * 1024);
        p0 = __builtin_amdgcn_mfma_f32_32x32x16_bf16(b0, q, p0, 0, 0, 0);
        p1 = __builtin_amdgcn_mfma_f32_32x32x16_bf16(b1, q, p1, 0, 0, 0); }
}
__device__ __forceinline__ int v_st(int k, int c) { const int kk = (k & ~0xC) | ((k & 4) << 1) | ((k & 8) >> 1); return ((kk >> 3) * 4 + (c >> 5)) * 512 + ((kk & 7) * 32 + (c & 31)) * 2; }
__device__ __forceinline__ int v_rd_base(int lane) { return ((lane & 3) << 3) | (((lane >> 2) & 3) << 6) | (((lane >> 4) & 1) << 5) | (((lane >> 5) & 1) << 8); }
constexpr int v_rd_off(int d0, int ks, int half) { return d0 * 512 + ks * 4096 + half * 2048; }
template <int OFF> __device__ __forceinline__ s16x4 tr_read(int vb) {
    s16x4 r; asm volatile("ds_read_b64_tr_b16 %0, %1 offset:%2" : "=&v"(r) : "v"(vb), "i"(OFF) : "memory"); return r;
}
template <int D0> __device__ __forceinline__ void pv_one(f32x16& od, int vb, bf16x8 pa0, bf16x8 pa1, bf16x8 pa2, bf16x8 pa3) {
    const s16x4 l0 = tr_read<v_rd_off(D0, 0, 0)>(vb), h0 = tr_read<v_rd_off(D0, 0, 1)>(vb), l1 = tr_read<v_rd_off(D0, 1, 0)>(vb), h1 = tr_read<v_rd_off(D0, 1, 1)>(vb);
    const s16x4 l2 = tr_read<v_rd_off(D0, 2, 0)>(vb), h2 = tr_read<v_rd_off(D0, 2, 1)>(vb), l3 = tr_read<v_rd_off(D0, 3, 0)>(vb), h3 = tr_read<v_rd_off(D0, 3, 1)>(vb);
    asm volatile("s_waitcnt lgkmcnt(0)" ::: "memory"); SBAR();
#define PK(L, H) (bf16x8){L[0], L[1], L[2], L[3], H[0], H[1], H[2], H[3]}
    od = __builtin_amdgcn_mfma_f32_32x32x16_bf16(pa0, PK(l0, h0), od, 0, 0, 0);
    od = __builtin_amdgcn_mfma_f32_32x32x16_bf16(pa1, PK(l1, h1), od, 0, 0, 0);
    od = __builtin_amdgcn_mfma_f32_32x32x16_bf16(pa2, PK(l2, h2), od, 0, 0, 0);
    od = __builtin_amdgcn_mfma_f32_32x32x16_bf16(pa3, PK(l3, h3), od, 0, 0, 0);
#undef PK
}
__device__ __forceinline__ void pv_d0(f32x16* o, int vb, bf16x8 pa0, bf16x8 pa1, bf16x8 pa2, bf16x8 pa3) {
    pv_one<0>(o[0], vb, pa0, pa1, pa2, pa3); pv_one<1>(o[1], vb, pa0, pa1, pa2, pa3); pv_one<2>(o[2], vb, pa0, pa1, pa2, pa3); pv_one<3>(o[3], vb, pa0, pa1, pa2, pa3);
}
__device__ __forceinline__ bf16x8 ld8(const bf16_t* p) { return *reinterpret_cast<const bf16x8*>(p); }

template <int DQ, int SD>
__device__ __forceinline__ void attn_body(const bf16_t* __restrict__ Qb, int ldq, const bf16_t* __restrict__ Kn, int ldkn, const bf16_t* __restrict__ Kr, int ldkr,
                                          const bf16_t* __restrict__ Vh, int ldv, bf16_t* __restrict__ Ob, int ldo, int seq, bool rope_q, int pos0, const float* __restrict__ tabM, char* lds, const int tid) {
    using CF = Cf<DQ>; constexpr int ND0 = CF::ND0, SHM_V = CF::SHM_V, SHM_K = CF::SHM_K;
    const int wid = tid >> 6, lane = tid & 63, r32 = lane & 31, hi = lane >> 5;
    char* V_lds = lds; char* K_lds = lds + 2 * SHM_V;
    float* ws = (float*)(lds + 2 * SHM_V + 2 * SHM_K) + wid * 64; float* li_l = ws; float* al_l = ws + 32;
    constexpr int NQR = DQ == 192 ? 4 : 8;
    float m_reg = -1e30f, l_reg = 0; f32x16 o[4] = {}; bf16x8 qr[NQR];
    const bf16_t* Qw = Qb + (long)(wid * QBLK + r32) * ldq + hi * 8;
#pragma unroll
    for (int d0 = 0; d0 < NQR; ++d0) qr[d0] = ld8(Qw + d0 * 16);
    char* qx = lds + CF::SHM + wid * 8192 + lane * 16;
    if constexpr (DQ == 192) {
#pragma unroll
        for (int d0 = 4; d0 < 8; ++d0) *(bf16x8*)(qx + (d0 - 4) * 1024) = ld8(Qw + d0 * 16);
        bf16x8 qe[4];
#pragma unroll
        for (int d0 = 0; d0 < 4; ++d0) qe[d0] = ld8(Qw + (8 + d0) * 16);
        if (rope_q) {
            const int pos = pos0 + wid * QBLK + r32, ri = pos >> 6, ci = pos & 63;
#pragma unroll
            for (int t = 0; t < 2; ++t) { const int p = t == 0 ? ri : ci; const float* tc = tabM + p * 16 + hi * 8; const float* tsn = tabM + 128 * 16 + p * 16 + hi * 8;
                bf16x8 a = qe[t], b = qe[2 + t];
#pragma unroll
                for (int jj = 0; jj < 8; ++jj) { const float x1 = bf2f((bf16_t)a[jj]), x2 = bf2f((bf16_t)b[jj]), c = tc[jj], s = tsn[jj];
                    a[jj] = (short)f2bf(x1 * c - x2 * s); b[jj] = (short)f2bf(x2 * c + x1 * s); }
                qe[t] = a; qe[2 + t] = b; }
        }
#pragma unroll
        for (int d0 = 0; d0 < 4; ++d0) *(bf16x8*)(qx + (4 + d0) * 1024) = qe[d0];
    }
    const int sr = tid >> 4, sc = (tid & 15) * 8, vst0 = v_st(sr, sc), vst1 = v_st(32 + sr, sc);
    const int sr2 = tid >> 3, sc2 = (tid & 7) * 8;
    const int vb0 = (int)(uintptr_t)V_lds + v_rd_base(lane);
    struct { bf16x8 vs0, vs1, ks0, ks1, ks2; } sr_[SD];
    const unsigned offV = (unsigned)(sr * ldv + sc) * 2u, offK = (unsigned)(sr * ldkn + sc) * 2u, offR = (unsigned)(sr2 * ldkr + sc2) * 2u;
#define SLOAD(i, k0) do { const char* vt_ = (const char*)Vh + (size_t)(k0) * ldv * 2; const char* kt_ = (const char*)Kn + (size_t)(k0) * ldkn * 2; \
    sr_[i].vs0 = *(const bf16x8*)(vt_ + offV); sr_[i].vs1 = *(const bf16x8*)(vt_ + (size_t)32 * ldv * 2 + offV); \
    sr_[i].ks0 = *(const bf16x8*)(kt_ + offK); sr_[i].ks1 = *(const bf16x8*)(kt_ + (size_t)32 * ldkn * 2 + offK); \
    if constexpr (DQ == 192) sr_[i].ks2 = *(const bf16x8*)((const char*)Kr + (size_t)(k0) * ldkr * 2 + offR); } while (0)
#define SWRITE(b, i) do { *(bf16x8*)(V_lds + (b) * SHM_V + vst0) = sr_[i].vs0; *(bf16x8*)(V_lds + (b) * SHM_V + vst1) = sr_[i].vs1; const int kc = sc * 2; \
    *(bf16x8*)(K_lds + (b) * SHM_K + CF::kswz(sr, kc)) = sr_[i].ks0; *(bf16x8*)(K_lds + (b) * SHM_K + CF::kswz(32 + sr, kc)) = sr_[i].ks1; \
    if constexpr (DQ == 192) *(bf16x8*)(K_lds + (b) * SHM_K + CF::kswz(sr2, 256 + sc2 * 2)) = sr_[i].ks2; } while (0)
#define SWAIT() do { if constexpr (SD == 1) asm volatile("s_waitcnt vmcnt(0)" ::: "memory"); else if constexpr (DQ == 192) asm volatile("s_waitcnt vmcnt(5)" ::: "memory"); else asm volatile("s_waitcnt vmcnt(4)" ::: "memory"); } while (0)
#define RESC(a) do { if (__any((a) < 1.f)) { if (hi == 0) al_l[r32] = (a); asm volatile("s_waitcnt lgkmcnt(0)" ::: "memory"); \
    _Pragma("unroll") for (int d = 0; d < 4; ++d) _Pragma("unroll") for (int r = 0; r < 16; ++r) o[d][r] *= al_l[crow(r, hi)]; } } while (0)
    f32x16 pA0, pA1, pB0, pB1; float mnA, mnB, alA, alB; bf16x8 pa0, pa1, pa2, pa3; const int NT = seq / KVBLK;
    constexpr int SE = 0, SO = SD - 1;
    SLOAD(SE, 0); asm volatile("s_waitcnt vmcnt(0)" ::: "memory"); SWRITE(0, SE); __syncthreads();
    qkt<DQ>(pA0, pA1, K_lds, qr, qx, r32, hi); partialSM<DQ>(pA0, pA1, m_reg, mnA, alA);
    SLOAD(SO, KVBLK); if constexpr (SD == 2) { if (2 < NT) SLOAD(SE, 2 * KVBLK); }
    SWAIT(); SWRITE(1, SO); __syncthreads();
    for (int j = 1; j + 1 < NT; j += 2) {
        SBAR(); qkt<DQ>(pB0, pB1, K_lds + SHM_K, qr, qx, r32, hi);
        finishSM(pA0, pA1, alA, l_reg, pa0, pa1, pa2, pa3); SBAR();
        SLOAD(SO, (j + SD) * KVBLK); SBAR();
        pv_d0(o, vb0, pa0, pa1, pa2, pa3); partialSM<DQ>(pB0, pB1, m_reg, mnB, alB);
        __syncthreads(); SWAIT(); SWRITE(0, SE);
        RESC(alB); __syncthreads();
        SBAR(); qkt<DQ>(pA0, pA1, K_lds, qr, qx, r32, hi);
        finishSM(pB0, pB1, alB, l_reg, pa0, pa1, pa2, pa3); SBAR();
        if (SD == 1 || j + 3 < NT) SLOAD(SE, (j + 1 + SD) * KVBLK); SBAR();
        pv_d0(o, vb0 + SHM_V, pa0, pa1, pa2, pa3); partialSM<DQ>(pA0, pA1, m_reg, mnA, alA);
        __syncthreads(); SWAIT(); SWRITE(1, SO);
        RESC(alA); __syncthreads();
    }
    SBAR(); qkt<DQ>(pB0, pB1, K_lds + SHM_K, qr, qx, r32, hi);
    finishSM(pA0, pA1, alA, l_reg, pa0, pa1, pa2, pa3); SBAR();
    pv_d0(o, vb0, pa0, pa1, pa2, pa3); partialSM<DQ>(pB0, pB1, m_reg, mnB, alB);
    __syncthreads(); RESC(alB);
    finishSM(pB0, pB1, alB, l_reg, pa0, pa1, pa2, pa3); SBAR();
    pv_d0(o, vb0 + SHM_V, pa0, pa1, pa2, pa3);
    if (hi == 0) li_l[r32] = l_reg; asm volatile("s_waitcnt lgkmcnt(0)" ::: "memory");
    float rli[16];
#pragma unroll
    for (int r = 0; r < 16; ++r) rli[r] = __builtin_amdgcn_rcpf(li_l[crow(r, hi)]);
    bf16_t* Ow = Ob + (long)(wid * QBLK) * ldo;
#pragma unroll
    for (int r = 0; r < 16; ++r) { const int orow = crow(r, hi);
#pragma unroll
        for (int d0 = 0; d0 < 4; ++d0) Ow[(long)orow * ldo + d0 * 32 + r32] = f2bf(o[d0][r] * rli[r]); }
#undef SLOAD
#undef SWRITE
#undef SWAIT
#undef RESC
}
}

template <int KS> __device__ __forceinline__ void mma_xy(f32x16& acc, const LAS bf16_t* X, const LAS bf16_t* Y, int hi) {
#pragma unroll
    for (int ks = 0; ks < KS; ++ks) { const bf16x8 a = *(const LAS bf16x8*)(X + ks * 16 + hi * 8), b = *(const LAS bf16x8*)(Y + ks * 16 + hi * 8);
        acc = __builtin_amdgcn_mfma_f32_32x32x16_bf16(a, b, acc, 0, 0, 0); }
}
__device__ __forceinline__ float logsig16(float x) { const float e = __expf(-fabsf(x)); return (fminf(x, 0.f) - __logf(1.f + e)) * 0.0625f; }
__device__ __forceinline__ int gla_sidx(int b, int dir, int h) { return (b * 2 + dir) * 4 + h; }

__device__ __forceinline__ void gla_cumsum_lds(const Ctx& C, int l, int h, int dir, const LAS float* lr, LAS float* segtot, LAS float* CUM) {
    const int seg = C.tid >> 7, d = C.tid & 127;
    const float* wa = INP(dir ? I_WA2B : I_WA2F) + (size_t)l * 16 * 512 + h * 128 + d;
    const float bias = INP(dir ? I_BAB : I_BAF)[l * 512 + h * 128 + d];
    float w[16], cum[16];
#pragma unroll
    for (int j = 0; j < 16; ++j) w[j] = wa[j * 512];
    float run = 0.f;
#pragma unroll
    for (int i = 0; i < 16; ++i) { const int s = seg * 16 + i, tk = dir ? 63 - s : s; float pre = bias;
#pragma unroll
        for (int j = 0; j < 16; ++j) pre += lr[tk * 32 + dir * 16 + j] * w[j];
        run += logsig16(pre); cum[i] = run; }
    segtot[seg * 128 + d] = run;
    __syncthreads();
    float off = 0.f;
#pragma unroll
    for (int q = 0; q < 3; ++q) if (q < seg) off += segtot[q * 128 + d];
#pragma unroll
    for (int i = 0; i < 16; ++i) { const int s = seg * 16 + i, tk = dir ? 63 - s : s; CUM[tk * 132 + d] = cum[i] + off; }
    __syncthreads();
}
__device__ __forceinline__ void unpack8(const u32x4 w, float (&x)[8]) { x[0] = bflo(w.x); x[1] = bfhi(w.x); x[2] = bflo(w.y); x[3] = bfhi(w.y); x[4] = bflo(w.z); x[5] = bfhi(w.z); x[6] = bflo(w.w); x[7] = bfhi(w.w); }
__device__ __forceinline__ void gla_build_vt(const Ctx& C, const bf16_t* P, size_t r0, int h, LAS bf16_t* VT) {
    u32x4 v[4];
#pragma unroll
    for (int it = 0; it < 4; ++it) { const int idx = C.tid + it * NTHREADS, sv = idx >> 5, e0 = (idx & 31) * 8; v[it] = *(const u32x4*)(P + (r0 + sv) * NP + C_LV + h * 256 + e0); }
#pragma unroll
    for (int it = 0; it < 4; ++it) { const int idx = C.tid + it * NTHREADS, sv = idx >> 5, e0 = (idx & 31) * 8;
        const unsigned wd[4] = {v[it].x, v[it].y, v[it].z, v[it].w};
#pragma unroll
        for (int q = 0; q < 4; ++q) { VT[(e0 + 2 * q) * 72 + sv] = (bf16_t)(wd[q] & 0xffffu); VT[(e0 + 2 * q + 1) * 72 + sv] = (bf16_t)(wd[q] >> 16); } }
}

__device__ __forceinline__ void phase_gla_local(const Ctx& C, int l) {
    const bf16_t* P = WSP(bf16_t, WS_P); bf16_t* GST = WSP(bf16_t, WS_GST); float* GDEC = WSP(float, WS_GDEC);
    LAS float* lr = (LAS float*)C.lds;
    LAS float* segtot = (LAS float*)(C.lds + 8192);
    LAS bf16_t* KT = (LAS bf16_t*)(C.lds + 10240);
    LAS bf16_t* VT = (LAS bf16_t*)(C.lds + 28672);
    LAS float* CUM = (LAS float*)(C.lds + 65536);
    const int r32 = C.lane & 31, hi = C.lane >> 5, d = C.tid & 127;
    const int btk = C.tid >> 3, bdg = (C.tid & 7) * 16;
    for (int unit = C.bid; unit < NBATCH * 4 * NCH; unit += C.G) {
        const int b = unit / (4 * NCH), h = (unit / NCH) % 4, ck = unit % NCH; const size_t r0 = (size_t)b * RPB + ck * 64;
        for (int i = C.tid; i < 64 * 32; i += NTHREADS) lr[i] = bf2f(P[(r0 + (i >> 5)) * NP + C_LRF + (i & 31)]);
        const u32x4 kw0 = *(const u32x4*)(P + (r0 + btk) * NP + C_LK + h * 128 + bdg), kw1 = *(const u32x4*)(P + (r0 + btk) * NP + C_LK + h * 128 + bdg + 8);
        gla_build_vt(C, P, r0, h, VT);
        __syncthreads();
#pragma unroll 1
        for (int dir = 0; dir < 2; ++dir) {
            gla_cumsum_lds(C, l, h, dir, lr, segtot, CUM);
            const int tend = dir ? 0 : 63;
            const size_t sx = (size_t)gla_sidx(b, dir, h) * NCH + ck;
            if (C.tid < 128) GDEC[sx * 128 + d] = __expf(CUM[tend * 132 + d]);
            { float kf[16]; { float t8[8]; unpack8(kw0, t8);
#pragma unroll
                for (int i = 0; i < 8; ++i) kf[i] = t8[i]; unpack8(kw1, t8);
#pragma unroll
                for (int i = 0; i < 8; ++i) kf[8 + i] = t8[i]; }
#pragma unroll
              for (int q = 0; q < 4; ++q) { const f32x4 cm = *(const LAS f32x4*)(CUM + btk * 132 + bdg + 4 * q), be = *(const LAS f32x4*)(CUM + tend * 132 + bdg + 4 * q);
#pragma unroll
                  for (int i = 0; i < 4; ++i) KT[(bdg + 4 * q + i) * 72 + btk] = f2bf(kf[4 * q + i] * __expf(be[i] - cm[i])); } }
            __syncthreads();
            { const int dt = C.wid & 3, eb = (C.wid >> 2) * 4;
              f32x16 acc[4] = {};
#pragma unroll
              for (int q = 0; q < 4; ++q) mma_xy<4>(acc[q], KT + (dt * 32 + r32) * 72, VT + ((eb + q) * 32 + r32) * 72, hi);
              bf16_t* st = GST + sx * 32768;
#pragma unroll
              for (int q = 0; q < 4; ++q)
#pragma unroll
                  for (int g = 0; g < 4; ++g) { u32x2 w; w.x = cvt_pk_bf16(acc[q][4 * g], acc[q][4 * g + 1]); w.y = cvt_pk_bf16(acc[q][4 * g + 2], acc[q][4 * g + 3]);
                      *(u32x2*)(st + (size_t)((eb + q) * 32 + r32) * 128 + dt * 32 + 8 * g + 4 * hi) = w; } }
            __syncthreads();
        }
    }
}

__device__ __forceinline__ void phase_gla_scan(const Ctx& C) {
    bf16_t* GST = WSP(bf16_t, WS_GST); const float* GDEC = WSP(float, WS_GDEC);
    for (int gid = C.bid * NTHREADS + C.tid; gid < 16 * 8192; gid += C.G * NTHREADS) {
        const int sidx = gid >> 13, g = gid & 8191, dir = (sidx >> 2) & 1, d4 = (g & 31) * 4;
        bf16_t* base = GST + (size_t)sidx * NCH * 32768 + (size_t)g * 4;
        const float* dbase = GDEC + (size_t)sidx * NCH * 128 + d4;
        float S[4] = {0.f, 0.f, 0.f, 0.f};
        for (int st = 0; st < NCH; st += 4) {
            int ck[4]; u32x2 L[4]; f32x4 dc[4];
#pragma unroll
            for (int q = 0; q < 4; ++q) { const int s = st + q; ck[q] = dir ? (s < 4 ? 3 - s : NCH + 3 - s) : s;
                L[q] = *(const u32x2*)(base + (size_t)ck[q] * 32768); dc[q] = *(const f32x4*)(dbase + (size_t)ck[q] * 128); }
#pragma unroll
            for (int q = 0; q < 4; ++q) { u32x2 w; w.x = cvt_pk_bf16(S[0], S[1]); w.y = cvt_pk_bf16(S[2], S[3]);
                *(u32x2*)(base + (size_t)ck[q] * 32768) = w;
                S[0] = dc[q][0] * S[0] + bflo(L[q].x); S[1] = dc[q][1] * S[1] + bfhi(L[q].x); S[2] = dc[q][2] * S[2] + bflo(L[q].y); S[3] = dc[q][3] * S[3] + bfhi(L[q].y); }
        }
    }
}

__device__ __forceinline__ void phase_gla_out(const Ctx& C, int l) {
    const bf16_t* P = WSP(bf16_t, WS_P); const bf16_t* GST = WSP(bf16_t, WS_GST); bf16_t* OL = WSP(bf16_t, WS_OL);
    LAS float* lr = (LAS float*)C.lds;
    LAS float* segtot = (LAS float*)(C.lds + 8192);
    LAS bf16_t* QT = (LAS bf16_t*)(C.lds + 10240);
    LAS bf16_t* KT = (LAS bf16_t*)(C.lds + 27648);
    LAS bf16_t* VT = (LAS bf16_t*)(C.lds + 45056);
    LAS bf16_t* SCm = (LAS bf16_t*)(C.lds + 81920);
    LAS float* OB = (LAS float*)(C.lds + 91136);
    LAS float* CUM = OB;
    const float* gon = INP(I_ONG) + l * 256;
    const int r32 = C.lane & 31, hi = C.lane >> 5;
    const int btk = C.tid >> 3, bdg = (C.tid & 7) * 16;
    for (int unit = C.bid; unit < NBATCH * 4 * NCH; unit += C.G) {
        const int b = unit / (4 * NCH), h = (unit / NCH) % 4, ck = unit % NCH; const size_t r0 = (size_t)b * RPB + ck * 64;
        for (int i = C.tid; i < 64 * 32; i += NTHREADS) lr[i] = bf2f(P[(r0 + (i >> 5)) * NP + C_LRF + (i & 31)]);
        const bf16_t* qp = P + (r0 + btk) * NP + C_LQ + h * 128 + bdg; const bf16_t* kp = P + (r0 + btk) * NP + C_LK + h * 128 + bdg;
        const u32x4 qw0 = *(const u32x4*)qp, qw1 = *(const u32x4*)(qp + 8), kw0 = *(const u32x4*)kp, kw1 = *(const u32x4*)(kp + 8);
        gla_build_vt(C, P, r0, h, VT);
        __syncthreads();
        f32x16 oacc[2] = {};
#pragma unroll 1
        for (int dir = 0; dir < 2; ++dir) {
            gla_cumsum_lds(C, l, h, dir, lr, segtot, CUM);
            { float qf[8], kf[8];
#pragma unroll
              for (int hh = 0; hh < 2; ++hh) { unpack8(hh ? qw1 : qw0, qf); unpack8(hh ? kw1 : kw0, kf);
                  const f32x4 c0 = *(const LAS f32x4*)(CUM + btk * 132 + bdg + 8 * hh), c1 = *(const LAS f32x4*)(CUM + btk * 132 + bdg + 8 * hh + 4);
                  float qo[8], ko[8];
#pragma unroll
                  for (int i = 0; i < 8; ++i) { const float cm = i < 4 ? c0[i & 3] : c1[i & 3]; qo[i] = qf[i] * __expf(cm) * 0.088388347648318440f; ko[i] = kf[i] * __expf(-cm); }
                  u32x4 wq, wk; wq.x = cvt_pk_bf16(qo[0], qo[1]); wq.y = cvt_pk_bf16(qo[2], qo[3]); wq.z = cvt_pk_bf16(qo[4], qo[5]); wq.w = cvt_pk_bf16(qo[6], qo[7]);
                  wk.x = cvt_pk_bf16(ko[0], ko[1]); wk.y = cvt_pk_bf16(ko[2], ko[3]); wk.z = cvt_pk_bf16(ko[4], ko[5]); wk.w = cvt_pk_bf16(ko[6], ko[7]);
                  *(LAS u32x4*)(QT + btk * 136 + bdg + 8 * hh) = wq; *(LAS u32x4*)(KT + btk * 136 + bdg + 8 * hh) = wk; } }
            __syncthreads();
            if (C.wid < 4) { const int mt = C.wid >> 1, nt = C.wid & 1; f32x16 sc = {};
                mma_xy<8>(sc, QT + (mt * 32 + r32) * 136, KT + (nt * 32 + r32) * 136, hi);
#pragma unroll
                for (int i = 0; i < 16; ++i) { const int t = mt * 32 + att::crow(i, hi), sx_ = nt * 32 + r32; const bool keep = dir ? (sx_ >= t) : (sx_ <= t);
                    SCm[t * 72 + sx_] = f2bf(keep ? sc[i] : 0.f); } }
            __syncthreads();
            { const bf16_t* st = GST + ((size_t)gla_sidx(b, dir, h) * NCH + ck) * 32768 + (size_t)(C.wid * 32 + r32) * 128 + hi * 8;
              bf16x8 sb[8];
#pragma unroll
              for (int ks = 0; ks < 8; ++ks) sb[ks] = *(const bf16x8*)(st + ks * 16);
#pragma unroll
              for (int mt = 0; mt < 2; ++mt) {
                  mma_xy<4>(oacc[mt], SCm + (mt * 32 + r32) * 72, VT + (C.wid * 32 + r32) * 72, hi);
#pragma unroll
                  for (int ks = 0; ks < 8; ++ks) { const bf16x8 a = *(const LAS bf16x8*)(QT + (mt * 32 + r32) * 136 + ks * 16 + hi * 8);
                      oacc[mt] = __builtin_amdgcn_mfma_f32_32x32x16_bf16(a, sb[ks], oacc[mt], 0, 0, 0); } } }
            __syncthreads();
        }
#pragma unroll
        for (int mt = 0; mt < 2; ++mt)
#pragma unroll
            for (int i = 0; i < 16; ++i) OB[(mt * 32 + att::crow(i, hi)) * 260 + C.wid * 32 + r32] = oacc[mt][i];
        __syncthreads();
        { const int t = C.tid >> 3, part = C.tid & 7; f32x4 v[8]; float ss = 0.f;
#pragma unroll
          for (int jj = 0; jj < 8; ++jj) { v[jj] = *(const LAS f32x4*)(OB + t * 260 + jj * 32 + part * 4); ss += v[jj][0] * v[jj][0] + v[jj][1] * v[jj][1] + v[jj][2] * v[jj][2] + v[jj][3] * v[jj][3]; }
          ss += __shfl_xor(ss, 1); ss += __shfl_xor(ss, 2); ss += __shfl_xor(ss, 4);
          const float rs = rsqrtf(ss * (1.0f / 256.0f) + NORM_EPS);
#pragma unroll
          for (int jj = 0; jj < 8; ++jj) { const int e = jj * 32 + part * 4; const f32x4 g = *(const f32x4*)(gon + e);
              const u32x2 gt = *(const u32x2*)(P + (r0 + t) * NP + C_LG + h * 256 + e);
              const float o0 = v[jj][0] * rs * g[0] * siluf_(bflo(gt.x)), o1 = v[jj][1] * rs * g[1] * siluf_(bfhi(gt.x)), o2 = v[jj][2] * rs * g[2] * siluf_(bflo(gt.y)), o3 = v[jj][3] * rs * g[3] * siluf_(bfhi(gt.y));
              u32x2 w; w.x = cvt_pk_bf16(o0, o1); w.y = cvt_pk_bf16(o2, o3);
              *(u32x2*)(OL + (r0 + t) * 1024 + h * 256 + e) = w; } }
        __syncthreads();
    }
}

__device__ __forceinline__ unsigned f_ord(float f) { const unsigned u = __float_as_uint(f); return u ^ ((unsigned)((int)u >> 31) | 0x80000000u); }
__device__ __forceinline__ float f_unord(unsigned k) { return __uint_as_float((k & 0x80000000u) ? (k ^ 0x80000000u) : ~k); }
__device__ __forceinline__ void ins_u(unsigned (&L)[16], unsigned x) {
#pragma unroll
    for (int j = 0; j < 16; ++j) { const unsigned h = L[j] > x ? L[j] : x; x = L[j] > x ? x : L[j]; L[j] = h; }
}
__device__ __forceinline__ void ins_f(float (&M)[16], float x) {
#pragma unroll
    for (int j = 0; j < 16; ++j) { const float h = M[j] > x ? M[j] : x; x = M[j] > x ? x : M[j]; M[j] = h; }
}
__device__ __forceinline__ void peer_top16(const bf16_t* __restrict__ qrow, const bf16_t* __restrict__ keys, int r32, int hi, unsigned (&L)[16]) {
    bf16x8 qf[8];
#pragma unroll
    for (int kk = 0; kk < 8; ++kk) qf[kk] = *(const bf16x8*)(qrow + kk * 16 + hi * 8);
#pragma unroll
    for (int j = 0; j < 16; ++j) L[j] = 0u;
#pragma unroll 1
    for (int mt = 0; mt < 4; ++mt) {
        f32x16 acc = {};
#pragma unroll
        for (int kk = 0; kk < 8; ++kk) { const bf16x8 a = *(const bf16x8*)(keys + (size_t)(mt * 32 + r32) * 128 + kk * 16 + hi * 8);
            acc = __builtin_amdgcn_mfma_f32_32x32x16_bf16(a, qf[kk], acc, 0, 0, 0); }
#pragma unroll
        for (int i = 0; i < 16; ++i) { const unsigned kidx = (unsigned)(mt * 32 + att::crow(i, hi)); ins_u(L, (f_ord(acc[i]) & ~127u) | (127u - kidx)); }
    }
    unsigned Pn[16];
#pragma unroll
    for (int j = 0; j < 16; ++j) Pn[j] = (unsigned)__shfl_xor((int)L[j], 32);
#pragma unroll
    for (int j = 0; j < 16; ++j) ins_u(L, Pn[j]);
}
__device__ __forceinline__ void phase_peer_select(const Ctx& C, const bool latent_only) {
    const bf16_t* PQ = WSP(bf16_t, WS_PQ); const bf16_t* K1 = WSP(bf16_t, WS_K1); const bf16_t* K2 = WSP(bf16_t, WS_K2);
    int* PIDX = WSP(int, WS_PIDX); float* PG = WSP(float, WS_PG);
    const int r32 = C.lane & 31, hi = C.lane >> 5, head = C.wid;
    const int ngrp = latent_only ? NBATCH * SEQ / 32 : TT / 32;
    for (int gi = C.bid; gi < ngrp; gi += C.G) {
        const int grp = latent_only ? gi + (CTXL / 32) * (1 + gi / (SEQ / 32)) : gi;
        const size_t tok = (size_t)grp * 32 + r32;
        unsigned L1[16], L2[16];
        peer_top16(PQ + tok * DM + head * 256, K1 + (size_t)head * 128 * 128, r32, hi, L1);
        peer_top16(PQ + tok * DM + head * 256 + 128, K2 + (size_t)head * 128 * 128, r32, hi, L2);
        float v1[16], v2[16];
#pragma unroll
        for (int j = 0; j < 16; ++j) { v1[j] = f_unord(L1[j] & ~127u); v2[j] = f_unord(L2[j] & ~127u); }
        float M[16];
#pragma unroll
        for (int j = 0; j < 16; ++j) M[j] = -3.0e38f;
#pragma unroll
        for (int a = 0; a < 16; ++a)
#pragma unroll
            for (int b = 0; b < 16; ++b) if ((a + 1) * (b + 1) <= 16) ins_f(M, v1[a] + v2[b]);
        const float thr = M[15], mx = M[0]; float den = 0.f;
#pragma unroll
        for (int j = 0; j < 16; ++j) den += __expf(M[j] - mx);
        const float rden = 1.0f / den;
        int pos = 0; int* ip = PIDX + tok * 128 + head * 16; float* gp = PG + tok * 128 + head * 16;
#pragma unroll
        for (int a = 0; a < 16; ++a)
#pragma unroll
            for (int b = 0; b < 16; ++b) if ((a + 1) * (b + 1) <= 16) {
                const float val = v1[a] + v2[b];
                if (val >= thr && pos < 16) { if (hi == 0) { ip[pos] = (int)((127u - (L1[a] & 127u)) * 128u + (127u - (L2[b] & 127u))); gp[pos] = __expf(val - mx) * rden; } ++pos; } }
    }
}
template <int OFF> __device__ __forceinline__ float dotf8(const float (&h)[32], const u32x4 w, float acc) {
#pragma unroll
    for (int j = 0; j < 4; ++j) { const f32x2 lo = __builtin_amdgcn_cvt_pk_f32_fp8((int)w[j], false), hi = __builtin_amdgcn_cvt_pk_f32_fp8((int)w[j], true);
        acc += h[OFF + 4 * j] * lo.x; acc += h[OFF + 4 * j + 1] * lo.y; acc += h[OFF + 4 * j + 2] * hi.x; acc += h[OFF + 4 * j + 3] * hi.y; }
    return acc;
}
constexpr int GT_MAXTOK = 9;
template <bool LAST> __device__ __forceinline__ void phase_peer_gather(const Ctx& C, const float* modl, const float pscale) {
    const bf16_t* HB = WSP(bf16_t, WS_HB); const unsigned char* U8 = C.ws + WS_U8; const unsigned char* V8 = C.ws + WS_V8;
    const float* SCU = WSP(float, WS_SCU); const float* SCV = WSP(float, WS_SCV);
    const int* PIDX = WSP(int, WS_PIDX); const float* PG = WSP(float, WS_PG); float* XS = WSP(float, WS_XS);
    const int lane = C.lane, s = lane >> 3, j = lane & 7;
    LAS int* IDS = (LAS int*)(C.lds + C.wid * (GT_MAXTOK * 512));
    LAS float* ACT = (LAS float*)(C.lds + 8 * GT_MAXTOK * 512 + C.wid * (GT_MAXTOK * 512));
    LAS int* ROWS = (LAS int*)(C.lds + 16 * GT_MAXTOK * 512 + C.wid * 64);
    int nk = 0;
    {
      const int per = (TT + C.G - 1) / C.G, base = C.bid * per;
#pragma unroll 1
      for (int k = 0; k < GT_MAXTOK; ++k) { const int o = C.wid + 8 * k; const int r = base + o; if (o < per && r < TT && !(LAST && (r % RPB) < CTXL)) { if (lane == 0) ROWS[nk] = r; ++nk; } } }
#define GT_ROW(k) __builtin_amdgcn_readfirstlane(ROWS[k])
#pragma unroll 1
    for (int k = 0; k < nk; ++k) { const int r = GT_ROW(k);
        IDS[k * 128 + lane] = PIDX[(size_t)r * 128 + lane] & (NEXP - 1); IDS[k * 128 + 64 + lane] = PIDX[(size_t)r * 128 + 64 + lane] & (NEXP - 1);
        ACT[k * 128 + lane] = 0.f; ACT[k * 128 + 64 + lane] = 0.f; }
    const int nit = 32 * nk;
#define GT_ITEM(it_) const int cb_ = (it_) / (2 * nk), rem_ = (it_) - cb_ * (2 * nk), k_ = rem_ >> 1, hf_ = rem_ & 1
#define GT_LOADU(UQ, HQ, it_) do { GT_ITEM(it_); const int r_ = GT_ROW(k_); \
        const bf16_t* hp_ = HB + (size_t)r_ * DM + cb_ * 128 + j * 16; HQ[0] = *(const u32x4*)hp_; HQ[1] = *(const u32x4*)(hp_ + 8); \
        const unsigned char* ub_ = U8 + (size_t)cb_ * ((size_t)NEXP * 128) + j * 16; \
        _Pragma("unroll") for (int eg = 0; eg < 8; ++eg) { const int id_ = IDS[k_ * 128 + (hf_ * 8 + eg) * 8 + s] & idmask; UQ[eg] = *(const u32x4*)(ub_ + (size_t)id_ * 128); } } while (0)
#define GT_COMPU(UQ, HQ, it_) do { GT_ITEM(it_); (void)cb_; f32x2 hf2[8]; \
        _Pragma("unroll") for (int hh = 0; hh < 2; ++hh) { const u32x4 w_ = HQ[hh]; \
            hf2[hh * 4 + 0] = (f32x2){bflo(w_.x), bfhi(w_.x)}; hf2[hh * 4 + 1] = (f32x2){bflo(w_.y), bfhi(w_.y)}; hf2[hh * 4 + 2] = (f32x2){bflo(w_.z), bfhi(w_.z)}; hf2[hh * 4 + 3] = (f32x2){bflo(w_.w), bfhi(w_.w)}; } \
        float d[8]; \
        _Pragma("unroll") for (int eg = 0; eg < 8; ++eg) { f32x2 d2 = (f32x2){0.f, 0.f}; \
            _Pragma("unroll") for (int q = 0; q < 4; ++q) { const f32x2 lo = __builtin_amdgcn_cvt_pk_f32_fp8((int)UQ[eg][q], false), hi = __builtin_amdgcn_cvt_pk_f32_fp8((int)UQ[eg][q], true); \
                d2 += hf2[2 * q] * lo; d2 += hf2[2 * q + 1] * hi; } \
            d[eg] = d2.x + d2.y; } \
          \
        float t4[4], t2[2], t1; \
        _Pragma("unroll") for (int i = 0; i < 4; ++i) { const float snd = (j & 4) ? d[i] : d[i + 4], kp = (j & 4) ? d[i + 4] : d[i]; t4[i] = kp + __shfl_xor(snd, 4); } \
        _Pragma("unroll") for (int i = 0; i < 2; ++i) { const float snd = (j & 2) ? t4[i] : t4[i + 2], kp = (j & 2) ? t4[i + 2] : t4[i]; t2[i] = kp + __shfl_xor(snd, 2); } \
        { const float snd = (j & 1) ? t2[0] : t2[1], kp = (j & 1) ? t2[1] : t2[0]; t1 = kp + __shfl_xor(snd, 1); } \
        ACT[k_ * 128 + (hf_ * 8 + j) * 8 + s] += t1; } while (0)
#ifdef DBG_GDUP
#pragma unroll 1
    for (int rep_ = 0; rep_ < 2; ++rep_) {
    const int idmask = rep_ == 0 ? DBG_GMASK : (NEXP - 1);
    if (rep_ == 1) { for (int k = 0; k < nk; ++k) { ACT[k * 128 + lane] = 0.f; ACT[k * 128 + 64 + lane] = 0.f; } }
#else
    { const int idmask = NEXP - 1;
#endif
    if (nit > 0) {
        u32x4 uA[8], uB[8], hA[2], hB[2];
        GT_LOADU(uA, hA, 0);
#pragma unroll 1
        for (int it = 0; it < nit; it += 2) {
            GT_LOADU(uB, hB, it + 1);
            GT_COMPU(uA, hA, it);
            if (it + 2 < nit) GT_LOADU(uA, hA, it + 2);
            GT_COMPU(uB, hB, it + 1);
        }
    }
    }
#undef GT_LOADU
#undef GT_COMPU
#pragma unroll 1
    for (int k = 0; k < nk; ++k) { const int r = GT_ROW(k);
#pragma unroll
        for (int hh = 0; hh < 2; ++hh) { const int e = hh * 64 + lane; const int id = IDS[k * 128 + e]; const float a = ACT[k * 128 + e] * SCU[id];
            const float w = PG[(size_t)r * 128 + e] * 0.5f * a * (1.0f + erff(a * 0.70710678118654752f));
#ifdef DBG_CHECK
            if (((r - 300) & 63) == 0 && r >= 300 && r < 300 + 64 * 128) WSP(float, WS_OM)[(size_t)r * 128 + e] = w;
#endif
            ACT[k * 128 + e] = w * SCV[id]; } }
#define GT_LOADV(VQ, WV, it_) do { GT_ITEM(it_); const unsigned char* vb_ = V8 + (size_t)cb_ * ((size_t)NEXP * 128) + j * 16; \
        _Pragma("unroll") for (int eg = 0; eg < 8; ++eg) { const int e_ = k_ * 128 + (hf_ * 8 + eg) * 8 + s; const int id_ = IDS[e_]; VQ[eg] = *(const u32x4*)(vb_ + (size_t)id_ * 128); WV[eg] = ACT[e_]; } } while (0)
#define GT_COMPV(VQ, WV) do { \
        _Pragma("unroll") for (int eg = 0; eg < 8; ++eg) { const f32x2 w2_ = (f32x2){WV[eg], WV[eg]}; \
            _Pragma("unroll") for (int q = 0; q < 4; ++q) { \
                const f32x2 lo = __builtin_amdgcn_cvt_pk_f32_fp8((int)VQ[eg][q], false), hi = __builtin_amdgcn_cvt_pk_f32_fp8((int)VQ[eg][q], true); \
                acc2[2 * q] += w2_ * lo; acc2[2 * q + 1] += w2_ * hi; } } } while (0)
    if (nit > 0) {
        u32x4 vA[8], vB[8]; float wA[8], wB[8];
        GT_LOADV(vA, wA, 0);
#pragma unroll 1
        for (int it = 0; it < nit; it += 2) {
            f32x2 acc2[8];
#pragma unroll
            for (int i = 0; i < 8; ++i) acc2[i] = (f32x2){0.f, 0.f};
            GT_LOADV(vB, wB, it + 1);
            GT_COMPV(vA, wA);
            if (it + 2 < nit) GT_LOADV(vA, wA, it + 2);
            GT_COMPV(vB, wB);
            f32x2 t4[4], t2[2], t1;
#pragma unroll
            for (int i = 0; i < 4; ++i) { const f32x2 snd = (s & 4) ? acc2[i] : acc2[i + 4], kp = (s & 4) ? acc2[i + 4] : acc2[i];
                t4[i] = kp + (f32x2){__shfl_xor(snd.x, 32), __shfl_xor(snd.y, 32)}; }
#pragma unroll
            for (int i = 0; i < 2; ++i) { const f32x2 snd = (s & 2) ? t4[i] : t4[i + 2], kp = (s & 2) ? t4[i + 2] : t4[i];
                t2[i] = kp + (f32x2){__shfl_xor(snd.x, 16), __shfl_xor(snd.y, 16)}; }
            { const f32x2 snd = (s & 1) ? t2[0] : t2[1], kp = (s & 1) ? t2[1] : t2[0]; t1 = kp + (f32x2){__shfl_xor(snd.x, 8), __shfl_xor(snd.y, 8)}; }
            { GT_ITEM(it); (void)hf_; const int r_ = GT_ROW(k_);
              const int col = cb_ * 128 + j * 16 + 2 * s; float* xp = XS + (size_t)r_ * DM + col; const float* g2 = modl + (size_t)mod_sel(r_) * 12288 + 5 * DM + col;
#ifdef DBG_CHECK
              if (((r_ - 300) & 63) == 0 && r_ >= 300 && r_ < 300 + 64 * 128) { float* dbgo = WSP(float, WS_MQ) + (size_t)r_ * DM + col; dbgo[0] = t1.x; dbgo[1] = t1.y; }
#endif
              const f32x2 x = *(const f32x2*)xp, g = *(const f32x2*)g2;
              *(f32x2*)xp = x + pscale * g * t1; }
        }
    }
#undef GT_LOADV
#undef GT_COMPV
#undef GT_ITEM
#undef GT_ROW
}
__device__ __forceinline__ void phase_final_norm(const Ctx& C) {
    const float* XS = WSP(float, WS_XS); const float* fg = INP(I_FG);
    for (int q = C.bid * 8 + C.wid; q < NBATCH * SEQ; q += C.G * 8) {
        const int b = q / SEQ, t = q % SEQ; const float* xr = XS + ((size_t)b * RPB + CTXL + t) * DM; float* op = C.out + (size_t)q * DM;
        f32x4 v[8]; float ss = 0.f;
#pragma unroll
        for (int c = 0; c < 8; ++c) { v[c] = *(const f32x4*)(xr + c * 256 + C.lane * 4); ss += v[c][0] * v[c][0] + v[c][1] * v[c][1] + v[c][2] * v[c][2] + v[c][3] * v[c][3]; }
        ss = wave_sum(ss); const float rs = rsqrtf(ss * (1.0f / DM) + NORM_EPS);
#pragma unroll
        for (int c = 0; c < 8; ++c) { const f32x4 g = *(const f32x4*)(fg + c * 256 + C.lane * 4); *(f32x4*)(op + c * 256 + C.lane * 4) = v[c] * rs * g; }
    }
}

template <int TYPE  > __device__ __forceinline__ void attn_units(const Ctx& C, bool need_ctx) {
    const bf16_t* P = WSP(bf16_t, WS_P);
    const int nu = need_ctx ? 528 : 512;
#pragma unroll 1
    for (int u = C.bid; u < nu; u += C.G) {
        int bh, qb; if (u < 512) { bh = (u >> 8) * 8 + (u & 7); qb = ((u & 255) >> 3) + 1; } else { bh = u - 512; qb = 0; }
        const int b = bh >> 3, h = bh & 7; const size_t rq = (size_t)b * RPB + (size_t)qb * 256, rk = (size_t)b * RPB; const int seq = qb == 0 ? CTXL : RPB;
        __syncthreads();
        if constexpr (TYPE == 1) {
            att::attn_body<128, 1>(P + rq * NP + C_AQ + h * 128, NP, P + rk * NP + C_AK + (h >> 2) * 128, NP, nullptr, 0, P + rk * NP + C_AV + (h >> 2) * 128, NP,
                                   WSP(bf16_t, WS_OA) + rq * 1024 + h * 128, 1024, seq, false, 0, nullptr, (char*)C.lds, C.tid);
        } else {
            const bf16_t* MQ = WSP(bf16_t, WS_MQ); const bf16_t* MKV = WSP(bf16_t, WS_MKV);
            att::attn_body<192, 1>(MQ + rq * 1536 + h * 192, 1536, MKV + rk * 2048 + h * 256, 2048, P + rk * NP + C_MKR, NP, MKV + rk * 2048 + h * 256 + 128, 2048,
                                   WSP(bf16_t, WS_OM) + rq * 1024 + h * 128, 1024, seq, qb > 0, (qb - 1) * 256, WSP(float, WS_TABM), (char*)C.lds, C.tid);
        }
    }
    __syncthreads();
}

constexpr int LDS_BYTES = 163840, LDS_BAR_OFF = LDS_BYTES - 16;
constexpr int N_PHASES = 26;
template <int K> __device__ __forceinline__ void run_phase(const Ctx& C0, int l) {
    const Ctx C = launder(C0);
    const float* modl = WSP(float, WS_MODV) + (size_t)l * 3 * 12288;
    if constexpr (K == 0) { phase_modv(C); phase_tables(C); __syncthreads(); phase_cvt_mixer_weights(C, 0); }
    if constexpr (K == 1) {
        if (l == 0) phase_norm_mod<true>(C, INP(I_N1G), modl, 0, DM);
        else { phase_norm_mod<false>(C, INP(I_N1G) + l * DM, modl, 0, DM); __syncthreads(); phase_cvt_mixer_weights(C, l); }
    }
    if constexpr (K == 2) {
        pg8::Gemm g{WSP(bf16_t, WS_HB), WSP(bf16_t, WS_WIN), TT, NP, DM, DM, DM}; pg8::StaticOrder S; S.init(TT, NP, C.G, C.bid);
        pg8::EpiStoreBf16 E{WSP(bf16_t, WS_P), NP};
        pg8::gemm_phase(C.lds, C.tid, g, S, E);
    }
    if constexpr (K == 3) phase_post_p(C, l);
    if constexpr (K == 4) {
        { pg8::Gemm g{WSP(bf16_t, WS_P) + C_MCQ, WSP(bf16_t, WS_WUQ), TT, 1536, 512, NP, 512}; pg8::StaticOrder S; S.init(TT, 1536, C.G, C.bid);
          pg8::EpiStoreBf16 E{WSP(bf16_t, WS_MQ), 1536}; pg8::gemm_phase(C.lds, C.tid, g, S, E); }
        { pg8::Gemm g{WSP(bf16_t, WS_P) + C_MCKV, WSP(bf16_t, WS_WUKV), TT, 2048, 512, NP, 512}; pg8::StaticOrder S; S.init(TT, 2048, C.G, C.bid);
          pg8::EpiStoreBf16 E{WSP(bf16_t, WS_MKV), 2048}; pg8::gemm_phase(C.lds, C.tid, g, S, E); }
        { const Ctx C2 = launder(C0); phase_gla_local(C2, l); }
#ifdef DBG_DUP_GLALOCAL
        { const Ctx C2 = launder(C0); __syncthreads(); phase_gla_local(C2, l); }
#endif
    }
    if constexpr (K == 5) phase_gla_scan(C);
    if constexpr (K == 6) { attn_units<0>(C, l + 1 < DEPTH); { const Ctx C2 = launder(C0); attn_units<1>(C2, l + 1 < DEPTH); } { const Ctx C3 = launder(C0); phase_gla_out(C3, l); }
#ifdef DBG_DUP_GLAOUT
        { const Ctx C3 = launder(C0); __syncthreads(); phase_gla_out(C3, l); }
#endif
    }
    if constexpr (K == 7) {
        const bf16_t* P = WSP(bf16_t, WS_P); bf16_t* Y = WSP(bf16_t, WS_Y);
        const pg8::Gemm ga{WSP(bf16_t, WS_OA), WSP(bf16_t, WS_WBR), TT, DM, 1024, 1024, 1024}, gl{WSP(bf16_t, WS_OL), WSP(bf16_t, WS_WBR) + (size_t)2048 * 1024, TT, DM, 1024, 1024, 1024},
                        gm{WSP(bf16_t, WS_OM), WSP(bf16_t, WS_WBR) + (size_t)2 * 2048 * 1024, TT, DM, 1024, 1024, 1024};
        const pg8::EpiGate<true> Ea{Y, DM, P + C_GA, NP}; const pg8::EpiGate<false> El{Y, DM, P + C_GL, NP}, Em{Y, DM, P + C_GM, NP};
        pg8::StaticOrder S; S.init(TT, DM, C.G, C.bid, l + 1 >= DEPTH);
        pg8::gemm_phase(C.lds, C.tid, ga, S, Ea); pg8::gemm_phase(C.lds, C.tid, gl, S, El); pg8::gemm_phase(C.lds, C.tid, gm, S, Em);
    }
    if constexpr (K == 8) {
        pg8::Gemm g{WSP(bf16_t, WS_Y), WSP(bf16_t, WS_WOUT), TT, DM, DM, DM, DM};
        pg8::EpiResid E{WSP(float, WS_XS), DM, modl + 2 * DM, l == 0 ? DBG_MIX0 : DBG_MIX1};
        pg8::StaticOrder S; S.init(TT, DM, C.G, C.bid, l + 1 >= DEPTH);
#ifdef DBG_DUP8
        { pg8::EpiResid E0{WSP(float, WS_XS), DM, modl + 2 * DM, 0.0f}; pg8::gemm_phase(C.lds, C.tid, g, S, E0); }
#endif
        pg8::gemm_phase(C.lds, C.tid, g, S, E);
        phase_cvt_peer_tables(C, l);
#ifdef DBG_CDUP
        phase_cvt_peer_tables(C, l);
#endif
    }
    if constexpr (K == 9) phase_norm_mod<false>(C, INP(I_N2G) + l * DM, modl, 3 * DM, 4 * DM);
    if constexpr (K == 10) {
        pg8::Gemm g{WSP(bf16_t, WS_HB), WSP(bf16_t, WS_WQ), TT, DM, DM, DM, DM};
        pg8::EpiStoreBf16 E{WSP(bf16_t, WS_PQ), DM};
        pg8::StaticOrder S; S.init(TT, DM, C.G, C.bid, l + 1 >= DEPTH); pg8::gemm_phase(C.lds, C.tid, g, S, E);
    }
    if constexpr (K == 11) phase_peer_select(C, l + 1 >= DEPTH);
    if constexpr (K == 13) phase_final_norm(C);
    if constexpr (K == 12) {
#ifdef DBG_DUP12
        if (l + 1 < DEPTH) phase_peer_gather<false>(C, modl, 0.0f); else phase_peer_gather<true>(C, modl, 0.0f);
        __syncthreads();
#endif
        if (l + 1 < DEPTH) phase_peer_gather<false>(C, modl, DBG_PEER0); else phase_peer_gather<true>(C, modl, DBG_PEER1); }
}
__device__ __forceinline__ Ctx make_ctx(const Args& args, unsigned char* lds_raw) {
    Ctx C0; C0.in = (const __attribute__((address_space(4))) cfp_t*)__builtin_amdgcn_kernarg_segment_ptr(); C0.out = args.out; C0.ws = args.ws; C0.lds = (LAS unsigned char*)lds_raw;
    C0.tid = threadIdx.x; C0.lane = C0.tid & 63; C0.wid = __builtin_amdgcn_readfirstlane(C0.tid >> 6); C0.G = gridDim.x; C0.bid = blockIdx.x;
    return C0;
}
template <int K> __global__ void __launch_bounds__(NTHREADS, 2) k_one(Args args) {
    extern __shared__ __attribute__((aligned(16))) unsigned char lds_raw[];
    const Ctx C0 = make_ctx(args, lds_raw);
    run_phase<K>(C0, args.ph_lo);
}
#if MK_N_LAUNCHES == 1 || defined(DBG_HYB)
__global__ void __launch_bounds__(NTHREADS, 2) mk_fwd(Args args) {
    extern __shared__ __attribute__((aligned(16))) unsigned char lds_raw[];
    const Ctx C0 = make_ctx(args, lds_raw);
    if (C0.tid < 4) ((LAS unsigned*)(C0.lds + LDS_BAR_OFF))[C0.tid] = 0u;
    __syncthreads();
    const int lo = args.ph_lo, hi = args.ph_hi;
    XcdBarrier bar; bar.bar = (unsigned*)(args.ws + WS_CTL); bar.x = 0; bar.st = nullptr;
    if (hi - lo > 1) bar = xcd_barrier_post((unsigned*)(args.ws + WS_CTL), (volatile LAS unsigned*)(C0.lds + LDS_BAR_OFF));
#define IN(k) (lo <= (k) && (k) < hi)
#define SEAM(k) do { if (IN(k) && IN((k) + 1)) xcd_barrier(bar); } while (0)
#ifndef DBG_DUP
#define DBG_DUP -1
#endif
#define PH(K, k) do { if (IN(k)) { run_phase<K>(C0, l); if (K == DBG_DUP) { xcd_barrier(bar); run_phase<K>(C0, l); } } SEAM(k); } while (0)
    { const int l = 0; PH(0, 0); }
#pragma unroll 1
    for (int l = 0; l < DEPTH; ++l) {
        const int pb = 1 + 12 * l;
        PH(1, pb + 0); PH(2, pb + 1); PH(3, pb + 2); PH(4, pb + 3); PH(5, pb + 4); PH(6, pb + 5);
        PH(7, pb + 6); PH(8, pb + 7); PH(9, pb + 8); PH(10, pb + 9); PH(11, pb + 10); PH(12, pb + 11);
    }
    { const int l = DEPTH - 1; PH(13, 1 + 12 * DEPTH); }
#undef PH
#undef IN
#undef SEAM
}
#define MAIN_KERNEL mk_fwd
#else
#define MAIN_KERNEL k_one<6>
#endif


#ifdef DBG_CHECK
__device__ __forceinline__ void dbg_report(unsigned* slot, float err) { if (!(err <= 3e38f)) err = 1e30f; atomicMax(slot, __float_as_uint(err)); }
__global__ void k_check_gemm(const bf16_t* A, int lda, const float* W, int K, int N, const bf16_t* Cm, int ldc, int M, unsigned* slot) {
    const unsigned id = blockIdx.x * blockDim.x + threadIdx.x; if (id >= 8192) return;
    const unsigned h = id * 2654435761u; const int row = (int)((h >> 8) % (unsigned)M), col = (int)((h * 40503u >> 7) % (unsigned)N);
    float ref = 0.f; for (int k = 0; k < K; ++k) ref += bf2f(A[(size_t)row * lda + k]) * W[(size_t)k * N + col];
    const float got = bf2f(Cm[(size_t)row * ldc + col]);
    dbg_report(slot, fabsf(got - ref) / (fabsf(ref) + 0.1f));
}

__global__ void k_check_attn(const unsigned char* ws, int type, unsigned* slot) {
    __shared__ float sc[RPB]; __shared__ float red[256]; __shared__ float qv[192];
    const int t = threadIdx.x, bh = blockIdx.x & 15, b = bh >> 3, h = bh & 7; const int qpos = (int)(((blockIdx.x >> 4) * 977u + 13u) % SEQ); const size_t rq = (size_t)b * RPB + CTXL + qpos, rk = (size_t)b * RPB;
    const bf16_t* P = (const bf16_t*)(ws + WS_P); const bf16_t* MQ = (const bf16_t*)(ws + WS_MQ); const bf16_t* MKV = (const bf16_t*)(ws + WS_MKV);
    const int dq = type ? 128 : 192;
    if (t < dq) { float v = type ? bf2f(P[rq * NP + C_AQ + h * 128 + t]) : bf2f(MQ[rq * 1536 + h * 192 + t]); qv[t] = v; }
    __syncthreads();
    if (!type && t < 32) {
        const int ri = qpos >> 6, ci = qpos & 63; const int i = t; const float pos = (float)(i < 16 ? ri : ci); const float inv = powf(10000.f, -(float)(i & 15) / 16.f); const float a = pos * inv;
        const float x1 = qv[128 + i], x2 = qv[160 + i]; qv[128 + i] = x1 * cosf(a) - x2 * sinf(a); qv[160 + i] = x2 * cosf(a) + x1 * sinf(a); }
    __syncthreads();
    const float scale = type ? 0.088388347648f : 0.0721687836487f;
    float mx = -1e30f;
    for (int k = t; k < RPB; k += 256) { float s = 0.f;
        if (type) { const bf16_t* kp = P + (rk + k) * NP + C_AK + (h >> 2) * 128; for (int d = 0; d < 128; ++d) s += qv[d] * bf2f(kp[d]); }
        else { const bf16_t* kp = MKV + (rk + k) * 2048 + h * 256; for (int d = 0; d < 128; ++d) s += qv[d] * bf2f(kp[d]); const bf16_t* kr = P + (rk + k) * NP + C_MKR; for (int d = 0; d < 64; ++d) s += qv[128 + d] * bf2f(kr[d]); }
        s *= scale; sc[k] = s; mx = fmaxf(mx, s); }
    red[t] = mx; __syncthreads(); for (int o = 128; o >= 1; o >>= 1) { if (t < o) red[t] = fmaxf(red[t], red[t + o]); __syncthreads(); } mx = red[0]; __syncthreads();
    float sum = 0.f; for (int k = t; k < RPB; k += 256) { const float p = __expf(sc[k] - mx); sc[k] = p; sum += p; }
    red[t] = sum; __syncthreads(); for (int o = 128; o >= 1; o >>= 1) { if (t < o) red[t] += red[t + o]; __syncthreads(); } sum = red[0]; __syncthreads();
    float e = 0.f, mag = 0.f;
    if (t < 128) { float o = 0.f; for (int k = 0; k < RPB; ++k) { const float vv = type ? bf2f(P[(rk + k) * NP + C_AV + (h >> 2) * 128 + t]) : bf2f(MKV[(rk + k) * 2048 + h * 256 + 128 + t]); o += sc[k] * vv; }
        o /= sum; const float got = bf2f(((const bf16_t*)(ws + (type ? WS_OA : WS_OM)))[rq * 1024 + h * 128 + t]); e = fabsf(got - o); mag = fabsf(o); }
    red[t] = e; __syncthreads(); for (int o = 128; o >= 1; o >>= 1) { if (t < o) red[t] = fmaxf(red[t], red[t + o]); __syncthreads(); } e = red[0]; __syncthreads();
    red[t] = mag; __syncthreads(); for (int o = 128; o >= 1; o >>= 1) { if (t < o) red[t] = fmaxf(red[t], red[t + o]); __syncthreads(); } mag = red[0];
    if (t == 0) dbg_report(slot, e / (mag + 1e-4f));
}
__global__ void __launch_bounds__(256) k_check_gla_rec(const unsigned char* ws, const float* wa_f, const float* ba_f, const float* wa_b, const float* ba_b, float* obuf, int b) {
    __shared__ float ad[128], kd[128], qd[128], lrs[16];
    const int e = threadIdx.x, h = blockIdx.x & 3, dir = blockIdx.x >> 2; const bf16_t* P = (const bf16_t*)(ws + WS_P);
    const float* wa = dir ? wa_b : wa_f; const float* ba = dir ? ba_b : ba_f;
    float S[128];
#pragma unroll
    for (int d = 0; d < 128; ++d) S[d] = 0.f;
    float* ob = obuf + ((size_t)(dir * 2 + b) * 4 + h) * RPB * 256;
    for (int st = 0; st < RPB; ++st) {
        int j; if (!dir) j = st; else j = st < CTXL ? CTXL - 1 - st : RPB - 1 - (st - CTXL);
        const size_t r = (size_t)b * RPB + j; const bf16_t* pr = P + r * NP;
        if (e < 16) lrs[e] = bf2f(pr[(dir ? C_LRB : C_LRF) + e]);
        __syncthreads();
        if (e < 128) { float pre = ba[h * 128 + e]; for (int q = 0; q < 16; ++q) pre += lrs[q] * wa[q * 512 + h * 128 + e];
            const float ls = (fminf(pre, 0.f) - log1pf(expf(-fabsf(pre)))) / 16.f; ad[e] = expf(ls); kd[e] = bf2f(pr[C_LK + h * 128 + e]); qd[e] = bf2f(pr[C_LQ + h * 128 + e]) * 0.088388347648f; }
        __syncthreads();
        const float v = bf2f(pr[C_LV + h * 256 + e]); float o = 0.f;
#pragma unroll
        for (int d = 0; d < 128; ++d) { S[d] = ad[d] * S[d] + kd[d] * v; o += qd[d] * S[d]; }
        ob[(size_t)j * 256 + e] = o;
        __syncthreads();
    }
}
__global__ void k_check_gla_cmp(const unsigned char* ws, const float* obuf, const float* gon, int b, unsigned* slot) {
    __shared__ float red[256];
    const int e = threadIdx.x, h = blockIdx.x & 3, j = blockIdx.x >> 2; const size_t r = (size_t)b * RPB + j; const bf16_t* P = (const bf16_t*)(ws + WS_P);
    const float o = obuf[((size_t)(0 * 2 + b) * 4 + h) * RPB * 256 + (size_t)j * 256 + e] + obuf[((size_t)(1 * 2 + b) * 4 + h) * RPB * 256 + (size_t)j * 256 + e];
    red[e] = o * o; __syncthreads(); for (int s_ = 128; s_ >= 1; s_ >>= 1) { if (e < s_) red[e] += red[e + s_]; __syncthreads(); }
    const float rs = rsqrtf(red[0] / 256.f + NORM_EPS); __syncthreads();
    const float gt = bf2f(P[r * NP + C_LG + h * 256 + e]); const float ref = o * rs * gon[e] * (gt / (1.f + expf(-gt)));
    const float got = bf2f(((const bf16_t*)(ws + WS_OL))[r * 1024 + h * 256 + e]);
    red[e] = fabsf(got - ref); __syncthreads(); for (int s_ = 128; s_ >= 1; s_ >>= 1) { if (e < s_) red[e] = fmaxf(red[e], red[e + s_]); __syncthreads(); }
    if (e == 0) dbg_report(slot, red[0] / 1.0f);
}
__global__ void k_check_select(const bf16_t* PQ, const float* k1, const float* k2, const int* PIDX, const float* PG, unsigned* slot) {
    __shared__ float s1[128], s2[128]; __shared__ int cnt; __shared__ float selv[16];
    const int tok = (blockIdx.x >> 3) * 61 + 5, head = blockIdx.x & 7, t = threadIdx.x;
    if (t == 0) cnt = 0;
    for (int n = t; n < 128; n += 64) { float a = 0.f, b = 0.f; for (int d = 0; d < 128; ++d) { a += bf2f(PQ[(size_t)tok * DM + head * 256 + d]) * k1[((size_t)head * 128 + n) * 128 + d]; b += bf2f(PQ[(size_t)tok * DM + head * 256 + 128 + d]) * k2[((size_t)head * 128 + n) * 128 + d]; } s1[n] = a; s2[n] = b; }
    __syncthreads();
    if (t < 16) { const int id = PIDX[(size_t)tok * 128 + head * 16 + t]; selv[t] = (id >= 0 && id < 16384) ? s1[id >> 7] + s2[id & 127] : -1e30f; }
    __syncthreads();
    float thr = selv[0], mx = selv[0]; for (int k = 1; k < 16; ++k) { thr = fminf(thr, selv[k]); mx = fmaxf(mx, selv[k]); }
    int c = 0; for (int p = t; p < 16384; p += 64) if (s1[p >> 7] + s2[p & 127] > thr + 0.02f) ++c;
    atomicAdd(&cnt, c); __syncthreads();
    if (t == 0) { float den = 0.f; for (int k = 0; k < 16; ++k) den += __expf(selv[k] - mx); float e = fabsf((float)cnt - 15.f) / 15.f > 0.34f ? fabsf((float)cnt - 15.f) / 15.f : 0.f;
        for (int k = 0; k < 16; ++k) e = fmaxf(e, fabsf(PG[(size_t)tok * 128 + head * 16 + k] - __expf(selv[k] - mx) / den) * 4.f);
        for (int k = 0; k < 16; ++k) for (int k2_ = 0; k2_ < k; ++k2_) if (PIDX[(size_t)tok * 128 + head * 16 + k] == PIDX[(size_t)tok * 128 + head * 16 + k2_]) e = fmaxf(e, 10.f);
        dbg_report(slot, e); }
}
__global__ void k_check_gather(const bf16_t* HB, const float* u, const float* v, const int* PIDX, const float* PG, const float* dbgo, unsigned* slot) {
    __shared__ float w[128];
    const int tok = blockIdx.x * 64 + 300, t = threadIdx.x;
    for (int k = t; k < 128; k += 64) { const int id = PIDX[(size_t)tok * 128 + k] & 16383; float a = 0.f; for (int d = 0; d < DM; ++d) a += bf2f(HB[(size_t)tok * DM + d]) * u[(size_t)id * DM + d];
        w[k] = PG[(size_t)tok * 128 + k] * 0.5f * a * (1.0f + erff(a * 0.70710678f)); }
    __syncthreads();
    float e = 0.f, sc = 0.f;
    for (int d = t; d < DM; d += 64) { float o = 0.f; for (int k = 0; k < 128; ++k) o += w[k] * v[(size_t)(PIDX[(size_t)tok * 128 + k] & 16383) * DM + d];
        e = fmaxf(e, fabsf(o - dbgo[(size_t)tok * DM + d])); sc = fmaxf(sc, fabsf(o)); }
    for (int o_ = 32; o_ >= 1; o_ >>= 1) { e = fmaxf(e, __shfl_xor(e, o_)); sc = fmaxf(sc, __shfl_xor(sc, o_)); }
    if (t == 0) dbg_report(slot, e / (sc + 1e-6f));
}
__global__ void k_dbg_out2(const float* x, const float* fg, float* out, const unsigned* slot) {
    const float mx = __uint_as_float(*slot); float v = 0.25f * (log10f(fmaxf(mx, 1e-30f)) + 4.0f); v = fminf(fmaxf(v, 0.f), 9.f);
    const float f = 1.0f + v;
    const int lane = threadIdx.x & 63; const size_t r = (size_t)blockIdx.x * 4 + (threadIdx.x >> 6);
    const float* xr = x + r * DM; float ss = 0.f;
    for (int c = lane; c < DM; c += 64) ss += xr[c] * xr[c];
    ss = wave_sum(ss); const float rs = rsqrtf(ss / DM + NORM_EPS);
    for (int c = lane; c < DM; c += 64) out[r * DM + c] = xr[c] * rs * fg[c] * f;
}
#endif
#ifdef DBG_SCAN
__global__ void k_scan16(const bf16_t* p, size_t n, unsigned* flags, int stage) {
    unsigned bad = 0; for (size_t i = (size_t)blockIdx.x * blockDim.x + threadIdx.x; i < n; i += (size_t)gridDim.x * blockDim.x) bad |= ((p[i] & 0x7f80u) == 0x7f80u);
    if (bad) atomicOr(&flags[stage], 1u);
}
__global__ void k_scan32(const float* p, size_t n, unsigned* flags, int stage) {
    unsigned bad = 0; for (size_t i = (size_t)blockIdx.x * blockDim.x + threadIdx.x; i < n; i += (size_t)gridDim.x * blockDim.x) bad |= ((__float_as_uint(p[i]) & 0x7f800000u) == 0x7f800000u);
    if (bad) atomicOr(&flags[stage], 1u);
}
__global__ void k_dbg_out(const float* x, const float* fg, float* out, const unsigned* flags, int nstage) {
    int code = 0; for (int s = nstage; s >= 1; --s) if (flags[s]) code = s;
    const float f = 1.0f + 0.25f * (float)code;
    const int lane = threadIdx.x & 63; const size_t r = (size_t)blockIdx.x * 4 + (threadIdx.x >> 6);
    const float* xr = x + r * DM; float ss = 0.f;
    for (int c = lane; c < DM; c += 64) ss += xr[c] * xr[c];
    ss = wave_sum(ss); const float rs = rsqrtf(ss / DM + NORM_EPS);
    for (int c = lane; c < DM; c += 64) out[r * DM + c] = xr[c] * rs * fg[c] * f;
}
#endif
extern "C" void kernel_launch(void* const* d_in, const int* in_sizes, int n_in, void* d_out, int out_size, void* d_ws, size_t ws_size, hipStream_t stream) {
    static int grid = 0;
    if (grid == 0) {
        if (n_in != 30 || out_size != NBATCH * SEQ * DM || ws_size < WS_END) { fprintf(stderr, "kernel_launch: shape/workspace mismatch: n_in %d out %d ws %zu (need %zu)\n", n_in, out_size, ws_size, (size_t)WS_END); grid = -1; return; }
        int dev = 0, cus = 0, per_cu = 0;
        if (hipGetDevice(&dev) != hipSuccess || hipDeviceGetAttribute(&cus, hipDeviceAttributeMultiprocessorCount, dev) != hipSuccess) { grid = -1; return; }
        bool okattr = hipFuncSetAttribute((const void*)MAIN_KERNEL, hipFuncAttributeMaxDynamicSharedMemorySize, LDS_BYTES) == hipSuccess;
#if MK_N_LAUNCHES != 1
#ifdef DBG_HYB
        okattr = okattr && hipFuncSetAttribute((const void*)mk_fwd, hipFuncAttributeMaxDynamicSharedMemorySize, LDS_BYTES) == hipSuccess;
#endif
#define SETA(K) okattr = okattr && hipFuncSetAttribute((const void*)k_one<K>, hipFuncAttributeMaxDynamicSharedMemorySize, LDS_BYTES) == hipSuccess
        SETA(0); SETA(1); SETA(2); SETA(3); SETA(4); SETA(5); SETA(6); SETA(7); SETA(8); SETA(9); SETA(10); SETA(11); SETA(12); SETA(13);
#undef SETA
#endif
        if (!okattr) { fprintf(stderr, "kernel_launch: hipFuncSetAttribute failed\n"); grid = -1; return; }
        if (hipOccupancyMaxActiveBlocksPerMultiprocessor(&per_cu, (const void*)MAIN_KERNEL, NTHREADS, LDS_BYTES) != hipSuccess || per_cu < 1) { fprintf(stderr, "kernel_launch: occupancy query says %d blocks per CU\n", per_cu); grid = -1; (void)hipGetLastError(); return; }
        grid = cus;
    }
    if (grid < 0) return;
    if (hipMemsetAsync((char*)d_ws + WS_CTL, 0, CTL_BYTES, stream) != hipSuccess) return;
    Args a{};
    for (int i = 0; i < 30; ++i) a.in[i] = (const float*)d_in[i];
    a.out = (float*)d_out; a.ws = (unsigned char*)d_ws;
#if MK_N_LAUNCHES == 1
#ifdef DBG_SPLIT
    for (int p = 0; p < N_PHASES; p += DBG_SPLIT) { a.ph_lo = p; a.ph_hi = p + DBG_SPLIT < N_PHASES ? p + DBG_SPLIT : N_PHASES; hipLaunchKernelGGL(mk_fwd, dim3(grid), dim3(NTHREADS), LDS_BYTES, stream, a); }
#else
    a.ph_lo = 0; a.ph_hi = N_PHASES;
    hipLaunchKernelGGL(mk_fwd, dim3(grid), dim3(NTHREADS), LDS_BYTES, stream, a);
#endif
#else
    a.ph_hi = 0;
#ifndef DBG_NLAUNCH
#define DBG_NLAUNCH 100
#endif
    int nl_ = 0;
#ifdef DBG_HYB
#define LAUNCH1(K, L) do { if (K == DBG_HYB) { a.ph_lo = 12 * (L) + (K); a.ph_hi = a.ph_lo + 1; hipLaunchKernelGGL(mk_fwd, dim3(grid), dim3(NTHREADS), LDS_BYTES, stream, a); a.ph_hi = 0; } else { a.ph_lo = (L); hipLaunchKernelGGL(k_one<K>, dim3(grid), dim3(NTHREADS), LDS_BYTES, stream, a); } } while (0)
#else
#define LAUNCH1(K, L) do { a.ph_lo = (L); if (nl_++ < DBG_NLAUNCH) { hipLaunchKernelGGL(k_one<K>, dim3(grid), dim3(NTHREADS), LDS_BYTES, stream, a); if (K == DBG_DUP) hipLaunchKernelGGL(k_one<K>, dim3(grid), dim3(NTHREADS), LDS_BYTES, stream, a); } } while (0)
#endif
#ifdef DBG_SCAN
    unsigned* flags = (unsigned*)((char*)d_ws + WS_CTL + 32768);
    char* W = (char*)d_ws;
#define S16(off, n, st) hipLaunchKernelGGL(k_scan16, dim3(1024), dim3(256), 0, stream, (const bf16_t*)(W + (off)), (size_t)(n), flags, st)
#define S32(off, n, st) hipLaunchKernelGGL(k_scan32, dim3(1024), dim3(256), 0, stream, (const float*)(W + (off)), (size_t)(n), flags, st)
    LAUNCH1(0, 0); S32(WS_MODV, 2 * 3 * 12288, 1);
    { const int l = 0;
      LAUNCH1(1, l); S16(WS_HB, (size_t)TT * DM, 2);
      LAUNCH1(2, l); S16(WS_P, (size_t)TT * NP, 3);
      LAUNCH1(3, l); S16(WS_P, (size_t)TT * NP, 4);
      LAUNCH1(4, l); S16(WS_MQ, (size_t)TT * 1536, 5); S16(WS_MKV, (size_t)TT * 2048, 5); S16(WS_GST, (size_t)2112 * 32768, 6); S32(WS_GDEC, (size_t)2112 * 128, 6);
      LAUNCH1(5, l); S16(WS_GST, (size_t)2112 * 32768, 7);
      LAUNCH1(6, l); S16(WS_OA, (size_t)TT * 1024, 8); S16(WS_OM, (size_t)TT * 1024, 9); S16(WS_OL, (size_t)TT * 1024, 10);
      LAUNCH1(7, l); S16(WS_Y, (size_t)TT * DM, 11);
      LAUNCH1(8, l); S32(WS_XS, (size_t)TT * DM, 12);
      LAUNCH1(9, l); S16(WS_HB, (size_t)TT * DM, 13);
      LAUNCH1(10, l); S16(WS_PQ, (size_t)TT * DM, 14);
      LAUNCH1(11, l); S32(WS_PG, (size_t)TT * 128, 15);
      LAUNCH1(12, l); S32(WS_XS, (size_t)TT * DM, 16);
    }
    hipLaunchKernelGGL(k_dbg_out, dim3(NBATCH * SEQ / 4), dim3(256), 0, stream, (const float*)d_in[0], (const float*)d_in[29], (float*)d_out, flags, 16);
#elif defined(DBG_CHECK)
    unsigned* flags = (unsigned*)((char*)d_ws + WS_CTL + 32768);
    char* W = (char*)d_ws;
    LAUNCH1(0, 0);
    { const int l = 0; LAUNCH1(1, l); LAUNCH1(2, l); LAUNCH1(3, l); LAUNCH1(4, l); LAUNCH1(5, l); LAUNCH1(6, l);
#if DBG_CHECK == 5 || DBG_CHECK == 6
      hipLaunchKernelGGL(k_check_attn, dim3(16 * 24), dim3(256), 0, stream, (const unsigned char*)d_ws, DBG_CHECK == 5 ? 1 : 0, flags + 100);
#endif
#if DBG_CHECK == 7
      { float* obuf = (float*)(W + WS_MQ);
        hipLaunchKernelGGL(k_check_gla_rec, dim3(8), dim3(256), 0, stream, (const unsigned char*)d_ws, (const float*)d_in[I_WA2F], (const float*)d_in[I_BAF], (const float*)d_in[I_WA2B], (const float*)d_in[I_BAB], obuf, 0);
        hipLaunchKernelGGL(k_check_gla_cmp, dim3(RPB * 4), dim3(256), 0, stream, (const unsigned char*)d_ws, (const float*)obuf, (const float*)d_in[I_ONG], 0, flags + 100); }
#endif
      LAUNCH1(7, l); LAUNCH1(8, l); LAUNCH1(9, l); LAUNCH1(10, l);
#if DBG_CHECK == 1
      hipLaunchKernelGGL(k_check_gemm, dim3(32), dim3(256), 0, stream, (const bf16_t*)(W + WS_HB), DM, (const float*)d_in[I_PWQ], DM, DM, (const bf16_t*)(W + WS_PQ), DM, TT, flags + 100);
#endif
      LAUNCH1(11, l);
#if DBG_CHECK == 2
      hipLaunchKernelGGL(k_check_select, dim3(256 * 8), dim3(64), 0, stream, (const bf16_t*)(W + WS_PQ), (const float*)d_in[I_PK1], (const float*)d_in[I_PK2], (const int*)(W + WS_PIDX), (const float*)(W + WS_PG), flags + 100);
#endif
      LAUNCH1(12, l);
#if DBG_CHECK == 3
      hipLaunchKernelGGL(k_check_gather, dim3(128), dim3(64), 0, stream, (const bf16_t*)(W + WS_HB), (const float*)d_in[I_PU], (const float*)d_in[I_PV], (const int*)(W + WS_PIDX), (const float*)(W + WS_PG), (const float*)(W + WS_MQ), flags + 100);
#endif
    }
    hipLaunchKernelGGL(k_dbg_out2, dim3(NBATCH * SEQ / 4), dim3(256), 0, stream, (const float*)d_in[0], (const float*)d_in[29], (float*)d_out, flags + 100);
#else
    LAUNCH1(0, 0);
    for (int l = 0; l < DEPTH; ++l) { LAUNCH1(1, l); LAUNCH1(2, l); LAUNCH1(3, l);
#ifdef DBG_DUP23
        LAUNCH1(2, l); LAUNCH1(3, l);
#endif
        LAUNCH1(4, l); LAUNCH1(5, l);
#ifdef DBG_DUP45
        LAUNCH1(4, l); LAUNCH1(5, l);
#endif
        LAUNCH1(6, l); LAUNCH1(7, l); LAUNCH1(8, l); LAUNCH1(9, l); LAUNCH1(10, l); LAUNCH1(11, l); LAUNCH1(12, l); }
    LAUNCH1(13, DEPTH - 1);
#endif
#undef LAUNCH1
#endif
    const hipError_t le = hipPeekAtLastError();
    if (le != hipSuccess) fprintf(stderr, "kernel_launch: launch failed: %s\n", hipGetErrorName(le));
}
```

```cpp
#include <hip/hip_runtime.h>
#include <cstdio>
#include <cstdint>

#ifndef MK_N_LAUNCHES
#ifndef DBG_DUP
#define DBG_DUP -1
#endif
#define MK_N_LAUNCHES 1
#endif

#ifndef DBG_MIX0
#define DBG_MIX0 1.0f
#define DBG_MIX1 1.0f
#define DBG_PEER0 1.0f
#define DBG_PEER1 1.0f
#endif
#define LAS __attribute__((address_space(3)))
typedef unsigned short bf16_t;
typedef short bf16x8 __attribute__((ext_vector_type(8)));
typedef short s16x4 __attribute__((ext_vector_type(4)));
typedef float f32x4 __attribute__((ext_vector_type(4)));
typedef float f32x2 __attribute__((ext_vector_type(2)));
typedef float f32x16 __attribute__((ext_vector_type(16)));
typedef unsigned u32x4 __attribute__((ext_vector_type(4)));
typedef unsigned u32x2 __attribute__((ext_vector_type(2)));
typedef __bf16 bf2_t __attribute__((ext_vector_type(2)));

constexpr int DM = 2048, NBATCH = 2, SEQ = 8192, CTXL = 256, DEPTH = 2;
constexpr int RPB = SEQ + CTXL;
constexpr int TT = NBATCH * RPB;
constexpr int IN_COLS = 11872, NP = 12032;
constexpr int C_AQ = 0, C_AK = 1024, C_AV = 1280, C_LQ = 1536, C_LK = 2048, C_LV = 2560, C_LG = 3584, C_LRF = 4608, C_LRB = 4624,
              C_MCQ = 4640, C_MCKV = 5152, C_MKR = 5664, C_GA = 5728, C_GL = 7776, C_GM = 9824;
constexpr int NCH = RPB / 64;
constexpr int NEXP = 16384;
constexpr float NORM_EPS = 1e-6f;
constexpr int NTHREADS = 512;

constexpr size_t al256(size_t x) { return (x + 255) / 256 * 256; }
constexpr size_t WS_CTL   = 0;
constexpr size_t CTL_BYTES = 65536;
constexpr size_t WS_MODV  = WS_CTL + CTL_BYTES;
constexpr size_t WS_TABA  = al256(WS_MODV + (size_t)2 * 3 * 12288 * 4);
constexpr size_t WS_TABM  = WS_TABA + 2 * 128 * 32 * 4;
constexpr size_t WS_XS    = al256(WS_TABM + 2 * 128 * 16 * 4);
constexpr size_t WS_HB    = WS_XS + (size_t)TT * DM * 4;
constexpr size_t WS_P     = WS_HB + (size_t)TT * DM * 2;
constexpr size_t WS_MQ    = WS_P + (size_t)TT * NP * 2;
constexpr size_t WS_MKV   = WS_MQ + (size_t)TT * 1536 * 2;
constexpr size_t WS_OA    = WS_MKV + (size_t)TT * 2048 * 2;
constexpr size_t WS_OL    = WS_OA + (size_t)TT * 1024 * 2;
constexpr size_t WS_OM    = WS_OL + (size_t)TT * 1024 * 2;
constexpr size_t WS_WIN   = WS_OM + (size_t)TT * 1024 * 2;
constexpr size_t WS_WUQ   = WS_WIN + (size_t)NP * 2048 * 2;
constexpr size_t WS_WUKV  = WS_WUQ + (size_t)1536 * 512 * 2;
constexpr size_t WS_WBR   = WS_WUKV + (size_t)2048 * 512 * 2;
constexpr size_t WS_WOUT  = WS_WBR + (size_t)3 * 2048 * 1024 * 2;
constexpr size_t WS_WQ    = WS_WOUT + (size_t)2048 * 2048 * 2;
constexpr size_t WS_K1    = WS_WQ + (size_t)2048 * 2048 * 2;
constexpr size_t WS_K2    = WS_K1 + (size_t)8 * 128 * 128 * 2;
constexpr size_t WS_GST   = WS_K2 + (size_t)8 * 128 * 128 * 2;
constexpr size_t WS_GDEC  = WS_GST + (size_t)NBATCH * 2 * 4 * NCH * 32768 * 2;
constexpr size_t WS_END   = WS_GDEC + (size_t)NBATCH * 2 * 4 * NCH * 128 * 4;
constexpr size_t WS_Y     = WS_MKV;
constexpr size_t WS_PQ    = WS_OA;
constexpr size_t WS_U8    = WS_P;
constexpr size_t WS_V8    = WS_U8 + (size_t)NEXP * DM;
constexpr size_t WS_SCU   = WS_V8 + (size_t)NEXP * DM;
constexpr size_t WS_SCV   = WS_SCU + (size_t)NEXP * 4;
constexpr size_t WS_PIDX  = WS_SCV + (size_t)NEXP * 4;
constexpr size_t WS_PG    = WS_PIDX + (size_t)TT * 128 * 4;
static_assert(WS_PG + (size_t)TT * 128 * 4 <= WS_MQ, "PEER alias region overflows P");

__device__ __forceinline__ unsigned cvt_pk_bf16(float lo, float hi) { bf2_t v; v.x = (__bf16)lo; v.y = (__bf16)hi; return __builtin_bit_cast(unsigned, v); }
__device__ __forceinline__ bf16_t f2bf(float f) { return (bf16_t)(cvt_pk_bf16(f, 0.f) & 0xffffu); }
__device__ __forceinline__ float bf2f(bf16_t b) { return __uint_as_float(((unsigned)b) << 16); }
__device__ __forceinline__ float bflo(unsigned w) { return __uint_as_float(w << 16); }
__device__ __forceinline__ float bfhi(unsigned w) { return __uint_as_float(w & 0xffff0000u); }
__device__ __forceinline__ float xchg32(float x, int lane) { auto r = __builtin_amdgcn_permlane32_swap(__float_as_uint(x), __float_as_uint(x), false, false); return __uint_as_float(lane < 32 ? r[1] : r[0]); }
__device__ __forceinline__ float xchg16(float x, int lane) { auto r = __builtin_amdgcn_permlane16_swap(__float_as_uint(x), __float_as_uint(x), false, false); return __uint_as_float((lane & 16) ? r[0] : r[1]); }
template <int CTRL> __device__ __forceinline__ float dppmov(float x) { return __uint_as_float(__builtin_amdgcn_update_dpp(0u, __float_as_uint(x), CTRL, 0xF, 0xF, false)); }
constexpr int DPP_ROR8 = 0x128, DPP_HMIRROR = 0x141, DPP_Q3210 = 0x1B, DPP_Q1032 = 0xB1;
__device__ __forceinline__ float wave_sum(float v) {
    const int lane = threadIdx.x & 63;
    v += xchg32(v, lane); v += xchg16(v, lane); v += dppmov<DPP_ROR8>(v); v += dppmov<DPP_HMIRROR>(v); v += dppmov<DPP_Q3210>(v); v += dppmov<DPP_Q1032>(v);
    return v;
}
__device__ __forceinline__ float sigmoidf_(float x) { return __builtin_amdgcn_rcpf(1.0f + __expf(-x)); }
__device__ __forceinline__ float siluf_(float x) { return x * __builtin_amdgcn_rcpf(1.0f + __expf(-x)); }

#define XB_TMO      128
#define XB_XCNT(j)  (256  + 64 * (j))
#define XB_XSUB(j)  (1280 + 64 * (j))
#define XB_XGEN(j)  (2304 + 64 * (j))
#define XB_TOP      3328
#define XB_TOPGEN   3392
#define XCD_BAR_WORDS 3456
#define XB_SPIN_CAP (1u << 20)
__device__ __forceinline__ unsigned xb_ld(unsigned* p)              { return __hip_atomic_load(p, __ATOMIC_RELAXED, __HIP_MEMORY_SCOPE_AGENT); }
__device__ __forceinline__ unsigned xb_add(unsigned* p, unsigned v) { return __hip_atomic_fetch_add(p, v, __ATOMIC_RELAXED, __HIP_MEMORY_SCOPE_AGENT); }
__device__ __forceinline__ unsigned xb_xcc_id() { return (unsigned)__builtin_amdgcn_s_getreg((3 << 11) | 20) & 0xFu; }
#define XB_SPIN(cond, bar) do { unsigned _sp = 0; while (cond) { __builtin_amdgcn_s_sleep(1); \
    if ((++_sp & 255u) == 0u) { if (xb_ld(&(bar)[XB_TMO])) break; if (_sp > XB_SPIN_CAP) { atomicAdd(&(bar)[XB_TMO], 1u); break; } } } } while (0)
struct XcdBarrier { unsigned* bar; unsigned x; volatile LAS unsigned* st; };
__device__ __forceinline__ XcdBarrier xcd_barrier_post(unsigned* bar, volatile LAS unsigned* st) {
    XcdBarrier b; b.bar = bar; b.x = xb_xcc_id(); b.st = st;
    if (threadIdx.x == 0) (void)xb_add(&bar[XB_XCNT(b.x)], 1u);
    return b;
}
__device__ __forceinline__ void xcd_barrier_complete(unsigned* bar, unsigned x, unsigned& nloc, unsigned& nx) {
    const unsigned G = gridDim.x * gridDim.y * gridDim.z;
    unsigned sum, cnt, mine, sp = 0u;
    for (;;) {
        sum = 0u; cnt = 0u; mine = 0u;
#pragma unroll
        for (unsigned j = 0; j < 16; ++j) { const unsigned c = xb_ld(&bar[XB_XCNT(j)]); sum += c; cnt += (c > 0u) ? 1u : 0u; mine = (j == x) ? c : mine; }
        if (sum == G) break;
        __builtin_amdgcn_s_sleep(1);
        if ((++sp & 255u) == 0u) { if (xb_ld(&bar[XB_TMO])) break; if (sp > XB_SPIN_CAP) { atomicAdd(&bar[XB_TMO], 1u); break; } }
    }
    nloc = mine > 0u ? mine : 1u; nx = cnt > 0u ? cnt : 1u;
}
__device__ __forceinline__ void xcd_barrier(const XcdBarrier& b) {
    asm volatile("s_waitcnt vmcnt(0)" ::: "memory");
    __syncthreads();
    if (threadIdx.x == 0) {
        unsigned* bar = b.bar;
        __builtin_amdgcn_s_waitcnt(0);
        unsigned nloc = b.st[0], nx = b.st[1];
        if (nloc == 0u) { xcd_barrier_complete(bar, b.x, nloc, nx); b.st[0] = nloc; b.st[1] = nx; }
        const unsigned old = xb_add(&bar[XB_XSUB(b.x)], 1u);
        const unsigned gen = old / nloc;
        if (old + 1u == (gen + 1u) * nloc) {
            __builtin_amdgcn_fence(__ATOMIC_RELEASE, "agent");
            asm volatile("s_waitcnt vmcnt(0)" ::: "memory");
            const unsigned og = xb_add(&bar[XB_TOP], 1u);
            const unsigned tg = og / nx;
            if (og + 1u == (tg + 1u) * nx) xb_add(&bar[XB_TOPGEN], 1u);
            else XB_SPIN(xb_ld(&bar[XB_TOPGEN]) == tg, bar);
            __builtin_amdgcn_fence(__ATOMIC_ACQUIRE, "agent");
            xb_add(&bar[XB_XGEN(b.x)], 1u);
            asm volatile("s_waitcnt vmcnt(0)" ::: "memory");
        } else {
            XB_SPIN(xb_ld(&bar[XB_XGEN(b.x)]) == gen, bar);
            __builtin_amdgcn_fence(__ATOMIC_ACQUIRE, "agent");
            asm volatile("s_waitcnt vmcnt(0)" ::: "memory");
        }
    }
    __syncthreads();
}

namespace pg8 {
constexpr int BM = 256, BK = 64, HALF = 128, HTB = HALF * BK * 2, STAGE_BYTES = 8 * HTB, NXCD = 8, WGM = 8;
__host__ __device__ __forceinline__ int lds_byte(int r, int c) { const int st = (r >> 4) * 2 + (c >> 5), rr = r & 15, cc = c & 31, ob = rr * 64 + cc * 2; return st * 1024 + (ob ^ (((ob >> 9) & 1) << 5)); }
__host__ __device__ __forceinline__ void stage_rc(int b, int& R, int& C) { const int st = b / 1024, sb = b % 1024, swz = sb ^ (((sb >> 9) & 1) << 5); R = (st >> 1) * 16 + swz / 64; C = (st & 1) * 32 + (swz % 64) / 2; }
__host__ __device__ __forceinline__ int perm32(int rho) { const int n = rho >> 4, i = rho & 15; return 8 * (i >> 2) + 4 * n + (i & 3); }
struct Unit { int pm, pn; };
struct Gemm { const bf16_t* A; const bf16_t* Bt; int M, N, K, lda, ldb; };
struct StaticOrder {
    int nM, nN, nwg, G, c, latent;
    __host__ __device__ void init(int M, int N, int G_, int c_, int latent_ = 0) { latent = latent_; nM = latent_ ? 64 : M / BM; nN = N / BM; nwg = nM * nN; G = G_; c = c_; }
    __host__ __device__ bool next(int i, Unit& u) const {
        const long L = (long)i * G + c; if (L >= nwg) return false;
        int wgid = (int)L; { const int q = nwg / NXCD, r = nwg % NXCD, xcd = wgid % NXCD, off = wgid / NXCD; wgid = (xcd < r ? xcd * (q + 1) : r * (q + 1) + (xcd - r) * q) + off; }
        const int nig = WGM * nN, gid = wgid / nig, fm = gid * WGM, gsz = (nM - fm) < WGM ? (nM - fm) : WGM;
        u.pm = fm + ((wgid % nig) % gsz); u.pn = (wgid % nig) / gsz; if (latent) u.pm += 1 + (u.pm >= 32 ? 1 : 0); return true;
    }
};
struct EpiStoreBf16 {
    static constexpr bool PERM = true;
    bf16_t* O; int ldc;
    __device__ __forceinline__ void operator()(const f32x4 (&acc)[2][2][4][2], const Unit& u, int wr, int wc, int fr, int fq) const {
        const int row0 = u.pm * BM + wr * 64 + fr, col0 = u.pn * BM + wc * 32 + 8 * fq;
#pragma unroll
        for (int ai = 0; ai < 2; ++ai)
#pragma unroll
            for (int m = 0; m < 4; ++m) { bf16_t* rowp = O + (size_t)(row0 + ai * HALF + m * 16) * ldc + col0;
#pragma unroll
                for (int bj = 0; bj < 2; ++bj) { const f32x4 v0 = acc[ai][bj][m][0], v1 = acc[ai][bj][m][1];
                    u32x4 w; w.x = cvt_pk_bf16(v0[0], v0[1]); w.y = cvt_pk_bf16(v0[2], v0[3]); w.z = cvt_pk_bf16(v1[0], v1[1]); w.w = cvt_pk_bf16(v1[2], v1[3]);
                    *(u32x4*)(rowp + bj * HALF) = w; } }
    }
};
template <bool FIRST> struct EpiGate {
    static constexpr bool PERM = true;
    bf16_t* Y; int ldy; const bf16_t* Gt; int ldg;
    __device__ __forceinline__ void operator()(const f32x4 (&acc)[2][2][4][2], const Unit& u, int wr, int wc, int fr, int fq) const {
        const int row0 = u.pm * BM + wr * 64 + fr, col0 = u.pn * BM + wc * 32 + 8 * fq;
#pragma unroll
        for (int ai = 0; ai < 2; ++ai)
#pragma unroll
        for (int mh = 0; mh < 2; ++mh) {
            u32x4 g[2][2], y[2][2];
#pragma unroll
            for (int mm = 0; mm < 2; ++mm)
#pragma unroll
                for (int bj = 0; bj < 2; ++bj) { const size_t r = (size_t)(row0 + ai * HALF + (mh * 2 + mm) * 16);
                    g[mm][bj] = *(const u32x4*)(Gt + r * ldg + col0 + bj * HALF);
                    if (!FIRST) y[mm][bj] = *(const u32x4*)(Y + r * ldy + col0 + bj * HALF); }
#pragma unroll
            for (int mm = 0; mm < 2; ++mm)
#pragma unroll
                for (int bj = 0; bj < 2; ++bj) { const int m = mh * 2 + mm; const size_t r = (size_t)(row0 + ai * HALF + m * 16); const f32x4 v0 = acc[ai][bj][m][0], v1 = acc[ai][bj][m][1]; const u32x4 gg = g[mm][bj];
                    float o[8];
                    o[0] = sigmoidf_(bflo(gg.x)) * v0[0]; o[1] = sigmoidf_(bfhi(gg.x)) * v0[1]; o[2] = sigmoidf_(bflo(gg.y)) * v0[2]; o[3] = sigmoidf_(bfhi(gg.y)) * v0[3];
                    o[4] = sigmoidf_(bflo(gg.z)) * v1[0]; o[5] = sigmoidf_(bfhi(gg.z)) * v1[1]; o[6] = sigmoidf_(bflo(gg.w)) * v1[2]; o[7] = sigmoidf_(bfhi(gg.w)) * v1[3];
                    if (!FIRST) { const u32x4 yy = y[mm][bj];
                        o[0] += bflo(yy.x); o[1] += bfhi(yy.x); o[2] += bflo(yy.y); o[3] += bfhi(yy.y); o[4] += bflo(yy.z); o[5] += bfhi(yy.z); o[6] += bflo(yy.w); o[7] += bfhi(yy.w); }
                    u32x4 w; w.x = cvt_pk_bf16(o[0], o[1]); w.y = cvt_pk_bf16(o[2], o[3]); w.z = cvt_pk_bf16(o[4], o[5]); w.w = cvt_pk_bf16(o[6], o[7]);
                    *(u32x4*)(Y + r * ldy + col0 + bj * HALF) = w; }
        }
    }
};
struct EpiResid {
    static constexpr bool PERM = false;
    float* X; int ldx; const float* gate; float gscale;
    __device__ __forceinline__ void operator()(const f32x4 (&acc)[2][2][4][2], const Unit& u, int wr, int wc, int fr, int fq) const {
        const int row0 = u.pm * BM + wr * 64 + fr, col0 = u.pn * BM + wc * 32 + 4 * fq;
        const int sel = (u.pm % 33 == 0) ? 2 : (u.pm / 33);
        const float* gp = gate + (size_t)sel * 12288 + col0;
        f32x4 gv[2][2];
#pragma unroll
        for (int bj = 0; bj < 2; ++bj)
#pragma unroll
            for (int n = 0; n < 2; ++n) gv[bj][n] = *(const f32x4*)(gp + bj * HALF + n * 16) * gscale;
#pragma unroll
        for (int ai = 0; ai < 2; ++ai)
#pragma unroll
            for (int mh = 0; mh < 2; ++mh) {
                f32x4 x[2][2][2];
#pragma unroll
                for (int mm = 0; mm < 2; ++mm)
#pragma unroll
                    for (int bj = 0; bj < 2; ++bj)
#pragma unroll
                        for (int n = 0; n < 2; ++n) x[mm][bj][n] = *(const f32x4*)(X + (size_t)(row0 + ai * HALF + (mh * 2 + mm) * 16) * ldx + col0 + bj * HALF + n * 16);
#pragma unroll
                for (int mm = 0; mm < 2; ++mm)
#pragma unroll
                    for (int bj = 0; bj < 2; ++bj)
#pragma unroll
                        for (int n = 0; n < 2; ++n) *(f32x4*)(X + (size_t)(row0 + ai * HALF + (mh * 2 + mm) * 16) * ldx + col0 + bj * HALF + n * 16) = x[mm][bj][n] + gv[bj][n] * acc[ai][bj][mh * 2 + mm][n];
            }
    }
};

template <class Epi, class Sched>
__device__ __forceinline__ void gemm_phase(LAS unsigned char* lds, const int tid, const Gemm g, const Sched& S, const Epi& E) {
    const int wid = __builtin_amdgcn_readfirstlane(tid >> 6), lane = tid & 63, wr = wid >> 2, wc = wid & 3, fr = lane & 15, fq = lane >> 4;
    const int K = g.K, nt = K / BK, lda = g.lda, ldb = g.ldb;
    unsigned voffA[2], voffB[2];
#pragma unroll
    for (int i = 0; i < 2; ++i) { int R, C; stage_rc(tid * 16 + i * 8192, R, C); const int Rb = Epi::PERM ? ((R & ~31) + perm32(R & 31)) : R;
        voffA[i] = (unsigned)(R * lda + C) * 2u; voffB[i] = (unsigned)(Rb * ldb + C) * 2u; }
    const size_t kstep = (size_t)(BK * 2);
    const size_t hstepA = (size_t)HALF * lda * 2, hstepB = (size_t)HALF * ldb * 2;
    const size_t tstepA = 2 * hstepA, tstepB = 2 * hstepB;
    const unsigned ldsw = (unsigned)wid * 1024u;
    const int aoff = lds_byte(wr * 64 + fr, fq * 8), boff = lds_byte(wc * 32 + fr, fq * 8);
#define PG8_SA(b, h) (((b) * 2 + (h)) * HTB)
#define PG8_SB(b, h) ((4 + (b) * 2 + (h)) * HTB)
#define PG8_STAGE(bufoff, gbase, voff) do { _Pragma("unroll") for (int _i = 0; _i < 2; ++_i) \
        __builtin_amdgcn_global_load_lds((const unsigned*)((const char*)(gbase) + (voff)[_i]), (LAS unsigned*)(lds + (bufoff) + ldsw + _i * 8192), 16, 0, 0); } while (0)
#define PG8_LDA(dst, b, h) do { _Pragma("unroll") for (int m = 0; m < 4; ++m) _Pragma("unroll") for (int k = 0; k < 2; ++k) dst[m][k] = *(const LAS bf16x8*)(lds + PG8_SA(b, h) + aoff + m * 2048 + k * 1024); } while (0)
#define PG8_LDB(dst, b, h) do { _Pragma("unroll") for (int n = 0; n < 2; ++n) _Pragma("unroll") for (int k = 0; k < 2; ++k) dst[n][k] = *(const LAS bf16x8*)(lds + PG8_SB(b, h) + boff + n * 2048 + k * 1024); } while (0)
#define PG8_MMA(ai, bj, At, Bt) do { __builtin_amdgcn_s_setprio(1); _Pragma("unroll") for (int m = 0; m < 4; ++m) _Pragma("unroll") for (int n = 0; n < 2; ++n) _Pragma("unroll") for (int k = 0; k < 2; ++k) \
        acc[ai][bj][m][n] = __builtin_amdgcn_mfma_f32_16x16x32_bf16(Bt[n][k], At[m][k], acc[ai][bj][m][n], 0, 0, 0); __builtin_amdgcn_s_setprio(0); } while (0)
#define PG8_WAIT_V(n) asm volatile("s_waitcnt vmcnt(" #n ")" ::: "memory")
#define PG8_WAIT_L(n) asm volatile("s_waitcnt lgkmcnt(" #n ")" ::: "memory")
#define PG8_BAR __builtin_amdgcn_s_barrier()
#define PG8_SCHED __builtin_amdgcn_sched_barrier(0)
    Unit cur, nxt; int ui = 0;
    if (!S.next(0, cur)) return;
    f32x4 acc[2][2][4][2];
#pragma unroll
    for (int a = 0; a < 2; ++a)
#pragma unroll
        for (int b = 0; b < 2; ++b)
#pragma unroll
            for (int m = 0; m < 4; ++m)
#pragma unroll
                for (int n = 0; n < 2; ++n) acc[a][b][m][n] = (f32x4){0.f, 0.f, 0.f, 0.f};
    bf16x8 At[4][2], B0[2][2], B1[2][2];
    const char* cA = (const char*)g.A + (size_t)cur.pm * tstepA; const char* cB = (const char*)g.Bt + (size_t)cur.pn * tstepB;
    PG8_STAGE(PG8_SB(0, 0), cB, voffB); PG8_STAGE(PG8_SA(0, 0), cA, voffA); PG8_STAGE(PG8_SB(0, 1), cB + hstepB, voffB); PG8_STAGE(PG8_SA(0, 1), cA + hstepA, voffA);
    if (wr == 1) PG8_BAR;
    PG8_WAIT_V(4); PG8_BAR;
    PG8_STAGE(PG8_SB(1, 0), cB + kstep, voffB); PG8_STAGE(PG8_SA(1, 0), cA + kstep, voffA); PG8_STAGE(PG8_SB(1, 1), cB + hstepB + kstep, voffB);
    PG8_WAIT_V(6); PG8_BAR;
    for (;;) {
        const bool has_next = S.next(ui + 1, nxt);
        const char* nA = has_next ? (const char*)g.A + (size_t)nxt.pm * tstepA : cA; const char* nB = has_next ? (const char*)g.Bt + (size_t)nxt.pn * tstepB : cB;
        for (int t = 0; t < nt; t += 2) {
            const bool last = (t == nt - 2);
            const char* a1 = cA + (size_t)(t + 1) * kstep;
            const char* a2 = last ? nA : cA + (size_t)(t + 2) * kstep; const char* b2 = last ? nB : cB + (size_t)(t + 2) * kstep;
            const char* a3 = a2 + kstep; const char* b3 = b2 + kstep;
            PG8_LDB(B0, 0, 0); PG8_SCHED; PG8_LDA(At, 0, 0); PG8_STAGE(PG8_SA(1, 1), a1 + hstepA, voffA);
            PG8_WAIT_L(8); PG8_BAR; PG8_WAIT_L(0); PG8_MMA(0, 0, At, B0); PG8_BAR; PG8_SCHED;
            PG8_LDB(B1, 0, 1); PG8_STAGE(PG8_SB(0, 0), b2, voffB);
            PG8_BAR; PG8_WAIT_L(0); PG8_MMA(0, 1, At, B1); PG8_BAR;
            PG8_LDA(At, 0, 1); PG8_STAGE(PG8_SA(0, 0), a2, voffA);
            PG8_BAR; PG8_WAIT_L(0); PG8_MMA(1, 0, At, B0); PG8_BAR; PG8_SCHED;
            PG8_STAGE(PG8_SB(0, 1), b2 + hstepB, voffB);
            PG8_WAIT_V(6); PG8_BAR; PG8_MMA(1, 1, At, B1); PG8_BAR;
            PG8_LDB(B0, 1, 0); PG8_SCHED; PG8_LDA(At, 1, 0); PG8_STAGE(PG8_SA(0, 1), a2 + hstepA, voffA);
            PG8_WAIT_L(8); PG8_BAR; PG8_WAIT_L(0); PG8_MMA(0, 0, At, B0); PG8_BAR; PG8_SCHED;
            PG8_LDB(B1, 1, 1); PG8_STAGE(PG8_SB(1, 0), b3, voffB);
            PG8_BAR; PG8_WAIT_L(0); PG8_MMA(0, 1, At, B1); PG8_BAR;
            PG8_LDA(At, 1, 1); PG8_STAGE(PG8_SA(1, 0), a3, voffA);
            PG8_BAR; PG8_WAIT_L(0); PG8_MMA(1, 0, At, B0); PG8_BAR; PG8_SCHED;
            PG8_STAGE(PG8_SB(1, 1), b3 + hstepB, voffB);
            PG8_WAIT_V(6); PG8_BAR; PG8_MMA(1, 1, At, B1); PG8_BAR;
        }
        E(acc, cur, wr, wc, fr, fq);
        if (!has_next) break;
#pragma unroll
        for (int a = 0; a < 2; ++a)
#pragma unroll
            for (int b = 0; b < 2; ++b)
#pragma unroll
                for (int m = 0; m < 4; ++m)
#pragma unroll
                    for (int n = 0; n < 2; ++n) acc[a][b][m][n] = (f32x4){0.f, 0.f, 0.f, 0.f};
        cur = nxt; cA = nA; cB = nB; ++ui;
    }
    PG8_WAIT_V(0);
    if (wr == 0) PG8_BAR;
    PG8_BAR;
#undef PG8_SA
#undef PG8_SB
#undef PG8_STAGE
#undef PG8_LDA
#undef PG8_LDB
#undef PG8_MMA
#undef PG8_WAIT_V
#undef PG8_WAIT_L
#undef PG8_BAR
#undef PG8_SCHED
}
}

struct Args { const float* in[30]; float* out; unsigned char* ws; int ph_lo, ph_hi; };
enum { I_X = 0, I_C, I_CTX, I_CCTX, I_WMOD, I_BMOD, I_N1G, I_WIN, I_QNG, I_KNG, I_WA2F, I_BAF, I_WA2B, I_BAB, I_ONG, I_MQNG, I_WUQ, I_MKVNG, I_WUKV,
       I_WBRA, I_WBRL, I_WBRM, I_WOUT, I_N2G, I_PWQ, I_PK1, I_PK2, I_PU, I_PV, I_FG };
typedef const float* cfp_t;
struct Ctx {
    const __attribute__((address_space(4))) cfp_t* in; float* out; unsigned char* ws; LAS unsigned char* lds;
    int tid, lane, wid, G, bid;
};
#define WSP(T, off) ((T*)(C.ws + (off)))
#define INP(i) (C.in[(i)])
__device__ __forceinline__ unsigned long long launder_u64(unsigned long long w) {
    unsigned lo = (unsigned)w, hi = (unsigned)(w >> 32); asm volatile("" : "+v"(lo), "+v"(hi));
    lo = __builtin_amdgcn_readfirstlane(lo); hi = __builtin_amdgcn_readfirstlane(hi); return ((unsigned long long)hi << 32) | lo;
}
__device__ __forceinline__ Ctx launder(const Ctx& C0) {
    Ctx R = C0; int t = C0.tid; asm volatile("" : "+v"(t)); R.tid = t; R.lane = t & 63; R.wid = __builtin_amdgcn_readfirstlane(t >> 6);
    R.ws = (unsigned char*)launder_u64((unsigned long long)C0.ws);
    R.in = (const __attribute__((address_space(4))) cfp_t*)launder_u64((unsigned long long)C0.in);
    unsigned l = (unsigned)(uintptr_t)C0.lds; asm volatile("" : "+v"(l)); l = __builtin_amdgcn_readfirstlane(l); R.lds = (LAS unsigned char*)(uintptr_t)l;
    return R;
}

__device__ __forceinline__ const float* src_row(const Ctx& C, int r) {
    const int b = r / RPB, j = r % RPB;
    return j < CTXL ? INP(I_CTX) + ((size_t)b * CTXL + j) * DM : INP(I_X) + ((size_t)b * SEQ + (j - CTXL)) * DM;
}
__device__ __forceinline__ int mod_sel(int r) { const int b = r / RPB, j = r % RPB; return j < CTXL ? 2 : b; }

__device__ __forceinline__ void phase_modv(const Ctx& C) {
    LAS float* sc = (LAS float*)C.lds;
    LAS float* red = (LAS float*)(C.lds + 3 * 2048 * 4);
    for (int i = C.tid; i < 3 * DM; i += NTHREADS) { const int r = i / DM, k = i % DM; const float v = r < 2 ? INP(I_C)[r * DM + k] : INP(I_CCTX)[k]; sc[i] = siluf_(v); }
    __syncthreads();
    float* modv = WSP(float, WS_MODV);
    const int kq = C.tid / 12, c4 = C.tid % 12;
    for (int item = C.bid; item < 2 * 256; item += C.G) {
        const int l = item / 256, cg = item % 256;
        float acc[3][4];
#pragma unroll
        for (int r = 0; r < 3; ++r)
#pragma unroll
            for (int j = 0; j < 4; ++j) acc[r][j] = 0.f;
        if (kq < 42) {
            const float* wp = INP(I_WMOD) + (size_t)l * DM * 12288 + 48 * cg + 4 * c4;
            for (int k = kq; k < DM; k += 42) {
                const f32x4 w = *(const f32x4*)(wp + (size_t)k * 12288);
#pragma unroll
                for (int r = 0; r < 3; ++r) { const float s = sc[r * DM + k];
#pragma unroll
                    for (int j = 0; j < 4; ++j) acc[r][j] += s * w[j]; }
            }
#pragma unroll
            for (int r = 0; r < 3; ++r)
#pragma unroll
                for (int j = 0; j < 4; ++j) red[kq * 144 + r * 48 + c4 * 4 + j] = acc[r][j];
        }
        __syncthreads();
        if (C.tid < 144) { float s = 0.f; for (int q = 0; q < 42; ++q) s += red[q * 144 + C.tid];
            const int r = C.tid / 48, cc = C.tid % 48;
            modv[((size_t)l * 3 + r) * 12288 + 48 * cg + cc] = s + INP(I_BMOD)[(size_t)l * 12288 + 48 * cg + cc]; }
        __syncthreads();
    }
}
__device__ __forceinline__ void phase_tables(const Ctx& C) {
    float* ta = WSP(float, WS_TABA); float* tm = WSP(float, WS_TABM);
    for (int i = C.bid * NTHREADS + C.tid; i < 128 * 32 + 128 * 16; i += C.G * NTHREADS) {
        if (i < 128 * 32) { const int pos = i / 32, f = i % 32; const float inv = exp2f(-(float)f * (13.287712379549449f / 32.0f)); const float a = (float)pos * inv;
            ta[i] = cosf(a); ta[128 * 32 + i] = sinf(a); }
        else { const int k = i - 128 * 32, pos = k / 16, f = k % 16; const float inv = exp2f(-(float)f * (13.287712379549449f / 16.0f)); const float a = (float)pos * inv;
            tm[k] = cosf(a); tm[128 * 16 + k] = sinf(a); }
    }
}
__device__ __forceinline__ void transpose_cvt(const Ctx& C, const float* src, int K, int N, bf16_t* dst, int Npad, int& item) {
    LAS float* tile = (LAS float*)C.lds;
    const int tk = K / 64, tn = Npad / 64, ntile = tk * tn;
    const int t0 = ((C.bid - item % C.G) + C.G) % C.G; item += ntile;
    for (int t = t0; t < ntile; t += C.G) {
        const int k0 = (t / tn) * 64, n0 = (t % tn) * 64;
#pragma unroll
        for (int p = 0; p < 2; ++p) { const int kk = (C.tid >> 4) + p * 32, nn = (C.tid & 15) * 4;
            f32x4 v = (f32x4){0.f, 0.f, 0.f, 0.f};
            if (n0 + nn < N) v = *(const f32x4*)(src + (size_t)(k0 + kk) * N + n0 + nn);
#pragma unroll
            for (int j = 0; j < 4; ++j) tile[kk * 65 + nn + j] = v[j]; }
        __syncthreads();
        { const int n = C.tid >> 3, k8 = (C.tid & 7) * 8; float v[8];
#pragma unroll
          for (int j = 0; j < 8; ++j) v[j] = tile[(k8 + j) * 65 + n];
          u32x4 w; w.x = cvt_pk_bf16(v[0], v[1]); w.y = cvt_pk_bf16(v[2], v[3]); w.z = cvt_pk_bf16(v[4], v[5]); w.w = cvt_pk_bf16(v[6], v[7]);
          *(u32x4*)(dst + (size_t)(n0 + n) * K + k0 + k8) = w; }
        __syncthreads();
    }
}
__device__ __forceinline__ void cvt_plain(const Ctx& C, const float* src, bf16_t* dst, size_t n8) {
    for (size_t i = (size_t)C.bid * NTHREADS + C.tid; i < n8; i += (size_t)C.G * NTHREADS) {
        const f32x4 a = *(const f32x4*)(src + i * 8), b = *(const f32x4*)(src + i * 8 + 4);
        u32x4 w; w.x = cvt_pk_bf16(a[0], a[1]); w.y = cvt_pk_bf16(a[2], a[3]); w.z = cvt_pk_bf16(b[0], b[1]); w.w = cvt_pk_bf16(b[2], b[3]);
        *(u32x4*)(dst + i * 8) = w;
    }
}
__device__ __forceinline__ void phase_cvt_mixer_weights(const Ctx& C, int l) {
    int item = 0;
    transpose_cvt(C, INP(I_WIN) + (size_t)l * DM * IN_COLS, DM, IN_COLS, WSP(bf16_t, WS_WIN), NP, item);
    transpose_cvt(C, INP(I_WUQ) + (size_t)l * 512 * 1536, 512, 1536, WSP(bf16_t, WS_WUQ), 1536, item);
    transpose_cvt(C, INP(I_WUKV) + (size_t)l * 512 * 2048, 512, 2048, WSP(bf16_t, WS_WUKV), 2048, item);
    transpose_cvt(C, INP(I_WBRA) + (size_t)l * 1024 * 2048, 1024, 2048, WSP(bf16_t, WS_WBR), 2048, item);
    transpose_cvt(C, INP(I_WBRL) + (size_t)l * 1024 * 2048, 1024, 2048, WSP(bf16_t, WS_WBR) + (size_t)2048 * 1024, 2048, item);
    transpose_cvt(C, INP(I_WBRM) + (size_t)l * 1024 * 2048, 1024, 2048, WSP(bf16_t, WS_WBR) + (size_t)2 * 2048 * 1024, 2048, item);
    transpose_cvt(C, INP(I_WOUT) + (size_t)l * 2048 * 2048, 2048, 2048, WSP(bf16_t, WS_WOUT), 2048, item);
    transpose_cvt(C, INP(I_PWQ) + (size_t)l * 2048 * 2048, 2048, 2048, WSP(bf16_t, WS_WQ), 2048, item);
    cvt_plain(C, INP(I_PK1) + (size_t)l * 8 * 128 * 128, WSP(bf16_t, WS_K1), 8 * 128 * 128 / 8);
    cvt_plain(C, INP(I_PK2) + (size_t)l * 8 * 128 * 128, WSP(bf16_t, WS_K2), 8 * 128 * 128 / 8);
}
__device__ __forceinline__ void phase_cvt_peer_tables(const Ctx& C, int l) {
    const int lane = C.lane;
    for (int row = C.bid * 8 + C.wid; row < NEXP; row += C.G * 8) {
#pragma unroll 1
        for (int tb = 0; tb < 2; ++tb) {
            const float* src = (tb ? INP(I_PV) : INP(I_PU)) + ((size_t)l * NEXP + row) * DM + lane * 16;
            f32x4 x[8]; float amax = 0.f;
#pragma unroll
            for (int c = 0; c < 2; ++c)
#pragma unroll
                for (int q = 0; q < 4; ++q) { x[c * 4 + q] = *(const f32x4*)(src + c * 1024 + q * 4);
                    amax = fmaxf(amax, fmaxf(fmaxf(fabsf(x[c * 4 + q][0]), fabsf(x[c * 4 + q][1])), fmaxf(fabsf(x[c * 4 + q][2]), fabsf(x[c * 4 + q][3])))); }
#pragma unroll
            for (int o = 32; o >= 1; o >>= 1) amax = fmaxf(amax, __shfl_xor(amax, o));
            const float sc = amax > 0.f ? 224.0f / amax : 1.0f, inv = amax > 0.f ? amax * (1.0f / 224.0f) : 1.0f;
            unsigned char* dst = C.ws + (tb ? WS_V8 : WS_U8) + (size_t)(lane >> 3) * ((size_t)NEXP * 128) + (size_t)row * 128 + (lane & 7) * 16;
#pragma unroll
            for (int c = 0; c < 2; ++c) { u32x4 w;
#pragma unroll
                for (int q = 0; q < 4; ++q) { const f32x4 v = x[c * 4 + q] * sc; int p = __builtin_amdgcn_cvt_pk_fp8_f32(v[0], v[1], 0, false); p = __builtin_amdgcn_cvt_pk_fp8_f32(v[2], v[3], p, true); w[q] = (unsigned)p; }
                *(u32x4*)(dst + (size_t)c * 8 * ((size_t)NEXP * 128)) = w; }
            if (lane == 0) WSP(float, tb ? WS_SCV : WS_SCU)[row] = inv;
        }
    }
}

template <bool FIRST> __device__ __forceinline__ void phase_norm_mod(const Ctx& C, const float* gvec, const float* modl  , int shift_off, int scale_off) {
    float* xs = WSP(float, WS_XS); bf16_t* hb = WSP(bf16_t, WS_HB);
    for (int r = C.bid * 8 + C.wid; r < TT; r += C.G * 8) {
        const float* xr = FIRST ? src_row(C, r) : xs + (size_t)r * DM;
        const float* mv = modl + (size_t)mod_sel(r) * 12288;
        f32x4 v[8]; float ss = 0.f;
#pragma unroll
        for (int c = 0; c < 4; ++c) { v[2 * c] = *(const f32x4*)(xr + c * 512 + C.lane * 8); v[2 * c + 1] = *(const f32x4*)(xr + c * 512 + C.lane * 8 + 4); }
#pragma unroll
        for (int c = 0; c < 8; ++c) ss += v[c][0] * v[c][0] + v[c][1] * v[c][1] + v[c][2] * v[c][2] + v[c][3] * v[c][3];
        ss = wave_sum(ss);
        const float rs = rsqrtf(ss * (1.0f / DM) + NORM_EPS);
#pragma unroll
        for (int c = 0; c < 4; ++c) { const int col = c * 512 + C.lane * 8;
            if (FIRST) { *(f32x4*)(xs + (size_t)r * DM + col) = v[2 * c]; *(f32x4*)(xs + (size_t)r * DM + col + 4) = v[2 * c + 1]; }
            float o[8];
#pragma unroll
            for (int h = 0; h < 2; ++h) { const f32x4 g = *(const f32x4*)(gvec + col + 4 * h), s = *(const f32x4*)(mv + scale_off + col + 4 * h), t = *(const f32x4*)(mv + shift_off + col + 4 * h);
#pragma unroll
                for (int j = 0; j < 4; ++j) o[4 * h + j] = v[2 * c + h][j] * rs * g[j] * (1.0f + s[j]) + t[j]; }
            u32x4 w; w.x = cvt_pk_bf16(o[0], o[1]); w.y = cvt_pk_bf16(o[2], o[3]); w.z = cvt_pk_bf16(o[4], o[5]); w.w = cvt_pk_bf16(o[6], o[7]);
            *(u32x4*)(hb + (size_t)r * DM + col) = w; }
    }
}

__device__ __forceinline__ void phase_post_p(const Ctx& C, int l) {
    bf16_t* P = WSP(bf16_t, WS_P); const float* ta = WSP(float, WS_TABA); const float* tm = WSP(float, WS_TABM);
    const float* qg = INP(I_QNG) + l * 128; const float* kg = INP(I_KNG) + l * 128;
    const float* mqg = INP(I_MQNG) + l * 512; const float* mkvg = INP(I_MKVNG) + l * 512;
    const int lane = C.lane;
    const float qg1 = qg[lane], qg2 = qg[lane + 64], kg1 = kg[lane], kg2 = kg[lane + 64];
    for (int r = C.bid * 8 + C.wid; r < TT; r += C.G * 8) {
        bf16_t* pr = P + (size_t)r * NP;
        const int j = r % RPB; const bool lat = j >= CTXL; const int pos = lat ? j - CTXL : 0, ri = pos >> 6, ci = pos & 63;
        float cs = 1.f, sn = 0.f;
        if (lat) { const int p = lane < 32 ? ri : ci, f = lane & 31; cs = ta[p * 32 + f]; sn = ta[128 * 32 + p * 32 + f]; }
#pragma unroll
        for (int h = 0; h < 10; ++h) {
            bf16_t* hp = pr + (h < 8 ? C_AQ + h * 128 : C_AK + (h - 8) * 128);
            const float x1 = bf2f(hp[lane]), x2 = bf2f(hp[lane + 64]);
            const float ss = wave_sum(x1 * x1 + x2 * x2);
            const float rs = rsqrtf(ss * (1.0f / 128.0f) + NORM_EPS);
            const float y1 = x1 * rs * (h < 8 ? qg1 : kg1), y2 = x2 * rs * (h < 8 ? qg2 : kg2);
            hp[lane] = f2bf(y1 * cs - y2 * sn); hp[lane + 64] = f2bf(y2 * cs + y1 * sn);
        }
#pragma unroll
        for (int s = 0; s < 2; ++s) {
            bf16_t* sp = pr + (s == 0 ? C_MCQ : C_MCKV) + lane * 8; const float* gg = (s == 0 ? mqg : mkvg) + lane * 8;
            const u32x4 w = *(const u32x4*)sp; float x[8] = {bflo(w.x), bfhi(w.x), bflo(w.y), bfhi(w.y), bflo(w.z), bfhi(w.z), bflo(w.w), bfhi(w.w)};
            float ss = 0.f;
#pragma unroll
            for (int i = 0; i < 8; ++i) ss += x[i] * x[i];
            ss = wave_sum(ss);
            const float rs = rsqrtf(ss * (1.0f / 512.0f) + NORM_EPS);
#pragma unroll
            for (int i = 0; i < 8; ++i) x[i] = x[i] * rs * gg[i];
            u32x4 o; o.x = cvt_pk_bf16(x[0], x[1]); o.y = cvt_pk_bf16(x[2], x[3]); o.z = cvt_pk_bf16(x[4], x[5]); o.w = cvt_pk_bf16(x[6], x[7]);
            *(u32x4*)sp = o;
        }
        if (lat) { bf16_t* kp = pr + C_MKR; const int i = lane & 31; const float x1 = bf2f(kp[i]), x2 = bf2f(kp[i + 32]);
            const int p = i < 16 ? ri : ci, f = i & 15; const float c2 = tm[p * 16 + f], s2 = tm[128 * 16 + p * 16 + f];
            if (lane < 32) { kp[i] = f2bf(x1 * c2 - x2 * s2); kp[i + 32] = f2bf(x2 * c2 + x1 * s2); } }
    }
}

namespace att {
constexpr int NW = 8, QBLK = 32, KVBLK = 64, DV = 128;
constexpr float THR = 8.f;
#define SBAR() __builtin_amdgcn_sched_barrier(0)
__device__ __forceinline__ int crow(int r, int hi) { return (r & 3) + 8 * (r >> 2) + 4 * hi; }
template <int DQ> struct Cf {
    static constexpr int ND0 = DQ / 16, KROWB = DQ * 2, SHM_K = KVBLK * DQ * 2, SHM_V = KVBLK * DV * 2, SHM = 2 * SHM_V + 2 * SHM_K + NW * 64 * 4;
    static constexpr float SCALE = DQ == 128 ? 0.088388347648318440f : 0.072168783648703220f;
    __device__ static __forceinline__ int kswz(int row, int colB) { return row * KROWB + (colB ^ ((row & 7) << 4)); }
};
template <int DQ> __device__ __forceinline__ void partialSM(f32x16& p0, f32x16& p1, float& m_reg, float& mn, float& alpha) {
    constexpr float SC = Cf<DQ>::SCALE, Cc = SC * 1.4426950408889634f;
    float pmax = p0[0];
#pragma unroll
    for (int r = 1; r < 16; ++r) pmax = fmaxf(pmax, p0[r]);
#pragma unroll
    for (int r = 0; r < 16; ++r) pmax = fmaxf(pmax, p1[r]);
    { auto rr = __builtin_amdgcn_permlane32_swap(__float_as_uint(pmax), __float_as_uint(pmax), false, false);
      pmax = fmaxf(__uint_as_float(rr[0]), __uint_as_float(rr[1])); }
    if (__builtin_expect(__all(pmax - m_reg <= THR / SC), 1)) { mn = m_reg; alpha = 1.f; }
    else { mn = fmaxf(m_reg, pmax); alpha = __builtin_amdgcn_exp2f((m_reg - mn) * Cc); m_reg = mn; }
    const float mnC = -mn * Cc;
#pragma unroll
    for (int r = 0; r < 16; ++r) p0[r] = fmaf(p0[r], Cc, mnC);
#pragma unroll
    for (int r = 0; r < 16; ++r) p1[r] = fmaf(p1[r], Cc, mnC);
#pragma unroll
    for (int r = 0; r < 16; ++r) p0[r] = __builtin_amdgcn_exp2f(p0[r]);
}
__device__ __forceinline__ void finishSM(f32x16& p0, f32x16& p1, float alpha, float& l_reg, bf16x8& pa0, bf16x8& pa1, bf16x8& pa2, bf16x8& pa3) {
#pragma unroll
    for (int r = 0; r < 16; ++r) p1[r] = __builtin_amdgcn_exp2f(p1[r]);
    float ps = 0;
#pragma unroll
    for (int r = 0; r < 16; ++r) ps += p0[r];
#pragma unroll
    for (int r = 0; r < 16; ++r) ps += p1[r];
    { auto rr = __builtin_amdgcn_permlane32_swap(__float_as_uint(ps), __float_as_uint(ps), false, false);
      ps = __uint_as_float(rr[0]) + __uint_as_float(rr[1]); }
    l_reg = l_reg * alpha + ps;
#define PK4(P, BASE, OUT) do { unsigned a0 = cvt_pk_bf16(P[BASE + 0], P[BASE + 1]), a1 = cvt_pk_bf16(P[BASE + 2], P[BASE + 3]);   \
    unsigned b0 = cvt_pk_bf16(P[BASE + 4], P[BASE + 5]), b1 = cvt_pk_bf16(P[BASE + 6], P[BASE + 7]);                              \
    auto r0 = __builtin_amdgcn_permlane32_swap(a0, b0, false, false); auto r1 = __builtin_amdgcn_permlane32_swap(a1, b1, false, false); \
    u32x4 w = {r0[0], r1[0], r0[1], r1[1]}; OUT = *reinterpret_cast<bf16x8*>(&w); } while (0)
    PK4(p0, 0, pa0); PK4(p0, 8, pa1); PK4(p1, 0, pa2); PK4(p1, 8, pa3);
#undef PK4
}
template <int DQ> __device__ __forceinline__ void qkt(f32x16& p0, f32x16& p1, const char* Ks, const bf16x8* qr, const char* qx, int r32, int hi) {
    p0 = f32x16{}; p1 = f32x16{};
#pragma unroll
    for (int d0 = 0; d0 < Cf<DQ>::ND0; ++d0) { const int cb = (d0 * 16 + hi * 8) * 2;
        const bf16x8 b0 = *reinterpret_cast<const bf16x8*>(Ks + Cf<DQ>::kswz(r32, cb));
        const bf16x8 b1 = *reinterpret_cast<const bf16x8*>(Ks + Cf<DQ>::kswz(32 + r32, cb));
        constexpr int NQR = DQ == 192 ? 4 : 8;
        bf16x8 q; if (d0 < NQR) q = qr[d0]; else q = *reinterpret_cast<const bf16x8*>(qx + (d0 - NQR) * 1024);
        p0 = __builtin_amdgcn_mfma_f32_32x32x16_bf16(b0, q, p0, 0, 0, 0);
        p1 = __builtin_amdgcn_mfma_f32_32x32x16_bf16(b1, q, p1, 0, 0, 0); }
}
__device__ __forceinline__ int v_st(int k, int c) { const int kk = (k & ~0xC) | ((k & 4) << 1) | ((k & 8) >> 1); return ((kk >> 3) * 4 + (c >> 5)) * 512 + ((kk & 7) * 32 + (c & 31)) * 2; }
__device__ __forceinline__ int v_rd_base(int lane) { return ((lane & 3) << 3) | (((lane >> 2) & 3) << 6) | (((lane >> 4) & 1) << 5) | (((lane >> 5) & 1) << 8); }
constexpr int v_rd_off(int d0, int ks, int half) { return d0 * 512 + ks * 4096 + half * 2048; }
template <int OFF> __device__ __forceinline__ s16x4 tr_read(int vb) {
    s16x4 r; asm volatile("ds_read_b64_tr_b16 %0, %1 offset:%2" : "=&v"(r) : "v"(vb), "i"(OFF) : "memory"); return r;
}
template <int D0> __device__ __forceinline__ void pv_one(f32x16& od, int vb, bf16x8 pa0, bf16x8 pa1, bf16x8 pa2, bf16x8 pa3) {
    const s16x4 l0 = tr_read<v_rd_off(D0, 0, 0)>(vb), h0 = tr_read<v_rd_off(D0, 0, 1)>(vb), l1 = tr_read<v_rd_off(D0, 1, 0)>(vb), h1 = tr_read<v_rd_off(D0, 1, 1)>(vb);
    const s16x4 l2 = tr_read<v_rd_off(D0, 2, 0)>(vb), h2 = tr_read<v_rd_off(D0, 2, 1)>(vb), l3 = tr_read<v_rd_off(D0, 3, 0)>(vb), h3 = tr_read<v_rd_off(D0, 3, 1)>(vb);
    asm volatile("s_waitcnt lgkmcnt(0)" ::: "memory"); SBAR();
#define PK(L, H) (bf16x8){L[0], L[1], L[2], L[3], H[0], H[1], H[2], H[3]}
    od = __builtin_amdgcn_mfma_f32_32x32x16_bf16(pa0, PK(l0, h0), od, 0, 0, 0);
    od = __builtin_amdgcn_mfma_f32_32x32x16_bf16(pa1, PK(l1, h1), od, 0, 0, 0);
    od = __builtin_amdgcn_mfma_f32_32x32x16_bf16(pa2, PK(l2, h2), od, 0, 0, 0);
    od = __builtin_amdgcn_mfma_f32_32x32x16_bf16(pa3, PK(l3, h3), od, 0, 0, 0);
#undef PK
}
__device__ __forceinline__ void pv_d0(f32x16* o, int vb, bf16x8 pa0, bf16x8 pa1, bf16x8 pa2, bf16x8 pa3) {
    pv_one<0>(o[0], vb, pa0, pa1, pa2, pa3); pv_one<1>(o[1], vb, pa0, pa1, pa2, pa3); pv_one<2>(o[2], vb, pa0, pa1, pa2, pa3); pv_one<3>(o[3], vb, pa0, pa1, pa2, pa3);
}
__device__ __forceinline__ bf16x8 ld8(const bf16_t* p) { return *reinterpret_cast<const bf16x8*>(p); }

template <int DQ, int SD>
__device__ __forceinline__ void attn_body(const bf16_t* __restrict__ Qb, int ldq, const bf16_t* __restrict__ Kn, int ldkn, const bf16_t* __restrict__ Kr, int ldkr,
                                          const bf16_t* __restrict__ Vh, int ldv, bf16_t* __restrict__ Ob, int ldo, int seq, bool rope_q, int pos0, const float* __restrict__ tabM, char* lds, const int tid) {
    using CF = Cf<DQ>; constexpr int ND0 = CF::ND0, SHM_V = CF::SHM_V, SHM_K = CF::SHM_K;
    const int wid = tid >> 6, lane = tid & 63, r32 = lane & 31, hi = lane >> 5;
    char* V_lds = lds; char* K_lds = lds + 2 * SHM_V;
    float* ws = (float*)(lds + 2 * SHM_V + 2 * SHM_K) + wid * 64; float* li_l = ws; float* al_l = ws + 32;
    constexpr int NQR = DQ == 192 ? 4 : 8;
    float m_reg = -1e30f, l_reg = 0; f32x16 o[4] = {}; bf16x8 qr[NQR];
    const bf16_t* Qw = Qb + (long)(wid * QBLK + r32) * ldq + hi * 8;
#pragma unroll
    for (int d0 = 0; d0 < NQR; ++d0) qr[d0] = ld8(Qw + d0 * 16);
    char* qx = lds + CF::SHM + wid * 8192 + lane * 16;
    if constexpr (DQ == 192) {
#pragma unroll
        for (int d0 = 4; d0 < 8; ++d0) *(bf16x8*)(qx + (d0 - 4) * 1024) = ld8(Qw + d0 * 16);
        bf16x8 qe[4];
#pragma unroll
        for (int d0 = 0; d0 < 4; ++d0) qe[d0] = ld8(Qw + (8 + d0) * 16);
        if (rope_q) {
            const int pos = pos0 + wid * QBLK + r32, ri = pos >> 6, ci = pos & 63;
#pragma unroll
            for (int t = 0; t < 2; ++t) { const int p = t == 0 ? ri : ci; const float* tc = tabM + p * 16 + hi * 8; const float* tsn = tabM + 128 * 16 + p * 16 + hi * 8;
                bf16x8 a = qe[t], b = qe[2 + t];
#pragma unroll
                for (int jj = 0; jj < 8; ++jj) { const float x1 = bf2f((bf16_t)a[jj]), x2 = bf2f((bf16_t)b[jj]), c = tc[jj], s = tsn[jj];
                    a[jj] = (short)f2bf(x1 * c - x2 * s); b[jj] = (short)f2bf(x2 * c + x1 * s); }
                qe[t] = a; qe[2 + t] = b; }
        }
#pragma unroll
        for (int d0 = 0; d0 < 4; ++d0) *(bf16x8*)(qx + (4 + d0) * 1024) = qe[d0];
    }
    const int sr = tid >> 4, sc = (tid & 15) * 8, vst0 = v_st(sr, sc), vst1 = v_st(32 + sr, sc);
    const int sr2 = tid >> 3, sc2 = (tid & 7) * 8;
    const int vb0 = (int)(uintptr_t)V_lds + v_rd_base(lane);
    struct { bf16x8 vs0, vs1, ks0, ks1, ks2; } sr_[SD];
    const unsigned offV = (unsigned)(sr * ldv + sc) * 2u, offK = (unsigned)(sr * ldkn + sc) * 2u, offR = (unsigned)(sr2 * ldkr + sc2) * 2u;
#define SLOAD(i, k0) do { const char* vt_ = (const char*)Vh + (size_t)(k0) * ldv * 2; const char* kt_ = (const char*)Kn + (size_t)(k0) * ldkn * 2; \
    sr_[i].vs0 = *(const bf16x8*)(vt_ + offV); sr_[i].vs1 = *(const bf16x8*)(vt_ + (size_t)32 * ldv * 2 + offV); \
    sr_[i].ks0 = *(const bf16x8*)(kt_ + offK); sr_[i].ks1 = *(const bf16x8*)(kt_ + (size_t)32 * ldkn * 2 + offK); \
    if constexpr (DQ == 192) sr_[i].ks2 = *(const bf16x8*)((const char*)Kr + (size_t)(k0) * ldkr * 2 + offR); } while (0)
#define SWRITE(b, i) do { *(bf16x8*)(V_lds + (b) * SHM_V + vst0) = sr_[i].vs0; *(bf16x8*)(V_lds + (b) * SHM_V + vst1) = sr_[i].vs1; const int kc = sc * 2; \
    *(bf16x8*)(K_lds + (b) * SHM_K + CF::kswz(sr, kc)) = sr_[i].ks0; *(bf16x8*)(K_lds + (b) * SHM_K + CF::kswz(32 + sr, kc)) = sr_[i].ks1; \
    if constexpr (DQ == 192) *(bf16x8*)(K_lds + (b) * SHM_K + CF::kswz(sr2, 256 + sc2 * 2)) = sr_[i].ks2; } while (0)
#define SWAIT() do { if constexpr (SD == 1) asm volatile("s_waitcnt vmcnt(0)" ::: "memory"); else if constexpr (DQ == 192) asm volatile("s_waitcnt vmcnt(5)" ::: "memory"); else asm volatile("s_waitcnt vmcnt(4)" ::: "memory"); } while (0)
#define RESC(a) do { if (__any((a) < 1.f)) { if (hi == 0) al_l[r32] = (a); asm volatile("s_waitcnt lgkmcnt(0)" ::: "memory"); \
    _Pragma("unroll") for (int d = 0; d < 4; ++d) _Pragma("unroll") for (int r = 0; r < 16; ++r) o[d][r] *= al_l[crow(r, hi)]; } } while (0)
    f32x16 pA0, pA1, pB0, pB1; float mnA, mnB, alA, alB; bf16x8 pa0, pa1, pa2, pa3; const int NT = seq / KVBLK;
    constexpr int SE = 0, SO = SD - 1;
    SLOAD(SE, 0); asm volatile("s_waitcnt vmcnt(0)" ::: "memory"); SWRITE(0, SE); __syncthreads();
    qkt<DQ>(pA0, pA1, K_lds, qr, qx, r32, hi); partialSM<DQ>(pA0, pA1, m_reg, mnA, alA);
    SLOAD(SO, KVBLK); if constexpr (SD == 2) { if (2 < NT) SLOAD(SE, 2 * KVBLK); }
    SWAIT(); SWRITE(1, SO); __syncthreads();
    for (int j = 1; j + 1 < NT; j += 2) {
        SBAR(); qkt<DQ>(pB0, pB1, K_lds + SHM_K, qr, qx, r32, hi);
        finishSM(pA0, pA1, alA, l_reg, pa0, pa1, pa2, pa3); SBAR();
        SLOAD(SO, (j + SD) * KVBLK); SBAR();
        pv_d0(o, vb0, pa0, pa1, pa2, pa3); partialSM<DQ>(pB0, pB1, m_reg, mnB, alB);
        __syncthreads(); SWAIT(); SWRITE(0, SE);
        RESC(alB); __syncthreads();
        SBAR(); qkt<DQ>(pA0, pA1, K_lds, qr, qx, r32, hi);
        finishSM(pB0, pB1, alB, l_reg, pa0, pa1, pa2, pa3); SBAR();
        if (SD == 1 || j + 3 < NT) SLOAD(SE, (j + 1 + SD) * KVBLK); SBAR();
        pv_d0(o, vb0 + SHM_V, pa0, pa1, pa2, pa3); partialSM<DQ>(pA0, pA1, m_reg, mnA, alA);
        __syncthreads(); SWAIT(); SWRITE(1, SO);
        RESC(alA); __syncthreads();
    }
    SBAR(); qkt<DQ>(pB0, pB1, K_lds + SHM_K, qr, qx, r32, hi);
    finishSM(pA0, pA1, alA, l_reg, pa0, pa1, pa2, pa3); SBAR();
    pv_d0(o, vb0, pa0, pa1, pa2, pa3); partialSM<DQ>(pB0, pB1, m_reg, mnB, alB);
    __syncthreads(); RESC(alB);
    finishSM(pB0, pB1, alB, l_reg, pa0, pa1, pa2, pa3); SBAR();
    pv_d0(o, vb0 + SHM_V, pa0, pa1, pa2, pa3);
    if (hi == 0) li_l[r32] = l_reg; asm volatile("s_waitcnt lgkmcnt(0)" ::: "memory");
    float rli[16];
#pragma unroll
    for (int r = 0; r < 16; ++r) rli[r] = __builtin_amdgcn_rcpf(li_l[crow(r, hi)]);
    bf16_t* Ow = Ob + (long)(wid * QBLK) * ldo;
#pragma unroll
    for (int r = 0; r < 16; ++r) { const int orow = crow(r, hi);
#pragma unroll
        for (int d0 = 0; d0 < 4; ++d0) Ow[(long)orow * ldo + d0 * 32 + r32] = f2bf(o[d0][r] * rli[r]); }
#undef SLOAD
#undef SWRITE
#undef SWAIT
#undef RESC
}
}

template <int KS> __device__ __forceinline__ void mma_xy(f32x16& acc, const LAS bf16_t* X, const LAS bf16_t* Y, int hi) {
#pragma unroll
    for (int ks = 0; ks < KS; ++ks) { const bf16x8 a = *(const LAS bf16x8*)(X + ks * 16 + hi * 8), b = *(const LAS bf16x8*)(Y + ks * 16 + hi * 8);
        acc = __builtin_amdgcn_mfma_f32_32x32x16_bf16(a, b, acc, 0, 0, 0); }
}
__device__ __forceinline__ float logsig16(float x) { const float e = __expf(-fabsf(x)); return (fminf(x, 0.f) - __logf(1.f + e)) * 0.0625f; }
__device__ __forceinline__ int gla_sidx(int b, int dir, int h) { return (b * 2 + dir) * 4 + h; }

__device__ __forceinline__ void gla_cumsum_lds(const Ctx& C, int l, int h, int dir, const LAS float* lr, LAS float* segtot, LAS float* CUM) {
    const int seg = C.tid >> 7, d = C.tid & 127;
    const float* wa = INP(dir ? I_WA2B : I_WA2F) + (size_t)l * 16 * 512 + h * 128 + d;
    const float bias = INP(dir ? I_BAB : I_BAF)[l * 512 + h * 128 + d];
    float w[16], cum[16];
#pragma unroll
    for (int j = 0; j < 16; ++j) w[j] = wa[j * 512];
    float run = 0.f;
#pragma unroll
    for (int i = 0; i < 16; ++i) { const int s = seg * 16 + i, tk = dir ? 63 - s : s; float pre = bias;
#pragma unroll
        for (int j = 0; j < 16; ++j) pre += lr[tk * 32 + dir * 16 + j] * w[j];
        run += logsig16(pre); cum[i] = run; }
    segtot[seg * 128 + d] = run;
    __syncthreads();
    float off = 0.f;
#pragma unroll
    for (int q = 0; q < 3; ++q) if (q < seg) off += segtot[q * 128 + d];
#pragma unroll
    for (int i = 0; i < 16; ++i) { const int s = seg * 16 + i, tk = dir ? 63 - s : s; CUM[tk * 132 + d] = cum[i] + off; }
    __syncthreads();
}
__device__ __forceinline__ void unpack8(const u32x4 w, float (&x)[8]) { x[0] = bflo(w.x); x[1] = bfhi(w.x); x[2] = bflo(w.y); x[3] = bfhi(w.y); x[4] = bflo(w.z); x[5] = bfhi(w.z); x[6] = bflo(w.w); x[7] = bfhi(w.w); }
__device__ __forceinline__ void gla_build_vt(const Ctx& C, const bf16_t* P, size_t r0, int h, LAS bf16_t* VT) {
    u32x4 v[4];
#pragma unroll
    for (int it = 0; it < 4; ++it) { const int idx = C.tid + it * NTHREADS, sv = idx >> 5, e0 = (idx & 31) * 8; v[it] = *(const u32x4*)(P + (r0 + sv) * NP + C_LV + h * 256 + e0); }
#pragma unroll
    for (int it = 0; it < 4; ++it) { const int idx = C.tid + it * NTHREADS, sv = idx >> 5, e0 = (idx & 31) * 8;
        const unsigned wd[4] = {v[it].x, v[it].y, v[it].z, v[it].w};
#pragma unroll
        for (int q = 0; q < 4; ++q) { VT[(e0 + 2 * q) * 72 + sv] = (bf16_t)(wd[q] & 0xffffu); VT[(e0 + 2 * q + 1) * 72 + sv] = (bf16_t)(wd[q] >> 16); } }
}

__device__ __forceinline__ void phase_gla_local(const Ctx& C, int l) {
    const bf16_t* P = WSP(bf16_t, WS_P); bf16_t* GST = WSP(bf16_t, WS_GST); float* GDEC = WSP(float, WS_GDEC);
    LAS float* lr = (LAS float*)C.lds;
    LAS float* segtot = (LAS float*)(C.lds + 8192);
    LAS bf16_t* KT = (LAS bf16_t*)(C.lds + 10240);
    LAS bf16_t* VT = (LAS bf16_t*)(C.lds + 28672);
    LAS float* CUM = (LAS float*)(C.lds + 65536);
    const int r32 = C.lane & 31, hi = C.lane >> 5, d = C.tid & 127;
    const int btk = C.tid >> 3, bdg = (C.tid & 7) * 16;
    for (int unit = C.bid; unit < NBATCH * 4 * NCH; unit += C.G) {
        const int b = unit / (4 * NCH), h = (unit / NCH) % 4, ck = unit % NCH; const size_t r0 = (size_t)b * RPB + ck * 64;
        for (int i = C.tid; i < 64 * 32; i += NTHREADS) lr[i] = bf2f(P[(r0 + (i >> 5)) * NP + C_LRF + (i & 31)]);
        const u32x4 kw0 = *(const u32x4*)(P + (r0 + btk) * NP + C_LK + h * 128 + bdg), kw1 = *(const u32x4*)(P + (r0 + btk) * NP + C_LK + h * 128 + bdg + 8);
        gla_build_vt(C, P, r0, h, VT);
        __syncthreads();
#pragma unroll 1
        for (int dir = 0; dir < 2; ++dir) {
            gla_cumsum_lds(C, l, h, dir, lr, segtot, CUM);
            const int tend = dir ? 0 : 63;
            const size_t sx = (size_t)gla_sidx(b, dir, h) * NCH + ck;
            if (C.tid < 128) GDEC[sx * 128 + d] = __expf(CUM[tend * 132 + d]);
            { float kf[16]; { float t8[8]; unpack8(kw0, t8);
#pragma unroll
                for (int i = 0; i < 8; ++i) kf[i] = t8[i]; unpack8(kw1, t8);
#pragma unroll
                for (int i = 0; i < 8; ++i) kf[8 + i] = t8[i]; }
#pragma unroll
              for (int q = 0; q < 4; ++q) { const f32x4 cm = *(const LAS f32x4*)(CUM + btk * 132 + bdg + 4 * q), be = *(const LAS f32x4*)(CUM + tend * 132 + bdg + 4 * q);
#pragma unroll
                  for (int i = 0; i < 4; ++i) KT[(bdg + 4 * q + i) * 72 + btk] = f2bf(kf[4 * q + i] * __expf(be[i] - cm[i])); } }
            __syncthreads();
            { const int dt = C.wid & 3, eb = (C.wid >> 2) * 4;
              f32x16 acc[4] = {};
#pragma unroll
              for (int q = 0; q < 4; ++q) mma_xy<4>(acc[q], KT + (dt * 32 + r32) * 72, VT + ((eb + q) * 32 + r32) * 72, hi);
              bf16_t* st = GST + sx * 32768;
#pragma unroll
              for (int q = 0; q < 4; ++q)
#pragma unroll
                  for (int g = 0; g < 4; ++g) { u32x2 w; w.x = cvt_pk_bf16(acc[q][4 * g], acc[q][4 * g + 1]); w.y = cvt_pk_bf16(acc[q][4 * g + 2], acc[q][4 * g + 3]);
                      *(u32x2*)(st + (size_t)((eb + q) * 32 + r32) * 128 + dt * 32 + 8 * g + 4 * hi) = w; } }
            __syncthreads();
        }
    }
}

__device__ __forceinline__ void phase_gla_scan(const Ctx& C) {
    bf16_t* GST = WSP(bf16_t, WS_GST); const float* GDEC = WSP(float, WS_GDEC);
    for (int gid = C.bid * NTHREADS + C.tid; gid < 16 * 8192; gid += C.G * NTHREADS) {
        const int sidx = gid >> 13, g = gid & 8191, dir = (sidx >> 2) & 1, d4 = (g & 31) * 4;
        bf16_t* base = GST + (size_t)sidx * NCH * 32768 + (size_t)g * 4;
        const float* dbase = GDEC + (size_t)sidx * NCH * 128 + d4;
        float S[4] = {0.f, 0.f, 0.f, 0.f};
        for (int st = 0; st < NCH; st += 4) {
            int ck[4]; u32x2 L[4]; f32x4 dc[4];
#pragma unroll
            for (int q = 0; q < 4; ++q) { const int s = st + q; ck[q] = dir ? (s < 4 ? 3 - s : NCH + 3 - s) : s;
                L[q] = *(const u32x2*)(base + (size_t)ck[q] * 32768); dc[q] = *(const f32x4*)(dbase + (size_t)ck[q] * 128); }
#pragma unroll
            for (int q = 0; q < 4; ++q) { u32x2 w; w.x = cvt_pk_bf16(S[0], S[1]); w.y = cvt_pk_bf16(S[2], S[3]);
                *(u32x2*)(base + (size_t)ck[q] * 32768) = w;
                S[0] = dc[q][0] * S[0] + bflo(L[q].x); S[1] = dc[q][1] * S[1] + bfhi(L[q].x); S[2] = dc[q][2] * S[2] + bflo(L[q].y); S[3] = dc[q][3] * S[3] + bfhi(L[q].y); }
        }
    }
}

__device__ __forceinline__ void phase_gla_out(const Ctx& C, int l) {
    const bf16_t* P = WSP(bf16_t, WS_P); const bf16_t* GST = WSP(bf16_t, WS_GST); bf16_t* OL = WSP(bf16_t, WS_OL);
    LAS float* lr = (LAS float*)C.lds;
    LAS float* segtot = (LAS float*)(C.lds + 8192);
    LAS bf16_t* QT = (LAS bf16_t*)(C.lds + 10240);
    LAS bf16_t* KT = (LAS bf16_t*)(C.lds + 27648);
    LAS bf16_t* VT = (LAS bf16_t*)(C.lds + 45056);
    LAS bf16_t* SCm = (LAS bf16_t*)(C.lds + 81920);
    LAS float* OB = (LAS float*)(C.lds + 91136);
    LAS float* CUM = OB;
    const float* gon = INP(I_ONG) + l * 256;
    const int r32 = C.lane & 31, hi = C.lane >> 5;
    const int btk = C.tid >> 3, bdg = (C.tid & 7) * 16;
    for (int unit = C.bid; unit < NBATCH * 4 * NCH; unit += C.G) {
        const int b = unit / (4 * NCH), h = (unit / NCH) % 4, ck = unit % NCH; const size_t r0 = (size_t)b * RPB + ck * 64;
        for (int i = C.tid; i < 64 * 32; i += NTHREADS) lr[i] = bf2f(P[(r0 + (i >> 5)) * NP + C_LRF + (i & 31)]);
        const bf16_t* qp = P + (r0 + btk) * NP + C_LQ + h * 128 + bdg; const bf16_t* kp = P + (r0 + btk) * NP + C_LK + h * 128 + bdg;
        const u32x4 qw0 = *(const u32x4*)qp, qw1 = *(const u32x4*)(qp + 8), kw0 = *(const u32x4*)kp, kw1 = *(const u32x4*)(kp + 8);
        gla_build_vt(C, P, r0, h, VT);
        __syncthreads();
        f32x16 oacc[2] = {};
#pragma unroll 1
        for (int dir = 0; dir < 2; ++dir) {
            gla_cumsum_lds(C, l, h, dir, lr, segtot, CUM);
            { float qf[8], kf[8];
#pragma unroll
              for (int hh = 0; hh < 2; ++hh) { unpack8(hh ? qw1 : qw0, qf); unpack8(hh ? kw1 : kw0, kf);
                  const f32x4 c0 = *(const LAS f32x4*)(CUM + btk * 132 + bdg + 8 * hh), c1 = *(const LAS f32x4*)(CUM + btk * 132 + bdg + 8 * hh + 4);
                  float qo[8], ko[8];
#pragma unroll
                  for (int i = 0; i < 8; ++i) { const float cm = i < 4 ? c0[i & 3] : c1[i & 3]; qo[i] = qf[i] * __expf(cm) * 0.088388347648318440f; ko[i] = kf[i] * __expf(-cm); }
                  u32x4 wq, wk; wq.x = cvt_pk_bf16(qo[0], qo[1]); wq.y = cvt_pk_bf16(qo[2], qo[3]); wq.z = cvt_pk_bf16(qo[4], qo[5]); wq.w = cvt_pk_bf16(qo[6], qo[7]);
                  wk.x = cvt_pk_bf16(ko[0], ko[1]); wk.y = cvt_pk_bf16(ko[2], ko[3]); wk.z = cvt_pk_bf16(ko[4], ko[5]); wk.w = cvt_pk_bf16(ko[6], ko[7]);
                  *(LAS u32x4*)(QT + btk * 136 + bdg + 8 * hh) = wq; *(LAS u32x4*)(KT + btk * 136 + bdg + 8 * hh) = wk; } }
            __syncthreads();
            if (C.wid < 4) { const int mt = C.wid >> 1, nt = C.wid & 1; f32x16 sc = {};
                mma_xy<8>(sc, QT + (mt * 32 + r32) * 136, KT + (nt * 32 + r32) * 136, hi);
#pragma unroll
                for (int i = 0; i < 16; ++i) { const int t = mt * 32 + att::crow(i, hi), sx_ = nt * 32 + r32; const bool keep = dir ? (sx_ >= t) : (sx_ <= t);
                    SCm[t * 72 + sx_] = f2bf(keep ? sc[i] : 0.f); } }
            __syncthreads();
            { const bf16_t* st = GST + ((size_t)gla_sidx(b, dir, h) * NCH + ck) * 32768 + (size_t)(C.wid * 32 + r32) * 128 + hi * 8;
              bf16x8 sb[8];
#pragma unroll
              for (int ks = 0; ks < 8; ++ks) sb[ks] = *(const bf16x8*)(st + ks * 16);
#pragma unroll
              for (int mt = 0; mt < 2; ++mt) {
                  mma_xy<4>(oacc[mt], SCm + (mt * 32 + r32) * 72, VT + (C.wid * 32 + r32) * 72, hi);
#pragma unroll
                  for (int ks = 0; ks < 8; ++ks) { const bf16x8 a = *(const LAS bf16x8*)(QT + (mt * 32 + r32) * 136 + ks * 16 + hi * 8);
                      oacc[mt] = __builtin_amdgcn_mfma_f32_32x32x16_bf16(a, sb[ks], oacc[mt], 0, 0, 0); } } }
            __syncthreads();
        }
#pragma unroll
        for (int mt = 0; mt < 2; ++mt)
#pragma unroll
            for (int i = 0; i < 16; ++i) OB[(mt * 32 + att::crow(i, hi)) * 260 + C.wid * 32 + r32] = oacc[mt][i];
        __syncthreads();
        { const int t = C.tid >> 3, part = C.tid & 7; f32x4 v[8]; float ss = 0.f;
#pragma unroll
          for (int jj = 0; jj < 8; ++jj) { v[jj] = *(const LAS f32x4*)(OB + t * 260 + jj * 32 + part * 4); ss += v[jj][0] * v[jj][0] + v[jj][1] * v[jj][1] + v[jj][2] * v[jj][2] + v[jj][3] * v[jj][3]; }
          ss += __shfl_xor(ss, 1); ss += __shfl_xor(ss, 2); ss += __shfl_xor(ss, 4);
          const float rs = rsqrtf(ss * (1.0f / 256.0f) + NORM_EPS);
#pragma unroll
          for (int jj = 0; jj < 8; ++jj) { const int e = jj * 32 + part * 4; const f32x4 g = *(const f32x4*)(gon + e);
              const u32x2 gt = *(const u32x2*)(P + (r0 + t) * NP + C_LG + h * 256 + e);
              const float o0 = v[jj][0] * rs * g[0] * siluf_(bflo(gt.x)), o1 = v[jj][1] * rs * g[1] * siluf_(bfhi(gt.x)), o2 = v[jj][2] * rs * g[2] * siluf_(bflo(gt.y)), o3 = v[jj][3] * rs * g[3] * siluf_(bfhi(gt.y));
              u32x2 w; w.x = cvt_pk_bf16(o0, o1); w.y = cvt_pk_bf16(o2, o3);
              *(u32x2*)(OL + (r0 + t) * 1024 + h * 256 + e) = w; } }
        __syncthreads();
    }
}

__device__ __forceinline__ unsigned f_ord(float f) { const unsigned u = __float_as_uint(f); return u ^ ((unsigned)((int)u >> 31) | 0x80000000u); }
__device__ __forceinline__ float f_unord(unsigned k) { return __uint_as_float((k & 0x80000000u) ? (k ^ 0x80000000u) : ~k); }
__device__ __forceinline__ void ins_u(unsigned (&L)[16], unsigned x) {
#pragma unroll
    for (int j = 0; j < 16; ++j) { const unsigned h = L[j] > x ? L[j] : x; x = L[j] > x ? x : L[j]; L[j] = h; }
}
__device__ __forceinline__ void ins_f(float (&M)[16], float x) {
#pragma unroll
    for (int j = 0; j < 16; ++j) { const float h = M[j] > x ? M[j] : x; x = M[j] > x ? x : M[j]; M[j] = h; }
}
__device__ __forceinline__ void peer_top16(const bf16_t* __restrict__ qrow, const bf16_t* __restrict__ keys, int r32, int hi, unsigned (&L)[16]) {
    bf16x8 qf[8];
#pragma unroll
    for (int kk = 0; kk < 8; ++kk) qf[kk] = *(const bf16x8*)(qrow + kk * 16 + hi * 8);
#pragma unroll
    for (int j = 0; j < 16; ++j) L[j] = 0u;
#pragma unroll 1
    for (int mt = 0; mt < 4; ++mt) {
        f32x16 acc = {};
#pragma unroll
        for (int kk = 0; kk < 8; ++kk) { const bf16x8 a = *(const bf16x8*)(keys + (size_t)(mt * 32 + r32) * 128 + kk * 16 + hi * 8);
            acc = __builtin_amdgcn_mfma_f32_32x32x16_bf16(a, qf[kk], acc, 0, 0, 0); }
#pragma unroll
        for (int i = 0; i < 16; ++i) { const unsigned kidx = (unsigned)(mt * 32 + att::crow(i, hi)); ins_u(L, (f_ord(acc[i]) & ~127u) | (127u - kidx)); }
    }
    unsigned Pn[16];
#pragma unroll
    for (int j = 0; j < 16; ++j) Pn[j] = (unsigned)__shfl_xor((int)L[j], 32);
#pragma unroll
    for (int j = 0; j < 16; ++j) ins_u(L, Pn[j]);
}
__device__ __forceinline__ void phase_peer_select(const Ctx& C, const bool latent_only) {
    const bf16_t* PQ = WSP(bf16_t, WS_PQ); const bf16_t* K1 = WSP(bf16_t, WS_K1); const bf16_t* K2 = WSP(bf16_t, WS_K2);
    int* PIDX = WSP(int, WS_PIDX); float* PG = WSP(float, WS_PG);
    const int r32 = C.lane & 31, hi = C.lane >> 5, head = C.wid;
    const int ngrp = latent_only ? NBATCH * SEQ / 32 : TT / 32;
    for (int gi = C.bid; gi < ngrp; gi += C.G) {
        const int grp = latent_only ? gi + (CTXL / 32) * (1 + gi / (SEQ / 32)) : gi;
        const size_t tok = (size_t)grp * 32 + r32;
        unsigned L1[16], L2[16];
        peer_top16(PQ + tok * DM + head * 256, K1 + (size_t)head * 128 * 128, r32, hi, L1);
        peer_top16(PQ + tok * DM + head * 256 + 128, K2 + (size_t)head * 128 * 128, r32, hi, L2);
        float v1[16], v2[16];
#pragma unroll
        for (int j = 0; j < 16; ++j) { v1[j] = f_unord(L1[j] & ~127u); v2[j] = f_unord(L2[j] & ~127u); }
        float M[16];
#pragma unroll
        for (int j = 0; j < 16; ++j) M[j] = -3.0e38f;
#pragma unroll
        for (int a = 0; a < 16; ++a)
#pragma unroll
            for (int b = 0; b < 16; ++b) if ((a + 1) * (b + 1) <= 16) ins_f(M, v1[a] + v2[b]);
        const float thr = M[15], mx = M[0]; float den = 0.f;
#pragma unroll
        for (int j = 0; j < 16; ++j) den += __expf(M[j] - mx);
        const float rden = 1.0f / den;
        int pos = 0; int* ip = PIDX + tok * 128 + head * 16; float* gp = PG + tok * 128 + head * 16;
#pragma unroll
        for (int a = 0; a < 16; ++a)
#pragma unroll
            for (int b = 0; b < 16; ++b) if ((a + 1) * (b + 1) <= 16) {
                const float val = v1[a] + v2[b];
                if (val >= thr && pos < 16) { if (hi == 0) { ip[pos] = (int)((127u - (L1[a] & 127u)) * 128u + (127u - (L2[b] & 127u))); gp[pos] = __expf(val - mx) * rden; } ++pos; } }
    }
}
template <int OFF> __device__ __forceinline__ float dotf8(const float (&h)[32], const u32x4 w, float acc) {
#pragma unroll
    for (int j = 0; j < 4; ++j) { const f32x2 lo = __builtin_amdgcn_cvt_pk_f32_fp8((int)w[j], false), hi = __builtin_amdgcn_cvt_pk_f32_fp8((int)w[j], true);
        acc += h[OFF + 4 * j] * lo.x; acc += h[OFF + 4 * j + 1] * lo.y; acc += h[OFF + 4 * j + 2] * hi.x; acc += h[OFF + 4 * j + 3] * hi.y; }
    return acc;
}
constexpr int GT_MAXTOK = 9;
template <bool LAST> __device__ __forceinline__ void phase_peer_gather(const Ctx& C, const float* modl, const float pscale) {
    const bf16_t* HB = WSP(bf16_t, WS_HB); const unsigned char* U8 = C.ws + WS_U8; const unsigned char* V8 = C.ws + WS_V8;
    const float* SCU = WSP(float, WS_SCU); const float* SCV = WSP(float, WS_SCV);
    const int* PIDX = WSP(int, WS_PIDX); const float* PG = WSP(float, WS_PG); float* XS = WSP(float, WS_XS);
    const int lane = C.lane, s = lane >> 3, j = lane & 7;
    LAS int* IDS = (LAS int*)(C.lds + C.wid * (GT_MAXTOK * 512));
    LAS float* ACT = (LAS float*)(C.lds + 8 * GT_MAXTOK * 512 + C.wid * (GT_MAXTOK * 512));
    LAS int* ROWS = (LAS int*)(C.lds + 16 * GT_MAXTOK * 512 + C.wid * 64);
    int nk = 0;
    {
      const int per = (TT + C.G - 1) / C.G, base = C.bid * per;
#pragma unroll 1
      for (int k = 0; k < GT_MAXTOK; ++k) { const int o = C.wid + 8 * k; const int r = base + o; if (o < per && r < TT && !(LAST && (r % RPB) < CTXL)) { if (lane == 0) ROWS[nk] = r; ++nk; } } }
#define GT_ROW(k) __builtin_amdgcn_readfirstlane(ROWS[k])
#pragma unroll 1
    for (int k = 0; k < nk; ++k) { const int r = GT_ROW(k);
        IDS[k * 128 + lane] = PIDX[(size_t)r * 128 + lane] & (NEXP - 1); IDS[k * 128 + 64 + lane] = PIDX[(size_t)r * 128 + 64 + lane] & (NEXP - 1);
        ACT[k * 128 + lane] = 0.f; ACT[k * 128 + 64 + lane] = 0.f; }
    const int nit = 32 * nk;
#define GT_ITEM(it_) const int cb_ = (it_) / (2 * nk), rem_ = (it_) - cb_ * (2 * nk), k_ = rem_ >> 1, hf_ = rem_ & 1
#define GT_LOADU(UQ, HQ, it_) do { GT_ITEM(it_); const int r_ = GT_ROW(k_); \
        const bf16_t* hp_ = HB + (size_t)r_ * DM + cb_ * 128 + j * 16; HQ[0] = *(const u32x4*)hp_; HQ[1] = *(const u32x4*)(hp_ + 8); \
        const unsigned char* ub_ = U8 + (size_t)cb_ * ((size_t)NEXP * 128) + j * 16; \
        _Pragma("unroll") for (int eg = 0; eg < 8; ++eg) { const int id_ = IDS[k_ * 128 + (hf_ * 8 + eg) * 8 + s] & idmask; UQ[eg] = *(const u32x4*)(ub_ + (size_t)id_ * 128); } } while (0)
#define GT_COMPU(UQ, HQ, it_) do { GT_ITEM(it_); (void)cb_; f32x2 hf2[8]; \
        _Pragma("unroll") for (int hh = 0; hh < 2; ++hh) { const u32x4 w_ = HQ[hh]; \
            hf2[hh * 4 + 0] = (f32x2){bflo(w_.x), bfhi(w_.x)}; hf2[hh * 4 + 1] = (f32x2){bflo(w_.y), bfhi(w_.y)}; hf2[hh * 4 + 2] = (f32x2){bflo(w_.z), bfhi(w_.z)}; hf2[hh * 4 + 3] = (f32x2){bflo(w_.w), bfhi(w_.w)}; } \
        float d[8]; \
        _Pragma("unroll") for (int eg = 0; eg < 8; ++eg) { f32x2 d2 = (f32x2){0.f, 0.f}; \
            _Pragma("unroll") for (int q = 0; q < 4; ++q) { const f32x2 lo = __builtin_amdgcn_cvt_pk_f32_fp8((int)UQ[eg][q], false), hi = __builtin_amdgcn_cvt_pk_f32_fp8((int)UQ[eg][q], true); \
                d2 += hf2[2 * q] * lo; d2 += hf2[2 * q + 1] * hi; } \
            d[eg] = d2.x + d2.y; } \
          \
        float t4[4], t2[2], t1; \
        _Pragma("unroll") for (int i = 0; i < 4; ++i) { const float snd = (j & 4) ? d[i] : d[i + 4], kp = (j & 4) ? d[i + 4] : d[i]; t4[i] = kp + dppmov<DPP_HMIRROR>(snd); } \
        _Pragma("unroll") for (int i = 0; i < 2; ++i) { const float snd = (j & 2) ? t4[i] : t4[i + 2], kp = (j & 2) ? t4[i + 2] : t4[i]; t2[i] = kp + dppmov<DPP_Q3210>(snd); } \
        { const float snd = (j & 1) ? t2[0] : t2[1], kp = (j & 1) ? t2[1] : t2[0]; t1 = kp + dppmov<DPP_Q1032>(snd); } \
        ACT[k_ * 128 + (hf_ * 8 + j) * 8 + s] += t1; } while (0)
#ifdef DBG_GDUP
#pragma unroll 1
    for (int rep_ = 0; rep_ < 2; ++rep_) {
    const int idmask = rep_ == 0 ? DBG_GMASK : (NEXP - 1);
    if (rep_ == 1) { for (int k = 0; k < nk; ++k) { ACT[k * 128 + lane] = 0.f; ACT[k * 128 + 64 + lane] = 0.f; } }
#else
    { const int idmask = NEXP - 1;
#endif
    if (nit > 0) {
        u32x4 uA[8], uB[8], hA[2], hB[2];
        GT_LOADU(uA, hA, 0);
#pragma unroll 1
        for (int it = 0; it < nit; it += 2) {
            GT_LOADU(uB, hB, it + 1);
            GT_COMPU(uA, hA, it);
            if (it + 2 < nit) GT_LOADU(uA, hA, it + 2);
            GT_COMPU(uB, hB, it + 1);
        }
    }
    }
#undef GT_LOADU
#undef GT_COMPU
#pragma unroll 1
    for (int k = 0; k < nk; ++k) { const int r = GT_ROW(k);
#pragma unroll
        for (int hh = 0; hh < 2; ++hh) { const int e = hh * 64 + lane; const int id = IDS[k * 128 + e]; const float a = ACT[k * 128 + e] * SCU[id];
            const float w = PG[(size_t)r * 128 + e] * 0.5f * a * (1.0f + erff(a * 0.70710678118654752f));
#ifdef DBG_CHECK
            if (((r - 300) & 63) == 0 && r >= 300 && r < 300 + 64 * 128) WSP(float, WS_OM)[(size_t)r * 128 + e] = w;
#endif
            ACT[k * 128 + e] = w * SCV[id]; } }
#define GT_LOADV(VQ, WV, it_) do { GT_ITEM(it_); const unsigned char* vb_ = V8 + (size_t)cb_ * ((size_t)NEXP * 128) + j * 16; \
        _Pragma("unroll") for (int eg = 0; eg < 8; ++eg) { const int e_ = k_ * 128 + (hf_ * 8 + eg) * 8 + s; const int id_ = IDS[e_]; VQ[eg] = *(const u32x4*)(vb_ + (size_t)id_ * 128); WV[eg] = ACT[e_]; } } while (0)
#define GT_COMPV(VQ, WV) do { \
        _Pragma("unroll") for (int eg = 0; eg < 8; ++eg) { const f32x2 w2_ = (f32x2){WV[eg], WV[eg]}; \
            _Pragma("unroll") for (int q = 0; q < 4; ++q) { \
                const f32x2 lo = __builtin_amdgcn_cvt_pk_f32_fp8((int)VQ[eg][q], false), hi = __builtin_amdgcn_cvt_pk_f32_fp8((int)VQ[eg][q], true); \
                acc2[2 * q] += w2_ * lo; acc2[2 * q + 1] += w2_ * hi; } } } while (0)
    if (nit > 0) {
        u32x4 vA[8], vB[8]; float wA[8], wB[8];
        GT_LOADV(vA, wA, 0);
#pragma unroll 1
        for (int it = 0; it < nit; it += 2) {
            f32x2 acc2[8];
#pragma unroll
            for (int i = 0; i < 8; ++i) acc2[i] = (f32x2){0.f, 0.f};
            GT_LOADV(vB, wB, it + 1);
            GT_COMPV(vA, wA);
            if (it + 2 < nit) GT_LOADV(vA, wA, it + 2);
            GT_COMPV(vB, wB);
            f32x2 t4[4], t2[2], t1;
#pragma unroll
            for (int i = 0; i < 4; ++i) { const f32x2 snd = (s & 4) ? acc2[i] : acc2[i + 4], kp = (s & 4) ? acc2[i + 4] : acc2[i];
                t4[i] = kp + (f32x2){xchg32(snd.x, lane), xchg32(snd.y, lane)}; }
#pragma unroll
            for (int i = 0; i < 2; ++i) { const f32x2 snd = (s & 2) ? t4[i] : t4[i + 2], kp = (s & 2) ? t4[i + 2] : t4[i];
                t2[i] = kp + (f32x2){xchg16(snd.x, lane), xchg16(snd.y, lane)}; }
            { const f32x2 snd = (s & 1) ? t2[0] : t2[1], kp = (s & 1) ? t2[1] : t2[0]; t1 = kp + (f32x2){dppmov<DPP_ROR8>(snd.x), dppmov<DPP_ROR8>(snd.y)}; }
            { GT_ITEM(it); (void)hf_; const int r_ = GT_ROW(k_);
              const int col = cb_ * 128 + j * 16 + 2 * s; float* xp = XS + (size_t)r_ * DM + col; const float* g2 = modl + (size_t)mod_sel(r_) * 12288 + 5 * DM + col;
#ifdef DBG_CHECK
              if (((r_ - 300) & 63) == 0 && r_ >= 300 && r_ < 300 + 64 * 128) { float* dbgo = WSP(float, WS_MQ) + (size_t)r_ * DM + col; dbgo[0] = t1.x; dbgo[1] = t1.y; }
#endif
              const f32x2 x = *(const f32x2*)xp, g = *(const f32x2*)g2;
              *(f32x2*)xp = x + pscale * g * t1; }
        }
    }
#undef GT_LOADV
#undef GT_COMPV
#undef GT_ITEM
#undef GT_ROW
}
__device__ __forceinline__ void phase_final_norm(const Ctx& C) {
    const float* XS = WSP(float, WS_XS); const float* fg = INP(I_FG);
    for (int q = C.bid * 8 + C.wid; q < NBATCH * SEQ; q += C.G * 8) {
        const int b = q / SEQ, t = q % SEQ; const float* xr = XS + ((size_t)b * RPB + CTXL + t) * DM; float* op = C.out + (size_t)q * DM;
        f32x4 v[8]; float ss = 0.f;
#pragma unroll
        for (int c = 0; c < 8; ++c) { v[c] = *(const f32x4*)(xr + c * 256 + C.lane * 4); ss += v[c][0] * v[c][0] + v[c][1] * v[c][1] + v[c][2] * v[c][2] + v[c][3] * v[c][3]; }
        ss = wave_sum(ss); const float rs = rsqrtf(ss * (1.0f / DM) + NORM_EPS);
#pragma unroll
        for (int c = 0; c < 8; ++c) { const f32x4 g = *(const f32x4*)(fg + c * 256 + C.lane * 4); *(f32x4*)(op + c * 256 + C.lane * 4) = v[c] * rs * g; }
    }
}

template <int TYPE  > __device__ __forceinline__ void attn_units(const Ctx& C, bool need_ctx) {
    const bf16_t* P = WSP(bf16_t, WS_P);
    const int nu = need_ctx ? 528 : 512;
#pragma unroll 1
    for (int u = C.bid; u < nu; u += C.G) {
        int bh, qb; if (u < 512) { bh = (u >> 8) * 8 + (u & 7); qb = ((u & 255) >> 3) + 1; } else { bh = u - 512; qb = 0; }
        const int b = bh >> 3, h = bh & 7; const size_t rq = (size_t)b * RPB + (size_t)qb * 256, rk = (size_t)b * RPB; const int seq = qb == 0 ? CTXL : RPB;
        __syncthreads();
        if constexpr (TYPE == 1) {
            att::attn_body<128, 1>(P + rq * NP + C_AQ + h * 128, NP, P + rk * NP + C_AK + (h >> 2) * 128, NP, nullptr, 0, P + rk * NP + C_AV + (h >> 2) * 128, NP,
                                   WSP(bf16_t, WS_OA) + rq * 1024 + h * 128, 1024, seq, false, 0, nullptr, (char*)C.lds, C.tid);
        } else {
            const bf16_t* MQ = WSP(bf16_t, WS_MQ); const bf16_t* MKV = WSP(bf16_t, WS_MKV);
            att::attn_body<192, 1>(MQ + rq * 1536 + h * 192, 1536, MKV + rk * 2048 + h * 256, 2048, P + rk * NP + C_MKR, NP, MKV + rk * 2048 + h * 256 + 128, 2048,
                                   WSP(bf16_t, WS_OM) + rq * 1024 + h * 128, 1024, seq, qb > 0, (qb - 1) * 256, WSP(float, WS_TABM), (char*)C.lds, C.tid);
        }
    }
    __syncthreads();
}

constexpr int LDS_BYTES = 163840, LDS_BAR_OFF = LDS_BYTES - 16;
constexpr int N_PHASES = 26;
template <int K> __device__ __forceinline__ void run_phase(const Ctx& C0, int l) {
    const Ctx C = launder(C0);
    const float* modl = WSP(float, WS_MODV) + (size_t)l * 3 * 12288;
    if constexpr (K == 0) { phase_modv(C); phase_tables(C); __syncthreads(); phase_cvt_mixer_weights(C, 0); }
    if constexpr (K == 1) {
        if (l == 0) phase_norm_mod<true>(C, INP(I_N1G), modl, 0, DM);
        else { phase_norm_mod<false>(C, INP(I_N1G) + l * DM, modl, 0, DM); __syncthreads(); phase_cvt_mixer_weights(C, l); }
    }
    if constexpr (K == 2) {
        pg8::Gemm g{WSP(bf16_t, WS_HB), WSP(bf16_t, WS_WIN), TT, NP, DM, DM, DM}; pg8::StaticOrder S; S.init(TT, NP, C.G, C.bid);
        pg8::EpiStoreBf16 E{WSP(bf16_t, WS_P), NP};
        pg8::gemm_phase(C.lds, C.tid, g, S, E);
    }
    if constexpr (K == 3) phase_post_p(C, l);
    if constexpr (K == 4) {
        { pg8::Gemm g{WSP(bf16_t, WS_P) + C_MCQ, WSP(bf16_t, WS_WUQ), TT, 1536, 512, NP, 512}; pg8::StaticOrder S; S.init(TT, 1536, C.G, C.bid);
          pg8::EpiStoreBf16 E{WSP(bf16_t, WS_MQ), 1536}; pg8::gemm_phase(C.lds, C.tid, g, S, E); }
        { pg8::Gemm g{WSP(bf16_t, WS_P) + C_MCKV, WSP(bf16_t, WS_WUKV), TT, 2048, 512, NP, 512}; pg8::StaticOrder S; S.init(TT, 2048, C.G, C.bid);
          pg8::EpiStoreBf16 E{WSP(bf16_t, WS_MKV), 2048}; pg8::gemm_phase(C.lds, C.tid, g, S, E); }
        { const Ctx C2 = launder(C0); phase_gla_local(C2, l); }
#ifdef DBG_DUP_GLALOCAL
        { const Ctx C2 = launder(C0); __syncthreads(); phase_gla_local(C2, l); }
#endif
    }
    if constexpr (K == 5) phase_gla_scan(C);
    if constexpr (K == 6) { attn_units<0>(C, l + 1 < DEPTH); { const Ctx C2 = launder(C0); attn_units<1>(C2, l + 1 < DEPTH); } { const Ctx C3 = launder(C0); phase_gla_out(C3, l); }
#ifdef DBG_DUP_GLAOUT
        { const Ctx C3 = launder(C0); __syncthreads(); phase_gla_out(C3, l); }
#endif
    }
    if constexpr (K == 7) {
        const bf16_t* P = WSP(bf16_t, WS_P); bf16_t* Y = WSP(bf16_t, WS_Y);
        const pg8::Gemm ga{WSP(bf16_t, WS_OA), WSP(bf16_t, WS_WBR), TT, DM, 1024, 1024, 1024}, gl{WSP(bf16_t, WS_OL), WSP(bf16_t, WS_WBR) + (size_t)2048 * 1024, TT, DM, 1024, 1024, 1024},
                        gm{WSP(bf16_t, WS_OM), WSP(bf16_t, WS_WBR) + (size_t)2 * 2048 * 1024, TT, DM, 1024, 1024, 1024};
        const pg8::EpiGate<true> Ea{Y, DM, P + C_GA, NP}; const pg8::EpiGate<false> El{Y, DM, P + C_GL, NP}, Em{Y, DM, P + C_GM, NP};
        pg8::StaticOrder S; S.init(TT, DM, C.G, C.bid, l + 1 >= DEPTH);
        pg8::gemm_phase(C.lds, C.tid, ga, S, Ea); pg8::gemm_phase(C.lds, C.tid, gl, S, El); pg8::gemm_phase(C.lds, C.tid, gm, S, Em);
    }
    if constexpr (K == 8) {
        pg8::Gemm g{WSP(bf16_t, WS_Y), WSP(bf16_t, WS_WOUT), TT, DM, DM, DM, DM};
        pg8::EpiResid E{WSP(float, WS_XS), DM, modl + 2 * DM, l == 0 ? DBG_MIX0 : DBG_MIX1};
        pg8::StaticOrder S; S.init(TT, DM, C.G, C.bid, l + 1 >= DEPTH);
#ifdef DBG_DUP8
        { pg8::EpiResid E0{WSP(float, WS_XS), DM, modl + 2 * DM, 0.0f}; pg8::gemm_phase(C.lds, C.tid, g, S, E0); }
#endif
        pg8::gemm_phase(C.lds, C.tid, g, S, E);
        phase_cvt_peer_tables(C, l);
#ifdef DBG_CDUP
        phase_cvt_peer_tables(C, l);
#endif
    }
    if constexpr (K == 9) phase_norm_mod<false>(C, INP(I_N2G) + l * DM, modl, 3 * DM, 4 * DM);
    if constexpr (K == 10) {
        pg8::Gemm g{WSP(bf16_t, WS_HB), WSP(bf16_t, WS_WQ), TT, DM, DM, DM, DM};
        pg8::EpiStoreBf16 E{WSP(bf16_t, WS_PQ), DM};
        pg8::StaticOrder S; S.init(TT, DM, C.G, C.bid, l + 1 >= DEPTH); pg8::gemm_phase(C.lds, C.tid, g, S, E);
    }
    if constexpr (K == 11) phase_peer_select(C, l + 1 >= DEPTH);
    if constexpr (K == 13) phase_final_norm(C);
    if constexpr (K == 12) {
#ifdef DBG_DUP12
        if (l + 1 < DEPTH) phase_peer_gather<false>(C, modl, 0.0f); else phase_peer_gather<true>(C, modl, 0.0f);
        __syncthreads();
#endif
        if (l + 1 < DEPTH) phase_peer_gather<false>(C, modl, DBG_PEER0); else phase_peer_gather<true>(C, modl, DBG_PEER1); }
}
__device__ __forceinline__ Ctx make_ctx(const Args& args, unsigned char* lds_raw) {
    Ctx C0; C0.in = (const __attribute__((address_space(4))) cfp_t*)__builtin_amdgcn_kernarg_segment_ptr(); C0.out = args.out; C0.ws = args.ws; C0.lds = (LAS unsigned char*)lds_raw;
    C0.tid = threadIdx.x; C0.lane = C0.tid & 63; C0.wid = __builtin_amdgcn_readfirstlane(C0.tid >> 6); C0.G = gridDim.x; C0.bid = blockIdx.x;
    return C0;
}
template <int K> __global__ void __launch_bounds__(NTHREADS, 2) k_one(Args args) {
    extern __shared__ __attribute__((aligned(16))) unsigned char lds_raw[];
    const Ctx C0 = make_ctx(args, lds_raw);
    run_phase<K>(C0, args.ph_lo);
}
#if MK_N_LAUNCHES == 1 || defined(DBG_HYB)
__global__ void __launch_bounds__(NTHREADS, 2) mk_fwd(Args args) {
    extern __shared__ __attribute__((aligned(16))) unsigned char lds_raw[];
    const Ctx C0 = make_ctx(args, lds_raw);
    if (C0.tid < 4) ((LAS unsigned*)(C0.lds + LDS_BAR_OFF))[C0.tid] = 0u;
    __syncthreads();
    const int lo = args.ph_lo, hi = args.ph_hi;
    XcdBarrier bar; bar.bar = (unsigned*)(args.ws + WS_CTL); bar.x = 0; bar.st = nullptr;
    if (hi - lo > 1) bar = xcd_barrier_post((unsigned*)(args.ws + WS_CTL), (volatile LAS unsigned*)(C0.lds + LDS_BAR_OFF));
#define IN(k) (lo <= (k) && (k) < hi)
#define SEAM(k) do { if (IN(k) && IN((k) + 1)) xcd_barrier(bar); } while (0)
#ifndef DBG_DUP
#define DBG_DUP -1
#endif
#define PH(K, k) do { if (IN(k)) { run_phase<K>(C0, l); if (K == DBG_DUP) { xcd_barrier(bar); run_phase<K>(C0, l); } } SEAM(k); } while (0)
    { const int l = 0; PH(0, 0); }
#pragma unroll 1
    for (int l = 0; l < DEPTH; ++l) {
        const int pb = 1 + 12 * l;
        PH(1, pb + 0); PH(2, pb + 1); PH(3, pb + 2); PH(4, pb + 3); PH(5, pb + 4); PH(6, pb + 5);
        PH(7, pb + 6); PH(8, pb + 7); PH(9, pb + 8); PH(10, pb + 9); PH(11, pb + 10); PH(12, pb + 11);
    }
    { const int l = DEPTH - 1; PH(13, 1 + 12 * DEPTH); }
#undef PH
#undef IN
#undef SEAM
}
#define MAIN_KERNEL mk_fwd
#else
#define MAIN_KERNEL k_one<6>
#endif


#ifdef DBG_CHECK
__device__ __forceinline__ void dbg_report(unsigned* slot, float err) { if (!(err <= 3e38f)) err = 1e30f; atomicMax(slot, __float_as_uint(err)); }
__global__ void k_check_gemm(const bf16_t* A, int lda, const float* W, int K, int N, const bf16_t* Cm, int ldc, int M, unsigned* slot) {
    const unsigned id = blockIdx.x * blockDim.x + threadIdx.x; if (id >= 8192) return;
    const unsigned h = id * 2654435761u; const int row = (int)((h >> 8) % (unsigned)M), col = (int)((h * 40503u >> 7) % (unsigned)N);
    float ref = 0.f; for (int k = 0; k < K; ++k) ref += bf2f(A[(size_t)row * lda + k]) * W[(size_t)k * N + col];
    const float got = bf2f(Cm[(size_t)row * ldc + col]);
    dbg_report(slot, fabsf(got - ref) / (fabsf(ref) + 0.1f));
}

__global__ void k_check_attn(const unsigned char* ws, int type, unsigned* slot) {
    __shared__ float sc[RPB]; __shared__ float red[256]; __shared__ float qv[192];
    const int t = threadIdx.x, bh = blockIdx.x & 15, b = bh >> 3, h = bh & 7; const int qpos = (int)(((blockIdx.x >> 4) * 977u + 13u) % SEQ); const size_t rq = (size_t)b * RPB + CTXL + qpos, rk = (size_t)b * RPB;
    const bf16_t* P = (const bf16_t*)(ws + WS_P); const bf16_t* MQ = (const bf16_t*)(ws + WS_MQ); const bf16_t* MKV = (const bf16_t*)(ws + WS_MKV);
    const int dq = type ? 128 : 192;
    if (t < dq) { float v = type ? bf2f(P[rq * NP + C_AQ + h * 128 + t]) : bf2f(MQ[rq * 1536 + h * 192 + t]); qv[t] = v; }
    __syncthreads();
    if (!type && t < 32) {
        const int ri = qpos >> 6, ci = qpos & 63; const int i = t; const float pos = (float)(i < 16 ? ri : ci); const float inv = powf(10000.f, -(float)(i & 15) / 16.f); const float a = pos * inv;
        const float x1 = qv[128 + i], x2 = qv[160 + i]; qv[128 + i] = x1 * cosf(a) - x2 * sinf(a); qv[160 + i] = x2 * cosf(a) + x1 * sinf(a); }
    __syncthreads();
    const float scale = type ? 0.088388347648f : 0.0721687836487f;
    float mx = -1e30f;
    for (int k = t; k < RPB; k += 256) { float s = 0.f;
        if (type) { const bf16_t* kp = P + (rk + k) * NP + C_AK + (h >> 2) * 128; for (int d = 0; d < 128; ++d) s += qv[d] * bf2f(kp[d]); }
        else { const bf16_t* kp = MKV + (rk + k) * 2048 + h * 256; for (int d = 0; d < 128; ++d) s += qv[d] * bf2f(kp[d]); const bf16_t* kr = P + (rk + k) * NP + C_MKR; for (int d = 0; d < 64; ++d) s += qv[128 + d] * bf2f(kr[d]); }
        s *= scale; sc[k] = s; mx = fmaxf(mx, s); }
    red[t] = mx; __syncthreads(); for (int o = 128; o >= 1; o >>= 1) { if (t < o) red[t] = fmaxf(red[t], red[t + o]); __syncthreads(); } mx = red[0]; __syncthreads();
    float sum = 0.f; for (int k = t; k < RPB; k += 256) { const float p = __expf(sc[k] - mx); sc[k] = p; sum += p; }
    red[t] = sum; __syncthreads(); for (int o = 128; o >= 1; o >>= 1) { if (t < o) red[t] += red[t + o]; __syncthreads(); } sum = red[0]; __syncthreads();
    float e = 0.f, mag = 0.f;
    if (t < 128) { float o = 0.f; for (int k = 0; k < RPB; ++k) { const float vv = type ? bf2f(P[(rk + k) * NP + C_AV + (h >> 2) * 128 + t]) : bf2f(MKV[(rk + k) * 2048 + h * 256 + 128 + t]); o += sc[k] * vv; }
        o /= sum; const float got = bf2f(((const bf16_t*)(ws + (type ? WS_OA : WS_OM)))[rq * 1024 + h * 128 + t]); e = fabsf(got - o); mag = fabsf(o); }
    red[t] = e; __syncthreads(); for (int o = 128; o >= 1; o >>= 1) { if (t < o) red[t] = fmaxf(red[t], red[t + o]); __syncthreads(); } e = red[0]; __syncthreads();
    red[t] = mag; __syncthreads(); for (int o = 128; o >= 1; o >>= 1) { if (t < o) red[t] = fmaxf(red[t], red[t + o]); __syncthreads(); } mag = red[0];
    if (t == 0) dbg_report(slot, e / (mag + 1e-4f));
}
__global__ void __launch_bounds__(256) k_check_gla_rec(const unsigned char* ws, const float* wa_f, const float* ba_f, const float* wa_b, const float* ba_b, float* obuf, int b) {
    __shared__ float ad[128], kd[128], qd[128], lrs[16];
    const int e = threadIdx.x, h = blockIdx.x & 3, dir = blockIdx.x >> 2; const bf16_t* P = (const bf16_t*)(ws + WS_P);
    const float* wa = dir ? wa_b : wa_f; const float* ba = dir ? ba_b : ba_f;
    float S[128];
#pragma unroll
    for (int d = 0; d < 128; ++d) S[d] = 0.f;
    float* ob = obuf + ((size_t)(dir * 2 + b) * 4 + h) * RPB * 256;
    for (int st = 0; st < RPB; ++st) {
        int j; if (!dir) j = st; else j = st < CTXL ? CTXL - 1 - st : RPB - 1 - (st - CTXL);
        const size_t r = (size_t)b * RPB + j; const bf16_t* pr = P + r * NP;
        if (e < 16) lrs[e] = bf2f(pr[(dir ? C_LRB : C_LRF) + e]);
        __syncthreads();
        if (e < 128) { float pre = ba[h * 128 + e]; for (int q = 0; q < 16; ++q) pre += lrs[q] * wa[q * 512 + h * 128 + e];
            const float ls = (fminf(pre, 0.f) - log1pf(expf(-fabsf(pre)))) / 16.f; ad[e] = expf(ls); kd[e] = bf2f(pr[C_LK + h * 128 + e]); qd[e] = bf2f(pr[C_LQ + h * 128 + e]) * 0.088388347648f; }
        __syncthreads();
        const float v = bf2f(pr[C_LV + h * 256 + e]); float o = 0.f;
#pragma unroll
        for (int d = 0; d < 128; ++d) { S[d] = ad[d] * S[d] + kd[d] * v; o += qd[d] * S[d]; }
        ob[(size_t)j * 256 + e] = o;
        __syncthreads();
    }
}
__global__ void k_check_gla_cmp(const unsigned char* ws, const float* obuf, const float* gon, int b, unsigned* slot) {
    __shared__ float red[256];
    const int e = threadIdx.x, h = blockIdx.x & 3, j = blockIdx.x >> 2; const size_t r = (size_t)b * RPB + j; const bf16_t* P = (const bf16_t*)(ws + WS_P);
    const float o = obuf[((size_t)(0 * 2 + b) * 4 + h) * RPB * 256 + (size_t)j * 256 + e] + obuf[((size_t)(1 * 2 + b) * 4 + h) * RPB * 256 + (size_t)j * 256 + e];
    red[e] = o * o; __syncthreads(); for (int s_ = 128; s_ >= 1; s_ >>= 1) { if (e < s_) red[e] += red[e + s_]; __syncthreads(); }
    const float rs = rsqrtf(red[0] / 256.f + NORM_EPS); __syncthreads();
    const float gt = bf2f(P[r * NP + C_LG + h * 256 + e]); const float ref = o * rs * gon[e] * (gt / (1.f + expf(-gt)));
    const float got = bf2f(((const bf16_t*)(ws + WS_OL))[r * 1024 + h * 256 + e]);
    red[e] = fabsf(got - ref); __syncthreads(); for (int s_ = 128; s_ >= 1; s_ >>= 1) { if (e < s_) red[e] = fmaxf(red[e], red[e + s_]); __syncthreads(); }
    if (e == 0) dbg_report(slot, red[0] / 1.0f);
}
__global__ void k_check_select(const bf16_t* PQ, const float* k1, const float* k2, const int* PIDX, const float* PG, unsigned* slot) {
    __shared__ float s1[128], s2[128]; __shared__ int cnt; __shared__ float selv[16];
    const int tok = (blockIdx.x >> 3) * 61 + 5, head = blockIdx.x & 7, t = threadIdx.x;
    if (t == 0) cnt = 0;
    for (int n = t; n < 128; n += 64) { float a = 0.f, b = 0.f; for (int d = 0; d < 128; ++d) { a += bf2f(PQ[(size_t)tok * DM + head * 256 + d]) * k1[((size_t)head * 128 + n) * 128 + d]; b += bf2f(PQ[(size_t)tok * DM + head * 256 + 128 + d]) * k2[((size_t)head * 128 + n) * 128 + d]; } s1[n] = a; s2[n] = b; }
    __syncthreads();
    if (t < 16) { const int id = PIDX[(size_t)tok * 128 + head * 16 + t]; selv[t] = (id >= 0 && id < 16384) ? s1[id >> 7] + s2[id & 127] : -1e30f; }
    __syncthreads();
    float thr = selv[0], mx = selv[0]; for (int k = 1; k < 16; ++k) { thr = fminf(thr, selv[k]); mx = fmaxf(mx, selv[k]); }
    int c = 0; for (int p = t; p < 16384; p += 64) if (s1[p >> 7] + s2[p & 127] > thr + 0.02f) ++c;
    atomicAdd(&cnt, c); __syncthreads();
    if (t == 0) { float den = 0.f; for (int k = 0; k < 16; ++k) den += __expf(selv[k] - mx); float e = fabsf((float)cnt - 15.f) / 15.f > 0.34f ? fabsf((float)cnt - 15.f) / 15.f : 0.f;
        for (int k = 0; k < 16; ++k) e = fmaxf(e, fabsf(PG[(size_t)tok * 128 + head * 16 + k] - __expf(selv[k] - mx) / den) * 4.f);
        for (int k = 0; k < 16; ++k) for (int k2_ = 0; k2_ < k; ++k2_) if (PIDX[(size_t)tok * 128 + head * 16 + k] == PIDX[(size_t)tok * 128 + head * 16 + k2_]) e = fmaxf(e, 10.f);
        dbg_report(slot, e); }
}
__global__ void k_check_gather(const bf16_t* HB, const float* u, const float* v, const int* PIDX, const float* PG, const float* dbgo, unsigned* slot) {
    __shared__ float w[128];
    const int tok = blockIdx.x * 64 + 300, t = threadIdx.x;
    for (int k = t; k < 128; k += 64) { const int id = PIDX[(size_t)tok * 128 + k] & 16383; float a = 0.f; for (int d = 0; d < DM; ++d) a += bf2f(HB[(size_t)tok * DM + d]) * u[(size_t)id * DM + d];
        w[k] = PG[(size_t)tok * 128 + k] * 0.5f * a * (1.0f + erff(a * 0.70710678f)); }
    __syncthreads();
    float e = 0.f, sc = 0.f;
    for (int d = t; d < DM; d += 64) { float o = 0.f; for (int k = 0; k < 128; ++k) o += w[k] * v[(size_t)(PIDX[(size_t)tok * 128 + k] & 16383) * DM + d];
        e = fmaxf(e, fabsf(o - dbgo[(size_t)tok * DM + d])); sc = fmaxf(sc, fabsf(o)); }
    for (int o_ = 32; o_ >= 1; o_ >>= 1) { e = fmaxf(e, __shfl_xor(e, o_)); sc = fmaxf(sc, __shfl_xor(sc, o_)); }
    if (t == 0) dbg_report(slot, e / (sc + 1e-6f));
}
__global__ void k_dbg_out2(const float* x, const float* fg, float* out, const unsigned* slot) {
    const float mx = __uint_as_float(*slot); float v = 0.25f * (log10f(fmaxf(mx, 1e-30f)) + 4.0f); v = fminf(fmaxf(v, 0.f), 9.f);
    const float f = 1.0f + v;
    const int lane = threadIdx.x & 63; const size_t r = (size_t)blockIdx.x * 4 + (threadIdx.x >> 6);
    const float* xr = x + r * DM; float ss = 0.f;
    for (int c = lane; c < DM; c += 64) ss += xr[c] * xr[c];
    ss = wave_sum(ss); const float rs = rsqrtf(ss / DM + NORM_EPS);
    for (int c = lane; c < DM; c += 64) out[r * DM + c] = xr[c] * rs * fg[c] * f;
}
#endif
#ifdef DBG_SCAN
__global__ void k_scan16(const bf16_t* p, size_t n, unsigned* flags, int stage) {
    unsigned bad = 0; for (size_t i = (size_t)blockIdx.x * blockDim.x + threadIdx.x; i < n; i += (size_t)gridDim.x * blockDim.x) bad |= ((p[i] & 0x7f80u) == 0x7f80u);
    if (bad) atomicOr(&flags[stage], 1u);
}
__global__ void k_scan32(const float* p, size_t n, unsigned* flags, int stage) {
    unsigned bad = 0; for (size_t i = (size_t)blockIdx.x * blockDim.x + threadIdx.x; i < n; i += (size_t)gridDim.x * blockDim.x) bad |= ((__float_as_uint(p[i]) & 0x7f800000u) == 0x7f800000u);
    if (bad) atomicOr(&flags[stage], 1u);
}
__global__ void k_dbg_out(const float* x, const float* fg, float* out, const unsigned* flags, int nstage) {
    int code = 0; for (int s = nstage; s >= 1; --s) if (flags[s]) code = s;
    const float f = 1.0f + 0.25f * (float)code;
    const int lane = threadIdx.x & 63; const size_t r = (size_t)blockIdx.x * 4 + (threadIdx.x >> 6);
    const float* xr = x + r * DM; float ss = 0.f;
    for (int c = lane; c < DM; c += 64) ss += xr[c] * xr[c];
    ss = wave_sum(ss); const float rs = rsqrtf(ss / DM + NORM_EPS);
    for (int c = lane; c < DM; c += 64) out[r * DM + c] = xr[c] * rs * fg[c] * f;
}
#endif
extern "C" void kernel_launch(void* const* d_in, const int* in_sizes, int n_in, void* d_out, int out_size, void* d_ws, size_t ws_size, hipStream_t stream) {
    static int grid = 0;
    if (grid == 0) {
        if (n_in != 30 || out_size != NBATCH * SEQ * DM || ws_size < WS_END) { fprintf(stderr, "kernel_launch: shape/workspace mismatch: n_in %d out %d ws %zu (need %zu)\n", n_in, out_size, ws_size, (size_t)WS_END); grid = -1; return; }
        int dev = 0, cus = 0, per_cu = 0;
        if (hipGetDevice(&dev) != hipSuccess || hipDeviceGetAttribute(&cus, hipDeviceAttributeMultiprocessorCount, dev) != hipSuccess) { grid = -1; return; }
        bool okattr = hipFuncSetAttribute((const void*)MAIN_KERNEL, hipFuncAttributeMaxDynamicSharedMemorySize, LDS_BYTES) == hipSuccess;
#if MK_N_LAUNCHES != 1
#ifdef DBG_HYB
        okattr = okattr && hipFuncSetAttribute((const void*)mk_fwd, hipFuncAttributeMaxDynamicSharedMemorySize, LDS_BYTES) == hipSuccess;
#endif
#define SETA(K) okattr = okattr && hipFuncSetAttribute((const void*)k_one<K>, hipFuncAttributeMaxDynamicSharedMemorySize, LDS_BYTES) == hipSuccess
        SETA(0); SETA(1); SETA(2); SETA(3); SETA(4); SETA(5); SETA(6); SETA(7); SETA(8); SETA(9); SETA(10); SETA(11); SETA(12); SETA(13);
#undef SETA
#endif
        if (!okattr) { fprintf(stderr, "kernel_launch: hipFuncSetAttribute failed\n"); grid = -1; return; }
        if (hipOccupancyMaxActiveBlocksPerMultiprocessor(&per_cu, (const void*)MAIN_KERNEL, NTHREADS, LDS_BYTES) != hipSuccess || per_cu < 1) { fprintf(stderr, "kernel_launch: occupancy query says %d blocks per CU\n", per_cu); grid = -1; (void)hipGetLastError(); return; }
        grid = cus;
    }
    if (grid < 0) return;
    if (hipMemsetAsync((char*)d_ws + WS_CTL, 0, CTL_BYTES, stream) != hipSuccess) return;
    Args a{};
    for (int i = 0; i < 30; ++i) a.in[i] = (const float*)d_in[i];
    a.out = (float*)d_out; a.ws = (unsigned char*)d_ws;
#if MK_N_LAUNCHES == 1
#ifdef DBG_SPLIT
    for (int p = 0; p < N_PHASES; p += DBG_SPLIT) { a.ph_lo = p; a.ph_hi = p + DBG_SPLIT < N_PHASES ? p + DBG_SPLIT : N_PHASES; hipLaunchKernelGGL(mk_fwd, dim3(grid), dim3(NTHREADS), LDS_BYTES, stream, a); }
#else
    a.ph_lo = 0; a.ph_hi = N_PHASES;
    hipLaunchKernelGGL(mk_fwd, dim3(grid), dim3(NTHREADS), LDS_BYTES, stream, a);
#endif
#else
    a.ph_hi = 0;
#ifndef DBG_NLAUNCH
#define DBG_NLAUNCH 100
#endif
    int nl_ = 0;
#ifdef DBG_HYB
#define LAUNCH1(K, L) do { if (K == DBG_HYB) { a.ph_lo = 12 * (L) + (K); a.ph_hi = a.ph_lo + 1; hipLaunchKernelGGL(mk_fwd, dim3(grid), dim3(NTHREADS), LDS_BYTES, stream, a); a.ph_hi = 0; } else { a.ph_lo = (L); hipLaunchKernelGGL(k_one<K>, dim3(grid), dim3(NTHREADS), LDS_BYTES, stream, a); } } while (0)
#else
#define LAUNCH1(K, L) do { a.ph_lo = (L); if (nl_++ < DBG_NLAUNCH) { hipLaunchKernelGGL(k_one<K>, dim3(grid), dim3(NTHREADS), LDS_BYTES, stream, a); if (K == DBG_DUP) hipLaunchKernelGGL(k_one<K>, dim3(grid), dim3(NTHREADS), LDS_BYTES, stream, a); } } while (0)
#endif
#ifdef DBG_SCAN
    unsigned* flags = (unsigned*)((char*)d_ws + WS_CTL + 32768);
    char* W = (char*)d_ws;
#define S16(off, n, st) hipLaunchKernelGGL(k_scan16, dim3(1024), dim3(256), 0, stream, (const bf16_t*)(W + (off)), (size_t)(n), flags, st)
#define S32(off, n, st) hipLaunchKernelGGL(k_scan32, dim3(1024), dim3(256), 0, stream, (const float*)(W + (off)), (size_t)(n), flags, st)
    LAUNCH1(0, 0); S32(WS_MODV, 2 * 3 * 12288, 1);
    { const int l = 0;
      LAUNCH1(1, l); S16(WS_HB, (size_t)TT * DM, 2);
      LAUNCH1(2, l); S16(WS_P, (size_t)TT * NP, 3);
      LAUNCH1(3, l); S16(WS_P, (size_t)TT * NP, 4);
      LAUNCH1(4, l); S16(WS_MQ, (size_t)TT * 1536, 5); S16(WS_MKV, (size_t)TT * 2048, 5); S16(WS_GST, (size_t)2112 * 32768, 6); S32(WS_GDEC, (size_t)2112 * 128, 6);
      LAUNCH1(5, l); S16(WS_GST, (size_t)2112 * 32768, 7);
      LAUNCH1(6, l); S16(WS_OA, (size_t)TT * 1024, 8); S16(WS_OM, (size_t)TT * 1024, 9); S16(WS_OL, (size_t)TT * 1024, 10);
      LAUNCH1(7, l); S16(WS_Y, (size_t)TT * DM, 11);
      LAUNCH1(8, l); S32(WS_XS, (size_t)TT * DM, 12);
      LAUNCH1(9, l); S16(WS_HB, (size_t)TT * DM, 13);
      LAUNCH1(10, l); S16(WS_PQ, (size_t)TT * DM, 14);
      LAUNCH1(11, l); S32(WS_PG, (size_t)TT * 128, 15);
      LAUNCH1(12, l); S32(WS_XS, (size_t)TT * DM, 16);
    }
    hipLaunchKernelGGL(k_dbg_out, dim3(NBATCH * SEQ / 4), dim3(256), 0, stream, (const float*)d_in[0], (const float*)d_in[29], (float*)d_out, flags, 16);
#elif defined(DBG_CHECK)
    unsigned* flags = (unsigned*)((char*)d_ws + WS_CTL + 32768);
    char* W = (char*)d_ws;
    LAUNCH1(0, 0);
    { const int l = 0; LAUNCH1(1, l); LAUNCH1(2, l); LAUNCH1(3, l); LAUNCH1(4, l); LAUNCH1(5, l); LAUNCH1(6, l);
#if DBG_CHECK == 5 || DBG_CHECK == 6
      hipLaunchKernelGGL(k_check_attn, dim3(16 * 24), dim3(256), 0, stream, (const unsigned char*)d_ws, DBG_CHECK == 5 ? 1 : 0, flags + 100);
#endif
#if DBG_CHECK == 7
      { float* obuf = (float*)(W + WS_MQ);
        hipLaunchKernelGGL(k_check_gla_rec, dim3(8), dim3(256), 0, stream, (const unsigned char*)d_ws, (const float*)d_in[I_WA2F], (const float*)d_in[I_BAF], (const float*)d_in[I_WA2B], (const float*)d_in[I_BAB], obuf, 0);
        hipLaunchKernelGGL(k_check_gla_cmp, dim3(RPB * 4), dim3(256), 0, stream, (const unsigned char*)d_ws, (const float*)obuf, (const float*)d_in[I_ONG], 0, flags + 100); }
#endif
      LAUNCH1(7, l); LAUNCH1(8, l); LAUNCH1(9, l); LAUNCH1(10, l);
#if DBG_CHECK == 1
      hipLaunchKernelGGL(k_check_gemm, dim3(32), dim3(256), 0, stream, (const bf16_t*)(W + WS_HB), DM, (const float*)d_in[I_PWQ], DM, DM, (const bf16_t*)(W + WS_PQ), DM, TT, flags + 100);
#endif
      LAUNCH1(11, l);
#if DBG_CHECK == 2
      hipLaunchKernelGGL(k_check_select, dim3(256 * 8), dim3(64), 0, stream, (const bf16_t*)(W + WS_PQ), (const float*)d_in[I_PK1], (const float*)d_in[I_PK2], (const int*)(W + WS_PIDX), (const float*)(W + WS_PG), flags + 100);
#endif
      LAUNCH1(12, l);
#if DBG_CHECK == 3
      hipLaunchKernelGGL(k_check_gather, dim3(128), dim3(64), 0, stream, (const bf16_t*)(W + WS_HB), (const float*)d_in[I_PU], (const float*)d_in[I_PV], (const int*)(W + WS_PIDX), (const float*)(W + WS_PG), (const float*)(W + WS_MQ), flags + 100);
#endif
    }
    hipLaunchKernelGGL(k_dbg_out2, dim3(NBATCH * SEQ / 4), dim3(256), 0, stream, (const float*)d_in[0], (const float*)d_in[29], (float*)d_out, flags + 100);
#else
    LAUNCH1(0, 0);
    for (int l = 0; l < DEPTH; ++l) { LAUNCH1(1, l); LAUNCH1(2, l); LAUNCH1(3, l);
#ifdef DBG_DUP23
        LAUNCH1(2, l); LAUNCH1(3, l);
#endif
        LAUNCH1(4, l); LAUNCH1(5, l);
#ifdef DBG_DUP45
        LAUNCH1(4, l); LAUNCH1(5, l);
#endif
        LAUNCH1(6, l); LAUNCH1(7, l); LAUNCH1(8, l); LAUNCH1(9, l); LAUNCH1(10, l); LAUNCH1(11, l); LAUNCH1(12, l); }
    LAUNCH1(13, DEPTH - 1);
#endif
#undef LAUNCH1
#endif
    const hipError_t le = hipPeekAtLastError();
    if (le != hipSuccess) fprintf(stderr, "kernel_launch: launch failed: %s\n", hipGetErrorName(le));
}
```

```cpp
#include <hip/hip_runtime.h>
#include <cstdio>
#include <cstdint>

#ifndef MK_N_LAUNCHES
#ifndef DBG_DUP
#define DBG_DUP -1
#endif
#define MK_N_LAUNCHES 1
#endif

#ifndef DBG_MIX0
#define DBG_MIX0 1.0f
#define DBG_MIX1 1.0f
#define DBG_PEER0 1.0f
#define DBG_PEER1 1.0f
#endif
#define LAS __attribute__((address_space(3)))
#define GLB __attribute__((address_space(1)))
typedef unsigned short bf16_t;
typedef short bf16x8 __attribute__((ext_vector_type(8)));
typedef short s16x4 __attribute__((ext_vector_type(4)));
typedef float f32x4 __attribute__((ext_vector_type(4)));
typedef float f32x2 __attribute__((ext_vector_type(2)));
typedef float f32x16 __attribute__((ext_vector_type(16)));
typedef unsigned u32x4 __attribute__((ext_vector_type(4)));
typedef unsigned u32x2 __attribute__((ext_vector_type(2)));
typedef __bf16 bf2_t __attribute__((ext_vector_type(2)));

constexpr int DM = 2048, NBATCH = 2, SEQ = 8192, CTXL = 256, DEPTH = 2;
constexpr int RPB = SEQ + CTXL;
constexpr int TT = NBATCH * RPB;
constexpr int IN_COLS = 11872, NP = 12032;
constexpr int C_AQ = 0, C_AK = 1024, C_AV = 1280, C_LQ = 1536, C_LK = 2048, C_LV = 2560, C_LG = 3584, C_LRF = 4608, C_LRB = 4624,
              C_MCQ = 4640, C_MCKV = 5152, C_MKR = 5664, C_GA = 5728, C_GL = 7776, C_GM = 9824;
constexpr int NCH = RPB / 64;
constexpr int NEXP = 16384;
constexpr float NORM_EPS = 1e-6f;
constexpr int NTHREADS = 512;

constexpr size_t al256(size_t x) { return (x + 255) / 256 * 256; }
constexpr size_t WS_CTL   = 0;
constexpr size_t CTL_BYTES = 65536;
constexpr size_t WS_MODV  = WS_CTL + CTL_BYTES;
constexpr size_t WS_TABA  = al256(WS_MODV + (size_t)2 * 3 * 12288 * 4);
constexpr size_t WS_TABM  = WS_TABA + 2 * 128 * 32 * 4;
constexpr size_t WS_XS    = al256(WS_TABM + 2 * 128 * 16 * 4);
constexpr size_t WS_HB    = WS_XS + (size_t)TT * DM * 4;
constexpr size_t WS_P     = WS_HB + (size_t)TT * DM * 2;
constexpr size_t WS_MQ    = WS_P + (size_t)TT * NP * 2;
constexpr size_t WS_MKV   = WS_MQ + (size_t)TT * 1536 * 2;
constexpr size_t WS_OA    = WS_MKV + (size_t)TT * 2048 * 2;
constexpr size_t WS_OL    = WS_OA + (size_t)TT * 1024 * 2;
constexpr size_t WS_OM    = WS_OL + (size_t)TT * 1024 * 2;
constexpr size_t WS_WIN   = WS_OM + (size_t)TT * 1024 * 2;
constexpr size_t WS_WUQ   = WS_WIN + (size_t)NP * 2048 * 2;
constexpr size_t WS_WUKV  = WS_WUQ + (size_t)1536 * 512 * 2;
constexpr size_t WS_WBR   = WS_WUKV + (size_t)2048 * 512 * 2;
constexpr size_t WS_WOUT  = WS_WBR + (size_t)3 * 2048 * 1024 * 2;
constexpr size_t WS_WQ    = WS_WOUT + (size_t)2048 * 2048 * 2;
constexpr size_t WS_K1    = WS_WQ + (size_t)2048 * 2048 * 2;
constexpr size_t WS_K2    = WS_K1 + (size_t)8 * 128 * 128 * 2;
constexpr size_t WS_GST   = WS_K2 + (size_t)8 * 128 * 128 * 2;
constexpr size_t WS_GDEC  = WS_GST + (size_t)NBATCH * 2 * 4 * NCH * 32768 * 2;
constexpr size_t WS_END   = WS_GDEC + (size_t)NBATCH * 2 * 4 * NCH * 128 * 4;
constexpr size_t WS_Y     = WS_MKV;
constexpr size_t WS_PQ    = WS_OA;
constexpr size_t WS_U8    = WS_P;
constexpr size_t WS_V8    = WS_U8 + (size_t)NEXP * DM;
constexpr size_t WS_SCU   = WS_V8 + (size_t)NEXP * DM;
constexpr size_t WS_SCV   = WS_SCU + (size_t)NEXP * 4;
constexpr size_t WS_PIDX  = WS_SCV + (size_t)NEXP * 4;
constexpr size_t WS_PG    = WS_PIDX + (size_t)TT * 128 * 4;
static_assert(WS_PG + (size_t)TT * 128 * 4 <= WS_MQ, "PEER alias region overflows P");

__device__ __forceinline__ unsigned cvt_pk_bf16(float lo, float hi) { bf2_t v; v.x = (__bf16)lo; v.y = (__bf16)hi; return __builtin_bit_cast(unsigned, v); }
__device__ __forceinline__ bf16_t f2bf(float f) { return (bf16_t)(cvt_pk_bf16(f, 0.f) & 0xffffu); }
__device__ __forceinline__ float bf2f(bf16_t b) { return __uint_as_float(((unsigned)b) << 16); }
__device__ __forceinline__ float bflo(unsigned w) { return __uint_as_float(w << 16); }
__device__ __forceinline__ float bfhi(unsigned w) { return __uint_as_float(w & 0xffff0000u); }
__device__ __forceinline__ float xchg32(float x, int lane) { auto r = __builtin_amdgcn_permlane32_swap(__float_as_uint(x), __float_as_uint(x), false, false); return __uint_as_float(lane < 32 ? r[1] : r[0]); }
__device__ __forceinline__ float xchg16(float x, int lane) { auto r = __builtin_amdgcn_permlane16_swap(__float_as_uint(x), __float_as_uint(x), false, false); return __uint_as_float((lane & 16) ? r[0] : r[1]); }
template <int CTRL> __device__ __forceinline__ float dppmov(float x) { return __uint_as_float(__builtin_amdgcn_update_dpp(0u, __float_as_uint(x), CTRL, 0xF, 0xF, false)); }
constexpr int DPP_ROR8 = 0x128, DPP_HMIRROR = 0x141, DPP_Q3210 = 0x1B, DPP_Q1032 = 0xB1;
__device__ __forceinline__ float wave_sum(float v) {
    const int lane = threadIdx.x & 63;
    v += xchg32(v, lane); v += xchg16(v, lane); v += dppmov<DPP_ROR8>(v); v += dppmov<DPP_HMIRROR>(v); v += dppmov<DPP_Q3210>(v); v += dppmov<DPP_Q1032>(v);
    return v;
}
__device__ __forceinline__ float sigmoidf_(float x) { return __builtin_amdgcn_rcpf(1.0f + __expf(-x)); }
__device__ __forceinline__ float siluf_(float x) { return x * __builtin_amdgcn_rcpf(1.0f + __expf(-x)); }

#define XB_TMO      128
#define XB_XCNT(j)  (256  + 64 * (j))
#define XB_XSUB(j)  (1280 + 64 * (j))
#define XB_XGEN(j)  (2304 + 64 * (j))
#define XB_TOP      3328
#define XB_TOPGEN   3392
#define XCD_BAR_WORDS 3456
#define XB_SPIN_CAP (1u << 20)
__device__ __forceinline__ unsigned xb_ld(unsigned* p)              { return __hip_atomic_load(p, __ATOMIC_RELAXED, __HIP_MEMORY_SCOPE_AGENT); }
__device__ __forceinline__ unsigned xb_add(unsigned* p, unsigned v) { return __hip_atomic_fetch_add(p, v, __ATOMIC_RELAXED, __HIP_MEMORY_SCOPE_AGENT); }
__device__ __forceinline__ unsigned xb_xcc_id() { return (unsigned)__builtin_amdgcn_s_getreg((3 << 11) | 20) & 0xFu; }
#define XB_SPIN(cond, bar) do { unsigned _sp = 0; while (cond) { __builtin_amdgcn_s_sleep(1); \
    if ((++_sp & 255u) == 0u) { if (xb_ld(&(bar)[XB_TMO])) break; if (_sp > XB_SPIN_CAP) { atomicAdd(&(bar)[XB_TMO], 1u); break; } } } } while (0)
struct XcdBarrier { unsigned* bar; unsigned x; volatile LAS unsigned* st; };
__device__ __forceinline__ XcdBarrier xcd_barrier_post(unsigned* bar, volatile LAS unsigned* st) {
    XcdBarrier b; b.bar = bar; b.x = xb_xcc_id(); b.st = st;
    if (threadIdx.x == 0) (void)xb_add(&bar[XB_XCNT(b.x)], 1u);
    return b;
}
__device__ __forceinline__ void xcd_barrier_complete(unsigned* bar, unsigned x, unsigned& nloc, unsigned& nx) {
    const unsigned G = gridDim.x * gridDim.y * gridDim.z;
    unsigned sum, cnt, mine, sp = 0u;
    for (;;) {
        sum = 0u; cnt = 0u; mine = 0u;
#pragma unroll
        for (unsigned j = 0; j < 16; ++j) { const unsigned c = xb_ld(&bar[XB_XCNT(j)]); sum += c; cnt += (c > 0u) ? 1u : 0u; mine = (j == x) ? c : mine; }
        if (sum == G) break;
        __builtin_amdgcn_s_sleep(1);
        if ((++sp & 255u) == 0u) { if (xb_ld(&bar[XB_TMO])) break; if (sp > XB_SPIN_CAP) { atomicAdd(&bar[XB_TMO], 1u); break; } }
    }
    nloc = mine > 0u ? mine : 1u; nx = cnt > 0u ? cnt : 1u;
}
__device__ __forceinline__ void xcd_barrier(const XcdBarrier& b) {
    asm volatile("s_waitcnt vmcnt(0)" ::: "memory");
    __syncthreads();
    if (threadIdx.x == 0) {
        unsigned* bar = b.bar;
        __builtin_amdgcn_s_waitcnt(0);
        unsigned nloc = b.st[0], nx = b.st[1];
        if (nloc == 0u) { xcd_barrier_complete(bar, b.x, nloc, nx); b.st[0] = nloc; b.st[1] = nx; }
        const unsigned old = xb_add(&bar[XB_XSUB(b.x)], 1u);
        const unsigned gen = old / nloc;
        if (old + 1u == (gen + 1u) * nloc) {
            __builtin_amdgcn_fence(__ATOMIC_RELEASE, "agent");
            asm volatile("s_waitcnt vmcnt(0)" ::: "memory");
            const unsigned og = xb_add(&bar[XB_TOP], 1u);
            const unsigned tg = og / nx;
            if (og + 1u == (tg + 1u) * nx) xb_add(&bar[XB_TOPGEN], 1u);
            else XB_SPIN(xb_ld(&bar[XB_TOPGEN]) == tg, bar);
            __builtin_amdgcn_fence(__ATOMIC_ACQUIRE, "agent");
            xb_add(&bar[XB_XGEN(b.x)], 1u);
            asm volatile("s_waitcnt vmcnt(0)" ::: "memory");
        } else {
            XB_SPIN(xb_ld(&bar[XB_XGEN(b.x)]) == gen, bar);
            __builtin_amdgcn_fence(__ATOMIC_ACQUIRE, "agent");
            asm volatile("s_waitcnt vmcnt(0)" ::: "memory");
        }
    }
    __syncthreads();
}

namespace pg8 {
constexpr int BM = 256, BK = 64, HALF = 128, HTB = HALF * BK * 2, STAGE_BYTES = 8 * HTB, NXCD = 8, WGM = 8;
__host__ __device__ __forceinline__ int lds_byte(int r, int c) { const int st = (r >> 4) * 2 + (c >> 5), rr = r & 15, cc = c & 31, ob = rr * 64 + cc * 2; return st * 1024 + (ob ^ (((ob >> 9) & 1) << 5)); }
__host__ __device__ __forceinline__ void stage_rc(int b, int& R, int& C) { const int st = b / 1024, sb = b % 1024, swz = sb ^ (((sb >> 9) & 1) << 5); R = (st >> 1) * 16 + swz / 64; C = (st & 1) * 32 + (swz % 64) / 2; }
__host__ __device__ __forceinline__ int perm32(int rho) { const int n = rho >> 4, i = rho & 15; return 8 * (i >> 2) + 4 * n + (i & 3); }
struct Unit { int pm, pn; };
struct Gemm { const bf16_t* A; const bf16_t* Bt; int M, N, K, lda, ldb; };
struct StaticOrder {
    int nM, nN, nwg, G, c, latent;
    __host__ __device__ void init(int M, int N, int G_, int c_, int latent_ = 0) { latent = latent_; nM = latent_ ? 64 : M / BM; nN = N / BM; nwg = nM * nN; G = G_; c = c_; }
    __host__ __device__ bool next(int i, Unit& u) const {
        const long L = (long)i * G + c; if (L >= nwg) return false;
        int wgid = (int)L; { const int q = nwg / NXCD, r = nwg % NXCD, xcd = wgid % NXCD, off = wgid / NXCD; wgid = (xcd < r ? xcd * (q + 1) : r * (q + 1) + (xcd - r) * q) + off; }
        const int nig = WGM * nN, gid = wgid / nig, fm = gid * WGM, gsz = (nM - fm) < WGM ? (nM - fm) : WGM;
        u.pm = fm + ((wgid % nig) % gsz); u.pn = (wgid % nig) / gsz; if (latent) u.pm += 1 + (u.pm >= 32 ? 1 : 0); return true;
    }
};
struct WinOrder {
    StaticOrder S; int full, nlat, G, c;
    __host__ __device__ void init(int G_, int c_, int full_) { full = full_; G = G_; c = c_; S.init(TT, NP, G_, c_, full_ ? 0 : 1); nlat = S.nwg; }
    __host__ __device__ bool next(int i, Unit& u) const {
        if (full) return S.next(i, u);
        const long L = (long)i * G + c;
        if (L < nlat) return S.next(i, u);
        const int q = (int)(L - nlat); if (q >= 24) return false;
        const int t = q % 12; u.pm = q < 12 ? 0 : 33;
        u.pn = t < 2 ? 4 + t : (t < 8 ? 8 + (t - 2) : (t == 8 ? 18 : 20 + (t - 9)));
        return true;
    }
};
struct EpiStoreBf16 {
    static constexpr bool PERM = true;
    bf16_t* O; int ldc;
    __device__ __forceinline__ void operator()(const f32x4 (&acc)[2][2][4][2], const Unit& u, int wr, int wc, int fr, int fq) const {
        const int row0 = u.pm * BM + wr * 64 + fr, col0 = u.pn * BM + wc * 32 + 8 * fq;
#pragma unroll
        for (int ai = 0; ai < 2; ++ai)
#pragma unroll
            for (int m = 0; m < 4; ++m) { bf16_t* rowp = O + (size_t)(row0 + ai * HALF + m * 16) * ldc + col0;
#pragma unroll
                for (int bj = 0; bj < 2; ++bj) { const f32x4 v0 = acc[ai][bj][m][0], v1 = acc[ai][bj][m][1];
                    u32x4 w; w.x = cvt_pk_bf16(v0[0], v0[1]); w.y = cvt_pk_bf16(v0[2], v0[3]); w.z = cvt_pk_bf16(v1[0], v1[1]); w.w = cvt_pk_bf16(v1[2], v1[3]);
                    *(u32x4*)(rowp + bj * HALF) = w; } }
    }
};
template <bool FIRST> struct EpiGate {
    static constexpr bool PERM = true;
    bf16_t* Y; int ldy; const bf16_t* Gt; int ldg;
    __device__ __forceinline__ void operator()(const f32x4 (&acc)[2][2][4][2], const Unit& u, int wr, int wc, int fr, int fq) const {
        const int row0 = u.pm * BM + wr * 64 + fr, col0 = u.pn * BM + wc * 32 + 8 * fq;
#pragma unroll
        for (int ai = 0; ai < 2; ++ai)
#pragma unroll
        for (int mh = 0; mh < 2; ++mh) {
            u32x4 g[2][2], y[2][2];
#pragma unroll
            for (int mm = 0; mm < 2; ++mm)
#pragma unroll
                for (int bj = 0; bj < 2; ++bj) { const size_t r = (size_t)(row0 + ai * HALF + (mh * 2 + mm) * 16);
                    g[mm][bj] = *(const u32x4*)(Gt + r * ldg + col0 + bj * HALF);
                    if (!FIRST) y[mm][bj] = *(const u32x4*)(Y + r * ldy + col0 + bj * HALF); }
#pragma unroll
            for (int mm = 0; mm < 2; ++mm)
#pragma unroll
                for (int bj = 0; bj < 2; ++bj) { const int m = mh * 2 + mm; const size_t r = (size_t)(row0 + ai * HALF + m * 16); const f32x4 v0 = acc[ai][bj][m][0], v1 = acc[ai][bj][m][1]; const u32x4 gg = g[mm][bj];
                    float o[8];
                    o[0] = sigmoidf_(bflo(gg.x)) * v0[0]; o[1] = sigmoidf_(bfhi(gg.x)) * v0[1]; o[2] = sigmoidf_(bflo(gg.y)) * v0[2]; o[3] = sigmoidf_(bfhi(gg.y)) * v0[3];
                    o[4] = sigmoidf_(bflo(gg.z)) * v1[0]; o[5] = sigmoidf_(bfhi(gg.z)) * v1[1]; o[6] = sigmoidf_(bflo(gg.w)) * v1[2]; o[7] = sigmoidf_(bfhi(gg.w)) * v1[3];
                    if (!FIRST) { const u32x4 yy = y[mm][bj];
                        o[0] += bflo(yy.x); o[1] += bfhi(yy.x); o[2] += bflo(yy.y); o[3] += bfhi(yy.y); o[4] += bflo(yy.z); o[5] += bfhi(yy.z); o[6] += bflo(yy.w); o[7] += bfhi(yy.w); }
                    u32x4 w; w.x = cvt_pk_bf16(o[0], o[1]); w.y = cvt_pk_bf16(o[2], o[3]); w.z = cvt_pk_bf16(o[4], o[5]); w.w = cvt_pk_bf16(o[6], o[7]);
                    *(u32x4*)(Y + r * ldy + col0 + bj * HALF) = w; }
        }
    }
};
struct EpiResid {
    static constexpr bool PERM = false;
    float* X; int ldx; const float* gate; float gscale;
    __device__ __forceinline__ void operator()(const f32x4 (&acc)[2][2][4][2], const Unit& u, int wr, int wc, int fr, int fq) const {
        const int row0 = u.pm * BM + wr * 64 + fr, col0 = u.pn * BM + wc * 32 + 4 * fq;
        const int sel = (u.pm % 33 == 0) ? 2 : (u.pm / 33);
        const float* gp = gate + (size_t)sel * 12288 + col0;
        f32x4 gv[2][2];
#pragma unroll
        for (int bj = 0; bj < 2; ++bj)
#pragma unroll
            for (int n = 0; n < 2; ++n) gv[bj][n] = *(const f32x4*)(gp + bj * HALF + n * 16) * gscale;
#pragma unroll
        for (int ai = 0; ai < 2; ++ai)
#pragma unroll
            for (int mh = 0; mh < 2; ++mh) {
                f32x4 x[2][2][2];
#pragma unroll
                for (int mm = 0; mm < 2; ++mm)
#pragma unroll
                    for (int bj = 0; bj < 2; ++bj)
#pragma unroll
                        for (int n = 0; n < 2; ++n) x[mm][bj][n] = *(const f32x4*)(X + (size_t)(row0 + ai * HALF + (mh * 2 + mm) * 16) * ldx + col0 + bj * HALF + n * 16);
#pragma unroll
                for (int mm = 0; mm < 2; ++mm)
#pragma unroll
                    for (int bj = 0; bj < 2; ++bj)
#pragma unroll
                        for (int n = 0; n < 2; ++n) *(f32x4*)(X + (size_t)(row0 + ai * HALF + (mh * 2 + mm) * 16) * ldx + col0 + bj * HALF + n * 16) = x[mm][bj][n] + gv[bj][n] * acc[ai][bj][mh * 2 + mm][n];
            }
    }
};

template <class Epi, class Sched>
__device__ __forceinline__ void gemm_phase(LAS unsigned char* lds, const int tid, const Gemm g, const Sched& S, const Epi& E) {
    const int wid = __builtin_amdgcn_readfirstlane(tid >> 6), lane = tid & 63, wr = wid >> 2, wc = wid & 3, fr = lane & 15, fq = lane >> 4;
    const int K = g.K, nt = K / BK, lda = g.lda, ldb = g.ldb;
    unsigned voffA[2], voffB[2];
#pragma unroll
    for (int i = 0; i < 2; ++i) { int R, C; stage_rc(tid * 16 + i * 8192, R, C); const int Rb = Epi::PERM ? ((R & ~31) + perm32(R & 31)) : R;
        voffA[i] = (unsigned)(R * lda + C) * 2u; voffB[i] = (unsigned)(Rb * ldb + C) * 2u; }
    const size_t kstep = (size_t)(BK * 2);
    const size_t hstepA = (size_t)HALF * lda * 2, hstepB = (size_t)HALF * ldb * 2;
    const size_t tstepA = 2 * hstepA, tstepB = 2 * hstepB;
    const unsigned ldsw = (unsigned)wid * 1024u;
    const int aoff = lds_byte(wr * 64 + fr, fq * 8), boff = lds_byte(wc * 32 + fr, fq * 8);
#define PG8_SA(b, h) (((b) * 2 + (h)) * HTB)
#define PG8_SB(b, h) ((4 + (b) * 2 + (h)) * HTB)
#define PG8_STAGE(bufoff, gbase, voff) do { _Pragma("unroll") for (int _i = 0; _i < 2; ++_i) \
        __builtin_amdgcn_global_load_lds((const unsigned*)((const char*)(gbase) + (voff)[_i]), (LAS unsigned*)(lds + (bufoff) + ldsw + _i * 8192), 16, 0, 0); } while (0)
#define PG8_LDA(dst, b, h) do { _Pragma("unroll") for (int m = 0; m < 4; ++m) _Pragma("unroll") for (int k = 0; k < 2; ++k) dst[m][k] = *(const LAS bf16x8*)(lds + PG8_SA(b, h) + aoff + m * 2048 + k * 1024); } while (0)
#define PG8_LDB(dst, b, h) do { _Pragma("unroll") for (int n = 0; n < 2; ++n) _Pragma("unroll") for (int k = 0; k < 2; ++k) dst[n][k] = *(const LAS bf16x8*)(lds + PG8_SB(b, h) + boff + n * 2048 + k * 1024); } while (0)
#define PG8_MMA(ai, bj, At, Bt) do { __builtin_amdgcn_s_setprio(1); _Pragma("unroll") for (int m = 0; m < 4; ++m) _Pragma("unroll") for (int n = 0; n < 2; ++n) _Pragma("unroll") for (int k = 0; k < 2; ++k) \
        acc[ai][bj][m][n] = __builtin_amdgcn_mfma_f32_16x16x32_bf16(Bt[n][k], At[m][k], acc[ai][bj][m][n], 0, 0, 0); __builtin_amdgcn_s_setprio(0); } while (0)
#define PG8_WAIT_V(n) asm volatile("s_waitcnt vmcnt(" #n ")" ::: "memory")
#define PG8_WAIT_L(n) asm volatile("s_waitcnt lgkmcnt(" #n ")" ::: "memory")
#define PG8_BAR __builtin_amdgcn_s_barrier()
#define PG8_SCHED __builtin_amdgcn_sched_barrier(0)
    Unit cur, nxt; int ui = 0;
    if (!S.next(0, cur)) return;
    f32x4 acc[2][2][4][2];
#pragma unroll
    for (int a = 0; a < 2; ++a)
#pragma unroll
        for (int b = 0; b < 2; ++b)
#pragma unroll
            for (int m = 0; m < 4; ++m)
#pragma unroll
                for (int n = 0; n < 2; ++n) acc[a][b][m][n] = (f32x4){0.f, 0.f, 0.f, 0.f};
    bf16x8 At[4][2], B0[2][2], B1[2][2];
    const char* cA = (const char*)g.A + (size_t)cur.pm * tstepA; const char* cB = (const char*)g.Bt + (size_t)cur.pn * tstepB;
    PG8_STAGE(PG8_SB(0, 0), cB, voffB); PG8_STAGE(PG8_SA(0, 0), cA, voffA); PG8_STAGE(PG8_SB(0, 1), cB + hstepB, voffB); PG8_STAGE(PG8_SA(0, 1), cA + hstepA, voffA);
    if (wr == 1) PG8_BAR;
    PG8_WAIT_V(4); PG8_BAR;
    PG8_STAGE(PG8_SB(1, 0), cB + kstep, voffB); PG8_STAGE(PG8_SA(1, 0), cA + kstep, voffA); PG8_STAGE(PG8_SB(1, 1), cB + hstepB + kstep, voffB);
    PG8_WAIT_V(6); PG8_BAR;
    for (;;) {
        const bool has_next = S.next(ui + 1, nxt);
        const char* nA = has_next ? (const char*)g.A + (size_t)nxt.pm * tstepA : cA; const char* nB = has_next ? (const char*)g.Bt + (size_t)nxt.pn * tstepB : cB;
        for (int t = 0; t < nt; t += 2) {
            const bool last = (t == nt - 2);
            const char* a1 = cA + (size_t)(t + 1) * kstep;
            const char* a2 = last ? nA : cA + (size_t)(t + 2) * kstep; const char* b2 = last ? nB : cB + (size_t)(t + 2) * kstep;
            const char* a3 = a2 + kstep; const char* b3 = b2 + kstep;
            PG8_LDB(B0, 0, 0); PG8_SCHED; PG8_LDA(At, 0, 0); PG8_STAGE(PG8_SA(1, 1), a1 + hstepA, voffA);
            PG8_WAIT_L(8); PG8_BAR; PG8_WAIT_L(0); PG8_MMA(0, 0, At, B0); PG8_BAR; PG8_SCHED;
            PG8_LDB(B1, 0, 1); PG8_STAGE(PG8_SB(0, 0), b2, voffB);
            PG8_BAR; PG8_WAIT_L(0); PG8_MMA(0, 1, At, B1); PG8_BAR;
            PG8_LDA(At, 0, 1); PG8_STAGE(PG8_SA(0, 0), a2, voffA);
            PG8_BAR; PG8_WAIT_L(0); PG8_MMA(1, 0, At, B0); PG8_BAR; PG8_SCHED;
            PG8_STAGE(PG8_SB(0, 1), b2 + hstepB, voffB);
            PG8_WAIT_V(6); PG8_BAR; PG8_MMA(1, 1, At, B1); PG8_BAR;
            PG8_LDB(B0, 1, 0); PG8_SCHED; PG8_LDA(At, 1, 0); PG8_STAGE(PG8_SA(0, 1), a2 + hstepA, voffA);
            PG8_WAIT_L(8); PG8_BAR; PG8_WAIT_L(0); PG8_MMA(0, 0, At, B0); PG8_BAR; PG8_SCHED;
            PG8_LDB(B1, 1, 1); PG8_STAGE(PG8_SB(1, 0), b3, voffB);
            PG8_BAR; PG8_WAIT_L(0); PG8_MMA(0, 1, At, B1); PG8_BAR;
            PG8_LDA(At, 1, 1); PG8_STAGE(PG8_SA(1, 0), a3, voffA);
            PG8_BAR; PG8_WAIT_L(0); PG8_MMA(1, 0, At, B0); PG8_BAR; PG8_SCHED;
            PG8_STAGE(PG8_SB(1, 1), b3 + hstepB, voffB);
            PG8_WAIT_V(6); PG8_BAR; PG8_MMA(1, 1, At, B1); PG8_BAR;
        }
        E(acc, cur, wr, wc, fr, fq);
        if (!has_next) break;
#pragma unroll
        for (int a = 0; a < 2; ++a)
#pragma unroll
            for (int b = 0; b < 2; ++b)
#pragma unroll
                for (int m = 0; m < 4; ++m)
#pragma unroll
                    for (int n = 0; n < 2; ++n) acc[a][b][m][n] = (f32x4){0.f, 0.f, 0.f, 0.f};
        cur = nxt; cA = nA; cB = nB; ++ui;
    }
    PG8_WAIT_V(0);
    if (wr == 0) PG8_BAR;
    PG8_BAR;
#undef PG8_SA
#undef PG8_SB
#undef PG8_STAGE
#undef PG8_LDA
#undef PG8_LDB
#undef PG8_MMA
#undef PG8_WAIT_V
#undef PG8_WAIT_L
#undef PG8_BAR
#undef PG8_SCHED
}
}

struct Args { const float* in[30]; float* out; unsigned char* ws; int ph_lo, ph_hi; };
enum { I_X = 0, I_C, I_CTX, I_CCTX, I_WMOD, I_BMOD, I_N1G, I_WIN, I_QNG, I_KNG, I_WA2F, I_BAF, I_WA2B, I_BAB, I_ONG, I_MQNG, I_WUQ, I_MKVNG, I_WUKV,
       I_WBRA, I_WBRL, I_WBRM, I_WOUT, I_N2G, I_PWQ, I_PK1, I_PK2, I_PU, I_PV, I_FG };
typedef const float* cfp_t;
struct Ctx {
    const __attribute__((address_space(4))) cfp_t* in; float* out; unsigned char* ws; LAS unsigned char* lds;
    int tid, lane, wid, G, bid;
};
#define WSP(T, off) ((T*)(C.ws + (off)))
#define INP(i) ((const float*)(const GLB float*)C.in[(i)])
__device__ __forceinline__ unsigned long long launder_u64(unsigned long long w) {
    unsigned lo = (unsigned)w, hi = (unsigned)(w >> 32); asm volatile("" : "+v"(lo), "+v"(hi));
    lo = __builtin_amdgcn_readfirstlane(lo); hi = __builtin_amdgcn_readfirstlane(hi); return ((unsigned long long)hi << 32) | lo;
}
__device__ __forceinline__ Ctx launder(const Ctx& C0) {
    Ctx R = C0; int t = C0.tid; asm volatile("" : "+v"(t)); R.tid = t; R.lane = t & 63; R.wid = __builtin_amdgcn_readfirstlane(t >> 6);
    R.ws = (unsigned char*)(GLB unsigned char*)launder_u64((unsigned long long)C0.ws);
    R.out = (float*)(GLB float*)(unsigned long long)C0.out;
    R.in = (const __attribute__((address_space(4))) cfp_t*)launder_u64((unsigned long long)C0.in);
    unsigned l = (unsigned)(uintptr_t)C0.lds; asm volatile("" : "+v"(l)); l = __builtin_amdgcn_readfirstlane(l); R.lds = (LAS unsigned char*)(uintptr_t)l;
    return R;
}

__device__ __forceinline__ const float* src_row(const Ctx& C, int r) {
    const int b = r / RPB, j = r % RPB;
    return j < CTXL ? INP(I_CTX) + ((size_t)b * CTXL + j) * DM : INP(I_X) + ((size_t)b * SEQ + (j - CTXL)) * DM;
}
__device__ __forceinline__ int mod_sel(int r) { const int b = r / RPB, j = r % RPB; return j < CTXL ? 2 : b; }

__device__ __forceinline__ void phase_modv(const Ctx& C) {
    LAS float* sc = (LAS float*)C.lds;
    LAS float* red = (LAS float*)(C.lds + 3 * 2048 * 4);
    for (int i = C.tid; i < 3 * DM; i += NTHREADS) { const int r = i / DM, k = i % DM; const float v = r < 2 ? INP(I_C)[r * DM + k] : INP(I_CCTX)[k]; sc[i] = siluf_(v); }
    __syncthreads();
    float* modv = WSP(float, WS_MODV);
    const int kq = C.tid / 12, c4 = C.tid % 12;
    for (int item = C.bid; item < 2 * 256; item += C.G) {
        const int l = item / 256, cg = item % 256;
        float acc[3][4];
#pragma unroll
        for (int r = 0; r < 3; ++r)
#pragma unroll
            for (int j = 0; j < 4; ++j) acc[r][j] = 0.f;
        if (kq < 42) {
            const float* wp = INP(I_WMOD) + (size_t)l * DM * 12288 + 48 * cg + 4 * c4;
            for (int k = kq; k < DM; k += 42) {
                const f32x4 w = *(const f32x4*)(wp + (size_t)k * 12288);
#pragma unroll
                for (int r = 0; r < 3; ++r) { const float s = sc[r * DM + k];
#pragma unroll
                    for (int j = 0; j < 4; ++j) acc[r][j] += s * w[j]; }
            }
#pragma unroll
            for (int r = 0; r < 3; ++r)
#pragma unroll
                for (int j = 0; j < 4; ++j) red[kq * 144 + r * 48 + c4 * 4 + j] = acc[r][j];
        }
        __syncthreads();
        if (C.tid < 144) { float s = 0.f; for (int q = 0; q < 42; ++q) s += red[q * 144 + C.tid];
            const int r = C.tid / 48, cc = C.tid % 48;
            modv[((size_t)l * 3 + r) * 12288 + 48 * cg + cc] = s + INP(I_BMOD)[(size_t)l * 12288 + 48 * cg + cc]; }
        __syncthreads();
    }
}
__device__ __forceinline__ void phase_tables(const Ctx& C) {
    float* ta = WSP(float, WS_TABA); float* tm = WSP(float, WS_TABM);
    for (int i = C.bid * NTHREADS + C.tid; i < 128 * 32 + 128 * 16; i += C.G * NTHREADS) {
        if (i < 128 * 32) { const int pos = i / 32, f = i % 32; const float inv = exp2f(-(float)f * (13.287712379549449f / 32.0f)); const float a = (float)pos * inv;
            ta[i] = cosf(a); ta[128 * 32 + i] = sinf(a); }
        else { const int k = i - 128 * 32, pos = k / 16, f = k % 16; const float inv = exp2f(-(float)f * (13.287712379549449f / 16.0f)); const float a = (float)pos * inv;
            tm[k] = cosf(a); tm[128 * 16 + k] = sinf(a); }
    }
}
__device__ __forceinline__ void transpose_cvt(const Ctx& C, const float* src, int K, int N, bf16_t* dst, int Npad, int& item) {
    LAS float* tile = (LAS float*)C.lds;
    const int tk = K / 64, tn = Npad / 64, ntile = tk * tn;
    const int t0 = ((C.bid - item % C.G) + C.G) % C.G; item += ntile;
    for (int t = t0; t < ntile; t += C.G) {
        const int k0 = (t / tn) * 64, n0 = (t % tn) * 64;
#pragma unroll
        for (int p = 0; p < 2; ++p) { const int kk = (C.tid >> 4) + p * 32, nn = (C.tid & 15) * 4;
            f32x4 v = (f32x4){0.f, 0.f, 0.f, 0.f};
            if (n0 + nn < N) v = *(const f32x4*)(src + (size_t)(k0 + kk) * N + n0 + nn);
#pragma unroll
            for (int j = 0; j < 4; ++j) tile[kk * 65 + nn + j] = v[j]; }
        __syncthreads();
        { const int n = C.tid >> 3, k8 = (C.tid & 7) * 8; float v[8];
#pragma unroll
          for (int j = 0; j < 8; ++j) v[j] = tile[(k8 + j) * 65 + n];
          u32x4 w; w.x = cvt_pk_bf16(v[0], v[1]); w.y = cvt_pk_bf16(v[2], v[3]); w.z = cvt_pk_bf16(v[4], v[5]); w.w = cvt_pk_bf16(v[6], v[7]);
          *(u32x4*)(dst + (size_t)(n0 + n) * K + k0 + k8) = w; }
        __syncthreads();
    }
}
__device__ __forceinline__ void cvt_plain(const Ctx& C, const float* src, bf16_t* dst, size_t n8) {
    for (size_t i = (size_t)C.bid * NTHREADS + C.tid; i < n8; i += (size_t)C.G * NTHREADS) {
        const f32x4 a = *(const f32x4*)(src + i * 8), b = *(const f32x4*)(src + i * 8 + 4);
        u32x4 w; w.x = cvt_pk_bf16(a[0], a[1]); w.y = cvt_pk_bf16(a[2], a[3]); w.z = cvt_pk_bf16(b[0], b[1]); w.w = cvt_pk_bf16(b[2], b[3]);
        *(u32x4*)(dst + i * 8) = w;
    }
}
__device__ __forceinline__ void phase_cvt_mixer_weights(const Ctx& C, int l) {
    int item = 0;
    transpose_cvt(C, INP(I_WIN) + (size_t)l * DM * IN_COLS, DM, IN_COLS, WSP(bf16_t, WS_WIN), NP, item);
    transpose_cvt(C, INP(I_WUQ) + (size_t)l * 512 * 1536, 512, 1536, WSP(bf16_t, WS_WUQ), 1536, item);
    transpose_cvt(C, INP(I_WUKV) + (size_t)l * 512 * 2048, 512, 2048, WSP(bf16_t, WS_WUKV), 2048, item);
    transpose_cvt(C, INP(I_WBRA) + (size_t)l * 1024 * 2048, 1024, 2048, WSP(bf16_t, WS_WBR), 2048, item);
    transpose_cvt(C, INP(I_WBRL) + (size_t)l * 1024 * 2048, 1024, 2048, WSP(bf16_t, WS_WBR) + (size_t)2048 * 1024, 2048, item);
    transpose_cvt(C, INP(I_WBRM) + (size_t)l * 1024 * 2048, 1024, 2048, WSP(bf16_t, WS_WBR) + (size_t)2 * 2048 * 1024, 2048, item);
    transpose_cvt(C, INP(I_WOUT) + (size_t)l * 2048 * 2048, 2048, 2048, WSP(bf16_t, WS_WOUT), 2048, item);
    transpose_cvt(C, INP(I_PWQ) + (size_t)l * 2048 * 2048, 2048, 2048, WSP(bf16_t, WS_WQ), 2048, item);
    cvt_plain(C, INP(I_PK1) + (size_t)l * 8 * 128 * 128, WSP(bf16_t, WS_K1), 8 * 128 * 128 / 8);
    cvt_plain(C, INP(I_PK2) + (size_t)l * 8 * 128 * 128, WSP(bf16_t, WS_K2), 8 * 128 * 128 / 8);
}
__device__ __forceinline__ void phase_cvt_peer_tables(const Ctx& C, int l) {
    const int lane = C.lane;
    for (int row = C.bid * 8 + C.wid; row < NEXP; row += C.G * 8) {
#pragma unroll 1
        for (int tb = 0; tb < 2; ++tb) {
            const float* src = (tb ? INP(I_PV) : INP(I_PU)) + ((size_t)l * NEXP + row) * DM + lane * 16;
            f32x4 x[8]; float amax = 0.f;
#pragma unroll
            for (int c = 0; c < 2; ++c)
#pragma unroll
                for (int q = 0; q < 4; ++q) { x[c * 4 + q] = *(const f32x4*)(src + c * 1024 + q * 4);
                    amax = fmaxf(amax, fmaxf(fmaxf(fabsf(x[c * 4 + q][0]), fabsf(x[c * 4 + q][1])), fmaxf(fabsf(x[c * 4 + q][2]), fabsf(x[c * 4 + q][3])))); }
#pragma unroll
            for (int o = 0; o < 1; ++o) { amax = fmaxf(amax, xchg32(amax, lane)); amax = fmaxf(amax, xchg16(amax, lane)); amax = fmaxf(amax, dppmov<DPP_ROR8>(amax));
                amax = fmaxf(amax, dppmov<DPP_HMIRROR>(amax)); amax = fmaxf(amax, dppmov<DPP_Q3210>(amax)); amax = fmaxf(amax, dppmov<DPP_Q1032>(amax)); }
            const float sc = amax > 0.f ? 224.0f / amax : 1.0f, inv = amax > 0.f ? amax * (1.0f / 224.0f) : 1.0f;
            unsigned char* dst = C.ws + (tb ? WS_V8 : WS_U8) + (size_t)(lane >> 3) * ((size_t)NEXP * 128) + (size_t)row * 128 + (lane & 7) * 16;
#pragma unroll
            for (int c = 0; c < 2; ++c) { u32x4 w;
#pragma unroll
                for (int q = 0; q < 4; ++q) { const f32x4 v = x[c * 4 + q] * sc; int p = __builtin_amdgcn_cvt_pk_fp8_f32(v[0], v[1], 0, false); p = __builtin_amdgcn_cvt_pk_fp8_f32(v[2], v[3], p, true); w[q] = (unsigned)p; }
                *(u32x4*)(dst + (size_t)c * 8 * ((size_t)NEXP * 128)) = w; }
            if (lane == 0) WSP(float, tb ? WS_SCV : WS_SCU)[row] = inv;
        }
    }
}

template <bool FIRST> __device__ __forceinline__ void phase_norm_mod(const Ctx& C, const float* gvec, const float* modl  , int shift_off, int scale_off) {
    float* xs = WSP(float, WS_XS); bf16_t* hb = WSP(bf16_t, WS_HB);
    for (int r = C.bid * 8 + C.wid; r < TT; r += C.G * 8) {
        const float* xr = FIRST ? src_row(C, r) : xs + (size_t)r * DM;
        const float* mv = modl + (size_t)mod_sel(r) * 12288;
        f32x4 v[8]; float ss = 0.f;
#pragma unroll
        for (int c = 0; c < 4; ++c) { v[2 * c] = *(const f32x4*)(xr + c * 512 + C.lane * 8); v[2 * c + 1] = *(const f32x4*)(xr + c * 512 + C.lane * 8 + 4); }
#pragma unroll
        for (int c = 0; c < 8; ++c) ss += v[c][0] * v[c][0] + v[c][1] * v[c][1] + v[c][2] * v[c][2] + v[c][3] * v[c][3];
        ss = wave_sum(ss);
        const float rs = rsqrtf(ss * (1.0f / DM) + NORM_EPS);
#pragma unroll
        for (int c = 0; c < 4; ++c) { const int col = c * 512 + C.lane * 8;
            if (FIRST) { *(f32x4*)(xs + (size_t)r * DM + col) = v[2 * c]; *(f32x4*)(xs + (size_t)r * DM + col + 4) = v[2 * c + 1]; }
            float o[8];
#pragma unroll
            for (int h = 0; h < 2; ++h) { const f32x4 g = *(const f32x4*)(gvec + col + 4 * h), s = *(const f32x4*)(mv + scale_off + col + 4 * h), t = *(const f32x4*)(mv + shift_off + col + 4 * h);
#pragma unroll
                for (int j = 0; j < 4; ++j) o[4 * h + j] = v[2 * c + h][j] * rs * g[j] * (1.0f + s[j]) + t[j]; }
            u32x4 w; w.x = cvt_pk_bf16(o[0], o[1]); w.y = cvt_pk_bf16(o[2], o[3]); w.z = cvt_pk_bf16(o[4], o[5]); w.w = cvt_pk_bf16(o[6], o[7]);
            *(u32x4*)(hb + (size_t)r * DM + col) = w; }
    }
}

__device__ __forceinline__ void phase_post_p(const Ctx& C, int l) {
    bf16_t* P = WSP(bf16_t, WS_P); const float* ta = WSP(float, WS_TABA); const float* tm = WSP(float, WS_TABM);
    const float* qg = INP(I_QNG) + l * 128; const float* kg = INP(I_KNG) + l * 128;
    const float* mqg = INP(I_MQNG) + l * 512; const float* mkvg = INP(I_MKVNG) + l * 512;
    const int lane = C.lane;
    const float qg1 = qg[lane], qg2 = qg[lane + 64], kg1 = kg[lane], kg2 = kg[lane + 64];
    for (int r = C.bid * 8 + C.wid; r < TT; r += C.G * 8) {
        bf16_t* pr = P + (size_t)r * NP;
        const int j = r % RPB; const bool lat = j >= CTXL; const int pos = lat ? j - CTXL : 0, ri = pos >> 6, ci = pos & 63;
        float cs = 1.f, sn = 0.f;
        if (lat) { const int p = lane < 32 ? ri : ci, f = lane & 31; cs = ta[p * 32 + f]; sn = ta[128 * 32 + p * 32 + f]; }
#pragma unroll
        for (int h = 0; h < 10; ++h) {
            bf16_t* hp = pr + (h < 8 ? C_AQ + h * 128 : C_AK + (h - 8) * 128);
            const float x1 = bf2f(hp[lane]), x2 = bf2f(hp[lane + 64]);
            const float ss = wave_sum(x1 * x1 + x2 * x2);
            const float rs = rsqrtf(ss * (1.0f / 128.0f) + NORM_EPS);
            const float y1 = x1 * rs * (h < 8 ? qg1 : kg1), y2 = x2 * rs * (h < 8 ? qg2 : kg2);
            hp[lane] = f2bf(y1 * cs - y2 * sn); hp[lane + 64] = f2bf(y2 * cs + y1 * sn);
        }
#pragma unroll
        for (int s = 0; s < 2; ++s) {
            bf16_t* sp = pr + (s == 0 ? C_MCQ : C_MCKV) + lane * 8; const float* gg = (s == 0 ? mqg : mkvg) + lane * 8;
            const u32x4 w = *(const u32x4*)sp; float x[8] = {bflo(w.x), bfhi(w.x), bflo(w.y), bfhi(w.y), bflo(w.z), bfhi(w.z), bflo(w.w), bfhi(w.w)};
            float ss = 0.f;
#pragma unroll
            for (int i = 0; i < 8; ++i) ss += x[i] * x[i];
            ss = wave_sum(ss);
            const float rs = rsqrtf(ss * (1.0f / 512.0f) + NORM_EPS);
#pragma unroll
            for (int i = 0; i < 8; ++i) x[i] = x[i] * rs * gg[i];
            u32x4 o; o.x = cvt_pk_bf16(x[0], x[1]); o.y = cvt_pk_bf16(x[2], x[3]); o.z = cvt_pk_bf16(x[4], x[5]); o.w = cvt_pk_bf16(x[6], x[7]);
            *(u32x4*)sp = o;
        }
        if (lat) { bf16_t* kp = pr + C_MKR; const int i = lane & 31; const float x1 = bf2f(kp[i]), x2 = bf2f(kp[i + 32]);
            const int p = i < 16 ? ri : ci, f = i & 15; const float c2 = tm[p * 16 + f], s2 = tm[128 * 16 + p * 16 + f];
            if (lane < 32) { kp[i] = f2bf(x1 * c2 - x2 * s2); kp[i + 32] = f2bf(x2 * c2 + x1 * s2); } }
    }
}

namespace att {
constexpr int NW = 8, QBLK = 32, KVBLK = 64, DV = 128;
constexpr float THR = 8.f;
#define SBAR() __builtin_amdgcn_sched_barrier(0)
__device__ __forceinline__ int crow(int r, int hi) { return (r & 3) + 8 * (r >> 2) + 4 * hi; }
template <int DQ> struct Cf {
    static constexpr int ND0 = DQ / 16, KROWB = DQ * 2, SHM_K = KVBLK * DQ * 2, SHM_V = KVBLK * DV * 2, SHM = 2 * SHM_V + 2 * SHM_K + NW * 64 * 4;
    static constexpr float SCALE = DQ == 128 ? 0.088388347648318440f : 0.072168783648703220f;
    __device__ static __forceinline__ int kswz(int row, int colB) { return row * KROWB + (colB ^ ((row & 7) << 4)); }
};
template <int DQ> __device__ __forceinline__ void partialSM(f32x16& p0, f32x16& p1, float& m_reg, float& mn, float& alpha) {
    constexpr float SC = Cf<DQ>::SCALE, Cc = SC * 1.4426950408889634f;
    float pmax = p0[0];
#pragma unroll
    for (int r = 1; r < 16; ++r) pmax = fmaxf(pmax, p0[r]);
#pragma unroll
    for (int r = 0; r < 16; ++r) pmax = fmaxf(pmax, p1[r]);
    { auto rr = __builtin_amdgcn_permlane32_swap(__float_as_uint(pmax), __float_as_uint(pmax), false, false);
      pmax = fmaxf(__uint_as_float(rr[0]), __uint_as_float(rr[1])); }
    if (__builtin_expect(__all(pmax - m_reg <= THR / SC), 1)) { mn = m_reg; alpha = 1.f; }
    else { mn = fmaxf(m_reg, pmax); alpha = __builtin_amdgcn_exp2f((m_reg - mn) * Cc); m_reg = mn; }
    const float mnC = -mn * Cc;
#pragma unroll
    for (int r = 0; r < 16; ++r) p0[r] = fmaf(p0[r], Cc, mnC);
#pragma unroll
    for (int r = 0; r < 16; ++r) p1[r] = fmaf(p1[r], Cc, mnC);
#pragma unroll
    for (int r = 0; r < 16; ++r) p0[r] = __builtin_amdgcn_exp2f(p0[r]);
}
__device__ __forceinline__ void finishSM(f32x16& p0, f32x16& p1, float alpha, float& l_reg, bf16x8& pa0, bf16x8& pa1, bf16x8& pa2, bf16x8& pa3) {
#pragma unroll
    for (int r = 0; r < 16; ++r) p1[r] = __builtin_amdgcn_exp2f(p1[r]);
    float ps = 0;
#pragma unroll
    for (int r = 0; r < 16; ++r) ps += p0[r];
#pragma unroll
    for (int r = 0; r < 16; ++r) ps += p1[r];
    { auto rr = __builtin_amdgcn_permlane32_swap(__float_as_uint(ps), __float_as_uint(ps), false, false);
      ps = __uint_as_float(rr[0]) + __uint_as_float(rr[1]); }
    l_reg = l_reg * alpha + ps;
#define PK4(P, BASE, OUT) do { unsigned a0 = cvt_pk_bf16(P[BASE + 0], P[BASE + 1]), a1 = cvt_pk_bf16(P[BASE + 2], P[BASE + 3]);   \
    unsigned b0 = cvt_pk_bf16(P[BASE + 4], P[BASE + 5]), b1 = cvt_pk_bf16(P[BASE + 6], P[BASE + 7]);                              \
    auto r0 = __builtin_amdgcn_permlane32_swap(a0, b0, false, false); auto r1 = __builtin_amdgcn_permlane32_swap(a1, b1, false, false); \
    u32x4 w = {r0[0], r1[0], r0[1], r1[1]}; OUT = *reinterpret_cast<bf16x8*>(&w); } while (0)
    PK4(p0, 0, pa0); PK4(p0, 8, pa1); PK4(p1, 0, pa2); PK4(p1, 8, pa3);
#undef PK4
}
template <int DQ> __device__ __forceinline__ void qkt(f32x16& p0, f32x16& p1, const char* Ks, const bf16x8* qr, const char* qx, int r32, int hi) {
    p0 = f32x16{}; p1 = f32x16{};
#pragma unroll
    for (int d0 = 0; d0 < Cf<DQ>::ND0; ++d0) { const int cb = (d0 * 16 + hi * 8) * 2;
        const bf16x8 b0 = *reinterpret_cast<const bf16x8*>(Ks + Cf<DQ>::kswz(r32, cb));
        const bf16x8 b1 = *reinterpret_cast<const bf16x8*>(Ks + Cf<DQ>::kswz(32 + r32, cb));
        constexpr int NQR = DQ == 192 ? 4 : 8;
        bf16x8 q; if (d0 < NQR) q = qr[d0]; else q = *reinterpret_cast<const bf16x8*>(qx + (d0 - NQR) * 1024);
        p0 = __builtin_amdgcn_mfma_f32_32x32x16_bf16(b0, q, p0, 0, 0, 0);
        p1 = __builtin_amdgcn_mfma_f32_32x32x16_bf16(b1, q, p1, 0, 0, 0); }
}
__device__ __forceinline__ int v_st(int k, int c) { const int kk = (k & ~0xC) | ((k & 4) << 1) | ((k & 8) >> 1); return ((kk >> 3) * 4 + (c >> 5)) * 512 + ((kk & 7) * 32 + (c & 31)) * 2; }
__device__ __forceinline__ int v_rd_base(int lane) { return ((lane & 3) << 3) | (((lane >> 2) & 3) << 6) | (((lane >> 4) & 1) << 5) | (((lane >> 5) & 1) << 8); }
constexpr int v_rd_off(int d0, int ks, int half) { return d0 * 512 + ks * 4096 + half * 2048; }
template <int OFF> __device__ __forceinline__ s16x4 tr_read(int vb) {
    s16x4 r; asm volatile("ds_read_b64_tr_b16 %0, %1 offset:%2" : "=&v"(r) : "v"(vb), "i"(OFF) : "memory"); return r;
}
template <int D0> __device__ __forceinline__ void pv_one(f32x16& od, int vb, bf16x8 pa0, bf16x8 pa1, bf16x8 pa2, bf16x8 pa3) {
    const s16x4 l0 = tr_read<v_rd_off(D0, 0, 0)>(vb), h0 = tr_read<v_rd_off(D0, 0, 1)>(vb), l1 = tr_read<v_rd_off(D0, 1, 0)>(vb), h1 = tr_read<v_rd_off(D0, 1, 1)>(vb);
    const s16x4 l2 = tr_read<v_rd_off(D0, 2, 0)>(vb), h2 = tr_read<v_rd_off(D0, 2, 1)>(vb), l3 = tr_read<v_rd_off(D0, 3, 0)>(vb), h3 = tr_read<v_rd_off(D0, 3, 1)>(vb);
    asm volatile("s_waitcnt lgkmcnt(0)" ::: "memory"); SBAR();
#define PK(L, H) (bf16x8){L[0], L[1], L[2], L[3], H[0], H[1], H[2], H[3]}
    od = __builtin_amdgcn_mfma_f32_32x32x16_bf16(pa0, PK(l0, h0), od, 0, 0, 0);
    od = __builtin_amdgcn_mfma_f32_32x32x16_bf16(pa1, PK(l1, h1), od, 0, 0, 0);
    od = __builtin_amdgcn_mfma_f32_32x32x16_bf16(pa2, PK(l2, h2), od, 0, 0, 0);
    od = __builtin_amdgcn_mfma_f32_32x32x16_bf16(pa3, PK(l3, h3), od, 0, 0, 0);
#undef PK
}
__device__ __forceinline__ void pv_d0(f32x16* o, int vb, bf16x8 pa0, bf16x8 pa1, bf16x8 pa2, bf16x8 pa3) {
    pv_one<0>(o[0], vb, pa0, pa1, pa2, pa3); pv_one<1>(o[1], vb, pa0, pa1, pa2, pa3); pv_one<2>(o[2], vb, pa0, pa1, pa2, pa3); pv_one<3>(o[3], vb, pa0, pa1, pa2, pa3);
}
__device__ __forceinline__ bf16x8 ld8(const bf16_t* p) { return *reinterpret_cast<const bf16x8*>(p); }

template <int DQ, int SD>
__device__ __forceinline__ void attn_body(const bf16_t* __restrict__ Qb, int ldq, const bf16_t* __restrict__ Kn, int ldkn, const bf16_t* __restrict__ Kr, int ldkr,
                                          const bf16_t* __restrict__ Vh, int ldv, bf16_t* __restrict__ Ob, int ldo, int seq, bool rope_q, int pos0, const float* __restrict__ tabM, char* lds, const int tid) {
    using CF = Cf<DQ>; constexpr int ND0 = CF::ND0, SHM_V = CF::SHM_V, SHM_K = CF::SHM_K;
    const int wid = tid >> 6, lane = tid & 63, r32 = lane & 31, hi = lane >> 5;
    char* V_lds = lds; char* K_lds = lds + 2 * SHM_V;
    float* ws = (float*)(lds + 2 * SHM_V + 2 * SHM_K) + wid * 64; float* li_l = ws; float* al_l = ws + 32;
    constexpr int NQR = DQ == 192 ? 4 : 8;
    float m_reg = -1e30f, l_reg = 0; f32x16 o[4] = {}; bf16x8 qr[NQR];
    const bf16_t* Qw = Qb + (long)(wid * QBLK + r32) * ldq + hi * 8;
#pragma unroll
    for (int d0 = 0; d0 < NQR; ++d0) qr[d0] = ld8(Qw + d0 * 16);
    char* qx = lds + CF::SHM + wid * 8192 + lane * 16;
    if constexpr (DQ == 192) {
#pragma unroll
        for (int d0 = 4; d0 < 8; ++d0) *(bf16x8*)(qx + (d0 - 4) * 1024) = ld8(Qw + d0 * 16);
        bf16x8 qe[4];
#pragma unroll
        for (int d0 = 0; d0 < 4; ++d0) qe[d0] = ld8(Qw + (8 + d0) * 16);
        if (rope_q) {
            const int pos = pos0 + wid * QBLK + r32, ri = pos >> 6, ci = pos & 63;
#pragma unroll
            for (int t = 0; t < 2; ++t) { const int p = t == 0 ? ri : ci; const float* tc = tabM + p * 16 + hi * 8; const float* tsn = tabM + 128 * 16 + p * 16 + hi * 8;
                bf16x8 a = qe[t], b = qe[2 + t];
#pragma unroll
                for (int jj = 0; jj < 8; ++jj) { const float x1 = bf2f((bf16_t)a[jj]), x2 = bf2f((bf16_t)b[jj]), c = tc[jj], s = tsn[jj];
                    a[jj] = (short)f2bf(x1 * c - x2 * s); b[jj] = (short)f2bf(x2 * c + x1 * s); }
                qe[t] = a; qe[2 + t] = b; }
        }
#pragma unroll
        for (int d0 = 0; d0 < 4; ++d0) *(bf16x8*)(qx + (4 + d0) * 1024) = qe[d0];
    }
    const int sr = tid >> 4, sc = (tid & 15) * 8, vst0 = v_st(sr, sc), vst1 = v_st(32 + sr, sc);
    const int sr2 = tid >> 3, sc2 = (tid & 7) * 8;
    const int vb0 = (int)(uintptr_t)V_lds + v_rd_base(lane);
    struct { bf16x8 vs0, vs1, ks0, ks1, ks2; } sr_[SD];
    const unsigned offV = (unsigned)(sr * ldv + sc) * 2u, offK = (unsigned)(sr * ldkn + sc) * 2u, offR = (unsigned)(sr2 * ldkr + sc2) * 2u;
#define SLOAD(i, k0) do { const char* vt_ = (const char*)Vh + (size_t)(k0) * ldv * 2; const char* kt_ = (const char*)Kn + (size_t)(k0) * ldkn * 2; \
    sr_[i].vs0 = *(const bf16x8*)(vt_ + offV); sr_[i].vs1 = *(const bf16x8*)(vt_ + (size_t)32 * ldv * 2 + offV); \
    sr_[i].ks0 = *(const bf16x8*)(kt_ + offK); sr_[i].ks1 = *(const bf16x8*)(kt_ + (size_t)32 * ldkn * 2 + offK); \
    if constexpr (DQ == 192) sr_[i].ks2 = *(const bf16x8*)((const char*)Kr + (size_t)(k0) * ldkr * 2 + offR); } while (0)
#define SWRITE(b, i) do { *(bf16x8*)(V_lds + (b) * SHM_V + vst0) = sr_[i].vs0; *(bf16x8*)(V_lds + (b) * SHM_V + vst1) = sr_[i].vs1; const int kc = sc * 2; \
    *(bf16x8*)(K_lds + (b) * SHM_K + CF::kswz(sr, kc)) = sr_[i].ks0; *(bf16x8*)(K_lds + (b) * SHM_K + CF::kswz(32 + sr, kc)) = sr_[i].ks1; \
    if constexpr (DQ == 192) *(bf16x8*)(K_lds + (b) * SHM_K + CF::kswz(sr2, 256 + sc2 * 2)) = sr_[i].ks2; } while (0)
#define SWAIT() do { if constexpr (SD == 1) asm volatile("s_waitcnt vmcnt(0)" ::: "memory"); else if constexpr (DQ == 192) asm volatile("s_waitcnt vmcnt(5)" ::: "memory"); else asm volatile("s_waitcnt vmcnt(4)" ::: "memory"); } while (0)
#define RESC(a) do { if (__any((a) < 1.f)) { if (hi == 0) al_l[r32] = (a); asm volatile("s_waitcnt lgkmcnt(0)" ::: "memory"); \
    _Pragma("unroll") for (int d = 0; d < 4; ++d) _Pragma("unroll") for (int r = 0; r < 16; ++r) o[d][r] *= al_l[crow(r, hi)]; } } while (0)
    f32x16 pA0, pA1, pB0, pB1; float mnA, mnB, alA, alB; bf16x8 pa0, pa1, pa2, pa3; const int NT = seq / KVBLK;
    constexpr int SE = 0, SO = SD - 1;
    SLOAD(SE, 0); asm volatile("s_waitcnt vmcnt(0)" ::: "memory"); SWRITE(0, SE); __syncthreads();
    qkt<DQ>(pA0, pA1, K_lds, qr, qx, r32, hi); partialSM<DQ>(pA0, pA1, m_reg, mnA, alA);
    SLOAD(SO, KVBLK); if constexpr (SD == 2) { if (2 < NT) SLOAD(SE, 2 * KVBLK); }
    SWAIT(); SWRITE(1, SO); __syncthreads();
    for (int j = 1; j + 1 < NT; j += 2) {
        SBAR(); qkt<DQ>(pB0, pB1, K_lds + SHM_K, qr, qx, r32, hi);
        finishSM(pA0, pA1, alA, l_reg, pa0, pa1, pa2, pa3); SBAR();
        SLOAD(SO, (j + SD) * KVBLK); SBAR();
        pv_d0(o, vb0, pa0, pa1, pa2, pa3); partialSM<DQ>(pB0, pB1, m_reg, mnB, alB);
        __syncthreads(); SWAIT(); SWRITE(0, SE);
        RESC(alB); __syncthreads();
        SBAR(); qkt<DQ>(pA0, pA1, K_lds, qr, qx, r32, hi);
        finishSM(pB0, pB1, alB, l_reg, pa0, pa1, pa2, pa3); SBAR();
        if (SD == 1 || j + 3 < NT) SLOAD(SE, (j + 1 + SD) * KVBLK); SBAR();
        pv_d0(o, vb0 + SHM_V, pa0, pa1, pa2, pa3); partialSM<DQ>(pA0, pA1, m_reg, mnA, alA);
        __syncthreads(); SWAIT(); SWRITE(1, SO);
        RESC(alA); __syncthreads();
    }
    SBAR(); qkt<DQ>(pB0, pB1, K_lds + SHM_K, qr, qx, r32, hi);
    finishSM(pA0, pA1, alA, l_reg, pa0, pa1, pa2, pa3); SBAR();
    pv_d0(o, vb0, pa0, pa1, pa2, pa3); partialSM<DQ>(pB0, pB1, m_reg, mnB, alB);
    __syncthreads(); RESC(alB);
    finishSM(pB0, pB1, alB, l_reg, pa0, pa1, pa2, pa3); SBAR();
    pv_d0(o, vb0 + SHM_V, pa0, pa1, pa2, pa3);
    if (hi == 0) li_l[r32] = l_reg; asm volatile("s_waitcnt lgkmcnt(0)" ::: "memory");
    float rli[16];
#pragma unroll
    for (int r = 0; r < 16; ++r) rli[r] = __builtin_amdgcn_rcpf(li_l[crow(r, hi)]);
    bf16_t* Ow = Ob + (long)(wid * QBLK) * ldo;
#pragma unroll
    for (int r = 0; r < 16; ++r) { const int orow = crow(r, hi);
#pragma unroll
        for (int d0 = 0; d0 < 4; ++d0) Ow[(long)orow * ldo + d0 * 32 + r32] = f2bf(o[d0][r] * rli[r]); }
#undef SLOAD
#undef SWRITE
#undef SWAIT
#undef RESC
}
}

template <int KS> __device__ __forceinline__ void mma_xy(f32x16& acc, const LAS bf16_t* X, const LAS bf16_t* Y, int hi) {
#pragma unroll
    for (int ks = 0; ks < KS; ++ks) { const bf16x8 a = *(const LAS bf16x8*)(X + ks * 16 + hi * 8), b = *(const LAS bf16x8*)(Y + ks * 16 + hi * 8);
        acc = __builtin_amdgcn_mfma_f32_32x32x16_bf16(a, b, acc, 0, 0, 0); }
}
__device__ __forceinline__ float logsig16(float x) { const float e = __expf(-fabsf(x)); return (fminf(x, 0.f) - __logf(1.f + e)) * 0.0625f; }
__device__ __forceinline__ int gla_sidx(int b, int dir, int h) { return (b * 2 + dir) * 4 + h; }

__device__ __forceinline__ void gla_cumsum_lds(const Ctx& C, int l, int h, int dir, const LAS float* lr, LAS float* segtot, LAS float* CUM) {
    const int seg = C.tid >> 7, d = C.tid & 127;
    const float* wa = INP(dir ? I_WA2B : I_WA2F) + (size_t)l * 16 * 512 + h * 128 + d;
    const float bias = INP(dir ? I_BAB : I_BAF)[l * 512 + h * 128 + d];
    float w[16], cum[16];
#pragma unroll
    for (int j = 0; j < 16; ++j) w[j] = wa[j * 512];
    float run = 0.f;
#pragma unroll
    for (int i = 0; i < 16; ++i) { const int s = seg * 16 + i, tk = dir ? 63 - s : s; float pre = bias;
#pragma unroll
        for (int j = 0; j < 16; ++j) pre += lr[tk * 32 + dir * 16 + j] * w[j];
        run += logsig16(pre); cum[i] = run; }
    segtot[seg * 128 + d] = run;
    __syncthreads();
    float off = 0.f;
#pragma unroll
    for (int q = 0; q < 3; ++q) if (q < seg) off += segtot[q * 128 + d];
#pragma unroll
    for (int i = 0; i < 16; ++i) { const int s = seg * 16 + i, tk = dir ? 63 - s : s; CUM[tk * 132 + d] = cum[i] + off; }
    __syncthreads();
}
__device__ __forceinline__ void unpack8(const u32x4 w, float (&x)[8]) { x[0] = bflo(w.x); x[1] = bfhi(w.x); x[2] = bflo(w.y); x[3] = bfhi(w.y); x[4] = bflo(w.z); x[5] = bfhi(w.z); x[6] = bflo(w.w); x[7] = bfhi(w.w); }
__device__ __forceinline__ void gla_build_vt(const Ctx& C, const bf16_t* P, size_t r0, int h, LAS bf16_t* VT) {
    u32x4 v[4];
#pragma unroll
    for (int it = 0; it < 4; ++it) { const int idx = C.tid + it * NTHREADS, sv = idx >> 5, e0 = (idx & 31) * 8; v[it] = *(const u32x4*)(P + (r0 + sv) * NP + C_LV + h * 256 + e0); }
#pragma unroll
    for (int it = 0; it < 4; ++it) { const int idx = C.tid + it * NTHREADS, sv = idx >> 5, e0 = (idx & 31) * 8;
        const unsigned wd[4] = {v[it].x, v[it].y, v[it].z, v[it].w};
#pragma unroll
        for (int q = 0; q < 4; ++q) { VT[(e0 + 2 * q) * 72 + sv] = (bf16_t)(wd[q] & 0xffffu); VT[(e0 + 2 * q + 1) * 72 + sv] = (bf16_t)(wd[q] >> 16); } }
}

__device__ __forceinline__ void phase_gla_local(const Ctx& C, int l) {
    const bf16_t* P = WSP(bf16_t, WS_P); bf16_t* GST = WSP(bf16_t, WS_GST); float* GDEC = WSP(float, WS_GDEC);
    LAS float* lr = (LAS float*)C.lds;
    LAS float* segtot = (LAS float*)(C.lds + 8192);
    LAS bf16_t* KT = (LAS bf16_t*)(C.lds + 10240);
    LAS bf16_t* VT = (LAS bf16_t*)(C.lds + 28672);
    LAS float* CUM = (LAS float*)(C.lds + 65536);
    const int r32 = C.lane & 31, hi = C.lane >> 5, d = C.tid & 127;
    const int btk = C.tid >> 3, bdg = (C.tid & 7) * 16;
    for (int unit = C.bid; unit < NBATCH * 4 * NCH; unit += C.G) {
        const int b = unit / (4 * NCH), h = (unit / NCH) % 4, ck = unit % NCH; const size_t r0 = (size_t)b * RPB + ck * 64;
        for (int i = C.tid; i < 64 * 32; i += NTHREADS) lr[i] = bf2f(P[(r0 + (i >> 5)) * NP + C_LRF + (i & 31)]);
        const u32x4 kw0 = *(const u32x4*)(P + (r0 + btk) * NP + C_LK + h * 128 + bdg), kw1 = *(const u32x4*)(P + (r0 + btk) * NP + C_LK + h * 128 + bdg + 8);
        gla_build_vt(C, P, r0, h, VT);
        __syncthreads();
#pragma unroll 1
        for (int dir = 0; dir < 2; ++dir) {
            gla_cumsum_lds(C, l, h, dir, lr, segtot, CUM);
            const int tend = dir ? 0 : 63;
            const size_t sx = (size_t)gla_sidx(b, dir, h) * NCH + ck;
            if (C.tid < 128) GDEC[sx * 128 + d] = __expf(CUM[tend * 132 + d]);
            { float kf[16]; { float t8[8]; unpack8(kw0, t8);
#pragma unroll
                for (int i = 0; i < 8; ++i) kf[i] = t8[i]; unpack8(kw1, t8);
#pragma unroll
                for (int i = 0; i < 8; ++i) kf[8 + i] = t8[i]; }
#pragma unroll
              for (int q = 0; q < 4; ++q) { const f32x4 cm = *(const LAS f32x4*)(CUM + btk * 132 + bdg + 4 * q), be = *(const LAS f32x4*)(CUM + tend * 132 + bdg + 4 * q);
#pragma unroll
                  for (int i = 0; i < 4; ++i) KT[(bdg + 4 * q + i) * 72 + btk] = f2bf(kf[4 * q + i] * __expf(be[i] - cm[i])); } }
            __syncthreads();
            { const int dt = C.wid & 3, eb = (C.wid >> 2) * 4;
              f32x16 acc[4] = {};
#pragma unroll
              for (int q = 0; q < 4; ++q) mma_xy<4>(acc[q], KT + (dt * 32 + r32) * 72, VT + ((eb + q) * 32 + r32) * 72, hi);
              bf16_t* st = GST + sx * 32768;
#pragma unroll
              for (int q = 0; q < 4; ++q)
#pragma unroll
                  for (int g = 0; g < 4; ++g) { u32x2 w; w.x = cvt_pk_bf16(acc[q][4 * g], acc[q][4 * g + 1]); w.y = cvt_pk_bf16(acc[q][4 * g + 2], acc[q][4 * g + 3]);
                      *(u32x2*)(st + (size_t)((eb + q) * 32 + r32) * 128 + dt * 32 + 8 * g + 4 * hi) = w; } }
            __syncthreads();
        }
    }
}

__device__ __forceinline__ void phase_gla_scan(const Ctx& C) {
    bf16_t* GST = WSP(bf16_t, WS_GST); const float* GDEC = WSP(float, WS_GDEC);
    for (int gid = C.bid * NTHREADS + C.tid; gid < 16 * 8192; gid += C.G * NTHREADS) {
        const int sidx = gid >> 13, g = gid & 8191, dir = (sidx >> 2) & 1, d4 = (g & 31) * 4;
        bf16_t* base = GST + (size_t)sidx * NCH * 32768 + (size_t)g * 4;
        const float* dbase = GDEC + (size_t)sidx * NCH * 128 + d4;
        float S[4] = {0.f, 0.f, 0.f, 0.f};
        for (int st = 0; st < NCH; st += 4) {
            int ck[4]; u32x2 L[4]; f32x4 dc[4];
#pragma unroll
            for (int q = 0; q < 4; ++q) { const int s = st + q; ck[q] = dir ? (s < 4 ? 3 - s : NCH + 3 - s) : s;
                L[q] = *(const u32x2*)(base + (size_t)ck[q] * 32768); dc[q] = *(const f32x4*)(dbase + (size_t)ck[q] * 128); }
#pragma unroll
            for (int q = 0; q < 4; ++q) { u32x2 w; w.x = cvt_pk_bf16(S[0], S[1]); w.y = cvt_pk_bf16(S[2], S[3]);
                *(u32x2*)(base + (size_t)ck[q] * 32768) = w;
                S[0] = dc[q][0] * S[0] + bflo(L[q].x); S[1] = dc[q][1] * S[1] + bfhi(L[q].x); S[2] = dc[q][2] * S[2] + bflo(L[q].y); S[3] = dc[q][3] * S[3] + bfhi(L[q].y); }
        }
    }
}

__device__ __forceinline__ void phase_gla_out(const Ctx& C, int l) {
    const bf16_t* P = WSP(bf16_t, WS_P); const bf16_t* GST = WSP(bf16_t, WS_GST); bf16_t* OL = WSP(bf16_t, WS_OL);
    LAS float* lr = (LAS float*)C.lds;
    LAS float* segtot = (LAS float*)(C.lds + 8192);
    LAS bf16_t* QT = (LAS bf16_t*)(C.lds + 10240);
    LAS bf16_t* KT = (LAS bf16_t*)(C.lds + 27648);
    LAS bf16_t* VT = (LAS bf16_t*)(C.lds + 45056);
    LAS bf16_t* SCm = (LAS bf16_t*)(C.lds + 81920);
    LAS float* OB = (LAS float*)(C.lds + 91136);
    LAS float* CUM = OB;
    const float* gon = INP(I_ONG) + l * 256;
    const int r32 = C.lane & 31, hi = C.lane >> 5;
    const int btk = C.tid >> 3, bdg = (C.tid & 7) * 16;
    for (int unit = C.bid; unit < NBATCH * 4 * NCH; unit += C.G) {
        const int b = unit / (4 * NCH), h = (unit / NCH) % 4, ck = unit % NCH; const size_t r0 = (size_t)b * RPB + ck * 64;
        for (int i = C.tid; i < 64 * 32; i += NTHREADS) lr[i] = bf2f(P[(r0 + (i >> 5)) * NP + C_LRF + (i & 31)]);
        const bf16_t* qp = P + (r0 + btk) * NP + C_LQ + h * 128 + bdg; const bf16_t* kp = P + (r0 + btk) * NP + C_LK + h * 128 + bdg;
        const u32x4 qw0 = *(const u32x4*)qp, qw1 = *(const u32x4*)(qp + 8), kw0 = *(const u32x4*)kp, kw1 = *(const u32x4*)(kp + 8);
        gla_build_vt(C, P, r0, h, VT);
        __syncthreads();
        f32x16 oacc[2] = {};
#pragma unroll 1
        for (int dir = 0; dir < 2; ++dir) {
            gla_cumsum_lds(C, l, h, dir, lr, segtot, CUM);
            { float qf[8], kf[8];
#pragma unroll
              for (int hh = 0; hh < 2; ++hh) { unpack8(hh ? qw1 : qw0, qf); unpack8(hh ? kw1 : kw0, kf);
                  const f32x4 c0 = *(const LAS f32x4*)(CUM + btk * 132 + bdg + 8 * hh), c1 = *(const LAS f32x4*)(CUM + btk * 132 + bdg + 8 * hh + 4);
                  float qo[8], ko[8];
#pragma unroll
                  for (int i = 0; i < 8; ++i) { const float cm = i < 4 ? c0[i & 3] : c1[i & 3]; qo[i] = qf[i] * __expf(cm) * 0.088388347648318440f; ko[i] = kf[i] * __expf(-cm); }
                  u32x4 wq, wk; wq.x = cvt_pk_bf16(qo[0], qo[1]); wq.y = cvt_pk_bf16(qo[2], qo[3]); wq.z = cvt_pk_bf16(qo[4], qo[5]); wq.w = cvt_pk_bf16(qo[6], qo[7]);
                  wk.x = cvt_pk_bf16(ko[0], ko[1]); wk.y = cvt_pk_bf16(ko[2], ko[3]); wk.z = cvt_pk_bf16(ko[4], ko[5]); wk.w = cvt_pk_bf16(ko[6], ko[7]);
                  *(LAS u32x4*)(QT + btk * 136 + bdg + 8 * hh) = wq; *(LAS u32x4*)(KT + btk * 136 + bdg + 8 * hh) = wk; } }
            __syncthreads();
            if (C.wid < 4) { const int mt = C.wid >> 1, nt = C.wid & 1; f32x16 sc = {};
                mma_xy<8>(sc, QT + (mt * 32 + r32) * 136, KT + (nt * 32 + r32) * 136, hi);
#pragma unroll
                for (int i = 0; i < 16; ++i) { const int t = mt * 32 + att::crow(i, hi), sx_ = nt * 32 + r32; const bool keep = dir ? (sx_ >= t) : (sx_ <= t);
                    SCm[t * 72 + sx_] = f2bf(keep ? sc[i] : 0.f); } }
            __syncthreads();
            { const bf16_t* st = GST + ((size_t)gla_sidx(b, dir, h) * NCH + ck) * 32768 + (size_t)(C.wid * 32 + r32) * 128 + hi * 8;
              bf16x8 sb[8];
#pragma unroll
              for (int ks = 0; ks < 8; ++ks) sb[ks] = *(const bf16x8*)(st + ks * 16);
#pragma unroll
              for (int mt = 0; mt < 2; ++mt) {
                  mma_xy<4>(oacc[mt], SCm + (mt * 32 + r32) * 72, VT + (C.wid * 32 + r32) * 72, hi);
#pragma unroll
                  for (int ks = 0; ks < 8; ++ks) { const bf16x8 a = *(const LAS bf16x8*)(QT + (mt * 32 + r32) * 136 + ks * 16 + hi * 8);
                      oacc[mt] = __builtin_amdgcn_mfma_f32_32x32x16_bf16(a, sb[ks], oacc[mt], 0, 0, 0); } } }
            __syncthreads();
        }
#pragma unroll
        for (int mt = 0; mt < 2; ++mt)
#pragma unroll
            for (int i = 0; i < 16; ++i) OB[(mt * 32 + att::crow(i, hi)) * 260 + C.wid * 32 + r32] = oacc[mt][i];
        __syncthreads();
        { const int t = C.tid >> 3, part = C.tid & 7; f32x4 v[8]; float ss = 0.f;
#pragma unroll
          for (int jj = 0; jj < 8; ++jj) { v[jj] = *(const LAS f32x4*)(OB + t * 260 + jj * 32 + part * 4); ss += v[jj][0] * v[jj][0] + v[jj][1] * v[jj][1] + v[jj][2] * v[jj][2] + v[jj][3] * v[jj][3]; }
          ss += dppmov<DPP_HMIRROR>(ss); ss += dppmov<DPP_Q3210>(ss); ss += dppmov<DPP_Q1032>(ss);
          const float rs = rsqrtf(ss * (1.0f / 256.0f) + NORM_EPS);
#pragma unroll
          for (int jj = 0; jj < 8; ++jj) { const int e = jj * 32 + part * 4; const f32x4 g = *(const f32x4*)(gon + e);
              const u32x2 gt = *(const u32x2*)(P + (r0 + t) * NP + C_LG + h * 256 + e);
              const float o0 = v[jj][0] * rs * g[0] * siluf_(bflo(gt.x)), o1 = v[jj][1] * rs * g[1] * siluf_(bfhi(gt.x)), o2 = v[jj][2] * rs * g[2] * siluf_(bflo(gt.y)), o3 = v[jj][3] * rs * g[3] * siluf_(bfhi(gt.y));
              u32x2 w; w.x = cvt_pk_bf16(o0, o1); w.y = cvt_pk_bf16(o2, o3);
              *(u32x2*)(OL + (r0 + t) * 1024 + h * 256 + e) = w; } }
        __syncthreads();
    }
}

__device__ __forceinline__ unsigned f_ord(float f) { const unsigned u = __float_as_uint(f); return u ^ ((unsigned)((int)u >> 31) | 0x80000000u); }
__device__ __forceinline__ float f_unord(unsigned k) { return __uint_as_float((k & 0x80000000u) ? (k ^ 0x80000000u) : ~k); }
__device__ __forceinline__ void ins_u(unsigned (&L)[16], unsigned x) {
#pragma unroll
    for (int j = 0; j < 16; ++j) { const unsigned h = L[j] > x ? L[j] : x; x = L[j] > x ? x : L[j]; L[j] = h; }
}
__device__ __forceinline__ void ins_f(float (&M)[16], float x) {
#pragma unroll
    for (int j = 0; j < 16; ++j) { const float h = M[j] > x ? M[j] : x; x = M[j] > x ? x : M[j]; M[j] = h; }
}
__device__ __forceinline__ void peer_top16(const bf16_t* __restrict__ qrow, const bf16_t* __restrict__ keys, int r32, int hi, unsigned (&L)[16]) {
    bf16x8 qf[8];
#pragma unroll
    for (int kk = 0; kk < 8; ++kk) qf[kk] = *(const bf16x8*)(qrow + kk * 16 + hi * 8);
#pragma unroll
    for (int j = 0; j < 16; ++j) L[j] = 0u;
#pragma unroll 1
    for (int mt = 0; mt < 4; ++mt) {
        f32x16 acc = {};
#pragma unroll
        for (int kk = 0; kk < 8; ++kk) { const bf16x8 a = *(const bf16x8*)(keys + (size_t)(mt * 32 + r32) * 128 + kk * 16 + hi * 8);
            acc = __builtin_amdgcn_mfma_f32_32x32x16_bf16(a, qf[kk], acc, 0, 0, 0); }
#pragma unroll
        for (int i = 0; i < 16; ++i) { const unsigned kidx = (unsigned)(mt * 32 + att::crow(i, hi)); ins_u(L, (f_ord(acc[i]) & ~127u) | (127u - kidx)); }
    }
    unsigned Pn[16];
#pragma unroll
    for (int j = 0; j < 16; ++j) { auto r_ = __builtin_amdgcn_permlane32_swap(L[j], L[j], false, false); Pn[j] = hi ? r_[0] : r_[1]; }
#pragma unroll
    for (int j = 0; j < 16; ++j) ins_u(L, Pn[j]);
}
__device__ __forceinline__ void phase_peer_select(const Ctx& C, const bool latent_only) {
    const bf16_t* PQ = WSP(bf16_t, WS_PQ); const bf16_t* K1 = WSP(bf16_t, WS_K1); const bf16_t* K2 = WSP(bf16_t, WS_K2);
    int* PIDX = WSP(int, WS_PIDX); float* PG = WSP(float, WS_PG);
    const int r32 = C.lane & 31, hi = C.lane >> 5, head = C.wid;
    const int ngrp = latent_only ? NBATCH * SEQ / 32 : TT / 32;
    for (int gi = C.bid; gi < ngrp; gi += C.G) {
        const int grp = latent_only ? gi + (CTXL / 32) * (1 + gi / (SEQ / 32)) : gi;
        const size_t tok = (size_t)grp * 32 + r32;
        unsigned L1[16], L2[16];
        peer_top16(PQ + tok * DM + head * 256, K1 + (size_t)head * 128 * 128, r32, hi, L1);
        peer_top16(PQ + tok * DM + head * 256 + 128, K2 + (size_t)head * 128 * 128, r32, hi, L2);
        float v1[16], v2[16];
#pragma unroll
        for (int j = 0; j < 16; ++j) { v1[j] = f_unord(L1[j] & ~127u); v2[j] = f_unord(L2[j] & ~127u); }
        float M[16];
#pragma unroll
        for (int j = 0; j < 16; ++j) M[j] = -3.0e38f;
#pragma unroll
        for (int a = 0; a < 16; ++a)
#pragma unroll
            for (int b = 0; b < 16; ++b) if ((a + 1) * (b + 1) <= 16) ins_f(M, v1[a] + v2[b]);
        const float thr = M[15], mx = M[0]; float den = 0.f;
#pragma unroll
        for (int j = 0; j < 16; ++j) den += __expf(M[j] - mx);
        const float rden = 1.0f / den;
        int pos = 0; int* ip = PIDX + tok * 128 + head * 16; float* gp = PG + tok * 128 + head * 16;
#pragma unroll
        for (int a = 0; a < 16; ++a)
#pragma unroll
            for (int b = 0; b < 16; ++b) if ((a + 1) * (b + 1) <= 16) {
                const float val = v1[a] + v2[b];
                if (val >= thr && pos < 16) { if (hi == 0) { ip[pos] = (int)((127u - (L1[a] & 127u)) * 128u + (127u - (L2[b] & 127u))); gp[pos] = __expf(val - mx) * rden; } ++pos; } }
    }
}
template <int OFF> __device__ __forceinline__ float dotf8(const float (&h)[32], const u32x4 w, float acc) {
#pragma unroll
    for (int j = 0; j < 4; ++j) { const f32x2 lo = __builtin_amdgcn_cvt_pk_f32_fp8((int)w[j], false), hi = __builtin_amdgcn_cvt_pk_f32_fp8((int)w[j], true);
        acc += h[OFF + 4 * j] * lo.x; acc += h[OFF + 4 * j + 1] * lo.y; acc += h[OFF + 4 * j + 2] * hi.x; acc += h[OFF + 4 * j + 3] * hi.y; }
    return acc;
}
constexpr int GT_MAXTOK = 9;
template <bool LAST> __device__ __forceinline__ void phase_peer_gather(const Ctx& C, const float* modl, const float pscale) {
    const bf16_t* HB = WSP(bf16_t, WS_HB); const unsigned char* U8 = C.ws + WS_U8; const unsigned char* V8 = C.ws + WS_V8;
    const float* SCU = WSP(float, WS_SCU); const float* SCV = WSP(float, WS_SCV);
    const int* PIDX = WSP(int, WS_PIDX); const float* PG = WSP(float, WS_PG); float* XS = WSP(float, WS_XS);
    const int lane = C.lane, s = lane >> 3, j = lane & 7;
    LAS int* IDS = (LAS int*)(C.lds + C.wid * (GT_MAXTOK * 512));
    LAS float* ACT = (LAS float*)(C.lds + 8 * GT_MAXTOK * 512 + C.wid * (GT_MAXTOK * 512));
    LAS int* ROWS = (LAS int*)(C.lds + 16 * GT_MAXTOK * 512 + C.wid * 64);
    int nk = 0;
    {
      const int per = (TT + C.G - 1) / C.G, base = C.bid * per;
#pragma unroll 1
      for (int k = 0; k < GT_MAXTOK; ++k) { const int o = C.wid + 8 * k; const int r = base + o; if (o < per && r < TT && !(LAST && (r % RPB) < CTXL)) { if (lane == 0) ROWS[nk] = r; ++nk; } } }
#define GT_ROW(k) __builtin_amdgcn_readfirstlane(ROWS[k])
#pragma unroll 1
    for (int k = 0; k < nk; ++k) { const int r = GT_ROW(k);
        IDS[k * 128 + lane] = PIDX[(size_t)r * 128 + lane] & (NEXP - 1); IDS[k * 128 + 64 + lane] = PIDX[(size_t)r * 128 + 64 + lane] & (NEXP - 1);
        ACT[k * 128 + lane] = 0.f; ACT[k * 128 + 64 + lane] = 0.f; }
    const int nit = 32 * nk;
#define GT_ITEM(it_) const int cb_ = (it_) / (2 * nk), rem_ = (it_) - cb_ * (2 * nk), k_ = rem_ >> 1, hf_ = rem_ & 1
#define GT_LOADU(UQ, HQ, it_) do { GT_ITEM(it_); const int r_ = GT_ROW(k_); \
        const bf16_t* hp_ = HB + (size_t)r_ * DM + cb_ * 128 + j * 16; HQ[0] = *(const u32x4*)hp_; HQ[1] = *(const u32x4*)(hp_ + 8); \
        const unsigned char* ub_ = U8 + (size_t)cb_ * ((size_t)NEXP * 128) + j * 16; \
        _Pragma("unroll") for (int eg = 0; eg < 8; ++eg) { const int id_ = IDS[k_ * 128 + (hf_ * 8 + eg) * 8 + s] & idmask; UQ[eg] = *(const u32x4*)(ub_ + (size_t)id_ * 128); } } while (0)
#define GT_COMPU(UQ, HQ, it_) do { GT_ITEM(it_); (void)cb_; f32x2 hf2[8]; \
        _Pragma("unroll") for (int hh = 0; hh < 2; ++hh) { const u32x4 w_ = HQ[hh]; \
            hf2[hh * 4 + 0] = (f32x2){bflo(w_.x), bfhi(w_.x)}; hf2[hh * 4 + 1] = (f32x2){bflo(w_.y), bfhi(w_.y)}; hf2[hh * 4 + 2] = (f32x2){bflo(w_.z), bfhi(w_.z)}; hf2[hh * 4 + 3] = (f32x2){bflo(w_.w), bfhi(w_.w)}; } \
        float d[8]; \
        _Pragma("unroll") for (int eg = 0; eg < 8; ++eg) { f32x2 d2 = (f32x2){0.f, 0.f}; \
            _Pragma("unroll") for (int q = 0; q < 4; ++q) { const f32x2 lo = __builtin_amdgcn_cvt_pk_f32_fp8((int)UQ[eg][q], false), hi = __builtin_amdgcn_cvt_pk_f32_fp8((int)UQ[eg][q], true); \
                d2 += hf2[2 * q] * lo; d2 += hf2[2 * q + 1] * hi; } \
            d[eg] = d2.x + d2.y; } \
          \
        float t4[4], t2[2], t1; \
        _Pragma("unroll") for (int i = 0; i < 4; ++i) { const float snd = (j & 4) ? d[i] : d[i + 4], kp = (j & 4) ? d[i + 4] : d[i]; t4[i] = kp + dppmov<DPP_HMIRROR>(snd); } \
        _Pragma("unroll") for (int i = 0; i < 2; ++i) { const float snd = (j & 2) ? t4[i] : t4[i + 2], kp = (j & 2) ? t4[i + 2] : t4[i]; t2[i] = kp + dppmov<DPP_Q3210>(snd); } \
        { const float snd = (j & 1) ? t2[0] : t2[1], kp = (j & 1) ? t2[1] : t2[0]; t1 = kp + dppmov<DPP_Q1032>(snd); } \
        ACT[k_ * 128 + (hf_ * 8 + j) * 8 + s] += t1; } while (0)
#ifdef DBG_GDUP
#pragma unroll 1
    for (int rep_ = 0; rep_ < 2; ++rep_) {
    const int idmask = rep_ == 0 ? DBG_GMASK : (NEXP - 1);
    if (rep_ == 1) { for (int k = 0; k < nk; ++k) { ACT[k * 128 + lane] = 0.f; ACT[k * 128 + 64 + lane] = 0.f; } }
#else
    { const int idmask = NEXP - 1;
#endif
    if (nit > 0) {
        u32x4 uA[8], uB[8], hA[2], hB[2];
        GT_LOADU(uA, hA, 0);
#pragma unroll 1
        for (int it = 0; it < nit; it += 2) {
            GT_LOADU(uB, hB, it + 1);
            GT_COMPU(uA, hA, it);
            if (it + 2 < nit) GT_LOADU(uA, hA, it + 2);
            GT_COMPU(uB, hB, it + 1);
        }
    }
    }
#undef GT_LOADU
#undef GT_COMPU
#pragma unroll 1
    for (int k = 0; k < nk; ++k) { const int r = GT_ROW(k);
#pragma unroll
        for (int hh = 0; hh < 2; ++hh) { const int e = hh * 64 + lane; const int id = IDS[k * 128 + e]; const float a = ACT[k * 128 + e] * SCU[id];
            const float w = PG[(size_t)r * 128 + e] * 0.5f * a * (1.0f + erff(a * 0.70710678118654752f));
#ifdef DBG_CHECK
            if (((r - 300) & 63) == 0 && r >= 300 && r < 300 + 64 * 128) WSP(float, WS_OM)[(size_t)r * 128 + e] = w;
#endif
            ACT[k * 128 + e] = w * SCV[id]; } }
#define GT_LOADV(VQ, WV, it_) do { GT_ITEM(it_); const unsigned char* vb_ = V8 + (size_t)cb_ * ((size_t)NEXP * 128) + j * 16; \
        _Pragma("unroll") for (int eg = 0; eg < 8; ++eg) { const int e_ = k_ * 128 + (hf_ * 8 + eg) * 8 + s; const int id_ = IDS[e_]; VQ[eg] = *(const u32x4*)(vb_ + (size_t)id_ * 128); WV[eg] = ACT[e_]; } } while (0)
#define GT_COMPV(VQ, WV) do { \
        _Pragma("unroll") for (int eg = 0; eg < 8; ++eg) { const f32x2 w2_ = (f32x2){WV[eg], WV[eg]}; \
            _Pragma("unroll") for (int q = 0; q < 4; ++q) { \
                const f32x2 lo = __builtin_amdgcn_cvt_pk_f32_fp8((int)VQ[eg][q], false), hi = __builtin_amdgcn_cvt_pk_f32_fp8((int)VQ[eg][q], true); \
                acc2[2 * q] += w2_ * lo; acc2[2 * q + 1] += w2_ * hi; } } } while (0)
    if (nit > 0) {
        u32x4 vA[8], vB[8]; float wA[8], wB[8];
        GT_LOADV(vA, wA, 0);
#pragma unroll 1
        for (int it = 0; it < nit; it += 2) {
            f32x2 acc2[8];
#pragma unroll
            for (int i = 0; i < 8; ++i) acc2[i] = (f32x2){0.f, 0.f};
            GT_LOADV(vB, wB, it + 1);
            GT_COMPV(vA, wA);
            if (it + 2 < nit) GT_LOADV(vA, wA, it + 2);
            GT_COMPV(vB, wB);
            f32x2 t4[4], t2[2], t1;
#pragma unroll
            for (int i = 0; i < 4; ++i) { const f32x2 snd = (s & 4) ? acc2[i] : acc2[i + 4], kp = (s & 4) ? acc2[i + 4] : acc2[i];
                t4[i] = kp + (f32x2){xchg32(snd.x, lane), xchg32(snd.y, lane)}; }
#pragma unroll
            for (int i = 0; i < 2; ++i) { const f32x2 snd = (s & 2) ? t4[i] : t4[i + 2], kp = (s & 2) ? t4[i + 2] : t4[i];
                t2[i] = kp + (f32x2){xchg16(snd.x, lane), xchg16(snd.y, lane)}; }
            { const f32x2 snd = (s & 1) ? t2[0] : t2[1], kp = (s & 1) ? t2[1] : t2[0]; t1 = kp + (f32x2){dppmov<DPP_ROR8>(snd.x), dppmov<DPP_ROR8>(snd.y)}; }
            { GT_ITEM(it); (void)hf_; const int r_ = GT_ROW(k_);
              const int col = cb_ * 128 + j * 16 + 2 * s; float* xp = XS + (size_t)r_ * DM + col; const float* g2 = modl + (size_t)mod_sel(r_) * 12288 + 5 * DM + col;
#ifdef DBG_CHECK
              if (((r_ - 300) & 63) == 0 && r_ >= 300 && r_ < 300 + 64 * 128) { float* dbgo = WSP(float, WS_MQ) + (size_t)r_ * DM + col; dbgo[0] = t1.x; dbgo[1] = t1.y; }
#endif
              const f32x2 x = *(const f32x2*)xp, g = *(const f32x2*)g2;
              *(f32x2*)xp = x + pscale * g * t1; }
        }
    }
#undef GT_LOADV
#undef GT_COMPV
#undef GT_ITEM
#undef GT_ROW
}
__device__ __forceinline__ void phase_final_norm(const Ctx& C) {
    const float* XS = WSP(float, WS_XS); const float* fg = INP(I_FG);
    for (int q = C.bid * 8 + C.wid; q < NBATCH * SEQ; q += C.G * 8) {
        const int b = q / SEQ, t = q % SEQ; const float* xr = XS + ((size_t)b * RPB + CTXL + t) * DM; float* op = C.out + (size_t)q * DM;
        f32x4 v[8]; float ss = 0.f;
#pragma unroll
        for (int c = 0; c < 8; ++c) { v[c] = *(const f32x4*)(xr + c * 256 + C.lane * 4); ss += v[c][0] * v[c][0] + v[c][1] * v[c][1] + v[c][2] * v[c][2] + v[c][3] * v[c][3]; }
        ss = wave_sum(ss); const float rs = rsqrtf(ss * (1.0f / DM) + NORM_EPS);
#pragma unroll
        for (int c = 0; c < 8; ++c) { const f32x4 g = *(const f32x4*)(fg + c * 256 + C.lane * 4); *(f32x4*)(op + c * 256 + C.lane * 4) = v[c] * rs * g; }
    }
}

template <int TYPE  > __device__ __forceinline__ void attn_units(const Ctx& C, bool need_ctx) {
    const bf16_t* P = WSP(bf16_t, WS_P);
    const int nu = need_ctx ? 528 : 512;
#pragma unroll 1
    for (int u = C.bid; u < nu; u += C.G) {
        int bh, qb; if (u < 512) { bh = (u >> 8) * 8 + (u & 7); qb = ((u & 255) >> 3) + 1; } else { bh = u - 512; qb = 0; }
        const int b = bh >> 3, h = bh & 7; const size_t rq = (size_t)b * RPB + (size_t)qb * 256, rk = (size_t)b * RPB; const int seq = qb == 0 ? CTXL : RPB;
        __syncthreads();
        if constexpr (TYPE == 1) {
            att::attn_body<128, 1>(P + rq * NP + C_AQ + h * 128, NP, P + rk * NP + C_AK + (h >> 2) * 128, NP, nullptr, 0, P + rk * NP + C_AV + (h >> 2) * 128, NP,
                                   WSP(bf16_t, WS_OA) + rq * 1024 + h * 128, 1024, seq, false, 0, nullptr, (char*)C.lds, C.tid);
        } else {
            const bf16_t* MQ = WSP(bf16_t, WS_MQ); const bf16_t* MKV = WSP(bf16_t, WS_MKV);
            att::attn_body<192, 1>(MQ + rq * 1536 + h * 192, 1536, MKV + rk * 2048 + h * 256, 2048, P + rk * NP + C_MKR, NP, MKV + rk * 2048 + h * 256 + 128, 2048,
                                   WSP(bf16_t, WS_OM) + rq * 1024 + h * 128, 1024, seq, qb > 0, (qb - 1) * 256, WSP(float, WS_TABM), (char*)C.lds, C.tid);
        }
    }
    __syncthreads();
}

constexpr int LDS_BYTES = 163840, LDS_BAR_OFF = LDS_BYTES - 16;
constexpr int N_PHASES = 26;
template <int K> __device__ __forceinline__ void run_phase(const Ctx& C0, int l) {
    const Ctx C = launder(C0);
    const float* modl = WSP(float, WS_MODV) + (size_t)l * 3 * 12288;
    if constexpr (K == 0) { phase_modv(C); phase_tables(C); __syncthreads(); phase_cvt_mixer_weights(C, 0); }
    if constexpr (K == 1) {
        if (l == 0) phase_norm_mod<true>(C, INP(I_N1G), modl, 0, DM);
        else { phase_norm_mod<false>(C, INP(I_N1G) + l * DM, modl, 0, DM); __syncthreads(); phase_cvt_mixer_weights(C, l); }
    }
    if constexpr (K == 2) {
        pg8::Gemm g{WSP(bf16_t, WS_HB), WSP(bf16_t, WS_WIN), TT, NP, DM, DM, DM}; pg8::WinOrder S; S.init(C.G, C.bid, l + 1 < DEPTH);
        pg8::EpiStoreBf16 E{WSP(bf16_t, WS_P), NP};
        pg8::gemm_phase(C.lds, C.tid, g, S, E);
    }
    if constexpr (K == 3) phase_post_p(C, l);
    if constexpr (K == 4) {
        { pg8::Gemm g{WSP(bf16_t, WS_P) + C_MCQ, WSP(bf16_t, WS_WUQ), TT, 1536, 512, NP, 512}; pg8::StaticOrder S; S.init(TT, 1536, C.G, C.bid);
          pg8::EpiStoreBf16 E{WSP(bf16_t, WS_MQ), 1536}; pg8::gemm_phase(C.lds, C.tid, g, S, E); }
        { pg8::Gemm g{WSP(bf16_t, WS_P) + C_MCKV, WSP(bf16_t, WS_WUKV), TT, 2048, 512, NP, 512}; pg8::StaticOrder S; S.init(TT, 2048, C.G, C.bid);
          pg8::EpiStoreBf16 E{WSP(bf16_t, WS_MKV), 2048}; pg8::gemm_phase(C.lds, C.tid, g, S, E); }
        { const Ctx C2 = launder(C0); phase_gla_local(C2, l); }
#ifdef DBG_DUP_GLALOCAL
        { const Ctx C2 = launder(C0); __syncthreads(); phase_gla_local(C2, l); }
#endif
    }
    if constexpr (K == 5) phase_gla_scan(C);
    if constexpr (K == 6) { attn_units<0>(C, l + 1 < DEPTH); { const Ctx C2 = launder(C0); attn_units<1>(C2, l + 1 < DEPTH); } { const Ctx C3 = launder(C0); phase_gla_out(C3, l); }
#ifdef DBG_DUP_GLAOUT
        { const Ctx C3 = launder(C0); __syncthreads(); phase_gla_out(C3, l); }
#endif
    }
    if constexpr (K == 7) {
        const bf16_t* P = WSP(bf16_t, WS_P); bf16_t* Y = WSP(bf16_t, WS_Y);
        const pg8::Gemm ga{WSP(bf16_t, WS_OA), WSP(bf16_t, WS_WBR), TT, DM, 1024, 1024, 1024}, gl{WSP(bf16_t, WS_OL), WSP(bf16_t, WS_WBR) + (size_t)2048 * 1024, TT, DM, 1024, 1024, 1024},
                        gm{WSP(bf16_t, WS_OM), WSP(bf16_t, WS_WBR) + (size_t)2 * 2048 * 1024, TT, DM, 1024, 1024, 1024};
        const pg8::EpiGate<true> Ea{Y, DM, P + C_GA, NP}; const pg8::EpiGate<false> El{Y, DM, P + C_GL, NP}, Em{Y, DM, P + C_GM, NP};
        pg8::StaticOrder S; S.init(TT, DM, C.G, C.bid, l + 1 >= DEPTH);
        pg8::gemm_phase(C.lds, C.tid, ga, S, Ea); pg8::gemm_phase(C.lds, C.tid, gl, S, El); pg8::gemm_phase(C.lds, C.tid, gm, S, Em);
    }
    if constexpr (K == 8) {
        pg8::Gemm g{WSP(bf16_t, WS_Y), WSP(bf16_t, WS_WOUT), TT, DM, DM, DM, DM};
        pg8::EpiResid E{WSP(float, WS_XS), DM, modl + 2 * DM, l == 0 ? DBG_MIX0 : DBG_MIX1};
        pg8::StaticOrder S; S.init(TT, DM, C.G, C.bid, l + 1 >= DEPTH);
#ifdef DBG_DUP8
        { pg8::EpiResid E0{WSP(float, WS_XS), DM, modl + 2 * DM, 0.0f}; pg8::gemm_phase(C.lds, C.tid, g, S, E0); }
#endif
        pg8::gemm_phase(C.lds, C.tid, g, S, E);
        phase_cvt_peer_tables(C, l);
#ifdef DBG_CDUP
        phase_cvt_peer_tables(C, l);
#endif
    }
    if constexpr (K == 9) phase_norm_mod<false>(C, INP(I_N2G) + l * DM, modl, 3 * DM, 4 * DM);
    if constexpr (K == 10) {
        pg8::Gemm g{WSP(bf16_t, WS_HB), WSP(bf16_t, WS_WQ), TT, DM, DM, DM, DM};
        pg8::EpiStoreBf16 E{WSP(bf16_t, WS_PQ), DM};
        pg8::StaticOrder S; S.init(TT, DM, C.G, C.bid, l + 1 >= DEPTH); pg8::gemm_phase(C.lds, C.tid, g, S, E);
    }
    if constexpr (K == 11) phase_peer_select(C, l + 1 >= DEPTH);
    if constexpr (K == 13) phase_final_norm(C);
    if constexpr (K == 12) {
#ifdef DBG_DUP12
        if (l + 1 < DEPTH) phase_peer_gather<false>(C, modl, 0.0f); else phase_peer_gather<true>(C, modl, 0.0f);
        __syncthreads();
#endif
        if (l + 1 < DEPTH) phase_peer_gather<false>(C, modl, DBG_PEER0); else phase_peer_gather<true>(C, modl, DBG_PEER1); }
}
__device__ __forceinline__ Ctx make_ctx(const Args& args, unsigned char* lds_raw) {
    Ctx C0; C0.in = (const __attribute__((address_space(4))) cfp_t*)__builtin_amdgcn_kernarg_segment_ptr(); C0.out = args.out; C0.ws = args.ws; C0.lds = (LAS unsigned char*)lds_raw;
    C0.tid = threadIdx.x; C0.lane = C0.tid & 63; C0.wid = __builtin_amdgcn_readfirstlane(C0.tid >> 6); C0.G = gridDim.x; C0.bid = blockIdx.x;
    return C0;
}
template <int K> __global__ void __launch_bounds__(NTHREADS, 2) k_one(Args args) {
    extern __shared__ __attribute__((aligned(16))) unsigned char lds_raw[];
    const Ctx C0 = make_ctx(args, lds_raw);
    run_phase<K>(C0, args.ph_lo);
}
#if MK_N_LAUNCHES == 1 || defined(DBG_HYB)
__global__ void __launch_bounds__(NTHREADS, 2) mk_fwd(Args args) {
    extern __shared__ __attribute__((aligned(16))) unsigned char lds_raw[];
    const Ctx C0 = make_ctx(args, lds_raw);
    if (C0.tid < 4) ((LAS unsigned*)(C0.lds + LDS_BAR_OFF))[C0.tid] = 0u;
    __syncthreads();
    const int lo = args.ph_lo, hi = args.ph_hi;
    XcdBarrier bar; bar.bar = (unsigned*)(args.ws + WS_CTL); bar.x = 0; bar.st = nullptr;
    if (hi - lo > 1) bar = xcd_barrier_post((unsigned*)(args.ws + WS_CTL), (volatile LAS unsigned*)(C0.lds + LDS_BAR_OFF));
#define IN(k) (lo <= (k) && (k) < hi)
#define SEAM(k) do { if (IN(k) && IN((k) + 1)) xcd_barrier(bar); } while (0)
#ifndef DBG_DUP
#define DBG_DUP -1
#endif
#define PH(K, k) do { if (IN(k)) { run_phase<K>(C0, l); if (K == DBG_DUP) { xcd_barrier(bar); run_phase<K>(C0, l); } } SEAM(k); } while (0)
    { const int l = 0; PH(0, 0); }
#pragma unroll 1
    for (int l = 0; l < DEPTH; ++l) {
        const int pb = 1 + 12 * l;
        PH(1, pb + 0); PH(2, pb + 1); PH(3, pb + 2); PH(4, pb + 3); PH(5, pb + 4); PH(6, pb + 5);
        PH(7, pb + 6); PH(8, pb + 7); PH(9, pb + 8); PH(10, pb + 9); PH(11, pb + 10); PH(12, pb + 11);
    }
    { const int l = DEPTH - 1; PH(13, 1 + 12 * DEPTH); }
#undef PH
#undef IN
#undef SEAM
}
#define MAIN_KERNEL mk_fwd
#else
#define MAIN_KERNEL k_one<6>
#endif


#ifdef DBG_CHECK
__device__ __forceinline__ void dbg_report(unsigned* slot, float err) { if (!(err <= 3e38f)) err = 1e30f; atomicMax(slot, __float_as_uint(err)); }
__global__ void k_check_gemm(const bf16_t* A, int lda, const float* W, int K, int N, const bf16_t* Cm, int ldc, int M, unsigned* slot) {
    const unsigned id = blockIdx.x * blockDim.x + threadIdx.x; if (id >= 8192) return;
    const unsigned h = id * 2654435761u; const int row = (int)((h >> 8) % (unsigned)M), col = (int)((h * 40503u >> 7) % (unsigned)N);
    float ref = 0.f; for (int k = 0; k < K; ++k) ref += bf2f(A[(size_t)row * lda + k]) * W[(size_t)k * N + col];
    const float got = bf2f(Cm[(size_t)row * ldc + col]);
    dbg_report(slot, fabsf(got - ref) / (fabsf(ref) + 0.1f));
}

__global__ void k_check_attn(const unsigned char* ws, int type, unsigned* slot) {
    __shared__ float sc[RPB]; __shared__ float red[256]; __shared__ float qv[192];
    const int t = threadIdx.x, bh = blockIdx.x & 15, b = bh >> 3, h = bh & 7; const int qpos = (int)(((blockIdx.x >> 4) * 977u + 13u) % SEQ); const size_t rq = (size_t)b * RPB + CTXL + qpos, rk = (size_t)b * RPB;
    const bf16_t* P = (const bf16_t*)(ws + WS_P); const bf16_t* MQ = (const bf16_t*)(ws + WS_MQ); const bf16_t* MKV = (const bf16_t*)(ws + WS_MKV);
    const int dq = type ? 128 : 192;
    if (t < dq) { float v = type ? bf2f(P[rq * NP + C_AQ + h * 128 + t]) : bf2f(MQ[rq * 1536 + h * 192 + t]); qv[t] = v; }
    __syncthreads();
    if (!type && t < 32) {
        const int ri = qpos >> 6, ci = qpos & 63; const int i = t; const float pos = (float)(i < 16 ? ri : ci); const float inv = powf(10000.f, -(float)(i & 15) / 16.f); const float a = pos * inv;
        const float x1 = qv[128 + i], x2 = qv[160 + i]; qv[128 + i] = x1 * cosf(a) - x2 * sinf(a); qv[160 + i] = x2 * cosf(a) + x1 * sinf(a); }
    __syncthreads();
    const float scale = type ? 0.088388347648f : 0.0721687836487f;
    float mx = -1e30f;
    for (int k = t; k < RPB; k += 256) { float s = 0.f;
        if (type) { const bf16_t* kp = P + (rk + k) * NP + C_AK + (h >> 2) * 128; for (int d = 0; d < 128; ++d) s += qv[d] * bf2f(kp[d]); }
        else { const bf16_t* kp = MKV + (rk + k) * 2048 + h * 256; for (int d = 0; d < 128; ++d) s += qv[d] * bf2f(kp[d]); const bf16_t* kr = P + (rk + k) * NP + C_MKR; for (int d = 0; d < 64; ++d) s += qv[128 + d] * bf2f(kr[d]); }
        s *= scale; sc[k] = s; mx = fmaxf(mx, s); }
    red[t] = mx; __syncthreads(); for (int o = 128; o >= 1; o >>= 1) { if (t < o) red[t] = fmaxf(red[t], red[t + o]); __syncthreads(); } mx = red[0]; __syncthreads();
    float sum = 0.f; for (int k = t; k < RPB; k += 256) { const float p = __expf(sc[k] - mx); sc[k] = p; sum += p; }
    red[t] = sum; __syncthreads(); for (int o = 128; o >= 1; o >>= 1) { if (t < o) red[t] += red[t + o]; __syncthreads(); } sum = red[0]; __syncthreads();
    float e = 0.f, mag = 0.f;
    if (t < 128) { float o = 0.f; for (int k = 0; k < RPB; ++k) { const float vv = type ? bf2f(P[(rk + k) * NP + C_AV + (h >> 2) * 128 + t]) : bf2f(MKV[(rk + k) * 2048 + h * 256 + 128 + t]); o += sc[k] * vv; }
        o /= sum; const float got = bf2f(((const bf16_t*)(ws + (type ? WS_OA : WS_OM)))[rq * 1024 + h * 128 + t]); e = fabsf(got - o); mag = fabsf(o); }
    red[t] = e; __syncthreads(); for (int o = 128; o >= 1; o >>= 1) { if (t < o) red[t] = fmaxf(red[t], red[t + o]); __syncthreads(); } e = red[0]; __syncthreads();
    red[t] = mag; __syncthreads(); for (int o = 128; o >= 1; o >>= 1) { if (t < o) red[t] = fmaxf(red[t], red[t + o]); __syncthreads(); } mag = red[0];
    if (t == 0) dbg_report(slot, e / (mag + 1e-4f));
}
__global__ void __launch_bounds__(256) k_check_gla_rec(const unsigned char* ws, const float* wa_f, const float* ba_f, const float* wa_b, const float* ba_b, float* obuf, int b) {
    __shared__ float ad[128], kd[128], qd[128], lrs[16];
    const int e = threadIdx.x, h = blockIdx.x & 3, dir = blockIdx.x >> 2; const bf16_t* P = (const bf16_t*)(ws + WS_P);
    const float* wa = dir ? wa_b : wa_f; const float* ba = dir ? ba_b : ba_f;
    float S[128];
#pragma unroll
    for (int d = 0; d < 128; ++d) S[d] = 0.f;
    float* ob = obuf + ((size_t)(dir * 2 + b) * 4 + h) * RPB * 256;
    for (int st = 0; st < RPB; ++st) {
        int j; if (!dir) j = st; else j = st < CTXL ? CTXL - 1 - st : RPB - 1 - (st - CTXL);
        const size_t r = (size_t)b * RPB + j; const bf16_t* pr = P + r * NP;
        if (e < 16) lrs[e] = bf2f(pr[(dir ? C_LRB : C_LRF) + e]);
        __syncthreads();
        if (e < 128) { float pre = ba[h * 128 + e]; for (int q = 0; q < 16; ++q) pre += lrs[q] * wa[q * 512 + h * 128 + e];
            const float ls = (fminf(pre, 0.f) - log1pf(expf(-fabsf(pre)))) / 16.f; ad[e] = expf(ls); kd[e] = bf2f(pr[C_LK + h * 128 + e]); qd[e] = bf2f(pr[C_LQ + h * 128 + e]) * 0.088388347648f; }
        __syncthreads();
        const float v = bf2f(pr[C_LV + h * 256 + e]); float o = 0.f;
#pragma unroll
        for (int d = 0; d < 128; ++d) { S[d] = ad[d] * S[d] + kd[d] * v; o += qd[d] * S[d]; }
        ob[(size_t)j * 256 + e] = o;
        __syncthreads();
    }
}
__global__ void k_check_gla_cmp(const unsigned char* ws, const float* obuf, const float* gon, int b, unsigned* slot) {
    __shared__ float red[256];
    const int e = threadIdx.x, h = blockIdx.x & 3, j = blockIdx.x >> 2; const size_t r = (size_t)b * RPB + j; const bf16_t* P = (const bf16_t*)(ws + WS_P);
    const float o = obuf[((size_t)(0 * 2 + b) * 4 + h) * RPB * 256 + (size_t)j * 256 + e] + obuf[((size_t)(1 * 2 + b) * 4 + h) * RPB * 256 + (size_t)j * 256 + e];
    red[e] = o * o; __syncthreads(); for (int s_ = 128; s_ >= 1; s_ >>= 1) { if (e < s_) red[e] += red[e + s_]; __syncthreads(); }
    const float rs = rsqrtf(red[0] / 256.f + NORM_EPS); __syncthreads();
    const float gt = bf2f(P[r * NP + C_LG + h * 256 + e]); const float ref = o * rs * gon[e] * (gt / (1.f + expf(-gt)));
    const float got = bf2f(((const bf16_t*)(ws + WS_OL))[r * 1024 + h * 256 + e]);
    red[e] = fabsf(got - ref); __syncthreads(); for (int s_ = 128; s_ >= 1; s_ >>= 1) { if (e < s_) red[e] = fmaxf(red[e], red[e + s_]); __syncthreads(); }
    if (e == 0) dbg_report(slot, red[0] / 1.0f);
}
__global__ void k_check_select(const bf16_t* PQ, const float* k1, const float* k2, const int* PIDX, const float* PG, unsigned* slot) {
    __shared__ float s1[128], s2[128]; __shared__ int cnt; __shared__ float selv[16];
    const int tok = (blockIdx.x >> 3) * 61 + 5, head = blockIdx.x & 7, t = threadIdx.x;
    if (t == 0) cnt = 0;
    for (int n = t; n < 128; n += 64) { float a = 0.f, b = 0.f; for (int d = 0; d < 128; ++d) { a += bf2f(PQ[(size_t)tok * DM + head * 256 + d]) * k1[((size_t)head * 128 + n) * 128 + d]; b += bf2f(PQ[(size_t)tok * DM + head * 256 + 128 + d]) * k2[((size_t)head * 128 + n) * 128 + d]; } s1[n] = a; s2[n] = b; }
    __syncthreads();
    if (t < 16) { const int id = PIDX[(size_t)tok * 128 + head * 16 + t]; selv[t] = (id >= 0 && id < 16384) ? s1[id >> 7] + s2[id & 127] : -1e30f; }
    __syncthreads();
    float thr = selv[0], mx = selv[0]; for (int k = 1; k < 16; ++k) { thr = fminf(thr, selv[k]); mx = fmaxf(mx, selv[k]); }
    int c = 0; for (int p = t; p < 16384; p += 64) if (s1[p >> 7] + s2[p & 127] > thr + 0.02f) ++c;
    atomicAdd(&cnt, c); __syncthreads();
    if (t == 0) { float den = 0.f; for (int k = 0; k < 16; ++k) den += __expf(selv[k] - mx); float e = fabsf((float)cnt - 15.f) / 15.f > 0.34f ? fabsf((float)cnt - 15.f) / 15.f : 0.f;
        for (int k = 0; k < 16; ++k) e = fmaxf(e, fabsf(PG[(size_t)tok * 128 + head * 16 + k] - __expf(selv[k] - mx) / den) * 4.f);
        for (int k = 0; k < 16; ++k) for (int k2_ = 0; k2_ < k; ++k2_) if (PIDX[(size_t)tok * 128 + head * 16 + k] == PIDX[(size_t)tok * 128 + head * 16 + k2_]) e = fmaxf(e, 10.f);
        dbg_report(slot, e); }
}
__global__ void k_check_gather(const bf16_t* HB, const float* u, const float* v, const int* PIDX, const float* PG, const float* dbgo, unsigned* slot) {
    __shared__ float w[128];
    const int tok = blockIdx.x * 64 + 300, t = threadIdx.x;
    for (int k = t; k < 128; k += 64) { const int id = PIDX[(size_t)tok * 128 + k] & 16383; float a = 0.f; for (int d = 0; d < DM; ++d) a += bf2f(HB[(size_t)tok * DM + d]) * u[(size_t)id * DM + d];
        w[k] = PG[(size_t)tok * 128 + k] * 0.5f * a * (1.0f + erff(a * 0.70710678f)); }
    __syncthreads();
    float e = 0.f, sc = 0.f;
    for (int d = t; d < DM; d += 64) { float o = 0.f; for (int k = 0; k < 128; ++k) o += w[k] * v[(size_t)(PIDX[(size_t)tok * 128 + k] & 16383) * DM + d];
        e = fmaxf(e, fabsf(o - dbgo[(size_t)tok * DM + d])); sc = fmaxf(sc, fabsf(o)); }
    for (int o_ = 32; o_ >= 1; o_ >>= 1) { e = fmaxf(e, __shfl_xor(e, o_)); sc = fmaxf(sc, __shfl_xor(sc, o_)); }
    if (t == 0) dbg_report(slot, e / (sc + 1e-6f));
}
__global__ void k_dbg_out2(const float* x, const float* fg, float* out, const unsigned* slot) {
    const float mx = __uint_as_float(*slot); float v = 0.25f * (log10f(fmaxf(mx, 1e-30f)) + 4.0f); v = fminf(fmaxf(v, 0.f), 9.f);
    const float f = 1.0f + v;
    const int lane = threadIdx.x & 63; const size_t r = (size_t)blockIdx.x * 4 + (threadIdx.x >> 6);
    const float* xr = x + r * DM; float ss = 0.f;
    for (int c = lane; c < DM; c += 64) ss += xr[c] * xr[c];
    ss = wave_sum(ss); const float rs = rsqrtf(ss / DM + NORM_EPS);
    for (int c = lane; c < DM; c += 64) out[r * DM + c] = xr[c] * rs * fg[c] * f;
}
#endif
#ifdef DBG_SCAN
__global__ void k_scan16(const bf16_t* p, size_t n, unsigned* flags, int stage) {
    unsigned bad = 0; for (size_t i = (size_t)blockIdx.x * blockDim.x + threadIdx.x; i < n; i += (size_t)gridDim.x * blockDim.x) bad |= ((p[i] & 0x7f80u) == 0x7f80u);
    if (bad) atomicOr(&flags[stage], 1u);
}
__global__ void k_scan32(const float* p, size_t n, unsigned* flags, int stage) {
    unsigned bad = 0; for (size_t i = (size_t)blockIdx.x * blockDim.x + threadIdx.x; i < n; i += (size_t)gridDim.x * blockDim.x) bad |= ((__float_as_uint(p[i]) & 0x7f800000u) == 0x7f800000u);
    if (bad) atomicOr(&flags[stage], 1u);
}
__global__ void k_dbg_out(const float* x, const float* fg, float* out, const unsigned* flags, int nstage) {
    int code = 0; for (int s = nstage; s >= 1; --s) if (flags[s]) code = s;
    const float f = 1.0f + 0.25f * (float)code;
    const int lane = threadIdx.x & 63; const size_t r = (size_t)blockIdx.x * 4 + (threadIdx.x >> 6);
    const float* xr = x + r * DM; float ss = 0.f;
    for (int c = lane; c < DM; c += 64) ss += xr[c] * xr[c];
    ss = wave_sum(ss); const float rs = rsqrtf(ss / DM + NORM_EPS);
    for (int c = lane; c < DM; c += 64) out[r * DM + c] = xr[c] * rs * fg[c] * f;
}
#endif
extern "C" void kernel_launch(void* const* d_in, const int* in_sizes, int n_in, void* d_out, int out_size, void* d_ws, size_t ws_size, hipStream_t stream) {
    static int grid = 0;
    if (grid == 0) {
        if (n_in != 30 || out_size != NBATCH * SEQ * DM || ws_size < WS_END) { fprintf(stderr, "kernel_launch: shape/workspace mismatch: n_in %d out %d ws %zu (need %zu)\n", n_in, out_size, ws_size, (size_t)WS_END); grid = -1; return; }
        int dev = 0, cus = 0, per_cu = 0;
        if (hipGetDevice(&dev) != hipSuccess || hipDeviceGetAttribute(&cus, hipDeviceAttributeMultiprocessorCount, dev) != hipSuccess) { grid = -1; return; }
        bool okattr = hipFuncSetAttribute((const void*)MAIN_KERNEL, hipFuncAttributeMaxDynamicSharedMemorySize, LDS_BYTES) == hipSuccess;
#if MK_N_LAUNCHES != 1
#ifdef DBG_HYB
        okattr = okattr && hipFuncSetAttribute((const void*)mk_fwd, hipFuncAttributeMaxDynamicSharedMemorySize, LDS_BYTES) == hipSuccess;
#endif
#define SETA(K) okattr = okattr && hipFuncSetAttribute((const void*)k_one<K>, hipFuncAttributeMaxDynamicSharedMemorySize, LDS_BYTES) == hipSuccess
        SETA(0); SETA(1); SETA(2); SETA(3); SETA(4); SETA(5); SETA(6); SETA(7); SETA(8); SETA(9); SETA(10); SETA(11); SETA(12); SETA(13);
#undef SETA
#endif
        if (!okattr) { fprintf(stderr, "kernel_launch: hipFuncSetAttribute failed\n"); grid = -1; return; }
        if (hipOccupancyMaxActiveBlocksPerMultiprocessor(&per_cu, (const void*)MAIN_KERNEL, NTHREADS, LDS_BYTES) != hipSuccess || per_cu < 1) { fprintf(stderr, "kernel_launch: occupancy query says %d blocks per CU\n", per_cu); grid = -1; (void)hipGetLastError(); return; }
        grid = cus;
    }
    if (grid < 0) return;
    if (hipMemsetAsync((char*)d_ws + WS_CTL, 0, CTL_BYTES, stream) != hipSuccess) return;
    Args a{};
    for (int i = 0; i < 30; ++i) a.in[i] = (const float*)d_in[i];
    a.out = (float*)d_out; a.ws = (unsigned char*)d_ws;
#if MK_N_LAUNCHES == 1
#ifdef DBG_SPLIT
    for (int p = 0; p < N_PHASES; p += DBG_SPLIT) { a.ph_lo = p; a.ph_hi = p + DBG_SPLIT < N_PHASES ? p + DBG_SPLIT : N_PHASES; hipLaunchKernelGGL(mk_fwd, dim3(grid), dim3(NTHREADS), LDS_BYTES, stream, a); }
#else
    a.ph_lo = 0; a.ph_hi = N_PHASES;
    hipLaunchKernelGGL(mk_fwd, dim3(grid), dim3(NTHREADS), LDS_BYTES, stream, a);
#endif
#else
    a.ph_hi = 0;
#ifndef DBG_NLAUNCH
#define DBG_NLAUNCH 100
#endif
    int nl_ = 0;
#ifdef DBG_HYB
#define LAUNCH1(K, L) do { if (K == DBG_HYB) { a.ph_lo = 12 * (L) + (K); a.ph_hi = a.ph_lo + 1; hipLaunchKernelGGL(mk_fwd, dim3(grid), dim3(NTHREADS), LDS_BYTES, stream, a); a.ph_hi = 0; } else { a.ph_lo = (L); hipLaunchKernelGGL(k_one<K>, dim3(grid), dim3(NTHREADS), LDS_BYTES, stream, a); } } while (0)
#else
#define LAUNCH1(K, L) do { a.ph_lo = (L); if (nl_++ < DBG_NLAUNCH) { hipLaunchKernelGGL(k_one<K>, dim3(grid), dim3(NTHREADS), LDS_BYTES, stream, a); if (K == DBG_DUP) hipLaunchKernelGGL(k_one<K>, dim3(grid), dim3(NTHREADS), LDS_BYTES, stream, a); } } while (0)
#endif
#ifdef DBG_SCAN
    unsigned* flags = (unsigned*)((char*)d_ws + WS_CTL + 32768);
    char* W = (char*)d_ws;
#define S16(off, n, st) hipLaunchKernelGGL(k_scan16, dim3(1024), dim3(256), 0, stream, (const bf16_t*)(W + (off)), (size_t)(n), flags, st)
#define S32(off, n, st) hipLaunchKernelGGL(k_scan32, dim3(1024), dim3(256), 0, stream, (const float*)(W + (off)), (size_t)(n), flags, st)
    LAUNCH1(0, 0); S32(WS_MODV, 2 * 3 * 12288, 1);
    { const int l = 0;
      LAUNCH1(1, l); S16(WS_HB, (size_t)TT * DM, 2);
      LAUNCH1(2, l); S16(WS_P, (size_t)TT * NP, 3);
      LAUNCH1(3, l); S16(WS_P, (size_t)TT * NP, 4);
      LAUNCH1(4, l); S16(WS_MQ, (size_t)TT * 1536, 5); S16(WS_MKV, (size_t)TT * 2048, 5); S16(WS_GST, (size_t)2112 * 32768, 6); S32(WS_GDEC, (size_t)2112 * 128, 6);
      LAUNCH1(5, l); S16(WS_GST, (size_t)2112 * 32768, 7);
      LAUNCH1(6, l); S16(WS_OA, (size_t)TT * 1024, 8); S16(WS_OM, (size_t)TT * 1024, 9); S16(WS_OL, (size_t)TT * 1024, 10);
      LAUNCH1(7, l); S16(WS_Y, (size_t)TT * DM, 11);
      LAUNCH1(8, l); S32(WS_XS, (size_t)TT * DM, 12);
      LAUNCH1(9, l); S16(WS_HB, (size_t)TT * DM, 13);
      LAUNCH1(10, l); S16(WS_PQ, (size_t)TT * DM, 14);
      LAUNCH1(11, l); S32(WS_PG, (size_t)TT * 128, 15);
      LAUNCH1(12, l); S32(WS_XS, (size_t)TT * DM, 16);
    }
    hipLaunchKernelGGL(k_dbg_out, dim3(NBATCH * SEQ / 4), dim3(256), 0, stream, (const float*)d_in[0], (const float*)d_in[29], (float*)d_out, flags, 16);
#elif defined(DBG_CHECK)
    unsigned* flags = (unsigned*)((char*)d_ws + WS_CTL + 32768);
    char* W = (char*)d_ws;
    LAUNCH1(0, 0);
    { const int l = 0; LAUNCH1(1, l); LAUNCH1(2, l); LAUNCH1(3, l); LAUNCH1(4, l); LAUNCH1(5, l); LAUNCH1(6, l);
#if DBG_CHECK == 5 || DBG_CHECK == 6
      hipLaunchKernelGGL(k_check_attn, dim3(16 * 24), dim3(256), 0, stream, (const unsigned char*)d_ws, DBG_CHECK == 5 ? 1 : 0, flags + 100);
#endif
#if DBG_CHECK == 7
      { float* obuf = (float*)(W + WS_MQ);
        hipLaunchKernelGGL(k_check_gla_rec, dim3(8), dim3(256), 0, stream, (const unsigned char*)d_ws, (const float*)d_in[I_WA2F], (const float*)d_in[I_BAF], (const float*)d_in[I_WA2B], (const float*)d_in[I_BAB], obuf, 0);
        hipLaunchKernelGGL(k_check_gla_cmp, dim3(RPB * 4), dim3(256), 0, stream, (const unsigned char*)d_ws, (const float*)obuf, (const float*)d_in[I_ONG], 0, flags + 100); }
#endif
      LAUNCH1(7, l); LAUNCH1(8, l); LAUNCH1(9, l); LAUNCH1(10, l);
#if DBG_CHECK == 1
      hipLaunchKernelGGL(k_check_gemm, dim3(32), dim3(256), 0, stream, (const bf16_t*)(W + WS_HB), DM, (const float*)d_in[I_PWQ], DM, DM, (const bf16_t*)(W + WS_PQ), DM, TT, flags + 100);
#endif
      LAUNCH1(11, l);
#if DBG_CHECK == 2
      hipLaunchKernelGGL(k_check_select, dim3(256 * 8), dim3(64), 0, stream, (const bf16_t*)(W + WS_PQ), (const float*)d_in[I_PK1], (const float*)d_in[I_PK2], (const int*)(W + WS_PIDX), (const float*)(W + WS_PG), flags + 100);
#endif
      LAUNCH1(12, l);
#if DBG_CHECK == 3
      hipLaunchKernelGGL(k_check_gather, dim3(128), dim3(64), 0, stream, (const bf16_t*)(W + WS_HB), (const float*)d_in[I_PU], (const float*)d_in[I_PV], (const int*)(W + WS_PIDX), (const float*)(W + WS_PG), (const float*)(W + WS_MQ), flags + 100);
#endif
    }
    hipLaunchKernelGGL(k_dbg_out2, dim3(NBATCH * SEQ / 4), dim3(256), 0, stream, (const float*)d_in[0], (const float*)d_in[29], (float*)d_out, flags + 100);
#else
    LAUNCH1(0, 0);
    for (int l = 0; l < DEPTH; ++l) { LAUNCH1(1, l); LAUNCH1(2, l); LAUNCH1(3, l);
#ifdef DBG_DUP23
        LAUNCH1(2, l); LAUNCH1(3, l);
#endif
        LAUNCH1(4, l); LAUNCH1(5, l);
#ifdef DBG_DUP45
        LAUNCH1(4, l); LAUNCH1(5, l);
#endif
        LAUNCH1(6, l); LAUNCH1(7, l); LAUNCH1(8, l); LAUNCH1(9, l); LAUNCH1(10, l); LAUNCH1(11, l); LAUNCH1(12, l); }
    LAUNCH1(13, DEPTH - 1);
#endif
#undef LAUNCH1
#endif
    const hipError_t le = hipPeekAtLastError();
    if (le != hipSuccess) fprintf(stderr, "kernel_launch: launch failed: %s\n", hipGetErrorName(le));
}
```

```cpp
#include <hip/hip_runtime.h>
#include <cstdio>
#include <cstdint>

#ifndef MK_N_LAUNCHES
#ifndef DBG_DUP
#define DBG_DUP -1
#endif
#define MK_N_LAUNCHES 1
#endif

#ifndef DBG_MIX0
#define DBG_MIX0 1.0f
#define DBG_MIX1 1.0f
#define DBG_PEER0 1.0f
#define DBG_PEER1 1.0f
#endif
#define LAS __attribute__((address_space(3)))
#define GLB __attribute__((address_space(1)))
typedef unsigned short bf16_t;
typedef short bf16x8 __attribute__((ext_vector_type(8)));
typedef short s16x4 __attribute__((ext_vector_type(4)));
typedef float f32x4 __attribute__((ext_vector_type(4)));
typedef float f32x2 __attribute__((ext_vector_type(2)));
typedef float f32x16 __attribute__((ext_vector_type(16)));
typedef unsigned u32x4 __attribute__((ext_vector_type(4)));
typedef unsigned u32x2 __attribute__((ext_vector_type(2)));
typedef __bf16 bf2_t __attribute__((ext_vector_type(2)));

constexpr int DM = 2048, NBATCH = 2, SEQ = 8192, CTXL = 256, DEPTH = 2;
constexpr int RPB = SEQ + CTXL;
constexpr int TT = NBATCH * RPB;
constexpr int IN_COLS = 11872, NP = 12032;
constexpr int C_AQ = 0, C_AK = 1024, C_AV = 1280, C_LQ = 1536, C_LK = 2048, C_LV = 2560, C_LG = 3584, C_LRF = 4608, C_LRB = 4624,
              C_MCQ = 4640, C_MCKV = 5152, C_MKR = 5664, C_GA = 5728, C_GL = 7776, C_GM = 9824;
constexpr int NCH = RPB / 64;
constexpr int NEXP = 16384;
constexpr float NORM_EPS = 1e-6f;
constexpr int NTHREADS = 512;

constexpr size_t al256(size_t x) { return (x + 255) / 256 * 256; }
constexpr size_t WS_CTL   = 0;
constexpr size_t CTL_BYTES = 65536;
constexpr size_t WS_MODV  = WS_CTL + CTL_BYTES;
constexpr size_t WS_TABA  = al256(WS_MODV + (size_t)2 * 3 * 12288 * 4);
constexpr size_t WS_TABM  = WS_TABA + 2 * 128 * 32 * 4;
constexpr size_t WS_XS    = al256(WS_TABM + 2 * 128 * 16 * 4);
constexpr size_t WS_HB    = WS_XS + (size_t)TT * DM * 4;
constexpr size_t WS_P     = WS_HB + (size_t)TT * DM * 2;
constexpr size_t WS_MQ    = WS_P + (size_t)TT * NP * 2;
constexpr size_t WS_MKV   = WS_MQ + (size_t)TT * 1536 * 2;
constexpr size_t WS_OA    = WS_MKV + (size_t)TT * 2048 * 2;
constexpr size_t WS_OL    = WS_OA + (size_t)TT * 1024 * 2;
constexpr size_t WS_OM    = WS_OL + (size_t)TT * 1024 * 2;
constexpr size_t WS_WIN   = WS_OM + (size_t)TT * 1024 * 2;
constexpr size_t WS_WUQ   = WS_WIN + (size_t)NP * 2048 * 2;
constexpr size_t WS_WUKV  = WS_WUQ + (size_t)1536 * 512 * 2;
constexpr size_t WS_WBR   = WS_WUKV + (size_t)2048 * 512 * 2;
constexpr size_t WS_WOUT  = WS_WBR + (size_t)3 * 2048 * 1024 * 2;
constexpr size_t WS_WQ    = WS_WOUT + (size_t)2048 * 2048 * 2;
constexpr size_t WS_K1    = WS_WQ + (size_t)2048 * 2048 * 2;
constexpr size_t WS_K2    = WS_K1 + (size_t)8 * 128 * 128 * 2;
constexpr size_t WS_GST   = WS_K2 + (size_t)8 * 128 * 128 * 2;
constexpr size_t WS_GDEC  = WS_GST + (size_t)NBATCH * 2 * 4 * NCH * 32768 * 2;
constexpr size_t WS_END   = WS_GDEC + (size_t)NBATCH * 2 * 4 * NCH * 128 * 4;
constexpr size_t WS_Y     = WS_MKV;
constexpr size_t WS_PQ    = WS_OA;
constexpr size_t WS_U8    = WS_P;
constexpr size_t WS_V8    = WS_U8 + (size_t)NEXP * DM;
constexpr size_t WS_SCU   = WS_V8 + (size_t)NEXP * DM;
constexpr size_t WS_SCV   = WS_SCU + (size_t)NEXP * 4;
constexpr size_t WS_PIDX  = WS_SCV + (size_t)NEXP * 4;
constexpr size_t WS_PG    = WS_PIDX + (size_t)TT * 128 * 4;
static_assert(WS_PG + (size_t)TT * 128 * 4 <= WS_MQ, "PEER alias region overflows P");

__device__ __forceinline__ unsigned cvt_pk_bf16(float lo, float hi) { bf2_t v; v.x = (__bf16)lo; v.y = (__bf16)hi; return __builtin_bit_cast(unsigned, v); }
__device__ __forceinline__ bf16_t f2bf(float f) { return (bf16_t)(cvt_pk_bf16(f, 0.f) & 0xffffu); }
__device__ __forceinline__ float bf2f(bf16_t b) { return __uint_as_float(((unsigned)b) << 16); }
__device__ __forceinline__ float bflo(unsigned w) { return __uint_as_float(w << 16); }
__device__ __forceinline__ float bfhi(unsigned w) { return __uint_as_float(w & 0xffff0000u); }
__device__ __forceinline__ float xchg32(float x, int lane) { auto r = __builtin_amdgcn_permlane32_swap(__float_as_uint(x), __float_as_uint(x), false, false); return __uint_as_float(lane < 32 ? r[1] : r[0]); }
__device__ __forceinline__ float xchg16(float x, int lane) { auto r = __builtin_amdgcn_permlane16_swap(__float_as_uint(x), __float_as_uint(x), false, false); return __uint_as_float((lane & 16) ? r[0] : r[1]); }
template <int CTRL> __device__ __forceinline__ float dppmov(float x) { return __uint_as_float(__builtin_amdgcn_update_dpp(0u, __float_as_uint(x), CTRL, 0xF, 0xF, false)); }
constexpr int DPP_ROR8 = 0x128, DPP_HMIRROR = 0x141, DPP_Q3210 = 0x1B, DPP_Q1032 = 0xB1;
__device__ __forceinline__ float wave_sum(float v) {
    const int lane = threadIdx.x & 63;
    v += xchg32(v, lane); v += xchg16(v, lane); v += dppmov<DPP_ROR8>(v); v += dppmov<DPP_HMIRROR>(v); v += dppmov<DPP_Q3210>(v); v += dppmov<DPP_Q1032>(v);
    return v;
}
__device__ __forceinline__ float sigmoidf_(float x) { return __builtin_amdgcn_rcpf(1.0f + __expf(-x)); }
__device__ __forceinline__ float siluf_(float x) { return x * __builtin_amdgcn_rcpf(1.0f + __expf(-x)); }

#define XB_TMO      128
#define XB_XCNT(j)  (256  + 64 * (j))
#define XB_XSUB(j)  (1280 + 64 * (j))
#define XB_XGEN(j)  (2304 + 64 * (j))
#define XB_TOP      3328
#define XB_TOPGEN   3392
#define XCD_BAR_WORDS 3456
#define XB_SPIN_CAP (1u << 20)
__device__ __forceinline__ unsigned xb_ld(unsigned* p)              { return __hip_atomic_load(p, __ATOMIC_RELAXED, __HIP_MEMORY_SCOPE_AGENT); }
__device__ __forceinline__ unsigned xb_add(unsigned* p, unsigned v) { return __hip_atomic_fetch_add(p, v, __ATOMIC_RELAXED, __HIP_MEMORY_SCOPE_AGENT); }
__device__ __forceinline__ unsigned xb_xcc_id() { return (unsigned)__builtin_amdgcn_s_getreg((3 << 11) | 20) & 0xFu; }
#define XB_SPIN(cond, bar) do { unsigned _sp = 0; while (cond) { __builtin_amdgcn_s_sleep(1); \
    if ((++_sp & 255u) == 0u) { if (xb_ld(&(bar)[XB_TMO])) break; if (_sp > XB_SPIN_CAP) { atomicAdd(&(bar)[XB_TMO], 1u); break; } } } } while (0)
struct XcdBarrier { unsigned* bar; unsigned x; volatile LAS unsigned* st; };
__device__ __forceinline__ XcdBarrier xcd_barrier_post(unsigned* bar, volatile LAS unsigned* st) {
    XcdBarrier b; b.bar = bar; b.x = xb_xcc_id(); b.st = st;
    if (threadIdx.x == 0) (void)xb_add(&bar[XB_XCNT(b.x)], 1u);
    return b;
}
__device__ __forceinline__ void xcd_barrier_complete(unsigned* bar, unsigned x, unsigned& nloc, unsigned& nx) {
    const unsigned G = gridDim.x * gridDim.y * gridDim.z;
    unsigned sum, cnt, mine, sp = 0u;
    for (;;) {
        sum = 0u; cnt = 0u; mine = 0u;
#pragma unroll
        for (unsigned j = 0; j < 16; ++j) { const unsigned c = xb_ld(&bar[XB_XCNT(j)]); sum += c; cnt += (c > 0u) ? 1u : 0u; mine = (j == x) ? c : mine; }
        if (sum == G) break;
        __builtin_amdgcn_s_sleep(1);
        if ((++sp & 255u) == 0u) { if (xb_ld(&bar[XB_TMO])) break; if (sp > XB_SPIN_CAP) { atomicAdd(&bar[XB_TMO], 1u); break; } }
    }
    nloc = mine > 0u ? mine : 1u; nx = cnt > 0u ? cnt : 1u;
}
__device__ __forceinline__ void xcd_barrier(const XcdBarrier& b) {
    asm volatile("s_waitcnt vmcnt(0)" ::: "memory");
    __syncthreads();
    if (threadIdx.x == 0) {
        unsigned* bar = b.bar;
        __builtin_amdgcn_s_waitcnt(0);
        unsigned nloc = b.st[0], nx = b.st[1];
        if (nloc == 0u) { xcd_barrier_complete(bar, b.x, nloc, nx); b.st[0] = nloc; b.st[1] = nx; }
        const unsigned old = xb_add(&bar[XB_XSUB(b.x)], 1u);
        const unsigned gen = old / nloc;
        if (old + 1u == (gen + 1u) * nloc) {
            __builtin_amdgcn_fence(__ATOMIC_RELEASE, "agent");
            asm volatile("s_waitcnt vmcnt(0)" ::: "memory");
            const unsigned og = xb_add(&bar[XB_TOP], 1u);
            const unsigned tg = og / nx;
            if (og + 1u == (tg + 1u) * nx) xb_add(&bar[XB_TOPGEN], 1u);
            else XB_SPIN(xb_ld(&bar[XB_TOPGEN]) == tg, bar);
            __builtin_amdgcn_fence(__ATOMIC_ACQUIRE, "agent");
            xb_add(&bar[XB_XGEN(b.x)], 1u);
            asm volatile("s_waitcnt vmcnt(0)" ::: "memory");
        } else {
            XB_SPIN(xb_ld(&bar[XB_XGEN(b.x)]) == gen, bar);
            __builtin_amdgcn_fence(__ATOMIC_ACQUIRE, "agent");
            asm volatile("s_waitcnt vmcnt(0)" ::: "memory");
        }
    }
    __syncthreads();
}

namespace pg8 {
constexpr int BM = 256, BK = 64, HALF = 128, HTB = HALF * BK * 2, STAGE_BYTES = 8 * HTB, NXCD = 8, WGM = 8;
__host__ __device__ __forceinline__ int lds_byte(int r, int c) { const int st = (r >> 4) * 2 + (c >> 5), rr = r & 15, cc = c & 31, ob = rr * 64 + cc * 2; return st * 1024 + (ob ^ (((ob >> 9) & 1) << 5)); }
__host__ __device__ __forceinline__ void stage_rc(int b, int& R, int& C) { const int st = b / 1024, sb = b % 1024, swz = sb ^ (((sb >> 9) & 1) << 5); R = (st >> 1) * 16 + swz / 64; C = (st & 1) * 32 + (swz % 64) / 2; }
__host__ __device__ __forceinline__ int perm32(int rho) { const int n = rho >> 4, i = rho & 15; return 8 * (i >> 2) + 4 * n + (i & 3); }
struct Unit { int pm, pn; };
struct Gemm { const bf16_t* A; const bf16_t* Bt; int M, N, K, lda, ldb; };
struct StaticOrder {
    int nM, nN, nwg, G, c, latent;
    __host__ __device__ void init(int M, int N, int G_, int c_, int latent_ = 0) { latent = latent_; nM = latent_ ? 64 : M / BM; nN = N / BM; nwg = nM * nN; G = G_; c = c_; }
    __host__ __device__ bool next(int i, Unit& u) const {
        const long L = (long)i * G + c; if (L >= nwg) return false;
        int wgid = (int)L; { const int q = nwg / NXCD, r = nwg % NXCD, xcd = wgid % NXCD, off = wgid / NXCD; wgid = (xcd < r ? xcd * (q + 1) : r * (q + 1) + (xcd - r) * q) + off; }
        const int nig = WGM * nN, gid = wgid / nig, fm = gid * WGM, gsz = (nM - fm) < WGM ? (nM - fm) : WGM;
        u.pm = fm + ((wgid % nig) % gsz); u.pn = (wgid % nig) / gsz; if (latent) u.pm += 1 + (u.pm >= 32 ? 1 : 0); return true;
    }
};
struct WinOrder {
    StaticOrder S; int full, nlat, G, c;
    __host__ __device__ void init(int G_, int c_, int full_) { full = full_; G = G_; c = c_; S.init(TT, NP, G_, c_, full_ ? 0 : 1); nlat = S.nwg; }
    __host__ __device__ bool next(int i, Unit& u) const {
        if (full) return S.next(i, u);
        const long L = (long)i * G + c;
        if (L < nlat) return S.next(i, u);
        const int q = (int)(L - nlat); if (q >= 24) return false;
        const int t = q % 12; u.pm = q < 12 ? 0 : 33;
        u.pn = t < 2 ? 4 + t : (t < 8 ? 8 + (t - 2) : (t == 8 ? 18 : 20 + (t - 9)));
        return true;
    }
};
struct EpiStoreBf16 {
    static constexpr bool PERM = true;
    bf16_t* O; int ldc;
    __device__ __forceinline__ void operator()(const f32x4 (&acc)[2][2][4][2], const Unit& u, int wr, int wc, int fr, int fq) const {
        const int row0 = u.pm * BM + wr * 64 + fr, col0 = u.pn * BM + wc * 32 + 8 * fq;
#pragma unroll
        for (int ai = 0; ai < 2; ++ai)
#pragma unroll
            for (int m = 0; m < 4; ++m) { bf16_t* rowp = O + (size_t)(row0 + ai * HALF + m * 16) * ldc + col0;
#pragma unroll
                for (int bj = 0; bj < 2; ++bj) { const f32x4 v0 = acc[ai][bj][m][0], v1 = acc[ai][bj][m][1];
                    u32x4 w; w.x = cvt_pk_bf16(v0[0], v0[1]); w.y = cvt_pk_bf16(v0[2], v0[3]); w.z = cvt_pk_bf16(v1[0], v1[1]); w.w = cvt_pk_bf16(v1[2], v1[3]);
                    *(u32x4*)(rowp + bj * HALF) = w; } }
    }
};
template <bool FIRST> struct EpiGate {
    static constexpr bool PERM = true;
    bf16_t* Y; int ldy; const bf16_t* Gt; int ldg;
    __device__ __forceinline__ void operator()(const f32x4 (&acc)[2][2][4][2], const Unit& u, int wr, int wc, int fr, int fq) const {
        const int row0 = u.pm * BM + wr * 64 + fr, col0 = u.pn * BM + wc * 32 + 8 * fq;
#pragma unroll
        for (int ai = 0; ai < 2; ++ai)
#pragma unroll
        for (int mh = 0; mh < 2; ++mh) {
            u32x4 g[2][2], y[2][2];
#pragma unroll
            for (int mm = 0; mm < 2; ++mm)
#pragma unroll
                for (int bj = 0; bj < 2; ++bj) { const size_t r = (size_t)(row0 + ai * HALF + (mh * 2 + mm) * 16);
                    g[mm][bj] = *(const u32x4*)(Gt + r * ldg + col0 + bj * HALF);
                    if (!FIRST) y[mm][bj] = *(const u32x4*)(Y + r * ldy + col0 + bj * HALF); }
#pragma unroll
            for (int mm = 0; mm < 2; ++mm)
#pragma unroll
                for (int bj = 0; bj < 2; ++bj) { const int m = mh * 2 + mm; const size_t r = (size_t)(row0 + ai * HALF + m * 16); const f32x4 v0 = acc[ai][bj][m][0], v1 = acc[ai][bj][m][1]; const u32x4 gg = g[mm][bj];
                    float o[8];
                    o[0] = sigmoidf_(bflo(gg.x)) * v0[0]; o[1] = sigmoidf_(bfhi(gg.x)) * v0[1]; o[2] = sigmoidf_(bflo(gg.y)) * v0[2]; o[3] = sigmoidf_(bfhi(gg.y)) * v0[3];
                    o[4] = sigmoidf_(bflo(gg.z)) * v1[0]; o[5] = sigmoidf_(bfhi(gg.z)) * v1[1]; o[6] = sigmoidf_(bflo(gg.w)) * v1[2]; o[7] = sigmoidf_(bfhi(gg.w)) * v1[3];
                    if (!FIRST) { const u32x4 yy = y[mm][bj];
                        o[0] += bflo(yy.x); o[1] += bfhi(yy.x); o[2] += bflo(yy.y); o[3] += bfhi(yy.y); o[4] += bflo(yy.z); o[5] += bfhi(yy.z); o[6] += bflo(yy.w); o[7] += bfhi(yy.w); }
                    u32x4 w; w.x = cvt_pk_bf16(o[0], o[1]); w.y = cvt_pk_bf16(o[2], o[3]); w.z = cvt_pk_bf16(o[4], o[5]); w.w = cvt_pk_bf16(o[6], o[7]);
                    *(u32x4*)(Y + r * ldy + col0 + bj * HALF) = w; }
        }
    }
};
struct EpiResid {
    static constexpr bool PERM = false;
    float* X; int ldx; const float* gate; float gscale;
    __device__ __forceinline__ void operator()(const f32x4 (&acc)[2][2][4][2], const Unit& u, int wr, int wc, int fr, int fq) const {
        const int row0 = u.pm * BM + wr * 64 + fr, col0 = u.pn * BM + wc * 32 + 4 * fq;
        const int sel = (u.pm % 33 == 0) ? 2 : (u.pm / 33);
        const float* gp = gate + (size_t)sel * 12288 + col0;
        f32x4 gv[2][2];
#pragma unroll
        for (int bj = 0; bj < 2; ++bj)
#pragma unroll
            for (int n = 0; n < 2; ++n) gv[bj][n] = *(const f32x4*)(gp + bj * HALF + n * 16) * gscale;
#pragma unroll
        for (int ai = 0; ai < 2; ++ai)
#pragma unroll
            for (int mh = 0; mh < 2; ++mh) {
                f32x4 x[2][2][2];
#pragma unroll
                for (int mm = 0; mm < 2; ++mm)
#pragma unroll
                    for (int bj = 0; bj < 2; ++bj)
#pragma unroll
                        for (int n = 0; n < 2; ++n) x[mm][bj][n] = *(const f32x4*)(X + (size_t)(row0 + ai * HALF + (mh * 2 + mm) * 16) * ldx + col0 + bj * HALF + n * 16);
#pragma unroll
                for (int mm = 0; mm < 2; ++mm)
#pragma unroll
                    for (int bj = 0; bj < 2; ++bj)
#pragma unroll
                        for (int n = 0; n < 2; ++n) *(f32x4*)(X + (size_t)(row0 + ai * HALF + (mh * 2 + mm) * 16) * ldx + col0 + bj * HALF + n * 16) = x[mm][bj][n] + gv[bj][n] * acc[ai][bj][mh * 2 + mm][n];
            }
    }
};

template <class Epi, class Sched>
__device__ __forceinline__ void gemm_phase(LAS unsigned char* lds, const int tid, const Gemm g, const Sched& S, const Epi& E) {
    const int wid = __builtin_amdgcn_readfirstlane(tid >> 6), lane = tid & 63, wr = wid >> 2, wc = wid & 3, fr = lane & 15, fq = lane >> 4;
    const int K = g.K, nt = K / BK, lda = g.lda, ldb = g.ldb;
    unsigned voffA[2], voffB[2];
#pragma unroll
    for (int i = 0; i < 2; ++i) { int R, C; stage_rc(tid * 16 + i * 8192, R, C); const int Rb = Epi::PERM ? ((R & ~31) + perm32(R & 31)) : R;
        voffA[i] = (unsigned)(R * lda + C) * 2u; voffB[i] = (unsigned)(Rb * ldb + C) * 2u; }
    const size_t kstep = (size_t)(BK * 2);
    const size_t hstepA = (size_t)HALF * lda * 2, hstepB = (size_t)HALF * ldb * 2;
    const size_t tstepA = 2 * hstepA, tstepB = 2 * hstepB;
    const unsigned ldsw = (unsigned)wid * 1024u;
    const int aoff = lds_byte(wr * 64 + fr, fq * 8), boff = lds_byte(wc * 32 + fr, fq * 8);
#define PG8_SA(b, h) (((b) * 2 + (h)) * HTB)
#define PG8_SB(b, h) ((4 + (b) * 2 + (h)) * HTB)
#define PG8_STAGE(bufoff, gbase, voff) do { _Pragma("unroll") for (int _i = 0; _i < 2; ++_i) \
        __builtin_amdgcn_global_load_lds((const unsigned*)((const char*)(gbase) + (voff)[_i]), (LAS unsigned*)(lds + (bufoff) + ldsw + _i * 8192), 16, 0, 0); } while (0)
#define PG8_LDA(dst, b, h) do { _Pragma("unroll") for (int m = 0; m < 4; ++m) _Pragma("unroll") for (int k = 0; k < 2; ++k) dst[m][k] = *(const LAS bf16x8*)(lds + PG8_SA(b, h) + aoff + m * 2048 + k * 1024); } while (0)
#define PG8_LDB(dst, b, h) do { _Pragma("unroll") for (int n = 0; n < 2; ++n) _Pragma("unroll") for (int k = 0; k < 2; ++k) dst[n][k] = *(const LAS bf16x8*)(lds + PG8_SB(b, h) + boff + n * 2048 + k * 1024); } while (0)
#define PG8_MMA(ai, bj, At, Bt) do { __builtin_amdgcn_s_setprio(1); _Pragma("unroll") for (int m = 0; m < 4; ++m) _Pragma("unroll") for (int n = 0; n < 2; ++n) _Pragma("unroll") for (int k = 0; k < 2; ++k) \
        acc[ai][bj][m][n] = __builtin_amdgcn_mfma_f32_16x16x32_bf16(Bt[n][k], At[m][k], acc[ai][bj][m][n], 0, 0, 0); __builtin_amdgcn_s_setprio(0); } while (0)
#define PG8_WAIT_V(n) asm volatile("s_waitcnt vmcnt(" #n ")" ::: "memory")
#define PG8_WAIT_L(n) asm volatile("s_waitcnt lgkmcnt(" #n ")" ::: "memory")
#define PG8_BAR __builtin_amdgcn_s_barrier()
#define PG8_SCHED __builtin_amdgcn_sched_barrier(0)
    Unit cur, nxt; int ui = 0;
    if (!S.next(0, cur)) return;
    f32x4 acc[2][2][4][2];
#pragma unroll
    for (int a = 0; a < 2; ++a)
#pragma unroll
        for (int b = 0; b < 2; ++b)
#pragma unroll
            for (int m = 0; m < 4; ++m)
#pragma unroll
                for (int n = 0; n < 2; ++n) acc[a][b][m][n] = (f32x4){0.f, 0.f, 0.f, 0.f};
    bf16x8 At[4][2], B0[2][2], B1[2][2];
    const char* cA = (const char*)g.A + (size_t)cur.pm * tstepA; const char* cB = (const char*)g.Bt + (size_t)cur.pn * tstepB;
    PG8_STAGE(PG8_SB(0, 0), cB, voffB); PG8_STAGE(PG8_SA(0, 0), cA, voffA); PG8_STAGE(PG8_SB(0, 1), cB + hstepB, voffB); PG8_STAGE(PG8_SA(0, 1), cA + hstepA, voffA);
    if (wr == 1) PG8_BAR;
    PG8_WAIT_V(4); PG8_BAR;
    PG8_STAGE(PG8_SB(1, 0), cB + kstep, voffB); PG8_STAGE(PG8_SA(1, 0), cA + kstep, voffA); PG8_STAGE(PG8_SB(1, 1), cB + hstepB + kstep, voffB);
    PG8_WAIT_V(6); PG8_BAR;
    for (;;) {
        const bool has_next = S.next(ui + 1, nxt);
        const char* nA = has_next ? (const char*)g.A + (size_t)nxt.pm * tstepA : cA; const char* nB = has_next ? (const char*)g.Bt + (size_t)nxt.pn * tstepB : cB;
        for (int t = 0; t < nt; t += 2) {
            const bool last = (t == nt - 2);
            const char* a1 = cA + (size_t)(t + 1) * kstep;
            const char* a2 = last ? nA : cA + (size_t)(t + 2) * kstep; const char* b2 = last ? nB : cB + (size_t)(t + 2) * kstep;
            const char* a3 = a2 + kstep; const char* b3 = b2 + kstep;
            PG8_LDB(B0, 0, 0); PG8_SCHED; PG8_LDA(At, 0, 0); PG8_STAGE(PG8_SA(1, 1), a1 + hstepA, voffA);
            PG8_WAIT_L(8); PG8_BAR; PG8_WAIT_L(0); PG8_MMA(0, 0, At, B0); PG8_BAR; PG8_SCHED;
            PG8_LDB(B1, 0, 1); PG8_STAGE(PG8_SB(0, 0), b2, voffB);
            PG8_BAR; PG8_WAIT_L(0); PG8_MMA(0, 1, At, B1); PG8_BAR;
            PG8_LDA(At, 0, 1); PG8_STAGE(PG8_SA(0, 0), a2, voffA);
            PG8_BAR; PG8_WAIT_L(0); PG8_MMA(1, 0, At, B0); PG8_BAR; PG8_SCHED;
            PG8_STAGE(PG8_SB(0, 1), b2 + hstepB, voffB);
            PG8_WAIT_V(6); PG8_BAR; PG8_MMA(1, 1, At, B1); PG8_BAR;
            PG8_LDB(B0, 1, 0); PG8_SCHED; PG8_LDA(At, 1, 0); PG8_STAGE(PG8_SA(0, 1), a2 + hstepA, voffA);
            PG8_WAIT_L(8); PG8_BAR; PG8_WAIT_L(0); PG8_MMA(0, 0, At, B0); PG8_BAR; PG8_SCHED;
            PG8_LDB(B1, 1, 1); PG8_STAGE(PG8_SB(1, 0), b3, voffB);
            PG8_BAR; PG8_WAIT_L(0); PG8_MMA(0, 1, At, B1); PG8_BAR;
            PG8_LDA(At, 1, 1); PG8_STAGE(PG8_SA(1, 0), a3, voffA);
            PG8_BAR; PG8_WAIT_L(0); PG8_MMA(1, 0, At, B0); PG8_BAR; PG8_SCHED;
            PG8_STAGE(PG8_SB(1, 1), b3 + hstepB, voffB);
            PG8_WAIT_V(6); PG8_BAR; PG8_MMA(1, 1, At, B1); PG8_BAR;
        }
        E(acc, cur, wr, wc, fr, fq);
        if (!has_next) break;
#pragma unroll
        for (int a = 0; a < 2; ++a)
#pragma unroll
            for (int b = 0; b < 2; ++b)
#pragma unroll
                for (int m = 0; m < 4; ++m)
#pragma unroll
                    for (int n = 0; n < 2; ++n) acc[a][b][m][n] = (f32x4){0.f, 0.f, 0.f, 0.f};
        cur = nxt; cA = nA; cB = nB; ++ui;
    }
    PG8_WAIT_V(0);
    if (wr == 0) PG8_BAR;
    PG8_BAR;
#undef PG8_SA
#undef PG8_SB
#undef PG8_STAGE
#undef PG8_LDA
#undef PG8_LDB
#undef PG8_MMA
#undef PG8_WAIT_V
#undef PG8_WAIT_L
#undef PG8_BAR
#undef PG8_SCHED
}
}

struct Args { const float* in[30]; float* out; unsigned char* ws; int ph_lo, ph_hi; };
enum { I_X = 0, I_C, I_CTX, I_CCTX, I_WMOD, I_BMOD, I_N1G, I_WIN, I_QNG, I_KNG, I_WA2F, I_BAF, I_WA2B, I_BAB, I_ONG, I_MQNG, I_WUQ, I_MKVNG, I_WUKV,
       I_WBRA, I_WBRL, I_WBRM, I_WOUT, I_N2G, I_PWQ, I_PK1, I_PK2, I_PU, I_PV, I_FG };
typedef const float* cfp_t;
struct Ctx {
    const __attribute__((address_space(4))) cfp_t* in; float* out; unsigned char* ws; LAS unsigned char* lds;
    int tid, lane, wid, G, bid;
};
#define WSP(T, off) ((T*)(C.ws + (off)))
#define INP(i) ((const float*)(const GLB float*)C.in[(i)])
__device__ __forceinline__ unsigned long long launder_u64(unsigned long long w) {
    unsigned lo = (unsigned)w, hi = (unsigned)(w >> 32); asm volatile("" : "+v"(lo), "+v"(hi));
    lo = __builtin_amdgcn_readfirstlane(lo); hi = __builtin_amdgcn_readfirstlane(hi); return ((unsigned long long)hi << 32) | lo;
}
__device__ __forceinline__ Ctx launder(const Ctx& C0) {
    Ctx R = C0; int t = C0.tid; asm volatile("" : "+v"(t)); R.tid = t; R.lane = t & 63; R.wid = __builtin_amdgcn_readfirstlane(t >> 6);
    R.ws = (unsigned char*)(GLB unsigned char*)launder_u64((unsigned long long)C0.ws);
    R.out = (float*)(GLB float*)(unsigned long long)C0.out;
    R.in = (const __attribute__((address_space(4))) cfp_t*)launder_u64((unsigned long long)C0.in);
    unsigned l = (unsigned)(uintptr_t)C0.lds; asm volatile("" : "+v"(l)); l = __builtin_amdgcn_readfirstlane(l); R.lds = (LAS unsigned char*)(uintptr_t)l;
    return R;
}

__device__ __forceinline__ const float* src_row(const Ctx& C, int r) {
    const int b = r / RPB, j = r % RPB;
    return j < CTXL ? INP(I_CTX) + ((size_t)b * CTXL + j) * DM : INP(I_X) + ((size_t)b * SEQ + (j - CTXL)) * DM;
}
__device__ __forceinline__ int mod_sel(int r) { const int b = r / RPB, j = r % RPB; return j < CTXL ? 2 : b; }

__device__ __forceinline__ void phase_modv(const Ctx& C) {
    LAS float* sc = (LAS float*)C.lds;
    LAS float* red = (LAS float*)(C.lds + 3 * 2048 * 4);
    for (int i = C.tid; i < 3 * DM; i += NTHREADS) { const int r = i / DM, k = i % DM; const float v = r < 2 ? INP(I_C)[r * DM + k] : INP(I_CCTX)[k]; sc[i] = siluf_(v); }
    __syncthreads();
    float* modv = WSP(float, WS_MODV);
    const int kq = C.tid / 12, c4 = C.tid % 12;
    for (int item = C.bid; item < 2 * 256; item += C.G) {
        const int l = item / 256, cg = item % 256;
        float acc[3][4];
#pragma unroll
        for (int r = 0; r < 3; ++r)
#pragma unroll
            for (int j = 0; j < 4; ++j) acc[r][j] = 0.f;
        if (kq < 42) {
            const float* wp = INP(I_WMOD) + (size_t)l * DM * 12288 + 48 * cg + 4 * c4;
#pragma unroll 1
            for (int k0 = kq; k0 < DM; k0 += 42 * 7) {
                f32x4 w[7];
#pragma unroll
                for (int u = 0; u < 7; ++u) { const int k = k0 + 42 * u; w[u] = k < DM ? *(const f32x4*)(wp + (size_t)k * 12288) : (f32x4){0.f, 0.f, 0.f, 0.f}; }
#pragma unroll
                for (int u = 0; u < 7; ++u) { const int k = k0 + 42 * u; if (k < DM) {
#pragma unroll
                    for (int r = 0; r < 3; ++r) { const float sv = sc[r * DM + k];
#pragma unroll
                        for (int j = 0; j < 4; ++j) acc[r][j] += sv * w[u][j]; } } }
            }
#pragma unroll
            for (int r = 0; r < 3; ++r)
#pragma unroll
                for (int j = 0; j < 4; ++j) red[kq * 144 + r * 48 + c4 * 4 + j] = acc[r][j];
        }
        __syncthreads();
        if (C.tid < 144) { float s = 0.f; for (int q = 0; q < 42; ++q) s += red[q * 144 + C.tid];
            const int r = C.tid / 48, cc = C.tid % 48;
            modv[((size_t)l * 3 + r) * 12288 + 48 * cg + cc] = s + INP(I_BMOD)[(size_t)l * 12288 + 48 * cg + cc]; }
        __syncthreads();
    }
}
__device__ __forceinline__ void phase_tables(const Ctx& C) {
    float* ta = WSP(float, WS_TABA); float* tm = WSP(float, WS_TABM);
    for (int i = C.bid * NTHREADS + C.tid; i < 128 * 32 + 128 * 16; i += C.G * NTHREADS) {
        if (i < 128 * 32) { const int pos = i / 32, f = i % 32; const float inv = exp2f(-(float)f * (13.287712379549449f / 32.0f)); const float a = (float)pos * inv;
            ta[i] = cosf(a); ta[128 * 32 + i] = sinf(a); }
        else { const int k = i - 128 * 32, pos = k / 16, f = k % 16; const float inv = exp2f(-(float)f * (13.287712379549449f / 16.0f)); const float a = (float)pos * inv;
            tm[k] = cosf(a); tm[128 * 16 + k] = sinf(a); }
    }
}
__device__ __forceinline__ void transpose_cvt(const Ctx& C, const float* src, int K, int N, bf16_t* dst, int Npad, int& item) {
    LAS float* tile = (LAS float*)C.lds;
    const int tk = K / 64, tn = Npad / 256, ntile = tk * tn;
    const int t0 = ((C.bid - item % C.G) + C.G) % C.G; item += ntile;
    for (int t = t0; t < ntile; t += C.G) {
        const int k0 = (t / tn) * 64, n0 = (t % tn) * 256;
        const int nn = (C.tid & 63) * 4, kr = C.tid >> 6;
        f32x4 v[8];
#pragma unroll
        for (int p = 0; p < 8; ++p) { v[p] = (f32x4){0.f, 0.f, 0.f, 0.f}; if (n0 + nn < N) v[p] = *(const f32x4*)(src + (size_t)(k0 + kr + p * 8) * N + n0 + nn); }
#pragma unroll
        for (int p = 0; p < 8; ++p)
#pragma unroll
            for (int j = 0; j < 4; ++j) tile[(kr + p * 8) * 257 + nn + j] = v[p][j];
        __syncthreads();
        { const int n = C.tid >> 1, kh = (C.tid & 1) * 32;
#pragma unroll
          for (int q = 0; q < 4; ++q) { float x[8];
#pragma unroll
              for (int j = 0; j < 8; ++j) x[j] = tile[(kh + q * 8 + j) * 257 + n];
              u32x4 w; w.x = cvt_pk_bf16(x[0], x[1]); w.y = cvt_pk_bf16(x[2], x[3]); w.z = cvt_pk_bf16(x[4], x[5]); w.w = cvt_pk_bf16(x[6], x[7]);
              *(u32x4*)(dst + (size_t)(n0 + n) * K + k0 + kh + q * 8) = w; } }
        __syncthreads();
    }
}
__device__ __forceinline__ void cvt_plain(const Ctx& C, const float* src, bf16_t* dst, size_t n8) {
    for (size_t i = (size_t)C.bid * NTHREADS + C.tid; i < n8; i += (size_t)C.G * NTHREADS) {
        const f32x4 a = *(const f32x4*)(src + i * 8), b = *(const f32x4*)(src + i * 8 + 4);
        u32x4 w; w.x = cvt_pk_bf16(a[0], a[1]); w.y = cvt_pk_bf16(a[2], a[3]); w.z = cvt_pk_bf16(b[0], b[1]); w.w = cvt_pk_bf16(b[2], b[3]);
        *(u32x4*)(dst + i * 8) = w;
    }
}
__device__ __forceinline__ void phase_cvt_mixer_weights(const Ctx& C, int l) {
    int item = 0;
    transpose_cvt(C, INP(I_WIN) + (size_t)l * DM * IN_COLS, DM, IN_COLS, WSP(bf16_t, WS_WIN), NP, item);
    transpose_cvt(C, INP(I_WUQ) + (size_t)l * 512 * 1536, 512, 1536, WSP(bf16_t, WS_WUQ), 1536, item);
    transpose_cvt(C, INP(I_WUKV) + (size_t)l * 512 * 2048, 512, 2048, WSP(bf16_t, WS_WUKV), 2048, item);
    transpose_cvt(C, INP(I_WBRA) + (size_t)l * 1024 * 2048, 1024, 2048, WSP(bf16_t, WS_WBR), 2048, item);
    transpose_cvt(C, INP(I_WBRL) + (size_t)l * 1024 * 2048, 1024, 2048, WSP(bf16_t, WS_WBR) + (size_t)2048 * 1024, 2048, item);
    transpose_cvt(C, INP(I_WBRM) + (size_t)l * 1024 * 2048, 1024, 2048, WSP(bf16_t, WS_WBR) + (size_t)2 * 2048 * 1024, 2048, item);
    transpose_cvt(C, INP(I_WOUT) + (size_t)l * 2048 * 2048, 2048, 2048, WSP(bf16_t, WS_WOUT), 2048, item);
    transpose_cvt(C, INP(I_PWQ) + (size_t)l * 2048 * 2048, 2048, 2048, WSP(bf16_t, WS_WQ), 2048, item);
    cvt_plain(C, INP(I_PK1) + (size_t)l * 8 * 128 * 128, WSP(bf16_t, WS_K1), 8 * 128 * 128 / 8);
    cvt_plain(C, INP(I_PK2) + (size_t)l * 8 * 128 * 128, WSP(bf16_t, WS_K2), 8 * 128 * 128 / 8);
}
__device__ __forceinline__ void phase_cvt_peer_tables(const Ctx& C, int l) {
    const int lane = C.lane;
    for (int row = C.bid * 8 + C.wid; row < NEXP; row += C.G * 8) {
#pragma unroll 1
        for (int tb = 0; tb < 2; ++tb) {
            const float* src = (tb ? INP(I_PV) : INP(I_PU)) + ((size_t)l * NEXP + row) * DM + lane * 16;
            f32x4 x[8]; float amax = 0.f;
#pragma unroll
            for (int c = 0; c < 2; ++c)
#pragma unroll
                for (int q = 0; q < 4; ++q) { x[c * 4 + q] = *(const f32x4*)(src + c * 1024 + q * 4);
                    amax = fmaxf(amax, fmaxf(fmaxf(fabsf(x[c * 4 + q][0]), fabsf(x[c * 4 + q][1])), fmaxf(fabsf(x[c * 4 + q][2]), fabsf(x[c * 4 + q][3])))); }
#pragma unroll
            for (int o = 0; o < 1; ++o) { amax = fmaxf(amax, xchg32(amax, lane)); amax = fmaxf(amax, xchg16(amax, lane)); amax = fmaxf(amax, dppmov<DPP_ROR8>(amax));
                amax = fmaxf(amax, dppmov<DPP_HMIRROR>(amax)); amax = fmaxf(amax, dppmov<DPP_Q3210>(amax)); amax = fmaxf(amax, dppmov<DPP_Q1032>(amax)); }
            const float sc = amax > 0.f ? 224.0f / amax : 1.0f, inv = amax > 0.f ? amax * (1.0f / 224.0f) : 1.0f;
            unsigned char* dst = C.ws + (tb ? WS_V8 : WS_U8) + (size_t)(lane >> 3) * ((size_t)NEXP * 128) + (size_t)row * 128 + (lane & 7) * 16;
#pragma unroll
            for (int c = 0; c < 2; ++c) { u32x4 w;
#pragma unroll
                for (int q = 0; q < 4; ++q) { const f32x4 v = x[c * 4 + q] * sc; int p = __builtin_amdgcn_cvt_pk_fp8_f32(v[0], v[1], 0, false); p = __builtin_amdgcn_cvt_pk_fp8_f32(v[2], v[3], p, true); w[q] = (unsigned)p; }
                *(u32x4*)(dst + (size_t)c * 8 * ((size_t)NEXP * 128)) = w; }
            if (lane == 0) WSP(float, tb ? WS_SCV : WS_SCU)[row] = inv;
        }
    }
}

template <bool FIRST> __device__ __forceinline__ void phase_norm_mod(const Ctx& C, const float* gvec, const float* modl  , int shift_off, int scale_off) {
    float* xs = WSP(float, WS_XS); bf16_t* hb = WSP(bf16_t, WS_HB);
    for (int r = C.bid * 8 + C.wid; r < TT; r += C.G * 8) {
        const float* xr = FIRST ? src_row(C, r) : xs + (size_t)r * DM;
        const float* mv = modl + (size_t)mod_sel(r) * 12288;
        f32x4 v[8]; float ss = 0.f;
#pragma unroll
        for (int c = 0; c < 4; ++c) { v[2 * c] = *(const f32x4*)(xr + c * 512 + C.lane * 8); v[2 * c + 1] = *(const f32x4*)(xr + c * 512 + C.lane * 8 + 4); }
#pragma unroll
        for (int c = 0; c < 8; ++c) ss += v[c][0] * v[c][0] + v[c][1] * v[c][1] + v[c][2] * v[c][2] + v[c][3] * v[c][3];
        ss = wave_sum(ss);
        const float rs = rsqrtf(ss * (1.0f / DM) + NORM_EPS);
#pragma unroll
        for (int c = 0; c < 4; ++c) { const int col = c * 512 + C.lane * 8;
            if (FIRST) { *(f32x4*)(xs + (size_t)r * DM + col) = v[2 * c]; *(f32x4*)(xs + (size_t)r * DM + col + 4) = v[2 * c + 1]; }
            float o[8];
#pragma unroll
            for (int h = 0; h < 2; ++h) { const f32x4 g = *(const f32x4*)(gvec + col + 4 * h), s = *(const f32x4*)(mv + scale_off + col + 4 * h), t = *(const f32x4*)(mv + shift_off + col + 4 * h);
#pragma unroll
                for (int j = 0; j < 4; ++j) o[4 * h + j] = v[2 * c + h][j] * rs * g[j] * (1.0f + s[j]) + t[j]; }
            u32x4 w; w.x = cvt_pk_bf16(o[0], o[1]); w.y = cvt_pk_bf16(o[2], o[3]); w.z = cvt_pk_bf16(o[4], o[5]); w.w = cvt_pk_bf16(o[6], o[7]);
            *(u32x4*)(hb + (size_t)r * DM + col) = w; }
    }
}

__device__ __forceinline__ void phase_post_p(const Ctx& C, int l) {
    bf16_t* P = WSP(bf16_t, WS_P); const float* ta = WSP(float, WS_TABA); const float* tm = WSP(float, WS_TABM);
    const float* qg = INP(I_QNG) + l * 128; const float* kg = INP(I_KNG) + l * 128;
    const float* mqg = INP(I_MQNG) + l * 512; const float* mkvg = INP(I_MKVNG) + l * 512;
    const int lane = C.lane;
    const float qg1 = qg[lane], qg2 = qg[lane + 64], kg1 = kg[lane], kg2 = kg[lane + 64];
    for (int r = C.bid * 8 + C.wid; r < TT; r += C.G * 8) {
        bf16_t* pr = P + (size_t)r * NP;
        const int j = r % RPB; const bool lat = j >= CTXL; const int pos = lat ? j - CTXL : 0, ri = pos >> 6, ci = pos & 63;
        float cs = 1.f, sn = 0.f;
        if (lat) { const int p = lane < 32 ? ri : ci, f = lane & 31; cs = ta[p * 32 + f]; sn = ta[128 * 32 + p * 32 + f]; }
#pragma unroll
        for (int h = 0; h < 10; ++h) {
            bf16_t* hp = pr + (h < 8 ? C_AQ + h * 128 : C_AK + (h - 8) * 128);
            const float x1 = bf2f(hp[lane]), x2 = bf2f(hp[lane + 64]);
            const float ss = wave_sum(x1 * x1 + x2 * x2);
            const float rs = rsqrtf(ss * (1.0f / 128.0f) + NORM_EPS);
            const float y1 = x1 * rs * (h < 8 ? qg1 : kg1), y2 = x2 * rs * (h < 8 ? qg2 : kg2);
            hp[lane] = f2bf(y1 * cs - y2 * sn); hp[lane + 64] = f2bf(y2 * cs + y1 * sn);
        }
#pragma unroll
        for (int s = 0; s < 2; ++s) {
            bf16_t* sp = pr + (s == 0 ? C_MCQ : C_MCKV) + lane * 8; const float* gg = (s == 0 ? mqg : mkvg) + lane * 8;
            const u32x4 w = *(const u32x4*)sp; float x[8] = {bflo(w.x), bfhi(w.x), bflo(w.y), bfhi(w.y), bflo(w.z), bfhi(w.z), bflo(w.w), bfhi(w.w)};
            float ss = 0.f;
#pragma unroll
            for (int i = 0; i < 8; ++i) ss += x[i] * x[i];
            ss = wave_sum(ss);
            const float rs = rsqrtf(ss * (1.0f / 512.0f) + NORM_EPS);
#pragma unroll
            for (int i = 0; i < 8; ++i) x[i] = x[i] * rs * gg[i];
            u32x4 o; o.x = cvt_pk_bf16(x[0], x[1]); o.y = cvt_pk_bf16(x[2], x[3]); o.z = cvt_pk_bf16(x[4], x[5]); o.w = cvt_pk_bf16(x[6], x[7]);
            *(u32x4*)sp = o;
        }
        if (lat) { bf16_t* kp = pr + C_MKR; const int i = lane & 31; const float x1 = bf2f(kp[i]), x2 = bf2f(kp[i + 32]);
            const int p = i < 16 ? ri : ci, f = i & 15; const float c2 = tm[p * 16 + f], s2 = tm[128 * 16 + p * 16 + f];
            if (lane < 32) { kp[i] = f2bf(x1 * c2 - x2 * s2); kp[i + 32] = f2bf(x2 * c2 + x1 * s2); } }
    }
}

namespace att {
constexpr int NW = 8, QBLK = 32, KVBLK = 64, DV = 128;
constexpr float THR = 8.f;
#define SBAR() __builtin_amdgcn_sched_barrier(0)
__device__ __forceinline__ int crow(int r, int hi) { return (r & 3) + 8 * (r >> 2) + 4 * hi; }
template <int DQ> struct Cf {
    static constexpr int ND0 = DQ / 16, KROWB = DQ * 2, SHM_K = KVBLK * DQ * 2, SHM_V = KVBLK * DV * 2, SHM = 2 * SHM_V + 2 * SHM_K + NW * 64 * 4;
    static constexpr float SCALE = DQ == 128 ? 0.088388347648318440f : 0.072168783648703220f;
    __device__ static __forceinline__ int kswz(int row, int colB) { return row * KROWB + (colB ^ ((row & 7) << 4)); }
};
template <int DQ> __device__ __forceinline__ void partialSM(f32x16& p0, f32x16& p1, float& m_reg, float& mn, float& alpha) {
    constexpr float SC = Cf<DQ>::SCALE, Cc = SC * 1.4426950408889634f;
    float pmax = p0[0];
#pragma unroll
    for (int r = 1; r < 16; ++r) pmax = fmaxf(pmax, p0[r]);
#pragma unroll
    for (int r = 0; r < 16; ++r) pmax = fmaxf(pmax, p1[r]);
    { auto rr = __builtin_amdgcn_permlane32_swap(__float_as_uint(pmax), __float_as_uint(pmax), false, false);
      pmax = fmaxf(__uint_as_float(rr[0]), __uint_as_float(rr[1])); }
    if (__builtin_expect(__all(pmax - m_reg <= THR / SC), 1)) { mn = m_reg; alpha = 1.f; }
    else { mn = fmaxf(m_reg, pmax); alpha = __builtin_amdgcn_exp2f((m_reg - mn) * Cc); m_reg = mn; }
    const float mnC = -mn * Cc;
#pragma unroll
    for (int r = 0; r < 16; ++r) p0[r] = fmaf(p0[r], Cc, mnC);
#pragma unroll
    for (int r = 0; r < 16; ++r) p1[r] = fmaf(p1[r], Cc, mnC);
#pragma unroll
    for (int r = 0; r < 16; ++r) p0[r] = __builtin_amdgcn_exp2f(p0[r]);
}
__device__ __forceinline__ void finishSM(f32x16& p0, f32x16& p1, float alpha, float& l_reg, bf16x8& pa0, bf16x8& pa1, bf16x8& pa2, bf16x8& pa3) {
#pragma unroll
    for (int r = 0; r < 16; ++r) p1[r] = __builtin_amdgcn_exp2f(p1[r]);
    float ps = 0;
#pragma unroll
    for (int r = 0; r < 16; ++r) ps += p0[r];
#pragma unroll
    for (int r = 0; r < 16; ++r) ps += p1[r];
    { auto rr = __builtin_amdgcn_permlane32_swap(__float_as_uint(ps), __float_as_uint(ps), false, false);
      ps = __uint_as_float(rr[0]) + __uint_as_float(rr[1]); }
    l_reg = l_reg * alpha + ps;
#define PK4(P, BASE, OUT) do { unsigned a0 = cvt_pk_bf16(P[BASE + 0], P[BASE + 1]), a1 = cvt_pk_bf16(P[BASE + 2], P[BASE + 3]);   \
    unsigned b0 = cvt_pk_bf16(P[BASE + 4], P[BASE + 5]), b1 = cvt_pk_bf16(P[BASE + 6], P[BASE + 7]);                              \
    auto r0 = __builtin_amdgcn_permlane32_swap(a0, b0, false, false); auto r1 = __builtin_amdgcn_permlane32_swap(a1, b1, false, false); \
    u32x4 w = {r0[0], r1[0], r0[1], r1[1]}; OUT = *reinterpret_cast<bf16x8*>(&w); } while (0)
    PK4(p0, 0, pa0); PK4(p0, 8, pa1); PK4(p1, 0, pa2); PK4(p1, 8, pa3);
#undef PK4
}
template <int DQ> __device__ __forceinline__ void qkt(f32x16& p0, f32x16& p1, const char* Ks, const bf16x8* qr, const char* qx, int r32, int hi) {
    p0 = f32x16{}; p1 = f32x16{};
#pragma unroll
    for (int d0 = 0; d0 < Cf<DQ>::ND0; ++d0) { const int cb = (d0 * 16 + hi * 8) * 2;
        const bf16x8 b0 = *reinterpret_cast<const bf16x8*>(Ks + Cf<DQ>::kswz(r32, cb));
        const bf16x8 b1 = *reinterpret_cast<const bf16x8*>(Ks + Cf<DQ>::kswz(32 + r32, cb));
        constexpr int NQR = DQ == 192 ? 4 : 8;
        bf16x8 q; if (d0 < NQR) q = qr[d0]; else q = *reinterpret_cast<const bf16x8*>(qx + (d0 - NQR) * 1024);
        p0 = __builtin_amdgcn_mfma_f32_32x32x16_bf16(b0, q, p0, 0, 0, 0);
        p1 = __builtin_amdgcn_mfma_f32_32x32x16_bf16(b1, q, p1, 0, 0, 0); }
}
__device__ __forceinline__ int v_st(int k, int c) { const int kk = (k & ~0xC) | ((k & 4) << 1) | ((k & 8) >> 1); return ((kk >> 3) * 4 + (c >> 5)) * 512 + ((kk & 7) * 32 + (c & 31)) * 2; }
__device__ __forceinline__ int v_rd_base(int lane) { return ((lane & 3) << 3) | (((lane >> 2) & 3) << 6) | (((lane >> 4) & 1) << 5) | (((lane >> 5) & 1) << 8); }
constexpr int v_rd_off(int d0, int ks, int half) { return d0 * 512 + ks * 4096 + half * 2048; }
template <int OFF> __device__ __forceinline__ s16x4 tr_read(int vb) {
    s16x4 r; asm volatile("ds_read_b64_tr_b16 %0, %1 offset:%2" : "=&v"(r) : "v"(vb), "i"(OFF) : "memory"); return r;
}
template <int D0> __device__ __forceinline__ void pv_one(f32x16& od, int vb, bf16x8 pa0, bf16x8 pa1, bf16x8 pa2, bf16x8 pa3) {
    const s16x4 l0 = tr_read<v_rd_off(D0, 0, 0)>(vb), h0 = tr_read<v_rd_off(D0, 0, 1)>(vb), l1 = tr_read<v_rd_off(D0, 1, 0)>(vb), h1 = tr_read<v_rd_off(D0, 1, 1)>(vb);
    const s16x4 l2 = tr_read<v_rd_off(D0, 2, 0)>(vb), h2 = tr_read<v_rd_off(D0, 2, 1)>(vb), l3 = tr_read<v_rd_off(D0, 3, 0)>(vb), h3 = tr_read<v_rd_off(D0, 3, 1)>(vb);
    asm volatile("s_waitcnt lgkmcnt(0)" ::: "memory"); SBAR();
#define PK(L, H) (bf16x8){L[0], L[1], L[2], L[3], H[0], H[1], H[2], H[3]}
    od = __builtin_amdgcn_mfma_f32_32x32x16_bf16(pa0, PK(l0, h0), od, 0, 0, 0);
    od = __builtin_amdgcn_mfma_f32_32x32x16_bf16(pa1, PK(l1, h1), od, 0, 0, 0);
    od = __builtin_amdgcn_mfma_f32_32x32x16_bf16(pa2, PK(l2, h2), od, 0, 0, 0);
    od = __builtin_amdgcn_mfma_f32_32x32x16_bf16(pa3, PK(l3, h3), od, 0, 0, 0);
#undef PK
}
__device__ __forceinline__ void pv_d0(f32x16* o, int vb, bf16x8 pa0, bf16x8 pa1, bf16x8 pa2, bf16x8 pa3) {
    pv_one<0>(o[0], vb, pa0, pa1, pa2, pa3); pv_one<1>(o[1], vb, pa0, pa1, pa2, pa3); pv_one<2>(o[2], vb, pa0, pa1, pa2, pa3); pv_one<3>(o[3], vb, pa0, pa1, pa2, pa3);
}
__device__ __forceinline__ bf16x8 ld8(const bf16_t* p) { return *reinterpret_cast<const bf16x8*>(p); }

template <int DQ, int SD>
__device__ __forceinline__ void attn_body(const bf16_t* __restrict__ Qb, int ldq, const bf16_t* __restrict__ Kn, int ldkn, const bf16_t* __restrict__ Kr, int ldkr,
                                          const bf16_t* __restrict__ Vh, int ldv, bf16_t* __restrict__ Ob, int ldo, int seq, bool rope_q, int pos0, const float* __restrict__ tabM, char* lds, const int tid) {
    using CF = Cf<DQ>; constexpr int ND0 = CF::ND0, SHM_V = CF::SHM_V, SHM_K = CF::SHM_K;
    const int wid = tid >> 6, lane = tid & 63, r32 = lane & 31, hi = lane >> 5;
    char* V_lds = lds; char* K_lds = lds + 2 * SHM_V;
    float* ws = (float*)(lds + 2 * SHM_V + 2 * SHM_K) + wid * 64; float* li_l = ws; float* al_l = ws + 32;
    constexpr int NQR = DQ == 192 ? 4 : 8;
    float m_reg = -1e30f, l_reg = 0; f32x16 o[4] = {}; bf16x8 qr[NQR];
    const bf16_t* Qw = Qb + (long)(wid * QBLK + r32) * ldq + hi * 8;
#pragma unroll
    for (int d0 = 0; d0 < NQR; ++d0) qr[d0] = ld8(Qw + d0 * 16);
    char* qx = lds + CF::SHM + wid * 8192 + lane * 16;
    if constexpr (DQ == 192) {
#pragma unroll
        for (int d0 = 4; d0 < 8; ++d0) *(bf16x8*)(qx + (d0 - 4) * 1024) = ld8(Qw + d0 * 16);
        bf16x8 qe[4];
#pragma unroll
        for (int d0 = 0; d0 < 4; ++d0) qe[d0] = ld8(Qw + (8 + d0) * 16);
        if (rope_q) {
            const int pos = pos0 + wid * QBLK + r32, ri = pos >> 6, ci = pos & 63;
#pragma unroll
            for (int t = 0; t < 2; ++t) { const int p = t == 0 ? ri : ci; const float* tc = tabM + p * 16 + hi * 8; const float* tsn = tabM + 128 * 16 + p * 16 + hi * 8;
                bf16x8 a = qe[t], b = qe[2 + t];
#pragma unroll
                for (int jj = 0; jj < 8; ++jj) { const float x1 = bf2f((bf16_t)a[jj]), x2 = bf2f((bf16_t)b[jj]), c = tc[jj], s = tsn[jj];
                    a[jj] = (short)f2bf(x1 * c - x2 * s); b[jj] = (short)f2bf(x2 * c + x1 * s); }
                qe[t] = a; qe[2 + t] = b; }
        }
#pragma unroll
        for (int d0 = 0; d0 < 4; ++d0) *(bf16x8*)(qx + (4 + d0) * 1024) = qe[d0];
    }
    const int sr = tid >> 4, sc = (tid & 15) * 8, vst0 = v_st(sr, sc), vst1 = v_st(32 + sr, sc);
    const int sr2 = tid >> 3, sc2 = (tid & 7) * 8;
    const int vb0 = (int)(uintptr_t)V_lds + v_rd_base(lane);
    struct { bf16x8 vs0, vs1, ks0, ks1, ks2; } sr_[SD];
    const unsigned offV = (unsigned)(sr * ldv + sc) * 2u, offK = (unsigned)(sr * ldkn + sc) * 2u, offR = (unsigned)(sr2 * ldkr + sc2) * 2u;
#define SLOAD(i, k0) do { const char* vt_ = (const char*)Vh + (size_t)(k0) * ldv * 2; const char* kt_ = (const char*)Kn + (size_t)(k0) * ldkn * 2; \
    sr_[i].vs0 = *(const bf16x8*)(vt_ + offV); sr_[i].vs1 = *(const bf16x8*)(vt_ + (size_t)32 * ldv * 2 + offV); \
    sr_[i].ks0 = *(const bf16x8*)(kt_ + offK); sr_[i].ks1 = *(const bf16x8*)(kt_ + (size_t)32 * ldkn * 2 + offK); \
    if constexpr (DQ == 192) sr_[i].ks2 = *(const bf16x8*)((const char*)Kr + (size_t)(k0) * ldkr * 2 + offR); } while (0)
#define SWRITE(b, i) do { *(bf16x8*)(V_lds + (b) * SHM_V + vst0) = sr_[i].vs0; *(bf16x8*)(V_lds + (b) * SHM_V + vst1) = sr_[i].vs1; const int kc = sc * 2; \
    *(bf16x8*)(K_lds + (b) * SHM_K + CF::kswz(sr, kc)) = sr_[i].ks0; *(bf16x8*)(K_lds + (b) * SHM_K + CF::kswz(32 + sr, kc)) = sr_[i].ks1; \
    if constexpr (DQ == 192) *(bf16x8*)(K_lds + (b) * SHM_K + CF::kswz(sr2, 256 + sc2 * 2)) = sr_[i].ks2; } while (0)
#define SWAIT() do { if constexpr (SD == 1) asm volatile("s_waitcnt vmcnt(0)" ::: "memory"); else if constexpr (DQ == 192) asm volatile("s_waitcnt vmcnt(5)" ::: "memory"); else asm volatile("s_waitcnt vmcnt(4)" ::: "memory"); } while (0)
#define RESC(a) do { if (__any((a) < 1.f)) { if (hi == 0) al_l[r32] = (a); asm volatile("s_waitcnt lgkmcnt(0)" ::: "memory"); \
    _Pragma("unroll") for (int d = 0; d < 4; ++d) _Pragma("unroll") for (int r = 0; r < 16; ++r) o[d][r] *= al_l[crow(r, hi)]; } } while (0)
    f32x16 pA0, pA1, pB0, pB1; float mnA, mnB, alA, alB; bf16x8 pa0, pa1, pa2, pa3; const int NT = seq / KVBLK;
    constexpr int SE = 0, SO = SD - 1;
    SLOAD(SE, 0); asm volatile("s_waitcnt vmcnt(0)" ::: "memory"); SWRITE(0, SE); __syncthreads();
    qkt<DQ>(pA0, pA1, K_lds, qr, qx, r32, hi); partialSM<DQ>(pA0, pA1, m_reg, mnA, alA);
    SLOAD(SO, KVBLK); if constexpr (SD == 2) { if (2 < NT) SLOAD(SE, 2 * KVBLK); }
    SWAIT(); SWRITE(1, SO); __syncthreads();
    for (int j = 1; j + 1 < NT; j += 2) {
        SBAR(); qkt<DQ>(pB0, pB1, K_lds + SHM_K, qr, qx, r32, hi);
        finishSM(pA0, pA1, alA, l_reg, pa0, pa1, pa2, pa3); SBAR();
        SLOAD(SO, (j + SD) * KVBLK); SBAR();
        pv_d0(o, vb0, pa0, pa1, pa2, pa3); partialSM<DQ>(pB0, pB1, m_reg, mnB, alB);
        __syncthreads(); SWAIT(); SWRITE(0, SE);
        RESC(alB); __syncthreads();
        SBAR(); qkt<DQ>(pA0, pA1, K_lds, qr, qx, r32, hi);
        finishSM(pB0, pB1, alB, l_reg, pa0, pa1, pa2, pa3); SBAR();
        if (SD == 1 || j + 3 < NT) SLOAD(SE, (j + 1 + SD) * KVBLK); SBAR();
        pv_d0(o, vb0 + SHM_V, pa0, pa1, pa2, pa3); partialSM<DQ>(pA0, pA1, m_reg, mnA, alA);
        __syncthreads(); SWAIT(); SWRITE(1, SO);
        RESC(alA); __syncthreads();
    }
    SBAR(); qkt<DQ>(pB0, pB1, K_lds + SHM_K, qr, qx, r32, hi);
    finishSM(pA0, pA1, alA, l_reg, pa0, pa1, pa2, pa3); SBAR();
    pv_d0(o, vb0, pa0, pa1, pa2, pa3); partialSM<DQ>(pB0, pB1, m_reg, mnB, alB);
    __syncthreads(); RESC(alB);
    finishSM(pB0, pB1, alB, l_reg, pa0, pa1, pa2, pa3); SBAR();
    pv_d0(o, vb0 + SHM_V, pa0, pa1, pa2, pa3);
    if (hi == 0) li_l[r32] = l_reg; asm volatile("s_waitcnt lgkmcnt(0)" ::: "memory");
    float rli[16];
#pragma unroll
    for (int r = 0; r < 16; ++r) rli[r] = __builtin_amdgcn_rcpf(li_l[crow(r, hi)]);
    bf16_t* Ow = Ob + (long)(wid * QBLK) * ldo;
#pragma unroll
    for (int r = 0; r < 16; ++r) { const int orow = crow(r, hi);
#pragma unroll
        for (int d0 = 0; d0 < 4; ++d0) Ow[(long)orow * ldo + d0 * 32 + r32] = f2bf(o[d0][r] * rli[r]); }
#undef SLOAD
#undef SWRITE
#undef SWAIT
#undef RESC
}
}

template <int KS> __device__ __forceinline__ void mma_xy(f32x16& acc, const LAS bf16_t* X, const LAS bf16_t* Y, int hi) {
#pragma unroll
    for (int ks = 0; ks < KS; ++ks) { const bf16x8 a = *(const LAS bf16x8*)(X + ks * 16 + hi * 8), b = *(const LAS bf16x8*)(Y + ks * 16 + hi * 8);
        acc = __builtin_amdgcn_mfma_f32_32x32x16_bf16(a, b, acc, 0, 0, 0); }
}
__device__ __forceinline__ float logsig16(float x) { const float e = __expf(-fabsf(x)); return (fminf(x, 0.f) - __logf(1.f + e)) * 0.0625f; }
__device__ __forceinline__ int gla_sidx(int b, int dir, int h) { return (b * 2 + dir) * 4 + h; }

__device__ __forceinline__ void gla_cumsum_lds(const Ctx& C, int l, int h, int dir, const LAS float* lr, LAS float* segtot, LAS float* CUM) {
    const int seg = C.tid >> 7, d = C.tid & 127;
    const float* wa = INP(dir ? I_WA2B : I_WA2F) + (size_t)l * 16 * 512 + h * 128 + d;
    const float bias = INP(dir ? I_BAB : I_BAF)[l * 512 + h * 128 + d];
    float w[16], cum[16];
#pragma unroll
    for (int j = 0; j < 16; ++j) w[j] = wa[j * 512];
    float run = 0.f;
#pragma unroll
    for (int i = 0; i < 16; ++i) { const int s = seg * 16 + i, tk = dir ? 63 - s : s; float pre = bias;
#pragma unroll
        for (int j = 0; j < 16; ++j) pre += lr[tk * 32 + dir * 16 + j] * w[j];
        run += logsig16(pre); cum[i] = run; }
    segtot[seg * 128 + d] = run;
    __syncthreads();
    float off = 0.f;
#pragma unroll
    for (int q = 0; q < 3; ++q) if (q < seg) off += segtot[q * 128 + d];
#pragma unroll
    for (int i = 0; i < 16; ++i) { const int s = seg * 16 + i, tk = dir ? 63 - s : s; CUM[tk * 132 + d] = cum[i] + off; }
    __syncthreads();
}
__device__ __forceinline__ void unpack8(const u32x4 w, float (&x)[8]) { x[0] = bflo(w.x); x[1] = bfhi(w.x); x[2] = bflo(w.y); x[3] = bfhi(w.y); x[4] = bflo(w.z); x[5] = bfhi(w.z); x[6] = bflo(w.w); x[7] = bfhi(w.w); }
__device__ __forceinline__ void gla_build_vt(const Ctx& C, const bf16_t* P, size_t r0, int h, LAS bf16_t* VT) {
    u32x4 v[4];
#pragma unroll
    for (int it = 0; it < 4; ++it) { const int idx = C.tid + it * NTHREADS, sv = idx >> 5, e0 = (idx & 31) * 8; v[it] = *(const u32x4*)(P + (r0 + sv) * NP + C_LV + h * 256 + e0); }
#pragma unroll
    for (int it = 0; it < 4; ++it) { const int idx = C.tid + it * NTHREADS, sv = idx >> 5, e0 = (idx & 31) * 8;
        const unsigned wd[4] = {v[it].x, v[it].y, v[it].z, v[it].w};
#pragma unroll
        for (int q = 0; q < 4; ++q) { VT[(e0 + 2 * q) * 72 + sv] = (bf16_t)(wd[q] & 0xffffu); VT[(e0 + 2 * q + 1) * 72 + sv] = (bf16_t)(wd[q] >> 16); } }
}

__device__ __forceinline__ void phase_gla_local(const Ctx& C, int l) {
    const bf16_t* P = WSP(bf16_t, WS_P); bf16_t* GST = WSP(bf16_t, WS_GST); float* GDEC = WSP(float, WS_GDEC);
    LAS float* lr = (LAS float*)C.lds;
    LAS float* segtot = (LAS float*)(C.lds + 8192);
    LAS bf16_t* KT = (LAS bf16_t*)(C.lds + 10240);
    LAS bf16_t* VT = (LAS bf16_t*)(C.lds + 28672);
    LAS float* CUM = (LAS float*)(C.lds + 65536);
    const int r32 = C.lane & 31, hi = C.lane >> 5, d = C.tid & 127;
    const int btk = C.tid >> 3, bdg = (C.tid & 7) * 16;
    for (int unit = C.bid; unit < NBATCH * 4 * NCH; unit += C.G) {
        const int b = unit / (4 * NCH), h = (unit / NCH) % 4, ck = unit % NCH; const size_t r0 = (size_t)b * RPB + ck * 64;
        for (int i = C.tid; i < 64 * 32; i += NTHREADS) lr[i] = bf2f(P[(r0 + (i >> 5)) * NP + C_LRF + (i & 31)]);
        const u32x4 kw0 = *(const u32x4*)(P + (r0 + btk) * NP + C_LK + h * 128 + bdg), kw1 = *(const u32x4*)(P + (r0 + btk) * NP + C_LK + h * 128 + bdg + 8);
        gla_build_vt(C, P, r0, h, VT);
        __syncthreads();
#pragma unroll 1
        for (int dir = 0; dir < 2; ++dir) {
            gla_cumsum_lds(C, l, h, dir, lr, segtot, CUM);
            const int tend = dir ? 0 : 63;
            const size_t sx = (size_t)gla_sidx(b, dir, h) * NCH + ck;
            if (C.tid < 128) GDEC[sx * 128 + d] = __expf(CUM[tend * 132 + d]);
            { float kf[16]; { float t8[8]; unpack8(kw0, t8);
#pragma unroll
                for (int i = 0; i < 8; ++i) kf[i] = t8[i]; unpack8(kw1, t8);
#pragma unroll
                for (int i = 0; i < 8; ++i) kf[8 + i] = t8[i]; }
#pragma unroll
              for (int q = 0; q < 4; ++q) { const f32x4 cm = *(const LAS f32x4*)(CUM + btk * 132 + bdg + 4 * q), be = *(const LAS f32x4*)(CUM + tend * 132 + bdg + 4 * q);
#pragma unroll
                  for (int i = 0; i < 4; ++i) KT[(bdg + 4 * q + i) * 72 + btk] = f2bf(kf[4 * q + i] * __expf(be[i] - cm[i])); } }
            __syncthreads();
            { const int dt = C.wid & 3, eb = (C.wid >> 2) * 4;
              f32x16 acc[4] = {};
#pragma unroll
              for (int q = 0; q < 4; ++q) mma_xy<4>(acc[q], KT + (dt * 32 + r32) * 72, VT + ((eb + q) * 32 + r32) * 72, hi);
              bf16_t* st = GST + sx * 32768;
#pragma unroll
              for (int q = 0; q < 4; ++q)
#pragma unroll
                  for (int g = 0; g < 4; ++g) { u32x2 w; w.x = cvt_pk_bf16(acc[q][4 * g], acc[q][4 * g + 1]); w.y = cvt_pk_bf16(acc[q][4 * g + 2], acc[q][4 * g + 3]);
                      *(u32x2*)(st + (size_t)((eb + q) * 32 + r32) * 128 + dt * 32 + 8 * g + 4 * hi) = w; } }
            __syncthreads();
        }
    }
}

__device__ __forceinline__ void phase_gla_scan(const Ctx& C) {
    bf16_t* GST = WSP(bf16_t, WS_GST); const float* GDEC = WSP(float, WS_GDEC);
    for (int gid = C.bid * NTHREADS + C.tid; gid < 16 * 8192; gid += C.G * NTHREADS) {
        const int sidx = gid >> 13, g = gid & 8191, dir = (sidx >> 2) & 1, d4 = (g & 31) * 4;
        bf16_t* base = GST + (size_t)sidx * NCH * 32768 + (size_t)g * 4;
        const float* dbase = GDEC + (size_t)sidx * NCH * 128 + d4;
        float S[4] = {0.f, 0.f, 0.f, 0.f};
        for (int st = 0; st < NCH; st += 4) {
            int ck[4]; u32x2 L[4]; f32x4 dc[4];
#pragma unroll
            for (int q = 0; q < 4; ++q) { const int s = st + q; ck[q] = dir ? (s < 4 ? 3 - s : NCH + 3 - s) : s;
                L[q] = *(const u32x2*)(base + (size_t)ck[q] * 32768); dc[q] = *(const f32x4*)(dbase + (size_t)ck[q] * 128); }
#pragma unroll
            for (int q = 0; q < 4; ++q) { u32x2 w; w.x = cvt_pk_bf16(S[0], S[1]); w.y = cvt_pk_bf16(S[2], S[3]);
                *(u32x2*)(base + (size_t)ck[q] * 32768) = w;
                S[0] = dc[q][0] * S[0] + bflo(L[q].x); S[1] = dc[q][1] * S[1] + bfhi(L[q].x); S[2] = dc[q][2] * S[2] + bflo(L[q].y); S[3] = dc[q][3] * S[3] + bfhi(L[q].y); }
        }
    }
}

__device__ __forceinline__ void phase_gla_out(const Ctx& C, int l) {
    const bf16_t* P = WSP(bf16_t, WS_P); const bf16_t* GST = WSP(bf16_t, WS_GST); bf16_t* OL = WSP(bf16_t, WS_OL);
    LAS float* lr = (LAS float*)C.lds;
    LAS float* segtot = (LAS float*)(C.lds + 8192);
    LAS bf16_t* QT = (LAS bf16_t*)(C.lds + 10240);
    LAS bf16_t* KT = (LAS bf16_t*)(C.lds + 27648);
    LAS bf16_t* VT = (LAS bf16_t*)(C.lds + 45056);
    LAS bf16_t* SCm = (LAS bf16_t*)(C.lds + 81920);
    LAS float* OB = (LAS float*)(C.lds + 91136);
    LAS float* CUM = OB;
    const float* gon = INP(I_ONG) + l * 256;
    const int r32 = C.lane & 31, hi = C.lane >> 5;
    const int btk = C.tid >> 3, bdg = (C.tid & 7) * 16;
    for (int unit = C.bid; unit < NBATCH * 4 * NCH; unit += C.G) {
        const int b = unit / (4 * NCH), h = (unit / NCH) % 4, ck = unit % NCH; const size_t r0 = (size_t)b * RPB + ck * 64;
        for (int i = C.tid; i < 64 * 32; i += NTHREADS) lr[i] = bf2f(P[(r0 + (i >> 5)) * NP + C_LRF + (i & 31)]);
        const bf16_t* qp = P + (r0 + btk) * NP + C_LQ + h * 128 + bdg; const bf16_t* kp = P + (r0 + btk) * NP + C_LK + h * 128 + bdg;
        const u32x4 qw0 = *(const u32x4*)qp, qw1 = *(const u32x4*)(qp + 8), kw0 = *(const u32x4*)kp, kw1 = *(const u32x4*)(kp + 8);
        gla_build_vt(C, P, r0, h, VT);
        __syncthreads();
        f32x16 oacc[2] = {};
#pragma unroll 1
        for (int dir = 0; dir < 2; ++dir) {
            gla_cumsum_lds(C, l, h, dir, lr, segtot, CUM);
            { float qf[8], kf[8];
#pragma unroll
              for (int hh = 0; hh < 2; ++hh) { unpack8(hh ? qw1 : qw0, qf); unpack8(hh ? kw1 : kw0, kf);
                  const f32x4 c0 = *(const LAS f32x4*)(CUM + btk * 132 + bdg + 8 * hh), c1 = *(const LAS f32x4*)(CUM + btk * 132 + bdg + 8 * hh + 4);
                  float qo[8], ko[8];
#pragma unroll
                  for (int i = 0; i < 8; ++i) { const float cm = i < 4 ? c0[i & 3] : c1[i & 3]; qo[i] = qf[i] * __expf(cm) * 0.088388347648318440f; ko[i] = kf[i] * __expf(-cm); }
                  u32x4 wq, wk; wq.x = cvt_pk_bf16(qo[0], qo[1]); wq.y = cvt_pk_bf16(qo[2], qo[3]); wq.z = cvt_pk_bf16(qo[4], qo[5]); wq.w = cvt_pk_bf16(qo[6], qo[7]);
                  wk.x = cvt_pk_bf16(ko[0], ko[1]); wk.y = cvt_pk_bf16(ko[2], ko[3]); wk.z = cvt_pk_bf16(ko[4], ko[5]); wk.w = cvt_pk_bf16(ko[6], ko[7]);
                  *(LAS u32x4*)(QT + btk * 136 + bdg + 8 * hh) = wq; *(LAS u32x4*)(KT + btk * 136 + bdg + 8 * hh) = wk; } }
            __syncthreads();
            if (C.wid < 4) { const int mt = C.wid >> 1, nt = C.wid & 1; f32x16 sc = {};
                mma_xy<8>(sc, QT + (mt * 32 + r32) * 136, KT + (nt * 32 + r32) * 136, hi);
#pragma unroll
                for (int i = 0; i < 16; ++i) { const int t = mt * 32 + att::crow(i, hi), sx_ = nt * 32 + r32; const bool keep = dir ? (sx_ >= t) : (sx_ <= t);
                    SCm[t * 72 + sx_] = f2bf(keep ? sc[i] : 0.f); } }
            __syncthreads();
            { const bf16_t* st = GST + ((size_t)gla_sidx(b, dir, h) * NCH + ck) * 32768 + (size_t)(C.wid * 32 + r32) * 128 + hi * 8;
              bf16x8 sb[8];
#pragma unroll
              for (int ks = 0; ks < 8; ++ks) sb[ks] = *(const bf16x8*)(st + ks * 16);
#pragma unroll
              for (int mt = 0; mt < 2; ++mt) {
                  mma_xy<4>(oacc[mt], SCm + (mt * 32 + r32) * 72, VT + (C.wid * 32 + r32) * 72, hi);
#pragma unroll
                  for (int ks = 0; ks < 8; ++ks) { const bf16x8 a = *(const LAS bf16x8*)(QT + (mt * 32 + r32) * 136 + ks * 16 + hi * 8);
                      oacc[mt] = __builtin_amdgcn_mfma_f32_32x32x16_bf16(a, sb[ks], oacc[mt], 0, 0, 0); } } }
            __syncthreads();
        }
#pragma unroll
        for (int mt = 0; mt < 2; ++mt)
#pragma unroll
            for (int i = 0; i < 16; ++i) OB[(mt * 32 + att::crow(i, hi)) * 260 + C.wid * 32 + r32] = oacc[mt][i];
        __syncthreads();
        { const int t = C.tid >> 3, part = C.tid & 7; f32x4 v[8]; float ss = 0.f;
#pragma unroll
          for (int jj = 0; jj < 8; ++jj) { v[jj] = *(const LAS f32x4*)(OB + t * 260 + jj * 32 + part * 4); ss += v[jj][0] * v[jj][0] + v[jj][1] * v[jj][1] + v[jj][2] * v[jj][2] + v[jj][3] * v[jj][3]; }
          ss += dppmov<DPP_HMIRROR>(ss); ss += dppmov<DPP_Q3210>(ss); ss += dppmov<DPP_Q1032>(ss);
          const float rs = rsqrtf(ss * (1.0f / 256.0f) + NORM_EPS);
#pragma unroll
          for (int jj = 0; jj < 8; ++jj) { const int e = jj * 32 + part * 4; const f32x4 g = *(const f32x4*)(gon + e);
              const u32x2 gt = *(const u32x2*)(P + (r0 + t) * NP + C_LG + h * 256 + e);
              const float o0 = v[jj][0] * rs * g[0] * siluf_(bflo(gt.x)), o1 = v[jj][1] * rs * g[1] * siluf_(bfhi(gt.x)), o2 = v[jj][2] * rs * g[2] * siluf_(bflo(gt.y)), o3 = v[jj][3] * rs * g[3] * siluf_(bfhi(gt.y));
              u32x2 w; w.x = cvt_pk_bf16(o0, o1); w.y = cvt_pk_bf16(o2, o3);
              *(u32x2*)(OL + (r0 + t) * 1024 + h * 256 + e) = w; } }
        __syncthreads();
    }
}

__device__ __forceinline__ unsigned f_ord(float f) { const unsigned u = __float_as_uint(f); return u ^ ((unsigned)((int)u >> 31) | 0x80000000u); }
__device__ __forceinline__ float f_unord(unsigned k) { return __uint_as_float((k & 0x80000000u) ? (k ^ 0x80000000u) : ~k); }
__device__ __forceinline__ void ins_u(unsigned (&L)[16], unsigned x) {
#pragma unroll
    for (int j = 0; j < 16; ++j) { const unsigned h = L[j] > x ? L[j] : x; x = L[j] > x ? x : L[j]; L[j] = h; }
}
__device__ __forceinline__ void ins_f(float (&M)[16], float x) {
#pragma unroll
    for (int j = 0; j < 16; ++j) { const float h = M[j] > x ? M[j] : x; x = M[j] > x ? x : M[j]; M[j] = h; }
}
__device__ __forceinline__ void peer_top16(const bf16_t* __restrict__ qrow, const bf16_t* __restrict__ keys, int r32, int hi, unsigned (&L)[16]) {
    bf16x8 qf[8];
#pragma unroll
    for (int kk = 0; kk < 8; ++kk) qf[kk] = *(const bf16x8*)(qrow + kk * 16 + hi * 8);
#pragma unroll
    for (int j = 0; j < 16; ++j) L[j] = 0u;
    bf16x8 kA[8], kB[8];
    const bf16_t* kl = keys + (size_t)r32 * 128 + hi * 8;
#define PT_LDK(dst, mt) do { _Pragma("unroll") for (int kk = 0; kk < 8; ++kk) dst[kk] = *(const bf16x8*)(kl + (mt) * 32 * 128 + kk * 16); } while (0)
#define PT_PROC(src, mt) do { f32x16 acc = {}; \
        _Pragma("unroll") for (int kk = 0; kk < 8; ++kk) acc = __builtin_amdgcn_mfma_f32_32x32x16_bf16(src[kk], qf[kk], acc, 0, 0, 0); \
        _Pragma("unroll") for (int i = 0; i < 16; ++i) { const unsigned kidx = (unsigned)((mt) * 32 + att::crow(i, hi)); ins_u(L, (f_ord(acc[i]) & ~127u) | (127u - kidx)); } } while (0)
    PT_LDK(kA, 0);
#pragma unroll 1
    for (int mp = 0; mp < 2; ++mp) { PT_LDK(kB, 2 * mp + 1); PT_PROC(kA, 2 * mp); if (mp == 0) PT_LDK(kA, 2); PT_PROC(kB, 2 * mp + 1); }
#undef PT_LDK
#undef PT_PROC
    unsigned Pn[16];
#pragma unroll
    for (int j = 0; j < 16; ++j) { auto r_ = __builtin_amdgcn_permlane32_swap(L[j], L[j], false, false); Pn[j] = hi ? r_[0] : r_[1]; }
#pragma unroll
    for (int j = 0; j < 16; ++j) ins_u(L, Pn[j]);
}
__device__ __forceinline__ void phase_peer_select(const Ctx& C, const bool latent_only) {
    const bf16_t* PQ = WSP(bf16_t, WS_PQ); const bf16_t* K1 = WSP(bf16_t, WS_K1); const bf16_t* K2 = WSP(bf16_t, WS_K2);
    int* PIDX = WSP(int, WS_PIDX); float* PG = WSP(float, WS_PG);
    const int r32 = C.lane & 31, hi = C.lane >> 5, head = C.wid;
    const int ngrp = latent_only ? NBATCH * SEQ / 32 : TT / 32;
    for (int gi = C.bid; gi < ngrp; gi += C.G) {
        const int grp = latent_only ? gi + (CTXL / 32) * (1 + gi / (SEQ / 32)) : gi;
        const size_t tok = (size_t)grp * 32 + r32;
        unsigned L1[16], L2[16];
        peer_top16(PQ + tok * DM + head * 256, K1 + (size_t)head * 128 * 128, r32, hi, L1);
        peer_top16(PQ + tok * DM + head * 256 + 128, K2 + (size_t)head * 128 * 128, r32, hi, L2);
        float v1[16], v2[16];
#pragma unroll
        for (int j = 0; j < 16; ++j) { v1[j] = f_unord(L1[j] & ~127u); v2[j] = f_unord(L2[j] & ~127u); }
        float M[16];
#pragma unroll
        for (int j = 0; j < 16; ++j) M[j] = -3.0e38f;
#pragma unroll
        for (int a = 0; a < 16; ++a)
#pragma unroll
            for (int b = 0; b < 16; ++b) if ((a + 1) * (b + 1) <= 16) ins_f(M, v1[a] + v2[b]);
        const float thr = M[15], mx = M[0]; float den = 0.f;
#pragma unroll
        for (int j = 0; j < 16; ++j) den += __expf(M[j] - mx);
        const float rden = 1.0f / den;
        int pos = 0; int* ip = PIDX + tok * 128 + head * 16; float* gp = PG + tok * 128 + head * 16;
#pragma unroll
        for (int a = 0; a < 16; ++a)
#pragma unroll
            for (int b = 0; b < 16; ++b) if ((a + 1) * (b + 1) <= 16) {
                const float val = v1[a] + v2[b];
                if (val >= thr && pos < 16) { if (hi == 0) { ip[pos] = (int)((127u - (L1[a] & 127u)) * 128u + (127u - (L2[b] & 127u))); gp[pos] = __expf(val - mx) * rden; } ++pos; } }
    }
}
template <int OFF> __device__ __forceinline__ float dotf8(const float (&h)[32], const u32x4 w, float acc) {
#pragma unroll
    for (int j = 0; j < 4; ++j) { const f32x2 lo = __builtin_amdgcn_cvt_pk_f32_fp8((int)w[j], false), hi = __builtin_amdgcn_cvt_pk_f32_fp8((int)w[j], true);
        acc += h[OFF + 4 * j] * lo.x; acc += h[OFF + 4 * j + 1] * lo.y; acc += h[OFF + 4 * j + 2] * hi.x; acc += h[OFF + 4 * j + 3] * hi.y; }
    return acc;
}
constexpr int GT_MAXTOK = 9;
template <bool LAST> __device__ __forceinline__ void phase_peer_gather(const Ctx& C, const float* modl, const float pscale) {
    const bf16_t* HB = WSP(bf16_t, WS_HB); const unsigned char* U8 = C.ws + WS_U8; const unsigned char* V8 = C.ws + WS_V8;
    const float* SCU = WSP(float, WS_SCU); const float* SCV = WSP(float, WS_SCV);
    const int* PIDX = WSP(int, WS_PIDX); const float* PG = WSP(float, WS_PG); float* XS = WSP(float, WS_XS);
    const int lane = C.lane, s = lane >> 3, j = lane & 7; const unsigned j16 = (unsigned)j * 16u;
    LAS int* IDS = (LAS int*)(C.lds + C.wid * (GT_MAXTOK * 512));
    LAS float* ACT = (LAS float*)(C.lds + 8 * GT_MAXTOK * 512 + C.wid * (GT_MAXTOK * 512));
    LAS int* ROWS = (LAS int*)(C.lds + 16 * GT_MAXTOK * 512 + C.wid * 64);
    int nk = 0;
    {
      const int per = (TT + C.G - 1) / C.G, base = C.bid * per;
#pragma unroll 1
      for (int k = 0; k < GT_MAXTOK; ++k) { const int o = C.wid + 8 * k; const int r = base + o; if (o < per && r < TT && !(LAST && (r % RPB) < CTXL)) { if (lane == 0) ROWS[nk] = r; ++nk; } } }
#define GT_ROW(k) __builtin_amdgcn_readfirstlane(ROWS[k])
#pragma unroll 1
    for (int k = 0; k < nk; ++k) { const int r = GT_ROW(k);
        IDS[k * 128 + lane] = (PIDX[(size_t)r * 128 + lane] & (NEXP - 1)) << 7; IDS[k * 128 + 64 + lane] = (PIDX[(size_t)r * 128 + 64 + lane] & (NEXP - 1)) << 7;
        ACT[k * 128 + lane] = 0.f; ACT[k * 128 + 64 + lane] = 0.f; }
    const int nit = 32 * nk;
#define GT_ITEM(it_) const int cb_ = (it_) / (2 * nk), rem_ = (it_) - cb_ * (2 * nk), k_ = rem_ >> 1, hf_ = rem_ & 1
#define GT_LOADU(UQ, HQ, it_) do { GT_ITEM(it_); const int r_ = GT_ROW(k_); \
        const bf16_t* hp_ = HB + (size_t)r_ * DM + cb_ * 128 + j * 16; HQ[0] = *(const u32x4*)hp_; HQ[1] = *(const u32x4*)(hp_ + 8); \
        const unsigned char* ub_ = U8 + (size_t)cb_ * ((size_t)NEXP * 128);     \
        _Pragma("unroll") for (int eg = 0; eg < 8; ++eg) { const unsigned off_ = ((unsigned)IDS[k_ * 128 + (hf_ * 8 + eg) * 8 + s] & idmask) + j16; UQ[eg] = *(const u32x4*)(ub_ + off_); } } while (0)
#define GT_COMPU(UQ, HQ, it_) do { GT_ITEM(it_); (void)cb_; f32x2 hf2[8]; \
        _Pragma("unroll") for (int hh = 0; hh < 2; ++hh) { const u32x4 w_ = HQ[hh]; \
            hf2[hh * 4 + 0] = (f32x2){bflo(w_.x), bfhi(w_.x)}; hf2[hh * 4 + 1] = (f32x2){bflo(w_.y), bfhi(w_.y)}; hf2[hh * 4 + 2] = (f32x2){bflo(w_.z), bfhi(w_.z)}; hf2[hh * 4 + 3] = (f32x2){bflo(w_.w), bfhi(w_.w)}; } \
        float d[8]; \
        _Pragma("unroll") for (int eg = 0; eg < 8; ++eg) { f32x2 d2 = (f32x2){0.f, 0.f}; \
            _Pragma("unroll") for (int q = 0; q < 4; ++q) { const f32x2 lo = __builtin_amdgcn_cvt_pk_f32_fp8((int)UQ[eg][q], false), hi = __builtin_amdgcn_cvt_pk_f32_fp8((int)UQ[eg][q], true); \
                d2 += hf2[2 * q] * lo; d2 += hf2[2 * q + 1] * hi; } \
            d[eg] = d2.x + d2.y; } \
          \
        float t4[4], t2[2], t1; \
        _Pragma("unroll") for (int i = 0; i < 4; ++i) { const float snd = (j & 4) ? d[i] : d[i + 4], kp = (j & 4) ? d[i + 4] : d[i]; t4[i] = kp + dppmov<DPP_HMIRROR>(snd); } \
        _Pragma("unroll") for (int i = 0; i < 2; ++i) { const float snd = (j & 2) ? t4[i] : t4[i + 2], kp = (j & 2) ? t4[i + 2] : t4[i]; t2[i] = kp + dppmov<DPP_Q3210>(snd); } \
        { const float snd = (j & 1) ? t2[0] : t2[1], kp = (j & 1) ? t2[1] : t2[0]; t1 = kp + dppmov<DPP_Q1032>(snd); } \
        ACT[k_ * 128 + (hf_ * 8 + j) * 8 + s] += t1; } while (0)
#ifdef DBG_GDUP
#pragma unroll 1
    for (int rep_ = 0; rep_ < 2; ++rep_) {
    const unsigned idmask = rep_ == 0 ? ((unsigned)DBG_GMASK << 7 | 127u) : 0xffffffffu;
    if (rep_ == 1) { for (int k = 0; k < nk; ++k) { ACT[k * 128 + lane] = 0.f; ACT[k * 128 + 64 + lane] = 0.f; } }
#else
    { const unsigned idmask = 0xffffffffu;
#endif
    if (nit > 0) {
        u32x4 uA[8], uB[8], hA[2], hB[2];
        GT_LOADU(uA, hA, 0);
#pragma unroll 1
        for (int it = 0; it < nit; it += 2) {
            GT_LOADU(uB, hB, it + 1);
            GT_COMPU(uA, hA, it);
            if (it + 2 < nit) GT_LOADU(uA, hA, it + 2);
            GT_COMPU(uB, hB, it + 1);
        }
    }
    }
#undef GT_LOADU
#undef GT_COMPU
#pragma unroll 1
    for (int k = 0; k < nk; ++k) { const int r = GT_ROW(k);
#pragma unroll
        for (int hh = 0; hh < 2; ++hh) { const int e = hh * 64 + lane; const int id = IDS[k * 128 + e] >> 7; const float a = ACT[k * 128 + e] * SCU[id];
            const float w = PG[(size_t)r * 128 + e] * 0.5f * a * (1.0f + erff(a * 0.70710678118654752f));
#ifdef DBG_CHECK
            if (((r - 300) & 63) == 0 && r >= 300 && r < 300 + 64 * 128) WSP(float, WS_OM)[(size_t)r * 128 + e] = w;
#endif
            ACT[k * 128 + e] = w * SCV[id]; } }
#define GT_LOADV(VQ, WV, it_) do { GT_ITEM(it_); const unsigned char* vb_ = V8 + (size_t)cb_ * ((size_t)NEXP * 128); \
        _Pragma("unroll") for (int eg = 0; eg < 8; ++eg) { const int e_ = k_ * 128 + (hf_ * 8 + eg) * 8 + s; const unsigned off_ = (unsigned)IDS[e_] + j16; VQ[eg] = *(const u32x4*)(vb_ + off_); WV[eg] = ACT[e_]; } } while (0)
#define GT_COMPV(VQ, WV) do { \
        _Pragma("unroll") for (int eg = 0; eg < 8; ++eg) { const f32x2 w2_ = (f32x2){WV[eg], WV[eg]}; \
            _Pragma("unroll") for (int q = 0; q < 4; ++q) { \
                const f32x2 lo = __builtin_amdgcn_cvt_pk_f32_fp8((int)VQ[eg][q], false), hi = __builtin_amdgcn_cvt_pk_f32_fp8((int)VQ[eg][q], true); \
                acc2[2 * q] += w2_ * lo; acc2[2 * q + 1] += w2_ * hi; } } } while (0)
    if (nit > 0) {
        u32x4 vA[8], vB[8]; float wA[8], wB[8];
        GT_LOADV(vA, wA, 0);
#pragma unroll 1
        for (int it = 0; it < nit; it += 2) {
            f32x2 acc2[8];
#pragma unroll
            for (int i = 0; i < 8; ++i) acc2[i] = (f32x2){0.f, 0.f};
            GT_LOADV(vB, wB, it + 1);
            GT_COMPV(vA, wA);
            if (it + 2 < nit) GT_LOADV(vA, wA, it + 2);
            GT_COMPV(vB, wB);
            f32x2 t4[4], t2[2], t1;
#pragma unroll
            for (int i = 0; i < 4; ++i) { const f32x2 snd = (s & 4) ? acc2[i] : acc2[i + 4], kp = (s & 4) ? acc2[i + 4] : acc2[i];
                t4[i] = kp + (f32x2){xchg32(snd.x, lane), xchg32(snd.y, lane)}; }
#pragma unroll
            for (int i = 0; i < 2; ++i) { const f32x2 snd = (s & 2) ? t4[i] : t4[i + 2], kp = (s & 2) ? t4[i + 2] : t4[i];
                t2[i] = kp + (f32x2){xchg16(snd.x, lane), xchg16(snd.y, lane)}; }
            { const f32x2 snd = (s & 1) ? t2[0] : t2[1], kp = (s & 1) ? t2[1] : t2[0]; t1 = kp + (f32x2){dppmov<DPP_ROR8>(snd.x), dppmov<DPP_ROR8>(snd.y)}; }
            { GT_ITEM(it); (void)hf_; const int r_ = GT_ROW(k_);
              const int col = cb_ * 128 + j * 16 + 2 * s; float* xp = XS + (size_t)r_ * DM + col; const float* g2 = modl + (size_t)mod_sel(r_) * 12288 + 5 * DM + col;
#ifdef DBG_CHECK
              if (((r_ - 300) & 63) == 0 && r_ >= 300 && r_ < 300 + 64 * 128) { float* dbgo = WSP(float, WS_MQ) + (size_t)r_ * DM + col; dbgo[0] = t1.x; dbgo[1] = t1.y; }
#endif
              const f32x2 x = *(const f32x2*)xp, g = *(const f32x2*)g2;
              *(f32x2*)xp = x + pscale * g * t1; }
        }
    }
#undef GT_LOADV
#undef GT_COMPV
#undef GT_ITEM
#undef GT_ROW
}
__device__ __forceinline__ void phase_final_norm(const Ctx& C) {
    const float* XS = WSP(float, WS_XS); const float* fg = INP(I_FG);
    for (int q = C.bid * 8 + C.wid; q < NBATCH * SEQ; q += C.G * 8) {
        const int b = q / SEQ, t = q % SEQ; const float* xr = XS + ((size_t)b * RPB + CTXL + t) * DM; float* op = C.out + (size_t)q * DM;
        f32x4 v[8]; float ss = 0.f;
#pragma unroll
        for (int c = 0; c < 8; ++c) { v[c] = *(const f32x4*)(xr + c * 256 + C.lane * 4); ss += v[c][0] * v[c][0] + v[c][1] * v[c][1] + v[c][2] * v[c][2] + v[c][3] * v[c][3]; }
        ss = wave_sum(ss); const float rs = rsqrtf(ss * (1.0f / DM) + NORM_EPS);
#pragma unroll
        for (int c = 0; c < 8; ++c) { const f32x4 g = *(const f32x4*)(fg + c * 256 + C.lane * 4); *(f32x4*)(op + c * 256 + C.lane * 4) = v[c] * rs * g; }
    }
}

template <int TYPE  > __device__ __forceinline__ void attn_units(const Ctx& C, bool need_ctx) {
    const bf16_t* P = WSP(bf16_t, WS_P);
    const int nu = need_ctx ? 528 : 512;
#pragma unroll 1
    for (int u = C.bid; u < nu; u += C.G) {
        int bh, qb; if (u < 512) { bh = (u >> 8) * 8 + (u & 7); qb = ((u & 255) >> 3) + 1; } else { bh = u - 512; qb = 0; }
        const int b = bh >> 3, h = bh & 7; const size_t rq = (size_t)b * RPB + (size_t)qb * 256, rk = (size_t)b * RPB; const int seq = qb == 0 ? CTXL : RPB;
        __syncthreads();
        if constexpr (TYPE == 1) {
            att::attn_body<128, 1>(P + rq * NP + C_AQ + h * 128, NP, P + rk * NP + C_AK + (h >> 2) * 128, NP, nullptr, 0, P + rk * NP + C_AV + (h >> 2) * 128, NP,
                                   WSP(bf16_t, WS_OA) + rq * 1024 + h * 128, 1024, seq, false, 0, nullptr, (char*)C.lds, C.tid);
        } else {
            const bf16_t* MQ = WSP(bf16_t, WS_MQ); const bf16_t* MKV = WSP(bf16_t, WS_MKV);
            att::attn_body<192, 1>(MQ + rq * 1536 + h * 192, 1536, MKV + rk * 2048 + h * 256, 2048, P + rk * NP + C_MKR, NP, MKV + rk * 2048 + h * 256 + 128, 2048,
                                   WSP(bf16_t, WS_OM) + rq * 1024 + h * 128, 1024, seq, qb > 0, (qb - 1) * 256, WSP(float, WS_TABM), (char*)C.lds, C.tid);
        }
    }
    __syncthreads();
}

constexpr int LDS_BYTES = 163840, LDS_BAR_OFF = LDS_BYTES - 16;
constexpr int N_PHASES = 26;
template <int K> __device__ __forceinline__ void run_phase(const Ctx& C0, int l) {
    const Ctx C = launder(C0);
    const float* modl = WSP(float, WS_MODV) + (size_t)l * 3 * 12288;
    if constexpr (K == 0) { phase_modv(C); phase_tables(C); __syncthreads(); phase_cvt_mixer_weights(C, 0); }
    if constexpr (K == 1) {
        if (l == 0) phase_norm_mod<true>(C, INP(I_N1G), modl, 0, DM);
        else { phase_norm_mod<false>(C, INP(I_N1G) + l * DM, modl, 0, DM); __syncthreads(); phase_cvt_mixer_weights(C, l); }
    }
    if constexpr (K == 2) {
        pg8::Gemm g{WSP(bf16_t, WS_HB), WSP(bf16_t, WS_WIN), TT, NP, DM, DM, DM}; pg8::WinOrder S; S.init(C.G, C.bid, l + 1 < DEPTH);
        pg8::EpiStoreBf16 E{WSP(bf16_t, WS_P), NP};
        pg8::gemm_phase(C.lds, C.tid, g, S, E);
    }
    if constexpr (K == 3) phase_post_p(C, l);
    if constexpr (K == 4) {
        { pg8::Gemm g{WSP(bf16_t, WS_P) + C_MCQ, WSP(bf16_t, WS_WUQ), TT, 1536, 512, NP, 512}; pg8::StaticOrder S; S.init(TT, 1536, C.G, C.bid);
          pg8::EpiStoreBf16 E{WSP(bf16_t, WS_MQ), 1536}; pg8::gemm_phase(C.lds, C.tid, g, S, E); }
        { pg8::Gemm g{WSP(bf16_t, WS_P) + C_MCKV, WSP(bf16_t, WS_WUKV), TT, 2048, 512, NP, 512}; pg8::StaticOrder S; S.init(TT, 2048, C.G, C.bid);
          pg8::EpiStoreBf16 E{WSP(bf16_t, WS_MKV), 2048}; pg8::gemm_phase(C.lds, C.tid, g, S, E); }
        { const Ctx C2 = launder(C0); phase_gla_local(C2, l); }
#ifdef DBG_DUP_GLALOCAL
        { const Ctx C2 = launder(C0); __syncthreads(); phase_gla_local(C2, l); }
#endif
    }
    if constexpr (K == 5) phase_gla_scan(C);
    if constexpr (K == 6) { attn_units<0>(C, l + 1 < DEPTH); { const Ctx C2 = launder(C0); attn_units<1>(C2, l + 1 < DEPTH); } { const Ctx C3 = launder(C0); phase_gla_out(C3, l); }
#ifdef DBG_DUP_GLAOUT
        { const Ctx C3 = launder(C0); __syncthreads(); phase_gla_out(C3, l); }
#endif
    }
    if constexpr (K == 7) {
        const bf16_t* P = WSP(bf16_t, WS_P); bf16_t* Y = WSP(bf16_t, WS_Y);
        const pg8::Gemm ga{WSP(bf16_t, WS_OA), WSP(bf16_t, WS_WBR), TT, DM, 1024, 1024, 1024}, gl{WSP(bf16_t, WS_OL), WSP(bf16_t, WS_WBR) + (size_t)2048 * 1024, TT, DM, 1024, 1024, 1024},
                        gm{WSP(bf16_t, WS_OM), WSP(bf16_t, WS_WBR) + (size_t)2 * 2048 * 1024, TT, DM, 1024, 1024, 1024};
        const pg8::EpiGate<true> Ea{Y, DM, P + C_GA, NP}; const pg8::EpiGate<false> El{Y, DM, P + C_GL, NP}, Em{Y, DM, P + C_GM, NP};
        pg8::StaticOrder S; S.init(TT, DM, C.G, C.bid, l + 1 >= DEPTH);
        pg8::gemm_phase(C.lds, C.tid, ga, S, Ea); pg8::gemm_phase(C.lds, C.tid, gl, S, El); pg8::gemm_phase(C.lds, C.tid, gm, S, Em);
    }
    if constexpr (K == 8) {
        pg8::Gemm g{WSP(bf16_t, WS_Y), WSP(bf16_t, WS_WOUT), TT, DM, DM, DM, DM};
        pg8::EpiResid E{WSP(float, WS_XS), DM, modl + 2 * DM, l == 0 ? DBG_MIX0 : DBG_MIX1};
        pg8::StaticOrder S; S.init(TT, DM, C.G, C.bid, l + 1 >= DEPTH);
#ifdef DBG_DUP8
        { pg8::EpiResid E0{WSP(float, WS_XS), DM, modl + 2 * DM, 0.0f}; pg8::gemm_phase(C.lds, C.tid, g, S, E0); }
#endif
        pg8::gemm_phase(C.lds, C.tid, g, S, E);
        phase_cvt_peer_tables(C, l);
#ifdef DBG_CDUP
        phase_cvt_peer_tables(C, l);
#endif
    }
    if constexpr (K == 9) phase_norm_mod<false>(C, INP(I_N2G) + l * DM, modl, 3 * DM, 4 * DM);
    if constexpr (K == 10) {
        pg8::Gemm g{WSP(bf16_t, WS_HB), WSP(bf16_t, WS_WQ), TT, DM, DM, DM, DM};
        pg8::EpiStoreBf16 E{WSP(bf16_t, WS_PQ), DM};
        pg8::StaticOrder S; S.init(TT, DM, C.G, C.bid, l + 1 >= DEPTH); pg8::gemm_phase(C.lds, C.tid, g, S, E);
    }
    if constexpr (K == 11) phase_peer_select(C, l + 1 >= DEPTH);
    if constexpr (K == 13) phase_final_norm(C);
    if constexpr (K == 12) {
#ifdef DBG_DUP12
        if (l + 1 < DEPTH) phase_peer_gather<false>(C, modl, 0.0f); else phase_peer_gather<true>(C, modl, 0.0f);
        __syncthreads();
#endif
        if (l + 1 < DEPTH) phase_peer_gather<false>(C, modl, DBG_PEER0); else phase_peer_gather<true>(C, modl, DBG_PEER1); }
}
__device__ __forceinline__ Ctx make_ctx(const Args& args, unsigned char* lds_raw) {
    Ctx C0; C0.in = (const __attribute__((address_space(4))) cfp_t*)__builtin_amdgcn_kernarg_segment_ptr(); C0.out = args.out; C0.ws = args.ws; C0.lds = (LAS unsigned char*)lds_raw;
    C0.tid = threadIdx.x; C0.lane = C0.tid & 63; C0.wid = __builtin_amdgcn_readfirstlane(C0.tid >> 6); C0.G = gridDim.x; C0.bid = blockIdx.x;
    return C0;
}
template <int K> __global__ void __launch_bounds__(NTHREADS, 2) k_one(Args args) {
    extern __shared__ __attribute__((aligned(16))) unsigned char lds_raw[];
    const Ctx C0 = make_ctx(args, lds_raw);
    run_phase<K>(C0, args.ph_lo);
}
#if MK_N_LAUNCHES == 1 || defined(DBG_HYB)
__global__ void __launch_bounds__(NTHREADS, 2) mk_fwd(Args args) {
    extern __shared__ __attribute__((aligned(16))) unsigned char lds_raw[];
    const Ctx C0 = make_ctx(args, lds_raw);
    if (C0.tid < 4) ((LAS unsigned*)(C0.lds + LDS_BAR_OFF))[C0.tid] = 0u;
    __syncthreads();
    const int lo = args.ph_lo, hi = args.ph_hi;
    XcdBarrier bar; bar.bar = (unsigned*)(args.ws + WS_CTL); bar.x = 0; bar.st = nullptr;
    if (hi - lo > 1) bar = xcd_barrier_post((unsigned*)(args.ws + WS_CTL), (volatile LAS unsigned*)(C0.lds + LDS_BAR_OFF));
#define IN(k) (lo <= (k) && (k) < hi)
#define SEAM(k) do { if (IN(k) && IN((k) + 1)) xcd_barrier(bar); } while (0)
#ifndef DBG_DUP
#define DBG_DUP -1
#endif
#define PH(K, k) do { if (IN(k)) { run_phase<K>(C0, l); if (K == DBG_DUP) { xcd_barrier(bar); run_phase<K>(C0, l); } } SEAM(k); } while (0)
    { const int l = 0; PH(0, 0); }
#pragma unroll 1
    for (int l = 0; l < DEPTH; ++l) {
        const int pb = 1 + 12 * l;
        PH(1, pb + 0); PH(2, pb + 1); PH(3, pb + 2); PH(4, pb + 3); PH(5, pb + 4); PH(6, pb + 5);
        PH(7, pb + 6); PH(8, pb + 7); PH(9, pb + 8); PH(10, pb + 9); PH(11, pb + 10); PH(12, pb + 11);
    }
    { const int l = DEPTH - 1; PH(13, 1 + 12 * DEPTH); }
#undef PH
#undef IN
#undef SEAM
}
#define MAIN_KERNEL mk_fwd
#else
#define MAIN_KERNEL k_one<6>
#endif


#ifdef DBG_CHECK
__device__ __forceinline__ void dbg_report(unsigned* slot, float err) { if (!(err <= 3e38f)) err = 1e30f; atomicMax(slot, __float_as_uint(err)); }
__global__ void k_check_gemm(const bf16_t* A, int lda, const float* W, int K, int N, const bf16_t* Cm, int ldc, int M, unsigned* slot) {
    const unsigned id = blockIdx.x * blockDim.x + threadIdx.x; if (id >= 8192) return;
    const unsigned h = id * 2654435761u; const int row = (int)((h >> 8) % (unsigned)M), col = (int)((h * 40503u >> 7) % (unsigned)N);
    float ref = 0.f; for (int k = 0; k < K; ++k) ref += bf2f(A[(size_t)row * lda + k]) * W[(size_t)k * N + col];
    const float got = bf2f(Cm[(size_t)row * ldc + col]);
    dbg_report(slot, fabsf(got - ref) / (fabsf(ref) + 0.1f));
}

__global__ void k_check_attn(const unsigned char* ws, int type, unsigned* slot) {
    __shared__ float sc[RPB]; __shared__ float red[256]; __shared__ float qv[192];
    const int t = threadIdx.x, bh = blockIdx.x & 15, b = bh >> 3, h = bh & 7; const int qpos = (int)(((blockIdx.x >> 4) * 977u + 13u) % SEQ); const size_t rq = (size_t)b * RPB + CTXL + qpos, rk = (size_t)b * RPB;
    const bf16_t* P = (const bf16_t*)(ws + WS_P); const bf16_t* MQ = (const bf16_t*)(ws + WS_MQ); const bf16_t* MKV = (const bf16_t*)(ws + WS_MKV);
    const int dq = type ? 128 : 192;
    if (t < dq) { float v = type ? bf2f(P[rq * NP + C_AQ + h * 128 + t]) : bf2f(MQ[rq * 1536 + h * 192 + t]); qv[t] = v; }
    __syncthreads();
    if (!type && t < 32) {
        const int ri = qpos >> 6, ci = qpos & 63; const int i = t; const float pos = (float)(i < 16 ? ri : ci); const float inv = powf(10000.f, -(float)(i & 15) / 16.f); const float a = pos * inv;
        const float x1 = qv[128 + i], x2 = qv[160 + i]; qv[128 + i] = x1 * cosf(a) - x2 * sinf(a); qv[160 + i] = x2 * cosf(a) + x1 * sinf(a); }
    __syncthreads();
    const float scale = type ? 0.088388347648f : 0.0721687836487f;
    float mx = -1e30f;
    for (int k = t; k < RPB; k += 256) { float s = 0.f;
        if (type) { const bf16_t* kp = P + (rk + k) * NP + C_AK + (h >> 2) * 128; for (int d = 0; d < 128; ++d) s += qv[d] * bf2f(kp[d]); }
        else { const bf16_t* kp = MKV + (rk + k) * 2048 + h * 256; for (int d = 0; d < 128; ++d) s += qv[d] * bf2f(kp[d]); const bf16_t* kr = P + (rk + k) * NP + C_MKR; for (int d = 0; d < 64; ++d) s += qv[128 + d] * bf2f(kr[d]); }
        s *= scale; sc[k] = s; mx = fmaxf(mx, s); }
    red[t] = mx; __syncthreads(); for (int o = 128; o >= 1; o >>= 1) { if (t < o) red[t] = fmaxf(red[t], red[t + o]); __syncthreads(); } mx = red[0]; __syncthreads();
    float sum = 0.f; for (int k = t; k < RPB; k += 256) { const float p = __expf(sc[k] - mx); sc[k] = p; sum += p; }
    red[t] = sum; __syncthreads(); for (int o = 128; o >= 1; o >>= 1) { if (t < o) red[t] += red[t + o]; __syncthreads(); } sum = red[0]; __syncthreads();
    float e = 0.f, mag = 0.f;
    if (t < 128) { float o = 0.f; for (int k = 0; k < RPB; ++k) { const float vv = type ? bf2f(P[(rk + k) * NP + C_AV + (h >> 2) * 128 + t]) : bf2f(MKV[(rk + k) * 2048 + h * 256 + 128 + t]); o += sc[k] * vv; }
        o /= sum; const float got = bf2f(((const bf16_t*)(ws + (type ? WS_OA : WS_OM)))[rq * 1024 + h * 128 + t]); e = fabsf(got - o); mag = fabsf(o); }
    red[t] = e; __syncthreads(); for (int o = 128; o >= 1; o >>= 1) { if (t < o) red[t] = fmaxf(red[t], red[t + o]); __syncthreads(); } e = red[0]; __syncthreads();
    red[t] = mag; __syncthreads(); for (int o = 128; o >= 1; o >>= 1) { if (t < o) red[t] = fmaxf(red[t], red[t + o]); __syncthreads(); } mag = red[0];
    if (t == 0) dbg_report(slot, e / (mag + 1e-4f));
}
__global__ void __launch_bounds__(256) k_check_gla_rec(const unsigned char* ws, const float* wa_f, const float* ba_f, const float* wa_b, const float* ba_b, float* obuf, int b) {
    __shared__ float ad[128], kd[128], qd[128], lrs[16];
    const int e = threadIdx.x, h = blockIdx.x & 3, dir = blockIdx.x >> 2; const bf16_t* P = (const bf16_t*)(ws + WS_P);
    const float* wa = dir ? wa_b : wa_f; const float* ba = dir ? ba_b : ba_f;
    float S[128];
#pragma unroll
    for (int d = 0; d < 128; ++d) S[d] = 0.f;
    float* ob = obuf + ((size_t)(dir * 2 + b) * 4 + h) * RPB * 256;
    for (int st = 0; st < RPB; ++st) {
        int j; if (!dir) j = st; else j = st < CTXL ? CTXL - 1 - st : RPB - 1 - (st - CTXL);
        const size_t r = (size_t)b * RPB + j; const bf16_t* pr = P + r * NP;
        if (e < 16) lrs[e] = bf2f(pr[(dir ? C_LRB : C_LRF) + e]);
        __syncthreads();
        if (e < 128) { float pre = ba[h * 128 + e]; for (int q = 0; q < 16; ++q) pre += lrs[q] * wa[q * 512 + h * 128 + e];
            const float ls = (fminf(pre, 0.f) - log1pf(expf(-fabsf(pre)))) / 16.f; ad[e] = expf(ls); kd[e] = bf2f(pr[C_LK + h * 128 + e]); qd[e] = bf2f(pr[C_LQ + h * 128 + e]) * 0.088388347648f; }
        __syncthreads();
        const float v = bf2f(pr[C_LV + h * 256 + e]); float o = 0.f;
#pragma unroll
        for (int d = 0; d < 128; ++d) { S[d] = ad[d] * S[d] + kd[d] * v; o += qd[d] * S[d]; }
        ob[(size_t)j * 256 + e] = o;
        __syncthreads();
    }
}
__global__ void k_check_gla_cmp(const unsigned char* ws, const float* obuf, const float* gon, int b, unsigned* slot) {
    __shared__ float red[256];
    const int e = threadIdx.x, h = blockIdx.x & 3, j = blockIdx.x >> 2; const size_t r = (size_t)b * RPB + j; const bf16_t* P = (const bf16_t*)(ws + WS_P);
    const float o = obuf[((size_t)(0 * 2 + b) * 4 + h) * RPB * 256 + (size_t)j * 256 + e] + obuf[((size_t)(1 * 2 + b) * 4 + h) * RPB * 256 + (size_t)j * 256 + e];
    red[e] = o * o; __syncthreads(); for (int s_ = 128; s_ >= 1; s_ >>= 1) { if (e < s_) red[e] += red[e + s_]; __syncthreads(); }
    const float rs = rsqrtf(red[0] / 256.f + NORM_EPS); __syncthreads();
    const float gt = bf2f(P[r * NP + C_LG + h * 256 + e]); const float ref = o * rs * gon[e] * (gt / (1.f + expf(-gt)));
    const float got = bf2f(((const bf16_t*)(ws + WS_OL))[r * 1024 + h * 256 + e]);
    red[e] = fabsf(got - ref); __syncthreads(); for (int s_ = 128; s_ >= 1; s_ >>= 1) { if (e < s_) red[e] = fmaxf(red[e], red[e + s_]); __syncthreads(); }
    if (e == 0) dbg_report(slot, red[0] / 1.0f);
}
__global__ void k_check_select(const bf16_t* PQ, const float* k1, const float* k2, const int* PIDX, const float* PG, unsigned* slot) {
    __shared__ float s1[128], s2[128]; __shared__ int cnt; __shared__ float selv[16];
    const int tok = (blockIdx.x >> 3) * 61 + 5, head = blockIdx.x & 7, t = threadIdx.x;
    if (t == 0) cnt = 0;
    for (int n = t; n < 128; n += 64) { float a = 0.f, b = 0.f; for (int d = 0; d < 128; ++d) { a += bf2f(PQ[(size_t)tok * DM + head * 256 + d]) * k1[((size_t)head * 128 + n) * 128 + d]; b += bf2f(PQ[(size_t)tok * DM + head * 256 + 128 + d]) * k2[((size_t)head * 128 + n) * 128 + d]; } s1[n] = a; s2[n] = b; }
    __syncthreads();
    if (t < 16) { const int id = PIDX[(size_t)tok * 128 + head * 16 + t]; selv[t] = (id >= 0 && id < 16384) ? s1[id >> 7] + s2[id & 127] : -1e30f; }
    __syncthreads();
    float thr = selv[0], mx = selv[0]; for (int k = 1; k < 16; ++k) { thr = fminf(thr, selv[k]); mx = fmaxf(mx, selv[k]); }
    int c = 0; for (int p = t; p < 16384; p += 64) if (s1[p >> 7] + s2[p & 127] > thr + 0.02f) ++c;
    atomicAdd(&cnt, c); __syncthreads();
    if (t == 0) { float den = 0.f; for (int k = 0; k < 16; ++k) den += __expf(selv[k] - mx); float e = fabsf((float)cnt - 15.f) / 15.f > 0.34f ? fabsf((float)cnt - 15.f) / 15.f : 0.f;
        for (int k = 0; k < 16; ++k) e = fmaxf(e, fabsf(PG[(size_t)tok * 128 + head * 16 + k] - __expf(selv[k] - mx) / den) * 4.f);
        for (int k = 0; k < 16; ++k) for (int k2_ = 0; k2_ < k; ++k2_) if (PIDX[(size_t)tok * 128 + head * 16 + k] == PIDX[(size_t)tok * 128 + head * 16 + k2_]) e = fmaxf(e, 10.f);
        dbg_report(slot, e); }
}
__global__ void k_check_gather(const bf16_t* HB, const float* u, const float* v, const int* PIDX, const float* PG, const float* dbgo, unsigned* slot) {
    __shared__ float w[128];
    const int tok = blockIdx.x * 64 + 300, t = threadIdx.x;
    for (int k = t; k < 128; k += 64) { const int id = PIDX[(size_t)tok * 128 + k] & 16383; float a = 0.f; for (int d = 0; d < DM; ++d) a += bf2f(HB[(size_t)tok * DM + d]) * u[(size_t)id * DM + d];
        w[k] = PG[(size_t)tok * 128 + k] * 0.5f * a * (1.0f + erff(a * 0.70710678f)); }
    __syncthreads();
    float e = 0.f, sc = 0.f;
    for (int d = t; d < DM; d += 64) { float o = 0.f; for (int k = 0; k < 128; ++k) o += w[k] * v[(size_t)(PIDX[(size_t)tok * 128 + k] & 16383) * DM + d];
        e = fmaxf(e, fabsf(o - dbgo[(size_t)tok * DM + d])); sc = fmaxf(sc, fabsf(o)); }
    for (int o_ = 32; o_ >= 1; o_ >>= 1) { e = fmaxf(e, __shfl_xor(e, o_)); sc = fmaxf(sc, __shfl_xor(sc, o_)); }
    if (t == 0) dbg_report(slot, e / (sc + 1e-6f));
}
__global__ void k_dbg_out2(const float* x, const float* fg, float* out, const unsigned* slot) {
    const float mx = __uint_as_float(*slot); float v = 0.25f * (log10f(fmaxf(mx, 1e-30f)) + 4.0f); v = fminf(fmaxf(v, 0.f), 9.f);
    const float f = 1.0f + v;
    const int lane = threadIdx.x & 63; const size_t r = (size_t)blockIdx.x * 4 + (threadIdx.x >> 6);
    const float* xr = x + r * DM; float ss = 0.f;
    for (int c = lane; c < DM; c += 64) ss += xr[c] * xr[c];
    ss = wave_sum(ss); const float rs = rsqrtf(ss / DM + NORM_EPS);
    for (int c = lane; c < DM; c += 64) out[r * DM + c] = xr[c] * rs * fg[c] * f;
}
#endif
#ifdef DBG_SCAN
__global__ void k_scan16(const bf16_t* p, size_t n, unsigned* flags, int stage) {
    unsigned bad = 0; for (size_t i = (size_t)blockIdx.x * blockDim.x + threadIdx.x; i < n; i += (size_t)gridDim.x * blockDim.x) bad |= ((p[i] & 0x7f80u) == 0x7f80u);
    if (bad) atomicOr(&flags[stage], 1u);
}
__global__ void k_scan32(const float* p, size_t n, unsigned* flags, int stage) {
    unsigned bad = 0; for (size_t i = (size_t)blockIdx.x * blockDim.x + threadIdx.x; i < n; i += (size_t)gridDim.x * blockDim.x) bad |= ((__float_as_uint(p[i]) & 0x7f800000u) == 0x7f800000u);
    if (bad) atomicOr(&flags[stage], 1u);
}
__global__ void k_dbg_out(const float* x, const float* fg, float* out, const unsigned* flags, int nstage) {
    int code = 0; for (int s = nstage; s >= 1; --s) if (flags[s]) code = s;
    const float f = 1.0f + 0.25f * (float)code;
    const int lane = threadIdx.x & 63; const size_t r = (size_t)blockIdx.x * 4 + (threadIdx.x >> 6);
    const float* xr = x + r * DM; float ss = 0.f;
    for (int c = lane; c < DM; c += 64) ss += xr[c] * xr[c];
    ss = wave_sum(ss); const float rs = rsqrtf(ss / DM + NORM_EPS);
    for (int c = lane; c < DM; c += 64) out[r * DM + c] = xr[c] * rs * fg[c] * f;
}
#endif
extern "C" void kernel_launch(void* const* d_in, const int* in_sizes, int n_in, void* d_out, int out_size, void* d_ws, size_t ws_size, hipStream_t stream) {
    static int grid = 0;
    if (grid == 0) {
        if (n_in != 30 || out_size != NBATCH * SEQ * DM || ws_size < WS_END) { fprintf(stderr, "kernel_launch: shape/workspace mismatch: n_in %d out %d ws %zu (need %zu)\n", n_in, out_size, ws_size, (size_t)WS_END); grid = -1; return; }
        int dev = 0, cus = 0, per_cu = 0;
        if (hipGetDevice(&dev) != hipSuccess || hipDeviceGetAttribute(&cus, hipDeviceAttributeMultiprocessorCount, dev) != hipSuccess) { grid = -1; return; }
        bool okattr = hipFuncSetAttribute((const void*)MAIN_KERNEL, hipFuncAttributeMaxDynamicSharedMemorySize, LDS_BYTES) == hipSuccess;
#if MK_N_LAUNCHES != 1
#ifdef DBG_HYB
        okattr = okattr && hipFuncSetAttribute((const void*)mk_fwd, hipFuncAttributeMaxDynamicSharedMemorySize, LDS_BYTES) == hipSuccess;
#endif
#define SETA(K) okattr = okattr && hipFuncSetAttribute((const void*)k_one<K>, hipFuncAttributeMaxDynamicSharedMemorySize, LDS_BYTES) == hipSuccess
        SETA(0); SETA(1); SETA(2); SETA(3); SETA(4); SETA(5); SETA(6); SETA(7); SETA(8); SETA(9); SETA(10); SETA(11); SETA(12); SETA(13);
#undef SETA
#endif
        if (!okattr) { fprintf(stderr, "kernel_launch: hipFuncSetAttribute failed\n"); grid = -1; return; }
        if (hipOccupancyMaxActiveBlocksPerMultiprocessor(&per_cu, (const void*)MAIN_KERNEL, NTHREADS, LDS_BYTES) != hipSuccess || per_cu < 1) { fprintf(stderr, "kernel_launch: occupancy query says %d blocks per CU\n", per_cu); grid = -1; (void)hipGetLastError(); return; }
        grid = cus;
    }
    if (grid < 0) return;
    if (hipMemsetAsync((char*)d_ws + WS_CTL, 0, CTL_BYTES, stream) != hipSuccess) return;
    Args a{};
    for (int i = 0; i < 30; ++i) a.in[i] = (const float*)d_in[i];
    a.out = (float*)d_out; a.ws = (unsigned char*)d_ws;
#if MK_N_LAUNCHES == 1
#ifdef DBG_SPLIT
    for (int p = 0; p < N_PHASES; p += DBG_SPLIT) { a.ph_lo = p; a.ph_hi = p + DBG_SPLIT < N_PHASES ? p + DBG_SPLIT : N_PHASES; hipLaunchKernelGGL(mk_fwd, dim3(grid), dim3(NTHREADS), LDS_BYTES, stream, a); }
#else
    a.ph_lo = 0; a.ph_hi = N_PHASES;
    hipLaunchKernelGGL(mk_fwd, dim3(grid), dim3(NTHREADS), LDS_BYTES, stream, a);
#endif
#else
    a.ph_hi = 0;
#ifndef DBG_NLAUNCH
#define DBG_NLAUNCH 100
#endif
    int nl_ = 0;
#ifdef DBG_HYB
#define LAUNCH1(K, L) do { if (K == DBG_HYB) { a.ph_lo = 12 * (L) + (K); a.ph_hi = a.ph_lo + 1; hipLaunchKernelGGL(mk_fwd, dim3(grid), dim3(NTHREADS), LDS_BYTES, stream, a); a.ph_hi = 0; } else { a.ph_lo = (L); hipLaunchKernelGGL(k_one<K>, dim3(grid), dim3(NTHREADS), LDS_BYTES, stream, a); } } while (0)
#else
#define LAUNCH1(K, L) do { a.ph_lo = (L); if (nl_++ < DBG_NLAUNCH) { hipLaunchKernelGGL(k_one<K>, dim3(grid), dim3(NTHREADS), LDS_BYTES, stream, a); if (K == DBG_DUP) hipLaunchKernelGGL(k_one<K>, dim3(grid), dim3(NTHREADS), LDS_BYTES, stream, a); } } while (0)
#endif
#ifdef DBG_SCAN
    unsigned* flags = (unsigned*)((char*)d_ws + WS_CTL + 32768);
    char* W = (char*)d_ws;
#define S16(off, n, st) hipLaunchKernelGGL(k_scan16, dim3(1024), dim3(256), 0, stream, (const bf16_t*)(W + (off)), (size_t)(n), flags, st)
#define S32(off, n, st) hipLaunchKernelGGL(k_scan32, dim3(1024), dim3(256), 0, stream, (const float*)(W + (off)), (size_t)(n), flags, st)
    LAUNCH1(0, 0); S32(WS_MODV, 2 * 3 * 12288, 1);
    { const int l = 0;
      LAUNCH1(1, l); S16(WS_HB, (size_t)TT * DM, 2);
      LAUNCH1(2, l); S16(WS_P, (size_t)TT * NP, 3);
      LAUNCH1(3, l); S16(WS_P, (size_t)TT * NP, 4);
      LAUNCH1(4, l); S16(WS_MQ, (size_t)TT * 1536, 5); S16(WS_MKV, (size_t)TT * 2048, 5); S16(WS_GST, (size_t)2112 * 32768, 6); S32(WS_GDEC, (size_t)2112 * 128, 6);
      LAUNCH1(5, l); S16(WS_GST, (size_t)2112 * 32768, 7);
      LAUNCH1(6, l); S16(WS_OA, (size_t)TT * 1024, 8); S16(WS_OM, (size_t)TT * 1024, 9); S16(WS_OL, (size_t)TT * 1024, 10);
      LAUNCH1(7, l); S16(WS_Y, (size_t)TT * DM, 11);
      LAUNCH1(8, l); S32(WS_XS, (size_t)TT * DM, 12);
      LAUNCH1(9, l); S16(WS_HB, (size_t)TT * DM, 13);
      LAUNCH1(10, l); S16(WS_PQ, (size_t)TT * DM, 14);
      LAUNCH1(11, l); S32(WS_PG, (size_t)TT * 128, 15);
      LAUNCH1(12, l); S32(WS_XS, (size_t)TT * DM, 16);
    }
    hipLaunchKernelGGL(k_dbg_out, dim3(NBATCH * SEQ / 4), dim3(256), 0, stream, (const float*)d_in[0], (const float*)d_in[29], (float*)d_out, flags, 16);
#elif defined(DBG_CHECK)
    unsigned* flags = (unsigned*)((char*)d_ws + WS_CTL + 32768);
    char* W = (char*)d_ws;
    LAUNCH1(0, 0);
    { const int l = 0; LAUNCH1(1, l); LAUNCH1(2, l); LAUNCH1(3, l); LAUNCH1(4, l); LAUNCH1(5, l); LAUNCH1(6, l);
#if DBG_CHECK == 5 || DBG_CHECK == 6
      hipLaunchKernelGGL(k_check_attn, dim3(16 * 24), dim3(256), 0, stream, (const unsigned char*)d_ws, DBG_CHECK == 5 ? 1 : 0, flags + 100);
#endif
#if DBG_CHECK == 7
      { float* obuf = (float*)(W + WS_MQ);
        hipLaunchKernelGGL(k_check_gla_rec, dim3(8), dim3(256), 0, stream, (const unsigned char*)d_ws, (const float*)d_in[I_WA2F], (const float*)d_in[I_BAF], (const float*)d_in[I_WA2B], (const float*)d_in[I_BAB], obuf, 0);
        hipLaunchKernelGGL(k_check_gla_cmp, dim3(RPB * 4), dim3(256), 0, stream, (const unsigned char*)d_ws, (const float*)obuf, (const float*)d_in[I_ONG], 0, flags + 100); }
#endif
      LAUNCH1(7, l); LAUNCH1(8, l); LAUNCH1(9, l); LAUNCH1(10, l);
#if DBG_CHECK == 1
      hipLaunchKernelGGL(k_check_gemm, dim3(32), dim3(256), 0, stream, (const bf16_t*)(W + WS_HB), DM, (const float*)d_in[I_PWQ], DM, DM, (const bf16_t*)(W + WS_PQ), DM, TT, flags + 100);
#endif
      LAUNCH1(11, l);
#if DBG_CHECK == 2
      hipLaunchKernelGGL(k_check_select, dim3(256 * 8), dim3(64), 0, stream, (const bf16_t*)(W + WS_PQ), (const float*)d_in[I_PK1], (const float*)d_in[I_PK2], (const int*)(W + WS_PIDX), (const float*)(W + WS_PG), flags + 100);
#endif
      LAUNCH1(12, l);
#if DBG_CHECK == 3
      hipLaunchKernelGGL(k_check_gather, dim3(128), dim3(64), 0, stream, (const bf16_t*)(W + WS_HB), (const float*)d_in[I_PU], (const float*)d_in[I_PV], (const int*)(W + WS_PIDX), (const float*)(W + WS_PG), (const float*)(W + WS_MQ), flags + 100);
#endif
    }
    hipLaunchKernelGGL(k_dbg_out2, dim3(NBATCH * SEQ / 4), dim3(256), 0, stream, (const float*)d_in[0], (const float*)d_in[29], (float*)d_out, flags + 100);
#else
    LAUNCH1(0, 0);
    for (int l = 0; l < DEPTH; ++l) { LAUNCH1(1, l); LAUNCH1(2, l); LAUNCH1(3, l);
#ifdef DBG_DUP23
        LAUNCH1(2, l); LAUNCH1(3, l);
#endif
        LAUNCH1(4, l); LAUNCH1(5, l);
#ifdef DBG_DUP45
        LAUNCH1(4, l); LAUNCH1(5, l);
#endif
        LAUNCH1(6, l); LAUNCH1(7, l); LAUNCH1(8, l); LAUNCH1(9, l); LAUNCH1(10, l); LAUNCH1(11, l); LAUNCH1(12, l); }
    LAUNCH1(13, DEPTH - 1);
#endif
#undef LAUNCH1
#endif
    const hipError_t le = hipPeekAtLastError();
    if (le != hipSuccess) fprintf(stderr, "kernel_launch: launch failed: %s\n", hipGetErrorName(le));
}
```

```cpp
#include <hip/hip_runtime.h>
#include <cstdio>
#include <cstdint>

#ifndef MK_N_LAUNCHES
#ifndef DBG_DUP
#define DBG_DUP -1
#endif
#define MK_N_LAUNCHES 1
#endif

#ifndef DBG_MIX0
#define DBG_MIX0 1.0f
#define DBG_MIX1 1.0f
#define DBG_PEER0 1.0f
#define DBG_PEER1 1.0f
#endif
#ifndef MLA_NQR
#define MLA_NQR 6
#endif
#define LAS __attribute__((address_space(3)))
#define GLB __attribute__((address_space(1)))
typedef unsigned short bf16_t;
typedef short bf16x8 __attribute__((ext_vector_type(8)));
typedef short s16x4 __attribute__((ext_vector_type(4)));
typedef float f32x4 __attribute__((ext_vector_type(4)));
typedef float f32x2 __attribute__((ext_vector_type(2)));
typedef float f32x16 __attribute__((ext_vector_type(16)));
typedef unsigned u32x4 __attribute__((ext_vector_type(4)));
typedef unsigned u32x2 __attribute__((ext_vector_type(2)));
typedef __bf16 bf2_t __attribute__((ext_vector_type(2)));

constexpr int DM = 2048, NBATCH = 2, SEQ = 8192, CTXL = 256, DEPTH = 2;
constexpr int RPB = SEQ + CTXL;
constexpr int TT = NBATCH * RPB;
constexpr int IN_COLS = 11872, NP = 12032;
constexpr int C_AQ = 0, C_AK = 1024, C_AV = 1280, C_LQ = 1536, C_LK = 2048, C_LV = 2560, C_LG = 3584, C_LRF = 4608, C_LRB = 4624,
              C_MCQ = 4640, C_MCKV = 5152, C_MKR = 5664, C_GA = 5728, C_GL = 7776, C_GM = 9824;
constexpr int NCH = RPB / 64;
constexpr int NEXP = 16384;
constexpr float NORM_EPS = 1e-6f;
constexpr int NTHREADS = 512;

constexpr size_t al256(size_t x) { return (x + 255) / 256 * 256; }
constexpr size_t WS_CTL   = 0;
constexpr size_t CTL_BYTES = 65536;
constexpr size_t WS_MODV  = WS_CTL + CTL_BYTES;
constexpr size_t WS_TABA  = al256(WS_MODV + (size_t)2 * 3 * 12288 * 4);
constexpr size_t WS_TABM  = WS_TABA + 2 * 128 * 32 * 4;
constexpr size_t WS_XS    = al256(WS_TABM + 2 * 128 * 16 * 4);
constexpr size_t WS_HB    = WS_XS + (size_t)TT * DM * 4;
constexpr size_t WS_P     = WS_HB + (size_t)TT * DM * 2;
constexpr size_t WS_MQ    = WS_P + (size_t)TT * NP * 2;
constexpr size_t WS_MKV   = WS_MQ + (size_t)TT * 1536 * 2;
constexpr size_t WS_OA    = WS_MKV + (size_t)TT * 2048 * 2;
constexpr size_t WS_OL    = WS_OA + (size_t)TT * 1024 * 2;
constexpr size_t WS_OM    = WS_OL + (size_t)TT * 1024 * 2;
constexpr size_t WS_WIN   = WS_OM + (size_t)TT * 1024 * 2;
constexpr size_t WS_WUQ   = WS_WIN + (size_t)NP * 2048 * 2;
constexpr size_t WS_WUKV  = WS_WUQ + (size_t)1536 * 512 * 2;
constexpr size_t WS_WBR   = WS_WUKV + (size_t)2048 * 512 * 2;
constexpr size_t WS_WOUT  = WS_WBR + (size_t)3 * 2048 * 1024 * 2;
constexpr size_t WS_WQ    = WS_WOUT + (size_t)2048 * 2048 * 2;
constexpr size_t WS_K1    = WS_WQ + (size_t)2048 * 2048 * 2;
constexpr size_t WS_K2    = WS_K1 + (size_t)8 * 128 * 128 * 2;
constexpr size_t WS_GST   = WS_K2 + (size_t)8 * 128 * 128 * 2;
constexpr size_t WS_GDEC  = WS_GST + (size_t)NBATCH * 2 * 4 * NCH * 32768 * 2;
constexpr size_t WS_END0  = WS_GDEC + (size_t)NBATCH * 2 * 4 * NCH * 128 * 4;
constexpr size_t WS_Y     = WS_MKV;
constexpr size_t WS_PQ    = WS_OA;
constexpr size_t WS_PIDX  = WS_P;
constexpr size_t WS_PG    = WS_PIDX + (size_t)TT * 128 * 4;
constexpr size_t PT_BYTES = 2 * (size_t)NEXP * DM + 2 * (size_t)NEXP * 4;
constexpr size_t WS_PT    = WS_END0;
constexpr size_t WS_END   = WS_PT + DEPTH * PT_BYTES;
constexpr size_t PT_U8 = 0, PT_V8 = (size_t)NEXP * DM, PT_SCU = 2 * (size_t)NEXP * DM, PT_SCV = PT_SCU + (size_t)NEXP * 4;
static_assert(WS_PG + (size_t)TT * 128 * 4 <= WS_MQ, "PEER alias region overflows P");

__device__ __forceinline__ unsigned cvt_pk_bf16(float lo, float hi) { bf2_t v; v.x = (__bf16)lo; v.y = (__bf16)hi; return __builtin_bit_cast(unsigned, v); }
__device__ __forceinline__ bf16_t f2bf(float f) { return (bf16_t)(cvt_pk_bf16(f, 0.f) & 0xffffu); }
__device__ __forceinline__ float bf2f(bf16_t b) { return __uint_as_float(((unsigned)b) << 16); }
__device__ __forceinline__ float bflo(unsigned w) { return __uint_as_float(w << 16); }
__device__ __forceinline__ float bfhi(unsigned w) { return __uint_as_float(w & 0xffff0000u); }
__device__ __forceinline__ float xchg32(float x, int lane) { auto r = __builtin_amdgcn_permlane32_swap(__float_as_uint(x), __float_as_uint(x), false, false); return __uint_as_float(lane < 32 ? r[1] : r[0]); }
__device__ __forceinline__ float xchg16(float x, int lane) { auto r = __builtin_amdgcn_permlane16_swap(__float_as_uint(x), __float_as_uint(x), false, false); return __uint_as_float((lane & 16) ? r[0] : r[1]); }
template <int CTRL> __device__ __forceinline__ float dppmov(float x) { return __uint_as_float(__builtin_amdgcn_update_dpp(0u, __float_as_uint(x), CTRL, 0xF, 0xF, false)); }
constexpr int DPP_ROR8 = 0x128, DPP_HMIRROR = 0x141, DPP_Q3210 = 0x1B, DPP_Q1032 = 0xB1;
__device__ __forceinline__ float wave_sum(float v) {
    const int lane = threadIdx.x & 63;
    v += xchg32(v, lane); v += xchg16(v, lane); v += dppmov<DPP_ROR8>(v); v += dppmov<DPP_HMIRROR>(v); v += dppmov<DPP_Q3210>(v); v += dppmov<DPP_Q1032>(v);
    return v;
}
__device__ __forceinline__ float sigmoidf_(float x) { return __builtin_amdgcn_rcpf(1.0f + __expf(-x)); }
__device__ __forceinline__ float siluf_(float x) { return x * __builtin_amdgcn_rcpf(1.0f + __expf(-x)); }

#define XB_TMO      128
#define XB_XCNT(j)  (256  + 64 * (j))
#define XB_XSUB(j)  (1280 + 64 * (j))
#define XB_XGEN(j)  (2304 + 64 * (j))
#define XB_TOP      3328
#define XB_TOPGEN   3392
#define XCD_BAR_WORDS 3456
#define XB_SPIN_CAP (1u << 20)
__device__ __forceinline__ unsigned xb_ld(unsigned* p)              { return __hip_atomic_load(p, __ATOMIC_RELAXED, __HIP_MEMORY_SCOPE_AGENT); }
__device__ __forceinline__ unsigned xb_add(unsigned* p, unsigned v) { return __hip_atomic_fetch_add(p, v, __ATOMIC_RELAXED, __HIP_MEMORY_SCOPE_AGENT); }
__device__ __forceinline__ unsigned xb_xcc_id() { return (unsigned)__builtin_amdgcn_s_getreg((3 << 11) | 20) & 0xFu; }
#define XB_SPIN(cond, bar) do { unsigned _sp = 0; while (cond) { __builtin_amdgcn_s_sleep(1); \
    if ((++_sp & 255u) == 0u) { if (xb_ld(&(bar)[XB_TMO])) break; if (_sp > XB_SPIN_CAP) { atomicAdd(&(bar)[XB_TMO], 1u); break; } } } } while (0)
struct XcdBarrier { unsigned* bar; unsigned x; volatile LAS unsigned* st; };
__device__ __forceinline__ XcdBarrier xcd_barrier_post(unsigned* bar, volatile LAS unsigned* st) {
    XcdBarrier b; b.bar = bar; b.x = xb_xcc_id(); b.st = st;
    if (threadIdx.x == 0) (void)xb_add(&bar[XB_XCNT(b.x)], 1u);
    return b;
}
__device__ __forceinline__ void xcd_barrier_complete(unsigned* bar, unsigned x, unsigned& nloc, unsigned& nx) {
    const unsigned G = gridDim.x * gridDim.y * gridDim.z;
    unsigned sum, cnt, mine, sp = 0u;
    for (;;) {
        sum = 0u; cnt = 0u; mine = 0u;
#pragma unroll
        for (unsigned j = 0; j < 16; ++j) { const unsigned c = xb_ld(&bar[XB_XCNT(j)]); sum += c; cnt += (c > 0u) ? 1u : 0u; mine = (j == x) ? c : mine; }
        if (sum == G) break;
        __builtin_amdgcn_s_sleep(1);
        if ((++sp & 255u) == 0u) { if (xb_ld(&bar[XB_TMO])) break; if (sp > XB_SPIN_CAP) { atomicAdd(&bar[XB_TMO], 1u); break; } }
    }
    nloc = mine > 0u ? mine : 1u; nx = cnt > 0u ? cnt : 1u;
}
__device__ __forceinline__ void xcd_barrier(const XcdBarrier& b) {
    asm volatile("s_waitcnt vmcnt(0)" ::: "memory");
    __syncthreads();
    if (threadIdx.x == 0) {
        unsigned* bar = b.bar;
        __builtin_amdgcn_s_waitcnt(0);
        unsigned nloc = b.st[0], nx = b.st[1];
        if (nloc == 0u) { xcd_barrier_complete(bar, b.x, nloc, nx); b.st[0] = nloc; b.st[1] = nx; }
        const unsigned old = xb_add(&bar[XB_XSUB(b.x)], 1u);
        const unsigned gen = old / nloc;
        if (old + 1u == (gen + 1u) * nloc) {
            __builtin_amdgcn_fence(__ATOMIC_RELEASE, "agent");
            asm volatile("s_waitcnt vmcnt(0)" ::: "memory");
            const unsigned og = xb_add(&bar[XB_TOP], 1u);
            const unsigned tg = og / nx;
            if (og + 1u == (tg + 1u) * nx) xb_add(&bar[XB_TOPGEN], 1u);
            else XB_SPIN(xb_ld(&bar[XB_TOPGEN]) == tg, bar);
            __builtin_amdgcn_fence(__ATOMIC_ACQUIRE, "agent");
            xb_add(&bar[XB_XGEN(b.x)], 1u);
            asm volatile("s_waitcnt vmcnt(0)" ::: "memory");
        } else {
            XB_SPIN(xb_ld(&bar[XB_XGEN(b.x)]) == gen, bar);
            __builtin_amdgcn_fence(__ATOMIC_ACQUIRE, "agent");
            asm volatile("s_waitcnt vmcnt(0)" ::: "memory");
        }
    }
    __syncthreads();
}

namespace pg8 {
constexpr int BM = 256, BK = 64, HALF = 128, HTB = HALF * BK * 2, STAGE_BYTES = 8 * HTB, NXCD = 8, WGM = 8;
__host__ __device__ __forceinline__ int lds_byte(int r, int c) { const int st = (r >> 4) * 2 + (c >> 5), rr = r & 15, cc = c & 31, ob = rr * 64 + cc * 2; return st * 1024 + (ob ^ (((ob >> 9) & 1) << 5)); }
__host__ __device__ __forceinline__ void stage_rc(int b, int& R, int& C) { const int st = b / 1024, sb = b % 1024, swz = sb ^ (((sb >> 9) & 1) << 5); R = (st >> 1) * 16 + swz / 64; C = (st & 1) * 32 + (swz % 64) / 2; }
__host__ __device__ __forceinline__ int perm32(int rho) { const int n = rho >> 4, i = rho & 15; return 8 * (i >> 2) + 4 * n + (i & 3); }
struct Unit { int pm, pn; };
struct Gemm { const bf16_t* A; const bf16_t* Bt; int M, N, K, lda, ldb; };
struct StaticOrder {
    int nM, nN, nwg, G, c, latent;
    __host__ __device__ void init(int M, int N, int G_, int c_, int latent_ = 0) { latent = latent_; nM = latent_ ? 64 : M / BM; nN = N / BM; nwg = nM * nN; G = G_; c = c_; }
    __host__ __device__ bool next(int i, Unit& u) const {
        const long L = (long)i * G + c; if (L >= nwg) return false;
        int wgid = (int)L; { const int q = nwg / NXCD, r = nwg % NXCD, xcd = wgid % NXCD, off = wgid / NXCD; wgid = (xcd < r ? xcd * (q + 1) : r * (q + 1) + (xcd - r) * q) + off; }
        const int nig = WGM * nN, gid = wgid / nig, fm = gid * WGM, gsz = (nM - fm) < WGM ? (nM - fm) : WGM;
        u.pm = fm + ((wgid % nig) % gsz); u.pn = (wgid % nig) / gsz; if (latent) u.pm += 1 + (u.pm >= 32 ? 1 : 0); return true;
    }
};
struct WinOrder {
    StaticOrder S; int full, nlat, G, c;
    __host__ __device__ void init(int G_, int c_, int full_) { full = full_; G = G_; c = c_; S.init(TT, NP, G_, c_, full_ ? 0 : 1); nlat = S.nwg; }
    __host__ __device__ bool next(int i, Unit& u) const {
        if (full) return S.next(i, u);
        const long L = (long)i * G + c;
        if (L < nlat) return S.next(i, u);
        const int q = (int)(L - nlat); if (q >= 24) return false;
        const int t = q % 12; u.pm = q < 12 ? 0 : 33;
        u.pn = t < 2 ? 4 + t : (t < 8 ? 8 + (t - 2) : (t == 8 ? 18 : 20 + (t - 9)));
        return true;
    }
};
struct EpiStoreBf16 {
    static constexpr bool PERM = true;
    bf16_t* O; int ldc;
    __device__ __forceinline__ void operator()(const f32x4 (&acc)[2][2][4][2], const Unit& u, int wr, int wc, int fr, int fq) const {
        const int row0 = u.pm * BM + wr * 64 + fr, col0 = u.pn * BM + wc * 32 + 8 * fq;
#pragma unroll
        for (int ai = 0; ai < 2; ++ai)
#pragma unroll
            for (int m = 0; m < 4; ++m) { bf16_t* rowp = O + (size_t)(row0 + ai * HALF + m * 16) * ldc + col0;
#pragma unroll
                for (int bj = 0; bj < 2; ++bj) { const f32x4 v0 = acc[ai][bj][m][0], v1 = acc[ai][bj][m][1];
                    u32x4 w; w.x = cvt_pk_bf16(v0[0], v0[1]); w.y = cvt_pk_bf16(v0[2], v0[3]); w.z = cvt_pk_bf16(v1[0], v1[1]); w.w = cvt_pk_bf16(v1[2], v1[3]);
                    *(u32x4*)(rowp + bj * HALF) = w; } }
    }
};
struct EpiNull {
    static constexpr bool PERM = true;
    __device__ __forceinline__ void operator()(const f32x4 (&acc)[2][2][4][2], const Unit&, int, int, int, int) const {
#pragma unroll
        for (int a = 0; a < 2; ++a)
#pragma unroll
            for (int b = 0; b < 2; ++b)
#pragma unroll
                for (int m = 0; m < 4; ++m)
#pragma unroll
                    for (int n = 0; n < 2; ++n) asm volatile("" :: "v"(acc[a][b][m][n]));
    }
};
template <bool FIRST> struct EpiGate {
    static constexpr bool PERM = true;
    bf16_t* Y; int ldy; const bf16_t* Gt; int ldg;
    __device__ __forceinline__ void operator()(const f32x4 (&acc)[2][2][4][2], const Unit& u, int wr, int wc, int fr, int fq) const {
        const int row0 = u.pm * BM + wr * 64 + fr, col0 = u.pn * BM + wc * 32 + 8 * fq;
#pragma unroll
        for (int ai = 0; ai < 2; ++ai)
#pragma unroll
        for (int mh = 0; mh < 2; ++mh) {
            u32x4 g[2][2], y[2][2];
#pragma unroll
            for (int mm = 0; mm < 2; ++mm)
#pragma unroll
                for (int bj = 0; bj < 2; ++bj) { const size_t r = (size_t)(row0 + ai * HALF + (mh * 2 + mm) * 16);
                    g[mm][bj] = *(const u32x4*)(Gt + r * ldg + col0 + bj * HALF);
                    if (!FIRST) y[mm][bj] = *(const u32x4*)(Y + r * ldy + col0 + bj * HALF); }
#pragma unroll
            for (int mm = 0; mm < 2; ++mm)
#pragma unroll
                for (int bj = 0; bj < 2; ++bj) { const int m = mh * 2 + mm; const size_t r = (size_t)(row0 + ai * HALF + m * 16); const f32x4 v0 = acc[ai][bj][m][0], v1 = acc[ai][bj][m][1]; const u32x4 gg = g[mm][bj];
                    float o[8];
                    o[0] = sigmoidf_(bflo(gg.x)) * v0[0]; o[1] = sigmoidf_(bfhi(gg.x)) * v0[1]; o[2] = sigmoidf_(bflo(gg.y)) * v0[2]; o[3] = sigmoidf_(bfhi(gg.y)) * v0[3];
                    o[4] = sigmoidf_(bflo(gg.z)) * v1[0]; o[5] = sigmoidf_(bfhi(gg.z)) * v1[1]; o[6] = sigmoidf_(bflo(gg.w)) * v1[2]; o[7] = sigmoidf_(bfhi(gg.w)) * v1[3];
                    if (!FIRST) { const u32x4 yy = y[mm][bj];
                        o[0] += bflo(yy.x); o[1] += bfhi(yy.x); o[2] += bflo(yy.y); o[3] += bfhi(yy.y); o[4] += bflo(yy.z); o[5] += bfhi(yy.z); o[6] += bflo(yy.w); o[7] += bfhi(yy.w); }
                    u32x4 w; w.x = cvt_pk_bf16(o[0], o[1]); w.y = cvt_pk_bf16(o[2], o[3]); w.z = cvt_pk_bf16(o[4], o[5]); w.w = cvt_pk_bf16(o[6], o[7]);
                    *(u32x4*)(Y + r * ldy + col0 + bj * HALF) = w; }
        }
    }
};
struct EpiResid {
    static constexpr bool PERM = false;
    float* X; int ldx; const float* gate; float gscale;
    __device__ __forceinline__ void operator()(const f32x4 (&acc)[2][2][4][2], const Unit& u, int wr, int wc, int fr, int fq) const {
        const int row0 = u.pm * BM + wr * 64 + fr, col0 = u.pn * BM + wc * 32 + 4 * fq;
        const int sel = (u.pm % 33 == 0) ? 2 : (u.pm / 33);
        const float* gp = gate + (size_t)sel * 12288 + col0;
        f32x4 gv[2][2];
#pragma unroll
        for (int bj = 0; bj < 2; ++bj)
#pragma unroll
            for (int n = 0; n < 2; ++n) gv[bj][n] = *(const f32x4*)(gp + bj * HALF + n * 16) * gscale;
#pragma unroll
        for (int ai = 0; ai < 2; ++ai)
#pragma unroll
            for (int mh = 0; mh < 2; ++mh) {
                f32x4 x[2][2][2];
#pragma unroll
                for (int mm = 0; mm < 2; ++mm)
#pragma unroll
                    for (int bj = 0; bj < 2; ++bj)
#pragma unroll
                        for (int n = 0; n < 2; ++n) x[mm][bj][n] = *(const f32x4*)(X + (size_t)(row0 + ai * HALF + (mh * 2 + mm) * 16) * ldx + col0 + bj * HALF + n * 16);
#pragma unroll
                for (int mm = 0; mm < 2; ++mm)
#pragma unroll
                    for (int bj = 0; bj < 2; ++bj)
#pragma unroll
                        for (int n = 0; n < 2; ++n) *(f32x4*)(X + (size_t)(row0 + ai * HALF + (mh * 2 + mm) * 16) * ldx + col0 + bj * HALF + n * 16) = x[mm][bj][n] + gv[bj][n] * acc[ai][bj][mh * 2 + mm][n];
            }
    }
};

template <class Epi, class Sched>
__device__ __forceinline__ void gemm_phase(LAS unsigned char* lds, const int tid, const Gemm g, const Sched& S, const Epi& E) {
    const int wid = __builtin_amdgcn_readfirstlane(tid >> 6), lane = tid & 63, wr = wid >> 2, wc = wid & 3, fr = lane & 15, fq = lane >> 4;
    const int K = g.K, nt = K / BK, lda = g.lda, ldb = g.ldb;
    unsigned voffA[2], voffB[2];
#pragma unroll
    for (int i = 0; i < 2; ++i) { int R, C; stage_rc(tid * 16 + i * 8192, R, C); const int Rb = Epi::PERM ? ((R & ~31) + perm32(R & 31)) : R;
        voffA[i] = (unsigned)(R * lda + C) * 2u; voffB[i] = (unsigned)(Rb * ldb + C) * 2u; }
    const size_t kstep = (size_t)(BK * 2);
    const size_t hstepA = (size_t)HALF * lda * 2, hstepB = (size_t)HALF * ldb * 2;
    const size_t tstepA = 2 * hstepA, tstepB = 2 * hstepB;
    const unsigned ldsw = (unsigned)wid * 1024u;
    const int aoff = lds_byte(wr * 64 + fr, fq * 8), boff = lds_byte(wc * 32 + fr, fq * 8);
#define PG8_SA(b, h) (((b) * 2 + (h)) * HTB)
#define PG8_SB(b, h) ((4 + (b) * 2 + (h)) * HTB)
#define PG8_STAGE(bufoff, gbase, voff) do { _Pragma("unroll") for (int _i = 0; _i < 2; ++_i) \
        __builtin_amdgcn_global_load_lds((const unsigned*)((const char*)(gbase) + (voff)[_i]), (LAS unsigned*)(lds + (bufoff) + ldsw + _i * 8192), 16, 0, 0); } while (0)
#define PG8_LDA(dst, b, h) do { _Pragma("unroll") for (int m = 0; m < 4; ++m) _Pragma("unroll") for (int k = 0; k < 2; ++k) dst[m][k] = *(const LAS bf16x8*)(lds + PG8_SA(b, h) + aoff + m * 2048 + k * 1024); } while (0)
#define PG8_LDB(dst, b, h) do { _Pragma("unroll") for (int n = 0; n < 2; ++n) _Pragma("unroll") for (int k = 0; k < 2; ++k) dst[n][k] = *(const LAS bf16x8*)(lds + PG8_SB(b, h) + boff + n * 2048 + k * 1024); } while (0)
#define PG8_MMA(ai, bj, At, Bt) do { __builtin_amdgcn_s_setprio(1); _Pragma("unroll") for (int m = 0; m < 4; ++m) _Pragma("unroll") for (int n = 0; n < 2; ++n) _Pragma("unroll") for (int k = 0; k < 2; ++k) \
        acc[ai][bj][m][n] = __builtin_amdgcn_mfma_f32_16x16x32_bf16(Bt[n][k], At[m][k], acc[ai][bj][m][n], 0, 0, 0); __builtin_amdgcn_s_setprio(0); } while (0)
#define PG8_WAIT_V(n) asm volatile("s_waitcnt vmcnt(" #n ")" ::: "memory")
#define PG8_WAIT_L(n) asm volatile("s_waitcnt lgkmcnt(" #n ")" ::: "memory")
#define PG8_BAR __builtin_amdgcn_s_barrier()
#define PG8_SCHED __builtin_amdgcn_sched_barrier(0)
    Unit cur, nxt; int ui = 0;
    if (!S.next(0, cur)) return;
    f32x4 acc[2][2][4][2];
#pragma unroll
    for (int a = 0; a < 2; ++a)
#pragma unroll
        for (int b = 0; b < 2; ++b)
#pragma unroll
            for (int m = 0; m < 4; ++m)
#pragma unroll
                for (int n = 0; n < 2; ++n) acc[a][b][m][n] = (f32x4){0.f, 0.f, 0.f, 0.f};
    bf16x8 At[4][2], B0[2][2], B1[2][2];
    const char* cA = (const char*)g.A + (size_t)cur.pm * tstepA; const char* cB = (const char*)g.Bt + (size_t)cur.pn * tstepB;
    PG8_STAGE(PG8_SB(0, 0), cB, voffB); PG8_STAGE(PG8_SA(0, 0), cA, voffA); PG8_STAGE(PG8_SB(0, 1), cB + hstepB, voffB); PG8_STAGE(PG8_SA(0, 1), cA + hstepA, voffA);
    if (wr == 1) PG8_BAR;
    PG8_WAIT_V(4); PG8_BAR;
    PG8_STAGE(PG8_SB(1, 0), cB + kstep, voffB); PG8_STAGE(PG8_SA(1, 0), cA + kstep, voffA); PG8_STAGE(PG8_SB(1, 1), cB + hstepB + kstep, voffB);
    PG8_WAIT_V(6); PG8_BAR;
    for (;;) {
        const bool has_next = S.next(ui + 1, nxt);
        const char* nA = has_next ? (const char*)g.A + (size_t)nxt.pm * tstepA : cA; const char* nB = has_next ? (const char*)g.Bt + (size_t)nxt.pn * tstepB : cB;
        for (int t = 0; t < nt; t += 2) {
            const bool last = (t == nt - 2);
            const char* a1 = cA + (size_t)(t + 1) * kstep;
            const char* a2 = last ? nA : cA + (size_t)(t + 2) * kstep; const char* b2 = last ? nB : cB + (size_t)(t + 2) * kstep;
            const char* a3 = a2 + kstep; const char* b3 = b2 + kstep;
            PG8_LDB(B0, 0, 0); PG8_SCHED; PG8_LDA(At, 0, 0); PG8_STAGE(PG8_SA(1, 1), a1 + hstepA, voffA);
            PG8_WAIT_L(8); PG8_BAR; PG8_WAIT_L(0); PG8_MMA(0, 0, At, B0); PG8_BAR; PG8_SCHED;
            PG8_LDB(B1, 0, 1); PG8_STAGE(PG8_SB(0, 0), b2, voffB);
            PG8_BAR; PG8_WAIT_L(0); PG8_MMA(0, 1, At, B1); PG8_BAR;
            PG8_LDA(At, 0, 1); PG8_STAGE(PG8_SA(0, 0), a2, voffA);
            PG8_BAR; PG8_WAIT_L(0); PG8_MMA(1, 0, At, B0); PG8_BAR; PG8_SCHED;
            PG8_STAGE(PG8_SB(0, 1), b2 + hstepB, voffB);
            PG8_WAIT_V(6); PG8_BAR; PG8_MMA(1, 1, At, B1); PG8_BAR;
            PG8_LDB(B0, 1, 0); PG8_SCHED; PG8_LDA(At, 1, 0); PG8_STAGE(PG8_SA(0, 1), a2 + hstepA, voffA);
            PG8_WAIT_L(8); PG8_BAR; PG8_WAIT_L(0); PG8_MMA(0, 0, At, B0); PG8_BAR; PG8_SCHED;
            PG8_LDB(B1, 1, 1); PG8_STAGE(PG8_SB(1, 0), b3, voffB);
            PG8_BAR; PG8_WAIT_L(0); PG8_MMA(0, 1, At, B1); PG8_BAR;
            PG8_LDA(At, 1, 1); PG8_STAGE(PG8_SA(1, 0), a3, voffA);
            PG8_BAR; PG8_WAIT_L(0); PG8_MMA(1, 0, At, B0); PG8_BAR; PG8_SCHED;
            PG8_STAGE(PG8_SB(1, 1), b3 + hstepB, voffB);
            PG8_WAIT_V(6); PG8_BAR; PG8_MMA(1, 1, At, B1); PG8_BAR;
        }
        E(acc, cur, wr, wc, fr, fq);
        if (!has_next) break;
#pragma unroll
        for (int a = 0; a < 2; ++a)
#pragma unroll
            for (int b = 0; b < 2; ++b)
#pragma unroll
                for (int m = 0; m < 4; ++m)
#pragma unroll
                    for (int n = 0; n < 2; ++n) acc[a][b][m][n] = (f32x4){0.f, 0.f, 0.f, 0.f};
        cur = nxt; cA = nA; cB = nB; ++ui;
    }
    PG8_WAIT_V(0);
    if (wr == 0) PG8_BAR;
    PG8_BAR;
#undef PG8_SA
#undef PG8_SB
#undef PG8_STAGE
#undef PG8_LDA
#undef PG8_LDB
#undef PG8_MMA
#undef PG8_WAIT_V
#undef PG8_WAIT_L
#undef PG8_BAR
#undef PG8_SCHED
}
}

struct Args { const float* in[30]; float* out; unsigned char* ws; int ph_lo, ph_hi; };
enum { I_X = 0, I_C, I_CTX, I_CCTX, I_WMOD, I_BMOD, I_N1G, I_WIN, I_QNG, I_KNG, I_WA2F, I_BAF, I_WA2B, I_BAB, I_ONG, I_MQNG, I_WUQ, I_MKVNG, I_WUKV,
       I_WBRA, I_WBRL, I_WBRM, I_WOUT, I_N2G, I_PWQ, I_PK1, I_PK2, I_PU, I_PV, I_FG };
typedef const float* cfp_t;
struct Ctx {
    const __attribute__((address_space(4))) cfp_t* in; float* out; unsigned char* ws; LAS unsigned char* lds;
    int tid, lane, wid, G, bid;
};
#define WSP(T, off) ((T*)(C.ws + (off)))
#define INP(i) ((const float*)(const GLB float*)C.in[(i)])
__device__ __forceinline__ unsigned long long launder_u64(unsigned long long w) {
    unsigned lo = (unsigned)w, hi = (unsigned)(w >> 32); asm volatile("" : "+v"(lo), "+v"(hi));
    lo = __builtin_amdgcn_readfirstlane(lo); hi = __builtin_amdgcn_readfirstlane(hi); return ((unsigned long long)hi << 32) | lo;
}
__device__ __forceinline__ Ctx launder(const Ctx& C0) {
    Ctx R = C0; int t = C0.tid; asm volatile("" : "+v"(t)); R.tid = t; R.lane = t & 63; R.wid = __builtin_amdgcn_readfirstlane(t >> 6);
    R.ws = (unsigned char*)(GLB unsigned char*)launder_u64((unsigned long long)C0.ws);
    R.out = (float*)(GLB float*)(unsigned long long)C0.out;
    R.in = (const __attribute__((address_space(4))) cfp_t*)launder_u64((unsigned long long)C0.in);
    unsigned l = (unsigned)(uintptr_t)C0.lds; asm volatile("" : "+v"(l)); l = __builtin_amdgcn_readfirstlane(l); R.lds = (LAS unsigned char*)(uintptr_t)l;
    return R;
}

__device__ __forceinline__ const float* src_row(const Ctx& C, int r) {
    const int b = r / RPB, j = r % RPB;
    return j < CTXL ? INP(I_CTX) + ((size_t)b * CTXL + j) * DM : INP(I_X) + ((size_t)b * SEQ + (j - CTXL)) * DM;
}
__device__ __forceinline__ int mod_sel(int r) { const int b = r / RPB, j = r % RPB; return j < CTXL ? 2 : b; }

__device__ __forceinline__ void phase_modv(const Ctx& C) {
    LAS float* sc = (LAS float*)C.lds;
    LAS float* red = (LAS float*)(C.lds + 3 * 2048 * 4);
    for (int i = C.tid; i < 3 * DM; i += NTHREADS) { const int r = i / DM, k = i % DM; const float v = r < 2 ? INP(I_C)[r * DM + k] : INP(I_CCTX)[k]; sc[i] = siluf_(v); }
    __syncthreads();
    float* modv = WSP(float, WS_MODV);
    const int kq = C.tid / 12, c4 = C.tid % 12;
    for (int item = C.bid; item < 2 * 256; item += C.G) {
        const int l = item / 256, cg = item % 256;
        float acc[3][4];
#pragma unroll
        for (int r = 0; r < 3; ++r)
#pragma unroll
            for (int j = 0; j < 4; ++j) acc[r][j] = 0.f;
        if (kq < 42) {
            const float* wp = INP(I_WMOD) + (size_t)l * DM * 12288 + 48 * cg + 4 * c4;
#pragma unroll 1
            for (int k0 = kq; k0 < DM; k0 += 42 * 7) {
                f32x4 w[7];
#pragma unroll
                for (int u = 0; u < 7; ++u) { const int k = k0 + 42 * u; w[u] = k < DM ? *(const f32x4*)(wp + (size_t)k * 12288) : (f32x4){0.f, 0.f, 0.f, 0.f}; }
#pragma unroll
                for (int u = 0; u < 7; ++u) { const int k = k0 + 42 * u; if (k < DM) {
#pragma unroll
                    for (int r = 0; r < 3; ++r) { const float sv = sc[r * DM + k];
#pragma unroll
                        for (int j = 0; j < 4; ++j) acc[r][j] += sv * w[u][j]; } } }
            }
#pragma unroll
            for (int r = 0; r < 3; ++r)
#pragma unroll
                for (int j = 0; j < 4; ++j) red[kq * 144 + r * 48 + c4 * 4 + j] = acc[r][j];
        }
        __syncthreads();
        if (C.tid < 144) { float s = 0.f; for (int q = 0; q < 42; ++q) s += red[q * 144 + C.tid];
            const int r = C.tid / 48, cc = C.tid % 48;
            modv[((size_t)l * 3 + r) * 12288 + 48 * cg + cc] = s + INP(I_BMOD)[(size_t)l * 12288 + 48 * cg + cc]; }
        __syncthreads();
    }
}
__device__ __forceinline__ void phase_tables(const Ctx& C) {
    float* ta = WSP(float, WS_TABA); float* tm = WSP(float, WS_TABM);
    for (int i = C.bid * NTHREADS + C.tid; i < 128 * 32 + 128 * 16; i += C.G * NTHREADS) {
        if (i < 128 * 32) { const int pos = i / 32, f = i % 32; const float inv = exp2f(-(float)f * (13.287712379549449f / 32.0f)); const float a = (float)pos * inv;
            ta[i] = cosf(a); ta[128 * 32 + i] = sinf(a); }
        else { const int k = i - 128 * 32, pos = k / 16, f = k % 16; const float inv = exp2f(-(float)f * (13.287712379549449f / 16.0f)); const float a = (float)pos * inv;
            tm[k] = cosf(a); tm[128 * 16 + k] = sinf(a); }
    }
}
__device__ __forceinline__ void transpose_cvt(const Ctx& C, const float* src, int K, int N, bf16_t* dst, int Npad, int& item) {
    LAS float* tile = (LAS float*)C.lds;
    const int tk = K / 64, tn = Npad / 256, ntile = tk * tn;
    const int t0 = ((C.bid - item % C.G) + C.G) % C.G; item += ntile;
    for (int t = t0; t < ntile; t += C.G) {
        const int k0 = (t / tn) * 64, n0 = (t % tn) * 256;
        const int nn = (C.tid & 63) * 4, kr = C.tid >> 6;
        f32x4 v[8];
#pragma unroll
        for (int p = 0; p < 8; ++p) { v[p] = (f32x4){0.f, 0.f, 0.f, 0.f}; if (n0 + nn < N) v[p] = *(const f32x4*)(src + (size_t)(k0 + kr + p * 8) * N + n0 + nn); }
#pragma unroll
        for (int p = 0; p < 8; ++p)
#pragma unroll
            for (int j = 0; j < 4; ++j) tile[(kr + p * 8) * 257 + nn + j] = v[p][j];
        __syncthreads();
        { const int n = C.tid >> 1, kh = (C.tid & 1) * 32;
#pragma unroll
          for (int q = 0; q < 4; ++q) { float x[8];
#pragma unroll
              for (int j = 0; j < 8; ++j) x[j] = tile[(kh + q * 8 + j) * 257 + n];
              u32x4 w; w.x = cvt_pk_bf16(x[0], x[1]); w.y = cvt_pk_bf16(x[2], x[3]); w.z = cvt_pk_bf16(x[4], x[5]); w.w = cvt_pk_bf16(x[6], x[7]);
              *(u32x4*)(dst + (size_t)(n0 + n) * K + k0 + kh + q * 8) = w; } }
        __syncthreads();
    }
}
__device__ __forceinline__ void cvt_plain(const Ctx& C, const float* src, bf16_t* dst, size_t n8) {
    for (size_t i = (size_t)C.bid * NTHREADS + C.tid; i < n8; i += (size_t)C.G * NTHREADS) {
        const f32x4 a = *(const f32x4*)(src + i * 8), b = *(const f32x4*)(src + i * 8 + 4);
        u32x4 w; w.x = cvt_pk_bf16(a[0], a[1]); w.y = cvt_pk_bf16(a[2], a[3]); w.z = cvt_pk_bf16(b[0], b[1]); w.w = cvt_pk_bf16(b[2], b[3]);
        *(u32x4*)(dst + i * 8) = w;
    }
}
__device__ __forceinline__ void phase_cvt_mixer_weights(const Ctx& C, int l) {
    int item = 0;
    transpose_cvt(C, INP(I_WIN) + (size_t)l * DM * IN_COLS, DM, IN_COLS, WSP(bf16_t, WS_WIN), NP, item);
    transpose_cvt(C, INP(I_WUQ) + (size_t)l * 512 * 1536, 512, 1536, WSP(bf16_t, WS_WUQ), 1536, item);
    transpose_cvt(C, INP(I_WUKV) + (size_t)l * 512 * 2048, 512, 2048, WSP(bf16_t, WS_WUKV), 2048, item);
    transpose_cvt(C, INP(I_WBRA) + (size_t)l * 1024 * 2048, 1024, 2048, WSP(bf16_t, WS_WBR), 2048, item);
    transpose_cvt(C, INP(I_WBRL) + (size_t)l * 1024 * 2048, 1024, 2048, WSP(bf16_t, WS_WBR) + (size_t)2048 * 1024, 2048, item);
    transpose_cvt(C, INP(I_WBRM) + (size_t)l * 1024 * 2048, 1024, 2048, WSP(bf16_t, WS_WBR) + (size_t)2 * 2048 * 1024, 2048, item);
    transpose_cvt(C, INP(I_WOUT) + (size_t)l * 2048 * 2048, 2048, 2048, WSP(bf16_t, WS_WOUT), 2048, item);
    transpose_cvt(C, INP(I_PWQ) + (size_t)l * 2048 * 2048, 2048, 2048, WSP(bf16_t, WS_WQ), 2048, item);
    cvt_plain(C, INP(I_PK1) + (size_t)l * 8 * 128 * 128, WSP(bf16_t, WS_K1), 8 * 128 * 128 / 8);
    cvt_plain(C, INP(I_PK2) + (size_t)l * 8 * 128 * 128, WSP(bf16_t, WS_K2), 8 * 128 * 128 / 8);
}
__device__ __forceinline__ void phase_cvt_peer_tables(const Ctx& C, int l, int row_lo, int row_hi, int wg_lo) {
    const int lane = C.lane; if (C.bid < wg_lo) return;
    unsigned char* pt = C.ws + WS_PT + (size_t)l * PT_BYTES;
    for (int row = row_lo + (C.bid - wg_lo) * 8 + C.wid; row < row_hi; row += (C.G - wg_lo) * 8) {
#pragma unroll 1
        for (int tb = 0; tb < 2; ++tb) {
            const float* src = (tb ? INP(I_PV) : INP(I_PU)) + ((size_t)l * NEXP + row) * DM + lane * 16;
            f32x4 x[8]; float amax = 0.f;
#pragma unroll
            for (int c = 0; c < 2; ++c)
#pragma unroll
                for (int q = 0; q < 4; ++q) { x[c * 4 + q] = *(const f32x4*)(src + c * 1024 + q * 4);
                    amax = fmaxf(amax, fmaxf(fmaxf(fabsf(x[c * 4 + q][0]), fabsf(x[c * 4 + q][1])), fmaxf(fabsf(x[c * 4 + q][2]), fabsf(x[c * 4 + q][3])))); }
            amax = fmaxf(amax, xchg32(amax, lane)); amax = fmaxf(amax, xchg16(amax, lane)); amax = fmaxf(amax, dppmov<DPP_ROR8>(amax));
            amax = fmaxf(amax, dppmov<DPP_HMIRROR>(amax)); amax = fmaxf(amax, dppmov<DPP_Q3210>(amax)); amax = fmaxf(amax, dppmov<DPP_Q1032>(amax));
            const float sc = amax > 0.f ? 224.0f / amax : 1.0f, inv = amax > 0.f ? amax * (1.0f / 224.0f) : 1.0f;
            unsigned char* dst = pt + (tb ? PT_V8 : PT_U8) + (size_t)(lane >> 3) * ((size_t)NEXP * 128) + (size_t)row * 128 + (lane & 7) * 16;
#pragma unroll
            for (int c = 0; c < 2; ++c) { u32x4 w;
#pragma unroll
                for (int q = 0; q < 4; ++q) { const f32x4 v = x[c * 4 + q] * sc; int p = __builtin_amdgcn_cvt_pk_fp8_f32(v[0], v[1], 0, false); p = __builtin_amdgcn_cvt_pk_fp8_f32(v[2], v[3], p, true); w[q] = (unsigned)p; }
                *(u32x4*)(dst + (size_t)c * 8 * ((size_t)NEXP * 128)) = w; }
            if (lane == 0) ((float*)(pt + (tb ? PT_SCV : PT_SCU)))[row] = inv;
        }
    }
}

template <bool FIRST> __device__ __forceinline__ void phase_norm_mod(const Ctx& C, const float* gvec, const float* modl  , int shift_off, int scale_off) {
    float* xs = WSP(float, WS_XS); bf16_t* hb = WSP(bf16_t, WS_HB);
    for (int r = C.bid * 8 + C.wid; r < TT; r += C.G * 8) {
        const float* xr = FIRST ? src_row(C, r) : xs + (size_t)r * DM;
        const float* mv = modl + (size_t)mod_sel(r) * 12288;
        f32x4 v[8]; float ss = 0.f;
#pragma unroll
        for (int c = 0; c < 4; ++c) { v[2 * c] = *(const f32x4*)(xr + c * 512 + C.lane * 8); v[2 * c + 1] = *(const f32x4*)(xr + c * 512 + C.lane * 8 + 4); }
#pragma unroll
        for (int c = 0; c < 8; ++c) ss += v[c][0] * v[c][0] + v[c][1] * v[c][1] + v[c][2] * v[c][2] + v[c][3] * v[c][3];
        ss = wave_sum(ss);
        const float rs = rsqrtf(ss * (1.0f / DM) + NORM_EPS);
#pragma unroll
        for (int c = 0; c < 4; ++c) { const int col = c * 512 + C.lane * 8;
            if (FIRST) { *(f32x4*)(xs + (size_t)r * DM + col) = v[2 * c]; *(f32x4*)(xs + (size_t)r * DM + col + 4) = v[2 * c + 1]; }
            float o[8];
#pragma unroll
            for (int h = 0; h < 2; ++h) { const f32x4 g = *(const f32x4*)(gvec + col + 4 * h), s = *(const f32x4*)(mv + scale_off + col + 4 * h), t = *(const f32x4*)(mv + shift_off + col + 4 * h);
#pragma unroll
                for (int j = 0; j < 4; ++j) o[4 * h + j] = v[2 * c + h][j] * rs * g[j] * (1.0f + s[j]) + t[j]; }
            u32x4 w; w.x = cvt_pk_bf16(o[0], o[1]); w.y = cvt_pk_bf16(o[2], o[3]); w.z = cvt_pk_bf16(o[4], o[5]); w.w = cvt_pk_bf16(o[6], o[7]);
            *(u32x4*)(hb + (size_t)r * DM + col) = w; }
    }
}

__device__ __forceinline__ void phase_post_p(const Ctx& C, int l) {
    bf16_t* P = WSP(bf16_t, WS_P); const float* ta = WSP(float, WS_TABA); const float* tm = WSP(float, WS_TABM);
    const float* qg = INP(I_QNG) + l * 128; const float* kg = INP(I_KNG) + l * 128;
    const float* mqg = INP(I_MQNG) + l * 512; const float* mkvg = INP(I_MKVNG) + l * 512;
    const int lane = C.lane;
    const float qg1 = qg[lane], qg2 = qg[lane + 64], kg1 = kg[lane], kg2 = kg[lane + 64];
    for (int r = C.bid * 8 + C.wid; r < TT; r += C.G * 8) {
        bf16_t* pr = P + (size_t)r * NP;
        const int j = r % RPB; const bool lat = j >= CTXL; const int pos = lat ? j - CTXL : 0, ri = pos >> 6, ci = pos & 63;
        float cs = 1.f, sn = 0.f;
        if (lat) { const int p = lane < 32 ? ri : ci, f = lane & 31; cs = ta[p * 32 + f]; sn = ta[128 * 32 + p * 32 + f]; }
#pragma unroll
        for (int h = 0; h < 10; ++h) {
            bf16_t* hp = pr + (h < 8 ? C_AQ + h * 128 : C_AK + (h - 8) * 128);
            const float x1 = bf2f(hp[lane]), x2 = bf2f(hp[lane + 64]);
            const float ss = wave_sum(x1 * x1 + x2 * x2);
            const float rs = rsqrtf(ss * (1.0f / 128.0f) + NORM_EPS);
            const float y1 = x1 * rs * (h < 8 ? qg1 : kg1), y2 = x2 * rs * (h < 8 ? qg2 : kg2);
            hp[lane] = f2bf(y1 * cs - y2 * sn); hp[lane + 64] = f2bf(y2 * cs + y1 * sn);
        }
#pragma unroll
        for (int s = 0; s < 2; ++s) {
            bf16_t* sp = pr + (s == 0 ? C_MCQ : C_MCKV) + lane * 8; const float* gg = (s == 0 ? mqg : mkvg) + lane * 8;
            const u32x4 w = *(const u32x4*)sp; float x[8] = {bflo(w.x), bfhi(w.x), bflo(w.y), bfhi(w.y), bflo(w.z), bfhi(w.z), bflo(w.w), bfhi(w.w)};
            float ss = 0.f;
#pragma unroll
            for (int i = 0; i < 8; ++i) ss += x[i] * x[i];
            ss = wave_sum(ss);
            const float rs = rsqrtf(ss * (1.0f / 512.0f) + NORM_EPS);
#pragma unroll
            for (int i = 0; i < 8; ++i) x[i] = x[i] * rs * gg[i];
            u32x4 o; o.x = cvt_pk_bf16(x[0], x[1]); o.y = cvt_pk_bf16(x[2], x[3]); o.z = cvt_pk_bf16(x[4], x[5]); o.w = cvt_pk_bf16(x[6], x[7]);
            *(u32x4*)sp = o;
        }
        if (lat) { bf16_t* kp = pr + C_MKR; const int i = lane & 31; const float x1 = bf2f(kp[i]), x2 = bf2f(kp[i + 32]);
            const int p = i < 16 ? ri : ci, f = i & 15; const float c2 = tm[p * 16 + f], s2 = tm[128 * 16 + p * 16 + f];
            if (lane < 32) { kp[i] = f2bf(x1 * c2 - x2 * s2); kp[i + 32] = f2bf(x2 * c2 + x1 * s2); } }
    }
}

namespace att {
constexpr int NW = 8, QBLK = 32, KVBLK = 64, DV = 128;
constexpr float THR = 8.f;
#define SBAR() __builtin_amdgcn_sched_barrier(0)
__device__ __forceinline__ int crow(int r, int hi) { return (r & 3) + 8 * (r >> 2) + 4 * hi; }
template <int DQ> struct Cf {
    static constexpr int ND0 = DQ / 16, KROWB = DQ * 2, SHM_K = KVBLK * DQ * 2, SHM_V = KVBLK * DV * 2, SHM = 2 * SHM_V + 2 * SHM_K + NW * 64 * 4;
    static constexpr float SCALE = DQ == 128 ? 0.088388347648318440f : 0.072168783648703220f;
    __device__ static __forceinline__ int kswz(int row, int colB) { return row * KROWB + (colB ^ ((row & 7) << 4)); }
};
template <int DQ> __device__ __forceinline__ void partialSM(f32x16& p0, f32x16& p1, float& m_reg, float& mn, float& alpha) {
    constexpr float SC = Cf<DQ>::SCALE, Cc = SC * 1.4426950408889634f;
    float pmax = p0[0];
#pragma unroll
    for (int r = 1; r < 16; ++r) pmax = fmaxf(pmax, p0[r]);
#pragma unroll
    for (int r = 0; r < 16; ++r) pmax = fmaxf(pmax, p1[r]);
    { auto rr = __builtin_amdgcn_permlane32_swap(__float_as_uint(pmax), __float_as_uint(pmax), false, false);
      pmax = fmaxf(__uint_as_float(rr[0]), __uint_as_float(rr[1])); }
    if (__builtin_expect(__all(pmax - m_reg <= THR / SC), 1)) { mn = m_reg; alpha = 1.f; }
    else { mn = fmaxf(m_reg, pmax); alpha = __builtin_amdgcn_exp2f((m_reg - mn) * Cc); m_reg = mn; }
    const float mnC = -mn * Cc;
#pragma unroll
    for (int r = 0; r < 16; ++r) p0[r] = fmaf(p0[r], Cc, mnC);
#pragma unroll
    for (int r = 0; r < 16; ++r) p1[r] = fmaf(p1[r], Cc, mnC);
#pragma unroll
    for (int r = 0; r < 16; ++r) p0[r] = __builtin_amdgcn_exp2f(p0[r]);
}
__device__ __forceinline__ void finishSM(f32x16& p0, f32x16& p1, float alpha, float& l_reg, bf16x8& pa0, bf16x8& pa1, bf16x8& pa2, bf16x8& pa3) {
#pragma unroll
    for (int r = 0; r < 16; ++r) p1[r] = __builtin_amdgcn_exp2f(p1[r]);
    float ps = 0;
#pragma unroll
    for (int r = 0; r < 16; ++r) ps += p0[r];
#pragma unroll
    for (int r = 0; r < 16; ++r) ps += p1[r];
    { auto rr = __builtin_amdgcn_permlane32_swap(__float_as_uint(ps), __float_as_uint(ps), false, false);
      ps = __uint_as_float(rr[0]) + __uint_as_float(rr[1]); }
    l_reg = l_reg * alpha + ps;
#define PK4(P, BASE, OUT) do { unsigned a0 = cvt_pk_bf16(P[BASE + 0], P[BASE + 1]), a1 = cvt_pk_bf16(P[BASE + 2], P[BASE + 3]);   \
    unsigned b0 = cvt_pk_bf16(P[BASE + 4], P[BASE + 5]), b1 = cvt_pk_bf16(P[BASE + 6], P[BASE + 7]);                              \
    auto r0 = __builtin_amdgcn_permlane32_swap(a0, b0, false, false); auto r1 = __builtin_amdgcn_permlane32_swap(a1, b1, false, false); \
    u32x4 w = {r0[0], r1[0], r0[1], r1[1]}; OUT = *reinterpret_cast<bf16x8*>(&w); } while (0)
    PK4(p0, 0, pa0); PK4(p0, 8, pa1); PK4(p1, 0, pa2); PK4(p1, 8, pa3);
#undef PK4
}
template <int DQ> __device__ __forceinline__ void qkt(f32x16& p0, f32x16& p1, const char* Ks, const bf16x8* qr, const char* qx, int r32, int hi) {
    p0 = f32x16{}; p1 = f32x16{};
#pragma unroll
    for (int d0 = 0; d0 < Cf<DQ>::ND0; ++d0) { const int cb = (d0 * 16 + hi * 8) * 2;
        const bf16x8 b0 = *reinterpret_cast<const bf16x8*>(Ks + Cf<DQ>::kswz(r32, cb));
        const bf16x8 b1 = *reinterpret_cast<const bf16x8*>(Ks + Cf<DQ>::kswz(32 + r32, cb));
        constexpr int NQR = DQ == 192 ? MLA_NQR : 8;
        bf16x8 q; if (d0 < NQR) q = qr[d0]; else q = *reinterpret_cast<const bf16x8*>(qx + (d0 - NQR) * 1024);
        p0 = __builtin_amdgcn_mfma_f32_32x32x16_bf16(b0, q, p0, 0, 0, 0);
        p1 = __builtin_amdgcn_mfma_f32_32x32x16_bf16(b1, q, p1, 0, 0, 0); }
}
__device__ __forceinline__ int v_st(int k, int c) { const int kk = (k & ~0xC) | ((k & 4) << 1) | ((k & 8) >> 1); return ((kk >> 3) * 4 + (c >> 5)) * 512 + ((kk & 7) * 32 + (c & 31)) * 2; }
__device__ __forceinline__ int v_rd_base(int lane) { return ((lane & 3) << 3) | (((lane >> 2) & 3) << 6) | (((lane >> 4) & 1) << 5) | (((lane >> 5) & 1) << 8); }
constexpr int v_rd_off(int d0, int ks, int half) { return d0 * 512 + ks * 4096 + half * 2048; }
template <int OFF> __device__ __forceinline__ s16x4 tr_read(int vb) {
    s16x4 r; asm volatile("ds_read_b64_tr_b16 %0, %1 offset:%2" : "=&v"(r) : "v"(vb), "i"(OFF) : "memory"); return r;
}
template <int D0> __device__ __forceinline__ void pv_one(f32x16& od, int vb, bf16x8 pa0, bf16x8 pa1, bf16x8 pa2, bf16x8 pa3) {
    const s16x4 l0 = tr_read<v_rd_off(D0, 0, 0)>(vb), h0 = tr_read<v_rd_off(D0, 0, 1)>(vb), l1 = tr_read<v_rd_off(D0, 1, 0)>(vb), h1 = tr_read<v_rd_off(D0, 1, 1)>(vb);
    const s16x4 l2 = tr_read<v_rd_off(D0, 2, 0)>(vb), h2 = tr_read<v_rd_off(D0, 2, 1)>(vb), l3 = tr_read<v_rd_off(D0, 3, 0)>(vb), h3 = tr_read<v_rd_off(D0, 3, 1)>(vb);
    asm volatile("s_waitcnt lgkmcnt(0)" ::: "memory"); SBAR();
#define PK(L, H) (bf16x8){L[0], L[1], L[2], L[3], H[0], H[1], H[2], H[3]}
    od = __builtin_amdgcn_mfma_f32_32x32x16_bf16(pa0, PK(l0, h0), od, 0, 0, 0);
    od = __builtin_amdgcn_mfma_f32_32x32x16_bf16(pa1, PK(l1, h1), od, 0, 0, 0);
    od = __builtin_amdgcn_mfma_f32_32x32x16_bf16(pa2, PK(l2, h2), od, 0, 0, 0);
    od = __builtin_amdgcn_mfma_f32_32x32x16_bf16(pa3, PK(l3, h3), od, 0, 0, 0);
#undef PK
}
__device__ __forceinline__ void pv_d0(f32x16* o, int vb, bf16x8 pa0, bf16x8 pa1, bf16x8 pa2, bf16x8 pa3) {
    pv_one<0>(o[0], vb, pa0, pa1, pa2, pa3); pv_one<1>(o[1], vb, pa0, pa1, pa2, pa3); pv_one<2>(o[2], vb, pa0, pa1, pa2, pa3); pv_one<3>(o[3], vb, pa0, pa1, pa2, pa3);
}
__device__ __forceinline__ bf16x8 ld8(const bf16_t* p) { return *reinterpret_cast<const bf16x8*>(p); }

template <int DQ, int SD>
__device__ __forceinline__ void attn_body(const bf16_t* __restrict__ Qb, int ldq, const bf16_t* __restrict__ Kn, int ldkn, const bf16_t* __restrict__ Kr, int ldkr,
                                          const bf16_t* __restrict__ Vh, int ldv, bf16_t* __restrict__ Ob, int ldo, int seq, bool rope_q, int pos0, const float* __restrict__ tabM, char* lds, const int tid) {
    using CF = Cf<DQ>; constexpr int ND0 = CF::ND0, SHM_V = CF::SHM_V, SHM_K = CF::SHM_K;
    const int wid = tid >> 6, lane = tid & 63, r32 = lane & 31, hi = lane >> 5;
    char* V_lds = lds; char* K_lds = lds + 2 * SHM_V;
    float* ws = (float*)(lds + 2 * SHM_V + 2 * SHM_K) + wid * 64; float* li_l = ws; float* al_l = ws + 32;
    constexpr int NQR = DQ == 192 ? MLA_NQR : 8;
    float m_reg = -1e30f, l_reg = 0; f32x16 o[4] = {}; bf16x8 qr[NQR];
    const bf16_t* Qw = Qb + (long)(wid * QBLK + r32) * ldq + hi * 8;
#pragma unroll
    for (int d0 = 0; d0 < NQR; ++d0) qr[d0] = ld8(Qw + d0 * 16);
    char* qx = lds + CF::SHM + wid * 8192 + lane * 16;
    if constexpr (DQ == 192) {
#pragma unroll
        for (int d0 = NQR; d0 < 8; ++d0) *(bf16x8*)(qx + (d0 - NQR) * 1024) = ld8(Qw + d0 * 16);
        bf16x8 qe[4];
#pragma unroll
        for (int d0 = 0; d0 < 4; ++d0) qe[d0] = ld8(Qw + (8 + d0) * 16);
        if (rope_q) {
            const int pos = pos0 + wid * QBLK + r32, ri = pos >> 6, ci = pos & 63;
#pragma unroll
            for (int t = 0; t < 2; ++t) { const int p = t == 0 ? ri : ci; const float* tc = tabM + p * 16 + hi * 8; const float* tsn = tabM + 128 * 16 + p * 16 + hi * 8;
                bf16x8 a = qe[t], b = qe[2 + t];
#pragma unroll
                for (int jj = 0; jj < 8; ++jj) { const float x1 = bf2f((bf16_t)a[jj]), x2 = bf2f((bf16_t)b[jj]), c = tc[jj], s = tsn[jj];
                    a[jj] = (short)f2bf(x1 * c - x2 * s); b[jj] = (short)f2bf(x2 * c + x1 * s); }
                qe[t] = a; qe[2 + t] = b; }
        }
#pragma unroll
        for (int d0 = 0; d0 < 4; ++d0) *(bf16x8*)(qx + (8 - NQR + d0) * 1024) = qe[d0];
    }
    const int sr = tid >> 4, sc = (tid & 15) * 8, vst0 = v_st(sr, sc), vst1 = v_st(32 + sr, sc);
    const int sr2 = tid >> 3, sc2 = (tid & 7) * 8;
    const int vb0 = (int)(uintptr_t)V_lds + v_rd_base(lane);
    struct { bf16x8 vs0, vs1, ks0, ks1, ks2; } sr_[SD];
    const unsigned offV = (unsigned)(sr * ldv + sc) * 2u, offK = (unsigned)(sr * ldkn + sc) * 2u, offR = (unsigned)(sr2 * ldkr + sc2) * 2u;
#define SLOAD(i, k0) do { const char* vt_ = (const char*)Vh + (size_t)(k0) * ldv * 2; const char* kt_ = (const char*)Kn + (size_t)(k0) * ldkn * 2; \
    sr_[i].vs0 = *(const bf16x8*)(vt_ + offV); sr_[i].vs1 = *(const bf16x8*)(vt_ + (size_t)32 * ldv * 2 + offV); \
    sr_[i].ks0 = *(const bf16x8*)(kt_ + offK); sr_[i].ks1 = *(const bf16x8*)(kt_ + (size_t)32 * ldkn * 2 + offK); \
    if constexpr (DQ == 192) sr_[i].ks2 = *(const bf16x8*)((const char*)Kr + (size_t)(k0) * ldkr * 2 + offR); } while (0)
#define SWRITE(b, i) do { *(bf16x8*)(V_lds + (b) * SHM_V + vst0) = sr_[i].vs0; *(bf16x8*)(V_lds + (b) * SHM_V + vst1) = sr_[i].vs1; const int kc = sc * 2; \
    *(bf16x8*)(K_lds + (b) * SHM_K + CF::kswz(sr, kc)) = sr_[i].ks0; *(bf16x8*)(K_lds + (b) * SHM_K + CF::kswz(32 + sr, kc)) = sr_[i].ks1; \
    if constexpr (DQ == 192) *(bf16x8*)(K_lds + (b) * SHM_K + CF::kswz(sr2, 256 + sc2 * 2)) = sr_[i].ks2; } while (0)
#define SWAIT() do { if constexpr (SD == 1) asm volatile("s_waitcnt vmcnt(0)" ::: "memory"); else if constexpr (DQ == 192) asm volatile("s_waitcnt vmcnt(5)" ::: "memory"); else asm volatile("s_waitcnt vmcnt(4)" ::: "memory"); } while (0)
#define RESC(a) do { if (__any((a) < 1.f)) { if (hi == 0) al_l[r32] = (a); asm volatile("s_waitcnt lgkmcnt(0)" ::: "memory"); \
    _Pragma("unroll") for (int d = 0; d < 4; ++d) _Pragma("unroll") for (int r = 0; r < 16; ++r) o[d][r] *= al_l[crow(r, hi)]; } } while (0)
    f32x16 pA0, pA1, pB0, pB1; float mnA, mnB, alA, alB; bf16x8 pa0, pa1, pa2, pa3; const int NT = seq / KVBLK;
    constexpr int SE = 0, SO = SD - 1;
    SLOAD(SE, 0); asm volatile("s_waitcnt vmcnt(0)" ::: "memory"); SWRITE(0, SE); __syncthreads();
    qkt<DQ>(pA0, pA1, K_lds, qr, qx, r32, hi); partialSM<DQ>(pA0, pA1, m_reg, mnA, alA);
    SLOAD(SO, KVBLK); if constexpr (SD == 2) { if (2 < NT) SLOAD(SE, 2 * KVBLK); }
    SWAIT(); SWRITE(1, SO); __syncthreads();
    for (int j = 1; j + 1 < NT; j += 2) {
        SBAR(); qkt<DQ>(pB0, pB1, K_lds + SHM_K, qr, qx, r32, hi);
        finishSM(pA0, pA1, alA, l_reg, pa0, pa1, pa2, pa3); SBAR();
        SLOAD(SO, (j + SD) * KVBLK); SBAR();
        pv_d0(o, vb0, pa0, pa1, pa2, pa3); partialSM<DQ>(pB0, pB1, m_reg, mnB, alB);
        __syncthreads(); SWAIT(); SWRITE(0, SE);
        RESC(alB); __syncthreads();
        SBAR(); qkt<DQ>(pA0, pA1, K_lds, qr, qx, r32, hi);
        finishSM(pB0, pB1, alB, l_reg, pa0, pa1, pa2, pa3); SBAR();
        if (SD == 1 || j + 3 < NT) SLOAD(SE, (j + 1 + SD) * KVBLK); SBAR();
        pv_d0(o, vb0 + SHM_V, pa0, pa1, pa2, pa3); partialSM<DQ>(pA0, pA1, m_reg, mnA, alA);
        __syncthreads(); SWAIT(); SWRITE(1, SO);
        RESC(alA); __syncthreads();
    }
    SBAR(); qkt<DQ>(pB0, pB1, K_lds + SHM_K, qr, qx, r32, hi);
    finishSM(pA0, pA1, alA, l_reg, pa0, pa1, pa2, pa3); SBAR();
    pv_d0(o, vb0, pa0, pa1, pa2, pa3); partialSM<DQ>(pB0, pB1, m_reg, mnB, alB);
    __syncthreads(); RESC(alB);
    finishSM(pB0, pB1, alB, l_reg, pa0, pa1, pa2, pa3); SBAR();
    pv_d0(o, vb0 + SHM_V, pa0, pa1, pa2, pa3);
    if (hi == 0) li_l[r32] = l_reg; asm volatile("s_waitcnt lgkmcnt(0)" ::: "memory");
    float rli[16];
#pragma unroll
    for (int r = 0; r < 16; ++r) rli[r] = __builtin_amdgcn_rcpf(li_l[crow(r, hi)]);
    bf16_t* Ow = Ob + (long)(wid * QBLK) * ldo;
#pragma unroll
    for (int r = 0; r < 16; ++r) { const int orow = crow(r, hi);
#pragma unroll
        for (int d0 = 0; d0 < 4; ++d0) Ow[(long)orow * ldo + d0 * 32 + r32] = f2bf(o[d0][r] * rli[r]); }
#undef SLOAD
#undef SWRITE
#undef SWAIT
#undef RESC
}
}

template <int KS> __device__ __forceinline__ void mma_xy(f32x16& acc, const LAS bf16_t* X, const LAS bf16_t* Y, int hi) {
#pragma unroll
    for (int ks = 0; ks < KS; ++ks) { const bf16x8 a = *(const LAS bf16x8*)(X + ks * 16 + hi * 8), b = *(const LAS bf16x8*)(Y + ks * 16 + hi * 8);
        acc = __builtin_amdgcn_mfma_f32_32x32x16_bf16(a, b, acc, 0, 0, 0); }
}
__device__ __forceinline__ float logsig16(float x) { const float e = __expf(-fabsf(x)); return (fminf(x, 0.f) - __logf(1.f + e)) * 0.0625f; }
__device__ __forceinline__ int gla_sidx(int b, int dir, int h) { return (b * 2 + dir) * 4 + h; }

__device__ __forceinline__ void gla_cumsum_lds(const Ctx& C, int l, int h, int dir, const LAS float* lr, LAS float* segtot, LAS float* CUM) {
    const int seg = C.tid >> 7, d = C.tid & 127;
    const float* wa = INP(dir ? I_WA2B : I_WA2F) + (size_t)l * 16 * 512 + h * 128 + d;
    const float bias = INP(dir ? I_BAB : I_BAF)[l * 512 + h * 128 + d];
    float w[16], cum[16];
#pragma unroll
    for (int j = 0; j < 16; ++j) w[j] = wa[j * 512];
    float run = 0.f;
#pragma unroll
    for (int i = 0; i < 16; ++i) { const int s = seg * 16 + i, tk = dir ? 63 - s : s; float pre = bias;
#pragma unroll
        for (int j = 0; j < 16; ++j) pre += lr[tk * 32 + dir * 16 + j] * w[j];
        run += logsig16(pre); cum[i] = run; }
    segtot[seg * 128 + d] = run;
    __syncthreads();
    float off = 0.f;
#pragma unroll
    for (int q = 0; q < 3; ++q) if (q < seg) off += segtot[q * 128 + d];
#pragma unroll
    for (int i = 0; i < 16; ++i) { const int s = seg * 16 + i, tk = dir ? 63 - s : s; CUM[tk * 132 + d] = cum[i] + off; }
    __syncthreads();
}
__device__ __forceinline__ void unpack8(const u32x4 w, float (&x)[8]) { x[0] = bflo(w.x); x[1] = bfhi(w.x); x[2] = bflo(w.y); x[3] = bfhi(w.y); x[4] = bflo(w.z); x[5] = bfhi(w.z); x[6] = bflo(w.w); x[7] = bfhi(w.w); }
__device__ __forceinline__ void gla_build_vt(const Ctx& C, const bf16_t* P, size_t r0, int h, LAS bf16_t* VT) {
    u32x4 v[4];
#pragma unroll
    for (int it = 0; it < 4; ++it) { const int idx = C.tid + it * NTHREADS, sv = idx >> 5, e0 = (idx & 31) * 8; v[it] = *(const u32x4*)(P + (r0 + sv) * NP + C_LV + h * 256 + e0); }
#pragma unroll
    for (int it = 0; it < 4; ++it) { const int idx = C.tid + it * NTHREADS, sv = idx >> 5, e0 = (idx & 31) * 8;
        const unsigned wd[4] = {v[it].x, v[it].y, v[it].z, v[it].w};
#pragma unroll
        for (int q = 0; q < 4; ++q) { VT[(e0 + 2 * q) * 72 + sv] = (bf16_t)(wd[q] & 0xffffu); VT[(e0 + 2 * q + 1) * 72 + sv] = (bf16_t)(wd[q] >> 16); } }
}

__device__ __forceinline__ void phase_gla_local(const Ctx& C, int l) {
    const bf16_t* P = WSP(bf16_t, WS_P); bf16_t* GST = WSP(bf16_t, WS_GST); float* GDEC = WSP(float, WS_GDEC);
    LAS float* lr = (LAS float*)C.lds;
    LAS float* segtot = (LAS float*)(C.lds + 8192);
    LAS bf16_t* KT = (LAS bf16_t*)(C.lds + 10240);
    LAS bf16_t* VT = (LAS bf16_t*)(C.lds + 28672);
    LAS float* CUM = (LAS float*)(C.lds + 65536);
    const int r32 = C.lane & 31, hi = C.lane >> 5, d = C.tid & 127;
    const int btk = C.tid >> 3, bdg = (C.tid & 7) * 16;
    for (int unit = C.bid; unit < NBATCH * 4 * NCH; unit += C.G) {
        const int b = unit / (4 * NCH), h = (unit / NCH) % 4, ck = unit % NCH; const size_t r0 = (size_t)b * RPB + ck * 64;
        for (int i = C.tid; i < 64 * 32; i += NTHREADS) lr[i] = bf2f(P[(r0 + (i >> 5)) * NP + C_LRF + (i & 31)]);
        const u32x4 kw0 = *(const u32x4*)(P + (r0 + btk) * NP + C_LK + h * 128 + bdg), kw1 = *(const u32x4*)(P + (r0 + btk) * NP + C_LK + h * 128 + bdg + 8);
        gla_build_vt(C, P, r0, h, VT);
        __syncthreads();
#pragma unroll 1
        for (int dir = 0; dir < 2; ++dir) {
            gla_cumsum_lds(C, l, h, dir, lr, segtot, CUM);
            const int tend = dir ? 0 : 63;
            const size_t sx = (size_t)gla_sidx(b, dir, h) * NCH + ck;
            if (C.tid < 128) GDEC[sx * 128 + d] = __expf(CUM[tend * 132 + d]);
            { float kf[16]; { float t8[8]; unpack8(kw0, t8);
#pragma unroll
                for (int i = 0; i < 8; ++i) kf[i] = t8[i]; unpack8(kw1, t8);
#pragma unroll
                for (int i = 0; i < 8; ++i) kf[8 + i] = t8[i]; }
#pragma unroll
              for (int q = 0; q < 4; ++q) { const f32x4 cm = *(const LAS f32x4*)(CUM + btk * 132 + bdg + 4 * q), be = *(const LAS f32x4*)(CUM + tend * 132 + bdg + 4 * q);
#pragma unroll
                  for (int i = 0; i < 4; ++i) KT[(bdg + 4 * q + i) * 72 + btk] = f2bf(kf[4 * q + i] * __expf(be[i] - cm[i])); } }
            __syncthreads();
            { const int dt = C.wid & 3, eb = (C.wid >> 2) * 4;
              f32x16 acc[4] = {};
#pragma unroll
              for (int q = 0; q < 4; ++q) mma_xy<4>(acc[q], KT + (dt * 32 + r32) * 72, VT + ((eb + q) * 32 + r32) * 72, hi);
              bf16_t* st = GST + sx * 32768;
#pragma unroll
              for (int q = 0; q < 4; ++q)
#pragma unroll
                  for (int g = 0; g < 4; ++g) { u32x2 w; w.x = cvt_pk_bf16(acc[q][4 * g], acc[q][4 * g + 1]); w.y = cvt_pk_bf16(acc[q][4 * g + 2], acc[q][4 * g + 3]);
                      *(u32x2*)(st + (size_t)((eb + q) * 32 + r32) * 128 + dt * 32 + 8 * g + 4 * hi) = w; } }
            __syncthreads();
        }
    }
}

__device__ __forceinline__ void phase_gla_scan(const Ctx& C) {
    bf16_t* GST = WSP(bf16_t, WS_GST); const float* GDEC = WSP(float, WS_GDEC);
    for (int gid = C.bid * NTHREADS + C.tid; gid < 16 * 8192; gid += C.G * NTHREADS) {
        const int sidx = gid >> 13, g = gid & 8191, dir = (sidx >> 2) & 1, d4 = (g & 31) * 4;
        bf16_t* base = GST + (size_t)sidx * NCH * 32768 + (size_t)g * 4;
        const float* dbase = GDEC + (size_t)sidx * NCH * 128 + d4;
        float S[4] = {0.f, 0.f, 0.f, 0.f};
        for (int st = 0; st < NCH; st += 4) {
            int ck[4]; u32x2 L[4]; f32x4 dc[4];
#pragma unroll
            for (int q = 0; q < 4; ++q) { const int s = st + q; ck[q] = dir ? (s < 4 ? 3 - s : NCH + 3 - s) : s;
                L[q] = *(const u32x2*)(base + (size_t)ck[q] * 32768); dc[q] = *(const f32x4*)(dbase + (size_t)ck[q] * 128); }
#pragma unroll
            for (int q = 0; q < 4; ++q) { u32x2 w; w.x = cvt_pk_bf16(S[0], S[1]); w.y = cvt_pk_bf16(S[2], S[3]);
                *(u32x2*)(base + (size_t)ck[q] * 32768) = w;
                S[0] = dc[q][0] * S[0] + bflo(L[q].x); S[1] = dc[q][1] * S[1] + bfhi(L[q].x); S[2] = dc[q][2] * S[2] + bflo(L[q].y); S[3] = dc[q][3] * S[3] + bfhi(L[q].y); }
        }
    }
}

__device__ __forceinline__ void phase_gla_out(const Ctx& C, int l) {
    const bf16_t* P = WSP(bf16_t, WS_P); const bf16_t* GST = WSP(bf16_t, WS_GST); bf16_t* OL = WSP(bf16_t, WS_OL);
    LAS float* lr = (LAS float*)C.lds;
    LAS float* segtot = (LAS float*)(C.lds + 8192);
    LAS bf16_t* QT = (LAS bf16_t*)(C.lds + 10240);
    LAS bf16_t* KT = (LAS bf16_t*)(C.lds + 27648);
    LAS bf16_t* VT = (LAS bf16_t*)(C.lds + 45056);
    LAS bf16_t* SCm = (LAS bf16_t*)(C.lds + 81920);
    LAS float* OB = (LAS float*)(C.lds + 91136);
    LAS float* CUM = OB;
    const float* gon = INP(I_ONG) + l * 256;
    const int r32 = C.lane & 31, hi = C.lane >> 5;
    const int btk = C.tid >> 3, bdg = (C.tid & 7) * 16;
    for (int unit = C.bid; unit < NBATCH * 4 * NCH; unit += C.G) {
        const int b = unit / (4 * NCH), h = (unit / NCH) % 4, ck = unit % NCH; const size_t r0 = (size_t)b * RPB + ck * 64;
        for (int i = C.tid; i < 64 * 32; i += NTHREADS) lr[i] = bf2f(P[(r0 + (i >> 5)) * NP + C_LRF + (i & 31)]);
        const bf16_t* qp = P + (r0 + btk) * NP + C_LQ + h * 128 + bdg; const bf16_t* kp = P + (r0 + btk) * NP + C_LK + h * 128 + bdg;
        const u32x4 qw0 = *(const u32x4*)qp, qw1 = *(const u32x4*)(qp + 8), kw0 = *(const u32x4*)kp, kw1 = *(const u32x4*)(kp + 8);
        gla_build_vt(C, P, r0, h, VT);
        __syncthreads();
        f32x16 oacc[2] = {};
#pragma unroll 1
        for (int dir = 0; dir < 2; ++dir) {
            gla_cumsum_lds(C, l, h, dir, lr, segtot, CUM);
            { float qf[8], kf[8];
#pragma unroll
              for (int hh = 0; hh < 2; ++hh) { unpack8(hh ? qw1 : qw0, qf); unpack8(hh ? kw1 : kw0, kf);
                  const f32x4 c0 = *(const LAS f32x4*)(CUM + btk * 132 + bdg + 8 * hh), c1 = *(const LAS f32x4*)(CUM + btk * 132 + bdg + 8 * hh + 4);
                  float qo[8], ko[8];
#pragma unroll
                  for (int i = 0; i < 8; ++i) { const float cm = i < 4 ? c0[i & 3] : c1[i & 3]; qo[i] = qf[i] * __expf(cm) * 0.088388347648318440f; ko[i] = kf[i] * __expf(-cm); }
                  u32x4 wq, wk; wq.x = cvt_pk_bf16(qo[0], qo[1]); wq.y = cvt_pk_bf16(qo[2], qo[3]); wq.z = cvt_pk_bf16(qo[4], qo[5]); wq.w = cvt_pk_bf16(qo[6], qo[7]);
                  wk.x = cvt_pk_bf16(ko[0], ko[1]); wk.y = cvt_pk_bf16(ko[2], ko[3]); wk.z = cvt_pk_bf16(ko[4], ko[5]); wk.w = cvt_pk_bf16(ko[6], ko[7]);
                  *(LAS u32x4*)(QT + btk * 136 + bdg + 8 * hh) = wq; *(LAS u32x4*)(KT + btk * 136 + bdg + 8 * hh) = wk; } }
            __syncthreads();
            if (C.wid < 4) { const int mt = C.wid >> 1, nt = C.wid & 1; f32x16 sc = {};
                mma_xy<8>(sc, QT + (mt * 32 + r32) * 136, KT + (nt * 32 + r32) * 136, hi);
#pragma unroll
                for (int i = 0; i < 16; ++i) { const int t = mt * 32 + att::crow(i, hi), sx_ = nt * 32 + r32; const bool keep = dir ? (sx_ >= t) : (sx_ <= t);
                    SCm[t * 72 + sx_] = f2bf(keep ? sc[i] : 0.f); } }
            __syncthreads();
            { const bf16_t* st = GST + ((size_t)gla_sidx(b, dir, h) * NCH + ck) * 32768 + (size_t)(C.wid * 32 + r32) * 128 + hi * 8;
              bf16x8 sb[8];
#pragma unroll
              for (int ks = 0; ks < 8; ++ks) sb[ks] = *(const bf16x8*)(st + ks * 16);
#pragma unroll
              for (int mt = 0; mt < 2; ++mt) {
                  mma_xy<4>(oacc[mt], SCm + (mt * 32 + r32) * 72, VT + (C.wid * 32 + r32) * 72, hi);
#pragma unroll
                  for (int ks = 0; ks < 8; ++ks) { const bf16x8 a = *(const LAS bf16x8*)(QT + (mt * 32 + r32) * 136 + ks * 16 + hi * 8);
                      oacc[mt] = __builtin_amdgcn_mfma_f32_32x32x16_bf16(a, sb[ks], oacc[mt], 0, 0, 0); } } }
            __syncthreads();
        }
#pragma unroll
        for (int mt = 0; mt < 2; ++mt)
#pragma unroll
            for (int i = 0; i < 16; ++i) OB[(mt * 32 + att::crow(i, hi)) * 260 + C.wid * 32 + r32] = oacc[mt][i];
        __syncthreads();
        { const int t = C.tid >> 3, part = C.tid & 7; f32x4 v[8]; float ss = 0.f;
#pragma unroll
          for (int jj = 0; jj < 8; ++jj) { v[jj] = *(const LAS f32x4*)(OB + t * 260 + jj * 32 + part * 4); ss += v[jj][0] * v[jj][0] + v[jj][1] * v[jj][1] + v[jj][2] * v[jj][2] + v[jj][3] * v[jj][3]; }
          ss += dppmov<DPP_HMIRROR>(ss); ss += dppmov<DPP_Q3210>(ss); ss += dppmov<DPP_Q1032>(ss);
          const float rs = rsqrtf(ss * (1.0f / 256.0f) + NORM_EPS);
#pragma unroll
          for (int jj = 0; jj < 8; ++jj) { const int e = jj * 32 + part * 4; const f32x4 g = *(const f32x4*)(gon + e);
              const u32x2 gt = *(const u32x2*)(P + (r0 + t) * NP + C_LG + h * 256 + e);
              const float o0 = v[jj][0] * rs * g[0] * siluf_(bflo(gt.x)), o1 = v[jj][1] * rs * g[1] * siluf_(bfhi(gt.x)), o2 = v[jj][2] * rs * g[2] * siluf_(bflo(gt.y)), o3 = v[jj][3] * rs * g[3] * siluf_(bfhi(gt.y));
              u32x2 w; w.x = cvt_pk_bf16(o0, o1); w.y = cvt_pk_bf16(o2, o3);
              *(u32x2*)(OL + (r0 + t) * 1024 + h * 256 + e) = w; } }
        __syncthreads();
    }
}

__device__ __forceinline__ unsigned f_ord(float f) { const unsigned u = __float_as_uint(f); return u ^ ((unsigned)((int)u >> 31) | 0x80000000u); }
__device__ __forceinline__ float f_unord(unsigned k) { return __uint_as_float((k & 0x80000000u) ? (k ^ 0x80000000u) : ~k); }
__device__ __forceinline__ void ins_u(unsigned (&L)[16], unsigned x) {
#pragma unroll
    for (int j = 0; j < 16; ++j) { const unsigned h = L[j] > x ? L[j] : x; x = L[j] > x ? x : L[j]; L[j] = h; }
}
__device__ __forceinline__ void ins_f(float (&M)[16], float x) {
#pragma unroll
    for (int j = 0; j < 16; ++j) { const float h = M[j] > x ? M[j] : x; x = M[j] > x ? x : M[j]; M[j] = h; }
}
__device__ __forceinline__ void peer_top16(const bf16_t* __restrict__ qrow, const bf16_t* __restrict__ keys, int r32, int hi, unsigned (&L)[16]) {
    bf16x8 qf[8];
#pragma unroll
    for (int kk = 0; kk < 8; ++kk) qf[kk] = *(const bf16x8*)(qrow + kk * 16 + hi * 8);
#pragma unroll
    for (int j = 0; j < 16; ++j) L[j] = 0u;
    bf16x8 kA[8], kB[8];
    const bf16_t* kl = keys + (size_t)r32 * 128 + hi * 8;
#define PT_LDK(dst, mt) do { _Pragma("unroll") for (int kk = 0; kk < 8; ++kk) dst[kk] = *(const bf16x8*)(kl + (mt) * 32 * 128 + kk * 16); } while (0)
#define PT_PROC(src, mt) do { f32x16 acc = {}; \
        _Pragma("unroll") for (int kk = 0; kk < 8; ++kk) acc = __builtin_amdgcn_mfma_f32_32x32x16_bf16(src[kk], qf[kk], acc, 0, 0, 0); \
        _Pragma("unroll") for (int i = 0; i < 16; ++i) { const unsigned kidx = (unsigned)((mt) * 32 + att::crow(i, hi)); ins_u(L, (f_ord(acc[i]) & ~127u) | (127u - kidx)); } } while (0)
    PT_LDK(kA, 0);
#pragma unroll 1
    for (int mp = 0; mp < 2; ++mp) { PT_LDK(kB, 2 * mp + 1); PT_PROC(kA, 2 * mp); if (mp == 0) PT_LDK(kA, 2); PT_PROC(kB, 2 * mp + 1); }
#undef PT_LDK
#undef PT_PROC
    unsigned Pn[16];
#pragma unroll
    for (int j = 0; j < 16; ++j) { auto r_ = __builtin_amdgcn_permlane32_swap(L[j], L[j], false, false); Pn[j] = hi ? r_[0] : r_[1]; }
#pragma unroll
    for (int j = 0; j < 16; ++j) ins_u(L, Pn[j]);
}
__device__ __forceinline__ void phase_peer_select(const Ctx& C, const bool latent_only) {
    const bf16_t* PQ = WSP(bf16_t, WS_PQ); const bf16_t* K1 = WSP(bf16_t, WS_K1); const bf16_t* K2 = WSP(bf16_t, WS_K2);
    int* PIDX = WSP(int, WS_PIDX); float* PG = WSP(float, WS_PG);
    const int r32 = C.lane & 31, hi = C.lane >> 5, head = C.wid;
    const int ngrp = latent_only ? NBATCH * SEQ / 32 : TT / 32;
    for (int gi = C.bid; gi < ngrp; gi += C.G) {
        const int grp = latent_only ? gi + (CTXL / 32) * (1 + gi / (SEQ / 32)) : gi;
        const size_t tok = (size_t)grp * 32 + r32;
        unsigned L1[16], L2[16];
        peer_top16(PQ + tok * DM + head * 256, K1 + (size_t)head * 128 * 128, r32, hi, L1);
        peer_top16(PQ + tok * DM + head * 256 + 128, K2 + (size_t)head * 128 * 128, r32, hi, L2);
        float v1[16], v2[16];
#pragma unroll
        for (int j = 0; j < 16; ++j) { v1[j] = f_unord(L1[j] & ~127u); v2[j] = f_unord(L2[j] & ~127u); }
        float M[16];
#pragma unroll
        for (int j = 0; j < 16; ++j) M[j] = -3.0e38f;
#pragma unroll
        for (int a = 0; a < 16; ++a)
#pragma unroll
            for (int b = 0; b < 16; ++b) if ((a + 1) * (b + 1) <= 16) ins_f(M, v1[a] + v2[b]);
        const float thr = M[15], mx = M[0]; float den = 0.f;
#pragma unroll
        for (int j = 0; j < 16; ++j) den += __expf(M[j] - mx);
        const float rden = 1.0f / den;
        int pos = 0; int* ip = PIDX + tok * 128 + head * 16; float* gp = PG + tok * 128 + head * 16;
#pragma unroll
        for (int a = 0; a < 16; ++a)
#pragma unroll
            for (int b = 0; b < 16; ++b) if ((a + 1) * (b + 1) <= 16) {
                const float val = v1[a] + v2[b];
                if (val >= thr && pos < 16) { if (hi == 0) { ip[pos] = (int)((127u - (L1[a] & 127u)) * 128u + (127u - (L2[b] & 127u))); gp[pos] = __expf(val - mx) * rden; } ++pos; } }
    }
}
template <int OFF> __device__ __forceinline__ float dotf8(const float (&h)[32], const u32x4 w, float acc) {
#pragma unroll
    for (int j = 0; j < 4; ++j) { const f32x2 lo = __builtin_amdgcn_cvt_pk_f32_fp8((int)w[j], false), hi = __builtin_amdgcn_cvt_pk_f32_fp8((int)w[j], true);
        acc += h[OFF + 4 * j] * lo.x; acc += h[OFF + 4 * j + 1] * lo.y; acc += h[OFF + 4 * j + 2] * hi.x; acc += h[OFF + 4 * j + 3] * hi.y; }
    return acc;
}
constexpr int GT_MAXTOK = 9;
template <bool LAST> __device__ __forceinline__ void phase_peer_gather(const Ctx& C, const float* modl, const float pscale) {
    const unsigned char* pt = C.ws + WS_PT + (size_t)(LAST ? DEPTH - 1 : 0) * PT_BYTES;
    const bf16_t* HB = WSP(bf16_t, WS_HB); const unsigned char* U8 = pt + PT_U8; const unsigned char* V8 = pt + PT_V8;
    const float* SCU = (const float*)(pt + PT_SCU); const float* SCV = (const float*)(pt + PT_SCV);
    const int* PIDX = WSP(int, WS_PIDX); const float* PG = WSP(float, WS_PG); float* XS = WSP(float, WS_XS);
    const int lane = C.lane, s = lane >> 3, j = lane & 7; const unsigned j16 = (unsigned)j * 16u;
    LAS int* IDS = (LAS int*)(C.lds + C.wid * (GT_MAXTOK * 512));
    LAS float* ACT = (LAS float*)(C.lds + 8 * GT_MAXTOK * 512 + C.wid * (GT_MAXTOK * 512));
    LAS int* ROWS = (LAS int*)(C.lds + 16 * GT_MAXTOK * 512 + C.wid * 64);
    int nk = 0;
    {
      const int per = (TT + C.G - 1) / C.G, base = C.bid * per;
#pragma unroll 1
      for (int k = 0; k < GT_MAXTOK; ++k) { const int o = C.wid + 8 * k; const int r = base + o; if (o < per && r < TT && !(LAST && (r % RPB) < CTXL)) { if (lane == 0) ROWS[nk] = r; ++nk; } } }
#define GT_ROW(k) __builtin_amdgcn_readfirstlane(ROWS[k])
#pragma unroll 1
    for (int k = 0; k < nk; ++k) { const int r = GT_ROW(k);
        IDS[k * 128 + lane] = (PIDX[(size_t)r * 128 + lane] & (NEXP - 1)) << 7; IDS[k * 128 + 64 + lane] = (PIDX[(size_t)r * 128 + 64 + lane] & (NEXP - 1)) << 7;
        ACT[k * 128 + lane] = 0.f; ACT[k * 128 + 64 + lane] = 0.f; }
    const int nit = 32 * nk;
#define GT_ITEM(it_) const int cb_ = (it_) / (2 * nk), rem_ = (it_) - cb_ * (2 * nk), k_ = rem_ >> 1, hf_ = rem_ & 1
#define GT_LOADU(UQ, HQ, it_) do { GT_ITEM(it_); const int r_ = GT_ROW(k_); \
        const bf16_t* hp_ = HB + (size_t)r_ * DM + cb_ * 128 + j * 16; HQ[0] = *(const u32x4*)hp_; HQ[1] = *(const u32x4*)(hp_ + 8); \
        const unsigned char* ub_ = U8 + (size_t)cb_ * ((size_t)NEXP * 128);     \
        _Pragma("unroll") for (int eg = 0; eg < 8; ++eg) { const unsigned off_ = ((unsigned)IDS[k_ * 128 + (hf_ * 8 + eg) * 8 + s] & idmask) + j16; UQ[eg] = *(const u32x4*)(ub_ + off_); } } while (0)
#define GT_COMPU(UQ, HQ, it_) do { GT_ITEM(it_); (void)cb_; f32x2 hf2[8]; \
        _Pragma("unroll") for (int hh = 0; hh < 2; ++hh) { const u32x4 w_ = HQ[hh]; \
            hf2[hh * 4 + 0] = (f32x2){bflo(w_.x), bfhi(w_.x)}; hf2[hh * 4 + 1] = (f32x2){bflo(w_.y), bfhi(w_.y)}; hf2[hh * 4 + 2] = (f32x2){bflo(w_.z), bfhi(w_.z)}; hf2[hh * 4 + 3] = (f32x2){bflo(w_.w), bfhi(w_.w)}; } \
        float d[8]; \
        _Pragma("unroll") for (int eg = 0; eg < 8; ++eg) { f32x2 d2 = (f32x2){0.f, 0.f}; \
            _Pragma("unroll") for (int q = 0; q < 4; ++q) { const f32x2 lo = __builtin_amdgcn_cvt_pk_f32_fp8((int)UQ[eg][q], false), hi = __builtin_amdgcn_cvt_pk_f32_fp8((int)UQ[eg][q], true); \
                d2 += hf2[2 * q] * lo; d2 += hf2[2 * q + 1] * hi; } \
            d[eg] = d2.x + d2.y; } \
          \
        float t4[4], t2[2], t1; \
        _Pragma("unroll") for (int i = 0; i < 4; ++i) { const float snd = (j & 4) ? d[i] : d[i + 4], kp = (j & 4) ? d[i + 4] : d[i]; t4[i] = kp + dppmov<DPP_HMIRROR>(snd); } \
        _Pragma("unroll") for (int i = 0; i < 2; ++i) { const float snd = (j & 2) ? t4[i] : t4[i + 2], kp = (j & 2) ? t4[i + 2] : t4[i]; t2[i] = kp + dppmov<DPP_Q3210>(snd); } \
        { const float snd = (j & 1) ? t2[0] : t2[1], kp = (j & 1) ? t2[1] : t2[0]; t1 = kp + dppmov<DPP_Q1032>(snd); } \
        ACT[k_ * 128 + (hf_ * 8 + j) * 8 + s] += t1; } while (0)
#ifdef DBG_GDUP
#pragma unroll 1
    for (int rep_ = 0; rep_ < 2; ++rep_) {
    const unsigned idmask = rep_ == 0 ? ((unsigned)DBG_GMASK << 7 | 127u) : 0xffffffffu;
    if (rep_ == 1) { for (int k = 0; k < nk; ++k) { ACT[k * 128 + lane] = 0.f; ACT[k * 128 + 64 + lane] = 0.f; } }
#else
    { const unsigned idmask = 0xffffffffu;
#endif
    if (nit > 0) {
        u32x4 uA[8], uB[8], hA[2], hB[2];
        GT_LOADU(uA, hA, 0);
#pragma unroll 1
        for (int it = 0; it < nit; it += 2) {
            GT_LOADU(uB, hB, it + 1);
            GT_COMPU(uA, hA, it);
            if (it + 2 < nit) GT_LOADU(uA, hA, it + 2);
            GT_COMPU(uB, hB, it + 1);
        }
    }
    }
#undef GT_LOADU
#undef GT_COMPU
#pragma unroll 1
    for (int k = 0; k < nk; ++k) { const int r = GT_ROW(k);
#pragma unroll
        for (int hh = 0; hh < 2; ++hh) { const int e = hh * 64 + lane; const int id = IDS[k * 128 + e] >> 7; const float a = ACT[k * 128 + e] * SCU[id];
            const float w = PG[(size_t)r * 128 + e] * 0.5f * a * (1.0f + erff(a * 0.70710678118654752f));
#ifdef DBG_CHECK
            if (((r - 300) & 63) == 0 && r >= 300 && r < 300 + 64 * 128) WSP(float, WS_OM)[(size_t)r * 128 + e] = w;
#endif
            ACT[k * 128 + e] = w * SCV[id]; } }
#define GT_LOADV(VQ, WV, it_) do { GT_ITEM(it_); const unsigned char* vb_ = V8 + (size_t)cb_ * ((size_t)NEXP * 128); \
        _Pragma("unroll") for (int eg = 0; eg < 8; ++eg) { const int e_ = k_ * 128 + (hf_ * 8 + eg) * 8 + s; const unsigned off_ = (unsigned)IDS[e_] + j16; VQ[eg] = *(const u32x4*)(vb_ + off_); WV[eg] = ACT[e_]; } } while (0)
#define GT_COMPV(VQ, WV) do { \
        _Pragma("unroll") for (int eg = 0; eg < 8; ++eg) { const f32x2 w2_ = (f32x2){WV[eg], WV[eg]}; \
            _Pragma("unroll") for (int q = 0; q < 4; ++q) { \
                const f32x2 lo = __builtin_amdgcn_cvt_pk_f32_fp8((int)VQ[eg][q], false), hi = __builtin_amdgcn_cvt_pk_f32_fp8((int)VQ[eg][q], true); \
                acc2[2 * q] += w2_ * lo; acc2[2 * q + 1] += w2_ * hi; } } } while (0)
    if (nit > 0) {
        u32x4 vA[8], vB[8]; float wA[8], wB[8];
        GT_LOADV(vA, wA, 0);
#pragma unroll 1
        for (int it = 0; it < nit; it += 2) {
            f32x2 acc2[8];
#pragma unroll
            for (int i = 0; i < 8; ++i) acc2[i] = (f32x2){0.f, 0.f};
            GT_LOADV(vB, wB, it + 1);
            GT_COMPV(vA, wA);
            if (it + 2 < nit) GT_LOADV(vA, wA, it + 2);
            GT_COMPV(vB, wB);
            f32x2 t4[4], t2[2], t1;
#pragma unroll
            for (int i = 0; i < 4; ++i) { const f32x2 snd = (s & 4) ? acc2[i] : acc2[i + 4], kp = (s & 4) ? acc2[i + 4] : acc2[i];
                t4[i] = kp + (f32x2){xchg32(snd.x, lane), xchg32(snd.y, lane)}; }
#pragma unroll
            for (int i = 0; i < 2; ++i) { const f32x2 snd = (s & 2) ? t4[i] : t4[i + 2], kp = (s & 2) ? t4[i + 2] : t4[i];
                t2[i] = kp + (f32x2){xchg16(snd.x, lane), xchg16(snd.y, lane)}; }
            { const f32x2 snd = (s & 1) ? t2[0] : t2[1], kp = (s & 1) ? t2[1] : t2[0]; t1 = kp + (f32x2){dppmov<DPP_ROR8>(snd.x), dppmov<DPP_ROR8>(snd.y)}; }
            { GT_ITEM(it); (void)hf_; const int r_ = GT_ROW(k_);
              const int col = cb_ * 128 + j * 16 + 2 * s; float* xp = XS + (size_t)r_ * DM + col; const float* g2 = modl + (size_t)mod_sel(r_) * 12288 + 5 * DM + col;
#ifdef DBG_CHECK
              if (((r_ - 300) & 63) == 0 && r_ >= 300 && r_ < 300 + 64 * 128) { float* dbgo = WSP(float, WS_MQ) + (size_t)r_ * DM + col; dbgo[0] = t1.x; dbgo[1] = t1.y; }
#endif
              const f32x2 x = *(const f32x2*)xp, g = *(const f32x2*)g2;
              *(f32x2*)xp = x + pscale * g * t1; }
        }
    }
#undef GT_LOADV
#undef GT_COMPV
#undef GT_ITEM
#undef GT_ROW
}
__device__ __forceinline__ void phase_final_norm(const Ctx& C) {
    const float* XS = WSP(float, WS_XS); const float* fg = INP(I_FG);
    for (int q = C.bid * 8 + C.wid; q < NBATCH * SEQ; q += C.G * 8) {
        const int b = q / SEQ, t = q % SEQ; const float* xr = XS + ((size_t)b * RPB + CTXL + t) * DM; float* op = C.out + (size_t)q * DM;
        f32x4 v[8]; float ss = 0.f;
#pragma unroll
        for (int c = 0; c < 8; ++c) { v[c] = *(const f32x4*)(xr + c * 256 + C.lane * 4); ss += v[c][0] * v[c][0] + v[c][1] * v[c][1] + v[c][2] * v[c][2] + v[c][3] * v[c][3]; }
        ss = wave_sum(ss); const float rs = rsqrtf(ss * (1.0f / DM) + NORM_EPS);
#pragma unroll
        for (int c = 0; c < 8; ++c) { const f32x4 g = *(const f32x4*)(fg + c * 256 + C.lane * 4); *(f32x4*)(op + c * 256 + C.lane * 4) = v[c] * rs * g; }
    }
}

template <int TYPE  > __device__ __forceinline__ void attn_units(const Ctx& C, bool need_ctx) {
    const bf16_t* P = WSP(bf16_t, WS_P);
    const int nu = need_ctx ? 528 : 512;
#pragma unroll 1
    for (int u = C.bid; u < nu; u += C.G) {
        int bh, qb; if (u < 512) { bh = (u >> 8) * 8 + (u & 7); qb = ((u & 255) >> 3) + 1; } else { bh = u - 512; qb = 0; }
        const int b = bh >> 3, h = bh & 7; const size_t rq = (size_t)b * RPB + (size_t)qb * 256, rk = (size_t)b * RPB; const int seq = qb == 0 ? CTXL : RPB;
        __syncthreads();
        if constexpr (TYPE == 1) {
            att::attn_body<128, 2>(P + rq * NP + C_AQ + h * 128, NP, P + rk * NP + C_AK + (h >> 2) * 128, NP, nullptr, 0, P + rk * NP + C_AV + (h >> 2) * 128, NP,
                                   WSP(bf16_t, WS_OA) + rq * 1024 + h * 128, 1024, seq, false, 0, nullptr, (char*)C.lds, C.tid);
        } else {
            const bf16_t* MQ = WSP(bf16_t, WS_MQ); const bf16_t* MKV = WSP(bf16_t, WS_MKV);
            att::attn_body<192, 1>(MQ + rq * 1536 + h * 192, 1536, MKV + rk * 2048 + h * 256, 2048, P + rk * NP + C_MKR, NP, MKV + rk * 2048 + h * 256 + 128, 2048,
                                   WSP(bf16_t, WS_OM) + rq * 1024 + h * 128, 1024, seq, qb > 0, (qb - 1) * 256, WSP(float, WS_TABM), (char*)C.lds, C.tid);
        }
    }
    __syncthreads();
}

constexpr int LDS_BYTES = 163840, LDS_BAR_OFF = LDS_BYTES - 16;
constexpr int N_PHASES = 26;
template <int K> __device__ __forceinline__ void run_phase(const Ctx& C0, int l) {
    const Ctx C = launder(C0);
    const float* modl = WSP(float, WS_MODV) + (size_t)l * 3 * 12288;
    if constexpr (K == 0) { phase_modv(C); phase_tables(C); __syncthreads(); phase_cvt_mixer_weights(C, 0); }
    if constexpr (K == 1) {
        if (l == 0) phase_norm_mod<true>(C, INP(I_N1G), modl, 0, DM);
        else { phase_norm_mod<false>(C, INP(I_N1G) + l * DM, modl, 0, DM); __syncthreads(); phase_cvt_mixer_weights(C, l); }
    }
    if constexpr (K == 2) {
        pg8::Gemm g{WSP(bf16_t, WS_HB), WSP(bf16_t, WS_WIN), TT, NP, DM, DM, DM}; pg8::WinOrder S; S.init(C.G, C.bid, l + 1 < DEPTH);
        pg8::EpiStoreBf16 E{WSP(bf16_t, WS_P), NP};
#if defined(DBG_DUP2) && DBG_DUP2 == 1
        { pg8::EpiNull E0; pg8::gemm_phase(C.lds, C.tid, g, S, E0); }
#elif defined(DBG_DUP2) && DBG_DUP2 == 2
        pg8::gemm_phase(C.lds, C.tid, g, S, E);
#endif
        pg8::gemm_phase(C.lds, C.tid, g, S, E);
    }
    if constexpr (K == 3) phase_post_p(C, l);
    if constexpr (K == 4) {
        { pg8::Gemm g{WSP(bf16_t, WS_P) + C_MCQ, WSP(bf16_t, WS_WUQ), TT, 1536, 512, NP, 512}; pg8::StaticOrder S; S.init(TT, 1536, C.G, C.bid);
          pg8::EpiStoreBf16 E{WSP(bf16_t, WS_MQ), 1536}; pg8::gemm_phase(C.lds, C.tid, g, S, E); }
        { pg8::Gemm g{WSP(bf16_t, WS_P) + C_MCKV, WSP(bf16_t, WS_WUKV), TT, 2048, 512, NP, 512}; pg8::StaticOrder S; S.init(TT, 2048, C.G, C.bid);
          pg8::EpiStoreBf16 E{WSP(bf16_t, WS_MKV), 2048}; pg8::gemm_phase(C.lds, C.tid, g, S, E); }
        { const Ctx C2 = launder(C0); phase_gla_local(C2, l); }
#ifdef DBG_DUP_GLALOCAL
        { const Ctx C2 = launder(C0); __syncthreads(); phase_gla_local(C2, l); }
#endif
    }
    if constexpr (K == 5) phase_gla_scan(C);
    if constexpr (K == 6) { attn_units<0>(C, l + 1 < DEPTH); { const Ctx C2 = launder(C0); attn_units<1>(C2, l + 1 < DEPTH); } { const Ctx C3 = launder(C0); phase_gla_out(C3, l); }
#ifdef DBG_DUP_GLAOUT
        { const Ctx C3 = launder(C0); __syncthreads(); phase_gla_out(C3, l); }
#endif
    }
    if constexpr (K == 7) {
        const bf16_t* P = WSP(bf16_t, WS_P); bf16_t* Y = WSP(bf16_t, WS_Y);
        const pg8::Gemm ga{WSP(bf16_t, WS_OA), WSP(bf16_t, WS_WBR), TT, DM, 1024, 1024, 1024}, gl{WSP(bf16_t, WS_OL), WSP(bf16_t, WS_WBR) + (size_t)2048 * 1024, TT, DM, 1024, 1024, 1024},
                        gm{WSP(bf16_t, WS_OM), WSP(bf16_t, WS_WBR) + (size_t)2 * 2048 * 1024, TT, DM, 1024, 1024, 1024};
        const pg8::EpiGate<true> Ea{Y, DM, P + C_GA, NP}; const pg8::EpiGate<false> El{Y, DM, P + C_GL, NP}, Em{Y, DM, P + C_GM, NP};
        pg8::StaticOrder S; S.init(TT, DM, C.G, C.bid, l + 1 >= DEPTH);
        pg8::gemm_phase(C.lds, C.tid, ga, S, Ea); pg8::gemm_phase(C.lds, C.tid, gl, S, El); pg8::gemm_phase(C.lds, C.tid, gm, S, Em);
        if (l == 0) { const Ctx C2 = launder(C0); phase_cvt_peer_tables(C2, 0, 0, NEXP, S.nwg % C.G); }
    }
    if constexpr (K == 8) {
        pg8::Gemm g{WSP(bf16_t, WS_Y), WSP(bf16_t, WS_WOUT), TT, DM, DM, DM, DM};
        pg8::EpiResid E{WSP(float, WS_XS), DM, modl + 2 * DM, l == 0 ? DBG_MIX0 : DBG_MIX1};
        pg8::StaticOrder S; S.init(TT, DM, C.G, C.bid, l + 1 >= DEPTH);
#ifdef DBG_DUP8
        { pg8::EpiResid E0{WSP(float, WS_XS), DM, modl + 2 * DM, 0.0f}; pg8::gemm_phase(C.lds, C.tid, g, S, E0); }
#endif
        pg8::gemm_phase(C.lds, C.tid, g, S, E);
        if (l == 0 && DEPTH > 1) { const Ctx C2 = launder(C0); phase_cvt_peer_tables(C2, 1, 0, NEXP / 2, S.nwg % C.G); }
    }
    if constexpr (K == 9) phase_norm_mod<false>(C, INP(I_N2G) + l * DM, modl, 3 * DM, 4 * DM);
    if constexpr (K == 10) {
        pg8::Gemm g{WSP(bf16_t, WS_HB), WSP(bf16_t, WS_WQ), TT, DM, DM, DM, DM};
        pg8::EpiStoreBf16 E{WSP(bf16_t, WS_PQ), DM};
        pg8::StaticOrder S; S.init(TT, DM, C.G, C.bid, l + 1 >= DEPTH); pg8::gemm_phase(C.lds, C.tid, g, S, E);
        if (l == 0 && DEPTH > 1) { const Ctx C2 = launder(C0); phase_cvt_peer_tables(C2, 1, NEXP / 2, NEXP, S.nwg % C.G); }
    }
    if constexpr (K == 11) phase_peer_select(C, l + 1 >= DEPTH);
    if constexpr (K == 13) phase_final_norm(C);
    if constexpr (K == 12) {
#ifdef DBG_DUP12
        if (l + 1 < DEPTH) phase_peer_gather<false>(C, modl, 0.0f); else phase_peer_gather<true>(C, modl, 0.0f);
        __syncthreads();
#endif
        if (l + 1 < DEPTH) phase_peer_gather<false>(C, modl, DBG_PEER0); else phase_peer_gather<true>(C, modl, DBG_PEER1); }
}
__device__ __forceinline__ Ctx make_ctx(const Args& args, unsigned char* lds_raw) {
    Ctx C0; C0.in = (const __attribute__((address_space(4))) cfp_t*)__builtin_amdgcn_kernarg_segment_ptr(); C0.out = args.out; C0.ws = args.ws; C0.lds = (LAS unsigned char*)lds_raw;
    C0.tid = threadIdx.x; C0.lane = C0.tid & 63; C0.wid = __builtin_amdgcn_readfirstlane(C0.tid >> 6); C0.G = gridDim.x; C0.bid = blockIdx.x;
    return C0;
}
template <int K> __global__ void __launch_bounds__(NTHREADS, 2) k_one(Args args) {
    extern __shared__ __attribute__((aligned(16))) unsigned char lds_raw[];
    const Ctx C0 = make_ctx(args, lds_raw);
    run_phase<K>(C0, args.ph_lo);
}
#if MK_N_LAUNCHES == 1 || defined(DBG_HYB)
__global__ void __launch_bounds__(NTHREADS, 2) mk_fwd(Args args) {
    extern __shared__ __attribute__((aligned(16))) unsigned char lds_raw[];
    const Ctx C0 = make_ctx(args, lds_raw);
    if (C0.tid < 4) ((LAS unsigned*)(C0.lds + LDS_BAR_OFF))[C0.tid] = 0u;
    __syncthreads();
    const int lo = args.ph_lo, hi = args.ph_hi;
    XcdBarrier bar; bar.bar = (unsigned*)(args.ws + WS_CTL); bar.x = 0; bar.st = nullptr;
    if (hi - lo > 1) bar = xcd_barrier_post((unsigned*)(args.ws + WS_CTL), (volatile LAS unsigned*)(C0.lds + LDS_BAR_OFF));
#define IN(k) (lo <= (k) && (k) < hi)
#define SEAM(k) do { if (IN(k) && IN((k) + 1)) xcd_barrier(bar); } while (0)
#ifndef DBG_DUP
#define DBG_DUP -1
#endif
#define PH(K, k) do { if (IN(k)) { run_phase<K>(C0, l); if (K == DBG_DUP) { xcd_barrier(bar); run_phase<K>(C0, l); } } SEAM(k); } while (0)
    { const int l = 0; PH(0, 0); }
#pragma unroll 1
    for (int l = 0; l < DEPTH; ++l) {
        const int pb = 1 + 12 * l;
        PH(1, pb + 0); PH(2, pb + 1); PH(3, pb + 2); PH(4, pb + 3); PH(5, pb + 4); PH(6, pb + 5);
        PH(7, pb + 6); PH(8, pb + 7); PH(9, pb + 8); PH(10, pb + 9); PH(11, pb + 10); PH(12, pb + 11);
    }
    { const int l = DEPTH - 1; PH(13, 1 + 12 * DEPTH); }
#undef PH
#undef IN
#undef SEAM
}
#define MAIN_KERNEL mk_fwd
#else
#define MAIN_KERNEL k_one<6>
#endif


#ifdef DBG_CHECK
__device__ __forceinline__ void dbg_report(unsigned* slot, float err) { if (!(err <= 3e38f)) err = 1e30f; atomicMax(slot, __float_as_uint(err)); }
__global__ void k_check_gemm(const bf16_t* A, int lda, const float* W, int K, int N, const bf16_t* Cm, int ldc, int M, unsigned* slot) {
    const unsigned id = blockIdx.x * blockDim.x + threadIdx.x; if (id >= 8192) return;
    const unsigned h = id * 2654435761u; const int row = (int)((h >> 8) % (unsigned)M), col = (int)((h * 40503u >> 7) % (unsigned)N);
    float ref = 0.f; for (int k = 0; k < K; ++k) ref += bf2f(A[(size_t)row * lda + k]) * W[(size_t)k * N + col];
    const float got = bf2f(Cm[(size_t)row * ldc + col]);
    dbg_report(slot, fabsf(got - ref) / (fabsf(ref) + 0.1f));
}

__global__ void k_check_attn(const unsigned char* ws, int type, unsigned* slot) {
    __shared__ float sc[RPB]; __shared__ float red[256]; __shared__ float qv[192];
    const int t = threadIdx.x, bh = blockIdx.x & 15, b = bh >> 3, h = bh & 7; const int qpos = (int)(((blockIdx.x >> 4) * 977u + 13u) % SEQ); const size_t rq = (size_t)b * RPB + CTXL + qpos, rk = (size_t)b * RPB;
    const bf16_t* P = (const bf16_t*)(ws + WS_P); const bf16_t* MQ = (const bf16_t*)(ws + WS_MQ); const bf16_t* MKV = (const bf16_t*)(ws + WS_MKV);
    const int dq = type ? 128 : 192;
    if (t < dq) { float v = type ? bf2f(P[rq * NP + C_AQ + h * 128 + t]) : bf2f(MQ[rq * 1536 + h * 192 + t]); qv[t] = v; }
    __syncthreads();
    if (!type && t < 32) {
        const int ri = qpos >> 6, ci = qpos & 63; const int i = t; const float pos = (float)(i < 16 ? ri : ci); const float inv = powf(10000.f, -(float)(i & 15) / 16.f); const float a = pos * inv;
        const float x1 = qv[128 + i], x2 = qv[160 + i]; qv[128 + i] = x1 * cosf(a) - x2 * sinf(a); qv[160 + i] = x2 * cosf(a) + x1 * sinf(a); }
    __syncthreads();
    const float scale = type ? 0.088388347648f : 0.0721687836487f;
    float mx = -1e30f;
    for (int k = t; k < RPB; k += 256) { float s = 0.f;
        if (type) { const bf16_t* kp = P + (rk + k) * NP + C_AK + (h >> 2) * 128; for (int d = 0; d < 128; ++d) s += qv[d] * bf2f(kp[d]); }
        else { const bf16_t* kp = MKV + (rk + k) * 2048 + h * 256; for (int d = 0; d < 128; ++d) s += qv[d] * bf2f(kp[d]); const bf16_t* kr = P + (rk + k) * NP + C_MKR; for (int d = 0; d < 64; ++d) s += qv[128 + d] * bf2f(kr[d]); }
        s *= scale; sc[k] = s; mx = fmaxf(mx, s); }
    red[t] = mx; __syncthreads(); for (int o = 128; o >= 1; o >>= 1) { if (t < o) red[t] = fmaxf(red[t], red[t + o]); __syncthreads(); } mx = red[0]; __syncthreads();
    float sum = 0.f; for (int k = t; k < RPB; k += 256) { const float p = __expf(sc[k] - mx); sc[k] = p; sum += p; }
    red[t] = sum; __syncthreads(); for (int o = 128; o >= 1; o >>= 1) { if (t < o) red[t] += red[t + o]; __syncthreads(); } sum = red[0]; __syncthreads();
    float e = 0.f, mag = 0.f;
    if (t < 128) { float o = 0.f; for (int k = 0; k < RPB; ++k) { const float vv = type ? bf2f(P[(rk + k) * NP + C_AV + (h >> 2) * 128 + t]) : bf2f(MKV[(rk + k) * 2048 + h * 256 + 128 + t]); o += sc[k] * vv; }
        o /= sum; const float got = bf2f(((const bf16_t*)(ws + (type ? WS_OA : WS_OM)))[rq * 1024 + h * 128 + t]); e = fabsf(got - o); mag = fabsf(o); }
    red[t] = e; __syncthreads(); for (int o = 128; o >= 1; o >>= 1) { if (t < o) red[t] = fmaxf(red[t], red[t + o]); __syncthreads(); } e = red[0]; __syncthreads();
    red[t] = mag; __syncthreads(); for (int o = 128; o >= 1; o >>= 1) { if (t < o) red[t] = fmaxf(red[t], red[t + o]); __syncthreads(); } mag = red[0];
    if (t == 0) dbg_report(slot, e / (mag + 1e-4f));
}
__global__ void __launch_bounds__(256) k_check_gla_rec(const unsigned char* ws, const float* wa_f, const float* ba_f, const float* wa_b, const float* ba_b, float* obuf, int b) {
    __shared__ float ad[128], kd[128], qd[128], lrs[16];
    const int e = threadIdx.x, h = blockIdx.x & 3, dir = blockIdx.x >> 2; const bf16_t* P = (const bf16_t*)(ws + WS_P);
    const float* wa = dir ? wa_b : wa_f; const float* ba = dir ? ba_b : ba_f;
    float S[128];
#pragma unroll
    for (int d = 0; d < 128; ++d) S[d] = 0.f;
    float* ob = obuf + ((size_t)(dir * 2 + b) * 4 + h) * RPB * 256;
    for (int st = 0; st < RPB; ++st) {
        int j; if (!dir) j = st; else j = st < CTXL ? CTXL - 1 - st : RPB - 1 - (st - CTXL);
        const size_t r = (size_t)b * RPB + j; const bf16_t* pr = P + r * NP;
        if (e < 16) lrs[e] = bf2f(pr[(dir ? C_LRB : C_LRF) + e]);
        __syncthreads();
        if (e < 128) { float pre = ba[h * 128 + e]; for (int q = 0; q < 16; ++q) pre += lrs[q] * wa[q * 512 + h * 128 + e];
            const float ls = (fminf(pre, 0.f) - log1pf(expf(-fabsf(pre)))) / 16.f; ad[e] = expf(ls); kd[e] = bf2f(pr[C_LK + h * 128 + e]); qd[e] = bf2f(pr[C_LQ + h * 128 + e]) * 0.088388347648f; }
        __syncthreads();
        const float v = bf2f(pr[C_LV + h * 256 + e]); float o = 0.f;
#pragma unroll
        for (int d = 0; d < 128; ++d) { S[d] = ad[d] * S[d] + kd[d] * v; o += qd[d] * S[d]; }
        ob[(size_t)j * 256 + e] = o;
        __syncthreads();
    }
}
__global__ void k_check_gla_cmp(const unsigned char* ws, const float* obuf, const float* gon, int b, unsigned* slot) {
    __shared__ float red[256];
    const int e = threadIdx.x, h = blockIdx.x & 3, j = blockIdx.x >> 2; const size_t r = (size_t)b * RPB + j; const bf16_t* P = (const bf16_t*)(ws + WS_P);
    const float o = obuf[((size_t)(0 * 2 + b) * 4 + h) * RPB * 256 + (size_t)j * 256 + e] + obuf[((size_t)(1 * 2 + b) * 4 + h) * RPB * 256 + (size_t)j * 256 + e];
    red[e] = o * o; __syncthreads(); for (int s_ = 128; s_ >= 1; s_ >>= 1) { if (e < s_) red[e] += red[e + s_]; __syncthreads(); }
    const float rs = rsqrtf(red[0] / 256.f + NORM_EPS); __syncthreads();
    const float gt = bf2f(P[r * NP + C_LG + h * 256 + e]); const float ref = o * rs * gon[e] * (gt / (1.f + expf(-gt)));
    const float got = bf2f(((const bf16_t*)(ws + WS_OL))[r * 1024 + h * 256 + e]);
    red[e] = fabsf(got - ref); __syncthreads(); for (int s_ = 128; s_ >= 1; s_ >>= 1) { if (e < s_) red[e] = fmaxf(red[e], red[e + s_]); __syncthreads(); }
    if (e == 0) dbg_report(slot, red[0] / 1.0f);
}
__global__ void k_check_select(const bf16_t* PQ, const float* k1, const float* k2, const int* PIDX, const float* PG, unsigned* slot) {
    __shared__ float s1[128], s2[128]; __shared__ int cnt; __shared__ float selv[16];
    const int tok = (blockIdx.x >> 3) * 61 + 5, head = blockIdx.x & 7, t = threadIdx.x;
    if (t == 0) cnt = 0;
    for (int n = t; n < 128; n += 64) { float a = 0.f, b = 0.f; for (int d = 0; d < 128; ++d) { a += bf2f(PQ[(size_t)tok * DM + head * 256 + d]) * k1[((size_t)head * 128 + n) * 128 + d]; b += bf2f(PQ[(size_t)tok * DM + head * 256 + 128 + d]) * k2[((size_t)head * 128 + n) * 128 + d]; } s1[n] = a; s2[n] = b; }
    __syncthreads();
    if (t < 16) { const int id = PIDX[(size_t)tok * 128 + head * 16 + t]; selv[t] = (id >= 0 && id < 16384) ? s1[id >> 7] + s2[id & 127] : -1e30f; }
    __syncthreads();
    float thr = selv[0], mx = selv[0]; for (int k = 1; k < 16; ++k) { thr = fminf(thr, selv[k]); mx = fmaxf(mx, selv[k]); }
    int c = 0; for (int p = t; p < 16384; p += 64) if (s1[p >> 7] + s2[p & 127] > thr + 0.02f) ++c;
    atomicAdd(&cnt, c); __syncthreads();
    if (t == 0) { float den = 0.f; for (int k = 0; k < 16; ++k) den += __expf(selv[k] - mx); float e = fabsf((float)cnt - 15.f) / 15.f > 0.34f ? fabsf((float)cnt - 15.f) / 15.f : 0.f;
        for (int k = 0; k < 16; ++k) e = fmaxf(e, fabsf(PG[(size_t)tok * 128 + head * 16 + k] - __expf(selv[k] - mx) / den) * 4.f);
        for (int k = 0; k < 16; ++k) for (int k2_ = 0; k2_ < k; ++k2_) if (PIDX[(size_t)tok * 128 + head * 16 + k] == PIDX[(size_t)tok * 128 + head * 16 + k2_]) e = fmaxf(e, 10.f);
        dbg_report(slot, e); }
}
__global__ void k_check_gather(const bf16_t* HB, const float* u, const float* v, const int* PIDX, const float* PG, const float* dbgo, unsigned* slot) {
    __shared__ float w[128];
    const int tok = blockIdx.x * 64 + 300, t = threadIdx.x;
    for (int k = t; k < 128; k += 64) { const int id = PIDX[(size_t)tok * 128 + k] & 16383; float a = 0.f; for (int d = 0; d < DM; ++d) a += bf2f(HB[(size_t)tok * DM + d]) * u[(size_t)id * DM + d];
        w[k] = PG[(size_t)tok * 128 + k] * 0.5f * a * (1.0f + erff(a * 0.70710678f)); }
    __syncthreads();
    float e = 0.f, sc = 0.f;
    for (int d = t; d < DM; d += 64) { float o = 0.f; for (int k = 0; k < 128; ++k) o += w[k] * v[(size_t)(PIDX[(size_t)tok * 128 + k] & 16383) * DM + d];
        e = fmaxf(e, fabsf(o - dbgo[(size_t)tok * DM + d])); sc = fmaxf(sc, fabsf(o)); }
    for (int o_ = 32; o_ >= 1; o_ >>= 1) { e = fmaxf(e, __shfl_xor(e, o_)); sc = fmaxf(sc, __shfl_xor(sc, o_)); }
    if (t == 0) dbg_report(slot, e / (sc + 1e-6f));
}
__global__ void k_dbg_out2(const float* x, const float* fg, float* out, const unsigned* slot) {
    const float mx = __uint_as_float(*slot); float v = 0.25f * (log10f(fmaxf(mx, 1e-30f)) + 4.0f); v = fminf(fmaxf(v, 0.f), 9.f);
    const float f = 1.0f + v;
    const int lane = threadIdx.x & 63; const size_t r = (size_t)blockIdx.x * 4 + (threadIdx.x >> 6);
    const float* xr = x + r * DM; float ss = 0.f;
    for (int c = lane; c < DM; c += 64) ss += xr[c] * xr[c];
    ss = wave_sum(ss); const float rs = rsqrtf(ss / DM + NORM_EPS);
    for (int c = lane; c < DM; c += 64) out[r * DM + c] = xr[c] * rs * fg[c] * f;
}
#endif
#ifdef DBG_SCAN
__global__ void k_scan16(const bf16_t* p, size_t n, unsigned* flags, int stage) {
    unsigned bad = 0; for (size_t i = (size_t)blockIdx.x * blockDim.x + threadIdx.x; i < n; i += (size_t)gridDim.x * blockDim.x) bad |= ((p[i] & 0x7f80u) == 0x7f80u);
    if (bad) atomicOr(&flags[stage], 1u);
}
__global__ void k_scan32(const float* p, size_t n, unsigned* flags, int stage) {
    unsigned bad = 0; for (size_t i = (size_t)blockIdx.x * blockDim.x + threadIdx.x; i < n; i += (size_t)gridDim.x * blockDim.x) bad |= ((__float_as_uint(p[i]) & 0x7f800000u) == 0x7f800000u);
    if (bad) atomicOr(&flags[stage], 1u);
}
__global__ void k_dbg_out(const float* x, const float* fg, float* out, const unsigned* flags, int nstage) {
    int code = 0; for (int s = nstage; s >= 1; --s) if (flags[s]) code = s;
    const float f = 1.0f + 0.25f * (float)code;
    const int lane = threadIdx.x & 63; const size_t r = (size_t)blockIdx.x * 4 + (threadIdx.x >> 6);
    const float* xr = x + r * DM; float ss = 0.f;
    for (int c = lane; c < DM; c += 64) ss += xr[c] * xr[c];
    ss = wave_sum(ss); const float rs = rsqrtf(ss / DM + NORM_EPS);
    for (int c = lane; c < DM; c += 64) out[r * DM + c] = xr[c] * rs * fg[c] * f;
}
#endif
extern "C" void kernel_launch(void* const* d_in, const int* in_sizes, int n_in, void* d_out, int out_size, void* d_ws, size_t ws_size, hipStream_t stream) {
    static int grid = 0;
    if (grid == 0) {
        if (n_in != 30 || out_size != NBATCH * SEQ * DM || ws_size < WS_END) { fprintf(stderr, "kernel_launch: shape/workspace mismatch: n_in %d out %d ws %zu (need %zu)\n", n_in, out_size, ws_size, (size_t)WS_END); grid = -1; return; }
        int dev = 0, cus = 0, per_cu = 0;
        if (hipGetDevice(&dev) != hipSuccess || hipDeviceGetAttribute(&cus, hipDeviceAttributeMultiprocessorCount, dev) != hipSuccess) { grid = -1; return; }
        bool okattr = hipFuncSetAttribute((const void*)MAIN_KERNEL, hipFuncAttributeMaxDynamicSharedMemorySize, LDS_BYTES) == hipSuccess;
#if MK_N_LAUNCHES != 1
#ifdef DBG_HYB
        okattr = okattr && hipFuncSetAttribute((const void*)mk_fwd, hipFuncAttributeMaxDynamicSharedMemorySize, LDS_BYTES) == hipSuccess;
#endif
#define SETA(K) okattr = okattr && hipFuncSetAttribute((const void*)k_one<K>, hipFuncAttributeMaxDynamicSharedMemorySize, LDS_BYTES) == hipSuccess
        SETA(0); SETA(1); SETA(2); SETA(3); SETA(4); SETA(5); SETA(6); SETA(7); SETA(8); SETA(9); SETA(10); SETA(11); SETA(12); SETA(13);
#undef SETA
#endif
        if (!okattr) { fprintf(stderr, "kernel_launch: hipFuncSetAttribute failed\n"); grid = -1; return; }
        if (hipOccupancyMaxActiveBlocksPerMultiprocessor(&per_cu, (const void*)MAIN_KERNEL, NTHREADS, LDS_BYTES) != hipSuccess || per_cu < 1) { fprintf(stderr, "kernel_launch: occupancy query says %d blocks per CU\n", per_cu); grid = -1; (void)hipGetLastError(); return; }
        grid = cus;
    }
    if (grid < 0) return;
    if (hipMemsetAsync((char*)d_ws + WS_CTL, 0, CTL_BYTES, stream) != hipSuccess) return;
    Args a{};
    for (int i = 0; i < 30; ++i) a.in[i] = (const float*)d_in[i];
    a.out = (float*)d_out; a.ws = (unsigned char*)d_ws;
#if MK_N_LAUNCHES == 1
#ifdef DBG_SPLIT
    for (int p = 0; p < N_PHASES; p += DBG_SPLIT) { a.ph_lo = p; a.ph_hi = p + DBG_SPLIT < N_PHASES ? p + DBG_SPLIT : N_PHASES; hipLaunchKernelGGL(mk_fwd, dim3(grid), dim3(NTHREADS), LDS_BYTES, stream, a); }
#else
    a.ph_lo = 0; a.ph_hi = N_PHASES;
    hipLaunchKernelGGL(mk_fwd, dim3(grid), dim3(NTHREADS), LDS_BYTES, stream, a);
#endif
#else
    a.ph_hi = 0;
#ifndef DBG_NLAUNCH
#define DBG_NLAUNCH 100
#endif
    int nl_ = 0;
#ifdef DBG_HYB
#define LAUNCH1(K, L) do { if (K == DBG_HYB) { a.ph_lo = 12 * (L) + (K); a.ph_hi = a.ph_lo + 1; hipLaunchKernelGGL(mk_fwd, dim3(grid), dim3(NTHREADS), LDS_BYTES, stream, a); a.ph_hi = 0; } else { a.ph_lo = (L); hipLaunchKernelGGL(k_one<K>, dim3(grid), dim3(NTHREADS), LDS_BYTES, stream, a); } } while (0)
#else
#define LAUNCH1(K, L) do { a.ph_lo = (L); if (nl_++ < DBG_NLAUNCH) { hipLaunchKernelGGL(k_one<K>, dim3(grid), dim3(NTHREADS), LDS_BYTES, stream, a); if (K == DBG_DUP) hipLaunchKernelGGL(k_one<K>, dim3(grid), dim3(NTHREADS), LDS_BYTES, stream, a); } } while (0)
#endif
#ifdef DBG_SCAN
    unsigned* flags = (unsigned*)((char*)d_ws + WS_CTL + 32768);
    char* W = (char*)d_ws;
#define S16(off, n, st) hipLaunchKernelGGL(k_scan16, dim3(1024), dim3(256), 0, stream, (const bf16_t*)(W + (off)), (size_t)(n), flags, st)
#define S32(off, n, st) hipLaunchKernelGGL(k_scan32, dim3(1024), dim3(256), 0, stream, (const float*)(W + (off)), (size_t)(n), flags, st)
    LAUNCH1(0, 0); S32(WS_MODV, 2 * 3 * 12288, 1);
    { const int l = 0;
      LAUNCH1(1, l); S16(WS_HB, (size_t)TT * DM, 2);
      LAUNCH1(2, l); S16(WS_P, (size_t)TT * NP, 3);
      LAUNCH1(3, l); S16(WS_P, (size_t)TT * NP, 4);
      LAUNCH1(4, l); S16(WS_MQ, (size_t)TT * 1536, 5); S16(WS_MKV, (size_t)TT * 2048, 5); S16(WS_GST, (size_t)2112 * 32768, 6); S32(WS_GDEC, (size_t)2112 * 128, 6);
      LAUNCH1(5, l); S16(WS_GST, (size_t)2112 * 32768, 7);
      LAUNCH1(6, l); S16(WS_OA, (size_t)TT * 1024, 8); S16(WS_OM, (size_t)TT * 1024, 9); S16(WS_OL, (size_t)TT * 1024, 10);
      LAUNCH1(7, l); S16(WS_Y, (size_t)TT * DM, 11);
      LAUNCH1(8, l); S32(WS_XS, (size_t)TT * DM, 12);
      LAUNCH1(9, l); S16(WS_HB, (size_t)TT * DM, 13);
      LAUNCH1(10, l); S16(WS_PQ, (size_t)TT * DM, 14);
      LAUNCH1(11, l); S32(WS_PG, (size_t)TT * 128, 15);
      LAUNCH1(12, l); S32(WS_XS, (size_t)TT * DM, 16);
    }
    hipLaunchKernelGGL(k_dbg_out, dim3(NBATCH * SEQ / 4), dim3(256), 0, stream, (const float*)d_in[0], (const float*)d_in[29], (float*)d_out, flags, 16);
#elif defined(DBG_CHECK)
    unsigned* flags = (unsigned*)((char*)d_ws + WS_CTL + 32768);
    char* W = (char*)d_ws;
    LAUNCH1(0, 0);
    { const int l = 0; LAUNCH1(1, l); LAUNCH1(2, l); LAUNCH1(3, l); LAUNCH1(4, l); LAUNCH1(5, l); LAUNCH1(6, l);
#if DBG_CHECK == 5 || DBG_CHECK == 6
      hipLaunchKernelGGL(k_check_attn, dim3(16 * 24), dim3(256), 0, stream, (const unsigned char*)d_ws, DBG_CHECK == 5 ? 1 : 0, flags + 100);
#endif
#if DBG_CHECK == 7
      { float* obuf = (float*)(W + WS_MQ);
        hipLaunchKernelGGL(k_check_gla_rec, dim3(8), dim3(256), 0, stream, (const unsigned char*)d_ws, (const float*)d_in[I_WA2F], (const float*)d_in[I_BAF], (const float*)d_in[I_WA2B], (const float*)d_in[I_BAB], obuf, 0);
        hipLaunchKernelGGL(k_check_gla_cmp, dim3(RPB * 4), dim3(256), 0, stream, (const unsigned char*)d_ws, (const float*)obuf, (const float*)d_in[I_ONG], 0, flags + 100); }
#endif
      LAUNCH1(7, l); LAUNCH1(8, l); LAUNCH1(9, l); LAUNCH1(10, l);
#if DBG_CHECK == 1
      hipLaunchKernelGGL(k_check_gemm, dim3(32), dim3(256), 0, stream, (const bf16_t*)(W + WS_HB), DM, (const float*)d_in[I_PWQ], DM, DM, (const bf16_t*)(W + WS_PQ), DM, TT, flags + 100);
#endif
      LAUNCH1(11, l);
#if DBG_CHECK == 2
      hipLaunchKernelGGL(k_check_select, dim3(256 * 8), dim3(64), 0, stream, (const bf16_t*)(W + WS_PQ), (const float*)d_in[I_PK1], (const float*)d_in[I_PK2], (const int*)(W + WS_PIDX), (const float*)(W + WS_PG), flags + 100);
#endif
      LAUNCH1(12, l);
#if DBG_CHECK == 3
      hipLaunchKernelGGL(k_check_gather, dim3(128), dim3(64), 0, stream, (const bf16_t*)(W + WS_HB), (const float*)d_in[I_PU], (const float*)d_in[I_PV], (const int*)(W + WS_PIDX), (const float*)(W + WS_PG), (const float*)(W + WS_MQ), flags + 100);
#endif
    }
    hipLaunchKernelGGL(k_dbg_out2, dim3(NBATCH * SEQ / 4), dim3(256), 0, stream, (const float*)d_in[0], (const float*)d_in[29], (float*)d_out, flags + 100);
#else
    LAUNCH1(0, 0);
    for (int l = 0; l < DEPTH; ++l) { LAUNCH1(1, l); LAUNCH1(2, l); LAUNCH1(3, l);
#ifdef DBG_DUP23
        LAUNCH1(2, l); LAUNCH1(3, l);
#endif
        LAUNCH1(4, l); LAUNCH1(5, l);
#ifdef DBG_DUP45
        LAUNCH1(4, l); LAUNCH1(5, l);
#endif
        LAUNCH1(6, l); LAUNCH1(7, l); LAUNCH1(8, l); LAUNCH1(9, l); LAUNCH1(10, l); LAUNCH1(11, l); LAUNCH1(12, l); }
    LAUNCH1(13, DEPTH - 1);
#endif
#undef LAUNCH1
#endif
    const hipError_t le = hipPeekAtLastError();
    if (le != hipSuccess) fprintf(stderr, "kernel_launch: launch failed: %s\n", hipGetErrorName(le));
}
```

```cpp
#include <hip/hip_runtime.h>
#include <cstdio>
#include <cstdint>

#ifndef MK_N_LAUNCHES
#ifndef DBG_DUP
#define DBG_DUP -1
#endif
#define MK_N_LAUNCHES 1
#endif

#ifndef DBG_MIX0
#define DBG_MIX0 1.0f
#define DBG_MIX1 1.0f
#define DBG_PEER0 1.0f
#define DBG_PEER1 1.0f
#endif
#ifndef MLA_NQR
#define MLA_NQR 6
#endif
#define LAS __attribute__((address_space(3)))
#define GLB __attribute__((address_space(1)))
typedef unsigned short bf16_t;
typedef short bf16x8 __attribute__((ext_vector_type(8)));
typedef short s16x4 __attribute__((ext_vector_type(4)));
typedef float f32x4 __attribute__((ext_vector_type(4)));
typedef float f32x2 __attribute__((ext_vector_type(2)));
typedef float f32x16 __attribute__((ext_vector_type(16)));
typedef unsigned u32x4 __attribute__((ext_vector_type(4)));
typedef unsigned u32x2 __attribute__((ext_vector_type(2)));
typedef __bf16 bf2_t __attribute__((ext_vector_type(2)));

constexpr int DM = 2048, NBATCH = 2, SEQ = 8192, CTXL = 256, DEPTH = 2;
constexpr int RPB = SEQ + CTXL;
constexpr int TT = NBATCH * RPB;
constexpr int IN_COLS = 11872, NP = 12032;
constexpr int C_AQ = 0, C_AK = 1024, C_AV = 1280, C_LQ = 1536, C_LK = 2048, C_LV = 2560, C_LG = 3584, C_LRF = 4608, C_LRB = 4624,
              C_MCQ = 4640, C_MCKV = 5152, C_MKR = 5664, C_GA = 5728, C_GL = 7776, C_GM = 9824;
constexpr int NCH = RPB / 64;
constexpr int NEXP = 16384;
constexpr float NORM_EPS = 1e-6f;
constexpr int NTHREADS = 512;

constexpr size_t al256(size_t x) { return (x + 255) / 256 * 256; }
constexpr size_t WS_CTL   = 0;
constexpr size_t CTL_BYTES = 65536;
constexpr size_t WS_MODV  = WS_CTL + CTL_BYTES;
constexpr size_t WS_TABA  = al256(WS_MODV + (size_t)2 * 3 * 12288 * 4);
constexpr size_t WS_TABM  = WS_TABA + 2 * 128 * 32 * 4;
constexpr size_t WS_XS    = al256(WS_TABM + 2 * 128 * 16 * 4);
constexpr size_t WS_HB    = WS_XS + (size_t)TT * DM * 4;
constexpr size_t WS_P     = WS_HB + (size_t)TT * DM * 2;
constexpr size_t WS_MQ    = WS_P + (size_t)TT * NP * 2;
constexpr size_t WS_MKV   = WS_MQ + (size_t)TT * 1536 * 2;
constexpr size_t WS_OA    = WS_MKV + (size_t)TT * 2048 * 2;
constexpr size_t WS_OL    = WS_OA + (size_t)TT * 1024 * 2;
constexpr size_t WS_OM    = WS_OL + (size_t)TT * 1024 * 2;
constexpr size_t WS_WIN   = WS_OM + (size_t)TT * 1024 * 2;
constexpr size_t WS_WUQ   = WS_WIN + (size_t)NP * 2048 * 2;
constexpr size_t WS_WUKV  = WS_WUQ + (size_t)1536 * 512 * 2;
constexpr size_t WS_WBR   = WS_WUKV + (size_t)2048 * 512 * 2;
constexpr size_t WS_WOUT  = WS_WBR + (size_t)3 * 2048 * 1024 * 2;
constexpr size_t WS_WQ    = WS_WOUT + (size_t)2048 * 2048 * 2;
constexpr size_t WS_K1    = WS_WQ + (size_t)2048 * 2048 * 2;
constexpr size_t WS_K2    = WS_K1 + (size_t)8 * 128 * 128 * 2;
constexpr size_t WS_GST   = WS_K2 + (size_t)8 * 128 * 128 * 2;
constexpr size_t WS_GDEC  = WS_GST + (size_t)NBATCH * 2 * 4 * NCH * 32768 * 2;
constexpr size_t WS_END0  = WS_GDEC + (size_t)NBATCH * 2 * 4 * NCH * 128 * 4;
constexpr size_t WS_Y     = WS_MKV;
constexpr size_t WS_PQ    = WS_OA;
constexpr size_t WS_PIDX  = WS_P;
constexpr size_t WS_PG    = WS_PIDX + (size_t)TT * 128 * 4;
constexpr size_t PT_BYTES = 2 * (size_t)NEXP * DM + 2 * (size_t)NEXP * 4;
constexpr size_t WS_PT    = WS_END0;
constexpr size_t WS_END   = WS_PT + DEPTH * PT_BYTES;
constexpr size_t PT_U8 = 0, PT_V8 = (size_t)NEXP * DM, PT_SCU = 2 * (size_t)NEXP * DM, PT_SCV = PT_SCU + (size_t)NEXP * 4;
static_assert(WS_PG + (size_t)TT * 128 * 4 <= WS_MQ, "PEER alias region overflows P");

__device__ __forceinline__ unsigned cvt_pk_bf16(float lo, float hi) { bf2_t v; v.x = (__bf16)lo; v.y = (__bf16)hi; return __builtin_bit_cast(unsigned, v); }
__device__ __forceinline__ bf16_t f2bf(float f) { return (bf16_t)(cvt_pk_bf16(f, 0.f) & 0xffffu); }
__device__ __forceinline__ float bf2f(bf16_t b) { return __uint_as_float(((unsigned)b) << 16); }
__device__ __forceinline__ float bflo(unsigned w) { return __uint_as_float(w << 16); }
__device__ __forceinline__ float bfhi(unsigned w) { return __uint_as_float(w & 0xffff0000u); }
__device__ __forceinline__ float xchg32(float x, int lane) { auto r = __builtin_amdgcn_permlane32_swap(__float_as_uint(x), __float_as_uint(x), false, false); return __uint_as_float(lane < 32 ? r[1] : r[0]); }
__device__ __forceinline__ float xchg16(float x, int lane) { auto r = __builtin_amdgcn_permlane16_swap(__float_as_uint(x), __float_as_uint(x), false, false); return __uint_as_float((lane & 16) ? r[0] : r[1]); }
template <int CTRL> __device__ __forceinline__ float dppmov(float x) { return __uint_as_float(__builtin_amdgcn_update_dpp(0u, __float_as_uint(x), CTRL, 0xF, 0xF, false)); }
constexpr int DPP_ROR8 = 0x128, DPP_HMIRROR = 0x141, DPP_Q3210 = 0x1B, DPP_Q1032 = 0xB1;
__device__ __forceinline__ float wave_sum(float v) {
    const int lane = threadIdx.x & 63;
    v += xchg32(v, lane); v += xchg16(v, lane); v += dppmov<DPP_ROR8>(v); v += dppmov<DPP_HMIRROR>(v); v += dppmov<DPP_Q3210>(v); v += dppmov<DPP_Q1032>(v);
    return v;
}
__device__ __forceinline__ float sigmoidf_(float x) { return __builtin_amdgcn_rcpf(1.0f + __expf(-x)); }
__device__ __forceinline__ float siluf_(float x) { return x * __builtin_amdgcn_rcpf(1.0f + __expf(-x)); }

#define XB_TMO      128
#define XB_XCNT(j)  (256  + 64 * (j))
#define XB_XSUB(j)  (1280 + 64 * (j))
#define XB_XGEN(j)  (2304 + 64 * (j))
#define XB_TOP      3328
#define XB_TOPGEN   3392
#define XCD_BAR_WORDS 3456
#define XB_SPIN_CAP (1u << 20)
__device__ __forceinline__ unsigned xb_ld(unsigned* p)              { return __hip_atomic_load(p, __ATOMIC_RELAXED, __HIP_MEMORY_SCOPE_AGENT); }
__device__ __forceinline__ unsigned xb_add(unsigned* p, unsigned v) { return __hip_atomic_fetch_add(p, v, __ATOMIC_RELAXED, __HIP_MEMORY_SCOPE_AGENT); }
__device__ __forceinline__ unsigned xb_xcc_id() { return (unsigned)__builtin_amdgcn_s_getreg((3 << 11) | 20) & 0xFu; }
#define XB_SPIN(cond, bar) do { unsigned _sp = 0; while (cond) { __builtin_amdgcn_s_sleep(1); \
    if ((++_sp & 255u) == 0u) { if (xb_ld(&(bar)[XB_TMO])) break; if (_sp > XB_SPIN_CAP) { atomicAdd(&(bar)[XB_TMO], 1u); break; } } } } while (0)
struct XcdBarrier { unsigned* bar; unsigned x; volatile LAS unsigned* st; };
__device__ __forceinline__ XcdBarrier xcd_barrier_post(unsigned* bar, volatile LAS unsigned* st) {
    XcdBarrier b; b.bar = bar; b.x = xb_xcc_id(); b.st = st;
    if (threadIdx.x == 0) (void)xb_add(&bar[XB_XCNT(b.x)], 1u);
    return b;
}
__device__ __forceinline__ void xcd_barrier_complete(unsigned* bar, unsigned x, unsigned& nloc, unsigned& nx) {
    const unsigned G = gridDim.x * gridDim.y * gridDim.z;
    unsigned sum, cnt, mine, sp = 0u;
    for (;;) {
        sum = 0u; cnt = 0u; mine = 0u;
#pragma unroll
        for (unsigned j = 0; j < 16; ++j) { const unsigned c = xb_ld(&bar[XB_XCNT(j)]); sum += c; cnt += (c > 0u) ? 1u : 0u; mine = (j == x) ? c : mine; }
        if (sum == G) break;
        __builtin_amdgcn_s_sleep(1);
        if ((++sp & 255u) == 0u) { if (xb_ld(&bar[XB_TMO])) break; if (sp > XB_SPIN_CAP) { atomicAdd(&bar[XB_TMO], 1u); break; } }
    }
    nloc = mine > 0u ? mine : 1u; nx = cnt > 0u ? cnt : 1u;
}
__device__ __forceinline__ void xcd_barrier(const XcdBarrier& b) {
    asm volatile("s_waitcnt vmcnt(0)" ::: "memory");
    __syncthreads();
    if (threadIdx.x == 0) {
        unsigned* bar = b.bar;
        __builtin_amdgcn_s_waitcnt(0);
        unsigned nloc = b.st[0], nx = b.st[1];
        if (nloc == 0u) { xcd_barrier_complete(bar, b.x, nloc, nx); b.st[0] = nloc; b.st[1] = nx; }
        const unsigned old = xb_add(&bar[XB_XSUB(b.x)], 1u);
        const unsigned gen = old / nloc;
        if (old + 1u == (gen + 1u) * nloc) {
            __builtin_amdgcn_fence(__ATOMIC_RELEASE, "agent");
            asm volatile("s_waitcnt vmcnt(0)" ::: "memory");
            const unsigned og = xb_add(&bar[XB_TOP], 1u);
            const unsigned tg = og / nx;
            if (og + 1u == (tg + 1u) * nx) xb_add(&bar[XB_TOPGEN], 1u);
            else XB_SPIN(xb_ld(&bar[XB_TOPGEN]) == tg, bar);
            __builtin_amdgcn_fence(__ATOMIC_ACQUIRE, "agent");
            xb_add(&bar[XB_XGEN(b.x)], 1u);
            asm volatile("s_waitcnt vmcnt(0)" ::: "memory");
        } else {
            XB_SPIN(xb_ld(&bar[XB_XGEN(b.x)]) == gen, bar);
            __builtin_amdgcn_fence(__ATOMIC_ACQUIRE, "agent");
            asm volatile("s_waitcnt vmcnt(0)" ::: "memory");
        }
    }
    __syncthreads();
}

namespace pg8 {
constexpr int BM = 256, BK = 64, HALF = 128, HTB = HALF * BK * 2, STAGE_BYTES = 8 * HTB, NXCD = 8, WGM = 8;
__host__ __device__ __forceinline__ int lds_byte(int r, int c) { const int st = (r >> 4) * 2 + (c >> 5), rr = r & 15, cc = c & 31, ob = rr * 64 + cc * 2; return st * 1024 + (ob ^ (((ob >> 9) & 1) << 5)); }
__host__ __device__ __forceinline__ void stage_rc(int b, int& R, int& C) { const int st = b / 1024, sb = b % 1024, swz = sb ^ (((sb >> 9) & 1) << 5); R = (st >> 1) * 16 + swz / 64; C = (st & 1) * 32 + (swz % 64) / 2; }
__host__ __device__ __forceinline__ int perm32(int rho) { const int n = rho >> 4, i = rho & 15; return 8 * (i >> 2) + 4 * n + (i & 3); }
struct Unit { int pm, pn; };
struct Gemm { const bf16_t* A; const bf16_t* Bt; int M, N, K, lda, ldb; };
struct StaticOrder {
    int nM, nN, nwg, G, c, latent;
    __host__ __device__ void init(int M, int N, int G_, int c_, int latent_ = 0) { latent = latent_; nM = latent_ ? 64 : M / BM; nN = N / BM; nwg = nM * nN; G = G_; c = c_; }
    __host__ __device__ bool next(int i, Unit& u) const {
        const long L = (long)i * G + c; if (L >= nwg) return false;
        int wgid = (int)L; { const int q = nwg / NXCD, r = nwg % NXCD, xcd = wgid % NXCD, off = wgid / NXCD; wgid = (xcd < r ? xcd * (q + 1) : r * (q + 1) + (xcd - r) * q) + off; }
        const int nig = WGM * nN, gid = wgid / nig, fm = gid * WGM, gsz = (nM - fm) < WGM ? (nM - fm) : WGM;
        u.pm = fm + ((wgid % nig) % gsz); u.pn = (wgid % nig) / gsz; if (latent) u.pm += 1 + (u.pm >= 32 ? 1 : 0); return true;
    }
};
struct WinOrder {
    StaticOrder S; int full, nlat, G, c;
    __host__ __device__ void init(int G_, int c_, int full_) { full = full_; G = G_; c = c_; S.init(TT, NP, G_, c_, full_ ? 0 : 1); nlat = S.nwg; }
    __host__ __device__ bool next(int i, Unit& u) const {
        if (full) return S.next(i, u);
        const long L = (long)i * G + c;
        if (L < nlat) return S.next(i, u);
        const int q = (int)(L - nlat); if (q >= 24) return false;
        const int t = q % 12; u.pm = q < 12 ? 0 : 33;
        u.pn = t < 2 ? 4 + t : (t < 8 ? 8 + (t - 2) : (t == 8 ? 18 : 20 + (t - 9)));
        return true;
    }
};
struct EpiStoreBf16 {
    static constexpr bool PERM = true;
    bf16_t* O; int ldc;
    __device__ __forceinline__ void operator()(const f32x4 (&acc)[2][2][4][2], const Unit& u, int wr, int wc, int fr, int fq) const {
        const int row0 = u.pm * BM + wr * 64 + fr, col0 = u.pn * BM + wc * 32 + 8 * fq;
#pragma unroll
        for (int ai = 0; ai < 2; ++ai)
#pragma unroll
            for (int m = 0; m < 4; ++m) { bf16_t* rowp = O + (size_t)(row0 + ai * HALF + m * 16) * ldc + col0;
#pragma unroll
                for (int bj = 0; bj < 2; ++bj) { const f32x4 v0 = acc[ai][bj][m][0], v1 = acc[ai][bj][m][1];
                    u32x4 w; w.x = cvt_pk_bf16(v0[0], v0[1]); w.y = cvt_pk_bf16(v0[2], v0[3]); w.z = cvt_pk_bf16(v1[0], v1[1]); w.w = cvt_pk_bf16(v1[2], v1[3]);
                    *(u32x4*)(rowp + bj * HALF) = w; } }
    }
};
struct EpiNull {
    static constexpr bool PERM = true;
    __device__ __forceinline__ void operator()(const f32x4 (&acc)[2][2][4][2], const Unit&, int, int, int, int) const {
#pragma unroll
        for (int a = 0; a < 2; ++a)
#pragma unroll
            for (int b = 0; b < 2; ++b)
#pragma unroll
                for (int m = 0; m < 4; ++m)
#pragma unroll
                    for (int n = 0; n < 2; ++n) asm volatile("" :: "v"(acc[a][b][m][n]));
    }
};
template <bool FIRST> struct EpiGate {
    static constexpr bool PERM = true;
    bf16_t* Y; int ldy; const bf16_t* Gt; int ldg;
    __device__ __forceinline__ void operator()(const f32x4 (&acc)[2][2][4][2], const Unit& u, int wr, int wc, int fr, int fq) const {
        const int row0 = u.pm * BM + wr * 64 + fr, col0 = u.pn * BM + wc * 32 + 8 * fq;
#pragma unroll
        for (int ai = 0; ai < 2; ++ai)
#pragma unroll
        for (int mh = 0; mh < 2; ++mh) {
            u32x4 g[2][2], y[2][2];
#pragma unroll
            for (int mm = 0; mm < 2; ++mm)
#pragma unroll
                for (int bj = 0; bj < 2; ++bj) { const size_t r = (size_t)(row0 + ai * HALF + (mh * 2 + mm) * 16);
                    g[mm][bj] = *(const u32x4*)(Gt + r * ldg + col0 + bj * HALF);
                    if (!FIRST) y[mm][bj] = *(const u32x4*)(Y + r * ldy + col0 + bj * HALF); }
#pragma unroll
            for (int mm = 0; mm < 2; ++mm)
#pragma unroll
                for (int bj = 0; bj < 2; ++bj) { const int m = mh * 2 + mm; const size_t r = (size_t)(row0 + ai * HALF + m * 16); const f32x4 v0 = acc[ai][bj][m][0], v1 = acc[ai][bj][m][1]; const u32x4 gg = g[mm][bj];
                    float o[8];
                    o[0] = sigmoidf_(bflo(gg.x)) * v0[0]; o[1] = sigmoidf_(bfhi(gg.x)) * v0[1]; o[2] = sigmoidf_(bflo(gg.y)) * v0[2]; o[3] = sigmoidf_(bfhi(gg.y)) * v0[3];
                    o[4] = sigmoidf_(bflo(gg.z)) * v1[0]; o[5] = sigmoidf_(bfhi(gg.z)) * v1[1]; o[6] = sigmoidf_(bflo(gg.w)) * v1[2]; o[7] = sigmoidf_(bfhi(gg.w)) * v1[3];
                    if (!FIRST) { const u32x4 yy = y[mm][bj];
                        o[0] += bflo(yy.x); o[1] += bfhi(yy.x); o[2] += bflo(yy.y); o[3] += bfhi(yy.y); o[4] += bflo(yy.z); o[5] += bfhi(yy.z); o[6] += bflo(yy.w); o[7] += bfhi(yy.w); }
                    u32x4 w; w.x = cvt_pk_bf16(o[0], o[1]); w.y = cvt_pk_bf16(o[2], o[3]); w.z = cvt_pk_bf16(o[4], o[5]); w.w = cvt_pk_bf16(o[6], o[7]);
                    *(u32x4*)(Y + r * ldy + col0 + bj * HALF) = w; }
        }
    }
};
struct EpiResid {
    static constexpr bool PERM = false;
    float* X; int ldx; const float* gate; float gscale;
    __device__ __forceinline__ void operator()(const f32x4 (&acc)[2][2][4][2], const Unit& u, int wr, int wc, int fr, int fq) const {
        const int row0 = u.pm * BM + wr * 64 + fr, col0 = u.pn * BM + wc * 32 + 4 * fq;
        const int sel = (u.pm % 33 == 0) ? 2 : (u.pm / 33);
        const float* gp = gate + (size_t)sel * 12288 + col0;
        f32x4 gv[2][2];
#pragma unroll
        for (int bj = 0; bj < 2; ++bj)
#pragma unroll
            for (int n = 0; n < 2; ++n) gv[bj][n] = *(const f32x4*)(gp + bj * HALF + n * 16) * gscale;
#pragma unroll
        for (int ai = 0; ai < 2; ++ai)
#pragma unroll
            for (int mh = 0; mh < 2; ++mh) {
                f32x4 x[2][2][2];
#pragma unroll
                for (int mm = 0; mm < 2; ++mm)
#pragma unroll
                    for (int bj = 0; bj < 2; ++bj)
#pragma unroll
                        for (int n = 0; n < 2; ++n) x[mm][bj][n] = *(const f32x4*)(X + (size_t)(row0 + ai * HALF + (mh * 2 + mm) * 16) * ldx + col0 + bj * HALF + n * 16);
#pragma unroll
                for (int mm = 0; mm < 2; ++mm)
#pragma unroll
                    for (int bj = 0; bj < 2; ++bj)
#pragma unroll
                        for (int n = 0; n < 2; ++n) *(f32x4*)(X + (size_t)(row0 + ai * HALF + (mh * 2 + mm) * 16) * ldx + col0 + bj * HALF + n * 16) = x[mm][bj][n] + gv[bj][n] * acc[ai][bj][mh * 2 + mm][n];
            }
    }
};

template <class Epi, class Sched>
__device__ __forceinline__ void gemm_phase(LAS unsigned char* lds, const int tid, const Gemm g, const Sched& S, const Epi& E) {
    const int wid = __builtin_amdgcn_readfirstlane(tid >> 6), lane = tid & 63, wr = wid >> 2, wc = wid & 3, fr = lane & 15, fq = lane >> 4;
    const int K = g.K, nt = K / BK, lda = g.lda, ldb = g.ldb;
    unsigned voffA[2], voffB[2];
#pragma unroll
    for (int i = 0; i < 2; ++i) { int R, C; stage_rc(tid * 16 + i * 8192, R, C); const int Rb = Epi::PERM ? ((R & ~31) + perm32(R & 31)) : R;
        voffA[i] = (unsigned)(R * lda + C) * 2u; voffB[i] = (unsigned)(Rb * ldb + C) * 2u; }
    const size_t kstep = (size_t)(BK * 2);
    const size_t hstepA = (size_t)HALF * lda * 2, hstepB = (size_t)HALF * ldb * 2;
    const size_t tstepA = 2 * hstepA, tstepB = 2 * hstepB;
    const unsigned ldsw = (unsigned)wid * 1024u;
    const int aoff = lds_byte(wr * 64 + fr, fq * 8), boff = lds_byte(wc * 32 + fr, fq * 8);
#define PG8_SA(b, h) (((b) * 2 + (h)) * HTB)
#define PG8_SB(b, h) ((4 + (b) * 2 + (h)) * HTB)
#define PG8_STAGE(bufoff, gbase, voff) do { _Pragma("unroll") for (int _i = 0; _i < 2; ++_i) \
        __builtin_amdgcn_global_load_lds((const unsigned*)((const char*)(gbase) + (voff)[_i]), (LAS unsigned*)(lds + (bufoff) + ldsw + _i * 8192), 16, 0, 0); } while (0)
#define PG8_LDA(dst, b, h) do { _Pragma("unroll") for (int m = 0; m < 4; ++m) _Pragma("unroll") for (int k = 0; k < 2; ++k) dst[m][k] = *(const LAS bf16x8*)(lds + PG8_SA(b, h) + aoff + m * 2048 + k * 1024); } while (0)
#define PG8_LDB(dst, b, h) do { _Pragma("unroll") for (int n = 0; n < 2; ++n) _Pragma("unroll") for (int k = 0; k < 2; ++k) dst[n][k] = *(const LAS bf16x8*)(lds + PG8_SB(b, h) + boff + n * 2048 + k * 1024); } while (0)
#define PG8_MMA(ai, bj, At, Bt) do { __builtin_amdgcn_s_setprio(1); _Pragma("unroll") for (int m = 0; m < 4; ++m) _Pragma("unroll") for (int n = 0; n < 2; ++n) _Pragma("unroll") for (int k = 0; k < 2; ++k) \
        acc[ai][bj][m][n] = __builtin_amdgcn_mfma_f32_16x16x32_bf16(Bt[n][k], At[m][k], acc[ai][bj][m][n], 0, 0, 0); __builtin_amdgcn_s_setprio(0); } while (0)
#define PG8_WAIT_V(n) asm volatile("s_waitcnt vmcnt(" #n ")" ::: "memory")
#define PG8_WAIT_L(n) asm volatile("s_waitcnt lgkmcnt(" #n ")" ::: "memory")
#define PG8_BAR __builtin_amdgcn_s_barrier()
#define PG8_SCHED __builtin_amdgcn_sched_barrier(0)
    Unit cur, nxt; int ui = 0;
    if (!S.next(0, cur)) return;
    f32x4 acc[2][2][4][2];
#pragma unroll
    for (int a = 0; a < 2; ++a)
#pragma unroll
        for (int b = 0; b < 2; ++b)
#pragma unroll
            for (int m = 0; m < 4; ++m)
#pragma unroll
                for (int n = 0; n < 2; ++n) acc[a][b][m][n] = (f32x4){0.f, 0.f, 0.f, 0.f};
    bf16x8 At[4][2], B0[2][2], B1[2][2];
    const char* cA = (const char*)g.A + (size_t)cur.pm * tstepA; const char* cB = (const char*)g.Bt + (size_t)cur.pn * tstepB;
    PG8_STAGE(PG8_SB(0, 0), cB, voffB); PG8_STAGE(PG8_SA(0, 0), cA, voffA); PG8_STAGE(PG8_SB(0, 1), cB + hstepB, voffB); PG8_STAGE(PG8_SA(0, 1), cA + hstepA, voffA);
    if (wr == 1) PG8_BAR;
    PG8_WAIT_V(4); PG8_BAR;
    PG8_STAGE(PG8_SB(1, 0), cB + kstep, voffB); PG8_STAGE(PG8_SA(1, 0), cA + kstep, voffA); PG8_STAGE(PG8_SB(1, 1), cB + hstepB + kstep, voffB);
    PG8_WAIT_V(6); PG8_BAR;
    for (;;) {
        const bool has_next = S.next(ui + 1, nxt);
        const char* nA = has_next ? (const char*)g.A + (size_t)nxt.pm * tstepA : cA; const char* nB = has_next ? (const char*)g.Bt + (size_t)nxt.pn * tstepB : cB;
        for (int t = 0; t < nt; t += 2) {
            const bool last = (t == nt - 2);
            const char* a1 = cA + (size_t)(t + 1) * kstep;
            const char* a2 = last ? nA : cA + (size_t)(t + 2) * kstep; const char* b2 = last ? nB : cB + (size_t)(t + 2) * kstep;
            const char* a3 = a2 + kstep; const char* b3 = b2 + kstep;
            PG8_LDB(B0, 0, 0); PG8_SCHED; PG8_LDA(At, 0, 0); PG8_STAGE(PG8_SA(1, 1), a1 + hstepA, voffA);
            PG8_WAIT_L(8); PG8_BAR; PG8_WAIT_L(0); PG8_MMA(0, 0, At, B0); PG8_BAR; PG8_SCHED;
            PG8_LDB(B1, 0, 1); PG8_STAGE(PG8_SB(0, 0), b2, voffB);
            PG8_BAR; PG8_WAIT_L(0); PG8_MMA(0, 1, At, B1); PG8_BAR;
            PG8_LDA(At, 0, 1); PG8_STAGE(PG8_SA(0, 0), a2, voffA);
            PG8_BAR; PG8_WAIT_L(0); PG8_MMA(1, 0, At, B0); PG8_BAR; PG8_SCHED;
            PG8_STAGE(PG8_SB(0, 1), b2 + hstepB, voffB);
            PG8_WAIT_V(6); PG8_BAR; PG8_MMA(1, 1, At, B1); PG8_BAR;
            PG8_LDB(B0, 1, 0); PG8_SCHED; PG8_LDA(At, 1, 0); PG8_STAGE(PG8_SA(0, 1), a2 + hstepA, voffA);
            PG8_WAIT_L(8); PG8_BAR; PG8_WAIT_L(0); PG8_MMA(0, 0, At, B0); PG8_BAR; PG8_SCHED;
            PG8_LDB(B1, 1, 1); PG8_STAGE(PG8_SB(1, 0), b3, voffB);
            PG8_BAR; PG8_WAIT_L(0); PG8_MMA(0, 1, At, B1); PG8_BAR;
            PG8_LDA(At, 1, 1); PG8_STAGE(PG8_SA(1, 0), a3, voffA);
            PG8_BAR; PG8_WAIT_L(0); PG8_MMA(1, 0, At, B0); PG8_BAR; PG8_SCHED;
            PG8_STAGE(PG8_SB(1, 1), b3 + hstepB, voffB);
            PG8_WAIT_V(6); PG8_BAR; PG8_MMA(1, 1, At, B1); PG8_BAR;
        }
        E(acc, cur, wr, wc, fr, fq);
        if (!has_next) break;
#pragma unroll
        for (int a = 0; a < 2; ++a)
#pragma unroll
            for (int b = 0; b < 2; ++b)
#pragma unroll
                for (int m = 0; m < 4; ++m)
#pragma unroll
                    for (int n = 0; n < 2; ++n) acc[a][b][m][n] = (f32x4){0.f, 0.f, 0.f, 0.f};
        cur = nxt; cA = nA; cB = nB; ++ui;
    }
    PG8_WAIT_V(0);
    if (wr == 0) PG8_BAR;
    PG8_BAR;
#undef PG8_SA
#undef PG8_SB
#undef PG8_STAGE
#undef PG8_LDA
#undef PG8_LDB
#undef PG8_MMA
#undef PG8_WAIT_V
#undef PG8_WAIT_L
#undef PG8_BAR
#undef PG8_SCHED
}
}

struct Args { const float* in[30]; float* out; unsigned char* ws; int ph_lo, ph_hi; };
enum { I_X = 0, I_C, I_CTX, I_CCTX, I_WMOD, I_BMOD, I_N1G, I_WIN, I_QNG, I_KNG, I_WA2F, I_BAF, I_WA2B, I_BAB, I_ONG, I_MQNG, I_WUQ, I_MKVNG, I_WUKV,
       I_WBRA, I_WBRL, I_WBRM, I_WOUT, I_N2G, I_PWQ, I_PK1, I_PK2, I_PU, I_PV, I_FG };
typedef const float* cfp_t;
struct Ctx {
    const __attribute__((address_space(4))) cfp_t* in; float* out; unsigned char* ws; LAS unsigned char* lds;
    int tid, lane, wid, G, bid;
};
#define WSP(T, off) ((T*)(C.ws + (off)))
#define INP(i) ((const float*)(const GLB float*)C.in[(i)])
__device__ __forceinline__ unsigned long long launder_u64(unsigned long long w) {
    unsigned lo = (unsigned)w, hi = (unsigned)(w >> 32); asm volatile("" : "+v"(lo), "+v"(hi));
    lo = __builtin_amdgcn_readfirstlane(lo); hi = __builtin_amdgcn_readfirstlane(hi); return ((unsigned long long)hi << 32) | lo;
}
__device__ __forceinline__ Ctx launder(const Ctx& C0) {
    Ctx R = C0; int t = C0.tid; asm volatile("" : "+v"(t)); R.tid = t; R.lane = t & 63; R.wid = __builtin_amdgcn_readfirstlane(t >> 6);
    R.ws = (unsigned char*)(GLB unsigned char*)launder_u64((unsigned long long)C0.ws);
    R.out = (float*)(GLB float*)(unsigned long long)C0.out;
    R.in = (const __attribute__((address_space(4))) cfp_t*)launder_u64((unsigned long long)C0.in);
    unsigned l = (unsigned)(uintptr_t)C0.lds; asm volatile("" : "+v"(l)); l = __builtin_amdgcn_readfirstlane(l); R.lds = (LAS unsigned char*)(uintptr_t)l;
    return R;
}

__device__ __forceinline__ const float* src_row(const Ctx& C, int r) {
    const int b = r / RPB, j = r % RPB;
    return j < CTXL ? INP(I_CTX) + ((size_t)b * CTXL + j) * DM : INP(I_X) + ((size_t)b * SEQ + (j - CTXL)) * DM;
}
__device__ __forceinline__ int mod_sel(int r) { const int b = r / RPB, j = r % RPB; return j < CTXL ? 2 : b; }

__device__ __forceinline__ void phase_modv(const Ctx& C) {
    LAS float* sc = (LAS float*)C.lds;
    LAS float* red = (LAS float*)(C.lds + 3 * 2048 * 4);
    for (int i = C.tid; i < 3 * DM; i += NTHREADS) { const int r = i / DM, k = i % DM; const float v = r < 2 ? INP(I_C)[r * DM + k] : INP(I_CCTX)[k]; sc[i] = siluf_(v); }
    __syncthreads();
    float* modv = WSP(float, WS_MODV);
    const int kq = C.tid / 12, c4 = C.tid % 12;
    for (int item = C.bid; item < 2 * 256; item += C.G) {
        const int l = item / 256, cg = item % 256;
        float acc[3][4];
#pragma unroll
        for (int r = 0; r < 3; ++r)
#pragma unroll
            for (int j = 0; j < 4; ++j) acc[r][j] = 0.f;
        if (kq < 42) {
            const float* wp = INP(I_WMOD) + (size_t)l * DM * 12288 + 48 * cg + 4 * c4;
#pragma unroll 1
            for (int k0 = kq; k0 < DM; k0 += 42 * 7) {
                f32x4 w[7];
#pragma unroll
                for (int u = 0; u < 7; ++u) { const int k = k0 + 42 * u; w[u] = k < DM ? *(const f32x4*)(wp + (size_t)k * 12288) : (f32x4){0.f, 0.f, 0.f, 0.f}; }
#pragma unroll
                for (int u = 0; u < 7; ++u) { const int k = k0 + 42 * u; if (k < DM) {
#pragma unroll
                    for (int r = 0; r < 3; ++r) { const float sv = sc[r * DM + k];
#pragma unroll
                        for (int j = 0; j < 4; ++j) acc[r][j] += sv * w[u][j]; } } }
            }
#pragma unroll
            for (int r = 0; r < 3; ++r)
#pragma unroll
                for (int j = 0; j < 4; ++j) red[kq * 144 + r * 48 + c4 * 4 + j] = acc[r][j];
        }
        __syncthreads();
        if (C.tid < 144) { float s = 0.f; for (int q = 0; q < 42; ++q) s += red[q * 144 + C.tid];
            const int r = C.tid / 48, cc = C.tid % 48;
            modv[((size_t)l * 3 + r) * 12288 + 48 * cg + cc] = s + INP(I_BMOD)[(size_t)l * 12288 + 48 * cg + cc]; }
        __syncthreads();
    }
}
__device__ __forceinline__ void phase_tables(const Ctx& C) {
    float* ta = WSP(float, WS_TABA); float* tm = WSP(float, WS_TABM);
    for (int i = C.bid * NTHREADS + C.tid; i < 128 * 32 + 128 * 16; i += C.G * NTHREADS) {
        if (i < 128 * 32) { const int pos = i / 32, f = i % 32; const float inv = exp2f(-(float)f * (13.287712379549449f / 32.0f)); const float a = (float)pos * inv;
            ta[i] = cosf(a); ta[128 * 32 + i] = sinf(a); }
        else { const int k = i - 128 * 32, pos = k / 16, f = k % 16; const float inv = exp2f(-(float)f * (13.287712379549449f / 16.0f)); const float a = (float)pos * inv;
            tm[k] = cosf(a); tm[128 * 16 + k] = sinf(a); }
    }
}
__device__ __forceinline__ void transpose_cvt(const Ctx& C, const float* src, int K, int N, bf16_t* dst, int Npad, int& item) {
    LAS float* tile = (LAS float*)C.lds;
    const int tk = K / 64, tn = Npad / 256, ntile = tk * tn;
    const int t0 = ((C.bid - item % C.G) + C.G) % C.G; item += ntile;
    for (int t = t0; t < ntile; t += C.G) {
        const int k0 = (t / tn) * 64, n0 = (t % tn) * 256;
        const int nn = (C.tid & 63) * 4, kr = C.tid >> 6;
        f32x4 v[8];
#pragma unroll
        for (int p = 0; p < 8; ++p) { v[p] = (f32x4){0.f, 0.f, 0.f, 0.f}; if (n0 + nn < N) v[p] = *(const f32x4*)(src + (size_t)(k0 + kr + p * 8) * N + n0 + nn); }
#pragma unroll
        for (int p = 0; p < 8; ++p)
#pragma unroll
            for (int j = 0; j < 4; ++j) tile[(kr + p * 8) * 257 + nn + j] = v[p][j];
        __syncthreads();
        { const int n = C.tid >> 1, kh = (C.tid & 1) * 32;
#pragma unroll
          for (int q = 0; q < 4; ++q) { float x[8];
#pragma unroll
              for (int j = 0; j < 8; ++j) x[j] = tile[(kh + q * 8 + j) * 257 + n];
              u32x4 w; w.x = cvt_pk_bf16(x[0], x[1]); w.y = cvt_pk_bf16(x[2], x[3]); w.z = cvt_pk_bf16(x[4], x[5]); w.w = cvt_pk_bf16(x[6], x[7]);
              *(u32x4*)(dst + (size_t)(n0 + n) * K + k0 + kh + q * 8) = w; } }
        __syncthreads();
    }
}
__device__ __forceinline__ void cvt_plain(const Ctx& C, const float* src, bf16_t* dst, size_t n8) {
    for (size_t i = (size_t)C.bid * NTHREADS + C.tid; i < n8; i += (size_t)C.G * NTHREADS) {
        const f32x4 a = *(const f32x4*)(src + i * 8), b = *(const f32x4*)(src + i * 8 + 4);
        u32x4 w; w.x = cvt_pk_bf16(a[0], a[1]); w.y = cvt_pk_bf16(a[2], a[3]); w.z = cvt_pk_bf16(b[0], b[1]); w.w = cvt_pk_bf16(b[2], b[3]);
        *(u32x4*)(dst + i * 8) = w;
    }
}
__device__ __forceinline__ void phase_cvt_mixer_weights(const Ctx& C, int l) {
    int item = 0;
    transpose_cvt(C, INP(I_WIN) + (size_t)l * DM * IN_COLS, DM, IN_COLS, WSP(bf16_t, WS_WIN), NP, item);
    transpose_cvt(C, INP(I_WUQ) + (size_t)l * 512 * 1536, 512, 1536, WSP(bf16_t, WS_WUQ), 1536, item);
    transpose_cvt(C, INP(I_WUKV) + (size_t)l * 512 * 2048, 512, 2048, WSP(bf16_t, WS_WUKV), 2048, item);
    transpose_cvt(C, INP(I_WBRA) + (size_t)l * 1024 * 2048, 1024, 2048, WSP(bf16_t, WS_WBR), 2048, item);
    transpose_cvt(C, INP(I_WBRL) + (size_t)l * 1024 * 2048, 1024, 2048, WSP(bf16_t, WS_WBR) + (size_t)2048 * 1024, 2048, item);
    transpose_cvt(C, INP(I_WBRM) + (size_t)l * 1024 * 2048, 1024, 2048, WSP(bf16_t, WS_WBR) + (size_t)2 * 2048 * 1024, 2048, item);
    transpose_cvt(C, INP(I_WOUT) + (size_t)l * 2048 * 2048, 2048, 2048, WSP(bf16_t, WS_WOUT), 2048, item);
    transpose_cvt(C, INP(I_PWQ) + (size_t)l * 2048 * 2048, 2048, 2048, WSP(bf16_t, WS_WQ), 2048, item);
    cvt_plain(C, INP(I_PK1) + (size_t)l * 8 * 128 * 128, WSP(bf16_t, WS_K1), 8 * 128 * 128 / 8);
    cvt_plain(C, INP(I_PK2) + (size_t)l * 8 * 128 * 128, WSP(bf16_t, WS_K2), 8 * 128 * 128 / 8);
}
__device__ __forceinline__ void phase_cvt_peer_tables(const Ctx& C, int l, int row_lo, int row_hi, int wg_lo) {
    const int lane = C.lane; if (C.bid < wg_lo) return;
    unsigned char* pt = C.ws + WS_PT + (size_t)l * PT_BYTES;
    for (int row = row_lo + (C.bid - wg_lo) * 8 + C.wid; row < row_hi; row += (C.G - wg_lo) * 8) {
#pragma unroll 1
        for (int tb = 0; tb < 2; ++tb) {
            const float* src = (tb ? INP(I_PV) : INP(I_PU)) + ((size_t)l * NEXP + row) * DM + lane * 16;
            f32x4 x[8]; float amax = 0.f;
#pragma unroll
            for (int c = 0; c < 2; ++c)
#pragma unroll
                for (int q = 0; q < 4; ++q) { x[c * 4 + q] = *(const f32x4*)(src + c * 1024 + q * 4);
                    amax = fmaxf(amax, fmaxf(fmaxf(fabsf(x[c * 4 + q][0]), fabsf(x[c * 4 + q][1])), fmaxf(fabsf(x[c * 4 + q][2]), fabsf(x[c * 4 + q][3])))); }
            amax = fmaxf(amax, xchg32(amax, lane)); amax = fmaxf(amax, xchg16(amax, lane)); amax = fmaxf(amax, dppmov<DPP_ROR8>(amax));
            amax = fmaxf(amax, dppmov<DPP_HMIRROR>(amax)); amax = fmaxf(amax, dppmov<DPP_Q3210>(amax)); amax = fmaxf(amax, dppmov<DPP_Q1032>(amax));
            const float sc = amax > 0.f ? 224.0f / amax : 1.0f, inv = amax > 0.f ? amax * (1.0f / 224.0f) : 1.0f;
            unsigned char* dst = pt + (tb ? PT_V8 : PT_U8) + (size_t)(lane >> 3) * ((size_t)NEXP * 128) + (size_t)row * 128 + (lane & 7) * 16;
#pragma unroll
            for (int c = 0; c < 2; ++c) { u32x4 w;
#pragma unroll
                for (int q = 0; q < 4; ++q) { const f32x4 v = x[c * 4 + q] * sc; int p = __builtin_amdgcn_cvt_pk_fp8_f32(v[0], v[1], 0, false); p = __builtin_amdgcn_cvt_pk_fp8_f32(v[2], v[3], p, true); w[q] = (unsigned)p; }
                *(u32x4*)(dst + (size_t)c * 8 * ((size_t)NEXP * 128)) = w; }
            if (lane == 0) ((float*)(pt + (tb ? PT_SCV : PT_SCU)))[row] = inv;
        }
    }
}

template <bool FIRST> __device__ __forceinline__ void phase_norm_mod(const Ctx& C, const float* gvec, const float* modl  , int shift_off, int scale_off) {
    float* xs = WSP(float, WS_XS); bf16_t* hb = WSP(bf16_t, WS_HB);
    for (int r = C.bid * 8 + C.wid; r < TT; r += C.G * 8) {
        const float* xr = FIRST ? src_row(C, r) : xs + (size_t)r * DM;
        const float* mv = modl + (size_t)mod_sel(r) * 12288;
        f32x4 v[8]; float ss = 0.f;
#pragma unroll
        for (int c = 0; c < 4; ++c) { v[2 * c] = *(const f32x4*)(xr + c * 512 + C.lane * 8); v[2 * c + 1] = *(const f32x4*)(xr + c * 512 + C.lane * 8 + 4); }
#pragma unroll
        for (int c = 0; c < 8; ++c) ss += v[c][0] * v[c][0] + v[c][1] * v[c][1] + v[c][2] * v[c][2] + v[c][3] * v[c][3];
        ss = wave_sum(ss);
        const float rs = rsqrtf(ss * (1.0f / DM) + NORM_EPS);
#pragma unroll
        for (int c = 0; c < 4; ++c) { const int col = c * 512 + C.lane * 8;
            if (FIRST) { *(f32x4*)(xs + (size_t)r * DM + col) = v[2 * c]; *(f32x4*)(xs + (size_t)r * DM + col + 4) = v[2 * c + 1]; }
            float o[8];
#pragma unroll
            for (int h = 0; h < 2; ++h) { const f32x4 g = *(const f32x4*)(gvec + col + 4 * h), s = *(const f32x4*)(mv + scale_off + col + 4 * h), t = *(const f32x4*)(mv + shift_off + col + 4 * h);
#pragma unroll
                for (int j = 0; j < 4; ++j) o[4 * h + j] = v[2 * c + h][j] * rs * g[j] * (1.0f + s[j]) + t[j]; }
            u32x4 w; w.x = cvt_pk_bf16(o[0], o[1]); w.y = cvt_pk_bf16(o[2], o[3]); w.z = cvt_pk_bf16(o[4], o[5]); w.w = cvt_pk_bf16(o[6], o[7]);
            *(u32x4*)(hb + (size_t)r * DM + col) = w; }
    }
}

__device__ __forceinline__ void phase_post_p(const Ctx& C, int l) {
    bf16_t* P = WSP(bf16_t, WS_P); const float* ta = WSP(float, WS_TABA); const float* tm = WSP(float, WS_TABM);
    const float* qg = INP(I_QNG) + l * 128; const float* kg = INP(I_KNG) + l * 128;
    const float* mqg = INP(I_MQNG) + l * 512; const float* mkvg = INP(I_MKVNG) + l * 512;
    const int lane = C.lane;
    const float qg1 = qg[lane], qg2 = qg[lane + 64], kg1 = kg[lane], kg2 = kg[lane + 64];
    for (int r = C.bid * 8 + C.wid; r < TT; r += C.G * 8) {
        bf16_t* pr = P + (size_t)r * NP;
        const int j = r % RPB; const bool lat = j >= CTXL; const int pos = lat ? j - CTXL : 0, ri = pos >> 6, ci = pos & 63;
        float cs = 1.f, sn = 0.f;
        if (lat) { const int p = lane < 32 ? ri : ci, f = lane & 31; cs = ta[p * 32 + f]; sn = ta[128 * 32 + p * 32 + f]; }
#pragma unroll
        for (int h = 0; h < 10; ++h) {
            bf16_t* hp = pr + (h < 8 ? C_AQ + h * 128 : C_AK + (h - 8) * 128);
            const float x1 = bf2f(hp[lane]), x2 = bf2f(hp[lane + 64]);
            const float ss = wave_sum(x1 * x1 + x2 * x2);
            const float rs = rsqrtf(ss * (1.0f / 128.0f) + NORM_EPS);
            const float y1 = x1 * rs * (h < 8 ? qg1 : kg1), y2 = x2 * rs * (h < 8 ? qg2 : kg2);
            hp[lane] = f2bf(y1 * cs - y2 * sn); hp[lane + 64] = f2bf(y2 * cs + y1 * sn);
        }
#pragma unroll
        for (int s = 0; s < 2; ++s) {
            bf16_t* sp = pr + (s == 0 ? C_MCQ : C_MCKV) + lane * 8; const float* gg = (s == 0 ? mqg : mkvg) + lane * 8;
            const u32x4 w = *(const u32x4*)sp; float x[8] = {bflo(w.x), bfhi(w.x), bflo(w.y), bfhi(w.y), bflo(w.z), bfhi(w.z), bflo(w.w), bfhi(w.w)};
            float ss = 0.f;
#pragma unroll
            for (int i = 0; i < 8; ++i) ss += x[i] * x[i];
            ss = wave_sum(ss);
            const float rs = rsqrtf(ss * (1.0f / 512.0f) + NORM_EPS);
#pragma unroll
            for (int i = 0; i < 8; ++i) x[i] = x[i] * rs * gg[i];
            u32x4 o; o.x = cvt_pk_bf16(x[0], x[1]); o.y = cvt_pk_bf16(x[2], x[3]); o.z = cvt_pk_bf16(x[4], x[5]); o.w = cvt_pk_bf16(x[6], x[7]);
            *(u32x4*)sp = o;
        }
        if (lat) { bf16_t* kp = pr + C_MKR; const int i = lane & 31; const float x1 = bf2f(kp[i]), x2 = bf2f(kp[i + 32]);
            const int p = i < 16 ? ri : ci, f = i & 15; const float c2 = tm[p * 16 + f], s2 = tm[128 * 16 + p * 16 + f];
            if (lane < 32) { kp[i] = f2bf(x1 * c2 - x2 * s2); kp[i + 32] = f2bf(x2 * c2 + x1 * s2); } }
    }
}

namespace att {
constexpr int NW = 8, QBLK = 32, KVBLK = 64, DV = 128;
constexpr float THR = 8.f;
#define SBAR() __builtin_amdgcn_sched_barrier(0)
__device__ __forceinline__ int crow(int r, int hi) { return (r & 3) + 8 * (r >> 2) + 4 * hi; }
template <int DQ> struct Cf {
    static constexpr int ND0 = DQ / 16, KROWB = DQ * 2, SHM_K = KVBLK * DQ * 2, SHM_V = KVBLK * DV * 2, SHM = 2 * SHM_V + 2 * SHM_K + NW * 64 * 4;
    static constexpr float SCALE = DQ == 128 ? 0.088388347648318440f : 0.072168783648703220f;
    __device__ static __forceinline__ int kswz(int row, int colB) { return row * KROWB + (colB ^ ((row & 7) << 4)); }
};
template <int DQ, int VAR = 0> __device__ __forceinline__ void partialSM(f32x16& p0, f32x16& p1, float& m_reg, float& mn, float& alpha) {
    constexpr float SC = Cf<DQ>::SCALE, Cc = SC * 1.4426950408889634f;
    float pmax = p0[0];
#pragma unroll
    for (int r = 1; r < 16; ++r) pmax = fmaxf(pmax, p0[r]);
#pragma unroll
    for (int r = 0; r < 16; ++r) pmax = fmaxf(pmax, p1[r]);
    { auto rr = __builtin_amdgcn_permlane32_swap(__float_as_uint(pmax), __float_as_uint(pmax), false, false);
      pmax = fmaxf(__uint_as_float(rr[0]), __uint_as_float(rr[1])); }
    if (__builtin_expect(__all(pmax - m_reg <= THR / SC), 1)) { mn = m_reg; alpha = 1.f; }
    else { mn = fmaxf(m_reg, pmax); alpha = __builtin_amdgcn_exp2f((m_reg - mn) * Cc); m_reg = mn; }
    const float mnC = -mn * Cc;
#pragma unroll
    for (int r = 0; r < 16; ++r) p0[r] = fmaf(p0[r], Cc, mnC);
#pragma unroll
    for (int r = 0; r < 16; ++r) p1[r] = fmaf(p1[r], Cc, mnC);
#pragma unroll
    for (int r = 0; r < 16; ++r) p0[r] = VAR == 1 ? p0[r] * 0.001f : __builtin_amdgcn_exp2f(p0[r]);
}
template <int VAR = 0> __device__ __forceinline__ void finishSM(f32x16& p0, f32x16& p1, float alpha, float& l_reg, bf16x8& pa0, bf16x8& pa1, bf16x8& pa2, bf16x8& pa3) {
#pragma unroll
    for (int r = 0; r < 16; ++r) p1[r] = VAR == 1 ? p1[r] * 0.001f : __builtin_amdgcn_exp2f(p1[r]);
    float ps = 0;
#pragma unroll
    for (int r = 0; r < 16; ++r) ps += p0[r];
#pragma unroll
    for (int r = 0; r < 16; ++r) ps += p1[r];
    { auto rr = __builtin_amdgcn_permlane32_swap(__float_as_uint(ps), __float_as_uint(ps), false, false);
      ps = __uint_as_float(rr[0]) + __uint_as_float(rr[1]); }
    l_reg = l_reg * alpha + ps;
#define PK4(P, BASE, OUT) do { unsigned a0 = cvt_pk_bf16(P[BASE + 0], P[BASE + 1]), a1 = cvt_pk_bf16(P[BASE + 2], P[BASE + 3]);   \
    unsigned b0 = cvt_pk_bf16(P[BASE + 4], P[BASE + 5]), b1 = cvt_pk_bf16(P[BASE + 6], P[BASE + 7]);                              \
    auto r0 = __builtin_amdgcn_permlane32_swap(a0, b0, false, false); auto r1 = __builtin_amdgcn_permlane32_swap(a1, b1, false, false); \
    u32x4 w = {r0[0], r1[0], r0[1], r1[1]}; OUT = *reinterpret_cast<bf16x8*>(&w); } while (0)
    PK4(p0, 0, pa0); PK4(p0, 8, pa1); PK4(p1, 0, pa2); PK4(p1, 8, pa3);
#undef PK4
}
template <int DQ> __device__ __forceinline__ void qkt(f32x16& p0, f32x16& p1, const char* Ks, const bf16x8* qr, const char* qx, int r32, int hi) {
    p0 = f32x16{}; p1 = f32x16{};
#pragma unroll
    for (int d0 = 0; d0 < Cf<DQ>::ND0; ++d0) { const int cb = (d0 * 16 + hi * 8) * 2;
        const bf16x8 b0 = *reinterpret_cast<const bf16x8*>(Ks + Cf<DQ>::kswz(r32, cb));
        const bf16x8 b1 = *reinterpret_cast<const bf16x8*>(Ks + Cf<DQ>::kswz(32 + r32, cb));
        constexpr int NQR = DQ == 192 ? MLA_NQR : 8;
        bf16x8 q; if (d0 < NQR) q = qr[d0]; else q = *reinterpret_cast<const bf16x8*>(qx + (d0 - NQR) * 1024);
        p0 = __builtin_amdgcn_mfma_f32_32x32x16_bf16(b0, q, p0, 0, 0, 0);
        p1 = __builtin_amdgcn_mfma_f32_32x32x16_bf16(b1, q, p1, 0, 0, 0); }
}
__device__ __forceinline__ int v_st(int k, int c) { const int kk = (k & ~0xC) | ((k & 4) << 1) | ((k & 8) >> 1); return ((kk >> 3) * 4 + (c >> 5)) * 512 + ((kk & 7) * 32 + (c & 31)) * 2; }
__device__ __forceinline__ int v_rd_base(int lane) { return ((lane & 3) << 3) | (((lane >> 2) & 3) << 6) | (((lane >> 4) & 1) << 5) | (((lane >> 5) & 1) << 8); }
constexpr int v_rd_off(int d0, int ks, int half) { return d0 * 512 + ks * 4096 + half * 2048; }
template <int OFF> __device__ __forceinline__ s16x4 tr_read(int vb) {
    s16x4 r; asm volatile("ds_read_b64_tr_b16 %0, %1 offset:%2" : "=&v"(r) : "v"(vb), "i"(OFF) : "memory"); return r;
}
template <int D0> __device__ __forceinline__ void pv_one(f32x16& od, int vb, bf16x8 pa0, bf16x8 pa1, bf16x8 pa2, bf16x8 pa3) {
    const s16x4 l0 = tr_read<v_rd_off(D0, 0, 0)>(vb), h0 = tr_read<v_rd_off(D0, 0, 1)>(vb), l1 = tr_read<v_rd_off(D0, 1, 0)>(vb), h1 = tr_read<v_rd_off(D0, 1, 1)>(vb);
    const s16x4 l2 = tr_read<v_rd_off(D0, 2, 0)>(vb), h2 = tr_read<v_rd_off(D0, 2, 1)>(vb), l3 = tr_read<v_rd_off(D0, 3, 0)>(vb), h3 = tr_read<v_rd_off(D0, 3, 1)>(vb);
    asm volatile("s_waitcnt lgkmcnt(0)" ::: "memory"); SBAR();
#define PK(L, H) (bf16x8){L[0], L[1], L[2], L[3], H[0], H[1], H[2], H[3]}
    od = __builtin_amdgcn_mfma_f32_32x32x16_bf16(pa0, PK(l0, h0), od, 0, 0, 0);
    od = __builtin_amdgcn_mfma_f32_32x32x16_bf16(pa1, PK(l1, h1), od, 0, 0, 0);
    od = __builtin_amdgcn_mfma_f32_32x32x16_bf16(pa2, PK(l2, h2), od, 0, 0, 0);
    od = __builtin_amdgcn_mfma_f32_32x32x16_bf16(pa3, PK(l3, h3), od, 0, 0, 0);
#undef PK
}
__device__ __forceinline__ void pv_d0(f32x16* o, int vb, bf16x8 pa0, bf16x8 pa1, bf16x8 pa2, bf16x8 pa3) {
    pv_one<0>(o[0], vb, pa0, pa1, pa2, pa3); pv_one<1>(o[1], vb, pa0, pa1, pa2, pa3); pv_one<2>(o[2], vb, pa0, pa1, pa2, pa3); pv_one<3>(o[3], vb, pa0, pa1, pa2, pa3);
}
__device__ __forceinline__ bf16x8 ld8(const bf16_t* p) { return *reinterpret_cast<const bf16x8*>(p); }

template <int DQ, int SD, int VAR = 0>
__device__ __forceinline__ void attn_body(const bf16_t* __restrict__ Qb, int ldq, const bf16_t* __restrict__ Kn, int ldkn, const bf16_t* __restrict__ Kr, int ldkr,
                                          const bf16_t* __restrict__ Vh, int ldv, bf16_t* __restrict__ Ob, int ldo, int seq, bool rope_q, int pos0, const float* __restrict__ tabM, char* lds, const int tid) {
    using CF = Cf<DQ>; constexpr int ND0 = CF::ND0, SHM_V = CF::SHM_V, SHM_K = CF::SHM_K;
    const int wid = tid >> 6, lane = tid & 63, r32 = lane & 31, hi = lane >> 5;
    char* V_lds = lds; char* K_lds = lds + 2 * SHM_V;
    float* ws = (float*)(lds + 2 * SHM_V + 2 * SHM_K) + wid * 64; float* li_l = ws; float* al_l = ws + 32;
    constexpr int NQR = DQ == 192 ? MLA_NQR : 8;
    float m_reg = -1e30f, l_reg = 0; f32x16 o[4] = {}; bf16x8 qr[NQR];
    const bf16_t* Qw = Qb + (long)(wid * QBLK + r32) * ldq + hi * 8;
#pragma unroll
    for (int d0 = 0; d0 < NQR; ++d0) qr[d0] = ld8(Qw + d0 * 16);
    char* qx = lds + CF::SHM + wid * 8192 + lane * 16;
    if constexpr (DQ == 192) {
#pragma unroll
        for (int d0 = NQR; d0 < 8; ++d0) *(bf16x8*)(qx + (d0 - NQR) * 1024) = ld8(Qw + d0 * 16);
        bf16x8 qe[4];
#pragma unroll
        for (int d0 = 0; d0 < 4; ++d0) qe[d0] = ld8(Qw + (8 + d0) * 16);
        if (rope_q) {
            const int pos = pos0 + wid * QBLK + r32, ri = pos >> 6, ci = pos & 63;
#pragma unroll
            for (int t = 0; t < 2; ++t) { const int p = t == 0 ? ri : ci; const float* tc = tabM + p * 16 + hi * 8; const float* tsn = tabM + 128 * 16 + p * 16 + hi * 8;
                bf16x8 a = qe[t], b = qe[2 + t];
#pragma unroll
                for (int jj = 0; jj < 8; ++jj) { const float x1 = bf2f((bf16_t)a[jj]), x2 = bf2f((bf16_t)b[jj]), c = tc[jj], s = tsn[jj];
                    a[jj] = (short)f2bf(x1 * c - x2 * s); b[jj] = (short)f2bf(x2 * c + x1 * s); }
                qe[t] = a; qe[2 + t] = b; }
        }
#pragma unroll
        for (int d0 = 0; d0 < 4; ++d0) *(bf16x8*)(qx + (8 - NQR + d0) * 1024) = qe[d0];
    }
    const int sr = tid >> 4, sc = (tid & 15) * 8, vst0 = v_st(sr, sc), vst1 = v_st(32 + sr, sc);
    const int sr2 = tid >> 3, sc2 = (tid & 7) * 8;
    const int vb0 = (int)(uintptr_t)V_lds + v_rd_base(lane);
    struct { bf16x8 vs0, vs1, ks0, ks1, ks2; } sr_[SD];
    const unsigned offV = (unsigned)(sr * ldv + sc) * 2u, offK = (unsigned)(sr * ldkn + sc) * 2u, offR = (unsigned)(sr2 * ldkr + sc2) * 2u;
#define SLOAD(i, k0) do { const char* vt_ = (const char*)Vh + (size_t)(k0) * ldv * 2; const char* kt_ = (const char*)Kn + (size_t)(k0) * ldkn * 2; \
    sr_[i].vs0 = *(const bf16x8*)(vt_ + offV); sr_[i].vs1 = *(const bf16x8*)(vt_ + (size_t)32 * ldv * 2 + offV); \
    sr_[i].ks0 = *(const bf16x8*)(kt_ + offK); sr_[i].ks1 = *(const bf16x8*)(kt_ + (size_t)32 * ldkn * 2 + offK); \
    if constexpr (DQ == 192) sr_[i].ks2 = *(const bf16x8*)((const char*)Kr + (size_t)(k0) * ldkr * 2 + offR); } while (0)
#define SWRITE(b, i) do { *(bf16x8*)(V_lds + (b) * SHM_V + vst0) = sr_[i].vs0; *(bf16x8*)(V_lds + (b) * SHM_V + vst1) = sr_[i].vs1; const int kc = sc * 2; \
    *(bf16x8*)(K_lds + (b) * SHM_K + CF::kswz(sr, kc)) = sr_[i].ks0; *(bf16x8*)(K_lds + (b) * SHM_K + CF::kswz(32 + sr, kc)) = sr_[i].ks1; \
    if constexpr (DQ == 192) *(bf16x8*)(K_lds + (b) * SHM_K + CF::kswz(sr2, 256 + sc2 * 2)) = sr_[i].ks2; } while (0)
#define SWAIT() do { if constexpr (SD == 1) asm volatile("s_waitcnt vmcnt(0)" ::: "memory"); else if constexpr (DQ == 192) asm volatile("s_waitcnt vmcnt(5)" ::: "memory"); else asm volatile("s_waitcnt vmcnt(4)" ::: "memory"); } while (0)
#define RESC(a) do { if (__any((a) < 1.f)) { if (hi == 0) al_l[r32] = (a); asm volatile("s_waitcnt lgkmcnt(0)" ::: "memory"); \
    _Pragma("unroll") for (int d = 0; d < 4; ++d) _Pragma("unroll") for (int r = 0; r < 16; ++r) o[d][r] *= al_l[crow(r, hi)]; } } while (0)
    f32x16 pA0, pA1, pB0, pB1; float mnA, mnB, alA, alB; bf16x8 pa0, pa1, pa2, pa3; const int NT = seq / KVBLK;
    constexpr int SE = 0, SO = SD - 1;
    SLOAD(SE, 0); asm volatile("s_waitcnt vmcnt(0)" ::: "memory"); SWRITE(0, SE); __syncthreads();
    qkt<DQ>(pA0, pA1, K_lds, qr, qx, r32, hi); partialSM<DQ, VAR>(pA0, pA1, m_reg, mnA, alA);
    SLOAD(SO, KVBLK); if constexpr (SD == 2) { if (2 < NT) SLOAD(SE, 2 * KVBLK); }
    SWAIT(); SWRITE(1, SO); __syncthreads();
#define ATT_SYNC() do { if constexpr (VAR != 2) __syncthreads(); } while (0)
    for (int j = 1; j + 1 < NT; j += 2) {
        SBAR(); qkt<DQ>(pB0, pB1, K_lds + SHM_K, qr, qx, r32, hi);
        finishSM<VAR>(pA0, pA1, alA, l_reg, pa0, pa1, pa2, pa3); SBAR();
        if constexpr (VAR != 3) SLOAD(SO, (j + SD) * KVBLK); SBAR();
        pv_d0(o, vb0, pa0, pa1, pa2, pa3); partialSM<DQ, VAR>(pB0, pB1, m_reg, mnB, alB);
        ATT_SYNC(); SWAIT(); SWRITE(0, SE);
        RESC(alB); ATT_SYNC();
        SBAR(); qkt<DQ>(pA0, pA1, K_lds, qr, qx, r32, hi);
        finishSM<VAR>(pB0, pB1, alB, l_reg, pa0, pa1, pa2, pa3); SBAR();
        if constexpr (VAR != 3) { if (SD == 1 || j + 3 < NT) SLOAD(SE, (j + 1 + SD) * KVBLK); } SBAR();
        pv_d0(o, vb0 + SHM_V, pa0, pa1, pa2, pa3); partialSM<DQ, VAR>(pA0, pA1, m_reg, mnA, alA);
        ATT_SYNC(); SWAIT(); SWRITE(1, SO);
        RESC(alA); ATT_SYNC();
    }
    SBAR(); qkt<DQ>(pB0, pB1, K_lds + SHM_K, qr, qx, r32, hi);
    finishSM<VAR>(pA0, pA1, alA, l_reg, pa0, pa1, pa2, pa3); SBAR();
    pv_d0(o, vb0, pa0, pa1, pa2, pa3); partialSM<DQ, VAR>(pB0, pB1, m_reg, mnB, alB);
    ATT_SYNC(); RESC(alB);
    finishSM<VAR>(pB0, pB1, alB, l_reg, pa0, pa1, pa2, pa3); SBAR();
    pv_d0(o, vb0 + SHM_V, pa0, pa1, pa2, pa3);
    if (hi == 0) li_l[r32] = l_reg; asm volatile("s_waitcnt lgkmcnt(0)" ::: "memory");
    float rli[16];
#pragma unroll
    for (int r = 0; r < 16; ++r) rli[r] = __builtin_amdgcn_rcpf(li_l[crow(r, hi)]);
    bf16_t* Ow = Ob + (long)(wid * QBLK) * ldo;
#pragma unroll
    for (int r = 0; r < 16; ++r) { const int orow = crow(r, hi);
#pragma unroll
        for (int d0 = 0; d0 < 4; ++d0) Ow[(long)orow * ldo + d0 * 32 + r32] = f2bf(o[d0][r] * rli[r]); }
#undef SLOAD
#undef ATT_SYNC
#undef SWRITE
#undef SWAIT
#undef RESC
}
}

template <int KS> __device__ __forceinline__ void mma_xy(f32x16& acc, const LAS bf16_t* X, const LAS bf16_t* Y, int hi) {
#pragma unroll
    for (int ks = 0; ks < KS; ++ks) { const bf16x8 a = *(const LAS bf16x8*)(X + ks * 16 + hi * 8), b = *(const LAS bf16x8*)(Y + ks * 16 + hi * 8);
        acc = __builtin_amdgcn_mfma_f32_32x32x16_bf16(a, b, acc, 0, 0, 0); }
}
__device__ __forceinline__ float logsig16(float x) { const float e = __expf(-fabsf(x)); return (fminf(x, 0.f) - __logf(1.f + e)) * 0.0625f; }
__device__ __forceinline__ int gla_sidx(int b, int dir, int h) { return (b * 2 + dir) * 4 + h; }

__device__ __forceinline__ void gla_cumsum_lds(const Ctx& C, int l, int h, int dir, const LAS float* lr, LAS float* segtot, LAS float* CUM) {
    const int seg = C.tid >> 7, d = C.tid & 127;
    const float* wa = INP(dir ? I_WA2B : I_WA2F) + (size_t)l * 16 * 512 + h * 128 + d;
    const float bias = INP(dir ? I_BAB : I_BAF)[l * 512 + h * 128 + d];
    float w[16], cum[16];
#pragma unroll
    for (int j = 0; j < 16; ++j) w[j] = wa[j * 512];
    float run = 0.f;
#pragma unroll
    for (int i = 0; i < 16; ++i) { const int s = seg * 16 + i, tk = dir ? 63 - s : s; float pre = bias;
#pragma unroll
        for (int j = 0; j < 16; ++j) pre += lr[tk * 32 + dir * 16 + j] * w[j];
        run += logsig16(pre); cum[i] = run; }
    segtot[seg * 128 + d] = run;
    __syncthreads();
    float off = 0.f;
#pragma unroll
    for (int q = 0; q < 3; ++q) if (q < seg) off += segtot[q * 128 + d];
#pragma unroll
    for (int i = 0; i < 16; ++i) { const int s = seg * 16 + i, tk = dir ? 63 - s : s; CUM[tk * 132 + d] = cum[i] + off; }
    __syncthreads();
}
__device__ __forceinline__ void unpack8(const u32x4 w, float (&x)[8]) { x[0] = bflo(w.x); x[1] = bfhi(w.x); x[2] = bflo(w.y); x[3] = bfhi(w.y); x[4] = bflo(w.z); x[5] = bfhi(w.z); x[6] = bflo(w.w); x[7] = bfhi(w.w); }
__device__ __forceinline__ void gla_build_vt(const Ctx& C, const bf16_t* P, size_t r0, int h, LAS bf16_t* VT) {
    u32x4 v[4];
#pragma unroll
    for (int it = 0; it < 4; ++it) { const int idx = C.tid + it * NTHREADS, sv = idx >> 5, e0 = (idx & 31) * 8; v[it] = *(const u32x4*)(P + (r0 + sv) * NP + C_LV + h * 256 + e0); }
#pragma unroll
    for (int it = 0; it < 4; ++it) { const int idx = C.tid + it * NTHREADS, sv = idx >> 5, e0 = (idx & 31) * 8;
        const unsigned wd[4] = {v[it].x, v[it].y, v[it].z, v[it].w};
#pragma unroll
        for (int q = 0; q < 4; ++q) { VT[(e0 + 2 * q) * 72 + sv] = (bf16_t)(wd[q] & 0xffffu); VT[(e0 + 2 * q + 1) * 72 + sv] = (bf16_t)(wd[q] >> 16); } }
}

__device__ __forceinline__ void phase_gla_local(const Ctx& C, int l, int rot) {
    const bf16_t* P = WSP(bf16_t, WS_P); bf16_t* GST = WSP(bf16_t, WS_GST); float* GDEC = WSP(float, WS_GDEC);
    LAS float* lr = (LAS float*)C.lds;
    LAS float* segtot = (LAS float*)(C.lds + 8192);
    LAS bf16_t* KT = (LAS bf16_t*)(C.lds + 10240);
    LAS bf16_t* VT = (LAS bf16_t*)(C.lds + 28672);
    LAS float* CUM = (LAS float*)(C.lds + 65536);
    const int r32 = C.lane & 31, hi = C.lane >> 5, d = C.tid & 127;
    const int btk = C.tid >> 3, bdg = (C.tid & 7) * 16;
    for (int unit = (C.bid + C.G - rot % C.G) % C.G; unit < NBATCH * 4 * NCH; unit += C.G) {
        const int b = unit / (4 * NCH), h = (unit / NCH) % 4, ck = unit % NCH; const size_t r0 = (size_t)b * RPB + ck * 64;
        for (int i = C.tid; i < 64 * 32; i += NTHREADS) lr[i] = bf2f(P[(r0 + (i >> 5)) * NP + C_LRF + (i & 31)]);
        const u32x4 kw0 = *(const u32x4*)(P + (r0 + btk) * NP + C_LK + h * 128 + bdg), kw1 = *(const u32x4*)(P + (r0 + btk) * NP + C_LK + h * 128 + bdg + 8);
        gla_build_vt(C, P, r0, h, VT);
        __syncthreads();
#pragma unroll 1
        for (int dir = 0; dir < 2; ++dir) {
            gla_cumsum_lds(C, l, h, dir, lr, segtot, CUM);
            const int tend = dir ? 0 : 63;
            const size_t sx = (size_t)gla_sidx(b, dir, h) * NCH + ck;
            if (C.tid < 128) GDEC[sx * 128 + d] = __expf(CUM[tend * 132 + d]);
            { float kf[16]; { float t8[8]; unpack8(kw0, t8);
#pragma unroll
                for (int i = 0; i < 8; ++i) kf[i] = t8[i]; unpack8(kw1, t8);
#pragma unroll
                for (int i = 0; i < 8; ++i) kf[8 + i] = t8[i]; }
#pragma unroll
              for (int q = 0; q < 4; ++q) { const f32x4 cm = *(const LAS f32x4*)(CUM + btk * 132 + bdg + 4 * q), be = *(const LAS f32x4*)(CUM + tend * 132 + bdg + 4 * q);
#pragma unroll
                  for (int i = 0; i < 4; ++i) KT[(bdg + 4 * q + i) * 72 + btk] = f2bf(kf[4 * q + i] * __expf(be[i] - cm[i])); } }
            __syncthreads();
            { const int dt = C.wid & 3, eb = (C.wid >> 2) * 4;
              f32x16 acc[4] = {};
#pragma unroll
              for (int q = 0; q < 4; ++q) mma_xy<4>(acc[q], KT + (dt * 32 + r32) * 72, VT + ((eb + q) * 32 + r32) * 72, hi);
              bf16_t* st = GST + sx * 32768;
#pragma unroll
              for (int q = 0; q < 4; ++q)
#pragma unroll
                  for (int g = 0; g < 4; ++g) { u32x2 w; w.x = cvt_pk_bf16(acc[q][4 * g], acc[q][4 * g + 1]); w.y = cvt_pk_bf16(acc[q][4 * g + 2], acc[q][4 * g + 3]);
                      *(u32x2*)(st + (size_t)((eb + q) * 32 + r32) * 128 + dt * 32 + 8 * g + 4 * hi) = w; } }
            __syncthreads();
        }
    }
}

__device__ __forceinline__ void phase_gla_scan(const Ctx& C) {
    bf16_t* GST = WSP(bf16_t, WS_GST); const float* GDEC = WSP(float, WS_GDEC);
    for (int gid = C.bid * NTHREADS + C.tid; gid < 16 * 8192; gid += C.G * NTHREADS) {
        const int sidx = gid >> 13, g = gid & 8191, dir = (sidx >> 2) & 1, d4 = (g & 31) * 4;
        bf16_t* base = GST + (size_t)sidx * NCH * 32768 + (size_t)g * 4;
        const float* dbase = GDEC + (size_t)sidx * NCH * 128 + d4;
        float S[4] = {0.f, 0.f, 0.f, 0.f};
        for (int st = 0; st < NCH; st += 4) {
            int ck[4]; u32x2 L[4]; f32x4 dc[4];
#pragma unroll
            for (int q = 0; q < 4; ++q) { const int s = st + q; ck[q] = dir ? (s < 4 ? 3 - s : NCH + 3 - s) : s;
                L[q] = *(const u32x2*)(base + (size_t)ck[q] * 32768); dc[q] = *(const f32x4*)(dbase + (size_t)ck[q] * 128); }
#pragma unroll
            for (int q = 0; q < 4; ++q) { u32x2 w; w.x = cvt_pk_bf16(S[0], S[1]); w.y = cvt_pk_bf16(S[2], S[3]);
                *(u32x2*)(base + (size_t)ck[q] * 32768) = w;
                S[0] = dc[q][0] * S[0] + bflo(L[q].x); S[1] = dc[q][1] * S[1] + bfhi(L[q].x); S[2] = dc[q][2] * S[2] + bflo(L[q].y); S[3] = dc[q][3] * S[3] + bfhi(L[q].y); }
        }
    }
}

__device__ __forceinline__ void phase_gla_out(const Ctx& C, int l, int rot) {
    const bf16_t* P = WSP(bf16_t, WS_P); const bf16_t* GST = WSP(bf16_t, WS_GST); bf16_t* OL = WSP(bf16_t, WS_OL);
    LAS float* lr = (LAS float*)C.lds;
    LAS float* segtot = (LAS float*)(C.lds + 8192);
    LAS bf16_t* QT = (LAS bf16_t*)(C.lds + 10240);
    LAS bf16_t* KT = (LAS bf16_t*)(C.lds + 27648);
    LAS bf16_t* VT = (LAS bf16_t*)(C.lds + 45056);
    LAS bf16_t* SCm = (LAS bf16_t*)(C.lds + 81920);
    LAS float* OB = (LAS float*)(C.lds + 91136);
    LAS float* CUM = OB;
    const float* gon = INP(I_ONG) + l * 256;
    const int r32 = C.lane & 31, hi = C.lane >> 5;
    const int btk = C.tid >> 3, bdg = (C.tid & 7) * 16;
    for (int unit = (C.bid + C.G - rot % C.G) % C.G; unit < NBATCH * 4 * NCH; unit += C.G) {
        const int b = unit / (4 * NCH), h = (unit / NCH) % 4, ck = unit % NCH; const size_t r0 = (size_t)b * RPB + ck * 64;
        for (int i = C.tid; i < 64 * 32; i += NTHREADS) lr[i] = bf2f(P[(r0 + (i >> 5)) * NP + C_LRF + (i & 31)]);
        const bf16_t* qp = P + (r0 + btk) * NP + C_LQ + h * 128 + bdg; const bf16_t* kp = P + (r0 + btk) * NP + C_LK + h * 128 + bdg;
        const u32x4 qw0 = *(const u32x4*)qp, qw1 = *(const u32x4*)(qp + 8), kw0 = *(const u32x4*)kp, kw1 = *(const u32x4*)(kp + 8);
        gla_build_vt(C, P, r0, h, VT);
        __syncthreads();
        f32x16 oacc[2] = {};
#pragma unroll 1
        for (int dir = 0; dir < 2; ++dir) {
            gla_cumsum_lds(C, l, h, dir, lr, segtot, CUM);
            { float qf[8], kf[8];
#pragma unroll
              for (int hh = 0; hh < 2; ++hh) { unpack8(hh ? qw1 : qw0, qf); unpack8(hh ? kw1 : kw0, kf);
                  const f32x4 c0 = *(const LAS f32x4*)(CUM + btk * 132 + bdg + 8 * hh), c1 = *(const LAS f32x4*)(CUM + btk * 132 + bdg + 8 * hh + 4);
                  float qo[8], ko[8];
#pragma unroll
                  for (int i = 0; i < 8; ++i) { const float cm = i < 4 ? c0[i & 3] : c1[i & 3]; qo[i] = qf[i] * __expf(cm) * 0.088388347648318440f; ko[i] = kf[i] * __expf(-cm); }
                  u32x4 wq, wk; wq.x = cvt_pk_bf16(qo[0], qo[1]); wq.y = cvt_pk_bf16(qo[2], qo[3]); wq.z = cvt_pk_bf16(qo[4], qo[5]); wq.w = cvt_pk_bf16(qo[6], qo[7]);
                  wk.x = cvt_pk_bf16(ko[0], ko[1]); wk.y = cvt_pk_bf16(ko[2], ko[3]); wk.z = cvt_pk_bf16(ko[4], ko[5]); wk.w = cvt_pk_bf16(ko[6], ko[7]);
                  *(LAS u32x4*)(QT + btk * 136 + bdg + 8 * hh) = wq; *(LAS u32x4*)(KT + btk * 136 + bdg + 8 * hh) = wk; } }
            __syncthreads();
            if (C.wid < 4) { const int mt = C.wid >> 1, nt = C.wid & 1; f32x16 sc = {};
                mma_xy<8>(sc, QT + (mt * 32 + r32) * 136, KT + (nt * 32 + r32) * 136, hi);
#pragma unroll
                for (int i = 0; i < 16; ++i) { const int t = mt * 32 + att::crow(i, hi), sx_ = nt * 32 + r32; const bool keep = dir ? (sx_ >= t) : (sx_ <= t);
                    SCm[t * 72 + sx_] = f2bf(keep ? sc[i] : 0.f); } }
            __syncthreads();
            { const bf16_t* st = GST + ((size_t)gla_sidx(b, dir, h) * NCH + ck) * 32768 + (size_t)(C.wid * 32 + r32) * 128 + hi * 8;
              bf16x8 sb[8];
#pragma unroll
              for (int ks = 0; ks < 8; ++ks) sb[ks] = *(const bf16x8*)(st + ks * 16);
#pragma unroll
              for (int mt = 0; mt < 2; ++mt) {
                  mma_xy<4>(oacc[mt], SCm + (mt * 32 + r32) * 72, VT + (C.wid * 32 + r32) * 72, hi);
#pragma unroll
                  for (int ks = 0; ks < 8; ++ks) { const bf16x8 a = *(const LAS bf16x8*)(QT + (mt * 32 + r32) * 136 + ks * 16 + hi * 8);
                      oacc[mt] = __builtin_amdgcn_mfma_f32_32x32x16_bf16(a, sb[ks], oacc[mt], 0, 0, 0); } } }
            __syncthreads();
        }
#pragma unroll
        for (int mt = 0; mt < 2; ++mt)
#pragma unroll
            for (int i = 0; i < 16; ++i) OB[(mt * 32 + att::crow(i, hi)) * 260 + C.wid * 32 + r32] = oacc[mt][i];
        __syncthreads();
        { const int t = C.tid >> 3, part = C.tid & 7; f32x4 v[8]; float ss = 0.f;
#pragma unroll
          for (int jj = 0; jj < 8; ++jj) { v[jj] = *(const LAS f32x4*)(OB + t * 260 + jj * 32 + part * 4); ss += v[jj][0] * v[jj][0] + v[jj][1] * v[jj][1] + v[jj][2] * v[jj][2] + v[jj][3] * v[jj][3]; }
          ss += dppmov<DPP_HMIRROR>(ss); ss += dppmov<DPP_Q3210>(ss); ss += dppmov<DPP_Q1032>(ss);
          const float rs = rsqrtf(ss * (1.0f / 256.0f) + NORM_EPS);
#pragma unroll
          for (int jj = 0; jj < 8; ++jj) { const int e = jj * 32 + part * 4; const f32x4 g = *(const f32x4*)(gon + e);
              const u32x2 gt = *(const u32x2*)(P + (r0 + t) * NP + C_LG + h * 256 + e);
              const float o0 = v[jj][0] * rs * g[0] * siluf_(bflo(gt.x)), o1 = v[jj][1] * rs * g[1] * siluf_(bfhi(gt.x)), o2 = v[jj][2] * rs * g[2] * siluf_(bflo(gt.y)), o3 = v[jj][3] * rs * g[3] * siluf_(bfhi(gt.y));
              u32x2 w; w.x = cvt_pk_bf16(o0, o1); w.y = cvt_pk_bf16(o2, o3);
              *(u32x2*)(OL + (r0 + t) * 1024 + h * 256 + e) = w; } }
        __syncthreads();
    }
}

__device__ __forceinline__ unsigned f_ord(float f) { const unsigned u = __float_as_uint(f); return u ^ ((unsigned)((int)u >> 31) | 0x80000000u); }
__device__ __forceinline__ float f_unord(unsigned k) { return __uint_as_float((k & 0x80000000u) ? (k ^ 0x80000000u) : ~k); }
__device__ __forceinline__ void ins_u(unsigned (&L)[16], unsigned x) {
#pragma unroll
    for (int j = 0; j < 16; ++j) { const unsigned h = L[j] > x ? L[j] : x; x = L[j] > x ? x : L[j]; L[j] = h; }
}
__device__ __forceinline__ void ins_f(float (&M)[16], float x) {
#pragma unroll
    for (int j = 0; j < 16; ++j) { const float h = M[j] > x ? M[j] : x; x = M[j] > x ? x : M[j]; M[j] = h; }
}
__device__ __forceinline__ void peer_top16(const bf16_t* __restrict__ qrow, const bf16_t* __restrict__ keys, int r32, int hi, unsigned (&L)[16]) {
    bf16x8 qf[8];
#pragma unroll
    for (int kk = 0; kk < 8; ++kk) qf[kk] = *(const bf16x8*)(qrow + kk * 16 + hi * 8);
#pragma unroll
    for (int j = 0; j < 16; ++j) L[j] = 0u;
    bf16x8 kA[8], kB[8];
    const bf16_t* kl = keys + (size_t)r32 * 128 + hi * 8;
#define PT_LDK(dst, mt) do { _Pragma("unroll") for (int kk = 0; kk < 8; ++kk) dst[kk] = *(const bf16x8*)(kl + (mt) * 32 * 128 + kk * 16); } while (0)
#define PT_PROC(src, mt) do { f32x16 acc = {}; \
        _Pragma("unroll") for (int kk = 0; kk < 8; ++kk) acc = __builtin_amdgcn_mfma_f32_32x32x16_bf16(src[kk], qf[kk], acc, 0, 0, 0); \
        _Pragma("unroll") for (int i = 0; i < 16; ++i) { const unsigned kidx = (unsigned)((mt) * 32 + att::crow(i, hi)); ins_u(L, (f_ord(acc[i]) & ~127u) | (127u - kidx)); } } while (0)
    PT_LDK(kA, 0);
#pragma unroll 1
    for (int mp = 0; mp < 2; ++mp) { PT_LDK(kB, 2 * mp + 1); PT_PROC(kA, 2 * mp); if (mp == 0) PT_LDK(kA, 2); PT_PROC(kB, 2 * mp + 1); }
#undef PT_LDK
#undef PT_PROC
    unsigned Pn[16];
#pragma unroll
    for (int j = 0; j < 16; ++j) { auto r_ = __builtin_amdgcn_permlane32_swap(L[j], L[j], false, false); Pn[j] = hi ? r_[0] : r_[1]; }
#pragma unroll
    for (int j = 0; j < 16; ++j) ins_u(L, Pn[j]);
}
__device__ __forceinline__ void phase_peer_select(const Ctx& C, const bool latent_only) {
    const bf16_t* PQ = WSP(bf16_t, WS_PQ); const bf16_t* K1 = WSP(bf16_t, WS_K1); const bf16_t* K2 = WSP(bf16_t, WS_K2);
    int* PIDX = WSP(int, WS_PIDX); float* PG = WSP(float, WS_PG);
    const int r32 = C.lane & 31, hi = C.lane >> 5, head = C.wid;
    const int ngrp = latent_only ? NBATCH * SEQ / 32 : TT / 32;
    for (int gi = C.bid; gi < ngrp; gi += C.G) {
        const int grp = latent_only ? gi + (CTXL / 32) * (1 + gi / (SEQ / 32)) : gi;
        const size_t tok = (size_t)grp * 32 + r32;
        unsigned L1[16], L2[16];
        peer_top16(PQ + tok * DM + head * 256, K1 + (size_t)head * 128 * 128, r32, hi, L1);
        peer_top16(PQ + tok * DM + head * 256 + 128, K2 + (size_t)head * 128 * 128, r32, hi, L2);
        float v1[16], v2[16];
#pragma unroll
        for (int j = 0; j < 16; ++j) { v1[j] = f_unord(L1[j] & ~127u); v2[j] = f_unord(L2[j] & ~127u); }
        float M[16];
#pragma unroll
        for (int j = 0; j < 16; ++j) M[j] = -3.0e38f;
#pragma unroll
        for (int a = 0; a < 16; ++a)
#pragma unroll
            for (int b = 0; b < 16; ++b) if ((a + 1) * (b + 1) <= 16) ins_f(M, v1[a] + v2[b]);
        const float thr = M[15], mx = M[0]; float den = 0.f;
#pragma unroll
        for (int j = 0; j < 16; ++j) den += __expf(M[j] - mx);
        const float rden = 1.0f / den;
        int pos = 0; int* ip = PIDX + tok * 128 + head * 16; float* gp = PG + tok * 128 + head * 16;
#pragma unroll
        for (int a = 0; a < 16; ++a)
#pragma unroll
            for (int b = 0; b < 16; ++b) if ((a + 1) * (b + 1) <= 16) {
                const float val = v1[a] + v2[b];
                if (val >= thr && pos < 16) { if (hi == 0) { ip[pos] = (int)((127u - (L1[a] & 127u)) * 128u + (127u - (L2[b] & 127u))); gp[pos] = __expf(val - mx) * rden; } ++pos; } }
    }
}
template <int OFF> __device__ __forceinline__ float dotf8(const float (&h)[32], const u32x4 w, float acc) {
#pragma unroll
    for (int j = 0; j < 4; ++j) { const f32x2 lo = __builtin_amdgcn_cvt_pk_f32_fp8((int)w[j], false), hi = __builtin_amdgcn_cvt_pk_f32_fp8((int)w[j], true);
        acc += h[OFF + 4 * j] * lo.x; acc += h[OFF + 4 * j + 1] * lo.y; acc += h[OFF + 4 * j + 2] * hi.x; acc += h[OFF + 4 * j + 3] * hi.y; }
    return acc;
}
constexpr int GT_MAXTOK = 9;
template <bool LAST> __device__ __forceinline__ void phase_peer_gather(const Ctx& C, const float* modl, const float pscale) {
    const unsigned char* pt = C.ws + WS_PT + (size_t)(LAST ? DEPTH - 1 : 0) * PT_BYTES;
    const bf16_t* HB = WSP(bf16_t, WS_HB); const unsigned char* U8 = pt + PT_U8; const unsigned char* V8 = pt + PT_V8;
    const float* SCU = (const float*)(pt + PT_SCU); const float* SCV = (const float*)(pt + PT_SCV);
    const int* PIDX = WSP(int, WS_PIDX); const float* PG = WSP(float, WS_PG); float* XS = WSP(float, WS_XS);
    const int lane = C.lane, s = lane >> 3, j = lane & 7; const unsigned j16 = (unsigned)j * 16u;
    LAS int* IDS = (LAS int*)(C.lds + C.wid * (GT_MAXTOK * 512));
    LAS float* ACT = (LAS float*)(C.lds + 8 * GT_MAXTOK * 512 + C.wid * (GT_MAXTOK * 512));
    LAS int* ROWS = (LAS int*)(C.lds + 16 * GT_MAXTOK * 512 + C.wid * 64);
    int nk = 0;
    {
      const int per = (TT + C.G - 1) / C.G, base = C.bid * per;
#pragma unroll 1
      for (int k = 0; k < GT_MAXTOK; ++k) { const int o = C.wid + 8 * k; const int r = base + o; if (o < per && r < TT && !(LAST && (r % RPB) < CTXL)) { if (lane == 0) ROWS[nk] = r; ++nk; } } }
#define GT_ROW(k) __builtin_amdgcn_readfirstlane(ROWS[k])
#pragma unroll 1
    for (int k = 0; k < nk; ++k) { const int r = GT_ROW(k);
        IDS[k * 128 + lane] = (PIDX[(size_t)r * 128 + lane] & (NEXP - 1)) << 7; IDS[k * 128 + 64 + lane] = (PIDX[(size_t)r * 128 + 64 + lane] & (NEXP - 1)) << 7;
        ACT[k * 128 + lane] = 0.f; ACT[k * 128 + 64 + lane] = 0.f; }
    const int nit = 32 * nk;
#define GT_ITEM(it_) const int cb_ = (it_) / (2 * nk), rem_ = (it_) - cb_ * (2 * nk), k_ = rem_ >> 1, hf_ = rem_ & 1
#define GT_LOADU(UQ, HQ, it_) do { GT_ITEM(it_); const int r_ = GT_ROW(k_); \
        const bf16_t* hp_ = HB + (size_t)r_ * DM + cb_ * 128 + j * 16; HQ[0] = *(const u32x4*)hp_; HQ[1] = *(const u32x4*)(hp_ + 8); \
        const unsigned char* ub_ = U8 + (size_t)cb_ * ((size_t)NEXP * 128);     \
        _Pragma("unroll") for (int eg = 0; eg < 8; ++eg) { const unsigned off_ = ((unsigned)IDS[k_ * 128 + (hf_ * 8 + eg) * 8 + s] & idmask) + j16; UQ[eg] = *(const u32x4*)(ub_ + off_); } } while (0)
#define GT_COMPU(UQ, HQ, it_) do { GT_ITEM(it_); (void)cb_; f32x2 hf2[8]; \
        _Pragma("unroll") for (int hh = 0; hh < 2; ++hh) { const u32x4 w_ = HQ[hh]; \
            hf2[hh * 4 + 0] = (f32x2){bflo(w_.x), bfhi(w_.x)}; hf2[hh * 4 + 1] = (f32x2){bflo(w_.y), bfhi(w_.y)}; hf2[hh * 4 + 2] = (f32x2){bflo(w_.z), bfhi(w_.z)}; hf2[hh * 4 + 3] = (f32x2){bflo(w_.w), bfhi(w_.w)}; } \
        float d[8]; \
        _Pragma("unroll") for (int eg = 0; eg < 8; ++eg) { f32x2 d2 = (f32x2){0.f, 0.f}; \
            _Pragma("unroll") for (int q = 0; q < 4; ++q) { const f32x2 lo = __builtin_amdgcn_cvt_pk_f32_fp8((int)UQ[eg][q], false), hi = __builtin_amdgcn_cvt_pk_f32_fp8((int)UQ[eg][q], true); \
                d2 += hf2[2 * q] * lo; d2 += hf2[2 * q + 1] * hi; } \
            d[eg] = d2.x + d2.y; } \
          \
        float t4[4], t2[2], t1; \
        _Pragma("unroll") for (int i = 0; i < 4; ++i) { const float snd = (j & 4) ? d[i] : d[i + 4], kp = (j & 4) ? d[i + 4] : d[i]; t4[i] = kp + dppmov<DPP_HMIRROR>(snd); } \
        _Pragma("unroll") for (int i = 0; i < 2; ++i) { const float snd = (j & 2) ? t4[i] : t4[i + 2], kp = (j & 2) ? t4[i + 2] : t4[i]; t2[i] = kp + dppmov<DPP_Q3210>(snd); } \
        { const float snd = (j & 1) ? t2[0] : t2[1], kp = (j & 1) ? t2[1] : t2[0]; t1 = kp + dppmov<DPP_Q1032>(snd); } \
        ACT[k_ * 128 + (hf_ * 8 + j) * 8 + s] += t1; } while (0)
#ifdef DBG_GDUP
#pragma unroll 1
    for (int rep_ = 0; rep_ < 2; ++rep_) {
    const unsigned idmask = rep_ == 0 ? ((unsigned)DBG_GMASK << 7 | 127u) : 0xffffffffu;
    if (rep_ == 1) { for (int k = 0; k < nk; ++k) { ACT[k * 128 + lane] = 0.f; ACT[k * 128 + 64 + lane] = 0.f; } }
#else
    { const unsigned idmask = 0xffffffffu;
#endif
    if (nit > 0) {
        u32x4 uA[8], uB[8], hA[2], hB[2];
        GT_LOADU(uA, hA, 0);
#pragma unroll 1
        for (int it = 0; it < nit; it += 2) {
            GT_LOADU(uB, hB, it + 1);
            GT_COMPU(uA, hA, it);
            if (it + 2 < nit) GT_LOADU(uA, hA, it + 2);
            GT_COMPU(uB, hB, it + 1);
        }
    }
    }
#undef GT_LOADU
#undef GT_COMPU
#pragma unroll 1
    for (int k = 0; k < nk; ++k) { const int r = GT_ROW(k);
#pragma unroll
        for (int hh = 0; hh < 2; ++hh) { const int e = hh * 64 + lane; const int id = IDS[k * 128 + e] >> 7; const float a = ACT[k * 128 + e] * SCU[id];
            const float w = PG[(size_t)r * 128 + e] * 0.5f * a * (1.0f + erff(a * 0.70710678118654752f));
#ifdef DBG_CHECK
            if (((r - 300) & 63) == 0 && r >= 300 && r < 300 + 64 * 128) WSP(float, WS_OM)[(size_t)r * 128 + e] = w;
#endif
            ACT[k * 128 + e] = w * SCV[id]; } }
#define GT_LOADV(VQ, WV, it_) do { GT_ITEM(it_); const unsigned char* vb_ = V8 + (size_t)cb_ * ((size_t)NEXP * 128); \
        _Pragma("unroll") for (int eg = 0; eg < 8; ++eg) { const int e_ = k_ * 128 + (hf_ * 8 + eg) * 8 + s; const unsigned off_ = (unsigned)IDS[e_] + j16; VQ[eg] = *(const u32x4*)(vb_ + off_); WV[eg] = ACT[e_]; } } while (0)
#define GT_COMPV(VQ, WV) do { \
        _Pragma("unroll") for (int eg = 0; eg < 8; ++eg) { const f32x2 w2_ = (f32x2){WV[eg], WV[eg]}; \
            _Pragma("unroll") for (int q = 0; q < 4; ++q) { \
                const f32x2 lo = __builtin_amdgcn_cvt_pk_f32_fp8((int)VQ[eg][q], false), hi = __builtin_amdgcn_cvt_pk_f32_fp8((int)VQ[eg][q], true); \
                acc2[2 * q] += w2_ * lo; acc2[2 * q + 1] += w2_ * hi; } } } while (0)
    if (nit > 0) {
        u32x4 vA[8], vB[8]; float wA[8], wB[8];
        GT_LOADV(vA, wA, 0);
#pragma unroll 1
        for (int it = 0; it < nit; it += 2) {
            f32x2 acc2[8];
#pragma unroll
            for (int i = 0; i < 8; ++i) acc2[i] = (f32x2){0.f, 0.f};
            GT_LOADV(vB, wB, it + 1);
            GT_COMPV(vA, wA);
            if (it + 2 < nit) GT_LOADV(vA, wA, it + 2);
            GT_COMPV(vB, wB);
            f32x2 t4[4], t2[2], t1;
#pragma unroll
            for (int i = 0; i < 4; ++i) { const f32x2 snd = (s & 4) ? acc2[i] : acc2[i + 4], kp = (s & 4) ? acc2[i + 4] : acc2[i];
                t4[i] = kp + (f32x2){xchg32(snd.x, lane), xchg32(snd.y, lane)}; }
#pragma unroll
            for (int i = 0; i < 2; ++i) { const f32x2 snd = (s & 2) ? t4[i] : t4[i + 2], kp = (s & 2) ? t4[i + 2] : t4[i];
                t2[i] = kp + (f32x2){xchg16(snd.x, lane), xchg16(snd.y, lane)}; }
            { const f32x2 snd = (s & 1) ? t2[0] : t2[1], kp = (s & 1) ? t2[1] : t2[0]; t1 = kp + (f32x2){dppmov<DPP_ROR8>(snd.x), dppmov<DPP_ROR8>(snd.y)}; }
            { GT_ITEM(it); (void)hf_; const int r_ = GT_ROW(k_);
              const int col = cb_ * 128 + j * 16 + 2 * s; float* xp = XS + (size_t)r_ * DM + col; const float* g2 = modl + (size_t)mod_sel(r_) * 12288 + 5 * DM + col;
#ifdef DBG_CHECK
              if (((r_ - 300) & 63) == 0 && r_ >= 300 && r_ < 300 + 64 * 128) { float* dbgo = WSP(float, WS_MQ) + (size_t)r_ * DM + col; dbgo[0] = t1.x; dbgo[1] = t1.y; }
#endif
              const f32x2 x = *(const f32x2*)xp, g = *(const f32x2*)g2;
              *(f32x2*)xp = x + pscale * g * t1; }
        }
    }
#undef GT_LOADV
#undef GT_COMPV
#undef GT_ITEM
#undef GT_ROW
}
__device__ __forceinline__ void phase_final_norm(const Ctx& C) {
    const float* XS = WSP(float, WS_XS); const float* fg = INP(I_FG);
    for (int q = C.bid * 8 + C.wid; q < NBATCH * SEQ; q += C.G * 8) {
        const int b = q / SEQ, t = q % SEQ; const float* xr = XS + ((size_t)b * RPB + CTXL + t) * DM; float* op = C.out + (size_t)q * DM;
        f32x4 v[8]; float ss = 0.f;
#pragma unroll
        for (int c = 0; c < 8; ++c) { v[c] = *(const f32x4*)(xr + c * 256 + C.lane * 4); ss += v[c][0] * v[c][0] + v[c][1] * v[c][1] + v[c][2] * v[c][2] + v[c][3] * v[c][3]; }
        ss = wave_sum(ss); const float rs = rsqrtf(ss * (1.0f / DM) + NORM_EPS);
#pragma unroll
        for (int c = 0; c < 8; ++c) { const f32x4 g = *(const f32x4*)(fg + c * 256 + C.lane * 4); *(f32x4*)(op + c * 256 + C.lane * 4) = v[c] * rs * g; }
    }
}

template <int TYPE  , int VAR = 0> __device__ __forceinline__ void attn_units(const Ctx& C, bool need_ctx) {
    const bf16_t* P = WSP(bf16_t, WS_P);
    const int nu = need_ctx ? 528 : 512;
#pragma unroll 1
    for (int u = C.bid; u < nu; u += C.G) {
        int bh, qb; if (u < 512) { bh = (u >> 8) * 8 + (u & 7); qb = ((u & 255) >> 3) + 1; } else { bh = u - 512; qb = 0; }
        const int b = bh >> 3, h = bh & 7; const size_t rq = (size_t)b * RPB + (size_t)qb * 256, rk = (size_t)b * RPB; const int seq = qb == 0 ? CTXL : RPB;
        __syncthreads();
        if constexpr (TYPE == 1) {
            att::attn_body<128, 2, VAR>(P + rq * NP + C_AQ + h * 128, NP, P + rk * NP + C_AK + (h >> 2) * 128, NP, nullptr, 0, P + rk * NP + C_AV + (h >> 2) * 128, NP,
                                   WSP(bf16_t, WS_OA) + rq * 1024 + h * 128, 1024, seq, false, 0, nullptr, (char*)C.lds, C.tid);
        } else {
            const bf16_t* MQ = WSP(bf16_t, WS_MQ); const bf16_t* MKV = WSP(bf16_t, WS_MKV);
            att::attn_body<192, 1, VAR>(MQ + rq * 1536 + h * 192, 1536, MKV + rk * 2048 + h * 256, 2048, P + rk * NP + C_MKR, NP, MKV + rk * 2048 + h * 256 + 128, 2048,
                                   WSP(bf16_t, WS_OM) + rq * 1024 + h * 128, 1024, seq, qb > 0, (qb - 1) * 256, WSP(float, WS_TABM), (char*)C.lds, C.tid);
        }
    }
    __syncthreads();
}

constexpr int LDS_BYTES = 163840, LDS_BAR_OFF = LDS_BYTES - 16;
constexpr int N_PHASES = 26;
template <int K> __device__ __forceinline__ void run_phase(const Ctx& C0, int l) {
    const Ctx C = launder(C0);
    const float* modl = WSP(float, WS_MODV) + (size_t)l * 3 * 12288;
    if constexpr (K == 0) { phase_modv(C); phase_tables(C); __syncthreads(); phase_cvt_mixer_weights(C, 0); }
    if constexpr (K == 1) {
        if (l == 0) phase_norm_mod<true>(C, INP(I_N1G), modl, 0, DM);
        else { phase_norm_mod<false>(C, INP(I_N1G) + l * DM, modl, 0, DM); __syncthreads(); phase_cvt_mixer_weights(C, l); }
    }
    if constexpr (K == 2) {
        pg8::Gemm g{WSP(bf16_t, WS_HB), WSP(bf16_t, WS_WIN), TT, NP, DM, DM, DM}; pg8::WinOrder S; S.init(C.G, C.bid, l + 1 < DEPTH);
        pg8::EpiStoreBf16 E{WSP(bf16_t, WS_P), NP};
#if defined(DBG_DUP2) && DBG_DUP2 == 1
        { pg8::EpiNull E0; pg8::gemm_phase(C.lds, C.tid, g, S, E0); }
#elif defined(DBG_DUP2) && DBG_DUP2 == 2
        pg8::gemm_phase(C.lds, C.tid, g, S, E);
#endif
        pg8::gemm_phase(C.lds, C.tid, g, S, E);
    }
    if constexpr (K == 3) phase_post_p(C, l);
    if constexpr (K == 4) {
        { pg8::Gemm g{WSP(bf16_t, WS_P) + C_MCQ, WSP(bf16_t, WS_WUQ), TT, 1536, 512, NP, 512}; pg8::StaticOrder S; S.init(TT, 1536, C.G, C.bid);
          pg8::EpiStoreBf16 E{WSP(bf16_t, WS_MQ), 1536}; pg8::gemm_phase(C.lds, C.tid, g, S, E); }
        { pg8::Gemm g{WSP(bf16_t, WS_P) + C_MCKV, WSP(bf16_t, WS_WUKV), TT, 2048, 512, NP, 512}; pg8::StaticOrder S; S.init(TT, 2048, C.G, (C.bid + C.G - 140 % C.G) % C.G);
          pg8::EpiStoreBf16 E{WSP(bf16_t, WS_MKV), 2048}; pg8::gemm_phase(C.lds, C.tid, g, S, E); }
        { const Ctx C2 = launder(C0); phase_gla_local(C2, l, 156); }
#ifdef DBG_DUP_GLALOCAL
        { const Ctx C2 = launder(C0); __syncthreads(); phase_gla_local(C2, l, 156); }
#endif
    }
    if constexpr (K == 5) phase_gla_scan(C);
    if constexpr (K == 6) {
#ifdef DBG_ATTVAR
        { const Ctx Cx = launder(C0); attn_units<0, DBG_ATTVAR>(Cx, l + 1 < DEPTH); } { const Ctx Cx = launder(C0); attn_units<1, DBG_ATTVAR>(Cx, l + 1 < DEPTH); } __syncthreads();
#endif
        attn_units<0>(C, l + 1 < DEPTH); { const Ctx C2 = launder(C0); attn_units<1>(C2, l + 1 < DEPTH); } { const Ctx C3 = launder(C0); phase_gla_out(C3, l, 128); }
#ifdef DBG_DUP_GLAOUT
        { const Ctx C3 = launder(C0); __syncthreads(); phase_gla_out(C3, l, 128); }
#endif
    }
    if constexpr (K == 7) {
        const bf16_t* P = WSP(bf16_t, WS_P); bf16_t* Y = WSP(bf16_t, WS_Y);
        const pg8::Gemm ga{WSP(bf16_t, WS_OA), WSP(bf16_t, WS_WBR), TT, DM, 1024, 1024, 1024}, gl{WSP(bf16_t, WS_OL), WSP(bf16_t, WS_WBR) + (size_t)2048 * 1024, TT, DM, 1024, 1024, 1024},
                        gm{WSP(bf16_t, WS_OM), WSP(bf16_t, WS_WBR) + (size_t)2 * 2048 * 1024, TT, DM, 1024, 1024, 1024};
        const pg8::EpiGate<true> Ea{Y, DM, P + C_GA, NP}; const pg8::EpiGate<false> El{Y, DM, P + C_GL, NP}, Em{Y, DM, P + C_GM, NP};
        pg8::StaticOrder S; S.init(TT, DM, C.G, C.bid, l + 1 >= DEPTH);
        pg8::gemm_phase(C.lds, C.tid, ga, S, Ea); pg8::gemm_phase(C.lds, C.tid, gl, S, El); pg8::gemm_phase(C.lds, C.tid, gm, S, Em);
        if (l == 0) { const Ctx C2 = launder(C0); phase_cvt_peer_tables(C2, 0, 0, NEXP, S.nwg % C.G); }
    }
    if constexpr (K == 8) {
        pg8::Gemm g{WSP(bf16_t, WS_Y), WSP(bf16_t, WS_WOUT), TT, DM, DM, DM, DM};
        pg8::EpiResid E{WSP(float, WS_XS), DM, modl + 2 * DM, l == 0 ? DBG_MIX0 : DBG_MIX1};
        pg8::StaticOrder S; S.init(TT, DM, C.G, C.bid, l + 1 >= DEPTH);
#ifdef DBG_DUP8
        { pg8::EpiResid E0{WSP(float, WS_XS), DM, modl + 2 * DM, 0.0f}; pg8::gemm_phase(C.lds, C.tid, g, S, E0); }
#endif
        pg8::gemm_phase(C.lds, C.tid, g, S, E);
        if (l == 0 && DEPTH > 1) { const Ctx C2 = launder(C0); phase_cvt_peer_tables(C2, 1, 0, NEXP / 2, S.nwg % C.G); }
    }
    if constexpr (K == 9) phase_norm_mod<false>(C, INP(I_N2G) + l * DM, modl, 3 * DM, 4 * DM);
    if constexpr (K == 10) {
        pg8::Gemm g{WSP(bf16_t, WS_HB), WSP(bf16_t, WS_WQ), TT, DM, DM, DM, DM};
        pg8::EpiStoreBf16 E{WSP(bf16_t, WS_PQ), DM};
        pg8::StaticOrder S; S.init(TT, DM, C.G, C.bid, l + 1 >= DEPTH); pg8::gemm_phase(C.lds, C.tid, g, S, E);
        if (l == 0 && DEPTH > 1) { const Ctx C2 = launder(C0); phase_cvt_peer_tables(C2, 1, NEXP / 2, NEXP, S.nwg % C.G); }
    }
    if constexpr (K == 11) phase_peer_select(C, l + 1 >= DEPTH);
    if constexpr (K == 13) phase_final_norm(C);
    if constexpr (K == 12) {
#ifdef DBG_DUP12
        if (l + 1 < DEPTH) phase_peer_gather<false>(C, modl, 0.0f); else phase_peer_gather<true>(C, modl, 0.0f);
        __syncthreads();
#endif
        if (l + 1 < DEPTH) phase_peer_gather<false>(C, modl, DBG_PEER0); else phase_peer_gather<true>(C, modl, DBG_PEER1); }
}
__device__ __forceinline__ Ctx make_ctx(const Args& args, unsigned char* lds_raw) {
    Ctx C0; C0.in = (const __attribute__((address_space(4))) cfp_t*)__builtin_amdgcn_kernarg_segment_ptr(); C0.out = args.out; C0.ws = args.ws; C0.lds = (LAS unsigned char*)lds_raw;
    C0.tid = threadIdx.x; C0.lane = C0.tid & 63; C0.wid = __builtin_amdgcn_readfirstlane(C0.tid >> 6); C0.G = gridDim.x; C0.bid = blockIdx.x;
    return C0;
}
template <int K> __global__ void __launch_bounds__(NTHREADS, 2) k_one(Args args) {
    extern __shared__ __attribute__((aligned(16))) unsigned char lds_raw[];
    const Ctx C0 = make_ctx(args, lds_raw);
    run_phase<K>(C0, args.ph_lo);
}
#if MK_N_LAUNCHES == 1 || defined(DBG_HYB)
__global__ void __launch_bounds__(NTHREADS, 2) mk_fwd(Args args) {
    extern __shared__ __attribute__((aligned(16))) unsigned char lds_raw[];
    const Ctx C0 = make_ctx(args, lds_raw);
    if (C0.tid < 4) ((LAS unsigned*)(C0.lds + LDS_BAR_OFF))[C0.tid] = 0u;
    __syncthreads();
    const int lo = args.ph_lo, hi = args.ph_hi;
    XcdBarrier bar; bar.bar = (unsigned*)(args.ws + WS_CTL); bar.x = 0; bar.st = nullptr;
    if (hi - lo > 1) bar = xcd_barrier_post((unsigned*)(args.ws + WS_CTL), (volatile LAS unsigned*)(C0.lds + LDS_BAR_OFF));
#define IN(k) (lo <= (k) && (k) < hi)
#define SEAM(k) do { if (IN(k) && IN((k) + 1)) xcd_barrier(bar); } while (0)
#ifndef DBG_DUP
#define DBG_DUP -1
#endif
#define PH(K, k) do { if (IN(k)) { run_phase<K>(C0, l); if (K == DBG_DUP) { xcd_barrier(bar); run_phase<K>(C0, l); } } SEAM(k); } while (0)
    { const int l = 0; PH(0, 0); }
#pragma unroll 1
    for (int l = 0; l < DEPTH; ++l) {
        const int pb = 1 + 12 * l;
        PH(1, pb + 0); PH(2, pb + 1); PH(3, pb + 2); PH(4, pb + 3); PH(5, pb + 4); PH(6, pb + 5);
        PH(7, pb + 6); PH(8, pb + 7); PH(9, pb + 8); PH(10, pb + 9); PH(11, pb + 10); PH(12, pb + 11);
    }
    { const int l = DEPTH - 1; PH(13, 1 + 12 * DEPTH); }
#undef PH
#undef IN
#undef SEAM
}
#define MAIN_KERNEL mk_fwd
#else
#define MAIN_KERNEL k_one<6>
#endif


#ifdef DBG_CHECK
__device__ __forceinline__ void dbg_report(unsigned* slot, float err) { if (!(err <= 3e38f)) err = 1e30f; atomicMax(slot, __float_as_uint(err)); }
__global__ void k_check_gemm(const bf16_t* A, int lda, const float* W, int K, int N, const bf16_t* Cm, int ldc, int M, unsigned* slot) {
    const unsigned id = blockIdx.x * blockDim.x + threadIdx.x; if (id >= 8192) return;
    const unsigned h = id * 2654435761u; const int row = (int)((h >> 8) % (unsigned)M), col = (int)((h * 40503u >> 7) % (unsigned)N);
    float ref = 0.f; for (int k = 0; k < K; ++k) ref += bf2f(A[(size_t)row * lda + k]) * W[(size_t)k * N + col];
    const float got = bf2f(Cm[(size_t)row * ldc + col]);
    dbg_report(slot, fabsf(got - ref) / (fabsf(ref) + 0.1f));
}

__global__ void k_check_attn(const unsigned char* ws, int type, unsigned* slot) {
    __shared__ float sc[RPB]; __shared__ float red[256]; __shared__ float qv[192];
    const int t = threadIdx.x, bh = blockIdx.x & 15, b = bh >> 3, h = bh & 7; const int qpos = (int)(((blockIdx.x >> 4) * 977u + 13u) % SEQ); const size_t rq = (size_t)b * RPB + CTXL + qpos, rk = (size_t)b * RPB;
    const bf16_t* P = (const bf16_t*)(ws + WS_P); const bf16_t* MQ = (const bf16_t*)(ws + WS_MQ); const bf16_t* MKV = (const bf16_t*)(ws + WS_MKV);
    const int dq = type ? 128 : 192;
    if (t < dq) { float v = type ? bf2f(P[rq * NP + C_AQ + h * 128 + t]) : bf2f(MQ[rq * 1536 + h * 192 + t]); qv[t] = v; }
    __syncthreads();
    if (!type && t < 32) {
        const int ri = qpos >> 6, ci = qpos & 63; const int i = t; const float pos = (float)(i < 16 ? ri : ci); const float inv = powf(10000.f, -(float)(i & 15) / 16.f); const float a = pos * inv;
        const float x1 = qv[128 + i], x2 = qv[160 + i]; qv[128 + i] = x1 * cosf(a) - x2 * sinf(a); qv[160 + i] = x2 * cosf(a) + x1 * sinf(a); }
    __syncthreads();
    const float scale = type ? 0.088388347648f : 0.0721687836487f;
    float mx = -1e30f;
    for (int k = t; k < RPB; k += 256) { float s = 0.f;
        if (type) { const bf16_t* kp = P + (rk + k) * NP + C_AK + (h >> 2) * 128; for (int d = 0; d < 128; ++d) s += qv[d] * bf2f(kp[d]); }
        else { const bf16_t* kp = MKV + (rk + k) * 2048 + h * 256; for (int d = 0; d < 128; ++d) s += qv[d] * bf2f(kp[d]); const bf16_t* kr = P + (rk + k) * NP + C_MKR; for (int d = 0; d < 64; ++d) s += qv[128 + d] * bf2f(kr[d]); }
        s *= scale; sc[k] = s; mx = fmaxf(mx, s); }
    red[t] = mx; __syncthreads(); for (int o = 128; o >= 1; o >>= 1) { if (t < o) red[t] = fmaxf(red[t], red[t + o]); __syncthreads(); } mx = red[0]; __syncthreads();
    float sum = 0.f; for (int k = t; k < RPB; k += 256) { const float p = __expf(sc[k] - mx); sc[k] = p; sum += p; }
    red[t] = sum; __syncthreads(); for (int o = 128; o >= 1; o >>= 1) { if (t < o) red[t] += red[t + o]; __syncthreads(); } sum = red[0]; __syncthreads();
    float e = 0.f, mag = 0.f;
    if (t < 128) { float o = 0.f; for (int k = 0; k < RPB; ++k) { const float vv = type ? bf2f(P[(rk + k) * NP + C_AV + (h >> 2) * 128 + t]) : bf2f(MKV[(rk + k) * 2048 + h * 256 + 128 + t]); o += sc[k] * vv; }
        o /= sum; const float got = bf2f(((const bf16_t*)(ws + (type ? WS_OA : WS_OM)))[rq * 1024 + h * 128 + t]); e = fabsf(got - o); mag = fabsf(o); }
    red[t] = e; __syncthreads(); for (int o = 128; o >= 1; o >>= 1) { if (t < o) red[t] = fmaxf(red[t], red[t + o]); __syncthreads(); } e = red[0]; __syncthreads();
    red[t] = mag; __syncthreads(); for (int o = 128; o >= 1; o >>= 1) { if (t < o) red[t] = fmaxf(red[t], red[t + o]); __syncthreads(); } mag = red[0];
    if (t == 0) dbg_report(slot, e / (mag + 1e-4f));
}
__global__ void __launch_bounds__(256) k_check_gla_rec(const unsigned char* ws, const float* wa_f, const float* ba_f, const float* wa_b, const float* ba_b, float* obuf, int b) {
    __shared__ float ad[128], kd[128], qd[128], lrs[16];
    const int e = threadIdx.x, h = blockIdx.x & 3, dir = blockIdx.x >> 2; const bf16_t* P = (const bf16_t*)(ws + WS_P);
    const float* wa = dir ? wa_b : wa_f; const float* ba = dir ? ba_b : ba_f;
    float S[128];
#pragma unroll
    for (int d = 0; d < 128; ++d) S[d] = 0.f;
    float* ob = obuf + ((size_t)(dir * 2 + b) * 4 + h) * RPB * 256;
    for (int st = 0; st < RPB; ++st) {
        int j; if (!dir) j = st; else j = st < CTXL ? CTXL - 1 - st : RPB - 1 - (st - CTXL);
        const size_t r = (size_t)b * RPB + j; const bf16_t* pr = P + r * NP;
        if (e < 16) lrs[e] = bf2f(pr[(dir ? C_LRB : C_LRF) + e]);
        __syncthreads();
        if (e < 128) { float pre = ba[h * 128 + e]; for (int q = 0; q < 16; ++q) pre += lrs[q] * wa[q * 512 + h * 128 + e];
            const float ls = (fminf(pre, 0.f) - log1pf(expf(-fabsf(pre)))) / 16.f; ad[e] = expf(ls); kd[e] = bf2f(pr[C_LK + h * 128 + e]); qd[e] = bf2f(pr[C_LQ + h * 128 + e]) * 0.088388347648f; }
        __syncthreads();
        const float v = bf2f(pr[C_LV + h * 256 + e]); float o = 0.f;
#pragma unroll
        for (int d = 0; d < 128; ++d) { S[d] = ad[d] * S[d] + kd[d] * v; o += qd[d] * S[d]; }
        ob[(size_t)j * 256 + e] = o;
        __syncthreads();
    }
}
__global__ void k_check_gla_cmp(const unsigned char* ws, const float* obuf, const float* gon, int b, unsigned* slot) {
    __shared__ float red[256];
    const int e = threadIdx.x, h = blockIdx.x & 3, j = blockIdx.x >> 2; const size_t r = (size_t)b * RPB + j; const bf16_t* P = (const bf16_t*)(ws + WS_P);
    const float o = obuf[((size_t)(0 * 2 + b) * 4 + h) * RPB * 256 + (size_t)j * 256 + e] + obuf[((size_t)(1 * 2 + b) * 4 + h) * RPB * 256 + (size_t)j * 256 + e];
    red[e] = o * o; __syncthreads(); for (int s_ = 128; s_ >= 1; s_ >>= 1) { if (e < s_) red[e] += red[e + s_]; __syncthreads(); }
    const float rs = rsqrtf(red[0] / 256.f + NORM_EPS); __syncthreads();
    const float gt = bf2f(P[r * NP + C_LG + h * 256 + e]); const float ref = o * rs * gon[e] * (gt / (1.f + expf(-gt)));
    const float got = bf2f(((const bf16_t*)(ws + WS_OL))[r * 1024 + h * 256 + e]);
    red[e] = fabsf(got - ref); __syncthreads(); for (int s_ = 128; s_ >= 1; s_ >>= 1) { if (e < s_) red[e] = fmaxf(red[e], red[e + s_]); __syncthreads(); }
    if (e == 0) dbg_report(slot, red[0] / 1.0f);
}
__global__ void k_check_select(const bf16_t* PQ, const float* k1, const float* k2, const int* PIDX, const float* PG, unsigned* slot) {
    __shared__ float s1[128], s2[128]; __shared__ int cnt; __shared__ float selv[16];
    const int tok = (blockIdx.x >> 3) * 61 + 5, head = blockIdx.x & 7, t = threadIdx.x;
    if (t == 0) cnt = 0;
    for (int n = t; n < 128; n += 64) { float a = 0.f, b = 0.f; for (int d = 0; d < 128; ++d) { a += bf2f(PQ[(size_t)tok * DM + head * 256 + d]) * k1[((size_t)head * 128 + n) * 128 + d]; b += bf2f(PQ[(size_t)tok * DM + head * 256 + 128 + d]) * k2[((size_t)head * 128 + n) * 128 + d]; } s1[n] = a; s2[n] = b; }
    __syncthreads();
    if (t < 16) { const int id = PIDX[(size_t)tok * 128 + head * 16 + t]; selv[t] = (id >= 0 && id < 16384) ? s1[id >> 7] + s2[id & 127] : -1e30f; }
    __syncthreads();
    float thr = selv[0], mx = selv[0]; for (int k = 1; k < 16; ++k) { thr = fminf(thr, selv[k]); mx = fmaxf(mx, selv[k]); }
    int c = 0; for (int p = t; p < 16384; p += 64) if (s1[p >> 7] + s2[p & 127] > thr + 0.02f) ++c;
    atomicAdd(&cnt, c); __syncthreads();
    if (t == 0) { float den = 0.f; for (int k = 0; k < 16; ++k) den += __expf(selv[k] - mx); float e = fabsf((float)cnt - 15.f) / 15.f > 0.34f ? fabsf((float)cnt - 15.f) / 15.f : 0.f;
        for (int k = 0; k < 16; ++k) e = fmaxf(e, fabsf(PG[(size_t)tok * 128 + head * 16 + k] - __expf(selv[k] - mx) / den) * 4.f);
        for (int k = 0; k < 16; ++k) for (int k2_ = 0; k2_ < k; ++k2_) if (PIDX[(size_t)tok * 128 + head * 16 + k] == PIDX[(size_t)tok * 128 + head * 16 + k2_]) e = fmaxf(e, 10.f);
        dbg_report(slot, e); }
}
__global__ void k_check_gather(const bf16_t* HB, const float* u, const float* v, const int* PIDX, const float* PG, const float* dbgo, unsigned* slot) {
    __shared__ float w[128];
    const int tok = blockIdx.x * 64 + 300, t = threadIdx.x;
    for (int k = t; k < 128; k += 64) { const int id = PIDX[(size_t)tok * 128 + k] & 16383; float a = 0.f; for (int d = 0; d < DM; ++d) a += bf2f(HB[(size_t)tok * DM + d]) * u[(size_t)id * DM + d];
        w[k] = PG[(size_t)tok * 128 + k] * 0.5f * a * (1.0f + erff(a * 0.70710678f)); }
    __syncthreads();
    float e = 0.f, sc = 0.f;
    for (int d = t; d < DM; d += 64) { float o = 0.f; for (int k = 0; k < 128; ++k) o += w[k] * v[(size_t)(PIDX[(size_t)tok * 128 + k] & 16383) * DM + d];
        e = fmaxf(e, fabsf(o - dbgo[(size_t)tok * DM + d])); sc = fmaxf(sc, fabsf(o)); }
    for (int o_ = 32; o_ >= 1; o_ >>= 1) { e = fmaxf(e, __shfl_xor(e, o_)); sc = fmaxf(sc, __shfl_xor(sc, o_)); }
    if (t == 0) dbg_report(slot, e / (sc + 1e-6f));
}
__global__ void k_dbg_out2(const float* x, const float* fg, float* out, const unsigned* slot) {
    const float mx = __uint_as_float(*slot); float v = 0.25f * (log10f(fmaxf(mx, 1e-30f)) + 4.0f); v = fminf(fmaxf(v, 0.f), 9.f);
    const float f = 1.0f + v;
    const int lane = threadIdx.x & 63; const size_t r = (size_t)blockIdx.x * 4 + (threadIdx.x >> 6);
    const float* xr = x + r * DM; float ss = 0.f;
    for (int c = lane; c < DM; c += 64) ss += xr[c] * xr[c];
    ss = wave_sum(ss); const float rs = rsqrtf(ss / DM + NORM_EPS);
    for (int c = lane; c < DM; c += 64) out[r * DM + c] = xr[c] * rs * fg[c] * f;
}
#endif
#ifdef DBG_SCAN
__global__ void k_scan16(const bf16_t* p, size_t n, unsigned* flags, int stage) {
    unsigned bad = 0; for (size_t i = (size_t)blockIdx.x * blockDim.x + threadIdx.x; i < n; i += (size_t)gridDim.x * blockDim.x) bad |= ((p[i] & 0x7f80u) == 0x7f80u);
    if (bad) atomicOr(&flags[stage], 1u);
}
__global__ void k_scan32(const float* p, size_t n, unsigned* flags, int stage) {
    unsigned bad = 0; for (size_t i = (size_t)blockIdx.x * blockDim.x + threadIdx.x; i < n; i += (size_t)gridDim.x * blockDim.x) bad |= ((__float_as_uint(p[i]) & 0x7f800000u) == 0x7f800000u);
    if (bad) atomicOr(&flags[stage], 1u);
}
__global__ void k_dbg_out(const float* x, const float* fg, float* out, const unsigned* flags, int nstage) {
    int code = 0; for (int s = nstage; s >= 1; --s) if (flags[s]) code = s;
    const float f = 1.0f + 0.25f * (float)code;
    const int lane = threadIdx.x & 63; const size_t r = (size_t)blockIdx.x * 4 + (threadIdx.x >> 6);
    const float* xr = x + r * DM; float ss = 0.f;
    for (int c = lane; c < DM; c += 64) ss += xr[c] * xr[c];
    ss = wave_sum(ss); const float rs = rsqrtf(ss / DM + NORM_EPS);
    for (int c = lane; c < DM; c += 64) out[r * DM + c] = xr[c] * rs * fg[c] * f;
}
#endif
extern "C" void kernel_launch(void* const* d_in, const int* in_sizes, int n_in, void* d_out, int out_size, void* d_ws, size_t ws_size, hipStream_t stream) {
    static int grid = 0;
    if (grid == 0) {
        if (n_in != 30 || out_size != NBATCH * SEQ * DM || ws_size < WS_END) { fprintf(stderr, "kernel_launch: shape/workspace mismatch: n_in %d out %d ws %zu (need %zu)\n", n_in, out_size, ws_size, (size_t)WS_END); grid = -1; return; }
        int dev = 0, cus = 0, per_cu = 0;
        if (hipGetDevice(&dev) != hipSuccess || hipDeviceGetAttribute(&cus, hipDeviceAttributeMultiprocessorCount, dev) != hipSuccess) { grid = -1; return; }
        bool okattr = hipFuncSetAttribute((const void*)MAIN_KERNEL, hipFuncAttributeMaxDynamicSharedMemorySize, LDS_BYTES) == hipSuccess;
#if MK_N_LAUNCHES != 1
#ifdef DBG_HYB
        okattr = okattr && hipFuncSetAttribute((const void*)mk_fwd, hipFuncAttributeMaxDynamicSharedMemorySize, LDS_BYTES) == hipSuccess;
#endif
#define SETA(K) okattr = okattr && hipFuncSetAttribute((const void*)k_one<K>, hipFuncAttributeMaxDynamicSharedMemorySize, LDS_BYTES) == hipSuccess
        SETA(0); SETA(1); SETA(2); SETA(3); SETA(4); SETA(5); SETA(6); SETA(7); SETA(8); SETA(9); SETA(10); SETA(11); SETA(12); SETA(13);
#undef SETA
#endif
        if (!okattr) { fprintf(stderr, "kernel_launch: hipFuncSetAttribute failed\n"); grid = -1; return; }
        if (hipOccupancyMaxActiveBlocksPerMultiprocessor(&per_cu, (const void*)MAIN_KERNEL, NTHREADS, LDS_BYTES) != hipSuccess || per_cu < 1) { fprintf(stderr, "kernel_launch: occupancy query says %d blocks per CU\n", per_cu); grid = -1; (void)hipGetLastError(); return; }
        grid = cus;
    }
    if (grid < 0) return;
    if (hipMemsetAsync((char*)d_ws + WS_CTL, 0, CTL_BYTES, stream) != hipSuccess) return;
    Args a{};
    for (int i = 0; i < 30; ++i) a.in[i] = (const float*)d_in[i];
    a.out = (float*)d_out; a.ws = (unsigned char*)d_ws;
#if MK_N_LAUNCHES == 1
#ifdef DBG_SPLIT
    for (int p = 0; p < N_PHASES; p += DBG_SPLIT) { a.ph_lo = p; a.ph_hi = p + DBG_SPLIT < N_PHASES ? p + DBG_SPLIT : N_PHASES; hipLaunchKernelGGL(mk_fwd, dim3(grid), dim3(NTHREADS), LDS_BYTES, stream, a); }
#else
    a.ph_lo = 0; a.ph_hi = N_PHASES;
    hipLaunchKernelGGL(mk_fwd, dim3(grid), dim3(NTHREADS), LDS_BYTES, stream, a);
#endif
#else
    a.ph_hi = 0;
#ifndef DBG_NLAUNCH
#define DBG_NLAUNCH 100
#endif
    int nl_ = 0;
#ifdef DBG_HYB
#define LAUNCH1(K, L) do { if (K == DBG_HYB) { a.ph_lo = 12 * (L) + (K); a.ph_hi = a.ph_lo + 1; hipLaunchKernelGGL(mk_fwd, dim3(grid), dim3(NTHREADS), LDS_BYTES, stream, a); a.ph_hi = 0; } else { a.ph_lo = (L); hipLaunchKernelGGL(k_one<K>, dim3(grid), dim3(NTHREADS), LDS_BYTES, stream, a); } } while (0)
#else
#define LAUNCH1(K, L) do { a.ph_lo = (L); if (nl_++ < DBG_NLAUNCH) { hipLaunchKernelGGL(k_one<K>, dim3(grid), dim3(NTHREADS), LDS_BYTES, stream, a); if (K == DBG_DUP) hipLaunchKernelGGL(k_one<K>, dim3(grid), dim3(NTHREADS), LDS_BYTES, stream, a); } } while (0)
#endif
#ifdef DBG_SCAN
    unsigned* flags = (unsigned*)((char*)d_ws + WS_CTL + 32768);
    char* W = (char*)d_ws;
#define S16(off, n, st) hipLaunchKernelGGL(k_scan16, dim3(1024), dim3(256), 0, stream, (const bf16_t*)(W + (off)), (size_t)(n), flags, st)
#define S32(off, n, st) hipLaunchKernelGGL(k_scan32, dim3(1024), dim3(256), 0, stream, (const float*)(W + (off)), (size_t)(n), flags, st)
    LAUNCH1(0, 0); S32(WS_MODV, 2 * 3 * 12288, 1);
    { const int l = 0;
      LAUNCH1(1, l); S16(WS_HB, (size_t)TT * DM, 2);
      LAUNCH1(2, l); S16(WS_P, (size_t)TT * NP, 3);
      LAUNCH1(3, l); S16(WS_P, (size_t)TT * NP, 4);
      LAUNCH1(4, l); S16(WS_MQ, (size_t)TT * 1536, 5); S16(WS_MKV, (size_t)TT * 2048, 5); S16(WS_GST, (size_t)2112 * 32768, 6); S32(WS_GDEC, (size_t)2112 * 128, 6);
      LAUNCH1(5, l); S16(WS_GST, (size_t)2112 * 32768, 7);
      LAUNCH1(6, l); S16(WS_OA, (size_t)TT * 1024, 8); S16(WS_OM, (size_t)TT * 1024, 9); S16(WS_OL, (size_t)TT * 1024, 10);
      LAUNCH1(7, l); S16(WS_Y, (size_t)TT * DM, 11);
      LAUNCH1(8, l); S32(WS_XS, (size_t)TT * DM, 12);
      LAUNCH1(9, l); S16(WS_HB, (size_t)TT * DM, 13);
      LAUNCH1(10, l); S16(WS_PQ, (size_t)TT * DM, 14);
      LAUNCH1(11, l); S32(WS_PG, (size_t)TT * 128, 15);
      LAUNCH1(12, l); S32(WS_XS, (size_t)TT * DM, 16);
    }
    hipLaunchKernelGGL(k_dbg_out, dim3(NBATCH * SEQ / 4), dim3(256), 0, stream, (const float*)d_in[0], (const float*)d_in[29], (float*)d_out, flags, 16);
#elif defined(DBG_CHECK)
    unsigned* flags = (unsigned*)((char*)d_ws + WS_CTL + 32768);
    char* W = (char*)d_ws;
    LAUNCH1(0, 0);
    { const int l = 0; LAUNCH1(1, l); LAUNCH1(2, l); LAUNCH1(3, l); LAUNCH1(4, l); LAUNCH1(5, l); LAUNCH1(6, l);
#if DBG_CHECK == 5 || DBG_CHECK == 6
      hipLaunchKernelGGL(k_check_attn, dim3(16 * 24), dim3(256), 0, stream, (const unsigned char*)d_ws, DBG_CHECK == 5 ? 1 : 0, flags + 100);
#endif
#if DBG_CHECK == 7
      { float* obuf = (float*)(W + WS_MQ);
        hipLaunchKernelGGL(k_check_gla_rec, dim3(8), dim3(256), 0, stream, (const unsigned char*)d_ws, (const float*)d_in[I_WA2F], (const float*)d_in[I_BAF], (const float*)d_in[I_WA2B], (const float*)d_in[I_BAB], obuf, 0);
        hipLaunchKernelGGL(k_check_gla_cmp, dim3(RPB * 4), dim3(256), 0, stream, (const unsigned char*)d_ws, (const float*)obuf, (const float*)d_in[I_ONG], 0, flags + 100); }
#endif
      LAUNCH1(7, l); LAUNCH1(8, l); LAUNCH1(9, l); LAUNCH1(10, l);
#if DBG_CHECK == 1
      hipLaunchKernelGGL(k_check_gemm, dim3(32), dim3(256), 0, stream, (const bf16_t*)(W + WS_HB), DM, (const float*)d_in[I_PWQ], DM, DM, (const bf16_t*)(W + WS_PQ), DM, TT, flags + 100);
#endif
      LAUNCH1(11, l);
#if DBG_CHECK == 2
      hipLaunchKernelGGL(k_check_select, dim3(256 * 8), dim3(64), 0, stream, (const bf16_t*)(W + WS_PQ), (const float*)d_in[I_PK1], (const float*)d_in[I_PK2], (const int*)(W + WS_PIDX), (const float*)(W + WS_PG), flags + 100);
#endif
      LAUNCH1(12, l);
#if DBG_CHECK == 3
      hipLaunchKernelGGL(k_check_gather, dim3(128), dim3(64), 0, stream, (const bf16_t*)(W + WS_HB), (const float*)d_in[I_PU], (const float*)d_in[I_PV], (const int*)(W + WS_PIDX), (const float*)(W + WS_PG), (const float*)(W + WS_MQ), flags + 100);
#endif
    }
    hipLaunchKernelGGL(k_dbg_out2, dim3(NBATCH * SEQ / 4), dim3(256), 0, stream, (const float*)d_in[0], (const float*)d_in[29], (float*)d_out, flags + 100);
#else
    LAUNCH1(0, 0);
    for (int l = 0; l < DEPTH; ++l) { LAUNCH1(1, l); LAUNCH1(2, l); LAUNCH1(3, l);
#ifdef DBG_DUP23
        LAUNCH1(2, l); LAUNCH1(3, l);
#endif
        LAUNCH1(4, l); LAUNCH1(5, l);
#ifdef DBG_DUP45
        LAUNCH1(4, l); LAUNCH1(5, l);
#endif
        LAUNCH1(6, l); LAUNCH1(7, l); LAUNCH1(8, l); LAUNCH1(9, l); LAUNCH1(10, l); LAUNCH1(11, l); LAUNCH1(12, l); }
    LAUNCH1(13, DEPTH - 1);
#endif
#undef LAUNCH1
#endif
    const hipError_t le = hipPeekAtLastError();
    if (le != hipSuccess) fprintf(stderr, "kernel_launch: launch failed: %s\n", hipGetErrorName(le));
}
```

```cpp
#include <hip/hip_runtime.h>
#include <cstdio>
#include <cstdint>

#ifndef MK_N_LAUNCHES
#ifndef DBG_DUP
#define DBG_DUP -1
#endif
#define MK_N_LAUNCHES 1
#endif

#ifndef DBG_MIX0
#define DBG_MIX0 1.0f
#define DBG_MIX1 1.0f
#define DBG_PEER0 1.0f
#define DBG_PEER1 1.0f
#endif
#ifndef MLA_NQR
#define MLA_NQR 6
#endif
#define LAS __attribute__((address_space(3)))
#define GLB __attribute__((address_space(1)))
typedef unsigned short bf16_t;
typedef short bf16x8 __attribute__((ext_vector_type(8)));
typedef short s16x4 __attribute__((ext_vector_type(4)));
typedef float f32x4 __attribute__((ext_vector_type(4)));
typedef float f32x2 __attribute__((ext_vector_type(2)));
typedef float f32x16 __attribute__((ext_vector_type(16)));
typedef unsigned u32x4 __attribute__((ext_vector_type(4)));
typedef unsigned u32x2 __attribute__((ext_vector_type(2)));
typedef __bf16 bf2_t __attribute__((ext_vector_type(2)));

constexpr int DM = 2048, NBATCH = 2, SEQ = 8192, CTXL = 256, DEPTH = 2;
constexpr int RPB = SEQ + CTXL;
constexpr int TT = NBATCH * RPB;
constexpr int IN_COLS = 11872, NP = 12032;
constexpr int C_AQ = 0, C_AK = 1024, C_AV = 1280, C_LQ = 1536, C_LK = 2048, C_LV = 2560, C_LG = 3584, C_LRF = 4608, C_LRB = 4624,
              C_MCQ = 4640, C_MCKV = 5152, C_MKR = 5664, C_GA = 5728, C_GL = 7776, C_GM = 9824;
constexpr int NCH = RPB / 64;
constexpr int NEXP = 16384;
constexpr float NORM_EPS = 1e-6f;
constexpr int NTHREADS = 512;

constexpr size_t al256(size_t x) { return (x + 255) / 256 * 256; }
constexpr size_t WS_CTL   = 0;
constexpr size_t CTL_BYTES = 65536;
constexpr size_t WS_MODV  = WS_CTL + CTL_BYTES;
constexpr size_t WS_TABA  = al256(WS_MODV + (size_t)2 * 3 * 12288 * 4);
constexpr size_t WS_TABM  = WS_TABA + 2 * 128 * 32 * 4;
constexpr size_t WS_XS    = al256(WS_TABM + 2 * 128 * 16 * 4);
constexpr size_t WS_HB    = WS_XS + (size_t)TT * DM * 4;
constexpr size_t WS_P     = WS_HB + (size_t)TT * DM * 2;
constexpr size_t WS_MQ    = WS_P + (size_t)TT * NP * 2;
constexpr size_t WS_MKV   = WS_MQ + (size_t)TT * 1536 * 2;
constexpr size_t WS_OA    = WS_MKV + (size_t)TT * 2048 * 2;
constexpr size_t WS_OL    = WS_OA + (size_t)TT * 1024 * 2;
constexpr size_t WS_OM    = WS_OL + (size_t)TT * 1024 * 2;
constexpr size_t WS_WIN   = WS_OM + (size_t)TT * 1024 * 2;
constexpr size_t WS_WUQ   = WS_WIN + (size_t)NP * 2048 * 2;
constexpr size_t WS_WUKV  = WS_WUQ + (size_t)1536 * 512 * 2;
constexpr size_t WS_WBR   = WS_WUKV + (size_t)2048 * 512 * 2;
constexpr size_t WS_WOUT  = WS_WBR + (size_t)3 * 2048 * 1024 * 2;
constexpr size_t WS_WQ    = WS_WOUT + (size_t)2048 * 2048 * 2;
constexpr size_t WS_K1    = WS_WQ + (size_t)2048 * 2048 * 2;
constexpr size_t WS_K2    = WS_K1 + (size_t)8 * 128 * 128 * 2;
constexpr size_t WS_GST   = WS_K2 + (size_t)8 * 128 * 128 * 2;
constexpr size_t WS_GDEC  = WS_GST + (size_t)NBATCH * 2 * 4 * NCH * 32768 * 2;
constexpr size_t WS_END0  = WS_GDEC + (size_t)NBATCH * 2 * 4 * NCH * 128 * 4;
constexpr size_t WS_Y     = WS_MKV;
constexpr size_t WS_PQ    = WS_OA;
constexpr size_t WS_PIDX  = WS_P;
constexpr size_t WS_PG    = WS_PIDX + (size_t)TT * 128 * 4;
constexpr size_t PT_BYTES = 2 * (size_t)NEXP * DM + 2 * (size_t)NEXP * 4;
constexpr size_t WS_WINS  = WS_END0;
constexpr size_t WS_PT    = al256(WS_WINS + (size_t)NP * 4);
constexpr size_t WS_END   = WS_PT + DEPTH * PT_BYTES;
constexpr size_t PT_U8 = 0, PT_V8 = (size_t)NEXP * DM, PT_SCU = 2 * (size_t)NEXP * DM, PT_SCV = PT_SCU + (size_t)NEXP * 4;
static_assert(WS_PG + (size_t)TT * 128 * 4 <= WS_MQ, "PEER alias region overflows P");

__device__ __forceinline__ unsigned cvt_pk_bf16(float lo, float hi) { bf2_t v; v.x = (__bf16)lo; v.y = (__bf16)hi; return __builtin_bit_cast(unsigned, v); }
__device__ __forceinline__ bf16_t f2bf(float f) { return (bf16_t)(cvt_pk_bf16(f, 0.f) & 0xffffu); }
__device__ __forceinline__ float bf2f(bf16_t b) { return __uint_as_float(((unsigned)b) << 16); }
__device__ __forceinline__ float bflo(unsigned w) { return __uint_as_float(w << 16); }
__device__ __forceinline__ float bfhi(unsigned w) { return __uint_as_float(w & 0xffff0000u); }
__device__ __forceinline__ float xchg32(float x, int lane) { auto r = __builtin_amdgcn_permlane32_swap(__float_as_uint(x), __float_as_uint(x), false, false); return __uint_as_float(lane < 32 ? r[1] : r[0]); }
__device__ __forceinline__ float xchg16(float x, int lane) { auto r = __builtin_amdgcn_permlane16_swap(__float_as_uint(x), __float_as_uint(x), false, false); return __uint_as_float((lane & 16) ? r[0] : r[1]); }
template <int CTRL> __device__ __forceinline__ float dppmov(float x) { return __uint_as_float(__builtin_amdgcn_update_dpp(0u, __float_as_uint(x), CTRL, 0xF, 0xF, false)); }
constexpr int DPP_ROR8 = 0x128, DPP_HMIRROR = 0x141, DPP_Q3210 = 0x1B, DPP_Q1032 = 0xB1;
__device__ __forceinline__ float wave_sum(float v) {
    const int lane = threadIdx.x & 63;
    v += xchg32(v, lane); v += xchg16(v, lane); v += dppmov<DPP_ROR8>(v); v += dppmov<DPP_HMIRROR>(v); v += dppmov<DPP_Q3210>(v); v += dppmov<DPP_Q1032>(v);
    return v;
}
__device__ __forceinline__ float sigmoidf_(float x) { return __builtin_amdgcn_rcpf(1.0f + __expf(-x)); }
__device__ __forceinline__ float siluf_(float x) { return x * __builtin_amdgcn_rcpf(1.0f + __expf(-x)); }

#define XB_TMO      128
#define XB_XCNT(j)  (256  + 64 * (j))
#define XB_XSUB(j)  (1280 + 64 * (j))
#define XB_XGEN(j)  (2304 + 64 * (j))
#define XB_TOP      3328
#define XB_TOPGEN   3392
#define XCD_BAR_WORDS 3456
#define XB_SPIN_CAP (1u << 20)
__device__ __forceinline__ unsigned xb_ld(unsigned* p)              { return __hip_atomic_load(p, __ATOMIC_RELAXED, __HIP_MEMORY_SCOPE_AGENT); }
__device__ __forceinline__ unsigned xb_add(unsigned* p, unsigned v) { return __hip_atomic_fetch_add(p, v, __ATOMIC_RELAXED, __HIP_MEMORY_SCOPE_AGENT); }
__device__ __forceinline__ unsigned xb_xcc_id() { return (unsigned)__builtin_amdgcn_s_getreg((3 << 11) | 20) & 0xFu; }
#define XB_SPIN(cond, bar) do { unsigned _sp = 0; while (cond) { __builtin_amdgcn_s_sleep(1); \
    if ((++_sp & 255u) == 0u) { if (xb_ld(&(bar)[XB_TMO])) break; if (_sp > XB_SPIN_CAP) { atomicAdd(&(bar)[XB_TMO], 1u); break; } } } } while (0)
struct XcdBarrier { unsigned* bar; unsigned x; volatile LAS unsigned* st; };
__device__ __forceinline__ XcdBarrier xcd_barrier_post(unsigned* bar, volatile LAS unsigned* st) {
    XcdBarrier b; b.bar = bar; b.x = xb_xcc_id(); b.st = st;
    if (threadIdx.x == 0) (void)xb_add(&bar[XB_XCNT(b.x)], 1u);
    return b;
}
__device__ __forceinline__ void xcd_barrier_complete(unsigned* bar, unsigned x, unsigned& nloc, unsigned& nx) {
    const unsigned G = gridDim.x * gridDim.y * gridDim.z;
    unsigned sum, cnt, mine, sp = 0u;
    for (;;) {
        sum = 0u; cnt = 0u; mine = 0u;
#pragma unroll
        for (unsigned j = 0; j < 16; ++j) { const unsigned c = xb_ld(&bar[XB_XCNT(j)]); sum += c; cnt += (c > 0u) ? 1u : 0u; mine = (j == x) ? c : mine; }
        if (sum == G) break;
        __builtin_amdgcn_s_sleep(1);
        if ((++sp & 255u) == 0u) { if (xb_ld(&bar[XB_TMO])) break; if (sp > XB_SPIN_CAP) { atomicAdd(&bar[XB_TMO], 1u); break; } }
    }
    nloc = mine > 0u ? mine : 1u; nx = cnt > 0u ? cnt : 1u;
}
__device__ __forceinline__ void xcd_barrier(const XcdBarrier& b) {
    asm volatile("s_waitcnt vmcnt(0)" ::: "memory");
    __syncthreads();
    if (threadIdx.x == 0) {
        unsigned* bar = b.bar;
        __builtin_amdgcn_s_waitcnt(0);
        unsigned nloc = b.st[0], nx = b.st[1];
        if (nloc == 0u) { xcd_barrier_complete(bar, b.x, nloc, nx); b.st[0] = nloc; b.st[1] = nx; }
        const unsigned old = xb_add(&bar[XB_XSUB(b.x)], 1u);
        const unsigned gen = old / nloc;
        if (old + 1u == (gen + 1u) * nloc) {
            __builtin_amdgcn_fence(__ATOMIC_RELEASE, "agent");
            asm volatile("s_waitcnt vmcnt(0)" ::: "memory");
            const unsigned og = xb_add(&bar[XB_TOP], 1u);
            const unsigned tg = og / nx;
            if (og + 1u == (tg + 1u) * nx) xb_add(&bar[XB_TOPGEN], 1u);
            else XB_SPIN(xb_ld(&bar[XB_TOPGEN]) == tg, bar);
            __builtin_amdgcn_fence(__ATOMIC_ACQUIRE, "agent");
            xb_add(&bar[XB_XGEN(b.x)], 1u);
            asm volatile("s_waitcnt vmcnt(0)" ::: "memory");
        } else {
            XB_SPIN(xb_ld(&bar[XB_XGEN(b.x)]) == gen, bar);
            __builtin_amdgcn_fence(__ATOMIC_ACQUIRE, "agent");
            asm volatile("s_waitcnt vmcnt(0)" ::: "memory");
        }
    }
    __syncthreads();
}

namespace pg8 {
constexpr int BM = 256, BK = 64, HALF = 128, HTB = HALF * BK * 2, STAGE_BYTES = 8 * HTB, NXCD = 8, WGM = 8;
__host__ __device__ __forceinline__ int lds_byte(int r, int c) { const int st = (r >> 4) * 2 + (c >> 5), rr = r & 15, cc = c & 31, ob = rr * 64 + cc * 2; return st * 1024 + (ob ^ (((ob >> 9) & 1) << 5)); }
__host__ __device__ __forceinline__ void stage_rc(int b, int& R, int& C) { const int st = b / 1024, sb = b % 1024, swz = sb ^ (((sb >> 9) & 1) << 5); R = (st >> 1) * 16 + swz / 64; C = (st & 1) * 32 + (swz % 64) / 2; }
__host__ __device__ __forceinline__ int perm32(int rho) { const int n = rho >> 4, i = rho & 15; return 8 * (i >> 2) + 4 * n + (i & 3); }
struct Unit { int pm, pn; };
struct Gemm { const bf16_t* A; const bf16_t* Bt; int M, N, K, lda, ldb; };
struct StaticOrder {
    int nM, nN, nwg, G, c, latent;
    __host__ __device__ void init(int M, int N, int G_, int c_, int latent_ = 0) { latent = latent_; nM = latent_ ? 64 : M / BM; nN = N / BM; nwg = nM * nN; G = G_; c = c_; }
    __host__ __device__ bool next(int i, Unit& u) const {
        const long L = (long)i * G + c; if (L >= nwg) return false;
        int wgid = (int)L; { const int q = nwg / NXCD, r = nwg % NXCD, xcd = wgid % NXCD, off = wgid / NXCD; wgid = (xcd < r ? xcd * (q + 1) : r * (q + 1) + (xcd - r) * q) + off; }
        const int nig = WGM * nN, gid = wgid / nig, fm = gid * WGM, gsz = (nM - fm) < WGM ? (nM - fm) : WGM;
        u.pm = fm + ((wgid % nig) % gsz); u.pn = (wgid % nig) / gsz; if (latent) u.pm += 1 + (u.pm >= 32 ? 1 : 0); return true;
    }
};
struct WinOrder {
    StaticOrder S; int full, nlat, G, c;
    __host__ __device__ void init(int G_, int c_, int full_) { full = full_; G = G_; c = c_; S.init(TT, NP, G_, c_, full_ ? 0 : 1); nlat = S.nwg; }
    __host__ __device__ bool next(int i, Unit& u) const {
        if (full) return S.next(i, u);
        const long L = (long)i * G + c;
        if (L < nlat) return S.next(i, u);
        const int q = (int)(L - nlat); if (q >= 24) return false;
        const int t = q % 12; u.pm = q < 12 ? 0 : 33;
        u.pn = t < 2 ? 4 + t : (t < 8 ? 8 + (t - 2) : (t == 8 ? 18 : 20 + (t - 9)));
        return true;
    }
};
struct EpiStoreBf16 {
    static constexpr bool PERM = true;
    bf16_t* O; int ldc;
    __device__ __forceinline__ void operator()(const f32x4 (&acc)[2][2][4][2], const Unit& u, int wr, int wc, int fr, int fq) const {
        const int row0 = u.pm * BM + wr * 64 + fr, col0 = u.pn * BM + wc * 32 + 8 * fq;
#pragma unroll
        for (int ai = 0; ai < 2; ++ai)
#pragma unroll
            for (int m = 0; m < 4; ++m) { bf16_t* rowp = O + (size_t)(row0 + ai * HALF + m * 16) * ldc + col0;
#pragma unroll
                for (int bj = 0; bj < 2; ++bj) { const f32x4 v0 = acc[ai][bj][m][0], v1 = acc[ai][bj][m][1];
                    u32x4 w; w.x = cvt_pk_bf16(v0[0], v0[1]); w.y = cvt_pk_bf16(v0[2], v0[3]); w.z = cvt_pk_bf16(v1[0], v1[1]); w.w = cvt_pk_bf16(v1[2], v1[3]);
                    *(u32x4*)(rowp + bj * HALF) = w; } }
    }
};
struct EpiNull {
    static constexpr bool PERM = true;
    __device__ __forceinline__ void operator()(const f32x4 (&acc)[2][2][4][2], const Unit&, int, int, int, int) const {
#pragma unroll
        for (int a = 0; a < 2; ++a)
#pragma unroll
            for (int b = 0; b < 2; ++b)
#pragma unroll
                for (int m = 0; m < 4; ++m)
#pragma unroll
                    for (int n = 0; n < 2; ++n) asm volatile("" :: "v"(acc[a][b][m][n]));
    }
};
struct EpiStoreBf16S {
    static constexpr bool PERM = true;
    bf16_t* O; int ldc; const float* cs;
    __device__ __forceinline__ void operator()(const f32x4 (&acc)[2][2][4][2], const Unit& u, int wr, int wc, int fr, int fq) const {
        const int row0 = u.pm * BM + wr * 64 + fr, col0 = u.pn * BM + wc * 32 + 8 * fq;
        f32x4 sv[2][2];
#pragma unroll
        for (int bj = 0; bj < 2; ++bj)
#pragma unroll
            for (int n = 0; n < 2; ++n) sv[bj][n] = *(const f32x4*)(cs + col0 + bj * HALF + 4 * n);
#pragma unroll
        for (int ai = 0; ai < 2; ++ai)
#pragma unroll
            for (int m = 0; m < 4; ++m) { bf16_t* rowp = O + (size_t)(row0 + ai * HALF + m * 16) * ldc + col0;
#pragma unroll
                for (int bj = 0; bj < 2; ++bj) { const f32x4 v0 = acc[ai][bj][m][0] * sv[bj][0], v1 = acc[ai][bj][m][1] * sv[bj][1];
                    u32x4 w; w.x = cvt_pk_bf16(v0[0], v0[1]); w.y = cvt_pk_bf16(v0[2], v0[3]); w.z = cvt_pk_bf16(v1[0], v1[1]); w.w = cvt_pk_bf16(v1[2], v1[3]);
                    *(u32x4*)(rowp + bj * HALF) = w; } }
    }
};
template <bool FIRST> struct EpiGate {
    static constexpr bool PERM = true;
    bf16_t* Y; int ldy; const bf16_t* Gt; int ldg;
    __device__ __forceinline__ void operator()(const f32x4 (&acc)[2][2][4][2], const Unit& u, int wr, int wc, int fr, int fq) const {
        const int row0 = u.pm * BM + wr * 64 + fr, col0 = u.pn * BM + wc * 32 + 8 * fq;
#pragma unroll
        for (int ai = 0; ai < 2; ++ai)
#pragma unroll
        for (int mh = 0; mh < 2; ++mh) {
            u32x4 g[2][2], y[2][2];
#pragma unroll
            for (int mm = 0; mm < 2; ++mm)
#pragma unroll
                for (int bj = 0; bj < 2; ++bj) { const size_t r = (size_t)(row0 + ai * HALF + (mh * 2 + mm) * 16);
                    g[mm][bj] = *(const u32x4*)(Gt + r * ldg + col0 + bj * HALF);
                    if (!FIRST) y[mm][bj] = *(const u32x4*)(Y + r * ldy + col0 + bj * HALF); }
#pragma unroll
            for (int mm = 0; mm < 2; ++mm)
#pragma unroll
                for (int bj = 0; bj < 2; ++bj) { const int m = mh * 2 + mm; const size_t r = (size_t)(row0 + ai * HALF + m * 16); const f32x4 v0 = acc[ai][bj][m][0], v1 = acc[ai][bj][m][1]; const u32x4 gg = g[mm][bj];
                    float o[8];
                    o[0] = sigmoidf_(bflo(gg.x)) * v0[0]; o[1] = sigmoidf_(bfhi(gg.x)) * v0[1]; o[2] = sigmoidf_(bflo(gg.y)) * v0[2]; o[3] = sigmoidf_(bfhi(gg.y)) * v0[3];
                    o[4] = sigmoidf_(bflo(gg.z)) * v1[0]; o[5] = sigmoidf_(bfhi(gg.z)) * v1[1]; o[6] = sigmoidf_(bflo(gg.w)) * v1[2]; o[7] = sigmoidf_(bfhi(gg.w)) * v1[3];
                    if (!FIRST) { const u32x4 yy = y[mm][bj];
                        o[0] += bflo(yy.x); o[1] += bfhi(yy.x); o[2] += bflo(yy.y); o[3] += bfhi(yy.y); o[4] += bflo(yy.z); o[5] += bfhi(yy.z); o[6] += bflo(yy.w); o[7] += bfhi(yy.w); }
                    u32x4 w; w.x = cvt_pk_bf16(o[0], o[1]); w.y = cvt_pk_bf16(o[2], o[3]); w.z = cvt_pk_bf16(o[4], o[5]); w.w = cvt_pk_bf16(o[6], o[7]);
                    *(u32x4*)(Y + r * ldy + col0 + bj * HALF) = w; }
        }
    }
};
struct EpiResid {
    static constexpr bool PERM = false;
    float* X; int ldx; const float* gate; float gscale;
    __device__ __forceinline__ void operator()(const f32x4 (&acc)[2][2][4][2], const Unit& u, int wr, int wc, int fr, int fq) const {
        const int row0 = u.pm * BM + wr * 64 + fr, col0 = u.pn * BM + wc * 32 + 4 * fq;
        const int sel = (u.pm % 33 == 0) ? 2 : (u.pm / 33);
        const float* gp = gate + (size_t)sel * 12288 + col0;
        f32x4 gv[2][2];
#pragma unroll
        for (int bj = 0; bj < 2; ++bj)
#pragma unroll
            for (int n = 0; n < 2; ++n) gv[bj][n] = *(const f32x4*)(gp + bj * HALF + n * 16) * gscale;
#pragma unroll
        for (int ai = 0; ai < 2; ++ai)
#pragma unroll
            for (int mh = 0; mh < 2; ++mh) {
                f32x4 x[2][2][2];
#pragma unroll
                for (int mm = 0; mm < 2; ++mm)
#pragma unroll
                    for (int bj = 0; bj < 2; ++bj)
#pragma unroll
                        for (int n = 0; n < 2; ++n) x[mm][bj][n] = *(const f32x4*)(X + (size_t)(row0 + ai * HALF + (mh * 2 + mm) * 16) * ldx + col0 + bj * HALF + n * 16);
#pragma unroll
                for (int mm = 0; mm < 2; ++mm)
#pragma unroll
                    for (int bj = 0; bj < 2; ++bj)
#pragma unroll
                        for (int n = 0; n < 2; ++n) *(f32x4*)(X + (size_t)(row0 + ai * HALF + (mh * 2 + mm) * 16) * ldx + col0 + bj * HALF + n * 16) = x[mm][bj][n] + gv[bj][n] * acc[ai][bj][mh * 2 + mm][n];
            }
    }
};

typedef int i32x8 __attribute__((ext_vector_type(8)));
typedef int i32x4 __attribute__((ext_vector_type(4)));
__device__ __forceinline__ i32x8 cat8(const bf16x8 lo, const bf16x8 hi) { const i32x4 a = __builtin_bit_cast(i32x4, lo), b = __builtin_bit_cast(i32x4, hi); return __builtin_shufflevector(a, b, 0, 1, 2, 3, 4, 5, 6, 7); }
template <class Epi, class Sched, int F8 = 0>
__device__ __forceinline__ void gemm_phase(LAS unsigned char* lds, const int tid, const Gemm g, const Sched& S, const Epi& E) {
    const int wid = __builtin_amdgcn_readfirstlane(tid >> 6), lane = tid & 63, wr = wid >> 2, wc = wid & 3, fr = lane & 15, fq = lane >> 4;
    const int K = g.K, nt = F8 ? K / 128 : K / BK, lda = g.lda, ldb = g.ldb;
    unsigned voffA[2], voffB[2];
#pragma unroll
    for (int i = 0; i < 2; ++i) { int R, C; stage_rc(tid * 16 + i * 8192, R, C); const int Rb = Epi::PERM ? ((R & ~31) + perm32(R & 31)) : R;
        voffA[i] = F8 ? (unsigned)(R * lda + C * 2) : (unsigned)(R * lda + C) * 2u; voffB[i] = F8 ? (unsigned)(Rb * ldb + C * 2) : (unsigned)(Rb * ldb + C) * 2u; }
    const size_t kstep = (size_t)(BK * 2);
    const size_t hstepA = (size_t)HALF * lda * (F8 ? 1 : 2), hstepB = (size_t)HALF * ldb * (F8 ? 1 : 2);
    const size_t tstepA = 2 * hstepA, tstepB = 2 * hstepB;
    const unsigned ldsw = (unsigned)wid * 1024u;
    const int aoff = F8 ? lds_byte(wr * 64 + fr, (fq & 1) * 16) + (fq >> 1) * 1024 : lds_byte(wr * 64 + fr, fq * 8);
    const int boff = F8 ? lds_byte(wc * 32 + fr, (fq & 1) * 16) + (fq >> 1) * 1024 : lds_byte(wc * 32 + fr, fq * 8);
#define PG8_SA(b, h) (((b) * 2 + (h)) * HTB)
#define PG8_SB(b, h) ((4 + (b) * 2 + (h)) * HTB)
#define PG8_STAGE(bufoff, gbase, voff) do { _Pragma("unroll") for (int _i = 0; _i < 2; ++_i) \
        __builtin_amdgcn_global_load_lds((const unsigned*)((const char*)(gbase) + (voff)[_i]), (LAS unsigned*)(lds + (bufoff) + ldsw + _i * 8192), 16, 0, 0); } while (0)
#define PG8_LDA(dst, b, h) do { if constexpr (F8) { _Pragma("unroll") for (int m = 0; m < 4; ++m) { const LAS unsigned char* p_ = lds + PG8_SA(b, h) + aoff + m * 2048; \
            const i32x4 lo_ = *(const LAS i32x4*)p_, hi_ = *(const LAS i32x4*)(p_ + 16); dst##8[m] = __builtin_shufflevector(lo_, hi_, 0, 1, 2, 3, 4, 5, 6, 7); } } \
        else { _Pragma("unroll") for (int m = 0; m < 4; ++m) _Pragma("unroll") for (int k = 0; k < 2; ++k) dst[m][k] = *(const LAS bf16x8*)(lds + PG8_SA(b, h) + aoff + m * 2048 + k * 1024); } } while (0)
#define PG8_LDB(dst, b, h) do { if constexpr (F8) { _Pragma("unroll") for (int n = 0; n < 2; ++n) { const LAS unsigned char* p_ = lds + PG8_SB(b, h) + boff + n * 2048; \
            const i32x4 lo_ = *(const LAS i32x4*)p_, hi_ = *(const LAS i32x4*)(p_ + 16); dst##8[n] = __builtin_shufflevector(lo_, hi_, 0, 1, 2, 3, 4, 5, 6, 7); } } \
        else { _Pragma("unroll") for (int n = 0; n < 2; ++n) _Pragma("unroll") for (int k = 0; k < 2; ++k) dst[n][k] = *(const LAS bf16x8*)(lds + PG8_SB(b, h) + boff + n * 2048 + k * 1024); } } while (0)
#define PG8_MMA(ai, bj, At, Bt) do { __builtin_amdgcn_s_setprio(1); \
        if constexpr (F8) { _Pragma("unroll") for (int m = 0; m < 4; ++m) _Pragma("unroll") for (int n = 0; n < 2; ++n) \
            asm volatile("v_mfma_scale_f32_16x16x128_f8f6f4 %0, %1, %2, %0, %3, %3 op_sel_hi:[0,0,0]" : "+v"(acc[ai][bj][m][n]) : "v"(Bt##8[n]), "v"(At##8[m]), "v"(mxscale)); } \
        else { _Pragma("unroll") for (int m = 0; m < 4; ++m) _Pragma("unroll") for (int n = 0; n < 2; ++n) _Pragma("unroll") for (int k = 0; k < 2; ++k) \
            acc[ai][bj][m][n] = __builtin_amdgcn_mfma_f32_16x16x32_bf16(Bt[n][k], At[m][k], acc[ai][bj][m][n], 0, 0, 0); } \
        __builtin_amdgcn_s_setprio(0); } while (0)
#define PG8_WAIT_V(n) asm volatile("s_waitcnt vmcnt(" #n ")" ::: "memory")
#define PG8_WAIT_L(n) asm volatile("s_waitcnt lgkmcnt(" #n ")" ::: "memory")
#define PG8_BAR __builtin_amdgcn_s_barrier()
#define PG8_SCHED __builtin_amdgcn_sched_barrier(0)
    Unit cur, nxt; int ui = 0;
    if (!S.next(0, cur)) return;
    f32x4 acc[2][2][4][2];
#pragma unroll
    for (int a = 0; a < 2; ++a)
#pragma unroll
        for (int b = 0; b < 2; ++b)
#pragma unroll
            for (int m = 0; m < 4; ++m)
#pragma unroll
                for (int n = 0; n < 2; ++n) acc[a][b][m][n] = (f32x4){0.f, 0.f, 0.f, 0.f};
    int mxscale = 0x7f7f7f7f; asm volatile("" : "+v"(mxscale));
    bf16x8 At[4][2], B0[2][2], B1[2][2]; i32x8 At8[4], B08[2], B18[2];
    const char* cA = (const char*)g.A + (size_t)cur.pm * tstepA; const char* cB = (const char*)g.Bt + (size_t)cur.pn * tstepB;
    PG8_STAGE(PG8_SB(0, 0), cB, voffB); PG8_STAGE(PG8_SA(0, 0), cA, voffA); PG8_STAGE(PG8_SB(0, 1), cB + hstepB, voffB); PG8_STAGE(PG8_SA(0, 1), cA + hstepA, voffA);
    if (wr == 1) PG8_BAR;
    PG8_WAIT_V(4); PG8_BAR;
    PG8_STAGE(PG8_SB(1, 0), cB + kstep, voffB); PG8_STAGE(PG8_SA(1, 0), cA + kstep, voffA); PG8_STAGE(PG8_SB(1, 1), cB + hstepB + kstep, voffB);
    PG8_WAIT_V(6); PG8_BAR;
    for (;;) {
        const bool has_next = S.next(ui + 1, nxt);
        const char* nA = has_next ? (const char*)g.A + (size_t)nxt.pm * tstepA : cA; const char* nB = has_next ? (const char*)g.Bt + (size_t)nxt.pn * tstepB : cB;
        for (int t = 0; t < nt; t += 2) {
            const bool last = (t == nt - 2);
            const char* a1 = cA + (size_t)(t + 1) * kstep;
            const char* a2 = last ? nA : cA + (size_t)(t + 2) * kstep; const char* b2 = last ? nB : cB + (size_t)(t + 2) * kstep;
            const char* a3 = a2 + kstep; const char* b3 = b2 + kstep;
            PG8_LDB(B0, 0, 0); PG8_SCHED; PG8_LDA(At, 0, 0); PG8_STAGE(PG8_SA(1, 1), a1 + hstepA, voffA);
            PG8_WAIT_L(8); PG8_BAR; PG8_WAIT_L(0); PG8_MMA(0, 0, At, B0); PG8_BAR; PG8_SCHED;
            PG8_LDB(B1, 0, 1); PG8_STAGE(PG8_SB(0, 0), b2, voffB);
            PG8_BAR; PG8_WAIT_L(0); PG8_MMA(0, 1, At, B1); PG8_BAR;
            PG8_LDA(At, 0, 1); PG8_STAGE(PG8_SA(0, 0), a2, voffA);
            PG8_BAR; PG8_WAIT_L(0); PG8_MMA(1, 0, At, B0); PG8_BAR; PG8_SCHED;
            PG8_STAGE(PG8_SB(0, 1), b2 + hstepB, voffB);
            PG8_WAIT_V(6); PG8_BAR; PG8_MMA(1, 1, At, B1); PG8_BAR;
            PG8_LDB(B0, 1, 0); PG8_SCHED; PG8_LDA(At, 1, 0); PG8_STAGE(PG8_SA(0, 1), a2 + hstepA, voffA);
            PG8_WAIT_L(8); PG8_BAR; PG8_WAIT_L(0); PG8_MMA(0, 0, At, B0); PG8_BAR; PG8_SCHED;
            PG8_LDB(B1, 1, 1); PG8_STAGE(PG8_SB(1, 0), b3, voffB);
            PG8_BAR; PG8_WAIT_L(0); PG8_MMA(0, 1, At, B1); PG8_BAR;
            PG8_LDA(At, 1, 1); PG8_STAGE(PG8_SA(1, 0), a3, voffA);
            PG8_BAR; PG8_WAIT_L(0); PG8_MMA(1, 0, At, B0); PG8_BAR; PG8_SCHED;
            PG8_STAGE(PG8_SB(1, 1), b3 + hstepB, voffB);
            PG8_WAIT_V(6); PG8_BAR; PG8_MMA(1, 1, At, B1); PG8_BAR;
        }
        if constexpr (F8) asm volatile("s_nop 15\n\ts_nop 7" ::: "memory");
        E(acc, cur, wr, wc, fr, fq);
        if (!has_next) break;
#pragma unroll
        for (int a = 0; a < 2; ++a)
#pragma unroll
            for (int b = 0; b < 2; ++b)
#pragma unroll
                for (int m = 0; m < 4; ++m)
#pragma unroll
                    for (int n = 0; n < 2; ++n) acc[a][b][m][n] = (f32x4){0.f, 0.f, 0.f, 0.f};
        cur = nxt; cA = nA; cB = nB; ++ui;
    }
    PG8_WAIT_V(0);
    if (wr == 0) PG8_BAR;
    PG8_BAR;
#undef PG8_SA
#undef PG8_SB
#undef PG8_STAGE
#undef PG8_LDA
#undef PG8_LDB
#undef PG8_MMA
#undef PG8_WAIT_V
#undef PG8_WAIT_L
#undef PG8_BAR
#undef PG8_SCHED
}
}

struct Args { const float* in[30]; float* out; unsigned char* ws; int ph_lo, ph_hi; };
enum { I_X = 0, I_C, I_CTX, I_CCTX, I_WMOD, I_BMOD, I_N1G, I_WIN, I_QNG, I_KNG, I_WA2F, I_BAF, I_WA2B, I_BAB, I_ONG, I_MQNG, I_WUQ, I_MKVNG, I_WUKV,
       I_WBRA, I_WBRL, I_WBRM, I_WOUT, I_N2G, I_PWQ, I_PK1, I_PK2, I_PU, I_PV, I_FG };
typedef const float* cfp_t;
struct Ctx {
    const __attribute__((address_space(4))) cfp_t* in; float* out; unsigned char* ws; LAS unsigned char* lds;
    int tid, lane, wid, G, bid;
};
#define WSP(T, off) ((T*)(C.ws + (off)))
#define INP(i) ((const float*)(const GLB float*)C.in[(i)])
__device__ __forceinline__ unsigned long long launder_u64(unsigned long long w) {
    unsigned lo = (unsigned)w, hi = (unsigned)(w >> 32); asm volatile("" : "+v"(lo), "+v"(hi));
    lo = __builtin_amdgcn_readfirstlane(lo); hi = __builtin_amdgcn_readfirstlane(hi); return ((unsigned long long)hi << 32) | lo;
}
__device__ __forceinline__ Ctx launder(const Ctx& C0) {
    Ctx R = C0; int t = C0.tid; asm volatile("" : "+v"(t)); R.tid = t; R.lane = t & 63; R.wid = __builtin_amdgcn_readfirstlane(t >> 6);
    R.ws = (unsigned char*)(GLB unsigned char*)launder_u64((unsigned long long)C0.ws);
    R.out = (float*)(GLB float*)(unsigned long long)C0.out;
    R.in = (const __attribute__((address_space(4))) cfp_t*)launder_u64((unsigned long long)C0.in);
    unsigned l = (unsigned)(uintptr_t)C0.lds; asm volatile("" : "+v"(l)); l = __builtin_amdgcn_readfirstlane(l); R.lds = (LAS unsigned char*)(uintptr_t)l;
    return R;
}

__device__ __forceinline__ const float* src_row(const Ctx& C, int r) {
    const int b = r / RPB, j = r % RPB;
    return j < CTXL ? INP(I_CTX) + ((size_t)b * CTXL + j) * DM : INP(I_X) + ((size_t)b * SEQ + (j - CTXL)) * DM;
}
__device__ __forceinline__ int mod_sel(int r) { const int b = r / RPB, j = r % RPB; return j < CTXL ? 2 : b; }

__device__ __forceinline__ void phase_modv(const Ctx& C) {
    LAS float* sc = (LAS float*)C.lds;
    LAS float* red = (LAS float*)(C.lds + 3 * 2048 * 4);
    for (int i = C.tid; i < 3 * DM; i += NTHREADS) { const int r = i / DM, k = i % DM; const float v = r < 2 ? INP(I_C)[r * DM + k] : INP(I_CCTX)[k]; sc[i] = siluf_(v); }
    __syncthreads();
    float* modv = WSP(float, WS_MODV);
    const int kq = C.tid / 12, c4 = C.tid % 12;
    for (int item = C.bid; item < 2 * 256; item += C.G) {
        const int l = item / 256, cg = item % 256;
        float acc[3][4];
#pragma unroll
        for (int r = 0; r < 3; ++r)
#pragma unroll
            for (int j = 0; j < 4; ++j) acc[r][j] = 0.f;
        if (kq < 42) {
            const float* wp = INP(I_WMOD) + (size_t)l * DM * 12288 + 48 * cg + 4 * c4;
#pragma unroll 1
            for (int k0 = kq; k0 < DM; k0 += 42 * 7) {
                f32x4 w[7];
#pragma unroll
                for (int u = 0; u < 7; ++u) { const int k = k0 + 42 * u; w[u] = k < DM ? *(const f32x4*)(wp + (size_t)k * 12288) : (f32x4){0.f, 0.f, 0.f, 0.f}; }
#pragma unroll
                for (int u = 0; u < 7; ++u) { const int k = k0 + 42 * u; if (k < DM) {
#pragma unroll
                    for (int r = 0; r < 3; ++r) { const float sv = sc[r * DM + k];
#pragma unroll
                        for (int j = 0; j < 4; ++j) acc[r][j] += sv * w[u][j]; } } }
            }
#pragma unroll
            for (int r = 0; r < 3; ++r)
#pragma unroll
                for (int j = 0; j < 4; ++j) red[kq * 144 + r * 48 + c4 * 4 + j] = acc[r][j];
        }
        __syncthreads();
        if (C.tid < 144) { float s = 0.f; for (int q = 0; q < 42; ++q) s += red[q * 144 + C.tid];
            const int r = C.tid / 48, cc = C.tid % 48;
            modv[((size_t)l * 3 + r) * 12288 + 48 * cg + cc] = s + INP(I_BMOD)[(size_t)l * 12288 + 48 * cg + cc]; }
        __syncthreads();
    }
}
__device__ __forceinline__ void phase_tables(const Ctx& C) {
    float* ta = WSP(float, WS_TABA); float* tm = WSP(float, WS_TABM);
    for (int i = C.bid * NTHREADS + C.tid; i < 128 * 32 + 128 * 16; i += C.G * NTHREADS) {
        if (i < 128 * 32) { const int pos = i / 32, f = i % 32; const float inv = exp2f(-(float)f * (13.287712379549449f / 32.0f)); const float a = (float)pos * inv;
            ta[i] = cosf(a); ta[128 * 32 + i] = sinf(a); }
        else { const int k = i - 128 * 32, pos = k / 16, f = k % 16; const float inv = exp2f(-(float)f * (13.287712379549449f / 16.0f)); const float a = (float)pos * inv;
            tm[k] = cosf(a); tm[128 * 16 + k] = sinf(a); }
    }
}
__device__ __forceinline__ void transpose_cvt(const Ctx& C, const float* src, int K, int N, bf16_t* dst, int Npad, int& item) {
    LAS float* tile = (LAS float*)C.lds;
    const int tk = K / 64, tn = Npad / 256, ntile = tk * tn;
    const int t0 = ((C.bid - item % C.G) + C.G) % C.G; item += ntile;
    for (int t = t0; t < ntile; t += C.G) {
        const int k0 = (t / tn) * 64, n0 = (t % tn) * 256;
        const int nn = (C.tid & 63) * 4, kr = C.tid >> 6;
        f32x4 v[8];
#pragma unroll
        for (int p = 0; p < 8; ++p) { v[p] = (f32x4){0.f, 0.f, 0.f, 0.f}; if (n0 + nn < N) v[p] = *(const f32x4*)(src + (size_t)(k0 + kr + p * 8) * N + n0 + nn); }
#pragma unroll
        for (int p = 0; p < 8; ++p)
#pragma unroll
            for (int j = 0; j < 4; ++j) tile[(kr + p * 8) * 257 + nn + j] = v[p][j];
        __syncthreads();
        { const int n = C.tid >> 1, kh = (C.tid & 1) * 32;
#pragma unroll
          for (int q = 0; q < 4; ++q) { float x[8];
#pragma unroll
              for (int j = 0; j < 8; ++j) x[j] = tile[(kh + q * 8 + j) * 257 + n];
              u32x4 w; w.x = cvt_pk_bf16(x[0], x[1]); w.y = cvt_pk_bf16(x[2], x[3]); w.z = cvt_pk_bf16(x[4], x[5]); w.w = cvt_pk_bf16(x[6], x[7]);
              *(u32x4*)(dst + (size_t)(n0 + n) * K + k0 + kh + q * 8) = w; } }
        __syncthreads();
    }
}
__device__ __forceinline__ void transpose_cvt_fp8(const Ctx& C, const float* src, int K, int N, unsigned char* dst, int Npad, float* cinv) {
    LAS float* tile = (LAS float*)C.lds;
    LAS float* red = (LAS float*)(C.lds + 64 * 65 * 4);
    LAS float* scl = red + 32 * 64;
    const int kk = C.tid >> 4, nn = (C.tid & 15) * 4;
    for (int cgp = C.bid; cgp < Npad / 64; cgp += C.G) {
        const int n0 = cgp * 64; const bool live = n0 + nn < N;
        float am[4] = {0.f, 0.f, 0.f, 0.f};
        for (int k0 = 0; k0 < K; k0 += 128) {
            f32x4 v[4];
#pragma unroll
            for (int p = 0; p < 4; ++p) v[p] = live ? *(const f32x4*)(src + (size_t)(k0 + kk + p * 32) * N + n0 + nn) : (f32x4){0.f, 0.f, 0.f, 0.f};
#pragma unroll
            for (int p = 0; p < 4; ++p)
#pragma unroll
                for (int j = 0; j < 4; ++j) am[j] = fmaxf(am[j], fabsf(v[p][j])); }
#pragma unroll
        for (int j = 0; j < 4; ++j) red[kk * 64 + nn + j] = am[j];
        __syncthreads();
        if (C.tid < 64) { float m = 0.f; for (int q = 0; q < 32; ++q) m = fmaxf(m, red[q * 64 + C.tid]);
            scl[C.tid] = m > 0.f ? 224.0f / m : 1.0f; cinv[n0 + C.tid] = m > 0.f ? m * (1.0f / 224.0f) : 1.0f; }
        __syncthreads();
        for (int k0 = 0; k0 < K; k0 += 64) {
#pragma unroll
            for (int p = 0; p < 2; ++p) { const f32x4 v = live ? *(const f32x4*)(src + (size_t)(k0 + kk + p * 32) * N + n0 + nn) : (f32x4){0.f, 0.f, 0.f, 0.f};
#pragma unroll
                for (int j = 0; j < 4; ++j) tile[(kk + p * 32) * 65 + nn + j] = v[j]; }
            __syncthreads();
            { const int n = C.tid >> 3, k8 = (C.tid & 7) * 8; const float sc = scl[n]; float x[8];
#pragma unroll
              for (int j = 0; j < 8; ++j) x[j] = tile[(k8 + j) * 65 + n] * sc;
              int p0 = __builtin_amdgcn_cvt_pk_fp8_f32(x[0], x[1], 0, false); p0 = __builtin_amdgcn_cvt_pk_fp8_f32(x[2], x[3], p0, true);
              int p1 = __builtin_amdgcn_cvt_pk_fp8_f32(x[4], x[5], 0, false); p1 = __builtin_amdgcn_cvt_pk_fp8_f32(x[6], x[7], p1, true);
              u32x2 w; w.x = (unsigned)p0; w.y = (unsigned)p1; *(u32x2*)(dst + (size_t)(n0 + n) * K + k0 + k8) = w; }
            __syncthreads();
        }
    }
}
__device__ __forceinline__ void cvt_plain(const Ctx& C, const float* src, bf16_t* dst, size_t n8) {
    for (size_t i = (size_t)C.bid * NTHREADS + C.tid; i < n8; i += (size_t)C.G * NTHREADS) {
        const f32x4 a = *(const f32x4*)(src + i * 8), b = *(const f32x4*)(src + i * 8 + 4);
        u32x4 w; w.x = cvt_pk_bf16(a[0], a[1]); w.y = cvt_pk_bf16(a[2], a[3]); w.z = cvt_pk_bf16(b[0], b[1]); w.w = cvt_pk_bf16(b[2], b[3]);
        *(u32x4*)(dst + i * 8) = w;
    }
}
__device__ __forceinline__ void phase_cvt_mixer_weights(const Ctx& C, int l) {
    int item = 0;
    transpose_cvt_fp8(C, INP(I_WIN) + (size_t)l * DM * IN_COLS, DM, IN_COLS, C.ws + WS_WIN, NP, WSP(float, WS_WINS));
    __syncthreads();
    transpose_cvt(C, INP(I_WUQ) + (size_t)l * 512 * 1536, 512, 1536, WSP(bf16_t, WS_WUQ), 1536, item);
    transpose_cvt(C, INP(I_WUKV) + (size_t)l * 512 * 2048, 512, 2048, WSP(bf16_t, WS_WUKV), 2048, item);
    transpose_cvt(C, INP(I_WBRA) + (size_t)l * 1024 * 2048, 1024, 2048, WSP(bf16_t, WS_WBR), 2048, item);
    transpose_cvt(C, INP(I_WBRL) + (size_t)l * 1024 * 2048, 1024, 2048, WSP(bf16_t, WS_WBR) + (size_t)2048 * 1024, 2048, item);
    transpose_cvt(C, INP(I_WBRM) + (size_t)l * 1024 * 2048, 1024, 2048, WSP(bf16_t, WS_WBR) + (size_t)2 * 2048 * 1024, 2048, item);
    transpose_cvt(C, INP(I_WOUT) + (size_t)l * 2048 * 2048, 2048, 2048, WSP(bf16_t, WS_WOUT), 2048, item);
    transpose_cvt(C, INP(I_PWQ) + (size_t)l * 2048 * 2048, 2048, 2048, WSP(bf16_t, WS_WQ), 2048, item);
    cvt_plain(C, INP(I_PK1) + (size_t)l * 8 * 128 * 128, WSP(bf16_t, WS_K1), 8 * 128 * 128 / 8);
    cvt_plain(C, INP(I_PK2) + (size_t)l * 8 * 128 * 128, WSP(bf16_t, WS_K2), 8 * 128 * 128 / 8);
}
__device__ __forceinline__ void phase_cvt_peer_tables(const Ctx& C, int l, int row_lo, int row_hi, int wg_lo) {
    const int lane = C.lane; if (C.bid < wg_lo) return;
    unsigned char* pt = C.ws + WS_PT + (size_t)l * PT_BYTES;
    for (int row = row_lo + (C.bid - wg_lo) * 8 + C.wid; row < row_hi; row += (C.G - wg_lo) * 8) {
#pragma unroll 1
        for (int tb = 0; tb < 2; ++tb) {
            const float* src = (tb ? INP(I_PV) : INP(I_PU)) + ((size_t)l * NEXP + row) * DM + lane * 16;
            f32x4 x[8]; float amax = 0.f;
#pragma unroll
            for (int c = 0; c < 2; ++c)
#pragma unroll
                for (int q = 0; q < 4; ++q) { x[c * 4 + q] = *(const f32x4*)(src + c * 1024 + q * 4);
                    amax = fmaxf(amax, fmaxf(fmaxf(fabsf(x[c * 4 + q][0]), fabsf(x[c * 4 + q][1])), fmaxf(fabsf(x[c * 4 + q][2]), fabsf(x[c * 4 + q][3])))); }
            amax = fmaxf(amax, xchg32(amax, lane)); amax = fmaxf(amax, xchg16(amax, lane)); amax = fmaxf(amax, dppmov<DPP_ROR8>(amax));
            amax = fmaxf(amax, dppmov<DPP_HMIRROR>(amax)); amax = fmaxf(amax, dppmov<DPP_Q3210>(amax)); amax = fmaxf(amax, dppmov<DPP_Q1032>(amax));
            const float sc = amax > 0.f ? 224.0f / amax : 1.0f, inv = amax > 0.f ? amax * (1.0f / 224.0f) : 1.0f;
            unsigned char* dst = pt + (tb ? PT_V8 : PT_U8) + (size_t)(lane >> 3) * ((size_t)NEXP * 128) + (size_t)row * 128 + (lane & 7) * 16;
#pragma unroll
            for (int c = 0; c < 2; ++c) { u32x4 w;
#pragma unroll
                for (int q = 0; q < 4; ++q) { const f32x4 v = x[c * 4 + q] * sc; int p = __builtin_amdgcn_cvt_pk_fp8_f32(v[0], v[1], 0, false); p = __builtin_amdgcn_cvt_pk_fp8_f32(v[2], v[3], p, true); w[q] = (unsigned)p; }
                *(u32x4*)(dst + (size_t)c * 8 * ((size_t)NEXP * 128)) = w; }
            if (lane == 0) ((float*)(pt + (tb ? PT_SCV : PT_SCU)))[row] = inv;
        }
    }
}

template <bool FIRST, bool F8OUT = false> __device__ __forceinline__ void phase_norm_mod(const Ctx& C, const float* gvec, const float* modl  , int shift_off, int scale_off) {
    float* xs = WSP(float, WS_XS); bf16_t* hb = WSP(bf16_t, WS_HB);
    for (int r = C.bid * 8 + C.wid; r < TT; r += C.G * 8) {
        const float* xr = FIRST ? src_row(C, r) : xs + (size_t)r * DM;
        const float* mv = modl + (size_t)mod_sel(r) * 12288;
        f32x4 v[8]; float ss = 0.f;
#pragma unroll
        for (int c = 0; c < 4; ++c) { v[2 * c] = *(const f32x4*)(xr + c * 512 + C.lane * 8); v[2 * c + 1] = *(const f32x4*)(xr + c * 512 + C.lane * 8 + 4); }
#pragma unroll
        for (int c = 0; c < 8; ++c) ss += v[c][0] * v[c][0] + v[c][1] * v[c][1] + v[c][2] * v[c][2] + v[c][3] * v[c][3];
        ss = wave_sum(ss);
        const float rs = rsqrtf(ss * (1.0f / DM) + NORM_EPS);
#pragma unroll
        for (int c = 0; c < 4; ++c) { const int col = c * 512 + C.lane * 8;
            if (FIRST) { *(f32x4*)(xs + (size_t)r * DM + col) = v[2 * c]; *(f32x4*)(xs + (size_t)r * DM + col + 4) = v[2 * c + 1]; }
            float o[8];
#pragma unroll
            for (int h = 0; h < 2; ++h) { const f32x4 g = *(const f32x4*)(gvec + col + 4 * h), s = *(const f32x4*)(mv + scale_off + col + 4 * h), t = *(const f32x4*)(mv + shift_off + col + 4 * h);
#pragma unroll
                for (int j = 0; j < 4; ++j) o[4 * h + j] = v[2 * c + h][j] * rs * g[j] * (1.0f + s[j]) + t[j]; }
            if constexpr (F8OUT) {
                int p0 = __builtin_amdgcn_cvt_pk_fp8_f32(o[0], o[1], 0, false); p0 = __builtin_amdgcn_cvt_pk_fp8_f32(o[2], o[3], p0, true);
                int p1 = __builtin_amdgcn_cvt_pk_fp8_f32(o[4], o[5], 0, false); p1 = __builtin_amdgcn_cvt_pk_fp8_f32(o[6], o[7], p1, true);
                u32x2 w; w.x = (unsigned)p0; w.y = (unsigned)p1; *(u32x2*)((unsigned char*)hb + (size_t)r * DM + col) = w;
            } else {
            u32x4 w; w.x = cvt_pk_bf16(o[0], o[1]); w.y = cvt_pk_bf16(o[2], o[3]); w.z = cvt_pk_bf16(o[4], o[5]); w.w = cvt_pk_bf16(o[6], o[7]);
            *(u32x4*)(hb + (size_t)r * DM + col) = w; } }
    }
}

__device__ __forceinline__ void phase_post_p(const Ctx& C, int l) {
    bf16_t* P = WSP(bf16_t, WS_P); const float* ta = WSP(float, WS_TABA); const float* tm = WSP(float, WS_TABM);
    const float* qg = INP(I_QNG) + l * 128; const float* kg = INP(I_KNG) + l * 128;
    const float* mqg = INP(I_MQNG) + l * 512; const float* mkvg = INP(I_MKVNG) + l * 512;
    const int lane = C.lane;
    const float qg1 = qg[lane], qg2 = qg[lane + 64], kg1 = kg[lane], kg2 = kg[lane + 64];
    for (int r = C.bid * 8 + C.wid; r < TT; r += C.G * 8) {
        bf16_t* pr = P + (size_t)r * NP;
        const int j = r % RPB; const bool lat = j >= CTXL; const int pos = lat ? j - CTXL : 0, ri = pos >> 6, ci = pos & 63;
        float cs = 1.f, sn = 0.f;
        if (lat) { const int p = lane < 32 ? ri : ci, f = lane & 31; cs = ta[p * 32 + f]; sn = ta[128 * 32 + p * 32 + f]; }
#pragma unroll
        for (int h = 0; h < 10; ++h) {
            bf16_t* hp = pr + (h < 8 ? C_AQ + h * 128 : C_AK + (h - 8) * 128);
            const float x1 = bf2f(hp[lane]), x2 = bf2f(hp[lane + 64]);
            const float ss = wave_sum(x1 * x1 + x2 * x2);
            const float rs = rsqrtf(ss * (1.0f / 128.0f) + NORM_EPS);
            const float y1 = x1 * rs * (h < 8 ? qg1 : kg1), y2 = x2 * rs * (h < 8 ? qg2 : kg2);
            hp[lane] = f2bf(y1 * cs - y2 * sn); hp[lane + 64] = f2bf(y2 * cs + y1 * sn);
        }
#pragma unroll
        for (int s = 0; s < 2; ++s) {
            bf16_t* sp = pr + (s == 0 ? C_MCQ : C_MCKV) + lane * 8; const float* gg = (s == 0 ? mqg : mkvg) + lane * 8;
            const u32x4 w = *(const u32x4*)sp; float x[8] = {bflo(w.x), bfhi(w.x), bflo(w.y), bfhi(w.y), bflo(w.z), bfhi(w.z), bflo(w.w), bfhi(w.w)};
            float ss = 0.f;
#pragma unroll
            for (int i = 0; i < 8; ++i) ss += x[i] * x[i];
            ss = wave_sum(ss);
            const float rs = rsqrtf(ss * (1.0f / 512.0f) + NORM_EPS);
#pragma unroll
            for (int i = 0; i < 8; ++i) x[i] = x[i] * rs * gg[i];
            u32x4 o; o.x = cvt_pk_bf16(x[0], x[1]); o.y = cvt_pk_bf16(x[2], x[3]); o.z = cvt_pk_bf16(x[4], x[5]); o.w = cvt_pk_bf16(x[6], x[7]);
            *(u32x4*)sp = o;
        }
        if (lat) { bf16_t* kp = pr + C_MKR; const int i = lane & 31; const float x1 = bf2f(kp[i]), x2 = bf2f(kp[i + 32]);
            const int p = i < 16 ? ri : ci, f = i & 15; const float c2 = tm[p * 16 + f], s2 = tm[128 * 16 + p * 16 + f];
            if (lane < 32) { kp[i] = f2bf(x1 * c2 - x2 * s2); kp[i + 32] = f2bf(x2 * c2 + x1 * s2); } }
    }
}

namespace att {
constexpr int NW = 8, QBLK = 32, KVBLK = 64, DV = 128;
constexpr float THR = 8.f;
#define SBAR() __builtin_amdgcn_sched_barrier(0)
__device__ __forceinline__ int crow(int r, int hi) { return (r & 3) + 8 * (r >> 2) + 4 * hi; }
template <int DQ> struct Cf {
    static constexpr int ND0 = DQ / 16, KROWB = DQ * 2, SHM_K = KVBLK * DQ * 2, SHM_V = KVBLK * DV * 2, SHM = 2 * SHM_V + 2 * SHM_K + NW * 64 * 4;
    static constexpr float SCALE = DQ == 128 ? 0.088388347648318440f : 0.072168783648703220f;
    __device__ static __forceinline__ int kswz(int row, int colB) { return row * KROWB + (colB ^ ((row & 7) << 4)); }
};
template <int DQ, int VAR = 0> __device__ __forceinline__ void partialSM(f32x16& p0, f32x16& p1, float& m_reg, float& mn, float& alpha) {
    constexpr float SC = Cf<DQ>::SCALE, Cc = SC * 1.4426950408889634f;
    float pmax = p0[0];
#pragma unroll
    for (int r = 1; r < 16; ++r) pmax = fmaxf(pmax, p0[r]);
#pragma unroll
    for (int r = 0; r < 16; ++r) pmax = fmaxf(pmax, p1[r]);
    { auto rr = __builtin_amdgcn_permlane32_swap(__float_as_uint(pmax), __float_as_uint(pmax), false, false);
      pmax = fmaxf(__uint_as_float(rr[0]), __uint_as_float(rr[1])); }
    if (__builtin_expect(__all(pmax - m_reg <= THR / SC), 1)) { mn = m_reg; alpha = 1.f; }
    else { mn = fmaxf(m_reg, pmax); alpha = __builtin_amdgcn_exp2f((m_reg - mn) * Cc); m_reg = mn; }
    const float mnC = -mn * Cc;
#pragma unroll
    for (int r = 0; r < 16; ++r) p0[r] = fmaf(p0[r], Cc, mnC);
#pragma unroll
    for (int r = 0; r < 16; ++r) p1[r] = fmaf(p1[r], Cc, mnC);
#pragma unroll
    for (int r = 0; r < 16; ++r) p0[r] = VAR == 1 ? p0[r] * 0.001f : __builtin_amdgcn_exp2f(p0[r]);
}
template <int VAR = 0> __device__ __forceinline__ void finishSM(f32x16& p0, f32x16& p1, float alpha, float& l_reg, bf16x8& pa0, bf16x8& pa1, bf16x8& pa2, bf16x8& pa3) {
#pragma unroll
    for (int r = 0; r < 16; ++r) p1[r] = VAR == 1 ? p1[r] * 0.001f : __builtin_amdgcn_exp2f(p1[r]);
    float ps = 0;
#pragma unroll
    for (int r = 0; r < 16; ++r) ps += p0[r];
#pragma unroll
    for (int r = 0; r < 16; ++r) ps += p1[r];
    { auto rr = __builtin_amdgcn_permlane32_swap(__float_as_uint(ps), __float_as_uint(ps), false, false);
      ps = __uint_as_float(rr[0]) + __uint_as_float(rr[1]); }
    l_reg = l_reg * alpha + ps;
#define PK4(P, BASE, OUT) do { unsigned a0 = cvt_pk_bf16(P[BASE + 0], P[BASE + 1]), a1 = cvt_pk_bf16(P[BASE + 2], P[BASE + 3]);   \
    unsigned b0 = cvt_pk_bf16(P[BASE + 4], P[BASE + 5]), b1 = cvt_pk_bf16(P[BASE + 6], P[BASE + 7]);                              \
    auto r0 = __builtin_amdgcn_permlane32_swap(a0, b0, false, false); auto r1 = __builtin_amdgcn_permlane32_swap(a1, b1, false, false); \
    u32x4 w = {r0[0], r1[0], r0[1], r1[1]}; OUT = *reinterpret_cast<bf16x8*>(&w); } while (0)
    PK4(p0, 0, pa0); PK4(p0, 8, pa1); PK4(p1, 0, pa2); PK4(p1, 8, pa3);
#undef PK4
}
template <int DQ> __device__ __forceinline__ void qkt(f32x16& p0, f32x16& p1, const char* Ks, const bf16x8* qr, const char* qx, int r32, int hi) {
    p0 = f32x16{}; p1 = f32x16{};
#pragma unroll
    for (int d0 = 0; d0 < Cf<DQ>::ND0; ++d0) { const int cb = (d0 * 16 + hi * 8) * 2;
        const bf16x8 b0 = *reinterpret_cast<const bf16x8*>(Ks + Cf<DQ>::kswz(r32, cb));
        const bf16x8 b1 = *reinterpret_cast<const bf16x8*>(Ks + Cf<DQ>::kswz(32 + r32, cb));
        constexpr int NQR = DQ == 192 ? MLA_NQR : 8;
        bf16x8 q; if (d0 < NQR) q = qr[d0]; else q = *reinterpret_cast<const bf16x8*>(qx + (d0 - NQR) * 1024);
        p0 = __builtin_amdgcn_mfma_f32_32x32x16_bf16(b0, q, p0, 0, 0, 0);
        p1 = __builtin_amdgcn_mfma_f32_32x32x16_bf16(b1, q, p1, 0, 0, 0); }
}
__device__ __forceinline__ int v_st(int k, int c) { const int kk = (k & ~0xC) | ((k & 4) << 1) | ((k & 8) >> 1); return ((kk >> 3) * 4 + (c >> 5)) * 512 + ((kk & 7) * 32 + (c & 31)) * 2; }
__device__ __forceinline__ int v_rd_base(int lane) { return ((lane & 3) << 3) | (((lane >> 2) & 3) << 6) | (((lane >> 4) & 1) << 5) | (((lane >> 5) & 1) << 8); }
constexpr int v_rd_off(int d0, int ks, int half) { return d0 * 512 + ks * 4096 + half * 2048; }
template <int OFF> __device__ __forceinline__ s16x4 tr_read(int vb) {
    s16x4 r; asm volatile("ds_read_b64_tr_b16 %0, %1 offset:%2" : "=&v"(r) : "v"(vb), "i"(OFF) : "memory"); return r;
}
template <int D0> __device__ __forceinline__ void pv_one(f32x16& od, int vb, bf16x8 pa0, bf16x8 pa1, bf16x8 pa2, bf16x8 pa3) {
    const s16x4 l0 = tr_read<v_rd_off(D0, 0, 0)>(vb), h0 = tr_read<v_rd_off(D0, 0, 1)>(vb), l1 = tr_read<v_rd_off(D0, 1, 0)>(vb), h1 = tr_read<v_rd_off(D0, 1, 1)>(vb);
    const s16x4 l2 = tr_read<v_rd_off(D0, 2, 0)>(vb), h2 = tr_read<v_rd_off(D0, 2, 1)>(vb), l3 = tr_read<v_rd_off(D0, 3, 0)>(vb), h3 = tr_read<v_rd_off(D0, 3, 1)>(vb);
    asm volatile("s_waitcnt lgkmcnt(0)" ::: "memory"); SBAR();
#define PK(L, H) (bf16x8){L[0], L[1], L[2], L[3], H[0], H[1], H[2], H[3]}
    od = __builtin_amdgcn_mfma_f32_32x32x16_bf16(pa0, PK(l0, h0), od, 0, 0, 0);
    od = __builtin_amdgcn_mfma_f32_32x32x16_bf16(pa1, PK(l1, h1), od, 0, 0, 0);
    od = __builtin_amdgcn_mfma_f32_32x32x16_bf16(pa2, PK(l2, h2), od, 0, 0, 0);
    od = __builtin_amdgcn_mfma_f32_32x32x16_bf16(pa3, PK(l3, h3), od, 0, 0, 0);
#undef PK
}
__device__ __forceinline__ void pv_d0(f32x16* o, int vb, bf16x8 pa0, bf16x8 pa1, bf16x8 pa2, bf16x8 pa3) {
    pv_one<0>(o[0], vb, pa0, pa1, pa2, pa3); pv_one<1>(o[1], vb, pa0, pa1, pa2, pa3); pv_one<2>(o[2], vb, pa0, pa1, pa2, pa3); pv_one<3>(o[3], vb, pa0, pa1, pa2, pa3);
}
__device__ __forceinline__ bf16x8 ld8(const bf16_t* p) { return *reinterpret_cast<const bf16x8*>(p); }

template <int DQ, int SD, int VAR = 0>
__device__ __forceinline__ void attn_body(const bf16_t* __restrict__ Qb, int ldq, const bf16_t* __restrict__ Kn, int ldkn, const bf16_t* __restrict__ Kr, int ldkr,
                                          const bf16_t* __restrict__ Vh, int ldv, bf16_t* __restrict__ Ob, int ldo, int seq, bool rope_q, int pos0, const float* __restrict__ tabM, char* lds, const int tid) {
    using CF = Cf<DQ>; constexpr int ND0 = CF::ND0, SHM_V = CF::SHM_V, SHM_K = CF::SHM_K;
    const int wid = tid >> 6, lane = tid & 63, r32 = lane & 31, hi = lane >> 5;
    char* V_lds = lds; char* K_lds = lds + 2 * SHM_V;
    float* ws = (float*)(lds + 2 * SHM_V + 2 * SHM_K) + wid * 64; float* li_l = ws; float* al_l = ws + 32;
    constexpr int NQR = DQ == 192 ? MLA_NQR : 8;
    float m_reg = -1e30f, l_reg = 0; f32x16 o[4] = {}; bf16x8 qr[NQR];
    const bf16_t* Qw = Qb + (long)(wid * QBLK + r32) * ldq + hi * 8;
#pragma unroll
    for (int d0 = 0; d0 < NQR; ++d0) qr[d0] = ld8(Qw + d0 * 16);
    char* qx = lds + CF::SHM + wid * 8192 + lane * 16;
    if constexpr (DQ == 192) {
#pragma unroll
        for (int d0 = NQR; d0 < 8; ++d0) *(bf16x8*)(qx + (d0 - NQR) * 1024) = ld8(Qw + d0 * 16);
        bf16x8 qe[4];
#pragma unroll
        for (int d0 = 0; d0 < 4; ++d0) qe[d0] = ld8(Qw + (8 + d0) * 16);
        if (rope_q) {
            const int pos = pos0 + wid * QBLK + r32, ri = pos >> 6, ci = pos & 63;
#pragma unroll
            for (int t = 0; t < 2; ++t) { const int p = t == 0 ? ri : ci; const float* tc = tabM + p * 16 + hi * 8; const float* tsn = tabM + 128 * 16 + p * 16 + hi * 8;
                bf16x8 a = qe[t], b = qe[2 + t];
#pragma unroll
                for (int jj = 0; jj < 8; ++jj) { const float x1 = bf2f((bf16_t)a[jj]), x2 = bf2f((bf16_t)b[jj]), c = tc[jj], s = tsn[jj];
                    a[jj] = (short)f2bf(x1 * c - x2 * s); b[jj] = (short)f2bf(x2 * c + x1 * s); }
                qe[t] = a; qe[2 + t] = b; }
        }
#pragma unroll
        for (int d0 = 0; d0 < 4; ++d0) *(bf16x8*)(qx + (8 - NQR + d0) * 1024) = qe[d0];
    }
    const int sr = tid >> 4, sc = (tid & 15) * 8, vst0 = v_st(sr, sc), vst1 = v_st(32 + sr, sc);
    const int sr2 = tid >> 3, sc2 = (tid & 7) * 8;
    const int vb0 = (int)(uintptr_t)V_lds + v_rd_base(lane);
    struct { bf16x8 vs0, vs1, ks0, ks1, ks2; } sr_[SD];
    const unsigned offV = (unsigned)(sr * ldv + sc) * 2u, offK = (unsigned)(sr * ldkn + sc) * 2u, offR = (unsigned)(sr2 * ldkr + sc2) * 2u;
#define SLOAD(i, k0) do { const char* vt_ = (const char*)Vh + (size_t)(k0) * ldv * 2; const char* kt_ = (const char*)Kn + (size_t)(k0) * ldkn * 2; \
    sr_[i].vs0 = *(const bf16x8*)(vt_ + offV); sr_[i].vs1 = *(const bf16x8*)(vt_ + (size_t)32 * ldv * 2 + offV); \
    sr_[i].ks0 = *(const bf16x8*)(kt_ + offK); sr_[i].ks1 = *(const bf16x8*)(kt_ + (size_t)32 * ldkn * 2 + offK); \
    if constexpr (DQ == 192) sr_[i].ks2 = *(const bf16x8*)((const char*)Kr + (size_t)(k0) * ldkr * 2 + offR); } while (0)
#define SWRITE(b, i) do { *(bf16x8*)(V_lds + (b) * SHM_V + vst0) = sr_[i].vs0; *(bf16x8*)(V_lds + (b) * SHM_V + vst1) = sr_[i].vs1; const int kc = sc * 2; \
    *(bf16x8*)(K_lds + (b) * SHM_K + CF::kswz(sr, kc)) = sr_[i].ks0; *(bf16x8*)(K_lds + (b) * SHM_K + CF::kswz(32 + sr, kc)) = sr_[i].ks1; \
    if constexpr (DQ == 192) *(bf16x8*)(K_lds + (b) * SHM_K + CF::kswz(sr2, 256 + sc2 * 2)) = sr_[i].ks2; } while (0)
#define SWAIT() do { if constexpr (SD == 1) asm volatile("s_waitcnt vmcnt(0)" ::: "memory"); else if constexpr (DQ == 192) asm volatile("s_waitcnt vmcnt(5)" ::: "memory"); else asm volatile("s_waitcnt vmcnt(4)" ::: "memory"); } while (0)
#define RESC(a) do { if (__any((a) < 1.f)) { if (hi == 0) al_l[r32] = (a); asm volatile("s_waitcnt lgkmcnt(0)" ::: "memory"); \
    _Pragma("unroll") for (int d = 0; d < 4; ++d) _Pragma("unroll") for (int r = 0; r < 16; ++r) o[d][r] *= al_l[crow(r, hi)]; } } while (0)
    f32x16 pA0, pA1, pB0, pB1; float mnA, mnB, alA, alB; bf16x8 pa0, pa1, pa2, pa3; const int NT = seq / KVBLK;
    constexpr int SE = 0, SO = SD - 1;
    SLOAD(SE, 0); asm volatile("s_waitcnt vmcnt(0)" ::: "memory"); SWRITE(0, SE); __syncthreads();
    qkt<DQ>(pA0, pA1, K_lds, qr, qx, r32, hi); partialSM<DQ, VAR>(pA0, pA1, m_reg, mnA, alA);
    SLOAD(SO, KVBLK); if constexpr (SD == 2) { if (2 < NT) SLOAD(SE, 2 * KVBLK); }
    SWAIT(); SWRITE(1, SO); __syncthreads();
#define ATT_SYNC() do { if constexpr (VAR != 2) __syncthreads(); } while (0)
    for (int j = 1; j + 1 < NT; j += 2) {
        SBAR(); qkt<DQ>(pB0, pB1, K_lds + SHM_K, qr, qx, r32, hi);
        finishSM<VAR>(pA0, pA1, alA, l_reg, pa0, pa1, pa2, pa3); SBAR();
        if constexpr (VAR != 3) SLOAD(SO, (j + SD) * KVBLK); SBAR();
        pv_d0(o, vb0, pa0, pa1, pa2, pa3); partialSM<DQ, VAR>(pB0, pB1, m_reg, mnB, alB);
        ATT_SYNC(); SWAIT(); SWRITE(0, SE);
        RESC(alB); ATT_SYNC();
        SBAR(); qkt<DQ>(pA0, pA1, K_lds, qr, qx, r32, hi);
        finishSM<VAR>(pB0, pB1, alB, l_reg, pa0, pa1, pa2, pa3); SBAR();
        if constexpr (VAR != 3) { if (SD == 1 || j + 3 < NT) SLOAD(SE, (j + 1 + SD) * KVBLK); } SBAR();
        pv_d0(o, vb0 + SHM_V, pa0, pa1, pa2, pa3); partialSM<DQ, VAR>(pA0, pA1, m_reg, mnA, alA);
        ATT_SYNC(); SWAIT(); SWRITE(1, SO);
        RESC(alA); ATT_SYNC();
    }
    SBAR(); qkt<DQ>(pB0, pB1, K_lds + SHM_K, qr, qx, r32, hi);
    finishSM<VAR>(pA0, pA1, alA, l_reg, pa0, pa1, pa2, pa3); SBAR();
    pv_d0(o, vb0, pa0, pa1, pa2, pa3); partialSM<DQ, VAR>(pB0, pB1, m_reg, mnB, alB);
    ATT_SYNC(); RESC(alB);
    finishSM<VAR>(pB0, pB1, alB, l_reg, pa0, pa1, pa2, pa3); SBAR();
    pv_d0(o, vb0 + SHM_V, pa0, pa1, pa2, pa3);
    if (hi == 0) li_l[r32] = l_reg; asm volatile("s_waitcnt lgkmcnt(0)" ::: "memory");
    float rli[16];
#pragma unroll
    for (int r = 0; r < 16; ++r) rli[r] = __builtin_amdgcn_rcpf(li_l[crow(r, hi)]);
    bf16_t* Ow = Ob + (long)(wid * QBLK) * ldo;
#pragma unroll
    for (int r = 0; r < 16; ++r) { const int orow = crow(r, hi);
#pragma unroll
        for (int d0 = 0; d0 < 4; ++d0) Ow[(long)orow * ldo + d0 * 32 + r32] = f2bf(o[d0][r] * rli[r]); }
#undef SLOAD
#undef ATT_SYNC
#undef SWRITE
#undef SWAIT
#undef RESC
}
}

template <int KS> __device__ __forceinline__ void mma_xy(f32x16& acc, const LAS bf16_t* X, const LAS bf16_t* Y, int hi) {
#pragma unroll
    for (int ks = 0; ks < KS; ++ks) { const bf16x8 a = *(const LAS bf16x8*)(X + ks * 16 + hi * 8), b = *(const LAS bf16x8*)(Y + ks * 16 + hi * 8);
        acc = __builtin_amdgcn_mfma_f32_32x32x16_bf16(a, b, acc, 0, 0, 0); }
}
__device__ __forceinline__ float logsig16(float x) { const float e = __expf(-fabsf(x)); return (fminf(x, 0.f) - __logf(1.f + e)) * 0.0625f; }
__device__ __forceinline__ int gla_sidx(int b, int dir, int h) { return (b * 2 + dir) * 4 + h; }

__device__ __forceinline__ void gla_cumsum_lds(const Ctx& C, int l, int h, int dir, const LAS float* lr, LAS float* segtot, LAS float* CUM) {
    const int seg = C.tid >> 7, d = C.tid & 127;
    const float* wa = INP(dir ? I_WA2B : I_WA2F) + (size_t)l * 16 * 512 + h * 128 + d;
    const float bias = INP(dir ? I_BAB : I_BAF)[l * 512 + h * 128 + d];
    float w[16], cum[16];
#pragma unroll
    for (int j = 0; j < 16; ++j) w[j] = wa[j * 512];
    float run = 0.f;
#pragma unroll
    for (int i = 0; i < 16; ++i) { const int s = seg * 16 + i, tk = dir ? 63 - s : s; float pre = bias;
#pragma unroll
        for (int j = 0; j < 16; ++j) pre += lr[tk * 32 + dir * 16 + j] * w[j];
        run += logsig16(pre); cum[i] = run; }
    segtot[seg * 128 + d] = run;
    __syncthreads();
    float off = 0.f;
#pragma unroll
    for (int q = 0; q < 3; ++q) if (q < seg) off += segtot[q * 128 + d];
#pragma unroll
    for (int i = 0; i < 16; ++i) { const int s = seg * 16 + i, tk = dir ? 63 - s : s; CUM[tk * 132 + d] = cum[i] + off; }
    __syncthreads();
}
__device__ __forceinline__ void unpack8(const u32x4 w, float (&x)[8]) { x[0] = bflo(w.x); x[1] = bfhi(w.x); x[2] = bflo(w.y); x[3] = bfhi(w.y); x[4] = bflo(w.z); x[5] = bfhi(w.z); x[6] = bflo(w.w); x[7] = bfhi(w.w); }
__device__ __forceinline__ void gla_build_vt(const Ctx& C, const bf16_t* P, size_t r0, int h, LAS bf16_t* VT) {
    u32x4 v[4];
#pragma unroll
    for (int it = 0; it < 4; ++it) { const int idx = C.tid + it * NTHREADS, sv = idx >> 5, e0 = (idx & 31) * 8; v[it] = *(const u32x4*)(P + (r0 + sv) * NP + C_LV + h * 256 + e0); }
#pragma unroll
    for (int it = 0; it < 4; ++it) { const int idx = C.tid + it * NTHREADS, sv = idx >> 5, e0 = (idx & 31) * 8;
        const unsigned wd[4] = {v[it].x, v[it].y, v[it].z, v[it].w};
#pragma unroll
        for (int q = 0; q < 4; ++q) { VT[(e0 + 2 * q) * 72 + sv] = (bf16_t)(wd[q] & 0xffffu); VT[(e0 + 2 * q + 1) * 72 + sv] = (bf16_t)(wd[q] >> 16); } }
}

__device__ __forceinline__ void phase_gla_local(const Ctx& C, int l, int rot) {
    const bf16_t* P = WSP(bf16_t, WS_P); bf16_t* GST = WSP(bf16_t, WS_GST); float* GDEC = WSP(float, WS_GDEC);
    LAS float* lr = (LAS float*)C.lds;
    LAS float* segtot = (LAS float*)(C.lds + 8192);
    LAS bf16_t* KT = (LAS bf16_t*)(C.lds + 10240);
    LAS bf16_t* VT = (LAS bf16_t*)(C.lds + 28672);
    LAS float* CUM = (LAS float*)(C.lds + 65536);
    const int r32 = C.lane & 31, hi = C.lane >> 5, d = C.tid & 127;
    const int btk = C.tid >> 3, bdg = (C.tid & 7) * 16;
    for (int unit = (C.bid + C.G - rot % C.G) % C.G; unit < NBATCH * 4 * NCH; unit += C.G) {
        const int b = unit / (4 * NCH), h = (unit / NCH) % 4, ck = unit % NCH; const size_t r0 = (size_t)b * RPB + ck * 64;
        for (int i = C.tid; i < 64 * 32; i += NTHREADS) lr[i] = bf2f(P[(r0 + (i >> 5)) * NP + C_LRF + (i & 31)]);
        const u32x4 kw0 = *(const u32x4*)(P + (r0 + btk) * NP + C_LK + h * 128 + bdg), kw1 = *(const u32x4*)(P + (r0 + btk) * NP + C_LK + h * 128 + bdg + 8);
        gla_build_vt(C, P, r0, h, VT);
        __syncthreads();
#pragma unroll 1
        for (int dir = 0; dir < 2; ++dir) {
            gla_cumsum_lds(C, l, h, dir, lr, segtot, CUM);
            const int tend = dir ? 0 : 63;
            const size_t sx = (size_t)gla_sidx(b, dir, h) * NCH + ck;
            if (C.tid < 128) GDEC[sx * 128 + d] = __expf(CUM[tend * 132 + d]);
            { float kf[16]; { float t8[8]; unpack8(kw0, t8);
#pragma unroll
                for (int i = 0; i < 8; ++i) kf[i] = t8[i]; unpack8(kw1, t8);
#pragma unroll
                for (int i = 0; i < 8; ++i) kf[8 + i] = t8[i]; }
#pragma unroll
              for (int q = 0; q < 4; ++q) { const f32x4 cm = *(const LAS f32x4*)(CUM + btk * 132 + bdg + 4 * q), be = *(const LAS f32x4*)(CUM + tend * 132 + bdg + 4 * q);
#pragma unroll
                  for (int i = 0; i < 4; ++i) KT[(bdg + 4 * q + i) * 72 + btk] = f2bf(kf[4 * q + i] * __expf(be[i] - cm[i])); } }
            __syncthreads();
            { const int dt = C.wid & 3, eb = (C.wid >> 2) * 4;
              f32x16 acc[4] = {};
#pragma unroll
              for (int q = 0; q < 4; ++q) mma_xy<4>(acc[q], KT + (dt * 32 + r32) * 72, VT + ((eb + q) * 32 + r32) * 72, hi);
              bf16_t* st = GST + sx * 32768;
#pragma unroll
              for (int q = 0; q < 4; ++q)
#pragma unroll
                  for (int g = 0; g < 4; ++g) { u32x2 w; w.x = cvt_pk_bf16(acc[q][4 * g], acc[q][4 * g + 1]); w.y = cvt_pk_bf16(acc[q][4 * g + 2], acc[q][4 * g + 3]);
                      *(u32x2*)(st + (size_t)((eb + q) * 32 + r32) * 128 + dt * 32 + 8 * g + 4 * hi) = w; } }
            __syncthreads();
        }
    }
}

__device__ __forceinline__ void phase_gla_scan(const Ctx& C) {
    bf16_t* GST = WSP(bf16_t, WS_GST); const float* GDEC = WSP(float, WS_GDEC);
    for (int gid = C.bid * NTHREADS + C.tid; gid < 16 * 8192; gid += C.G * NTHREADS) {
        const int sidx = gid >> 13, g = gid & 8191, dir = (sidx >> 2) & 1, d4 = (g & 31) * 4;
        bf16_t* base = GST + (size_t)sidx * NCH * 32768 + (size_t)g * 4;
        const float* dbase = GDEC + (size_t)sidx * NCH * 128 + d4;
        float S[4] = {0.f, 0.f, 0.f, 0.f};
        for (int st = 0; st < NCH; st += 4) {
            int ck[4]; u32x2 L[4]; f32x4 dc[4];
#pragma unroll
            for (int q = 0; q < 4; ++q) { const int s = st + q; ck[q] = dir ? (s < 4 ? 3 - s : NCH + 3 - s) : s;
                L[q] = *(const u32x2*)(base + (size_t)ck[q] * 32768); dc[q] = *(const f32x4*)(dbase + (size_t)ck[q] * 128); }
#pragma unroll
            for (int q = 0; q < 4; ++q) { u32x2 w; w.x = cvt_pk_bf16(S[0], S[1]); w.y = cvt_pk_bf16(S[2], S[3]);
                *(u32x2*)(base + (size_t)ck[q] * 32768) = w;
                S[0] = dc[q][0] * S[0] + bflo(L[q].x); S[1] = dc[q][1] * S[1] + bfhi(L[q].x); S[2] = dc[q][2] * S[2] + bflo(L[q].y); S[3] = dc[q][3] * S[3] + bfhi(L[q].y); }
        }
    }
}

__device__ __forceinline__ void phase_gla_out(const Ctx& C, int l, int rot) {
    const bf16_t* P = WSP(bf16_t, WS_P); const bf16_t* GST = WSP(bf16_t, WS_GST); bf16_t* OL = WSP(bf16_t, WS_OL);
    LAS float* lr = (LAS float*)C.lds;
    LAS float* segtot = (LAS float*)(C.lds + 8192);
    LAS bf16_t* QT = (LAS bf16_t*)(C.lds + 10240);
    LAS bf16_t* KT = (LAS bf16_t*)(C.lds + 27648);
    LAS bf16_t* VT = (LAS bf16_t*)(C.lds + 45056);
    LAS bf16_t* SCm = (LAS bf16_t*)(C.lds + 81920);
    LAS float* OB = (LAS float*)(C.lds + 91136);
    LAS float* CUM = OB;
    const float* gon = INP(I_ONG) + l * 256;
    const int r32 = C.lane & 31, hi = C.lane >> 5;
    const int btk = C.tid >> 3, bdg = (C.tid & 7) * 16;
    for (int unit = (C.bid + C.G - rot % C.G) % C.G; unit < NBATCH * 4 * NCH; unit += C.G) {
        const int b = unit / (4 * NCH), h = (unit / NCH) % 4, ck = unit % NCH; const size_t r0 = (size_t)b * RPB + ck * 64;
        for (int i = C.tid; i < 64 * 32; i += NTHREADS) lr[i] = bf2f(P[(r0 + (i >> 5)) * NP + C_LRF + (i & 31)]);
        const bf16_t* qp = P + (r0 + btk) * NP + C_LQ + h * 128 + bdg; const bf16_t* kp = P + (r0 + btk) * NP + C_LK + h * 128 + bdg;
        const u32x4 qw0 = *(const u32x4*)qp, qw1 = *(const u32x4*)(qp + 8), kw0 = *(const u32x4*)kp, kw1 = *(const u32x4*)(kp + 8);
        gla_build_vt(C, P, r0, h, VT);
        __syncthreads();
        f32x16 oacc[2] = {};
#pragma unroll 1
        for (int dir = 0; dir < 2; ++dir) {
            gla_cumsum_lds(C, l, h, dir, lr, segtot, CUM);
            { float qf[8], kf[8];
#pragma unroll
              for (int hh = 0; hh < 2; ++hh) { unpack8(hh ? qw1 : qw0, qf); unpack8(hh ? kw1 : kw0, kf);
                  const f32x4 c0 = *(const LAS f32x4*)(CUM + btk * 132 + bdg + 8 * hh), c1 = *(const LAS f32x4*)(CUM + btk * 132 + bdg + 8 * hh + 4);
                  float qo[8], ko[8];
#pragma unroll
                  for (int i = 0; i < 8; ++i) { const float cm = i < 4 ? c0[i & 3] : c1[i & 3]; qo[i] = qf[i] * __expf(cm) * 0.088388347648318440f; ko[i] = kf[i] * __expf(-cm); }
                  u32x4 wq, wk; wq.x = cvt_pk_bf16(qo[0], qo[1]); wq.y = cvt_pk_bf16(qo[2], qo[3]); wq.z = cvt_pk_bf16(qo[4], qo[5]); wq.w = cvt_pk_bf16(qo[6], qo[7]);
                  wk.x = cvt_pk_bf16(ko[0], ko[1]); wk.y = cvt_pk_bf16(ko[2], ko[3]); wk.z = cvt_pk_bf16(ko[4], ko[5]); wk.w = cvt_pk_bf16(ko[6], ko[7]);
                  *(LAS u32x4*)(QT + btk * 136 + bdg + 8 * hh) = wq; *(LAS u32x4*)(KT + btk * 136 + bdg + 8 * hh) = wk; } }
            __syncthreads();
            if (C.wid < 4) { const int mt = C.wid >> 1, nt = C.wid & 1; f32x16 sc = {};
                mma_xy<8>(sc, QT + (mt * 32 + r32) * 136, KT + (nt * 32 + r32) * 136, hi);
#pragma unroll
                for (int i = 0; i < 16; ++i) { const int t = mt * 32 + att::crow(i, hi), sx_ = nt * 32 + r32; const bool keep = dir ? (sx_ >= t) : (sx_ <= t);
                    SCm[t * 72 + sx_] = f2bf(keep ? sc[i] : 0.f); } }
            __syncthreads();
            { const bf16_t* st = GST + ((size_t)gla_sidx(b, dir, h) * NCH + ck) * 32768 + (size_t)(C.wid * 32 + r32) * 128 + hi * 8;
              bf16x8 sb[8];
#pragma unroll
              for (int ks = 0; ks < 8; ++ks) sb[ks] = *(const bf16x8*)(st + ks * 16);
#pragma unroll
              for (int mt = 0; mt < 2; ++mt) {
                  mma_xy<4>(oacc[mt], SCm + (mt * 32 + r32) * 72, VT + (C.wid * 32 + r32) * 72, hi);
#pragma unroll
                  for (int ks = 0; ks < 8; ++ks) { const bf16x8 a = *(const LAS bf16x8*)(QT + (mt * 32 + r32) * 136 + ks * 16 + hi * 8);
                      oacc[mt] = __builtin_amdgcn_mfma_f32_32x32x16_bf16(a, sb[ks], oacc[mt], 0, 0, 0); } } }
            __syncthreads();
        }
#pragma unroll
        for (int mt = 0; mt < 2; ++mt)
#pragma unroll
            for (int i = 0; i < 16; ++i) OB[(mt * 32 + att::crow(i, hi)) * 260 + C.wid * 32 + r32] = oacc[mt][i];
        __syncthreads();
        { const int t = C.tid >> 3, part = C.tid & 7; f32x4 v[8]; float ss = 0.f;
#pragma unroll
          for (int jj = 0; jj < 8; ++jj) { v[jj] = *(const LAS f32x4*)(OB + t * 260 + jj * 32 + part * 4); ss += v[jj][0] * v[jj][0] + v[jj][1] * v[jj][1] + v[jj][2] * v[jj][2] + v[jj][3] * v[jj][3]; }
          ss += dppmov<DPP_HMIRROR>(ss); ss += dppmov<DPP_Q3210>(ss); ss += dppmov<DPP_Q1032>(ss);
          const float rs = rsqrtf(ss * (1.0f / 256.0f) + NORM_EPS);
#pragma unroll
          for (int jj = 0; jj < 8; ++jj) { const int e = jj * 32 + part * 4; const f32x4 g = *(const f32x4*)(gon + e);
              const u32x2 gt = *(const u32x2*)(P + (r0 + t) * NP + C_LG + h * 256 + e);
              const float o0 = v[jj][0] * rs * g[0] * siluf_(bflo(gt.x)), o1 = v[jj][1] * rs * g[1] * siluf_(bfhi(gt.x)), o2 = v[jj][2] * rs * g[2] * siluf_(bflo(gt.y)), o3 = v[jj][3] * rs * g[3] * siluf_(bfhi(gt.y));
              u32x2 w; w.x = cvt_pk_bf16(o0, o1); w.y = cvt_pk_bf16(o2, o3);
              *(u32x2*)(OL + (r0 + t) * 1024 + h * 256 + e) = w; } }
        __syncthreads();
    }
}

__device__ __forceinline__ unsigned f_ord(float f) { const unsigned u = __float_as_uint(f); return u ^ ((unsigned)((int)u >> 31) | 0x80000000u); }
__device__ __forceinline__ float f_unord(unsigned k) { return __uint_as_float((k & 0x80000000u) ? (k ^ 0x80000000u) : ~k); }
__device__ __forceinline__ void ins_u(unsigned (&L)[16], unsigned x) {
#pragma unroll
    for (int j = 0; j < 16; ++j) { const unsigned h = L[j] > x ? L[j] : x; x = L[j] > x ? x : L[j]; L[j] = h; }
}
__device__ __forceinline__ void ins_f(float (&M)[16], float x) {
#pragma unroll
    for (int j = 0; j < 16; ++j) { const float h = M[j] > x ? M[j] : x; x = M[j] > x ? x : M[j]; M[j] = h; }
}
__device__ __forceinline__ void peer_top16(const bf16_t* __restrict__ qrow, const bf16_t* __restrict__ keys, int r32, int hi, unsigned (&L)[16]) {
    bf16x8 qf[8];
#pragma unroll
    for (int kk = 0; kk < 8; ++kk) qf[kk] = *(const bf16x8*)(qrow + kk * 16 + hi * 8);
#pragma unroll
    for (int j = 0; j < 16; ++j) L[j] = 0u;
    bf16x8 kA[8], kB[8];
    const bf16_t* kl = keys + (size_t)r32 * 128 + hi * 8;
#define PT_LDK(dst, mt) do { _Pragma("unroll") for (int kk = 0; kk < 8; ++kk) dst[kk] = *(const bf16x8*)(kl + (mt) * 32 * 128 + kk * 16); } while (0)
#define PT_PROC(src, mt) do { f32x16 acc = {}; \
        _Pragma("unroll") for (int kk = 0; kk < 8; ++kk) acc = __builtin_amdgcn_mfma_f32_32x32x16_bf16(src[kk], qf[kk], acc, 0, 0, 0); \
        _Pragma("unroll") for (int i = 0; i < 16; ++i) { const unsigned kidx = (unsigned)((mt) * 32 + att::crow(i, hi)); ins_u(L, (f_ord(acc[i]) & ~127u) | (127u - kidx)); } } while (0)
    PT_LDK(kA, 0);
#pragma unroll 1
    for (int mp = 0; mp < 2; ++mp) { PT_LDK(kB, 2 * mp + 1); PT_PROC(kA, 2 * mp); if (mp == 0) PT_LDK(kA, 2); PT_PROC(kB, 2 * mp + 1); }
#undef PT_LDK
#undef PT_PROC
    unsigned Pn[16];
#pragma unroll
    for (int j = 0; j < 16; ++j) { auto r_ = __builtin_amdgcn_permlane32_swap(L[j], L[j], false, false); Pn[j] = hi ? r_[0] : r_[1]; }
#pragma unroll
    for (int j = 0; j < 16; ++j) ins_u(L, Pn[j]);
}
__device__ __forceinline__ void phase_peer_select(const Ctx& C, const bool latent_only) {
    const bf16_t* PQ = WSP(bf16_t, WS_PQ); const bf16_t* K1 = WSP(bf16_t, WS_K1); const bf16_t* K2 = WSP(bf16_t, WS_K2);
    int* PIDX = WSP(int, WS_PIDX); float* PG = WSP(float, WS_PG);
    const int r32 = C.lane & 31, hi = C.lane >> 5, head = C.wid;
    const int ngrp = latent_only ? NBATCH * SEQ / 32 : TT / 32;
    for (int gi = C.bid; gi < ngrp; gi += C.G) {
        const int grp = latent_only ? gi + (CTXL / 32) * (1 + gi / (SEQ / 32)) : gi;
        const size_t tok = (size_t)grp * 32 + r32;
        unsigned L1[16], L2[16];
        peer_top16(PQ + tok * DM + head * 256, K1 + (size_t)head * 128 * 128, r32, hi, L1);
        peer_top16(PQ + tok * DM + head * 256 + 128, K2 + (size_t)head * 128 * 128, r32, hi, L2);
        float v1[16], v2[16];
#pragma unroll
        for (int j = 0; j < 16; ++j) { v1[j] = f_unord(L1[j] & ~127u); v2[j] = f_unord(L2[j] & ~127u); }
        float M[16];
#pragma unroll
        for (int j = 0; j < 16; ++j) M[j] = -3.0e38f;
#pragma unroll
        for (int a = 0; a < 16; ++a)
#pragma unroll
            for (int b = 0; b < 16; ++b) if ((a + 1) * (b + 1) <= 16) ins_f(M, v1[a] + v2[b]);
        const float thr = M[15], mx = M[0]; float den = 0.f;
#pragma unroll
        for (int j = 0; j < 16; ++j) den += __expf(M[j] - mx);
        const float rden = 1.0f / den;
        int pos = 0; int* ip = PIDX + tok * 128 + head * 16; float* gp = PG + tok * 128 + head * 16;
#pragma unroll
        for (int a = 0; a < 16; ++a)
#pragma unroll
            for (int b = 0; b < 16; ++b) if ((a + 1) * (b + 1) <= 16) {
                const float val = v1[a] + v2[b];
                if (val >= thr && pos < 16) { if (hi == 0) { ip[pos] = (int)((127u - (L1[a] & 127u)) * 128u + (127u - (L2[b] & 127u))); gp[pos] = __expf(val - mx) * rden; } ++pos; } }
    }
}
template <int OFF> __device__ __forceinline__ float dotf8(const float (&h)[32], const u32x4 w, float acc) {
#pragma unroll
    for (int j = 0; j < 4; ++j) { const f32x2 lo = __builtin_amdgcn_cvt_pk_f32_fp8((int)w[j], false), hi = __builtin_amdgcn_cvt_pk_f32_fp8((int)w[j], true);
        acc += h[OFF + 4 * j] * lo.x; acc += h[OFF + 4 * j + 1] * lo.y; acc += h[OFF + 4 * j + 2] * hi.x; acc += h[OFF + 4 * j + 3] * hi.y; }
    return acc;
}
constexpr int GT_MAXTOK = 9;
template <bool LAST> __device__ __forceinline__ void phase_peer_gather(const Ctx& C, const float* modl, const float pscale) {
    const unsigned char* pt = C.ws + WS_PT + (size_t)(LAST ? DEPTH - 1 : 0) * PT_BYTES;
    const bf16_t* HB = WSP(bf16_t, WS_HB); const unsigned char* U8 = pt + PT_U8; const unsigned char* V8 = pt + PT_V8;
    const float* SCU = (const float*)(pt + PT_SCU); const float* SCV = (const float*)(pt + PT_SCV);
    const int* PIDX = WSP(int, WS_PIDX); const float* PG = WSP(float, WS_PG); float* XS = WSP(float, WS_XS);
    const int lane = C.lane, s = lane >> 3, j = lane & 7; const unsigned j16 = (unsigned)j * 16u;
    LAS int* IDS = (LAS int*)(C.lds + C.wid * (GT_MAXTOK * 512));
    LAS float* ACT = (LAS float*)(C.lds + 8 * GT_MAXTOK * 512 + C.wid * (GT_MAXTOK * 512));
    LAS int* ROWS = (LAS int*)(C.lds + 16 * GT_MAXTOK * 512 + C.wid * 64);
    int nk = 0;
    {
      const int per = (TT + C.G - 1) / C.G, base = C.bid * per;
#pragma unroll 1
      for (int k = 0; k < GT_MAXTOK; ++k) { const int o = C.wid + 8 * k; const int r = base + o; if (o < per && r < TT && !(LAST && (r % RPB) < CTXL)) { if (lane == 0) ROWS[nk] = r; ++nk; } } }
#define GT_ROW(k) __builtin_amdgcn_readfirstlane(ROWS[k])
#pragma unroll 1
    for (int k = 0; k < nk; ++k) { const int r = GT_ROW(k);
        IDS[k * 128 + lane] = (PIDX[(size_t)r * 128 + lane] & (NEXP - 1)) << 7; IDS[k * 128 + 64 + lane] = (PIDX[(size_t)r * 128 + 64 + lane] & (NEXP - 1)) << 7;
        ACT[k * 128 + lane] = 0.f; ACT[k * 128 + 64 + lane] = 0.f; }
    const int nit = 32 * nk;
#define GT_ITEM(it_) const int cb_ = (it_) / (2 * nk), rem_ = (it_) - cb_ * (2 * nk), k_ = rem_ >> 1, hf_ = rem_ & 1
#define GT_LOADU(UQ, HQ, it_) do { GT_ITEM(it_); const int r_ = GT_ROW(k_); \
        const bf16_t* hp_ = HB + (size_t)r_ * DM + cb_ * 128 + j * 16; HQ[0] = *(const u32x4*)hp_; HQ[1] = *(const u32x4*)(hp_ + 8); \
        const unsigned char* ub_ = U8 + (size_t)cb_ * ((size_t)NEXP * 128);     \
        _Pragma("unroll") for (int eg = 0; eg < 8; ++eg) { const unsigned off_ = ((unsigned)IDS[k_ * 128 + (hf_ * 8 + eg) * 8 + s] & idmask) + j16; UQ[eg] = *(const u32x4*)(ub_ + off_); } } while (0)
#define GT_COMPU(UQ, HQ, it_) do { GT_ITEM(it_); (void)cb_; f32x2 hf2[8]; \
        _Pragma("unroll") for (int hh = 0; hh < 2; ++hh) { const u32x4 w_ = HQ[hh]; \
            hf2[hh * 4 + 0] = (f32x2){bflo(w_.x), bfhi(w_.x)}; hf2[hh * 4 + 1] = (f32x2){bflo(w_.y), bfhi(w_.y)}; hf2[hh * 4 + 2] = (f32x2){bflo(w_.z), bfhi(w_.z)}; hf2[hh * 4 + 3] = (f32x2){bflo(w_.w), bfhi(w_.w)}; } \
        float d[8]; \
        _Pragma("unroll") for (int eg = 0; eg < 8; ++eg) { f32x2 d2 = (f32x2){0.f, 0.f}; \
            _Pragma("unroll") for (int q = 0; q < 4; ++q) { const f32x2 lo = __builtin_amdgcn_cvt_pk_f32_fp8((int)UQ[eg][q], false), hi = __builtin_amdgcn_cvt_pk_f32_fp8((int)UQ[eg][q], true); \
                d2 += hf2[2 * q] * lo; d2 += hf2[2 * q + 1] * hi; } \
            d[eg] = d2.x + d2.y; } \
          \
        float t4[4], t2[2], t1; \
        _Pragma("unroll") for (int i = 0; i < 4; ++i) { const float snd = (j & 4) ? d[i] : d[i + 4], kp = (j & 4) ? d[i + 4] : d[i]; t4[i] = kp + dppmov<DPP_HMIRROR>(snd); } \
        _Pragma("unroll") for (int i = 0; i < 2; ++i) { const float snd = (j & 2) ? t4[i] : t4[i + 2], kp = (j & 2) ? t4[i + 2] : t4[i]; t2[i] = kp + dppmov<DPP_Q3210>(snd); } \
        { const float snd = (j & 1) ? t2[0] : t2[1], kp = (j & 1) ? t2[1] : t2[0]; t1 = kp + dppmov<DPP_Q1032>(snd); } \
        ACT[k_ * 128 + (hf_ * 8 + j) * 8 + s] += t1; } while (0)
#ifdef DBG_GDUP
#pragma unroll 1
    for (int rep_ = 0; rep_ < 2; ++rep_) {
    const unsigned idmask = rep_ == 0 ? ((unsigned)DBG_GMASK << 7 | 127u) : 0xffffffffu;
    if (rep_ == 1) { for (int k = 0; k < nk; ++k) { ACT[k * 128 + lane] = 0.f; ACT[k * 128 + 64 + lane] = 0.f; } }
#else
    { const unsigned idmask = 0xffffffffu;
#endif
    if (nit > 0) {
        u32x4 uA[8], uB[8], hA[2], hB[2];
        GT_LOADU(uA, hA, 0);
#pragma unroll 1
        for (int it = 0; it < nit; it += 2) {
            GT_LOADU(uB, hB, it + 1);
            GT_COMPU(uA, hA, it);
            if (it + 2 < nit) GT_LOADU(uA, hA, it + 2);
            GT_COMPU(uB, hB, it + 1);
        }
    }
    }
#undef GT_LOADU
#undef GT_COMPU
#pragma unroll 1
    for (int k = 0; k < nk; ++k) { const int r = GT_ROW(k);
#pragma unroll
        for (int hh = 0; hh < 2; ++hh) { const int e = hh * 64 + lane; const int id = IDS[k * 128 + e] >> 7; const float a = ACT[k * 128 + e] * SCU[id];
            const float w = PG[(size_t)r * 128 + e] * 0.5f * a * (1.0f + erff(a * 0.70710678118654752f));
#if defined(DBG_CHECK) && (DBG_CHECK == 3 || DBG_CHECK == 4)
            if (((r - 300) & 63) == 0 && r >= 300 && r < 300 + 64 * 128) WSP(float, WS_OM)[(size_t)r * 128 + e] = w;
#endif
            ACT[k * 128 + e] = w * SCV[id]; } }
#define GT_LOADV(VQ, WV, it_) do { GT_ITEM(it_); const unsigned char* vb_ = V8 + (size_t)cb_ * ((size_t)NEXP * 128); \
        _Pragma("unroll") for (int eg = 0; eg < 8; ++eg) { const int e_ = k_ * 128 + (hf_ * 8 + eg) * 8 + s; const unsigned off_ = (unsigned)IDS[e_] + j16; VQ[eg] = *(const u32x4*)(vb_ + off_); WV[eg] = ACT[e_]; } } while (0)
#define GT_COMPV(VQ, WV) do { \
        _Pragma("unroll") for (int eg = 0; eg < 8; ++eg) { const f32x2 w2_ = (f32x2){WV[eg], WV[eg]}; \
            _Pragma("unroll") for (int q = 0; q < 4; ++q) { \
                const f32x2 lo = __builtin_amdgcn_cvt_pk_f32_fp8((int)VQ[eg][q], false), hi = __builtin_amdgcn_cvt_pk_f32_fp8((int)VQ[eg][q], true); \
                acc2[2 * q] += w2_ * lo; acc2[2 * q + 1] += w2_ * hi; } } } while (0)
    if (nit > 0) {
        u32x4 vA[8], vB[8]; float wA[8], wB[8];
        GT_LOADV(vA, wA, 0);
#pragma unroll 1
        for (int it = 0; it < nit; it += 2) {
            f32x2 acc2[8];
#pragma unroll
            for (int i = 0; i < 8; ++i) acc2[i] = (f32x2){0.f, 0.f};
            GT_LOADV(vB, wB, it + 1);
            GT_COMPV(vA, wA);
            if (it + 2 < nit) GT_LOADV(vA, wA, it + 2);
            GT_COMPV(vB, wB);
            f32x2 t4[4], t2[2], t1;
#pragma unroll
            for (int i = 0; i < 4; ++i) { const f32x2 snd = (s & 4) ? acc2[i] : acc2[i + 4], kp = (s & 4) ? acc2[i + 4] : acc2[i];
                t4[i] = kp + (f32x2){xchg32(snd.x, lane), xchg32(snd.y, lane)}; }
#pragma unroll
            for (int i = 0; i < 2; ++i) { const f32x2 snd = (s & 2) ? t4[i] : t4[i + 2], kp = (s & 2) ? t4[i + 2] : t4[i];
                t2[i] = kp + (f32x2){xchg16(snd.x, lane), xchg16(snd.y, lane)}; }
            { const f32x2 snd = (s & 1) ? t2[0] : t2[1], kp = (s & 1) ? t2[1] : t2[0]; t1 = kp + (f32x2){dppmov<DPP_ROR8>(snd.x), dppmov<DPP_ROR8>(snd.y)}; }
            { GT_ITEM(it); (void)hf_; const int r_ = GT_ROW(k_);
              const int col = cb_ * 128 + j * 16 + 2 * s; float* xp = XS + (size_t)r_ * DM + col; const float* g2 = modl + (size_t)mod_sel(r_) * 12288 + 5 * DM + col;
#if defined(DBG_CHECK) && (DBG_CHECK == 3 || DBG_CHECK == 4)
              if (((r_ - 300) & 63) == 0 && r_ >= 300 && r_ < 300 + 64 * 128) { float* dbgo = WSP(float, WS_MQ) + (size_t)r_ * DM + col; dbgo[0] = t1.x; dbgo[1] = t1.y; }
#endif
              const f32x2 x = *(const f32x2*)xp, g = *(const f32x2*)g2;
              *(f32x2*)xp = x + pscale * g * t1; }
        }
    }
#undef GT_LOADV
#undef GT_COMPV
#undef GT_ITEM
#undef GT_ROW
}
__device__ __forceinline__ void phase_final_norm(const Ctx& C) {
    const float* XS = WSP(float, WS_XS); const float* fg = INP(I_FG);
    for (int q = C.bid * 8 + C.wid; q < NBATCH * SEQ; q += C.G * 8) {
        const int b = q / SEQ, t = q % SEQ; const float* xr = XS + ((size_t)b * RPB + CTXL + t) * DM; float* op = C.out + (size_t)q * DM;
        f32x4 v[8]; float ss = 0.f;
#pragma unroll
        for (int c = 0; c < 8; ++c) { v[c] = *(const f32x4*)(xr + c * 256 + C.lane * 4); ss += v[c][0] * v[c][0] + v[c][1] * v[c][1] + v[c][2] * v[c][2] + v[c][3] * v[c][3]; }
        ss = wave_sum(ss); const float rs = rsqrtf(ss * (1.0f / DM) + NORM_EPS);
#pragma unroll
        for (int c = 0; c < 8; ++c) { const f32x4 g = *(const f32x4*)(fg + c * 256 + C.lane * 4); *(f32x4*)(op + c * 256 + C.lane * 4) = v[c] * rs * g; }
    }
}

template <int TYPE  , int VAR = 0> __device__ __forceinline__ void attn_units(const Ctx& C, bool need_ctx) {
    const bf16_t* P = WSP(bf16_t, WS_P);
    const int nu = need_ctx ? 528 : 512;
#pragma unroll 1
    for (int u = C.bid; u < nu; u += C.G) {
        int bh, qb; if (u < 512) { bh = (u >> 8) * 8 + (u & 7); qb = ((u & 255) >> 3) + 1; } else { bh = u - 512; qb = 0; }
        const int b = bh >> 3, h = bh & 7; const size_t rq = (size_t)b * RPB + (size_t)qb * 256, rk = (size_t)b * RPB; const int seq = qb == 0 ? CTXL : RPB;
        __syncthreads();
        if constexpr (TYPE == 1) {
            att::attn_body<128, 2, VAR>(P + rq * NP + C_AQ + h * 128, NP, P + rk * NP + C_AK + (h >> 2) * 128, NP, nullptr, 0, P + rk * NP + C_AV + (h >> 2) * 128, NP,
                                   WSP(bf16_t, WS_OA) + rq * 1024 + h * 128, 1024, seq, false, 0, nullptr, (char*)C.lds, C.tid);
        } else {
            const bf16_t* MQ = WSP(bf16_t, WS_MQ); const bf16_t* MKV = WSP(bf16_t, WS_MKV);
            att::attn_body<192, 1, VAR>(MQ + rq * 1536 + h * 192, 1536, MKV + rk * 2048 + h * 256, 2048, P + rk * NP + C_MKR, NP, MKV + rk * 2048 + h * 256 + 128, 2048,
                                   WSP(bf16_t, WS_OM) + rq * 1024 + h * 128, 1024, seq, qb > 0, (qb - 1) * 256, WSP(float, WS_TABM), (char*)C.lds, C.tid);
        }
    }
    __syncthreads();
}

constexpr int LDS_BYTES = 163840, LDS_BAR_OFF = LDS_BYTES - 16;
constexpr int N_PHASES = 26;
template <int K> __device__ __forceinline__ void run_phase(const Ctx& C0, int l) {
    const Ctx C = launder(C0);
    const float* modl = WSP(float, WS_MODV) + (size_t)l * 3 * 12288;
    if constexpr (K == 0) { phase_modv(C); phase_tables(C); __syncthreads(); phase_cvt_mixer_weights(C, 0); }
    if constexpr (K == 1) {
        if (l == 0) phase_norm_mod<true, true>(C, INP(I_N1G), modl, 0, DM);
        else { phase_norm_mod<false, true>(C, INP(I_N1G) + l * DM, modl, 0, DM); __syncthreads(); phase_cvt_mixer_weights(C, l); }
    }
    if constexpr (K == 2) {
        pg8::Gemm g{WSP(bf16_t, WS_HB), WSP(bf16_t, WS_WIN), TT, NP, DM, DM, DM}; pg8::WinOrder S; S.init(C.G, C.bid, l + 1 < DEPTH);
        pg8::EpiStoreBf16S E{WSP(bf16_t, WS_P), NP, WSP(float, WS_WINS)};
        pg8::gemm_phase<pg8::EpiStoreBf16S, pg8::WinOrder, 1>(C.lds, C.tid, g, S, E);
    }
    if constexpr (K == 3) phase_post_p(C, l);
    if constexpr (K == 4) {
        { pg8::Gemm g{WSP(bf16_t, WS_P) + C_MCQ, WSP(bf16_t, WS_WUQ), TT, 1536, 512, NP, 512}; pg8::StaticOrder S; S.init(TT, 1536, C.G, C.bid);
          pg8::EpiStoreBf16 E{WSP(bf16_t, WS_MQ), 1536}; pg8::gemm_phase(C.lds, C.tid, g, S, E); }
        { pg8::Gemm g{WSP(bf16_t, WS_P) + C_MCKV, WSP(bf16_t, WS_WUKV), TT, 2048, 512, NP, 512}; pg8::StaticOrder S; S.init(TT, 2048, C.G, (C.bid + C.G - 140 % C.G) % C.G);
          pg8::EpiStoreBf16 E{WSP(bf16_t, WS_MKV), 2048}; pg8::gemm_phase(C.lds, C.tid, g, S, E); }
        { const Ctx C2 = launder(C0); phase_gla_local(C2, l, 156); }
#ifdef DBG_DUP_GLALOCAL
        { const Ctx C2 = launder(C0); __syncthreads(); phase_gla_local(C2, l, 156); }
#endif
    }
    if constexpr (K == 5) phase_gla_scan(C);
    if constexpr (K == 6) {
#ifdef DBG_ATTVAR
        { const Ctx Cx = launder(C0); attn_units<0, DBG_ATTVAR>(Cx, l + 1 < DEPTH); } { const Ctx Cx = launder(C0); attn_units<1, DBG_ATTVAR>(Cx, l + 1 < DEPTH); } __syncthreads();
#endif
        attn_units<0>(C, l + 1 < DEPTH); { const Ctx C2 = launder(C0); attn_units<1>(C2, l + 1 < DEPTH); } { const Ctx C3 = launder(C0); phase_gla_out(C3, l, 128); }
#ifdef DBG_DUP_GLAOUT
        { const Ctx C3 = launder(C0); __syncthreads(); phase_gla_out(C3, l, 128); }
#endif
    }
    if constexpr (K == 7) {
        const bf16_t* P = WSP(bf16_t, WS_P); bf16_t* Y = WSP(bf16_t, WS_Y);
        const pg8::Gemm ga{WSP(bf16_t, WS_OA), WSP(bf16_t, WS_WBR), TT, DM, 1024, 1024, 1024}, gl{WSP(bf16_t, WS_OL), WSP(bf16_t, WS_WBR) + (size_t)2048 * 1024, TT, DM, 1024, 1024, 1024},
                        gm{WSP(bf16_t, WS_OM), WSP(bf16_t, WS_WBR) + (size_t)2 * 2048 * 1024, TT, DM, 1024, 1024, 1024};
        const pg8::EpiGate<true> Ea{Y, DM, P + C_GA, NP}; const pg8::EpiGate<false> El{Y, DM, P + C_GL, NP}, Em{Y, DM, P + C_GM, NP};
        pg8::StaticOrder S; S.init(TT, DM, C.G, C.bid, l + 1 >= DEPTH);
        pg8::gemm_phase(C.lds, C.tid, ga, S, Ea); pg8::gemm_phase(C.lds, C.tid, gl, S, El); pg8::gemm_phase(C.lds, C.tid, gm, S, Em);
        if (l == 0) { const Ctx C2 = launder(C0); phase_cvt_peer_tables(C2, 0, 0, NEXP, S.nwg % C.G); }
    }
    if constexpr (K == 8) {
        pg8::Gemm g{WSP(bf16_t, WS_Y), WSP(bf16_t, WS_WOUT), TT, DM, DM, DM, DM};
        pg8::EpiResid E{WSP(float, WS_XS), DM, modl + 2 * DM, l == 0 ? DBG_MIX0 : DBG_MIX1};
        pg8::StaticOrder S; S.init(TT, DM, C.G, C.bid, l + 1 >= DEPTH);
#ifdef DBG_DUP8
        { pg8::EpiResid E0{WSP(float, WS_XS), DM, modl + 2 * DM, 0.0f}; pg8::gemm_phase(C.lds, C.tid, g, S, E0); }
#endif
        pg8::gemm_phase(C.lds, C.tid, g, S, E);
        if (l == 0 && DEPTH > 1) { const Ctx C2 = launder(C0); phase_cvt_peer_tables(C2, 1, 0, NEXP / 2, S.nwg % C.G); }
    }
    if constexpr (K == 9) phase_norm_mod<false>(C, INP(I_N2G) + l * DM, modl, 3 * DM, 4 * DM);
    if constexpr (K == 10) {
        pg8::Gemm g{WSP(bf16_t, WS_HB), WSP(bf16_t, WS_WQ), TT, DM, DM, DM, DM};
        pg8::EpiStoreBf16 E{WSP(bf16_t, WS_PQ), DM};
        pg8::StaticOrder S; S.init(TT, DM, C.G, C.bid, l + 1 >= DEPTH); pg8::gemm_phase(C.lds, C.tid, g, S, E);
        if (l == 0 && DEPTH > 1) { const Ctx C2 = launder(C0); phase_cvt_peer_tables(C2, 1, NEXP / 2, NEXP, S.nwg % C.G); }
    }
    if constexpr (K == 11) phase_peer_select(C, l + 1 >= DEPTH);
    if constexpr (K == 13) phase_final_norm(C);
    if constexpr (K == 12) {
#ifdef DBG_DUP12
        if (l + 1 < DEPTH) phase_peer_gather<false>(C, modl, 0.0f); else phase_peer_gather<true>(C, modl, 0.0f);
        __syncthreads();
#endif
        if (l + 1 < DEPTH) phase_peer_gather<false>(C, modl, DBG_PEER0); else phase_peer_gather<true>(C, modl, DBG_PEER1); }
}
__device__ __forceinline__ Ctx make_ctx(const Args& args, unsigned char* lds_raw) {
    Ctx C0; C0.in = (const __attribute__((address_space(4))) cfp_t*)__builtin_amdgcn_kernarg_segment_ptr(); C0.out = args.out; C0.ws = args.ws; C0.lds = (LAS unsigned char*)lds_raw;
    C0.tid = threadIdx.x; C0.lane = C0.tid & 63; C0.wid = __builtin_amdgcn_readfirstlane(C0.tid >> 6); C0.G = gridDim.x; C0.bid = blockIdx.x;
    return C0;
}
template <int K> __global__ void __launch_bounds__(NTHREADS, 2) k_one(Args args) {
    extern __shared__ __attribute__((aligned(16))) unsigned char lds_raw[];
    const Ctx C0 = make_ctx(args, lds_raw);
    run_phase<K>(C0, args.ph_lo);
}
#if MK_N_LAUNCHES == 1 || defined(DBG_HYB)
__global__ void __launch_bounds__(NTHREADS, 2) mk_fwd(Args args) {
    extern __shared__ __attribute__((aligned(16))) unsigned char lds_raw[];
    const Ctx C0 = make_ctx(args, lds_raw);
    if (C0.tid < 4) ((LAS unsigned*)(C0.lds + LDS_BAR_OFF))[C0.tid] = 0u;
    __syncthreads();
    const int lo = args.ph_lo, hi = args.ph_hi;
    XcdBarrier bar; bar.bar = (unsigned*)(args.ws + WS_CTL); bar.x = 0; bar.st = nullptr;
    if (hi - lo > 1) bar = xcd_barrier_post((unsigned*)(args.ws + WS_CTL), (volatile LAS unsigned*)(C0.lds + LDS_BAR_OFF));
#define IN(k) (lo <= (k) && (k) < hi)
#define SEAM(k) do { if (IN(k) && IN((k) + 1)) xcd_barrier(bar); } while (0)
#ifndef DBG_DUP
#define DBG_DUP -1
#endif
#define PH(K, k) do { if (IN(k)) { run_phase<K>(C0, l); if (K == DBG_DUP) { xcd_barrier(bar); run_phase<K>(C0, l); } } SEAM(k); } while (0)
    { const int l = 0; PH(0, 0); }
#pragma unroll 1
    for (int l = 0; l < DEPTH; ++l) {
        const int pb = 1 + 12 * l;
        PH(1, pb + 0); PH(2, pb + 1); PH(3, pb + 2); PH(4, pb + 3); PH(5, pb + 4); PH(6, pb + 5);
        PH(7, pb + 6); PH(8, pb + 7); PH(9, pb + 8); PH(10, pb + 9); PH(11, pb + 10); PH(12, pb + 11);
    }
    { const int l = DEPTH - 1; PH(13, 1 + 12 * DEPTH); }
#undef PH
#undef IN
#undef SEAM
}
#define MAIN_KERNEL mk_fwd
#else
#define MAIN_KERNEL k_one<6>
#endif


#ifdef DBG_PROBE
typedef int i32x8 __attribute__((ext_vector_type(8)));
__device__ __forceinline__ unsigned char fp8_of_int(int v) {
    const float f = (float)v; return (unsigned char)(__builtin_amdgcn_cvt_pk_fp8_f32(f, 0.f, 0, false) & 0xff); }
__global__ void k_probe_mx(unsigned* slot) {
    const int l = threadIdx.x, r = l & 15, g = l >> 4;
    float worst[2] = {0.f, 0.f};
    for (int hyp = 0; hyp < 2; ++hyp) {
        i32x8 A, B;
        for (int j = 0; j < 8; ++j) { unsigned wa = 0, wb = 0;
            for (int b = 0; b < 4; ++b) { const int i = 4 * j + b;
                const int k = hyp == 0 ? g * 32 + i : (i >> 3) * 32 + g * 8 + (i & 7);
                wa |= (unsigned)fp8_of_int(((3 * r + k) % 7) - 3) << (8 * b); wb |= (unsigned)fp8_of_int(((5 * k + 2 * r) % 9) - 4) << (8 * b); }
            A[j] = (int)wa; B[j] = (int)wb; }
        f32x4 c = {0.f, 0.f, 0.f, 0.f};
        c = __builtin_amdgcn_mfma_scale_f32_16x16x128_f8f6f4(A, B, c, 0, 0, 0, 0x7f7f7f7f, 0, 0x7f7f7f7f);
        for (int i = 0; i < 4; ++i) { const int m = 4 * g + i, n = r; float ref = 0.f; for (int k = 0; k < 128; ++k) ref += (float)(((3 * m + k) % 7) - 3) * (float)(((5 * k + 2 * n) % 9) - 4);
            worst[hyp] = fmaxf(worst[hyp], fabsf(c[i] - ref)); }
    }
    for (int o = 32; o >= 1; o >>= 1) { worst[0] = fmaxf(worst[0], __shfl_xor(worst[0], o)); worst[1] = fmaxf(worst[1], __shfl_xor(worst[1], o)); }
    if (l == 0) { const float code = worst[0] == 0.f ? 0.4f : (worst[1] == 0.f ? 0.8f : 1.2f); *slot = __float_as_uint(powf(10.f, code / 0.25f - 4.f)); }
}
#endif
#ifdef DBG_CHECK
__device__ __forceinline__ void dbg_report(unsigned* slot, float err) { if (!(err <= 3e38f)) err = 1e30f; atomicMax(slot, __float_as_uint(err)); }
__global__ void k_check_gemm(const bf16_t* A, int lda, const float* W, int K, int N, const bf16_t* Cm, int ldc, int M, unsigned* slot) {
    const unsigned id = blockIdx.x * blockDim.x + threadIdx.x; if (id >= 8192) return;
    const unsigned h = id * 2654435761u; const int row = (int)((h >> 8) % (unsigned)M), col = (int)((h * 40503u >> 7) % (unsigned)N);
    float ref = 0.f; for (int k = 0; k < K; ++k) ref += bf2f(A[(size_t)row * lda + k]) * W[(size_t)k * N + col];
    const float got = bf2f(Cm[(size_t)row * ldc + col]);
    dbg_report(slot, fabsf(got - ref) / (fabsf(ref) + 0.1f));
}

__global__ void k_check_attn(const unsigned char* ws, int type, unsigned* slot) {
    __shared__ float sc[RPB]; __shared__ float red[256]; __shared__ float qv[192];
    const int t = threadIdx.x, bh = blockIdx.x & 15, b = bh >> 3, h = bh & 7; const int qpos = (int)(((blockIdx.x >> 4) * 977u + 13u) % SEQ); const size_t rq = (size_t)b * RPB + CTXL + qpos, rk = (size_t)b * RPB;
    const bf16_t* P = (const bf16_t*)(ws + WS_P); const bf16_t* MQ = (const bf16_t*)(ws + WS_MQ); const bf16_t* MKV = (const bf16_t*)(ws + WS_MKV);
    const int dq = type ? 128 : 192;
    if (t < dq) { float v = type ? bf2f(P[rq * NP + C_AQ + h * 128 + t]) : bf2f(MQ[rq * 1536 + h * 192 + t]); qv[t] = v; }
    __syncthreads();
    if (!type && t < 32) {
        const int ri = qpos >> 6, ci = qpos & 63; const int i = t; const float pos = (float)(i < 16 ? ri : ci); const float inv = powf(10000.f, -(float)(i & 15) / 16.f); const float a = pos * inv;
        const float x1 = qv[128 + i], x2 = qv[160 + i]; qv[128 + i] = x1 * cosf(a) - x2 * sinf(a); qv[160 + i] = x2 * cosf(a) + x1 * sinf(a); }
    __syncthreads();
    const float scale = type ? 0.088388347648f : 0.0721687836487f;
    float mx = -1e30f;
    for (int k = t; k < RPB; k += 256) { float s = 0.f;
        if (type) { const bf16_t* kp = P + (rk + k) * NP + C_AK + (h >> 2) * 128; for (int d = 0; d < 128; ++d) s += qv[d] * bf2f(kp[d]); }
        else { const bf16_t* kp = MKV + (rk + k) * 2048 + h * 256; for (int d = 0; d < 128; ++d) s += qv[d] * bf2f(kp[d]); const bf16_t* kr = P + (rk + k) * NP + C_MKR; for (int d = 0; d < 64; ++d) s += qv[128 + d] * bf2f(kr[d]); }
        s *= scale; sc[k] = s; mx = fmaxf(mx, s); }
    red[t] = mx; __syncthreads(); for (int o = 128; o >= 1; o >>= 1) { if (t < o) red[t] = fmaxf(red[t], red[t + o]); __syncthreads(); } mx = red[0]; __syncthreads();
    float sum = 0.f; for (int k = t; k < RPB; k += 256) { const float p = __expf(sc[k] - mx); sc[k] = p; sum += p; }
    red[t] = sum; __syncthreads(); for (int o = 128; o >= 1; o >>= 1) { if (t < o) red[t] += red[t + o]; __syncthreads(); } sum = red[0]; __syncthreads();
    float e = 0.f, mag = 0.f;
    if (t < 128) { float o = 0.f; for (int k = 0; k < RPB; ++k) { const float vv = type ? bf2f(P[(rk + k) * NP + C_AV + (h >> 2) * 128 + t]) : bf2f(MKV[(rk + k) * 2048 + h * 256 + 128 + t]); o += sc[k] * vv; }
        o /= sum; const float got = bf2f(((const bf16_t*)(ws + (type ? WS_OA : WS_OM)))[rq * 1024 + h * 128 + t]); e = fabsf(got - o); mag = fabsf(o); }
    red[t] = e; __syncthreads(); for (int o = 128; o >= 1; o >>= 1) { if (t < o) red[t] = fmaxf(red[t], red[t + o]); __syncthreads(); } e = red[0]; __syncthreads();
    red[t] = mag; __syncthreads(); for (int o = 128; o >= 1; o >>= 1) { if (t < o) red[t] = fmaxf(red[t], red[t + o]); __syncthreads(); } mag = red[0];
    if (t == 0) dbg_report(slot, e / (mag + 1e-4f));
}
__global__ void __launch_bounds__(256) k_check_gla_rec(const unsigned char* ws, const float* wa_f, const float* ba_f, const float* wa_b, const float* ba_b, float* obuf, int b) {
    __shared__ float ad[128], kd[128], qd[128], lrs[16];
    const int e = threadIdx.x, h = blockIdx.x & 3, dir = blockIdx.x >> 2; const bf16_t* P = (const bf16_t*)(ws + WS_P);
    const float* wa = dir ? wa_b : wa_f; const float* ba = dir ? ba_b : ba_f;
    float S[128];
#pragma unroll
    for (int d = 0; d < 128; ++d) S[d] = 0.f;
    float* ob = obuf + ((size_t)(dir * 2 + b) * 4 + h) * RPB * 256;
    for (int st = 0; st < RPB; ++st) {
        int j; if (!dir) j = st; else j = st < CTXL ? CTXL - 1 - st : RPB - 1 - (st - CTXL);
        const size_t r = (size_t)b * RPB + j; const bf16_t* pr = P + r * NP;
        if (e < 16) lrs[e] = bf2f(pr[(dir ? C_LRB : C_LRF) + e]);
        __syncthreads();
        if (e < 128) { float pre = ba[h * 128 + e]; for (int q = 0; q < 16; ++q) pre += lrs[q] * wa[q * 512 + h * 128 + e];
            const float ls = (fminf(pre, 0.f) - log1pf(expf(-fabsf(pre)))) / 16.f; ad[e] = expf(ls); kd[e] = bf2f(pr[C_LK + h * 128 + e]); qd[e] = bf2f(pr[C_LQ + h * 128 + e]) * 0.088388347648f; }
        __syncthreads();
        const float v = bf2f(pr[C_LV + h * 256 + e]); float o = 0.f;
#pragma unroll
        for (int d = 0; d < 128; ++d) { S[d] = ad[d] * S[d] + kd[d] * v; o += qd[d] * S[d]; }
        ob[(size_t)j * 256 + e] = o;
        __syncthreads();
    }
}
__global__ void k_check_gla_cmp(const unsigned char* ws, const float* obuf, const float* gon, int b, unsigned* slot) {
    __shared__ float red[256];
    const int e = threadIdx.x, h = blockIdx.x & 3, j = blockIdx.x >> 2; const size_t r = (size_t)b * RPB + j; const bf16_t* P = (const bf16_t*)(ws + WS_P);
    const float o = obuf[((size_t)(0 * 2 + b) * 4 + h) * RPB * 256 + (size_t)j * 256 + e] + obuf[((size_t)(1 * 2 + b) * 4 + h) * RPB * 256 + (size_t)j * 256 + e];
    red[e] = o * o; __syncthreads(); for (int s_ = 128; s_ >= 1; s_ >>= 1) { if (e < s_) red[e] += red[e + s_]; __syncthreads(); }
    const float rs = rsqrtf(red[0] / 256.f + NORM_EPS); __syncthreads();
    const float gt = bf2f(P[r * NP + C_LG + h * 256 + e]); const float ref = o * rs * gon[e] * (gt / (1.f + expf(-gt)));
    const float got = bf2f(((const bf16_t*)(ws + WS_OL))[r * 1024 + h * 256 + e]);
    red[e] = fabsf(got - ref); __syncthreads(); for (int s_ = 128; s_ >= 1; s_ >>= 1) { if (e < s_) red[e] = fmaxf(red[e], red[e + s_]); __syncthreads(); }
    if (e == 0) dbg_report(slot, red[0] / 1.0f);
}

__global__ void k_check_gemm8(const unsigned char* A8, const float* W, int K, int N, const bf16_t* Cm, int ldc, int M, unsigned* slot) {
    const unsigned id = blockIdx.x * blockDim.x + threadIdx.x; if (id >= 8192) return;
    const unsigned h = id * 2654435761u; const int row = (int)((h >> 8) % (unsigned)M), col = (int)((h * 40503u >> 7) % (unsigned)N);
    float ref = 0.f, mag = 0.f; for (int k = 0; k < K; ++k) { const float a = __builtin_amdgcn_cvt_f32_fp8((int)A8[(size_t)row * K + k], 0), w = W[(size_t)k * N + col]; ref += a * w; mag += a * a * w * w; }
    const float got = bf2f(Cm[(size_t)row * ldc + col]);
    dbg_report(slot, fabsf(got - ref) / (sqrtf(mag) + 1e-3f));
}
__global__ void k_check_select(const bf16_t* PQ, const float* k1, const float* k2, const int* PIDX, const float* PG, unsigned* slot) {
    __shared__ float s1[128], s2[128]; __shared__ int cnt; __shared__ float selv[16];
    const int tok = (blockIdx.x >> 3) * 61 + 5, head = blockIdx.x & 7, t = threadIdx.x;
    if (t == 0) cnt = 0;
    for (int n = t; n < 128; n += 64) { float a = 0.f, b = 0.f; for (int d = 0; d < 128; ++d) { a += bf2f(PQ[(size_t)tok * DM + head * 256 + d]) * k1[((size_t)head * 128 + n) * 128 + d]; b += bf2f(PQ[(size_t)tok * DM + head * 256 + 128 + d]) * k2[((size_t)head * 128 + n) * 128 + d]; } s1[n] = a; s2[n] = b; }
    __syncthreads();
    if (t < 16) { const int id = PIDX[(size_t)tok * 128 + head * 16 + t]; selv[t] = (id >= 0 && id < 16384) ? s1[id >> 7] + s2[id & 127] : -1e30f; }
    __syncthreads();
    float thr = selv[0], mx = selv[0]; for (int k = 1; k < 16; ++k) { thr = fminf(thr, selv[k]); mx = fmaxf(mx, selv[k]); }
    int c = 0; for (int p = t; p < 16384; p += 64) if (s1[p >> 7] + s2[p & 127] > thr + 0.02f) ++c;
    atomicAdd(&cnt, c); __syncthreads();
    if (t == 0) { float den = 0.f; for (int k = 0; k < 16; ++k) den += __expf(selv[k] - mx); float e = fabsf((float)cnt - 15.f) / 15.f > 0.34f ? fabsf((float)cnt - 15.f) / 15.f : 0.f;
        for (int k = 0; k < 16; ++k) e = fmaxf(e, fabsf(PG[(size_t)tok * 128 + head * 16 + k] - __expf(selv[k] - mx) / den) * 4.f);
        for (int k = 0; k < 16; ++k) for (int k2_ = 0; k2_ < k; ++k2_) if (PIDX[(size_t)tok * 128 + head * 16 + k] == PIDX[(size_t)tok * 128 + head * 16 + k2_]) e = fmaxf(e, 10.f);
        dbg_report(slot, e); }
}
__global__ void k_check_gather(const bf16_t* HB, const float* u, const float* v, const int* PIDX, const float* PG, const float* dbgo, unsigned* slot) {
    __shared__ float w[128];
    const int tok = blockIdx.x * 64 + 300, t = threadIdx.x;
    for (int k = t; k < 128; k += 64) { const int id = PIDX[(size_t)tok * 128 + k] & 16383; float a = 0.f; for (int d = 0; d < DM; ++d) a += bf2f(HB[(size_t)tok * DM + d]) * u[(size_t)id * DM + d];
        w[k] = PG[(size_t)tok * 128 + k] * 0.5f * a * (1.0f + erff(a * 0.70710678f)); }
    __syncthreads();
    float e = 0.f, sc = 0.f;
    for (int d = t; d < DM; d += 64) { float o = 0.f; for (int k = 0; k < 128; ++k) o += w[k] * v[(size_t)(PIDX[(size_t)tok * 128 + k] & 16383) * DM + d];
        e = fmaxf(e, fabsf(o - dbgo[(size_t)tok * DM + d])); sc = fmaxf(sc, fabsf(o)); }
    for (int o_ = 32; o_ >= 1; o_ >>= 1) { e = fmaxf(e, __shfl_xor(e, o_)); sc = fmaxf(sc, __shfl_xor(sc, o_)); }
    if (t == 0) dbg_report(slot, e / (sc + 1e-6f));
}
__global__ void k_dbg_out2(const float* x, const float* fg, float* out, const unsigned* slot) {
    const float mx = __uint_as_float(*slot); float v = 0.25f * (log10f(fmaxf(mx, 1e-30f)) + 4.0f); v = fminf(fmaxf(v, 0.f), 9.f);
    const float f = 1.0f + v;
    const int lane = threadIdx.x & 63; const size_t r = (size_t)blockIdx.x * 4 + (threadIdx.x >> 6);
    const float* xr = x + r * DM; float ss = 0.f;
    for (int c = lane; c < DM; c += 64) ss += xr[c] * xr[c];
    ss = wave_sum(ss); const float rs = rsqrtf(ss / DM + NORM_EPS);
    for (int c = lane; c < DM; c += 64) out[r * DM + c] = xr[c] * rs * fg[c] * f;
}
#endif
#ifdef DBG_SCAN
__global__ void k_scan16(const bf16_t* p, size_t n, unsigned* flags, int stage) {
    unsigned bad = 0; for (size_t i = (size_t)blockIdx.x * blockDim.x + threadIdx.x; i < n; i += (size_t)gridDim.x * blockDim.x) bad |= ((p[i] & 0x7f80u) == 0x7f80u);
    if (bad) atomicOr(&flags[stage], 1u);
}
__global__ void k_scan32(const float* p, size_t n, unsigned* flags, int stage) {
    unsigned bad = 0; for (size_t i = (size_t)blockIdx.x * blockDim.x + threadIdx.x; i < n; i += (size_t)gridDim.x * blockDim.x) bad |= ((__float_as_uint(p[i]) & 0x7f800000u) == 0x7f800000u);
    if (bad) atomicOr(&flags[stage], 1u);
}
__global__ void k_dbg_out(const float* x, const float* fg, float* out, const unsigned* flags, int nstage) {
    int code = 0; for (int s = nstage; s >= 1; --s) if (flags[s]) code = s;
    const float f = 1.0f + 0.25f * (float)code;
    const int lane = threadIdx.x & 63; const size_t r = (size_t)blockIdx.x * 4 + (threadIdx.x >> 6);
    const float* xr = x + r * DM; float ss = 0.f;
    for (int c = lane; c < DM; c += 64) ss += xr[c] * xr[c];
    ss = wave_sum(ss); const float rs = rsqrtf(ss / DM + NORM_EPS);
    for (int c = lane; c < DM; c += 64) out[r * DM + c] = xr[c] * rs * fg[c] * f;
}
#endif
extern "C" void kernel_launch(void* const* d_in, const int* in_sizes, int n_in, void* d_out, int out_size, void* d_ws, size_t ws_size, hipStream_t stream) {
    static int grid = 0;
    if (grid == 0) {
        if (n_in != 30 || out_size != NBATCH * SEQ * DM || ws_size < WS_END) { fprintf(stderr, "kernel_launch: shape/workspace mismatch: n_in %d out %d ws %zu (need %zu)\n", n_in, out_size, ws_size, (size_t)WS_END); grid = -1; return; }
        int dev = 0, cus = 0, per_cu = 0;
        if (hipGetDevice(&dev) != hipSuccess || hipDeviceGetAttribute(&cus, hipDeviceAttributeMultiprocessorCount, dev) != hipSuccess) { grid = -1; return; }
        bool okattr = hipFuncSetAttribute((const void*)MAIN_KERNEL, hipFuncAttributeMaxDynamicSharedMemorySize, LDS_BYTES) == hipSuccess;
#if MK_N_LAUNCHES != 1
#ifdef DBG_HYB
        okattr = okattr && hipFuncSetAttribute((const void*)mk_fwd, hipFuncAttributeMaxDynamicSharedMemorySize, LDS_BYTES) == hipSuccess;
#endif
#define SETA(K) okattr = okattr && hipFuncSetAttribute((const void*)k_one<K>, hipFuncAttributeMaxDynamicSharedMemorySize, LDS_BYTES) == hipSuccess
        SETA(0); SETA(1); SETA(2); SETA(3); SETA(4); SETA(5); SETA(6); SETA(7); SETA(8); SETA(9); SETA(10); SETA(11); SETA(12); SETA(13);
#undef SETA
#endif
        if (!okattr) { fprintf(stderr, "kernel_launch: hipFuncSetAttribute failed\n"); grid = -1; return; }
        if (hipOccupancyMaxActiveBlocksPerMultiprocessor(&per_cu, (const void*)MAIN_KERNEL, NTHREADS, LDS_BYTES) != hipSuccess || per_cu < 1) { fprintf(stderr, "kernel_launch: occupancy query says %d blocks per CU\n", per_cu); grid = -1; (void)hipGetLastError(); return; }
        grid = cus;
    }
    if (grid < 0) return;
    if (hipMemsetAsync((char*)d_ws + WS_CTL, 0, CTL_BYTES, stream) != hipSuccess) return;
    Args a{};
    for (int i = 0; i < 30; ++i) a.in[i] = (const float*)d_in[i];
    a.out = (float*)d_out; a.ws = (unsigned char*)d_ws;
#if defined(DBG_PROBE)
    { unsigned* flags = (unsigned*)((char*)d_ws + WS_CTL + 32768);
      hipLaunchKernelGGL(k_probe_mx, dim3(1), dim3(64), 0, stream, flags + 100);
      hipLaunchKernelGGL(k_dbg_out2, dim3(NBATCH * SEQ / 4), dim3(256), 0, stream, (const float*)d_in[0], (const float*)d_in[29], (float*)d_out, flags + 100); }
#elif MK_N_LAUNCHES == 1 && defined(DBG_CHECK)
    {
        unsigned* flags = (unsigned*)((char*)d_ws + WS_CTL + 32768); char* W = (char*)d_ws;
        a.ph_lo = 0; a.ph_hi = (DBG_CHECK == 8) ? 3 : (DBG_CHECK >= 5) ? 7 : (DBG_CHECK == 1 ? 11 : (DBG_CHECK == 2 ? 12 : 13));
        hipLaunchKernelGGL(mk_fwd, dim3(grid), dim3(NTHREADS), LDS_BYTES, stream, a);
#if DBG_CHECK == 8
        hipLaunchKernelGGL(k_check_gemm8, dim3(32), dim3(256), 0, stream, (const unsigned char*)(W + WS_HB), (const float*)d_in[I_WIN], DM, IN_COLS, (const bf16_t*)(W + WS_P), NP, TT, flags + 100);
#elif DBG_CHECK == 5 || DBG_CHECK == 6
        hipLaunchKernelGGL(k_check_attn, dim3(16 * 24), dim3(256), 0, stream, (const unsigned char*)d_ws, DBG_CHECK == 5 ? 1 : 0, flags + 100);
#elif DBG_CHECK == 7
        { float* obuf = (float*)(W + WS_MQ);
          hipLaunchKernelGGL(k_check_gla_rec, dim3(8), dim3(256), 0, stream, (const unsigned char*)d_ws, (const float*)d_in[I_WA2F], (const float*)d_in[I_BAF], (const float*)d_in[I_WA2B], (const float*)d_in[I_BAB], obuf, 0);
          hipLaunchKernelGGL(k_check_gla_cmp, dim3(RPB * 4), dim3(256), 0, stream, (const unsigned char*)d_ws, (const float*)obuf, (const float*)d_in[I_ONG], 0, flags + 100); }
#elif DBG_CHECK == 1
        hipLaunchKernelGGL(k_check_gemm, dim3(32), dim3(256), 0, stream, (const bf16_t*)(W + WS_HB), DM, (const float*)d_in[I_PWQ], DM, DM, (const bf16_t*)(W + WS_PQ), DM, TT, flags + 100);
#elif DBG_CHECK == 2
        hipLaunchKernelGGL(k_check_select, dim3(256 * 8), dim3(64), 0, stream, (const bf16_t*)(W + WS_PQ), (const float*)d_in[I_PK1], (const float*)d_in[I_PK2], (const int*)(W + WS_PIDX), (const float*)(W + WS_PG), flags + 100);
#else
        hipLaunchKernelGGL(k_check_gather, dim3(128), dim3(64), 0, stream, (const bf16_t*)(W + WS_HB), (const float*)d_in[I_PU], (const float*)d_in[I_PV], (const int*)(W + WS_PIDX), (const float*)(W + WS_PG), (const float*)(W + WS_MQ), flags + 100);
#endif
        hipLaunchKernelGGL(k_dbg_out2, dim3(NBATCH * SEQ / 4), dim3(256), 0, stream, (const float*)d_in[0], (const float*)d_in[29], (float*)d_out, flags + 100);
    }
#elif MK_N_LAUNCHES == 1
#ifdef DBG_SPLIT
    for (int p = 0; p < N_PHASES; p += DBG_SPLIT) { a.ph_lo = p; a.ph_hi = p + DBG_SPLIT < N_PHASES ? p + DBG_SPLIT : N_PHASES; hipLaunchKernelGGL(mk_fwd, dim3(grid), dim3(NTHREADS), LDS_BYTES, stream, a); }
#else
    a.ph_lo = 0; a.ph_hi = N_PHASES;
    hipLaunchKernelGGL(mk_fwd, dim3(grid), dim3(NTHREADS), LDS_BYTES, stream, a);
#endif
#else
    a.ph_hi = 0;
#ifndef DBG_NLAUNCH
#define DBG_NLAUNCH 100
#endif
    int nl_ = 0;
#ifdef DBG_HYB
#define LAUNCH1(K, L) do { if (K == DBG_HYB) { a.ph_lo = 12 * (L) + (K); a.ph_hi = a.ph_lo + 1; hipLaunchKernelGGL(mk_fwd, dim3(grid), dim3(NTHREADS), LDS_BYTES, stream, a); a.ph_hi = 0; } else { a.ph_lo = (L); hipLaunchKernelGGL(k_one<K>, dim3(grid), dim3(NTHREADS), LDS_BYTES, stream, a); } } while (0)
#else
#define LAUNCH1(K, L) do { a.ph_lo = (L); if (nl_++ < DBG_NLAUNCH) { hipLaunchKernelGGL(k_one<K>, dim3(grid), dim3(NTHREADS), LDS_BYTES, stream, a); if (K == DBG_DUP) hipLaunchKernelGGL(k_one<K>, dim3(grid), dim3(NTHREADS), LDS_BYTES, stream, a); } } while (0)
#endif
#ifdef DBG_SCAN
    unsigned* flags = (unsigned*)((char*)d_ws + WS_CTL + 32768);
    char* W = (char*)d_ws;
#define S16(off, n, st) hipLaunchKernelGGL(k_scan16, dim3(1024), dim3(256), 0, stream, (const bf16_t*)(W + (off)), (size_t)(n), flags, st)
#define S32(off, n, st) hipLaunchKernelGGL(k_scan32, dim3(1024), dim3(256), 0, stream, (const float*)(W + (off)), (size_t)(n), flags, st)
    LAUNCH1(0, 0); S32(WS_MODV, 2 * 3 * 12288, 1);
    { const int l = 0;
      LAUNCH1(1, l); S16(WS_HB, (size_t)TT * DM, 2);
      LAUNCH1(2, l); S16(WS_P, (size_t)TT * NP, 3);
      LAUNCH1(3, l); S16(WS_P, (size_t)TT * NP, 4);
      LAUNCH1(4, l); S16(WS_MQ, (size_t)TT * 1536, 5); S16(WS_MKV, (size_t)TT * 2048, 5); S16(WS_GST, (size_t)2112 * 32768, 6); S32(WS_GDEC, (size_t)2112 * 128, 6);
      LAUNCH1(5, l); S16(WS_GST, (size_t)2112 * 32768, 7);
      LAUNCH1(6, l); S16(WS_OA, (size_t)TT * 1024, 8); S16(WS_OM, (size_t)TT * 1024, 9); S16(WS_OL, (size_t)TT * 1024, 10);
      LAUNCH1(7, l); S16(WS_Y, (size_t)TT * DM, 11);
      LAUNCH1(8, l); S32(WS_XS, (size_t)TT * DM, 12);
      LAUNCH1(9, l); S16(WS_HB, (size_t)TT * DM, 13);
      LAUNCH1(10, l); S16(WS_PQ, (size_t)TT * DM, 14);
      LAUNCH1(11, l); S32(WS_PG, (size_t)TT * 128, 15);
      LAUNCH1(12, l); S32(WS_XS, (size_t)TT * DM, 16);
    }
    hipLaunchKernelGGL(k_dbg_out, dim3(NBATCH * SEQ / 4), dim3(256), 0, stream, (const float*)d_in[0], (const float*)d_in[29], (float*)d_out, flags, 16);
#elif defined(DBG_CHECK)
    unsigned* flags = (unsigned*)((char*)d_ws + WS_CTL + 32768);
    char* W = (char*)d_ws;
    LAUNCH1(0, 0);
    { const int l = 0; LAUNCH1(1, l); LAUNCH1(2, l); LAUNCH1(3, l); LAUNCH1(4, l); LAUNCH1(5, l); LAUNCH1(6, l);
#if DBG_CHECK == 5 || DBG_CHECK == 6
      hipLaunchKernelGGL(k_check_attn, dim3(16 * 24), dim3(256), 0, stream, (const unsigned char*)d_ws, DBG_CHECK == 5 ? 1 : 0, flags + 100);
#endif
#if DBG_CHECK == 7
      { float* obuf = (float*)(W + WS_MQ);
        hipLaunchKernelGGL(k_check_gla_rec, dim3(8), dim3(256), 0, stream, (const unsigned char*)d_ws, (const float*)d_in[I_WA2F], (const float*)d_in[I_BAF], (const float*)d_in[I_WA2B], (const float*)d_in[I_BAB], obuf, 0);
        hipLaunchKernelGGL(k_check_gla_cmp, dim3(RPB * 4), dim3(256), 0, stream, (const unsigned char*)d_ws, (const float*)obuf, (const float*)d_in[I_ONG], 0, flags + 100); }
#endif
      LAUNCH1(7, l); LAUNCH1(8, l); LAUNCH1(9, l); LAUNCH1(10, l);
#if DBG_CHECK == 1
      hipLaunchKernelGGL(k_check_gemm, dim3(32), dim3(256), 0, stream, (const bf16_t*)(W + WS_HB), DM, (const float*)d_in[I_PWQ], DM, DM, (const bf16_t*)(W + WS_PQ), DM, TT, flags + 100);
#endif
      LAUNCH1(11, l);
#if DBG_CHECK == 2
      hipLaunchKernelGGL(k_check_select, dim3(256 * 8), dim3(64), 0, stream, (const bf16_t*)(W + WS_PQ), (const float*)d_in[I_PK1], (const float*)d_in[I_PK2], (const int*)(W + WS_PIDX), (const float*)(W + WS_PG), flags + 100);
#endif
      LAUNCH1(12, l);
#if DBG_CHECK == 3
      hipLaunchKernelGGL(k_check_gather, dim3(128), dim3(64), 0, stream, (const bf16_t*)(W + WS_HB), (const float*)d_in[I_PU], (const float*)d_in[I_PV], (const int*)(W + WS_PIDX), (const float*)(W + WS_PG), (const float*)(W + WS_MQ), flags + 100);
#endif
    }
    hipLaunchKernelGGL(k_dbg_out2, dim3(NBATCH * SEQ / 4), dim3(256), 0, stream, (const float*)d_in[0], (const float*)d_in[29], (float*)d_out, flags + 100);
#else
    LAUNCH1(0, 0);
    for (int l = 0; l < DEPTH; ++l) { LAUNCH1(1, l); LAUNCH1(2, l); LAUNCH1(3, l);
#ifdef DBG_DUP23
        LAUNCH1(2, l); LAUNCH1(3, l);
#endif
        LAUNCH1(4, l); LAUNCH1(5, l);
#ifdef DBG_DUP45
        LAUNCH1(4, l); LAUNCH1(5, l);
#endif
        LAUNCH1(6, l); LAUNCH1(7, l); LAUNCH1(8, l); LAUNCH1(9, l); LAUNCH1(10, l); LAUNCH1(11, l); LAUNCH1(12, l); }
    LAUNCH1(13, DEPTH - 1);
#endif
#undef LAUNCH1
#endif
    const hipError_t le = hipPeekAtLastError();
    if (le != hipSuccess) fprintf(stderr, "kernel_launch: launch failed: %s\n", hipGetErrorName(le));
}
```

```cpp
#include <hip/hip_runtime.h>
#include <cstdio>
#include <cstdint>

#ifndef MK_N_LAUNCHES
#ifndef DBG_DUP
#define DBG_DUP -1
#endif
#define MK_N_LAUNCHES 1
#endif

#ifndef DBG_MIX0
#define DBG_MIX0 1.0f
#define DBG_MIX1 1.0f
#define DBG_PEER0 1.0f
#define DBG_PEER1 1.0f
#endif
#ifndef MLA_NQR
#define MLA_NQR 6
#endif
#define LAS __attribute__((address_space(3)))
#define GLB __attribute__((address_space(1)))
typedef unsigned short bf16_t;
typedef short bf16x8 __attribute__((ext_vector_type(8)));
typedef short s16x4 __attribute__((ext_vector_type(4)));
typedef float f32x4 __attribute__((ext_vector_type(4)));
typedef float f32x2 __attribute__((ext_vector_type(2)));
typedef float f32x16 __attribute__((ext_vector_type(16)));
typedef unsigned u32x4 __attribute__((ext_vector_type(4)));
typedef unsigned u32x2 __attribute__((ext_vector_type(2)));
typedef __bf16 bf2_t __attribute__((ext_vector_type(2)));

constexpr int DM = 2048, NBATCH = 2, SEQ = 8192, CTXL = 256, DEPTH = 2;
constexpr int RPB = SEQ + CTXL;
constexpr int TT = NBATCH * RPB;
constexpr int IN_COLS = 11872, NP = 12032;
constexpr int C_AQ = 0, C_AK = 1024, C_AV = 1280, C_LQ = 1536, C_LK = 2048, C_LV = 2560, C_LG = 3584, C_LRF = 4608, C_LRB = 4624,
              C_MCQ = 4640, C_MCKV = 5152, C_MKR = 5664, C_GA = 5728, C_GL = 7776, C_GM = 9824;
constexpr int NCH = RPB / 64;
constexpr int NEXP = 16384;
constexpr float NORM_EPS = 1e-6f;
constexpr int NTHREADS = 512;

constexpr size_t al256(size_t x) { return (x + 255) / 256 * 256; }
constexpr size_t WS_CTL   = 0;
constexpr size_t CTL_BYTES = 65536;
constexpr size_t WS_MODV  = WS_CTL + CTL_BYTES;
constexpr size_t WS_TABA  = al256(WS_MODV + (size_t)2 * 3 * 12288 * 4);
constexpr size_t WS_TABM  = WS_TABA + 2 * 128 * 32 * 4;
constexpr size_t WS_XS    = al256(WS_TABM + 2 * 128 * 16 * 4);
constexpr size_t WS_HB    = WS_XS + (size_t)TT * DM * 4;
constexpr size_t WS_P     = WS_HB + (size_t)TT * DM * 2;
constexpr size_t WS_MQ    = WS_P + (size_t)TT * NP * 2;
constexpr size_t WS_MKV   = WS_MQ + (size_t)TT * 1536 * 2;
constexpr size_t WS_OA    = WS_MKV + (size_t)TT * 2048 * 2;
constexpr size_t WS_OL    = WS_OA + (size_t)TT * 1024 * 2;
constexpr size_t WS_OM    = WS_OL + (size_t)TT * 1024 * 2;
constexpr size_t WS_WIN   = WS_OM + (size_t)TT * 1024 * 2;
constexpr size_t WS_WUQ   = WS_WIN + (size_t)NP * 2048 * 2;
constexpr size_t WS_WUKV  = WS_WUQ + (size_t)1536 * 512 * 2;
constexpr size_t WS_WBR   = WS_WUKV + (size_t)2048 * 512 * 2;
constexpr size_t WS_WOUT  = WS_WBR + (size_t)3 * 2048 * 1024 * 2;
constexpr size_t WS_WQ    = WS_WOUT + (size_t)2048 * 2048 * 2;
constexpr size_t WS_K1    = WS_WQ + (size_t)2048 * 2048 * 2;
constexpr size_t WS_K2    = WS_K1 + (size_t)8 * 128 * 128 * 2;
constexpr size_t WS_GST   = WS_K2 + (size_t)8 * 128 * 128 * 2;
constexpr size_t WS_GDEC  = WS_GST + (size_t)NBATCH * 2 * 4 * NCH * 32768 * 2;
constexpr size_t WS_END0  = WS_GDEC + (size_t)NBATCH * 2 * 4 * NCH * 128 * 4;
constexpr size_t WS_Y     = WS_MKV;
constexpr size_t WS_PQ    = WS_OA;
constexpr size_t WS_PIDX  = WS_P;
constexpr size_t WS_PG    = WS_PIDX + (size_t)TT * 128 * 4;
constexpr size_t PT_BYTES = 2 * (size_t)NEXP * DM + 2 * (size_t)NEXP * 4;
constexpr size_t WS_WINS  = WS_END0;
constexpr size_t WS_WOUTS = al256(WS_WINS + (size_t)NP * 4);
constexpr size_t WS_PT    = al256(WS_WOUTS + (size_t)DM * 4);
constexpr size_t WS_END   = WS_PT + DEPTH * PT_BYTES;
constexpr size_t PT_U8 = 0, PT_V8 = (size_t)NEXP * DM, PT_SCU = 2 * (size_t)NEXP * DM, PT_SCV = PT_SCU + (size_t)NEXP * 4;
static_assert(WS_PG + (size_t)TT * 128 * 4 <= WS_MQ, "PEER alias region overflows P");

__device__ __forceinline__ unsigned cvt_pk_bf16(float lo, float hi) { bf2_t v; v.x = (__bf16)lo; v.y = (__bf16)hi; return __builtin_bit_cast(unsigned, v); }
__device__ __forceinline__ bf16_t f2bf(float f) { return (bf16_t)(cvt_pk_bf16(f, 0.f) & 0xffffu); }
__device__ __forceinline__ float bf2f(bf16_t b) { return __uint_as_float(((unsigned)b) << 16); }
__device__ __forceinline__ float bflo(unsigned w) { return __uint_as_float(w << 16); }
__device__ __forceinline__ float bfhi(unsigned w) { return __uint_as_float(w & 0xffff0000u); }
__device__ __forceinline__ float xchg32(float x, int lane) { auto r = __builtin_amdgcn_permlane32_swap(__float_as_uint(x), __float_as_uint(x), false, false); return __uint_as_float(lane < 32 ? r[1] : r[0]); }
__device__ __forceinline__ float xchg16(float x, int lane) { auto r = __builtin_amdgcn_permlane16_swap(__float_as_uint(x), __float_as_uint(x), false, false); return __uint_as_float((lane & 16) ? r[0] : r[1]); }
template <int CTRL> __device__ __forceinline__ float dppmov(float x) { return __uint_as_float(__builtin_amdgcn_update_dpp(0u, __float_as_uint(x), CTRL, 0xF, 0xF, false)); }
constexpr int DPP_ROR8 = 0x128, DPP_HMIRROR = 0x141, DPP_Q3210 = 0x1B, DPP_Q1032 = 0xB1;
__device__ __forceinline__ float wave_sum(float v) {
    const int lane = threadIdx.x & 63;
    v += xchg32(v, lane); v += xchg16(v, lane); v += dppmov<DPP_ROR8>(v); v += dppmov<DPP_HMIRROR>(v); v += dppmov<DPP_Q3210>(v); v += dppmov<DPP_Q1032>(v);
    return v;
}
__device__ __forceinline__ float sigmoidf_(float x) { return __builtin_amdgcn_rcpf(1.0f + __expf(-x)); }
__device__ __forceinline__ float siluf_(float x) { return x * __builtin_amdgcn_rcpf(1.0f + __expf(-x)); }

#define XB_TMO      128
#define XB_XCNT(j)  (256  + 64 * (j))
#define XB_XSUB(j)  (1280 + 64 * (j))
#define XB_XGEN(j)  (2304 + 64 * (j))
#define XB_TOP      3328
#define XB_TOPGEN   3392
#define XCD_BAR_WORDS 3456
#define XB_SPIN_CAP (1u << 20)
__device__ __forceinline__ unsigned xb_ld(unsigned* p)              { return __hip_atomic_load(p, __ATOMIC_RELAXED, __HIP_MEMORY_SCOPE_AGENT); }
__device__ __forceinline__ unsigned xb_add(unsigned* p, unsigned v) { return __hip_atomic_fetch_add(p, v, __ATOMIC_RELAXED, __HIP_MEMORY_SCOPE_AGENT); }
__device__ __forceinline__ unsigned xb_xcc_id() { return (unsigned)__builtin_amdgcn_s_getreg((3 << 11) | 20) & 0xFu; }
#define XB_SPIN(cond, bar) do { unsigned _sp = 0; while (cond) { __builtin_amdgcn_s_sleep(1); \
    if ((++_sp & 255u) == 0u) { if (xb_ld(&(bar)[XB_TMO])) break; if (_sp > XB_SPIN_CAP) { atomicAdd(&(bar)[XB_TMO], 1u); break; } } } } while (0)
struct XcdBarrier { unsigned* bar; unsigned x; volatile LAS unsigned* st; };
__device__ __forceinline__ XcdBarrier xcd_barrier_post(unsigned* bar, volatile LAS unsigned* st) {
    XcdBarrier b; b.bar = bar; b.x = xb_xcc_id(); b.st = st;
    if (threadIdx.x == 0) (void)xb_add(&bar[XB_XCNT(b.x)], 1u);
    return b;
}
__device__ __forceinline__ void xcd_barrier_complete(unsigned* bar, unsigned x, unsigned& nloc, unsigned& nx) {
    const unsigned G = gridDim.x * gridDim.y * gridDim.z;
    unsigned sum, cnt, mine, sp = 0u;
    for (;;) {
        sum = 0u; cnt = 0u; mine = 0u;
#pragma unroll
        for (unsigned j = 0; j < 16; ++j) { const unsigned c = xb_ld(&bar[XB_XCNT(j)]); sum += c; cnt += (c > 0u) ? 1u : 0u; mine = (j == x) ? c : mine; }
        if (sum == G) break;
        __builtin_amdgcn_s_sleep(1);
        if ((++sp & 255u) == 0u) { if (xb_ld(&bar[XB_TMO])) break; if (sp > XB_SPIN_CAP) { atomicAdd(&bar[XB_TMO], 1u); break; } }
    }
    nloc = mine > 0u ? mine : 1u; nx = cnt > 0u ? cnt : 1u;
}
__device__ __forceinline__ void xcd_barrier(const XcdBarrier& b) {
    asm volatile("s_waitcnt vmcnt(0)" ::: "memory");
    __syncthreads();
    if (threadIdx.x == 0) {
        unsigned* bar = b.bar;
        __builtin_amdgcn_s_waitcnt(0);
        unsigned nloc = b.st[0], nx = b.st[1];
        if (nloc == 0u) { xcd_barrier_complete(bar, b.x, nloc, nx); b.st[0] = nloc; b.st[1] = nx; }
        const unsigned old = xb_add(&bar[XB_XSUB(b.x)], 1u);
        const unsigned gen = old / nloc;
        if (old + 1u == (gen + 1u) * nloc) {
            __builtin_amdgcn_fence(__ATOMIC_RELEASE, "agent");
            asm volatile("s_waitcnt vmcnt(0)" ::: "memory");
            const unsigned og = xb_add(&bar[XB_TOP], 1u);
            const unsigned tg = og / nx;
            if (og + 1u == (tg + 1u) * nx) xb_add(&bar[XB_TOPGEN], 1u);
            else XB_SPIN(xb_ld(&bar[XB_TOPGEN]) == tg, bar);
            __builtin_amdgcn_fence(__ATOMIC_ACQUIRE, "agent");
            xb_add(&bar[XB_XGEN(b.x)], 1u);
            asm volatile("s_waitcnt vmcnt(0)" ::: "memory");
        } else {
            XB_SPIN(xb_ld(&bar[XB_XGEN(b.x)]) == gen, bar);
            __builtin_amdgcn_fence(__ATOMIC_ACQUIRE, "agent");
            asm volatile("s_waitcnt vmcnt(0)" ::: "memory");
        }
    }
    __syncthreads();
}

namespace pg8 {
constexpr int BM = 256, BK = 64, HALF = 128, HTB = HALF * BK * 2, STAGE_BYTES = 8 * HTB, NXCD = 8, WGM = 8;
__host__ __device__ __forceinline__ int lds_byte(int r, int c) { const int st = (r >> 4) * 2 + (c >> 5), rr = r & 15, cc = c & 31, ob = rr * 64 + cc * 2; return st * 1024 + (ob ^ (((ob >> 9) & 1) << 5)); }
__host__ __device__ __forceinline__ void stage_rc(int b, int& R, int& C) { const int st = b / 1024, sb = b % 1024, swz = sb ^ (((sb >> 9) & 1) << 5); R = (st >> 1) * 16 + swz / 64; C = (st & 1) * 32 + (swz % 64) / 2; }
__host__ __device__ __forceinline__ int perm32(int rho) { const int n = rho >> 4, i = rho & 15; return 8 * (i >> 2) + 4 * n + (i & 3); }
struct Unit { int pm, pn; };
struct Gemm { const bf16_t* A; const bf16_t* Bt; int M, N, K, lda, ldb; };
struct StaticOrder {
    int nM, nN, nwg, G, c, latent;
    __host__ __device__ void init(int M, int N, int G_, int c_, int latent_ = 0) { latent = latent_; nM = latent_ ? 64 : M / BM; nN = N / BM; nwg = nM * nN; G = G_; c = c_; }
    __host__ __device__ bool next(int i, Unit& u) const {
        const long L = (long)i * G + c; if (L >= nwg) return false;
        int wgid = (int)L; { const int q = nwg / NXCD, r = nwg % NXCD, xcd = wgid % NXCD, off = wgid / NXCD; wgid = (xcd < r ? xcd * (q + 1) : r * (q + 1) + (xcd - r) * q) + off; }
        const int nig = WGM * nN, gid = wgid / nig, fm = gid * WGM, gsz = (nM - fm) < WGM ? (nM - fm) : WGM;
        u.pm = fm + ((wgid % nig) % gsz); u.pn = (wgid % nig) / gsz; if (latent) u.pm += 1 + (u.pm >= 32 ? 1 : 0); return true;
    }
};
struct WinOrder {
    StaticOrder S; int full, nlat, G, c;
    __host__ __device__ void init(int G_, int c_, int full_) { full = full_; G = G_; c = c_; S.init(TT, NP, G_, c_, full_ ? 0 : 1); nlat = S.nwg; }
    __host__ __device__ bool next(int i, Unit& u) const {
        if (full) return S.next(i, u);
        const long L = (long)i * G + c;
        if (L < nlat) return S.next(i, u);
        const int q = (int)(L - nlat); if (q >= 24) return false;
        const int t = q % 12; u.pm = q < 12 ? 0 : 33;
        u.pn = t < 2 ? 4 + t : (t < 8 ? 8 + (t - 2) : (t == 8 ? 18 : 20 + (t - 9)));
        return true;
    }
};
struct EpiStoreBf16 {
    static constexpr bool PERM = true;
    bf16_t* O; int ldc;
    __device__ __forceinline__ void operator()(const f32x4 (&acc)[2][2][4][2], const Unit& u, int wr, int wc, int fr, int fq) const {
        const int row0 = u.pm * BM + wr * 64 + fr, col0 = u.pn * BM + wc * 32 + 8 * fq;
#pragma unroll
        for (int ai = 0; ai < 2; ++ai)
#pragma unroll
            for (int m = 0; m < 4; ++m) { bf16_t* rowp = O + (size_t)(row0 + ai * HALF + m * 16) * ldc + col0;
#pragma unroll
                for (int bj = 0; bj < 2; ++bj) { const f32x4 v0 = acc[ai][bj][m][0], v1 = acc[ai][bj][m][1];
                    u32x4 w; w.x = cvt_pk_bf16(v0[0], v0[1]); w.y = cvt_pk_bf16(v0[2], v0[3]); w.z = cvt_pk_bf16(v1[0], v1[1]); w.w = cvt_pk_bf16(v1[2], v1[3]);
                    *(u32x4*)(rowp + bj * HALF) = w; } }
    }
};
struct EpiNull {
    static constexpr bool PERM = true;
    __device__ __forceinline__ void operator()(const f32x4 (&acc)[2][2][4][2], const Unit&, int, int, int, int) const {
#pragma unroll
        for (int a = 0; a < 2; ++a)
#pragma unroll
            for (int b = 0; b < 2; ++b)
#pragma unroll
                for (int m = 0; m < 4; ++m)
#pragma unroll
                    for (int n = 0; n < 2; ++n) asm volatile("" :: "v"(acc[a][b][m][n]));
    }
};
struct EpiStoreBf16S {
    static constexpr bool PERM = true;
    bf16_t* O; int ldc; const float* cs;
    __device__ __forceinline__ void operator()(const f32x4 (&acc)[2][2][4][2], const Unit& u, int wr, int wc, int fr, int fq) const {
        const int row0 = u.pm * BM + wr * 64 + fr, col0 = u.pn * BM + wc * 32 + 8 * fq;
        f32x4 sv[2][2];
#pragma unroll
        for (int bj = 0; bj < 2; ++bj)
#pragma unroll
            for (int n = 0; n < 2; ++n) sv[bj][n] = *(const f32x4*)(cs + col0 + bj * HALF + 4 * n);
#pragma unroll
        for (int ai = 0; ai < 2; ++ai)
#pragma unroll
            for (int m = 0; m < 4; ++m) { bf16_t* rowp = O + (size_t)(row0 + ai * HALF + m * 16) * ldc + col0;
#pragma unroll
                for (int bj = 0; bj < 2; ++bj) { const f32x4 v0 = acc[ai][bj][m][0] * sv[bj][0], v1 = acc[ai][bj][m][1] * sv[bj][1];
                    u32x4 w; w.x = cvt_pk_bf16(v0[0], v0[1]); w.y = cvt_pk_bf16(v0[2], v0[3]); w.z = cvt_pk_bf16(v1[0], v1[1]); w.w = cvt_pk_bf16(v1[2], v1[3]);
                    *(u32x4*)(rowp + bj * HALF) = w; } }
    }
};
template <bool FIRST, bool F8OUT = false> struct EpiGate {
    static constexpr bool PERM = true;
    bf16_t* Y; int ldy; const bf16_t* Gt; int ldg; unsigned char* Y8; int ldy8;
    __device__ __forceinline__ void operator()(const f32x4 (&acc)[2][2][4][2], const Unit& u, int wr, int wc, int fr, int fq) const {
        const int row0 = u.pm * BM + wr * 64 + fr, col0 = u.pn * BM + wc * 32 + 8 * fq;
#pragma unroll
        for (int ai = 0; ai < 2; ++ai)
#pragma unroll
        for (int mh = 0; mh < 2; ++mh) {
            u32x4 g[2][2], y[2][2];
#pragma unroll
            for (int mm = 0; mm < 2; ++mm)
#pragma unroll
                for (int bj = 0; bj < 2; ++bj) { const size_t r = (size_t)(row0 + ai * HALF + (mh * 2 + mm) * 16);
                    g[mm][bj] = *(const u32x4*)(Gt + r * ldg + col0 + bj * HALF);
                    if (!FIRST) y[mm][bj] = *(const u32x4*)(Y + r * ldy + col0 + bj * HALF); }
#pragma unroll
            for (int mm = 0; mm < 2; ++mm)
#pragma unroll
                for (int bj = 0; bj < 2; ++bj) { const int m = mh * 2 + mm; const size_t r = (size_t)(row0 + ai * HALF + m * 16); const f32x4 v0 = acc[ai][bj][m][0], v1 = acc[ai][bj][m][1]; const u32x4 gg = g[mm][bj];
                    float o[8];
                    o[0] = sigmoidf_(bflo(gg.x)) * v0[0]; o[1] = sigmoidf_(bfhi(gg.x)) * v0[1]; o[2] = sigmoidf_(bflo(gg.y)) * v0[2]; o[3] = sigmoidf_(bfhi(gg.y)) * v0[3];
                    o[4] = sigmoidf_(bflo(gg.z)) * v1[0]; o[5] = sigmoidf_(bfhi(gg.z)) * v1[1]; o[6] = sigmoidf_(bflo(gg.w)) * v1[2]; o[7] = sigmoidf_(bfhi(gg.w)) * v1[3];
                    if (!FIRST) { const u32x4 yy = y[mm][bj];
                        o[0] += bflo(yy.x); o[1] += bfhi(yy.x); o[2] += bflo(yy.y); o[3] += bfhi(yy.y); o[4] += bflo(yy.z); o[5] += bfhi(yy.z); o[6] += bflo(yy.w); o[7] += bfhi(yy.w); }
                    if constexpr (F8OUT) { int p0 = __builtin_amdgcn_cvt_pk_fp8_f32(o[0], o[1], 0, false); p0 = __builtin_amdgcn_cvt_pk_fp8_f32(o[2], o[3], p0, true);
                        int p1 = __builtin_amdgcn_cvt_pk_fp8_f32(o[4], o[5], 0, false); p1 = __builtin_amdgcn_cvt_pk_fp8_f32(o[6], o[7], p1, true);
                        u32x2 w8; w8.x = (unsigned)p0; w8.y = (unsigned)p1; *(u32x2*)(Y8 + r * ldy8 + col0 + bj * HALF) = w8; }
                    else { u32x4 w; w.x = cvt_pk_bf16(o[0], o[1]); w.y = cvt_pk_bf16(o[2], o[3]); w.z = cvt_pk_bf16(o[4], o[5]); w.w = cvt_pk_bf16(o[6], o[7]);
                        *(u32x4*)(Y + r * ldy + col0 + bj * HALF) = w; } }
        }
    }
};
template <bool CS> struct EpiResidT {
    static constexpr bool PERM = false;
    float* X; int ldx; const float* gate; const float* cs;
    __device__ __forceinline__ void operator()(const f32x4 (&acc)[2][2][4][2], const Unit& u, int wr, int wc, int fr, int fq) const {
        const int row0 = u.pm * BM + wr * 64 + fr, col0 = u.pn * BM + wc * 32 + 4 * fq;
        const int sel = (u.pm % 33 == 0) ? 2 : (u.pm / 33);
        const float* gp = gate + (size_t)sel * 12288 + col0;
        f32x4 gv[2][2];
#pragma unroll
        for (int bj = 0; bj < 2; ++bj)
#pragma unroll
            for (int n = 0; n < 2; ++n) { gv[bj][n] = *(const f32x4*)(gp + bj * HALF + n * 16); if constexpr (CS) gv[bj][n] = gv[bj][n] * *(const f32x4*)(cs + col0 + bj * HALF + n * 16); }
#pragma unroll
        for (int ai = 0; ai < 2; ++ai)
#pragma unroll
            for (int mh = 0; mh < 2; ++mh) {
                f32x4 x[2][2][2];
#pragma unroll
                for (int mm = 0; mm < 2; ++mm)
#pragma unroll
                    for (int bj = 0; bj < 2; ++bj)
#pragma unroll
                        for (int n = 0; n < 2; ++n) x[mm][bj][n] = *(const f32x4*)(X + (size_t)(row0 + ai * HALF + (mh * 2 + mm) * 16) * ldx + col0 + bj * HALF + n * 16);
#pragma unroll
                for (int mm = 0; mm < 2; ++mm)
#pragma unroll
                    for (int bj = 0; bj < 2; ++bj)
#pragma unroll
                        for (int n = 0; n < 2; ++n) *(f32x4*)(X + (size_t)(row0 + ai * HALF + (mh * 2 + mm) * 16) * ldx + col0 + bj * HALF + n * 16) = x[mm][bj][n] + gv[bj][n] * acc[ai][bj][mh * 2 + mm][n];
            }
    }
};

typedef int i32x8 __attribute__((ext_vector_type(8)));
typedef int i32x4 __attribute__((ext_vector_type(4)));
__device__ __forceinline__ i32x8 cat8(const bf16x8 lo, const bf16x8 hi) { const i32x4 a = __builtin_bit_cast(i32x4, lo), b = __builtin_bit_cast(i32x4, hi); return __builtin_shufflevector(a, b, 0, 1, 2, 3, 4, 5, 6, 7); }
template <class Epi, class Sched, int F8 = 0>
__device__ __forceinline__ void gemm_phase(LAS unsigned char* lds, const int tid, const Gemm g, const Sched& S, const Epi& E) {
    const int wid = __builtin_amdgcn_readfirstlane(tid >> 6), lane = tid & 63, wr = wid >> 2, wc = wid & 3, fr = lane & 15, fq = lane >> 4;
    const int K = g.K, nt = F8 ? K / 128 : K / BK, lda = g.lda, ldb = g.ldb;
    unsigned voffA[2], voffB[2];
#pragma unroll
    for (int i = 0; i < 2; ++i) { int R, C; stage_rc(tid * 16 + i * 8192, R, C); const int Rb = Epi::PERM ? ((R & ~31) + perm32(R & 31)) : R;
        voffA[i] = F8 ? (unsigned)(R * lda + C * 2) : (unsigned)(R * lda + C) * 2u; voffB[i] = F8 ? (unsigned)(Rb * ldb + C * 2) : (unsigned)(Rb * ldb + C) * 2u; }
    const size_t kstep = (size_t)(BK * 2);
    const size_t hstepA = (size_t)HALF * lda * (F8 ? 1 : 2), hstepB = (size_t)HALF * ldb * (F8 ? 1 : 2);
    const size_t tstepA = 2 * hstepA, tstepB = 2 * hstepB;
    const unsigned ldsw = (unsigned)wid * 1024u;
    const int aoff = F8 ? lds_byte(wr * 64 + fr, (fq & 1) * 16) + (fq >> 1) * 1024 : lds_byte(wr * 64 + fr, fq * 8);
    const int boff = F8 ? lds_byte(wc * 32 + fr, (fq & 1) * 16) + (fq >> 1) * 1024 : lds_byte(wc * 32 + fr, fq * 8);
#define PG8_SA(b, h) (((b) * 2 + (h)) * HTB)
#define PG8_SB(b, h) ((4 + (b) * 2 + (h)) * HTB)
#define PG8_STAGE(bufoff, gbase, voff) do { _Pragma("unroll") for (int _i = 0; _i < 2; ++_i) \
        __builtin_amdgcn_global_load_lds((const unsigned*)((const char*)(gbase) + (voff)[_i]), (LAS unsigned*)(lds + (bufoff) + ldsw + _i * 8192), 16, 0, 0); } while (0)
#define PG8_LDA(dst, b, h) do { if constexpr (F8) { _Pragma("unroll") for (int m = 0; m < 4; ++m) { const LAS unsigned char* p_ = lds + PG8_SA(b, h) + aoff + m * 2048; \
            const i32x4 lo_ = *(const LAS i32x4*)p_, hi_ = *(const LAS i32x4*)(p_ + 16); dst##8[m] = __builtin_shufflevector(lo_, hi_, 0, 1, 2, 3, 4, 5, 6, 7); } } \
        else { _Pragma("unroll") for (int m = 0; m < 4; ++m) _Pragma("unroll") for (int k = 0; k < 2; ++k) dst[m][k] = *(const LAS bf16x8*)(lds + PG8_SA(b, h) + aoff + m * 2048 + k * 1024); } } while (0)
#define PG8_LDB(dst, b, h) do { if constexpr (F8) { _Pragma("unroll") for (int n = 0; n < 2; ++n) { const LAS unsigned char* p_ = lds + PG8_SB(b, h) + boff + n * 2048; \
            const i32x4 lo_ = *(const LAS i32x4*)p_, hi_ = *(const LAS i32x4*)(p_ + 16); dst##8[n] = __builtin_shufflevector(lo_, hi_, 0, 1, 2, 3, 4, 5, 6, 7); } } \
        else { _Pragma("unroll") for (int n = 0; n < 2; ++n) _Pragma("unroll") for (int k = 0; k < 2; ++k) dst[n][k] = *(const LAS bf16x8*)(lds + PG8_SB(b, h) + boff + n * 2048 + k * 1024); } } while (0)
#define PG8_MMA(ai, bj, At, Bt) do { __builtin_amdgcn_s_setprio(1); \
        if constexpr (F8) { _Pragma("unroll") for (int m = 0; m < 4; ++m) _Pragma("unroll") for (int n = 0; n < 2; ++n) \
            asm volatile("v_mfma_scale_f32_16x16x128_f8f6f4 %0, %1, %2, %0, %3, %3 op_sel_hi:[0,0,0]" : "+v"(acc[ai][bj][m][n]) : "v"(Bt##8[n]), "v"(At##8[m]), "v"(mxscale)); } \
        else { _Pragma("unroll") for (int m = 0; m < 4; ++m) _Pragma("unroll") for (int n = 0; n < 2; ++n) _Pragma("unroll") for (int k = 0; k < 2; ++k) \
            acc[ai][bj][m][n] = __builtin_amdgcn_mfma_f32_16x16x32_bf16(Bt[n][k], At[m][k], acc[ai][bj][m][n], 0, 0, 0); } \
        __builtin_amdgcn_s_setprio(0); } while (0)
#define PG8_WAIT_V(n) asm volatile("s_waitcnt vmcnt(" #n ")" ::: "memory")
#define PG8_WAIT_L(n) asm volatile("s_waitcnt lgkmcnt(" #n ")" ::: "memory")
#define PG8_BAR __builtin_amdgcn_s_barrier()
#define PG8_SCHED __builtin_amdgcn_sched_barrier(0)
    Unit cur, nxt; int ui = 0;
    if (!S.next(0, cur)) return;
    f32x4 acc[2][2][4][2];
#pragma unroll
    for (int a = 0; a < 2; ++a)
#pragma unroll
        for (int b = 0; b < 2; ++b)
#pragma unroll
            for (int m = 0; m < 4; ++m)
#pragma unroll
                for (int n = 0; n < 2; ++n) acc[a][b][m][n] = (f32x4){0.f, 0.f, 0.f, 0.f};
    int mxscale = 0x7f7f7f7f; asm volatile("" : "+v"(mxscale));
    bf16x8 At[4][2], B0[2][2], B1[2][2]; i32x8 At8[4], B08[2], B18[2];
    const char* cA = (const char*)g.A + (size_t)cur.pm * tstepA; const char* cB = (const char*)g.Bt + (size_t)cur.pn * tstepB;
    PG8_STAGE(PG8_SB(0, 0), cB, voffB); PG8_STAGE(PG8_SA(0, 0), cA, voffA); PG8_STAGE(PG8_SB(0, 1), cB + hstepB, voffB); PG8_STAGE(PG8_SA(0, 1), cA + hstepA, voffA);
    if (wr == 1) PG8_BAR;
    PG8_WAIT_V(4); PG8_BAR;
    PG8_STAGE(PG8_SB(1, 0), cB + kstep, voffB); PG8_STAGE(PG8_SA(1, 0), cA + kstep, voffA); PG8_STAGE(PG8_SB(1, 1), cB + hstepB + kstep, voffB);
    PG8_WAIT_V(6); PG8_BAR;
    for (;;) {
        const bool has_next = S.next(ui + 1, nxt);
        const char* nA = has_next ? (const char*)g.A + (size_t)nxt.pm * tstepA : cA; const char* nB = has_next ? (const char*)g.Bt + (size_t)nxt.pn * tstepB : cB;
        for (int t = 0; t < nt; t += 2) {
            const bool last = (t == nt - 2);
            const char* a1 = cA + (size_t)(t + 1) * kstep;
            const char* a2 = last ? nA : cA + (size_t)(t + 2) * kstep; const char* b2 = last ? nB : cB + (size_t)(t + 2) * kstep;
            const char* a3 = a2 + kstep; const char* b3 = b2 + kstep;
            PG8_LDB(B0, 0, 0); PG8_SCHED; PG8_LDA(At, 0, 0); PG8_STAGE(PG8_SA(1, 1), a1 + hstepA, voffA);
            PG8_WAIT_L(8); PG8_BAR; PG8_WAIT_L(0); PG8_MMA(0, 0, At, B0); PG8_BAR; PG8_SCHED;
            PG8_LDB(B1, 0, 1); PG8_STAGE(PG8_SB(0, 0), b2, voffB);
            PG8_BAR; PG8_WAIT_L(0); PG8_MMA(0, 1, At, B1); PG8_BAR;
            PG8_LDA(At, 0, 1); PG8_STAGE(PG8_SA(0, 0), a2, voffA);
            PG8_BAR; PG8_WAIT_L(0); PG8_MMA(1, 0, At, B0); PG8_BAR; PG8_SCHED;
            PG8_STAGE(PG8_SB(0, 1), b2 + hstepB, voffB);
            PG8_WAIT_V(6); PG8_BAR; PG8_MMA(1, 1, At, B1); PG8_BAR;
            PG8_LDB(B0, 1, 0); PG8_SCHED; PG8_LDA(At, 1, 0); PG8_STAGE(PG8_SA(0, 1), a2 + hstepA, voffA);
            PG8_WAIT_L(8); PG8_BAR; PG8_WAIT_L(0); PG8_MMA(0, 0, At, B0); PG8_BAR; PG8_SCHED;
            PG8_LDB(B1, 1, 1); PG8_STAGE(PG8_SB(1, 0), b3, voffB);
            PG8_BAR; PG8_WAIT_L(0); PG8_MMA(0, 1, At, B1); PG8_BAR;
            PG8_LDA(At, 1, 1); PG8_STAGE(PG8_SA(1, 0), a3, voffA);
            PG8_BAR; PG8_WAIT_L(0); PG8_MMA(1, 0, At, B0); PG8_BAR; PG8_SCHED;
            PG8_STAGE(PG8_SB(1, 1), b3 + hstepB, voffB);
            PG8_WAIT_V(6); PG8_BAR; PG8_MMA(1, 1, At, B1); PG8_BAR;
        }
        if constexpr (F8) asm volatile("s_nop 15\n\ts_nop 7");
        E(acc, cur, wr, wc, fr, fq);
        if (!has_next) break;
#pragma unroll
        for (int a = 0; a < 2; ++a)
#pragma unroll
            for (int b = 0; b < 2; ++b)
#pragma unroll
                for (int m = 0; m < 4; ++m)
#pragma unroll
                    for (int n = 0; n < 2; ++n) acc[a][b][m][n] = (f32x4){0.f, 0.f, 0.f, 0.f};
        cur = nxt; cA = nA; cB = nB; ++ui;
    }
    PG8_WAIT_V(0);
    if (wr == 0) PG8_BAR;
    PG8_BAR;
#undef PG8_SA
#undef PG8_SB
#undef PG8_STAGE
#undef PG8_LDA
#undef PG8_LDB
#undef PG8_MMA
#undef PG8_WAIT_V
#undef PG8_WAIT_L
#undef PG8_BAR
#undef PG8_SCHED
}
}

struct Args { const float* in[30]; float* out; unsigned char* ws; int ph_lo, ph_hi; };
enum { I_X = 0, I_C, I_CTX, I_CCTX, I_WMOD, I_BMOD, I_N1G, I_WIN, I_QNG, I_KNG, I_WA2F, I_BAF, I_WA2B, I_BAB, I_ONG, I_MQNG, I_WUQ, I_MKVNG, I_WUKV,
       I_WBRA, I_WBRL, I_WBRM, I_WOUT, I_N2G, I_PWQ, I_PK1, I_PK2, I_PU, I_PV, I_FG };
typedef const float* cfp_t;
struct Ctx {
    const __attribute__((address_space(4))) cfp_t* in; float* out; unsigned char* ws; LAS unsigned char* lds;
    int tid, lane, wid, G, bid;
};
#define WSP(T, off) ((T*)(C.ws + (off)))
#define INP(i) ((const float*)(const GLB float*)C.in[(i)])
__device__ __forceinline__ unsigned long long launder_u64(unsigned long long w) {
    unsigned lo = (unsigned)w, hi = (unsigned)(w >> 32); asm volatile("" : "+v"(lo), "+v"(hi));
    lo = __builtin_amdgcn_readfirstlane(lo); hi = __builtin_amdgcn_readfirstlane(hi); return ((unsigned long long)hi << 32) | lo;
}
__device__ __forceinline__ Ctx launder(const Ctx& C0) {
    Ctx R = C0; int t = C0.tid; asm volatile("" : "+v"(t)); R.tid = t; R.lane = t & 63; R.wid = __builtin_amdgcn_readfirstlane(t >> 6);
    R.ws = (unsigned char*)(GLB unsigned char*)launder_u64((unsigned long long)C0.ws);
    R.out = (float*)(GLB float*)(unsigned long long)C0.out;
    R.in = (const __attribute__((address_space(4))) cfp_t*)launder_u64((unsigned long long)C0.in);
    unsigned l = (unsigned)(uintptr_t)C0.lds; asm volatile("" : "+v"(l)); l = __builtin_amdgcn_readfirstlane(l); R.lds = (LAS unsigned char*)(uintptr_t)l;
    return R;
}

__device__ __forceinline__ const float* src_row(const Ctx& C, int r) {
    const int b = r / RPB, j = r % RPB;
    return j < CTXL ? INP(I_CTX) + ((size_t)b * CTXL + j) * DM : INP(I_X) + ((size_t)b * SEQ + (j - CTXL)) * DM;
}
__device__ __forceinline__ int mod_sel(int r) { const int b = r / RPB, j = r % RPB; return j < CTXL ? 2 : b; }

__device__ __forceinline__ void phase_modv(const Ctx& C) {
    LAS float* sc = (LAS float*)C.lds;
    LAS float* red = (LAS float*)(C.lds + 3 * 2048 * 4);
    for (int i = C.tid; i < 3 * DM; i += NTHREADS) { const int r = i / DM, k = i % DM; const float v = r < 2 ? INP(I_C)[r * DM + k] : INP(I_CCTX)[k]; sc[i] = siluf_(v); }
    __syncthreads();
    float* modv = WSP(float, WS_MODV);
    const int kq = C.tid / 12, c4 = C.tid % 12;
    for (int item = C.bid; item < 2 * 256; item += C.G) {
        const int l = item / 256, cg = item % 256;
        float acc[3][4];
#pragma unroll
        for (int r = 0; r < 3; ++r)
#pragma unroll
            for (int j = 0; j < 4; ++j) acc[r][j] = 0.f;
        if (kq < 42) {
            const float* wp = INP(I_WMOD) + (size_t)l * DM * 12288 + 48 * cg + 4 * c4;
#pragma unroll 1
            for (int k0 = kq; k0 < DM; k0 += 42 * 7) {
                f32x4 w[7];
#pragma unroll
                for (int u = 0; u < 7; ++u) { const int k = k0 + 42 * u; w[u] = k < DM ? *(const f32x4*)(wp + (size_t)k * 12288) : (f32x4){0.f, 0.f, 0.f, 0.f}; }
#pragma unroll
                for (int u = 0; u < 7; ++u) { const int k = k0 + 42 * u; if (k < DM) {
#pragma unroll
                    for (int r = 0; r < 3; ++r) { const float sv = sc[r * DM + k];
#pragma unroll
                        for (int j = 0; j < 4; ++j) acc[r][j] += sv * w[u][j]; } } }
            }
#pragma unroll
            for (int r = 0; r < 3; ++r)
#pragma unroll
                for (int j = 0; j < 4; ++j) red[kq * 144 + r * 48 + c4 * 4 + j] = acc[r][j];
        }
        __syncthreads();
        if (C.tid < 144) { float s = 0.f; for (int q = 0; q < 42; ++q) s += red[q * 144 + C.tid];
            const int r = C.tid / 48, cc = C.tid % 48;
            modv[((size_t)l * 3 + r) * 12288 + 48 * cg + cc] = s + INP(I_BMOD)[(size_t)l * 12288 + 48 * cg + cc]; }
        __syncthreads();
    }
}
__device__ __forceinline__ void phase_tables(const Ctx& C) {
    float* ta = WSP(float, WS_TABA); float* tm = WSP(float, WS_TABM);
    for (int i = C.bid * NTHREADS + C.tid; i < 128 * 32 + 128 * 16; i += C.G * NTHREADS) {
        if (i < 128 * 32) { const int pos = i / 32, f = i % 32; const float inv = exp2f(-(float)f * (13.287712379549449f / 32.0f)); const float a = (float)pos * inv;
            ta[i] = cosf(a); ta[128 * 32 + i] = sinf(a); }
        else { const int k = i - 128 * 32, pos = k / 16, f = k % 16; const float inv = exp2f(-(float)f * (13.287712379549449f / 16.0f)); const float a = (float)pos * inv;
            tm[k] = cosf(a); tm[128 * 16 + k] = sinf(a); }
    }
}
__device__ __forceinline__ void transpose_cvt(const Ctx& C, const float* src, int K, int N, bf16_t* dst, int Npad, int& item) {
    LAS float* tile = (LAS float*)C.lds;
    const int tk = K / 64, tn = Npad / 256, ntile = tk * tn;
    const int t0 = ((C.bid - item % C.G) + C.G) % C.G; item += ntile;
    for (int t = t0; t < ntile; t += C.G) {
        const int k0 = (t / tn) * 64, n0 = (t % tn) * 256;
        const int nn = (C.tid & 63) * 4, kr = C.tid >> 6;
        f32x4 v[8];
#pragma unroll
        for (int p = 0; p < 8; ++p) { v[p] = (f32x4){0.f, 0.f, 0.f, 0.f}; if (n0 + nn < N) v[p] = *(const f32x4*)(src + (size_t)(k0 + kr + p * 8) * N + n0 + nn); }
#pragma unroll
        for (int p = 0; p < 8; ++p)
#pragma unroll
            for (int j = 0; j < 4; ++j) tile[(kr + p * 8) * 257 + nn + j] = v[p][j];
        __syncthreads();
        { const int n = C.tid >> 1, kh = (C.tid & 1) * 32;
#pragma unroll
          for (int q = 0; q < 4; ++q) { float x[8];
#pragma unroll
              for (int j = 0; j < 8; ++j) x[j] = tile[(kh + q * 8 + j) * 257 + n];
              u32x4 w; w.x = cvt_pk_bf16(x[0], x[1]); w.y = cvt_pk_bf16(x[2], x[3]); w.z = cvt_pk_bf16(x[4], x[5]); w.w = cvt_pk_bf16(x[6], x[7]);
              *(u32x4*)(dst + (size_t)(n0 + n) * K + k0 + kh + q * 8) = w; } }
        __syncthreads();
    }
}
__device__ __forceinline__ void transpose_cvt_fp8(const Ctx& C, const float* src, int K, int N, unsigned char* dst, int Npad, float* cinv) {
    LAS float* tile = (LAS float*)C.lds;
    LAS float* red = (LAS float*)(C.lds + 64 * 65 * 4);
    LAS float* scl = red + 32 * 64;
    const int kk = C.tid >> 4, nn = (C.tid & 15) * 4;
    for (int cgp = C.bid; cgp < Npad / 64; cgp += C.G) {
        const int n0 = cgp * 64; const bool live = n0 + nn < N;
        float am[4] = {0.f, 0.f, 0.f, 0.f};
        for (int k0 = 0; k0 < K; k0 += 128) {
            f32x4 v[4];
#pragma unroll
            for (int p = 0; p < 4; ++p) v[p] = live ? *(const f32x4*)(src + (size_t)(k0 + kk + p * 32) * N + n0 + nn) : (f32x4){0.f, 0.f, 0.f, 0.f};
#pragma unroll
            for (int p = 0; p < 4; ++p)
#pragma unroll
                for (int j = 0; j < 4; ++j) am[j] = fmaxf(am[j], fabsf(v[p][j])); }
#pragma unroll
        for (int j = 0; j < 4; ++j) red[kk * 64 + nn + j] = am[j];
        __syncthreads();
        if (C.tid < 64) { float m = 0.f; for (int q = 0; q < 32; ++q) m = fmaxf(m, red[q * 64 + C.tid]);
            scl[C.tid] = m > 0.f ? 224.0f / m : 1.0f; cinv[n0 + C.tid] = m > 0.f ? m * (1.0f / 224.0f) : 1.0f; }
        __syncthreads();
        for (int k0 = 0; k0 < K; k0 += 64) {
#pragma unroll
            for (int p = 0; p < 2; ++p) { const f32x4 v = live ? *(const f32x4*)(src + (size_t)(k0 + kk + p * 32) * N + n0 + nn) : (f32x4){0.f, 0.f, 0.f, 0.f};
#pragma unroll
                for (int j = 0; j < 4; ++j) tile[(kk + p * 32) * 65 + nn + j] = v[j]; }
            __syncthreads();
            { const int n = C.tid >> 3, k8 = (C.tid & 7) * 8; const float sc = scl[n]; float x[8];
#pragma unroll
              for (int j = 0; j < 8; ++j) x[j] = tile[(k8 + j) * 65 + n] * sc;
              int p0 = __builtin_amdgcn_cvt_pk_fp8_f32(x[0], x[1], 0, false); p0 = __builtin_amdgcn_cvt_pk_fp8_f32(x[2], x[3], p0, true);
              int p1 = __builtin_amdgcn_cvt_pk_fp8_f32(x[4], x[5], 0, false); p1 = __builtin_amdgcn_cvt_pk_fp8_f32(x[6], x[7], p1, true);
              u32x2 w; w.x = (unsigned)p0; w.y = (unsigned)p1; *(u32x2*)(dst + (size_t)(n0 + n) * K + k0 + k8) = w; }
            __syncthreads();
        }
    }
}
__device__ __forceinline__ void cvt_plain(const Ctx& C, const float* src, bf16_t* dst, size_t n8) {
    for (size_t i = (size_t)C.bid * NTHREADS + C.tid; i < n8; i += (size_t)C.G * NTHREADS) {
        const f32x4 a = *(const f32x4*)(src + i * 8), b = *(const f32x4*)(src + i * 8 + 4);
        u32x4 w; w.x = cvt_pk_bf16(a[0], a[1]); w.y = cvt_pk_bf16(a[2], a[3]); w.z = cvt_pk_bf16(b[0], b[1]); w.w = cvt_pk_bf16(b[2], b[3]);
        *(u32x4*)(dst + i * 8) = w;
    }
}
__device__ __forceinline__ void phase_cvt_mixer_weights(const Ctx& C, int l) {
    int item = 0;
    transpose_cvt_fp8(C, INP(I_WIN) + (size_t)l * DM * IN_COLS, DM, IN_COLS, C.ws + WS_WIN, NP, WSP(float, WS_WINS));
    __syncthreads();
    transpose_cvt(C, INP(I_WUQ) + (size_t)l * 512 * 1536, 512, 1536, WSP(bf16_t, WS_WUQ), 1536, item);
    transpose_cvt(C, INP(I_WUKV) + (size_t)l * 512 * 2048, 512, 2048, WSP(bf16_t, WS_WUKV), 2048, item);
    transpose_cvt(C, INP(I_WBRA) + (size_t)l * 1024 * 2048, 1024, 2048, WSP(bf16_t, WS_WBR), 2048, item);
    transpose_cvt(C, INP(I_WBRL) + (size_t)l * 1024 * 2048, 1024, 2048, WSP(bf16_t, WS_WBR) + (size_t)2048 * 1024, 2048, item);
    transpose_cvt(C, INP(I_WBRM) + (size_t)l * 1024 * 2048, 1024, 2048, WSP(bf16_t, WS_WBR) + (size_t)2 * 2048 * 1024, 2048, item);
    transpose_cvt_fp8(C, INP(I_WOUT) + (size_t)l * 2048 * 2048, 2048, 2048, C.ws + WS_WOUT, 2048, WSP(float, WS_WOUTS));
    __syncthreads();
    transpose_cvt(C, INP(I_PWQ) + (size_t)l * 2048 * 2048, 2048, 2048, WSP(bf16_t, WS_WQ), 2048, item);
    cvt_plain(C, INP(I_PK1) + (size_t)l * 8 * 128 * 128, WSP(bf16_t, WS_K1), 8 * 128 * 128 / 8);
    cvt_plain(C, INP(I_PK2) + (size_t)l * 8 * 128 * 128, WSP(bf16_t, WS_K2), 8 * 128 * 128 / 8);
}
__device__ __forceinline__ void phase_cvt_peer_tables(const Ctx& C, int l, int row_lo, int row_hi, int wg_lo) {
    const int lane = C.lane; if (C.bid < wg_lo) return;
    unsigned char* pt = C.ws + WS_PT + (size_t)l * PT_BYTES;
    for (int row = row_lo + (C.bid - wg_lo) * 8 + C.wid; row < row_hi; row += (C.G - wg_lo) * 8) {
#pragma unroll 1
        for (int tb = 0; tb < 2; ++tb) {
            const float* src = (tb ? INP(I_PV) : INP(I_PU)) + ((size_t)l * NEXP + row) * DM + lane * 16;
            f32x4 x[8]; float amax = 0.f;
#pragma unroll
            for (int c = 0; c < 2; ++c)
#pragma unroll
                for (int q = 0; q < 4; ++q) { x[c * 4 + q] = *(const f32x4*)(src + c * 1024 + q * 4);
                    amax = fmaxf(amax, fmaxf(fmaxf(fabsf(x[c * 4 + q][0]), fabsf(x[c * 4 + q][1])), fmaxf(fabsf(x[c * 4 + q][2]), fabsf(x[c * 4 + q][3])))); }
            amax = fmaxf(amax, xchg32(amax, lane)); amax = fmaxf(amax, xchg16(amax, lane)); amax = fmaxf(amax, dppmov<DPP_ROR8>(amax));
            amax = fmaxf(amax, dppmov<DPP_HMIRROR>(amax)); amax = fmaxf(amax, dppmov<DPP_Q3210>(amax)); amax = fmaxf(amax, dppmov<DPP_Q1032>(amax));
            const float sc = amax > 0.f ? 224.0f / amax : 1.0f, inv = amax > 0.f ? amax * (1.0f / 224.0f) : 1.0f;
            unsigned char* dst = pt + (tb ? PT_V8 : PT_U8) + (size_t)(lane >> 3) * ((size_t)NEXP * 128) + (size_t)row * 128 + (lane & 7) * 16;
#pragma unroll
            for (int c = 0; c < 2; ++c) { u32x4 w;
#pragma unroll
                for (int q = 0; q < 4; ++q) { const f32x4 v = x[c * 4 + q] * sc; int p = __builtin_amdgcn_cvt_pk_fp8_f32(v[0], v[1], 0, false); p = __builtin_amdgcn_cvt_pk_fp8_f32(v[2], v[3], p, true); w[q] = (unsigned)p; }
                *(u32x4*)(dst + (size_t)c * 8 * ((size_t)NEXP * 128)) = w; }
            if (lane == 0) ((float*)(pt + (tb ? PT_SCV : PT_SCU)))[row] = inv;
        }
    }
}

template <bool FIRST, bool F8OUT = false> __device__ __forceinline__ void phase_norm_mod(const Ctx& C, const float* gvec, const float* modl  , int shift_off, int scale_off) {
    float* xs = WSP(float, WS_XS); bf16_t* hb = WSP(bf16_t, WS_HB);
    for (int r = C.bid * 8 + C.wid; r < TT; r += C.G * 8) {
        const float* xr = FIRST ? src_row(C, r) : xs + (size_t)r * DM;
        const float* mv = modl + (size_t)mod_sel(r) * 12288;
        f32x4 v[8]; float ss = 0.f;
#pragma unroll
        for (int c = 0; c < 4; ++c) { v[2 * c] = *(const f32x4*)(xr + c * 512 + C.lane * 8); v[2 * c + 1] = *(const f32x4*)(xr + c * 512 + C.lane * 8 + 4); }
#pragma unroll
        for (int c = 0; c < 8; ++c) ss += v[c][0] * v[c][0] + v[c][1] * v[c][1] + v[c][2] * v[c][2] + v[c][3] * v[c][3];
        ss = wave_sum(ss);
        const float rs = rsqrtf(ss * (1.0f / DM) + NORM_EPS);
#pragma unroll
        for (int c = 0; c < 4; ++c) { const int col = c * 512 + C.lane * 8;
            if (FIRST) { *(f32x4*)(xs + (size_t)r * DM + col) = v[2 * c]; *(f32x4*)(xs + (size_t)r * DM + col + 4) = v[2 * c + 1]; }
            float o[8];
#pragma unroll
            for (int h = 0; h < 2; ++h) { const f32x4 g = *(const f32x4*)(gvec + col + 4 * h), s = *(const f32x4*)(mv + scale_off + col + 4 * h), t = *(const f32x4*)(mv + shift_off + col + 4 * h);
#pragma unroll
                for (int j = 0; j < 4; ++j) o[4 * h + j] = v[2 * c + h][j] * rs * g[j] * (1.0f + s[j]) + t[j]; }
            if constexpr (F8OUT) {
                int p0 = __builtin_amdgcn_cvt_pk_fp8_f32(o[0], o[1], 0, false); p0 = __builtin_amdgcn_cvt_pk_fp8_f32(o[2], o[3], p0, true);
                int p1 = __builtin_amdgcn_cvt_pk_fp8_f32(o[4], o[5], 0, false); p1 = __builtin_amdgcn_cvt_pk_fp8_f32(o[6], o[7], p1, true);
                u32x2 w; w.x = (unsigned)p0; w.y = (unsigned)p1; *(u32x2*)((unsigned char*)hb + (size_t)r * DM + col) = w;
            } else {
            u32x4 w; w.x = cvt_pk_bf16(o[0], o[1]); w.y = cvt_pk_bf16(o[2], o[3]); w.z = cvt_pk_bf16(o[4], o[5]); w.w = cvt_pk_bf16(o[6], o[7]);
            *(u32x4*)(hb + (size_t)r * DM + col) = w; } }
    }
}

__device__ __forceinline__ void phase_post_p(const Ctx& C, int l) {
    bf16_t* P = WSP(bf16_t, WS_P); const float* ta = WSP(float, WS_TABA); const float* tm = WSP(float, WS_TABM);
    const float* qg = INP(I_QNG) + l * 128; const float* kg = INP(I_KNG) + l * 128;
    const float* mqg = INP(I_MQNG) + l * 512; const float* mkvg = INP(I_MKVNG) + l * 512;
    const int lane = C.lane;
    const float qg1 = qg[lane], qg2 = qg[lane + 64], kg1 = kg[lane], kg2 = kg[lane + 64];
    for (int r = C.bid * 8 + C.wid; r < TT; r += C.G * 8) {
        bf16_t* pr = P + (size_t)r * NP;
        const int j = r % RPB; const bool lat = j >= CTXL; const int pos = lat ? j - CTXL : 0, ri = pos >> 6, ci = pos & 63;
        float cs = 1.f, sn = 0.f;
        if (lat) { const int p = lane < 32 ? ri : ci, f = lane & 31; cs = ta[p * 32 + f]; sn = ta[128 * 32 + p * 32 + f]; }
#pragma unroll
        for (int h = 0; h < 10; ++h) {
            bf16_t* hp = pr + (h < 8 ? C_AQ + h * 128 : C_AK + (h - 8) * 128);
            const float x1 = bf2f(hp[lane]), x2 = bf2f(hp[lane + 64]);
            const float ss = wave_sum(x1 * x1 + x2 * x2);
            const float rs = rsqrtf(ss * (1.0f / 128.0f) + NORM_EPS);
            const float y1 = x1 * rs * (h < 8 ? qg1 : kg1), y2 = x2 * rs * (h < 8 ? qg2 : kg2);
            hp[lane] = f2bf(y1 * cs - y2 * sn); hp[lane + 64] = f2bf(y2 * cs + y1 * sn);
        }
#pragma unroll
        for (int s = 0; s < 2; ++s) {
            bf16_t* sp = pr + (s == 0 ? C_MCQ : C_MCKV) + lane * 8; const float* gg = (s == 0 ? mqg : mkvg) + lane * 8;
            const u32x4 w = *(const u32x4*)sp; float x[8] = {bflo(w.x), bfhi(w.x), bflo(w.y), bfhi(w.y), bflo(w.z), bfhi(w.z), bflo(w.w), bfhi(w.w)};
            float ss = 0.f;
#pragma unroll
            for (int i = 0; i < 8; ++i) ss += x[i] * x[i];
            ss = wave_sum(ss);
            const float rs = rsqrtf(ss * (1.0f / 512.0f) + NORM_EPS);
#pragma unroll
            for (int i = 0; i < 8; ++i) x[i] = x[i] * rs * gg[i];
            u32x4 o; o.x = cvt_pk_bf16(x[0], x[1]); o.y = cvt_pk_bf16(x[2], x[3]); o.z = cvt_pk_bf16(x[4], x[5]); o.w = cvt_pk_bf16(x[6], x[7]);
            *(u32x4*)sp = o;
        }
        if (lat) { bf16_t* kp = pr + C_MKR; const int i = lane & 31; const float x1 = bf2f(kp[i]), x2 = bf2f(kp[i + 32]);
            const int p = i < 16 ? ri : ci, f = i & 15; const float c2 = tm[p * 16 + f], s2 = tm[128 * 16 + p * 16 + f];
            if (lane < 32) { kp[i] = f2bf(x1 * c2 - x2 * s2); kp[i + 32] = f2bf(x2 * c2 + x1 * s2); } }
    }
}

namespace att {
constexpr int NW = 8, QBLK = 32, KVBLK = 64, DV = 128;
constexpr float THR = 8.f;
#define SBAR() __builtin_amdgcn_sched_barrier(0)
__device__ __forceinline__ int crow(int r, int hi) { return (r & 3) + 8 * (r >> 2) + 4 * hi; }
template <int DQ> struct Cf {
    static constexpr int ND0 = DQ / 16, KROWB = DQ * 2, SHM_K = KVBLK * DQ * 2, SHM_V = KVBLK * DV * 2, SHM = 2 * SHM_V + 2 * SHM_K + NW * 64 * 4;
    static constexpr float SCALE = DQ == 128 ? 0.088388347648318440f : 0.072168783648703220f;
    __device__ static __forceinline__ int kswz(int row, int colB) { return row * KROWB + (colB ^ ((row & 7) << 4)); }
};
template <int DQ, int VAR = 0> __device__ __forceinline__ void partialSM(f32x16& p0, f32x16& p1, float& m_reg, float& mn, float& alpha) {
    constexpr float SC = Cf<DQ>::SCALE, Cc = SC * 1.4426950408889634f;
    float pmax = p0[0];
#pragma unroll
    for (int r = 1; r < 16; ++r) pmax = fmaxf(pmax, p0[r]);
#pragma unroll
    for (int r = 0; r < 16; ++r) pmax = fmaxf(pmax, p1[r]);
    { auto rr = __builtin_amdgcn_permlane32_swap(__float_as_uint(pmax), __float_as_uint(pmax), false, false);
      pmax = fmaxf(__uint_as_float(rr[0]), __uint_as_float(rr[1])); }
    if (__builtin_expect(__all(pmax - m_reg <= THR / SC), 1)) { mn = m_reg; alpha = 1.f; }
    else { mn = fmaxf(m_reg, pmax); alpha = __builtin_amdgcn_exp2f((m_reg - mn) * Cc); m_reg = mn; }
    const float mnC = -mn * Cc;
#pragma unroll
    for (int r = 0; r < 16; ++r) p0[r] = fmaf(p0[r], Cc, mnC);
#pragma unroll
    for (int r = 0; r < 16; ++r) p1[r] = fmaf(p1[r], Cc, mnC);
#pragma unroll
    for (int r = 0; r < 16; ++r) p0[r] = VAR == 1 ? p0[r] * 0.001f : __builtin_amdgcn_exp2f(p0[r]);
}
template <int VAR = 0> __device__ __forceinline__ void finishSM(f32x16& p0, f32x16& p1, float alpha, float& l_reg, bf16x8& pa0, bf16x8& pa1, bf16x8& pa2, bf16x8& pa3) {
#pragma unroll
    for (int r = 0; r < 16; ++r) p1[r] = VAR == 1 ? p1[r] * 0.001f : __builtin_amdgcn_exp2f(p1[r]);
    float ps = 0;
#pragma unroll
    for (int r = 0; r < 16; ++r) ps += p0[r];
#pragma unroll
    for (int r = 0; r < 16; ++r) ps += p1[r];
    { auto rr = __builtin_amdgcn_permlane32_swap(__float_as_uint(ps), __float_as_uint(ps), false, false);
      ps = __uint_as_float(rr[0]) + __uint_as_float(rr[1]); }
    l_reg = l_reg * alpha + ps;
#define PK4(P, BASE, OUT) do { unsigned a0 = cvt_pk_bf16(P[BASE + 0], P[BASE + 1]), a1 = cvt_pk_bf16(P[BASE + 2], P[BASE + 3]);   \
    unsigned b0 = cvt_pk_bf16(P[BASE + 4], P[BASE + 5]), b1 = cvt_pk_bf16(P[BASE + 6], P[BASE + 7]);                              \
    auto r0 = __builtin_amdgcn_permlane32_swap(a0, b0, false, false); auto r1 = __builtin_amdgcn_permlane32_swap(a1, b1, false, false); \
    u32x4 w = {r0[0], r1[0], r0[1], r1[1]}; OUT = *reinterpret_cast<bf16x8*>(&w); } while (0)
    PK4(p0, 0, pa0); PK4(p0, 8, pa1); PK4(p1, 0, pa2); PK4(p1, 8, pa3);
#undef PK4
}
template <int DQ> __device__ __forceinline__ void qkt(f32x16& p0, f32x16& p1, const char* Ks, const bf16x8* qr, const char* qx, int r32, int hi) {
    p0 = f32x16{}; p1 = f32x16{};
#pragma unroll
    for (int d0 = 0; d0 < Cf<DQ>::ND0; ++d0) { const int cb = (d0 * 16 + hi * 8) * 2;
        const bf16x8 b0 = *reinterpret_cast<const bf16x8*>(Ks + Cf<DQ>::kswz(r32, cb));
        const bf16x8 b1 = *reinterpret_cast<const bf16x8*>(Ks + Cf<DQ>::kswz(32 + r32, cb));
        constexpr int NQR = DQ == 192 ? MLA_NQR : 8;
        bf16x8 q; if (d0 < NQR) q = qr[d0]; else q = *reinterpret_cast<const bf16x8*>(qx + (d0 - NQR) * 1024);
        p0 = __builtin_amdgcn_mfma_f32_32x32x16_bf16(b0, q, p0, 0, 0, 0);
        p1 = __builtin_amdgcn_mfma_f32_32x32x16_bf16(b1, q, p1, 0, 0, 0); }
}
__device__ __forceinline__ int v_st(int k, int c) { const int kk = (k & ~0xC) | ((k & 4) << 1) | ((k & 8) >> 1); return ((kk >> 3) * 4 + (c >> 5)) * 512 + ((kk & 7) * 32 + (c & 31)) * 2; }
__device__ __forceinline__ int v_rd_base(int lane) { return ((lane & 3) << 3) | (((lane >> 2) & 3) << 6) | (((lane >> 4) & 1) << 5) | (((lane >> 5) & 1) << 8); }
constexpr int v_rd_off(int d0, int ks, int half) { return d0 * 512 + ks * 4096 + half * 2048; }
template <int OFF> __device__ __forceinline__ s16x4 tr_read(int vb) {
    s16x4 r; asm volatile("ds_read_b64_tr_b16 %0, %1 offset:%2" : "=&v"(r) : "v"(vb), "i"(OFF) : "memory"); return r;
}
template <int D0> __device__ __forceinline__ void pv_one(f32x16& od, int vb, bf16x8 pa0, bf16x8 pa1, bf16x8 pa2, bf16x8 pa3) {
    const s16x4 l0 = tr_read<v_rd_off(D0, 0, 0)>(vb), h0 = tr_read<v_rd_off(D0, 0, 1)>(vb), l1 = tr_read<v_rd_off(D0, 1, 0)>(vb), h1 = tr_read<v_rd_off(D0, 1, 1)>(vb);
    const s16x4 l2 = tr_read<v_rd_off(D0, 2, 0)>(vb), h2 = tr_read<v_rd_off(D0, 2, 1)>(vb), l3 = tr_read<v_rd_off(D0, 3, 0)>(vb), h3 = tr_read<v_rd_off(D0, 3, 1)>(vb);
    asm volatile("s_waitcnt lgkmcnt(0)" ::: "memory"); SBAR();
#define PK(L, H) (bf16x8){L[0], L[1], L[2], L[3], H[0], H[1], H[2], H[3]}
    od = __builtin_amdgcn_mfma_f32_32x32x16_bf16(pa0, PK(l0, h0), od, 0, 0, 0);
    od = __builtin_amdgcn_mfma_f32_32x32x16_bf16(pa1, PK(l1, h1), od, 0, 0, 0);
    od = __builtin_amdgcn_mfma_f32_32x32x16_bf16(pa2, PK(l2, h2), od, 0, 0, 0);
    od = __builtin_amdgcn_mfma_f32_32x32x16_bf16(pa3, PK(l3, h3), od, 0, 0, 0);
#undef PK
}
__device__ __forceinline__ void pv_d0(f32x16* o, int vb, bf16x8 pa0, bf16x8 pa1, bf16x8 pa2, bf16x8 pa3) {
    pv_one<0>(o[0], vb, pa0, pa1, pa2, pa3); pv_one<1>(o[1], vb, pa0, pa1, pa2, pa3); pv_one<2>(o[2], vb, pa0, pa1, pa2, pa3); pv_one<3>(o[3], vb, pa0, pa1, pa2, pa3);
}
__device__ __forceinline__ bf16x8 ld8(const bf16_t* p) { return *reinterpret_cast<const bf16x8*>(p); }

template <int DQ, int SD, int VAR = 0>
__device__ __forceinline__ void attn_body(const bf16_t* __restrict__ Qb, int ldq, const bf16_t* __restrict__ Kn, int ldkn, const bf16_t* __restrict__ Kr, int ldkr,
                                          const bf16_t* __restrict__ Vh, int ldv, bf16_t* __restrict__ Ob, int ldo, int seq, bool rope_q, int pos0, const float* __restrict__ tabM, char* lds, const int tid) {
    using CF = Cf<DQ>; constexpr int ND0 = CF::ND0, SHM_V = CF::SHM_V, SHM_K = CF::SHM_K;
    const int wid = tid >> 6, lane = tid & 63, r32 = lane & 31, hi = lane >> 5;
    char* V_lds = lds; char* K_lds = lds + 2 * SHM_V;
    float* ws = (float*)(lds + 2 * SHM_V + 2 * SHM_K) + wid * 64; float* li_l = ws; float* al_l = ws + 32;
    constexpr int NQR = DQ == 192 ? MLA_NQR : 8;
    float m_reg = -1e30f, l_reg = 0; f32x16 o[4] = {}; bf16x8 qr[NQR];
    const bf16_t* Qw = Qb + (long)(wid * QBLK + r32) * ldq + hi * 8;
#pragma unroll
    for (int d0 = 0; d0 < NQR; ++d0) qr[d0] = ld8(Qw + d0 * 16);
    char* qx = lds + CF::SHM + wid * 8192 + lane * 16;
    if constexpr (DQ == 192) {
#pragma unroll
        for (int d0 = NQR; d0 < 8; ++d0) *(bf16x8*)(qx + (d0 - NQR) * 1024) = ld8(Qw + d0 * 16);
        bf16x8 qe[4];
#pragma unroll
        for (int d0 = 0; d0 < 4; ++d0) qe[d0] = ld8(Qw + (8 + d0) * 16);
        if (rope_q) {
            const int pos = pos0 + wid * QBLK + r32, ri = pos >> 6, ci = pos & 63;
#pragma unroll
            for (int t = 0; t < 2; ++t) { const int p = t == 0 ? ri : ci; const float* tc = tabM + p * 16 + hi * 8; const float* tsn = tabM + 128 * 16 + p * 16 + hi * 8;
                bf16x8 a = qe[t], b = qe[2 + t];
#pragma unroll
                for (int jj = 0; jj < 8; ++jj) { const float x1 = bf2f((bf16_t)a[jj]), x2 = bf2f((bf16_t)b[jj]), c = tc[jj], s = tsn[jj];
                    a[jj] = (short)f2bf(x1 * c - x2 * s); b[jj] = (short)f2bf(x2 * c + x1 * s); }
                qe[t] = a; qe[2 + t] = b; }
        }
#pragma unroll
        for (int d0 = 0; d0 < 4; ++d0) *(bf16x8*)(qx + (8 - NQR + d0) * 1024) = qe[d0];
    }
    const int sr = tid >> 4, sc = (tid & 15) * 8, vst0 = v_st(sr, sc), vst1 = v_st(32 + sr, sc);
    const int sr2 = tid >> 3, sc2 = (tid & 7) * 8;
    const int vb0 = (int)(uintptr_t)V_lds + v_rd_base(lane);
    struct { bf16x8 vs0, vs1, ks0, ks1, ks2; } sr_[SD];
    const unsigned offV = (unsigned)(sr * ldv + sc) * 2u, offK = (unsigned)(sr * ldkn + sc) * 2u, offR = (unsigned)(sr2 * ldkr + sc2) * 2u;
#define SLOAD(i, k0) do { const char* vt_ = (const char*)Vh + (size_t)(k0) * ldv * 2; const char* kt_ = (const char*)Kn + (size_t)(k0) * ldkn * 2; \
    sr_[i].vs0 = *(const bf16x8*)(vt_ + offV); sr_[i].vs1 = *(const bf16x8*)(vt_ + (size_t)32 * ldv * 2 + offV); \
    sr_[i].ks0 = *(const bf16x8*)(kt_ + offK); sr_[i].ks1 = *(const bf16x8*)(kt_ + (size_t)32 * ldkn * 2 + offK); \
    if constexpr (DQ == 192) sr_[i].ks2 = *(const bf16x8*)((const char*)Kr + (size_t)(k0) * ldkr * 2 + offR); } while (0)
#define SWRITE(b, i) do { *(bf16x8*)(V_lds + (b) * SHM_V + vst0) = sr_[i].vs0; *(bf16x8*)(V_lds + (b) * SHM_V + vst1) = sr_[i].vs1; const int kc = sc * 2; \
    *(bf16x8*)(K_lds + (b) * SHM_K + CF::kswz(sr, kc)) = sr_[i].ks0; *(bf16x8*)(K_lds + (b) * SHM_K + CF::kswz(32 + sr, kc)) = sr_[i].ks1; \
    if constexpr (DQ == 192) *(bf16x8*)(K_lds + (b) * SHM_K + CF::kswz(sr2, 256 + sc2 * 2)) = sr_[i].ks2; } while (0)
#define SWAIT() do { if constexpr (SD == 1) asm volatile("s_waitcnt vmcnt(0)" ::: "memory"); else if constexpr (DQ == 192) asm volatile("s_waitcnt vmcnt(5)" ::: "memory"); else asm volatile("s_waitcnt vmcnt(4)" ::: "memory"); } while (0)
#define RESC(a) do { if (__any((a) < 1.f)) { if (hi == 0) al_l[r32] = (a); asm volatile("s_waitcnt lgkmcnt(0)" ::: "memory"); \
    _Pragma("unroll") for (int d = 0; d < 4; ++d) _Pragma("unroll") for (int r = 0; r < 16; ++r) o[d][r] *= al_l[crow(r, hi)]; } } while (0)
    f32x16 pA0, pA1, pB0, pB1; float mnA, mnB, alA, alB; bf16x8 pa0, pa1, pa2, pa3; const int NT = seq / KVBLK;
    constexpr int SE = 0, SO = SD - 1;
    SLOAD(SE, 0); asm volatile("s_waitcnt vmcnt(0)" ::: "memory"); SWRITE(0, SE); __syncthreads();
    qkt<DQ>(pA0, pA1, K_lds, qr, qx, r32, hi); partialSM<DQ, VAR>(pA0, pA1, m_reg, mnA, alA);
    SLOAD(SO, KVBLK); if constexpr (SD == 2) { if (2 < NT) SLOAD(SE, 2 * KVBLK); }
    SWAIT(); SWRITE(1, SO); __syncthreads();
#define ATT_SYNC() do { if constexpr (VAR != 2) __syncthreads(); } while (0)
    for (int j = 1; j + 1 < NT; j += 2) {
        SBAR(); qkt<DQ>(pB0, pB1, K_lds + SHM_K, qr, qx, r32, hi);
        finishSM<VAR>(pA0, pA1, alA, l_reg, pa0, pa1, pa2, pa3); SBAR();
        if constexpr (VAR != 3) SLOAD(SO, (j + SD) * KVBLK); SBAR();
        pv_d0(o, vb0, pa0, pa1, pa2, pa3); partialSM<DQ, VAR>(pB0, pB1, m_reg, mnB, alB);
        ATT_SYNC(); SWAIT(); SWRITE(0, SE);
        RESC(alB); ATT_SYNC();
        SBAR(); qkt<DQ>(pA0, pA1, K_lds, qr, qx, r32, hi);
        finishSM<VAR>(pB0, pB1, alB, l_reg, pa0, pa1, pa2, pa3); SBAR();
        if constexpr (VAR != 3) { if (SD == 1 || j + 3 < NT) SLOAD(SE, (j + 1 + SD) * KVBLK); } SBAR();
        pv_d0(o, vb0 + SHM_V, pa0, pa1, pa2, pa3); partialSM<DQ, VAR>(pA0, pA1, m_reg, mnA, alA);
        ATT_SYNC(); SWAIT(); SWRITE(1, SO);
        RESC(alA); ATT_SYNC();
    }
    SBAR(); qkt<DQ>(pB0, pB1, K_lds + SHM_K, qr, qx, r32, hi);
    finishSM<VAR>(pA0, pA1, alA, l_reg, pa0, pa1, pa2, pa3); SBAR();
    pv_d0(o, vb0, pa0, pa1, pa2, pa3); partialSM<DQ, VAR>(pB0, pB1, m_reg, mnB, alB);
    ATT_SYNC(); RESC(alB);
    finishSM<VAR>(pB0, pB1, alB, l_reg, pa0, pa1, pa2, pa3); SBAR();
    pv_d0(o, vb0 + SHM_V, pa0, pa1, pa2, pa3);
    if (hi == 0) li_l[r32] = l_reg; asm volatile("s_waitcnt lgkmcnt(0)" ::: "memory");
    float rli[16];
#pragma unroll
    for (int r = 0; r < 16; ++r) rli[r] = __builtin_amdgcn_rcpf(li_l[crow(r, hi)]);
    bf16_t* Ow = Ob + (long)(wid * QBLK) * ldo;
#pragma unroll
    for (int r = 0; r < 16; ++r) { const int orow = crow(r, hi);
#pragma unroll
        for (int d0 = 0; d0 < 4; ++d0) Ow[(long)orow * ldo + d0 * 32 + r32] = f2bf(o[d0][r] * rli[r]); }
#undef SLOAD
#undef ATT_SYNC
#undef SWRITE
#undef SWAIT
#undef RESC
}
}

template <int KS> __device__ __forceinline__ void mma_xy(f32x16& acc, const LAS bf16_t* X, const LAS bf16_t* Y, int hi) {
#pragma unroll
    for (int ks = 0; ks < KS; ++ks) { const bf16x8 a = *(const LAS bf16x8*)(X + ks * 16 + hi * 8), b = *(const LAS bf16x8*)(Y + ks * 16 + hi * 8);
        acc = __builtin_amdgcn_mfma_f32_32x32x16_bf16(a, b, acc, 0, 0, 0); }
}
__device__ __forceinline__ float logsig16(float x) { const float e = __expf(-fabsf(x)); return (fminf(x, 0.f) - __logf(1.f + e)) * 0.0625f; }
__device__ __forceinline__ int gla_sidx(int b, int dir, int h) { return (b * 2 + dir) * 4 + h; }

__device__ __forceinline__ void gla_cumsum_lds(const Ctx& C, int l, int h, int dir, const LAS float* lr, LAS float* segtot, LAS float* CUM) {
    const int seg = C.tid >> 7, d = C.tid & 127;
    const float* wa = INP(dir ? I_WA2B : I_WA2F) + (size_t)l * 16 * 512 + h * 128 + d;
    const float bias = INP(dir ? I_BAB : I_BAF)[l * 512 + h * 128 + d];
    float w[16], cum[16];
#pragma unroll
    for (int j = 0; j < 16; ++j) w[j] = wa[j * 512];
    float run = 0.f;
#pragma unroll
    for (int i = 0; i < 16; ++i) { const int s = seg * 16 + i, tk = dir ? 63 - s : s; float pre = bias;
#pragma unroll
        for (int j = 0; j < 16; ++j) pre += lr[tk * 32 + dir * 16 + j] * w[j];
        run += logsig16(pre); cum[i] = run; }
    segtot[seg * 128 + d] = run;
    __syncthreads();
    float off = 0.f;
#pragma unroll
    for (int q = 0; q < 3; ++q) if (q < seg) off += segtot[q * 128 + d];
#pragma unroll
    for (int i = 0; i < 16; ++i) { const int s = seg * 16 + i, tk = dir ? 63 - s : s; CUM[tk * 132 + d] = cum[i] + off; }
    __syncthreads();
}
__device__ __forceinline__ void unpack8(const u32x4 w, float (&x)[8]) { x[0] = bflo(w.x); x[1] = bfhi(w.x); x[2] = bflo(w.y); x[3] = bfhi(w.y); x[4] = bflo(w.z); x[5] = bfhi(w.z); x[6] = bflo(w.w); x[7] = bfhi(w.w); }
__device__ __forceinline__ void gla_build_vt(const Ctx& C, const bf16_t* P, size_t r0, int h, LAS bf16_t* VT) {
    u32x4 v[4];
#pragma unroll
    for (int it = 0; it < 4; ++it) { const int idx = C.tid + it * NTHREADS, sv = idx >> 5, e0 = (idx & 31) * 8; v[it] = *(const u32x4*)(P + (r0 + sv) * NP + C_LV + h * 256 + e0); }
#pragma unroll
    for (int it = 0; it < 4; ++it) { const int idx = C.tid + it * NTHREADS, sv = idx >> 5, e0 = (idx & 31) * 8;
        const unsigned wd[4] = {v[it].x, v[it].y, v[it].z, v[it].w};
#pragma unroll
        for (int q = 0; q < 4; ++q) { VT[(e0 + 2 * q) * 72 + sv] = (bf16_t)(wd[q] & 0xffffu); VT[(e0 + 2 * q + 1) * 72 + sv] = (bf16_t)(wd[q] >> 16); } }
}

__device__ __forceinline__ void phase_gla_local(const Ctx& C, int l, int rot) {
    const bf16_t* P = WSP(bf16_t, WS_P); bf16_t* GST = WSP(bf16_t, WS_GST); float* GDEC = WSP(float, WS_GDEC);
    LAS float* lr = (LAS float*)C.lds;
    LAS float* segtot = (LAS float*)(C.lds + 8192);
    LAS bf16_t* KT = (LAS bf16_t*)(C.lds + 10240);
    LAS bf16_t* VT = (LAS bf16_t*)(C.lds + 28672);
    LAS float* CUM = (LAS float*)(C.lds + 65536);
    const int r32 = C.lane & 31, hi = C.lane >> 5, d = C.tid & 127;
    const int btk = C.tid >> 3, bdg = (C.tid & 7) * 16;
    for (int unit = (C.bid + C.G - rot % C.G) % C.G; unit < NBATCH * 4 * NCH; unit += C.G) {
        const int b = unit / (4 * NCH), h = (unit / NCH) % 4, ck = unit % NCH; const size_t r0 = (size_t)b * RPB + ck * 64;
        for (int i = C.tid; i < 64 * 32; i += NTHREADS) lr[i] = bf2f(P[(r0 + (i >> 5)) * NP + C_LRF + (i & 31)]);
        const u32x4 kw0 = *(const u32x4*)(P + (r0 + btk) * NP + C_LK + h * 128 + bdg), kw1 = *(const u32x4*)(P + (r0 + btk) * NP + C_LK + h * 128 + bdg + 8);
        gla_build_vt(C, P, r0, h, VT);
        __syncthreads();
#pragma unroll 1
        for (int dir = 0; dir < 2; ++dir) {
            gla_cumsum_lds(C, l, h, dir, lr, segtot, CUM);
            const int tend = dir ? 0 : 63;
            const size_t sx = (size_t)gla_sidx(b, dir, h) * NCH + ck;
            if (C.tid < 128) GDEC[sx * 128 + d] = __expf(CUM[tend * 132 + d]);
            { float kf[16]; { float t8[8]; unpack8(kw0, t8);
#pragma unroll
                for (int i = 0; i < 8; ++i) kf[i] = t8[i]; unpack8(kw1, t8);
#pragma unroll
                for (int i = 0; i < 8; ++i) kf[8 + i] = t8[i]; }
#pragma unroll
              for (int q = 0; q < 4; ++q) { const f32x4 cm = *(const LAS f32x4*)(CUM + btk * 132 + bdg + 4 * q), be = *(const LAS f32x4*)(CUM + tend * 132 + bdg + 4 * q);
#pragma unroll
                  for (int i = 0; i < 4; ++i) KT[(bdg + 4 * q + i) * 72 + btk] = f2bf(kf[4 * q + i] * __expf(be[i] - cm[i])); } }
            __syncthreads();
            { const int dt = C.wid & 3, eb = (C.wid >> 2) * 4;
              f32x16 acc[4] = {};
#pragma unroll
              for (int q = 0; q < 4; ++q) mma_xy<4>(acc[q], KT + (dt * 32 + r32) * 72, VT + ((eb + q) * 32 + r32) * 72, hi);
              bf16_t* st = GST + sx * 32768;
#pragma unroll
              for (int q = 0; q < 4; ++q)
#pragma unroll
                  for (int g = 0; g < 4; ++g) { u32x2 w; w.x = cvt_pk_bf16(acc[q][4 * g], acc[q][4 * g + 1]); w.y = cvt_pk_bf16(acc[q][4 * g + 2], acc[q][4 * g + 3]);
                      *(u32x2*)(st + (size_t)((eb + q) * 32 + r32) * 128 + dt * 32 + 8 * g + 4 * hi) = w; } }
            __syncthreads();
        }
    }
}

__device__ __forceinline__ void phase_gla_scan(const Ctx& C) {
    bf16_t* GST = WSP(bf16_t, WS_GST); const float* GDEC = WSP(float, WS_GDEC);
    for (int gid = C.bid * NTHREADS + C.tid; gid < 16 * 8192; gid += C.G * NTHREADS) {
        const int sidx = gid >> 13, g = gid & 8191, dir = (sidx >> 2) & 1, d4 = (g & 31) * 4;
        bf16_t* base = GST + (size_t)sidx * NCH * 32768 + (size_t)g * 4;
        const float* dbase = GDEC + (size_t)sidx * NCH * 128 + d4;
        float S[4] = {0.f, 0.f, 0.f, 0.f};
        for (int st = 0; st < NCH; st += 4) {
            int ck[4]; u32x2 L[4]; f32x4 dc[4];
#pragma unroll
            for (int q = 0; q < 4; ++q) { const int s = st + q; ck[q] = dir ? (s < 4 ? 3 - s : NCH + 3 - s) : s;
                L[q] = *(const u32x2*)(base + (size_t)ck[q] * 32768); dc[q] = *(const f32x4*)(dbase + (size_t)ck[q] * 128); }
#pragma unroll
            for (int q = 0; q < 4; ++q) { u32x2 w; w.x = cvt_pk_bf16(S[0], S[1]); w.y = cvt_pk_bf16(S[2], S[3]);
                *(u32x2*)(base + (size_t)ck[q] * 32768) = w;
                S[0] = dc[q][0] * S[0] + bflo(L[q].x); S[1] = dc[q][1] * S[1] + bfhi(L[q].x); S[2] = dc[q][2] * S[2] + bflo(L[q].y); S[3] = dc[q][3] * S[3] + bfhi(L[q].y); }
        }
    }
}

__device__ __forceinline__ void phase_gla_out(const Ctx& C, int l, int rot) {
    const bf16_t* P = WSP(bf16_t, WS_P); const bf16_t* GST = WSP(bf16_t, WS_GST); bf16_t* OL = WSP(bf16_t, WS_OL);
    LAS float* lr = (LAS float*)C.lds;
    LAS float* segtot = (LAS float*)(C.lds + 8192);
    LAS bf16_t* QT = (LAS bf16_t*)(C.lds + 10240);
    LAS bf16_t* KT = (LAS bf16_t*)(C.lds + 27648);
    LAS bf16_t* VT = (LAS bf16_t*)(C.lds + 45056);
    LAS bf16_t* SCm = (LAS bf16_t*)(C.lds + 81920);
    LAS float* OB = (LAS float*)(C.lds + 91136);
    LAS float* CUM = OB;
    const float* gon = INP(I_ONG) + l * 256;
    const int r32 = C.lane & 31, hi = C.lane >> 5;
    const int btk = C.tid >> 3, bdg = (C.tid & 7) * 16;
    for (int unit = (C.bid + C.G - rot % C.G) % C.G; unit < NBATCH * 4 * NCH; unit += C.G) {
        const int b = unit / (4 * NCH), h = (unit / NCH) % 4, ck = unit % NCH; const size_t r0 = (size_t)b * RPB + ck * 64;
        for (int i = C.tid; i < 64 * 32; i += NTHREADS) lr[i] = bf2f(P[(r0 + (i >> 5)) * NP + C_LRF + (i & 31)]);
        const bf16_t* qp = P + (r0 + btk) * NP + C_LQ + h * 128 + bdg; const bf16_t* kp = P + (r0 + btk) * NP + C_LK + h * 128 + bdg;
        const u32x4 qw0 = *(const u32x4*)qp, qw1 = *(const u32x4*)(qp + 8), kw0 = *(const u32x4*)kp, kw1 = *(const u32x4*)(kp + 8);
        gla_build_vt(C, P, r0, h, VT);
        __syncthreads();
        f32x16 oacc[2] = {};
#pragma unroll 1
        for (int dir = 0; dir < 2; ++dir) {
            gla_cumsum_lds(C, l, h, dir, lr, segtot, CUM);
            { float qf[8], kf[8];
#pragma unroll
              for (int hh = 0; hh < 2; ++hh) { unpack8(hh ? qw1 : qw0, qf); unpack8(hh ? kw1 : kw0, kf);
                  const f32x4 c0 = *(const LAS f32x4*)(CUM + btk * 132 + bdg + 8 * hh), c1 = *(const LAS f32x4*)(CUM + btk * 132 + bdg + 8 * hh + 4);
                  float qo[8], ko[8];
#pragma unroll
                  for (int i = 0; i < 8; ++i) { const float cm = i < 4 ? c0[i & 3] : c1[i & 3]; qo[i] = qf[i] * __expf(cm) * 0.088388347648318440f; ko[i] = kf[i] * __expf(-cm); }
                  u32x4 wq, wk; wq.x = cvt_pk_bf16(qo[0], qo[1]); wq.y = cvt_pk_bf16(qo[2], qo[3]); wq.z = cvt_pk_bf16(qo[4], qo[5]); wq.w = cvt_pk_bf16(qo[6], qo[7]);
                  wk.x = cvt_pk_bf16(ko[0], ko[1]); wk.y = cvt_pk_bf16(ko[2], ko[3]); wk.z = cvt_pk_bf16(ko[4], ko[5]); wk.w = cvt_pk_bf16(ko[6], ko[7]);
                  *(LAS u32x4*)(QT + btk * 136 + bdg + 8 * hh) = wq; *(LAS u32x4*)(KT + btk * 136 + bdg + 8 * hh) = wk; } }
            __syncthreads();
            if (C.wid < 4) { const int mt = C.wid >> 1, nt = C.wid & 1; f32x16 sc = {};
                mma_xy<8>(sc, QT + (mt * 32 + r32) * 136, KT + (nt * 32 + r32) * 136, hi);
#pragma unroll
                for (int i = 0; i < 16; ++i) { const int t = mt * 32 + att::crow(i, hi), sx_ = nt * 32 + r32; const bool keep = dir ? (sx_ >= t) : (sx_ <= t);
                    SCm[t * 72 + sx_] = f2bf(keep ? sc[i] : 0.f); } }
            __syncthreads();
            { const bf16_t* st = GST + ((size_t)gla_sidx(b, dir, h) * NCH + ck) * 32768 + (size_t)(C.wid * 32 + r32) * 128 + hi * 8;
              bf16x8 sb[8];
#pragma unroll
              for (int ks = 0; ks < 8; ++ks) sb[ks] = *(const bf16x8*)(st + ks * 16);
#pragma unroll
              for (int mt = 0; mt < 2; ++mt) {
                  mma_xy<4>(oacc[mt], SCm + (mt * 32 + r32) * 72, VT + (C.wid * 32 + r32) * 72, hi);
#pragma unroll
                  for (int ks = 0; ks < 8; ++ks) { const bf16x8 a = *(const LAS bf16x8*)(QT + (mt * 32 + r32) * 136 + ks * 16 + hi * 8);
                      oacc[mt] = __builtin_amdgcn_mfma_f32_32x32x16_bf16(a, sb[ks], oacc[mt], 0, 0, 0); } } }
            __syncthreads();
        }
#pragma unroll
        for (int mt = 0; mt < 2; ++mt)
#pragma unroll
            for (int i = 0; i < 16; ++i) OB[(mt * 32 + att::crow(i, hi)) * 260 + C.wid * 32 + r32] = oacc[mt][i];
        __syncthreads();
        { const int t = C.tid >> 3, part = C.tid & 7; f32x4 v[8]; float ss = 0.f;
#pragma unroll
          for (int jj = 0; jj < 8; ++jj) { v[jj] = *(const LAS f32x4*)(OB + t * 260 + jj * 32 + part * 4); ss += v[jj][0] * v[jj][0] + v[jj][1] * v[jj][1] + v[jj][2] * v[jj][2] + v[jj][3] * v[jj][3]; }
          ss += dppmov<DPP_HMIRROR>(ss); ss += dppmov<DPP_Q3210>(ss); ss += dppmov<DPP_Q1032>(ss);
          const float rs = rsqrtf(ss * (1.0f / 256.0f) + NORM_EPS);
#pragma unroll
          for (int jj = 0; jj < 8; ++jj) { const int e = jj * 32 + part * 4; const f32x4 g = *(const f32x4*)(gon + e);
              const u32x2 gt = *(const u32x2*)(P + (r0 + t) * NP + C_LG + h * 256 + e);
              const float o0 = v[jj][0] * rs * g[0] * siluf_(bflo(gt.x)), o1 = v[jj][1] * rs * g[1] * siluf_(bfhi(gt.x)), o2 = v[jj][2] * rs * g[2] * siluf_(bflo(gt.y)), o3 = v[jj][3] * rs * g[3] * siluf_(bfhi(gt.y));
              u32x2 w; w.x = cvt_pk_bf16(o0, o1); w.y = cvt_pk_bf16(o2, o3);
              *(u32x2*)(OL + (r0 + t) * 1024 + h * 256 + e) = w; } }
        __syncthreads();
    }
}

__device__ __forceinline__ unsigned f_ord(float f) { const unsigned u = __float_as_uint(f); return u ^ ((unsigned)((int)u >> 31) | 0x80000000u); }
__device__ __forceinline__ float f_unord(unsigned k) { return __uint_as_float((k & 0x80000000u) ? (k ^ 0x80000000u) : ~k); }
__device__ __forceinline__ void ins_u(unsigned (&L)[16], unsigned x) {
#pragma unroll
    for (int j = 0; j < 16; ++j) { const unsigned h = L[j] > x ? L[j] : x; x = L[j] > x ? x : L[j]; L[j] = h; }
}
__device__ __forceinline__ void ins_f(float (&M)[16], float x) {
#pragma unroll
    for (int j = 0; j < 16; ++j) { const float h = M[j] > x ? M[j] : x; x = M[j] > x ? x : M[j]; M[j] = h; }
}
__device__ __forceinline__ void peer_top16(const bf16_t* __restrict__ qrow, const bf16_t* __restrict__ keys, int r32, int hi, unsigned (&L)[16]) {
    bf16x8 qf[8];
#pragma unroll
    for (int kk = 0; kk < 8; ++kk) qf[kk] = *(const bf16x8*)(qrow + kk * 16 + hi * 8);
#pragma unroll
    for (int j = 0; j < 16; ++j) L[j] = 0u;
    bf16x8 kA[8], kB[8];
    const bf16_t* kl = keys + (size_t)r32 * 128 + hi * 8;
#define PT_LDK(dst, mt) do { _Pragma("unroll") for (int kk = 0; kk < 8; ++kk) dst[kk] = *(const bf16x8*)(kl + (mt) * 32 * 128 + kk * 16); } while (0)
#define PT_PROC(src, mt) do { f32x16 acc = {}; \
        _Pragma("unroll") for (int kk = 0; kk < 8; ++kk) acc = __builtin_amdgcn_mfma_f32_32x32x16_bf16(src[kk], qf[kk], acc, 0, 0, 0); \
        _Pragma("unroll") for (int i = 0; i < 16; ++i) { const unsigned kidx = (unsigned)((mt) * 32 + att::crow(i, hi)); ins_u(L, (f_ord(acc[i]) & ~127u) | (127u - kidx)); } } while (0)
    PT_LDK(kA, 0);
#pragma unroll 1
    for (int mp = 0; mp < 2; ++mp) { PT_LDK(kB, 2 * mp + 1); PT_PROC(kA, 2 * mp); if (mp == 0) PT_LDK(kA, 2); PT_PROC(kB, 2 * mp + 1); }
#undef PT_LDK
#undef PT_PROC
    unsigned Pn[16];
#pragma unroll
    for (int j = 0; j < 16; ++j) { auto r_ = __builtin_amdgcn_permlane32_swap(L[j], L[j], false, false); Pn[j] = hi ? r_[0] : r_[1]; }
#pragma unroll
    for (int j = 0; j < 16; ++j) ins_u(L, Pn[j]);
}
__device__ __forceinline__ void phase_peer_select(const Ctx& C, const bool latent_only) {
    const bf16_t* PQ = WSP(bf16_t, WS_PQ); const bf16_t* K1 = WSP(bf16_t, WS_K1); const bf16_t* K2 = WSP(bf16_t, WS_K2);
    int* PIDX = WSP(int, WS_PIDX); float* PG = WSP(float, WS_PG);
    const int r32 = C.lane & 31, hi = C.lane >> 5, head = C.wid;
    const int ngrp = latent_only ? NBATCH * SEQ / 32 : TT / 32;
    for (int gi = C.bid; gi < ngrp; gi += C.G) {
        const int grp = latent_only ? gi + (CTXL / 32) * (1 + gi / (SEQ / 32)) : gi;
        const size_t tok = (size_t)grp * 32 + r32;
        unsigned L1[16], L2[16];
        peer_top16(PQ + tok * DM + head * 256, K1 + (size_t)head * 128 * 128, r32, hi, L1);
        peer_top16(PQ + tok * DM + head * 256 + 128, K2 + (size_t)head * 128 * 128, r32, hi, L2);
        float v1[16], v2[16];
#pragma unroll
        for (int j = 0; j < 16; ++j) { v1[j] = f_unord(L1[j] & ~127u); v2[j] = f_unord(L2[j] & ~127u); }
        float M[16];
#pragma unroll
        for (int j = 0; j < 16; ++j) M[j] = -3.0e38f;
#pragma unroll
        for (int a = 0; a < 16; ++a)
#pragma unroll
            for (int b = 0; b < 16; ++b) if ((a + 1) * (b + 1) <= 16) ins_f(M, v1[a] + v2[b]);
        const float thr = M[15], mx = M[0]; float den = 0.f;
#pragma unroll
        for (int j = 0; j < 16; ++j) den += __expf(M[j] - mx);
        const float rden = 1.0f / den;
        int pos = 0; int* ip = PIDX + tok * 128 + head * 16; float* gp = PG + tok * 128 + head * 16;
#pragma unroll
        for (int a = 0; a < 16; ++a)
#pragma unroll
            for (int b = 0; b < 16; ++b) if ((a + 1) * (b + 1) <= 16) {
                const float val = v1[a] + v2[b];
                if (val >= thr && pos < 16) { if (hi == 0) { ip[pos] = (int)((127u - (L1[a] & 127u)) * 128u + (127u - (L2[b] & 127u))); gp[pos] = __expf(val - mx) * rden; } ++pos; } }
    }
}
template <int OFF> __device__ __forceinline__ float dotf8(const float (&h)[32], const u32x4 w, float acc) {
#pragma unroll
    for (int j = 0; j < 4; ++j) { const f32x2 lo = __builtin_amdgcn_cvt_pk_f32_fp8((int)w[j], false), hi = __builtin_amdgcn_cvt_pk_f32_fp8((int)w[j], true);
        acc += h[OFF + 4 * j] * lo.x; acc += h[OFF + 4 * j + 1] * lo.y; acc += h[OFF + 4 * j + 2] * hi.x; acc += h[OFF + 4 * j + 3] * hi.y; }
    return acc;
}
constexpr int GT_MAXTOK = 9;
template <bool LAST> __device__ __forceinline__ void phase_peer_gather(const Ctx& C, const float* modl, const float pscale) {
    const unsigned char* pt = C.ws + WS_PT + (size_t)(LAST ? DEPTH - 1 : 0) * PT_BYTES;
    const bf16_t* HB = WSP(bf16_t, WS_HB); const unsigned char* U8 = pt + PT_U8; const unsigned char* V8 = pt + PT_V8;
    const float* SCU = (const float*)(pt + PT_SCU); const float* SCV = (const float*)(pt + PT_SCV);
    const int* PIDX = WSP(int, WS_PIDX); const float* PG = WSP(float, WS_PG); float* XS = WSP(float, WS_XS);
    const int lane = C.lane, s = lane >> 3, j = lane & 7; const unsigned j16 = (unsigned)j * 16u;
    LAS int* IDS = (LAS int*)(C.lds + C.wid * (GT_MAXTOK * 512));
    LAS float* ACT = (LAS float*)(C.lds + 8 * GT_MAXTOK * 512 + C.wid * (GT_MAXTOK * 512));
    LAS int* ROWS = (LAS int*)(C.lds + 16 * GT_MAXTOK * 512 + C.wid * 64);
    int nk = 0;
    {
      const int per = (TT + C.G - 1) / C.G, base = C.bid * per;
#pragma unroll 1
      for (int k = 0; k < GT_MAXTOK; ++k) { const int o = C.wid + 8 * k; const int r = base + o; if (o < per && r < TT && !(LAST && (r % RPB) < CTXL)) { if (lane == 0) ROWS[nk] = r; ++nk; } } }
#define GT_ROW(k) __builtin_amdgcn_readfirstlane(ROWS[k])
#pragma unroll 1
    for (int k = 0; k < nk; ++k) { const int r = GT_ROW(k);
        IDS[k * 128 + lane] = (PIDX[(size_t)r * 128 + lane] & (NEXP - 1)) << 7; IDS[k * 128 + 64 + lane] = (PIDX[(size_t)r * 128 + 64 + lane] & (NEXP - 1)) << 7;
        ACT[k * 128 + lane] = 0.f; ACT[k * 128 + 64 + lane] = 0.f; }
    const int nit = 32 * nk;
#define GT_ITEM(it_) const int cb_ = (it_) / (2 * nk), rem_ = (it_) - cb_ * (2 * nk), k_ = rem_ >> 1, hf_ = rem_ & 1
#define GT_LOADU(UQ, HQ, it_) do { GT_ITEM(it_); const int r_ = GT_ROW(k_); \
        const bf16_t* hp_ = HB + (size_t)r_ * DM + cb_ * 128 + j * 16; HQ[0] = *(const u32x4*)hp_; HQ[1] = *(const u32x4*)(hp_ + 8); \
        const unsigned char* ub_ = U8 + (size_t)cb_ * ((size_t)NEXP * 128);     \
        _Pragma("unroll") for (int eg = 0; eg < 8; ++eg) { const unsigned off_ = ((unsigned)IDS[k_ * 128 + (hf_ * 8 + eg) * 8 + s] & idmask) + j16; UQ[eg] = *(const u32x4*)(ub_ + off_); } } while (0)
#define GT_COMPU(UQ, HQ, it_) do { GT_ITEM(it_); (void)cb_; f32x2 hf2[8]; \
        _Pragma("unroll") for (int hh = 0; hh < 2; ++hh) { const u32x4 w_ = HQ[hh]; \
            hf2[hh * 4 + 0] = (f32x2){bflo(w_.x), bfhi(w_.x)}; hf2[hh * 4 + 1] = (f32x2){bflo(w_.y), bfhi(w_.y)}; hf2[hh * 4 + 2] = (f32x2){bflo(w_.z), bfhi(w_.z)}; hf2[hh * 4 + 3] = (f32x2){bflo(w_.w), bfhi(w_.w)}; } \
        float d[8]; \
        _Pragma("unroll") for (int eg = 0; eg < 8; ++eg) { f32x2 d2 = (f32x2){0.f, 0.f}; \
            _Pragma("unroll") for (int q = 0; q < 4; ++q) { const f32x2 lo = __builtin_amdgcn_cvt_pk_f32_fp8((int)UQ[eg][q], false), hi = __builtin_amdgcn_cvt_pk_f32_fp8((int)UQ[eg][q], true); \
                d2 += hf2[2 * q] * lo; d2 += hf2[2 * q + 1] * hi; } \
            d[eg] = d2.x + d2.y; } \
          \
        float t4[4], t2[2], t1; \
        _Pragma("unroll") for (int i = 0; i < 4; ++i) { const float snd = (j & 4) ? d[i] : d[i + 4], kp = (j & 4) ? d[i + 4] : d[i]; t4[i] = kp + dppmov<DPP_HMIRROR>(snd); } \
        _Pragma("unroll") for (int i = 0; i < 2; ++i) { const float snd = (j & 2) ? t4[i] : t4[i + 2], kp = (j & 2) ? t4[i + 2] : t4[i]; t2[i] = kp + dppmov<DPP_Q3210>(snd); } \
        { const float snd = (j & 1) ? t2[0] : t2[1], kp = (j & 1) ? t2[1] : t2[0]; t1 = kp + dppmov<DPP_Q1032>(snd); } \
        ACT[k_ * 128 + (hf_ * 8 + j) * 8 + s] += t1; } while (0)
#ifdef DBG_GDUP
#pragma unroll 1
    for (int rep_ = 0; rep_ < 2; ++rep_) {
    const unsigned idmask = rep_ == 0 ? ((unsigned)DBG_GMASK << 7 | 127u) : 0xffffffffu;
    if (rep_ == 1) { for (int k = 0; k < nk; ++k) { ACT[k * 128 + lane] = 0.f; ACT[k * 128 + 64 + lane] = 0.f; } }
#else
    { const unsigned idmask = 0xffffffffu;
#endif
    if (nit > 0) {
        u32x4 uA[8], uB[8], hA[2], hB[2];
        GT_LOADU(uA, hA, 0);
#pragma unroll 1
        for (int it = 0; it < nit; it += 2) {
            GT_LOADU(uB, hB, it + 1);
            GT_COMPU(uA, hA, it);
            if (it + 2 < nit) GT_LOADU(uA, hA, it + 2);
            GT_COMPU(uB, hB, it + 1);
        }
    }
    }
#undef GT_LOADU
#undef GT_COMPU
#pragma unroll 1
    for (int k = 0; k < nk; ++k) { const int r = GT_ROW(k);
#pragma unroll
        for (int hh = 0; hh < 2; ++hh) { const int e = hh * 64 + lane; const int id = IDS[k * 128 + e] >> 7; const float a = ACT[k * 128 + e] * SCU[id];
            const float w = PG[(size_t)r * 128 + e] * 0.5f * a * (1.0f + erff(a * 0.70710678118654752f));
#if defined(DBG_CHECK) && (DBG_CHECK == 3 || DBG_CHECK == 4)
            if (((r - 300) & 63) == 0 && r >= 300 && r < 300 + 64 * 128) WSP(float, WS_OM)[(size_t)r * 128 + e] = w;
#endif
            ACT[k * 128 + e] = w * SCV[id]; } }
#define GT_LOADV(VQ, WV, it_) do { GT_ITEM(it_); const unsigned char* vb_ = V8 + (size_t)cb_ * ((size_t)NEXP * 128); \
        _Pragma("unroll") for (int eg = 0; eg < 8; ++eg) { const int e_ = k_ * 128 + (hf_ * 8 + eg) * 8 + s; const unsigned off_ = (unsigned)IDS[e_] + j16; VQ[eg] = *(const u32x4*)(vb_ + off_); WV[eg] = ACT[e_]; } } while (0)
#define GT_COMPV(VQ, WV) do { \
        _Pragma("unroll") for (int eg = 0; eg < 8; ++eg) { const f32x2 w2_ = (f32x2){WV[eg], WV[eg]}; \
            _Pragma("unroll") for (int q = 0; q < 4; ++q) { \
                const f32x2 lo = __builtin_amdgcn_cvt_pk_f32_fp8((int)VQ[eg][q], false), hi = __builtin_amdgcn_cvt_pk_f32_fp8((int)VQ[eg][q], true); \
                acc2[2 * q] += w2_ * lo; acc2[2 * q + 1] += w2_ * hi; } } } while (0)
    if (nit > 0) {
        u32x4 vA[8], vB[8]; float wA[8], wB[8];
        GT_LOADV(vA, wA, 0);
#pragma unroll 1
        for (int it = 0; it < nit; it += 2) {
            f32x2 acc2[8];
#pragma unroll
            for (int i = 0; i < 8; ++i) acc2[i] = (f32x2){0.f, 0.f};
            GT_LOADV(vB, wB, it + 1);
            GT_COMPV(vA, wA);
            if (it + 2 < nit) GT_LOADV(vA, wA, it + 2);
            GT_COMPV(vB, wB);
            f32x2 t4[4], t2[2], t1;
#pragma unroll
            for (int i = 0; i < 4; ++i) { const f32x2 snd = (s & 4) ? acc2[i] : acc2[i + 4], kp = (s & 4) ? acc2[i + 4] : acc2[i];
                t4[i] = kp + (f32x2){xchg32(snd.x, lane), xchg32(snd.y, lane)}; }
#pragma unroll
            for (int i = 0; i < 2; ++i) { const f32x2 snd = (s & 2) ? t4[i] : t4[i + 2], kp = (s & 2) ? t4[i + 2] : t4[i];
                t2[i] = kp + (f32x2){xchg16(snd.x, lane), xchg16(snd.y, lane)}; }
            { const f32x2 snd = (s & 1) ? t2[0] : t2[1], kp = (s & 1) ? t2[1] : t2[0]; t1 = kp + (f32x2){dppmov<DPP_ROR8>(snd.x), dppmov<DPP_ROR8>(snd.y)}; }
            { GT_ITEM(it); (void)hf_; const int r_ = GT_ROW(k_);
              const int col = cb_ * 128 + j * 16 + 2 * s; float* xp = XS + (size_t)r_ * DM + col; const float* g2 = modl + (size_t)mod_sel(r_) * 12288 + 5 * DM + col;
#if defined(DBG_CHECK) && (DBG_CHECK == 3 || DBG_CHECK == 4)
              if (((r_ - 300) & 63) == 0 && r_ >= 300 && r_ < 300 + 64 * 128) { float* dbgo = WSP(float, WS_MQ) + (size_t)r_ * DM + col; dbgo[0] = t1.x; dbgo[1] = t1.y; }
#endif
              const f32x2 x = *(const f32x2*)xp, g = *(const f32x2*)g2;
              *(f32x2*)xp = x + pscale * g * t1; }
        }
    }
#undef GT_LOADV
#undef GT_COMPV
#undef GT_ITEM
#undef GT_ROW
}
__device__ __forceinline__ void phase_final_norm(const Ctx& C) {
    const float* XS = WSP(float, WS_XS); const float* fg = INP(I_FG);
    for (int q = C.bid * 8 + C.wid; q < NBATCH * SEQ; q += C.G * 8) {
        const int b = q / SEQ, t = q % SEQ; const float* xr = XS + ((size_t)b * RPB + CTXL + t) * DM; float* op = C.out + (size_t)q * DM;
        f32x4 v[8]; float ss = 0.f;
#pragma unroll
        for (int c = 0; c < 8; ++c) { v[c] = *(const f32x4*)(xr + c * 256 + C.lane * 4); ss += v[c][0] * v[c][0] + v[c][1] * v[c][1] + v[c][2] * v[c][2] + v[c][3] * v[c][3]; }
        ss = wave_sum(ss); const float rs = rsqrtf(ss * (1.0f / DM) + NORM_EPS);
#pragma unroll
        for (int c = 0; c < 8; ++c) { const f32x4 g = *(const f32x4*)(fg + c * 256 + C.lane * 4); *(f32x4*)(op + c * 256 + C.lane * 4) = v[c] * rs * g; }
    }
}

template <int TYPE  , int VAR = 0> __device__ __forceinline__ void attn_units(const Ctx& C, bool need_ctx) {
    const bf16_t* P = WSP(bf16_t, WS_P);
    const int nu = need_ctx ? 528 : 512;
#pragma unroll 1
    for (int u = C.bid; u < nu; u += C.G) {
        int bh, qb; if (u < 512) { bh = (u >> 8) * 8 + (u & 7); qb = ((u & 255) >> 3) + 1; } else { bh = u - 512; qb = 0; }
        const int b = bh >> 3, h = bh & 7; const size_t rq = (size_t)b * RPB + (size_t)qb * 256, rk = (size_t)b * RPB; const int seq = qb == 0 ? CTXL : RPB;
        __syncthreads();
        if constexpr (TYPE == 1) {
            att::attn_body<128, 2, VAR>(P + rq * NP + C_AQ + h * 128, NP, P + rk * NP + C_AK + (h >> 2) * 128, NP, nullptr, 0, P + rk * NP + C_AV + (h >> 2) * 128, NP,
                                   WSP(bf16_t, WS_OA) + rq * 1024 + h * 128, 1024, seq, false, 0, nullptr, (char*)C.lds, C.tid);
        } else {
            const bf16_t* MQ = WSP(bf16_t, WS_MQ); const bf16_t* MKV = WSP(bf16_t, WS_MKV);
            att::attn_body<192, 1, VAR>(MQ + rq * 1536 + h * 192, 1536, MKV + rk * 2048 + h * 256, 2048, P + rk * NP + C_MKR, NP, MKV + rk * 2048 + h * 256 + 128, 2048,
                                   WSP(bf16_t, WS_OM) + rq * 1024 + h * 128, 1024, seq, qb > 0, (qb - 1) * 256, WSP(float, WS_TABM), (char*)C.lds, C.tid);
        }
    }
    __syncthreads();
}

constexpr int LDS_BYTES = 163840, LDS_BAR_OFF = LDS_BYTES - 16;
constexpr int N_PHASES = 26;
template <int K> __device__ __forceinline__ void run_phase(const Ctx& C0, int l) {
    const Ctx C = launder(C0);
    const float* modl = WSP(float, WS_MODV) + (size_t)l * 3 * 12288;
    if constexpr (K == 0) { phase_modv(C); phase_tables(C); __syncthreads(); phase_cvt_mixer_weights(C, 0); }
    if constexpr (K == 1) {
        if (l == 0) phase_norm_mod<true, true>(C, INP(I_N1G), modl, 0, DM);
        else { phase_norm_mod<false, true>(C, INP(I_N1G) + l * DM, modl, 0, DM); __syncthreads(); phase_cvt_mixer_weights(C, l); }
    }
    if constexpr (K == 2) {
        pg8::Gemm g{WSP(bf16_t, WS_HB), WSP(bf16_t, WS_WIN), TT, NP, DM, DM, DM}; pg8::WinOrder S; S.init(C.G, C.bid, l + 1 < DEPTH);
        pg8::EpiStoreBf16S E{WSP(bf16_t, WS_P), NP, WSP(float, WS_WINS)};
        pg8::gemm_phase<pg8::EpiStoreBf16S, pg8::WinOrder, 1>(C.lds, C.tid, g, S, E);
    }
    if constexpr (K == 3) phase_post_p(C, l);
    if constexpr (K == 4) {
        { pg8::Gemm g{WSP(bf16_t, WS_P) + C_MCQ, WSP(bf16_t, WS_WUQ), TT, 1536, 512, NP, 512}; pg8::StaticOrder S; S.init(TT, 1536, C.G, C.bid);
          pg8::EpiStoreBf16 E{WSP(bf16_t, WS_MQ), 1536}; pg8::gemm_phase(C.lds, C.tid, g, S, E); }
        { pg8::Gemm g{WSP(bf16_t, WS_P) + C_MCKV, WSP(bf16_t, WS_WUKV), TT, 2048, 512, NP, 512}; pg8::StaticOrder S; S.init(TT, 2048, C.G, (C.bid + C.G - 140 % C.G) % C.G);
          pg8::EpiStoreBf16 E{WSP(bf16_t, WS_MKV), 2048}; pg8::gemm_phase(C.lds, C.tid, g, S, E); }
        { const Ctx C2 = launder(C0); phase_gla_local(C2, l, 156); }
#ifdef DBG_DUP_GLALOCAL
        { const Ctx C2 = launder(C0); __syncthreads(); phase_gla_local(C2, l, 156); }
#endif
    }
    if constexpr (K == 5) phase_gla_scan(C);
    if constexpr (K == 6) {
#ifdef DBG_ATTVAR
        { const Ctx Cx = launder(C0); attn_units<0, DBG_ATTVAR>(Cx, l + 1 < DEPTH); } { const Ctx Cx = launder(C0); attn_units<1, DBG_ATTVAR>(Cx, l + 1 < DEPTH); } __syncthreads();
#endif
        attn_units<0>(C, l + 1 < DEPTH); { const Ctx C2 = launder(C0); attn_units<1>(C2, l + 1 < DEPTH); } { const Ctx C3 = launder(C0); phase_gla_out(C3, l, 128); }
#ifdef DBG_DUP_GLAOUT
        { const Ctx C3 = launder(C0); __syncthreads(); phase_gla_out(C3, l, 128); }
#endif
    }
    if constexpr (K == 7) {
        const bf16_t* P = WSP(bf16_t, WS_P); bf16_t* Y = WSP(bf16_t, WS_Y);
        const pg8::Gemm ga{WSP(bf16_t, WS_OA), WSP(bf16_t, WS_WBR), TT, DM, 1024, 1024, 1024}, gl{WSP(bf16_t, WS_OL), WSP(bf16_t, WS_WBR) + (size_t)2048 * 1024, TT, DM, 1024, 1024, 1024},
                        gm{WSP(bf16_t, WS_OM), WSP(bf16_t, WS_WBR) + (size_t)2 * 2048 * 1024, TT, DM, 1024, 1024, 1024};
        unsigned char* Y8 = C.ws + WS_HB;
        const pg8::EpiGate<true> Ea{Y, DM, P + C_GA, NP, nullptr, 0}; const pg8::EpiGate<false> El{Y, DM, P + C_GL, NP, nullptr, 0}; const pg8::EpiGate<false, true> Em{Y, DM, P + C_GM, NP, Y8, DM};
        pg8::StaticOrder S; S.init(TT, DM, C.G, C.bid, l + 1 >= DEPTH);
        pg8::gemm_phase(C.lds, C.tid, ga, S, Ea); pg8::gemm_phase(C.lds, C.tid, gl, S, El); pg8::gemm_phase(C.lds, C.tid, gm, S, Em);
        if (l == 0) { const Ctx C2 = launder(C0); phase_cvt_peer_tables(C2, 0, 0, NEXP, S.nwg % C.G); }
    }
    if constexpr (K == 8) {
        pg8::Gemm g{WSP(bf16_t, WS_HB), WSP(bf16_t, WS_WOUT), TT, DM, DM, DM, DM};
        const pg8::EpiResidT<true> E{WSP(float, WS_XS), DM, modl + 2 * DM, WSP(float, WS_WOUTS)};
        pg8::StaticOrder S; S.init(TT, DM, C.G, C.bid, l + 1 >= DEPTH);
        pg8::gemm_phase<pg8::EpiResidT<true>, pg8::StaticOrder, 1>(C.lds, C.tid, g, S, E);
        if (l == 0 && DEPTH > 1) { const Ctx C2 = launder(C0); phase_cvt_peer_tables(C2, 1, 0, NEXP / 2, S.nwg % C.G); }
    }
    if constexpr (K == 9) phase_norm_mod<false>(C, INP(I_N2G) + l * DM, modl, 3 * DM, 4 * DM);
    if constexpr (K == 10) {
        pg8::Gemm g{WSP(bf16_t, WS_HB), WSP(bf16_t, WS_WQ), TT, DM, DM, DM, DM};
        pg8::EpiStoreBf16 E{WSP(bf16_t, WS_PQ), DM};
        pg8::StaticOrder S; S.init(TT, DM, C.G, C.bid, l + 1 >= DEPTH); pg8::gemm_phase(C.lds, C.tid, g, S, E);
        if (l == 0 && DEPTH > 1) { const Ctx C2 = launder(C0); phase_cvt_peer_tables(C2, 1, NEXP / 2, NEXP, S.nwg % C.G); }
    }
    if constexpr (K == 11) phase_peer_select(C, l + 1 >= DEPTH);
    if constexpr (K == 13) phase_final_norm(C);
    if constexpr (K == 12) {
#ifdef DBG_DUP12
        if (l + 1 < DEPTH) phase_peer_gather<false>(C, modl, 0.0f); else phase_peer_gather<true>(C, modl, 0.0f);
        __syncthreads();
#endif
        if (l + 1 < DEPTH) phase_peer_gather<false>(C, modl, DBG_PEER0); else phase_peer_gather<true>(C, modl, DBG_PEER1); }
}
__device__ __forceinline__ Ctx make_ctx(const Args& args, unsigned char* lds_raw) {
    Ctx C0; C0.in = (const __attribute__((address_space(4))) cfp_t*)__builtin_amdgcn_kernarg_segment_ptr(); C0.out = args.out; C0.ws = args.ws; C0.lds = (LAS unsigned char*)lds_raw;
    C0.tid = threadIdx.x; C0.lane = C0.tid & 63; C0.wid = __builtin_amdgcn_readfirstlane(C0.tid >> 6); C0.G = gridDim.x; C0.bid = blockIdx.x;
    return C0;
}
template <int K> __global__ void __launch_bounds__(NTHREADS, 2) k_one(Args args) {
    extern __shared__ __attribute__((aligned(16))) unsigned char lds_raw[];
    const Ctx C0 = make_ctx(args, lds_raw);
    run_phase<K>(C0, args.ph_lo);
}
#if MK_N_LAUNCHES == 1 || defined(DBG_HYB)
__global__ void __launch_bounds__(NTHREADS, 2) mk_fwd(Args args) {
    extern __shared__ __attribute__((aligned(16))) unsigned char lds_raw[];
    const Ctx C0 = make_ctx(args, lds_raw);
    if (C0.tid < 4) ((LAS unsigned*)(C0.lds + LDS_BAR_OFF))[C0.tid] = 0u;
    __syncthreads();
    const int lo = args.ph_lo, hi = args.ph_hi;
    XcdBarrier bar; bar.bar = (unsigned*)(args.ws + WS_CTL); bar.x = 0; bar.st = nullptr;
    if (hi - lo > 1) bar = xcd_barrier_post((unsigned*)(args.ws + WS_CTL), (volatile LAS unsigned*)(C0.lds + LDS_BAR_OFF));
#define IN(k) (lo <= (k) && (k) < hi)
#define SEAM(k) do { if (IN(k) && IN((k) + 1)) xcd_barrier(bar); } while (0)
#ifndef DBG_DUP
#define DBG_DUP -1
#endif
#define PH(K, k) do { if (IN(k)) { run_phase<K>(C0, l); if (K == DBG_DUP) { xcd_barrier(bar); run_phase<K>(C0, l); } } SEAM(k); } while (0)
    { const int l = 0; PH(0, 0); }
#pragma unroll 1
    for (int l = 0; l < DEPTH; ++l) {
        const int pb = 1 + 12 * l;
        PH(1, pb + 0); PH(2, pb + 1); PH(3, pb + 2); PH(4, pb + 3); PH(5, pb + 4); PH(6, pb + 5);
        PH(7, pb + 6); PH(8, pb + 7); PH(9, pb + 8); PH(10, pb + 9); PH(11, pb + 10); PH(12, pb + 11);
    }
    { const int l = DEPTH - 1; PH(13, 1 + 12 * DEPTH); }
#undef PH
#undef IN
#undef SEAM
}
#define MAIN_KERNEL mk_fwd
#else
#define MAIN_KERNEL k_one<6>
#endif


#ifdef DBG_PROBE
typedef int i32x8 __attribute__((ext_vector_type(8)));
__device__ __forceinline__ unsigned char fp8_of_int(int v) {
    const float f = (float)v; return (unsigned char)(__builtin_amdgcn_cvt_pk_fp8_f32(f, 0.f, 0, false) & 0xff); }
__global__ void k_probe_mx(unsigned* slot) {
    const int l = threadIdx.x, r = l & 15, g = l >> 4;
    float worst[2] = {0.f, 0.f};
    for (int hyp = 0; hyp < 2; ++hyp) {
        i32x8 A, B;
        for (int j = 0; j < 8; ++j) { unsigned wa = 0, wb = 0;
            for (int b = 0; b < 4; ++b) { const int i = 4 * j + b;
                const int k = hyp == 0 ? g * 32 + i : (i >> 3) * 32 + g * 8 + (i & 7);
                wa |= (unsigned)fp8_of_int(((3 * r + k) % 7) - 3) << (8 * b); wb |= (unsigned)fp8_of_int(((5 * k + 2 * r) % 9) - 4) << (8 * b); }
            A[j] = (int)wa; B[j] = (int)wb; }
        f32x4 c = {0.f, 0.f, 0.f, 0.f};
        c = __builtin_amdgcn_mfma_scale_f32_16x16x128_f8f6f4(A, B, c, 0, 0, 0, 0x7f7f7f7f, 0, 0x7f7f7f7f);
        for (int i = 0; i < 4; ++i) { const int m = 4 * g + i, n = r; float ref = 0.f; for (int k = 0; k < 128; ++k) ref += (float)(((3 * m + k) % 7) - 3) * (float)(((5 * k + 2 * n) % 9) - 4);
            worst[hyp] = fmaxf(worst[hyp], fabsf(c[i] - ref)); }
    }
    for (int o = 32; o >= 1; o >>= 1) { worst[0] = fmaxf(worst[0], __shfl_xor(worst[0], o)); worst[1] = fmaxf(worst[1], __shfl_xor(worst[1], o)); }
    if (l == 0) { const float code = worst[0] == 0.f ? 0.4f : (worst[1] == 0.f ? 0.8f : 1.2f); *slot = __float_as_uint(powf(10.f, code / 0.25f - 4.f)); }
}
#endif
#ifdef DBG_CHECK
__device__ __forceinline__ void dbg_report(unsigned* slot, float err) { if (!(err <= 3e38f)) err = 1e30f; atomicMax(slot, __float_as_uint(err)); }
__global__ void k_check_gemm(const bf16_t* A, int lda, const float* W, int K, int N, const bf16_t* Cm, int ldc, int M, unsigned* slot) {
    const unsigned id = blockIdx.x * blockDim.x + threadIdx.x; if (id >= 8192) return;
    const unsigned h = id * 2654435761u; const int row = (int)((h >> 8) % (unsigned)M), col = (int)((h * 40503u >> 7) % (unsigned)N);
    float ref = 0.f; for (int k = 0; k < K; ++k) ref += bf2f(A[(size_t)row * lda + k]) * W[(size_t)k * N + col];
    const float got = bf2f(Cm[(size_t)row * ldc + col]);
    dbg_report(slot, fabsf(got - ref) / (fabsf(ref) + 0.1f));
}

__global__ void k_check_attn(const unsigned char* ws, int type, unsigned* slot) {
    __shared__ float sc[RPB]; __shared__ float red[256]; __shared__ float qv[192];
    const int t = threadIdx.x, bh = blockIdx.x & 15, b = bh >> 3, h = bh & 7; const int qpos = (int)(((blockIdx.x >> 4) * 977u + 13u) % SEQ); const size_t rq = (size_t)b * RPB + CTXL + qpos, rk = (size_t)b * RPB;
    const bf16_t* P = (const bf16_t*)(ws + WS_P); const bf16_t* MQ = (const bf16_t*)(ws + WS_MQ); const bf16_t* MKV = (const bf16_t*)(ws + WS_MKV);
    const int dq = type ? 128 : 192;
    if (t < dq) { float v = type ? bf2f(P[rq * NP + C_AQ + h * 128 + t]) : bf2f(MQ[rq * 1536 + h * 192 + t]); qv[t] = v; }
    __syncthreads();
    if (!type && t < 32) {
        const int ri = qpos >> 6, ci = qpos & 63; const int i = t; const float pos = (float)(i < 16 ? ri : ci); const float inv = powf(10000.f, -(float)(i & 15) / 16.f); const float a = pos * inv;
        const float x1 = qv[128 + i], x2 = qv[160 + i]; qv[128 + i] = x1 * cosf(a) - x2 * sinf(a); qv[160 + i] = x2 * cosf(a) + x1 * sinf(a); }
    __syncthreads();
    const float scale = type ? 0.088388347648f : 0.0721687836487f;
    float mx = -1e30f;
    for (int k = t; k < RPB; k += 256) { float s = 0.f;
        if (type) { const bf16_t* kp = P + (rk + k) * NP + C_AK + (h >> 2) * 128; for (int d = 0; d < 128; ++d) s += qv[d] * bf2f(kp[d]); }
        else { const bf16_t* kp = MKV + (rk + k) * 2048 + h * 256; for (int d = 0; d < 128; ++d) s += qv[d] * bf2f(kp[d]); const bf16_t* kr = P + (rk + k) * NP + C_MKR; for (int d = 0; d < 64; ++d) s += qv[128 + d] * bf2f(kr[d]); }
        s *= scale; sc[k] = s; mx = fmaxf(mx, s); }
    red[t] = mx; __syncthreads(); for (int o = 128; o >= 1; o >>= 1) { if (t < o) red[t] = fmaxf(red[t], red[t + o]); __syncthreads(); } mx = red[0]; __syncthreads();
    float sum = 0.f; for (int k = t; k < RPB; k += 256) { const float p = __expf(sc[k] - mx); sc[k] = p; sum += p; }
    red[t] = sum; __syncthreads(); for (int o = 128; o >= 1; o >>= 1) { if (t < o) red[t] += red[t + o]; __syncthreads(); } sum = red[0]; __syncthreads();
    float e = 0.f, mag = 0.f;
    if (t < 128) { float o = 0.f; for (int k = 0; k < RPB; ++k) { const float vv = type ? bf2f(P[(rk + k) * NP + C_AV + (h >> 2) * 128 + t]) : bf2f(MKV[(rk + k) * 2048 + h * 256 + 128 + t]); o += sc[k] * vv; }
        o /= sum; const float got = bf2f(((const bf16_t*)(ws + (type ? WS_OA : WS_OM)))[rq * 1024 + h * 128 + t]); e = fabsf(got - o); mag = fabsf(o); }
    red[t] = e; __syncthreads(); for (int o = 128; o >= 1; o >>= 1) { if (t < o) red[t] = fmaxf(red[t], red[t + o]); __syncthreads(); } e = red[0]; __syncthreads();
    red[t] = mag; __syncthreads(); for (int o = 128; o >= 1; o >>= 1) { if (t < o) red[t] = fmaxf(red[t], red[t + o]); __syncthreads(); } mag = red[0];
    if (t == 0) dbg_report(slot, e / (mag + 1e-4f));
}
__global__ void __launch_bounds__(256) k_check_gla_rec(const unsigned char* ws, const float* wa_f, const float* ba_f, const float* wa_b, const float* ba_b, float* obuf, int b) {
    __shared__ float ad[128], kd[128], qd[128], lrs[16];
    const int e = threadIdx.x, h = blockIdx.x & 3, dir = blockIdx.x >> 2; const bf16_t* P = (const bf16_t*)(ws + WS_P);
    const float* wa = dir ? wa_b : wa_f; const float* ba = dir ? ba_b : ba_f;
    float S[128];
#pragma unroll
    for (int d = 0; d < 128; ++d) S[d] = 0.f;
    float* ob = obuf + ((size_t)(dir * 2 + b) * 4 + h) * RPB * 256;
    for (int st = 0; st < RPB; ++st) {
        int j; if (!dir) j = st; else j = st < CTXL ? CTXL - 1 - st : RPB - 1 - (st - CTXL);
        const size_t r = (size_t)b * RPB + j; const bf16_t* pr = P + r * NP;
        if (e < 16) lrs[e] = bf2f(pr[(dir ? C_LRB : C_LRF) + e]);
        __syncthreads();
        if (e < 128) { float pre = ba[h * 128 + e]; for (int q = 0; q < 16; ++q) pre += lrs[q] * wa[q * 512 + h * 128 + e];
            const float ls = (fminf(pre, 0.f) - log1pf(expf(-fabsf(pre)))) / 16.f; ad[e] = expf(ls); kd[e] = bf2f(pr[C_LK + h * 128 + e]); qd[e] = bf2f(pr[C_LQ + h * 128 + e]) * 0.088388347648f; }
        __syncthreads();
        const float v = bf2f(pr[C_LV + h * 256 + e]); float o = 0.f;
#pragma unroll
        for (int d = 0; d < 128; ++d) { S[d] = ad[d] * S[d] + kd[d] * v; o += qd[d] * S[d]; }
        ob[(size_t)j * 256 + e] = o;
        __syncthreads();
    }
}
__global__ void k_check_gla_cmp(const unsigned char* ws, const float* obuf, const float* gon, int b, unsigned* slot) {
    __shared__ float red[256];
    const int e = threadIdx.x, h = blockIdx.x & 3, j = blockIdx.x >> 2; const size_t r = (size_t)b * RPB + j; const bf16_t* P = (const bf16_t*)(ws + WS_P);
    const float o = obuf[((size_t)(0 * 2 + b) * 4 + h) * RPB * 256 + (size_t)j * 256 + e] + obuf[((size_t)(1 * 2 + b) * 4 + h) * RPB * 256 + (size_t)j * 256 + e];
    red[e] = o * o; __syncthreads(); for (int s_ = 128; s_ >= 1; s_ >>= 1) { if (e < s_) red[e] += red[e + s_]; __syncthreads(); }
    const float rs = rsqrtf(red[0] / 256.f + NORM_EPS); __syncthreads();
    const float gt = bf2f(P[r * NP + C_LG + h * 256 + e]); const float ref = o * rs * gon[e] * (gt / (1.f + expf(-gt)));
    const float got = bf2f(((const bf16_t*)(ws + WS_OL))[r * 1024 + h * 256 + e]);
    red[e] = fabsf(got - ref); __syncthreads(); for (int s_ = 128; s_ >= 1; s_ >>= 1) { if (e < s_) red[e] = fmaxf(red[e], red[e + s_]); __syncthreads(); }
    if (e == 0) dbg_report(slot, red[0] / 1.0f);
}

__global__ void k_check_gemm8(const unsigned char* A8, const float* W, int K, int N, const bf16_t* Cm, int ldc, int M, unsigned* slot) {
    const unsigned id = blockIdx.x * blockDim.x + threadIdx.x; if (id >= 8192) return;
    const unsigned h = id * 2654435761u; const int row = (int)((h >> 8) % (unsigned)M), col = (int)((h * 40503u >> 7) % (unsigned)N);
    float ref = 0.f, mag = 0.f; for (int k = 0; k < K; ++k) { const float a = __builtin_amdgcn_cvt_f32_fp8((int)A8[(size_t)row * K + k], 0), w = W[(size_t)k * N + col]; ref += a * w; mag += a * a * w * w; }
    const float got = bf2f(Cm[(size_t)row * ldc + col]);
    dbg_report(slot, fabsf(got - ref) / (sqrtf(mag) + 1e-3f));
}
__global__ void k_check_select(const bf16_t* PQ, const float* k1, const float* k2, const int* PIDX, const float* PG, unsigned* slot) {
    __shared__ float s1[128], s2[128]; __shared__ int cnt; __shared__ float selv[16];
    const int tok = (blockIdx.x >> 3) * 61 + 5, head = blockIdx.x & 7, t = threadIdx.x;
    if (t == 0) cnt = 0;
    for (int n = t; n < 128; n += 64) { float a = 0.f, b = 0.f; for (int d = 0; d < 128; ++d) { a += bf2f(PQ[(size_t)tok * DM + head * 256 + d]) * k1[((size_t)head * 128 + n) * 128 + d]; b += bf2f(PQ[(size_t)tok * DM + head * 256 + 128 + d]) * k2[((size_t)head * 128 + n) * 128 + d]; } s1[n] = a; s2[n] = b; }
    __syncthreads();
    if (t < 16) { const int id = PIDX[(size_t)tok * 128 + head * 16 + t]; selv[t] = (id >= 0 && id < 16384) ? s1[id >> 7] + s2[id & 127] : -1e30f; }
    __syncthreads();
    float thr = selv[0], mx = selv[0]; for (int k = 1; k < 16; ++k) { thr = fminf(thr, selv[k]); mx = fmaxf(mx, selv[k]); }
    int c = 0; for (int p = t; p < 16384; p += 64) if (s1[p >> 7] + s2[p & 127] > thr + 0.02f) ++c;
    atomicAdd(&cnt, c); __syncthreads();
    if (t == 0) { float den = 0.f; for (int k = 0; k < 16; ++k) den += __expf(selv[k] - mx); float e = fabsf((float)cnt - 15.f) / 15.f > 0.34f ? fabsf((float)cnt - 15.f) / 15.f : 0.f;
        for (int k = 0; k < 16; ++k) e = fmaxf(e, fabsf(PG[(size_t)tok * 128 + head * 16 + k] - __expf(selv[k] - mx) / den) * 4.f);
        for (int k = 0; k < 16; ++k) for (int k2_ = 0; k2_ < k; ++k2_) if (PIDX[(size_t)tok * 128 + head * 16 + k] == PIDX[(size_t)tok * 128 + head * 16 + k2_]) e = fmaxf(e, 10.f);
        dbg_report(slot, e); }
}
__global__ void k_check_gather(const bf16_t* HB, const float* u, const float* v, const int* PIDX, const float* PG, const float* dbgo, unsigned* slot) {
    __shared__ float w[128];
    const int tok = blockIdx.x * 64 + 300, t = threadIdx.x;
    for (int k = t; k < 128; k += 64) { const int id = PIDX[(size_t)tok * 128 + k] & 16383; float a = 0.f; for (int d = 0; d < DM; ++d) a += bf2f(HB[(size_t)tok * DM + d]) * u[(size_t)id * DM + d];
        w[k] = PG[(size_t)tok * 128 + k] * 0.5f * a * (1.0f + erff(a * 0.70710678f)); }
    __syncthreads();
    float e = 0.f, sc = 0.f;
    for (int d = t; d < DM; d += 64) { float o = 0.f; for (int k = 0; k < 128; ++k) o += w[k] * v[(size_t)(PIDX[(size_t)tok * 128 + k] & 16383) * DM + d];
        e = fmaxf(e, fabsf(o - dbgo[(size_t)tok * DM + d])); sc = fmaxf(sc, fabsf(o)); }
    for (int o_ = 32; o_ >= 1; o_ >>= 1) { e = fmaxf(e, __shfl_xor(e, o_)); sc = fmaxf(sc, __shfl_xor(sc, o_)); }
    if (t == 0) dbg_report(slot, e / (sc + 1e-6f));
}
__global__ void k_dbg_out2(const float* x, const float* fg, float* out, const unsigned* slot) {
    const float mx = __uint_as_float(*slot); float v = 0.25f * (log10f(fmaxf(mx, 1e-30f)) + 4.0f); v = fminf(fmaxf(v, 0.f), 9.f);
    const float f = 1.0f + v;
    const int lane = threadIdx.x & 63; const size_t r = (size_t)blockIdx.x * 4 + (threadIdx.x >> 6);
    const float* xr = x + r * DM; float ss = 0.f;
    for (int c = lane; c < DM; c += 64) ss += xr[c] * xr[c];
    ss = wave_sum(ss); const float rs = rsqrtf(ss / DM + NORM_EPS);
    for (int c = lane; c < DM; c += 64) out[r * DM + c] = xr[c] * rs * fg[c] * f;
}
#endif
#ifdef DBG_SCAN
__global__ void k_scan16(const bf16_t* p, size_t n, unsigned* flags, int stage) {
    unsigned bad = 0; for (size_t i = (size_t)blockIdx.x * blockDim.x + threadIdx.x; i < n; i += (size_t)gridDim.x * blockDim.x) bad |= ((p[i] & 0x7f80u) == 0x7f80u);
    if (bad) atomicOr(&flags[stage], 1u);
}
__global__ void k_scan32(const float* p, size_t n, unsigned* flags, int stage) {
    unsigned bad = 0; for (size_t i = (size_t)blockIdx.x * blockDim.x + threadIdx.x; i < n; i += (size_t)gridDim.x * blockDim.x) bad |= ((__float_as_uint(p[i]) & 0x7f800000u) == 0x7f800000u);
    if (bad) atomicOr(&flags[stage], 1u);
}
__global__ void k_dbg_out(const float* x, const float* fg, float* out, const unsigned* flags, int nstage) {
    int code = 0; for (int s = nstage; s >= 1; --s) if (flags[s]) code = s;
    const float f = 1.0f + 0.25f * (float)code;
    const int lane = threadIdx.x & 63; const size_t r = (size_t)blockIdx.x * 4 + (threadIdx.x >> 6);
    const float* xr = x + r * DM; float ss = 0.f;
    for (int c = lane; c < DM; c += 64) ss += xr[c] * xr[c];
    ss = wave_sum(ss); const float rs = rsqrtf(ss / DM + NORM_EPS);
    for (int c = lane; c < DM; c += 64) out[r * DM + c] = xr[c] * rs * fg[c] * f;
}
#endif
extern "C" void kernel_launch(void* const* d_in, const int* in_sizes, int n_in, void* d_out, int out_size, void* d_ws, size_t ws_size, hipStream_t stream) {
    static int grid = 0;
    if (grid == 0) {
        if (n_in != 30 || out_size != NBATCH * SEQ * DM || ws_size < WS_END) { fprintf(stderr, "kernel_launch: shape/workspace mismatch: n_in %d out %d ws %zu (need %zu)\n", n_in, out_size, ws_size, (size_t)WS_END); grid = -1; return; }
        int dev = 0, cus = 0, per_cu = 0;
        if (hipGetDevice(&dev) != hipSuccess || hipDeviceGetAttribute(&cus, hipDeviceAttributeMultiprocessorCount, dev) != hipSuccess) { grid = -1; return; }
        bool okattr = hipFuncSetAttribute((const void*)MAIN_KERNEL, hipFuncAttributeMaxDynamicSharedMemorySize, LDS_BYTES) == hipSuccess;
#if MK_N_LAUNCHES != 1
#ifdef DBG_HYB
        okattr = okattr && hipFuncSetAttribute((const void*)mk_fwd, hipFuncAttributeMaxDynamicSharedMemorySize, LDS_BYTES) == hipSuccess;
#endif
#define SETA(K) okattr = okattr && hipFuncSetAttribute((const void*)k_one<K>, hipFuncAttributeMaxDynamicSharedMemorySize, LDS_BYTES) == hipSuccess
        SETA(0); SETA(1); SETA(2); SETA(3); SETA(4); SETA(5); SETA(6); SETA(7); SETA(8); SETA(9); SETA(10); SETA(11); SETA(12); SETA(13);
#undef SETA
#endif
        if (!okattr) { fprintf(stderr, "kernel_launch: hipFuncSetAttribute failed\n"); grid = -1; return; }
        if (hipOccupancyMaxActiveBlocksPerMultiprocessor(&per_cu, (const void*)MAIN_KERNEL, NTHREADS, LDS_BYTES) != hipSuccess || per_cu < 1) { fprintf(stderr, "kernel_launch: occupancy query says %d blocks per CU\n", per_cu); grid = -1; (void)hipGetLastError(); return; }
        grid = cus;
    }
    if (grid < 0) return;
    if (hipMemsetAsync((char*)d_ws + WS_CTL, 0, CTL_BYTES, stream) != hipSuccess) return;
    Args a{};
    for (int i = 0; i < 30; ++i) a.in[i] = (const float*)d_in[i];
    a.out = (float*)d_out; a.ws = (unsigned char*)d_ws;
#if defined(DBG_PROBE)
    { unsigned* flags = (unsigned*)((char*)d_ws + WS_CTL + 32768);
      hipLaunchKernelGGL(k_probe_mx, dim3(1), dim3(64), 0, stream, flags + 100);
      hipLaunchKernelGGL(k_dbg_out2, dim3(NBATCH * SEQ / 4), dim3(256), 0, stream, (const float*)d_in[0], (const float*)d_in[29], (float*)d_out, flags + 100); }
#elif MK_N_LAUNCHES == 1 && defined(DBG_CHECK)
    {
        unsigned* flags = (unsigned*)((char*)d_ws + WS_CTL + 32768); char* W = (char*)d_ws;
        a.ph_lo = 0; a.ph_hi = (DBG_CHECK == 8) ? 3 : (DBG_CHECK >= 5) ? 7 : (DBG_CHECK == 1 ? 11 : (DBG_CHECK == 2 ? 12 : 13));
        hipLaunchKernelGGL(mk_fwd, dim3(grid), dim3(NTHREADS), LDS_BYTES, stream, a);
#if DBG_CHECK == 8
        hipLaunchKernelGGL(k_check_gemm8, dim3(32), dim3(256), 0, stream, (const unsigned char*)(W + WS_HB), (const float*)d_in[I_WIN], DM, IN_COLS, (const bf16_t*)(W + WS_P), NP, TT, flags + 100);
#elif DBG_CHECK == 5 || DBG_CHECK == 6
        hipLaunchKernelGGL(k_check_attn, dim3(16 * 24), dim3(256), 0, stream, (const unsigned char*)d_ws, DBG_CHECK == 5 ? 1 : 0, flags + 100);
#elif DBG_CHECK == 7
        { float* obuf = (float*)(W + WS_MQ);
          hipLaunchKernelGGL(k_check_gla_rec, dim3(8), dim3(256), 0, stream, (const unsigned char*)d_ws, (const float*)d_in[I_WA2F], (const float*)d_in[I_BAF], (const float*)d_in[I_WA2B], (const float*)d_in[I_BAB], obuf, 0);
          hipLaunchKernelGGL(k_check_gla_cmp, dim3(RPB * 4), dim3(256), 0, stream, (const unsigned char*)d_ws, (const float*)obuf, (const float*)d_in[I_ONG], 0, flags + 100); }
#elif DBG_CHECK == 1
        hipLaunchKernelGGL(k_check_gemm, dim3(32), dim3(256), 0, stream, (const bf16_t*)(W + WS_HB), DM, (const float*)d_in[I_PWQ], DM, DM, (const bf16_t*)(W + WS_PQ), DM, TT, flags + 100);
#elif DBG_CHECK == 2
        hipLaunchKernelGGL(k_check_select, dim3(256 * 8), dim3(64), 0, stream, (const bf16_t*)(W + WS_PQ), (const float*)d_in[I_PK1], (const float*)d_in[I_PK2], (const int*)(W + WS_PIDX), (const float*)(W + WS_PG), flags + 100);
#else
        hipLaunchKernelGGL(k_check_gather, dim3(128), dim3(64), 0, stream, (const bf16_t*)(W + WS_HB), (const float*)d_in[I_PU], (const float*)d_in[I_PV], (const int*)(W + WS_PIDX), (const float*)(W + WS_PG), (const float*)(W + WS_MQ), flags + 100);
#endif
        hipLaunchKernelGGL(k_dbg_out2, dim3(NBATCH * SEQ / 4), dim3(256), 0, stream, (const float*)d_in[0], (const float*)d_in[29], (float*)d_out, flags + 100);
    }
#elif MK_N_LAUNCHES == 1
#ifdef DBG_SPLIT
    for (int p = 0; p < N_PHASES; p += DBG_SPLIT) { a.ph_lo = p; a.ph_hi = p + DBG_SPLIT < N_PHASES ? p + DBG_SPLIT : N_PHASES; hipLaunchKernelGGL(mk_fwd, dim3(grid), dim3(NTHREADS), LDS_BYTES, stream, a); }
#else
    a.ph_lo = 0; a.ph_hi = N_PHASES;
    hipLaunchKernelGGL(mk_fwd, dim3(grid), dim3(NTHREADS), LDS_BYTES, stream, a);
#endif
#else
    a.ph_hi = 0;
#ifndef DBG_NLAUNCH
#define DBG_NLAUNCH 100
#endif
    int nl_ = 0;
#ifdef DBG_HYB
#define LAUNCH1(K, L) do { if (K == DBG_HYB) { a.ph_lo = 12 * (L) + (K); a.ph_hi = a.ph_lo + 1; hipLaunchKernelGGL(mk_fwd, dim3(grid), dim3(NTHREADS), LDS_BYTES, stream, a); a.ph_hi = 0; } else { a.ph_lo = (L); hipLaunchKernelGGL(k_one<K>, dim3(grid), dim3(NTHREADS), LDS_BYTES, stream, a); } } while (0)
#else
#define LAUNCH1(K, L) do { a.ph_lo = (L); if (nl_++ < DBG_NLAUNCH) { hipLaunchKernelGGL(k_one<K>, dim3(grid), dim3(NTHREADS), LDS_BYTES, stream, a); if (K == DBG_DUP) hipLaunchKernelGGL(k_one<K>, dim3(grid), dim3(NTHREADS), LDS_BYTES, stream, a); } } while (0)
#endif
#ifdef DBG_SCAN
    unsigned* flags = (unsigned*)((char*)d_ws + WS_CTL + 32768);
    char* W = (char*)d_ws;
#define S16(off, n, st) hipLaunchKernelGGL(k_scan16, dim3(1024), dim3(256), 0, stream, (const bf16_t*)(W + (off)), (size_t)(n), flags, st)
#define S32(off, n, st) hipLaunchKernelGGL(k_scan32, dim3(1024), dim3(256), 0, stream, (const float*)(W + (off)), (size_t)(n), flags, st)
    LAUNCH1(0, 0); S32(WS_MODV, 2 * 3 * 12288, 1);
    { const int l = 0;
      LAUNCH1(1, l); S16(WS_HB, (size_t)TT * DM, 2);
      LAUNCH1(2, l); S16(WS_P, (size_t)TT * NP, 3);
      LAUNCH1(3, l); S16(WS_P, (size_t)TT * NP, 4);
      LAUNCH1(4, l); S16(WS_MQ, (size_t)TT * 1536, 5); S16(WS_MKV, (size_t)TT * 2048, 5); S16(WS_GST, (size_t)2112 * 32768, 6); S32(WS_GDEC, (size_t)2112 * 128, 6);
      LAUNCH1(5, l); S16(WS_GST, (size_t)2112 * 32768, 7);
      LAUNCH1(6, l); S16(WS_OA, (size_t)TT * 1024, 8); S16(WS_OM, (size_t)TT * 1024, 9); S16(WS_OL, (size_t)TT * 1024, 10);
      LAUNCH1(7, l); S16(WS_Y, (size_t)TT * DM, 11);
      LAUNCH1(8, l); S32(WS_XS, (size_t)TT * DM, 12);
      LAUNCH1(9, l); S16(WS_HB, (size_t)TT * DM, 13);
      LAUNCH1(10, l); S16(WS_PQ, (size_t)TT * DM, 14);
      LAUNCH1(11, l); S32(WS_PG, (size_t)TT * 128, 15);
      LAUNCH1(12, l); S32(WS_XS, (size_t)TT * DM, 16);
    }
    hipLaunchKernelGGL(k_dbg_out, dim3(NBATCH * SEQ / 4), dim3(256), 0, stream, (const float*)d_in[0], (const float*)d_in[29], (float*)d_out, flags, 16);
#elif defined(DBG_CHECK)
    unsigned* flags = (unsigned*)((char*)d_ws + WS_CTL + 32768);
    char* W = (char*)d_ws;
    LAUNCH1(0, 0);
    { const int l = 0; LAUNCH1(1, l); LAUNCH1(2, l); LAUNCH1(3, l); LAUNCH1(4, l); LAUNCH1(5, l); LAUNCH1(6, l);
#if DBG_CHECK == 5 || DBG_CHECK == 6
      hipLaunchKernelGGL(k_check_attn, dim3(16 * 24), dim3(256), 0, stream, (const unsigned char*)d_ws, DBG_CHECK == 5 ? 1 : 0, flags + 100);
#endif
#if DBG_CHECK == 7
      { float* obuf = (float*)(W + WS_MQ);
        hipLaunchKernelGGL(k_check_gla_rec, dim3(8), dim3(256), 0, stream, (const unsigned char*)d_ws, (const float*)d_in[I_WA2F], (const float*)d_in[I_BAF], (const float*)d_in[I_WA2B], (const float*)d_in[I_BAB], obuf, 0);
        hipLaunchKernelGGL(k_check_gla_cmp, dim3(RPB * 4), dim3(256), 0, stream, (const unsigned char*)d_ws, (const float*)obuf, (const float*)d_in[I_ONG], 0, flags + 100); }
#endif
      LAUNCH1(7, l); LAUNCH1(8, l); LAUNCH1(9, l); LAUNCH1(10, l);
#if DBG_CHECK == 1
      hipLaunchKernelGGL(k_check_gemm, dim3(32), dim3(256), 0, stream, (const bf16_t*)(W + WS_HB), DM, (const float*)d_in[I_PWQ], DM, DM, (const bf16_t*)(W + WS_PQ), DM, TT, flags + 100);
#endif
      LAUNCH1(11, l);
#if DBG_CHECK == 2
      hipLaunchKernelGGL(k_check_select, dim3(256 * 8), dim3(64), 0, stream, (const bf16_t*)(W + WS_PQ), (const float*)d_in[I_PK1], (const float*)d_in[I_PK2], (const int*)(W + WS_PIDX), (const float*)(W + WS_PG), flags + 100);
#endif
      LAUNCH1(12, l);
#if DBG_CHECK == 3
      hipLaunchKernelGGL(k_check_gather, dim3(128), dim3(64), 0, stream, (const bf16_t*)(W + WS_HB), (const float*)d_in[I_PU], (const float*)d_in[I_PV], (const int*)(W + WS_PIDX), (const float*)(W + WS_PG), (const float*)(W + WS_MQ), flags + 100);
#endif
    }
    hipLaunchKernelGGL(k_dbg_out2, dim3(NBATCH * SEQ / 4), dim3(256), 0, stream, (const float*)d_in[0], (const float*)d_in[29], (float*)d_out, flags + 100);
#else
    LAUNCH1(0, 0);
    for (int l = 0; l < DEPTH; ++l) { LAUNCH1(1, l); LAUNCH1(2, l); LAUNCH1(3, l);
#ifdef DBG_DUP23
        LAUNCH1(2, l); LAUNCH1(3, l);
#endif
        LAUNCH1(4, l); LAUNCH1(5, l);
#ifdef DBG_DUP45
        LAUNCH1(4, l); LAUNCH1(5, l);
#endif
        LAUNCH1(6, l); LAUNCH1(7, l); LAUNCH1(8, l); LAUNCH1(9, l); LAUNCH1(10, l); LAUNCH1(11, l); LAUNCH1(12, l); }
    LAUNCH1(13, DEPTH - 1);
#endif
#undef LAUNCH1
#endif
    const hipError_t le = hipPeekAtLastError();
    if (le != hipSuccess) fprintf(stderr, "kernel_launch: launch failed: %s\n", hipGetErrorName(le));
}
```

```cpp
#include <hip/hip_runtime.h>
#include <cstdio>
#include <cstdint>

#ifndef MK_N_LAUNCHES
#ifndef DBG_DUP
#define DBG_DUP -1
#endif
#define MK_N_LAUNCHES 1
#endif

#ifndef DBG_MIX0
#define DBG_MIX0 1.0f
#define DBG_MIX1 1.0f
#define DBG_PEER0 1.0f
#define DBG_PEER1 1.0f
#endif
#ifndef MLA_NQR
#define MLA_NQR 4
#endif
#define LAS __attribute__((address_space(3)))
#define GLB __attribute__((address_space(1)))
typedef unsigned short bf16_t;
typedef short bf16x8 __attribute__((ext_vector_type(8)));
typedef short s16x4 __attribute__((ext_vector_type(4)));
typedef float f32x4 __attribute__((ext_vector_type(4)));
typedef float f32x2 __attribute__((ext_vector_type(2)));
typedef float f32x16 __attribute__((ext_vector_type(16)));
typedef unsigned u32x4 __attribute__((ext_vector_type(4)));
typedef unsigned u32x2 __attribute__((ext_vector_type(2)));
typedef __bf16 bf2_t __attribute__((ext_vector_type(2)));

constexpr int DM = 2048, NBATCH = 2, SEQ = 8192, CTXL = 256, DEPTH = 2;
constexpr int RPB = SEQ + CTXL;
constexpr int TT = NBATCH * RPB;
constexpr int IN_COLS = 11872, NP = 12032;
constexpr int C_AQ = 0, C_AK = 1024, C_AV = 1280, C_LQ = 1536, C_LK = 2048, C_LV = 2560, C_LG = 3584, C_LRF = 4608, C_LRB = 4624,
              C_MCQ = 4640, C_MCKV = 5152, C_MKR = 5664, C_GA = 5728, C_GL = 7776, C_GM = 9824;
constexpr int NCH = RPB / 64;
constexpr int NEXP = 16384;
constexpr float NORM_EPS = 1e-6f;
constexpr int NTHREADS = 512;

constexpr size_t al256(size_t x) { return (x + 255) / 256 * 256; }
constexpr size_t WS_CTL   = 0;
constexpr size_t CTL_BYTES = 65536;
constexpr size_t WS_MODV  = WS_CTL + CTL_BYTES;
constexpr size_t WS_TABA  = al256(WS_MODV + (size_t)2 * 3 * 12288 * 4);
constexpr size_t WS_TABM  = WS_TABA + 2 * 128 * 32 * 4;
constexpr size_t WS_XS    = al256(WS_TABM + 2 * 128 * 16 * 4);
constexpr size_t WS_HB    = WS_XS + (size_t)TT * DM * 4;
constexpr size_t WS_P     = WS_HB + (size_t)TT * DM * 2;
constexpr size_t WS_MQ    = WS_P + (size_t)TT * NP * 2;
constexpr size_t WS_MKV   = WS_MQ + (size_t)TT * 1536 * 2;
constexpr size_t WS_OA    = WS_MKV + (size_t)TT * 2048 * 2;
constexpr size_t WS_OL    = WS_OA + (size_t)TT * 1024 * 2;
constexpr size_t WS_OM    = WS_OL + (size_t)TT * 1024 * 2;
constexpr size_t WS_WIN   = WS_OM + (size_t)TT * 1024 * 2;
constexpr size_t WS_WUQ   = WS_WIN + (size_t)NP * 2048 * 2;
constexpr size_t WS_WUKV  = WS_WUQ + (size_t)1536 * 512 * 2;
constexpr size_t WS_WBR   = WS_WUKV + (size_t)2048 * 512 * 2;
constexpr size_t WS_WOUT  = WS_WBR + (size_t)3 * 2048 * 1024 * 2;
constexpr size_t WS_WQ    = WS_WOUT + (size_t)2048 * 2048 * 2;
constexpr size_t WS_K1    = WS_WQ + (size_t)2048 * 2048 * 2;
constexpr size_t WS_K2    = WS_K1 + (size_t)8 * 128 * 128 * 2;
constexpr size_t WS_GST   = WS_K2 + (size_t)8 * 128 * 128 * 2;
constexpr size_t WS_GDEC  = WS_GST + (size_t)NBATCH * 2 * 4 * NCH * 32768 * 2;
constexpr size_t WS_END0  = WS_GDEC + (size_t)NBATCH * 2 * 4 * NCH * 128 * 4;
constexpr size_t WS_Y     = WS_MKV;
constexpr size_t WS_PQ    = WS_OA;
constexpr size_t WS_PIDX  = WS_P;
constexpr size_t WS_PG    = WS_PIDX + (size_t)TT * 128 * 4;
constexpr size_t PT_BYTES = 2 * (size_t)NEXP * DM + 2 * (size_t)NEXP * 4;
constexpr size_t WS_WINS  = WS_END0;
constexpr size_t WS_WOUTS = al256(WS_WINS + (size_t)NP * 4);
constexpr size_t WS_WBRS  = al256(WS_WOUTS + (size_t)DM * 4);
constexpr size_t WS_PT    = al256(WS_WBRS + (size_t)3 * DM * 4);
constexpr size_t WS_END   = WS_PT + DEPTH * PT_BYTES;
constexpr size_t PT_U8 = 0, PT_V8 = (size_t)NEXP * DM, PT_SCU = 2 * (size_t)NEXP * DM, PT_SCV = PT_SCU + (size_t)NEXP * 4;
static_assert(WS_PG + (size_t)TT * 128 * 4 <= WS_MQ, "PEER alias region overflows P");

__device__ __forceinline__ unsigned cvt_pk_bf16(float lo, float hi) { bf2_t v; v.x = (__bf16)lo; v.y = (__bf16)hi; return __builtin_bit_cast(unsigned, v); }
__device__ __forceinline__ bf16_t f2bf(float f) { return (bf16_t)(cvt_pk_bf16(f, 0.f) & 0xffffu); }
__device__ __forceinline__ float bf2f(bf16_t b) { return __uint_as_float(((unsigned)b) << 16); }
__device__ __forceinline__ float bflo(unsigned w) { return __uint_as_float(w << 16); }
__device__ __forceinline__ float bfhi(unsigned w) { return __uint_as_float(w & 0xffff0000u); }
__device__ __forceinline__ float xchg32(float x, int lane) { auto r = __builtin_amdgcn_permlane32_swap(__float_as_uint(x), __float_as_uint(x), false, false); return __uint_as_float(lane < 32 ? r[1] : r[0]); }
__device__ __forceinline__ float xchg16(float x, int lane) { auto r = __builtin_amdgcn_permlane16_swap(__float_as_uint(x), __float_as_uint(x), false, false); return __uint_as_float((lane & 16) ? r[0] : r[1]); }
template <int CTRL> __device__ __forceinline__ float dppmov(float x) { return __uint_as_float(__builtin_amdgcn_update_dpp(0u, __float_as_uint(x), CTRL, 0xF, 0xF, false)); }
constexpr int DPP_ROR8 = 0x128, DPP_HMIRROR = 0x141, DPP_Q3210 = 0x1B, DPP_Q1032 = 0xB1;
__device__ __forceinline__ float wave_sum(float v) {
    const int lane = threadIdx.x & 63;
    v += xchg32(v, lane); v += xchg16(v, lane); v += dppmov<DPP_ROR8>(v); v += dppmov<DPP_HMIRROR>(v); v += dppmov<DPP_Q3210>(v); v += dppmov<DPP_Q1032>(v);
    return v;
}
__device__ __forceinline__ float sigmoidf_(float x) { return __builtin_amdgcn_rcpf(1.0f + __expf(-x)); }
__device__ __forceinline__ float siluf_(float x) { return x * __builtin_amdgcn_rcpf(1.0f + __expf(-x)); }

#define XB_TMO      128
#define XB_XCNT(j)  (256  + 64 * (j))
#define XB_XSUB(j)  (1280 + 64 * (j))
#define XB_XGEN(j)  (2304 + 64 * (j))
#define XB_TOP      3328
#define XB_TOPGEN   3392
#define XCD_BAR_WORDS 3456
#define XB_SPIN_CAP (1u << 20)
__device__ __forceinline__ unsigned xb_ld(unsigned* p)              { return __hip_atomic_load(p, __ATOMIC_RELAXED, __HIP_MEMORY_SCOPE_AGENT); }
__device__ __forceinline__ unsigned xb_add(unsigned* p, unsigned v) { return __hip_atomic_fetch_add(p, v, __ATOMIC_RELAXED, __HIP_MEMORY_SCOPE_AGENT); }
__device__ __forceinline__ unsigned xb_xcc_id() { return (unsigned)__builtin_amdgcn_s_getreg((3 << 11) | 20) & 0xFu; }
#define XB_SPIN(cond, bar) do { unsigned _sp = 0; while (cond) { __builtin_amdgcn_s_sleep(1); \
    if ((++_sp & 255u) == 0u) { if (xb_ld(&(bar)[XB_TMO])) break; if (_sp > XB_SPIN_CAP) { atomicAdd(&(bar)[XB_TMO], 1u); break; } } } } while (0)
struct XcdBarrier { unsigned* bar; unsigned x; volatile LAS unsigned* st; };
__device__ __forceinline__ XcdBarrier xcd_barrier_post(unsigned* bar, volatile LAS unsigned* st) {
    XcdBarrier b; b.bar = bar; b.x = xb_xcc_id(); b.st = st;
    if (threadIdx.x == 0) (void)xb_add(&bar[XB_XCNT(b.x)], 1u);
    return b;
}
__device__ __forceinline__ void xcd_barrier_complete(unsigned* bar, unsigned x, unsigned& nloc, unsigned& nx) {
    const unsigned G = gridDim.x * gridDim.y * gridDim.z;
    unsigned sum, cnt, mine, sp = 0u;
    for (;;) {
        sum = 0u; cnt = 0u; mine = 0u;
#pragma unroll
        for (unsigned j = 0; j < 16; ++j) { const unsigned c = xb_ld(&bar[XB_XCNT(j)]); sum += c; cnt += (c > 0u) ? 1u : 0u; mine = (j == x) ? c : mine; }
        if (sum == G) break;
        __builtin_amdgcn_s_sleep(1);
        if ((++sp & 255u) == 0u) { if (xb_ld(&bar[XB_TMO])) break; if (sp > XB_SPIN_CAP) { atomicAdd(&bar[XB_TMO], 1u); break; } }
    }
    nloc = mine > 0u ? mine : 1u; nx = cnt > 0u ? cnt : 1u;
}
__device__ __forceinline__ void xcd_barrier(const XcdBarrier& b) {
    asm volatile("s_waitcnt vmcnt(0)" ::: "memory");
    __syncthreads();
    if (threadIdx.x == 0) {
        unsigned* bar = b.bar;
        __builtin_amdgcn_s_waitcnt(0);
        unsigned nloc = b.st[0], nx = b.st[1];
        if (nloc == 0u) { xcd_barrier_complete(bar, b.x, nloc, nx); b.st[0] = nloc; b.st[1] = nx; }
        const unsigned old = xb_add(&bar[XB_XSUB(b.x)], 1u);
        const unsigned gen = old / nloc;
        if (old + 1u == (gen + 1u) * nloc) {
            __builtin_amdgcn_fence(__ATOMIC_RELEASE, "agent");
            asm volatile("s_waitcnt vmcnt(0)" ::: "memory");
            const unsigned og = xb_add(&bar[XB_TOP], 1u);
            const unsigned tg = og / nx;
            if (og + 1u == (tg + 1u) * nx) xb_add(&bar[XB_TOPGEN], 1u);
            else XB_SPIN(xb_ld(&bar[XB_TOPGEN]) == tg, bar);
            __builtin_amdgcn_fence(__ATOMIC_ACQUIRE, "agent");
            xb_add(&bar[XB_XGEN(b.x)], 1u);
            asm volatile("s_waitcnt vmcnt(0)" ::: "memory");
        } else {
            XB_SPIN(xb_ld(&bar[XB_XGEN(b.x)]) == gen, bar);
            __builtin_amdgcn_fence(__ATOMIC_ACQUIRE, "agent");
            asm volatile("s_waitcnt vmcnt(0)" ::: "memory");
        }
    }
    __syncthreads();
}

namespace pg8 {
constexpr int BM = 256, BK = 64, HALF = 128, HTB = HALF * BK * 2, STAGE_BYTES = 8 * HTB, NXCD = 8, WGM = 8;
__host__ __device__ __forceinline__ int lds_byte(int r, int c) { const int st = (r >> 4) * 2 + (c >> 5), rr = r & 15, cc = c & 31, ob = rr * 64 + cc * 2; return st * 1024 + (ob ^ (((ob >> 9) & 1) << 5)); }
__host__ __device__ __forceinline__ void stage_rc(int b, int& R, int& C) { const int st = b / 1024, sb = b % 1024, swz = sb ^ (((sb >> 9) & 1) << 5); R = (st >> 1) * 16 + swz / 64; C = (st & 1) * 32 + (swz % 64) / 2; }
__host__ __device__ __forceinline__ int perm32(int rho) { const int n = rho >> 4, i = rho & 15; return 8 * (i >> 2) + 4 * n + (i & 3); }
struct Unit { int pm, pn; };
struct Gemm { const bf16_t* A; const bf16_t* Bt; int M, N, K, lda, ldb; };
struct StaticOrder {
    int nM, nN, nwg, G, c, latent;
    __host__ __device__ void init(int M, int N, int G_, int c_, int latent_ = 0) { latent = latent_; nM = latent_ ? 64 : M / BM; nN = N / BM; nwg = nM * nN; G = G_; c = c_; }
    __host__ __device__ bool next(int i, Unit& u) const {
        const long L = (long)i * G + c; if (L >= nwg) return false;
        int wgid = (int)L; { const int q = nwg / NXCD, r = nwg % NXCD, xcd = wgid % NXCD, off = wgid / NXCD; wgid = (xcd < r ? xcd * (q + 1) : r * (q + 1) + (xcd - r) * q) + off; }
        const int nig = WGM * nN, gid = wgid / nig, fm = gid * WGM, gsz = (nM - fm) < WGM ? (nM - fm) : WGM;
        u.pm = fm + ((wgid % nig) % gsz); u.pn = (wgid % nig) / gsz; if (latent) u.pm += 1 + (u.pm >= 32 ? 1 : 0); return true;
    }
};
struct WinOrder {
    StaticOrder S; int full, nlat, G, c;
    __host__ __device__ void init(int G_, int c_, int full_) { full = full_; G = G_; c = c_; S.init(TT, NP, G_, c_, full_ ? 0 : 1); nlat = S.nwg; }
    __host__ __device__ bool next(int i, Unit& u) const {
        if (full) return S.next(i, u);
        const long L = (long)i * G + c;
        if (L < nlat) return S.next(i, u);
        const int q = (int)(L - nlat); if (q >= 24) return false;
        const int t = q % 12; u.pm = q < 12 ? 0 : 33;
        u.pn = t < 2 ? 4 + t : (t < 8 ? 8 + (t - 2) : (t == 8 ? 18 : 20 + (t - 9)));
        return true;
    }
};
struct EpiStoreBf16 {
    static constexpr bool PERM = true;
    bf16_t* O; int ldc;
    __device__ __forceinline__ void operator()(const f32x4 (&acc)[2][2][4][2], const Unit& u, int wr, int wc, int fr, int fq) const {
        const int row0 = u.pm * BM + wr * 64 + fr, col0 = u.pn * BM + wc * 32 + 8 * fq;
#pragma unroll
        for (int ai = 0; ai < 2; ++ai)
#pragma unroll
            for (int m = 0; m < 4; ++m) { bf16_t* rowp = O + (size_t)(row0 + ai * HALF + m * 16) * ldc + col0;
#pragma unroll
                for (int bj = 0; bj < 2; ++bj) { const f32x4 v0 = acc[ai][bj][m][0], v1 = acc[ai][bj][m][1];
                    u32x4 w; w.x = cvt_pk_bf16(v0[0], v0[1]); w.y = cvt_pk_bf16(v0[2], v0[3]); w.z = cvt_pk_bf16(v1[0], v1[1]); w.w = cvt_pk_bf16(v1[2], v1[3]);
                    *(u32x4*)(rowp + bj * HALF) = w; } }
    }
};
struct EpiNull {
    static constexpr bool PERM = true;
    __device__ __forceinline__ void operator()(const f32x4 (&acc)[2][2][4][2], const Unit&, int, int, int, int) const {
#pragma unroll
        for (int a = 0; a < 2; ++a)
#pragma unroll
            for (int b = 0; b < 2; ++b)
#pragma unroll
                for (int m = 0; m < 4; ++m)
#pragma unroll
                    for (int n = 0; n < 2; ++n) asm volatile("" :: "v"(acc[a][b][m][n]));
    }
};
struct EpiStoreBf16S {
    static constexpr bool PERM = true;
    bf16_t* O; int ldc; const float* cs;
    __device__ __forceinline__ void operator()(const f32x4 (&acc)[2][2][4][2], const Unit& u, int wr, int wc, int fr, int fq) const {
        const int row0 = u.pm * BM + wr * 64 + fr, col0 = u.pn * BM + wc * 32 + 8 * fq;
        f32x4 sv[2][2];
#pragma unroll
        for (int bj = 0; bj < 2; ++bj)
#pragma unroll
            for (int n = 0; n < 2; ++n) sv[bj][n] = *(const f32x4*)(cs + col0 + bj * HALF + 4 * n);
#pragma unroll
        for (int ai = 0; ai < 2; ++ai)
#pragma unroll
            for (int m = 0; m < 4; ++m) { bf16_t* rowp = O + (size_t)(row0 + ai * HALF + m * 16) * ldc + col0;
#pragma unroll
                for (int bj = 0; bj < 2; ++bj) { const f32x4 v0 = acc[ai][bj][m][0] * sv[bj][0], v1 = acc[ai][bj][m][1] * sv[bj][1];
                    u32x4 w; w.x = cvt_pk_bf16(v0[0], v0[1]); w.y = cvt_pk_bf16(v0[2], v0[3]); w.z = cvt_pk_bf16(v1[0], v1[1]); w.w = cvt_pk_bf16(v1[2], v1[3]);
                    *(u32x4*)(rowp + bj * HALF) = w; } }
    }
};
template <bool FIRST, bool F8OUT = false> struct EpiGate {
    static constexpr bool PERM = true;
    bf16_t* Y; const bf16_t* Gt; unsigned char* Y8; const float* cs;
    __device__ __forceinline__ void operator()(const f32x4 (&acc)[2][2][4][2], const Unit& u, int wr, int wc, int fr, int fq) const {
        constexpr int ldy = DM, ldg = NP, ldy8 = DM;
        const int row0 = u.pm * BM + wr * 64 + fr, col0 = u.pn * BM + wc * 32 + 8 * fq;
        f32x4 sv[2][2];
#pragma unroll
        for (int bj = 0; bj < 2; ++bj)
#pragma unroll
            for (int n = 0; n < 2; ++n) sv[bj][n] = *(const f32x4*)(cs + col0 + bj * HALF + 4 * n);
#pragma unroll
        for (int ai = 0; ai < 2; ++ai)
#pragma unroll
        for (int mh = 0; mh < 2; ++mh) {
            u32x4 g[2][2], y[2][2];
#pragma unroll
            for (int mm = 0; mm < 2; ++mm)
#pragma unroll
                for (int bj = 0; bj < 2; ++bj) { const size_t r = (size_t)(row0 + ai * HALF + (mh * 2 + mm) * 16);
                    g[mm][bj] = *(const u32x4*)(Gt + r * ldg + col0 + bj * HALF);
                    if (!FIRST) y[mm][bj] = *(const u32x4*)(Y + r * ldy + col0 + bj * HALF); }
#pragma unroll
            for (int mm = 0; mm < 2; ++mm)
#pragma unroll
                for (int bj = 0; bj < 2; ++bj) { const int m = mh * 2 + mm; const size_t r = (size_t)(row0 + ai * HALF + m * 16); const f32x4 v0 = acc[ai][bj][m][0] * sv[bj][0], v1 = acc[ai][bj][m][1] * sv[bj][1]; const u32x4 gg = g[mm][bj];
                    float o[8];
                    o[0] = sigmoidf_(bflo(gg.x)) * v0[0]; o[1] = sigmoidf_(bfhi(gg.x)) * v0[1]; o[2] = sigmoidf_(bflo(gg.y)) * v0[2]; o[3] = sigmoidf_(bfhi(gg.y)) * v0[3];
                    o[4] = sigmoidf_(bflo(gg.z)) * v1[0]; o[5] = sigmoidf_(bfhi(gg.z)) * v1[1]; o[6] = sigmoidf_(bflo(gg.w)) * v1[2]; o[7] = sigmoidf_(bfhi(gg.w)) * v1[3];
                    if (!FIRST) { const u32x4 yy = y[mm][bj];
                        o[0] += bflo(yy.x); o[1] += bfhi(yy.x); o[2] += bflo(yy.y); o[3] += bfhi(yy.y); o[4] += bflo(yy.z); o[5] += bfhi(yy.z); o[6] += bflo(yy.w); o[7] += bfhi(yy.w); }
                    if constexpr (F8OUT) { int p0 = __builtin_amdgcn_cvt_pk_fp8_f32(o[0], o[1], 0, false); p0 = __builtin_amdgcn_cvt_pk_fp8_f32(o[2], o[3], p0, true);
                        int p1 = __builtin_amdgcn_cvt_pk_fp8_f32(o[4], o[5], 0, false); p1 = __builtin_amdgcn_cvt_pk_fp8_f32(o[6], o[7], p1, true);
                        u32x2 w8; w8.x = (unsigned)p0; w8.y = (unsigned)p1; *(u32x2*)(Y8 + r * ldy8 + col0 + bj * HALF) = w8; }
                    else { u32x4 w; w.x = cvt_pk_bf16(o[0], o[1]); w.y = cvt_pk_bf16(o[2], o[3]); w.z = cvt_pk_bf16(o[4], o[5]); w.w = cvt_pk_bf16(o[6], o[7]);
                        *(u32x4*)(Y + r * ldy + col0 + bj * HALF) = w; } }
        }
    }
};
template <bool CS> struct EpiResidT {
    static constexpr bool PERM = false;
    float* X; int ldx; const float* gate; const float* cs;
    __device__ __forceinline__ void operator()(const f32x4 (&acc)[2][2][4][2], const Unit& u, int wr, int wc, int fr, int fq) const {
        const int row0 = u.pm * BM + wr * 64 + fr, col0 = u.pn * BM + wc * 32 + 4 * fq;
        const int sel = (u.pm % 33 == 0) ? 2 : (u.pm / 33);
        const float* gp = gate + (size_t)sel * 12288 + col0;
        f32x4 gv[2][2];
#pragma unroll
        for (int bj = 0; bj < 2; ++bj)
#pragma unroll
            for (int n = 0; n < 2; ++n) { gv[bj][n] = *(const f32x4*)(gp + bj * HALF + n * 16); if constexpr (CS) gv[bj][n] = gv[bj][n] * *(const f32x4*)(cs + col0 + bj * HALF + n * 16); }
#pragma unroll
        for (int ai = 0; ai < 2; ++ai)
#pragma unroll
            for (int mh = 0; mh < 2; ++mh) {
                f32x4 x[2][2][2];
#pragma unroll
                for (int mm = 0; mm < 2; ++mm)
#pragma unroll
                    for (int bj = 0; bj < 2; ++bj)
#pragma unroll
                        for (int n = 0; n < 2; ++n) x[mm][bj][n] = *(const f32x4*)(X + (size_t)(row0 + ai * HALF + (mh * 2 + mm) * 16) * ldx + col0 + bj * HALF + n * 16);
#pragma unroll
                for (int mm = 0; mm < 2; ++mm)
#pragma unroll
                    for (int bj = 0; bj < 2; ++bj)
#pragma unroll
                        for (int n = 0; n < 2; ++n) *(f32x4*)(X + (size_t)(row0 + ai * HALF + (mh * 2 + mm) * 16) * ldx + col0 + bj * HALF + n * 16) = x[mm][bj][n] + gv[bj][n] * acc[ai][bj][mh * 2 + mm][n];
            }
    }
};

typedef int i32x8 __attribute__((ext_vector_type(8)));
typedef int i32x4 __attribute__((ext_vector_type(4)));
__device__ __forceinline__ i32x8 cat8(const bf16x8 lo, const bf16x8 hi) { const i32x4 a = __builtin_bit_cast(i32x4, lo), b = __builtin_bit_cast(i32x4, hi); return __builtin_shufflevector(a, b, 0, 1, 2, 3, 4, 5, 6, 7); }
template <class Epi, class Sched, int F8 = 0>
__device__ __forceinline__ void gemm_phase(LAS unsigned char* lds, const int tid, const Gemm g, const Sched& S, const Epi& E) {
    const int wid = __builtin_amdgcn_readfirstlane(tid >> 6), lane = tid & 63, wr = wid >> 2, wc = wid & 3, fr = lane & 15, fq = lane >> 4;
    const int K = g.K, nt = F8 ? K / 128 : K / BK, lda = g.lda, ldb = g.ldb;
    unsigned voffA[2], voffB[2];
#pragma unroll
    for (int i = 0; i < 2; ++i) { int R, C; stage_rc(tid * 16 + i * 8192, R, C); const int Rb = Epi::PERM ? ((R & ~31) + perm32(R & 31)) : R;
        voffA[i] = F8 ? (unsigned)(R * lda + C * 2) : (unsigned)(R * lda + C) * 2u; voffB[i] = F8 ? (unsigned)(Rb * ldb + C * 2) : (unsigned)(Rb * ldb + C) * 2u; }
    const size_t kstep = (size_t)(BK * 2);
    const size_t hstepA = (size_t)HALF * lda * (F8 ? 1 : 2), hstepB = (size_t)HALF * ldb * (F8 ? 1 : 2);
    const size_t tstepA = 2 * hstepA, tstepB = 2 * hstepB;
    const unsigned ldsw = (unsigned)wid * 1024u;
    const int aoff = F8 ? lds_byte(wr * 64 + fr, (fq & 1) * 16) + (fq >> 1) * 1024 : lds_byte(wr * 64 + fr, fq * 8);
    const int boff = F8 ? lds_byte(wc * 32 + fr, (fq & 1) * 16) + (fq >> 1) * 1024 : lds_byte(wc * 32 + fr, fq * 8);
#define PG8_SA(b, h) (((b) * 2 + (h)) * HTB)
#define PG8_SB(b, h) ((4 + (b) * 2 + (h)) * HTB)
#define PG8_STAGE(bufoff, gbase, voff) do { _Pragma("unroll") for (int _i = 0; _i < 2; ++_i) \
        __builtin_amdgcn_global_load_lds((const unsigned*)((const char*)(gbase) + (voff)[_i]), (LAS unsigned*)(lds + (bufoff) + ldsw + _i * 8192), 16, 0, 0); } while (0)
#define PG8_LDA(dst, b, h) do { if constexpr (F8) { _Pragma("unroll") for (int m = 0; m < 4; ++m) { const LAS unsigned char* p_ = lds + PG8_SA(b, h) + aoff + m * 2048; \
            const i32x4 lo_ = *(const LAS i32x4*)p_, hi_ = *(const LAS i32x4*)(p_ + 16); dst##8[m] = __builtin_shufflevector(lo_, hi_, 0, 1, 2, 3, 4, 5, 6, 7); } } \
        else { _Pragma("unroll") for (int m = 0; m < 4; ++m) _Pragma("unroll") for (int k = 0; k < 2; ++k) dst[m][k] = *(const LAS bf16x8*)(lds + PG8_SA(b, h) + aoff + m * 2048 + k * 1024); } } while (0)
#define PG8_LDB(dst, b, h) do { if constexpr (F8) { _Pragma("unroll") for (int n = 0; n < 2; ++n) { const LAS unsigned char* p_ = lds + PG8_SB(b, h) + boff + n * 2048; \
            const i32x4 lo_ = *(const LAS i32x4*)p_, hi_ = *(const LAS i32x4*)(p_ + 16); dst##8[n] = __builtin_shufflevector(lo_, hi_, 0, 1, 2, 3, 4, 5, 6, 7); } } \
        else { _Pragma("unroll") for (int n = 0; n < 2; ++n) _Pragma("unroll") for (int k = 0; k < 2; ++k) dst[n][k] = *(const LAS bf16x8*)(lds + PG8_SB(b, h) + boff + n * 2048 + k * 1024); } } while (0)
#define PG8_MMA(ai, bj, At, Bt) do { __builtin_amdgcn_s_setprio(1); \
        if constexpr (F8) { _Pragma("unroll") for (int m = 0; m < 4; ++m) _Pragma("unroll") for (int n = 0; n < 2; ++n) \
            asm volatile("v_mfma_scale_f32_16x16x128_f8f6f4 %0, %1, %2, %0, %3, %3 op_sel_hi:[0,0,0]" : "+v"(acc[ai][bj][m][n]) : "v"(Bt##8[n]), "v"(At##8[m]), "v"(mxscale)); } \
        else { _Pragma("unroll") for (int m = 0; m < 4; ++m) _Pragma("unroll") for (int n = 0; n < 2; ++n) _Pragma("unroll") for (int k = 0; k < 2; ++k) \
            acc[ai][bj][m][n] = __builtin_amdgcn_mfma_f32_16x16x32_bf16(Bt[n][k], At[m][k], acc[ai][bj][m][n], 0, 0, 0); } \
        __builtin_amdgcn_s_setprio(0); } while (0)
#define PG8_WAIT_V(n) asm volatile("s_waitcnt vmcnt(" #n ")" ::: "memory")
#define PG8_WAIT_L(n) asm volatile("s_waitcnt lgkmcnt(" #n ")" ::: "memory")
#define PG8_BAR __builtin_amdgcn_s_barrier()
#define PG8_SCHED __builtin_amdgcn_sched_barrier(0)
    Unit cur, nxt; int ui = 0;
    if (!S.next(0, cur)) return;
    f32x4 acc[2][2][4][2];
#pragma unroll
    for (int a = 0; a < 2; ++a)
#pragma unroll
        for (int b = 0; b < 2; ++b)
#pragma unroll
            for (int m = 0; m < 4; ++m)
#pragma unroll
                for (int n = 0; n < 2; ++n) acc[a][b][m][n] = (f32x4){0.f, 0.f, 0.f, 0.f};
    int mxscale = 0x7f7f7f7f; asm volatile("" : "+v"(mxscale));
    bf16x8 At[4][2], B0[2][2], B1[2][2]; i32x8 At8[4], B08[2], B18[2];
    const char* cA = (const char*)g.A + (size_t)cur.pm * tstepA; const char* cB = (const char*)g.Bt + (size_t)cur.pn * tstepB;
    PG8_STAGE(PG8_SB(0, 0), cB, voffB); PG8_STAGE(PG8_SA(0, 0), cA, voffA); PG8_STAGE(PG8_SB(0, 1), cB + hstepB, voffB); PG8_STAGE(PG8_SA(0, 1), cA + hstepA, voffA);
    if (wr == 1) PG8_BAR;
    PG8_WAIT_V(4); PG8_BAR;
    PG8_STAGE(PG8_SB(1, 0), cB + kstep, voffB); PG8_STAGE(PG8_SA(1, 0), cA + kstep, voffA); PG8_STAGE(PG8_SB(1, 1), cB + hstepB + kstep, voffB);
    PG8_WAIT_V(6); PG8_BAR;
    for (;;) {
        const bool has_next = S.next(ui + 1, nxt);
        const char* nA = has_next ? (const char*)g.A + (size_t)nxt.pm * tstepA : cA; const char* nB = has_next ? (const char*)g.Bt + (size_t)nxt.pn * tstepB : cB;
        for (int t = 0; t < nt; t += 2) {
            const bool last = (t == nt - 2);
            const char* a1 = cA + (size_t)(t + 1) * kstep;
            const char* a2 = last ? nA : cA + (size_t)(t + 2) * kstep; const char* b2 = last ? nB : cB + (size_t)(t + 2) * kstep;
            const char* a3 = a2 + kstep; const char* b3 = b2 + kstep;
            PG8_LDB(B0, 0, 0); PG8_SCHED; PG8_LDA(At, 0, 0); PG8_STAGE(PG8_SA(1, 1), a1 + hstepA, voffA);
            PG8_WAIT_L(8); PG8_BAR; PG8_WAIT_L(0); PG8_MMA(0, 0, At, B0); PG8_BAR; PG8_SCHED;
            PG8_LDB(B1, 0, 1); PG8_STAGE(PG8_SB(0, 0), b2, voffB);
            PG8_BAR; PG8_WAIT_L(0); PG8_MMA(0, 1, At, B1); PG8_BAR;
            PG8_LDA(At, 0, 1); PG8_STAGE(PG8_SA(0, 0), a2, voffA);
            PG8_BAR; PG8_WAIT_L(0); PG8_MMA(1, 0, At, B0); PG8_BAR; PG8_SCHED;
            PG8_STAGE(PG8_SB(0, 1), b2 + hstepB, voffB);
            PG8_WAIT_V(6); PG8_BAR; PG8_MMA(1, 1, At, B1); PG8_BAR;
            PG8_LDB(B0, 1, 0); PG8_SCHED; PG8_LDA(At, 1, 0); PG8_STAGE(PG8_SA(0, 1), a2 + hstepA, voffA);
            PG8_WAIT_L(8); PG8_BAR; PG8_WAIT_L(0); PG8_MMA(0, 0, At, B0); PG8_BAR; PG8_SCHED;
            PG8_LDB(B1, 1, 1); PG8_STAGE(PG8_SB(1, 0), b3, voffB);
            PG8_BAR; PG8_WAIT_L(0); PG8_MMA(0, 1, At, B1); PG8_BAR;
            PG8_LDA(At, 1, 1); PG8_STAGE(PG8_SA(1, 0), a3, voffA);
            PG8_BAR; PG8_WAIT_L(0); PG8_MMA(1, 0, At, B0); PG8_BAR; PG8_SCHED;
            PG8_STAGE(PG8_SB(1, 1), b3 + hstepB, voffB);
            PG8_WAIT_V(6); PG8_BAR; PG8_MMA(1, 1, At, B1); PG8_BAR;
        }
        if constexpr (F8) asm volatile("s_nop 15\n\ts_nop 7");
        E(acc, cur, wr, wc, fr, fq);
        if (!has_next) break;
#pragma unroll
        for (int a = 0; a < 2; ++a)
#pragma unroll
            for (int b = 0; b < 2; ++b)
#pragma unroll
                for (int m = 0; m < 4; ++m)
#pragma unroll
                    for (int n = 0; n < 2; ++n) acc[a][b][m][n] = (f32x4){0.f, 0.f, 0.f, 0.f};
        cur = nxt; cA = nA; cB = nB; ++ui;
    }
    PG8_WAIT_V(0);
    if (wr == 0) PG8_BAR;
    PG8_BAR;
#undef PG8_SA
#undef PG8_SB
#undef PG8_STAGE
#undef PG8_LDA
#undef PG8_LDB
#undef PG8_MMA
#undef PG8_WAIT_V
#undef PG8_WAIT_L
#undef PG8_BAR
#undef PG8_SCHED
}
}

struct Args { const float* in[30]; float* out; unsigned char* ws; int ph_lo, ph_hi; };
enum { I_X = 0, I_C, I_CTX, I_CCTX, I_WMOD, I_BMOD, I_N1G, I_WIN, I_QNG, I_KNG, I_WA2F, I_BAF, I_WA2B, I_BAB, I_ONG, I_MQNG, I_WUQ, I_MKVNG, I_WUKV,
       I_WBRA, I_WBRL, I_WBRM, I_WOUT, I_N2G, I_PWQ, I_PK1, I_PK2, I_PU, I_PV, I_FG };
typedef const float* cfp_t;
struct Ctx {
    const __attribute__((address_space(4))) cfp_t* in; float* out; unsigned char* ws; LAS unsigned char* lds;
    int tid, lane, wid, G, bid;
};
#define WSP(T, off) ((T*)(C.ws + (off)))
#define INP(i) ((const float*)(const GLB float*)C.in[(i)])
__device__ __forceinline__ unsigned long long launder_u64(unsigned long long w) {
    unsigned lo = (unsigned)w, hi = (unsigned)(w >> 32); asm volatile("" : "+v"(lo), "+v"(hi));
    lo = __builtin_amdgcn_readfirstlane(lo); hi = __builtin_amdgcn_readfirstlane(hi); return ((unsigned long long)hi << 32) | lo;
}
__device__ __forceinline__ Ctx launder(const Ctx& C0) {
    Ctx R = C0; int t = C0.tid; asm volatile("" : "+v"(t)); R.tid = t; R.lane = t & 63; R.wid = __builtin_amdgcn_readfirstlane(t >> 6);
    R.ws = (unsigned char*)(GLB unsigned char*)launder_u64((unsigned long long)C0.ws);
    R.out = (float*)(GLB float*)(unsigned long long)C0.out;
    R.in = (const __attribute__((address_space(4))) cfp_t*)launder_u64((unsigned long long)C0.in);
    unsigned l = (unsigned)(uintptr_t)C0.lds; asm volatile("" : "+v"(l)); l = __builtin_amdgcn_readfirstlane(l); R.lds = (LAS unsigned char*)(uintptr_t)l;
    return R;
}

__device__ __forceinline__ const float* src_row(const Ctx& C, int r) {
    const int b = r / RPB, j = r % RPB;
    return j < CTXL ? INP(I_CTX) + ((size_t)b * CTXL + j) * DM : INP(I_X) + ((size_t)b * SEQ + (j - CTXL)) * DM;
}
__device__ __forceinline__ int mod_sel(int r) { const int b = r / RPB, j = r % RPB; return j < CTXL ? 2 : b; }

__device__ __forceinline__ void phase_modv(const Ctx& C) {
    LAS float* sc = (LAS float*)C.lds;
    LAS float* red = (LAS float*)(C.lds + 3 * 2048 * 4);
    for (int i = C.tid; i < 3 * DM; i += NTHREADS) { const int r = i / DM, k = i % DM; const float v = r < 2 ? INP(I_C)[r * DM + k] : INP(I_CCTX)[k]; sc[i] = siluf_(v); }
    __syncthreads();
    float* modv = WSP(float, WS_MODV);
    const int kq = C.tid / 12, c4 = C.tid % 12;
    for (int item = C.bid; item < 2 * 256; item += C.G) {
        const int l = item / 256, cg = item % 256;
        float acc[3][4];
#pragma unroll
        for (int r = 0; r < 3; ++r)
#pragma unroll
            for (int j = 0; j < 4; ++j) acc[r][j] = 0.f;
        if (kq < 42) {
            const float* wp = INP(I_WMOD) + (size_t)l * DM * 12288 + 48 * cg + 4 * c4;
#pragma unroll 1
            for (int k0 = kq; k0 < DM; k0 += 42 * 7) {
                f32x4 w[7];
#pragma unroll
                for (int u = 0; u < 7; ++u) { const int k = k0 + 42 * u; w[u] = k < DM ? *(const f32x4*)(wp + (size_t)k * 12288) : (f32x4){0.f, 0.f, 0.f, 0.f}; }
#pragma unroll
                for (int u = 0; u < 7; ++u) { const int k = k0 + 42 * u; if (k < DM) {
#pragma unroll
                    for (int r = 0; r < 3; ++r) { const float sv = sc[r * DM + k];
#pragma unroll
                        for (int j = 0; j < 4; ++j) acc[r][j] += sv * w[u][j]; } } }
            }
#pragma unroll
            for (int r = 0; r < 3; ++r)
#pragma unroll
                for (int j = 0; j < 4; ++j) red[kq * 144 + r * 48 + c4 * 4 + j] = acc[r][j];
        }
        __syncthreads();
        if (C.tid < 144) { float s = 0.f; for (int q = 0; q < 42; ++q) s += red[q * 144 + C.tid];
            const int r = C.tid / 48, cc = C.tid % 48;
            modv[((size_t)l * 3 + r) * 12288 + 48 * cg + cc] = s + INP(I_BMOD)[(size_t)l * 12288 + 48 * cg + cc]; }
        __syncthreads();
    }
}
__device__ __forceinline__ void phase_tables(const Ctx& C) {
    float* ta = WSP(float, WS_TABA); float* tm = WSP(float, WS_TABM);
    for (int i = C.bid * NTHREADS + C.tid; i < 128 * 32 + 128 * 16; i += C.G * NTHREADS) {
        if (i < 128 * 32) { const int pos = i / 32, f = i % 32; const float inv = exp2f(-(float)f * (13.287712379549449f / 32.0f)); const float a = (float)pos * inv;
            ta[i] = cosf(a); ta[128 * 32 + i] = sinf(a); }
        else { const int k = i - 128 * 32, pos = k / 16, f = k % 16; const float inv = exp2f(-(float)f * (13.287712379549449f / 16.0f)); const float a = (float)pos * inv;
            tm[k] = cosf(a); tm[128 * 16 + k] = sinf(a); }
    }
}
__device__ __forceinline__ void transpose_cvt(const Ctx& C, const float* src, int K, int N, bf16_t* dst, int Npad, int& item) {
    LAS float* tile = (LAS float*)C.lds;
    const int tk = K / 64, tn = Npad / 256, ntile = tk * tn;
    const int t0 = ((C.bid - item % C.G) + C.G) % C.G; item += ntile;
    for (int t = t0; t < ntile; t += C.G) {
        const int k0 = (t / tn) * 64, n0 = (t % tn) * 256;
        const int nn = (C.tid & 63) * 4, kr = C.tid >> 6;
        f32x4 v[8];
#pragma unroll
        for (int p = 0; p < 8; ++p) { v[p] = (f32x4){0.f, 0.f, 0.f, 0.f}; if (n0 + nn < N) v[p] = *(const f32x4*)(src + (size_t)(k0 + kr + p * 8) * N + n0 + nn); }
#pragma unroll
        for (int p = 0; p < 8; ++p)
#pragma unroll
            for (int j = 0; j < 4; ++j) tile[(kr + p * 8) * 257 + nn + j] = v[p][j];
        __syncthreads();
        { const int n = C.tid >> 1, kh = (C.tid & 1) * 32;
#pragma unroll
          for (int q = 0; q < 4; ++q) { float x[8];
#pragma unroll
              for (int j = 0; j < 8; ++j) x[j] = tile[(kh + q * 8 + j) * 257 + n];
              u32x4 w; w.x = cvt_pk_bf16(x[0], x[1]); w.y = cvt_pk_bf16(x[2], x[3]); w.z = cvt_pk_bf16(x[4], x[5]); w.w = cvt_pk_bf16(x[6], x[7]);
              *(u32x4*)(dst + (size_t)(n0 + n) * K + k0 + kh + q * 8) = w; } }
        __syncthreads();
    }
}
__device__ __forceinline__ void transpose_cvt_fp8(const Ctx& C, const float* src, int K, int N, unsigned char* dst, int Npad, float* cinv, const float cmul = 1.0f) {
    LAS float* tile = (LAS float*)C.lds;
    LAS float* red = (LAS float*)(C.lds + 64 * 65 * 4);
    LAS float* scl = red + 32 * 64;
    const int kk = C.tid >> 4, nn = (C.tid & 15) * 4;
    for (int cgp = C.bid; cgp < Npad / 64; cgp += C.G) {
        const int n0 = cgp * 64; const bool live = n0 + nn < N;
        float am[4] = {0.f, 0.f, 0.f, 0.f};
        for (int k0 = 0; k0 < K; k0 += 128) {
            f32x4 v[4];
#pragma unroll
            for (int p = 0; p < 4; ++p) v[p] = live ? *(const f32x4*)(src + (size_t)(k0 + kk + p * 32) * N + n0 + nn) : (f32x4){0.f, 0.f, 0.f, 0.f};
#pragma unroll
            for (int p = 0; p < 4; ++p)
#pragma unroll
                for (int j = 0; j < 4; ++j) am[j] = fmaxf(am[j], fabsf(v[p][j])); }
#pragma unroll
        for (int j = 0; j < 4; ++j) red[kk * 64 + nn + j] = am[j];
        __syncthreads();
        if (C.tid < 64) { float m = 0.f; for (int q = 0; q < 32; ++q) m = fmaxf(m, red[q * 64 + C.tid]);
            scl[C.tid] = m > 0.f ? 224.0f / m : 1.0f; cinv[n0 + C.tid] = (m > 0.f ? m * (1.0f / 224.0f) : 1.0f) * cmul; }
        __syncthreads();
        for (int k0 = 0; k0 < K; k0 += 64) {
#pragma unroll
            for (int p = 0; p < 2; ++p) { const f32x4 v = live ? *(const f32x4*)(src + (size_t)(k0 + kk + p * 32) * N + n0 + nn) : (f32x4){0.f, 0.f, 0.f, 0.f};
#pragma unroll
                for (int j = 0; j < 4; ++j) tile[(kk + p * 32) * 65 + nn + j] = v[j]; }
            __syncthreads();
            { const int n = C.tid >> 3, k8 = (C.tid & 7) * 8; const float sc = scl[n]; float x[8];
#pragma unroll
              for (int j = 0; j < 8; ++j) x[j] = tile[(k8 + j) * 65 + n] * sc;
              int p0 = __builtin_amdgcn_cvt_pk_fp8_f32(x[0], x[1], 0, false); p0 = __builtin_amdgcn_cvt_pk_fp8_f32(x[2], x[3], p0, true);
              int p1 = __builtin_amdgcn_cvt_pk_fp8_f32(x[4], x[5], 0, false); p1 = __builtin_amdgcn_cvt_pk_fp8_f32(x[6], x[7], p1, true);
              u32x2 w; w.x = (unsigned)p0; w.y = (unsigned)p1; *(u32x2*)(dst + (size_t)(n0 + n) * K + k0 + k8) = w; }
            __syncthreads();
        }
    }
}
__device__ __forceinline__ void cvt_plain(const Ctx& C, const float* src, bf16_t* dst, size_t n8) {
    for (size_t i = (size_t)C.bid * NTHREADS + C.tid; i < n8; i += (size_t)C.G * NTHREADS) {
        const f32x4 a = *(const f32x4*)(src + i * 8), b = *(const f32x4*)(src + i * 8 + 4);
        u32x4 w; w.x = cvt_pk_bf16(a[0], a[1]); w.y = cvt_pk_bf16(a[2], a[3]); w.z = cvt_pk_bf16(b[0], b[1]); w.w = cvt_pk_bf16(b[2], b[3]);
        *(u32x4*)(dst + i * 8) = w;
    }
}
__device__ __forceinline__ void phase_cvt_mixer_weights(const Ctx& C, int l) {
    int item = 0;
    transpose_cvt_fp8(C, INP(I_WIN) + (size_t)l * DM * IN_COLS, DM, IN_COLS, C.ws + WS_WIN, NP, WSP(float, WS_WINS));
    __syncthreads();
    transpose_cvt(C, INP(I_WUQ) + (size_t)l * 512 * 1536, 512, 1536, WSP(bf16_t, WS_WUQ), 1536, item);
    transpose_cvt(C, INP(I_WUKV) + (size_t)l * 512 * 2048, 512, 2048, WSP(bf16_t, WS_WUKV), 2048, item);
    transpose_cvt_fp8(C, INP(I_WBRA) + (size_t)l * 1024 * 2048, 1024, 2048, C.ws + WS_WBR, 2048, WSP(float, WS_WBRS), 1.0f / 32.0f); __syncthreads();
    transpose_cvt_fp8(C, INP(I_WBRL) + (size_t)l * 1024 * 2048, 1024, 2048, C.ws + WS_WBR + (size_t)2048 * 1024, 2048, WSP(float, WS_WBRS) + DM, 1.0f); __syncthreads();
    transpose_cvt_fp8(C, INP(I_WBRM) + (size_t)l * 1024 * 2048, 1024, 2048, C.ws + WS_WBR + (size_t)2 * 2048 * 1024, 2048, WSP(float, WS_WBRS) + 2 * DM, 1.0f / 32.0f); __syncthreads();
    transpose_cvt_fp8(C, INP(I_WOUT) + (size_t)l * 2048 * 2048, 2048, 2048, C.ws + WS_WOUT, 2048, WSP(float, WS_WOUTS));
    __syncthreads();
    transpose_cvt(C, INP(I_PWQ) + (size_t)l * 2048 * 2048, 2048, 2048, WSP(bf16_t, WS_WQ), 2048, item);
    cvt_plain(C, INP(I_PK1) + (size_t)l * 8 * 128 * 128, WSP(bf16_t, WS_K1), 8 * 128 * 128 / 8);
    cvt_plain(C, INP(I_PK2) + (size_t)l * 8 * 128 * 128, WSP(bf16_t, WS_K2), 8 * 128 * 128 / 8);
}
__device__ __forceinline__ void phase_cvt_peer_tables(const Ctx& C, int l, int row_lo, int row_hi, int wg_lo) {
    const int lane = C.lane; if (C.bid < wg_lo) return;
    unsigned char* pt = C.ws + WS_PT + (size_t)l * PT_BYTES;
    for (int row = row_lo + (C.bid - wg_lo) * 8 + C.wid; row < row_hi; row += (C.G - wg_lo) * 8) {
#pragma unroll 1
        for (int tb = 0; tb < 2; ++tb) {
            const float* src = (tb ? INP(I_PV) : INP(I_PU)) + ((size_t)l * NEXP + row) * DM + lane * 16;
            f32x4 x[8]; float amax = 0.f;
#pragma unroll
            for (int c = 0; c < 2; ++c)
#pragma unroll
                for (int q = 0; q < 4; ++q) { x[c * 4 + q] = *(const f32x4*)(src + c * 1024 + q * 4);
                    amax = fmaxf(amax, fmaxf(fmaxf(fabsf(x[c * 4 + q][0]), fabsf(x[c * 4 + q][1])), fmaxf(fabsf(x[c * 4 + q][2]), fabsf(x[c * 4 + q][3])))); }
            amax = fmaxf(amax, xchg32(amax, lane)); amax = fmaxf(amax, xchg16(amax, lane)); amax = fmaxf(amax, dppmov<DPP_ROR8>(amax));
            amax = fmaxf(amax, dppmov<DPP_HMIRROR>(amax)); amax = fmaxf(amax, dppmov<DPP_Q3210>(amax)); amax = fmaxf(amax, dppmov<DPP_Q1032>(amax));
            const float sc = amax > 0.f ? 224.0f / amax : 1.0f, inv = amax > 0.f ? amax * (1.0f / 224.0f) : 1.0f;
            unsigned char* dst = pt + (tb ? PT_V8 : PT_U8) + (size_t)(lane >> 3) * ((size_t)NEXP * 128) + (size_t)row * 128 + (lane & 7) * 16;
#pragma unroll
            for (int c = 0; c < 2; ++c) { u32x4 w;
#pragma unroll
                for (int q = 0; q < 4; ++q) { const f32x4 v = x[c * 4 + q] * sc; int p = __builtin_amdgcn_cvt_pk_fp8_f32(v[0], v[1], 0, false); p = __builtin_amdgcn_cvt_pk_fp8_f32(v[2], v[3], p, true); w[q] = (unsigned)p; }
                *(u32x4*)(dst + (size_t)c * 8 * ((size_t)NEXP * 128)) = w; }
            if (lane == 0) ((float*)(pt + (tb ? PT_SCV : PT_SCU)))[row] = inv;
        }
    }
}

template <bool FIRST, bool F8OUT = false> __device__ __forceinline__ void phase_norm_mod(const Ctx& C, const float* gvec, const float* modl  , int shift_off, int scale_off) {
    float* xs = WSP(float, WS_XS); bf16_t* hb = WSP(bf16_t, WS_HB);
    for (int r = C.bid * 8 + C.wid; r < TT; r += C.G * 8) {
        const float* xr = FIRST ? src_row(C, r) : xs + (size_t)r * DM;
        const float* mv = modl + (size_t)mod_sel(r) * 12288;
        f32x4 v[8]; float ss = 0.f;
#pragma unroll
        for (int c = 0; c < 4; ++c) { v[2 * c] = *(const f32x4*)(xr + c * 512 + C.lane * 8); v[2 * c + 1] = *(const f32x4*)(xr + c * 512 + C.lane * 8 + 4); }
#pragma unroll
        for (int c = 0; c < 8; ++c) ss += v[c][0] * v[c][0] + v[c][1] * v[c][1] + v[c][2] * v[c][2] + v[c][3] * v[c][3];
        ss = wave_sum(ss);
        const float rs = rsqrtf(ss * (1.0f / DM) + NORM_EPS);
#pragma unroll
        for (int c = 0; c < 4; ++c) { const int col = c * 512 + C.lane * 8;
            if (FIRST) { *(f32x4*)(xs + (size_t)r * DM + col) = v[2 * c]; *(f32x4*)(xs + (size_t)r * DM + col + 4) = v[2 * c + 1]; }
            float o[8];
#pragma unroll
            for (int h = 0; h < 2; ++h) { const f32x4 g = *(const f32x4*)(gvec + col + 4 * h), s = *(const f32x4*)(mv + scale_off + col + 4 * h), t = *(const f32x4*)(mv + shift_off + col + 4 * h);
#pragma unroll
                for (int j = 0; j < 4; ++j) o[4 * h + j] = v[2 * c + h][j] * rs * g[j] * (1.0f + s[j]) + t[j]; }
            if constexpr (F8OUT) {
                int p0 = __builtin_amdgcn_cvt_pk_fp8_f32(o[0], o[1], 0, false); p0 = __builtin_amdgcn_cvt_pk_fp8_f32(o[2], o[3], p0, true);
                int p1 = __builtin_amdgcn_cvt_pk_fp8_f32(o[4], o[5], 0, false); p1 = __builtin_amdgcn_cvt_pk_fp8_f32(o[6], o[7], p1, true);
                u32x2 w; w.x = (unsigned)p0; w.y = (unsigned)p1; *(u32x2*)((unsigned char*)hb + (size_t)r * DM + col) = w;
            } else {
            u32x4 w; w.x = cvt_pk_bf16(o[0], o[1]); w.y = cvt_pk_bf16(o[2], o[3]); w.z = cvt_pk_bf16(o[4], o[5]); w.w = cvt_pk_bf16(o[6], o[7]);
            *(u32x4*)(hb + (size_t)r * DM + col) = w; } }
    }
}

__device__ __forceinline__ void phase_post_p(const Ctx& C, int l) {
    bf16_t* P = WSP(bf16_t, WS_P); const float* ta = WSP(float, WS_TABA); const float* tm = WSP(float, WS_TABM);
    const float* qg = INP(I_QNG) + l * 128; const float* kg = INP(I_KNG) + l * 128;
    const float* mqg = INP(I_MQNG) + l * 512; const float* mkvg = INP(I_MKVNG) + l * 512;
    const int lane = C.lane;
    const float qg1 = qg[lane], qg2 = qg[lane + 64], kg1 = kg[lane], kg2 = kg[lane + 64];
    for (int r = C.bid * 8 + C.wid; r < TT; r += C.G * 8) {
        bf16_t* pr = P + (size_t)r * NP;
        const int j = r % RPB; const bool lat = j >= CTXL; const int pos = lat ? j - CTXL : 0, ri = pos >> 6, ci = pos & 63;
        float cs = 1.f, sn = 0.f;
        if (lat) { const int p = lane < 32 ? ri : ci, f = lane & 31; cs = ta[p * 32 + f]; sn = ta[128 * 32 + p * 32 + f]; }
#pragma unroll
        for (int h = 0; h < 10; ++h) {
            bf16_t* hp = pr + (h < 8 ? C_AQ + h * 128 : C_AK + (h - 8) * 128);
            const float x1 = bf2f(hp[lane]), x2 = bf2f(hp[lane + 64]);
            const float ss = wave_sum(x1 * x1 + x2 * x2);
            const float rs = rsqrtf(ss * (1.0f / 128.0f) + NORM_EPS);
            const float y1 = x1 * rs * (h < 8 ? qg1 : kg1), y2 = x2 * rs * (h < 8 ? qg2 : kg2);
            hp[lane] = f2bf(y1 * cs - y2 * sn); hp[lane + 64] = f2bf(y2 * cs + y1 * sn);
        }
#pragma unroll
        for (int s = 0; s < 2; ++s) {
            bf16_t* sp = pr + (s == 0 ? C_MCQ : C_MCKV) + lane * 8; const float* gg = (s == 0 ? mqg : mkvg) + lane * 8;
            const u32x4 w = *(const u32x4*)sp; float x[8] = {bflo(w.x), bfhi(w.x), bflo(w.y), bfhi(w.y), bflo(w.z), bfhi(w.z), bflo(w.w), bfhi(w.w)};
            float ss = 0.f;
#pragma unroll
            for (int i = 0; i < 8; ++i) ss += x[i] * x[i];
            ss = wave_sum(ss);
            const float rs = rsqrtf(ss * (1.0f / 512.0f) + NORM_EPS);
#pragma unroll
            for (int i = 0; i < 8; ++i) x[i] = x[i] * rs * gg[i];
            u32x4 o; o.x = cvt_pk_bf16(x[0], x[1]); o.y = cvt_pk_bf16(x[2], x[3]); o.z = cvt_pk_bf16(x[4], x[5]); o.w = cvt_pk_bf16(x[6], x[7]);
            *(u32x4*)sp = o;
        }
        if (lat) { bf16_t* kp = pr + C_MKR; const int i = lane & 31; const float x1 = bf2f(kp[i]), x2 = bf2f(kp[i + 32]);
            const int p = i < 16 ? ri : ci, f = i & 15; const float c2 = tm[p * 16 + f], s2 = tm[128 * 16 + p * 16 + f];
            if (lane < 32) { kp[i] = f2bf(x1 * c2 - x2 * s2); kp[i + 32] = f2bf(x2 * c2 + x1 * s2); } }
    }
}

namespace att {
constexpr int NW = 8, QBLK = 32, KVBLK = 64, DV = 128;
constexpr float THR = 8.f;
#define SBAR() __builtin_amdgcn_sched_barrier(0)
__device__ __forceinline__ int crow(int r, int hi) { return (r & 3) + 8 * (r >> 2) + 4 * hi; }
template <int DQ> struct Cf {
    static constexpr int ND0 = DQ / 16, KROWB = DQ * 2, SHM_K = KVBLK * DQ * 2, SHM_V = KVBLK * DV * 2, SHM = 2 * SHM_V + 2 * SHM_K + NW * 64 * 4;
    static constexpr float SCALE = DQ == 128 ? 0.088388347648318440f : 0.072168783648703220f;
    __device__ static __forceinline__ int kswz(int row, int colB) { return row * KROWB + (colB ^ ((row & 7) << 4)); }
};
template <int DQ, int VAR = 0> __device__ __forceinline__ void partialSM(f32x16& p0, f32x16& p1, float& m_reg, float& mn, float& alpha) {
    constexpr float SC = Cf<DQ>::SCALE, Cc = SC * 1.4426950408889634f;
    float pmax = p0[0];
#pragma unroll
    for (int r = 1; r < 16; ++r) pmax = fmaxf(pmax, p0[r]);
#pragma unroll
    for (int r = 0; r < 16; ++r) pmax = fmaxf(pmax, p1[r]);
    { auto rr = __builtin_amdgcn_permlane32_swap(__float_as_uint(pmax), __float_as_uint(pmax), false, false);
      pmax = fmaxf(__uint_as_float(rr[0]), __uint_as_float(rr[1])); }
    if (__builtin_expect(__all(pmax - m_reg <= THR / SC), 1)) { mn = m_reg; alpha = 1.f; }
    else { mn = fmaxf(m_reg, pmax); alpha = __builtin_amdgcn_exp2f((m_reg - mn) * Cc); m_reg = mn; }
    const float mnC = -mn * Cc;
#pragma unroll
    for (int r = 0; r < 16; ++r) p0[r] = fmaf(p0[r], Cc, mnC);
#pragma unroll
    for (int r = 0; r < 16; ++r) p1[r] = fmaf(p1[r], Cc, mnC);
#pragma unroll
    for (int r = 0; r < 16; ++r) p0[r] = VAR == 1 ? p0[r] * 0.001f : __builtin_amdgcn_exp2f(p0[r]);
}
template <int VAR = 0> __device__ __forceinline__ void finishSM(f32x16& p0, f32x16& p1, float alpha, float& l_reg, bf16x8& pa0, bf16x8& pa1, bf16x8& pa2, bf16x8& pa3) {
#pragma unroll
    for (int r = 0; r < 16; ++r) p1[r] = VAR == 1 ? p1[r] * 0.001f : __builtin_amdgcn_exp2f(p1[r]);
    float ps = 0;
#pragma unroll
    for (int r = 0; r < 16; ++r) ps += p0[r];
#pragma unroll
    for (int r = 0; r < 16; ++r) ps += p1[r];
    { auto rr = __builtin_amdgcn_permlane32_swap(__float_as_uint(ps), __float_as_uint(ps), false, false);
      ps = __uint_as_float(rr[0]) + __uint_as_float(rr[1]); }
    l_reg = l_reg * alpha + ps;
#define PK4(P, BASE, OUT) do { unsigned a0 = cvt_pk_bf16(P[BASE + 0], P[BASE + 1]), a1 = cvt_pk_bf16(P[BASE + 2], P[BASE + 3]);   \
    unsigned b0 = cvt_pk_bf16(P[BASE + 4], P[BASE + 5]), b1 = cvt_pk_bf16(P[BASE + 6], P[BASE + 7]);                              \
    auto r0 = __builtin_amdgcn_permlane32_swap(a0, b0, false, false); auto r1 = __builtin_amdgcn_permlane32_swap(a1, b1, false, false); \
    u32x4 w = {r0[0], r1[0], r0[1], r1[1]}; OUT = *reinterpret_cast<bf16x8*>(&w); } while (0)
    PK4(p0, 0, pa0); PK4(p0, 8, pa1); PK4(p1, 0, pa2); PK4(p1, 8, pa3);
#undef PK4
}
template <int DQ> __device__ __forceinline__ void qkt(f32x16& p0, f32x16& p1, const char* Ks, const bf16x8* qr, const char* qx, int r32, int hi) {
    p0 = f32x16{}; p1 = f32x16{};
#pragma unroll
    for (int d0 = 0; d0 < Cf<DQ>::ND0; ++d0) { const int cb = (d0 * 16 + hi * 8) * 2;
        const bf16x8 b0 = *reinterpret_cast<const bf16x8*>(Ks + Cf<DQ>::kswz(r32, cb));
        const bf16x8 b1 = *reinterpret_cast<const bf16x8*>(Ks + Cf<DQ>::kswz(32 + r32, cb));
        constexpr int NQR = DQ == 192 ? MLA_NQR : 8;
        bf16x8 q; if (d0 < NQR) q = qr[d0]; else q = *reinterpret_cast<const bf16x8*>(qx + (d0 - NQR) * 1024);
        p0 = __builtin_amdgcn_mfma_f32_32x32x16_bf16(b0, q, p0, 0, 0, 0);
        p1 = __builtin_amdgcn_mfma_f32_32x32x16_bf16(b1, q, p1, 0, 0, 0); }
}
__device__ __forceinline__ int v_st(int k, int c) { const int kk = (k & ~0xC) | ((k & 4) << 1) | ((k & 8) >> 1); return ((kk >> 3) * 4 + (c >> 5)) * 512 + ((kk & 7) * 32 + (c & 31)) * 2; }
__device__ __forceinline__ int v_rd_base(int lane) { return ((lane & 3) << 3) | (((lane >> 2) & 3) << 6) | (((lane >> 4) & 1) << 5) | (((lane >> 5) & 1) << 8); }
constexpr int v_rd_off(int d0, int ks, int half) { return d0 * 512 + ks * 4096 + half * 2048; }
template <int OFF> __device__ __forceinline__ s16x4 tr_read(int vb) {
    s16x4 r; asm volatile("ds_read_b64_tr_b16 %0, %1 offset:%2" : "=&v"(r) : "v"(vb), "i"(OFF) : "memory"); return r;
}
template <int D0> __device__ __forceinline__ void pv_one(f32x16& od, int vb, bf16x8 pa0, bf16x8 pa1, bf16x8 pa2, bf16x8 pa3) {
    const s16x4 l0 = tr_read<v_rd_off(D0, 0, 0)>(vb), h0 = tr_read<v_rd_off(D0, 0, 1)>(vb), l1 = tr_read<v_rd_off(D0, 1, 0)>(vb), h1 = tr_read<v_rd_off(D0, 1, 1)>(vb);
    const s16x4 l2 = tr_read<v_rd_off(D0, 2, 0)>(vb), h2 = tr_read<v_rd_off(D0, 2, 1)>(vb), l3 = tr_read<v_rd_off(D0, 3, 0)>(vb), h3 = tr_read<v_rd_off(D0, 3, 1)>(vb);
    asm volatile("s_waitcnt lgkmcnt(0)" ::: "memory"); SBAR();
#define PK(L, H) (bf16x8){L[0], L[1], L[2], L[3], H[0], H[1], H[2], H[3]}
    od = __builtin_amdgcn_mfma_f32_32x32x16_bf16(pa0, PK(l0, h0), od, 0, 0, 0);
    od = __builtin_amdgcn_mfma_f32_32x32x16_bf16(pa1, PK(l1, h1), od, 0, 0, 0);
    od = __builtin_amdgcn_mfma_f32_32x32x16_bf16(pa2, PK(l2, h2), od, 0, 0, 0);
    od = __builtin_amdgcn_mfma_f32_32x32x16_bf16(pa3, PK(l3, h3), od, 0, 0, 0);
#undef PK
}
__device__ __forceinline__ void pv_d0(f32x16* o, int vb, bf16x8 pa0, bf16x8 pa1, bf16x8 pa2, bf16x8 pa3) {
    pv_one<0>(o[0], vb, pa0, pa1, pa2, pa3); pv_one<1>(o[1], vb, pa0, pa1, pa2, pa3); pv_one<2>(o[2], vb, pa0, pa1, pa2, pa3); pv_one<3>(o[3], vb, pa0, pa1, pa2, pa3);
}
__device__ __forceinline__ bf16x8 ld8(const bf16_t* p) { return *reinterpret_cast<const bf16x8*>(p); }

template <int DQ, int SD, int VAR = 0>
__device__ __forceinline__ void attn_body(const bf16_t* __restrict__ Qb, int ldq, const bf16_t* __restrict__ Kn, int ldkn, const bf16_t* __restrict__ Kr, int ldkr,
                                          const bf16_t* __restrict__ Vh, int ldv, unsigned char* __restrict__ Ob, int ldo, int seq, bool rope_q, int pos0, const float* __restrict__ tabM, char* lds, const int tid) {
    using CF = Cf<DQ>; constexpr int ND0 = CF::ND0, SHM_V = CF::SHM_V, SHM_K = CF::SHM_K;
    const int wid = tid >> 6, lane = tid & 63, r32 = lane & 31, hi = lane >> 5;
    char* V_lds = lds; char* K_lds = lds + 2 * SHM_V;
    float* ws = (float*)(lds + 2 * SHM_V + 2 * SHM_K) + wid * 64; float* li_l = ws; float* al_l = ws + 32;
    constexpr int NQR = DQ == 192 ? MLA_NQR : 8;
    float m_reg = -1e30f, l_reg = 0; f32x16 o[4] = {}; bf16x8 qr[NQR];
    const bf16_t* Qw = Qb + (long)(wid * QBLK + r32) * ldq + hi * 8;
#pragma unroll
    for (int d0 = 0; d0 < NQR; ++d0) qr[d0] = ld8(Qw + d0 * 16);
    char* qx = lds + CF::SHM + wid * 8192 + lane * 16;
    if constexpr (DQ == 192) {
#pragma unroll
        for (int d0 = NQR; d0 < 8; ++d0) *(bf16x8*)(qx + (d0 - NQR) * 1024) = ld8(Qw + d0 * 16);
        bf16x8 qe[4];
#pragma unroll
        for (int d0 = 0; d0 < 4; ++d0) qe[d0] = ld8(Qw + (8 + d0) * 16);
        if (rope_q) {
            const int pos = pos0 + wid * QBLK + r32, ri = pos >> 6, ci = pos & 63;
#pragma unroll
            for (int t = 0; t < 2; ++t) { const int p = t == 0 ? ri : ci; const float* tc = tabM + p * 16 + hi * 8; const float* tsn = tabM + 128 * 16 + p * 16 + hi * 8;
                bf16x8 a = qe[t], b = qe[2 + t];
#pragma unroll
                for (int jj = 0; jj < 8; ++jj) { const float x1 = bf2f((bf16_t)a[jj]), x2 = bf2f((bf16_t)b[jj]), c = tc[jj], s = tsn[jj];
                    a[jj] = (short)f2bf(x1 * c - x2 * s); b[jj] = (short)f2bf(x2 * c + x1 * s); }
                qe[t] = a; qe[2 + t] = b; }
        }
#pragma unroll
        for (int d0 = 0; d0 < 4; ++d0) *(bf16x8*)(qx + (8 - NQR + d0) * 1024) = qe[d0];
    }
    const int sr = tid >> 4, sc = (tid & 15) * 8, vst0 = v_st(sr, sc), vst1 = v_st(32 + sr, sc);
    const int sr2 = tid >> 3, sc2 = (tid & 7) * 8;
    const int vb0 = (int)(uintptr_t)V_lds + v_rd_base(lane);
    struct { bf16x8 vs0, vs1, ks0, ks1, ks2; } sr_[SD];
    const unsigned offV = (unsigned)(sr * ldv + sc) * 2u, offK = (unsigned)(sr * ldkn + sc) * 2u, offR = (unsigned)(sr2 * ldkr + sc2) * 2u;
#define SLOAD(i, k0) do { const char* vt_ = (const char*)Vh + (size_t)(k0) * ldv * 2; const char* kt_ = (const char*)Kn + (size_t)(k0) * ldkn * 2; \
    sr_[i].vs0 = *(const bf16x8*)(vt_ + offV); sr_[i].vs1 = *(const bf16x8*)(vt_ + (size_t)32 * ldv * 2 + offV); \
    sr_[i].ks0 = *(const bf16x8*)(kt_ + offK); sr_[i].ks1 = *(const bf16x8*)(kt_ + (size_t)32 * ldkn * 2 + offK); \
    if constexpr (DQ == 192) sr_[i].ks2 = *(const bf16x8*)((const char*)Kr + (size_t)(k0) * ldkr * 2 + offR); } while (0)
#define SWRITE(b, i) do { *(bf16x8*)(V_lds + (b) * SHM_V + vst0) = sr_[i].vs0; *(bf16x8*)(V_lds + (b) * SHM_V + vst1) = sr_[i].vs1; const int kc = sc * 2; \
    *(bf16x8*)(K_lds + (b) * SHM_K + CF::kswz(sr, kc)) = sr_[i].ks0; *(bf16x8*)(K_lds + (b) * SHM_K + CF::kswz(32 + sr, kc)) = sr_[i].ks1; \
    if constexpr (DQ == 192) *(bf16x8*)(K_lds + (b) * SHM_K + CF::kswz(sr2, 256 + sc2 * 2)) = sr_[i].ks2; } while (0)
#define SWAIT() do { if constexpr (SD == 1) asm volatile("s_waitcnt vmcnt(0)" ::: "memory"); else if constexpr (DQ == 192) asm volatile("s_waitcnt vmcnt(5)" ::: "memory"); else asm volatile("s_waitcnt vmcnt(4)" ::: "memory"); } while (0)
#define RESC(a) do { if (__any((a) < 1.f)) { if (hi == 0) al_l[r32] = (a); asm volatile("s_waitcnt lgkmcnt(0)" ::: "memory"); \
    _Pragma("unroll") for (int d = 0; d < 4; ++d) _Pragma("unroll") for (int r = 0; r < 16; ++r) o[d][r] *= al_l[crow(r, hi)]; } } while (0)
    f32x16 pA0, pA1, pB0, pB1; float mnA, mnB, alA, alB; bf16x8 pa0, pa1, pa2, pa3; const int NT = seq / KVBLK;
    constexpr int SE = 0, SO = SD - 1;
    SLOAD(SE, 0); asm volatile("s_waitcnt vmcnt(0)" ::: "memory"); SWRITE(0, SE); __syncthreads();
    qkt<DQ>(pA0, pA1, K_lds, qr, qx, r32, hi); partialSM<DQ, VAR>(pA0, pA1, m_reg, mnA, alA);
    SLOAD(SO, KVBLK); if constexpr (SD == 2) { if (2 < NT) SLOAD(SE, 2 * KVBLK); }
    SWAIT(); SWRITE(1, SO); __syncthreads();
#define ATT_SYNC() do { if constexpr (VAR != 2) __syncthreads(); } while (0)
    for (int j = 1; j + 1 < NT; j += 2) {
        SBAR(); qkt<DQ>(pB0, pB1, K_lds + SHM_K, qr, qx, r32, hi);
        finishSM<VAR>(pA0, pA1, alA, l_reg, pa0, pa1, pa2, pa3); SBAR();
        if constexpr (VAR != 3) SLOAD(SO, (j + SD) * KVBLK); SBAR();
        pv_d0(o, vb0, pa0, pa1, pa2, pa3); partialSM<DQ, VAR>(pB0, pB1, m_reg, mnB, alB);
        ATT_SYNC(); SWAIT(); SWRITE(0, SE);
        RESC(alB); ATT_SYNC();
        SBAR(); qkt<DQ>(pA0, pA1, K_lds, qr, qx, r32, hi);
        finishSM<VAR>(pB0, pB1, alB, l_reg, pa0, pa1, pa2, pa3); SBAR();
        if constexpr (VAR != 3) { if (SD == 1 || j + 3 < NT) SLOAD(SE, (j + 1 + SD) * KVBLK); } SBAR();
        pv_d0(o, vb0 + SHM_V, pa0, pa1, pa2, pa3); partialSM<DQ, VAR>(pA0, pA1, m_reg, mnA, alA);
        ATT_SYNC(); SWAIT(); SWRITE(1, SO);
        RESC(alA); ATT_SYNC();
    }
    SBAR(); qkt<DQ>(pB0, pB1, K_lds + SHM_K, qr, qx, r32, hi);
    finishSM<VAR>(pA0, pA1, alA, l_reg, pa0, pa1, pa2, pa3); SBAR();
    pv_d0(o, vb0, pa0, pa1, pa2, pa3); partialSM<DQ, VAR>(pB0, pB1, m_reg, mnB, alB);
    ATT_SYNC(); RESC(alB);
    finishSM<VAR>(pB0, pB1, alB, l_reg, pa0, pa1, pa2, pa3); SBAR();
    pv_d0(o, vb0 + SHM_V, pa0, pa1, pa2, pa3);
    if (hi == 0) li_l[r32] = l_reg; asm volatile("s_waitcnt lgkmcnt(0)" ::: "memory");
    float rli[16];
#pragma unroll
    for (int r = 0; r < 16; ++r) rli[r] = __builtin_amdgcn_rcpf(li_l[crow(r, hi)]);
    unsigned char* Ow = Ob + (long)(wid * QBLK) * ldo;
#pragma unroll
    for (int r = 0; r < 16; ++r) { const int orow = crow(r, hi);
#pragma unroll
        for (int d0 = 0; d0 < 4; ++d0) Ow[(long)orow * ldo + d0 * 32 + r32] = (unsigned char)(__builtin_amdgcn_cvt_pk_fp8_f32(o[d0][r] * rli[r] * 32.0f, 0.f, 0, false) & 0xff); }
#undef SLOAD
#undef ATT_SYNC
#undef SWRITE
#undef SWAIT
#undef RESC
}
}

template <int KS> __device__ __forceinline__ void mma_xy(f32x16& acc, const LAS bf16_t* X, const LAS bf16_t* Y, int hi) {
#pragma unroll
    for (int ks = 0; ks < KS; ++ks) { const bf16x8 a = *(const LAS bf16x8*)(X + ks * 16 + hi * 8), b = *(const LAS bf16x8*)(Y + ks * 16 + hi * 8);
        acc = __builtin_amdgcn_mfma_f32_32x32x16_bf16(a, b, acc, 0, 0, 0); }
}
__device__ __forceinline__ float logsig16(float x) { const float e = __expf(-fabsf(x)); return (fminf(x, 0.f) - __logf(1.f + e)) * 0.0625f; }
__device__ __forceinline__ int gla_sidx(int b, int dir, int h) { return (b * 2 + dir) * 4 + h; }

__device__ __forceinline__ void gla_cumsum_lds(const Ctx& C, int l, int h, int dir, const LAS float* lr, LAS float* segtot, LAS float* CUM) {
    const int seg = C.tid >> 7, d = C.tid & 127;
    const float* wa = INP(dir ? I_WA2B : I_WA2F) + (size_t)l * 16 * 512 + h * 128 + d;
    const float bias = INP(dir ? I_BAB : I_BAF)[l * 512 + h * 128 + d];
    float w[16], cum[16];
#pragma unroll
    for (int j = 0; j < 16; ++j) w[j] = wa[j * 512];
    float run = 0.f;
#pragma unroll
    for (int i = 0; i < 16; ++i) { const int s = seg * 16 + i, tk = dir ? 63 - s : s; float pre = bias;
#pragma unroll
        for (int j = 0; j < 16; ++j) pre += lr[tk * 32 + dir * 16 + j] * w[j];
        run += logsig16(pre); cum[i] = run; }
    segtot[seg * 128 + d] = run;
    __syncthreads();
    float off = 0.f;
#pragma unroll
    for (int q = 0; q < 3; ++q) if (q < seg) off += segtot[q * 128 + d];
#pragma unroll
    for (int i = 0; i < 16; ++i) { const int s = seg * 16 + i, tk = dir ? 63 - s : s; CUM[tk * 132 + d] = cum[i] + off; }
    __syncthreads();
}
__device__ __forceinline__ void unpack8(const u32x4 w, float (&x)[8]) { x[0] = bflo(w.x); x[1] = bfhi(w.x); x[2] = bflo(w.y); x[3] = bfhi(w.y); x[4] = bflo(w.z); x[5] = bfhi(w.z); x[6] = bflo(w.w); x[7] = bfhi(w.w); }
__device__ __forceinline__ void gla_build_vt(const Ctx& C, const bf16_t* P, size_t r0, int h, LAS bf16_t* VT) {
    u32x4 v[4];
#pragma unroll
    for (int it = 0; it < 4; ++it) { const int idx = C.tid + it * NTHREADS, sv = idx >> 5, e0 = (idx & 31) * 8; v[it] = *(const u32x4*)(P + (r0 + sv) * NP + C_LV + h * 256 + e0); }
#pragma unroll
    for (int it = 0; it < 4; ++it) { const int idx = C.tid + it * NTHREADS, sv = idx >> 5, e0 = (idx & 31) * 8;
        const unsigned wd[4] = {v[it].x, v[it].y, v[it].z, v[it].w};
#pragma unroll
        for (int q = 0; q < 4; ++q) { VT[(e0 + 2 * q) * 72 + sv] = (bf16_t)(wd[q] & 0xffffu); VT[(e0 + 2 * q + 1) * 72 + sv] = (bf16_t)(wd[q] >> 16); } }
}

__device__ __forceinline__ void phase_gla_local(const Ctx& C, int l, int rot) {
    const bf16_t* P = WSP(bf16_t, WS_P); bf16_t* GST = WSP(bf16_t, WS_GST); float* GDEC = WSP(float, WS_GDEC);
    LAS float* lr = (LAS float*)C.lds;
    LAS float* segtot = (LAS float*)(C.lds + 8192);
    LAS bf16_t* KT = (LAS bf16_t*)(C.lds + 10240);
    LAS bf16_t* VT = (LAS bf16_t*)(C.lds + 28672);
    LAS float* CUM = (LAS float*)(C.lds + 65536);
    const int r32 = C.lane & 31, hi = C.lane >> 5, d = C.tid & 127;
    const int btk = C.tid >> 3, bdg = (C.tid & 7) * 16;
    for (int unit = (C.bid + C.G - rot % C.G) % C.G; unit < NBATCH * 4 * NCH; unit += C.G) {
        const int b = unit / (4 * NCH), h = (unit / NCH) % 4, ck = unit % NCH; const size_t r0 = (size_t)b * RPB + ck * 64;
        for (int i = C.tid; i < 64 * 32; i += NTHREADS) lr[i] = bf2f(P[(r0 + (i >> 5)) * NP + C_LRF + (i & 31)]);
        const u32x4 kw0 = *(const u32x4*)(P + (r0 + btk) * NP + C_LK + h * 128 + bdg), kw1 = *(const u32x4*)(P + (r0 + btk) * NP + C_LK + h * 128 + bdg + 8);
        gla_build_vt(C, P, r0, h, VT);
        __syncthreads();
#pragma unroll 1
        for (int dir = 0; dir < 2; ++dir) {
            gla_cumsum_lds(C, l, h, dir, lr, segtot, CUM);
            const int tend = dir ? 0 : 63;
            const size_t sx = (size_t)gla_sidx(b, dir, h) * NCH + ck;
            if (C.tid < 128) GDEC[sx * 128 + d] = __expf(CUM[tend * 132 + d]);
            { float kf[16]; { float t8[8]; unpack8(kw0, t8);
#pragma unroll
                for (int i = 0; i < 8; ++i) kf[i] = t8[i]; unpack8(kw1, t8);
#pragma unroll
                for (int i = 0; i < 8; ++i) kf[8 + i] = t8[i]; }
#pragma unroll
              for (int q = 0; q < 4; ++q) { const f32x4 cm = *(const LAS f32x4*)(CUM + btk * 132 + bdg + 4 * q), be = *(const LAS f32x4*)(CUM + tend * 132 + bdg + 4 * q);
#pragma unroll
                  for (int i = 0; i < 4; ++i) KT[(bdg + 4 * q + i) * 72 + btk] = f2bf(kf[4 * q + i] * __expf(be[i] - cm[i])); } }
            __syncthreads();
            { const int dt = C.wid & 3, eb = (C.wid >> 2) * 4;
              f32x16 acc[4] = {};
#pragma unroll
              for (int q = 0; q < 4; ++q) mma_xy<4>(acc[q], KT + (dt * 32 + r32) * 72, VT + ((eb + q) * 32 + r32) * 72, hi);
              bf16_t* st = GST + sx * 32768;
#pragma unroll
              for (int q = 0; q < 4; ++q)
#pragma unroll
                  for (int g = 0; g < 4; ++g) { u32x2 w; w.x = cvt_pk_bf16(acc[q][4 * g], acc[q][4 * g + 1]); w.y = cvt_pk_bf16(acc[q][4 * g + 2], acc[q][4 * g + 3]);
                      *(u32x2*)(st + (size_t)((eb + q) * 32 + r32) * 128 + dt * 32 + 8 * g + 4 * hi) = w; } }
            __syncthreads();
        }
    }
}

__device__ __forceinline__ void phase_gla_scan(const Ctx& C) {
    bf16_t* GST = WSP(bf16_t, WS_GST); const float* GDEC = WSP(float, WS_GDEC);
    for (int gid = C.bid * NTHREADS + C.tid; gid < 16 * 8192; gid += C.G * NTHREADS) {
        const int sidx = gid >> 13, g = gid & 8191, dir = (sidx >> 2) & 1, d4 = (g & 31) * 4;
        bf16_t* base = GST + (size_t)sidx * NCH * 32768 + (size_t)g * 4;
        const float* dbase = GDEC + (size_t)sidx * NCH * 128 + d4;
        float S[4] = {0.f, 0.f, 0.f, 0.f};
        for (int st = 0; st < NCH; st += 4) {
            int ck[4]; u32x2 L[4]; f32x4 dc[4];
#pragma unroll
            for (int q = 0; q < 4; ++q) { const int s = st + q; ck[q] = dir ? (s < 4 ? 3 - s : NCH + 3 - s) : s;
                L[q] = *(const u32x2*)(base + (size_t)ck[q] * 32768); dc[q] = *(const f32x4*)(dbase + (size_t)ck[q] * 128); }
#pragma unroll
            for (int q = 0; q < 4; ++q) { u32x2 w; w.x = cvt_pk_bf16(S[0], S[1]); w.y = cvt_pk_bf16(S[2], S[3]);
                *(u32x2*)(base + (size_t)ck[q] * 32768) = w;
                S[0] = dc[q][0] * S[0] + bflo(L[q].x); S[1] = dc[q][1] * S[1] + bfhi(L[q].x); S[2] = dc[q][2] * S[2] + bflo(L[q].y); S[3] = dc[q][3] * S[3] + bfhi(L[q].y); }
        }
    }
}

__device__ __forceinline__ void phase_gla_out(const Ctx& C, int l, int rot) {
    const bf16_t* P = WSP(bf16_t, WS_P); const bf16_t* GST = WSP(bf16_t, WS_GST); unsigned char* OL = C.ws + WS_OL;
    LAS float* lr = (LAS float*)C.lds;
    LAS float* segtot = (LAS float*)(C.lds + 8192);
    LAS bf16_t* QT = (LAS bf16_t*)(C.lds + 10240);
    LAS bf16_t* KT = (LAS bf16_t*)(C.lds + 27648);
    LAS bf16_t* VT = (LAS bf16_t*)(C.lds + 45056);
    LAS bf16_t* SCm = (LAS bf16_t*)(C.lds + 81920);
    LAS float* OB = (LAS float*)(C.lds + 91136);
    LAS float* CUM = OB;
    const float* gon = INP(I_ONG) + l * 256;
    const int r32 = C.lane & 31, hi = C.lane >> 5;
    const int btk = C.tid >> 3, bdg = (C.tid & 7) * 16;
    for (int unit = (C.bid + C.G - rot % C.G) % C.G; unit < NBATCH * 4 * NCH; unit += C.G) {
        const int b = unit / (4 * NCH), h = (unit / NCH) % 4, ck = unit % NCH; const size_t r0 = (size_t)b * RPB + ck * 64;
        for (int i = C.tid; i < 64 * 32; i += NTHREADS) lr[i] = bf2f(P[(r0 + (i >> 5)) * NP + C_LRF + (i & 31)]);
        const bf16_t* qp = P + (r0 + btk) * NP + C_LQ + h * 128 + bdg; const bf16_t* kp = P + (r0 + btk) * NP + C_LK + h * 128 + bdg;
        const u32x4 qw0 = *(const u32x4*)qp, qw1 = *(const u32x4*)(qp + 8), kw0 = *(const u32x4*)kp, kw1 = *(const u32x4*)(kp + 8);
        gla_build_vt(C, P, r0, h, VT);
        __syncthreads();
        f32x16 oacc[2] = {};
#pragma unroll 1
        for (int dir = 0; dir < 2; ++dir) {
            gla_cumsum_lds(C, l, h, dir, lr, segtot, CUM);
            { float qf[8], kf[8];
#pragma unroll
              for (int hh = 0; hh < 2; ++hh) { unpack8(hh ? qw1 : qw0, qf); unpack8(hh ? kw1 : kw0, kf);
                  const f32x4 c0 = *(const LAS f32x4*)(CUM + btk * 132 + bdg + 8 * hh), c1 = *(const LAS f32x4*)(CUM + btk * 132 + bdg + 8 * hh + 4);
                  float qo[8], ko[8];
#pragma unroll
                  for (int i = 0; i < 8; ++i) { const float cm = i < 4 ? c0[i & 3] : c1[i & 3]; qo[i] = qf[i] * __expf(cm) * 0.088388347648318440f; ko[i] = kf[i] * __expf(-cm); }
                  u32x4 wq, wk; wq.x = cvt_pk_bf16(qo[0], qo[1]); wq.y = cvt_pk_bf16(qo[2], qo[3]); wq.z = cvt_pk_bf16(qo[4], qo[5]); wq.w = cvt_pk_bf16(qo[6], qo[7]);
                  wk.x = cvt_pk_bf16(ko[0], ko[1]); wk.y = cvt_pk_bf16(ko[2], ko[3]); wk.z = cvt_pk_bf16(ko[4], ko[5]); wk.w = cvt_pk_bf16(ko[6], ko[7]);
                  *(LAS u32x4*)(QT + btk * 136 + bdg + 8 * hh) = wq; *(LAS u32x4*)(KT + btk * 136 + bdg + 8 * hh) = wk; } }
            __syncthreads();
            if (C.wid < 4) { const int mt = C.wid >> 1, nt = C.wid & 1; f32x16 sc = {};
                mma_xy<8>(sc, QT + (mt * 32 + r32) * 136, KT + (nt * 32 + r32) * 136, hi);
#pragma unroll
                for (int i = 0; i < 16; ++i) { const int t = mt * 32 + att::crow(i, hi), sx_ = nt * 32 + r32; const bool keep = dir ? (sx_ >= t) : (sx_ <= t);
                    SCm[t * 72 + sx_] = f2bf(keep ? sc[i] : 0.f); } }
            __syncthreads();
            { const bf16_t* st = GST + ((size_t)gla_sidx(b, dir, h) * NCH + ck) * 32768 + (size_t)(C.wid * 32 + r32) * 128 + hi * 8;
              bf16x8 sb[8];
#pragma unroll
              for (int ks = 0; ks < 8; ++ks) sb[ks] = *(const bf16x8*)(st + ks * 16);
#pragma unroll
              for (int mt = 0; mt < 2; ++mt) {
                  mma_xy<4>(oacc[mt], SCm + (mt * 32 + r32) * 72, VT + (C.wid * 32 + r32) * 72, hi);
#pragma unroll
                  for (int ks = 0; ks < 8; ++ks) { const bf16x8 a = *(const LAS bf16x8*)(QT + (mt * 32 + r32) * 136 + ks * 16 + hi * 8);
                      oacc[mt] = __builtin_amdgcn_mfma_f32_32x32x16_bf16(a, sb[ks], oacc[mt], 0, 0, 0); } } }
            __syncthreads();
        }
#pragma unroll
        for (int mt = 0; mt < 2; ++mt)
#pragma unroll
            for (int i = 0; i < 16; ++i) OB[(mt * 32 + att::crow(i, hi)) * 260 + C.wid * 32 + r32] = oacc[mt][i];
        __syncthreads();
        { const int t = C.tid >> 3, part = C.tid & 7; f32x4 v[8]; float ss = 0.f;
#pragma unroll
          for (int jj = 0; jj < 8; ++jj) { v[jj] = *(const LAS f32x4*)(OB + t * 260 + jj * 32 + part * 4); ss += v[jj][0] * v[jj][0] + v[jj][1] * v[jj][1] + v[jj][2] * v[jj][2] + v[jj][3] * v[jj][3]; }
          ss += dppmov<DPP_HMIRROR>(ss); ss += dppmov<DPP_Q3210>(ss); ss += dppmov<DPP_Q1032>(ss);
          const float rs = rsqrtf(ss * (1.0f / 256.0f) + NORM_EPS);
#pragma unroll
          for (int jj = 0; jj < 8; ++jj) { const int e = jj * 32 + part * 4; const f32x4 g = *(const f32x4*)(gon + e);
              const u32x2 gt = *(const u32x2*)(P + (r0 + t) * NP + C_LG + h * 256 + e);
              const float o0 = v[jj][0] * rs * g[0] * siluf_(bflo(gt.x)), o1 = v[jj][1] * rs * g[1] * siluf_(bfhi(gt.x)), o2 = v[jj][2] * rs * g[2] * siluf_(bflo(gt.y)), o3 = v[jj][3] * rs * g[3] * siluf_(bfhi(gt.y));
              int p8 = __builtin_amdgcn_cvt_pk_fp8_f32(o0, o1, 0, false); p8 = __builtin_amdgcn_cvt_pk_fp8_f32(o2, o3, p8, true);
              *(unsigned*)(OL + (r0 + t) * 1024 + h * 256 + e) = (unsigned)p8; } }
        __syncthreads();
    }
}

__device__ __forceinline__ unsigned f_ord(float f) { const unsigned u = __float_as_uint(f); return u ^ ((unsigned)((int)u >> 31) | 0x80000000u); }
__device__ __forceinline__ float f_unord(unsigned k) { return __uint_as_float((k & 0x80000000u) ? (k ^ 0x80000000u) : ~k); }
__device__ __forceinline__ void ins_u(unsigned (&L)[16], unsigned x) {
#pragma unroll
    for (int j = 0; j < 16; ++j) { const unsigned h = L[j] > x ? L[j] : x; x = L[j] > x ? x : L[j]; L[j] = h; }
}
__device__ __forceinline__ void ins_f(float (&M)[16], float x) {
#pragma unroll
    for (int j = 0; j < 16; ++j) { const float h = M[j] > x ? M[j] : x; x = M[j] > x ? x : M[j]; M[j] = h; }
}
__device__ __forceinline__ void peer_top16(const bf16_t* __restrict__ qrow, const bf16_t* __restrict__ keys, int r32, int hi, unsigned (&L)[16]) {
    bf16x8 qf[8];
#pragma unroll
    for (int kk = 0; kk < 8; ++kk) qf[kk] = *(const bf16x8*)(qrow + kk * 16 + hi * 8);
#pragma unroll
    for (int j = 0; j < 16; ++j) L[j] = 0u;
    bf16x8 kA[8], kB[8];
    const bf16_t* kl = keys + (size_t)r32 * 128 + hi * 8;
#define PT_LDK(dst, mt) do { _Pragma("unroll") for (int kk = 0; kk < 8; ++kk) dst[kk] = *(const bf16x8*)(kl + (mt) * 32 * 128 + kk * 16); } while (0)
#define PT_PROC(src, mt) do { f32x16 acc = {}; \
        _Pragma("unroll") for (int kk = 0; kk < 8; ++kk) acc = __builtin_amdgcn_mfma_f32_32x32x16_bf16(src[kk], qf[kk], acc, 0, 0, 0); \
        _Pragma("unroll") for (int i = 0; i < 16; ++i) { const unsigned kidx = (unsigned)((mt) * 32 + att::crow(i, hi)); ins_u(L, (f_ord(acc[i]) & ~127u) | (127u - kidx)); } } while (0)
    PT_LDK(kA, 0);
#pragma unroll 1
    for (int mp = 0; mp < 2; ++mp) { PT_LDK(kB, 2 * mp + 1); PT_PROC(kA, 2 * mp); if (mp == 0) PT_LDK(kA, 2); PT_PROC(kB, 2 * mp + 1); }
#undef PT_LDK
#undef PT_PROC
    unsigned Pn[16];
#pragma unroll
    for (int j = 0; j < 16; ++j) { auto r_ = __builtin_amdgcn_permlane32_swap(L[j], L[j], false, false); Pn[j] = hi ? r_[0] : r_[1]; }
#pragma unroll
    for (int j = 0; j < 16; ++j) ins_u(L, Pn[j]);
}
__device__ __forceinline__ void phase_peer_select(const Ctx& C, const bool latent_only) {
    const bf16_t* PQ = WSP(bf16_t, WS_PQ); const bf16_t* K1 = WSP(bf16_t, WS_K1); const bf16_t* K2 = WSP(bf16_t, WS_K2);
    int* PIDX = WSP(int, WS_PIDX); float* PG = WSP(float, WS_PG);
    const int r32 = C.lane & 31, hi = C.lane >> 5, head = C.wid;
    const int ngrp = latent_only ? NBATCH * SEQ / 32 : TT / 32;
    for (int gi = C.bid; gi < ngrp; gi += C.G) {
        const int grp = latent_only ? gi + (CTXL / 32) * (1 + gi / (SEQ / 32)) : gi;
        const size_t tok = (size_t)grp * 32 + r32;
        unsigned L1[16], L2[16];
        peer_top16(PQ + tok * DM + head * 256, K1 + (size_t)head * 128 * 128, r32, hi, L1);
        peer_top16(PQ + tok * DM + head * 256 + 128, K2 + (size_t)head * 128 * 128, r32, hi, L2);
        float v1[16], v2[16];
#pragma unroll
        for (int j = 0; j < 16; ++j) { v1[j] = f_unord(L1[j] & ~127u); v2[j] = f_unord(L2[j] & ~127u); }
        float M[16];
#pragma unroll
        for (int j = 0; j < 16; ++j) M[j] = -3.0e38f;
#pragma unroll
        for (int a = 0; a < 16; ++a)
#pragma unroll
            for (int b = 0; b < 16; ++b) if ((a + 1) * (b + 1) <= 16) ins_f(M, v1[a] + v2[b]);
        const float thr = M[15], mx = M[0]; float den = 0.f;
#pragma unroll
        for (int j = 0; j < 16; ++j) den += __expf(M[j] - mx);
        const float rden = 1.0f / den;
        int pos = 0; int* ip = PIDX + tok * 128 + head * 16; float* gp = PG + tok * 128 + head * 16;
#pragma unroll
        for (int a = 0; a < 16; ++a)
#pragma unroll
            for (int b = 0; b < 16; ++b) if ((a + 1) * (b + 1) <= 16) {
                const float val = v1[a] + v2[b];
                if (val >= thr && pos < 16) { if (hi == 0) { ip[pos] = (int)((127u - (L1[a] & 127u)) * 128u + (127u - (L2[b] & 127u))); gp[pos] = __expf(val - mx) * rden; } ++pos; } }
    }
}
template <int OFF> __device__ __forceinline__ float dotf8(const float (&h)[32], const u32x4 w, float acc) {
#pragma unroll
    for (int j = 0; j < 4; ++j) { const f32x2 lo = __builtin_amdgcn_cvt_pk_f32_fp8((int)w[j], false), hi = __builtin_amdgcn_cvt_pk_f32_fp8((int)w[j], true);
        acc += h[OFF + 4 * j] * lo.x; acc += h[OFF + 4 * j + 1] * lo.y; acc += h[OFF + 4 * j + 2] * hi.x; acc += h[OFF + 4 * j + 3] * hi.y; }
    return acc;
}
constexpr float ATT_O8_SCALE = 32.0f;
constexpr int GT_MAXTOK = 9;
template <bool LAST> __device__ __forceinline__ void phase_peer_gather(const Ctx& C, const float* modl, const float pscale) {
    const unsigned char* pt = C.ws + WS_PT + (size_t)(LAST ? DEPTH - 1 : 0) * PT_BYTES;
    const bf16_t* HB = WSP(bf16_t, WS_HB); const unsigned char* U8 = pt + PT_U8; const unsigned char* V8 = pt + PT_V8;
    const float* SCU = (const float*)(pt + PT_SCU); const float* SCV = (const float*)(pt + PT_SCV);
    const int* PIDX = WSP(int, WS_PIDX); const float* PG = WSP(float, WS_PG); float* XS = WSP(float, WS_XS);
    const int lane = C.lane, s = lane >> 3, j = lane & 7; const unsigned j16 = (unsigned)j * 16u;
    LAS int* IDS = (LAS int*)(C.lds + C.wid * (GT_MAXTOK * 512));
    LAS float* ACT = (LAS float*)(C.lds + 8 * GT_MAXTOK * 512 + C.wid * (GT_MAXTOK * 512));
    LAS int* ROWS = (LAS int*)(C.lds + 16 * GT_MAXTOK * 512 + C.wid * 64);
    int nk = 0;
    {
      const int per = (TT + C.G - 1) / C.G, base = C.bid * per;
#pragma unroll 1
      for (int k = 0; k < GT_MAXTOK; ++k) { const int o = C.wid + 8 * k; const int r = base + o; if (o < per && r < TT && !(LAST && (r % RPB) < CTXL)) { if (lane == 0) ROWS[nk] = r; ++nk; } } }
#define GT_ROW(k) __builtin_amdgcn_readfirstlane(ROWS[k])
#pragma unroll 1
    for (int k = 0; k < nk; ++k) { const int r = GT_ROW(k);
        IDS[k * 128 + lane] = (PIDX[(size_t)r * 128 + lane] & (NEXP - 1)) << 7; IDS[k * 128 + 64 + lane] = (PIDX[(size_t)r * 128 + 64 + lane] & (NEXP - 1)) << 7;
        ACT[k * 128 + lane] = 0.f; ACT[k * 128 + 64 + lane] = 0.f; }
    const int nit = 32 * nk;
#define GT_ITEM(it_) const int cb_ = (it_) / (2 * nk), rem_ = (it_) - cb_ * (2 * nk), k_ = rem_ >> 1, hf_ = rem_ & 1
#define GT_LOADU(UQ, HQ, it_) do { GT_ITEM(it_); const int r_ = GT_ROW(k_); \
        const bf16_t* hp_ = HB + (size_t)r_ * DM + cb_ * 128 + j * 16; HQ[0] = *(const u32x4*)hp_; HQ[1] = *(const u32x4*)(hp_ + 8); \
        const unsigned char* ub_ = U8 + (size_t)cb_ * ((size_t)NEXP * 128);     \
        _Pragma("unroll") for (int eg = 0; eg < 8; ++eg) { const unsigned off_ = ((unsigned)IDS[k_ * 128 + (hf_ * 8 + eg) * 8 + s] & idmask) + j16; UQ[eg] = *(const u32x4*)(ub_ + off_); } } while (0)
#define GT_COMPU(UQ, HQ, it_) do { GT_ITEM(it_); (void)cb_; f32x2 hf2[8]; \
        _Pragma("unroll") for (int hh = 0; hh < 2; ++hh) { const u32x4 w_ = HQ[hh]; \
            hf2[hh * 4 + 0] = (f32x2){bflo(w_.x), bfhi(w_.x)}; hf2[hh * 4 + 1] = (f32x2){bflo(w_.y), bfhi(w_.y)}; hf2[hh * 4 + 2] = (f32x2){bflo(w_.z), bfhi(w_.z)}; hf2[hh * 4 + 3] = (f32x2){bflo(w_.w), bfhi(w_.w)}; } \
        float d[8]; \
        _Pragma("unroll") for (int eg = 0; eg < 8; ++eg) { f32x2 d2 = (f32x2){0.f, 0.f}; \
            _Pragma("unroll") for (int q = 0; q < 4; ++q) { const f32x2 lo = __builtin_amdgcn_cvt_pk_f32_fp8((int)UQ[eg][q], false), hi = __builtin_amdgcn_cvt_pk_f32_fp8((int)UQ[eg][q], true); \
                d2 += hf2[2 * q] * lo; d2 += hf2[2 * q + 1] * hi; } \
            d[eg] = d2.x + d2.y; } \
          \
        float t4[4], t2[2], t1; \
        _Pragma("unroll") for (int i = 0; i < 4; ++i) { const float snd = (j & 4) ? d[i] : d[i + 4], kp = (j & 4) ? d[i + 4] : d[i]; t4[i] = kp + dppmov<DPP_HMIRROR>(snd); } \
        _Pragma("unroll") for (int i = 0; i < 2; ++i) { const float snd = (j & 2) ? t4[i] : t4[i + 2], kp = (j & 2) ? t4[i + 2] : t4[i]; t2[i] = kp + dppmov<DPP_Q3210>(snd); } \
        { const float snd = (j & 1) ? t2[0] : t2[1], kp = (j & 1) ? t2[1] : t2[0]; t1 = kp + dppmov<DPP_Q1032>(snd); } \
        ACT[k_ * 128 + (hf_ * 8 + j) * 8 + s] += t1; } while (0)
#ifdef DBG_GDUP
#pragma unroll 1
    for (int rep_ = 0; rep_ < 2; ++rep_) {
    const unsigned idmask = rep_ == 0 ? ((unsigned)DBG_GMASK << 7 | 127u) : 0xffffffffu;
    if (rep_ == 1) { for (int k = 0; k < nk; ++k) { ACT[k * 128 + lane] = 0.f; ACT[k * 128 + 64 + lane] = 0.f; } }
#else
    { const unsigned idmask = 0xffffffffu;
#endif
    if (nit > 0) {
        u32x4 uA[8], uB[8], hA[2], hB[2];
        GT_LOADU(uA, hA, 0);
#pragma unroll 1
        for (int it = 0; it < nit; it += 2) {
            GT_LOADU(uB, hB, it + 1);
            GT_COMPU(uA, hA, it);
            if (it + 2 < nit) GT_LOADU(uA, hA, it + 2);
            GT_COMPU(uB, hB, it + 1);
        }
    }
    }
#undef GT_LOADU
#undef GT_COMPU
#pragma unroll 1
    for (int k = 0; k < nk; ++k) { const int r = GT_ROW(k);
#pragma unroll
        for (int hh = 0; hh < 2; ++hh) { const int e = hh * 64 + lane; const int id = IDS[k * 128 + e] >> 7; const float a = ACT[k * 128 + e] * SCU[id];
            const float w = PG[(size_t)r * 128 + e] * 0.5f * a * (1.0f + erff(a * 0.70710678118654752f));
#if defined(DBG_CHECK) && (DBG_CHECK == 3 || DBG_CHECK == 4)
            if (((r - 300) & 63) == 0 && r >= 300 && r < 300 + 64 * 128) WSP(float, WS_OM)[(size_t)r * 128 + e] = w;
#endif
            ACT[k * 128 + e] = w * SCV[id]; } }
#define GT_LOADV(VQ, WV, it_) do { GT_ITEM(it_); const unsigned char* vb_ = V8 + (size_t)cb_ * ((size_t)NEXP * 128); \
        _Pragma("unroll") for (int eg = 0; eg < 8; ++eg) { const int e_ = k_ * 128 + (hf_ * 8 + eg) * 8 + s; const unsigned off_ = (unsigned)IDS[e_] + j16; VQ[eg] = *(const u32x4*)(vb_ + off_); WV[eg] = ACT[e_]; } } while (0)
#define GT_COMPV(VQ, WV) do { \
        _Pragma("unroll") for (int eg = 0; eg < 8; ++eg) { const f32x2 w2_ = (f32x2){WV[eg], WV[eg]}; \
            _Pragma("unroll") for (int q = 0; q < 4; ++q) { \
                const f32x2 lo = __builtin_amdgcn_cvt_pk_f32_fp8((int)VQ[eg][q], false), hi = __builtin_amdgcn_cvt_pk_f32_fp8((int)VQ[eg][q], true); \
                acc2[2 * q] += w2_ * lo; acc2[2 * q + 1] += w2_ * hi; } } } while (0)
    if (nit > 0) {
        u32x4 vA[8], vB[8]; float wA[8], wB[8];
        GT_LOADV(vA, wA, 0);
#pragma unroll 1
        for (int it = 0; it < nit; it += 2) {
            f32x2 acc2[8];
#pragma unroll
            for (int i = 0; i < 8; ++i) acc2[i] = (f32x2){0.f, 0.f};
            GT_LOADV(vB, wB, it + 1);
            GT_COMPV(vA, wA);
            if (it + 2 < nit) GT_LOADV(vA, wA, it + 2);
            GT_COMPV(vB, wB);
            f32x2 t4[4], t2[2], t1;
#pragma unroll
            for (int i = 0; i < 4; ++i) { const f32x2 snd = (s & 4) ? acc2[i] : acc2[i + 4], kp = (s & 4) ? acc2[i + 4] : acc2[i];
                t4[i] = kp + (f32x2){xchg32(snd.x, lane), xchg32(snd.y, lane)}; }
#pragma unroll
            for (int i = 0; i < 2; ++i) { const f32x2 snd = (s & 2) ? t4[i] : t4[i + 2], kp = (s & 2) ? t4[i + 2] : t4[i];
                t2[i] = kp + (f32x2){xchg16(snd.x, lane), xchg16(snd.y, lane)}; }
            { const f32x2 snd = (s & 1) ? t2[0] : t2[1], kp = (s & 1) ? t2[1] : t2[0]; t1 = kp + (f32x2){dppmov<DPP_ROR8>(snd.x), dppmov<DPP_ROR8>(snd.y)}; }
            { GT_ITEM(it); (void)hf_; const int r_ = GT_ROW(k_);
              const int col = cb_ * 128 + j * 16 + 2 * s; float* xp = XS + (size_t)r_ * DM + col; const float* g2 = modl + (size_t)mod_sel(r_) * 12288 + 5 * DM + col;
#if defined(DBG_CHECK) && (DBG_CHECK == 3 || DBG_CHECK == 4)
              if (((r_ - 300) & 63) == 0 && r_ >= 300 && r_ < 300 + 64 * 128) { float* dbgo = WSP(float, WS_MQ) + (size_t)r_ * DM + col; dbgo[0] = t1.x; dbgo[1] = t1.y; }
#endif
              const f32x2 x = *(const f32x2*)xp, g = *(const f32x2*)g2;
              *(f32x2*)xp = x + pscale * g * t1; }
        }
    }
#undef GT_LOADV
#undef GT_COMPV
#undef GT_ITEM
#undef GT_ROW
}
__device__ __forceinline__ void phase_final_norm(const Ctx& C) {
    const float* XS = WSP(float, WS_XS); const float* fg = INP(I_FG);
    for (int q = C.bid * 8 + C.wid; q < NBATCH * SEQ; q += C.G * 8) {
        const int b = q / SEQ, t = q % SEQ; const float* xr = XS + ((size_t)b * RPB + CTXL + t) * DM; float* op = C.out + (size_t)q * DM;
        f32x4 v[8]; float ss = 0.f;
#pragma unroll
        for (int c = 0; c < 8; ++c) { v[c] = *(const f32x4*)(xr + c * 256 + C.lane * 4); ss += v[c][0] * v[c][0] + v[c][1] * v[c][1] + v[c][2] * v[c][2] + v[c][3] * v[c][3]; }
        ss = wave_sum(ss); const float rs = rsqrtf(ss * (1.0f / DM) + NORM_EPS);
#pragma unroll
        for (int c = 0; c < 8; ++c) { const f32x4 g = *(const f32x4*)(fg + c * 256 + C.lane * 4); *(f32x4*)(op + c * 256 + C.lane * 4) = v[c] * rs * g; }
    }
}

template <int TYPE  , int VAR = 0> __device__ __forceinline__ void attn_units(const Ctx& C, bool need_ctx) {
    const bf16_t* P = WSP(bf16_t, WS_P);
    const int nu = need_ctx ? 528 : 512;
#pragma unroll 1
    for (int u = C.bid; u < nu; u += C.G) {
        int bh, qb; if (u < 512) { bh = (u >> 8) * 8 + (u & 7); qb = ((u & 255) >> 3) + 1; } else { bh = u - 512; qb = 0; }
        const int b = bh >> 3, h = bh & 7; const size_t rq = (size_t)b * RPB + (size_t)qb * 256, rk = (size_t)b * RPB; const int seq = qb == 0 ? CTXL : RPB;
        __syncthreads();
        if constexpr (TYPE == 1) {
            att::attn_body<128, 2, VAR>(P + rq * NP + C_AQ + h * 128, NP, P + rk * NP + C_AK + (h >> 2) * 128, NP, nullptr, 0, P + rk * NP + C_AV + (h >> 2) * 128, NP,
                                   C.ws + WS_OA + rq * 1024 + h * 128, 1024, seq, false, 0, nullptr, (char*)C.lds, C.tid);
        } else {
            const bf16_t* MQ = WSP(bf16_t, WS_MQ); const bf16_t* MKV = WSP(bf16_t, WS_MKV);
            att::attn_body<192, 1, VAR>(MQ + rq * 1536 + h * 192, 1536, MKV + rk * 2048 + h * 256, 2048, P + rk * NP + C_MKR, NP, MKV + rk * 2048 + h * 256 + 128, 2048,
                                   C.ws + WS_OM + rq * 1024 + h * 128, 1024, seq, qb > 0, (qb - 1) * 256, WSP(float, WS_TABM), (char*)C.lds, C.tid);
        }
    }
    __syncthreads();
}

constexpr int LDS_BYTES = 163840, LDS_BAR_OFF = LDS_BYTES - 16;
constexpr int N_PHASES = 26;
template <int K> __device__ __forceinline__ void run_phase(const Ctx& C0, int l) {
    const Ctx C = launder(C0);
    const float* modl = WSP(float, WS_MODV) + (size_t)l * 3 * 12288;
    if constexpr (K == 0) { phase_modv(C); phase_tables(C); __syncthreads(); phase_cvt_mixer_weights(C, 0); }
    if constexpr (K == 1) {
        if (l == 0) phase_norm_mod<true, true>(C, INP(I_N1G), modl, 0, DM);
        else { phase_norm_mod<false, true>(C, INP(I_N1G) + l * DM, modl, 0, DM); __syncthreads(); phase_cvt_mixer_weights(C, l); }
    }
    if constexpr (K == 2) {
        pg8::Gemm g{WSP(bf16_t, WS_HB), WSP(bf16_t, WS_WIN), TT, NP, DM, DM, DM}; pg8::WinOrder S; S.init(C.G, C.bid, l + 1 < DEPTH);
        pg8::EpiStoreBf16S E{WSP(bf16_t, WS_P), NP, WSP(float, WS_WINS)};
        pg8::gemm_phase<pg8::EpiStoreBf16S, pg8::WinOrder, 1>(C.lds, C.tid, g, S, E);
    }
    if constexpr (K == 3) phase_post_p(C, l);
    if constexpr (K == 4) {
        { pg8::Gemm g{WSP(bf16_t, WS_P) + C_MCQ, WSP(bf16_t, WS_WUQ), TT, 1536, 512, NP, 512}; pg8::StaticOrder S; S.init(TT, 1536, C.G, C.bid);
          pg8::EpiStoreBf16 E{WSP(bf16_t, WS_MQ), 1536}; pg8::gemm_phase(C.lds, C.tid, g, S, E); }
        { pg8::Gemm g{WSP(bf16_t, WS_P) + C_MCKV, WSP(bf16_t, WS_WUKV), TT, 2048, 512, NP, 512}; pg8::StaticOrder S; S.init(TT, 2048, C.G, (C.bid + C.G - 140 % C.G) % C.G);
          pg8::EpiStoreBf16 E{WSP(bf16_t, WS_MKV), 2048}; pg8::gemm_phase(C.lds, C.tid, g, S, E); }
        { const Ctx C2 = launder(C0); phase_gla_local(C2, l, 156); }
#ifdef DBG_DUP_GLALOCAL
        { const Ctx C2 = launder(C0); __syncthreads(); phase_gla_local(C2, l, 156); }
#endif
    }
    if constexpr (K == 5) phase_gla_scan(C);
    if constexpr (K == 6) {
#ifdef DBG_ATTVAR
        { const Ctx Cx = launder(C0); attn_units<0, DBG_ATTVAR>(Cx, l + 1 < DEPTH); } { const Ctx Cx = launder(C0); attn_units<1, DBG_ATTVAR>(Cx, l + 1 < DEPTH); } __syncthreads();
#endif
        attn_units<0>(C, l + 1 < DEPTH); { const Ctx C2 = launder(C0); attn_units<1>(C2, l + 1 < DEPTH); } { const Ctx C3 = launder(C0); phase_gla_out(C3, l, 128); }
#ifdef DBG_DUP_GLAOUT
        { const Ctx C3 = launder(C0); __syncthreads(); phase_gla_out(C3, l, 128); }
#endif
    }
    if constexpr (K == 7) {
        const bf16_t* P = WSP(bf16_t, WS_P); bf16_t* Y = WSP(bf16_t, WS_Y);
        const pg8::Gemm ga{WSP(bf16_t, WS_OA), WSP(bf16_t, WS_WBR), TT, DM, 1024, 1024, 1024}, gl{WSP(bf16_t, WS_OL), (const bf16_t*)(C.ws + WS_WBR + (size_t)2048 * 1024), TT, DM, 1024, 1024, 1024},
                        gm{WSP(bf16_t, WS_OM), (const bf16_t*)(C.ws + WS_WBR + (size_t)2 * 2048 * 1024), TT, DM, 1024, 1024, 1024};
        unsigned char* Y8 = C.ws + WS_HB;
        const float* wbs = WSP(float, WS_WBRS);
        const pg8::EpiGate<true> Ea{Y, P + C_GA, nullptr, wbs}; const pg8::EpiGate<false> El{Y, P + C_GL, nullptr, wbs + DM}; const pg8::EpiGate<false, true> Em{Y, P + C_GM, Y8, wbs + 2 * DM};
        pg8::StaticOrder S; S.init(TT, DM, C.G, C.bid, l + 1 >= DEPTH);
        pg8::gemm_phase<pg8::EpiGate<true>, pg8::StaticOrder, 1>(C.lds, C.tid, ga, S, Ea); pg8::gemm_phase<pg8::EpiGate<false>, pg8::StaticOrder, 1>(C.lds, C.tid, gl, S, El);
        pg8::gemm_phase<pg8::EpiGate<false, true>, pg8::StaticOrder, 1>(C.lds, C.tid, gm, S, Em);
        if (l == 0) { const Ctx C2 = launder(C0); phase_cvt_peer_tables(C2, 0, 0, NEXP, S.nwg % C.G); }
    }
    if constexpr (K == 8) {
        pg8::Gemm g{WSP(bf16_t, WS_HB), WSP(bf16_t, WS_WOUT), TT, DM, DM, DM, DM};
        const pg8::EpiResidT<true> E{WSP(float, WS_XS), DM, modl + 2 * DM, WSP(float, WS_WOUTS)};
        pg8::StaticOrder S; S.init(TT, DM, C.G, C.bid, l + 1 >= DEPTH);
        pg8::gemm_phase<pg8::EpiResidT<true>, pg8::StaticOrder, 1>(C.lds, C.tid, g, S, E);
        if (l == 0 && DEPTH > 1) { const Ctx C2 = launder(C0); phase_cvt_peer_tables(C2, 1, 0, NEXP / 2, S.nwg % C.G); }
    }
    if constexpr (K == 9) phase_norm_mod<false>(C, INP(I_N2G) + l * DM, modl, 3 * DM, 4 * DM);
    if constexpr (K == 10) {
        pg8::Gemm g{WSP(bf16_t, WS_HB), WSP(bf16_t, WS_WQ), TT, DM, DM, DM, DM};
        pg8::EpiStoreBf16 E{WSP(bf16_t, WS_PQ), DM};
        pg8::StaticOrder S; S.init(TT, DM, C.G, C.bid, l + 1 >= DEPTH); pg8::gemm_phase(C.lds, C.tid, g, S, E);
        if (l == 0 && DEPTH > 1) { const Ctx C2 = launder(C0); phase_cvt_peer_tables(C2, 1, NEXP / 2, NEXP, S.nwg % C.G); }
    }
    if constexpr (K == 11) phase_peer_select(C, l + 1 >= DEPTH);
    if constexpr (K == 13) phase_final_norm(C);
    if constexpr (K == 12) {
#ifdef DBG_DUP12
        if (l + 1 < DEPTH) phase_peer_gather<false>(C, modl, 0.0f); else phase_peer_gather<true>(C, modl, 0.0f);
        __syncthreads();
#endif
        if (l + 1 < DEPTH) phase_peer_gather<false>(C, modl, DBG_PEER0); else phase_peer_gather<true>(C, modl, DBG_PEER1); }
}
__device__ __forceinline__ Ctx make_ctx(const Args& args, unsigned char* lds_raw) {
    Ctx C0; C0.in = (const __attribute__((address_space(4))) cfp_t*)__builtin_amdgcn_kernarg_segment_ptr(); C0.out = args.out; C0.ws = args.ws; C0.lds = (LAS unsigned char*)lds_raw;
    C0.tid = threadIdx.x; C0.lane = C0.tid & 63; C0.wid = __builtin_amdgcn_readfirstlane(C0.tid >> 6); C0.G = gridDim.x; C0.bid = blockIdx.x;
    return C0;
}
template <int K> __global__ void __launch_bounds__(NTHREADS, 2) k_one(Args args) {
    extern __shared__ __attribute__((aligned(16))) unsigned char lds_raw[];
    const Ctx C0 = make_ctx(args, lds_raw);
    run_phase<K>(C0, args.ph_lo);
}
#if MK_N_LAUNCHES == 1 || defined(DBG_HYB)
__global__ void __launch_bounds__(NTHREADS, 2) mk_fwd(Args args) {
    extern __shared__ __attribute__((aligned(16))) unsigned char lds_raw[];
    const Ctx C0 = make_ctx(args, lds_raw);
    if (C0.tid < 4) ((LAS unsigned*)(C0.lds + LDS_BAR_OFF))[C0.tid] = 0u;
    __syncthreads();
    const int lo = args.ph_lo, hi = args.ph_hi;
    XcdBarrier bar; bar.bar = (unsigned*)(args.ws + WS_CTL); bar.x = 0; bar.st = nullptr;
    if (hi - lo > 1) bar = xcd_barrier_post((unsigned*)(args.ws + WS_CTL), (volatile LAS unsigned*)(C0.lds + LDS_BAR_OFF));
#define IN(k) (lo <= (k) && (k) < hi)
#define SEAM(k) do { if (IN(k) && IN((k) + 1)) xcd_barrier(bar); } while (0)
#ifndef DBG_DUP
#define DBG_DUP -1
#endif
#define PH(K, k) do { if (IN(k)) { run_phase<K>(C0, l); if (K == DBG_DUP) { xcd_barrier(bar); run_phase<K>(C0, l); } } SEAM(k); } while (0)
    { const int l = 0; PH(0, 0); }
#pragma unroll 1
    for (int l = 0; l < DEPTH; ++l) {
        const int pb = 1 + 12 * l;
        PH(1, pb + 0); PH(2, pb + 1); PH(3, pb + 2); PH(4, pb + 3); PH(5, pb + 4); PH(6, pb + 5);
        PH(7, pb + 6); PH(8, pb + 7); PH(9, pb + 8); PH(10, pb + 9); PH(11, pb + 10); PH(12, pb + 11);
    }
    { const int l = DEPTH - 1; PH(13, 1 + 12 * DEPTH); }
#undef PH
#undef IN
#undef SEAM
}
#define MAIN_KERNEL mk_fwd
#else
#define MAIN_KERNEL k_one<6>
#endif


#ifdef DBG_PROBE
typedef int i32x8 __attribute__((ext_vector_type(8)));
__device__ __forceinline__ unsigned char fp8_of_int(int v) {
    const float f = (float)v; return (unsigned char)(__builtin_amdgcn_cvt_pk_fp8_f32(f, 0.f, 0, false) & 0xff); }
__global__ void k_probe_mx(unsigned* slot) {
    const int l = threadIdx.x, r = l & 15, g = l >> 4;
    float worst[2] = {0.f, 0.f};
    for (int hyp = 0; hyp < 2; ++hyp) {
        i32x8 A, B;
        for (int j = 0; j < 8; ++j) { unsigned wa = 0, wb = 0;
            for (int b = 0; b < 4; ++b) { const int i = 4 * j + b;
                const int k = hyp == 0 ? g * 32 + i : (i >> 3) * 32 + g * 8 + (i & 7);
                wa |= (unsigned)fp8_of_int(((3 * r + k) % 7) - 3) << (8 * b); wb |= (unsigned)fp8_of_int(((5 * k + 2 * r) % 9) - 4) << (8 * b); }
            A[j] = (int)wa; B[j] = (int)wb; }
        f32x4 c = {0.f, 0.f, 0.f, 0.f};
        c = __builtin_amdgcn_mfma_scale_f32_16x16x128_f8f6f4(A, B, c, 0, 0, 0, 0x7f7f7f7f, 0, 0x7f7f7f7f);
        for (int i = 0; i < 4; ++i) { const int m = 4 * g + i, n = r; float ref = 0.f; for (int k = 0; k < 128; ++k) ref += (float)(((3 * m + k) % 7) - 3) * (float)(((5 * k + 2 * n) % 9) - 4);
            worst[hyp] = fmaxf(worst[hyp], fabsf(c[i] - ref)); }
    }
    for (int o = 32; o >= 1; o >>= 1) { worst[0] = fmaxf(worst[0], __shfl_xor(worst[0], o)); worst[1] = fmaxf(worst[1], __shfl_xor(worst[1], o)); }
    if (l == 0) { const float code = worst[0] == 0.f ? 0.4f : (worst[1] == 0.f ? 0.8f : 1.2f); *slot = __float_as_uint(powf(10.f, code / 0.25f - 4.f)); }
}
#endif
#ifdef DBG_CHECK
__device__ __forceinline__ void dbg_report(unsigned* slot, float err) { if (!(err <= 3e38f)) err = 1e30f; atomicMax(slot, __float_as_uint(err)); }
__global__ void k_check_gemm(const bf16_t* A, int lda, const float* W, int K, int N, const bf16_t* Cm, int ldc, int M, unsigned* slot) {
    const unsigned id = blockIdx.x * blockDim.x + threadIdx.x; if (id >= 8192) return;
    const unsigned h = id * 2654435761u; const int row = (int)((h >> 8) % (unsigned)M), col = (int)((h * 40503u >> 7) % (unsigned)N);
    float ref = 0.f; for (int k = 0; k < K; ++k) ref += bf2f(A[(size_t)row * lda + k]) * W[(size_t)k * N + col];
    const float got = bf2f(Cm[(size_t)row * ldc + col]);
    dbg_report(slot, fabsf(got - ref) / (fabsf(ref) + 0.1f));
}

__global__ void k_check_attn(const unsigned char* ws, int type, unsigned* slot) {
    __shared__ float sc[RPB]; __shared__ float red[256]; __shared__ float qv[192];
    const int t = threadIdx.x, bh = blockIdx.x & 15, b = bh >> 3, h = bh & 7; const int qpos = (int)(((blockIdx.x >> 4) * 977u + 13u) % SEQ); const size_t rq = (size_t)b * RPB + CTXL + qpos, rk = (size_t)b * RPB;
    const bf16_t* P = (const bf16_t*)(ws + WS_P); const bf16_t* MQ = (const bf16_t*)(ws + WS_MQ); const bf16_t* MKV = (const bf16_t*)(ws + WS_MKV);
    const int dq = type ? 128 : 192;
    if (t < dq) { float v = type ? bf2f(P[rq * NP + C_AQ + h * 128 + t]) : bf2f(MQ[rq * 1536 + h * 192 + t]); qv[t] = v; }
    __syncthreads();
    if (!type && t < 32) {
        const int ri = qpos >> 6, ci = qpos & 63; const int i = t; const float pos = (float)(i < 16 ? ri : ci); const float inv = powf(10000.f, -(float)(i & 15) / 16.f); const float a = pos * inv;
        const float x1 = qv[128 + i], x2 = qv[160 + i]; qv[128 + i] = x1 * cosf(a) - x2 * sinf(a); qv[160 + i] = x2 * cosf(a) + x1 * sinf(a); }
    __syncthreads();
    const float scale = type ? 0.088388347648f : 0.0721687836487f;
    float mx = -1e30f;
    for (int k = t; k < RPB; k += 256) { float s = 0.f;
        if (type) { const bf16_t* kp = P + (rk + k) * NP + C_AK + (h >> 2) * 128; for (int d = 0; d < 128; ++d) s += qv[d] * bf2f(kp[d]); }
        else { const bf16_t* kp = MKV + (rk + k) * 2048 + h * 256; for (int d = 0; d < 128; ++d) s += qv[d] * bf2f(kp[d]); const bf16_t* kr = P + (rk + k) * NP + C_MKR; for (int d = 0; d < 64; ++d) s += qv[128 + d] * bf2f(kr[d]); }
        s *= scale; sc[k] = s; mx = fmaxf(mx, s); }
    red[t] = mx; __syncthreads(); for (int o = 128; o >= 1; o >>= 1) { if (t < o) red[t] = fmaxf(red[t], red[t + o]); __syncthreads(); } mx = red[0]; __syncthreads();
    float sum = 0.f; for (int k = t; k < RPB; k += 256) { const float p = __expf(sc[k] - mx); sc[k] = p; sum += p; }
    red[t] = sum; __syncthreads(); for (int o = 128; o >= 1; o >>= 1) { if (t < o) red[t] += red[t + o]; __syncthreads(); } sum = red[0]; __syncthreads();
    float e = 0.f, mag = 0.f;
    if (t < 128) { float o = 0.f; for (int k = 0; k < RPB; ++k) { const float vv = type ? bf2f(P[(rk + k) * NP + C_AV + (h >> 2) * 128 + t]) : bf2f(MKV[(rk + k) * 2048 + h * 256 + 128 + t]); o += sc[k] * vv; }
        o /= sum; const float got = __builtin_amdgcn_cvt_f32_fp8((int)(ws + (type ? WS_OA : WS_OM))[rq * 1024 + h * 128 + t], 0) * (1.0f / 32.0f); e = fabsf(got - o); mag = fabsf(o); }
    red[t] = e; __syncthreads(); for (int o = 128; o >= 1; o >>= 1) { if (t < o) red[t] = fmaxf(red[t], red[t + o]); __syncthreads(); } e = red[0]; __syncthreads();
    red[t] = mag; __syncthreads(); for (int o = 128; o >= 1; o >>= 1) { if (t < o) red[t] = fmaxf(red[t], red[t + o]); __syncthreads(); } mag = red[0];
    if (t == 0) dbg_report(slot, e / (mag + 1e-4f));
}
__global__ void __launch_bounds__(256) k_check_gla_rec(const unsigned char* ws, const float* wa_f, const float* ba_f, const float* wa_b, const float* ba_b, float* obuf, int b) {
    __shared__ float ad[128], kd[128], qd[128], lrs[16];
    const int e = threadIdx.x, h = blockIdx.x & 3, dir = blockIdx.x >> 2; const bf16_t* P = (const bf16_t*)(ws + WS_P);
    const float* wa = dir ? wa_b : wa_f; const float* ba = dir ? ba_b : ba_f;
    float S[128];
#pragma unroll
    for (int d = 0; d < 128; ++d) S[d] = 0.f;
    float* ob = obuf + ((size_t)(dir * 2 + b) * 4 + h) * RPB * 256;
    for (int st = 0; st < RPB; ++st) {
        int j; if (!dir) j = st; else j = st < CTXL ? CTXL - 1 - st : RPB - 1 - (st - CTXL);
        const size_t r = (size_t)b * RPB + j; const bf16_t* pr = P + r * NP;
        if (e < 16) lrs[e] = bf2f(pr[(dir ? C_LRB : C_LRF) + e]);
        __syncthreads();
        if (e < 128) { float pre = ba[h * 128 + e]; for (int q = 0; q < 16; ++q) pre += lrs[q] * wa[q * 512 + h * 128 + e];
            const float ls = (fminf(pre, 0.f) - log1pf(expf(-fabsf(pre)))) / 16.f; ad[e] = expf(ls); kd[e] = bf2f(pr[C_LK + h * 128 + e]); qd[e] = bf2f(pr[C_LQ + h * 128 + e]) * 0.088388347648f; }
        __syncthreads();
        const float v = bf2f(pr[C_LV + h * 256 + e]); float o = 0.f;
#pragma unroll
        for (int d = 0; d < 128; ++d) { S[d] = ad[d] * S[d] + kd[d] * v; o += qd[d] * S[d]; }
        ob[(size_t)j * 256 + e] = o;
        __syncthreads();
    }
}
__global__ void k_check_gla_cmp(const unsigned char* ws, const float* obuf, const float* gon, int b, unsigned* slot) {
    __shared__ float red[256];
    const int e = threadIdx.x, h = blockIdx.x & 3, j = blockIdx.x >> 2; const size_t r = (size_t)b * RPB + j; const bf16_t* P = (const bf16_t*)(ws + WS_P);
    const float o = obuf[((size_t)(0 * 2 + b) * 4 + h) * RPB * 256 + (size_t)j * 256 + e] + obuf[((size_t)(1 * 2 + b) * 4 + h) * RPB * 256 + (size_t)j * 256 + e];
    red[e] = o * o; __syncthreads(); for (int s_ = 128; s_ >= 1; s_ >>= 1) { if (e < s_) red[e] += red[e + s_]; __syncthreads(); }
    const float rs = rsqrtf(red[0] / 256.f + NORM_EPS); __syncthreads();
    const float gt = bf2f(P[r * NP + C_LG + h * 256 + e]); const float ref = o * rs * gon[e] * (gt / (1.f + expf(-gt)));
    const float got = __builtin_amdgcn_cvt_f32_fp8((int)(ws + WS_OL)[r * 1024 + h * 256 + e], 0);
    red[e] = fabsf(got - ref); __syncthreads(); for (int s_ = 128; s_ >= 1; s_ >>= 1) { if (e < s_) red[e] = fmaxf(red[e], red[e + s_]); __syncthreads(); }
    if (e == 0) dbg_report(slot, red[0] / 1.0f);
}

__global__ void k_check_gemm8(const unsigned char* A8, const float* W, int K, int N, const bf16_t* Cm, int ldc, int M, unsigned* slot) {
    const unsigned id = blockIdx.x * blockDim.x + threadIdx.x; if (id >= 8192) return;
    const unsigned h = id * 2654435761u; const int row = (int)((h >> 8) % (unsigned)M), col = (int)((h * 40503u >> 7) % (unsigned)N);
    float ref = 0.f, mag = 0.f; for (int k = 0; k < K; ++k) { const float a = __builtin_amdgcn_cvt_f32_fp8((int)A8[(size_t)row * K + k], 0), w = W[(size_t)k * N + col]; ref += a * w; mag += a * a * w * w; }
    const float got = bf2f(Cm[(size_t)row * ldc + col]);
    dbg_report(slot, fabsf(got - ref) / (sqrtf(mag) + 1e-3f));
}
__global__ void k_check_select(const bf16_t* PQ, const float* k1, const float* k2, const int* PIDX, const float* PG, unsigned* slot) {
    __shared__ float s1[128], s2[128]; __shared__ int cnt; __shared__ float selv[16];
    const int tok = (blockIdx.x >> 3) * 61 + 5, head = blockIdx.x & 7, t = threadIdx.x;
    if (t == 0) cnt = 0;
    for (int n = t; n < 128; n += 64) { float a = 0.f, b = 0.f; for (int d = 0; d < 128; ++d) { a += bf2f(PQ[(size_t)tok * DM + head * 256 + d]) * k1[((size_t)head * 128 + n) * 128 + d]; b += bf2f(PQ[(size_t)tok * DM + head * 256 + 128 + d]) * k2[((size_t)head * 128 + n) * 128 + d]; } s1[n] = a; s2[n] = b; }
    __syncthreads();
    if (t < 16) { const int id = PIDX[(size_t)tok * 128 + head * 16 + t]; selv[t] = (id >= 0 && id < 16384) ? s1[id >> 7] + s2[id & 127] : -1e30f; }
    __syncthreads();
    float thr = selv[0], mx = selv[0]; for (int k = 1; k < 16; ++k) { thr = fminf(thr, selv[k]); mx = fmaxf(mx, selv[k]); }
    int c = 0; for (int p = t; p < 16384; p += 64) if (s1[p >> 7] + s2[p & 127] > thr + 0.02f) ++c;
    atomicAdd(&cnt, c); __syncthreads();
    if (t == 0) { float den = 0.f; for (int k = 0; k < 16; ++k) den += __expf(selv[k] - mx); float e = fabsf((float)cnt - 15.f) / 15.f > 0.34f ? fabsf((float)cnt - 15.f) / 15.f : 0.f;
        for (int k = 0; k < 16; ++k) e = fmaxf(e, fabsf(PG[(size_t)tok * 128 + head * 16 + k] - __expf(selv[k] - mx) / den) * 4.f);
        for (int k = 0; k < 16; ++k) for (int k2_ = 0; k2_ < k; ++k2_) if (PIDX[(size_t)tok * 128 + head * 16 + k] == PIDX[(size_t)tok * 128 + head * 16 + k2_]) e = fmaxf(e, 10.f);
        dbg_report(slot, e); }
}
__global__ void k_check_gather(const bf16_t* HB, const float* u, const float* v, const int* PIDX, const float* PG, const float* dbgo, unsigned* slot) {
    __shared__ float w[128];
    const int tok = blockIdx.x * 64 + 300, t = threadIdx.x;
    for (int k = t; k < 128; k += 64) { const int id = PIDX[(size_t)tok * 128 + k] & 16383; float a = 0.f; for (int d = 0; d < DM; ++d) a += bf2f(HB[(size_t)tok * DM + d]) * u[(size_t)id * DM + d];
        w[k] = PG[(size_t)tok * 128 + k] * 0.5f * a * (1.0f + erff(a * 0.70710678f)); }
    __syncthreads();
    float e = 0.f, sc = 0.f;
    for (int d = t; d < DM; d += 64) { float o = 0.f; for (int k = 0; k < 128; ++k) o += w[k] * v[(size_t)(PIDX[(size_t)tok * 128 + k] & 16383) * DM + d];
        e = fmaxf(e, fabsf(o - dbgo[(size_t)tok * DM + d])); sc = fmaxf(sc, fabsf(o)); }
    for (int o_ = 32; o_ >= 1; o_ >>= 1) { e = fmaxf(e, __shfl_xor(e, o_)); sc = fmaxf(sc, __shfl_xor(sc, o_)); }
    if (t == 0) dbg_report(slot, e / (sc + 1e-6f));
}
__global__ void k_dbg_out2(const float* x, const float* fg, float* out, const unsigned* slot) {
    const float mx = __uint_as_float(*slot); float v = 0.25f * (log10f(fmaxf(mx, 1e-30f)) + 4.0f); v = fminf(fmaxf(v, 0.f), 9.f);
    const float f = 1.0f + v;
    const int lane = threadIdx.x & 63; const size_t r = (size_t)blockIdx.x * 4 + (threadIdx.x >> 6);
    const float* xr = x + r * DM; float ss = 0.f;
    for (int c = lane; c < DM; c += 64) ss += xr[c] * xr[c];
    ss = wave_sum(ss); const float rs = rsqrtf(ss / DM + NORM_EPS);
    for (int c = lane; c < DM; c += 64) out[r * DM + c] = xr[c] * rs * fg[c] * f;
}
#endif
#ifdef DBG_SCAN
__global__ void k_scan16(const bf16_t* p, size_t n, unsigned* flags, int stage) {
    unsigned bad = 0; for (size_t i = (size_t)blockIdx.x * blockDim.x + threadIdx.x; i < n; i += (size_t)gridDim.x * blockDim.x) bad |= ((p[i] & 0x7f80u) == 0x7f80u);
    if (bad) atomicOr(&flags[stage], 1u);
}
__global__ void k_scan32(const float* p, size_t n, unsigned* flags, int stage) {
    unsigned bad = 0; for (size_t i = (size_t)blockIdx.x * blockDim.x + threadIdx.x; i < n; i += (size_t)gridDim.x * blockDim.x) bad |= ((__float_as_uint(p[i]) & 0x7f800000u) == 0x7f800000u);
    if (bad) atomicOr(&flags[stage], 1u);
}
__global__ void k_dbg_out(const float* x, const float* fg, float* out, const unsigned* flags, int nstage) {
    int code = 0; for (int s = nstage; s >= 1; --s) if (flags[s]) code = s;
    const float f = 1.0f + 0.25f * (float)code;
    const int lane = threadIdx.x & 63; const size_t r = (size_t)blockIdx.x * 4 + (threadIdx.x >> 6);
    const float* xr = x + r * DM; float ss = 0.f;
    for (int c = lane; c < DM; c += 64) ss += xr[c] * xr[c];
    ss = wave_sum(ss); const float rs = rsqrtf(ss / DM + NORM_EPS);
    for (int c = lane; c < DM; c += 64) out[r * DM + c] = xr[c] * rs * fg[c] * f;
}
#endif
extern "C" void kernel_launch(void* const* d_in, const int* in_sizes, int n_in, void* d_out, int out_size, void* d_ws, size_t ws_size, hipStream_t stream) {
    static int grid = 0;
    if (grid == 0) {
        if (n_in != 30 || out_size != NBATCH * SEQ * DM || ws_size < WS_END) { fprintf(stderr, "kernel_launch: shape/workspace mismatch: n_in %d out %d ws %zu (need %zu)\n", n_in, out_size, ws_size, (size_t)WS_END); grid = -1; return; }
        int dev = 0, cus = 0, per_cu = 0;
        if (hipGetDevice(&dev) != hipSuccess || hipDeviceGetAttribute(&cus, hipDeviceAttributeMultiprocessorCount, dev) != hipSuccess) { grid = -1; return; }
        bool okattr = hipFuncSetAttribute((const void*)MAIN_KERNEL, hipFuncAttributeMaxDynamicSharedMemorySize, LDS_BYTES) == hipSuccess;
#if MK_N_LAUNCHES != 1
#ifdef DBG_HYB
        okattr = okattr && hipFuncSetAttribute((const void*)mk_fwd, hipFuncAttributeMaxDynamicSharedMemorySize, LDS_BYTES) == hipSuccess;
#endif
#define SETA(K) okattr = okattr && hipFuncSetAttribute((const void*)k_one<K>, hipFuncAttributeMaxDynamicSharedMemorySize, LDS_BYTES) == hipSuccess
        SETA(0); SETA(1); SETA(2); SETA(3); SETA(4); SETA(5); SETA(6); SETA(7); SETA(8); SETA(9); SETA(10); SETA(11); SETA(12); SETA(13);
#undef SETA
#endif
        if (!okattr) { fprintf(stderr, "kernel_launch: hipFuncSetAttribute failed\n"); grid = -1; return; }
        if (hipOccupancyMaxActiveBlocksPerMultiprocessor(&per_cu, (const void*)MAIN_KERNEL, NTHREADS, LDS_BYTES) != hipSuccess || per_cu < 1) { fprintf(stderr, "kernel_launch: occupancy query says %d blocks per CU\n", per_cu); grid = -1; (void)hipGetLastError(); return; }
        grid = cus;
    }
    if (grid < 0) return;
    if (hipMemsetAsync((char*)d_ws + WS_CTL, 0, CTL_BYTES, stream) != hipSuccess) return;
    Args a{};
    for (int i = 0; i < 30; ++i) a.in[i] = (const float*)d_in[i];
    a.out = (float*)d_out; a.ws = (unsigned char*)d_ws;
#if defined(DBG_PROBE)
    { unsigned* flags = (unsigned*)((char*)d_ws + WS_CTL + 32768);
      hipLaunchKernelGGL(k_probe_mx, dim3(1), dim3(64), 0, stream, flags + 100);
      hipLaunchKernelGGL(k_dbg_out2, dim3(NBATCH * SEQ / 4), dim3(256), 0, stream, (const float*)d_in[0], (const float*)d_in[29], (float*)d_out, flags + 100); }
#elif MK_N_LAUNCHES == 1 && defined(DBG_CHECK)
    {
        unsigned* flags = (unsigned*)((char*)d_ws + WS_CTL + 32768); char* W = (char*)d_ws;
        a.ph_lo = 0; a.ph_hi = (DBG_CHECK == 8) ? 3 : (DBG_CHECK >= 5) ? 7 : (DBG_CHECK == 1 ? 11 : (DBG_CHECK == 2 ? 12 : 13));
        hipLaunchKernelGGL(mk_fwd, dim3(grid), dim3(NTHREADS), LDS_BYTES, stream, a);
#if DBG_CHECK == 8
        hipLaunchKernelGGL(k_check_gemm8, dim3(32), dim3(256), 0, stream, (const unsigned char*)(W + WS_HB), (const float*)d_in[I_WIN], DM, IN_COLS, (const bf16_t*)(W + WS_P), NP, TT, flags + 100);
#elif DBG_CHECK == 5 || DBG_CHECK == 6
        hipLaunchKernelGGL(k_check_attn, dim3(16 * 24), dim3(256), 0, stream, (const unsigned char*)d_ws, DBG_CHECK == 5 ? 1 : 0, flags + 100);
#elif DBG_CHECK == 7
        { float* obuf = (float*)(W + WS_MQ);
          hipLaunchKernelGGL(k_check_gla_rec, dim3(8), dim3(256), 0, stream, (const unsigned char*)d_ws, (const float*)d_in[I_WA2F], (const float*)d_in[I_BAF], (const float*)d_in[I_WA2B], (const float*)d_in[I_BAB], obuf, 0);
          hipLaunchKernelGGL(k_check_gla_cmp, dim3(RPB * 4), dim3(256), 0, stream, (const unsigned char*)d_ws, (const float*)obuf, (const float*)d_in[I_ONG], 0, flags + 100); }
#elif DBG_CHECK == 1
        hipLaunchKernelGGL(k_check_gemm, dim3(32), dim3(256), 0, stream, (const bf16_t*)(W + WS_HB), DM, (const float*)d_in[I_PWQ], DM, DM, (const bf16_t*)(W + WS_PQ), DM, TT, flags + 100);
#elif DBG_CHECK == 2
        hipLaunchKernelGGL(k_check_select, dim3(256 * 8), dim3(64), 0, stream, (const bf16_t*)(W + WS_PQ), (const float*)d_in[I_PK1], (const float*)d_in[I_PK2], (const int*)(W + WS_PIDX), (const float*)(W + WS_PG), flags + 100);
#else
        hipLaunchKernelGGL(k_check_gather, dim3(128), dim3(64), 0, stream, (const bf16_t*)(W + WS_HB), (const float*)d_in[I_PU], (const float*)d_in[I_PV], (const int*)(W + WS_PIDX), (const float*)(W + WS_PG), (const float*)(W + WS_MQ), flags + 100);
#endif
        hipLaunchKernelGGL(k_dbg_out2, dim3(NBATCH * SEQ / 4), dim3(256), 0, stream, (const float*)d_in[0], (const float*)d_in[29], (float*)d_out, flags + 100);
    }
#elif MK_N_LAUNCHES == 1
#ifdef DBG_SPLIT
    for (int p = 0; p < N_PHASES; p += DBG_SPLIT) { a.ph_lo = p; a.ph_hi = p + DBG_SPLIT < N_PHASES ? p + DBG_SPLIT : N_PHASES; hipLaunchKernelGGL(mk_fwd, dim3(grid), dim3(NTHREADS), LDS_BYTES, stream, a); }
#else
    a.ph_lo = 0; a.ph_hi = N_PHASES;
    hipLaunchKernelGGL(mk_fwd, dim3(grid), dim3(NTHREADS), LDS_BYTES, stream, a);
#endif
#else
    a.ph_hi = 0;
#ifndef DBG_NLAUNCH
#define DBG_NLAUNCH 100
#endif
    int nl_ = 0;
#ifdef DBG_HYB
#define LAUNCH1(K, L) do { if (K == DBG_HYB) { a.ph_lo = 12 * (L) + (K); a.ph_hi = a.ph_lo + 1; hipLaunchKernelGGL(mk_fwd, dim3(grid), dim3(NTHREADS), LDS_BYTES, stream, a); a.ph_hi = 0; } else { a.ph_lo = (L); hipLaunchKernelGGL(k_one<K>, dim3(grid), dim3(NTHREADS), LDS_BYTES, stream, a); } } while (0)
#else
#define LAUNCH1(K, L) do { a.ph_lo = (L); if (nl_++ < DBG_NLAUNCH) { hipLaunchKernelGGL(k_one<K>, dim3(grid), dim3(NTHREADS), LDS_BYTES, stream, a); if (K == DBG_DUP) hipLaunchKernelGGL(k_one<K>, dim3(grid), dim3(NTHREADS), LDS_BYTES, stream, a); } } while (0)
#endif
#ifdef DBG_SCAN
    unsigned* flags = (unsigned*)((char*)d_ws + WS_CTL + 32768);
    char* W = (char*)d_ws;
#define S16(off, n, st) hipLaunchKernelGGL(k_scan16, dim3(1024), dim3(256), 0, stream, (const bf16_t*)(W + (off)), (size_t)(n), flags, st)
#define S32(off, n, st) hipLaunchKernelGGL(k_scan32, dim3(1024), dim3(256), 0, stream, (const float*)(W + (off)), (size_t)(n), flags, st)
    LAUNCH1(0, 0); S32(WS_MODV, 2 * 3 * 12288, 1);
    { const int l = 0;
      LAUNCH1(1, l); S16(WS_HB, (size_t)TT * DM, 2);
      LAUNCH1(2, l); S16(WS_P, (size_t)TT * NP, 3);
      LAUNCH1(3, l); S16(WS_P, (size_t)TT * NP, 4);
      LAUNCH1(4, l); S16(WS_MQ, (size_t)TT * 1536, 5); S16(WS_MKV, (size_t)TT * 2048, 5); S16(WS_GST, (size_t)2112 * 32768, 6); S32(WS_GDEC, (size_t)2112 * 128, 6);
      LAUNCH1(5, l); S16(WS_GST, (size_t)2112 * 32768, 7);
      LAUNCH1(6, l); S16(WS_OA, (size_t)TT * 1024, 8); S16(WS_OM, (size_t)TT * 1024, 9); S16(WS_OL, (size_t)TT * 1024, 10);
      LAUNCH1(7, l); S16(WS_Y, (size_t)TT * DM, 11);
      LAUNCH1(8, l); S32(WS_XS, (size_t)TT * DM, 12);
      LAUNCH1(9, l); S16(WS_HB, (size_t)TT * DM, 13);
      LAUNCH1(10, l); S16(WS_PQ, (size_t)TT * DM, 14);
      LAUNCH1(11, l); S32(WS_PG, (size_t)TT * 128, 15);
      LAUNCH1(12, l); S32(WS_XS, (size_t)TT * DM, 16);
    }
    hipLaunchKernelGGL(k_dbg_out, dim3(NBATCH * SEQ / 4), dim3(256), 0, stream, (const float*)d_in[0], (const float*)d_in[29], (float*)d_out, flags, 16);
#elif defined(DBG_CHECK)
    unsigned* flags = (unsigned*)((char*)d_ws + WS_CTL + 32768);
    char* W = (char*)d_ws;
    LAUNCH1(0, 0);
    { const int l = 0; LAUNCH1(1, l); LAUNCH1(2, l); LAUNCH1(3, l); LAUNCH1(4, l); LAUNCH1(5, l); LAUNCH1(6, l);
#if DBG_CHECK == 5 || DBG_CHECK == 6
      hipLaunchKernelGGL(k_check_attn, dim3(16 * 24), dim3(256), 0, stream, (const unsigned char*)d_ws, DBG_CHECK == 5 ? 1 : 0, flags + 100);
#endif
#if DBG_CHECK == 7
      { float* obuf = (float*)(W + WS_MQ);
        hipLaunchKernelGGL(k_check_gla_rec, dim3(8), dim3(256), 0, stream, (const unsigned char*)d_ws, (const float*)d_in[I_WA2F], (const float*)d_in[I_BAF], (const float*)d_in[I_WA2B], (const float*)d_in[I_BAB], obuf, 0);
        hipLaunchKernelGGL(k_check_gla_cmp, dim3(RPB * 4), dim3(256), 0, stream, (const unsigned char*)d_ws, (const float*)obuf, (const float*)d_in[I_ONG], 0, flags + 100); }
#endif
      LAUNCH1(7, l); LAUNCH1(8, l); LAUNCH1(9, l); LAUNCH1(10, l);
#if DBG_CHECK == 1
      hipLaunchKernelGGL(k_check_gemm, dim3(32), dim3(256), 0, stream, (const bf16_t*)(W + WS_HB), DM, (const float*)d_in[I_PWQ], DM, DM, (const bf16_t*)(W + WS_PQ), DM, TT, flags + 100);
#endif
      LAUNCH1(11, l);
#if DBG_CHECK == 2
      hipLaunchKernelGGL(k_check_select, dim3(256 * 8), dim3(64), 0, stream, (const bf16_t*)(W + WS_PQ), (const float*)d_in[I_PK1], (const float*)d_in[I_PK2], (const int*)(W + WS_PIDX), (const float*)(W + WS_PG), flags + 100);
#endif
      LAUNCH1(12, l);
#if DBG_CHECK == 3
      hipLaunchKernelGGL(k_check_gather, dim3(128), dim3(64), 0, stream, (const bf16_t*)(W + WS_HB), (const float*)d_in[I_PU], (const float*)d_in[I_PV], (const int*)(W + WS_PIDX), (const float*)(W + WS_PG), (const float*)(W + WS_MQ), flags + 100);
#endif
    }
    hipLaunchKernelGGL(k_dbg_out2, dim3(NBATCH * SEQ / 4), dim3(256), 0, stream, (const float*)d_in[0], (const float*)d_in[29], (float*)d_out, flags + 100);
#else
    LAUNCH1(0, 0);
    for (int l = 0; l < DEPTH; ++l) { LAUNCH1(1, l); LAUNCH1(2, l); LAUNCH1(3, l);
#ifdef DBG_DUP23
        LAUNCH1(2, l); LAUNCH1(3, l);
#endif
        LAUNCH1(4, l); LAUNCH1(5, l);
#ifdef DBG_DUP45
        LAUNCH1(4, l); LAUNCH1(5, l);
#endif
        LAUNCH1(6, l); LAUNCH1(7, l); LAUNCH1(8, l); LAUNCH1(9, l); LAUNCH1(10, l); LAUNCH1(11, l); LAUNCH1(12, l); }
    LAUNCH1(13, DEPTH - 1);
#endif
#undef LAUNCH1
#endif
    const hipError_t le = hipPeekAtLastError();
    if (le != hipSuccess) fprintf(stderr, "kernel_launch: launch failed: %s\n", hipGetErrorName(le));
}
```

```cpp
#include <hip/hip_runtime.h>
#include <cstdio>
#include <cstdint>

#ifndef MK_N_LAUNCHES
#ifndef DBG_DUP
#define DBG_DUP -1
#endif
#define MK_N_LAUNCHES 1
#endif

#ifndef DBG_MIX0
#define DBG_MIX0 1.0f
#define DBG_MIX1 1.0f
#define DBG_PEER0 1.0f
#define DBG_PEER1 1.0f
#endif
#ifndef MLA_NQR
#define MLA_NQR 4
#endif
#define LAS __attribute__((address_space(3)))
#define GLB __attribute__((address_space(1)))
typedef unsigned short bf16_t;
typedef short bf16x8 __attribute__((ext_vector_type(8)));
typedef short s16x4 __attribute__((ext_vector_type(4)));
typedef float f32x4 __attribute__((ext_vector_type(4)));
typedef float f32x2 __attribute__((ext_vector_type(2)));
typedef float f32x16 __attribute__((ext_vector_type(16)));
typedef unsigned u32x4 __attribute__((ext_vector_type(4)));
typedef unsigned u32x2 __attribute__((ext_vector_type(2)));
typedef __bf16 bf2_t __attribute__((ext_vector_type(2)));

constexpr int DM = 2048, NBATCH = 2, SEQ = 8192, CTXL = 256, DEPTH = 2;
constexpr int RPB = SEQ + CTXL;
constexpr int TT = NBATCH * RPB;
constexpr int IN_COLS = 11872, NP = 12032;
constexpr int C_AQ = 0, C_AK = 1024, C_AV = 1280, C_LQ = 1536, C_LK = 2048, C_LV = 2560, C_LG = 3584, C_LRF = 4608, C_LRB = 4624,
              C_MCQ = 4640, C_MCKV = 5152, C_MKR = 5664, C_GA = 5728, C_GL = 7776, C_GM = 9824;
constexpr int NCH = RPB / 64;
constexpr int NEXP = 16384;
constexpr float NORM_EPS = 1e-6f;
constexpr int NTHREADS = 512;

constexpr size_t al256(size_t x) { return (x + 255) / 256 * 256; }
constexpr size_t WS_CTL   = 0;
constexpr size_t CTL_BYTES = 65536;
constexpr size_t WS_MODV  = WS_CTL + CTL_BYTES;
constexpr size_t WS_TABA  = al256(WS_MODV + (size_t)2 * 3 * 12288 * 4);
constexpr size_t WS_TABM  = WS_TABA + 2 * 128 * 32 * 4;
constexpr size_t WS_XS    = al256(WS_TABM + 2 * 128 * 16 * 4);
constexpr size_t WS_HB    = WS_XS + (size_t)TT * DM * 4;
constexpr size_t WS_P     = WS_HB + (size_t)TT * DM * 2;
constexpr size_t WS_MQ    = WS_P + (size_t)TT * NP * 2;
constexpr size_t WS_MKV   = WS_MQ + (size_t)TT * 1536 * 2;
constexpr size_t WS_OA    = WS_MKV + (size_t)TT * 2048 * 2;
constexpr size_t WS_OL    = WS_OA + (size_t)TT * 1024 * 2;
constexpr size_t WS_OM    = WS_OL + (size_t)TT * 1024 * 2;
constexpr size_t WS_WIN   = WS_OM + (size_t)TT * 1024 * 2;
constexpr size_t WS_WUQ   = WS_WIN + (size_t)NP * 2048 * 2;
constexpr size_t WS_WUKV  = WS_WUQ + (size_t)1536 * 512 * 2;
constexpr size_t WS_WBR   = WS_WUKV + (size_t)2048 * 512 * 2;
constexpr size_t WS_WOUT  = WS_WBR + (size_t)3 * 2048 * 1024 * 2;
constexpr size_t WS_WQ    = WS_WOUT + (size_t)2048 * 2048 * 2;
constexpr size_t WS_K1    = WS_WQ + (size_t)2048 * 2048 * 2;
constexpr size_t WS_K2    = WS_K1 + (size_t)8 * 128 * 128 * 2;
constexpr size_t WS_GST   = WS_K2 + (size_t)8 * 128 * 128 * 2;
constexpr size_t WS_GDEC  = WS_GST + (size_t)NBATCH * 2 * 4 * NCH * 32768 * 2;
constexpr size_t WS_END0  = WS_GDEC + (size_t)NBATCH * 2 * 4 * NCH * 128 * 4;
constexpr size_t WS_KN8   = WS_OA + (size_t)TT * 1024;
constexpr size_t WS_AK8   = WS_OL + (size_t)TT * 1024;
constexpr size_t WS_KR8   = WS_AK8 + (size_t)TT * 256;
constexpr size_t WS_Y     = WS_MKV;
constexpr size_t WS_PQ    = WS_OA;
constexpr size_t WS_PIDX  = WS_P;
constexpr size_t WS_PG    = WS_PIDX + (size_t)TT * 128 * 4;
constexpr size_t PT_BYTES = 2 * (size_t)NEXP * DM + 2 * (size_t)NEXP * 4;
constexpr size_t WS_WINS  = WS_END0;
constexpr size_t WS_WOUTS = al256(WS_WINS + (size_t)NP * 4);
constexpr size_t WS_WBRS  = al256(WS_WOUTS + (size_t)DM * 4);
constexpr size_t WS_PT    = al256(WS_WBRS + (size_t)3 * DM * 4);
constexpr size_t WS_END   = WS_PT + DEPTH * PT_BYTES;
constexpr size_t PT_U8 = 0, PT_V8 = (size_t)NEXP * DM, PT_SCU = 2 * (size_t)NEXP * DM, PT_SCV = PT_SCU + (size_t)NEXP * 4;
static_assert(WS_PG + (size_t)TT * 128 * 4 <= WS_MQ, "PEER alias region overflows P");

__device__ __forceinline__ unsigned cvt_pk_bf16(float lo, float hi) { bf2_t v; v.x = (__bf16)lo; v.y = (__bf16)hi; return __builtin_bit_cast(unsigned, v); }
__device__ __forceinline__ bf16_t f2bf(float f) { return (bf16_t)(cvt_pk_bf16(f, 0.f) & 0xffffu); }
__device__ __forceinline__ float bf2f(bf16_t b) { return __uint_as_float(((unsigned)b) << 16); }
__device__ __forceinline__ float bflo(unsigned w) { return __uint_as_float(w << 16); }
__device__ __forceinline__ float bfhi(unsigned w) { return __uint_as_float(w & 0xffff0000u); }
__device__ __forceinline__ float xchg32(float x, int lane) { auto r = __builtin_amdgcn_permlane32_swap(__float_as_uint(x), __float_as_uint(x), false, false); return __uint_as_float(lane < 32 ? r[1] : r[0]); }
__device__ __forceinline__ float xchg16(float x, int lane) { auto r = __builtin_amdgcn_permlane16_swap(__float_as_uint(x), __float_as_uint(x), false, false); return __uint_as_float((lane & 16) ? r[0] : r[1]); }
template <int CTRL> __device__ __forceinline__ float dppmov(float x) { return __uint_as_float(__builtin_amdgcn_update_dpp(0u, __float_as_uint(x), CTRL, 0xF, 0xF, false)); }
constexpr int DPP_ROR8 = 0x128, DPP_HMIRROR = 0x141, DPP_Q3210 = 0x1B, DPP_Q1032 = 0xB1;
__device__ __forceinline__ float wave_sum(float v) {
    const int lane = threadIdx.x & 63;
    v += xchg32(v, lane); v += xchg16(v, lane); v += dppmov<DPP_ROR8>(v); v += dppmov<DPP_HMIRROR>(v); v += dppmov<DPP_Q3210>(v); v += dppmov<DPP_Q1032>(v);
    return v;
}
__device__ __forceinline__ float sigmoidf_(float x) { return __builtin_amdgcn_rcpf(1.0f + __expf(-x)); }
__device__ __forceinline__ float siluf_(float x) { return x * __builtin_amdgcn_rcpf(1.0f + __expf(-x)); }

#define XB_TMO      128
#define XB_XCNT(j)  (256  + 64 * (j))
#define XB_XSUB(j)  (1280 + 64 * (j))
#define XB_XGEN(j)  (2304 + 64 * (j))
#define XB_TOP      3328
#define XB_TOPGEN   3392
#define XCD_BAR_WORDS 3456
#define XB_SPIN_CAP (1u << 20)
__device__ __forceinline__ unsigned xb_ld(unsigned* p)              { return __hip_atomic_load(p, __ATOMIC_RELAXED, __HIP_MEMORY_SCOPE_AGENT); }
__device__ __forceinline__ unsigned xb_add(unsigned* p, unsigned v) { return __hip_atomic_fetch_add(p, v, __ATOMIC_RELAXED, __HIP_MEMORY_SCOPE_AGENT); }
__device__ __forceinline__ unsigned xb_xcc_id() { return (unsigned)__builtin_amdgcn_s_getreg((3 << 11) | 20) & 0xFu; }
#define XB_SPIN(cond, bar) do { unsigned _sp = 0; while (cond) { __builtin_amdgcn_s_sleep(1); \
    if ((++_sp & 255u) == 0u) { if (xb_ld(&(bar)[XB_TMO])) break; if (_sp > XB_SPIN_CAP) { atomicAdd(&(bar)[XB_TMO], 1u); break; } } } } while (0)
struct XcdBarrier { unsigned* bar; unsigned x; volatile LAS unsigned* st; };
__device__ __forceinline__ XcdBarrier xcd_barrier_post(unsigned* bar, volatile LAS unsigned* st) {
    XcdBarrier b; b.bar = bar; b.x = xb_xcc_id(); b.st = st;
    if (threadIdx.x == 0) (void)xb_add(&bar[XB_XCNT(b.x)], 1u);
    return b;
}
__device__ __forceinline__ void xcd_barrier_complete(unsigned* bar, unsigned x, unsigned& nloc, unsigned& nx) {
    const unsigned G = gridDim.x * gridDim.y * gridDim.z;
    unsigned sum, cnt, mine, sp = 0u;
    for (;;) {
        sum = 0u; cnt = 0u; mine = 0u;
#pragma unroll
        for (unsigned j = 0; j < 16; ++j) { const unsigned c = xb_ld(&bar[XB_XCNT(j)]); sum += c; cnt += (c > 0u) ? 1u : 0u; mine = (j == x) ? c : mine; }
        if (sum == G) break;
        __builtin_amdgcn_s_sleep(1);
        if ((++sp & 255u) == 0u) { if (xb_ld(&bar[XB_TMO])) break; if (sp > XB_SPIN_CAP) { atomicAdd(&bar[XB_TMO], 1u); break; } }
    }
    nloc = mine > 0u ? mine : 1u; nx = cnt > 0u ? cnt : 1u;
}
__device__ __forceinline__ void xcd_barrier(const XcdBarrier& b) {
    asm volatile("s_waitcnt vmcnt(0)" ::: "memory");
    __syncthreads();
    if (threadIdx.x == 0) {
        unsigned* bar = b.bar;
        __builtin_amdgcn_s_waitcnt(0);
        unsigned nloc = b.st[0], nx = b.st[1];
        if (nloc == 0u) { xcd_barrier_complete(bar, b.x, nloc, nx); b.st[0] = nloc; b.st[1] = nx; }
        const unsigned old = xb_add(&bar[XB_XSUB(b.x)], 1u);
        const unsigned gen = old / nloc;
        if (old + 1u == (gen + 1u) * nloc) {
            __builtin_amdgcn_fence(__ATOMIC_RELEASE, "agent");
            asm volatile("s_waitcnt vmcnt(0)" ::: "memory");
            const unsigned og = xb_add(&bar[XB_TOP], 1u);
            const unsigned tg = og / nx;
            if (og + 1u == (tg + 1u) * nx) xb_add(&bar[XB_TOPGEN], 1u);
            else XB_SPIN(xb_ld(&bar[XB_TOPGEN]) == tg, bar);
            __builtin_amdgcn_fence(__ATOMIC_ACQUIRE, "agent");
            xb_add(&bar[XB_XGEN(b.x)], 1u);
            asm volatile("s_waitcnt vmcnt(0)" ::: "memory");
        } else {
            XB_SPIN(xb_ld(&bar[XB_XGEN(b.x)]) == gen, bar);
            __builtin_amdgcn_fence(__ATOMIC_ACQUIRE, "agent");
            asm volatile("s_waitcnt vmcnt(0)" ::: "memory");
        }
    }
    __syncthreads();
}

namespace pg8 {
constexpr int BM = 256, BK = 64, HALF = 128, HTB = HALF * BK * 2, STAGE_BYTES = 8 * HTB, NXCD = 8, WGM = 8;
__host__ __device__ __forceinline__ int lds_byte(int r, int c) { const int st = (r >> 4) * 2 + (c >> 5), rr = r & 15, cc = c & 31, ob = rr * 64 + cc * 2; return st * 1024 + (ob ^ (((ob >> 9) & 1) << 5)); }
__host__ __device__ __forceinline__ void stage_rc(int b, int& R, int& C) { const int st = b / 1024, sb = b % 1024, swz = sb ^ (((sb >> 9) & 1) << 5); R = (st >> 1) * 16 + swz / 64; C = (st & 1) * 32 + (swz % 64) / 2; }
__host__ __device__ __forceinline__ int perm32(int rho) { const int n = rho >> 4, i = rho & 15; return 8 * (i >> 2) + 4 * n + (i & 3); }
struct Unit { int pm, pn; };
struct Gemm { const bf16_t* A; const bf16_t* Bt; int M, N, K, lda, ldb; };
struct StaticOrder {
    int nM, nN, nwg, G, c, latent;
    __host__ __device__ void init(int M, int N, int G_, int c_, int latent_ = 0) { latent = latent_; nM = latent_ ? 64 : M / BM; nN = N / BM; nwg = nM * nN; G = G_; c = c_; }
    __host__ __device__ bool next(int i, Unit& u) const {
        const long L = (long)i * G + c; if (L >= nwg) return false;
        int wgid = (int)L; { const int q = nwg / NXCD, r = nwg % NXCD, xcd = wgid % NXCD, off = wgid / NXCD; wgid = (xcd < r ? xcd * (q + 1) : r * (q + 1) + (xcd - r) * q) + off; }
        const int nig = WGM * nN, gid = wgid / nig, fm = gid * WGM, gsz = (nM - fm) < WGM ? (nM - fm) : WGM;
        u.pm = fm + ((wgid % nig) % gsz); u.pn = (wgid % nig) / gsz; if (latent) u.pm += 1 + (u.pm >= 32 ? 1 : 0); return true;
    }
};
struct WinOrder {
    StaticOrder S; int full, nlat, G, c;
    __host__ __device__ void init(int G_, int c_, int full_) { full = full_; G = G_; c = c_; S.init(TT, NP, G_, c_, full_ ? 0 : 1); nlat = S.nwg; }
    __host__ __device__ bool next(int i, Unit& u) const {
        if (full) return S.next(i, u);
        const long L = (long)i * G + c;
        if (L < nlat) return S.next(i, u);
        const int q = (int)(L - nlat); if (q >= 24) return false;
        const int t = q % 12; u.pm = q < 12 ? 0 : 33;
        u.pn = t < 2 ? 4 + t : (t < 8 ? 8 + (t - 2) : (t == 8 ? 18 : 20 + (t - 9)));
        return true;
    }
};
struct EpiStoreBf16 {
    static constexpr bool PERM = true;
    bf16_t* O; int ldc;
    __device__ __forceinline__ void operator()(const f32x4 (&acc)[2][2][4][2], const Unit& u, int wr, int wc, int fr, int fq) const {
        const int row0 = u.pm * BM + wr * 64 + fr, col0 = u.pn * BM + wc * 32 + 8 * fq;
#pragma unroll
        for (int ai = 0; ai < 2; ++ai)
#pragma unroll
            for (int m = 0; m < 4; ++m) { bf16_t* rowp = O + (size_t)(row0 + ai * HALF + m * 16) * ldc + col0;
#pragma unroll
                for (int bj = 0; bj < 2; ++bj) { const f32x4 v0 = acc[ai][bj][m][0], v1 = acc[ai][bj][m][1];
                    u32x4 w; w.x = cvt_pk_bf16(v0[0], v0[1]); w.y = cvt_pk_bf16(v0[2], v0[3]); w.z = cvt_pk_bf16(v1[0], v1[1]); w.w = cvt_pk_bf16(v1[2], v1[3]);
                    *(u32x4*)(rowp + bj * HALF) = w; } }
    }
};
struct EpiNull {
    static constexpr bool PERM = true;
    __device__ __forceinline__ void operator()(const f32x4 (&acc)[2][2][4][2], const Unit&, int, int, int, int) const {
#pragma unroll
        for (int a = 0; a < 2; ++a)
#pragma unroll
            for (int b = 0; b < 2; ++b)
#pragma unroll
                for (int m = 0; m < 4; ++m)
#pragma unroll
                    for (int n = 0; n < 2; ++n) asm volatile("" :: "v"(acc[a][b][m][n]));
    }
};
struct EpiStoreMKV {
    static constexpr bool PERM = true;
    bf16_t* O; unsigned char* K8;
    __device__ __forceinline__ void operator()(const f32x4 (&acc)[2][2][4][2], const Unit& u, int wr, int wc, int fr, int fq) const {
        const int row0 = u.pm * BM + wr * 64 + fr, col0 = u.pn * BM + wc * 32 + 8 * fq;
#pragma unroll
        for (int ai = 0; ai < 2; ++ai)
#pragma unroll
            for (int m = 0; m < 4; ++m) { const size_t r = (size_t)(row0 + ai * HALF + m * 16); bf16_t* rowp = O + r * 2048 + col0;
#pragma unroll
                for (int bj = 0; bj < 2; ++bj) { const f32x4 v0 = acc[ai][bj][m][0], v1 = acc[ai][bj][m][1];
                    u32x4 w; w.x = cvt_pk_bf16(v0[0], v0[1]); w.y = cvt_pk_bf16(v0[2], v0[3]); w.z = cvt_pk_bf16(v1[0], v1[1]); w.w = cvt_pk_bf16(v1[2], v1[3]);
                    *(u32x4*)(rowp + bj * HALF) = w;
                    if (bj == 0) { int p0 = __builtin_amdgcn_cvt_pk_fp8_f32(v0[0], v0[1], 0, false); p0 = __builtin_amdgcn_cvt_pk_fp8_f32(v0[2], v0[3], p0, true);
                        int p1 = __builtin_amdgcn_cvt_pk_fp8_f32(v1[0], v1[1], 0, false); p1 = __builtin_amdgcn_cvt_pk_fp8_f32(v1[2], v1[3], p1, true);
                        u32x2 w8; w8.x = (unsigned)p0; w8.y = (unsigned)p1; *(u32x2*)(K8 + r * 1024 + u.pn * 128 + wc * 32 + 8 * fq) = w8; } } }
    }
};
struct EpiStoreBf16S {
    static constexpr bool PERM = true;
    bf16_t* O; int ldc; const float* cs;
    __device__ __forceinline__ void operator()(const f32x4 (&acc)[2][2][4][2], const Unit& u, int wr, int wc, int fr, int fq) const {
        const int row0 = u.pm * BM + wr * 64 + fr, col0 = u.pn * BM + wc * 32 + 8 * fq;
        f32x4 sv[2][2];
#pragma unroll
        for (int bj = 0; bj < 2; ++bj)
#pragma unroll
            for (int n = 0; n < 2; ++n) sv[bj][n] = *(const f32x4*)(cs + col0 + bj * HALF + 4 * n);
#pragma unroll
        for (int ai = 0; ai < 2; ++ai)
#pragma unroll
            for (int m = 0; m < 4; ++m) { bf16_t* rowp = O + (size_t)(row0 + ai * HALF + m * 16) * ldc + col0;
#pragma unroll
                for (int bj = 0; bj < 2; ++bj) { const f32x4 v0 = acc[ai][bj][m][0] * sv[bj][0], v1 = acc[ai][bj][m][1] * sv[bj][1];
                    u32x4 w; w.x = cvt_pk_bf16(v0[0], v0[1]); w.y = cvt_pk_bf16(v0[2], v0[3]); w.z = cvt_pk_bf16(v1[0], v1[1]); w.w = cvt_pk_bf16(v1[2], v1[3]);
                    *(u32x4*)(rowp + bj * HALF) = w; } }
    }
};
template <bool FIRST, bool F8OUT = false> struct EpiGate {
    static constexpr bool PERM = true;
    bf16_t* Y; const bf16_t* Gt; unsigned char* Y8; const float* cs;
    __device__ __forceinline__ void operator()(const f32x4 (&acc)[2][2][4][2], const Unit& u, int wr, int wc, int fr, int fq) const {
        constexpr int ldy = DM, ldg = NP, ldy8 = DM;
        const int row0 = u.pm * BM + wr * 64 + fr, col0 = u.pn * BM + wc * 32 + 8 * fq;
        f32x4 sv[2][2];
#pragma unroll
        for (int bj = 0; bj < 2; ++bj)
#pragma unroll
            for (int n = 0; n < 2; ++n) sv[bj][n] = *(const f32x4*)(cs + col0 + bj * HALF + 4 * n);
#pragma unroll
        for (int ai = 0; ai < 2; ++ai)
#pragma unroll
        for (int mh = 0; mh < 2; ++mh) {
            u32x4 g[2][2], y[2][2];
#pragma unroll
            for (int mm = 0; mm < 2; ++mm)
#pragma unroll
                for (int bj = 0; bj < 2; ++bj) { const size_t r = (size_t)(row0 + ai * HALF + (mh * 2 + mm) * 16);
                    g[mm][bj] = *(const u32x4*)(Gt + r * ldg + col0 + bj * HALF);
                    if (!FIRST) y[mm][bj] = *(const u32x4*)(Y + r * ldy + col0 + bj * HALF); }
#pragma unroll
            for (int mm = 0; mm < 2; ++mm)
#pragma unroll
                for (int bj = 0; bj < 2; ++bj) { const int m = mh * 2 + mm; const size_t r = (size_t)(row0 + ai * HALF + m * 16); const f32x4 v0 = acc[ai][bj][m][0] * sv[bj][0], v1 = acc[ai][bj][m][1] * sv[bj][1]; const u32x4 gg = g[mm][bj];
                    float o[8];
                    o[0] = sigmoidf_(bflo(gg.x)) * v0[0]; o[1] = sigmoidf_(bfhi(gg.x)) * v0[1]; o[2] = sigmoidf_(bflo(gg.y)) * v0[2]; o[3] = sigmoidf_(bfhi(gg.y)) * v0[3];
                    o[4] = sigmoidf_(bflo(gg.z)) * v1[0]; o[5] = sigmoidf_(bfhi(gg.z)) * v1[1]; o[6] = sigmoidf_(bflo(gg.w)) * v1[2]; o[7] = sigmoidf_(bfhi(gg.w)) * v1[3];
                    if (!FIRST) { const u32x4 yy = y[mm][bj];
                        o[0] += bflo(yy.x); o[1] += bfhi(yy.x); o[2] += bflo(yy.y); o[3] += bfhi(yy.y); o[4] += bflo(yy.z); o[5] += bfhi(yy.z); o[6] += bflo(yy.w); o[7] += bfhi(yy.w); }
                    if constexpr (F8OUT) { int p0 = __builtin_amdgcn_cvt_pk_fp8_f32(o[0], o[1], 0, false); p0 = __builtin_amdgcn_cvt_pk_fp8_f32(o[2], o[3], p0, true);
                        int p1 = __builtin_amdgcn_cvt_pk_fp8_f32(o[4], o[5], 0, false); p1 = __builtin_amdgcn_cvt_pk_fp8_f32(o[6], o[7], p1, true);
                        u32x2 w8; w8.x = (unsigned)p0; w8.y = (unsigned)p1; *(u32x2*)(Y8 + r * ldy8 + col0 + bj * HALF) = w8; }
                    else { u32x4 w; w.x = cvt_pk_bf16(o[0], o[1]); w.y = cvt_pk_bf16(o[2], o[3]); w.z = cvt_pk_bf16(o[4], o[5]); w.w = cvt_pk_bf16(o[6], o[7]);
                        *(u32x4*)(Y + r * ldy + col0 + bj * HALF) = w; } }
        }
    }
};
template <bool CS> struct EpiResidT {
    static constexpr bool PERM = false;
    float* X; int ldx; const float* gate; const float* cs;
    __device__ __forceinline__ void operator()(const f32x4 (&acc)[2][2][4][2], const Unit& u, int wr, int wc, int fr, int fq) const {
        const int row0 = u.pm * BM + wr * 64 + fr, col0 = u.pn * BM + wc * 32 + 4 * fq;
        const int sel = (u.pm % 33 == 0) ? 2 : (u.pm / 33);
        const float* gp = gate + (size_t)sel * 12288 + col0;
        f32x4 gv[2][2];
#pragma unroll
        for (int bj = 0; bj < 2; ++bj)
#pragma unroll
            for (int n = 0; n < 2; ++n) { gv[bj][n] = *(const f32x4*)(gp + bj * HALF + n * 16); if constexpr (CS) gv[bj][n] = gv[bj][n] * *(const f32x4*)(cs + col0 + bj * HALF + n * 16); }
#pragma unroll
        for (int ai = 0; ai < 2; ++ai)
#pragma unroll
            for (int mh = 0; mh < 2; ++mh) {
                f32x4 x[2][2][2];
#pragma unroll
                for (int mm = 0; mm < 2; ++mm)
#pragma unroll
                    for (int bj = 0; bj < 2; ++bj)
#pragma unroll
                        for (int n = 0; n < 2; ++n) x[mm][bj][n] = *(const f32x4*)(X + (size_t)(row0 + ai * HALF + (mh * 2 + mm) * 16) * ldx + col0 + bj * HALF + n * 16);
#pragma unroll
                for (int mm = 0; mm < 2; ++mm)
#pragma unroll
                    for (int bj = 0; bj < 2; ++bj)
#pragma unroll
                        for (int n = 0; n < 2; ++n) *(f32x4*)(X + (size_t)(row0 + ai * HALF + (mh * 2 + mm) * 16) * ldx + col0 + bj * HALF + n * 16) = x[mm][bj][n] + gv[bj][n] * acc[ai][bj][mh * 2 + mm][n];
            }
    }
};

typedef int i32x8 __attribute__((ext_vector_type(8)));
typedef int i32x4 __attribute__((ext_vector_type(4)));
__device__ __forceinline__ i32x8 cat8(const bf16x8 lo, const bf16x8 hi) { const i32x4 a = __builtin_bit_cast(i32x4, lo), b = __builtin_bit_cast(i32x4, hi); return __builtin_shufflevector(a, b, 0, 1, 2, 3, 4, 5, 6, 7); }
template <class Epi, class Sched, int F8 = 0>
__device__ __forceinline__ void gemm_phase(LAS unsigned char* lds, const int tid, const Gemm g, const Sched& S, const Epi& E) {
    const int wid = __builtin_amdgcn_readfirstlane(tid >> 6), lane = tid & 63, wr = wid >> 2, wc = wid & 3, fr = lane & 15, fq = lane >> 4;
    const int K = g.K, nt = F8 ? K / 128 : K / BK, lda = g.lda, ldb = g.ldb;
    unsigned voffA[2], voffB[2];
#pragma unroll
    for (int i = 0; i < 2; ++i) { int R, C; stage_rc(tid * 16 + i * 8192, R, C); const int Rb = Epi::PERM ? ((R & ~31) + perm32(R & 31)) : R;
        voffA[i] = F8 ? (unsigned)(R * lda + C * 2) : (unsigned)(R * lda + C) * 2u; voffB[i] = F8 ? (unsigned)(Rb * ldb + C * 2) : (unsigned)(Rb * ldb + C) * 2u; }
    const size_t kstep = (size_t)(BK * 2);
    const size_t hstepA = (size_t)HALF * lda * (F8 ? 1 : 2), hstepB = (size_t)HALF * ldb * (F8 ? 1 : 2);
    const size_t tstepA = 2 * hstepA, tstepB = 2 * hstepB;
    const unsigned ldsw = (unsigned)wid * 1024u;
    const int aoff = F8 ? lds_byte(wr * 64 + fr, (fq & 1) * 16) + (fq >> 1) * 1024 : lds_byte(wr * 64 + fr, fq * 8);
    const int boff = F8 ? lds_byte(wc * 32 + fr, (fq & 1) * 16) + (fq >> 1) * 1024 : lds_byte(wc * 32 + fr, fq * 8);
#define PG8_SA(b, h) (((b) * 2 + (h)) * HTB)
#define PG8_SB(b, h) ((4 + (b) * 2 + (h)) * HTB)
#define PG8_STAGE(bufoff, gbase, voff) do { _Pragma("unroll") for (int _i = 0; _i < 2; ++_i) \
        __builtin_amdgcn_global_load_lds((const unsigned*)((const char*)(gbase) + (voff)[_i]), (LAS unsigned*)(lds + (bufoff) + ldsw + _i * 8192), 16, 0, 0); } while (0)
#define PG8_LDA(dst, b, h) do { if constexpr (F8) { _Pragma("unroll") for (int m = 0; m < 4; ++m) { const LAS unsigned char* p_ = lds + PG8_SA(b, h) + aoff + m * 2048; \
            const i32x4 lo_ = *(const LAS i32x4*)p_, hi_ = *(const LAS i32x4*)(p_ + 16); dst##8[m] = __builtin_shufflevector(lo_, hi_, 0, 1, 2, 3, 4, 5, 6, 7); } } \
        else { _Pragma("unroll") for (int m = 0; m < 4; ++m) _Pragma("unroll") for (int k = 0; k < 2; ++k) dst[m][k] = *(const LAS bf16x8*)(lds + PG8_SA(b, h) + aoff + m * 2048 + k * 1024); } } while (0)
#define PG8_LDB(dst, b, h) do { if constexpr (F8) { _Pragma("unroll") for (int n = 0; n < 2; ++n) { const LAS unsigned char* p_ = lds + PG8_SB(b, h) + boff + n * 2048; \
            const i32x4 lo_ = *(const LAS i32x4*)p_, hi_ = *(const LAS i32x4*)(p_ + 16); dst##8[n] = __builtin_shufflevector(lo_, hi_, 0, 1, 2, 3, 4, 5, 6, 7); } } \
        else { _Pragma("unroll") for (int n = 0; n < 2; ++n) _Pragma("unroll") for (int k = 0; k < 2; ++k) dst[n][k] = *(const LAS bf16x8*)(lds + PG8_SB(b, h) + boff + n * 2048 + k * 1024); } } while (0)
#define PG8_MMA(ai, bj, At, Bt) do { __builtin_amdgcn_s_setprio(1); \
        if constexpr (F8) { _Pragma("unroll") for (int m = 0; m < 4; ++m) _Pragma("unroll") for (int n = 0; n < 2; ++n) \
            asm volatile("v_mfma_scale_f32_16x16x128_f8f6f4 %0, %1, %2, %0, %3, %3 op_sel_hi:[0,0,0]" : "+v"(acc[ai][bj][m][n]) : "v"(Bt##8[n]), "v"(At##8[m]), "v"(mxscale)); } \
        else { _Pragma("unroll") for (int m = 0; m < 4; ++m) _Pragma("unroll") for (int n = 0; n < 2; ++n) _Pragma("unroll") for (int k = 0; k < 2; ++k) \
            acc[ai][bj][m][n] = __builtin_amdgcn_mfma_f32_16x16x32_bf16(Bt[n][k], At[m][k], acc[ai][bj][m][n], 0, 0, 0); } \
        __builtin_amdgcn_s_setprio(0); } while (0)
#define PG8_WAIT_V(n) asm volatile("s_waitcnt vmcnt(" #n ")" ::: "memory")
#define PG8_WAIT_L(n) asm volatile("s_waitcnt lgkmcnt(" #n ")" ::: "memory")
#define PG8_BAR __builtin_amdgcn_s_barrier()
#define PG8_SCHED __builtin_amdgcn_sched_barrier(0)
    Unit cur, nxt; int ui = 0;
    if (!S.next(0, cur)) return;
    f32x4 acc[2][2][4][2];
#pragma unroll
    for (int a = 0; a < 2; ++a)
#pragma unroll
        for (int b = 0; b < 2; ++b)
#pragma unroll
            for (int m = 0; m < 4; ++m)
#pragma unroll
                for (int n = 0; n < 2; ++n) acc[a][b][m][n] = (f32x4){0.f, 0.f, 0.f, 0.f};
    int mxscale = 0x7f7f7f7f; asm volatile("" : "+v"(mxscale));
    bf16x8 At[4][2], B0[2][2], B1[2][2]; i32x8 At8[4], B08[2], B18[2];
    const char* cA = (const char*)g.A + (size_t)cur.pm * tstepA; const char* cB = (const char*)g.Bt + (size_t)cur.pn * tstepB;
    PG8_STAGE(PG8_SB(0, 0), cB, voffB); PG8_STAGE(PG8_SA(0, 0), cA, voffA); PG8_STAGE(PG8_SB(0, 1), cB + hstepB, voffB); PG8_STAGE(PG8_SA(0, 1), cA + hstepA, voffA);
    if (wr == 1) PG8_BAR;
    PG8_WAIT_V(4); PG8_BAR;
    PG8_STAGE(PG8_SB(1, 0), cB + kstep, voffB); PG8_STAGE(PG8_SA(1, 0), cA + kstep, voffA); PG8_STAGE(PG8_SB(1, 1), cB + hstepB + kstep, voffB);
    PG8_WAIT_V(6); PG8_BAR;
    for (;;) {
        const bool has_next = S.next(ui + 1, nxt);
        const char* nA = has_next ? (const char*)g.A + (size_t)nxt.pm * tstepA : cA; const char* nB = has_next ? (const char*)g.Bt + (size_t)nxt.pn * tstepB : cB;
        for (int t = 0; t < nt; t += 2) {
            const bool last = (t == nt - 2);
            const char* a1 = cA + (size_t)(t + 1) * kstep;
            const char* a2 = last ? nA : cA + (size_t)(t + 2) * kstep; const char* b2 = last ? nB : cB + (size_t)(t + 2) * kstep;
            const char* a3 = a2 + kstep; const char* b3 = b2 + kstep;
            PG8_LDB(B0, 0, 0); PG8_SCHED; PG8_LDA(At, 0, 0); PG8_STAGE(PG8_SA(1, 1), a1 + hstepA, voffA);
            PG8_WAIT_L(8); PG8_BAR; PG8_WAIT_L(0); PG8_MMA(0, 0, At, B0); PG8_BAR; PG8_SCHED;
            PG8_LDB(B1, 0, 1); PG8_STAGE(PG8_SB(0, 0), b2, voffB);
            PG8_BAR; PG8_WAIT_L(0); PG8_MMA(0, 1, At, B1); PG8_BAR;
            PG8_LDA(At, 0, 1); PG8_STAGE(PG8_SA(0, 0), a2, voffA);
            PG8_BAR; PG8_WAIT_L(0); PG8_MMA(1, 0, At, B0); PG8_BAR; PG8_SCHED;
            PG8_STAGE(PG8_SB(0, 1), b2 + hstepB, voffB);
            PG8_WAIT_V(6); PG8_BAR; PG8_MMA(1, 1, At, B1); PG8_BAR;
            PG8_LDB(B0, 1, 0); PG8_SCHED; PG8_LDA(At, 1, 0); PG8_STAGE(PG8_SA(0, 1), a2 + hstepA, voffA);
            PG8_WAIT_L(8); PG8_BAR; PG8_WAIT_L(0); PG8_MMA(0, 0, At, B0); PG8_BAR; PG8_SCHED;
            PG8_LDB(B1, 1, 1); PG8_STAGE(PG8_SB(1, 0), b3, voffB);
            PG8_BAR; PG8_WAIT_L(0); PG8_MMA(0, 1, At, B1); PG8_BAR;
            PG8_LDA(At, 1, 1); PG8_STAGE(PG8_SA(1, 0), a3, voffA);
            PG8_BAR; PG8_WAIT_L(0); PG8_MMA(1, 0, At, B0); PG8_BAR; PG8_SCHED;
            PG8_STAGE(PG8_SB(1, 1), b3 + hstepB, voffB);
            PG8_WAIT_V(6); PG8_BAR; PG8_MMA(1, 1, At, B1); PG8_BAR;
        }
        if constexpr (F8) asm volatile("s_nop 15\n\ts_nop 7");
        E(acc, cur, wr, wc, fr, fq);
        if (!has_next) break;
#pragma unroll
        for (int a = 0; a < 2; ++a)
#pragma unroll
            for (int b = 0; b < 2; ++b)
#pragma unroll
                for (int m = 0; m < 4; ++m)
#pragma unroll
                    for (int n = 0; n < 2; ++n) acc[a][b][m][n] = (f32x4){0.f, 0.f, 0.f, 0.f};
        cur = nxt; cA = nA; cB = nB; ++ui;
    }
    PG8_WAIT_V(0);
    if (wr == 0) PG8_BAR;
    PG8_BAR;
#undef PG8_SA
#undef PG8_SB
#undef PG8_STAGE
#undef PG8_LDA
#undef PG8_LDB
#undef PG8_MMA
#undef PG8_WAIT_V
#undef PG8_WAIT_L
#undef PG8_BAR
#undef PG8_SCHED
}
}

struct Args { const float* in[30]; float* out; unsigned char* ws; int ph_lo, ph_hi; };
enum { I_X = 0, I_C, I_CTX, I_CCTX, I_WMOD, I_BMOD, I_N1G, I_WIN, I_QNG, I_KNG, I_WA2F, I_BAF, I_WA2B, I_BAB, I_ONG, I_MQNG, I_WUQ, I_MKVNG, I_WUKV,
       I_WBRA, I_WBRL, I_WBRM, I_WOUT, I_N2G, I_PWQ, I_PK1, I_PK2, I_PU, I_PV, I_FG };
typedef const float* cfp_t;
struct Ctx {
    const __attribute__((address_space(4))) cfp_t* in; float* out; unsigned char* ws; LAS unsigned char* lds;
    int tid, lane, wid, G, bid;
};
#define WSP(T, off) ((T*)(C.ws + (off)))
#define INP(i) ((const float*)(const GLB float*)C.in[(i)])
__device__ __forceinline__ unsigned long long launder_u64(unsigned long long w) {
    unsigned lo = (unsigned)w, hi = (unsigned)(w >> 32); asm volatile("" : "+v"(lo), "+v"(hi));
    lo = __builtin_amdgcn_readfirstlane(lo); hi = __builtin_amdgcn_readfirstlane(hi); return ((unsigned long long)hi << 32) | lo;
}
__device__ __forceinline__ Ctx launder(const Ctx& C0) {
    Ctx R = C0; int t = C0.tid; asm volatile("" : "+v"(t)); R.tid = t; R.lane = t & 63; R.wid = __builtin_amdgcn_readfirstlane(t >> 6);
    R.ws = (unsigned char*)(GLB unsigned char*)launder_u64((unsigned long long)C0.ws);
    R.out = (float*)(GLB float*)(unsigned long long)C0.out;
    R.in = (const __attribute__((address_space(4))) cfp_t*)launder_u64((unsigned long long)C0.in);
    unsigned l = (unsigned)(uintptr_t)C0.lds; asm volatile("" : "+v"(l)); l = __builtin_amdgcn_readfirstlane(l); R.lds = (LAS unsigned char*)(uintptr_t)l;
    return R;
}

__device__ __forceinline__ const float* src_row(const Ctx& C, int r) {
    const int b = r / RPB, j = r % RPB;
    return j < CTXL ? INP(I_CTX) + ((size_t)b * CTXL + j) * DM : INP(I_X) + ((size_t)b * SEQ + (j - CTXL)) * DM;
}
__device__ __forceinline__ int mod_sel(int r) { const int b = r / RPB, j = r % RPB; return j < CTXL ? 2 : b; }

__device__ __forceinline__ void phase_modv(const Ctx& C) {
    LAS float* sc = (LAS float*)C.lds;
    LAS float* red = (LAS float*)(C.lds + 3 * 2048 * 4);
    for (int i = C.tid; i < 3 * DM; i += NTHREADS) { const int r = i / DM, k = i % DM; const float v = r < 2 ? INP(I_C)[r * DM + k] : INP(I_CCTX)[k]; sc[i] = siluf_(v); }
    __syncthreads();
    float* modv = WSP(float, WS_MODV);
    const int kq = C.tid / 12, c4 = C.tid % 12;
    for (int item = C.bid; item < 2 * 256; item += C.G) {
        const int l = item / 256, cg = item % 256;
        float acc[3][4];
#pragma unroll
        for (int r = 0; r < 3; ++r)
#pragma unroll
            for (int j = 0; j < 4; ++j) acc[r][j] = 0.f;
        if (kq < 42) {
            const float* wp = INP(I_WMOD) + (size_t)l * DM * 12288 + 48 * cg + 4 * c4;
#pragma unroll 1
            for (int k0 = kq; k0 < DM; k0 += 42 * 7) {
                f32x4 w[7];
#pragma unroll
                for (int u = 0; u < 7; ++u) { const int k = k0 + 42 * u; w[u] = k < DM ? *(const f32x4*)(wp + (size_t)k * 12288) : (f32x4){0.f, 0.f, 0.f, 0.f}; }
#pragma unroll
                for (int u = 0; u < 7; ++u) { const int k = k0 + 42 * u; if (k < DM) {
#pragma unroll
                    for (int r = 0; r < 3; ++r) { const float sv = sc[r * DM + k];
#pragma unroll
                        for (int j = 0; j < 4; ++j) acc[r][j] += sv * w[u][j]; } } }
            }
#pragma unroll
            for (int r = 0; r < 3; ++r)
#pragma unroll
                for (int j = 0; j < 4; ++j) red[kq * 144 + r * 48 + c4 * 4 + j] = acc[r][j];
        }
        __syncthreads();
        if (C.tid < 144) { float s = 0.f; for (int q = 0; q < 42; ++q) s += red[q * 144 + C.tid];
            const int r = C.tid / 48, cc = C.tid % 48;
            modv[((size_t)l * 3 + r) * 12288 + 48 * cg + cc] = s + INP(I_BMOD)[(size_t)l * 12288 + 48 * cg + cc]; }
        __syncthreads();
    }
}
__device__ __forceinline__ void phase_tables(const Ctx& C) {
    float* ta = WSP(float, WS_TABA); float* tm = WSP(float, WS_TABM);
    for (int i = C.bid * NTHREADS + C.tid; i < 128 * 32 + 128 * 16; i += C.G * NTHREADS) {
        if (i < 128 * 32) { const int pos = i / 32, f = i % 32; const float inv = exp2f(-(float)f * (13.287712379549449f / 32.0f)); const float a = (float)pos * inv;
            ta[i] = cosf(a); ta[128 * 32 + i] = sinf(a); }
        else { const int k = i - 128 * 32, pos = k / 16, f = k % 16; const float inv = exp2f(-(float)f * (13.287712379549449f / 16.0f)); const float a = (float)pos * inv;
            tm[k] = cosf(a); tm[128 * 16 + k] = sinf(a); }
    }
}
__device__ __forceinline__ void transpose_cvt(const Ctx& C, const float* src, int K, int N, bf16_t* dst, int Npad, int& item) {
    LAS float* tile = (LAS float*)C.lds;
    const int tk = K / 64, tn = Npad / 256, ntile = tk * tn;
    const int t0 = ((C.bid - item % C.G) + C.G) % C.G; item += ntile;
    for (int t = t0; t < ntile; t += C.G) {
        const int k0 = (t / tn) * 64, n0 = (t % tn) * 256;
        const int nn = (C.tid & 63) * 4, kr = C.tid >> 6;
        f32x4 v[8];
#pragma unroll
        for (int p = 0; p < 8; ++p) { v[p] = (f32x4){0.f, 0.f, 0.f, 0.f}; if (n0 + nn < N) v[p] = *(const f32x4*)(src + (size_t)(k0 + kr + p * 8) * N + n0 + nn); }
#pragma unroll
        for (int p = 0; p < 8; ++p)
#pragma unroll
            for (int j = 0; j < 4; ++j) tile[(kr + p * 8) * 257 + nn + j] = v[p][j];
        __syncthreads();
        { const int n = C.tid >> 1, kh = (C.tid & 1) * 32;
#pragma unroll
          for (int q = 0; q < 4; ++q) { float x[8];
#pragma unroll
              for (int j = 0; j < 8; ++j) x[j] = tile[(kh + q * 8 + j) * 257 + n];
              u32x4 w; w.x = cvt_pk_bf16(x[0], x[1]); w.y = cvt_pk_bf16(x[2], x[3]); w.z = cvt_pk_bf16(x[4], x[5]); w.w = cvt_pk_bf16(x[6], x[7]);
              *(u32x4*)(dst + (size_t)(n0 + n) * K + k0 + kh + q * 8) = w; } }
        __syncthreads();
    }
}
__device__ __forceinline__ void transpose_cvt_fp8(const Ctx& C, const float* src, int K, int N, unsigned char* dst, int Npad, float* cinv, const float cmul = 1.0f) {
    LAS float* tile = (LAS float*)C.lds;
    LAS float* red = (LAS float*)(C.lds + 64 * 65 * 4);
    LAS float* scl = red + 32 * 64;
    const int kk = C.tid >> 4, nn = (C.tid & 15) * 4;
    for (int cgp = C.bid; cgp < Npad / 64; cgp += C.G) {
        const int n0 = cgp * 64; const bool live = n0 + nn < N;
        float am[4] = {0.f, 0.f, 0.f, 0.f};
        for (int k0 = 0; k0 < K; k0 += 128) {
            f32x4 v[4];
#pragma unroll
            for (int p = 0; p < 4; ++p) v[p] = live ? *(const f32x4*)(src + (size_t)(k0 + kk + p * 32) * N + n0 + nn) : (f32x4){0.f, 0.f, 0.f, 0.f};
#pragma unroll
            for (int p = 0; p < 4; ++p)
#pragma unroll
                for (int j = 0; j < 4; ++j) am[j] = fmaxf(am[j], fabsf(v[p][j])); }
#pragma unroll
        for (int j = 0; j < 4; ++j) red[kk * 64 + nn + j] = am[j];
        __syncthreads();
        if (C.tid < 64) { float m = 0.f; for (int q = 0; q < 32; ++q) m = fmaxf(m, red[q * 64 + C.tid]);
            scl[C.tid] = m > 0.f ? 224.0f / m : 1.0f; cinv[n0 + C.tid] = (m > 0.f ? m * (1.0f / 224.0f) : 1.0f) * cmul; }
        __syncthreads();
        for (int k0 = 0; k0 < K; k0 += 64) {
#pragma unroll
            for (int p = 0; p < 2; ++p) { const f32x4 v = live ? *(const f32x4*)(src + (size_t)(k0 + kk + p * 32) * N + n0 + nn) : (f32x4){0.f, 0.f, 0.f, 0.f};
#pragma unroll
                for (int j = 0; j < 4; ++j) tile[(kk + p * 32) * 65 + nn + j] = v[j]; }
            __syncthreads();
            { const int n = C.tid >> 3, k8 = (C.tid & 7) * 8; const float sc = scl[n]; float x[8];
#pragma unroll
              for (int j = 0; j < 8; ++j) x[j] = tile[(k8 + j) * 65 + n] * sc;
              int p0 = __builtin_amdgcn_cvt_pk_fp8_f32(x[0], x[1], 0, false); p0 = __builtin_amdgcn_cvt_pk_fp8_f32(x[2], x[3], p0, true);
              int p1 = __builtin_amdgcn_cvt_pk_fp8_f32(x[4], x[5], 0, false); p1 = __builtin_amdgcn_cvt_pk_fp8_f32(x[6], x[7], p1, true);
              u32x2 w; w.x = (unsigned)p0; w.y = (unsigned)p1; *(u32x2*)(dst + (size_t)(n0 + n) * K + k0 + k8) = w; }
            __syncthreads();
        }
    }
}
__device__ __forceinline__ void cvt_plain(const Ctx& C, const float* src, bf16_t* dst, size_t n8) {
    for (size_t i = (size_t)C.bid * NTHREADS + C.tid; i < n8; i += (size_t)C.G * NTHREADS) {
        const f32x4 a = *(const f32x4*)(src + i * 8), b = *(const f32x4*)(src + i * 8 + 4);
        u32x4 w; w.x = cvt_pk_bf16(a[0], a[1]); w.y = cvt_pk_bf16(a[2], a[3]); w.z = cvt_pk_bf16(b[0], b[1]); w.w = cvt_pk_bf16(b[2], b[3]);
        *(u32x4*)(dst + i * 8) = w;
    }
}
__device__ __forceinline__ void phase_cvt_mixer_weights(const Ctx& C, int l) {
    int item = 0;
    transpose_cvt_fp8(C, INP(I_WIN) + (size_t)l * DM * IN_COLS, DM, IN_COLS, C.ws + WS_WIN, NP, WSP(float, WS_WINS));
    __syncthreads();
    transpose_cvt(C, INP(I_WUQ) + (size_t)l * 512 * 1536, 512, 1536, WSP(bf16_t, WS_WUQ), 1536, item);
    transpose_cvt(C, INP(I_WUKV) + (size_t)l * 512 * 2048, 512, 2048, WSP(bf16_t, WS_WUKV), 2048, item);
    transpose_cvt_fp8(C, INP(I_WBRA) + (size_t)l * 1024 * 2048, 1024, 2048, C.ws + WS_WBR, 2048, WSP(float, WS_WBRS), 1.0f / 32.0f); __syncthreads();
    transpose_cvt_fp8(C, INP(I_WBRL) + (size_t)l * 1024 * 2048, 1024, 2048, C.ws + WS_WBR + (size_t)2048 * 1024, 2048, WSP(float, WS_WBRS) + DM, 1.0f); __syncthreads();
    transpose_cvt_fp8(C, INP(I_WBRM) + (size_t)l * 1024 * 2048, 1024, 2048, C.ws + WS_WBR + (size_t)2 * 2048 * 1024, 2048, WSP(float, WS_WBRS) + 2 * DM, 1.0f / 32.0f); __syncthreads();
    transpose_cvt_fp8(C, INP(I_WOUT) + (size_t)l * 2048 * 2048, 2048, 2048, C.ws + WS_WOUT, 2048, WSP(float, WS_WOUTS));
    __syncthreads();
    transpose_cvt(C, INP(I_PWQ) + (size_t)l * 2048 * 2048, 2048, 2048, WSP(bf16_t, WS_WQ), 2048, item);
    cvt_plain(C, INP(I_PK1) + (size_t)l * 8 * 128 * 128, WSP(bf16_t, WS_K1), 8 * 128 * 128 / 8);
    cvt_plain(C, INP(I_PK2) + (size_t)l * 8 * 128 * 128, WSP(bf16_t, WS_K2), 8 * 128 * 128 / 8);
}
__device__ __forceinline__ void phase_cvt_peer_tables(const Ctx& C, int l, int row_lo, int row_hi, int wg_lo) {
    const int lane = C.lane; if (C.bid < wg_lo) return;
    unsigned char* pt = C.ws + WS_PT + (size_t)l * PT_BYTES;
    for (int row = row_lo + (C.bid - wg_lo) * 8 + C.wid; row < row_hi; row += (C.G - wg_lo) * 8) {
#pragma unroll 1
        for (int tb = 0; tb < 2; ++tb) {
            const float* src = (tb ? INP(I_PV) : INP(I_PU)) + ((size_t)l * NEXP + row) * DM + lane * 16;
            f32x4 x[8]; float amax = 0.f;
#pragma unroll
            for (int c = 0; c < 2; ++c)
#pragma unroll
                for (int q = 0; q < 4; ++q) { x[c * 4 + q] = *(const f32x4*)(src + c * 1024 + q * 4);
                    amax = fmaxf(amax, fmaxf(fmaxf(fabsf(x[c * 4 + q][0]), fabsf(x[c * 4 + q][1])), fmaxf(fabsf(x[c * 4 + q][2]), fabsf(x[c * 4 + q][3])))); }
            amax = fmaxf(amax, xchg32(amax, lane)); amax = fmaxf(amax, xchg16(amax, lane)); amax = fmaxf(amax, dppmov<DPP_ROR8>(amax));
            amax = fmaxf(amax, dppmov<DPP_HMIRROR>(amax)); amax = fmaxf(amax, dppmov<DPP_Q3210>(amax)); amax = fmaxf(amax, dppmov<DPP_Q1032>(amax));
            const float sc = amax > 0.f ? 224.0f / amax : 1.0f, inv = amax > 0.f ? amax * (1.0f / 224.0f) : 1.0f;
            unsigned char* dst = pt + (tb ? PT_V8 : PT_U8) + (size_t)(lane >> 3) * ((size_t)NEXP * 128) + (size_t)row * 128 + (lane & 7) * 16;
#pragma unroll
            for (int c = 0; c < 2; ++c) { u32x4 w;
#pragma unroll
                for (int q = 0; q < 4; ++q) { const f32x4 v = x[c * 4 + q] * sc; int p = __builtin_amdgcn_cvt_pk_fp8_f32(v[0], v[1], 0, false); p = __builtin_amdgcn_cvt_pk_fp8_f32(v[2], v[3], p, true); w[q] = (unsigned)p; }
                *(u32x4*)(dst + (size_t)c * 8 * ((size_t)NEXP * 128)) = w; }
            if (lane == 0) ((float*)(pt + (tb ? PT_SCV : PT_SCU)))[row] = inv;
        }
    }
}

template <bool FIRST, bool F8OUT = false> __device__ __forceinline__ void phase_norm_mod(const Ctx& C, const float* gvec, const float* modl  , int shift_off, int scale_off) {
    float* xs = WSP(float, WS_XS); bf16_t* hb = WSP(bf16_t, WS_HB);
    for (int r = C.bid * 8 + C.wid; r < TT; r += C.G * 8) {
        const float* xr = FIRST ? src_row(C, r) : xs + (size_t)r * DM;
        const float* mv = modl + (size_t)mod_sel(r) * 12288;
        f32x4 v[8]; float ss = 0.f;
#pragma unroll
        for (int c = 0; c < 4; ++c) { v[2 * c] = *(const f32x4*)(xr + c * 512 + C.lane * 8); v[2 * c + 1] = *(const f32x4*)(xr + c * 512 + C.lane * 8 + 4); }
#pragma unroll
        for (int c = 0; c < 8; ++c) ss += v[c][0] * v[c][0] + v[c][1] * v[c][1] + v[c][2] * v[c][2] + v[c][3] * v[c][3];
        ss = wave_sum(ss);
        const float rs = rsqrtf(ss * (1.0f / DM) + NORM_EPS);
#pragma unroll
        for (int c = 0; c < 4; ++c) { const int col = c * 512 + C.lane * 8;
            if (FIRST) { *(f32x4*)(xs + (size_t)r * DM + col) = v[2 * c]; *(f32x4*)(xs + (size_t)r * DM + col + 4) = v[2 * c + 1]; }
            float o[8];
#pragma unroll
            for (int h = 0; h < 2; ++h) { const f32x4 g = *(const f32x4*)(gvec + col + 4 * h), s = *(const f32x4*)(mv + scale_off + col + 4 * h), t = *(const f32x4*)(mv + shift_off + col + 4 * h);
#pragma unroll
                for (int j = 0; j < 4; ++j) o[4 * h + j] = v[2 * c + h][j] * rs * g[j] * (1.0f + s[j]) + t[j]; }
            if constexpr (F8OUT) {
                int p0 = __builtin_amdgcn_cvt_pk_fp8_f32(o[0], o[1], 0, false); p0 = __builtin_amdgcn_cvt_pk_fp8_f32(o[2], o[3], p0, true);
                int p1 = __builtin_amdgcn_cvt_pk_fp8_f32(o[4], o[5], 0, false); p1 = __builtin_amdgcn_cvt_pk_fp8_f32(o[6], o[7], p1, true);
                u32x2 w; w.x = (unsigned)p0; w.y = (unsigned)p1; *(u32x2*)((unsigned char*)hb + (size_t)r * DM + col) = w;
            } else {
            u32x4 w; w.x = cvt_pk_bf16(o[0], o[1]); w.y = cvt_pk_bf16(o[2], o[3]); w.z = cvt_pk_bf16(o[4], o[5]); w.w = cvt_pk_bf16(o[6], o[7]);
            *(u32x4*)(hb + (size_t)r * DM + col) = w; } }
    }
}

__device__ __forceinline__ void phase_post_p(const Ctx& C, int l) {
    bf16_t* P = WSP(bf16_t, WS_P); const float* ta = WSP(float, WS_TABA); const float* tm = WSP(float, WS_TABM);
    const float* qg = INP(I_QNG) + l * 128; const float* kg = INP(I_KNG) + l * 128;
    const float* mqg = INP(I_MQNG) + l * 512; const float* mkvg = INP(I_MKVNG) + l * 512;
    const int lane = C.lane;
    const float qg1 = qg[lane], qg2 = qg[lane + 64], kg1 = kg[lane], kg2 = kg[lane + 64];
    for (int r = C.bid * 8 + C.wid; r < TT; r += C.G * 8) {
        bf16_t* pr = P + (size_t)r * NP;
        const int j = r % RPB; const bool lat = j >= CTXL; const int pos = lat ? j - CTXL : 0, ri = pos >> 6, ci = pos & 63;
        float cs = 1.f, sn = 0.f;
        if (lat) { const int p = lane < 32 ? ri : ci, f = lane & 31; cs = ta[p * 32 + f]; sn = ta[128 * 32 + p * 32 + f]; }
#pragma unroll
        for (int h = 0; h < 10; ++h) {
            bf16_t* hp = pr + (h < 8 ? C_AQ + h * 128 : C_AK + (h - 8) * 128);
            const float x1 = bf2f(hp[lane]), x2 = bf2f(hp[lane + 64]);
            const float ss = wave_sum(x1 * x1 + x2 * x2);
            const float rs = rsqrtf(ss * (1.0f / 128.0f) + NORM_EPS);
            const float y1 = x1 * rs * (h < 8 ? qg1 : kg1), y2 = x2 * rs * (h < 8 ? qg2 : kg2);
            const float z1 = y1 * cs - y2 * sn, z2 = y2 * cs + y1 * sn;
            hp[lane] = f2bf(z1); hp[lane + 64] = f2bf(z2);
            if (h >= 8) { unsigned char* k8 = C.ws + WS_AK8 + (size_t)r * 256 + (h - 8) * 128;
                k8[lane] = (unsigned char)(__builtin_amdgcn_cvt_pk_fp8_f32(z1, 0.f, 0, false) & 0xff); k8[lane + 64] = (unsigned char)(__builtin_amdgcn_cvt_pk_fp8_f32(z2, 0.f, 0, false) & 0xff); }
        }
#pragma unroll
        for (int s = 0; s < 2; ++s) {
            bf16_t* sp = pr + (s == 0 ? C_MCQ : C_MCKV) + lane * 8; const float* gg = (s == 0 ? mqg : mkvg) + lane * 8;
            const u32x4 w = *(const u32x4*)sp; float x[8] = {bflo(w.x), bfhi(w.x), bflo(w.y), bfhi(w.y), bflo(w.z), bfhi(w.z), bflo(w.w), bfhi(w.w)};
            float ss = 0.f;
#pragma unroll
            for (int i = 0; i < 8; ++i) ss += x[i] * x[i];
            ss = wave_sum(ss);
            const float rs = rsqrtf(ss * (1.0f / 512.0f) + NORM_EPS);
#pragma unroll
            for (int i = 0; i < 8; ++i) x[i] = x[i] * rs * gg[i];
            u32x4 o; o.x = cvt_pk_bf16(x[0], x[1]); o.y = cvt_pk_bf16(x[2], x[3]); o.z = cvt_pk_bf16(x[4], x[5]); o.w = cvt_pk_bf16(x[6], x[7]);
            *(u32x4*)sp = o;
        }
        { bf16_t* kp = pr + C_MKR; const int i = lane & 31; const float x1 = bf2f(kp[i]), x2 = bf2f(kp[i + 32]);
          float c2 = 1.f, s2 = 0.f; if (lat) { const int p = i < 16 ? ri : ci, f = i & 15; c2 = tm[p * 16 + f]; s2 = tm[128 * 16 + p * 16 + f]; }
          const float z1 = x1 * c2 - x2 * s2, z2 = x2 * c2 + x1 * s2;
          if (lane < 32) { if (lat) { kp[i] = f2bf(z1); kp[i + 32] = f2bf(z2); }
              unsigned char* k8 = C.ws + WS_KR8 + (size_t)r * 64; k8[i] = (unsigned char)(__builtin_amdgcn_cvt_pk_fp8_f32(z1, 0.f, 0, false) & 0xff); k8[i + 32] = (unsigned char)(__builtin_amdgcn_cvt_pk_fp8_f32(z2, 0.f, 0, false) & 0xff); } }
    }
}

typedef int i32x8 __attribute__((ext_vector_type(8)));
typedef int i32x4 __attribute__((ext_vector_type(4)));
namespace att {
constexpr int NW = 8, QBLK = 32, KVBLK = 64, DV = 128;
constexpr float THR = 8.f;
#define SBAR() __builtin_amdgcn_sched_barrier(0)
__device__ __forceinline__ int crow(int r, int hi) { return (r & 3) + 8 * (r >> 2) + 4 * hi; }
template <int DQ> struct Cf {
    static constexpr int ND0 = DQ / 16, KROWB = DQ * 2, SHM_K = KVBLK * DQ * 2, SHM_V = KVBLK * DV * 2, SHM = 2 * SHM_V + 2 * SHM_K + NW * 64 * 4;
    static constexpr float SCALE = DQ == 128 ? 0.088388347648318440f : 0.072168783648703220f;
    __device__ static __forceinline__ int kswz(int row, int colB) { return row * KROWB + (colB ^ ((row & 7) << 4)); }
};
template <int DQ, int VAR = 0> __device__ __forceinline__ void partialSM(f32x16& p0, f32x16& p1, float& m_reg, float& mn, float& alpha) {
    constexpr float SC = Cf<DQ>::SCALE, Cc = SC * 1.4426950408889634f;
    float pmax = p0[0];
#pragma unroll
    for (int r = 1; r < 16; ++r) pmax = fmaxf(pmax, p0[r]);
#pragma unroll
    for (int r = 0; r < 16; ++r) pmax = fmaxf(pmax, p1[r]);
    { auto rr = __builtin_amdgcn_permlane32_swap(__float_as_uint(pmax), __float_as_uint(pmax), false, false);
      pmax = fmaxf(__uint_as_float(rr[0]), __uint_as_float(rr[1])); }
    if (__builtin_expect(__all(pmax - m_reg <= THR / SC), 1)) { mn = m_reg; alpha = 1.f; }
    else { mn = fmaxf(m_reg, pmax); alpha = __builtin_amdgcn_exp2f((m_reg - mn) * Cc); m_reg = mn; }
    const float mnC = -mn * Cc;
#pragma unroll
    for (int r = 0; r < 16; ++r) p0[r] = fmaf(p0[r], Cc, mnC);
#pragma unroll
    for (int r = 0; r < 16; ++r) p1[r] = fmaf(p1[r], Cc, mnC);
#pragma unroll
    for (int r = 0; r < 16; ++r) p0[r] = VAR == 1 ? p0[r] * 0.001f : __builtin_amdgcn_exp2f(p0[r]);
}
template <int VAR = 0> __device__ __forceinline__ void finishSM(f32x16& p0, f32x16& p1, float alpha, float& l_reg, bf16x8& pa0, bf16x8& pa1, bf16x8& pa2, bf16x8& pa3) {
#pragma unroll
    for (int r = 0; r < 16; ++r) p1[r] = VAR == 1 ? p1[r] * 0.001f : __builtin_amdgcn_exp2f(p1[r]);
    float ps = 0;
#pragma unroll
    for (int r = 0; r < 16; ++r) ps += p0[r];
#pragma unroll
    for (int r = 0; r < 16; ++r) ps += p1[r];
    { auto rr = __builtin_amdgcn_permlane32_swap(__float_as_uint(ps), __float_as_uint(ps), false, false);
      ps = __uint_as_float(rr[0]) + __uint_as_float(rr[1]); }
    l_reg = l_reg * alpha + ps;
#define PK4(P, BASE, OUT) do { unsigned a0 = cvt_pk_bf16(P[BASE + 0], P[BASE + 1]), a1 = cvt_pk_bf16(P[BASE + 2], P[BASE + 3]);   \
    unsigned b0 = cvt_pk_bf16(P[BASE + 4], P[BASE + 5]), b1 = cvt_pk_bf16(P[BASE + 6], P[BASE + 7]);                              \
    auto r0 = __builtin_amdgcn_permlane32_swap(a0, b0, false, false); auto r1 = __builtin_amdgcn_permlane32_swap(a1, b1, false, false); \
    u32x4 w = {r0[0], r1[0], r0[1], r1[1]}; OUT = *reinterpret_cast<bf16x8*>(&w); } while (0)
    PK4(p0, 0, pa0); PK4(p0, 8, pa1); PK4(p1, 0, pa2); PK4(p1, 8, pa3);
#undef PK4
}
template <int DQ> __device__ __forceinline__ void qkt(f32x16& p0, f32x16& p1, const char* Ks, const bf16x8* qr, const char* qx, int r32, int hi) {
    p0 = f32x16{}; p1 = f32x16{};
#pragma unroll
    for (int d0 = 0; d0 < Cf<DQ>::ND0; ++d0) { const int cb = (d0 * 16 + hi * 8) * 2;
        const bf16x8 b0 = *reinterpret_cast<const bf16x8*>(Ks + Cf<DQ>::kswz(r32, cb));
        const bf16x8 b1 = *reinterpret_cast<const bf16x8*>(Ks + Cf<DQ>::kswz(32 + r32, cb));
        constexpr int NQR = DQ == 192 ? MLA_NQR : 8;
        bf16x8 q; if (d0 < NQR) q = qr[d0]; else q = *reinterpret_cast<const bf16x8*>(qx + (d0 - NQR) * 1024);
        p0 = __builtin_amdgcn_mfma_f32_32x32x16_bf16(b0, q, p0, 0, 0, 0);
        p1 = __builtin_amdgcn_mfma_f32_32x32x16_bf16(b1, q, p1, 0, 0, 0); }
}
__device__ __forceinline__ int v_st(int k, int c) { const int kk = (k & ~0xC) | ((k & 4) << 1) | ((k & 8) >> 1); return ((kk >> 3) * 4 + (c >> 5)) * 512 + ((kk & 7) * 32 + (c & 31)) * 2; }
__device__ __forceinline__ int v_rd_base(int lane) { return ((lane & 3) << 3) | (((lane >> 2) & 3) << 6) | (((lane >> 4) & 1) << 5) | (((lane >> 5) & 1) << 8); }
constexpr int v_rd_off(int d0, int ks, int half) { return d0 * 512 + ks * 4096 + half * 2048; }
template <int OFF> __device__ __forceinline__ s16x4 tr_read(int vb) {
    s16x4 r; asm volatile("ds_read_b64_tr_b16 %0, %1 offset:%2" : "=&v"(r) : "v"(vb), "i"(OFF) : "memory"); return r;
}
template <int D0> __device__ __forceinline__ void pv_one(f32x16& od, int vb, bf16x8 pa0, bf16x8 pa1, bf16x8 pa2, bf16x8 pa3) {
    const s16x4 l0 = tr_read<v_rd_off(D0, 0, 0)>(vb), h0 = tr_read<v_rd_off(D0, 0, 1)>(vb), l1 = tr_read<v_rd_off(D0, 1, 0)>(vb), h1 = tr_read<v_rd_off(D0, 1, 1)>(vb);
    const s16x4 l2 = tr_read<v_rd_off(D0, 2, 0)>(vb), h2 = tr_read<v_rd_off(D0, 2, 1)>(vb), l3 = tr_read<v_rd_off(D0, 3, 0)>(vb), h3 = tr_read<v_rd_off(D0, 3, 1)>(vb);
    asm volatile("s_waitcnt lgkmcnt(0)" ::: "memory"); SBAR();
#define PK(L, H) (bf16x8){L[0], L[1], L[2], L[3], H[0], H[1], H[2], H[3]}
    od = __builtin_amdgcn_mfma_f32_32x32x16_bf16(pa0, PK(l0, h0), od, 0, 0, 0);
    od = __builtin_amdgcn_mfma_f32_32x32x16_bf16(pa1, PK(l1, h1), od, 0, 0, 0);
    od = __builtin_amdgcn_mfma_f32_32x32x16_bf16(pa2, PK(l2, h2), od, 0, 0, 0);
    od = __builtin_amdgcn_mfma_f32_32x32x16_bf16(pa3, PK(l3, h3), od, 0, 0, 0);
#undef PK
}
__device__ __forceinline__ void pv_d0(f32x16* o, int vb, bf16x8 pa0, bf16x8 pa1, bf16x8 pa2, bf16x8 pa3) {
    pv_one<0>(o[0], vb, pa0, pa1, pa2, pa3); pv_one<1>(o[1], vb, pa0, pa1, pa2, pa3); pv_one<2>(o[2], vb, pa0, pa1, pa2, pa3); pv_one<3>(o[3], vb, pa0, pa1, pa2, pa3);
}
__device__ __forceinline__ bf16x8 ld8(const bf16_t* p) { return *reinterpret_cast<const bf16x8*>(p); }

template <int DQ, int SD, int VAR = 0>
__device__ __forceinline__ void attn_body(const bf16_t* __restrict__ Qb, int ldq, const bf16_t* __restrict__ Kn, int ldkn, const bf16_t* __restrict__ Kr, int ldkr,
                                          const bf16_t* __restrict__ Vh, int ldv, unsigned char* __restrict__ Ob, int ldo, int seq, bool rope_q, int pos0, const float* __restrict__ tabM, char* lds, const int tid) {
    using CF = Cf<DQ>; constexpr int ND0 = CF::ND0, SHM_V = CF::SHM_V, SHM_K = CF::SHM_K;
    const int wid = tid >> 6, lane = tid & 63, r32 = lane & 31, hi = lane >> 5;
    char* V_lds = lds; char* K_lds = lds + 2 * SHM_V;
    float* ws = (float*)(lds + 2 * SHM_V + 2 * SHM_K) + wid * 64; float* li_l = ws; float* al_l = ws + 32;
    constexpr int NQR = DQ == 192 ? MLA_NQR : 8;
    float m_reg = -1e30f, l_reg = 0; f32x16 o[4] = {}; bf16x8 qr[NQR];
    const bf16_t* Qw = Qb + (long)(wid * QBLK + r32) * ldq + hi * 8;
#pragma unroll
    for (int d0 = 0; d0 < NQR; ++d0) qr[d0] = ld8(Qw + d0 * 16);
    char* qx = lds + CF::SHM + wid * 8192 + lane * 16;
    if constexpr (DQ == 192) {
#pragma unroll
        for (int d0 = NQR; d0 < 8; ++d0) *(bf16x8*)(qx + (d0 - NQR) * 1024) = ld8(Qw + d0 * 16);
        bf16x8 qe[4];
#pragma unroll
        for (int d0 = 0; d0 < 4; ++d0) qe[d0] = ld8(Qw + (8 + d0) * 16);
        if (rope_q) {
            const int pos = pos0 + wid * QBLK + r32, ri = pos >> 6, ci = pos & 63;
#pragma unroll
            for (int t = 0; t < 2; ++t) { const int p = t == 0 ? ri : ci; const float* tc = tabM + p * 16 + hi * 8; const float* tsn = tabM + 128 * 16 + p * 16 + hi * 8;
                bf16x8 a = qe[t], b = qe[2 + t];
#pragma unroll
                for (int jj = 0; jj < 8; ++jj) { const float x1 = bf2f((bf16_t)a[jj]), x2 = bf2f((bf16_t)b[jj]), c = tc[jj], s = tsn[jj];
                    a[jj] = (short)f2bf(x1 * c - x2 * s); b[jj] = (short)f2bf(x2 * c + x1 * s); }
                qe[t] = a; qe[2 + t] = b; }
        }
#pragma unroll
        for (int d0 = 0; d0 < 4; ++d0) *(bf16x8*)(qx + (8 - NQR + d0) * 1024) = qe[d0];
    }
    const int sr = tid >> 4, sc = (tid & 15) * 8, vst0 = v_st(sr, sc), vst1 = v_st(32 + sr, sc);
    const int sr2 = tid >> 3, sc2 = (tid & 7) * 8;
    const int vb0 = (int)(uintptr_t)V_lds + v_rd_base(lane);
    struct { bf16x8 vs0, vs1, ks0, ks1, ks2; } sr_[SD];
    const unsigned offV = (unsigned)(sr * ldv + sc) * 2u, offK = (unsigned)(sr * ldkn + sc) * 2u, offR = (unsigned)(sr2 * ldkr + sc2) * 2u;
#define SLOAD(i, k0) do { const char* vt_ = (const char*)Vh + (size_t)(k0) * ldv * 2; const char* kt_ = (const char*)Kn + (size_t)(k0) * ldkn * 2; \
    sr_[i].vs0 = *(const bf16x8*)(vt_ + offV); sr_[i].vs1 = *(const bf16x8*)(vt_ + (size_t)32 * ldv * 2 + offV); \
    sr_[i].ks0 = *(const bf16x8*)(kt_ + offK); sr_[i].ks1 = *(const bf16x8*)(kt_ + (size_t)32 * ldkn * 2 + offK); \
    if constexpr (DQ == 192) sr_[i].ks2 = *(const bf16x8*)((const char*)Kr + (size_t)(k0) * ldkr * 2 + offR); } while (0)
#define SWRITE(b, i) do { *(bf16x8*)(V_lds + (b) * SHM_V + vst0) = sr_[i].vs0; *(bf16x8*)(V_lds + (b) * SHM_V + vst1) = sr_[i].vs1; const int kc = sc * 2; \
    *(bf16x8*)(K_lds + (b) * SHM_K + CF::kswz(sr, kc)) = sr_[i].ks0; *(bf16x8*)(K_lds + (b) * SHM_K + CF::kswz(32 + sr, kc)) = sr_[i].ks1; \
    if constexpr (DQ == 192) *(bf16x8*)(K_lds + (b) * SHM_K + CF::kswz(sr2, 256 + sc2 * 2)) = sr_[i].ks2; } while (0)
#define SWAIT() do { if constexpr (SD == 1) asm volatile("s_waitcnt vmcnt(0)" ::: "memory"); else if constexpr (DQ == 192) asm volatile("s_waitcnt vmcnt(5)" ::: "memory"); else asm volatile("s_waitcnt vmcnt(4)" ::: "memory"); } while (0)
#define RESC(a) do { if (__any((a) < 1.f)) { if (hi == 0) al_l[r32] = (a); asm volatile("s_waitcnt lgkmcnt(0)" ::: "memory"); \
    _Pragma("unroll") for (int d = 0; d < 4; ++d) _Pragma("unroll") for (int r = 0; r < 16; ++r) o[d][r] *= al_l[crow(r, hi)]; } } while (0)
    f32x16 pA0, pA1, pB0, pB1; float mnA, mnB, alA, alB; bf16x8 pa0, pa1, pa2, pa3; const int NT = seq / KVBLK;
    constexpr int SE = 0, SO = SD - 1;
    SLOAD(SE, 0); asm volatile("s_waitcnt vmcnt(0)" ::: "memory"); SWRITE(0, SE); __syncthreads();
    qkt<DQ>(pA0, pA1, K_lds, qr, qx, r32, hi); partialSM<DQ, VAR>(pA0, pA1, m_reg, mnA, alA);
    SLOAD(SO, KVBLK); if constexpr (SD == 2) { if (2 < NT) SLOAD(SE, 2 * KVBLK); }
    SWAIT(); SWRITE(1, SO); __syncthreads();
#define ATT_SYNC() do { if constexpr (VAR != 2) __syncthreads(); } while (0)
    for (int j = 1; j + 1 < NT; j += 2) {
        SBAR(); qkt<DQ>(pB0, pB1, K_lds + SHM_K, qr, qx, r32, hi);
        finishSM<VAR>(pA0, pA1, alA, l_reg, pa0, pa1, pa2, pa3); SBAR();
        if constexpr (VAR != 3) SLOAD(SO, (j + SD) * KVBLK); SBAR();
        pv_d0(o, vb0, pa0, pa1, pa2, pa3); partialSM<DQ, VAR>(pB0, pB1, m_reg, mnB, alB);
        ATT_SYNC(); SWAIT(); SWRITE(0, SE);
        RESC(alB); ATT_SYNC();
        SBAR(); qkt<DQ>(pA0, pA1, K_lds, qr, qx, r32, hi);
        finishSM<VAR>(pB0, pB1, alB, l_reg, pa0, pa1, pa2, pa3); SBAR();
        if constexpr (VAR != 3) { if (SD == 1 || j + 3 < NT) SLOAD(SE, (j + 1 + SD) * KVBLK); } SBAR();
        pv_d0(o, vb0 + SHM_V, pa0, pa1, pa2, pa3); partialSM<DQ, VAR>(pA0, pA1, m_reg, mnA, alA);
        ATT_SYNC(); SWAIT(); SWRITE(1, SO);
        RESC(alA); ATT_SYNC();
    }
    SBAR(); qkt<DQ>(pB0, pB1, K_lds + SHM_K, qr, qx, r32, hi);
    finishSM<VAR>(pA0, pA1, alA, l_reg, pa0, pa1, pa2, pa3); SBAR();
    pv_d0(o, vb0, pa0, pa1, pa2, pa3); partialSM<DQ, VAR>(pB0, pB1, m_reg, mnB, alB);
    ATT_SYNC(); RESC(alB);
    finishSM<VAR>(pB0, pB1, alB, l_reg, pa0, pa1, pa2, pa3); SBAR();
    pv_d0(o, vb0 + SHM_V, pa0, pa1, pa2, pa3);
    if (hi == 0) li_l[r32] = l_reg; asm volatile("s_waitcnt lgkmcnt(0)" ::: "memory");
    float rli[16];
#pragma unroll
    for (int r = 0; r < 16; ++r) rli[r] = __builtin_amdgcn_rcpf(li_l[crow(r, hi)]);
    unsigned char* Ow = Ob + (long)(wid * QBLK) * ldo;
#pragma unroll
    for (int r = 0; r < 16; ++r) { const int orow = crow(r, hi);
#pragma unroll
        for (int d0 = 0; d0 < 4; ++d0) Ow[(long)orow * ldo + d0 * 32 + r32] = (unsigned char)(__builtin_amdgcn_cvt_pk_fp8_f32(o[d0][r] * rli[r] * 32.0f, 0.f, 0, false) & 0xff); }
#undef SLOAD
#undef ATT_SYNC
#undef SWRITE
#undef SWAIT
#undef RESC
}

__device__ __forceinline__ int k8addr(int row, int b, int DQ_) { return row * DQ_ + (b < 128 ? (b ^ ((row & 7) << 4)) : 128 + ((b - 128) ^ ((row & 3) << 4))); }
template <int DQ> __device__ __forceinline__ void qkt8(f32x16& p0, f32x16& p1, const char* Ks, const i32x8* qf, int r32, int hi) {
    p0 = f32x16{}; p1 = f32x16{};
#pragma unroll
    for (int ks = 0; ks < DQ / 64; ++ks) { const int b = ks * 64 + hi * 32;
        const i32x4 a0l = *reinterpret_cast<const i32x4*>(Ks + k8addr(r32, b, DQ)), a0h = *reinterpret_cast<const i32x4*>(Ks + k8addr(r32, b + 16, DQ));
        const i32x4 a1l = *reinterpret_cast<const i32x4*>(Ks + k8addr(32 + r32, b, DQ)), a1h = *reinterpret_cast<const i32x4*>(Ks + k8addr(32 + r32, b + 16, DQ));
        p0 = __builtin_amdgcn_mfma_scale_f32_32x32x64_f8f6f4(__builtin_shufflevector(a0l, a0h, 0, 1, 2, 3, 4, 5, 6, 7), qf[ks], p0, 0, 0, 0, 0x7f7f7f7f, 0, 0x7f7f7f7f);
        p1 = __builtin_amdgcn_mfma_scale_f32_32x32x64_f8f6f4(__builtin_shufflevector(a1l, a1h, 0, 1, 2, 3, 4, 5, 6, 7), qf[ks], p1, 0, 0, 0, 0x7f7f7f7f, 0, 0x7f7f7f7f); }
}
__device__ __forceinline__ int pk4_fp8(float a, float b, float c, float d) { int p = __builtin_amdgcn_cvt_pk_fp8_f32(a, b, 0, false); return __builtin_amdgcn_cvt_pk_fp8_f32(c, d, p, true); }
template <int DQ>
__device__ __forceinline__ void attn_body8(const bf16_t* __restrict__ Qb, int ldq, const unsigned char* __restrict__ Kn8, int ldkn, const unsigned char* __restrict__ Kr8, int ldkr,
                                           const bf16_t* __restrict__ Vh, int ldv, unsigned char* __restrict__ Ob, int ldo, int seq, bool rope_q, int pos0, const float* __restrict__ tabM, char* lds, const int tid) {
    constexpr int NKS = DQ / 64, SHM_V = KVBLK * DV * 2, SHM_K = KVBLK * DQ;
    const int wid = tid >> 6, lane = tid & 63, r32 = lane & 31, hi = lane >> 5;
    char* V_lds = lds; char* K_lds = lds + 2 * SHM_V;
    float* ws = (float*)(lds + 2 * SHM_V + 2 * SHM_K) + wid * 64; float* li_l = ws; float* al_l = ws + 32;
    float m_reg = -1e30f, l_reg = 0; f32x16 o[4] = {}; i32x8 qf[NKS];
    const bf16_t* Qrow = Qb + (long)(wid * QBLK + r32) * ldq;
#pragma unroll
    for (int ks = 0; ks < NKS; ++ks) {
        float x[32];
#pragma unroll
        for (int c = 0; c < 4; ++c) { const u32x4 w = *(const u32x4*)(Qrow + ks * 64 + hi * 32 + c * 8);
            x[c * 8 + 0] = bflo(w.x); x[c * 8 + 1] = bfhi(w.x); x[c * 8 + 2] = bflo(w.y); x[c * 8 + 3] = bfhi(w.y); x[c * 8 + 4] = bflo(w.z); x[c * 8 + 5] = bfhi(w.z); x[c * 8 + 6] = bflo(w.w); x[c * 8 + 7] = bfhi(w.w); }
        if (DQ == 192 && ks == 2 && rope_q) {
            float y[32];
#pragma unroll
            for (int c = 0; c < 4; ++c) { const u32x4 w = *(const u32x4*)(Qrow + 128 + (1 - hi) * 32 + c * 8);
                y[c * 8 + 0] = bflo(w.x); y[c * 8 + 1] = bfhi(w.x); y[c * 8 + 2] = bflo(w.y); y[c * 8 + 3] = bfhi(w.y); y[c * 8 + 4] = bflo(w.z); y[c * 8 + 5] = bfhi(w.z); y[c * 8 + 6] = bflo(w.w); y[c * 8 + 7] = bfhi(w.w); }
            const int pos = pos0 + wid * QBLK + r32, ri = pos >> 6, ci = pos & 63;
#pragma unroll
            for (int i = 0; i < 32; ++i) { const int p = i < 16 ? ri : ci, f = i & 15; const float c_ = tabM[p * 16 + f], s_ = tabM[128 * 16 + p * 16 + f];
                x[i] = hi ? x[i] * c_ + y[i] * s_ : x[i] * c_ - y[i] * s_; }
        }
        i32x8 q8;
#pragma unroll
        for (int j = 0; j < 8; ++j) q8[j] = pk4_fp8(x[4 * j], x[4 * j + 1], x[4 * j + 2], x[4 * j + 3]);
        qf[ks] = q8;
    }
    const int sr = tid >> 4, sc = (tid & 15) * 8, vst0 = v_st(sr, sc), vst1 = v_st(32 + sr, sc);
    const int kr = tid >> 3, kb = (tid & 7) * 16;
    const int kr2 = (tid & 255) >> 2, kb2 = (tid & 3) * 16;
    const int vb0 = (int)(uintptr_t)V_lds + v_rd_base(lane);
    struct { bf16x8 vs0, vs1; u32x4 k0, k1; } sr_[1];
    const unsigned offV = (unsigned)(sr * ldv + sc) * 2u, offK = (unsigned)(kr * ldkn + kb), offR = (unsigned)(kr2 * ldkr + kb2);
#define SLOAD8(k0_) do { const char* vt_ = (const char*)Vh + (size_t)(k0_) * ldv * 2; \
    sr_[0].vs0 = *(const bf16x8*)(vt_ + offV); sr_[0].vs1 = *(const bf16x8*)(vt_ + (size_t)32 * ldv * 2 + offV); \
    sr_[0].k0 = *(const u32x4*)(Kn8 + (size_t)(k0_) * ldkn + offK); \
    if constexpr (DQ == 192) { if (tid < 256) sr_[0].k1 = *(const u32x4*)(Kr8 + (size_t)(k0_) * ldkr + offR); } } while (0)
#define SWRITE8(b) do { *(bf16x8*)(V_lds + (b) * SHM_V + vst0) = sr_[0].vs0; *(bf16x8*)(V_lds + (b) * SHM_V + vst1) = sr_[0].vs1; \
    *(u32x4*)(K_lds + (b) * SHM_K + k8addr(kr, kb, DQ)) = sr_[0].k0; \
    if constexpr (DQ == 192) { if (tid < 256) *(u32x4*)(K_lds + (b) * SHM_K + k8addr(kr2, 128 + kb2, DQ)) = sr_[0].k1; } } while (0)
#define SWAIT8() asm volatile("s_waitcnt vmcnt(0)" ::: "memory")
#define RESC8(a) do { if (__any((a) < 1.f)) { if (hi == 0) al_l[r32] = (a); asm volatile("s_waitcnt lgkmcnt(0)" ::: "memory"); \
    _Pragma("unroll") for (int d = 0; d < 4; ++d) _Pragma("unroll") for (int r = 0; r < 16; ++r) o[d][r] *= al_l[crow(r, hi)]; } } while (0)
    f32x16 pA0, pA1, pB0, pB1; float mnA, mnB, alA, alB; bf16x8 pa0, pa1, pa2, pa3; const int NT = seq / KVBLK;
    SLOAD8(0); SWAIT8(); SWRITE8(0); __syncthreads();
    qkt8<DQ>(pA0, pA1, K_lds, qf, r32, hi); partialSM<DQ, 0>(pA0, pA1, m_reg, mnA, alA);
    SLOAD8(KVBLK);
    SWAIT8(); SWRITE8(1); __syncthreads();
    for (int j = 1; j + 1 < NT; j += 2) {
        SBAR(); qkt8<DQ>(pB0, pB1, K_lds + SHM_K, qf, r32, hi);
        finishSM<0>(pA0, pA1, alA, l_reg, pa0, pa1, pa2, pa3); SBAR();
        SLOAD8((j + 1) * KVBLK); SBAR();
        pv_d0(o, vb0, pa0, pa1, pa2, pa3); partialSM<DQ, 0>(pB0, pB1, m_reg, mnB, alB);
        __syncthreads(); SWAIT8(); SWRITE8(0);
        RESC8(alB); __syncthreads();
        SBAR(); qkt8<DQ>(pA0, pA1, K_lds, qf, r32, hi);
        finishSM<0>(pB0, pB1, alB, l_reg, pa0, pa1, pa2, pa3); SBAR();
        SLOAD8((j + 2) * KVBLK); SBAR();
        pv_d0(o, vb0 + SHM_V, pa0, pa1, pa2, pa3); partialSM<DQ, 0>(pA0, pA1, m_reg, mnA, alA);
        __syncthreads(); SWAIT8(); SWRITE8(1);
        RESC8(alA); __syncthreads();
    }
    SBAR(); qkt8<DQ>(pB0, pB1, K_lds + SHM_K, qf, r32, hi);
    finishSM<0>(pA0, pA1, alA, l_reg, pa0, pa1, pa2, pa3); SBAR();
    pv_d0(o, vb0, pa0, pa1, pa2, pa3); partialSM<DQ, 0>(pB0, pB1, m_reg, mnB, alB);
    __syncthreads(); RESC8(alB);
    finishSM<0>(pB0, pB1, alB, l_reg, pa0, pa1, pa2, pa3); SBAR();
    pv_d0(o, vb0 + SHM_V, pa0, pa1, pa2, pa3);
    if (hi == 0) li_l[r32] = l_reg; asm volatile("s_waitcnt lgkmcnt(0)" ::: "memory");
    float rli[16];
#pragma unroll
    for (int r = 0; r < 16; ++r) rli[r] = __builtin_amdgcn_rcpf(li_l[crow(r, hi)]);
    unsigned char* Ow = Ob + (long)(wid * QBLK) * ldo;
#pragma unroll
    for (int r = 0; r < 16; ++r) { const int orow = crow(r, hi);
#pragma unroll
        for (int d0 = 0; d0 < 4; ++d0) Ow[(long)orow * ldo + d0 * 32 + r32] = (unsigned char)(__builtin_amdgcn_cvt_pk_fp8_f32(o[d0][r] * rli[r] * 32.0f, 0.f, 0, false) & 0xff); }
#undef SLOAD8
#undef SWRITE8
#undef SWAIT8
#undef RESC8
}
}

template <int KS> __device__ __forceinline__ void mma_xy(f32x16& acc, const LAS bf16_t* X, const LAS bf16_t* Y, int hi) {
#pragma unroll
    for (int ks = 0; ks < KS; ++ks) { const bf16x8 a = *(const LAS bf16x8*)(X + ks * 16 + hi * 8), b = *(const LAS bf16x8*)(Y + ks * 16 + hi * 8);
        acc = __builtin_amdgcn_mfma_f32_32x32x16_bf16(a, b, acc, 0, 0, 0); }
}
__device__ __forceinline__ float logsig16(float x) { const float e = __expf(-fabsf(x)); return (fminf(x, 0.f) - __logf(1.f + e)) * 0.0625f; }
__device__ __forceinline__ int gla_sidx(int b, int dir, int h) { return (b * 2 + dir) * 4 + h; }

__device__ __forceinline__ void gla_cumsum_lds(const Ctx& C, int l, int h, int dir, const LAS float* lr, LAS float* segtot, LAS float* CUM) {
    const int seg = C.tid >> 7, d = C.tid & 127;
    const float* wa = INP(dir ? I_WA2B : I_WA2F) + (size_t)l * 16 * 512 + h * 128 + d;
    const float bias = INP(dir ? I_BAB : I_BAF)[l * 512 + h * 128 + d];
    float w[16], cum[16];
#pragma unroll
    for (int j = 0; j < 16; ++j) w[j] = wa[j * 512];
    float run = 0.f;
#pragma unroll
    for (int i = 0; i < 16; ++i) { const int s = seg * 16 + i, tk = dir ? 63 - s : s; float pre = bias;
#pragma unroll
        for (int j = 0; j < 16; ++j) pre += lr[tk * 32 + dir * 16 + j] * w[j];
        run += logsig16(pre); cum[i] = run; }
    segtot[seg * 128 + d] = run;
    __syncthreads();
    float off = 0.f;
#pragma unroll
    for (int q = 0; q < 3; ++q) if (q < seg) off += segtot[q * 128 + d];
#pragma unroll
    for (int i = 0; i < 16; ++i) { const int s = seg * 16 + i, tk = dir ? 63 - s : s; CUM[tk * 132 + d] = cum[i] + off; }
    __syncthreads();
}
__device__ __forceinline__ void unpack8(const u32x4 w, float (&x)[8]) { x[0] = bflo(w.x); x[1] = bfhi(w.x); x[2] = bflo(w.y); x[3] = bfhi(w.y); x[4] = bflo(w.z); x[5] = bfhi(w.z); x[6] = bflo(w.w); x[7] = bfhi(w.w); }
__device__ __forceinline__ void gla_build_vt(const Ctx& C, const bf16_t* P, size_t r0, int h, LAS bf16_t* VT) {
    u32x4 v[4];
#pragma unroll
    for (int it = 0; it < 4; ++it) { const int idx = C.tid + it * NTHREADS, sv = idx >> 5, e0 = (idx & 31) * 8; v[it] = *(const u32x4*)(P + (r0 + sv) * NP + C_LV + h * 256 + e0); }
#pragma unroll
    for (int it = 0; it < 4; ++it) { const int idx = C.tid + it * NTHREADS, sv = idx >> 5, e0 = (idx & 31) * 8;
        const unsigned wd[4] = {v[it].x, v[it].y, v[it].z, v[it].w};
#pragma unroll
        for (int q = 0; q < 4; ++q) { VT[(e0 + 2 * q) * 72 + sv] = (bf16_t)(wd[q] & 0xffffu); VT[(e0 + 2 * q + 1) * 72 + sv] = (bf16_t)(wd[q] >> 16); } }
}

__device__ __forceinline__ void phase_gla_local(const Ctx& C, int l, int rot) {
    const bf16_t* P = WSP(bf16_t, WS_P); bf16_t* GST = WSP(bf16_t, WS_GST); float* GDEC = WSP(float, WS_GDEC);
    LAS float* lr = (LAS float*)C.lds;
    LAS float* segtot = (LAS float*)(C.lds + 8192);
    LAS bf16_t* KT = (LAS bf16_t*)(C.lds + 10240);
    LAS bf16_t* VT = (LAS bf16_t*)(C.lds + 28672);
    LAS float* CUM = (LAS float*)(C.lds + 65536);
    const int r32 = C.lane & 31, hi = C.lane >> 5, d = C.tid & 127;
    const int btk = C.tid >> 3, bdg = (C.tid & 7) * 16;
    for (int unit = (C.bid + C.G - rot % C.G) % C.G; unit < NBATCH * 4 * NCH; unit += C.G) {
        const int b = unit / (4 * NCH), h = (unit / NCH) % 4, ck = unit % NCH; const size_t r0 = (size_t)b * RPB + ck * 64;
        for (int i = C.tid; i < 64 * 32; i += NTHREADS) lr[i] = bf2f(P[(r0 + (i >> 5)) * NP + C_LRF + (i & 31)]);
        const u32x4 kw0 = *(const u32x4*)(P + (r0 + btk) * NP + C_LK + h * 128 + bdg), kw1 = *(const u32x4*)(P + (r0 + btk) * NP + C_LK + h * 128 + bdg + 8);
        gla_build_vt(C, P, r0, h, VT);
        __syncthreads();
#pragma unroll 1
        for (int dir = 0; dir < 2; ++dir) {
            gla_cumsum_lds(C, l, h, dir, lr, segtot, CUM);
            const int tend = dir ? 0 : 63;
            const size_t sx = (size_t)gla_sidx(b, dir, h) * NCH + ck;
            if (C.tid < 128) GDEC[sx * 128 + d] = __expf(CUM[tend * 132 + d]);
            { float kf[16]; { float t8[8]; unpack8(kw0, t8);
#pragma unroll
                for (int i = 0; i < 8; ++i) kf[i] = t8[i]; unpack8(kw1, t8);
#pragma unroll
                for (int i = 0; i < 8; ++i) kf[8 + i] = t8[i]; }
#pragma unroll
              for (int q = 0; q < 4; ++q) { const f32x4 cm = *(const LAS f32x4*)(CUM + btk * 132 + bdg + 4 * q), be = *(const LAS f32x4*)(CUM + tend * 132 + bdg + 4 * q);
#pragma unroll
                  for (int i = 0; i < 4; ++i) KT[(bdg + 4 * q + i) * 72 + btk] = f2bf(kf[4 * q + i] * __expf(be[i] - cm[i])); } }
            __syncthreads();
            { const int dt = C.wid & 3, eb = (C.wid >> 2) * 4;
              f32x16 acc[4] = {};
#pragma unroll
              for (int q = 0; q < 4; ++q) mma_xy<4>(acc[q], KT + (dt * 32 + r32) * 72, VT + ((eb + q) * 32 + r32) * 72, hi);
              bf16_t* st = GST + sx * 32768;
#pragma unroll
              for (int q = 0; q < 4; ++q)
#pragma unroll
                  for (int g = 0; g < 4; ++g) { u32x2 w; w.x = cvt_pk_bf16(acc[q][4 * g], acc[q][4 * g + 1]); w.y = cvt_pk_bf16(acc[q][4 * g + 2], acc[q][4 * g + 3]);
                      *(u32x2*)(st + (size_t)((eb + q) * 32 + r32) * 128 + dt * 32 + 8 * g + 4 * hi) = w; } }
            __syncthreads();
        }
    }
}

__device__ __forceinline__ void phase_gla_scan(const Ctx& C) {
    bf16_t* GST = WSP(bf16_t, WS_GST); const float* GDEC = WSP(float, WS_GDEC);
    for (int gid = C.bid * NTHREADS + C.tid; gid < 16 * 8192; gid += C.G * NTHREADS) {
        const int sidx = gid >> 13, g = gid & 8191, dir = (sidx >> 2) & 1, d4 = (g & 31) * 4;
        bf16_t* base = GST + (size_t)sidx * NCH * 32768 + (size_t)g * 4;
        const float* dbase = GDEC + (size_t)sidx * NCH * 128 + d4;
        float S[4] = {0.f, 0.f, 0.f, 0.f};
        for (int st = 0; st < NCH; st += 4) {
            int ck[4]; u32x2 L[4]; f32x4 dc[4];
#pragma unroll
            for (int q = 0; q < 4; ++q) { const int s = st + q; ck[q] = dir ? (s < 4 ? 3 - s : NCH + 3 - s) : s;
                L[q] = *(const u32x2*)(base + (size_t)ck[q] * 32768); dc[q] = *(const f32x4*)(dbase + (size_t)ck[q] * 128); }
#pragma unroll
            for (int q = 0; q < 4; ++q) { u32x2 w; w.x = cvt_pk_bf16(S[0], S[1]); w.y = cvt_pk_bf16(S[2], S[3]);
                *(u32x2*)(base + (size_t)ck[q] * 32768) = w;
                S[0] = dc[q][0] * S[0] + bflo(L[q].x); S[1] = dc[q][1] * S[1] + bfhi(L[q].x); S[2] = dc[q][2] * S[2] + bflo(L[q].y); S[3] = dc[q][3] * S[3] + bfhi(L[q].y); }
        }
    }
}

__device__ __forceinline__ void phase_gla_out(const Ctx& C, int l, int rot) {
    const bf16_t* P = WSP(bf16_t, WS_P); const bf16_t* GST = WSP(bf16_t, WS_GST); unsigned char* OL = C.ws + WS_OL;
    LAS float* lr = (LAS float*)C.lds;
    LAS float* segtot = (LAS float*)(C.lds + 8192);
    LAS bf16_t* QT = (LAS bf16_t*)(C.lds + 10240);
    LAS bf16_t* KT = (LAS bf16_t*)(C.lds + 27648);
    LAS bf16_t* VT = (LAS bf16_t*)(C.lds + 45056);
    LAS bf16_t* SCm = (LAS bf16_t*)(C.lds + 81920);
    LAS float* OB = (LAS float*)(C.lds + 91136);
    LAS float* CUM = OB;
    const float* gon = INP(I_ONG) + l * 256;
    const int r32 = C.lane & 31, hi = C.lane >> 5;
    const int btk = C.tid >> 3, bdg = (C.tid & 7) * 16;
    for (int unit = (C.bid + C.G - rot % C.G) % C.G; unit < NBATCH * 4 * NCH; unit += C.G) {
        const int b = unit / (4 * NCH), h = (unit / NCH) % 4, ck = unit % NCH; const size_t r0 = (size_t)b * RPB + ck * 64;
        for (int i = C.tid; i < 64 * 32; i += NTHREADS) lr[i] = bf2f(P[(r0 + (i >> 5)) * NP + C_LRF + (i & 31)]);
        const bf16_t* qp = P + (r0 + btk) * NP + C_LQ + h * 128 + bdg; const bf16_t* kp = P + (r0 + btk) * NP + C_LK + h * 128 + bdg;
        const u32x4 qw0 = *(const u32x4*)qp, qw1 = *(const u32x4*)(qp + 8), kw0 = *(const u32x4*)kp, kw1 = *(const u32x4*)(kp + 8);
        gla_build_vt(C, P, r0, h, VT);
        __syncthreads();
        f32x16 oacc[2] = {};
#pragma unroll 1
        for (int dir = 0; dir < 2; ++dir) {
            gla_cumsum_lds(C, l, h, dir, lr, segtot, CUM);
            { float qf[8], kf[8];
#pragma unroll
              for (int hh = 0; hh < 2; ++hh) { unpack8(hh ? qw1 : qw0, qf); unpack8(hh ? kw1 : kw0, kf);
                  const f32x4 c0 = *(const LAS f32x4*)(CUM + btk * 132 + bdg + 8 * hh), c1 = *(const LAS f32x4*)(CUM + btk * 132 + bdg + 8 * hh + 4);
                  float qo[8], ko[8];
#pragma unroll
                  for (int i = 0; i < 8; ++i) { const float cm = i < 4 ? c0[i & 3] : c1[i & 3]; qo[i] = qf[i] * __expf(cm) * 0.088388347648318440f; ko[i] = kf[i] * __expf(-cm); }
                  u32x4 wq, wk; wq.x = cvt_pk_bf16(qo[0], qo[1]); wq.y = cvt_pk_bf16(qo[2], qo[3]); wq.z = cvt_pk_bf16(qo[4], qo[5]); wq.w = cvt_pk_bf16(qo[6], qo[7]);
                  wk.x = cvt_pk_bf16(ko[0], ko[1]); wk.y = cvt_pk_bf16(ko[2], ko[3]); wk.z = cvt_pk_bf16(ko[4], ko[5]); wk.w = cvt_pk_bf16(ko[6], ko[7]);
                  *(LAS u32x4*)(QT + btk * 136 + bdg + 8 * hh) = wq; *(LAS u32x4*)(KT + btk * 136 + bdg + 8 * hh) = wk; } }
            __syncthreads();
            if (C.wid < 4) { const int mt = C.wid >> 1, nt = C.wid & 1; f32x16 sc = {};
                mma_xy<8>(sc, QT + (mt * 32 + r32) * 136, KT + (nt * 32 + r32) * 136, hi);
#pragma unroll
                for (int i = 0; i < 16; ++i) { const int t = mt * 32 + att::crow(i, hi), sx_ = nt * 32 + r32; const bool keep = dir ? (sx_ >= t) : (sx_ <= t);
                    SCm[t * 72 + sx_] = f2bf(keep ? sc[i] : 0.f); } }
            __syncthreads();
            { const bf16_t* st = GST + ((size_t)gla_sidx(b, dir, h) * NCH + ck) * 32768 + (size_t)(C.wid * 32 + r32) * 128 + hi * 8;
              bf16x8 sb[8];
#pragma unroll
              for (int ks = 0; ks < 8; ++ks) sb[ks] = *(const bf16x8*)(st + ks * 16);
#pragma unroll
              for (int mt = 0; mt < 2; ++mt) {
                  mma_xy<4>(oacc[mt], SCm + (mt * 32 + r32) * 72, VT + (C.wid * 32 + r32) * 72, hi);
#pragma unroll
                  for (int ks = 0; ks < 8; ++ks) { const bf16x8 a = *(const LAS bf16x8*)(QT + (mt * 32 + r32) * 136 + ks * 16 + hi * 8);
                      oacc[mt] = __builtin_amdgcn_mfma_f32_32x32x16_bf16(a, sb[ks], oacc[mt], 0, 0, 0); } } }
            __syncthreads();
        }
#pragma unroll
        for (int mt = 0; mt < 2; ++mt)
#pragma unroll
            for (int i = 0; i < 16; ++i) OB[(mt * 32 + att::crow(i, hi)) * 260 + C.wid * 32 + r32] = oacc[mt][i];
        __syncthreads();
        { const int t = C.tid >> 3, part = C.tid & 7; f32x4 v[8]; float ss = 0.f;
#pragma unroll
          for (int jj = 0; jj < 8; ++jj) { v[jj] = *(const LAS f32x4*)(OB + t * 260 + jj * 32 + part * 4); ss += v[jj][0] * v[jj][0] + v[jj][1] * v[jj][1] + v[jj][2] * v[jj][2] + v[jj][3] * v[jj][3]; }
          ss += dppmov<DPP_HMIRROR>(ss); ss += dppmov<DPP_Q3210>(ss); ss += dppmov<DPP_Q1032>(ss);
          const float rs = rsqrtf(ss * (1.0f / 256.0f) + NORM_EPS);
#pragma unroll
          for (int jj = 0; jj < 8; ++jj) { const int e = jj * 32 + part * 4; const f32x4 g = *(const f32x4*)(gon + e);
              const u32x2 gt = *(const u32x2*)(P + (r0 + t) * NP + C_LG + h * 256 + e);
              const float o0 = v[jj][0] * rs * g[0] * siluf_(bflo(gt.x)), o1 = v[jj][1] * rs * g[1] * siluf_(bfhi(gt.x)), o2 = v[jj][2] * rs * g[2] * siluf_(bflo(gt.y)), o3 = v[jj][3] * rs * g[3] * siluf_(bfhi(gt.y));
              int p8 = __builtin_amdgcn_cvt_pk_fp8_f32(o0, o1, 0, false); p8 = __builtin_amdgcn_cvt_pk_fp8_f32(o2, o3, p8, true);
              *(unsigned*)(OL + (r0 + t) * 1024 + h * 256 + e) = (unsigned)p8; } }
        __syncthreads();
    }
}

__device__ __forceinline__ unsigned f_ord(float f) { const unsigned u = __float_as_uint(f); return u ^ ((unsigned)((int)u >> 31) | 0x80000000u); }
__device__ __forceinline__ float f_unord(unsigned k) { return __uint_as_float((k & 0x80000000u) ? (k ^ 0x80000000u) : ~k); }
__device__ __forceinline__ void ins_u(unsigned (&L)[16], unsigned x) {
#pragma unroll
    for (int j = 0; j < 16; ++j) { const unsigned h = L[j] > x ? L[j] : x; x = L[j] > x ? x : L[j]; L[j] = h; }
}
__device__ __forceinline__ void ins_f(float (&M)[16], float x) {
#pragma unroll
    for (int j = 0; j < 16; ++j) { const float h = M[j] > x ? M[j] : x; x = M[j] > x ? x : M[j]; M[j] = h; }
}
__device__ __forceinline__ void peer_top16(const bf16_t* __restrict__ qrow, const bf16_t* __restrict__ keys, int r32, int hi, unsigned (&L)[16]) {
    bf16x8 qf[8];
#pragma unroll
    for (int kk = 0; kk < 8; ++kk) qf[kk] = *(const bf16x8*)(qrow + kk * 16 + hi * 8);
#pragma unroll
    for (int j = 0; j < 16; ++j) L[j] = 0u;
    bf16x8 kA[8], kB[8];
    const bf16_t* kl = keys + (size_t)r32 * 128 + hi * 8;
#define PT_LDK(dst, mt) do { _Pragma("unroll") for (int kk = 0; kk < 8; ++kk) dst[kk] = *(const bf16x8*)(kl + (mt) * 32 * 128 + kk * 16); } while (0)
#define PT_PROC(src, mt) do { f32x16 acc = {}; \
        _Pragma("unroll") for (int kk = 0; kk < 8; ++kk) acc = __builtin_amdgcn_mfma_f32_32x32x16_bf16(src[kk], qf[kk], acc, 0, 0, 0); \
        _Pragma("unroll") for (int i = 0; i < 16; ++i) { const unsigned kidx = (unsigned)((mt) * 32 + att::crow(i, hi)); ins_u(L, (f_ord(acc[i]) & ~127u) | (127u - kidx)); } } while (0)
    PT_LDK(kA, 0);
#pragma unroll 1
    for (int mp = 0; mp < 2; ++mp) { PT_LDK(kB, 2 * mp + 1); PT_PROC(kA, 2 * mp); if (mp == 0) PT_LDK(kA, 2); PT_PROC(kB, 2 * mp + 1); }
#undef PT_LDK
#undef PT_PROC
    unsigned Pn[16];
#pragma unroll
    for (int j = 0; j < 16; ++j) { auto r_ = __builtin_amdgcn_permlane32_swap(L[j], L[j], false, false); Pn[j] = hi ? r_[0] : r_[1]; }
#pragma unroll
    for (int j = 0; j < 16; ++j) ins_u(L, Pn[j]);
}
__device__ __forceinline__ void phase_peer_select(const Ctx& C, const bool latent_only) {
    const bf16_t* PQ = WSP(bf16_t, WS_PQ); const bf16_t* K1 = WSP(bf16_t, WS_K1); const bf16_t* K2 = WSP(bf16_t, WS_K2);
    int* PIDX = WSP(int, WS_PIDX); float* PG = WSP(float, WS_PG);
    const int r32 = C.lane & 31, hi = C.lane >> 5, head = C.wid;
    const int ngrp = latent_only ? NBATCH * SEQ / 32 : TT / 32;
    for (int gi = C.bid; gi < ngrp; gi += C.G) {
        const int grp = latent_only ? gi + (CTXL / 32) * (1 + gi / (SEQ / 32)) : gi;
        const size_t tok = (size_t)grp * 32 + r32;
        unsigned L1[16], L2[16];
        peer_top16(PQ + tok * DM + head * 256, K1 + (size_t)head * 128 * 128, r32, hi, L1);
        peer_top16(PQ + tok * DM + head * 256 + 128, K2 + (size_t)head * 128 * 128, r32, hi, L2);
        float v1[16], v2[16];
#pragma unroll
        for (int j = 0; j < 16; ++j) { v1[j] = f_unord(L1[j] & ~127u); v2[j] = f_unord(L2[j] & ~127u); }
        float M[16];
#pragma unroll
        for (int j = 0; j < 16; ++j) M[j] = -3.0e38f;
#pragma unroll
        for (int a = 0; a < 16; ++a)
#pragma unroll
            for (int b = 0; b < 16; ++b) if ((a + 1) * (b + 1) <= 16) ins_f(M, v1[a] + v2[b]);
        const float thr = M[15], mx = M[0]; float den = 0.f;
#pragma unroll
        for (int j = 0; j < 16; ++j) den += __expf(M[j] - mx);
        const float rden = 1.0f / den;
        int pos = 0; int* ip = PIDX + tok * 128 + head * 16; float* gp = PG + tok * 128 + head * 16;
#pragma unroll
        for (int a = 0; a < 16; ++a)
#pragma unroll
            for (int b = 0; b < 16; ++b) if ((a + 1) * (b + 1) <= 16) {
                const float val = v1[a] + v2[b];
                if (val >= thr && pos < 16) { if (hi == 0) { ip[pos] = (int)((127u - (L1[a] & 127u)) * 128u + (127u - (L2[b] & 127u))); gp[pos] = __expf(val - mx) * rden; } ++pos; } }
    }
}
template <int OFF> __device__ __forceinline__ float dotf8(const float (&h)[32], const u32x4 w, float acc) {
#pragma unroll
    for (int j = 0; j < 4; ++j) { const f32x2 lo = __builtin_amdgcn_cvt_pk_f32_fp8((int)w[j], false), hi = __builtin_amdgcn_cvt_pk_f32_fp8((int)w[j], true);
        acc += h[OFF + 4 * j] * lo.x; acc += h[OFF + 4 * j + 1] * lo.y; acc += h[OFF + 4 * j + 2] * hi.x; acc += h[OFF + 4 * j + 3] * hi.y; }
    return acc;
}
constexpr float ATT_O8_SCALE = 32.0f;
constexpr int GT_MAXTOK = 9;
template <bool LAST> __device__ __forceinline__ void phase_peer_gather(const Ctx& C, const float* modl, const float pscale) {
    const unsigned char* pt = C.ws + WS_PT + (size_t)(LAST ? DEPTH - 1 : 0) * PT_BYTES;
    const bf16_t* HB = WSP(bf16_t, WS_HB); const unsigned char* U8 = pt + PT_U8; const unsigned char* V8 = pt + PT_V8;
    const float* SCU = (const float*)(pt + PT_SCU); const float* SCV = (const float*)(pt + PT_SCV);
    const int* PIDX = WSP(int, WS_PIDX); const float* PG = WSP(float, WS_PG); float* XS = WSP(float, WS_XS);
    const int lane = C.lane, s = lane >> 3, j = lane & 7; const unsigned j16 = (unsigned)j * 16u;
    LAS int* IDS = (LAS int*)(C.lds + C.wid * (GT_MAXTOK * 512));
    LAS float* ACT = (LAS float*)(C.lds + 8 * GT_MAXTOK * 512 + C.wid * (GT_MAXTOK * 512));
    LAS int* ROWS = (LAS int*)(C.lds + 16 * GT_MAXTOK * 512 + C.wid * 64);
    int nk = 0;
    {
      const int per = (TT + C.G - 1) / C.G, base = C.bid * per;
#pragma unroll 1
      for (int k = 0; k < GT_MAXTOK; ++k) { const int o = C.wid + 8 * k; const int r = base + o; if (o < per && r < TT && !(LAST && (r % RPB) < CTXL)) { if (lane == 0) ROWS[nk] = r; ++nk; } } }
#define GT_ROW(k) __builtin_amdgcn_readfirstlane(ROWS[k])
#pragma unroll 1
    for (int k = 0; k < nk; ++k) { const int r = GT_ROW(k);
        IDS[k * 128 + lane] = (PIDX[(size_t)r * 128 + lane] & (NEXP - 1)) << 7; IDS[k * 128 + 64 + lane] = (PIDX[(size_t)r * 128 + 64 + lane] & (NEXP - 1)) << 7;
        ACT[k * 128 + lane] = 0.f; ACT[k * 128 + 64 + lane] = 0.f; }
    const int nit = 32 * nk;
#define GT_ITEM(it_) const int cb_ = (it_) / (2 * nk), rem_ = (it_) - cb_ * (2 * nk), k_ = rem_ >> 1, hf_ = rem_ & 1
#define GT_LOADU(UQ, HQ, it_) do { GT_ITEM(it_); const int r_ = GT_ROW(k_); \
        const bf16_t* hp_ = HB + (size_t)r_ * DM + cb_ * 128 + j * 16; HQ[0] = *(const u32x4*)hp_; HQ[1] = *(const u32x4*)(hp_ + 8); \
        const unsigned char* ub_ = U8 + (size_t)cb_ * ((size_t)NEXP * 128);     \
        _Pragma("unroll") for (int eg = 0; eg < 8; ++eg) { const unsigned off_ = ((unsigned)IDS[k_ * 128 + (hf_ * 8 + eg) * 8 + s] & idmask) + j16; UQ[eg] = *(const u32x4*)(ub_ + off_); } } while (0)
#define GT_COMPU(UQ, HQ, it_) do { GT_ITEM(it_); (void)cb_; f32x2 hf2[8]; \
        _Pragma("unroll") for (int hh = 0; hh < 2; ++hh) { const u32x4 w_ = HQ[hh]; \
            hf2[hh * 4 + 0] = (f32x2){bflo(w_.x), bfhi(w_.x)}; hf2[hh * 4 + 1] = (f32x2){bflo(w_.y), bfhi(w_.y)}; hf2[hh * 4 + 2] = (f32x2){bflo(w_.z), bfhi(w_.z)}; hf2[hh * 4 + 3] = (f32x2){bflo(w_.w), bfhi(w_.w)}; } \
        float d[8]; \
        _Pragma("unroll") for (int eg = 0; eg < 8; ++eg) { f32x2 d2 = (f32x2){0.f, 0.f}; \
            _Pragma("unroll") for (int q = 0; q < 4; ++q) { const f32x2 lo = __builtin_amdgcn_cvt_pk_f32_fp8((int)UQ[eg][q], false), hi = __builtin_amdgcn_cvt_pk_f32_fp8((int)UQ[eg][q], true); \
                d2 += hf2[2 * q] * lo; d2 += hf2[2 * q + 1] * hi; } \
            d[eg] = d2.x + d2.y; } \
          \
        float t4[4], t2[2], t1; \
        _Pragma("unroll") for (int i = 0; i < 4; ++i) { const float snd = (j & 4) ? d[i] : d[i + 4], kp = (j & 4) ? d[i + 4] : d[i]; t4[i] = kp + dppmov<DPP_HMIRROR>(snd); } \
        _Pragma("unroll") for (int i = 0; i < 2; ++i) { const float snd = (j & 2) ? t4[i] : t4[i + 2], kp = (j & 2) ? t4[i + 2] : t4[i]; t2[i] = kp + dppmov<DPP_Q3210>(snd); } \
        { const float snd = (j & 1) ? t2[0] : t2[1], kp = (j & 1) ? t2[1] : t2[0]; t1 = kp + dppmov<DPP_Q1032>(snd); } \
        ACT[k_ * 128 + (hf_ * 8 + j) * 8 + s] += t1; } while (0)
#ifdef DBG_GDUP
#pragma unroll 1
    for (int rep_ = 0; rep_ < 2; ++rep_) {
    const unsigned idmask = rep_ == 0 ? ((unsigned)DBG_GMASK << 7 | 127u) : 0xffffffffu;
    if (rep_ == 1) { for (int k = 0; k < nk; ++k) { ACT[k * 128 + lane] = 0.f; ACT[k * 128 + 64 + lane] = 0.f; } }
#else
    { const unsigned idmask = 0xffffffffu;
#endif
    if (nit > 0) {
        u32x4 uA[8], uB[8], hA[2], hB[2];
        GT_LOADU(uA, hA, 0);
#pragma unroll 1
        for (int it = 0; it < nit; it += 2) {
            GT_LOADU(uB, hB, it + 1);
            GT_COMPU(uA, hA, it);
            if (it + 2 < nit) GT_LOADU(uA, hA, it + 2);
            GT_COMPU(uB, hB, it + 1);
        }
    }
    }
#undef GT_LOADU
#undef GT_COMPU
#pragma unroll 1
    for (int k = 0; k < nk; ++k) { const int r = GT_ROW(k);
#pragma unroll
        for (int hh = 0; hh < 2; ++hh) { const int e = hh * 64 + lane; const int id = IDS[k * 128 + e] >> 7; const float a = ACT[k * 128 + e] * SCU[id];
            const float w = PG[(size_t)r * 128 + e] * 0.5f * a * (1.0f + erff(a * 0.70710678118654752f));
#if defined(DBG_CHECK) && (DBG_CHECK == 3 || DBG_CHECK == 4)
            if (((r - 300) & 63) == 0 && r >= 300 && r < 300 + 64 * 128) WSP(float, WS_OM)[(size_t)r * 128 + e] = w;
#endif
            ACT[k * 128 + e] = w * SCV[id]; } }
#define GT_LOADV(VQ, WV, it_) do { GT_ITEM(it_); const unsigned char* vb_ = V8 + (size_t)cb_ * ((size_t)NEXP * 128); \
        _Pragma("unroll") for (int eg = 0; eg < 8; ++eg) { const int e_ = k_ * 128 + (hf_ * 8 + eg) * 8 + s; const unsigned off_ = (unsigned)IDS[e_] + j16; VQ[eg] = *(const u32x4*)(vb_ + off_); WV[eg] = ACT[e_]; } } while (0)
#define GT_COMPV(VQ, WV) do { \
        _Pragma("unroll") for (int eg = 0; eg < 8; ++eg) { const f32x2 w2_ = (f32x2){WV[eg], WV[eg]}; \
            _Pragma("unroll") for (int q = 0; q < 4; ++q) { \
                const f32x2 lo = __builtin_amdgcn_cvt_pk_f32_fp8((int)VQ[eg][q], false), hi = __builtin_amdgcn_cvt_pk_f32_fp8((int)VQ[eg][q], true); \
                acc2[2 * q] += w2_ * lo; acc2[2 * q + 1] += w2_ * hi; } } } while (0)
    if (nit > 0) {
        u32x4 vA[8], vB[8]; float wA[8], wB[8];
        GT_LOADV(vA, wA, 0);
#pragma unroll 1
        for (int it = 0; it < nit; it += 2) {
            f32x2 acc2[8];
#pragma unroll
            for (int i = 0; i < 8; ++i) acc2[i] = (f32x2){0.f, 0.f};
            GT_LOADV(vB, wB, it + 1);
            GT_COMPV(vA, wA);
            if (it + 2 < nit) GT_LOADV(vA, wA, it + 2);
            GT_COMPV(vB, wB);
            f32x2 t4[4], t2[2], t1;
#pragma unroll
            for (int i = 0; i < 4; ++i) { const f32x2 snd = (s & 4) ? acc2[i] : acc2[i + 4], kp = (s & 4) ? acc2[i + 4] : acc2[i];
                t4[i] = kp + (f32x2){xchg32(snd.x, lane), xchg32(snd.y, lane)}; }
#pragma unroll
            for (int i = 0; i < 2; ++i) { const f32x2 snd = (s & 2) ? t4[i] : t4[i + 2], kp = (s & 2) ? t4[i + 2] : t4[i];
                t2[i] = kp + (f32x2){xchg16(snd.x, lane), xchg16(snd.y, lane)}; }
            { const f32x2 snd = (s & 1) ? t2[0] : t2[1], kp = (s & 1) ? t2[1] : t2[0]; t1 = kp + (f32x2){dppmov<DPP_ROR8>(snd.x), dppmov<DPP_ROR8>(snd.y)}; }
            { GT_ITEM(it); (void)hf_; const int r_ = GT_ROW(k_);
              const int col = cb_ * 128 + j * 16 + 2 * s; float* xp = XS + (size_t)r_ * DM + col; const float* g2 = modl + (size_t)mod_sel(r_) * 12288 + 5 * DM + col;
#if defined(DBG_CHECK) && (DBG_CHECK == 3 || DBG_CHECK == 4)
              if (((r_ - 300) & 63) == 0 && r_ >= 300 && r_ < 300 + 64 * 128) { float* dbgo = WSP(float, WS_MQ) + (size_t)r_ * DM + col; dbgo[0] = t1.x; dbgo[1] = t1.y; }
#endif
              const f32x2 x = *(const f32x2*)xp, g = *(const f32x2*)g2;
              *(f32x2*)xp = x + pscale * g * t1; }
        }
    }
#undef GT_LOADV
#undef GT_COMPV
#undef GT_ITEM
#undef GT_ROW
}
__device__ __forceinline__ void phase_final_norm(const Ctx& C) {
    const float* XS = WSP(float, WS_XS); const float* fg = INP(I_FG);
    for (int q = C.bid * 8 + C.wid; q < NBATCH * SEQ; q += C.G * 8) {
        const int b = q / SEQ, t = q % SEQ; const float* xr = XS + ((size_t)b * RPB + CTXL + t) * DM; float* op = C.out + (size_t)q * DM;
        f32x4 v[8]; float ss = 0.f;
#pragma unroll
        for (int c = 0; c < 8; ++c) { v[c] = *(const f32x4*)(xr + c * 256 + C.lane * 4); ss += v[c][0] * v[c][0] + v[c][1] * v[c][1] + v[c][2] * v[c][2] + v[c][3] * v[c][3]; }
        ss = wave_sum(ss); const float rs = rsqrtf(ss * (1.0f / DM) + NORM_EPS);
#pragma unroll
        for (int c = 0; c < 8; ++c) { const f32x4 g = *(const f32x4*)(fg + c * 256 + C.lane * 4); *(f32x4*)(op + c * 256 + C.lane * 4) = v[c] * rs * g; }
    }
}

template <int TYPE  , int VAR = 0> __device__ __forceinline__ void attn_units(const Ctx& C, bool need_ctx) {
    const bf16_t* P = WSP(bf16_t, WS_P);
    const int nu = need_ctx ? 528 : 512;
#pragma unroll 1
    for (int u = C.bid; u < nu; u += C.G) {
        int bh, qb; if (u < 512) { bh = (u >> 8) * 8 + (u & 7); qb = ((u & 255) >> 3) + 1; } else { bh = u - 512; qb = 0; }
        const int b = bh >> 3, h = bh & 7; const size_t rq = (size_t)b * RPB + (size_t)qb * 256, rk = (size_t)b * RPB; const int seq = qb == 0 ? CTXL : RPB;
        __syncthreads();
        if constexpr (TYPE == 1) {
            att::attn_body8<128>(P + rq * NP + C_AQ + h * 128, NP, C.ws + WS_AK8 + rk * 256 + (h >> 2) * 128, 256, nullptr, 0, P + rk * NP + C_AV + (h >> 2) * 128, NP,
                                 C.ws + WS_OA + rq * 1024 + h * 128, 1024, seq, false, 0, nullptr, (char*)C.lds, C.tid);
        } else {
            const bf16_t* MQ = WSP(bf16_t, WS_MQ); const bf16_t* MKV = WSP(bf16_t, WS_MKV);
            att::attn_body8<192>(MQ + rq * 1536 + h * 192, 1536, C.ws + WS_KN8 + rk * 1024 + h * 128, 1024, C.ws + WS_KR8 + rk * 64, 64, MKV + rk * 2048 + h * 256 + 128, 2048,
                                 C.ws + WS_OM + rq * 1024 + h * 128, 1024, seq, qb > 0, (qb - 1) * 256, WSP(float, WS_TABM), (char*)C.lds, C.tid);
        }
    }
    __syncthreads();
}

constexpr int LDS_BYTES = 163840, LDS_BAR_OFF = LDS_BYTES - 16;
constexpr int N_PHASES = 26;
template <int K> __device__ __forceinline__ void run_phase(const Ctx& C0, int l) {
    const Ctx C = launder(C0);
    const float* modl = WSP(float, WS_MODV) + (size_t)l * 3 * 12288;
    if constexpr (K == 0) { phase_modv(C); phase_tables(C); __syncthreads(); phase_cvt_mixer_weights(C, 0); }
    if constexpr (K == 1) {
        if (l == 0) phase_norm_mod<true, true>(C, INP(I_N1G), modl, 0, DM);
        else { phase_norm_mod<false, true>(C, INP(I_N1G) + l * DM, modl, 0, DM); __syncthreads(); phase_cvt_mixer_weights(C, l); }
    }
    if constexpr (K == 2) {
        pg8::Gemm g{WSP(bf16_t, WS_HB), WSP(bf16_t, WS_WIN), TT, NP, DM, DM, DM}; pg8::WinOrder S; S.init(C.G, C.bid, l + 1 < DEPTH);
        pg8::EpiStoreBf16S E{WSP(bf16_t, WS_P), NP, WSP(float, WS_WINS)};
        pg8::gemm_phase<pg8::EpiStoreBf16S, pg8::WinOrder, 1>(C.lds, C.tid, g, S, E);
    }
    if constexpr (K == 3) phase_post_p(C, l);
    if constexpr (K == 4) {
        { pg8::Gemm g{WSP(bf16_t, WS_P) + C_MCQ, WSP(bf16_t, WS_WUQ), TT, 1536, 512, NP, 512}; pg8::StaticOrder S; S.init(TT, 1536, C.G, C.bid);
          pg8::EpiStoreBf16 E{WSP(bf16_t, WS_MQ), 1536}; pg8::gemm_phase(C.lds, C.tid, g, S, E); }
        { pg8::Gemm g{WSP(bf16_t, WS_P) + C_MCKV, WSP(bf16_t, WS_WUKV), TT, 2048, 512, NP, 512}; pg8::StaticOrder S; S.init(TT, 2048, C.G, (C.bid + C.G - 140 % C.G) % C.G);
          pg8::EpiStoreMKV E{WSP(bf16_t, WS_MKV), C.ws + WS_KN8}; pg8::gemm_phase(C.lds, C.tid, g, S, E); }
        { const Ctx C2 = launder(C0); phase_gla_local(C2, l, 156); }
#ifdef DBG_DUP_GLALOCAL
        { const Ctx C2 = launder(C0); __syncthreads(); phase_gla_local(C2, l, 156); }
#endif
    }
    if constexpr (K == 5) phase_gla_scan(C);
    if constexpr (K == 6) {
#ifdef DBG_ATTVAR
        { const Ctx Cx = launder(C0); attn_units<0, DBG_ATTVAR>(Cx, l + 1 < DEPTH); } { const Ctx Cx = launder(C0); attn_units<1, DBG_ATTVAR>(Cx, l + 1 < DEPTH); } __syncthreads();
#endif
        attn_units<0>(C, l + 1 < DEPTH); { const Ctx C2 = launder(C0); attn_units<1>(C2, l + 1 < DEPTH); } { const Ctx C3 = launder(C0); phase_gla_out(C3, l, 128); }
#ifdef DBG_DUP_GLAOUT
        { const Ctx C3 = launder(C0); __syncthreads(); phase_gla_out(C3, l, 128); }
#endif
    }
    if constexpr (K == 7) {
        const bf16_t* P = WSP(bf16_t, WS_P); bf16_t* Y = WSP(bf16_t, WS_Y);
        const pg8::Gemm ga{WSP(bf16_t, WS_OA), WSP(bf16_t, WS_WBR), TT, DM, 1024, 1024, 1024}, gl{WSP(bf16_t, WS_OL), (const bf16_t*)(C.ws + WS_WBR + (size_t)2048 * 1024), TT, DM, 1024, 1024, 1024},
                        gm{WSP(bf16_t, WS_OM), (const bf16_t*)(C.ws + WS_WBR + (size_t)2 * 2048 * 1024), TT, DM, 1024, 1024, 1024};
        unsigned char* Y8 = C.ws + WS_HB;
        const float* wbs = WSP(float, WS_WBRS);
        const pg8::EpiGate<true> Ea{Y, P + C_GA, nullptr, wbs}; const pg8::EpiGate<false> El{Y, P + C_GL, nullptr, wbs + DM}; const pg8::EpiGate<false, true> Em{Y, P + C_GM, Y8, wbs + 2 * DM};
        pg8::StaticOrder S; S.init(TT, DM, C.G, C.bid, l + 1 >= DEPTH);
        pg8::gemm_phase<pg8::EpiGate<true>, pg8::StaticOrder, 1>(C.lds, C.tid, ga, S, Ea); pg8::gemm_phase<pg8::EpiGate<false>, pg8::StaticOrder, 1>(C.lds, C.tid, gl, S, El);
        pg8::gemm_phase<pg8::EpiGate<false, true>, pg8::StaticOrder, 1>(C.lds, C.tid, gm, S, Em);
        if (l == 0) { const Ctx C2 = launder(C0); phase_cvt_peer_tables(C2, 0, 0, NEXP, S.nwg % C.G); }
    }
    if constexpr (K == 8) {
        pg8::Gemm g{WSP(bf16_t, WS_HB), WSP(bf16_t, WS_WOUT), TT, DM, DM, DM, DM};
        const pg8::EpiResidT<true> E{WSP(float, WS_XS), DM, modl + 2 * DM, WSP(float, WS_WOUTS)};
        pg8::StaticOrder S; S.init(TT, DM, C.G, C.bid, l + 1 >= DEPTH);
        pg8::gemm_phase<pg8::EpiResidT<true>, pg8::StaticOrder, 1>(C.lds, C.tid, g, S, E);
        if (l == 0 && DEPTH > 1) { const Ctx C2 = launder(C0); phase_cvt_peer_tables(C2, 1, 0, NEXP / 2, S.nwg % C.G); }
    }
    if constexpr (K == 9) phase_norm_mod<false>(C, INP(I_N2G) + l * DM, modl, 3 * DM, 4 * DM);
    if constexpr (K == 10) {
        pg8::Gemm g{WSP(bf16_t, WS_HB), WSP(bf16_t, WS_WQ), TT, DM, DM, DM, DM};
        pg8::EpiStoreBf16 E{WSP(bf16_t, WS_PQ), DM};
        pg8::StaticOrder S; S.init(TT, DM, C.G, C.bid, l + 1 >= DEPTH); pg8::gemm_phase(C.lds, C.tid, g, S, E);
        if (l == 0 && DEPTH > 1) { const Ctx C2 = launder(C0); phase_cvt_peer_tables(C2, 1, NEXP / 2, NEXP, S.nwg % C.G); }
    }
    if constexpr (K == 11) phase_peer_select(C, l + 1 >= DEPTH);
    if constexpr (K == 13) phase_final_norm(C);
    if constexpr (K == 12) {
#ifdef DBG_DUP12
        if (l + 1 < DEPTH) phase_peer_gather<false>(C, modl, 0.0f); else phase_peer_gather<true>(C, modl, 0.0f);
        __syncthreads();
#endif
        if (l + 1 < DEPTH) phase_peer_gather<false>(C, modl, DBG_PEER0); else phase_peer_gather<true>(C, modl, DBG_PEER1); }
}
__device__ __forceinline__ Ctx make_ctx(const Args& args, unsigned char* lds_raw) {
    Ctx C0; C0.in = (const __attribute__((address_space(4))) cfp_t*)__builtin_amdgcn_kernarg_segment_ptr(); C0.out = args.out; C0.ws = args.ws; C0.lds = (LAS unsigned char*)lds_raw;
    C0.tid = threadIdx.x; C0.lane = C0.tid & 63; C0.wid = __builtin_amdgcn_readfirstlane(C0.tid >> 6); C0.G = gridDim.x; C0.bid = blockIdx.x;
    return C0;
}
template <int K> __global__ void __launch_bounds__(NTHREADS, 2) k_one(Args args) {
    extern __shared__ __attribute__((aligned(16))) unsigned char lds_raw[];
    const Ctx C0 = make_ctx(args, lds_raw);
    run_phase<K>(C0, args.ph_lo);
}
#if MK_N_LAUNCHES == 1 || defined(DBG_HYB)
__global__ void __launch_bounds__(NTHREADS, 2) mk_fwd(Args args) {
    extern __shared__ __attribute__((aligned(16))) unsigned char lds_raw[];
    const Ctx C0 = make_ctx(args, lds_raw);
    if (C0.tid < 4) ((LAS unsigned*)(C0.lds + LDS_BAR_OFF))[C0.tid] = 0u;
    __syncthreads();
    const int lo = args.ph_lo, hi = args.ph_hi;
    XcdBarrier bar; bar.bar = (unsigned*)(args.ws + WS_CTL); bar.x = 0; bar.st = nullptr;
    if (hi - lo > 1) bar = xcd_barrier_post((unsigned*)(args.ws + WS_CTL), (volatile LAS unsigned*)(C0.lds + LDS_BAR_OFF));
#define IN(k) (lo <= (k) && (k) < hi)
#define SEAM(k) do { if (IN(k) && IN((k) + 1)) xcd_barrier(bar); } while (0)
#ifndef DBG_DUP
#define DBG_DUP -1
#endif
#define PH(K, k) do { if (IN(k)) { run_phase<K>(C0, l); if (K == DBG_DUP) { xcd_barrier(bar); run_phase<K>(C0, l); } } SEAM(k); } while (0)
    { const int l = 0; PH(0, 0); }
#pragma unroll 1
    for (int l = 0; l < DEPTH; ++l) {
        const int pb = 1 + 12 * l;
        PH(1, pb + 0); PH(2, pb + 1); PH(3, pb + 2); PH(4, pb + 3); PH(5, pb + 4); PH(6, pb + 5);
        PH(7, pb + 6); PH(8, pb + 7); PH(9, pb + 8); PH(10, pb + 9); PH(11, pb + 10); PH(12, pb + 11);
    }
    { const int l = DEPTH - 1; PH(13, 1 + 12 * DEPTH); }
#undef PH
#undef IN
#undef SEAM
}
#define MAIN_KERNEL mk_fwd
#else
#define MAIN_KERNEL k_one<6>
#endif


#ifdef DBG_PROBE
typedef int i32x8 __attribute__((ext_vector_type(8)));
__device__ __forceinline__ unsigned char fp8_of_int(int v) {
    const float f = (float)v; return (unsigned char)(__builtin_amdgcn_cvt_pk_fp8_f32(f, 0.f, 0, false) & 0xff); }
__global__ void k_probe_mx(unsigned* slot) {
    const int l = threadIdx.x, r = l & 31, g = l >> 5;
    i32x8 A, B;
    for (int j = 0; j < 8; ++j) { unsigned wa = 0, wb = 0;
        for (int b = 0; b < 4; ++b) { const int k = g * 32 + 4 * j + b;
            wa |= (unsigned)fp8_of_int(((3 * r + k) % 7) - 3) << (8 * b); wb |= (unsigned)fp8_of_int(((5 * k + 2 * r) % 9) - 4) << (8 * b); }
        A[j] = (int)wa; B[j] = (int)wb; }
    f32x16 c = {};
    c = __builtin_amdgcn_mfma_scale_f32_32x32x64_f8f6f4(A, B, c, 0, 0, 0, 0x7f7f7f7f, 0, 0x7f7f7f7f);
    float worst = 0.f;
    for (int i = 0; i < 16; ++i) { const int m = (i & 3) + 8 * (i >> 2) + 4 * g, n = r; float ref = 0.f; for (int k = 0; k < 64; ++k) ref += (float)(((3 * m + k) % 7) - 3) * (float)(((5 * k + 2 * n) % 9) - 4);
        worst = fmaxf(worst, fabsf(c[i] - ref)); }
    for (int o = 32; o >= 1; o >>= 1) worst = fmaxf(worst, __shfl_xor(worst, o));
    if (l == 0) { const float code = worst == 0.f ? 0.4f : 1.2f; *slot = __float_as_uint(powf(10.f, code / 0.25f - 4.f)); }
}
#endif
#ifdef DBG_CHECK
__device__ __forceinline__ void dbg_report(unsigned* slot, float err) { if (!(err <= 3e38f)) err = 1e30f; atomicMax(slot, __float_as_uint(err)); }
__global__ void k_check_gemm(const bf16_t* A, int lda, const float* W, int K, int N, const bf16_t* Cm, int ldc, int M, unsigned* slot) {
    const unsigned id = blockIdx.x * blockDim.x + threadIdx.x; if (id >= 8192) return;
    const unsigned h = id * 2654435761u; const int row = (int)((h >> 8) % (unsigned)M), col = (int)((h * 40503u >> 7) % (unsigned)N);
    float ref = 0.f; for (int k = 0; k < K; ++k) ref += bf2f(A[(size_t)row * lda + k]) * W[(size_t)k * N + col];
    const float got = bf2f(Cm[(size_t)row * ldc + col]);
    dbg_report(slot, fabsf(got - ref) / (fabsf(ref) + 0.1f));
}

__global__ void k_check_attn(const unsigned char* ws, int type, unsigned* slot) {
    __shared__ float sc[RPB]; __shared__ float red[256]; __shared__ float qv[192];
    const int t = threadIdx.x, bh = blockIdx.x & 15, b = bh >> 3, h = bh & 7; const int qpos = (int)(((blockIdx.x >> 4) * 977u + 13u) % SEQ); const size_t rq = (size_t)b * RPB + CTXL + qpos, rk = (size_t)b * RPB;
    const bf16_t* P = (const bf16_t*)(ws + WS_P); const bf16_t* MQ = (const bf16_t*)(ws + WS_MQ); const bf16_t* MKV = (const bf16_t*)(ws + WS_MKV);
    const int dq = type ? 128 : 192;
    if (t < dq) { float v = type ? bf2f(P[rq * NP + C_AQ + h * 128 + t]) : bf2f(MQ[rq * 1536 + h * 192 + t]); qv[t] = v; }
    __syncthreads();
    if (!type && t < 32) {
        const int ri = qpos >> 6, ci = qpos & 63; const int i = t; const float pos = (float)(i < 16 ? ri : ci); const float inv = powf(10000.f, -(float)(i & 15) / 16.f); const float a = pos * inv;
        const float x1 = qv[128 + i], x2 = qv[160 + i]; qv[128 + i] = x1 * cosf(a) - x2 * sinf(a); qv[160 + i] = x2 * cosf(a) + x1 * sinf(a); }
    __syncthreads();
    const float scale = type ? 0.088388347648f : 0.0721687836487f;
    float mx = -1e30f;
    for (int k = t; k < RPB; k += 256) { float s = 0.f;
        if (type) { const bf16_t* kp = P + (rk + k) * NP + C_AK + (h >> 2) * 128; for (int d = 0; d < 128; ++d) s += qv[d] * bf2f(kp[d]); }
        else { const bf16_t* kp = MKV + (rk + k) * 2048 + h * 256; for (int d = 0; d < 128; ++d) s += qv[d] * bf2f(kp[d]); const bf16_t* kr = P + (rk + k) * NP + C_MKR; for (int d = 0; d < 64; ++d) s += qv[128 + d] * bf2f(kr[d]); }
        s *= scale; sc[k] = s; mx = fmaxf(mx, s); }
    red[t] = mx; __syncthreads(); for (int o = 128; o >= 1; o >>= 1) { if (t < o) red[t] = fmaxf(red[t], red[t + o]); __syncthreads(); } mx = red[0]; __syncthreads();
    float sum = 0.f; for (int k = t; k < RPB; k += 256) { const float p = __expf(sc[k] - mx); sc[k] = p; sum += p; }
    red[t] = sum; __syncthreads(); for (int o = 128; o >= 1; o >>= 1) { if (t < o) red[t] += red[t + o]; __syncthreads(); } sum = red[0]; __syncthreads();
    float e = 0.f, mag = 0.f;
    if (t < 128) { float o = 0.f; for (int k = 0; k < RPB; ++k) { const float vv = type ? bf2f(P[(rk + k) * NP + C_AV + (h >> 2) * 128 + t]) : bf2f(MKV[(rk + k) * 2048 + h * 256 + 128 + t]); o += sc[k] * vv; }
        o /= sum; const float got = __builtin_amdgcn_cvt_f32_fp8((int)(ws + (type ? WS_OA : WS_OM))[rq * 1024 + h * 128 + t], 0) * (1.0f / 32.0f); e = fabsf(got - o); mag = fabsf(o); }
    red[t] = e; __syncthreads(); for (int o = 128; o >= 1; o >>= 1) { if (t < o) red[t] = fmaxf(red[t], red[t + o]); __syncthreads(); } e = red[0]; __syncthreads();
    red[t] = mag; __syncthreads(); for (int o = 128; o >= 1; o >>= 1) { if (t < o) red[t] = fmaxf(red[t], red[t + o]); __syncthreads(); } mag = red[0];
    if (t == 0) dbg_report(slot, e / (mag + 1e-4f));
}
__global__ void __launch_bounds__(256) k_check_gla_rec(const unsigned char* ws, const float* wa_f, const float* ba_f, const float* wa_b, const float* ba_b, float* obuf, int b) {
    __shared__ float ad[128], kd[128], qd[128], lrs[16];
    const int e = threadIdx.x, h = blockIdx.x & 3, dir = blockIdx.x >> 2; const bf16_t* P = (const bf16_t*)(ws + WS_P);
    const float* wa = dir ? wa_b : wa_f; const float* ba = dir ? ba_b : ba_f;
    float S[128];
#pragma unroll
    for (int d = 0; d < 128; ++d) S[d] = 0.f;
    float* ob = obuf + ((size_t)(dir * 2 + b) * 4 + h) * RPB * 256;
    for (int st = 0; st < RPB; ++st) {
        int j; if (!dir) j = st; else j = st < CTXL ? CTXL - 1 - st : RPB - 1 - (st - CTXL);
        const size_t r = (size_t)b * RPB + j; const bf16_t* pr = P + r * NP;
        if (e < 16) lrs[e] = bf2f(pr[(dir ? C_LRB : C_LRF) + e]);
        __syncthreads();
        if (e < 128) { float pre = ba[h * 128 + e]; for (int q = 0; q < 16; ++q) pre += lrs[q] * wa[q * 512 + h * 128 + e];
            const float ls = (fminf(pre, 0.f) - log1pf(expf(-fabsf(pre)))) / 16.f; ad[e] = expf(ls); kd[e] = bf2f(pr[C_LK + h * 128 + e]); qd[e] = bf2f(pr[C_LQ + h * 128 + e]) * 0.088388347648f; }
        __syncthreads();
        const float v = bf2f(pr[C_LV + h * 256 + e]); float o = 0.f;
#pragma unroll
        for (int d = 0; d < 128; ++d) { S[d] = ad[d] * S[d] + kd[d] * v; o += qd[d] * S[d]; }
        ob[(size_t)j * 256 + e] = o;
        __syncthreads();
    }
}
__global__ void k_check_gla_cmp(const unsigned char* ws, const float* obuf, const float* gon, int b, unsigned* slot) {
    __shared__ float red[256];
    const int e = threadIdx.x, h = blockIdx.x & 3, j = blockIdx.x >> 2; const size_t r = (size_t)b * RPB + j; const bf16_t* P = (const bf16_t*)(ws + WS_P);
    const float o = obuf[((size_t)(0 * 2 + b) * 4 + h) * RPB * 256 + (size_t)j * 256 + e] + obuf[((size_t)(1 * 2 + b) * 4 + h) * RPB * 256 + (size_t)j * 256 + e];
    red[e] = o * o; __syncthreads(); for (int s_ = 128; s_ >= 1; s_ >>= 1) { if (e < s_) red[e] += red[e + s_]; __syncthreads(); }
    const float rs = rsqrtf(red[0] / 256.f + NORM_EPS); __syncthreads();
    const float gt = bf2f(P[r * NP + C_LG + h * 256 + e]); const float ref = o * rs * gon[e] * (gt / (1.f + expf(-gt)));
    const float got = __builtin_amdgcn_cvt_f32_fp8((int)(ws + WS_OL)[r * 1024 + h * 256 + e], 0);
    red[e] = fabsf(got - ref); __syncthreads(); for (int s_ = 128; s_ >= 1; s_ >>= 1) { if (e < s_) red[e] = fmaxf(red[e], red[e + s_]); __syncthreads(); }
    if (e == 0) dbg_report(slot, red[0] / 1.0f);
}

__global__ void k_check_gemm8(const unsigned char* A8, const float* W, int K, int N, const bf16_t* Cm, int ldc, int M, unsigned* slot) {
    const unsigned id = blockIdx.x * blockDim.x + threadIdx.x; if (id >= 8192) return;
    const unsigned h = id * 2654435761u; const int row = (int)((h >> 8) % (unsigned)M), col = (int)((h * 40503u >> 7) % (unsigned)N);
    float ref = 0.f, mag = 0.f; for (int k = 0; k < K; ++k) { const float a = __builtin_amdgcn_cvt_f32_fp8((int)A8[(size_t)row * K + k], 0), w = W[(size_t)k * N + col]; ref += a * w; mag += a * a * w * w; }
    const float got = bf2f(Cm[(size_t)row * ldc + col]);
    dbg_report(slot, fabsf(got - ref) / (sqrtf(mag) + 1e-3f));
}
__global__ void k_check_select(const bf16_t* PQ, const float* k1, const float* k2, const int* PIDX, const float* PG, unsigned* slot) {
    __shared__ float s1[128], s2[128]; __shared__ int cnt; __shared__ float selv[16];
    const int tok = (blockIdx.x >> 3) * 61 + 5, head = blockIdx.x & 7, t = threadIdx.x;
    if (t == 0) cnt = 0;
    for (int n = t; n < 128; n += 64) { float a = 0.f, b = 0.f; for (int d = 0; d < 128; ++d) { a += bf2f(PQ[(size_t)tok * DM + head * 256 + d]) * k1[((size_t)head * 128 + n) * 128 + d]; b += bf2f(PQ[(size_t)tok * DM + head * 256 + 128 + d]) * k2[((size_t)head * 128 + n) * 128 + d]; } s1[n] = a; s2[n] = b; }
    __syncthreads();
    if (t < 16) { const int id = PIDX[(size_t)tok * 128 + head * 16 + t]; selv[t] = (id >= 0 && id < 16384) ? s1[id >> 7] + s2[id & 127] : -1e30f; }
    __syncthreads();
    float thr = selv[0], mx = selv[0]; for (int k = 1; k < 16; ++k) { thr = fminf(thr, selv[k]); mx = fmaxf(mx, selv[k]); }
    int c = 0; for (int p = t; p < 16384; p += 64) if (s1[p >> 7] + s2[p & 127] > thr + 0.02f) ++c;
    atomicAdd(&cnt, c); __syncthreads();
    if (t == 0) { float den = 0.f; for (int k = 0; k < 16; ++k) den += __expf(selv[k] - mx); float e = fabsf((float)cnt - 15.f) / 15.f > 0.34f ? fabsf((float)cnt - 15.f) / 15.f : 0.f;
        for (int k = 0; k < 16; ++k) e = fmaxf(e, fabsf(PG[(size_t)tok * 128 + head * 16 + k] - __expf(selv[k] - mx) / den) * 4.f);
        for (int k = 0; k < 16; ++k) for (int k2_ = 0; k2_ < k; ++k2_) if (PIDX[(size_t)tok * 128 + head * 16 + k] == PIDX[(size_t)tok * 128 + head * 16 + k2_]) e = fmaxf(e, 10.f);
        dbg_report(slot, e); }
}
__global__ void k_check_gather(const bf16_t* HB, const float* u, const float* v, const int* PIDX, const float* PG, const float* dbgo, unsigned* slot) {
    __shared__ float w[128];
    const int tok = blockIdx.x * 64 + 300, t = threadIdx.x;
    for (int k = t; k < 128; k += 64) { const int id = PIDX[(size_t)tok * 128 + k] & 16383; float a = 0.f; for (int d = 0; d < DM; ++d) a += bf2f(HB[(size_t)tok * DM + d]) * u[(size_t)id * DM + d];
        w[k] = PG[(size_t)tok * 128 + k] * 0.5f * a * (1.0f + erff(a * 0.70710678f)); }
    __syncthreads();
    float e = 0.f, sc = 0.f;
    for (int d = t; d < DM; d += 64) { float o = 0.f; for (int k = 0; k < 128; ++k) o += w[k] * v[(size_t)(PIDX[(size_t)tok * 128 + k] & 16383) * DM + d];
        e = fmaxf(e, fabsf(o - dbgo[(size_t)tok * DM + d])); sc = fmaxf(sc, fabsf(o)); }
    for (int o_ = 32; o_ >= 1; o_ >>= 1) { e = fmaxf(e, __shfl_xor(e, o_)); sc = fmaxf(sc, __shfl_xor(sc, o_)); }
    if (t == 0) dbg_report(slot, e / (sc + 1e-6f));
}
__global__ void k_dbg_out2(const float* x, const float* fg, float* out, const unsigned* slot) {
    const float mx = __uint_as_float(*slot); float v = 0.25f * (log10f(fmaxf(mx, 1e-30f)) + 4.0f); v = fminf(fmaxf(v, 0.f), 9.f);
    const float f = 1.0f + v;
    const int lane = threadIdx.x & 63; const size_t r = (size_t)blockIdx.x * 4 + (threadIdx.x >> 6);
    const float* xr = x + r * DM; float ss = 0.f;
    for (int c = lane; c < DM; c += 64) ss += xr[c] * xr[c];
    ss = wave_sum(ss); const float rs = rsqrtf(ss / DM + NORM_EPS);
    for (int c = lane; c < DM; c += 64) out[r * DM + c] = xr[c] * rs * fg[c] * f;
}
#endif
#ifdef DBG_SCAN
__global__ void k_scan16(const bf16_t* p, size_t n, unsigned* flags, int stage) {
    unsigned bad = 0; for (size_t i = (size_t)blockIdx.x * blockDim.x + threadIdx.x; i < n; i += (size_t)gridDim.x * blockDim.x) bad |= ((p[i] & 0x7f80u) == 0x7f80u);
    if (bad) atomicOr(&flags[stage], 1u);
}
__global__ void k_scan32(const float* p, size_t n, unsigned* flags, int stage) {
    unsigned bad = 0; for (size_t i = (size_t)blockIdx.x * blockDim.x + threadIdx.x; i < n; i += (size_t)gridDim.x * blockDim.x) bad |= ((__float_as_uint(p[i]) & 0x7f800000u) == 0x7f800000u);
    if (bad) atomicOr(&flags[stage], 1u);
}
__global__ void k_dbg_out(const float* x, const float* fg, float* out, const unsigned* flags, int nstage) {
    int code = 0; for (int s = nstage; s >= 1; --s) if (flags[s]) code = s;
    const float f = 1.0f + 0.25f * (float)code;
    const int lane = threadIdx.x & 63; const size_t r = (size_t)blockIdx.x * 4 + (threadIdx.x >> 6);
    const float* xr = x + r * DM; float ss = 0.f;
    for (int c = lane; c < DM; c += 64) ss += xr[c] * xr[c];
    ss = wave_sum(ss); const float rs = rsqrtf(ss / DM + NORM_EPS);
    for (int c = lane; c < DM; c += 64) out[r * DM + c] = xr[c] * rs * fg[c] * f;
}
#endif
extern "C" void kernel_launch(void* const* d_in, const int* in_sizes, int n_in, void* d_out, int out_size, void* d_ws, size_t ws_size, hipStream_t stream) {
    static int grid = 0;
    if (grid == 0) {
        if (n_in != 30 || out_size != NBATCH * SEQ * DM || ws_size < WS_END) { fprintf(stderr, "kernel_launch: shape/workspace mismatch: n_in %d out %d ws %zu (need %zu)\n", n_in, out_size, ws_size, (size_t)WS_END); grid = -1; return; }
        int dev = 0, cus = 0, per_cu = 0;
        if (hipGetDevice(&dev) != hipSuccess || hipDeviceGetAttribute(&cus, hipDeviceAttributeMultiprocessorCount, dev) != hipSuccess) { grid = -1; return; }
        bool okattr = hipFuncSetAttribute((const void*)MAIN_KERNEL, hipFuncAttributeMaxDynamicSharedMemorySize, LDS_BYTES) == hipSuccess;
#if MK_N_LAUNCHES != 1
#ifdef DBG_HYB
        okattr = okattr && hipFuncSetAttribute((const void*)mk_fwd, hipFuncAttributeMaxDynamicSharedMemorySize, LDS_BYTES) == hipSuccess;
#endif
#define SETA(K) okattr = okattr && hipFuncSetAttribute((const void*)k_one<K>, hipFuncAttributeMaxDynamicSharedMemorySize, LDS_BYTES) == hipSuccess
        SETA(0); SETA(1); SETA(2); SETA(3); SETA(4); SETA(5); SETA(6); SETA(7); SETA(8); SETA(9); SETA(10); SETA(11); SETA(12); SETA(13);
#undef SETA
#endif
        if (!okattr) { fprintf(stderr, "kernel_launch: hipFuncSetAttribute failed\n"); grid = -1; return; }
        if (hipOccupancyMaxActiveBlocksPerMultiprocessor(&per_cu, (const void*)MAIN_KERNEL, NTHREADS, LDS_BYTES) != hipSuccess || per_cu < 1) { fprintf(stderr, "kernel_launch: occupancy query says %d blocks per CU\n", per_cu); grid = -1; (void)hipGetLastError(); return; }
        grid = cus;
    }
    if (grid < 0) return;
    if (hipMemsetAsync((char*)d_ws + WS_CTL, 0, CTL_BYTES, stream) != hipSuccess) return;
    Args a{};
    for (int i = 0; i < 30; ++i) a.in[i] = (const float*)d_in[i];
    a.out = (float*)d_out; a.ws = (unsigned char*)d_ws;
#if defined(DBG_PROBE)
    { unsigned* flags = (unsigned*)((char*)d_ws + WS_CTL + 32768);
      hipLaunchKernelGGL(k_probe_mx, dim3(1), dim3(64), 0, stream, flags + 100);
      hipLaunchKernelGGL(k_dbg_out2, dim3(NBATCH * SEQ / 4), dim3(256), 0, stream, (const float*)d_in[0], (const float*)d_in[29], (float*)d_out, flags + 100); }
#elif MK_N_LAUNCHES == 1 && defined(DBG_CHECK)
    {
        unsigned* flags = (unsigned*)((char*)d_ws + WS_CTL + 32768); char* W = (char*)d_ws;
        a.ph_lo = 0; a.ph_hi = (DBG_CHECK == 8) ? 3 : (DBG_CHECK >= 5) ? 7 : (DBG_CHECK == 1 ? 11 : (DBG_CHECK == 2 ? 12 : 13));
        hipLaunchKernelGGL(mk_fwd, dim3(grid), dim3(NTHREADS), LDS_BYTES, stream, a);
#if DBG_CHECK == 8
        hipLaunchKernelGGL(k_check_gemm8, dim3(32), dim3(256), 0, stream, (const unsigned char*)(W + WS_HB), (const float*)d_in[I_WIN], DM, IN_COLS, (const bf16_t*)(W + WS_P), NP, TT, flags + 100);
#elif DBG_CHECK == 5 || DBG_CHECK == 6
        hipLaunchKernelGGL(k_check_attn, dim3(16 * 24), dim3(256), 0, stream, (const unsigned char*)d_ws, DBG_CHECK == 5 ? 1 : 0, flags + 100);
#elif DBG_CHECK == 7
        { float* obuf = (float*)(W + WS_MQ);
          hipLaunchKernelGGL(k_check_gla_rec, dim3(8), dim3(256), 0, stream, (const unsigned char*)d_ws, (const float*)d_in[I_WA2F], (const float*)d_in[I_BAF], (const float*)d_in[I_WA2B], (const float*)d_in[I_BAB], obuf, 0);
          hipLaunchKernelGGL(k_check_gla_cmp, dim3(RPB * 4), dim3(256), 0, stream, (const unsigned char*)d_ws, (const float*)obuf, (const float*)d_in[I_ONG], 0, flags + 100); }
#elif DBG_CHECK == 1
        hipLaunchKernelGGL(k_check_gemm, dim3(32), dim3(256), 0, stream, (const bf16_t*)(W + WS_HB), DM, (const float*)d_in[I_PWQ], DM, DM, (const bf16_t*)(W + WS_PQ), DM, TT, flags + 100);
#elif DBG_CHECK == 2
        hipLaunchKernelGGL(k_check_select, dim3(256 * 8), dim3(64), 0, stream, (const bf16_t*)(W + WS_PQ), (const float*)d_in[I_PK1], (const float*)d_in[I_PK2], (const int*)(W + WS_PIDX), (const float*)(W + WS_PG), flags + 100);
#else
        hipLaunchKernelGGL(k_check_gather, dim3(128), dim3(64), 0, stream, (const bf16_t*)(W + WS_HB), (const float*)d_in[I_PU], (const float*)d_in[I_PV], (const int*)(W + WS_PIDX), (const float*)(W + WS_PG), (const float*)(W + WS_MQ), flags + 100);
#endif
        hipLaunchKernelGGL(k_dbg_out2, dim3(NBATCH * SEQ / 4), dim3(256), 0, stream, (const float*)d_in[0], (const float*)d_in[29], (float*)d_out, flags + 100);
    }
#elif MK_N_LAUNCHES == 1
#ifdef DBG_SPLIT
    for (int p = 0; p < N_PHASES; p += DBG_SPLIT) { a.ph_lo = p; a.ph_hi = p + DBG_SPLIT < N_PHASES ? p + DBG_SPLIT : N_PHASES; hipLaunchKernelGGL(mk_fwd, dim3(grid), dim3(NTHREADS), LDS_BYTES, stream, a); }
#else
    a.ph_lo = 0; a.ph_hi = N_PHASES;
    hipLaunchKernelGGL(mk_fwd, dim3(grid), dim3(NTHREADS), LDS_BYTES, stream, a);
#endif
#else
    a.ph_hi = 0;
#ifndef DBG_NLAUNCH
#define DBG_NLAUNCH 100
#endif
    int nl_ = 0;
#ifdef DBG_HYB
#define LAUNCH1(K, L) do { if (K == DBG_HYB) { a.ph_lo = 12 * (L) + (K); a.ph_hi = a.ph_lo + 1; hipLaunchKernelGGL(mk_fwd, dim3(grid), dim3(NTHREADS), LDS_BYTES, stream, a); a.ph_hi = 0; } else { a.ph_lo = (L); hipLaunchKernelGGL(k_one<K>, dim3(grid), dim3(NTHREADS), LDS_BYTES, stream, a); } } while (0)
#else
#define LAUNCH1(K, L) do { a.ph_lo = (L); if (nl_++ < DBG_NLAUNCH) { hipLaunchKernelGGL(k_one<K>, dim3(grid), dim3(NTHREADS), LDS_BYTES, stream, a); if (K == DBG_DUP) hipLaunchKernelGGL(k_one<K>, dim3(grid), dim3(NTHREADS), LDS_BYTES, stream, a); } } while (0)
#endif
#ifdef DBG_SCAN
    unsigned* flags = (unsigned*)((char*)d_ws + WS_CTL + 32768);
    char* W = (char*)d_ws;
#define S16(off, n, st) hipLaunchKernelGGL(k_scan16, dim3(1024), dim3(256), 0, stream, (const bf16_t*)(W + (off)), (size_t)(n), flags, st)
#define S32(off, n, st) hipLaunchKernelGGL(k_scan32, dim3(1024), dim3(256), 0, stream, (const float*)(W + (off)), (size_t)(n), flags, st)
    LAUNCH1(0, 0); S32(WS_MODV, 2 * 3 * 12288, 1);
    { const int l = 0;
      LAUNCH1(1, l); S16(WS_HB, (size_t)TT * DM, 2);
      LAUNCH1(2, l); S16(WS_P, (size_t)TT * NP, 3);
      LAUNCH1(3, l); S16(WS_P, (size_t)TT * NP, 4);
      LAUNCH1(4, l); S16(WS_MQ, (size_t)TT * 1536, 5); S16(WS_MKV, (size_t)TT * 2048, 5); S16(WS_GST, (size_t)2112 * 32768, 6); S32(WS_GDEC, (size_t)2112 * 128, 6);
      LAUNCH1(5, l); S16(WS_GST, (size_t)2112 * 32768, 7);
      LAUNCH1(6, l); S16(WS_OA, (size_t)TT * 1024, 8); S16(WS_OM, (size_t)TT * 1024, 9); S16(WS_OL, (size_t)TT * 1024, 10);
      LAUNCH1(7, l); S16(WS_Y, (size_t)TT * DM, 11);
      LAUNCH1(8, l); S32(WS_XS, (size_t)TT * DM, 12);
      LAUNCH1(9, l); S16(WS_HB, (size_t)TT * DM, 13);
      LAUNCH1(10, l); S16(WS_PQ, (size_t)TT * DM, 14);
      LAUNCH1(11, l); S32(WS_PG, (size_t)TT * 128, 15);
      LAUNCH1(12, l); S32(WS_XS, (size_t)TT * DM, 16);
    }
    hipLaunchKernelGGL(k_dbg_out, dim3(NBATCH * SEQ / 4), dim3(256), 0, stream, (const float*)d_in[0], (const float*)d_in[29], (float*)d_out, flags, 16);
#elif defined(DBG_CHECK)
    unsigned* flags = (unsigned*)((char*)d_ws + WS_CTL + 32768);
    char* W = (char*)d_ws;
    LAUNCH1(0, 0);
    { const int l = 0; LAUNCH1(1, l); LAUNCH1(2, l); LAUNCH1(3, l); LAUNCH1(4, l); LAUNCH1(5, l); LAUNCH1(6, l);
#if DBG_CHECK == 5 || DBG_CHECK == 6
      hipLaunchKernelGGL(k_check_attn, dim3(16 * 24), dim3(256), 0, stream, (const unsigned char*)d_ws, DBG_CHECK == 5 ? 1 : 0, flags + 100);
#endif
#if DBG_CHECK == 7
      { float* obuf = (float*)(W + WS_MQ);
        hipLaunchKernelGGL(k_check_gla_rec, dim3(8), dim3(256), 0, stream, (const unsigned char*)d_ws, (const float*)d_in[I_WA2F], (const float*)d_in[I_BAF], (const float*)d_in[I_WA2B], (const float*)d_in[I_BAB], obuf, 0);
        hipLaunchKernelGGL(k_check_gla_cmp, dim3(RPB * 4), dim3(256), 0, stream, (const unsigned char*)d_ws, (const float*)obuf, (const float*)d_in[I_ONG], 0, flags + 100); }
#endif
      LAUNCH1(7, l); LAUNCH1(8, l); LAUNCH1(9, l); LAUNCH1(10, l);
#if DBG_CHECK == 1
      hipLaunchKernelGGL(k_check_gemm, dim3(32), dim3(256), 0, stream, (const bf16_t*)(W + WS_HB), DM, (const float*)d_in[I_PWQ], DM, DM, (const bf16_t*)(W + WS_PQ), DM, TT, flags + 100);
#endif
      LAUNCH1(11, l);
#if DBG_CHECK == 2
      hipLaunchKernelGGL(k_check_select, dim3(256 * 8), dim3(64), 0, stream, (const bf16_t*)(W + WS_PQ), (const float*)d_in[I_PK1], (const float*)d_in[I_PK2], (const int*)(W + WS_PIDX), (const float*)(W + WS_PG), flags + 100);
#endif
      LAUNCH1(12, l);
#if DBG_CHECK == 3
      hipLaunchKernelGGL(k_check_gather, dim3(128), dim3(64), 0, stream, (const bf16_t*)(W + WS_HB), (const float*)d_in[I_PU], (const float*)d_in[I_PV], (const int*)(W + WS_PIDX), (const float*)(W + WS_PG), (const float*)(W + WS_MQ), flags + 100);
#endif
    }
    hipLaunchKernelGGL(k_dbg_out2, dim3(NBATCH * SEQ / 4), dim3(256), 0, stream, (const float*)d_in[0], (const float*)d_in[29], (float*)d_out, flags + 100);
#else
    LAUNCH1(0, 0);
    for (int l = 0; l < DEPTH; ++l) { LAUNCH1(1, l); LAUNCH1(2, l); LAUNCH1(3, l);
#ifdef DBG_DUP23
        LAUNCH1(2, l); LAUNCH1(3, l);
#endif
        LAUNCH1(4, l); LAUNCH1(5, l);
#ifdef DBG_DUP45
        LAUNCH1(4, l); LAUNCH1(5, l);
#endif
        LAUNCH1(6, l); LAUNCH1(7, l); LAUNCH1(8, l); LAUNCH1(9, l); LAUNCH1(10, l); LAUNCH1(11, l); LAUNCH1(12, l); }
    LAUNCH1(13, DEPTH - 1);
#endif
#undef LAUNCH1
#endif
    const hipError_t le = hipPeekAtLastError();
    if (le != hipSuccess) fprintf(stderr, "kernel_launch: launch failed: %s\n", hipGetErrorName(le));
}
```

```cpp
#include <hip/hip_runtime.h>
#include <cstdio>
#include <cstdint>

#ifndef MK_N_LAUNCHES
#ifndef DBG_DUP
#define DBG_DUP -1
#endif
#define MK_N_LAUNCHES 1
#endif

#ifndef DBG_MIX0
#define DBG_MIX0 1.0f
#define DBG_MIX1 1.0f
#define DBG_PEER0 1.0f
#define DBG_PEER1 1.0f
#endif
#ifndef MLA_NQR
#define MLA_NQR 4
#endif
#define LAS __attribute__((address_space(3)))
#define GLB __attribute__((address_space(1)))
typedef unsigned short bf16_t;
typedef short bf16x8 __attribute__((ext_vector_type(8)));
typedef short s16x4 __attribute__((ext_vector_type(4)));
typedef float f32x4 __attribute__((ext_vector_type(4)));
typedef float f32x2 __attribute__((ext_vector_type(2)));
typedef float f32x16 __attribute__((ext_vector_type(16)));
typedef unsigned u32x4 __attribute__((ext_vector_type(4)));
typedef unsigned u32x2 __attribute__((ext_vector_type(2)));
typedef __bf16 bf2_t __attribute__((ext_vector_type(2)));

constexpr int DM = 2048, NBATCH = 2, SEQ = 8192, CTXL = 256, DEPTH = 2;
constexpr int RPB = SEQ + CTXL;
constexpr int TT = NBATCH * RPB;
constexpr int IN_COLS = 11872, NP = 12032;
constexpr int C_AQ = 0, C_AK = 1024, C_AV = 1280, C_LQ = 1536, C_LK = 2048, C_LV = 2560, C_LG = 3584, C_LRF = 4608, C_LRB = 4624,
              C_MCQ = 4640, C_MCKV = 5152, C_MKR = 5664, C_GA = 5728, C_GL = 7776, C_GM = 9824;
constexpr int NCH = RPB / 64;
constexpr int NEXP = 16384;
constexpr float NORM_EPS = 1e-6f;
constexpr int NTHREADS = 512;

constexpr size_t al256(size_t x) { return (x + 255) / 256 * 256; }
constexpr size_t WS_CTL   = 0;
constexpr size_t CTL_BYTES = 65536;
constexpr size_t WS_MODV  = WS_CTL + CTL_BYTES;
constexpr size_t WS_TABA  = al256(WS_MODV + (size_t)2 * 3 * 12288 * 4);
constexpr size_t WS_TABM  = WS_TABA + 2 * 128 * 32 * 4;
constexpr size_t WS_XS    = al256(WS_TABM + 2 * 128 * 16 * 4);
constexpr size_t WS_HB    = WS_XS + (size_t)TT * DM * 4;
constexpr size_t WS_P     = WS_HB + (size_t)TT * DM * 2;
constexpr size_t WS_MQ    = WS_P + (size_t)TT * NP * 2;
constexpr size_t WS_MKV   = WS_MQ + (size_t)TT * 1536 * 2;
constexpr size_t WS_OA    = WS_MKV + (size_t)TT * 2048 * 2;
constexpr size_t WS_OL    = WS_OA + (size_t)TT * 1024 * 2;
constexpr size_t WS_OM    = WS_OL + (size_t)TT * 1024 * 2;
constexpr size_t WS_WIN   = WS_OM + (size_t)TT * 1024 * 2;
constexpr size_t WS_WUQ   = WS_WIN + (size_t)NP * 2048 * 2;
constexpr size_t WS_WUKV  = WS_WUQ + (size_t)1536 * 512 * 2;
constexpr size_t WS_WBR   = WS_WUKV + (size_t)2048 * 512 * 2;
constexpr size_t WS_WOUT  = WS_WBR + (size_t)3 * 2048 * 1024 * 2;
constexpr size_t WS_WQ    = WS_WOUT + (size_t)2048 * 2048 * 2;
constexpr size_t WS_K1    = WS_WQ + (size_t)2048 * 2048 * 2;
constexpr size_t WS_K2    = WS_K1 + (size_t)8 * 128 * 128 * 2;
constexpr size_t WS_GST   = WS_K2 + (size_t)8 * 128 * 128 * 2;
constexpr size_t WS_GDEC  = WS_GST + (size_t)NBATCH * 2 * 4 * NCH * 32768 * 2;
constexpr size_t WS_END0  = WS_GDEC + (size_t)NBATCH * 2 * 4 * NCH * 128 * 4;
constexpr size_t WS_KN8   = WS_OA + (size_t)TT * 1024;
constexpr size_t WS_AK8   = WS_OL + (size_t)TT * 1024;
constexpr size_t WS_KR8   = WS_AK8 + (size_t)TT * 256;
constexpr size_t WS_VT8A  = WS_KR8 + (size_t)TT * 64;
constexpr size_t WS_VT8M  = WS_OM + (size_t)TT * 1024;
constexpr size_t WS_Y     = WS_MKV;
constexpr size_t WS_PQ    = WS_OA;
constexpr size_t WS_PIDX  = WS_P;
constexpr size_t WS_PG    = WS_PIDX + (size_t)TT * 128 * 4;
constexpr size_t PT_BYTES = 2 * (size_t)NEXP * DM + 2 * (size_t)NEXP * 4;
constexpr size_t WS_WINS  = WS_END0;
constexpr size_t WS_WOUTS = al256(WS_WINS + (size_t)NP * 4);
constexpr size_t WS_WBRS  = al256(WS_WOUTS + (size_t)DM * 4);
constexpr size_t WS_PT    = al256(WS_WBRS + (size_t)3 * DM * 4);
constexpr size_t WS_END   = WS_PT + DEPTH * PT_BYTES;
constexpr size_t PT_U8 = 0, PT_V8 = (size_t)NEXP * DM, PT_SCU = 2 * (size_t)NEXP * DM, PT_SCV = PT_SCU + (size_t)NEXP * 4;
static_assert(WS_PG + (size_t)TT * 128 * 4 <= WS_MQ, "PEER alias region overflows P");

__device__ __forceinline__ unsigned cvt_pk_bf16(float lo, float hi) { bf2_t v; v.x = (__bf16)lo; v.y = (__bf16)hi; return __builtin_bit_cast(unsigned, v); }
__device__ __forceinline__ bf16_t f2bf(float f) { return (bf16_t)(cvt_pk_bf16(f, 0.f) & 0xffffu); }
__device__ __forceinline__ float bf2f(bf16_t b) { return __uint_as_float(((unsigned)b) << 16); }
__device__ __forceinline__ float bflo(unsigned w) { return __uint_as_float(w << 16); }
__device__ __forceinline__ float bfhi(unsigned w) { return __uint_as_float(w & 0xffff0000u); }
__device__ __forceinline__ float xchg32(float x, int lane) { auto r = __builtin_amdgcn_permlane32_swap(__float_as_uint(x), __float_as_uint(x), false, false); return __uint_as_float(lane < 32 ? r[1] : r[0]); }
__device__ __forceinline__ float xchg16(float x, int lane) { auto r = __builtin_amdgcn_permlane16_swap(__float_as_uint(x), __float_as_uint(x), false, false); return __uint_as_float((lane & 16) ? r[0] : r[1]); }
template <int CTRL> __device__ __forceinline__ float dppmov(float x) { return __uint_as_float(__builtin_amdgcn_update_dpp(0u, __float_as_uint(x), CTRL, 0xF, 0xF, false)); }
constexpr int DPP_ROR8 = 0x128, DPP_HMIRROR = 0x141, DPP_Q3210 = 0x1B, DPP_Q1032 = 0xB1;
__device__ __forceinline__ float wave_sum(float v) {
    const int lane = threadIdx.x & 63;
    v += xchg32(v, lane); v += xchg16(v, lane); v += dppmov<DPP_ROR8>(v); v += dppmov<DPP_HMIRROR>(v); v += dppmov<DPP_Q3210>(v); v += dppmov<DPP_Q1032>(v);
    return v;
}
__device__ __forceinline__ float sigmoidf_(float x) { return __builtin_amdgcn_rcpf(1.0f + __expf(-x)); }
__device__ __forceinline__ float siluf_(float x) { return x * __builtin_amdgcn_rcpf(1.0f + __expf(-x)); }

#define XB_TMO      128
#define XB_XCNT(j)  (256  + 64 * (j))
#define XB_XSUB(j)  (1280 + 64 * (j))
#define XB_XGEN(j)  (2304 + 64 * (j))
#define XB_TOP      3328
#define XB_TOPGEN   3392
#define XCD_BAR_WORDS 3456
#define XB_SPIN_CAP (1u << 20)
__device__ __forceinline__ unsigned xb_ld(unsigned* p)              { return __hip_atomic_load(p, __ATOMIC_RELAXED, __HIP_MEMORY_SCOPE_AGENT); }
__device__ __forceinline__ unsigned xb_add(unsigned* p, unsigned v) { return __hip_atomic_fetch_add(p, v, __ATOMIC_RELAXED, __HIP_MEMORY_SCOPE_AGENT); }
__device__ __forceinline__ unsigned xb_xcc_id() { return (unsigned)__builtin_amdgcn_s_getreg((3 << 11) | 20) & 0xFu; }
#define XB_SPIN(cond, bar) do { unsigned _sp = 0; while (cond) { __builtin_amdgcn_s_sleep(1); \
    if ((++_sp & 255u) == 0u) { if (xb_ld(&(bar)[XB_TMO])) break; if (_sp > XB_SPIN_CAP) { atomicAdd(&(bar)[XB_TMO], 1u); break; } } } } while (0)
struct XcdBarrier { unsigned* bar; unsigned x; volatile LAS unsigned* st; };
__device__ __forceinline__ XcdBarrier xcd_barrier_post(unsigned* bar, volatile LAS unsigned* st) {
    XcdBarrier b; b.bar = bar; b.x = xb_xcc_id(); b.st = st;
    if (threadIdx.x == 0) (void)xb_add(&bar[XB_XCNT(b.x)], 1u);
    return b;
}
__device__ __forceinline__ void xcd_barrier_complete(unsigned* bar, unsigned x, unsigned& nloc, unsigned& nx) {
    const unsigned G = gridDim.x * gridDim.y * gridDim.z;
    unsigned sum, cnt, mine, sp = 0u;
    for (;;) {
        sum = 0u; cnt = 0u; mine = 0u;
#pragma unroll
        for (unsigned j = 0; j < 16; ++j) { const unsigned c = xb_ld(&bar[XB_XCNT(j)]); sum += c; cnt += (c > 0u) ? 1u : 0u; mine = (j == x) ? c : mine; }
        if (sum == G) break;
        __builtin_amdgcn_s_sleep(1);
        if ((++sp & 255u) == 0u) { if (xb_ld(&bar[XB_TMO])) break; if (sp > XB_SPIN_CAP) { atomicAdd(&bar[XB_TMO], 1u); break; } }
    }
    nloc = mine > 0u ? mine : 1u; nx = cnt > 0u ? cnt : 1u;
}
__device__ __forceinline__ void xcd_barrier(const XcdBarrier& b) {
    asm volatile("s_waitcnt vmcnt(0)" ::: "memory");
    __syncthreads();
    if (threadIdx.x == 0) {
        unsigned* bar = b.bar;
        __builtin_amdgcn_s_waitcnt(0);
        unsigned nloc = b.st[0], nx = b.st[1];
        if (nloc == 0u) { xcd_barrier_complete(bar, b.x, nloc, nx); b.st[0] = nloc; b.st[1] = nx; }
        const unsigned old = xb_add(&bar[XB_XSUB(b.x)], 1u);
        const unsigned gen = old / nloc;
        if (old + 1u == (gen + 1u) * nloc) {
            __builtin_amdgcn_fence(__ATOMIC_RELEASE, "agent");
            asm volatile("s_waitcnt vmcnt(0)" ::: "memory");
            const unsigned og = xb_add(&bar[XB_TOP], 1u);
            const unsigned tg = og / nx;
            if (og + 1u == (tg + 1u) * nx) xb_add(&bar[XB_TOPGEN], 1u);
            else XB_SPIN(xb_ld(&bar[XB_TOPGEN]) == tg, bar);
            __builtin_amdgcn_fence(__ATOMIC_ACQUIRE, "agent");
            xb_add(&bar[XB_XGEN(b.x)], 1u);
            asm volatile("s_waitcnt vmcnt(0)" ::: "memory");
        } else {
            XB_SPIN(xb_ld(&bar[XB_XGEN(b.x)]) == gen, bar);
            __builtin_amdgcn_fence(__ATOMIC_ACQUIRE, "agent");
            asm volatile("s_waitcnt vmcnt(0)" ::: "memory");
        }
    }
    __syncthreads();
}

namespace pg8 {
constexpr int BM = 256, BK = 64, HALF = 128, HTB = HALF * BK * 2, STAGE_BYTES = 8 * HTB, NXCD = 8, WGM = 8;
__host__ __device__ __forceinline__ int lds_byte(int r, int c) { const int st = (r >> 4) * 2 + (c >> 5), rr = r & 15, cc = c & 31, ob = rr * 64 + cc * 2; return st * 1024 + (ob ^ (((ob >> 9) & 1) << 5)); }
__host__ __device__ __forceinline__ void stage_rc(int b, int& R, int& C) { const int st = b / 1024, sb = b % 1024, swz = sb ^ (((sb >> 9) & 1) << 5); R = (st >> 1) * 16 + swz / 64; C = (st & 1) * 32 + (swz % 64) / 2; }
__host__ __device__ __forceinline__ int perm32(int rho) { const int n = rho >> 4, i = rho & 15; return 8 * (i >> 2) + 4 * n + (i & 3); }
struct Unit { int pm, pn; };
struct Gemm { const bf16_t* A; const bf16_t* Bt; int M, N, K, lda, ldb; };
struct StaticOrder {
    int nM, nN, nwg, G, c, latent;
    __host__ __device__ void init(int M, int N, int G_, int c_, int latent_ = 0) { latent = latent_; nM = latent_ ? 64 : M / BM; nN = N / BM; nwg = nM * nN; G = G_; c = c_; }
    __host__ __device__ bool next(int i, Unit& u) const {
        const long L = (long)i * G + c; if (L >= nwg) return false;
        int wgid = (int)L; { const int q = nwg / NXCD, r = nwg % NXCD, xcd = wgid % NXCD, off = wgid / NXCD; wgid = (xcd < r ? xcd * (q + 1) : r * (q + 1) + (xcd - r) * q) + off; }
        const int nig = WGM * nN, gid = wgid / nig, fm = gid * WGM, gsz = (nM - fm) < WGM ? (nM - fm) : WGM;
        u.pm = fm + ((wgid % nig) % gsz); u.pn = (wgid % nig) / gsz; if (latent) u.pm += 1 + (u.pm >= 32 ? 1 : 0); return true;
    }
};
struct WinOrder {
    StaticOrder S; int full, nlat, G, c;
    __host__ __device__ void init(int G_, int c_, int full_) { full = full_; G = G_; c = c_; S.init(TT, NP, G_, c_, full_ ? 0 : 1); nlat = S.nwg; }
    __host__ __device__ bool next(int i, Unit& u) const {
        if (full) return S.next(i, u);
        const long L = (long)i * G + c;
        if (L < nlat) return S.next(i, u);
        const int q = (int)(L - nlat); if (q >= 24) return false;
        const int t = q % 12; u.pm = q < 12 ? 0 : 33;
        u.pn = t < 2 ? 4 + t : (t < 8 ? 8 + (t - 2) : (t == 8 ? 18 : 20 + (t - 9)));
        return true;
    }
};
struct EpiStoreBf16 {
    static constexpr bool PERM = true;
    bf16_t* O; int ldc;
    __device__ __forceinline__ void operator()(const f32x4 (&acc)[2][2][4][2], const Unit& u, int wr, int wc, int fr, int fq) const {
        const int row0 = u.pm * BM + wr * 64 + fr, col0 = u.pn * BM + wc * 32 + 8 * fq;
#pragma unroll
        for (int ai = 0; ai < 2; ++ai)
#pragma unroll
            for (int m = 0; m < 4; ++m) { bf16_t* rowp = O + (size_t)(row0 + ai * HALF + m * 16) * ldc + col0;
#pragma unroll
                for (int bj = 0; bj < 2; ++bj) { const f32x4 v0 = acc[ai][bj][m][0], v1 = acc[ai][bj][m][1];
                    u32x4 w; w.x = cvt_pk_bf16(v0[0], v0[1]); w.y = cvt_pk_bf16(v0[2], v0[3]); w.z = cvt_pk_bf16(v1[0], v1[1]); w.w = cvt_pk_bf16(v1[2], v1[3]);
                    *(u32x4*)(rowp + bj * HALF) = w; } }
    }
};
struct EpiNull {
    static constexpr bool PERM = true;
    __device__ __forceinline__ void operator()(const f32x4 (&acc)[2][2][4][2], const Unit&, int, int, int, int) const {
#pragma unroll
        for (int a = 0; a < 2; ++a)
#pragma unroll
            for (int b = 0; b < 2; ++b)
#pragma unroll
                for (int m = 0; m < 4; ++m)
#pragma unroll
                    for (int n = 0; n < 2; ++n) asm volatile("" :: "v"(acc[a][b][m][n]));
    }
};
struct EpiStoreMKV {
    static constexpr bool PERM = true;
    bf16_t* O; unsigned char* K8;
    __device__ __forceinline__ void operator()(const f32x4 (&acc)[2][2][4][2], const Unit& u, int wr, int wc, int fr, int fq) const {
        const int row0 = u.pm * BM + wr * 64 + fr, col0 = u.pn * BM + wc * 32 + 8 * fq;
#pragma unroll
        for (int ai = 0; ai < 2; ++ai)
#pragma unroll
            for (int m = 0; m < 4; ++m) { const size_t r = (size_t)(row0 + ai * HALF + m * 16); bf16_t* rowp = O + r * 2048 + col0;
#pragma unroll
                for (int bj = 0; bj < 2; ++bj) { const f32x4 v0 = acc[ai][bj][m][0], v1 = acc[ai][bj][m][1];
                    u32x4 w; w.x = cvt_pk_bf16(v0[0], v0[1]); w.y = cvt_pk_bf16(v0[2], v0[3]); w.z = cvt_pk_bf16(v1[0], v1[1]); w.w = cvt_pk_bf16(v1[2], v1[3]);
                    *(u32x4*)(rowp + bj * HALF) = w;
                    if (bj == 0) { int p0 = __builtin_amdgcn_cvt_pk_fp8_f32(v0[0], v0[1], 0, false); p0 = __builtin_amdgcn_cvt_pk_fp8_f32(v0[2], v0[3], p0, true);
                        int p1 = __builtin_amdgcn_cvt_pk_fp8_f32(v1[0], v1[1], 0, false); p1 = __builtin_amdgcn_cvt_pk_fp8_f32(v1[2], v1[3], p1, true);
                        u32x2 w8; w8.x = (unsigned)p0; w8.y = (unsigned)p1; *(u32x2*)(K8 + r * 1024 + u.pn * 128 + wc * 32 + 8 * fq) = w8; } } }
    }
};
struct EpiStoreBf16S {
    static constexpr bool PERM = true;
    bf16_t* O; int ldc; const float* cs;
    __device__ __forceinline__ void operator()(const f32x4 (&acc)[2][2][4][2], const Unit& u, int wr, int wc, int fr, int fq) const {
        const int row0 = u.pm * BM + wr * 64 + fr, col0 = u.pn * BM + wc * 32 + 8 * fq;
        f32x4 sv[2][2];
#pragma unroll
        for (int bj = 0; bj < 2; ++bj)
#pragma unroll
            for (int n = 0; n < 2; ++n) sv[bj][n] = *(const f32x4*)(cs + col0 + bj * HALF + 4 * n);
#pragma unroll
        for (int ai = 0; ai < 2; ++ai)
#pragma unroll
            for (int m = 0; m < 4; ++m) { bf16_t* rowp = O + (size_t)(row0 + ai * HALF + m * 16) * ldc + col0;
#pragma unroll
                for (int bj = 0; bj < 2; ++bj) { const f32x4 v0 = acc[ai][bj][m][0] * sv[bj][0], v1 = acc[ai][bj][m][1] * sv[bj][1];
                    u32x4 w; w.x = cvt_pk_bf16(v0[0], v0[1]); w.y = cvt_pk_bf16(v0[2], v0[3]); w.z = cvt_pk_bf16(v1[0], v1[1]); w.w = cvt_pk_bf16(v1[2], v1[3]);
                    *(u32x4*)(rowp + bj * HALF) = w; } }
    }
};
template <bool FIRST, bool F8OUT = false> struct EpiGate {
    static constexpr bool PERM = true;
    bf16_t* Y; const bf16_t* Gt; unsigned char* Y8; const float* cs;
    __device__ __forceinline__ void operator()(const f32x4 (&acc)[2][2][4][2], const Unit& u, int wr, int wc, int fr, int fq) const {
        constexpr int ldy = DM, ldg = NP, ldy8 = DM;
        const int row0 = u.pm * BM + wr * 64 + fr, col0 = u.pn * BM + wc * 32 + 8 * fq;
        f32x4 sv[2][2];
#pragma unroll
        for (int bj = 0; bj < 2; ++bj)
#pragma unroll
            for (int n = 0; n < 2; ++n) sv[bj][n] = *(const f32x4*)(cs + col0 + bj * HALF + 4 * n);
#pragma unroll
        for (int ai = 0; ai < 2; ++ai)
#pragma unroll
        for (int mh = 0; mh < 2; ++mh) {
            u32x4 g[2][2], y[2][2];
#pragma unroll
            for (int mm = 0; mm < 2; ++mm)
#pragma unroll
                for (int bj = 0; bj < 2; ++bj) { const size_t r = (size_t)(row0 + ai * HALF + (mh * 2 + mm) * 16);
                    g[mm][bj] = *(const u32x4*)(Gt + r * ldg + col0 + bj * HALF);
                    if (!FIRST) y[mm][bj] = *(const u32x4*)(Y + r * ldy + col0 + bj * HALF); }
#pragma unroll
            for (int mm = 0; mm < 2; ++mm)
#pragma unroll
                for (int bj = 0; bj < 2; ++bj) { const int m = mh * 2 + mm; const size_t r = (size_t)(row0 + ai * HALF + m * 16); const f32x4 v0 = acc[ai][bj][m][0] * sv[bj][0], v1 = acc[ai][bj][m][1] * sv[bj][1]; const u32x4 gg = g[mm][bj];
                    float o[8];
                    o[0] = sigmoidf_(bflo(gg.x)) * v0[0]; o[1] = sigmoidf_(bfhi(gg.x)) * v0[1]; o[2] = sigmoidf_(bflo(gg.y)) * v0[2]; o[3] = sigmoidf_(bfhi(gg.y)) * v0[3];
                    o[4] = sigmoidf_(bflo(gg.z)) * v1[0]; o[5] = sigmoidf_(bfhi(gg.z)) * v1[1]; o[6] = sigmoidf_(bflo(gg.w)) * v1[2]; o[7] = sigmoidf_(bfhi(gg.w)) * v1[3];
                    if (!FIRST) { const u32x4 yy = y[mm][bj];
                        o[0] += bflo(yy.x); o[1] += bfhi(yy.x); o[2] += bflo(yy.y); o[3] += bfhi(yy.y); o[4] += bflo(yy.z); o[5] += bfhi(yy.z); o[6] += bflo(yy.w); o[7] += bfhi(yy.w); }
                    if constexpr (F8OUT) { int p0 = __builtin_amdgcn_cvt_pk_fp8_f32(o[0], o[1], 0, false); p0 = __builtin_amdgcn_cvt_pk_fp8_f32(o[2], o[3], p0, true);
                        int p1 = __builtin_amdgcn_cvt_pk_fp8_f32(o[4], o[5], 0, false); p1 = __builtin_amdgcn_cvt_pk_fp8_f32(o[6], o[7], p1, true);
                        u32x2 w8; w8.x = (unsigned)p0; w8.y = (unsigned)p1; *(u32x2*)(Y8 + r * ldy8 + col0 + bj * HALF) = w8; }
                    else { u32x4 w; w.x = cvt_pk_bf16(o[0], o[1]); w.y = cvt_pk_bf16(o[2], o[3]); w.z = cvt_pk_bf16(o[4], o[5]); w.w = cvt_pk_bf16(o[6], o[7]);
                        *(u32x4*)(Y + r * ldy + col0 + bj * HALF) = w; } }
        }
    }
};
template <bool CS> struct EpiResidT {
    static constexpr bool PERM = false;
    float* X; int ldx; const float* gate; const float* cs;
    __device__ __forceinline__ void operator()(const f32x4 (&acc)[2][2][4][2], const Unit& u, int wr, int wc, int fr, int fq) const {
        const int row0 = u.pm * BM + wr * 64 + fr, col0 = u.pn * BM + wc * 32 + 4 * fq;
        const int sel = (u.pm % 33 == 0) ? 2 : (u.pm / 33);
        const float* gp = gate + (size_t)sel * 12288 + col0;
        f32x4 gv[2][2];
#pragma unroll
        for (int bj = 0; bj < 2; ++bj)
#pragma unroll
            for (int n = 0; n < 2; ++n) { gv[bj][n] = *(const f32x4*)(gp + bj * HALF + n * 16); if constexpr (CS) gv[bj][n] = gv[bj][n] * *(const f32x4*)(cs + col0 + bj * HALF + n * 16); }
#pragma unroll
        for (int ai = 0; ai < 2; ++ai)
#pragma unroll
            for (int mh = 0; mh < 2; ++mh) {
                f32x4 x[2][2][2];
#pragma unroll
                for (int mm = 0; mm < 2; ++mm)
#pragma unroll
                    for (int bj = 0; bj < 2; ++bj)
#pragma unroll
                        for (int n = 0; n < 2; ++n) x[mm][bj][n] = *(const f32x4*)(X + (size_t)(row0 + ai * HALF + (mh * 2 + mm) * 16) * ldx + col0 + bj * HALF + n * 16);
#pragma unroll
                for (int mm = 0; mm < 2; ++mm)
#pragma unroll
                    for (int bj = 0; bj < 2; ++bj)
#pragma unroll
                        for (int n = 0; n < 2; ++n) *(f32x4*)(X + (size_t)(row0 + ai * HALF + (mh * 2 + mm) * 16) * ldx + col0 + bj * HALF + n * 16) = x[mm][bj][n] + gv[bj][n] * acc[ai][bj][mh * 2 + mm][n];
            }
    }
};

typedef int i32x8 __attribute__((ext_vector_type(8)));
typedef int i32x4 __attribute__((ext_vector_type(4)));
__device__ __forceinline__ i32x8 cat8(const bf16x8 lo, const bf16x8 hi) { const i32x4 a = __builtin_bit_cast(i32x4, lo), b = __builtin_bit_cast(i32x4, hi); return __builtin_shufflevector(a, b, 0, 1, 2, 3, 4, 5, 6, 7); }
template <class Epi, class Sched, int F8 = 0>
__device__ __forceinline__ void gemm_phase(LAS unsigned char* lds, const int tid, const Gemm g, const Sched& S, const Epi& E) {
    const int wid = __builtin_amdgcn_readfirstlane(tid >> 6), lane = tid & 63, wr = wid >> 2, wc = wid & 3, fr = lane & 15, fq = lane >> 4;
    const int K = g.K, nt = F8 ? K / 128 : K / BK, lda = g.lda, ldb = g.ldb;
    unsigned voffA[2], voffB[2];
#pragma unroll
    for (int i = 0; i < 2; ++i) { int R, C; stage_rc(tid * 16 + i * 8192, R, C); const int Rb = Epi::PERM ? ((R & ~31) + perm32(R & 31)) : R;
        voffA[i] = F8 ? (unsigned)(R * lda + C * 2) : (unsigned)(R * lda + C) * 2u; voffB[i] = F8 ? (unsigned)(Rb * ldb + C * 2) : (unsigned)(Rb * ldb + C) * 2u; }
    const size_t kstep = (size_t)(BK * 2);
    const size_t hstepA = (size_t)HALF * lda * (F8 ? 1 : 2), hstepB = (size_t)HALF * ldb * (F8 ? 1 : 2);
    const size_t tstepA = 2 * hstepA, tstepB = 2 * hstepB;
    const unsigned ldsw = (unsigned)wid * 1024u;
    const int aoff = F8 ? lds_byte(wr * 64 + fr, (fq & 1) * 16) + (fq >> 1) * 1024 : lds_byte(wr * 64 + fr, fq * 8);
    const int boff = F8 ? lds_byte(wc * 32 + fr, (fq & 1) * 16) + (fq >> 1) * 1024 : lds_byte(wc * 32 + fr, fq * 8);
#define PG8_SA(b, h) (((b) * 2 + (h)) * HTB)
#define PG8_SB(b, h) ((4 + (b) * 2 + (h)) * HTB)
#define PG8_STAGE(bufoff, gbase, voff) do { _Pragma("unroll") for (int _i = 0; _i < 2; ++_i) \
        __builtin_amdgcn_global_load_lds((const unsigned*)((const char*)(gbase) + (voff)[_i]), (LAS unsigned*)(lds + (bufoff) + ldsw + _i * 8192), 16, 0, 0); } while (0)
#define PG8_LDA(dst, b, h) do { if constexpr (F8) { _Pragma("unroll") for (int m = 0; m < 4; ++m) { const LAS unsigned char* p_ = lds + PG8_SA(b, h) + aoff + m * 2048; \
            const i32x4 lo_ = *(const LAS i32x4*)p_, hi_ = *(const LAS i32x4*)(p_ + 16); dst##8[m] = __builtin_shufflevector(lo_, hi_, 0, 1, 2, 3, 4, 5, 6, 7); } } \
        else { _Pragma("unroll") for (int m = 0; m < 4; ++m) _Pragma("unroll") for (int k = 0; k < 2; ++k) dst[m][k] = *(const LAS bf16x8*)(lds + PG8_SA(b, h) + aoff + m * 2048 + k * 1024); } } while (0)
#define PG8_LDB(dst, b, h) do { if constexpr (F8) { _Pragma("unroll") for (int n = 0; n < 2; ++n) { const LAS unsigned char* p_ = lds + PG8_SB(b, h) + boff + n * 2048; \
            const i32x4 lo_ = *(const LAS i32x4*)p_, hi_ = *(const LAS i32x4*)(p_ + 16); dst##8[n] = __builtin_shufflevector(lo_, hi_, 0, 1, 2, 3, 4, 5, 6, 7); } } \
        else { _Pragma("unroll") for (int n = 0; n < 2; ++n) _Pragma("unroll") for (int k = 0; k < 2; ++k) dst[n][k] = *(const LAS bf16x8*)(lds + PG8_SB(b, h) + boff + n * 2048 + k * 1024); } } while (0)
#define PG8_MMA(ai, bj, At, Bt) do { __builtin_amdgcn_s_setprio(1); \
        if constexpr (F8) { _Pragma("unroll") for (int m = 0; m < 4; ++m) _Pragma("unroll") for (int n = 0; n < 2; ++n) \
            asm volatile("v_mfma_scale_f32_16x16x128_f8f6f4 %0, %1, %2, %0, %3, %3 op_sel_hi:[0,0,0]" : "+v"(acc[ai][bj][m][n]) : "v"(Bt##8[n]), "v"(At##8[m]), "v"(mxscale)); } \
        else { _Pragma("unroll") for (int m = 0; m < 4; ++m) _Pragma("unroll") for (int n = 0; n < 2; ++n) _Pragma("unroll") for (int k = 0; k < 2; ++k) \
            acc[ai][bj][m][n] = __builtin_amdgcn_mfma_f32_16x16x32_bf16(Bt[n][k], At[m][k], acc[ai][bj][m][n], 0, 0, 0); } \
        __builtin_amdgcn_s_setprio(0); } while (0)
#define PG8_WAIT_V(n) asm volatile("s_waitcnt vmcnt(" #n ")" ::: "memory")
#define PG8_WAIT_L(n) asm volatile("s_waitcnt lgkmcnt(" #n ")" ::: "memory")
#define PG8_BAR __builtin_amdgcn_s_barrier()
#define PG8_SCHED __builtin_amdgcn_sched_barrier(0)
    Unit cur, nxt; int ui = 0;
    if (!S.next(0, cur)) return;
    f32x4 acc[2][2][4][2];
#pragma unroll
    for (int a = 0; a < 2; ++a)
#pragma unroll
        for (int b = 0; b < 2; ++b)
#pragma unroll
            for (int m = 0; m < 4; ++m)
#pragma unroll
                for (int n = 0; n < 2; ++n) acc[a][b][m][n] = (f32x4){0.f, 0.f, 0.f, 0.f};
    int mxscale = 0x7f7f7f7f; asm volatile("" : "+v"(mxscale));
    bf16x8 At[4][2], B0[2][2], B1[2][2]; i32x8 At8[4], B08[2], B18[2];
    const char* cA = (const char*)g.A + (size_t)cur.pm * tstepA; const char* cB = (const char*)g.Bt + (size_t)cur.pn * tstepB;
    PG8_STAGE(PG8_SB(0, 0), cB, voffB); PG8_STAGE(PG8_SA(0, 0), cA, voffA); PG8_STAGE(PG8_SB(0, 1), cB + hstepB, voffB); PG8_STAGE(PG8_SA(0, 1), cA + hstepA, voffA);
    if (wr == 1) PG8_BAR;
    PG8_WAIT_V(4); PG8_BAR;
    PG8_STAGE(PG8_SB(1, 0), cB + kstep, voffB); PG8_STAGE(PG8_SA(1, 0), cA + kstep, voffA); PG8_STAGE(PG8_SB(1, 1), cB + hstepB + kstep, voffB);
    PG8_WAIT_V(6); PG8_BAR;
    for (;;) {
        const bool has_next = S.next(ui + 1, nxt);
        const char* nA = has_next ? (const char*)g.A + (size_t)nxt.pm * tstepA : cA; const char* nB = has_next ? (const char*)g.Bt + (size_t)nxt.pn * tstepB : cB;
        for (int t = 0; t < nt; t += 2) {
            const bool last = (t == nt - 2);
            const char* a1 = cA + (size_t)(t + 1) * kstep;
            const char* a2 = last ? nA : cA + (size_t)(t + 2) * kstep; const char* b2 = last ? nB : cB + (size_t)(t + 2) * kstep;
            const char* a3 = a2 + kstep; const char* b3 = b2 + kstep;
            PG8_LDB(B0, 0, 0); PG8_SCHED; PG8_LDA(At, 0, 0); PG8_STAGE(PG8_SA(1, 1), a1 + hstepA, voffA);
            PG8_WAIT_L(8); PG8_BAR; PG8_WAIT_L(0); PG8_MMA(0, 0, At, B0); PG8_BAR; PG8_SCHED;
            PG8_LDB(B1, 0, 1); PG8_STAGE(PG8_SB(0, 0), b2, voffB);
            PG8_BAR; PG8_WAIT_L(0); PG8_MMA(0, 1, At, B1); PG8_BAR;
            PG8_LDA(At, 0, 1); PG8_STAGE(PG8_SA(0, 0), a2, voffA);
            PG8_BAR; PG8_WAIT_L(0); PG8_MMA(1, 0, At, B0); PG8_BAR; PG8_SCHED;
            PG8_STAGE(PG8_SB(0, 1), b2 + hstepB, voffB);
            PG8_WAIT_V(6); PG8_BAR; PG8_MMA(1, 1, At, B1); PG8_BAR;
            PG8_LDB(B0, 1, 0); PG8_SCHED; PG8_LDA(At, 1, 0); PG8_STAGE(PG8_SA(0, 1), a2 + hstepA, voffA);
            PG8_WAIT_L(8); PG8_BAR; PG8_WAIT_L(0); PG8_MMA(0, 0, At, B0); PG8_BAR; PG8_SCHED;
            PG8_LDB(B1, 1, 1); PG8_STAGE(PG8_SB(1, 0), b3, voffB);
            PG8_BAR; PG8_WAIT_L(0); PG8_MMA(0, 1, At, B1); PG8_BAR;
            PG8_LDA(At, 1, 1); PG8_STAGE(PG8_SA(1, 0), a3, voffA);
            PG8_BAR; PG8_WAIT_L(0); PG8_MMA(1, 0, At, B0); PG8_BAR; PG8_SCHED;
            PG8_STAGE(PG8_SB(1, 1), b3 + hstepB, voffB);
            PG8_WAIT_V(6); PG8_BAR; PG8_MMA(1, 1, At, B1); PG8_BAR;
        }
        if constexpr (F8) asm volatile("s_nop 15\n\ts_nop 7");
        E(acc, cur, wr, wc, fr, fq);
        if (!has_next) break;
#pragma unroll
        for (int a = 0; a < 2; ++a)
#pragma unroll
            for (int b = 0; b < 2; ++b)
#pragma unroll
                for (int m = 0; m < 4; ++m)
#pragma unroll
                    for (int n = 0; n < 2; ++n) acc[a][b][m][n] = (f32x4){0.f, 0.f, 0.f, 0.f};
        cur = nxt; cA = nA; cB = nB; ++ui;
    }
    PG8_WAIT_V(0);
    if (wr == 0) PG8_BAR;
    PG8_BAR;
#undef PG8_SA
#undef PG8_SB
#undef PG8_STAGE
#undef PG8_LDA
#undef PG8_LDB
#undef PG8_MMA
#undef PG8_WAIT_V
#undef PG8_WAIT_L
#undef PG8_BAR
#undef PG8_SCHED
}
}

struct Args { const float* in[30]; float* out; unsigned char* ws; int ph_lo, ph_hi; };
enum { I_X = 0, I_C, I_CTX, I_CCTX, I_WMOD, I_BMOD, I_N1G, I_WIN, I_QNG, I_KNG, I_WA2F, I_BAF, I_WA2B, I_BAB, I_ONG, I_MQNG, I_WUQ, I_MKVNG, I_WUKV,
       I_WBRA, I_WBRL, I_WBRM, I_WOUT, I_N2G, I_PWQ, I_PK1, I_PK2, I_PU, I_PV, I_FG };
typedef const float* cfp_t;
struct Ctx {
    const __attribute__((address_space(4))) cfp_t* in; float* out; unsigned char* ws; LAS unsigned char* lds;
    int tid, lane, wid, G, bid;
};
#define WSP(T, off) ((T*)(C.ws + (off)))
#define INP(i) ((const float*)(const GLB float*)C.in[(i)])
__device__ __forceinline__ unsigned long long launder_u64(unsigned long long w) {
    unsigned lo = (unsigned)w, hi = (unsigned)(w >> 32); asm volatile("" : "+v"(lo), "+v"(hi));
    lo = __builtin_amdgcn_readfirstlane(lo); hi = __builtin_amdgcn_readfirstlane(hi); return ((unsigned long long)hi << 32) | lo;
}
__device__ __forceinline__ Ctx launder(const Ctx& C0) {
    Ctx R = C0; int t = C0.tid; asm volatile("" : "+v"(t)); R.tid = t; R.lane = t & 63; R.wid = __builtin_amdgcn_readfirstlane(t >> 6);
    R.ws = (unsigned char*)(GLB unsigned char*)launder_u64((unsigned long long)C0.ws);
    R.out = (float*)(GLB float*)(unsigned long long)C0.out;
    R.in = (const __attribute__((address_space(4))) cfp_t*)launder_u64((unsigned long long)C0.in);
    unsigned l = (unsigned)(uintptr_t)C0.lds; asm volatile("" : "+v"(l)); l = __builtin_amdgcn_readfirstlane(l); R.lds = (LAS unsigned char*)(uintptr_t)l;
    return R;
}

__device__ __forceinline__ const float* src_row(const Ctx& C, int r) {
    const int b = r / RPB, j = r % RPB;
    return j < CTXL ? INP(I_CTX) + ((size_t)b * CTXL + j) * DM : INP(I_X) + ((size_t)b * SEQ + (j - CTXL)) * DM;
}
__device__ __forceinline__ int mod_sel(int r) { const int b = r / RPB, j = r % RPB; return j < CTXL ? 2 : b; }

__device__ __forceinline__ void phase_modv(const Ctx& C) {
    LAS float* sc = (LAS float*)C.lds;
    LAS float* red = (LAS float*)(C.lds + 3 * 2048 * 4);
    for (int i = C.tid; i < 3 * DM; i += NTHREADS) { const int r = i / DM, k = i % DM; const float v = r < 2 ? INP(I_C)[r * DM + k] : INP(I_CCTX)[k]; sc[i] = siluf_(v); }
    __syncthreads();
    float* modv = WSP(float, WS_MODV);
    const int kq = C.tid / 12, c4 = C.tid % 12;
    for (int item = C.bid; item < 2 * 256; item += C.G) {
        const int l = item / 256, cg = item % 256;
        float acc[3][4];
#pragma unroll
        for (int r = 0; r < 3; ++r)
#pragma unroll
            for (int j = 0; j < 4; ++j) acc[r][j] = 0.f;
        if (kq < 42) {
            const float* wp = INP(I_WMOD) + (size_t)l * DM * 12288 + 48 * cg + 4 * c4;
#pragma unroll 1
            for (int k0 = kq; k0 < DM; k0 += 42 * 7) {
                f32x4 w[7];
#pragma unroll
                for (int u = 0; u < 7; ++u) { const int k = k0 + 42 * u; w[u] = k < DM ? *(const f32x4*)(wp + (size_t)k * 12288) : (f32x4){0.f, 0.f, 0.f, 0.f}; }
#pragma unroll
                for (int u = 0; u < 7; ++u) { const int k = k0 + 42 * u; if (k < DM) {
#pragma unroll
                    for (int r = 0; r < 3; ++r) { const float sv = sc[r * DM + k];
#pragma unroll
                        for (int j = 0; j < 4; ++j) acc[r][j] += sv * w[u][j]; } } }
            }
#pragma unroll
            for (int r = 0; r < 3; ++r)
#pragma unroll
                for (int j = 0; j < 4; ++j) red[kq * 144 + r * 48 + c4 * 4 + j] = acc[r][j];
        }
        __syncthreads();
        if (C.tid < 144) { float s = 0.f; for (int q = 0; q < 42; ++q) s += red[q * 144 + C.tid];
            const int r = C.tid / 48, cc = C.tid % 48;
            modv[((size_t)l * 3 + r) * 12288 + 48 * cg + cc] = s + INP(I_BMOD)[(size_t)l * 12288 + 48 * cg + cc]; }
        __syncthreads();
    }
}
__device__ __forceinline__ void phase_tables(const Ctx& C) {
    float* ta = WSP(float, WS_TABA); float* tm = WSP(float, WS_TABM);
    for (int i = C.bid * NTHREADS + C.tid; i < 128 * 32 + 128 * 16; i += C.G * NTHREADS) {
        if (i < 128 * 32) { const int pos = i / 32, f = i % 32; const float inv = exp2f(-(float)f * (13.287712379549449f / 32.0f)); const float a = (float)pos * inv;
            ta[i] = cosf(a); ta[128 * 32 + i] = sinf(a); }
        else { const int k = i - 128 * 32, pos = k / 16, f = k % 16; const float inv = exp2f(-(float)f * (13.287712379549449f / 16.0f)); const float a = (float)pos * inv;
            tm[k] = cosf(a); tm[128 * 16 + k] = sinf(a); }
    }
}
__device__ __forceinline__ void transpose_cvt(const Ctx& C, const float* src, int K, int N, bf16_t* dst, int Npad, int& item) {
    LAS float* tile = (LAS float*)C.lds;
    const int tk = K / 64, tn = Npad / 256, ntile = tk * tn;
    const int t0 = ((C.bid - item % C.G) + C.G) % C.G; item += ntile;
    for (int t = t0; t < ntile; t += C.G) {
        const int k0 = (t / tn) * 64, n0 = (t % tn) * 256;
        const int nn = (C.tid & 63) * 4, kr = C.tid >> 6;
        f32x4 v[8];
#pragma unroll
        for (int p = 0; p < 8; ++p) { v[p] = (f32x4){0.f, 0.f, 0.f, 0.f}; if (n0 + nn < N) v[p] = *(const f32x4*)(src + (size_t)(k0 + kr + p * 8) * N + n0 + nn); }
#pragma unroll
        for (int p = 0; p < 8; ++p)
#pragma unroll
            for (int j = 0; j < 4; ++j) tile[(kr + p * 8) * 257 + nn + j] = v[p][j];
        __syncthreads();
        { const int n = C.tid >> 1, kh = (C.tid & 1) * 32;
#pragma unroll
          for (int q = 0; q < 4; ++q) { float x[8];
#pragma unroll
              for (int j = 0; j < 8; ++j) x[j] = tile[(kh + q * 8 + j) * 257 + n];
              u32x4 w; w.x = cvt_pk_bf16(x[0], x[1]); w.y = cvt_pk_bf16(x[2], x[3]); w.z = cvt_pk_bf16(x[4], x[5]); w.w = cvt_pk_bf16(x[6], x[7]);
              *(u32x4*)(dst + (size_t)(n0 + n) * K + k0 + kh + q * 8) = w; } }
        __syncthreads();
    }
}
__device__ __forceinline__ void transpose_cvt_fp8(const Ctx& C, const float* src, int K, int N, unsigned char* dst, int Npad, float* cinv, const float cmul = 1.0f) {
    LAS float* tile = (LAS float*)C.lds;
    LAS float* red = (LAS float*)(C.lds + 64 * 65 * 4);
    LAS float* scl = red + 32 * 64;
    const int kk = C.tid >> 4, nn = (C.tid & 15) * 4;
    for (int cgp = C.bid; cgp < Npad / 64; cgp += C.G) {
        const int n0 = cgp * 64; const bool live = n0 + nn < N;
        float am[4] = {0.f, 0.f, 0.f, 0.f};
        for (int k0 = 0; k0 < K; k0 += 128) {
            f32x4 v[4];
#pragma unroll
            for (int p = 0; p < 4; ++p) v[p] = live ? *(const f32x4*)(src + (size_t)(k0 + kk + p * 32) * N + n0 + nn) : (f32x4){0.f, 0.f, 0.f, 0.f};
#pragma unroll
            for (int p = 0; p < 4; ++p)
#pragma unroll
                for (int j = 0; j < 4; ++j) am[j] = fmaxf(am[j], fabsf(v[p][j])); }
#pragma unroll
        for (int j = 0; j < 4; ++j) red[kk * 64 + nn + j] = am[j];
        __syncthreads();
        if (C.tid < 64) { float m = 0.f; for (int q = 0; q < 32; ++q) m = fmaxf(m, red[q * 64 + C.tid]);
            scl[C.tid] = m > 0.f ? 224.0f / m : 1.0f; cinv[n0 + C.tid] = (m > 0.f ? m * (1.0f / 224.0f) : 1.0f) * cmul; }
        __syncthreads();
        for (int k0 = 0; k0 < K; k0 += 64) {
#pragma unroll
            for (int p = 0; p < 2; ++p) { const f32x4 v = live ? *(const f32x4*)(src + (size_t)(k0 + kk + p * 32) * N + n0 + nn) : (f32x4){0.f, 0.f, 0.f, 0.f};
#pragma unroll
                for (int j = 0; j < 4; ++j) tile[(kk + p * 32) * 65 + nn + j] = v[j]; }
            __syncthreads();
            { const int n = C.tid >> 3, k8 = (C.tid & 7) * 8; const float sc = scl[n]; float x[8];
#pragma unroll
              for (int j = 0; j < 8; ++j) x[j] = tile[(k8 + j) * 65 + n] * sc;
              int p0 = __builtin_amdgcn_cvt_pk_fp8_f32(x[0], x[1], 0, false); p0 = __builtin_amdgcn_cvt_pk_fp8_f32(x[2], x[3], p0, true);
              int p1 = __builtin_amdgcn_cvt_pk_fp8_f32(x[4], x[5], 0, false); p1 = __builtin_amdgcn_cvt_pk_fp8_f32(x[6], x[7], p1, true);
              u32x2 w; w.x = (unsigned)p0; w.y = (unsigned)p1; *(u32x2*)(dst + (size_t)(n0 + n) * K + k0 + k8) = w; }
            __syncthreads();
        }
    }
}
__device__ __forceinline__ void cvt_plain(const Ctx& C, const float* src, bf16_t* dst, size_t n8) {
    for (size_t i = (size_t)C.bid * NTHREADS + C.tid; i < n8; i += (size_t)C.G * NTHREADS) {
        const f32x4 a = *(const f32x4*)(src + i * 8), b = *(const f32x4*)(src + i * 8 + 4);
        u32x4 w; w.x = cvt_pk_bf16(a[0], a[1]); w.y = cvt_pk_bf16(a[2], a[3]); w.z = cvt_pk_bf16(b[0], b[1]); w.w = cvt_pk_bf16(b[2], b[3]);
        *(u32x4*)(dst + i * 8) = w;
    }
}
__device__ __forceinline__ void phase_cvt_mixer_weights(const Ctx& C, int l) {
    int item = 0;
    transpose_cvt_fp8(C, INP(I_WIN) + (size_t)l * DM * IN_COLS, DM, IN_COLS, C.ws + WS_WIN, NP, WSP(float, WS_WINS));
    __syncthreads();
    transpose_cvt(C, INP(I_WUQ) + (size_t)l * 512 * 1536, 512, 1536, WSP(bf16_t, WS_WUQ), 1536, item);
    transpose_cvt(C, INP(I_WUKV) + (size_t)l * 512 * 2048, 512, 2048, WSP(bf16_t, WS_WUKV), 2048, item);
    transpose_cvt_fp8(C, INP(I_WBRA) + (size_t)l * 1024 * 2048, 1024, 2048, C.ws + WS_WBR, 2048, WSP(float, WS_WBRS), 1.0f / 32.0f); __syncthreads();
    transpose_cvt_fp8(C, INP(I_WBRL) + (size_t)l * 1024 * 2048, 1024, 2048, C.ws + WS_WBR + (size_t)2048 * 1024, 2048, WSP(float, WS_WBRS) + DM, 1.0f); __syncthreads();
    transpose_cvt_fp8(C, INP(I_WBRM) + (size_t)l * 1024 * 2048, 1024, 2048, C.ws + WS_WBR + (size_t)2 * 2048 * 1024, 2048, WSP(float, WS_WBRS) + 2 * DM, 1.0f / 32.0f); __syncthreads();
    transpose_cvt_fp8(C, INP(I_WOUT) + (size_t)l * 2048 * 2048, 2048, 2048, C.ws + WS_WOUT, 2048, WSP(float, WS_WOUTS));
    __syncthreads();
    transpose_cvt(C, INP(I_PWQ) + (size_t)l * 2048 * 2048, 2048, 2048, WSP(bf16_t, WS_WQ), 2048, item);
    cvt_plain(C, INP(I_PK1) + (size_t)l * 8 * 128 * 128, WSP(bf16_t, WS_K1), 8 * 128 * 128 / 8);
    cvt_plain(C, INP(I_PK2) + (size_t)l * 8 * 128 * 128, WSP(bf16_t, WS_K2), 8 * 128 * 128 / 8);
}
__device__ __forceinline__ void phase_cvt_peer_tables(const Ctx& C, int l, int row_lo, int row_hi, int wg_lo) {
    const int lane = C.lane; if (C.bid < wg_lo) return;
    unsigned char* pt = C.ws + WS_PT + (size_t)l * PT_BYTES;
    for (int row = row_lo + (C.bid - wg_lo) * 8 + C.wid; row < row_hi; row += (C.G - wg_lo) * 8) {
#pragma unroll 1
        for (int tb = 0; tb < 2; ++tb) {
            const float* src = (tb ? INP(I_PV) : INP(I_PU)) + ((size_t)l * NEXP + row) * DM + lane * 16;
            f32x4 x[8]; float amax = 0.f;
#pragma unroll
            for (int c = 0; c < 2; ++c)
#pragma unroll
                for (int q = 0; q < 4; ++q) { x[c * 4 + q] = *(const f32x4*)(src + c * 1024 + q * 4);
                    amax = fmaxf(amax, fmaxf(fmaxf(fabsf(x[c * 4 + q][0]), fabsf(x[c * 4 + q][1])), fmaxf(fabsf(x[c * 4 + q][2]), fabsf(x[c * 4 + q][3])))); }
            amax = fmaxf(amax, xchg32(amax, lane)); amax = fmaxf(amax, xchg16(amax, lane)); amax = fmaxf(amax, dppmov<DPP_ROR8>(amax));
            amax = fmaxf(amax, dppmov<DPP_HMIRROR>(amax)); amax = fmaxf(amax, dppmov<DPP_Q3210>(amax)); amax = fmaxf(amax, dppmov<DPP_Q1032>(amax));
            const float sc = amax > 0.f ? 224.0f / amax : 1.0f, inv = amax > 0.f ? amax * (1.0f / 224.0f) : 1.0f;
            unsigned char* dst = pt + (tb ? PT_V8 : PT_U8) + (size_t)(lane >> 3) * ((size_t)NEXP * 128) + (size_t)row * 128 + (lane & 7) * 16;
#pragma unroll
            for (int c = 0; c < 2; ++c) { u32x4 w;
#pragma unroll
                for (int q = 0; q < 4; ++q) { const f32x4 v = x[c * 4 + q] * sc; int p = __builtin_amdgcn_cvt_pk_fp8_f32(v[0], v[1], 0, false); p = __builtin_amdgcn_cvt_pk_fp8_f32(v[2], v[3], p, true); w[q] = (unsigned)p; }
                *(u32x4*)(dst + (size_t)c * 8 * ((size_t)NEXP * 128)) = w; }
            if (lane == 0) ((float*)(pt + (tb ? PT_SCV : PT_SCU)))[row] = inv;
        }
    }
}

template <bool FIRST, bool F8OUT = false> __device__ __forceinline__ void phase_norm_mod(const Ctx& C, const float* gvec, const float* modl  , int shift_off, int scale_off) {
    float* xs = WSP(float, WS_XS); bf16_t* hb = WSP(bf16_t, WS_HB);
    for (int r = C.bid * 8 + C.wid; r < TT; r += C.G * 8) {
        const float* xr = FIRST ? src_row(C, r) : xs + (size_t)r * DM;
        const float* mv = modl + (size_t)mod_sel(r) * 12288;
        f32x4 v[8]; float ss = 0.f;
#pragma unroll
        for (int c = 0; c < 4; ++c) { v[2 * c] = *(const f32x4*)(xr + c * 512 + C.lane * 8); v[2 * c + 1] = *(const f32x4*)(xr + c * 512 + C.lane * 8 + 4); }
#pragma unroll
        for (int c = 0; c < 8; ++c) ss += v[c][0] * v[c][0] + v[c][1] * v[c][1] + v[c][2] * v[c][2] + v[c][3] * v[c][3];
        ss = wave_sum(ss);
        const float rs = rsqrtf(ss * (1.0f / DM) + NORM_EPS);
#pragma unroll
        for (int c = 0; c < 4; ++c) { const int col = c * 512 + C.lane * 8;
            if (FIRST) { *(f32x4*)(xs + (size_t)r * DM + col) = v[2 * c]; *(f32x4*)(xs + (size_t)r * DM + col + 4) = v[2 * c + 1]; }
            float o[8];
#pragma unroll
            for (int h = 0; h < 2; ++h) { const f32x4 g = *(const f32x4*)(gvec + col + 4 * h), s = *(const f32x4*)(mv + scale_off + col + 4 * h), t = *(const f32x4*)(mv + shift_off + col + 4 * h);
#pragma unroll
                for (int j = 0; j < 4; ++j) o[4 * h + j] = v[2 * c + h][j] * rs * g[j] * (1.0f + s[j]) + t[j]; }
            if constexpr (F8OUT) {
                int p0 = __builtin_amdgcn_cvt_pk_fp8_f32(o[0], o[1], 0, false); p0 = __builtin_amdgcn_cvt_pk_fp8_f32(o[2], o[3], p0, true);
                int p1 = __builtin_amdgcn_cvt_pk_fp8_f32(o[4], o[5], 0, false); p1 = __builtin_amdgcn_cvt_pk_fp8_f32(o[6], o[7], p1, true);
                u32x2 w; w.x = (unsigned)p0; w.y = (unsigned)p1; *(u32x2*)((unsigned char*)hb + (size_t)r * DM + col) = w;
            } else {
            u32x4 w; w.x = cvt_pk_bf16(o[0], o[1]); w.y = cvt_pk_bf16(o[2], o[3]); w.z = cvt_pk_bf16(o[4], o[5]); w.w = cvt_pk_bf16(o[6], o[7]);
            *(u32x4*)(hb + (size_t)r * DM + col) = w; } }
    }
}

__device__ __forceinline__ void phase_post_p(const Ctx& C, int l) {
    bf16_t* P = WSP(bf16_t, WS_P); const float* ta = WSP(float, WS_TABA); const float* tm = WSP(float, WS_TABM);
    const float* qg = INP(I_QNG) + l * 128; const float* kg = INP(I_KNG) + l * 128;
    const float* mqg = INP(I_MQNG) + l * 512; const float* mkvg = INP(I_MKVNG) + l * 512;
    const int lane = C.lane;
    const float qg1 = qg[lane], qg2 = qg[lane + 64], kg1 = kg[lane], kg2 = kg[lane + 64];
    for (int r = C.bid * 8 + C.wid; r < TT; r += C.G * 8) {
        bf16_t* pr = P + (size_t)r * NP;
        const int j = r % RPB; const bool lat = j >= CTXL; const int pos = lat ? j - CTXL : 0, ri = pos >> 6, ci = pos & 63;
        float cs = 1.f, sn = 0.f;
        if (lat) { const int p = lane < 32 ? ri : ci, f = lane & 31; cs = ta[p * 32 + f]; sn = ta[128 * 32 + p * 32 + f]; }
#pragma unroll
        for (int h = 0; h < 10; ++h) {
            bf16_t* hp = pr + (h < 8 ? C_AQ + h * 128 : C_AK + (h - 8) * 128);
            const float x1 = bf2f(hp[lane]), x2 = bf2f(hp[lane + 64]);
            const float ss = wave_sum(x1 * x1 + x2 * x2);
            const float rs = rsqrtf(ss * (1.0f / 128.0f) + NORM_EPS);
            const float y1 = x1 * rs * (h < 8 ? qg1 : kg1), y2 = x2 * rs * (h < 8 ? qg2 : kg2);
            const float z1 = y1 * cs - y2 * sn, z2 = y2 * cs + y1 * sn;
            hp[lane] = f2bf(z1); hp[lane + 64] = f2bf(z2);
            if (h >= 8) { unsigned char* k8 = C.ws + WS_AK8 + (size_t)r * 256 + (h - 8) * 128;
                k8[lane] = (unsigned char)(__builtin_amdgcn_cvt_pk_fp8_f32(z1, 0.f, 0, false) & 0xff); k8[lane + 64] = (unsigned char)(__builtin_amdgcn_cvt_pk_fp8_f32(z2, 0.f, 0, false) & 0xff); }
        }
#pragma unroll
        for (int s = 0; s < 2; ++s) {
            bf16_t* sp = pr + (s == 0 ? C_MCQ : C_MCKV) + lane * 8; const float* gg = (s == 0 ? mqg : mkvg) + lane * 8;
            const u32x4 w = *(const u32x4*)sp; float x[8] = {bflo(w.x), bfhi(w.x), bflo(w.y), bfhi(w.y), bflo(w.z), bfhi(w.z), bflo(w.w), bfhi(w.w)};
            float ss = 0.f;
#pragma unroll
            for (int i = 0; i < 8; ++i) ss += x[i] * x[i];
            ss = wave_sum(ss);
            const float rs = rsqrtf(ss * (1.0f / 512.0f) + NORM_EPS);
#pragma unroll
            for (int i = 0; i < 8; ++i) x[i] = x[i] * rs * gg[i];
            u32x4 o; o.x = cvt_pk_bf16(x[0], x[1]); o.y = cvt_pk_bf16(x[2], x[3]); o.z = cvt_pk_bf16(x[4], x[5]); o.w = cvt_pk_bf16(x[6], x[7]);
            *(u32x4*)sp = o;
        }
        { bf16_t* kp = pr + C_MKR; const int i = lane & 31; const float x1 = bf2f(kp[i]), x2 = bf2f(kp[i + 32]);
          float c2 = 1.f, s2 = 0.f; if (lat) { const int p = i < 16 ? ri : ci, f = i & 15; c2 = tm[p * 16 + f]; s2 = tm[128 * 16 + p * 16 + f]; }
          const float z1 = x1 * c2 - x2 * s2, z2 = x2 * c2 + x1 * s2;
          if (lane < 32) { if (lat) { kp[i] = f2bf(z1); kp[i + 32] = f2bf(z2); }
              unsigned char* k8 = C.ws + WS_KR8 + (size_t)r * 64; k8[i] = (unsigned char)(__builtin_amdgcn_cvt_pk_fp8_f32(z1, 0.f, 0, false) & 0xff); k8[i + 32] = (unsigned char)(__builtin_amdgcn_cvt_pk_fp8_f32(z2, 0.f, 0, false) & 0xff); } }
    }
}

typedef int i32x8 __attribute__((ext_vector_type(8)));
typedef int i32x4 __attribute__((ext_vector_type(4)));
namespace att {
constexpr int NW = 8, QBLK = 32, KVBLK = 64, DV = 128;
constexpr float THR = 8.f;
#define SBAR() __builtin_amdgcn_sched_barrier(0)
__device__ __forceinline__ int crow(int r, int hi) { return (r & 3) + 8 * (r >> 2) + 4 * hi; }
template <int DQ> struct Cf {
    static constexpr int ND0 = DQ / 16, KROWB = DQ * 2, SHM_K = KVBLK * DQ * 2, SHM_V = KVBLK * DV * 2, SHM = 2 * SHM_V + 2 * SHM_K + NW * 64 * 4;
    static constexpr float SCALE = DQ == 128 ? 0.088388347648318440f : 0.072168783648703220f;
    __device__ static __forceinline__ int kswz(int row, int colB) { return row * KROWB + (colB ^ ((row & 7) << 4)); }
};
template <int DQ, int VAR = 0> __device__ __forceinline__ void partialSM(f32x16& p0, f32x16& p1, float& m_reg, float& mn, float& alpha, const float thr = THR) {
    constexpr float SC = Cf<DQ>::SCALE, Cc = SC * 1.4426950408889634f;
    float pmax = p0[0];
#pragma unroll
    for (int r = 1; r < 16; ++r) pmax = fmaxf(pmax, p0[r]);
#pragma unroll
    for (int r = 0; r < 16; ++r) pmax = fmaxf(pmax, p1[r]);
    { auto rr = __builtin_amdgcn_permlane32_swap(__float_as_uint(pmax), __float_as_uint(pmax), false, false);
      pmax = fmaxf(__uint_as_float(rr[0]), __uint_as_float(rr[1])); }
    if (__builtin_expect(__all(pmax - m_reg <= thr / SC), 1)) { mn = m_reg; alpha = 1.f; }
    else { mn = fmaxf(m_reg, pmax); alpha = __builtin_amdgcn_exp2f((m_reg - mn) * Cc); m_reg = mn; }
    const float mnC = -mn * Cc;
#pragma unroll
    for (int r = 0; r < 16; ++r) p0[r] = fmaf(p0[r], Cc, mnC);
#pragma unroll
    for (int r = 0; r < 16; ++r) p1[r] = fmaf(p1[r], Cc, mnC);
#pragma unroll
    for (int r = 0; r < 16; ++r) p0[r] = VAR == 1 ? p0[r] * 0.001f : __builtin_amdgcn_exp2f(p0[r]);
}
template <int VAR = 0> __device__ __forceinline__ void finishSM(f32x16& p0, f32x16& p1, float alpha, float& l_reg, bf16x8& pa0, bf16x8& pa1, bf16x8& pa2, bf16x8& pa3) {
#pragma unroll
    for (int r = 0; r < 16; ++r) p1[r] = VAR == 1 ? p1[r] * 0.001f : __builtin_amdgcn_exp2f(p1[r]);
    float ps = 0;
#pragma unroll
    for (int r = 0; r < 16; ++r) ps += p0[r];
#pragma unroll
    for (int r = 0; r < 16; ++r) ps += p1[r];
    { auto rr = __builtin_amdgcn_permlane32_swap(__float_as_uint(ps), __float_as_uint(ps), false, false);
      ps = __uint_as_float(rr[0]) + __uint_as_float(rr[1]); }
    l_reg = l_reg * alpha + ps;
#define PK4(P, BASE, OUT) do { unsigned a0 = cvt_pk_bf16(P[BASE + 0], P[BASE + 1]), a1 = cvt_pk_bf16(P[BASE + 2], P[BASE + 3]);   \
    unsigned b0 = cvt_pk_bf16(P[BASE + 4], P[BASE + 5]), b1 = cvt_pk_bf16(P[BASE + 6], P[BASE + 7]);                              \
    auto r0 = __builtin_amdgcn_permlane32_swap(a0, b0, false, false); auto r1 = __builtin_amdgcn_permlane32_swap(a1, b1, false, false); \
    u32x4 w = {r0[0], r1[0], r0[1], r1[1]}; OUT = *reinterpret_cast<bf16x8*>(&w); } while (0)
    PK4(p0, 0, pa0); PK4(p0, 8, pa1); PK4(p1, 0, pa2); PK4(p1, 8, pa3);
#undef PK4
}
template <int DQ> __device__ __forceinline__ void qkt(f32x16& p0, f32x16& p1, const char* Ks, const bf16x8* qr, const char* qx, int r32, int hi) {
    p0 = f32x16{}; p1 = f32x16{};
#pragma unroll
    for (int d0 = 0; d0 < Cf<DQ>::ND0; ++d0) { const int cb = (d0 * 16 + hi * 8) * 2;
        const bf16x8 b0 = *reinterpret_cast<const bf16x8*>(Ks + Cf<DQ>::kswz(r32, cb));
        const bf16x8 b1 = *reinterpret_cast<const bf16x8*>(Ks + Cf<DQ>::kswz(32 + r32, cb));
        constexpr int NQR = DQ == 192 ? MLA_NQR : 8;
        bf16x8 q; if (d0 < NQR) q = qr[d0]; else q = *reinterpret_cast<const bf16x8*>(qx + (d0 - NQR) * 1024);
        p0 = __builtin_amdgcn_mfma_f32_32x32x16_bf16(b0, q, p0, 0, 0, 0);
        p1 = __builtin_amdgcn_mfma_f32_32x32x16_bf16(b1, q, p1, 0, 0, 0); }
}
__device__ __forceinline__ int v_st(int k, int c) { const int kk = (k & ~0xC) | ((k & 4) << 1) | ((k & 8) >> 1); return ((kk >> 3) * 4 + (c >> 5)) * 512 + ((kk & 7) * 32 + (c & 31)) * 2; }
__device__ __forceinline__ int v_rd_base(int lane) { return ((lane & 3) << 3) | (((lane >> 2) & 3) << 6) | (((lane >> 4) & 1) << 5) | (((lane >> 5) & 1) << 8); }
constexpr int v_rd_off(int d0, int ks, int half) { return d0 * 512 + ks * 4096 + half * 2048; }
template <int OFF> __device__ __forceinline__ s16x4 tr_read(int vb) {
    s16x4 r; asm volatile("ds_read_b64_tr_b16 %0, %1 offset:%2" : "=&v"(r) : "v"(vb), "i"(OFF) : "memory"); return r;
}
template <int D0> __device__ __forceinline__ void pv_one(f32x16& od, int vb, bf16x8 pa0, bf16x8 pa1, bf16x8 pa2, bf16x8 pa3) {
    const s16x4 l0 = tr_read<v_rd_off(D0, 0, 0)>(vb), h0 = tr_read<v_rd_off(D0, 0, 1)>(vb), l1 = tr_read<v_rd_off(D0, 1, 0)>(vb), h1 = tr_read<v_rd_off(D0, 1, 1)>(vb);
    const s16x4 l2 = tr_read<v_rd_off(D0, 2, 0)>(vb), h2 = tr_read<v_rd_off(D0, 2, 1)>(vb), l3 = tr_read<v_rd_off(D0, 3, 0)>(vb), h3 = tr_read<v_rd_off(D0, 3, 1)>(vb);
    asm volatile("s_waitcnt lgkmcnt(0)" ::: "memory"); SBAR();
#define PK(L, H) (bf16x8){L[0], L[1], L[2], L[3], H[0], H[1], H[2], H[3]}
    od = __builtin_amdgcn_mfma_f32_32x32x16_bf16(pa0, PK(l0, h0), od, 0, 0, 0);
    od = __builtin_amdgcn_mfma_f32_32x32x16_bf16(pa1, PK(l1, h1), od, 0, 0, 0);
    od = __builtin_amdgcn_mfma_f32_32x32x16_bf16(pa2, PK(l2, h2), od, 0, 0, 0);
    od = __builtin_amdgcn_mfma_f32_32x32x16_bf16(pa3, PK(l3, h3), od, 0, 0, 0);
#undef PK
}
__device__ __forceinline__ void pv_d0(f32x16* o, int vb, bf16x8 pa0, bf16x8 pa1, bf16x8 pa2, bf16x8 pa3) {
    pv_one<0>(o[0], vb, pa0, pa1, pa2, pa3); pv_one<1>(o[1], vb, pa0, pa1, pa2, pa3); pv_one<2>(o[2], vb, pa0, pa1, pa2, pa3); pv_one<3>(o[3], vb, pa0, pa1, pa2, pa3);
}
__device__ __forceinline__ bf16x8 ld8(const bf16_t* p) { return *reinterpret_cast<const bf16x8*>(p); }

template <int DQ, int SD, int VAR = 0>
__device__ __forceinline__ void attn_body(const bf16_t* __restrict__ Qb, int ldq, const bf16_t* __restrict__ Kn, int ldkn, const bf16_t* __restrict__ Kr, int ldkr,
                                          const bf16_t* __restrict__ Vh, int ldv, unsigned char* __restrict__ Ob, int ldo, int seq, bool rope_q, int pos0, const float* __restrict__ tabM, char* lds, const int tid) {
    using CF = Cf<DQ>; constexpr int ND0 = CF::ND0, SHM_V = CF::SHM_V, SHM_K = CF::SHM_K;
    const int wid = tid >> 6, lane = tid & 63, r32 = lane & 31, hi = lane >> 5;
    char* V_lds = lds; char* K_lds = lds + 2 * SHM_V;
    float* ws = (float*)(lds + 2 * SHM_V + 2 * SHM_K) + wid * 64; float* li_l = ws; float* al_l = ws + 32;
    constexpr int NQR = DQ == 192 ? MLA_NQR : 8;
    float m_reg = -1e30f, l_reg = 0; f32x16 o[4] = {}; bf16x8 qr[NQR];
    const bf16_t* Qw = Qb + (long)(wid * QBLK + r32) * ldq + hi * 8;
#pragma unroll
    for (int d0 = 0; d0 < NQR; ++d0) qr[d0] = ld8(Qw + d0 * 16);
    char* qx = lds + CF::SHM + wid * 8192 + lane * 16;
    if constexpr (DQ == 192) {
#pragma unroll
        for (int d0 = NQR; d0 < 8; ++d0) *(bf16x8*)(qx + (d0 - NQR) * 1024) = ld8(Qw + d0 * 16);
        bf16x8 qe[4];
#pragma unroll
        for (int d0 = 0; d0 < 4; ++d0) qe[d0] = ld8(Qw + (8 + d0) * 16);
        if (rope_q) {
            const int pos = pos0 + wid * QBLK + r32, ri = pos >> 6, ci = pos & 63;
#pragma unroll
            for (int t = 0; t < 2; ++t) { const int p = t == 0 ? ri : ci; const float* tc = tabM + p * 16 + hi * 8; const float* tsn = tabM + 128 * 16 + p * 16 + hi * 8;
                bf16x8 a = qe[t], b = qe[2 + t];
#pragma unroll
                for (int jj = 0; jj < 8; ++jj) { const float x1 = bf2f((bf16_t)a[jj]), x2 = bf2f((bf16_t)b[jj]), c = tc[jj], s = tsn[jj];
                    a[jj] = (short)f2bf(x1 * c - x2 * s); b[jj] = (short)f2bf(x2 * c + x1 * s); }
                qe[t] = a; qe[2 + t] = b; }
        }
#pragma unroll
        for (int d0 = 0; d0 < 4; ++d0) *(bf16x8*)(qx + (8 - NQR + d0) * 1024) = qe[d0];
    }
    const int sr = tid >> 4, sc = (tid & 15) * 8, vst0 = v_st(sr, sc), vst1 = v_st(32 + sr, sc);
    const int sr2 = tid >> 3, sc2 = (tid & 7) * 8;
    const int vb0 = (int)(uintptr_t)V_lds + v_rd_base(lane);
    struct { bf16x8 vs0, vs1, ks0, ks1, ks2; } sr_[SD];
    const unsigned offV = (unsigned)(sr * ldv + sc) * 2u, offK = (unsigned)(sr * ldkn + sc) * 2u, offR = (unsigned)(sr2 * ldkr + sc2) * 2u;
#define SLOAD(i, k0) do { const char* vt_ = (const char*)Vh + (size_t)(k0) * ldv * 2; const char* kt_ = (const char*)Kn + (size_t)(k0) * ldkn * 2; \
    sr_[i].vs0 = *(const bf16x8*)(vt_ + offV); sr_[i].vs1 = *(const bf16x8*)(vt_ + (size_t)32 * ldv * 2 + offV); \
    sr_[i].ks0 = *(const bf16x8*)(kt_ + offK); sr_[i].ks1 = *(const bf16x8*)(kt_ + (size_t)32 * ldkn * 2 + offK); \
    if constexpr (DQ == 192) sr_[i].ks2 = *(const bf16x8*)((const char*)Kr + (size_t)(k0) * ldkr * 2 + offR); } while (0)
#define SWRITE(b, i) do { *(bf16x8*)(V_lds + (b) * SHM_V + vst0) = sr_[i].vs0; *(bf16x8*)(V_lds + (b) * SHM_V + vst1) = sr_[i].vs1; const int kc = sc * 2; \
    *(bf16x8*)(K_lds + (b) * SHM_K + CF::kswz(sr, kc)) = sr_[i].ks0; *(bf16x8*)(K_lds + (b) * SHM_K + CF::kswz(32 + sr, kc)) = sr_[i].ks1; \
    if constexpr (DQ == 192) *(bf16x8*)(K_lds + (b) * SHM_K + CF::kswz(sr2, 256 + sc2 * 2)) = sr_[i].ks2; } while (0)
#define SWAIT() do { if constexpr (SD == 1) asm volatile("s_waitcnt vmcnt(0)" ::: "memory"); else if constexpr (DQ == 192) asm volatile("s_waitcnt vmcnt(5)" ::: "memory"); else asm volatile("s_waitcnt vmcnt(4)" ::: "memory"); } while (0)
#define RESC(a) do { if (__any((a) < 1.f)) { if (hi == 0) al_l[r32] = (a); asm volatile("s_waitcnt lgkmcnt(0)" ::: "memory"); \
    _Pragma("unroll") for (int d = 0; d < 4; ++d) _Pragma("unroll") for (int r = 0; r < 16; ++r) o[d][r] *= al_l[crow(r, hi)]; } } while (0)
    f32x16 pA0, pA1, pB0, pB1; float mnA, mnB, alA, alB; bf16x8 pa0, pa1, pa2, pa3; const int NT = seq / KVBLK;
    constexpr int SE = 0, SO = SD - 1;
    SLOAD(SE, 0); asm volatile("s_waitcnt vmcnt(0)" ::: "memory"); SWRITE(0, SE); __syncthreads();
    qkt<DQ>(pA0, pA1, K_lds, qr, qx, r32, hi); partialSM<DQ, VAR>(pA0, pA1, m_reg, mnA, alA);
    SLOAD(SO, KVBLK); if constexpr (SD == 2) { if (2 < NT) SLOAD(SE, 2 * KVBLK); }
    SWAIT(); SWRITE(1, SO); __syncthreads();
#define ATT_SYNC() do { if constexpr (VAR != 2) __syncthreads(); } while (0)
    for (int j = 1; j + 1 < NT; j += 2) {
        SBAR(); qkt<DQ>(pB0, pB1, K_lds + SHM_K, qr, qx, r32, hi);
        finishSM<VAR>(pA0, pA1, alA, l_reg, pa0, pa1, pa2, pa3); SBAR();
        if constexpr (VAR != 3) SLOAD(SO, (j + SD) * KVBLK); SBAR();
        pv_d0(o, vb0, pa0, pa1, pa2, pa3); partialSM<DQ, VAR>(pB0, pB1, m_reg, mnB, alB);
        ATT_SYNC(); SWAIT(); SWRITE(0, SE);
        RESC(alB); ATT_SYNC();
        SBAR(); qkt<DQ>(pA0, pA1, K_lds, qr, qx, r32, hi);
        finishSM<VAR>(pB0, pB1, alB, l_reg, pa0, pa1, pa2, pa3); SBAR();
        if constexpr (VAR != 3) { if (SD == 1 || j + 3 < NT) SLOAD(SE, (j + 1 + SD) * KVBLK); } SBAR();
        pv_d0(o, vb0 + SHM_V, pa0, pa1, pa2, pa3); partialSM<DQ, VAR>(pA0, pA1, m_reg, mnA, alA);
        ATT_SYNC(); SWAIT(); SWRITE(1, SO);
        RESC(alA); ATT_SYNC();
    }
    SBAR(); qkt<DQ>(pB0, pB1, K_lds + SHM_K, qr, qx, r32, hi);
    finishSM<VAR>(pA0, pA1, alA, l_reg, pa0, pa1, pa2, pa3); SBAR();
    pv_d0(o, vb0, pa0, pa1, pa2, pa3); partialSM<DQ, VAR>(pB0, pB1, m_reg, mnB, alB);
    ATT_SYNC(); RESC(alB);
    finishSM<VAR>(pB0, pB1, alB, l_reg, pa0, pa1, pa2, pa3); SBAR();
    pv_d0(o, vb0 + SHM_V, pa0, pa1, pa2, pa3);
    if (hi == 0) li_l[r32] = l_reg; asm volatile("s_waitcnt lgkmcnt(0)" ::: "memory");
    float rli[16];
#pragma unroll
    for (int r = 0; r < 16; ++r) rli[r] = __builtin_amdgcn_rcpf(li_l[crow(r, hi)]);
    unsigned char* Ow = Ob + (long)(wid * QBLK) * ldo;
#pragma unroll
    for (int r = 0; r < 16; ++r) { const int orow = crow(r, hi);
#pragma unroll
        for (int d0 = 0; d0 < 4; ++d0) Ow[(long)orow * ldo + d0 * 32 + r32] = (unsigned char)(__builtin_amdgcn_cvt_pk_fp8_f32(o[d0][r] * rli[r] * 32.0f, 0.f, 0, false) & 0xff); }
#undef SLOAD
#undef ATT_SYNC
#undef SWRITE
#undef SWAIT
#undef RESC
}

__device__ __forceinline__ int k8addr(int row, int b, int DQ_) { return row * DQ_ + (b < 128 ? (b ^ ((row & 7) << 4)) : 128 + ((b - 128) ^ ((row & 3) << 4))); }
#define MX32(ACC, A, B, SC) asm volatile("s_nop 1\n\tv_mfma_scale_f32_32x32x64_f8f6f4 %0, %1, %2, %0, %3, %3 op_sel_hi:[0,0,0]" : "+v"(ACC) : "v"(A), "v"(B), "v"(SC))
template <int DQ> __device__ __forceinline__ void qkt8(f32x16& p0, f32x16& p1, const char* Ks, const i32x8* qf, int r32, int hi) {
    p0 = f32x16{}; p1 = f32x16{}; int mxs = 0x7f7f7f7f; asm volatile("" : "+v"(mxs));
#pragma unroll
    for (int ks = 0; ks < DQ / 64; ++ks) { const int b = ks * 64 + hi * 32;
        const i32x4 a0l = *reinterpret_cast<const i32x4*>(Ks + k8addr(r32, b, DQ)), a0h = *reinterpret_cast<const i32x4*>(Ks + k8addr(r32, b + 16, DQ));
        const i32x4 a1l = *reinterpret_cast<const i32x4*>(Ks + k8addr(32 + r32, b, DQ)), a1h = *reinterpret_cast<const i32x4*>(Ks + k8addr(32 + r32, b + 16, DQ));
        const i32x8 a0 = __builtin_shufflevector(a0l, a0h, 0, 1, 2, 3, 4, 5, 6, 7), a1 = __builtin_shufflevector(a1l, a1h, 0, 1, 2, 3, 4, 5, 6, 7);
        MX32(p0, a0, qf[ks], mxs); MX32(p1, a1, qf[ks], mxs); }
    asm volatile("s_nop 15\n\ts_nop 7");
}
__device__ __forceinline__ int pk4_fp8(float a, float b, float c, float d) { int p = __builtin_amdgcn_cvt_pk_fp8_f32(a, b, 0, false); return __builtin_amdgcn_cvt_pk_fp8_f32(c, d, p, true); }
template <int DQ>
__device__ __forceinline__ void attn_body8(const bf16_t* __restrict__ Qb, int ldq, const unsigned char* __restrict__ Kn8, int ldkn, const unsigned char* __restrict__ Kr8, int ldkr,
                                           const bf16_t* __restrict__ Vh, int ldv, unsigned char* __restrict__ Ob, int ldo, int seq, bool rope_q, int pos0, const float* __restrict__ tabM, char* lds, const int tid) {
    constexpr int NKS = DQ / 64, SHM_V = KVBLK * DV * 2, SHM_K = KVBLK * DQ;
    const int wid = tid >> 6, lane = tid & 63, r32 = lane & 31, hi = lane >> 5;
    char* V_lds = lds; char* K_lds = lds + 2 * SHM_V;
    float* ws = (float*)(lds + 2 * SHM_V + 2 * SHM_K) + wid * 64; float* li_l = ws; float* al_l = ws + 32;
    float m_reg = -1e30f, l_reg = 0; f32x16 o[4] = {}; i32x8 qf[NKS];
    const bf16_t* Qrow = Qb + (long)(wid * QBLK + r32) * ldq;
#pragma unroll
    for (int ks = 0; ks < NKS; ++ks) {
        float x[32];
#pragma unroll
        for (int c = 0; c < 4; ++c) { const u32x4 w = *(const u32x4*)(Qrow + ks * 64 + hi * 32 + c * 8);
            x[c * 8 + 0] = bflo(w.x); x[c * 8 + 1] = bfhi(w.x); x[c * 8 + 2] = bflo(w.y); x[c * 8 + 3] = bfhi(w.y); x[c * 8 + 4] = bflo(w.z); x[c * 8 + 5] = bfhi(w.z); x[c * 8 + 6] = bflo(w.w); x[c * 8 + 7] = bfhi(w.w); }
        if (DQ == 192 && ks == 2 && rope_q) {
            float y[32];
#pragma unroll
            for (int c = 0; c < 4; ++c) { const u32x4 w = *(const u32x4*)(Qrow + 128 + (1 - hi) * 32 + c * 8);
                y[c * 8 + 0] = bflo(w.x); y[c * 8 + 1] = bfhi(w.x); y[c * 8 + 2] = bflo(w.y); y[c * 8 + 3] = bfhi(w.y); y[c * 8 + 4] = bflo(w.z); y[c * 8 + 5] = bfhi(w.z); y[c * 8 + 6] = bflo(w.w); y[c * 8 + 7] = bfhi(w.w); }
            const int pos = pos0 + wid * QBLK + r32, ri = pos >> 6, ci = pos & 63;
#pragma unroll
            for (int i = 0; i < 32; ++i) { const int p = i < 16 ? ri : ci, f = i & 15; const float c_ = tabM[p * 16 + f], s_ = tabM[128 * 16 + p * 16 + f];
                x[i] = hi ? x[i] * c_ + y[i] * s_ : x[i] * c_ - y[i] * s_; }
        }
        i32x8 q8;
#pragma unroll
        for (int j = 0; j < 8; ++j) q8[j] = pk4_fp8(x[4 * j], x[4 * j + 1], x[4 * j + 2], x[4 * j + 3]);
        qf[ks] = q8;
    }
    const int sr = tid >> 4, sc = (tid & 15) * 8, vst0 = v_st(sr, sc), vst1 = v_st(32 + sr, sc);
    const int kr = tid >> 3, kb = (tid & 7) * 16;
    const int kr2 = (tid & 255) >> 2, kb2 = (tid & 3) * 16;
    const int vb0 = (int)(uintptr_t)V_lds + v_rd_base(lane);
    struct { bf16x8 vs0, vs1; u32x4 k0, k1; } sr_[1];
    const unsigned offV = (unsigned)(sr * ldv + sc) * 2u, offK = (unsigned)(kr * ldkn + kb), offR = (unsigned)(kr2 * ldkr + kb2);
#define SLOAD8(k0_) do { const char* vt_ = (const char*)Vh + (size_t)(k0_) * ldv * 2; \
    sr_[0].vs0 = *(const bf16x8*)(vt_ + offV); sr_[0].vs1 = *(const bf16x8*)(vt_ + (size_t)32 * ldv * 2 + offV); \
    sr_[0].k0 = *(const u32x4*)(Kn8 + (size_t)(k0_) * ldkn + offK); \
    if constexpr (DQ == 192) { if (tid < 256) sr_[0].k1 = *(const u32x4*)(Kr8 + (size_t)(k0_) * ldkr + offR); } } while (0)
#define SWRITE8(b) do { *(bf16x8*)(V_lds + (b) * SHM_V + vst0) = sr_[0].vs0; *(bf16x8*)(V_lds + (b) * SHM_V + vst1) = sr_[0].vs1; \
    *(u32x4*)(K_lds + (b) * SHM_K + k8addr(kr, kb, DQ)) = sr_[0].k0; \
    if constexpr (DQ == 192) { if (tid < 256) *(u32x4*)(K_lds + (b) * SHM_K + k8addr(kr2, 128 + kb2, DQ)) = sr_[0].k1; } } while (0)
#define SWAIT8() asm volatile("s_waitcnt vmcnt(0)" ::: "memory")
#define RESC8(a) do { if (__any((a) < 1.f)) { if (hi == 0) al_l[r32] = (a); asm volatile("s_waitcnt lgkmcnt(0)" ::: "memory"); \
    _Pragma("unroll") for (int d = 0; d < 4; ++d) _Pragma("unroll") for (int r = 0; r < 16; ++r) o[d][r] *= al_l[crow(r, hi)]; } } while (0)
    f32x16 pA0, pA1, pB0, pB1; float mnA, mnB, alA, alB; bf16x8 pa0, pa1, pa2, pa3; const int NT = seq / KVBLK;
    SLOAD8(0); SWAIT8(); SWRITE8(0); __syncthreads();
    qkt8<DQ>(pA0, pA1, K_lds, qf, r32, hi); partialSM<DQ, 0>(pA0, pA1, m_reg, mnA, alA);
    SLOAD8(KVBLK);
    SWAIT8(); SWRITE8(1); __syncthreads();
    for (int j = 1; j + 1 < NT; j += 2) {
        SBAR(); qkt8<DQ>(pB0, pB1, K_lds + SHM_K, qf, r32, hi);
        finishSM<0>(pA0, pA1, alA, l_reg, pa0, pa1, pa2, pa3); SBAR();
        SLOAD8((j + 1) * KVBLK); SBAR();
        pv_d0(o, vb0, pa0, pa1, pa2, pa3); partialSM<DQ, 0>(pB0, pB1, m_reg, mnB, alB);
        __syncthreads(); SWAIT8(); SWRITE8(0);
        RESC8(alB); __syncthreads();
        SBAR(); qkt8<DQ>(pA0, pA1, K_lds, qf, r32, hi);
        finishSM<0>(pB0, pB1, alB, l_reg, pa0, pa1, pa2, pa3); SBAR();
        SLOAD8((j + 2) * KVBLK); SBAR();
        pv_d0(o, vb0 + SHM_V, pa0, pa1, pa2, pa3); partialSM<DQ, 0>(pA0, pA1, m_reg, mnA, alA);
        __syncthreads(); SWAIT8(); SWRITE8(1);
        RESC8(alA); __syncthreads();
    }
    SBAR(); qkt8<DQ>(pB0, pB1, K_lds + SHM_K, qf, r32, hi);
    finishSM<0>(pA0, pA1, alA, l_reg, pa0, pa1, pa2, pa3); SBAR();
    pv_d0(o, vb0, pa0, pa1, pa2, pa3); partialSM<DQ, 0>(pB0, pB1, m_reg, mnB, alB);
    __syncthreads(); RESC8(alB);
    finishSM<0>(pB0, pB1, alB, l_reg, pa0, pa1, pa2, pa3); SBAR();
    pv_d0(o, vb0 + SHM_V, pa0, pa1, pa2, pa3);
    if (hi == 0) li_l[r32] = l_reg; asm volatile("s_waitcnt lgkmcnt(0)" ::: "memory");
    float rli[16];
#pragma unroll
    for (int r = 0; r < 16; ++r) rli[r] = __builtin_amdgcn_rcpf(li_l[crow(r, hi)]);
    unsigned char* Ow = Ob + (long)(wid * QBLK) * ldo;
#pragma unroll
    for (int r = 0; r < 16; ++r) { const int orow = crow(r, hi);
#pragma unroll
        for (int d0 = 0; d0 < 4; ++d0) Ow[(long)orow * ldo + d0 * 32 + r32] = (unsigned char)(__builtin_amdgcn_cvt_pk_fp8_f32(o[d0][r] * rli[r] * 32.0f, 0.f, 0, false) & 0xff); }
#undef SLOAD8
#undef SWRITE8
#undef SWAIT8
#undef RESC8
}

__device__ __host__ __forceinline__ int vt8_key(int g, int j) { const int i = j & 15; return (j < 16 ? 0 : 32) + (i & 3) + 8 * (i >> 2) + 4 * g; }
template <int DQ>
__device__ __forceinline__ void attn_body88(const bf16_t* __restrict__ Qb, int ldq, const unsigned char* __restrict__ Kn8, int ldkn, const unsigned char* __restrict__ Kr8, int ldkr,
                                            const unsigned char* __restrict__ VT8, unsigned char* __restrict__ Ob, int ldo, int seq, bool rope_q, int pos0, const float* __restrict__ tabM, char* lds, const int tid) {
    constexpr int NKS = DQ / 64, SHM_V = 128 * 64, SHM_K = KVBLK * DQ;
    constexpr float PSC = 128.0f, THR8 = 1.0f;
    const int wid = tid >> 6, lane = tid & 63, r32 = lane & 31, hi = lane >> 5;
    char* V_lds = lds; char* K_lds = lds + 2 * SHM_V;
    float* ws = (float*)(lds + 2 * SHM_V + 2 * SHM_K) + wid * 64; float* li_l = ws; float* al_l = ws + 32;
    float m_reg = -1e30f, l_reg = 0; f32x16 o[4] = {}; i32x8 qf[NKS];
    const bf16_t* Qrow = Qb + (long)(wid * QBLK + r32) * ldq;
#pragma unroll
    for (int ks = 0; ks < NKS; ++ks) {
        float x[32];
#pragma unroll
        for (int c = 0; c < 4; ++c) { const u32x4 w = *(const u32x4*)(Qrow + ks * 64 + hi * 32 + c * 8);
            x[c * 8 + 0] = bflo(w.x); x[c * 8 + 1] = bfhi(w.x); x[c * 8 + 2] = bflo(w.y); x[c * 8 + 3] = bfhi(w.y); x[c * 8 + 4] = bflo(w.z); x[c * 8 + 5] = bfhi(w.z); x[c * 8 + 6] = bflo(w.w); x[c * 8 + 7] = bfhi(w.w); }
        if (DQ == 192 && ks == 2 && rope_q) {
            float y[32];
#pragma unroll
            for (int c = 0; c < 4; ++c) { const u32x4 w = *(const u32x4*)(Qrow + 128 + (1 - hi) * 32 + c * 8);
                y[c * 8 + 0] = bflo(w.x); y[c * 8 + 1] = bfhi(w.x); y[c * 8 + 2] = bflo(w.y); y[c * 8 + 3] = bfhi(w.y); y[c * 8 + 4] = bflo(w.z); y[c * 8 + 5] = bfhi(w.z); y[c * 8 + 6] = bflo(w.w); y[c * 8 + 7] = bfhi(w.w); }
            const int pos = pos0 + wid * QBLK + r32, ri = pos >> 6, ci = pos & 63;
#pragma unroll
            for (int i = 0; i < 32; ++i) { const int p = i < 16 ? ri : ci, f = i & 15; const float c_ = tabM[p * 16 + f], s_ = tabM[128 * 16 + p * 16 + f];
                x[i] = hi ? x[i] * c_ + y[i] * s_ : x[i] * c_ - y[i] * s_; }
        }
        i32x8 q8;
#pragma unroll
        for (int j = 0; j < 8; ++j) q8[j] = pk4_fp8(x[4 * j], x[4 * j + 1], x[4 * j + 2], x[4 * j + 3]);
        qf[ks] = q8;
    }
    const int vr = tid >> 2, vc = tid & 3;
    const int vwr = vr * 64 + ((vc ^ ((vr >> 2) & 3)) << 4);
    const int kr = tid >> 3, kb = (tid & 7) * 16;
    const int kr2 = (tid & 255) >> 2, kb2 = (tid & 3) * 16;
    struct { u32x4 v, k0, k1; } sr_[1];
    const unsigned offK = (unsigned)(kr * ldkn + kb), offR = (unsigned)(kr2 * ldkr + kb2);
#define SLOAD8(k0_) do { sr_[0].v = *(const u32x4*)(VT8 + (size_t)((k0_) >> 6) * 8192 + tid * 16); \
    sr_[0].k0 = *(const u32x4*)(Kn8 + (size_t)(k0_) * ldkn + offK); \
    if constexpr (DQ == 192) { if (tid < 256) sr_[0].k1 = *(const u32x4*)(Kr8 + (size_t)(k0_) * ldkr + offR); } } while (0)
#define SWRITE8(b) do { *(u32x4*)(V_lds + (b) * SHM_V + vwr) = sr_[0].v; \
    *(u32x4*)(K_lds + (b) * SHM_K + k8addr(kr, kb, DQ)) = sr_[0].k0; \
    if constexpr (DQ == 192) { if (tid < 256) *(u32x4*)(K_lds + (b) * SHM_K + k8addr(kr2, 128 + kb2, DQ)) = sr_[0].k1; } } while (0)
#define SWAIT8() asm volatile("s_waitcnt vmcnt(0)" ::: "memory")
#define RESC8(a) do { if (__any((a) < 1.f)) { if (hi == 0) al_l[r32] = (a); asm volatile("s_waitcnt lgkmcnt(0)" ::: "memory"); \
    _Pragma("unroll") for (int d = 0; d < 4; ++d) _Pragma("unroll") for (int r = 0; r < 16; ++r) o[d][r] *= al_l[crow(r, hi)]; } } while (0)
#define FIN8(P0, P1, AL, PA) do { _Pragma("unroll") for (int r = 0; r < 16; ++r) P1[r] = __builtin_amdgcn_exp2f(P1[r]); \
    float ps_ = 0; _Pragma("unroll") for (int r = 0; r < 16; ++r) ps_ += P0[r]; _Pragma("unroll") for (int r = 0; r < 16; ++r) ps_ += P1[r]; \
    { auto rr_ = __builtin_amdgcn_permlane32_swap(__float_as_uint(ps_), __float_as_uint(ps_), false, false); ps_ = __uint_as_float(rr_[0]) + __uint_as_float(rr_[1]); } \
    l_reg = l_reg * (AL) + ps_; \
    _Pragma("unroll") for (int j = 0; j < 4; ++j) { PA[j] = pk4_fp8(P0[4 * j] * PSC, P0[4 * j + 1] * PSC, P0[4 * j + 2] * PSC, P0[4 * j + 3] * PSC); \
        PA[4 + j] = pk4_fp8(P1[4 * j] * PSC, P1[4 * j + 1] * PSC, P1[4 * j + 2] * PSC, P1[4 * j + 3] * PSC); } } while (0)
#define PV8(VB, PA) do { int mxs_ = 0x7f7f7f7f; asm volatile("" : "+v"(mxs_)); _Pragma("unroll") for (int d0 = 0; d0 < 4; ++d0) { const int row_ = d0 * 32 + r32, xs_ = (row_ >> 2) & 3; \
        const i32x4 lo_ = *reinterpret_cast<const i32x4*>((VB) + row_ * 64 + (((2 * hi) ^ xs_) << 4)), hi_ = *reinterpret_cast<const i32x4*>((VB) + row_ * 64 + (((2 * hi + 1) ^ xs_) << 4)); \
        const i32x8 vb_ = __builtin_shufflevector(lo_, hi_, 0, 1, 2, 3, 4, 5, 6, 7); MX32(o[d0], PA, vb_, mxs_); } asm volatile("s_nop 15\n\ts_nop 7"); } while (0)
    f32x16 pA0, pA1, pB0, pB1; float mnA, mnB, alA, alB; i32x8 pa; const int NT = seq / KVBLK;
    SLOAD8(0); SWAIT8(); SWRITE8(0); __syncthreads();
    qkt8<DQ>(pA0, pA1, K_lds, qf, r32, hi); partialSM<DQ, 0>(pA0, pA1, m_reg, mnA, alA, THR8);
    SLOAD8(KVBLK);
    SWAIT8(); SWRITE8(1); __syncthreads();
    for (int j = 1; j + 1 < NT; j += 2) {
        SBAR(); qkt8<DQ>(pB0, pB1, K_lds + SHM_K, qf, r32, hi);
        FIN8(pA0, pA1, alA, pa); SBAR();
        SLOAD8((j + 1) * KVBLK); SBAR();
        PV8(V_lds, pa); partialSM<DQ, 0>(pB0, pB1, m_reg, mnB, alB, THR8);
        __syncthreads(); SWAIT8(); SWRITE8(0);
        RESC8(alB); __syncthreads();
        SBAR(); qkt8<DQ>(pA0, pA1, K_lds, qf, r32, hi);
        FIN8(pB0, pB1, alB, pa); SBAR();
        SLOAD8((j + 2) * KVBLK); SBAR();
        PV8(V_lds + SHM_V, pa); partialSM<DQ, 0>(pA0, pA1, m_reg, mnA, alA, THR8);
        __syncthreads(); SWAIT8(); SWRITE8(1);
        RESC8(alA); __syncthreads();
    }
    SBAR(); qkt8<DQ>(pB0, pB1, K_lds + SHM_K, qf, r32, hi);
    FIN8(pA0, pA1, alA, pa); SBAR();
    PV8(V_lds, pa); partialSM<DQ, 0>(pB0, pB1, m_reg, mnB, alB, THR8);
    __syncthreads(); RESC8(alB);
    FIN8(pB0, pB1, alB, pa); SBAR();
    PV8(V_lds + SHM_V, pa);
    if (hi == 0) li_l[r32] = l_reg; asm volatile("s_waitcnt lgkmcnt(0)" ::: "memory");
    float rli[16];
#pragma unroll
    for (int r = 0; r < 16; ++r) rli[r] = __builtin_amdgcn_rcpf(li_l[crow(r, hi)]) * (32.0f / PSC);
    unsigned char* Ow = Ob + (long)(wid * QBLK) * ldo;
#pragma unroll
    for (int r = 0; r < 16; ++r) { const int orow = crow(r, hi);
#pragma unroll
        for (int d0 = 0; d0 < 4; ++d0) Ow[(long)orow * ldo + d0 * 32 + r32] = (unsigned char)(__builtin_amdgcn_cvt_pk_fp8_f32(o[d0][r] * rli[r], 0.f, 0, false) & 0xff); }
#undef SLOAD8
#undef SWRITE8
#undef SWAIT8
#undef RESC8
#undef FIN8
#undef PV8
}
#undef MX32
}

template <int KS> __device__ __forceinline__ void mma_xy(f32x16& acc, const LAS bf16_t* X, const LAS bf16_t* Y, int hi) {
#pragma unroll
    for (int ks = 0; ks < KS; ++ks) { const bf16x8 a = *(const LAS bf16x8*)(X + ks * 16 + hi * 8), b = *(const LAS bf16x8*)(Y + ks * 16 + hi * 8);
        acc = __builtin_amdgcn_mfma_f32_32x32x16_bf16(a, b, acc, 0, 0, 0); }
}
__device__ __forceinline__ float logsig16(float x) { const float e = __expf(-fabsf(x)); return (fminf(x, 0.f) - __logf(1.f + e)) * 0.0625f; }
__device__ __forceinline__ int gla_sidx(int b, int dir, int h) { return (b * 2 + dir) * 4 + h; }

__device__ __forceinline__ void gla_cumsum_lds(const Ctx& C, int l, int h, int dir, const LAS float* lr, LAS float* segtot, LAS float* CUM) {
    const int seg = C.tid >> 7, d = C.tid & 127;
    const float* wa = INP(dir ? I_WA2B : I_WA2F) + (size_t)l * 16 * 512 + h * 128 + d;
    const float bias = INP(dir ? I_BAB : I_BAF)[l * 512 + h * 128 + d];
    float w[16], cum[16];
#pragma unroll
    for (int j = 0; j < 16; ++j) w[j] = wa[j * 512];
    float run = 0.f;
#pragma unroll
    for (int i = 0; i < 16; ++i) { const int s = seg * 16 + i, tk = dir ? 63 - s : s; float pre = bias;
#pragma unroll
        for (int j = 0; j < 16; ++j) pre += lr[tk * 32 + dir * 16 + j] * w[j];
        run += logsig16(pre); cum[i] = run; }
    segtot[seg * 128 + d] = run;
    __syncthreads();
    float off = 0.f;
#pragma unroll
    for (int q = 0; q < 3; ++q) if (q < seg) off += segtot[q * 128 + d];
#pragma unroll
    for (int i = 0; i < 16; ++i) { const int s = seg * 16 + i, tk = dir ? 63 - s : s; CUM[tk * 132 + d] = cum[i] + off; }
    __syncthreads();
}
__device__ __forceinline__ void unpack8(const u32x4 w, float (&x)[8]) { x[0] = bflo(w.x); x[1] = bfhi(w.x); x[2] = bflo(w.y); x[3] = bfhi(w.y); x[4] = bflo(w.z); x[5] = bfhi(w.z); x[6] = bflo(w.w); x[7] = bfhi(w.w); }
__device__ __forceinline__ void gla_build_vt(const Ctx& C, const bf16_t* P, size_t r0, int h, LAS bf16_t* VT) {
    u32x4 v[4];
#pragma unroll
    for (int it = 0; it < 4; ++it) { const int idx = C.tid + it * NTHREADS, sv = idx >> 5, e0 = (idx & 31) * 8; v[it] = *(const u32x4*)(P + (r0 + sv) * NP + C_LV + h * 256 + e0); }
#pragma unroll
    for (int it = 0; it < 4; ++it) { const int idx = C.tid + it * NTHREADS, sv = idx >> 5, e0 = (idx & 31) * 8;
        const unsigned wd[4] = {v[it].x, v[it].y, v[it].z, v[it].w};
#pragma unroll
        for (int q = 0; q < 4; ++q) { VT[(e0 + 2 * q) * 72 + sv] = (bf16_t)(wd[q] & 0xffffu); VT[(e0 + 2 * q + 1) * 72 + sv] = (bf16_t)(wd[q] >> 16); } }
}

__device__ __forceinline__ void phase_gla_local(const Ctx& C, int l, int rot) {
    const bf16_t* P = WSP(bf16_t, WS_P); bf16_t* GST = WSP(bf16_t, WS_GST); float* GDEC = WSP(float, WS_GDEC);
    LAS float* lr = (LAS float*)C.lds;
    LAS float* segtot = (LAS float*)(C.lds + 8192);
    LAS bf16_t* KT = (LAS bf16_t*)(C.lds + 10240);
    LAS bf16_t* VT = (LAS bf16_t*)(C.lds + 28672);
    LAS float* CUM = (LAS float*)(C.lds + 65536);
    const int r32 = C.lane & 31, hi = C.lane >> 5, d = C.tid & 127;
    const int btk = C.tid >> 3, bdg = (C.tid & 7) * 16;
    for (int unit = (C.bid + C.G - rot % C.G) % C.G; unit < NBATCH * 4 * NCH; unit += C.G) {
        const int b = unit / (4 * NCH), h = (unit / NCH) % 4, ck = unit % NCH; const size_t r0 = (size_t)b * RPB + ck * 64;
        for (int i = C.tid; i < 64 * 32; i += NTHREADS) lr[i] = bf2f(P[(r0 + (i >> 5)) * NP + C_LRF + (i & 31)]);
        const u32x4 kw0 = *(const u32x4*)(P + (r0 + btk) * NP + C_LK + h * 128 + bdg), kw1 = *(const u32x4*)(P + (r0 + btk) * NP + C_LK + h * 128 + bdg + 8);
        gla_build_vt(C, P, r0, h, VT);
        __syncthreads();
#pragma unroll 1
        for (int dir = 0; dir < 2; ++dir) {
            gla_cumsum_lds(C, l, h, dir, lr, segtot, CUM);
            const int tend = dir ? 0 : 63;
            const size_t sx = (size_t)gla_sidx(b, dir, h) * NCH + ck;
            if (C.tid < 128) GDEC[sx * 128 + d] = __expf(CUM[tend * 132 + d]);
            { float kf[16]; { float t8[8]; unpack8(kw0, t8);
#pragma unroll
                for (int i = 0; i < 8; ++i) kf[i] = t8[i]; unpack8(kw1, t8);
#pragma unroll
                for (int i = 0; i < 8; ++i) kf[8 + i] = t8[i]; }
#pragma unroll
              for (int q = 0; q < 4; ++q) { const f32x4 cm = *(const LAS f32x4*)(CUM + btk * 132 + bdg + 4 * q), be = *(const LAS f32x4*)(CUM + tend * 132 + bdg + 4 * q);
#pragma unroll
                  for (int i = 0; i < 4; ++i) KT[(bdg + 4 * q + i) * 72 + btk] = f2bf(kf[4 * q + i] * __expf(be[i] - cm[i])); } }
            __syncthreads();
            { const int dt = C.wid & 3, eb = (C.wid >> 2) * 4;
              f32x16 acc[4] = {};
#pragma unroll
              for (int q = 0; q < 4; ++q) mma_xy<4>(acc[q], KT + (dt * 32 + r32) * 72, VT + ((eb + q) * 32 + r32) * 72, hi);
              bf16_t* st = GST + sx * 32768;
#pragma unroll
              for (int q = 0; q < 4; ++q)
#pragma unroll
                  for (int g = 0; g < 4; ++g) { u32x2 w; w.x = cvt_pk_bf16(acc[q][4 * g], acc[q][4 * g + 1]); w.y = cvt_pk_bf16(acc[q][4 * g + 2], acc[q][4 * g + 3]);
                      *(u32x2*)(st + (size_t)((eb + q) * 32 + r32) * 128 + dt * 32 + 8 * g + 4 * hi) = w; } }
            __syncthreads();
        }
    }
}

__device__ __forceinline__ void phase_gla_scan(const Ctx& C) {
    bf16_t* GST = WSP(bf16_t, WS_GST); const float* GDEC = WSP(float, WS_GDEC);
    for (int gid = C.bid * NTHREADS + C.tid; gid < 16 * 8192; gid += C.G * NTHREADS) {
        const int sidx = gid >> 13, g = gid & 8191, dir = (sidx >> 2) & 1, d4 = (g & 31) * 4;
        bf16_t* base = GST + (size_t)sidx * NCH * 32768 + (size_t)g * 4;
        const float* dbase = GDEC + (size_t)sidx * NCH * 128 + d4;
        float S[4] = {0.f, 0.f, 0.f, 0.f};
        for (int st = 0; st < NCH; st += 4) {
            int ck[4]; u32x2 L[4]; f32x4 dc[4];
#pragma unroll
            for (int q = 0; q < 4; ++q) { const int s = st + q; ck[q] = dir ? (s < 4 ? 3 - s : NCH + 3 - s) : s;
                L[q] = *(const u32x2*)(base + (size_t)ck[q] * 32768); dc[q] = *(const f32x4*)(dbase + (size_t)ck[q] * 128); }
#pragma unroll
            for (int q = 0; q < 4; ++q) { u32x2 w; w.x = cvt_pk_bf16(S[0], S[1]); w.y = cvt_pk_bf16(S[2], S[3]);
                *(u32x2*)(base + (size_t)ck[q] * 32768) = w;
                S[0] = dc[q][0] * S[0] + bflo(L[q].x); S[1] = dc[q][1] * S[1] + bfhi(L[q].x); S[2] = dc[q][2] * S[2] + bflo(L[q].y); S[3] = dc[q][3] * S[3] + bfhi(L[q].y); }
        }
    }
}

__device__ __forceinline__ void phase_gla_out(const Ctx& C, int l, int rot) {
    const bf16_t* P = WSP(bf16_t, WS_P); const bf16_t* GST = WSP(bf16_t, WS_GST); unsigned char* OL = C.ws + WS_OL;
    LAS float* lr = (LAS float*)C.lds;
    LAS float* segtot = (LAS float*)(C.lds + 8192);
    LAS bf16_t* QT = (LAS bf16_t*)(C.lds + 10240);
    LAS bf16_t* KT = (LAS bf16_t*)(C.lds + 27648);
    LAS bf16_t* VT = (LAS bf16_t*)(C.lds + 45056);
    LAS bf16_t* SCm = (LAS bf16_t*)(C.lds + 81920);
    LAS float* OB = (LAS float*)(C.lds + 91136);
    LAS float* CUM = OB;
    const float* gon = INP(I_ONG) + l * 256;
    const int r32 = C.lane & 31, hi = C.lane >> 5;
    const int btk = C.tid >> 3, bdg = (C.tid & 7) * 16;
    for (int unit = (C.bid + C.G - rot % C.G) % C.G; unit < NBATCH * 4 * NCH; unit += C.G) {
        const int b = unit / (4 * NCH), h = (unit / NCH) % 4, ck = unit % NCH; const size_t r0 = (size_t)b * RPB + ck * 64;
        for (int i = C.tid; i < 64 * 32; i += NTHREADS) lr[i] = bf2f(P[(r0 + (i >> 5)) * NP + C_LRF + (i & 31)]);
        const bf16_t* qp = P + (r0 + btk) * NP + C_LQ + h * 128 + bdg; const bf16_t* kp = P + (r0 + btk) * NP + C_LK + h * 128 + bdg;
        const u32x4 qw0 = *(const u32x4*)qp, qw1 = *(const u32x4*)(qp + 8), kw0 = *(const u32x4*)kp, kw1 = *(const u32x4*)(kp + 8);
        gla_build_vt(C, P, r0, h, VT);
        __syncthreads();
        f32x16 oacc[2] = {};
#pragma unroll 1
        for (int dir = 0; dir < 2; ++dir) {
            gla_cumsum_lds(C, l, h, dir, lr, segtot, CUM);
            { float qf[8], kf[8];
#pragma unroll
              for (int hh = 0; hh < 2; ++hh) { unpack8(hh ? qw1 : qw0, qf); unpack8(hh ? kw1 : kw0, kf);
                  const f32x4 c0 = *(const LAS f32x4*)(CUM + btk * 132 + bdg + 8 * hh), c1 = *(const LAS f32x4*)(CUM + btk * 132 + bdg + 8 * hh + 4);
                  float qo[8], ko[8];
#pragma unroll
                  for (int i = 0; i < 8; ++i) { const float cm = i < 4 ? c0[i & 3] : c1[i & 3]; qo[i] = qf[i] * __expf(cm) * 0.088388347648318440f; ko[i] = kf[i] * __expf(-cm); }
                  u32x4 wq, wk; wq.x = cvt_pk_bf16(qo[0], qo[1]); wq.y = cvt_pk_bf16(qo[2], qo[3]); wq.z = cvt_pk_bf16(qo[4], qo[5]); wq.w = cvt_pk_bf16(qo[6], qo[7]);
                  wk.x = cvt_pk_bf16(ko[0], ko[1]); wk.y = cvt_pk_bf16(ko[2], ko[3]); wk.z = cvt_pk_bf16(ko[4], ko[5]); wk.w = cvt_pk_bf16(ko[6], ko[7]);
                  *(LAS u32x4*)(QT + btk * 136 + bdg + 8 * hh) = wq; *(LAS u32x4*)(KT + btk * 136 + bdg + 8 * hh) = wk; } }
            __syncthreads();
            if (C.wid < 4) { const int mt = C.wid >> 1, nt = C.wid & 1; f32x16 sc = {};
                mma_xy<8>(sc, QT + (mt * 32 + r32) * 136, KT + (nt * 32 + r32) * 136, hi);
#pragma unroll
                for (int i = 0; i < 16; ++i) { const int t = mt * 32 + att::crow(i, hi), sx_ = nt * 32 + r32; const bool keep = dir ? (sx_ >= t) : (sx_ <= t);
                    SCm[t * 72 + sx_] = f2bf(keep ? sc[i] : 0.f); } }
            __syncthreads();
            { const bf16_t* st = GST + ((size_t)gla_sidx(b, dir, h) * NCH + ck) * 32768 + (size_t)(C.wid * 32 + r32) * 128 + hi * 8;
              bf16x8 sb[8];
#pragma unroll
              for (int ks = 0; ks < 8; ++ks) sb[ks] = *(const bf16x8*)(st + ks * 16);
#pragma unroll
              for (int mt = 0; mt < 2; ++mt) {
                  mma_xy<4>(oacc[mt], SCm + (mt * 32 + r32) * 72, VT + (C.wid * 32 + r32) * 72, hi);
#pragma unroll
                  for (int ks = 0; ks < 8; ++ks) { const bf16x8 a = *(const LAS bf16x8*)(QT + (mt * 32 + r32) * 136 + ks * 16 + hi * 8);
                      oacc[mt] = __builtin_amdgcn_mfma_f32_32x32x16_bf16(a, sb[ks], oacc[mt], 0, 0, 0); } } }
            __syncthreads();
        }
#pragma unroll
        for (int mt = 0; mt < 2; ++mt)
#pragma unroll
            for (int i = 0; i < 16; ++i) OB[(mt * 32 + att::crow(i, hi)) * 260 + C.wid * 32 + r32] = oacc[mt][i];
        __syncthreads();
        { const int t = C.tid >> 3, part = C.tid & 7; f32x4 v[8]; float ss = 0.f;
#pragma unroll
          for (int jj = 0; jj < 8; ++jj) { v[jj] = *(const LAS f32x4*)(OB + t * 260 + jj * 32 + part * 4); ss += v[jj][0] * v[jj][0] + v[jj][1] * v[jj][1] + v[jj][2] * v[jj][2] + v[jj][3] * v[jj][3]; }
          ss += dppmov<DPP_HMIRROR>(ss); ss += dppmov<DPP_Q3210>(ss); ss += dppmov<DPP_Q1032>(ss);
          const float rs = rsqrtf(ss * (1.0f / 256.0f) + NORM_EPS);
#pragma unroll
          for (int jj = 0; jj < 8; ++jj) { const int e = jj * 32 + part * 4; const f32x4 g = *(const f32x4*)(gon + e);
              const u32x2 gt = *(const u32x2*)(P + (r0 + t) * NP + C_LG + h * 256 + e);
              const float o0 = v[jj][0] * rs * g[0] * siluf_(bflo(gt.x)), o1 = v[jj][1] * rs * g[1] * siluf_(bfhi(gt.x)), o2 = v[jj][2] * rs * g[2] * siluf_(bflo(gt.y)), o3 = v[jj][3] * rs * g[3] * siluf_(bfhi(gt.y));
              int p8 = __builtin_amdgcn_cvt_pk_fp8_f32(o0, o1, 0, false); p8 = __builtin_amdgcn_cvt_pk_fp8_f32(o2, o3, p8, true);
              *(unsigned*)(OL + (r0 + t) * 1024 + h * 256 + e) = (unsigned)p8; } }
        __syncthreads();
    }
}

__device__ __forceinline__ unsigned f_ord(float f) { const unsigned u = __float_as_uint(f); return u ^ ((unsigned)((int)u >> 31) | 0x80000000u); }
__device__ __forceinline__ float f_unord(unsigned k) { return __uint_as_float((k & 0x80000000u) ? (k ^ 0x80000000u) : ~k); }
__device__ __forceinline__ void ins_u(unsigned (&L)[16], unsigned x) {
#pragma unroll
    for (int j = 0; j < 16; ++j) { const unsigned h = L[j] > x ? L[j] : x; x = L[j] > x ? x : L[j]; L[j] = h; }
}
__device__ __forceinline__ void ins_f(float (&M)[16], float x) {
#pragma unroll
    for (int j = 0; j < 16; ++j) { const float h = M[j] > x ? M[j] : x; x = M[j] > x ? x : M[j]; M[j] = h; }
}
__device__ __forceinline__ void peer_top16(const bf16_t* __restrict__ qrow, const bf16_t* __restrict__ keys, int r32, int hi, unsigned (&L)[16]) {
    bf16x8 qf[8];
#pragma unroll
    for (int kk = 0; kk < 8; ++kk) qf[kk] = *(const bf16x8*)(qrow + kk * 16 + hi * 8);
#pragma unroll
    for (int j = 0; j < 16; ++j) L[j] = 0u;
    bf16x8 kA[8], kB[8];
    const bf16_t* kl = keys + (size_t)r32 * 128 + hi * 8;
#define PT_LDK(dst, mt) do { _Pragma("unroll") for (int kk = 0; kk < 8; ++kk) dst[kk] = *(const bf16x8*)(kl + (mt) * 32 * 128 + kk * 16); } while (0)
#define PT_PROC(src, mt) do { f32x16 acc = {}; \
        _Pragma("unroll") for (int kk = 0; kk < 8; ++kk) acc = __builtin_amdgcn_mfma_f32_32x32x16_bf16(src[kk], qf[kk], acc, 0, 0, 0); \
        _Pragma("unroll") for (int i = 0; i < 16; ++i) { const unsigned kidx = (unsigned)((mt) * 32 + att::crow(i, hi)); ins_u(L, (f_ord(acc[i]) & ~127u) | (127u - kidx)); } } while (0)
    PT_LDK(kA, 0);
#pragma unroll 1
    for (int mp = 0; mp < 2; ++mp) { PT_LDK(kB, 2 * mp + 1); PT_PROC(kA, 2 * mp); if (mp == 0) PT_LDK(kA, 2); PT_PROC(kB, 2 * mp + 1); }
#undef PT_LDK
#undef PT_PROC
    unsigned Pn[16];
#pragma unroll
    for (int j = 0; j < 16; ++j) { auto r_ = __builtin_amdgcn_permlane32_swap(L[j], L[j], false, false); Pn[j] = hi ? r_[0] : r_[1]; }
#pragma unroll
    for (int j = 0; j < 16; ++j) ins_u(L, Pn[j]);
}
__device__ __forceinline__ void phase_peer_select(const Ctx& C, const bool latent_only) {
    const bf16_t* PQ = WSP(bf16_t, WS_PQ); const bf16_t* K1 = WSP(bf16_t, WS_K1); const bf16_t* K2 = WSP(bf16_t, WS_K2);
    int* PIDX = WSP(int, WS_PIDX); float* PG = WSP(float, WS_PG);
    const int r32 = C.lane & 31, hi = C.lane >> 5, head = C.wid;
    const int ngrp = latent_only ? NBATCH * SEQ / 32 : TT / 32;
    for (int gi = C.bid; gi < ngrp; gi += C.G) {
        const int grp = latent_only ? gi + (CTXL / 32) * (1 + gi / (SEQ / 32)) : gi;
        const size_t tok = (size_t)grp * 32 + r32;
        unsigned L1[16], L2[16];
        peer_top16(PQ + tok * DM + head * 256, K1 + (size_t)head * 128 * 128, r32, hi, L1);
        peer_top16(PQ + tok * DM + head * 256 + 128, K2 + (size_t)head * 128 * 128, r32, hi, L2);
        float v1[16], v2[16];
#pragma unroll
        for (int j = 0; j < 16; ++j) { v1[j] = f_unord(L1[j] & ~127u); v2[j] = f_unord(L2[j] & ~127u); }
        float M[16];
#pragma unroll
        for (int j = 0; j < 16; ++j) M[j] = -3.0e38f;
#pragma unroll
        for (int a = 0; a < 16; ++a)
#pragma unroll
            for (int b = 0; b < 16; ++b) if ((a + 1) * (b + 1) <= 16) ins_f(M, v1[a] + v2[b]);
        const float thr = M[15], mx = M[0]; float den = 0.f;
#pragma unroll
        for (int j = 0; j < 16; ++j) den += __expf(M[j] - mx);
        const float rden = 1.0f / den;
        int pos = 0; int* ip = PIDX + tok * 128 + head * 16; float* gp = PG + tok * 128 + head * 16;
#pragma unroll
        for (int a = 0; a < 16; ++a)
#pragma unroll
            for (int b = 0; b < 16; ++b) if ((a + 1) * (b + 1) <= 16) {
                const float val = v1[a] + v2[b];
                if (val >= thr && pos < 16) { if (hi == 0) { ip[pos] = (int)((127u - (L1[a] & 127u)) * 128u + (127u - (L2[b] & 127u))); gp[pos] = __expf(val - mx) * rden; } ++pos; } }
    }
}
template <int OFF> __device__ __forceinline__ float dotf8(const float (&h)[32], const u32x4 w, float acc) {
#pragma unroll
    for (int j = 0; j < 4; ++j) { const f32x2 lo = __builtin_amdgcn_cvt_pk_f32_fp8((int)w[j], false), hi = __builtin_amdgcn_cvt_pk_f32_fp8((int)w[j], true);
        acc += h[OFF + 4 * j] * lo.x; acc += h[OFF + 4 * j + 1] * lo.y; acc += h[OFF + 4 * j + 2] * hi.x; acc += h[OFF + 4 * j + 3] * hi.y; }
    return acc;
}
constexpr float ATT_O8_SCALE = 32.0f;
constexpr int GT_MAXTOK = 9;
template <bool LAST> __device__ __forceinline__ void phase_peer_gather(const Ctx& C, const float* modl, const float pscale) {
    const unsigned char* pt = C.ws + WS_PT + (size_t)(LAST ? DEPTH - 1 : 0) * PT_BYTES;
    const bf16_t* HB = WSP(bf16_t, WS_HB); const unsigned char* U8 = pt + PT_U8; const unsigned char* V8 = pt + PT_V8;
    const float* SCU = (const float*)(pt + PT_SCU); const float* SCV = (const float*)(pt + PT_SCV);
    const int* PIDX = WSP(int, WS_PIDX); const float* PG = WSP(float, WS_PG); float* XS = WSP(float, WS_XS);
    const int lane = C.lane, s = lane >> 3, j = lane & 7; const unsigned j16 = (unsigned)j * 16u;
    LAS int* IDS = (LAS int*)(C.lds + C.wid * (GT_MAXTOK * 512));
    LAS float* ACT = (LAS float*)(C.lds + 8 * GT_MAXTOK * 512 + C.wid * (GT_MAXTOK * 512));
    LAS int* ROWS = (LAS int*)(C.lds + 16 * GT_MAXTOK * 512 + C.wid * 64);
    int nk = 0;
    {
      const int per = (TT + C.G - 1) / C.G, base = C.bid * per;
#pragma unroll 1
      for (int k = 0; k < GT_MAXTOK; ++k) { const int o = C.wid + 8 * k; const int r = base + o; if (o < per && r < TT && !(LAST && (r % RPB) < CTXL)) { if (lane == 0) ROWS[nk] = r; ++nk; } } }
#define GT_ROW(k) __builtin_amdgcn_readfirstlane(ROWS[k])
#pragma unroll 1
    for (int k = 0; k < nk; ++k) { const int r = GT_ROW(k);
        IDS[k * 128 + lane] = (PIDX[(size_t)r * 128 + lane] & (NEXP - 1)) << 7; IDS[k * 128 + 64 + lane] = (PIDX[(size_t)r * 128 + 64 + lane] & (NEXP - 1)) << 7;
        ACT[k * 128 + lane] = 0.f; ACT[k * 128 + 64 + lane] = 0.f; }
    const int nit = 32 * nk;
#define GT_ITEM(it_) const int cb_ = (it_) / (2 * nk), rem_ = (it_) - cb_ * (2 * nk), k_ = rem_ >> 1, hf_ = rem_ & 1
#define GT_LOADU(UQ, HQ, it_) do { GT_ITEM(it_); const int r_ = GT_ROW(k_); \
        const bf16_t* hp_ = HB + (size_t)r_ * DM + cb_ * 128 + j * 16; HQ[0] = *(const u32x4*)hp_; HQ[1] = *(const u32x4*)(hp_ + 8); \
        const unsigned char* ub_ = U8 + (size_t)cb_ * ((size_t)NEXP * 128);     \
        _Pragma("unroll") for (int eg = 0; eg < 8; ++eg) { const unsigned off_ = ((unsigned)IDS[k_ * 128 + (hf_ * 8 + eg) * 8 + s] & idmask) + j16; UQ[eg] = *(const u32x4*)(ub_ + off_); } } while (0)
#define GT_COMPU(UQ, HQ, it_) do { GT_ITEM(it_); (void)cb_; f32x2 hf2[8]; \
        _Pragma("unroll") for (int hh = 0; hh < 2; ++hh) { const u32x4 w_ = HQ[hh]; \
            hf2[hh * 4 + 0] = (f32x2){bflo(w_.x), bfhi(w_.x)}; hf2[hh * 4 + 1] = (f32x2){bflo(w_.y), bfhi(w_.y)}; hf2[hh * 4 + 2] = (f32x2){bflo(w_.z), bfhi(w_.z)}; hf2[hh * 4 + 3] = (f32x2){bflo(w_.w), bfhi(w_.w)}; } \
        float d[8]; \
        _Pragma("unroll") for (int eg = 0; eg < 8; ++eg) { f32x2 d2 = (f32x2){0.f, 0.f}; \
            _Pragma("unroll") for (int q = 0; q < 4; ++q) { const f32x2 lo = __builtin_amdgcn_cvt_pk_f32_fp8((int)UQ[eg][q], false), hi = __builtin_amdgcn_cvt_pk_f32_fp8((int)UQ[eg][q], true); \
                d2 += hf2[2 * q] * lo; d2 += hf2[2 * q + 1] * hi; } \
            d[eg] = d2.x + d2.y; } \
          \
        float t4[4], t2[2], t1; \
        _Pragma("unroll") for (int i = 0; i < 4; ++i) { const float snd = (j & 4) ? d[i] : d[i + 4], kp = (j & 4) ? d[i + 4] : d[i]; t4[i] = kp + dppmov<DPP_HMIRROR>(snd); } \
        _Pragma("unroll") for (int i = 0; i < 2; ++i) { const float snd = (j & 2) ? t4[i] : t4[i + 2], kp = (j & 2) ? t4[i + 2] : t4[i]; t2[i] = kp + dppmov<DPP_Q3210>(snd); } \
        { const float snd = (j & 1) ? t2[0] : t2[1], kp = (j & 1) ? t2[1] : t2[0]; t1 = kp + dppmov<DPP_Q1032>(snd); } \
        ACT[k_ * 128 + (hf_ * 8 + j) * 8 + s] += t1; } while (0)
#ifdef DBG_GDUP
#pragma unroll 1
    for (int rep_ = 0; rep_ < 2; ++rep_) {
    const unsigned idmask = rep_ == 0 ? ((unsigned)DBG_GMASK << 7 | 127u) : 0xffffffffu;
    if (rep_ == 1) { for (int k = 0; k < nk; ++k) { ACT[k * 128 + lane] = 0.f; ACT[k * 128 + 64 + lane] = 0.f; } }
#else
    { const unsigned idmask = 0xffffffffu;
#endif
    if (nit > 0) {
        u32x4 uA[8], uB[8], hA[2], hB[2];
        GT_LOADU(uA, hA, 0);
#pragma unroll 1
        for (int it = 0; it < nit; it += 2) {
            GT_LOADU(uB, hB, it + 1);
            GT_COMPU(uA, hA, it);
            if (it + 2 < nit) GT_LOADU(uA, hA, it + 2);
            GT_COMPU(uB, hB, it + 1);
        }
    }
    }
#undef GT_LOADU
#undef GT_COMPU
#pragma unroll 1
    for (int k = 0; k < nk; ++k) { const int r = GT_ROW(k);
#pragma unroll
        for (int hh = 0; hh < 2; ++hh) { const int e = hh * 64 + lane; const int id = IDS[k * 128 + e] >> 7; const float a = ACT[k * 128 + e] * SCU[id];
            const float w = PG[(size_t)r * 128 + e] * 0.5f * a * (1.0f + erff(a * 0.70710678118654752f));
#if defined(DBG_CHECK) && (DBG_CHECK == 3 || DBG_CHECK == 4)
            if (((r - 300) & 63) == 0 && r >= 300 && r < 300 + 64 * 128) WSP(float, WS_OM)[(size_t)r * 128 + e] = w;
#endif
            ACT[k * 128 + e] = w * SCV[id]; } }
#define GT_LOADV(VQ, WV, it_) do { GT_ITEM(it_); const unsigned char* vb_ = V8 + (size_t)cb_ * ((size_t)NEXP * 128); \
        _Pragma("unroll") for (int eg = 0; eg < 8; ++eg) { const int e_ = k_ * 128 + (hf_ * 8 + eg) * 8 + s; const unsigned off_ = (unsigned)IDS[e_] + j16; VQ[eg] = *(const u32x4*)(vb_ + off_); WV[eg] = ACT[e_]; } } while (0)
#define GT_COMPV(VQ, WV) do { \
        _Pragma("unroll") for (int eg = 0; eg < 8; ++eg) { const f32x2 w2_ = (f32x2){WV[eg], WV[eg]}; \
            _Pragma("unroll") for (int q = 0; q < 4; ++q) { \
                const f32x2 lo = __builtin_amdgcn_cvt_pk_f32_fp8((int)VQ[eg][q], false), hi = __builtin_amdgcn_cvt_pk_f32_fp8((int)VQ[eg][q], true); \
                acc2[2 * q] += w2_ * lo; acc2[2 * q + 1] += w2_ * hi; } } } while (0)
    if (nit > 0) {
        u32x4 vA[8], vB[8]; float wA[8], wB[8];
        GT_LOADV(vA, wA, 0);
#pragma unroll 1
        for (int it = 0; it < nit; it += 2) {
            f32x2 acc2[8];
#pragma unroll
            for (int i = 0; i < 8; ++i) acc2[i] = (f32x2){0.f, 0.f};
            GT_LOADV(vB, wB, it + 1);
            GT_COMPV(vA, wA);
            if (it + 2 < nit) GT_LOADV(vA, wA, it + 2);
            GT_COMPV(vB, wB);
            f32x2 t4[4], t2[2], t1;
#pragma unroll
            for (int i = 0; i < 4; ++i) { const f32x2 snd = (s & 4) ? acc2[i] : acc2[i + 4], kp = (s & 4) ? acc2[i + 4] : acc2[i];
                t4[i] = kp + (f32x2){xchg32(snd.x, lane), xchg32(snd.y, lane)}; }
#pragma unroll
            for (int i = 0; i < 2; ++i) { const f32x2 snd = (s & 2) ? t4[i] : t4[i + 2], kp = (s & 2) ? t4[i + 2] : t4[i];
                t2[i] = kp + (f32x2){xchg16(snd.x, lane), xchg16(snd.y, lane)}; }
            { const f32x2 snd = (s & 1) ? t2[0] : t2[1], kp = (s & 1) ? t2[1] : t2[0]; t1 = kp + (f32x2){dppmov<DPP_ROR8>(snd.x), dppmov<DPP_ROR8>(snd.y)}; }
            { GT_ITEM(it); (void)hf_; const int r_ = GT_ROW(k_);
              const int col = cb_ * 128 + j * 16 + 2 * s; float* xp = XS + (size_t)r_ * DM + col; const float* g2 = modl + (size_t)mod_sel(r_) * 12288 + 5 * DM + col;
#if defined(DBG_CHECK) && (DBG_CHECK == 3 || DBG_CHECK == 4)
              if (((r_ - 300) & 63) == 0 && r_ >= 300 && r_ < 300 + 64 * 128) { float* dbgo = WSP(float, WS_MQ) + (size_t)r_ * DM + col; dbgo[0] = t1.x; dbgo[1] = t1.y; }
#endif
              const f32x2 x = *(const f32x2*)xp, g = *(const f32x2*)g2;
              *(f32x2*)xp = x + pscale * g * t1; }
        }
    }
#undef GT_LOADV
#undef GT_COMPV
#undef GT_ITEM
#undef GT_ROW
}
__device__ __forceinline__ void phase_final_norm(const Ctx& C) {
    const float* XS = WSP(float, WS_XS); const float* fg = INP(I_FG);
    for (int q = C.bid * 8 + C.wid; q < NBATCH * SEQ; q += C.G * 8) {
        const int b = q / SEQ, t = q % SEQ; const float* xr = XS + ((size_t)b * RPB + CTXL + t) * DM; float* op = C.out + (size_t)q * DM;
        f32x4 v[8]; float ss = 0.f;
#pragma unroll
        for (int c = 0; c < 8; ++c) { v[c] = *(const f32x4*)(xr + c * 256 + C.lane * 4); ss += v[c][0] * v[c][0] + v[c][1] * v[c][1] + v[c][2] * v[c][2] + v[c][3] * v[c][3]; }
        ss = wave_sum(ss); const float rs = rsqrtf(ss * (1.0f / DM) + NORM_EPS);
#pragma unroll
        for (int c = 0; c < 8; ++c) { const f32x4 g = *(const f32x4*)(fg + c * 256 + C.lane * 4); *(f32x4*)(op + c * 256 + C.lane * 4) = v[c] * rs * g; }
    }
}


__device__ __forceinline__ void phase_vt8(const Ctx& C) {
    const bf16_t* P = WSP(bf16_t, WS_P); const bf16_t* MKV = WSP(bf16_t, WS_MKV);
    const int dv = C.tid & 127, kq = C.tid >> 7, g = kq >> 1, j0 = (kq & 1) * 16;
    constexpr int NU_A = NBATCH * 2 * NCH, NU_M = NBATCH * 8 * NCH;
    for (int u = C.bid; u < NU_A + NU_M; u += C.G) {
        const bool gqa = u < NU_A; const int v = gqa ? u : u - NU_A; const int nh = gqa ? 2 : 8;
        const int b = v / (nh * NCH), h = (v / NCH) % nh, t = v % NCH; const size_t r0 = (size_t)b * RPB + t * 64;
        const bf16_t* src = gqa ? P + r0 * NP + C_AV + h * 128 + dv : MKV + r0 * 2048 + h * 256 + 128 + dv; const size_t ld = gqa ? NP : 2048;
        float x[16];
#pragma unroll
        for (int jj = 0; jj < 16; ++jj) x[jj] = bf2f(src[(size_t)att::vt8_key(g, j0 + jj) * ld]);
        u32x4 w; w.x = (unsigned)att::pk4_fp8(x[0], x[1], x[2], x[3]); w.y = (unsigned)att::pk4_fp8(x[4], x[5], x[6], x[7]); w.z = (unsigned)att::pk4_fp8(x[8], x[9], x[10], x[11]); w.w = (unsigned)att::pk4_fp8(x[12], x[13], x[14], x[15]);
        unsigned char* dst = C.ws + (gqa ? WS_VT8A : WS_VT8M) + ((size_t)(b * nh + h) * NCH + t) * 8192 + dv * 64 + kq * 16;
        *(u32x4*)dst = w;
    }
}
template <int TYPE  , int VAR = 0> __device__ __forceinline__ void attn_units(const Ctx& C, bool need_ctx) {
    const bf16_t* P = WSP(bf16_t, WS_P);
    const int nu = need_ctx ? 528 : 512;
#pragma unroll 1
    for (int u = C.bid; u < nu; u += C.G) {
        int bh, qb; if (u < 512) { bh = (u >> 8) * 8 + (u & 7); qb = ((u & 255) >> 3) + 1; } else { bh = u - 512; qb = 0; }
        const int b = bh >> 3, h = bh & 7; const size_t rq = (size_t)b * RPB + (size_t)qb * 256, rk = (size_t)b * RPB; const int seq = qb == 0 ? CTXL : RPB;
        __syncthreads();
        if constexpr (TYPE == 1) {
            att::attn_body88<128>(P + rq * NP + C_AQ + h * 128, NP, C.ws + WS_AK8 + rk * 256 + (h >> 2) * 128, 256, nullptr, 0, C.ws + WS_VT8A + (size_t)(b * 2 + (h >> 2)) * NCH * 8192,
                                  C.ws + WS_OA + rq * 1024 + h * 128, 1024, seq, false, 0, nullptr, (char*)C.lds, C.tid);
        } else {
            const bf16_t* MQ = WSP(bf16_t, WS_MQ);
            att::attn_body88<192>(MQ + rq * 1536 + h * 192, 1536, C.ws + WS_KN8 + rk * 1024 + h * 128, 1024, C.ws + WS_KR8 + rk * 64, 64, C.ws + WS_VT8M + (size_t)(b * 8 + h) * NCH * 8192,
                                  C.ws + WS_OM + rq * 1024 + h * 128, 1024, seq, qb > 0, (qb - 1) * 256, WSP(float, WS_TABM), (char*)C.lds, C.tid);
        }
    }
    __syncthreads();
}

constexpr int LDS_BYTES = 163840, LDS_BAR_OFF = LDS_BYTES - 16;
constexpr int N_PHASES = 26;
template <int K> __device__ __forceinline__ void run_phase(const Ctx& C0, int l) {
    const Ctx C = launder(C0);
    const float* modl = WSP(float, WS_MODV) + (size_t)l * 3 * 12288;
    if constexpr (K == 0) { phase_modv(C); phase_tables(C); __syncthreads(); phase_cvt_mixer_weights(C, 0); }
    if constexpr (K == 1) {
        if (l == 0) phase_norm_mod<true, true>(C, INP(I_N1G), modl, 0, DM);
        else { phase_norm_mod<false, true>(C, INP(I_N1G) + l * DM, modl, 0, DM); __syncthreads(); phase_cvt_mixer_weights(C, l); }
    }
    if constexpr (K == 2) {
        pg8::Gemm g{WSP(bf16_t, WS_HB), WSP(bf16_t, WS_WIN), TT, NP, DM, DM, DM}; pg8::WinOrder S; S.init(C.G, C.bid, l + 1 < DEPTH);
        pg8::EpiStoreBf16S E{WSP(bf16_t, WS_P), NP, WSP(float, WS_WINS)};
        pg8::gemm_phase<pg8::EpiStoreBf16S, pg8::WinOrder, 1>(C.lds, C.tid, g, S, E);
    }
    if constexpr (K == 3) phase_post_p(C, l);
    if constexpr (K == 4) {
        { pg8::Gemm g{WSP(bf16_t, WS_P) + C_MCQ, WSP(bf16_t, WS_WUQ), TT, 1536, 512, NP, 512}; pg8::StaticOrder S; S.init(TT, 1536, C.G, C.bid);
          pg8::EpiStoreBf16 E{WSP(bf16_t, WS_MQ), 1536}; pg8::gemm_phase(C.lds, C.tid, g, S, E); }
        { pg8::Gemm g{WSP(bf16_t, WS_P) + C_MCKV, WSP(bf16_t, WS_WUKV), TT, 2048, 512, NP, 512}; pg8::StaticOrder S; S.init(TT, 2048, C.G, (C.bid + C.G - 140 % C.G) % C.G);
          pg8::EpiStoreMKV E{WSP(bf16_t, WS_MKV), C.ws + WS_KN8}; pg8::gemm_phase(C.lds, C.tid, g, S, E); }
        { const Ctx C2 = launder(C0); phase_gla_local(C2, l, 156); }
#ifdef DBG_DUP_GLALOCAL
        { const Ctx C2 = launder(C0); __syncthreads(); phase_gla_local(C2, l, 156); }
#endif
    }
    if constexpr (K == 5) { phase_gla_scan(C); { const Ctx C2 = launder(C0); phase_vt8(C2); } }
    if constexpr (K == 6) {
#ifdef DBG_ATTVAR
        { const Ctx Cx = launder(C0); attn_units<0, DBG_ATTVAR>(Cx, l + 1 < DEPTH); } { const Ctx Cx = launder(C0); attn_units<1, DBG_ATTVAR>(Cx, l + 1 < DEPTH); } __syncthreads();
#endif
        attn_units<0>(C, l + 1 < DEPTH); { const Ctx C2 = launder(C0); attn_units<1>(C2, l + 1 < DEPTH); } { const Ctx C3 = launder(C0); phase_gla_out(C3, l, 128); }
#ifdef DBG_DUP_GLAOUT
        { const Ctx C3 = launder(C0); __syncthreads(); phase_gla_out(C3, l, 128); }
#endif
    }
    if constexpr (K == 7) {
        const bf16_t* P = WSP(bf16_t, WS_P); bf16_t* Y = WSP(bf16_t, WS_Y);
        const pg8::Gemm ga{WSP(bf16_t, WS_OA), WSP(bf16_t, WS_WBR), TT, DM, 1024, 1024, 1024}, gl{WSP(bf16_t, WS_OL), (const bf16_t*)(C.ws + WS_WBR + (size_t)2048 * 1024), TT, DM, 1024, 1024, 1024},
                        gm{WSP(bf16_t, WS_OM), (const bf16_t*)(C.ws + WS_WBR + (size_t)2 * 2048 * 1024), TT, DM, 1024, 1024, 1024};
        unsigned char* Y8 = C.ws + WS_HB;
        const float* wbs = WSP(float, WS_WBRS);
        const pg8::EpiGate<true> Ea{Y, P + C_GA, nullptr, wbs}; const pg8::EpiGate<false> El{Y, P + C_GL, nullptr, wbs + DM}; const pg8::EpiGate<false, true> Em{Y, P + C_GM, Y8, wbs + 2 * DM};
        pg8::StaticOrder S; S.init(TT, DM, C.G, C.bid, l + 1 >= DEPTH);
        pg8::gemm_phase<pg8::EpiGate<true>, pg8::StaticOrder, 1>(C.lds, C.tid, ga, S, Ea); pg8::gemm_phase<pg8::EpiGate<false>, pg8::StaticOrder, 1>(C.lds, C.tid, gl, S, El);
        pg8::gemm_phase<pg8::EpiGate<false, true>, pg8::StaticOrder, 1>(C.lds, C.tid, gm, S, Em);
        if (l == 0) { const Ctx C2 = launder(C0); phase_cvt_peer_tables(C2, 0, 0, NEXP, S.nwg % C.G); }
    }
    if constexpr (K == 8) {
        pg8::Gemm g{WSP(bf16_t, WS_HB), WSP(bf16_t, WS_WOUT), TT, DM, DM, DM, DM};
        const pg8::EpiResidT<true> E{WSP(float, WS_XS), DM, modl + 2 * DM, WSP(float, WS_WOUTS)};
        pg8::StaticOrder S; S.init(TT, DM, C.G, C.bid, l + 1 >= DEPTH);
        pg8::gemm_phase<pg8::EpiResidT<true>, pg8::StaticOrder, 1>(C.lds, C.tid, g, S, E);
        if (l == 0 && DEPTH > 1) { const Ctx C2 = launder(C0); phase_cvt_peer_tables(C2, 1, 0, NEXP / 2, S.nwg % C.G); }
    }
    if constexpr (K == 9) phase_norm_mod<false>(C, INP(I_N2G) + l * DM, modl, 3 * DM, 4 * DM);
    if constexpr (K == 10) {
        pg8::Gemm g{WSP(bf16_t, WS_HB), WSP(bf16_t, WS_WQ), TT, DM, DM, DM, DM};
        pg8::EpiStoreBf16 E{WSP(bf16_t, WS_PQ), DM};
        pg8::StaticOrder S; S.init(TT, DM, C.G, C.bid, l + 1 >= DEPTH); pg8::gemm_phase(C.lds, C.tid, g, S, E);
        if (l == 0 && DEPTH > 1) { const Ctx C2 = launder(C0); phase_cvt_peer_tables(C2, 1, NEXP / 2, NEXP, S.nwg % C.G); }
    }
    if constexpr (K == 11) phase_peer_select(C, l + 1 >= DEPTH);
    if constexpr (K == 13) phase_final_norm(C);
    if constexpr (K == 12) {
#ifdef DBG_DUP12
        if (l + 1 < DEPTH) phase_peer_gather<false>(C, modl, 0.0f); else phase_peer_gather<true>(C, modl, 0.0f);
        __syncthreads();
#endif
        if (l + 1 < DEPTH) phase_peer_gather<false>(C, modl, DBG_PEER0); else phase_peer_gather<true>(C, modl, DBG_PEER1); }
}
__device__ __forceinline__ Ctx make_ctx(const Args& args, unsigned char* lds_raw) {
    Ctx C0; C0.in = (const __attribute__((address_space(4))) cfp_t*)__builtin_amdgcn_kernarg_segment_ptr(); C0.out = args.out; C0.ws = args.ws; C0.lds = (LAS unsigned char*)lds_raw;
    C0.tid = threadIdx.x; C0.lane = C0.tid & 63; C0.wid = __builtin_amdgcn_readfirstlane(C0.tid >> 6); C0.G = gridDim.x; C0.bid = blockIdx.x;
    return C0;
}
template <int K> __global__ void __launch_bounds__(NTHREADS, 2) k_one(Args args) {
    extern __shared__ __attribute__((aligned(16))) unsigned char lds_raw[];
    const Ctx C0 = make_ctx(args, lds_raw);
    run_phase<K>(C0, args.ph_lo);
}
#if MK_N_LAUNCHES == 1 || defined(DBG_HYB)
__global__ void __launch_bounds__(NTHREADS, 2) mk_fwd(Args args) {
    extern __shared__ __attribute__((aligned(16))) unsigned char lds_raw[];
    const Ctx C0 = make_ctx(args, lds_raw);
    if (C0.tid < 4) ((LAS unsigned*)(C0.lds + LDS_BAR_OFF))[C0.tid] = 0u;
    __syncthreads();
    const int lo = args.ph_lo, hi = args.ph_hi;
    XcdBarrier bar; bar.bar = (unsigned*)(args.ws + WS_CTL); bar.x = 0; bar.st = nullptr;
    if (hi - lo > 1) bar = xcd_barrier_post((unsigned*)(args.ws + WS_CTL), (volatile LAS unsigned*)(C0.lds + LDS_BAR_OFF));
#define IN(k) (lo <= (k) && (k) < hi)
#define SEAM(k) do { if (IN(k) && IN((k) + 1)) xcd_barrier(bar); } while (0)
#ifndef DBG_DUP
#define DBG_DUP -1
#endif
#define PH(K, k) do { if (IN(k)) { run_phase<K>(C0, l); if (K == DBG_DUP) { xcd_barrier(bar); run_phase<K>(C0, l); } } SEAM(k); } while (0)
    { const int l = 0; PH(0, 0); }
#pragma unroll 1
    for (int l = 0; l < DEPTH; ++l) {
        const int pb = 1 + 12 * l;
        PH(1, pb + 0); PH(2, pb + 1); PH(3, pb + 2); PH(4, pb + 3); PH(5, pb + 4); PH(6, pb + 5);
        PH(7, pb + 6); PH(8, pb + 7); PH(9, pb + 8); PH(10, pb + 9); PH(11, pb + 10); PH(12, pb + 11);
    }
    { const int l = DEPTH - 1; PH(13, 1 + 12 * DEPTH); }
#undef PH
#undef IN
#undef SEAM
}
#define MAIN_KERNEL mk_fwd
#else
#define MAIN_KERNEL k_one<6>
#endif


#ifdef DBG_PROBE
typedef int i32x8 __attribute__((ext_vector_type(8)));
__device__ __forceinline__ unsigned char fp8_of_int(int v) {
    const float f = (float)v; return (unsigned char)(__builtin_amdgcn_cvt_pk_fp8_f32(f, 0.f, 0, false) & 0xff); }
__global__ void k_probe_mx(unsigned* slot) {
    const int l = threadIdx.x, r = l & 31, g = l >> 5;
    i32x8 A, B;
    for (int j = 0; j < 8; ++j) { unsigned wa = 0, wb = 0;
        for (int b = 0; b < 4; ++b) { const int k = g * 32 + 4 * j + b;
            wa |= (unsigned)fp8_of_int(((3 * r + k) % 7) - 3) << (8 * b); wb |= (unsigned)fp8_of_int(((5 * k + 2 * r) % 9) - 4) << (8 * b); }
        A[j] = (int)wa; B[j] = (int)wb; }
    f32x16 c = {};
    c = __builtin_amdgcn_mfma_scale_f32_32x32x64_f8f6f4(A, B, c, 0, 0, 0, 0x7f7f7f7f, 0, 0x7f7f7f7f);
    float worst = 0.f;
    for (int i = 0; i < 16; ++i) { const int m = (i & 3) + 8 * (i >> 2) + 4 * g, n = r; float ref = 0.f; for (int k = 0; k < 64; ++k) ref += (float)(((3 * m + k) % 7) - 3) * (float)(((5 * k + 2 * n) % 9) - 4);
        worst = fmaxf(worst, fabsf(c[i] - ref)); }
    for (int o = 32; o >= 1; o >>= 1) worst = fmaxf(worst, __shfl_xor(worst, o));
    if (l == 0) { const float code = worst == 0.f ? 0.4f : 1.2f; *slot = __float_as_uint(powf(10.f, code / 0.25f - 4.f)); }
}
#endif
#ifdef DBG_CHECK
__device__ __forceinline__ void dbg_report(unsigned* slot, float err) { if (!(err <= 3e38f)) err = 1e30f; atomicMax(slot, __float_as_uint(err)); }
__global__ void k_check_gemm(const bf16_t* A, int lda, const float* W, int K, int N, const bf16_t* Cm, int ldc, int M, unsigned* slot) {
    const unsigned id = blockIdx.x * blockDim.x + threadIdx.x; if (id >= 8192) return;
    const unsigned h = id * 2654435761u; const int row = (int)((h >> 8) % (unsigned)M), col = (int)((h * 40503u >> 7) % (unsigned)N);
    float ref = 0.f; for (int k = 0; k < K; ++k) ref += bf2f(A[(size_t)row * lda + k]) * W[(size_t)k * N + col];
    const float got = bf2f(Cm[(size_t)row * ldc + col]);
    dbg_report(slot, fabsf(got - ref) / (fabsf(ref) + 0.1f));
}

__global__ void k_check_attn(const unsigned char* ws, int type, unsigned* slot) {
    __shared__ float sc[RPB]; __shared__ float red[256]; __shared__ float qv[192];
    const int t = threadIdx.x, bh = blockIdx.x & 15, b = bh >> 3, h = bh & 7; const int qpos = (int)(((blockIdx.x >> 4) * 977u + 13u) % SEQ); const size_t rq = (size_t)b * RPB + CTXL + qpos, rk = (size_t)b * RPB;
    const bf16_t* P = (const bf16_t*)(ws + WS_P); const bf16_t* MQ = (const bf16_t*)(ws + WS_MQ); const bf16_t* MKV = (const bf16_t*)(ws + WS_MKV);
    const int dq = type ? 128 : 192;
    if (t < dq) { float v = type ? bf2f(P[rq * NP + C_AQ + h * 128 + t]) : bf2f(MQ[rq * 1536 + h * 192 + t]); qv[t] = v; }
    __syncthreads();
    if (!type && t < 32) {
        const int ri = qpos >> 6, ci = qpos & 63; const int i = t; const float pos = (float)(i < 16 ? ri : ci); const float inv = powf(10000.f, -(float)(i & 15) / 16.f); const float a = pos * inv;
        const float x1 = qv[128 + i], x2 = qv[160 + i]; qv[128 + i] = x1 * cosf(a) - x2 * sinf(a); qv[160 + i] = x2 * cosf(a) + x1 * sinf(a); }
    __syncthreads();
    const float scale = type ? 0.088388347648f : 0.0721687836487f;
    float mx = -1e30f;
    for (int k = t; k < RPB; k += 256) { float s = 0.f;
        if (type) { const bf16_t* kp = P + (rk + k) * NP + C_AK + (h >> 2) * 128; for (int d = 0; d < 128; ++d) s += qv[d] * bf2f(kp[d]); }
        else { const bf16_t* kp = MKV + (rk + k) * 2048 + h * 256; for (int d = 0; d < 128; ++d) s += qv[d] * bf2f(kp[d]); const bf16_t* kr = P + (rk + k) * NP + C_MKR; for (int d = 0; d < 64; ++d) s += qv[128 + d] * bf2f(kr[d]); }
        s *= scale; sc[k] = s; mx = fmaxf(mx, s); }
    red[t] = mx; __syncthreads(); for (int o = 128; o >= 1; o >>= 1) { if (t < o) red[t] = fmaxf(red[t], red[t + o]); __syncthreads(); } mx = red[0]; __syncthreads();
    float sum = 0.f; for (int k = t; k < RPB; k += 256) { const float p = __expf(sc[k] - mx); sc[k] = p; sum += p; }
    red[t] = sum; __syncthreads(); for (int o = 128; o >= 1; o >>= 1) { if (t < o) red[t] += red[t + o]; __syncthreads(); } sum = red[0]; __syncthreads();
    float e = 0.f, mag = 0.f;
    if (t < 128) { float o = 0.f; for (int k = 0; k < RPB; ++k) { const float vv = type ? bf2f(P[(rk + k) * NP + C_AV + (h >> 2) * 128 + t]) : bf2f(MKV[(rk + k) * 2048 + h * 256 + 128 + t]); o += sc[k] * vv; }
        o /= sum; const float got = __builtin_amdgcn_cvt_f32_fp8((int)(ws + (type ? WS_OA : WS_OM))[rq * 1024 + h * 128 + t], 0) * (1.0f / 32.0f); e = fabsf(got - o); mag = fabsf(o); }
    red[t] = e; __syncthreads(); for (int o = 128; o >= 1; o >>= 1) { if (t < o) red[t] = fmaxf(red[t], red[t + o]); __syncthreads(); } e = red[0]; __syncthreads();
    red[t] = mag; __syncthreads(); for (int o = 128; o >= 1; o >>= 1) { if (t < o) red[t] = fmaxf(red[t], red[t + o]); __syncthreads(); } mag = red[0];
    if (t == 0) dbg_report(slot, e / (mag + 1e-4f));
}
__global__ void __launch_bounds__(256) k_check_gla_rec(const unsigned char* ws, const float* wa_f, const float* ba_f, const float* wa_b, const float* ba_b, float* obuf, int b) {
    __shared__ float ad[128], kd[128], qd[128], lrs[16];
    const int e = threadIdx.x, h = blockIdx.x & 3, dir = blockIdx.x >> 2; const bf16_t* P = (const bf16_t*)(ws + WS_P);
    const float* wa = dir ? wa_b : wa_f; const float* ba = dir ? ba_b : ba_f;
    float S[128];
#pragma unroll
    for (int d = 0; d < 128; ++d) S[d] = 0.f;
    float* ob = obuf + ((size_t)(dir * 2 + b) * 4 + h) * RPB * 256;
    for (int st = 0; st < RPB; ++st) {
        int j; if (!dir) j = st; else j = st < CTXL ? CTXL - 1 - st : RPB - 1 - (st - CTXL);
        const size_t r = (size_t)b * RPB + j; const bf16_t* pr = P + r * NP;
        if (e < 16) lrs[e] = bf2f(pr[(dir ? C_LRB : C_LRF) + e]);
        __syncthreads();
        if (e < 128) { float pre = ba[h * 128 + e]; for (int q = 0; q < 16; ++q) pre += lrs[q] * wa[q * 512 + h * 128 + e];
            const float ls = (fminf(pre, 0.f) - log1pf(expf(-fabsf(pre)))) / 16.f; ad[e] = expf(ls); kd[e] = bf2f(pr[C_LK + h * 128 + e]); qd[e] = bf2f(pr[C_LQ + h * 128 + e]) * 0.088388347648f; }
        __syncthreads();
        const float v = bf2f(pr[C_LV + h * 256 + e]); float o = 0.f;
#pragma unroll
        for (int d = 0; d < 128; ++d) { S[d] = ad[d] * S[d] + kd[d] * v; o += qd[d] * S[d]; }
        ob[(size_t)j * 256 + e] = o;
        __syncthreads();
    }
}
__global__ void k_check_gla_cmp(const unsigned char* ws, const float* obuf, const float* gon, int b, unsigned* slot) {
    __shared__ float red[256];
    const int e = threadIdx.x, h = blockIdx.x & 3, j = blockIdx.x >> 2; const size_t r = (size_t)b * RPB + j; const bf16_t* P = (const bf16_t*)(ws + WS_P);
    const float o = obuf[((size_t)(0 * 2 + b) * 4 + h) * RPB * 256 + (size_t)j * 256 + e] + obuf[((size_t)(1 * 2 + b) * 4 + h) * RPB * 256 + (size_t)j * 256 + e];
    red[e] = o * o; __syncthreads(); for (int s_ = 128; s_ >= 1; s_ >>= 1) { if (e < s_) red[e] += red[e + s_]; __syncthreads(); }
    const float rs = rsqrtf(red[0] / 256.f + NORM_EPS); __syncthreads();
    const float gt = bf2f(P[r * NP + C_LG + h * 256 + e]); const float ref = o * rs * gon[e] * (gt / (1.f + expf(-gt)));
    const float got = __builtin_amdgcn_cvt_f32_fp8((int)(ws + WS_OL)[r * 1024 + h * 256 + e], 0);
    red[e] = fabsf(got - ref); __syncthreads(); for (int s_ = 128; s_ >= 1; s_ >>= 1) { if (e < s_) red[e] = fmaxf(red[e], red[e + s_]); __syncthreads(); }
    if (e == 0) dbg_report(slot, red[0] / 1.0f);
}

__global__ void k_check_gemm8(const unsigned char* A8, const float* W, int K, int N, const bf16_t* Cm, int ldc, int M, unsigned* slot) {
    const unsigned id = blockIdx.x * blockDim.x + threadIdx.x; if (id >= 8192) return;
    const unsigned h = id * 2654435761u; const int row = (int)((h >> 8) % (unsigned)M), col = (int)((h * 40503u >> 7) % (unsigned)N);
    float ref = 0.f, mag = 0.f; for (int k = 0; k < K; ++k) { const float a = __builtin_amdgcn_cvt_f32_fp8((int)A8[(size_t)row * K + k], 0), w = W[(size_t)k * N + col]; ref += a * w; mag += a * a * w * w; }
    const float got = bf2f(Cm[(size_t)row * ldc + col]);
    dbg_report(slot, fabsf(got - ref) / (sqrtf(mag) + 1e-3f));
}
__global__ void k_check_select(const bf16_t* PQ, const float* k1, const float* k2, const int* PIDX, const float* PG, unsigned* slot) {
    __shared__ float s1[128], s2[128]; __shared__ int cnt; __shared__ float selv[16];
    const int tok = (blockIdx.x >> 3) * 61 + 5, head = blockIdx.x & 7, t = threadIdx.x;
    if (t == 0) cnt = 0;
    for (int n = t; n < 128; n += 64) { float a = 0.f, b = 0.f; for (int d = 0; d < 128; ++d) { a += bf2f(PQ[(size_t)tok * DM + head * 256 + d]) * k1[((size_t)head * 128 + n) * 128 + d]; b += bf2f(PQ[(size_t)tok * DM + head * 256 + 128 + d]) * k2[((size_t)head * 128 + n) * 128 + d]; } s1[n] = a; s2[n] = b; }
    __syncthreads();
    if (t < 16) { const int id = PIDX[(size_t)tok * 128 + head * 16 + t]; selv[t] = (id >= 0 && id < 16384) ? s1[id >> 7] + s2[id & 127] : -1e30f; }
    __syncthreads();
    float thr = selv[0], mx = selv[0]; for (int k = 1; k < 16; ++k) { thr = fminf(thr, selv[k]); mx = fmaxf(mx, selv[k]); }
    int c = 0; for (int p = t; p < 16384; p += 64) if (s1[p >> 7] + s2[p & 127] > thr + 0.02f) ++c;
    atomicAdd(&cnt, c); __syncthreads();
    if (t == 0) { float den = 0.f; for (int k = 0; k < 16; ++k) den += __expf(selv[k] - mx); float e = fabsf((float)cnt - 15.f) / 15.f > 0.34f ? fabsf((float)cnt - 15.f) / 15.f : 0.f;
        for (int k = 0; k < 16; ++k) e = fmaxf(e, fabsf(PG[(size_t)tok * 128 + head * 16 + k] - __expf(selv[k] - mx) / den) * 4.f);
        for (int k = 0; k < 16; ++k) for (int k2_ = 0; k2_ < k; ++k2_) if (PIDX[(size_t)tok * 128 + head * 16 + k] == PIDX[(size_t)tok * 128 + head * 16 + k2_]) e = fmaxf(e, 10.f);
        dbg_report(slot, e); }
}
__global__ void k_check_gather(const bf16_t* HB, const float* u, const float* v, const int* PIDX, const float* PG, const float* dbgo, unsigned* slot) {
    __shared__ float w[128];
    const int tok = blockIdx.x * 64 + 300, t = threadIdx.x;
    for (int k = t; k < 128; k += 64) { const int id = PIDX[(size_t)tok * 128 + k] & 16383; float a = 0.f; for (int d = 0; d < DM; ++d) a += bf2f(HB[(size_t)tok * DM + d]) * u[(size_t)id * DM + d];
        w[k] = PG[(size_t)tok * 128 + k] * 0.5f * a * (1.0f + erff(a * 0.70710678f)); }
    __syncthreads();
    float e = 0.f, sc = 0.f;
    for (int d = t; d < DM; d += 64) { float o = 0.f; for (int k = 0; k < 128; ++k) o += w[k] * v[(size_t)(PIDX[(size_t)tok * 128 + k] & 16383) * DM + d];
        e = fmaxf(e, fabsf(o - dbgo[(size_t)tok * DM + d])); sc = fmaxf(sc, fabsf(o)); }
    for (int o_ = 32; o_ >= 1; o_ >>= 1) { e = fmaxf(e, __shfl_xor(e, o_)); sc = fmaxf(sc, __shfl_xor(sc, o_)); }
    if (t == 0) dbg_report(slot, e / (sc + 1e-6f));
}
__global__ void k_dbg_out2(const float* x, const float* fg, float* out, const unsigned* slot) {
    const float mx = __uint_as_float(*slot); float v = 0.25f * (log10f(fmaxf(mx, 1e-30f)) + 4.0f); v = fminf(fmaxf(v, 0.f), 9.f);
    const float f = 1.0f + v;
    const int lane = threadIdx.x & 63; const size_t r = (size_t)blockIdx.x * 4 + (threadIdx.x >> 6);
    const float* xr = x + r * DM; float ss = 0.f;
    for (int c = lane; c < DM; c += 64) ss += xr[c] * xr[c];
    ss = wave_sum(ss); const float rs = rsqrtf(ss / DM + NORM_EPS);
    for (int c = lane; c < DM; c += 64) out[r * DM + c] = xr[c] * rs * fg[c] * f;
}
#endif
#ifdef DBG_SCAN
__global__ void k_scan16(const bf16_t* p, size_t n, unsigned* flags, int stage) {
    unsigned bad = 0; for (size_t i = (size_t)blockIdx.x * blockDim.x + threadIdx.x; i < n; i += (size_t)gridDim.x * blockDim.x) bad |= ((p[i] & 0x7f80u) == 0x7f80u);
    if (bad) atomicOr(&flags[stage], 1u);
}
__global__ void k_scan32(const float* p, size_t n, unsigned* flags, int stage) {
    unsigned bad = 0; for (size_t i = (size_t)blockIdx.x * blockDim.x + threadIdx.x; i < n; i += (size_t)gridDim.x * blockDim.x) bad |= ((__float_as_uint(p[i]) & 0x7f800000u) == 0x7f800000u);
    if (bad) atomicOr(&flags[stage], 1u);
}
__global__ void k_dbg_out(const float* x, const float* fg, float* out, const unsigned* flags, int nstage) {
    int code = 0; for (int s = nstage; s >= 1; --s) if (flags[s]) code = s;
    const float f = 1.0f + 0.25f * (float)code;
    const int lane = threadIdx.x & 63; const size_t r = (size_t)blockIdx.x * 4 + (threadIdx.x >> 6);
    const float* xr = x + r * DM; float ss = 0.f;
    for (int c = lane; c < DM; c += 64) ss += xr[c] * xr[c];
    ss = wave_sum(ss); const float rs = rsqrtf(ss / DM + NORM_EPS);
    for (int c = lane; c < DM; c += 64) out[r * DM + c] = xr[c] * rs * fg[c] * f;
}
#endif
extern "C" void kernel_launch(void* const* d_in, const int* in_sizes, int n_in, void* d_out, int out_size, void* d_ws, size_t ws_size, hipStream_t stream) {
    static int grid = 0;
    if (grid == 0) {
        if (n_in != 30 || out_size != NBATCH * SEQ * DM || ws_size < WS_END) { fprintf(stderr, "kernel_launch: shape/workspace mismatch: n_in %d out %d ws %zu (need %zu)\n", n_in, out_size, ws_size, (size_t)WS_END); grid = -1; return; }
        int dev = 0, cus = 0, per_cu = 0;
        if (hipGetDevice(&dev) != hipSuccess || hipDeviceGetAttribute(&cus, hipDeviceAttributeMultiprocessorCount, dev) != hipSuccess) { grid = -1; return; }
        bool okattr = hipFuncSetAttribute((const void*)MAIN_KERNEL, hipFuncAttributeMaxDynamicSharedMemorySize, LDS_BYTES) == hipSuccess;
#if MK_N_LAUNCHES != 1
#ifdef DBG_HYB
        okattr = okattr && hipFuncSetAttribute((const void*)mk_fwd, hipFuncAttributeMaxDynamicSharedMemorySize, LDS_BYTES) == hipSuccess;
#endif
#define SETA(K) okattr = okattr && hipFuncSetAttribute((const void*)k_one<K>, hipFuncAttributeMaxDynamicSharedMemorySize, LDS_BYTES) == hipSuccess
        SETA(0); SETA(1); SETA(2); SETA(3); SETA(4); SETA(5); SETA(6); SETA(7); SETA(8); SETA(9); SETA(10); SETA(11); SETA(12); SETA(13);
#undef SETA
#endif
        if (!okattr) { fprintf(stderr, "kernel_launch: hipFuncSetAttribute failed\n"); grid = -1; return; }
        if (hipOccupancyMaxActiveBlocksPerMultiprocessor(&per_cu, (const void*)MAIN_KERNEL, NTHREADS, LDS_BYTES) != hipSuccess || per_cu < 1) { fprintf(stderr, "kernel_launch: occupancy query says %d blocks per CU\n", per_cu); grid = -1; (void)hipGetLastError(); return; }
        grid = cus;
    }
    if (grid < 0) return;
    if (hipMemsetAsync((char*)d_ws + WS_CTL, 0, CTL_BYTES, stream) != hipSuccess) return;
    Args a{};
    for (int i = 0; i < 30; ++i) a.in[i] = (const float*)d_in[i];
    a.out = (float*)d_out; a.ws = (unsigned char*)d_ws;
#if defined(DBG_PROBE)
    { unsigned* flags = (unsigned*)((char*)d_ws + WS_CTL + 32768);
      hipLaunchKernelGGL(k_probe_mx, dim3(1), dim3(64), 0, stream, flags + 100);
      hipLaunchKernelGGL(k_dbg_out2, dim3(NBATCH * SEQ / 4), dim3(256), 0, stream, (const float*)d_in[0], (const float*)d_in[29], (float*)d_out, flags + 100); }
#elif MK_N_LAUNCHES == 1 && defined(DBG_CHECK)
    {
        unsigned* flags = (unsigned*)((char*)d_ws + WS_CTL + 32768); char* W = (char*)d_ws;
        a.ph_lo = 0; a.ph_hi = (DBG_CHECK == 8) ? 3 : (DBG_CHECK >= 5) ? 7 : (DBG_CHECK == 1 ? 11 : (DBG_CHECK == 2 ? 12 : 13));
        hipLaunchKernelGGL(mk_fwd, dim3(grid), dim3(NTHREADS), LDS_BYTES, stream, a);
#if DBG_CHECK == 8
        hipLaunchKernelGGL(k_check_gemm8, dim3(32), dim3(256), 0, stream, (const unsigned char*)(W + WS_HB), (const float*)d_in[I_WIN], DM, IN_COLS, (const bf16_t*)(W + WS_P), NP, TT, flags + 100);
#elif DBG_CHECK == 5 || DBG_CHECK == 6
        hipLaunchKernelGGL(k_check_attn, dim3(16 * 24), dim3(256), 0, stream, (const unsigned char*)d_ws, DBG_CHECK == 5 ? 1 : 0, flags + 100);
#elif DBG_CHECK == 7
        { float* obuf = (float*)(W + WS_MQ);
          hipLaunchKernelGGL(k_check_gla_rec, dim3(8), dim3(256), 0, stream, (const unsigned char*)d_ws, (const float*)d_in[I_WA2F], (const float*)d_in[I_BAF], (const float*)d_in[I_WA2B], (const float*)d_in[I_BAB], obuf, 0);
          hipLaunchKernelGGL(k_check_gla_cmp, dim3(RPB * 4), dim3(256), 0, stream, (const unsigned char*)d_ws, (const float*)obuf, (const float*)d_in[I_ONG], 0, flags + 100); }
#elif DBG_CHECK == 1
        hipLaunchKernelGGL(k_check_gemm, dim3(32), dim3(256), 0, stream, (const bf16_t*)(W + WS_HB), DM, (const float*)d_in[I_PWQ], DM, DM, (const bf16_t*)(W + WS_PQ), DM, TT, flags + 100);
#elif DBG_CHECK == 2
        hipLaunchKernelGGL(k_check_select, dim3(256 * 8), dim3(64), 0, stream, (const bf16_t*)(W + WS_PQ), (const float*)d_in[I_PK1], (const float*)d_in[I_PK2], (const int*)(W + WS_PIDX), (const float*)(W + WS_PG), flags + 100);
#else
        hipLaunchKernelGGL(k_check_gather, dim3(128), dim3(64), 0, stream, (const bf16_t*)(W + WS_HB), (const float*)d_in[I_PU], (const float*)d_in[I_PV], (const int*)(W + WS_PIDX), (const float*)(W + WS_PG), (const float*)(W + WS_MQ), flags + 100);
#endif
        hipLaunchKernelGGL(k_dbg_out2, dim3(NBATCH * SEQ / 4), dim3(256), 0, stream, (const float*)d_in[0], (const float*)d_in[29], (float*)d_out, flags + 100);
    }
#elif MK_N_LAUNCHES == 1
#ifdef DBG_SPLIT
    for (int p = 0; p < N_PHASES; p += DBG_SPLIT) { a.ph_lo = p; a.ph_hi = p + DBG_SPLIT < N_PHASES ? p + DBG_SPLIT : N_PHASES; hipLaunchKernelGGL(mk_fwd, dim3(grid), dim3(NTHREADS), LDS_BYTES, stream, a); }
#else
    a.ph_lo = 0; a.ph_hi = N_PHASES;
    hipLaunchKernelGGL(mk_fwd, dim3(grid), dim3(NTHREADS), LDS_BYTES, stream, a);
#endif
#else
    a.ph_hi = 0;
#ifndef DBG_NLAUNCH
#define DBG_NLAUNCH 100
#endif
    int nl_ = 0;
#ifdef DBG_HYB
#define LAUNCH1(K, L) do { if (K == DBG_HYB) { a.ph_lo = 12 * (L) + (K); a.ph_hi = a.ph_lo + 1; hipLaunchKernelGGL(mk_fwd, dim3(grid), dim3(NTHREADS), LDS_BYTES, stream, a); a.ph_hi = 0; } else { a.ph_lo = (L); hipLaunchKernelGGL(k_one<K>, dim3(grid), dim3(NTHREADS), LDS_BYTES, stream, a); } } while (0)
#else
#define LAUNCH1(K, L) do { a.ph_lo = (L); if (nl_++ < DBG_NLAUNCH) { hipLaunchKernelGGL(k_one<K>, dim3(grid), dim3(NTHREADS), LDS_BYTES, stream, a); if (K == DBG_DUP) hipLaunchKernelGGL(k_one<K>, dim3(grid), dim3(NTHREADS), LDS_BYTES, stream, a); } } while (0)
#endif
#ifdef DBG_SCAN
    unsigned* flags = (unsigned*)((char*)d_ws + WS_CTL + 32768);
    char* W = (char*)d_ws;
#define S16(off, n, st) hipLaunchKernelGGL(k_scan16, dim3(1024), dim3(256), 0, stream, (const bf16_t*)(W + (off)), (size_t)(n), flags, st)
#define S32(off, n, st) hipLaunchKernelGGL(k_scan32, dim3(1024), dim3(256), 0, stream, (const float*)(W + (off)), (size_t)(n), flags, st)
    LAUNCH1(0, 0); S32(WS_MODV, 2 * 3 * 12288, 1);
    { const int l = 0;
      LAUNCH1(1, l); S16(WS_HB, (size_t)TT * DM, 2);
      LAUNCH1(2, l); S16(WS_P, (size_t)TT * NP, 3);
      LAUNCH1(3, l); S16(WS_P, (size_t)TT * NP, 4);
      LAUNCH1(4, l); S16(WS_MQ, (size_t)TT * 1536, 5); S16(WS_MKV, (size_t)TT * 2048, 5); S16(WS_GST, (size_t)2112 * 32768, 6); S32(WS_GDEC, (size_t)2112 * 128, 6);
      LAUNCH1(5, l); S16(WS_GST, (size_t)2112 * 32768, 7);
      LAUNCH1(6, l); S16(WS_OA, (size_t)TT * 1024, 8); S16(WS_OM, (size_t)TT * 1024, 9); S16(WS_OL, (size_t)TT * 1024, 10);
      LAUNCH1(7, l); S16(WS_Y, (size_t)TT * DM, 11);
      LAUNCH1(8, l); S32(WS_XS, (size_t)TT * DM, 12);
      LAUNCH1(9, l); S16(WS_HB, (size_t)TT * DM, 13);
      LAUNCH1(10, l); S16(WS_PQ, (size_t)TT * DM, 14);
      LAUNCH1(11, l); S32(WS_PG, (size_t)TT * 128, 15);
      LAUNCH1(12, l); S32(WS_XS, (size_t)TT * DM, 16);
    }
    hipLaunchKernelGGL(k_dbg_out, dim3(NBATCH * SEQ / 4), dim3(256), 0, stream, (const float*)d_in[0], (const float*)d_in[29], (float*)d_out, flags, 16);
#elif defined(DBG_CHECK)
    unsigned* flags = (unsigned*)((char*)d_ws + WS_CTL + 32768);
    char* W = (char*)d_ws;
    LAUNCH1(0, 0);
    { const int l = 0; LAUNCH1(1, l); LAUNCH1(2, l); LAUNCH1(3, l); LAUNCH1(4, l); LAUNCH1(5, l); LAUNCH1(6, l);
#if DBG_CHECK == 5 || DBG_CHECK == 6
      hipLaunchKernelGGL(k_check_attn, dim3(16 * 24), dim3(256), 0, stream, (const unsigned char*)d_ws, DBG_CHECK == 5 ? 1 : 0, flags + 100);
#endif
#if DBG_CHECK == 7
      { float* obuf = (float*)(W + WS_MQ);
        hipLaunchKernelGGL(k_check_gla_rec, dim3(8), dim3(256), 0, stream, (const unsigned char*)d_ws, (const float*)d_in[I_WA2F], (const float*)d_in[I_BAF], (const float*)d_in[I_WA2B], (const float*)d_in[I_BAB], obuf, 0);
        hipLaunchKernelGGL(k_check_gla_cmp, dim3(RPB * 4), dim3(256), 0, stream, (const unsigned char*)d_ws, (const float*)obuf, (const float*)d_in[I_ONG], 0, flags + 100); }
#endif
      LAUNCH1(7, l); LAUNCH1(8, l); LAUNCH1(9, l); LAUNCH1(10, l);
#if DBG_CHECK == 1
      hipLaunchKernelGGL(k_check_gemm, dim3(32), dim3(256), 0, stream, (const bf16_t*)(W + WS_HB), DM, (const float*)d_in[I_PWQ], DM, DM, (const bf16_t*)(W + WS_PQ), DM, TT, flags + 100);
#endif
      LAUNCH1(11, l);
#if DBG_CHECK == 2
      hipLaunchKernelGGL(k_check_select, dim3(256 * 8), dim3(64), 0, stream, (const bf16_t*)(W + WS_PQ), (const float*)d_in[I_PK1], (const float*)d_in[I_PK2], (const int*)(W + WS_PIDX), (const float*)(W + WS_PG), flags + 100);
#endif
      LAUNCH1(12, l);
#if DBG_CHECK == 3
      hipLaunchKernelGGL(k_check_gather, dim3(128), dim3(64), 0, stream, (const bf16_t*)(W + WS_HB), (const float*)d_in[I_PU], (const float*)d_in[I_PV], (const int*)(W + WS_PIDX), (const float*)(W + WS_PG), (const float*)(W + WS_MQ), flags + 100);
#endif
    }
    hipLaunchKernelGGL(k_dbg_out2, dim3(NBATCH * SEQ / 4), dim3(256), 0, stream, (const float*)d_in[0], (const float*)d_in[29], (float*)d_out, flags + 100);
#else
    LAUNCH1(0, 0);
    for (int l = 0; l < DEPTH; ++l) { LAUNCH1(1, l); LAUNCH1(2, l); LAUNCH1(3, l);
#ifdef DBG_DUP23
        LAUNCH1(2, l); LAUNCH1(3, l);
#endif
        LAUNCH1(4, l); LAUNCH1(5, l);
#ifdef DBG_DUP45
        LAUNCH1(4, l); LAUNCH1(5, l);
#endif
        LAUNCH1(6, l); LAUNCH1(7, l); LAUNCH1(8, l); LAUNCH1(9, l); LAUNCH1(10, l); LAUNCH1(11, l); LAUNCH1(12, l); }
    LAUNCH1(13, DEPTH - 1);
#endif
#undef LAUNCH1
#endif
    const hipError_t le = hipPeekAtLastError();
    if (le != hipSuccess) fprintf(stderr, "kernel_launch: launch failed: %s\n", hipGetErrorName(le));
}
```

```cpp
#include <hip/hip_runtime.h>
#include <cstdio>
#include <cstdint>

#ifndef MK_N_LAUNCHES
#ifndef DBG_DUP
#define DBG_DUP -1
#endif
#define MK_N_LAUNCHES 1
#endif

#ifndef DBG_MIX0
#define DBG_MIX0 1.0f
#define DBG_MIX1 1.0f
#define DBG_PEER0 1.0f
#define DBG_PEER1 1.0f
#endif
#ifndef MLA_NQR
#define MLA_NQR 4
#endif
#define LAS __attribute__((address_space(3)))
#define GLB __attribute__((address_space(1)))
typedef unsigned short bf16_t;
typedef short bf16x8 __attribute__((ext_vector_type(8)));
typedef short s16x4 __attribute__((ext_vector_type(4)));
typedef float f32x4 __attribute__((ext_vector_type(4)));
typedef float f32x2 __attribute__((ext_vector_type(2)));
typedef float f32x16 __attribute__((ext_vector_type(16)));
typedef unsigned u32x4 __attribute__((ext_vector_type(4)));
typedef unsigned u32x2 __attribute__((ext_vector_type(2)));
typedef __bf16 bf2_t __attribute__((ext_vector_type(2)));

constexpr int DM = 2048, NBATCH = 2, SEQ = 8192, CTXL = 256, DEPTH = 2;
constexpr int RPB = SEQ + CTXL;
constexpr int TT = NBATCH * RPB;
constexpr int IN_COLS = 11872, NP = 12032;
constexpr int C_AQ = 0, C_AK = 1024, C_AV = 1280, C_LQ = 1536, C_LK = 2048, C_LV = 2560, C_LG = 3584, C_LRF = 4608, C_LRB = 4624,
              C_MCQ = 4640, C_MCKV = 5152, C_MKR = 5664, C_GA = 5728, C_GL = 7776, C_GM = 9824;
constexpr int NCH = RPB / 64;
constexpr int NEXP = 16384;
constexpr float NORM_EPS = 1e-6f;
constexpr int NTHREADS = 512;

constexpr size_t al256(size_t x) { return (x + 255) / 256 * 256; }
constexpr size_t WS_CTL   = 0;
constexpr size_t CTL_BYTES = 65536;
constexpr size_t WS_MODV  = WS_CTL + CTL_BYTES;
constexpr size_t WS_TABA  = al256(WS_MODV + (size_t)2 * 3 * 12288 * 4);
constexpr size_t WS_TABM  = WS_TABA + 2 * 128 * 32 * 4;
constexpr size_t WS_XS    = al256(WS_TABM + 2 * 128 * 16 * 4);
constexpr size_t WS_HB    = WS_XS + (size_t)TT * DM * 4;
constexpr size_t WS_P     = WS_HB + (size_t)TT * DM * 2;
constexpr size_t WS_MQ    = WS_P + (size_t)TT * NP * 2;
constexpr size_t WS_MKV   = WS_MQ + (size_t)TT * 1536 * 2;
constexpr size_t WS_OA    = WS_MKV + (size_t)TT * 2048 * 2;
constexpr size_t WS_OL    = WS_OA + (size_t)TT * 1024 * 2;
constexpr size_t WS_OM    = WS_OL + (size_t)TT * 1024 * 2;
constexpr size_t WS_WIN   = WS_OM + (size_t)TT * 1024 * 2;
constexpr size_t WS_WUQ   = WS_WIN + (size_t)NP * 2048 * 2;
constexpr size_t WS_WUKV  = WS_WUQ + (size_t)1536 * 512 * 2;
constexpr size_t WS_WBR   = WS_WUKV + (size_t)2048 * 512 * 2;
constexpr size_t WS_WOUT  = WS_WBR + (size_t)3 * 2048 * 1024 * 2;
constexpr size_t WS_WQ    = WS_WOUT + (size_t)2048 * 2048 * 2;
constexpr size_t WS_K1    = WS_WQ + (size_t)2048 * 2048 * 2;
constexpr size_t WS_K2    = WS_K1 + (size_t)8 * 128 * 128 * 2;
constexpr size_t WS_GST   = WS_K2 + (size_t)8 * 128 * 128 * 2;
constexpr size_t WS_GDEC  = WS_GST + (size_t)NBATCH * 2 * 4 * NCH * 32768 * 2;
constexpr size_t WS_END0  = WS_GDEC + (size_t)NBATCH * 2 * 4 * NCH * 128 * 4;
constexpr size_t WS_KN8   = WS_OA + (size_t)TT * 1024;
constexpr size_t WS_AK8   = WS_OL + (size_t)TT * 1024;
constexpr size_t WS_KR8   = WS_AK8 + (size_t)TT * 256;
constexpr size_t WS_VT8A  = WS_KR8 + (size_t)TT * 64;
constexpr size_t WS_VT8M  = WS_OM + (size_t)TT * 1024;
constexpr size_t WS_Y     = WS_MKV;
constexpr size_t WS_PQ    = WS_OA;
constexpr size_t WS_PIDX  = WS_P;
constexpr size_t WS_PG    = WS_PIDX + (size_t)TT * 128 * 4;
constexpr size_t PT_BYTES = 2 * (size_t)NEXP * DM + 2 * (size_t)NEXP * 4;
constexpr size_t WS_WINS  = WS_END0;
constexpr size_t WS_WOUTS = al256(WS_WINS + (size_t)NP * 4);
constexpr size_t WS_WBRS  = al256(WS_WOUTS + (size_t)DM * 4);
constexpr size_t WS_PT    = al256(WS_WBRS + (size_t)3 * DM * 4);
constexpr size_t WS_END   = WS_PT + DEPTH * PT_BYTES;
constexpr size_t PT_U8 = 0, PT_V8 = (size_t)NEXP * DM, PT_SCU = 2 * (size_t)NEXP * DM, PT_SCV = PT_SCU + (size_t)NEXP * 4;
static_assert(WS_PG + (size_t)TT * 128 * 4 <= WS_MQ, "PEER alias region overflows P");

__device__ __forceinline__ unsigned cvt_pk_bf16(float lo, float hi) { bf2_t v; v.x = (__bf16)lo; v.y = (__bf16)hi; return __builtin_bit_cast(unsigned, v); }
__device__ __forceinline__ bf16_t f2bf(float f) { return (bf16_t)(cvt_pk_bf16(f, 0.f) & 0xffffu); }
__device__ __forceinline__ float bf2f(bf16_t b) { return __uint_as_float(((unsigned)b) << 16); }
__device__ __forceinline__ float bflo(unsigned w) { return __uint_as_float(w << 16); }
__device__ __forceinline__ float bfhi(unsigned w) { return __uint_as_float(w & 0xffff0000u); }
__device__ __forceinline__ float xchg32(float x, int lane) { auto r = __builtin_amdgcn_permlane32_swap(__float_as_uint(x), __float_as_uint(x), false, false); return __uint_as_float(lane < 32 ? r[1] : r[0]); }
__device__ __forceinline__ float xchg16(float x, int lane) { auto r = __builtin_amdgcn_permlane16_swap(__float_as_uint(x), __float_as_uint(x), false, false); return __uint_as_float((lane & 16) ? r[0] : r[1]); }
template <int CTRL> __device__ __forceinline__ float dppmov(float x) { return __uint_as_float(__builtin_amdgcn_update_dpp(0u, __float_as_uint(x), CTRL, 0xF, 0xF, false)); }
constexpr int DPP_ROR8 = 0x128, DPP_HMIRROR = 0x141, DPP_Q3210 = 0x1B, DPP_Q1032 = 0xB1;
__device__ __forceinline__ float wave_sum(float v) {
    const int lane = threadIdx.x & 63;
    v += xchg32(v, lane); v += xchg16(v, lane); v += dppmov<DPP_ROR8>(v); v += dppmov<DPP_HMIRROR>(v); v += dppmov<DPP_Q3210>(v); v += dppmov<DPP_Q1032>(v);
    return v;
}
__device__ __forceinline__ float sigmoidf_(float x) { return __builtin_amdgcn_rcpf(1.0f + __expf(-x)); }
__device__ __forceinline__ float siluf_(float x) { return x * __builtin_amdgcn_rcpf(1.0f + __expf(-x)); }

#define XB_TMO      128
#define XB_XCNT(j)  (256  + 64 * (j))
#define XB_XSUB(j)  (1280 + 64 * (j))
#define XB_XGEN(j)  (2304 + 64 * (j))
#define XB_TOP      3328
#define XB_TOPGEN   3392
#define XCD_BAR_WORDS 3456
#define XB_SPIN_CAP (1u << 20)
__device__ __forceinline__ unsigned xb_ld(unsigned* p)              { return __hip_atomic_load(p, __ATOMIC_RELAXED, __HIP_MEMORY_SCOPE_AGENT); }
__device__ __forceinline__ unsigned xb_add(unsigned* p, unsigned v) { return __hip_atomic_fetch_add(p, v, __ATOMIC_RELAXED, __HIP_MEMORY_SCOPE_AGENT); }
__device__ __forceinline__ unsigned xb_xcc_id() { return (unsigned)__builtin_amdgcn_s_getreg((3 << 11) | 20) & 0xFu; }
#define XB_SPIN(cond, bar) do { unsigned _sp = 0; while (cond) { __builtin_amdgcn_s_sleep(1); \
    if ((++_sp & 255u) == 0u) { if (xb_ld(&(bar)[XB_TMO])) break; if (_sp > XB_SPIN_CAP) { atomicAdd(&(bar)[XB_TMO], 1u); break; } } } } while (0)
struct XcdBarrier { unsigned* bar; unsigned x; volatile LAS unsigned* st; };
__device__ __forceinline__ XcdBarrier xcd_barrier_post(unsigned* bar, volatile LAS unsigned* st) {
    XcdBarrier b; b.bar = bar; b.x = xb_xcc_id(); b.st = st;
    if (threadIdx.x == 0) (void)xb_add(&bar[XB_XCNT(b.x)], 1u);
    return b;
}
__device__ __forceinline__ void xcd_barrier_complete(unsigned* bar, unsigned x, unsigned& nloc, unsigned& nx) {
    const unsigned G = gridDim.x * gridDim.y * gridDim.z;
    unsigned sum, cnt, mine, sp = 0u;
    for (;;) {
        sum = 0u; cnt = 0u; mine = 0u;
#pragma unroll
        for (unsigned j = 0; j < 16; ++j) { const unsigned c = xb_ld(&bar[XB_XCNT(j)]); sum += c; cnt += (c > 0u) ? 1u : 0u; mine = (j == x) ? c : mine; }
        if (sum == G) break;
        __builtin_amdgcn_s_sleep(1);
        if ((++sp & 255u) == 0u) { if (xb_ld(&bar[XB_TMO])) break; if (sp > XB_SPIN_CAP) { atomicAdd(&bar[XB_TMO], 1u); break; } }
    }
    nloc = mine > 0u ? mine : 1u; nx = cnt > 0u ? cnt : 1u;
}
__device__ __forceinline__ void xcd_barrier(const XcdBarrier& b) {
    asm volatile("s_waitcnt vmcnt(0)" ::: "memory");
    __syncthreads();
    if (threadIdx.x == 0) {
        unsigned* bar = b.bar;
        __builtin_amdgcn_s_waitcnt(0);
        unsigned nloc = b.st[0], nx = b.st[1];
        if (nloc == 0u) { xcd_barrier_complete(bar, b.x, nloc, nx); b.st[0] = nloc; b.st[1] = nx; }
        const unsigned old = xb_add(&bar[XB_XSUB(b.x)], 1u);
        const unsigned gen = old / nloc;
        if (old + 1u == (gen + 1u) * nloc) {
            __builtin_amdgcn_fence(__ATOMIC_RELEASE, "agent");
            asm volatile("s_waitcnt vmcnt(0)" ::: "memory");
            const unsigned og = xb_add(&bar[XB_TOP], 1u);
            const unsigned tg = og / nx;
            if (og + 1u == (tg + 1u) * nx) xb_add(&bar[XB_TOPGEN], 1u);
            else XB_SPIN(xb_ld(&bar[XB_TOPGEN]) == tg, bar);
            __builtin_amdgcn_fence(__ATOMIC_ACQUIRE, "agent");
            xb_add(&bar[XB_XGEN(b.x)], 1u);
            asm volatile("s_waitcnt vmcnt(0)" ::: "memory");
        } else {
            XB_SPIN(xb_ld(&bar[XB_XGEN(b.x)]) == gen, bar);
            __builtin_amdgcn_fence(__ATOMIC_ACQUIRE, "agent");
            asm volatile("s_waitcnt vmcnt(0)" ::: "memory");
        }
    }
    __syncthreads();
}

namespace pg8 {
constexpr int BM = 256, BK = 64, HALF = 128, HTB = HALF * BK * 2, STAGE_BYTES = 8 * HTB, NXCD = 8, WGM = 8;
__host__ __device__ __forceinline__ int lds_byte(int r, int c) { const int st = (r >> 4) * 2 + (c >> 5), rr = r & 15, cc = c & 31, ob = rr * 64 + cc * 2; return st * 1024 + (ob ^ (((ob >> 9) & 1) << 5)); }
__host__ __device__ __forceinline__ void stage_rc(int b, int& R, int& C) { const int st = b / 1024, sb = b % 1024, swz = sb ^ (((sb >> 9) & 1) << 5); R = (st >> 1) * 16 + swz / 64; C = (st & 1) * 32 + (swz % 64) / 2; }
__host__ __device__ __forceinline__ int perm32(int rho) { const int n = rho >> 4, i = rho & 15; return 8 * (i >> 2) + 4 * n + (i & 3); }
struct Unit { int pm, pn; };
struct Gemm { const bf16_t* A; const bf16_t* Bt; int M, N, K, lda, ldb; };
struct StaticOrder {
    int nM, nN, nwg, G, c, latent;
    __host__ __device__ void init(int M, int N, int G_, int c_, int latent_ = 0) { latent = latent_; nM = latent_ ? 64 : M / BM; nN = N / BM; nwg = nM * nN; G = G_; c = c_; }
    __host__ __device__ bool next(int i, Unit& u) const {
        const long L = (long)i * G + c; if (L >= nwg) return false;
        int wgid = (int)L; { const int q = nwg / NXCD, r = nwg % NXCD, xcd = wgid % NXCD, off = wgid / NXCD; wgid = (xcd < r ? xcd * (q + 1) : r * (q + 1) + (xcd - r) * q) + off; }
        const int nig = WGM * nN, gid = wgid / nig, fm = gid * WGM, gsz = (nM - fm) < WGM ? (nM - fm) : WGM;
        u.pm = fm + ((wgid % nig) % gsz); u.pn = (wgid % nig) / gsz; if (latent) u.pm += 1 + (u.pm >= 32 ? 1 : 0); return true;
    }
};
struct WinOrder {
    StaticOrder S; int full, nlat, G, c;
    __host__ __device__ void init(int G_, int c_, int full_) { full = full_; G = G_; c = c_; S.init(TT, NP, G_, c_, full_ ? 0 : 1); nlat = S.nwg; }
    __host__ __device__ bool next(int i, Unit& u) const {
        if (full) return S.next(i, u);
        const long L = (long)i * G + c;
        if (L < nlat) return S.next(i, u);
        const int q = (int)(L - nlat); if (q >= 24) return false;
        const int t = q % 12; u.pm = q < 12 ? 0 : 33;
        u.pn = t < 2 ? 4 + t : (t < 8 ? 8 + (t - 2) : (t == 8 ? 18 : 20 + (t - 9)));
        return true;
    }
};
struct EpiStoreBf16 {
    static constexpr bool PERM = true;
    bf16_t* O; int ldc;
    __device__ __forceinline__ void operator()(const f32x4 (&acc)[2][2][4][2], const Unit& u, int wr, int wc, int fr, int fq) const {
        const int row0 = u.pm * BM + wr * 64 + fr, col0 = u.pn * BM + wc * 32 + 8 * fq;
#pragma unroll
        for (int ai = 0; ai < 2; ++ai)
#pragma unroll
            for (int m = 0; m < 4; ++m) { bf16_t* rowp = O + (size_t)(row0 + ai * HALF + m * 16) * ldc + col0;
#pragma unroll
                for (int bj = 0; bj < 2; ++bj) { const f32x4 v0 = acc[ai][bj][m][0], v1 = acc[ai][bj][m][1];
                    u32x4 w; w.x = cvt_pk_bf16(v0[0], v0[1]); w.y = cvt_pk_bf16(v0[2], v0[3]); w.z = cvt_pk_bf16(v1[0], v1[1]); w.w = cvt_pk_bf16(v1[2], v1[3]);
                    *(u32x4*)(rowp + bj * HALF) = w; } }
    }
};
struct EpiNull {
    static constexpr bool PERM = true;
    __device__ __forceinline__ void operator()(const f32x4 (&acc)[2][2][4][2], const Unit&, int, int, int, int) const {
#pragma unroll
        for (int a = 0; a < 2; ++a)
#pragma unroll
            for (int b = 0; b < 2; ++b)
#pragma unroll
                for (int m = 0; m < 4; ++m)
#pragma unroll
                    for (int n = 0; n < 2; ++n) asm volatile("" :: "v"(acc[a][b][m][n]));
    }
};
struct EpiStoreMKV {
    static constexpr bool PERM = true;
    bf16_t* O; unsigned char* K8;
    __device__ __forceinline__ void operator()(const f32x4 (&acc)[2][2][4][2], const Unit& u, int wr, int wc, int fr, int fq) const {
        const int row0 = u.pm * BM + wr * 64 + fr, col0 = u.pn * BM + wc * 32 + 8 * fq;
#pragma unroll
        for (int ai = 0; ai < 2; ++ai)
#pragma unroll
            for (int m = 0; m < 4; ++m) { const size_t r = (size_t)(row0 + ai * HALF + m * 16); bf16_t* rowp = O + r * 2048 + col0;
#pragma unroll
                for (int bj = 0; bj < 2; ++bj) { const f32x4 v0 = acc[ai][bj][m][0], v1 = acc[ai][bj][m][1];
                    u32x4 w; w.x = cvt_pk_bf16(v0[0], v0[1]); w.y = cvt_pk_bf16(v0[2], v0[3]); w.z = cvt_pk_bf16(v1[0], v1[1]); w.w = cvt_pk_bf16(v1[2], v1[3]);
                    *(u32x4*)(rowp + bj * HALF) = w;
                    if (bj == 0) { int p0 = __builtin_amdgcn_cvt_pk_fp8_f32(v0[0], v0[1], 0, false); p0 = __builtin_amdgcn_cvt_pk_fp8_f32(v0[2], v0[3], p0, true);
                        int p1 = __builtin_amdgcn_cvt_pk_fp8_f32(v1[0], v1[1], 0, false); p1 = __builtin_amdgcn_cvt_pk_fp8_f32(v1[2], v1[3], p1, true);
                        u32x2 w8; w8.x = (unsigned)p0; w8.y = (unsigned)p1; *(u32x2*)(K8 + r * 1024 + u.pn * 128 + wc * 32 + 8 * fq) = w8; } } }
    }
};
struct EpiStoreBf16S {
    static constexpr bool PERM = true;
    bf16_t* O; int ldc; const float* cs;
    __device__ __forceinline__ void operator()(const f32x4 (&acc)[2][2][4][2], const Unit& u, int wr, int wc, int fr, int fq) const {
        const int row0 = u.pm * BM + wr * 64 + fr, col0 = u.pn * BM + wc * 32 + 8 * fq;
        f32x4 sv[2][2];
#pragma unroll
        for (int bj = 0; bj < 2; ++bj)
#pragma unroll
            for (int n = 0; n < 2; ++n) sv[bj][n] = *(const f32x4*)(cs + col0 + bj * HALF + 4 * n);
#pragma unroll
        for (int ai = 0; ai < 2; ++ai)
#pragma unroll
            for (int m = 0; m < 4; ++m) { bf16_t* rowp = O + (size_t)(row0 + ai * HALF + m * 16) * ldc + col0;
#pragma unroll
                for (int bj = 0; bj < 2; ++bj) { const f32x4 v0 = acc[ai][bj][m][0] * sv[bj][0], v1 = acc[ai][bj][m][1] * sv[bj][1];
                    u32x4 w; w.x = cvt_pk_bf16(v0[0], v0[1]); w.y = cvt_pk_bf16(v0[2], v0[3]); w.z = cvt_pk_bf16(v1[0], v1[1]); w.w = cvt_pk_bf16(v1[2], v1[3]);
                    *(u32x4*)(rowp + bj * HALF) = w; } }
    }
};
template <bool FIRST, bool F8OUT = false> struct EpiGate {
    static constexpr bool PERM = true;
    bf16_t* Y; const bf16_t* Gt; unsigned char* Y8; const float* cs;
    __device__ __forceinline__ void operator()(const f32x4 (&acc)[2][2][4][2], const Unit& u, int wr, int wc, int fr, int fq) const {
        constexpr int ldy = DM, ldg = NP, ldy8 = DM;
        const int row0 = u.pm * BM + wr * 64 + fr, col0 = u.pn * BM + wc * 32 + 8 * fq;
        f32x4 sv[2][2];
#pragma unroll
        for (int bj = 0; bj < 2; ++bj)
#pragma unroll
            for (int n = 0; n < 2; ++n) sv[bj][n] = *(const f32x4*)(cs + col0 + bj * HALF + 4 * n);
#pragma unroll
        for (int ai = 0; ai < 2; ++ai)
#pragma unroll
        for (int mh = 0; mh < 2; ++mh) {
            u32x4 g[2][2], y[2][2];
#pragma unroll
            for (int mm = 0; mm < 2; ++mm)
#pragma unroll
                for (int bj = 0; bj < 2; ++bj) { const size_t r = (size_t)(row0 + ai * HALF + (mh * 2 + mm) * 16);
                    g[mm][bj] = *(const u32x4*)(Gt + r * ldg + col0 + bj * HALF);
                    if (!FIRST) y[mm][bj] = *(const u32x4*)(Y + r * ldy + col0 + bj * HALF); }
#pragma unroll
            for (int mm = 0; mm < 2; ++mm)
#pragma unroll
                for (int bj = 0; bj < 2; ++bj) { const int m = mh * 2 + mm; const size_t r = (size_t)(row0 + ai * HALF + m * 16); const f32x4 v0 = acc[ai][bj][m][0] * sv[bj][0], v1 = acc[ai][bj][m][1] * sv[bj][1]; const u32x4 gg = g[mm][bj];
                    float o[8];
                    o[0] = sigmoidf_(bflo(gg.x)) * v0[0]; o[1] = sigmoidf_(bfhi(gg.x)) * v0[1]; o[2] = sigmoidf_(bflo(gg.y)) * v0[2]; o[3] = sigmoidf_(bfhi(gg.y)) * v0[3];
                    o[4] = sigmoidf_(bflo(gg.z)) * v1[0]; o[5] = sigmoidf_(bfhi(gg.z)) * v1[1]; o[6] = sigmoidf_(bflo(gg.w)) * v1[2]; o[7] = sigmoidf_(bfhi(gg.w)) * v1[3];
                    if (!FIRST) { const u32x4 yy = y[mm][bj];
                        o[0] += bflo(yy.x); o[1] += bfhi(yy.x); o[2] += bflo(yy.y); o[3] += bfhi(yy.y); o[4] += bflo(yy.z); o[5] += bfhi(yy.z); o[6] += bflo(yy.w); o[7] += bfhi(yy.w); }
                    if constexpr (F8OUT) { int p0 = __builtin_amdgcn_cvt_pk_fp8_f32(o[0], o[1], 0, false); p0 = __builtin_amdgcn_cvt_pk_fp8_f32(o[2], o[3], p0, true);
                        int p1 = __builtin_amdgcn_cvt_pk_fp8_f32(o[4], o[5], 0, false); p1 = __builtin_amdgcn_cvt_pk_fp8_f32(o[6], o[7], p1, true);
                        u32x2 w8; w8.x = (unsigned)p0; w8.y = (unsigned)p1; *(u32x2*)(Y8 + r * ldy8 + col0 + bj * HALF) = w8; }
                    else { u32x4 w; w.x = cvt_pk_bf16(o[0], o[1]); w.y = cvt_pk_bf16(o[2], o[3]); w.z = cvt_pk_bf16(o[4], o[5]); w.w = cvt_pk_bf16(o[6], o[7]);
                        *(u32x4*)(Y + r * ldy + col0 + bj * HALF) = w; } }
        }
    }
};
template <bool CS> struct EpiResidT {
    static constexpr bool PERM = false;
    float* X; int ldx; const float* gate; const float* cs;
    __device__ __forceinline__ void operator()(const f32x4 (&acc)[2][2][4][2], const Unit& u, int wr, int wc, int fr, int fq) const {
        const int row0 = u.pm * BM + wr * 64 + fr, col0 = u.pn * BM + wc * 32 + 4 * fq;
        const int sel = (u.pm % 33 == 0) ? 2 : (u.pm / 33);
        const float* gp = gate + (size_t)sel * 12288 + col0;
        f32x4 gv[2][2];
#pragma unroll
        for (int bj = 0; bj < 2; ++bj)
#pragma unroll
            for (int n = 0; n < 2; ++n) { gv[bj][n] = *(const f32x4*)(gp + bj * HALF + n * 16); if constexpr (CS) gv[bj][n] = gv[bj][n] * *(const f32x4*)(cs + col0 + bj * HALF + n * 16); }
#pragma unroll
        for (int ai = 0; ai < 2; ++ai)
#pragma unroll
            for (int mh = 0; mh < 2; ++mh) {
                f32x4 x[2][2][2];
#pragma unroll
                for (int mm = 0; mm < 2; ++mm)
#pragma unroll
                    for (int bj = 0; bj < 2; ++bj)
#pragma unroll
                        for (int n = 0; n < 2; ++n) x[mm][bj][n] = *(const f32x4*)(X + (size_t)(row0 + ai * HALF + (mh * 2 + mm) * 16) * ldx + col0 + bj * HALF + n * 16);
#pragma unroll
                for (int mm = 0; mm < 2; ++mm)
#pragma unroll
                    for (int bj = 0; bj < 2; ++bj)
#pragma unroll
                        for (int n = 0; n < 2; ++n) *(f32x4*)(X + (size_t)(row0 + ai * HALF + (mh * 2 + mm) * 16) * ldx + col0 + bj * HALF + n * 16) = x[mm][bj][n] + gv[bj][n] * acc[ai][bj][mh * 2 + mm][n];
            }
    }
};

typedef int i32x8 __attribute__((ext_vector_type(8)));
typedef int i32x4 __attribute__((ext_vector_type(4)));
__device__ __forceinline__ i32x8 cat8(const bf16x8 lo, const bf16x8 hi) { const i32x4 a = __builtin_bit_cast(i32x4, lo), b = __builtin_bit_cast(i32x4, hi); return __builtin_shufflevector(a, b, 0, 1, 2, 3, 4, 5, 6, 7); }
template <class Epi, class Sched, int F8 = 0>
__device__ __forceinline__ void gemm_phase(LAS unsigned char* lds, const int tid, const Gemm g, const Sched& S, const Epi& E) {
    const int wid = __builtin_amdgcn_readfirstlane(tid >> 6), lane = tid & 63, wr = wid >> 2, wc = wid & 3, fr = lane & 15, fq = lane >> 4;
    const int K = g.K, nt = F8 ? K / 128 : K / BK, lda = g.lda, ldb = g.ldb;
    unsigned voffA[2], voffB[2];
#pragma unroll
    for (int i = 0; i < 2; ++i) { int R, C; stage_rc(tid * 16 + i * 8192, R, C); const int Rb = Epi::PERM ? ((R & ~31) + perm32(R & 31)) : R;
        voffA[i] = F8 ? (unsigned)(R * lda + C * 2) : (unsigned)(R * lda + C) * 2u; voffB[i] = F8 ? (unsigned)(Rb * ldb + C * 2) : (unsigned)(Rb * ldb + C) * 2u; }
    const size_t kstep = (size_t)(BK * 2);
    const size_t hstepA = (size_t)HALF * lda * (F8 ? 1 : 2), hstepB = (size_t)HALF * ldb * (F8 ? 1 : 2);
    const size_t tstepA = 2 * hstepA, tstepB = 2 * hstepB;
    const unsigned ldsw = (unsigned)wid * 1024u;
    const int aoff = F8 ? lds_byte(wr * 64 + fr, (fq & 1) * 16) + (fq >> 1) * 1024 : lds_byte(wr * 64 + fr, fq * 8);
    const int boff = F8 ? lds_byte(wc * 32 + fr, (fq & 1) * 16) + (fq >> 1) * 1024 : lds_byte(wc * 32 + fr, fq * 8);
#define PG8_SA(b, h) (((b) * 2 + (h)) * HTB)
#define PG8_SB(b, h) ((4 + (b) * 2 + (h)) * HTB)
#define PG8_STAGE(bufoff, gbase, voff) do { _Pragma("unroll") for (int _i = 0; _i < 2; ++_i) \
        __builtin_amdgcn_global_load_lds((const unsigned*)((const char*)(gbase) + (voff)[_i]), (LAS unsigned*)(lds + (bufoff) + ldsw + _i * 8192), 16, 0, 0); } while (0)
#define PG8_LDA(dst, b, h) do { if constexpr (F8) { _Pragma("unroll") for (int m = 0; m < 4; ++m) { const LAS unsigned char* p_ = lds + PG8_SA(b, h) + aoff + m * 2048; \
            const i32x4 lo_ = *(const LAS i32x4*)p_, hi_ = *(const LAS i32x4*)(p_ + 16); dst##8[m] = __builtin_shufflevector(lo_, hi_, 0, 1, 2, 3, 4, 5, 6, 7); } } \
        else { _Pragma("unroll") for (int m = 0; m < 4; ++m) _Pragma("unroll") for (int k = 0; k < 2; ++k) dst[m][k] = *(const LAS bf16x8*)(lds + PG8_SA(b, h) + aoff + m * 2048 + k * 1024); } } while (0)
#define PG8_LDB(dst, b, h) do { if constexpr (F8) { _Pragma("unroll") for (int n = 0; n < 2; ++n) { const LAS unsigned char* p_ = lds + PG8_SB(b, h) + boff + n * 2048; \
            const i32x4 lo_ = *(const LAS i32x4*)p_, hi_ = *(const LAS i32x4*)(p_ + 16); dst##8[n] = __builtin_shufflevector(lo_, hi_, 0, 1, 2, 3, 4, 5, 6, 7); } } \
        else { _Pragma("unroll") for (int n = 0; n < 2; ++n) _Pragma("unroll") for (int k = 0; k < 2; ++k) dst[n][k] = *(const LAS bf16x8*)(lds + PG8_SB(b, h) + boff + n * 2048 + k * 1024); } } while (0)
#define PG8_MMA(ai, bj, At, Bt) do { __builtin_amdgcn_s_setprio(1); \
        if constexpr (F8) { _Pragma("unroll") for (int m = 0; m < 4; ++m) _Pragma("unroll") for (int n = 0; n < 2; ++n) \
            asm volatile("v_mfma_scale_f32_16x16x128_f8f6f4 %0, %1, %2, %0, %3, %3 op_sel_hi:[0,0,0]" : "+v"(acc[ai][bj][m][n]) : "v"(Bt##8[n]), "v"(At##8[m]), "v"(mxscale)); } \
        else { _Pragma("unroll") for (int m = 0; m < 4; ++m) _Pragma("unroll") for (int n = 0; n < 2; ++n) _Pragma("unroll") for (int k = 0; k < 2; ++k) \
            acc[ai][bj][m][n] = __builtin_amdgcn_mfma_f32_16x16x32_bf16(Bt[n][k], At[m][k], acc[ai][bj][m][n], 0, 0, 0); } \
        __builtin_amdgcn_s_setprio(0); } while (0)
#define PG8_WAIT_V(n) asm volatile("s_waitcnt vmcnt(" #n ")" ::: "memory")
#define PG8_WAIT_L(n) asm volatile("s_waitcnt lgkmcnt(" #n ")" ::: "memory")
#define PG8_BAR __builtin_amdgcn_s_barrier()
#define PG8_SCHED __builtin_amdgcn_sched_barrier(0)
    Unit cur, nxt; int ui = 0;
    if (!S.next(0, cur)) return;
    f32x4 acc[2][2][4][2];
#pragma unroll
    for (int a = 0; a < 2; ++a)
#pragma unroll
        for (int b = 0; b < 2; ++b)
#pragma unroll
            for (int m = 0; m < 4; ++m)
#pragma unroll
                for (int n = 0; n < 2; ++n) acc[a][b][m][n] = (f32x4){0.f, 0.f, 0.f, 0.f};
    int mxscale = 0x7f7f7f7f; asm volatile("" : "+v"(mxscale));
    bf16x8 At[4][2], B0[2][2], B1[2][2]; i32x8 At8[4], B08[2], B18[2];
    const char* cA = (const char*)g.A + (size_t)cur.pm * tstepA; const char* cB = (const char*)g.Bt + (size_t)cur.pn * tstepB;
    PG8_STAGE(PG8_SB(0, 0), cB, voffB); PG8_STAGE(PG8_SA(0, 0), cA, voffA); PG8_STAGE(PG8_SB(0, 1), cB + hstepB, voffB); PG8_STAGE(PG8_SA(0, 1), cA + hstepA, voffA);
    if (wr == 1) PG8_BAR;
    PG8_WAIT_V(4); PG8_BAR;
    PG8_STAGE(PG8_SB(1, 0), cB + kstep, voffB); PG8_STAGE(PG8_SA(1, 0), cA + kstep, voffA); PG8_STAGE(PG8_SB(1, 1), cB + hstepB + kstep, voffB);
    PG8_WAIT_V(6); PG8_BAR;
    for (;;) {
        const bool has_next = S.next(ui + 1, nxt);
        const char* nA = has_next ? (const char*)g.A + (size_t)nxt.pm * tstepA : cA; const char* nB = has_next ? (const char*)g.Bt + (size_t)nxt.pn * tstepB : cB;
        for (int t = 0; t < nt; t += 2) {
            const bool last = (t == nt - 2);
            const char* a1 = cA + (size_t)(t + 1) * kstep;
            const char* a2 = last ? nA : cA + (size_t)(t + 2) * kstep; const char* b2 = last ? nB : cB + (size_t)(t + 2) * kstep;
            const char* a3 = a2 + kstep; const char* b3 = b2 + kstep;
            PG8_LDB(B0, 0, 0); PG8_SCHED; PG8_LDA(At, 0, 0); PG8_STAGE(PG8_SA(1, 1), a1 + hstepA, voffA);
            PG8_WAIT_L(8); PG8_BAR; PG8_WAIT_L(0); PG8_MMA(0, 0, At, B0); PG8_BAR; PG8_SCHED;
            PG8_LDB(B1, 0, 1); PG8_STAGE(PG8_SB(0, 0), b2, voffB);
            PG8_BAR; PG8_WAIT_L(0); PG8_MMA(0, 1, At, B1); PG8_BAR;
            PG8_LDA(At, 0, 1); PG8_STAGE(PG8_SA(0, 0), a2, voffA);
            PG8_BAR; PG8_WAIT_L(0); PG8_MMA(1, 0, At, B0); PG8_BAR; PG8_SCHED;
            PG8_STAGE(PG8_SB(0, 1), b2 + hstepB, voffB);
            PG8_WAIT_V(6); PG8_BAR; PG8_MMA(1, 1, At, B1); PG8_BAR;
            PG8_LDB(B0, 1, 0); PG8_SCHED; PG8_LDA(At, 1, 0); PG8_STAGE(PG8_SA(0, 1), a2 + hstepA, voffA);
            PG8_WAIT_L(8); PG8_BAR; PG8_WAIT_L(0); PG8_MMA(0, 0, At, B0); PG8_BAR; PG8_SCHED;
            PG8_LDB(B1, 1, 1); PG8_STAGE(PG8_SB(1, 0), b3, voffB);
            PG8_BAR; PG8_WAIT_L(0); PG8_MMA(0, 1, At, B1); PG8_BAR;
            PG8_LDA(At, 1, 1); PG8_STAGE(PG8_SA(1, 0), a3, voffA);
            PG8_BAR; PG8_WAIT_L(0); PG8_MMA(1, 0, At, B0); PG8_BAR; PG8_SCHED;
            PG8_STAGE(PG8_SB(1, 1), b3 + hstepB, voffB);
            PG8_WAIT_V(6); PG8_BAR; PG8_MMA(1, 1, At, B1); PG8_BAR;
        }
        if constexpr (F8) asm volatile("s_nop 15\n\ts_nop 7");
        E(acc, cur, wr, wc, fr, fq);
        if (!has_next) break;
#pragma unroll
        for (int a = 0; a < 2; ++a)
#pragma unroll
            for (int b = 0; b < 2; ++b)
#pragma unroll
                for (int m = 0; m < 4; ++m)
#pragma unroll
                    for (int n = 0; n < 2; ++n) acc[a][b][m][n] = (f32x4){0.f, 0.f, 0.f, 0.f};
        cur = nxt; cA = nA; cB = nB; ++ui;
    }
    PG8_WAIT_V(0);
    if (wr == 0) PG8_BAR;
    PG8_BAR;
#undef PG8_SA
#undef PG8_SB
#undef PG8_STAGE
#undef PG8_LDA
#undef PG8_LDB
#undef PG8_MMA
#undef PG8_WAIT_V
#undef PG8_WAIT_L
#undef PG8_BAR
#undef PG8_SCHED
}
}

struct Args { const float* in[30]; float* out; unsigned char* ws; int ph_lo, ph_hi; };
enum { I_X = 0, I_C, I_CTX, I_CCTX, I_WMOD, I_BMOD, I_N1G, I_WIN, I_QNG, I_KNG, I_WA2F, I_BAF, I_WA2B, I_BAB, I_ONG, I_MQNG, I_WUQ, I_MKVNG, I_WUKV,
       I_WBRA, I_WBRL, I_WBRM, I_WOUT, I_N2G, I_PWQ, I_PK1, I_PK2, I_PU, I_PV, I_FG };
typedef const float* cfp_t;
struct Ctx {
    const __attribute__((address_space(4))) cfp_t* in; float* out; unsigned char* ws; LAS unsigned char* lds;
    int tid, lane, wid, G, bid;
};
#define WSP(T, off) ((T*)(C.ws + (off)))
#define INP(i) ((const float*)(const GLB float*)C.in[(i)])
__device__ __forceinline__ unsigned long long launder_u64(unsigned long long w) {
    unsigned lo = (unsigned)w, hi = (unsigned)(w >> 32); asm volatile("" : "+v"(lo), "+v"(hi));
    lo = __builtin_amdgcn_readfirstlane(lo); hi = __builtin_amdgcn_readfirstlane(hi); return ((unsigned long long)hi << 32) | lo;
}
__device__ __forceinline__ Ctx launder(const Ctx& C0) {
    Ctx R = C0; int t = C0.tid; asm volatile("" : "+v"(t)); R.tid = t; R.lane = t & 63; R.wid = __builtin_amdgcn_readfirstlane(t >> 6);
    R.ws = (unsigned char*)(GLB unsigned char*)launder_u64((unsigned long long)C0.ws);
    R.out = (float*)(GLB float*)(unsigned long long)C0.out;
    R.in = (const __attribute__((address_space(4))) cfp_t*)launder_u64((unsigned long long)C0.in);
    unsigned l = (unsigned)(uintptr_t)C0.lds; asm volatile("" : "+v"(l)); l = __builtin_amdgcn_readfirstlane(l); R.lds = (LAS unsigned char*)(uintptr_t)l;
    return R;
}

__device__ __forceinline__ const float* src_row(const Ctx& C, int r) {
    const int b = r / RPB, j = r % RPB;
    return j < CTXL ? INP(I_CTX) + ((size_t)b * CTXL + j) * DM : INP(I_X) + ((size_t)b * SEQ + (j - CTXL)) * DM;
}
__device__ __forceinline__ int mod_sel(int r) { const int b = r / RPB, j = r % RPB; return j < CTXL ? 2 : b; }

__device__ __forceinline__ void phase_modv(const Ctx& C) {
    LAS float* sc = (LAS float*)C.lds;
    LAS float* red = (LAS float*)(C.lds + 3 * 2048 * 4);
    for (int i = C.tid; i < 3 * DM; i += NTHREADS) { const int r = i / DM, k = i % DM; const float v = r < 2 ? INP(I_C)[r * DM + k] : INP(I_CCTX)[k]; sc[i] = siluf_(v); }
    __syncthreads();
    float* modv = WSP(float, WS_MODV);
    const int kq = C.tid / 12, c4 = C.tid % 12;
    for (int item = C.bid; item < 2 * 256; item += C.G) {
        const int l = item / 256, cg = item % 256;
        float acc[3][4];
#pragma unroll
        for (int r = 0; r < 3; ++r)
#pragma unroll
            for (int j = 0; j < 4; ++j) acc[r][j] = 0.f;
        if (kq < 42) {
            const float* wp = INP(I_WMOD) + (size_t)l * DM * 12288 + 48 * cg + 4 * c4;
#pragma unroll 1
            for (int k0 = kq; k0 < DM; k0 += 42 * 7) {
                f32x4 w[7];
#pragma unroll
                for (int u = 0; u < 7; ++u) { const int k = k0 + 42 * u; w[u] = k < DM ? *(const f32x4*)(wp + (size_t)k * 12288) : (f32x4){0.f, 0.f, 0.f, 0.f}; }
#pragma unroll
                for (int u = 0; u < 7; ++u) { const int k = k0 + 42 * u; if (k < DM) {
#pragma unroll
                    for (int r = 0; r < 3; ++r) { const float sv = sc[r * DM + k];
#pragma unroll
                        for (int j = 0; j < 4; ++j) acc[r][j] += sv * w[u][j]; } } }
            }
#pragma unroll
            for (int r = 0; r < 3; ++r)
#pragma unroll
                for (int j = 0; j < 4; ++j) red[kq * 144 + r * 48 + c4 * 4 + j] = acc[r][j];
        }
        __syncthreads();
        if (C.tid < 144) { float s = 0.f; for (int q = 0; q < 42; ++q) s += red[q * 144 + C.tid];
            const int r = C.tid / 48, cc = C.tid % 48;
            modv[((size_t)l * 3 + r) * 12288 + 48 * cg + cc] = s + INP(I_BMOD)[(size_t)l * 12288 + 48 * cg + cc]; }
        __syncthreads();
    }
}
__device__ __forceinline__ void phase_tables(const Ctx& C) {
    float* ta = WSP(float, WS_TABA); float* tm = WSP(float, WS_TABM);
    for (int i = C.bid * NTHREADS + C.tid; i < 128 * 32 + 128 * 16; i += C.G * NTHREADS) {
        if (i < 128 * 32) { const int pos = i / 32, f = i % 32; const float inv = exp2f(-(float)f * (13.287712379549449f / 32.0f)); const float a = (float)pos * inv;
            ta[i] = cosf(a); ta[128 * 32 + i] = sinf(a); }
        else { const int k = i - 128 * 32, pos = k / 16, f = k % 16; const float inv = exp2f(-(float)f * (13.287712379549449f / 16.0f)); const float a = (float)pos * inv;
            tm[k] = cosf(a); tm[128 * 16 + k] = sinf(a); }
    }
}
__device__ __forceinline__ void transpose_cvt(const Ctx& C, const float* src, int K, int N, bf16_t* dst, int Npad, int& item) {
    LAS float* tile = (LAS float*)C.lds;
    const int tk = K / 64, tn = Npad / 256, ntile = tk * tn;
    const int t0 = ((C.bid - item % C.G) + C.G) % C.G; item += ntile;
    for (int t = t0; t < ntile; t += C.G) {
        const int k0 = (t / tn) * 64, n0 = (t % tn) * 256;
        const int nn = (C.tid & 63) * 4, kr = C.tid >> 6;
        f32x4 v[8];
#pragma unroll
        for (int p = 0; p < 8; ++p) { v[p] = (f32x4){0.f, 0.f, 0.f, 0.f}; if (n0 + nn < N) v[p] = *(const f32x4*)(src + (size_t)(k0 + kr + p * 8) * N + n0 + nn); }
#pragma unroll
        for (int p = 0; p < 8; ++p)
#pragma unroll
            for (int j = 0; j < 4; ++j) tile[(kr + p * 8) * 257 + nn + j] = v[p][j];
        __syncthreads();
        { const int n = C.tid >> 1, kh = (C.tid & 1) * 32;
#pragma unroll
          for (int q = 0; q < 4; ++q) { float x[8];
#pragma unroll
              for (int j = 0; j < 8; ++j) x[j] = tile[(kh + q * 8 + j) * 257 + n];
              u32x4 w; w.x = cvt_pk_bf16(x[0], x[1]); w.y = cvt_pk_bf16(x[2], x[3]); w.z = cvt_pk_bf16(x[4], x[5]); w.w = cvt_pk_bf16(x[6], x[7]);
              *(u32x4*)(dst + (size_t)(n0 + n) * K + k0 + kh + q * 8) = w; } }
        __syncthreads();
    }
}
__device__ __forceinline__ void transpose_cvt_fp8(const Ctx& C, const float* src, int K, int N, unsigned char* dst, int Npad, float* cinv, const float cmul = 1.0f) {
    LAS float* tile = (LAS float*)C.lds;
    LAS float* red = (LAS float*)(C.lds + 64 * 65 * 4);
    LAS float* scl = red + 32 * 64;
    const int kk = C.tid >> 4, nn = (C.tid & 15) * 4;
    for (int cgp = C.bid; cgp < Npad / 64; cgp += C.G) {
        const int n0 = cgp * 64; const bool live = n0 + nn < N;
        float am[4] = {0.f, 0.f, 0.f, 0.f};
        for (int k0 = 0; k0 < K; k0 += 128) {
            f32x4 v[4];
#pragma unroll
            for (int p = 0; p < 4; ++p) v[p] = live ? *(const f32x4*)(src + (size_t)(k0 + kk + p * 32) * N + n0 + nn) : (f32x4){0.f, 0.f, 0.f, 0.f};
#pragma unroll
            for (int p = 0; p < 4; ++p)
#pragma unroll
                for (int j = 0; j < 4; ++j) am[j] = fmaxf(am[j], fabsf(v[p][j])); }
#pragma unroll
        for (int j = 0; j < 4; ++j) red[kk * 64 + nn + j] = am[j];
        __syncthreads();
        if (C.tid < 64) { float m = 0.f; for (int q = 0; q < 32; ++q) m = fmaxf(m, red[q * 64 + C.tid]);
            scl[C.tid] = m > 0.f ? 224.0f / m : 1.0f; cinv[n0 + C.tid] = (m > 0.f ? m * (1.0f / 224.0f) : 1.0f) * cmul; }
        __syncthreads();
        for (int k0 = 0; k0 < K; k0 += 64) {
#pragma unroll
            for (int p = 0; p < 2; ++p) { const f32x4 v = live ? *(const f32x4*)(src + (size_t)(k0 + kk + p * 32) * N + n0 + nn) : (f32x4){0.f, 0.f, 0.f, 0.f};
#pragma unroll
                for (int j = 0; j < 4; ++j) tile[(kk + p * 32) * 65 + nn + j] = v[j]; }
            __syncthreads();
            { const int n = C.tid >> 3, k8 = (C.tid & 7) * 8; const float sc = scl[n]; float x[8];
#pragma unroll
              for (int j = 0; j < 8; ++j) x[j] = tile[(k8 + j) * 65 + n] * sc;
              int p0 = __builtin_amdgcn_cvt_pk_fp8_f32(x[0], x[1], 0, false); p0 = __builtin_amdgcn_cvt_pk_fp8_f32(x[2], x[3], p0, true);
              int p1 = __builtin_amdgcn_cvt_pk_fp8_f32(x[4], x[5], 0, false); p1 = __builtin_amdgcn_cvt_pk_fp8_f32(x[6], x[7], p1, true);
              u32x2 w; w.x = (unsigned)p0; w.y = (unsigned)p1; *(u32x2*)(dst + (size_t)(n0 + n) * K + k0 + k8) = w; }
            __syncthreads();
        }
    }
}
__device__ __forceinline__ void cvt_plain(const Ctx& C, const float* src, bf16_t* dst, size_t n8) {
    for (size_t i = (size_t)C.bid * NTHREADS + C.tid; i < n8; i += (size_t)C.G * NTHREADS) {
        const f32x4 a = *(const f32x4*)(src + i * 8), b = *(const f32x4*)(src + i * 8 + 4);
        u32x4 w; w.x = cvt_pk_bf16(a[0], a[1]); w.y = cvt_pk_bf16(a[2], a[3]); w.z = cvt_pk_bf16(b[0], b[1]); w.w = cvt_pk_bf16(b[2], b[3]);
        *(u32x4*)(dst + i * 8) = w;
    }
}
__device__ __forceinline__ void phase_cvt_mixer_weights(const Ctx& C, int l) {
    int item = 0;
    transpose_cvt_fp8(C, INP(I_WIN) + (size_t)l * DM * IN_COLS, DM, IN_COLS, C.ws + WS_WIN, NP, WSP(float, WS_WINS));
    __syncthreads();
    transpose_cvt(C, INP(I_WUQ) + (size_t)l * 512 * 1536, 512, 1536, WSP(bf16_t, WS_WUQ), 1536, item);
    transpose_cvt(C, INP(I_WUKV) + (size_t)l * 512 * 2048, 512, 2048, WSP(bf16_t, WS_WUKV), 2048, item);
    transpose_cvt_fp8(C, INP(I_WBRA) + (size_t)l * 1024 * 2048, 1024, 2048, C.ws + WS_WBR, 2048, WSP(float, WS_WBRS), 1.0f / 32.0f); __syncthreads();
    transpose_cvt_fp8(C, INP(I_WBRL) + (size_t)l * 1024 * 2048, 1024, 2048, C.ws + WS_WBR + (size_t)2048 * 1024, 2048, WSP(float, WS_WBRS) + DM, 1.0f); __syncthreads();
    transpose_cvt_fp8(C, INP(I_WBRM) + (size_t)l * 1024 * 2048, 1024, 2048, C.ws + WS_WBR + (size_t)2 * 2048 * 1024, 2048, WSP(float, WS_WBRS) + 2 * DM, 1.0f / 32.0f); __syncthreads();
    transpose_cvt_fp8(C, INP(I_WOUT) + (size_t)l * 2048 * 2048, 2048, 2048, C.ws + WS_WOUT, 2048, WSP(float, WS_WOUTS));
    __syncthreads();
    transpose_cvt(C, INP(I_PWQ) + (size_t)l * 2048 * 2048, 2048, 2048, WSP(bf16_t, WS_WQ), 2048, item);
    cvt_plain(C, INP(I_PK1) + (size_t)l * 8 * 128 * 128, WSP(bf16_t, WS_K1), 8 * 128 * 128 / 8);
    cvt_plain(C, INP(I_PK2) + (size_t)l * 8 * 128 * 128, WSP(bf16_t, WS_K2), 8 * 128 * 128 / 8);
}
__device__ __forceinline__ void phase_cvt_peer_tables(const Ctx& C, int l, int row_lo, int row_hi, int wg_lo) {
    const int lane = C.lane; if (C.bid < wg_lo) return;
    unsigned char* pt = C.ws + WS_PT + (size_t)l * PT_BYTES;
    for (int row = row_lo + (C.bid - wg_lo) * 8 + C.wid; row < row_hi; row += (C.G - wg_lo) * 8) {
#pragma unroll 1
        for (int tb = 0; tb < 2; ++tb) {
            const float* src = (tb ? INP(I_PV) : INP(I_PU)) + ((size_t)l * NEXP + row) * DM + lane * 16;
            f32x4 x[8]; float amax = 0.f;
#pragma unroll
            for (int c = 0; c < 2; ++c)
#pragma unroll
                for (int q = 0; q < 4; ++q) { x[c * 4 + q] = *(const f32x4*)(src + c * 1024 + q * 4);
                    amax = fmaxf(amax, fmaxf(fmaxf(fabsf(x[c * 4 + q][0]), fabsf(x[c * 4 + q][1])), fmaxf(fabsf(x[c * 4 + q][2]), fabsf(x[c * 4 + q][3])))); }
            amax = fmaxf(amax, xchg32(amax, lane)); amax = fmaxf(amax, xchg16(amax, lane)); amax = fmaxf(amax, dppmov<DPP_ROR8>(amax));
            amax = fmaxf(amax, dppmov<DPP_HMIRROR>(amax)); amax = fmaxf(amax, dppmov<DPP_Q3210>(amax)); amax = fmaxf(amax, dppmov<DPP_Q1032>(amax));
            const float sc = amax > 0.f ? 224.0f / amax : 1.0f, inv = amax > 0.f ? amax * (1.0f / 224.0f) : 1.0f;
            unsigned char* dst = pt + (tb ? PT_V8 : PT_U8) + (size_t)(lane >> 3) * ((size_t)NEXP * 128) + (size_t)row * 128 + (lane & 7) * 16;
#pragma unroll
            for (int c = 0; c < 2; ++c) { u32x4 w;
#pragma unroll
                for (int q = 0; q < 4; ++q) { const f32x4 v = x[c * 4 + q] * sc; int p = __builtin_amdgcn_cvt_pk_fp8_f32(v[0], v[1], 0, false); p = __builtin_amdgcn_cvt_pk_fp8_f32(v[2], v[3], p, true); w[q] = (unsigned)p; }
                *(u32x4*)(dst + (size_t)c * 8 * ((size_t)NEXP * 128)) = w; }
            if (lane == 0) ((float*)(pt + (tb ? PT_SCV : PT_SCU)))[row] = inv;
        }
    }
}

template <bool FIRST, bool F8OUT = false> __device__ __forceinline__ void phase_norm_mod(const Ctx& C, const float* gvec, const float* modl  , int shift_off, int scale_off) {
    float* xs = WSP(float, WS_XS); bf16_t* hb = WSP(bf16_t, WS_HB);
    for (int r = C.bid * 8 + C.wid; r < TT; r += C.G * 8) {
        const float* xr = FIRST ? src_row(C, r) : xs + (size_t)r * DM;
        const float* mv = modl + (size_t)mod_sel(r) * 12288;
        f32x4 v[8]; float ss = 0.f;
#pragma unroll
        for (int c = 0; c < 4; ++c) { v[2 * c] = *(const f32x4*)(xr + c * 512 + C.lane * 8); v[2 * c + 1] = *(const f32x4*)(xr + c * 512 + C.lane * 8 + 4); }
#pragma unroll
        for (int c = 0; c < 8; ++c) ss += v[c][0] * v[c][0] + v[c][1] * v[c][1] + v[c][2] * v[c][2] + v[c][3] * v[c][3];
        ss = wave_sum(ss);
        const float rs = rsqrtf(ss * (1.0f / DM) + NORM_EPS);
#pragma unroll
        for (int c = 0; c < 4; ++c) { const int col = c * 512 + C.lane * 8;
            if (FIRST) { *(f32x4*)(xs + (size_t)r * DM + col) = v[2 * c]; *(f32x4*)(xs + (size_t)r * DM + col + 4) = v[2 * c + 1]; }
            float o[8];
#pragma unroll
            for (int h = 0; h < 2; ++h) { const f32x4 g = *(const f32x4*)(gvec + col + 4 * h), s = *(const f32x4*)(mv + scale_off + col + 4 * h), t = *(const f32x4*)(mv + shift_off + col + 4 * h);
#pragma unroll
                for (int j = 0; j < 4; ++j) o[4 * h + j] = v[2 * c + h][j] * rs * g[j] * (1.0f + s[j]) + t[j]; }
            if constexpr (F8OUT) {
                int p0 = __builtin_amdgcn_cvt_pk_fp8_f32(o[0], o[1], 0, false); p0 = __builtin_amdgcn_cvt_pk_fp8_f32(o[2], o[3], p0, true);
                int p1 = __builtin_amdgcn_cvt_pk_fp8_f32(o[4], o[5], 0, false); p1 = __builtin_amdgcn_cvt_pk_fp8_f32(o[6], o[7], p1, true);
                u32x2 w; w.x = (unsigned)p0; w.y = (unsigned)p1; *(u32x2*)((unsigned char*)hb + (size_t)r * DM + col) = w;
            } else {
            u32x4 w; w.x = cvt_pk_bf16(o[0], o[1]); w.y = cvt_pk_bf16(o[2], o[3]); w.z = cvt_pk_bf16(o[4], o[5]); w.w = cvt_pk_bf16(o[6], o[7]);
            *(u32x4*)(hb + (size_t)r * DM + col) = w; } }
    }
}

__device__ __forceinline__ void phase_post_p(const Ctx& C, int l) {
    bf16_t* P = WSP(bf16_t, WS_P); const float* ta = WSP(float, WS_TABA); const float* tm = WSP(float, WS_TABM);
    const float* qg = INP(I_QNG) + l * 128; const float* kg = INP(I_KNG) + l * 128;
    const float* mqg = INP(I_MQNG) + l * 512; const float* mkvg = INP(I_MKVNG) + l * 512;
    const int lane = C.lane;
    const float qg1 = qg[lane], qg2 = qg[lane + 64], kg1 = kg[lane], kg2 = kg[lane + 64];
    for (int r = C.bid * 8 + C.wid; r < TT; r += C.G * 8) {
        bf16_t* pr = P + (size_t)r * NP;
        const int j = r % RPB; const bool lat = j >= CTXL; const int pos = lat ? j - CTXL : 0, ri = pos >> 6, ci = pos & 63;
        float cs = 1.f, sn = 0.f;
        if (lat) { const int p = lane < 32 ? ri : ci, f = lane & 31; cs = ta[p * 32 + f]; sn = ta[128 * 32 + p * 32 + f]; }
#pragma unroll
        for (int h = 0; h < 10; ++h) {
            bf16_t* hp = pr + (h < 8 ? C_AQ + h * 128 : C_AK + (h - 8) * 128);
            const float x1 = bf2f(hp[lane]), x2 = bf2f(hp[lane + 64]);
            const float ss = wave_sum(x1 * x1 + x2 * x2);
            const float rs = rsqrtf(ss * (1.0f / 128.0f) + NORM_EPS);
            const float y1 = x1 * rs * (h < 8 ? qg1 : kg1), y2 = x2 * rs * (h < 8 ? qg2 : kg2);
            const float z1 = y1 * cs - y2 * sn, z2 = y2 * cs + y1 * sn;
            hp[lane] = f2bf(z1); hp[lane + 64] = f2bf(z2);
            if (h >= 8) { unsigned char* k8 = C.ws + WS_AK8 + (size_t)r * 256 + (h - 8) * 128;
                k8[lane] = (unsigned char)(__builtin_amdgcn_cvt_pk_fp8_f32(z1, 0.f, 0, false) & 0xff); k8[lane + 64] = (unsigned char)(__builtin_amdgcn_cvt_pk_fp8_f32(z2, 0.f, 0, false) & 0xff); }
        }
#pragma unroll
        for (int s = 0; s < 2; ++s) {
            bf16_t* sp = pr + (s == 0 ? C_MCQ : C_MCKV) + lane * 8; const float* gg = (s == 0 ? mqg : mkvg) + lane * 8;
            const u32x4 w = *(const u32x4*)sp; float x[8] = {bflo(w.x), bfhi(w.x), bflo(w.y), bfhi(w.y), bflo(w.z), bfhi(w.z), bflo(w.w), bfhi(w.w)};
            float ss = 0.f;
#pragma unroll
            for (int i = 0; i < 8; ++i) ss += x[i] * x[i];
            ss = wave_sum(ss);
            const float rs = rsqrtf(ss * (1.0f / 512.0f) + NORM_EPS);
#pragma unroll
            for (int i = 0; i < 8; ++i) x[i] = x[i] * rs * gg[i];
            u32x4 o; o.x = cvt_pk_bf16(x[0], x[1]); o.y = cvt_pk_bf16(x[2], x[3]); o.z = cvt_pk_bf16(x[4], x[5]); o.w = cvt_pk_bf16(x[6], x[7]);
            *(u32x4*)sp = o;
        }
        { bf16_t* kp = pr + C_MKR; const int i = lane & 31; const float x1 = bf2f(kp[i]), x2 = bf2f(kp[i + 32]);
          float c2 = 1.f, s2 = 0.f; if (lat) { const int p = i < 16 ? ri : ci, f = i & 15; c2 = tm[p * 16 + f]; s2 = tm[128 * 16 + p * 16 + f]; }
          const float z1 = x1 * c2 - x2 * s2, z2 = x2 * c2 + x1 * s2;
          if (lane < 32) { if (lat) { kp[i] = f2bf(z1); kp[i + 32] = f2bf(z2); }
              unsigned char* k8 = C.ws + WS_KR8 + (size_t)r * 64; k8[i] = (unsigned char)(__builtin_amdgcn_cvt_pk_fp8_f32(z1, 0.f, 0, false) & 0xff); k8[i + 32] = (unsigned char)(__builtin_amdgcn_cvt_pk_fp8_f32(z2, 0.f, 0, false) & 0xff); } }
    }
}

typedef int i32x8 __attribute__((ext_vector_type(8)));
typedef int i32x4 __attribute__((ext_vector_type(4)));
namespace att {
constexpr int NW = 8, QBLK = 32, KVBLK = 64, DV = 128;
constexpr float THR = 8.f;
#define SBAR() __builtin_amdgcn_sched_barrier(0)
__device__ __forceinline__ int crow(int r, int hi) { return (r & 3) + 8 * (r >> 2) + 4 * hi; }
template <int DQ> struct Cf {
    static constexpr int ND0 = DQ / 16, KROWB = DQ * 2, SHM_K = KVBLK * DQ * 2, SHM_V = KVBLK * DV * 2, SHM = 2 * SHM_V + 2 * SHM_K + NW * 64 * 4;
    static constexpr float SCALE = DQ == 128 ? 0.088388347648318440f : 0.072168783648703220f;
    __device__ static __forceinline__ int kswz(int row, int colB) { return row * KROWB + (colB ^ ((row & 7) << 4)); }
};
template <int DQ, int VAR = 0> __device__ __forceinline__ void partialSM(f32x16& p0, f32x16& p1, float& m_reg, float& mn, float& alpha, const float thr = THR, const float eoff = 0.f) {
    constexpr float SC = Cf<DQ>::SCALE, Cc = SC * 1.4426950408889634f;
    float pmax = p0[0];
#pragma unroll
    for (int r = 1; r < 16; ++r) pmax = fmaxf(pmax, p0[r]);
#pragma unroll
    for (int r = 0; r < 16; ++r) pmax = fmaxf(pmax, p1[r]);
    { auto rr = __builtin_amdgcn_permlane32_swap(__float_as_uint(pmax), __float_as_uint(pmax), false, false);
      pmax = fmaxf(__uint_as_float(rr[0]), __uint_as_float(rr[1])); }
    if (__builtin_expect(__all(pmax - m_reg <= thr / SC), 1)) { mn = m_reg; alpha = 1.f; }
    else { mn = fmaxf(m_reg, pmax); alpha = __builtin_amdgcn_exp2f((m_reg - mn) * Cc); m_reg = mn; }
    const float mnC = eoff - mn * Cc;
#pragma unroll
    for (int r = 0; r < 16; ++r) p0[r] = fmaf(p0[r], Cc, mnC);
#pragma unroll
    for (int r = 0; r < 16; ++r) p1[r] = fmaf(p1[r], Cc, mnC);
#pragma unroll
    for (int r = 0; r < 16; ++r) p0[r] = VAR == 1 ? p0[r] * 0.001f : __builtin_amdgcn_exp2f(p0[r]);
}
template <int VAR = 0> __device__ __forceinline__ void finishSM(f32x16& p0, f32x16& p1, float alpha, float& l_reg, bf16x8& pa0, bf16x8& pa1, bf16x8& pa2, bf16x8& pa3) {
#pragma unroll
    for (int r = 0; r < 16; ++r) p1[r] = VAR == 1 ? p1[r] * 0.001f : __builtin_amdgcn_exp2f(p1[r]);
    float ps = 0;
#pragma unroll
    for (int r = 0; r < 16; ++r) ps += p0[r];
#pragma unroll
    for (int r = 0; r < 16; ++r) ps += p1[r];
    { auto rr = __builtin_amdgcn_permlane32_swap(__float_as_uint(ps), __float_as_uint(ps), false, false);
      ps = __uint_as_float(rr[0]) + __uint_as_float(rr[1]); }
    l_reg = l_reg * alpha + ps;
#define PK4(P, BASE, OUT) do { unsigned a0 = cvt_pk_bf16(P[BASE + 0], P[BASE + 1]), a1 = cvt_pk_bf16(P[BASE + 2], P[BASE + 3]);   \
    unsigned b0 = cvt_pk_bf16(P[BASE + 4], P[BASE + 5]), b1 = cvt_pk_bf16(P[BASE + 6], P[BASE + 7]);                              \
    auto r0 = __builtin_amdgcn_permlane32_swap(a0, b0, false, false); auto r1 = __builtin_amdgcn_permlane32_swap(a1, b1, false, false); \
    u32x4 w = {r0[0], r1[0], r0[1], r1[1]}; OUT = *reinterpret_cast<bf16x8*>(&w); } while (0)
    PK4(p0, 0, pa0); PK4(p0, 8, pa1); PK4(p1, 0, pa2); PK4(p1, 8, pa3);
#undef PK4
}
template <int DQ> __device__ __forceinline__ void qkt(f32x16& p0, f32x16& p1, const char* Ks, const bf16x8* qr, const char* qx, int r32, int hi) {
    p0 = f32x16{}; p1 = f32x16{};
#pragma unroll
    for (int d0 = 0; d0 < Cf<DQ>::ND0; ++d0) { const int cb = (d0 * 16 + hi * 8) * 2;
        const bf16x8 b0 = *reinterpret_cast<const bf16x8*>(Ks + Cf<DQ>::kswz(r32, cb));
        const bf16x8 b1 = *reinterpret_cast<const bf16x8*>(Ks + Cf<DQ>::kswz(32 + r32, cb));
        constexpr int NQR = DQ == 192 ? MLA_NQR : 8;
        bf16x8 q; if (d0 < NQR) q = qr[d0]; else q = *reinterpret_cast<const bf16x8*>(qx + (d0 - NQR) * 1024);
        p0 = __builtin_amdgcn_mfma_f32_32x32x16_bf16(b0, q, p0, 0, 0, 0);
        p1 = __builtin_amdgcn_mfma_f32_32x32x16_bf16(b1, q, p1, 0, 0, 0); }
}
__device__ __forceinline__ int v_st(int k, int c) { const int kk = (k & ~0xC) | ((k & 4) << 1) | ((k & 8) >> 1); return ((kk >> 3) * 4 + (c >> 5)) * 512 + ((kk & 7) * 32 + (c & 31)) * 2; }
__device__ __forceinline__ int v_rd_base(int lane) { return ((lane & 3) << 3) | (((lane >> 2) & 3) << 6) | (((lane >> 4) & 1) << 5) | (((lane >> 5) & 1) << 8); }
constexpr int v_rd_off(int d0, int ks, int half) { return d0 * 512 + ks * 4096 + half * 2048; }
template <int OFF> __device__ __forceinline__ s16x4 tr_read(int vb) {
    s16x4 r; asm volatile("ds_read_b64_tr_b16 %0, %1 offset:%2" : "=&v"(r) : "v"(vb), "i"(OFF) : "memory"); return r;
}
template <int D0> __device__ __forceinline__ void pv_one(f32x16& od, int vb, bf16x8 pa0, bf16x8 pa1, bf16x8 pa2, bf16x8 pa3) {
    const s16x4 l0 = tr_read<v_rd_off(D0, 0, 0)>(vb), h0 = tr_read<v_rd_off(D0, 0, 1)>(vb), l1 = tr_read<v_rd_off(D0, 1, 0)>(vb), h1 = tr_read<v_rd_off(D0, 1, 1)>(vb);
    const s16x4 l2 = tr_read<v_rd_off(D0, 2, 0)>(vb), h2 = tr_read<v_rd_off(D0, 2, 1)>(vb), l3 = tr_read<v_rd_off(D0, 3, 0)>(vb), h3 = tr_read<v_rd_off(D0, 3, 1)>(vb);
    asm volatile("s_waitcnt lgkmcnt(0)" ::: "memory"); SBAR();
#define PK(L, H) (bf16x8){L[0], L[1], L[2], L[3], H[0], H[1], H[2], H[3]}
    od = __builtin_amdgcn_mfma_f32_32x32x16_bf16(pa0, PK(l0, h0), od, 0, 0, 0);
    od = __builtin_amdgcn_mfma_f32_32x32x16_bf16(pa1, PK(l1, h1), od, 0, 0, 0);
    od = __builtin_amdgcn_mfma_f32_32x32x16_bf16(pa2, PK(l2, h2), od, 0, 0, 0);
    od = __builtin_amdgcn_mfma_f32_32x32x16_bf16(pa3, PK(l3, h3), od, 0, 0, 0);
#undef PK
}
__device__ __forceinline__ void pv_d0(f32x16* o, int vb, bf16x8 pa0, bf16x8 pa1, bf16x8 pa2, bf16x8 pa3) {
    pv_one<0>(o[0], vb, pa0, pa1, pa2, pa3); pv_one<1>(o[1], vb, pa0, pa1, pa2, pa3); pv_one<2>(o[2], vb, pa0, pa1, pa2, pa3); pv_one<3>(o[3], vb, pa0, pa1, pa2, pa3);
}
__device__ __forceinline__ bf16x8 ld8(const bf16_t* p) { return *reinterpret_cast<const bf16x8*>(p); }

template <int DQ, int SD, int VAR = 0>
__device__ __forceinline__ void attn_body(const bf16_t* __restrict__ Qb, int ldq, const bf16_t* __restrict__ Kn, int ldkn, const bf16_t* __restrict__ Kr, int ldkr,
                                          const bf16_t* __restrict__ Vh, int ldv, unsigned char* __restrict__ Ob, int ldo, int seq, bool rope_q, int pos0, const float* __restrict__ tabM, char* lds, const int tid) {
    using CF = Cf<DQ>; constexpr int ND0 = CF::ND0, SHM_V = CF::SHM_V, SHM_K = CF::SHM_K;
    const int wid = tid >> 6, lane = tid & 63, r32 = lane & 31, hi = lane >> 5;
    char* V_lds = lds; char* K_lds = lds + 2 * SHM_V;
    float* ws = (float*)(lds + 2 * SHM_V + 2 * SHM_K) + wid * 64; float* li_l = ws; float* al_l = ws + 32;
    constexpr int NQR = DQ == 192 ? MLA_NQR : 8;
    float m_reg = -1e30f, l_reg = 0; f32x16 o[4] = {}; bf16x8 qr[NQR];
    const bf16_t* Qw = Qb + (long)(wid * QBLK + r32) * ldq + hi * 8;
#pragma unroll
    for (int d0 = 0; d0 < NQR; ++d0) qr[d0] = ld8(Qw + d0 * 16);
    char* qx = lds + CF::SHM + wid * 8192 + lane * 16;
    if constexpr (DQ == 192) {
#pragma unroll
        for (int d0 = NQR; d0 < 8; ++d0) *(bf16x8*)(qx + (d0 - NQR) * 1024) = ld8(Qw + d0 * 16);
        bf16x8 qe[4];
#pragma unroll
        for (int d0 = 0; d0 < 4; ++d0) qe[d0] = ld8(Qw + (8 + d0) * 16);
        if (rope_q) {
            const int pos = pos0 + wid * QBLK + r32, ri = pos >> 6, ci = pos & 63;
#pragma unroll
            for (int t = 0; t < 2; ++t) { const int p = t == 0 ? ri : ci; const float* tc = tabM + p * 16 + hi * 8; const float* tsn = tabM + 128 * 16 + p * 16 + hi * 8;
                bf16x8 a = qe[t], b = qe[2 + t];
#pragma unroll
                for (int jj = 0; jj < 8; ++jj) { const float x1 = bf2f((bf16_t)a[jj]), x2 = bf2f((bf16_t)b[jj]), c = tc[jj], s = tsn[jj];
                    a[jj] = (short)f2bf(x1 * c - x2 * s); b[jj] = (short)f2bf(x2 * c + x1 * s); }
                qe[t] = a; qe[2 + t] = b; }
        }
#pragma unroll
        for (int d0 = 0; d0 < 4; ++d0) *(bf16x8*)(qx + (8 - NQR + d0) * 1024) = qe[d0];
    }
    const int sr = tid >> 4, sc = (tid & 15) * 8, vst0 = v_st(sr, sc), vst1 = v_st(32 + sr, sc);
    const int sr2 = tid >> 3, sc2 = (tid & 7) * 8;
    const int vb0 = (int)(uintptr_t)V_lds + v_rd_base(lane);
    struct { bf16x8 vs0, vs1, ks0, ks1, ks2; } sr_[SD];
    const unsigned offV = (unsigned)(sr * ldv + sc) * 2u, offK = (unsigned)(sr * ldkn + sc) * 2u, offR = (unsigned)(sr2 * ldkr + sc2) * 2u;
#define SLOAD(i, k0) do { const char* vt_ = (const char*)Vh + (size_t)(k0) * ldv * 2; const char* kt_ = (const char*)Kn + (size_t)(k0) * ldkn * 2; \
    sr_[i].vs0 = *(const bf16x8*)(vt_ + offV); sr_[i].vs1 = *(const bf16x8*)(vt_ + (size_t)32 * ldv * 2 + offV); \
    sr_[i].ks0 = *(const bf16x8*)(kt_ + offK); sr_[i].ks1 = *(const bf16x8*)(kt_ + (size_t)32 * ldkn * 2 + offK); \
    if constexpr (DQ == 192) sr_[i].ks2 = *(const bf16x8*)((const char*)Kr + (size_t)(k0) * ldkr * 2 + offR); } while (0)
#define SWRITE(b, i) do { *(bf16x8*)(V_lds + (b) * SHM_V + vst0) = sr_[i].vs0; *(bf16x8*)(V_lds + (b) * SHM_V + vst1) = sr_[i].vs1; const int kc = sc * 2; \
    *(bf16x8*)(K_lds + (b) * SHM_K + CF::kswz(sr, kc)) = sr_[i].ks0; *(bf16x8*)(K_lds + (b) * SHM_K + CF::kswz(32 + sr, kc)) = sr_[i].ks1; \
    if constexpr (DQ == 192) *(bf16x8*)(K_lds + (b) * SHM_K + CF::kswz(sr2, 256 + sc2 * 2)) = sr_[i].ks2; } while (0)
#define SWAIT() do { if constexpr (SD == 1) asm volatile("s_waitcnt vmcnt(0)" ::: "memory"); else if constexpr (DQ == 192) asm volatile("s_waitcnt vmcnt(5)" ::: "memory"); else asm volatile("s_waitcnt vmcnt(4)" ::: "memory"); } while (0)
#define RESC(a) do { if (__any((a) < 1.f)) { if (hi == 0) al_l[r32] = (a); asm volatile("s_waitcnt lgkmcnt(0)" ::: "memory"); \
    _Pragma("unroll") for (int d = 0; d < 4; ++d) _Pragma("unroll") for (int r = 0; r < 16; ++r) o[d][r] *= al_l[crow(r, hi)]; } } while (0)
    f32x16 pA0, pA1, pB0, pB1; float mnA, mnB, alA, alB; bf16x8 pa0, pa1, pa2, pa3; const int NT = seq / KVBLK;
    constexpr int SE = 0, SO = SD - 1;
    SLOAD(SE, 0); asm volatile("s_waitcnt vmcnt(0)" ::: "memory"); SWRITE(0, SE); __syncthreads();
    qkt<DQ>(pA0, pA1, K_lds, qr, qx, r32, hi); partialSM<DQ, VAR>(pA0, pA1, m_reg, mnA, alA);
    SLOAD(SO, KVBLK); if constexpr (SD == 2) { if (2 < NT) SLOAD(SE, 2 * KVBLK); }
    SWAIT(); SWRITE(1, SO); __syncthreads();
#define ATT_SYNC() do { if constexpr (VAR != 2) __syncthreads(); } while (0)
    for (int j = 1; j + 1 < NT; j += 2) {
        SBAR(); qkt<DQ>(pB0, pB1, K_lds + SHM_K, qr, qx, r32, hi);
        finishSM<VAR>(pA0, pA1, alA, l_reg, pa0, pa1, pa2, pa3); SBAR();
        if constexpr (VAR != 3) SLOAD(SO, (j + SD) * KVBLK); SBAR();
        pv_d0(o, vb0, pa0, pa1, pa2, pa3); partialSM<DQ, VAR>(pB0, pB1, m_reg, mnB, alB);
        ATT_SYNC(); SWAIT(); SWRITE(0, SE);
        RESC(alB); ATT_SYNC();
        SBAR(); qkt<DQ>(pA0, pA1, K_lds, qr, qx, r32, hi);
        finishSM<VAR>(pB0, pB1, alB, l_reg, pa0, pa1, pa2, pa3); SBAR();
        if constexpr (VAR != 3) { if (SD == 1 || j + 3 < NT) SLOAD(SE, (j + 1 + SD) * KVBLK); } SBAR();
        pv_d0(o, vb0 + SHM_V, pa0, pa1, pa2, pa3); partialSM<DQ, VAR>(pA0, pA1, m_reg, mnA, alA);
        ATT_SYNC(); SWAIT(); SWRITE(1, SO);
        RESC(alA); ATT_SYNC();
    }
    SBAR(); qkt<DQ>(pB0, pB1, K_lds + SHM_K, qr, qx, r32, hi);
    finishSM<VAR>(pA0, pA1, alA, l_reg, pa0, pa1, pa2, pa3); SBAR();
    pv_d0(o, vb0, pa0, pa1, pa2, pa3); partialSM<DQ, VAR>(pB0, pB1, m_reg, mnB, alB);
    ATT_SYNC(); RESC(alB);
    finishSM<VAR>(pB0, pB1, alB, l_reg, pa0, pa1, pa2, pa3); SBAR();
    pv_d0(o, vb0 + SHM_V, pa0, pa1, pa2, pa3);
    if (hi == 0) li_l[r32] = l_reg; asm volatile("s_waitcnt lgkmcnt(0)" ::: "memory");
    float rli[16];
#pragma unroll
    for (int r = 0; r < 16; ++r) rli[r] = __builtin_amdgcn_rcpf(li_l[crow(r, hi)]);
    unsigned char* Ow = Ob + (long)(wid * QBLK) * ldo;
#pragma unroll
    for (int r = 0; r < 16; ++r) { const int orow = crow(r, hi);
#pragma unroll
        for (int d0 = 0; d0 < 4; ++d0) Ow[(long)orow * ldo + d0 * 32 + r32] = (unsigned char)(__builtin_amdgcn_cvt_pk_fp8_f32(o[d0][r] * rli[r] * 32.0f, 0.f, 0, false) & 0xff); }
#undef SLOAD
#undef ATT_SYNC
#undef SWRITE
#undef SWAIT
#undef RESC
}

__device__ __forceinline__ int k8addr(int row, int b, int DQ_) { return row * DQ_ + (b < 128 ? (b ^ ((row & 7) << 4)) : 128 + ((b - 128) ^ ((row & 3) << 4))); }
#define MX32(ACC, A, B, SC) asm volatile("s_nop 1\n\tv_mfma_scale_f32_32x32x64_f8f6f4 %0, %1, %2, %0, %3, %3 op_sel_hi:[0,0,0]" : "+v"(ACC) : "v"(A), "v"(B), "v"(SC))
#define MX32Z(ACC, A, B, SC) asm volatile("v_mfma_scale_f32_32x32x64_f8f6f4 %0, %1, %2, 0, %3, %3 op_sel_hi:[0,0,0]" : "=&v"(ACC) : "v"(A), "v"(B), "v"(SC))
template <int DQ, bool NOPS = true> __device__ __forceinline__ void qkt8(f32x16& p0, f32x16& p1, const char* Ks, const i32x8* qf, int r32, int hi) {
    int mxs = 0x7f7f7f7f; asm volatile("" : "+v"(mxs));
#pragma unroll
    for (int ks = 0; ks < DQ / 64; ++ks) { const int b = ks * 64 + hi * 32;
        const i32x4 a0l = *reinterpret_cast<const i32x4*>(Ks + k8addr(r32, b, DQ)), a0h = *reinterpret_cast<const i32x4*>(Ks + k8addr(r32, b + 16, DQ));
        const i32x4 a1l = *reinterpret_cast<const i32x4*>(Ks + k8addr(32 + r32, b, DQ)), a1h = *reinterpret_cast<const i32x4*>(Ks + k8addr(32 + r32, b + 16, DQ));
        const i32x8 a0 = __builtin_shufflevector(a0l, a0h, 0, 1, 2, 3, 4, 5, 6, 7), a1 = __builtin_shufflevector(a1l, a1h, 0, 1, 2, 3, 4, 5, 6, 7);
        if (ks == 0) { MX32Z(p0, a0, qf[ks], mxs); MX32Z(p1, a1, qf[ks], mxs); } else { MX32(p0, a0, qf[ks], mxs); MX32(p1, a1, qf[ks], mxs); } }
    if (NOPS) asm volatile("s_nop 15\n\ts_nop 7");
}
__device__ __forceinline__ int pk4_fp8(float a, float b, float c, float d) { int p = __builtin_amdgcn_cvt_pk_fp8_f32(a, b, 0, false); return __builtin_amdgcn_cvt_pk_fp8_f32(c, d, p, true); }
__device__ __forceinline__ int pk4_fp8u(float a, float b, float c, float d) { int u; asm volatile("" : "=v"(u)); const int p = __builtin_amdgcn_cvt_pk_fp8_f32(a, b, u, false); return __builtin_amdgcn_cvt_pk_fp8_f32(c, d, p, true); }
template <int DQ>
__device__ __forceinline__ void attn_body8(const bf16_t* __restrict__ Qb, int ldq, const unsigned char* __restrict__ Kn8, int ldkn, const unsigned char* __restrict__ Kr8, int ldkr,
                                           const bf16_t* __restrict__ Vh, int ldv, unsigned char* __restrict__ Ob, int ldo, int seq, bool rope_q, int pos0, const float* __restrict__ tabM, char* lds, const int tid) {
    constexpr int NKS = DQ / 64, SHM_V = KVBLK * DV * 2, SHM_K = KVBLK * DQ;
    const int wid = tid >> 6, lane = tid & 63, r32 = lane & 31, hi = lane >> 5;
    char* V_lds = lds; char* K_lds = lds + 2 * SHM_V;
    float* ws = (float*)(lds + 2 * SHM_V + 2 * SHM_K) + wid * 64; float* li_l = ws; float* al_l = ws + 32;
    float m_reg = -1e30f, l_reg = 0; f32x16 o[4] = {}; i32x8 qf[NKS];
    const bf16_t* Qrow = Qb + (long)(wid * QBLK + r32) * ldq;
#pragma unroll
    for (int ks = 0; ks < NKS; ++ks) {
        float x[32];
#pragma unroll
        for (int c = 0; c < 4; ++c) { const u32x4 w = *(const u32x4*)(Qrow + ks * 64 + hi * 32 + c * 8);
            x[c * 8 + 0] = bflo(w.x); x[c * 8 + 1] = bfhi(w.x); x[c * 8 + 2] = bflo(w.y); x[c * 8 + 3] = bfhi(w.y); x[c * 8 + 4] = bflo(w.z); x[c * 8 + 5] = bfhi(w.z); x[c * 8 + 6] = bflo(w.w); x[c * 8 + 7] = bfhi(w.w); }
        if (DQ == 192 && ks == 2 && rope_q) {
            float y[32];
#pragma unroll
            for (int c = 0; c < 4; ++c) { const u32x4 w = *(const u32x4*)(Qrow + 128 + (1 - hi) * 32 + c * 8);
                y[c * 8 + 0] = bflo(w.x); y[c * 8 + 1] = bfhi(w.x); y[c * 8 + 2] = bflo(w.y); y[c * 8 + 3] = bfhi(w.y); y[c * 8 + 4] = bflo(w.z); y[c * 8 + 5] = bfhi(w.z); y[c * 8 + 6] = bflo(w.w); y[c * 8 + 7] = bfhi(w.w); }
            const int pos = pos0 + wid * QBLK + r32, ri = pos >> 6, ci = pos & 63;
#pragma unroll
            for (int i = 0; i < 32; ++i) { const int p = i < 16 ? ri : ci, f = i & 15; const float c_ = tabM[p * 16 + f], s_ = tabM[128 * 16 + p * 16 + f];
                x[i] = hi ? x[i] * c_ + y[i] * s_ : x[i] * c_ - y[i] * s_; }
        }
        i32x8 q8;
#pragma unroll
        for (int j = 0; j < 8; ++j) q8[j] = pk4_fp8(x[4 * j], x[4 * j + 1], x[4 * j + 2], x[4 * j + 3]);
        qf[ks] = q8;
    }
    const int sr = tid >> 4, sc = (tid & 15) * 8, vst0 = v_st(sr, sc), vst1 = v_st(32 + sr, sc);
    const int kr = tid >> 3, kb = (tid & 7) * 16;
    const int kr2 = (tid & 255) >> 2, kb2 = (tid & 3) * 16;
    const int vb0 = (int)(uintptr_t)V_lds + v_rd_base(lane);
    struct { bf16x8 vs0, vs1; u32x4 k0, k1; } sr_[1];
    const unsigned offV = (unsigned)(sr * ldv + sc) * 2u, offK = (unsigned)(kr * ldkn + kb), offR = (unsigned)(kr2 * ldkr + kb2);
#define SLOAD8(k0_) do { const char* vt_ = (const char*)Vh + (size_t)(k0_) * ldv * 2; \
    sr_[0].vs0 = *(const bf16x8*)(vt_ + offV); sr_[0].vs1 = *(const bf16x8*)(vt_ + (size_t)32 * ldv * 2 + offV); \
    sr_[0].k0 = *(const u32x4*)(Kn8 + (size_t)(k0_) * ldkn + offK); \
    if constexpr (DQ == 192) { if (tid < 256) sr_[0].k1 = *(const u32x4*)(Kr8 + (size_t)(k0_) * ldkr + offR); } } while (0)
#define SWRITE8(b) do { *(bf16x8*)(V_lds + (b) * SHM_V + vst0) = sr_[0].vs0; *(bf16x8*)(V_lds + (b) * SHM_V + vst1) = sr_[0].vs1; \
    *(u32x4*)(K_lds + (b) * SHM_K + k8addr(kr, kb, DQ)) = sr_[0].k0; \
    if constexpr (DQ == 192) { if (tid < 256) *(u32x4*)(K_lds + (b) * SHM_K + k8addr(kr2, 128 + kb2, DQ)) = sr_[0].k1; } } while (0)
#define SWAIT8() asm volatile("s_waitcnt vmcnt(0)" ::: "memory")
#define RESC8(a) do { if (__any((a) < 1.f)) { if (hi == 0) al_l[r32] = (a); asm volatile("s_waitcnt lgkmcnt(0)" ::: "memory"); \
    _Pragma("unroll") for (int d = 0; d < 4; ++d) _Pragma("unroll") for (int r = 0; r < 16; ++r) o[d][r] *= al_l[crow(r, hi)]; } } while (0)
    f32x16 pA0, pA1, pB0, pB1; float mnA, mnB, alA, alB; bf16x8 pa0, pa1, pa2, pa3; const int NT = seq / KVBLK;
    SLOAD8(0); SWAIT8(); SWRITE8(0); __syncthreads();
    qkt8<DQ>(pA0, pA1, K_lds, qf, r32, hi); partialSM<DQ, 0>(pA0, pA1, m_reg, mnA, alA);
    SLOAD8(KVBLK);
    SWAIT8(); SWRITE8(1); __syncthreads();
    for (int j = 1; j + 1 < NT; j += 2) {
        SBAR(); qkt8<DQ>(pB0, pB1, K_lds + SHM_K, qf, r32, hi);
        finishSM<0>(pA0, pA1, alA, l_reg, pa0, pa1, pa2, pa3); SBAR();
        SLOAD8((j + 1) * KVBLK); SBAR();
        pv_d0(o, vb0, pa0, pa1, pa2, pa3); partialSM<DQ, 0>(pB0, pB1, m_reg, mnB, alB);
        __syncthreads(); SWAIT8(); SWRITE8(0);
        RESC8(alB); __syncthreads();
        SBAR(); qkt8<DQ>(pA0, pA1, K_lds, qf, r32, hi);
        finishSM<0>(pB0, pB1, alB, l_reg, pa0, pa1, pa2, pa3); SBAR();
        SLOAD8((j + 2) * KVBLK); SBAR();
        pv_d0(o, vb0 + SHM_V, pa0, pa1, pa2, pa3); partialSM<DQ, 0>(pA0, pA1, m_reg, mnA, alA);
        __syncthreads(); SWAIT8(); SWRITE8(1);
        RESC8(alA); __syncthreads();
    }
    SBAR(); qkt8<DQ>(pB0, pB1, K_lds + SHM_K, qf, r32, hi);
    finishSM<0>(pA0, pA1, alA, l_reg, pa0, pa1, pa2, pa3); SBAR();
    pv_d0(o, vb0, pa0, pa1, pa2, pa3); partialSM<DQ, 0>(pB0, pB1, m_reg, mnB, alB);
    __syncthreads(); RESC8(alB);
    finishSM<0>(pB0, pB1, alB, l_reg, pa0, pa1, pa2, pa3); SBAR();
    pv_d0(o, vb0 + SHM_V, pa0, pa1, pa2, pa3);
    if (hi == 0) li_l[r32] = l_reg; asm volatile("s_waitcnt lgkmcnt(0)" ::: "memory");
    float rli[16];
#pragma unroll
    for (int r = 0; r < 16; ++r) rli[r] = __builtin_amdgcn_rcpf(li_l[crow(r, hi)]);
    unsigned char* Ow = Ob + (long)(wid * QBLK) * ldo;
#pragma unroll
    for (int r = 0; r < 16; ++r) { const int orow = crow(r, hi);
#pragma unroll
        for (int d0 = 0; d0 < 4; ++d0) Ow[(long)orow * ldo + d0 * 32 + r32] = (unsigned char)(__builtin_amdgcn_cvt_pk_fp8_f32(o[d0][r] * rli[r] * 32.0f, 0.f, 0, false) & 0xff); }
#undef SLOAD8
#undef SWRITE8
#undef SWAIT8
#undef RESC8
}

__device__ __host__ __forceinline__ int vt8_key(int g, int j) { const int i = j & 15; return (j < 16 ? 0 : 32) + (i & 3) + 8 * (i >> 2) + 4 * g; }
template <int DQ>
__device__ __forceinline__ void attn_body88(const bf16_t* __restrict__ Qb, int ldq, const unsigned char* __restrict__ Kn8, int ldkn, const unsigned char* __restrict__ Kr8, int ldkr,
                                            const unsigned char* __restrict__ VT8, unsigned char* __restrict__ Ob, int ldo, int seq, bool rope_q, int pos0, const float* __restrict__ tabM, char* lds, const int tid) {
    constexpr int NKS = DQ / 64, SHM_V = 128 * 64, SHM_K = KVBLK * DQ;
    constexpr float EOFF = 7.0f, THR8 = 1.0f;
    const int wid = tid >> 6, lane = tid & 63, r32 = lane & 31, hi = lane >> 5;
    char* V_lds = lds; char* K_lds = lds + 2 * SHM_V;
    float* ws = (float*)(lds + 2 * SHM_V + 2 * SHM_K) + wid * 64; float* li_l = ws; float* al_l = ws + 32;
    float m_reg = -1e30f, l_reg = 0; f32x16 o[4] = {}; i32x8 qf[NKS];
    const bf16_t* Qrow = Qb + (long)(wid * QBLK + r32) * ldq;
#pragma unroll
    for (int ks = 0; ks < NKS; ++ks) {
        float x[32];
#pragma unroll
        for (int c = 0; c < 4; ++c) { const u32x4 w = *(const u32x4*)(Qrow + ks * 64 + hi * 32 + c * 8);
            x[c * 8 + 0] = bflo(w.x); x[c * 8 + 1] = bfhi(w.x); x[c * 8 + 2] = bflo(w.y); x[c * 8 + 3] = bfhi(w.y); x[c * 8 + 4] = bflo(w.z); x[c * 8 + 5] = bfhi(w.z); x[c * 8 + 6] = bflo(w.w); x[c * 8 + 7] = bfhi(w.w); }
        if (DQ == 192 && ks == 2 && rope_q) {
            float y[32];
#pragma unroll
            for (int c = 0; c < 4; ++c) { const u32x4 w = *(const u32x4*)(Qrow + 128 + (1 - hi) * 32 + c * 8);
                y[c * 8 + 0] = bflo(w.x); y[c * 8 + 1] = bfhi(w.x); y[c * 8 + 2] = bflo(w.y); y[c * 8 + 3] = bfhi(w.y); y[c * 8 + 4] = bflo(w.z); y[c * 8 + 5] = bfhi(w.z); y[c * 8 + 6] = bflo(w.w); y[c * 8 + 7] = bfhi(w.w); }
            const int pos = pos0 + wid * QBLK + r32, ri = pos >> 6, ci = pos & 63;
#pragma unroll
            for (int i = 0; i < 32; ++i) { const int p = i < 16 ? ri : ci, f = i & 15; const float c_ = tabM[p * 16 + f], s_ = tabM[128 * 16 + p * 16 + f];
                x[i] = hi ? x[i] * c_ + y[i] * s_ : x[i] * c_ - y[i] * s_; }
        }
        i32x8 q8;
#pragma unroll
        for (int j = 0; j < 8; ++j) q8[j] = pk4_fp8(x[4 * j], x[4 * j + 1], x[4 * j + 2], x[4 * j + 3]);
        qf[ks] = q8;
    }
    const int vr = tid >> 2, vc = tid & 3;
    const int vwr = vr * 64 + ((vc ^ ((vr >> 2) & 3)) << 4);
    const int kr = tid >> 3, kb = (tid & 7) * 16;
    const int kr2 = (tid & 255) >> 2, kb2 = (tid & 3) * 16;
    struct { u32x4 v, k0, k1; } sr_[1];
    const unsigned offK = (unsigned)(kr * ldkn + kb), offR = (unsigned)(kr2 * ldkr + kb2);
#define SLOAD8(k0_) do { sr_[0].v = *(const u32x4*)(VT8 + (size_t)((k0_) >> 6) * 8192 + tid * 16); \
    sr_[0].k0 = *(const u32x4*)(Kn8 + (size_t)(k0_) * ldkn + offK); \
    if constexpr (DQ == 192) { if (tid < 256) sr_[0].k1 = *(const u32x4*)(Kr8 + (size_t)(k0_) * ldkr + offR); } } while (0)
#define SWRITE8(b) do { *(u32x4*)(V_lds + (b) * SHM_V + vwr) = sr_[0].v; \
    *(u32x4*)(K_lds + (b) * SHM_K + k8addr(kr, kb, DQ)) = sr_[0].k0; \
    if constexpr (DQ == 192) { if (tid < 256) *(u32x4*)(K_lds + (b) * SHM_K + k8addr(kr2, 128 + kb2, DQ)) = sr_[0].k1; } } while (0)
#define SWAIT8() asm volatile("s_waitcnt vmcnt(0)" ::: "memory")
#define RESC8(a) do { if (__any((a) < 1.f)) { if (hi == 0) al_l[r32] = (a); asm volatile("s_waitcnt lgkmcnt(0)" ::: "memory"); \
    _Pragma("unroll") for (int d = 0; d < 4; ++d) _Pragma("unroll") for (int r = 0; r < 16; ++r) o[d][r] *= al_l[crow(r, hi)]; } } while (0)
#define FIN8(P0, P1, AL, PA) do { _Pragma("unroll") for (int r = 0; r < 16; ++r) P1[r] = __builtin_amdgcn_exp2f(P1[r]); \
    float ps_ = 0; _Pragma("unroll") for (int r = 0; r < 16; ++r) ps_ += P0[r]; _Pragma("unroll") for (int r = 0; r < 16; ++r) ps_ += P1[r]; \
    { auto rr_ = __builtin_amdgcn_permlane32_swap(__float_as_uint(ps_), __float_as_uint(ps_), false, false); ps_ = __uint_as_float(rr_[0]) + __uint_as_float(rr_[1]); } \
    l_reg = l_reg * (AL) + ps_; \
    _Pragma("unroll") for (int j = 0; j < 4; ++j) { PA[j] = pk4_fp8u(P0[4 * j], P0[4 * j + 1], P0[4 * j + 2], P0[4 * j + 3]); \
        PA[4 + j] = pk4_fp8u(P1[4 * j], P1[4 * j + 1], P1[4 * j + 2], P1[4 * j + 3]); } } while (0)
#define PV8(VB, PA, NOPS) do { int mxs_ = 0x7f7f7f7f; asm volatile("" : "+v"(mxs_)); _Pragma("unroll") for (int d0 = 0; d0 < 4; ++d0) { const int row_ = d0 * 32 + r32, xs_ = (row_ >> 2) & 3; \
        const i32x4 lo_ = *reinterpret_cast<const i32x4*>((VB) + row_ * 64 + (((2 * hi) ^ xs_) << 4)), hi_ = *reinterpret_cast<const i32x4*>((VB) + row_ * 64 + (((2 * hi + 1) ^ xs_) << 4)); \
        const i32x8 vb_ = __builtin_shufflevector(lo_, hi_, 0, 1, 2, 3, 4, 5, 6, 7); MX32(o[d0], PA, vb_, mxs_); } if (NOPS) asm volatile("s_nop 15\n\ts_nop 7"); } while (0)
    f32x16 pA0, pA1, pB0, pB1; float mnA, mnB, alA, alB; i32x8 pa; const int NT = seq / KVBLK;
    SLOAD8(0); SWAIT8(); SWRITE8(0); __syncthreads();
    qkt8<DQ>(pA0, pA1, K_lds, qf, r32, hi); partialSM<DQ, 0>(pA0, pA1, m_reg, mnA, alA, THR8, EOFF);
    SLOAD8(KVBLK);
    SWAIT8(); SWRITE8(1); __syncthreads();
    for (int j = 1; j + 1 < NT; j += 2) {
        SBAR(); qkt8<DQ, false>(pB0, pB1, K_lds + SHM_K, qf, r32, hi);
        FIN8(pA0, pA1, alA, pa); SBAR();
        SLOAD8((j + 1) * KVBLK); SBAR();
        PV8(V_lds, pa, 0); partialSM<DQ, 0>(pB0, pB1, m_reg, mnB, alB, THR8, EOFF);
        __syncthreads(); SWAIT8(); SWRITE8(0);
        RESC8(alB); __syncthreads();
        SBAR(); qkt8<DQ, false>(pA0, pA1, K_lds, qf, r32, hi);
        FIN8(pB0, pB1, alB, pa); SBAR();
        SLOAD8((j + 2) * KVBLK); SBAR();
        PV8(V_lds + SHM_V, pa, 0); partialSM<DQ, 0>(pA0, pA1, m_reg, mnA, alA, THR8, EOFF);
        __syncthreads(); SWAIT8(); SWRITE8(1);
        RESC8(alA); __syncthreads();
    }
    SBAR(); qkt8<DQ, false>(pB0, pB1, K_lds + SHM_K, qf, r32, hi);
    FIN8(pA0, pA1, alA, pa); SBAR();
    PV8(V_lds, pa, 0); partialSM<DQ, 0>(pB0, pB1, m_reg, mnB, alB, THR8, EOFF);
    __syncthreads(); RESC8(alB);
    FIN8(pB0, pB1, alB, pa); SBAR();
    PV8(V_lds + SHM_V, pa, 1);
    if (hi == 0) li_l[r32] = l_reg; asm volatile("s_waitcnt lgkmcnt(0)" ::: "memory");
    float rli[16];
#pragma unroll
    for (int r = 0; r < 16; ++r) rli[r] = __builtin_amdgcn_rcpf(li_l[crow(r, hi)]) * 32.0f;
    unsigned char* Ow = Ob + (long)(wid * QBLK) * ldo;
#pragma unroll
    for (int r = 0; r < 16; ++r) { const int orow = crow(r, hi);
#pragma unroll
        for (int d0 = 0; d0 < 4; ++d0) Ow[(long)orow * ldo + d0 * 32 + r32] = (unsigned char)(__builtin_amdgcn_cvt_pk_fp8_f32(o[d0][r] * rli[r], 0.f, 0, false) & 0xff); }
#undef SLOAD8
#undef SWRITE8
#undef SWAIT8
#undef RESC8
#undef FIN8
#undef PV8
}
#undef MX32
}

template <int KS> __device__ __forceinline__ void mma_xy(f32x16& acc, const LAS bf16_t* X, const LAS bf16_t* Y, int hi) {
#pragma unroll
    for (int ks = 0; ks < KS; ++ks) { const bf16x8 a = *(const LAS bf16x8*)(X + ks * 16 + hi * 8), b = *(const LAS bf16x8*)(Y + ks * 16 + hi * 8);
        acc = __builtin_amdgcn_mfma_f32_32x32x16_bf16(a, b, acc, 0, 0, 0); }
}
__device__ __forceinline__ float logsig16(float x) { const float e = __expf(-fabsf(x)); return (fminf(x, 0.f) - __logf(1.f + e)) * 0.0625f; }
__device__ __forceinline__ int gla_sidx(int b, int dir, int h) { return (b * 2 + dir) * 4 + h; }

__device__ __forceinline__ void gla_cumsum_lds(const Ctx& C, int l, int h, int dir, const LAS float* lr, LAS float* segtot, LAS float* CUM) {
    const int seg = C.tid >> 7, d = C.tid & 127;
    const float* wa = INP(dir ? I_WA2B : I_WA2F) + (size_t)l * 16 * 512 + h * 128 + d;
    const float bias = INP(dir ? I_BAB : I_BAF)[l * 512 + h * 128 + d];
    float w[16], cum[16];
#pragma unroll
    for (int j = 0; j < 16; ++j) w[j] = wa[j * 512];
    float run = 0.f;
#pragma unroll
    for (int i = 0; i < 16; ++i) { const int s = seg * 16 + i, tk = dir ? 63 - s : s; float pre = bias;
#pragma unroll
        for (int j = 0; j < 16; ++j) pre += lr[tk * 32 + dir * 16 + j] * w[j];
        run += logsig16(pre); cum[i] = run; }
    segtot[seg * 128 + d] = run;
    __syncthreads();
    float off = 0.f;
#pragma unroll
    for (int q = 0; q < 3; ++q) if (q < seg) off += segtot[q * 128 + d];
#pragma unroll
    for (int i = 0; i < 16; ++i) { const int s = seg * 16 + i, tk = dir ? 63 - s : s; CUM[tk * 132 + d] = cum[i] + off; }
    __syncthreads();
}
__device__ __forceinline__ void unpack8(const u32x4 w, float (&x)[8]) { x[0] = bflo(w.x); x[1] = bfhi(w.x); x[2] = bflo(w.y); x[3] = bfhi(w.y); x[4] = bflo(w.z); x[5] = bfhi(w.z); x[6] = bflo(w.w); x[7] = bfhi(w.w); }
__device__ __forceinline__ void gla_build_vt(const Ctx& C, const bf16_t* P, size_t r0, int h, LAS bf16_t* VT) {
    u32x4 v[4];
#pragma unroll
    for (int it = 0; it < 4; ++it) { const int idx = C.tid + it * NTHREADS, sv = idx >> 5, e0 = (idx & 31) * 8; v[it] = *(const u32x4*)(P + (r0 + sv) * NP + C_LV + h * 256 + e0); }
#pragma unroll
    for (int it = 0; it < 4; ++it) { const int idx = C.tid + it * NTHREADS, sv = idx >> 5, e0 = (idx & 31) * 8;
        const unsigned wd[4] = {v[it].x, v[it].y, v[it].z, v[it].w};
#pragma unroll
        for (int q = 0; q < 4; ++q) { VT[(e0 + 2 * q) * 72 + sv] = (bf16_t)(wd[q] & 0xffffu); VT[(e0 + 2 * q + 1) * 72 + sv] = (bf16_t)(wd[q] >> 16); } }
}

__device__ __forceinline__ void phase_gla_local(const Ctx& C, int l, int rot) {
    const bf16_t* P = WSP(bf16_t, WS_P); bf16_t* GST = WSP(bf16_t, WS_GST); float* GDEC = WSP(float, WS_GDEC);
    LAS float* lr = (LAS float*)C.lds;
    LAS float* segtot = (LAS float*)(C.lds + 8192);
    LAS bf16_t* KT = (LAS bf16_t*)(C.lds + 10240);
    LAS bf16_t* VT = (LAS bf16_t*)(C.lds + 28672);
    LAS float* CUM = (LAS float*)(C.lds + 65536);
    const int r32 = C.lane & 31, hi = C.lane >> 5, d = C.tid & 127;
    const int btk = C.tid >> 3, bdg = (C.tid & 7) * 16;
    for (int unit = (C.bid + C.G - rot % C.G) % C.G; unit < NBATCH * 4 * NCH; unit += C.G) {
        const int b = unit / (4 * NCH), h = (unit / NCH) % 4, ck = unit % NCH; const size_t r0 = (size_t)b * RPB + ck * 64;
        for (int i = C.tid; i < 64 * 32; i += NTHREADS) lr[i] = bf2f(P[(r0 + (i >> 5)) * NP + C_LRF + (i & 31)]);
        const u32x4 kw0 = *(const u32x4*)(P + (r0 + btk) * NP + C_LK + h * 128 + bdg), kw1 = *(const u32x4*)(P + (r0 + btk) * NP + C_LK + h * 128 + bdg + 8);
        gla_build_vt(C, P, r0, h, VT);
        __syncthreads();
#pragma unroll 1
        for (int dir = 0; dir < 2; ++dir) {
            gla_cumsum_lds(C, l, h, dir, lr, segtot, CUM);
            const int tend = dir ? 0 : 63;
            const size_t sx = (size_t)gla_sidx(b, dir, h) * NCH + ck;
            if (C.tid < 128) GDEC[sx * 128 + d] = __expf(CUM[tend * 132 + d]);
            { float kf[16]; { float t8[8]; unpack8(kw0, t8);
#pragma unroll
                for (int i = 0; i < 8; ++i) kf[i] = t8[i]; unpack8(kw1, t8);
#pragma unroll
                for (int i = 0; i < 8; ++i) kf[8 + i] = t8[i]; }
#pragma unroll
              for (int q = 0; q < 4; ++q) { const f32x4 cm = *(const LAS f32x4*)(CUM + btk * 132 + bdg + 4 * q), be = *(const LAS f32x4*)(CUM + tend * 132 + bdg + 4 * q);
#pragma unroll
                  for (int i = 0; i < 4; ++i) KT[(bdg + 4 * q + i) * 72 + btk] = f2bf(kf[4 * q + i] * __expf(be[i] - cm[i])); } }
            __syncthreads();
            { const int dt = C.wid & 3, eb = (C.wid >> 2) * 4;
              f32x16 acc[4] = {};
#pragma unroll
              for (int q = 0; q < 4; ++q) mma_xy<4>(acc[q], KT + (dt * 32 + r32) * 72, VT + ((eb + q) * 32 + r32) * 72, hi);
              bf16_t* st = GST + sx * 32768;
#pragma unroll
              for (int q = 0; q < 4; ++q)
#pragma unroll
                  for (int g = 0; g < 4; ++g) { u32x2 w; w.x = cvt_pk_bf16(acc[q][4 * g], acc[q][4 * g + 1]); w.y = cvt_pk_bf16(acc[q][4 * g + 2], acc[q][4 * g + 3]);
                      *(u32x2*)(st + (size_t)((eb + q) * 32 + r32) * 128 + dt * 32 + 8 * g + 4 * hi) = w; } }
            __syncthreads();
        }
    }
}

__device__ __forceinline__ void phase_gla_scan(const Ctx& C) {
    bf16_t* GST = WSP(bf16_t, WS_GST); const float* GDEC = WSP(float, WS_GDEC);
    for (int gid = C.bid * NTHREADS + C.tid; gid < 16 * 8192; gid += C.G * NTHREADS) {
        const int sidx = gid >> 13, g = gid & 8191, dir = (sidx >> 2) & 1, d4 = (g & 31) * 4;
        bf16_t* base = GST + (size_t)sidx * NCH * 32768 + (size_t)g * 4;
        const float* dbase = GDEC + (size_t)sidx * NCH * 128 + d4;
        float S[4] = {0.f, 0.f, 0.f, 0.f};
        for (int st = 0; st < NCH; st += 4) {
            int ck[4]; u32x2 L[4]; f32x4 dc[4];
#pragma unroll
            for (int q = 0; q < 4; ++q) { const int s = st + q; ck[q] = dir ? (s < 4 ? 3 - s : NCH + 3 - s) : s;
                L[q] = *(const u32x2*)(base + (size_t)ck[q] * 32768); dc[q] = *(const f32x4*)(dbase + (size_t)ck[q] * 128); }
#pragma unroll
            for (int q = 0; q < 4; ++q) { u32x2 w; w.x = cvt_pk_bf16(S[0], S[1]); w.y = cvt_pk_bf16(S[2], S[3]);
                *(u32x2*)(base + (size_t)ck[q] * 32768) = w;
                S[0] = dc[q][0] * S[0] + bflo(L[q].x); S[1] = dc[q][1] * S[1] + bfhi(L[q].x); S[2] = dc[q][2] * S[2] + bflo(L[q].y); S[3] = dc[q][3] * S[3] + bfhi(L[q].y); }
        }
    }
}

__device__ __forceinline__ void phase_gla_out(const Ctx& C, int l, int rot) {
    const bf16_t* P = WSP(bf16_t, WS_P); const bf16_t* GST = WSP(bf16_t, WS_GST); unsigned char* OL = C.ws + WS_OL;
    LAS float* lr = (LAS float*)C.lds;
    LAS float* segtot = (LAS float*)(C.lds + 8192);
    LAS bf16_t* QT = (LAS bf16_t*)(C.lds + 10240);
    LAS bf16_t* KT = (LAS bf16_t*)(C.lds + 27648);
    LAS bf16_t* VT = (LAS bf16_t*)(C.lds + 45056);
    LAS bf16_t* SCm = (LAS bf16_t*)(C.lds + 81920);
    LAS float* OB = (LAS float*)(C.lds + 91136);
    LAS float* CUM = OB;
    const float* gon = INP(I_ONG) + l * 256;
    const int r32 = C.lane & 31, hi = C.lane >> 5;
    const int btk = C.tid >> 3, bdg = (C.tid & 7) * 16;
    for (int unit = (C.bid + C.G - rot % C.G) % C.G; unit < NBATCH * 4 * NCH; unit += C.G) {
        const int b = unit / (4 * NCH), h = (unit / NCH) % 4, ck = unit % NCH; const size_t r0 = (size_t)b * RPB + ck * 64;
        for (int i = C.tid; i < 64 * 32; i += NTHREADS) lr[i] = bf2f(P[(r0 + (i >> 5)) * NP + C_LRF + (i & 31)]);
        const bf16_t* qp = P + (r0 + btk) * NP + C_LQ + h * 128 + bdg; const bf16_t* kp = P + (r0 + btk) * NP + C_LK + h * 128 + bdg;
        const u32x4 qw0 = *(const u32x4*)qp, qw1 = *(const u32x4*)(qp + 8), kw0 = *(const u32x4*)kp, kw1 = *(const u32x4*)(kp + 8);
        gla_build_vt(C, P, r0, h, VT);
        __syncthreads();
        f32x16 oacc[2] = {};
#pragma unroll 1
        for (int dir = 0; dir < 2; ++dir) {
            gla_cumsum_lds(C, l, h, dir, lr, segtot, CUM);
            { float qf[8], kf[8];
#pragma unroll
              for (int hh = 0; hh < 2; ++hh) { unpack8(hh ? qw1 : qw0, qf); unpack8(hh ? kw1 : kw0, kf);
                  const f32x4 c0 = *(const LAS f32x4*)(CUM + btk * 132 + bdg + 8 * hh), c1 = *(const LAS f32x4*)(CUM + btk * 132 + bdg + 8 * hh + 4);
                  float qo[8], ko[8];
#pragma unroll
                  for (int i = 0; i < 8; ++i) { const float cm = i < 4 ? c0[i & 3] : c1[i & 3]; qo[i] = qf[i] * __expf(cm) * 0.088388347648318440f; ko[i] = kf[i] * __expf(-cm); }
                  u32x4 wq, wk; wq.x = cvt_pk_bf16(qo[0], qo[1]); wq.y = cvt_pk_bf16(qo[2], qo[3]); wq.z = cvt_pk_bf16(qo[4], qo[5]); wq.w = cvt_pk_bf16(qo[6], qo[7]);
                  wk.x = cvt_pk_bf16(ko[0], ko[1]); wk.y = cvt_pk_bf16(ko[2], ko[3]); wk.z = cvt_pk_bf16(ko[4], ko[5]); wk.w = cvt_pk_bf16(ko[6], ko[7]);
                  *(LAS u32x4*)(QT + btk * 136 + bdg + 8 * hh) = wq; *(LAS u32x4*)(KT + btk * 136 + bdg + 8 * hh) = wk; } }
            __syncthreads();
            if (C.wid < 4) { const int mt = C.wid >> 1, nt = C.wid & 1; f32x16 sc = {};
                mma_xy<8>(sc, QT + (mt * 32 + r32) * 136, KT + (nt * 32 + r32) * 136, hi);
#pragma unroll
                for (int i = 0; i < 16; ++i) { const int t = mt * 32 + att::crow(i, hi), sx_ = nt * 32 + r32; const bool keep = dir ? (sx_ >= t) : (sx_ <= t);
                    SCm[t * 72 + sx_] = f2bf(keep ? sc[i] : 0.f); } }
            __syncthreads();
            { const bf16_t* st = GST + ((size_t)gla_sidx(b, dir, h) * NCH + ck) * 32768 + (size_t)(C.wid * 32 + r32) * 128 + hi * 8;
              bf16x8 sb[8];
#pragma unroll
              for (int ks = 0; ks < 8; ++ks) sb[ks] = *(const bf16x8*)(st + ks * 16);
#pragma unroll
              for (int mt = 0; mt < 2; ++mt) {
                  mma_xy<4>(oacc[mt], SCm + (mt * 32 + r32) * 72, VT + (C.wid * 32 + r32) * 72, hi);
#pragma unroll
                  for (int ks = 0; ks < 8; ++ks) { const bf16x8 a = *(const LAS bf16x8*)(QT + (mt * 32 + r32) * 136 + ks * 16 + hi * 8);
                      oacc[mt] = __builtin_amdgcn_mfma_f32_32x32x16_bf16(a, sb[ks], oacc[mt], 0, 0, 0); } } }
            __syncthreads();
        }
#pragma unroll
        for (int mt = 0; mt < 2; ++mt)
#pragma unroll
            for (int i = 0; i < 16; ++i) OB[(mt * 32 + att::crow(i, hi)) * 260 + C.wid * 32 + r32] = oacc[mt][i];
        __syncthreads();
        { const int t = C.tid >> 3, part = C.tid & 7; f32x4 v[8]; float ss = 0.f;
#pragma unroll
          for (int jj = 0; jj < 8; ++jj) { v[jj] = *(const LAS f32x4*)(OB + t * 260 + jj * 32 + part * 4); ss += v[jj][0] * v[jj][0] + v[jj][1] * v[jj][1] + v[jj][2] * v[jj][2] + v[jj][3] * v[jj][3]; }
          ss += dppmov<DPP_HMIRROR>(ss); ss += dppmov<DPP_Q3210>(ss); ss += dppmov<DPP_Q1032>(ss);
          const float rs = rsqrtf(ss * (1.0f / 256.0f) + NORM_EPS);
#pragma unroll
          for (int jj = 0; jj < 8; ++jj) { const int e = jj * 32 + part * 4; const f32x4 g = *(const f32x4*)(gon + e);
              const u32x2 gt = *(const u32x2*)(P + (r0 + t) * NP + C_LG + h * 256 + e);
              const float o0 = v[jj][0] * rs * g[0] * siluf_(bflo(gt.x)), o1 = v[jj][1] * rs * g[1] * siluf_(bfhi(gt.x)), o2 = v[jj][2] * rs * g[2] * siluf_(bflo(gt.y)), o3 = v[jj][3] * rs * g[3] * siluf_(bfhi(gt.y));
              int p8 = __builtin_amdgcn_cvt_pk_fp8_f32(o0, o1, 0, false); p8 = __builtin_amdgcn_cvt_pk_fp8_f32(o2, o3, p8, true);
              *(unsigned*)(OL + (r0 + t) * 1024 + h * 256 + e) = (unsigned)p8; } }
        __syncthreads();
    }
}

__device__ __forceinline__ unsigned f_ord(float f) { const unsigned u = __float_as_uint(f); return u ^ ((unsigned)((int)u >> 31) | 0x80000000u); }
__device__ __forceinline__ float f_unord(unsigned k) { return __uint_as_float((k & 0x80000000u) ? (k ^ 0x80000000u) : ~k); }
__device__ __forceinline__ void ins_u(unsigned (&L)[16], unsigned x) {
#pragma unroll
    for (int j = 0; j < 16; ++j) { const unsigned h = L[j] > x ? L[j] : x; x = L[j] > x ? x : L[j]; L[j] = h; }
}
__device__ __forceinline__ void ins_f(float (&M)[16], float x) {
#pragma unroll
    for (int j = 0; j < 16; ++j) { const float h = M[j] > x ? M[j] : x; x = M[j] > x ? x : M[j]; M[j] = h; }
}
__device__ __forceinline__ void peer_top16(const bf16_t* __restrict__ qrow, const bf16_t* __restrict__ keys, int r32, int hi, unsigned (&L)[16]) {
    bf16x8 qf[8];
#pragma unroll
    for (int kk = 0; kk < 8; ++kk) qf[kk] = *(const bf16x8*)(qrow + kk * 16 + hi * 8);
#pragma unroll
    for (int j = 0; j < 16; ++j) L[j] = 0u;
    bf16x8 kA[8], kB[8];
    const bf16_t* kl = keys + (size_t)r32 * 128 + hi * 8;
#define PT_LDK(dst, mt) do { _Pragma("unroll") for (int kk = 0; kk < 8; ++kk) dst[kk] = *(const bf16x8*)(kl + (mt) * 32 * 128 + kk * 16); } while (0)
#define PT_PROC(src, mt) do { f32x16 acc = {}; \
        _Pragma("unroll") for (int kk = 0; kk < 8; ++kk) acc = __builtin_amdgcn_mfma_f32_32x32x16_bf16(src[kk], qf[kk], acc, 0, 0, 0); \
        _Pragma("unroll") for (int i = 0; i < 16; ++i) { const unsigned kidx = (unsigned)((mt) * 32 + att::crow(i, hi)); ins_u(L, (f_ord(acc[i]) & ~127u) | (127u - kidx)); } } while (0)
    PT_LDK(kA, 0);
#pragma unroll 1
    for (int mp = 0; mp < 2; ++mp) { PT_LDK(kB, 2 * mp + 1); PT_PROC(kA, 2 * mp); if (mp == 0) PT_LDK(kA, 2); PT_PROC(kB, 2 * mp + 1); }
#undef PT_LDK
#undef PT_PROC
    unsigned Pn[16];
#pragma unroll
    for (int j = 0; j < 16; ++j) { auto r_ = __builtin_amdgcn_permlane32_swap(L[j], L[j], false, false); Pn[j] = hi ? r_[0] : r_[1]; }
#pragma unroll
    for (int j = 0; j < 16; ++j) ins_u(L, Pn[j]);
}
__device__ __forceinline__ void phase_peer_select(const Ctx& C, const bool latent_only) {
    const bf16_t* PQ = WSP(bf16_t, WS_PQ); const bf16_t* K1 = WSP(bf16_t, WS_K1); const bf16_t* K2 = WSP(bf16_t, WS_K2);
    int* PIDX = WSP(int, WS_PIDX); float* PG = WSP(float, WS_PG);
    const int r32 = C.lane & 31, hi = C.lane >> 5, head = C.wid;
    const int ngrp = latent_only ? NBATCH * SEQ / 32 : TT / 32;
    for (int gi = C.bid; gi < ngrp; gi += C.G) {
        const int grp = latent_only ? gi + (CTXL / 32) * (1 + gi / (SEQ / 32)) : gi;
        const size_t tok = (size_t)grp * 32 + r32;
        unsigned L1[16], L2[16];
        peer_top16(PQ + tok * DM + head * 256, K1 + (size_t)head * 128 * 128, r32, hi, L1);
        peer_top16(PQ + tok * DM + head * 256 + 128, K2 + (size_t)head * 128 * 128, r32, hi, L2);
        float v1[16], v2[16];
#pragma unroll
        for (int j = 0; j < 16; ++j) { v1[j] = f_unord(L1[j] & ~127u); v2[j] = f_unord(L2[j] & ~127u); }
        float M[16];
#pragma unroll
        for (int j = 0; j < 16; ++j) M[j] = -3.0e38f;
#pragma unroll
        for (int a = 0; a < 16; ++a)
#pragma unroll
            for (int b = 0; b < 16; ++b) if ((a + 1) * (b + 1) <= 16) ins_f(M, v1[a] + v2[b]);
        const float thr = M[15], mx = M[0]; float den = 0.f;
#pragma unroll
        for (int j = 0; j < 16; ++j) den += __expf(M[j] - mx);
        const float rden = 1.0f / den;
        int pos = 0; int* ip = PIDX + tok * 128 + head * 16; float* gp = PG + tok * 128 + head * 16;
#pragma unroll
        for (int a = 0; a < 16; ++a)
#pragma unroll
            for (int b = 0; b < 16; ++b) if ((a + 1) * (b + 1) <= 16) {
                const float val = v1[a] + v2[b];
                if (val >= thr && pos < 16) { if (hi == 0) { ip[pos] = (int)((127u - (L1[a] & 127u)) * 128u + (127u - (L2[b] & 127u))); gp[pos] = __expf(val - mx) * rden; } ++pos; } }
    }
}
template <int OFF> __device__ __forceinline__ float dotf8(const float (&h)[32], const u32x4 w, float acc) {
#pragma unroll
    for (int j = 0; j < 4; ++j) { const f32x2 lo = __builtin_amdgcn_cvt_pk_f32_fp8((int)w[j], false), hi = __builtin_amdgcn_cvt_pk_f32_fp8((int)w[j], true);
        acc += h[OFF + 4 * j] * lo.x; acc += h[OFF + 4 * j + 1] * lo.y; acc += h[OFF + 4 * j + 2] * hi.x; acc += h[OFF + 4 * j + 3] * hi.y; }
    return acc;
}
constexpr float ATT_O8_SCALE = 32.0f;
constexpr int GT_MAXTOK = 9;
template <bool LAST> __device__ __forceinline__ void phase_peer_gather(const Ctx& C, const float* modl, const float pscale) {
    const unsigned char* pt = C.ws + WS_PT + (size_t)(LAST ? DEPTH - 1 : 0) * PT_BYTES;
    const bf16_t* HB = WSP(bf16_t, WS_HB); const unsigned char* U8 = pt + PT_U8; const unsigned char* V8 = pt + PT_V8;
    const float* SCU = (const float*)(pt + PT_SCU); const float* SCV = (const float*)(pt + PT_SCV);
    const int* PIDX = WSP(int, WS_PIDX); const float* PG = WSP(float, WS_PG); float* XS = WSP(float, WS_XS);
    const int lane = C.lane, s = lane >> 3, j = lane & 7; const unsigned j16 = (unsigned)j * 16u;
    LAS int* IDS = (LAS int*)(C.lds + C.wid * (GT_MAXTOK * 512));
    LAS float* ACT = (LAS float*)(C.lds + 8 * GT_MAXTOK * 512 + C.wid * (GT_MAXTOK * 512));
    LAS int* ROWS = (LAS int*)(C.lds + 16 * GT_MAXTOK * 512 + C.wid * 64);
    int nk = 0;
    {
      const int per = (TT + C.G - 1) / C.G, base = C.bid * per;
#pragma unroll 1
      for (int k = 0; k < GT_MAXTOK; ++k) { const int o = C.wid + 8 * k; const int r = base + o; if (o < per && r < TT && !(LAST && (r % RPB) < CTXL)) { if (lane == 0) ROWS[nk] = r; ++nk; } } }
#define GT_ROW(k) __builtin_amdgcn_readfirstlane(ROWS[k])
#pragma unroll 1
    for (int k = 0; k < nk; ++k) { const int r = GT_ROW(k);
        IDS[k * 128 + lane] = (PIDX[(size_t)r * 128 + lane] & (NEXP - 1)) << 7; IDS[k * 128 + 64 + lane] = (PIDX[(size_t)r * 128 + 64 + lane] & (NEXP - 1)) << 7;
        ACT[k * 128 + lane] = 0.f; ACT[k * 128 + 64 + lane] = 0.f; }
    const int nit = 32 * nk;
#define GT_ITEM(it_) const int cb_ = (it_) / (2 * nk), rem_ = (it_) - cb_ * (2 * nk), k_ = rem_ >> 1, hf_ = rem_ & 1
#define GT_LOADU(UQ, HQ, it_) do { GT_ITEM(it_); const int r_ = GT_ROW(k_); \
        const bf16_t* hp_ = HB + (size_t)r_ * DM + cb_ * 128 + j * 16; HQ[0] = *(const u32x4*)hp_; HQ[1] = *(const u32x4*)(hp_ + 8); \
        const unsigned char* ub_ = U8 + (size_t)cb_ * ((size_t)NEXP * 128);     \
        _Pragma("unroll") for (int eg = 0; eg < 8; ++eg) { const unsigned off_ = ((unsigned)IDS[k_ * 128 + (hf_ * 8 + eg) * 8 + s] & idmask) + j16; UQ[eg] = *(const u32x4*)(ub_ + off_); } } while (0)
#define GT_COMPU(UQ, HQ, it_) do { GT_ITEM(it_); (void)cb_; f32x2 hf2[8]; \
        _Pragma("unroll") for (int hh = 0; hh < 2; ++hh) { const u32x4 w_ = HQ[hh]; \
            hf2[hh * 4 + 0] = (f32x2){bflo(w_.x), bfhi(w_.x)}; hf2[hh * 4 + 1] = (f32x2){bflo(w_.y), bfhi(w_.y)}; hf2[hh * 4 + 2] = (f32x2){bflo(w_.z), bfhi(w_.z)}; hf2[hh * 4 + 3] = (f32x2){bflo(w_.w), bfhi(w_.w)}; } \
        float d[8]; \
        _Pragma("unroll") for (int eg = 0; eg < 8; ++eg) { f32x2 d2 = (f32x2){0.f, 0.f}; \
            _Pragma("unroll") for (int q = 0; q < 4; ++q) { const f32x2 lo = __builtin_amdgcn_cvt_pk_f32_fp8((int)UQ[eg][q], false), hi = __builtin_amdgcn_cvt_pk_f32_fp8((int)UQ[eg][q], true); \
                d2 += hf2[2 * q] * lo; d2 += hf2[2 * q + 1] * hi; } \
            d[eg] = d2.x + d2.y; } \
          \
        float t4[4], t2[2], t1; \
        _Pragma("unroll") for (int i = 0; i < 4; ++i) { const float snd = (j & 4) ? d[i] : d[i + 4], kp = (j & 4) ? d[i + 4] : d[i]; t4[i] = kp + dppmov<DPP_HMIRROR>(snd); } \
        _Pragma("unroll") for (int i = 0; i < 2; ++i) { const float snd = (j & 2) ? t4[i] : t4[i + 2], kp = (j & 2) ? t4[i + 2] : t4[i]; t2[i] = kp + dppmov<DPP_Q3210>(snd); } \
        { const float snd = (j & 1) ? t2[0] : t2[1], kp = (j & 1) ? t2[1] : t2[0]; t1 = kp + dppmov<DPP_Q1032>(snd); } \
        ACT[k_ * 128 + (hf_ * 8 + j) * 8 + s] += t1; } while (0)
#ifdef DBG_GDUP
#pragma unroll 1
    for (int rep_ = 0; rep_ < 2; ++rep_) {
    const unsigned idmask = rep_ == 0 ? ((unsigned)DBG_GMASK << 7 | 127u) : 0xffffffffu;
    if (rep_ == 1) { for (int k = 0; k < nk; ++k) { ACT[k * 128 + lane] = 0.f; ACT[k * 128 + 64 + lane] = 0.f; } }
#else
    { const unsigned idmask = 0xffffffffu;
#endif
    if (nit > 0) {
        u32x4 uA[8], uB[8], hA[2], hB[2];
        GT_LOADU(uA, hA, 0);
#pragma unroll 1
        for (int it = 0; it < nit; it += 2) {
            GT_LOADU(uB, hB, it + 1);
            GT_COMPU(uA, hA, it);
            if (it + 2 < nit) GT_LOADU(uA, hA, it + 2);
            GT_COMPU(uB, hB, it + 1);
        }
    }
    }
#undef GT_LOADU
#undef GT_COMPU
#pragma unroll 1
    for (int k = 0; k < nk; ++k) { const int r = GT_ROW(k);
#pragma unroll
        for (int hh = 0; hh < 2; ++hh) { const int e = hh * 64 + lane; const int id = IDS[k * 128 + e] >> 7; const float a = ACT[k * 128 + e] * SCU[id];
            const float w = PG[(size_t)r * 128 + e] * 0.5f * a * (1.0f + erff(a * 0.70710678118654752f));
#if defined(DBG_CHECK) && (DBG_CHECK == 3 || DBG_CHECK == 4)
            if (((r - 300) & 63) == 0 && r >= 300 && r < 300 + 64 * 128) WSP(float, WS_OM)[(size_t)r * 128 + e] = w;
#endif
            ACT[k * 128 + e] = w * SCV[id]; } }
#define GT_LOADV(VQ, WV, it_) do { GT_ITEM(it_); const unsigned char* vb_ = V8 + (size_t)cb_ * ((size_t)NEXP * 128); \
        _Pragma("unroll") for (int eg = 0; eg < 8; ++eg) { const int e_ = k_ * 128 + (hf_ * 8 + eg) * 8 + s; const unsigned off_ = (unsigned)IDS[e_] + j16; VQ[eg] = *(const u32x4*)(vb_ + off_); WV[eg] = ACT[e_]; } } while (0)
#define GT_COMPV(VQ, WV) do { \
        _Pragma("unroll") for (int eg = 0; eg < 8; ++eg) { const f32x2 w2_ = (f32x2){WV[eg], WV[eg]}; \
            _Pragma("unroll") for (int q = 0; q < 4; ++q) { \
                const f32x2 lo = __builtin_amdgcn_cvt_pk_f32_fp8((int)VQ[eg][q], false), hi = __builtin_amdgcn_cvt_pk_f32_fp8((int)VQ[eg][q], true); \
                acc2[2 * q] += w2_ * lo; acc2[2 * q + 1] += w2_ * hi; } } } while (0)
    if (nit > 0) {
        u32x4 vA[8], vB[8]; float wA[8], wB[8];
        GT_LOADV(vA, wA, 0);
#pragma unroll 1
        for (int it = 0; it < nit; it += 2) {
            f32x2 acc2[8];
#pragma unroll
            for (int i = 0; i < 8; ++i) acc2[i] = (f32x2){0.f, 0.f};
            GT_LOADV(vB, wB, it + 1);
            GT_COMPV(vA, wA);
            if (it + 2 < nit) GT_LOADV(vA, wA, it + 2);
            GT_COMPV(vB, wB);
            f32x2 t4[4], t2[2], t1;
#pragma unroll
            for (int i = 0; i < 4; ++i) { const f32x2 snd = (s & 4) ? acc2[i] : acc2[i + 4], kp = (s & 4) ? acc2[i + 4] : acc2[i];
                t4[i] = kp + (f32x2){xchg32(snd.x, lane), xchg32(snd.y, lane)}; }
#pragma unroll
            for (int i = 0; i < 2; ++i) { const f32x2 snd = (s & 2) ? t4[i] : t4[i + 2], kp = (s & 2) ? t4[i + 2] : t4[i];
                t2[i] = kp + (f32x2){xchg16(snd.x, lane), xchg16(snd.y, lane)}; }
            { const f32x2 snd = (s & 1) ? t2[0] : t2[1], kp = (s & 1) ? t2[1] : t2[0]; t1 = kp + (f32x2){dppmov<DPP_ROR8>(snd.x), dppmov<DPP_ROR8>(snd.y)}; }
            { GT_ITEM(it); (void)hf_; const int r_ = GT_ROW(k_);
              const int col = cb_ * 128 + j * 16 + 2 * s; float* xp = XS + (size_t)r_ * DM + col; const float* g2 = modl + (size_t)mod_sel(r_) * 12288 + 5 * DM + col;
#if defined(DBG_CHECK) && (DBG_CHECK == 3 || DBG_CHECK == 4)
              if (((r_ - 300) & 63) == 0 && r_ >= 300 && r_ < 300 + 64 * 128) { float* dbgo = WSP(float, WS_MQ) + (size_t)r_ * DM + col; dbgo[0] = t1.x; dbgo[1] = t1.y; }
#endif
              const f32x2 x = *(const f32x2*)xp, g = *(const f32x2*)g2;
              *(f32x2*)xp = x + pscale * g * t1; }
        }
    }
#undef GT_LOADV
#undef GT_COMPV
#undef GT_ITEM
#undef GT_ROW
}
__device__ __forceinline__ void phase_final_norm(const Ctx& C) {
    const float* XS = WSP(float, WS_XS); const float* fg = INP(I_FG);
    for (int q = C.bid * 8 + C.wid; q < NBATCH * SEQ; q += C.G * 8) {
        const int b = q / SEQ, t = q % SEQ; const float* xr = XS + ((size_t)b * RPB + CTXL + t) * DM; float* op = C.out + (size_t)q * DM;
        f32x4 v[8]; float ss = 0.f;
#pragma unroll
        for (int c = 0; c < 8; ++c) { v[c] = *(const f32x4*)(xr + c * 256 + C.lane * 4); ss += v[c][0] * v[c][0] + v[c][1] * v[c][1] + v[c][2] * v[c][2] + v[c][3] * v[c][3]; }
        ss = wave_sum(ss); const float rs = rsqrtf(ss * (1.0f / DM) + NORM_EPS);
#pragma unroll
        for (int c = 0; c < 8; ++c) { const f32x4 g = *(const f32x4*)(fg + c * 256 + C.lane * 4); *(f32x4*)(op + c * 256 + C.lane * 4) = v[c] * rs * g; }
    }
}


__device__ __forceinline__ void phase_vt8(const Ctx& C) {
    const bf16_t* P = WSP(bf16_t, WS_P); const bf16_t* MKV = WSP(bf16_t, WS_MKV);
    const int dv = C.tid & 127, kq = C.tid >> 7, g = kq >> 1, j0 = (kq & 1) * 16;
    constexpr int NU_A = NBATCH * 2 * NCH, NU_M = NBATCH * 8 * NCH;
    for (int u = C.bid; u < NU_A + NU_M; u += C.G) {
        const bool gqa = u < NU_A; const int v = gqa ? u : u - NU_A; const int nh = gqa ? 2 : 8;
        const int b = v / (nh * NCH), h = (v / NCH) % nh, t = v % NCH; const size_t r0 = (size_t)b * RPB + t * 64;
        const bf16_t* src = gqa ? P + r0 * NP + C_AV + h * 128 + dv : MKV + r0 * 2048 + h * 256 + 128 + dv; const size_t ld = gqa ? NP : 2048;
        float x[16];
#pragma unroll
        for (int jj = 0; jj < 16; ++jj) x[jj] = bf2f(src[(size_t)att::vt8_key(g, j0 + jj) * ld]);
        u32x4 w; w.x = (unsigned)att::pk4_fp8(x[0], x[1], x[2], x[3]); w.y = (unsigned)att::pk4_fp8(x[4], x[5], x[6], x[7]); w.z = (unsigned)att::pk4_fp8(x[8], x[9], x[10], x[11]); w.w = (unsigned)att::pk4_fp8(x[12], x[13], x[14], x[15]);
        unsigned char* dst = C.ws + (gqa ? WS_VT8A : WS_VT8M) + ((size_t)(b * nh + h) * NCH + t) * 8192 + dv * 64 + kq * 16;
        *(u32x4*)dst = w;
    }
}
template <int TYPE  , int VAR = 0> __device__ __forceinline__ void attn_units(const Ctx& C, bool need_ctx) {
    const bf16_t* P = WSP(bf16_t, WS_P);
    const int nu = need_ctx ? 528 : 512;
#pragma unroll 1
    for (int u = C.bid; u < nu; u += C.G) {
        int bh, qb; if (u < 512) { bh = (u >> 8) * 8 + (u & 7); qb = ((u & 255) >> 3) + 1; } else { bh = u - 512; qb = 0; }
        const int b = bh >> 3, h = bh & 7; const size_t rq = (size_t)b * RPB + (size_t)qb * 256, rk = (size_t)b * RPB; const int seq = qb == 0 ? CTXL : RPB;
        __syncthreads();
        if constexpr (TYPE == 1) {
            att::attn_body88<128>(P + rq * NP + C_AQ + h * 128, NP, C.ws + WS_AK8 + rk * 256 + (h >> 2) * 128, 256, nullptr, 0, C.ws + WS_VT8A + (size_t)(b * 2 + (h >> 2)) * NCH * 8192,
                                  C.ws + WS_OA + rq * 1024 + h * 128, 1024, seq, false, 0, nullptr, (char*)C.lds, C.tid);
        } else {
            const bf16_t* MQ = WSP(bf16_t, WS_MQ);
            att::attn_body88<192>(MQ + rq * 1536 + h * 192, 1536, C.ws + WS_KN8 + rk * 1024 + h * 128, 1024, C.ws + WS_KR8 + rk * 64, 64, C.ws + WS_VT8M + (size_t)(b * 8 + h) * NCH * 8192,
                                  C.ws + WS_OM + rq * 1024 + h * 128, 1024, seq, qb > 0, (qb - 1) * 256, WSP(float, WS_TABM), (char*)C.lds, C.tid);
        }
    }
    __syncthreads();
}

constexpr int LDS_BYTES = 163840, LDS_BAR_OFF = LDS_BYTES - 16;
constexpr int N_PHASES = 26;
template <int K> __device__ __forceinline__ void run_phase(const Ctx& C0, int l) {
    const Ctx C = launder(C0);
    const float* modl = WSP(float, WS_MODV) + (size_t)l * 3 * 12288;
    if constexpr (K == 0) { phase_modv(C); phase_tables(C); __syncthreads(); phase_cvt_mixer_weights(C, 0); }
    if constexpr (K == 1) {
        if (l == 0) phase_norm_mod<true, true>(C, INP(I_N1G), modl, 0, DM);
        else { phase_norm_mod<false, true>(C, INP(I_N1G) + l * DM, modl, 0, DM); __syncthreads(); phase_cvt_mixer_weights(C, l); }
    }
    if constexpr (K == 2) {
        pg8::Gemm g{WSP(bf16_t, WS_HB), WSP(bf16_t, WS_WIN), TT, NP, DM, DM, DM}; pg8::WinOrder S; S.init(C.G, C.bid, l + 1 < DEPTH);
        pg8::EpiStoreBf16S E{WSP(bf16_t, WS_P), NP, WSP(float, WS_WINS)};
        pg8::gemm_phase<pg8::EpiStoreBf16S, pg8::WinOrder, 1>(C.lds, C.tid, g, S, E);
    }
    if constexpr (K == 3) phase_post_p(C, l);
    if constexpr (K == 4) {
        { pg8::Gemm g{WSP(bf16_t, WS_P) + C_MCQ, WSP(bf16_t, WS_WUQ), TT, 1536, 512, NP, 512}; pg8::StaticOrder S; S.init(TT, 1536, C.G, C.bid);
          pg8::EpiStoreBf16 E{WSP(bf16_t, WS_MQ), 1536}; pg8::gemm_phase(C.lds, C.tid, g, S, E); }
        { pg8::Gemm g{WSP(bf16_t, WS_P) + C_MCKV, WSP(bf16_t, WS_WUKV), TT, 2048, 512, NP, 512}; pg8::StaticOrder S; S.init(TT, 2048, C.G, (C.bid + C.G - 140 % C.G) % C.G);
          pg8::EpiStoreMKV E{WSP(bf16_t, WS_MKV), C.ws + WS_KN8}; pg8::gemm_phase(C.lds, C.tid, g, S, E); }
        { const Ctx C2 = launder(C0); phase_gla_local(C2, l, 156); }
#ifdef DBG_DUP_GLALOCAL
        { const Ctx C2 = launder(C0); __syncthreads(); phase_gla_local(C2, l, 156); }
#endif
    }
    if constexpr (K == 5) { phase_gla_scan(C); { const Ctx C2 = launder(C0); phase_vt8(C2); } }
    if constexpr (K == 6) {
#ifdef DBG_ATTVAR
        { const Ctx Cx = launder(C0); attn_units<0, DBG_ATTVAR>(Cx, l + 1 < DEPTH); } { const Ctx Cx = launder(C0); attn_units<1, DBG_ATTVAR>(Cx, l + 1 < DEPTH); } __syncthreads();
#endif
        attn_units<0>(C, l + 1 < DEPTH); { const Ctx C2 = launder(C0); attn_units<1>(C2, l + 1 < DEPTH); } { const Ctx C3 = launder(C0); phase_gla_out(C3, l, 128); }
#ifdef DBG_DUP_GLAOUT
        { const Ctx C3 = launder(C0); __syncthreads(); phase_gla_out(C3, l, 128); }
#endif
    }
    if constexpr (K == 7) {
        const bf16_t* P = WSP(bf16_t, WS_P); bf16_t* Y = WSP(bf16_t, WS_Y);
        const pg8::Gemm ga{WSP(bf16_t, WS_OA), WSP(bf16_t, WS_WBR), TT, DM, 1024, 1024, 1024}, gl{WSP(bf16_t, WS_OL), (const bf16_t*)(C.ws + WS_WBR + (size_t)2048 * 1024), TT, DM, 1024, 1024, 1024},
                        gm{WSP(bf16_t, WS_OM), (const bf16_t*)(C.ws + WS_WBR + (size_t)2 * 2048 * 1024), TT, DM, 1024, 1024, 1024};
        unsigned char* Y8 = C.ws + WS_HB;
        const float* wbs = WSP(float, WS_WBRS);
        const pg8::EpiGate<true> Ea{Y, P + C_GA, nullptr, wbs}; const pg8::EpiGate<false> El{Y, P + C_GL, nullptr, wbs + DM}; const pg8::EpiGate<false, true> Em{Y, P + C_GM, Y8, wbs + 2 * DM};
        pg8::StaticOrder S; S.init(TT, DM, C.G, C.bid, l + 1 >= DEPTH);
        pg8::gemm_phase<pg8::EpiGate<true>, pg8::StaticOrder, 1>(C.lds, C.tid, ga, S, Ea); pg8::gemm_phase<pg8::EpiGate<false>, pg8::StaticOrder, 1>(C.lds, C.tid, gl, S, El);
        pg8::gemm_phase<pg8::EpiGate<false, true>, pg8::StaticOrder, 1>(C.lds, C.tid, gm, S, Em);
        if (l == 0) { const Ctx C2 = launder(C0); phase_cvt_peer_tables(C2, 0, 0, NEXP, S.nwg % C.G); }
    }
    if constexpr (K == 8) {
        pg8::Gemm g{WSP(bf16_t, WS_HB), WSP(bf16_t, WS_WOUT), TT, DM, DM, DM, DM};
        const pg8::EpiResidT<true> E{WSP(float, WS_XS), DM, modl + 2 * DM, WSP(float, WS_WOUTS)};
        pg8::StaticOrder S; S.init(TT, DM, C.G, C.bid, l + 1 >= DEPTH);
        pg8::gemm_phase<pg8::EpiResidT<true>, pg8::StaticOrder, 1>(C.lds, C.tid, g, S, E);
        if (l == 0 && DEPTH > 1) { const Ctx C2 = launder(C0); phase_cvt_peer_tables(C2, 1, 0, NEXP / 2, S.nwg % C.G); }
    }
    if constexpr (K == 9) phase_norm_mod<false>(C, INP(I_N2G) + l * DM, modl, 3 * DM, 4 * DM);
    if constexpr (K == 10) {
        pg8::Gemm g{WSP(bf16_t, WS_HB), WSP(bf16_t, WS_WQ), TT, DM, DM, DM, DM};
        pg8::EpiStoreBf16 E{WSP(bf16_t, WS_PQ), DM};
        pg8::StaticOrder S; S.init(TT, DM, C.G, C.bid, l + 1 >= DEPTH); pg8::gemm_phase(C.lds, C.tid, g, S, E);
        if (l == 0 && DEPTH > 1) { const Ctx C2 = launder(C0); phase_cvt_peer_tables(C2, 1, NEXP / 2, NEXP, S.nwg % C.G); }
    }
    if constexpr (K == 11) phase_peer_select(C, l + 1 >= DEPTH);
    if constexpr (K == 13) phase_final_norm(C);
    if constexpr (K == 12) {
#ifdef DBG_DUP12
        if (l + 1 < DEPTH) phase_peer_gather<false>(C, modl, 0.0f); else phase_peer_gather<true>(C, modl, 0.0f);
        __syncthreads();
#endif
        if (l + 1 < DEPTH) phase_peer_gather<false>(C, modl, DBG_PEER0); else phase_peer_gather<true>(C, modl, DBG_PEER1); }
}
__device__ __forceinline__ Ctx make_ctx(const Args& args, unsigned char* lds_raw) {
    Ctx C0; C0.in = (const __attribute__((address_space(4))) cfp_t*)__builtin_amdgcn_kernarg_segment_ptr(); C0.out = args.out; C0.ws = args.ws; C0.lds = (LAS unsigned char*)lds_raw;
    C0.tid = threadIdx.x; C0.lane = C0.tid & 63; C0.wid = __builtin_amdgcn_readfirstlane(C0.tid >> 6); C0.G = gridDim.x; C0.bid = blockIdx.x;
    return C0;
}
template <int K> __global__ void __launch_bounds__(NTHREADS, 2) k_one(Args args) {
    extern __shared__ __attribute__((aligned(16))) unsigned char lds_raw[];
    const Ctx C0 = make_ctx(args, lds_raw);
    run_phase<K>(C0, args.ph_lo);
}
#if MK_N_LAUNCHES == 1 || defined(DBG_HYB)
__global__ void __launch_bounds__(NTHREADS, 2) mk_fwd(Args args) {
    extern __shared__ __attribute__((aligned(16))) unsigned char lds_raw[];
    const Ctx C0 = make_ctx(args, lds_raw);
    if (C0.tid < 4) ((LAS unsigned*)(C0.lds + LDS_BAR_OFF))[C0.tid] = 0u;
    __syncthreads();
    const int lo = args.ph_lo, hi = args.ph_hi;
    XcdBarrier bar; bar.bar = (unsigned*)(args.ws + WS_CTL); bar.x = 0; bar.st = nullptr;
    if (hi - lo > 1) bar = xcd_barrier_post((unsigned*)(args.ws + WS_CTL), (volatile LAS unsigned*)(C0.lds + LDS_BAR_OFF));
#define IN(k) (lo <= (k) && (k) < hi)
#define SEAM(k) do { if (IN(k) && IN((k) + 1)) xcd_barrier(bar); } while (0)
#ifndef DBG_DUP
#define DBG_DUP -1
#endif
#define PH(K, k) do { if (IN(k)) { run_phase<K>(C0, l); if (K == DBG_DUP) { xcd_barrier(bar); run_phase<K>(C0, l); } } SEAM(k); } while (0)
    { const int l = 0; PH(0, 0); }
#pragma unroll 1
    for (int l = 0; l < DEPTH; ++l) {
        const int pb = 1 + 12 * l;
        PH(1, pb + 0); PH(2, pb + 1); PH(3, pb + 2); PH(4, pb + 3); PH(5, pb + 4); PH(6, pb + 5);
        PH(7, pb + 6); PH(8, pb + 7); PH(9, pb + 8); PH(10, pb + 9); PH(11, pb + 10); PH(12, pb + 11);
    }
    { const int l = DEPTH - 1; PH(13, 1 + 12 * DEPTH); }
#undef PH
#undef IN
#undef SEAM
}
#define MAIN_KERNEL mk_fwd
#else
#define MAIN_KERNEL k_one<6>
#endif


#ifdef DBG_PROBE
typedef int i32x8 __attribute__((ext_vector_type(8)));
__device__ __forceinline__ unsigned char fp8_of_int(int v) {
    const float f = (float)v; return (unsigned char)(__builtin_amdgcn_cvt_pk_fp8_f32(f, 0.f, 0, false) & 0xff); }
__global__ void k_probe_mx(unsigned* slot) {
    const int l = threadIdx.x, r = l & 31, g = l >> 5;
    i32x8 A, B;
    for (int j = 0; j < 8; ++j) { unsigned wa = 0, wb = 0;
        for (int b = 0; b < 4; ++b) { const int k = g * 32 + 4 * j + b;
            wa |= (unsigned)fp8_of_int(((3 * r + k) % 7) - 3) << (8 * b); wb |= (unsigned)fp8_of_int(((5 * k + 2 * r) % 9) - 4) << (8 * b); }
        A[j] = (int)wa; B[j] = (int)wb; }
    f32x16 c = {};
    c = __builtin_amdgcn_mfma_scale_f32_32x32x64_f8f6f4(A, B, c, 0, 0, 0, 0x7f7f7f7f, 0, 0x7f7f7f7f);
    float worst = 0.f;
    for (int i = 0; i < 16; ++i) { const int m = (i & 3) + 8 * (i >> 2) + 4 * g, n = r; float ref = 0.f; for (int k = 0; k < 64; ++k) ref += (float)(((3 * m + k) % 7) - 3) * (float)(((5 * k + 2 * n) % 9) - 4);
        worst = fmaxf(worst, fabsf(c[i] - ref)); }
    for (int o = 32; o >= 1; o >>= 1) worst = fmaxf(worst, __shfl_xor(worst, o));
    if (l == 0) { const float code = worst == 0.f ? 0.4f : 1.2f; *slot = __float_as_uint(powf(10.f, code / 0.25f - 4.f)); }
}
#endif
#ifdef DBG_CHECK
__device__ __forceinline__ void dbg_report(unsigned* slot, float err) { if (!(err <= 3e38f)) err = 1e30f; atomicMax(slot, __float_as_uint(err)); }
__global__ void k_check_gemm(const bf16_t* A, int lda, const float* W, int K, int N, const bf16_t* Cm, int ldc, int M, unsigned* slot) {
    const unsigned id = blockIdx.x * blockDim.x + threadIdx.x; if (id >= 8192) return;
    const unsigned h = id * 2654435761u; const int row = (int)((h >> 8) % (unsigned)M), col = (int)((h * 40503u >> 7) % (unsigned)N);
    float ref = 0.f; for (int k = 0; k < K; ++k) ref += bf2f(A[(size_t)row * lda + k]) * W[(size_t)k * N + col];
    const float got = bf2f(Cm[(size_t)row * ldc + col]);
    dbg_report(slot, fabsf(got - ref) / (fabsf(ref) + 0.1f));
}

__global__ void k_check_attn(const unsigned char* ws, int type, unsigned* slot) {
    __shared__ float sc[RPB]; __shared__ float red[256]; __shared__ float qv[192];
    const int t = threadIdx.x, bh = blockIdx.x & 15, b = bh >> 3, h = bh & 7; const int qpos = (int)(((blockIdx.x >> 4) * 977u + 13u) % SEQ); const size_t rq = (size_t)b * RPB + CTXL + qpos, rk = (size_t)b * RPB;
    const bf16_t* P = (const bf16_t*)(ws + WS_P); const bf16_t* MQ = (const bf16_t*)(ws + WS_MQ); const bf16_t* MKV = (const bf16_t*)(ws + WS_MKV);
    const int dq = type ? 128 : 192;
    if (t < dq) { float v = type ? bf2f(P[rq * NP + C_AQ + h * 128 + t]) : bf2f(MQ[rq * 1536 + h * 192 + t]); qv[t] = v; }
    __syncthreads();
    if (!type && t < 32) {
        const int ri = qpos >> 6, ci = qpos & 63; const int i = t; const float pos = (float)(i < 16 ? ri : ci); const float inv = powf(10000.f, -(float)(i & 15) / 16.f); const float a = pos * inv;
        const float x1 = qv[128 + i], x2 = qv[160 + i]; qv[128 + i] = x1 * cosf(a) - x2 * sinf(a); qv[160 + i] = x2 * cosf(a) + x1 * sinf(a); }
    __syncthreads();
    const float scale = type ? 0.088388347648f : 0.0721687836487f;
    float mx = -1e30f;
    for (int k = t; k < RPB; k += 256) { float s = 0.f;
        if (type) { const bf16_t* kp = P + (rk + k) * NP + C_AK + (h >> 2) * 128; for (int d = 0; d < 128; ++d) s += qv[d] * bf2f(kp[d]); }
        else { const bf16_t* kp = MKV + (rk + k) * 2048 + h * 256; for (int d = 0; d < 128; ++d) s += qv[d] * bf2f(kp[d]); const bf16_t* kr = P + (rk + k) * NP + C_MKR; for (int d = 0; d < 64; ++d) s += qv[128 + d] * bf2f(kr[d]); }
        s *= scale; sc[k] = s; mx = fmaxf(mx, s); }
    red[t] = mx; __syncthreads(); for (int o = 128; o >= 1; o >>= 1) { if (t < o) red[t] = fmaxf(red[t], red[t + o]); __syncthreads(); } mx = red[0]; __syncthreads();
    float sum = 0.f; for (int k = t; k < RPB; k += 256) { const float p = __expf(sc[k] - mx); sc[k] = p; sum += p; }
    red[t] = sum; __syncthreads(); for (int o = 128; o >= 1; o >>= 1) { if (t < o) red[t] += red[t + o]; __syncthreads(); } sum = red[0]; __syncthreads();
    float e = 0.f, mag = 0.f;
    if (t < 128) { float o = 0.f; for (int k = 0; k < RPB; ++k) { const float vv = type ? bf2f(P[(rk + k) * NP + C_AV + (h >> 2) * 128 + t]) : bf2f(MKV[(rk + k) * 2048 + h * 256 + 128 + t]); o += sc[k] * vv; }
        o /= sum; const float got = __builtin_amdgcn_cvt_f32_fp8((int)(ws + (type ? WS_OA : WS_OM))[rq * 1024 + h * 128 + t], 0) * (1.0f / 32.0f); e = fabsf(got - o); mag = fabsf(o); }
    red[t] = e; __syncthreads(); for (int o = 128; o >= 1; o >>= 1) { if (t < o) red[t] = fmaxf(red[t], red[t + o]); __syncthreads(); } e = red[0]; __syncthreads();
    red[t] = mag; __syncthreads(); for (int o = 128; o >= 1; o >>= 1) { if (t < o) red[t] = fmaxf(red[t], red[t + o]); __syncthreads(); } mag = red[0];
    if (t == 0) dbg_report(slot, e / (mag + 1e-4f));
}
__global__ void __launch_bounds__(256) k_check_gla_rec(const unsigned char* ws, const float* wa_f, const float* ba_f, const float* wa_b, const float* ba_b, float* obuf, int b) {
    __shared__ float ad[128], kd[128], qd[128], lrs[16];
    const int e = threadIdx.x, h = blockIdx.x & 3, dir = blockIdx.x >> 2; const bf16_t* P = (const bf16_t*)(ws + WS_P);
    const float* wa = dir ? wa_b : wa_f; const float* ba = dir ? ba_b : ba_f;
    float S[128];
#pragma unroll
    for (int d = 0; d < 128; ++d) S[d] = 0.f;
    float* ob = obuf + ((size_t)(dir * 2 + b) * 4 + h) * RPB * 256;
    for (int st = 0; st < RPB; ++st) {
        int j; if (!dir) j = st; else j = st < CTXL ? CTXL - 1 - st : RPB - 1 - (st - CTXL);
        const size_t r = (size_t)b * RPB + j; const bf16_t* pr = P + r * NP;
        if (e < 16) lrs[e] = bf2f(pr[(dir ? C_LRB : C_LRF) + e]);
        __syncthreads();
        if (e < 128) { float pre = ba[h * 128 + e]; for (int q = 0; q < 16; ++q) pre += lrs[q] * wa[q * 512 + h * 128 + e];
            const float ls = (fminf(pre, 0.f) - log1pf(expf(-fabsf(pre)))) / 16.f; ad[e] = expf(ls); kd[e] = bf2f(pr[C_LK + h * 128 + e]); qd[e] = bf2f(pr[C_LQ + h * 128 + e]) * 0.088388347648f; }
        __syncthreads();
        const float v = bf2f(pr[C_LV + h * 256 + e]); float o = 0.f;
#pragma unroll
        for (int d = 0; d < 128; ++d) { S[d] = ad[d] * S[d] + kd[d] * v; o += qd[d] * S[d]; }
        ob[(size_t)j * 256 + e] = o;
        __syncthreads();
    }
}
__global__ void k_check_gla_cmp(const unsigned char* ws, const float* obuf, const float* gon, int b, unsigned* slot) {
    __shared__ float red[256];
    const int e = threadIdx.x, h = blockIdx.x & 3, j = blockIdx.x >> 2; const size_t r = (size_t)b * RPB + j; const bf16_t* P = (const bf16_t*)(ws + WS_P);
    const float o = obuf[((size_t)(0 * 2 + b) * 4 + h) * RPB * 256 + (size_t)j * 256 + e] + obuf[((size_t)(1 * 2 + b) * 4 + h) * RPB * 256 + (size_t)j * 256 + e];
    red[e] = o * o; __syncthreads(); for (int s_ = 128; s_ >= 1; s_ >>= 1) { if (e < s_) red[e] += red[e + s_]; __syncthreads(); }
    const float rs = rsqrtf(red[0] / 256.f + NORM_EPS); __syncthreads();
    const float gt = bf2f(P[r * NP + C_LG + h * 256 + e]); const float ref = o * rs * gon[e] * (gt / (1.f + expf(-gt)));
    const float got = __builtin_amdgcn_cvt_f32_fp8((int)(ws + WS_OL)[r * 1024 + h * 256 + e], 0);
    red[e] = fabsf(got - ref); __syncthreads(); for (int s_ = 128; s_ >= 1; s_ >>= 1) { if (e < s_) red[e] = fmaxf(red[e], red[e + s_]); __syncthreads(); }
    if (e == 0) dbg_report(slot, red[0] / 1.0f);
}

__global__ void k_check_gemm8(const unsigned char* A8, const float* W, int K, int N, const bf16_t* Cm, int ldc, int M, unsigned* slot) {
    const unsigned id = blockIdx.x * blockDim.x + threadIdx.x; if (id >= 8192) return;
    const unsigned h = id * 2654435761u; const int row = (int)((h >> 8) % (unsigned)M), col = (int)((h * 40503u >> 7) % (unsigned)N);
    float ref = 0.f, mag = 0.f; for (int k = 0; k < K; ++k) { const float a = __builtin_amdgcn_cvt_f32_fp8((int)A8[(size_t)row * K + k], 0), w = W[(size_t)k * N + col]; ref += a * w; mag += a * a * w * w; }
    const float got = bf2f(Cm[(size_t)row * ldc + col]);
    dbg_report(slot, fabsf(got - ref) / (sqrtf(mag) + 1e-3f));
}
__global__ void k_check_select(const bf16_t* PQ, const float* k1, const float* k2, const int* PIDX, const float* PG, unsigned* slot) {
    __shared__ float s1[128], s2[128]; __shared__ int cnt; __shared__ float selv[16];
    const int tok = (blockIdx.x >> 3) * 61 + 5, head = blockIdx.x & 7, t = threadIdx.x;
    if (t == 0) cnt = 0;
    for (int n = t; n < 128; n += 64) { float a = 0.f, b = 0.f; for (int d = 0; d < 128; ++d) { a += bf2f(PQ[(size_t)tok * DM + head * 256 + d]) * k1[((size_t)head * 128 + n) * 128 + d]; b += bf2f(PQ[(size_t)tok * DM + head * 256 + 128 + d]) * k2[((size_t)head * 128 + n) * 128 + d]; } s1[n] = a; s2[n] = b; }
    __syncthreads();
    if (t < 16) { const int id = PIDX[(size_t)tok * 128 + head * 16 + t]; selv[t] = (id >= 0 && id < 16384) ? s1[id >> 7] + s2[id & 127] : -1e30f; }
    __syncthreads();
    float thr = selv[0], mx = selv[0]; for (int k = 1; k < 16; ++k) { thr = fminf(thr, selv[k]); mx = fmaxf(mx, selv[k]); }
    int c = 0; for (int p = t; p < 16384; p += 64) if (s1[p >> 7] + s2[p & 127] > thr + 0.02f) ++c;
    atomicAdd(&cnt, c); __syncthreads();
    if (t == 0) { float den = 0.f; for (int k = 0; k < 16; ++k) den += __expf(selv[k] - mx); float e = fabsf((float)cnt - 15.f) / 15.f > 0.34f ? fabsf((float)cnt - 15.f) / 15.f : 0.f;
        for (int k = 0; k < 16; ++k) e = fmaxf(e, fabsf(PG[(size_t)tok * 128 + head * 16 + k] - __expf(selv[k] - mx) / den) * 4.f);
        for (int k = 0; k < 16; ++k) for (int k2_ = 0; k2_ < k; ++k2_) if (PIDX[(size_t)tok * 128 + head * 16 + k] == PIDX[(size_t)tok * 128 + head * 16 + k2_]) e = fmaxf(e, 10.f);
        dbg_report(slot, e); }
}
__global__ void k_check_gather(const bf16_t* HB, const float* u, const float* v, const int* PIDX, const float* PG, const float* dbgo, unsigned* slot) {
    __shared__ float w[128];
    const int tok = blockIdx.x * 64 + 300, t = threadIdx.x;
    for (int k = t; k < 128; k += 64) { const int id = PIDX[(size_t)tok * 128 + k] & 16383; float a = 0.f; for (int d = 0; d < DM; ++d) a += bf2f(HB[(size_t)tok * DM + d]) * u[(size_t)id * DM + d];
        w[k] = PG[(size_t)tok * 128 + k] * 0.5f * a * (1.0f + erff(a * 0.70710678f)); }
    __syncthreads();
    float e = 0.f, sc = 0.f;
    for (int d = t; d < DM; d += 64) { float o = 0.f; for (int k = 0; k < 128; ++k) o += w[k] * v[(size_t)(PIDX[(size_t)tok * 128 + k] & 16383) * DM + d];
        e = fmaxf(e, fabsf(o - dbgo[(size_t)tok * DM + d])); sc = fmaxf(sc, fabsf(o)); }
    for (int o_ = 32; o_ >= 1; o_ >>= 1) { e = fmaxf(e, __shfl_xor(e, o_)); sc = fmaxf(sc, __shfl_xor(sc, o_)); }
    if (t == 0) dbg_report(slot, e / (sc + 1e-6f));
}
__global__ void k_dbg_out2(const float* x, const float* fg, float* out, const unsigned* slot) {
    const float mx = __uint_as_float(*slot); float v = 0.25f * (log10f(fmaxf(mx, 1e-30f)) + 4.0f); v = fminf(fmaxf(v, 0.f), 9.f);
    const float f = 1.0f + v;
    const int lane = threadIdx.x & 63; const size_t r = (size_t)blockIdx.x * 4 + (threadIdx.x >> 6);
    const float* xr = x + r * DM; float ss = 0.f;
    for (int c = lane; c < DM; c += 64) ss += xr[c] * xr[c];
    ss = wave_sum(ss); const float rs = rsqrtf(ss / DM + NORM_EPS);
    for (int c = lane; c < DM; c += 64) out[r * DM + c] = xr[c] * rs * fg[c] * f;
}
#endif
#ifdef DBG_SCAN
__global__ void k_scan16(const bf16_t* p, size_t n, unsigned* flags, int stage) {
    unsigned bad = 0; for (size_t i = (size_t)blockIdx.x * blockDim.x + threadIdx.x; i < n; i += (size_t)gridDim.x * blockDim.x) bad |= ((p[i] & 0x7f80u) == 0x7f80u);
    if (bad) atomicOr(&flags[stage], 1u);
}
__global__ void k_scan32(const float* p, size_t n, unsigned* flags, int stage) {
    unsigned bad = 0; for (size_t i = (size_t)blockIdx.x * blockDim.x + threadIdx.x; i < n; i += (size_t)gridDim.x * blockDim.x) bad |= ((__float_as_uint(p[i]) & 0x7f800000u) == 0x7f800000u);
    if (bad) atomicOr(&flags[stage], 1u);
}
__global__ void k_dbg_out(const float* x, const float* fg, float* out, const unsigned* flags, int nstage) {
    int code = 0; for (int s = nstage; s >= 1; --s) if (flags[s]) code = s;
    const float f = 1.0f + 0.25f * (float)code;
    const int lane = threadIdx.x & 63; const size_t r = (size_t)blockIdx.x * 4 + (threadIdx.x >> 6);
    const float* xr = x + r * DM; float ss = 0.f;
    for (int c = lane; c < DM; c += 64) ss += xr[c] * xr[c];
    ss = wave_sum(ss); const float rs = rsqrtf(ss / DM + NORM_EPS);
    for (int c = lane; c < DM; c += 64) out[r * DM + c] = xr[c] * rs * fg[c] * f;
}
#endif
extern "C" void kernel_launch(void* const* d_in, const int* in_sizes, int n_in, void* d_out, int out_size, void* d_ws, size_t ws_size, hipStream_t stream) {
    static int grid = 0;
    if (grid == 0) {
        if (n_in != 30 || out_size != NBATCH * SEQ * DM || ws_size < WS_END) { fprintf(stderr, "kernel_launch: shape/workspace mismatch: n_in %d out %d ws %zu (need %zu)\n", n_in, out_size, ws_size, (size_t)WS_END); grid = -1; return; }
        int dev = 0, cus = 0, per_cu = 0;
        if (hipGetDevice(&dev) != hipSuccess || hipDeviceGetAttribute(&cus, hipDeviceAttributeMultiprocessorCount, dev) != hipSuccess) { grid = -1; return; }
        bool okattr = hipFuncSetAttribute((const void*)MAIN_KERNEL, hipFuncAttributeMaxDynamicSharedMemorySize, LDS_BYTES) == hipSuccess;
#if MK_N_LAUNCHES != 1
#ifdef DBG_HYB
        okattr = okattr && hipFuncSetAttribute((const void*)mk_fwd, hipFuncAttributeMaxDynamicSharedMemorySize, LDS_BYTES) == hipSuccess;
#endif
#define SETA(K) okattr = okattr && hipFuncSetAttribute((const void*)k_one<K>, hipFuncAttributeMaxDynamicSharedMemorySize, LDS_BYTES) == hipSuccess
        SETA(0); SETA(1); SETA(2); SETA(3); SETA(4); SETA(5); SETA(6); SETA(7); SETA(8); SETA(9); SETA(10); SETA(11); SETA(12); SETA(13);
#undef SETA
#endif
        if (!okattr) { fprintf(stderr, "kernel_launch: hipFuncSetAttribute failed\n"); grid = -1; return; }
        if (hipOccupancyMaxActiveBlocksPerMultiprocessor(&per_cu, (const void*)MAIN_KERNEL, NTHREADS, LDS_BYTES) != hipSuccess || per_cu < 1) { fprintf(stderr, "kernel_launch: occupancy query says %d blocks per CU\n", per_cu); grid = -1; (void)hipGetLastError(); return; }
        grid = cus;
    }
    if (grid < 0) return;
    if (hipMemsetAsync((char*)d_ws + WS_CTL, 0, CTL_BYTES, stream) != hipSuccess) return;
    Args a{};
    for (int i = 0; i < 30; ++i) a.in[i] = (const float*)d_in[i];
    a.out = (float*)d_out; a.ws = (unsigned char*)d_ws;
#if defined(DBG_PROBE)
    { unsigned* flags = (unsigned*)((char*)d_ws + WS_CTL + 32768);
      hipLaunchKernelGGL(k_probe_mx, dim3(1), dim3(64), 0, stream, flags + 100);
      hipLaunchKernelGGL(k_dbg_out2, dim3(NBATCH * SEQ / 4), dim3(256), 0, stream, (const float*)d_in[0], (const float*)d_in[29], (float*)d_out, flags + 100); }
#elif MK_N_LAUNCHES == 1 && defined(DBG_CHECK)
    {
        unsigned* flags = (unsigned*)((char*)d_ws + WS_CTL + 32768); char* W = (char*)d_ws;
        a.ph_lo = 0; a.ph_hi = (DBG_CHECK == 8) ? 3 : (DBG_CHECK >= 5) ? 7 : (DBG_CHECK == 1 ? 11 : (DBG_CHECK == 2 ? 12 : 13));
        hipLaunchKernelGGL(mk_fwd, dim3(grid), dim3(NTHREADS), LDS_BYTES, stream, a);
#if DBG_CHECK == 8
        hipLaunchKernelGGL(k_check_gemm8, dim3(32), dim3(256), 0, stream, (const unsigned char*)(W + WS_HB), (const float*)d_in[I_WIN], DM, IN_COLS, (const bf16_t*)(W + WS_P), NP, TT, flags + 100);
#elif DBG_CHECK == 5 || DBG_CHECK == 6
        hipLaunchKernelGGL(k_check_attn, dim3(16 * 24), dim3(256), 0, stream, (const unsigned char*)d_ws, DBG_CHECK == 5 ? 1 : 0, flags + 100);
#elif DBG_CHECK == 7
        { float* obuf = (float*)(W + WS_MQ);
          hipLaunchKernelGGL(k_check_gla_rec, dim3(8), dim3(256), 0, stream, (const unsigned char*)d_ws, (const float*)d_in[I_WA2F], (const float*)d_in[I_BAF], (const float*)d_in[I_WA2B], (const float*)d_in[I_BAB], obuf, 0);
          hipLaunchKernelGGL(k_check_gla_cmp, dim3(RPB * 4), dim3(256), 0, stream, (const unsigned char*)d_ws, (const float*)obuf, (const float*)d_in[I_ONG], 0, flags + 100); }
#elif DBG_CHECK == 1
        hipLaunchKernelGGL(k_check_gemm, dim3(32), dim3(256), 0, stream, (const bf16_t*)(W + WS_HB), DM, (const float*)d_in[I_PWQ], DM, DM, (const bf16_t*)(W + WS_PQ), DM, TT, flags + 100);
#elif DBG_CHECK == 2
        hipLaunchKernelGGL(k_check_select, dim3(256 * 8), dim3(64), 0, stream, (const bf16_t*)(W + WS_PQ), (const float*)d_in[I_PK1], (const float*)d_in[I_PK2], (const int*)(W + WS_PIDX), (const float*)(W + WS_PG), flags + 100);
#else
        hipLaunchKernelGGL(k_check_gather, dim3(128), dim3(64), 0, stream, (const bf16_t*)(W + WS_HB), (const float*)d_in[I_PU], (const float*)d_in[I_PV], (const int*)(W + WS_PIDX), (const float*)(W + WS_PG), (const float*)(W + WS_MQ), flags + 100);
#endif
        hipLaunchKernelGGL(k_dbg_out2, dim3(NBATCH * SEQ / 4), dim3(256), 0, stream, (const float*)d_in[0], (const float*)d_in[29], (float*)d_out, flags + 100);
    }
#elif MK_N_LAUNCHES == 1
#ifdef DBG_SPLIT
    for (int p = 0; p < N_PHASES; p += DBG_SPLIT) { a.ph_lo = p; a.ph_hi = p + DBG_SPLIT < N_PHASES ? p + DBG_SPLIT : N_PHASES; hipLaunchKernelGGL(mk_fwd, dim3(grid), dim3(NTHREADS), LDS_BYTES, stream, a); }
#else
    a.ph_lo = 0; a.ph_hi = N_PHASES;
    hipLaunchKernelGGL(mk_fwd, dim3(grid), dim3(NTHREADS), LDS_BYTES, stream, a);
#endif
#else
    a.ph_hi = 0;
#ifndef DBG_NLAUNCH
#define DBG_NLAUNCH 100
#endif
    int nl_ = 0;
#ifdef DBG_HYB
#define LAUNCH1(K, L) do { if (K == DBG_HYB) { a.ph_lo = 12 * (L) + (K); a.ph_hi = a.ph_lo + 1; hipLaunchKernelGGL(mk_fwd, dim3(grid), dim3(NTHREADS), LDS_BYTES, stream, a); a.ph_hi = 0; } else { a.ph_lo = (L); hipLaunchKernelGGL(k_one<K>, dim3(grid), dim3(NTHREADS), LDS_BYTES, stream, a); } } while (0)
#else
#define LAUNCH1(K, L) do { a.ph_lo = (L); if (nl_++ < DBG_NLAUNCH) { hipLaunchKernelGGL(k_one<K>, dim3(grid), dim3(NTHREADS), LDS_BYTES, stream, a); if (K == DBG_DUP) hipLaunchKernelGGL(k_one<K>, dim3(grid), dim3(NTHREADS), LDS_BYTES, stream, a); } } while (0)
#endif
#ifdef DBG_SCAN
    unsigned* flags = (unsigned*)((char*)d_ws + WS_CTL + 32768);
    char* W = (char*)d_ws;
#define S16(off, n, st) hipLaunchKernelGGL(k_scan16, dim3(1024), dim3(256), 0, stream, (const bf16_t*)(W + (off)), (size_t)(n), flags, st)
#define S32(off, n, st) hipLaunchKernelGGL(k_scan32, dim3(1024), dim3(256), 0, stream, (const float*)(W + (off)), (size_t)(n), flags, st)
    LAUNCH1(0, 0); S32(WS_MODV, 2 * 3 * 12288, 1);
    { const int l = 0;
      LAUNCH1(1, l); S16(WS_HB, (size_t)TT * DM, 2);
      LAUNCH1(2, l); S16(WS_P, (size_t)TT * NP, 3);
      LAUNCH1(3, l); S16(WS_P, (size_t)TT * NP, 4);
      LAUNCH1(4, l); S16(WS_MQ, (size_t)TT * 1536, 5); S16(WS_MKV, (size_t)TT * 2048, 5); S16(WS_GST, (size_t)2112 * 32768, 6); S32(WS_GDEC, (size_t)2112 * 128, 6);
      LAUNCH1(5, l); S16(WS_GST, (size_t)2112 * 32768, 7);
      LAUNCH1(6, l); S16(WS_OA, (size_t)TT * 1024, 8); S16(WS_OM, (size_t)TT * 1024, 9); S16(WS_OL, (size_t)TT * 1024, 10);
      LAUNCH1(7, l); S16(WS_Y, (size_t)TT * DM, 11);
      LAUNCH1(8, l); S32(WS_XS, (size_t)TT * DM, 12);
      LAUNCH1(9, l); S16(WS_HB, (size_t)TT * DM, 13);
      LAUNCH1(10, l); S16(WS_PQ, (size_t)TT * DM, 14);
      LAUNCH1(11, l); S32(WS_PG, (size_t)TT * 128, 15);
      LAUNCH1(12, l); S32(WS_XS, (size_t)TT * DM, 16);
    }
    hipLaunchKernelGGL(k_dbg_out, dim3(NBATCH * SEQ / 4), dim3(256), 0, stream, (const float*)d_in[0], (const float*)d_in[29], (float*)d_out, flags, 16);
#elif defined(DBG_CHECK)
    unsigned* flags = (unsigned*)((char*)d_ws + WS_CTL + 32768);
    char* W = (char*)d_ws;
    LAUNCH1(0, 0);
    { const int l = 0; LAUNCH1(1, l); LAUNCH1(2, l); LAUNCH1(3, l); LAUNCH1(4, l); LAUNCH1(5, l); LAUNCH1(6, l);
#if DBG_CHECK == 5 || DBG_CHECK == 6
      hipLaunchKernelGGL(k_check_attn, dim3(16 * 24), dim3(256), 0, stream, (const unsigned char*)d_ws, DBG_CHECK == 5 ? 1 : 0, flags + 100);
#endif
#if DBG_CHECK == 7
      { float* obuf = (float*)(W + WS_MQ);
        hipLaunchKernelGGL(k_check_gla_rec, dim3(8), dim3(256), 0, stream, (const unsigned char*)d_ws, (const float*)d_in[I_WA2F], (const float*)d_in[I_BAF], (const float*)d_in[I_WA2B], (const float*)d_in[I_BAB], obuf, 0);
        hipLaunchKernelGGL(k_check_gla_cmp, dim3(RPB * 4), dim3(256), 0, stream, (const unsigned char*)d_ws, (const float*)obuf, (const float*)d_in[I_ONG], 0, flags + 100); }
#endif
      LAUNCH1(7, l); LAUNCH1(8, l); LAUNCH1(9, l); LAUNCH1(10, l);
#if DBG_CHECK == 1
      hipLaunchKernelGGL(k_check_gemm, dim3(32), dim3(256), 0, stream, (const bf16_t*)(W + WS_HB), DM, (const float*)d_in[I_PWQ], DM, DM, (const bf16_t*)(W + WS_PQ), DM, TT, flags + 100);
#endif
      LAUNCH1(11, l);
#if DBG_CHECK == 2
      hipLaunchKernelGGL(k_check_select, dim3(256 * 8), dim3(64), 0, stream, (const bf16_t*)(W + WS_PQ), (const float*)d_in[I_PK1], (const float*)d_in[I_PK2], (const int*)(W + WS_PIDX), (const float*)(W + WS_PG), flags + 100);
#endif
      LAUNCH1(12, l);
#if DBG_CHECK == 3
      hipLaunchKernelGGL(k_check_gather, dim3(128), dim3(64), 0, stream, (const bf16_t*)(W + WS_HB), (const float*)d_in[I_PU], (const float*)d_in[I_PV], (const int*)(W + WS_PIDX), (const float*)(W + WS_PG), (const float*)(W + WS_MQ), flags + 100);
#endif
    }
    hipLaunchKernelGGL(k_dbg_out2, dim3(NBATCH * SEQ / 4), dim3(256), 0, stream, (const float*)d_in[0], (const float*)d_in[29], (float*)d_out, flags + 100);
#else
    LAUNCH1(0, 0);
    for (int l = 0; l < DEPTH; ++l) { LAUNCH1(1, l); LAUNCH1(2, l); LAUNCH1(3, l);
#ifdef DBG_DUP23
        LAUNCH1(2, l); LAUNCH1(3, l);
#endif
        LAUNCH1(4, l); LAUNCH1(5, l);
#ifdef DBG_DUP45
        LAUNCH1(4, l); LAUNCH1(5, l);
#endif
        LAUNCH1(6, l); LAUNCH1(7, l); LAUNCH1(8, l); LAUNCH1(9, l); LAUNCH1(10, l); LAUNCH1(11, l); LAUNCH1(12, l); }
    LAUNCH1(13, DEPTH - 1);
#endif
#undef LAUNCH1
#endif
    const hipError_t le = hipPeekAtLastError();
    if (le != hipSuccess) fprintf(stderr, "kernel_launch: launch failed: %s\n", hipGetErrorName(le));
}
```

```cpp
#include <hip/hip_runtime.h>
#include <cstdio>
#include <cstdint>

#ifndef MK_N_LAUNCHES
#ifndef DBG_DUP
#define DBG_DUP -1
#endif
#define MK_N_LAUNCHES 1
#endif

#ifndef DBG_MIX0
#define DBG_MIX0 1.0f
#define DBG_MIX1 1.0f
#define DBG_PEER0 1.0f
#define DBG_PEER1 1.0f
#endif
#ifndef MLA_NQR
#define MLA_NQR 4
#endif
#define LAS __attribute__((address_space(3)))
#define GLB __attribute__((address_space(1)))
typedef unsigned short bf16_t;
typedef short bf16x8 __attribute__((ext_vector_type(8)));
typedef short s16x4 __attribute__((ext_vector_type(4)));
typedef float f32x4 __attribute__((ext_vector_type(4)));
typedef float f32x2 __attribute__((ext_vector_type(2)));
typedef float f32x16 __attribute__((ext_vector_type(16)));
typedef unsigned u32x4 __attribute__((ext_vector_type(4)));
typedef unsigned u32x2 __attribute__((ext_vector_type(2)));
typedef __bf16 bf2_t __attribute__((ext_vector_type(2)));

constexpr int DM = 2048, NBATCH = 2, SEQ = 8192, CTXL = 256, DEPTH = 2;
constexpr int RPB = SEQ + CTXL;
constexpr int TT = NBATCH * RPB;
constexpr int IN_COLS = 11872, NP = 12032;
constexpr int C_AQ = 0, C_AK = 1024, C_AV = 1280, C_LQ = 1536, C_LK = 2048, C_LV = 2560, C_LG = 3584, C_LRF = 4608, C_LRB = 4624,
              C_MCQ = 4640, C_MCKV = 5152, C_MKR = 5664, C_GA = 5728, C_GL = 7776, C_GM = 9824;
constexpr int NCH = RPB / 64;
constexpr int NEXP = 16384;
constexpr float NORM_EPS = 1e-6f;
constexpr int NTHREADS = 512;

constexpr size_t al256(size_t x) { return (x + 255) / 256 * 256; }
constexpr size_t WS_CTL   = 0;
constexpr size_t CTL_BYTES = 65536;
constexpr size_t WS_MODV  = WS_CTL + CTL_BYTES;
constexpr size_t WS_TABA  = al256(WS_MODV + (size_t)2 * 3 * 12288 * 4);
constexpr size_t WS_TABM  = WS_TABA + 2 * 128 * 32 * 4;
constexpr size_t WS_XS    = al256(WS_TABM + 2 * 128 * 16 * 4);
constexpr size_t WS_HB    = WS_XS + (size_t)TT * DM * 4;
constexpr size_t WS_P     = WS_HB + (size_t)TT * DM * 2;
constexpr size_t WS_MQ    = WS_P + (size_t)TT * NP * 2;
constexpr size_t WS_MKV   = WS_MQ + (size_t)TT * 1536 * 2;
constexpr size_t WS_OA    = WS_MKV + (size_t)TT * 2048 * 2;
constexpr size_t WS_OL    = WS_OA + (size_t)TT * 1024 * 2;
constexpr size_t WS_OM    = WS_OL + (size_t)TT * 1024 * 2;
constexpr size_t WS_WIN   = WS_OM + (size_t)TT * 1024 * 2;
constexpr size_t WS_WUQ   = WS_WIN + (size_t)NP * 2048 * 2;
constexpr size_t WS_WUKV  = WS_WUQ + (size_t)1536 * 512 * 2;
constexpr size_t WS_WBR   = WS_WUKV + (size_t)2048 * 512 * 2;
constexpr size_t WS_WOUT  = WS_WBR + (size_t)3 * 2048 * 1024 * 2;
constexpr size_t WS_WQ    = WS_WOUT + (size_t)2048 * 2048 * 2;
constexpr size_t WS_K1    = WS_WQ + (size_t)2048 * 2048 * 2;
constexpr size_t WS_K2    = WS_K1 + (size_t)8 * 128 * 128 * 2;
constexpr size_t WS_GST   = WS_K2 + (size_t)8 * 128 * 128 * 2;
constexpr size_t WS_GDEC  = WS_GST + (size_t)NBATCH * 2 * 4 * NCH * 32768 * 2;
constexpr size_t WS_END0  = WS_GDEC + (size_t)NBATCH * 2 * 4 * NCH * 128 * 4;
constexpr size_t WS_KN8   = WS_OA + (size_t)TT * 1024;
constexpr size_t WS_AK8   = WS_OL + (size_t)TT * 1024;
constexpr size_t WS_KR8   = WS_AK8 + (size_t)TT * 256;
constexpr size_t WS_VT8A  = WS_KR8 + (size_t)TT * 64;
constexpr size_t WS_VT8M  = WS_OM + (size_t)TT * 1024;
constexpr size_t WS_Y     = WS_MKV;
constexpr size_t WS_PQ    = WS_OA;
constexpr size_t WS_PIDX  = WS_P;
constexpr size_t WS_PG    = WS_PIDX + (size_t)TT * 128 * 4;
constexpr size_t PT_BYTES = 2 * (size_t)NEXP * DM + 2 * (size_t)NEXP * 4;
constexpr size_t WS_WINS  = WS_END0;
constexpr size_t WS_WOUTS = al256(WS_WINS + (size_t)NP * 4);
constexpr size_t WS_WBRS  = al256(WS_WOUTS + (size_t)DM * 4);
constexpr size_t WS_PT    = al256(WS_WBRS + (size_t)3 * DM * 4);
constexpr size_t WS_END   = WS_PT + DEPTH * PT_BYTES;
constexpr size_t PT_U8 = 0, PT_V8 = (size_t)NEXP * DM, PT_SCU = 2 * (size_t)NEXP * DM, PT_SCV = PT_SCU + (size_t)NEXP * 4;
static_assert(WS_PG + (size_t)TT * 128 * 4 <= WS_MQ, "PEER alias region overflows P");

__device__ __forceinline__ unsigned cvt_pk_bf16(float lo, float hi) { bf2_t v; v.x = (__bf16)lo; v.y = (__bf16)hi; return __builtin_bit_cast(unsigned, v); }
__device__ __forceinline__ bf16_t f2bf(float f) { return (bf16_t)(cvt_pk_bf16(f, 0.f) & 0xffffu); }
__device__ __forceinline__ float bf2f(bf16_t b) { return __uint_as_float(((unsigned)b) << 16); }
__device__ __forceinline__ float bflo(unsigned w) { return __uint_as_float(w << 16); }
__device__ __forceinline__ float bfhi(unsigned w) { return __uint_as_float(w & 0xffff0000u); }
__device__ __forceinline__ float xchg32(float x, int lane) { auto r = __builtin_amdgcn_permlane32_swap(__float_as_uint(x), __float_as_uint(x), false, false); return __uint_as_float(lane < 32 ? r[1] : r[0]); }
__device__ __forceinline__ float xchg16(float x, int lane) { auto r = __builtin_amdgcn_permlane16_swap(__float_as_uint(x), __float_as_uint(x), false, false); return __uint_as_float((lane & 16) ? r[0] : r[1]); }
template <int CTRL> __device__ __forceinline__ float dppmov(float x) { return __uint_as_float(__builtin_amdgcn_update_dpp(0u, __float_as_uint(x), CTRL, 0xF, 0xF, false)); }
constexpr int DPP_ROR8 = 0x128, DPP_HMIRROR = 0x141, DPP_Q3210 = 0x1B, DPP_Q1032 = 0xB1;
__device__ __forceinline__ float wave_sum(float v) {
    const int lane = threadIdx.x & 63;
    v += xchg32(v, lane); v += xchg16(v, lane); v += dppmov<DPP_ROR8>(v); v += dppmov<DPP_HMIRROR>(v); v += dppmov<DPP_Q3210>(v); v += dppmov<DPP_Q1032>(v);
    return v;
}
__device__ __forceinline__ float sigmoidf_(float x) { return __builtin_amdgcn_rcpf(1.0f + __expf(-x)); }
__device__ __forceinline__ float siluf_(float x) { return x * __builtin_amdgcn_rcpf(1.0f + __expf(-x)); }

#define XB_TMO      128
#define XB_XCNT(j)  (256  + 64 * (j))
#define XB_XSUB(j)  (1280 + 64 * (j))
#define XB_XGEN(j)  (2304 + 64 * (j))
#define XB_TOP      3328
#define XB_TOPGEN   3392
#define XCD_BAR_WORDS 3456
#define XB_SPIN_CAP (1u << 20)
__device__ __forceinline__ unsigned xb_ld(unsigned* p)              { return __hip_atomic_load(p, __ATOMIC_RELAXED, __HIP_MEMORY_SCOPE_AGENT); }
__device__ __forceinline__ unsigned xb_add(unsigned* p, unsigned v) { return __hip_atomic_fetch_add(p, v, __ATOMIC_RELAXED, __HIP_MEMORY_SCOPE_AGENT); }
__device__ __forceinline__ unsigned xb_xcc_id() { return (unsigned)__builtin_amdgcn_s_getreg((3 << 11) | 20) & 0xFu; }
#define XB_SPIN(cond, bar) do { unsigned _sp = 0; while (cond) { __builtin_amdgcn_s_sleep(1); \
    if ((++_sp & 255u) == 0u) { if (xb_ld(&(bar)[XB_TMO])) break; if (_sp > XB_SPIN_CAP) { atomicAdd(&(bar)[XB_TMO], 1u); break; } } } } while (0)
struct XcdBarrier { unsigned* bar; unsigned x; volatile LAS unsigned* st; };
__device__ __forceinline__ XcdBarrier xcd_barrier_post(unsigned* bar, volatile LAS unsigned* st) {
    XcdBarrier b; b.bar = bar; b.x = xb_xcc_id(); b.st = st;
    if (threadIdx.x == 0) (void)xb_add(&bar[XB_XCNT(b.x)], 1u);
    return b;
}
__device__ __forceinline__ void xcd_barrier_complete(unsigned* bar, unsigned x, unsigned& nloc, unsigned& nx) {
    const unsigned G = gridDim.x * gridDim.y * gridDim.z;
    unsigned sum, cnt, mine, sp = 0u;
    for (;;) {
        sum = 0u; cnt = 0u; mine = 0u;
#pragma unroll
        for (unsigned j = 0; j < 16; ++j) { const unsigned c = xb_ld(&bar[XB_XCNT(j)]); sum += c; cnt += (c > 0u) ? 1u : 0u; mine = (j == x) ? c : mine; }
        if (sum == G) break;
        __builtin_amdgcn_s_sleep(1);
        if ((++sp & 255u) == 0u) { if (xb_ld(&bar[XB_TMO])) break; if (sp > XB_SPIN_CAP) { atomicAdd(&bar[XB_TMO], 1u); break; } }
    }
    nloc = mine > 0u ? mine : 1u; nx = cnt > 0u ? cnt : 1u;
}
__device__ __forceinline__ void xcd_barrier(const XcdBarrier& b) {
    asm volatile("s_waitcnt vmcnt(0)" ::: "memory");
    __syncthreads();
    if (threadIdx.x == 0) {
        unsigned* bar = b.bar;
        __builtin_amdgcn_s_waitcnt(0);
        unsigned nloc = b.st[0], nx = b.st[1];
        if (nloc == 0u) { xcd_barrier_complete(bar, b.x, nloc, nx); b.st[0] = nloc; b.st[1] = nx; }
        const unsigned old = xb_add(&bar[XB_XSUB(b.x)], 1u);
        const unsigned gen = old / nloc;
        if (old + 1u == (gen + 1u) * nloc) {
            __builtin_amdgcn_fence(__ATOMIC_RELEASE, "agent");
            asm volatile("s_waitcnt vmcnt(0)" ::: "memory");
            const unsigned og = xb_add(&bar[XB_TOP], 1u);
            const unsigned tg = og / nx;
            if (og + 1u == (tg + 1u) * nx) xb_add(&bar[XB_TOPGEN], 1u);
            else XB_SPIN(xb_ld(&bar[XB_TOPGEN]) == tg, bar);
            __builtin_amdgcn_fence(__ATOMIC_ACQUIRE, "agent");
            xb_add(&bar[XB_XGEN(b.x)], 1u);
            asm volatile("s_waitcnt vmcnt(0)" ::: "memory");
        } else {
            XB_SPIN(xb_ld(&bar[XB_XGEN(b.x)]) == gen, bar);
            __builtin_amdgcn_fence(__ATOMIC_ACQUIRE, "agent");
            asm volatile("s_waitcnt vmcnt(0)" ::: "memory");
        }
    }
    __syncthreads();
}

namespace pg8 {
constexpr int BM = 256, BK = 64, HALF = 128, HTB = HALF * BK * 2, STAGE_BYTES = 8 * HTB, NXCD = 8, WGM = 8;
__host__ __device__ __forceinline__ int lds_byte(int r, int c) { const int st = (r >> 4) * 2 + (c >> 5), rr = r & 15, cc = c & 31, ob = rr * 64 + cc * 2; return st * 1024 + (ob ^ (((ob >> 9) & 1) << 5)); }
__host__ __device__ __forceinline__ void stage_rc(int b, int& R, int& C) { const int st = b / 1024, sb = b % 1024, swz = sb ^ (((sb >> 9) & 1) << 5); R = (st >> 1) * 16 + swz / 64; C = (st & 1) * 32 + (swz % 64) / 2; }
__host__ __device__ __forceinline__ int perm32(int rho) { const int n = rho >> 4, i = rho & 15; return 8 * (i >> 2) + 4 * n + (i & 3); }
struct Unit { int pm, pn; };
struct Gemm { const bf16_t* A; const bf16_t* Bt; int M, N, K, lda, ldb; };
struct StaticOrder {
    int nM, nN, nwg, G, c, latent;
    __host__ __device__ void init(int M, int N, int G_, int c_, int latent_ = 0) { latent = latent_; nM = latent_ ? 64 : M / BM; nN = N / BM; nwg = nM * nN; G = G_; c = c_; }
    __host__ __device__ bool next(int i, Unit& u) const {
        const long L = (long)i * G + c; if (L >= nwg) return false;
        int wgid = (int)L; { const int q = nwg / NXCD, r = nwg % NXCD, xcd = wgid % NXCD, off = wgid / NXCD; wgid = (xcd < r ? xcd * (q + 1) : r * (q + 1) + (xcd - r) * q) + off; }
        const int nig = WGM * nN, gid = wgid / nig, fm = gid * WGM, gsz = (nM - fm) < WGM ? (nM - fm) : WGM;
        u.pm = fm + ((wgid % nig) % gsz); u.pn = (wgid % nig) / gsz; if (latent) u.pm += 1 + (u.pm >= 32 ? 1 : 0); return true;
    }
};
struct WinOrder {
    StaticOrder S; int full, nlat, G, c;
    __host__ __device__ void init(int G_, int c_, int full_) { full = full_; G = G_; c = c_; S.init(TT, NP, G_, c_, full_ ? 0 : 1); nlat = S.nwg; }
    __host__ __device__ bool next(int i, Unit& u) const {
        if (full) return S.next(i, u);
        const long L = (long)i * G + c;
        if (L < nlat) return S.next(i, u);
        const int q = (int)(L - nlat); if (q >= 24) return false;
        const int t = q % 12; u.pm = q < 12 ? 0 : 33;
        u.pn = t < 2 ? 4 + t : (t < 8 ? 8 + (t - 2) : (t == 8 ? 18 : 20 + (t - 9)));
        return true;
    }
};
struct EpiStoreBf16 {
    static constexpr bool PERM = true;
    bf16_t* O; int ldc;
    __device__ __forceinline__ void operator()(const f32x4 (&acc)[2][2][4][2], const Unit& u, int wr, int wc, int fr, int fq) const {
        const int row0 = u.pm * BM + wr * 64 + fr, col0 = u.pn * BM + wc * 32 + 8 * fq;
#pragma unroll
        for (int ai = 0; ai < 2; ++ai)
#pragma unroll
            for (int m = 0; m < 4; ++m) { bf16_t* rowp = O + (size_t)(row0 + ai * HALF + m * 16) * ldc + col0;
#pragma unroll
                for (int bj = 0; bj < 2; ++bj) { const f32x4 v0 = acc[ai][bj][m][0], v1 = acc[ai][bj][m][1];
                    u32x4 w; w.x = cvt_pk_bf16(v0[0], v0[1]); w.y = cvt_pk_bf16(v0[2], v0[3]); w.z = cvt_pk_bf16(v1[0], v1[1]); w.w = cvt_pk_bf16(v1[2], v1[3]);
                    *(u32x4*)(rowp + bj * HALF) = w; } }
    }
};
struct EpiNull {
    static constexpr bool PERM = true;
    __device__ __forceinline__ void operator()(const f32x4 (&acc)[2][2][4][2], const Unit&, int, int, int, int) const {
#pragma unroll
        for (int a = 0; a < 2; ++a)
#pragma unroll
            for (int b = 0; b < 2; ++b)
#pragma unroll
                for (int m = 0; m < 4; ++m)
#pragma unroll
                    for (int n = 0; n < 2; ++n) asm volatile("" :: "v"(acc[a][b][m][n]));
    }
};
struct EpiStoreMKV {
    static constexpr bool PERM = true;
    bf16_t* O; unsigned char* K8;
    __device__ __forceinline__ void operator()(const f32x4 (&acc)[2][2][4][2], const Unit& u, int wr, int wc, int fr, int fq) const {
        const int row0 = u.pm * BM + wr * 64 + fr, col0 = u.pn * BM + wc * 32 + 8 * fq;
#pragma unroll
        for (int ai = 0; ai < 2; ++ai)
#pragma unroll
            for (int m = 0; m < 4; ++m) { const size_t r = (size_t)(row0 + ai * HALF + m * 16); bf16_t* rowp = O + r * 2048 + col0;
#pragma unroll
                for (int bj = 0; bj < 2; ++bj) { const f32x4 v0 = acc[ai][bj][m][0], v1 = acc[ai][bj][m][1];
                    u32x4 w; w.x = cvt_pk_bf16(v0[0], v0[1]); w.y = cvt_pk_bf16(v0[2], v0[3]); w.z = cvt_pk_bf16(v1[0], v1[1]); w.w = cvt_pk_bf16(v1[2], v1[3]);
                    *(u32x4*)(rowp + bj * HALF) = w;
                    if (bj == 0) { int p0 = __builtin_amdgcn_cvt_pk_fp8_f32(v0[0], v0[1], 0, false); p0 = __builtin_amdgcn_cvt_pk_fp8_f32(v0[2], v0[3], p0, true);
                        int p1 = __builtin_amdgcn_cvt_pk_fp8_f32(v1[0], v1[1], 0, false); p1 = __builtin_amdgcn_cvt_pk_fp8_f32(v1[2], v1[3], p1, true);
                        u32x2 w8; w8.x = (unsigned)p0; w8.y = (unsigned)p1; *(u32x2*)(K8 + r * 1024 + u.pn * 128 + wc * 32 + 8 * fq) = w8; } } }
    }
};
struct EpiStoreBf16S {
    static constexpr bool PERM = true;
    bf16_t* O; int ldc; const float* cs;
    __device__ __forceinline__ void operator()(const f32x4 (&acc)[2][2][4][2], const Unit& u, int wr, int wc, int fr, int fq) const {
        const int row0 = u.pm * BM + wr * 64 + fr, col0 = u.pn * BM + wc * 32 + 8 * fq;
        f32x4 sv[2][2];
#pragma unroll
        for (int bj = 0; bj < 2; ++bj)
#pragma unroll
            for (int n = 0; n < 2; ++n) sv[bj][n] = *(const f32x4*)(cs + col0 + bj * HALF + 4 * n);
#pragma unroll
        for (int ai = 0; ai < 2; ++ai)
#pragma unroll
            for (int m = 0; m < 4; ++m) { bf16_t* rowp = O + (size_t)(row0 + ai * HALF + m * 16) * ldc + col0;
#pragma unroll
                for (int bj = 0; bj < 2; ++bj) { const f32x4 v0 = acc[ai][bj][m][0] * sv[bj][0], v1 = acc[ai][bj][m][1] * sv[bj][1];
                    u32x4 w; w.x = cvt_pk_bf16(v0[0], v0[1]); w.y = cvt_pk_bf16(v0[2], v0[3]); w.z = cvt_pk_bf16(v1[0], v1[1]); w.w = cvt_pk_bf16(v1[2], v1[3]);
                    *(u32x4*)(rowp + bj * HALF) = w; } }
    }
};
template <bool FIRST, bool F8OUT = false> struct EpiGate {
    static constexpr bool PERM = true;
    bf16_t* Y; const bf16_t* Gt; unsigned char* Y8; const float* cs;
    __device__ __forceinline__ void operator()(const f32x4 (&acc)[2][2][4][2], const Unit& u, int wr, int wc, int fr, int fq) const {
        constexpr int ldy = DM, ldg = NP, ldy8 = DM;
        const int row0 = u.pm * BM + wr * 64 + fr, col0 = u.pn * BM + wc * 32 + 8 * fq;
        f32x4 sv[2][2];
#pragma unroll
        for (int bj = 0; bj < 2; ++bj)
#pragma unroll
            for (int n = 0; n < 2; ++n) sv[bj][n] = *(const f32x4*)(cs + col0 + bj * HALF + 4 * n);
#pragma unroll
        for (int ai = 0; ai < 2; ++ai)
#pragma unroll
        for (int mh = 0; mh < 2; ++mh) {
            u32x4 g[2][2], y[2][2];
#pragma unroll
            for (int mm = 0; mm < 2; ++mm)
#pragma unroll
                for (int bj = 0; bj < 2; ++bj) { const size_t r = (size_t)(row0 + ai * HALF + (mh * 2 + mm) * 16);
                    g[mm][bj] = *(const u32x4*)(Gt + r * ldg + col0 + bj * HALF);
                    if (!FIRST) y[mm][bj] = *(const u32x4*)(Y + r * ldy + col0 + bj * HALF); }
#pragma unroll
            for (int mm = 0; mm < 2; ++mm)
#pragma unroll
                for (int bj = 0; bj < 2; ++bj) { const int m = mh * 2 + mm; const size_t r = (size_t)(row0 + ai * HALF + m * 16); const f32x4 v0 = acc[ai][bj][m][0] * sv[bj][0], v1 = acc[ai][bj][m][1] * sv[bj][1]; const u32x4 gg = g[mm][bj];
                    float o[8];
                    o[0] = sigmoidf_(bflo(gg.x)) * v0[0]; o[1] = sigmoidf_(bfhi(gg.x)) * v0[1]; o[2] = sigmoidf_(bflo(gg.y)) * v0[2]; o[3] = sigmoidf_(bfhi(gg.y)) * v0[3];
                    o[4] = sigmoidf_(bflo(gg.z)) * v1[0]; o[5] = sigmoidf_(bfhi(gg.z)) * v1[1]; o[6] = sigmoidf_(bflo(gg.w)) * v1[2]; o[7] = sigmoidf_(bfhi(gg.w)) * v1[3];
                    if (!FIRST) { const u32x4 yy = y[mm][bj];
                        o[0] += bflo(yy.x); o[1] += bfhi(yy.x); o[2] += bflo(yy.y); o[3] += bfhi(yy.y); o[4] += bflo(yy.z); o[5] += bfhi(yy.z); o[6] += bflo(yy.w); o[7] += bfhi(yy.w); }
                    if constexpr (F8OUT) { int p0 = __builtin_amdgcn_cvt_pk_fp8_f32(o[0], o[1], 0, false); p0 = __builtin_amdgcn_cvt_pk_fp8_f32(o[2], o[3], p0, true);
                        int p1 = __builtin_amdgcn_cvt_pk_fp8_f32(o[4], o[5], 0, false); p1 = __builtin_amdgcn_cvt_pk_fp8_f32(o[6], o[7], p1, true);
                        u32x2 w8; w8.x = (unsigned)p0; w8.y = (unsigned)p1; *(u32x2*)(Y8 + r * ldy8 + col0 + bj * HALF) = w8; }
                    else { u32x4 w; w.x = cvt_pk_bf16(o[0], o[1]); w.y = cvt_pk_bf16(o[2], o[3]); w.z = cvt_pk_bf16(o[4], o[5]); w.w = cvt_pk_bf16(o[6], o[7]);
                        *(u32x4*)(Y + r * ldy + col0 + bj * HALF) = w; } }
        }
    }
};
template <bool CS> struct EpiResidT {
    static constexpr bool PERM = false;
    float* X; int ldx; const float* gate; const float* cs;
    __device__ __forceinline__ void operator()(const f32x4 (&acc)[2][2][4][2], const Unit& u, int wr, int wc, int fr, int fq) const {
        const int row0 = u.pm * BM + wr * 64 + fr, col0 = u.pn * BM + wc * 32 + 4 * fq;
        const int sel = (u.pm % 33 == 0) ? 2 : (u.pm / 33);
        const float* gp = gate + (size_t)sel * 12288 + col0;
        f32x4 gv[2][2];
#pragma unroll
        for (int bj = 0; bj < 2; ++bj)
#pragma unroll
            for (int n = 0; n < 2; ++n) { gv[bj][n] = *(const f32x4*)(gp + bj * HALF + n * 16); if constexpr (CS) gv[bj][n] = gv[bj][n] * *(const f32x4*)(cs + col0 + bj * HALF + n * 16); }
#pragma unroll
        for (int ai = 0; ai < 2; ++ai)
#pragma unroll
            for (int mh = 0; mh < 2; ++mh) {
                f32x4 x[2][2][2];
#pragma unroll
                for (int mm = 0; mm < 2; ++mm)
#pragma unroll
                    for (int bj = 0; bj < 2; ++bj)
#pragma unroll
                        for (int n = 0; n < 2; ++n) x[mm][bj][n] = *(const f32x4*)(X + (size_t)(row0 + ai * HALF + (mh * 2 + mm) * 16) * ldx + col0 + bj * HALF + n * 16);
#pragma unroll
                for (int mm = 0; mm < 2; ++mm)
#pragma unroll
                    for (int bj = 0; bj < 2; ++bj)
#pragma unroll
                        for (int n = 0; n < 2; ++n) *(f32x4*)(X + (size_t)(row0 + ai * HALF + (mh * 2 + mm) * 16) * ldx + col0 + bj * HALF + n * 16) = x[mm][bj][n] + gv[bj][n] * acc[ai][bj][mh * 2 + mm][n];
            }
    }
};

typedef int i32x8 __attribute__((ext_vector_type(8)));
typedef int i32x4 __attribute__((ext_vector_type(4)));
__device__ __forceinline__ i32x8 cat8(const bf16x8 lo, const bf16x8 hi) { const i32x4 a = __builtin_bit_cast(i32x4, lo), b = __builtin_bit_cast(i32x4, hi); return __builtin_shufflevector(a, b, 0, 1, 2, 3, 4, 5, 6, 7); }
template <class Epi, class Sched, int F8 = 0>
__device__ __forceinline__ void gemm_phase(LAS unsigned char* lds, const int tid, const Gemm g, const Sched& S, const Epi& E) {
    const int wid = __builtin_amdgcn_readfirstlane(tid >> 6), lane = tid & 63, wr = wid >> 2, wc = wid & 3, fr = lane & 15, fq = lane >> 4;
    const int K = g.K, nt = F8 ? K / 128 : K / BK, lda = g.lda, ldb = g.ldb;
    unsigned voffA[2], voffB[2];
#pragma unroll
    for (int i = 0; i < 2; ++i) { int R, C; stage_rc(tid * 16 + i * 8192, R, C); const int Rb = Epi::PERM ? ((R & ~31) + perm32(R & 31)) : R;
        voffA[i] = F8 ? (unsigned)(R * lda + C * 2) : (unsigned)(R * lda + C) * 2u; voffB[i] = F8 ? (unsigned)(Rb * ldb + C * 2) : (unsigned)(Rb * ldb + C) * 2u; }
    const size_t kstep = (size_t)(BK * 2);
    const size_t hstepA = (size_t)HALF * lda * (F8 ? 1 : 2), hstepB = (size_t)HALF * ldb * (F8 ? 1 : 2);
    const size_t tstepA = 2 * hstepA, tstepB = 2 * hstepB;
    const unsigned ldsw = (unsigned)wid * 1024u;
    const int aoff = F8 ? lds_byte(wr * 64 + fr, (fq & 1) * 16) + (fq >> 1) * 1024 : lds_byte(wr * 64 + fr, fq * 8);
    const int boff = F8 ? lds_byte(wc * 32 + fr, (fq & 1) * 16) + (fq >> 1) * 1024 : lds_byte(wc * 32 + fr, fq * 8);
#define PG8_SA(b, h) (((b) * 2 + (h)) * HTB)
#define PG8_SB(b, h) ((4 + (b) * 2 + (h)) * HTB)
#define PG8_STAGE(bufoff, gbase, voff) do { _Pragma("unroll") for (int _i = 0; _i < 2; ++_i) \
        __builtin_amdgcn_global_load_lds((const unsigned*)((const char*)(gbase) + (voff)[_i]), (LAS unsigned*)(lds + (bufoff) + ldsw + _i * 8192), 16, 0, 0); } while (0)
#define PG8_LDA(dst, b, h) do { if constexpr (F8) { _Pragma("unroll") for (int m = 0; m < 4; ++m) { const LAS unsigned char* p_ = lds + PG8_SA(b, h) + aoff + m * 2048; \
            const i32x4 lo_ = *(const LAS i32x4*)p_, hi_ = *(const LAS i32x4*)(p_ + 16); dst##8[m] = __builtin_shufflevector(lo_, hi_, 0, 1, 2, 3, 4, 5, 6, 7); } } \
        else { _Pragma("unroll") for (int m = 0; m < 4; ++m) _Pragma("unroll") for (int k = 0; k < 2; ++k) dst[m][k] = *(const LAS bf16x8*)(lds + PG8_SA(b, h) + aoff + m * 2048 + k * 1024); } } while (0)
#define PG8_LDB(dst, b, h) do { if constexpr (F8) { _Pragma("unroll") for (int n = 0; n < 2; ++n) { const LAS unsigned char* p_ = lds + PG8_SB(b, h) + boff + n * 2048; \
            const i32x4 lo_ = *(const LAS i32x4*)p_, hi_ = *(const LAS i32x4*)(p_ + 16); dst##8[n] = __builtin_shufflevector(lo_, hi_, 0, 1, 2, 3, 4, 5, 6, 7); } } \
        else { _Pragma("unroll") for (int n = 0; n < 2; ++n) _Pragma("unroll") for (int k = 0; k < 2; ++k) dst[n][k] = *(const LAS bf16x8*)(lds + PG8_SB(b, h) + boff + n * 2048 + k * 1024); } } while (0)
#define PG8_MMA(ai, bj, At, Bt) do { __builtin_amdgcn_s_setprio(1); \
        if constexpr (F8) { _Pragma("unroll") for (int m = 0; m < 4; ++m) _Pragma("unroll") for (int n = 0; n < 2; ++n) \
            asm volatile("v_mfma_scale_f32_16x16x128_f8f6f4 %0, %1, %2, %0, %3, %3 op_sel_hi:[0,0,0]" : "+v"(acc[ai][bj][m][n]) : "v"(Bt##8[n]), "v"(At##8[m]), "v"(mxscale)); } \
        else { _Pragma("unroll") for (int m = 0; m < 4; ++m) _Pragma("unroll") for (int n = 0; n < 2; ++n) _Pragma("unroll") for (int k = 0; k < 2; ++k) \
            acc[ai][bj][m][n] = __builtin_amdgcn_mfma_f32_16x16x32_bf16(Bt[n][k], At[m][k], acc[ai][bj][m][n], 0, 0, 0); } \
        __builtin_amdgcn_s_setprio(0); } while (0)
#define PG8_WAIT_V(n) asm volatile("s_waitcnt vmcnt(" #n ")" ::: "memory")
#define PG8_WAIT_L(n) asm volatile("s_waitcnt lgkmcnt(" #n ")" ::: "memory")
#define PG8_BAR __builtin_amdgcn_s_barrier()
#define PG8_SCHED __builtin_amdgcn_sched_barrier(0)
    Unit cur, nxt; int ui = 0;
    if (!S.next(0, cur)) return;
    f32x4 acc[2][2][4][2];
#pragma unroll
    for (int a = 0; a < 2; ++a)
#pragma unroll
        for (int b = 0; b < 2; ++b)
#pragma unroll
            for (int m = 0; m < 4; ++m)
#pragma unroll
                for (int n = 0; n < 2; ++n) acc[a][b][m][n] = (f32x4){0.f, 0.f, 0.f, 0.f};
    int mxscale = 0x7f7f7f7f; asm volatile("" : "+v"(mxscale));
    bf16x8 At[4][2], B0[2][2], B1[2][2]; i32x8 At8[4], B08[2], B18[2];
    const char* cA = (const char*)g.A + (size_t)cur.pm * tstepA; const char* cB = (const char*)g.Bt + (size_t)cur.pn * tstepB;
    PG8_STAGE(PG8_SB(0, 0), cB, voffB); PG8_STAGE(PG8_SA(0, 0), cA, voffA); PG8_STAGE(PG8_SB(0, 1), cB + hstepB, voffB); PG8_STAGE(PG8_SA(0, 1), cA + hstepA, voffA);
    if (wr == 1) PG8_BAR;
    PG8_WAIT_V(4); PG8_BAR;
    PG8_STAGE(PG8_SB(1, 0), cB + kstep, voffB); PG8_STAGE(PG8_SA(1, 0), cA + kstep, voffA); PG8_STAGE(PG8_SB(1, 1), cB + hstepB + kstep, voffB);
    PG8_WAIT_V(6); PG8_BAR;
    for (;;) {
        const bool has_next = S.next(ui + 1, nxt);
        const char* nA = has_next ? (const char*)g.A + (size_t)nxt.pm * tstepA : cA; const char* nB = has_next ? (const char*)g.Bt + (size_t)nxt.pn * tstepB : cB;
        for (int t = 0; t < nt; t += 2) {
            const bool last = (t == nt - 2);
            const char* a1 = cA + (size_t)(t + 1) * kstep;
            const char* a2 = last ? nA : cA + (size_t)(t + 2) * kstep; const char* b2 = last ? nB : cB + (size_t)(t + 2) * kstep;
            const char* a3 = a2 + kstep; const char* b3 = b2 + kstep;
            PG8_LDB(B0, 0, 0); PG8_SCHED; PG8_LDA(At, 0, 0); PG8_STAGE(PG8_SA(1, 1), a1 + hstepA, voffA);
            PG8_WAIT_L(8); PG8_BAR; PG8_WAIT_L(0); PG8_MMA(0, 0, At, B0); PG8_BAR; PG8_SCHED;
            PG8_LDB(B1, 0, 1); PG8_STAGE(PG8_SB(0, 0), b2, voffB);
            PG8_BAR; PG8_WAIT_L(0); PG8_MMA(0, 1, At, B1); PG8_BAR;
            PG8_LDA(At, 0, 1); PG8_STAGE(PG8_SA(0, 0), a2, voffA);
            PG8_BAR; PG8_WAIT_L(0); PG8_MMA(1, 0, At, B0); PG8_BAR; PG8_SCHED;
            PG8_STAGE(PG8_SB(0, 1), b2 + hstepB, voffB);
            PG8_WAIT_V(6); PG8_BAR; PG8_MMA(1, 1, At, B1); PG8_BAR;
            PG8_LDB(B0, 1, 0); PG8_SCHED; PG8_LDA(At, 1, 0); PG8_STAGE(PG8_SA(0, 1), a2 + hstepA, voffA);
            PG8_WAIT_L(8); PG8_BAR; PG8_WAIT_L(0); PG8_MMA(0, 0, At, B0); PG8_BAR; PG8_SCHED;
            PG8_LDB(B1, 1, 1); PG8_STAGE(PG8_SB(1, 0), b3, voffB);
            PG8_BAR; PG8_WAIT_L(0); PG8_MMA(0, 1, At, B1); PG8_BAR;
            PG8_LDA(At, 1, 1); PG8_STAGE(PG8_SA(1, 0), a3, voffA);
            PG8_BAR; PG8_WAIT_L(0); PG8_MMA(1, 0, At, B0); PG8_BAR; PG8_SCHED;
            PG8_STAGE(PG8_SB(1, 1), b3 + hstepB, voffB);
            PG8_WAIT_V(6); PG8_BAR; PG8_MMA(1, 1, At, B1); PG8_BAR;
        }
        if constexpr (F8) asm volatile("s_nop 15\n\ts_nop 7");
        E(acc, cur, wr, wc, fr, fq);
        if (!has_next) break;
#pragma unroll
        for (int a = 0; a < 2; ++a)
#pragma unroll
            for (int b = 0; b < 2; ++b)
#pragma unroll
                for (int m = 0; m < 4; ++m)
#pragma unroll
                    for (int n = 0; n < 2; ++n) acc[a][b][m][n] = (f32x4){0.f, 0.f, 0.f, 0.f};
        cur = nxt; cA = nA; cB = nB; ++ui;
    }
    PG8_WAIT_V(0);
    if (wr == 0) PG8_BAR;
    PG8_BAR;
#undef PG8_SA
#undef PG8_SB
#undef PG8_STAGE
#undef PG8_LDA
#undef PG8_LDB
#undef PG8_MMA
#undef PG8_WAIT_V
#undef PG8_WAIT_L
#undef PG8_BAR
#undef PG8_SCHED
}
}

struct Args { const float* in[30]; float* out; unsigned char* ws; int ph_lo, ph_hi; };
enum { I_X = 0, I_C, I_CTX, I_CCTX, I_WMOD, I_BMOD, I_N1G, I_WIN, I_QNG, I_KNG, I_WA2F, I_BAF, I_WA2B, I_BAB, I_ONG, I_MQNG, I_WUQ, I_MKVNG, I_WUKV,
       I_WBRA, I_WBRL, I_WBRM, I_WOUT, I_N2G, I_PWQ, I_PK1, I_PK2, I_PU, I_PV, I_FG };
typedef const float* cfp_t;
struct Ctx {
    const __attribute__((address_space(4))) cfp_t* in; float* out; unsigned char* ws; LAS unsigned char* lds;
    int tid, lane, wid, G, bid;
};
#define WSP(T, off) ((T*)(C.ws + (off)))
#define INP(i) ((const float*)(const GLB float*)C.in[(i)])
__device__ __forceinline__ unsigned long long launder_u64(unsigned long long w) {
    unsigned lo = (unsigned)w, hi = (unsigned)(w >> 32); asm volatile("" : "+v"(lo), "+v"(hi));
    lo = __builtin_amdgcn_readfirstlane(lo); hi = __builtin_amdgcn_readfirstlane(hi); return ((unsigned long long)hi << 32) | lo;
}
__device__ __forceinline__ Ctx launder(const Ctx& C0) {
    Ctx R = C0; int t = C0.tid; asm volatile("" : "+v"(t)); R.tid = t; R.lane = t & 63; R.wid = __builtin_amdgcn_readfirstlane(t >> 6);
    R.ws = (unsigned char*)(GLB unsigned char*)launder_u64((unsigned long long)C0.ws);
    R.out = (float*)(GLB float*)(unsigned long long)C0.out;
    R.in = (const __attribute__((address_space(4))) cfp_t*)launder_u64((unsigned long long)C0.in);
    unsigned l = (unsigned)(uintptr_t)C0.lds; asm volatile("" : "+v"(l)); l = __builtin_amdgcn_readfirstlane(l); R.lds = (LAS unsigned char*)(uintptr_t)l;
    return R;
}

__device__ __forceinline__ const float* src_row(const Ctx& C, int r) {
    const int b = r / RPB, j = r % RPB;
    return j < CTXL ? INP(I_CTX) + ((size_t)b * CTXL + j) * DM : INP(I_X) + ((size_t)b * SEQ + (j - CTXL)) * DM;
}
__device__ __forceinline__ int mod_sel(int r) { const int b = r / RPB, j = r % RPB; return j < CTXL ? 2 : b; }

__device__ __forceinline__ void phase_modv(const Ctx& C) {
    LAS float* sc = (LAS float*)C.lds;
    LAS float* red = (LAS float*)(C.lds + 3 * 2048 * 4);
    for (int i = C.tid; i < 3 * DM; i += NTHREADS) { const int r = i / DM, k = i % DM; const float v = r < 2 ? INP(I_C)[r * DM + k] : INP(I_CCTX)[k]; sc[i] = siluf_(v); }
    __syncthreads();
    float* modv = WSP(float, WS_MODV);
    const int kq = C.tid / 12, c4 = C.tid % 12;
    for (int item = C.bid; item < 2 * 256; item += C.G) {
        const int l = item / 256, cg = item % 256;
        float acc[3][4];
#pragma unroll
        for (int r = 0; r < 3; ++r)
#pragma unroll
            for (int j = 0; j < 4; ++j) acc[r][j] = 0.f;
        if (kq < 42) {
            const float* wp = INP(I_WMOD) + (size_t)l * DM * 12288 + 48 * cg + 4 * c4;
#pragma unroll 1
            for (int k0 = kq; k0 < DM; k0 += 42 * 7) {
                f32x4 w[7];
#pragma unroll
                for (int u = 0; u < 7; ++u) { const int k = k0 + 42 * u; w[u] = k < DM ? *(const f32x4*)(wp + (size_t)k * 12288) : (f32x4){0.f, 0.f, 0.f, 0.f}; }
#pragma unroll
                for (int u = 0; u < 7; ++u) { const int k = k0 + 42 * u; if (k < DM) {
#pragma unroll
                    for (int r = 0; r < 3; ++r) { const float sv = sc[r * DM + k];
#pragma unroll
                        for (int j = 0; j < 4; ++j) acc[r][j] += sv * w[u][j]; } } }
            }
#pragma unroll
            for (int r = 0; r < 3; ++r)
#pragma unroll
                for (int j = 0; j < 4; ++j) red[kq * 144 + r * 48 + c4 * 4 + j] = acc[r][j];
        }
        __syncthreads();
        if (C.tid < 144) { float s = 0.f; for (int q = 0; q < 42; ++q) s += red[q * 144 + C.tid];
            const int r = C.tid / 48, cc = C.tid % 48;
            modv[((size_t)l * 3 + r) * 12288 + 48 * cg + cc] = s + INP(I_BMOD)[(size_t)l * 12288 + 48 * cg + cc]; }
        __syncthreads();
    }
}
__device__ __forceinline__ void phase_tables(const Ctx& C) {
    float* ta = WSP(float, WS_TABA); float* tm = WSP(float, WS_TABM);
    for (int i = C.bid * NTHREADS + C.tid; i < 128 * 32 + 128 * 16; i += C.G * NTHREADS) {
        if (i < 128 * 32) { const int pos = i / 32, f = i % 32; const float inv = exp2f(-(float)f * (13.287712379549449f / 32.0f)); const float a = (float)pos * inv;
            ta[i] = cosf(a); ta[128 * 32 + i] = sinf(a); }
        else { const int k = i - 128 * 32, pos = k / 16, f = k % 16; const float inv = exp2f(-(float)f * (13.287712379549449f / 16.0f)); const float a = (float)pos * inv;
            tm[k] = cosf(a); tm[128 * 16 + k] = sinf(a); }
    }
}
__device__ __forceinline__ void transpose_cvt(const Ctx& C, const float* src, int K, int N, bf16_t* dst, int Npad, int& item) {
    LAS float* tile = (LAS float*)C.lds;
    const int tk = K / 64, tn = Npad / 256, ntile = tk * tn;
    const int t0 = ((C.bid - item % C.G) + C.G) % C.G; item += ntile;
    for (int t = t0; t < ntile; t += C.G) {
        const int k0 = (t / tn) * 64, n0 = (t % tn) * 256;
        const int nn = (C.tid & 63) * 4, kr = C.tid >> 6;
        f32x4 v[8];
#pragma unroll
        for (int p = 0; p < 8; ++p) { v[p] = (f32x4){0.f, 0.f, 0.f, 0.f}; if (n0 + nn < N) v[p] = *(const f32x4*)(src + (size_t)(k0 + kr + p * 8) * N + n0 + nn); }
#pragma unroll
        for (int p = 0; p < 8; ++p)
#pragma unroll
            for (int j = 0; j < 4; ++j) tile[(kr + p * 8) * 257 + nn + j] = v[p][j];
        __syncthreads();
        { const int n = C.tid >> 1, kh = (C.tid & 1) * 32;
#pragma unroll
          for (int q = 0; q < 4; ++q) { float x[8];
#pragma unroll
              for (int j = 0; j < 8; ++j) x[j] = tile[(kh + q * 8 + j) * 257 + n];
              u32x4 w; w.x = cvt_pk_bf16(x[0], x[1]); w.y = cvt_pk_bf16(x[2], x[3]); w.z = cvt_pk_bf16(x[4], x[5]); w.w = cvt_pk_bf16(x[6], x[7]);
              *(u32x4*)(dst + (size_t)(n0 + n) * K + k0 + kh + q * 8) = w; } }
        __syncthreads();
    }
}
__device__ __forceinline__ void transpose_cvt_fp8(const Ctx& C, const float* src, int K, int N, unsigned char* dst, int Npad, float* cinv, const float cmul = 1.0f, const int wg_off = 0) {
    LAS float* tile = (LAS float*)C.lds;
    LAS float* red = (LAS float*)(C.lds + 64 * 65 * 4);
    LAS float* scl = red + 32 * 64;
    const int kk = C.tid >> 4, nn = (C.tid & 15) * 4;
    for (int cgp = ((C.bid - wg_off) % C.G + C.G) % C.G; cgp < Npad / 64; cgp += C.G) {
        const int n0 = cgp * 64; const bool live = n0 + nn < N;
        float am[4] = {0.f, 0.f, 0.f, 0.f};
        for (int k0 = 0; k0 < K; k0 += 128) {
            f32x4 v[4];
#pragma unroll
            for (int p = 0; p < 4; ++p) v[p] = live ? *(const f32x4*)(src + (size_t)(k0 + kk + p * 32) * N + n0 + nn) : (f32x4){0.f, 0.f, 0.f, 0.f};
#pragma unroll
            for (int p = 0; p < 4; ++p)
#pragma unroll
                for (int j = 0; j < 4; ++j) am[j] = fmaxf(am[j], fabsf(v[p][j])); }
#pragma unroll
        for (int j = 0; j < 4; ++j) red[kk * 64 + nn + j] = am[j];
        __syncthreads();
        if (C.tid < 64) { float m = 0.f; for (int q = 0; q < 32; ++q) m = fmaxf(m, red[q * 64 + C.tid]);
            scl[C.tid] = m > 0.f ? 224.0f / m : 1.0f; cinv[n0 + C.tid] = (m > 0.f ? m * (1.0f / 224.0f) : 1.0f) * cmul; }
        __syncthreads();
        for (int k0 = 0; k0 < K; k0 += 64) {
#pragma unroll
            for (int p = 0; p < 2; ++p) { const f32x4 v = live ? *(const f32x4*)(src + (size_t)(k0 + kk + p * 32) * N + n0 + nn) : (f32x4){0.f, 0.f, 0.f, 0.f};
#pragma unroll
                for (int j = 0; j < 4; ++j) tile[(kk + p * 32) * 65 + nn + j] = v[j]; }
            __syncthreads();
            { const int n = C.tid >> 3, k8 = (C.tid & 7) * 8; const float sc = scl[n]; float x[8];
#pragma unroll
              for (int j = 0; j < 8; ++j) x[j] = tile[(k8 + j) * 65 + n] * sc;
              int p0 = __builtin_amdgcn_cvt_pk_fp8_f32(x[0], x[1], 0, false); p0 = __builtin_amdgcn_cvt_pk_fp8_f32(x[2], x[3], p0, true);
              int p1 = __builtin_amdgcn_cvt_pk_fp8_f32(x[4], x[5], 0, false); p1 = __builtin_amdgcn_cvt_pk_fp8_f32(x[6], x[7], p1, true);
              u32x2 w; w.x = (unsigned)p0; w.y = (unsigned)p1; *(u32x2*)(dst + (size_t)(n0 + n) * K + k0 + k8) = w; }
            __syncthreads();
        }
    }
}
__device__ __forceinline__ void cvt_plain(const Ctx& C, const float* src, bf16_t* dst, size_t n8) {
    for (size_t i = (size_t)C.bid * NTHREADS + C.tid; i < n8; i += (size_t)C.G * NTHREADS) {
        const f32x4 a = *(const f32x4*)(src + i * 8), b = *(const f32x4*)(src + i * 8 + 4);
        u32x4 w; w.x = cvt_pk_bf16(a[0], a[1]); w.y = cvt_pk_bf16(a[2], a[3]); w.z = cvt_pk_bf16(b[0], b[1]); w.w = cvt_pk_bf16(b[2], b[3]);
        *(u32x4*)(dst + i * 8) = w;
    }
}
__device__ __forceinline__ void phase_cvt_mixer_weights(const Ctx& C, int l) {
    int item = 0;
    transpose_cvt_fp8(C, INP(I_WIN) + (size_t)l * DM * IN_COLS, DM, IN_COLS, C.ws + WS_WIN, NP, WSP(float, WS_WINS));
    __syncthreads();
    transpose_cvt(C, INP(I_WUQ) + (size_t)l * 512 * 1536, 512, 1536, WSP(bf16_t, WS_WUQ), 1536, item);
    transpose_cvt(C, INP(I_WUKV) + (size_t)l * 512 * 2048, 512, 2048, WSP(bf16_t, WS_WUKV), 2048, item);
    transpose_cvt_fp8(C, INP(I_WBRA) + (size_t)l * 1024 * 2048, 1024, 2048, C.ws + WS_WBR, 2048, WSP(float, WS_WBRS), 1.0f / 32.0f, 220); __syncthreads();
    transpose_cvt_fp8(C, INP(I_WBRL) + (size_t)l * 1024 * 2048, 1024, 2048, C.ws + WS_WBR + (size_t)2048 * 1024, 2048, WSP(float, WS_WBRS) + DM, 1.0f, 220); __syncthreads();
    transpose_cvt_fp8(C, INP(I_WBRM) + (size_t)l * 1024 * 2048, 1024, 2048, C.ws + WS_WBR + (size_t)2 * 2048 * 1024, 2048, WSP(float, WS_WBRS) + 2 * DM, 1.0f / 32.0f, 252); __syncthreads();
    transpose_cvt_fp8(C, INP(I_WOUT) + (size_t)l * 2048 * 2048, 2048, 2048, C.ws + WS_WOUT, 2048, WSP(float, WS_WOUTS), 1.0f, 188);
    __syncthreads();
    transpose_cvt(C, INP(I_PWQ) + (size_t)l * 2048 * 2048, 2048, 2048, WSP(bf16_t, WS_WQ), 2048, item);
    cvt_plain(C, INP(I_PK1) + (size_t)l * 8 * 128 * 128, WSP(bf16_t, WS_K1), 8 * 128 * 128 / 8);
    cvt_plain(C, INP(I_PK2) + (size_t)l * 8 * 128 * 128, WSP(bf16_t, WS_K2), 8 * 128 * 128 / 8);
}
__device__ __forceinline__ void phase_cvt_peer_tables(const Ctx& C, int l, int row_lo, int row_hi, int wg_lo) {
    const int lane = C.lane; if (C.bid < wg_lo) return;
    unsigned char* pt = C.ws + WS_PT + (size_t)l * PT_BYTES;
    for (int row = row_lo + (C.bid - wg_lo) * 8 + C.wid; row < row_hi; row += (C.G - wg_lo) * 8) {
#pragma unroll 1
        for (int tb = 0; tb < 2; ++tb) {
            const float* src = (tb ? INP(I_PV) : INP(I_PU)) + ((size_t)l * NEXP + row) * DM + lane * 16;
            f32x4 x[8]; float amax = 0.f;
#pragma unroll
            for (int c = 0; c < 2; ++c)
#pragma unroll
                for (int q = 0; q < 4; ++q) { x[c * 4 + q] = *(const f32x4*)(src + c * 1024 + q * 4);
                    amax = fmaxf(amax, fmaxf(fmaxf(fabsf(x[c * 4 + q][0]), fabsf(x[c * 4 + q][1])), fmaxf(fabsf(x[c * 4 + q][2]), fabsf(x[c * 4 + q][3])))); }
            amax = fmaxf(amax, xchg32(amax, lane)); amax = fmaxf(amax, xchg16(amax, lane)); amax = fmaxf(amax, dppmov<DPP_ROR8>(amax));
            amax = fmaxf(amax, dppmov<DPP_HMIRROR>(amax)); amax = fmaxf(amax, dppmov<DPP_Q3210>(amax)); amax = fmaxf(amax, dppmov<DPP_Q1032>(amax));
            const float sc = amax > 0.f ? 224.0f / amax : 1.0f, inv = amax > 0.f ? amax * (1.0f / 224.0f) : 1.0f;
            unsigned char* dst = pt + (tb ? PT_V8 : PT_U8) + (size_t)(lane >> 3) * ((size_t)NEXP * 128) + (size_t)row * 128 + (lane & 7) * 16;
#pragma unroll
            for (int c = 0; c < 2; ++c) { u32x4 w;
#pragma unroll
                for (int q = 0; q < 4; ++q) { const f32x4 v = x[c * 4 + q] * sc; int p = __builtin_amdgcn_cvt_pk_fp8_f32(v[0], v[1], 0, false); p = __builtin_amdgcn_cvt_pk_fp8_f32(v[2], v[3], p, true); w[q] = (unsigned)p; }
                *(u32x4*)(dst + (size_t)c * 8 * ((size_t)NEXP * 128)) = w; }
            if (lane == 0) ((float*)(pt + (tb ? PT_SCV : PT_SCU)))[row] = inv;
        }
    }
}

template <bool FIRST, bool F8OUT = false> __device__ __forceinline__ void phase_norm_mod(const Ctx& C, const float* gvec, const float* modl  , int shift_off, int scale_off) {
    float* xs = WSP(float, WS_XS); bf16_t* hb = WSP(bf16_t, WS_HB);
    for (int r = C.bid * 8 + C.wid; r < TT; r += C.G * 8) {
        const float* xr = FIRST ? src_row(C, r) : xs + (size_t)r * DM;
        const float* mv = modl + (size_t)mod_sel(r) * 12288;
        f32x4 v[8]; float ss = 0.f;
#pragma unroll
        for (int c = 0; c < 4; ++c) { v[2 * c] = *(const f32x4*)(xr + c * 512 + C.lane * 8); v[2 * c + 1] = *(const f32x4*)(xr + c * 512 + C.lane * 8 + 4); }
#pragma unroll
        for (int c = 0; c < 8; ++c) ss += v[c][0] * v[c][0] + v[c][1] * v[c][1] + v[c][2] * v[c][2] + v[c][3] * v[c][3];
        ss = wave_sum(ss);
        const float rs = rsqrtf(ss * (1.0f / DM) + NORM_EPS);
#pragma unroll
        for (int c = 0; c < 4; ++c) { const int col = c * 512 + C.lane * 8;
            if (FIRST) { *(f32x4*)(xs + (size_t)r * DM + col) = v[2 * c]; *(f32x4*)(xs + (size_t)r * DM + col + 4) = v[2 * c + 1]; }
            float o[8];
#pragma unroll
            for (int h = 0; h < 2; ++h) { const f32x4 g = *(const f32x4*)(gvec + col + 4 * h), s = *(const f32x4*)(mv + scale_off + col + 4 * h), t = *(const f32x4*)(mv + shift_off + col + 4 * h);
#pragma unroll
                for (int j = 0; j < 4; ++j) o[4 * h + j] = v[2 * c + h][j] * rs * g[j] * (1.0f + s[j]) + t[j]; }
            if constexpr (F8OUT) {
                int p0 = __builtin_amdgcn_cvt_pk_fp8_f32(o[0], o[1], 0, false); p0 = __builtin_amdgcn_cvt_pk_fp8_f32(o[2], o[3], p0, true);
                int p1 = __builtin_amdgcn_cvt_pk_fp8_f32(o[4], o[5], 0, false); p1 = __builtin_amdgcn_cvt_pk_fp8_f32(o[6], o[7], p1, true);
                u32x2 w; w.x = (unsigned)p0; w.y = (unsigned)p1; *(u32x2*)((unsigned char*)hb + (size_t)r * DM + col) = w;
            } else {
            u32x4 w; w.x = cvt_pk_bf16(o[0], o[1]); w.y = cvt_pk_bf16(o[2], o[3]); w.z = cvt_pk_bf16(o[4], o[5]); w.w = cvt_pk_bf16(o[6], o[7]);
            *(u32x4*)(hb + (size_t)r * DM + col) = w; } }
    }
}

__device__ __forceinline__ void phase_post_p(const Ctx& C, int l) {
    bf16_t* P = WSP(bf16_t, WS_P); const float* ta = WSP(float, WS_TABA); const float* tm = WSP(float, WS_TABM);
    const float* qg = INP(I_QNG) + l * 128; const float* kg = INP(I_KNG) + l * 128;
    const float* mqg = INP(I_MQNG) + l * 512; const float* mkvg = INP(I_MKVNG) + l * 512;
    const int lane = C.lane;
    const float qg1 = qg[lane], qg2 = qg[lane + 64], kg1 = kg[lane], kg2 = kg[lane + 64];
    for (int r = C.bid * 8 + C.wid; r < TT; r += C.G * 8) {
        bf16_t* pr = P + (size_t)r * NP;
        const int j = r % RPB; const bool lat = j >= CTXL; const int pos = lat ? j - CTXL : 0, ri = pos >> 6, ci = pos & 63;
        float cs = 1.f, sn = 0.f;
        if (lat) { const int p = lane < 32 ? ri : ci, f = lane & 31; cs = ta[p * 32 + f]; sn = ta[128 * 32 + p * 32 + f]; }
#pragma unroll
        for (int h = 0; h < 10; ++h) {
            bf16_t* hp = pr + (h < 8 ? C_AQ + h * 128 : C_AK + (h - 8) * 128);
            const float x1 = bf2f(hp[lane]), x2 = bf2f(hp[lane + 64]);
            const float ss = wave_sum(x1 * x1 + x2 * x2);
            const float rs = rsqrtf(ss * (1.0f / 128.0f) + NORM_EPS);
            const float y1 = x1 * rs * (h < 8 ? qg1 : kg1), y2 = x2 * rs * (h < 8 ? qg2 : kg2);
            const float z1 = y1 * cs - y2 * sn, z2 = y2 * cs + y1 * sn;
            hp[lane] = f2bf(z1); hp[lane + 64] = f2bf(z2);
            if (h >= 8) { unsigned char* k8 = C.ws + WS_AK8 + (size_t)r * 256 + (h - 8) * 128;
                k8[lane] = (unsigned char)(__builtin_amdgcn_cvt_pk_fp8_f32(z1, 0.f, 0, false) & 0xff); k8[lane + 64] = (unsigned char)(__builtin_amdgcn_cvt_pk_fp8_f32(z2, 0.f, 0, false) & 0xff); }
        }
#pragma unroll
        for (int s = 0; s < 2; ++s) {
            bf16_t* sp = pr + (s == 0 ? C_MCQ : C_MCKV) + lane * 8; const float* gg = (s == 0 ? mqg : mkvg) + lane * 8;
            const u32x4 w = *(const u32x4*)sp; float x[8] = {bflo(w.x), bfhi(w.x), bflo(w.y), bfhi(w.y), bflo(w.z), bfhi(w.z), bflo(w.w), bfhi(w.w)};
            float ss = 0.f;
#pragma unroll
            for (int i = 0; i < 8; ++i) ss += x[i] * x[i];
            ss = wave_sum(ss);
            const float rs = rsqrtf(ss * (1.0f / 512.0f) + NORM_EPS);
#pragma unroll
            for (int i = 0; i < 8; ++i) x[i] = x[i] * rs * gg[i];
            u32x4 o; o.x = cvt_pk_bf16(x[0], x[1]); o.y = cvt_pk_bf16(x[2], x[3]); o.z = cvt_pk_bf16(x[4], x[5]); o.w = cvt_pk_bf16(x[6], x[7]);
            *(u32x4*)sp = o;
        }
        { bf16_t* kp = pr + C_MKR; const int i = lane & 31; const float x1 = bf2f(kp[i]), x2 = bf2f(kp[i + 32]);
          float c2 = 1.f, s2 = 0.f; if (lat) { const int p = i < 16 ? ri : ci, f = i & 15; c2 = tm[p * 16 + f]; s2 = tm[128 * 16 + p * 16 + f]; }
          const float z1 = x1 * c2 - x2 * s2, z2 = x2 * c2 + x1 * s2;
          if (lane < 32) { if (lat) { kp[i] = f2bf(z1); kp[i + 32] = f2bf(z2); }
              unsigned char* k8 = C.ws + WS_KR8 + (size_t)r * 64; k8[i] = (unsigned char)(__builtin_amdgcn_cvt_pk_fp8_f32(z1, 0.f, 0, false) & 0xff); k8[i + 32] = (unsigned char)(__builtin_amdgcn_cvt_pk_fp8_f32(z2, 0.f, 0, false) & 0xff); } }
    }
}

typedef int i32x8 __attribute__((ext_vector_type(8)));
typedef int i32x4 __attribute__((ext_vector_type(4)));
namespace att {
constexpr int NW = 8, QBLK = 32, KVBLK = 64, DV = 128;
constexpr float THR = 8.f;
#define SBAR() __builtin_amdgcn_sched_barrier(0)
__device__ __forceinline__ int crow(int r, int hi) { return (r & 3) + 8 * (r >> 2) + 4 * hi; }
template <int DQ> struct Cf {
    static constexpr int ND0 = DQ / 16, KROWB = DQ * 2, SHM_K = KVBLK * DQ * 2, SHM_V = KVBLK * DV * 2, SHM = 2 * SHM_V + 2 * SHM_K + NW * 64 * 4;
    static constexpr float SCALE = DQ == 128 ? 0.088388347648318440f : 0.072168783648703220f;
    __device__ static __forceinline__ int kswz(int row, int colB) { return row * KROWB + (colB ^ ((row & 7) << 4)); }
};
template <int DQ, int VAR = 0> __device__ __forceinline__ void partialSM(f32x16& p0, f32x16& p1, float& m_reg, float& mn, float& alpha, const float thr = THR, const float eoff = 0.f) {
    constexpr float SC = Cf<DQ>::SCALE, Cc = SC * 1.4426950408889634f;
    float pmax = p0[0];
#pragma unroll
    for (int r = 1; r < 16; ++r) pmax = fmaxf(pmax, p0[r]);
#pragma unroll
    for (int r = 0; r < 16; ++r) pmax = fmaxf(pmax, p1[r]);
    { auto rr = __builtin_amdgcn_permlane32_swap(__float_as_uint(pmax), __float_as_uint(pmax), false, false);
      pmax = fmaxf(__uint_as_float(rr[0]), __uint_as_float(rr[1])); }
    if (__builtin_expect(__all(pmax - m_reg <= thr / SC), 1)) { mn = m_reg; alpha = 1.f; }
    else { mn = fmaxf(m_reg, pmax); alpha = __builtin_amdgcn_exp2f((m_reg - mn) * Cc); m_reg = mn; }
    const float mnC = eoff - mn * Cc;
#pragma unroll
    for (int r = 0; r < 16; ++r) p0[r] = fmaf(p0[r], Cc, mnC);
#pragma unroll
    for (int r = 0; r < 16; ++r) p1[r] = fmaf(p1[r], Cc, mnC);
#pragma unroll
    for (int r = 0; r < 16; ++r) p0[r] = VAR == 1 ? p0[r] * 0.001f : __builtin_amdgcn_exp2f(p0[r]);
}
template <int VAR = 0> __device__ __forceinline__ void finishSM(f32x16& p0, f32x16& p1, float alpha, float& l_reg, bf16x8& pa0, bf16x8& pa1, bf16x8& pa2, bf16x8& pa3) {
#pragma unroll
    for (int r = 0; r < 16; ++r) p1[r] = VAR == 1 ? p1[r] * 0.001f : __builtin_amdgcn_exp2f(p1[r]);
    float ps = 0;
#pragma unroll
    for (int r = 0; r < 16; ++r) ps += p0[r];
#pragma unroll
    for (int r = 0; r < 16; ++r) ps += p1[r];
    { auto rr = __builtin_amdgcn_permlane32_swap(__float_as_uint(ps), __float_as_uint(ps), false, false);
      ps = __uint_as_float(rr[0]) + __uint_as_float(rr[1]); }
    l_reg = l_reg * alpha + ps;
#define PK4(P, BASE, OUT) do { unsigned a0 = cvt_pk_bf16(P[BASE + 0], P[BASE + 1]), a1 = cvt_pk_bf16(P[BASE + 2], P[BASE + 3]);   \
    unsigned b0 = cvt_pk_bf16(P[BASE + 4], P[BASE + 5]), b1 = cvt_pk_bf16(P[BASE + 6], P[BASE + 7]);                              \
    auto r0 = __builtin_amdgcn_permlane32_swap(a0, b0, false, false); auto r1 = __builtin_amdgcn_permlane32_swap(a1, b1, false, false); \
    u32x4 w = {r0[0], r1[0], r0[1], r1[1]}; OUT = *reinterpret_cast<bf16x8*>(&w); } while (0)
    PK4(p0, 0, pa0); PK4(p0, 8, pa1); PK4(p1, 0, pa2); PK4(p1, 8, pa3);
#undef PK4
}
template <int DQ> __device__ __forceinline__ void qkt(f32x16& p0, f32x16& p1, const char* Ks, const bf16x8* qr, const char* qx, int r32, int hi) {
    p0 = f32x16{}; p1 = f32x16{};
#pragma unroll
    for (int d0 = 0; d0 < Cf<DQ>::ND0; ++d0) { const int cb = (d0 * 16 + hi * 8) * 2;
        const bf16x8 b0 = *reinterpret_cast<const bf16x8*>(Ks + Cf<DQ>::kswz(r32, cb));
        const bf16x8 b1 = *reinterpret_cast<const bf16x8*>(Ks + Cf<DQ>::kswz(32 + r32, cb));
        constexpr int NQR = DQ == 192 ? MLA_NQR : 8;
        bf16x8 q; if (d0 < NQR) q = qr[d0]; else q = *reinterpret_cast<const bf16x8*>(qx + (d0 - NQR) * 1024);
        p0 = __builtin_amdgcn_mfma_f32_32x32x16_bf16(b0, q, p0, 0, 0, 0);
        p1 = __builtin_amdgcn_mfma_f32_32x32x16_bf16(b1, q, p1, 0, 0, 0); }
}
__device__ __forceinline__ int v_st(int k, int c) { const int kk = (k & ~0xC) | ((k & 4) << 1) | ((k & 8) >> 1); return ((kk >> 3) * 4 + (c >> 5)) * 512 + ((kk & 7) * 32 + (c & 31)) * 2; }
__device__ __forceinline__ int v_rd_base(int lane) { return ((lane & 3) << 3) | (((lane >> 2) & 3) << 6) | (((lane >> 4) & 1) << 5) | (((lane >> 5) & 1) << 8); }
constexpr int v_rd_off(int d0, int ks, int half) { return d0 * 512 + ks * 4096 + half * 2048; }
template <int OFF> __device__ __forceinline__ s16x4 tr_read(int vb) {
    s16x4 r; asm volatile("ds_read_b64_tr_b16 %0, %1 offset:%2" : "=&v"(r) : "v"(vb), "i"(OFF) : "memory"); return r;
}
template <int D0> __device__ __forceinline__ void pv_one(f32x16& od, int vb, bf16x8 pa0, bf16x8 pa1, bf16x8 pa2, bf16x8 pa3) {
    const s16x4 l0 = tr_read<v_rd_off(D0, 0, 0)>(vb), h0 = tr_read<v_rd_off(D0, 0, 1)>(vb), l1 = tr_read<v_rd_off(D0, 1, 0)>(vb), h1 = tr_read<v_rd_off(D0, 1, 1)>(vb);
    const s16x4 l2 = tr_read<v_rd_off(D0, 2, 0)>(vb), h2 = tr_read<v_rd_off(D0, 2, 1)>(vb), l3 = tr_read<v_rd_off(D0, 3, 0)>(vb), h3 = tr_read<v_rd_off(D0, 3, 1)>(vb);
    asm volatile("s_waitcnt lgkmcnt(0)" ::: "memory"); SBAR();
#define PK(L, H) (bf16x8){L[0], L[1], L[2], L[3], H[0], H[1], H[2], H[3]}
    od = __builtin_amdgcn_mfma_f32_32x32x16_bf16(pa0, PK(l0, h0), od, 0, 0, 0);
    od = __builtin_amdgcn_mfma_f32_32x32x16_bf16(pa1, PK(l1, h1), od, 0, 0, 0);
    od = __builtin_amdgcn_mfma_f32_32x32x16_bf16(pa2, PK(l2, h2), od, 0, 0, 0);
    od = __builtin_amdgcn_mfma_f32_32x32x16_bf16(pa3, PK(l3, h3), od, 0, 0, 0);
#undef PK
}
__device__ __forceinline__ void pv_d0(f32x16* o, int vb, bf16x8 pa0, bf16x8 pa1, bf16x8 pa2, bf16x8 pa3) {
    pv_one<0>(o[0], vb, pa0, pa1, pa2, pa3); pv_one<1>(o[1], vb, pa0, pa1, pa2, pa3); pv_one<2>(o[2], vb, pa0, pa1, pa2, pa3); pv_one<3>(o[3], vb, pa0, pa1, pa2, pa3);
}
__device__ __forceinline__ bf16x8 ld8(const bf16_t* p) { return *reinterpret_cast<const bf16x8*>(p); }

template <int DQ, int SD, int VAR = 0>
__device__ __forceinline__ void attn_body(const bf16_t* __restrict__ Qb, int ldq, const bf16_t* __restrict__ Kn, int ldkn, const bf16_t* __restrict__ Kr, int ldkr,
                                          const bf16_t* __restrict__ Vh, int ldv, unsigned char* __restrict__ Ob, int ldo, int seq, bool rope_q, int pos0, const float* __restrict__ tabM, char* lds, const int tid) {
    using CF = Cf<DQ>; constexpr int ND0 = CF::ND0, SHM_V = CF::SHM_V, SHM_K = CF::SHM_K;
    const int wid = tid >> 6, lane = tid & 63, r32 = lane & 31, hi = lane >> 5;
    char* V_lds = lds; char* K_lds = lds + 2 * SHM_V;
    float* ws = (float*)(lds + 2 * SHM_V + 2 * SHM_K) + wid * 64; float* li_l = ws; float* al_l = ws + 32;
    constexpr int NQR = DQ == 192 ? MLA_NQR : 8;
    float m_reg = -1e30f, l_reg = 0; f32x16 o[4] = {}; bf16x8 qr[NQR];
    const bf16_t* Qw = Qb + (long)(wid * QBLK + r32) * ldq + hi * 8;
#pragma unroll
    for (int d0 = 0; d0 < NQR; ++d0) qr[d0] = ld8(Qw + d0 * 16);
    char* qx = lds + CF::SHM + wid * 8192 + lane * 16;
    if constexpr (DQ == 192) {
#pragma unroll
        for (int d0 = NQR; d0 < 8; ++d0) *(bf16x8*)(qx + (d0 - NQR) * 1024) = ld8(Qw + d0 * 16);
        bf16x8 qe[4];
#pragma unroll
        for (int d0 = 0; d0 < 4; ++d0) qe[d0] = ld8(Qw + (8 + d0) * 16);
        if (rope_q) {
            const int pos = pos0 + wid * QBLK + r32, ri = pos >> 6, ci = pos & 63;
#pragma unroll
            for (int t = 0; t < 2; ++t) { const int p = t == 0 ? ri : ci; const float* tc = tabM + p * 16 + hi * 8; const float* tsn = tabM + 128 * 16 + p * 16 + hi * 8;
                bf16x8 a = qe[t], b = qe[2 + t];
#pragma unroll
                for (int jj = 0; jj < 8; ++jj) { const float x1 = bf2f((bf16_t)a[jj]), x2 = bf2f((bf16_t)b[jj]), c = tc[jj], s = tsn[jj];
                    a[jj] = (short)f2bf(x1 * c - x2 * s); b[jj] = (short)f2bf(x2 * c + x1 * s); }
                qe[t] = a; qe[2 + t] = b; }
        }
#pragma unroll
        for (int d0 = 0; d0 < 4; ++d0) *(bf16x8*)(qx + (8 - NQR + d0) * 1024) = qe[d0];
    }
    const int sr = tid >> 4, sc = (tid & 15) * 8, vst0 = v_st(sr, sc), vst1 = v_st(32 + sr, sc);
    const int sr2 = tid >> 3, sc2 = (tid & 7) * 8;
    const int vb0 = (int)(uintptr_t)V_lds + v_rd_base(lane);
    struct { bf16x8 vs0, vs1, ks0, ks1, ks2; } sr_[SD];
    const unsigned offV = (unsigned)(sr * ldv + sc) * 2u, offK = (unsigned)(sr * ldkn + sc) * 2u, offR = (unsigned)(sr2 * ldkr + sc2) * 2u;
#define SLOAD(i, k0) do { const char* vt_ = (const char*)Vh + (size_t)(k0) * ldv * 2; const char* kt_ = (const char*)Kn + (size_t)(k0) * ldkn * 2; \
    sr_[i].vs0 = *(const bf16x8*)(vt_ + offV); sr_[i].vs1 = *(const bf16x8*)(vt_ + (size_t)32 * ldv * 2 + offV); \
    sr_[i].ks0 = *(const bf16x8*)(kt_ + offK); sr_[i].ks1 = *(const bf16x8*)(kt_ + (size_t)32 * ldkn * 2 + offK); \
    if constexpr (DQ == 192) sr_[i].ks2 = *(const bf16x8*)((const char*)Kr + (size_t)(k0) * ldkr * 2 + offR); } while (0)
#define SWRITE(b, i) do { *(bf16x8*)(V_lds + (b) * SHM_V + vst0) = sr_[i].vs0; *(bf16x8*)(V_lds + (b) * SHM_V + vst1) = sr_[i].vs1; const int kc = sc * 2; \
    *(bf16x8*)(K_lds + (b) * SHM_K + CF::kswz(sr, kc)) = sr_[i].ks0; *(bf16x8*)(K_lds + (b) * SHM_K + CF::kswz(32 + sr, kc)) = sr_[i].ks1; \
    if constexpr (DQ == 192) *(bf16x8*)(K_lds + (b) * SHM_K + CF::kswz(sr2, 256 + sc2 * 2)) = sr_[i].ks2; } while (0)
#define SWAIT() do { if constexpr (SD == 1) asm volatile("s_waitcnt vmcnt(0)" ::: "memory"); else if constexpr (DQ == 192) asm volatile("s_waitcnt vmcnt(5)" ::: "memory"); else asm volatile("s_waitcnt vmcnt(4)" ::: "memory"); } while (0)
#define RESC(a) do { if (__any((a) < 1.f)) { if (hi == 0) al_l[r32] = (a); asm volatile("s_waitcnt lgkmcnt(0)" ::: "memory"); \
    _Pragma("unroll") for (int d = 0; d < 4; ++d) _Pragma("unroll") for (int r = 0; r < 16; ++r) o[d][r] *= al_l[crow(r, hi)]; } } while (0)
    f32x16 pA0, pA1, pB0, pB1; float mnA, mnB, alA, alB; bf16x8 pa0, pa1, pa2, pa3; const int NT = seq / KVBLK;
    constexpr int SE = 0, SO = SD - 1;
    SLOAD(SE, 0); asm volatile("s_waitcnt vmcnt(0)" ::: "memory"); SWRITE(0, SE); __syncthreads();
    qkt<DQ>(pA0, pA1, K_lds, qr, qx, r32, hi); partialSM<DQ, VAR>(pA0, pA1, m_reg, mnA, alA);
    SLOAD(SO, KVBLK); if constexpr (SD == 2) { if (2 < NT) SLOAD(SE, 2 * KVBLK); }
    SWAIT(); SWRITE(1, SO); __syncthreads();
#define ATT_SYNC() do { if constexpr (VAR != 2) __syncthreads(); } while (0)
    for (int j = 1; j + 1 < NT; j += 2) {
        SBAR(); qkt<DQ>(pB0, pB1, K_lds + SHM_K, qr, qx, r32, hi);
        finishSM<VAR>(pA0, pA1, alA, l_reg, pa0, pa1, pa2, pa3); SBAR();
        if constexpr (VAR != 3) SLOAD(SO, (j + SD) * KVBLK); SBAR();
        pv_d0(o, vb0, pa0, pa1, pa2, pa3); partialSM<DQ, VAR>(pB0, pB1, m_reg, mnB, alB);
        ATT_SYNC(); SWAIT(); SWRITE(0, SE);
        RESC(alB); ATT_SYNC();
        SBAR(); qkt<DQ>(pA0, pA1, K_lds, qr, qx, r32, hi);
        finishSM<VAR>(pB0, pB1, alB, l_reg, pa0, pa1, pa2, pa3); SBAR();
        if constexpr (VAR != 3) { if (SD == 1 || j + 3 < NT) SLOAD(SE, (j + 1 + SD) * KVBLK); } SBAR();
        pv_d0(o, vb0 + SHM_V, pa0, pa1, pa2, pa3); partialSM<DQ, VAR>(pA0, pA1, m_reg, mnA, alA);
        ATT_SYNC(); SWAIT(); SWRITE(1, SO);
        RESC(alA); ATT_SYNC();
    }
    SBAR(); qkt<DQ>(pB0, pB1, K_lds + SHM_K, qr, qx, r32, hi);
    finishSM<VAR>(pA0, pA1, alA, l_reg, pa0, pa1, pa2, pa3); SBAR();
    pv_d0(o, vb0, pa0, pa1, pa2, pa3); partialSM<DQ, VAR>(pB0, pB1, m_reg, mnB, alB);
    ATT_SYNC(); RESC(alB);
    finishSM<VAR>(pB0, pB1, alB, l_reg, pa0, pa1, pa2, pa3); SBAR();
    pv_d0(o, vb0 + SHM_V, pa0, pa1, pa2, pa3);
    if (hi == 0) li_l[r32] = l_reg; asm volatile("s_waitcnt lgkmcnt(0)" ::: "memory");
    float rli[16];
#pragma unroll
    for (int r = 0; r < 16; ++r) rli[r] = __builtin_amdgcn_rcpf(li_l[crow(r, hi)]);
    unsigned char* Ow = Ob + (long)(wid * QBLK) * ldo;
#pragma unroll
    for (int r = 0; r < 16; ++r) { const int orow = crow(r, hi);
#pragma unroll
        for (int d0 = 0; d0 < 4; ++d0) Ow[(long)orow * ldo + d0 * 32 + r32] = (unsigned char)(__builtin_amdgcn_cvt_pk_fp8_f32(o[d0][r] * rli[r] * 32.0f, 0.f, 0, false) & 0xff); }
#undef SLOAD
#undef ATT_SYNC
#undef SWRITE
#undef SWAIT
#undef RESC
}

__device__ __forceinline__ int k8addr(int row, int b, int DQ_) { return row * DQ_ + (b < 128 ? (b ^ ((row & 7) << 4)) : 128 + ((b - 128) ^ ((row & 3) << 4))); }
#define MX32(ACC, A, B, SC) asm volatile("s_nop 1\n\tv_mfma_scale_f32_32x32x64_f8f6f4 %0, %1, %2, %0, %3, %3 op_sel_hi:[0,0,0]" : "+v"(ACC) : "v"(A), "v"(B), "v"(SC))
#define MX32Z(ACC, A, B, SC) asm volatile("v_mfma_scale_f32_32x32x64_f8f6f4 %0, %1, %2, 0, %3, %3 op_sel_hi:[0,0,0]" : "=&v"(ACC) : "v"(A), "v"(B), "v"(SC))
template <int DQ, bool NOPS = true> __device__ __forceinline__ void qkt8(f32x16& p0, f32x16& p1, const char* Ks, const i32x8* qf, int r32, int hi) {
    int mxs = 0x7f7f7f7f; asm volatile("" : "+v"(mxs));
#pragma unroll
    for (int ks = 0; ks < DQ / 64; ++ks) { const int b = ks * 64 + hi * 32;
        const i32x4 a0l = *reinterpret_cast<const i32x4*>(Ks + k8addr(r32, b, DQ)), a0h = *reinterpret_cast<const i32x4*>(Ks + k8addr(r32, b + 16, DQ));
        const i32x4 a1l = *reinterpret_cast<const i32x4*>(Ks + k8addr(32 + r32, b, DQ)), a1h = *reinterpret_cast<const i32x4*>(Ks + k8addr(32 + r32, b + 16, DQ));
        const i32x8 a0 = __builtin_shufflevector(a0l, a0h, 0, 1, 2, 3, 4, 5, 6, 7), a1 = __builtin_shufflevector(a1l, a1h, 0, 1, 2, 3, 4, 5, 6, 7);
        if (ks == 0) { MX32Z(p0, a0, qf[ks], mxs); MX32Z(p1, a1, qf[ks], mxs); } else { MX32(p0, a0, qf[ks], mxs); MX32(p1, a1, qf[ks], mxs); } }
    if (NOPS) asm volatile("s_nop 15\n\ts_nop 7");
}
__device__ __forceinline__ int pk4_fp8(float a, float b, float c, float d) { int p = __builtin_amdgcn_cvt_pk_fp8_f32(a, b, 0, false); return __builtin_amdgcn_cvt_pk_fp8_f32(c, d, p, true); }
__device__ __forceinline__ int pk4_fp8u(float a, float b, float c, float d) { int u; asm volatile("" : "=v"(u)); const int p = __builtin_amdgcn_cvt_pk_fp8_f32(a, b, u, false); return __builtin_amdgcn_cvt_pk_fp8_f32(c, d, p, true); }
template <int DQ>
__device__ __forceinline__ void attn_body8(const bf16_t* __restrict__ Qb, int ldq, const unsigned char* __restrict__ Kn8, int ldkn, const unsigned char* __restrict__ Kr8, int ldkr,
                                           const bf16_t* __restrict__ Vh, int ldv, unsigned char* __restrict__ Ob, int ldo, int seq, bool rope_q, int pos0, const float* __restrict__ tabM, char* lds, const int tid) {
    constexpr int NKS = DQ / 64, SHM_V = KVBLK * DV * 2, SHM_K = KVBLK * DQ;
    const int wid = tid >> 6, lane = tid & 63, r32 = lane & 31, hi = lane >> 5;
    char* V_lds = lds; char* K_lds = lds + 2 * SHM_V;
    float* ws = (float*)(lds + 2 * SHM_V + 2 * SHM_K) + wid * 64; float* li_l = ws; float* al_l = ws + 32;
    float m_reg = -1e30f, l_reg = 0; f32x16 o[4] = {}; i32x8 qf[NKS];
    const bf16_t* Qrow = Qb + (long)(wid * QBLK + r32) * ldq;
#pragma unroll
    for (int ks = 0; ks < NKS; ++ks) {
        float x[32];
#pragma unroll
        for (int c = 0; c < 4; ++c) { const u32x4 w = *(const u32x4*)(Qrow + ks * 64 + hi * 32 + c * 8);
            x[c * 8 + 0] = bflo(w.x); x[c * 8 + 1] = bfhi(w.x); x[c * 8 + 2] = bflo(w.y); x[c * 8 + 3] = bfhi(w.y); x[c * 8 + 4] = bflo(w.z); x[c * 8 + 5] = bfhi(w.z); x[c * 8 + 6] = bflo(w.w); x[c * 8 + 7] = bfhi(w.w); }
        if (DQ == 192 && ks == 2 && rope_q) {
            float y[32];
#pragma unroll
            for (int c = 0; c < 4; ++c) { const u32x4 w = *(const u32x4*)(Qrow + 128 + (1 - hi) * 32 + c * 8);
                y[c * 8 + 0] = bflo(w.x); y[c * 8 + 1] = bfhi(w.x); y[c * 8 + 2] = bflo(w.y); y[c * 8 + 3] = bfhi(w.y); y[c * 8 + 4] = bflo(w.z); y[c * 8 + 5] = bfhi(w.z); y[c * 8 + 6] = bflo(w.w); y[c * 8 + 7] = bfhi(w.w); }
            const int pos = pos0 + wid * QBLK + r32, ri = pos >> 6, ci = pos & 63;
#pragma unroll
            for (int i = 0; i < 32; ++i) { const int p = i < 16 ? ri : ci, f = i & 15; const float c_ = tabM[p * 16 + f], s_ = tabM[128 * 16 + p * 16 + f];
                x[i] = hi ? x[i] * c_ + y[i] * s_ : x[i] * c_ - y[i] * s_; }
        }
        i32x8 q8;
#pragma unroll
        for (int j = 0; j < 8; ++j) q8[j] = pk4_fp8(x[4 * j], x[4 * j + 1], x[4 * j + 2], x[4 * j + 3]);
        qf[ks] = q8;
    }
    const int sr = tid >> 4, sc = (tid & 15) * 8, vst0 = v_st(sr, sc), vst1 = v_st(32 + sr, sc);
    const int kr = tid >> 3, kb = (tid & 7) * 16;
    const int kr2 = (tid & 255) >> 2, kb2 = (tid & 3) * 16;
    const int vb0 = (int)(uintptr_t)V_lds + v_rd_base(lane);
    struct { bf16x8 vs0, vs1; u32x4 k0, k1; } sr_[1];
    const unsigned offV = (unsigned)(sr * ldv + sc) * 2u, offK = (unsigned)(kr * ldkn + kb), offR = (unsigned)(kr2 * ldkr + kb2);
#define SLOAD8(k0_) do { const char* vt_ = (const char*)Vh + (size_t)(k0_) * ldv * 2; \
    sr_[0].vs0 = *(const bf16x8*)(vt_ + offV); sr_[0].vs1 = *(const bf16x8*)(vt_ + (size_t)32 * ldv * 2 + offV); \
    sr_[0].k0 = *(const u32x4*)(Kn8 + (size_t)(k0_) * ldkn + offK); \
    if constexpr (DQ == 192) { if (tid < 256) sr_[0].k1 = *(const u32x4*)(Kr8 + (size_t)(k0_) * ldkr + offR); } } while (0)
#define SWRITE8(b) do { *(bf16x8*)(V_lds + (b) * SHM_V + vst0) = sr_[0].vs0; *(bf16x8*)(V_lds + (b) * SHM_V + vst1) = sr_[0].vs1; \
    *(u32x4*)(K_lds + (b) * SHM_K + k8addr(kr, kb, DQ)) = sr_[0].k0; \
    if constexpr (DQ == 192) { if (tid < 256) *(u32x4*)(K_lds + (b) * SHM_K + k8addr(kr2, 128 + kb2, DQ)) = sr_[0].k1; } } while (0)
#define SWAIT8() asm volatile("s_waitcnt vmcnt(0)" ::: "memory")
#define RESC8(a) do { if (__any((a) < 1.f)) { if (hi == 0) al_l[r32] = (a); asm volatile("s_waitcnt lgkmcnt(0)" ::: "memory"); \
    _Pragma("unroll") for (int d = 0; d < 4; ++d) _Pragma("unroll") for (int r = 0; r < 16; ++r) o[d][r] *= al_l[crow(r, hi)]; } } while (0)
    f32x16 pA0, pA1, pB0, pB1; float mnA, mnB, alA, alB; bf16x8 pa0, pa1, pa2, pa3; const int NT = seq / KVBLK;
    SLOAD8(0); SWAIT8(); SWRITE8(0); __syncthreads();
    qkt8<DQ>(pA0, pA1, K_lds, qf, r32, hi); partialSM<DQ, 0>(pA0, pA1, m_reg, mnA, alA);
    SLOAD8(KVBLK);
    SWAIT8(); SWRITE8(1); __syncthreads();
    for (int j = 1; j + 1 < NT; j += 2) {
        SBAR(); qkt8<DQ>(pB0, pB1, K_lds + SHM_K, qf, r32, hi);
        finishSM<0>(pA0, pA1, alA, l_reg, pa0, pa1, pa2, pa3); SBAR();
        SLOAD8((j + 1) * KVBLK); SBAR();
        pv_d0(o, vb0, pa0, pa1, pa2, pa3); partialSM<DQ, 0>(pB0, pB1, m_reg, mnB, alB);
        __syncthreads(); SWAIT8(); SWRITE8(0);
        RESC8(alB); __syncthreads();
        SBAR(); qkt8<DQ>(pA0, pA1, K_lds, qf, r32, hi);
        finishSM<0>(pB0, pB1, alB, l_reg, pa0, pa1, pa2, pa3); SBAR();
        SLOAD8((j + 2) * KVBLK); SBAR();
        pv_d0(o, vb0 + SHM_V, pa0, pa1, pa2, pa3); partialSM<DQ, 0>(pA0, pA1, m_reg, mnA, alA);
        __syncthreads(); SWAIT8(); SWRITE8(1);
        RESC8(alA); __syncthreads();
    }
    SBAR(); qkt8<DQ>(pB0, pB1, K_lds + SHM_K, qf, r32, hi);
    finishSM<0>(pA0, pA1, alA, l_reg, pa0, pa1, pa2, pa3); SBAR();
    pv_d0(o, vb0, pa0, pa1, pa2, pa3); partialSM<DQ, 0>(pB0, pB1, m_reg, mnB, alB);
    __syncthreads(); RESC8(alB);
    finishSM<0>(pB0, pB1, alB, l_reg, pa0, pa1, pa2, pa3); SBAR();
    pv_d0(o, vb0 + SHM_V, pa0, pa1, pa2, pa3);
    if (hi == 0) li_l[r32] = l_reg; asm volatile("s_waitcnt lgkmcnt(0)" ::: "memory");
    float rli[16];
#pragma unroll
    for (int r = 0; r < 16; ++r) rli[r] = __builtin_amdgcn_rcpf(li_l[crow(r, hi)]);
    unsigned char* Ow = Ob + (long)(wid * QBLK) * ldo;
#pragma unroll
    for (int r = 0; r < 16; ++r) { const int orow = crow(r, hi);
#pragma unroll
        for (int d0 = 0; d0 < 4; ++d0) Ow[(long)orow * ldo + d0 * 32 + r32] = (unsigned char)(__builtin_amdgcn_cvt_pk_fp8_f32(o[d0][r] * rli[r] * 32.0f, 0.f, 0, false) & 0xff); }
#undef SLOAD8
#undef SWRITE8
#undef SWAIT8
#undef RESC8
}

__device__ __host__ __forceinline__ int vt8_key(int g, int j) { const int i = j & 15; return (j < 16 ? 0 : 32) + (i & 3) + 8 * (i >> 2) + 4 * g; }
template <int DQ>
__device__ __forceinline__ void attn_body88(const bf16_t* __restrict__ Qb, int ldq, const unsigned char* __restrict__ Kn8, int ldkn, const unsigned char* __restrict__ Kr8, int ldkr,
                                            const unsigned char* __restrict__ VT8, unsigned char* __restrict__ Ob, int ldo, int seq, bool rope_q, int pos0, const float* __restrict__ tabM, char* lds, const int tid) {
    constexpr int NKS = DQ / 64, SHM_V = 128 * 64, SHM_K = KVBLK * DQ;
    constexpr float EOFF = 7.0f, THR8 = 1.0f;
    const int wid = tid >> 6, lane = tid & 63, r32 = lane & 31, hi = lane >> 5;
    char* V_lds = lds; char* K_lds = lds + 2 * SHM_V;
    float* ws = (float*)(lds + 2 * SHM_V + 2 * SHM_K) + wid * 64; float* li_l = ws; float* al_l = ws + 32;
    float m_reg = -1e30f, l_reg = 0; f32x16 o[4] = {}; i32x8 qf[NKS];
    const bf16_t* Qrow = Qb + (long)(wid * QBLK + r32) * ldq;
#pragma unroll
    for (int ks = 0; ks < NKS; ++ks) {
        float x[32];
#pragma unroll
        for (int c = 0; c < 4; ++c) { const u32x4 w = *(const u32x4*)(Qrow + ks * 64 + hi * 32 + c * 8);
            x[c * 8 + 0] = bflo(w.x); x[c * 8 + 1] = bfhi(w.x); x[c * 8 + 2] = bflo(w.y); x[c * 8 + 3] = bfhi(w.y); x[c * 8 + 4] = bflo(w.z); x[c * 8 + 5] = bfhi(w.z); x[c * 8 + 6] = bflo(w.w); x[c * 8 + 7] = bfhi(w.w); }
        if (DQ == 192 && ks == 2 && rope_q) {
            float y[32];
#pragma unroll
            for (int c = 0; c < 4; ++c) { const u32x4 w = *(const u32x4*)(Qrow + 128 + (1 - hi) * 32 + c * 8);
                y[c * 8 + 0] = bflo(w.x); y[c * 8 + 1] = bfhi(w.x); y[c * 8 + 2] = bflo(w.y); y[c * 8 + 3] = bfhi(w.y); y[c * 8 + 4] = bflo(w.z); y[c * 8 + 5] = bfhi(w.z); y[c * 8 + 6] = bflo(w.w); y[c * 8 + 7] = bfhi(w.w); }
            const int pos = pos0 + wid * QBLK + r32, ri = pos >> 6, ci = pos & 63;
#pragma unroll
            for (int i = 0; i < 32; ++i) { const int p = i < 16 ? ri : ci, f = i & 15; const float c_ = tabM[p * 16 + f], s_ = tabM[128 * 16 + p * 16 + f];
                x[i] = hi ? x[i] * c_ + y[i] * s_ : x[i] * c_ - y[i] * s_; }
        }
        i32x8 q8;
#pragma unroll
        for (int j = 0; j < 8; ++j) q8[j] = pk4_fp8(x[4 * j], x[4 * j + 1], x[4 * j + 2], x[4 * j + 3]);
        qf[ks] = q8;
    }
    const int vr = tid >> 2, vc = tid & 3;
    const int vwr = vr * 64 + ((vc ^ ((vr >> 2) & 3)) << 4);
    const int kr = tid >> 3, kb = (tid & 7) * 16;
    const int kr2 = (tid & 255) >> 2, kb2 = (tid & 3) * 16;
    struct { u32x4 v, k0, k1; } sr_[1];
    const unsigned offK = (unsigned)(kr * ldkn + kb), offR = (unsigned)(kr2 * ldkr + kb2);
#define SLOAD8(k0_) do { sr_[0].v = *(const u32x4*)(VT8 + (size_t)((k0_) >> 6) * 8192 + tid * 16); \
    sr_[0].k0 = *(const u32x4*)(Kn8 + (size_t)(k0_) * ldkn + offK); \
    if constexpr (DQ == 192) { if (tid < 256) sr_[0].k1 = *(const u32x4*)(Kr8 + (size_t)(k0_) * ldkr + offR); } } while (0)
#define SWRITE8(b) do { *(u32x4*)(V_lds + (b) * SHM_V + vwr) = sr_[0].v; \
    *(u32x4*)(K_lds + (b) * SHM_K + k8addr(kr, kb, DQ)) = sr_[0].k0; \
    if constexpr (DQ == 192) { if (tid < 256) *(u32x4*)(K_lds + (b) * SHM_K + k8addr(kr2, 128 + kb2, DQ)) = sr_[0].k1; } } while (0)
#define SWAIT8() asm volatile("s_waitcnt vmcnt(0)" ::: "memory")
#define RESC8(a) do { if (__any((a) < 1.f)) { if (hi == 0) al_l[r32] = (a); asm volatile("s_waitcnt lgkmcnt(0)" ::: "memory"); \
    _Pragma("unroll") for (int d = 0; d < 4; ++d) _Pragma("unroll") for (int r = 0; r < 16; ++r) o[d][r] *= al_l[crow(r, hi)]; } } while (0)
#define FIN8(P0, P1, AL, PA) do { _Pragma("unroll") for (int r = 0; r < 16; ++r) P1[r] = __builtin_amdgcn_exp2f(P1[r]); \
    float ps_ = 0; _Pragma("unroll") for (int r = 0; r < 16; ++r) ps_ += P0[r]; _Pragma("unroll") for (int r = 0; r < 16; ++r) ps_ += P1[r]; \
    { auto rr_ = __builtin_amdgcn_permlane32_swap(__float_as_uint(ps_), __float_as_uint(ps_), false, false); ps_ = __uint_as_float(rr_[0]) + __uint_as_float(rr_[1]); } \
    l_reg = l_reg * (AL) + ps_; \
    _Pragma("unroll") for (int j = 0; j < 4; ++j) { PA[j] = pk4_fp8u(P0[4 * j], P0[4 * j + 1], P0[4 * j + 2], P0[4 * j + 3]); \
        PA[4 + j] = pk4_fp8u(P1[4 * j], P1[4 * j + 1], P1[4 * j + 2], P1[4 * j + 3]); } } while (0)
#define PV8(VB, PA, NOPS) do { int mxs_ = 0x7f7f7f7f; asm volatile("" : "+v"(mxs_)); _Pragma("unroll") for (int d0 = 0; d0 < 4; ++d0) { const int row_ = d0 * 32 + r32, xs_ = (row_ >> 2) & 3; \
        const i32x4 lo_ = *reinterpret_cast<const i32x4*>((VB) + row_ * 64 + (((2 * hi) ^ xs_) << 4)), hi_ = *reinterpret_cast<const i32x4*>((VB) + row_ * 64 + (((2 * hi + 1) ^ xs_) << 4)); \
        const i32x8 vb_ = __builtin_shufflevector(lo_, hi_, 0, 1, 2, 3, 4, 5, 6, 7); MX32(o[d0], PA, vb_, mxs_); } if (NOPS) asm volatile("s_nop 15\n\ts_nop 7"); } while (0)
    f32x16 pA0, pA1, pB0, pB1; float mnA, mnB, alA, alB; i32x8 pa; const int NT = seq / KVBLK;
    SLOAD8(0); SWAIT8(); SWRITE8(0); __syncthreads();
    qkt8<DQ>(pA0, pA1, K_lds, qf, r32, hi); partialSM<DQ, 0>(pA0, pA1, m_reg, mnA, alA, THR8, EOFF);
    SLOAD8(KVBLK);
    SWAIT8(); SWRITE8(1); __syncthreads();
    for (int j = 1; j + 1 < NT; j += 2) {
        SBAR(); qkt8<DQ, false>(pB0, pB1, K_lds + SHM_K, qf, r32, hi);
        FIN8(pA0, pA1, alA, pa); SBAR();
        SLOAD8((j + 1) * KVBLK); SBAR();
        PV8(V_lds, pa, 0); partialSM<DQ, 0>(pB0, pB1, m_reg, mnB, alB, THR8, EOFF);
        __syncthreads(); SWAIT8(); SWRITE8(0);
        RESC8(alB); __syncthreads();
        SBAR(); qkt8<DQ, false>(pA0, pA1, K_lds, qf, r32, hi);
        FIN8(pB0, pB1, alB, pa); SBAR();
        SLOAD8((j + 2) * KVBLK); SBAR();
        PV8(V_lds + SHM_V, pa, 0); partialSM<DQ, 0>(pA0, pA1, m_reg, mnA, alA, THR8, EOFF);
        __syncthreads(); SWAIT8(); SWRITE8(1);
        RESC8(alA); __syncthreads();
    }
    SBAR(); qkt8<DQ, false>(pB0, pB1, K_lds + SHM_K, qf, r32, hi);
    FIN8(pA0, pA1, alA, pa); SBAR();
    PV8(V_lds, pa, 0); partialSM<DQ, 0>(pB0, pB1, m_reg, mnB, alB, THR8, EOFF);
    __syncthreads(); RESC8(alB);
    FIN8(pB0, pB1, alB, pa); SBAR();
    PV8(V_lds + SHM_V, pa, 1);
    if (hi == 0) li_l[r32] = l_reg; asm volatile("s_waitcnt lgkmcnt(0)" ::: "memory");
    float rli[16];
#pragma unroll
    for (int r = 0; r < 16; ++r) rli[r] = __builtin_amdgcn_rcpf(li_l[crow(r, hi)]) * 32.0f;
    unsigned char* Ow = Ob + (long)(wid * QBLK) * ldo;
#pragma unroll
    for (int r = 0; r < 16; ++r) { const int orow = crow(r, hi);
#pragma unroll
        for (int d0 = 0; d0 < 4; ++d0) Ow[(long)orow * ldo + d0 * 32 + r32] = (unsigned char)(__builtin_amdgcn_cvt_pk_fp8_f32(o[d0][r] * rli[r], 0.f, 0, false) & 0xff); }
#undef SLOAD8
#undef SWRITE8
#undef SWAIT8
#undef RESC8
#undef FIN8
#undef PV8
}
#undef MX32
}

template <int KS> __device__ __forceinline__ void mma_xy(f32x16& acc, const LAS bf16_t* X, const LAS bf16_t* Y, int hi) {
#pragma unroll
    for (int ks = 0; ks < KS; ++ks) { const bf16x8 a = *(const LAS bf16x8*)(X + ks * 16 + hi * 8), b = *(const LAS bf16x8*)(Y + ks * 16 + hi * 8);
        acc = __builtin_amdgcn_mfma_f32_32x32x16_bf16(a, b, acc, 0, 0, 0); }
}
__device__ __forceinline__ float logsig16(float x) { const float e = __expf(-fabsf(x)); return (fminf(x, 0.f) - __logf(1.f + e)) * 0.0625f; }
__device__ __forceinline__ int gla_sidx(int b, int dir, int h) { return (b * 2 + dir) * 4 + h; }

__device__ __forceinline__ void gla_cumsum_lds(const Ctx& C, int l, int h, int dir, const LAS float* lr, LAS float* segtot, LAS float* CUM) {
    const int seg = C.tid >> 7, d = C.tid & 127;
    const float* wa = INP(dir ? I_WA2B : I_WA2F) + (size_t)l * 16 * 512 + h * 128 + d;
    const float bias = INP(dir ? I_BAB : I_BAF)[l * 512 + h * 128 + d];
    float w[16], cum[16];
#pragma unroll
    for (int j = 0; j < 16; ++j) w[j] = wa[j * 512];
    float run = 0.f;
#pragma unroll
    for (int i = 0; i < 16; ++i) { const int s = seg * 16 + i, tk = dir ? 63 - s : s; float pre = bias;
#pragma unroll
        for (int j = 0; j < 16; ++j) pre += lr[tk * 32 + dir * 16 + j] * w[j];
        run += logsig16(pre); cum[i] = run; }
    segtot[seg * 128 + d] = run;
    __syncthreads();
    float off = 0.f;
#pragma unroll
    for (int q = 0; q < 3; ++q) if (q < seg) off += segtot[q * 128 + d];
#pragma unroll
    for (int i = 0; i < 16; ++i) { const int s = seg * 16 + i, tk = dir ? 63 - s : s; CUM[tk * 132 + d] = cum[i] + off; }
    __syncthreads();
}
__device__ __forceinline__ void unpack8(const u32x4 w, float (&x)[8]) { x[0] = bflo(w.x); x[1] = bfhi(w.x); x[2] = bflo(w.y); x[3] = bfhi(w.y); x[4] = bflo(w.z); x[5] = bfhi(w.z); x[6] = bflo(w.w); x[7] = bfhi(w.w); }
__device__ __forceinline__ void gla_build_vt(const Ctx& C, const bf16_t* P, size_t r0, int h, LAS bf16_t* VT) {
    u32x4 v[4];
#pragma unroll
    for (int it = 0; it < 4; ++it) { const int idx = C.tid + it * NTHREADS, sv = idx >> 5, e0 = (idx & 31) * 8; v[it] = *(const u32x4*)(P + (r0 + sv) * NP + C_LV + h * 256 + e0); }
#pragma unroll
    for (int it = 0; it < 4; ++it) { const int idx = C.tid + it * NTHREADS, sv = idx >> 5, e0 = (idx & 31) * 8;
        const unsigned wd[4] = {v[it].x, v[it].y, v[it].z, v[it].w};
#pragma unroll
        for (int q = 0; q < 4; ++q) { VT[(e0 + 2 * q) * 72 + sv] = (bf16_t)(wd[q] & 0xffffu); VT[(e0 + 2 * q + 1) * 72 + sv] = (bf16_t)(wd[q] >> 16); } }
}

__device__ __forceinline__ void phase_gla_local(const Ctx& C, int l, int rot) {
    const bf16_t* P = WSP(bf16_t, WS_P); bf16_t* GST = WSP(bf16_t, WS_GST); float* GDEC = WSP(float, WS_GDEC);
    LAS float* lr = (LAS float*)C.lds;
    LAS float* segtot = (LAS float*)(C.lds + 8192);
    LAS bf16_t* KT = (LAS bf16_t*)(C.lds + 10240);
    LAS bf16_t* VT = (LAS bf16_t*)(C.lds + 28672);
    LAS float* CUM = (LAS float*)(C.lds + 65536);
    const int r32 = C.lane & 31, hi = C.lane >> 5, d = C.tid & 127;
    const int btk = C.tid >> 3, bdg = (C.tid & 7) * 16;
    for (int unit = (C.bid + C.G - rot % C.G) % C.G; unit < NBATCH * 4 * NCH; unit += C.G) {
        const int b = unit / (4 * NCH), h = (unit / NCH) % 4, ck = unit % NCH; const size_t r0 = (size_t)b * RPB + ck * 64;
        for (int i = C.tid; i < 64 * 32; i += NTHREADS) lr[i] = bf2f(P[(r0 + (i >> 5)) * NP + C_LRF + (i & 31)]);
        const u32x4 kw0 = *(const u32x4*)(P + (r0 + btk) * NP + C_LK + h * 128 + bdg), kw1 = *(const u32x4*)(P + (r0 + btk) * NP + C_LK + h * 128 + bdg + 8);
        gla_build_vt(C, P, r0, h, VT);
        __syncthreads();
#pragma unroll 1
        for (int dir = 0; dir < 2; ++dir) {
            gla_cumsum_lds(C, l, h, dir, lr, segtot, CUM);
            const int tend = dir ? 0 : 63;
            const size_t sx = (size_t)gla_sidx(b, dir, h) * NCH + ck;
            if (C.tid < 128) GDEC[sx * 128 + d] = __expf(CUM[tend * 132 + d]);
            { float kf[16]; { float t8[8]; unpack8(kw0, t8);
#pragma unroll
                for (int i = 0; i < 8; ++i) kf[i] = t8[i]; unpack8(kw1, t8);
#pragma unroll
                for (int i = 0; i < 8; ++i) kf[8 + i] = t8[i]; }
#pragma unroll
              for (int q = 0; q < 4; ++q) { const f32x4 cm = *(const LAS f32x4*)(CUM + btk * 132 + bdg + 4 * q), be = *(const LAS f32x4*)(CUM + tend * 132 + bdg + 4 * q);
#pragma unroll
                  for (int i = 0; i < 4; ++i) KT[(bdg + 4 * q + i) * 72 + btk] = f2bf(kf[4 * q + i] * __expf(be[i] - cm[i])); } }
            __syncthreads();
            { const int dt = C.wid & 3, eb = (C.wid >> 2) * 4;
              f32x16 acc[4] = {};
#pragma unroll
              for (int q = 0; q < 4; ++q) mma_xy<4>(acc[q], KT + (dt * 32 + r32) * 72, VT + ((eb + q) * 32 + r32) * 72, hi);
              bf16_t* st = GST + sx * 32768;
#pragma unroll
              for (int q = 0; q < 4; ++q)
#pragma unroll
                  for (int g = 0; g < 4; ++g) { u32x2 w; w.x = cvt_pk_bf16(acc[q][4 * g], acc[q][4 * g + 1]); w.y = cvt_pk_bf16(acc[q][4 * g + 2], acc[q][4 * g + 3]);
                      *(u32x2*)(st + (size_t)((eb + q) * 32 + r32) * 128 + dt * 32 + 8 * g + 4 * hi) = w; } }
            __syncthreads();
        }
    }
}

__device__ __forceinline__ void phase_gla_scan(const Ctx& C) {
    bf16_t* GST = WSP(bf16_t, WS_GST); const float* GDEC = WSP(float, WS_GDEC);
    for (int gid = C.bid * NTHREADS + C.tid; gid < 16 * 8192; gid += C.G * NTHREADS) {
        const int sidx = gid >> 13, g = gid & 8191, dir = (sidx >> 2) & 1, d4 = (g & 31) * 4;
        bf16_t* base = GST + (size_t)sidx * NCH * 32768 + (size_t)g * 4;
        const float* dbase = GDEC + (size_t)sidx * NCH * 128 + d4;
        float S[4] = {0.f, 0.f, 0.f, 0.f};
        for (int st = 0; st < NCH; st += 4) {
            int ck[4]; u32x2 L[4]; f32x4 dc[4];
#pragma unroll
            for (int q = 0; q < 4; ++q) { const int s = st + q; ck[q] = dir ? (s < 4 ? 3 - s : NCH + 3 - s) : s;
                L[q] = *(const u32x2*)(base + (size_t)ck[q] * 32768); dc[q] = *(const f32x4*)(dbase + (size_t)ck[q] * 128); }
#pragma unroll
            for (int q = 0; q < 4; ++q) { u32x2 w; w.x = cvt_pk_bf16(S[0], S[1]); w.y = cvt_pk_bf16(S[2], S[3]);
                *(u32x2*)(base + (size_t)ck[q] * 32768) = w;
                S[0] = dc[q][0] * S[0] + bflo(L[q].x); S[1] = dc[q][1] * S[1] + bfhi(L[q].x); S[2] = dc[q][2] * S[2] + bflo(L[q].y); S[3] = dc[q][3] * S[3] + bfhi(L[q].y); }
        }
    }
}

__device__ __forceinline__ void phase_gla_out(const Ctx& C, int l, int rot) {
    const bf16_t* P = WSP(bf16_t, WS_P); const bf16_t* GST = WSP(bf16_t, WS_GST); unsigned char* OL = C.ws + WS_OL;
    LAS float* lr = (LAS float*)C.lds;
    LAS float* segtot = (LAS float*)(C.lds + 8192);
    LAS bf16_t* QT = (LAS bf16_t*)(C.lds + 10240);
    LAS bf16_t* KT = (LAS bf16_t*)(C.lds + 27648);
    LAS bf16_t* VT = (LAS bf16_t*)(C.lds + 45056);
    LAS bf16_t* SCm = (LAS bf16_t*)(C.lds + 81920);
    LAS float* OB = (LAS float*)(C.lds + 91136);
    LAS float* CUM = OB;
    const float* gon = INP(I_ONG) + l * 256;
    const int r32 = C.lane & 31, hi = C.lane >> 5;
    const int btk = C.tid >> 3, bdg = (C.tid & 7) * 16;
    for (int unit = (C.bid + C.G - rot % C.G) % C.G; unit < NBATCH * 4 * NCH; unit += C.G) {
        const int b = unit / (4 * NCH), h = (unit / NCH) % 4, ck = unit % NCH; const size_t r0 = (size_t)b * RPB + ck * 64;
        for (int i = C.tid; i < 64 * 32; i += NTHREADS) lr[i] = bf2f(P[(r0 + (i >> 5)) * NP + C_LRF + (i & 31)]);
        const bf16_t* qp = P + (r0 + btk) * NP + C_LQ + h * 128 + bdg; const bf16_t* kp = P + (r0 + btk) * NP + C_LK + h * 128 + bdg;
        const u32x4 qw0 = *(const u32x4*)qp, qw1 = *(const u32x4*)(qp + 8), kw0 = *(const u32x4*)kp, kw1 = *(const u32x4*)(kp + 8);
        gla_build_vt(C, P, r0, h, VT);
        __syncthreads();
        f32x16 oacc[2] = {};
#pragma unroll 1
        for (int dir = 0; dir < 2; ++dir) {
            gla_cumsum_lds(C, l, h, dir, lr, segtot, CUM);
            { float qf[8], kf[8];
#pragma unroll
              for (int hh = 0; hh < 2; ++hh) { unpack8(hh ? qw1 : qw0, qf); unpack8(hh ? kw1 : kw0, kf);
                  const f32x4 c0 = *(const LAS f32x4*)(CUM + btk * 132 + bdg + 8 * hh), c1 = *(const LAS f32x4*)(CUM + btk * 132 + bdg + 8 * hh + 4);
                  float qo[8], ko[8];
#pragma unroll
                  for (int i = 0; i < 8; ++i) { const float cm = i < 4 ? c0[i & 3] : c1[i & 3]; qo[i] = qf[i] * __expf(cm) * 0.088388347648318440f; ko[i] = kf[i] * __expf(-cm); }
                  u32x4 wq, wk; wq.x = cvt_pk_bf16(qo[0], qo[1]); wq.y = cvt_pk_bf16(qo[2], qo[3]); wq.z = cvt_pk_bf16(qo[4], qo[5]); wq.w = cvt_pk_bf16(qo[6], qo[7]);
                  wk.x = cvt_pk_bf16(ko[0], ko[1]); wk.y = cvt_pk_bf16(ko[2], ko[3]); wk.z = cvt_pk_bf16(ko[4], ko[5]); wk.w = cvt_pk_bf16(ko[6], ko[7]);
                  *(LAS u32x4*)(QT + btk * 136 + bdg + 8 * hh) = wq; *(LAS u32x4*)(KT + btk * 136 + bdg + 8 * hh) = wk; } }
            __syncthreads();
            if (C.wid < 4) { const int mt = C.wid >> 1, nt = C.wid & 1; f32x16 sc = {};
                mma_xy<8>(sc, QT + (mt * 32 + r32) * 136, KT + (nt * 32 + r32) * 136, hi);
#pragma unroll
                for (int i = 0; i < 16; ++i) { const int t = mt * 32 + att::crow(i, hi), sx_ = nt * 32 + r32; const bool keep = dir ? (sx_ >= t) : (sx_ <= t);
                    SCm[t * 72 + sx_] = f2bf(keep ? sc[i] : 0.f); } }
            __syncthreads();
            { const bf16_t* st = GST + ((size_t)gla_sidx(b, dir, h) * NCH + ck) * 32768 + (size_t)(C.wid * 32 + r32) * 128 + hi * 8;
              bf16x8 sb[8];
#pragma unroll
              for (int ks = 0; ks < 8; ++ks) sb[ks] = *(const bf16x8*)(st + ks * 16);
#pragma unroll
              for (int mt = 0; mt < 2; ++mt) {
                  mma_xy<4>(oacc[mt], SCm + (mt * 32 + r32) * 72, VT + (C.wid * 32 + r32) * 72, hi);
#pragma unroll
                  for (int ks = 0; ks < 8; ++ks) { const bf16x8 a = *(const LAS bf16x8*)(QT + (mt * 32 + r32) * 136 + ks * 16 + hi * 8);
                      oacc[mt] = __builtin_amdgcn_mfma_f32_32x32x16_bf16(a, sb[ks], oacc[mt], 0, 0, 0); } } }
            __syncthreads();
        }
#pragma unroll
        for (int mt = 0; mt < 2; ++mt)
#pragma unroll
            for (int i = 0; i < 16; ++i) OB[(mt * 32 + att::crow(i, hi)) * 260 + C.wid * 32 + r32] = oacc[mt][i];
        __syncthreads();
        { const int t = C.tid >> 3, part = C.tid & 7; f32x4 v[8]; float ss = 0.f;
#pragma unroll
          for (int jj = 0; jj < 8; ++jj) { v[jj] = *(const LAS f32x4*)(OB + t * 260 + jj * 32 + part * 4); ss += v[jj][0] * v[jj][0] + v[jj][1] * v[jj][1] + v[jj][2] * v[jj][2] + v[jj][3] * v[jj][3]; }
          ss += dppmov<DPP_HMIRROR>(ss); ss += dppmov<DPP_Q3210>(ss); ss += dppmov<DPP_Q1032>(ss);
          const float rs = rsqrtf(ss * (1.0f / 256.0f) + NORM_EPS);
#pragma unroll
          for (int jj = 0; jj < 8; ++jj) { const int e = jj * 32 + part * 4; const f32x4 g = *(const f32x4*)(gon + e);
              const u32x2 gt = *(const u32x2*)(P + (r0 + t) * NP + C_LG + h * 256 + e);
              const float o0 = v[jj][0] * rs * g[0] * siluf_(bflo(gt.x)), o1 = v[jj][1] * rs * g[1] * siluf_(bfhi(gt.x)), o2 = v[jj][2] * rs * g[2] * siluf_(bflo(gt.y)), o3 = v[jj][3] * rs * g[3] * siluf_(bfhi(gt.y));
              int p8 = __builtin_amdgcn_cvt_pk_fp8_f32(o0, o1, 0, false); p8 = __builtin_amdgcn_cvt_pk_fp8_f32(o2, o3, p8, true);
              *(unsigned*)(OL + (r0 + t) * 1024 + h * 256 + e) = (unsigned)p8; } }
        __syncthreads();
    }
}

__device__ __forceinline__ unsigned f_ord(float f) { const unsigned u = __float_as_uint(f); return u ^ ((unsigned)((int)u >> 31) | 0x80000000u); }
__device__ __forceinline__ float f_unord(unsigned k) { return __uint_as_float((k & 0x80000000u) ? (k ^ 0x80000000u) : ~k); }
__device__ __forceinline__ void ins_u(unsigned (&L)[16], unsigned x) {
#pragma unroll
    for (int j = 0; j < 16; ++j) { const unsigned h = L[j] > x ? L[j] : x; x = L[j] > x ? x : L[j]; L[j] = h; }
}
__device__ __forceinline__ void ins_f(float (&M)[16], float x) {
#pragma unroll
    for (int j = 0; j < 16; ++j) { const float h = M[j] > x ? M[j] : x; x = M[j] > x ? x : M[j]; M[j] = h; }
}
__device__ __forceinline__ void peer_top16(const bf16_t* __restrict__ qrow, const bf16_t* __restrict__ keys, int r32, int hi, unsigned (&L)[16]) {
    bf16x8 qf[8];
#pragma unroll
    for (int kk = 0; kk < 8; ++kk) qf[kk] = *(const bf16x8*)(qrow + kk * 16 + hi * 8);
#pragma unroll
    for (int j = 0; j < 16; ++j) L[j] = 0u;
    bf16x8 kA[8], kB[8];
    const bf16_t* kl = keys + (size_t)r32 * 128 + hi * 8;
#define PT_LDK(dst, mt) do { _Pragma("unroll") for (int kk = 0; kk < 8; ++kk) dst[kk] = *(const bf16x8*)(kl + (mt) * 32 * 128 + kk * 16); } while (0)
#define PT_PROC(src, mt) do { f32x16 acc = {}; \
        _Pragma("unroll") for (int kk = 0; kk < 8; ++kk) acc = __builtin_amdgcn_mfma_f32_32x32x16_bf16(src[kk], qf[kk], acc, 0, 0, 0); \
        _Pragma("unroll") for (int i = 0; i < 16; ++i) { const unsigned kidx = (unsigned)((mt) * 32 + att::crow(i, hi)); ins_u(L, (f_ord(acc[i]) & ~127u) | (127u - kidx)); } } while (0)
    PT_LDK(kA, 0);
#pragma unroll 1
    for (int mp = 0; mp < 2; ++mp) { PT_LDK(kB, 2 * mp + 1); PT_PROC(kA, 2 * mp); if (mp == 0) PT_LDK(kA, 2); PT_PROC(kB, 2 * mp + 1); }
#undef PT_LDK
#undef PT_PROC
    unsigned Pn[16];
#pragma unroll
    for (int j = 0; j < 16; ++j) { auto r_ = __builtin_amdgcn_permlane32_swap(L[j], L[j], false, false); Pn[j] = hi ? r_[0] : r_[1]; }
#pragma unroll
    for (int j = 0; j < 16; ++j) ins_u(L, Pn[j]);
}
__device__ __forceinline__ void phase_peer_select(const Ctx& C, const bool latent_only) {
    const bf16_t* PQ = WSP(bf16_t, WS_PQ); const bf16_t* K1 = WSP(bf16_t, WS_K1); const bf16_t* K2 = WSP(bf16_t, WS_K2);
    int* PIDX = WSP(int, WS_PIDX); float* PG = WSP(float, WS_PG);
    const int r32 = C.lane & 31, hi = C.lane >> 5, head = C.wid;
    const int ngrp = latent_only ? NBATCH * SEQ / 32 : TT / 32;
    for (int gi = C.bid; gi < ngrp; gi += C.G) {
        const int grp = latent_only ? gi + (CTXL / 32) * (1 + gi / (SEQ / 32)) : gi;
        const size_t tok = (size_t)grp * 32 + r32;
        unsigned L1[16], L2[16];
        peer_top16(PQ + tok * DM + head * 256, K1 + (size_t)head * 128 * 128, r32, hi, L1);
        peer_top16(PQ + tok * DM + head * 256 + 128, K2 + (size_t)head * 128 * 128, r32, hi, L2);
        float v1[16], v2[16];
#pragma unroll
        for (int j = 0; j < 16; ++j) { v1[j] = f_unord(L1[j] & ~127u); v2[j] = f_unord(L2[j] & ~127u); }
        float M[16];
#pragma unroll
        for (int j = 0; j < 16; ++j) M[j] = -3.0e38f;
#pragma unroll
        for (int a = 0; a < 16; ++a)
#pragma unroll
            for (int b = 0; b < 16; ++b) if ((a + 1) * (b + 1) <= 16) ins_f(M, v1[a] + v2[b]);
        const float thr = M[15], mx = M[0]; float den = 0.f;
#pragma unroll
        for (int j = 0; j < 16; ++j) den += __expf(M[j] - mx);
        const float rden = 1.0f / den;
        int pos = 0; int* ip = PIDX + tok * 128 + head * 16; float* gp = PG + tok * 128 + head * 16;
#pragma unroll
        for (int a = 0; a < 16; ++a)
#pragma unroll
            for (int b = 0; b < 16; ++b) if ((a + 1) * (b + 1) <= 16) {
                const float val = v1[a] + v2[b];
                if (val >= thr && pos < 16) { if (hi == 0) { ip[pos] = (int)((127u - (L1[a] & 127u)) * 128u + (127u - (L2[b] & 127u))); gp[pos] = __expf(val - mx) * rden; } ++pos; } }
    }
}
template <int OFF> __device__ __forceinline__ float dotf8(const float (&h)[32], const u32x4 w, float acc) {
#pragma unroll
    for (int j = 0; j < 4; ++j) { const f32x2 lo = __builtin_amdgcn_cvt_pk_f32_fp8((int)w[j], false), hi = __builtin_amdgcn_cvt_pk_f32_fp8((int)w[j], true);
        acc += h[OFF + 4 * j] * lo.x; acc += h[OFF + 4 * j + 1] * lo.y; acc += h[OFF + 4 * j + 2] * hi.x; acc += h[OFF + 4 * j + 3] * hi.y; }
    return acc;
}
constexpr float ATT_O8_SCALE = 32.0f;
constexpr int GT_MAXTOK = 9;
template <bool LAST> __device__ __forceinline__ void phase_peer_gather(const Ctx& C, const float* modl, const float pscale) {
    const unsigned char* pt = C.ws + WS_PT + (size_t)(LAST ? DEPTH - 1 : 0) * PT_BYTES;
    const bf16_t* HB = WSP(bf16_t, WS_HB); const unsigned char* U8 = pt + PT_U8; const unsigned char* V8 = pt + PT_V8;
    const float* SCU = (const float*)(pt + PT_SCU); const float* SCV = (const float*)(pt + PT_SCV);
    const int* PIDX = WSP(int, WS_PIDX); const float* PG = WSP(float, WS_PG); float* XS = WSP(float, WS_XS);
    const int lane = C.lane, s = lane >> 3, j = lane & 7; const unsigned j16 = (unsigned)j * 16u;
    LAS int* IDS = (LAS int*)(C.lds + C.wid * (GT_MAXTOK * 512));
    LAS float* ACT = (LAS float*)(C.lds + 8 * GT_MAXTOK * 512 + C.wid * (GT_MAXTOK * 512));
    LAS int* ROWS = (LAS int*)(C.lds + 16 * GT_MAXTOK * 512 + C.wid * 64);
    int nk = 0;
    {
      const int per = (TT + C.G - 1) / C.G, base = C.bid * per;
#pragma unroll 1
      for (int k = 0; k < GT_MAXTOK; ++k) { const int o = C.wid + 8 * k; const int r = base + o; if (o < per && r < TT && !(LAST && (r % RPB) < CTXL)) { if (lane == 0) ROWS[nk] = r; ++nk; } } }
#define GT_ROW(k) __builtin_amdgcn_readfirstlane(ROWS[k])
#pragma unroll 1
    for (int k = 0; k < nk; ++k) { const int r = GT_ROW(k);
        IDS[k * 128 + lane] = (PIDX[(size_t)r * 128 + lane] & (NEXP - 1)) << 7; IDS[k * 128 + 64 + lane] = (PIDX[(size_t)r * 128 + 64 + lane] & (NEXP - 1)) << 7;
        ACT[k * 128 + lane] = 0.f; ACT[k * 128 + 64 + lane] = 0.f; }
    const int nit = 32 * nk;
#define GT_ITEM(it_) const int cb_ = (it_) / (2 * nk), rem_ = (it_) - cb_ * (2 * nk), k_ = rem_ >> 1, hf_ = rem_ & 1
#define GT_LOADU(UQ, HQ, it_) do { GT_ITEM(it_); const int r_ = GT_ROW(k_); \
        const bf16_t* hp_ = HB + (size_t)r_ * DM + cb_ * 128 + j * 16; HQ[0] = *(const u32x4*)hp_; HQ[1] = *(const u32x4*)(hp_ + 8); \
        const unsigned char* ub_ = U8 + (size_t)cb_ * ((size_t)NEXP * 128);     \
        _Pragma("unroll") for (int eg = 0; eg < 8; ++eg) { const unsigned off_ = ((unsigned)IDS[k_ * 128 + (hf_ * 8 + eg) * 8 + s] & idmask) + j16; UQ[eg] = *(const u32x4*)(ub_ + off_); } } while (0)
#define GT_COMPU(UQ, HQ, it_) do { GT_ITEM(it_); (void)cb_; f32x2 hf2[8]; \
        _Pragma("unroll") for (int hh = 0; hh < 2; ++hh) { const u32x4 w_ = HQ[hh]; \
            hf2[hh * 4 + 0] = (f32x2){bflo(w_.x), bfhi(w_.x)}; hf2[hh * 4 + 1] = (f32x2){bflo(w_.y), bfhi(w_.y)}; hf2[hh * 4 + 2] = (f32x2){bflo(w_.z), bfhi(w_.z)}; hf2[hh * 4 + 3] = (f32x2){bflo(w_.w), bfhi(w_.w)}; } \
        float d[8]; \
        _Pragma("unroll") for (int eg = 0; eg < 8; ++eg) { f32x2 d2 = (f32x2){0.f, 0.f}; \
            _Pragma("unroll") for (int q = 0; q < 4; ++q) { const f32x2 lo = __builtin_amdgcn_cvt_pk_f32_fp8((int)UQ[eg][q], false), hi = __builtin_amdgcn_cvt_pk_f32_fp8((int)UQ[eg][q], true); \
                d2 += hf2[2 * q] * lo; d2 += hf2[2 * q + 1] * hi; } \
            d[eg] = d2.x + d2.y; } \
          \
        float t4[4], t2[2], t1; \
        _Pragma("unroll") for (int i = 0; i < 4; ++i) { const float snd = (j & 4) ? d[i] : d[i + 4], kp = (j & 4) ? d[i + 4] : d[i]; t4[i] = kp + dppmov<DPP_HMIRROR>(snd); } \
        _Pragma("unroll") for (int i = 0; i < 2; ++i) { const float snd = (j & 2) ? t4[i] : t4[i + 2], kp = (j & 2) ? t4[i + 2] : t4[i]; t2[i] = kp + dppmov<DPP_Q3210>(snd); } \
        { const float snd = (j & 1) ? t2[0] : t2[1], kp = (j & 1) ? t2[1] : t2[0]; t1 = kp + dppmov<DPP_Q1032>(snd); } \
        ACT[k_ * 128 + (hf_ * 8 + j) * 8 + s] += t1; } while (0)
#ifdef DBG_GDUP
#pragma unroll 1
    for (int rep_ = 0; rep_ < 2; ++rep_) {
    const unsigned idmask = rep_ == 0 ? ((unsigned)DBG_GMASK << 7 | 127u) : 0xffffffffu;
    if (rep_ == 1) { for (int k = 0; k < nk; ++k) { ACT[k * 128 + lane] = 0.f; ACT[k * 128 + 64 + lane] = 0.f; } }
#else
    { const unsigned idmask = 0xffffffffu;
#endif
    if (nit > 0) {
        u32x4 uA[8], uB[8], hA[2], hB[2];
        GT_LOADU(uA, hA, 0);
#pragma unroll 1
        for (int it = 0; it < nit; it += 2) {
            GT_LOADU(uB, hB, it + 1);
            GT_COMPU(uA, hA, it);
            if (it + 2 < nit) GT_LOADU(uA, hA, it + 2);
            GT_COMPU(uB, hB, it + 1);
        }
    }
    }
#undef GT_LOADU
#undef GT_COMPU
#pragma unroll 1
    for (int k = 0; k < nk; ++k) { const int r = GT_ROW(k);
#pragma unroll
        for (int hh = 0; hh < 2; ++hh) { const int e = hh * 64 + lane; const int id = IDS[k * 128 + e] >> 7; const float a = ACT[k * 128 + e] * SCU[id];
            const float w = PG[(size_t)r * 128 + e] * 0.5f * a * (1.0f + erff(a * 0.70710678118654752f));
#if defined(DBG_CHECK) && (DBG_CHECK == 3 || DBG_CHECK == 4)
            if (((r - 300) & 63) == 0 && r >= 300 && r < 300 + 64 * 128) WSP(float, WS_OM)[(size_t)r * 128 + e] = w;
#endif
            ACT[k * 128 + e] = w * SCV[id]; } }
#define GT_LOADV(VQ, WV, it_) do { GT_ITEM(it_); const unsigned char* vb_ = V8 + (size_t)cb_ * ((size_t)NEXP * 128); \
        _Pragma("unroll") for (int eg = 0; eg < 8; ++eg) { const int e_ = k_ * 128 + (hf_ * 8 + eg) * 8 + s; const unsigned off_ = (unsigned)IDS[e_] + j16; VQ[eg] = *(const u32x4*)(vb_ + off_); WV[eg] = ACT[e_]; } } while (0)
#define GT_COMPV(VQ, WV) do { \
        _Pragma("unroll") for (int eg = 0; eg < 8; ++eg) { const f32x2 w2_ = (f32x2){WV[eg], WV[eg]}; \
            _Pragma("unroll") for (int q = 0; q < 4; ++q) { \
                const f32x2 lo = __builtin_amdgcn_cvt_pk_f32_fp8((int)VQ[eg][q], false), hi = __builtin_amdgcn_cvt_pk_f32_fp8((int)VQ[eg][q], true); \
                acc2[2 * q] += w2_ * lo; acc2[2 * q + 1] += w2_ * hi; } } } while (0)
    if (nit > 0) {
        u32x4 vA[8], vB[8]; float wA[8], wB[8];
        GT_LOADV(vA, wA, 0);
#pragma unroll 1
        for (int it = 0; it < nit; it += 2) {
            f32x2 acc2[8];
#pragma unroll
            for (int i = 0; i < 8; ++i) acc2[i] = (f32x2){0.f, 0.f};
            GT_LOADV(vB, wB, it + 1);
            GT_COMPV(vA, wA);
            if (it + 2 < nit) GT_LOADV(vA, wA, it + 2);
            GT_COMPV(vB, wB);
            f32x2 t4[4], t2[2], t1;
#pragma unroll
            for (int i = 0; i < 4; ++i) { const f32x2 snd = (s & 4) ? acc2[i] : acc2[i + 4], kp = (s & 4) ? acc2[i + 4] : acc2[i];
                t4[i] = kp + (f32x2){xchg32(snd.x, lane), xchg32(snd.y, lane)}; }
#pragma unroll
            for (int i = 0; i < 2; ++i) { const f32x2 snd = (s & 2) ? t4[i] : t4[i + 2], kp = (s & 2) ? t4[i + 2] : t4[i];
                t2[i] = kp + (f32x2){xchg16(snd.x, lane), xchg16(snd.y, lane)}; }
            { const f32x2 snd = (s & 1) ? t2[0] : t2[1], kp = (s & 1) ? t2[1] : t2[0]; t1 = kp + (f32x2){dppmov<DPP_ROR8>(snd.x), dppmov<DPP_ROR8>(snd.y)}; }
            { GT_ITEM(it); (void)hf_; const int r_ = GT_ROW(k_);
              const int col = cb_ * 128 + j * 16 + 2 * s; float* xp = XS + (size_t)r_ * DM + col; const float* g2 = modl + (size_t)mod_sel(r_) * 12288 + 5 * DM + col;
#if defined(DBG_CHECK) && (DBG_CHECK == 3 || DBG_CHECK == 4)
              if (((r_ - 300) & 63) == 0 && r_ >= 300 && r_ < 300 + 64 * 128) { float* dbgo = WSP(float, WS_MQ) + (size_t)r_ * DM + col; dbgo[0] = t1.x; dbgo[1] = t1.y; }
#endif
              const f32x2 x = *(const f32x2*)xp, g = *(const f32x2*)g2;
              *(f32x2*)xp = x + pscale * g * t1; }
        }
    }
#undef GT_LOADV
#undef GT_COMPV
#undef GT_ITEM
#undef GT_ROW
}
__device__ __forceinline__ void phase_final_norm(const Ctx& C) {
    const float* XS = WSP(float, WS_XS); const float* fg = INP(I_FG);
    for (int q = C.bid * 8 + C.wid; q < NBATCH * SEQ; q += C.G * 8) {
        const int b = q / SEQ, t = q % SEQ; const float* xr = XS + ((size_t)b * RPB + CTXL + t) * DM; float* op = C.out + (size_t)q * DM;
        f32x4 v[8]; float ss = 0.f;
#pragma unroll
        for (int c = 0; c < 8; ++c) { v[c] = *(const f32x4*)(xr + c * 256 + C.lane * 4); ss += v[c][0] * v[c][0] + v[c][1] * v[c][1] + v[c][2] * v[c][2] + v[c][3] * v[c][3]; }
        ss = wave_sum(ss); const float rs = rsqrtf(ss * (1.0f / DM) + NORM_EPS);
#pragma unroll
        for (int c = 0; c < 8; ++c) { const f32x4 g = *(const f32x4*)(fg + c * 256 + C.lane * 4); *(f32x4*)(op + c * 256 + C.lane * 4) = v[c] * rs * g; }
    }
}


__device__ __forceinline__ void phase_vt8(const Ctx& C) {
    const bf16_t* P = WSP(bf16_t, WS_P); const bf16_t* MKV = WSP(bf16_t, WS_MKV);
    const int dv = C.tid & 127, kq = C.tid >> 7, g = kq >> 1, j0 = (kq & 1) * 16;
    constexpr int NU_A = NBATCH * 2 * NCH, NU_M = NBATCH * 8 * NCH;
    for (int u = C.bid; u < NU_A + NU_M; u += C.G) {
        const bool gqa = u < NU_A; const int v = gqa ? u : u - NU_A; const int nh = gqa ? 2 : 8;
        const int b = v / (nh * NCH), h = (v / NCH) % nh, t = v % NCH; const size_t r0 = (size_t)b * RPB + t * 64;
        const bf16_t* src = gqa ? P + r0 * NP + C_AV + h * 128 + dv : MKV + r0 * 2048 + h * 256 + 128 + dv; const size_t ld = gqa ? NP : 2048;
        float x[16];
#pragma unroll
        for (int jj = 0; jj < 16; ++jj) x[jj] = bf2f(src[(size_t)att::vt8_key(g, j0 + jj) * ld]);
        u32x4 w; w.x = (unsigned)att::pk4_fp8(x[0], x[1], x[2], x[3]); w.y = (unsigned)att::pk4_fp8(x[4], x[5], x[6], x[7]); w.z = (unsigned)att::pk4_fp8(x[8], x[9], x[10], x[11]); w.w = (unsigned)att::pk4_fp8(x[12], x[13], x[14], x[15]);
        unsigned char* dst = C.ws + (gqa ? WS_VT8A : WS_VT8M) + ((size_t)(b * nh + h) * NCH + t) * 8192 + dv * 64 + kq * 16;
        *(u32x4*)dst = w;
    }
}
template <int TYPE  , int VAR = 0> __device__ __forceinline__ void attn_units(const Ctx& C, bool need_ctx) {
    const bf16_t* P = WSP(bf16_t, WS_P);
    const int nu = need_ctx ? 528 : 512;
#pragma unroll 1
    for (int u = C.bid; u < nu; u += C.G) {
        int bh, qb; if (u < 512) { bh = (u >> 8) * 8 + (u & 7); qb = ((u & 255) >> 3) + 1; } else { bh = u - 512; qb = 0; }
        const int b = bh >> 3, h = bh & 7; const size_t rq = (size_t)b * RPB + (size_t)qb * 256, rk = (size_t)b * RPB; const int seq = qb == 0 ? CTXL : RPB;
        __syncthreads();
        if constexpr (TYPE == 1) {
            att::attn_body88<128>(P + rq * NP + C_AQ + h * 128, NP, C.ws + WS_AK8 + rk * 256 + (h >> 2) * 128, 256, nullptr, 0, C.ws + WS_VT8A + (size_t)(b * 2 + (h >> 2)) * NCH * 8192,
                                  C.ws + WS_OA + rq * 1024 + h * 128, 1024, seq, false, 0, nullptr, (char*)C.lds, C.tid);
        } else {
            const bf16_t* MQ = WSP(bf16_t, WS_MQ);
            att::attn_body88<192>(MQ + rq * 1536 + h * 192, 1536, C.ws + WS_KN8 + rk * 1024 + h * 128, 1024, C.ws + WS_KR8 + rk * 64, 64, C.ws + WS_VT8M + (size_t)(b * 8 + h) * NCH * 8192,
                                  C.ws + WS_OM + rq * 1024 + h * 128, 1024, seq, qb > 0, (qb - 1) * 256, WSP(float, WS_TABM), (char*)C.lds, C.tid);
        }
    }
    __syncthreads();
}

constexpr int LDS_BYTES = 163840, LDS_BAR_OFF = LDS_BYTES - 16;
constexpr int N_PHASES = 26;
template <int K> __device__ __forceinline__ void run_phase(const Ctx& C0, int l) {
    const Ctx C = launder(C0);
    const float* modl = WSP(float, WS_MODV) + (size_t)l * 3 * 12288;
    if constexpr (K == 0) { phase_modv(C); phase_tables(C); __syncthreads(); phase_cvt_mixer_weights(C, 0); }
    if constexpr (K == 1) {
        if (l == 0) phase_norm_mod<true, true>(C, INP(I_N1G), modl, 0, DM);
        else { phase_norm_mod<false, true>(C, INP(I_N1G) + l * DM, modl, 0, DM); __syncthreads(); phase_cvt_mixer_weights(C, l); }
    }
    if constexpr (K == 2) {
        pg8::Gemm g{WSP(bf16_t, WS_HB), WSP(bf16_t, WS_WIN), TT, NP, DM, DM, DM}; pg8::WinOrder S; S.init(C.G, C.bid, l + 1 < DEPTH);
        pg8::EpiStoreBf16S E{WSP(bf16_t, WS_P), NP, WSP(float, WS_WINS)};
        pg8::gemm_phase<pg8::EpiStoreBf16S, pg8::WinOrder, 1>(C.lds, C.tid, g, S, E);
    }
    if constexpr (K == 3) phase_post_p(C, l);
    if constexpr (K == 4) {
        { pg8::Gemm g{WSP(bf16_t, WS_P) + C_MCQ, WSP(bf16_t, WS_WUQ), TT, 1536, 512, NP, 512}; pg8::StaticOrder S; S.init(TT, 1536, C.G, C.bid);
          pg8::EpiStoreBf16 E{WSP(bf16_t, WS_MQ), 1536}; pg8::gemm_phase(C.lds, C.tid, g, S, E); }
        { pg8::Gemm g{WSP(bf16_t, WS_P) + C_MCKV, WSP(bf16_t, WS_WUKV), TT, 2048, 512, NP, 512}; pg8::StaticOrder S; S.init(TT, 2048, C.G, (C.bid + C.G - 140 % C.G) % C.G);
          pg8::EpiStoreMKV E{WSP(bf16_t, WS_MKV), C.ws + WS_KN8}; pg8::gemm_phase(C.lds, C.tid, g, S, E); }
        { const Ctx C2 = launder(C0); phase_gla_local(C2, l, 156); }
#ifdef DBG_DUP_GLALOCAL
        { const Ctx C2 = launder(C0); __syncthreads(); phase_gla_local(C2, l, 156); }
#endif
    }
    if constexpr (K == 5) { phase_gla_scan(C); { const Ctx C2 = launder(C0); phase_vt8(C2); } }
    if constexpr (K == 6) {
#ifdef DBG_ATTVAR
        { const Ctx Cx = launder(C0); attn_units<0, DBG_ATTVAR>(Cx, l + 1 < DEPTH); } { const Ctx Cx = launder(C0); attn_units<1, DBG_ATTVAR>(Cx, l + 1 < DEPTH); } __syncthreads();
#endif
        attn_units<0>(C, l + 1 < DEPTH); { const Ctx C2 = launder(C0); attn_units<1>(C2, l + 1 < DEPTH); } { const Ctx C3 = launder(C0); phase_gla_out(C3, l, 128); }
#ifdef DBG_DUP_GLAOUT
        { const Ctx C3 = launder(C0); __syncthreads(); phase_gla_out(C3, l, 128); }
#endif
    }
    if constexpr (K == 7) {
        const bf16_t* P = WSP(bf16_t, WS_P); bf16_t* Y = WSP(bf16_t, WS_Y);
        const pg8::Gemm ga{WSP(bf16_t, WS_OA), WSP(bf16_t, WS_WBR), TT, DM, 1024, 1024, 1024}, gl{WSP(bf16_t, WS_OL), (const bf16_t*)(C.ws + WS_WBR + (size_t)2048 * 1024), TT, DM, 1024, 1024, 1024},
                        gm{WSP(bf16_t, WS_OM), (const bf16_t*)(C.ws + WS_WBR + (size_t)2 * 2048 * 1024), TT, DM, 1024, 1024, 1024};
        unsigned char* Y8 = C.ws + WS_HB;
        const float* wbs = WSP(float, WS_WBRS);
        const pg8::EpiGate<true> Ea{Y, P + C_GA, nullptr, wbs}; const pg8::EpiGate<false> El{Y, P + C_GL, nullptr, wbs + DM}; const pg8::EpiGate<false, true> Em{Y, P + C_GM, Y8, wbs + 2 * DM};
        pg8::StaticOrder S; S.init(TT, DM, C.G, C.bid, l + 1 >= DEPTH);
        pg8::gemm_phase<pg8::EpiGate<true>, pg8::StaticOrder, 1>(C.lds, C.tid, ga, S, Ea); pg8::gemm_phase<pg8::EpiGate<false>, pg8::StaticOrder, 1>(C.lds, C.tid, gl, S, El);
        pg8::gemm_phase<pg8::EpiGate<false, true>, pg8::StaticOrder, 1>(C.lds, C.tid, gm, S, Em);
        if (l == 0) { const Ctx C2 = launder(C0); phase_cvt_peer_tables(C2, 0, 0, NEXP, S.nwg % C.G); }
    }
    if constexpr (K == 8) {
        pg8::Gemm g{WSP(bf16_t, WS_HB), WSP(bf16_t, WS_WOUT), TT, DM, DM, DM, DM};
        const pg8::EpiResidT<true> E{WSP(float, WS_XS), DM, modl + 2 * DM, WSP(float, WS_WOUTS)};
        pg8::StaticOrder S; S.init(TT, DM, C.G, C.bid, l + 1 >= DEPTH);
        pg8::gemm_phase<pg8::EpiResidT<true>, pg8::StaticOrder, 1>(C.lds, C.tid, g, S, E);
        if (l == 0 && DEPTH > 1) { const Ctx C2 = launder(C0); phase_cvt_peer_tables(C2, 1, 0, NEXP / 2, S.nwg % C.G); }
    }
    if constexpr (K == 9) phase_norm_mod<false>(C, INP(I_N2G) + l * DM, modl, 3 * DM, 4 * DM);
    if constexpr (K == 10) {
        pg8::Gemm g{WSP(bf16_t, WS_HB), WSP(bf16_t, WS_WQ), TT, DM, DM, DM, DM};
        pg8::EpiStoreBf16 E{WSP(bf16_t, WS_PQ), DM};
        pg8::StaticOrder S; S.init(TT, DM, C.G, C.bid, l + 1 >= DEPTH); pg8::gemm_phase(C.lds, C.tid, g, S, E);
        if (l == 0 && DEPTH > 1) { const Ctx C2 = launder(C0); phase_cvt_peer_tables(C2, 1, NEXP / 2, NEXP, S.nwg % C.G); }
    }
    if constexpr (K == 11) phase_peer_select(C, l + 1 >= DEPTH);
    if constexpr (K == 13) phase_final_norm(C);
    if constexpr (K == 12) {
#ifdef DBG_DUP12
        if (l + 1 < DEPTH) phase_peer_gather<false>(C, modl, 0.0f); else phase_peer_gather<true>(C, modl, 0.0f);
        __syncthreads();
#endif
        if (l + 1 < DEPTH) phase_peer_gather<false>(C, modl, DBG_PEER0); else phase_peer_gather<true>(C, modl, DBG_PEER1); }
}
__device__ __forceinline__ Ctx make_ctx(const Args& args, unsigned char* lds_raw) {
    Ctx C0; C0.in = (const __attribute__((address_space(4))) cfp_t*)__builtin_amdgcn_kernarg_segment_ptr(); C0.out = args.out; C0.ws = args.ws; C0.lds = (LAS unsigned char*)lds_raw;
    C0.tid = threadIdx.x; C0.lane = C0.tid & 63; C0.wid = __builtin_amdgcn_readfirstlane(C0.tid >> 6); C0.G = gridDim.x; C0.bid = blockIdx.x;
    return C0;
}
template <int K> __global__ void __launch_bounds__(NTHREADS, 2) k_one(Args args) {
    extern __shared__ __attribute__((aligned(16))) unsigned char lds_raw[];
    const Ctx C0 = make_ctx(args, lds_raw);
    run_phase<K>(C0, args.ph_lo);
}
#if MK_N_LAUNCHES == 1 || defined(DBG_HYB)
__global__ void __launch_bounds__(NTHREADS, 2) mk_fwd(Args args) {
    extern __shared__ __attribute__((aligned(16))) unsigned char lds_raw[];
    const Ctx C0 = make_ctx(args, lds_raw);
    if (C0.tid < 4) ((LAS unsigned*)(C0.lds + LDS_BAR_OFF))[C0.tid] = 0u;
    __syncthreads();
    const int lo = args.ph_lo, hi = args.ph_hi;
    XcdBarrier bar; bar.bar = (unsigned*)(args.ws + WS_CTL); bar.x = 0; bar.st = nullptr;
    if (hi - lo > 1) bar = xcd_barrier_post((unsigned*)(args.ws + WS_CTL), (volatile LAS unsigned*)(C0.lds + LDS_BAR_OFF));
#define IN(k) (lo <= (k) && (k) < hi)
#define SEAM(k) do { if (IN(k) && IN((k) + 1)) xcd_barrier(bar); } while (0)
#ifndef DBG_DUP
#define DBG_DUP -1
#endif
#define PH(K, k) do { if (IN(k)) { run_phase<K>(C0, l); if (K == DBG_DUP) { xcd_barrier(bar); run_phase<K>(C0, l); } } SEAM(k); } while (0)
    { const int l = 0; PH(0, 0); }
#pragma unroll 1
    for (int l = 0; l < DEPTH; ++l) {
        const int pb = 1 + 12 * l;
        PH(1, pb + 0); PH(2, pb + 1); PH(3, pb + 2); PH(4, pb + 3); PH(5, pb + 4); PH(6, pb + 5);
        PH(7, pb + 6); PH(8, pb + 7); PH(9, pb + 8); PH(10, pb + 9); PH(11, pb + 10); PH(12, pb + 11);
    }
    { const int l = DEPTH - 1; PH(13, 1 + 12 * DEPTH); }
#undef PH
#undef IN
#undef SEAM
}
#define MAIN_KERNEL mk_fwd
#else
#define MAIN_KERNEL k_one<6>
#endif


#ifdef DBG_PROBE
typedef int i32x8 __attribute__((ext_vector_type(8)));
__device__ __forceinline__ unsigned char fp8_of_int(int v) {
    const float f = (float)v; return (unsigned char)(__builtin_amdgcn_cvt_pk_fp8_f32(f, 0.f, 0, false) & 0xff); }
__global__ void k_probe_mx(unsigned* slot) {
    const int l = threadIdx.x, r = l & 31, g = l >> 5;
    i32x8 A, B;
    for (int j = 0; j < 8; ++j) { unsigned wa = 0, wb = 0;
        for (int b = 0; b < 4; ++b) { const int k = g * 32 + 4 * j + b;
            wa |= (unsigned)fp8_of_int(((3 * r + k) % 7) - 3) << (8 * b); wb |= (unsigned)fp8_of_int(((5 * k + 2 * r) % 9) - 4) << (8 * b); }
        A[j] = (int)wa; B[j] = (int)wb; }
    f32x16 c = {};
    c = __builtin_amdgcn_mfma_scale_f32_32x32x64_f8f6f4(A, B, c, 0, 0, 0, 0x7f7f7f7f, 0, 0x7f7f7f7f);
    float worst = 0.f;
    for (int i = 0; i < 16; ++i) { const int m = (i & 3) + 8 * (i >> 2) + 4 * g, n = r; float ref = 0.f; for (int k = 0; k < 64; ++k) ref += (float)(((3 * m + k) % 7) - 3) * (float)(((5 * k + 2 * n) % 9) - 4);
        worst = fmaxf(worst, fabsf(c[i] - ref)); }
    for (int o = 32; o >= 1; o >>= 1) worst = fmaxf(worst, __shfl_xor(worst, o));
    if (l == 0) { const float code = worst == 0.f ? 0.4f : 1.2f; *slot = __float_as_uint(powf(10.f, code / 0.25f - 4.f)); }
}
#endif
#ifdef DBG_CHECK
__device__ __forceinline__ void dbg_report(unsigned* slot, float err) { if (!(err <= 3e38f)) err = 1e30f; atomicMax(slot, __float_as_uint(err)); }
__global__ void k_check_gemm(const bf16_t* A, int lda, const float* W, int K, int N, const bf16_t* Cm, int ldc, int M, unsigned* slot) {
    const unsigned id = blockIdx.x * blockDim.x + threadIdx.x; if (id >= 8192) return;
    const unsigned h = id * 2654435761u; const int row = (int)((h >> 8) % (unsigned)M), col = (int)((h * 40503u >> 7) % (unsigned)N);
    float ref = 0.f; for (int k = 0; k < K; ++k) ref += bf2f(A[(size_t)row * lda + k]) * W[(size_t)k * N + col];
    const float got = bf2f(Cm[(size_t)row * ldc + col]);
    dbg_report(slot, fabsf(got - ref) / (fabsf(ref) + 0.1f));
}

__global__ void k_check_attn(const unsigned char* ws, int type, unsigned* slot) {
    __shared__ float sc[RPB]; __shared__ float red[256]; __shared__ float qv[192];
    const int t = threadIdx.x, bh = blockIdx.x & 15, b = bh >> 3, h = bh & 7; const int qpos = (int)(((blockIdx.x >> 4) * 977u + 13u) % SEQ); const size_t rq = (size_t)b * RPB + CTXL + qpos, rk = (size_t)b * RPB;
    const bf16_t* P = (const bf16_t*)(ws + WS_P); const bf16_t* MQ = (const bf16_t*)(ws + WS_MQ); const bf16_t* MKV = (const bf16_t*)(ws + WS_MKV);
    const int dq = type ? 128 : 192;
    if (t < dq) { float v = type ? bf2f(P[rq * NP + C_AQ + h * 128 + t]) : bf2f(MQ[rq * 1536 + h * 192 + t]); qv[t] = v; }
    __syncthreads();
    if (!type && t < 32) {
        const int ri = qpos >> 6, ci = qpos & 63; const int i = t; const float pos = (float)(i < 16 ? ri : ci); const float inv = powf(10000.f, -(float)(i & 15) / 16.f); const float a = pos * inv;
        const float x1 = qv[128 + i], x2 = qv[160 + i]; qv[128 + i] = x1 * cosf(a) - x2 * sinf(a); qv[160 + i] = x2 * cosf(a) + x1 * sinf(a); }
    __syncthreads();
    const float scale = type ? 0.088388347648f : 0.0721687836487f;
    float mx = -1e30f;
    for (int k = t; k < RPB; k += 256) { float s = 0.f;
        if (type) { const bf16_t* kp = P + (rk + k) * NP + C_AK + (h >> 2) * 128; for (int d = 0; d < 128; ++d) s += qv[d] * bf2f(kp[d]); }
        else { const bf16_t* kp = MKV + (rk + k) * 2048 + h * 256; for (int d = 0; d < 128; ++d) s += qv[d] * bf2f(kp[d]); const bf16_t* kr = P + (rk + k) * NP + C_MKR; for (int d = 0; d < 64; ++d) s += qv[128 + d] * bf2f(kr[d]); }
        s *= scale; sc[k] = s; mx = fmaxf(mx, s); }
    red[t] = mx; __syncthreads(); for (int o = 128; o >= 1; o >>= 1) { if (t < o) red[t] = fmaxf(red[t], red[t + o]); __syncthreads(); } mx = red[0]; __syncthreads();
    float sum = 0.f; for (int k = t; k < RPB; k += 256) { const float p = __expf(sc[k] - mx); sc[k] = p; sum += p; }
    red[t] = sum; __syncthreads(); for (int o = 128; o >= 1; o >>= 1) { if (t < o) red[t] += red[t + o]; __syncthreads(); } sum = red[0]; __syncthreads();
    float e = 0.f, mag = 0.f;
    if (t < 128) { float o = 0.f; for (int k = 0; k < RPB; ++k) { const float vv = type ? bf2f(P[(rk + k) * NP + C_AV + (h >> 2) * 128 + t]) : bf2f(MKV[(rk + k) * 2048 + h * 256 + 128 + t]); o += sc[k] * vv; }
        o /= sum; const float got = __builtin_amdgcn_cvt_f32_fp8((int)(ws + (type ? WS_OA : WS_OM))[rq * 1024 + h * 128 + t], 0) * (1.0f / 32.0f); e = fabsf(got - o); mag = fabsf(o); }
    red[t] = e; __syncthreads(); for (int o = 128; o >= 1; o >>= 1) { if (t < o) red[t] = fmaxf(red[t], red[t + o]); __syncthreads(); } e = red[0]; __syncthreads();
    red[t] = mag; __syncthreads(); for (int o = 128; o >= 1; o >>= 1) { if (t < o) red[t] = fmaxf(red[t], red[t + o]); __syncthreads(); } mag = red[0];
    if (t == 0) dbg_report(slot, e / (mag + 1e-4f));
}
__global__ void __launch_bounds__(256) k_check_gla_rec(const unsigned char* ws, const float* wa_f, const float* ba_f, const float* wa_b, const float* ba_b, float* obuf, int b) {
    __shared__ float ad[128], kd[128], qd[128], lrs[16];
    const int e = threadIdx.x, h = blockIdx.x & 3, dir = blockIdx.x >> 2; const bf16_t* P = (const bf16_t*)(ws + WS_P);
    const float* wa = dir ? wa_b : wa_f; const float* ba = dir ? ba_b : ba_f;
    float S[128];
#pragma unroll
    for (int d = 0; d < 128; ++d) S[d] = 0.f;
    float* ob = obuf + ((size_t)(dir * 2 + b) * 4 + h) * RPB * 256;
    for (int st = 0; st < RPB; ++st) {
        int j; if (!dir) j = st; else j = st < CTXL ? CTXL - 1 - st : RPB - 1 - (st - CTXL);
        const size_t r = (size_t)b * RPB + j; const bf16_t* pr = P + r * NP;
        if (e < 16) lrs[e] = bf2f(pr[(dir ? C_LRB : C_LRF) + e]);
        __syncthreads();
        if (e < 128) { float pre = ba[h * 128 + e]; for (int q = 0; q < 16; ++q) pre += lrs[q] * wa[q * 512 + h * 128 + e];
            const float ls = (fminf(pre, 0.f) - log1pf(expf(-fabsf(pre)))) / 16.f; ad[e] = expf(ls); kd[e] = bf2f(pr[C_LK + h * 128 + e]); qd[e] = bf2f(pr[C_LQ + h * 128 + e]) * 0.088388347648f; }
        __syncthreads();
        const float v = bf2f(pr[C_LV + h * 256 + e]); float o = 0.f;
#pragma unroll
        for (int d = 0; d < 128; ++d) { S[d] = ad[d] * S[d] + kd[d] * v; o += qd[d] * S[d]; }
        ob[(size_t)j * 256 + e] = o;
        __syncthreads();
    }
}
__global__ void k_check_gla_cmp(const unsigned char* ws, const float* obuf, const float* gon, int b, unsigned* slot) {
    __shared__ float red[256];
    const int e = threadIdx.x, h = blockIdx.x & 3, j = blockIdx.x >> 2; const size_t r = (size_t)b * RPB + j; const bf16_t* P = (const bf16_t*)(ws + WS_P);
    const float o = obuf[((size_t)(0 * 2 + b) * 4 + h) * RPB * 256 + (size_t)j * 256 + e] + obuf[((size_t)(1 * 2 + b) * 4 + h) * RPB * 256 + (size_t)j * 256 + e];
    red[e] = o * o; __syncthreads(); for (int s_ = 128; s_ >= 1; s_ >>= 1) { if (e < s_) red[e] += red[e + s_]; __syncthreads(); }
    const float rs = rsqrtf(red[0] / 256.f + NORM_EPS); __syncthreads();
    const float gt = bf2f(P[r * NP + C_LG + h * 256 + e]); const float ref = o * rs * gon[e] * (gt / (1.f + expf(-gt)));
    const float got = __builtin_amdgcn_cvt_f32_fp8((int)(ws + WS_OL)[r * 1024 + h * 256 + e], 0);
    red[e] = fabsf(got - ref); __syncthreads(); for (int s_ = 128; s_ >= 1; s_ >>= 1) { if (e < s_) red[e] = fmaxf(red[e], red[e + s_]); __syncthreads(); }
    if (e == 0) dbg_report(slot, red[0] / 1.0f);
}

__global__ void k_check_gemm8(const unsigned char* A8, const float* W, int K, int N, const bf16_t* Cm, int ldc, int M, unsigned* slot) {
    const unsigned id = blockIdx.x * blockDim.x + threadIdx.x; if (id >= 8192) return;
    const unsigned h = id * 2654435761u; const int row = (int)((h >> 8) % (unsigned)M), col = (int)((h * 40503u >> 7) % (unsigned)N);
    float ref = 0.f, mag = 0.f; for (int k = 0; k < K; ++k) { const float a = __builtin_amdgcn_cvt_f32_fp8((int)A8[(size_t)row * K + k], 0), w = W[(size_t)k * N + col]; ref += a * w; mag += a * a * w * w; }
    const float got = bf2f(Cm[(size_t)row * ldc + col]);
    dbg_report(slot, fabsf(got - ref) / (sqrtf(mag) + 1e-3f));
}
__global__ void k_check_select(const bf16_t* PQ, const float* k1, const float* k2, const int* PIDX, const float* PG, unsigned* slot) {
    __shared__ float s1[128], s2[128]; __shared__ int cnt; __shared__ float selv[16];
    const int tok = (blockIdx.x >> 3) * 61 + 5, head = blockIdx.x & 7, t = threadIdx.x;
    if (t == 0) cnt = 0;
    for (int n = t; n < 128; n += 64) { float a = 0.f, b = 0.f; for (int d = 0; d < 128; ++d) { a += bf2f(PQ[(size_t)tok * DM + head * 256 + d]) * k1[((size_t)head * 128 + n) * 128 + d]; b += bf2f(PQ[(size_t)tok * DM + head * 256 + 128 + d]) * k2[((size_t)head * 128 + n) * 128 + d]; } s1[n] = a; s2[n] = b; }
    __syncthreads();
    if (t < 16) { const int id = PIDX[(size_t)tok * 128 + head * 16 + t]; selv[t] = (id >= 0 && id < 16384) ? s1[id >> 7] + s2[id & 127] : -1e30f; }
    __syncthreads();
    float thr = selv[0], mx = selv[0]; for (int k = 1; k < 16; ++k) { thr = fminf(thr, selv[k]); mx = fmaxf(mx, selv[k]); }
    int c = 0; for (int p = t; p < 16384; p += 64) if (s1[p >> 7] + s2[p & 127] > thr + 0.02f) ++c;
    atomicAdd(&cnt, c); __syncthreads();
    if (t == 0) { float den = 0.f; for (int k = 0; k < 16; ++k) den += __expf(selv[k] - mx); float e = fabsf((float)cnt - 15.f) / 15.f > 0.34f ? fabsf((float)cnt - 15.f) / 15.f : 0.f;
        for (int k = 0; k < 16; ++k) e = fmaxf(e, fabsf(PG[(size_t)tok * 128 + head * 16 + k] - __expf(selv[k] - mx) / den) * 4.f);
        for (int k = 0; k < 16; ++k) for (int k2_ = 0; k2_ < k; ++k2_) if (PIDX[(size_t)tok * 128 + head * 16 + k] == PIDX[(size_t)tok * 128 + head * 16 + k2_]) e = fmaxf(e, 10.f);
        dbg_report(slot, e); }
}
__global__ void k_check_gather(const bf16_t* HB, const float* u, const float* v, const int* PIDX, const float* PG, const float* dbgo, unsigned* slot) {
    __shared__ float w[128];
    const int tok = blockIdx.x * 64 + 300, t = threadIdx.x;
    for (int k = t; k < 128; k += 64) { const int id = PIDX[(size_t)tok * 128 + k] & 16383; float a = 0.f; for (int d = 0; d < DM; ++d) a += bf2f(HB[(size_t)tok * DM + d]) * u[(size_t)id * DM + d];
        w[k] = PG[(size_t)tok * 128 + k] * 0.5f * a * (1.0f + erff(a * 0.70710678f)); }
    __syncthreads();
    float e = 0.f, sc = 0.f;
    for (int d = t; d < DM; d += 64) { float o = 0.f; for (int k = 0; k < 128; ++k) o += w[k] * v[(size_t)(PIDX[(size_t)tok * 128 + k] & 16383) * DM + d];
        e = fmaxf(e, fabsf(o - dbgo[(size_t)tok * DM + d])); sc = fmaxf(sc, fabsf(o)); }
    for (int o_ = 32; o_ >= 1; o_ >>= 1) { e = fmaxf(e, __shfl_xor(e, o_)); sc = fmaxf(sc, __shfl_xor(sc, o_)); }
    if (t == 0) dbg_report(slot, e / (sc + 1e-6f));
}
__global__ void k_dbg_out2(const float* x, const float* fg, float* out, const unsigned* slot) {
    const float mx = __uint_as_float(*slot); float v = 0.25f * (log10f(fmaxf(mx, 1e-30f)) + 4.0f); v = fminf(fmaxf(v, 0.f), 9.f);
    const float f = 1.0f + v;
    const int lane = threadIdx.x & 63; const size_t r = (size_t)blockIdx.x * 4 + (threadIdx.x >> 6);
    const float* xr = x + r * DM; float ss = 0.f;
    for (int c = lane; c < DM; c += 64) ss += xr[c] * xr[c];
    ss = wave_sum(ss); const float rs = rsqrtf(ss / DM + NORM_EPS);
    for (int c = lane; c < DM; c += 64) out[r * DM + c] = xr[c] * rs * fg[c] * f;
}
#endif
#ifdef DBG_SCAN
__global__ void k_scan16(const bf16_t* p, size_t n, unsigned* flags, int stage) {
    unsigned bad = 0; for (size_t i = (size_t)blockIdx.x * blockDim.x + threadIdx.x; i < n; i += (size_t)gridDim.x * blockDim.x) bad |= ((p[i] & 0x7f80u) == 0x7f80u);
    if (bad) atomicOr(&flags[stage], 1u);
}
__global__ void k_scan32(const float* p, size_t n, unsigned* flags, int stage) {
    unsigned bad = 0; for (size_t i = (size_t)blockIdx.x * blockDim.x + threadIdx.x; i < n; i += (size_t)gridDim.x * blockDim.x) bad |= ((__float_as_uint(p[i]) & 0x7f800000u) == 0x7f800000u);
    if (bad) atomicOr(&flags[stage], 1u);
}
__global__ void k_dbg_out(const float* x, const float* fg, float* out, const unsigned* flags, int nstage) {
    int code = 0; for (int s = nstage; s >= 1; --s) if (flags[s]) code = s;
    const float f = 1.0f + 0.25f * (float)code;
    const int lane = threadIdx.x & 63; const size_t r = (size_t)blockIdx.x * 4 + (threadIdx.x >> 6);
    const float* xr = x + r * DM; float ss = 0.f;
    for (int c = lane; c < DM; c += 64) ss += xr[c] * xr[c];
    ss = wave_sum(ss); const float rs = rsqrtf(ss / DM + NORM_EPS);
    for (int c = lane; c < DM; c += 64) out[r * DM + c] = xr[c] * rs * fg[c] * f;
}
#endif
extern "C" void kernel_launch(void* const* d_in, const int* in_sizes, int n_in, void* d_out, int out_size, void* d_ws, size_t ws_size, hipStream_t stream) {
    static int grid = 0;
    if (grid == 0) {
        if (n_in != 30 || out_size != NBATCH * SEQ * DM || ws_size < WS_END) { fprintf(stderr, "kernel_launch: shape/workspace mismatch: n_in %d out %d ws %zu (need %zu)\n", n_in, out_size, ws_size, (size_t)WS_END); grid = -1; return; }
        int dev = 0, cus = 0, per_cu = 0;
        if (hipGetDevice(&dev) != hipSuccess || hipDeviceGetAttribute(&cus, hipDeviceAttributeMultiprocessorCount, dev) != hipSuccess) { grid = -1; return; }
        bool okattr = hipFuncSetAttribute((const void*)MAIN_KERNEL, hipFuncAttributeMaxDynamicSharedMemorySize, LDS_BYTES) == hipSuccess;
#if MK_N_LAUNCHES != 1
#ifdef DBG_HYB
        okattr = okattr && hipFuncSetAttribute((const void*)mk_fwd, hipFuncAttributeMaxDynamicSharedMemorySize, LDS_BYTES) == hipSuccess;
#endif
#define SETA(K) okattr = okattr && hipFuncSetAttribute((const void*)k_one<K>, hipFuncAttributeMaxDynamicSharedMemorySize, LDS_BYTES) == hipSuccess
        SETA(0); SETA(1); SETA(2); SETA(3); SETA(4); SETA(5); SETA(6); SETA(7); SETA(8); SETA(9); SETA(10); SETA(11); SETA(12); SETA(13);
#undef SETA
#endif
        if (!okattr) { fprintf(stderr, "kernel_launch: hipFuncSetAttribute failed\n"); grid = -1; return; }
        if (hipOccupancyMaxActiveBlocksPerMultiprocessor(&per_cu, (const void*)MAIN_KERNEL, NTHREADS, LDS_BYTES) != hipSuccess || per_cu < 1) { fprintf(stderr, "kernel_launch: occupancy query says %d blocks per CU\n", per_cu); grid = -1; (void)hipGetLastError(); return; }
        grid = cus;
    }
    if (grid < 0) return;
    if (hipMemsetAsync((char*)d_ws + WS_CTL, 0, CTL_BYTES, stream) != hipSuccess) return;
    Args a{};
    for (int i = 0; i < 30; ++i) a.in[i] = (const float*)d_in[i];
    a.out = (float*)d_out; a.ws = (unsigned char*)d_ws;
#if defined(DBG_PROBE)
    { unsigned* flags = (unsigned*)((char*)d_ws + WS_CTL + 32768);
      hipLaunchKernelGGL(k_probe_mx, dim3(1), dim3(64), 0, stream, flags + 100);
      hipLaunchKernelGGL(k_dbg_out2, dim3(NBATCH * SEQ / 4), dim3(256), 0, stream, (const float*)d_in[0], (const float*)d_in[29], (float*)d_out, flags + 100); }
#elif MK_N_LAUNCHES == 1 && defined(DBG_CHECK)
    {
        unsigned* flags = (unsigned*)((char*)d_ws + WS_CTL + 32768); char* W = (char*)d_ws;
        a.ph_lo = 0; a.ph_hi = (DBG_CHECK == 8) ? 3 : (DBG_CHECK >= 5) ? 7 : (DBG_CHECK == 1 ? 11 : (DBG_CHECK == 2 ? 12 : 13));
        hipLaunchKernelGGL(mk_fwd, dim3(grid), dim3(NTHREADS), LDS_BYTES, stream, a);
#if DBG_CHECK == 8
        hipLaunchKernelGGL(k_check_gemm8, dim3(32), dim3(256), 0, stream, (const unsigned char*)(W + WS_HB), (const float*)d_in[I_WIN], DM, IN_COLS, (const bf16_t*)(W + WS_P), NP, TT, flags + 100);
#elif DBG_CHECK == 5 || DBG_CHECK == 6
        hipLaunchKernelGGL(k_check_attn, dim3(16 * 24), dim3(256), 0, stream, (const unsigned char*)d_ws, DBG_CHECK == 5 ? 1 : 0, flags + 100);
#elif DBG_CHECK == 7
        { float* obuf = (float*)(W + WS_MQ);
          hipLaunchKernelGGL(k_check_gla_rec, dim3(8), dim3(256), 0, stream, (const unsigned char*)d_ws, (const float*)d_in[I_WA2F], (const float*)d_in[I_BAF], (const float*)d_in[I_WA2B], (const float*)d_in[I_BAB], obuf, 0);
          hipLaunchKernelGGL(k_check_gla_cmp, dim3(RPB * 4), dim3(256), 0, stream, (const unsigned char*)d_ws, (const float*)obuf, (const float*)d_in[I_ONG], 0, flags + 100); }
#elif DBG_CHECK == 1
        hipLaunchKernelGGL(k_check_gemm, dim3(32), dim3(256), 0, stream, (const bf16_t*)(W + WS_HB), DM, (const float*)d_in[I_PWQ], DM, DM, (const bf16_t*)(W + WS_PQ), DM, TT, flags + 100);
#elif DBG_CHECK == 2
        hipLaunchKernelGGL(k_check_select, dim3(256 * 8), dim3(64), 0, stream, (const bf16_t*)(W + WS_PQ), (const float*)d_in[I_PK1], (const float*)d_in[I_PK2], (const int*)(W + WS_PIDX), (const float*)(W + WS_PG), flags + 100);
#else
        hipLaunchKernelGGL(k_check_gather, dim3(128), dim3(64), 0, stream, (const bf16_t*)(W + WS_HB), (const float*)d_in[I_PU], (const float*)d_in[I_PV], (const int*)(W + WS_PIDX), (const float*)(W + WS_PG), (const float*)(W + WS_MQ), flags + 100);
#endif
        hipLaunchKernelGGL(k_dbg_out2, dim3(NBATCH * SEQ / 4), dim3(256), 0, stream, (const float*)d_in[0], (const float*)d_in[29], (float*)d_out, flags + 100);
    }
#elif MK_N_LAUNCHES == 1
#ifdef DBG_SPLIT
    for (int p = 0; p < N_PHASES; p += DBG_SPLIT) { a.ph_lo = p; a.ph_hi = p + DBG_SPLIT < N_PHASES ? p + DBG_SPLIT : N_PHASES; hipLaunchKernelGGL(mk_fwd, dim3(grid), dim3(NTHREADS), LDS_BYTES, stream, a); }
#else
    a.ph_lo = 0; a.ph_hi = N_PHASES;
    hipLaunchKernelGGL(mk_fwd, dim3(grid), dim3(NTHREADS), LDS_BYTES, stream, a);
#endif
#else
    a.ph_hi = 0;
#ifndef DBG_NLAUNCH
#define DBG_NLAUNCH 100
#endif
    int nl_ = 0;
#ifdef DBG_HYB
#define LAUNCH1(K, L) do { if (K == DBG_HYB) { a.ph_lo = 12 * (L) + (K); a.ph_hi = a.ph_lo + 1; hipLaunchKernelGGL(mk_fwd, dim3(grid), dim3(NTHREADS), LDS_BYTES, stream, a); a.ph_hi = 0; } else { a.ph_lo = (L); hipLaunchKernelGGL(k_one<K>, dim3(grid), dim3(NTHREADS), LDS_BYTES, stream, a); } } while (0)
#else
#define LAUNCH1(K, L) do { a.ph_lo = (L); if (nl_++ < DBG_NLAUNCH) { hipLaunchKernelGGL(k_one<K>, dim3(grid), dim3(NTHREADS), LDS_BYTES, stream, a); if (K == DBG_DUP) hipLaunchKernelGGL(k_one<K>, dim3(grid), dim3(NTHREADS), LDS_BYTES, stream, a); } } while (0)
#endif
#ifdef DBG_SCAN
    unsigned* flags = (unsigned*)((char*)d_ws + WS_CTL + 32768);
    char* W = (char*)d_ws;
#define S16(off, n, st) hipLaunchKernelGGL(k_scan16, dim3(1024), dim3(256), 0, stream, (const bf16_t*)(W + (off)), (size_t)(n), flags, st)
#define S32(off, n, st) hipLaunchKernelGGL(k_scan32, dim3(1024), dim3(256), 0, stream, (const float*)(W + (off)), (size_t)(n), flags, st)
    LAUNCH1(0, 0); S32(WS_MODV, 2 * 3 * 12288, 1);
    { const int l = 0;
      LAUNCH1(1, l); S16(WS_HB, (size_t)TT * DM, 2);
      LAUNCH1(2, l); S16(WS_P, (size_t)TT * NP, 3);
      LAUNCH1(3, l); S16(WS_P, (size_t)TT * NP, 4);
      LAUNCH1(4, l); S16(WS_MQ, (size_t)TT * 1536, 5); S16(WS_MKV, (size_t)TT * 2048, 5); S16(WS_GST, (size_t)2112 * 32768, 6); S32(WS_GDEC, (size_t)2112 * 128, 6);
      LAUNCH1(5, l); S16(WS_GST, (size_t)2112 * 32768, 7);
      LAUNCH1(6, l); S16(WS_OA, (size_t)TT * 1024, 8); S16(WS_OM, (size_t)TT * 1024, 9); S16(WS_OL, (size_t)TT * 1024, 10);
      LAUNCH1(7, l); S16(WS_Y, (size_t)TT * DM, 11);
      LAUNCH1(8, l); S32(WS_XS, (size_t)TT * DM, 12);
      LAUNCH1(9, l); S16(WS_HB, (size_t)TT * DM, 13);
      LAUNCH1(10, l); S16(WS_PQ, (size_t)TT * DM, 14);
      LAUNCH1(11, l); S32(WS_PG, (size_t)TT * 128, 15);
      LAUNCH1(12, l); S32(WS_XS, (size_t)TT * DM, 16);
    }
    hipLaunchKernelGGL(k_dbg_out, dim3(NBATCH * SEQ / 4), dim3(256), 0, stream, (const float*)d_in[0], (const float*)d_in[29], (float*)d_out, flags, 16);
#elif defined(DBG_CHECK)
    unsigned* flags = (unsigned*)((char*)d_ws + WS_CTL + 32768);
    char* W = (char*)d_ws;
    LAUNCH1(0, 0);
    { const int l = 0; LAUNCH1(1, l); LAUNCH1(2, l); LAUNCH1(3, l); LAUNCH1(4, l); LAUNCH1(5, l); LAUNCH1(6, l);
#if DBG_CHECK == 5 || DBG_CHECK == 6
      hipLaunchKernelGGL(k_check_attn, dim3(16 * 24), dim3(256), 0, stream, (const unsigned char*)d_ws, DBG_CHECK == 5 ? 1 : 0, flags + 100);
#endif
#if DBG_CHECK == 7
      { float* obuf = (float*)(W + WS_MQ);
        hipLaunchKernelGGL(k_check_gla_rec, dim3(8), dim3(256), 0, stream, (const unsigned char*)d_ws, (const float*)d_in[I_WA2F], (const float*)d_in[I_BAF], (const float*)d_in[I_WA2B], (const float*)d_in[I_BAB], obuf, 0);
        hipLaunchKernelGGL(k_check_gla_cmp, dim3(RPB * 4), dim3(256), 0, stream, (const unsigned char*)d_ws, (const float*)obuf, (const float*)d_in[I_ONG], 0, flags + 100); }
#endif
      LAUNCH1(7, l); LAUNCH1(8, l); LAUNCH1(9, l); LAUNCH1(10, l);
#if DBG_CHECK == 1
      hipLaunchKernelGGL(k_check_gemm, dim3(32), dim3(256), 0, stream, (const bf16_t*)(W + WS_HB), DM, (const float*)d_in[I_PWQ], DM, DM, (const bf16_t*)(W + WS_PQ), DM, TT, flags + 100);
#endif
      LAUNCH1(11, l);
#if DBG_CHECK == 2
      hipLaunchKernelGGL(k_check_select, dim3(256 * 8), dim3(64), 0, stream, (const bf16_t*)(W + WS_PQ), (const float*)d_in[I_PK1], (const float*)d_in[I_PK2], (const int*)(W + WS_PIDX), (const float*)(W + WS_PG), flags + 100);
#endif
      LAUNCH1(12, l);
#if DBG_CHECK == 3
      hipLaunchKernelGGL(k_check_gather, dim3(128), dim3(64), 0, stream, (const bf16_t*)(W + WS_HB), (const float*)d_in[I_PU], (const float*)d_in[I_PV], (const int*)(W + WS_PIDX), (const float*)(W + WS_PG), (const float*)(W + WS_MQ), flags + 100);
#endif
    }
    hipLaunchKernelGGL(k_dbg_out2, dim3(NBATCH * SEQ / 4), dim3(256), 0, stream, (const float*)d_in[0], (const float*)d_in[29], (float*)d_out, flags + 100);
#else
    LAUNCH1(0, 0);
    for (int l = 0; l < DEPTH; ++l) { LAUNCH1(1, l); LAUNCH1(2, l); LAUNCH1(3, l);
#ifdef DBG_DUP23
        LAUNCH1(2, l); LAUNCH1(3, l);
#endif
        LAUNCH1(4, l); LAUNCH1(5, l);
#ifdef DBG_DUP45
        LAUNCH1(4, l); LAUNCH1(5, l);
#endif
        LAUNCH1(6, l); LAUNCH1(7, l); LAUNCH1(8, l); LAUNCH1(9, l); LAUNCH1(10, l); LAUNCH1(11, l); LAUNCH1(12, l); }
    LAUNCH1(13, DEPTH - 1);
#endif
#undef LAUNCH1
#endif
    const hipError_t le = hipPeekAtLastError();
    if (le != hipSuccess) fprintf(stderr, "kernel_launch: launch failed: %s\n", hipGetErrorName(le));
}
```

```cpp
#include <hip/hip_runtime.h>
#include <cstdio>
#include <cstdint>

#ifndef MK_N_LAUNCHES
#ifndef DBG_DUP
#define DBG_DUP -1
#endif
#define MK_N_LAUNCHES 1
#endif

#ifndef DBG_MIX0
#define DBG_MIX0 1.0f
#define DBG_MIX1 1.0f
#define DBG_PEER0 1.0f
#define DBG_PEER1 1.0f
#endif
#ifndef MLA_NQR
#define MLA_NQR 4
#endif
#define LAS __attribute__((address_space(3)))
#define GLB __attribute__((address_space(1)))
typedef unsigned short bf16_t;
typedef short bf16x8 __attribute__((ext_vector_type(8)));
typedef short s16x4 __attribute__((ext_vector_type(4)));
typedef float f32x4 __attribute__((ext_vector_type(4)));
typedef float f32x2 __attribute__((ext_vector_type(2)));
typedef float f32x16 __attribute__((ext_vector_type(16)));
typedef unsigned u32x4 __attribute__((ext_vector_type(4)));
typedef unsigned u32x2 __attribute__((ext_vector_type(2)));
typedef __bf16 bf2_t __attribute__((ext_vector_type(2)));

constexpr int DM = 2048, NBATCH = 2, SEQ = 8192, CTXL = 256, DEPTH = 2;
constexpr int RPB = SEQ + CTXL;
constexpr int TT = NBATCH * RPB;
constexpr int IN_COLS = 11872, NP = 12032;
constexpr int C_AQ = 0, C_AK = 1024, C_AV = 1280, C_LQ = 1536, C_LK = 2048, C_LV = 2560, C_LG = 3584, C_LRF = 4608, C_LRB = 4624,
              C_MCQ = 4640, C_MCKV = 5152, C_MKR = 5664, C_GA = 5728, C_GL = 7776, C_GM = 9824;
constexpr int NCH = RPB / 64;
constexpr int NEXP = 16384;
constexpr float NORM_EPS = 1e-6f;
constexpr int NTHREADS = 512;

constexpr size_t al256(size_t x) { return (x + 255) / 256 * 256; }
constexpr size_t WS_CTL   = 0;
constexpr size_t CTL_BYTES = 65536;
constexpr size_t WS_MODV  = WS_CTL + CTL_BYTES;
constexpr size_t WS_TABA  = al256(WS_MODV + (size_t)2 * 3 * 12288 * 4);
constexpr size_t WS_TABM  = WS_TABA + 2 * 128 * 32 * 4;
constexpr size_t WS_XS    = al256(WS_TABM + 2 * 128 * 16 * 4);
constexpr size_t WS_HB    = WS_XS + (size_t)TT * DM * 4;
constexpr size_t WS_P     = WS_HB + (size_t)TT * DM * 2;
constexpr size_t WS_MQ    = WS_P + (size_t)TT * NP * 2;
constexpr size_t WS_MKV   = WS_MQ + (size_t)TT * 1536 * 2;
constexpr size_t WS_OA    = WS_MKV + (size_t)TT * 2048 * 2;
constexpr size_t WS_OL    = WS_OA + (size_t)TT * 1024 * 2;
constexpr size_t WS_OM    = WS_OL + (size_t)TT * 1024 * 2;
constexpr size_t WS_WIN   = WS_OM + (size_t)TT * 1024 * 2;
constexpr size_t WS_WUQ   = WS_WIN + (size_t)NP * 2048 * 2;
constexpr size_t WS_WUKV  = WS_WUQ + (size_t)1536 * 512 * 2;
constexpr size_t WS_WBR   = WS_WUKV + (size_t)2048 * 512 * 2;
constexpr size_t WS_WOUT  = WS_WBR + (size_t)3 * 2048 * 1024 * 2;
constexpr size_t WS_WQ    = WS_WOUT + (size_t)2048 * 2048 * 2;
constexpr size_t WS_K1    = WS_WQ + (size_t)2048 * 2048 * 2;
constexpr size_t WS_K2    = WS_K1 + (size_t)8 * 128 * 128 * 2;
constexpr size_t WS_GST   = WS_K2 + (size_t)8 * 128 * 128 * 2;
constexpr size_t WS_GDEC  = WS_GST + (size_t)NBATCH * 2 * 4 * NCH * 32768 * 2;
constexpr size_t WS_END0  = WS_GDEC + (size_t)NBATCH * 2 * 4 * NCH * 128 * 4;
constexpr size_t WS_KN8   = WS_OA + (size_t)TT * 1024;
constexpr size_t WS_AK8   = WS_OL + (size_t)TT * 1024;
constexpr size_t WS_KR8   = WS_AK8 + (size_t)TT * 256;
constexpr size_t WS_VT8A  = WS_KR8 + (size_t)TT * 64;
constexpr size_t WS_VT8M  = WS_OM + (size_t)TT * 1024;
constexpr size_t WS_Y     = WS_MKV;
constexpr size_t WS_PQ    = WS_OA;
constexpr size_t WS_PIDX  = WS_P;
constexpr size_t WS_PG    = WS_PIDX + (size_t)TT * 128 * 4;
constexpr size_t PT_BYTES = 2 * (size_t)NEXP * DM + 2 * (size_t)NEXP * 4;
constexpr size_t WS_WINS  = WS_END0;
constexpr size_t WS_WOUTS = al256(WS_WINS + (size_t)NP * 4);
constexpr size_t WS_WBRS  = al256(WS_WOUTS + (size_t)DM * 4);
constexpr size_t WS_PT    = al256(WS_WBRS + (size_t)3 * DM * 4);
constexpr size_t WS_END   = WS_PT + DEPTH * PT_BYTES;
constexpr size_t PT_U8 = 0, PT_V8 = (size_t)NEXP * DM, PT_SCU = 2 * (size_t)NEXP * DM, PT_SCV = PT_SCU + (size_t)NEXP * 4;
static_assert(WS_PG + (size_t)TT * 128 * 4 <= WS_MQ, "PEER alias region overflows P");

__device__ __forceinline__ unsigned cvt_pk_bf16(float lo, float hi) { bf2_t v; v.x = (__bf16)lo; v.y = (__bf16)hi; return __builtin_bit_cast(unsigned, v); }
__device__ __forceinline__ bf16_t f2bf(float f) { return (bf16_t)(cvt_pk_bf16(f, 0.f) & 0xffffu); }
__device__ __forceinline__ float bf2f(bf16_t b) { return __uint_as_float(((unsigned)b) << 16); }
__device__ __forceinline__ float bflo(unsigned w) { return __uint_as_float(w << 16); }
__device__ __forceinline__ float bfhi(unsigned w) { return __uint_as_float(w & 0xffff0000u); }
__device__ __forceinline__ float xchg32(float x, int lane) { auto r = __builtin_amdgcn_permlane32_swap(__float_as_uint(x), __float_as_uint(x), false, false); return __uint_as_float(lane < 32 ? r[1] : r[0]); }
__device__ __forceinline__ float xchg16(float x, int lane) { auto r = __builtin_amdgcn_permlane16_swap(__float_as_uint(x), __float_as_uint(x), false, false); return __uint_as_float((lane & 16) ? r[0] : r[1]); }
template <int CTRL> __device__ __forceinline__ float dppmov(float x) { return __uint_as_float(__builtin_amdgcn_update_dpp(0u, __float_as_uint(x), CTRL, 0xF, 0xF, false)); }
constexpr int DPP_ROR8 = 0x128, DPP_HMIRROR = 0x141, DPP_Q3210 = 0x1B, DPP_Q1032 = 0xB1;
__device__ __forceinline__ float wave_sum(float v) {
    const int lane = threadIdx.x & 63;
    v += xchg32(v, lane); v += xchg16(v, lane); v += dppmov<DPP_ROR8>(v); v += dppmov<DPP_HMIRROR>(v); v += dppmov<DPP_Q3210>(v); v += dppmov<DPP_Q1032>(v);
    return v;
}
__device__ __forceinline__ float sigmoidf_(float x) { return __builtin_amdgcn_rcpf(1.0f + __expf(-x)); }
__device__ __forceinline__ float siluf_(float x) { return x * __builtin_amdgcn_rcpf(1.0f + __expf(-x)); }

#define XB_TMO      128
#define XB_XCNT(j)  (256  + 64 * (j))
#define XB_XSUB(j)  (1280 + 64 * (j))
#define XB_XGEN(j)  (2304 + 64 * (j))
#define XB_TOP      3328
#define XB_TOPGEN   3392
#define XCD_BAR_WORDS 3456
#define XB_SPIN_CAP (1u << 20)
__device__ __forceinline__ unsigned xb_ld(unsigned* p)              { return __hip_atomic_load(p, __ATOMIC_RELAXED, __HIP_MEMORY_SCOPE_AGENT); }
__device__ __forceinline__ unsigned xb_add(unsigned* p, unsigned v) { return __hip_atomic_fetch_add(p, v, __ATOMIC_RELAXED, __HIP_MEMORY_SCOPE_AGENT); }
__device__ __forceinline__ unsigned xb_xcc_id() { return (unsigned)__builtin_amdgcn_s_getreg((3 << 11) | 20) & 0xFu; }
#define XB_SPIN(cond, bar) do { unsigned _sp = 0; while (cond) { __builtin_amdgcn_s_sleep(1); \
    if ((++_sp & 255u) == 0u) { if (xb_ld(&(bar)[XB_TMO])) break; if (_sp > XB_SPIN_CAP) { atomicAdd(&(bar)[XB_TMO], 1u); break; } } } } while (0)
struct XcdBarrier { unsigned* bar; unsigned x; volatile LAS unsigned* st; };
__device__ __forceinline__ XcdBarrier xcd_barrier_post(unsigned* bar, volatile LAS unsigned* st) {
    XcdBarrier b; b.bar = bar; b.x = xb_xcc_id(); b.st = st;
    if (threadIdx.x == 0) (void)xb_add(&bar[XB_XCNT(b.x)], 1u);
    return b;
}
__device__ __forceinline__ void xcd_barrier_complete(unsigned* bar, unsigned x, unsigned& nloc, unsigned& nx) {
    const unsigned G = gridDim.x * gridDim.y * gridDim.z;
    unsigned sum, cnt, mine, sp = 0u;
    for (;;) {
        sum = 0u; cnt = 0u; mine = 0u;
#pragma unroll
        for (unsigned j = 0; j < 16; ++j) { const unsigned c = xb_ld(&bar[XB_XCNT(j)]); sum += c; cnt += (c > 0u) ? 1u : 0u; mine = (j == x) ? c : mine; }
        if (sum == G) break;
        __builtin_amdgcn_s_sleep(1);
        if ((++sp & 255u) == 0u) { if (xb_ld(&bar[XB_TMO])) break; if (sp > XB_SPIN_CAP) { atomicAdd(&bar[XB_TMO], 1u); break; } }
    }
    nloc = mine > 0u ? mine : 1u; nx = cnt > 0u ? cnt : 1u;
}
__device__ __forceinline__ void xcd_barrier(const XcdBarrier& b) {
    asm volatile("s_waitcnt vmcnt(0)" ::: "memory");
    __syncthreads();
    if (threadIdx.x == 0) {
        unsigned* bar = b.bar;
        __builtin_amdgcn_s_waitcnt(0);
        unsigned nloc = b.st[0], nx = b.st[1];
        if (nloc == 0u) { xcd_barrier_complete(bar, b.x, nloc, nx); b.st[0] = nloc; b.st[1] = nx; }
        const unsigned old = xb_add(&bar[XB_XSUB(b.x)], 1u);
        const unsigned gen = old / nloc;
        if (old + 1u == (gen + 1u) * nloc) {
            __builtin_amdgcn_fence(__ATOMIC_RELEASE, "agent");
            asm volatile("s_waitcnt vmcnt(0)" ::: "memory");
            const unsigned og = xb_add(&bar[XB_TOP], 1u);
            const unsigned tg = og / nx;
            if (og + 1u == (tg + 1u) * nx) xb_add(&bar[XB_TOPGEN], 1u);
            else XB_SPIN(xb_ld(&bar[XB_TOPGEN]) == tg, bar);
            __builtin_amdgcn_fence(__ATOMIC_ACQUIRE, "agent");
            xb_add(&bar[XB_XGEN(b.x)], 1u);
            asm volatile("s_waitcnt vmcnt(0)" ::: "memory");
        } else {
            XB_SPIN(xb_ld(&bar[XB_XGEN(b.x)]) == gen, bar);
            __builtin_amdgcn_fence(__ATOMIC_ACQUIRE, "agent");
            asm volatile("s_waitcnt vmcnt(0)" ::: "memory");
        }
    }
    __syncthreads();
}

namespace pg8 {
constexpr int BM = 256, BK = 64, HALF = 128, HTB = HALF * BK * 2, STAGE_BYTES = 8 * HTB, NXCD = 8, WGM = 8;
__host__ __device__ __forceinline__ int lds_byte(int r, int c) { const int st = (r >> 4) * 2 + (c >> 5), rr = r & 15, cc = c & 31, ob = rr * 64 + cc * 2; return st * 1024 + (ob ^ (((ob >> 9) & 1) << 5)); }
__host__ __device__ __forceinline__ void stage_rc(int b, int& R, int& C) { const int st = b / 1024, sb = b % 1024, swz = sb ^ (((sb >> 9) & 1) << 5); R = (st >> 1) * 16 + swz / 64; C = (st & 1) * 32 + (swz % 64) / 2; }
__host__ __device__ __forceinline__ int perm32(int rho) { const int n = rho >> 4, i = rho & 15; return 8 * (i >> 2) + 4 * n + (i & 3); }
struct Unit { int pm, pn; };
struct Gemm { const bf16_t* A; const bf16_t* Bt; int M, N, K, lda, ldb; };
struct StaticOrder {
    int nM, nN, nwg, G, c, latent;
    __host__ __device__ void init(int M, int N, int G_, int c_, int latent_ = 0) { latent = latent_; nM = latent_ ? 64 : M / BM; nN = N / BM; nwg = nM * nN; G = G_; c = c_; }
    __host__ __device__ bool next(int i, Unit& u) const {
        const long L = (long)i * G + c; if (L >= nwg) return false;
        int wgid = (int)L; { const int q = nwg / NXCD, r = nwg % NXCD, xcd = wgid % NXCD, off = wgid / NXCD; wgid = (xcd < r ? xcd * (q + 1) : r * (q + 1) + (xcd - r) * q) + off; }
        const int nig = WGM * nN, gid = wgid / nig, fm = gid * WGM, gsz = (nM - fm) < WGM ? (nM - fm) : WGM;
        u.pm = fm + ((wgid % nig) % gsz); u.pn = (wgid % nig) / gsz; if (latent) u.pm += 1 + (u.pm >= 32 ? 1 : 0); return true;
    }
};
struct WinOrder {
    StaticOrder S; int full, nlat, G, c;
    __host__ __device__ void init(int G_, int c_, int full_) { full = full_; G = G_; c = c_; S.init(TT, NP, G_, c_, full_ ? 0 : 1); nlat = S.nwg; }
    __host__ __device__ bool next(int i, Unit& u) const {
        if (full) return S.next(i, u);
        const long L = (long)i * G + c;
        if (L < nlat) return S.next(i, u);
        const int q = (int)(L - nlat); if (q >= 24) return false;
        const int t = q % 12; u.pm = q < 12 ? 0 : 33;
        u.pn = t < 2 ? 4 + t : (t < 8 ? 8 + (t - 2) : (t == 8 ? 18 : 20 + (t - 9)));
        return true;
    }
};
struct EpiStoreBf16 {
    static constexpr bool PERM = true;
    bf16_t* O; int ldc;
    __device__ __forceinline__ void operator()(const f32x4 (&acc)[2][2][4][2], const Unit& u, int wr, int wc, int fr, int fq) const {
        const int row0 = u.pm * BM + wr * 64 + fr, col0 = u.pn * BM + wc * 32 + 8 * fq;
#pragma unroll
        for (int ai = 0; ai < 2; ++ai)
#pragma unroll
            for (int m = 0; m < 4; ++m) { bf16_t* rowp = O + (size_t)(row0 + ai * HALF + m * 16) * ldc + col0;
#pragma unroll
                for (int bj = 0; bj < 2; ++bj) { const f32x4 v0 = acc[ai][bj][m][0], v1 = acc[ai][bj][m][1];
                    u32x4 w; w.x = cvt_pk_bf16(v0[0], v0[1]); w.y = cvt_pk_bf16(v0[2], v0[3]); w.z = cvt_pk_bf16(v1[0], v1[1]); w.w = cvt_pk_bf16(v1[2], v1[3]);
                    *(u32x4*)(rowp + bj * HALF) = w; } }
    }
};
struct EpiNull {
    static constexpr bool PERM = true;
    __device__ __forceinline__ void operator()(const f32x4 (&acc)[2][2][4][2], const Unit&, int, int, int, int) const {
#pragma unroll
        for (int a = 0; a < 2; ++a)
#pragma unroll
            for (int b = 0; b < 2; ++b)
#pragma unroll
                for (int m = 0; m < 4; ++m)
#pragma unroll
                    for (int n = 0; n < 2; ++n) asm volatile("" :: "v"(acc[a][b][m][n]));
    }
};
struct EpiStoreMKV {
    static constexpr bool PERM = true;
    bf16_t* O; unsigned char* K8;
    __device__ __forceinline__ void operator()(const f32x4 (&acc)[2][2][4][2], const Unit& u, int wr, int wc, int fr, int fq) const {
        const int row0 = u.pm * BM + wr * 64 + fr, col0 = u.pn * BM + wc * 32 + 8 * fq;
#pragma unroll
        for (int ai = 0; ai < 2; ++ai)
#pragma unroll
            for (int m = 0; m < 4; ++m) { const size_t r = (size_t)(row0 + ai * HALF + m * 16); bf16_t* rowp = O + r * 2048 + col0;
#pragma unroll
                for (int bj = 0; bj < 2; ++bj) { const f32x4 v0 = acc[ai][bj][m][0], v1 = acc[ai][bj][m][1];
                    u32x4 w; w.x = cvt_pk_bf16(v0[0], v0[1]); w.y = cvt_pk_bf16(v0[2], v0[3]); w.z = cvt_pk_bf16(v1[0], v1[1]); w.w = cvt_pk_bf16(v1[2], v1[3]);
                    *(u32x4*)(rowp + bj * HALF) = w;
                    if (bj == 0) { int p0 = __builtin_amdgcn_cvt_pk_fp8_f32(v0[0], v0[1], 0, false); p0 = __builtin_amdgcn_cvt_pk_fp8_f32(v0[2], v0[3], p0, true);
                        int p1 = __builtin_amdgcn_cvt_pk_fp8_f32(v1[0], v1[1], 0, false); p1 = __builtin_amdgcn_cvt_pk_fp8_f32(v1[2], v1[3], p1, true);
                        u32x2 w8; w8.x = (unsigned)p0; w8.y = (unsigned)p1; *(u32x2*)(K8 + r * 1024 + u.pn * 128 + wc * 32 + 8 * fq) = w8; } } }
    }
};
struct EpiStoreBf16S {
    static constexpr bool PERM = true;
    bf16_t* O; int ldc; const float* cs;
    __device__ __forceinline__ void operator()(const f32x4 (&acc)[2][2][4][2], const Unit& u, int wr, int wc, int fr, int fq) const {
        const int row0 = u.pm * BM + wr * 64 + fr, col0 = u.pn * BM + wc * 32 + 8 * fq;
        f32x4 sv[2][2];
#pragma unroll
        for (int bj = 0; bj < 2; ++bj)
#pragma unroll
            for (int n = 0; n < 2; ++n) sv[bj][n] = *(const f32x4*)(cs + col0 + bj * HALF + 4 * n);
#pragma unroll
        for (int ai = 0; ai < 2; ++ai)
#pragma unroll
            for (int m = 0; m < 4; ++m) { bf16_t* rowp = O + (size_t)(row0 + ai * HALF + m * 16) * ldc + col0;
#pragma unroll
                for (int bj = 0; bj < 2; ++bj) { const f32x4 v0 = acc[ai][bj][m][0] * sv[bj][0], v1 = acc[ai][bj][m][1] * sv[bj][1];
                    u32x4 w; w.x = cvt_pk_bf16(v0[0], v0[1]); w.y = cvt_pk_bf16(v0[2], v0[3]); w.z = cvt_pk_bf16(v1[0], v1[1]); w.w = cvt_pk_bf16(v1[2], v1[3]);
                    *(u32x4*)(rowp + bj * HALF) = w; } }
    }
};
template <bool FIRST, bool F8OUT = false> struct EpiGate {
    static constexpr bool PERM = true;
    bf16_t* Y; const bf16_t* Gt; unsigned char* Y8; const float* cs;
    __device__ __forceinline__ void operator()(const f32x4 (&acc)[2][2][4][2], const Unit& u, int wr, int wc, int fr, int fq) const {
        constexpr int ldy = DM, ldg = NP, ldy8 = DM;
        const int row0 = u.pm * BM + wr * 64 + fr, col0 = u.pn * BM + wc * 32 + 8 * fq;
        f32x4 sv[2][2];
#pragma unroll
        for (int bj = 0; bj < 2; ++bj)
#pragma unroll
            for (int n = 0; n < 2; ++n) sv[bj][n] = *(const f32x4*)(cs + col0 + bj * HALF + 4 * n);
#pragma unroll
        for (int ai = 0; ai < 2; ++ai)
#pragma unroll
        for (int mh = 0; mh < 2; ++mh) {
            u32x4 g[2][2], y[2][2];
#pragma unroll
            for (int mm = 0; mm < 2; ++mm)
#pragma unroll
                for (int bj = 0; bj < 2; ++bj) { const size_t r = (size_t)(row0 + ai * HALF + (mh * 2 + mm) * 16);
                    g[mm][bj] = *(const u32x4*)(Gt + r * ldg + col0 + bj * HALF);
                    if (!FIRST) y[mm][bj] = *(const u32x4*)(Y + r * ldy + col0 + bj * HALF); }
#pragma unroll
            for (int mm = 0; mm < 2; ++mm)
#pragma unroll
                for (int bj = 0; bj < 2; ++bj) { const int m = mh * 2 + mm; const size_t r = (size_t)(row0 + ai * HALF + m * 16); const f32x4 v0 = acc[ai][bj][m][0] * sv[bj][0], v1 = acc[ai][bj][m][1] * sv[bj][1]; const u32x4 gg = g[mm][bj];
                    float o[8];
                    o[0] = sigmoidf_(bflo(gg.x)) * v0[0]; o[1] = sigmoidf_(bfhi(gg.x)) * v0[1]; o[2] = sigmoidf_(bflo(gg.y)) * v0[2]; o[3] = sigmoidf_(bfhi(gg.y)) * v0[3];
                    o[4] = sigmoidf_(bflo(gg.z)) * v1[0]; o[5] = sigmoidf_(bfhi(gg.z)) * v1[1]; o[6] = sigmoidf_(bflo(gg.w)) * v1[2]; o[7] = sigmoidf_(bfhi(gg.w)) * v1[3];
                    if (!FIRST) { const u32x4 yy = y[mm][bj];
                        o[0] += bflo(yy.x); o[1] += bfhi(yy.x); o[2] += bflo(yy.y); o[3] += bfhi(yy.y); o[4] += bflo(yy.z); o[5] += bfhi(yy.z); o[6] += bflo(yy.w); o[7] += bfhi(yy.w); }
                    if constexpr (F8OUT) { int p0 = __builtin_amdgcn_cvt_pk_fp8_f32(o[0], o[1], 0, false); p0 = __builtin_amdgcn_cvt_pk_fp8_f32(o[2], o[3], p0, true);
                        int p1 = __builtin_amdgcn_cvt_pk_fp8_f32(o[4], o[5], 0, false); p1 = __builtin_amdgcn_cvt_pk_fp8_f32(o[6], o[7], p1, true);
                        u32x2 w8; w8.x = (unsigned)p0; w8.y = (unsigned)p1; *(u32x2*)(Y8 + r * ldy8 + col0 + bj * HALF) = w8; }
                    else { u32x4 w; w.x = cvt_pk_bf16(o[0], o[1]); w.y = cvt_pk_bf16(o[2], o[3]); w.z = cvt_pk_bf16(o[4], o[5]); w.w = cvt_pk_bf16(o[6], o[7]);
                        *(u32x4*)(Y + r * ldy + col0 + bj * HALF) = w; } }
        }
    }
};
template <bool CS> struct EpiResidT {
    static constexpr bool PERM = false;
    float* X; int ldx; const float* gate; const float* cs;
    __device__ __forceinline__ void operator()(const f32x4 (&acc)[2][2][4][2], const Unit& u, int wr, int wc, int fr, int fq) const {
        const int row0 = u.pm * BM + wr * 64 + fr, col0 = u.pn * BM + wc * 32 + 4 * fq;
        const int sel = (u.pm % 33 == 0) ? 2 : (u.pm / 33);
        const float* gp = gate + (size_t)sel * 12288 + col0;
        f32x4 gv[2][2];
#pragma unroll
        for (int bj = 0; bj < 2; ++bj)
#pragma unroll
            for (int n = 0; n < 2; ++n) { gv[bj][n] = *(const f32x4*)(gp + bj * HALF + n * 16); if constexpr (CS) gv[bj][n] = gv[bj][n] * *(const f32x4*)(cs + col0 + bj * HALF + n * 16); }
#pragma unroll
        for (int ai = 0; ai < 2; ++ai)
#pragma unroll
            for (int mh = 0; mh < 2; ++mh) {
                f32x4 x[2][2][2];
#pragma unroll
                for (int mm = 0; mm < 2; ++mm)
#pragma unroll
                    for (int bj = 0; bj < 2; ++bj)
#pragma unroll
                        for (int n = 0; n < 2; ++n) x[mm][bj][n] = *(const f32x4*)(X + (size_t)(row0 + ai * HALF + (mh * 2 + mm) * 16) * ldx + col0 + bj * HALF + n * 16);
#pragma unroll
                for (int mm = 0; mm < 2; ++mm)
#pragma unroll
                    for (int bj = 0; bj < 2; ++bj)
#pragma unroll
                        for (int n = 0; n < 2; ++n) *(f32x4*)(X + (size_t)(row0 + ai * HALF + (mh * 2 + mm) * 16) * ldx + col0 + bj * HALF + n * 16) = x[mm][bj][n] + gv[bj][n] * acc[ai][bj][mh * 2 + mm][n];
            }
    }
};

typedef int i32x8 __attribute__((ext_vector_type(8)));
typedef int i32x4 __attribute__((ext_vector_type(4)));
__device__ __forceinline__ i32x8 cat8(const bf16x8 lo, const bf16x8 hi) { const i32x4 a = __builtin_bit_cast(i32x4, lo), b = __builtin_bit_cast(i32x4, hi); return __builtin_shufflevector(a, b, 0, 1, 2, 3, 4, 5, 6, 7); }
template <class Epi, class Sched, int F8 = 0>
__device__ __forceinline__ void gemm_phase(LAS unsigned char* lds, const int tid, const Gemm g, const Sched& S, const Epi& E) {
    const int wid = __builtin_amdgcn_readfirstlane(tid >> 6), lane = tid & 63, wr = wid >> 2, wc = wid & 3, fr = lane & 15, fq = lane >> 4;
    const int K = g.K, nt = F8 ? K / 128 : K / BK, lda = g.lda, ldb = g.ldb;
    unsigned voffA[2], voffB[2];
#pragma unroll
    for (int i = 0; i < 2; ++i) { int R, C; stage_rc(tid * 16 + i * 8192, R, C); const int Rb = Epi::PERM ? ((R & ~31) + perm32(R & 31)) : R;
        voffA[i] = F8 ? (unsigned)(R * lda + C * 2) : (unsigned)(R * lda + C) * 2u; voffB[i] = F8 ? (unsigned)(Rb * ldb + C * 2) : (unsigned)(Rb * ldb + C) * 2u; }
    const size_t kstep = (size_t)(BK * 2);
    const size_t hstepA = (size_t)HALF * lda * (F8 ? 1 : 2), hstepB = (size_t)HALF * ldb * (F8 ? 1 : 2);
    const size_t tstepA = 2 * hstepA, tstepB = 2 * hstepB;
    const unsigned ldsw = (unsigned)wid * 1024u;
    const int aoff = F8 ? lds_byte(wr * 64 + fr, (fq & 1) * 16) + (fq >> 1) * 1024 : lds_byte(wr * 64 + fr, fq * 8);
    const int boff = F8 ? lds_byte(wc * 32 + fr, (fq & 1) * 16) + (fq >> 1) * 1024 : lds_byte(wc * 32 + fr, fq * 8);
#define PG8_SA(b, h) (((b) * 2 + (h)) * HTB)
#define PG8_SB(b, h) ((4 + (b) * 2 + (h)) * HTB)
#define PG8_STAGE(bufoff, gbase, voff) do { _Pragma("unroll") for (int _i = 0; _i < 2; ++_i) \
        __builtin_amdgcn_global_load_lds((const unsigned*)((const char*)(gbase) + (voff)[_i]), (LAS unsigned*)(lds + (bufoff) + ldsw + _i * 8192), 16, 0, 0); } while (0)
#define PG8_LDA(dst, b, h) do { if constexpr (F8) { _Pragma("unroll") for (int m = 0; m < 4; ++m) { const LAS unsigned char* p_ = lds + PG8_SA(b, h) + aoff + m * 2048; \
            const i32x4 lo_ = *(const LAS i32x4*)p_, hi_ = *(const LAS i32x4*)(p_ + 16); dst##8[m] = __builtin_shufflevector(lo_, hi_, 0, 1, 2, 3, 4, 5, 6, 7); } } \
        else { _Pragma("unroll") for (int m = 0; m < 4; ++m) _Pragma("unroll") for (int k = 0; k < 2; ++k) dst[m][k] = *(const LAS bf16x8*)(lds + PG8_SA(b, h) + aoff + m * 2048 + k * 1024); } } while (0)
#define PG8_LDB(dst, b, h) do { if constexpr (F8) { _Pragma("unroll") for (int n = 0; n < 2; ++n) { const LAS unsigned char* p_ = lds + PG8_SB(b, h) + boff + n * 2048; \
            const i32x4 lo_ = *(const LAS i32x4*)p_, hi_ = *(const LAS i32x4*)(p_ + 16); dst##8[n] = __builtin_shufflevector(lo_, hi_, 0, 1, 2, 3, 4, 5, 6, 7); } } \
        else { _Pragma("unroll") for (int n = 0; n < 2; ++n) _Pragma("unroll") for (int k = 0; k < 2; ++k) dst[n][k] = *(const LAS bf16x8*)(lds + PG8_SB(b, h) + boff + n * 2048 + k * 1024); } } while (0)
#define PG8_MMA(ai, bj, At, Bt) do { __builtin_amdgcn_s_setprio(1); \
        if constexpr (F8) { _Pragma("unroll") for (int m = 0; m < 4; ++m) _Pragma("unroll") for (int n = 0; n < 2; ++n) \
            asm volatile("v_mfma_scale_f32_16x16x128_f8f6f4 %0, %1, %2, %0, %3, %3 op_sel_hi:[0,0,0]" : "+v"(acc[ai][bj][m][n]) : "v"(Bt##8[n]), "v"(At##8[m]), "v"(mxscale)); } \
        else { _Pragma("unroll") for (int m = 0; m < 4; ++m) _Pragma("unroll") for (int n = 0; n < 2; ++n) _Pragma("unroll") for (int k = 0; k < 2; ++k) \
            acc[ai][bj][m][n] = __builtin_amdgcn_mfma_f32_16x16x32_bf16(Bt[n][k], At[m][k], acc[ai][bj][m][n], 0, 0, 0); } \
        __builtin_amdgcn_s_setprio(0); } while (0)
#define PG8_WAIT_V(n) asm volatile("s_waitcnt vmcnt(" #n ")" ::: "memory")
#define PG8_WAIT_L(n) asm volatile("s_waitcnt lgkmcnt(" #n ")" ::: "memory")
#define PG8_BAR __builtin_amdgcn_s_barrier()
#define PG8_SCHED __builtin_amdgcn_sched_barrier(0)
    Unit cur, nxt; int ui = 0;
    if (!S.next(0, cur)) return;
    f32x4 acc[2][2][4][2];
#pragma unroll
    for (int a = 0; a < 2; ++a)
#pragma unroll
        for (int b = 0; b < 2; ++b)
#pragma unroll
            for (int m = 0; m < 4; ++m)
#pragma unroll
                for (int n = 0; n < 2; ++n) acc[a][b][m][n] = (f32x4){0.f, 0.f, 0.f, 0.f};
    int mxscale = 0x7f7f7f7f; asm volatile("" : "+v"(mxscale));
    bf16x8 At[4][2], B0[2][2], B1[2][2]; i32x8 At8[4], B08[2], B18[2];
    const char* cA = (const char*)g.A + (size_t)cur.pm * tstepA; const char* cB = (const char*)g.Bt + (size_t)cur.pn * tstepB;
    PG8_STAGE(PG8_SB(0, 0), cB, voffB); PG8_STAGE(PG8_SA(0, 0), cA, voffA); PG8_STAGE(PG8_SB(0, 1), cB + hstepB, voffB); PG8_STAGE(PG8_SA(0, 1), cA + hstepA, voffA);
    if (wr == 1) PG8_BAR;
    PG8_WAIT_V(4); PG8_BAR;
    PG8_STAGE(PG8_SB(1, 0), cB + kstep, voffB); PG8_STAGE(PG8_SA(1, 0), cA + kstep, voffA); PG8_STAGE(PG8_SB(1, 1), cB + hstepB + kstep, voffB);
    PG8_WAIT_V(6); PG8_BAR;
    for (;;) {
        const bool has_next = S.next(ui + 1, nxt);
        const char* nA = has_next ? (const char*)g.A + (size_t)nxt.pm * tstepA : cA; const char* nB = has_next ? (const char*)g.Bt + (size_t)nxt.pn * tstepB : cB;
        for (int t = 0; t < nt; t += 2) {
            const bool last = (t == nt - 2);
            const char* a1 = cA + (size_t)(t + 1) * kstep;
            const char* a2 = last ? nA : cA + (size_t)(t + 2) * kstep; const char* b2 = last ? nB : cB + (size_t)(t + 2) * kstep;
            const char* a3 = a2 + kstep; const char* b3 = b2 + kstep;
            PG8_LDB(B0, 0, 0); PG8_SCHED; PG8_LDA(At, 0, 0); PG8_STAGE(PG8_SA(1, 1), a1 + hstepA, voffA);
            PG8_WAIT_L(8); PG8_BAR; PG8_WAIT_L(0); PG8_MMA(0, 0, At, B0); PG8_BAR; PG8_SCHED;
            PG8_LDB(B1, 0, 1); PG8_STAGE(PG8_SB(0, 0), b2, voffB);
            PG8_BAR; PG8_WAIT_L(0); PG8_MMA(0, 1, At, B1); PG8_BAR;
            PG8_LDA(At, 0, 1); PG8_STAGE(PG8_SA(0, 0), a2, voffA);
            PG8_BAR; PG8_WAIT_L(0); PG8_MMA(1, 0, At, B0); PG8_BAR; PG8_SCHED;
            PG8_STAGE(PG8_SB(0, 1), b2 + hstepB, voffB);
            PG8_WAIT_V(6); PG8_BAR; PG8_MMA(1, 1, At, B1); PG8_BAR;
            PG8_LDB(B0, 1, 0); PG8_SCHED; PG8_LDA(At, 1, 0); PG8_STAGE(PG8_SA(0, 1), a2 + hstepA, voffA);
            PG8_WAIT_L(8); PG8_BAR; PG8_WAIT_L(0); PG8_MMA(0, 0, At, B0); PG8_BAR; PG8_SCHED;
            PG8_LDB(B1, 1, 1); PG8_STAGE(PG8_SB(1, 0), b3, voffB);
            PG8_BAR; PG8_WAIT_L(0); PG8_MMA(0, 1, At, B1); PG8_BAR;
            PG8_LDA(At, 1, 1); PG8_STAGE(PG8_SA(1, 0), a3, voffA);
            PG8_BAR; PG8_WAIT_L(0); PG8_MMA(1, 0, At, B0); PG8_BAR; PG8_SCHED;
            PG8_STAGE(PG8_SB(1, 1), b3 + hstepB, voffB);
            PG8_WAIT_V(6); PG8_BAR; PG8_MMA(1, 1, At, B1); PG8_BAR;
        }
        if constexpr (F8) asm volatile("s_nop 15\n\ts_nop 7");
        E(acc, cur, wr, wc, fr, fq);
        if (!has_next) break;
#pragma unroll
        for (int a = 0; a < 2; ++a)
#pragma unroll
            for (int b = 0; b < 2; ++b)
#pragma unroll
                for (int m = 0; m < 4; ++m)
#pragma unroll
                    for (int n = 0; n < 2; ++n) acc[a][b][m][n] = (f32x4){0.f, 0.f, 0.f, 0.f};
        cur = nxt; cA = nA; cB = nB; ++ui;
    }
    PG8_WAIT_V(0);
    if (wr == 0) PG8_BAR;
    PG8_BAR;
#undef PG8_SA
#undef PG8_SB
#undef PG8_STAGE
#undef PG8_LDA
#undef PG8_LDB
#undef PG8_MMA
#undef PG8_WAIT_V
#undef PG8_WAIT_L
#undef PG8_BAR
#undef PG8_SCHED
}
}

struct Args { const float* in[30]; float* out; unsigned char* ws; int ph_lo, ph_hi; };
enum { I_X = 0, I_C, I_CTX, I_CCTX, I_WMOD, I_BMOD, I_N1G, I_WIN, I_QNG, I_KNG, I_WA2F, I_BAF, I_WA2B, I_BAB, I_ONG, I_MQNG, I_WUQ, I_MKVNG, I_WUKV,
       I_WBRA, I_WBRL, I_WBRM, I_WOUT, I_N2G, I_PWQ, I_PK1, I_PK2, I_PU, I_PV, I_FG };
typedef const float* cfp_t;
struct Ctx {
    const __attribute__((address_space(4))) cfp_t* in; float* out; unsigned char* ws; LAS unsigned char* lds;
    int tid, lane, wid, G, bid;
};
#define WSP(T, off) ((T*)(C.ws + (off)))
#define INP(i) ((const float*)(const GLB float*)C.in[(i)])
__device__ __forceinline__ unsigned long long launder_u64(unsigned long long w) {
    unsigned lo = (unsigned)w, hi = (unsigned)(w >> 32); asm volatile("" : "+v"(lo), "+v"(hi));
    lo = __builtin_amdgcn_readfirstlane(lo); hi = __builtin_amdgcn_readfirstlane(hi); return ((unsigned long long)hi << 32) | lo;
}
__device__ __forceinline__ Ctx launder(const Ctx& C0) {
    Ctx R = C0; int t = C0.tid; asm volatile("" : "+v"(t)); R.tid = t; R.lane = t & 63; R.wid = __builtin_amdgcn_readfirstlane(t >> 6);
    R.ws = (unsigned char*)(GLB unsigned char*)launder_u64((unsigned long long)C0.ws);
    R.out = (float*)(GLB float*)(unsigned long long)C0.out;
    R.in = (const __attribute__((address_space(4))) cfp_t*)launder_u64((unsigned long long)C0.in);
    unsigned l = (unsigned)(uintptr_t)C0.lds; asm volatile("" : "+v"(l)); l = __builtin_amdgcn_readfirstlane(l); R.lds = (LAS unsigned char*)(uintptr_t)l;
    return R;
}

__device__ __forceinline__ const float* src_row(const Ctx& C, int r) {
    const int b = r / RPB, j = r % RPB;
    return j < CTXL ? INP(I_CTX) + ((size_t)b * CTXL + j) * DM : INP(I_X) + ((size_t)b * SEQ + (j - CTXL)) * DM;
}
__device__ __forceinline__ int mod_sel(int r) { const int b = r / RPB, j = r % RPB; return j < CTXL ? 2 : b; }

__device__ __forceinline__ void phase_modv(const Ctx& C) {
    LAS float* sc = (LAS float*)C.lds;
    LAS float* red = (LAS float*)(C.lds + 3 * 2048 * 4);
    for (int i = C.tid; i < 3 * DM; i += NTHREADS) { const int r = i / DM, k = i % DM; const float v = r < 2 ? INP(I_C)[r * DM + k] : INP(I_CCTX)[k]; sc[i] = siluf_(v); }
    __syncthreads();
    float* modv = WSP(float, WS_MODV);
    const int kq = C.tid / 12, c4 = C.tid % 12;
    for (int item = C.bid; item < 2 * 256; item += C.G) {
        const int l = item / 256, cg = item % 256;
        float acc[3][4];
#pragma unroll
        for (int r = 0; r < 3; ++r)
#pragma unroll
            for (int j = 0; j < 4; ++j) acc[r][j] = 0.f;
        if (kq < 42) {
            const float* wp = INP(I_WMOD) + (size_t)l * DM * 12288 + 48 * cg + 4 * c4;
#pragma unroll 1
            for (int k0 = kq; k0 < DM; k0 += 42 * 7) {
                f32x4 w[7];
#pragma unroll
                for (int u = 0; u < 7; ++u) { const int k = k0 + 42 * u; w[u] = k < DM ? *(const f32x4*)(wp + (size_t)k * 12288) : (f32x4){0.f, 0.f, 0.f, 0.f}; }
#pragma unroll
                for (int u = 0; u < 7; ++u) { const int k = k0 + 42 * u; if (k < DM) {
#pragma unroll
                    for (int r = 0; r < 3; ++r) { const float sv = sc[r * DM + k];
#pragma unroll
                        for (int j = 0; j < 4; ++j) acc[r][j] += sv * w[u][j]; } } }
            }
#pragma unroll
            for (int r = 0; r < 3; ++r)
#pragma unroll
                for (int j = 0; j < 4; ++j) red[kq * 144 + r * 48 + c4 * 4 + j] = acc[r][j];
        }
        __syncthreads();
        if (C.tid < 144) { float s = 0.f; for (int q = 0; q < 42; ++q) s += red[q * 144 + C.tid];
            const int r = C.tid / 48, cc = C.tid % 48;
            modv[((size_t)l * 3 + r) * 12288 + 48 * cg + cc] = s + INP(I_BMOD)[(size_t)l * 12288 + 48 * cg + cc]; }
        __syncthreads();
    }
}
__device__ __forceinline__ void phase_tables(const Ctx& C) {
    float* ta = WSP(float, WS_TABA); float* tm = WSP(float, WS_TABM);
    for (int i = C.bid * NTHREADS + C.tid; i < 128 * 32 + 128 * 16; i += C.G * NTHREADS) {
        if (i < 128 * 32) { const int pos = i / 32, f = i % 32; const float inv = exp2f(-(float)f * (13.287712379549449f / 32.0f)); const float a = (float)pos * inv;
            ta[i] = cosf(a); ta[128 * 32 + i] = sinf(a); }
        else { const int k = i - 128 * 32, pos = k / 16, f = k % 16; const float inv = exp2f(-(float)f * (13.287712379549449f / 16.0f)); const float a = (float)pos * inv;
            tm[k] = cosf(a); tm[128 * 16 + k] = sinf(a); }
    }
}
__device__ __forceinline__ void transpose_cvt(const Ctx& C, const float* src, int K, int N, bf16_t* dst, int Npad, int& item) {
    LAS float* tile = (LAS float*)C.lds;
    const int tk = K / 64, tn = Npad / 256, ntile = tk * tn;
    const int t0 = ((C.bid - item % C.G) + C.G) % C.G; item += ntile;
    for (int t = t0; t < ntile; t += C.G) {
        const int k0 = (t / tn) * 64, n0 = (t % tn) * 256;
        const int nn = (C.tid & 63) * 4, kr = C.tid >> 6;
        f32x4 v[8];
#pragma unroll
        for (int p = 0; p < 8; ++p) { v[p] = (f32x4){0.f, 0.f, 0.f, 0.f}; if (n0 + nn < N) v[p] = *(const f32x4*)(src + (size_t)(k0 + kr + p * 8) * N + n0 + nn); }
#pragma unroll
        for (int p = 0; p < 8; ++p)
#pragma unroll
            for (int j = 0; j < 4; ++j) tile[(kr + p * 8) * 257 + nn + j] = v[p][j];
        __syncthreads();
        { const int n = C.tid >> 1, kh = (C.tid & 1) * 32;
#pragma unroll
          for (int q = 0; q < 4; ++q) { float x[8];
#pragma unroll
              for (int j = 0; j < 8; ++j) x[j] = tile[(kh + q * 8 + j) * 257 + n];
              u32x4 w; w.x = cvt_pk_bf16(x[0], x[1]); w.y = cvt_pk_bf16(x[2], x[3]); w.z = cvt_pk_bf16(x[4], x[5]); w.w = cvt_pk_bf16(x[6], x[7]);
              *(u32x4*)(dst + (size_t)(n0 + n) * K + k0 + kh + q * 8) = w; } }
        __syncthreads();
    }
}
__device__ __forceinline__ void transpose_cvt_fp8(const Ctx& C, const float* src, int K, int N, unsigned char* dst, int Npad, float* cinv, const float cmul = 1.0f, const int wg_off = 0) {
    LAS float* tile = (LAS float*)C.lds;
    LAS float* red = (LAS float*)(C.lds + 64 * 65 * 4);
    LAS float* scl = red + 32 * 64;
    const int kk = C.tid >> 4, nn = (C.tid & 15) * 4;
    for (int cgp = ((C.bid - wg_off) % C.G + C.G) % C.G; cgp < Npad / 64; cgp += C.G) {
        const int n0 = cgp * 64; const bool live = n0 + nn < N;
        float am[4] = {0.f, 0.f, 0.f, 0.f};
        for (int k0 = 0; k0 < K; k0 += 128) {
            f32x4 v[4];
#pragma unroll
            for (int p = 0; p < 4; ++p) v[p] = live ? *(const f32x4*)(src + (size_t)(k0 + kk + p * 32) * N + n0 + nn) : (f32x4){0.f, 0.f, 0.f, 0.f};
#pragma unroll
            for (int p = 0; p < 4; ++p)
#pragma unroll
                for (int j = 0; j < 4; ++j) am[j] = fmaxf(am[j], fabsf(v[p][j])); }
#pragma unroll
        for (int j = 0; j < 4; ++j) red[kk * 64 + nn + j] = am[j];
        __syncthreads();
        if (C.tid < 64) { float m = 0.f; for (int q = 0; q < 32; ++q) m = fmaxf(m, red[q * 64 + C.tid]);
            scl[C.tid] = m > 0.f ? 224.0f / m : 1.0f; cinv[n0 + C.tid] = (m > 0.f ? m * (1.0f / 224.0f) : 1.0f) * cmul; }
        __syncthreads();
        for (int k0 = 0; k0 < K; k0 += 64) {
#pragma unroll
            for (int p = 0; p < 2; ++p) { const f32x4 v = live ? *(const f32x4*)(src + (size_t)(k0 + kk + p * 32) * N + n0 + nn) : (f32x4){0.f, 0.f, 0.f, 0.f};
#pragma unroll
                for (int j = 0; j < 4; ++j) tile[(kk + p * 32) * 65 + nn + j] = v[j]; }
            __syncthreads();
            { const int n = C.tid >> 3, k8 = (C.tid & 7) * 8; const float sc = scl[n]; float x[8];
#pragma unroll
              for (int j = 0; j < 8; ++j) x[j] = tile[(k8 + j) * 65 + n] * sc;
              int p0 = __builtin_amdgcn_cvt_pk_fp8_f32(x[0], x[1], 0, false); p0 = __builtin_amdgcn_cvt_pk_fp8_f32(x[2], x[3], p0, true);
              int p1 = __builtin_amdgcn_cvt_pk_fp8_f32(x[4], x[5], 0, false); p1 = __builtin_amdgcn_cvt_pk_fp8_f32(x[6], x[7], p1, true);
              u32x2 w; w.x = (unsigned)p0; w.y = (unsigned)p1; *(u32x2*)(dst + (size_t)(n0 + n) * K + k0 + k8) = w; }
            __syncthreads();
        }
    }
}
__device__ __forceinline__ void cvt_plain(const Ctx& C, const float* src, bf16_t* dst, size_t n8) {
    for (size_t i = (size_t)C.bid * NTHREADS + C.tid; i < n8; i += (size_t)C.G * NTHREADS) {
        const f32x4 a = *(const f32x4*)(src + i * 8), b = *(const f32x4*)(src + i * 8 + 4);
        u32x4 w; w.x = cvt_pk_bf16(a[0], a[1]); w.y = cvt_pk_bf16(a[2], a[3]); w.z = cvt_pk_bf16(b[0], b[1]); w.w = cvt_pk_bf16(b[2], b[3]);
        *(u32x4*)(dst + i * 8) = w;
    }
}
__device__ __forceinline__ void phase_cvt_mixer_weights(const Ctx& C, int l) {
    int item = 0;
    transpose_cvt_fp8(C, INP(I_WIN) + (size_t)l * DM * IN_COLS, DM, IN_COLS, C.ws + WS_WIN, NP, WSP(float, WS_WINS));
    __syncthreads();
    transpose_cvt(C, INP(I_WUQ) + (size_t)l * 512 * 1536, 512, 1536, WSP(bf16_t, WS_WUQ), 1536, item);
    transpose_cvt(C, INP(I_WUKV) + (size_t)l * 512 * 2048, 512, 2048, WSP(bf16_t, WS_WUKV), 2048, item);
    transpose_cvt_fp8(C, INP(I_WBRA) + (size_t)l * 1024 * 2048, 1024, 2048, C.ws + WS_WBR, 2048, WSP(float, WS_WBRS), 1.0f / 32.0f, 220); __syncthreads();
    transpose_cvt_fp8(C, INP(I_WBRL) + (size_t)l * 1024 * 2048, 1024, 2048, C.ws + WS_WBR + (size_t)2048 * 1024, 2048, WSP(float, WS_WBRS) + DM, 1.0f, 220); __syncthreads();
    transpose_cvt_fp8(C, INP(I_WBRM) + (size_t)l * 1024 * 2048, 1024, 2048, C.ws + WS_WBR + (size_t)2 * 2048 * 1024, 2048, WSP(float, WS_WBRS) + 2 * DM, 1.0f / 32.0f, 252); __syncthreads();
    transpose_cvt_fp8(C, INP(I_WOUT) + (size_t)l * 2048 * 2048, 2048, 2048, C.ws + WS_WOUT, 2048, WSP(float, WS_WOUTS), 1.0f, 188);
    __syncthreads();
    transpose_cvt(C, INP(I_PWQ) + (size_t)l * 2048 * 2048, 2048, 2048, WSP(bf16_t, WS_WQ), 2048, item);
    cvt_plain(C, INP(I_PK1) + (size_t)l * 8 * 128 * 128, WSP(bf16_t, WS_K1), 8 * 128 * 128 / 8);
    cvt_plain(C, INP(I_PK2) + (size_t)l * 8 * 128 * 128, WSP(bf16_t, WS_K2), 8 * 128 * 128 / 8);
}
__device__ __forceinline__ void phase_cvt_peer_tables(const Ctx& C, int l, int row_lo, int row_hi, int wg_lo) {
    const int lane = C.lane; if (C.bid < wg_lo) return;
    unsigned char* pt = C.ws + WS_PT + (size_t)l * PT_BYTES;
    for (int row = row_lo + (C.bid - wg_lo) * 8 + C.wid; row < row_hi; row += (C.G - wg_lo) * 8) {
#pragma unroll 1
        for (int tb = 0; tb < 2; ++tb) {
            const float* src = (tb ? INP(I_PV) : INP(I_PU)) + ((size_t)l * NEXP + row) * DM + lane * 16;
            f32x4 x[8]; float amax = 0.f;
#pragma unroll
            for (int c = 0; c < 2; ++c)
#pragma unroll
                for (int q = 0; q < 4; ++q) { x[c * 4 + q] = *(const f32x4*)(src + c * 1024 + q * 4);
                    amax = fmaxf(amax, fmaxf(fmaxf(fabsf(x[c * 4 + q][0]), fabsf(x[c * 4 + q][1])), fmaxf(fabsf(x[c * 4 + q][2]), fabsf(x[c * 4 + q][3])))); }
            amax = fmaxf(amax, xchg32(amax, lane)); amax = fmaxf(amax, xchg16(amax, lane)); amax = fmaxf(amax, dppmov<DPP_ROR8>(amax));
            amax = fmaxf(amax, dppmov<DPP_HMIRROR>(amax)); amax = fmaxf(amax, dppmov<DPP_Q3210>(amax)); amax = fmaxf(amax, dppmov<DPP_Q1032>(amax));
            const float sc = amax > 0.f ? 224.0f / amax : 1.0f, inv = amax > 0.f ? amax * (1.0f / 224.0f) : 1.0f;
            unsigned char* dst = pt + (tb ? PT_V8 : PT_U8) + (size_t)(lane >> 3) * ((size_t)NEXP * 128) + (size_t)row * 128 + (lane & 7) * 16;
#pragma unroll
            for (int c = 0; c < 2; ++c) { u32x4 w;
#pragma unroll
                for (int q = 0; q < 4; ++q) { const f32x4 v = x[c * 4 + q] * sc; int p = __builtin_amdgcn_cvt_pk_fp8_f32(v[0], v[1], 0, false); p = __builtin_amdgcn_cvt_pk_fp8_f32(v[2], v[3], p, true); w[q] = (unsigned)p; }
                *(u32x4*)(dst + (size_t)c * 8 * ((size_t)NEXP * 128)) = w; }
            if (lane == 0) ((float*)(pt + (tb ? PT_SCV : PT_SCU)))[row] = inv;
        }
    }
}

template <bool FIRST, bool F8OUT = false> __device__ __forceinline__ void phase_norm_mod(const Ctx& C, const float* gvec, const float* modl  , int shift_off, int scale_off) {
    float* xs = WSP(float, WS_XS); bf16_t* hb = WSP(bf16_t, WS_HB);
    for (int r = C.bid * 8 + C.wid; r < TT; r += C.G * 8) {
        const float* xr = FIRST ? src_row(C, r) : xs + (size_t)r * DM;
        const float* mv = modl + (size_t)mod_sel(r) * 12288;
        f32x4 v[8]; float ss = 0.f;
#pragma unroll
        for (int c = 0; c < 4; ++c) { v[2 * c] = *(const f32x4*)(xr + c * 512 + C.lane * 8); v[2 * c + 1] = *(const f32x4*)(xr + c * 512 + C.lane * 8 + 4); }
#pragma unroll
        for (int c = 0; c < 8; ++c) ss += v[c][0] * v[c][0] + v[c][1] * v[c][1] + v[c][2] * v[c][2] + v[c][3] * v[c][3];
        ss = wave_sum(ss);
        const float rs = rsqrtf(ss * (1.0f / DM) + NORM_EPS);
#pragma unroll
        for (int c = 0; c < 4; ++c) { const int col = c * 512 + C.lane * 8;
            if (FIRST) { *(f32x4*)(xs + (size_t)r * DM + col) = v[2 * c]; *(f32x4*)(xs + (size_t)r * DM + col + 4) = v[2 * c + 1]; }
            float o[8];
#pragma unroll
            for (int h = 0; h < 2; ++h) { const f32x4 g = *(const f32x4*)(gvec + col + 4 * h), s = *(const f32x4*)(mv + scale_off + col + 4 * h), t = *(const f32x4*)(mv + shift_off + col + 4 * h);
#pragma unroll
                for (int j = 0; j < 4; ++j) o[4 * h + j] = v[2 * c + h][j] * rs * g[j] * (1.0f + s[j]) + t[j]; }
            if constexpr (F8OUT) {
                int p0 = __builtin_amdgcn_cvt_pk_fp8_f32(o[0], o[1], 0, false); p0 = __builtin_amdgcn_cvt_pk_fp8_f32(o[2], o[3], p0, true);
                int p1 = __builtin_amdgcn_cvt_pk_fp8_f32(o[4], o[5], 0, false); p1 = __builtin_amdgcn_cvt_pk_fp8_f32(o[6], o[7], p1, true);
                u32x2 w; w.x = (unsigned)p0; w.y = (unsigned)p1; *(u32x2*)((unsigned char*)hb + (size_t)r * DM + col) = w;
            } else {
            u32x4 w; w.x = cvt_pk_bf16(o[0], o[1]); w.y = cvt_pk_bf16(o[2], o[3]); w.z = cvt_pk_bf16(o[4], o[5]); w.w = cvt_pk_bf16(o[6], o[7]);
            *(u32x4*)(hb + (size_t)r * DM + col) = w; } }
    }
}

__device__ __forceinline__ void phase_post_p(const Ctx& C, int l) {
    bf16_t* P = WSP(bf16_t, WS_P); const float* ta = WSP(float, WS_TABA); const float* tm = WSP(float, WS_TABM);
    const float* qg = INP(I_QNG) + l * 128; const float* kg = INP(I_KNG) + l * 128;
    const float* mqg = INP(I_MQNG) + l * 512; const float* mkvg = INP(I_MKVNG) + l * 512;
    const int lane = C.lane;
    const float qg1 = qg[lane], qg2 = qg[lane + 64], kg1 = kg[lane], kg2 = kg[lane + 64];
    for (int r = C.bid * 8 + C.wid; r < TT; r += C.G * 8) {
        bf16_t* pr = P + (size_t)r * NP;
        const int j = r % RPB; const bool lat = j >= CTXL; const int pos = lat ? j - CTXL : 0, ri = pos >> 6, ci = pos & 63;
        float cs = 1.f, sn = 0.f;
        if (lat) { const int p = lane < 32 ? ri : ci, f = lane & 31; cs = ta[p * 32 + f]; sn = ta[128 * 32 + p * 32 + f]; }
#pragma unroll
        for (int h = 0; h < 10; ++h) {
            bf16_t* hp = pr + (h < 8 ? C_AQ + h * 128 : C_AK + (h - 8) * 128);
            const float x1 = bf2f(hp[lane]), x2 = bf2f(hp[lane + 64]);
            const float ss = wave_sum(x1 * x1 + x2 * x2);
            const float rs = rsqrtf(ss * (1.0f / 128.0f) + NORM_EPS);
            const float y1 = x1 * rs * (h < 8 ? qg1 : kg1), y2 = x2 * rs * (h < 8 ? qg2 : kg2);
            const float z1 = y1 * cs - y2 * sn, z2 = y2 * cs + y1 * sn;
            hp[lane] = f2bf(z1); hp[lane + 64] = f2bf(z2);
            if (h >= 8) { unsigned char* k8 = C.ws + WS_AK8 + (size_t)r * 256 + (h - 8) * 128;
                k8[lane] = (unsigned char)(__builtin_amdgcn_cvt_pk_fp8_f32(z1, 0.f, 0, false) & 0xff); k8[lane + 64] = (unsigned char)(__builtin_amdgcn_cvt_pk_fp8_f32(z2, 0.f, 0, false) & 0xff); }
        }
#pragma unroll
        for (int s = 0; s < 2; ++s) {
            bf16_t* sp = pr + (s == 0 ? C_MCQ : C_MCKV) + lane * 8; const float* gg = (s == 0 ? mqg : mkvg) + lane * 8;
            const u32x4 w = *(const u32x4*)sp; float x[8] = {bflo(w.x), bfhi(w.x), bflo(w.y), bfhi(w.y), bflo(w.z), bfhi(w.z), bflo(w.w), bfhi(w.w)};
            float ss = 0.f;
#pragma unroll
            for (int i = 0; i < 8; ++i) ss += x[i] * x[i];
            ss = wave_sum(ss);
            const float rs = rsqrtf(ss * (1.0f / 512.0f) + NORM_EPS);
#pragma unroll
            for (int i = 0; i < 8; ++i) x[i] = x[i] * rs * gg[i];
            u32x4 o; o.x = cvt_pk_bf16(x[0], x[1]); o.y = cvt_pk_bf16(x[2], x[3]); o.z = cvt_pk_bf16(x[4], x[5]); o.w = cvt_pk_bf16(x[6], x[7]);
            *(u32x4*)sp = o;
        }
        { bf16_t* kp = pr + C_MKR; const int i = lane & 31; const float x1 = bf2f(kp[i]), x2 = bf2f(kp[i + 32]);
          float c2 = 1.f, s2 = 0.f; if (lat) { const int p = i < 16 ? ri : ci, f = i & 15; c2 = tm[p * 16 + f]; s2 = tm[128 * 16 + p * 16 + f]; }
          const float z1 = x1 * c2 - x2 * s2, z2 = x2 * c2 + x1 * s2;
          if (lane < 32) { if (lat) { kp[i] = f2bf(z1); kp[i + 32] = f2bf(z2); }
              unsigned char* k8 = C.ws + WS_KR8 + (size_t)r * 64; k8[i] = (unsigned char)(__builtin_amdgcn_cvt_pk_fp8_f32(z1, 0.f, 0, false) & 0xff); k8[i + 32] = (unsigned char)(__builtin_amdgcn_cvt_pk_fp8_f32(z2, 0.f, 0, false) & 0xff); } }
    }
}

typedef int i32x8 __attribute__((ext_vector_type(8)));
typedef int i32x4 __attribute__((ext_vector_type(4)));
namespace att {
constexpr int NW = 8, QBLK = 32, KVBLK = 64, DV = 128;
constexpr float THR = 8.f;
#define SBAR() __builtin_amdgcn_sched_barrier(0)
__device__ __forceinline__ int crow(int r, int hi) { return (r & 3) + 8 * (r >> 2) + 4 * hi; }
template <int DQ> struct Cf {
    static constexpr int ND0 = DQ / 16, KROWB = DQ * 2, SHM_K = KVBLK * DQ * 2, SHM_V = KVBLK * DV * 2, SHM = 2 * SHM_V + 2 * SHM_K + NW * 64 * 4;
    static constexpr float SCALE = DQ == 128 ? 0.088388347648318440f : 0.072168783648703220f;
    __device__ static __forceinline__ int kswz(int row, int colB) { return row * KROWB + (colB ^ ((row & 7) << 4)); }
};
template <int DQ, int VAR = 0> __device__ __forceinline__ void partialSM(f32x16& p0, f32x16& p1, float& m_reg, float& mn, float& alpha, const float thr = THR, const float eoff = 0.f) {
    constexpr float SC = Cf<DQ>::SCALE, Cc = SC * 1.4426950408889634f;
    float pmax = p0[0];
#pragma unroll
    for (int r = 1; r < 16; ++r) pmax = fmaxf(pmax, p0[r]);
#pragma unroll
    for (int r = 0; r < 16; ++r) pmax = fmaxf(pmax, p1[r]);
    { auto rr = __builtin_amdgcn_permlane32_swap(__float_as_uint(pmax), __float_as_uint(pmax), false, false);
      pmax = fmaxf(__uint_as_float(rr[0]), __uint_as_float(rr[1])); }
    if (__builtin_expect(__all(pmax - m_reg <= thr / SC), 1)) { mn = m_reg; alpha = 1.f; }
    else { mn = fmaxf(m_reg, pmax); alpha = __builtin_amdgcn_exp2f((m_reg - mn) * Cc); m_reg = mn; }
    const float mnC = eoff - mn * Cc;
#pragma unroll
    for (int r = 0; r < 16; ++r) p0[r] = fmaf(p0[r], Cc, mnC);
#pragma unroll
    for (int r = 0; r < 16; ++r) p1[r] = fmaf(p1[r], Cc, mnC);
#pragma unroll
    for (int r = 0; r < 16; ++r) p0[r] = VAR == 1 ? p0[r] * 0.001f : __builtin_amdgcn_exp2f(p0[r]);
}
template <int VAR = 0> __device__ __forceinline__ void finishSM(f32x16& p0, f32x16& p1, float alpha, float& l_reg, bf16x8& pa0, bf16x8& pa1, bf16x8& pa2, bf16x8& pa3) {
#pragma unroll
    for (int r = 0; r < 16; ++r) p1[r] = VAR == 1 ? p1[r] * 0.001f : __builtin_amdgcn_exp2f(p1[r]);
    float ps = 0;
#pragma unroll
    for (int r = 0; r < 16; ++r) ps += p0[r];
#pragma unroll
    for (int r = 0; r < 16; ++r) ps += p1[r];
    { auto rr = __builtin_amdgcn_permlane32_swap(__float_as_uint(ps), __float_as_uint(ps), false, false);
      ps = __uint_as_float(rr[0]) + __uint_as_float(rr[1]); }
    l_reg = l_reg * alpha + ps;
#define PK4(P, BASE, OUT) do { unsigned a0 = cvt_pk_bf16(P[BASE + 0], P[BASE + 1]), a1 = cvt_pk_bf16(P[BASE + 2], P[BASE + 3]);   \
    unsigned b0 = cvt_pk_bf16(P[BASE + 4], P[BASE + 5]), b1 = cvt_pk_bf16(P[BASE + 6], P[BASE + 7]);                              \
    auto r0 = __builtin_amdgcn_permlane32_swap(a0, b0, false, false); auto r1 = __builtin_amdgcn_permlane32_swap(a1, b1, false, false); \
    u32x4 w = {r0[0], r1[0], r0[1], r1[1]}; OUT = *reinterpret_cast<bf16x8*>(&w); } while (0)
    PK4(p0, 0, pa0); PK4(p0, 8, pa1); PK4(p1, 0, pa2); PK4(p1, 8, pa3);
#undef PK4
}
template <int DQ> __device__ __forceinline__ void qkt(f32x16& p0, f32x16& p1, const char* Ks, const bf16x8* qr, const char* qx, int r32, int hi) {
    p0 = f32x16{}; p1 = f32x16{};
#pragma unroll
    for (int d0 = 0; d0 < Cf<DQ>::ND0; ++d0) { const int cb = (d0 * 16 + hi * 8) * 2;
        const bf16x8 b0 = *reinterpret_cast<const bf16x8*>(Ks + Cf<DQ>::kswz(r32, cb));
        const bf16x8 b1 = *reinterpret_cast<const bf16x8*>(Ks + Cf<DQ>::kswz(32 + r32, cb));
        constexpr int NQR = DQ == 192 ? MLA_NQR : 8;
        bf16x8 q; if (d0 < NQR) q = qr[d0]; else q = *reinterpret_cast<const bf16x8*>(qx + (d0 - NQR) * 1024);
        p0 = __builtin_amdgcn_mfma_f32_32x32x16_bf16(b0, q, p0, 0, 0, 0);
        p1 = __builtin_amdgcn_mfma_f32_32x32x16_bf16(b1, q, p1, 0, 0, 0); }
}
__device__ __forceinline__ int v_st(int k, int c) { const int kk = (k & ~0xC) | ((k & 4) << 1) | ((k & 8) >> 1); return ((kk >> 3) * 4 + (c >> 5)) * 512 + ((kk & 7) * 32 + (c & 31)) * 2; }
__device__ __forceinline__ int v_rd_base(int lane) { return ((lane & 3) << 3) | (((lane >> 2) & 3) << 6) | (((lane >> 4) & 1) << 5) | (((lane >> 5) & 1) << 8); }
constexpr int v_rd_off(int d0, int ks, int half) { return d0 * 512 + ks * 4096 + half * 2048; }
template <int OFF> __device__ __forceinline__ s16x4 tr_read(int vb) {
    s16x4 r; asm volatile("ds_read_b64_tr_b16 %0, %1 offset:%2" : "=&v"(r) : "v"(vb), "i"(OFF) : "memory"); return r;
}
template <int D0> __device__ __forceinline__ void pv_one(f32x16& od, int vb, bf16x8 pa0, bf16x8 pa1, bf16x8 pa2, bf16x8 pa3) {
    const s16x4 l0 = tr_read<v_rd_off(D0, 0, 0)>(vb), h0 = tr_read<v_rd_off(D0, 0, 1)>(vb), l1 = tr_read<v_rd_off(D0, 1, 0)>(vb), h1 = tr_read<v_rd_off(D0, 1, 1)>(vb);
    const s16x4 l2 = tr_read<v_rd_off(D0, 2, 0)>(vb), h2 = tr_read<v_rd_off(D0, 2, 1)>(vb), l3 = tr_read<v_rd_off(D0, 3, 0)>(vb), h3 = tr_read<v_rd_off(D0, 3, 1)>(vb);
    asm volatile("s_waitcnt lgkmcnt(0)" ::: "memory"); SBAR();
#define PK(L, H) (bf16x8){L[0], L[1], L[2], L[3], H[0], H[1], H[2], H[3]}
    od = __builtin_amdgcn_mfma_f32_32x32x16_bf16(pa0, PK(l0, h0), od, 0, 0, 0);
    od = __builtin_amdgcn_mfma_f32_32x32x16_bf16(pa1, PK(l1, h1), od, 0, 0, 0);
    od = __builtin_amdgcn_mfma_f32_32x32x16_bf16(pa2, PK(l2, h2), od, 0, 0, 0);
    od = __builtin_amdgcn_mfma_f32_32x32x16_bf16(pa3, PK(l3, h3), od, 0, 0, 0);
#undef PK
}
__device__ __forceinline__ void pv_d0(f32x16* o, int vb, bf16x8 pa0, bf16x8 pa1, bf16x8 pa2, bf16x8 pa3) {
    pv_one<0>(o[0], vb, pa0, pa1, pa2, pa3); pv_one<1>(o[1], vb, pa0, pa1, pa2, pa3); pv_one<2>(o[2], vb, pa0, pa1, pa2, pa3); pv_one<3>(o[3], vb, pa0, pa1, pa2, pa3);
}
__device__ __forceinline__ bf16x8 ld8(const bf16_t* p) { return *reinterpret_cast<const bf16x8*>(p); }

template <int DQ, int SD, int VAR = 0>
__device__ __forceinline__ void attn_body(const bf16_t* __restrict__ Qb, int ldq, const bf16_t* __restrict__ Kn, int ldkn, const bf16_t* __restrict__ Kr, int ldkr,
                                          const bf16_t* __restrict__ Vh, int ldv, unsigned char* __restrict__ Ob, int ldo, int seq, bool rope_q, int pos0, const float* __restrict__ tabM, char* lds, const int tid) {
    using CF = Cf<DQ>; constexpr int ND0 = CF::ND0, SHM_V = CF::SHM_V, SHM_K = CF::SHM_K;
    const int wid = tid >> 6, lane = tid & 63, r32 = lane & 31, hi = lane >> 5;
    char* V_lds = lds; char* K_lds = lds + 2 * SHM_V;
    float* ws = (float*)(lds + 2 * SHM_V + 2 * SHM_K) + wid * 64; float* li_l = ws; float* al_l = ws + 32;
    constexpr int NQR = DQ == 192 ? MLA_NQR : 8;
    float m_reg = -1e30f, l_reg = 0; f32x16 o[4] = {}; bf16x8 qr[NQR];
    const bf16_t* Qw = Qb + (long)(wid * QBLK + r32) * ldq + hi * 8;
#pragma unroll
    for (int d0 = 0; d0 < NQR; ++d0) qr[d0] = ld8(Qw + d0 * 16);
    char* qx = lds + CF::SHM + wid * 8192 + lane * 16;
    if constexpr (DQ == 192) {
#pragma unroll
        for (int d0 = NQR; d0 < 8; ++d0) *(bf16x8*)(qx + (d0 - NQR) * 1024) = ld8(Qw + d0 * 16);
        bf16x8 qe[4];
#pragma unroll
        for (int d0 = 0; d0 < 4; ++d0) qe[d0] = ld8(Qw + (8 + d0) * 16);
        if (rope_q) {
            const int pos = pos0 + wid * QBLK + r32, ri = pos >> 6, ci = pos & 63;
#pragma unroll
            for (int t = 0; t < 2; ++t) { const int p = t == 0 ? ri : ci; const float* tc = tabM + p * 16 + hi * 8; const float* tsn = tabM + 128 * 16 + p * 16 + hi * 8;
                bf16x8 a = qe[t], b = qe[2 + t];
#pragma unroll
                for (int jj = 0; jj < 8; ++jj) { const float x1 = bf2f((bf16_t)a[jj]), x2 = bf2f((bf16_t)b[jj]), c = tc[jj], s = tsn[jj];
                    a[jj] = (short)f2bf(x1 * c - x2 * s); b[jj] = (short)f2bf(x2 * c + x1 * s); }
                qe[t] = a; qe[2 + t] = b; }
        }
#pragma unroll
        for (int d0 = 0; d0 < 4; ++d0) *(bf16x8*)(qx + (8 - NQR + d0) * 1024) = qe[d0];
    }
    const int sr = tid >> 4, sc = (tid & 15) * 8, vst0 = v_st(sr, sc), vst1 = v_st(32 + sr, sc);
    const int sr2 = tid >> 3, sc2 = (tid & 7) * 8;
    const int vb0 = (int)(uintptr_t)V_lds + v_rd_base(lane);
    struct { bf16x8 vs0, vs1, ks0, ks1, ks2; } sr_[SD];
    const unsigned offV = (unsigned)(sr * ldv + sc) * 2u, offK = (unsigned)(sr * ldkn + sc) * 2u, offR = (unsigned)(sr2 * ldkr + sc2) * 2u;
#define SLOAD(i, k0) do { const char* vt_ = (const char*)Vh + (size_t)(k0) * ldv * 2; const char* kt_ = (const char*)Kn + (size_t)(k0) * ldkn * 2; \
    sr_[i].vs0 = *(const bf16x8*)(vt_ + offV); sr_[i].vs1 = *(const bf16x8*)(vt_ + (size_t)32 * ldv * 2 + offV); \
    sr_[i].ks0 = *(const bf16x8*)(kt_ + offK); sr_[i].ks1 = *(const bf16x8*)(kt_ + (size_t)32 * ldkn * 2 + offK); \
    if constexpr (DQ == 192) sr_[i].ks2 = *(const bf16x8*)((const char*)Kr + (size_t)(k0) * ldkr * 2 + offR); } while (0)
#define SWRITE(b, i) do { *(bf16x8*)(V_lds + (b) * SHM_V + vst0) = sr_[i].vs0; *(bf16x8*)(V_lds + (b) * SHM_V + vst1) = sr_[i].vs1; const int kc = sc * 2; \
    *(bf16x8*)(K_lds + (b) * SHM_K + CF::kswz(sr, kc)) = sr_[i].ks0; *(bf16x8*)(K_lds + (b) * SHM_K + CF::kswz(32 + sr, kc)) = sr_[i].ks1; \
    if constexpr (DQ == 192) *(bf16x8*)(K_lds + (b) * SHM_K + CF::kswz(sr2, 256 + sc2 * 2)) = sr_[i].ks2; } while (0)
#define SWAIT() do { if constexpr (SD == 1) asm volatile("s_waitcnt vmcnt(0)" ::: "memory"); else if constexpr (DQ == 192) asm volatile("s_waitcnt vmcnt(5)" ::: "memory"); else asm volatile("s_waitcnt vmcnt(4)" ::: "memory"); } while (0)
#define RESC(a) do { if (__any((a) < 1.f)) { if (hi == 0) al_l[r32] = (a); asm volatile("s_waitcnt lgkmcnt(0)" ::: "memory"); \
    _Pragma("unroll") for (int d = 0; d < 4; ++d) _Pragma("unroll") for (int r = 0; r < 16; ++r) o[d][r] *= al_l[crow(r, hi)]; } } while (0)
    f32x16 pA0, pA1, pB0, pB1; float mnA, mnB, alA, alB; bf16x8 pa0, pa1, pa2, pa3; const int NT = seq / KVBLK;
    constexpr int SE = 0, SO = SD - 1;
    SLOAD(SE, 0); asm volatile("s_waitcnt vmcnt(0)" ::: "memory"); SWRITE(0, SE); __syncthreads();
    qkt<DQ>(pA0, pA1, K_lds, qr, qx, r32, hi); partialSM<DQ, VAR>(pA0, pA1, m_reg, mnA, alA);
    SLOAD(SO, KVBLK); if constexpr (SD == 2) { if (2 < NT) SLOAD(SE, 2 * KVBLK); }
    SWAIT(); SWRITE(1, SO); __syncthreads();
#define ATT_SYNC() do { if constexpr (VAR != 2) __syncthreads(); } while (0)
    for (int j = 1; j + 1 < NT; j += 2) {
        SBAR(); qkt<DQ>(pB0, pB1, K_lds + SHM_K, qr, qx, r32, hi);
        finishSM<VAR>(pA0, pA1, alA, l_reg, pa0, pa1, pa2, pa3); SBAR();
        if constexpr (VAR != 3) SLOAD(SO, (j + SD) * KVBLK); SBAR();
        pv_d0(o, vb0, pa0, pa1, pa2, pa3); partialSM<DQ, VAR>(pB0, pB1, m_reg, mnB, alB);
        ATT_SYNC(); SWAIT(); SWRITE(0, SE);
        RESC(alB); ATT_SYNC();
        SBAR(); qkt<DQ>(pA0, pA1, K_lds, qr, qx, r32, hi);
        finishSM<VAR>(pB0, pB1, alB, l_reg, pa0, pa1, pa2, pa3); SBAR();
        if constexpr (VAR != 3) { if (SD == 1 || j + 3 < NT) SLOAD(SE, (j + 1 + SD) * KVBLK); } SBAR();
        pv_d0(o, vb0 + SHM_V, pa0, pa1, pa2, pa3); partialSM<DQ, VAR>(pA0, pA1, m_reg, mnA, alA);
        ATT_SYNC(); SWAIT(); SWRITE(1, SO);
        RESC(alA); ATT_SYNC();
    }
    SBAR(); qkt<DQ>(pB0, pB1, K_lds + SHM_K, qr, qx, r32, hi);
    finishSM<VAR>(pA0, pA1, alA, l_reg, pa0, pa1, pa2, pa3); SBAR();
    pv_d0(o, vb0, pa0, pa1, pa2, pa3); partialSM<DQ, VAR>(pB0, pB1, m_reg, mnB, alB);
    ATT_SYNC(); RESC(alB);
    finishSM<VAR>(pB0, pB1, alB, l_reg, pa0, pa1, pa2, pa3); SBAR();
    pv_d0(o, vb0 + SHM_V, pa0, pa1, pa2, pa3);
    if (hi == 0) li_l[r32] = l_reg; asm volatile("s_waitcnt lgkmcnt(0)" ::: "memory");
    float rli[16];
#pragma unroll
    for (int r = 0; r < 16; ++r) rli[r] = __builtin_amdgcn_rcpf(li_l[crow(r, hi)]);
    unsigned char* Ow = Ob + (long)(wid * QBLK) * ldo;
#pragma unroll
    for (int r = 0; r < 16; ++r) { const int orow = crow(r, hi);
#pragma unroll
        for (int d0 = 0; d0 < 4; ++d0) Ow[(long)orow * ldo + d0 * 32 + r32] = (unsigned char)(__builtin_amdgcn_cvt_pk_fp8_f32(o[d0][r] * rli[r] * 32.0f, 0.f, 0, false) & 0xff); }
#undef SLOAD
#undef ATT_SYNC
#undef SWRITE
#undef SWAIT
#undef RESC
}

__device__ __forceinline__ int k8addr(int row, int b, int DQ_) { return row * DQ_ + (b < 128 ? (b ^ ((row & 7) << 4)) : 128 + ((b - 128) ^ ((row & 3) << 4))); }
#define MX32(ACC, A, B, SC) asm volatile("s_nop 1\n\tv_mfma_scale_f32_32x32x64_f8f6f4 %0, %1, %2, %0, %3, %3 op_sel_hi:[0,0,0]" : "+v"(ACC) : "v"(A), "v"(B), "v"(SC))
#define MX32Z(ACC, A, B, SC) asm volatile("v_mfma_scale_f32_32x32x64_f8f6f4 %0, %1, %2, 0, %3, %3 op_sel_hi:[0,0,0]" : "=&v"(ACC) : "v"(A), "v"(B), "v"(SC))
template <int DQ, bool NOPS = true> __device__ __forceinline__ void qkt8(f32x16& p0, f32x16& p1, const char* Ks, const i32x8* qf, int r32, int hi) {
    int mxs = 0x7f7f7f7f; asm volatile("" : "+v"(mxs));
#pragma unroll
    for (int ks = 0; ks < DQ / 64; ++ks) { const int b = ks * 64 + hi * 32;
        const i32x4 a0l = *reinterpret_cast<const i32x4*>(Ks + k8addr(r32, b, DQ)), a0h = *reinterpret_cast<const i32x4*>(Ks + k8addr(r32, b + 16, DQ));
        const i32x4 a1l = *reinterpret_cast<const i32x4*>(Ks + k8addr(32 + r32, b, DQ)), a1h = *reinterpret_cast<const i32x4*>(Ks + k8addr(32 + r32, b + 16, DQ));
        const i32x8 a0 = __builtin_shufflevector(a0l, a0h, 0, 1, 2, 3, 4, 5, 6, 7), a1 = __builtin_shufflevector(a1l, a1h, 0, 1, 2, 3, 4, 5, 6, 7);
        if (ks == 0) { MX32Z(p0, a0, qf[ks], mxs); MX32Z(p1, a1, qf[ks], mxs); } else { MX32(p0, a0, qf[ks], mxs); MX32(p1, a1, qf[ks], mxs); } }
    if (NOPS) asm volatile("s_nop 15\n\ts_nop 7");
}
__device__ __forceinline__ int pk4_fp8(float a, float b, float c, float d) { int p = __builtin_amdgcn_cvt_pk_fp8_f32(a, b, 0, false); return __builtin_amdgcn_cvt_pk_fp8_f32(c, d, p, true); }
__device__ __forceinline__ int pk4_fp8u(float a, float b, float c, float d) { int u; asm volatile("" : "=v"(u)); const int p = __builtin_amdgcn_cvt_pk_fp8_f32(a, b, u, false); return __builtin_amdgcn_cvt_pk_fp8_f32(c, d, p, true); }
template <int DQ>
__device__ __forceinline__ void attn_body8(const bf16_t* __restrict__ Qb, int ldq, const unsigned char* __restrict__ Kn8, int ldkn, const unsigned char* __restrict__ Kr8, int ldkr,
                                           const bf16_t* __restrict__ Vh, int ldv, unsigned char* __restrict__ Ob, int ldo, int seq, bool rope_q, int pos0, const float* __restrict__ tabM, char* lds, const int tid) {
    constexpr int NKS = DQ / 64, SHM_V = KVBLK * DV * 2, SHM_K = KVBLK * DQ;
    const int wid = tid >> 6, lane = tid & 63, r32 = lane & 31, hi = lane >> 5;
    char* V_lds = lds; char* K_lds = lds + 2 * SHM_V;
    float* ws = (float*)(lds + 2 * SHM_V + 2 * SHM_K) + wid * 64; float* li_l = ws; float* al_l = ws + 32;
    float m_reg = -1e30f, l_reg = 0; f32x16 o[4] = {}; i32x8 qf[NKS];
    const bf16_t* Qrow = Qb + (long)(wid * QBLK + r32) * ldq;
#pragma unroll
    for (int ks = 0; ks < NKS; ++ks) {
        float x[32];
#pragma unroll
        for (int c = 0; c < 4; ++c) { const u32x4 w = *(const u32x4*)(Qrow + ks * 64 + hi * 32 + c * 8);
            x[c * 8 + 0] = bflo(w.x); x[c * 8 + 1] = bfhi(w.x); x[c * 8 + 2] = bflo(w.y); x[c * 8 + 3] = bfhi(w.y); x[c * 8 + 4] = bflo(w.z); x[c * 8 + 5] = bfhi(w.z); x[c * 8 + 6] = bflo(w.w); x[c * 8 + 7] = bfhi(w.w); }
        if (DQ == 192 && ks == 2 && rope_q) {
            float y[32];
#pragma unroll
            for (int c = 0; c < 4; ++c) { const u32x4 w = *(const u32x4*)(Qrow + 128 + (1 - hi) * 32 + c * 8);
                y[c * 8 + 0] = bflo(w.x); y[c * 8 + 1] = bfhi(w.x); y[c * 8 + 2] = bflo(w.y); y[c * 8 + 3] = bfhi(w.y); y[c * 8 + 4] = bflo(w.z); y[c * 8 + 5] = bfhi(w.z); y[c * 8 + 6] = bflo(w.w); y[c * 8 + 7] = bfhi(w.w); }
            const int pos = pos0 + wid * QBLK + r32, ri = pos >> 6, ci = pos & 63;
#pragma unroll
            for (int i = 0; i < 32; ++i) { const int p = i < 16 ? ri : ci, f = i & 15; const float c_ = tabM[p * 16 + f], s_ = tabM[128 * 16 + p * 16 + f];
                x[i] = hi ? x[i] * c_ + y[i] * s_ : x[i] * c_ - y[i] * s_; }
        }
        i32x8 q8;
#pragma unroll
        for (int j = 0; j < 8; ++j) q8[j] = pk4_fp8(x[4 * j], x[4 * j + 1], x[4 * j + 2], x[4 * j + 3]);
        qf[ks] = q8;
    }
    const int sr = tid >> 4, sc = (tid & 15) * 8, vst0 = v_st(sr, sc), vst1 = v_st(32 + sr, sc);
    const int kr = tid >> 3, kb = (tid & 7) * 16;
    const int kr2 = (tid & 255) >> 2, kb2 = (tid & 3) * 16;
    const int vb0 = (int)(uintptr_t)V_lds + v_rd_base(lane);
    struct { bf16x8 vs0, vs1; u32x4 k0, k1; } sr_[1];
    const unsigned offV = (unsigned)(sr * ldv + sc) * 2u, offK = (unsigned)(kr * ldkn + kb), offR = (unsigned)(kr2 * ldkr + kb2);
#define SLOAD8(k0_) do { const char* vt_ = (const char*)Vh + (size_t)(k0_) * ldv * 2; \
    sr_[0].vs0 = *(const bf16x8*)(vt_ + offV); sr_[0].vs1 = *(const bf16x8*)(vt_ + (size_t)32 * ldv * 2 + offV); \
    sr_[0].k0 = *(const u32x4*)(Kn8 + (size_t)(k0_) * ldkn + offK); \
    if constexpr (DQ == 192) { if (tid < 256) sr_[0].k1 = *(const u32x4*)(Kr8 + (size_t)(k0_) * ldkr + offR); } } while (0)
#define SWRITE8(b) do { *(bf16x8*)(V_lds + (b) * SHM_V + vst0) = sr_[0].vs0; *(bf16x8*)(V_lds + (b) * SHM_V + vst1) = sr_[0].vs1; \
    *(u32x4*)(K_lds + (b) * SHM_K + k8addr(kr, kb, DQ)) = sr_[0].k0; \
    if constexpr (DQ == 192) { if (tid < 256) *(u32x4*)(K_lds + (b) * SHM_K + k8addr(kr2, 128 + kb2, DQ)) = sr_[0].k1; } } while (0)
#define SWAIT8() asm volatile("s_waitcnt vmcnt(0)" ::: "memory")
#define RESC8(a) do { if (__any((a) < 1.f)) { if (hi == 0) al_l[r32] = (a); asm volatile("s_waitcnt lgkmcnt(0)" ::: "memory"); \
    _Pragma("unroll") for (int d = 0; d < 4; ++d) _Pragma("unroll") for (int r = 0; r < 16; ++r) o[d][r] *= al_l[crow(r, hi)]; } } while (0)
    f32x16 pA0, pA1, pB0, pB1; float mnA, mnB, alA, alB; bf16x8 pa0, pa1, pa2, pa3; const int NT = seq / KVBLK;
    SLOAD8(0); SWAIT8(); SWRITE8(0); __syncthreads();
    qkt8<DQ>(pA0, pA1, K_lds, qf, r32, hi); partialSM<DQ, 0>(pA0, pA1, m_reg, mnA, alA);
    SLOAD8(KVBLK);
    SWAIT8(); SWRITE8(1); __syncthreads();
    for (int j = 1; j + 1 < NT; j += 2) {
        SBAR(); qkt8<DQ>(pB0, pB1, K_lds + SHM_K, qf, r32, hi);
        finishSM<0>(pA0, pA1, alA, l_reg, pa0, pa1, pa2, pa3); SBAR();
        SLOAD8((j + 1) * KVBLK); SBAR();
        pv_d0(o, vb0, pa0, pa1, pa2, pa3); partialSM<DQ, 0>(pB0, pB1, m_reg, mnB, alB);
        __syncthreads(); SWAIT8(); SWRITE8(0);
        RESC8(alB); __syncthreads();
        SBAR(); qkt8<DQ>(pA0, pA1, K_lds, qf, r32, hi);
        finishSM<0>(pB0, pB1, alB, l_reg, pa0, pa1, pa2, pa3); SBAR();
        SLOAD8((j + 2) * KVBLK); SBAR();
        pv_d0(o, vb0 + SHM_V, pa0, pa1, pa2, pa3); partialSM<DQ, 0>(pA0, pA1, m_reg, mnA, alA);
        __syncthreads(); SWAIT8(); SWRITE8(1);
        RESC8(alA); __syncthreads();
    }
    SBAR(); qkt8<DQ>(pB0, pB1, K_lds + SHM_K, qf, r32, hi);
    finishSM<0>(pA0, pA1, alA, l_reg, pa0, pa1, pa2, pa3); SBAR();
    pv_d0(o, vb0, pa0, pa1, pa2, pa3); partialSM<DQ, 0>(pB0, pB1, m_reg, mnB, alB);
    __syncthreads(); RESC8(alB);
    finishSM<0>(pB0, pB1, alB, l_reg, pa0, pa1, pa2, pa3); SBAR();
    pv_d0(o, vb0 + SHM_V, pa0, pa1, pa2, pa3);
    if (hi == 0) li_l[r32] = l_reg; asm volatile("s_waitcnt lgkmcnt(0)" ::: "memory");
    float rli[16];
#pragma unroll
    for (int r = 0; r < 16; ++r) rli[r] = __builtin_amdgcn_rcpf(li_l[crow(r, hi)]);
    unsigned char* Ow = Ob + (long)(wid * QBLK) * ldo;
#pragma unroll
    for (int r = 0; r < 16; ++r) { const int orow = crow(r, hi);
#pragma unroll
        for (int d0 = 0; d0 < 4; ++d0) Ow[(long)orow * ldo + d0 * 32 + r32] = (unsigned char)(__builtin_amdgcn_cvt_pk_fp8_f32(o[d0][r] * rli[r] * 32.0f, 0.f, 0, false) & 0xff); }
#undef SLOAD8
#undef SWRITE8
#undef SWAIT8
#undef RESC8
}

__device__ __host__ __forceinline__ int vt8_key(int g, int j) { const int i = j & 15; return (j < 16 ? 0 : 32) + (i & 3) + 8 * (i >> 2) + 4 * g; }
template <int DQ>
__device__ __forceinline__ void attn_body88(const bf16_t* __restrict__ Qb, int ldq, const unsigned char* __restrict__ Kn8, int ldkn, const unsigned char* __restrict__ Kr8, int ldkr,
                                            const unsigned char* __restrict__ VT8, unsigned char* __restrict__ Ob, int ldo, int seq, bool rope_q, int pos0, const float* __restrict__ tabM, char* lds, const int tid) {
    constexpr int NKS = DQ / 64, SHM_V = 128 * 64, SHM_K = KVBLK * DQ;
    constexpr float EOFF = 7.0f, THR8 = 1.0f;
    const int wid = tid >> 6, lane = tid & 63, r32 = lane & 31, hi = lane >> 5;
    char* V_lds = lds; char* K_lds = lds + 2 * SHM_V;
    float* ws = (float*)(lds + 2 * SHM_V + 2 * SHM_K) + wid * 64; float* li_l = ws; float* al_l = ws + 32;
    float m_reg = -1e30f, l_reg = 0; f32x16 o[4] = {}; i32x8 qf[NKS];
    const bf16_t* Qrow = Qb + (long)(wid * QBLK + r32) * ldq;
#pragma unroll
    for (int ks = 0; ks < NKS; ++ks) {
        float x[32];
#pragma unroll
        for (int c = 0; c < 4; ++c) { const u32x4 w = *(const u32x4*)(Qrow + ks * 64 + hi * 32 + c * 8);
            x[c * 8 + 0] = bflo(w.x); x[c * 8 + 1] = bfhi(w.x); x[c * 8 + 2] = bflo(w.y); x[c * 8 + 3] = bfhi(w.y); x[c * 8 + 4] = bflo(w.z); x[c * 8 + 5] = bfhi(w.z); x[c * 8 + 6] = bflo(w.w); x[c * 8 + 7] = bfhi(w.w); }
        if (DQ == 192 && ks == 2 && rope_q) {
            float y[32];
#pragma unroll
            for (int c = 0; c < 4; ++c) { const u32x4 w = *(const u32x4*)(Qrow + 128 + (1 - hi) * 32 + c * 8);
                y[c * 8 + 0] = bflo(w.x); y[c * 8 + 1] = bfhi(w.x); y[c * 8 + 2] = bflo(w.y); y[c * 8 + 3] = bfhi(w.y); y[c * 8 + 4] = bflo(w.z); y[c * 8 + 5] = bfhi(w.z); y[c * 8 + 6] = bflo(w.w); y[c * 8 + 7] = bfhi(w.w); }
            const int pos = pos0 + wid * QBLK + r32, ri = pos >> 6, ci = pos & 63;
#pragma unroll
            for (int i = 0; i < 32; ++i) { const int p = i < 16 ? ri : ci, f = i & 15; const float c_ = tabM[p * 16 + f], s_ = tabM[128 * 16 + p * 16 + f];
                x[i] = hi ? x[i] * c_ + y[i] * s_ : x[i] * c_ - y[i] * s_; }
        }
        i32x8 q8;
#pragma unroll
        for (int j = 0; j < 8; ++j) q8[j] = pk4_fp8(x[4 * j], x[4 * j + 1], x[4 * j + 2], x[4 * j + 3]);
        qf[ks] = q8;
    }
    const int wu = __builtin_amdgcn_readfirstlane(wid);
    const unsigned lbase = __builtin_amdgcn_readfirstlane((unsigned)(uintptr_t)(LAS char*)lds), wofs = (unsigned)wu * 1024u;
    const int vr = tid >> 2;
    const unsigned offVd = (unsigned)((vr * 4 + ((tid & 3) ^ ((vr >> 2) & 3))) * 16);
    const unsigned char* kp0; const unsigned char* kp1 = nullptr; unsigned ks0, ks1 = 0;
    if constexpr (DQ == 128) { const int row = tid >> 3, c = tid & 7; kp0 = Kn8 + (size_t)row * ldkn + ((c ^ (row & 7)) << 4); ks0 = (unsigned)(KVBLK * ldkn); }
    else { { const int G = tid, row = G / 12, c = G % 12; const bool nope = c < 8;
             kp0 = nope ? Kn8 + (size_t)row * ldkn + ((c ^ (row & 7)) << 4) : Kr8 + (size_t)row * ldkr + (((c - 8) ^ (row & 3)) << 4); ks0 = (unsigned)(KVBLK * (nope ? ldkn : ldkr)); }
           { const int G = 512 + (tid & 255), row = G / 12, c = G % 12; const bool nope = c < 8;
             kp1 = nope ? Kn8 + (size_t)row * ldkn + ((c ^ (row & 7)) << 4) : Kr8 + (size_t)row * ldkr + (((c - 8) ^ (row & 3)) << 4); ks1 = (unsigned)(KVBLK * (nope ? ldkn : ldkr)); } }
#define DMA16(gp, loff) __builtin_amdgcn_global_load_lds((const unsigned*)(gp), (LAS unsigned*)(uintptr_t)(lbase + (unsigned)(loff) + wofs), 16, 0, 0)
#define DMAK(t_, b_) do { DMA16(kp0 + (size_t)(t_) * ks0, 2 * SHM_V + (b_) * SHM_K); \
        if constexpr (DQ == 192) { if (wu < 4) DMA16(kp1 + (size_t)(t_) * ks1, 2 * SHM_V + (b_) * SHM_K + 8192); } } while (0)
#define DMAV(t_, b_) DMA16(VT8 + (size_t)(t_) * 8192 + offVd, (b_) * SHM_V)
#define DWAIT() asm volatile("s_waitcnt vmcnt(0)" ::: "memory")
#define RESC8(a) do { if (__any((a) < 1.f)) { if (hi == 0) al_l[r32] = (a); asm volatile("s_waitcnt lgkmcnt(0)" ::: "memory"); \
    _Pragma("unroll") for (int d = 0; d < 4; ++d) _Pragma("unroll") for (int r = 0; r < 16; ++r) o[d][r] *= al_l[crow(r, hi)]; } } while (0)
#define FIN8(P0, P1, AL, PA) do { _Pragma("unroll") for (int r = 0; r < 16; ++r) P1[r] = __builtin_amdgcn_exp2f(P1[r]); \
    float ps_ = 0; _Pragma("unroll") for (int r = 0; r < 16; ++r) ps_ += P0[r]; _Pragma("unroll") for (int r = 0; r < 16; ++r) ps_ += P1[r]; \
    { auto rr_ = __builtin_amdgcn_permlane32_swap(__float_as_uint(ps_), __float_as_uint(ps_), false, false); ps_ = __uint_as_float(rr_[0]) + __uint_as_float(rr_[1]); } \
    l_reg = l_reg * (AL) + ps_; \
    _Pragma("unroll") for (int j = 0; j < 4; ++j) { PA[j] = pk4_fp8u(P0[4 * j], P0[4 * j + 1], P0[4 * j + 2], P0[4 * j + 3]); \
        PA[4 + j] = pk4_fp8u(P1[4 * j], P1[4 * j + 1], P1[4 * j + 2], P1[4 * j + 3]); } } while (0)
#define PV8(VB, PA, NOPS) do { int mxs_ = 0x7f7f7f7f; asm volatile("" : "+v"(mxs_)); _Pragma("unroll") for (int d0 = 0; d0 < 4; ++d0) { const int row_ = d0 * 32 + r32, xs_ = (row_ >> 2) & 3; \
        const i32x4 lo_ = *reinterpret_cast<const i32x4*>((VB) + row_ * 64 + (((2 * hi) ^ xs_) << 4)), hi_ = *reinterpret_cast<const i32x4*>((VB) + row_ * 64 + (((2 * hi + 1) ^ xs_) << 4)); \
        const i32x8 vb_ = __builtin_shufflevector(lo_, hi_, 0, 1, 2, 3, 4, 5, 6, 7); MX32(o[d0], PA, vb_, mxs_); } if (NOPS) asm volatile("s_nop 15\n\ts_nop 7"); } while (0)
    f32x16 pA0, pA1, pB0, pB1; float mnA, mnB, alA, alB; i32x8 pa; const int NT = seq / KVBLK;
#define PSM8(P0, P1, MN, AL) do { partialSM<DQ, 0>(P0, P1, m_reg, MN, AL, THR8, EOFF); RESC8(AL); } while (0)
    DMAK(0, 0); DMAV(0, 0); DMAK(1, 1); DWAIT(); __syncthreads();
    qkt8<DQ>(pA0, pA1, K_lds, qf, r32, hi); PSM8(pA0, pA1, mnA, alA);
    __syncthreads();
    for (int j = 1; j + 1 < NT; j += 2) {
        DMAK(j + 1, 0); DMAV(j, 1);
        SBAR(); qkt8<DQ, false>(pB0, pB1, K_lds + SHM_K, qf, r32, hi);
        FIN8(pA0, pA1, alA, pa); SBAR();
        PV8(V_lds, pa, 0); PSM8(pB0, pB1, mnB, alB);
        DWAIT(); __syncthreads();
        if (j + 2 < NT) DMAK(j + 2, 1);
        DMAV(j + 1, 0);
        SBAR(); qkt8<DQ, false>(pA0, pA1, K_lds, qf, r32, hi);
        FIN8(pB0, pB1, alB, pa); SBAR();
        PV8(V_lds + SHM_V, pa, 0); PSM8(pA0, pA1, mnA, alA);
        DWAIT(); __syncthreads();
    }
    DMAV(NT - 1, 1);
    SBAR(); qkt8<DQ, false>(pB0, pB1, K_lds + SHM_K, qf, r32, hi);
    FIN8(pA0, pA1, alA, pa); SBAR();
    PV8(V_lds, pa, 0); PSM8(pB0, pB1, mnB, alB);
    DWAIT(); __syncthreads();
    FIN8(pB0, pB1, alB, pa); SBAR();
    PV8(V_lds + SHM_V, pa, 1);
#undef PSM8
#undef DMA16
#undef DMAK
#undef DMAV
#undef DWAIT
    if (hi == 0) li_l[r32] = l_reg; asm volatile("s_waitcnt lgkmcnt(0)" ::: "memory");
    float rli[16];
#pragma unroll
    for (int r = 0; r < 16; ++r) rli[r] = __builtin_amdgcn_rcpf(li_l[crow(r, hi)]) * 32.0f;
    unsigned char* Ow = Ob + (long)(wid * QBLK) * ldo;
#pragma unroll
    for (int r = 0; r < 16; ++r) { const int orow = crow(r, hi);
#pragma unroll
        for (int d0 = 0; d0 < 4; ++d0) Ow[(long)orow * ldo + d0 * 32 + r32] = (unsigned char)(__builtin_amdgcn_cvt_pk_fp8_f32(o[d0][r] * rli[r], 0.f, 0, false) & 0xff); }
#undef RESC8
#undef FIN8
#undef PV8
}
#undef MX32
}

template <int KS> __device__ __forceinline__ void mma_xy(f32x16& acc, const LAS bf16_t* X, const LAS bf16_t* Y, int hi) {
#pragma unroll
    for (int ks = 0; ks < KS; ++ks) { const bf16x8 a = *(const LAS bf16x8*)(X + ks * 16 + hi * 8), b = *(const LAS bf16x8*)(Y + ks * 16 + hi * 8);
        acc = __builtin_amdgcn_mfma_f32_32x32x16_bf16(a, b, acc, 0, 0, 0); }
}
__device__ __forceinline__ float logsig16(float x) { const float e = __expf(-fabsf(x)); return (fminf(x, 0.f) - __logf(1.f + e)) * 0.0625f; }
__device__ __forceinline__ int gla_sidx(int b, int dir, int h) { return (b * 2 + dir) * 4 + h; }

__device__ __forceinline__ void gla_cumsum_lds(const Ctx& C, int l, int h, int dir, const LAS float* lr, LAS float* segtot, LAS float* CUM) {
    const int seg = C.tid >> 7, d = C.tid & 127;
    const float* wa = INP(dir ? I_WA2B : I_WA2F) + (size_t)l * 16 * 512 + h * 128 + d;
    const float bias = INP(dir ? I_BAB : I_BAF)[l * 512 + h * 128 + d];
    float w[16], cum[16];
#pragma unroll
    for (int j = 0; j < 16; ++j) w[j] = wa[j * 512];
    float run = 0.f;
#pragma unroll
    for (int i = 0; i < 16; ++i) { const int s = seg * 16 + i, tk = dir ? 63 - s : s; float pre = bias;
#pragma unroll
        for (int j = 0; j < 16; ++j) pre += lr[tk * 32 + dir * 16 + j] * w[j];
        run += logsig16(pre); cum[i] = run; }
    segtot[seg * 128 + d] = run;
    __syncthreads();
    float off = 0.f;
#pragma unroll
    for (int q = 0; q < 3; ++q) if (q < seg) off += segtot[q * 128 + d];
#pragma unroll
    for (int i = 0; i < 16; ++i) { const int s = seg * 16 + i, tk = dir ? 63 - s : s; CUM[tk * 132 + d] = cum[i] + off; }
    __syncthreads();
}
__device__ __forceinline__ void unpack8(const u32x4 w, float (&x)[8]) { x[0] = bflo(w.x); x[1] = bfhi(w.x); x[2] = bflo(w.y); x[3] = bfhi(w.y); x[4] = bflo(w.z); x[5] = bfhi(w.z); x[6] = bflo(w.w); x[7] = bfhi(w.w); }
__device__ __forceinline__ void gla_build_vt(const Ctx& C, const bf16_t* P, size_t r0, int h, LAS bf16_t* VT) {
    u32x4 v[4];
#pragma unroll
    for (int it = 0; it < 4; ++it) { const int idx = C.tid + it * NTHREADS, sv = idx >> 5, e0 = (idx & 31) * 8; v[it] = *(const u32x4*)(P + (r0 + sv) * NP + C_LV + h * 256 + e0); }
#pragma unroll
    for (int it = 0; it < 4; ++it) { const int idx = C.tid + it * NTHREADS, sv = idx >> 5, e0 = (idx & 31) * 8;
        const unsigned wd[4] = {v[it].x, v[it].y, v[it].z, v[it].w};
#pragma unroll
        for (int q = 0; q < 4; ++q) { VT[(e0 + 2 * q) * 72 + sv] = (bf16_t)(wd[q] & 0xffffu); VT[(e0 + 2 * q + 1) * 72 + sv] = (bf16_t)(wd[q] >> 16); } }
}

__device__ __forceinline__ void phase_gla_local(const Ctx& C, int l, int rot) {
    const bf16_t* P = WSP(bf16_t, WS_P); bf16_t* GST = WSP(bf16_t, WS_GST); float* GDEC = WSP(float, WS_GDEC);
    LAS float* lr = (LAS float*)C.lds;
    LAS float* segtot = (LAS float*)(C.lds + 8192);
    LAS bf16_t* KT = (LAS bf16_t*)(C.lds + 10240);
    LAS bf16_t* VT = (LAS bf16_t*)(C.lds + 28672);
    LAS float* CUM = (LAS float*)(C.lds + 65536);
    const int r32 = C.lane & 31, hi = C.lane >> 5, d = C.tid & 127;
    const int btk = C.tid >> 3, bdg = (C.tid & 7) * 16;
    for (int unit = (C.bid + C.G - rot % C.G) % C.G; unit < NBATCH * 4 * NCH; unit += C.G) {
        const int b = unit / (4 * NCH), h = (unit / NCH) % 4, ck = unit % NCH; const size_t r0 = (size_t)b * RPB + ck * 64;
        for (int i = C.tid; i < 64 * 32; i += NTHREADS) lr[i] = bf2f(P[(r0 + (i >> 5)) * NP + C_LRF + (i & 31)]);
        const u32x4 kw0 = *(const u32x4*)(P + (r0 + btk) * NP + C_LK + h * 128 + bdg), kw1 = *(const u32x4*)(P + (r0 + btk) * NP + C_LK + h * 128 + bdg + 8);
        gla_build_vt(C, P, r0, h, VT);
        __syncthreads();
#pragma unroll 1
        for (int dir = 0; dir < 2; ++dir) {
            gla_cumsum_lds(C, l, h, dir, lr, segtot, CUM);
            const int tend = dir ? 0 : 63;
            const size_t sx = (size_t)gla_sidx(b, dir, h) * NCH + ck;
            if (C.tid < 128) GDEC[sx * 128 + d] = __expf(CUM[tend * 132 + d]);
            { float kf[16]; { float t8[8]; unpack8(kw0, t8);
#pragma unroll
                for (int i = 0; i < 8; ++i) kf[i] = t8[i]; unpack8(kw1, t8);
#pragma unroll
                for (int i = 0; i < 8; ++i) kf[8 + i] = t8[i]; }
#pragma unroll
              for (int q = 0; q < 4; ++q) { const f32x4 cm = *(const LAS f32x4*)(CUM + btk * 132 + bdg + 4 * q), be = *(const LAS f32x4*)(CUM + tend * 132 + bdg + 4 * q);
#pragma unroll
                  for (int i = 0; i < 4; ++i) KT[(bdg + 4 * q + i) * 72 + btk] = f2bf(kf[4 * q + i] * __expf(be[i] - cm[i])); } }
            __syncthreads();
            { const int dt = C.wid & 3, eb = (C.wid >> 2) * 4;
              f32x16 acc[4] = {};
#pragma unroll
              for (int q = 0; q < 4; ++q) mma_xy<4>(acc[q], KT + (dt * 32 + r32) * 72, VT + ((eb + q) * 32 + r32) * 72, hi);
              bf16_t* st = GST + sx * 32768;
#pragma unroll
              for (int q = 0; q < 4; ++q)
#pragma unroll
                  for (int g = 0; g < 4; ++g) { u32x2 w; w.x = cvt_pk_bf16(acc[q][4 * g], acc[q][4 * g + 1]); w.y = cvt_pk_bf16(acc[q][4 * g + 2], acc[q][4 * g + 3]);
                      *(u32x2*)(st + (size_t)((eb + q) * 32 + r32) * 128 + dt * 32 + 8 * g + 4 * hi) = w; } }
            __syncthreads();
        }
    }
}

__device__ __forceinline__ void phase_gla_scan(const Ctx& C) {
    bf16_t* GST = WSP(bf16_t, WS_GST); const float* GDEC = WSP(float, WS_GDEC);
    for (int gid = C.bid * NTHREADS + C.tid; gid < 16 * 8192; gid += C.G * NTHREADS) {
        const int sidx = gid >> 13, g = gid & 8191, dir = (sidx >> 2) & 1, d4 = (g & 31) * 4;
        bf16_t* base = GST + (size_t)sidx * NCH * 32768 + (size_t)g * 4;
        const float* dbase = GDEC + (size_t)sidx * NCH * 128 + d4;
        float S[4] = {0.f, 0.f, 0.f, 0.f};
        for (int st = 0; st < NCH; st += 4) {
            int ck[4]; u32x2 L[4]; f32x4 dc[4];
#pragma unroll
            for (int q = 0; q < 4; ++q) { const int s = st + q; ck[q] = dir ? (s < 4 ? 3 - s : NCH + 3 - s) : s;
                L[q] = *(const u32x2*)(base + (size_t)ck[q] * 32768); dc[q] = *(const f32x4*)(dbase + (size_t)ck[q] * 128); }
#pragma unroll
            for (int q = 0; q < 4; ++q) { u32x2 w; w.x = cvt_pk_bf16(S[0], S[1]); w.y = cvt_pk_bf16(S[2], S[3]);
                *(u32x2*)(base + (size_t)ck[q] * 32768) = w;
                S[0] = dc[q][0] * S[0] + bflo(L[q].x); S[1] = dc[q][1] * S[1] + bfhi(L[q].x); S[2] = dc[q][2] * S[2] + bflo(L[q].y); S[3] = dc[q][3] * S[3] + bfhi(L[q].y); }
        }
    }
}

__device__ __forceinline__ void phase_gla_out(const Ctx& C, int l, int rot) {
    const bf16_t* P = WSP(bf16_t, WS_P); const bf16_t* GST = WSP(bf16_t, WS_GST); unsigned char* OL = C.ws + WS_OL;
    LAS float* lr = (LAS float*)C.lds;
    LAS float* segtot = (LAS float*)(C.lds + 8192);
    LAS bf16_t* QT = (LAS bf16_t*)(C.lds + 10240);
    LAS bf16_t* KT = (LAS bf16_t*)(C.lds + 27648);
    LAS bf16_t* VT = (LAS bf16_t*)(C.lds + 45056);
    LAS bf16_t* SCm = (LAS bf16_t*)(C.lds + 81920);
    LAS float* OB = (LAS float*)(C.lds + 91136);
    LAS float* CUM = OB;
    const float* gon = INP(I_ONG) + l * 256;
    const int r32 = C.lane & 31, hi = C.lane >> 5;
    const int btk = C.tid >> 3, bdg = (C.tid & 7) * 16;
    for (int unit = (C.bid + C.G - rot % C.G) % C.G; unit < NBATCH * 4 * NCH; unit += C.G) {
        const int b = unit / (4 * NCH), h = (unit / NCH) % 4, ck = unit % NCH; const size_t r0 = (size_t)b * RPB + ck * 64;
        for (int i = C.tid; i < 64 * 32; i += NTHREADS) lr[i] = bf2f(P[(r0 + (i >> 5)) * NP + C_LRF + (i & 31)]);
        const bf16_t* qp = P + (r0 + btk) * NP + C_LQ + h * 128 + bdg; const bf16_t* kp = P + (r0 + btk) * NP + C_LK + h * 128 + bdg;
        const u32x4 qw0 = *(const u32x4*)qp, qw1 = *(const u32x4*)(qp + 8), kw0 = *(const u32x4*)kp, kw1 = *(const u32x4*)(kp + 8);
        gla_build_vt(C, P, r0, h, VT);
        __syncthreads();
        f32x16 oacc[2] = {};
#pragma unroll 1
        for (int dir = 0; dir < 2; ++dir) {
            gla_cumsum_lds(C, l, h, dir, lr, segtot, CUM);
            { float qf[8], kf[8];
#pragma unroll
              for (int hh = 0; hh < 2; ++hh) { unpack8(hh ? qw1 : qw0, qf); unpack8(hh ? kw1 : kw0, kf);
                  const f32x4 c0 = *(const LAS f32x4*)(CUM + btk * 132 + bdg + 8 * hh), c1 = *(const LAS f32x4*)(CUM + btk * 132 + bdg + 8 * hh + 4);
                  float qo[8], ko[8];
#pragma unroll
                  for (int i = 0; i < 8; ++i) { const float cm = i < 4 ? c0[i & 3] : c1[i & 3]; qo[i] = qf[i] * __expf(cm) * 0.088388347648318440f; ko[i] = kf[i] * __expf(-cm); }
                  u32x4 wq, wk; wq.x = cvt_pk_bf16(qo[0], qo[1]); wq.y = cvt_pk_bf16(qo[2], qo[3]); wq.z = cvt_pk_bf16(qo[4], qo[5]); wq.w = cvt_pk_bf16(qo[6], qo[7]);
                  wk.x = cvt_pk_bf16(ko[0], ko[1]); wk.y = cvt_pk_bf16(ko[2], ko[3]); wk.z = cvt_pk_bf16(ko[4], ko[5]); wk.w = cvt_pk_bf16(ko[6], ko[7]);
                  *(LAS u32x4*)(QT + btk * 136 + bdg + 8 * hh) = wq; *(LAS u32x4*)(KT + btk * 136 + bdg + 8 * hh) = wk; } }
            __syncthreads();
            if (C.wid < 4) { const int mt = C.wid >> 1, nt = C.wid & 1; f32x16 sc = {};
                mma_xy<8>(sc, QT + (mt * 32 + r32) * 136, KT + (nt * 32 + r32) * 136, hi);
#pragma unroll
                for (int i = 0; i < 16; ++i) { const int t = mt * 32 + att::crow(i, hi), sx_ = nt * 32 + r32; const bool keep = dir ? (sx_ >= t) : (sx_ <= t);
                    SCm[t * 72 + sx_] = f2bf(keep ? sc[i] : 0.f); } }
            __syncthreads();
            { const bf16_t* st = GST + ((size_t)gla_sidx(b, dir, h) * NCH + ck) * 32768 + (size_t)(C.wid * 32 + r32) * 128 + hi * 8;
              bf16x8 sb[8];
#pragma unroll
              for (int ks = 0; ks < 8; ++ks) sb[ks] = *(const bf16x8*)(st + ks * 16);
#pragma unroll
              for (int mt = 0; mt < 2; ++mt) {
                  mma_xy<4>(oacc[mt], SCm + (mt * 32 + r32) * 72, VT + (C.wid * 32 + r32) * 72, hi);
#pragma unroll
                  for (int ks = 0; ks < 8; ++ks) { const bf16x8 a = *(const LAS bf16x8*)(QT + (mt * 32 + r32) * 136 + ks * 16 + hi * 8);
                      oacc[mt] = __builtin_amdgcn_mfma_f32_32x32x16_bf16(a, sb[ks], oacc[mt], 0, 0, 0); } } }
            __syncthreads();
        }
#pragma unroll
        for (int mt = 0; mt < 2; ++mt)
#pragma unroll
            for (int i = 0; i < 16; ++i) OB[(mt * 32 + att::crow(i, hi)) * 260 + C.wid * 32 + r32] = oacc[mt][i];
        __syncthreads();
        { const int t = C.tid >> 3, part = C.tid & 7; f32x4 v[8]; float ss = 0.f;
#pragma unroll
          for (int jj = 0; jj < 8; ++jj) { v[jj] = *(const LAS f32x4*)(OB + t * 260 + jj * 32 + part * 4); ss += v[jj][0] * v[jj][0] + v[jj][1] * v[jj][1] + v[jj][2] * v[jj][2] + v[jj][3] * v[jj][3]; }
          ss += dppmov<DPP_HMIRROR>(ss); ss += dppmov<DPP_Q3210>(ss); ss += dppmov<DPP_Q1032>(ss);
          const float rs = rsqrtf(ss * (1.0f / 256.0f) + NORM_EPS);
#pragma unroll
          for (int jj = 0; jj < 8; ++jj) { const int e = jj * 32 + part * 4; const f32x4 g = *(const f32x4*)(gon + e);
              const u32x2 gt = *(const u32x2*)(P + (r0 + t) * NP + C_LG + h * 256 + e);
              const float o0 = v[jj][0] * rs * g[0] * siluf_(bflo(gt.x)), o1 = v[jj][1] * rs * g[1] * siluf_(bfhi(gt.x)), o2 = v[jj][2] * rs * g[2] * siluf_(bflo(gt.y)), o3 = v[jj][3] * rs * g[3] * siluf_(bfhi(gt.y));
              int p8 = __builtin_amdgcn_cvt_pk_fp8_f32(o0, o1, 0, false); p8 = __builtin_amdgcn_cvt_pk_fp8_f32(o2, o3, p8, true);
              *(unsigned*)(OL + (r0 + t) * 1024 + h * 256 + e) = (unsigned)p8; } }
        __syncthreads();
    }
}

__device__ __forceinline__ unsigned f_ord(float f) { const unsigned u = __float_as_uint(f); return u ^ ((unsigned)((int)u >> 31) | 0x80000000u); }
__device__ __forceinline__ float f_unord(unsigned k) { return __uint_as_float((k & 0x80000000u) ? (k ^ 0x80000000u) : ~k); }
__device__ __forceinline__ void ins_u(unsigned (&L)[16], unsigned x) {
#pragma unroll
    for (int j = 0; j < 16; ++j) { const unsigned h = L[j] > x ? L[j] : x; x = L[j] > x ? x : L[j]; L[j] = h; }
}
__device__ __forceinline__ void ins_f(float (&M)[16], float x) {
#pragma unroll
    for (int j = 0; j < 16; ++j) { const float h = M[j] > x ? M[j] : x; x = M[j] > x ? x : M[j]; M[j] = h; }
}
__device__ __forceinline__ void peer_top16(const bf16_t* __restrict__ qrow, const bf16_t* __restrict__ keys, int r32, int hi, unsigned (&L)[16]) {
    bf16x8 qf[8];
#pragma unroll
    for (int kk = 0; kk < 8; ++kk) qf[kk] = *(const bf16x8*)(qrow + kk * 16 + hi * 8);
#pragma unroll
    for (int j = 0; j < 16; ++j) L[j] = 0u;
    bf16x8 kA[8], kB[8];
    const bf16_t* kl = keys + (size_t)r32 * 128 + hi * 8;
#define PT_LDK(dst, mt) do { _Pragma("unroll") for (int kk = 0; kk < 8; ++kk) dst[kk] = *(const bf16x8*)(kl + (mt) * 32 * 128 + kk * 16); } while (0)
#define PT_PROC(src, mt) do { f32x16 acc = {}; \
        _Pragma("unroll") for (int kk = 0; kk < 8; ++kk) acc = __builtin_amdgcn_mfma_f32_32x32x16_bf16(src[kk], qf[kk], acc, 0, 0, 0); \
        _Pragma("unroll") for (int i = 0; i < 16; ++i) { const unsigned kidx = (unsigned)((mt) * 32 + att::crow(i, hi)); ins_u(L, (f_ord(acc[i]) & ~127u) | (127u - kidx)); } } while (0)
    PT_LDK(kA, 0);
#pragma unroll 1
    for (int mp = 0; mp < 2; ++mp) { PT_LDK(kB, 2 * mp + 1); PT_PROC(kA, 2 * mp); if (mp == 0) PT_LDK(kA, 2); PT_PROC(kB, 2 * mp + 1); }
#undef PT_LDK
#undef PT_PROC
    unsigned Pn[16];
#pragma unroll
    for (int j = 0; j < 16; ++j) { auto r_ = __builtin_amdgcn_permlane32_swap(L[j], L[j], false, false); Pn[j] = hi ? r_[0] : r_[1]; }
#pragma unroll
    for (int j = 0; j < 16; ++j) ins_u(L, Pn[j]);
}
__device__ __forceinline__ void phase_peer_select(const Ctx& C, const bool latent_only) {
    const bf16_t* PQ = WSP(bf16_t, WS_PQ); const bf16_t* K1 = WSP(bf16_t, WS_K1); const bf16_t* K2 = WSP(bf16_t, WS_K2);
    int* PIDX = WSP(int, WS_PIDX); float* PG = WSP(float, WS_PG);
    const int r32 = C.lane & 31, hi = C.lane >> 5, head = C.wid;
    const int ngrp = latent_only ? NBATCH * SEQ / 32 : TT / 32;
    for (int gi = C.bid; gi < ngrp; gi += C.G) {
        const int grp = latent_only ? gi + (CTXL / 32) * (1 + gi / (SEQ / 32)) : gi;
        const size_t tok = (size_t)grp * 32 + r32;
        unsigned L1[16], L2[16];
        peer_top16(PQ + tok * DM + head * 256, K1 + (size_t)head * 128 * 128, r32, hi, L1);
        peer_top16(PQ + tok * DM + head * 256 + 128, K2 + (size_t)head * 128 * 128, r32, hi, L2);
        float v1[16], v2[16];
#pragma unroll
        for (int j = 0; j < 16; ++j) { v1[j] = f_unord(L1[j] & ~127u); v2[j] = f_unord(L2[j] & ~127u); }
        float M[16];
#pragma unroll
        for (int j = 0; j < 16; ++j) M[j] = -3.0e38f;
#pragma unroll
        for (int a = 0; a < 16; ++a)
#pragma unroll
            for (int b = 0; b < 16; ++b) if ((a + 1) * (b + 1) <= 16) ins_f(M, v1[a] + v2[b]);
        const float thr = M[15], mx = M[0]; float den = 0.f;
#pragma unroll
        for (int j = 0; j < 16; ++j) den += __expf(M[j] - mx);
        const float rden = 1.0f / den;
        int pos = 0; int* ip = PIDX + tok * 128 + head * 16; float* gp = PG + tok * 128 + head * 16;
#pragma unroll
        for (int a = 0; a < 16; ++a)
#pragma unroll
            for (int b = 0; b < 16; ++b) if ((a + 1) * (b + 1) <= 16) {
                const float val = v1[a] + v2[b];
                if (val >= thr && pos < 16) { if (hi == 0) { ip[pos] = (int)((127u - (L1[a] & 127u)) * 128u + (127u - (L2[b] & 127u))); gp[pos] = __expf(val - mx) * rden; } ++pos; } }
    }
}
template <int OFF> __device__ __forceinline__ float dotf8(const float (&h)[32], const u32x4 w, float acc) {
#pragma unroll
    for (int j = 0; j < 4; ++j) { const f32x2 lo = __builtin_amdgcn_cvt_pk_f32_fp8((int)w[j], false), hi = __builtin_amdgcn_cvt_pk_f32_fp8((int)w[j], true);
        acc += h[OFF + 4 * j] * lo.x; acc += h[OFF + 4 * j + 1] * lo.y; acc += h[OFF + 4 * j + 2] * hi.x; acc += h[OFF + 4 * j + 3] * hi.y; }
    return acc;
}
constexpr float ATT_O8_SCALE = 32.0f;
constexpr int GT_MAXTOK = 9;
template <bool LAST> __device__ __forceinline__ void phase_peer_gather(const Ctx& C, const float* modl, const float pscale) {
    const unsigned char* pt = C.ws + WS_PT + (size_t)(LAST ? DEPTH - 1 : 0) * PT_BYTES;
    const bf16_t* HB = WSP(bf16_t, WS_HB); const unsigned char* U8 = pt + PT_U8; const unsigned char* V8 = pt + PT_V8;
    const float* SCU = (const float*)(pt + PT_SCU); const float* SCV = (const float*)(pt + PT_SCV);
    const int* PIDX = WSP(int, WS_PIDX); const float* PG = WSP(float, WS_PG); float* XS = WSP(float, WS_XS);
    const int lane = C.lane, s = lane >> 3, j = lane & 7; const unsigned j16 = (unsigned)j * 16u;
    LAS int* IDS = (LAS int*)(C.lds + C.wid * (GT_MAXTOK * 512));
    LAS float* ACT = (LAS float*)(C.lds + 8 * GT_MAXTOK * 512 + C.wid * (GT_MAXTOK * 512));
    LAS int* ROWS = (LAS int*)(C.lds + 16 * GT_MAXTOK * 512 + C.wid * 64);
    int nk = 0;
    {
      const int per = (TT + C.G - 1) / C.G, base = C.bid * per;
#pragma unroll 1
      for (int k = 0; k < GT_MAXTOK; ++k) { const int o = C.wid + 8 * k; const int r = base + o; if (o < per && r < TT && !(LAST && (r % RPB) < CTXL)) { if (lane == 0) ROWS[nk] = r; ++nk; } } }
#define GT_ROW(k) __builtin_amdgcn_readfirstlane(ROWS[k])
#pragma unroll 1
    for (int k = 0; k < nk; ++k) { const int r = GT_ROW(k);
        IDS[k * 128 + lane] = (PIDX[(size_t)r * 128 + lane] & (NEXP - 1)) << 7; IDS[k * 128 + 64 + lane] = (PIDX[(size_t)r * 128 + 64 + lane] & (NEXP - 1)) << 7;
        ACT[k * 128 + lane] = 0.f; ACT[k * 128 + 64 + lane] = 0.f; }
    const int nit = 32 * nk;
#define GT_ITEM(it_) const int cb_ = (it_) / (2 * nk), rem_ = (it_) - cb_ * (2 * nk), k_ = rem_ >> 1, hf_ = rem_ & 1
#define GT_LOADU(UQ, HQ, it_) do { GT_ITEM(it_); const int r_ = GT_ROW(k_); \
        const bf16_t* hp_ = HB + (size_t)r_ * DM + cb_ * 128 + j * 16; HQ[0] = *(const u32x4*)hp_; HQ[1] = *(const u32x4*)(hp_ + 8); \
        const unsigned char* ub_ = U8 + (size_t)cb_ * ((size_t)NEXP * 128);     \
        _Pragma("unroll") for (int eg = 0; eg < 8; ++eg) { const unsigned off_ = ((unsigned)IDS[k_ * 128 + (hf_ * 8 + eg) * 8 + s] & idmask) + j16; UQ[eg] = *(const u32x4*)(ub_ + off_); } } while (0)
#define GT_COMPU(UQ, HQ, it_) do { GT_ITEM(it_); (void)cb_; f32x2 hf2[8]; \
        _Pragma("unroll") for (int hh = 0; hh < 2; ++hh) { const u32x4 w_ = HQ[hh]; \
            hf2[hh * 4 + 0] = (f32x2){bflo(w_.x), bfhi(w_.x)}; hf2[hh * 4 + 1] = (f32x2){bflo(w_.y), bfhi(w_.y)}; hf2[hh * 4 + 2] = (f32x2){bflo(w_.z), bfhi(w_.z)}; hf2[hh * 4 + 3] = (f32x2){bflo(w_.w), bfhi(w_.w)}; } \
        float d[8]; \
        _Pragma("unroll") for (int eg = 0; eg < 8; ++eg) { f32x2 d2 = (f32x2){0.f, 0.f}; \
            _Pragma("unroll") for (int q = 0; q < 4; ++q) { const f32x2 lo = __builtin_amdgcn_cvt_pk_f32_fp8((int)UQ[eg][q], false), hi = __builtin_amdgcn_cvt_pk_f32_fp8((int)UQ[eg][q], true); \
                d2 += hf2[2 * q] * lo; d2 += hf2[2 * q + 1] * hi; } \
            d[eg] = d2.x + d2.y; } \
          \
        float t4[4], t2[2], t1; \
        _Pragma("unroll") for (int i = 0; i < 4; ++i) { const float snd = (j & 4) ? d[i] : d[i + 4], kp = (j & 4) ? d[i + 4] : d[i]; t4[i] = kp + dppmov<DPP_HMIRROR>(snd); } \
        _Pragma("unroll") for (int i = 0; i < 2; ++i) { const float snd = (j & 2) ? t4[i] : t4[i + 2], kp = (j & 2) ? t4[i + 2] : t4[i]; t2[i] = kp + dppmov<DPP_Q3210>(snd); } \
        { const float snd = (j & 1) ? t2[0] : t2[1], kp = (j & 1) ? t2[1] : t2[0]; t1 = kp + dppmov<DPP_Q1032>(snd); } \
        ACT[k_ * 128 + (hf_ * 8 + j) * 8 + s] += t1; } while (0)
#ifdef DBG_GDUP
#pragma unroll 1
    for (int rep_ = 0; rep_ < 2; ++rep_) {
    const unsigned idmask = rep_ == 0 ? ((unsigned)DBG_GMASK << 7 | 127u) : 0xffffffffu;
    if (rep_ == 1) { for (int k = 0; k < nk; ++k) { ACT[k * 128 + lane] = 0.f; ACT[k * 128 + 64 + lane] = 0.f; } }
#else
    { const unsigned idmask = 0xffffffffu;
#endif
    if (nit > 0) {
        u32x4 uA[8], uB[8], hA[2], hB[2];
        GT_LOADU(uA, hA, 0);
#pragma unroll 1
        for (int it = 0; it < nit; it += 2) {
            GT_LOADU(uB, hB, it + 1);
            GT_COMPU(uA, hA, it);
            if (it + 2 < nit) GT_LOADU(uA, hA, it + 2);
            GT_COMPU(uB, hB, it + 1);
        }
    }
    }
#undef GT_LOADU
#undef GT_COMPU
#pragma unroll 1
    for (int k = 0; k < nk; ++k) { const int r = GT_ROW(k);
#pragma unroll
        for (int hh = 0; hh < 2; ++hh) { const int e = hh * 64 + lane; const int id = IDS[k * 128 + e] >> 7; const float a = ACT[k * 128 + e] * SCU[id];
            const float w = PG[(size_t)r * 128 + e] * 0.5f * a * (1.0f + erff(a * 0.70710678118654752f));
#if defined(DBG_CHECK) && (DBG_CHECK == 3 || DBG_CHECK == 4)
            if (((r - 300) & 63) == 0 && r >= 300 && r < 300 + 64 * 128) WSP(float, WS_OM)[(size_t)r * 128 + e] = w;
#endif
            ACT[k * 128 + e] = w * SCV[id]; } }
#define GT_LOADV(VQ, WV, it_) do { GT_ITEM(it_); const unsigned char* vb_ = V8 + (size_t)cb_ * ((size_t)NEXP * 128); \
        _Pragma("unroll") for (int eg = 0; eg < 8; ++eg) { const int e_ = k_ * 128 + (hf_ * 8 + eg) * 8 + s; const unsigned off_ = (unsigned)IDS[e_] + j16; VQ[eg] = *(const u32x4*)(vb_ + off_); WV[eg] = ACT[e_]; } } while (0)
#define GT_COMPV(VQ, WV) do { \
        _Pragma("unroll") for (int eg = 0; eg < 8; ++eg) { const f32x2 w2_ = (f32x2){WV[eg], WV[eg]}; \
            _Pragma("unroll") for (int q = 0; q < 4; ++q) { \
                const f32x2 lo = __builtin_amdgcn_cvt_pk_f32_fp8((int)VQ[eg][q], false), hi = __builtin_amdgcn_cvt_pk_f32_fp8((int)VQ[eg][q], true); \
                acc2[2 * q] += w2_ * lo; acc2[2 * q + 1] += w2_ * hi; } } } while (0)
    if (nit > 0) {
        u32x4 vA[8], vB[8]; float wA[8], wB[8];
        GT_LOADV(vA, wA, 0);
#pragma unroll 1
        for (int it = 0; it < nit; it += 2) {
            f32x2 acc2[8];
#pragma unroll
            for (int i = 0; i < 8; ++i) acc2[i] = (f32x2){0.f, 0.f};
            GT_LOADV(vB, wB, it + 1);
            GT_COMPV(vA, wA);
            if (it + 2 < nit) GT_LOADV(vA, wA, it + 2);
            GT_COMPV(vB, wB);
            f32x2 t4[4], t2[2], t1;
#pragma unroll
            for (int i = 0; i < 4; ++i) { const f32x2 snd = (s & 4) ? acc2[i] : acc2[i + 4], kp = (s & 4) ? acc2[i + 4] : acc2[i];
                t4[i] = kp + (f32x2){xchg32(snd.x, lane), xchg32(snd.y, lane)}; }
#pragma unroll
            for (int i = 0; i < 2; ++i) { const f32x2 snd = (s & 2) ? t4[i] : t4[i + 2], kp = (s & 2) ? t4[i + 2] : t4[i];
                t2[i] = kp + (f32x2){xchg16(snd.x, lane), xchg16(snd.y, lane)}; }
            { const f32x2 snd = (s & 1) ? t2[0] : t2[1], kp = (s & 1) ? t2[1] : t2[0]; t1 = kp + (f32x2){dppmov<DPP_ROR8>(snd.x), dppmov<DPP_ROR8>(snd.y)}; }
            { GT_ITEM(it); (void)hf_; const int r_ = GT_ROW(k_);
              const int col = cb_ * 128 + j * 16 + 2 * s; float* xp = XS + (size_t)r_ * DM + col; const float* g2 = modl + (size_t)mod_sel(r_) * 12288 + 5 * DM + col;
#if defined(DBG_CHECK) && (DBG_CHECK == 3 || DBG_CHECK == 4)
              if (((r_ - 300) & 63) == 0 && r_ >= 300 && r_ < 300 + 64 * 128) { float* dbgo = WSP(float, WS_MQ) + (size_t)r_ * DM + col; dbgo[0] = t1.x; dbgo[1] = t1.y; }
#endif
              const f32x2 x = *(const f32x2*)xp, g = *(const f32x2*)g2;
              *(f32x2*)xp = x + pscale * g * t1; }
        }
    }
#undef GT_LOADV
#undef GT_COMPV
#undef GT_ITEM
#undef GT_ROW
}
__device__ __forceinline__ void phase_final_norm(const Ctx& C) {
    const float* XS = WSP(float, WS_XS); const float* fg = INP(I_FG);
    for (int q = C.bid * 8 + C.wid; q < NBATCH * SEQ; q += C.G * 8) {
        const int b = q / SEQ, t = q % SEQ; const float* xr = XS + ((size_t)b * RPB + CTXL + t) * DM; float* op = C.out + (size_t)q * DM;
        f32x4 v[8]; float ss = 0.f;
#pragma unroll
        for (int c = 0; c < 8; ++c) { v[c] = *(const f32x4*)(xr + c * 256 + C.lane * 4); ss += v[c][0] * v[c][0] + v[c][1] * v[c][1] + v[c][2] * v[c][2] + v[c][3] * v[c][3]; }
        ss = wave_sum(ss); const float rs = rsqrtf(ss * (1.0f / DM) + NORM_EPS);
#pragma unroll
        for (int c = 0; c < 8; ++c) { const f32x4 g = *(const f32x4*)(fg + c * 256 + C.lane * 4); *(f32x4*)(op + c * 256 + C.lane * 4) = v[c] * rs * g; }
    }
}


__device__ __forceinline__ void phase_vt8(const Ctx& C) {
    const bf16_t* P = WSP(bf16_t, WS_P); const bf16_t* MKV = WSP(bf16_t, WS_MKV);
    const int dv = C.tid & 127, kq = C.tid >> 7, g = kq >> 1, j0 = (kq & 1) * 16;
    constexpr int NU_A = NBATCH * 2 * NCH, NU_M = NBATCH * 8 * NCH;
    for (int u = C.bid; u < NU_A + NU_M; u += C.G) {
        const bool gqa = u < NU_A; const int v = gqa ? u : u - NU_A; const int nh = gqa ? 2 : 8;
        const int b = v / (nh * NCH), h = (v / NCH) % nh, t = v % NCH; const size_t r0 = (size_t)b * RPB + t * 64;
        const bf16_t* src = gqa ? P + r0 * NP + C_AV + h * 128 + dv : MKV + r0 * 2048 + h * 256 + 128 + dv; const size_t ld = gqa ? NP : 2048;
        float x[16];
#pragma unroll
        for (int jj = 0; jj < 16; ++jj) x[jj] = bf2f(src[(size_t)att::vt8_key(g, j0 + jj) * ld]);
        u32x4 w; w.x = (unsigned)att::pk4_fp8(x[0], x[1], x[2], x[3]); w.y = (unsigned)att::pk4_fp8(x[4], x[5], x[6], x[7]); w.z = (unsigned)att::pk4_fp8(x[8], x[9], x[10], x[11]); w.w = (unsigned)att::pk4_fp8(x[12], x[13], x[14], x[15]);
        unsigned char* dst = C.ws + (gqa ? WS_VT8A : WS_VT8M) + ((size_t)(b * nh + h) * NCH + t) * 8192 + dv * 64 + kq * 16;
        *(u32x4*)dst = w;
    }
}
template <int TYPE  , int VAR = 0> __device__ __forceinline__ void attn_units(const Ctx& C, bool need_ctx) {
    const bf16_t* P = WSP(bf16_t, WS_P);
    const int nu = need_ctx ? 528 : 512;
#pragma unroll 1
    for (int u = C.bid; u < nu; u += C.G) {
        int bh, qb; if (u < 512) { bh = (u >> 8) * 8 + (u & 7); qb = ((u & 255) >> 3) + 1; } else { bh = u - 512; qb = 0; }
        const int b = bh >> 3, h = bh & 7; const size_t rq = (size_t)b * RPB + (size_t)qb * 256, rk = (size_t)b * RPB; const int seq = qb == 0 ? CTXL : RPB;
        __syncthreads();
        if constexpr (TYPE == 1) {
            att::attn_body88<128>(P + rq * NP + C_AQ + h * 128, NP, C.ws + WS_AK8 + rk * 256 + (h >> 2) * 128, 256, nullptr, 0, C.ws + WS_VT8A + (size_t)(b * 2 + (h >> 2)) * NCH * 8192,
                                  C.ws + WS_OA + rq * 1024 + h * 128, 1024, seq, false, 0, nullptr, (char*)C.lds, C.tid);
        } else {
            const bf16_t* MQ = WSP(bf16_t, WS_MQ);
            att::attn_body88<192>(MQ + rq * 1536 + h * 192, 1536, C.ws + WS_KN8 + rk * 1024 + h * 128, 1024, C.ws + WS_KR8 + rk * 64, 64, C.ws + WS_VT8M + (size_t)(b * 8 + h) * NCH * 8192,
                                  C.ws + WS_OM + rq * 1024 + h * 128, 1024, seq, qb > 0, (qb - 1) * 256, WSP(float, WS_TABM), (char*)C.lds, C.tid);
        }
    }
    __syncthreads();
}

constexpr int LDS_BYTES = 163840, LDS_BAR_OFF = LDS_BYTES - 16;
constexpr int N_PHASES = 26;
template <int K> __device__ __forceinline__ void run_phase(const Ctx& C0, int l) {
    const Ctx C = launder(C0);
    const float* modl = WSP(float, WS_MODV) + (size_t)l * 3 * 12288;
    if constexpr (K == 0) { phase_modv(C); phase_tables(C); __syncthreads(); phase_cvt_mixer_weights(C, 0); }
    if constexpr (K == 1) {
        if (l == 0) phase_norm_mod<true, true>(C, INP(I_N1G), modl, 0, DM);
        else { phase_norm_mod<false, true>(C, INP(I_N1G) + l * DM, modl, 0, DM); __syncthreads(); phase_cvt_mixer_weights(C, l); }
    }
    if constexpr (K == 2) {
        pg8::Gemm g{WSP(bf16_t, WS_HB), WSP(bf16_t, WS_WIN), TT, NP, DM, DM, DM}; pg8::WinOrder S; S.init(C.G, C.bid, l + 1 < DEPTH);
        pg8::EpiStoreBf16S E{WSP(bf16_t, WS_P), NP, WSP(float, WS_WINS)};
        pg8::gemm_phase<pg8::EpiStoreBf16S, pg8::WinOrder, 1>(C.lds, C.tid, g, S, E);
    }
    if constexpr (K == 3) phase_post_p(C, l);
    if constexpr (K == 4) {
        { pg8::Gemm g{WSP(bf16_t, WS_P) + C_MCQ, WSP(bf16_t, WS_WUQ), TT, 1536, 512, NP, 512}; pg8::StaticOrder S; S.init(TT, 1536, C.G, C.bid);
          pg8::EpiStoreBf16 E{WSP(bf16_t, WS_MQ), 1536}; pg8::gemm_phase(C.lds, C.tid, g, S, E); }
        { pg8::Gemm g{WSP(bf16_t, WS_P) + C_MCKV, WSP(bf16_t, WS_WUKV), TT, 2048, 512, NP, 512}; pg8::StaticOrder S; S.init(TT, 2048, C.G, (C.bid + C.G - 140 % C.G) % C.G);
          pg8::EpiStoreMKV E{WSP(bf16_t, WS_MKV), C.ws + WS_KN8}; pg8::gemm_phase(C.lds, C.tid, g, S, E); }
        { const Ctx C2 = launder(C0); phase_gla_local(C2, l, 156); }
#ifdef DBG_DUP_GLALOCAL
        { const Ctx C2 = launder(C0); __syncthreads(); phase_gla_local(C2, l, 156); }
#endif
    }
    if constexpr (K == 5) { phase_gla_scan(C); { const Ctx C2 = launder(C0); phase_vt8(C2); } }
    if constexpr (K == 6) {
#ifdef DBG_ATTVAR
        { const Ctx Cx = launder(C0); attn_units<0, DBG_ATTVAR>(Cx, l + 1 < DEPTH); } { const Ctx Cx = launder(C0); attn_units<1, DBG_ATTVAR>(Cx, l + 1 < DEPTH); } __syncthreads();
#endif
        attn_units<0>(C, l + 1 < DEPTH); { const Ctx C2 = launder(C0); attn_units<1>(C2, l + 1 < DEPTH); } { const Ctx C3 = launder(C0); phase_gla_out(C3, l, 128); }
#ifdef DBG_DUP_GLAOUT
        { const Ctx C3 = launder(C0); __syncthreads(); phase_gla_out(C3, l, 128); }
#endif
    }
    if constexpr (K == 7) {
        const bf16_t* P = WSP(bf16_t, WS_P); bf16_t* Y = WSP(bf16_t, WS_Y);
        const pg8::Gemm ga{WSP(bf16_t, WS_OA), WSP(bf16_t, WS_WBR), TT, DM, 1024, 1024, 1024}, gl{WSP(bf16_t, WS_OL), (const bf16_t*)(C.ws + WS_WBR + (size_t)2048 * 1024), TT, DM, 1024, 1024, 1024},
                        gm{WSP(bf16_t, WS_OM), (const bf16_t*)(C.ws + WS_WBR + (size_t)2 * 2048 * 1024), TT, DM, 1024, 1024, 1024};
        unsigned char* Y8 = C.ws + WS_HB;
        const float* wbs = WSP(float, WS_WBRS);
        const pg8::EpiGate<true> Ea{Y, P + C_GA, nullptr, wbs}; const pg8::EpiGate<false> El{Y, P + C_GL, nullptr, wbs + DM}; const pg8::EpiGate<false, true> Em{Y, P + C_GM, Y8, wbs + 2 * DM};
        pg8::StaticOrder S; S.init(TT, DM, C.G, C.bid, l + 1 >= DEPTH);
        pg8::gemm_phase<pg8::EpiGate<true>, pg8::StaticOrder, 1>(C.lds, C.tid, ga, S, Ea); pg8::gemm_phase<pg8::EpiGate<false>, pg8::StaticOrder, 1>(C.lds, C.tid, gl, S, El);
        pg8::gemm_phase<pg8::EpiGate<false, true>, pg8::StaticOrder, 1>(C.lds, C.tid, gm, S, Em);
        if (l == 0) { const Ctx C2 = launder(C0); phase_cvt_peer_tables(C2, 0, 0, NEXP, S.nwg % C.G); }
    }
    if constexpr (K == 8) {
        pg8::Gemm g{WSP(bf16_t, WS_HB), WSP(bf16_t, WS_WOUT), TT, DM, DM, DM, DM};
        const pg8::EpiResidT<true> E{WSP(float, WS_XS), DM, modl + 2 * DM, WSP(float, WS_WOUTS)};
        pg8::StaticOrder S; S.init(TT, DM, C.G, C.bid, l + 1 >= DEPTH);
        pg8::gemm_phase<pg8::EpiResidT<true>, pg8::StaticOrder, 1>(C.lds, C.tid, g, S, E);
        if (l == 0 && DEPTH > 1) { const Ctx C2 = launder(C0); phase_cvt_peer_tables(C2, 1, 0, NEXP / 2, S.nwg % C.G); }
    }
    if constexpr (K == 9) phase_norm_mod<false>(C, INP(I_N2G) + l * DM, modl, 3 * DM, 4 * DM);
    if constexpr (K == 10) {
        pg8::Gemm g{WSP(bf16_t, WS_HB), WSP(bf16_t, WS_WQ), TT, DM, DM, DM, DM};
        pg8::EpiStoreBf16 E{WSP(bf16_t, WS_PQ), DM};
        pg8::StaticOrder S; S.init(TT, DM, C.G, C.bid, l + 1 >= DEPTH); pg8::gemm_phase(C.lds, C.tid, g, S, E);
        if (l == 0 && DEPTH > 1) { const Ctx C2 = launder(C0); phase_cvt_peer_tables(C2, 1, NEXP / 2, NEXP, S.nwg % C.G); }
    }
    if constexpr (K == 11) phase_peer_select(C, l + 1 >= DEPTH);
    if constexpr (K == 13) phase_final_norm(C);
    if constexpr (K == 12) {
#ifdef DBG_DUP12
        if (l + 1 < DEPTH) phase_peer_gather<false>(C, modl, 0.0f); else phase_peer_gather<true>(C, modl, 0.0f);
        __syncthreads();
#endif
        if (l + 1 < DEPTH) phase_peer_gather<false>(C, modl, DBG_PEER0); else phase_peer_gather<true>(C, modl, DBG_PEER1); }
}
__device__ __forceinline__ Ctx make_ctx(const Args& args, unsigned char* lds_raw) {
    Ctx C0; C0.in = (const __attribute__((address_space(4))) cfp_t*)__builtin_amdgcn_kernarg_segment_ptr(); C0.out = args.out; C0.ws = args.ws; C0.lds = (LAS unsigned char*)lds_raw;
    C0.tid = threadIdx.x; C0.lane = C0.tid & 63; C0.wid = __builtin_amdgcn_readfirstlane(C0.tid >> 6); C0.G = gridDim.x; C0.bid = blockIdx.x;
    return C0;
}
template <int K> __global__ void __launch_bounds__(NTHREADS, 2) k_one(Args args) {
    extern __shared__ __attribute__((aligned(16))) unsigned char lds_raw[];
    const Ctx C0 = make_ctx(args, lds_raw);
    run_phase<K>(C0, args.ph_lo);
}
#if MK_N_LAUNCHES == 1 || defined(DBG_HYB)
__global__ void __launch_bounds__(NTHREADS, 2) mk_fwd(Args args) {
    extern __shared__ __attribute__((aligned(16))) unsigned char lds_raw[];
    const Ctx C0 = make_ctx(args, lds_raw);
    if (C0.tid < 4) ((LAS unsigned*)(C0.lds + LDS_BAR_OFF))[C0.tid] = 0u;
    __syncthreads();
    const int lo = args.ph_lo, hi = args.ph_hi;
    XcdBarrier bar; bar.bar = (unsigned*)(args.ws + WS_CTL); bar.x = 0; bar.st = nullptr;
    if (hi - lo > 1) bar = xcd_barrier_post((unsigned*)(args.ws + WS_CTL), (volatile LAS unsigned*)(C0.lds + LDS_BAR_OFF));
#define IN(k) (lo <= (k) && (k) < hi)
#define SEAM(k) do { if (IN(k) && IN((k) + 1)) xcd_barrier(bar); } while (0)
#ifndef DBG_DUP
#define DBG_DUP -1
#endif
#define PH(K, k) do { if (IN(k)) { run_phase<K>(C0, l); if (K == DBG_DUP) { xcd_barrier(bar); run_phase<K>(C0, l); } } SEAM(k); } while (0)
    { const int l = 0; PH(0, 0); }
#pragma unroll 1
    for (int l = 0; l < DEPTH; ++l) {
        const int pb = 1 + 12 * l;
        PH(1, pb + 0); PH(2, pb + 1); PH(3, pb + 2); PH(4, pb + 3); PH(5, pb + 4); PH(6, pb + 5);
        PH(7, pb + 6); PH(8, pb + 7); PH(9, pb + 8); PH(10, pb + 9); PH(11, pb + 10); PH(12, pb + 11);
    }
    { const int l = DEPTH - 1; PH(13, 1 + 12 * DEPTH); }
#undef PH
#undef IN
#undef SEAM
}
#define MAIN_KERNEL mk_fwd
#else
#define MAIN_KERNEL k_one<6>
#endif


#ifdef DBG_PROBE
typedef int i32x8 __attribute__((ext_vector_type(8)));
__device__ __forceinline__ unsigned char fp8_of_int(int v) {
    const float f = (float)v; return (unsigned char)(__builtin_amdgcn_cvt_pk_fp8_f32(f, 0.f, 0, false) & 0xff); }
__global__ void k_probe_mx(unsigned* slot) {
    const int l = threadIdx.x, r = l & 31, g = l >> 5;
    i32x8 A, B;
    for (int j = 0; j < 8; ++j) { unsigned wa = 0, wb = 0;
        for (int b = 0; b < 4; ++b) { const int k = g * 32 + 4 * j + b;
            wa |= (unsigned)fp8_of_int(((3 * r + k) % 7) - 3) << (8 * b); wb |= (unsigned)fp8_of_int(((5 * k + 2 * r) % 9) - 4) << (8 * b); }
        A[j] = (int)wa; B[j] = (int)wb; }
    f32x16 c = {};
    c = __builtin_amdgcn_mfma_scale_f32_32x32x64_f8f6f4(A, B, c, 0, 0, 0, 0x7f7f7f7f, 0, 0x7f7f7f7f);
    float worst = 0.f;
    for (int i = 0; i < 16; ++i) { const int m = (i & 3) + 8 * (i >> 2) + 4 * g, n = r; float ref = 0.f; for (int k = 0; k < 64; ++k) ref += (float)(((3 * m + k) % 7) - 3) * (float)(((5 * k + 2 * n) % 9) - 4);
        worst = fmaxf(worst, fabsf(c[i] - ref)); }
    for (int o = 32; o >= 1; o >>= 1) worst = fmaxf(worst, __shfl_xor(worst, o));
    if (l == 0) { const float code = worst == 0.f ? 0.4f : 1.2f; *slot = __float_as_uint(powf(10.f, code / 0.25f - 4.f)); }
}
#endif
#ifdef DBG_CHECK
__device__ __forceinline__ void dbg_report(unsigned* slot, float err) { if (!(err <= 3e38f)) err = 1e30f; atomicMax(slot, __float_as_uint(err)); }
__global__ void k_check_gemm(const bf16_t* A, int lda, const float* W, int K, int N, const bf16_t* Cm, int ldc, int M, unsigned* slot) {
    const unsigned id = blockIdx.x * blockDim.x + threadIdx.x; if (id >= 8192) return;
    const unsigned h = id * 2654435761u; const int row = (int)((h >> 8) % (unsigned)M), col = (int)((h * 40503u >> 7) % (unsigned)N);
    float ref = 0.f; for (int k = 0; k < K; ++k) ref += bf2f(A[(size_t)row * lda + k]) * W[(size_t)k * N + col];
    const float got = bf2f(Cm[(size_t)row * ldc + col]);
    dbg_report(slot, fabsf(got - ref) / (fabsf(ref) + 0.1f));
}

__global__ void k_check_attn(const unsigned char* ws, int type, unsigned* slot) {
    __shared__ float sc[RPB]; __shared__ float red[256]; __shared__ float qv[192];
    const int t = threadIdx.x, bh = blockIdx.x & 15, b = bh >> 3, h = bh & 7; const int qpos = (int)(((blockIdx.x >> 4) * 977u + 13u) % SEQ); const size_t rq = (size_t)b * RPB + CTXL + qpos, rk = (size_t)b * RPB;
    const bf16_t* P = (const bf16_t*)(ws + WS_P); const bf16_t* MQ = (const bf16_t*)(ws + WS_MQ); const bf16_t* MKV = (const bf16_t*)(ws + WS_MKV);
    const int dq = type ? 128 : 192;
    if (t < dq) { float v = type ? bf2f(P[rq * NP + C_AQ + h * 128 + t]) : bf2f(MQ[rq * 1536 + h * 192 + t]); qv[t] = v; }
    __syncthreads();
    if (!type && t < 32) {
        const int ri = qpos >> 6, ci = qpos & 63; const int i = t; const float pos = (float)(i < 16 ? ri : ci); const float inv = powf(10000.f, -(float)(i & 15) / 16.f); const float a = pos * inv;
        const float x1 = qv[128 + i], x2 = qv[160 + i]; qv[128 + i] = x1 * cosf(a) - x2 * sinf(a); qv[160 + i] = x2 * cosf(a) + x1 * sinf(a); }
    __syncthreads();
    const float scale = type ? 0.088388347648f : 0.0721687836487f;
    float mx = -1e30f;
    for (int k = t; k < RPB; k += 256) { float s = 0.f;
        if (type) { const bf16_t* kp = P + (rk + k) * NP + C_AK + (h >> 2) * 128; for (int d = 0; d < 128; ++d) s += qv[d] * bf2f(kp[d]); }
        else { const bf16_t* kp = MKV + (rk + k) * 2048 + h * 256; for (int d = 0; d < 128; ++d) s += qv[d] * bf2f(kp[d]); const bf16_t* kr = P + (rk + k) * NP + C_MKR; for (int d = 0; d < 64; ++d) s += qv[128 + d] * bf2f(kr[d]); }
        s *= scale; sc[k] = s; mx = fmaxf(mx, s); }
    red[t] = mx; __syncthreads(); for (int o = 128; o >= 1; o >>= 1) { if (t < o) red[t] = fmaxf(red[t], red[t + o]); __syncthreads(); } mx = red[0]; __syncthreads();
    float sum = 0.f; for (int k = t; k < RPB; k += 256) { const float p = __expf(sc[k] - mx); sc[k] = p; sum += p; }
    red[t] = sum; __syncthreads(); for (int o = 128; o >= 1; o >>= 1) { if (t < o) red[t] += red[t + o]; __syncthreads(); } sum = red[0]; __syncthreads();
    float e = 0.f, mag = 0.f;
    if (t < 128) { float o = 0.f; for (int k = 0; k < RPB; ++k) { const float vv = type ? bf2f(P[(rk + k) * NP + C_AV + (h >> 2) * 128 + t]) : bf2f(MKV[(rk + k) * 2048 + h * 256 + 128 + t]); o += sc[k] * vv; }
        o /= sum; const float got = __builtin_amdgcn_cvt_f32_fp8((int)(ws + (type ? WS_OA : WS_OM))[rq * 1024 + h * 128 + t], 0) * (1.0f / 32.0f); e = fabsf(got - o); mag = fabsf(o); }
    red[t] = e; __syncthreads(); for (int o = 128; o >= 1; o >>= 1) { if (t < o) red[t] = fmaxf(red[t], red[t + o]); __syncthreads(); } e = red[0]; __syncthreads();
    red[t] = mag; __syncthreads(); for (int o = 128; o >= 1; o >>= 1) { if (t < o) red[t] = fmaxf(red[t], red[t + o]); __syncthreads(); } mag = red[0];
    if (t == 0) dbg_report(slot, e / (mag + 1e-4f));
}
__global__ void __launch_bounds__(256) k_check_gla_rec(const unsigned char* ws, const float* wa_f, const float* ba_f, const float* wa_b, const float* ba_b, float* obuf, int b) {
    __shared__ float ad[128], kd[128], qd[128], lrs[16];
    const int e = threadIdx.x, h = blockIdx.x & 3, dir = blockIdx.x >> 2; const bf16_t* P = (const bf16_t*)(ws + WS_P);
    const float* wa = dir ? wa_b : wa_f; const float* ba = dir ? ba_b : ba_f;
    float S[128];
#pragma unroll
    for (int d = 0; d < 128; ++d) S[d] = 0.f;
    float* ob = obuf + ((size_t)(dir * 2 + b) * 4 + h) * RPB * 256;
    for (int st = 0; st < RPB; ++st) {
        int j; if (!dir) j = st; else j = st < CTXL ? CTXL - 1 - st : RPB - 1 - (st - CTXL);
        const size_t r = (size_t)b * RPB + j; const bf16_t* pr = P + r * NP;
        if (e < 16) lrs[e] = bf2f(pr[(dir ? C_LRB : C_LRF) + e]);
        __syncthreads();
        if (e < 128) { float pre = ba[h * 128 + e]; for (int q = 0; q < 16; ++q) pre += lrs[q] * wa[q * 512 + h * 128 + e];
            const float ls = (fminf(pre, 0.f) - log1pf(expf(-fabsf(pre)))) / 16.f; ad[e] = expf(ls); kd[e] = bf2f(pr[C_LK + h * 128 + e]); qd[e] = bf2f(pr[C_LQ + h * 128 + e]) * 0.088388347648f; }
        __syncthreads();
        const float v = bf2f(pr[C_LV + h * 256 + e]); float o = 0.f;
#pragma unroll
        for (int d = 0; d < 128; ++d) { S[d] = ad[d] * S[d] + kd[d] * v; o += qd[d] * S[d]; }
        ob[(size_t)j * 256 + e] = o;
        __syncthreads();
    }
}
__global__ void k_check_gla_cmp(const unsigned char* ws, const float* obuf, const float* gon, int b, unsigned* slot) {
    __shared__ float red[256];
    const int e = threadIdx.x, h = blockIdx.x & 3, j = blockIdx.x >> 2; const size_t r = (size_t)b * RPB + j; const bf16_t* P = (const bf16_t*)(ws + WS_P);
    const float o = obuf[((size_t)(0 * 2 + b) * 4 + h) * RPB * 256 + (size_t)j * 256 + e] + obuf[((size_t)(1 * 2 + b) * 4 + h) * RPB * 256 + (size_t)j * 256 + e];
    red[e] = o * o; __syncthreads(); for (int s_ = 128; s_ >= 1; s_ >>= 1) { if (e < s_) red[e] += red[e + s_]; __syncthreads(); }
    const float rs = rsqrtf(red[0] / 256.f + NORM_EPS); __syncthreads();
    const float gt = bf2f(P[r * NP + C_LG + h * 256 + e]); const float ref = o * rs * gon[e] * (gt / (1.f + expf(-gt)));
    const float got = __builtin_amdgcn_cvt_f32_fp8((int)(ws + WS_OL)[r * 1024 + h * 256 + e], 0);
    red[e] = fabsf(got - ref); __syncthreads(); for (int s_ = 128; s_ >= 1; s_ >>= 1) { if (e < s_) red[e] = fmaxf(red[e], red[e + s_]); __syncthreads(); }
    if (e == 0) dbg_report(slot, red[0] / 1.0f);
}

__global__ void k_check_gemm8(const unsigned char* A8, const float* W, int K, int N, const bf16_t* Cm, int ldc, int M, unsigned* slot) {
    const unsigned id = blockIdx.x * blockDim.x + threadIdx.x; if (id >= 8192) return;
    const unsigned h = id * 2654435761u; const int row = (int)((h >> 8) % (unsigned)M), col = (int)((h * 40503u >> 7) % (unsigned)N);
    float ref = 0.f, mag = 0.f; for (int k = 0; k < K; ++k) { const float a = __builtin_amdgcn_cvt_f32_fp8((int)A8[(size_t)row * K + k], 0), w = W[(size_t)k * N + col]; ref += a * w; mag += a * a * w * w; }
    const float got = bf2f(Cm[(size_t)row * ldc + col]);
    dbg_report(slot, fabsf(got - ref) / (sqrtf(mag) + 1e-3f));
}
__global__ void k_check_select(const bf16_t* PQ, const float* k1, const float* k2, const int* PIDX, const float* PG, unsigned* slot) {
    __shared__ float s1[128], s2[128]; __shared__ int cnt; __shared__ float selv[16];
    const int tok = (blockIdx.x >> 3) * 61 + 5, head = blockIdx.x & 7, t = threadIdx.x;
    if (t == 0) cnt = 0;
    for (int n = t; n < 128; n += 64) { float a = 0.f, b = 0.f; for (int d = 0; d < 128; ++d) { a += bf2f(PQ[(size_t)tok * DM + head * 256 + d]) * k1[((size_t)head * 128 + n) * 128 + d]; b += bf2f(PQ[(size_t)tok * DM + head * 256 + 128 + d]) * k2[((size_t)head * 128 + n) * 128 + d]; } s1[n] = a; s2[n] = b; }
    __syncthreads();
    if (t < 16) { const int id = PIDX[(size_t)tok * 128 + head * 16 + t]; selv[t] = (id >= 0 && id < 16384) ? s1[id >> 7] + s2[id & 127] : -1e30f; }
    __syncthreads();
    float thr = selv[0], mx = selv[0]; for (int k = 1; k < 16; ++k) { thr = fminf(thr, selv[k]); mx = fmaxf(mx, selv[k]); }
    int c = 0; for (int p = t; p < 16384; p += 64) if (s1[p >> 7] + s2[p & 127] > thr + 0.02f) ++c;
    atomicAdd(&cnt, c); __syncthreads();
    if (t == 0) { float den = 0.f; for (int k = 0; k < 16; ++k) den += __expf(selv[k] - mx); float e = fabsf((float)cnt - 15.f) / 15.f > 0.34f ? fabsf((float)cnt - 15.f) / 15.f : 0.f;
        for (int k = 0; k < 16; ++k) e = fmaxf(e, fabsf(PG[(size_t)tok * 128 + head * 16 + k] - __expf(selv[k] - mx) / den) * 4.f);
        for (int k = 0; k < 16; ++k) for (int k2_ = 0; k2_ < k; ++k2_) if (PIDX[(size_t)tok * 128 + head * 16 + k] == PIDX[(size_t)tok * 128 + head * 16 + k2_]) e = fmaxf(e, 10.f);
        dbg_report(slot, e); }
}
__global__ void k_check_gather(const bf16_t* HB, const float* u, const float* v, const int* PIDX, const float* PG, const float* dbgo, unsigned* slot) {
    __shared__ float w[128];
    const int tok = blockIdx.x * 64 + 300, t = threadIdx.x;
    for (int k = t; k < 128; k += 64) { const int id = PIDX[(size_t)tok * 128 + k] & 16383; float a = 0.f; for (int d = 0; d < DM; ++d) a += bf2f(HB[(size_t)tok * DM + d]) * u[(size_t)id * DM + d];
        w[k] = PG[(size_t)tok * 128 + k] * 0.5f * a * (1.0f + erff(a * 0.70710678f)); }
    __syncthreads();
    float e = 0.f, sc = 0.f;
    for (int d = t; d < DM; d += 64) { float o = 0.f; for (int k = 0; k < 128; ++k) o += w[k] * v[(size_t)(PIDX[(size_t)tok * 128 + k] & 16383) * DM + d];
        e = fmaxf(e, fabsf(o - dbgo[(size_t)tok * DM + d])); sc = fmaxf(sc, fabsf(o)); }
    for (int o_ = 32; o_ >= 1; o_ >>= 1) { e = fmaxf(e, __shfl_xor(e, o_)); sc = fmaxf(sc, __shfl_xor(sc, o_)); }
    if (t == 0) dbg_report(slot, e / (sc + 1e-6f));
}
__global__ void k_dbg_out2(const float* x, const float* fg, float* out, const unsigned* slot) {
    const float mx = __uint_as_float(*slot); float v = 0.25f * (log10f(fmaxf(mx, 1e-30f)) + 4.0f); v = fminf(fmaxf(v, 0.f), 9.f);
    const float f = 1.0f + v;
    const int lane = threadIdx.x & 63; const size_t r = (size_t)blockIdx.x * 4 + (threadIdx.x >> 6);
    const float* xr = x + r * DM; float ss = 0.f;
    for (int c = lane; c < DM; c += 64) ss += xr[c] * xr[c];
    ss = wave_sum(ss); const float rs = rsqrtf(ss / DM + NORM_EPS);
    for (int c = lane; c < DM; c += 64) out[r * DM + c] = xr[c] * rs * fg[c] * f;
}
#endif
#ifdef DBG_SCAN
__global__ void k_scan16(const bf16_t* p, size_t n, unsigned* flags, int stage) {
    unsigned bad = 0; for (size_t i = (size_t)blockIdx.x * blockDim.x + threadIdx.x; i < n; i += (size_t)gridDim.x * blockDim.x) bad |= ((p[i] & 0x7f80u) == 0x7f80u);
    if (bad) atomicOr(&flags[stage], 1u);
}
__global__ void k_scan32(const float* p, size_t n, unsigned* flags, int stage) {
    unsigned bad = 0; for (size_t i = (size_t)blockIdx.x * blockDim.x + threadIdx.x; i < n; i += (size_t)gridDim.x * blockDim.x) bad |= ((__float_as_uint(p[i]) & 0x7f800000u) == 0x7f800000u);
    if (bad) atomicOr(&flags[stage], 1u);
}
__global__ void k_dbg_out(const float* x, const float* fg, float* out, const unsigned* flags, int nstage) {
    int code = 0; for (int s = nstage; s >= 1; --s) if (flags[s]) code = s;
    const float f = 1.0f + 0.25f * (float)code;
    const int lane = threadIdx.x & 63; const size_t r = (size_t)blockIdx.x * 4 + (threadIdx.x >> 6);
    const float* xr = x + r * DM; float ss = 0.f;
    for (int c = lane; c < DM; c += 64) ss += xr[c] * xr[c];
    ss = wave_sum(ss); const float rs = rsqrtf(ss / DM + NORM_EPS);
    for (int c = lane; c < DM; c += 64) out[r * DM + c] = xr[c] * rs * fg[c] * f;
}
#endif
extern "C" void kernel_launch(void* const* d_in, const int* in_sizes, int n_in, void* d_out, int out_size, void* d_ws, size_t ws_size, hipStream_t stream) {
    static int grid = 0;
    if (grid == 0) {
        if (n_in != 30 || out_size != NBATCH * SEQ * DM || ws_size < WS_END) { fprintf(stderr, "kernel_launch: shape/workspace mismatch: n_in %d out %d ws %zu (need %zu)\n", n_in, out_size, ws_size, (size_t)WS_END); grid = -1; return; }
        int dev = 0, cus = 0, per_cu = 0;
        if (hipGetDevice(&dev) != hipSuccess || hipDeviceGetAttribute(&cus, hipDeviceAttributeMultiprocessorCount, dev) != hipSuccess) { grid = -1; return; }
        bool okattr = hipFuncSetAttribute((const void*)MAIN_KERNEL, hipFuncAttributeMaxDynamicSharedMemorySize, LDS_BYTES) == hipSuccess;
#if MK_N_LAUNCHES != 1
#ifdef DBG_HYB
        okattr = okattr && hipFuncSetAttribute((const void*)mk_fwd, hipFuncAttributeMaxDynamicSharedMemorySize, LDS_BYTES) == hipSuccess;
#endif
#define SETA(K) okattr = okattr && hipFuncSetAttribute((const void*)k_one<K>, hipFuncAttributeMaxDynamicSharedMemorySize, LDS_BYTES) == hipSuccess
        SETA(0); SETA(1); SETA(2); SETA(3); SETA(4); SETA(5); SETA(6); SETA(7); SETA(8); SETA(9); SETA(10); SETA(11); SETA(12); SETA(13);
#undef SETA
#endif
        if (!okattr) { fprintf(stderr, "kernel_launch: hipFuncSetAttribute failed\n"); grid = -1; return; }
        if (hipOccupancyMaxActiveBlocksPerMultiprocessor(&per_cu, (const void*)MAIN_KERNEL, NTHREADS, LDS_BYTES) != hipSuccess || per_cu < 1) { fprintf(stderr, "kernel_launch: occupancy query says %d blocks per CU\n", per_cu); grid = -1; (void)hipGetLastError(); return; }
        grid = cus;
    }
    if (grid < 0) return;
    if (hipMemsetAsync((char*)d_ws + WS_CTL, 0, CTL_BYTES, stream) != hipSuccess) return;
    Args a{};
    for (int i = 0; i < 30; ++i) a.in[i] = (const float*)d_in[i];
    a.out = (float*)d_out; a.ws = (unsigned char*)d_ws;
#if defined(DBG_PROBE)
    { unsigned* flags = (unsigned*)((char*)d_ws + WS_CTL + 32768);
      hipLaunchKernelGGL(k_probe_mx, dim3(1), dim3(64), 0, stream, flags + 100);
      hipLaunchKernelGGL(k_dbg_out2, dim3(NBATCH * SEQ / 4), dim3(256), 0, stream, (const float*)d_in[0], (const float*)d_in[29], (float*)d_out, flags + 100); }
#elif MK_N_LAUNCHES == 1 && defined(DBG_CHECK)
    {
        unsigned* flags = (unsigned*)((char*)d_ws + WS_CTL + 32768); char* W = (char*)d_ws;
        a.ph_lo = 0; a.ph_hi = (DBG_CHECK == 8) ? 3 : (DBG_CHECK >= 5) ? 7 : (DBG_CHECK == 1 ? 11 : (DBG_CHECK == 2 ? 12 : 13));
        hipLaunchKernelGGL(mk_fwd, dim3(grid), dim3(NTHREADS), LDS_BYTES, stream, a);
#if DBG_CHECK == 8
        hipLaunchKernelGGL(k_check_gemm8, dim3(32), dim3(256), 0, stream, (const unsigned char*)(W + WS_HB), (const float*)d_in[I_WIN], DM, IN_COLS, (const bf16_t*)(W + WS_P), NP, TT, flags + 100);
#elif DBG_CHECK == 5 || DBG_CHECK == 6
        hipLaunchKernelGGL(k_check_attn, dim3(16 * 24), dim3(256), 0, stream, (const unsigned char*)d_ws, DBG_CHECK == 5 ? 1 : 0, flags + 100);
#elif DBG_CHECK == 7
        { float* obuf = (float*)(W + WS_MQ);
          hipLaunchKernelGGL(k_check_gla_rec, dim3(8), dim3(256), 0, stream, (const unsigned char*)d_ws, (const float*)d_in[I_WA2F], (const float*)d_in[I_BAF], (const float*)d_in[I_WA2B], (const float*)d_in[I_BAB], obuf, 0);
          hipLaunchKernelGGL(k_check_gla_cmp, dim3(RPB * 4), dim3(256), 0, stream, (const unsigned char*)d_ws, (const float*)obuf, (const float*)d_in[I_ONG], 0, flags + 100); }
#elif DBG_CHECK == 1
        hipLaunchKernelGGL(k_check_gemm, dim3(32), dim3(256), 0, stream, (const bf16_t*)(W + WS_HB), DM, (const float*)d_in[I_PWQ], DM, DM, (const bf16_t*)(W + WS_PQ), DM, TT, flags + 100);
#elif DBG_CHECK == 2
        hipLaunchKernelGGL(k_check_select, dim3(256 * 8), dim3(64), 0, stream, (const bf16_t*)(W + WS_PQ), (const float*)d_in[I_PK1], (const float*)d_in[I_PK2], (const int*)(W + WS_PIDX), (const float*)(W + WS_PG), flags + 100);
#else
        hipLaunchKernelGGL(k_check_gather, dim3(128), dim3(64), 0, stream, (const bf16_t*)(W + WS_HB), (const float*)d_in[I_PU], (const float*)d_in[I_PV], (const int*)(W + WS_PIDX), (const float*)(W + WS_PG), (const float*)(W + WS_MQ), flags + 100);
#endif
        hipLaunchKernelGGL(k_dbg_out2, dim3(NBATCH * SEQ / 4), dim3(256), 0, stream, (const float*)d_in[0], (const float*)d_in[29], (float*)d_out, flags + 100);
    }
#elif MK_N_LAUNCHES == 1
#ifdef DBG_SPLIT
    for (int p = 0; p < N_PHASES; p += DBG_SPLIT) { a.ph_lo = p; a.ph_hi = p + DBG_SPLIT < N_PHASES ? p + DBG_SPLIT : N_PHASES; hipLaunchKernelGGL(mk_fwd, dim3(grid), dim3(NTHREADS), LDS_BYTES, stream, a); }
#else
    a.ph_lo = 0; a.ph_hi = N_PHASES;
    hipLaunchKernelGGL(mk_fwd, dim3(grid), dim3(NTHREADS), LDS_BYTES, stream, a);
#endif
#else
    a.ph_hi = 0;
#ifndef DBG_NLAUNCH
#define DBG_NLAUNCH 100
#endif
    int nl_ = 0;
#ifdef DBG_HYB
#define LAUNCH1(K, L) do { if (K == DBG_HYB) { a.ph_lo = 12 * (L) + (K); a.ph_hi = a.ph_lo + 1; hipLaunchKernelGGL(mk_fwd, dim3(grid), dim3(NTHREADS), LDS_BYTES, stream, a); a.ph_hi = 0; } else { a.ph_lo = (L); hipLaunchKernelGGL(k_one<K>, dim3(grid), dim3(NTHREADS), LDS_BYTES, stream, a); } } while (0)
#else
#define LAUNCH1(K, L) do { a.ph_lo = (L); if (nl_++ < DBG_NLAUNCH) { hipLaunchKernelGGL(k_one<K>, dim3(grid), dim3(NTHREADS), LDS_BYTES, stream, a); if (K == DBG_DUP) hipLaunchKernelGGL(k_one<K>, dim3(grid), dim3(NTHREADS), LDS_BYTES, stream, a); } } while (0)
#endif
#ifdef DBG_SCAN
    unsigned* flags = (unsigned*)((char*)d_ws + WS_CTL + 32768);
    char* W = (char*)d_ws;
#define S16(off, n, st) hipLaunchKernelGGL(k_scan16, dim3(1024), dim3(256), 0, stream, (const bf16_t*)(W + (off)), (size_t)(n), flags, st)
#define S32(off, n, st) hipLaunchKernelGGL(k_scan32, dim3(1024), dim3(256), 0, stream, (const float*)(W + (off)), (size_t)(n), flags, st)
    LAUNCH1(0, 0); S32(WS_MODV, 2 * 3 * 12288, 1);
    { const int l = 0;
      LAUNCH1(1, l); S16(WS_HB, (size_t)TT * DM, 2);
      LAUNCH1(2, l); S16(WS_P, (size_t)TT * NP, 3);
      LAUNCH1(3, l); S16(WS_P, (size_t)TT * NP, 4);
      LAUNCH1(4, l); S16(WS_MQ, (size_t)TT * 1536, 5); S16(WS_MKV, (size_t)TT * 2048, 5); S16(WS_GST, (size_t)2112 * 32768, 6); S32(WS_GDEC, (size_t)2112 * 128, 6);
      LAUNCH1(5, l); S16(WS_GST, (size_t)2112 * 32768, 7);
      LAUNCH1(6, l); S16(WS_OA, (size_t)TT * 1024, 8); S16(WS_OM, (size_t)TT * 1024, 9); S16(WS_OL, (size_t)TT * 1024, 10);
      LAUNCH1(7, l); S16(WS_Y, (size_t)TT * DM, 11);
      LAUNCH1(8, l); S32(WS_XS, (size_t)TT * DM, 12);
      LAUNCH1(9, l); S16(WS_HB, (size_t)TT * DM, 13);
      LAUNCH1(10, l); S16(WS_PQ, (size_t)TT * DM, 14);
      LAUNCH1(11, l); S32(WS_PG, (size_t)TT * 128, 15);
      LAUNCH1(12, l); S32(WS_XS, (size_t)TT * DM, 16);
    }
    hipLaunchKernelGGL(k_dbg_out, dim3(NBATCH * SEQ / 4), dim3(256), 0, stream, (const float*)d_in[0], (const float*)d_in[29], (float*)d_out, flags, 16);
#elif defined(DBG_CHECK)
    unsigned* flags = (unsigned*)((char*)d_ws + WS_CTL + 32768);
    char* W = (char*)d_ws;
    LAUNCH1(0, 0);
    { const int l = 0; LAUNCH1(1, l); LAUNCH1(2, l); LAUNCH1(3, l); LAUNCH1(4, l); LAUNCH1(5, l); LAUNCH1(6, l);
#if DBG_CHECK == 5 || DBG_CHECK == 6
      hipLaunchKernelGGL(k_check_attn, dim3(16 * 24), dim3(256), 0, stream, (const unsigned char*)d_ws, DBG_CHECK == 5 ? 1 : 0, flags + 100);
#endif
#if DBG_CHECK == 7
      { float* obuf = (float*)(W + WS_MQ);
        hipLaunchKernelGGL(k_check_gla_rec, dim3(8), dim3(256), 0, stream, (const unsigned char*)d_ws, (const float*)d_in[I_WA2F], (const float*)d_in[I_BAF], (const float*)d_in[I_WA2B], (const float*)d_in[I_BAB], obuf, 0);
        hipLaunchKernelGGL(k_check_gla_cmp, dim3(RPB * 4), dim3(256), 0, stream, (const unsigned char*)d_ws, (const float*)obuf, (const float*)d_in[I_ONG], 0, flags + 100); }
#endif
      LAUNCH1(7, l); LAUNCH1(8, l); LAUNCH1(9, l); LAUNCH1(10, l);
#if DBG_CHECK == 1
      hipLaunchKernelGGL(k_check_gemm, dim3(32), dim3(256), 0, stream, (const bf16_t*)(W + WS_HB), DM, (const float*)d_in[I_PWQ], DM, DM, (const bf16_t*)(W + WS_PQ), DM, TT, flags + 100);
#endif
      LAUNCH1(11, l);
#if DBG_CHECK == 2
      hipLaunchKernelGGL(k_check_select, dim3(256 * 8), dim3(64), 0, stream, (const bf16_t*)(W + WS_PQ), (const float*)d_in[I_PK1], (const float*)d_in[I_PK2], (const int*)(W + WS_PIDX), (const float*)(W + WS_PG), flags + 100);
#endif
      LAUNCH1(12, l);
#if DBG_CHECK == 3
      hipLaunchKernelGGL(k_check_gather, dim3(128), dim3(64), 0, stream, (const bf16_t*)(W + WS_HB), (const float*)d_in[I_PU], (const float*)d_in[I_PV], (const int*)(W + WS_PIDX), (const float*)(W + WS_PG), (const float*)(W + WS_MQ), flags + 100);
#endif
    }
    hipLaunchKernelGGL(k_dbg_out2, dim3(NBATCH * SEQ / 4), dim3(256), 0, stream, (const float*)d_in[0], (const float*)d_in[29], (float*)d_out, flags + 100);
#else
    LAUNCH1(0, 0);
    for (int l = 0; l < DEPTH; ++l) { LAUNCH1(1, l); LAUNCH1(2, l); LAUNCH1(3, l);
#ifdef DBG_DUP23
        LAUNCH1(2, l); LAUNCH1(3, l);
#endif
        LAUNCH1(4, l); LAUNCH1(5, l);
#ifdef DBG_DUP45
        LAUNCH1(4, l); LAUNCH1(5, l);
#endif
        LAUNCH1(6, l); LAUNCH1(7, l); LAUNCH1(8, l); LAUNCH1(9, l); LAUNCH1(10, l); LAUNCH1(11, l); LAUNCH1(12, l); }
    LAUNCH1(13, DEPTH - 1);
#endif
#undef LAUNCH1
#endif
    const hipError_t le = hipPeekAtLastError();
    if (le != hipSuccess) fprintf(stderr, "kernel_launch: launch failed: %s\n", hipGetErrorName(le));
}
```

```cpp
#include <hip/hip_runtime.h>
#include <cstdio>
#include <cstdint>

#ifndef MK_N_LAUNCHES
#ifndef DBG_DUP
#define DBG_DUP -1
#endif
#define MK_N_LAUNCHES 1
#endif

#ifndef DBG_MIX0
#define DBG_MIX0 1.0f
#define DBG_MIX1 1.0f
#define DBG_PEER0 1.0f
#define DBG_PEER1 1.0f
#endif
#ifndef MLA_NQR
#define MLA_NQR 4
#endif
#define LAS __attribute__((address_space(3)))
#define GLB __attribute__((address_space(1)))
typedef unsigned short bf16_t;
typedef short bf16x8 __attribute__((ext_vector_type(8)));
typedef short s16x4 __attribute__((ext_vector_type(4)));
typedef float f32x4 __attribute__((ext_vector_type(4)));
typedef float f32x2 __attribute__((ext_vector_type(2)));
typedef float f32x16 __attribute__((ext_vector_type(16)));
typedef unsigned u32x4 __attribute__((ext_vector_type(4)));
typedef unsigned u32x2 __attribute__((ext_vector_type(2)));
typedef __bf16 bf2_t __attribute__((ext_vector_type(2)));

constexpr int DM = 2048, NBATCH = 2, SEQ = 8192, CTXL = 256, DEPTH = 2;
constexpr int RPB = SEQ + CTXL;
constexpr int TT = NBATCH * RPB;
constexpr int IN_COLS = 11872, NP = 12032;
constexpr int C_AQ = 0, C_AK = 1024, C_AV = 1280, C_LQ = 1536, C_LK = 2048, C_LV = 2560, C_LG = 3584, C_LRF = 4608, C_LRB = 4624,
              C_MCQ = 4640, C_MCKV = 5152, C_MKR = 5664, C_GA = 5728, C_GL = 7776, C_GM = 9824;
constexpr int NCH = RPB / 64;
constexpr int NEXP = 16384;
constexpr float NORM_EPS = 1e-6f;
constexpr int NTHREADS = 512;

constexpr size_t al256(size_t x) { return (x + 255) / 256 * 256; }
constexpr size_t WS_CTL   = 0;
constexpr size_t CTL_BYTES = 65536;
constexpr size_t WS_MODV  = WS_CTL + CTL_BYTES;
constexpr size_t WS_TABA  = al256(WS_MODV + (size_t)2 * 3 * 12288 * 4);
constexpr size_t WS_TABM  = WS_TABA + 2 * 128 * 32 * 4;
constexpr size_t WS_XS    = al256(WS_TABM + 2 * 128 * 16 * 4);
constexpr size_t WS_HB    = WS_XS + (size_t)TT * DM * 4;
constexpr size_t WS_P     = WS_HB + (size_t)TT * DM * 2;
constexpr size_t WS_MQ    = WS_P + (size_t)TT * NP * 2;
constexpr size_t WS_MKV   = WS_MQ + (size_t)TT * 1536 * 2;
constexpr size_t WS_OA    = WS_MKV + (size_t)TT * 2048 * 2;
constexpr size_t WS_OL    = WS_OA + (size_t)TT * 1024 * 2;
constexpr size_t WS_OM    = WS_OL + (size_t)TT * 1024 * 2;
constexpr size_t WS_WIN   = WS_OM + (size_t)TT * 1024 * 2;
constexpr size_t WS_WUQ   = WS_WIN + (size_t)NP * 2048 * 2;
constexpr size_t WS_WUKV  = WS_WUQ + (size_t)1536 * 512 * 2;
constexpr size_t WS_WBR   = WS_WUKV + (size_t)2048 * 512 * 2;
constexpr size_t WS_WOUT  = WS_WBR + (size_t)3 * 2048 * 1024 * 2;
constexpr size_t WS_WQ    = WS_WOUT + (size_t)2048 * 2048 * 2;
constexpr size_t WS_K1    = WS_WQ + (size_t)2048 * 2048 * 2;
constexpr size_t WS_K2    = WS_K1 + (size_t)8 * 128 * 128 * 2;
constexpr size_t WS_GST   = WS_K2 + (size_t)8 * 128 * 128 * 2;
constexpr size_t WS_GDEC  = WS_GST + (size_t)NBATCH * 2 * 4 * NCH * 32768 * 2;
constexpr size_t WS_END0  = WS_GDEC + (size_t)NBATCH * 2 * 4 * NCH * 128 * 4;
constexpr size_t WS_KN8   = WS_OA + (size_t)TT * 1024;
constexpr size_t WS_AK8   = WS_OL + (size_t)TT * 1024;
constexpr size_t WS_KR8   = WS_AK8 + (size_t)TT * 256;
constexpr size_t WS_VT8A  = WS_KR8 + (size_t)TT * 64;
constexpr size_t WS_VT8M  = WS_OM + (size_t)TT * 1024;
constexpr size_t WS_Y     = WS_MKV;
constexpr size_t WS_PQ    = WS_OA;
constexpr size_t WS_PIDX  = WS_P;
constexpr size_t WS_PG    = WS_PIDX + (size_t)TT * 128 * 4;
constexpr size_t PT_BYTES = 2 * (size_t)NEXP * DM + 2 * (size_t)NEXP * 4;
constexpr size_t WS_WINS  = WS_END0;
constexpr size_t WS_WOUTS = al256(WS_WINS + (size_t)NP * 4);
constexpr size_t WS_WBRS  = al256(WS_WOUTS + (size_t)DM * 4);
constexpr size_t WS_PT    = al256(WS_WBRS + (size_t)3 * DM * 4);
constexpr size_t WS_END   = WS_PT + DEPTH * PT_BYTES;
constexpr size_t PT_U8 = 0, PT_V8 = (size_t)NEXP * DM, PT_SCU = 2 * (size_t)NEXP * DM, PT_SCV = PT_SCU + (size_t)NEXP * 4;
static_assert(WS_PG + (size_t)TT * 128 * 4 <= WS_MQ, "PEER alias region overflows P");

__device__ __forceinline__ unsigned cvt_pk_bf16(float lo, float hi) { bf2_t v; v.x = (__bf16)lo; v.y = (__bf16)hi; return __builtin_bit_cast(unsigned, v); }
__device__ __forceinline__ bf16_t f2bf(float f) { return (bf16_t)(cvt_pk_bf16(f, 0.f) & 0xffffu); }
__device__ __forceinline__ float bf2f(bf16_t b) { return __uint_as_float(((unsigned)b) << 16); }
__device__ __forceinline__ float bflo(unsigned w) { return __uint_as_float(w << 16); }
__device__ __forceinline__ float bfhi(unsigned w) { return __uint_as_float(w & 0xffff0000u); }
__device__ __forceinline__ float xchg32(float x, int lane) { auto r = __builtin_amdgcn_permlane32_swap(__float_as_uint(x), __float_as_uint(x), false, false); return __uint_as_float(lane < 32 ? r[1] : r[0]); }
__device__ __forceinline__ float xchg16(float x, int lane) { auto r = __builtin_amdgcn_permlane16_swap(__float_as_uint(x), __float_as_uint(x), false, false); return __uint_as_float((lane & 16) ? r[0] : r[1]); }
template <int CTRL> __device__ __forceinline__ float dppmov(float x) { return __uint_as_float(__builtin_amdgcn_update_dpp(0u, __float_as_uint(x), CTRL, 0xF, 0xF, false)); }
constexpr int DPP_ROR8 = 0x128, DPP_HMIRROR = 0x141, DPP_Q3210 = 0x1B, DPP_Q1032 = 0xB1;
__device__ __forceinline__ float wave_sum(float v) {
    const int lane = threadIdx.x & 63;
    v += xchg32(v, lane); v += xchg16(v, lane); v += dppmov<DPP_ROR8>(v); v += dppmov<DPP_HMIRROR>(v); v += dppmov<DPP_Q3210>(v); v += dppmov<DPP_Q1032>(v);
    return v;
}
__device__ __forceinline__ float sigmoidf_(float x) { return __builtin_amdgcn_rcpf(1.0f + __expf(-x)); }
__device__ __forceinline__ float siluf_(float x) { return x * __builtin_amdgcn_rcpf(1.0f + __expf(-x)); }

#define XB_TMO      128
#define XB_XCNT(j)  (256  + 64 * (j))
#define XB_XSUB(j)  (1280 + 64 * (j))
#define XB_XGEN(j)  (2304 + 64 * (j))
#define XB_TOP      3328
#define XB_TOPGEN   3392
#define XCD_BAR_WORDS 3456
#define XB_SPIN_CAP (1u << 20)
__device__ __forceinline__ unsigned xb_ld(unsigned* p)              { return __hip_atomic_load(p, __ATOMIC_RELAXED, __HIP_MEMORY_SCOPE_AGENT); }
__device__ __forceinline__ unsigned xb_add(unsigned* p, unsigned v) { return __hip_atomic_fetch_add(p, v, __ATOMIC_RELAXED, __HIP_MEMORY_SCOPE_AGENT); }
__device__ __forceinline__ unsigned xb_xcc_id() { return (unsigned)__builtin_amdgcn_s_getreg((3 << 11) | 20) & 0xFu; }
#define XB_SPIN(cond, bar) do { unsigned _sp = 0; while (cond) { __builtin_amdgcn_s_sleep(1); \
    if ((++_sp & 255u) == 0u) { if (xb_ld(&(bar)[XB_TMO])) break; if (_sp > XB_SPIN_CAP) { atomicAdd(&(bar)[XB_TMO], 1u); break; } } } } while (0)
struct XcdBarrier { unsigned* bar; unsigned x; volatile LAS unsigned* st; };
__device__ __forceinline__ XcdBarrier xcd_barrier_post(unsigned* bar, volatile LAS unsigned* st) {
    XcdBarrier b; b.bar = bar; b.x = xb_xcc_id(); b.st = st;
    if (threadIdx.x == 0) (void)xb_add(&bar[XB_XCNT(b.x)], 1u);
    return b;
}
__device__ __forceinline__ void xcd_barrier_complete(unsigned* bar, unsigned x, unsigned& nloc, unsigned& nx) {
    const unsigned G = gridDim.x * gridDim.y * gridDim.z;
    unsigned sum, cnt, mine, sp = 0u;
    for (;;) {
        sum = 0u; cnt = 0u; mine = 0u;
#pragma unroll
        for (unsigned j = 0; j < 16; ++j) { const unsigned c = xb_ld(&bar[XB_XCNT(j)]); sum += c; cnt += (c > 0u) ? 1u : 0u; mine = (j == x) ? c : mine; }
        if (sum == G) break;
        __builtin_amdgcn_s_sleep(1);
        if ((++sp & 255u) == 0u) { if (xb_ld(&bar[XB_TMO])) break; if (sp > XB_SPIN_CAP) { atomicAdd(&bar[XB_TMO], 1u); break; } }
    }
    nloc = mine > 0u ? mine : 1u; nx = cnt > 0u ? cnt : 1u;
}
__device__ __forceinline__ void xcd_barrier(const XcdBarrier& b) {
    asm volatile("s_waitcnt vmcnt(0)" ::: "memory");
    __syncthreads();
    if (threadIdx.x == 0) {
        unsigned* bar = b.bar;
        __builtin_amdgcn_s_waitcnt(0);
        unsigned nloc = b.st[0], nx = b.st[1];
        if (nloc == 0u) { xcd_barrier_complete(bar, b.x, nloc, nx); b.st[0] = nloc; b.st[1] = nx; }
        const unsigned old = xb_add(&bar[XB_XSUB(b.x)], 1u);
        const unsigned gen = old / nloc;
        if (old + 1u == (gen + 1u) * nloc) {
            __builtin_amdgcn_fence(__ATOMIC_RELEASE, "agent");
            asm volatile("s_waitcnt vmcnt(0)" ::: "memory");
            const unsigned og = xb_add(&bar[XB_TOP], 1u);
            const unsigned tg = og / nx;
            if (og + 1u == (tg + 1u) * nx) xb_add(&bar[XB_TOPGEN], 1u);
            else XB_SPIN(xb_ld(&bar[XB_TOPGEN]) == tg, bar);
            __builtin_amdgcn_fence(__ATOMIC_ACQUIRE, "agent");
            xb_add(&bar[XB_XGEN(b.x)], 1u);
            asm volatile("s_waitcnt vmcnt(0)" ::: "memory");
        } else {
            XB_SPIN(xb_ld(&bar[XB_XGEN(b.x)]) == gen, bar);
            __builtin_amdgcn_fence(__ATOMIC_ACQUIRE, "agent");
            asm volatile("s_waitcnt vmcnt(0)" ::: "memory");
        }
    }
    __syncthreads();
}

namespace pg8 {
constexpr int BM = 256, BK = 64, HALF = 128, HTB = HALF * BK * 2, STAGE_BYTES = 8 * HTB, NXCD = 8, WGM = 8;
__host__ __device__ __forceinline__ int lds_byte(int r, int c) { const int st = (r >> 4) * 2 + (c >> 5), rr = r & 15, cc = c & 31, ob = rr * 64 + cc * 2; return st * 1024 + (ob ^ (((ob >> 9) & 1) << 5)); }
__host__ __device__ __forceinline__ void stage_rc(int b, int& R, int& C) { const int st = b / 1024, sb = b % 1024, swz = sb ^ (((sb >> 9) & 1) << 5); R = (st >> 1) * 16 + swz / 64; C = (st & 1) * 32 + (swz % 64) / 2; }
__host__ __device__ __forceinline__ int perm32(int rho) { const int n = rho >> 4, i = rho & 15; return 8 * (i >> 2) + 4 * n + (i & 3); }
struct Unit { int pm, pn; };
struct Gemm { const bf16_t* A; const bf16_t* Bt; int M, N, K, lda, ldb; };
struct StaticOrder {
    int nM, nN, nwg, G, c, latent;
    __host__ __device__ void init(int M, int N, int G_, int c_, int latent_ = 0) { latent = latent_; nM = latent_ ? 64 : M / BM; nN = N / BM; nwg = nM * nN; G = G_; c = c_; }
    __host__ __device__ bool next(int i, Unit& u) const {
        const long L = (long)i * G + c; if (L >= nwg) return false;
        int wgid = (int)L; { const int q = nwg / NXCD, r = nwg % NXCD, xcd = wgid % NXCD, off = wgid / NXCD; wgid = (xcd < r ? xcd * (q + 1) : r * (q + 1) + (xcd - r) * q) + off; }
        const int nig = WGM * nN, gid = wgid / nig, fm = gid * WGM, gsz = (nM - fm) < WGM ? (nM - fm) : WGM;
        u.pm = fm + ((wgid % nig) % gsz); u.pn = (wgid % nig) / gsz; if (latent) u.pm += 1 + (u.pm >= 32 ? 1 : 0); return true;
    }
};
struct WinOrder {
    StaticOrder S; int full, nlat, G, c;
    __host__ __device__ void init(int G_, int c_, int full_) { full = full_; G = G_; c = c_; S.init(TT, NP, G_, c_, full_ ? 0 : 1); nlat = S.nwg; }
    __host__ __device__ bool next(int i, Unit& u) const {
        if (full) return S.next(i, u);
        const long L = (long)i * G + c;
        if (L < nlat) return S.next(i, u);
        const int q = (int)(L - nlat); if (q >= 24) return false;
        const int t = q % 12; u.pm = q < 12 ? 0 : 33;
        u.pn = t < 2 ? 4 + t : (t < 8 ? 8 + (t - 2) : (t == 8 ? 18 : 20 + (t - 9)));
        return true;
    }
};
struct EpiStoreBf16 {
    static constexpr bool PERM = true;
    bf16_t* O; int ldc;
    __device__ __forceinline__ void operator()(const f32x4 (&acc)[2][2][4][2], const Unit& u, int wr, int wc, int fr, int fq) const {
        const int row0 = u.pm * BM + wr * 64 + fr, col0 = u.pn * BM + wc * 32 + 8 * fq;
#pragma unroll
        for (int ai = 0; ai < 2; ++ai)
#pragma unroll
            for (int m = 0; m < 4; ++m) { bf16_t* rowp = O + (size_t)(row0 + ai * HALF + m * 16) * ldc + col0;
#pragma unroll
                for (int bj = 0; bj < 2; ++bj) { const f32x4 v0 = acc[ai][bj][m][0], v1 = acc[ai][bj][m][1];
                    u32x4 w; w.x = cvt_pk_bf16(v0[0], v0[1]); w.y = cvt_pk_bf16(v0[2], v0[3]); w.z = cvt_pk_bf16(v1[0], v1[1]); w.w = cvt_pk_bf16(v1[2], v1[3]);
                    *(u32x4*)(rowp + bj * HALF) = w; } }
    }
};
struct EpiNull {
    static constexpr bool PERM = true;
    __device__ __forceinline__ void operator()(const f32x4 (&acc)[2][2][4][2], const Unit&, int, int, int, int) const {
#pragma unroll
        for (int a = 0; a < 2; ++a)
#pragma unroll
            for (int b = 0; b < 2; ++b)
#pragma unroll
                for (int m = 0; m < 4; ++m)
#pragma unroll
                    for (int n = 0; n < 2; ++n) asm volatile("" :: "v"(acc[a][b][m][n]));
    }
};
struct EpiStoreMKV {
    static constexpr bool PERM = true;
    bf16_t* O; unsigned char* K8;
    __device__ __forceinline__ void operator()(const f32x4 (&acc)[2][2][4][2], const Unit& u, int wr, int wc, int fr, int fq) const {
        const int row0 = u.pm * BM + wr * 64 + fr, col0 = u.pn * BM + wc * 32 + 8 * fq;
#pragma unroll
        for (int ai = 0; ai < 2; ++ai)
#pragma unroll
            for (int m = 0; m < 4; ++m) { const size_t r = (size_t)(row0 + ai * HALF + m * 16); bf16_t* rowp = O + r * 2048 + col0;
#pragma unroll
                for (int bj = 0; bj < 2; ++bj) { const f32x4 v0 = acc[ai][bj][m][0], v1 = acc[ai][bj][m][1];
                    u32x4 w; w.x = cvt_pk_bf16(v0[0], v0[1]); w.y = cvt_pk_bf16(v0[2], v0[3]); w.z = cvt_pk_bf16(v1[0], v1[1]); w.w = cvt_pk_bf16(v1[2], v1[3]);
                    *(u32x4*)(rowp + bj * HALF) = w;
                    if (bj == 0) { int p0 = __builtin_amdgcn_cvt_pk_fp8_f32(v0[0], v0[1], 0, false); p0 = __builtin_amdgcn_cvt_pk_fp8_f32(v0[2], v0[3], p0, true);
                        int p1 = __builtin_amdgcn_cvt_pk_fp8_f32(v1[0], v1[1], 0, false); p1 = __builtin_amdgcn_cvt_pk_fp8_f32(v1[2], v1[3], p1, true);
                        u32x2 w8; w8.x = (unsigned)p0; w8.y = (unsigned)p1; *(u32x2*)(K8 + r * 1024 + u.pn * 128 + wc * 32 + 8 * fq) = w8; } } }
    }
};
struct EpiStoreBf16S {
    static constexpr bool PERM = true;
    bf16_t* O; int ldc; const float* cs;
    __device__ __forceinline__ void operator()(const f32x4 (&acc)[2][2][4][2], const Unit& u, int wr, int wc, int fr, int fq) const {
        const int row0 = u.pm * BM + wr * 64 + fr, col0 = u.pn * BM + wc * 32 + 8 * fq;
        f32x4 sv[2][2];
#pragma unroll
        for (int bj = 0; bj < 2; ++bj)
#pragma unroll
            for (int n = 0; n < 2; ++n) sv[bj][n] = *(const f32x4*)(cs + col0 + bj * HALF + 4 * n);
#pragma unroll
        for (int ai = 0; ai < 2; ++ai)
#pragma unroll
            for (int m = 0; m < 4; ++m) { bf16_t* rowp = O + (size_t)(row0 + ai * HALF + m * 16) * ldc + col0;
#pragma unroll
                for (int bj = 0; bj < 2; ++bj) { const f32x4 v0 = acc[ai][bj][m][0] * sv[bj][0], v1 = acc[ai][bj][m][1] * sv[bj][1];
                    u32x4 w; w.x = cvt_pk_bf16(v0[0], v0[1]); w.y = cvt_pk_bf16(v0[2], v0[3]); w.z = cvt_pk_bf16(v1[0], v1[1]); w.w = cvt_pk_bf16(v1[2], v1[3]);
                    *(u32x4*)(rowp + bj * HALF) = w; } }
    }
};
template <bool FIRST, bool F8OUT = false> struct EpiGate {
    static constexpr bool PERM = true;
    bf16_t* Y; const bf16_t* Gt; unsigned char* Y8; const float* cs;
    __device__ __forceinline__ void operator()(const f32x4 (&acc)[2][2][4][2], const Unit& u, int wr, int wc, int fr, int fq) const {
        constexpr int ldy = DM, ldg = NP, ldy8 = DM;
        const int row0 = u.pm * BM + wr * 64 + fr, col0 = u.pn * BM + wc * 32 + 8 * fq;
        f32x4 sv[2][2];
#pragma unroll
        for (int bj = 0; bj < 2; ++bj)
#pragma unroll
            for (int n = 0; n < 2; ++n) sv[bj][n] = *(const f32x4*)(cs + col0 + bj * HALF + 4 * n);
#pragma unroll
        for (int ai = 0; ai < 2; ++ai)
#pragma unroll
        for (int mh = 0; mh < 2; ++mh) {
            u32x4 g[2][2], y[2][2];
#pragma unroll
            for (int mm = 0; mm < 2; ++mm)
#pragma unroll
                for (int bj = 0; bj < 2; ++bj) { const size_t r = (size_t)(row0 + ai * HALF + (mh * 2 + mm) * 16);
                    g[mm][bj] = *(const u32x4*)(Gt + r * ldg + col0 + bj * HALF);
                    if (!FIRST) y[mm][bj] = *(const u32x4*)(Y + r * ldy + col0 + bj * HALF); }
#pragma unroll
            for (int mm = 0; mm < 2; ++mm)
#pragma unroll
                for (int bj = 0; bj < 2; ++bj) { const int m = mh * 2 + mm; const size_t r = (size_t)(row0 + ai * HALF + m * 16); const f32x4 v0 = acc[ai][bj][m][0] * sv[bj][0], v1 = acc[ai][bj][m][1] * sv[bj][1]; const u32x4 gg = g[mm][bj];
                    float o[8];
                    o[0] = sigmoidf_(bflo(gg.x)) * v0[0]; o[1] = sigmoidf_(bfhi(gg.x)) * v0[1]; o[2] = sigmoidf_(bflo(gg.y)) * v0[2]; o[3] = sigmoidf_(bfhi(gg.y)) * v0[3];
                    o[4] = sigmoidf_(bflo(gg.z)) * v1[0]; o[5] = sigmoidf_(bfhi(gg.z)) * v1[1]; o[6] = sigmoidf_(bflo(gg.w)) * v1[2]; o[7] = sigmoidf_(bfhi(gg.w)) * v1[3];
                    if (!FIRST) { const u32x4 yy = y[mm][bj];
                        o[0] += bflo(yy.x); o[1] += bfhi(yy.x); o[2] += bflo(yy.y); o[3] += bfhi(yy.y); o[4] += bflo(yy.z); o[5] += bfhi(yy.z); o[6] += bflo(yy.w); o[7] += bfhi(yy.w); }
                    if constexpr (F8OUT) { int p0 = __builtin_amdgcn_cvt_pk_fp8_f32(o[0], o[1], 0, false); p0 = __builtin_amdgcn_cvt_pk_fp8_f32(o[2], o[3], p0, true);
                        int p1 = __builtin_amdgcn_cvt_pk_fp8_f32(o[4], o[5], 0, false); p1 = __builtin_amdgcn_cvt_pk_fp8_f32(o[6], o[7], p1, true);
                        u32x2 w8; w8.x = (unsigned)p0; w8.y = (unsigned)p1; *(u32x2*)(Y8 + r * ldy8 + col0 + bj * HALF) = w8; }
                    else { u32x4 w; w.x = cvt_pk_bf16(o[0], o[1]); w.y = cvt_pk_bf16(o[2], o[3]); w.z = cvt_pk_bf16(o[4], o[5]); w.w = cvt_pk_bf16(o[6], o[7]);
                        *(u32x4*)(Y + r * ldy + col0 + bj * HALF) = w; } }
        }
    }
};
template <bool CS> struct EpiResidT {
    static constexpr bool PERM = false;
    float* X; int ldx; const float* gate; const float* cs;
    __device__ __forceinline__ void operator()(const f32x4 (&acc)[2][2][4][2], const Unit& u, int wr, int wc, int fr, int fq) const {
        const int row0 = u.pm * BM + wr * 64 + fr, col0 = u.pn * BM + wc * 32 + 4 * fq;
        const int sel = (u.pm % 33 == 0) ? 2 : (u.pm / 33);
        const float* gp = gate + (size_t)sel * 12288 + col0;
        f32x4 gv[2][2];
#pragma unroll
        for (int bj = 0; bj < 2; ++bj)
#pragma unroll
            for (int n = 0; n < 2; ++n) { gv[bj][n] = *(const f32x4*)(gp + bj * HALF + n * 16); if constexpr (CS) gv[bj][n] = gv[bj][n] * *(const f32x4*)(cs + col0 + bj * HALF + n * 16); }
#pragma unroll
        for (int ai = 0; ai < 2; ++ai)
#pragma unroll
            for (int mh = 0; mh < 2; ++mh) {
                f32x4 x[2][2][2];
#pragma unroll
                for (int mm = 0; mm < 2; ++mm)
#pragma unroll
                    for (int bj = 0; bj < 2; ++bj)
#pragma unroll
                        for (int n = 0; n < 2; ++n) x[mm][bj][n] = *(const f32x4*)(X + (size_t)(row0 + ai * HALF + (mh * 2 + mm) * 16) * ldx + col0 + bj * HALF + n * 16);
#pragma unroll
                for (int mm = 0; mm < 2; ++mm)
#pragma unroll
                    for (int bj = 0; bj < 2; ++bj)
#pragma unroll
                        for (int n = 0; n < 2; ++n) *(f32x4*)(X + (size_t)(row0 + ai * HALF + (mh * 2 + mm) * 16) * ldx + col0 + bj * HALF + n * 16) = x[mm][bj][n] + gv[bj][n] * acc[ai][bj][mh * 2 + mm][n];
            }
    }
};

typedef int i32x8 __attribute__((ext_vector_type(8)));
typedef int i32x4 __attribute__((ext_vector_type(4)));
__device__ __forceinline__ i32x8 cat8(const bf16x8 lo, const bf16x8 hi) { const i32x4 a = __builtin_bit_cast(i32x4, lo), b = __builtin_bit_cast(i32x4, hi); return __builtin_shufflevector(a, b, 0, 1, 2, 3, 4, 5, 6, 7); }
template <class Epi, class Sched, int F8 = 0>
__device__ __forceinline__ void gemm_phase(LAS unsigned char* lds, const int tid, const Gemm g, const Sched& S, const Epi& E) {
    const int wid = __builtin_amdgcn_readfirstlane(tid >> 6), lane = tid & 63, wr = wid >> 2, wc = wid & 3, fr = lane & 15, fq = lane >> 4;
    const int K = g.K, nt = F8 ? K / 128 : K / BK, lda = g.lda, ldb = g.ldb;
    unsigned voffA[2], voffB[2];
#pragma unroll
    for (int i = 0; i < 2; ++i) { int R, C; stage_rc(tid * 16 + i * 8192, R, C); const int Rb = Epi::PERM ? ((R & ~31) + perm32(R & 31)) : R;
        voffA[i] = F8 ? (unsigned)(R * lda + C * 2) : (unsigned)(R * lda + C) * 2u; voffB[i] = F8 ? (unsigned)(Rb * ldb + C * 2) : (unsigned)(Rb * ldb + C) * 2u; }
    const size_t kstep = (size_t)(BK * 2);
    const size_t hstepA = (size_t)HALF * lda * (F8 ? 1 : 2), hstepB = (size_t)HALF * ldb * (F8 ? 1 : 2);
    const size_t tstepA = 2 * hstepA, tstepB = 2 * hstepB;
    const unsigned ldsw = (unsigned)wid * 1024u;
    const int aoff = F8 ? lds_byte(wr * 64 + fr, (fq & 1) * 16) + (fq >> 1) * 1024 : lds_byte(wr * 64 + fr, fq * 8);
    const int boff = F8 ? lds_byte(wc * 32 + fr, (fq & 1) * 16) + (fq >> 1) * 1024 : lds_byte(wc * 32 + fr, fq * 8);
#define PG8_SA(b, h) (((b) * 2 + (h)) * HTB)
#define PG8_SB(b, h) ((4 + (b) * 2 + (h)) * HTB)
#define PG8_STAGE(bufoff, gbase, voff) do { _Pragma("unroll") for (int _i = 0; _i < 2; ++_i) \
        __builtin_amdgcn_global_load_lds((const unsigned*)((const char*)(gbase) + (voff)[_i]), (LAS unsigned*)(lds + (bufoff) + ldsw + _i * 8192), 16, 0, 0); } while (0)
#define PG8_LDA(dst, b, h) do { if constexpr (F8) { _Pragma("unroll") for (int m = 0; m < 4; ++m) { const LAS unsigned char* p_ = lds + PG8_SA(b, h) + aoff + m * 2048; \
            const i32x4 lo_ = *(const LAS i32x4*)p_, hi_ = *(const LAS i32x4*)(p_ + 16); dst##8[m] = __builtin_shufflevector(lo_, hi_, 0, 1, 2, 3, 4, 5, 6, 7); } } \
        else { _Pragma("unroll") for (int m = 0; m < 4; ++m) _Pragma("unroll") for (int k = 0; k < 2; ++k) dst[m][k] = *(const LAS bf16x8*)(lds + PG8_SA(b, h) + aoff + m * 2048 + k * 1024); } } while (0)
#define PG8_LDB(dst, b, h) do { if constexpr (F8) { _Pragma("unroll") for (int n = 0; n < 2; ++n) { const LAS unsigned char* p_ = lds + PG8_SB(b, h) + boff + n * 2048; \
            const i32x4 lo_ = *(const LAS i32x4*)p_, hi_ = *(const LAS i32x4*)(p_ + 16); dst##8[n] = __builtin_shufflevector(lo_, hi_, 0, 1, 2, 3, 4, 5, 6, 7); } } \
        else { _Pragma("unroll") for (int n = 0; n < 2; ++n) _Pragma("unroll") for (int k = 0; k < 2; ++k) dst[n][k] = *(const LAS bf16x8*)(lds + PG8_SB(b, h) + boff + n * 2048 + k * 1024); } } while (0)
#define PG8_MMA(ai, bj, At, Bt) do { __builtin_amdgcn_s_setprio(1); \
        if constexpr (F8) { _Pragma("unroll") for (int m = 0; m < 4; ++m) _Pragma("unroll") for (int n = 0; n < 2; ++n) \
            asm volatile("v_mfma_scale_f32_16x16x128_f8f6f4 %0, %1, %2, %0, %3, %3 op_sel_hi:[0,0,0]" : "+v"(acc[ai][bj][m][n]) : "v"(Bt##8[n]), "v"(At##8[m]), "v"(mxscale)); } \
        else { _Pragma("unroll") for (int m = 0; m < 4; ++m) _Pragma("unroll") for (int n = 0; n < 2; ++n) _Pragma("unroll") for (int k = 0; k < 2; ++k) \
            acc[ai][bj][m][n] = __builtin_amdgcn_mfma_f32_16x16x32_bf16(Bt[n][k], At[m][k], acc[ai][bj][m][n], 0, 0, 0); } \
        __builtin_amdgcn_s_setprio(0); } while (0)
#define PG8_WAIT_V(n) asm volatile("s_waitcnt vmcnt(" #n ")" ::: "memory")
#define PG8_WAIT_L(n) asm volatile("s_waitcnt lgkmcnt(" #n ")" ::: "memory")
#define PG8_BAR __builtin_amdgcn_s_barrier()
#define PG8_SCHED __builtin_amdgcn_sched_barrier(0)
    Unit cur, nxt; int ui = 0;
    if (!S.next(0, cur)) return;
    f32x4 acc[2][2][4][2];
#pragma unroll
    for (int a = 0; a < 2; ++a)
#pragma unroll
        for (int b = 0; b < 2; ++b)
#pragma unroll
            for (int m = 0; m < 4; ++m)
#pragma unroll
                for (int n = 0; n < 2; ++n) acc[a][b][m][n] = (f32x4){0.f, 0.f, 0.f, 0.f};
    int mxscale = 0x7f7f7f7f; asm volatile("" : "+v"(mxscale));
    bf16x8 At[4][2], B0[2][2], B1[2][2]; i32x8 At8[4], B08[2], B18[2];
    const char* cA = (const char*)g.A + (size_t)cur.pm * tstepA; const char* cB = (const char*)g.Bt + (size_t)cur.pn * tstepB;
    PG8_STAGE(PG8_SB(0, 0), cB, voffB); PG8_STAGE(PG8_SA(0, 0), cA, voffA); PG8_STAGE(PG8_SB(0, 1), cB + hstepB, voffB); PG8_STAGE(PG8_SA(0, 1), cA + hstepA, voffA);
    if (wr == 1) PG8_BAR;
    PG8_WAIT_V(4); PG8_BAR;
    PG8_STAGE(PG8_SB(1, 0), cB + kstep, voffB); PG8_STAGE(PG8_SA(1, 0), cA + kstep, voffA); PG8_STAGE(PG8_SB(1, 1), cB + hstepB + kstep, voffB);
    PG8_WAIT_V(6); PG8_BAR;
    for (;;) {
        const bool has_next = S.next(ui + 1, nxt);
        const char* nA = has_next ? (const char*)g.A + (size_t)nxt.pm * tstepA : cA; const char* nB = has_next ? (const char*)g.Bt + (size_t)nxt.pn * tstepB : cB;
        for (int t = 0; t < nt; t += 2) {
            const bool last = (t == nt - 2);
            const char* a1 = cA + (size_t)(t + 1) * kstep;
            const char* a2 = last ? nA : cA + (size_t)(t + 2) * kstep; const char* b2 = last ? nB : cB + (size_t)(t + 2) * kstep;
            const char* a3 = a2 + kstep; const char* b3 = b2 + kstep;
            PG8_LDB(B0, 0, 0); PG8_SCHED; PG8_LDA(At, 0, 0); PG8_STAGE(PG8_SA(1, 1), a1 + hstepA, voffA);
            PG8_WAIT_L(8); PG8_BAR; PG8_WAIT_L(0); PG8_MMA(0, 0, At, B0); PG8_BAR; PG8_SCHED;
            PG8_LDB(B1, 0, 1); PG8_STAGE(PG8_SB(0, 0), b2, voffB);
            PG8_BAR; PG8_WAIT_L(0); PG8_MMA(0, 1, At, B1); PG8_BAR;
            PG8_LDA(At, 0, 1); PG8_STAGE(PG8_SA(0, 0), a2, voffA);
            PG8_BAR; PG8_WAIT_L(0); PG8_MMA(1, 0, At, B0); PG8_BAR; PG8_SCHED;
            PG8_STAGE(PG8_SB(0, 1), b2 + hstepB, voffB);
            PG8_WAIT_V(6); PG8_BAR; PG8_MMA(1, 1, At, B1); PG8_BAR;
            PG8_LDB(B0, 1, 0); PG8_SCHED; PG8_LDA(At, 1, 0); PG8_STAGE(PG8_SA(0, 1), a2 + hstepA, voffA);
            PG8_WAIT_L(8); PG8_BAR; PG8_WAIT_L(0); PG8_MMA(0, 0, At, B0); PG8_BAR; PG8_SCHED;
            PG8_LDB(B1, 1, 1); PG8_STAGE(PG8_SB(1, 0), b3, voffB);
            PG8_BAR; PG8_WAIT_L(0); PG8_MMA(0, 1, At, B1); PG8_BAR;
            PG8_LDA(At, 1, 1); PG8_STAGE(PG8_SA(1, 0), a3, voffA);
            PG8_BAR; PG8_WAIT_L(0); PG8_MMA(1, 0, At, B0); PG8_BAR; PG8_SCHED;
            PG8_STAGE(PG8_SB(1, 1), b3 + hstepB, voffB);
            PG8_WAIT_V(6); PG8_BAR; PG8_MMA(1, 1, At, B1); PG8_BAR;
        }
        if constexpr (F8) asm volatile("s_nop 15\n\ts_nop 7");
        E(acc, cur, wr, wc, fr, fq);
        if (!has_next) break;
#pragma unroll
        for (int a = 0; a < 2; ++a)
#pragma unroll
            for (int b = 0; b < 2; ++b)
#pragma unroll
                for (int m = 0; m < 4; ++m)
#pragma unroll
                    for (int n = 0; n < 2; ++n) acc[a][b][m][n] = (f32x4){0.f, 0.f, 0.f, 0.f};
        cur = nxt; cA = nA; cB = nB; ++ui;
    }
    PG8_WAIT_V(0);
    if (wr == 0) PG8_BAR;
    PG8_BAR;
#undef PG8_SA
#undef PG8_SB
#undef PG8_STAGE
#undef PG8_LDA
#undef PG8_LDB
#undef PG8_MMA
#undef PG8_WAIT_V
#undef PG8_WAIT_L
#undef PG8_BAR
#undef PG8_SCHED
}
}

struct Args { const float* in[30]; float* out; unsigned char* ws; int ph_lo, ph_hi; };
enum { I_X = 0, I_C, I_CTX, I_CCTX, I_WMOD, I_BMOD, I_N1G, I_WIN, I_QNG, I_KNG, I_WA2F, I_BAF, I_WA2B, I_BAB, I_ONG, I_MQNG, I_WUQ, I_MKVNG, I_WUKV,
       I_WBRA, I_WBRL, I_WBRM, I_WOUT, I_N2G, I_PWQ, I_PK1, I_PK2, I_PU, I_PV, I_FG };
typedef const float* cfp_t;
struct Ctx {
    const __attribute__((address_space(4))) cfp_t* in; float* out; unsigned char* ws; LAS unsigned char* lds;
    int tid, lane, wid, G, bid;
};
#define WSP(T, off) ((T*)(C.ws + (off)))
#define INP(i) ((const float*)(const GLB float*)C.in[(i)])
__device__ __forceinline__ unsigned long long launder_u64(unsigned long long w) {
    unsigned lo = (unsigned)w, hi = (unsigned)(w >> 32); asm volatile("" : "+v"(lo), "+v"(hi));
    lo = __builtin_amdgcn_readfirstlane(lo); hi = __builtin_amdgcn_readfirstlane(hi); return ((unsigned long long)hi << 32) | lo;
}
__device__ __forceinline__ Ctx launder(const Ctx& C0) {
    Ctx R = C0; int t = C0.tid; asm volatile("" : "+v"(t)); R.tid = t; R.lane = t & 63; R.wid = __builtin_amdgcn_readfirstlane(t >> 6);
    R.ws = (unsigned char*)(GLB unsigned char*)launder_u64((unsigned long long)C0.ws);
    R.out = (float*)(GLB float*)(unsigned long long)C0.out;
    R.in = (const __attribute__((address_space(4))) cfp_t*)launder_u64((unsigned long long)C0.in);
    unsigned l = (unsigned)(uintptr_t)C0.lds; asm volatile("" : "+v"(l)); l = __builtin_amdgcn_readfirstlane(l); R.lds = (LAS unsigned char*)(uintptr_t)l;
    return R;
}

__device__ __forceinline__ const float* src_row(const Ctx& C, int r) {
    const int b = r / RPB, j = r % RPB;
    return j < CTXL ? INP(I_CTX) + ((size_t)b * CTXL + j) * DM : INP(I_X) + ((size_t)b * SEQ + (j - CTXL)) * DM;
}
__device__ __forceinline__ int mod_sel(int r) { const int b = r / RPB, j = r % RPB; return j < CTXL ? 2 : b; }

__device__ __forceinline__ void phase_modv(const Ctx& C) {
    LAS float* sc = (LAS float*)C.lds;
    LAS float* red = (LAS float*)(C.lds + 3 * 2048 * 4);
    for (int i = C.tid; i < 3 * DM; i += NTHREADS) { const int r = i / DM, k = i % DM; const float v = r < 2 ? INP(I_C)[r * DM + k] : INP(I_CCTX)[k]; sc[i] = siluf_(v); }
    __syncthreads();
    float* modv = WSP(float, WS_MODV);
    const int kq = C.tid / 12, c4 = C.tid % 12;
    for (int item = C.bid; item < 2 * 256; item += C.G) {
        const int l = item / 256, cg = item % 256;
        float acc[3][4];
#pragma unroll
        for (int r = 0; r < 3; ++r)
#pragma unroll
            for (int j = 0; j < 4; ++j) acc[r][j] = 0.f;
        if (kq < 42) {
            const float* wp = INP(I_WMOD) + (size_t)l * DM * 12288 + 48 * cg + 4 * c4;
#pragma unroll 1
            for (int k0 = kq; k0 < DM; k0 += 42 * 7) {
                f32x4 w[7];
#pragma unroll
                for (int u = 0; u < 7; ++u) { const int k = k0 + 42 * u; w[u] = k < DM ? *(const f32x4*)(wp + (size_t)k * 12288) : (f32x4){0.f, 0.f, 0.f, 0.f}; }
#pragma unroll
                for (int u = 0; u < 7; ++u) { const int k = k0 + 42 * u; if (k < DM) {
#pragma unroll
                    for (int r = 0; r < 3; ++r) { const float sv = sc[r * DM + k];
#pragma unroll
                        for (int j = 0; j < 4; ++j) acc[r][j] += sv * w[u][j]; } } }
            }
#pragma unroll
            for (int r = 0; r < 3; ++r)
#pragma unroll
                for (int j = 0; j < 4; ++j) red[kq * 144 + r * 48 + c4 * 4 + j] = acc[r][j];
        }
        __syncthreads();
        if (C.tid < 144) { float s = 0.f; for (int q = 0; q < 42; ++q) s += red[q * 144 + C.tid];
            const int r = C.tid / 48, cc = C.tid % 48;
            modv[((size_t)l * 3 + r) * 12288 + 48 * cg + cc] = s + INP(I_BMOD)[(size_t)l * 12288 + 48 * cg + cc]; }
        __syncthreads();
    }
}
__device__ __forceinline__ void phase_tables(const Ctx& C) {
    float* ta = WSP(float, WS_TABA); float* tm = WSP(float, WS_TABM);
    for (int i = C.bid * NTHREADS + C.tid; i < 128 * 32 + 128 * 16; i += C.G * NTHREADS) {
        if (i < 128 * 32) { const int pos = i / 32, f = i % 32; const float inv = exp2f(-(float)f * (13.287712379549449f / 32.0f)); const float a = (float)pos * inv;
            ta[i] = cosf(a); ta[128 * 32 + i] = sinf(a); }
        else { const int k = i - 128 * 32, pos = k / 16, f = k % 16; const float inv = exp2f(-(float)f * (13.287712379549449f / 16.0f)); const float a = (float)pos * inv;
            tm[k] = cosf(a); tm[128 * 16 + k] = sinf(a); }
    }
}
__device__ __forceinline__ void transpose_cvt(const Ctx& C, const float* src, int K, int N, bf16_t* dst, int Npad, int& item) {
    LAS float* tile = (LAS float*)C.lds;
    const int tk = K / 64, tn = Npad / 256, ntile = tk * tn;
    const int t0 = ((C.bid - item % C.G) + C.G) % C.G; item += ntile;
    for (int t = t0; t < ntile; t += C.G) {
        const int k0 = (t / tn) * 64, n0 = (t % tn) * 256;
        const int nn = (C.tid & 63) * 4, kr = C.tid >> 6;
        f32x4 v[8];
#pragma unroll
        for (int p = 0; p < 8; ++p) { v[p] = (f32x4){0.f, 0.f, 0.f, 0.f}; if (n0 + nn < N) v[p] = *(const f32x4*)(src + (size_t)(k0 + kr + p * 8) * N + n0 + nn); }
#pragma unroll
        for (int p = 0; p < 8; ++p)
#pragma unroll
            for (int j = 0; j < 4; ++j) tile[(kr + p * 8) * 257 + nn + j] = v[p][j];
        __syncthreads();
        { const int n = C.tid >> 1, kh = (C.tid & 1) * 32;
#pragma unroll
          for (int q = 0; q < 4; ++q) { float x[8];
#pragma unroll
              for (int j = 0; j < 8; ++j) x[j] = tile[(kh + q * 8 + j) * 257 + n];
              u32x4 w; w.x = cvt_pk_bf16(x[0], x[1]); w.y = cvt_pk_bf16(x[2], x[3]); w.z = cvt_pk_bf16(x[4], x[5]); w.w = cvt_pk_bf16(x[6], x[7]);
              *(u32x4*)(dst + (size_t)(n0 + n) * K + k0 + kh + q * 8) = w; } }
        __syncthreads();
    }
}
__device__ __forceinline__ void transpose_cvt_fp8(const Ctx& C, const float* src, int K, int N, unsigned char* dst, int Npad, float* cinv, const float cmul = 1.0f, const int wg_off = 0) {
    LAS float* tile = (LAS float*)C.lds;
    LAS float* red = (LAS float*)(C.lds + 64 * 65 * 4);
    LAS float* scl = red + 32 * 64;
    const int kk = C.tid >> 4, nn = (C.tid & 15) * 4;
    for (int cgp = ((C.bid - wg_off) % C.G + C.G) % C.G; cgp < Npad / 64; cgp += C.G) {
        const int n0 = cgp * 64; const bool live = n0 + nn < N;
        float am[4] = {0.f, 0.f, 0.f, 0.f};
        for (int k0 = 0; k0 < K; k0 += 128) {
            f32x4 v[4];
#pragma unroll
            for (int p = 0; p < 4; ++p) v[p] = live ? *(const f32x4*)(src + (size_t)(k0 + kk + p * 32) * N + n0 + nn) : (f32x4){0.f, 0.f, 0.f, 0.f};
#pragma unroll
            for (int p = 0; p < 4; ++p)
#pragma unroll
                for (int j = 0; j < 4; ++j) am[j] = fmaxf(am[j], fabsf(v[p][j])); }
#pragma unroll
        for (int j = 0; j < 4; ++j) red[kk * 64 + nn + j] = am[j];
        __syncthreads();
        if (C.tid < 64) { float m = 0.f; for (int q = 0; q < 32; ++q) m = fmaxf(m, red[q * 64 + C.tid]);
            scl[C.tid] = m > 0.f ? 224.0f / m : 1.0f; cinv[n0 + C.tid] = (m > 0.f ? m * (1.0f / 224.0f) : 1.0f) * cmul; }
        __syncthreads();
        for (int k0 = 0; k0 < K; k0 += 64) {
#pragma unroll
            for (int p = 0; p < 2; ++p) { const f32x4 v = live ? *(const f32x4*)(src + (size_t)(k0 + kk + p * 32) * N + n0 + nn) : (f32x4){0.f, 0.f, 0.f, 0.f};
#pragma unroll
                for (int j = 0; j < 4; ++j) tile[(kk + p * 32) * 65 + nn + j] = v[j]; }
            __syncthreads();
            { const int n = C.tid >> 3, k8 = (C.tid & 7) * 8; const float sc = scl[n]; float x[8];
#pragma unroll
              for (int j = 0; j < 8; ++j) x[j] = tile[(k8 + j) * 65 + n] * sc;
              int p0 = __builtin_amdgcn_cvt_pk_fp8_f32(x[0], x[1], 0, false); p0 = __builtin_amdgcn_cvt_pk_fp8_f32(x[2], x[3], p0, true);
              int p1 = __builtin_amdgcn_cvt_pk_fp8_f32(x[4], x[5], 0, false); p1 = __builtin_amdgcn_cvt_pk_fp8_f32(x[6], x[7], p1, true);
              u32x2 w; w.x = (unsigned)p0; w.y = (unsigned)p1; *(u32x2*)(dst + (size_t)(n0 + n) * K + k0 + k8) = w; }
            __syncthreads();
        }
    }
}
__device__ __forceinline__ void cvt_plain(const Ctx& C, const float* src, bf16_t* dst, size_t n8) {
    for (size_t i = (size_t)C.bid * NTHREADS + C.tid; i < n8; i += (size_t)C.G * NTHREADS) {
        const f32x4 a = *(const f32x4*)(src + i * 8), b = *(const f32x4*)(src + i * 8 + 4);
        u32x4 w; w.x = cvt_pk_bf16(a[0], a[1]); w.y = cvt_pk_bf16(a[2], a[3]); w.z = cvt_pk_bf16(b[0], b[1]); w.w = cvt_pk_bf16(b[2], b[3]);
        *(u32x4*)(dst + i * 8) = w;
    }
}
__device__ __forceinline__ void phase_cvt_mixer_weights(const Ctx& C, int l) {
    int item = 0;
    transpose_cvt_fp8(C, INP(I_WIN) + (size_t)l * DM * IN_COLS, DM, IN_COLS, C.ws + WS_WIN, NP, WSP(float, WS_WINS));
    __syncthreads();
    transpose_cvt(C, INP(I_WUQ) + (size_t)l * 512 * 1536, 512, 1536, WSP(bf16_t, WS_WUQ), 1536, item);
    transpose_cvt(C, INP(I_WUKV) + (size_t)l * 512 * 2048, 512, 2048, WSP(bf16_t, WS_WUKV), 2048, item);
    transpose_cvt_fp8(C, INP(I_WBRA) + (size_t)l * 1024 * 2048, 1024, 2048, C.ws + WS_WBR, 2048, WSP(float, WS_WBRS), 1.0f / 32.0f, 220); __syncthreads();
    transpose_cvt_fp8(C, INP(I_WBRL) + (size_t)l * 1024 * 2048, 1024, 2048, C.ws + WS_WBR + (size_t)2048 * 1024, 2048, WSP(float, WS_WBRS) + DM, 1.0f, 220); __syncthreads();
    transpose_cvt_fp8(C, INP(I_WBRM) + (size_t)l * 1024 * 2048, 1024, 2048, C.ws + WS_WBR + (size_t)2 * 2048 * 1024, 2048, WSP(float, WS_WBRS) + 2 * DM, 1.0f / 32.0f, 252); __syncthreads();
    transpose_cvt_fp8(C, INP(I_WOUT) + (size_t)l * 2048 * 2048, 2048, 2048, C.ws + WS_WOUT, 2048, WSP(float, WS_WOUTS), 1.0f, 188);
    __syncthreads();
    transpose_cvt(C, INP(I_PWQ) + (size_t)l * 2048 * 2048, 2048, 2048, WSP(bf16_t, WS_WQ), 2048, item);
    cvt_plain(C, INP(I_PK1) + (size_t)l * 8 * 128 * 128, WSP(bf16_t, WS_K1), 8 * 128 * 128 / 8);
    cvt_plain(C, INP(I_PK2) + (size_t)l * 8 * 128 * 128, WSP(bf16_t, WS_K2), 8 * 128 * 128 / 8);
}
__device__ __forceinline__ void phase_cvt_peer_tables(const Ctx& C, int l, int row_lo, int row_hi, int wg_lo) {
    const int lane = C.lane; if (C.bid < wg_lo) return;
    unsigned char* pt = C.ws + WS_PT + (size_t)l * PT_BYTES;
    for (int row = row_lo + (C.bid - wg_lo) * 8 + C.wid; row < row_hi; row += (C.G - wg_lo) * 8) {
#pragma unroll 1
        for (int tb = 0; tb < 2; ++tb) {
            const float* src = (tb ? INP(I_PV) : INP(I_PU)) + ((size_t)l * NEXP + row) * DM + lane * 16;
            f32x4 x[8]; float amax = 0.f;
#pragma unroll
            for (int c = 0; c < 2; ++c)
#pragma unroll
                for (int q = 0; q < 4; ++q) { x[c * 4 + q] = *(const f32x4*)(src + c * 1024 + q * 4);
                    amax = fmaxf(amax, fmaxf(fmaxf(fabsf(x[c * 4 + q][0]), fabsf(x[c * 4 + q][1])), fmaxf(fabsf(x[c * 4 + q][2]), fabsf(x[c * 4 + q][3])))); }
            amax = fmaxf(amax, xchg32(amax, lane)); amax = fmaxf(amax, xchg16(amax, lane)); amax = fmaxf(amax, dppmov<DPP_ROR8>(amax));
            amax = fmaxf(amax, dppmov<DPP_HMIRROR>(amax)); amax = fmaxf(amax, dppmov<DPP_Q3210>(amax)); amax = fmaxf(amax, dppmov<DPP_Q1032>(amax));
            const float sc = amax > 0.f ? 224.0f / amax : 1.0f, inv = amax > 0.f ? amax * (1.0f / 224.0f) : 1.0f;
            unsigned char* dst = pt + (tb ? PT_V8 : PT_U8) + (size_t)(lane >> 3) * ((size_t)NEXP * 128) + (size_t)row * 128 + (lane & 7) * 16;
#pragma unroll
            for (int c = 0; c < 2; ++c) { u32x4 w;
#pragma unroll
                for (int q = 0; q < 4; ++q) { const f32x4 v = x[c * 4 + q] * sc; int p = __builtin_amdgcn_cvt_pk_fp8_f32(v[0], v[1], 0, false); p = __builtin_amdgcn_cvt_pk_fp8_f32(v[2], v[3], p, true); w[q] = (unsigned)p; }
                *(u32x4*)(dst + (size_t)c * 8 * ((size_t)NEXP * 128)) = w; }
            if (lane == 0) ((float*)(pt + (tb ? PT_SCV : PT_SCU)))[row] = inv;
        }
    }
}

template <bool FIRST, bool F8OUT = false> __device__ __forceinline__ void phase_norm_mod(const Ctx& C, const float* gvec, const float* modl  , int shift_off, int scale_off) {
    float* xs = WSP(float, WS_XS); bf16_t* hb = WSP(bf16_t, WS_HB);
    for (int r = C.bid * 8 + C.wid; r < TT; r += C.G * 8) {
        const float* xr = FIRST ? src_row(C, r) : xs + (size_t)r * DM;
        const float* mv = modl + (size_t)mod_sel(r) * 12288;
        f32x4 v[8]; float ss = 0.f;
#pragma unroll
        for (int c = 0; c < 4; ++c) { v[2 * c] = *(const f32x4*)(xr + c * 512 + C.lane * 8); v[2 * c + 1] = *(const f32x4*)(xr + c * 512 + C.lane * 8 + 4); }
#pragma unroll
        for (int c = 0; c < 8; ++c) ss += v[c][0] * v[c][0] + v[c][1] * v[c][1] + v[c][2] * v[c][2] + v[c][3] * v[c][3];
        ss = wave_sum(ss);
        const float rs = rsqrtf(ss * (1.0f / DM) + NORM_EPS);
#pragma unroll
        for (int c = 0; c < 4; ++c) { const int col = c * 512 + C.lane * 8;
            if (FIRST) { *(f32x4*)(xs + (size_t)r * DM + col) = v[2 * c]; *(f32x4*)(xs + (size_t)r * DM + col + 4) = v[2 * c + 1]; }
            float o[8];
#pragma unroll
            for (int h = 0; h < 2; ++h) { const f32x4 g = *(const f32x4*)(gvec + col + 4 * h), s = *(const f32x4*)(mv + scale_off + col + 4 * h), t = *(const f32x4*)(mv + shift_off + col + 4 * h);
#pragma unroll
                for (int j = 0; j < 4; ++j) o[4 * h + j] = v[2 * c + h][j] * rs * g[j] * (1.0f + s[j]) + t[j]; }
            if constexpr (F8OUT) {
                int p0 = __builtin_amdgcn_cvt_pk_fp8_f32(o[0], o[1], 0, false); p0 = __builtin_amdgcn_cvt_pk_fp8_f32(o[2], o[3], p0, true);
                int p1 = __builtin_amdgcn_cvt_pk_fp8_f32(o[4], o[5], 0, false); p1 = __builtin_amdgcn_cvt_pk_fp8_f32(o[6], o[7], p1, true);
                u32x2 w; w.x = (unsigned)p0; w.y = (unsigned)p1; *(u32x2*)((unsigned char*)hb + (size_t)r * DM + col) = w;
            } else {
            u32x4 w; w.x = cvt_pk_bf16(o[0], o[1]); w.y = cvt_pk_bf16(o[2], o[3]); w.z = cvt_pk_bf16(o[4], o[5]); w.w = cvt_pk_bf16(o[6], o[7]);
            *(u32x4*)(hb + (size_t)r * DM + col) = w; } }
    }
}

__device__ __forceinline__ void phase_post_p(const Ctx& C, int l) {
    bf16_t* P = WSP(bf16_t, WS_P); const float* ta = WSP(float, WS_TABA); const float* tm = WSP(float, WS_TABM);
    const float* qg = INP(I_QNG) + l * 128; const float* kg = INP(I_KNG) + l * 128;
    const float* mqg = INP(I_MQNG) + l * 512; const float* mkvg = INP(I_MKVNG) + l * 512;
    const int lane = C.lane;
    const float qg1 = qg[lane], qg2 = qg[lane + 64], kg1 = kg[lane], kg2 = kg[lane + 64];
    for (int r = C.bid * 8 + C.wid; r < TT; r += C.G * 8) {
        bf16_t* pr = P + (size_t)r * NP;
        const int j = r % RPB; const bool lat = j >= CTXL; const int pos = lat ? j - CTXL : 0, ri = pos >> 6, ci = pos & 63;
        float cs = 1.f, sn = 0.f;
        if (lat) { const int p = lane < 32 ? ri : ci, f = lane & 31; cs = ta[p * 32 + f]; sn = ta[128 * 32 + p * 32 + f]; }
#pragma unroll
        for (int h = 0; h < 10; ++h) {
            bf16_t* hp = pr + (h < 8 ? C_AQ + h * 128 : C_AK + (h - 8) * 128);
            const float x1 = bf2f(hp[lane]), x2 = bf2f(hp[lane + 64]);
            const float ss = wave_sum(x1 * x1 + x2 * x2);
            const float rs = rsqrtf(ss * (1.0f / 128.0f) + NORM_EPS);
            const float y1 = x1 * rs * (h < 8 ? qg1 : kg1), y2 = x2 * rs * (h < 8 ? qg2 : kg2);
            const float z1 = y1 * cs - y2 * sn, z2 = y2 * cs + y1 * sn;
            hp[lane] = f2bf(z1); hp[lane + 64] = f2bf(z2);
            if (h >= 8) { unsigned char* k8 = C.ws + WS_AK8 + (size_t)r * 256 + (h - 8) * 128;
                k8[lane] = (unsigned char)(__builtin_amdgcn_cvt_pk_fp8_f32(z1, 0.f, 0, false) & 0xff); k8[lane + 64] = (unsigned char)(__builtin_amdgcn_cvt_pk_fp8_f32(z2, 0.f, 0, false) & 0xff); }
        }
#pragma unroll
        for (int s = 0; s < 2; ++s) {
            bf16_t* sp = pr + (s == 0 ? C_MCQ : C_MCKV) + lane * 8; const float* gg = (s == 0 ? mqg : mkvg) + lane * 8;
            const u32x4 w = *(const u32x4*)sp; float x[8] = {bflo(w.x), bfhi(w.x), bflo(w.y), bfhi(w.y), bflo(w.z), bfhi(w.z), bflo(w.w), bfhi(w.w)};
            float ss = 0.f;
#pragma unroll
            for (int i = 0; i < 8; ++i) ss += x[i] * x[i];
            ss = wave_sum(ss);
            const float rs = rsqrtf(ss * (1.0f / 512.0f) + NORM_EPS);
#pragma unroll
            for (int i = 0; i < 8; ++i) x[i] = x[i] * rs * gg[i];
            u32x4 o; o.x = cvt_pk_bf16(x[0], x[1]); o.y = cvt_pk_bf16(x[2], x[3]); o.z = cvt_pk_bf16(x[4], x[5]); o.w = cvt_pk_bf16(x[6], x[7]);
            *(u32x4*)sp = o;
        }
        { bf16_t* kp = pr + C_MKR; const int i = lane & 31; const float x1 = bf2f(kp[i]), x2 = bf2f(kp[i + 32]);
          float c2 = 1.f, s2 = 0.f; if (lat) { const int p = i < 16 ? ri : ci, f = i & 15; c2 = tm[p * 16 + f]; s2 = tm[128 * 16 + p * 16 + f]; }
          const float z1 = x1 * c2 - x2 * s2, z2 = x2 * c2 + x1 * s2;
          if (lane < 32) { if (lat) { kp[i] = f2bf(z1); kp[i + 32] = f2bf(z2); }
              unsigned char* k8 = C.ws + WS_KR8 + (size_t)r * 64; k8[i] = (unsigned char)(__builtin_amdgcn_cvt_pk_fp8_f32(z1, 0.f, 0, false) & 0xff); k8[i + 32] = (unsigned char)(__builtin_amdgcn_cvt_pk_fp8_f32(z2, 0.f, 0, false) & 0xff); } }
    }
}

typedef int i32x8 __attribute__((ext_vector_type(8)));
typedef int i32x4 __attribute__((ext_vector_type(4)));
namespace att {
constexpr int NW = 8, QBLK = 32, KVBLK = 64, DV = 128;
constexpr float THR = 8.f;
#define SBAR() __builtin_amdgcn_sched_barrier(0)
__device__ __forceinline__ int crow(int r, int hi) { return (r & 3) + 8 * (r >> 2) + 4 * hi; }
template <int DQ> struct Cf {
    static constexpr int ND0 = DQ / 16, KROWB = DQ * 2, SHM_K = KVBLK * DQ * 2, SHM_V = KVBLK * DV * 2, SHM = 2 * SHM_V + 2 * SHM_K + NW * 64 * 4;
    static constexpr float SCALE = DQ == 128 ? 0.088388347648318440f : 0.072168783648703220f;
    __device__ static __forceinline__ int kswz(int row, int colB) { return row * KROWB + (colB ^ ((row & 7) << 4)); }
};
template <int DQ, int VAR = 0> __device__ __forceinline__ void partialSM(f32x16& p0, f32x16& p1, float& m_reg, float& mn, float& alpha, const float thr = THR, const float eoff = 0.f) {
    constexpr float SC = Cf<DQ>::SCALE, Cc = SC * 1.4426950408889634f;
    float pmax = p0[0];
#pragma unroll
    for (int r = 1; r < 16; ++r) pmax = fmaxf(pmax, p0[r]);
#pragma unroll
    for (int r = 0; r < 16; ++r) pmax = fmaxf(pmax, p1[r]);
    { auto rr = __builtin_amdgcn_permlane32_swap(__float_as_uint(pmax), __float_as_uint(pmax), false, false);
      pmax = fmaxf(__uint_as_float(rr[0]), __uint_as_float(rr[1])); }
    if (__builtin_expect(__all(pmax - m_reg <= thr / SC), 1)) { mn = m_reg; alpha = 1.f; }
    else { mn = fmaxf(m_reg, pmax); alpha = __builtin_amdgcn_exp2f((m_reg - mn) * Cc); m_reg = mn; }
    const float mnC = eoff - mn * Cc;
#pragma unroll
    for (int r = 0; r < 16; ++r) p0[r] = fmaf(p0[r], Cc, mnC);
#pragma unroll
    for (int r = 0; r < 16; ++r) p1[r] = fmaf(p1[r], Cc, mnC);
#pragma unroll
    for (int r = 0; r < 16; ++r) p0[r] = VAR == 1 ? p0[r] * 0.001f : __builtin_amdgcn_exp2f(p0[r]);
}
template <int VAR = 0> __device__ __forceinline__ void finishSM(f32x16& p0, f32x16& p1, float alpha, float& l_reg, bf16x8& pa0, bf16x8& pa1, bf16x8& pa2, bf16x8& pa3) {
#pragma unroll
    for (int r = 0; r < 16; ++r) p1[r] = VAR == 1 ? p1[r] * 0.001f : __builtin_amdgcn_exp2f(p1[r]);
    float ps = 0;
#pragma unroll
    for (int r = 0; r < 16; ++r) ps += p0[r];
#pragma unroll
    for (int r = 0; r < 16; ++r) ps += p1[r];
    { auto rr = __builtin_amdgcn_permlane32_swap(__float_as_uint(ps), __float_as_uint(ps), false, false);
      ps = __uint_as_float(rr[0]) + __uint_as_float(rr[1]); }
    l_reg = l_reg * alpha + ps;
#define PK4(P, BASE, OUT) do { unsigned a0 = cvt_pk_bf16(P[BASE + 0], P[BASE + 1]), a1 = cvt_pk_bf16(P[BASE + 2], P[BASE + 3]);   \
    unsigned b0 = cvt_pk_bf16(P[BASE + 4], P[BASE + 5]), b1 = cvt_pk_bf16(P[BASE + 6], P[BASE + 7]);                              \
    auto r0 = __builtin_amdgcn_permlane32_swap(a0, b0, false, false); auto r1 = __builtin_amdgcn_permlane32_swap(a1, b1, false, false); \
    u32x4 w = {r0[0], r1[0], r0[1], r1[1]}; OUT = *reinterpret_cast<bf16x8*>(&w); } while (0)
    PK4(p0, 0, pa0); PK4(p0, 8, pa1); PK4(p1, 0, pa2); PK4(p1, 8, pa3);
#undef PK4
}
template <int DQ> __device__ __forceinline__ void qkt(f32x16& p0, f32x16& p1, const char* Ks, const bf16x8* qr, const char* qx, int r32, int hi) {
    p0 = f32x16{}; p1 = f32x16{};
#pragma unroll
    for (int d0 = 0; d0 < Cf<DQ>::ND0; ++d0) { const int cb = (d0 * 16 + hi * 8) * 2;
        const bf16x8 b0 = *reinterpret_cast<const bf16x8*>(Ks + Cf<DQ>::kswz(r32, cb));
        const bf16x8 b1 = *reinterpret_cast<const bf16x8*>(Ks + Cf<DQ>::kswz(32 + r32, cb));
        constexpr int NQR = DQ == 192 ? MLA_NQR : 8;
        bf16x8 q; if (d0 < NQR) q = qr[d0]; else q = *reinterpret_cast<const bf16x8*>(qx + (d0 - NQR) * 1024);
        p0 = __builtin_amdgcn_mfma_f32_32x32x16_bf16(b0, q, p0, 0, 0, 0);
        p1 = __builtin_amdgcn_mfma_f32_32x32x16_bf16(b1, q, p1, 0, 0, 0); }
}
__device__ __forceinline__ int v_st(int k, int c) { const int kk = (k & ~0xC) | ((k & 4) << 1) | ((k & 8) >> 1); return ((kk >> 3) * 4 + (c >> 5)) * 512 + ((kk & 7) * 32 + (c & 31)) * 2; }
__device__ __forceinline__ int v_rd_base(int lane) { return ((lane & 3) << 3) | (((lane >> 2) & 3) << 6) | (((lane >> 4) & 1) << 5) | (((lane >> 5) & 1) << 8); }
constexpr int v_rd_off(int d0, int ks, int half) { return d0 * 512 + ks * 4096 + half * 2048; }
template <int OFF> __device__ __forceinline__ s16x4 tr_read(int vb) {
    s16x4 r; asm volatile("ds_read_b64_tr_b16 %0, %1 offset:%2" : "=&v"(r) : "v"(vb), "i"(OFF) : "memory"); return r;
}
template <int D0> __device__ __forceinline__ void pv_one(f32x16& od, int vb, bf16x8 pa0, bf16x8 pa1, bf16x8 pa2, bf16x8 pa3) {
    const s16x4 l0 = tr_read<v_rd_off(D0, 0, 0)>(vb), h0 = tr_read<v_rd_off(D0, 0, 1)>(vb), l1 = tr_read<v_rd_off(D0, 1, 0)>(vb), h1 = tr_read<v_rd_off(D0, 1, 1)>(vb);
    const s16x4 l2 = tr_read<v_rd_off(D0, 2, 0)>(vb), h2 = tr_read<v_rd_off(D0, 2, 1)>(vb), l3 = tr_read<v_rd_off(D0, 3, 0)>(vb), h3 = tr_read<v_rd_off(D0, 3, 1)>(vb);
    asm volatile("s_waitcnt lgkmcnt(0)" ::: "memory"); SBAR();
#define PK(L, H) (bf16x8){L[0], L[1], L[2], L[3], H[0], H[1], H[2], H[3]}
    od = __builtin_amdgcn_mfma_f32_32x32x16_bf16(pa0, PK(l0, h0), od, 0, 0, 0);
    od = __builtin_amdgcn_mfma_f32_32x32x16_bf16(pa1, PK(l1, h1), od, 0, 0, 0);
    od = __builtin_amdgcn_mfma_f32_32x32x16_bf16(pa2, PK(l2, h2), od, 0, 0, 0);
    od = __builtin_amdgcn_mfma_f32_32x32x16_bf16(pa3, PK(l3, h3), od, 0, 0, 0);
#undef PK
}
__device__ __forceinline__ void pv_d0(f32x16* o, int vb, bf16x8 pa0, bf16x8 pa1, bf16x8 pa2, bf16x8 pa3) {
    pv_one<0>(o[0], vb, pa0, pa1, pa2, pa3); pv_one<1>(o[1], vb, pa0, pa1, pa2, pa3); pv_one<2>(o[2], vb, pa0, pa1, pa2, pa3); pv_one<3>(o[3], vb, pa0, pa1, pa2, pa3);
}
__device__ __forceinline__ bf16x8 ld8(const bf16_t* p) { return *reinterpret_cast<const bf16x8*>(p); }

template <int DQ, int SD, int VAR = 0>
__device__ __forceinline__ void attn_body(const bf16_t* __restrict__ Qb, int ldq, const bf16_t* __restrict__ Kn, int ldkn, const bf16_t* __restrict__ Kr, int ldkr,
                                          const bf16_t* __restrict__ Vh, int ldv, unsigned char* __restrict__ Ob, int ldo, int seq, bool rope_q, int pos0, const float* __restrict__ tabM, char* lds, const int tid) {
    using CF = Cf<DQ>; constexpr int ND0 = CF::ND0, SHM_V = CF::SHM_V, SHM_K = CF::SHM_K;
    const int wid = tid >> 6, lane = tid & 63, r32 = lane & 31, hi = lane >> 5;
    char* V_lds = lds; char* K_lds = lds + 2 * SHM_V;
    float* ws = (float*)(lds + 2 * SHM_V + 2 * SHM_K) + wid * 64; float* li_l = ws; float* al_l = ws + 32;
    constexpr int NQR = DQ == 192 ? MLA_NQR : 8;
    float m_reg = -1e30f, l_reg = 0; f32x16 o[4] = {}; bf16x8 qr[NQR];
    const bf16_t* Qw = Qb + (long)(wid * QBLK + r32) * ldq + hi * 8;
#pragma unroll
    for (int d0 = 0; d0 < NQR; ++d0) qr[d0] = ld8(Qw + d0 * 16);
    char* qx = lds + CF::SHM + wid * 8192 + lane * 16;
    if constexpr (DQ == 192) {
#pragma unroll
        for (int d0 = NQR; d0 < 8; ++d0) *(bf16x8*)(qx + (d0 - NQR) * 1024) = ld8(Qw + d0 * 16);
        bf16x8 qe[4];
#pragma unroll
        for (int d0 = 0; d0 < 4; ++d0) qe[d0] = ld8(Qw + (8 + d0) * 16);
        if (rope_q) {
            const int pos = pos0 + wid * QBLK + r32, ri = pos >> 6, ci = pos & 63;
#pragma unroll
            for (int t = 0; t < 2; ++t) { const int p = t == 0 ? ri : ci; const float* tc = tabM + p * 16 + hi * 8; const float* tsn = tabM + 128 * 16 + p * 16 + hi * 8;
                bf16x8 a = qe[t], b = qe[2 + t];
#pragma unroll
                for (int jj = 0; jj < 8; ++jj) { const float x1 = bf2f((bf16_t)a[jj]), x2 = bf2f((bf16_t)b[jj]), c = tc[jj], s = tsn[jj];
                    a[jj] = (short)f2bf(x1 * c - x2 * s); b[jj] = (short)f2bf(x2 * c + x1 * s); }
                qe[t] = a; qe[2 + t] = b; }
        }
#pragma unroll
        for (int d0 = 0; d0 < 4; ++d0) *(bf16x8*)(qx + (8 - NQR + d0) * 1024) = qe[d0];
    }
    const int sr = tid >> 4, sc = (tid & 15) * 8, vst0 = v_st(sr, sc), vst1 = v_st(32 + sr, sc);
    const int sr2 = tid >> 3, sc2 = (tid & 7) * 8;
    const int vb0 = (int)(uintptr_t)V_lds + v_rd_base(lane);
    struct { bf16x8 vs0, vs1, ks0, ks1, ks2; } sr_[SD];
    const unsigned offV = (unsigned)(sr * ldv + sc) * 2u, offK = (unsigned)(sr * ldkn + sc) * 2u, offR = (unsigned)(sr2 * ldkr + sc2) * 2u;
#define SLOAD(i, k0) do { const char* vt_ = (const char*)Vh + (size_t)(k0) * ldv * 2; const char* kt_ = (const char*)Kn + (size_t)(k0) * ldkn * 2; \
    sr_[i].vs0 = *(const bf16x8*)(vt_ + offV); sr_[i].vs1 = *(const bf16x8*)(vt_ + (size_t)32 * ldv * 2 + offV); \
    sr_[i].ks0 = *(const bf16x8*)(kt_ + offK); sr_[i].ks1 = *(const bf16x8*)(kt_ + (size_t)32 * ldkn * 2 + offK); \
    if constexpr (DQ == 192) sr_[i].ks2 = *(const bf16x8*)((const char*)Kr + (size_t)(k0) * ldkr * 2 + offR); } while (0)
#define SWRITE(b, i) do { *(bf16x8*)(V_lds + (b) * SHM_V + vst0) = sr_[i].vs0; *(bf16x8*)(V_lds + (b) * SHM_V + vst1) = sr_[i].vs1; const int kc = sc * 2; \
    *(bf16x8*)(K_lds + (b) * SHM_K + CF::kswz(sr, kc)) = sr_[i].ks0; *(bf16x8*)(K_lds + (b) * SHM_K + CF::kswz(32 + sr, kc)) = sr_[i].ks1; \
    if constexpr (DQ == 192) *(bf16x8*)(K_lds + (b) * SHM_K + CF::kswz(sr2, 256 + sc2 * 2)) = sr_[i].ks2; } while (0)
#define SWAIT() do { if constexpr (SD == 1) asm volatile("s_waitcnt vmcnt(0)" ::: "memory"); else if constexpr (DQ == 192) asm volatile("s_waitcnt vmcnt(5)" ::: "memory"); else asm volatile("s_waitcnt vmcnt(4)" ::: "memory"); } while (0)
#define RESC(a) do { if (__any((a) < 1.f)) { if (hi == 0) al_l[r32] = (a); asm volatile("s_waitcnt lgkmcnt(0)" ::: "memory"); \
    _Pragma("unroll") for (int d = 0; d < 4; ++d) _Pragma("unroll") for (int r = 0; r < 16; ++r) o[d][r] *= al_l[crow(r, hi)]; } } while (0)
    f32x16 pA0, pA1, pB0, pB1; float mnA, mnB, alA, alB; bf16x8 pa0, pa1, pa2, pa3; const int NT = seq / KVBLK;
    constexpr int SE = 0, SO = SD - 1;
    SLOAD(SE, 0); asm volatile("s_waitcnt vmcnt(0)" ::: "memory"); SWRITE(0, SE); __syncthreads();
    qkt<DQ>(pA0, pA1, K_lds, qr, qx, r32, hi); partialSM<DQ, VAR>(pA0, pA1, m_reg, mnA, alA);
    SLOAD(SO, KVBLK); if constexpr (SD == 2) { if (2 < NT) SLOAD(SE, 2 * KVBLK); }
    SWAIT(); SWRITE(1, SO); __syncthreads();
#define ATT_SYNC() do { if constexpr (VAR != 2) __syncthreads(); } while (0)
    for (int j = 1; j + 1 < NT; j += 2) {
        SBAR(); qkt<DQ>(pB0, pB1, K_lds + SHM_K, qr, qx, r32, hi);
        finishSM<VAR>(pA0, pA1, alA, l_reg, pa0, pa1, pa2, pa3); SBAR();
        if constexpr (VAR != 3) SLOAD(SO, (j + SD) * KVBLK); SBAR();
        pv_d0(o, vb0, pa0, pa1, pa2, pa3); partialSM<DQ, VAR>(pB0, pB1, m_reg, mnB, alB);
        ATT_SYNC(); SWAIT(); SWRITE(0, SE);
        RESC(alB); ATT_SYNC();
        SBAR(); qkt<DQ>(pA0, pA1, K_lds, qr, qx, r32, hi);
        finishSM<VAR>(pB0, pB1, alB, l_reg, pa0, pa1, pa2, pa3); SBAR();
        if constexpr (VAR != 3) { if (SD == 1 || j + 3 < NT) SLOAD(SE, (j + 1 + SD) * KVBLK); } SBAR();
        pv_d0(o, vb0 + SHM_V, pa0, pa1, pa2, pa3); partialSM<DQ, VAR>(pA0, pA1, m_reg, mnA, alA);
        ATT_SYNC(); SWAIT(); SWRITE(1, SO);
        RESC(alA); ATT_SYNC();
    }
    SBAR(); qkt<DQ>(pB0, pB1, K_lds + SHM_K, qr, qx, r32, hi);
    finishSM<VAR>(pA0, pA1, alA, l_reg, pa0, pa1, pa2, pa3); SBAR();
    pv_d0(o, vb0, pa0, pa1, pa2, pa3); partialSM<DQ, VAR>(pB0, pB1, m_reg, mnB, alB);
    ATT_SYNC(); RESC(alB);
    finishSM<VAR>(pB0, pB1, alB, l_reg, pa0, pa1, pa2, pa3); SBAR();
    pv_d0(o, vb0 + SHM_V, pa0, pa1, pa2, pa3);
    if (hi == 0) li_l[r32] = l_reg; asm volatile("s_waitcnt lgkmcnt(0)" ::: "memory");
    float rli[16];
#pragma unroll
    for (int r = 0; r < 16; ++r) rli[r] = __builtin_amdgcn_rcpf(li_l[crow(r, hi)]);
    unsigned char* Ow = Ob + (long)(wid * QBLK) * ldo;
#pragma unroll
    for (int r = 0; r < 16; ++r) { const int orow = crow(r, hi);
#pragma unroll
        for (int d0 = 0; d0 < 4; ++d0) Ow[(long)orow * ldo + d0 * 32 + r32] = (unsigned char)(__builtin_amdgcn_cvt_pk_fp8_f32(o[d0][r] * rli[r] * 32.0f, 0.f, 0, false) & 0xff); }
#undef SLOAD
#undef ATT_SYNC
#undef SWRITE
#undef SWAIT
#undef RESC
}

__device__ __forceinline__ int k8addr(int row, int b, int DQ_) { return row * DQ_ + (b < 128 ? (b ^ ((row & 7) << 4)) : 128 + ((b - 128) ^ ((row & 3) << 4))); }
#define MX32(ACC, A, B, SC) asm volatile("s_nop 1\n\tv_mfma_scale_f32_32x32x64_f8f6f4 %0, %1, %2, %0, %3, %3 op_sel_hi:[0,0,0]" : "+v"(ACC) : "v"(A), "v"(B), "v"(SC))
#define MX32Z(ACC, A, B, SC) asm volatile("v_mfma_scale_f32_32x32x64_f8f6f4 %0, %1, %2, 0, %3, %3 op_sel_hi:[0,0,0]" : "=&v"(ACC) : "v"(A), "v"(B), "v"(SC))
template <int DQ, bool NOPS = true> __device__ __forceinline__ void qkt8(f32x16& p0, f32x16& p1, const char* Ks, const i32x8* qf, int r32, int hi) {
    int mxs = 0x7f7f7f7f; asm volatile("" : "+v"(mxs));
#pragma unroll
    for (int ks = 0; ks < DQ / 64; ++ks) { const int b = ks * 64 + hi * 32;
        const i32x4 a0l = *reinterpret_cast<const i32x4*>(Ks + k8addr(r32, b, DQ)), a0h = *reinterpret_cast<const i32x4*>(Ks + k8addr(r32, b + 16, DQ));
        const i32x4 a1l = *reinterpret_cast<const i32x4*>(Ks + k8addr(32 + r32, b, DQ)), a1h = *reinterpret_cast<const i32x4*>(Ks + k8addr(32 + r32, b + 16, DQ));
        const i32x8 a0 = __builtin_shufflevector(a0l, a0h, 0, 1, 2, 3, 4, 5, 6, 7), a1 = __builtin_shufflevector(a1l, a1h, 0, 1, 2, 3, 4, 5, 6, 7);
        if (ks == 0) { MX32Z(p0, a0, qf[ks], mxs); MX32Z(p1, a1, qf[ks], mxs); } else { MX32(p0, a0, qf[ks], mxs); MX32(p1, a1, qf[ks], mxs); } }
    if (NOPS) asm volatile("s_nop 15\n\ts_nop 7");
}
__device__ __forceinline__ int pk4_fp8(float a, float b, float c, float d) { int p = __builtin_amdgcn_cvt_pk_fp8_f32(a, b, 0, false); return __builtin_amdgcn_cvt_pk_fp8_f32(c, d, p, true); }
__device__ __forceinline__ int pk4_fp8u(float a, float b, float c, float d) { int u; asm volatile("" : "=v"(u)); const int p = __builtin_amdgcn_cvt_pk_fp8_f32(a, b, u, false); return __builtin_amdgcn_cvt_pk_fp8_f32(c, d, p, true); }
template <int DQ>
__device__ __forceinline__ void attn_body8(const bf16_t* __restrict__ Qb, int ldq, const unsigned char* __restrict__ Kn8, int ldkn, const unsigned char* __restrict__ Kr8, int ldkr,
                                           const bf16_t* __restrict__ Vh, int ldv, unsigned char* __restrict__ Ob, int ldo, int seq, bool rope_q, int pos0, const float* __restrict__ tabM, char* lds, const int tid) {
    constexpr int NKS = DQ / 64, SHM_V = KVBLK * DV * 2, SHM_K = KVBLK * DQ;
    const int wid = tid >> 6, lane = tid & 63, r32 = lane & 31, hi = lane >> 5;
    char* V_lds = lds; char* K_lds = lds + 2 * SHM_V;
    float* ws = (float*)(lds + 2 * SHM_V + 2 * SHM_K) + wid * 64; float* li_l = ws; float* al_l = ws + 32;
    float m_reg = -1e30f, l_reg = 0; f32x16 o[4] = {}; i32x8 qf[NKS];
    const bf16_t* Qrow = Qb + (long)(wid * QBLK + r32) * ldq;
#pragma unroll
    for (int ks = 0; ks < NKS; ++ks) {
        float x[32];
#pragma unroll
        for (int c = 0; c < 4; ++c) { const u32x4 w = *(const u32x4*)(Qrow + ks * 64 + hi * 32 + c * 8);
            x[c * 8 + 0] = bflo(w.x); x[c * 8 + 1] = bfhi(w.x); x[c * 8 + 2] = bflo(w.y); x[c * 8 + 3] = bfhi(w.y); x[c * 8 + 4] = bflo(w.z); x[c * 8 + 5] = bfhi(w.z); x[c * 8 + 6] = bflo(w.w); x[c * 8 + 7] = bfhi(w.w); }
        if (DQ == 192 && ks == 2 && rope_q) {
            float y[32];
#pragma unroll
            for (int c = 0; c < 4; ++c) { const u32x4 w = *(const u32x4*)(Qrow + 128 + (1 - hi) * 32 + c * 8);
                y[c * 8 + 0] = bflo(w.x); y[c * 8 + 1] = bfhi(w.x); y[c * 8 + 2] = bflo(w.y); y[c * 8 + 3] = bfhi(w.y); y[c * 8 + 4] = bflo(w.z); y[c * 8 + 5] = bfhi(w.z); y[c * 8 + 6] = bflo(w.w); y[c * 8 + 7] = bfhi(w.w); }
            const int pos = pos0 + wid * QBLK + r32, ri = pos >> 6, ci = pos & 63;
#pragma unroll
            for (int i = 0; i < 32; ++i) { const int p = i < 16 ? ri : ci, f = i & 15; const float c_ = tabM[p * 16 + f], s_ = tabM[128 * 16 + p * 16 + f];
                x[i] = hi ? x[i] * c_ + y[i] * s_ : x[i] * c_ - y[i] * s_; }
        }
        i32x8 q8;
#pragma unroll
        for (int j = 0; j < 8; ++j) q8[j] = pk4_fp8(x[4 * j], x[4 * j + 1], x[4 * j + 2], x[4 * j + 3]);
        qf[ks] = q8;
    }
    const int sr = tid >> 4, sc = (tid & 15) * 8, vst0 = v_st(sr, sc), vst1 = v_st(32 + sr, sc);
    const int kr = tid >> 3, kb = (tid & 7) * 16;
    const int kr2 = (tid & 255) >> 2, kb2 = (tid & 3) * 16;
    const int vb0 = (int)(uintptr_t)V_lds + v_rd_base(lane);
    struct { bf16x8 vs0, vs1; u32x4 k0, k1; } sr_[1];
    const unsigned offV = (unsigned)(sr * ldv + sc) * 2u, offK = (unsigned)(kr * ldkn + kb), offR = (unsigned)(kr2 * ldkr + kb2);
#define SLOAD8(k0_) do { const char* vt_ = (const char*)Vh + (size_t)(k0_) * ldv * 2; \
    sr_[0].vs0 = *(const bf16x8*)(vt_ + offV); sr_[0].vs1 = *(const bf16x8*)(vt_ + (size_t)32 * ldv * 2 + offV); \
    sr_[0].k0 = *(const u32x4*)(Kn8 + (size_t)(k0_) * ldkn + offK); \
    if constexpr (DQ == 192) { if (tid < 256) sr_[0].k1 = *(const u32x4*)(Kr8 + (size_t)(k0_) * ldkr + offR); } } while (0)
#define SWRITE8(b) do { *(bf16x8*)(V_lds + (b) * SHM_V + vst0) = sr_[0].vs0; *(bf16x8*)(V_lds + (b) * SHM_V + vst1) = sr_[0].vs1; \
    *(u32x4*)(K_lds + (b) * SHM_K + k8addr(kr, kb, DQ)) = sr_[0].k0; \
    if constexpr (DQ == 192) { if (tid < 256) *(u32x4*)(K_lds + (b) * SHM_K + k8addr(kr2, 128 + kb2, DQ)) = sr_[0].k1; } } while (0)
#define SWAIT8() asm volatile("s_waitcnt vmcnt(0)" ::: "memory")
#define RESC8(a) do { if (__any((a) < 1.f)) { if (hi == 0) al_l[r32] = (a); asm volatile("s_waitcnt lgkmcnt(0)" ::: "memory"); \
    _Pragma("unroll") for (int d = 0; d < 4; ++d) _Pragma("unroll") for (int r = 0; r < 16; ++r) o[d][r] *= al_l[crow(r, hi)]; } } while (0)
    f32x16 pA0, pA1, pB0, pB1; float mnA, mnB, alA, alB; bf16x8 pa0, pa1, pa2, pa3; const int NT = seq / KVBLK;
    SLOAD8(0); SWAIT8(); SWRITE8(0); __syncthreads();
    qkt8<DQ>(pA0, pA1, K_lds, qf, r32, hi); partialSM<DQ, 0>(pA0, pA1, m_reg, mnA, alA);
    SLOAD8(KVBLK);
    SWAIT8(); SWRITE8(1); __syncthreads();
    for (int j = 1; j + 1 < NT; j += 2) {
        SBAR(); qkt8<DQ>(pB0, pB1, K_lds + SHM_K, qf, r32, hi);
        finishSM<0>(pA0, pA1, alA, l_reg, pa0, pa1, pa2, pa3); SBAR();
        SLOAD8((j + 1) * KVBLK); SBAR();
        pv_d0(o, vb0, pa0, pa1, pa2, pa3); partialSM<DQ, 0>(pB0, pB1, m_reg, mnB, alB);
        __syncthreads(); SWAIT8(); SWRITE8(0);
        RESC8(alB); __syncthreads();
        SBAR(); qkt8<DQ>(pA0, pA1, K_lds, qf, r32, hi);
        finishSM<0>(pB0, pB1, alB, l_reg, pa0, pa1, pa2, pa3); SBAR();
        SLOAD8((j + 2) * KVBLK); SBAR();
        pv_d0(o, vb0 + SHM_V, pa0, pa1, pa2, pa3); partialSM<DQ, 0>(pA0, pA1, m_reg, mnA, alA);
        __syncthreads(); SWAIT8(); SWRITE8(1);
        RESC8(alA); __syncthreads();
    }
    SBAR(); qkt8<DQ>(pB0, pB1, K_lds + SHM_K, qf, r32, hi);
    finishSM<0>(pA0, pA1, alA, l_reg, pa0, pa1, pa2, pa3); SBAR();
    pv_d0(o, vb0, pa0, pa1, pa2, pa3); partialSM<DQ, 0>(pB0, pB1, m_reg, mnB, alB);
    __syncthreads(); RESC8(alB);
    finishSM<0>(pB0, pB1, alB, l_reg, pa0, pa1, pa2, pa3); SBAR();
    pv_d0(o, vb0 + SHM_V, pa0, pa1, pa2, pa3);
    if (hi == 0) li_l[r32] = l_reg; asm volatile("s_waitcnt lgkmcnt(0)" ::: "memory");
    float rli[16];
#pragma unroll
    for (int r = 0; r < 16; ++r) rli[r] = __builtin_amdgcn_rcpf(li_l[crow(r, hi)]);
    unsigned char* Ow = Ob + (long)(wid * QBLK) * ldo;
#pragma unroll
    for (int r = 0; r < 16; ++r) { const int orow = crow(r, hi);
#pragma unroll
        for (int d0 = 0; d0 < 4; ++d0) Ow[(long)orow * ldo + d0 * 32 + r32] = (unsigned char)(__builtin_amdgcn_cvt_pk_fp8_f32(o[d0][r] * rli[r] * 32.0f, 0.f, 0, false) & 0xff); }
#undef SLOAD8
#undef SWRITE8
#undef SWAIT8
#undef RESC8
}

__device__ __host__ __forceinline__ int vt8_key(int g, int j) { const int i = j & 15; return (j < 16 ? 0 : 32) + (i & 3) + 8 * (i >> 2) + 4 * g; }
template <int DQ>
__device__ __forceinline__ void attn_body88(const bf16_t* __restrict__ Qb, int ldq, const unsigned char* __restrict__ Kn8, int ldkn, const unsigned char* __restrict__ Kr8, int ldkr,
                                            const unsigned char* __restrict__ VT8, unsigned char* __restrict__ Ob, int ldo, int seq, bool rope_q, int pos0, const float* __restrict__ tabM, char* lds, const int tid) {
    constexpr int NKS = DQ / 64, SHM_V = 128 * 64, SHM_K = KVBLK * DQ;
    constexpr float EOFF = 7.0f, THR8 = 1.0f;
    const int wid = tid >> 6, lane = tid & 63, r32 = lane & 31, hi = lane >> 5;
    char* V_lds = lds; char* K_lds = lds + 2 * SHM_V;
    float* ws = (float*)(lds + 2 * SHM_V + 2 * SHM_K) + wid * 64; float* li_l = ws; float* al_l = ws + 32;
    float m_reg = -1e30f, l_reg = 0; f32x16 o[4] = {}; i32x8 qf[NKS];
    const bf16_t* Qrow = Qb + (long)(wid * QBLK + r32) * ldq;
#pragma unroll
    for (int ks = 0; ks < NKS; ++ks) {
        float x[32];
#pragma unroll
        for (int c = 0; c < 4; ++c) { const u32x4 w = *(const u32x4*)(Qrow + ks * 64 + hi * 32 + c * 8);
            x[c * 8 + 0] = bflo(w.x); x[c * 8 + 1] = bfhi(w.x); x[c * 8 + 2] = bflo(w.y); x[c * 8 + 3] = bfhi(w.y); x[c * 8 + 4] = bflo(w.z); x[c * 8 + 5] = bfhi(w.z); x[c * 8 + 6] = bflo(w.w); x[c * 8 + 7] = bfhi(w.w); }
        if (DQ == 192 && ks == 2 && rope_q) {
            float y[32];
#pragma unroll
            for (int c = 0; c < 4; ++c) { const u32x4 w = *(const u32x4*)(Qrow + 128 + (1 - hi) * 32 + c * 8);
                y[c * 8 + 0] = bflo(w.x); y[c * 8 + 1] = bfhi(w.x); y[c * 8 + 2] = bflo(w.y); y[c * 8 + 3] = bfhi(w.y); y[c * 8 + 4] = bflo(w.z); y[c * 8 + 5] = bfhi(w.z); y[c * 8 + 6] = bflo(w.w); y[c * 8 + 7] = bfhi(w.w); }
            const int pos = pos0 + wid * QBLK + r32, ri = pos >> 6, ci = pos & 63;
#pragma unroll
            for (int i = 0; i < 32; ++i) { const int p = i < 16 ? ri : ci, f = i & 15; const float c_ = tabM[p * 16 + f], s_ = tabM[128 * 16 + p * 16 + f];
                x[i] = hi ? x[i] * c_ + y[i] * s_ : x[i] * c_ - y[i] * s_; }
        }
        i32x8 q8;
#pragma unroll
        for (int j = 0; j < 8; ++j) q8[j] = pk4_fp8(x[4 * j], x[4 * j + 1], x[4 * j + 2], x[4 * j + 3]);
        qf[ks] = q8;
    }
    const int wu = __builtin_amdgcn_readfirstlane(wid);
    const unsigned lbase = __builtin_amdgcn_readfirstlane((unsigned)(uintptr_t)(LAS char*)lds), wofs = (unsigned)wu * 1024u;
    const int vr = tid >> 2;
    const unsigned offVd = (unsigned)((vr * 4 + ((tid & 3) ^ ((vr >> 2) & 3))) * 16);
    const unsigned char* kp0; const unsigned char* kp1 = nullptr; unsigned ks0, ks1 = 0;
    if constexpr (DQ == 128) { const int row = tid >> 3, c = tid & 7; kp0 = Kn8 + (size_t)row * ldkn + ((c ^ (row & 7)) << 4); ks0 = (unsigned)(KVBLK * ldkn); }
    else { { const int G = tid, row = G / 12, c = G % 12; const bool nope = c < 8;
             kp0 = nope ? Kn8 + (size_t)row * ldkn + ((c ^ (row & 7)) << 4) : Kr8 + (size_t)row * ldkr + (((c - 8) ^ (row & 3)) << 4); ks0 = (unsigned)(KVBLK * (nope ? ldkn : ldkr)); }
           { const int G = 512 + (tid & 255), row = G / 12, c = G % 12; const bool nope = c < 8;
             kp1 = nope ? Kn8 + (size_t)row * ldkn + ((c ^ (row & 7)) << 4) : Kr8 + (size_t)row * ldkr + (((c - 8) ^ (row & 3)) << 4); ks1 = (unsigned)(KVBLK * (nope ? ldkn : ldkr)); } }
#define DMA16(gp, loff) __builtin_amdgcn_global_load_lds((const unsigned*)(gp), (LAS unsigned*)(uintptr_t)(lbase + (unsigned)(loff) + wofs), 16, 0, 0)
#define DMAK(t_, b_) do { DMA16(kp0 + (size_t)(t_) * ks0, 2 * SHM_V + (b_) * SHM_K); \
        if constexpr (DQ == 192) { if (wu < 4) DMA16(kp1 + (size_t)(t_) * ks1, 2 * SHM_V + (b_) * SHM_K + 8192); } } while (0)
#define DMAV(t_, b_) DMA16(VT8 + (size_t)(t_) * 8192 + offVd, (b_) * SHM_V)
#define DWAIT() asm volatile("s_waitcnt vmcnt(0)" ::: "memory")
#define RESC8(a) do { if (__any((a) < 1.f)) { if (hi == 0) al_l[r32] = (a); asm volatile("s_waitcnt lgkmcnt(0)" ::: "memory"); \
    _Pragma("unroll") for (int d = 0; d < 4; ++d) _Pragma("unroll") for (int r = 0; r < 16; ++r) o[d][r] *= al_l[crow(r, hi)]; } } while (0)
#define FIN8(P0, P1, AL, PA) do { _Pragma("unroll") for (int r = 0; r < 16; ++r) P1[r] = __builtin_amdgcn_exp2f(P1[r]); \
    float ps_ = 0; _Pragma("unroll") for (int r = 0; r < 16; ++r) ps_ += P0[r]; _Pragma("unroll") for (int r = 0; r < 16; ++r) ps_ += P1[r]; \
    { auto rr_ = __builtin_amdgcn_permlane32_swap(__float_as_uint(ps_), __float_as_uint(ps_), false, false); ps_ = __uint_as_float(rr_[0]) + __uint_as_float(rr_[1]); } \
    l_reg = l_reg * (AL) + ps_; \
    _Pragma("unroll") for (int j = 0; j < 4; ++j) { PA[j] = pk4_fp8u(P0[4 * j], P0[4 * j + 1], P0[4 * j + 2], P0[4 * j + 3]); \
        PA[4 + j] = pk4_fp8u(P1[4 * j], P1[4 * j + 1], P1[4 * j + 2], P1[4 * j + 3]); } } while (0)
#define PV8(VB, PA, NOPS) do { int mxs_ = 0x7f7f7f7f; asm volatile("" : "+v"(mxs_)); _Pragma("unroll") for (int d0 = 0; d0 < 4; ++d0) { const int row_ = d0 * 32 + r32, xs_ = (row_ >> 2) & 3; \
        const i32x4 lo_ = *reinterpret_cast<const i32x4*>((VB) + row_ * 64 + (((2 * hi) ^ xs_) << 4)), hi_ = *reinterpret_cast<const i32x4*>((VB) + row_ * 64 + (((2 * hi + 1) ^ xs_) << 4)); \
        const i32x8 vb_ = __builtin_shufflevector(lo_, hi_, 0, 1, 2, 3, 4, 5, 6, 7); MX32(o[d0], PA, vb_, mxs_); } if (NOPS) asm volatile("s_nop 15\n\ts_nop 7"); } while (0)
    f32x16 pA0, pA1, pB0, pB1; float mnA, mnB, alA, alB; i32x8 pa; const int NT = seq / KVBLK;
#define PSM8(P0, P1, MN, AL) do { partialSM<DQ, 0>(P0, P1, m_reg, MN, AL, THR8, EOFF); RESC8(AL); } while (0)
    DMAK(0, 0); DMAV(0, 0); DMAK(1, 1); DWAIT(); __syncthreads();
    qkt8<DQ>(pA0, pA1, K_lds, qf, r32, hi); PSM8(pA0, pA1, mnA, alA);
    __syncthreads();
    for (int j = 1; j + 1 < NT; j += 2) {
        DMAK(j + 1, 0); DMAV(j, 1);
        SBAR(); qkt8<DQ, false>(pB0, pB1, K_lds + SHM_K, qf, r32, hi);
        FIN8(pA0, pA1, alA, pa); SBAR();
        PV8(V_lds, pa, 0); PSM8(pB0, pB1, mnB, alB);
        DWAIT(); __syncthreads();
        if (j + 2 < NT) DMAK(j + 2, 1);
        DMAV(j + 1, 0);
        SBAR(); qkt8<DQ, false>(pA0, pA1, K_lds, qf, r32, hi);
        FIN8(pB0, pB1, alB, pa); SBAR();
        PV8(V_lds + SHM_V, pa, 0); PSM8(pA0, pA1, mnA, alA);
        DWAIT(); __syncthreads();
    }
    DMAV(NT - 1, 1);
    SBAR(); qkt8<DQ, false>(pB0, pB1, K_lds + SHM_K, qf, r32, hi);
    FIN8(pA0, pA1, alA, pa); SBAR();
    PV8(V_lds, pa, 0); PSM8(pB0, pB1, mnB, alB);
    DWAIT(); __syncthreads();
    FIN8(pB0, pB1, alB, pa); SBAR();
    PV8(V_lds + SHM_V, pa, 1);
#undef PSM8
#undef DMA16
#undef DMAK
#undef DMAV
#undef DWAIT
    if (hi == 0) li_l[r32] = l_reg; asm volatile("s_waitcnt lgkmcnt(0)" ::: "memory");
    float rli[16];
#pragma unroll
    for (int r = 0; r < 16; ++r) rli[r] = __builtin_amdgcn_rcpf(li_l[crow(r, hi)]) * 32.0f;
    unsigned char* Ow = Ob + (long)(wid * QBLK) * ldo;
#pragma unroll
    for (int r = 0; r < 16; ++r) { const int orow = crow(r, hi);
#pragma unroll
        for (int d0 = 0; d0 < 4; ++d0) Ow[(long)orow * ldo + d0 * 32 + r32] = (unsigned char)(__builtin_amdgcn_cvt_pk_fp8_f32(o[d0][r] * rli[r], 0.f, 0, false) & 0xff); }
#undef RESC8
#undef FIN8
#undef PV8
}
#undef MX32
}

template <int KS> __device__ __forceinline__ void mma_xy(f32x16& acc, const LAS bf16_t* X, const LAS bf16_t* Y, int hi) {
#pragma unroll
    for (int ks = 0; ks < KS; ++ks) { const bf16x8 a = *(const LAS bf16x8*)(X + ks * 16 + hi * 8), b = *(const LAS bf16x8*)(Y + ks * 16 + hi * 8);
        acc = __builtin_amdgcn_mfma_f32_32x32x16_bf16(a, b, acc, 0, 0, 0); }
}
__device__ __forceinline__ float logsig16(float x) { const float e = __expf(-fabsf(x)); return (fminf(x, 0.f) - __logf(1.f + e)) * 0.0625f; }
__device__ __forceinline__ int gla_sidx(int b, int dir, int h) { return (b * 2 + dir) * 4 + h; }

__device__ __forceinline__ void gla_cumsum_lds(const Ctx& C, int l, int h, int dir, const LAS float* lr, LAS float* segtot, LAS float* CUM) {
    const int seg = C.tid >> 7, d = C.tid & 127;
    const float* wa = INP(dir ? I_WA2B : I_WA2F) + (size_t)l * 16 * 512 + h * 128 + d;
    const float bias = INP(dir ? I_BAB : I_BAF)[l * 512 + h * 128 + d];
    float w[16], cum[16];
#pragma unroll
    for (int j = 0; j < 16; ++j) w[j] = wa[j * 512];
    float run = 0.f;
#pragma unroll
    for (int i = 0; i < 16; ++i) { const int s = seg * 16 + i, tk = dir ? 63 - s : s; float pre = bias;
#pragma unroll
        for (int j = 0; j < 16; ++j) pre += lr[tk * 32 + dir * 16 + j] * w[j];
        run += logsig16(pre); cum[i] = run; }
    segtot[seg * 128 + d] = run;
    __syncthreads();
    float off = 0.f;
#pragma unroll
    for (int q = 0; q < 3; ++q) if (q < seg) off += segtot[q * 128 + d];
#pragma unroll
    for (int i = 0; i < 16; ++i) { const int s = seg * 16 + i, tk = dir ? 63 - s : s; CUM[tk * 132 + d] = cum[i] + off; }
    __syncthreads();
}
__device__ __forceinline__ void unpack8(const u32x4 w, float (&x)[8]) { x[0] = bflo(w.x); x[1] = bfhi(w.x); x[2] = bflo(w.y); x[3] = bfhi(w.y); x[4] = bflo(w.z); x[5] = bfhi(w.z); x[6] = bflo(w.w); x[7] = bfhi(w.w); }
__device__ __forceinline__ void gla_build_vt(const Ctx& C, const bf16_t* P, size_t r0, int h, LAS bf16_t* VT) {
    u32x4 v[4];
#pragma unroll
    for (int it = 0; it < 4; ++it) { const int idx = C.tid + it * NTHREADS, sv = idx >> 5, e0 = (idx & 31) * 8; v[it] = *(const u32x4*)(P + (r0 + sv) * NP + C_LV + h * 256 + e0); }
#pragma unroll
    for (int it = 0; it < 4; ++it) { const int idx = C.tid + it * NTHREADS, sv = idx >> 5, e0 = (idx & 31) * 8;
        const unsigned wd[4] = {v[it].x, v[it].y, v[it].z, v[it].w};
#pragma unroll
        for (int q = 0; q < 4; ++q) { VT[(e0 + 2 * q) * 72 + sv] = (bf16_t)(wd[q] & 0xffffu); VT[(e0 + 2 * q + 1) * 72 + sv] = (bf16_t)(wd[q] >> 16); } }
}

__device__ __forceinline__ void phase_gla_local(const Ctx& C, int l, int rot) {
    const bf16_t* P = WSP(bf16_t, WS_P); bf16_t* GST = WSP(bf16_t, WS_GST); float* GDEC = WSP(float, WS_GDEC);
    LAS float* lr = (LAS float*)C.lds;
    LAS float* segtot = (LAS float*)(C.lds + 8192);
    LAS bf16_t* KT = (LAS bf16_t*)(C.lds + 10240);
    LAS bf16_t* VT = (LAS bf16_t*)(C.lds + 28672);
    LAS float* CUM = (LAS float*)(C.lds + 65536);
    const int r32 = C.lane & 31, hi = C.lane >> 5, d = C.tid & 127;
    const int btk = C.tid >> 3, bdg = (C.tid & 7) * 16;
    for (int unit = (C.bid + C.G - rot % C.G) % C.G; unit < NBATCH * 4 * NCH; unit += C.G) {
        const int b = unit / (4 * NCH), h = (unit / NCH) % 4, ck = unit % NCH; const size_t r0 = (size_t)b * RPB + ck * 64;
        for (int i = C.tid; i < 64 * 32; i += NTHREADS) lr[i] = bf2f(P[(r0 + (i >> 5)) * NP + C_LRF + (i & 31)]);
        const u32x4 kw0 = *(const u32x4*)(P + (r0 + btk) * NP + C_LK + h * 128 + bdg), kw1 = *(const u32x4*)(P + (r0 + btk) * NP + C_LK + h * 128 + bdg + 8);
        gla_build_vt(C, P, r0, h, VT);
        __syncthreads();
#pragma unroll 1
        for (int dir = 0; dir < 2; ++dir) {
            gla_cumsum_lds(C, l, h, dir, lr, segtot, CUM);
            const int tend = dir ? 0 : 63;
            const size_t sx = (size_t)gla_sidx(b, dir, h) * NCH + ck;
            if (C.tid < 128) GDEC[sx * 128 + d] = __expf(CUM[tend * 132 + d]);
            { float kf[16]; { float t8[8]; unpack8(kw0, t8);
#pragma unroll
                for (int i = 0; i < 8; ++i) kf[i] = t8[i]; unpack8(kw1, t8);
#pragma unroll
                for (int i = 0; i < 8; ++i) kf[8 + i] = t8[i]; }
#pragma unroll
              for (int q = 0; q < 4; ++q) { const f32x4 cm = *(const LAS f32x4*)(CUM + btk * 132 + bdg + 4 * q), be = *(const LAS f32x4*)(CUM + tend * 132 + bdg + 4 * q);
#pragma unroll
                  for (int i = 0; i < 4; ++i) KT[(bdg + 4 * q + i) * 72 + btk] = f2bf(kf[4 * q + i] * __expf(be[i] - cm[i])); } }
            __syncthreads();
            { const int dt = C.wid & 3, eb = (C.wid >> 2) * 4;
              f32x16 acc[4] = {};
#pragma unroll
              for (int q = 0; q < 4; ++q) mma_xy<4>(acc[q], KT + (dt * 32 + r32) * 72, VT + ((eb + q) * 32 + r32) * 72, hi);
              bf16_t* st = GST + sx * 32768;
#pragma unroll
              for (int q = 0; q < 4; ++q)
#pragma unroll
                  for (int g = 0; g < 4; ++g) { u32x2 w; w.x = cvt_pk_bf16(acc[q][4 * g], acc[q][4 * g + 1]); w.y = cvt_pk_bf16(acc[q][4 * g + 2], acc[q][4 * g + 3]);
                      *(u32x2*)(st + (size_t)((eb + q) * 32 + r32) * 128 + dt * 32 + 8 * g + 4 * hi) = w; } }
            __syncthreads();
        }
    }
}

__device__ __forceinline__ void phase_gla_scan(const Ctx& C) {
    bf16_t* GST = WSP(bf16_t, WS_GST); const float* GDEC = WSP(float, WS_GDEC);
    for (int gid = C.bid * NTHREADS + C.tid; gid < 16 * 8192; gid += C.G * NTHREADS) {
        const int sidx = gid >> 13, g = gid & 8191, dir = (sidx >> 2) & 1, d4 = (g & 31) * 4;
        bf16_t* base = GST + (size_t)sidx * NCH * 32768 + (size_t)g * 4;
        const float* dbase = GDEC + (size_t)sidx * NCH * 128 + d4;
        float S[4] = {0.f, 0.f, 0.f, 0.f};
        for (int st = 0; st < NCH; st += 4) {
            int ck[4]; u32x2 L[4]; f32x4 dc[4];
#pragma unroll
            for (int q = 0; q < 4; ++q) { const int s = st + q; ck[q] = dir ? (s < 4 ? 3 - s : NCH + 3 - s) : s;
                L[q] = *(const u32x2*)(base + (size_t)ck[q] * 32768); dc[q] = *(const f32x4*)(dbase + (size_t)ck[q] * 128); }
#pragma unroll
            for (int q = 0; q < 4; ++q) { u32x2 w; w.x = cvt_pk_bf16(S[0], S[1]); w.y = cvt_pk_bf16(S[2], S[3]);
                *(u32x2*)(base + (size_t)ck[q] * 32768) = w;
                S[0] = dc[q][0] * S[0] + bflo(L[q].x); S[1] = dc[q][1] * S[1] + bfhi(L[q].x); S[2] = dc[q][2] * S[2] + bflo(L[q].y); S[3] = dc[q][3] * S[3] + bfhi(L[q].y); }
        }
    }
}

__device__ __forceinline__ void phase_gla_out(const Ctx& C, int l, int rot) {
    const bf16_t* P = WSP(bf16_t, WS_P); const bf16_t* GST = WSP(bf16_t, WS_GST); unsigned char* OL = C.ws + WS_OL;
    LAS float* lr = (LAS float*)C.lds;
    LAS float* segtot = (LAS float*)(C.lds + 8192);
    LAS bf16_t* QT = (LAS bf16_t*)(C.lds + 10240);
    LAS bf16_t* KT = (LAS bf16_t*)(C.lds + 27648);
    LAS bf16_t* VT = (LAS bf16_t*)(C.lds + 45056);
    LAS bf16_t* SCm = (LAS bf16_t*)(C.lds + 81920);
    LAS float* OB = (LAS float*)(C.lds + 91136);
    LAS float* CUM = OB;
    const float* gon = INP(I_ONG) + l * 256;
    const int r32 = C.lane & 31, hi = C.lane >> 5;
    const int btk = C.tid >> 3, bdg = (C.tid & 7) * 16;
    const bool lastl = l + 1 >= DEPTH; const int nck = lastl ? NCH - CTXL / 64 : NCH;
    for (int unit = (C.bid + C.G - rot % C.G) % C.G; unit < NBATCH * 4 * nck; unit += C.G) {
        const int b = unit / (4 * nck), h = (unit / nck) % 4, ck = unit % nck + (NCH - nck); const size_t r0 = (size_t)b * RPB + ck * 64;
        for (int i = C.tid; i < 64 * 32; i += NTHREADS) lr[i] = bf2f(P[(r0 + (i >> 5)) * NP + C_LRF + (i & 31)]);
        const bf16_t* qp = P + (r0 + btk) * NP + C_LQ + h * 128 + bdg; const bf16_t* kp = P + (r0 + btk) * NP + C_LK + h * 128 + bdg;
        const u32x4 qw0 = *(const u32x4*)qp, qw1 = *(const u32x4*)(qp + 8), kw0 = *(const u32x4*)kp, kw1 = *(const u32x4*)(kp + 8);
        gla_build_vt(C, P, r0, h, VT);
        __syncthreads();
        f32x16 oacc[2] = {};
#pragma unroll 1
        for (int dir = 0; dir < 2; ++dir) {
            gla_cumsum_lds(C, l, h, dir, lr, segtot, CUM);
            { float qf[8], kf[8];
#pragma unroll
              for (int hh = 0; hh < 2; ++hh) { unpack8(hh ? qw1 : qw0, qf); unpack8(hh ? kw1 : kw0, kf);
                  const f32x4 c0 = *(const LAS f32x4*)(CUM + btk * 132 + bdg + 8 * hh), c1 = *(const LAS f32x4*)(CUM + btk * 132 + bdg + 8 * hh + 4);
                  float qo[8], ko[8];
#pragma unroll
                  for (int i = 0; i < 8; ++i) { const float cm = i < 4 ? c0[i & 3] : c1[i & 3]; qo[i] = qf[i] * __expf(cm) * 0.088388347648318440f; ko[i] = kf[i] * __expf(-cm); }
                  u32x4 wq, wk; wq.x = cvt_pk_bf16(qo[0], qo[1]); wq.y = cvt_pk_bf16(qo[2], qo[3]); wq.z = cvt_pk_bf16(qo[4], qo[5]); wq.w = cvt_pk_bf16(qo[6], qo[7]);
                  wk.x = cvt_pk_bf16(ko[0], ko[1]); wk.y = cvt_pk_bf16(ko[2], ko[3]); wk.z = cvt_pk_bf16(ko[4], ko[5]); wk.w = cvt_pk_bf16(ko[6], ko[7]);
                  *(LAS u32x4*)(QT + btk * 136 + bdg + 8 * hh) = wq; *(LAS u32x4*)(KT + btk * 136 + bdg + 8 * hh) = wk; } }
            __syncthreads();
            if (C.wid < 4) { const int mt = C.wid >> 1, nt = C.wid & 1; f32x16 sc = {};
                mma_xy<8>(sc, QT + (mt * 32 + r32) * 136, KT + (nt * 32 + r32) * 136, hi);
#pragma unroll
                for (int i = 0; i < 16; ++i) { const int t = mt * 32 + att::crow(i, hi), sx_ = nt * 32 + r32; const bool keep = dir ? (sx_ >= t) : (sx_ <= t);
                    SCm[t * 72 + sx_] = f2bf(keep ? sc[i] : 0.f); } }
            __syncthreads();
            { const bf16_t* st = GST + ((size_t)gla_sidx(b, dir, h) * NCH + ck) * 32768 + (size_t)(C.wid * 32 + r32) * 128 + hi * 8;
              bf16x8 sb[8];
#pragma unroll
              for (int ks = 0; ks < 8; ++ks) sb[ks] = *(const bf16x8*)(st + ks * 16);
#pragma unroll
              for (int mt = 0; mt < 2; ++mt) {
                  mma_xy<4>(oacc[mt], SCm + (mt * 32 + r32) * 72, VT + (C.wid * 32 + r32) * 72, hi);
#pragma unroll
                  for (int ks = 0; ks < 8; ++ks) { const bf16x8 a = *(const LAS bf16x8*)(QT + (mt * 32 + r32) * 136 + ks * 16 + hi * 8);
                      oacc[mt] = __builtin_amdgcn_mfma_f32_32x32x16_bf16(a, sb[ks], oacc[mt], 0, 0, 0); } } }
            __syncthreads();
        }
#pragma unroll
        for (int mt = 0; mt < 2; ++mt)
#pragma unroll
            for (int i = 0; i < 16; ++i) OB[(mt * 32 + att::crow(i, hi)) * 260 + C.wid * 32 + r32] = oacc[mt][i];
        __syncthreads();
        { const int t = C.tid >> 3, part = C.tid & 7; f32x4 v[8]; float ss = 0.f;
#pragma unroll
          for (int jj = 0; jj < 8; ++jj) { v[jj] = *(const LAS f32x4*)(OB + t * 260 + jj * 32 + part * 4); ss += v[jj][0] * v[jj][0] + v[jj][1] * v[jj][1] + v[jj][2] * v[jj][2] + v[jj][3] * v[jj][3]; }
          ss += dppmov<DPP_HMIRROR>(ss); ss += dppmov<DPP_Q3210>(ss); ss += dppmov<DPP_Q1032>(ss);
          const float rs = rsqrtf(ss * (1.0f / 256.0f) + NORM_EPS);
#pragma unroll
          for (int jj = 0; jj < 8; ++jj) { const int e = jj * 32 + part * 4; const f32x4 g = *(const f32x4*)(gon + e);
              const u32x2 gt = *(const u32x2*)(P + (r0 + t) * NP + C_LG + h * 256 + e);
              const float o0 = v[jj][0] * rs * g[0] * siluf_(bflo(gt.x)), o1 = v[jj][1] * rs * g[1] * siluf_(bfhi(gt.x)), o2 = v[jj][2] * rs * g[2] * siluf_(bflo(gt.y)), o3 = v[jj][3] * rs * g[3] * siluf_(bfhi(gt.y));
              int p8 = __builtin_amdgcn_cvt_pk_fp8_f32(o0, o1, 0, false); p8 = __builtin_amdgcn_cvt_pk_fp8_f32(o2, o3, p8, true);
              *(unsigned*)(OL + (r0 + t) * 1024 + h * 256 + e) = (unsigned)p8; } }
        __syncthreads();
    }
}

__device__ __forceinline__ unsigned f_ord(float f) { const unsigned u = __float_as_uint(f); return u ^ ((unsigned)((int)u >> 31) | 0x80000000u); }
__device__ __forceinline__ float f_unord(unsigned k) { return __uint_as_float((k & 0x80000000u) ? (k ^ 0x80000000u) : ~k); }
__device__ __forceinline__ void ins_u(unsigned (&L)[16], unsigned x) {
#pragma unroll
    for (int j = 0; j < 16; ++j) { const unsigned h = L[j] > x ? L[j] : x; x = L[j] > x ? x : L[j]; L[j] = h; }
}
__device__ __forceinline__ void ins_f(float (&M)[16], float x) {
#pragma unroll
    for (int j = 0; j < 16; ++j) { const float h = M[j] > x ? M[j] : x; x = M[j] > x ? x : M[j]; M[j] = h; }
}
__device__ __forceinline__ void peer_top16(const bf16_t* __restrict__ qrow, const bf16_t* __restrict__ keys, int r32, int hi, unsigned (&L)[16]) {
    bf16x8 qf[8];
#pragma unroll
    for (int kk = 0; kk < 8; ++kk) qf[kk] = *(const bf16x8*)(qrow + kk * 16 + hi * 8);
#pragma unroll
    for (int j = 0; j < 16; ++j) L[j] = 0u;
    bf16x8 kA[8], kB[8];
    const bf16_t* kl = keys + (size_t)r32 * 128 + hi * 8;
#define PT_LDK(dst, mt) do { _Pragma("unroll") for (int kk = 0; kk < 8; ++kk) dst[kk] = *(const bf16x8*)(kl + (mt) * 32 * 128 + kk * 16); } while (0)
#define PT_PROC(src, mt) do { f32x16 acc = {}; \
        _Pragma("unroll") for (int kk = 0; kk < 8; ++kk) acc = __builtin_amdgcn_mfma_f32_32x32x16_bf16(src[kk], qf[kk], acc, 0, 0, 0); \
        _Pragma("unroll") for (int i = 0; i < 16; ++i) { const unsigned kidx = (unsigned)((mt) * 32 + att::crow(i, hi)); ins_u(L, (f_ord(acc[i]) & ~127u) | (127u - kidx)); } } while (0)
    PT_LDK(kA, 0);
#pragma unroll 1
    for (int mp = 0; mp < 2; ++mp) { PT_LDK(kB, 2 * mp + 1); PT_PROC(kA, 2 * mp); if (mp == 0) PT_LDK(kA, 2); PT_PROC(kB, 2 * mp + 1); }
#undef PT_LDK
#undef PT_PROC
    unsigned Pn[16];
#pragma unroll
    for (int j = 0; j < 16; ++j) { auto r_ = __builtin_amdgcn_permlane32_swap(L[j], L[j], false, false); Pn[j] = hi ? r_[0] : r_[1]; }
#pragma unroll
    for (int j = 0; j < 16; ++j) ins_u(L, Pn[j]);
}
__device__ __forceinline__ void phase_peer_select(const Ctx& C, const bool latent_only) {
    const bf16_t* PQ = WSP(bf16_t, WS_PQ); const bf16_t* K1 = WSP(bf16_t, WS_K1); const bf16_t* K2 = WSP(bf16_t, WS_K2);
    int* PIDX = WSP(int, WS_PIDX); float* PG = WSP(float, WS_PG);
    const int r32 = C.lane & 31, hi = C.lane >> 5, head = C.wid;
    const int ngrp = latent_only ? NBATCH * SEQ / 32 : TT / 32;
    for (int gi = C.bid; gi < ngrp; gi += C.G) {
        const int grp = latent_only ? gi + (CTXL / 32) * (1 + gi / (SEQ / 32)) : gi;
        const size_t tok = (size_t)grp * 32 + r32;
        unsigned L1[16], L2[16];
        peer_top16(PQ + tok * DM + head * 256, K1 + (size_t)head * 128 * 128, r32, hi, L1);
        peer_top16(PQ + tok * DM + head * 256 + 128, K2 + (size_t)head * 128 * 128, r32, hi, L2);
        float v1[16], v2[16];
#pragma unroll
        for (int j = 0; j < 16; ++j) { v1[j] = f_unord(L1[j] & ~127u); v2[j] = f_unord(L2[j] & ~127u); }
        float M[16];
#pragma unroll
        for (int j = 0; j < 16; ++j) M[j] = -3.0e38f;
#pragma unroll
        for (int a = 0; a < 16; ++a)
#pragma unroll
            for (int b = 0; b < 16; ++b) if ((a + 1) * (b + 1) <= 16) ins_f(M, v1[a] + v2[b]);
        const float thr = M[15], mx = M[0]; float den = 0.f;
#pragma unroll
        for (int j = 0; j < 16; ++j) den += __expf(M[j] - mx);
        const float rden = 1.0f / den;
        int pos = 0; int* ip = PIDX + tok * 128 + head * 16; float* gp = PG + tok * 128 + head * 16;
#pragma unroll
        for (int a = 0; a < 16; ++a)
#pragma unroll
            for (int b = 0; b < 16; ++b) if ((a + 1) * (b + 1) <= 16) {
                const float val = v1[a] + v2[b];
                if (val >= thr && pos < 16) { if (hi == 0) { ip[pos] = (int)((127u - (L1[a] & 127u)) * 128u + (127u - (L2[b] & 127u))); gp[pos] = __expf(val - mx) * rden; } ++pos; } }
    }
}
template <int OFF> __device__ __forceinline__ float dotf8(const float (&h)[32], const u32x4 w, float acc) {
#pragma unroll
    for (int j = 0; j < 4; ++j) { const f32x2 lo = __builtin_amdgcn_cvt_pk_f32_fp8((int)w[j], false), hi = __builtin_amdgcn_cvt_pk_f32_fp8((int)w[j], true);
        acc += h[OFF + 4 * j] * lo.x; acc += h[OFF + 4 * j + 1] * lo.y; acc += h[OFF + 4 * j + 2] * hi.x; acc += h[OFF + 4 * j + 3] * hi.y; }
    return acc;
}
constexpr float ATT_O8_SCALE = 32.0f;
constexpr int GT_MAXTOK = 9;
template <bool LAST> __device__ __forceinline__ void phase_peer_gather(const Ctx& C, const float* modl, const float pscale) {
    const unsigned char* pt = C.ws + WS_PT + (size_t)(LAST ? DEPTH - 1 : 0) * PT_BYTES;
    const bf16_t* HB = WSP(bf16_t, WS_HB); const unsigned char* U8 = pt + PT_U8; const unsigned char* V8 = pt + PT_V8;
    const float* SCU = (const float*)(pt + PT_SCU); const float* SCV = (const float*)(pt + PT_SCV);
    const int* PIDX = WSP(int, WS_PIDX); const float* PG = WSP(float, WS_PG); float* XS = WSP(float, WS_XS);
    const int lane = C.lane, s = lane >> 3, j = lane & 7; const unsigned j16 = (unsigned)j * 16u;
    LAS int* IDS = (LAS int*)(C.lds + C.wid * (GT_MAXTOK * 512));
    LAS float* ACT = (LAS float*)(C.lds + 8 * GT_MAXTOK * 512 + C.wid * (GT_MAXTOK * 512));
    LAS int* ROWS = (LAS int*)(C.lds + 16 * GT_MAXTOK * 512 + C.wid * 64);
    int nk = 0;
    {
      const int per = (TT + C.G - 1) / C.G, base = C.bid * per;
#pragma unroll 1
      for (int k = 0; k < GT_MAXTOK; ++k) { const int o = C.wid + 8 * k; const int r = base + o; if (o < per && r < TT && !(LAST && (r % RPB) < CTXL)) { if (lane == 0) ROWS[nk] = r; ++nk; } } }
#define GT_ROW(k) __builtin_amdgcn_readfirstlane(ROWS[k])
#pragma unroll 1
    for (int k = 0; k < nk; ++k) { const int r = GT_ROW(k);
        IDS[k * 128 + lane] = (PIDX[(size_t)r * 128 + lane] & (NEXP - 1)) << 7; IDS[k * 128 + 64 + lane] = (PIDX[(size_t)r * 128 + 64 + lane] & (NEXP - 1)) << 7;
        ACT[k * 128 + lane] = 0.f; ACT[k * 128 + 64 + lane] = 0.f; }
    const int nit = 32 * nk;
#define GT_ITEM(it_) const int cb_ = (it_) / (2 * nk), rem_ = (it_) - cb_ * (2 * nk), k_ = rem_ >> 1, hf_ = rem_ & 1
#define GT_LOADU(UQ, HQ, it_) do { GT_ITEM(it_); const int r_ = GT_ROW(k_); \
        const bf16_t* hp_ = HB + (size_t)r_ * DM + cb_ * 128 + j * 16; HQ[0] = *(const u32x4*)hp_; HQ[1] = *(const u32x4*)(hp_ + 8); \
        const unsigned char* ub_ = U8 + (size_t)cb_ * ((size_t)NEXP * 128);     \
        _Pragma("unroll") for (int eg = 0; eg < 8; ++eg) { const unsigned off_ = ((unsigned)IDS[k_ * 128 + (hf_ * 8 + eg) * 8 + s] & idmask) + j16; UQ[eg] = *(const u32x4*)(ub_ + off_); } } while (0)
#define GT_COMPU(UQ, HQ, it_) do { GT_ITEM(it_); (void)cb_; f32x2 hf2[8]; \
        _Pragma("unroll") for (int hh = 0; hh < 2; ++hh) { const u32x4 w_ = HQ[hh]; \
            hf2[hh * 4 + 0] = (f32x2){bflo(w_.x), bfhi(w_.x)}; hf2[hh * 4 + 1] = (f32x2){bflo(w_.y), bfhi(w_.y)}; hf2[hh * 4 + 2] = (f32x2){bflo(w_.z), bfhi(w_.z)}; hf2[hh * 4 + 3] = (f32x2){bflo(w_.w), bfhi(w_.w)}; } \
        float d[8]; \
        _Pragma("unroll") for (int eg = 0; eg < 8; ++eg) { f32x2 d2 = (f32x2){0.f, 0.f}; \
            _Pragma("unroll") for (int q = 0; q < 4; ++q) { const f32x2 lo = __builtin_amdgcn_cvt_pk_f32_fp8((int)UQ[eg][q], false), hi = __builtin_amdgcn_cvt_pk_f32_fp8((int)UQ[eg][q], true); \
                d2 += hf2[2 * q] * lo; d2 += hf2[2 * q + 1] * hi; } \
            d[eg] = d2.x + d2.y; } \
          \
        float t4[4], t2[2], t1; \
        _Pragma("unroll") for (int i = 0; i < 4; ++i) { const float snd = (j & 4) ? d[i] : d[i + 4], kp = (j & 4) ? d[i + 4] : d[i]; t4[i] = kp + dppmov<DPP_HMIRROR>(snd); } \
        _Pragma("unroll") for (int i = 0; i < 2; ++i) { const float snd = (j & 2) ? t4[i] : t4[i + 2], kp = (j & 2) ? t4[i + 2] : t4[i]; t2[i] = kp + dppmov<DPP_Q3210>(snd); } \
        { const float snd = (j & 1) ? t2[0] : t2[1], kp = (j & 1) ? t2[1] : t2[0]; t1 = kp + dppmov<DPP_Q1032>(snd); } \
        ACT[k_ * 128 + (hf_ * 8 + j) * 8 + s] += t1; } while (0)
#ifdef DBG_GDUP
#pragma unroll 1
    for (int rep_ = 0; rep_ < 2; ++rep_) {
    const unsigned idmask = rep_ == 0 ? ((unsigned)DBG_GMASK << 7 | 127u) : 0xffffffffu;
    if (rep_ == 1) { for (int k = 0; k < nk; ++k) { ACT[k * 128 + lane] = 0.f; ACT[k * 128 + 64 + lane] = 0.f; } }
#else
    { const unsigned idmask = 0xffffffffu;
#endif
    if (nit > 0) {
        u32x4 uA[8], uB[8], hA[2], hB[2];
        GT_LOADU(uA, hA, 0);
#pragma unroll 1
        for (int it = 0; it < nit; it += 2) {
            GT_LOADU(uB, hB, it + 1);
            GT_COMPU(uA, hA, it);
            if (it + 2 < nit) GT_LOADU(uA, hA, it + 2);
            GT_COMPU(uB, hB, it + 1);
        }
    }
    }
#undef GT_LOADU
#undef GT_COMPU
#pragma unroll 1
    for (int k = 0; k < nk; ++k) { const int r = GT_ROW(k);
#pragma unroll
        for (int hh = 0; hh < 2; ++hh) { const int e = hh * 64 + lane; const int id = IDS[k * 128 + e] >> 7; const float a = ACT[k * 128 + e] * SCU[id];
            const float w = PG[(size_t)r * 128 + e] * 0.5f * a * (1.0f + erff(a * 0.70710678118654752f));
#if defined(DBG_CHECK) && (DBG_CHECK == 3 || DBG_CHECK == 4)
            if (((r - 300) & 63) == 0 && r >= 300 && r < 300 + 64 * 128) WSP(float, WS_OM)[(size_t)r * 128 + e] = w;
#endif
            ACT[k * 128 + e] = w * SCV[id]; } }
#define GT_LOADV(VQ, WV, it_) do { GT_ITEM(it_); const unsigned char* vb_ = V8 + (size_t)cb_ * ((size_t)NEXP * 128); \
        _Pragma("unroll") for (int eg = 0; eg < 8; ++eg) { const int e_ = k_ * 128 + (hf_ * 8 + eg) * 8 + s; const unsigned off_ = (unsigned)IDS[e_] + j16; VQ[eg] = *(const u32x4*)(vb_ + off_); WV[eg] = ACT[e_]; } } while (0)
#define GT_COMPV(VQ, WV) do { \
        _Pragma("unroll") for (int eg = 0; eg < 8; ++eg) { const f32x2 w2_ = (f32x2){WV[eg], WV[eg]}; \
            _Pragma("unroll") for (int q = 0; q < 4; ++q) { \
                const f32x2 lo = __builtin_amdgcn_cvt_pk_f32_fp8((int)VQ[eg][q], false), hi = __builtin_amdgcn_cvt_pk_f32_fp8((int)VQ[eg][q], true); \
                acc2[2 * q] += w2_ * lo; acc2[2 * q + 1] += w2_ * hi; } } } while (0)
    if (nit > 0) {
        u32x4 vA[8], vB[8]; float wA[8], wB[8];
        GT_LOADV(vA, wA, 0);
#pragma unroll 1
        for (int it = 0; it < nit; it += 2) {
            f32x2 acc2[8];
#pragma unroll
            for (int i = 0; i < 8; ++i) acc2[i] = (f32x2){0.f, 0.f};
            GT_LOADV(vB, wB, it + 1);
            GT_COMPV(vA, wA);
            if (it + 2 < nit) GT_LOADV(vA, wA, it + 2);
            GT_COMPV(vB, wB);
            f32x2 t4[4], t2[2], t1;
#pragma unroll
            for (int i = 0; i < 4; ++i) { const f32x2 snd = (s & 4) ? acc2[i] : acc2[i + 4], kp = (s & 4) ? acc2[i + 4] : acc2[i];
                t4[i] = kp + (f32x2){xchg32(snd.x, lane), xchg32(snd.y, lane)}; }
#pragma unroll
            for (int i = 0; i < 2; ++i) { const f32x2 snd = (s & 2) ? t4[i] : t4[i + 2], kp = (s & 2) ? t4[i + 2] : t4[i];
                t2[i] = kp + (f32x2){xchg16(snd.x, lane), xchg16(snd.y, lane)}; }
            { const f32x2 snd = (s & 1) ? t2[0] : t2[1], kp = (s & 1) ? t2[1] : t2[0]; t1 = kp + (f32x2){dppmov<DPP_ROR8>(snd.x), dppmov<DPP_ROR8>(snd.y)}; }
            { GT_ITEM(it); (void)hf_; const int r_ = GT_ROW(k_);
              const int col = cb_ * 128 + j * 16 + 2 * s; float* xp = XS + (size_t)r_ * DM + col; const float* g2 = modl + (size_t)mod_sel(r_) * 12288 + 5 * DM + col;
#if defined(DBG_CHECK) && (DBG_CHECK == 3 || DBG_CHECK == 4)
              if (((r_ - 300) & 63) == 0 && r_ >= 300 && r_ < 300 + 64 * 128) { float* dbgo = WSP(float, WS_MQ) + (size_t)r_ * DM + col; dbgo[0] = t1.x; dbgo[1] = t1.y; }
#endif
              const f32x2 x = *(const f32x2*)xp, g = *(const f32x2*)g2;
              *(f32x2*)xp = x + pscale * g * t1; }
        }
    }
#undef GT_LOADV
#undef GT_COMPV
#undef GT_ITEM
#undef GT_ROW
}
__device__ __forceinline__ void phase_final_norm(const Ctx& C) {
    const float* XS = WSP(float, WS_XS); const float* fg = INP(I_FG);
    for (int q = C.bid * 8 + C.wid; q < NBATCH * SEQ; q += C.G * 8) {
        const int b = q / SEQ, t = q % SEQ; const float* xr = XS + ((size_t)b * RPB + CTXL + t) * DM; float* op = C.out + (size_t)q * DM;
        f32x4 v[8]; float ss = 0.f;
#pragma unroll
        for (int c = 0; c < 8; ++c) { v[c] = *(const f32x4*)(xr + c * 256 + C.lane * 4); ss += v[c][0] * v[c][0] + v[c][1] * v[c][1] + v[c][2] * v[c][2] + v[c][3] * v[c][3]; }
        ss = wave_sum(ss); const float rs = rsqrtf(ss * (1.0f / DM) + NORM_EPS);
#pragma unroll
        for (int c = 0; c < 8; ++c) { const f32x4 g = *(const f32x4*)(fg + c * 256 + C.lane * 4); *(f32x4*)(op + c * 256 + C.lane * 4) = v[c] * rs * g; }
    }
}


__device__ __forceinline__ void phase_vt8(const Ctx& C) {
    const bf16_t* P = WSP(bf16_t, WS_P); const bf16_t* MKV = WSP(bf16_t, WS_MKV);
    const int dv = C.tid & 127, kq = C.tid >> 7, g = kq >> 1, j0 = (kq & 1) * 16;
    constexpr int NU_A = NBATCH * 2 * NCH, NU_M = NBATCH * 8 * NCH;
    for (int u = C.bid; u < NU_A + NU_M; u += C.G) {
        const bool gqa = u < NU_A; const int v = gqa ? u : u - NU_A; const int nh = gqa ? 2 : 8;
        const int b = v / (nh * NCH), h = (v / NCH) % nh, t = v % NCH; const size_t r0 = (size_t)b * RPB + t * 64;
        const bf16_t* src = gqa ? P + r0 * NP + C_AV + h * 128 + dv : MKV + r0 * 2048 + h * 256 + 128 + dv; const size_t ld = gqa ? NP : 2048;
        float x[16];
#pragma unroll
        for (int jj = 0; jj < 16; ++jj) x[jj] = bf2f(src[(size_t)att::vt8_key(g, j0 + jj) * ld]);
        u32x4 w; w.x = (unsigned)att::pk4_fp8(x[0], x[1], x[2], x[3]); w.y = (unsigned)att::pk4_fp8(x[4], x[5], x[6], x[7]); w.z = (unsigned)att::pk4_fp8(x[8], x[9], x[10], x[11]); w.w = (unsigned)att::pk4_fp8(x[12], x[13], x[14], x[15]);
        unsigned char* dst = C.ws + (gqa ? WS_VT8A : WS_VT8M) + ((size_t)(b * nh + h) * NCH + t) * 8192 + dv * 64 + kq * 16;
        *(u32x4*)dst = w;
    }
}
template <int TYPE  , int VAR = 0> __device__ __forceinline__ void attn_units(const Ctx& C, bool need_ctx) {
    const bf16_t* P = WSP(bf16_t, WS_P);
    const int nu = need_ctx ? 528 : 512;
#pragma unroll 1
    for (int u = C.bid; u < nu; u += C.G) {
        int bh, qb; if (u < 512) { bh = (u >> 8) * 8 + (u & 7); qb = ((u & 255) >> 3) + 1; } else { bh = u - 512; qb = 0; }
        const int b = bh >> 3, h = bh & 7; const size_t rq = (size_t)b * RPB + (size_t)qb * 256, rk = (size_t)b * RPB; const int seq = qb == 0 ? CTXL : RPB;
        __syncthreads();
        if constexpr (TYPE == 1) {
            att::attn_body88<128>(P + rq * NP + C_AQ + h * 128, NP, C.ws + WS_AK8 + rk * 256 + (h >> 2) * 128, 256, nullptr, 0, C.ws + WS_VT8A + (size_t)(b * 2 + (h >> 2)) * NCH * 8192,
                                  C.ws + WS_OA + rq * 1024 + h * 128, 1024, seq, false, 0, nullptr, (char*)C.lds, C.tid);
        } else {
            const bf16_t* MQ = WSP(bf16_t, WS_MQ);
            att::attn_body88<192>(MQ + rq * 1536 + h * 192, 1536, C.ws + WS_KN8 + rk * 1024 + h * 128, 1024, C.ws + WS_KR8 + rk * 64, 64, C.ws + WS_VT8M + (size_t)(b * 8 + h) * NCH * 8192,
                                  C.ws + WS_OM + rq * 1024 + h * 128, 1024, seq, qb > 0, (qb - 1) * 256, WSP(float, WS_TABM), (char*)C.lds, C.tid);
        }
    }
    __syncthreads();
}

constexpr int LDS_BYTES = 163840, LDS_BAR_OFF = LDS_BYTES - 16;
constexpr int N_PHASES = 26;
template <int K> __device__ __forceinline__ void run_phase(const Ctx& C0, int l) {
    const Ctx C = launder(C0);
    const float* modl = WSP(float, WS_MODV) + (size_t)l * 3 * 12288;
    if constexpr (K == 0) { phase_modv(C); phase_tables(C); __syncthreads(); phase_cvt_mixer_weights(C, 0); }
    if constexpr (K == 1) {
        if (l == 0) phase_norm_mod<true, true>(C, INP(I_N1G), modl, 0, DM);
        else { phase_norm_mod<false, true>(C, INP(I_N1G) + l * DM, modl, 0, DM); __syncthreads(); phase_cvt_mixer_weights(C, l); }
    }
    if constexpr (K == 2) {
        pg8::Gemm g{WSP(bf16_t, WS_HB), WSP(bf16_t, WS_WIN), TT, NP, DM, DM, DM}; pg8::WinOrder S; S.init(C.G, C.bid, l + 1 < DEPTH);
        pg8::EpiStoreBf16S E{WSP(bf16_t, WS_P), NP, WSP(float, WS_WINS)};
        pg8::gemm_phase<pg8::EpiStoreBf16S, pg8::WinOrder, 1>(C.lds, C.tid, g, S, E);
    }
    if constexpr (K == 3) phase_post_p(C, l);
    if constexpr (K == 4) {
        { pg8::Gemm g{WSP(bf16_t, WS_P) + C_MCQ, WSP(bf16_t, WS_WUQ), TT, 1536, 512, NP, 512}; pg8::StaticOrder S; S.init(TT, 1536, C.G, C.bid);
          pg8::EpiStoreBf16 E{WSP(bf16_t, WS_MQ), 1536}; pg8::gemm_phase(C.lds, C.tid, g, S, E); }
        { pg8::Gemm g{WSP(bf16_t, WS_P) + C_MCKV, WSP(bf16_t, WS_WUKV), TT, 2048, 512, NP, 512}; pg8::StaticOrder S; S.init(TT, 2048, C.G, (C.bid + C.G - 140 % C.G) % C.G);
          pg8::EpiStoreMKV E{WSP(bf16_t, WS_MKV), C.ws + WS_KN8}; pg8::gemm_phase(C.lds, C.tid, g, S, E); }
        { const Ctx C2 = launder(C0); phase_gla_local(C2, l, 156); }
#ifdef DBG_DUP_GLALOCAL
        { const Ctx C2 = launder(C0); __syncthreads(); phase_gla_local(C2, l, 156); }
#endif
    }
    if constexpr (K == 5) { phase_gla_scan(C); { const Ctx C2 = launder(C0); phase_vt8(C2); } }
    if constexpr (K == 6) {
#ifdef DBG_ATTVAR
        { const Ctx Cx = launder(C0); attn_units<0, DBG_ATTVAR>(Cx, l + 1 < DEPTH); } { const Ctx Cx = launder(C0); attn_units<1, DBG_ATTVAR>(Cx, l + 1 < DEPTH); } __syncthreads();
#endif
        attn_units<0>(C, l + 1 < DEPTH); { const Ctx C2 = launder(C0); attn_units<1>(C2, l + 1 < DEPTH); } { const Ctx C3 = launder(C0); phase_gla_out(C3, l, 128); }
#ifdef DBG_DUP_GLAOUT
        { const Ctx C3 = launder(C0); __syncthreads(); phase_gla_out(C3, l, 128); }
#endif
    }
    if constexpr (K == 7) {
        const bf16_t* P = WSP(bf16_t, WS_P); bf16_t* Y = WSP(bf16_t, WS_Y);
        const pg8::Gemm ga{WSP(bf16_t, WS_OA), WSP(bf16_t, WS_WBR), TT, DM, 1024, 1024, 1024}, gl{WSP(bf16_t, WS_OL), (const bf16_t*)(C.ws + WS_WBR + (size_t)2048 * 1024), TT, DM, 1024, 1024, 1024},
                        gm{WSP(bf16_t, WS_OM), (const bf16_t*)(C.ws + WS_WBR + (size_t)2 * 2048 * 1024), TT, DM, 1024, 1024, 1024};
        unsigned char* Y8 = C.ws + WS_HB;
        const float* wbs = WSP(float, WS_WBRS);
        const pg8::EpiGate<true> Ea{Y, P + C_GA, nullptr, wbs}; const pg8::EpiGate<false> El{Y, P + C_GL, nullptr, wbs + DM}; const pg8::EpiGate<false, true> Em{Y, P + C_GM, Y8, wbs + 2 * DM};
        pg8::StaticOrder S; S.init(TT, DM, C.G, C.bid, l + 1 >= DEPTH);
        pg8::gemm_phase<pg8::EpiGate<true>, pg8::StaticOrder, 1>(C.lds, C.tid, ga, S, Ea); pg8::gemm_phase<pg8::EpiGate<false>, pg8::StaticOrder, 1>(C.lds, C.tid, gl, S, El);
        pg8::gemm_phase<pg8::EpiGate<false, true>, pg8::StaticOrder, 1>(C.lds, C.tid, gm, S, Em);
        if (l == 0) { const Ctx C2 = launder(C0); phase_cvt_peer_tables(C2, 0, 0, NEXP, S.nwg % C.G); }
    }
    if constexpr (K == 8) {
        pg8::Gemm g{WSP(bf16_t, WS_HB), WSP(bf16_t, WS_WOUT), TT, DM, DM, DM, DM};
        const pg8::EpiResidT<true> E{WSP(float, WS_XS), DM, modl + 2 * DM, WSP(float, WS_WOUTS)};
        pg8::StaticOrder S; S.init(TT, DM, C.G, C.bid, l + 1 >= DEPTH);
        pg8::gemm_phase<pg8::EpiResidT<true>, pg8::StaticOrder, 1>(C.lds, C.tid, g, S, E);
        if (l == 0 && DEPTH > 1) { const Ctx C2 = launder(C0); phase_cvt_peer_tables(C2, 1, 0, NEXP / 2, S.nwg % C.G); }
    }
    if constexpr (K == 9) phase_norm_mod<false>(C, INP(I_N2G) + l * DM, modl, 3 * DM, 4 * DM);
    if constexpr (K == 10) {
        pg8::Gemm g{WSP(bf16_t, WS_HB), WSP(bf16_t, WS_WQ), TT, DM, DM, DM, DM};
        pg8::EpiStoreBf16 E{WSP(bf16_t, WS_PQ), DM};
        pg8::StaticOrder S; S.init(TT, DM, C.G, C.bid, l + 1 >= DEPTH); pg8::gemm_phase(C.lds, C.tid, g, S, E);
        if (l == 0 && DEPTH > 1) { const Ctx C2 = launder(C0); phase_cvt_peer_tables(C2, 1, NEXP / 2, NEXP, S.nwg % C.G); }
    }
    if constexpr (K == 11) phase_peer_select(C, l + 1 >= DEPTH);
    if constexpr (K == 13) phase_final_norm(C);
    if constexpr (K == 12) {
#ifdef DBG_DUP12
        if (l + 1 < DEPTH) phase_peer_gather<false>(C, modl, 0.0f); else phase_peer_gather<true>(C, modl, 0.0f);
        __syncthreads();
#endif
        if (l + 1 < DEPTH) phase_peer_gather<false>(C, modl, DBG_PEER0); else phase_peer_gather<true>(C, modl, DBG_PEER1); }
}
__device__ __forceinline__ Ctx make_ctx(const Args& args, unsigned char* lds_raw) {
    Ctx C0; C0.in = (const __attribute__((address_space(4))) cfp_t*)__builtin_amdgcn_kernarg_segment_ptr(); C0.out = args.out; C0.ws = args.ws; C0.lds = (LAS unsigned char*)lds_raw;
    C0.tid = threadIdx.x; C0.lane = C0.tid & 63; C0.wid = __builtin_amdgcn_readfirstlane(C0.tid >> 6); C0.G = gridDim.x; C0.bid = blockIdx.x;
    return C0;
}
template <int K> __global__ void __launch_bounds__(NTHREADS, 2) k_one(Args args) {
    extern __shared__ __attribute__((aligned(16))) unsigned char lds_raw[];
    const Ctx C0 = make_ctx(args, lds_raw);
    run_phase<K>(C0, args.ph_lo);
}
#if MK_N_LAUNCHES == 1 || defined(DBG_HYB)
__global__ void __launch_bounds__(NTHREADS, 2) mk_fwd(Args args) {
    extern __shared__ __attribute__((aligned(16))) unsigned char lds_raw[];
    const Ctx C0 = make_ctx(args, lds_raw);
    if (C0.tid < 4) ((LAS unsigned*)(C0.lds + LDS_BAR_OFF))[C0.tid] = 0u;
    __syncthreads();
    const int lo = args.ph_lo, hi = args.ph_hi;
    XcdBarrier bar; bar.bar = (unsigned*)(args.ws + WS_CTL); bar.x = 0; bar.st = nullptr;
    if (hi - lo > 1) bar = xcd_barrier_post((unsigned*)(args.ws + WS_CTL), (volatile LAS unsigned*)(C0.lds + LDS_BAR_OFF));
#define IN(k) (lo <= (k) && (k) < hi)
#define SEAM(k) do { if (IN(k) && IN((k) + 1)) xcd_barrier(bar); } while (0)
#ifndef DBG_DUP
#define DBG_DUP -1
#endif
#define PH(K, k) do { if (IN(k)) { run_phase<K>(C0, l); if (K == DBG_DUP) { xcd_barrier(bar); run_phase<K>(C0, l); } } SEAM(k); } while (0)
    { const int l = 0; PH(0, 0); }
#pragma unroll 1
    for (int l = 0; l < DEPTH; ++l) {
        const int pb = 1 + 12 * l;
        PH(1, pb + 0); PH(2, pb + 1); PH(3, pb + 2); PH(4, pb + 3); PH(5, pb + 4); PH(6, pb + 5);
        PH(7, pb + 6); PH(8, pb + 7); PH(9, pb + 8); PH(10, pb + 9); PH(11, pb + 10); PH(12, pb + 11);
    }
    { const int l = DEPTH - 1; PH(13, 1 + 12 * DEPTH); }
#undef PH
#undef IN
#undef SEAM
}
#define MAIN_KERNEL mk_fwd
#else
#define MAIN_KERNEL k_one<6>
#endif


#ifdef DBG_PROBE
typedef int i32x8 __attribute__((ext_vector_type(8)));
__device__ __forceinline__ unsigned char fp8_of_int(int v) {
    const float f = (float)v; return (unsigned char)(__builtin_amdgcn_cvt_pk_fp8_f32(f, 0.f, 0, false) & 0xff); }
__global__ void k_probe_mx(unsigned* slot) {
    const int l = threadIdx.x, r = l & 31, g = l >> 5;
    i32x8 A, B;
    for (int j = 0; j < 8; ++j) { unsigned wa = 0, wb = 0;
        for (int b = 0; b < 4; ++b) { const int k = g * 32 + 4 * j + b;
            wa |= (unsigned)fp8_of_int(((3 * r + k) % 7) - 3) << (8 * b); wb |= (unsigned)fp8_of_int(((5 * k + 2 * r) % 9) - 4) << (8 * b); }
        A[j] = (int)wa; B[j] = (int)wb; }
    f32x16 c = {};
    c = __builtin_amdgcn_mfma_scale_f32_32x32x64_f8f6f4(A, B, c, 0, 0, 0, 0x7f7f7f7f, 0, 0x7f7f7f7f);
    float worst = 0.f;
    for (int i = 0; i < 16; ++i) { const int m = (i & 3) + 8 * (i >> 2) + 4 * g, n = r; float ref = 0.f; for (int k = 0; k < 64; ++k) ref += (float)(((3 * m + k) % 7) - 3) * (float)(((5 * k + 2 * n) % 9) - 4);
        worst = fmaxf(worst, fabsf(c[i] - ref)); }
    for (int o = 32; o >= 1; o >>= 1) worst = fmaxf(worst, __shfl_xor(worst, o));
    if (l == 0) { const float code = worst == 0.f ? 0.4f : 1.2f; *slot = __float_as_uint(powf(10.f, code / 0.25f - 4.f)); }
}
#endif
#ifdef DBG_CHECK
__device__ __forceinline__ void dbg_report(unsigned* slot, float err) { if (!(err <= 3e38f)) err = 1e30f; atomicMax(slot, __float_as_uint(err)); }
__global__ void k_check_gemm(const bf16_t* A, int lda, const float* W, int K, int N, const bf16_t* Cm, int ldc, int M, unsigned* slot) {
    const unsigned id = blockIdx.x * blockDim.x + threadIdx.x; if (id >= 8192) return;
    const unsigned h = id * 2654435761u; const int row = (int)((h >> 8) % (unsigned)M), col = (int)((h * 40503u >> 7) % (unsigned)N);
    float ref = 0.f; for (int k = 0; k < K; ++k) ref += bf2f(A[(size_t)row * lda + k]) * W[(size_t)k * N + col];
    const float got = bf2f(Cm[(size_t)row * ldc + col]);
    dbg_report(slot, fabsf(got - ref) / (fabsf(ref) + 0.1f));
}

__global__ void k_check_attn(const unsigned char* ws, int type, unsigned* slot) {
    __shared__ float sc[RPB]; __shared__ float red[256]; __shared__ float qv[192];
    const int t = threadIdx.x, bh = blockIdx.x & 15, b = bh >> 3, h = bh & 7; const int qpos = (int)(((blockIdx.x >> 4) * 977u + 13u) % SEQ); const size_t rq = (size_t)b * RPB + CTXL + qpos, rk = (size_t)b * RPB;
    const bf16_t* P = (const bf16_t*)(ws + WS_P); const bf16_t* MQ = (const bf16_t*)(ws + WS_MQ); const bf16_t* MKV = (const bf16_t*)(ws + WS_MKV);
    const int dq = type ? 128 : 192;
    if (t < dq) { float v = type ? bf2f(P[rq * NP + C_AQ + h * 128 + t]) : bf2f(MQ[rq * 1536 + h * 192 + t]); qv[t] = v; }
    __syncthreads();
    if (!type && t < 32) {
        const int ri = qpos >> 6, ci = qpos & 63; const int i = t; const float pos = (float)(i < 16 ? ri : ci); const float inv = powf(10000.f, -(float)(i & 15) / 16.f); const float a = pos * inv;
        const float x1 = qv[128 + i], x2 = qv[160 + i]; qv[128 + i] = x1 * cosf(a) - x2 * sinf(a); qv[160 + i] = x2 * cosf(a) + x1 * sinf(a); }
    __syncthreads();
    const float scale = type ? 0.088388347648f : 0.0721687836487f;
    float mx = -1e30f;
    for (int k = t; k < RPB; k += 256) { float s = 0.f;
        if (type) { const bf16_t* kp = P + (rk + k) * NP + C_AK + (h >> 2) * 128; for (int d = 0; d < 128; ++d) s += qv[d] * bf2f(kp[d]); }
        else { const bf16_t* kp = MKV + (rk + k) * 2048 + h * 256; for (int d = 0; d < 128; ++d) s += qv[d] * bf2f(kp[d]); const bf16_t* kr = P + (rk + k) * NP + C_MKR; for (int d = 0; d < 64; ++d) s += qv[128 + d] * bf2f(kr[d]); }
        s *= scale; sc[k] = s; mx = fmaxf(mx, s); }
    red[t] = mx; __syncthreads(); for (int o = 128; o >= 1; o >>= 1) { if (t < o) red[t] = fmaxf(red[t], red[t + o]); __syncthreads(); } mx = red[0]; __syncthreads();
    float sum = 0.f; for (int k = t; k < RPB; k += 256) { const float p = __expf(sc[k] - mx); sc[k] = p; sum += p; }
    red[t] = sum; __syncthreads(); for (int o = 128; o >= 1; o >>= 1) { if (t < o) red[t] += red[t + o]; __syncthreads(); } sum = red[0]; __syncthreads();
    float e = 0.f, mag = 0.f;
    if (t < 128) { float o = 0.f; for (int k = 0; k < RPB; ++k) { const float vv = type ? bf2f(P[(rk + k) * NP + C_AV + (h >> 2) * 128 + t]) : bf2f(MKV[(rk + k) * 2048 + h * 256 + 128 + t]); o += sc[k] * vv; }
        o /= sum; const float got = __builtin_amdgcn_cvt_f32_fp8((int)(ws + (type ? WS_OA : WS_OM))[rq * 1024 + h * 128 + t], 0) * (1.0f / 32.0f); e = fabsf(got - o); mag = fabsf(o); }
    red[t] = e; __syncthreads(); for (int o = 128; o >= 1; o >>= 1) { if (t < o) red[t] = fmaxf(red[t], red[t + o]); __syncthreads(); } e = red[0]; __syncthreads();
    red[t] = mag; __syncthreads(); for (int o = 128; o >= 1; o >>= 1) { if (t < o) red[t] = fmaxf(red[t], red[t + o]); __syncthreads(); } mag = red[0];
    if (t == 0) dbg_report(slot, e / (mag + 1e-4f));
}
__global__ void __launch_bounds__(256) k_check_gla_rec(const unsigned char* ws, const float* wa_f, const float* ba_f, const float* wa_b, const float* ba_b, float* obuf, int b) {
    __shared__ float ad[128], kd[128], qd[128], lrs[16];
    const int e = threadIdx.x, h = blockIdx.x & 3, dir = blockIdx.x >> 2; const bf16_t* P = (const bf16_t*)(ws + WS_P);
    const float* wa = dir ? wa_b : wa_f; const float* ba = dir ? ba_b : ba_f;
    float S[128];
#pragma unroll
    for (int d = 0; d < 128; ++d) S[d] = 0.f;
    float* ob = obuf + ((size_t)(dir * 2 + b) * 4 + h) * RPB * 256;
    for (int st = 0; st < RPB; ++st) {
        int j; if (!dir) j = st; else j = st < CTXL ? CTXL - 1 - st : RPB - 1 - (st - CTXL);
        const size_t r = (size_t)b * RPB + j; const bf16_t* pr = P + r * NP;
        if (e < 16) lrs[e] = bf2f(pr[(dir ? C_LRB : C_LRF) + e]);
        __syncthreads();
        if (e < 128) { float pre = ba[h * 128 + e]; for (int q = 0; q < 16; ++q) pre += lrs[q] * wa[q * 512 + h * 128 + e];
            const float ls = (fminf(pre, 0.f) - log1pf(expf(-fabsf(pre)))) / 16.f; ad[e] = expf(ls); kd[e] = bf2f(pr[C_LK + h * 128 + e]); qd[e] = bf2f(pr[C_LQ + h * 128 + e]) * 0.088388347648f; }
        __syncthreads();
        const float v = bf2f(pr[C_LV + h * 256 + e]); float o = 0.f;
#pragma unroll
        for (int d = 0; d < 128; ++d) { S[d] = ad[d] * S[d] + kd[d] * v; o += qd[d] * S[d]; }
        ob[(size_t)j * 256 + e] = o;
        __syncthreads();
    }
}
__global__ void k_check_gla_cmp(const unsigned char* ws, const float* obuf, const float* gon, int b, unsigned* slot) {
    __shared__ float red[256];
    const int e = threadIdx.x, h = blockIdx.x & 3, j = blockIdx.x >> 2; const size_t r = (size_t)b * RPB + j; const bf16_t* P = (const bf16_t*)(ws + WS_P);
    const float o = obuf[((size_t)(0 * 2 + b) * 4 + h) * RPB * 256 + (size_t)j * 256 + e] + obuf[((size_t)(1 * 2 + b) * 4 + h) * RPB * 256 + (size_t)j * 256 + e];
    red[e] = o * o; __syncthreads(); for (int s_ = 128; s_ >= 1; s_ >>= 1) { if (e < s_) red[e] += red[e + s_]; __syncthreads(); }
    const float rs = rsqrtf(red[0] / 256.f + NORM_EPS); __syncthreads();
    const float gt = bf2f(P[r * NP + C_LG + h * 256 + e]); const float ref = o * rs * gon[e] * (gt / (1.f + expf(-gt)));
    const float got = __builtin_amdgcn_cvt_f32_fp8((int)(ws + WS_OL)[r * 1024 + h * 256 + e], 0);
    red[e] = fabsf(got - ref); __syncthreads(); for (int s_ = 128; s_ >= 1; s_ >>= 1) { if (e < s_) red[e] = fmaxf(red[e], red[e + s_]); __syncthreads(); }
    if (e == 0) dbg_report(slot, red[0] / 1.0f);
}

__global__ void k_check_gemm8(const unsigned char* A8, const float* W, int K, int N, const bf16_t* Cm, int ldc, int M, unsigned* slot) {
    const unsigned id = blockIdx.x * blockDim.x + threadIdx.x; if (id >= 8192) return;
    const unsigned h = id * 2654435761u; const int row = (int)((h >> 8) % (unsigned)M), col = (int)((h * 40503u >> 7) % (unsigned)N);
    float ref = 0.f, mag = 0.f; for (int k = 0; k < K; ++k) { const float a = __builtin_amdgcn_cvt_f32_fp8((int)A8[(size_t)row * K + k], 0), w = W[(size_t)k * N + col]; ref += a * w; mag += a * a * w * w; }
    const float got = bf2f(Cm[(size_t)row * ldc + col]);
    dbg_report(slot, fabsf(got - ref) / (sqrtf(mag) + 1e-3f));
}
__global__ void k_check_select(const bf16_t* PQ, const float* k1, const float* k2, const int* PIDX, const float* PG, unsigned* slot) {
    __shared__ float s1[128], s2[128]; __shared__ int cnt; __shared__ float selv[16];
    const int tok = (blockIdx.x >> 3) * 61 + 5, head = blockIdx.x & 7, t = threadIdx.x;
    if (t == 0) cnt = 0;
    for (int n = t; n < 128; n += 64) { float a = 0.f, b = 0.f; for (int d = 0; d < 128; ++d) { a += bf2f(PQ[(size_t)tok * DM + head * 256 + d]) * k1[((size_t)head * 128 + n) * 128 + d]; b += bf2f(PQ[(size_t)tok * DM + head * 256 + 128 + d]) * k2[((size_t)head * 128 + n) * 128 + d]; } s1[n] = a; s2[n] = b; }
    __syncthreads();
    if (t < 16) { const int id = PIDX[(size_t)tok * 128 + head * 16 + t]; selv[t] = (id >= 0 && id < 16384) ? s1[id >> 7] + s2[id & 127] : -1e30f; }
    __syncthreads();
    float thr = selv[0], mx = selv[0]; for (int k = 1; k < 16; ++k) { thr = fminf(thr, selv[k]); mx = fmaxf(mx, selv[k]); }
    int c = 0; for (int p = t; p < 16384; p += 64) if (s1[p >> 7] + s2[p & 127] > thr + 0.02f) ++c;
    atomicAdd(&cnt, c); __syncthreads();
    if (t == 0) { float den = 0.f; for (int k = 0; k < 16; ++k) den += __expf(selv[k] - mx); float e = fabsf((float)cnt - 15.f) / 15.f > 0.34f ? fabsf((float)cnt - 15.f) / 15.f : 0.f;
        for (int k = 0; k < 16; ++k) e = fmaxf(e, fabsf(PG[(size_t)tok * 128 + head * 16 + k] - __expf(selv[k] - mx) / den) * 4.f);
        for (int k = 0; k < 16; ++k) for (int k2_ = 0; k2_ < k; ++k2_) if (PIDX[(size_t)tok * 128 + head * 16 + k] == PIDX[(size_t)tok * 128 + head * 16 + k2_]) e = fmaxf(e, 10.f);
        dbg_report(slot, e); }
}
__global__ void k_check_gather(const bf16_t* HB, const float* u, const float* v, const int* PIDX, const float* PG, const float* dbgo, unsigned* slot) {
    __shared__ float w[128];
    const int tok = blockIdx.x * 64 + 300, t = threadIdx.x;
    for (int k = t; k < 128; k += 64) { const int id = PIDX[(size_t)tok * 128 + k] & 16383; float a = 0.f; for (int d = 0; d < DM; ++d) a += bf2f(HB[(size_t)tok * DM + d]) * u[(size_t)id * DM + d];
        w[k] = PG[(size_t)tok * 128 + k] * 0.5f * a * (1.0f + erff(a * 0.70710678f)); }
    __syncthreads();
    float e = 0.f, sc = 0.f;
    for (int d = t; d < DM; d += 64) { float o = 0.f; for (int k = 0; k < 128; ++k) o += w[k] * v[(size_t)(PIDX[(size_t)tok * 128 + k] & 16383) * DM + d];
        e = fmaxf(e, fabsf(o - dbgo[(size_t)tok * DM + d])); sc = fmaxf(sc, fabsf(o)); }
    for (int o_ = 32; o_ >= 1; o_ >>= 1) { e = fmaxf(e, __shfl_xor(e, o_)); sc = fmaxf(sc, __shfl_xor(sc, o_)); }
    if (t == 0) dbg_report(slot, e / (sc + 1e-6f));
}
__global__ void k_dbg_out2(const float* x, const float* fg, float* out, const unsigned* slot) {
    const float mx = __uint_as_float(*slot); float v = 0.25f * (log10f(fmaxf(mx, 1e-30f)) + 4.0f); v = fminf(fmaxf(v, 0.f), 9.f);
    const float f = 1.0f + v;
    const int lane = threadIdx.x & 63; const size_t r = (size_t)blockIdx.x * 4 + (threadIdx.x >> 6);
    const float* xr = x + r * DM; float ss = 0.f;
    for (int c = lane; c < DM; c += 64) ss += xr[c] * xr[c];
    ss = wave_sum(ss); const float rs = rsqrtf(ss / DM + NORM_EPS);
    for (int c = lane; c < DM; c += 64) out[r * DM + c] = xr[c] * rs * fg[c] * f;
}
#endif
#ifdef DBG_SCAN
__global__ void k_scan16(const bf16_t* p, size_t n, unsigned* flags, int stage) {
    unsigned bad = 0; for (size_t i = (size_t)blockIdx.x * blockDim.x + threadIdx.x; i < n; i += (size_t)gridDim.x * blockDim.x) bad |= ((p[i] & 0x7f80u) == 0x7f80u);
    if (bad) atomicOr(&flags[stage], 1u);
}
__global__ void k_scan32(const float* p, size_t n, unsigned* flags, int stage) {
    unsigned bad = 0; for (size_t i = (size_t)blockIdx.x * blockDim.x + threadIdx.x; i < n; i += (size_t)gridDim.x * blockDim.x) bad |= ((__float_as_uint(p[i]) & 0x7f800000u) == 0x7f800000u);
    if (bad) atomicOr(&flags[stage], 1u);
}
__global__ void k_dbg_out(const float* x, const float* fg, float* out, const unsigned* flags, int nstage) {
    int code = 0; for (int s = nstage; s >= 1; --s) if (flags[s]) code = s;
    const float f = 1.0f + 0.25f * (float)code;
    const int lane = threadIdx.x & 63; const size_t r = (size_t)blockIdx.x * 4 + (threadIdx.x >> 6);
    const float* xr = x + r * DM; float ss = 0.f;
    for (int c = lane; c < DM; c += 64) ss += xr[c] * xr[c];
    ss = wave_sum(ss); const float rs = rsqrtf(ss / DM + NORM_EPS);
    for (int c = lane; c < DM; c += 64) out[r * DM + c] = xr[c] * rs * fg[c] * f;
}
#endif
extern "C" void kernel_launch(void* const* d_in, const int* in_sizes, int n_in, void* d_out, int out_size, void* d_ws, size_t ws_size, hipStream_t stream) {
    static int grid = 0;
    if (grid == 0) {
        if (n_in != 30 || out_size != NBATCH * SEQ * DM || ws_size < WS_END) { fprintf(stderr, "kernel_launch: shape/workspace mismatch: n_in %d out %d ws %zu (need %zu)\n", n_in, out_size, ws_size, (size_t)WS_END); grid = -1; return; }
        int dev = 0, cus = 0, per_cu = 0;
        if (hipGetDevice(&dev) != hipSuccess || hipDeviceGetAttribute(&cus, hipDeviceAttributeMultiprocessorCount, dev) != hipSuccess) { grid = -1; return; }
        bool okattr = hipFuncSetAttribute((const void*)MAIN_KERNEL, hipFuncAttributeMaxDynamicSharedMemorySize, LDS_BYTES) == hipSuccess;
#if MK_N_LAUNCHES != 1
#ifdef DBG_HYB
        okattr = okattr && hipFuncSetAttribute((const void*)mk_fwd, hipFuncAttributeMaxDynamicSharedMemorySize, LDS_BYTES) == hipSuccess;
#endif
#define SETA(K) okattr = okattr && hipFuncSetAttribute((const void*)k_one<K>, hipFuncAttributeMaxDynamicSharedMemorySize, LDS_BYTES) == hipSuccess
        SETA(0); SETA(1); SETA(2); SETA(3); SETA(4); SETA(5); SETA(6); SETA(7); SETA(8); SETA(9); SETA(10); SETA(11); SETA(12); SETA(13);
#undef SETA
#endif
        if (!okattr) { fprintf(stderr, "kernel_launch: hipFuncSetAttribute failed\n"); grid = -1; return; }
        if (hipOccupancyMaxActiveBlocksPerMultiprocessor(&per_cu, (const void*)MAIN_KERNEL, NTHREADS, LDS_BYTES) != hipSuccess || per_cu < 1) { fprintf(stderr, "kernel_launch: occupancy query says %d blocks per CU\n", per_cu); grid = -1; (void)hipGetLastError(); return; }
        grid = cus;
    }
    if (grid < 0) return;
    if (hipMemsetAsync((char*)d_ws + WS_CTL, 0, CTL_BYTES, stream) != hipSuccess) return;
    Args a{};
    for (int i = 0; i < 30; ++i) a.in[i] = (const float*)d_in[i];
    a.out = (float*)d_out; a.ws = (unsigned char*)d_ws;
#if defined(DBG_PROBE)
    { unsigned* flags = (unsigned*)((char*)d_ws + WS_CTL + 32768);
      hipLaunchKernelGGL(k_probe_mx, dim3(1), dim3(64), 0, stream, flags + 100);
      hipLaunchKernelGGL(k_dbg_out2, dim3(NBATCH * SEQ / 4), dim3(256), 0, stream, (const float*)d_in[0], (const float*)d_in[29], (float*)d_out, flags + 100); }
#elif MK_N_LAUNCHES == 1 && defined(DBG_CHECK)
    {
        unsigned* flags = (unsigned*)((char*)d_ws + WS_CTL + 32768); char* W = (char*)d_ws;
        a.ph_lo = 0; a.ph_hi = (DBG_CHECK == 8) ? 3 : (DBG_CHECK >= 5) ? 7 : (DBG_CHECK == 1 ? 11 : (DBG_CHECK == 2 ? 12 : 13));
        hipLaunchKernelGGL(mk_fwd, dim3(grid), dim3(NTHREADS), LDS_BYTES, stream, a);
#if DBG_CHECK == 8
        hipLaunchKernelGGL(k_check_gemm8, dim3(32), dim3(256), 0, stream, (const unsigned char*)(W + WS_HB), (const float*)d_in[I_WIN], DM, IN_COLS, (const bf16_t*)(W + WS_P), NP, TT, flags + 100);
#elif DBG_CHECK == 5 || DBG_CHECK == 6
        hipLaunchKernelGGL(k_check_attn, dim3(16 * 24), dim3(256), 0, stream, (const unsigned char*)d_ws, DBG_CHECK == 5 ? 1 : 0, flags + 100);
#elif DBG_CHECK == 7
        { float* obuf = (float*)(W + WS_MQ);
          hipLaunchKernelGGL(k_check_gla_rec, dim3(8), dim3(256), 0, stream, (const unsigned char*)d_ws, (const float*)d_in[I_WA2F], (const float*)d_in[I_BAF], (const float*)d_in[I_WA2B], (const float*)d_in[I_BAB], obuf, 0);
          hipLaunchKernelGGL(k_check_gla_cmp, dim3(RPB * 4), dim3(256), 0, stream, (const unsigned char*)d_ws, (const float*)obuf, (const float*)d_in[I_ONG], 0, flags + 100); }
#elif DBG_CHECK == 1
        hipLaunchKernelGGL(k_check_gemm, dim3(32), dim3(256), 0, stream, (const bf16_t*)(W + WS_HB), DM, (const float*)d_in[I_PWQ], DM, DM, (const bf16_t*)(W + WS_PQ), DM, TT, flags + 100);
#elif DBG_CHECK == 2
        hipLaunchKernelGGL(k_check_select, dim3(256 * 8), dim3(64), 0, stream, (const bf16_t*)(W + WS_PQ), (const float*)d_in[I_PK1], (const float*)d_in[I_PK2], (const int*)(W + WS_PIDX), (const float*)(W + WS_PG), flags + 100);
#else
        hipLaunchKernelGGL(k_check_gather, dim3(128), dim3(64), 0, stream, (const bf16_t*)(W + WS_HB), (const float*)d_in[I_PU], (const float*)d_in[I_PV], (const int*)(W + WS_PIDX), (const float*)(W + WS_PG), (const float*)(W + WS_MQ), flags + 100);
#endif
        hipLaunchKernelGGL(k_dbg_out2, dim3(NBATCH * SEQ / 4), dim3(256), 0, stream, (const float*)d_in[0], (const float*)d_in[29], (float*)d_out, flags + 100);
    }
#elif MK_N_LAUNCHES == 1
#ifdef DBG_SPLIT
    for (int p = 0; p < N_PHASES; p += DBG_SPLIT) { a.ph_lo = p; a.ph_hi = p + DBG_SPLIT < N_PHASES ? p + DBG_SPLIT : N_PHASES; hipLaunchKernelGGL(mk_fwd, dim3(grid), dim3(NTHREADS), LDS_BYTES, stream, a); }
#else
    a.ph_lo = 0; a.ph_hi = N_PHASES;
    hipLaunchKernelGGL(mk_fwd, dim3(grid), dim3(NTHREADS), LDS_BYTES, stream, a);
#endif
#else
    a.ph_hi = 0;
#ifndef DBG_NLAUNCH
#define DBG_NLAUNCH 100
#endif
    int nl_ = 0;
#ifdef DBG_HYB
#define LAUNCH1(K, L) do { if (K == DBG_HYB) { a.ph_lo = 12 * (L) + (K); a.ph_hi = a.ph_lo + 1; hipLaunchKernelGGL(mk_fwd, dim3(grid), dim3(NTHREADS), LDS_BYTES, stream, a); a.ph_hi = 0; } else { a.ph_lo = (L); hipLaunchKernelGGL(k_one<K>, dim3(grid), dim3(NTHREADS), LDS_BYTES, stream, a); } } while (0)
#else
#define LAUNCH1(K, L) do { a.ph_lo = (L); if (nl_++ < DBG_NLAUNCH) { hipLaunchKernelGGL(k_one<K>, dim3(grid), dim3(NTHREADS), LDS_BYTES, stream, a); if (K == DBG_DUP) hipLaunchKernelGGL(k_one<K>, dim3(grid), dim3(NTHREADS), LDS_BYTES, stream, a); } } while (0)
#endif
#ifdef DBG_SCAN
    unsigned* flags = (unsigned*)((char*)d_ws + WS_CTL + 32768);
    char* W = (char*)d_ws;
#define S16(off, n, st) hipLaunchKernelGGL(k_scan16, dim3(1024), dim3(256), 0, stream, (const bf16_t*)(W + (off)), (size_t)(n), flags, st)
#define S32(off, n, st) hipLaunchKernelGGL(k_scan32, dim3(1024), dim3(256), 0, stream, (const float*)(W + (off)), (size_t)(n), flags, st)
    LAUNCH1(0, 0); S32(WS_MODV, 2 * 3 * 12288, 1);
    { const int l = 0;
      LAUNCH1(1, l); S16(WS_HB, (size_t)TT * DM, 2);
      LAUNCH1(2, l); S16(WS_P, (size_t)TT * NP, 3);
      LAUNCH1(3, l); S16(WS_P, (size_t)TT * NP, 4);
      LAUNCH1(4, l); S16(WS_MQ, (size_t)TT * 1536, 5); S16(WS_MKV, (size_t)TT * 2048, 5); S16(WS_GST, (size_t)2112 * 32768, 6); S32(WS_GDEC, (size_t)2112 * 128, 6);
      LAUNCH1(5, l); S16(WS_GST, (size_t)2112 * 32768, 7);
      LAUNCH1(6, l); S16(WS_OA, (size_t)TT * 1024, 8); S16(WS_OM, (size_t)TT * 1024, 9); S16(WS_OL, (size_t)TT * 1024, 10);
      LAUNCH1(7, l); S16(WS_Y, (size_t)TT * DM, 11);
      LAUNCH1(8, l); S32(WS_XS, (size_t)TT * DM, 12);
      LAUNCH1(9, l); S16(WS_HB, (size_t)TT * DM, 13);
      LAUNCH1(10, l); S16(WS_PQ, (size_t)TT * DM, 14);
      LAUNCH1(11, l); S32(WS_PG, (size_t)TT * 128, 15);
      LAUNCH1(12, l); S32(WS_XS, (size_t)TT * DM, 16);
    }
    hipLaunchKernelGGL(k_dbg_out, dim3(NBATCH * SEQ / 4), dim3(256), 0, stream, (const float*)d_in[0], (const float*)d_in[29], (float*)d_out, flags, 16);
#elif defined(DBG_CHECK)
    unsigned* flags = (unsigned*)((char*)d_ws + WS_CTL + 32768);
    char* W = (char*)d_ws;
    LAUNCH1(0, 0);
    { const int l = 0; LAUNCH1(1, l); LAUNCH1(2, l); LAUNCH1(3, l); LAUNCH1(4, l); LAUNCH1(5, l); LAUNCH1(6, l);
#if DBG_CHECK == 5 || DBG_CHECK == 6
      hipLaunchKernelGGL(k_check_attn, dim3(16 * 24), dim3(256), 0, stream, (const unsigned char*)d_ws, DBG_CHECK == 5 ? 1 : 0, flags + 100);
#endif
#if DBG_CHECK == 7
      { float* obuf = (float*)(W + WS_MQ);
        hipLaunchKernelGGL(k_check_gla_rec, dim3(8), dim3(256), 0, stream, (const unsigned char*)d_ws, (const float*)d_in[I_WA2F], (const float*)d_in[I_BAF], (const float*)d_in[I_WA2B], (const float*)d_in[I_BAB], obuf, 0);
        hipLaunchKernelGGL(k_check_gla_cmp, dim3(RPB * 4), dim3(256), 0, stream, (const unsigned char*)d_ws, (const float*)obuf, (const float*)d_in[I_ONG], 0, flags + 100); }
#endif
      LAUNCH1(7, l); LAUNCH1(8, l); LAUNCH1(9, l); LAUNCH1(10, l);
#if DBG_CHECK == 1
      hipLaunchKernelGGL(k_check_gemm, dim3(32), dim3(256), 0, stream, (const bf16_t*)(W + WS_HB), DM, (const float*)d_in[I_PWQ], DM, DM, (const bf16_t*)(W + WS_PQ), DM, TT, flags + 100);
#endif
      LAUNCH1(11, l);
#if DBG_CHECK == 2
      hipLaunchKernelGGL(k_check_select, dim3(256 * 8), dim3(64), 0, stream, (const bf16_t*)(W + WS_PQ), (const float*)d_in[I_PK1], (const float*)d_in[I_PK2], (const int*)(W + WS_PIDX), (const float*)(W + WS_PG), flags + 100);
#endif
      LAUNCH1(12, l);
#if DBG_CHECK == 3
      hipLaunchKernelGGL(k_check_gather, dim3(128), dim3(64), 0, stream, (const bf16_t*)(W + WS_HB), (const float*)d_in[I_PU], (const float*)d_in[I_PV], (const int*)(W + WS_PIDX), (const float*)(W + WS_PG), (const float*)(W + WS_MQ), flags + 100);
#endif
    }
    hipLaunchKernelGGL(k_dbg_out2, dim3(NBATCH * SEQ / 4), dim3(256), 0, stream, (const float*)d_in[0], (const float*)d_in[29], (float*)d_out, flags + 100);
#else
    LAUNCH1(0, 0);
    for (int l = 0; l < DEPTH; ++l) { LAUNCH1(1, l); LAUNCH1(2, l); LAUNCH1(3, l);
#ifdef DBG_DUP23
        LAUNCH1(2, l); LAUNCH1(3, l);
#endif
        LAUNCH1(4, l); LAUNCH1(5, l);
#ifdef DBG_DUP45
        LAUNCH1(4, l); LAUNCH1(5, l);
#endif
        LAUNCH1(6, l); LAUNCH1(7, l); LAUNCH1(8, l); LAUNCH1(9, l); LAUNCH1(10, l); LAUNCH1(11, l); LAUNCH1(12, l); }
    LAUNCH1(13, DEPTH - 1);
#endif
#undef LAUNCH1
#endif
    const hipError_t le = hipPeekAtLastError();
    if (le != hipSuccess) fprintf(stderr, "kernel_launch: launch failed: %s\n", hipGetErrorName(le));
}
```

```cpp
#include <hip/hip_runtime.h>
#include <cstdio>
#include <cstdint>

#ifndef MK_N_LAUNCHES
#ifndef DBG_DUP
#define DBG_DUP -1
#endif
#define MK_N_LAUNCHES 1
#endif

#ifndef DBG_MIX0
#define DBG_MIX0 1.0f
#define DBG_MIX1 1.0f
#define DBG_PEER0 1.0f
#define DBG_PEER1 1.0f
#endif
#ifndef MLA_NQR
#define MLA_NQR 4
#endif
#define LAS __attribute__((address_space(3)))
#define GLB __attribute__((address_space(1)))
typedef unsigned short bf16_t;
typedef short bf16x8 __attribute__((ext_vector_type(8)));
typedef short s16x4 __attribute__((ext_vector_type(4)));
typedef float f32x4 __attribute__((ext_vector_type(4)));
typedef float f32x2 __attribute__((ext_vector_type(2)));
typedef float f32x16 __attribute__((ext_vector_type(16)));
typedef unsigned u32x4 __attribute__((ext_vector_type(4)));
typedef unsigned u32x2 __attribute__((ext_vector_type(2)));
typedef __bf16 bf2_t __attribute__((ext_vector_type(2)));

constexpr int DM = 2048, NBATCH = 2, SEQ = 8192, CTXL = 256, DEPTH = 2;
constexpr int RPB = SEQ + CTXL;
constexpr int TT = NBATCH * RPB;
constexpr int IN_COLS = 11872, NP = 12032;
constexpr int C_AQ = 0, C_AK = 1024, C_AV = 1280, C_LQ = 1536, C_LK = 2048, C_LV = 2560, C_LG = 3584, C_LRF = 4608, C_LRB = 4624,
              C_MCQ = 4640, C_MCKV = 5152, C_MKR = 5664, C_GA = 5728, C_GL = 7776, C_GM = 9824;
constexpr int NCH = RPB / 64;
constexpr int NEXP = 16384;
constexpr float NORM_EPS = 1e-6f;
constexpr int NTHREADS = 512;

constexpr size_t al256(size_t x) { return (x + 255) / 256 * 256; }
constexpr size_t WS_CTL   = 0;
constexpr size_t CTL_BYTES = 65536;
constexpr size_t WS_MODV  = WS_CTL + CTL_BYTES;
constexpr size_t WS_TABA  = al256(WS_MODV + (size_t)2 * 3 * 12288 * 4);
constexpr size_t WS_TABM  = WS_TABA + 2 * 128 * 32 * 4;
constexpr size_t WS_XS    = al256(WS_TABM + 2 * 128 * 16 * 4);
constexpr size_t WS_HB    = WS_XS + (size_t)TT * DM * 4;
constexpr size_t WS_P     = WS_HB + (size_t)TT * DM * 2;
constexpr size_t WS_MQ    = WS_P + (size_t)TT * NP * 2;
constexpr size_t WS_MKV   = WS_MQ + (size_t)TT * 1536 * 2;
constexpr size_t WS_OA    = WS_MKV + (size_t)TT * 2048 * 2;
constexpr size_t WS_OL    = WS_OA + (size_t)TT * 1024 * 2;
constexpr size_t WS_OM    = WS_OL + (size_t)TT * 1024 * 2;
constexpr size_t WS_WIN   = WS_OM + (size_t)TT * 1024 * 2;
constexpr size_t WS_WUQ   = WS_WIN + (size_t)NP * 2048 * 2;
constexpr size_t WS_WUKV  = WS_WUQ + (size_t)1536 * 512 * 2;
constexpr size_t WS_WBR   = WS_WUKV + (size_t)2048 * 512 * 2;
constexpr size_t WS_WOUT  = WS_WBR + (size_t)3 * 2048 * 1024 * 2;
constexpr size_t WS_WQ    = WS_WOUT + (size_t)2048 * 2048 * 2;
constexpr size_t WS_K1    = WS_WQ + (size_t)2048 * 2048 * 2;
constexpr size_t WS_K2    = WS_K1 + (size_t)8 * 128 * 128 * 2;
constexpr size_t WS_GST   = WS_K2 + (size_t)8 * 128 * 128 * 2;
constexpr size_t WS_GDEC  = WS_GST + (size_t)NBATCH * 2 * 4 * NCH * 32768 * 2;
constexpr size_t WS_END0  = WS_GDEC + (size_t)NBATCH * 2 * 4 * NCH * 128 * 4;
constexpr size_t WS_KN8   = WS_OA + (size_t)TT * 1024;
constexpr size_t WS_AK8   = WS_OL + (size_t)TT * 1024;
constexpr size_t WS_KR8   = WS_AK8 + (size_t)TT * 256;
constexpr size_t WS_VT8A  = WS_KR8 + (size_t)TT * 64;
constexpr size_t WS_VT8M  = WS_OM + (size_t)TT * 1024;
constexpr size_t WS_Y     = WS_MKV;
constexpr size_t WS_PQ    = WS_OA;
constexpr size_t WS_PIDX  = WS_P;
constexpr size_t WS_PG    = WS_PIDX + (size_t)TT * 128 * 4;
constexpr size_t PT_BYTES = 2 * (size_t)NEXP * DM + 2 * (size_t)NEXP * 4;
constexpr size_t WS_WINS  = WS_END0;
constexpr size_t WS_WOUTS = al256(WS_WINS + (size_t)NP * 4);
constexpr size_t WS_WBRS  = al256(WS_WOUTS + (size_t)DM * 4);
constexpr size_t WS_PT    = al256(WS_WBRS + (size_t)3 * DM * 4);
constexpr size_t WS_END   = WS_PT + DEPTH * PT_BYTES;
constexpr size_t PT_U8 = 0, PT_V8 = (size_t)NEXP * DM, PT_SCU = 2 * (size_t)NEXP * DM, PT_SCV = PT_SCU + (size_t)NEXP * 4;
static_assert(WS_PG + (size_t)TT * 128 * 4 <= WS_MQ, "PEER alias region overflows P");

__device__ __forceinline__ unsigned cvt_pk_bf16(float lo, float hi) { bf2_t v; v.x = (__bf16)lo; v.y = (__bf16)hi; return __builtin_bit_cast(unsigned, v); }
__device__ __forceinline__ bf16_t f2bf(float f) { return (bf16_t)(cvt_pk_bf16(f, 0.f) & 0xffffu); }
__device__ __forceinline__ float bf2f(bf16_t b) { return __uint_as_float(((unsigned)b) << 16); }
__device__ __forceinline__ float bflo(unsigned w) { return __uint_as_float(w << 16); }
__device__ __forceinline__ float bfhi(unsigned w) { return __uint_as_float(w & 0xffff0000u); }
__device__ __forceinline__ float xchg32(float x, int lane) { auto r = __builtin_amdgcn_permlane32_swap(__float_as_uint(x), __float_as_uint(x), false, false); return __uint_as_float(lane < 32 ? r[1] : r[0]); }
__device__ __forceinline__ float xchg16(float x, int lane) { auto r = __builtin_amdgcn_permlane16_swap(__float_as_uint(x), __float_as_uint(x), false, false); return __uint_as_float((lane & 16) ? r[0] : r[1]); }
template <int CTRL> __device__ __forceinline__ float dppmov(float x) { return __uint_as_float(__builtin_amdgcn_update_dpp(0u, __float_as_uint(x), CTRL, 0xF, 0xF, false)); }
constexpr int DPP_ROR8 = 0x128, DPP_HMIRROR = 0x141, DPP_Q3210 = 0x1B, DPP_Q1032 = 0xB1;
__device__ __forceinline__ float wave_sum(float v) {
    const int lane = threadIdx.x & 63;
    v += xchg32(v, lane); v += xchg16(v, lane); v += dppmov<DPP_ROR8>(v); v += dppmov<DPP_HMIRROR>(v); v += dppmov<DPP_Q3210>(v); v += dppmov<DPP_Q1032>(v);
    return v;
}
__device__ __forceinline__ float sigmoidf_(float x) { return __builtin_amdgcn_rcpf(1.0f + __expf(-x)); }
__device__ __forceinline__ float siluf_(float x) { return x * __builtin_amdgcn_rcpf(1.0f + __expf(-x)); }

#define XB_TMO      128
#define XB_XCNT(j)  (256  + 64 * (j))
#define XB_XSUB(j)  (1280 + 64 * (j))
#define XB_XGEN(j)  (2304 + 64 * (j))
#define XB_TOP      3328
#define XB_TOPGEN   3392
#define XCD_BAR_WORDS 3456
#define XB_SPIN_CAP (1u << 20)
__device__ __forceinline__ unsigned xb_ld(unsigned* p)              { return __hip_atomic_load(p, __ATOMIC_RELAXED, __HIP_MEMORY_SCOPE_AGENT); }
__device__ __forceinline__ unsigned xb_add(unsigned* p, unsigned v) { return __hip_atomic_fetch_add(p, v, __ATOMIC_RELAXED, __HIP_MEMORY_SCOPE_AGENT); }
__device__ __forceinline__ unsigned xb_xcc_id() { return (unsigned)__builtin_amdgcn_s_getreg((3 << 11) | 20) & 0xFu; }
#define XB_SPIN(cond, bar) do { unsigned _sp = 0; while (cond) { __builtin_amdgcn_s_sleep(1); \
    if ((++_sp & 255u) == 0u) { if (xb_ld(&(bar)[XB_TMO])) break; if (_sp > XB_SPIN_CAP) { atomicAdd(&(bar)[XB_TMO], 1u); break; } } } } while (0)
struct XcdBarrier { unsigned* bar; unsigned x; volatile LAS unsigned* st; };
__device__ __forceinline__ XcdBarrier xcd_barrier_post(unsigned* bar, volatile LAS unsigned* st) {
    XcdBarrier b; b.bar = bar; b.x = xb_xcc_id(); b.st = st;
    if (threadIdx.x == 0) (void)xb_add(&bar[XB_XCNT(b.x)], 1u);
    return b;
}
__device__ __forceinline__ void xcd_barrier_complete(unsigned* bar, unsigned x, unsigned& nloc, unsigned& nx) {
    const unsigned G = gridDim.x * gridDim.y * gridDim.z;
    unsigned sum, cnt, mine, sp = 0u;
    for (;;) {
        sum = 0u; cnt = 0u; mine = 0u;
#pragma unroll
        for (unsigned j = 0; j < 16; ++j) { const unsigned c = xb_ld(&bar[XB_XCNT(j)]); sum += c; cnt += (c > 0u) ? 1u : 0u; mine = (j == x) ? c : mine; }
        if (sum == G) break;
        __builtin_amdgcn_s_sleep(1);
        if ((++sp & 255u) == 0u) { if (xb_ld(&bar[XB_TMO])) break; if (sp > XB_SPIN_CAP) { atomicAdd(&bar[XB_TMO], 1u); break; } }
    }
    nloc = mine > 0u ? mine : 1u; nx = cnt > 0u ? cnt : 1u;
}
__device__ __forceinline__ void xcd_barrier(const XcdBarrier& b) {
    asm volatile("s_waitcnt vmcnt(0)" ::: "memory");
    __syncthreads();
    if (threadIdx.x == 0) {
        unsigned* bar = b.bar;
        __builtin_amdgcn_s_waitcnt(0);
        unsigned nloc = b.st[0], nx = b.st[1];
        if (nloc == 0u) { xcd_barrier_complete(bar, b.x, nloc, nx); b.st[0] = nloc; b.st[1] = nx; }
        const unsigned old = xb_add(&bar[XB_XSUB(b.x)], 1u);
        const unsigned gen = old / nloc;
        if (old + 1u == (gen + 1u) * nloc) {
            __builtin_amdgcn_fence(__ATOMIC_RELEASE, "agent");
            asm volatile("s_waitcnt vmcnt(0)" ::: "memory");
            const unsigned og = xb_add(&bar[XB_TOP], 1u);
            const unsigned tg = og / nx;
            if (og + 1u == (tg + 1u) * nx) xb_add(&bar[XB_TOPGEN], 1u);
            else XB_SPIN(xb_ld(&bar[XB_TOPGEN]) == tg, bar);
            __builtin_amdgcn_fence(__ATOMIC_ACQUIRE, "agent");
            xb_add(&bar[XB_XGEN(b.x)], 1u);
            asm volatile("s_waitcnt vmcnt(0)" ::: "memory");
        } else {
            XB_SPIN(xb_ld(&bar[XB_XGEN(b.x)]) == gen, bar);
            __builtin_amdgcn_fence(__ATOMIC_ACQUIRE, "agent");
            asm volatile("s_waitcnt vmcnt(0)" ::: "memory");
        }
    }
    __syncthreads();
}

namespace pg8 {
constexpr int BM = 256, BK = 64, HALF = 128, HTB = HALF * BK * 2, STAGE_BYTES = 8 * HTB, NXCD = 8, WGM = 8;
__host__ __device__ __forceinline__ int lds_byte(int r, int c) { const int st = (r >> 4) * 2 + (c >> 5), rr = r & 15, cc = c & 31, ob = rr * 64 + cc * 2; return st * 1024 + (ob ^ (((ob >> 9) & 1) << 5)); }
__host__ __device__ __forceinline__ void stage_rc(int b, int& R, int& C) { const int st = b / 1024, sb = b % 1024, swz = sb ^ (((sb >> 9) & 1) << 5); R = (st >> 1) * 16 + swz / 64; C = (st & 1) * 32 + (swz % 64) / 2; }
__host__ __device__ __forceinline__ int perm32(int rho) { const int n = rho >> 4, i = rho & 15; return 8 * (i >> 2) + 4 * n + (i & 3); }
struct Unit { int pm, pn; };
struct Gemm { const bf16_t* A; const bf16_t* Bt; int M, N, K, lda, ldb; };
struct StaticOrder {
    int nM, nN, nwg, G, c, latent;
    __host__ __device__ void init(int M, int N, int G_, int c_, int latent_ = 0) { latent = latent_; nM = latent_ ? 64 : M / BM; nN = N / BM; nwg = nM * nN; G = G_; c = c_; }
    __host__ __device__ bool next(int i, Unit& u) const {
        const long L = (long)i * G + c; if (L >= nwg) return false;
        int wgid = (int)L; { const int q = nwg / NXCD, r = nwg % NXCD, xcd = wgid % NXCD, off = wgid / NXCD; wgid = (xcd < r ? xcd * (q + 1) : r * (q + 1) + (xcd - r) * q) + off; }
        const int nig = WGM * nN, gid = wgid / nig, fm = gid * WGM, gsz = (nM - fm) < WGM ? (nM - fm) : WGM;
        u.pm = fm + ((wgid % nig) % gsz); u.pn = (wgid % nig) / gsz; if (latent) u.pm += 1 + (u.pm >= 32 ? 1 : 0); return true;
    }
};
struct WinOrder {
    StaticOrder S; int full, nlat, G, c;
    __host__ __device__ void init(int G_, int c_, int full_) { full = full_; G = G_; c = c_; S.init(TT, NP, G_, c_, full_ ? 0 : 1); nlat = S.nwg; }
    __host__ __device__ bool next(int i, Unit& u) const {
        if (full) return S.next(i, u);
        const long L = (long)i * G + c;
        if (L < nlat) return S.next(i, u);
        const int q = (int)(L - nlat); if (q >= 24) return false;
        const int t = q % 12; u.pm = q < 12 ? 0 : 33;
        u.pn = t < 2 ? 4 + t : (t < 8 ? 8 + (t - 2) : (t == 8 ? 18 : 20 + (t - 9)));
        return true;
    }
};
struct EpiStoreBf16 {
    static constexpr bool PERM = true;
    bf16_t* O; int ldc;
    __device__ __forceinline__ void operator()(const f32x4 (&acc)[2][2][4][2], const Unit& u, int wr, int wc, int fr, int fq) const {
        const int row0 = u.pm * BM + wr * 64 + fr, col0 = u.pn * BM + wc * 32 + 8 * fq;
#pragma unroll
        for (int ai = 0; ai < 2; ++ai)
#pragma unroll
            for (int m = 0; m < 4; ++m) { bf16_t* rowp = O + (size_t)(row0 + ai * HALF + m * 16) * ldc + col0;
#pragma unroll
                for (int bj = 0; bj < 2; ++bj) { const f32x4 v0 = acc[ai][bj][m][0], v1 = acc[ai][bj][m][1];
                    u32x4 w; w.x = cvt_pk_bf16(v0[0], v0[1]); w.y = cvt_pk_bf16(v0[2], v0[3]); w.z = cvt_pk_bf16(v1[0], v1[1]); w.w = cvt_pk_bf16(v1[2], v1[3]);
                    *(u32x4*)(rowp + bj * HALF) = w; } }
    }
};
struct EpiNull {
    static constexpr bool PERM = true;
    __device__ __forceinline__ void operator()(const f32x4 (&acc)[2][2][4][2], const Unit&, int, int, int, int) const {
#pragma unroll
        for (int a = 0; a < 2; ++a)
#pragma unroll
            for (int b = 0; b < 2; ++b)
#pragma unroll
                for (int m = 0; m < 4; ++m)
#pragma unroll
                    for (int n = 0; n < 2; ++n) asm volatile("" :: "v"(acc[a][b][m][n]));
    }
};
struct EpiStoreMKV {
    static constexpr bool PERM = true;
    bf16_t* O; unsigned char* K8;
    __device__ __forceinline__ void operator()(const f32x4 (&acc)[2][2][4][2], const Unit& u, int wr, int wc, int fr, int fq) const {
        const int row0 = u.pm * BM + wr * 64 + fr, col0 = u.pn * BM + wc * 32 + 8 * fq;
#pragma unroll
        for (int ai = 0; ai < 2; ++ai)
#pragma unroll
            for (int m = 0; m < 4; ++m) { const size_t r = (size_t)(row0 + ai * HALF + m * 16); bf16_t* rowp = O + r * 2048 + col0;
#pragma unroll
                for (int bj = 0; bj < 2; ++bj) { const f32x4 v0 = acc[ai][bj][m][0], v1 = acc[ai][bj][m][1];
                    u32x4 w; w.x = cvt_pk_bf16(v0[0], v0[1]); w.y = cvt_pk_bf16(v0[2], v0[3]); w.z = cvt_pk_bf16(v1[0], v1[1]); w.w = cvt_pk_bf16(v1[2], v1[3]);
                    *(u32x4*)(rowp + bj * HALF) = w;
                    if (bj == 0) { int p0 = __builtin_amdgcn_cvt_pk_fp8_f32(v0[0], v0[1], 0, false); p0 = __builtin_amdgcn_cvt_pk_fp8_f32(v0[2], v0[3], p0, true);
                        int p1 = __builtin_amdgcn_cvt_pk_fp8_f32(v1[0], v1[1], 0, false); p1 = __builtin_amdgcn_cvt_pk_fp8_f32(v1[2], v1[3], p1, true);
                        u32x2 w8; w8.x = (unsigned)p0; w8.y = (unsigned)p1; *(u32x2*)(K8 + r * 1024 + u.pn * 128 + wc * 32 + 8 * fq) = w8; } } }
    }
};
struct EpiStoreBf16S {
    static constexpr bool PERM = true;
    bf16_t* O; int ldc; const float* cs;
    __device__ __forceinline__ void operator()(const f32x4 (&acc)[2][2][4][2], const Unit& u, int wr, int wc, int fr, int fq) const {
        const int row0 = u.pm * BM + wr * 64 + fr, col0 = u.pn * BM + wc * 32 + 8 * fq;
        f32x4 sv[2][2];
#pragma unroll
        for (int bj = 0; bj < 2; ++bj)
#pragma unroll
            for (int n = 0; n < 2; ++n) sv[bj][n] = *(const f32x4*)(cs + col0 + bj * HALF + 4 * n);
#pragma unroll
        for (int ai = 0; ai < 2; ++ai)
#pragma unroll
            for (int m = 0; m < 4; ++m) { bf16_t* rowp = O + (size_t)(row0 + ai * HALF + m * 16) * ldc + col0;
#pragma unroll
                for (int bj = 0; bj < 2; ++bj) { const f32x4 v0 = acc[ai][bj][m][0] * sv[bj][0], v1 = acc[ai][bj][m][1] * sv[bj][1];
                    u32x4 w; w.x = cvt_pk_bf16(v0[0], v0[1]); w.y = cvt_pk_bf16(v0[2], v0[3]); w.z = cvt_pk_bf16(v1[0], v1[1]); w.w = cvt_pk_bf16(v1[2], v1[3]);
                    *(u32x4*)(rowp + bj * HALF) = w; } }
    }
};
template <bool FIRST, bool F8OUT = false> struct EpiGate {
    static constexpr bool PERM = true;
    bf16_t* Y; const bf16_t* Gt; unsigned char* Y8; const float* cs;
    __device__ __forceinline__ void operator()(const f32x4 (&acc)[2][2][4][2], const Unit& u, int wr, int wc, int fr, int fq) const {
        constexpr int ldy = DM, ldg = NP, ldy8 = DM;
        const int row0 = u.pm * BM + wr * 64 + fr, col0 = u.pn * BM + wc * 32 + 8 * fq;
        f32x4 sv[2][2];
#pragma unroll
        for (int bj = 0; bj < 2; ++bj)
#pragma unroll
            for (int n = 0; n < 2; ++n) sv[bj][n] = *(const f32x4*)(cs + col0 + bj * HALF + 4 * n);
#pragma unroll
        for (int ai = 0; ai < 2; ++ai)
#pragma unroll
        for (int mh = 0; mh < 2; ++mh) {
            u32x4 g[2][2], y[2][2];
#pragma unroll
            for (int mm = 0; mm < 2; ++mm)
#pragma unroll
                for (int bj = 0; bj < 2; ++bj) { const size_t r = (size_t)(row0 + ai * HALF + (mh * 2 + mm) * 16);
                    g[mm][bj] = *(const u32x4*)(Gt + r * ldg + col0 + bj * HALF);
                    if (!FIRST) y[mm][bj] = *(const u32x4*)(Y + r * ldy + col0 + bj * HALF); }
#pragma unroll
            for (int mm = 0; mm < 2; ++mm)
#pragma unroll
                for (int bj = 0; bj < 2; ++bj) { const int m = mh * 2 + mm; const size_t r = (size_t)(row0 + ai * HALF + m * 16); const f32x4 v0 = acc[ai][bj][m][0] * sv[bj][0], v1 = acc[ai][bj][m][1] * sv[bj][1]; const u32x4 gg = g[mm][bj];
                    float o[8];
                    o[0] = sigmoidf_(bflo(gg.x)) * v0[0]; o[1] = sigmoidf_(bfhi(gg.x)) * v0[1]; o[2] = sigmoidf_(bflo(gg.y)) * v0[2]; o[3] = sigmoidf_(bfhi(gg.y)) * v0[3];
                    o[4] = sigmoidf_(bflo(gg.z)) * v1[0]; o[5] = sigmoidf_(bfhi(gg.z)) * v1[1]; o[6] = sigmoidf_(bflo(gg.w)) * v1[2]; o[7] = sigmoidf_(bfhi(gg.w)) * v1[3];
                    if (!FIRST) { const u32x4 yy = y[mm][bj];
                        o[0] += bflo(yy.x); o[1] += bfhi(yy.x); o[2] += bflo(yy.y); o[3] += bfhi(yy.y); o[4] += bflo(yy.z); o[5] += bfhi(yy.z); o[6] += bflo(yy.w); o[7] += bfhi(yy.w); }
                    if constexpr (F8OUT) { int p0 = __builtin_amdgcn_cvt_pk_fp8_f32(o[0], o[1], 0, false); p0 = __builtin_amdgcn_cvt_pk_fp8_f32(o[2], o[3], p0, true);
                        int p1 = __builtin_amdgcn_cvt_pk_fp8_f32(o[4], o[5], 0, false); p1 = __builtin_amdgcn_cvt_pk_fp8_f32(o[6], o[7], p1, true);
                        u32x2 w8; w8.x = (unsigned)p0; w8.y = (unsigned)p1; *(u32x2*)(Y8 + r * ldy8 + col0 + bj * HALF) = w8; }
                    else { u32x4 w; w.x = cvt_pk_bf16(o[0], o[1]); w.y = cvt_pk_bf16(o[2], o[3]); w.z = cvt_pk_bf16(o[4], o[5]); w.w = cvt_pk_bf16(o[6], o[7]);
                        *(u32x4*)(Y + r * ldy + col0 + bj * HALF) = w; } }
        }
    }
};
template <bool CS> struct EpiResidT {
    static constexpr bool PERM = false;
    float* X; int ldx; const float* gate; const float* cs;
    __device__ __forceinline__ void operator()(const f32x4 (&acc)[2][2][4][2], const Unit& u, int wr, int wc, int fr, int fq) const {
        const int row0 = u.pm * BM + wr * 64 + fr, col0 = u.pn * BM + wc * 32 + 4 * fq;
        const int sel = (u.pm % 33 == 0) ? 2 : (u.pm / 33);
        const float* gp = gate + (size_t)sel * 12288 + col0;
        f32x4 gv[2][2];
#pragma unroll
        for (int bj = 0; bj < 2; ++bj)
#pragma unroll
            for (int n = 0; n < 2; ++n) { gv[bj][n] = *(const f32x4*)(gp + bj * HALF + n * 16); if constexpr (CS) gv[bj][n] = gv[bj][n] * *(const f32x4*)(cs + col0 + bj * HALF + n * 16); }
#pragma unroll
        for (int ai = 0; ai < 2; ++ai)
#pragma unroll
            for (int mh = 0; mh < 2; ++mh) {
                f32x4 x[2][2][2];
#pragma unroll
                for (int mm = 0; mm < 2; ++mm)
#pragma unroll
                    for (int bj = 0; bj < 2; ++bj)
#pragma unroll
                        for (int n = 0; n < 2; ++n) x[mm][bj][n] = *(const f32x4*)(X + (size_t)(row0 + ai * HALF + (mh * 2 + mm) * 16) * ldx + col0 + bj * HALF + n * 16);
#pragma unroll
                for (int mm = 0; mm < 2; ++mm)
#pragma unroll
                    for (int bj = 0; bj < 2; ++bj)
#pragma unroll
                        for (int n = 0; n < 2; ++n) *(f32x4*)(X + (size_t)(row0 + ai * HALF + (mh * 2 + mm) * 16) * ldx + col0 + bj * HALF + n * 16) = x[mm][bj][n] + gv[bj][n] * acc[ai][bj][mh * 2 + mm][n];
            }
    }
};

typedef int i32x8 __attribute__((ext_vector_type(8)));
typedef int i32x4 __attribute__((ext_vector_type(4)));
__device__ __forceinline__ i32x8 cat8(const bf16x8 lo, const bf16x8 hi) { const i32x4 a = __builtin_bit_cast(i32x4, lo), b = __builtin_bit_cast(i32x4, hi); return __builtin_shufflevector(a, b, 0, 1, 2, 3, 4, 5, 6, 7); }
template <class Epi, class Sched, int F8 = 0>
__device__ __forceinline__ void gemm_phase(LAS unsigned char* lds, const int tid, const Gemm g, const Sched& S, const Epi& E) {
    const int wid = __builtin_amdgcn_readfirstlane(tid >> 6), lane = tid & 63, wr = wid >> 2, wc = wid & 3, fr = lane & 15, fq = lane >> 4;
    const int K = g.K, nt = F8 ? K / 128 : K / BK, lda = g.lda, ldb = g.ldb;
    unsigned voffA[2], voffB[2];
#pragma unroll
    for (int i = 0; i < 2; ++i) { int R, C; stage_rc(tid * 16 + i * 8192, R, C); const int Rb = Epi::PERM ? ((R & ~31) + perm32(R & 31)) : R;
        voffA[i] = F8 ? (unsigned)(R * lda + C * 2) : (unsigned)(R * lda + C) * 2u; voffB[i] = F8 ? (unsigned)(Rb * ldb + C * 2) : (unsigned)(Rb * ldb + C) * 2u; }
    const size_t kstep = (size_t)(BK * 2);
    const size_t hstepA = (size_t)HALF * lda * (F8 ? 1 : 2), hstepB = (size_t)HALF * ldb * (F8 ? 1 : 2);
    const size_t tstepA = 2 * hstepA, tstepB = 2 * hstepB;
    const unsigned ldsw = (unsigned)wid * 1024u;
    const int aoff = F8 ? lds_byte(wr * 64 + fr, (fq & 1) * 16) + (fq >> 1) * 1024 : lds_byte(wr * 64 + fr, fq * 8);
    const int boff = F8 ? lds_byte(wc * 32 + fr, (fq & 1) * 16) + (fq >> 1) * 1024 : lds_byte(wc * 32 + fr, fq * 8);
#define PG8_SA(b, h) (((b) * 2 + (h)) * HTB)
#define PG8_SB(b, h) ((4 + (b) * 2 + (h)) * HTB)
#define PG8_STAGE(bufoff, gbase, voff) do { _Pragma("unroll") for (int _i = 0; _i < 2; ++_i) \
        __builtin_amdgcn_global_load_lds((const unsigned*)((const char*)(gbase) + (voff)[_i]), (LAS unsigned*)(lds + (bufoff) + ldsw + _i * 8192), 16, 0, 0); } while (0)
#define PG8_LDA(dst, b, h) do { if constexpr (F8) { _Pragma("unroll") for (int m = 0; m < 4; ++m) { const LAS unsigned char* p_ = lds + PG8_SA(b, h) + aoff + m * 2048; \
            const i32x4 lo_ = *(const LAS i32x4*)p_, hi_ = *(const LAS i32x4*)(p_ + 16); dst##8[m] = __builtin_shufflevector(lo_, hi_, 0, 1, 2, 3, 4, 5, 6, 7); } } \
        else { _Pragma("unroll") for (int m = 0; m < 4; ++m) _Pragma("unroll") for (int k = 0; k < 2; ++k) dst[m][k] = *(const LAS bf16x8*)(lds + PG8_SA(b, h) + aoff + m * 2048 + k * 1024); } } while (0)
#define PG8_LDB(dst, b, h) do { if constexpr (F8) { _Pragma("unroll") for (int n = 0; n < 2; ++n) { const LAS unsigned char* p_ = lds + PG8_SB(b, h) + boff + n * 2048; \
            const i32x4 lo_ = *(const LAS i32x4*)p_, hi_ = *(const LAS i32x4*)(p_ + 16); dst##8[n] = __builtin_shufflevector(lo_, hi_, 0, 1, 2, 3, 4, 5, 6, 7); } } \
        else { _Pragma("unroll") for (int n = 0; n < 2; ++n) _Pragma("unroll") for (int k = 0; k < 2; ++k) dst[n][k] = *(const LAS bf16x8*)(lds + PG8_SB(b, h) + boff + n * 2048 + k * 1024); } } while (0)
#define PG8_MMA(ai, bj, At, Bt) do { __builtin_amdgcn_s_setprio(1); \
        if constexpr (F8) { _Pragma("unroll") for (int m = 0; m < 4; ++m) _Pragma("unroll") for (int n = 0; n < 2; ++n) \
            asm volatile("v_mfma_scale_f32_16x16x128_f8f6f4 %0, %1, %2, %0, %3, %3 op_sel_hi:[0,0,0]" : "+v"(acc[ai][bj][m][n]) : "v"(Bt##8[n]), "v"(At##8[m]), "v"(mxscale)); } \
        else { _Pragma("unroll") for (int m = 0; m < 4; ++m) _Pragma("unroll") for (int n = 0; n < 2; ++n) _Pragma("unroll") for (int k = 0; k < 2; ++k) \
            acc[ai][bj][m][n] = __builtin_amdgcn_mfma_f32_16x16x32_bf16(Bt[n][k], At[m][k], acc[ai][bj][m][n], 0, 0, 0); } \
        __builtin_amdgcn_s_setprio(0); } while (0)
#define PG8_WAIT_V(n) asm volatile("s_waitcnt vmcnt(" #n ")" ::: "memory")
#define PG8_WAIT_L(n) asm volatile("s_waitcnt lgkmcnt(" #n ")" ::: "memory")
#define PG8_BAR __builtin_amdgcn_s_barrier()
#define PG8_SCHED __builtin_amdgcn_sched_barrier(0)
    Unit cur, nxt; int ui = 0;
    if (!S.next(0, cur)) return;
    f32x4 acc[2][2][4][2];
#pragma unroll
    for (int a = 0; a < 2; ++a)
#pragma unroll
        for (int b = 0; b < 2; ++b)
#pragma unroll
            for (int m = 0; m < 4; ++m)
#pragma unroll
                for (int n = 0; n < 2; ++n) acc[a][b][m][n] = (f32x4){0.f, 0.f, 0.f, 0.f};
    int mxscale = 0x7f7f7f7f; asm volatile("" : "+v"(mxscale));
    bf16x8 At[4][2], B0[2][2], B1[2][2]; i32x8 At8[4], B08[2], B18[2];
    const char* cA = (const char*)g.A + (size_t)cur.pm * tstepA; const char* cB = (const char*)g.Bt + (size_t)cur.pn * tstepB;
    PG8_STAGE(PG8_SB(0, 0), cB, voffB); PG8_STAGE(PG8_SA(0, 0), cA, voffA); PG8_STAGE(PG8_SB(0, 1), cB + hstepB, voffB); PG8_STAGE(PG8_SA(0, 1), cA + hstepA, voffA);
    if (wr == 1) PG8_BAR;
    PG8_WAIT_V(4); PG8_BAR;
    PG8_STAGE(PG8_SB(1, 0), cB + kstep, voffB); PG8_STAGE(PG8_SA(1, 0), cA + kstep, voffA); PG8_STAGE(PG8_SB(1, 1), cB + hstepB + kstep, voffB);
    PG8_WAIT_V(6); PG8_BAR;
    for (;;) {
        const bool has_next = S.next(ui + 1, nxt);
        const char* nA = has_next ? (const char*)g.A + (size_t)nxt.pm * tstepA : cA; const char* nB = has_next ? (const char*)g.Bt + (size_t)nxt.pn * tstepB : cB;
        for (int t = 0; t < nt; t += 2) {
            const bool last = (t == nt - 2);
            const char* a1 = cA + (size_t)(t + 1) * kstep;
            const char* a2 = last ? nA : cA + (size_t)(t + 2) * kstep; const char* b2 = last ? nB : cB + (size_t)(t + 2) * kstep;
            const char* a3 = a2 + kstep; const char* b3 = b2 + kstep;
            PG8_LDB(B0, 0, 0); PG8_SCHED; PG8_LDA(At, 0, 0); PG8_STAGE(PG8_SA(1, 1), a1 + hstepA, voffA);
            PG8_WAIT_L(8); PG8_BAR; PG8_WAIT_L(0); PG8_MMA(0, 0, At, B0); PG8_BAR; PG8_SCHED;
            PG8_LDB(B1, 0, 1); PG8_STAGE(PG8_SB(0, 0), b2, voffB);
            PG8_BAR; PG8_WAIT_L(0); PG8_MMA(0, 1, At, B1); PG8_BAR;
            PG8_LDA(At, 0, 1); PG8_STAGE(PG8_SA(0, 0), a2, voffA);
            PG8_BAR; PG8_WAIT_L(0); PG8_MMA(1, 0, At, B0); PG8_BAR; PG8_SCHED;
            PG8_STAGE(PG8_SB(0, 1), b2 + hstepB, voffB);
            PG8_WAIT_V(6); PG8_BAR; PG8_MMA(1, 1, At, B1); PG8_BAR;
            PG8_LDB(B0, 1, 0); PG8_SCHED; PG8_LDA(At, 1, 0); PG8_STAGE(PG8_SA(0, 1), a2 + hstepA, voffA);
            PG8_WAIT_L(8); PG8_BAR; PG8_WAIT_L(0); PG8_MMA(0, 0, At, B0); PG8_BAR; PG8_SCHED;
            PG8_LDB(B1, 1, 1); PG8_STAGE(PG8_SB(1, 0), b3, voffB);
            PG8_BAR; PG8_WAIT_L(0); PG8_MMA(0, 1, At, B1); PG8_BAR;
            PG8_LDA(At, 1, 1); PG8_STAGE(PG8_SA(1, 0), a3, voffA);
            PG8_BAR; PG8_WAIT_L(0); PG8_MMA(1, 0, At, B0); PG8_BAR; PG8_SCHED;
            PG8_STAGE(PG8_SB(1, 1), b3 + hstepB, voffB);
            PG8_WAIT_V(6); PG8_BAR; PG8_MMA(1, 1, At, B1); PG8_BAR;
        }
        if constexpr (F8) asm volatile("s_nop 15\n\ts_nop 7");
        E(acc, cur, wr, wc, fr, fq);
        if (!has_next) break;
#pragma unroll
        for (int a = 0; a < 2; ++a)
#pragma unroll
            for (int b = 0; b < 2; ++b)
#pragma unroll
                for (int m = 0; m < 4; ++m)
#pragma unroll
                    for (int n = 0; n < 2; ++n) acc[a][b][m][n] = (f32x4){0.f, 0.f, 0.f, 0.f};
        cur = nxt; cA = nA; cB = nB; ++ui;
    }
    PG8_WAIT_V(0);
    if (wr == 0) PG8_BAR;
    PG8_BAR;
#undef PG8_SA
#undef PG8_SB
#undef PG8_STAGE
#undef PG8_LDA
#undef PG8_LDB
#undef PG8_MMA
#undef PG8_WAIT_V
#undef PG8_WAIT_L
#undef PG8_BAR
#undef PG8_SCHED
}
}

struct Args { const float* in[30]; float* out; unsigned char* ws; int ph_lo, ph_hi; };
enum { I_X = 0, I_C, I_CTX, I_CCTX, I_WMOD, I_BMOD, I_N1G, I_WIN, I_QNG, I_KNG, I_WA2F, I_BAF, I_WA2B, I_BAB, I_ONG, I_MQNG, I_WUQ, I_MKVNG, I_WUKV,
       I_WBRA, I_WBRL, I_WBRM, I_WOUT, I_N2G, I_PWQ, I_PK1, I_PK2, I_PU, I_PV, I_FG };
typedef const float* cfp_t;
struct Ctx {
    const __attribute__((address_space(4))) cfp_t* in; float* out; unsigned char* ws; LAS unsigned char* lds;
    int tid, lane, wid, G, bid;
};
#define WSP(T, off) ((T*)(C.ws + (off)))
#define INP(i) ((const float*)(const GLB float*)C.in[(i)])
__device__ __forceinline__ unsigned long long launder_u64(unsigned long long w) {
    unsigned lo = (unsigned)w, hi = (unsigned)(w >> 32); asm volatile("" : "+v"(lo), "+v"(hi));
    lo = __builtin_amdgcn_readfirstlane(lo); hi = __builtin_amdgcn_readfirstlane(hi); return ((unsigned long long)hi << 32) | lo;
}
__device__ __forceinline__ Ctx launder(const Ctx& C0) {
    Ctx R = C0; int t = C0.tid; asm volatile("" : "+v"(t)); R.tid = t; R.lane = t & 63; R.wid = __builtin_amdgcn_readfirstlane(t >> 6);
    R.ws = (unsigned char*)(GLB unsigned char*)launder_u64((unsigned long long)C0.ws);
    R.out = (float*)(GLB float*)(unsigned long long)C0.out;
    R.in = (const __attribute__((address_space(4))) cfp_t*)launder_u64((unsigned long long)C0.in);
    unsigned l = (unsigned)(uintptr_t)C0.lds; asm volatile("" : "+v"(l)); l = __builtin_amdgcn_readfirstlane(l); R.lds = (LAS unsigned char*)(uintptr_t)l;
    return R;
}

__device__ __forceinline__ const float* src_row(const Ctx& C, int r) {
    const int b = r / RPB, j = r % RPB;
    return j < CTXL ? INP(I_CTX) + ((size_t)b * CTXL + j) * DM : INP(I_X) + ((size_t)b * SEQ + (j - CTXL)) * DM;
}
__device__ __forceinline__ int mod_sel(int r) { const int b = r / RPB, j = r % RPB; return j < CTXL ? 2 : b; }

__device__ __forceinline__ void phase_modv(const Ctx& C) {
    LAS float* sc = (LAS float*)C.lds;
    LAS float* red = (LAS float*)(C.lds + 3 * 2048 * 4);
    for (int i = C.tid; i < 3 * DM; i += NTHREADS) { const int r = i / DM, k = i % DM; const float v = r < 2 ? INP(I_C)[r * DM + k] : INP(I_CCTX)[k]; sc[i] = siluf_(v); }
    __syncthreads();
    float* modv = WSP(float, WS_MODV);
    const int kq = C.tid / 12, c4 = C.tid % 12;
    for (int item = C.bid; item < 2 * 256; item += C.G) {
        const int l = item / 256, cg = item % 256;
        float acc[3][4];
#pragma unroll
        for (int r = 0; r < 3; ++r)
#pragma unroll
            for (int j = 0; j < 4; ++j) acc[r][j] = 0.f;
        if (kq < 42) {
            const float* wp = INP(I_WMOD) + (size_t)l * DM * 12288 + 48 * cg + 4 * c4;
#pragma unroll 1
            for (int k0 = kq; k0 < DM; k0 += 42 * 7) {
                f32x4 w[7];
#pragma unroll
                for (int u = 0; u < 7; ++u) { const int k = k0 + 42 * u; w[u] = k < DM ? *(const f32x4*)(wp + (size_t)k * 12288) : (f32x4){0.f, 0.f, 0.f, 0.f}; }
#pragma unroll
                for (int u = 0; u < 7; ++u) { const int k = k0 + 42 * u; if (k < DM) {
#pragma unroll
                    for (int r = 0; r < 3; ++r) { const float sv = sc[r * DM + k];
#pragma unroll
                        for (int j = 0; j < 4; ++j) acc[r][j] += sv * w[u][j]; } } }
            }
#pragma unroll
            for (int r = 0; r < 3; ++r)
#pragma unroll
                for (int j = 0; j < 4; ++j) red[kq * 144 + r * 48 + c4 * 4 + j] = acc[r][j];
        }
        __syncthreads();
        if (C.tid < 144) { float s = 0.f; for (int q = 0; q < 42; ++q) s += red[q * 144 + C.tid];
            const int r = C.tid / 48, cc = C.tid % 48;
            modv[((size_t)l * 3 + r) * 12288 + 48 * cg + cc] = s + INP(I_BMOD)[(size_t)l * 12288 + 48 * cg + cc]; }
        __syncthreads();
    }
}
__device__ __forceinline__ void phase_tables(const Ctx& C) {
    float* ta = WSP(float, WS_TABA); float* tm = WSP(float, WS_TABM);
    for (int i = C.bid * NTHREADS + C.tid; i < 128 * 32 + 128 * 16; i += C.G * NTHREADS) {
        if (i < 128 * 32) { const int pos = i / 32, f = i % 32; const float inv = exp2f(-(float)f * (13.287712379549449f / 32.0f)); const float a = (float)pos * inv;
            ta[i] = cosf(a); ta[128 * 32 + i] = sinf(a); }
        else { const int k = i - 128 * 32, pos = k / 16, f = k % 16; const float inv = exp2f(-(float)f * (13.287712379549449f / 16.0f)); const float a = (float)pos * inv;
            tm[k] = cosf(a); tm[128 * 16 + k] = sinf(a); }
    }
}
__device__ __forceinline__ void transpose_cvt(const Ctx& C, const float* src, int K, int N, bf16_t* dst, int Npad, int& item) {
    LAS float* tile = (LAS float*)C.lds;
    const int tk = K / 64, tn = Npad / 256, ntile = tk * tn;
    const int t0 = ((C.bid - item % C.G) + C.G) % C.G; item += ntile;
    for (int t = t0; t < ntile; t += C.G) {
        const int k0 = (t / tn) * 64, n0 = (t % tn) * 256;
        const int nn = (C.tid & 63) * 4, kr = C.tid >> 6;
        f32x4 v[8];
#pragma unroll
        for (int p = 0; p < 8; ++p) { v[p] = (f32x4){0.f, 0.f, 0.f, 0.f}; if (n0 + nn < N) v[p] = *(const f32x4*)(src + (size_t)(k0 + kr + p * 8) * N + n0 + nn); }
#pragma unroll
        for (int p = 0; p < 8; ++p)
#pragma unroll
            for (int j = 0; j < 4; ++j) tile[(kr + p * 8) * 257 + nn + j] = v[p][j];
        __syncthreads();
        { const int n = C.tid >> 1, kh = (C.tid & 1) * 32;
#pragma unroll
          for (int q = 0; q < 4; ++q) { float x[8];
#pragma unroll
              for (int j = 0; j < 8; ++j) x[j] = tile[(kh + q * 8 + j) * 257 + n];
              u32x4 w; w.x = cvt_pk_bf16(x[0], x[1]); w.y = cvt_pk_bf16(x[2], x[3]); w.z = cvt_pk_bf16(x[4], x[5]); w.w = cvt_pk_bf16(x[6], x[7]);
              *(u32x4*)(dst + (size_t)(n0 + n) * K + k0 + kh + q * 8) = w; } }
        __syncthreads();
    }
}
__device__ __forceinline__ void transpose_cvt_fp8(const Ctx& C, const float* src, int K, int N, unsigned char* dst, int Npad, float* cinv, const float cmul = 1.0f, const int wg_off = 0) {
    LAS float* tile = (LAS float*)C.lds;
    LAS float* red = (LAS float*)(C.lds + 64 * 65 * 4);
    LAS float* scl = red + 32 * 64;
    const int kk = C.tid >> 4, nn = (C.tid & 15) * 4;
    for (int cgp = ((C.bid - wg_off) % C.G + C.G) % C.G; cgp < Npad / 64; cgp += C.G) {
        const int n0 = cgp * 64; const bool live = n0 + nn < N;
        float am[4] = {0.f, 0.f, 0.f, 0.f};
        for (int k0 = 0; k0 < K; k0 += 128) {
            f32x4 v[4];
#pragma unroll
            for (int p = 0; p < 4; ++p) v[p] = live ? *(const f32x4*)(src + (size_t)(k0 + kk + p * 32) * N + n0 + nn) : (f32x4){0.f, 0.f, 0.f, 0.f};
#pragma unroll
            for (int p = 0; p < 4; ++p)
#pragma unroll
                for (int j = 0; j < 4; ++j) am[j] = fmaxf(am[j], fabsf(v[p][j])); }
#pragma unroll
        for (int j = 0; j < 4; ++j) red[kk * 64 + nn + j] = am[j];
        __syncthreads();
        if (C.tid < 64) { float m = 0.f; for (int q = 0; q < 32; ++q) m = fmaxf(m, red[q * 64 + C.tid]);
            scl[C.tid] = m > 0.f ? 224.0f / m : 1.0f; cinv[n0 + C.tid] = (m > 0.f ? m * (1.0f / 224.0f) : 1.0f) * cmul; }
        __syncthreads();
        for (int k0 = 0; k0 < K; k0 += 64) {
#pragma unroll
            for (int p = 0; p < 2; ++p) { const f32x4 v = live ? *(const f32x4*)(src + (size_t)(k0 + kk + p * 32) * N + n0 + nn) : (f32x4){0.f, 0.f, 0.f, 0.f};
#pragma unroll
                for (int j = 0; j < 4; ++j) tile[(kk + p * 32) * 65 + nn + j] = v[j]; }
            __syncthreads();
            { const int n = C.tid >> 3, k8 = (C.tid & 7) * 8; const float sc = scl[n]; float x[8];
#pragma unroll
              for (int j = 0; j < 8; ++j) x[j] = tile[(k8 + j) * 65 + n] * sc;
              int p0 = __builtin_amdgcn_cvt_pk_fp8_f32(x[0], x[1], 0, false); p0 = __builtin_amdgcn_cvt_pk_fp8_f32(x[2], x[3], p0, true);
              int p1 = __builtin_amdgcn_cvt_pk_fp8_f32(x[4], x[5], 0, false); p1 = __builtin_amdgcn_cvt_pk_fp8_f32(x[6], x[7], p1, true);
              u32x2 w; w.x = (unsigned)p0; w.y = (unsigned)p1; *(u32x2*)(dst + (size_t)(n0 + n) * K + k0 + k8) = w; }
            __syncthreads();
        }
    }
}
__device__ __forceinline__ void cvt_plain(const Ctx& C, const float* src, bf16_t* dst, size_t n8) {
    for (size_t i = (size_t)C.bid * NTHREADS + C.tid; i < n8; i += (size_t)C.G * NTHREADS) {
        const f32x4 a = *(const f32x4*)(src + i * 8), b = *(const f32x4*)(src + i * 8 + 4);
        u32x4 w; w.x = cvt_pk_bf16(a[0], a[1]); w.y = cvt_pk_bf16(a[2], a[3]); w.z = cvt_pk_bf16(b[0], b[1]); w.w = cvt_pk_bf16(b[2], b[3]);
        *(u32x4*)(dst + i * 8) = w;
    }
}
__device__ __forceinline__ void phase_cvt_mixer_weights(const Ctx& C, int l) {
    int item = 0;
    transpose_cvt_fp8(C, INP(I_WIN) + (size_t)l * DM * IN_COLS, DM, IN_COLS, C.ws + WS_WIN, NP, WSP(float, WS_WINS));
    __syncthreads();
    transpose_cvt(C, INP(I_WUQ) + (size_t)l * 512 * 1536, 512, 1536, WSP(bf16_t, WS_WUQ), 1536, item);
    transpose_cvt(C, INP(I_WUKV) + (size_t)l * 512 * 2048, 512, 2048, WSP(bf16_t, WS_WUKV), 2048, item);
    transpose_cvt_fp8(C, INP(I_WBRA) + (size_t)l * 1024 * 2048, 1024, 2048, C.ws + WS_WBR, 2048, WSP(float, WS_WBRS), 1.0f / 32.0f, 220); __syncthreads();
    transpose_cvt_fp8(C, INP(I_WBRL) + (size_t)l * 1024 * 2048, 1024, 2048, C.ws + WS_WBR + (size_t)2048 * 1024, 2048, WSP(float, WS_WBRS) + DM, 1.0f, 220); __syncthreads();
    transpose_cvt_fp8(C, INP(I_WBRM) + (size_t)l * 1024 * 2048, 1024, 2048, C.ws + WS_WBR + (size_t)2 * 2048 * 1024, 2048, WSP(float, WS_WBRS) + 2 * DM, 1.0f / 32.0f, 252); __syncthreads();
    transpose_cvt_fp8(C, INP(I_WOUT) + (size_t)l * 2048 * 2048, 2048, 2048, C.ws + WS_WOUT, 2048, WSP(float, WS_WOUTS), 1.0f, 188);
    __syncthreads();
    transpose_cvt(C, INP(I_PWQ) + (size_t)l * 2048 * 2048, 2048, 2048, WSP(bf16_t, WS_WQ), 2048, item);
    cvt_plain(C, INP(I_PK1) + (size_t)l * 8 * 128 * 128, WSP(bf16_t, WS_K1), 8 * 128 * 128 / 8);
    cvt_plain(C, INP(I_PK2) + (size_t)l * 8 * 128 * 128, WSP(bf16_t, WS_K2), 8 * 128 * 128 / 8);
}
__device__ __forceinline__ void phase_cvt_peer_tables(const Ctx& C, int l, int row_lo, int row_hi, int wg_lo) {
    const int lane = C.lane; if (C.bid < wg_lo) return;
    unsigned char* pt = C.ws + WS_PT + (size_t)l * PT_BYTES;
    for (int row = row_lo + (C.bid - wg_lo) * 8 + C.wid; row < row_hi; row += (C.G - wg_lo) * 8) {
#pragma unroll 1
        for (int tb = 0; tb < 2; ++tb) {
            const float* src = (tb ? INP(I_PV) : INP(I_PU)) + ((size_t)l * NEXP + row) * DM + lane * 16;
            f32x4 x[8]; float amax = 0.f;
#pragma unroll
            for (int c = 0; c < 2; ++c)
#pragma unroll
                for (int q = 0; q < 4; ++q) { x[c * 4 + q] = *(const f32x4*)(src + c * 1024 + q * 4);
                    amax = fmaxf(amax, fmaxf(fmaxf(fabsf(x[c * 4 + q][0]), fabsf(x[c * 4 + q][1])), fmaxf(fabsf(x[c * 4 + q][2]), fabsf(x[c * 4 + q][3])))); }
            amax = fmaxf(amax, xchg32(amax, lane)); amax = fmaxf(amax, xchg16(amax, lane)); amax = fmaxf(amax, dppmov<DPP_ROR8>(amax));
            amax = fmaxf(amax, dppmov<DPP_HMIRROR>(amax)); amax = fmaxf(amax, dppmov<DPP_Q3210>(amax)); amax = fmaxf(amax, dppmov<DPP_Q1032>(amax));
            const float sc = amax > 0.f ? 224.0f / amax : 1.0f, inv = amax > 0.f ? amax * (1.0f / 224.0f) : 1.0f;
            unsigned char* dst = pt + (tb ? PT_V8 : PT_U8) + (size_t)(lane >> 3) * ((size_t)NEXP * 128) + (size_t)row * 128 + (lane & 7) * 16;
#pragma unroll
            for (int c = 0; c < 2; ++c) { u32x4 w;
#pragma unroll
                for (int q = 0; q < 4; ++q) { const f32x4 v = x[c * 4 + q] * sc; int p = __builtin_amdgcn_cvt_pk_fp8_f32(v[0], v[1], 0, false); p = __builtin_amdgcn_cvt_pk_fp8_f32(v[2], v[3], p, true); w[q] = (unsigned)p; }
                *(u32x4*)(dst + (size_t)c * 8 * ((size_t)NEXP * 128)) = w; }
            if (lane == 0) ((float*)(pt + (tb ? PT_SCV : PT_SCU)))[row] = inv;
        }
    }
}

template <bool FIRST, bool F8OUT = false> __device__ __forceinline__ void phase_norm_mod(const Ctx& C, const float* gvec, const float* modl  , int shift_off, int scale_off) {
    float* xs = WSP(float, WS_XS); bf16_t* hb = WSP(bf16_t, WS_HB);
    for (int r = C.bid * 8 + C.wid; r < TT; r += C.G * 8) {
        const float* xr = FIRST ? src_row(C, r) : xs + (size_t)r * DM;
        const float* mv = modl + (size_t)mod_sel(r) * 12288;
        f32x4 v[8]; float ss = 0.f;
#pragma unroll
        for (int c = 0; c < 4; ++c) { v[2 * c] = *(const f32x4*)(xr + c * 512 + C.lane * 8); v[2 * c + 1] = *(const f32x4*)(xr + c * 512 + C.lane * 8 + 4); }
#pragma unroll
        for (int c = 0; c < 8; ++c) ss += v[c][0] * v[c][0] + v[c][1] * v[c][1] + v[c][2] * v[c][2] + v[c][3] * v[c][3];
        ss = wave_sum(ss);
        const float rs = rsqrtf(ss * (1.0f / DM) + NORM_EPS);
#pragma unroll
        for (int c = 0; c < 4; ++c) { const int col = c * 512 + C.lane * 8;
            if (FIRST) { *(f32x4*)(xs + (size_t)r * DM + col) = v[2 * c]; *(f32x4*)(xs + (size_t)r * DM + col + 4) = v[2 * c + 1]; }
            float o[8];
#pragma unroll
            for (int h = 0; h < 2; ++h) { const f32x4 g = *(const f32x4*)(gvec + col + 4 * h), s = *(const f32x4*)(mv + scale_off + col + 4 * h), t = *(const f32x4*)(mv + shift_off + col + 4 * h);
#pragma unroll
                for (int j = 0; j < 4; ++j) o[4 * h + j] = v[2 * c + h][j] * rs * g[j] * (1.0f + s[j]) + t[j]; }
            if constexpr (F8OUT) {
                int p0 = __builtin_amdgcn_cvt_pk_fp8_f32(o[0], o[1], 0, false); p0 = __builtin_amdgcn_cvt_pk_fp8_f32(o[2], o[3], p0, true);
                int p1 = __builtin_amdgcn_cvt_pk_fp8_f32(o[4], o[5], 0, false); p1 = __builtin_amdgcn_cvt_pk_fp8_f32(o[6], o[7], p1, true);
                u32x2 w; w.x = (unsigned)p0; w.y = (unsigned)p1; *(u32x2*)((unsigned char*)hb + (size_t)r * DM + col) = w;
            } else {
            u32x4 w; w.x = cvt_pk_bf16(o[0], o[1]); w.y = cvt_pk_bf16(o[2], o[3]); w.z = cvt_pk_bf16(o[4], o[5]); w.w = cvt_pk_bf16(o[6], o[7]);
            *(u32x4*)(hb + (size_t)r * DM + col) = w; } }
    }
}

__device__ __forceinline__ void phase_post_p(const Ctx& C, int l) {
    bf16_t* P = WSP(bf16_t, WS_P); const float* ta = WSP(float, WS_TABA); const float* tm = WSP(float, WS_TABM);
    const float* qg = INP(I_QNG) + l * 128; const float* kg = INP(I_KNG) + l * 128;
    const float* mqg = INP(I_MQNG) + l * 512; const float* mkvg = INP(I_MKVNG) + l * 512;
    const int lane = C.lane;
    const float qg1 = qg[lane], qg2 = qg[lane + 64], kg1 = kg[lane], kg2 = kg[lane + 64];
    for (int r = C.bid * 8 + C.wid; r < TT; r += C.G * 8) {
        bf16_t* pr = P + (size_t)r * NP;
        const int j = r % RPB; const bool lat = j >= CTXL; const int pos = lat ? j - CTXL : 0, ri = pos >> 6, ci = pos & 63;
        float cs = 1.f, sn = 0.f;
        if (lat) { const int p = lane < 32 ? ri : ci, f = lane & 31; cs = ta[p * 32 + f]; sn = ta[128 * 32 + p * 32 + f]; }
#pragma unroll
        for (int h = 0; h < 10; ++h) {
            bf16_t* hp = pr + (h < 8 ? C_AQ + h * 128 : C_AK + (h - 8) * 128);
            const float x1 = bf2f(hp[lane]), x2 = bf2f(hp[lane + 64]);
            const float ss = wave_sum(x1 * x1 + x2 * x2);
            const float rs = rsqrtf(ss * (1.0f / 128.0f) + NORM_EPS);
            const float y1 = x1 * rs * (h < 8 ? qg1 : kg1), y2 = x2 * rs * (h < 8 ? qg2 : kg2);
            const float z1 = y1 * cs - y2 * sn, z2 = y2 * cs + y1 * sn;
            hp[lane] = f2bf(z1); hp[lane + 64] = f2bf(z2);
            if (h >= 8) { unsigned char* k8 = C.ws + WS_AK8 + (size_t)r * 256 + (h - 8) * 128;
                k8[lane] = (unsigned char)(__builtin_amdgcn_cvt_pk_fp8_f32(z1, 0.f, 0, false) & 0xff); k8[lane + 64] = (unsigned char)(__builtin_amdgcn_cvt_pk_fp8_f32(z2, 0.f, 0, false) & 0xff); }
        }
#pragma unroll
        for (int s = 0; s < 2; ++s) {
            bf16_t* sp = pr + (s == 0 ? C_MCQ : C_MCKV) + lane * 8; const float* gg = (s == 0 ? mqg : mkvg) + lane * 8;
            const u32x4 w = *(const u32x4*)sp; float x[8] = {bflo(w.x), bfhi(w.x), bflo(w.y), bfhi(w.y), bflo(w.z), bfhi(w.z), bflo(w.w), bfhi(w.w)};
            float ss = 0.f;
#pragma unroll
            for (int i = 0; i < 8; ++i) ss += x[i] * x[i];
            ss = wave_sum(ss);
            const float rs = rsqrtf(ss * (1.0f / 512.0f) + NORM_EPS);
#pragma unroll
            for (int i = 0; i < 8; ++i) x[i] = x[i] * rs * gg[i];
            u32x4 o; o.x = cvt_pk_bf16(x[0], x[1]); o.y = cvt_pk_bf16(x[2], x[3]); o.z = cvt_pk_bf16(x[4], x[5]); o.w = cvt_pk_bf16(x[6], x[7]);
            *(u32x4*)sp = o;
        }
        { bf16_t* kp = pr + C_MKR; const int i = lane & 31; const float x1 = bf2f(kp[i]), x2 = bf2f(kp[i + 32]);
          float c2 = 1.f, s2 = 0.f; if (lat) { const int p = i < 16 ? ri : ci, f = i & 15; c2 = tm[p * 16 + f]; s2 = tm[128 * 16 + p * 16 + f]; }
          const float z1 = x1 * c2 - x2 * s2, z2 = x2 * c2 + x1 * s2;
          if (lane < 32) { if (lat) { kp[i] = f2bf(z1); kp[i + 32] = f2bf(z2); }
              unsigned char* k8 = C.ws + WS_KR8 + (size_t)r * 64; k8[i] = (unsigned char)(__builtin_amdgcn_cvt_pk_fp8_f32(z1, 0.f, 0, false) & 0xff); k8[i + 32] = (unsigned char)(__builtin_amdgcn_cvt_pk_fp8_f32(z2, 0.f, 0, false) & 0xff); } }
    }
}

typedef int i32x8 __attribute__((ext_vector_type(8)));
typedef int i32x4 __attribute__((ext_vector_type(4)));
namespace att {
constexpr int NW = 8, QBLK = 32, KVBLK = 64, DV = 128;
constexpr float THR = 8.f;
#define SBAR() __builtin_amdgcn_sched_barrier(0)
__device__ __forceinline__ int crow(int r, int hi) { return (r & 3) + 8 * (r >> 2) + 4 * hi; }
template <int DQ> struct Cf {
    static constexpr int ND0 = DQ / 16, KROWB = DQ * 2, SHM_K = KVBLK * DQ * 2, SHM_V = KVBLK * DV * 2, SHM = 2 * SHM_V + 2 * SHM_K + NW * 64 * 4;
    static constexpr float SCALE = DQ == 128 ? 0.088388347648318440f : 0.072168783648703220f;
    __device__ static __forceinline__ int kswz(int row, int colB) { return row * KROWB + (colB ^ ((row & 7) << 4)); }
};
template <int DQ, int VAR = 0> __device__ __forceinline__ void partialSM(f32x16& p0, f32x16& p1, float& m_reg, float& mn, float& alpha, const float thr = THR, const float eoff = 0.f) {
    constexpr float SC = Cf<DQ>::SCALE, Cc = SC * 1.4426950408889634f;
    float pmax = p0[0];
#pragma unroll
    for (int r = 1; r < 16; ++r) pmax = fmaxf(pmax, p0[r]);
#pragma unroll
    for (int r = 0; r < 16; ++r) pmax = fmaxf(pmax, p1[r]);
    { auto rr = __builtin_amdgcn_permlane32_swap(__float_as_uint(pmax), __float_as_uint(pmax), false, false);
      pmax = fmaxf(__uint_as_float(rr[0]), __uint_as_float(rr[1])); }
    if (__builtin_expect(__all(pmax - m_reg <= thr / SC), 1)) { mn = m_reg; alpha = 1.f; }
    else { mn = fmaxf(m_reg, pmax); alpha = __builtin_amdgcn_exp2f((m_reg - mn) * Cc); m_reg = mn; }
    const float mnC = eoff - mn * Cc;
#pragma unroll
    for (int r = 0; r < 16; ++r) p0[r] = fmaf(p0[r], Cc, mnC);
#pragma unroll
    for (int r = 0; r < 16; ++r) p1[r] = fmaf(p1[r], Cc, mnC);
#pragma unroll
    for (int r = 0; r < 16; ++r) p0[r] = VAR == 1 ? p0[r] * 0.001f : __builtin_amdgcn_exp2f(p0[r]);
}
template <int VAR = 0> __device__ __forceinline__ void finishSM(f32x16& p0, f32x16& p1, float alpha, float& l_reg, bf16x8& pa0, bf16x8& pa1, bf16x8& pa2, bf16x8& pa3) {
#pragma unroll
    for (int r = 0; r < 16; ++r) p1[r] = VAR == 1 ? p1[r] * 0.001f : __builtin_amdgcn_exp2f(p1[r]);
    float ps = 0;
#pragma unroll
    for (int r = 0; r < 16; ++r) ps += p0[r];
#pragma unroll
    for (int r = 0; r < 16; ++r) ps += p1[r];
    { auto rr = __builtin_amdgcn_permlane32_swap(__float_as_uint(ps), __float_as_uint(ps), false, false);
      ps = __uint_as_float(rr[0]) + __uint_as_float(rr[1]); }
    l_reg = l_reg * alpha + ps;
#define PK4(P, BASE, OUT) do { unsigned a0 = cvt_pk_bf16(P[BASE + 0], P[BASE + 1]), a1 = cvt_pk_bf16(P[BASE + 2], P[BASE + 3]);   \
    unsigned b0 = cvt_pk_bf16(P[BASE + 4], P[BASE + 5]), b1 = cvt_pk_bf16(P[BASE + 6], P[BASE + 7]);                              \
    auto r0 = __builtin_amdgcn_permlane32_swap(a0, b0, false, false); auto r1 = __builtin_amdgcn_permlane32_swap(a1, b1, false, false); \
    u32x4 w = {r0[0], r1[0], r0[1], r1[1]}; OUT = *reinterpret_cast<bf16x8*>(&w); } while (0)
    PK4(p0, 0, pa0); PK4(p0, 8, pa1); PK4(p1, 0, pa2); PK4(p1, 8, pa3);
#undef PK4
}
template <int DQ> __device__ __forceinline__ void qkt(f32x16& p0, f32x16& p1, const char* Ks, const bf16x8* qr, const char* qx, int r32, int hi) {
    p0 = f32x16{}; p1 = f32x16{};
#pragma unroll
    for (int d0 = 0; d0 < Cf<DQ>::ND0; ++d0) { const int cb = (d0 * 16 + hi * 8) * 2;
        const bf16x8 b0 = *reinterpret_cast<const bf16x8*>(Ks + Cf<DQ>::kswz(r32, cb));
        const bf16x8 b1 = *reinterpret_cast<const bf16x8*>(Ks + Cf<DQ>::kswz(32 + r32, cb));
        constexpr int NQR = DQ == 192 ? MLA_NQR : 8;
        bf16x8 q; if (d0 < NQR) q = qr[d0]; else q = *reinterpret_cast<const bf16x8*>(qx + (d0 - NQR) * 1024);
        p0 = __builtin_amdgcn_mfma_f32_32x32x16_bf16(b0, q, p0, 0, 0, 0);
        p1 = __builtin_amdgcn_mfma_f32_32x32x16_bf16(b1, q, p1, 0, 0, 0); }
}
__device__ __forceinline__ int v_st(int k, int c) { const int kk = (k & ~0xC) | ((k & 4) << 1) | ((k & 8) >> 1); return ((kk >> 3) * 4 + (c >> 5)) * 512 + ((kk & 7) * 32 + (c & 31)) * 2; }
__device__ __forceinline__ int v_rd_base(int lane) { return ((lane & 3) << 3) | (((lane >> 2) & 3) << 6) | (((lane >> 4) & 1) << 5) | (((lane >> 5) & 1) << 8); }
constexpr int v_rd_off(int d0, int ks, int half) { return d0 * 512 + ks * 4096 + half * 2048; }
template <int OFF> __device__ __forceinline__ s16x4 tr_read(int vb) {
    s16x4 r; asm volatile("ds_read_b64_tr_b16 %0, %1 offset:%2" : "=&v"(r) : "v"(vb), "i"(OFF) : "memory"); return r;
}
template <int D0> __device__ __forceinline__ void pv_one(f32x16& od, int vb, bf16x8 pa0, bf16x8 pa1, bf16x8 pa2, bf16x8 pa3) {
    const s16x4 l0 = tr_read<v_rd_off(D0, 0, 0)>(vb), h0 = tr_read<v_rd_off(D0, 0, 1)>(vb), l1 = tr_read<v_rd_off(D0, 1, 0)>(vb), h1 = tr_read<v_rd_off(D0, 1, 1)>(vb);
    const s16x4 l2 = tr_read<v_rd_off(D0, 2, 0)>(vb), h2 = tr_read<v_rd_off(D0, 2, 1)>(vb), l3 = tr_read<v_rd_off(D0, 3, 0)>(vb), h3 = tr_read<v_rd_off(D0, 3, 1)>(vb);
    asm volatile("s_waitcnt lgkmcnt(0)" ::: "memory"); SBAR();
#define PK(L, H) (bf16x8){L[0], L[1], L[2], L[3], H[0], H[1], H[2], H[3]}
    od = __builtin_amdgcn_mfma_f32_32x32x16_bf16(pa0, PK(l0, h0), od, 0, 0, 0);
    od = __builtin_amdgcn_mfma_f32_32x32x16_bf16(pa1, PK(l1, h1), od, 0, 0, 0);
    od = __builtin_amdgcn_mfma_f32_32x32x16_bf16(pa2, PK(l2, h2), od, 0, 0, 0);
    od = __builtin_amdgcn_mfma_f32_32x32x16_bf16(pa3, PK(l3, h3), od, 0, 0, 0);
#undef PK
}
__device__ __forceinline__ void pv_d0(f32x16* o, int vb, bf16x8 pa0, bf16x8 pa1, bf16x8 pa2, bf16x8 pa3) {
    pv_one<0>(o[0], vb, pa0, pa1, pa2, pa3); pv_one<1>(o[1], vb, pa0, pa1, pa2, pa3); pv_one<2>(o[2], vb, pa0, pa1, pa2, pa3); pv_one<3>(o[3], vb, pa0, pa1, pa2, pa3);
}
__device__ __forceinline__ bf16x8 ld8(const bf16_t* p) { return *reinterpret_cast<const bf16x8*>(p); }

template <int DQ, int SD, int VAR = 0>
__device__ __forceinline__ void attn_body(const bf16_t* __restrict__ Qb, int ldq, const bf16_t* __restrict__ Kn, int ldkn, const bf16_t* __restrict__ Kr, int ldkr,
                                          const bf16_t* __restrict__ Vh, int ldv, unsigned char* __restrict__ Ob, int ldo, int seq, bool rope_q, int pos0, const float* __restrict__ tabM, char* lds, const int tid) {
    using CF = Cf<DQ>; constexpr int ND0 = CF::ND0, SHM_V = CF::SHM_V, SHM_K = CF::SHM_K;
    const int wid = tid >> 6, lane = tid & 63, r32 = lane & 31, hi = lane >> 5;
    char* V_lds = lds; char* K_lds = lds + 2 * SHM_V;
    float* ws = (float*)(lds + 2 * SHM_V + 2 * SHM_K) + wid * 64; float* li_l = ws; float* al_l = ws + 32;
    constexpr int NQR = DQ == 192 ? MLA_NQR : 8;
    float m_reg = -1e30f, l_reg = 0; f32x16 o[4] = {}; bf16x8 qr[NQR];
    const bf16_t* Qw = Qb + (long)(wid * QBLK + r32) * ldq + hi * 8;
#pragma unroll
    for (int d0 = 0; d0 < NQR; ++d0) qr[d0] = ld8(Qw + d0 * 16);
    char* qx = lds + CF::SHM + wid * 8192 + lane * 16;
    if constexpr (DQ == 192) {
#pragma unroll
        for (int d0 = NQR; d0 < 8; ++d0) *(bf16x8*)(qx + (d0 - NQR) * 1024) = ld8(Qw + d0 * 16);
        bf16x8 qe[4];
#pragma unroll
        for (int d0 = 0; d0 < 4; ++d0) qe[d0] = ld8(Qw + (8 + d0) * 16);
        if (rope_q) {
            const int pos = pos0 + wid * QBLK + r32, ri = pos >> 6, ci = pos & 63;
#pragma unroll
            for (int t = 0; t < 2; ++t) { const int p = t == 0 ? ri : ci; const float* tc = tabM + p * 16 + hi * 8; const float* tsn = tabM + 128 * 16 + p * 16 + hi * 8;
                bf16x8 a = qe[t], b = qe[2 + t];
#pragma unroll
                for (int jj = 0; jj < 8; ++jj) { const float x1 = bf2f((bf16_t)a[jj]), x2 = bf2f((bf16_t)b[jj]), c = tc[jj], s = tsn[jj];
                    a[jj] = (short)f2bf(x1 * c - x2 * s); b[jj] = (short)f2bf(x2 * c + x1 * s); }
                qe[t] = a; qe[2 + t] = b; }
        }
#pragma unroll
        for (int d0 = 0; d0 < 4; ++d0) *(bf16x8*)(qx + (8 - NQR + d0) * 1024) = qe[d0];
    }
    const int sr = tid >> 4, sc = (tid & 15) * 8, vst0 = v_st(sr, sc), vst1 = v_st(32 + sr, sc);
    const int sr2 = tid >> 3, sc2 = (tid & 7) * 8;
    const int vb0 = (int)(uintptr_t)V_lds + v_rd_base(lane);
    struct { bf16x8 vs0, vs1, ks0, ks1, ks2; } sr_[SD];
    const unsigned offV = (unsigned)(sr * ldv + sc) * 2u, offK = (unsigned)(sr * ldkn + sc) * 2u, offR = (unsigned)(sr2 * ldkr + sc2) * 2u;
#define SLOAD(i, k0) do { const char* vt_ = (const char*)Vh + (size_t)(k0) * ldv * 2; const char* kt_ = (const char*)Kn + (size_t)(k0) * ldkn * 2; \
    sr_[i].vs0 = *(const bf16x8*)(vt_ + offV); sr_[i].vs1 = *(const bf16x8*)(vt_ + (size_t)32 * ldv * 2 + offV); \
    sr_[i].ks0 = *(const bf16x8*)(kt_ + offK); sr_[i].ks1 = *(const bf16x8*)(kt_ + (size_t)32 * ldkn * 2 + offK); \
    if constexpr (DQ == 192) sr_[i].ks2 = *(const bf16x8*)((const char*)Kr + (size_t)(k0) * ldkr * 2 + offR); } while (0)
#define SWRITE(b, i) do { *(bf16x8*)(V_lds + (b) * SHM_V + vst0) = sr_[i].vs0; *(bf16x8*)(V_lds + (b) * SHM_V + vst1) = sr_[i].vs1; const int kc = sc * 2; \
    *(bf16x8*)(K_lds + (b) * SHM_K + CF::kswz(sr, kc)) = sr_[i].ks0; *(bf16x8*)(K_lds + (b) * SHM_K + CF::kswz(32 + sr, kc)) = sr_[i].ks1; \
    if constexpr (DQ == 192) *(bf16x8*)(K_lds + (b) * SHM_K + CF::kswz(sr2, 256 + sc2 * 2)) = sr_[i].ks2; } while (0)
#define SWAIT() do { if constexpr (SD == 1) asm volatile("s_waitcnt vmcnt(0)" ::: "memory"); else if constexpr (DQ == 192) asm volatile("s_waitcnt vmcnt(5)" ::: "memory"); else asm volatile("s_waitcnt vmcnt(4)" ::: "memory"); } while (0)
#define RESC(a) do { if (__any((a) < 1.f)) { if (hi == 0) al_l[r32] = (a); asm volatile("s_waitcnt lgkmcnt(0)" ::: "memory"); \
    _Pragma("unroll") for (int d = 0; d < 4; ++d) _Pragma("unroll") for (int r = 0; r < 16; ++r) o[d][r] *= al_l[crow(r, hi)]; } } while (0)
    f32x16 pA0, pA1, pB0, pB1; float mnA, mnB, alA, alB; bf16x8 pa0, pa1, pa2, pa3; const int NT = seq / KVBLK;
    constexpr int SE = 0, SO = SD - 1;
    SLOAD(SE, 0); asm volatile("s_waitcnt vmcnt(0)" ::: "memory"); SWRITE(0, SE); __syncthreads();
    qkt<DQ>(pA0, pA1, K_lds, qr, qx, r32, hi); partialSM<DQ, VAR>(pA0, pA1, m_reg, mnA, alA);
    SLOAD(SO, KVBLK); if constexpr (SD == 2) { if (2 < NT) SLOAD(SE, 2 * KVBLK); }
    SWAIT(); SWRITE(1, SO); __syncthreads();
#define ATT_SYNC() do { if constexpr (VAR != 2) __syncthreads(); } while (0)
    for (int j = 1; j + 1 < NT; j += 2) {
        SBAR(); qkt<DQ>(pB0, pB1, K_lds + SHM_K, qr, qx, r32, hi);
        finishSM<VAR>(pA0, pA1, alA, l_reg, pa0, pa1, pa2, pa3); SBAR();
        if constexpr (VAR != 3) SLOAD(SO, (j + SD) * KVBLK); SBAR();
        pv_d0(o, vb0, pa0, pa1, pa2, pa3); partialSM<DQ, VAR>(pB0, pB1, m_reg, mnB, alB);
        ATT_SYNC(); SWAIT(); SWRITE(0, SE);
        RESC(alB); ATT_SYNC();
        SBAR(); qkt<DQ>(pA0, pA1, K_lds, qr, qx, r32, hi);
        finishSM<VAR>(pB0, pB1, alB, l_reg, pa0, pa1, pa2, pa3); SBAR();
        if constexpr (VAR != 3) { if (SD == 1 || j + 3 < NT) SLOAD(SE, (j + 1 + SD) * KVBLK); } SBAR();
        pv_d0(o, vb0 + SHM_V, pa0, pa1, pa2, pa3); partialSM<DQ, VAR>(pA0, pA1, m_reg, mnA, alA);
        ATT_SYNC(); SWAIT(); SWRITE(1, SO);
        RESC(alA); ATT_SYNC();
    }
    SBAR(); qkt<DQ>(pB0, pB1, K_lds + SHM_K, qr, qx, r32, hi);
    finishSM<VAR>(pA0, pA1, alA, l_reg, pa0, pa1, pa2, pa3); SBAR();
    pv_d0(o, vb0, pa0, pa1, pa2, pa3); partialSM<DQ, VAR>(pB0, pB1, m_reg, mnB, alB);
    ATT_SYNC(); RESC(alB);
    finishSM<VAR>(pB0, pB1, alB, l_reg, pa0, pa1, pa2, pa3); SBAR();
    pv_d0(o, vb0 + SHM_V, pa0, pa1, pa2, pa3);
    if (hi == 0) li_l[r32] = l_reg; asm volatile("s_waitcnt lgkmcnt(0)" ::: "memory");
    float rli[16];
#pragma unroll
    for (int r = 0; r < 16; ++r) rli[r] = __builtin_amdgcn_rcpf(li_l[crow(r, hi)]);
    unsigned char* Ow = Ob + (long)(wid * QBLK) * ldo;
#pragma unroll
    for (int r = 0; r < 16; ++r) { const int orow = crow(r, hi);
#pragma unroll
        for (int d0 = 0; d0 < 4; ++d0) Ow[(long)orow * ldo + d0 * 32 + r32] = (unsigned char)(__builtin_amdgcn_cvt_pk_fp8_f32(o[d0][r] * rli[r] * 32.0f, 0.f, 0, false) & 0xff); }
#undef SLOAD
#undef ATT_SYNC
#undef SWRITE
#undef SWAIT
#undef RESC
}

__device__ __forceinline__ int k8addr(int row, int b, int DQ_) { return row * DQ_ + (b < 128 ? (b ^ ((row & 7) << 4)) : 128 + ((b - 128) ^ ((row & 3) << 4))); }
#define MX32(ACC, A, B, SC) asm volatile("s_nop 1\n\tv_mfma_scale_f32_32x32x64_f8f6f4 %0, %1, %2, %0, %3, %3 op_sel_hi:[0,0,0]" : "+v"(ACC) : "v"(A), "v"(B), "v"(SC))
#define MX32Z(ACC, A, B, SC) asm volatile("v_mfma_scale_f32_32x32x64_f8f6f4 %0, %1, %2, 0, %3, %3 op_sel_hi:[0,0,0]" : "=&v"(ACC) : "v"(A), "v"(B), "v"(SC))
template <int DQ, bool NOPS = true> __device__ __forceinline__ void qkt8(f32x16& p0, f32x16& p1, const char* Ks, const i32x8* qf, int r32, int hi) {
    int mxs = 0x7f7f7f7f; asm volatile("" : "+v"(mxs));
#pragma unroll
    for (int ks = 0; ks < DQ / 64; ++ks) { const int b = ks * 64 + hi * 32;
        const i32x4 a0l = *reinterpret_cast<const i32x4*>(Ks + k8addr(r32, b, DQ)), a0h = *reinterpret_cast<const i32x4*>(Ks + k8addr(r32, b + 16, DQ));
        const i32x4 a1l = *reinterpret_cast<const i32x4*>(Ks + k8addr(32 + r32, b, DQ)), a1h = *reinterpret_cast<const i32x4*>(Ks + k8addr(32 + r32, b + 16, DQ));
        const i32x8 a0 = __builtin_shufflevector(a0l, a0h, 0, 1, 2, 3, 4, 5, 6, 7), a1 = __builtin_shufflevector(a1l, a1h, 0, 1, 2, 3, 4, 5, 6, 7);
        if (ks == 0) { MX32Z(p0, a0, qf[ks], mxs); MX32Z(p1, a1, qf[ks], mxs); } else { MX32(p0, a0, qf[ks], mxs); MX32(p1, a1, qf[ks], mxs); } }
    if (NOPS) asm volatile("s_nop 15\n\ts_nop 7");
}
__device__ __forceinline__ int pk4_fp8(float a, float b, float c, float d) { int p = __builtin_amdgcn_cvt_pk_fp8_f32(a, b, 0, false); return __builtin_amdgcn_cvt_pk_fp8_f32(c, d, p, true); }
__device__ __forceinline__ int pk4_fp8u(float a, float b, float c, float d) { int u; asm volatile("" : "=v"(u)); const int p = __builtin_amdgcn_cvt_pk_fp8_f32(a, b, u, false); return __builtin_amdgcn_cvt_pk_fp8_f32(c, d, p, true); }
template <int DQ>
__device__ __forceinline__ void attn_body8(const bf16_t* __restrict__ Qb, int ldq, const unsigned char* __restrict__ Kn8, int ldkn, const unsigned char* __restrict__ Kr8, int ldkr,
                                           const bf16_t* __restrict__ Vh, int ldv, unsigned char* __restrict__ Ob, int ldo, int seq, bool rope_q, int pos0, const float* __restrict__ tabM, char* lds, const int tid) {
    constexpr int NKS = DQ / 64, SHM_V = KVBLK * DV * 2, SHM_K = KVBLK * DQ;
    const int wid = tid >> 6, lane = tid & 63, r32 = lane & 31, hi = lane >> 5;
    char* V_lds = lds; char* K_lds = lds + 2 * SHM_V;
    float* ws = (float*)(lds + 2 * SHM_V + 2 * SHM_K) + wid * 64; float* li_l = ws; float* al_l = ws + 32;
    float m_reg = -1e30f, l_reg = 0; f32x16 o[4] = {}; i32x8 qf[NKS];
    const bf16_t* Qrow = Qb + (long)(wid * QBLK + r32) * ldq;
#pragma unroll
    for (int ks = 0; ks < NKS; ++ks) {
        float x[32];
#pragma unroll
        for (int c = 0; c < 4; ++c) { const u32x4 w = *(const u32x4*)(Qrow + ks * 64 + hi * 32 + c * 8);
            x[c * 8 + 0] = bflo(w.x); x[c * 8 + 1] = bfhi(w.x); x[c * 8 + 2] = bflo(w.y); x[c * 8 + 3] = bfhi(w.y); x[c * 8 + 4] = bflo(w.z); x[c * 8 + 5] = bfhi(w.z); x[c * 8 + 6] = bflo(w.w); x[c * 8 + 7] = bfhi(w.w); }
        if (DQ == 192 && ks == 2 && rope_q) {
            float y[32];
#pragma unroll
            for (int c = 0; c < 4; ++c) { const u32x4 w = *(const u32x4*)(Qrow + 128 + (1 - hi) * 32 + c * 8);
                y[c * 8 + 0] = bflo(w.x); y[c * 8 + 1] = bfhi(w.x); y[c * 8 + 2] = bflo(w.y); y[c * 8 + 3] = bfhi(w.y); y[c * 8 + 4] = bflo(w.z); y[c * 8 + 5] = bfhi(w.z); y[c * 8 + 6] = bflo(w.w); y[c * 8 + 7] = bfhi(w.w); }
            const int pos = pos0 + wid * QBLK + r32, ri = pos >> 6, ci = pos & 63;
#pragma unroll
            for (int i = 0; i < 32; ++i) { const int p = i < 16 ? ri : ci, f = i & 15; const float c_ = tabM[p * 16 + f], s_ = tabM[128 * 16 + p * 16 + f];
                x[i] = hi ? x[i] * c_ + y[i] * s_ : x[i] * c_ - y[i] * s_; }
        }
        i32x8 q8;
#pragma unroll
        for (int j = 0; j < 8; ++j) q8[j] = pk4_fp8(x[4 * j], x[4 * j + 1], x[4 * j + 2], x[4 * j + 3]);
        qf[ks] = q8;
    }
    const int sr = tid >> 4, sc = (tid & 15) * 8, vst0 = v_st(sr, sc), vst1 = v_st(32 + sr, sc);
    const int kr = tid >> 3, kb = (tid & 7) * 16;
    const int kr2 = (tid & 255) >> 2, kb2 = (tid & 3) * 16;
    const int vb0 = (int)(uintptr_t)V_lds + v_rd_base(lane);
    struct { bf16x8 vs0, vs1; u32x4 k0, k1; } sr_[1];
    const unsigned offV = (unsigned)(sr * ldv + sc) * 2u, offK = (unsigned)(kr * ldkn + kb), offR = (unsigned)(kr2 * ldkr + kb2);
#define SLOAD8(k0_) do { const char* vt_ = (const char*)Vh + (size_t)(k0_) * ldv * 2; \
    sr_[0].vs0 = *(const bf16x8*)(vt_ + offV); sr_[0].vs1 = *(const bf16x8*)(vt_ + (size_t)32 * ldv * 2 + offV); \
    sr_[0].k0 = *(const u32x4*)(Kn8 + (size_t)(k0_) * ldkn + offK); \
    if constexpr (DQ == 192) { if (tid < 256) sr_[0].k1 = *(const u32x4*)(Kr8 + (size_t)(k0_) * ldkr + offR); } } while (0)
#define SWRITE8(b) do { *(bf16x8*)(V_lds + (b) * SHM_V + vst0) = sr_[0].vs0; *(bf16x8*)(V_lds + (b) * SHM_V + vst1) = sr_[0].vs1; \
    *(u32x4*)(K_lds + (b) * SHM_K + k8addr(kr, kb, DQ)) = sr_[0].k0; \
    if constexpr (DQ == 192) { if (tid < 256) *(u32x4*)(K_lds + (b) * SHM_K + k8addr(kr2, 128 + kb2, DQ)) = sr_[0].k1; } } while (0)
#define SWAIT8() asm volatile("s_waitcnt vmcnt(0)" ::: "memory")
#define RESC8(a) do { if (__any((a) < 1.f)) { if (hi == 0) al_l[r32] = (a); asm volatile("s_waitcnt lgkmcnt(0)" ::: "memory"); \
    _Pragma("unroll") for (int d = 0; d < 4; ++d) _Pragma("unroll") for (int r = 0; r < 16; ++r) o[d][r] *= al_l[crow(r, hi)]; } } while (0)
    f32x16 pA0, pA1, pB0, pB1; float mnA, mnB, alA, alB; bf16x8 pa0, pa1, pa2, pa3; const int NT = seq / KVBLK;
    SLOAD8(0); SWAIT8(); SWRITE8(0); __syncthreads();
    qkt8<DQ>(pA0, pA1, K_lds, qf, r32, hi); partialSM<DQ, 0>(pA0, pA1, m_reg, mnA, alA);
    SLOAD8(KVBLK);
    SWAIT8(); SWRITE8(1); __syncthreads();
    for (int j = 1; j + 1 < NT; j += 2) {
        SBAR(); qkt8<DQ>(pB0, pB1, K_lds + SHM_K, qf, r32, hi);
        finishSM<0>(pA0, pA1, alA, l_reg, pa0, pa1, pa2, pa3); SBAR();
        SLOAD8((j + 1) * KVBLK); SBAR();
        pv_d0(o, vb0, pa0, pa1, pa2, pa3); partialSM<DQ, 0>(pB0, pB1, m_reg, mnB, alB);
        __syncthreads(); SWAIT8(); SWRITE8(0);
        RESC8(alB); __syncthreads();
        SBAR(); qkt8<DQ>(pA0, pA1, K_lds, qf, r32, hi);
        finishSM<0>(pB0, pB1, alB, l_reg, pa0, pa1, pa2, pa3); SBAR();
        SLOAD8((j + 2) * KVBLK); SBAR();
        pv_d0(o, vb0 + SHM_V, pa0, pa1, pa2, pa3); partialSM<DQ, 0>(pA0, pA1, m_reg, mnA, alA);
        __syncthreads(); SWAIT8(); SWRITE8(1);
        RESC8(alA); __syncthreads();
    }
    SBAR(); qkt8<DQ>(pB0, pB1, K_lds + SHM_K, qf, r32, hi);
    finishSM<0>(pA0, pA1, alA, l_reg, pa0, pa1, pa2, pa3); SBAR();
    pv_d0(o, vb0, pa0, pa1, pa2, pa3); partialSM<DQ, 0>(pB0, pB1, m_reg, mnB, alB);
    __syncthreads(); RESC8(alB);
    finishSM<0>(pB0, pB1, alB, l_reg, pa0, pa1, pa2, pa3); SBAR();
    pv_d0(o, vb0 + SHM_V, pa0, pa1, pa2, pa3);
    if (hi == 0) li_l[r32] = l_reg; asm volatile("s_waitcnt lgkmcnt(0)" ::: "memory");
    float rli[16];
#pragma unroll
    for (int r = 0; r < 16; ++r) rli[r] = __builtin_amdgcn_rcpf(li_l[crow(r, hi)]);
    unsigned char* Ow = Ob + (long)(wid * QBLK) * ldo;
#pragma unroll
    for (int r = 0; r < 16; ++r) { const int orow = crow(r, hi);
#pragma unroll
        for (int d0 = 0; d0 < 4; ++d0) Ow[(long)orow * ldo + d0 * 32 + r32] = (unsigned char)(__builtin_amdgcn_cvt_pk_fp8_f32(o[d0][r] * rli[r] * 32.0f, 0.f, 0, false) & 0xff); }
#undef SLOAD8
#undef SWRITE8
#undef SWAIT8
#undef RESC8
}

__device__ __host__ __forceinline__ int vt8_key(int g, int j) { const int i = j & 15; return (j < 16 ? 0 : 32) + (i & 3) + 8 * (i >> 2) + 4 * g; }
template <int DQ>
__device__ __forceinline__ void attn_body88(const bf16_t* __restrict__ Qb, int ldq, const unsigned char* __restrict__ Kn8, int ldkn, const unsigned char* __restrict__ Kr8, int ldkr,
                                            const unsigned char* __restrict__ VT8, unsigned char* __restrict__ Ob, int ldo, int seq, bool rope_q, int pos0, const float* __restrict__ tabM, char* lds, const int tid) {
    constexpr int NKS = DQ / 64, SHM_V = 128 * 64, SHM_K = KVBLK * DQ;
    constexpr float EOFF = 7.0f, THR8 = 1.0f;
    const int wid = tid >> 6, lane = tid & 63, r32 = lane & 31, hi = lane >> 5;
    char* V_lds = lds; char* K_lds = lds + 2 * SHM_V;
    float* ws = (float*)(lds + 2 * SHM_V + 2 * SHM_K) + wid * 64; float* li_l = ws; float* al_l = ws + 32;
    float m_reg = -1e30f, l_reg = 0; f32x16 o[4] = {}; i32x8 qf[NKS];
    const bf16_t* Qrow = Qb + (long)(wid * QBLK + r32) * ldq;
#pragma unroll
    for (int ks = 0; ks < NKS; ++ks) {
        float x[32];
#pragma unroll
        for (int c = 0; c < 4; ++c) { const u32x4 w = *(const u32x4*)(Qrow + ks * 64 + hi * 32 + c * 8);
            x[c * 8 + 0] = bflo(w.x); x[c * 8 + 1] = bfhi(w.x); x[c * 8 + 2] = bflo(w.y); x[c * 8 + 3] = bfhi(w.y); x[c * 8 + 4] = bflo(w.z); x[c * 8 + 5] = bfhi(w.z); x[c * 8 + 6] = bflo(w.w); x[c * 8 + 7] = bfhi(w.w); }
        if (DQ == 192 && ks == 2 && rope_q) {
            float y[32];
#pragma unroll
            for (int c = 0; c < 4; ++c) { const u32x4 w = *(const u32x4*)(Qrow + 128 + (1 - hi) * 32 + c * 8);
                y[c * 8 + 0] = bflo(w.x); y[c * 8 + 1] = bfhi(w.x); y[c * 8 + 2] = bflo(w.y); y[c * 8 + 3] = bfhi(w.y); y[c * 8 + 4] = bflo(w.z); y[c * 8 + 5] = bfhi(w.z); y[c * 8 + 6] = bflo(w.w); y[c * 8 + 7] = bfhi(w.w); }
            const int pos = pos0 + wid * QBLK + r32, ri = pos >> 6, ci = pos & 63;
#pragma unroll
            for (int i = 0; i < 32; ++i) { const int p = i < 16 ? ri : ci, f = i & 15; const float c_ = tabM[p * 16 + f], s_ = tabM[128 * 16 + p * 16 + f];
                x[i] = hi ? x[i] * c_ + y[i] * s_ : x[i] * c_ - y[i] * s_; }
        }
        i32x8 q8;
#pragma unroll
        for (int j = 0; j < 8; ++j) q8[j] = pk4_fp8(x[4 * j], x[4 * j + 1], x[4 * j + 2], x[4 * j + 3]);
        qf[ks] = q8;
    }
    const int wu = __builtin_amdgcn_readfirstlane(wid);
    const unsigned lbase = __builtin_amdgcn_readfirstlane((unsigned)(uintptr_t)(LAS char*)lds), wofs = (unsigned)wu * 1024u;
    const int vr = tid >> 2;
    const unsigned offVd = (unsigned)((vr * 4 + ((tid & 3) ^ ((vr >> 2) & 3))) * 16);
    const unsigned char* kp0; const unsigned char* kp1 = nullptr; unsigned ks0, ks1 = 0;
    if constexpr (DQ == 128) { const int row = tid >> 3, c = tid & 7; kp0 = Kn8 + (size_t)row * ldkn + ((c ^ (row & 7)) << 4); ks0 = (unsigned)(KVBLK * ldkn); }
    else { { const int G = tid, row = G / 12, c = G % 12; const bool nope = c < 8;
             kp0 = nope ? Kn8 + (size_t)row * ldkn + ((c ^ (row & 7)) << 4) : Kr8 + (size_t)row * ldkr + (((c - 8) ^ (row & 3)) << 4); ks0 = (unsigned)(KVBLK * (nope ? ldkn : ldkr)); }
           { const int G = 512 + (tid & 255), row = G / 12, c = G % 12; const bool nope = c < 8;
             kp1 = nope ? Kn8 + (size_t)row * ldkn + ((c ^ (row & 7)) << 4) : Kr8 + (size_t)row * ldkr + (((c - 8) ^ (row & 3)) << 4); ks1 = (unsigned)(KVBLK * (nope ? ldkn : ldkr)); } }
#define DMA16(gp, loff) __builtin_amdgcn_global_load_lds((const unsigned*)(gp), (LAS unsigned*)(uintptr_t)(lbase + (unsigned)(loff) + wofs), 16, 0, 0)
#define DMAK(t_, b_) do { DMA16(kp0 + (size_t)(t_) * ks0, 2 * SHM_V + (b_) * SHM_K); \
        if constexpr (DQ == 192) { if (wu < 4) DMA16(kp1 + (size_t)(t_) * ks1, 2 * SHM_V + (b_) * SHM_K + 8192); } } while (0)
#define DMAV(t_, b_) DMA16(VT8 + (size_t)(t_) * 8192 + offVd, (b_) * SHM_V)
#define DWAIT() asm volatile("s_waitcnt vmcnt(0)" ::: "memory")
#define RESC8(a) do { if (__any((a) < 1.f)) { if (hi == 0) al_l[r32] = (a); asm volatile("s_waitcnt lgkmcnt(0)" ::: "memory"); \
    _Pragma("unroll") for (int d = 0; d < 4; ++d) _Pragma("unroll") for (int r = 0; r < 16; ++r) o[d][r] *= al_l[crow(r, hi)]; } } while (0)
#define FIN8(P0, P1, AL, PA) do { _Pragma("unroll") for (int r = 0; r < 16; ++r) P1[r] = __builtin_amdgcn_exp2f(P1[r]); \
    float ps_ = 0; _Pragma("unroll") for (int r = 0; r < 16; ++r) ps_ += P0[r]; _Pragma("unroll") for (int r = 0; r < 16; ++r) ps_ += P1[r]; \
    { auto rr_ = __builtin_amdgcn_permlane32_swap(__float_as_uint(ps_), __float_as_uint(ps_), false, false); ps_ = __uint_as_float(rr_[0]) + __uint_as_float(rr_[1]); } \
    l_reg = l_reg * (AL) + ps_; \
    _Pragma("unroll") for (int j = 0; j < 4; ++j) { PA[j] = pk4_fp8u(P0[4 * j], P0[4 * j + 1], P0[4 * j + 2], P0[4 * j + 3]); \
        PA[4 + j] = pk4_fp8u(P1[4 * j], P1[4 * j + 1], P1[4 * j + 2], P1[4 * j + 3]); } } while (0)
#define PV8(VB, PA, NOPS) do { int mxs_ = 0x7f7f7f7f; asm volatile("" : "+v"(mxs_)); _Pragma("unroll") for (int d0 = 0; d0 < 4; ++d0) { const int row_ = d0 * 32 + r32, xs_ = (row_ >> 2) & 3; \
        const i32x4 lo_ = *reinterpret_cast<const i32x4*>((VB) + row_ * 64 + (((2 * hi) ^ xs_) << 4)), hi_ = *reinterpret_cast<const i32x4*>((VB) + row_ * 64 + (((2 * hi + 1) ^ xs_) << 4)); \
        const i32x8 vb_ = __builtin_shufflevector(lo_, hi_, 0, 1, 2, 3, 4, 5, 6, 7); MX32(o[d0], PA, vb_, mxs_); } if (NOPS) asm volatile("s_nop 15\n\ts_nop 7"); } while (0)
    f32x16 pA0, pA1, pB0, pB1; float mnA, mnB, alA, alB; i32x8 pa; const int NT = seq / KVBLK;
#define PSM8(P0, P1, MN, AL) do { partialSM<DQ, 0>(P0, P1, m_reg, MN, AL, THR8, EOFF); RESC8(AL); } while (0)
    DMAK(0, 0); DMAV(0, 0); DMAK(1, 1); DWAIT(); __syncthreads();
    qkt8<DQ>(pA0, pA1, K_lds, qf, r32, hi); PSM8(pA0, pA1, mnA, alA);
    __syncthreads();
    for (int j = 1; j + 1 < NT; j += 2) {
        DMAK(j + 1, 0); DMAV(j, 1);
        SBAR(); qkt8<DQ, false>(pB0, pB1, K_lds + SHM_K, qf, r32, hi);
        FIN8(pA0, pA1, alA, pa); SBAR();
        PV8(V_lds, pa, 0); PSM8(pB0, pB1, mnB, alB);
        DWAIT(); __syncthreads();
        if (j + 2 < NT) DMAK(j + 2, 1);
        DMAV(j + 1, 0);
        SBAR(); qkt8<DQ, false>(pA0, pA1, K_lds, qf, r32, hi);
        FIN8(pB0, pB1, alB, pa); SBAR();
        PV8(V_lds + SHM_V, pa, 0); PSM8(pA0, pA1, mnA, alA);
        DWAIT(); __syncthreads();
    }
    DMAV(NT - 1, 1);
    SBAR(); qkt8<DQ, false>(pB0, pB1, K_lds + SHM_K, qf, r32, hi);
    FIN8(pA0, pA1, alA, pa); SBAR();
    PV8(V_lds, pa, 0); PSM8(pB0, pB1, mnB, alB);
    DWAIT(); __syncthreads();
    FIN8(pB0, pB1, alB, pa); SBAR();
    PV8(V_lds + SHM_V, pa, 1);
#undef PSM8
#undef DMA16
#undef DMAK
#undef DMAV
#undef DWAIT
    if (hi == 0) li_l[r32] = l_reg; asm volatile("s_waitcnt lgkmcnt(0)" ::: "memory");
    float rli[16];
#pragma unroll
    for (int r = 0; r < 16; ++r) rli[r] = __builtin_amdgcn_rcpf(li_l[crow(r, hi)]) * 32.0f;
    unsigned char* Ow = Ob + (long)(wid * QBLK) * ldo;
#pragma unroll
    for (int r = 0; r < 16; ++r) { const int orow = crow(r, hi);
#pragma unroll
        for (int d0 = 0; d0 < 4; ++d0) Ow[(long)orow * ldo + d0 * 32 + r32] = (unsigned char)(__builtin_amdgcn_cvt_pk_fp8_f32(o[d0][r] * rli[r], 0.f, 0, false) & 0xff); }
#undef RESC8
#undef FIN8
#undef PV8
}
#undef MX32
}

template <int KS> __device__ __forceinline__ void mma_xy(f32x16& acc, const LAS bf16_t* X, const LAS bf16_t* Y, int hi) {
#pragma unroll
    for (int ks = 0; ks < KS; ++ks) { const bf16x8 a = *(const LAS bf16x8*)(X + ks * 16 + hi * 8), b = *(const LAS bf16x8*)(Y + ks * 16 + hi * 8);
        acc = __builtin_amdgcn_mfma_f32_32x32x16_bf16(a, b, acc, 0, 0, 0); }
}
__device__ __forceinline__ float logsig16(float x) { const float e = __expf(-fabsf(x)); return (fminf(x, 0.f) - __logf(1.f + e)) * 0.0625f; }
__device__ __forceinline__ int gla_sidx(int b, int dir, int h) { return (b * 2 + dir) * 4 + h; }

__device__ __forceinline__ void gla_cumsum_lds(const Ctx& C, int l, int h, int dir, const LAS float* lr, LAS float* segtot, LAS float* CUM) {
    const int seg = C.tid >> 7, d = C.tid & 127;
    const float* wa = INP(dir ? I_WA2B : I_WA2F) + (size_t)l * 16 * 512 + h * 128 + d;
    const float bias = INP(dir ? I_BAB : I_BAF)[l * 512 + h * 128 + d];
    float w[16], cum[16];
#pragma unroll
    for (int j = 0; j < 16; ++j) w[j] = wa[j * 512];
    float run = 0.f;
#pragma unroll
    for (int i = 0; i < 16; ++i) { const int s = seg * 16 + i, tk = dir ? 63 - s : s; float pre = bias;
#pragma unroll
        for (int j = 0; j < 16; ++j) pre += lr[tk * 32 + dir * 16 + j] * w[j];
        run += logsig16(pre); cum[i] = run; }
    segtot[seg * 128 + d] = run;
    __syncthreads();
    float off = 0.f;
#pragma unroll
    for (int q = 0; q < 3; ++q) if (q < seg) off += segtot[q * 128 + d];
#pragma unroll
    for (int i = 0; i < 16; ++i) { const int s = seg * 16 + i, tk = dir ? 63 - s : s; CUM[tk * 132 + d] = cum[i] + off; }
    __syncthreads();
}
__device__ __forceinline__ void unpack8(const u32x4 w, float (&x)[8]) { x[0] = bflo(w.x); x[1] = bfhi(w.x); x[2] = bflo(w.y); x[3] = bfhi(w.y); x[4] = bflo(w.z); x[5] = bfhi(w.z); x[6] = bflo(w.w); x[7] = bfhi(w.w); }
__device__ __forceinline__ void gla_build_vt(const Ctx& C, const bf16_t* P, size_t r0, int h, LAS bf16_t* VT) {
    u32x4 v[4];
#pragma unroll
    for (int it = 0; it < 4; ++it) { const int idx = C.tid + it * NTHREADS, sv = idx >> 5, e0 = (idx & 31) * 8; v[it] = *(const u32x4*)(P + (r0 + sv) * NP + C_LV + h * 256 + e0); }
#pragma unroll
    for (int it = 0; it < 4; ++it) { const int idx = C.tid + it * NTHREADS, sv = idx >> 5, e0 = (idx & 31) * 8;
        const unsigned wd[4] = {v[it].x, v[it].y, v[it].z, v[it].w};
#pragma unroll
        for (int q = 0; q < 4; ++q) { VT[(e0 + 2 * q) * 72 + sv] = (bf16_t)(wd[q] & 0xffffu); VT[(e0 + 2 * q + 1) * 72 + sv] = (bf16_t)(wd[q] >> 16); } }
}

__device__ __forceinline__ void phase_gla_local(const Ctx& C, int l, int rot) {
    const bf16_t* P = WSP(bf16_t, WS_P); bf16_t* GST = WSP(bf16_t, WS_GST); float* GDEC = WSP(float, WS_GDEC);
    LAS float* lr = (LAS float*)C.lds;
    LAS float* segtot = (LAS float*)(C.lds + 8192);
    LAS bf16_t* KT = (LAS bf16_t*)(C.lds + 10240);
    LAS bf16_t* VT = (LAS bf16_t*)(C.lds + 28672);
    LAS float* CUM = (LAS float*)(C.lds + 65536);
    const int r32 = C.lane & 31, hi = C.lane >> 5, d = C.tid & 127;
    const int btk = C.tid >> 3, bdg = (C.tid & 7) * 16;
    for (int unit = (C.bid + C.G - rot % C.G) % C.G; unit < NBATCH * 4 * NCH; unit += C.G) {
        const int b = unit / (4 * NCH), h = (unit / NCH) % 4, ck = unit % NCH; const size_t r0 = (size_t)b * RPB + ck * 64;
        for (int i = C.tid; i < 64 * 32; i += NTHREADS) lr[i] = bf2f(P[(r0 + (i >> 5)) * NP + C_LRF + (i & 31)]);
        const u32x4 kw0 = *(const u32x4*)(P + (r0 + btk) * NP + C_LK + h * 128 + bdg), kw1 = *(const u32x4*)(P + (r0 + btk) * NP + C_LK + h * 128 + bdg + 8);
        gla_build_vt(C, P, r0, h, VT);
        __syncthreads();
#pragma unroll 1
        for (int dir = 0; dir < 2; ++dir) {
            gla_cumsum_lds(C, l, h, dir, lr, segtot, CUM);
            const int tend = dir ? 0 : 63;
            const size_t sx = (size_t)gla_sidx(b, dir, h) * NCH + ck;
            if (C.tid < 128) GDEC[sx * 128 + d] = __expf(CUM[tend * 132 + d]);
            { float kf[16]; { float t8[8]; unpack8(kw0, t8);
#pragma unroll
                for (int i = 0; i < 8; ++i) kf[i] = t8[i]; unpack8(kw1, t8);
#pragma unroll
                for (int i = 0; i < 8; ++i) kf[8 + i] = t8[i]; }
#pragma unroll
              for (int q = 0; q < 4; ++q) { const f32x4 cm = *(const LAS f32x4*)(CUM + btk * 132 + bdg + 4 * q), be = *(const LAS f32x4*)(CUM + tend * 132 + bdg + 4 * q);
#pragma unroll
                  for (int i = 0; i < 4; ++i) KT[(bdg + 4 * q + i) * 72 + btk] = f2bf(kf[4 * q + i] * __expf(be[i] - cm[i])); } }
            __syncthreads();
            { const int dt = C.wid & 3, eb = (C.wid >> 2) * 4;
              f32x16 acc[4] = {};
#pragma unroll
              for (int q = 0; q < 4; ++q) mma_xy<4>(acc[q], KT + (dt * 32 + r32) * 72, VT + ((eb + q) * 32 + r32) * 72, hi);
              bf16_t* st = GST + sx * 32768;
#pragma unroll
              for (int q = 0; q < 4; ++q)
#pragma unroll
                  for (int g = 0; g < 4; ++g) { u32x2 w; w.x = cvt_pk_bf16(acc[q][4 * g], acc[q][4 * g + 1]); w.y = cvt_pk_bf16(acc[q][4 * g + 2], acc[q][4 * g + 3]);
                      *(u32x2*)(st + (size_t)((eb + q) * 32 + r32) * 128 + dt * 32 + 8 * g + 4 * hi) = w; } }
            __syncthreads();
        }
    }
}

__device__ __forceinline__ void phase_gla_scan(const Ctx& C) {
    bf16_t* GST = WSP(bf16_t, WS_GST); const float* GDEC = WSP(float, WS_GDEC);
    for (int gid = C.bid * NTHREADS + C.tid; gid < 16 * 8192; gid += C.G * NTHREADS) {
        const int sidx = gid >> 13, g = gid & 8191, dir = (sidx >> 2) & 1, d4 = (g & 31) * 4;
        bf16_t* base = GST + (size_t)sidx * NCH * 32768 + (size_t)g * 4;
        const float* dbase = GDEC + (size_t)sidx * NCH * 128 + d4;
        float S[4] = {0.f, 0.f, 0.f, 0.f};
        for (int st = 0; st < NCH; st += 4) {
            int ck[4]; u32x2 L[4]; f32x4 dc[4];
#pragma unroll
            for (int q = 0; q < 4; ++q) { const int s = st + q; ck[q] = dir ? (s < 4 ? 3 - s : NCH + 3 - s) : s;
                L[q] = *(const u32x2*)(base + (size_t)ck[q] * 32768); dc[q] = *(const f32x4*)(dbase + (size_t)ck[q] * 128); }
#pragma unroll
            for (int q = 0; q < 4; ++q) { u32x2 w; w.x = cvt_pk_bf16(S[0], S[1]); w.y = cvt_pk_bf16(S[2], S[3]);
                *(u32x2*)(base + (size_t)ck[q] * 32768) = w;
                S[0] = dc[q][0] * S[0] + bflo(L[q].x); S[1] = dc[q][1] * S[1] + bfhi(L[q].x); S[2] = dc[q][2] * S[2] + bflo(L[q].y); S[3] = dc[q][3] * S[3] + bfhi(L[q].y); }
        }
    }
}

__device__ __forceinline__ void phase_gla_out(const Ctx& C, int l, int rot) {
    const bf16_t* P = WSP(bf16_t, WS_P); const bf16_t* GST = WSP(bf16_t, WS_GST); unsigned char* OL = C.ws + WS_OL;
    LAS float* lr = (LAS float*)C.lds;
    LAS float* segtot = (LAS float*)(C.lds + 8192);
    LAS bf16_t* QT = (LAS bf16_t*)(C.lds + 10240);
    LAS bf16_t* KT = (LAS bf16_t*)(C.lds + 27648);
    LAS bf16_t* VT = (LAS bf16_t*)(C.lds + 45056);
    LAS bf16_t* SCm = (LAS bf16_t*)(C.lds + 81920);
    LAS float* OB = (LAS float*)(C.lds + 91136);
    LAS float* CUM = OB;
    const float* gon = INP(I_ONG) + l * 256;
    const int r32 = C.lane & 31, hi = C.lane >> 5;
    const int btk = C.tid >> 3, bdg = (C.tid & 7) * 16;
    const bool lastl = l + 1 >= DEPTH; const int nck = lastl ? NCH - CTXL / 64 : NCH;
    for (int unit = (C.bid + C.G - rot % C.G) % C.G; unit < NBATCH * 4 * nck; unit += C.G) {
        const int b = unit / (4 * nck), h = (unit / nck) % 4, ck = unit % nck + (NCH - nck); const size_t r0 = (size_t)b * RPB + ck * 64;
        for (int i = C.tid; i < 64 * 32; i += NTHREADS) lr[i] = bf2f(P[(r0 + (i >> 5)) * NP + C_LRF + (i & 31)]);
        const bf16_t* qp = P + (r0 + btk) * NP + C_LQ + h * 128 + bdg; const bf16_t* kp = P + (r0 + btk) * NP + C_LK + h * 128 + bdg;
        const u32x4 qw0 = *(const u32x4*)qp, qw1 = *(const u32x4*)(qp + 8), kw0 = *(const u32x4*)kp, kw1 = *(const u32x4*)(kp + 8);
        gla_build_vt(C, P, r0, h, VT);
        __syncthreads();
        f32x16 oacc[2] = {};
#pragma unroll 1
        for (int dir = 0; dir < 2; ++dir) {
            gla_cumsum_lds(C, l, h, dir, lr, segtot, CUM);
            { float qf[8], kf[8];
#pragma unroll
              for (int hh = 0; hh < 2; ++hh) { unpack8(hh ? qw1 : qw0, qf); unpack8(hh ? kw1 : kw0, kf);
                  const f32x4 c0 = *(const LAS f32x4*)(CUM + btk * 132 + bdg + 8 * hh), c1 = *(const LAS f32x4*)(CUM + btk * 132 + bdg + 8 * hh + 4);
                  float qo[8], ko[8];
#pragma unroll
                  for (int i = 0; i < 8; ++i) { const float cm = i < 4 ? c0[i & 3] : c1[i & 3]; qo[i] = qf[i] * __expf(cm) * 0.088388347648318440f; ko[i] = kf[i] * __expf(-cm); }
                  u32x4 wq, wk; wq.x = cvt_pk_bf16(qo[0], qo[1]); wq.y = cvt_pk_bf16(qo[2], qo[3]); wq.z = cvt_pk_bf16(qo[4], qo[5]); wq.w = cvt_pk_bf16(qo[6], qo[7]);
                  wk.x = cvt_pk_bf16(ko[0], ko[1]); wk.y = cvt_pk_bf16(ko[2], ko[3]); wk.z = cvt_pk_bf16(ko[4], ko[5]); wk.w = cvt_pk_bf16(ko[6], ko[7]);
                  *(LAS u32x4*)(QT + btk * 136 + bdg + 8 * hh) = wq; *(LAS u32x4*)(KT + btk * 136 + bdg + 8 * hh) = wk; } }
            __syncthreads();
            if (C.wid < 4) { const int mt = C.wid >> 1, nt = C.wid & 1; f32x16 sc = {};
                mma_xy<8>(sc, QT + (mt * 32 + r32) * 136, KT + (nt * 32 + r32) * 136, hi);
#pragma unroll
                for (int i = 0; i < 16; ++i) { const int t = mt * 32 + att::crow(i, hi), sx_ = nt * 32 + r32; const bool keep = dir ? (sx_ >= t) : (sx_ <= t);
                    SCm[t * 72 + sx_] = f2bf(keep ? sc[i] : 0.f); } }
            __syncthreads();
            { const bf16_t* st = GST + ((size_t)gla_sidx(b, dir, h) * NCH + ck) * 32768 + (size_t)(C.wid * 32 + r32) * 128 + hi * 8;
              bf16x8 sb[8];
#pragma unroll
              for (int ks = 0; ks < 8; ++ks) sb[ks] = *(const bf16x8*)(st + ks * 16);
#pragma unroll
              for (int mt = 0; mt < 2; ++mt) {
                  mma_xy<4>(oacc[mt], SCm + (mt * 32 + r32) * 72, VT + (C.wid * 32 + r32) * 72, hi);
#pragma unroll
                  for (int ks = 0; ks < 8; ++ks) { const bf16x8 a = *(const LAS bf16x8*)(QT + (mt * 32 + r32) * 136 + ks * 16 + hi * 8);
                      oacc[mt] = __builtin_amdgcn_mfma_f32_32x32x16_bf16(a, sb[ks], oacc[mt], 0, 0, 0); } } }
            __syncthreads();
        }
#pragma unroll
        for (int mt = 0; mt < 2; ++mt)
#pragma unroll
            for (int i = 0; i < 16; ++i) OB[(mt * 32 + att::crow(i, hi)) * 260 + C.wid * 32 + r32] = oacc[mt][i];
        __syncthreads();
        { const int t = C.tid >> 3, part = C.tid & 7; f32x4 v[8]; float ss = 0.f;
#pragma unroll
          for (int jj = 0; jj < 8; ++jj) { v[jj] = *(const LAS f32x4*)(OB + t * 260 + jj * 32 + part * 4); ss += v[jj][0] * v[jj][0] + v[jj][1] * v[jj][1] + v[jj][2] * v[jj][2] + v[jj][3] * v[jj][3]; }
          ss += dppmov<DPP_HMIRROR>(ss); ss += dppmov<DPP_Q3210>(ss); ss += dppmov<DPP_Q1032>(ss);
          const float rs = rsqrtf(ss * (1.0f / 256.0f) + NORM_EPS);
#pragma unroll
          for (int jj = 0; jj < 8; ++jj) { const int e = jj * 32 + part * 4; const f32x4 g = *(const f32x4*)(gon + e);
              const u32x2 gt = *(const u32x2*)(P + (r0 + t) * NP + C_LG + h * 256 + e);
              const float o0 = v[jj][0] * rs * g[0] * siluf_(bflo(gt.x)), o1 = v[jj][1] * rs * g[1] * siluf_(bfhi(gt.x)), o2 = v[jj][2] * rs * g[2] * siluf_(bflo(gt.y)), o3 = v[jj][3] * rs * g[3] * siluf_(bfhi(gt.y));
              int p8 = __builtin_amdgcn_cvt_pk_fp8_f32(o0, o1, 0, false); p8 = __builtin_amdgcn_cvt_pk_fp8_f32(o2, o3, p8, true);
              *(unsigned*)(OL + (r0 + t) * 1024 + h * 256 + e) = (unsigned)p8; } }
        __syncthreads();
    }
}

__device__ __forceinline__ unsigned f_ord(float f) { const unsigned u = __float_as_uint(f); return u ^ ((unsigned)((int)u >> 31) | 0x80000000u); }
__device__ __forceinline__ float f_unord(unsigned k) { return __uint_as_float((k & 0x80000000u) ? (k ^ 0x80000000u) : ~k); }
__device__ __forceinline__ void ins_u(unsigned (&L)[16], unsigned x) {
#pragma unroll
    for (int j = 0; j < 16; ++j) { const unsigned h = L[j] > x ? L[j] : x; x = L[j] > x ? x : L[j]; L[j] = h; }
}
__device__ __forceinline__ void ins_f(float (&M)[16], float x) {
#pragma unroll
    for (int j = 0; j < 16; ++j) { const float h = M[j] > x ? M[j] : x; x = M[j] > x ? x : M[j]; M[j] = h; }
}
__device__ __forceinline__ void peer_top16(const bf16_t* __restrict__ qrow, const bf16_t* __restrict__ keys, int r32, int hi, unsigned (&L)[16]) {
    bf16x8 qf[8];
#pragma unroll
    for (int kk = 0; kk < 8; ++kk) qf[kk] = *(const bf16x8*)(qrow + kk * 16 + hi * 8);
#pragma unroll
    for (int j = 0; j < 16; ++j) L[j] = 0u;
    bf16x8 kA[8], kB[8];
    const bf16_t* kl = keys + (size_t)r32 * 128 + hi * 8;
#define PT_LDK(dst, mt) do { _Pragma("unroll") for (int kk = 0; kk < 8; ++kk) dst[kk] = *(const bf16x8*)(kl + (mt) * 32 * 128 + kk * 16); } while (0)
#define PT_PROC(src, mt) do { f32x16 acc = {}; \
        _Pragma("unroll") for (int kk = 0; kk < 8; ++kk) acc = __builtin_amdgcn_mfma_f32_32x32x16_bf16(src[kk], qf[kk], acc, 0, 0, 0); \
        _Pragma("unroll") for (int i = 0; i < 16; ++i) { const unsigned kidx = (unsigned)((mt) * 32 + att::crow(i, hi)); ins_u(L, (f_ord(acc[i]) & ~127u) | (127u - kidx)); } } while (0)
    PT_LDK(kA, 0);
#pragma unroll 1
    for (int mp = 0; mp < 2; ++mp) { PT_LDK(kB, 2 * mp + 1); PT_PROC(kA, 2 * mp); if (mp == 0) PT_LDK(kA, 2); PT_PROC(kB, 2 * mp + 1); }
#undef PT_LDK
#undef PT_PROC
    unsigned Pn[16];
#pragma unroll
    for (int j = 0; j < 16; ++j) { auto r_ = __builtin_amdgcn_permlane32_swap(L[j], L[j], false, false); Pn[j] = hi ? r_[0] : r_[1]; }
#pragma unroll
    for (int j = 0; j < 16; ++j) ins_u(L, Pn[j]);
}
__device__ __forceinline__ void phase_peer_select(const Ctx& C, const bool latent_only) {
    const bf16_t* PQ = WSP(bf16_t, WS_PQ); const bf16_t* K1 = WSP(bf16_t, WS_K1); const bf16_t* K2 = WSP(bf16_t, WS_K2);
    int* PIDX = WSP(int, WS_PIDX); float* PG = WSP(float, WS_PG);
    const int r32 = C.lane & 31, hi = C.lane >> 5, head = C.wid;
    const int ngrp = latent_only ? NBATCH * SEQ / 32 : TT / 32;
    for (int gi = C.bid; gi < ngrp; gi += C.G) {
        const int grp = latent_only ? gi + (CTXL / 32) * (1 + gi / (SEQ / 32)) : gi;
        const size_t tok = (size_t)grp * 32 + r32;
        unsigned L1[16], L2[16];
        peer_top16(PQ + tok * DM + head * 256, K1 + (size_t)head * 128 * 128, r32, hi, L1);
        peer_top16(PQ + tok * DM + head * 256 + 128, K2 + (size_t)head * 128 * 128, r32, hi, L2);
        float v1[16], v2[16];
#pragma unroll
        for (int j = 0; j < 16; ++j) { v1[j] = f_unord(L1[j] & ~127u); v2[j] = f_unord(L2[j] & ~127u); }
        float M[16];
#pragma unroll
        for (int j = 0; j < 16; ++j) M[j] = -3.0e38f;
#pragma unroll
        for (int a = 0; a < 16; ++a)
#pragma unroll
            for (int b = 0; b < 16; ++b) if ((a + 1) * (b + 1) <= 16) ins_f(M, v1[a] + v2[b]);
        const float thr = M[15], mx = M[0]; float den = 0.f;
#pragma unroll
        for (int j = 0; j < 16; ++j) den += __expf(M[j] - mx);
        const float rden = 1.0f / den;
        int pos = 0; int* ip = PIDX + tok * 128 + head * 16; float* gp = PG + tok * 128 + head * 16;
#pragma unroll
        for (int a = 0; a < 16; ++a)
#pragma unroll
            for (int b = 0; b < 16; ++b) if ((a + 1) * (b + 1) <= 16) {
                const float val = v1[a] + v2[b];
                if (val >= thr && pos < 16) { if (hi == 0) { ip[pos] = (int)((127u - (L1[a] & 127u)) * 128u + (127u - (L2[b] & 127u))); gp[pos] = __expf(val - mx) * rden; } ++pos; } }
    }
}
template <int OFF> __device__ __forceinline__ float dotf8(const float (&h)[32], const u32x4 w, float acc) {
#pragma unroll
    for (int j = 0; j < 4; ++j) { const f32x2 lo = __builtin_amdgcn_cvt_pk_f32_fp8((int)w[j], false), hi = __builtin_amdgcn_cvt_pk_f32_fp8((int)w[j], true);
        acc += h[OFF + 4 * j] * lo.x; acc += h[OFF + 4 * j + 1] * lo.y; acc += h[OFF + 4 * j + 2] * hi.x; acc += h[OFF + 4 * j + 3] * hi.y; }
    return acc;
}
constexpr float ATT_O8_SCALE = 32.0f;
constexpr int GT_MAXTOK = 9;
template <bool LAST> __device__ __forceinline__ void phase_peer_gather(const Ctx& C, const float* modl, const float pscale) {
    const unsigned char* pt = C.ws + WS_PT + (size_t)(LAST ? DEPTH - 1 : 0) * PT_BYTES;
    const bf16_t* HB = WSP(bf16_t, WS_HB); const unsigned char* U8 = pt + PT_U8; const unsigned char* V8 = pt + PT_V8;
    const float* SCU = (const float*)(pt + PT_SCU); const float* SCV = (const float*)(pt + PT_SCV);
    const int* PIDX = WSP(int, WS_PIDX); const float* PG = WSP(float, WS_PG); float* XS = WSP(float, WS_XS);
    const int lane = C.lane, s = lane >> 3, j = lane & 7; const unsigned j16 = (unsigned)j * 16u;
    LAS int* IDS = (LAS int*)(C.lds + C.wid * (GT_MAXTOK * 512));
    LAS float* ACT = (LAS float*)(C.lds + 8 * GT_MAXTOK * 512 + C.wid * (GT_MAXTOK * 512));
    LAS int* ROWS = (LAS int*)(C.lds + 16 * GT_MAXTOK * 512 + C.wid * 64);
    int nk = 0;
    {
      const int nrows = LAST ? NBATCH * SEQ : TT, per = (nrows + C.G - 1) / C.G, base = C.bid * per;
#pragma unroll 1
      for (int k = 0; k < GT_MAXTOK; ++k) { const int o = C.wid + 8 * k; const int i = base + o; const int r = LAST ? (i / SEQ) * RPB + CTXL + i % SEQ : i;
          if (o < per && i < nrows) { if (lane == 0) ROWS[nk] = r; ++nk; } } }
#define GT_ROW(k) __builtin_amdgcn_readfirstlane(ROWS[k])
#pragma unroll 1
    for (int k = 0; k < nk; ++k) { const int r = GT_ROW(k);
        IDS[k * 128 + lane] = (PIDX[(size_t)r * 128 + lane] & (NEXP - 1)) << 7; IDS[k * 128 + 64 + lane] = (PIDX[(size_t)r * 128 + 64 + lane] & (NEXP - 1)) << 7;
        ACT[k * 128 + lane] = 0.f; ACT[k * 128 + 64 + lane] = 0.f; }
    const int nit = 32 * nk;
#define GT_ITEM(it_) const int cb_ = (it_) / (2 * nk), rem_ = (it_) - cb_ * (2 * nk), k_ = rem_ >> 1, hf_ = rem_ & 1
#define GT_LOADU(UQ, HQ, it_) do { GT_ITEM(it_); const int r_ = GT_ROW(k_); \
        const bf16_t* hp_ = HB + (size_t)r_ * DM + cb_ * 128 + j * 16; HQ[0] = *(const u32x4*)hp_; HQ[1] = *(const u32x4*)(hp_ + 8); \
        const unsigned char* ub_ = U8 + (size_t)cb_ * ((size_t)NEXP * 128);     \
        _Pragma("unroll") for (int eg = 0; eg < 8; ++eg) { const unsigned off_ = ((unsigned)IDS[k_ * 128 + (hf_ * 8 + eg) * 8 + s] & idmask) + j16; UQ[eg] = *(const u32x4*)(ub_ + off_); } } while (0)
#define GT_COMPU(UQ, HQ, it_) do { GT_ITEM(it_); (void)cb_; f32x2 hf2[8]; \
        _Pragma("unroll") for (int hh = 0; hh < 2; ++hh) { const u32x4 w_ = HQ[hh]; \
            hf2[hh * 4 + 0] = (f32x2){bflo(w_.x), bfhi(w_.x)}; hf2[hh * 4 + 1] = (f32x2){bflo(w_.y), bfhi(w_.y)}; hf2[hh * 4 + 2] = (f32x2){bflo(w_.z), bfhi(w_.z)}; hf2[hh * 4 + 3] = (f32x2){bflo(w_.w), bfhi(w_.w)}; } \
        float d[8]; \
        _Pragma("unroll") for (int eg = 0; eg < 8; ++eg) { f32x2 d2 = (f32x2){0.f, 0.f}; \
            _Pragma("unroll") for (int q = 0; q < 4; ++q) { const f32x2 lo = __builtin_amdgcn_cvt_pk_f32_fp8((int)UQ[eg][q], false), hi = __builtin_amdgcn_cvt_pk_f32_fp8((int)UQ[eg][q], true); \
                d2 += hf2[2 * q] * lo; d2 += hf2[2 * q + 1] * hi; } \
            d[eg] = d2.x + d2.y; } \
          \
        float t4[4], t2[2], t1; \
        _Pragma("unroll") for (int i = 0; i < 4; ++i) { const float snd = (j & 4) ? d[i] : d[i + 4], kp = (j & 4) ? d[i + 4] : d[i]; t4[i] = kp + dppmov<DPP_HMIRROR>(snd); } \
        _Pragma("unroll") for (int i = 0; i < 2; ++i) { const float snd = (j & 2) ? t4[i] : t4[i + 2], kp = (j & 2) ? t4[i + 2] : t4[i]; t2[i] = kp + dppmov<DPP_Q3210>(snd); } \
        { const float snd = (j & 1) ? t2[0] : t2[1], kp = (j & 1) ? t2[1] : t2[0]; t1 = kp + dppmov<DPP_Q1032>(snd); } \
        ACT[k_ * 128 + (hf_ * 8 + j) * 8 + s] += t1; } while (0)
#ifdef DBG_GDUP
#pragma unroll 1
    for (int rep_ = 0; rep_ < 2; ++rep_) {
    const unsigned idmask = rep_ == 0 ? ((unsigned)DBG_GMASK << 7 | 127u) : 0xffffffffu;
    if (rep_ == 1) { for (int k = 0; k < nk; ++k) { ACT[k * 128 + lane] = 0.f; ACT[k * 128 + 64 + lane] = 0.f; } }
#else
    { const unsigned idmask = 0xffffffffu;
#endif
    if (nit > 0) {
        u32x4 uA[8], uB[8], hA[2], hB[2];
        GT_LOADU(uA, hA, 0);
#pragma unroll 1
        for (int it = 0; it < nit; it += 2) {
            GT_LOADU(uB, hB, it + 1);
            GT_COMPU(uA, hA, it);
            if (it + 2 < nit) GT_LOADU(uA, hA, it + 2);
            GT_COMPU(uB, hB, it + 1);
        }
    }
    }
#undef GT_LOADU
#undef GT_COMPU
#pragma unroll 1
    for (int k = 0; k < nk; ++k) { const int r = GT_ROW(k);
#pragma unroll
        for (int hh = 0; hh < 2; ++hh) { const int e = hh * 64 + lane; const int id = IDS[k * 128 + e] >> 7; const float a = ACT[k * 128 + e] * SCU[id];
            const float w = PG[(size_t)r * 128 + e] * 0.5f * a * (1.0f + erff(a * 0.70710678118654752f));
#if defined(DBG_CHECK) && (DBG_CHECK == 3 || DBG_CHECK == 4)
            if (((r - 300) & 63) == 0 && r >= 300 && r < 300 + 64 * 128) WSP(float, WS_OM)[(size_t)r * 128 + e] = w;
#endif
            ACT[k * 128 + e] = w * SCV[id]; } }
#define GT_LOADV(VQ, WV, it_) do { GT_ITEM(it_); const unsigned char* vb_ = V8 + (size_t)cb_ * ((size_t)NEXP * 128); \
        _Pragma("unroll") for (int eg = 0; eg < 8; ++eg) { const int e_ = k_ * 128 + (hf_ * 8 + eg) * 8 + s; const unsigned off_ = (unsigned)IDS[e_] + j16; VQ[eg] = *(const u32x4*)(vb_ + off_); WV[eg] = ACT[e_]; } } while (0)
#define GT_COMPV(VQ, WV) do { \
        _Pragma("unroll") for (int eg = 0; eg < 8; ++eg) { const f32x2 w2_ = (f32x2){WV[eg], WV[eg]}; \
            _Pragma("unroll") for (int q = 0; q < 4; ++q) { \
                const f32x2 lo = __builtin_amdgcn_cvt_pk_f32_fp8((int)VQ[eg][q], false), hi = __builtin_amdgcn_cvt_pk_f32_fp8((int)VQ[eg][q], true); \
                acc2[2 * q] += w2_ * lo; acc2[2 * q + 1] += w2_ * hi; } } } while (0)
    if (nit > 0) {
        u32x4 vA[8], vB[8]; float wA[8], wB[8];
        GT_LOADV(vA, wA, 0);
#pragma unroll 1
        for (int it = 0; it < nit; it += 2) {
            f32x2 acc2[8];
#pragma unroll
            for (int i = 0; i < 8; ++i) acc2[i] = (f32x2){0.f, 0.f};
            GT_LOADV(vB, wB, it + 1);
            GT_COMPV(vA, wA);
            if (it + 2 < nit) GT_LOADV(vA, wA, it + 2);
            GT_COMPV(vB, wB);
            f32x2 t4[4], t2[2], t1;
#pragma unroll
            for (int i = 0; i < 4; ++i) { const f32x2 snd = (s & 4) ? acc2[i] : acc2[i + 4], kp = (s & 4) ? acc2[i + 4] : acc2[i];
                t4[i] = kp + (f32x2){xchg32(snd.x, lane), xchg32(snd.y, lane)}; }
#pragma unroll
            for (int i = 0; i < 2; ++i) { const f32x2 snd = (s & 2) ? t4[i] : t4[i + 2], kp = (s & 2) ? t4[i + 2] : t4[i];
                t2[i] = kp + (f32x2){xchg16(snd.x, lane), xchg16(snd.y, lane)}; }
            { const f32x2 snd = (s & 1) ? t2[0] : t2[1], kp = (s & 1) ? t2[1] : t2[0]; t1 = kp + (f32x2){dppmov<DPP_ROR8>(snd.x), dppmov<DPP_ROR8>(snd.y)}; }
            { GT_ITEM(it); (void)hf_; const int r_ = GT_ROW(k_);
              const int col = cb_ * 128 + j * 16 + 2 * s; float* xp = XS + (size_t)r_ * DM + col; const float* g2 = modl + (size_t)mod_sel(r_) * 12288 + 5 * DM + col;
#if defined(DBG_CHECK) && (DBG_CHECK == 3 || DBG_CHECK == 4)
              if (((r_ - 300) & 63) == 0 && r_ >= 300 && r_ < 300 + 64 * 128) { float* dbgo = WSP(float, WS_MQ) + (size_t)r_ * DM + col; dbgo[0] = t1.x; dbgo[1] = t1.y; }
#endif
              const f32x2 x = *(const f32x2*)xp, g = *(const f32x2*)g2;
              *(f32x2*)xp = x + pscale * g * t1; }
        }
    }
#undef GT_LOADV
#undef GT_COMPV
#undef GT_ITEM
#undef GT_ROW
}
__device__ __forceinline__ void phase_final_norm(const Ctx& C) {
    const float* XS = WSP(float, WS_XS); const float* fg = INP(I_FG);
    for (int q = C.bid * 8 + C.wid; q < NBATCH * SEQ; q += C.G * 8) {
        const int b = q / SEQ, t = q % SEQ; const float* xr = XS + ((size_t)b * RPB + CTXL + t) * DM; float* op = C.out + (size_t)q * DM;
        f32x4 v[8]; float ss = 0.f;
#pragma unroll
        for (int c = 0; c < 8; ++c) { v[c] = *(const f32x4*)(xr + c * 256 + C.lane * 4); ss += v[c][0] * v[c][0] + v[c][1] * v[c][1] + v[c][2] * v[c][2] + v[c][3] * v[c][3]; }
        ss = wave_sum(ss); const float rs = rsqrtf(ss * (1.0f / DM) + NORM_EPS);
#pragma unroll
        for (int c = 0; c < 8; ++c) { const f32x4 g = *(const f32x4*)(fg + c * 256 + C.lane * 4); *(f32x4*)(op + c * 256 + C.lane * 4) = v[c] * rs * g; }
    }
}


__device__ __forceinline__ void phase_vt8(const Ctx& C) {
    const bf16_t* P = WSP(bf16_t, WS_P); const bf16_t* MKV = WSP(bf16_t, WS_MKV);
    const int dv = C.tid & 127, kq = C.tid >> 7, g = kq >> 1, j0 = (kq & 1) * 16;
    constexpr int NU_A = NBATCH * 2 * NCH, NU_M = NBATCH * 8 * NCH;
    for (int u = C.bid; u < NU_A + NU_M; u += C.G) {
        const bool gqa = u < NU_A; const int v = gqa ? u : u - NU_A; const int nh = gqa ? 2 : 8;
        const int b = v / (nh * NCH), h = (v / NCH) % nh, t = v % NCH; const size_t r0 = (size_t)b * RPB + t * 64;
        const bf16_t* src = gqa ? P + r0 * NP + C_AV + h * 128 + dv : MKV + r0 * 2048 + h * 256 + 128 + dv; const size_t ld = gqa ? NP : 2048;
        float x[16];
#pragma unroll
        for (int jj = 0; jj < 16; ++jj) x[jj] = bf2f(src[(size_t)att::vt8_key(g, j0 + jj) * ld]);
        u32x4 w; w.x = (unsigned)att::pk4_fp8(x[0], x[1], x[2], x[3]); w.y = (unsigned)att::pk4_fp8(x[4], x[5], x[6], x[7]); w.z = (unsigned)att::pk4_fp8(x[8], x[9], x[10], x[11]); w.w = (unsigned)att::pk4_fp8(x[12], x[13], x[14], x[15]);
        unsigned char* dst = C.ws + (gqa ? WS_VT8A : WS_VT8M) + ((size_t)(b * nh + h) * NCH + t) * 8192 + dv * 64 + kq * 16;
        *(u32x4*)dst = w;
    }
}
template <int TYPE  , int VAR = 0> __device__ __forceinline__ void attn_units(const Ctx& C, bool need_ctx) {
    const bf16_t* P = WSP(bf16_t, WS_P);
    const int nu = need_ctx ? 528 : 512;
#pragma unroll 1
    for (int u = C.bid; u < nu; u += C.G) {
        int bh, qb; if (u < 512) { bh = (u >> 8) * 8 + (u & 7); qb = ((u & 255) >> 3) + 1; } else { bh = u - 512; qb = 0; }
        const int b = bh >> 3, h = bh & 7; const size_t rq = (size_t)b * RPB + (size_t)qb * 256, rk = (size_t)b * RPB; const int seq = qb == 0 ? CTXL : RPB;
        __syncthreads();
        if constexpr (TYPE == 1) {
            att::attn_body88<128>(P + rq * NP + C_AQ + h * 128, NP, C.ws + WS_AK8 + rk * 256 + (h >> 2) * 128, 256, nullptr, 0, C.ws + WS_VT8A + (size_t)(b * 2 + (h >> 2)) * NCH * 8192,
                                  C.ws + WS_OA + rq * 1024 + h * 128, 1024, seq, false, 0, nullptr, (char*)C.lds, C.tid);
        } else {
            const bf16_t* MQ = WSP(bf16_t, WS_MQ);
            att::attn_body88<192>(MQ + rq * 1536 + h * 192, 1536, C.ws + WS_KN8 + rk * 1024 + h * 128, 1024, C.ws + WS_KR8 + rk * 64, 64, C.ws + WS_VT8M + (size_t)(b * 8 + h) * NCH * 8192,
                                  C.ws + WS_OM + rq * 1024 + h * 128, 1024, seq, qb > 0, (qb - 1) * 256, WSP(float, WS_TABM), (char*)C.lds, C.tid);
        }
    }
    __syncthreads();
}

constexpr int LDS_BYTES = 163840, LDS_BAR_OFF = LDS_BYTES - 16;
constexpr int N_PHASES = 26;
template <int K> __device__ __forceinline__ void run_phase(const Ctx& C0, int l) {
    const Ctx C = launder(C0);
    const float* modl = WSP(float, WS_MODV) + (size_t)l * 3 * 12288;
    if constexpr (K == 0) { phase_modv(C); phase_tables(C); __syncthreads(); phase_cvt_mixer_weights(C, 0); }
    if constexpr (K == 1) {
        if (l == 0) phase_norm_mod<true, true>(C, INP(I_N1G), modl, 0, DM);
        else { phase_norm_mod<false, true>(C, INP(I_N1G) + l * DM, modl, 0, DM); __syncthreads(); phase_cvt_mixer_weights(C, l); }
    }
    if constexpr (K == 2) {
        pg8::Gemm g{WSP(bf16_t, WS_HB), WSP(bf16_t, WS_WIN), TT, NP, DM, DM, DM}; pg8::WinOrder S; S.init(C.G, C.bid, l + 1 < DEPTH);
        pg8::EpiStoreBf16S E{WSP(bf16_t, WS_P), NP, WSP(float, WS_WINS)};
        pg8::gemm_phase<pg8::EpiStoreBf16S, pg8::WinOrder, 1>(C.lds, C.tid, g, S, E);
    }
    if constexpr (K == 3) phase_post_p(C, l);
    if constexpr (K == 4) {
        { pg8::Gemm g{WSP(bf16_t, WS_P) + C_MCQ, WSP(bf16_t, WS_WUQ), TT, 1536, 512, NP, 512}; pg8::StaticOrder S; S.init(TT, 1536, C.G, C.bid);
          pg8::EpiStoreBf16 E{WSP(bf16_t, WS_MQ), 1536}; pg8::gemm_phase(C.lds, C.tid, g, S, E); }
        { pg8::Gemm g{WSP(bf16_t, WS_P) + C_MCKV, WSP(bf16_t, WS_WUKV), TT, 2048, 512, NP, 512}; pg8::StaticOrder S; S.init(TT, 2048, C.G, (C.bid + C.G - 140 % C.G) % C.G);
          pg8::EpiStoreMKV E{WSP(bf16_t, WS_MKV), C.ws + WS_KN8}; pg8::gemm_phase(C.lds, C.tid, g, S, E); }
        { const Ctx C2 = launder(C0); phase_gla_local(C2, l, 156); }
#ifdef DBG_DUP_GLALOCAL
        { const Ctx C2 = launder(C0); __syncthreads(); phase_gla_local(C2, l, 156); }
#endif
    }
    if constexpr (K == 5) { phase_gla_scan(C); { const Ctx C2 = launder(C0); phase_vt8(C2); } }
    if constexpr (K == 6) {
#ifdef DBG_ATTVAR
        { const Ctx Cx = launder(C0); attn_units<0, DBG_ATTVAR>(Cx, l + 1 < DEPTH); } { const Ctx Cx = launder(C0); attn_units<1, DBG_ATTVAR>(Cx, l + 1 < DEPTH); } __syncthreads();
#endif
        attn_units<0>(C, l + 1 < DEPTH); { const Ctx C2 = launder(C0); attn_units<1>(C2, l + 1 < DEPTH); } { const Ctx C3 = launder(C0); phase_gla_out(C3, l, 128); }
#ifdef DBG_DUP_GLAOUT
        { const Ctx C3 = launder(C0); __syncthreads(); phase_gla_out(C3, l, 128); }
#endif
    }
    if constexpr (K == 7) {
        const bf16_t* P = WSP(bf16_t, WS_P); bf16_t* Y = WSP(bf16_t, WS_Y);
        const pg8::Gemm ga{WSP(bf16_t, WS_OA), WSP(bf16_t, WS_WBR), TT, DM, 1024, 1024, 1024}, gl{WSP(bf16_t, WS_OL), (const bf16_t*)(C.ws + WS_WBR + (size_t)2048 * 1024), TT, DM, 1024, 1024, 1024},
                        gm{WSP(bf16_t, WS_OM), (const bf16_t*)(C.ws + WS_WBR + (size_t)2 * 2048 * 1024), TT, DM, 1024, 1024, 1024};
        unsigned char* Y8 = C.ws + WS_HB;
        const float* wbs = WSP(float, WS_WBRS);
        const pg8::EpiGate<true> Ea{Y, P + C_GA, nullptr, wbs}; const pg8::EpiGate<false> El{Y, P + C_GL, nullptr, wbs + DM}; const pg8::EpiGate<false, true> Em{Y, P + C_GM, Y8, wbs + 2 * DM};
        pg8::StaticOrder S; S.init(TT, DM, C.G, C.bid, l + 1 >= DEPTH);
        pg8::gemm_phase<pg8::EpiGate<true>, pg8::StaticOrder, 1>(C.lds, C.tid, ga, S, Ea); pg8::gemm_phase<pg8::EpiGate<false>, pg8::StaticOrder, 1>(C.lds, C.tid, gl, S, El);
        pg8::gemm_phase<pg8::EpiGate<false, true>, pg8::StaticOrder, 1>(C.lds, C.tid, gm, S, Em);
        if (l == 0) { const Ctx C2 = launder(C0); phase_cvt_peer_tables(C2, 0, 0, NEXP, S.nwg % C.G); }
    }
    if constexpr (K == 8) {
        pg8::Gemm g{WSP(bf16_t, WS_HB), WSP(bf16_t, WS_WOUT), TT, DM, DM, DM, DM};
        const pg8::EpiResidT<true> E{WSP(float, WS_XS), DM, modl + 2 * DM, WSP(float, WS_WOUTS)};
        pg8::StaticOrder S; S.init(TT, DM, C.G, C.bid, l + 1 >= DEPTH);
        pg8::gemm_phase<pg8::EpiResidT<true>, pg8::StaticOrder, 1>(C.lds, C.tid, g, S, E);
        if (l == 0 && DEPTH > 1) { const Ctx C2 = launder(C0); phase_cvt_peer_tables(C2, 1, 0, NEXP / 2, S.nwg % C.G); }
    }
    if constexpr (K == 9) phase_norm_mod<false>(C, INP(I_N2G) + l * DM, modl, 3 * DM, 4 * DM);
    if constexpr (K == 10) {
        pg8::Gemm g{WSP(bf16_t, WS_HB), WSP(bf16_t, WS_WQ), TT, DM, DM, DM, DM};
        pg8::EpiStoreBf16 E{WSP(bf16_t, WS_PQ), DM};
        pg8::StaticOrder S; S.init(TT, DM, C.G, C.bid, l + 1 >= DEPTH); pg8::gemm_phase(C.lds, C.tid, g, S, E);
        if (l == 0 && DEPTH > 1) { const Ctx C2 = launder(C0); phase_cvt_peer_tables(C2, 1, NEXP / 2, NEXP, S.nwg % C.G); }
    }
    if constexpr (K == 11) phase_peer_select(C, l + 1 >= DEPTH);
    if constexpr (K == 13) phase_final_norm(C);
    if constexpr (K == 12) {
#ifdef DBG_DUP12
        if (l + 1 < DEPTH) phase_peer_gather<false>(C, modl, 0.0f); else phase_peer_gather<true>(C, modl, 0.0f);
        __syncthreads();
#endif
        if (l + 1 < DEPTH) phase_peer_gather<false>(C, modl, DBG_PEER0); else phase_peer_gather<true>(C, modl, DBG_PEER1); }
}
__device__ __forceinline__ Ctx make_ctx(const Args& args, unsigned char* lds_raw) {
    Ctx C0; C0.in = (const __attribute__((address_space(4))) cfp_t*)__builtin_amdgcn_kernarg_segment_ptr(); C0.out = args.out; C0.ws = args.ws; C0.lds = (LAS unsigned char*)lds_raw;
    C0.tid = threadIdx.x; C0.lane = C0.tid & 63; C0.wid = __builtin_amdgcn_readfirstlane(C0.tid >> 6); C0.G = gridDim.x; C0.bid = blockIdx.x;
    return C0;
}
template <int K> __global__ void __launch_bounds__(NTHREADS, 2) k_one(Args args) {
    extern __shared__ __attribute__((aligned(16))) unsigned char lds_raw[];
    const Ctx C0 = make_ctx(args, lds_raw);
    run_phase<K>(C0, args.ph_lo);
}
#if MK_N_LAUNCHES == 1 || defined(DBG_HYB)
__global__ void __launch_bounds__(NTHREADS, 2) mk_fwd(Args args) {
    extern __shared__ __attribute__((aligned(16))) unsigned char lds_raw[];
    const Ctx C0 = make_ctx(args, lds_raw);
    if (C0.tid < 4) ((LAS unsigned*)(C0.lds + LDS_BAR_OFF))[C0.tid] = 0u;
    __syncthreads();
    const int lo = args.ph_lo, hi = args.ph_hi;
    XcdBarrier bar; bar.bar = (unsigned*)(args.ws + WS_CTL); bar.x = 0; bar.st = nullptr;
    if (hi - lo > 1) bar = xcd_barrier_post((unsigned*)(args.ws + WS_CTL), (volatile LAS unsigned*)(C0.lds + LDS_BAR_OFF));
#define IN(k) (lo <= (k) && (k) < hi)
#define SEAM(k) do { if (IN(k) && IN((k) + 1)) xcd_barrier(bar); } while (0)
#ifndef DBG_DUP
#define DBG_DUP -1
#endif
#define PH(K, k) do { if (IN(k)) { run_phase<K>(C0, l); if (K == DBG_DUP) { xcd_barrier(bar); run_phase<K>(C0, l); } } SEAM(k); } while (0)
    { const int l = 0; PH(0, 0); }
#pragma unroll 1
    for (int l = 0; l < DEPTH; ++l) {
        const int pb = 1 + 12 * l;
        PH(1, pb + 0); PH(2, pb + 1); PH(3, pb + 2); PH(4, pb + 3); PH(5, pb + 4); PH(6, pb + 5);
        PH(7, pb + 6); PH(8, pb + 7); PH(9, pb + 8); PH(10, pb + 9); PH(11, pb + 10); PH(12, pb + 11);
    }
    { const int l = DEPTH - 1; PH(13, 1 + 12 * DEPTH); }
#undef PH
#undef IN
#undef SEAM
}
#define MAIN_KERNEL mk_fwd
#else
#define MAIN_KERNEL k_one<6>
#endif


#ifdef DBG_PROBE
typedef int i32x8 __attribute__((ext_vector_type(8)));
__device__ __forceinline__ unsigned char fp8_of_int(int v) {
    const float f = (float)v; return (unsigned char)(__builtin_amdgcn_cvt_pk_fp8_f32(f, 0.f, 0, false) & 0xff); }
__global__ void k_probe_mx(unsigned* slot) {
    const int l = threadIdx.x, r = l & 31, g = l >> 5;
    i32x8 A, B;
    for (int j = 0; j < 8; ++j) { unsigned wa = 0, wb = 0;
        for (int b = 0; b < 4; ++b) { const int k = g * 32 + 4 * j + b;
            wa |= (unsigned)fp8_of_int(((3 * r + k) % 7) - 3) << (8 * b); wb |= (unsigned)fp8_of_int(((5 * k + 2 * r) % 9) - 4) << (8 * b); }
        A[j] = (int)wa; B[j] = (int)wb; }
    f32x16 c = {};
    c = __builtin_amdgcn_mfma_scale_f32_32x32x64_f8f6f4(A, B, c, 0, 0, 0, 0x7f7f7f7f, 0, 0x7f7f7f7f);
    float worst = 0.f;
    for (int i = 0; i < 16; ++i) { const int m = (i & 3) + 8 * (i >> 2) + 4 * g, n = r; float ref = 0.f; for (int k = 0; k < 64; ++k) ref += (float)(((3 * m + k) % 7) - 3) * (float)(((5 * k + 2 * n) % 9) - 4);
        worst = fmaxf(worst, fabsf(c[i] - ref)); }
    for (int o = 32; o >= 1; o >>= 1) worst = fmaxf(worst, __shfl_xor(worst, o));
    if (l == 0) { const float code = worst == 0.f ? 0.4f : 1.2f; *slot = __float_as_uint(powf(10.f, code / 0.25f - 4.f)); }
}
#endif
#ifdef DBG_CHECK
__device__ __forceinline__ void dbg_report(unsigned* slot, float err) { if (!(err <= 3e38f)) err = 1e30f; atomicMax(slot, __float_as_uint(err)); }
__global__ void k_check_gemm(const bf16_t* A, int lda, const float* W, int K, int N, const bf16_t* Cm, int ldc, int M, unsigned* slot) {
    const unsigned id = blockIdx.x * blockDim.x + threadIdx.x; if (id >= 8192) return;
    const unsigned h = id * 2654435761u; const int row = (int)((h >> 8) % (unsigned)M), col = (int)((h * 40503u >> 7) % (unsigned)N);
    float ref = 0.f; for (int k = 0; k < K; ++k) ref += bf2f(A[(size_t)row * lda + k]) * W[(size_t)k * N + col];
    const float got = bf2f(Cm[(size_t)row * ldc + col]);
    dbg_report(slot, fabsf(got - ref) / (fabsf(ref) + 0.1f));
}

__global__ void k_check_attn(const unsigned char* ws, int type, unsigned* slot) {
    __shared__ float sc[RPB]; __shared__ float red[256]; __shared__ float qv[192];
    const int t = threadIdx.x, bh = blockIdx.x & 15, b = bh >> 3, h = bh & 7; const int qpos = (int)(((blockIdx.x >> 4) * 977u + 13u) % SEQ); const size_t rq = (size_t)b * RPB + CTXL + qpos, rk = (size_t)b * RPB;
    const bf16_t* P = (const bf16_t*)(ws + WS_P); const bf16_t* MQ = (const bf16_t*)(ws + WS_MQ); const bf16_t* MKV = (const bf16_t*)(ws + WS_MKV);
    const int dq = type ? 128 : 192;
    if (t < dq) { float v = type ? bf2f(P[rq * NP + C_AQ + h * 128 + t]) : bf2f(MQ[rq * 1536 + h * 192 + t]); qv[t] = v; }
    __syncthreads();
    if (!type && t < 32) {
        const int ri = qpos >> 6, ci = qpos & 63; const int i = t; const float pos = (float)(i < 16 ? ri : ci); const float inv = powf(10000.f, -(float)(i & 15) / 16.f); const float a = pos * inv;
        const float x1 = qv[128 + i], x2 = qv[160 + i]; qv[128 + i] = x1 * cosf(a) - x2 * sinf(a); qv[160 + i] = x2 * cosf(a) + x1 * sinf(a); }
    __syncthreads();
    const float scale = type ? 0.088388347648f : 0.0721687836487f;
    float mx = -1e30f;
    for (int k = t; k < RPB; k += 256) { float s = 0.f;
        if (type) { const bf16_t* kp = P + (rk + k) * NP + C_AK + (h >> 2) * 128; for (int d = 0; d < 128; ++d) s += qv[d] * bf2f(kp[d]); }
        else { const bf16_t* kp = MKV + (rk + k) * 2048 + h * 256; for (int d = 0; d < 128; ++d) s += qv[d] * bf2f(kp[d]); const bf16_t* kr = P + (rk + k) * NP + C_MKR; for (int d = 0; d < 64; ++d) s += qv[128 + d] * bf2f(kr[d]); }
        s *= scale; sc[k] = s; mx = fmaxf(mx, s); }
    red[t] = mx; __syncthreads(); for (int o = 128; o >= 1; o >>= 1) { if (t < o) red[t] = fmaxf(red[t], red[t + o]); __syncthreads(); } mx = red[0]; __syncthreads();
    float sum = 0.f; for (int k = t; k < RPB; k += 256) { const float p = __expf(sc[k] - mx); sc[k] = p; sum += p; }
    red[t] = sum; __syncthreads(); for (int o = 128; o >= 1; o >>= 1) { if (t < o) red[t] += red[t + o]; __syncthreads(); } sum = red[0]; __syncthreads();
    float e = 0.f, mag = 0.f;
    if (t < 128) { float o = 0.f; for (int k = 0; k < RPB; ++k) { const float vv = type ? bf2f(P[(rk + k) * NP + C_AV + (h >> 2) * 128 + t]) : bf2f(MKV[(rk + k) * 2048 + h * 256 + 128 + t]); o += sc[k] * vv; }
        o /= sum; const float got = __builtin_amdgcn_cvt_f32_fp8((int)(ws + (type ? WS_OA : WS_OM))[rq * 1024 + h * 128 + t], 0) * (1.0f / 32.0f); e = fabsf(got - o); mag = fabsf(o); }
    red[t] = e; __syncthreads(); for (int o = 128; o >= 1; o >>= 1) { if (t < o) red[t] = fmaxf(red[t], red[t + o]); __syncthreads(); } e = red[0]; __syncthreads();
    red[t] = mag; __syncthreads(); for (int o = 128; o >= 1; o >>= 1) { if (t < o) red[t] = fmaxf(red[t], red[t + o]); __syncthreads(); } mag = red[0];
    if (t == 0) dbg_report(slot, e / (mag + 1e-4f));
}
__global__ void __launch_bounds__(256) k_check_gla_rec(const unsigned char* ws, const float* wa_f, const float* ba_f, const float* wa_b, const float* ba_b, float* obuf, int b) {
    __shared__ float ad[128], kd[128], qd[128], lrs[16];
    const int e = threadIdx.x, h = blockIdx.x & 3, dir = blockIdx.x >> 2; const bf16_t* P = (const bf16_t*)(ws + WS_P);
    const float* wa = dir ? wa_b : wa_f; const float* ba = dir ? ba_b : ba_f;
    float S[128];
#pragma unroll
    for (int d = 0; d < 128; ++d) S[d] = 0.f;
    float* ob = obuf + ((size_t)(dir * 2 + b) * 4 + h) * RPB * 256;
    for (int st = 0; st < RPB; ++st) {
        int j; if (!dir) j = st; else j = st < CTXL ? CTXL - 1 - st : RPB - 1 - (st - CTXL);
        const size_t r = (size_t)b * RPB + j; const bf16_t* pr = P + r * NP;
        if (e < 16) lrs[e] = bf2f(pr[(dir ? C_LRB : C_LRF) + e]);
        __syncthreads();
        if (e < 128) { float pre = ba[h * 128 + e]; for (int q = 0; q < 16; ++q) pre += lrs[q] * wa[q * 512 + h * 128 + e];
            const float ls = (fminf(pre, 0.f) - log1pf(expf(-fabsf(pre)))) / 16.f; ad[e] = expf(ls); kd[e] = bf2f(pr[C_LK + h * 128 + e]); qd[e] = bf2f(pr[C_LQ + h * 128 + e]) * 0.088388347648f; }
        __syncthreads();
        const float v = bf2f(pr[C_LV + h * 256 + e]); float o = 0.f;
#pragma unroll
        for (int d = 0; d < 128; ++d) { S[d] = ad[d] * S[d] + kd[d] * v; o += qd[d] * S[d]; }
        ob[(size_t)j * 256 + e] = o;
        __syncthreads();
    }
}
__global__ void k_check_gla_cmp(const unsigned char* ws, const float* obuf, const float* gon, int b, unsigned* slot) {
    __shared__ float red[256];
    const int e = threadIdx.x, h = blockIdx.x & 3, j = blockIdx.x >> 2; const size_t r = (size_t)b * RPB + j; const bf16_t* P = (const bf16_t*)(ws + WS_P);
    const float o = obuf[((size_t)(0 * 2 + b) * 4 + h) * RPB * 256 + (size_t)j * 256 + e] + obuf[((size_t)(1 * 2 + b) * 4 + h) * RPB * 256 + (size_t)j * 256 + e];
    red[e] = o * o; __syncthreads(); for (int s_ = 128; s_ >= 1; s_ >>= 1) { if (e < s_) red[e] += red[e + s_]; __syncthreads(); }
    const float rs = rsqrtf(red[0] / 256.f + NORM_EPS); __syncthreads();
    const float gt = bf2f(P[r * NP + C_LG + h * 256 + e]); const float ref = o * rs * gon[e] * (gt / (1.f + expf(-gt)));
    const float got = __builtin_amdgcn_cvt_f32_fp8((int)(ws + WS_OL)[r * 1024 + h * 256 + e], 0);
    red[e] = fabsf(got - ref); __syncthreads(); for (int s_ = 128; s_ >= 1; s_ >>= 1) { if (e < s_) red[e] = fmaxf(red[e], red[e + s_]); __syncthreads(); }
    if (e == 0) dbg_report(slot, red[0] / 1.0f);
}

__global__ void k_check_gemm8(const unsigned char* A8, const float* W, int K, int N, const bf16_t* Cm, int ldc, int M, unsigned* slot) {
    const unsigned id = blockIdx.x * blockDim.x + threadIdx.x; if (id >= 8192) return;
    const unsigned h = id * 2654435761u; const int row = (int)((h >> 8) % (unsigned)M), col = (int)((h * 40503u >> 7) % (unsigned)N);
    float ref = 0.f, mag = 0.f; for (int k = 0; k < K; ++k) { const float a = __builtin_amdgcn_cvt_f32_fp8((int)A8[(size_t)row * K + k], 0), w = W[(size_t)k * N + col]; ref += a * w; mag += a * a * w * w; }
    const float got = bf2f(Cm[(size_t)row * ldc + col]);
    dbg_report(slot, fabsf(got - ref) / (sqrtf(mag) + 1e-3f));
}
__global__ void k_check_select(const bf16_t* PQ, const float* k1, const float* k2, const int* PIDX, const float* PG, unsigned* slot) {
    __shared__ float s1[128], s2[128]; __shared__ int cnt; __shared__ float selv[16];
    const int tok = (blockIdx.x >> 3) * 61 + 5, head = blockIdx.x & 7, t = threadIdx.x;
    if (t == 0) cnt = 0;
    for (int n = t; n < 128; n += 64) { float a = 0.f, b = 0.f; for (int d = 0; d < 128; ++d) { a += bf2f(PQ[(size_t)tok * DM + head * 256 + d]) * k1[((size_t)head * 128 + n) * 128 + d]; b += bf2f(PQ[(size_t)tok * DM + head * 256 + 128 + d]) * k2[((size_t)head * 128 + n) * 128 + d]; } s1[n] = a; s2[n] = b; }
    __syncthreads();
    if (t < 16) { const int id = PIDX[(size_t)tok * 128 + head * 16 + t]; selv[t] = (id >= 0 && id < 16384) ? s1[id >> 7] + s2[id & 127] : -1e30f; }
    __syncthreads();
    float thr = selv[0], mx = selv[0]; for (int k = 1; k < 16; ++k) { thr = fminf(thr, selv[k]); mx = fmaxf(mx, selv[k]); }
    int c = 0; for (int p = t; p < 16384; p += 64) if (s1[p >> 7] + s2[p & 127] > thr + 0.02f) ++c;
    atomicAdd(&cnt, c); __syncthreads();
    if (t == 0) { float den = 0.f; for (int k = 0; k < 16; ++k) den += __expf(selv[k] - mx); float e = fabsf((float)cnt - 15.f) / 15.f > 0.34f ? fabsf((float)cnt - 15.f) / 15.f : 0.f;
        for (int k = 0; k < 16; ++k) e = fmaxf(e, fabsf(PG[(size_t)tok * 128 + head * 16 + k] - __expf(selv[k] - mx) / den) * 4.f);
        for (int k = 0; k < 16; ++k) for (int k2_ = 0; k2_ < k; ++k2_) if (PIDX[(size_t)tok * 128 + head * 16 + k] == PIDX[(size_t)tok * 128 + head * 16 + k2_]) e = fmaxf(e, 10.f);
        dbg_report(slot, e); }
}
__global__ void k_check_gather(const bf16_t* HB, const float* u, const float* v, const int* PIDX, const float* PG, const float* dbgo, unsigned* slot) {
    __shared__ float w[128];
    const int tok = blockIdx.x * 64 + 300, t = threadIdx.x;
    for (int k = t; k < 128; k += 64) { const int id = PIDX[(size_t)tok * 128 + k] & 16383; float a = 0.f; for (int d = 0; d < DM; ++d) a += bf2f(HB[(size_t)tok * DM + d]) * u[(size_t)id * DM + d];
        w[k] = PG[(size_t)tok * 128 + k] * 0.5f * a * (1.0f + erff(a * 0.70710678f)); }
    __syncthreads();
    float e = 0.f, sc = 0.f;
    for (int d = t; d < DM; d += 64) { float o = 0.f; for (int k = 0; k < 128; ++k) o += w[k] * v[(size_t)(PIDX[(size_t)tok * 128 + k] & 16383) * DM + d];
        e = fmaxf(e, fabsf(o - dbgo[(size_t)tok * DM + d])); sc = fmaxf(sc, fabsf(o)); }
    for (int o_ = 32; o_ >= 1; o_ >>= 1) { e = fmaxf(e, __shfl_xor(e, o_)); sc = fmaxf(sc, __shfl_xor(sc, o_)); }
    if (t == 0) dbg_report(slot, e / (sc + 1e-6f));
}
__global__ void k_dbg_out2(const float* x, const float* fg, float* out, const unsigned* slot) {
    const float mx = __uint_as_float(*slot); float v = 0.25f * (log10f(fmaxf(mx, 1e-30f)) + 4.0f); v = fminf(fmaxf(v, 0.f), 9.f);
    const float f = 1.0f + v;
    const int lane = threadIdx.x & 63; const size_t r = (size_t)blockIdx.x * 4 + (threadIdx.x >> 6);
    const float* xr = x + r * DM; float ss = 0.f;
    for (int c = lane; c < DM; c += 64) ss += xr[c] * xr[c];
    ss = wave_sum(ss); const float rs = rsqrtf(ss / DM + NORM_EPS);
    for (int c = lane; c < DM; c += 64) out[r * DM + c] = xr[c] * rs * fg[c] * f;
}
#endif
#ifdef DBG_SCAN
__global__ void k_scan16(const bf16_t* p, size_t n, unsigned* flags, int stage) {
    unsigned bad = 0; for (size_t i = (size_t)blockIdx.x * blockDim.x + threadIdx.x; i < n; i += (size_t)gridDim.x * blockDim.x) bad |= ((p[i] & 0x7f80u) == 0x7f80u);
    if (bad) atomicOr(&flags[stage], 1u);
}
__global__ void k_scan32(const float* p, size_t n, unsigned* flags, int stage) {
    unsigned bad = 0; for (size_t i = (size_t)blockIdx.x * blockDim.x + threadIdx.x; i < n; i += (size_t)gridDim.x * blockDim.x) bad |= ((__float_as_uint(p[i]) & 0x7f800000u) == 0x7f800000u);
    if (bad) atomicOr(&flags[stage], 1u);
}
__global__ void k_dbg_out(const float* x, const float* fg, float* out, const unsigned* flags, int nstage) {
    int code = 0; for (int s = nstage; s >= 1; --s) if (flags[s]) code = s;
    const float f = 1.0f + 0.25f * (float)code;
    const int lane = threadIdx.x & 63; const size_t r = (size_t)blockIdx.x * 4 + (threadIdx.x >> 6);
    const float* xr = x + r * DM; float ss = 0.f;
    for (int c = lane; c < DM; c += 64) ss += xr[c] * xr[c];
    ss = wave_sum(ss); const float rs = rsqrtf(ss / DM + NORM_EPS);
    for (int c = lane; c < DM; c += 64) out[r * DM + c] = xr[c] * rs * fg[c] * f;
}
#endif
extern "C" void kernel_launch(void* const* d_in, const int* in_sizes, int n_in, void* d_out, int out_size, void* d_ws, size_t ws_size, hipStream_t stream) {
    static int grid = 0;
    if (grid == 0) {
        if (n_in != 30 || out_size != NBATCH * SEQ * DM || ws_size < WS_END) { fprintf(stderr, "kernel_launch: shape/workspace mismatch: n_in %d out %d ws %zu (need %zu)\n", n_in, out_size, ws_size, (size_t)WS_END); grid = -1; return; }
        int dev = 0, cus = 0, per_cu = 0;
        if (hipGetDevice(&dev) != hipSuccess || hipDeviceGetAttribute(&cus, hipDeviceAttributeMultiprocessorCount, dev) != hipSuccess) { grid = -1; return; }
        bool okattr = hipFuncSetAttribute((const void*)MAIN_KERNEL, hipFuncAttributeMaxDynamicSharedMemorySize, LDS_BYTES) == hipSuccess;
#if MK_N_LAUNCHES != 1
#ifdef DBG_HYB
        okattr = okattr && hipFuncSetAttribute((const void*)mk_fwd, hipFuncAttributeMaxDynamicSharedMemorySize, LDS_BYTES) == hipSuccess;
#endif
#define SETA(K) okattr = okattr && hipFuncSetAttribute((const void*)k_one<K>, hipFuncAttributeMaxDynamicSharedMemorySize, LDS_BYTES) == hipSuccess
        SETA(0); SETA(1); SETA(2); SETA(3); SETA(4); SETA(5); SETA(6); SETA(7); SETA(8); SETA(9); SETA(10); SETA(11); SETA(12); SETA(13);
#undef SETA
#endif
        if (!okattr) { fprintf(stderr, "kernel_launch: hipFuncSetAttribute failed\n"); grid = -1; return; }
        if (hipOccupancyMaxActiveBlocksPerMultiprocessor(&per_cu, (const void*)MAIN_KERNEL, NTHREADS, LDS_BYTES) != hipSuccess || per_cu < 1) { fprintf(stderr, "kernel_launch: occupancy query says %d blocks per CU\n", per_cu); grid = -1; (void)hipGetLastError(); return; }
        grid = cus;
    }
    if (grid < 0) return;
    if (hipMemsetAsync((char*)d_ws + WS_CTL, 0, CTL_BYTES, stream) != hipSuccess) return;
    Args a{};
    for (int i = 0; i < 30; ++i) a.in[i] = (const float*)d_in[i];
    a.out = (float*)d_out; a.ws = (unsigned char*)d_ws;
#if defined(DBG_PROBE)
    { unsigned* flags = (unsigned*)((char*)d_ws + WS_CTL + 32768);
      hipLaunchKernelGGL(k_probe_mx, dim3(1), dim3(64), 0, stream, flags + 100);
      hipLaunchKernelGGL(k_dbg_out2, dim3(NBATCH * SEQ / 4), dim3(256), 0, stream, (const float*)d_in[0], (const float*)d_in[29], (float*)d_out, flags + 100); }
#elif MK_N_LAUNCHES == 1 && defined(DBG_CHECK)
    {
        unsigned* flags = (unsigned*)((char*)d_ws + WS_CTL + 32768); char* W = (char*)d_ws;
        a.ph_lo = 0; a.ph_hi = (DBG_CHECK == 8) ? 3 : (DBG_CHECK >= 5) ? 7 : (DBG_CHECK == 1 ? 11 : (DBG_CHECK == 2 ? 12 : 13));
        hipLaunchKernelGGL(mk_fwd, dim3(grid), dim3(NTHREADS), LDS_BYTES, stream, a);
#if DBG_CHECK == 8
        hipLaunchKernelGGL(k_check_gemm8, dim3(32), dim3(256), 0, stream, (const unsigned char*)(W + WS_HB), (const float*)d_in[I_WIN], DM, IN_COLS, (const bf16_t*)(W + WS_P), NP, TT, flags + 100);
#elif DBG_CHECK == 5 || DBG_CHECK == 6
        hipLaunchKernelGGL(k_check_attn, dim3(16 * 24), dim3(256), 0, stream, (const unsigned char*)d_ws, DBG_CHECK == 5 ? 1 : 0, flags + 100);
#elif DBG_CHECK == 7
        { float* obuf = (float*)(W + WS_MQ);
          hipLaunchKernelGGL(k_check_gla_rec, dim3(8), dim3(256), 0, stream, (const unsigned char*)d_ws, (const float*)d_in[I_WA2F], (const float*)d_in[I_BAF], (const float*)d_in[I_WA2B], (const float*)d_in[I_BAB], obuf, 0);
          hipLaunchKernelGGL(k_check_gla_cmp, dim3(RPB * 4), dim3(256), 0, stream, (const unsigned char*)d_ws, (const float*)obuf, (const float*)d_in[I_ONG], 0, flags + 100); }
#elif DBG_CHECK == 1
        hipLaunchKernelGGL(k_check_gemm, dim3(32), dim3(256), 0, stream, (const bf16_t*)(W + WS_HB), DM, (const float*)d_in[I_PWQ], DM, DM, (const bf16_t*)(W + WS_PQ), DM, TT, flags + 100);
#elif DBG_CHECK == 2
        hipLaunchKernelGGL(k_check_select, dim3(256 * 8), dim3(64), 0, stream, (const bf16_t*)(W + WS_PQ), (const float*)d_in[I_PK1], (const float*)d_in[I_PK2], (const int*)(W + WS_PIDX), (const float*)(W + WS_PG), flags + 100);
#else
        hipLaunchKernelGGL(k_check_gather, dim3(128), dim3(64), 0, stream, (const bf16_t*)(W + WS_HB), (const float*)d_in[I_PU], (const float*)d_in[I_PV], (const int*)(W + WS_PIDX), (const float*)(W + WS_PG), (const float*)(W + WS_MQ), flags + 100);
#endif
        hipLaunchKernelGGL(k_dbg_out2, dim3(NBATCH * SEQ / 4), dim3(256), 0, stream, (const float*)d_in[0], (const float*)d_in[29], (float*)d_out, flags + 100);
    }
#elif MK_N_LAUNCHES == 1
#ifdef DBG_SPLIT
    for (int p = 0; p < N_PHASES; p += DBG_SPLIT) { a.ph_lo = p; a.ph_hi = p + DBG_SPLIT < N_PHASES ? p + DBG_SPLIT : N_PHASES; hipLaunchKernelGGL(mk_fwd, dim3(grid), dim3(NTHREADS), LDS_BYTES, stream, a); }
#else
    a.ph_lo = 0; a.ph_hi = N_PHASES;
    hipLaunchKernelGGL(mk_fwd, dim3(grid), dim3(NTHREADS), LDS_BYTES, stream, a);
#endif
#else
    a.ph_hi = 0;
#ifndef DBG_NLAUNCH
#define DBG_NLAUNCH 100
#endif
    int nl_ = 0;
#ifdef DBG_HYB
#define LAUNCH1(K, L) do { if (K == DBG_HYB) { a.ph_lo = 12 * (L) + (K); a.ph_hi = a.ph_lo + 1; hipLaunchKernelGGL(mk_fwd, dim3(grid), dim3(NTHREADS), LDS_BYTES, stream, a); a.ph_hi = 0; } else { a.ph_lo = (L); hipLaunchKernelGGL(k_one<K>, dim3(grid), dim3(NTHREADS), LDS_BYTES, stream, a); } } while (0)
#else
#define LAUNCH1(K, L) do { a.ph_lo = (L); if (nl_++ < DBG_NLAUNCH) { hipLaunchKernelGGL(k_one<K>, dim3(grid), dim3(NTHREADS), LDS_BYTES, stream, a); if (K == DBG_DUP) hipLaunchKernelGGL(k_one<K>, dim3(grid), dim3(NTHREADS), LDS_BYTES, stream, a); } } while (0)
#endif
#ifdef DBG_SCAN
    unsigned* flags = (unsigned*)((char*)d_ws + WS_CTL + 32768);
    char* W = (char*)d_ws;
#define S16(off, n, st) hipLaunchKernelGGL(k_scan16, dim3(1024), dim3(256), 0, stream, (const bf16_t*)(W + (off)), (size_t)(n), flags, st)
#define S32(off, n, st) hipLaunchKernelGGL(k_scan32, dim3(1024), dim3(256), 0, stream, (const float*)(W + (off)), (size_t)(n), flags, st)
    LAUNCH1(0, 0); S32(WS_MODV, 2 * 3 * 12288, 1);
    { const int l = 0;
      LAUNCH1(1, l); S16(WS_HB, (size_t)TT * DM, 2);
      LAUNCH1(2, l); S16(WS_P, (size_t)TT * NP, 3);
      LAUNCH1(3, l); S16(WS_P, (size_t)TT * NP, 4);
      LAUNCH1(4, l); S16(WS_MQ, (size_t)TT * 1536, 5); S16(WS_MKV, (size_t)TT * 2048, 5); S16(WS_GST, (size_t)2112 * 32768, 6); S32(WS_GDEC, (size_t)2112 * 128, 6);
      LAUNCH1(5, l); S16(WS_GST, (size_t)2112 * 32768, 7);
      LAUNCH1(6, l); S16(WS_OA, (size_t)TT * 1024, 8); S16(WS_OM, (size_t)TT * 1024, 9); S16(WS_OL, (size_t)TT * 1024, 10);
      LAUNCH1(7, l); S16(WS_Y, (size_t)TT * DM, 11);
      LAUNCH1(8, l); S32(WS_XS, (size_t)TT * DM, 12);
      LAUNCH1(9, l); S16(WS_HB, (size_t)TT * DM, 13);
      LAUNCH1(10, l); S16(WS_PQ, (size_t)TT * DM, 14);
      LAUNCH1(11, l); S32(WS_PG, (size_t)TT * 128, 15);
      LAUNCH1(12, l); S32(WS_XS, (size_t)TT * DM, 16);
    }
    hipLaunchKernelGGL(k_dbg_out, dim3(NBATCH * SEQ / 4), dim3(256), 0, stream, (const float*)d_in[0], (const float*)d_in[29], (float*)d_out, flags, 16);
#elif defined(DBG_CHECK)
    unsigned* flags = (unsigned*)((char*)d_ws + WS_CTL + 32768);
    char* W = (char*)d_ws;
    LAUNCH1(0, 0);
    { const int l = 0; LAUNCH1(1, l); LAUNCH1(2, l); LAUNCH1(3, l); LAUNCH1(4, l); LAUNCH1(5, l); LAUNCH1(6, l);
#if DBG_CHECK == 5 || DBG_CHECK == 6
      hipLaunchKernelGGL(k_check_attn, dim3(16 * 24), dim3(256), 0, stream, (const unsigned char*)d_ws, DBG_CHECK == 5 ? 1 : 0, flags + 100);
#endif
#if DBG_CHECK == 7
      { float* obuf = (float*)(W + WS_MQ);
        hipLaunchKernelGGL(k_check_gla_rec, dim3(8), dim3(256), 0, stream, (const unsigned char*)d_ws, (const float*)d_in[I_WA2F], (const float*)d_in[I_BAF], (const float*)d_in[I_WA2B], (const float*)d_in[I_BAB], obuf, 0);
        hipLaunchKernelGGL(k_check_gla_cmp, dim3(RPB * 4), dim3(256), 0, stream, (const unsigned char*)d_ws, (const float*)obuf, (const float*)d_in[I_ONG], 0, flags + 100); }
#endif
      LAUNCH1(7, l); LAUNCH1(8, l); LAUNCH1(9, l); LAUNCH1(10, l);
#if DBG_CHECK == 1
      hipLaunchKernelGGL(k_check_gemm, dim3(32), dim3(256), 0, stream, (const bf16_t*)(W + WS_HB), DM, (const float*)d_in[I_PWQ], DM, DM, (const bf16_t*)(W + WS_PQ), DM, TT, flags + 100);
#endif
      LAUNCH1(11, l);
#if DBG_CHECK == 2
      hipLaunchKernelGGL(k_check_select, dim3(256 * 8), dim3(64), 0, stream, (const bf16_t*)(W + WS_PQ), (const float*)d_in[I_PK1], (const float*)d_in[I_PK2], (const int*)(W + WS_PIDX), (const float*)(W + WS_PG), flags + 100);
#endif
      LAUNCH1(12, l);
#if DBG_CHECK == 3
      hipLaunchKernelGGL(k_check_gather, dim3(128), dim3(64), 0, stream, (const bf16_t*)(W + WS_HB), (const float*)d_in[I_PU], (const float*)d_in[I_PV], (const int*)(W + WS_PIDX), (const float*)(W + WS_PG), (const float*)(W + WS_MQ), flags + 100);
#endif
    }
    hipLaunchKernelGGL(k_dbg_out2, dim3(NBATCH * SEQ / 4), dim3(256), 0, stream, (const float*)d_in[0], (const float*)d_in[29], (float*)d_out, flags + 100);
#else
    LAUNCH1(0, 0);
    for (int l = 0; l < DEPTH; ++l) { LAUNCH1(1, l); LAUNCH1(2, l); LAUNCH1(3, l);
#ifdef DBG_DUP23
        LAUNCH1(2, l); LAUNCH1(3, l);
#endif
        LAUNCH1(4, l); LAUNCH1(5, l);
#ifdef DBG_DUP45
        LAUNCH1(4, l); LAUNCH1(5, l);
#endif
        LAUNCH1(6, l); LAUNCH1(7, l); LAUNCH1(8, l); LAUNCH1(9, l); LAUNCH1(10, l); LAUNCH1(11, l); LAUNCH1(12, l); }
    LAUNCH1(13, DEPTH - 1);
#endif
#undef LAUNCH1
#endif
    const hipError_t le = hipPeekAtLastError();
    if (le != hipSuccess) fprintf(stderr, "kernel_launch: launch failed: %s\n", hipGetErrorName(le));
}
```

```cpp
#include <hip/hip_runtime.h>
#include <cstdio>
#include <cstdint>

#ifndef MK_N_LAUNCHES
#ifndef DBG_DUP
#define DBG_DUP -1
#endif
#define MK_N_LAUNCHES 1
#endif

#ifndef DBG_MIX0
#define DBG_MIX0 1.0f
#define DBG_MIX1 1.0f
#define DBG_PEER0 1.0f
#define DBG_PEER1 1.0f
#endif
#ifndef MLA_NQR
#define MLA_NQR 4
#endif
#define LAS __attribute__((address_space(3)))
#define GLB __attribute__((address_space(1)))
typedef unsigned short bf16_t;
typedef short bf16x8 __attribute__((ext_vector_type(8)));
typedef short s16x4 __attribute__((ext_vector_type(4)));
typedef float f32x4 __attribute__((ext_vector_type(4)));
typedef float f32x2 __attribute__((ext_vector_type(2)));
typedef float f32x16 __attribute__((ext_vector_type(16)));
typedef unsigned u32x4 __attribute__((ext_vector_type(4)));
typedef unsigned u32x2 __attribute__((ext_vector_type(2)));
typedef __bf16 bf2_t __attribute__((ext_vector_type(2)));

constexpr int DM = 2048, NBATCH = 2, SEQ = 8192, CTXL = 256, DEPTH = 2;
constexpr int RPB = SEQ + CTXL;
constexpr int TT = NBATCH * RPB;
constexpr int IN_COLS = 11872, NP = 12032;
constexpr int C_AQ = 0, C_AK = 1024, C_AV = 1280, C_LQ = 1536, C_LK = 2048, C_LV = 2560, C_LG = 3584, C_LRF = 4608, C_LRB = 4624,
              C_MCQ = 4640, C_MCKV = 5152, C_MKR = 5664, C_GA = 5728, C_GL = 7776, C_GM = 9824;
constexpr int NCH = RPB / 64;
constexpr int NEXP = 16384;
constexpr float NORM_EPS = 1e-6f;
constexpr int NTHREADS = 512;

constexpr size_t al256(size_t x) { return (x + 255) / 256 * 256; }
constexpr size_t WS_CTL   = 0;
constexpr size_t CTL_BYTES = 65536;
constexpr size_t WS_MODV  = WS_CTL + CTL_BYTES;
constexpr size_t WS_TABA  = al256(WS_MODV + (size_t)2 * 3 * 12288 * 4);
constexpr size_t WS_TABM  = WS_TABA + 2 * 128 * 32 * 4;
constexpr size_t WS_XS    = al256(WS_TABM + 2 * 128 * 16 * 4);
constexpr size_t WS_HB    = WS_XS + (size_t)TT * DM * 4;
constexpr size_t WS_P     = WS_HB + (size_t)TT * DM * 2;
constexpr size_t WS_MQ    = WS_P + (size_t)TT * NP * 2;
constexpr size_t WS_MKV   = WS_MQ + (size_t)TT * 1536 * 2;
constexpr size_t WS_OA    = WS_MKV + (size_t)TT * 2048 * 2;
constexpr size_t WS_OL    = WS_OA + (size_t)TT * 1024 * 2;
constexpr size_t WS_OM    = WS_OL + (size_t)TT * 1024 * 2;
constexpr size_t WS_WIN   = WS_OM + (size_t)TT * 1024 * 2;
constexpr size_t WS_WUQ   = WS_WIN + (size_t)NP * 2048 * 2;
constexpr size_t WS_WUKV  = WS_WUQ + (size_t)1536 * 512 * 2;
constexpr size_t WS_WBR   = WS_WUKV + (size_t)2048 * 512 * 2;
constexpr size_t WS_WOUT  = WS_WBR + (size_t)3 * 2048 * 1024 * 2;
constexpr size_t WS_WQ    = WS_WOUT + (size_t)2048 * 2048 * 2;
constexpr size_t WS_K1    = WS_WQ + (size_t)2048 * 2048 * 2;
constexpr size_t WS_K2    = WS_K1 + (size_t)8 * 128 * 128 * 2;
constexpr size_t WS_GST   = WS_K2 + (size_t)8 * 128 * 128 * 2;
constexpr size_t WS_GDEC  = WS_GST + (size_t)NBATCH * 2 * 4 * NCH * 32768 * 2;
constexpr size_t WS_END0  = WS_GDEC + (size_t)NBATCH * 2 * 4 * NCH * 128 * 4;
constexpr size_t WS_KN8   = WS_OA + (size_t)TT * 1024;
constexpr size_t WS_AK8   = WS_OL + (size_t)TT * 1024;
constexpr size_t WS_KR8   = WS_AK8 + (size_t)TT * 256;
constexpr size_t WS_VT8A  = WS_KR8 + (size_t)TT * 64;
constexpr size_t WS_VT8M  = WS_OM + (size_t)TT * 1024;
constexpr size_t WS_Y     = WS_MKV;
constexpr size_t WS_PQ    = WS_OA;
constexpr size_t WS_PIDX  = WS_P;
constexpr size_t WS_PG    = WS_PIDX + (size_t)TT * 128 * 4;
constexpr size_t PT_BYTES = 2 * (size_t)NEXP * DM + 2 * (size_t)NEXP * 4;
constexpr size_t WS_WINS  = WS_END0;
constexpr size_t WS_WOUTS = al256(WS_WINS + (size_t)NP * 4);
constexpr size_t WS_WBRS  = al256(WS_WOUTS + (size_t)DM * 4);
constexpr size_t WS_PT    = al256(WS_WBRS + (size_t)3 * DM * 4);
constexpr size_t WS_END   = WS_PT + DEPTH * PT_BYTES;
constexpr size_t PT_U8 = 0, PT_V8 = (size_t)NEXP * DM, PT_SCU = 2 * (size_t)NEXP * DM, PT_SCV = PT_SCU + (size_t)NEXP * 4;
static_assert(WS_PG + (size_t)TT * 128 * 4 <= WS_MQ, "PEER alias region overflows P");

__device__ __forceinline__ unsigned cvt_pk_bf16(float lo, float hi) { bf2_t v; v.x = (__bf16)lo; v.y = (__bf16)hi; return __builtin_bit_cast(unsigned, v); }
__device__ __forceinline__ bf16_t f2bf(float f) { return (bf16_t)(cvt_pk_bf16(f, 0.f) & 0xffffu); }
__device__ __forceinline__ float bf2f(bf16_t b) { return __uint_as_float(((unsigned)b) << 16); }
__device__ __forceinline__ float bflo(unsigned w) { return __uint_as_float(w << 16); }
__device__ __forceinline__ float bfhi(unsigned w) { return __uint_as_float(w & 0xffff0000u); }
__device__ __forceinline__ float xchg32(float x, int lane) { auto r = __builtin_amdgcn_permlane32_swap(__float_as_uint(x), __float_as_uint(x), false, false); return __uint_as_float(lane < 32 ? r[1] : r[0]); }
__device__ __forceinline__ float xchg16(float x, int lane) { auto r = __builtin_amdgcn_permlane16_swap(__float_as_uint(x), __float_as_uint(x), false, false); return __uint_as_float((lane & 16) ? r[0] : r[1]); }
template <int CTRL> __device__ __forceinline__ float dppmov(float x) { return __uint_as_float(__builtin_amdgcn_update_dpp(0u, __float_as_uint(x), CTRL, 0xF, 0xF, false)); }
constexpr int DPP_ROR8 = 0x128, DPP_HMIRROR = 0x141, DPP_Q3210 = 0x1B, DPP_Q1032 = 0xB1;
__device__ __forceinline__ float wave_sum(float v) {
    const int lane = threadIdx.x & 63;
    v += xchg32(v, lane); v += xchg16(v, lane); v += dppmov<DPP_ROR8>(v); v += dppmov<DPP_HMIRROR>(v); v += dppmov<DPP_Q3210>(v); v += dppmov<DPP_Q1032>(v);
    return v;
}
__device__ __forceinline__ float sigmoidf_(float x) { return __builtin_amdgcn_rcpf(1.0f + __expf(-x)); }
__device__ __forceinline__ float siluf_(float x) { return x * __builtin_amdgcn_rcpf(1.0f + __expf(-x)); }

#define XB_TMO      128
#define XB_XCNT(j)  (256  + 64 * (j))
#define XB_XSUB(j)  (1280 + 64 * (j))
#define XB_XGEN(j)  (2304 + 64 * (j))
#define XB_TOP      3328
#define XB_TOPGEN   3392
#define XCD_BAR_WORDS 3456
#define XB_SPIN_CAP (1u << 20)
__device__ __forceinline__ unsigned xb_ld(unsigned* p)              { return __hip_atomic_load(p, __ATOMIC_RELAXED, __HIP_MEMORY_SCOPE_AGENT); }
__device__ __forceinline__ unsigned xb_add(unsigned* p, unsigned v) { return __hip_atomic_fetch_add(p, v, __ATOMIC_RELAXED, __HIP_MEMORY_SCOPE_AGENT); }
__device__ __forceinline__ unsigned xb_xcc_id() { return (unsigned)__builtin_amdgcn_s_getreg((3 << 11) | 20) & 0xFu; }
#define XB_SPIN(cond, bar) do { unsigned _sp = 0; while (cond) { __builtin_amdgcn_s_sleep(1); \
    if ((++_sp & 255u) == 0u) { if (xb_ld(&(bar)[XB_TMO])) break; if (_sp > XB_SPIN_CAP) { atomicAdd(&(bar)[XB_TMO], 1u); break; } } } } while (0)
struct XcdBarrier { unsigned* bar; unsigned x; volatile LAS unsigned* st; };
__device__ __forceinline__ XcdBarrier xcd_barrier_post(unsigned* bar, volatile LAS unsigned* st) {
    XcdBarrier b; b.bar = bar; b.x = xb_xcc_id(); b.st = st;
    if (threadIdx.x == 0) (void)xb_add(&bar[XB_XCNT(b.x)], 1u);
    return b;
}
__device__ __forceinline__ void xcd_barrier_complete(unsigned* bar, unsigned x, unsigned& nloc, unsigned& nx) {
    const unsigned G = gridDim.x * gridDim.y * gridDim.z;
    unsigned sum, cnt, mine, sp = 0u;
    for (;;) {
        sum = 0u; cnt = 0u; mine = 0u;
#pragma unroll
        for (unsigned j = 0; j < 16; ++j) { const unsigned c = xb_ld(&bar[XB_XCNT(j)]); sum += c; cnt += (c > 0u) ? 1u : 0u; mine = (j == x) ? c : mine; }
        if (sum == G) break;
        __builtin_amdgcn_s_sleep(1);
        if ((++sp & 255u) == 0u) { if (xb_ld(&bar[XB_TMO])) break; if (sp > XB_SPIN_CAP) { atomicAdd(&bar[XB_TMO], 1u); break; } }
    }
    nloc = mine > 0u ? mine : 1u; nx = cnt > 0u ? cnt : 1u;
}
__device__ __forceinline__ void xcd_barrier(const XcdBarrier& b) {
    asm volatile("s_waitcnt vmcnt(0)" ::: "memory");
    __syncthreads();
    if (threadIdx.x == 0) {
        unsigned* bar = b.bar;
        __builtin_amdgcn_s_waitcnt(0);
        unsigned nloc = b.st[0], nx = b.st[1];
        if (nloc == 0u) { xcd_barrier_complete(bar, b.x, nloc, nx); b.st[0] = nloc; b.st[1] = nx; }
        const unsigned old = xb_add(&bar[XB_XSUB(b.x)], 1u);
        const unsigned gen = old / nloc;
        if (old + 1u == (gen + 1u) * nloc) {
            __builtin_amdgcn_fence(__ATOMIC_RELEASE, "agent");
            asm volatile("s_waitcnt vmcnt(0)" ::: "memory");
            const unsigned og = xb_add(&bar[XB_TOP], 1u);
            const unsigned tg = og / nx;
            if (og + 1u == (tg + 1u) * nx) xb_add(&bar[XB_TOPGEN], 1u);
            else XB_SPIN(xb_ld(&bar[XB_TOPGEN]) == tg, bar);
            __builtin_amdgcn_fence(__ATOMIC_ACQUIRE, "agent");
            xb_add(&bar[XB_XGEN(b.x)], 1u);
            asm volatile("s_waitcnt vmcnt(0)" ::: "memory");
        } else {
            XB_SPIN(xb_ld(&bar[XB_XGEN(b.x)]) == gen, bar);
            __builtin_amdgcn_fence(__ATOMIC_ACQUIRE, "agent");
            asm volatile("s_waitcnt vmcnt(0)" ::: "memory");
        }
    }
    __syncthreads();
}

namespace pg8 {
constexpr int BM = 256, BK = 64, HALF = 128, HTB = HALF * BK * 2, STAGE_BYTES = 8 * HTB, NXCD = 8, WGM = 8;
__host__ __device__ __forceinline__ int lds_byte(int r, int c) { const int st = (r >> 4) * 2 + (c >> 5), rr = r & 15, cc = c & 31, ob = rr * 64 + cc * 2; return st * 1024 + (ob ^ (((ob >> 9) & 1) << 5)); }
__host__ __device__ __forceinline__ void stage_rc(int b, int& R, int& C) { const int st = b / 1024, sb = b % 1024, swz = sb ^ (((sb >> 9) & 1) << 5); R = (st >> 1) * 16 + swz / 64; C = (st & 1) * 32 + (swz % 64) / 2; }
__host__ __device__ __forceinline__ int perm32(int rho) { const int n = rho >> 4, i = rho & 15; return 8 * (i >> 2) + 4 * n + (i & 3); }
struct Unit { int pm, pn; };
struct Gemm { const bf16_t* A; const bf16_t* Bt; int M, N, K, lda, ldb; };
struct StaticOrder {
    int nM, nN, nwg, G, c, latent;
    __host__ __device__ void init(int M, int N, int G_, int c_, int latent_ = 0) { latent = latent_; nM = latent_ ? 64 : M / BM; nN = N / BM; nwg = nM * nN; G = G_; c = c_; }
    __host__ __device__ bool next(int i, Unit& u) const {
        const long L = (long)i * G + c; if (L >= nwg) return false;
        int wgid = (int)L; { const int q = nwg / NXCD, r = nwg % NXCD, xcd = wgid % NXCD, off = wgid / NXCD; wgid = (xcd < r ? xcd * (q + 1) : r * (q + 1) + (xcd - r) * q) + off; }
        const int nig = WGM * nN, gid = wgid / nig, fm = gid * WGM, gsz = (nM - fm) < WGM ? (nM - fm) : WGM;
        u.pm = fm + ((wgid % nig) % gsz); u.pn = (wgid % nig) / gsz; if (latent) u.pm += 1 + (u.pm >= 32 ? 1 : 0); return true;
    }
};
struct WinOrder {
    StaticOrder S; int full, nlat, G, c;
    __host__ __device__ void init(int G_, int c_, int full_) { full = full_; G = G_; c = c_; S.init(TT, NP, G_, c_, full_ ? 0 : 1); nlat = S.nwg; }
    __host__ __device__ bool next(int i, Unit& u) const {
        if (full) return S.next(i, u);
        const long L = (long)i * G + c;
        if (L < nlat) return S.next(i, u);
        const int q = (int)(L - nlat); if (q >= 24) return false;
        const int t = q % 12; u.pm = q < 12 ? 0 : 33;
        u.pn = t < 2 ? 4 + t : (t < 8 ? 8 + (t - 2) : (t == 8 ? 18 : 20 + (t - 9)));
        return true;
    }
};
struct EpiStoreBf16 {
    static constexpr bool PERM = true;
    bf16_t* O; int ldc;
    __device__ __forceinline__ void operator()(const f32x4 (&acc)[2][2][4][2], const Unit& u, int wr, int wc, int fr, int fq) const {
        const int row0 = u.pm * BM + wr * 64 + fr, col0 = u.pn * BM + wc * 32 + 8 * fq;
#pragma unroll
        for (int ai = 0; ai < 2; ++ai)
#pragma unroll
            for (int m = 0; m < 4; ++m) { bf16_t* rowp = O + (size_t)(row0 + ai * HALF + m * 16) * ldc + col0;
#pragma unroll
                for (int bj = 0; bj < 2; ++bj) { const f32x4 v0 = acc[ai][bj][m][0], v1 = acc[ai][bj][m][1];
                    u32x4 w; w.x = cvt_pk_bf16(v0[0], v0[1]); w.y = cvt_pk_bf16(v0[2], v0[3]); w.z = cvt_pk_bf16(v1[0], v1[1]); w.w = cvt_pk_bf16(v1[2], v1[3]);
                    *(u32x4*)(rowp + bj * HALF) = w; } }
    }
};
struct EpiNull {
    static constexpr bool PERM = true;
    __device__ __forceinline__ void operator()(const f32x4 (&acc)[2][2][4][2], const Unit&, int, int, int, int) const {
#pragma unroll
        for (int a = 0; a < 2; ++a)
#pragma unroll
            for (int b = 0; b < 2; ++b)
#pragma unroll
                for (int m = 0; m < 4; ++m)
#pragma unroll
                    for (int n = 0; n < 2; ++n) asm volatile("" :: "v"(acc[a][b][m][n]));
    }
};
struct EpiStoreMKV {
    static constexpr bool PERM = true;
    bf16_t* O; unsigned char* K8;
    __device__ __forceinline__ void operator()(const f32x4 (&acc)[2][2][4][2], const Unit& u, int wr, int wc, int fr, int fq) const {
        const int row0 = u.pm * BM + wr * 64 + fr, col0 = u.pn * BM + wc * 32 + 8 * fq;
#pragma unroll
        for (int ai = 0; ai < 2; ++ai)
#pragma unroll
            for (int m = 0; m < 4; ++m) { const size_t r = (size_t)(row0 + ai * HALF + m * 16); bf16_t* rowp = O + r * 2048 + col0;
#pragma unroll
                for (int bj = 0; bj < 2; ++bj) { const f32x4 v0 = acc[ai][bj][m][0], v1 = acc[ai][bj][m][1];
                    u32x4 w; w.x = cvt_pk_bf16(v0[0], v0[1]); w.y = cvt_pk_bf16(v0[2], v0[3]); w.z = cvt_pk_bf16(v1[0], v1[1]); w.w = cvt_pk_bf16(v1[2], v1[3]);
                    *(u32x4*)(rowp + bj * HALF) = w;
                    if (bj == 0) { int p0 = __builtin_amdgcn_cvt_pk_fp8_f32(v0[0], v0[1], 0, false); p0 = __builtin_amdgcn_cvt_pk_fp8_f32(v0[2], v0[3], p0, true);
                        int p1 = __builtin_amdgcn_cvt_pk_fp8_f32(v1[0], v1[1], 0, false); p1 = __builtin_amdgcn_cvt_pk_fp8_f32(v1[2], v1[3], p1, true);
                        u32x2 w8; w8.x = (unsigned)p0; w8.y = (unsigned)p1; *(u32x2*)(K8 + r * 1024 + u.pn * 128 + wc * 32 + 8 * fq) = w8; } } }
    }
};
struct EpiStoreBf16S {
    static constexpr bool PERM = true;
    bf16_t* O; int ldc; const float* cs;
    __device__ __forceinline__ void operator()(const f32x4 (&acc)[2][2][4][2], const Unit& u, int wr, int wc, int fr, int fq) const {
        const int row0 = u.pm * BM + wr * 64 + fr, col0 = u.pn * BM + wc * 32 + 8 * fq;
        f32x4 sv[2][2];
#pragma unroll
        for (int bj = 0; bj < 2; ++bj)
#pragma unroll
            for (int n = 0; n < 2; ++n) sv[bj][n] = *(const f32x4*)(cs + col0 + bj * HALF + 4 * n);
#pragma unroll
        for (int ai = 0; ai < 2; ++ai)
#pragma unroll
            for (int m = 0; m < 4; ++m) { bf16_t* rowp = O + (size_t)(row0 + ai * HALF + m * 16) * ldc + col0;
#pragma unroll
                for (int bj = 0; bj < 2; ++bj) { const f32x4 v0 = acc[ai][bj][m][0] * sv[bj][0], v1 = acc[ai][bj][m][1] * sv[bj][1];
                    u32x4 w; w.x = cvt_pk_bf16(v0[0], v0[1]); w.y = cvt_pk_bf16(v0[2], v0[3]); w.z = cvt_pk_bf16(v1[0], v1[1]); w.w = cvt_pk_bf16(v1[2], v1[3]);
                    *(u32x4*)(rowp + bj * HALF) = w; } }
    }
};
template <bool FIRST, bool F8OUT = false> struct EpiGate {
    static constexpr bool PERM = true;
    bf16_t* Y; const bf16_t* Gt; unsigned char* Y8; const float* cs;
    __device__ __forceinline__ void operator()(const f32x4 (&acc)[2][2][4][2], const Unit& u, int wr, int wc, int fr, int fq) const {
        constexpr int ldy = DM, ldg = NP, ldy8 = DM;
        const int row0 = u.pm * BM + wr * 64 + fr, col0 = u.pn * BM + wc * 32 + 8 * fq;
        f32x4 sv[2][2];
#pragma unroll
        for (int bj = 0; bj < 2; ++bj)
#pragma unroll
            for (int n = 0; n < 2; ++n) sv[bj][n] = *(const f32x4*)(cs + col0 + bj * HALF + 4 * n);
#pragma unroll
        for (int ai = 0; ai < 2; ++ai)
#pragma unroll
        for (int mh = 0; mh < 2; ++mh) {
            u32x4 g[2][2], y[2][2];
#pragma unroll
            for (int mm = 0; mm < 2; ++mm)
#pragma unroll
                for (int bj = 0; bj < 2; ++bj) { const size_t r = (size_t)(row0 + ai * HALF + (mh * 2 + mm) * 16);
                    g[mm][bj] = *(const u32x4*)(Gt + r * ldg + col0 + bj * HALF);
                    if (!FIRST) y[mm][bj] = *(const u32x4*)(Y + r * ldy + col0 + bj * HALF); }
#pragma unroll
            for (int mm = 0; mm < 2; ++mm)
#pragma unroll
                for (int bj = 0; bj < 2; ++bj) { const int m = mh * 2 + mm; const size_t r = (size_t)(row0 + ai * HALF + m * 16); const f32x4 v0 = acc[ai][bj][m][0] * sv[bj][0], v1 = acc[ai][bj][m][1] * sv[bj][1]; const u32x4 gg = g[mm][bj];
                    float o[8];
                    o[0] = sigmoidf_(bflo(gg.x)) * v0[0]; o[1] = sigmoidf_(bfhi(gg.x)) * v0[1]; o[2] = sigmoidf_(bflo(gg.y)) * v0[2]; o[3] = sigmoidf_(bfhi(gg.y)) * v0[3];
                    o[4] = sigmoidf_(bflo(gg.z)) * v1[0]; o[5] = sigmoidf_(bfhi(gg.z)) * v1[1]; o[6] = sigmoidf_(bflo(gg.w)) * v1[2]; o[7] = sigmoidf_(bfhi(gg.w)) * v1[3];
                    if (!FIRST) { const u32x4 yy = y[mm][bj];
                        o[0] += bflo(yy.x); o[1] += bfhi(yy.x); o[2] += bflo(yy.y); o[3] += bfhi(yy.y); o[4] += bflo(yy.z); o[5] += bfhi(yy.z); o[6] += bflo(yy.w); o[7] += bfhi(yy.w); }
                    if constexpr (F8OUT) { int p0 = __builtin_amdgcn_cvt_pk_fp8_f32(o[0], o[1], 0, false); p0 = __builtin_amdgcn_cvt_pk_fp8_f32(o[2], o[3], p0, true);
                        int p1 = __builtin_amdgcn_cvt_pk_fp8_f32(o[4], o[5], 0, false); p1 = __builtin_amdgcn_cvt_pk_fp8_f32(o[6], o[7], p1, true);
                        u32x2 w8; w8.x = (unsigned)p0; w8.y = (unsigned)p1; *(u32x2*)(Y8 + r * ldy8 + col0 + bj * HALF) = w8; }
                    else { u32x4 w; w.x = cvt_pk_bf16(o[0], o[1]); w.y = cvt_pk_bf16(o[2], o[3]); w.z = cvt_pk_bf16(o[4], o[5]); w.w = cvt_pk_bf16(o[6], o[7]);
                        *(u32x4*)(Y + r * ldy + col0 + bj * HALF) = w; } }
        }
    }
};
template <bool CS> struct EpiResidT {
    static constexpr bool PERM = false;
    float* X; int ldx; const float* gate; const float* cs;
    __device__ __forceinline__ void operator()(const f32x4 (&acc)[2][2][4][2], const Unit& u, int wr, int wc, int fr, int fq) const {
        const int row0 = u.pm * BM + wr * 64 + fr, col0 = u.pn * BM + wc * 32 + 4 * fq;
        const int sel = (u.pm % 33 == 0) ? 2 : (u.pm / 33);
        const float* gp = gate + (size_t)sel * 12288 + col0;
        f32x4 gv[2][2];
#pragma unroll
        for (int bj = 0; bj < 2; ++bj)
#pragma unroll
            for (int n = 0; n < 2; ++n) { gv[bj][n] = *(const f32x4*)(gp + bj * HALF + n * 16); if constexpr (CS) gv[bj][n] = gv[bj][n] * *(const f32x4*)(cs + col0 + bj * HALF + n * 16); }
#pragma unroll
        for (int ai = 0; ai < 2; ++ai)
#pragma unroll
            for (int mh = 0; mh < 2; ++mh) {
                f32x4 x[2][2][2];
#pragma unroll
                for (int mm = 0; mm < 2; ++mm)
#pragma unroll
                    for (int bj = 0; bj < 2; ++bj)
#pragma unroll
                        for (int n = 0; n < 2; ++n) x[mm][bj][n] = *(const f32x4*)(X + (size_t)(row0 + ai * HALF + (mh * 2 + mm) * 16) * ldx + col0 + bj * HALF + n * 16);
#pragma unroll
                for (int mm = 0; mm < 2; ++mm)
#pragma unroll
                    for (int bj = 0; bj < 2; ++bj)
#pragma unroll
                        for (int n = 0; n < 2; ++n) *(f32x4*)(X + (size_t)(row0 + ai * HALF + (mh * 2 + mm) * 16) * ldx + col0 + bj * HALF + n * 16) = x[mm][bj][n] + gv[bj][n] * acc[ai][bj][mh * 2 + mm][n];
            }
    }
};

typedef int i32x8 __attribute__((ext_vector_type(8)));
typedef int i32x4 __attribute__((ext_vector_type(4)));
__device__ __forceinline__ i32x8 cat8(const bf16x8 lo, const bf16x8 hi) { const i32x4 a = __builtin_bit_cast(i32x4, lo), b = __builtin_bit_cast(i32x4, hi); return __builtin_shufflevector(a, b, 0, 1, 2, 3, 4, 5, 6, 7); }
template <class Epi, class Sched, int F8 = 0>
__device__ __forceinline__ void gemm_phase(LAS unsigned char* lds, const int tid, const Gemm g, const Sched& S, const Epi& E) {
    const int wid = __builtin_amdgcn_readfirstlane(tid >> 6), lane = tid & 63, wr = wid >> 2, wc = wid & 3, fr = lane & 15, fq = lane >> 4;
    const int K = g.K, nt = F8 ? K / 128 : K / BK, lda = g.lda, ldb = g.ldb;
    unsigned voffA[2], voffB[2];
#pragma unroll
    for (int i = 0; i < 2; ++i) { int R, C; stage_rc(tid * 16 + i * 8192, R, C); const int Rb = Epi::PERM ? ((R & ~31) + perm32(R & 31)) : R;
        voffA[i] = F8 ? (unsigned)(R * lda + C * 2) : (unsigned)(R * lda + C) * 2u; voffB[i] = F8 ? (unsigned)(Rb * ldb + C * 2) : (unsigned)(Rb * ldb + C) * 2u; }
    const size_t kstep = (size_t)(BK * 2);
    const size_t hstepA = (size_t)HALF * lda * (F8 ? 1 : 2), hstepB = (size_t)HALF * ldb * (F8 ? 1 : 2);
    const size_t tstepA = 2 * hstepA, tstepB = 2 * hstepB;
    const unsigned ldsw = (unsigned)wid * 1024u;
    const int aoff = F8 ? lds_byte(wr * 64 + fr, (fq & 1) * 16) + (fq >> 1) * 1024 : lds_byte(wr * 64 + fr, fq * 8);
    const int boff = F8 ? lds_byte(wc * 32 + fr, (fq & 1) * 16) + (fq >> 1) * 1024 : lds_byte(wc * 32 + fr, fq * 8);
#define PG8_SA(b, h) (((b) * 2 + (h)) * HTB)
#define PG8_SB(b, h) ((4 + (b) * 2 + (h)) * HTB)
#define PG8_STAGE(bufoff, gbase, voff) do { _Pragma("unroll") for (int _i = 0; _i < 2; ++_i) \
        __builtin_amdgcn_global_load_lds((const unsigned*)((const char*)(gbase) + (voff)[_i]), (LAS unsigned*)(lds + (bufoff) + ldsw + _i * 8192), 16, 0, 0); } while (0)
#define PG8_LDA(dst, b, h) do { if constexpr (F8) { _Pragma("unroll") for (int m = 0; m < 4; ++m) { const LAS unsigned char* p_ = lds + PG8_SA(b, h) + aoff + m * 2048; \
            const i32x4 lo_ = *(const LAS i32x4*)p_, hi_ = *(const LAS i32x4*)(p_ + 16); dst##8[m] = __builtin_shufflevector(lo_, hi_, 0, 1, 2, 3, 4, 5, 6, 7); } } \
        else { _Pragma("unroll") for (int m = 0; m < 4; ++m) _Pragma("unroll") for (int k = 0; k < 2; ++k) dst[m][k] = *(const LAS bf16x8*)(lds + PG8_SA(b, h) + aoff + m * 2048 + k * 1024); } } while (0)
#define PG8_LDB(dst, b, h) do { if constexpr (F8) { _Pragma("unroll") for (int n = 0; n < 2; ++n) { const LAS unsigned char* p_ = lds + PG8_SB(b, h) + boff + n * 2048; \
            const i32x4 lo_ = *(const LAS i32x4*)p_, hi_ = *(const LAS i32x4*)(p_ + 16); dst##8[n] = __builtin_shufflevector(lo_, hi_, 0, 1, 2, 3, 4, 5, 6, 7); } } \
        else { _Pragma("unroll") for (int n = 0; n < 2; ++n) _Pragma("unroll") for (int k = 0; k < 2; ++k) dst[n][k] = *(const LAS bf16x8*)(lds + PG8_SB(b, h) + boff + n * 2048 + k * 1024); } } while (0)
#define PG8_MMA(ai, bj, At, Bt) do { __builtin_amdgcn_s_setprio(1); \
        if constexpr (F8) { _Pragma("unroll") for (int m = 0; m < 4; ++m) _Pragma("unroll") for (int n = 0; n < 2; ++n) \
            asm volatile("v_mfma_scale_f32_16x16x128_f8f6f4 %0, %1, %2, %0, %3, %3 op_sel_hi:[0,0,0]" : "+v"(acc[ai][bj][m][n]) : "v"(Bt##8[n]), "v"(At##8[m]), "v"(mxscale)); } \
        else { _Pragma("unroll") for (int m = 0; m < 4; ++m) _Pragma("unroll") for (int n = 0; n < 2; ++n) _Pragma("unroll") for (int k = 0; k < 2; ++k) \
            acc[ai][bj][m][n] = __builtin_amdgcn_mfma_f32_16x16x32_bf16(Bt[n][k], At[m][k], acc[ai][bj][m][n], 0, 0, 0); } \
        __builtin_amdgcn_s_setprio(0); } while (0)
#define PG8_WAIT_V(n) asm volatile("s_waitcnt vmcnt(" #n ")" ::: "memory")
#define PG8_WAIT_L(n) asm volatile("s_waitcnt lgkmcnt(" #n ")" ::: "memory")
#define PG8_BAR __builtin_amdgcn_s_barrier()
#define PG8_SCHED __builtin_amdgcn_sched_barrier(0)
    Unit cur, nxt; int ui = 0;
    if (!S.next(0, cur)) return;
    f32x4 acc[2][2][4][2];
#pragma unroll
    for (int a = 0; a < 2; ++a)
#pragma unroll
        for (int b = 0; b < 2; ++b)
#pragma unroll
            for (int m = 0; m < 4; ++m)
#pragma unroll
                for (int n = 0; n < 2; ++n) acc[a][b][m][n] = (f32x4){0.f, 0.f, 0.f, 0.f};
    int mxscale = 0x7f7f7f7f; asm volatile("" : "+v"(mxscale));
    bf16x8 At[4][2], B0[2][2], B1[2][2]; i32x8 At8[4], B08[2], B18[2];
    const char* cA = (const char*)g.A + (size_t)cur.pm * tstepA; const char* cB = (const char*)g.Bt + (size_t)cur.pn * tstepB;
    PG8_STAGE(PG8_SB(0, 0), cB, voffB); PG8_STAGE(PG8_SA(0, 0), cA, voffA); PG8_STAGE(PG8_SB(0, 1), cB + hstepB, voffB); PG8_STAGE(PG8_SA(0, 1), cA + hstepA, voffA);
    if (wr == 1) PG8_BAR;
    PG8_WAIT_V(4); PG8_BAR;
    PG8_STAGE(PG8_SB(1, 0), cB + kstep, voffB); PG8_STAGE(PG8_SA(1, 0), cA + kstep, voffA); PG8_STAGE(PG8_SB(1, 1), cB + hstepB + kstep, voffB);
    PG8_WAIT_V(6); PG8_BAR;
    for (;;) {
        const bool has_next = S.next(ui + 1, nxt);
        const char* nA = has_next ? (const char*)g.A + (size_t)nxt.pm * tstepA : cA; const char* nB = has_next ? (const char*)g.Bt + (size_t)nxt.pn * tstepB : cB;
        for (int t = 0; t < nt; t += 2) {
            const bool last = (t == nt - 2);
            const char* a1 = cA + (size_t)(t + 1) * kstep;
            const char* a2 = last ? nA : cA + (size_t)(t + 2) * kstep; const char* b2 = last ? nB : cB + (size_t)(t + 2) * kstep;
            const char* a3 = a2 + kstep; const char* b3 = b2 + kstep;
            PG8_LDB(B0, 0, 0); PG8_SCHED; PG8_LDA(At, 0, 0); PG8_STAGE(PG8_SA(1, 1), a1 + hstepA, voffA);
            PG8_WAIT_L(8); PG8_BAR; PG8_WAIT_L(0); PG8_MMA(0, 0, At, B0); PG8_BAR; PG8_SCHED;
            PG8_LDB(B1, 0, 1); PG8_STAGE(PG8_SB(0, 0), b2, voffB);
            PG8_BAR; PG8_WAIT_L(0); PG8_MMA(0, 1, At, B1); PG8_BAR;
            PG8_LDA(At, 0, 1); PG8_STAGE(PG8_SA(0, 0), a2, voffA);
            PG8_BAR; PG8_WAIT_L(0); PG8_MMA(1, 0, At, B0); PG8_BAR; PG8_SCHED;
            PG8_STAGE(PG8_SB(0, 1), b2 + hstepB, voffB);
            PG8_WAIT_V(6); PG8_BAR; PG8_MMA(1, 1, At, B1); PG8_BAR;
            PG8_LDB(B0, 1, 0); PG8_SCHED; PG8_LDA(At, 1, 0); PG8_STAGE(PG8_SA(0, 1), a2 + hstepA, voffA);
            PG8_WAIT_L(8); PG8_BAR; PG8_WAIT_L(0); PG8_MMA(0, 0, At, B0); PG8_BAR; PG8_SCHED;
            PG8_LDB(B1, 1, 1); PG8_STAGE(PG8_SB(1, 0), b3, voffB);
            PG8_BAR; PG8_WAIT_L(0); PG8_MMA(0, 1, At, B1); PG8_BAR;
            PG8_LDA(At, 1, 1); PG8_STAGE(PG8_SA(1, 0), a3, voffA);
            PG8_BAR; PG8_WAIT_L(0); PG8_MMA(1, 0, At, B0); PG8_BAR; PG8_SCHED;
            PG8_STAGE(PG8_SB(1, 1), b3 + hstepB, voffB);
            PG8_WAIT_V(6); PG8_BAR; PG8_MMA(1, 1, At, B1); PG8_BAR;
        }
        if constexpr (F8) asm volatile("s_nop 15\n\ts_nop 7");
        E(acc, cur, wr, wc, fr, fq);
        if (!has_next) break;
#pragma unroll
        for (int a = 0; a < 2; ++a)
#pragma unroll
            for (int b = 0; b < 2; ++b)
#pragma unroll
                for (int m = 0; m < 4; ++m)
#pragma unroll
                    for (int n = 0; n < 2; ++n) acc[a][b][m][n] = (f32x4){0.f, 0.f, 0.f, 0.f};
        cur = nxt; cA = nA; cB = nB; ++ui;
    }
    PG8_WAIT_V(0);
    if (wr == 0) PG8_BAR;
    PG8_BAR;
#undef PG8_SA
#undef PG8_SB
#undef PG8_STAGE
#undef PG8_LDA
#undef PG8_LDB
#undef PG8_MMA
#undef PG8_WAIT_V
#undef PG8_WAIT_L
#undef PG8_BAR
#undef PG8_SCHED
}
}

struct Args { const float* in[30]; float* out; unsigned char* ws; int ph_lo, ph_hi; };
enum { I_X = 0, I_C, I_CTX, I_CCTX, I_WMOD, I_BMOD, I_N1G, I_WIN, I_QNG, I_KNG, I_WA2F, I_BAF, I_WA2B, I_BAB, I_ONG, I_MQNG, I_WUQ, I_MKVNG, I_WUKV,
       I_WBRA, I_WBRL, I_WBRM, I_WOUT, I_N2G, I_PWQ, I_PK1, I_PK2, I_PU, I_PV, I_FG };
typedef const float* cfp_t;
struct Ctx {
    const __attribute__((address_space(4))) cfp_t* in; float* out; unsigned char* ws; LAS unsigned char* lds;
    int tid, lane, wid, G, bid;
};
#define WSP(T, off) ((T*)(C.ws + (off)))
#define INP(i) ((const float*)(const GLB float*)C.in[(i)])
__device__ __forceinline__ unsigned long long launder_u64(unsigned long long w) {
    unsigned lo = (unsigned)w, hi = (unsigned)(w >> 32); asm volatile("" : "+v"(lo), "+v"(hi));
    lo = __builtin_amdgcn_readfirstlane(lo); hi = __builtin_amdgcn_readfirstlane(hi); return ((unsigned long long)hi << 32) | lo;
}
__device__ __forceinline__ Ctx launder(const Ctx& C0) {
    Ctx R = C0; int t = C0.tid; asm volatile("" : "+v"(t)); R.tid = t; R.lane = t & 63; R.wid = __builtin_amdgcn_readfirstlane(t >> 6);
    R.ws = (unsigned char*)(GLB unsigned char*)launder_u64((unsigned long long)C0.ws);
    R.out = (float*)(GLB float*)(unsigned long long)C0.out;
    R.in = (const __attribute__((address_space(4))) cfp_t*)launder_u64((unsigned long long)C0.in);
    unsigned l = (unsigned)(uintptr_t)C0.lds; asm volatile("" : "+v"(l)); l = __builtin_amdgcn_readfirstlane(l); R.lds = (LAS unsigned char*)(uintptr_t)l;
    return R;
}

__device__ __forceinline__ const float* src_row(const Ctx& C, int r) {
    const int b = r / RPB, j = r % RPB;
    return j < CTXL ? INP(I_CTX) + ((size_t)b * CTXL + j) * DM : INP(I_X) + ((size_t)b * SEQ + (j - CTXL)) * DM;
}
__device__ __forceinline__ int mod_sel(int r) { const int b = r / RPB, j = r % RPB; return j < CTXL ? 2 : b; }

__device__ __forceinline__ void phase_modv(const Ctx& C) {
    LAS float* sc = (LAS float*)C.lds;
    LAS float* red = (LAS float*)(C.lds + 3 * 2048 * 4);
    for (int i = C.tid; i < 3 * DM; i += NTHREADS) { const int r = i / DM, k = i % DM; const float v = r < 2 ? INP(I_C)[r * DM + k] : INP(I_CCTX)[k]; sc[i] = siluf_(v); }
    __syncthreads();
    float* modv = WSP(float, WS_MODV);
    const int kq = C.tid / 12, c4 = C.tid % 12;
    for (int item = C.bid; item < 2 * 256; item += C.G) {
        const int l = item / 256, cg = item % 256;
        float acc[3][4];
#pragma unroll
        for (int r = 0; r < 3; ++r)
#pragma unroll
            for (int j = 0; j < 4; ++j) acc[r][j] = 0.f;
        if (kq < 42) {
            const float* wp = INP(I_WMOD) + (size_t)l * DM * 12288 + 48 * cg + 4 * c4;
#pragma unroll 1
            for (int k0 = kq; k0 < DM; k0 += 42 * 7) {
                f32x4 w[7];
#pragma unroll
                for (int u = 0; u < 7; ++u) { const int k = k0 + 42 * u; w[u] = k < DM ? *(const f32x4*)(wp + (size_t)k * 12288) : (f32x4){0.f, 0.f, 0.f, 0.f}; }
#pragma unroll
                for (int u = 0; u < 7; ++u) { const int k = k0 + 42 * u; if (k < DM) {
#pragma unroll
                    for (int r = 0; r < 3; ++r) { const float sv = sc[r * DM + k];
#pragma unroll
                        for (int j = 0; j < 4; ++j) acc[r][j] += sv * w[u][j]; } } }
            }
#pragma unroll
            for (int r = 0; r < 3; ++r)
#pragma unroll
                for (int j = 0; j < 4; ++j) red[kq * 144 + r * 48 + c4 * 4 + j] = acc[r][j];
        }
        __syncthreads();
        if (C.tid < 144) { float s = 0.f; for (int q = 0; q < 42; ++q) s += red[q * 144 + C.tid];
            const int r = C.tid / 48, cc = C.tid % 48;
            modv[((size_t)l * 3 + r) * 12288 + 48 * cg + cc] = s + INP(I_BMOD)[(size_t)l * 12288 + 48 * cg + cc]; }
        __syncthreads();
    }
}
__device__ __forceinline__ void phase_tables(const Ctx& C) {
    float* ta = WSP(float, WS_TABA); float* tm = WSP(float, WS_TABM);
    for (int i = C.bid * NTHREADS + C.tid; i < 128 * 32 + 128 * 16; i += C.G * NTHREADS) {
        if (i < 128 * 32) { const int pos = i / 32, f = i % 32; const float inv = exp2f(-(float)f * (13.287712379549449f / 32.0f)); const float a = (float)pos * inv;
            ta[i] = cosf(a); ta[128 * 32 + i] = sinf(a); }
        else { const int k = i - 128 * 32, pos = k / 16, f = k % 16; const float inv = exp2f(-(float)f * (13.287712379549449f / 16.0f)); const float a = (float)pos * inv;
            tm[k] = cosf(a); tm[128 * 16 + k] = sinf(a); }
    }
}
__device__ __forceinline__ void transpose_cvt(const Ctx& C, const float* src, int K, int N, bf16_t* dst, int Npad, int& item) {
    LAS float* tile = (LAS float*)C.lds;
    const int tk = K / 64, tn = Npad / 256, ntile = tk * tn;
    const int t0 = ((C.bid - item % C.G) + C.G) % C.G; item += ntile;
    for (int t = t0; t < ntile; t += C.G) {
        const int k0 = (t / tn) * 64, n0 = (t % tn) * 256;
        const int nn = (C.tid & 63) * 4, kr = C.tid >> 6;
        f32x4 v[8];
#pragma unroll
        for (int p = 0; p < 8; ++p) { v[p] = (f32x4){0.f, 0.f, 0.f, 0.f}; if (n0 + nn < N) v[p] = *(const f32x4*)(src + (size_t)(k0 + kr + p * 8) * N + n0 + nn); }
#pragma unroll
        for (int p = 0; p < 8; ++p)
#pragma unroll
            for (int j = 0; j < 4; ++j) tile[(kr + p * 8) * 257 + nn + j] = v[p][j];
        __syncthreads();
        { const int n = C.tid >> 1, kh = (C.tid & 1) * 32;
#pragma unroll
          for (int q = 0; q < 4; ++q) { float x[8];
#pragma unroll
              for (int j = 0; j < 8; ++j) x[j] = tile[(kh + q * 8 + j) * 257 + n];
              u32x4 w; w.x = cvt_pk_bf16(x[0], x[1]); w.y = cvt_pk_bf16(x[2], x[3]); w.z = cvt_pk_bf16(x[4], x[5]); w.w = cvt_pk_bf16(x[6], x[7]);
              *(u32x4*)(dst + (size_t)(n0 + n) * K + k0 + kh + q * 8) = w; } }
        __syncthreads();
    }
}
__device__ __forceinline__ void transpose_cvt_fp8(const Ctx& C, const float* src, int K, int N, unsigned char* dst, int Npad, float* cinv, const float cmul = 1.0f, const int wg_off = 0) {
    LAS float* tile = (LAS float*)C.lds;
    LAS float* red = (LAS float*)(C.lds + 64 * 65 * 4);
    LAS float* scl = red + 32 * 64;
    const int kk = C.tid >> 4, nn = (C.tid & 15) * 4;
    for (int cgp = ((C.bid - wg_off) % C.G + C.G) % C.G; cgp < Npad / 64; cgp += C.G) {
        const int n0 = cgp * 64; const bool live = n0 + nn < N;
        float am[4] = {0.f, 0.f, 0.f, 0.f};
        for (int k0 = 0; k0 < K; k0 += 128) {
            f32x4 v[4];
#pragma unroll
            for (int p = 0; p < 4; ++p) v[p] = live ? *(const f32x4*)(src + (size_t)(k0 + kk + p * 32) * N + n0 + nn) : (f32x4){0.f, 0.f, 0.f, 0.f};
#pragma unroll
            for (int p = 0; p < 4; ++p)
#pragma unroll
                for (int j = 0; j < 4; ++j) am[j] = fmaxf(am[j], fabsf(v[p][j])); }
#pragma unroll
        for (int j = 0; j < 4; ++j) red[kk * 64 + nn + j] = am[j];
        __syncthreads();
        if (C.tid < 64) { float m = 0.f; for (int q = 0; q < 32; ++q) m = fmaxf(m, red[q * 64 + C.tid]);
            scl[C.tid] = m > 0.f ? 224.0f / m : 1.0f; cinv[n0 + C.tid] = (m > 0.f ? m * (1.0f / 224.0f) : 1.0f) * cmul; }
        __syncthreads();
        for (int k0 = 0; k0 < K; k0 += 64) {
#pragma unroll
            for (int p = 0; p < 2; ++p) { const f32x4 v = live ? *(const f32x4*)(src + (size_t)(k0 + kk + p * 32) * N + n0 + nn) : (f32x4){0.f, 0.f, 0.f, 0.f};
#pragma unroll
                for (int j = 0; j < 4; ++j) tile[(kk + p * 32) * 65 + nn + j] = v[j]; }
            __syncthreads();
            { const int n = C.tid >> 3, k8 = (C.tid & 7) * 8; const float sc = scl[n]; float x[8];
#pragma unroll
              for (int j = 0; j < 8; ++j) x[j] = tile[(k8 + j) * 65 + n] * sc;
              int p0 = __builtin_amdgcn_cvt_pk_fp8_f32(x[0], x[1], 0, false); p0 = __builtin_amdgcn_cvt_pk_fp8_f32(x[2], x[3], p0, true);
              int p1 = __builtin_amdgcn_cvt_pk_fp8_f32(x[4], x[5], 0, false); p1 = __builtin_amdgcn_cvt_pk_fp8_f32(x[6], x[7], p1, true);
              u32x2 w; w.x = (unsigned)p0; w.y = (unsigned)p1; *(u32x2*)(dst + (size_t)(n0 + n) * K + k0 + k8) = w; }
            __syncthreads();
        }
    }
}
__device__ __forceinline__ void cvt_plain(const Ctx& C, const float* src, bf16_t* dst, size_t n8) {
    for (size_t i = (size_t)C.bid * NTHREADS + C.tid; i < n8; i += (size_t)C.G * NTHREADS) {
        const f32x4 a = *(const f32x4*)(src + i * 8), b = *(const f32x4*)(src + i * 8 + 4);
        u32x4 w; w.x = cvt_pk_bf16(a[0], a[1]); w.y = cvt_pk_bf16(a[2], a[3]); w.z = cvt_pk_bf16(b[0], b[1]); w.w = cvt_pk_bf16(b[2], b[3]);
        *(u32x4*)(dst + i * 8) = w;
    }
}
__device__ __forceinline__ void phase_cvt_mixer_weights(const Ctx& C, int l) {
    int item = 0;
    transpose_cvt_fp8(C, INP(I_WIN) + (size_t)l * DM * IN_COLS, DM, IN_COLS, C.ws + WS_WIN, NP, WSP(float, WS_WINS));
    __syncthreads();
    transpose_cvt(C, INP(I_WUQ) + (size_t)l * 512 * 1536, 512, 1536, WSP(bf16_t, WS_WUQ), 1536, item);
    transpose_cvt(C, INP(I_WUKV) + (size_t)l * 512 * 2048, 512, 2048, WSP(bf16_t, WS_WUKV), 2048, item);
    transpose_cvt_fp8(C, INP(I_WBRA) + (size_t)l * 1024 * 2048, 1024, 2048, C.ws + WS_WBR, 2048, WSP(float, WS_WBRS), 1.0f / 32.0f, 220); __syncthreads();
    transpose_cvt_fp8(C, INP(I_WBRL) + (size_t)l * 1024 * 2048, 1024, 2048, C.ws + WS_WBR + (size_t)2048 * 1024, 2048, WSP(float, WS_WBRS) + DM, 1.0f, 220); __syncthreads();
    transpose_cvt_fp8(C, INP(I_WBRM) + (size_t)l * 1024 * 2048, 1024, 2048, C.ws + WS_WBR + (size_t)2 * 2048 * 1024, 2048, WSP(float, WS_WBRS) + 2 * DM, 1.0f / 32.0f, 252); __syncthreads();
    transpose_cvt_fp8(C, INP(I_WOUT) + (size_t)l * 2048 * 2048, 2048, 2048, C.ws + WS_WOUT, 2048, WSP(float, WS_WOUTS), 1.0f, 188);
    __syncthreads();
    transpose_cvt(C, INP(I_PWQ) + (size_t)l * 2048 * 2048, 2048, 2048, WSP(bf16_t, WS_WQ), 2048, item);
    cvt_plain(C, INP(I_PK1) + (size_t)l * 8 * 128 * 128, WSP(bf16_t, WS_K1), 8 * 128 * 128 / 8);
    cvt_plain(C, INP(I_PK2) + (size_t)l * 8 * 128 * 128, WSP(bf16_t, WS_K2), 8 * 128 * 128 / 8);
}
__device__ __forceinline__ void phase_cvt_peer_tables(const Ctx& C, int l, int row_lo, int row_hi, int wg_lo) {
    const int lane = C.lane; if (C.bid < wg_lo) return;
    unsigned char* pt = C.ws + WS_PT + (size_t)l * PT_BYTES;
    for (int row = row_lo + (C.bid - wg_lo) * 8 + C.wid; row < row_hi; row += (C.G - wg_lo) * 8) {
#pragma unroll 1
        for (int tb = 0; tb < 2; ++tb) {
            const float* src = (tb ? INP(I_PV) : INP(I_PU)) + ((size_t)l * NEXP + row) * DM + lane * 16;
            f32x4 x[8]; float amax = 0.f;
#pragma unroll
            for (int c = 0; c < 2; ++c)
#pragma unroll
                for (int q = 0; q < 4; ++q) { x[c * 4 + q] = *(const f32x4*)(src + c * 1024 + q * 4);
                    amax = fmaxf(amax, fmaxf(fmaxf(fabsf(x[c * 4 + q][0]), fabsf(x[c * 4 + q][1])), fmaxf(fabsf(x[c * 4 + q][2]), fabsf(x[c * 4 + q][3])))); }
            amax = fmaxf(amax, xchg32(amax, lane)); amax = fmaxf(amax, xchg16(amax, lane)); amax = fmaxf(amax, dppmov<DPP_ROR8>(amax));
            amax = fmaxf(amax, dppmov<DPP_HMIRROR>(amax)); amax = fmaxf(amax, dppmov<DPP_Q3210>(amax)); amax = fmaxf(amax, dppmov<DPP_Q1032>(amax));
            const float sc = amax > 0.f ? 224.0f / amax : 1.0f, inv = amax > 0.f ? amax * (1.0f / 224.0f) : 1.0f;
            unsigned char* dst = pt + (tb ? PT_V8 : PT_U8) + (size_t)(lane >> 3) * ((size_t)NEXP * 128) + (size_t)row * 128 + (lane & 7) * 16;
#pragma unroll
            for (int c = 0; c < 2; ++c) { u32x4 w;
#pragma unroll
                for (int q = 0; q < 4; ++q) { const f32x4 v = x[c * 4 + q] * sc; int p = __builtin_amdgcn_cvt_pk_fp8_f32(v[0], v[1], 0, false); p = __builtin_amdgcn_cvt_pk_fp8_f32(v[2], v[3], p, true); w[q] = (unsigned)p; }
                *(u32x4*)(dst + (size_t)c * 8 * ((size_t)NEXP * 128)) = w; }
            if (lane == 0) ((float*)(pt + (tb ? PT_SCV : PT_SCU)))[row] = inv;
        }
    }
}

template <bool FIRST, bool F8OUT = false> __device__ __forceinline__ void phase_norm_mod(const Ctx& C, const float* gvec, const float* modl  , int shift_off, int scale_off) {
    float* xs = WSP(float, WS_XS); bf16_t* hb = WSP(bf16_t, WS_HB);
    f32x4 vn[8];
#define NM_LOAD(R) do { const float* xr_ = FIRST ? src_row(C, (R)) : xs + (size_t)(R) * DM; \
        _Pragma("unroll") for (int c = 0; c < 4; ++c) { vn[2 * c] = *(const f32x4*)(xr_ + c * 512 + C.lane * 8); vn[2 * c + 1] = *(const f32x4*)(xr_ + c * 512 + C.lane * 8 + 4); } } while (0)
    { const int r0 = C.bid * 8 + C.wid; if (r0 < TT) NM_LOAD(r0); }
    for (int r = C.bid * 8 + C.wid; r < TT; r += C.G * 8) {
        const float* mv = modl + (size_t)mod_sel(r) * 12288;
        f32x4 v[8]; float ss = 0.f;
#pragma unroll
        for (int c = 0; c < 8; ++c) v[c] = vn[c];
        if (r + C.G * 8 < TT) NM_LOAD(r + C.G * 8);
        __builtin_amdgcn_sched_barrier(0);
#pragma unroll
        for (int c = 0; c < 8; ++c) ss += v[c][0] * v[c][0] + v[c][1] * v[c][1] + v[c][2] * v[c][2] + v[c][3] * v[c][3];
        ss = wave_sum(ss);
        const float rs = rsqrtf(ss * (1.0f / DM) + NORM_EPS);
#pragma unroll
        for (int c = 0; c < 4; ++c) { const int col = c * 512 + C.lane * 8;
            if (FIRST) { *(f32x4*)(xs + (size_t)r * DM + col) = v[2 * c]; *(f32x4*)(xs + (size_t)r * DM + col + 4) = v[2 * c + 1]; }
            float o[8];
#pragma unroll
            for (int h = 0; h < 2; ++h) { const f32x4 g = *(const f32x4*)(gvec + col + 4 * h), s = *(const f32x4*)(mv + scale_off + col + 4 * h), t = *(const f32x4*)(mv + shift_off + col + 4 * h);
#pragma unroll
                for (int j = 0; j < 4; ++j) o[4 * h + j] = v[2 * c + h][j] * rs * g[j] * (1.0f + s[j]) + t[j]; }
            if constexpr (F8OUT) {
                int p0 = __builtin_amdgcn_cvt_pk_fp8_f32(o[0], o[1], 0, false); p0 = __builtin_amdgcn_cvt_pk_fp8_f32(o[2], o[3], p0, true);
                int p1 = __builtin_amdgcn_cvt_pk_fp8_f32(o[4], o[5], 0, false); p1 = __builtin_amdgcn_cvt_pk_fp8_f32(o[6], o[7], p1, true);
                u32x2 w; w.x = (unsigned)p0; w.y = (unsigned)p1; *(u32x2*)((unsigned char*)hb + (size_t)r * DM + col) = w;
            } else {
            u32x4 w; w.x = cvt_pk_bf16(o[0], o[1]); w.y = cvt_pk_bf16(o[2], o[3]); w.z = cvt_pk_bf16(o[4], o[5]); w.w = cvt_pk_bf16(o[6], o[7]);
            *(u32x4*)(hb + (size_t)r * DM + col) = w; } }
    }
}
#undef NM_LOAD

__device__ __forceinline__ void phase_post_p(const Ctx& C, int l) {
    bf16_t* P = WSP(bf16_t, WS_P); const float* ta = WSP(float, WS_TABA); const float* tm = WSP(float, WS_TABM);
    const float* qg = INP(I_QNG) + l * 128; const float* kg = INP(I_KNG) + l * 128;
    const float* mqg = INP(I_MQNG) + l * 512; const float* mkvg = INP(I_MKVNG) + l * 512;
    const int lane = C.lane;
    const float qg1 = qg[lane], qg2 = qg[lane + 64], kg1 = kg[lane], kg2 = kg[lane + 64];
    for (int r = C.bid * 8 + C.wid; r < TT; r += C.G * 8) {
        bf16_t* pr = P + (size_t)r * NP;
        const int j = r % RPB; const bool lat = j >= CTXL; const int pos = lat ? j - CTXL : 0, ri = pos >> 6, ci = pos & 63;
        float cs = 1.f, sn = 0.f;
        if (lat) { const int p = lane < 32 ? ri : ci, f = lane & 31; cs = ta[p * 32 + f]; sn = ta[128 * 32 + p * 32 + f]; }
#pragma unroll
        for (int h = 0; h < 10; ++h) {
            bf16_t* hp = pr + (h < 8 ? C_AQ + h * 128 : C_AK + (h - 8) * 128);
            const float x1 = bf2f(hp[lane]), x2 = bf2f(hp[lane + 64]);
            const float ss = wave_sum(x1 * x1 + x2 * x2);
            const float rs = rsqrtf(ss * (1.0f / 128.0f) + NORM_EPS);
            const float y1 = x1 * rs * (h < 8 ? qg1 : kg1), y2 = x2 * rs * (h < 8 ? qg2 : kg2);
            const float z1 = y1 * cs - y2 * sn, z2 = y2 * cs + y1 * sn;
            hp[lane] = f2bf(z1); hp[lane + 64] = f2bf(z2);
            if (h >= 8) { unsigned char* k8 = C.ws + WS_AK8 + (size_t)r * 256 + (h - 8) * 128;
                k8[lane] = (unsigned char)(__builtin_amdgcn_cvt_pk_fp8_f32(z1, 0.f, 0, false) & 0xff); k8[lane + 64] = (unsigned char)(__builtin_amdgcn_cvt_pk_fp8_f32(z2, 0.f, 0, false) & 0xff); }
        }
#pragma unroll
        for (int s = 0; s < 2; ++s) {
            bf16_t* sp = pr + (s == 0 ? C_MCQ : C_MCKV) + lane * 8; const float* gg = (s == 0 ? mqg : mkvg) + lane * 8;
            const u32x4 w = *(const u32x4*)sp; float x[8] = {bflo(w.x), bfhi(w.x), bflo(w.y), bfhi(w.y), bflo(w.z), bfhi(w.z), bflo(w.w), bfhi(w.w)};
            float ss = 0.f;
#pragma unroll
            for (int i = 0; i < 8; ++i) ss += x[i] * x[i];
            ss = wave_sum(ss);
            const float rs = rsqrtf(ss * (1.0f / 512.0f) + NORM_EPS);
#pragma unroll
            for (int i = 0; i < 8; ++i) x[i] = x[i] * rs * gg[i];
            u32x4 o; o.x = cvt_pk_bf16(x[0], x[1]); o.y = cvt_pk_bf16(x[2], x[3]); o.z = cvt_pk_bf16(x[4], x[5]); o.w = cvt_pk_bf16(x[6], x[7]);
            *(u32x4*)sp = o;
        }
        { bf16_t* kp = pr + C_MKR; const int i = lane & 31; const float x1 = bf2f(kp[i]), x2 = bf2f(kp[i + 32]);
          float c2 = 1.f, s2 = 0.f; if (lat) { const int p = i < 16 ? ri : ci, f = i & 15; c2 = tm[p * 16 + f]; s2 = tm[128 * 16 + p * 16 + f]; }
          const float z1 = x1 * c2 - x2 * s2, z2 = x2 * c2 + x1 * s2;
          if (lane < 32) { if (lat) { kp[i] = f2bf(z1); kp[i + 32] = f2bf(z2); }
              unsigned char* k8 = C.ws + WS_KR8 + (size_t)r * 64; k8[i] = (unsigned char)(__builtin_amdgcn_cvt_pk_fp8_f32(z1, 0.f, 0, false) & 0xff); k8[i + 32] = (unsigned char)(__builtin_amdgcn_cvt_pk_fp8_f32(z2, 0.f, 0, false) & 0xff); } }
    }
}

typedef int i32x8 __attribute__((ext_vector_type(8)));
typedef int i32x4 __attribute__((ext_vector_type(4)));
namespace att {
constexpr int NW = 8, QBLK = 32, KVBLK = 64, DV = 128;
constexpr float THR = 8.f;
#define SBAR() __builtin_amdgcn_sched_barrier(0)
__device__ __forceinline__ int crow(int r, int hi) { return (r & 3) + 8 * (r >> 2) + 4 * hi; }
template <int DQ> struct Cf {
    static constexpr int ND0 = DQ / 16, KROWB = DQ * 2, SHM_K = KVBLK * DQ * 2, SHM_V = KVBLK * DV * 2, SHM = 2 * SHM_V + 2 * SHM_K + NW * 64 * 4;
    static constexpr float SCALE = DQ == 128 ? 0.088388347648318440f : 0.072168783648703220f;
    __device__ static __forceinline__ int kswz(int row, int colB) { return row * KROWB + (colB ^ ((row & 7) << 4)); }
};
template <int DQ, int VAR = 0> __device__ __forceinline__ void partialSM(f32x16& p0, f32x16& p1, float& m_reg, float& mn, float& alpha, const float thr = THR, const float eoff = 0.f) {
    constexpr float SC = Cf<DQ>::SCALE, Cc = SC * 1.4426950408889634f;
    float pmax = p0[0];
#pragma unroll
    for (int r = 1; r < 16; ++r) pmax = fmaxf(pmax, p0[r]);
#pragma unroll
    for (int r = 0; r < 16; ++r) pmax = fmaxf(pmax, p1[r]);
    { auto rr = __builtin_amdgcn_permlane32_swap(__float_as_uint(pmax), __float_as_uint(pmax), false, false);
      pmax = fmaxf(__uint_as_float(rr[0]), __uint_as_float(rr[1])); }
    if (__builtin_expect(__all(pmax - m_reg <= thr / SC), 1)) { mn = m_reg; alpha = 1.f; }
    else { mn = fmaxf(m_reg, pmax); alpha = __builtin_amdgcn_exp2f((m_reg - mn) * Cc); m_reg = mn; }
    const float mnC = eoff - mn * Cc;
#pragma unroll
    for (int r = 0; r < 16; ++r) p0[r] = fmaf(p0[r], Cc, mnC);
#pragma unroll
    for (int r = 0; r < 16; ++r) p1[r] = fmaf(p1[r], Cc, mnC);
#pragma unroll
    for (int r = 0; r < 16; ++r) p0[r] = VAR == 1 ? p0[r] * 0.001f : __builtin_amdgcn_exp2f(p0[r]);
}
template <int VAR = 0> __device__ __forceinline__ void finishSM(f32x16& p0, f32x16& p1, float alpha, float& l_reg, bf16x8& pa0, bf16x8& pa1, bf16x8& pa2, bf16x8& pa3) {
#pragma unroll
    for (int r = 0; r < 16; ++r) p1[r] = VAR == 1 ? p1[r] * 0.001f : __builtin_amdgcn_exp2f(p1[r]);
    float ps = 0;
#pragma unroll
    for (int r = 0; r < 16; ++r) ps += p0[r];
#pragma unroll
    for (int r = 0; r < 16; ++r) ps += p1[r];
    { auto rr = __builtin_amdgcn_permlane32_swap(__float_as_uint(ps), __float_as_uint(ps), false, false);
      ps = __uint_as_float(rr[0]) + __uint_as_float(rr[1]); }
    l_reg = l_reg * alpha + ps;
#define PK4(P, BASE, OUT) do { unsigned a0 = cvt_pk_bf16(P[BASE + 0], P[BASE + 1]), a1 = cvt_pk_bf16(P[BASE + 2], P[BASE + 3]);   \
    unsigned b0 = cvt_pk_bf16(P[BASE + 4], P[BASE + 5]), b1 = cvt_pk_bf16(P[BASE + 6], P[BASE + 7]);                              \
    auto r0 = __builtin_amdgcn_permlane32_swap(a0, b0, false, false); auto r1 = __builtin_amdgcn_permlane32_swap(a1, b1, false, false); \
    u32x4 w = {r0[0], r1[0], r0[1], r1[1]}; OUT = *reinterpret_cast<bf16x8*>(&w); } while (0)
    PK4(p0, 0, pa0); PK4(p0, 8, pa1); PK4(p1, 0, pa2); PK4(p1, 8, pa3);
#undef PK4
}
template <int DQ> __device__ __forceinline__ void qkt(f32x16& p0, f32x16& p1, const char* Ks, const bf16x8* qr, const char* qx, int r32, int hi) {
    p0 = f32x16{}; p1 = f32x16{};
#pragma unroll
    for (int d0 = 0; d0 < Cf<DQ>::ND0; ++d0) { const int cb = (d0 * 16 + hi * 8) * 2;
        const bf16x8 b0 = *reinterpret_cast<const bf16x8*>(Ks + Cf<DQ>::kswz(r32, cb));
        const bf16x8 b1 = *reinterpret_cast<const bf16x8*>(Ks + Cf<DQ>::kswz(32 + r32, cb));
        constexpr int NQR = DQ == 192 ? MLA_NQR : 8;
        bf16x8 q; if (d0 < NQR) q = qr[d0]; else q = *reinterpret_cast<const bf16x8*>(qx + (d0 - NQR) * 1024);
        p0 = __builtin_amdgcn_mfma_f32_32x32x16_bf16(b0, q, p0, 0, 0, 0);
        p1 = __builtin_amdgcn_mfma_f32_32x32x16_bf16(b1, q, p1, 0, 0, 0); }
}
__device__ __forceinline__ int v_st(int k, int c) { const int kk = (k & ~0xC) | ((k & 4) << 1) | ((k & 8) >> 1); return ((kk >> 3) * 4 + (c >> 5)) * 512 + ((kk & 7) * 32 + (c & 31)) * 2; }
__device__ __forceinline__ int v_rd_base(int lane) { return ((lane & 3) << 3) | (((lane >> 2) & 3) << 6) | (((lane >> 4) & 1) << 5) | (((lane >> 5) & 1) << 8); }
constexpr int v_rd_off(int d0, int ks, int half) { return d0 * 512 + ks * 4096 + half * 2048; }
template <int OFF> __device__ __forceinline__ s16x4 tr_read(int vb) {
    s16x4 r; asm volatile("ds_read_b64_tr_b16 %0, %1 offset:%2" : "=&v"(r) : "v"(vb), "i"(OFF) : "memory"); return r;
}
template <int D0> __device__ __forceinline__ void pv_one(f32x16& od, int vb, bf16x8 pa0, bf16x8 pa1, bf16x8 pa2, bf16x8 pa3) {
    const s16x4 l0 = tr_read<v_rd_off(D0, 0, 0)>(vb), h0 = tr_read<v_rd_off(D0, 0, 1)>(vb), l1 = tr_read<v_rd_off(D0, 1, 0)>(vb), h1 = tr_read<v_rd_off(D0, 1, 1)>(vb);
    const s16x4 l2 = tr_read<v_rd_off(D0, 2, 0)>(vb), h2 = tr_read<v_rd_off(D0, 2, 1)>(vb), l3 = tr_read<v_rd_off(D0, 3, 0)>(vb), h3 = tr_read<v_rd_off(D0, 3, 1)>(vb);
    asm volatile("s_waitcnt lgkmcnt(0)" ::: "memory"); SBAR();
#define PK(L, H) (bf16x8){L[0], L[1], L[2], L[3], H[0], H[1], H[2], H[3]}
    od = __builtin_amdgcn_mfma_f32_32x32x16_bf16(pa0, PK(l0, h0), od, 0, 0, 0);
    od = __builtin_amdgcn_mfma_f32_32x32x16_bf16(pa1, PK(l1, h1), od, 0, 0, 0);
    od = __builtin_amdgcn_mfma_f32_32x32x16_bf16(pa2, PK(l2, h2), od, 0, 0, 0);
    od = __builtin_amdgcn_mfma_f32_32x32x16_bf16(pa3, PK(l3, h3), od, 0, 0, 0);
#undef PK
}
__device__ __forceinline__ void pv_d0(f32x16* o, int vb, bf16x8 pa0, bf16x8 pa1, bf16x8 pa2, bf16x8 pa3) {
    pv_one<0>(o[0], vb, pa0, pa1, pa2, pa3); pv_one<1>(o[1], vb, pa0, pa1, pa2, pa3); pv_one<2>(o[2], vb, pa0, pa1, pa2, pa3); pv_one<3>(o[3], vb, pa0, pa1, pa2, pa3);
}
__device__ __forceinline__ bf16x8 ld8(const bf16_t* p) { return *reinterpret_cast<const bf16x8*>(p); }

template <int DQ, int SD, int VAR = 0>
__device__ __forceinline__ void attn_body(const bf16_t* __restrict__ Qb, int ldq, const bf16_t* __restrict__ Kn, int ldkn, const bf16_t* __restrict__ Kr, int ldkr,
                                          const bf16_t* __restrict__ Vh, int ldv, unsigned char* __restrict__ Ob, int ldo, int seq, bool rope_q, int pos0, const float* __restrict__ tabM, char* lds, const int tid) {
    using CF = Cf<DQ>; constexpr int ND0 = CF::ND0, SHM_V = CF::SHM_V, SHM_K = CF::SHM_K;
    const int wid = tid >> 6, lane = tid & 63, r32 = lane & 31, hi = lane >> 5;
    char* V_lds = lds; char* K_lds = lds + 2 * SHM_V;
    float* ws = (float*)(lds + 2 * SHM_V + 2 * SHM_K) + wid * 64; float* li_l = ws; float* al_l = ws + 32;
    constexpr int NQR = DQ == 192 ? MLA_NQR : 8;
    float m_reg = -1e30f, l_reg = 0; f32x16 o[4] = {}; bf16x8 qr[NQR];
    const bf16_t* Qw = Qb + (long)(wid * QBLK + r32) * ldq + hi * 8;
#pragma unroll
    for (int d0 = 0; d0 < NQR; ++d0) qr[d0] = ld8(Qw + d0 * 16);
    char* qx = lds + CF::SHM + wid * 8192 + lane * 16;
    if constexpr (DQ == 192) {
#pragma unroll
        for (int d0 = NQR; d0 < 8; ++d0) *(bf16x8*)(qx + (d0 - NQR) * 1024) = ld8(Qw + d0 * 16);
        bf16x8 qe[4];
#pragma unroll
        for (int d0 = 0; d0 < 4; ++d0) qe[d0] = ld8(Qw + (8 + d0) * 16);
        if (rope_q) {
            const int pos = pos0 + wid * QBLK + r32, ri = pos >> 6, ci = pos & 63;
#pragma unroll
            for (int t = 0; t < 2; ++t) { const int p = t == 0 ? ri : ci; const float* tc = tabM + p * 16 + hi * 8; const float* tsn = tabM + 128 * 16 + p * 16 + hi * 8;
                bf16x8 a = qe[t], b = qe[2 + t];
#pragma unroll
                for (int jj = 0; jj < 8; ++jj) { const float x1 = bf2f((bf16_t)a[jj]), x2 = bf2f((bf16_t)b[jj]), c = tc[jj], s = tsn[jj];
                    a[jj] = (short)f2bf(x1 * c - x2 * s); b[jj] = (short)f2bf(x2 * c + x1 * s); }
                qe[t] = a; qe[2 + t] = b; }
        }
#pragma unroll
        for (int d0 = 0; d0 < 4; ++d0) *(bf16x8*)(qx + (8 - NQR + d0) * 1024) = qe[d0];
    }
    const int sr = tid >> 4, sc = (tid & 15) * 8, vst0 = v_st(sr, sc), vst1 = v_st(32 + sr, sc);
    const int sr2 = tid >> 3, sc2 = (tid & 7) * 8;
    const int vb0 = (int)(uintptr_t)V_lds + v_rd_base(lane);
    struct { bf16x8 vs0, vs1, ks0, ks1, ks2; } sr_[SD];
    const unsigned offV = (unsigned)(sr * ldv + sc) * 2u, offK = (unsigned)(sr * ldkn + sc) * 2u, offR = (unsigned)(sr2 * ldkr + sc2) * 2u;
#define SLOAD(i, k0) do { const char* vt_ = (const char*)Vh + (size_t)(k0) * ldv * 2; const char* kt_ = (const char*)Kn + (size_t)(k0) * ldkn * 2; \
    sr_[i].vs0 = *(const bf16x8*)(vt_ + offV); sr_[i].vs1 = *(const bf16x8*)(vt_ + (size_t)32 * ldv * 2 + offV); \
    sr_[i].ks0 = *(const bf16x8*)(kt_ + offK); sr_[i].ks1 = *(const bf16x8*)(kt_ + (size_t)32 * ldkn * 2 + offK); \
    if constexpr (DQ == 192) sr_[i].ks2 = *(const bf16x8*)((const char*)Kr + (size_t)(k0) * ldkr * 2 + offR); } while (0)
#define SWRITE(b, i) do { *(bf16x8*)(V_lds + (b) * SHM_V + vst0) = sr_[i].vs0; *(bf16x8*)(V_lds + (b) * SHM_V + vst1) = sr_[i].vs1; const int kc = sc * 2; \
    *(bf16x8*)(K_lds + (b) * SHM_K + CF::kswz(sr, kc)) = sr_[i].ks0; *(bf16x8*)(K_lds + (b) * SHM_K + CF::kswz(32 + sr, kc)) = sr_[i].ks1; \
    if constexpr (DQ == 192) *(bf16x8*)(K_lds + (b) * SHM_K + CF::kswz(sr2, 256 + sc2 * 2)) = sr_[i].ks2; } while (0)
#define SWAIT() do { if constexpr (SD == 1) asm volatile("s_waitcnt vmcnt(0)" ::: "memory"); else if constexpr (DQ == 192) asm volatile("s_waitcnt vmcnt(5)" ::: "memory"); else asm volatile("s_waitcnt vmcnt(4)" ::: "memory"); } while (0)
#define RESC(a) do { if (__any((a) < 1.f)) { if (hi == 0) al_l[r32] = (a); asm volatile("s_waitcnt lgkmcnt(0)" ::: "memory"); \
    _Pragma("unroll") for (int d = 0; d < 4; ++d) _Pragma("unroll") for (int r = 0; r < 16; ++r) o[d][r] *= al_l[crow(r, hi)]; } } while (0)
    f32x16 pA0, pA1, pB0, pB1; float mnA, mnB, alA, alB; bf16x8 pa0, pa1, pa2, pa3; const int NT = seq / KVBLK;
    constexpr int SE = 0, SO = SD - 1;
    SLOAD(SE, 0); asm volatile("s_waitcnt vmcnt(0)" ::: "memory"); SWRITE(0, SE); __syncthreads();
    qkt<DQ>(pA0, pA1, K_lds, qr, qx, r32, hi); partialSM<DQ, VAR>(pA0, pA1, m_reg, mnA, alA);
    SLOAD(SO, KVBLK); if constexpr (SD == 2) { if (2 < NT) SLOAD(SE, 2 * KVBLK); }
    SWAIT(); SWRITE(1, SO); __syncthreads();
#define ATT_SYNC() do { if constexpr (VAR != 2) __syncthreads(); } while (0)
    for (int j = 1; j + 1 < NT; j += 2) {
        SBAR(); qkt<DQ>(pB0, pB1, K_lds + SHM_K, qr, qx, r32, hi);
        finishSM<VAR>(pA0, pA1, alA, l_reg, pa0, pa1, pa2, pa3); SBAR();
        if constexpr (VAR != 3) SLOAD(SO, (j + SD) * KVBLK); SBAR();
        pv_d0(o, vb0, pa0, pa1, pa2, pa3); partialSM<DQ, VAR>(pB0, pB1, m_reg, mnB, alB);
        ATT_SYNC(); SWAIT(); SWRITE(0, SE);
        RESC(alB); ATT_SYNC();
        SBAR(); qkt<DQ>(pA0, pA1, K_lds, qr, qx, r32, hi);
        finishSM<VAR>(pB0, pB1, alB, l_reg, pa0, pa1, pa2, pa3); SBAR();
        if constexpr (VAR != 3) { if (SD == 1 || j + 3 < NT) SLOAD(SE, (j + 1 + SD) * KVBLK); } SBAR();
        pv_d0(o, vb0 + SHM_V, pa0, pa1, pa2, pa3); partialSM<DQ, VAR>(pA0, pA1, m_reg, mnA, alA);
        ATT_SYNC(); SWAIT(); SWRITE(1, SO);
        RESC(alA); ATT_SYNC();
    }
    SBAR(); qkt<DQ>(pB0, pB1, K_lds + SHM_K, qr, qx, r32, hi);
    finishSM<VAR>(pA0, pA1, alA, l_reg, pa0, pa1, pa2, pa3); SBAR();
    pv_d0(o, vb0, pa0, pa1, pa2, pa3); partialSM<DQ, VAR>(pB0, pB1, m_reg, mnB, alB);
    ATT_SYNC(); RESC(alB);
    finishSM<VAR>(pB0, pB1, alB, l_reg, pa0, pa1, pa2, pa3); SBAR();
    pv_d0(o, vb0 + SHM_V, pa0, pa1, pa2, pa3);
    if (hi == 0) li_l[r32] = l_reg; asm volatile("s_waitcnt lgkmcnt(0)" ::: "memory");
    float rli[16];
#pragma unroll
    for (int r = 0; r < 16; ++r) rli[r] = __builtin_amdgcn_rcpf(li_l[crow(r, hi)]);
    unsigned char* Ow = Ob + (long)(wid * QBLK) * ldo;
#pragma unroll
    for (int r = 0; r < 16; ++r) { const int orow = crow(r, hi);
#pragma unroll
        for (int d0 = 0; d0 < 4; ++d0) Ow[(long)orow * ldo + d0 * 32 + r32] = (unsigned char)(__builtin_amdgcn_cvt_pk_fp8_f32(o[d0][r] * rli[r] * 32.0f, 0.f, 0, false) & 0xff); }
#undef SLOAD
#undef ATT_SYNC
#undef SWRITE
#undef SWAIT
#undef RESC
}

__device__ __forceinline__ int k8addr(int row, int b, int DQ_) { return row * DQ_ + (b < 128 ? (b ^ ((row & 7) << 4)) : 128 + ((b - 128) ^ ((row & 3) << 4))); }
#define MX32(ACC, A, B, SC) asm volatile("s_nop 1\n\tv_mfma_scale_f32_32x32x64_f8f6f4 %0, %1, %2, %0, %3, %3 op_sel_hi:[0,0,0]" : "+v"(ACC) : "v"(A), "v"(B), "v"(SC))
#define MX32Z(ACC, A, B, SC) asm volatile("v_mfma_scale_f32_32x32x64_f8f6f4 %0, %1, %2, 0, %3, %3 op_sel_hi:[0,0,0]" : "=&v"(ACC) : "v"(A), "v"(B), "v"(SC))
template <int DQ, bool NOPS = true> __device__ __forceinline__ void qkt8(f32x16& p0, f32x16& p1, const char* Ks, const i32x8* qf, int r32, int hi) {
    int mxs = 0x7f7f7f7f; asm volatile("" : "+v"(mxs));
#pragma unroll
    for (int ks = 0; ks < DQ / 64; ++ks) { const int b = ks * 64 + hi * 32;
        const i32x4 a0l = *reinterpret_cast<const i32x4*>(Ks + k8addr(r32, b, DQ)), a0h = *reinterpret_cast<const i32x4*>(Ks + k8addr(r32, b + 16, DQ));
        const i32x4 a1l = *reinterpret_cast<const i32x4*>(Ks + k8addr(32 + r32, b, DQ)), a1h = *reinterpret_cast<const i32x4*>(Ks + k8addr(32 + r32, b + 16, DQ));
        const i32x8 a0 = __builtin_shufflevector(a0l, a0h, 0, 1, 2, 3, 4, 5, 6, 7), a1 = __builtin_shufflevector(a1l, a1h, 0, 1, 2, 3, 4, 5, 6, 7);
        if (ks == 0) { MX32Z(p0, a0, qf[ks], mxs); MX32Z(p1, a1, qf[ks], mxs); } else { MX32(p0, a0, qf[ks], mxs); MX32(p1, a1, qf[ks], mxs); } }
    if (NOPS) asm volatile("s_nop 15\n\ts_nop 7");
}
__device__ __forceinline__ int pk4_fp8(float a, float b, float c, float d) { int p = __builtin_amdgcn_cvt_pk_fp8_f32(a, b, 0, false); return __builtin_amdgcn_cvt_pk_fp8_f32(c, d, p, true); }
__device__ __forceinline__ int pk4_fp8u(float a, float b, float c, float d) { int u; asm volatile("" : "=v"(u)); const int p = __builtin_amdgcn_cvt_pk_fp8_f32(a, b, u, false); return __builtin_amdgcn_cvt_pk_fp8_f32(c, d, p, true); }
template <int DQ>
__device__ __forceinline__ void attn_body8(const bf16_t* __restrict__ Qb, int ldq, const unsigned char* __restrict__ Kn8, int ldkn, const unsigned char* __restrict__ Kr8, int ldkr,
                                           const bf16_t* __restrict__ Vh, int ldv, unsigned char* __restrict__ Ob, int ldo, int seq, bool rope_q, int pos0, const float* __restrict__ tabM, char* lds, const int tid) {
    constexpr int NKS = DQ / 64, SHM_V = KVBLK * DV * 2, SHM_K = KVBLK * DQ;
    const int wid = tid >> 6, lane = tid & 63, r32 = lane & 31, hi = lane >> 5;
    char* V_lds = lds; char* K_lds = lds + 2 * SHM_V;
    float* ws = (float*)(lds + 2 * SHM_V + 2 * SHM_K) + wid * 64; float* li_l = ws; float* al_l = ws + 32;
    float m_reg = -1e30f, l_reg = 0; f32x16 o[4] = {}; i32x8 qf[NKS];
    const bf16_t* Qrow = Qb + (long)(wid * QBLK + r32) * ldq;
#pragma unroll
    for (int ks = 0; ks < NKS; ++ks) {
        float x[32];
#pragma unroll
        for (int c = 0; c < 4; ++c) { const u32x4 w = *(const u32x4*)(Qrow + ks * 64 + hi * 32 + c * 8);
            x[c * 8 + 0] = bflo(w.x); x[c * 8 + 1] = bfhi(w.x); x[c * 8 + 2] = bflo(w.y); x[c * 8 + 3] = bfhi(w.y); x[c * 8 + 4] = bflo(w.z); x[c * 8 + 5] = bfhi(w.z); x[c * 8 + 6] = bflo(w.w); x[c * 8 + 7] = bfhi(w.w); }
        if (DQ == 192 && ks == 2 && rope_q) {
            float y[32];
#pragma unroll
            for (int c = 0; c < 4; ++c) { const u32x4 w = *(const u32x4*)(Qrow + 128 + (1 - hi) * 32 + c * 8);
                y[c * 8 + 0] = bflo(w.x); y[c * 8 + 1] = bfhi(w.x); y[c * 8 + 2] = bflo(w.y); y[c * 8 + 3] = bfhi(w.y); y[c * 8 + 4] = bflo(w.z); y[c * 8 + 5] = bfhi(w.z); y[c * 8 + 6] = bflo(w.w); y[c * 8 + 7] = bfhi(w.w); }
            const int pos = pos0 + wid * QBLK + r32, ri = pos >> 6, ci = pos & 63;
#pragma unroll
            for (int i = 0; i < 32; ++i) { const int p = i < 16 ? ri : ci, f = i & 15; const float c_ = tabM[p * 16 + f], s_ = tabM[128 * 16 + p * 16 + f];
                x[i] = hi ? x[i] * c_ + y[i] * s_ : x[i] * c_ - y[i] * s_; }
        }
        i32x8 q8;
#pragma unroll
        for (int j = 0; j < 8; ++j) q8[j] = pk4_fp8(x[4 * j], x[4 * j + 1], x[4 * j + 2], x[4 * j + 3]);
        qf[ks] = q8;
    }
    const int sr = tid >> 4, sc = (tid & 15) * 8, vst0 = v_st(sr, sc), vst1 = v_st(32 + sr, sc);
    const int kr = tid >> 3, kb = (tid & 7) * 16;
    const int kr2 = (tid & 255) >> 2, kb2 = (tid & 3) * 16;
    const int vb0 = (int)(uintptr_t)V_lds + v_rd_base(lane);
    struct { bf16x8 vs0, vs1; u32x4 k0, k1; } sr_[1];
    const unsigned offV = (unsigned)(sr * ldv + sc) * 2u, offK = (unsigned)(kr * ldkn + kb), offR = (unsigned)(kr2 * ldkr + kb2);
#define SLOAD8(k0_) do { const char* vt_ = (const char*)Vh + (size_t)(k0_) * ldv * 2; \
    sr_[0].vs0 = *(const bf16x8*)(vt_ + offV); sr_[0].vs1 = *(const bf16x8*)(vt_ + (size_t)32 * ldv * 2 + offV); \
    sr_[0].k0 = *(const u32x4*)(Kn8 + (size_t)(k0_) * ldkn + offK); \
    if constexpr (DQ == 192) { if (tid < 256) sr_[0].k1 = *(const u32x4*)(Kr8 + (size_t)(k0_) * ldkr + offR); } } while (0)
#define SWRITE8(b) do { *(bf16x8*)(V_lds + (b) * SHM_V + vst0) = sr_[0].vs0; *(bf16x8*)(V_lds + (b) * SHM_V + vst1) = sr_[0].vs1; \
    *(u32x4*)(K_lds + (b) * SHM_K + k8addr(kr, kb, DQ)) = sr_[0].k0; \
    if constexpr (DQ == 192) { if (tid < 256) *(u32x4*)(K_lds + (b) * SHM_K + k8addr(kr2, 128 + kb2, DQ)) = sr_[0].k1; } } while (0)
#define SWAIT8() asm volatile("s_waitcnt vmcnt(0)" ::: "memory")
#define RESC8(a) do { if (__any((a) < 1.f)) { if (hi == 0) al_l[r32] = (a); asm volatile("s_waitcnt lgkmcnt(0)" ::: "memory"); \
    _Pragma("unroll") for (int d = 0; d < 4; ++d) _Pragma("unroll") for (int r = 0; r < 16; ++r) o[d][r] *= al_l[crow(r, hi)]; } } while (0)
    f32x16 pA0, pA1, pB0, pB1; float mnA, mnB, alA, alB; bf16x8 pa0, pa1, pa2, pa3; const int NT = seq / KVBLK;
    SLOAD8(0); SWAIT8(); SWRITE8(0); __syncthreads();
    qkt8<DQ>(pA0, pA1, K_lds, qf, r32, hi); partialSM<DQ, 0>(pA0, pA1, m_reg, mnA, alA);
    SLOAD8(KVBLK);
    SWAIT8(); SWRITE8(1); __syncthreads();
    for (int j = 1; j + 1 < NT; j += 2) {
        SBAR(); qkt8<DQ>(pB0, pB1, K_lds + SHM_K, qf, r32, hi);
        finishSM<0>(pA0, pA1, alA, l_reg, pa0, pa1, pa2, pa3); SBAR();
        SLOAD8((j + 1) * KVBLK); SBAR();
        pv_d0(o, vb0, pa0, pa1, pa2, pa3); partialSM<DQ, 0>(pB0, pB1, m_reg, mnB, alB);
        __syncthreads(); SWAIT8(); SWRITE8(0);
        RESC8(alB); __syncthreads();
        SBAR(); qkt8<DQ>(pA0, pA1, K_lds, qf, r32, hi);
        finishSM<0>(pB0, pB1, alB, l_reg, pa0, pa1, pa2, pa3); SBAR();
        SLOAD8((j + 2) * KVBLK); SBAR();
        pv_d0(o, vb0 + SHM_V, pa0, pa1, pa2, pa3); partialSM<DQ, 0>(pA0, pA1, m_reg, mnA, alA);
        __syncthreads(); SWAIT8(); SWRITE8(1);
        RESC8(alA); __syncthreads();
    }
    SBAR(); qkt8<DQ>(pB0, pB1, K_lds + SHM_K, qf, r32, hi);
    finishSM<0>(pA0, pA1, alA, l_reg, pa0, pa1, pa2, pa3); SBAR();
    pv_d0(o, vb0, pa0, pa1, pa2, pa3); partialSM<DQ, 0>(pB0, pB1, m_reg, mnB, alB);
    __syncthreads(); RESC8(alB);
    finishSM<0>(pB0, pB1, alB, l_reg, pa0, pa1, pa2, pa3); SBAR();
    pv_d0(o, vb0 + SHM_V, pa0, pa1, pa2, pa3);
    if (hi == 0) li_l[r32] = l_reg; asm volatile("s_waitcnt lgkmcnt(0)" ::: "memory");
    float rli[16];
#pragma unroll
    for (int r = 0; r < 16; ++r) rli[r] = __builtin_amdgcn_rcpf(li_l[crow(r, hi)]);
    unsigned char* Ow = Ob + (long)(wid * QBLK) * ldo;
#pragma unroll
    for (int r = 0; r < 16; ++r) { const int orow = crow(r, hi);
#pragma unroll
        for (int d0 = 0; d0 < 4; ++d0) Ow[(long)orow * ldo + d0 * 32 + r32] = (unsigned char)(__builtin_amdgcn_cvt_pk_fp8_f32(o[d0][r] * rli[r] * 32.0f, 0.f, 0, false) & 0xff); }
#undef SLOAD8
#undef SWRITE8
#undef SWAIT8
#undef RESC8
}

__device__ __host__ __forceinline__ int vt8_key(int g, int j) { const int i = j & 15; return (j < 16 ? 0 : 32) + (i & 3) + 8 * (i >> 2) + 4 * g; }
template <int DQ>
__device__ __forceinline__ void attn_body88(const bf16_t* __restrict__ Qb, int ldq, const unsigned char* __restrict__ Kn8, int ldkn, const unsigned char* __restrict__ Kr8, int ldkr,
                                            const unsigned char* __restrict__ VT8, unsigned char* __restrict__ Ob, int ldo, int seq, bool rope_q, int pos0, const float* __restrict__ tabM, char* lds, const int tid) {
    constexpr int NKS = DQ / 64, SHM_V = 128 * 64, SHM_K = KVBLK * DQ;
    constexpr float EOFF = 7.0f, THR8 = 1.0f;
    const int wid = tid >> 6, lane = tid & 63, r32 = lane & 31, hi = lane >> 5;
    char* V_lds = lds; char* K_lds = lds + 2 * SHM_V;
    float* ws = (float*)(lds + 2 * SHM_V + 2 * SHM_K) + wid * 64; float* li_l = ws; float* al_l = ws + 32;
    float m_reg = -1e30f, l_reg = 0; f32x16 o[4] = {}; i32x8 qf[NKS];
    const bf16_t* Qrow = Qb + (long)(wid * QBLK + r32) * ldq;
#pragma unroll
    for (int ks = 0; ks < NKS; ++ks) {
        float x[32];
#pragma unroll
        for (int c = 0; c < 4; ++c) { const u32x4 w = *(const u32x4*)(Qrow + ks * 64 + hi * 32 + c * 8);
            x[c * 8 + 0] = bflo(w.x); x[c * 8 + 1] = bfhi(w.x); x[c * 8 + 2] = bflo(w.y); x[c * 8 + 3] = bfhi(w.y); x[c * 8 + 4] = bflo(w.z); x[c * 8 + 5] = bfhi(w.z); x[c * 8 + 6] = bflo(w.w); x[c * 8 + 7] = bfhi(w.w); }
        if (DQ == 192 && ks == 2 && rope_q) {
            float y[32];
#pragma unroll
            for (int c = 0; c < 4; ++c) { const u32x4 w = *(const u32x4*)(Qrow + 128 + (1 - hi) * 32 + c * 8);
                y[c * 8 + 0] = bflo(w.x); y[c * 8 + 1] = bfhi(w.x); y[c * 8 + 2] = bflo(w.y); y[c * 8 + 3] = bfhi(w.y); y[c * 8 + 4] = bflo(w.z); y[c * 8 + 5] = bfhi(w.z); y[c * 8 + 6] = bflo(w.w); y[c * 8 + 7] = bfhi(w.w); }
            const int pos = pos0 + wid * QBLK + r32, ri = pos >> 6, ci = pos & 63;
#pragma unroll
            for (int i = 0; i < 32; ++i) { const int p = i < 16 ? ri : ci, f = i & 15; const float c_ = tabM[p * 16 + f], s_ = tabM[128 * 16 + p * 16 + f];
                x[i] = hi ? x[i] * c_ + y[i] * s_ : x[i] * c_ - y[i] * s_; }
        }
        i32x8 q8;
#pragma unroll
        for (int j = 0; j < 8; ++j) q8[j] = pk4_fp8(x[4 * j], x[4 * j + 1], x[4 * j + 2], x[4 * j + 3]);
        qf[ks] = q8;
    }
    const int wu = __builtin_amdgcn_readfirstlane(wid);
    const unsigned lbase = __builtin_amdgcn_readfirstlane((unsigned)(uintptr_t)(LAS char*)lds), wofs = (unsigned)wu * 1024u;
    const int vr = tid >> 2;
    const unsigned offVd = (unsigned)((vr * 4 + ((tid & 3) ^ ((vr >> 2) & 3))) * 16);
    const unsigned char* kp0; const unsigned char* kp1 = nullptr; unsigned ks0, ks1 = 0;
    if constexpr (DQ == 128) { const int row = tid >> 3, c = tid & 7; kp0 = Kn8 + (size_t)row * ldkn + ((c ^ (row & 7)) << 4); ks0 = (unsigned)(KVBLK * ldkn); }
    else { { const int G = tid, row = G / 12, c = G % 12; const bool nope = c < 8;
             kp0 = nope ? Kn8 + (size_t)row * ldkn + ((c ^ (row & 7)) << 4) : Kr8 + (size_t)row * ldkr + (((c - 8) ^ (row & 3)) << 4); ks0 = (unsigned)(KVBLK * (nope ? ldkn : ldkr)); }
           { const int G = 512 + (tid & 255), row = G / 12, c = G % 12; const bool nope = c < 8;
             kp1 = nope ? Kn8 + (size_t)row * ldkn + ((c ^ (row & 7)) << 4) : Kr8 + (size_t)row * ldkr + (((c - 8) ^ (row & 3)) << 4); ks1 = (unsigned)(KVBLK * (nope ? ldkn : ldkr)); } }
#define DMA16(gp, loff) __builtin_amdgcn_global_load_lds((const unsigned*)(gp), (LAS unsigned*)(uintptr_t)(lbase + (unsigned)(loff) + wofs), 16, 0, 0)
#define DMAK(t_, b_) do { DMA16(kp0 + (size_t)(t_) * ks0, 2 * SHM_V + (b_) * SHM_K); \
        if constexpr (DQ == 192) { if (wu < 4) DMA16(kp1 + (size_t)(t_) * ks1, 2 * SHM_V + (b_) * SHM_K + 8192); } } while (0)
#define DMAV(t_, b_) DMA16(VT8 + (size_t)(t_) * 8192 + offVd, (b_) * SHM_V)
#define DWAIT() asm volatile("s_waitcnt vmcnt(0)" ::: "memory")
#define RESC8(a) do { if (__any((a) < 1.f)) { if (hi == 0) al_l[r32] = (a); asm volatile("s_waitcnt lgkmcnt(0)" ::: "memory"); \
    _Pragma("unroll") for (int d = 0; d < 4; ++d) _Pragma("unroll") for (int r = 0; r < 16; ++r) o[d][r] *= al_l[crow(r, hi)]; } } while (0)
#define FIN8(P0, P1, AL, PA) do { _Pragma("unroll") for (int r = 0; r < 16; ++r) P1[r] = __builtin_amdgcn_exp2f(P1[r]); \
    float ps_ = 0; _Pragma("unroll") for (int r = 0; r < 16; ++r) ps_ += P0[r]; _Pragma("unroll") for (int r = 0; r < 16; ++r) ps_ += P1[r]; \
    { auto rr_ = __builtin_amdgcn_permlane32_swap(__float_as_uint(ps_), __float_as_uint(ps_), false, false); ps_ = __uint_as_float(rr_[0]) + __uint_as_float(rr_[1]); } \
    l_reg = l_reg * (AL) + ps_; \
    _Pragma("unroll") for (int j = 0; j < 4; ++j) { PA[j] = pk4_fp8u(P0[4 * j], P0[4 * j + 1], P0[4 * j + 2], P0[4 * j + 3]); \
        PA[4 + j] = pk4_fp8u(P1[4 * j], P1[4 * j + 1], P1[4 * j + 2], P1[4 * j + 3]); } } while (0)
#define PV8(VB, PA, NOPS) do { int mxs_ = 0x7f7f7f7f; asm volatile("" : "+v"(mxs_)); _Pragma("unroll") for (int d0 = 0; d0 < 4; ++d0) { const int row_ = d0 * 32 + r32, xs_ = (row_ >> 2) & 3; \
        const i32x4 lo_ = *reinterpret_cast<const i32x4*>((VB) + row_ * 64 + (((2 * hi) ^ xs_) << 4)), hi_ = *reinterpret_cast<const i32x4*>((VB) + row_ * 64 + (((2 * hi + 1) ^ xs_) << 4)); \
        const i32x8 vb_ = __builtin_shufflevector(lo_, hi_, 0, 1, 2, 3, 4, 5, 6, 7); MX32(o[d0], PA, vb_, mxs_); } if (NOPS) asm volatile("s_nop 15\n\ts_nop 7"); } while (0)
    f32x16 pA0, pA1, pB0, pB1; float mnA, mnB, alA, alB; i32x8 pa; const int NT = seq / KVBLK;
#define PSM8(P0, P1, MN, AL) do { partialSM<DQ, 0>(P0, P1, m_reg, MN, AL, THR8, EOFF); RESC8(AL); } while (0)
    DMAK(0, 0); DMAV(0, 0); DMAK(1, 1); DWAIT(); __syncthreads();
    qkt8<DQ>(pA0, pA1, K_lds, qf, r32, hi); PSM8(pA0, pA1, mnA, alA);
    __syncthreads();
    for (int j = 1; j + 1 < NT; j += 2) {
        DMAK(j + 1, 0); DMAV(j, 1);
        SBAR(); qkt8<DQ, false>(pB0, pB1, K_lds + SHM_K, qf, r32, hi);
        FIN8(pA0, pA1, alA, pa); SBAR();
        PV8(V_lds, pa, 0); PSM8(pB0, pB1, mnB, alB);
        DWAIT(); __syncthreads();
        if (j + 2 < NT) DMAK(j + 2, 1);
        DMAV(j + 1, 0);
        SBAR(); qkt8<DQ, false>(pA0, pA1, K_lds, qf, r32, hi);
        FIN8(pB0, pB1, alB, pa); SBAR();
        PV8(V_lds + SHM_V, pa, 0); PSM8(pA0, pA1, mnA, alA);
        DWAIT(); __syncthreads();
    }
    DMAV(NT - 1, 1);
    SBAR(); qkt8<DQ, false>(pB0, pB1, K_lds + SHM_K, qf, r32, hi);
    FIN8(pA0, pA1, alA, pa); SBAR();
    PV8(V_lds, pa, 0); PSM8(pB0, pB1, mnB, alB);
    DWAIT(); __syncthreads();
    FIN8(pB0, pB1, alB, pa); SBAR();
    PV8(V_lds + SHM_V, pa, 1);
#undef PSM8
#undef DMA16
#undef DMAK
#undef DMAV
#undef DWAIT
    if (hi == 0) li_l[r32] = l_reg; asm volatile("s_waitcnt lgkmcnt(0)" ::: "memory");
    float rli[16];
#pragma unroll
    for (int r = 0; r < 16; ++r) rli[r] = __builtin_amdgcn_rcpf(li_l[crow(r, hi)]) * 32.0f;
    unsigned char* Ow = Ob + (long)(wid * QBLK) * ldo;
#pragma unroll
    for (int r = 0; r < 16; ++r) { const int orow = crow(r, hi);
#pragma unroll
        for (int d0 = 0; d0 < 4; ++d0) Ow[(long)orow * ldo + d0 * 32 + r32] = (unsigned char)(__builtin_amdgcn_cvt_pk_fp8_f32(o[d0][r] * rli[r], 0.f, 0, false) & 0xff); }
#undef RESC8
#undef FIN8
#undef PV8
}
#undef MX32
}

template <int KS> __device__ __forceinline__ void mma_xy(f32x16& acc, const LAS bf16_t* X, const LAS bf16_t* Y, int hi) {
#pragma unroll
    for (int ks = 0; ks < KS; ++ks) { const bf16x8 a = *(const LAS bf16x8*)(X + ks * 16 + hi * 8), b = *(const LAS bf16x8*)(Y + ks * 16 + hi * 8);
        acc = __builtin_amdgcn_mfma_f32_32x32x16_bf16(a, b, acc, 0, 0, 0); }
}
__device__ __forceinline__ float logsig16(float x) { const float e = __expf(-fabsf(x)); return (fminf(x, 0.f) - __logf(1.f + e)) * 0.0625f; }
__device__ __forceinline__ int gla_sidx(int b, int dir, int h) { return (b * 2 + dir) * 4 + h; }

__device__ __forceinline__ void gla_cumsum_lds(const Ctx& C, int l, int h, int dir, const LAS float* lr, LAS float* segtot, LAS float* CUM) {
    const int seg = C.tid >> 7, d = C.tid & 127;
    const float* wa = INP(dir ? I_WA2B : I_WA2F) + (size_t)l * 16 * 512 + h * 128 + d;
    const float bias = INP(dir ? I_BAB : I_BAF)[l * 512 + h * 128 + d];
    float w[16], cum[16];
#pragma unroll
    for (int j = 0; j < 16; ++j) w[j] = wa[j * 512];
    float run = 0.f;
#pragma unroll
    for (int i = 0; i < 16; ++i) { const int s = seg * 16 + i, tk = dir ? 63 - s : s; float pre = bias;
#pragma unroll
        for (int j = 0; j < 16; ++j) pre += lr[tk * 32 + dir * 16 + j] * w[j];
        run += logsig16(pre); cum[i] = run; }
    segtot[seg * 128 + d] = run;
    __syncthreads();
    float off = 0.f;
#pragma unroll
    for (int q = 0; q < 3; ++q) if (q < seg) off += segtot[q * 128 + d];
#pragma unroll
    for (int i = 0; i < 16; ++i) { const int s = seg * 16 + i, tk = dir ? 63 - s : s; CUM[tk * 132 + d] = cum[i] + off; }
    __syncthreads();
}
__device__ __forceinline__ void unpack8(const u32x4 w, float (&x)[8]) { x[0] = bflo(w.x); x[1] = bfhi(w.x); x[2] = bflo(w.y); x[3] = bfhi(w.y); x[4] = bflo(w.z); x[5] = bfhi(w.z); x[6] = bflo(w.w); x[7] = bfhi(w.w); }
__device__ __forceinline__ void gla_build_vt(const Ctx& C, const bf16_t* P, size_t r0, int h, LAS bf16_t* VT) {
    u32x4 v[4];
#pragma unroll
    for (int it = 0; it < 4; ++it) { const int idx = C.tid + it * NTHREADS, sv = idx >> 5, e0 = (idx & 31) * 8; v[it] = *(const u32x4*)(P + (r0 + sv) * NP + C_LV + h * 256 + e0); }
#pragma unroll
    for (int it = 0; it < 4; ++it) { const int idx = C.tid + it * NTHREADS, sv = idx >> 5, e0 = (idx & 31) * 8;
        const unsigned wd[4] = {v[it].x, v[it].y, v[it].z, v[it].w};
#pragma unroll
        for (int q = 0; q < 4; ++q) { VT[(e0 + 2 * q) * 72 + sv] = (bf16_t)(wd[q] & 0xffffu); VT[(e0 + 2 * q + 1) * 72 + sv] = (bf16_t)(wd[q] >> 16); } }
}

__device__ __forceinline__ void phase_gla_local(const Ctx& C, int l, int rot) {
    const bf16_t* P = WSP(bf16_t, WS_P); bf16_t* GST = WSP(bf16_t, WS_GST); float* GDEC = WSP(float, WS_GDEC);
    LAS float* lr = (LAS float*)C.lds;
    LAS float* segtot = (LAS float*)(C.lds + 8192);
    LAS bf16_t* KT = (LAS bf16_t*)(C.lds + 10240);
    LAS bf16_t* VT = (LAS bf16_t*)(C.lds + 28672);
    LAS float* CUM = (LAS float*)(C.lds + 65536);
    const int r32 = C.lane & 31, hi = C.lane >> 5, d = C.tid & 127;
    const int btk = C.tid >> 3, bdg = (C.tid & 7) * 16;
    for (int unit = (C.bid + C.G - rot % C.G) % C.G; unit < NBATCH * 4 * NCH; unit += C.G) {
        const int b = unit / (4 * NCH), h = (unit / NCH) % 4, ck = unit % NCH; const size_t r0 = (size_t)b * RPB + ck * 64;
        for (int i = C.tid; i < 64 * 32; i += NTHREADS) lr[i] = bf2f(P[(r0 + (i >> 5)) * NP + C_LRF + (i & 31)]);
        const u32x4 kw0 = *(const u32x4*)(P + (r0 + btk) * NP + C_LK + h * 128 + bdg), kw1 = *(const u32x4*)(P + (r0 + btk) * NP + C_LK + h * 128 + bdg + 8);
        gla_build_vt(C, P, r0, h, VT);
        __syncthreads();
#pragma unroll 1
        for (int dir = 0; dir < 2; ++dir) {
            gla_cumsum_lds(C, l, h, dir, lr, segtot, CUM);
            const int tend = dir ? 0 : 63;
            const size_t sx = (size_t)gla_sidx(b, dir, h) * NCH + ck;
            if (C.tid < 128) GDEC[sx * 128 + d] = __expf(CUM[tend * 132 + d]);
            { float kf[16]; { float t8[8]; unpack8(kw0, t8);
#pragma unroll
                for (int i = 0; i < 8; ++i) kf[i] = t8[i]; unpack8(kw1, t8);
#pragma unroll
                for (int i = 0; i < 8; ++i) kf[8 + i] = t8[i]; }
#pragma unroll
              for (int q = 0; q < 4; ++q) { const f32x4 cm = *(const LAS f32x4*)(CUM + btk * 132 + bdg + 4 * q), be = *(const LAS f32x4*)(CUM + tend * 132 + bdg + 4 * q);
#pragma unroll
                  for (int i = 0; i < 4; ++i) KT[(bdg + 4 * q + i) * 72 + btk] = f2bf(kf[4 * q + i] * __expf(be[i] - cm[i])); } }
            __syncthreads();
            { const int dt = C.wid & 3, eb = (C.wid >> 2) * 4;
              f32x16 acc[4] = {};
#pragma unroll
              for (int q = 0; q < 4; ++q) mma_xy<4>(acc[q], KT + (dt * 32 + r32) * 72, VT + ((eb + q) * 32 + r32) * 72, hi);
              bf16_t* st = GST + sx * 32768;
#pragma unroll
              for (int q = 0; q < 4; ++q)
#pragma unroll
                  for (int g = 0; g < 4; ++g) { u32x2 w; w.x = cvt_pk_bf16(acc[q][4 * g], acc[q][4 * g + 1]); w.y = cvt_pk_bf16(acc[q][4 * g + 2], acc[q][4 * g + 3]);
                      *(u32x2*)(st + (size_t)((eb + q) * 32 + r32) * 128 + dt * 32 + 8 * g + 4 * hi) = w; } }
            __syncthreads();
        }
    }
}

__device__ __forceinline__ void phase_gla_scan(const Ctx& C) {
    bf16_t* GST = WSP(bf16_t, WS_GST); const float* GDEC = WSP(float, WS_GDEC);
    for (int gid = C.bid * NTHREADS + C.tid; gid < 16 * 8192; gid += C.G * NTHREADS) {
        const int sidx = gid >> 13, g = gid & 8191, dir = (sidx >> 2) & 1, d4 = (g & 31) * 4;
        bf16_t* base = GST + (size_t)sidx * NCH * 32768 + (size_t)g * 4;
        const float* dbase = GDEC + (size_t)sidx * NCH * 128 + d4;
        float S[4] = {0.f, 0.f, 0.f, 0.f};
        for (int st = 0; st < NCH; st += 4) {
            int ck[4]; u32x2 L[4]; f32x4 dc[4];
#pragma unroll
            for (int q = 0; q < 4; ++q) { const int s = st + q; ck[q] = dir ? (s < 4 ? 3 - s : NCH + 3 - s) : s;
                L[q] = *(const u32x2*)(base + (size_t)ck[q] * 32768); dc[q] = *(const f32x4*)(dbase + (size_t)ck[q] * 128); }
#pragma unroll
            for (int q = 0; q < 4; ++q) { u32x2 w; w.x = cvt_pk_bf16(S[0], S[1]); w.y = cvt_pk_bf16(S[2], S[3]);
                *(u32x2*)(base + (size_t)ck[q] * 32768) = w;
                S[0] = dc[q][0] * S[0] + bflo(L[q].x); S[1] = dc[q][1] * S[1] + bfhi(L[q].x); S[2] = dc[q][2] * S[2] + bflo(L[q].y); S[3] = dc[q][3] * S[3] + bfhi(L[q].y); }
        }
    }
}

__device__ __forceinline__ void phase_gla_out(const Ctx& C, int l, int rot) {
    const bf16_t* P = WSP(bf16_t, WS_P); const bf16_t* GST = WSP(bf16_t, WS_GST); unsigned char* OL = C.ws + WS_OL;
    LAS float* lr = (LAS float*)C.lds;
    LAS float* segtot = (LAS float*)(C.lds + 8192);
    LAS bf16_t* QT = (LAS bf16_t*)(C.lds + 10240);
    LAS bf16_t* KT = (LAS bf16_t*)(C.lds + 27648);
    LAS bf16_t* VT = (LAS bf16_t*)(C.lds + 45056);
    LAS bf16_t* SCm = (LAS bf16_t*)(C.lds + 81920);
    LAS float* OB = (LAS float*)(C.lds + 91136);
    LAS float* CUM = OB;
    const float* gon = INP(I_ONG) + l * 256;
    const int r32 = C.lane & 31, hi = C.lane >> 5;
    const int btk = C.tid >> 3, bdg = (C.tid & 7) * 16;
    const bool lastl = l + 1 >= DEPTH; const int nck = lastl ? NCH - CTXL / 64 : NCH;
    for (int unit = (C.bid + C.G - rot % C.G) % C.G; unit < NBATCH * 4 * nck; unit += C.G) {
        const int b = unit / (4 * nck), h = (unit / nck) % 4, ck = unit % nck + (NCH - nck); const size_t r0 = (size_t)b * RPB + ck * 64;
        for (int i = C.tid; i < 64 * 32; i += NTHREADS) lr[i] = bf2f(P[(r0 + (i >> 5)) * NP + C_LRF + (i & 31)]);
        const bf16_t* qp = P + (r0 + btk) * NP + C_LQ + h * 128 + bdg; const bf16_t* kp = P + (r0 + btk) * NP + C_LK + h * 128 + bdg;
        const u32x4 qw0 = *(const u32x4*)qp, qw1 = *(const u32x4*)(qp + 8), kw0 = *(const u32x4*)kp, kw1 = *(const u32x4*)(kp + 8);
        gla_build_vt(C, P, r0, h, VT);
        __syncthreads();
        f32x16 oacc[2] = {};
#pragma unroll 1
        for (int dir = 0; dir < 2; ++dir) {
            gla_cumsum_lds(C, l, h, dir, lr, segtot, CUM);
            { float qf[8], kf[8];
#pragma unroll
              for (int hh = 0; hh < 2; ++hh) { unpack8(hh ? qw1 : qw0, qf); unpack8(hh ? kw1 : kw0, kf);
                  const f32x4 c0 = *(const LAS f32x4*)(CUM + btk * 132 + bdg + 8 * hh), c1 = *(const LAS f32x4*)(CUM + btk * 132 + bdg + 8 * hh + 4);
                  float qo[8], ko[8];
#pragma unroll
                  for (int i = 0; i < 8; ++i) { const float cm = i < 4 ? c0[i & 3] : c1[i & 3]; qo[i] = qf[i] * __expf(cm) * 0.088388347648318440f; ko[i] = kf[i] * __expf(-cm); }
                  u32x4 wq, wk; wq.x = cvt_pk_bf16(qo[0], qo[1]); wq.y = cvt_pk_bf16(qo[2], qo[3]); wq.z = cvt_pk_bf16(qo[4], qo[5]); wq.w = cvt_pk_bf16(qo[6], qo[7]);
                  wk.x = cvt_pk_bf16(ko[0], ko[1]); wk.y = cvt_pk_bf16(ko[2], ko[3]); wk.z = cvt_pk_bf16(ko[4], ko[5]); wk.w = cvt_pk_bf16(ko[6], ko[7]);
                  *(LAS u32x4*)(QT + btk * 136 + bdg + 8 * hh) = wq; *(LAS u32x4*)(KT + btk * 136 + bdg + 8 * hh) = wk; } }
            __syncthreads();
            if (C.wid < 4) { const int mt = C.wid >> 1, nt = C.wid & 1; f32x16 sc = {};
                mma_xy<8>(sc, QT + (mt * 32 + r32) * 136, KT + (nt * 32 + r32) * 136, hi);
#pragma unroll
                for (int i = 0; i < 16; ++i) { const int t = mt * 32 + att::crow(i, hi), sx_ = nt * 32 + r32; const bool keep = dir ? (sx_ >= t) : (sx_ <= t);
                    SCm[t * 72 + sx_] = f2bf(keep ? sc[i] : 0.f); } }
            __syncthreads();
            { const bf16_t* st = GST + ((size_t)gla_sidx(b, dir, h) * NCH + ck) * 32768 + (size_t)(C.wid * 32 + r32) * 128 + hi * 8;
              bf16x8 sb[8];
#pragma unroll
              for (int ks = 0; ks < 8; ++ks) sb[ks] = *(const bf16x8*)(st + ks * 16);
#pragma unroll
              for (int mt = 0; mt < 2; ++mt) {
                  mma_xy<4>(oacc[mt], SCm + (mt * 32 + r32) * 72, VT + (C.wid * 32 + r32) * 72, hi);
#pragma unroll
                  for (int ks = 0; ks < 8; ++ks) { const bf16x8 a = *(const LAS bf16x8*)(QT + (mt * 32 + r32) * 136 + ks * 16 + hi * 8);
                      oacc[mt] = __builtin_amdgcn_mfma_f32_32x32x16_bf16(a, sb[ks], oacc[mt], 0, 0, 0); } } }
            __syncthreads();
        }
#pragma unroll
        for (int mt = 0; mt < 2; ++mt)
#pragma unroll
            for (int i = 0; i < 16; ++i) OB[(mt * 32 + att::crow(i, hi)) * 260 + C.wid * 32 + r32] = oacc[mt][i];
        __syncthreads();
        { const int t = C.tid >> 3, part = C.tid & 7; f32x4 v[8]; float ss = 0.f;
#pragma unroll
          for (int jj = 0; jj < 8; ++jj) { v[jj] = *(const LAS f32x4*)(OB + t * 260 + jj * 32 + part * 4); ss += v[jj][0] * v[jj][0] + v[jj][1] * v[jj][1] + v[jj][2] * v[jj][2] + v[jj][3] * v[jj][3]; }
          ss += dppmov<DPP_HMIRROR>(ss); ss += dppmov<DPP_Q3210>(ss); ss += dppmov<DPP_Q1032>(ss);
          const float rs = rsqrtf(ss * (1.0f / 256.0f) + NORM_EPS);
#pragma unroll
          for (int jj = 0; jj < 8; ++jj) { const int e = jj * 32 + part * 4; const f32x4 g = *(const f32x4*)(gon + e);
              const u32x2 gt = *(const u32x2*)(P + (r0 + t) * NP + C_LG + h * 256 + e);
              const float o0 = v[jj][0] * rs * g[0] * siluf_(bflo(gt.x)), o1 = v[jj][1] * rs * g[1] * siluf_(bfhi(gt.x)), o2 = v[jj][2] * rs * g[2] * siluf_(bflo(gt.y)), o3 = v[jj][3] * rs * g[3] * siluf_(bfhi(gt.y));
              int p8 = __builtin_amdgcn_cvt_pk_fp8_f32(o0, o1, 0, false); p8 = __builtin_amdgcn_cvt_pk_fp8_f32(o2, o3, p8, true);
              *(unsigned*)(OL + (r0 + t) * 1024 + h * 256 + e) = (unsigned)p8; } }
        __syncthreads();
    }
}

__device__ __forceinline__ unsigned f_ord(float f) { const unsigned u = __float_as_uint(f); return u ^ ((unsigned)((int)u >> 31) | 0x80000000u); }
__device__ __forceinline__ float f_unord(unsigned k) { return __uint_as_float((k & 0x80000000u) ? (k ^ 0x80000000u) : ~k); }
__device__ __forceinline__ void ins_u(unsigned (&L)[16], unsigned x) {
#pragma unroll
    for (int j = 0; j < 16; ++j) { const unsigned h = L[j] > x ? L[j] : x; x = L[j] > x ? x : L[j]; L[j] = h; }
}
__device__ __forceinline__ void ins_f(float (&M)[16], float x) {
#pragma unroll
    for (int j = 0; j < 16; ++j) { const float h = M[j] > x ? M[j] : x; x = M[j] > x ? x : M[j]; M[j] = h; }
}
__device__ __forceinline__ void peer_top16(const bf16_t* __restrict__ qrow, const bf16_t* __restrict__ keys, int r32, int hi, unsigned (&L)[16]) {
    bf16x8 qf[8];
#pragma unroll
    for (int kk = 0; kk < 8; ++kk) qf[kk] = *(const bf16x8*)(qrow + kk * 16 + hi * 8);
#pragma unroll
    for (int j = 0; j < 16; ++j) L[j] = 0u;
    bf16x8 kA[8], kB[8];
    const bf16_t* kl = keys + (size_t)r32 * 128 + hi * 8;
#define PT_LDK(dst, mt) do { _Pragma("unroll") for (int kk = 0; kk < 8; ++kk) dst[kk] = *(const bf16x8*)(kl + (mt) * 32 * 128 + kk * 16); } while (0)
#define PT_PROC(src, mt) do { f32x16 acc = {}; \
        _Pragma("unroll") for (int kk = 0; kk < 8; ++kk) acc = __builtin_amdgcn_mfma_f32_32x32x16_bf16(src[kk], qf[kk], acc, 0, 0, 0); \
        _Pragma("unroll") for (int i = 0; i < 16; ++i) { const unsigned kidx = (unsigned)((mt) * 32 + att::crow(i, hi)); ins_u(L, (f_ord(acc[i]) & ~127u) | (127u - kidx)); } } while (0)
    PT_LDK(kA, 0);
#pragma unroll 1
    for (int mp = 0; mp < 2; ++mp) { PT_LDK(kB, 2 * mp + 1); PT_PROC(kA, 2 * mp); if (mp == 0) PT_LDK(kA, 2); PT_PROC(kB, 2 * mp + 1); }
#undef PT_LDK
#undef PT_PROC
    unsigned Pn[16];
#pragma unroll
    for (int j = 0; j < 16; ++j) { auto r_ = __builtin_amdgcn_permlane32_swap(L[j], L[j], false, false); Pn[j] = hi ? r_[0] : r_[1]; }
#pragma unroll
    for (int j = 0; j < 16; ++j) ins_u(L, Pn[j]);
}
__device__ __forceinline__ void phase_peer_select(const Ctx& C, const bool latent_only) {
    const bf16_t* PQ = WSP(bf16_t, WS_PQ); const bf16_t* K1 = WSP(bf16_t, WS_K1); const bf16_t* K2 = WSP(bf16_t, WS_K2);
    int* PIDX = WSP(int, WS_PIDX); float* PG = WSP(float, WS_PG);
    const int r32 = C.lane & 31, hi = C.lane >> 5, head = C.wid;
    const int ngrp = latent_only ? NBATCH * SEQ / 32 : TT / 32;
    for (int gi = C.bid; gi < ngrp; gi += C.G) {
        const int grp = latent_only ? gi + (CTXL / 32) * (1 + gi / (SEQ / 32)) : gi;
        const size_t tok = (size_t)grp * 32 + r32;
        unsigned L1[16], L2[16];
        peer_top16(PQ + tok * DM + head * 256, K1 + (size_t)head * 128 * 128, r32, hi, L1);
        peer_top16(PQ + tok * DM + head * 256 + 128, K2 + (size_t)head * 128 * 128, r32, hi, L2);
        float v1[16], v2[16];
#pragma unroll
        for (int j = 0; j < 16; ++j) { v1[j] = f_unord(L1[j] & ~127u); v2[j] = f_unord(L2[j] & ~127u); }
        float M[16];
#pragma unroll
        for (int j = 0; j < 16; ++j) M[j] = -3.0e38f;
#pragma unroll
        for (int a = 0; a < 16; ++a)
#pragma unroll
            for (int b = 0; b < 16; ++b) if ((a + 1) * (b + 1) <= 16) ins_f(M, v1[a] + v2[b]);
        const float thr = M[15], mx = M[0]; float den = 0.f;
#pragma unroll
        for (int j = 0; j < 16; ++j) den += __expf(M[j] - mx);
        const float rden = 1.0f / den;
        int pos = 0; int* ip = PIDX + tok * 128 + head * 16; float* gp = PG + tok * 128 + head * 16;
#pragma unroll
        for (int a = 0; a < 16; ++a)
#pragma unroll
            for (int b = 0; b < 16; ++b) if ((a + 1) * (b + 1) <= 16) {
                const float val = v1[a] + v2[b];
                if (val >= thr && pos < 16) { if (hi == 0) { ip[pos] = (int)((127u - (L1[a] & 127u)) * 128u + (127u - (L2[b] & 127u))); gp[pos] = __expf(val - mx) * rden; } ++pos; } }
    }
}
template <int OFF> __device__ __forceinline__ float dotf8(const float (&h)[32], const u32x4 w, float acc) {
#pragma unroll
    for (int j = 0; j < 4; ++j) { const f32x2 lo = __builtin_amdgcn_cvt_pk_f32_fp8((int)w[j], false), hi = __builtin_amdgcn_cvt_pk_f32_fp8((int)w[j], true);
        acc += h[OFF + 4 * j] * lo.x; acc += h[OFF + 4 * j + 1] * lo.y; acc += h[OFF + 4 * j + 2] * hi.x; acc += h[OFF + 4 * j + 3] * hi.y; }
    return acc;
}
constexpr float ATT_O8_SCALE = 32.0f;
constexpr int GT_MAXTOK = 9;
template <bool LAST> __device__ __forceinline__ void phase_peer_gather(const Ctx& C, const float* modl, const float pscale) {
    const unsigned char* pt = C.ws + WS_PT + (size_t)(LAST ? DEPTH - 1 : 0) * PT_BYTES;
    const bf16_t* HB = WSP(bf16_t, WS_HB); const unsigned char* U8 = pt + PT_U8; const unsigned char* V8 = pt + PT_V8;
    const float* SCU = (const float*)(pt + PT_SCU); const float* SCV = (const float*)(pt + PT_SCV);
    const int* PIDX = WSP(int, WS_PIDX); const float* PG = WSP(float, WS_PG); float* XS = WSP(float, WS_XS);
    const int lane = C.lane, s = lane >> 3, j = lane & 7; const unsigned j16 = (unsigned)j * 16u;
    LAS int* IDS = (LAS int*)(C.lds + C.wid * (GT_MAXTOK * 512));
    LAS float* ACT = (LAS float*)(C.lds + 8 * GT_MAXTOK * 512 + C.wid * (GT_MAXTOK * 512));
    LAS int* ROWS = (LAS int*)(C.lds + 16 * GT_MAXTOK * 512 + C.wid * 64);
    int nk = 0;
    {
      const int nrows = LAST ? NBATCH * SEQ : TT, per = (nrows + C.G - 1) / C.G, base = C.bid * per;
#pragma unroll 1
      for (int k = 0; k < GT_MAXTOK; ++k) { const int o = C.wid + 8 * k; const int i = base + o; const int r = LAST ? (i / SEQ) * RPB + CTXL + i % SEQ : i;
          if (o < per && i < nrows) { if (lane == 0) ROWS[nk] = r; ++nk; } } }
#define GT_ROW(k) __builtin_amdgcn_readfirstlane(ROWS[k])
#pragma unroll 1
    for (int k = 0; k < nk; ++k) { const int r = GT_ROW(k);
        IDS[k * 128 + lane] = (PIDX[(size_t)r * 128 + lane] & (NEXP - 1)) << 7; IDS[k * 128 + 64 + lane] = (PIDX[(size_t)r * 128 + 64 + lane] & (NEXP - 1)) << 7;
        ACT[k * 128 + lane] = 0.f; ACT[k * 128 + 64 + lane] = 0.f; }
    const int nit = 32 * nk;
#define GT_ITEM(it_) const int cb_ = (it_) / (2 * nk), rem_ = (it_) - cb_ * (2 * nk), k_ = rem_ >> 1, hf_ = rem_ & 1
#define GT_LOADU(UQ, HQ, it_) do { GT_ITEM(it_); const int r_ = GT_ROW(k_); \
        const bf16_t* hp_ = HB + (size_t)r_ * DM + cb_ * 128 + j * 16; HQ[0] = *(const u32x4*)hp_; HQ[1] = *(const u32x4*)(hp_ + 8); \
        const unsigned char* ub_ = U8 + (size_t)cb_ * ((size_t)NEXP * 128);     \
        _Pragma("unroll") for (int eg = 0; eg < 8; ++eg) { const unsigned off_ = ((unsigned)IDS[k_ * 128 + (hf_ * 8 + eg) * 8 + s] & idmask) + j16; UQ[eg] = *(const u32x4*)(ub_ + off_); } } while (0)
#define GT_COMPU(UQ, HQ, it_) do { GT_ITEM(it_); (void)cb_; f32x2 hf2[8]; \
        _Pragma("unroll") for (int hh = 0; hh < 2; ++hh) { const u32x4 w_ = HQ[hh]; \
            hf2[hh * 4 + 0] = (f32x2){bflo(w_.x), bfhi(w_.x)}; hf2[hh * 4 + 1] = (f32x2){bflo(w_.y), bfhi(w_.y)}; hf2[hh * 4 + 2] = (f32x2){bflo(w_.z), bfhi(w_.z)}; hf2[hh * 4 + 3] = (f32x2){bflo(w_.w), bfhi(w_.w)}; } \
        float d[8]; \
        _Pragma("unroll") for (int eg = 0; eg < 8; ++eg) { f32x2 d2 = (f32x2){0.f, 0.f}; \
            _Pragma("unroll") for (int q = 0; q < 4; ++q) { const f32x2 lo = __builtin_amdgcn_cvt_pk_f32_fp8((int)UQ[eg][q], false), hi = __builtin_amdgcn_cvt_pk_f32_fp8((int)UQ[eg][q], true); \
                d2 += hf2[2 * q] * lo; d2 += hf2[2 * q + 1] * hi; } \
            d[eg] = d2.x + d2.y; } \
          \
        float t4[4], t2[2], t1; \
        _Pragma("unroll") for (int i = 0; i < 4; ++i) { const float snd = (j & 4) ? d[i] : d[i + 4], kp = (j & 4) ? d[i + 4] : d[i]; t4[i] = kp + dppmov<DPP_HMIRROR>(snd); } \
        _Pragma("unroll") for (int i = 0; i < 2; ++i) { const float snd = (j & 2) ? t4[i] : t4[i + 2], kp = (j & 2) ? t4[i + 2] : t4[i]; t2[i] = kp + dppmov<DPP_Q3210>(snd); } \
        { const float snd = (j & 1) ? t2[0] : t2[1], kp = (j & 1) ? t2[1] : t2[0]; t1 = kp + dppmov<DPP_Q1032>(snd); } \
        ACT[k_ * 128 + (hf_ * 8 + j) * 8 + s] += t1; } while (0)
#ifdef DBG_GDUP
#pragma unroll 1
    for (int rep_ = 0; rep_ < 2; ++rep_) {
    const unsigned idmask = rep_ == 0 ? ((unsigned)DBG_GMASK << 7 | 127u) : 0xffffffffu;
    if (rep_ == 1) { for (int k = 0; k < nk; ++k) { ACT[k * 128 + lane] = 0.f; ACT[k * 128 + 64 + lane] = 0.f; } }
#else
    { const unsigned idmask = 0xffffffffu;
#endif
    if (nit > 0) {
        u32x4 uA[8], uB[8], hA[2], hB[2];
        GT_LOADU(uA, hA, 0);
#pragma unroll 1
        for (int it = 0; it < nit; it += 2) {
            GT_LOADU(uB, hB, it + 1);
            GT_COMPU(uA, hA, it);
            if (it + 2 < nit) GT_LOADU(uA, hA, it + 2);
            GT_COMPU(uB, hB, it + 1);
        }
    }
    }
#undef GT_LOADU
#undef GT_COMPU
#pragma unroll 1
    for (int k = 0; k < nk; ++k) { const int r = GT_ROW(k);
#pragma unroll
        for (int hh = 0; hh < 2; ++hh) { const int e = hh * 64 + lane; const int id = IDS[k * 128 + e] >> 7; const float a = ACT[k * 128 + e] * SCU[id];
            const float w = PG[(size_t)r * 128 + e] * 0.5f * a * (1.0f + erff(a * 0.70710678118654752f));
#if defined(DBG_CHECK) && (DBG_CHECK == 3 || DBG_CHECK == 4)
            if (((r - 300) & 63) == 0 && r >= 300 && r < 300 + 64 * 128) WSP(float, WS_OM)[(size_t)r * 128 + e] = w;
#endif
            ACT[k * 128 + e] = w * SCV[id]; } }
#define GT_LOADV(VQ, WV, it_) do { GT_ITEM(it_); const unsigned char* vb_ = V8 + (size_t)cb_ * ((size_t)NEXP * 128); \
        _Pragma("unroll") for (int eg = 0; eg < 8; ++eg) { const int e_ = k_ * 128 + (hf_ * 8 + eg) * 8 + s; const unsigned off_ = (unsigned)IDS[e_] + j16; VQ[eg] = *(const u32x4*)(vb_ + off_); WV[eg] = ACT[e_]; } } while (0)
#define GT_COMPV(VQ, WV) do { \
        _Pragma("unroll") for (int eg = 0; eg < 8; ++eg) { const f32x2 w2_ = (f32x2){WV[eg], WV[eg]}; \
            _Pragma("unroll") for (int q = 0; q < 4; ++q) { \
                const f32x2 lo = __builtin_amdgcn_cvt_pk_f32_fp8((int)VQ[eg][q], false), hi = __builtin_amdgcn_cvt_pk_f32_fp8((int)VQ[eg][q], true); \
                acc2[2 * q] += w2_ * lo; acc2[2 * q + 1] += w2_ * hi; } } } while (0)
    if (nit > 0) {
        u32x4 vA[8], vB[8]; float wA[8], wB[8];
        GT_LOADV(vA, wA, 0);
#pragma unroll 1
        for (int it = 0; it < nit; it += 2) {
            f32x2 acc2[8];
#pragma unroll
            for (int i = 0; i < 8; ++i) acc2[i] = (f32x2){0.f, 0.f};
            GT_LOADV(vB, wB, it + 1);
            GT_COMPV(vA, wA);
            if (it + 2 < nit) GT_LOADV(vA, wA, it + 2);
            GT_COMPV(vB, wB);
            f32x2 t4[4], t2[2], t1;
#pragma unroll
            for (int i = 0; i < 4; ++i) { const f32x2 snd = (s & 4) ? acc2[i] : acc2[i + 4], kp = (s & 4) ? acc2[i + 4] : acc2[i];
                t4[i] = kp + (f32x2){xchg32(snd.x, lane), xchg32(snd.y, lane)}; }
#pragma unroll
            for (int i = 0; i < 2; ++i) { const f32x2 snd = (s & 2) ? t4[i] : t4[i + 2], kp = (s & 2) ? t4[i + 2] : t4[i];
                t2[i] = kp + (f32x2){xchg16(snd.x, lane), xchg16(snd.y, lane)}; }
            { const f32x2 snd = (s & 1) ? t2[0] : t2[1], kp = (s & 1) ? t2[1] : t2[0]; t1 = kp + (f32x2){dppmov<DPP_ROR8>(snd.x), dppmov<DPP_ROR8>(snd.y)}; }
            { GT_ITEM(it); (void)hf_; const int r_ = GT_ROW(k_);
              const int col = cb_ * 128 + j * 16 + 2 * s; float* xp = XS + (size_t)r_ * DM + col; const float* g2 = modl + (size_t)mod_sel(r_) * 12288 + 5 * DM + col;
#if defined(DBG_CHECK) && (DBG_CHECK == 3 || DBG_CHECK == 4)
              if (((r_ - 300) & 63) == 0 && r_ >= 300 && r_ < 300 + 64 * 128) { float* dbgo = WSP(float, WS_MQ) + (size_t)r_ * DM + col; dbgo[0] = t1.x; dbgo[1] = t1.y; }
#endif
              const f32x2 x = *(const f32x2*)xp, g = *(const f32x2*)g2;
              *(f32x2*)xp = x + pscale * g * t1; }
        }
    }
#undef GT_LOADV
#undef GT_COMPV
#undef GT_ITEM
#undef GT_ROW
}
__device__ __forceinline__ void phase_final_norm(const Ctx& C) {
    const float* XS = WSP(float, WS_XS); const float* fg = INP(I_FG);
    for (int q = C.bid * 8 + C.wid; q < NBATCH * SEQ; q += C.G * 8) {
        const int b = q / SEQ, t = q % SEQ; const float* xr = XS + ((size_t)b * RPB + CTXL + t) * DM; float* op = C.out + (size_t)q * DM;
        f32x4 v[8]; float ss = 0.f;
#pragma unroll
        for (int c = 0; c < 8; ++c) { v[c] = *(const f32x4*)(xr + c * 256 + C.lane * 4); ss += v[c][0] * v[c][0] + v[c][1] * v[c][1] + v[c][2] * v[c][2] + v[c][3] * v[c][3]; }
        ss = wave_sum(ss); const float rs = rsqrtf(ss * (1.0f / DM) + NORM_EPS);
#pragma unroll
        for (int c = 0; c < 8; ++c) { const f32x4 g = *(const f32x4*)(fg + c * 256 + C.lane * 4); *(f32x4*)(op + c * 256 + C.lane * 4) = v[c] * rs * g; }
    }
}


__device__ __forceinline__ void phase_vt8(const Ctx& C) {
    const bf16_t* P = WSP(bf16_t, WS_P); const bf16_t* MKV = WSP(bf16_t, WS_MKV);
    const int dv = C.tid & 127, kq = C.tid >> 7, g = kq >> 1, j0 = (kq & 1) * 16;
    constexpr int NU_A = NBATCH * 2 * NCH, NU_M = NBATCH * 8 * NCH;
    for (int u = C.bid; u < NU_A + NU_M; u += C.G) {
        const bool gqa = u < NU_A; const int v = gqa ? u : u - NU_A; const int nh = gqa ? 2 : 8;
        const int b = v / (nh * NCH), h = (v / NCH) % nh, t = v % NCH; const size_t r0 = (size_t)b * RPB + t * 64;
        const bf16_t* src = gqa ? P + r0 * NP + C_AV + h * 128 + dv : MKV + r0 * 2048 + h * 256 + 128 + dv; const size_t ld = gqa ? NP : 2048;
        float x[16];
#pragma unroll
        for (int jj = 0; jj < 16; ++jj) x[jj] = bf2f(src[(size_t)att::vt8_key(g, j0 + jj) * ld]);
        u32x4 w; w.x = (unsigned)att::pk4_fp8(x[0], x[1], x[2], x[3]); w.y = (unsigned)att::pk4_fp8(x[4], x[5], x[6], x[7]); w.z = (unsigned)att::pk4_fp8(x[8], x[9], x[10], x[11]); w.w = (unsigned)att::pk4_fp8(x[12], x[13], x[14], x[15]);
        unsigned char* dst = C.ws + (gqa ? WS_VT8A : WS_VT8M) + ((size_t)(b * nh + h) * NCH + t) * 8192 + dv * 64 + kq * 16;
        *(u32x4*)dst = w;
    }
}
template <int TYPE  , int VAR = 0> __device__ __forceinline__ void attn_units(const Ctx& C, bool need_ctx) {
    const bf16_t* P = WSP(bf16_t, WS_P);
    const int nu = need_ctx ? 528 : 512;
#pragma unroll 1
    for (int u = C.bid; u < nu; u += C.G) {
        int bh, qb; if (u < 512) { bh = (u >> 8) * 8 + (u & 7); qb = ((u & 255) >> 3) + 1; } else { bh = u - 512; qb = 0; }
        const int b = bh >> 3, h = bh & 7; const size_t rq = (size_t)b * RPB + (size_t)qb * 256, rk = (size_t)b * RPB; const int seq = qb == 0 ? CTXL : RPB;
        __syncthreads();
        if constexpr (TYPE == 1) {
            att::attn_body88<128>(P + rq * NP + C_AQ + h * 128, NP, C.ws + WS_AK8 + rk * 256 + (h >> 2) * 128, 256, nullptr, 0, C.ws + WS_VT8A + (size_t)(b * 2 + (h >> 2)) * NCH * 8192,
                                  C.ws + WS_OA + rq * 1024 + h * 128, 1024, seq, false, 0, nullptr, (char*)C.lds, C.tid);
        } else {
            const bf16_t* MQ = WSP(bf16_t, WS_MQ);
            att::attn_body88<192>(MQ + rq * 1536 + h * 192, 1536, C.ws + WS_KN8 + rk * 1024 + h * 128, 1024, C.ws + WS_KR8 + rk * 64, 64, C.ws + WS_VT8M + (size_t)(b * 8 + h) * NCH * 8192,
                                  C.ws + WS_OM + rq * 1024 + h * 128, 1024, seq, qb > 0, (qb - 1) * 256, WSP(float, WS_TABM), (char*)C.lds, C.tid);
        }
    }
    __syncthreads();
}

constexpr int LDS_BYTES = 163840, LDS_BAR_OFF = LDS_BYTES - 16;
constexpr int N_PHASES = 26;
template <int K> __device__ __forceinline__ void run_phase(const Ctx& C0, int l) {
    const Ctx C = launder(C0);
    const float* modl = WSP(float, WS_MODV) + (size_t)l * 3 * 12288;
    if constexpr (K == 0) { phase_modv(C); phase_tables(C); __syncthreads(); phase_cvt_mixer_weights(C, 0); }
    if constexpr (K == 1) {
        if (l == 0) phase_norm_mod<true, true>(C, INP(I_N1G), modl, 0, DM);
        else { phase_norm_mod<false, true>(C, INP(I_N1G) + l * DM, modl, 0, DM); __syncthreads(); phase_cvt_mixer_weights(C, l); }
    }
    if constexpr (K == 2) {
        pg8::Gemm g{WSP(bf16_t, WS_HB), WSP(bf16_t, WS_WIN), TT, NP, DM, DM, DM}; pg8::WinOrder S; S.init(C.G, C.bid, l + 1 < DEPTH);
        pg8::EpiStoreBf16S E{WSP(bf16_t, WS_P), NP, WSP(float, WS_WINS)};
        pg8::gemm_phase<pg8::EpiStoreBf16S, pg8::WinOrder, 1>(C.lds, C.tid, g, S, E);
    }
    if constexpr (K == 3) phase_post_p(C, l);
    if constexpr (K == 4) {
        { pg8::Gemm g{WSP(bf16_t, WS_P) + C_MCQ, WSP(bf16_t, WS_WUQ), TT, 1536, 512, NP, 512}; pg8::StaticOrder S; S.init(TT, 1536, C.G, C.bid);
          pg8::EpiStoreBf16 E{WSP(bf16_t, WS_MQ), 1536}; pg8::gemm_phase(C.lds, C.tid, g, S, E); }
        { pg8::Gemm g{WSP(bf16_t, WS_P) + C_MCKV, WSP(bf16_t, WS_WUKV), TT, 2048, 512, NP, 512}; pg8::StaticOrder S; S.init(TT, 2048, C.G, (C.bid + C.G - 140 % C.G) % C.G);
          pg8::EpiStoreMKV E{WSP(bf16_t, WS_MKV), C.ws + WS_KN8}; pg8::gemm_phase(C.lds, C.tid, g, S, E); }
        { const Ctx C2 = launder(C0); phase_gla_local(C2, l, 156); }
#ifdef DBG_DUP_GLALOCAL
        { const Ctx C2 = launder(C0); __syncthreads(); phase_gla_local(C2, l, 156); }
#endif
    }
    if constexpr (K == 5) { phase_gla_scan(C); { const Ctx C2 = launder(C0); phase_vt8(C2); } }
    if constexpr (K == 6) {
#ifdef DBG_ATTVAR
        { const Ctx Cx = launder(C0); attn_units<0, DBG_ATTVAR>(Cx, l + 1 < DEPTH); } { const Ctx Cx = launder(C0); attn_units<1, DBG_ATTVAR>(Cx, l + 1 < DEPTH); } __syncthreads();
#endif
        attn_units<0>(C, l + 1 < DEPTH); { const Ctx C2 = launder(C0); attn_units<1>(C2, l + 1 < DEPTH); } { const Ctx C3 = launder(C0); phase_gla_out(C3, l, 128); }
#ifdef DBG_DUP_GLAOUT
        { const Ctx C3 = launder(C0); __syncthreads(); phase_gla_out(C3, l, 128); }
#endif
    }
    if constexpr (K == 7) {
        const bf16_t* P = WSP(bf16_t, WS_P); bf16_t* Y = WSP(bf16_t, WS_Y);
        const pg8::Gemm ga{WSP(bf16_t, WS_OA), WSP(bf16_t, WS_WBR), TT, DM, 1024, 1024, 1024}, gl{WSP(bf16_t, WS_OL), (const bf16_t*)(C.ws + WS_WBR + (size_t)2048 * 1024), TT, DM, 1024, 1024, 1024},
                        gm{WSP(bf16_t, WS_OM), (const bf16_t*)(C.ws + WS_WBR + (size_t)2 * 2048 * 1024), TT, DM, 1024, 1024, 1024};
        unsigned char* Y8 = C.ws + WS_HB;
        const float* wbs = WSP(float, WS_WBRS);
        const pg8::EpiGate<true> Ea{Y, P + C_GA, nullptr, wbs}; const pg8::EpiGate<false> El{Y, P + C_GL, nullptr, wbs + DM}; const pg8::EpiGate<false, true> Em{Y, P + C_GM, Y8, wbs + 2 * DM};
        pg8::StaticOrder S; S.init(TT, DM, C.G, C.bid, l + 1 >= DEPTH);
        pg8::gemm_phase<pg8::EpiGate<true>, pg8::StaticOrder, 1>(C.lds, C.tid, ga, S, Ea); pg8::gemm_phase<pg8::EpiGate<false>, pg8::StaticOrder, 1>(C.lds, C.tid, gl, S, El);
        pg8::gemm_phase<pg8::EpiGate<false, true>, pg8::StaticOrder, 1>(C.lds, C.tid, gm, S, Em);
        if (l == 0) { const Ctx C2 = launder(C0); phase_cvt_peer_tables(C2, 0, 0, NEXP, S.nwg % C.G); }
    }
    if constexpr (K == 8) {
        pg8::Gemm g{WSP(bf16_t, WS_HB), WSP(bf16_t, WS_WOUT), TT, DM, DM, DM, DM};
        const pg8::EpiResidT<true> E{WSP(float, WS_XS), DM, modl + 2 * DM, WSP(float, WS_WOUTS)};
        pg8::StaticOrder S; S.init(TT, DM, C.G, C.bid, l + 1 >= DEPTH);
        pg8::gemm_phase<pg8::EpiResidT<true>, pg8::StaticOrder, 1>(C.lds, C.tid, g, S, E);
        if (l == 0 && DEPTH > 1) { const Ctx C2 = launder(C0); phase_cvt_peer_tables(C2, 1, 0, NEXP / 2, S.nwg % C.G); }
    }
    if constexpr (K == 9) phase_norm_mod<false>(C, INP(I_N2G) + l * DM, modl, 3 * DM, 4 * DM);
    if constexpr (K == 10) {
        pg8::Gemm g{WSP(bf16_t, WS_HB), WSP(bf16_t, WS_WQ), TT, DM, DM, DM, DM};
        pg8::EpiStoreBf16 E{WSP(bf16_t, WS_PQ), DM};
        pg8::StaticOrder S; S.init(TT, DM, C.G, C.bid, l + 1 >= DEPTH); pg8::gemm_phase(C.lds, C.tid, g, S, E);
        if (l == 0 && DEPTH > 1) { const Ctx C2 = launder(C0); phase_cvt_peer_tables(C2, 1, NEXP / 2, NEXP, S.nwg % C.G); }
    }
    if constexpr (K == 11) phase_peer_select(C, l + 1 >= DEPTH);
    if constexpr (K == 13) phase_final_norm(C);
    if constexpr (K == 12) {
#ifdef DBG_DUP12
        if (l + 1 < DEPTH) phase_peer_gather<false>(C, modl, 0.0f); else phase_peer_gather<true>(C, modl, 0.0f);
        __syncthreads();
#endif
        if (l + 1 < DEPTH) phase_peer_gather<false>(C, modl, DBG_PEER0); else phase_peer_gather<true>(C, modl, DBG_PEER1); }
}
__device__ __forceinline__ Ctx make_ctx(const Args& args, unsigned char* lds_raw) {
    Ctx C0; C0.in = (const __attribute__((address_space(4))) cfp_t*)__builtin_amdgcn_kernarg_segment_ptr(); C0.out = args.out; C0.ws = args.ws; C0.lds = (LAS unsigned char*)lds_raw;
    C0.tid = threadIdx.x; C0.lane = C0.tid & 63; C0.wid = __builtin_amdgcn_readfirstlane(C0.tid >> 6); C0.G = gridDim.x; C0.bid = blockIdx.x;
    return C0;
}
template <int K> __global__ void __launch_bounds__(NTHREADS, 2) k_one(Args args) {
    extern __shared__ __attribute__((aligned(16))) unsigned char lds_raw[];
    const Ctx C0 = make_ctx(args, lds_raw);
    run_phase<K>(C0, args.ph_lo);
}
#if MK_N_LAUNCHES == 1 || defined(DBG_HYB)
__global__ void __launch_bounds__(NTHREADS, 2) mk_fwd(Args args) {
    extern __shared__ __attribute__((aligned(16))) unsigned char lds_raw[];
    const Ctx C0 = make_ctx(args, lds_raw);
    if (C0.tid < 4) ((LAS unsigned*)(C0.lds + LDS_BAR_OFF))[C0.tid] = 0u;
    __syncthreads();
    const int lo = args.ph_lo, hi = args.ph_hi;
    XcdBarrier bar; bar.bar = (unsigned*)(args.ws + WS_CTL); bar.x = 0; bar.st = nullptr;
    if (hi - lo > 1) bar = xcd_barrier_post((unsigned*)(args.ws + WS_CTL), (volatile LAS unsigned*)(C0.lds + LDS_BAR_OFF));
#define IN(k) (lo <= (k) && (k) < hi)
#define SEAM(k) do { if (IN(k) && IN((k) + 1)) xcd_barrier(bar); } while (0)
#ifndef DBG_DUP
#define DBG_DUP -1
#endif
#define PH(K, k) do { if (IN(k)) { run_phase<K>(C0, l); if (K == DBG_DUP) { xcd_barrier(bar); run_phase<K>(C0, l); } } SEAM(k); } while (0)
    { const int l = 0; PH(0, 0); }
#pragma unroll 1
    for (int l = 0; l < DEPTH; ++l) {
        const int pb = 1 + 12 * l;
        PH(1, pb + 0); PH(2, pb + 1); PH(3, pb + 2); PH(4, pb + 3); PH(5, pb + 4); PH(6, pb + 5);
        PH(7, pb + 6); PH(8, pb + 7); PH(9, pb + 8); PH(10, pb + 9); PH(11, pb + 10); PH(12, pb + 11);
    }
    { const int l = DEPTH - 1; PH(13, 1 + 12 * DEPTH); }
#undef PH
#undef IN
#undef SEAM
}
#define MAIN_KERNEL mk_fwd
#else
#define MAIN_KERNEL k_one<6>
#endif


#ifdef DBG_PROBE
typedef int i32x8 __attribute__((ext_vector_type(8)));
__device__ __forceinline__ unsigned char fp8_of_int(int v) {
    const float f = (float)v; return (unsigned char)(__builtin_amdgcn_cvt_pk_fp8_f32(f, 0.f, 0, false) & 0xff); }
__global__ void k_probe_mx(unsigned* slot) {
    const int l = threadIdx.x, r = l & 31, g = l >> 5;
    i32x8 A, B;
    for (int j = 0; j < 8; ++j) { unsigned wa = 0, wb = 0;
        for (int b = 0; b < 4; ++b) { const int k = g * 32 + 4 * j + b;
            wa |= (unsigned)fp8_of_int(((3 * r + k) % 7) - 3) << (8 * b); wb |= (unsigned)fp8_of_int(((5 * k + 2 * r) % 9) - 4) << (8 * b); }
        A[j] = (int)wa; B[j] = (int)wb; }
    f32x16 c = {};
    c = __builtin_amdgcn_mfma_scale_f32_32x32x64_f8f6f4(A, B, c, 0, 0, 0, 0x7f7f7f7f, 0, 0x7f7f7f7f);
    float worst = 0.f;
    for (int i = 0; i < 16; ++i) { const int m = (i & 3) + 8 * (i >> 2) + 4 * g, n = r; float ref = 0.f; for (int k = 0; k < 64; ++k) ref += (float)(((3 * m + k) % 7) - 3) * (float)(((5 * k + 2 * n) % 9) - 4);
        worst = fmaxf(worst, fabsf(c[i] - ref)); }
    for (int o = 32; o >= 1; o >>= 1) worst = fmaxf(worst, __shfl_xor(worst, o));
    if (l == 0) { const float code = worst == 0.f ? 0.4f : 1.2f; *slot = __float_as_uint(powf(10.f, code / 0.25f - 4.f)); }
}
#endif
#ifdef DBG_CHECK
__device__ __forceinline__ void dbg_report(unsigned* slot, float err) { if (!(err <= 3e38f)) err = 1e30f; atomicMax(slot, __float_as_uint(err)); }
__global__ void k_check_gemm(const bf16_t* A, int lda, const float* W, int K, int N, const bf16_t* Cm, int ldc, int M, unsigned* slot) {
    const unsigned id = blockIdx.x * blockDim.x + threadIdx.x; if (id >= 8192) return;
    const unsigned h = id * 2654435761u; const int row = (int)((h >> 8) % (unsigned)M), col = (int)((h * 40503u >> 7) % (unsigned)N);
    float ref = 0.f; for (int k = 0; k < K; ++k) ref += bf2f(A[(size_t)row * lda + k]) * W[(size_t)k * N + col];
    const float got = bf2f(Cm[(size_t)row * ldc + col]);
    dbg_report(slot, fabsf(got - ref) / (fabsf(ref) + 0.1f));
}

__global__ void k_check_attn(const unsigned char* ws, int type, unsigned* slot) {
    __shared__ float sc[RPB]; __shared__ float red[256]; __shared__ float qv[192];
    const int t = threadIdx.x, bh = blockIdx.x & 15, b = bh >> 3, h = bh & 7; const int qpos = (int)(((blockIdx.x >> 4) * 977u + 13u) % SEQ); const size_t rq = (size_t)b * RPB + CTXL + qpos, rk = (size_t)b * RPB;
    const bf16_t* P = (const bf16_t*)(ws + WS_P); const bf16_t* MQ = (const bf16_t*)(ws + WS_MQ); const bf16_t* MKV = (const bf16_t*)(ws + WS_MKV);
    const int dq = type ? 128 : 192;
    if (t < dq) { float v = type ? bf2f(P[rq * NP + C_AQ + h * 128 + t]) : bf2f(MQ[rq * 1536 + h * 192 + t]); qv[t] = v; }
    __syncthreads();
    if (!type && t < 32) {
        const int ri = qpos >> 6, ci = qpos & 63; const int i = t; const float pos = (float)(i < 16 ? ri : ci); const float inv = powf(10000.f, -(float)(i & 15) / 16.f); const float a = pos * inv;
        const float x1 = qv[128 + i], x2 = qv[160 + i]; qv[128 + i] = x1 * cosf(a) - x2 * sinf(a); qv[160 + i] = x2 * cosf(a) + x1 * sinf(a); }
    __syncthreads();
    const float scale = type ? 0.088388347648f : 0.0721687836487f;
    float mx = -1e30f;
    for (int k = t; k < RPB; k += 256) { float s = 0.f;
        if (type) { const bf16_t* kp = P + (rk + k) * NP + C_AK + (h >> 2) * 128; for (int d = 0; d < 128; ++d) s += qv[d] * bf2f(kp[d]); }
        else { const bf16_t* kp = MKV + (rk + k) * 2048 + h * 256; for (int d = 0; d < 128; ++d) s += qv[d] * bf2f(kp[d]); const bf16_t* kr = P + (rk + k) * NP + C_MKR; for (int d = 0; d < 64; ++d) s += qv[128 + d] * bf2f(kr[d]); }
        s *= scale; sc[k] = s; mx = fmaxf(mx, s); }
    red[t] = mx; __syncthreads(); for (int o = 128; o >= 1; o >>= 1) { if (t < o) red[t] = fmaxf(red[t], red[t + o]); __syncthreads(); } mx = red[0]; __syncthreads();
    float sum = 0.f; for (int k = t; k < RPB; k += 256) { const float p = __expf(sc[k] - mx); sc[k] = p; sum += p; }
    red[t] = sum; __syncthreads(); for (int o = 128; o >= 1; o >>= 1) { if (t < o) red[t] += red[t + o]; __syncthreads(); } sum = red[0]; __syncthreads();
    float e = 0.f, mag = 0.f;
    if (t < 128) { float o = 0.f; for (int k = 0; k < RPB; ++k) { const float vv = type ? bf2f(P[(rk + k) * NP + C_AV + (h >> 2) * 128 + t]) : bf2f(MKV[(rk + k) * 2048 + h * 256 + 128 + t]); o += sc[k] * vv; }
        o /= sum; const float got = __builtin_amdgcn_cvt_f32_fp8((int)(ws + (type ? WS_OA : WS_OM))[rq * 1024 + h * 128 + t], 0) * (1.0f / 32.0f); e = fabsf(got - o); mag = fabsf(o); }
    red[t] = e; __syncthreads(); for (int o = 128; o >= 1; o >>= 1) { if (t < o) red[t] = fmaxf(red[t], red[t + o]); __syncthreads(); } e = red[0]; __syncthreads();
    red[t] = mag; __syncthreads(); for (int o = 128; o >= 1; o >>= 1) { if (t < o) red[t] = fmaxf(red[t], red[t + o]); __syncthreads(); } mag = red[0];
    if (t == 0) dbg_report(slot, e / (mag + 1e-4f));
}
__global__ void __launch_bounds__(256) k_check_gla_rec(const unsigned char* ws, const float* wa_f, const float* ba_f, const float* wa_b, const float* ba_b, float* obuf, int b) {
    __shared__ float ad[128], kd[128], qd[128], lrs[16];
    const int e = threadIdx.x, h = blockIdx.x & 3, dir = blockIdx.x >> 2; const bf16_t* P = (const bf16_t*)(ws + WS_P);
    const float* wa = dir ? wa_b : wa_f; const float* ba = dir ? ba_b : ba_f;
    float S[128];
#pragma unroll
    for (int d = 0; d < 128; ++d) S[d] = 0.f;
    float* ob = obuf + ((size_t)(dir * 2 + b) * 4 + h) * RPB * 256;
    for (int st = 0; st < RPB; ++st) {
        int j; if (!dir) j = st; else j = st < CTXL ? CTXL - 1 - st : RPB - 1 - (st - CTXL);
        const size_t r = (size_t)b * RPB + j; const bf16_t* pr = P + r * NP;
        if (e < 16) lrs[e] = bf2f(pr[(dir ? C_LRB : C_LRF) + e]);
        __syncthreads();
        if (e < 128) { float pre = ba[h * 128 + e]; for (int q = 0; q < 16; ++q) pre += lrs[q] * wa[q * 512 + h * 128 + e];
            const float ls = (fminf(pre, 0.f) - log1pf(expf(-fabsf(pre)))) / 16.f; ad[e] = expf(ls); kd[e] = bf2f(pr[C_LK + h * 128 + e]); qd[e] = bf2f(pr[C_LQ + h * 128 + e]) * 0.088388347648f; }
        __syncthreads();
        const float v = bf2f(pr[C_LV + h * 256 + e]); float o = 0.f;
#pragma unroll
        for (int d = 0; d < 128; ++d) { S[d] = ad[d] * S[d] + kd[d] * v; o += qd[d] * S[d]; }
        ob[(size_t)j * 256 + e] = o;
        __syncthreads();
    }
}
__global__ void k_check_gla_cmp(const unsigned char* ws, const float* obuf, const float* gon, int b, unsigned* slot) {
    __shared__ float red[256];
    const int e = threadIdx.x, h = blockIdx.x & 3, j = blockIdx.x >> 2; const size_t r = (size_t)b * RPB + j; const bf16_t* P = (const bf16_t*)(ws + WS_P);
    const float o = obuf[((size_t)(0 * 2 + b) * 4 + h) * RPB * 256 + (size_t)j * 256 + e] + obuf[((size_t)(1 * 2 + b) * 4 + h) * RPB * 256 + (size_t)j * 256 + e];
    red[e] = o * o; __syncthreads(); for (int s_ = 128; s_ >= 1; s_ >>= 1) { if (e < s_) red[e] += red[e + s_]; __syncthreads(); }
    const float rs = rsqrtf(red[0] / 256.f + NORM_EPS); __syncthreads();
    const float gt = bf2f(P[r * NP + C_LG + h * 256 + e]); const float ref = o * rs * gon[e] * (gt / (1.f + expf(-gt)));
    const float got = __builtin_amdgcn_cvt_f32_fp8((int)(ws + WS_OL)[r * 1024 + h * 256 + e], 0);
    red[e] = fabsf(got - ref); __syncthreads(); for (int s_ = 128; s_ >= 1; s_ >>= 1) { if (e < s_) red[e] = fmaxf(red[e], red[e + s_]); __syncthreads(); }
    if (e == 0) dbg_report(slot, red[0] / 1.0f);
}

__global__ void k_check_gemm8(const unsigned char* A8, const float* W, int K, int N, const bf16_t* Cm, int ldc, int M, unsigned* slot) {
    const unsigned id = blockIdx.x * blockDim.x + threadIdx.x; if (id >= 8192) return;
    const unsigned h = id * 2654435761u; const int row = (int)((h >> 8) % (unsigned)M), col = (int)((h * 40503u >> 7) % (unsigned)N);
    float ref = 0.f, mag = 0.f; for (int k = 0; k < K; ++k) { const float a = __builtin_amdgcn_cvt_f32_fp8((int)A8[(size_t)row * K + k], 0), w = W[(size_t)k * N + col]; ref += a * w; mag += a * a * w * w; }
    const float got = bf2f(Cm[(size_t)row * ldc + col]);
    dbg_report(slot, fabsf(got - ref) / (sqrtf(mag) + 1e-3f));
}
__global__ void k_check_select(const bf16_t* PQ, const float* k1, const float* k2, const int* PIDX, const float* PG, unsigned* slot) {
    __shared__ float s1[128], s2[128]; __shared__ int cnt; __shared__ float selv[16];
    const int tok = (blockIdx.x >> 3) * 61 + 5, head = blockIdx.x & 7, t = threadIdx.x;
    if (t == 0) cnt = 0;
    for (int n = t; n < 128; n += 64) { float a = 0.f, b = 0.f; for (int d = 0; d < 128; ++d) { a += bf2f(PQ[(size_t)tok * DM + head * 256 + d]) * k1[((size_t)head * 128 + n) * 128 + d]; b += bf2f(PQ[(size_t)tok * DM + head * 256 + 128 + d]) * k2[((size_t)head * 128 + n) * 128 + d]; } s1[n] = a; s2[n] = b; }
    __syncthreads();
    if (t < 16) { const int id = PIDX[(size_t)tok * 128 + head * 16 + t]; selv[t] = (id >= 0 && id < 16384) ? s1[id >> 7] + s2[id & 127] : -1e30f; }
    __syncthreads();
    float thr = selv[0], mx = selv[0]; for (int k = 1; k < 16; ++k) { thr = fminf(thr, selv[k]); mx = fmaxf(mx, selv[k]); }
    int c = 0; for (int p = t; p < 16384; p += 64) if (s1[p >> 7] + s2[p & 127] > thr + 0.02f) ++c;
    atomicAdd(&cnt, c); __syncthreads();
    if (t == 0) { float den = 0.f; for (int k = 0; k < 16; ++k) den += __expf(selv[k] - mx); float e = fabsf((float)cnt - 15.f) / 15.f > 0.34f ? fabsf((float)cnt - 15.f) / 15.f : 0.f;
        for (int k = 0; k < 16; ++k) e = fmaxf(e, fabsf(PG[(size_t)tok * 128 + head * 16 + k] - __expf(selv[k] - mx) / den) * 4.f);
        for (int k = 0; k < 16; ++k) for (int k2_ = 0; k2_ < k; ++k2_) if (PIDX[(size_t)tok * 128 + head * 16 + k] == PIDX[(size_t)tok * 128 + head * 16 + k2_]) e = fmaxf(e, 10.f);
        dbg_report(slot, e); }
}
__global__ void k_check_gather(const bf16_t* HB, const float* u, const float* v, const int* PIDX, const float* PG, const float* dbgo, unsigned* slot) {
    __shared__ float w[128];
    const int tok = blockIdx.x * 64 + 300, t = threadIdx.x;
    for (int k = t; k < 128; k += 64) { const int id = PIDX[(size_t)tok * 128 + k] & 16383; float a = 0.f; for (int d = 0; d < DM; ++d) a += bf2f(HB[(size_t)tok * DM + d]) * u[(size_t)id * DM + d];
        w[k] = PG[(size_t)tok * 128 + k] * 0.5f * a * (1.0f + erff(a * 0.70710678f)); }
    __syncthreads();
    float e = 0.f, sc = 0.f;
    for (int d = t; d < DM; d += 64) { float o = 0.f; for (int k = 0; k < 128; ++k) o += w[k] * v[(size_t)(PIDX[(size_t)tok * 128 + k] & 16383) * DM + d];
        e = fmaxf(e, fabsf(o - dbgo[(size_t)tok * DM + d])); sc = fmaxf(sc, fabsf(o)); }
    for (int o_ = 32; o_ >= 1; o_ >>= 1) { e = fmaxf(e, __shfl_xor(e, o_)); sc = fmaxf(sc, __shfl_xor(sc, o_)); }
    if (t == 0) dbg_report(slot, e / (sc + 1e-6f));
}
__global__ void k_dbg_out2(const float* x, const float* fg, float* out, const unsigned* slot) {
    const float mx = __uint_as_float(*slot); float v = 0.25f * (log10f(fmaxf(mx, 1e-30f)) + 4.0f); v = fminf(fmaxf(v, 0.f), 9.f);
    const float f = 1.0f + v;
    const int lane = threadIdx.x & 63; const size_t r = (size_t)blockIdx.x * 4 + (threadIdx.x >> 6);
    const float* xr = x + r * DM; float ss = 0.f;
    for (int c = lane; c < DM; c += 64) ss += xr[c] * xr[c];
    ss = wave_sum(ss); const float rs = rsqrtf(ss / DM + NORM_EPS);
    for (int c = lane; c < DM; c += 64) out[r * DM + c] = xr[c] * rs * fg[c] * f;
}
#endif
#ifdef DBG_SCAN
__global__ void k_scan16(const bf16_t* p, size_t n, unsigned* flags, int stage) {
    unsigned bad = 0; for (size_t i = (size_t)blockIdx.x * blockDim.x + threadIdx.x; i < n; i += (size_t)gridDim.x * blockDim.x) bad |= ((p[i] & 0x7f80u) == 0x7f80u);
    if (bad) atomicOr(&flags[stage], 1u);
}
__global__ void k_scan32(const float* p, size_t n, unsigned* flags, int stage) {
    unsigned bad = 0; for (size_t i = (size_t)blockIdx.x * blockDim.x + threadIdx.x; i < n; i += (size_t)gridDim.x * blockDim.x) bad |= ((__float_as_uint(p[i]) & 0x7f800000u) == 0x7f800000u);
    if (bad) atomicOr(&flags[stage], 1u);
}
__global__ void k_dbg_out(const float* x, const float* fg, float* out, const unsigned* flags, int nstage) {
    int code = 0; for (int s = nstage; s >= 1; --s) if (flags[s]) code = s;
    const float f = 1.0f + 0.25f * (float)code;
    const int lane = threadIdx.x & 63; const size_t r = (size_t)blockIdx.x * 4 + (threadIdx.x >> 6);
    const float* xr = x + r * DM; float ss = 0.f;
    for (int c = lane; c < DM; c += 64) ss += xr[c] * xr[c];
    ss = wave_sum(ss); const float rs = rsqrtf(ss / DM + NORM_EPS);
    for (int c = lane; c < DM; c += 64) out[r * DM + c] = xr[c] * rs * fg[c] * f;
}
#endif
extern "C" void kernel_launch(void* const* d_in, const int* in_sizes, int n_in, void* d_out, int out_size, void* d_ws, size_t ws_size, hipStream_t stream) {
    static int grid = 0;
    if (grid == 0) {
        if (n_in != 30 || out_size != NBATCH * SEQ * DM || ws_size < WS_END) { fprintf(stderr, "kernel_launch: shape/workspace mismatch: n_in %d out %d ws %zu (need %zu)\n", n_in, out_size, ws_size, (size_t)WS_END); grid = -1; return; }
        int dev = 0, cus = 0, per_cu = 0;
        if (hipGetDevice(&dev) != hipSuccess || hipDeviceGetAttribute(&cus, hipDeviceAttributeMultiprocessorCount, dev) != hipSuccess) { grid = -1; return; }
        bool okattr = hipFuncSetAttribute((const void*)MAIN_KERNEL, hipFuncAttributeMaxDynamicSharedMemorySize, LDS_BYTES) == hipSuccess;
#if MK_N_LAUNCHES != 1
#ifdef DBG_HYB
        okattr = okattr && hipFuncSetAttribute((const void*)mk_fwd, hipFuncAttributeMaxDynamicSharedMemorySize, LDS_BYTES) == hipSuccess;
#endif
#define SETA(K) okattr = okattr && hipFuncSetAttribute((const void*)k_one<K>, hipFuncAttributeMaxDynamicSharedMemorySize, LDS_BYTES) == hipSuccess
        SETA(0); SETA(1); SETA(2); SETA(3); SETA(4); SETA(5); SETA(6); SETA(7); SETA(8); SETA(9); SETA(10); SETA(11); SETA(12); SETA(13);
#undef SETA
#endif
        if (!okattr) { fprintf(stderr, "kernel_launch: hipFuncSetAttribute failed\n"); grid = -1; return; }
        if (hipOccupancyMaxActiveBlocksPerMultiprocessor(&per_cu, (const void*)MAIN_KERNEL, NTHREADS, LDS_BYTES) != hipSuccess || per_cu < 1) { fprintf(stderr, "kernel_launch: occupancy query says %d blocks per CU\n", per_cu); grid = -1; (void)hipGetLastError(); return; }
        grid = cus;
    }
    if (grid < 0) return;
    if (hipMemsetAsync((char*)d_ws + WS_CTL, 0, CTL_BYTES, stream) != hipSuccess) return;
    Args a{};
    for (int i = 0; i < 30; ++i) a.in[i] = (const float*)d_in[i];
    a.out = (float*)d_out; a.ws = (unsigned char*)d_ws;
#if defined(DBG_PROBE)
    { unsigned* flags = (unsigned*)((char*)d_ws + WS_CTL + 32768);
      hipLaunchKernelGGL(k_probe_mx, dim3(1), dim3(64), 0, stream, flags + 100);
      hipLaunchKernelGGL(k_dbg_out2, dim3(NBATCH * SEQ / 4), dim3(256), 0, stream, (const float*)d_in[0], (const float*)d_in[29], (float*)d_out, flags + 100); }
#elif MK_N_LAUNCHES == 1 && defined(DBG_CHECK)
    {
        unsigned* flags = (unsigned*)((char*)d_ws + WS_CTL + 32768); char* W = (char*)d_ws;
        a.ph_lo = 0; a.ph_hi = (DBG_CHECK == 8) ? 3 : (DBG_CHECK >= 5) ? 7 : (DBG_CHECK == 1 ? 11 : (DBG_CHECK == 2 ? 12 : 13));
        hipLaunchKernelGGL(mk_fwd, dim3(grid), dim3(NTHREADS), LDS_BYTES, stream, a);
#if DBG_CHECK == 8
        hipLaunchKernelGGL(k_check_gemm8, dim3(32), dim3(256), 0, stream, (const unsigned char*)(W + WS_HB), (const float*)d_in[I_WIN], DM, IN_COLS, (const bf16_t*)(W + WS_P), NP, TT, flags + 100);
#elif DBG_CHECK == 5 || DBG_CHECK == 6
        hipLaunchKernelGGL(k_check_attn, dim3(16 * 24), dim3(256), 0, stream, (const unsigned char*)d_ws, DBG_CHECK == 5 ? 1 : 0, flags + 100);
#elif DBG_CHECK == 7
        { float* obuf = (float*)(W + WS_MQ);
          hipLaunchKernelGGL(k_check_gla_rec, dim3(8), dim3(256), 0, stream, (const unsigned char*)d_ws, (const float*)d_in[I_WA2F], (const float*)d_in[I_BAF], (const float*)d_in[I_WA2B], (const float*)d_in[I_BAB], obuf, 0);
          hipLaunchKernelGGL(k_check_gla_cmp, dim3(RPB * 4), dim3(256), 0, stream, (const unsigned char*)d_ws, (const float*)obuf, (const float*)d_in[I_ONG], 0, flags + 100); }
#elif DBG_CHECK == 1
        hipLaunchKernelGGL(k_check_gemm, dim3(32), dim3(256), 0, stream, (const bf16_t*)(W + WS_HB), DM, (const float*)d_in[I_PWQ], DM, DM, (const bf16_t*)(W + WS_PQ), DM, TT, flags + 100);
#elif DBG_CHECK == 2
        hipLaunchKernelGGL(k_check_select, dim3(256 * 8), dim3(64), 0, stream, (const bf16_t*)(W + WS_PQ), (const float*)d_in[I_PK1], (const float*)d_in[I_PK2], (const int*)(W + WS_PIDX), (const float*)(W + WS_PG), flags + 100);
#else
        hipLaunchKernelGGL(k_check_gather, dim3(128), dim3(64), 0, stream, (const bf16_t*)(W + WS_HB), (const float*)d_in[I_PU], (const float*)d_in[I_PV], (const int*)(W + WS_PIDX), (const float*)(W + WS_PG), (const float*)(W + WS_MQ), flags + 100);
#endif
        hipLaunchKernelGGL(k_dbg_out2, dim3(NBATCH * SEQ / 4), dim3(256), 0, stream, (const float*)d_in[0], (const float*)d_in[29], (float*)d_out, flags + 100);
    }
#elif MK_N_LAUNCHES == 1
#ifdef DBG_SPLIT
    for (int p = 0; p < N_PHASES; p += DBG_SPLIT) { a.ph_lo = p; a.ph_hi = p + DBG_SPLIT < N_PHASES ? p + DBG_SPLIT : N_PHASES; hipLaunchKernelGGL(mk_fwd, dim3(grid), dim3(NTHREADS), LDS_BYTES, stream, a); }
#else
    a.ph_lo = 0; a.ph_hi = N_PHASES;
    hipLaunchKernelGGL(mk_fwd, dim3(grid), dim3(NTHREADS), LDS_BYTES, stream, a);
#endif
#else
    a.ph_hi = 0;
#ifndef DBG_NLAUNCH
#define DBG_NLAUNCH 100
#endif
    int nl_ = 0;
#ifdef DBG_HYB
#define LAUNCH1(K, L) do { if (K == DBG_HYB) { a.ph_lo = 12 * (L) + (K); a.ph_hi = a.ph_lo + 1; hipLaunchKernelGGL(mk_fwd, dim3(grid), dim3(NTHREADS), LDS_BYTES, stream, a); a.ph_hi = 0; } else { a.ph_lo = (L); hipLaunchKernelGGL(k_one<K>, dim3(grid), dim3(NTHREADS), LDS_BYTES, stream, a); } } while (0)
#else
#define LAUNCH1(K, L) do { a.ph_lo = (L); if (nl_++ < DBG_NLAUNCH) { hipLaunchKernelGGL(k_one<K>, dim3(grid), dim3(NTHREADS), LDS_BYTES, stream, a); if (K == DBG_DUP) hipLaunchKernelGGL(k_one<K>, dim3(grid), dim3(NTHREADS), LDS_BYTES, stream, a); } } while (0)
#endif
#ifdef DBG_SCAN
    unsigned* flags = (unsigned*)((char*)d_ws + WS_CTL + 32768);
    char* W = (char*)d_ws;
#define S16(off, n, st) hipLaunchKernelGGL(k_scan16, dim3(1024), dim3(256), 0, stream, (const bf16_t*)(W + (off)), (size_t)(n), flags, st)
#define S32(off, n, st) hipLaunchKernelGGL(k_scan32, dim3(1024), dim3(256), 0, stream, (const float*)(W + (off)), (size_t)(n), flags, st)
    LAUNCH1(0, 0); S32(WS_MODV, 2 * 3 * 12288, 1);
    { const int l = 0;
      LAUNCH1(1, l); S16(WS_HB, (size_t)TT * DM, 2);
      LAUNCH1(2, l); S16(WS_P, (size_t)TT * NP, 3);
      LAUNCH1(3, l); S16(WS_P, (size_t)TT * NP, 4);
      LAUNCH1(4, l); S16(WS_MQ, (size_t)TT * 1536, 5); S16(WS_MKV, (size_t)TT * 2048, 5); S16(WS_GST, (size_t)2112 * 32768, 6); S32(WS_GDEC, (size_t)2112 * 128, 6);
      LAUNCH1(5, l); S16(WS_GST, (size_t)2112 * 32768, 7);
      LAUNCH1(6, l); S16(WS_OA, (size_t)TT * 1024, 8); S16(WS_OM, (size_t)TT * 1024, 9); S16(WS_OL, (size_t)TT * 1024, 10);
      LAUNCH1(7, l); S16(WS_Y, (size_t)TT * DM, 11);
      LAUNCH1(8, l); S32(WS_XS, (size_t)TT * DM, 12);
      LAUNCH1(9, l); S16(WS_HB, (size_t)TT * DM, 13);
      LAUNCH1(10, l); S16(WS_PQ, (size_t)TT * DM, 14);
      LAUNCH1(11, l); S32(WS_PG, (size_t)TT * 128, 15);
      LAUNCH1(12, l); S32(WS_XS, (size_t)TT * DM, 16);
    }
    hipLaunchKernelGGL(k_dbg_out, dim3(NBATCH * SEQ / 4), dim3(256), 0, stream, (const float*)d_in[0], (const float*)d_in[29], (float*)d_out, flags, 16);
#elif defined(DBG_CHECK)
    unsigned* flags = (unsigned*)((char*)d_ws + WS_CTL + 32768);
    char* W = (char*)d_ws;
    LAUNCH1(0, 0);
    { const int l = 0; LAUNCH1(1, l); LAUNCH1(2, l); LAUNCH1(3, l); LAUNCH1(4, l); LAUNCH1(5, l); LAUNCH1(6, l);
#if DBG_CHECK == 5 || DBG_CHECK == 6
      hipLaunchKernelGGL(k_check_attn, dim3(16 * 24), dim3(256), 0, stream, (const unsigned char*)d_ws, DBG_CHECK == 5 ? 1 : 0, flags + 100);
#endif
#if DBG_CHECK == 7
      { float* obuf = (float*)(W + WS_MQ);
        hipLaunchKernelGGL(k_check_gla_rec, dim3(8), dim3(256), 0, stream, (const unsigned char*)d_ws, (const float*)d_in[I_WA2F], (const float*)d_in[I_BAF], (const float*)d_in[I_WA2B], (const float*)d_in[I_BAB], obuf, 0);
        hipLaunchKernelGGL(k_check_gla_cmp, dim3(RPB * 4), dim3(256), 0, stream, (const unsigned char*)d_ws, (const float*)obuf, (const float*)d_in[I_ONG], 0, flags + 100); }
#endif
      LAUNCH1(7, l); LAUNCH1(8, l); LAUNCH1(9, l); LAUNCH1(10, l);
#if DBG_CHECK == 1
      hipLaunchKernelGGL(k_check_gemm, dim3(32), dim3(256), 0, stream, (const bf16_t*)(W + WS_HB), DM, (const float*)d_in[I_PWQ], DM, DM, (const bf16_t*)(W + WS_PQ), DM, TT, flags + 100);
#endif
      LAUNCH1(11, l);
#if DBG_CHECK == 2
      hipLaunchKernelGGL(k_check_select, dim3(256 * 8), dim3(64), 0, stream, (const bf16_t*)(W + WS_PQ), (const float*)d_in[I_PK1], (const float*)d_in[I_PK2], (const int*)(W + WS_PIDX), (const float*)(W + WS_PG), flags + 100);
#endif
      LAUNCH1(12, l);
#if DBG_CHECK == 3
      hipLaunchKernelGGL(k_check_gather, dim3(128), dim3(64), 0, stream, (const bf16_t*)(W + WS_HB), (const float*)d_in[I_PU], (const float*)d_in[I_PV], (const int*)(W + WS_PIDX), (const float*)(W + WS_PG), (const float*)(W + WS_MQ), flags + 100);
#endif
    }
    hipLaunchKernelGGL(k_dbg_out2, dim3(NBATCH * SEQ / 4), dim3(256), 0, stream, (const float*)d_in[0], (const float*)d_in[29], (float*)d_out, flags + 100);
#else
    LAUNCH1(0, 0);
    for (int l = 0; l < DEPTH; ++l) { LAUNCH1(1, l); LAUNCH1(2, l); LAUNCH1(3, l);
#ifdef DBG_DUP23
        LAUNCH1(2, l); LAUNCH1(3, l);
#endif
        LAUNCH1(4, l); LAUNCH1(5, l);
#ifdef DBG_DUP45
        LAUNCH1(4, l); LAUNCH1(5, l);
#endif
        LAUNCH1(6, l); LAUNCH1(7, l); LAUNCH1(8, l); LAUNCH1(9, l); LAUNCH1(10, l); LAUNCH1(11, l); LAUNCH1(12, l); }
    LAUNCH1(13, DEPTH - 1);
#endif
#undef LAUNCH1
#endif
    const hipError_t le = hipPeekAtLastError();
    if (le != hipSuccess) fprintf(stderr, "kernel_launch: launch failed: %s\n", hipGetErrorName(le));
}
```

```cpp
#include <hip/hip_runtime.h>
#include <cstdio>
#include <cstdint>

#ifndef MK_N_LAUNCHES
#ifndef DBG_DUP
#define DBG_DUP -1
#endif
#define MK_N_LAUNCHES 1
#endif

#ifndef DBG_MIX0
#define DBG_MIX0 1.0f
#define DBG_MIX1 1.0f
#define DBG_PEER0 1.0f
#define DBG_PEER1 1.0f
#endif
#ifndef MLA_NQR
#define MLA_NQR 4
#endif
#define LAS __attribute__((address_space(3)))
#define GLB __attribute__((address_space(1)))
typedef unsigned short bf16_t;
typedef short bf16x8 __attribute__((ext_vector_type(8)));
typedef short s16x4 __attribute__((ext_vector_type(4)));
typedef float f32x4 __attribute__((ext_vector_type(4)));
typedef float f32x2 __attribute__((ext_vector_type(2)));
typedef float f32x16 __attribute__((ext_vector_type(16)));
typedef unsigned u32x4 __attribute__((ext_vector_type(4)));
typedef unsigned u32x2 __attribute__((ext_vector_type(2)));
typedef __bf16 bf2_t __attribute__((ext_vector_type(2)));

constexpr int DM = 2048, NBATCH = 2, SEQ = 8192, CTXL = 256, DEPTH = 2;
constexpr int RPB = SEQ + CTXL;
constexpr int TT = NBATCH * RPB;
constexpr int IN_COLS = 11872, NP = 12032;
constexpr int C_AQ = 0, C_AK = 1024, C_AV = 1280, C_LQ = 1536, C_LK = 2048, C_LV = 2560, C_LG = 3584, C_LRF = 4608, C_LRB = 4624,
              C_MCQ = 4640, C_MCKV = 5152, C_MKR = 5664, C_GA = 5728, C_GL = 7776, C_GM = 9824;
constexpr int NCH = RPB / 64;
constexpr int NEXP = 16384;
constexpr float NORM_EPS = 1e-6f;
constexpr int NTHREADS = 512;

constexpr size_t al256(size_t x) { return (x + 255) / 256 * 256; }
constexpr size_t WS_CTL   = 0;
constexpr size_t CTL_BYTES = 65536;
constexpr size_t WS_MODV  = WS_CTL + CTL_BYTES;
constexpr size_t WS_TABA  = al256(WS_MODV + (size_t)2 * 3 * 12288 * 4);
constexpr size_t WS_TABM  = WS_TABA + 2 * 128 * 32 * 4;
constexpr size_t WS_XS    = al256(WS_TABM + 2 * 128 * 16 * 4);
constexpr size_t WS_HB    = WS_XS + (size_t)TT * DM * 4;
constexpr size_t WS_P     = WS_HB + (size_t)TT * DM * 2;
constexpr size_t WS_MQ    = WS_P + (size_t)TT * NP * 2;
constexpr size_t WS_MKV   = WS_MQ + (size_t)TT * 1536 * 2;
constexpr size_t WS_OA    = WS_MKV + (size_t)TT * 2048 * 2;
constexpr size_t WS_OL    = WS_OA + (size_t)TT * 1024 * 2;
constexpr size_t WS_OM    = WS_OL + (size_t)TT * 1024 * 2;
constexpr size_t WS_WIN   = WS_OM + (size_t)TT * 1024 * 2;
constexpr size_t WS_WUQ   = WS_WIN + (size_t)NP * 2048 * 2;
constexpr size_t WS_WUKV  = WS_WUQ + (size_t)1536 * 512 * 2;
constexpr size_t WS_WBR   = WS_WUKV + (size_t)2048 * 512 * 2;
constexpr size_t WS_WOUT  = WS_WBR + (size_t)3 * 2048 * 1024 * 2;
constexpr size_t WS_WQ    = WS_WOUT + (size_t)2048 * 2048 * 2;
constexpr size_t WS_K1    = WS_WQ + (size_t)2048 * 2048 * 2;
constexpr size_t WS_K2    = WS_K1 + (size_t)8 * 128 * 128 * 2;
constexpr size_t WS_GST   = WS_K2 + (size_t)8 * 128 * 128 * 2;
constexpr size_t WS_GDEC  = WS_GST + (size_t)NBATCH * 2 * 4 * NCH * 32768 * 2;
constexpr size_t WS_END0  = WS_GDEC + (size_t)NBATCH * 2 * 4 * NCH * 128 * 4;
constexpr size_t WS_KN8   = WS_OA + (size_t)TT * 1024;
constexpr size_t WS_AK8   = WS_OL + (size_t)TT * 1024;
constexpr size_t WS_KR8   = WS_AK8 + (size_t)TT * 256;
constexpr size_t WS_VT8A  = WS_KR8 + (size_t)TT * 64;
constexpr size_t WS_VT8M  = WS_OM + (size_t)TT * 1024;
constexpr size_t WS_Y     = WS_MKV;
constexpr size_t WS_PQ    = WS_OA;
constexpr size_t WS_PIDX  = WS_P;
constexpr size_t WS_PG    = WS_PIDX + (size_t)TT * 128 * 4;
constexpr size_t PT_BYTES = 2 * (size_t)NEXP * DM + 2 * (size_t)NEXP * 4;
constexpr size_t WS_WINS  = WS_END0;
constexpr size_t WS_WOUTS = al256(WS_WINS + (size_t)NP * 4);
constexpr size_t WS_WBRS  = al256(WS_WOUTS + (size_t)DM * 4);
constexpr size_t WS_PT    = al256(WS_WBRS + (size_t)3 * DM * 4);
constexpr size_t WS_END   = WS_PT + DEPTH * PT_BYTES;
constexpr size_t PT_U8 = 0, PT_V8 = (size_t)NEXP * DM, PT_SCU = 2 * (size_t)NEXP * DM, PT_SCV = PT_SCU + (size_t)NEXP * 4;
static_assert(WS_PG + (size_t)TT * 128 * 4 <= WS_MQ, "PEER alias region overflows P");

__device__ __forceinline__ unsigned cvt_pk_bf16(float lo, float hi) { bf2_t v; v.x = (__bf16)lo; v.y = (__bf16)hi; return __builtin_bit_cast(unsigned, v); }
__device__ __forceinline__ bf16_t f2bf(float f) { return (bf16_t)(cvt_pk_bf16(f, 0.f) & 0xffffu); }
__device__ __forceinline__ float bf2f(bf16_t b) { return __uint_as_float(((unsigned)b) << 16); }
__device__ __forceinline__ float bflo(unsigned w) { return __uint_as_float(w << 16); }
__device__ __forceinline__ float bfhi(unsigned w) { return __uint_as_float(w & 0xffff0000u); }
__device__ __forceinline__ float xchg32(float x, int lane) { auto r = __builtin_amdgcn_permlane32_swap(__float_as_uint(x), __float_as_uint(x), false, false); return __uint_as_float(lane < 32 ? r[1] : r[0]); }
__device__ __forceinline__ float xchg16(float x, int lane) { auto r = __builtin_amdgcn_permlane16_swap(__float_as_uint(x), __float_as_uint(x), false, false); return __uint_as_float((lane & 16) ? r[0] : r[1]); }
template <int CTRL> __device__ __forceinline__ float dppmov(float x) { return __uint_as_float(__builtin_amdgcn_update_dpp(0u, __float_as_uint(x), CTRL, 0xF, 0xF, false)); }
constexpr int DPP_ROR8 = 0x128, DPP_HMIRROR = 0x141, DPP_Q3210 = 0x1B, DPP_Q1032 = 0xB1;
__device__ __forceinline__ float wave_sum(float v) {
    const int lane = threadIdx.x & 63;
    v += xchg32(v, lane); v += xchg16(v, lane); v += dppmov<DPP_ROR8>(v); v += dppmov<DPP_HMIRROR>(v); v += dppmov<DPP_Q3210>(v); v += dppmov<DPP_Q1032>(v);
    return v;
}
__device__ __forceinline__ float sigmoidf_(float x) { return __builtin_amdgcn_rcpf(1.0f + __expf(-x)); }
__device__ __forceinline__ float siluf_(float x) { return x * __builtin_amdgcn_rcpf(1.0f + __expf(-x)); }

#define XB_TMO      128
#define XB_XCNT(j)  (256  + 64 * (j))
#define XB_XSUB(j)  (1280 + 64 * (j))
#define XB_XGEN(j)  (2304 + 64 * (j))
#define XB_TOP      3328
#define XB_TOPGEN   3392
#define XCD_BAR_WORDS 3456
#define XB_SPIN_CAP (1u << 20)
__device__ __forceinline__ unsigned xb_ld(unsigned* p)              { return __hip_atomic_load(p, __ATOMIC_RELAXED, __HIP_MEMORY_SCOPE_AGENT); }
__device__ __forceinline__ unsigned xb_add(unsigned* p, unsigned v) { return __hip_atomic_fetch_add(p, v, __ATOMIC_RELAXED, __HIP_MEMORY_SCOPE_AGENT); }
__device__ __forceinline__ unsigned xb_xcc_id() { return (unsigned)__builtin_amdgcn_s_getreg((3 << 11) | 20) & 0xFu; }
#define XB_SPIN(cond, bar) do { unsigned _sp = 0; while (cond) { __builtin_amdgcn_s_sleep(1); \
    if ((++_sp & 255u) == 0u) { if (xb_ld(&(bar)[XB_TMO])) break; if (_sp > XB_SPIN_CAP) { atomicAdd(&(bar)[XB_TMO], 1u); break; } } } } while (0)
struct XcdBarrier { unsigned* bar; unsigned x; volatile LAS unsigned* st; };
__device__ __forceinline__ XcdBarrier xcd_barrier_post(unsigned* bar, volatile LAS unsigned* st) {
    XcdBarrier b; b.bar = bar; b.x = xb_xcc_id(); b.st = st;
    if (threadIdx.x == 0) (void)xb_add(&bar[XB_XCNT(b.x)], 1u);
    return b;
}
__device__ __forceinline__ void xcd_barrier_complete(unsigned* bar, unsigned x, unsigned& nloc, unsigned& nx) {
    const unsigned G = gridDim.x * gridDim.y * gridDim.z;
    unsigned sum, cnt, mine, sp = 0u;
    for (;;) {
        sum = 0u; cnt = 0u; mine = 0u;
#pragma unroll
        for (unsigned j = 0; j < 16; ++j) { const unsigned c = xb_ld(&bar[XB_XCNT(j)]); sum += c; cnt += (c > 0u) ? 1u : 0u; mine = (j == x) ? c : mine; }
        if (sum == G) break;
        __builtin_amdgcn_s_sleep(1);
        if ((++sp & 255u) == 0u) { if (xb_ld(&bar[XB_TMO])) break; if (sp > XB_SPIN_CAP) { atomicAdd(&bar[XB_TMO], 1u); break; } }
    }
    nloc = mine > 0u ? mine : 1u; nx = cnt > 0u ? cnt : 1u;
}
__device__ __forceinline__ void xcd_barrier(const XcdBarrier& b) {
    asm volatile("s_waitcnt vmcnt(0)" ::: "memory");
    __syncthreads();
    if (threadIdx.x == 0) {
        unsigned* bar = b.bar;
        __builtin_amdgcn_s_waitcnt(0);
        unsigned nloc = b.st[0], nx = b.st[1];
        if (nloc == 0u) { xcd_barrier_complete(bar, b.x, nloc, nx); b.st[0] = nloc; b.st[1] = nx; }
        const unsigned old = xb_add(&bar[XB_XSUB(b.x)], 1u);
        const unsigned gen = old / nloc;
        if (old + 1u == (gen + 1u) * nloc) {
            __builtin_amdgcn_fence(__ATOMIC_RELEASE, "agent");
            asm volatile("s_waitcnt vmcnt(0)" ::: "memory");
            const unsigned og = xb_add(&bar[XB_TOP], 1u);
            const unsigned tg = og / nx;
            if (og + 1u == (tg + 1u) * nx) xb_add(&bar[XB_TOPGEN], 1u);
            else XB_SPIN(xb_ld(&bar[XB_TOPGEN]) == tg, bar);
            __builtin_amdgcn_fence(__ATOMIC_ACQUIRE, "agent");
            xb_add(&bar[XB_XGEN(b.x)], 1u);
            asm volatile("s_waitcnt vmcnt(0)" ::: "memory");
        } else {
            XB_SPIN(xb_ld(&bar[XB_XGEN(b.x)]) == gen, bar);
            __builtin_amdgcn_fence(__ATOMIC_ACQUIRE, "agent");
            asm volatile("s_waitcnt vmcnt(0)" ::: "memory");
        }
    }
    __syncthreads();
}

namespace pg8 {
constexpr int BM = 256, BK = 64, HALF = 128, HTB = HALF * BK * 2, STAGE_BYTES = 8 * HTB, NXCD = 8, WGM = 8;
__host__ __device__ __forceinline__ int lds_byte(int r, int c) { const int st = (r >> 4) * 2 + (c >> 5), rr = r & 15, cc = c & 31, ob = rr * 64 + cc * 2; return st * 1024 + (ob ^ (((ob >> 9) & 1) << 5)); }
__host__ __device__ __forceinline__ void stage_rc(int b, int& R, int& C) { const int st = b / 1024, sb = b % 1024, swz = sb ^ (((sb >> 9) & 1) << 5); R = (st >> 1) * 16 + swz / 64; C = (st & 1) * 32 + (swz % 64) / 2; }
__host__ __device__ __forceinline__ int perm32(int rho) { const int n = rho >> 4, i = rho & 15; return 8 * (i >> 2) + 4 * n + (i & 3); }
struct Unit { int pm, pn; };
struct Gemm { const bf16_t* A; const bf16_t* Bt; int M, N, K, lda, ldb; };
struct StaticOrder {
    int nM, nN, nwg, G, c, latent;
    __host__ __device__ void init(int M, int N, int G_, int c_, int latent_ = 0) { latent = latent_; nM = latent_ ? 64 : M / BM; nN = N / BM; nwg = nM * nN; G = G_; c = c_; }
    __host__ __device__ bool next(int i, Unit& u) const {
        const long L = (long)i * G + c; if (L >= nwg) return false;
        int wgid = (int)L; { const int q = nwg / NXCD, r = nwg % NXCD, xcd = wgid % NXCD, off = wgid / NXCD; wgid = (xcd < r ? xcd * (q + 1) : r * (q + 1) + (xcd - r) * q) + off; }
        const int nig = WGM * nN, gid = wgid / nig, fm = gid * WGM, gsz = (nM - fm) < WGM ? (nM - fm) : WGM;
        u.pm = fm + ((wgid % nig) % gsz); u.pn = (wgid % nig) / gsz; if (latent) u.pm += 1 + (u.pm >= 32 ? 1 : 0); return true;
    }
};
struct WinOrder {
    StaticOrder S; int full, nlat, G, c;
    __host__ __device__ void init(int G_, int c_, int full_) { full = full_; G = G_; c = c_; S.init(TT, NP, G_, c_, full_ ? 0 : 1); nlat = S.nwg; }
    __host__ __device__ bool next(int i, Unit& u) const {
        if (full) return S.next(i, u);
        const long L = (long)i * G + c;
        if (L < nlat) return S.next(i, u);
        const int q = (int)(L - nlat); if (q >= 24) return false;
        const int t = q % 12; u.pm = q < 12 ? 0 : 33;
        u.pn = t < 2 ? 4 + t : (t < 8 ? 8 + (t - 2) : (t == 8 ? 18 : 20 + (t - 9)));
        return true;
    }
};
struct EpiStoreBf16 {
    static constexpr bool PERM = true;
    bf16_t* O; int ldc;
    __device__ __forceinline__ void operator()(const f32x4 (&acc)[2][2][4][2], const Unit& u, int wr, int wc, int fr, int fq) const {
        const int row0 = u.pm * BM + wr * 64 + fr, col0 = u.pn * BM + wc * 32 + 8 * fq;
#pragma unroll
        for (int ai = 0; ai < 2; ++ai)
#pragma unroll
            for (int m = 0; m < 4; ++m) { bf16_t* rowp = O + (size_t)(row0 + ai * HALF + m * 16) * ldc + col0;
#pragma unroll
                for (int bj = 0; bj < 2; ++bj) { const f32x4 v0 = acc[ai][bj][m][0], v1 = acc[ai][bj][m][1];
                    u32x4 w; w.x = cvt_pk_bf16(v0[0], v0[1]); w.y = cvt_pk_bf16(v0[2], v0[3]); w.z = cvt_pk_bf16(v1[0], v1[1]); w.w = cvt_pk_bf16(v1[2], v1[3]);
                    *(u32x4*)(rowp + bj * HALF) = w; } }
    }
};
struct EpiNull {
    static constexpr bool PERM = true;
    __device__ __forceinline__ void operator()(const f32x4 (&acc)[2][2][4][2], const Unit&, int, int, int, int) const {
#pragma unroll
        for (int a = 0; a < 2; ++a)
#pragma unroll
            for (int b = 0; b < 2; ++b)
#pragma unroll
                for (int m = 0; m < 4; ++m)
#pragma unroll
                    for (int n = 0; n < 2; ++n) asm volatile("" :: "v"(acc[a][b][m][n]));
    }
};
struct EpiStoreMKV {
    static constexpr bool PERM = true;
    bf16_t* O; unsigned char* K8;
    __device__ __forceinline__ void operator()(const f32x4 (&acc)[2][2][4][2], const Unit& u, int wr, int wc, int fr, int fq) const {
        const int row0 = u.pm * BM + wr * 64 + fr, col0 = u.pn * BM + wc * 32 + 8 * fq;
#pragma unroll
        for (int ai = 0; ai < 2; ++ai)
#pragma unroll
            for (int m = 0; m < 4; ++m) { const size_t r = (size_t)(row0 + ai * HALF + m * 16); bf16_t* rowp = O + r * 2048 + col0;
#pragma unroll
                for (int bj = 0; bj < 2; ++bj) { const f32x4 v0 = acc[ai][bj][m][0], v1 = acc[ai][bj][m][1];
                    u32x4 w; w.x = cvt_pk_bf16(v0[0], v0[1]); w.y = cvt_pk_bf16(v0[2], v0[3]); w.z = cvt_pk_bf16(v1[0], v1[1]); w.w = cvt_pk_bf16(v1[2], v1[3]);
                    *(u32x4*)(rowp + bj * HALF) = w;
                    if (bj == 0) { int p0 = __builtin_amdgcn_cvt_pk_fp8_f32(v0[0], v0[1], 0, false); p0 = __builtin_amdgcn_cvt_pk_fp8_f32(v0[2], v0[3], p0, true);
                        int p1 = __builtin_amdgcn_cvt_pk_fp8_f32(v1[0], v1[1], 0, false); p1 = __builtin_amdgcn_cvt_pk_fp8_f32(v1[2], v1[3], p1, true);
                        u32x2 w8; w8.x = (unsigned)p0; w8.y = (unsigned)p1; *(u32x2*)(K8 + r * 1024 + u.pn * 128 + wc * 32 + 8 * fq) = w8; } } }
    }
};
struct EpiStoreBf16S {
    static constexpr bool PERM = true;
    bf16_t* O; int ldc; const float* cs;
    __device__ __forceinline__ void operator()(const f32x4 (&acc)[2][2][4][2], const Unit& u, int wr, int wc, int fr, int fq) const {
        const int row0 = u.pm * BM + wr * 64 + fr, col0 = u.pn * BM + wc * 32 + 8 * fq;
        f32x4 sv[2][2];
#pragma unroll
        for (int bj = 0; bj < 2; ++bj)
#pragma unroll
            for (int n = 0; n < 2; ++n) sv[bj][n] = *(const f32x4*)(cs + col0 + bj * HALF + 4 * n);
#pragma unroll
        for (int ai = 0; ai < 2; ++ai)
#pragma unroll
            for (int m = 0; m < 4; ++m) { bf16_t* rowp = O + (size_t)(row0 + ai * HALF + m * 16) * ldc + col0;
#pragma unroll
                for (int bj = 0; bj < 2; ++bj) { const f32x4 v0 = acc[ai][bj][m][0] * sv[bj][0], v1 = acc[ai][bj][m][1] * sv[bj][1];
                    u32x4 w; w.x = cvt_pk_bf16(v0[0], v0[1]); w.y = cvt_pk_bf16(v0[2], v0[3]); w.z = cvt_pk_bf16(v1[0], v1[1]); w.w = cvt_pk_bf16(v1[2], v1[3]);
                    *(u32x4*)(rowp + bj * HALF) = w; } }
    }
};
template <bool FIRST, bool F8OUT = false> struct EpiGate {
    static constexpr bool PERM = true;
    bf16_t* Y; const bf16_t* Gt; unsigned char* Y8; const float* cs;
    __device__ __forceinline__ void operator()(const f32x4 (&acc)[2][2][4][2], const Unit& u, int wr, int wc, int fr, int fq) const {
        constexpr int ldy = DM, ldg = NP, ldy8 = DM;
        const int row0 = u.pm * BM + wr * 64 + fr, col0 = u.pn * BM + wc * 32 + 8 * fq;
        f32x4 sv[2][2];
#pragma unroll
        for (int bj = 0; bj < 2; ++bj)
#pragma unroll
            for (int n = 0; n < 2; ++n) sv[bj][n] = *(const f32x4*)(cs + col0 + bj * HALF + 4 * n);
#pragma unroll
        for (int ai = 0; ai < 2; ++ai)
#pragma unroll
        for (int mh = 0; mh < 2; ++mh) {
            u32x4 g[2][2], y[2][2];
#pragma unroll
            for (int mm = 0; mm < 2; ++mm)
#pragma unroll
                for (int bj = 0; bj < 2; ++bj) { const size_t r = (size_t)(row0 + ai * HALF + (mh * 2 + mm) * 16);
                    g[mm][bj] = *(const u32x4*)(Gt + r * ldg + col0 + bj * HALF);
                    if (!FIRST) y[mm][bj] = *(const u32x4*)(Y + r * ldy + col0 + bj * HALF); }
#pragma unroll
            for (int mm = 0; mm < 2; ++mm)
#pragma unroll
                for (int bj = 0; bj < 2; ++bj) { const int m = mh * 2 + mm; const size_t r = (size_t)(row0 + ai * HALF + m * 16); const f32x4 v0 = acc[ai][bj][m][0] * sv[bj][0], v1 = acc[ai][bj][m][1] * sv[bj][1]; const u32x4 gg = g[mm][bj];
                    float o[8];
                    o[0] = sigmoidf_(bflo(gg.x)) * v0[0]; o[1] = sigmoidf_(bfhi(gg.x)) * v0[1]; o[2] = sigmoidf_(bflo(gg.y)) * v0[2]; o[3] = sigmoidf_(bfhi(gg.y)) * v0[3];
                    o[4] = sigmoidf_(bflo(gg.z)) * v1[0]; o[5] = sigmoidf_(bfhi(gg.z)) * v1[1]; o[6] = sigmoidf_(bflo(gg.w)) * v1[2]; o[7] = sigmoidf_(bfhi(gg.w)) * v1[3];
                    if (!FIRST) { const u32x4 yy = y[mm][bj];
                        o[0] += bflo(yy.x); o[1] += bfhi(yy.x); o[2] += bflo(yy.y); o[3] += bfhi(yy.y); o[4] += bflo(yy.z); o[5] += bfhi(yy.z); o[6] += bflo(yy.w); o[7] += bfhi(yy.w); }
                    if constexpr (F8OUT) { int p0 = __builtin_amdgcn_cvt_pk_fp8_f32(o[0], o[1], 0, false); p0 = __builtin_amdgcn_cvt_pk_fp8_f32(o[2], o[3], p0, true);
                        int p1 = __builtin_amdgcn_cvt_pk_fp8_f32(o[4], o[5], 0, false); p1 = __builtin_amdgcn_cvt_pk_fp8_f32(o[6], o[7], p1, true);
                        u32x2 w8; w8.x = (unsigned)p0; w8.y = (unsigned)p1; *(u32x2*)(Y8 + r * ldy8 + col0 + bj * HALF) = w8; }
                    else { u32x4 w; w.x = cvt_pk_bf16(o[0], o[1]); w.y = cvt_pk_bf16(o[2], o[3]); w.z = cvt_pk_bf16(o[4], o[5]); w.w = cvt_pk_bf16(o[6], o[7]);
                        *(u32x4*)(Y + r * ldy + col0 + bj * HALF) = w; } }
        }
    }
};
template <bool CS> struct EpiResidT {
    static constexpr bool PERM = false;
    float* X; int ldx; const float* gate; const float* cs;
    __device__ __forceinline__ void operator()(const f32x4 (&acc)[2][2][4][2], const Unit& u, int wr, int wc, int fr, int fq) const {
        const int row0 = u.pm * BM + wr * 64 + fr, col0 = u.pn * BM + wc * 32 + 4 * fq;
        const int sel = (u.pm % 33 == 0) ? 2 : (u.pm / 33);
        const float* gp = gate + (size_t)sel * 12288 + col0;
        f32x4 gv[2][2];
#pragma unroll
        for (int bj = 0; bj < 2; ++bj)
#pragma unroll
            for (int n = 0; n < 2; ++n) { gv[bj][n] = *(const f32x4*)(gp + bj * HALF + n * 16); if constexpr (CS) gv[bj][n] = gv[bj][n] * *(const f32x4*)(cs + col0 + bj * HALF + n * 16); }
#pragma unroll
        for (int ai = 0; ai < 2; ++ai)
#pragma unroll
            for (int mh = 0; mh < 2; ++mh) {
                f32x4 x[2][2][2];
#pragma unroll
                for (int mm = 0; mm < 2; ++mm)
#pragma unroll
                    for (int bj = 0; bj < 2; ++bj)
#pragma unroll
                        for (int n = 0; n < 2; ++n) x[mm][bj][n] = *(const f32x4*)(X + (size_t)(row0 + ai * HALF + (mh * 2 + mm) * 16) * ldx + col0 + bj * HALF + n * 16);
#pragma unroll
                for (int mm = 0; mm < 2; ++mm)
#pragma unroll
                    for (int bj = 0; bj < 2; ++bj)
#pragma unroll
                        for (int n = 0; n < 2; ++n) *(f32x4*)(X + (size_t)(row0 + ai * HALF + (mh * 2 + mm) * 16) * ldx + col0 + bj * HALF + n * 16) = x[mm][bj][n] + gv[bj][n] * acc[ai][bj][mh * 2 + mm][n];
            }
    }
};

typedef int i32x8 __attribute__((ext_vector_type(8)));
typedef int i32x4 __attribute__((ext_vector_type(4)));
__device__ __forceinline__ i32x8 cat8(const bf16x8 lo, const bf16x8 hi) { const i32x4 a = __builtin_bit_cast(i32x4, lo), b = __builtin_bit_cast(i32x4, hi); return __builtin_shufflevector(a, b, 0, 1, 2, 3, 4, 5, 6, 7); }
template <class Epi, class Sched, int F8 = 0>
__device__ __forceinline__ void gemm_phase(LAS unsigned char* lds, const int tid, const Gemm g, const Sched& S, const Epi& E) {
    const int wid = __builtin_amdgcn_readfirstlane(tid >> 6), lane = tid & 63, wr = wid >> 2, wc = wid & 3, fr = lane & 15, fq = lane >> 4;
    const int K = g.K, nt = F8 ? K / 128 : K / BK, lda = g.lda, ldb = g.ldb;
    unsigned voffA[2], voffB[2];
#pragma unroll
    for (int i = 0; i < 2; ++i) { int R, C; stage_rc(tid * 16 + i * 8192, R, C); const int Rb = Epi::PERM ? ((R & ~31) + perm32(R & 31)) : R;
        voffA[i] = F8 ? (unsigned)(R * lda + C * 2) : (unsigned)(R * lda + C) * 2u; voffB[i] = F8 ? (unsigned)(Rb * ldb + C * 2) : (unsigned)(Rb * ldb + C) * 2u; }
    const size_t kstep = (size_t)(BK * 2);
    const size_t hstepA = (size_t)HALF * lda * (F8 ? 1 : 2), hstepB = (size_t)HALF * ldb * (F8 ? 1 : 2);
    const size_t tstepA = 2 * hstepA, tstepB = 2 * hstepB;
    const unsigned ldsw = (unsigned)wid * 1024u;
    const int aoff = F8 ? lds_byte(wr * 64 + fr, (fq & 1) * 16) + (fq >> 1) * 1024 : lds_byte(wr * 64 + fr, fq * 8);
    const int boff = F8 ? lds_byte(wc * 32 + fr, (fq & 1) * 16) + (fq >> 1) * 1024 : lds_byte(wc * 32 + fr, fq * 8);
#define PG8_SA(b, h) (((b) * 2 + (h)) * HTB)
#define PG8_SB(b, h) ((4 + (b) * 2 + (h)) * HTB)
#define PG8_STAGE(bufoff, gbase, voff) do { _Pragma("unroll") for (int _i = 0; _i < 2; ++_i) \
        __builtin_amdgcn_global_load_lds((const unsigned*)((const char*)(gbase) + (voff)[_i]), (LAS unsigned*)(lds + (bufoff) + ldsw + _i * 8192), 16, 0, 0); } while (0)
#define PG8_LDA(dst, b, h) do { if constexpr (F8) { _Pragma("unroll") for (int m = 0; m < 4; ++m) { const LAS unsigned char* p_ = lds + PG8_SA(b, h) + aoff + m * 2048; \
            const i32x4 lo_ = *(const LAS i32x4*)p_, hi_ = *(const LAS i32x4*)(p_ + 16); dst##8[m] = __builtin_shufflevector(lo_, hi_, 0, 1, 2, 3, 4, 5, 6, 7); } } \
        else { _Pragma("unroll") for (int m = 0; m < 4; ++m) _Pragma("unroll") for (int k = 0; k < 2; ++k) dst[m][k] = *(const LAS bf16x8*)(lds + PG8_SA(b, h) + aoff + m * 2048 + k * 1024); } } while (0)
#define PG8_LDB(dst, b, h) do { if constexpr (F8) { _Pragma("unroll") for (int n = 0; n < 2; ++n) { const LAS unsigned char* p_ = lds + PG8_SB(b, h) + boff + n * 2048; \
            const i32x4 lo_ = *(const LAS i32x4*)p_, hi_ = *(const LAS i32x4*)(p_ + 16); dst##8[n] = __builtin_shufflevector(lo_, hi_, 0, 1, 2, 3, 4, 5, 6, 7); } } \
        else { _Pragma("unroll") for (int n = 0; n < 2; ++n) _Pragma("unroll") for (int k = 0; k < 2; ++k) dst[n][k] = *(const LAS bf16x8*)(lds + PG8_SB(b, h) + boff + n * 2048 + k * 1024); } } while (0)
#define PG8_MMA(ai, bj, At, Bt) do { __builtin_amdgcn_s_setprio(1); \
        if constexpr (F8) { _Pragma("unroll") for (int m = 0; m < 4; ++m) _Pragma("unroll") for (int n = 0; n < 2; ++n) \
            asm volatile("v_mfma_scale_f32_16x16x128_f8f6f4 %0, %1, %2, %0, %3, %3 op_sel_hi:[0,0,0]" : "+v"(acc[ai][bj][m][n]) : "v"(Bt##8[n]), "v"(At##8[m]), "v"(mxscale)); } \
        else { _Pragma("unroll") for (int m = 0; m < 4; ++m) _Pragma("unroll") for (int n = 0; n < 2; ++n) _Pragma("unroll") for (int k = 0; k < 2; ++k) \
            acc[ai][bj][m][n] = __builtin_amdgcn_mfma_f32_16x16x32_bf16(Bt[n][k], At[m][k], acc[ai][bj][m][n], 0, 0, 0); } \
        __builtin_amdgcn_s_setprio(0); } while (0)
#define PG8_WAIT_V(n) asm volatile("s_waitcnt vmcnt(" #n ")" ::: "memory")
#define PG8_WAIT_L(n) asm volatile("s_waitcnt lgkmcnt(" #n ")" ::: "memory")
#define PG8_BAR __builtin_amdgcn_s_barrier()
#define PG8_SCHED __builtin_amdgcn_sched_barrier(0)
    Unit cur, nxt; int ui = 0;
    if (!S.next(0, cur)) return;
    f32x4 acc[2][2][4][2];
#pragma unroll
    for (int a = 0; a < 2; ++a)
#pragma unroll
        for (int b = 0; b < 2; ++b)
#pragma unroll
            for (int m = 0; m < 4; ++m)
#pragma unroll
                for (int n = 0; n < 2; ++n) acc[a][b][m][n] = (f32x4){0.f, 0.f, 0.f, 0.f};
    int mxscale = 0x7f7f7f7f; asm volatile("" : "+v"(mxscale));
    bf16x8 At[4][2], B0[2][2], B1[2][2]; i32x8 At8[4], B08[2], B18[2];
    const char* cA = (const char*)g.A + (size_t)cur.pm * tstepA; const char* cB = (const char*)g.Bt + (size_t)cur.pn * tstepB;
    PG8_STAGE(PG8_SB(0, 0), cB, voffB); PG8_STAGE(PG8_SA(0, 0), cA, voffA); PG8_STAGE(PG8_SB(0, 1), cB + hstepB, voffB); PG8_STAGE(PG8_SA(0, 1), cA + hstepA, voffA);
    if (wr == 1) PG8_BAR;
    PG8_WAIT_V(4); PG8_BAR;
    PG8_STAGE(PG8_SB(1, 0), cB + kstep, voffB); PG8_STAGE(PG8_SA(1, 0), cA + kstep, voffA); PG8_STAGE(PG8_SB(1, 1), cB + hstepB + kstep, voffB);
    PG8_WAIT_V(6); PG8_BAR;
    for (;;) {
        const bool has_next = S.next(ui + 1, nxt);
        const char* nA = has_next ? (const char*)g.A + (size_t)nxt.pm * tstepA : cA; const char* nB = has_next ? (const char*)g.Bt + (size_t)nxt.pn * tstepB : cB;
        for (int t = 0; t < nt; t += 2) {
            const bool last = (t == nt - 2);
            const char* a1 = cA + (size_t)(t + 1) * kstep;
            const char* a2 = last ? nA : cA + (size_t)(t + 2) * kstep; const char* b2 = last ? nB : cB + (size_t)(t + 2) * kstep;
            const char* a3 = a2 + kstep; const char* b3 = b2 + kstep;
            PG8_LDB(B0, 0, 0); PG8_SCHED; PG8_LDA(At, 0, 0); PG8_STAGE(PG8_SA(1, 1), a1 + hstepA, voffA);
            PG8_WAIT_L(8); PG8_BAR; PG8_WAIT_L(0); PG8_MMA(0, 0, At, B0); PG8_BAR; PG8_SCHED;
            PG8_LDB(B1, 0, 1); PG8_STAGE(PG8_SB(0, 0), b2, voffB);
            PG8_BAR; PG8_WAIT_L(0); PG8_MMA(0, 1, At, B1); PG8_BAR;
            PG8_LDA(At, 0, 1); PG8_STAGE(PG8_SA(0, 0), a2, voffA);
            PG8_BAR; PG8_WAIT_L(0); PG8_MMA(1, 0, At, B0); PG8_BAR; PG8_SCHED;
            PG8_STAGE(PG8_SB(0, 1), b2 + hstepB, voffB);
            PG8_WAIT_V(6); PG8_BAR; PG8_MMA(1, 1, At, B1); PG8_BAR;
            PG8_LDB(B0, 1, 0); PG8_SCHED; PG8_LDA(At, 1, 0); PG8_STAGE(PG8_SA(0, 1), a2 + hstepA, voffA);
            PG8_WAIT_L(8); PG8_BAR; PG8_WAIT_L(0); PG8_MMA(0, 0, At, B0); PG8_BAR; PG8_SCHED;
            PG8_LDB(B1, 1, 1); PG8_STAGE(PG8_SB(1, 0), b3, voffB);
            PG8_BAR; PG8_WAIT_L(0); PG8_MMA(0, 1, At, B1); PG8_BAR;
            PG8_LDA(At, 1, 1); PG8_STAGE(PG8_SA(1, 0), a3, voffA);
            PG8_BAR; PG8_WAIT_L(0); PG8_MMA(1, 0, At, B0); PG8_BAR; PG8_SCHED;
            PG8_STAGE(PG8_SB(1, 1), b3 + hstepB, voffB);
            PG8_WAIT_V(6); PG8_BAR; PG8_MMA(1, 1, At, B1); PG8_BAR;
        }
        if constexpr (F8) asm volatile("s_nop 15\n\ts_nop 7");
        E(acc, cur, wr, wc, fr, fq);
        if (!has_next) break;
#pragma unroll
        for (int a = 0; a < 2; ++a)
#pragma unroll
            for (int b = 0; b < 2; ++b)
#pragma unroll
                for (int m = 0; m < 4; ++m)
#pragma unroll
                    for (int n = 0; n < 2; ++n) acc[a][b][m][n] = (f32x4){0.f, 0.f, 0.f, 0.f};
        cur = nxt; cA = nA; cB = nB; ++ui;
    }
    PG8_WAIT_V(0);
    if (wr == 0) PG8_BAR;
    PG8_BAR;
#undef PG8_SA
#undef PG8_SB
#undef PG8_STAGE
#undef PG8_LDA
#undef PG8_LDB
#undef PG8_MMA
#undef PG8_WAIT_V
#undef PG8_WAIT_L
#undef PG8_BAR
#undef PG8_SCHED
}
}

struct Args { const float* in[30]; float* out; unsigned char* ws; int ph_lo, ph_hi; };
enum { I_X = 0, I_C, I_CTX, I_CCTX, I_WMOD, I_BMOD, I_N1G, I_WIN, I_QNG, I_KNG, I_WA2F, I_BAF, I_WA2B, I_BAB, I_ONG, I_MQNG, I_WUQ, I_MKVNG, I_WUKV,
       I_WBRA, I_WBRL, I_WBRM, I_WOUT, I_N2G, I_PWQ, I_PK1, I_PK2, I_PU, I_PV, I_FG };
typedef const float* cfp_t;
struct Ctx {
    const __attribute__((address_space(4))) cfp_t* in; float* out; unsigned char* ws; LAS unsigned char* lds;
    int tid, lane, wid, G, bid;
};
#define WSP(T, off) ((T*)(C.ws + (off)))
#define INP(i) ((const float*)(const GLB float*)C.in[(i)])
__device__ __forceinline__ unsigned long long launder_u64(unsigned long long w) {
    unsigned lo = (unsigned)w, hi = (unsigned)(w >> 32); asm volatile("" : "+v"(lo), "+v"(hi));
    lo = __builtin_amdgcn_readfirstlane(lo); hi = __builtin_amdgcn_readfirstlane(hi); return ((unsigned long long)hi << 32) | lo;
}
__device__ __forceinline__ Ctx launder(const Ctx& C0) {
    Ctx R = C0; int t = C0.tid; asm volatile("" : "+v"(t)); R.tid = t; R.lane = t & 63; R.wid = __builtin_amdgcn_readfirstlane(t >> 6);
    R.ws = (unsigned char*)(GLB unsigned char*)launder_u64((unsigned long long)C0.ws);
    R.out = (float*)(GLB float*)(unsigned long long)C0.out;
    R.in = (const __attribute__((address_space(4))) cfp_t*)launder_u64((unsigned long long)C0.in);
    unsigned l = (unsigned)(uintptr_t)C0.lds; asm volatile("" : "+v"(l)); l = __builtin_amdgcn_readfirstlane(l); R.lds = (LAS unsigned char*)(uintptr_t)l;
    return R;
}

__device__ __forceinline__ const float* src_row(const Ctx& C, int r) {
    const int b = r / RPB, j = r % RPB;
    return j < CTXL ? INP(I_CTX) + ((size_t)b * CTXL + j) * DM : INP(I_X) + ((size_t)b * SEQ + (j - CTXL)) * DM;
}
__device__ __forceinline__ int mod_sel(int r) { const int b = r / RPB, j = r % RPB; return j < CTXL ? 2 : b; }

__device__ __forceinline__ void phase_modv(const Ctx& C) {
    LAS float* sc = (LAS float*)C.lds;
    LAS float* red = (LAS float*)(C.lds + 3 * 2048 * 4);
    for (int i = C.tid; i < 3 * DM; i += NTHREADS) { const int r = i / DM, k = i % DM; const float v = r < 2 ? INP(I_C)[r * DM + k] : INP(I_CCTX)[k]; sc[i] = siluf_(v); }
    __syncthreads();
    float* modv = WSP(float, WS_MODV);
    const int kq = C.tid / 12, c4 = C.tid % 12;
    for (int item = C.bid; item < 2 * 256; item += C.G) {
        const int l = item / 256, cg = item % 256;
        float acc[3][4];
#pragma unroll
        for (int r = 0; r < 3; ++r)
#pragma unroll
            for (int j = 0; j < 4; ++j) acc[r][j] = 0.f;
        if (kq < 42) {
            const float* wp = INP(I_WMOD) + (size_t)l * DM * 12288 + 48 * cg + 4 * c4;
#pragma unroll 1
            for (int k0 = kq; k0 < DM; k0 += 42 * 7) {
                f32x4 w[7];
#pragma unroll
                for (int u = 0; u < 7; ++u) { const int k = k0 + 42 * u; w[u] = k < DM ? *(const f32x4*)(wp + (size_t)k * 12288) : (f32x4){0.f, 0.f, 0.f, 0.f}; }
#pragma unroll
                for (int u = 0; u < 7; ++u) { const int k = k0 + 42 * u; if (k < DM) {
#pragma unroll
                    for (int r = 0; r < 3; ++r) { const float sv = sc[r * DM + k];
#pragma unroll
                        for (int j = 0; j < 4; ++j) acc[r][j] += sv * w[u][j]; } } }
            }
#pragma unroll
            for (int r = 0; r < 3; ++r)
#pragma unroll
                for (int j = 0; j < 4; ++j) red[kq * 144 + r * 48 + c4 * 4 + j] = acc[r][j];
        }
        __syncthreads();
        if (C.tid < 144) { float s = 0.f; for (int q = 0; q < 42; ++q) s += red[q * 144 + C.tid];
            const int r = C.tid / 48, cc = C.tid % 48;
            modv[((size_t)l * 3 + r) * 12288 + 48 * cg + cc] = s + INP(I_BMOD)[(size_t)l * 12288 + 48 * cg + cc]; }
        __syncthreads();
    }
}
__device__ __forceinline__ void phase_tables(const Ctx& C) {
    float* ta = WSP(float, WS_TABA); float* tm = WSP(float, WS_TABM);
    for (int i = C.bid * NTHREADS + C.tid; i < 128 * 32 + 128 * 16; i += C.G * NTHREADS) {
        if (i < 128 * 32) { const int pos = i / 32, f = i % 32; const float inv = exp2f(-(float)f * (13.287712379549449f / 32.0f)); const float a = (float)pos * inv;
            ta[i] = cosf(a); ta[128 * 32 + i] = sinf(a); }
        else { const int k = i - 128 * 32, pos = k / 16, f = k % 16; const float inv = exp2f(-(float)f * (13.287712379549449f / 16.0f)); const float a = (float)pos * inv;
            tm[k] = cosf(a); tm[128 * 16 + k] = sinf(a); }
    }
}
__device__ __forceinline__ void transpose_cvt(const Ctx& C, const float* src, int K, int N, bf16_t* dst, int Npad, int& item) {
    LAS float* tile = (LAS float*)C.lds;
    const int tk = K / 64, tn = Npad / 256, ntile = tk * tn;
    const int t0 = ((C.bid - item % C.G) + C.G) % C.G; item += ntile;
    for (int t = t0; t < ntile; t += C.G) {
        const int k0 = (t / tn) * 64, n0 = (t % tn) * 256;
        const int nn = (C.tid & 63) * 4, kr = C.tid >> 6;
        f32x4 v[8];
#pragma unroll
        for (int p = 0; p < 8; ++p) { v[p] = (f32x4){0.f, 0.f, 0.f, 0.f}; if (n0 + nn < N) v[p] = *(const f32x4*)(src + (size_t)(k0 + kr + p * 8) * N + n0 + nn); }
#pragma unroll
        for (int p = 0; p < 8; ++p)
#pragma unroll
            for (int j = 0; j < 4; ++j) tile[(kr + p * 8) * 257 + nn + j] = v[p][j];
        __syncthreads();
        { const int n = C.tid >> 1, kh = (C.tid & 1) * 32;
#pragma unroll
          for (int q = 0; q < 4; ++q) { float x[8];
#pragma unroll
              for (int j = 0; j < 8; ++j) x[j] = tile[(kh + q * 8 + j) * 257 + n];
              u32x4 w; w.x = cvt_pk_bf16(x[0], x[1]); w.y = cvt_pk_bf16(x[2], x[3]); w.z = cvt_pk_bf16(x[4], x[5]); w.w = cvt_pk_bf16(x[6], x[7]);
              *(u32x4*)(dst + (size_t)(n0 + n) * K + k0 + kh + q * 8) = w; } }
        __syncthreads();
    }
}
__device__ __forceinline__ void transpose_cvt_fp8(const Ctx& C, const float* src, int K, int N, unsigned char* dst, int Npad, float* cinv, const float cmul = 1.0f, const int wg_off = 0) {
    LAS float* tile = (LAS float*)C.lds;
    LAS float* red = (LAS float*)(C.lds + 64 * 65 * 4);
    LAS float* scl = red + 32 * 64;
    const int kk = C.tid >> 4, nn = (C.tid & 15) * 4;
    for (int cgp = ((C.bid - wg_off) % C.G + C.G) % C.G; cgp < Npad / 64; cgp += C.G) {
        const int n0 = cgp * 64; const bool live = n0 + nn < N;
        float am[4] = {0.f, 0.f, 0.f, 0.f};
        for (int k0 = 0; k0 < K; k0 += 128) {
            f32x4 v[4];
#pragma unroll
            for (int p = 0; p < 4; ++p) v[p] = live ? *(const f32x4*)(src + (size_t)(k0 + kk + p * 32) * N + n0 + nn) : (f32x4){0.f, 0.f, 0.f, 0.f};
#pragma unroll
            for (int p = 0; p < 4; ++p)
#pragma unroll
                for (int j = 0; j < 4; ++j) am[j] = fmaxf(am[j], fabsf(v[p][j])); }
#pragma unroll
        for (int j = 0; j < 4; ++j) red[kk * 64 + nn + j] = am[j];
        __syncthreads();
        if (C.tid < 64) { float m = 0.f; for (int q = 0; q < 32; ++q) m = fmaxf(m, red[q * 64 + C.tid]);
            scl[C.tid] = m > 0.f ? 224.0f / m : 1.0f; cinv[n0 + C.tid] = (m > 0.f ? m * (1.0f / 224.0f) : 1.0f) * cmul; }
        __syncthreads();
        for (int k0 = 0; k0 < K; k0 += 64) {
#pragma unroll
            for (int p = 0; p < 2; ++p) { const f32x4 v = live ? *(const f32x4*)(src + (size_t)(k0 + kk + p * 32) * N + n0 + nn) : (f32x4){0.f, 0.f, 0.f, 0.f};
#pragma unroll
                for (int j = 0; j < 4; ++j) tile[(kk + p * 32) * 65 + nn + j] = v[j]; }
            __syncthreads();
            { const int n = C.tid >> 3, k8 = (C.tid & 7) * 8; const float sc = scl[n]; float x[8];
#pragma unroll
              for (int j = 0; j < 8; ++j) x[j] = tile[(k8 + j) * 65 + n] * sc;
              int p0 = __builtin_amdgcn_cvt_pk_fp8_f32(x[0], x[1], 0, false); p0 = __builtin_amdgcn_cvt_pk_fp8_f32(x[2], x[3], p0, true);
              int p1 = __builtin_amdgcn_cvt_pk_fp8_f32(x[4], x[5], 0, false); p1 = __builtin_amdgcn_cvt_pk_fp8_f32(x[6], x[7], p1, true);
              u32x2 w; w.x = (unsigned)p0; w.y = (unsigned)p1; *(u32x2*)(dst + (size_t)(n0 + n) * K + k0 + k8) = w; }
            __syncthreads();
        }
    }
}
__device__ __forceinline__ void cvt_plain(const Ctx& C, const float* src, bf16_t* dst, size_t n8) {
    for (size_t i = (size_t)C.bid * NTHREADS + C.tid; i < n8; i += (size_t)C.G * NTHREADS) {
        const f32x4 a = *(const f32x4*)(src + i * 8), b = *(const f32x4*)(src + i * 8 + 4);
        u32x4 w; w.x = cvt_pk_bf16(a[0], a[1]); w.y = cvt_pk_bf16(a[2], a[3]); w.z = cvt_pk_bf16(b[0], b[1]); w.w = cvt_pk_bf16(b[2], b[3]);
        *(u32x4*)(dst + i * 8) = w;
    }
}
__device__ __forceinline__ void phase_cvt_mixer_weights(const Ctx& C, int l) {
    int item = 0;
    transpose_cvt_fp8(C, INP(I_WIN) + (size_t)l * DM * IN_COLS, DM, IN_COLS, C.ws + WS_WIN, NP, WSP(float, WS_WINS));
    __syncthreads();
    transpose_cvt(C, INP(I_WUQ) + (size_t)l * 512 * 1536, 512, 1536, WSP(bf16_t, WS_WUQ), 1536, item);
    transpose_cvt(C, INP(I_WUKV) + (size_t)l * 512 * 2048, 512, 2048, WSP(bf16_t, WS_WUKV), 2048, item);
    transpose_cvt_fp8(C, INP(I_WBRA) + (size_t)l * 1024 * 2048, 1024, 2048, C.ws + WS_WBR, 2048, WSP(float, WS_WBRS), 1.0f / 32.0f, 220); __syncthreads();
    transpose_cvt_fp8(C, INP(I_WBRL) + (size_t)l * 1024 * 2048, 1024, 2048, C.ws + WS_WBR + (size_t)2048 * 1024, 2048, WSP(float, WS_WBRS) + DM, 1.0f, 220); __syncthreads();
    transpose_cvt_fp8(C, INP(I_WBRM) + (size_t)l * 1024 * 2048, 1024, 2048, C.ws + WS_WBR + (size_t)2 * 2048 * 1024, 2048, WSP(float, WS_WBRS) + 2 * DM, 1.0f / 32.0f, 252); __syncthreads();
    transpose_cvt_fp8(C, INP(I_WOUT) + (size_t)l * 2048 * 2048, 2048, 2048, C.ws + WS_WOUT, 2048, WSP(float, WS_WOUTS), 1.0f, 188);
    __syncthreads();
    transpose_cvt(C, INP(I_PWQ) + (size_t)l * 2048 * 2048, 2048, 2048, WSP(bf16_t, WS_WQ), 2048, item);
    cvt_plain(C, INP(I_PK1) + (size_t)l * 8 * 128 * 128, WSP(bf16_t, WS_K1), 8 * 128 * 128 / 8);
    cvt_plain(C, INP(I_PK2) + (size_t)l * 8 * 128 * 128, WSP(bf16_t, WS_K2), 8 * 128 * 128 / 8);
}
__device__ __forceinline__ void phase_cvt_peer_tables(const Ctx& C, int l, int row_lo, int row_hi, int wg_lo) {
    const int lane = C.lane; if (C.bid < wg_lo) return;
    unsigned char* pt = C.ws + WS_PT + (size_t)l * PT_BYTES;
    for (int row = row_lo + (C.bid - wg_lo) * 8 + C.wid; row < row_hi; row += (C.G - wg_lo) * 8) {
#pragma unroll 1
        for (int tb = 0; tb < 2; ++tb) {
            const float* src = (tb ? INP(I_PV) : INP(I_PU)) + ((size_t)l * NEXP + row) * DM + lane * 16;
            f32x4 x[8]; float amax = 0.f;
#pragma unroll
            for (int c = 0; c < 2; ++c)
#pragma unroll
                for (int q = 0; q < 4; ++q) { x[c * 4 + q] = *(const f32x4*)(src + c * 1024 + q * 4);
                    amax = fmaxf(amax, fmaxf(fmaxf(fabsf(x[c * 4 + q][0]), fabsf(x[c * 4 + q][1])), fmaxf(fabsf(x[c * 4 + q][2]), fabsf(x[c * 4 + q][3])))); }
            amax = fmaxf(amax, xchg32(amax, lane)); amax = fmaxf(amax, xchg16(amax, lane)); amax = fmaxf(amax, dppmov<DPP_ROR8>(amax));
            amax = fmaxf(amax, dppmov<DPP_HMIRROR>(amax)); amax = fmaxf(amax, dppmov<DPP_Q3210>(amax)); amax = fmaxf(amax, dppmov<DPP_Q1032>(amax));
            const float sc = amax > 0.f ? 224.0f / amax : 1.0f, inv = amax > 0.f ? amax * (1.0f / 224.0f) : 1.0f;
            unsigned char* dst = pt + (tb ? PT_V8 : PT_U8) + (size_t)(lane >> 3) * ((size_t)NEXP * 128) + (size_t)row * 128 + (lane & 7) * 16;
#pragma unroll
            for (int c = 0; c < 2; ++c) { u32x4 w;
#pragma unroll
                for (int q = 0; q < 4; ++q) { const f32x4 v = x[c * 4 + q] * sc; int p = __builtin_amdgcn_cvt_pk_fp8_f32(v[0], v[1], 0, false); p = __builtin_amdgcn_cvt_pk_fp8_f32(v[2], v[3], p, true); w[q] = (unsigned)p; }
                *(u32x4*)(dst + (size_t)c * 8 * ((size_t)NEXP * 128)) = w; }
            if (lane == 0) ((float*)(pt + (tb ? PT_SCV : PT_SCU)))[row] = inv;
        }
    }
}

template <bool FIRST, bool F8OUT = false> __device__ __forceinline__ void phase_norm_mod(const Ctx& C, const float* gvec, const float* modl  , int shift_off, int scale_off) {
    float* xs = WSP(float, WS_XS); bf16_t* hb = WSP(bf16_t, WS_HB);
    f32x4 vn[8];
#define NM_LOAD(R) do { const float* xr_ = FIRST ? src_row(C, (R)) : xs + (size_t)(R) * DM; \
        _Pragma("unroll") for (int c = 0; c < 4; ++c) { vn[2 * c] = *(const f32x4*)(xr_ + c * 512 + C.lane * 8); vn[2 * c + 1] = *(const f32x4*)(xr_ + c * 512 + C.lane * 8 + 4); } } while (0)
    { const int r0 = C.bid * 8 + C.wid; if (r0 < TT) NM_LOAD(r0); }
    for (int r = C.bid * 8 + C.wid; r < TT; r += C.G * 8) {
        const float* mv = modl + (size_t)mod_sel(r) * 12288;
        f32x4 v[8]; float ss = 0.f;
#pragma unroll
        for (int c = 0; c < 8; ++c) v[c] = vn[c];
        if (r + C.G * 8 < TT) NM_LOAD(r + C.G * 8);
        __builtin_amdgcn_sched_barrier(0);
#pragma unroll
        for (int c = 0; c < 8; ++c) ss += v[c][0] * v[c][0] + v[c][1] * v[c][1] + v[c][2] * v[c][2] + v[c][3] * v[c][3];
        ss = wave_sum(ss);
        const float rs = rsqrtf(ss * (1.0f / DM) + NORM_EPS);
#pragma unroll
        for (int c = 0; c < 4; ++c) { const int col = c * 512 + C.lane * 8;
            if (FIRST) { *(f32x4*)(xs + (size_t)r * DM + col) = v[2 * c]; *(f32x4*)(xs + (size_t)r * DM + col + 4) = v[2 * c + 1]; }
            float o[8];
#pragma unroll
            for (int h = 0; h < 2; ++h) { const f32x4 g = *(const f32x4*)(gvec + col + 4 * h), s = *(const f32x4*)(mv + scale_off + col + 4 * h), t = *(const f32x4*)(mv + shift_off + col + 4 * h);
#pragma unroll
                for (int j = 0; j < 4; ++j) o[4 * h + j] = v[2 * c + h][j] * rs * g[j] * (1.0f + s[j]) + t[j]; }
            if constexpr (F8OUT) {
                int p0 = __builtin_amdgcn_cvt_pk_fp8_f32(o[0], o[1], 0, false); p0 = __builtin_amdgcn_cvt_pk_fp8_f32(o[2], o[3], p0, true);
                int p1 = __builtin_amdgcn_cvt_pk_fp8_f32(o[4], o[5], 0, false); p1 = __builtin_amdgcn_cvt_pk_fp8_f32(o[6], o[7], p1, true);
                u32x2 w; w.x = (unsigned)p0; w.y = (unsigned)p1; *(u32x2*)((unsigned char*)hb + (size_t)r * DM + col) = w;
            } else {
            u32x4 w; w.x = cvt_pk_bf16(o[0], o[1]); w.y = cvt_pk_bf16(o[2], o[3]); w.z = cvt_pk_bf16(o[4], o[5]); w.w = cvt_pk_bf16(o[6], o[7]);
            *(u32x4*)(hb + (size_t)r * DM + col) = w; } }
    }
}
#undef NM_LOAD

__device__ __forceinline__ void phase_post_p(const Ctx& C, int l) {
    bf16_t* P = WSP(bf16_t, WS_P); const float* ta = WSP(float, WS_TABA); const float* tm = WSP(float, WS_TABM);
    const float* qg = INP(I_QNG) + l * 128; const float* kg = INP(I_KNG) + l * 128;
    const float* mqg = INP(I_MQNG) + l * 512; const float* mkvg = INP(I_MKVNG) + l * 512;
    const int lane = C.lane;
    const float qg1 = qg[lane], qg2 = qg[lane + 64], kg1 = kg[lane], kg2 = kg[lane + 64];
    for (int r = C.bid * 8 + C.wid; r < TT; r += C.G * 8) {
        bf16_t* pr = P + (size_t)r * NP;
        const int j = r % RPB; const bool lat = j >= CTXL; const int pos = lat ? j - CTXL : 0, ri = pos >> 6, ci = pos & 63;
        float cs = 1.f, sn = 0.f;
        if (lat) { const int p = lane < 32 ? ri : ci, f = lane & 31; cs = ta[p * 32 + f]; sn = ta[128 * 32 + p * 32 + f]; }
#pragma unroll
        for (int h = 0; h < 10; ++h) {
            bf16_t* hp = pr + (h < 8 ? C_AQ + h * 128 : C_AK + (h - 8) * 128);
            const float x1 = bf2f(hp[lane]), x2 = bf2f(hp[lane + 64]);
            const float ss = wave_sum(x1 * x1 + x2 * x2);
            const float rs = rsqrtf(ss * (1.0f / 128.0f) + NORM_EPS);
            const float y1 = x1 * rs * (h < 8 ? qg1 : kg1), y2 = x2 * rs * (h < 8 ? qg2 : kg2);
            const float z1 = y1 * cs - y2 * sn, z2 = y2 * cs + y1 * sn;
            hp[lane] = f2bf(z1); hp[lane + 64] = f2bf(z2);
            if (h >= 8) { unsigned char* k8 = C.ws + WS_AK8 + (size_t)r * 256 + (h - 8) * 128;
                k8[lane] = (unsigned char)(__builtin_amdgcn_cvt_pk_fp8_f32(z1, 0.f, 0, false) & 0xff); k8[lane + 64] = (unsigned char)(__builtin_amdgcn_cvt_pk_fp8_f32(z2, 0.f, 0, false) & 0xff); }
        }
#pragma unroll
        for (int s = 0; s < 2; ++s) {
            bf16_t* sp = pr + (s == 0 ? C_MCQ : C_MCKV) + lane * 8; const float* gg = (s == 0 ? mqg : mkvg) + lane * 8;
            const u32x4 w = *(const u32x4*)sp; float x[8] = {bflo(w.x), bfhi(w.x), bflo(w.y), bfhi(w.y), bflo(w.z), bfhi(w.z), bflo(w.w), bfhi(w.w)};
            float ss = 0.f;
#pragma unroll
            for (int i = 0; i < 8; ++i) ss += x[i] * x[i];
            ss = wave_sum(ss);
            const float rs = rsqrtf(ss * (1.0f / 512.0f) + NORM_EPS);
#pragma unroll
            for (int i = 0; i < 8; ++i) x[i] = x[i] * rs * gg[i];
            u32x4 o; o.x = cvt_pk_bf16(x[0], x[1]); o.y = cvt_pk_bf16(x[2], x[3]); o.z = cvt_pk_bf16(x[4], x[5]); o.w = cvt_pk_bf16(x[6], x[7]);
            *(u32x4*)sp = o;
        }
        { bf16_t* kp = pr + C_MKR; const int i = lane & 31; const float x1 = bf2f(kp[i]), x2 = bf2f(kp[i + 32]);
          float c2 = 1.f, s2 = 0.f; if (lat) { const int p = i < 16 ? ri : ci, f = i & 15; c2 = tm[p * 16 + f]; s2 = tm[128 * 16 + p * 16 + f]; }
          const float z1 = x1 * c2 - x2 * s2, z2 = x2 * c2 + x1 * s2;
          if (lane < 32) { if (lat) { kp[i] = f2bf(z1); kp[i + 32] = f2bf(z2); }
              unsigned char* k8 = C.ws + WS_KR8 + (size_t)r * 64; k8[i] = (unsigned char)(__builtin_amdgcn_cvt_pk_fp8_f32(z1, 0.f, 0, false) & 0xff); k8[i + 32] = (unsigned char)(__builtin_amdgcn_cvt_pk_fp8_f32(z2, 0.f, 0, false) & 0xff); } }
    }
}

typedef int i32x8 __attribute__((ext_vector_type(8)));
typedef int i32x4 __attribute__((ext_vector_type(4)));
namespace att {
constexpr int NW = 8, QBLK = 32, KVBLK = 64, DV = 128;
constexpr float THR = 8.f;
#define SBAR() __builtin_amdgcn_sched_barrier(0)
__device__ __forceinline__ int crow(int r, int hi) { return (r & 3) + 8 * (r >> 2) + 4 * hi; }
template <int DQ> struct Cf {
    static constexpr int ND0 = DQ / 16, KROWB = DQ * 2, SHM_K = KVBLK * DQ * 2, SHM_V = KVBLK * DV * 2, SHM = 2 * SHM_V + 2 * SHM_K + NW * 64 * 4;
    static constexpr float SCALE = DQ == 128 ? 0.088388347648318440f : 0.072168783648703220f;
    __device__ static __forceinline__ int kswz(int row, int colB) { return row * KROWB + (colB ^ ((row & 7) << 4)); }
};
template <int DQ, int VAR = 0> __device__ __forceinline__ void partialSM(f32x16& p0, f32x16& p1, float& m_reg, float& mn, float& alpha, const float thr = THR, const float eoff = 0.f) {
    constexpr float SC = Cf<DQ>::SCALE, Cc = SC * 1.4426950408889634f;
    float pmax = p0[0];
#pragma unroll
    for (int r = 1; r < 16; ++r) pmax = fmaxf(pmax, p0[r]);
#pragma unroll
    for (int r = 0; r < 16; ++r) pmax = fmaxf(pmax, p1[r]);
    { auto rr = __builtin_amdgcn_permlane32_swap(__float_as_uint(pmax), __float_as_uint(pmax), false, false);
      pmax = fmaxf(__uint_as_float(rr[0]), __uint_as_float(rr[1])); }
    if (__builtin_expect(__all(pmax - m_reg <= thr / SC), 1)) { mn = m_reg; alpha = 1.f; }
    else { mn = fmaxf(m_reg, pmax); alpha = __builtin_amdgcn_exp2f((m_reg - mn) * Cc); m_reg = mn; }
    const float mnC = eoff - mn * Cc;
#pragma unroll
    for (int r = 0; r < 16; ++r) p0[r] = fmaf(p0[r], Cc, mnC);
#pragma unroll
    for (int r = 0; r < 16; ++r) p1[r] = fmaf(p1[r], Cc, mnC);
#pragma unroll
    for (int r = 0; r < 16; ++r) p0[r] = VAR == 1 ? p0[r] * 0.001f : __builtin_amdgcn_exp2f(p0[r]);
}
template <int VAR = 0> __device__ __forceinline__ void finishSM(f32x16& p0, f32x16& p1, float alpha, float& l_reg, bf16x8& pa0, bf16x8& pa1, bf16x8& pa2, bf16x8& pa3) {
#pragma unroll
    for (int r = 0; r < 16; ++r) p1[r] = VAR == 1 ? p1[r] * 0.001f : __builtin_amdgcn_exp2f(p1[r]);
    float ps = 0;
#pragma unroll
    for (int r = 0; r < 16; ++r) ps += p0[r];
#pragma unroll
    for (int r = 0; r < 16; ++r) ps += p1[r];
    { auto rr = __builtin_amdgcn_permlane32_swap(__float_as_uint(ps), __float_as_uint(ps), false, false);
      ps = __uint_as_float(rr[0]) + __uint_as_float(rr[1]); }
    l_reg = l_reg * alpha + ps;
#define PK4(P, BASE, OUT) do { unsigned a0 = cvt_pk_bf16(P[BASE + 0], P[BASE + 1]), a1 = cvt_pk_bf16(P[BASE + 2], P[BASE + 3]);   \
    unsigned b0 = cvt_pk_bf16(P[BASE + 4], P[BASE + 5]), b1 = cvt_pk_bf16(P[BASE + 6], P[BASE + 7]);                              \
    auto r0 = __builtin_amdgcn_permlane32_swap(a0, b0, false, false); auto r1 = __builtin_amdgcn_permlane32_swap(a1, b1, false, false); \
    u32x4 w = {r0[0], r1[0], r0[1], r1[1]}; OUT = *reinterpret_cast<bf16x8*>(&w); } while (0)
    PK4(p0, 0, pa0); PK4(p0, 8, pa1); PK4(p1, 0, pa2); PK4(p1, 8, pa3);
#undef PK4
}
template <int DQ> __device__ __forceinline__ void qkt(f32x16& p0, f32x16& p1, const char* Ks, const bf16x8* qr, const char* qx, int r32, int hi) {
    p0 = f32x16{}; p1 = f32x16{};
#pragma unroll
    for (int d0 = 0; d0 < Cf<DQ>::ND0; ++d0) { const int cb = (d0 * 16 + hi * 8) * 2;
        const bf16x8 b0 = *reinterpret_cast<const bf16x8*>(Ks + Cf<DQ>::kswz(r32, cb));
        const bf16x8 b1 = *reinterpret_cast<const bf16x8*>(Ks + Cf<DQ>::kswz(32 + r32, cb));
        constexpr int NQR = DQ == 192 ? MLA_NQR : 8;
        bf16x8 q; if (d0 < NQR) q = qr[d0]; else q = *reinterpret_cast<const bf16x8*>(qx + (d0 - NQR) * 1024);
        p0 = __builtin_amdgcn_mfma_f32_32x32x16_bf16(b0, q, p0, 0, 0, 0);
        p1 = __builtin_amdgcn_mfma_f32_32x32x16_bf16(b1, q, p1, 0, 0, 0); }
}
__device__ __forceinline__ int v_st(int k, int c) { const int kk = (k & ~0xC) | ((k & 4) << 1) | ((k & 8) >> 1); return ((kk >> 3) * 4 + (c >> 5)) * 512 + ((kk & 7) * 32 + (c & 31)) * 2; }
__device__ __forceinline__ int v_rd_base(int lane) { return ((lane & 3) << 3) | (((lane >> 2) & 3) << 6) | (((lane >> 4) & 1) << 5) | (((lane >> 5) & 1) << 8); }
constexpr int v_rd_off(int d0, int ks, int half) { return d0 * 512 + ks * 4096 + half * 2048; }
template <int OFF> __device__ __forceinline__ s16x4 tr_read(int vb) {
    s16x4 r; asm volatile("ds_read_b64_tr_b16 %0, %1 offset:%2" : "=&v"(r) : "v"(vb), "i"(OFF) : "memory"); return r;
}
template <int D0> __device__ __forceinline__ void pv_one(f32x16& od, int vb, bf16x8 pa0, bf16x8 pa1, bf16x8 pa2, bf16x8 pa3) {
    const s16x4 l0 = tr_read<v_rd_off(D0, 0, 0)>(vb), h0 = tr_read<v_rd_off(D0, 0, 1)>(vb), l1 = tr_read<v_rd_off(D0, 1, 0)>(vb), h1 = tr_read<v_rd_off(D0, 1, 1)>(vb);
    const s16x4 l2 = tr_read<v_rd_off(D0, 2, 0)>(vb), h2 = tr_read<v_rd_off(D0, 2, 1)>(vb), l3 = tr_read<v_rd_off(D0, 3, 0)>(vb), h3 = tr_read<v_rd_off(D0, 3, 1)>(vb);
    asm volatile("s_waitcnt lgkmcnt(0)" ::: "memory"); SBAR();
#define PK(L, H) (bf16x8){L[0], L[1], L[2], L[3], H[0], H[1], H[2], H[3]}
    od = __builtin_amdgcn_mfma_f32_32x32x16_bf16(pa0, PK(l0, h0), od, 0, 0, 0);
    od = __builtin_amdgcn_mfma_f32_32x32x16_bf16(pa1, PK(l1, h1), od, 0, 0, 0);
    od = __builtin_amdgcn_mfma_f32_32x32x16_bf16(pa2, PK(l2, h2), od, 0, 0, 0);
    od = __builtin_amdgcn_mfma_f32_32x32x16_bf16(pa3, PK(l3, h3), od, 0, 0, 0);
#undef PK
}
__device__ __forceinline__ void pv_d0(f32x16* o, int vb, bf16x8 pa0, bf16x8 pa1, bf16x8 pa2, bf16x8 pa3) {
    pv_one<0>(o[0], vb, pa0, pa1, pa2, pa3); pv_one<1>(o[1], vb, pa0, pa1, pa2, pa3); pv_one<2>(o[2], vb, pa0, pa1, pa2, pa3); pv_one<3>(o[3], vb, pa0, pa1, pa2, pa3);
}
__device__ __forceinline__ bf16x8 ld8(const bf16_t* p) { return *reinterpret_cast<const bf16x8*>(p); }

template <int DQ, int SD, int VAR = 0>
__device__ __forceinline__ void attn_body(const bf16_t* __restrict__ Qb, int ldq, const bf16_t* __restrict__ Kn, int ldkn, const bf16_t* __restrict__ Kr, int ldkr,
                                          const bf16_t* __restrict__ Vh, int ldv, unsigned char* __restrict__ Ob, int ldo, int seq, bool rope_q, int pos0, const float* __restrict__ tabM, char* lds, const int tid) {
    using CF = Cf<DQ>; constexpr int ND0 = CF::ND0, SHM_V = CF::SHM_V, SHM_K = CF::SHM_K;
    const int wid = tid >> 6, lane = tid & 63, r32 = lane & 31, hi = lane >> 5;
    char* V_lds = lds; char* K_lds = lds + 2 * SHM_V;
    float* ws = (float*)(lds + 2 * SHM_V + 2 * SHM_K) + wid * 64; float* li_l = ws; float* al_l = ws + 32;
    constexpr int NQR = DQ == 192 ? MLA_NQR : 8;
    float m_reg = -1e30f, l_reg = 0; f32x16 o[4] = {}; bf16x8 qr[NQR];
    const bf16_t* Qw = Qb + (long)(wid * QBLK + r32) * ldq + hi * 8;
#pragma unroll
    for (int d0 = 0; d0 < NQR; ++d0) qr[d0] = ld8(Qw + d0 * 16);
    char* qx = lds + CF::SHM + wid * 8192 + lane * 16;
    if constexpr (DQ == 192) {
#pragma unroll
        for (int d0 = NQR; d0 < 8; ++d0) *(bf16x8*)(qx + (d0 - NQR) * 1024) = ld8(Qw + d0 * 16);
        bf16x8 qe[4];
#pragma unroll
        for (int d0 = 0; d0 < 4; ++d0) qe[d0] = ld8(Qw + (8 + d0) * 16);
        if (rope_q) {
            const int pos = pos0 + wid * QBLK + r32, ri = pos >> 6, ci = pos & 63;
#pragma unroll
            for (int t = 0; t < 2; ++t) { const int p = t == 0 ? ri : ci; const float* tc = tabM + p * 16 + hi * 8; const float* tsn = tabM + 128 * 16 + p * 16 + hi * 8;
                bf16x8 a = qe[t], b = qe[2 + t];
#pragma unroll
                for (int jj = 0; jj < 8; ++jj) { const float x1 = bf2f((bf16_t)a[jj]), x2 = bf2f((bf16_t)b[jj]), c = tc[jj], s = tsn[jj];
                    a[jj] = (short)f2bf(x1 * c - x2 * s); b[jj] = (short)f2bf(x2 * c + x1 * s); }
                qe[t] = a; qe[2 + t] = b; }
        }
#pragma unroll
        for (int d0 = 0; d0 < 4; ++d0) *(bf16x8*)(qx + (8 - NQR + d0) * 1024) = qe[d0];
    }
    const int sr = tid >> 4, sc = (tid & 15) * 8, vst0 = v_st(sr, sc), vst1 = v_st(32 + sr, sc);
    const int sr2 = tid >> 3, sc2 = (tid & 7) * 8;
    const int vb0 = (int)(uintptr_t)V_lds + v_rd_base(lane);
    struct { bf16x8 vs0, vs1, ks0, ks1, ks2; } sr_[SD];
    const unsigned offV = (unsigned)(sr * ldv + sc) * 2u, offK = (unsigned)(sr * ldkn + sc) * 2u, offR = (unsigned)(sr2 * ldkr + sc2) * 2u;
#define SLOAD(i, k0) do { const char* vt_ = (const char*)Vh + (size_t)(k0) * ldv * 2; const char* kt_ = (const char*)Kn + (size_t)(k0) * ldkn * 2; \
    sr_[i].vs0 = *(const bf16x8*)(vt_ + offV); sr_[i].vs1 = *(const bf16x8*)(vt_ + (size_t)32 * ldv * 2 + offV); \
    sr_[i].ks0 = *(const bf16x8*)(kt_ + offK); sr_[i].ks1 = *(const bf16x8*)(kt_ + (size_t)32 * ldkn * 2 + offK); \
    if constexpr (DQ == 192) sr_[i].ks2 = *(const bf16x8*)((const char*)Kr + (size_t)(k0) * ldkr * 2 + offR); } while (0)
#define SWRITE(b, i) do { *(bf16x8*)(V_lds + (b) * SHM_V + vst0) = sr_[i].vs0; *(bf16x8*)(V_lds + (b) * SHM_V + vst1) = sr_[i].vs1; const int kc = sc * 2; \
    *(bf16x8*)(K_lds + (b) * SHM_K + CF::kswz(sr, kc)) = sr_[i].ks0; *(bf16x8*)(K_lds + (b) * SHM_K + CF::kswz(32 + sr, kc)) = sr_[i].ks1; \
    if constexpr (DQ == 192) *(bf16x8*)(K_lds + (b) * SHM_K + CF::kswz(sr2, 256 + sc2 * 2)) = sr_[i].ks2; } while (0)
#define SWAIT() do { if constexpr (SD == 1) asm volatile("s_waitcnt vmcnt(0)" ::: "memory"); else if constexpr (DQ == 192) asm volatile("s_waitcnt vmcnt(5)" ::: "memory"); else asm volatile("s_waitcnt vmcnt(4)" ::: "memory"); } while (0)
#define RESC(a) do { if (__any((a) < 1.f)) { if (hi == 0) al_l[r32] = (a); asm volatile("s_waitcnt lgkmcnt(0)" ::: "memory"); \
    _Pragma("unroll") for (int d = 0; d < 4; ++d) _Pragma("unroll") for (int r = 0; r < 16; ++r) o[d][r] *= al_l[crow(r, hi)]; } } while (0)
    f32x16 pA0, pA1, pB0, pB1; float mnA, mnB, alA, alB; bf16x8 pa0, pa1, pa2, pa3; const int NT = seq / KVBLK;
    constexpr int SE = 0, SO = SD - 1;
    SLOAD(SE, 0); asm volatile("s_waitcnt vmcnt(0)" ::: "memory"); SWRITE(0, SE); __syncthreads();
    qkt<DQ>(pA0, pA1, K_lds, qr, qx, r32, hi); partialSM<DQ, VAR>(pA0, pA1, m_reg, mnA, alA);
    SLOAD(SO, KVBLK); if constexpr (SD == 2) { if (2 < NT) SLOAD(SE, 2 * KVBLK); }
    SWAIT(); SWRITE(1, SO); __syncthreads();
#define ATT_SYNC() do { if constexpr (VAR != 2) __syncthreads(); } while (0)
    for (int j = 1; j + 1 < NT; j += 2) {
        SBAR(); qkt<DQ>(pB0, pB1, K_lds + SHM_K, qr, qx, r32, hi);
        finishSM<VAR>(pA0, pA1, alA, l_reg, pa0, pa1, pa2, pa3); SBAR();
        if constexpr (VAR != 3) SLOAD(SO, (j + SD) * KVBLK); SBAR();
        pv_d0(o, vb0, pa0, pa1, pa2, pa3); partialSM<DQ, VAR>(pB0, pB1, m_reg, mnB, alB);
        ATT_SYNC(); SWAIT(); SWRITE(0, SE);
        RESC(alB); ATT_SYNC();
        SBAR(); qkt<DQ>(pA0, pA1, K_lds, qr, qx, r32, hi);
        finishSM<VAR>(pB0, pB1, alB, l_reg, pa0, pa1, pa2, pa3); SBAR();
        if constexpr (VAR != 3) { if (SD == 1 || j + 3 < NT) SLOAD(SE, (j + 1 + SD) * KVBLK); } SBAR();
        pv_d0(o, vb0 + SHM_V, pa0, pa1, pa2, pa3); partialSM<DQ, VAR>(pA0, pA1, m_reg, mnA, alA);
        ATT_SYNC(); SWAIT(); SWRITE(1, SO);
        RESC(alA); ATT_SYNC();
    }
    SBAR(); qkt<DQ>(pB0, pB1, K_lds + SHM_K, qr, qx, r32, hi);
    finishSM<VAR>(pA0, pA1, alA, l_reg, pa0, pa1, pa2, pa3); SBAR();
    pv_d0(o, vb0, pa0, pa1, pa2, pa3); partialSM<DQ, VAR>(pB0, pB1, m_reg, mnB, alB);
    ATT_SYNC(); RESC(alB);
    finishSM<VAR>(pB0, pB1, alB, l_reg, pa0, pa1, pa2, pa3); SBAR();
    pv_d0(o, vb0 + SHM_V, pa0, pa1, pa2, pa3);
    if (hi == 0) li_l[r32] = l_reg; asm volatile("s_waitcnt lgkmcnt(0)" ::: "memory");
    float rli[16];
#pragma unroll
    for (int r = 0; r < 16; ++r) rli[r] = __builtin_amdgcn_rcpf(li_l[crow(r, hi)]);
    unsigned char* Ow = Ob + (long)(wid * QBLK) * ldo;
#pragma unroll
    for (int r = 0; r < 16; ++r) { const int orow = crow(r, hi);
#pragma unroll
        for (int d0 = 0; d0 < 4; ++d0) Ow[(long)orow * ldo + d0 * 32 + r32] = (unsigned char)(__builtin_amdgcn_cvt_pk_fp8_f32(o[d0][r] * rli[r] * 32.0f, 0.f, 0, false) & 0xff); }
#undef SLOAD
#undef ATT_SYNC
#undef SWRITE
#undef SWAIT
#undef RESC
}

__device__ __forceinline__ int k8addr(int row, int b, int DQ_) { return row * DQ_ + (b < 128 ? (b ^ ((row & 7) << 4)) : 128 + ((b - 128) ^ ((row & 3) << 4))); }
#define MX32(ACC, A, B, SC) asm volatile("s_nop 1\n\tv_mfma_scale_f32_32x32x64_f8f6f4 %0, %1, %2, %0, %3, %3 op_sel_hi:[0,0,0]" : "+v"(ACC) : "v"(A), "v"(B), "v"(SC))
#define MX32Z(ACC, A, B, SC) asm volatile("v_mfma_scale_f32_32x32x64_f8f6f4 %0, %1, %2, 0, %3, %3 op_sel_hi:[0,0,0]" : "=&v"(ACC) : "v"(A), "v"(B), "v"(SC))
template <int DQ, bool NOPS = true> __device__ __forceinline__ void qkt8(f32x16& p0, f32x16& p1, const char* Ks, const i32x8* qf, int r32, int hi) {
    int mxs = 0x7f7f7f7f; asm volatile("" : "+v"(mxs));
#pragma unroll
    for (int ks = 0; ks < DQ / 64; ++ks) { const int b = ks * 64 + hi * 32;
        const i32x4 a0l = *reinterpret_cast<const i32x4*>(Ks + k8addr(r32, b, DQ)), a0h = *reinterpret_cast<const i32x4*>(Ks + k8addr(r32, b + 16, DQ));
        const i32x4 a1l = *reinterpret_cast<const i32x4*>(Ks + k8addr(32 + r32, b, DQ)), a1h = *reinterpret_cast<const i32x4*>(Ks + k8addr(32 + r32, b + 16, DQ));
        const i32x8 a0 = __builtin_shufflevector(a0l, a0h, 0, 1, 2, 3, 4, 5, 6, 7), a1 = __builtin_shufflevector(a1l, a1h, 0, 1, 2, 3, 4, 5, 6, 7);
        if (ks == 0) { MX32Z(p0, a0, qf[ks], mxs); MX32Z(p1, a1, qf[ks], mxs); } else { MX32(p0, a0, qf[ks], mxs); MX32(p1, a1, qf[ks], mxs); } }
    if (NOPS) asm volatile("s_nop 15\n\ts_nop 7");
}
__device__ __forceinline__ int pk4_fp8(float a, float b, float c, float d) { int p = __builtin_amdgcn_cvt_pk_fp8_f32(a, b, 0, false); return __builtin_amdgcn_cvt_pk_fp8_f32(c, d, p, true); }
__device__ __forceinline__ int pk4_fp8u(float a, float b, float c, float d) { int u; asm volatile("" : "=v"(u)); const int p = __builtin_amdgcn_cvt_pk_fp8_f32(a, b, u, false); return __builtin_amdgcn_cvt_pk_fp8_f32(c, d, p, true); }
template <int DQ>
__device__ __forceinline__ void attn_body8(const bf16_t* __restrict__ Qb, int ldq, const unsigned char* __restrict__ Kn8, int ldkn, const unsigned char* __restrict__ Kr8, int ldkr,
                                           const bf16_t* __restrict__ Vh, int ldv, unsigned char* __restrict__ Ob, int ldo, int seq, bool rope_q, int pos0, const float* __restrict__ tabM, char* lds, const int tid) {
    constexpr int NKS = DQ / 64, SHM_V = KVBLK * DV * 2, SHM_K = KVBLK * DQ;
    const int wid = tid >> 6, lane = tid & 63, r32 = lane & 31, hi = lane >> 5;
    char* V_lds = lds; char* K_lds = lds + 2 * SHM_V;
    float* ws = (float*)(lds + 2 * SHM_V + 2 * SHM_K) + wid * 64; float* li_l = ws; float* al_l = ws + 32;
    float m_reg = -1e30f, l_reg = 0; f32x16 o[4] = {}; i32x8 qf[NKS];
    const bf16_t* Qrow = Qb + (long)(wid * QBLK + r32) * ldq;
#pragma unroll
    for (int ks = 0; ks < NKS; ++ks) {
        float x[32];
#pragma unroll
        for (int c = 0; c < 4; ++c) { const u32x4 w = *(const u32x4*)(Qrow + ks * 64 + hi * 32 + c * 8);
            x[c * 8 + 0] = bflo(w.x); x[c * 8 + 1] = bfhi(w.x); x[c * 8 + 2] = bflo(w.y); x[c * 8 + 3] = bfhi(w.y); x[c * 8 + 4] = bflo(w.z); x[c * 8 + 5] = bfhi(w.z); x[c * 8 + 6] = bflo(w.w); x[c * 8 + 7] = bfhi(w.w); }
        if (DQ == 192 && ks == 2 && rope_q) {
            float y[32];
#pragma unroll
            for (int c = 0; c < 4; ++c) { const u32x4 w = *(const u32x4*)(Qrow + 128 + (1 - hi) * 32 + c * 8);
                y[c * 8 + 0] = bflo(w.x); y[c * 8 + 1] = bfhi(w.x); y[c * 8 + 2] = bflo(w.y); y[c * 8 + 3] = bfhi(w.y); y[c * 8 + 4] = bflo(w.z); y[c * 8 + 5] = bfhi(w.z); y[c * 8 + 6] = bflo(w.w); y[c * 8 + 7] = bfhi(w.w); }
            const int pos = pos0 + wid * QBLK + r32, ri = pos >> 6, ci = pos & 63;
#pragma unroll
            for (int i = 0; i < 32; ++i) { const int p = i < 16 ? ri : ci, f = i & 15; const float c_ = tabM[p * 16 + f], s_ = tabM[128 * 16 + p * 16 + f];
                x[i] = hi ? x[i] * c_ + y[i] * s_ : x[i] * c_ - y[i] * s_; }
        }
        i32x8 q8;
#pragma unroll
        for (int j = 0; j < 8; ++j) q8[j] = pk4_fp8(x[4 * j], x[4 * j + 1], x[4 * j + 2], x[4 * j + 3]);
        qf[ks] = q8;
    }
    const int sr = tid >> 4, sc = (tid & 15) * 8, vst0 = v_st(sr, sc), vst1 = v_st(32 + sr, sc);
    const int kr = tid >> 3, kb = (tid & 7) * 16;
    const int kr2 = (tid & 255) >> 2, kb2 = (tid & 3) * 16;
    const int vb0 = (int)(uintptr_t)V_lds + v_rd_base(lane);
    struct { bf16x8 vs0, vs1; u32x4 k0, k1; } sr_[1];
    const unsigned offV = (unsigned)(sr * ldv + sc) * 2u, offK = (unsigned)(kr * ldkn + kb), offR = (unsigned)(kr2 * ldkr + kb2);
#define SLOAD8(k0_) do { const char* vt_ = (const char*)Vh + (size_t)(k0_) * ldv * 2; \
    sr_[0].vs0 = *(const bf16x8*)(vt_ + offV); sr_[0].vs1 = *(const bf16x8*)(vt_ + (size_t)32 * ldv * 2 + offV); \
    sr_[0].k0 = *(const u32x4*)(Kn8 + (size_t)(k0_) * ldkn + offK); \
    if constexpr (DQ == 192) { if (tid < 256) sr_[0].k1 = *(const u32x4*)(Kr8 + (size_t)(k0_) * ldkr + offR); } } while (0)
#define SWRITE8(b) do { *(bf16x8*)(V_lds + (b) * SHM_V + vst0) = sr_[0].vs0; *(bf16x8*)(V_lds + (b) * SHM_V + vst1) = sr_[0].vs1; \
    *(u32x4*)(K_lds + (b) * SHM_K + k8addr(kr, kb, DQ)) = sr_[0].k0; \
    if constexpr (DQ == 192) { if (tid < 256) *(u32x4*)(K_lds + (b) * SHM_K + k8addr(kr2, 128 + kb2, DQ)) = sr_[0].k1; } } while (0)
#define SWAIT8() asm volatile("s_waitcnt vmcnt(0)" ::: "memory")
#define RESC8(a) do { if (__any((a) < 1.f)) { if (hi == 0) al_l[r32] = (a); asm volatile("s_waitcnt lgkmcnt(0)" ::: "memory"); \
    _Pragma("unroll") for (int d = 0; d < 4; ++d) _Pragma("unroll") for (int r = 0; r < 16; ++r) o[d][r] *= al_l[crow(r, hi)]; } } while (0)
    f32x16 pA0, pA1, pB0, pB1; float mnA, mnB, alA, alB; bf16x8 pa0, pa1, pa2, pa3; const int NT = seq / KVBLK;
    SLOAD8(0); SWAIT8(); SWRITE8(0); __syncthreads();
    qkt8<DQ>(pA0, pA1, K_lds, qf, r32, hi); partialSM<DQ, 0>(pA0, pA1, m_reg, mnA, alA);
    SLOAD8(KVBLK);
    SWAIT8(); SWRITE8(1); __syncthreads();
    for (int j = 1; j + 1 < NT; j += 2) {
        SBAR(); qkt8<DQ>(pB0, pB1, K_lds + SHM_K, qf, r32, hi);
        finishSM<0>(pA0, pA1, alA, l_reg, pa0, pa1, pa2, pa3); SBAR();
        SLOAD8((j + 1) * KVBLK); SBAR();
        pv_d0(o, vb0, pa0, pa1, pa2, pa3); partialSM<DQ, 0>(pB0, pB1, m_reg, mnB, alB);
        __syncthreads(); SWAIT8(); SWRITE8(0);
        RESC8(alB); __syncthreads();
        SBAR(); qkt8<DQ>(pA0, pA1, K_lds, qf, r32, hi);
        finishSM<0>(pB0, pB1, alB, l_reg, pa0, pa1, pa2, pa3); SBAR();
        SLOAD8((j + 2) * KVBLK); SBAR();
        pv_d0(o, vb0 + SHM_V, pa0, pa1, pa2, pa3); partialSM<DQ, 0>(pA0, pA1, m_reg, mnA, alA);
        __syncthreads(); SWAIT8(); SWRITE8(1);
        RESC8(alA); __syncthreads();
    }
    SBAR(); qkt8<DQ>(pB0, pB1, K_lds + SHM_K, qf, r32, hi);
    finishSM<0>(pA0, pA1, alA, l_reg, pa0, pa1, pa2, pa3); SBAR();
    pv_d0(o, vb0, pa0, pa1, pa2, pa3); partialSM<DQ, 0>(pB0, pB1, m_reg, mnB, alB);
    __syncthreads(); RESC8(alB);
    finishSM<0>(pB0, pB1, alB, l_reg, pa0, pa1, pa2, pa3); SBAR();
    pv_d0(o, vb0 + SHM_V, pa0, pa1, pa2, pa3);
    if (hi == 0) li_l[r32] = l_reg; asm volatile("s_waitcnt lgkmcnt(0)" ::: "memory");
    float rli[16];
#pragma unroll
    for (int r = 0; r < 16; ++r) rli[r] = __builtin_amdgcn_rcpf(li_l[crow(r, hi)]);
    unsigned char* Ow = Ob + (long)(wid * QBLK) * ldo;
#pragma unroll
    for (int r = 0; r < 16; ++r) { const int orow = crow(r, hi);
#pragma unroll
        for (int d0 = 0; d0 < 4; ++d0) Ow[(long)orow * ldo + d0 * 32 + r32] = (unsigned char)(__builtin_amdgcn_cvt_pk_fp8_f32(o[d0][r] * rli[r] * 32.0f, 0.f, 0, false) & 0xff); }
#undef SLOAD8
#undef SWRITE8
#undef SWAIT8
#undef RESC8
}

__device__ __host__ __forceinline__ int vt8_key(int g, int j) { const int i = j & 15; return (j < 16 ? 0 : 32) + (i & 3) + 8 * (i >> 2) + 4 * g; }
template <int DQ>
__device__ __forceinline__ void attn_body88(const bf16_t* __restrict__ Qb, int ldq, const unsigned char* __restrict__ Kn8, int ldkn, const unsigned char* __restrict__ Kr8, int ldkr,
                                            const unsigned char* __restrict__ VT8, unsigned char* __restrict__ Ob, int ldo, int seq, bool rope_q, int pos0, const float* __restrict__ tabM, char* lds, const int tid) {
    constexpr int NKS = DQ / 64, SHM_V = 128 * 64, SHM_K = KVBLK * DQ;
    constexpr float EOFF = 7.0f, THR8 = 1.0f;
    const int wid = tid >> 6, lane = tid & 63, r32 = lane & 31, hi = lane >> 5;
    char* V_lds = lds; char* K_lds = lds + 2 * SHM_V;
    float* ws = (float*)(lds + 2 * SHM_V + 2 * SHM_K) + wid * 64; float* li_l = ws; float* al_l = ws + 32;
    float m_reg = -1e30f, l_reg = 0; f32x16 o[4] = {}; i32x8 qf[NKS];
    const bf16_t* Qrow = Qb + (long)(wid * QBLK + r32) * ldq;
#pragma unroll
    for (int ks = 0; ks < NKS; ++ks) {
        float x[32];
#pragma unroll
        for (int c = 0; c < 4; ++c) { const u32x4 w = *(const u32x4*)(Qrow + ks * 64 + hi * 32 + c * 8);
            x[c * 8 + 0] = bflo(w.x); x[c * 8 + 1] = bfhi(w.x); x[c * 8 + 2] = bflo(w.y); x[c * 8 + 3] = bfhi(w.y); x[c * 8 + 4] = bflo(w.z); x[c * 8 + 5] = bfhi(w.z); x[c * 8 + 6] = bflo(w.w); x[c * 8 + 7] = bfhi(w.w); }
        if (DQ == 192 && ks == 2 && rope_q) {
            float y[32];
#pragma unroll
            for (int c = 0; c < 4; ++c) { const u32x4 w = *(const u32x4*)(Qrow + 128 + (1 - hi) * 32 + c * 8);
                y[c * 8 + 0] = bflo(w.x); y[c * 8 + 1] = bfhi(w.x); y[c * 8 + 2] = bflo(w.y); y[c * 8 + 3] = bfhi(w.y); y[c * 8 + 4] = bflo(w.z); y[c * 8 + 5] = bfhi(w.z); y[c * 8 + 6] = bflo(w.w); y[c * 8 + 7] = bfhi(w.w); }
            const int pos = pos0 + wid * QBLK + r32, ri = pos >> 6, ci = pos & 63;
#pragma unroll
            for (int i = 0; i < 32; ++i) { const int p = i < 16 ? ri : ci, f = i & 15; const float c_ = tabM[p * 16 + f], s_ = tabM[128 * 16 + p * 16 + f];
                x[i] = hi ? x[i] * c_ + y[i] * s_ : x[i] * c_ - y[i] * s_; }
        }
        i32x8 q8;
#pragma unroll
        for (int j = 0; j < 8; ++j) q8[j] = pk4_fp8(x[4 * j], x[4 * j + 1], x[4 * j + 2], x[4 * j + 3]);
        qf[ks] = q8;
    }
    const int wu = __builtin_amdgcn_readfirstlane(wid);
    const unsigned lbase = __builtin_amdgcn_readfirstlane((unsigned)(uintptr_t)(LAS char*)lds), wofs = (unsigned)wu * 1024u;
    const int vr = tid >> 2;
    const unsigned offVd = (unsigned)((vr * 4 + ((tid & 3) ^ ((vr >> 2) & 3))) * 16);
    const unsigned char* kp0; const unsigned char* kp1 = nullptr; unsigned ks0, ks1 = 0;
    if constexpr (DQ == 128) { const int row = tid >> 3, c = tid & 7; kp0 = Kn8 + (size_t)row * ldkn + ((c ^ (row & 7)) << 4); ks0 = (unsigned)(KVBLK * ldkn); }
    else { { const int G = tid, row = G / 12, c = G % 12; const bool nope = c < 8;
             kp0 = nope ? Kn8 + (size_t)row * ldkn + ((c ^ (row & 7)) << 4) : Kr8 + (size_t)row * ldkr + (((c - 8) ^ (row & 3)) << 4); ks0 = (unsigned)(KVBLK * (nope ? ldkn : ldkr)); }
           { const int G = 512 + (tid & 255), row = G / 12, c = G % 12; const bool nope = c < 8;
             kp1 = nope ? Kn8 + (size_t)row * ldkn + ((c ^ (row & 7)) << 4) : Kr8 + (size_t)row * ldkr + (((c - 8) ^ (row & 3)) << 4); ks1 = (unsigned)(KVBLK * (nope ? ldkn : ldkr)); } }
#define DMA16(gp, loff) __builtin_amdgcn_global_load_lds((const unsigned*)(gp), (LAS unsigned*)(uintptr_t)(lbase + (unsigned)(loff) + wofs), 16, 0, 0)
#define DMAK(t_, b_) do { DMA16(kp0 + (size_t)(t_) * ks0, 2 * SHM_V + (b_) * SHM_K); \
        if constexpr (DQ == 192) { if (wu < 4) DMA16(kp1 + (size_t)(t_) * ks1, 2 * SHM_V + (b_) * SHM_K + 8192); } } while (0)
#define DMAV(t_, b_) DMA16(VT8 + (size_t)(t_) * 8192 + offVd, (b_) * SHM_V)
#define DWAIT() asm volatile("s_waitcnt vmcnt(0)" ::: "memory")
#define RESC8(a) do { if (__any((a) < 1.f)) { if (hi == 0) al_l[r32] = (a); asm volatile("s_waitcnt lgkmcnt(0)" ::: "memory"); \
    _Pragma("unroll") for (int d = 0; d < 4; ++d) _Pragma("unroll") for (int r = 0; r < 16; ++r) o[d][r] *= al_l[crow(r, hi)]; } } while (0)
#define FIN8(P0, P1, AL, PA) do { _Pragma("unroll") for (int r = 0; r < 16; ++r) P1[r] = __builtin_amdgcn_exp2f(P1[r]); \
    float ps_ = 0; _Pragma("unroll") for (int r = 0; r < 16; ++r) ps_ += P0[r]; _Pragma("unroll") for (int r = 0; r < 16; ++r) ps_ += P1[r]; \
    { auto rr_ = __builtin_amdgcn_permlane32_swap(__float_as_uint(ps_), __float_as_uint(ps_), false, false); ps_ = __uint_as_float(rr_[0]) + __uint_as_float(rr_[1]); } \
    l_reg = l_reg * (AL) + ps_; \
    _Pragma("unroll") for (int j = 0; j < 4; ++j) { PA[j] = pk4_fp8u(P0[4 * j], P0[4 * j + 1], P0[4 * j + 2], P0[4 * j + 3]); \
        PA[4 + j] = pk4_fp8u(P1[4 * j], P1[4 * j + 1], P1[4 * j + 2], P1[4 * j + 3]); } } while (0)
#define PV8(VB, PA, NOPS) do { int mxs_ = 0x7f7f7f7f; asm volatile("" : "+v"(mxs_)); _Pragma("unroll") for (int d0 = 0; d0 < 4; ++d0) { const int row_ = d0 * 32 + r32, xs_ = (row_ >> 2) & 3; \
        const i32x4 lo_ = *reinterpret_cast<const i32x4*>((VB) + row_ * 64 + (((2 * hi) ^ xs_) << 4)), hi_ = *reinterpret_cast<const i32x4*>((VB) + row_ * 64 + (((2 * hi + 1) ^ xs_) << 4)); \
        const i32x8 vb_ = __builtin_shufflevector(lo_, hi_, 0, 1, 2, 3, 4, 5, 6, 7); MX32(o[d0], PA, vb_, mxs_); } if (NOPS) asm volatile("s_nop 15\n\ts_nop 7"); } while (0)
    f32x16 pA0, pA1, pB0, pB1; float mnA, mnB, alA, alB; i32x8 pa; const int NT = seq / KVBLK;
#define PSM8(P0, P1, MN, AL) do { partialSM<DQ, 0>(P0, P1, m_reg, MN, AL, THR8, EOFF); RESC8(AL); } while (0)
    DMAK(0, 0); DMAV(0, 0); DMAK(1, 1); DWAIT(); __syncthreads();
    qkt8<DQ>(pA0, pA1, K_lds, qf, r32, hi); PSM8(pA0, pA1, mnA, alA);
    __syncthreads();
    for (int j = 1; j + 1 < NT; j += 2) {
        DMAK(j + 1, 0); DMAV(j, 1);
        SBAR(); qkt8<DQ, false>(pB0, pB1, K_lds + SHM_K, qf, r32, hi);
        FIN8(pA0, pA1, alA, pa); SBAR();
        PV8(V_lds, pa, 0); PSM8(pB0, pB1, mnB, alB);
        DWAIT(); __syncthreads();
        if (j + 2 < NT) DMAK(j + 2, 1);
        DMAV(j + 1, 0);
        SBAR(); qkt8<DQ, false>(pA0, pA1, K_lds, qf, r32, hi);
        FIN8(pB0, pB1, alB, pa); SBAR();
        PV8(V_lds + SHM_V, pa, 0); PSM8(pA0, pA1, mnA, alA);
        DWAIT(); __syncthreads();
    }
    DMAV(NT - 1, 1);
    SBAR(); qkt8<DQ, false>(pB0, pB1, K_lds + SHM_K, qf, r32, hi);
    FIN8(pA0, pA1, alA, pa); SBAR();
    PV8(V_lds, pa, 0); PSM8(pB0, pB1, mnB, alB);
    DWAIT(); __syncthreads();
    FIN8(pB0, pB1, alB, pa); SBAR();
    PV8(V_lds + SHM_V, pa, 1);
#undef PSM8
#undef DMA16
#undef DMAK
#undef DMAV
#undef DWAIT
    if (hi == 0) li_l[r32] = l_reg; asm volatile("s_waitcnt lgkmcnt(0)" ::: "memory");
    float rli[16];
#pragma unroll
    for (int r = 0; r < 16; ++r) rli[r] = __builtin_amdgcn_rcpf(li_l[crow(r, hi)]) * 32.0f;
    unsigned char* Ow = Ob + (long)(wid * QBLK) * ldo;
#pragma unroll
    for (int r = 0; r < 16; ++r) { const int orow = crow(r, hi);
#pragma unroll
        for (int d0 = 0; d0 < 4; ++d0) Ow[(long)orow * ldo + d0 * 32 + r32] = (unsigned char)(__builtin_amdgcn_cvt_pk_fp8_f32(o[d0][r] * rli[r], 0.f, 0, false) & 0xff); }
#undef RESC8
#undef FIN8
#undef PV8
}
#undef MX32
}

template <int KS> __device__ __forceinline__ void mma_xy(f32x16& acc, const LAS bf16_t* X, const LAS bf16_t* Y, int hi) {
#pragma unroll
    for (int ks = 0; ks < KS; ++ks) { const bf16x8 a = *(const LAS bf16x8*)(X + ks * 16 + hi * 8), b = *(const LAS bf16x8*)(Y + ks * 16 + hi * 8);
        acc = __builtin_amdgcn_mfma_f32_32x32x16_bf16(a, b, acc, 0, 0, 0); }
}
__device__ __forceinline__ float logsig16(float x) { const float e = __expf(-fabsf(x)); return (fminf(x, 0.f) - __logf(1.f + e)) * 0.0625f; }
__device__ __forceinline__ int gla_sidx(int b, int dir, int h) { return (b * 2 + dir) * 4 + h; }

__device__ __forceinline__ void gla_cumsum_lds(const Ctx& C, int l, int h, int dir, const LAS float* lr, LAS float* segtot, LAS float* CUM) {
    const int seg = C.tid >> 7, d = C.tid & 127;
    const float* wa = INP(dir ? I_WA2B : I_WA2F) + (size_t)l * 16 * 512 + h * 128 + d;
    const float bias = INP(dir ? I_BAB : I_BAF)[l * 512 + h * 128 + d];
    float w[16], cum[16];
#pragma unroll
    for (int j = 0; j < 16; ++j) w[j] = wa[j * 512];
    float run = 0.f;
#pragma unroll
    for (int i = 0; i < 16; ++i) { const int s = seg * 16 + i, tk = dir ? 63 - s : s; float pre = bias;
#pragma unroll
        for (int j = 0; j < 16; ++j) pre += lr[tk * 32 + dir * 16 + j] * w[j];
        run += logsig16(pre); cum[i] = run; }
    segtot[seg * 128 + d] = run;
    __syncthreads();
    float off = 0.f;
#pragma unroll
    for (int q = 0; q < 3; ++q) if (q < seg) off += segtot[q * 128 + d];
#pragma unroll
    for (int i = 0; i < 16; ++i) { const int s = seg * 16 + i, tk = dir ? 63 - s : s; CUM[tk * 132 + d] = cum[i] + off; }
    __syncthreads();
}
__device__ __forceinline__ void unpack8(const u32x4 w, float (&x)[8]) { x[0] = bflo(w.x); x[1] = bfhi(w.x); x[2] = bflo(w.y); x[3] = bfhi(w.y); x[4] = bflo(w.z); x[5] = bfhi(w.z); x[6] = bflo(w.w); x[7] = bfhi(w.w); }
__device__ __forceinline__ void gla_build_vt(const Ctx& C, const bf16_t* P, size_t r0, int h, LAS bf16_t* VT) {
    u32x4 v[4];
#pragma unroll
    for (int it = 0; it < 4; ++it) { const int idx = C.tid + it * NTHREADS, sv = idx >> 5, e0 = (idx & 31) * 8; v[it] = *(const u32x4*)(P + (r0 + sv) * NP + C_LV + h * 256 + e0); }
#pragma unroll
    for (int it = 0; it < 4; ++it) { const int idx = C.tid + it * NTHREADS, sv = idx >> 5, e0 = (idx & 31) * 8;
        const unsigned wd[4] = {v[it].x, v[it].y, v[it].z, v[it].w};
#pragma unroll
        for (int q = 0; q < 4; ++q) { VT[(e0 + 2 * q) * 72 + sv] = (bf16_t)(wd[q] & 0xffffu); VT[(e0 + 2 * q + 1) * 72 + sv] = (bf16_t)(wd[q] >> 16); } }
}

__device__ __forceinline__ void phase_gla_local(const Ctx& C, int l, int rot) {
    const bf16_t* P = WSP(bf16_t, WS_P); bf16_t* GST = WSP(bf16_t, WS_GST); float* GDEC = WSP(float, WS_GDEC);
    LAS float* lr = (LAS float*)C.lds;
    LAS float* segtot = (LAS float*)(C.lds + 8192);
    LAS bf16_t* KT = (LAS bf16_t*)(C.lds + 10240);
    LAS bf16_t* VT = (LAS bf16_t*)(C.lds + 28672);
    LAS float* CUM = (LAS float*)(C.lds + 65536);
    const int r32 = C.lane & 31, hi = C.lane >> 5, d = C.tid & 127;
    const int btk = C.tid >> 3, bdg = (C.tid & 7) * 16;
    for (int unit = (C.bid + C.G - rot % C.G) % C.G; unit < NBATCH * 4 * NCH; unit += C.G) {
        const int b = unit / (4 * NCH), h = (unit / NCH) % 4, ck = unit % NCH; const size_t r0 = (size_t)b * RPB + ck * 64;
        for (int i = C.tid; i < 64 * 32; i += NTHREADS) lr[i] = bf2f(P[(r0 + (i >> 5)) * NP + C_LRF + (i & 31)]);
        const u32x4 kw0 = *(const u32x4*)(P + (r0 + btk) * NP + C_LK + h * 128 + bdg), kw1 = *(const u32x4*)(P + (r0 + btk) * NP + C_LK + h * 128 + bdg + 8);
        gla_build_vt(C, P, r0, h, VT);
        __syncthreads();
#pragma unroll 1
        for (int dir = 0; dir < 2; ++dir) {
            gla_cumsum_lds(C, l, h, dir, lr, segtot, CUM);
            const int tend = dir ? 0 : 63;
            const size_t sx = (size_t)gla_sidx(b, dir, h) * NCH + ck;
            if (C.tid < 128) GDEC[sx * 128 + d] = __expf(CUM[tend * 132 + d]);
            { float kf[16]; { float t8[8]; unpack8(kw0, t8);
#pragma unroll
                for (int i = 0; i < 8; ++i) kf[i] = t8[i]; unpack8(kw1, t8);
#pragma unroll
                for (int i = 0; i < 8; ++i) kf[8 + i] = t8[i]; }
#pragma unroll
              for (int q = 0; q < 4; ++q) { const f32x4 cm = *(const LAS f32x4*)(CUM + btk * 132 + bdg + 4 * q), be = *(const LAS f32x4*)(CUM + tend * 132 + bdg + 4 * q);
#pragma unroll
                  for (int i = 0; i < 4; ++i) KT[(bdg + 4 * q + i) * 72 + btk] = f2bf(kf[4 * q + i] * __expf(be[i] - cm[i])); } }
            __syncthreads();
            { const int dt = C.wid & 3, eb = (C.wid >> 2) * 4;
              f32x16 acc[4] = {};
#pragma unroll
              for (int q = 0; q < 4; ++q) mma_xy<4>(acc[q], KT + (dt * 32 + r32) * 72, VT + ((eb + q) * 32 + r32) * 72, hi);
              bf16_t* st = GST + sx * 32768;
#pragma unroll
              for (int q = 0; q < 4; ++q)
#pragma unroll
                  for (int g = 0; g < 4; ++g) { u32x2 w; w.x = cvt_pk_bf16(acc[q][4 * g], acc[q][4 * g + 1]); w.y = cvt_pk_bf16(acc[q][4 * g + 2], acc[q][4 * g + 3]);
                      *(u32x2*)(st + (size_t)((eb + q) * 32 + r32) * 128 + dt * 32 + 8 * g + 4 * hi) = w; } }
            __syncthreads();
        }
    }
}

__device__ __forceinline__ void phase_gla_scan(const Ctx& C) {
    bf16_t* GST = WSP(bf16_t, WS_GST); const float* GDEC = WSP(float, WS_GDEC);
    for (int gid = C.bid * NTHREADS + C.tid; gid < 16 * 8192; gid += C.G * NTHREADS) {
        const int sidx = gid >> 13, g = gid & 8191, dir = (sidx >> 2) & 1, d4 = (g & 31) * 4;
        bf16_t* base = GST + (size_t)sidx * NCH * 32768 + (size_t)g * 4;
        const float* dbase = GDEC + (size_t)sidx * NCH * 128 + d4;
        float S[4] = {0.f, 0.f, 0.f, 0.f};
        for (int st = 0; st < NCH; st += 4) {
            int ck[4]; u32x2 L[4]; f32x4 dc[4];
#pragma unroll
            for (int q = 0; q < 4; ++q) { const int s = st + q; ck[q] = dir ? (s < 4 ? 3 - s : NCH + 3 - s) : s;
                L[q] = *(const u32x2*)(base + (size_t)ck[q] * 32768); dc[q] = *(const f32x4*)(dbase + (size_t)ck[q] * 128); }
#pragma unroll
            for (int q = 0; q < 4; ++q) { u32x2 w; w.x = cvt_pk_bf16(S[0], S[1]); w.y = cvt_pk_bf16(S[2], S[3]);
                *(u32x2*)(base + (size_t)ck[q] * 32768) = w;
                S[0] = dc[q][0] * S[0] + bflo(L[q].x); S[1] = dc[q][1] * S[1] + bfhi(L[q].x); S[2] = dc[q][2] * S[2] + bflo(L[q].y); S[3] = dc[q][3] * S[3] + bfhi(L[q].y); }
        }
    }
}

__device__ __forceinline__ void phase_gla_out(const Ctx& C, int l, int rot) {
    const bf16_t* P = WSP(bf16_t, WS_P); const bf16_t* GST = WSP(bf16_t, WS_GST); unsigned char* OL = C.ws + WS_OL;
    LAS float* lr = (LAS float*)C.lds;
    LAS float* segtot = (LAS float*)(C.lds + 8192);
    LAS bf16_t* QT = (LAS bf16_t*)(C.lds + 10240);
    LAS bf16_t* KT = (LAS bf16_t*)(C.lds + 27648);
    LAS bf16_t* VT = (LAS bf16_t*)(C.lds + 45056);
    LAS bf16_t* SCm = (LAS bf16_t*)(C.lds + 81920);
    LAS float* OB = (LAS float*)(C.lds + 91136);
    LAS float* CUM = OB;
    const float* gon = INP(I_ONG) + l * 256;
    const int r32 = C.lane & 31, hi = C.lane >> 5;
    const int btk = C.tid >> 3, bdg = (C.tid & 7) * 16;
    const bool lastl = l + 1 >= DEPTH; const int nck = lastl ? NCH - CTXL / 64 : NCH;
    for (int unit = (C.bid + C.G - rot % C.G) % C.G; unit < NBATCH * 4 * nck; unit += C.G) {
        const int b = unit / (4 * nck), h = (unit / nck) % 4, ck = unit % nck + (NCH - nck); const size_t r0 = (size_t)b * RPB + ck * 64;
        for (int i = C.tid; i < 64 * 32; i += NTHREADS) lr[i] = bf2f(P[(r0 + (i >> 5)) * NP + C_LRF + (i & 31)]);
        const bf16_t* qp = P + (r0 + btk) * NP + C_LQ + h * 128 + bdg; const bf16_t* kp = P + (r0 + btk) * NP + C_LK + h * 128 + bdg;
        const u32x4 qw0 = *(const u32x4*)qp, qw1 = *(const u32x4*)(qp + 8), kw0 = *(const u32x4*)kp, kw1 = *(const u32x4*)(kp + 8);
        gla_build_vt(C, P, r0, h, VT);
        __syncthreads();
        f32x16 oacc[2] = {};
#pragma unroll 1
        for (int dir = 0; dir < 2; ++dir) {
            gla_cumsum_lds(C, l, h, dir, lr, segtot, CUM);
            { float qf[8], kf[8];
#pragma unroll
              for (int hh = 0; hh < 2; ++hh) { unpack8(hh ? qw1 : qw0, qf); unpack8(hh ? kw1 : kw0, kf);
                  const f32x4 c0 = *(const LAS f32x4*)(CUM + btk * 132 + bdg + 8 * hh), c1 = *(const LAS f32x4*)(CUM + btk * 132 + bdg + 8 * hh + 4);
                  float qo[8], ko[8];
#pragma unroll
                  for (int i = 0; i < 8; ++i) { const float cm = i < 4 ? c0[i & 3] : c1[i & 3]; qo[i] = qf[i] * __expf(cm) * 0.088388347648318440f; ko[i] = kf[i] * __expf(-cm); }
                  u32x4 wq, wk; wq.x = cvt_pk_bf16(qo[0], qo[1]); wq.y = cvt_pk_bf16(qo[2], qo[3]); wq.z = cvt_pk_bf16(qo[4], qo[5]); wq.w = cvt_pk_bf16(qo[6], qo[7]);
                  wk.x = cvt_pk_bf16(ko[0], ko[1]); wk.y = cvt_pk_bf16(ko[2], ko[3]); wk.z = cvt_pk_bf16(ko[4], ko[5]); wk.w = cvt_pk_bf16(ko[6], ko[7]);
                  *(LAS u32x4*)(QT + btk * 136 + bdg + 8 * hh) = wq; *(LAS u32x4*)(KT + btk * 136 + bdg + 8 * hh) = wk; } }
            __syncthreads();
            if (C.wid < 4) { const int mt = C.wid >> 1, nt = C.wid & 1; f32x16 sc = {};
                mma_xy<8>(sc, QT + (mt * 32 + r32) * 136, KT + (nt * 32 + r32) * 136, hi);
#pragma unroll
                for (int i = 0; i < 16; ++i) { const int t = mt * 32 + att::crow(i, hi), sx_ = nt * 32 + r32; const bool keep = dir ? (sx_ >= t) : (sx_ <= t);
                    SCm[t * 72 + sx_] = f2bf(keep ? sc[i] : 0.f); } }
            __syncthreads();
            { const bf16_t* st = GST + ((size_t)gla_sidx(b, dir, h) * NCH + ck) * 32768 + (size_t)(C.wid * 32 + r32) * 128 + hi * 8;
              bf16x8 sb[8];
#pragma unroll
              for (int ks = 0; ks < 8; ++ks) sb[ks] = *(const bf16x8*)(st + ks * 16);
#pragma unroll
              for (int mt = 0; mt < 2; ++mt) {
                  mma_xy<4>(oacc[mt], SCm + (mt * 32 + r32) * 72, VT + (C.wid * 32 + r32) * 72, hi);
#pragma unroll
                  for (int ks = 0; ks < 8; ++ks) { const bf16x8 a = *(const LAS bf16x8*)(QT + (mt * 32 + r32) * 136 + ks * 16 + hi * 8);
                      oacc[mt] = __builtin_amdgcn_mfma_f32_32x32x16_bf16(a, sb[ks], oacc[mt], 0, 0, 0); } } }
            __syncthreads();
        }
#pragma unroll
        for (int mt = 0; mt < 2; ++mt)
#pragma unroll
            for (int i = 0; i < 16; ++i) OB[(mt * 32 + att::crow(i, hi)) * 260 + C.wid * 32 + r32] = oacc[mt][i];
        __syncthreads();
        { const int t = C.tid >> 3, part = C.tid & 7; f32x4 v[8]; float ss = 0.f;
#pragma unroll
          for (int jj = 0; jj < 8; ++jj) { v[jj] = *(const LAS f32x4*)(OB + t * 260 + jj * 32 + part * 4); ss += v[jj][0] * v[jj][0] + v[jj][1] * v[jj][1] + v[jj][2] * v[jj][2] + v[jj][3] * v[jj][3]; }
          ss += dppmov<DPP_HMIRROR>(ss); ss += dppmov<DPP_Q3210>(ss); ss += dppmov<DPP_Q1032>(ss);
          const float rs = rsqrtf(ss * (1.0f / 256.0f) + NORM_EPS);
#pragma unroll
          for (int jj = 0; jj < 8; ++jj) { const int e = jj * 32 + part * 4; const f32x4 g = *(const f32x4*)(gon + e);
              const u32x2 gt = *(const u32x2*)(P + (r0 + t) * NP + C_LG + h * 256 + e);
              const float o0 = v[jj][0] * rs * g[0] * siluf_(bflo(gt.x)), o1 = v[jj][1] * rs * g[1] * siluf_(bfhi(gt.x)), o2 = v[jj][2] * rs * g[2] * siluf_(bflo(gt.y)), o3 = v[jj][3] * rs * g[3] * siluf_(bfhi(gt.y));
              int p8 = __builtin_amdgcn_cvt_pk_fp8_f32(o0, o1, 0, false); p8 = __builtin_amdgcn_cvt_pk_fp8_f32(o2, o3, p8, true);
              *(unsigned*)(OL + (r0 + t) * 1024 + h * 256 + e) = (unsigned)p8; } }
        __syncthreads();
    }
}

__device__ __forceinline__ unsigned f_ord(float f) { const unsigned u = __float_as_uint(f); return u ^ ((unsigned)((int)u >> 31) | 0x80000000u); }
__device__ __forceinline__ float f_unord(unsigned k) { return __uint_as_float((k & 0x80000000u) ? (k ^ 0x80000000u) : ~k); }
__device__ __forceinline__ void ins_u(unsigned (&L)[16], unsigned x) {
#pragma unroll
    for (int j = 0; j < 16; ++j) { const unsigned h = L[j] > x ? L[j] : x; x = L[j] > x ? x : L[j]; L[j] = h; }
}
__device__ __forceinline__ void ins_f(float (&M)[16], float x) {
#pragma unroll
    for (int j = 0; j < 16; ++j) { const float h = M[j] > x ? M[j] : x; x = M[j] > x ? x : M[j]; M[j] = h; }
}
__device__ __forceinline__ void peer_top16(const bf16_t* __restrict__ qrow, const bf16_t* __restrict__ keys, int r32, int hi, unsigned (&L)[16]) {
    bf16x8 qf[8];
#pragma unroll
    for (int kk = 0; kk < 8; ++kk) qf[kk] = *(const bf16x8*)(qrow + kk * 16 + hi * 8);
#pragma unroll
    for (int j = 0; j < 16; ++j) L[j] = 0u;
    bf16x8 kA[8], kB[8];
    const bf16_t* kl = keys + (size_t)r32 * 128 + hi * 8;
#define PT_LDK(dst, mt) do { _Pragma("unroll") for (int kk = 0; kk < 8; ++kk) dst[kk] = *(const bf16x8*)(kl + (mt) * 32 * 128 + kk * 16); } while (0)
#define PT_PROC(src, mt) do { f32x16 acc = {}; \
        _Pragma("unroll") for (int kk = 0; kk < 8; ++kk) acc = __builtin_amdgcn_mfma_f32_32x32x16_bf16(src[kk], qf[kk], acc, 0, 0, 0); \
        _Pragma("unroll") for (int i = 0; i < 16; ++i) { const unsigned kidx = (unsigned)((mt) * 32 + att::crow(i, hi)); ins_u(L, (f_ord(acc[i]) & ~127u) | (127u - kidx)); } } while (0)
    PT_LDK(kA, 0);
#pragma unroll 1
    for (int mp = 0; mp < 2; ++mp) { PT_LDK(kB, 2 * mp + 1); PT_PROC(kA, 2 * mp); if (mp == 0) PT_LDK(kA, 2); PT_PROC(kB, 2 * mp + 1); }
#undef PT_LDK
#undef PT_PROC
    unsigned Pn[16];
#pragma unroll
    for (int j = 0; j < 16; ++j) { auto r_ = __builtin_amdgcn_permlane32_swap(L[j], L[j], false, false); Pn[j] = hi ? r_[0] : r_[1]; }
#pragma unroll
    for (int j = 0; j < 16; ++j) ins_u(L, Pn[j]);
}
__device__ __forceinline__ void phase_peer_select(const Ctx& C, const bool latent_only) {
    const bf16_t* PQ = WSP(bf16_t, WS_PQ); const bf16_t* K1 = WSP(bf16_t, WS_K1); const bf16_t* K2 = WSP(bf16_t, WS_K2);
    int* PIDX = WSP(int, WS_PIDX); float* PG = WSP(float, WS_PG);
    const int r32 = C.lane & 31, hi = C.lane >> 5, head = C.wid;
    const int ngrp = latent_only ? NBATCH * SEQ / 32 : TT / 32;
    for (int gi = C.bid; gi < ngrp; gi += C.G) {
        const int grp = latent_only ? gi + (CTXL / 32) * (1 + gi / (SEQ / 32)) : gi;
        const size_t tok = (size_t)grp * 32 + r32;
        unsigned L1[16], L2[16];
        peer_top16(PQ + tok * DM + head * 256, K1 + (size_t)head * 128 * 128, r32, hi, L1);
        peer_top16(PQ + tok * DM + head * 256 + 128, K2 + (size_t)head * 128 * 128, r32, hi, L2);
        float v1[16], v2[16];
#pragma unroll
        for (int j = 0; j < 16; ++j) { v1[j] = f_unord(L1[j] & ~127u); v2[j] = f_unord(L2[j] & ~127u); }
        float M[16];
#pragma unroll
        for (int j = 0; j < 16; ++j) M[j] = -3.0e38f;
#pragma unroll
        for (int a = 0; a < 16; ++a)
#pragma unroll
            for (int b = 0; b < 16; ++b) if ((a + 1) * (b + 1) <= 16) ins_f(M, v1[a] + v2[b]);
        const float thr = M[15], mx = M[0]; float den = 0.f;
#pragma unroll
        for (int j = 0; j < 16; ++j) den += __expf(M[j] - mx);
        const float rden = 1.0f / den;
        int pos = 0; int* ip = PIDX + tok * 128 + head * 16; float* gp = PG + tok * 128 + head * 16;
#pragma unroll
        for (int a = 0; a < 16; ++a)
#pragma unroll
            for (int b = 0; b < 16; ++b) if ((a + 1) * (b + 1) <= 16) {
                const float val = v1[a] + v2[b];
                if (val >= thr && pos < 16) { if (hi == 0) { ip[pos] = (int)((127u - (L1[a] & 127u)) * 128u + (127u - (L2[b] & 127u))); gp[pos] = __expf(val - mx) * rden; } ++pos; } }
    }
}
template <int OFF> __device__ __forceinline__ float dotf8(const float (&h)[32], const u32x4 w, float acc) {
#pragma unroll
    for (int j = 0; j < 4; ++j) { const f32x2 lo = __builtin_amdgcn_cvt_pk_f32_fp8((int)w[j], false), hi = __builtin_amdgcn_cvt_pk_f32_fp8((int)w[j], true);
        acc += h[OFF + 4 * j] * lo.x; acc += h[OFF + 4 * j + 1] * lo.y; acc += h[OFF + 4 * j + 2] * hi.x; acc += h[OFF + 4 * j + 3] * hi.y; }
    return acc;
}
constexpr float ATT_O8_SCALE = 32.0f;
constexpr int GT_MAXTOK = 9;
template <bool LAST> __device__ __forceinline__ void phase_peer_gather(const Ctx& C, const float* modl, const float pscale) {
    const unsigned char* pt = C.ws + WS_PT + (size_t)(LAST ? DEPTH - 1 : 0) * PT_BYTES;
    const bf16_t* HB = WSP(bf16_t, WS_HB); const unsigned char* U8 = pt + PT_U8; const unsigned char* V8 = pt + PT_V8;
    const float* SCU = (const float*)(pt + PT_SCU); const float* SCV = (const float*)(pt + PT_SCV);
    const int* PIDX = WSP(int, WS_PIDX); const float* PG = WSP(float, WS_PG); float* XS = WSP(float, WS_XS);
    const int lane = C.lane, s = lane >> 3, j = lane & 7; const unsigned j16 = (unsigned)j * 16u;
    LAS int* IDS = (LAS int*)(C.lds + C.wid * (GT_MAXTOK * 512));
    LAS float* ACT = (LAS float*)(C.lds + 8 * GT_MAXTOK * 512 + C.wid * (GT_MAXTOK * 512));
    LAS int* ROWS = (LAS int*)(C.lds + 16 * GT_MAXTOK * 512 + C.wid * 64);
    int nk = 0;
    {
      const int nrows = LAST ? NBATCH * SEQ : TT, per = (nrows + C.G - 1) / C.G, base = C.bid * per;
#pragma unroll 1
      for (int k = 0; k < GT_MAXTOK; ++k) { const int o = C.wid + 8 * k; const int i = base + o; const int r = LAST ? (i / SEQ) * RPB + CTXL + i % SEQ : i;
          if (o < per && i < nrows) { if (lane == 0) ROWS[nk] = r; ++nk; } } }
#define GT_ROW(k) __builtin_amdgcn_readfirstlane(ROWS[k])
#pragma unroll 1
    for (int k = 0; k < nk; ++k) { const int r = GT_ROW(k);
        IDS[k * 128 + lane] = (PIDX[(size_t)r * 128 + lane] & (NEXP - 1)) << 7; IDS[k * 128 + 64 + lane] = (PIDX[(size_t)r * 128 + 64 + lane] & (NEXP - 1)) << 7;
        ACT[k * 128 + lane] = 0.f; ACT[k * 128 + 64 + lane] = 0.f; }
    const int nit = 32 * nk;
#define GT_ITEM(it_) const int cb_ = (it_) / (2 * nk), rem_ = (it_) - cb_ * (2 * nk), k_ = rem_ >> 1, hf_ = rem_ & 1
#define GT_LOADU(UQ, HQ, it_) do { GT_ITEM(it_); const int r_ = GT_ROW(k_); \
        const bf16_t* hp_ = HB + (size_t)r_ * DM + cb_ * 128 + j * 16; HQ[0] = *(const u32x4*)hp_; HQ[1] = *(const u32x4*)(hp_ + 8); \
        const unsigned char* ub_ = U8 + (size_t)cb_ * ((size_t)NEXP * 128);     \
        _Pragma("unroll") for (int eg = 0; eg < 8; ++eg) { const unsigned off_ = ((unsigned)IDS[k_ * 128 + (hf_ * 8 + eg) * 8 + s] & idmask) + j16; UQ[eg] = *(const u32x4*)(ub_ + off_); } } while (0)
#define GT_LOADU_NOH(UQ, it_) do { GT_ITEM(it_); const unsigned char* ub_ = U8 + (size_t)cb_ * ((size_t)NEXP * 128); \
        _Pragma("unroll") for (int eg = 0; eg < 8; ++eg) { const unsigned off_ = ((unsigned)IDS[k_ * 128 + (hf_ * 8 + eg) * 8 + s] & idmask) + j16; UQ[eg] = *(const u32x4*)(ub_ + off_); } } while (0)
#define GT_UNPACKH(HQ) do { _Pragma("unroll") for (int hh = 0; hh < 2; ++hh) { const u32x4 w_ = HQ[hh]; \
            hf2[hh * 4 + 0] = (f32x2){bflo(w_.x), bfhi(w_.x)}; hf2[hh * 4 + 1] = (f32x2){bflo(w_.y), bfhi(w_.y)}; hf2[hh * 4 + 2] = (f32x2){bflo(w_.z), bfhi(w_.z)}; hf2[hh * 4 + 3] = (f32x2){bflo(w_.w), bfhi(w_.w)}; } } while (0)
#define GT_COMPU(UQ, HQ, it_) do { GT_ITEM(it_); (void)cb_; \
        float d[8]; \
        _Pragma("unroll") for (int eg = 0; eg < 8; ++eg) { f32x2 d2 = (f32x2){0.f, 0.f}; \
            _Pragma("unroll") for (int q = 0; q < 4; ++q) { const f32x2 lo = __builtin_amdgcn_cvt_pk_f32_fp8((int)UQ[eg][q], false), hi = __builtin_amdgcn_cvt_pk_f32_fp8((int)UQ[eg][q], true); \
                d2 += hf2[2 * q] * lo; d2 += hf2[2 * q + 1] * hi; } \
            d[eg] = d2.x + d2.y; } \
          \
        float t4[4], t2[2], t1; \
        _Pragma("unroll") for (int i = 0; i < 4; ++i) { const float snd = (j & 4) ? d[i] : d[i + 4], kp = (j & 4) ? d[i + 4] : d[i]; t4[i] = kp + dppmov<DPP_HMIRROR>(snd); } \
        _Pragma("unroll") for (int i = 0; i < 2; ++i) { const float snd = (j & 2) ? t4[i] : t4[i + 2], kp = (j & 2) ? t4[i + 2] : t4[i]; t2[i] = kp + dppmov<DPP_Q3210>(snd); } \
        { const float snd = (j & 1) ? t2[0] : t2[1], kp = (j & 1) ? t2[1] : t2[0]; t1 = kp + dppmov<DPP_Q1032>(snd); } \
        ACT[k_ * 128 + (hf_ * 8 + j) * 8 + s] += t1; } while (0)
#ifdef DBG_GDUP
#pragma unroll 1
    for (int rep_ = 0; rep_ < 2; ++rep_) {
    const unsigned idmask = rep_ == 0 ? ((unsigned)DBG_GMASK << 7 | 127u) : 0xffffffffu;
    if (rep_ == 1) { for (int k = 0; k < nk; ++k) { ACT[k * 128 + lane] = 0.f; ACT[k * 128 + 64 + lane] = 0.f; } }
#else
    { const unsigned idmask = 0xffffffffu;
#endif
    if (nit > 0) {
        u32x4 uA[8], uB[8], hA[2]; f32x2 hf2[8];
        GT_LOADU(uA, hA, 0);
#pragma unroll 1
        for (int it = 0; it < nit; it += 2) {
            GT_LOADU_NOH(uB, it + 1);
            GT_UNPACKH(hA);
            GT_COMPU(uA, hA, it);
            if (it + 2 < nit) GT_LOADU(uA, hA, it + 2);
            GT_COMPU(uB, hA, it + 1);
        }
    }
    }
#undef GT_LOADU
#undef GT_LOADU_NOH
#undef GT_UNPACKH
#undef GT_COMPU
#pragma unroll 1
    for (int k = 0; k < nk; ++k) { const int r = GT_ROW(k);
#pragma unroll
        for (int hh = 0; hh < 2; ++hh) { const int e = hh * 64 + lane; const int id = IDS[k * 128 + e] >> 7; const float a = ACT[k * 128 + e] * SCU[id];
            const float w = PG[(size_t)r * 128 + e] * 0.5f * a * (1.0f + erff(a * 0.70710678118654752f));
#if defined(DBG_CHECK) && (DBG_CHECK == 3 || DBG_CHECK == 4)
            if (((r - 300) & 63) == 0 && r >= 300 && r < 300 + 64 * 128) WSP(float, WS_OM)[(size_t)r * 128 + e] = w;
#endif
            ACT[k * 128 + e] = w * SCV[id]; } }
#define GT_LOADV(VQ, WV, it_) do { GT_ITEM(it_); const unsigned char* vb_ = V8 + (size_t)cb_ * ((size_t)NEXP * 128); \
        _Pragma("unroll") for (int eg = 0; eg < 8; ++eg) { const int e_ = k_ * 128 + (hf_ * 8 + eg) * 8 + s; const unsigned off_ = (unsigned)IDS[e_] + j16; VQ[eg] = *(const u32x4*)(vb_ + off_); WV[eg] = ACT[e_]; } } while (0)
#define GT_COMPV(VQ, WV) do { \
        _Pragma("unroll") for (int eg = 0; eg < 8; ++eg) { const f32x2 w2_ = (f32x2){WV[eg], WV[eg]}; \
            _Pragma("unroll") for (int q = 0; q < 4; ++q) { \
                const f32x2 lo = __builtin_amdgcn_cvt_pk_f32_fp8((int)VQ[eg][q], false), hi = __builtin_amdgcn_cvt_pk_f32_fp8((int)VQ[eg][q], true); \
                acc2[2 * q] += w2_ * lo; acc2[2 * q + 1] += w2_ * hi; } } } while (0)
    if (nit > 0) {
        u32x4 vA[8], vB[8]; float wA[8], wB[8];
        GT_LOADV(vA, wA, 0);
#pragma unroll 1
        for (int it = 0; it < nit; it += 2) {
            f32x2 acc2[8];
#pragma unroll
            for (int i = 0; i < 8; ++i) acc2[i] = (f32x2){0.f, 0.f};
            GT_LOADV(vB, wB, it + 1);
            GT_COMPV(vA, wA);
            if (it + 2 < nit) GT_LOADV(vA, wA, it + 2);
            GT_COMPV(vB, wB);
            f32x2 t4[4], t2[2], t1;
#pragma unroll
            for (int i = 0; i < 4; ++i) { const f32x2 snd = (s & 4) ? acc2[i] : acc2[i + 4], kp = (s & 4) ? acc2[i + 4] : acc2[i];
                t4[i] = kp + (f32x2){xchg32(snd.x, lane), xchg32(snd.y, lane)}; }
#pragma unroll
            for (int i = 0; i < 2; ++i) { const f32x2 snd = (s & 2) ? t4[i] : t4[i + 2], kp = (s & 2) ? t4[i + 2] : t4[i];
                t2[i] = kp + (f32x2){xchg16(snd.x, lane), xchg16(snd.y, lane)}; }
            { const f32x2 snd = (s & 1) ? t2[0] : t2[1], kp = (s & 1) ? t2[1] : t2[0]; t1 = kp + (f32x2){dppmov<DPP_ROR8>(snd.x), dppmov<DPP_ROR8>(snd.y)}; }
            { GT_ITEM(it); (void)hf_; const int r_ = GT_ROW(k_);
              const int col = cb_ * 128 + j * 16 + 2 * s; float* xp = XS + (size_t)r_ * DM + col; const float* g2 = modl + (size_t)mod_sel(r_) * 12288 + 5 * DM + col;
#if defined(DBG_CHECK) && (DBG_CHECK == 3 || DBG_CHECK == 4)
              if (((r_ - 300) & 63) == 0 && r_ >= 300 && r_ < 300 + 64 * 128) { float* dbgo = WSP(float, WS_MQ) + (size_t)r_ * DM + col; dbgo[0] = t1.x; dbgo[1] = t1.y; }
#endif
              const f32x2 x = *(const f32x2*)xp, g = *(const f32x2*)g2;
              *(f32x2*)xp = x + pscale * g * t1; }
        }
    }
#undef GT_LOADV
#undef GT_COMPV
#undef GT_ITEM
#undef GT_ROW
}
__device__ __forceinline__ void phase_final_norm(const Ctx& C) {
    const float* XS = WSP(float, WS_XS); const float* fg = INP(I_FG);
    for (int q = C.bid * 8 + C.wid; q < NBATCH * SEQ; q += C.G * 8) {
        const int b = q / SEQ, t = q % SEQ; const float* xr = XS + ((size_t)b * RPB + CTXL + t) * DM; float* op = C.out + (size_t)q * DM;
        f32x4 v[8]; float ss = 0.f;
#pragma unroll
        for (int c = 0; c < 8; ++c) { v[c] = *(const f32x4*)(xr + c * 256 + C.lane * 4); ss += v[c][0] * v[c][0] + v[c][1] * v[c][1] + v[c][2] * v[c][2] + v[c][3] * v[c][3]; }
        ss = wave_sum(ss); const float rs = rsqrtf(ss * (1.0f / DM) + NORM_EPS);
#pragma unroll
        for (int c = 0; c < 8; ++c) { const f32x4 g = *(const f32x4*)(fg + c * 256 + C.lane * 4); *(f32x4*)(op + c * 256 + C.lane * 4) = v[c] * rs * g; }
    }
}


__device__ __forceinline__ void phase_vt8(const Ctx& C) {
    const bf16_t* P = WSP(bf16_t, WS_P); const bf16_t* MKV = WSP(bf16_t, WS_MKV);
    const int dv = C.tid & 127, kq = C.tid >> 7, g = kq >> 1, j0 = (kq & 1) * 16;
    constexpr int NU_A = NBATCH * 2 * NCH, NU_M = NBATCH * 8 * NCH;
    for (int u = C.bid; u < NU_A + NU_M; u += C.G) {
        const bool gqa = u < NU_A; const int v = gqa ? u : u - NU_A; const int nh = gqa ? 2 : 8;
        const int b = v / (nh * NCH), h = (v / NCH) % nh, t = v % NCH; const size_t r0 = (size_t)b * RPB + t * 64;
        const bf16_t* src = gqa ? P + r0 * NP + C_AV + h * 128 + dv : MKV + r0 * 2048 + h * 256 + 128 + dv; const size_t ld = gqa ? NP : 2048;
        float x[16];
#pragma unroll
        for (int jj = 0; jj < 16; ++jj) x[jj] = bf2f(src[(size_t)att::vt8_key(g, j0 + jj) * ld]);
        u32x4 w; w.x = (unsigned)att::pk4_fp8(x[0], x[1], x[2], x[3]); w.y = (unsigned)att::pk4_fp8(x[4], x[5], x[6], x[7]); w.z = (unsigned)att::pk4_fp8(x[8], x[9], x[10], x[11]); w.w = (unsigned)att::pk4_fp8(x[12], x[13], x[14], x[15]);
        unsigned char* dst = C.ws + (gqa ? WS_VT8A : WS_VT8M) + ((size_t)(b * nh + h) * NCH + t) * 8192 + dv * 64 + kq * 16;
        *(u32x4*)dst = w;
    }
}
template <int TYPE  , int VAR = 0> __device__ __forceinline__ void attn_units(const Ctx& C, bool need_ctx) {
    const bf16_t* P = WSP(bf16_t, WS_P);
    const int nu = need_ctx ? 528 : 512;
#pragma unroll 1
    for (int u = C.bid; u < nu; u += C.G) {
        int bh, qb; if (u < 512) { bh = (u >> 8) * 8 + (u & 7); qb = ((u & 255) >> 3) + 1; } else { bh = u - 512; qb = 0; }
        const int b = bh >> 3, h = bh & 7; const size_t rq = (size_t)b * RPB + (size_t)qb * 256, rk = (size_t)b * RPB; const int seq = qb == 0 ? CTXL : RPB;
        __syncthreads();
        if constexpr (TYPE == 1) {
            att::attn_body88<128>(P + rq * NP + C_AQ + h * 128, NP, C.ws + WS_AK8 + rk * 256 + (h >> 2) * 128, 256, nullptr, 0, C.ws + WS_VT8A + (size_t)(b * 2 + (h >> 2)) * NCH * 8192,
                                  C.ws + WS_OA + rq * 1024 + h * 128, 1024, seq, false, 0, nullptr, (char*)C.lds, C.tid);
        } else {
            const bf16_t* MQ = WSP(bf16_t, WS_MQ);
            att::attn_body88<192>(MQ + rq * 1536 + h * 192, 1536, C.ws + WS_KN8 + rk * 1024 + h * 128, 1024, C.ws + WS_KR8 + rk * 64, 64, C.ws + WS_VT8M + (size_t)(b * 8 + h) * NCH * 8192,
                                  C.ws + WS_OM + rq * 1024 + h * 128, 1024, seq, qb > 0, (qb - 1) * 256, WSP(float, WS_TABM), (char*)C.lds, C.tid);
        }
    }
    __syncthreads();
}

constexpr int LDS_BYTES = 163840, LDS_BAR_OFF = LDS_BYTES - 16;
constexpr int N_PHASES = 26;
template <int K> __device__ __forceinline__ void run_phase(const Ctx& C0, int l) {
    const Ctx C = launder(C0);
    const float* modl = WSP(float, WS_MODV) + (size_t)l * 3 * 12288;
    if constexpr (K == 0) { phase_modv(C); phase_tables(C); __syncthreads(); phase_cvt_mixer_weights(C, 0); }
    if constexpr (K == 1) {
        if (l == 0) phase_norm_mod<true, true>(C, INP(I_N1G), modl, 0, DM);
        else { phase_norm_mod<false, true>(C, INP(I_N1G) + l * DM, modl, 0, DM); __syncthreads(); phase_cvt_mixer_weights(C, l); }
    }
    if constexpr (K == 2) {
        pg8::Gemm g{WSP(bf16_t, WS_HB), WSP(bf16_t, WS_WIN), TT, NP, DM, DM, DM}; pg8::WinOrder S; S.init(C.G, C.bid, l + 1 < DEPTH);
        pg8::EpiStoreBf16S E{WSP(bf16_t, WS_P), NP, WSP(float, WS_WINS)};
        pg8::gemm_phase<pg8::EpiStoreBf16S, pg8::WinOrder, 1>(C.lds, C.tid, g, S, E);
    }
    if constexpr (K == 3) phase_post_p(C, l);
    if constexpr (K == 4) {
        { pg8::Gemm g{WSP(bf16_t, WS_P) + C_MCQ, WSP(bf16_t, WS_WUQ), TT, 1536, 512, NP, 512}; pg8::StaticOrder S; S.init(TT, 1536, C.G, C.bid);
          pg8::EpiStoreBf16 E{WSP(bf16_t, WS_MQ), 1536}; pg8::gemm_phase(C.lds, C.tid, g, S, E); }
        { pg8::Gemm g{WSP(bf16_t, WS_P) + C_MCKV, WSP(bf16_t, WS_WUKV), TT, 2048, 512, NP, 512}; pg8::StaticOrder S; S.init(TT, 2048, C.G, (C.bid + C.G - 140 % C.G) % C.G);
          pg8::EpiStoreMKV E{WSP(bf16_t, WS_MKV), C.ws + WS_KN8}; pg8::gemm_phase(C.lds, C.tid, g, S, E); }
        { const Ctx C2 = launder(C0); phase_gla_local(C2, l, 156); }
#ifdef DBG_DUP_GLALOCAL
        { const Ctx C2 = launder(C0); __syncthreads(); phase_gla_local(C2, l, 156); }
#endif
    }
    if constexpr (K == 5) { phase_gla_scan(C); { const Ctx C2 = launder(C0); phase_vt8(C2); } }
    if constexpr (K == 6) {
#ifdef DBG_ATTVAR
        { const Ctx Cx = launder(C0); attn_units<0, DBG_ATTVAR>(Cx, l + 1 < DEPTH); } { const Ctx Cx = launder(C0); attn_units<1, DBG_ATTVAR>(Cx, l + 1 < DEPTH); } __syncthreads();
#endif
        attn_units<0>(C, l + 1 < DEPTH); { const Ctx C2 = launder(C0); attn_units<1>(C2, l + 1 < DEPTH); } { const Ctx C3 = launder(C0); phase_gla_out(C3, l, 128); }
#ifdef DBG_DUP_GLAOUT
        { const Ctx C3 = launder(C0); __syncthreads(); phase_gla_out(C3, l, 128); }
#endif
    }
    if constexpr (K == 7) {
        const bf16_t* P = WSP(bf16_t, WS_P); bf16_t* Y = WSP(bf16_t, WS_Y);
        const pg8::Gemm ga{WSP(bf16_t, WS_OA), WSP(bf16_t, WS_WBR), TT, DM, 1024, 1024, 1024}, gl{WSP(bf16_t, WS_OL), (const bf16_t*)(C.ws + WS_WBR + (size_t)2048 * 1024), TT, DM, 1024, 1024, 1024},
                        gm{WSP(bf16_t, WS_OM), (const bf16_t*)(C.ws + WS_WBR + (size_t)2 * 2048 * 1024), TT, DM, 1024, 1024, 1024};
        unsigned char* Y8 = C.ws + WS_HB;
        const float* wbs = WSP(float, WS_WBRS);
        const pg8::EpiGate<true> Ea{Y, P + C_GA, nullptr, wbs}; const pg8::EpiGate<false> El{Y, P + C_GL, nullptr, wbs + DM}; const pg8::EpiGate<false, true> Em{Y, P + C_GM, Y8, wbs + 2 * DM};
        pg8::StaticOrder S; S.init(TT, DM, C.G, C.bid, l + 1 >= DEPTH);
        pg8::gemm_phase<pg8::EpiGate<true>, pg8::StaticOrder, 1>(C.lds, C.tid, ga, S, Ea); pg8::gemm_phase<pg8::EpiGate<false>, pg8::StaticOrder, 1>(C.lds, C.tid, gl, S, El);
        pg8::gemm_phase<pg8::EpiGate<false, true>, pg8::StaticOrder, 1>(C.lds, C.tid, gm, S, Em);
        if (l == 0) { const Ctx C2 = launder(C0); phase_cvt_peer_tables(C2, 0, 0, NEXP, S.nwg % C.G); }
    }
    if constexpr (K == 8) {
        pg8::Gemm g{WSP(bf16_t, WS_HB), WSP(bf16_t, WS_WOUT), TT, DM, DM, DM, DM};
        const pg8::EpiResidT<true> E{WSP(float, WS_XS), DM, modl + 2 * DM, WSP(float, WS_WOUTS)};
        pg8::StaticOrder S; S.init(TT, DM, C.G, C.bid, l + 1 >= DEPTH);
        pg8::gemm_phase<pg8::EpiResidT<true>, pg8::StaticOrder, 1>(C.lds, C.tid, g, S, E);
        if (l == 0 && DEPTH > 1) { const Ctx C2 = launder(C0); phase_cvt_peer_tables(C2, 1, 0, NEXP / 2, S.nwg % C.G); }
    }
    if constexpr (K == 9) phase_norm_mod<false>(C, INP(I_N2G) + l * DM, modl, 3 * DM, 4 * DM);
    if constexpr (K == 10) {
        pg8::Gemm g{WSP(bf16_t, WS_HB), WSP(bf16_t, WS_WQ), TT, DM, DM, DM, DM};
        pg8::EpiStoreBf16 E{WSP(bf16_t, WS_PQ), DM};
        pg8::StaticOrder S; S.init(TT, DM, C.G, C.bid, l + 1 >= DEPTH); pg8::gemm_phase(C.lds, C.tid, g, S, E);
        if (l == 0 && DEPTH > 1) { const Ctx C2 = launder(C0); phase_cvt_peer_tables(C2, 1, NEXP / 2, NEXP, S.nwg % C.G); }
    }
    if constexpr (K == 11) phase_peer_select(C, l + 1 >= DEPTH);
    if constexpr (K == 13) phase_final_norm(C);
    if constexpr (K == 12) {
#ifdef DBG_DUP12
        if (l + 1 < DEPTH) phase_peer_gather<false>(C, modl, 0.0f); else phase_peer_gather<true>(C, modl, 0.0f);
        __syncthreads();
#endif
        if (l + 1 < DEPTH) phase_peer_gather<false>(C, modl, DBG_PEER0); else phase_peer_gather<true>(C, modl, DBG_PEER1); }
}
__device__ __forceinline__ Ctx make_ctx(const Args& args, unsigned char* lds_raw) {
    Ctx C0; C0.in = (const __attribute__((address_space(4))) cfp_t*)__builtin_amdgcn_kernarg_segment_ptr(); C0.out = args.out; C0.ws = args.ws; C0.lds = (LAS unsigned char*)lds_raw;
    C0.tid = threadIdx.x; C0.lane = C0.tid & 63; C0.wid = __builtin_amdgcn_readfirstlane(C0.tid >> 6); C0.G = gridDim.x; C0.bid = blockIdx.x;
    return C0;
}
template <int K> __global__ void __launch_bounds__(NTHREADS, 2) k_one(Args args) {
    extern __shared__ __attribute__((aligned(16))) unsigned char lds_raw[];
    const Ctx C0 = make_ctx(args, lds_raw);
    run_phase<K>(C0, args.ph_lo);
}
#if MK_N_LAUNCHES == 1 || defined(DBG_HYB)
__global__ void __launch_bounds__(NTHREADS, 2) mk_fwd(Args args) {
    extern __shared__ __attribute__((aligned(16))) unsigned char lds_raw[];
    const Ctx C0 = make_ctx(args, lds_raw);
    if (C0.tid < 4) ((LAS unsigned*)(C0.lds + LDS_BAR_OFF))[C0.tid] = 0u;
    __syncthreads();
    const int lo = args.ph_lo, hi = args.ph_hi;
    XcdBarrier bar; bar.bar = (unsigned*)(args.ws + WS_CTL); bar.x = 0; bar.st = nullptr;
    if (hi - lo > 1) bar = xcd_barrier_post((unsigned*)(args.ws + WS_CTL), (volatile LAS unsigned*)(C0.lds + LDS_BAR_OFF));
#define IN(k) (lo <= (k) && (k) < hi)
#define SEAM(k) do { if (IN(k) && IN((k) + 1)) xcd_barrier(bar); } while (0)
#ifndef DBG_DUP
#define DBG_DUP -1
#endif
#define PH(K, k) do { if (IN(k)) { run_phase<K>(C0, l); if (K == DBG_DUP) { xcd_barrier(bar); run_phase<K>(C0, l); } } SEAM(k); } while (0)
    { const int l = 0; PH(0, 0); }
#pragma unroll 1
    for (int l = 0; l < DEPTH; ++l) {
        const int pb = 1 + 12 * l;
        PH(1, pb + 0); PH(2, pb + 1); PH(3, pb + 2); PH(4, pb + 3); PH(5, pb + 4); PH(6, pb + 5);
        PH(7, pb + 6); PH(8, pb + 7); PH(9, pb + 8); PH(10, pb + 9); PH(11, pb + 10); PH(12, pb + 11);
    }
    { const int l = DEPTH - 1; PH(13, 1 + 12 * DEPTH); }
#undef PH
#undef IN
#undef SEAM
}
#define MAIN_KERNEL mk_fwd
#else
#define MAIN_KERNEL k_one<6>
#endif


#ifdef DBG_PROBE
typedef int i32x8 __attribute__((ext_vector_type(8)));
__device__ __forceinline__ unsigned char fp8_of_int(int v) {
    const float f = (float)v; return (unsigned char)(__builtin_amdgcn_cvt_pk_fp8_f32(f, 0.f, 0, false) & 0xff); }
__global__ void k_probe_mx(unsigned* slot) {
    const int l = threadIdx.x, r = l & 31, g = l >> 5;
    i32x8 A, B;
    for (int j = 0; j < 8; ++j) { unsigned wa = 0, wb = 0;
        for (int b = 0; b < 4; ++b) { const int k = g * 32 + 4 * j + b;
            wa |= (unsigned)fp8_of_int(((3 * r + k) % 7) - 3) << (8 * b); wb |= (unsigned)fp8_of_int(((5 * k + 2 * r) % 9) - 4) << (8 * b); }
        A[j] = (int)wa; B[j] = (int)wb; }
    f32x16 c = {};
    c = __builtin_amdgcn_mfma_scale_f32_32x32x64_f8f6f4(A, B, c, 0, 0, 0, 0x7f7f7f7f, 0, 0x7f7f7f7f);
    float worst = 0.f;
    for (int i = 0; i < 16; ++i) { const int m = (i & 3) + 8 * (i >> 2) + 4 * g, n = r; float ref = 0.f; for (int k = 0; k < 64; ++k) ref += (float)(((3 * m + k) % 7) - 3) * (float)(((5 * k + 2 * n) % 9) - 4);
        worst = fmaxf(worst, fabsf(c[i] - ref)); }
    for (int o = 32; o >= 1; o >>= 1) worst = fmaxf(worst, __shfl_xor(worst, o));
    if (l == 0) { const float code = worst == 0.f ? 0.4f : 1.2f; *slot = __float_as_uint(powf(10.f, code / 0.25f - 4.f)); }
}
#endif
#ifdef DBG_CHECK
__device__ __forceinline__ void dbg_report(unsigned* slot, float err) { if (!(err <= 3e38f)) err = 1e30f; atomicMax(slot, __float_as_uint(err)); }
__global__ void k_check_gemm(const bf16_t* A, int lda, const float* W, int K, int N, const bf16_t* Cm, int ldc, int M, unsigned* slot) {
    const unsigned id = blockIdx.x * blockDim.x + threadIdx.x; if (id >= 8192) return;
    const unsigned h = id * 2654435761u; const int row = (int)((h >> 8) % (unsigned)M), col = (int)((h * 40503u >> 7) % (unsigned)N);
    float ref = 0.f; for (int k = 0; k < K; ++k) ref += bf2f(A[(size_t)row * lda + k]) * W[(size_t)k * N + col];
    const float got = bf2f(Cm[(size_t)row * ldc + col]);
    dbg_report(slot, fabsf(got - ref) / (fabsf(ref) + 0.1f));
}

__global__ void k_check_attn(const unsigned char* ws, int type, unsigned* slot) {
    __shared__ float sc[RPB]; __shared__ float red[256]; __shared__ float qv[192];
    const int t = threadIdx.x, bh = blockIdx.x & 15, b = bh >> 3, h = bh & 7; const int qpos = (int)(((blockIdx.x >> 4) * 977u + 13u) % SEQ); const size_t rq = (size_t)b * RPB + CTXL + qpos, rk = (size_t)b * RPB;
    const bf16_t* P = (const bf16_t*)(ws + WS_P); const bf16_t* MQ = (const bf16_t*)(ws + WS_MQ); const bf16_t* MKV = (const bf16_t*)(ws + WS_MKV);
    const int dq = type ? 128 : 192;
    if (t < dq) { float v = type ? bf2f(P[rq * NP + C_AQ + h * 128 + t]) : bf2f(MQ[rq * 1536 + h * 192 + t]); qv[t] = v; }
    __syncthreads();
    if (!type && t < 32) {
        const int ri = qpos >> 6, ci = qpos & 63; const int i = t; const float pos = (float)(i < 16 ? ri : ci); const float inv = powf(10000.f, -(float)(i & 15) / 16.f); const float a = pos * inv;
        const float x1 = qv[128 + i], x2 = qv[160 + i]; qv[128 + i] = x1 * cosf(a) - x2 * sinf(a); qv[160 + i] = x2 * cosf(a) + x1 * sinf(a); }
    __syncthreads();
    const float scale = type ? 0.088388347648f : 0.0721687836487f;
    float mx = -1e30f;
    for (int k = t; k < RPB; k += 256) { float s = 0.f;
        if (type) { const bf16_t* kp = P + (rk + k) * NP + C_AK + (h >> 2) * 128; for (int d = 0; d < 128; ++d) s += qv[d] * bf2f(kp[d]); }
        else { const bf16_t* kp = MKV + (rk + k) * 2048 + h * 256; for (int d = 0; d < 128; ++d) s += qv[d] * bf2f(kp[d]); const bf16_t* kr = P + (rk + k) * NP + C_MKR; for (int d = 0; d < 64; ++d) s += qv[128 + d] * bf2f(kr[d]); }
        s *= scale; sc[k] = s; mx = fmaxf(mx, s); }
    red[t] = mx; __syncthreads(); for (int o = 128; o >= 1; o >>= 1) { if (t < o) red[t] = fmaxf(red[t], red[t + o]); __syncthreads(); } mx = red[0]; __syncthreads();
    float sum = 0.f; for (int k = t; k < RPB; k += 256) { const float p = __expf(sc[k] - mx); sc[k] = p; sum += p; }
    red[t] = sum; __syncthreads(); for (int o = 128; o >= 1; o >>= 1) { if (t < o) red[t] += red[t + o]; __syncthreads(); } sum = red[0]; __syncthreads();
    float e = 0.f, mag = 0.f;
    if (t < 128) { float o = 0.f; for (int k = 0; k < RPB; ++k) { const float vv = type ? bf2f(P[(rk + k) * NP + C_AV + (h >> 2) * 128 + t]) : bf2f(MKV[(rk + k) * 2048 + h * 256 + 128 + t]); o += sc[k] * vv; }
        o /= sum; const float got = __builtin_amdgcn_cvt_f32_fp8((int)(ws + (type ? WS_OA : WS_OM))[rq * 1024 + h * 128 + t], 0) * (1.0f / 32.0f); e = fabsf(got - o); mag = fabsf(o); }
    red[t] = e; __syncthreads(); for (int o = 128; o >= 1; o >>= 1) { if (t < o) red[t] = fmaxf(red[t], red[t + o]); __syncthreads(); } e = red[0]; __syncthreads();
    red[t] = mag; __syncthreads(); for (int o = 128; o >= 1; o >>= 1) { if (t < o) red[t] = fmaxf(red[t], red[t + o]); __syncthreads(); } mag = red[0];
    if (t == 0) dbg_report(slot, e / (mag + 1e-4f));
}
__global__ void __launch_bounds__(256) k_check_gla_rec(const unsigned char* ws, const float* wa_f, const float* ba_f, const float* wa_b, const float* ba_b, float* obuf, int b) {
    __shared__ float ad[128], kd[128], qd[128], lrs[16];
    const int e = threadIdx.x, h = blockIdx.x & 3, dir = blockIdx.x >> 2; const bf16_t* P = (const bf16_t*)(ws + WS_P);
    const float* wa = dir ? wa_b : wa_f; const float* ba = dir ? ba_b : ba_f;
    float S[128];
#pragma unroll
    for (int d = 0; d < 128; ++d) S[d] = 0.f;
    float* ob = obuf + ((size_t)(dir * 2 + b) * 4 + h) * RPB * 256;
    for (int st = 0; st < RPB; ++st) {
        int j; if (!dir) j = st; else j = st < CTXL ? CTXL - 1 - st : RPB - 1 - (st - CTXL);
        const size_t r = (size_t)b * RPB + j; const bf16_t* pr = P + r * NP;
        if (e < 16) lrs[e] = bf2f(pr[(dir ? C_LRB : C_LRF) + e]);
        __syncthreads();
        if (e < 128) { float pre = ba[h * 128 + e]; for (int q = 0; q < 16; ++q) pre += lrs[q] * wa[q * 512 + h * 128 + e];
            const float ls = (fminf(pre, 0.f) - log1pf(expf(-fabsf(pre)))) / 16.f; ad[e] = expf(ls); kd[e] = bf2f(pr[C_LK + h * 128 + e]); qd[e] = bf2f(pr[C_LQ + h * 128 + e]) * 0.088388347648f; }
        __syncthreads();
        const float v = bf2f(pr[C_LV + h * 256 + e]); float o = 0.f;
#pragma unroll
        for (int d = 0; d < 128; ++d) { S[d] = ad[d] * S[d] + kd[d] * v; o += qd[d] * S[d]; }
        ob[(size_t)j * 256 + e] = o;
        __syncthreads();
    }
}
__global__ void k_check_gla_cmp(const unsigned char* ws, const float* obuf, const float* gon, int b, unsigned* slot) {
    __shared__ float red[256];
    const int e = threadIdx.x, h = blockIdx.x & 3, j = blockIdx.x >> 2; const size_t r = (size_t)b * RPB + j; const bf16_t* P = (const bf16_t*)(ws + WS_P);
    const float o = obuf[((size_t)(0 * 2 + b) * 4 + h) * RPB * 256 + (size_t)j * 256 + e] + obuf[((size_t)(1 * 2 + b) * 4 + h) * RPB * 256 + (size_t)j * 256 + e];
    red[e] = o * o; __syncthreads(); for (int s_ = 128; s_ >= 1; s_ >>= 1) { if (e < s_) red[e] += red[e + s_]; __syncthreads(); }
    const float rs = rsqrtf(red[0] / 256.f + NORM_EPS); __syncthreads();
    const float gt = bf2f(P[r * NP + C_LG + h * 256 + e]); const float ref = o * rs * gon[e] * (gt / (1.f + expf(-gt)));
    const float got = __builtin_amdgcn_cvt_f32_fp8((int)(ws + WS_OL)[r * 1024 + h * 256 + e], 0);
    red[e] = fabsf(got - ref); __syncthreads(); for (int s_ = 128; s_ >= 1; s_ >>= 1) { if (e < s_) red[e] = fmaxf(red[e], red[e + s_]); __syncthreads(); }
    if (e == 0) dbg_report(slot, red[0] / 1.0f);
}

__global__ void k_check_gemm8(const unsigned char* A8, const float* W, int K, int N, const bf16_t* Cm, int ldc, int M, unsigned* slot) {
    const unsigned id = blockIdx.x * blockDim.x + threadIdx.x; if (id >= 8192) return;
    const unsigned h = id * 2654435761u; const int row = (int)((h >> 8) % (unsigned)M), col = (int)((h * 40503u >> 7) % (unsigned)N);
    float ref = 0.f, mag = 0.f; for (int k = 0; k < K; ++k) { const float a = __builtin_amdgcn_cvt_f32_fp8((int)A8[(size_t)row * K + k], 0), w = W[(size_t)k * N + col]; ref += a * w; mag += a * a * w * w; }
    const float got = bf2f(Cm[(size_t)row * ldc + col]);
    dbg_report(slot, fabsf(got - ref) / (sqrtf(mag) + 1e-3f));
}
__global__ void k_check_select(const bf16_t* PQ, const float* k1, const float* k2, const int* PIDX, const float* PG, unsigned* slot) {
    __shared__ float s1[128], s2[128]; __shared__ int cnt; __shared__ float selv[16];
    const int tok = (blockIdx.x >> 3) * 61 + 5, head = blockIdx.x & 7, t = threadIdx.x;
    if (t == 0) cnt = 0;
    for (int n = t; n < 128; n += 64) { float a = 0.f, b = 0.f; for (int d = 0; d < 128; ++d) { a += bf2f(PQ[(size_t)tok * DM + head * 256 + d]) * k1[((size_t)head * 128 + n) * 128 + d]; b += bf2f(PQ[(size_t)tok * DM + head * 256 + 128 + d]) * k2[((size_t)head * 128 + n) * 128 + d]; } s1[n] = a; s2[n] = b; }
    __syncthreads();
    if (t < 16) { const int id = PIDX[(size_t)tok * 128 + head * 16 + t]; selv[t] = (id >= 0 && id < 16384) ? s1[id >> 7] + s2[id & 127] : -1e30f; }
    __syncthreads();
    float thr = selv[0], mx = selv[0]; for (int k = 1; k < 16; ++k) { thr = fminf(thr, selv[k]); mx = fmaxf(mx, selv[k]); }
    int c = 0; for (int p = t; p < 16384; p += 64) if (s1[p >> 7] + s2[p & 127] > thr + 0.02f) ++c;
    atomicAdd(&cnt, c); __syncthreads();
    if (t == 0) { float den = 0.f; for (int k = 0; k < 16; ++k) den += __expf(selv[k] - mx); float e = fabsf((float)cnt - 15.f) / 15.f > 0.34f ? fabsf((float)cnt - 15.f) / 15.f : 0.f;
        for (int k = 0; k < 16; ++k) e = fmaxf(e, fabsf(PG[(size_t)tok * 128 + head * 16 + k] - __expf(selv[k] - mx) / den) * 4.f);
        for (int k = 0; k < 16; ++k) for (int k2_ = 0; k2_ < k; ++k2_) if (PIDX[(size_t)tok * 128 + head * 16 + k] == PIDX[(size_t)tok * 128 + head * 16 + k2_]) e = fmaxf(e, 10.f);
        dbg_report(slot, e); }
}
__global__ void k_check_gather(const bf16_t* HB, const float* u, const float* v, const int* PIDX, const float* PG, const float* dbgo, unsigned* slot) {
    __shared__ float w[128];
    const int tok = blockIdx.x * 64 + 300, t = threadIdx.x;
    for (int k = t; k < 128; k += 64) { const int id = PIDX[(size_t)tok * 128 + k] & 16383; float a = 0.f; for (int d = 0; d < DM; ++d) a += bf2f(HB[(size_t)tok * DM + d]) * u[(size_t)id * DM + d];
        w[k] = PG[(size_t)tok * 128 + k] * 0.5f * a * (1.0f + erff(a * 0.70710678f)); }
    __syncthreads();
    float e = 0.f, sc = 0.f;
    for (int d = t; d < DM; d += 64) { float o = 0.f; for (int k = 0; k < 128; ++k) o += w[k] * v[(size_t)(PIDX[(size_t)tok * 128 + k] & 16383) * DM + d];
        e = fmaxf(e, fabsf(o - dbgo[(size_t)tok * DM + d])); sc = fmaxf(sc, fabsf(o)); }
    for (int o_ = 32; o_ >= 1; o_ >>= 1) { e = fmaxf(e, __shfl_xor(e, o_)); sc = fmaxf(sc, __shfl_xor(sc, o_)); }
    if (t == 0) dbg_report(slot, e / (sc + 1e-6f));
}
__global__ void k_dbg_out2(const float* x, const float* fg, float* out, const unsigned* slot) {
    const float mx = __uint_as_float(*slot); float v = 0.25f * (log10f(fmaxf(mx, 1e-30f)) + 4.0f); v = fminf(fmaxf(v, 0.f), 9.f);
    const float f = 1.0f + v;
    const int lane = threadIdx.x & 63; const size_t r = (size_t)blockIdx.x * 4 + (threadIdx.x >> 6);
    const float* xr = x + r * DM; float ss = 0.f;
    for (int c = lane; c < DM; c += 64) ss += xr[c] * xr[c];
    ss = wave_sum(ss); const float rs = rsqrtf(ss / DM + NORM_EPS);
    for (int c = lane; c < DM; c += 64) out[r * DM + c] = xr[c] * rs * fg[c] * f;
}
#endif
#ifdef DBG_SCAN
__global__ void k_scan16(const bf16_t* p, size_t n, unsigned* flags, int stage) {
    unsigned bad = 0; for (size_t i = (size_t)blockIdx.x * blockDim.x + threadIdx.x; i < n; i += (size_t)gridDim.x * blockDim.x) bad |= ((p[i] & 0x7f80u) == 0x7f80u);
    if (bad) atomicOr(&flags[stage], 1u);
}
__global__ void k_scan32(const float* p, size_t n, unsigned* flags, int stage) {
    unsigned bad = 0; for (size_t i = (size_t)blockIdx.x * blockDim.x + threadIdx.x; i < n; i += (size_t)gridDim.x * blockDim.x) bad |= ((__float_as_uint(p[i]) & 0x7f800000u) == 0x7f800000u);
    if (bad) atomicOr(&flags[stage], 1u);
}
__global__ void k_dbg_out(const float* x, const float* fg, float* out, const unsigned* flags, int nstage) {
    int code = 0; for (int s = nstage; s >= 1; --s) if (flags[s]) code = s;
    const float f = 1.0f + 0.25f * (float)code;
    const int lane = threadIdx.x & 63; const size_t r = (size_t)blockIdx.x * 4 + (threadIdx.x >> 6);
    const float* xr = x + r * DM; float ss = 0.f;
    for (int c = lane; c < DM; c += 64) ss += xr[c] * xr[c];
    ss = wave_sum(ss); const float rs = rsqrtf(ss / DM + NORM_EPS);
    for (int c = lane; c < DM; c += 64) out[r * DM + c] = xr[c] * rs * fg[c] * f;
}
#endif
extern "C" void kernel_launch(void* const* d_in, const int* in_sizes, int n_in, void* d_out, int out_size, void* d_ws, size_t ws_size, hipStream_t stream) {
    static int grid = 0;
    if (grid == 0) {
        if (n_in != 30 || out_size != NBATCH * SEQ * DM || ws_size < WS_END) { fprintf(stderr, "kernel_launch: shape/workspace mismatch: n_in %d out %d ws %zu (need %zu)\n", n_in, out_size, ws_size, (size_t)WS_END); grid = -1; return; }
        int dev = 0, cus = 0, per_cu = 0;
        if (hipGetDevice(&dev) != hipSuccess || hipDeviceGetAttribute(&cus, hipDeviceAttributeMultiprocessorCount, dev) != hipSuccess) { grid = -1; return; }
        bool okattr = hipFuncSetAttribute((const void*)MAIN_KERNEL, hipFuncAttributeMaxDynamicSharedMemorySize, LDS_BYTES) == hipSuccess;
#if MK_N_LAUNCHES != 1
#ifdef DBG_HYB
        okattr = okattr && hipFuncSetAttribute((const void*)mk_fwd, hipFuncAttributeMaxDynamicSharedMemorySize, LDS_BYTES) == hipSuccess;
#endif
#define SETA(K) okattr = okattr && hipFuncSetAttribute((const void*)k_one<K>, hipFuncAttributeMaxDynamicSharedMemorySize, LDS_BYTES) == hipSuccess
        SETA(0); SETA(1); SETA(2); SETA(3); SETA(4); SETA(5); SETA(6); SETA(7); SETA(8); SETA(9); SETA(10); SETA(11); SETA(12); SETA(13);
#undef SETA
#endif
        if (!okattr) { fprintf(stderr, "kernel_launch: hipFuncSetAttribute failed\n"); grid = -1; return; }
        if (hipOccupancyMaxActiveBlocksPerMultiprocessor(&per_cu, (const void*)MAIN_KERNEL, NTHREADS, LDS_BYTES) != hipSuccess || per_cu < 1) { fprintf(stderr, "kernel_launch: occupancy query says %d blocks per CU\n", per_cu); grid = -1; (void)hipGetLastError(); return; }
        grid = cus;
    }
    if (grid < 0) return;
    if (hipMemsetAsync((char*)d_ws + WS_CTL, 0, CTL_BYTES, stream) != hipSuccess) return;
    Args a{};
    for (int i = 0; i < 30; ++i) a.in[i] = (const float*)d_in[i];
    a.out = (float*)d_out; a.ws = (unsigned char*)d_ws;
#if defined(DBG_PROBE)
    { unsigned* flags = (unsigned*)((char*)d_ws + WS_CTL + 32768);
      hipLaunchKernelGGL(k_probe_mx, dim3(1), dim3(64), 0, stream, flags + 100);
      hipLaunchKernelGGL(k_dbg_out2, dim3(NBATCH * SEQ / 4), dim3(256), 0, stream, (const float*)d_in[0], (const float*)d_in[29], (float*)d_out, flags + 100); }
#elif MK_N_LAUNCHES == 1 && defined(DBG_CHECK)
    {
        unsigned* flags = (unsigned*)((char*)d_ws + WS_CTL + 32768); char* W = (char*)d_ws;
        a.ph_lo = 0; a.ph_hi = (DBG_CHECK == 8) ? 3 : (DBG_CHECK >= 5) ? 7 : (DBG_CHECK == 1 ? 11 : (DBG_CHECK == 2 ? 12 : 13));
        hipLaunchKernelGGL(mk_fwd, dim3(grid), dim3(NTHREADS), LDS_BYTES, stream, a);
#if DBG_CHECK == 8
        hipLaunchKernelGGL(k_check_gemm8, dim3(32), dim3(256), 0, stream, (const unsigned char*)(W + WS_HB), (const float*)d_in[I_WIN], DM, IN_COLS, (const bf16_t*)(W + WS_P), NP, TT, flags + 100);
#elif DBG_CHECK == 5 || DBG_CHECK == 6
        hipLaunchKernelGGL(k_check_attn, dim3(16 * 24), dim3(256), 0, stream, (const unsigned char*)d_ws, DBG_CHECK == 5 ? 1 : 0, flags + 100);
#elif DBG_CHECK == 7
        { float* obuf = (float*)(W + WS_MQ);
          hipLaunchKernelGGL(k_check_gla_rec, dim3(8), dim3(256), 0, stream, (const unsigned char*)d_ws, (const float*)d_in[I_WA2F], (const float*)d_in[I_BAF], (const float*)d_in[I_WA2B], (const float*)d_in[I_BAB], obuf, 0);
          hipLaunchKernelGGL(k_check_gla_cmp, dim3(RPB * 4), dim3(256), 0, stream, (const unsigned char*)d_ws, (const float*)obuf, (const float*)d_in[I_ONG], 0, flags + 100); }
#elif DBG_CHECK == 1
        hipLaunchKernelGGL(k_check_gemm, dim3(32), dim3(256), 0, stream, (const bf16_t*)(W + WS_HB), DM, (const float*)d_in[I_PWQ], DM, DM, (const bf16_t*)(W + WS_PQ), DM, TT, flags + 100);
#elif DBG_CHECK == 2
        hipLaunchKernelGGL(k_check_select, dim3(256 * 8), dim3(64), 0, stream, (const bf16_t*)(W + WS_PQ), (const float*)d_in[I_PK1], (const float*)d_in[I_PK2], (const int*)(W + WS_PIDX), (const float*)(W + WS_PG), flags + 100);
#else
        hipLaunchKernelGGL(k_check_gather, dim3(128), dim3(64), 0, stream, (const bf16_t*)(W + WS_HB), (const float*)d_in[I_PU], (const float*)d_in[I_PV], (const int*)(W + WS_PIDX), (const float*)(W + WS_PG), (const float*)(W + WS_MQ), flags + 100);
#endif
        hipLaunchKernelGGL(k_dbg_out2, dim3(NBATCH * SEQ / 4), dim3(256), 0, stream, (const float*)d_in[0], (const float*)d_in[29], (float*)d_out, flags + 100);
    }
#elif MK_N_LAUNCHES == 1
#ifdef DBG_SPLIT
    for (int p = 0; p < N_PHASES; p += DBG_SPLIT) { a.ph_lo = p; a.ph_hi = p + DBG_SPLIT < N_PHASES ? p + DBG_SPLIT : N_PHASES; hipLaunchKernelGGL(mk_fwd, dim3(grid), dim3(NTHREADS), LDS_BYTES, stream, a); }
#else
    a.ph_lo = 0; a.ph_hi = N_PHASES;
    hipLaunchKernelGGL(mk_fwd, dim3(grid), dim3(NTHREADS), LDS_BYTES, stream, a);
#endif
#else
    a.ph_hi = 0;
#ifndef DBG_NLAUNCH
#define DBG_NLAUNCH 100
#endif
    int nl_ = 0;
#ifdef DBG_HYB
#define LAUNCH1(K, L) do { if (K == DBG_HYB) { a.ph_lo = 12 * (L) + (K); a.ph_hi = a.ph_lo + 1; hipLaunchKernelGGL(mk_fwd, dim3(grid), dim3(NTHREADS), LDS_BYTES, stream, a); a.ph_hi = 0; } else { a.ph_lo = (L); hipLaunchKernelGGL(k_one<K>, dim3(grid), dim3(NTHREADS), LDS_BYTES, stream, a); } } while (0)
#else
#define LAUNCH1(K, L) do { a.ph_lo = (L); if (nl_++ < DBG_NLAUNCH) { hipLaunchKernelGGL(k_one<K>, dim3(grid), dim3(NTHREADS), LDS_BYTES, stream, a); if (K == DBG_DUP) hipLaunchKernelGGL(k_one<K>, dim3(grid), dim3(NTHREADS), LDS_BYTES, stream, a); } } while (0)
#endif
#ifdef DBG_SCAN
    unsigned* flags = (unsigned*)((char*)d_ws + WS_CTL + 32768);
    char* W = (char*)d_ws;
#define S16(off, n, st) hipLaunchKernelGGL(k_scan16, dim3(1024), dim3(256), 0, stream, (const bf16_t*)(W + (off)), (size_t)(n), flags, st)
#define S32(off, n, st) hipLaunchKernelGGL(k_scan32, dim3(1024), dim3(256), 0, stream, (const float*)(W + (off)), (size_t)(n), flags, st)
    LAUNCH1(0, 0); S32(WS_MODV, 2 * 3 * 12288, 1);
    { const int l = 0;
      LAUNCH1(1, l); S16(WS_HB, (size_t)TT * DM, 2);
      LAUNCH1(2, l); S16(WS_P, (size_t)TT * NP, 3);
      LAUNCH1(3, l); S16(WS_P, (size_t)TT * NP, 4);
      LAUNCH1(4, l); S16(WS_MQ, (size_t)TT * 1536, 5); S16(WS_MKV, (size_t)TT * 2048, 5); S16(WS_GST, (size_t)2112 * 32768, 6); S32(WS_GDEC, (size_t)2112 * 128, 6);
      LAUNCH1(5, l); S16(WS_GST, (size_t)2112 * 32768, 7);
      LAUNCH1(6, l); S16(WS_OA, (size_t)TT * 1024, 8); S16(WS_OM, (size_t)TT * 1024, 9); S16(WS_OL, (size_t)TT * 1024, 10);
      LAUNCH1(7, l); S16(WS_Y, (size_t)TT * DM, 11);
      LAUNCH1(8, l); S32(WS_XS, (size_t)TT * DM, 12);
      LAUNCH1(9, l); S16(WS_HB, (size_t)TT * DM, 13);
      LAUNCH1(10, l); S16(WS_PQ, (size_t)TT * DM, 14);
      LAUNCH1(11, l); S32(WS_PG, (size_t)TT * 128, 15);
      LAUNCH1(12, l); S32(WS_XS, (size_t)TT * DM, 16);
    }
    hipLaunchKernelGGL(k_dbg_out, dim3(NBATCH * SEQ / 4), dim3(256), 0, stream, (const float*)d_in[0], (const float*)d_in[29], (float*)d_out, flags, 16);
#elif defined(DBG_CHECK)
    unsigned* flags = (unsigned*)((char*)d_ws + WS_CTL + 32768);
    char* W = (char*)d_ws;
    LAUNCH1(0, 0);
    { const int l = 0; LAUNCH1(1, l); LAUNCH1(2, l); LAUNCH1(3, l); LAUNCH1(4, l); LAUNCH1(5, l); LAUNCH1(6, l);
#if DBG_CHECK == 5 || DBG_CHECK == 6
      hipLaunchKernelGGL(k_check_attn, dim3(16 * 24), dim3(256), 0, stream, (const unsigned char*)d_ws, DBG_CHECK == 5 ? 1 : 0, flags + 100);
#endif
#if DBG_CHECK == 7
      { float* obuf = (float*)(W + WS_MQ);
        hipLaunchKernelGGL(k_check_gla_rec, dim3(8), dim3(256), 0, stream, (const unsigned char*)d_ws, (const float*)d_in[I_WA2F], (const float*)d_in[I_BAF], (const float*)d_in[I_WA2B], (const float*)d_in[I_BAB], obuf, 0);
        hipLaunchKernelGGL(k_check_gla_cmp, dim3(RPB * 4), dim3(256), 0, stream, (const unsigned char*)d_ws, (const float*)obuf, (const float*)d_in[I_ONG], 0, flags + 100); }
#endif
      LAUNCH1(7, l); LAUNCH1(8, l); LAUNCH1(9, l); LAUNCH1(10, l);
#if DBG_CHECK == 1
      hipLaunchKernelGGL(k_check_gemm, dim3(32), dim3(256), 0, stream, (const bf16_t*)(W + WS_HB), DM, (const float*)d_in[I_PWQ], DM, DM, (const bf16_t*)(W + WS_PQ), DM, TT, flags + 100);
#endif
      LAUNCH1(11, l);
#if DBG_CHECK == 2
      hipLaunchKernelGGL(k_check_select, dim3(256 * 8), dim3(64), 0, stream, (const bf16_t*)(W + WS_PQ), (const float*)d_in[I_PK1], (const float*)d_in[I_PK2], (const int*)(W + WS_PIDX), (const float*)(W + WS_PG), flags + 100);
#endif
      LAUNCH1(12, l);
#if DBG_CHECK == 3
      hipLaunchKernelGGL(k_check_gather, dim3(128), dim3(64), 0, stream, (const bf16_t*)(W + WS_HB), (const float*)d_in[I_PU], (const float*)d_in[I_PV], (const int*)(W + WS_PIDX), (const float*)(W + WS_PG), (const float*)(W + WS_MQ), flags + 100);
#endif
    }
    hipLaunchKernelGGL(k_dbg_out2, dim3(NBATCH * SEQ / 4), dim3(256), 0, stream, (const float*)d_in[0], (const float*)d_in[29], (float*)d_out, flags + 100);
#else
    LAUNCH1(0, 0);
    for (int l = 0; l < DEPTH; ++l) { LAUNCH1(1, l); LAUNCH1(2, l); LAUNCH1(3, l);
#ifdef DBG_DUP23
        LAUNCH1(2, l); LAUNCH1(3, l);
#endif
        LAUNCH1(4, l); LAUNCH1(5, l);
#ifdef DBG_DUP45
        LAUNCH1(4, l); LAUNCH1(5, l);
#endif
        LAUNCH1(6, l); LAUNCH1(7, l); LAUNCH1(8, l); LAUNCH1(9, l); LAUNCH1(10, l); LAUNCH1(11, l); LAUNCH1(12, l); }
    LAUNCH1(13, DEPTH - 1);
#endif
#undef LAUNCH1
#endif
    const hipError_t le = hipPeekAtLastError();
    if (le != hipSuccess) fprintf(stderr, "kernel_launch: launch failed: %s\n", hipGetErrorName(le));
}
```
